# Optimizing an MI355X kernel written in HIP

```python
import math
import jax
import jax.numpy as jnp
from jax import lax
import numpy as np

D_MODEL = 1024
BATCH = 8
SEQ = 4096
DEPTH = 2

HEAD_DIM = 64
NSA_HEADS = 8
NSA_KV_GROUPS = 2
CMP_BLOCK = 32
CMP_STRIDE = 16
CMP_HIDDEN = 256
SLC_BLOCK = 64
SLC_TOPK = 16
WINDOW = 512
FOX_HEADS = 4
DIFF_HEADS = 4
DIFF_QK_DIM = HEAD_DIM // 2
N_GROUPS = 4
EXPERTS_PER_GROUP = 8
N_EXPERTS = N_GROUPS * EXPERTS_PER_GROUP
TOPK_IN_GROUP = 2
D_EXPERT = 256
Q_BLOCK = 128
SLC_Q_BLOCK = 64
RMS_EPS = 1e-6
NEG_INF = -1e30
FORCE_SCORE = 1e4

NSA_Q = NSA_HEADS * HEAD_DIM
NSA_KV = NSA_KV_GROUPS * HEAD_DIM
NSA_GATE = NSA_HEADS * 3
FOX_W = FOX_HEADS * HEAD_DIM
DIFF_W = DIFF_HEADS * HEAD_DIM
MIX_WIDTH = NSA_Q + FOX_W + DIFF_W
IN_WIDTHS = (NSA_Q, NSA_KV, NSA_KV, NSA_KV, NSA_KV, NSA_KV, NSA_KV, NSA_GATE,
             FOX_W, FOX_W, FOX_W, FOX_HEADS, DIFF_W, DIFF_W, DIFF_W)
D_IN = sum(IN_WIDTHS)

kernel_name = "hybrid_nsa_fox_diff_hmoe"


def _rmsnorm(x, g):
    xf = x.astype(jnp.float32)
    y = xf * lax.rsqrt(jnp.mean(xf * xf, axis=-1, keepdims=True) + RMS_EPS)
    return (y * g.astype(jnp.float32)).astype(x.dtype)


def _masked_softmax(logits, mask):
    logits = jnp.where(mask, logits.astype(jnp.float32), NEG_INF)
    return jnp.where(mask, jax.nn.softmax(logits, axis=-1), 0.0)


def _alibi_slopes(n):
    return jnp.asarray(2.0 ** (-8.0 * np.arange(1, n + 1) / n), dtype=jnp.float32)


def _lambda_init(layer):
    return 0.8 - 0.6 * math.exp(-0.3 * layer)


def _nsa_mixer(q, kc, vc, ks, vs, kw, vw, gate_logits,
               cmp_k_pe, cmp_k_w1, cmp_k_w2, cmp_v_pe, cmp_v_w1, cmp_v_w2):
    B, T, _ = q.shape
    G, HG, HD = NSA_KV_GROUPS, NSA_HEADS // NSA_KV_GROUPS, HEAD_DIM
    scale = HD ** -0.5
    slopes = _alibi_slopes(NSA_HEADS).reshape(G, HG)[:, :, None, None]
    qh = q.reshape(B, T, G, HG, HD).transpose(0, 2, 3, 1, 4)

    def kvh(a):
        return a.reshape(B, T, G, HD).transpose(0, 2, 1, 3)

    kc, vc, ks, vs, kw, vw = (kvh(a) for a in (kc, vc, ks, vs, kw, vw))
    pos = jnp.arange(T)

    n_cmp = (T - CMP_BLOCK) // CMP_STRIDE + 1
    tok = np.arange(n_cmp)[:, None] * CMP_STRIDE + np.arange(CMP_BLOCK)[None, :]

    def compress(a, pe, w1, w2):
        blk = (a[:, :, tok, :] + pe).reshape(B, G, n_cmp, CMP_BLOCK * HD)
        return jax.nn.gelu(blk @ w1) @ w2

    k_cmp = compress(kc, cmp_k_pe, cmp_k_w1, cmp_k_w2)
    v_cmp = compress(vc, cmp_v_pe, cmp_v_w1, cmp_v_w2)
    cmp_end = jnp.arange(n_cmp) * CMP_STRIDE + CMP_BLOCK - 1
    dist_c = (pos[:, None] - cmp_end[None, :]).astype(jnp.float32)
    s_cmp = jnp.einsum('bghtd,bgcd->bghtc', qh, k_cmp) * scale - slopes * dist_c
    p_cmp = _masked_softmax(s_cmp, dist_c >= 0)
    o_cmp = jnp.einsum('bghtc,bgcd->bghtd', p_cmp.astype(v_cmp.dtype), v_cmp)

    n_sel = T // SLC_BLOCK
    top_n = min(SLC_TOPK, n_sel)
    c_start = np.arange(n_cmp) * CMP_STRIDE
    s_start = np.arange(n_sel) * SLC_BLOCK
    overlap = np.clip(np.minimum(c_start[:, None] + CMP_BLOCK, s_start[None, :] + SLC_BLOCK)
                      - np.maximum(c_start[:, None], s_start[None, :]), 0, None) / CMP_BLOCK
    overlap = jnp.asarray(overlap, dtype=jnp.float32)
    imp = jnp.einsum('bghtc,cj->bgtj', p_cmp, overlap)
    cur = pos // SLC_BLOCK
    j = jnp.arange(n_sel)
    valid = j[None, :] <= cur[:, None]
    forced = (j[None, :] == 0) | (j[None, :] == cur[:, None]) | (j[None, :] == cur[:, None] - 1)
    imp = jnp.where(valid, jnp.where(forced, FORCE_SCORE, imp), NEG_INF)
    _, sel_idx = lax.top_k(imp, top_n)

    ks_b = ks.reshape(B, G, n_sel, SLC_BLOCK, HD)
    vs_b = vs.reshape(B, G, n_sel, SLC_BLOCK, HD)
    nq = T // SLC_Q_BLOCK
    q_chunks = qh.reshape(B, G, HG, nq, SLC_Q_BLOCK, HD).transpose(3, 0, 1, 2, 4, 5)
    idx_chunks = sel_idx.reshape(B, G, nq, SLC_Q_BLOCK, top_n).transpose(2, 0, 1, 3, 4)
    pos_chunks = pos.reshape(nq, SLC_Q_BLOCK)
    b_ix = jnp.arange(B)[:, None, None, None]
    g_ix = jnp.arange(G)[None, :, None, None]
    n_keys = top_n * SLC_BLOCK

    def slc_block(args):
        qc, ic, pc = args
        k_sel = ks_b[b_ix, g_ix, ic].reshape(B, G, SLC_Q_BLOCK, n_keys, HD)
        v_sel = vs_b[b_ix, g_ix, ic].reshape(B, G, SLC_Q_BLOCK, n_keys, HD)
        kpos = (ic[..., None] * SLC_BLOCK + jnp.arange(SLC_BLOCK)).reshape(B, G, SLC_Q_BLOCK, n_keys)
        dist = (pc[:, None] - kpos).astype(jnp.float32)[:, :, None]
        s = jnp.einsum('bghqd,bgqkd->bghqk', qc, k_sel) * scale - slopes * dist
        p = _masked_softmax(s, dist >= 0)
        return jnp.einsum('bghqk,bgqkd->bghqd', p.astype(v_sel.dtype), v_sel)

    o_slc = lax.map(slc_block, (q_chunks, idx_chunks, pos_chunks))
    o_slc = o_slc.transpose(1, 2, 3, 0, 4, 5).reshape(B, G, HG, T, HD)

    nb = T // Q_BLOCK
    span = WINDOW + Q_BLOCK
    kw_p = jnp.pad(kw, ((0, 0), (0, 0), (WINDOW, 0), (0, 0)))
    vw_p = jnp.pad(vw, ((0, 0), (0, 0), (WINDOW, 0), (0, 0)))
    q_blocks = qh.reshape(B, G, HG, nb, Q_BLOCK, HD).transpose(3, 0, 1, 2, 4, 5)

    def win_block(args):
        qb, i = args
        start = i * Q_BLOCK
        kb = lax.dynamic_slice_in_dim(kw_p, start, span, axis=2)
        vb = lax.dynamic_slice_in_dim(vw_p, start, span, axis=2)
        qpos = start + jnp.arange(Q_BLOCK)
        kpos = start - WINDOW + jnp.arange(span)
        dist = (qpos[:, None] - kpos[None, :]).astype(jnp.float32)
        mask = (dist >= 0) & (dist < WINDOW) & (kpos[None, :] >= 0)
        s = jnp.einsum('bghqd,bgkd->bghqk', qb, kb) * scale - slopes * dist
        p = _masked_softmax(s, mask)
        return jnp.einsum('bghqk,bgkd->bghqd', p.astype(vb.dtype), vb)

    o_win = lax.map(win_block, (q_blocks, jnp.arange(nb)))
    o_win = o_win.transpose(1, 2, 3, 0, 4, 5).reshape(B, G, HG, T, HD)

    gates = jax.nn.sigmoid(gate_logits).reshape(B, T, G, HG, 3).transpose(0, 2, 3, 1, 4)
    o = gates[..., 0:1] * o_cmp + gates[..., 1:2] * o_slc + gates[..., 2:3] * o_win
    return o.transpose(0, 3, 1, 2, 4).reshape(B, T, NSA_Q)


def _fox_mixer(q, k, v, f_logit):
    B, T, _ = q.shape
    H, HD = FOX_HEADS, HEAD_DIM
    scale = HD ** -0.5
    qh = q.reshape(B, T, H, HD).transpose(0, 2, 1, 3)
    kh = k.reshape(B, T, H, HD).transpose(0, 2, 1, 3)
    vh = v.reshape(B, T, H, HD).transpose(0, 2, 1, 3)
    log_f = jax.nn.log_sigmoid(f_logit.astype(jnp.float32)).transpose(0, 2, 1)
    cum = jnp.cumsum(log_f, axis=-1)
    nb = T // Q_BLOCK
    q_blocks = qh.reshape(B, H, nb, Q_BLOCK, HD).transpose(2, 0, 1, 3, 4)
    c_blocks = cum.reshape(B, H, nb, Q_BLOCK).transpose(2, 0, 1, 3)
    pos_blocks = jnp.arange(T).reshape(nb, Q_BLOCK)
    kpos = jnp.arange(T)

    def blk(args):
        qb, cb, pb = args
        s = jnp.einsum('bhqd,bhkd->bhqk', qb, kh) * scale + (cb[..., None] - cum[:, :, None, :])
        p = _masked_softmax(s, pb[:, None] >= kpos[None, :])
        return jnp.einsum('bhqk,bhkd->bhqd', p.astype(vh.dtype), vh)

    o = lax.map(blk, (q_blocks, c_blocks, pos_blocks))
    return o.transpose(1, 0, 3, 2, 4).reshape(B, T, FOX_W)


def _diff_mixer(q, k, v, lam, subln, lambda_init):
    B, T, _ = q.shape
    H, d, HD = DIFF_HEADS, DIFF_QK_DIM, HEAD_DIM
    scale = d ** -0.5
    qh = q.reshape(B, T, H, 2, d).transpose(0, 2, 3, 1, 4)
    kh = k.reshape(B, T, H, 2, d).transpose(0, 2, 3, 1, 4)
    vh = v.reshape(B, T, H, HD).transpose(0, 2, 1, 3)
    lam_f = lam.astype(jnp.float32)
    lam_full = jnp.exp(jnp.sum(lam_f[0] * lam_f[1])) - jnp.exp(jnp.sum(lam_f[2] * lam_f[3])) + lambda_init
    slopes = _alibi_slopes(H)[:, None, None, None]
    nb = T // Q_BLOCK
    q_blocks = qh.reshape(B, H, 2, nb, Q_BLOCK, d).transpose(3, 0, 1, 2, 4, 5)
    pos_blocks = jnp.arange(T).reshape(nb, Q_BLOCK)
    kpos = jnp.arange(T)

    def blk(args):
        qb, pb = args
        dist = (pb[:, None] - kpos[None, :]).astype(jnp.float32)
        s = jnp.einsum('bhiqd,bhikd->bhiqk', qb, kh) * scale - slopes * dist
        p = _masked_softmax(s, dist >= 0)
        attn = p[:, :, 0] - lam_full * p[:, :, 1]
        return jnp.einsum('bhqk,bhkd->bhqd', attn.astype(vh.dtype), vh)

    o = lax.map(blk, (q_blocks, pos_blocks))
    o = o.transpose(1, 0, 3, 2, 4).reshape(B, T, H, HD)
    o = _rmsnorm(o, subln) * (1.0 - lambda_init)
    return o.reshape(B, T, DIFF_W)


def _hier_moe(h, w_grp, b_grp, w_exp, b_exp, w_e_gate, w_e_up, w_e_down):
    B, T, D = h.shape
    hf = h.reshape(B * T, D)
    n = hf.shape[0]
    rows = jnp.arange(n)
    grp_logits = (hf @ w_grp).astype(jnp.float32) + b_grp.astype(jnp.float32)
    grp_prob = jax.nn.softmax(grp_logits, axis=-1)
    grp = jnp.argmax(grp_logits, axis=-1)
    grp_gate = grp_prob[rows, grp][:, None]
    exp_logits = ((hf @ w_exp).astype(jnp.float32) + b_exp.astype(jnp.float32)).reshape(n, N_GROUPS, EXPERTS_PER_GROUP)
    in_grp = exp_logits[rows, grp]
    top_val, top_idx = lax.top_k(in_grp, TOPK_IN_GROUP)
    w_top = jax.nn.softmax(top_val, axis=-1) * grp_gate
    eid = grp[:, None] * EXPERTS_PER_GROUP + top_idx
    gate = jnp.sum(jax.nn.one_hot(eid, N_EXPERTS, dtype=jnp.float32) * w_top[..., None], axis=1)
    gate = gate.astype(hf.dtype)
    out = jnp.zeros_like(hf)
    for e in range(N_EXPERTS):
        a = hf @ w_e_gate[e]
        u = hf @ w_e_up[e]
        out = out + (jax.nn.silu(a) * u * gate[:, e:e + 1]) @ w_e_down[e]
    return out.reshape(B, T, D)


def setup_inputs(seed: int = 0) -> dict:
    key = jax.random.key(seed)
    ks = jax.random.split(key, 24)
    L, D = DEPTH, D_MODEL

    def nrm(k, shape, fan_in):
        return jax.random.normal(k, shape, jnp.float32) * fan_in ** -0.5

    def small(k, shape, s):
        return s * jax.random.normal(k, shape, jnp.float32)

    return {
        'x': jax.random.normal(ks[0], (BATCH, SEQ, D), jnp.float32),
        'norm_attn': 1.0 + small(ks[1], (L, D), 0.02),
        'w_in': nrm(ks[2], (L, D, D_IN), D),
        'b_gate': small(ks[3], (L, NSA_GATE), 0.02),
        'b_fgt': 2.0 + 2.0 * jax.random.uniform(ks[4], (L, FOX_HEADS), jnp.float32),
        'cmp_k_pe': small(ks[5], (L, CMP_BLOCK, HEAD_DIM), 0.1),
        'cmp_k_w1': nrm(ks[6], (L, CMP_BLOCK * HEAD_DIM, CMP_HIDDEN), CMP_BLOCK * HEAD_DIM),
        'cmp_k_w2': nrm(ks[7], (L, CMP_HIDDEN, HEAD_DIM), CMP_HIDDEN),
        'cmp_v_pe': small(ks[8], (L, CMP_BLOCK, HEAD_DIM), 0.1),
        'cmp_v_w1': nrm(ks[9], (L, CMP_BLOCK * HEAD_DIM, CMP_HIDDEN), CMP_BLOCK * HEAD_DIM),
        'cmp_v_w2': nrm(ks[10], (L, CMP_HIDDEN, HEAD_DIM), CMP_HIDDEN),
        'diff_lambda': small(ks[11], (L, 4, DIFF_QK_DIM), 0.1),
        'diff_subln': 1.0 + small(ks[12], (L, HEAD_DIM), 0.02),
        'w_out': nrm(ks[13], (L, MIX_WIDTH, D), MIX_WIDTH),
        'norm_ffn': 1.0 + small(ks[14], (L, D), 0.02),
        'w_grp': nrm(ks[15], (L, D, N_GROUPS), D),
        'b_grp': small(ks[16], (L, N_GROUPS), 0.01),
        'w_exp': nrm(ks[17], (L, D, N_EXPERTS), D),
        'b_exp': small(ks[18], (L, N_EXPERTS), 0.01),
        'w_e_gate': nrm(ks[19], (L, N_EXPERTS, D, D_EXPERT), D),
        'w_e_up': nrm(ks[20], (L, N_EXPERTS, D, D_EXPERT), D),
        'w_e_down': nrm(ks[21], (L, N_EXPERTS, D_EXPERT, D), D_EXPERT),
        'norm_final': 1.0 + small(ks[22], (D,), 0.02),
    }


def reference(x, norm_attn, w_in, b_gate, b_fgt, cmp_k_pe, cmp_k_w1, cmp_k_w2,
              cmp_v_pe, cmp_v_w1, cmp_v_w2, diff_lambda, diff_subln, w_out,
              norm_ffn, w_grp, b_grp, w_exp, b_exp, w_e_gate, w_e_up, w_e_down,
              norm_final):
    splits = [int(s) for s in np.cumsum(IN_WIDTHS)[:-1]]
    for l in range(DEPTH):
        h = _rmsnorm(x, norm_attn[l])
        proj = h @ w_in[l]
        (nsa_q, kc, vc, ks_, vs_, kw, vw, nsa_g,
         fq, fk, fv, ff, dq, dk, dv) = jnp.split(proj, splits, axis=-1)
        o_a = _nsa_mixer(nsa_q, kc, vc, ks_, vs_, kw, vw, nsa_g + b_gate[l],
                         cmp_k_pe[l], cmp_k_w1[l], cmp_k_w2[l],
                         cmp_v_pe[l], cmp_v_w1[l], cmp_v_w2[l])
        o_b = _fox_mixer(fq, fk, fv, ff + b_fgt[l])
        o_c = _diff_mixer(dq, dk, dv, diff_lambda[l], diff_subln[l], _lambda_init(l))
        x = x + jnp.concatenate([o_a, o_b, o_c], axis=-1) @ w_out[l]
        x = x + _hier_moe(_rmsnorm(x, norm_ffn[l]), w_grp[l], b_grp[l], w_exp[l], b_exp[l],
                          w_e_gate[l], w_e_up[l], w_e_down[l])
    return _rmsnorm(x, norm_final)
```

```cpp
#include <hip/hip_runtime.h>
#include <cstdio>
#include <cstdint>

#ifndef N_LAUNCH_MODE
#define N_LAUNCH_MODE 0
#endif

#define LAS __attribute__((address_space(3)))
#define GAS __attribute__((address_space(1)))
typedef unsigned short bf16;
typedef unsigned long long u64;
typedef float f32x4 __attribute__((ext_vector_type(4)));
typedef unsigned u32x4 __attribute__((ext_vector_type(4)));

constexpr int B_ = 8, T_ = 4096, D_ = 1024, NT = B_ * T_, L_ = 2;
constexpr int HD = 64, D_IN = 2844;
constexpr int N_CMP = 255, CMP_HID = 256;
constexpr int NEXP = 32, DEXP = 256;
constexpr float EPS = 1e-6f;
constexpr float LOG2E = 1.4426950408889634f;
constexpr int NWAVES = 8, NTHREADS = 512;

constexpr int C_NSAQ = 0, C_KV6 = 512, C_GATE = 1280, C_FQ = 1304, C_FF = 2072, C_DQ = 2076, C_DV = 2588;

constexpr size_t MiB = 1u << 20;
constexpr size_t WS_CTL = 0, CTL_BYTES = 1 * MiB;
constexpr size_t WS_QN = 1 * MiB;
constexpr size_t WS_KV6 = WS_QN + 32 * MiB;
constexpr size_t KV6_STRIDE = 8 * MiB + 64 * 1024;
constexpr size_t WS_FQKV = WS_KV6 + 6 * KV6_STRIDE;
constexpr size_t WS_DQK = WS_FQKV + 48 * MiB;
constexpr size_t WS_DV = WS_DQK + 32 * MiB;
constexpr size_t WS_GATE = WS_DV + 16 * MiB;
constexpr size_t WS_FL = WS_GATE + 3 * MiB;
constexpr size_t WS_HC = WS_FL + 1 * MiB;
constexpr size_t WS_KVCMP = WS_HC + 4 * MiB;
constexpr size_t WS_SEL = WS_KVCMP + 1 * MiB;
constexpr size_t WS_OCMP = WS_SEL + 1 * MiB;
constexpr size_t WS_OWIN = WS_OCMP + 32 * MiB;
constexpr size_t WS_HN = WS_OWIN + 32 * MiB;
constexpr size_t WS_ATT = WS_HN + 64 * MiB;
constexpr size_t WS_ROUTE = WS_ATT + 64 * MiB;
constexpr size_t WS_END = WS_ROUTE + 1 * MiB;

__device__ __forceinline__ float bf2f(bf16 v) { return __uint_as_float(((unsigned)v) << 16); }
__device__ __forceinline__ unsigned f2bf(float f) { unsigned u = __float_as_uint(f); return (u + 0x7fffu + ((u >> 16) & 1u)) >> 16; }
__device__ __forceinline__ unsigned pk2(float lo, float hi) { return f2bf(lo) | (f2bf(hi) << 16); }
__device__ __forceinline__ float wave_sum(float v) {
#pragma unroll
    for (int o = 1; o < 64; o <<= 1) v += __shfl_xor(v, o);
    return v;
}
__device__ __forceinline__ float wave_max(float v) {
#pragma unroll
    for (int o = 1; o < 64; o <<= 1) v = fmaxf(v, __shfl_xor(v, o));
    return v;
}
__device__ __forceinline__ float sigmoidf_(float x) { return 1.f / (1.f + __expf(-x)); }
__device__ __forceinline__ float log_sigmoidf_(float x) { return x >= 0.f ? -log1pf(__expf(-x)) : x - log1pf(__expf(x)); }
__device__ __forceinline__ float gelu_tanh(float x) { const float u = 0.7978845608028654f * (x + 0.044715f * x * x * x); return 0.5f * x * (1.f + tanhf(u)); }
__device__ __forceinline__ float alibi_slope(int idx1, int n) { return exp2f(-8.0f * (float)idx1 / (float)n); }

#define XB_TMO      128
#define XB_XCNT(j)  (256  + 64 * (j))
#define XB_XSUB(j)  (1280 + 64 * (j))
#define XB_XGEN(j)  (2304 + 64 * (j))
#define XB_TOP      3328
#define XB_TOPGEN   3392
#define XCD_BAR_WORDS 3456
#define XB_SPIN_CAP (1u << 25)
__device__ __forceinline__ unsigned xb_ld(unsigned* p)              { return __hip_atomic_load(p, __ATOMIC_RELAXED, __HIP_MEMORY_SCOPE_AGENT); }
__device__ __forceinline__ unsigned xb_add(unsigned* p, unsigned v) { return __hip_atomic_fetch_add(p, v, __ATOMIC_RELAXED, __HIP_MEMORY_SCOPE_AGENT); }
__device__ __forceinline__ unsigned xb_xcc_id() { return (unsigned)__builtin_amdgcn_s_getreg((3 << 11) | 20) & 0xFu; }
#define XB_SPIN(cond, bar) do { unsigned _sp = 0; while (cond) { __builtin_amdgcn_s_sleep(1); \
    if ((++_sp & 255u) == 0u) { if (xb_ld(&(bar)[XB_TMO])) break; if (_sp > XB_SPIN_CAP) { atomicAdd(&(bar)[XB_TMO], 1u); break; } } } } while (0)
struct XcdBarrier { unsigned* bar; unsigned x; volatile LAS unsigned* st; };
__device__ __forceinline__ XcdBarrier xcd_barrier_post(unsigned* bar, volatile LAS unsigned* st) {
    XcdBarrier b; b.bar = bar; b.x = xb_xcc_id(); b.st = st;
    if (threadIdx.x == 0) (void)xb_add(&bar[XB_XCNT(b.x)], 1u);
    return b;
}
__device__ __forceinline__ void xcd_barrier_complete(unsigned* bar, unsigned x, unsigned& nloc, unsigned& nx) {
    const unsigned G = gridDim.x * gridDim.y * gridDim.z;
    unsigned sum, cnt, mine, sp = 0u;
    for (;;) {
        sum = 0u; cnt = 0u; mine = 0u;
#pragma unroll
        for (unsigned j = 0; j < 16; ++j) { const unsigned c = xb_ld(&bar[XB_XCNT(j)]); sum += c; cnt += (c > 0u) ? 1u : 0u; mine = (j == x) ? c : mine; }
        if (sum == G) break;
        __builtin_amdgcn_s_sleep(1);
        if ((++sp & 255u) == 0u) { if (xb_ld(&bar[XB_TMO])) break; if (sp > XB_SPIN_CAP) { atomicAdd(&bar[XB_TMO], 1u); break; } }
    }
    nloc = mine > 0u ? mine : 1u; nx = cnt > 0u ? cnt : 1u;
}
__device__ __forceinline__ void xcd_barrier(const XcdBarrier& b) {
    asm volatile("s_waitcnt vmcnt(0)" ::: "memory");
    __syncthreads();
    if (threadIdx.x == 0) {
        unsigned* bar = b.bar;
        __builtin_amdgcn_s_waitcnt(0);
        unsigned nloc = b.st[0], nx = b.st[1];
        if (nloc == 0u) { xcd_barrier_complete(bar, b.x, nloc, nx); b.st[0] = nloc; b.st[1] = nx; }
        const unsigned old = xb_add(&bar[XB_XSUB(b.x)], 1u);
        const unsigned gen = old / nloc;
        if (old + 1u == (gen + 1u) * nloc) {
            __builtin_amdgcn_fence(__ATOMIC_RELEASE, "agent");
            asm volatile("s_waitcnt vmcnt(0)" ::: "memory");
            const unsigned og = xb_add(&bar[XB_TOP], 1u);
            const unsigned tg = og / nx;
            if (og + 1u == (tg + 1u) * nx) xb_add(&bar[XB_TOPGEN], 1u);
            else XB_SPIN(xb_ld(&bar[XB_TOPGEN]) == tg, bar);
            __builtin_amdgcn_fence(__ATOMIC_ACQUIRE, "agent");
            xb_add(&bar[XB_XGEN(b.x)], 1u);
            asm volatile("s_waitcnt vmcnt(0)" ::: "memory");
        } else {
            XB_SPIN(xb_ld(&bar[XB_XGEN(b.x)]) == gen, bar);
            __builtin_amdgcn_fence(__ATOMIC_ACQUIRE, "agent");
            asm volatile("s_waitcnt vmcnt(0)" ::: "memory");
        }
    }
    __syncthreads();
}

struct Params { const float* in[23]; float* out; unsigned char* ws; int ph_lo, ph_hi; };
constexpr int LDS_BYTES = 147456;
constexpr int MISC_OFF = 131072 + 320;

struct Ctx {
    LAS unsigned char* lds; int tid, lane, wave, bid, G, gw, ngw;
    const float* const* in; float* xcur; unsigned char* ws;
};

__device__ __forceinline__ void ph_norm_bf16(const Ctx& c, const float* x, const float* g, bf16* out) {
    for (int row = c.gw; row < NT; row += c.ngw) {
        const f32x4* xr = (const f32x4*)(x + (size_t)row * D_) + c.lane;
        f32x4 v[4]; float ss = 0.f;
#pragma unroll
        for (int j = 0; j < 4; ++j) { v[j] = xr[64 * j]; ss += v[j].x * v[j].x + v[j].y * v[j].y + v[j].z * v[j].z + v[j].w * v[j].w; }
        const float r = rsqrtf(wave_sum(ss) * (1.f / D_) + EPS);
        u64* o8 = (u64*)(out + (size_t)row * D_) + c.lane;
#pragma unroll
        for (int j = 0; j < 4; ++j) { const f32x4 gg = ((const f32x4*)g)[c.lane + 64 * j];
            o8[64 * j] = (u64)pk2(v[j].x * r * gg.x, v[j].y * r * gg.y) | ((u64)pk2(v[j].z * r * gg.z, v[j].w * r * gg.w) << 32); }
    }
}
__device__ __forceinline__ void ph_norm_final(const Ctx& c, float* x, const float* g) {
    for (int row = c.gw; row < NT; row += c.ngw) {
        f32x4* xr = (f32x4*)(x + (size_t)row * D_) + c.lane;
        f32x4 v[4]; float ss = 0.f;
#pragma unroll
        for (int j = 0; j < 4; ++j) { v[j] = xr[64 * j]; ss += v[j].x * v[j].x + v[j].y * v[j].y + v[j].z * v[j].z + v[j].w * v[j].w; }
        const float r = rsqrtf(wave_sum(ss) * (1.f / D_) + EPS);
#pragma unroll
        for (int j = 0; j < 4; ++j) { const f32x4 gg = ((const f32x4*)g)[c.lane + 64 * j]; xr[64 * j] = v[j] * r * gg; }
    }
}

template <class AF, class EF>
__device__ __forceinline__ void naive_gemm(const Ctx& c, int M, int N, int K, AF af, const float* W, int ldb, EF ef) {
    LAS float* As = (LAS float*)c.lds;
    LAS float* Bs = As + 16 * 132;
    const int tm = (M + 127) / 128, tn = (N + 127) / 128, ntile = tm * tn;
    const int ty = c.tid >> 4, tx = c.tid & 15;
    for (int tile = c.bid; tile < ntile; tile += c.G) {
        const int m0 = (tile / tn) * 128, n0 = (tile % tn) * 128;
        float acc[4][8];
#pragma unroll
        for (int i = 0; i < 4; ++i)
#pragma unroll
            for (int j = 0; j < 8; ++j) acc[i][j] = 0.f;
        for (int k0 = 0; k0 < K; k0 += 16) {
            __syncthreads();
#pragma unroll
            for (int i = 0; i < 4; ++i) { const int e = c.tid + i * 512, r = e >> 4, kk = e & 15; const int row = m0 + r;
                As[kk * 132 + r] = (row < M) ? af(row, k0 + kk) : 0.f; }
#pragma unroll
            for (int i = 0; i < 4; ++i) { const int e = c.tid + i * 512, kk = e >> 7, cc = e & 127; const int col = n0 + cc;
                Bs[kk * 132 + cc] = (col < N) ? W[(size_t)(k0 + kk) * ldb + col] : 0.f; }
            __syncthreads();
#pragma unroll 2
            for (int kk = 0; kk < 16; ++kk) {
                float a[4], b[8];
#pragma unroll
                for (int i = 0; i < 4; ++i) a[i] = As[kk * 132 + ty * 4 + i];
#pragma unroll
                for (int j = 0; j < 8; ++j) b[j] = Bs[kk * 132 + tx * 8 + j];
#pragma unroll
                for (int i = 0; i < 4; ++i)
#pragma unroll
                    for (int j = 0; j < 8; ++j) acc[i][j] = fmaf(a[i], b[j], acc[i][j]);
            }
        }
        LAS float* Cs = Bs + 16 * 132;
        __syncthreads();
#pragma unroll
        for (int i = 0; i < 4; ++i)
#pragma unroll
            for (int j = 0; j < 8; ++j) Cs[(ty * 4 + i) * 129 + tx * 8 + j] = acc[i][j];
        __syncthreads();
#pragma unroll 1
        for (int e = c.tid; e < 128 * 128; e += NTHREADS) { const int r = e >> 7, cc = e & 127, row = m0 + r, col = n0 + cc; if (row < M && col < N) ef(row, col, Cs[r * 129 + cc]); }
    }
    __syncthreads();
}

struct InProjOut { bf16* qn; bf16* kv6; bf16* fqkv; bf16* dqk; bf16* dv; float* gate; float* fl; const float* b_gate; const float* b_fgt; };
__device__ __forceinline__ void inproj_store(const InProjOut& o, int n, int col, float v) {
    const int b = n / T_, t = n % T_;
    if (col < C_KV6) { const int h = col >> 6, d = col & 63; o.qn[((size_t)(b * 8 + h) * T_ + t) * 64 + d] = (bf16)f2bf(v * (0.125f * LOG2E)); }
    else if (col < C_GATE) { const int cc = col - C_KV6, idx = cc >> 7, g = (cc >> 6) & 1, d = cc & 63;
        ((bf16*)((unsigned char*)o.kv6 + idx * KV6_STRIDE))[((size_t)(b * 2 + g) * T_ + t) * 64 + d] = (bf16)f2bf(v); }
    else if (col < C_FQ) { const int j = col - C_GATE; o.gate[(size_t)n * 24 + j] = sigmoidf_(v + o.b_gate[j]); }
    else if (col < C_FF) { const int cc = col - C_FQ, idx = cc >> 8, h = (cc >> 6) & 3, d = cc & 63;
        o.fqkv[(size_t)idx * (8 * MiB) + ((size_t)(b * 4 + h) * T_ + t) * 64 + d] = (bf16)f2bf(idx == 0 ? v * (0.125f * LOG2E) : v); }
    else if (col < C_DQ) { const int h = col - C_FF; o.fl[(size_t)(b * 4 + h) * T_ + t] = log_sigmoidf_(v + o.b_fgt[h]); }
    else if (col < C_DV) { const int cc = col - C_DQ, idx = cc >> 8, h = (cc >> 6) & 3, i = (cc >> 5) & 1, d = cc & 31;
        o.dqk[(size_t)idx * (8 * MiB) + ((size_t)((b * 4 + h) * 2 + i) * T_ + t) * 32 + d] = (bf16)f2bf(idx == 0 ? v * (0.17677669529663687f * LOG2E) : v); }
    else { const int cc = col - C_DV, h = cc >> 6, d = cc & 63; o.dv[((size_t)(b * 4 + h) * T_ + t) * 64 + d] = (bf16)f2bf(v); }
}

__device__ __forceinline__ void ph_cumsum(const Ctx& c, float* fl) {
    for (int s = c.gw; s < B_ * 4; s += c.ngw) {
        float* p = fl + (size_t)s * T_; float carry = 0.f;
        for (int t0 = 0; t0 < T_; t0 += 64) {
            float v = p[t0 + c.lane];
#pragma unroll
            for (int o = 1; o < 64; o <<= 1) { const float u = __shfl_up(v, o); if (c.lane >= o) v += u; }
            v += carry; p[t0 + c.lane] = v; carry = __shfl(v, 63);
        }
    }
}

template <int DQK>
__device__ __forceinline__ float naive_attn_row(const bf16* q, const bf16* K, const bf16* V, int t, u64 mask, float slope2, const float* cum, int win, int lane) {
    float qv[DQK];
    { const u32x4* q4 = (const u32x4*)q;
#pragma unroll
      for (int i = 0; i < DQK / 8; ++i) { const u32x4 w = q4[i];
          qv[8 * i + 0] = __uint_as_float(w.x << 16); qv[8 * i + 1] = __uint_as_float(w.x & 0xffff0000u);
          qv[8 * i + 2] = __uint_as_float(w.y << 16); qv[8 * i + 3] = __uint_as_float(w.y & 0xffff0000u);
          qv[8 * i + 4] = __uint_as_float(w.z << 16); qv[8 * i + 5] = __uint_as_float(w.z & 0xffff0000u);
          qv[8 * i + 6] = __uint_as_float(w.w << 16); qv[8 * i + 7] = __uint_as_float(w.w & 0xffff0000u); } }
    const float cumt = cum ? cum[t] : 0.f;
    float m = -INFINITY, l = 0.f, o = 0.f;
    while (mask) {
        const int j = __builtin_ctzll(mask); mask &= mask - 1;
        const int kpos = 64 * j + lane; const int dist = t - kpos;
        const bool valid = dist >= 0 && dist < win;
        float s = 0.f;
        { const u32x4* k4 = (const u32x4*)(K + (size_t)kpos * DQK);
#pragma unroll
          for (int i = 0; i < DQK / 8; ++i) { const u32x4 w = k4[i];
              s = fmaf(qv[8 * i + 0], __uint_as_float(w.x << 16), s); s = fmaf(qv[8 * i + 1], __uint_as_float(w.x & 0xffff0000u), s);
              s = fmaf(qv[8 * i + 2], __uint_as_float(w.y << 16), s); s = fmaf(qv[8 * i + 3], __uint_as_float(w.y & 0xffff0000u), s);
              s = fmaf(qv[8 * i + 4], __uint_as_float(w.z << 16), s); s = fmaf(qv[8 * i + 5], __uint_as_float(w.z & 0xffff0000u), s);
              s = fmaf(qv[8 * i + 6], __uint_as_float(w.w << 16), s); s = fmaf(qv[8 * i + 7], __uint_as_float(w.w & 0xffff0000u), s); } }
        s -= slope2 * (float)dist;
        if (cum) s += (cumt - cum[kpos]) * LOG2E;
        s = valid ? s : -INFINITY;
        const float mb = wave_max(s);
        if (mb == -INFINITY) continue;
        const float mn = fmaxf(m, mb), alpha = exp2f(m - mn);
        const float p = valid ? exp2f(s - mn) : 0.f;
        l = l * alpha + wave_sum(p); o *= alpha; m = mn;
        const bf16* vb = V + (size_t)(64 * j) * 64 + lane;
#pragma unroll 8
        for (int k = 0; k < 64; ++k) o = fmaf(__shfl(p, k), bf2f(vb[(size_t)k * 64]), o);
    }
    return l > 0.f ? o / l : 0.f;
}

__device__ __forceinline__ void ph_cmp_attn(const Ctx& c, const bf16* qn, const bf16* kcmp, const bf16* vcmp, const float* gate, u64* sel, bf16* ocmp) {
    LAS float* pl = (LAS float*)(c.lds) + c.wave * 256;
    const int lane = c.lane;
    for (int it = c.gw; it < B_ * 2 * T_; it += c.ngw) {
        const int t = it % T_, bg = it / T_, b = bg >> 1, g = bg & 1;
        const int nvis = (t >= 31) ? ((t - 31) >> 4) + 1 : 0;
        const bf16* kc = kcmp + (size_t)bg * 256 * 64; const bf16* vc = vcmp + (size_t)bg * 256 * 64;
        float imp = 0.f;
        for (int hg = 0; hg < 4; ++hg) {
            const int h = g * 4 + hg; const float slope2 = alibi_slope(h + 1, 8) * LOG2E;
            const bf16* q = qn + ((size_t)(b * 8 + h) * T_ + t) * 64;
            float qv[64];
            { const u32x4* q4 = (const u32x4*)q;
#pragma unroll
              for (int i = 0; i < 8; ++i) { const u32x4 w = q4[i];
                  qv[8 * i + 0] = __uint_as_float(w.x << 16); qv[8 * i + 1] = __uint_as_float(w.x & 0xffff0000u);
                  qv[8 * i + 2] = __uint_as_float(w.y << 16); qv[8 * i + 3] = __uint_as_float(w.y & 0xffff0000u);
                  qv[8 * i + 4] = __uint_as_float(w.z << 16); qv[8 * i + 5] = __uint_as_float(w.z & 0xffff0000u);
                  qv[8 * i + 6] = __uint_as_float(w.w << 16); qv[8 * i + 7] = __uint_as_float(w.w & 0xffff0000u); } }
            float s[4]; float m = -INFINITY;
#pragma unroll
            for (int i = 0; i < 4; ++i) { const int cc = lane + 64 * i; float a = 0.f;
                if (cc < nvis) { const u32x4* k4 = (const u32x4*)(kc + (size_t)cc * 64);
#pragma unroll
                    for (int e = 0; e < 8; ++e) { const u32x4 w = k4[e];
                        a = fmaf(qv[8 * e + 0], __uint_as_float(w.x << 16), a); a = fmaf(qv[8 * e + 1], __uint_as_float(w.x & 0xffff0000u), a);
                        a = fmaf(qv[8 * e + 2], __uint_as_float(w.y << 16), a); a = fmaf(qv[8 * e + 3], __uint_as_float(w.y & 0xffff0000u), a);
                        a = fmaf(qv[8 * e + 4], __uint_as_float(w.z << 16), a); a = fmaf(qv[8 * e + 5], __uint_as_float(w.z & 0xffff0000u), a);
                        a = fmaf(qv[8 * e + 6], __uint_as_float(w.w << 16), a); a = fmaf(qv[8 * e + 7], __uint_as_float(w.w & 0xffff0000u), a); }
                    a -= slope2 * (float)(t - (16 * cc + 31)); } else a = -INFINITY;
                s[i] = a; m = fmaxf(m, a); }
            m = wave_max(m);
            float p[4], lsum = 0.f;
#pragma unroll
            for (int i = 0; i < 4; ++i) { p[i] = (lane + 64 * i < nvis) ? exp2f(s[i] - m) : 0.f; lsum += p[i]; }
            lsum = wave_sum(lsum);
            const float inv = lsum > 0.f ? 1.f / lsum : 0.f;
#pragma unroll
            for (int i = 0; i < 4; ++i) { p[i] *= inv; pl[lane + 64 * i] = p[i]; }
            asm volatile("s_waitcnt lgkmcnt(0)" ::: "memory");
            float o = 0.f;
            for (int cc = 0; cc < nvis; ++cc) o = fmaf(pl[cc], bf2f(vc[(size_t)cc * 64 + lane]), o);
            const float gt = gate[((size_t)(b * T_ + t)) * 24 + h * 3 + 0];
            ocmp[(size_t)(b * T_ + t) * 512 + h * 64 + lane] = (bf16)f2bf(gt * o);
            { const int j = lane; float a = pl[4 * j] + pl[4 * j + 1] + pl[4 * j + 2] + 0.5f * pl[4 * j + 3]; if (j > 0) a += 0.5f * pl[4 * j - 1]; imp += a; }
            asm volatile("s_waitcnt lgkmcnt(0)" ::: "memory");
        }
        const int cur = t >> 6; const int j = lane;
        u64 m64;
        if (cur <= 15) m64 = (cur == 63) ? ~0ull : ((1ull << (cur + 1)) - 1ull);
        else {
            float val = (j > cur) ? -INFINITY : ((j == 0 || j == cur || j == cur - 1) ? 1e4f : imp);
            m64 = 0ull;
            for (int r = 0; r < 16; ++r) {
                const float mx = wave_max(val);
                const u64 bal = __ballot(val == mx);
                const int w = __builtin_ctzll(bal);
                m64 |= 1ull << w; if (j == w) val = -INFINITY;
            }
        }
        if (lane == 0) sel[(size_t)bg * T_ + t] = m64;
    }
}

__device__ __forceinline__ void ph_win_attn(const Ctx& c, const bf16* qn, const bf16* kw, const bf16* vw, const float* gate, bf16* owin) {
    for (int it = c.gw; it < B_ * 8 * T_; it += c.ngw) {
        const int t = it % T_, bh = it / T_, b = bh >> 3, h = bh & 7, g = h >> 2;
        const int cur = t >> 6, jlo = (t - 511) > 0 ? (t - 511) >> 6 : 0;
        const u64 hi = (cur == 63) ? ~0ull : ((1ull << (cur + 1)) - 1ull); const u64 mask = hi & ~((1ull << jlo) - 1ull);
        const float o = naive_attn_row<64>(qn + ((size_t)bh * T_ + t) * 64, kw + (size_t)(b * 2 + g) * T_ * 64, vw + (size_t)(b * 2 + g) * T_ * 64, t, mask,
                                           alibi_slope(h + 1, 8) * LOG2E, nullptr, 512, c.lane);
        owin[(size_t)(b * T_ + t) * 512 + h * 64 + c.lane] = (bf16)f2bf(gate[(size_t)(b * T_ + t) * 24 + h * 3 + 2] * o);
    }
}
__device__ __forceinline__ void ph_slc_attn(const Ctx& c, const bf16* qn, const bf16* ks, const bf16* vs, const float* gate, const u64* sel, const bf16* ocmp, const bf16* owin, bf16* att) {
    for (int it = c.gw; it < B_ * 8 * T_; it += c.ngw) {
        const int t = it % T_, bh = it / T_, b = bh >> 3, h = bh & 7, g = h >> 2;
        const u64 mask = sel[(size_t)(b * 2 + g) * T_ + t];
        const float o = naive_attn_row<64>(qn + ((size_t)bh * T_ + t) * 64, ks + (size_t)(b * 2 + g) * T_ * 64, vs + (size_t)(b * 2 + g) * T_ * 64, t, mask,
                                           alibi_slope(h + 1, 8) * LOG2E, nullptr, 1 << 30, c.lane);
        const size_t n = (size_t)(b * T_ + t);
        const float r = gate[n * 24 + h * 3 + 1] * o + bf2f(ocmp[n * 512 + h * 64 + c.lane]) + bf2f(owin[n * 512 + h * 64 + c.lane]);
        att[n * 1024 + h * 64 + c.lane] = (bf16)f2bf(r);
    }
}
__device__ __forceinline__ void ph_fox_attn(const Ctx& c, const bf16* fq, const bf16* fk, const bf16* fv, const float* cum, bf16* att) {
    for (int it = c.gw; it < B_ * 4 * T_; it += c.ngw) {
        const int t = it % T_, bh = it / T_, b = bh >> 2, h = bh & 3;
        const int cur = t >> 6; const u64 mask = (cur == 63) ? ~0ull : ((1ull << (cur + 1)) - 1ull);
        const float o = naive_attn_row<64>(fq + ((size_t)bh * T_ + t) * 64, fk + (size_t)bh * T_ * 64, fv + (size_t)bh * T_ * 64, t, mask, 0.f, cum + (size_t)bh * T_, 1 << 30, c.lane);
        att[(size_t)(b * T_ + t) * 1024 + 512 + h * 64 + c.lane] = (bf16)f2bf(o);
    }
}
__device__ __forceinline__ void ph_diff_attn(const Ctx& c, const bf16* dq, const bf16* dk, const bf16* dv, const float* lam, const float* subln, float lambda_init, bf16* att) {
    float l1 = 0.f, l2 = 0.f;
    if (c.lane < 32) { l1 = lam[c.lane] * lam[32 + c.lane]; l2 = lam[64 + c.lane] * lam[96 + c.lane]; }
    const float lam_full = __expf(wave_sum(l1)) - __expf(wave_sum(l2)) + lambda_init;
    const float sg = subln[c.lane] * (1.f - lambda_init);
    for (int it = c.gw; it < B_ * 4 * T_; it += c.ngw) {
        const int t = it % T_, bh = it / T_, b = bh >> 2, h = bh & 3;
        const int cur = t >> 6; const u64 mask = (cur == 63) ? ~0ull : ((1ull << (cur + 1)) - 1ull);
        const float slope2 = alibi_slope(h + 1, 4) * LOG2E;
        const bf16* vb = dv + (size_t)bh * T_ * 64;
        const float o1 = naive_attn_row<32>(dq + ((size_t)(bh * 2 + 0) * T_ + t) * 32, dk + (size_t)(bh * 2 + 0) * T_ * 32, vb, t, mask, slope2, nullptr, 1 << 30, c.lane);
        const float o2 = naive_attn_row<32>(dq + ((size_t)(bh * 2 + 1) * T_ + t) * 32, dk + (size_t)(bh * 2 + 1) * T_ * 32, vb, t, mask, slope2, nullptr, 1 << 30, c.lane);
        const float o = o1 - lam_full * o2;
        const float r = rsqrtf(wave_sum(o * o) * (1.f / 64.f) + EPS);
        att[(size_t)(b * T_ + t) * 1024 + 768 + h * 64 + c.lane] = (bf16)f2bf(o * r * sg);
    }
}

__device__ __forceinline__ void ph_moe_route(const Ctx& c, const float* x, const float* g, const float* wgrp, const float* bgrp, const float* wexp, const float* bexp, bf16* hn, int* route_e, float* route_w) {
    for (int row = c.gw; row < NT; row += c.ngw) {
        const f32x4* xr = (const f32x4*)(x + (size_t)row * D_) + c.lane;
        f32x4 v[4]; float ss = 0.f;
#pragma unroll
        for (int j = 0; j < 4; ++j) { v[j] = xr[64 * j]; ss += v[j].x * v[j].x + v[j].y * v[j].y + v[j].z * v[j].z + v[j].w * v[j].w; }
        const float r = rsqrtf(wave_sum(ss) * (1.f / D_) + EPS);
        u64* o8 = (u64*)(hn + (size_t)row * D_) + c.lane;
#pragma unroll
        for (int j = 0; j < 4; ++j) { const f32x4 gg = ((const f32x4*)g)[c.lane + 64 * j]; v[j] = v[j] * r * gg;
            o8[64 * j] = (u64)pk2(v[j].x, v[j].y) | ((u64)pk2(v[j].z, v[j].w) << 32); }
        float gl[4];
#pragma unroll
        for (int q = 0; q < 4; ++q) { float a = 0.f;
#pragma unroll
            for (int j = 0; j < 4; ++j) { const int k = 4 * (c.lane + 64 * j);
                a = fmaf(v[j].x, wgrp[(size_t)(k + 0) * 4 + q], a); a = fmaf(v[j].y, wgrp[(size_t)(k + 1) * 4 + q], a);
                a = fmaf(v[j].z, wgrp[(size_t)(k + 2) * 4 + q], a); a = fmaf(v[j].w, wgrp[(size_t)(k + 3) * 4 + q], a); }
            gl[q] = wave_sum(a) + bgrp[q]; }
        int grp = 0; float gm = gl[0];
#pragma unroll
        for (int q = 1; q < 4; ++q) if (gl[q] > gm) { gm = gl[q]; grp = q; }
        float gs = 0.f;
#pragma unroll
        for (int q = 0; q < 4; ++q) gs += __expf(gl[q] - gm);
        const float grp_gate = 1.f / gs;
        float el[8];
#pragma unroll
        for (int q = 0; q < 8; ++q) { float a = 0.f; const int col = grp * 8 + q;
#pragma unroll
            for (int j = 0; j < 4; ++j) { const int k = 4 * (c.lane + 64 * j);
                a = fmaf(v[j].x, wexp[(size_t)(k + 0) * 32 + col], a); a = fmaf(v[j].y, wexp[(size_t)(k + 1) * 32 + col], a);
                a = fmaf(v[j].z, wexp[(size_t)(k + 2) * 32 + col], a); a = fmaf(v[j].w, wexp[(size_t)(k + 3) * 32 + col], a); }
            el[q] = wave_sum(a) + bexp[col]; }
        int i0 = 0; float v0 = el[0];
#pragma unroll
        for (int q = 1; q < 8; ++q) if (el[q] > v0) { v0 = el[q]; i0 = q; }
        int i1 = -1; float v1 = -INFINITY;
#pragma unroll
        for (int q = 0; q < 8; ++q) if (q != i0 && el[q] > v1) { v1 = el[q]; i1 = q; }
        const float e1 = __expf(v1 - v0), den = 1.f + e1;
        if (c.lane == 0) { route_e[2 * row] = grp * 8 + i0; route_e[2 * row + 1] = grp * 8 + i1; route_w[2 * row] = grp_gate / den; route_w[2 * row + 1] = grp_gate * e1 / den; }
    }
}
__device__ __forceinline__ void ph_moe_naive(const Ctx& c, const bf16* hn, const int* route_e, const float* route_w, const float* wg, const float* wu, const float* wd, float* x) {
    LAS float* hs = (LAS float*)c.lds;
    LAS float* au = hs + 1024;
    LAS float* h2 = au + 512;
    for (int row = c.bid; row < NT; row += c.G) {
        __syncthreads();
        hs[c.tid] = bf2f(hn[(size_t)row * D_ + c.tid]); hs[c.tid + 512] = bf2f(hn[(size_t)row * D_ + c.tid + 512]);
        float o0 = 0.f, o1 = 0.f;
        for (int s = 0; s < 2; ++s) {
            const int e = route_e[2 * row + s]; const float w = route_w[2 * row + s];
            __syncthreads();
            const float* W = (c.tid < 256 ? wg : wu) + (size_t)e * D_ * DEXP + (c.tid & 255);
            float a = 0.f;
            for (int k = 0; k < D_; ++k) a = fmaf(hs[k], W[(size_t)k * DEXP], a);
            au[c.tid] = a;
            __syncthreads();
            if (c.tid < 256) { const float ga = au[c.tid], up = au[c.tid + 256]; h2[c.tid] = ga / (1.f + __expf(-ga)) * up * w; }
            __syncthreads();
            const float* Wd = wd + (size_t)e * DEXP * D_;
            for (int k = 0; k < DEXP; ++k) { const float hv = h2[k]; o0 = fmaf(hv, Wd[(size_t)k * D_ + c.tid], o0); o1 = fmaf(hv, Wd[(size_t)k * D_ + c.tid + 512], o1); }
        }
        x[(size_t)row * D_ + c.tid] += o0; x[(size_t)row * D_ + c.tid + 512] += o1;
    }
    __syncthreads();
}

typedef __attribute__((address_space(4))) const Params* KP;
constexpr int PH_PER_LAYER = 9, N_PHASES = L_ * PH_PER_LAYER + 1;
extern __shared__ __attribute__((aligned(16))) unsigned char lds_raw[];
__device__ __forceinline__ Ctx make_ctx(KP p) {
    Ctx c; c.lds = (LAS unsigned char*)lds_raw; c.tid = threadIdx.x; c.lane = c.tid & 63; c.wave = __builtin_amdgcn_readfirstlane(c.tid >> 6);
    c.bid = blockIdx.x; c.G = gridDim.x; c.gw = c.bid * NWAVES + c.wave; c.ngw = c.G * NWAVES; c.in = nullptr; c.xcur = p->out; c.ws = p->ws;
    return c;
}
struct Bufs {
    bf16 *QN, *KV6, *KC, *VC, *KS, *VS, *KW, *VW, *FQ, *FK, *FV, *DQ, *DK, *DV, *HC, *KCMP, *VCMP, *OCMP, *OWIN, *HN, *ATT;
    float *GATE, *FL, *ROUTE_W; u64* SEL; int* ROUTE_E;
};
__device__ __forceinline__ Bufs make_bufs(unsigned char* ws) {
    Bufs b;
    b.QN = (bf16*)(ws + WS_QN); b.KV6 = (bf16*)(ws + WS_KV6);
    b.KC = (bf16*)(ws + WS_KV6 + 0 * KV6_STRIDE); b.VC = (bf16*)(ws + WS_KV6 + 1 * KV6_STRIDE);
    b.KS = (bf16*)(ws + WS_KV6 + 2 * KV6_STRIDE); b.VS = (bf16*)(ws + WS_KV6 + 3 * KV6_STRIDE);
    b.KW = (bf16*)(ws + WS_KV6 + 4 * KV6_STRIDE); b.VW = (bf16*)(ws + WS_KV6 + 5 * KV6_STRIDE);
    b.FQ = (bf16*)(ws + WS_FQKV); b.FK = b.FQ + 8 * MiB; b.FV = b.FQ + 16 * MiB;
    b.DQ = (bf16*)(ws + WS_DQK); b.DK = b.DQ + 8 * MiB; b.DV = (bf16*)(ws + WS_DV);
    b.GATE = (float*)(ws + WS_GATE); b.FL = (float*)(ws + WS_FL);
    b.HC = (bf16*)(ws + WS_HC); b.KCMP = (bf16*)(ws + WS_KVCMP); b.VCMP = b.KCMP + 16 * 256 * 64;
    b.SEL = (u64*)(ws + WS_SEL); b.OCMP = (bf16*)(ws + WS_OCMP); b.OWIN = (bf16*)(ws + WS_OWIN);
    b.HN = (bf16*)(ws + WS_HN); b.ATT = (bf16*)(ws + WS_ATT);
    b.ROUTE_E = (int*)(ws + WS_ROUTE); b.ROUTE_W = (float*)(ws + WS_ROUTE + 512 * 1024);
    return b;
}
__device__ __forceinline__ float lambda_init_of(int l) { return 0.8f - 0.6f * expf(-0.3f * (float)l); }

__device__ __noinline__ void P_norm1(KP p, int l) { const Ctx c = make_ctx(p); const Bufs b = make_bufs(p->ws);
    ph_norm_bf16(c, (l == 0) ? p->in[0] : p->out, p->in[1] + (size_t)l * D_, b.HN); }
__device__ __noinline__ void P_inproj(KP p, int l) { const Ctx c = make_ctx(p); const Bufs b = make_bufs(p->ws);
    InProjOut o{b.QN, b.KV6, b.FQ, b.DQ, b.DV, b.GATE, b.FL, p->in[3] + l * 24, p->in[4] + l * 4};
    const bf16* A = b.HN;
    naive_gemm(c, NT, D_IN, D_, [=](int r, int k) { return bf2f(A[(size_t)r * D_ + k]); }, p->in[2] + (size_t)l * D_ * D_IN, D_IN,
               [=](int r, int col, float v) { inproj_store(o, r, col, v); }); }
__device__ __noinline__ void P_cmp1(KP p, int l, int kv) { const Ctx c = make_ctx(p); const Bufs b = make_bufs(p->ws);
    const bf16* src = kv == 0 ? b.KC : b.VC; const float* pe = p->in[kv == 0 ? 5 : 8] + (size_t)l * 2048; bf16* hc = b.HC + (size_t)kv * 4096 * 256;
    naive_gemm(c, 4096, 256, 2048, [=](int r, int k) { return bf2f(src[(size_t)r * 1024 + k]) + pe[k]; }, p->in[kv == 0 ? 6 : 9] + (size_t)l * 2048 * 256, 256,
               [=](int r, int col, float v) { hc[(size_t)r * 256 + col] = (bf16)f2bf(gelu_tanh(v)); }); }
__device__ __noinline__ void P_cumsum(KP p, int l) { const Ctx c = make_ctx(p); const Bufs b = make_bufs(p->ws); ph_cumsum(c, b.FL); }
__device__ __noinline__ void P_cmp2(KP p, int l, int kv) { const Ctx c = make_ctx(p); const Bufs b = make_bufs(p->ws);
    const bf16* hc = b.HC + (size_t)kv * 4096 * 256; bf16* dst = kv == 0 ? b.KCMP : b.VCMP;
    naive_gemm(c, 4096, 64, 256, [=](int r, int k) { return bf2f(hc[(size_t)r * 256 + k]); }, p->in[kv == 0 ? 7 : 10] + (size_t)l * 256 * 64, 64,
               [=](int r, int col, float v) { dst[(size_t)r * 64 + col] = (bf16)f2bf((r & 255) == 255 ? 0.f : v); }); }
__device__ __noinline__ void P_win(KP p, int l) { const Ctx c = make_ctx(p); const Bufs b = make_bufs(p->ws); ph_win_attn(c, b.QN, b.KW, b.VW, b.GATE, b.OWIN); }
__device__ __noinline__ void P_fox(KP p, int l) { const Ctx c = make_ctx(p); const Bufs b = make_bufs(p->ws); ph_fox_attn(c, b.FQ, b.FK, b.FV, b.FL, b.ATT); }
__device__ __noinline__ void P_diff(KP p, int l) { const Ctx c = make_ctx(p); const Bufs b = make_bufs(p->ws);
    ph_diff_attn(c, b.DQ, b.DK, b.DV, p->in[11] + (size_t)l * 128, p->in[12] + (size_t)l * 64, lambda_init_of(l), b.ATT); }
__device__ __noinline__ void P_cmpattn(KP p, int l) { const Ctx c = make_ctx(p); const Bufs b = make_bufs(p->ws); ph_cmp_attn(c, b.QN, b.KCMP, b.VCMP, b.GATE, b.SEL, b.OCMP); }
__device__ __noinline__ void P_slc(KP p, int l) { const Ctx c = make_ctx(p); const Bufs b = make_bufs(p->ws); ph_slc_attn(c, b.QN, b.KS, b.VS, b.GATE, b.SEL, b.OCMP, b.OWIN, b.ATT); }
__device__ __noinline__ void P_outproj(KP p, int l) { const Ctx c = make_ctx(p); const Bufs b = make_bufs(p->ws);
    const bf16* A = b.ATT; float* xo = p->out; const float* xin = (l == 0) ? p->in[0] : p->out;
    naive_gemm(c, NT, D_, D_, [=](int r, int k) { return bf2f(A[(size_t)r * D_ + k]); }, p->in[13] + (size_t)l * D_ * D_, D_,
               [=](int r, int col, float v) { xo[(size_t)r * D_ + col] = xin[(size_t)r * D_ + col] + v; }); }
__device__ __noinline__ void P_route(KP p, int l) { const Ctx c = make_ctx(p); const Bufs b = make_bufs(p->ws);
    ph_moe_route(c, p->out, p->in[14] + (size_t)l * D_, p->in[15] + (size_t)l * D_ * 4, p->in[16] + l * 4, p->in[17] + (size_t)l * D_ * 32, p->in[18] + l * 32, b.HN, b.ROUTE_E, b.ROUTE_W); }
__device__ __noinline__ void P_moe(KP p, int l) { const Ctx c = make_ctx(p); const Bufs b = make_bufs(p->ws);
    ph_moe_naive(c, b.HN, b.ROUTE_E, b.ROUTE_W, p->in[19] + (size_t)l * NEXP * D_ * DEXP, p->in[20] + (size_t)l * NEXP * D_ * DEXP, p->in[21] + (size_t)l * NEXP * DEXP * D_, p->out); }
__device__ __noinline__ void P_final(KP p) { const Ctx c = make_ctx(p); ph_norm_final(c, p->out, p->in[22]); }
__device__ __noinline__ void P_gridbar(KP p) {
    XcdBarrier bar; bar.bar = (unsigned*)(p->ws + WS_CTL) + 4096; bar.x = xb_xcc_id(); bar.st = (volatile LAS unsigned*)((LAS unsigned char*)lds_raw + MISC_OFF) + 8;
    xcd_barrier(bar);
}

__global__ void __launch_bounds__(NTHREADS, 2) fwd_kernel(Params pp) {
    const KP p = (KP)__builtin_amdgcn_kernarg_segment_ptr();
    { volatile LAS unsigned* MISC = (volatile LAS unsigned*)((LAS unsigned char*)lds_raw + MISC_OFF); if (threadIdx.x < 32) MISC[threadIdx.x] = 0u; }
    __syncthreads();
    const int lo = p->ph_lo, hi = p->ph_hi;
    if (hi - lo > 1) (void)xcd_barrier_post((unsigned*)(p->ws + WS_CTL) + 4096, (volatile LAS unsigned*)((LAS unsigned char*)lds_raw + MISC_OFF) + 8);
#define IN(k) (lo <= (k) && (k) < hi)
#define SEAM(k) do { if (IN(k) && IN((k) + 1)) P_gridbar(p); } while (0)
    for (int l = 0; l < L_; ++l) {
        const int P0 = l * PH_PER_LAYER;
        if (IN(P0 + 0)) P_norm1(p, l);
        SEAM(P0 + 0);
        if (IN(P0 + 1)) P_inproj(p, l);
        SEAM(P0 + 1);
        if (IN(P0 + 2)) { P_cmp1(p, l, 0); P_cmp1(p, l, 1); P_cumsum(p, l); }
        SEAM(P0 + 2);
        if (IN(P0 + 3)) { P_cmp2(p, l, 0); P_cmp2(p, l, 1); P_win(p, l); P_fox(p, l); P_diff(p, l); }
        SEAM(P0 + 3);
        if (IN(P0 + 4)) P_cmpattn(p, l);
        SEAM(P0 + 4);
        if (IN(P0 + 5)) P_slc(p, l);
        SEAM(P0 + 5);
        if (IN(P0 + 6)) P_outproj(p, l);
        SEAM(P0 + 6);
        if (IN(P0 + 7)) P_route(p, l);
        SEAM(P0 + 7);
        if (IN(P0 + 8)) P_moe(p, l);
        SEAM(P0 + 8);
    }
    if (IN(L_ * PH_PER_LAYER)) P_final(p);
#undef IN
#undef SEAM
}

extern "C" void kernel_launch(void* const* d_in, const int* in_sizes, int n_in, void* d_out, int out_size, void* d_ws, size_t ws_size, hipStream_t stream) {
    static int grid = 0;
    if (grid == 0) {
        if (n_in != 23 || out_size != NT * D_ || ws_size < WS_END) { fprintf(stderr, "kernel_launch: unexpected sizes n_in %d out %d ws %zu (need %zu)\n", n_in, out_size, ws_size, (size_t)WS_END); grid = -1; return; }
        int dev = 0, cus = 0, per_cu = 0;
        if (hipGetDevice(&dev) != hipSuccess || hipDeviceGetAttribute(&cus, hipDeviceAttributeMultiprocessorCount, dev) != hipSuccess) { grid = -1; return; }
        if (hipFuncSetAttribute((const void*)fwd_kernel, hipFuncAttributeMaxDynamicSharedMemorySize, LDS_BYTES) != hipSuccess) { fprintf(stderr, "kernel_launch: hipFuncSetAttribute failed\n"); grid = -1; return; }
        if (hipOccupancyMaxActiveBlocksPerMultiprocessor(&per_cu, (const void*)fwd_kernel, NTHREADS, LDS_BYTES) != hipSuccess || per_cu < 1) { fprintf(stderr, "kernel_launch: occupancy query says %d\n", per_cu); }
        (void)hipGetLastError();
        grid = cus;
    }
    if (grid < 0) return;
    (void)hipMemsetAsync((char*)d_ws + WS_CTL, 0, CTL_BYTES, stream);
    Params p{};
    for (int i = 0; i < 23; ++i) p.in[i] = (const float*)d_in[i];
    p.out = (float*)d_out; p.ws = (unsigned char*)d_ws;
#if N_LAUNCH_MODE == 0
    p.ph_lo = 0; p.ph_hi = N_PHASES;
    hipLaunchKernelGGL(fwd_kernel, dim3(grid), dim3(NTHREADS), LDS_BYTES, stream, p);
#else
    for (int k = 0; k < N_PHASES; ++k) { p.ph_lo = k; p.ph_hi = k + 1; hipLaunchKernelGGL(fwd_kernel, dim3(grid), dim3(NTHREADS), LDS_BYTES, stream, p); }
#endif
}
```

```cpp
#include <hip/hip_runtime.h>
#include <cstdio>
#include <cstdint>

#ifndef N_LAUNCH_MODE
#define N_LAUNCH_MODE 0
#endif

#define LAS __attribute__((address_space(3)))
#define GAS __attribute__((address_space(1)))
typedef unsigned short bf16;
typedef unsigned long long u64;
typedef float f32x4 __attribute__((ext_vector_type(4)));
typedef unsigned u32x4 __attribute__((ext_vector_type(4)));

constexpr int B_ = 8, T_ = 4096, D_ = 1024, NT = B_ * T_, L_ = 2;
constexpr int HD = 64, D_IN = 2844;
constexpr int N_CMP = 255, CMP_HID = 256;
constexpr int NEXP = 32, DEXP = 256;
constexpr float EPS = 1e-6f;
constexpr float LOG2E = 1.4426950408889634f;
constexpr int NWAVES = 8, NTHREADS = 512;

constexpr int C_NSAQ = 0, C_KV6 = 512, C_GATE = 1280, C_FQ = 1304, C_FF = 2072, C_DQ = 2076, C_DV = 2588;

constexpr size_t MiB = 1u << 20;
constexpr size_t WS_CTL = 0, CTL_BYTES = 1 * MiB;
constexpr size_t WS_QN = 1 * MiB;
constexpr size_t WS_KV6 = WS_QN + 32 * MiB;
constexpr size_t KV6_STRIDE = 8 * MiB + 64 * 1024;
constexpr size_t WS_FQKV = WS_KV6 + 6 * KV6_STRIDE;
constexpr size_t WS_DQK = WS_FQKV + 48 * MiB;
constexpr size_t WS_DV = WS_DQK + 32 * MiB;
constexpr size_t WS_GATE = WS_DV + 16 * MiB;
constexpr size_t WS_FL = WS_GATE + 3 * MiB;
constexpr size_t WS_HC = WS_FL + 1 * MiB;
constexpr size_t WS_KVCMP = WS_HC + 4 * MiB;
constexpr size_t WS_SEL = WS_KVCMP + 1 * MiB;
constexpr size_t WS_OCMP = WS_SEL + 1 * MiB;
constexpr size_t WS_OWIN = WS_OCMP + 32 * MiB;
constexpr size_t WS_HN = WS_OWIN + 32 * MiB;
constexpr size_t WS_ATT = WS_HN + 64 * MiB;
constexpr size_t WS_ROUTE = WS_ATT + 64 * MiB;
constexpr size_t WS_WIN_T = WS_ROUTE + 1 * MiB;
constexpr size_t WS_WOUT_T = WS_WIN_T + 12 * MiB;
constexpr size_t WS_WGU_T = WS_WOUT_T + 4 * MiB;
constexpr size_t WS_WD_T = WS_WGU_T + 64 * MiB;
constexpr size_t WS_W1_T = WS_WD_T + 32 * MiB;
constexpr size_t WS_W2_T = WS_W1_T + 4 * MiB;
constexpr size_t WS_BIAS1 = WS_W2_T + 512 * 1024;
constexpr size_t WS_END = WS_BIAS1 + 512 * 1024;
constexpr int NIN = 3072;

__device__ __forceinline__ float bf2f(bf16 v) { return __uint_as_float(((unsigned)v) << 16); }
__device__ __forceinline__ unsigned f2bf(float f) { unsigned u = __float_as_uint(f); return (u + 0x7fffu + ((u >> 16) & 1u)) >> 16; }
__device__ __forceinline__ unsigned pk2(float lo, float hi) { return f2bf(lo) | (f2bf(hi) << 16); }
__device__ __forceinline__ float wave_sum(float v) {
#pragma unroll
    for (int o = 1; o < 64; o <<= 1) v += __shfl_xor(v, o);
    return v;
}
__device__ __forceinline__ float wave_max(float v) {
#pragma unroll
    for (int o = 1; o < 64; o <<= 1) v = fmaxf(v, __shfl_xor(v, o));
    return v;
}
__device__ __forceinline__ float sigmoidf_(float x) { return 1.f / (1.f + __expf(-x)); }
__device__ __forceinline__ float log_sigmoidf_(float x) { return x >= 0.f ? -log1pf(__expf(-x)) : x - log1pf(__expf(x)); }
__device__ __forceinline__ float gelu_tanh(float x) { const float u = 0.7978845608028654f * (x + 0.044715f * x * x * x); return 0.5f * x * (1.f + tanhf(u)); }
__device__ __forceinline__ float alibi_slope(int idx1, int n) { return exp2f(-8.0f * (float)idx1 / (float)n); }

#define XB_TMO      128
#define XB_XCNT(j)  (256  + 64 * (j))
#define XB_XSUB(j)  (1280 + 64 * (j))
#define XB_XGEN(j)  (2304 + 64 * (j))
#define XB_TOP      3328
#define XB_TOPGEN   3392
#define XCD_BAR_WORDS 3456
#define XB_SPIN_CAP (1u << 25)
__device__ __forceinline__ unsigned xb_ld(unsigned* p)              { return __hip_atomic_load(p, __ATOMIC_RELAXED, __HIP_MEMORY_SCOPE_AGENT); }
__device__ __forceinline__ unsigned xb_add(unsigned* p, unsigned v) { return __hip_atomic_fetch_add(p, v, __ATOMIC_RELAXED, __HIP_MEMORY_SCOPE_AGENT); }
__device__ __forceinline__ unsigned xb_xcc_id() { return (unsigned)__builtin_amdgcn_s_getreg((3 << 11) | 20) & 0xFu; }
#define XB_SPIN(cond, bar) do { unsigned _sp = 0; while (cond) { __builtin_amdgcn_s_sleep(1); \
    if ((++_sp & 255u) == 0u) { if (xb_ld(&(bar)[XB_TMO])) break; if (_sp > XB_SPIN_CAP) { atomicAdd(&(bar)[XB_TMO], 1u); break; } } } } while (0)
struct XcdBarrier { unsigned* bar; unsigned x; volatile LAS unsigned* st; };
__device__ __forceinline__ XcdBarrier xcd_barrier_post(unsigned* bar, volatile LAS unsigned* st) {
    XcdBarrier b; b.bar = bar; b.x = xb_xcc_id(); b.st = st;
    if (threadIdx.x == 0) (void)xb_add(&bar[XB_XCNT(b.x)], 1u);
    return b;
}
__device__ __forceinline__ void xcd_barrier_complete(unsigned* bar, unsigned x, unsigned& nloc, unsigned& nx) {
    const unsigned G = gridDim.x * gridDim.y * gridDim.z;
    unsigned sum, cnt, mine, sp = 0u;
    for (;;) {
        sum = 0u; cnt = 0u; mine = 0u;
#pragma unroll
        for (unsigned j = 0; j < 16; ++j) { const unsigned c = xb_ld(&bar[XB_XCNT(j)]); sum += c; cnt += (c > 0u) ? 1u : 0u; mine = (j == x) ? c : mine; }
        if (sum == G) break;
        __builtin_amdgcn_s_sleep(1);
        if ((++sp & 255u) == 0u) { if (xb_ld(&bar[XB_TMO])) break; if (sp > XB_SPIN_CAP) { atomicAdd(&bar[XB_TMO], 1u); break; } }
    }
    nloc = mine > 0u ? mine : 1u; nx = cnt > 0u ? cnt : 1u;
}
__device__ __forceinline__ void xcd_barrier(const XcdBarrier& b) {
    asm volatile("s_waitcnt vmcnt(0)" ::: "memory");
    __syncthreads();
    if (threadIdx.x == 0) {
        unsigned* bar = b.bar;
        __builtin_amdgcn_s_waitcnt(0);
        unsigned nloc = b.st[0], nx = b.st[1];
        if (nloc == 0u) { xcd_barrier_complete(bar, b.x, nloc, nx); b.st[0] = nloc; b.st[1] = nx; }
        const unsigned old = xb_add(&bar[XB_XSUB(b.x)], 1u);
        const unsigned gen = old / nloc;
        if (old + 1u == (gen + 1u) * nloc) {
            __builtin_amdgcn_fence(__ATOMIC_RELEASE, "agent");
            asm volatile("s_waitcnt vmcnt(0)" ::: "memory");
            const unsigned og = xb_add(&bar[XB_TOP], 1u);
            const unsigned tg = og / nx;
            if (og + 1u == (tg + 1u) * nx) xb_add(&bar[XB_TOPGEN], 1u);
            else XB_SPIN(xb_ld(&bar[XB_TOPGEN]) == tg, bar);
            __builtin_amdgcn_fence(__ATOMIC_ACQUIRE, "agent");
            xb_add(&bar[XB_XGEN(b.x)], 1u);
            asm volatile("s_waitcnt vmcnt(0)" ::: "memory");
        } else {
            XB_SPIN(xb_ld(&bar[XB_XGEN(b.x)]) == gen, bar);
            __builtin_amdgcn_fence(__ATOMIC_ACQUIRE, "agent");
            asm volatile("s_waitcnt vmcnt(0)" ::: "memory");
        }
    }
    __syncthreads();
}

struct Params { const float* in[23]; float* out; unsigned char* ws; int ph_lo, ph_hi; };
constexpr int LDS_BYTES = 147456;
constexpr int MISC_OFF = 131072 + 320;

struct Ctx {
    LAS unsigned char* lds; int tid, lane, wave, bid, G, gw, ngw;
    const float* const* in; float* xcur; unsigned char* ws;
};

namespace pg8 {
#define PG8_LAS __attribute__((address_space(3)))
typedef unsigned short bf16_t;
typedef short bf16x8 __attribute__((ext_vector_type(8)));
typedef float f32x4 __attribute__((ext_vector_type(4)));
typedef unsigned u32x4 __attribute__((ext_vector_type(4)));
constexpr int BM = 256, BK = 64, HALF = 128, HTB = HALF * BK * 2  , STAGE_BYTES = 8 * HTB, NXCD = 8, WGM = 8;

__host__ __device__ __forceinline__ int lds_byte(int r, int c) { const int st = (r >> 4) * 2 + (c >> 5), rr = r & 15, cc = c & 31, ob = rr * 64 + cc * 2; return st * 1024 + (ob ^ (((ob >> 9) & 1) << 5)); }
__host__ __device__ __forceinline__ void stage_rc(int b, int& R, int& C) { const int st = b / 1024, sb = b % 1024, swz = sb ^ (((sb >> 9) & 1) << 5); R = (st >> 1) * 16 + swz / 64; C = (st & 1) * 32 + (swz % 64) / 2; }
__host__ __device__ __forceinline__ int perm32(int rho) { const int n = rho >> 4, i = rho & 15; return 8 * (i >> 2) + 4 * n + (i & 3); }

struct Unit { int pm, pn; const char* a; const char* b; const char* b2; };
struct Gemm { int lda, ldb, K, ksplit; };

__device__ __forceinline__ unsigned cvt_pk_bf16(float lo, float hi) { unsigned r; asm volatile("v_cvt_pk_bf16_f32 %0, %1, %2" : "=v"(r) : "v"(lo), "v"(hi)); return r; }
typedef float f32x2 __attribute__((ext_vector_type(2)));

template <class Epi, class Sched, bool ALIGN_EPI = false, bool SP2 = false>
__device__ __forceinline__ void gemm_phase(PG8_LAS unsigned char* lds, const Gemm g, const Sched& S, const Epi& E) {
    int tid_ = threadIdx.x; asm volatile("" : "+v"(tid_));
    const int tid = tid_, wid = __builtin_amdgcn_readfirstlane(tid >> 6), lane = tid & 63, wr = wid >> 2, wc = wid & 3, fr = lane & 15, fq = lane >> 4;
    const int K = g.K, nt = K / BK, ks = g.ksplit;
    unsigned voffA[2], voffB[2];
#pragma unroll
    for (int i = 0; i < 2; ++i) { int R, C; stage_rc(tid * 16 + i * 8192, R, C); const int Rb = Epi::PERM ? ((R & ~31) + perm32(R & 31)) : R;
        voffA[i] = (unsigned)(R * g.lda + C) * 2u; voffB[i] = (unsigned)(Rb * g.ldb + C) * 2u; }
    const size_t kstep = (size_t)(BK * 2);
    const size_t hsA = (size_t)HALF * g.lda * 2, hsB = (size_t)HALF * g.ldb * 2;
    const unsigned ldsw = (unsigned)wid * 1024u;
    const int aoff = lds_byte(wr * 64 + fr, fq * 8), boff = lds_byte(wc * 32 + fr, fq * 8);
#define PG8_SA(b, h) (((b) * 2 + (h)) * HTB)
#define PG8_SB(b, h) ((4 + (b) * 2 + (h)) * HTB)
#define PG8_STAGE(bufoff, gbase, voff) do { _Pragma("unroll") for (int _i = 0; _i < 2; ++_i) \
        __builtin_amdgcn_global_load_lds((const unsigned*)((const char*)(gbase) + (voff)[_i]), (PG8_LAS unsigned*)(lds + (bufoff) + ldsw + _i * 8192), 16, 0, 0); } while (0)
#define PG8_LDA(dst, b, h) do { _Pragma("unroll") for (int m = 0; m < 4; ++m) _Pragma("unroll") for (int k = 0; k < 2; ++k) dst[m][k] = *(const PG8_LAS bf16x8*)(lds + PG8_SA(b, h) + aoff + m * 2048 + k * 1024); } while (0)
#define PG8_LDB(dst, b, h) do { _Pragma("unroll") for (int n = 0; n < 2; ++n) _Pragma("unroll") for (int k = 0; k < 2; ++k) dst[n][k] = *(const PG8_LAS bf16x8*)(lds + PG8_SB(b, h) + boff + n * 2048 + k * 1024); } while (0)
#define PG8_MMA(ai, bj, At, Bt) do { __builtin_amdgcn_s_setprio(1); _Pragma("unroll") for (int m = 0; m < 4; ++m) _Pragma("unroll") for (int n = 0; n < 2; ++n) _Pragma("unroll") for (int k = 0; k < 2; ++k) \
        acc[ai][bj][m][n] = __builtin_amdgcn_mfma_f32_16x16x32_bf16(Bt[n][k], At[m][k], acc[ai][bj][m][n], 0, 0, 0); __builtin_amdgcn_s_setprio(0); } while (0)
#define PG8_WAIT_V(n) asm volatile("s_waitcnt vmcnt(" #n ")" ::: "memory")
#define PG8_WAIT_L(n) asm volatile("s_waitcnt lgkmcnt(" #n ")" ::: "memory")
#define PG8_BAR __builtin_amdgcn_s_barrier()
#define PG8_SCHED __builtin_amdgcn_sched_barrier(0)
    Unit cur, nxt; int ui = 0;
    if (!S.next(0, cur)) return;
    f32x4 acc[2][2][4][2];
#pragma unroll
    for (int a = 0; a < 2; ++a)
#pragma unroll
        for (int b = 0; b < 2; ++b)
#pragma unroll
            for (int m = 0; m < 4; ++m)
#pragma unroll
                for (int n = 0; n < 2; ++n) acc[a][b][m][n] = (f32x4){0.f, 0.f, 0.f, 0.f};
    bf16x8 At[4][2], B0[2][2], B1[2][2];
    const char* cA = cur.a; const char* cB = cur.b; const char* cB2 = cur.b2;
#define PG8_BK(base, base2, kt) ((kt) < ks ? (base) + (size_t)(kt) * kstep : (base2) + (size_t)((kt) - ks) * kstep)
    S.a_ready(cur);
    if constexpr (SP2) {
        PG8_STAGE(PG8_SB(0, 0), cB, voffB); PG8_STAGE(PG8_SB(0, 1), cB + hsB, voffB); PG8_STAGE(PG8_SA(0, 0), cA, voffA); PG8_STAGE(PG8_SA(0, 1), cA + hsA, voffA);
        if (wr == 1) PG8_BAR;
        PG8_WAIT_V(2); PG8_BAR;
        PG8_STAGE(PG8_SB(1, 0), PG8_BK(cB, cB2, 1), voffB); PG8_STAGE(PG8_SA(1, 0), cA + kstep, voffA); PG8_STAGE(PG8_SB(1, 1), PG8_BK(cB, cB2, 1) + hsB, voffB);
        PG8_WAIT_V(6); PG8_BAR;
    } else {
        PG8_STAGE(PG8_SB(0, 0), cB, voffB); PG8_STAGE(PG8_SA(0, 0), cA, voffA); PG8_STAGE(PG8_SB(0, 1), cB + hsB, voffB); PG8_STAGE(PG8_SA(0, 1), cA + hsA, voffA);
        if (wr == 1) PG8_BAR;
        PG8_WAIT_V(4); PG8_BAR;
        PG8_STAGE(PG8_SB(1, 0), PG8_BK(cB, cB2, 1), voffB); PG8_STAGE(PG8_SA(1, 0), cA + kstep, voffA); PG8_STAGE(PG8_SB(1, 1), PG8_BK(cB, cB2, 1) + hsB, voffB);
        PG8_WAIT_V(6); PG8_BAR;
    }
    for (;;) {
        const bool has_next = S.next(ui + 1, nxt);
        const char* nA = has_next ? nxt.a : cA; const char* nB = has_next ? nxt.b : cB; const char* nB2 = has_next ? nxt.b2 : cB2;
        for (int t = 0; t < nt; t += 2) {
            const bool last = (t == nt - 2);
            const char* a1 = cA + (size_t)(t + 1) * kstep;
            const char* a2 = last ? nA : cA + (size_t)(t + 2) * kstep; const char* b2 = last ? PG8_BK(nB, nB2, 0) : PG8_BK(cB, cB2, t + 2);
            const char* a3 = a2 + kstep; const char* b3 = last ? PG8_BK(nB, nB2, 1) : PG8_BK(cB, cB2, t + 3);
            if (last && has_next) S.a_ready(nxt);
            if constexpr (SP2) {
            PG8_LDB(B0, 0, 0); PG8_LDB(B1, 0, 1); PG8_SCHED; PG8_LDA(At, 0, 0); PG8_STAGE(PG8_SA(1, 1), a1 + hsA, voffA);
            PG8_WAIT_V(8); PG8_WAIT_L(0); PG8_BAR; PG8_MMA(0, 0, At, B0); PG8_MMA(0, 1, At, B1); PG8_BAR; PG8_SCHED;
            PG8_LDA(At, 0, 1); PG8_STAGE(PG8_SB(0, 0), b2, voffB); PG8_STAGE(PG8_SB(0, 1), b2 + hsB, voffB); PG8_STAGE(PG8_SA(0, 0), a2, voffA);
            PG8_WAIT_V(8); PG8_WAIT_L(0); PG8_BAR; PG8_MMA(1, 0, At, B0); PG8_MMA(1, 1, At, B1); PG8_BAR; PG8_SCHED;
            PG8_LDB(B0, 1, 0); PG8_LDB(B1, 1, 1); PG8_SCHED; PG8_LDA(At, 1, 0); PG8_STAGE(PG8_SA(0, 1), a2 + hsA, voffA);
            PG8_WAIT_V(8); PG8_WAIT_L(0); PG8_BAR; PG8_MMA(0, 0, At, B0); PG8_MMA(0, 1, At, B1); PG8_BAR; PG8_SCHED;
            PG8_LDA(At, 1, 1); PG8_STAGE(PG8_SB(1, 0), b3, voffB); PG8_STAGE(PG8_SB(1, 1), b3 + hsB, voffB); PG8_STAGE(PG8_SA(1, 0), a3, voffA);
            PG8_WAIT_V(8); PG8_WAIT_L(0); PG8_BAR; PG8_MMA(1, 0, At, B0); PG8_MMA(1, 1, At, B1); PG8_BAR; PG8_SCHED;
            } else {
            PG8_LDB(B0, 0, 0); PG8_SCHED; PG8_LDA(At, 0, 0); PG8_STAGE(PG8_SA(1, 1), a1 + hsA, voffA);
            PG8_WAIT_L(8); PG8_BAR; PG8_WAIT_L(0); PG8_MMA(0, 0, At, B0); PG8_BAR; PG8_SCHED;
            PG8_LDB(B1, 0, 1); PG8_STAGE(PG8_SB(0, 0), b2, voffB);
            PG8_BAR; PG8_WAIT_L(0); PG8_MMA(0, 1, At, B1); PG8_BAR;
            PG8_LDA(At, 0, 1); PG8_STAGE(PG8_SA(0, 0), a2, voffA);
            PG8_BAR; PG8_WAIT_L(0); PG8_MMA(1, 0, At, B0); PG8_BAR; PG8_SCHED;
            PG8_STAGE(PG8_SB(0, 1), b2 + hsB, voffB);
            PG8_WAIT_V(6); PG8_BAR; PG8_MMA(1, 1, At, B1); PG8_BAR;
            PG8_LDB(B0, 1, 0); PG8_SCHED; PG8_LDA(At, 1, 0); PG8_STAGE(PG8_SA(0, 1), a2 + hsA, voffA);
            PG8_WAIT_L(8); PG8_BAR; PG8_WAIT_L(0); PG8_MMA(0, 0, At, B0); PG8_BAR; PG8_SCHED;
            PG8_LDB(B1, 1, 1); PG8_STAGE(PG8_SB(1, 0), b3, voffB);
            PG8_BAR; PG8_WAIT_L(0); PG8_MMA(0, 1, At, B1); PG8_BAR;
            PG8_LDA(At, 1, 1); PG8_STAGE(PG8_SA(1, 0), a3, voffA);
            PG8_BAR; PG8_WAIT_L(0); PG8_MMA(1, 0, At, B0); PG8_BAR; PG8_SCHED;
            PG8_STAGE(PG8_SB(1, 1), b3 + hsB, voffB);
            PG8_WAIT_V(6); PG8_BAR; PG8_MMA(1, 1, At, B1); PG8_BAR;
            }
        }
        if constexpr (ALIGN_EPI) { if (wr == 0) PG8_BAR; }
        if constexpr (!Epi::AFTER_DRAIN) { E(acc, cur, wr, wc, fr, fq); S.done(cur); }
        if (!has_next) break;
#pragma unroll
        for (int a = 0; a < 2; ++a)
#pragma unroll
            for (int b = 0; b < 2; ++b)
#pragma unroll
                for (int m = 0; m < 4; ++m)
#pragma unroll
                    for (int n = 0; n < 2; ++n) acc[a][b][m][n] = (f32x4){0.f, 0.f, 0.f, 0.f};
        cur = nxt; cA = nA; cB = nB; cB2 = nB2; ++ui;
        if constexpr (ALIGN_EPI) { if (wr == 1) PG8_BAR; }
    }
    PG8_WAIT_V(0);
    if constexpr (!ALIGN_EPI) { if (wr == 0) PG8_BAR; }
    PG8_BAR;
    if constexpr (Epi::AFTER_DRAIN) { E.fused(acc, cur, wr, wc, fr, fq, lds, wid, lane); S.done(cur); }
#undef PG8_BK
#undef PG8_SA
#undef PG8_SB
#undef PG8_STAGE
#undef PG8_LDA
#undef PG8_LDB
#undef PG8_MMA
#undef PG8_WAIT_V
#undef PG8_WAIT_L
#undef PG8_BAR
#undef PG8_SCHED
}
}

struct PlainOrder {
    const char* A; const char* Bt; int lda, ldb, nM, nN, nwg, G, c;
    __device__ __forceinline__ void init(const void* A_, const void* Bt_, int lda_, int ldb_, int M, int N, int G_, int c_) { A = (const char*)A_; Bt = (const char*)Bt_; lda = lda_; ldb = ldb_; nM = M / 256; nN = N / 256; nwg = nM * nN; G = G_; c = c_; }
    __device__ __forceinline__ bool next(int i, pg8::Unit& u) const {
        const long L = (long)i * G + c; if (L >= nwg) return false;
        int wgid = (int)L; { const int q = nwg / 8, r = nwg % 8, xcd = wgid % 8, off = wgid / 8; wgid = (xcd < r ? xcd * (q + 1) : r * (q + 1) + (xcd - r) * q) + off; }
        const int nig = 8 * nN, gid = wgid / nig, fm = gid * 8, gsz = (nM - fm) < 8 ? (nM - fm) : 8;
        u.pm = fm + ((wgid % nig) % gsz); u.pn = (wgid % nig) / gsz;
        u.a = A + (size_t)u.pm * 256 * lda * 2; u.b = Bt + (size_t)u.pn * 256 * ldb * 2; u.b2 = u.b; return true;
    }
    __device__ __forceinline__ void a_ready(const pg8::Unit&) const {}
    __device__ __forceinline__ void done(const pg8::Unit&) const {}
};
struct EpiInProj {
    static constexpr bool PERM = true, AFTER_DRAIN = false;
    unsigned char* ws; const float* b_gate; const float* b_fgt;
    __device__ __forceinline__ void operator()(const pg8::f32x4 (&acc)[2][2][4][2], const pg8::Unit& u, int wr, int wc, int fr, int fq) const {
        asm volatile("" : "+v"(fr), "+v"(fq));
        const int pn = u.pn, b = (u.pm * 256) / T_, t0 = u.pm * 256 - b * T_ + wr * 64 + fr;
        if (pn == 11) {
            if (wc == 0 && fq < 4) {
                float* gate = (float*)(ws + WS_GATE); float* fl = (float*)(ws + WS_FL);
#pragma unroll
                for (int ai = 0; ai < 2; ++ai)
#pragma unroll
                    for (int m = 0; m < 4; ++m) { const int t = t0 + ai * 128 + m * 16; const size_t n = (size_t)b * T_ + t;
#pragma unroll
                        for (int nn = 0; nn < 2; ++nn)
#pragma unroll
                            for (int e = 0; e < 4; ++e) { const int c = 8 * fq + 4 * nn + e; const float v = acc[ai][0][m][nn][e];
                                if (c < 24) gate[n * 24 + c] = sigmoidf_(v + b_gate[c]);
                                else if (c < 28) fl[(size_t)(b * 4 + (c - 24)) * T_ + t] = log_sigmoidf_(v + b_fgt[c - 24]); } }
            }
            return;
        }
#pragma unroll
        for (int bj = 0; bj < 2; ++bj) {
            const int c = bj * 128 + wc * 32 + 8 * fq;
            bf16* base; int W = 64; float sc = 1.f;
            if (pn < 2) { base = (bf16*)(ws + WS_QN) + (size_t)(b * 8 + pn * 4 + (c >> 6)) * T_ * 64 + (c & 63); sc = 0.125f * LOG2E; }
            else if (pn < 5) { base = (bf16*)(ws + WS_KV6 + (size_t)((pn - 2) * 2 + (c >> 7)) * KV6_STRIDE) + (size_t)(b * 2 + ((c >> 6) & 1)) * T_ * 64 + (c & 63); }
            else if (pn < 8) { base = (bf16*)(ws + WS_FQKV) + (size_t)(pn - 5) * (8 * MiB) + (size_t)(b * 4 + (c >> 6)) * T_ * 64 + (c & 63); if (pn == 5) sc = 0.125f * LOG2E; }
            else if (pn < 10) { base = (bf16*)(ws + WS_DQK) + (size_t)(pn - 8) * (8 * MiB) + (size_t)(b * 8 + (c >> 5)) * T_ * 32 + (c & 31); W = 32; if (pn == 8) sc = 0.17677669529663687f * LOG2E; }
            else { base = (bf16*)(ws + WS_DV) + (size_t)(b * 4 + (c >> 6)) * T_ * 64 + (c & 63); }
#pragma unroll
            for (int ai = 0; ai < 2; ++ai)
#pragma unroll
                for (int m = 0; m < 4; ++m) { const int t = t0 + ai * 128 + m * 16;
                    const pg8::f32x4 v0 = acc[ai][bj][m][0] * sc, v1 = acc[ai][bj][m][1] * sc;
                    pg8::u32x4 w; w.x = pg8::cvt_pk_bf16(v0[0], v0[1]); w.y = pg8::cvt_pk_bf16(v0[2], v0[3]); w.z = pg8::cvt_pk_bf16(v1[0], v1[1]); w.w = pg8::cvt_pk_bf16(v1[2], v1[3]);
                    *(pg8::u32x4*)(base + (size_t)t * W) = w; }
        }
    }
};
struct EpiResF32 {
    static constexpr bool PERM = false, AFTER_DRAIN = false;
    const float* base; float* out;
    __device__ __forceinline__ void operator()(const pg8::f32x4 (&acc)[2][2][4][2], const pg8::Unit& u, int wr, int wc, int fr, int fq) const {
        asm volatile("" : "+v"(fr), "+v"(fq));
#pragma unroll
        for (int ai = 0; ai < 2; ++ai)
#pragma unroll
            for (int m = 0; m < 4; ++m) { const size_t off = (size_t)(u.pm * 256 + ai * 128 + wr * 64 + m * 16 + fr) * D_ + u.pn * 256 + wc * 32 + 4 * fq;
#pragma unroll
                for (int bj = 0; bj < 2; ++bj)
#pragma unroll
                    for (int n = 0; n < 2; ++n) { const pg8::f32x4 bs = *(const pg8::f32x4*)(base + off + bj * 128 + n * 16); *(pg8::f32x4*)(out + off + bj * 128 + n * 16) = bs + acc[ai][bj][m][n]; } }
    }
};

__device__ __forceinline__ void transpose_item(const float* W, int ldw, bf16* WT, int ldt, int r0, int rmul, int k0, LAS float* scr, int lane) {
#pragma unroll 8
    for (int i = 0; i < 32; ++i) { const int kk = 2 * i + (lane >> 5); scr[kk * 33 + (lane & 31)] = W[(size_t)(k0 + kk) * ldw + (lane & 31)]; }
    asm volatile("s_waitcnt lgkmcnt(0)" ::: "memory");
    const int c = lane & 7;
#pragma unroll
    for (int j = 0; j < 4; ++j) { const int n = (lane >> 3) + 8 * j; const LAS float* sp = scr + (8 * c) * 33 + n;
        u32x4 o; o.x = pk2(sp[0 * 33], sp[1 * 33]); o.y = pk2(sp[2 * 33], sp[3 * 33]); o.z = pk2(sp[4 * 33], sp[5 * 33]); o.w = pk2(sp[6 * 33], sp[7 * 33]);
        *(u32x4*)(WT + (size_t)(r0 + rmul * n) * ldt + k0 + 8 * c) = o; }
    asm volatile("s_waitcnt lgkmcnt(0)" ::: "memory");
}
__device__ __forceinline__ void transpose_seg(const float* W, int ldw, int K, int sc0, int ncol, bf16* WT, int r0, int rmul, int item, LAS float* scr, int lane) {
    const int nb = ncol / 32, kb = item / nb, cb = item % nb;
    transpose_item(W + sc0 + cb * 32, ldw, WT, K, r0 + rmul * cb * 32, rmul, kb * 64, scr, lane);
}

__device__ __forceinline__ void ph_norm_bf16(const Ctx& c, const float* x, const float* g, bf16* out) {
    for (int row = c.gw; row < NT; row += c.ngw) {
        const f32x4* xr = (const f32x4*)(x + (size_t)row * D_) + c.lane;
        f32x4 v[4]; float ss = 0.f;
#pragma unroll
        for (int j = 0; j < 4; ++j) { v[j] = xr[64 * j]; ss += v[j].x * v[j].x + v[j].y * v[j].y + v[j].z * v[j].z + v[j].w * v[j].w; }
        const float r = rsqrtf(wave_sum(ss) * (1.f / D_) + EPS);
        u64* o8 = (u64*)(out + (size_t)row * D_) + c.lane;
#pragma unroll
        for (int j = 0; j < 4; ++j) { const f32x4 gg = ((const f32x4*)g)[c.lane + 64 * j];
            o8[64 * j] = (u64)pk2(v[j].x * r * gg.x, v[j].y * r * gg.y) | ((u64)pk2(v[j].z * r * gg.z, v[j].w * r * gg.w) << 32); }
    }
}
__device__ __forceinline__ void ph_norm_final(const Ctx& c, float* x, const float* g) {
    for (int row = c.gw; row < NT; row += c.ngw) {
        f32x4* xr = (f32x4*)(x + (size_t)row * D_) + c.lane;
        f32x4 v[4]; float ss = 0.f;
#pragma unroll
        for (int j = 0; j < 4; ++j) { v[j] = xr[64 * j]; ss += v[j].x * v[j].x + v[j].y * v[j].y + v[j].z * v[j].z + v[j].w * v[j].w; }
        const float r = rsqrtf(wave_sum(ss) * (1.f / D_) + EPS);
#pragma unroll
        for (int j = 0; j < 4; ++j) { const f32x4 gg = ((const f32x4*)g)[c.lane + 64 * j]; xr[64 * j] = v[j] * r * gg; }
    }
}

template <class AF, class EF>
__device__ __forceinline__ void naive_gemm(const Ctx& c, int M, int N, int K, AF af, const float* W, int ldb, EF ef) {
    LAS float* As = (LAS float*)c.lds;
    LAS float* Bs = As + 16 * 132;
    const int tm = (M + 127) / 128, tn = (N + 127) / 128, ntile = tm * tn;
    const int ty = c.tid >> 4, tx = c.tid & 15;
    for (int tile = c.bid; tile < ntile; tile += c.G) {
        const int m0 = (tile / tn) * 128, n0 = (tile % tn) * 128;
        float acc[4][8];
#pragma unroll
        for (int i = 0; i < 4; ++i)
#pragma unroll
            for (int j = 0; j < 8; ++j) acc[i][j] = 0.f;
        for (int k0 = 0; k0 < K; k0 += 16) {
            __syncthreads();
#pragma unroll
            for (int i = 0; i < 4; ++i) { const int e = c.tid + i * 512, r = e >> 4, kk = e & 15; const int row = m0 + r;
                As[kk * 132 + r] = (row < M) ? af(row, k0 + kk) : 0.f; }
#pragma unroll
            for (int i = 0; i < 4; ++i) { const int e = c.tid + i * 512, kk = e >> 7, cc = e & 127; const int col = n0 + cc;
                Bs[kk * 132 + cc] = (col < N) ? W[(size_t)(k0 + kk) * ldb + col] : 0.f; }
            __syncthreads();
#pragma unroll 2
            for (int kk = 0; kk < 16; ++kk) {
                float a[4], b[8];
#pragma unroll
                for (int i = 0; i < 4; ++i) a[i] = As[kk * 132 + ty * 4 + i];
#pragma unroll
                for (int j = 0; j < 8; ++j) b[j] = Bs[kk * 132 + tx * 8 + j];
#pragma unroll
                for (int i = 0; i < 4; ++i)
#pragma unroll
                    for (int j = 0; j < 8; ++j) acc[i][j] = fmaf(a[i], b[j], acc[i][j]);
            }
        }
        LAS float* Cs = Bs + 16 * 132;
        __syncthreads();
#pragma unroll
        for (int i = 0; i < 4; ++i)
#pragma unroll
            for (int j = 0; j < 8; ++j) Cs[(ty * 4 + i) * 129 + tx * 8 + j] = acc[i][j];
        __syncthreads();
#pragma unroll 1
        for (int e = c.tid; e < 128 * 128; e += NTHREADS) { const int r = e >> 7, cc = e & 127, row = m0 + r, col = n0 + cc; if (row < M && col < N) ef(row, col, Cs[r * 129 + cc]); }
    }
    __syncthreads();
}

struct InProjOut { bf16* qn; bf16* kv6; bf16* fqkv; bf16* dqk; bf16* dv; float* gate; float* fl; const float* b_gate; const float* b_fgt; };
__device__ __forceinline__ void inproj_store(const InProjOut& o, int n, int col, float v) {
    const int b = n / T_, t = n % T_;
    if (col < C_KV6) { const int h = col >> 6, d = col & 63; o.qn[((size_t)(b * 8 + h) * T_ + t) * 64 + d] = (bf16)f2bf(v * (0.125f * LOG2E)); }
    else if (col < C_GATE) { const int cc = col - C_KV6, idx = cc >> 7, g = (cc >> 6) & 1, d = cc & 63;
        ((bf16*)((unsigned char*)o.kv6 + idx * KV6_STRIDE))[((size_t)(b * 2 + g) * T_ + t) * 64 + d] = (bf16)f2bf(v); }
    else if (col < C_FQ) { const int j = col - C_GATE; o.gate[(size_t)n * 24 + j] = sigmoidf_(v + o.b_gate[j]); }
    else if (col < C_FF) { const int cc = col - C_FQ, idx = cc >> 8, h = (cc >> 6) & 3, d = cc & 63;
        o.fqkv[(size_t)idx * (8 * MiB) + ((size_t)(b * 4 + h) * T_ + t) * 64 + d] = (bf16)f2bf(idx == 0 ? v * (0.125f * LOG2E) : v); }
    else if (col < C_DQ) { const int h = col - C_FF; o.fl[(size_t)(b * 4 + h) * T_ + t] = log_sigmoidf_(v + o.b_fgt[h]); }
    else if (col < C_DV) { const int cc = col - C_DQ, idx = cc >> 8, h = (cc >> 6) & 3, i = (cc >> 5) & 1, d = cc & 31;
        o.dqk[(size_t)idx * (8 * MiB) + ((size_t)((b * 4 + h) * 2 + i) * T_ + t) * 32 + d] = (bf16)f2bf(idx == 0 ? v * (0.17677669529663687f * LOG2E) : v); }
    else { const int cc = col - C_DV, h = cc >> 6, d = cc & 63; o.dv[((size_t)(b * 4 + h) * T_ + t) * 64 + d] = (bf16)f2bf(v); }
}

__device__ __forceinline__ void ph_cumsum(const Ctx& c, float* fl) {
    for (int s = c.gw; s < B_ * 4; s += c.ngw) {
        float* p = fl + (size_t)s * T_; float carry = 0.f;
        for (int t0 = 0; t0 < T_; t0 += 64) {
            float v = p[t0 + c.lane];
#pragma unroll
            for (int o = 1; o < 64; o <<= 1) { const float u = __shfl_up(v, o); if (c.lane >= o) v += u; }
            v += carry; p[t0 + c.lane] = v; carry = __shfl(v, 63);
        }
    }
}

template <int DQK>
__device__ __forceinline__ float naive_attn_row(const bf16* q, const bf16* K, const bf16* V, int t, u64 mask, float slope2, const float* cum, int win, int lane) {
    float qv[DQK];
    { const u32x4* q4 = (const u32x4*)q;
#pragma unroll
      for (int i = 0; i < DQK / 8; ++i) { const u32x4 w = q4[i];
          qv[8 * i + 0] = __uint_as_float(w.x << 16); qv[8 * i + 1] = __uint_as_float(w.x & 0xffff0000u);
          qv[8 * i + 2] = __uint_as_float(w.y << 16); qv[8 * i + 3] = __uint_as_float(w.y & 0xffff0000u);
          qv[8 * i + 4] = __uint_as_float(w.z << 16); qv[8 * i + 5] = __uint_as_float(w.z & 0xffff0000u);
          qv[8 * i + 6] = __uint_as_float(w.w << 16); qv[8 * i + 7] = __uint_as_float(w.w & 0xffff0000u); } }
    const float cumt = cum ? cum[t] : 0.f;
    float m = -INFINITY, l = 0.f, o = 0.f;
    while (mask) {
        const int j = __builtin_ctzll(mask); mask &= mask - 1;
        const int kpos = 64 * j + lane; const int dist = t - kpos;
        const bool valid = dist >= 0 && dist < win;
        float s = 0.f;
        { const u32x4* k4 = (const u32x4*)(K + (size_t)kpos * DQK);
#pragma unroll
          for (int i = 0; i < DQK / 8; ++i) { const u32x4 w = k4[i];
              s = fmaf(qv[8 * i + 0], __uint_as_float(w.x << 16), s); s = fmaf(qv[8 * i + 1], __uint_as_float(w.x & 0xffff0000u), s);
              s = fmaf(qv[8 * i + 2], __uint_as_float(w.y << 16), s); s = fmaf(qv[8 * i + 3], __uint_as_float(w.y & 0xffff0000u), s);
              s = fmaf(qv[8 * i + 4], __uint_as_float(w.z << 16), s); s = fmaf(qv[8 * i + 5], __uint_as_float(w.z & 0xffff0000u), s);
              s = fmaf(qv[8 * i + 6], __uint_as_float(w.w << 16), s); s = fmaf(qv[8 * i + 7], __uint_as_float(w.w & 0xffff0000u), s); } }
        s -= slope2 * (float)dist;
        if (cum) s += (cumt - cum[kpos]) * LOG2E;
        s = valid ? s : -INFINITY;
        const float mb = wave_max(s);
        if (mb == -INFINITY) continue;
        const float mn = fmaxf(m, mb), alpha = exp2f(m - mn);
        const float p = valid ? exp2f(s - mn) : 0.f;
        l = l * alpha + wave_sum(p); o *= alpha; m = mn;
        const bf16* vb = V + (size_t)(64 * j) * 64 + lane;
#pragma unroll 8
        for (int k = 0; k < 64; ++k) o = fmaf(__shfl(p, k), bf2f(vb[(size_t)k * 64]), o);
    }
    return l > 0.f ? o / l : 0.f;
}

__device__ __forceinline__ void ph_cmp_attn(const Ctx& c, const bf16* qn, const bf16* kcmp, const bf16* vcmp, const float* gate, u64* sel, bf16* ocmp) {
    LAS float* pl = (LAS float*)(c.lds) + c.wave * 256;
    const int lane = c.lane;
    for (int it = c.gw; it < B_ * 2 * T_; it += c.ngw) {
        const int t = it % T_, bg = it / T_, b = bg >> 1, g = bg & 1;
        const int nvis = (t >= 31) ? ((t - 31) >> 4) + 1 : 0;
        const bf16* kc = kcmp + (size_t)bg * 256 * 64; const bf16* vc = vcmp + (size_t)bg * 256 * 64;
        float imp = 0.f;
        for (int hg = 0; hg < 4; ++hg) {
            const int h = g * 4 + hg; const float slope2 = alibi_slope(h + 1, 8) * LOG2E;
            const bf16* q = qn + ((size_t)(b * 8 + h) * T_ + t) * 64;
            float qv[64];
            { const u32x4* q4 = (const u32x4*)q;
#pragma unroll
              for (int i = 0; i < 8; ++i) { const u32x4 w = q4[i];
                  qv[8 * i + 0] = __uint_as_float(w.x << 16); qv[8 * i + 1] = __uint_as_float(w.x & 0xffff0000u);
                  qv[8 * i + 2] = __uint_as_float(w.y << 16); qv[8 * i + 3] = __uint_as_float(w.y & 0xffff0000u);
                  qv[8 * i + 4] = __uint_as_float(w.z << 16); qv[8 * i + 5] = __uint_as_float(w.z & 0xffff0000u);
                  qv[8 * i + 6] = __uint_as_float(w.w << 16); qv[8 * i + 7] = __uint_as_float(w.w & 0xffff0000u); } }
            float s[4]; float m = -INFINITY;
#pragma unroll
            for (int i = 0; i < 4; ++i) { const int cc = lane + 64 * i; float a = 0.f;
                if (cc < nvis) { const u32x4* k4 = (const u32x4*)(kc + (size_t)cc * 64);
#pragma unroll
                    for (int e = 0; e < 8; ++e) { const u32x4 w = k4[e];
                        a = fmaf(qv[8 * e + 0], __uint_as_float(w.x << 16), a); a = fmaf(qv[8 * e + 1], __uint_as_float(w.x & 0xffff0000u), a);
                        a = fmaf(qv[8 * e + 2], __uint_as_float(w.y << 16), a); a = fmaf(qv[8 * e + 3], __uint_as_float(w.y & 0xffff0000u), a);
                        a = fmaf(qv[8 * e + 4], __uint_as_float(w.z << 16), a); a = fmaf(qv[8 * e + 5], __uint_as_float(w.z & 0xffff0000u), a);
                        a = fmaf(qv[8 * e + 6], __uint_as_float(w.w << 16), a); a = fmaf(qv[8 * e + 7], __uint_as_float(w.w & 0xffff0000u), a); }
                    a -= slope2 * (float)(t - (16 * cc + 31)); } else a = -INFINITY;
                s[i] = a; m = fmaxf(m, a); }
            m = wave_max(m);
            float p[4], lsum = 0.f;
#pragma unroll
            for (int i = 0; i < 4; ++i) { p[i] = (lane + 64 * i < nvis) ? exp2f(s[i] - m) : 0.f; lsum += p[i]; }
            lsum = wave_sum(lsum);
            const float inv = lsum > 0.f ? 1.f / lsum : 0.f;
#pragma unroll
            for (int i = 0; i < 4; ++i) { p[i] *= inv; pl[lane + 64 * i] = p[i]; }
            asm volatile("s_waitcnt lgkmcnt(0)" ::: "memory");
            float o = 0.f;
            for (int cc = 0; cc < nvis; ++cc) o = fmaf(pl[cc], bf2f(vc[(size_t)cc * 64 + lane]), o);
            const float gt = gate[((size_t)(b * T_ + t)) * 24 + h * 3 + 0];
            ocmp[(size_t)(b * T_ + t) * 512 + h * 64 + lane] = (bf16)f2bf(gt * o);
            { const int j = lane; float a = pl[4 * j] + pl[4 * j + 1] + pl[4 * j + 2] + 0.5f * pl[4 * j + 3]; if (j > 0) a += 0.5f * pl[4 * j - 1]; imp += a; }
            asm volatile("s_waitcnt lgkmcnt(0)" ::: "memory");
        }
        const int cur = t >> 6; const int j = lane;
        u64 m64;
        if (cur <= 15) m64 = (cur == 63) ? ~0ull : ((1ull << (cur + 1)) - 1ull);
        else {
            float val = (j > cur) ? -INFINITY : ((j == 0 || j == cur || j == cur - 1) ? 1e4f : imp);
            m64 = 0ull;
            for (int r = 0; r < 16; ++r) {
                const float mx = wave_max(val);
                const u64 bal = __ballot(val == mx);
                const int w = __builtin_ctzll(bal);
                m64 |= 1ull << w; if (j == w) val = -INFINITY;
            }
        }
        if (lane == 0) sel[(size_t)bg * T_ + t] = m64;
    }
}

__device__ __forceinline__ void ph_win_attn(const Ctx& c, const bf16* qn, const bf16* kw, const bf16* vw, const float* gate, bf16* owin) {
    for (int it = c.gw; it < B_ * 8 * T_; it += c.ngw) {
        const int t = it % T_, bh = it / T_, b = bh >> 3, h = bh & 7, g = h >> 2;
        const int cur = t >> 6, jlo = (t - 511) > 0 ? (t - 511) >> 6 : 0;
        const u64 hi = (cur == 63) ? ~0ull : ((1ull << (cur + 1)) - 1ull); const u64 mask = hi & ~((1ull << jlo) - 1ull);
        const float o = naive_attn_row<64>(qn + ((size_t)bh * T_ + t) * 64, kw + (size_t)(b * 2 + g) * T_ * 64, vw + (size_t)(b * 2 + g) * T_ * 64, t, mask,
                                           alibi_slope(h + 1, 8) * LOG2E, nullptr, 512, c.lane);
        owin[(size_t)(b * T_ + t) * 512 + h * 64 + c.lane] = (bf16)f2bf(gate[(size_t)(b * T_ + t) * 24 + h * 3 + 2] * o);
    }
}
__device__ __forceinline__ void ph_slc_attn(const Ctx& c, const bf16* qn, const bf16* ks, const bf16* vs, const float* gate, const u64* sel, const bf16* ocmp, const bf16* owin, bf16* att) {
    for (int it = c.gw; it < B_ * 8 * T_; it += c.ngw) {
        const int t = it % T_, bh = it / T_, b = bh >> 3, h = bh & 7, g = h >> 2;
        const u64 mask = sel[(size_t)(b * 2 + g) * T_ + t];
        const float o = naive_attn_row<64>(qn + ((size_t)bh * T_ + t) * 64, ks + (size_t)(b * 2 + g) * T_ * 64, vs + (size_t)(b * 2 + g) * T_ * 64, t, mask,
                                           alibi_slope(h + 1, 8) * LOG2E, nullptr, 1 << 30, c.lane);
        const size_t n = (size_t)(b * T_ + t);
        const float r = gate[n * 24 + h * 3 + 1] * o + bf2f(ocmp[n * 512 + h * 64 + c.lane]) + bf2f(owin[n * 512 + h * 64 + c.lane]);
        att[n * 1024 + h * 64 + c.lane] = (bf16)f2bf(r);
    }
}
__device__ __forceinline__ void ph_fox_attn(const Ctx& c, const bf16* fq, const bf16* fk, const bf16* fv, const float* cum, bf16* att) {
    for (int it = c.gw; it < B_ * 4 * T_; it += c.ngw) {
        const int t = it % T_, bh = it / T_, b = bh >> 2, h = bh & 3;
        const int cur = t >> 6; const u64 mask = (cur == 63) ? ~0ull : ((1ull << (cur + 1)) - 1ull);
        const float o = naive_attn_row<64>(fq + ((size_t)bh * T_ + t) * 64, fk + (size_t)bh * T_ * 64, fv + (size_t)bh * T_ * 64, t, mask, 0.f, cum + (size_t)bh * T_, 1 << 30, c.lane);
        att[(size_t)(b * T_ + t) * 1024 + 512 + h * 64 + c.lane] = (bf16)f2bf(o);
    }
}
__device__ __forceinline__ void ph_diff_attn(const Ctx& c, const bf16* dq, const bf16* dk, const bf16* dv, const float* lam, const float* subln, float lambda_init, bf16* att) {
    float l1 = 0.f, l2 = 0.f;
    if (c.lane < 32) { l1 = lam[c.lane] * lam[32 + c.lane]; l2 = lam[64 + c.lane] * lam[96 + c.lane]; }
    const float lam_full = __expf(wave_sum(l1)) - __expf(wave_sum(l2)) + lambda_init;
    const float sg = subln[c.lane] * (1.f - lambda_init);
    for (int it = c.gw; it < B_ * 4 * T_; it += c.ngw) {
        const int t = it % T_, bh = it / T_, b = bh >> 2, h = bh & 3;
        const int cur = t >> 6; const u64 mask = (cur == 63) ? ~0ull : ((1ull << (cur + 1)) - 1ull);
        const float slope2 = alibi_slope(h + 1, 4) * LOG2E;
        const bf16* vb = dv + (size_t)bh * T_ * 64;
        const float o1 = naive_attn_row<32>(dq + ((size_t)(bh * 2 + 0) * T_ + t) * 32, dk + (size_t)(bh * 2 + 0) * T_ * 32, vb, t, mask, slope2, nullptr, 1 << 30, c.lane);
        const float o2 = naive_attn_row<32>(dq + ((size_t)(bh * 2 + 1) * T_ + t) * 32, dk + (size_t)(bh * 2 + 1) * T_ * 32, vb, t, mask, slope2, nullptr, 1 << 30, c.lane);
        const float o = o1 - lam_full * o2;
        const float r = rsqrtf(wave_sum(o * o) * (1.f / 64.f) + EPS);
        att[(size_t)(b * T_ + t) * 1024 + 768 + h * 64 + c.lane] = (bf16)f2bf(o * r * sg);
    }
}

__device__ __forceinline__ void ph_moe_route(const Ctx& c, const float* x, const float* g, const float* wgrp, const float* bgrp, const float* wexp, const float* bexp, bf16* hn, int* route_e, float* route_w) {
    for (int row = c.gw; row < NT; row += c.ngw) {
        const f32x4* xr = (const f32x4*)(x + (size_t)row * D_) + c.lane;
        f32x4 v[4]; float ss = 0.f;
#pragma unroll
        for (int j = 0; j < 4; ++j) { v[j] = xr[64 * j]; ss += v[j].x * v[j].x + v[j].y * v[j].y + v[j].z * v[j].z + v[j].w * v[j].w; }
        const float r = rsqrtf(wave_sum(ss) * (1.f / D_) + EPS);
        u64* o8 = (u64*)(hn + (size_t)row * D_) + c.lane;
#pragma unroll
        for (int j = 0; j < 4; ++j) { const f32x4 gg = ((const f32x4*)g)[c.lane + 64 * j]; v[j] = v[j] * r * gg;
            o8[64 * j] = (u64)pk2(v[j].x, v[j].y) | ((u64)pk2(v[j].z, v[j].w) << 32); }
        float gl[4];
#pragma unroll
        for (int q = 0; q < 4; ++q) { float a = 0.f;
#pragma unroll
            for (int j = 0; j < 4; ++j) { const int k = 4 * (c.lane + 64 * j);
                a = fmaf(v[j].x, wgrp[(size_t)(k + 0) * 4 + q], a); a = fmaf(v[j].y, wgrp[(size_t)(k + 1) * 4 + q], a);
                a = fmaf(v[j].z, wgrp[(size_t)(k + 2) * 4 + q], a); a = fmaf(v[j].w, wgrp[(size_t)(k + 3) * 4 + q], a); }
            gl[q] = wave_sum(a) + bgrp[q]; }
        int grp = 0; float gm = gl[0];
#pragma unroll
        for (int q = 1; q < 4; ++q) if (gl[q] > gm) { gm = gl[q]; grp = q; }
        float gs = 0.f;
#pragma unroll
        for (int q = 0; q < 4; ++q) gs += __expf(gl[q] - gm);
        const float grp_gate = 1.f / gs;
        float el[8];
#pragma unroll
        for (int q = 0; q < 8; ++q) { float a = 0.f; const int col = grp * 8 + q;
#pragma unroll
            for (int j = 0; j < 4; ++j) { const int k = 4 * (c.lane + 64 * j);
                a = fmaf(v[j].x, wexp[(size_t)(k + 0) * 32 + col], a); a = fmaf(v[j].y, wexp[(size_t)(k + 1) * 32 + col], a);
                a = fmaf(v[j].z, wexp[(size_t)(k + 2) * 32 + col], a); a = fmaf(v[j].w, wexp[(size_t)(k + 3) * 32 + col], a); }
            el[q] = wave_sum(a) + bexp[col]; }
        int i0 = 0; float v0 = el[0];
#pragma unroll
        for (int q = 1; q < 8; ++q) if (el[q] > v0) { v0 = el[q]; i0 = q; }
        int i1 = -1; float v1 = -INFINITY;
#pragma unroll
        for (int q = 0; q < 8; ++q) if (q != i0 && el[q] > v1) { v1 = el[q]; i1 = q; }
        const float e1 = __expf(v1 - v0), den = 1.f + e1;
        if (c.lane == 0) { route_e[2 * row] = grp * 8 + i0; route_e[2 * row + 1] = grp * 8 + i1; route_w[2 * row] = grp_gate / den; route_w[2 * row + 1] = grp_gate * e1 / den; }
    }
}
__device__ __forceinline__ void ph_moe_naive(const Ctx& c, const bf16* hn, const int* route_e, const float* route_w, const float* wg, const float* wu, const float* wd, float* x) {
    LAS float* hs = (LAS float*)c.lds;
    LAS float* au = hs + 1024;
    LAS float* h2 = au + 512;
    for (int row = c.bid; row < NT; row += c.G) {
        __syncthreads();
        hs[c.tid] = bf2f(hn[(size_t)row * D_ + c.tid]); hs[c.tid + 512] = bf2f(hn[(size_t)row * D_ + c.tid + 512]);
        float o0 = 0.f, o1 = 0.f;
        for (int s = 0; s < 2; ++s) {
            const int e = route_e[2 * row + s]; const float w = route_w[2 * row + s];
            __syncthreads();
            const float* W = (c.tid < 256 ? wg : wu) + (size_t)e * D_ * DEXP + (c.tid & 255);
            float a = 0.f;
            for (int k = 0; k < D_; ++k) a = fmaf(hs[k], W[(size_t)k * DEXP], a);
            au[c.tid] = a;
            __syncthreads();
            if (c.tid < 256) { const float ga = au[c.tid], up = au[c.tid + 256]; h2[c.tid] = ga / (1.f + __expf(-ga)) * up * w; }
            __syncthreads();
            const float* Wd = wd + (size_t)e * DEXP * D_;
            for (int k = 0; k < DEXP; ++k) { const float hv = h2[k]; o0 = fmaf(hv, Wd[(size_t)k * D_ + c.tid], o0); o1 = fmaf(hv, Wd[(size_t)k * D_ + c.tid + 512], o1); }
        }
        x[(size_t)row * D_ + c.tid] += o0; x[(size_t)row * D_ + c.tid + 512] += o1;
    }
    __syncthreads();
}

typedef __attribute__((address_space(4))) const Params* KP;
__device__ __forceinline__ KP uni_kp(KP p) { const unsigned long long v = (unsigned long long)p; const unsigned lo = __builtin_amdgcn_readfirstlane((unsigned)v), hi = __builtin_amdgcn_readfirstlane((unsigned)(v >> 32)); return (KP)(((unsigned long long)hi << 32) | lo); }
constexpr int PH_PER_LAYER = 9, N_PHASES = L_ * PH_PER_LAYER + 2;
extern __shared__ __attribute__((aligned(16))) unsigned char lds_raw[];
__device__ __forceinline__ Ctx make_ctx(KP p) {
    Ctx c; c.lds = (LAS unsigned char*)lds_raw; c.tid = threadIdx.x; c.lane = c.tid & 63; c.wave = __builtin_amdgcn_readfirstlane(c.tid >> 6);
    c.bid = blockIdx.x; c.G = gridDim.x; c.gw = c.bid * NWAVES + c.wave; c.ngw = c.G * NWAVES; c.in = nullptr; c.xcur = p->out; c.ws = p->ws;
    return c;
}
struct Bufs {
    bf16 *QN, *KV6, *KC, *VC, *KS, *VS, *KW, *VW, *FQ, *FK, *FV, *DQ, *DK, *DV, *HC, *KCMP, *VCMP, *OCMP, *OWIN, *HN, *ATT;
    float *GATE, *FL, *ROUTE_W; u64* SEL; int* ROUTE_E;
};
__device__ __forceinline__ Bufs make_bufs(unsigned char* ws) {
    Bufs b;
    b.QN = (bf16*)(ws + WS_QN); b.KV6 = (bf16*)(ws + WS_KV6);
    b.KC = (bf16*)(ws + WS_KV6 + 0 * KV6_STRIDE); b.VC = (bf16*)(ws + WS_KV6 + 1 * KV6_STRIDE);
    b.KS = (bf16*)(ws + WS_KV6 + 2 * KV6_STRIDE); b.VS = (bf16*)(ws + WS_KV6 + 3 * KV6_STRIDE);
    b.KW = (bf16*)(ws + WS_KV6 + 4 * KV6_STRIDE); b.VW = (bf16*)(ws + WS_KV6 + 5 * KV6_STRIDE);
    b.FQ = (bf16*)(ws + WS_FQKV); b.FK = b.FQ + 8 * MiB; b.FV = b.FQ + 16 * MiB;
    b.DQ = (bf16*)(ws + WS_DQK); b.DK = b.DQ + 8 * MiB; b.DV = (bf16*)(ws + WS_DV);
    b.GATE = (float*)(ws + WS_GATE); b.FL = (float*)(ws + WS_FL);
    b.HC = (bf16*)(ws + WS_HC); b.KCMP = (bf16*)(ws + WS_KVCMP); b.VCMP = b.KCMP + 16 * 256 * 64;
    b.SEL = (u64*)(ws + WS_SEL); b.OCMP = (bf16*)(ws + WS_OCMP); b.OWIN = (bf16*)(ws + WS_OWIN);
    b.HN = (bf16*)(ws + WS_HN); b.ATT = (bf16*)(ws + WS_ATT);
    b.ROUTE_E = (int*)(ws + WS_ROUTE); b.ROUTE_W = (float*)(ws + WS_ROUTE + 512 * 1024);
    return b;
}
__device__ __forceinline__ float lambda_init_of(int l) { return 0.8f - 0.6f * expf(-0.3f * (float)l); }

__device__ __noinline__ void P_prologue(KP p_) { const KP p = uni_kp(p_);
    const Ctx c = make_ctx(p); unsigned char* ws = p->ws;
    LAS float* scr = (LAS float*)(c.lds) + c.wave * (64 * 33);
    constexpr int I_A = 16 * 40, I_B = 16 * 24, I_C = 16 * 24, I_O = 16 * 32, I_G = 16 * 8, I_D = 4 * 32, I_E = 2 * I_G + I_D, I_W1 = 32 * 8, I_W2 = 4 * 2;
    constexpr int PER_L = I_A + I_B + I_C + I_O + NEXP * I_E + 2 * (I_W1 + I_W2);
    for (int it = c.gw; it < L_ * PER_L; it += c.ngw) {
        const int l = it / PER_L; int r = it % PER_L;
        const float* W; bf16* WT; int ldw, K, sc0, ncol, r0 = 0, rmul = 1;
        if (r < I_A + I_B + I_C) { W = p->in[2] + (size_t)l * D_ * D_IN; WT = (bf16*)(ws + WS_WIN_T) + (size_t)l * NIN * D_; ldw = D_IN; K = D_;
            if (r < I_A) { sc0 = 0; ncol = 1280; r0 = 0; } else if (r < I_A + I_B) { r -= I_A; sc0 = C_FQ; ncol = 768; r0 = 1280; } else { r -= I_A + I_B; sc0 = C_DQ; ncol = 768; r0 = 2048; } }
        else if ((r -= I_A + I_B + I_C) < I_O) { W = p->in[13] + (size_t)l * D_ * D_; WT = (bf16*)(ws + WS_WOUT_T) + (size_t)l * D_ * D_; ldw = D_; K = D_; sc0 = 0; ncol = 1024; }
        else if ((r -= I_O) < NEXP * I_E) { const int e = r / I_E; r = r % I_E; const size_t le = (size_t)l * NEXP + e;
            if (r < 2 * I_G) { const int up = r >= I_G; r -= up * I_G; W = p->in[19 + up] + le * D_ * DEXP; WT = (bf16*)(ws + WS_WGU_T) + le * 512 * D_; ldw = DEXP; K = D_; sc0 = 0; ncol = 256; r0 = up; rmul = 2; }
            else { r -= 2 * I_G; W = p->in[21] + le * DEXP * D_; WT = (bf16*)(ws + WS_WD_T) + le * D_ * DEXP; ldw = D_; K = DEXP; sc0 = 0; ncol = 1024; } }
        else { r -= NEXP * I_E; const int kv = r / (I_W1 + I_W2); r = r % (I_W1 + I_W2); const size_t lk = (size_t)l * 2 + kv;
            if (r < I_W1) { W = p->in[kv == 0 ? 6 : 9] + (size_t)l * 2048 * 256; WT = (bf16*)(ws + WS_W1_T) + lk * 256 * 2048; ldw = 256; K = 2048; sc0 = 0; ncol = 256; }
            else { r -= I_W1; W = p->in[kv == 0 ? 7 : 10] + (size_t)l * 256 * 64; WT = (bf16*)(ws + WS_W2_T) + lk * 64 * 256; ldw = 64; K = 256; sc0 = 0; ncol = 64; } }
        transpose_seg(W, ldw, K, sc0, ncol, WT, r0, rmul, r, scr, c.lane);
    }
    for (int i = c.bid * NTHREADS + c.tid; i < L_ * 256 * D_; i += c.G * NTHREADS) {
        const int l = i / (256 * D_), rr = (i / D_) % 256, k = i % D_;
        const float* win = p->in[2] + (size_t)l * D_ * D_IN;
        float v = 0.f; if (rr < 24) v = win[(size_t)k * D_IN + C_GATE + rr]; else if (rr < 28) v = win[(size_t)k * D_IN + C_FF + (rr - 24)];
        ((bf16*)(ws + WS_WIN_T))[((size_t)l * NIN + 2816 + rr) * D_ + k] = (bf16)f2bf(v);
    }
    for (int w = c.gw; w < L_ * 2 * 4; w += c.ngw) {
        const int l = w / 8, kv = (w / 4) & 1, j = (w & 3) * 64 + c.lane;
        const float* pe = p->in[kv == 0 ? 5 : 8] + (size_t)l * 2048; const float* w1 = p->in[kv == 0 ? 6 : 9] + (size_t)l * 2048 * 256;
        float a = 0.f; for (int k = 0; k < 2048; ++k) a = fmaf(pe[k], w1[(size_t)k * 256 + j], a);
        ((float*)(ws + WS_BIAS1))[(l * 2 + kv) * 256 + j] = a;
    }
}
__device__ __forceinline__ void P_inproj_mfma(int l_) { const KP p = (KP)__builtin_amdgcn_kernarg_segment_ptr(); int l = l_; asm volatile("" : "+s"(l));
    unsigned char* ws = p->ws;
    PlainOrder S; S.init(ws + WS_HN, (const bf16*)(ws + WS_WIN_T) + (size_t)l * NIN * D_, D_, D_, NT, NIN, (int)gridDim.x, (int)blockIdx.x);
    const pg8::Gemm g{D_, D_, D_, D_ / 64};
    const EpiInProj E{ws, p->in[3] + l * 24, p->in[4] + l * 4};
    pg8::gemm_phase<EpiInProj, PlainOrder, true, true>((LAS unsigned char*)lds_raw, g, S, E);
}
__device__ __forceinline__ void P_outproj_mfma(int l_) { const KP p = (KP)__builtin_amdgcn_kernarg_segment_ptr(); int l = l_; asm volatile("" : "+s"(l));
    unsigned char* ws = p->ws;
    PlainOrder S; S.init(ws + WS_ATT, (const bf16*)(ws + WS_WOUT_T) + (size_t)l * D_ * D_, D_, D_, NT, D_, (int)gridDim.x, (int)blockIdx.x);
    const pg8::Gemm g{D_, D_, D_, D_ / 64};
    const EpiResF32 E{(l == 0) ? p->in[0] : p->out, p->out};
    pg8::gemm_phase<EpiResF32, PlainOrder, true, true>((LAS unsigned char*)lds_raw, g, S, E);
}
__device__ __noinline__ void P_norm1(KP p_, int l_) { const KP p = uni_kp(p_); const int l = __builtin_amdgcn_readfirstlane(l_); const Ctx c = make_ctx(p); const Bufs b = make_bufs(p->ws);
    ph_norm_bf16(c, (l == 0) ? p->in[0] : p->out, p->in[1] + (size_t)l * D_, b.HN); }
__device__ __noinline__ void P_inproj(KP p_, int l_) { const KP p = uni_kp(p_); const int l = __builtin_amdgcn_readfirstlane(l_); const Ctx c = make_ctx(p); const Bufs b = make_bufs(p->ws);
    InProjOut o{b.QN, b.KV6, b.FQ, b.DQ, b.DV, b.GATE, b.FL, p->in[3] + l * 24, p->in[4] + l * 4};
    const bf16* A = b.HN;
    naive_gemm(c, NT, D_IN, D_, [=](int r, int k) { return bf2f(A[(size_t)r * D_ + k]); }, p->in[2] + (size_t)l * D_ * D_IN, D_IN,
               [=](int r, int col, float v) { inproj_store(o, r, col, v); }); }
__device__ __noinline__ void P_cmp1(KP p_, int l_, int kv_) { const KP p = uni_kp(p_); const int l = __builtin_amdgcn_readfirstlane(l_), kv = __builtin_amdgcn_readfirstlane(kv_); const Ctx c = make_ctx(p); const Bufs b = make_bufs(p->ws);
    const bf16* src = kv == 0 ? b.KC : b.VC; const float* pe = p->in[kv == 0 ? 5 : 8] + (size_t)l * 2048; bf16* hc = b.HC + (size_t)kv * 4096 * 256;
    naive_gemm(c, 4096, 256, 2048, [=](int r, int k) { return bf2f(src[(size_t)r * 1024 + k]) + pe[k]; }, p->in[kv == 0 ? 6 : 9] + (size_t)l * 2048 * 256, 256,
               [=](int r, int col, float v) { hc[(size_t)r * 256 + col] = (bf16)f2bf(gelu_tanh(v)); }); }
__device__ __noinline__ void P_cumsum(KP p_, int l_) { const KP p = uni_kp(p_); const int l = __builtin_amdgcn_readfirstlane(l_); const Ctx c = make_ctx(p); const Bufs b = make_bufs(p->ws); ph_cumsum(c, b.FL); }
__device__ __noinline__ void P_cmp2(KP p_, int l_, int kv_) { const KP p = uni_kp(p_); const int l = __builtin_amdgcn_readfirstlane(l_), kv = __builtin_amdgcn_readfirstlane(kv_); const Ctx c = make_ctx(p); const Bufs b = make_bufs(p->ws);
    const bf16* hc = b.HC + (size_t)kv * 4096 * 256; bf16* dst = kv == 0 ? b.KCMP : b.VCMP;
    naive_gemm(c, 4096, 64, 256, [=](int r, int k) { return bf2f(hc[(size_t)r * 256 + k]); }, p->in[kv == 0 ? 7 : 10] + (size_t)l * 256 * 64, 64,
               [=](int r, int col, float v) { dst[(size_t)r * 64 + col] = (bf16)f2bf((r & 255) == 255 ? 0.f : v); }); }
__device__ __noinline__ void P_win(KP p_, int l_) { const KP p = uni_kp(p_); const int l = __builtin_amdgcn_readfirstlane(l_); const Ctx c = make_ctx(p); const Bufs b = make_bufs(p->ws); ph_win_attn(c, b.QN, b.KW, b.VW, b.GATE, b.OWIN); }
__device__ __noinline__ void P_fox(KP p_, int l_) { const KP p = uni_kp(p_); const int l = __builtin_amdgcn_readfirstlane(l_); const Ctx c = make_ctx(p); const Bufs b = make_bufs(p->ws); ph_fox_attn(c, b.FQ, b.FK, b.FV, b.FL, b.ATT); }
__device__ __noinline__ void P_diff(KP p_, int l_) { const KP p = uni_kp(p_); const int l = __builtin_amdgcn_readfirstlane(l_); const Ctx c = make_ctx(p); const Bufs b = make_bufs(p->ws);
    ph_diff_attn(c, b.DQ, b.DK, b.DV, p->in[11] + (size_t)l * 128, p->in[12] + (size_t)l * 64, lambda_init_of(l), b.ATT); }
__device__ __noinline__ void P_cmpattn(KP p_, int l_) { const KP p = uni_kp(p_); const int l = __builtin_amdgcn_readfirstlane(l_); const Ctx c = make_ctx(p); const Bufs b = make_bufs(p->ws); ph_cmp_attn(c, b.QN, b.KCMP, b.VCMP, b.GATE, b.SEL, b.OCMP); }
__device__ __noinline__ void P_slc(KP p_, int l_) { const KP p = uni_kp(p_); const int l = __builtin_amdgcn_readfirstlane(l_); const Ctx c = make_ctx(p); const Bufs b = make_bufs(p->ws); ph_slc_attn(c, b.QN, b.KS, b.VS, b.GATE, b.SEL, b.OCMP, b.OWIN, b.ATT); }
__device__ __noinline__ void P_outproj(KP p_, int l_) { const KP p = uni_kp(p_); const int l = __builtin_amdgcn_readfirstlane(l_); const Ctx c = make_ctx(p); const Bufs b = make_bufs(p->ws);
    const bf16* A = b.ATT; float* xo = p->out; const float* xin = (l == 0) ? p->in[0] : p->out;
    naive_gemm(c, NT, D_, D_, [=](int r, int k) { return bf2f(A[(size_t)r * D_ + k]); }, p->in[13] + (size_t)l * D_ * D_, D_,
               [=](int r, int col, float v) { xo[(size_t)r * D_ + col] = xin[(size_t)r * D_ + col] + v; }); }
__device__ __noinline__ void P_route(KP p_, int l_) { const KP p = uni_kp(p_); const int l = __builtin_amdgcn_readfirstlane(l_); const Ctx c = make_ctx(p); const Bufs b = make_bufs(p->ws);
    ph_moe_route(c, p->out, p->in[14] + (size_t)l * D_, p->in[15] + (size_t)l * D_ * 4, p->in[16] + l * 4, p->in[17] + (size_t)l * D_ * 32, p->in[18] + l * 32, b.HN, b.ROUTE_E, b.ROUTE_W); }
__device__ __noinline__ void P_moe(KP p_, int l_) { const KP p = uni_kp(p_); const int l = __builtin_amdgcn_readfirstlane(l_); const Ctx c = make_ctx(p); const Bufs b = make_bufs(p->ws);
    ph_moe_naive(c, b.HN, b.ROUTE_E, b.ROUTE_W, p->in[19] + (size_t)l * NEXP * D_ * DEXP, p->in[20] + (size_t)l * NEXP * D_ * DEXP, p->in[21] + (size_t)l * NEXP * DEXP * D_, p->out); }
__device__ __noinline__ void P_final(KP p_) { const KP p = uni_kp(p_); const Ctx c = make_ctx(p); ph_norm_final(c, p->out, p->in[22]); }
__device__ __noinline__ void P_gridbar(KP p_) { const KP p = uni_kp(p_);
    XcdBarrier bar; bar.bar = (unsigned*)(p->ws + WS_CTL) + 4096; bar.x = xb_xcc_id(); bar.st = (volatile LAS unsigned*)((LAS unsigned char*)lds_raw + MISC_OFF) + 8;
    xcd_barrier(bar);
}

__global__ void __launch_bounds__(NTHREADS, 2) fwd_kernel(Params pp) {
    const KP p = (KP)__builtin_amdgcn_kernarg_segment_ptr();
    { volatile LAS unsigned* MISC = (volatile LAS unsigned*)((LAS unsigned char*)lds_raw + MISC_OFF); if (threadIdx.x < 32) MISC[threadIdx.x] = 0u; }
    __syncthreads();
    const int lo = p->ph_lo, hi = p->ph_hi;
    if (hi - lo > 1) (void)xcd_barrier_post((unsigned*)(p->ws + WS_CTL) + 4096, (volatile LAS unsigned*)((LAS unsigned char*)lds_raw + MISC_OFF) + 8);
#define IN(k) (lo <= (k) && (k) < hi)
#define SEAM(k) do { if (IN(k) && IN((k) + 1)) P_gridbar(p); } while (0)
    if (IN(0)) P_prologue(p);
    SEAM(0);
    for (int l = 0; l < L_; ++l) {
        const int P0 = 1 + l * PH_PER_LAYER;
        if (IN(P0 + 0)) P_norm1(p, l);
        SEAM(P0 + 0);
        if (IN(P0 + 1)) P_inproj_mfma(l);
        SEAM(P0 + 1);
        if (IN(P0 + 2)) { P_cmp1(p, l, 0); P_cmp1(p, l, 1); P_cumsum(p, l); }
        SEAM(P0 + 2);
        if (IN(P0 + 3)) { P_cmp2(p, l, 0); P_cmp2(p, l, 1); P_win(p, l); P_fox(p, l); P_diff(p, l); }
        SEAM(P0 + 3);
        if (IN(P0 + 4)) P_cmpattn(p, l);
        SEAM(P0 + 4);
        if (IN(P0 + 5)) P_slc(p, l);
        SEAM(P0 + 5);
        if (IN(P0 + 6)) P_outproj_mfma(l);
        SEAM(P0 + 6);
        if (IN(P0 + 7)) P_route(p, l);
        SEAM(P0 + 7);
        if (IN(P0 + 8)) P_moe(p, l);
        SEAM(P0 + 8);
    }
    if (IN(1 + L_ * PH_PER_LAYER)) P_final(p);
#undef IN
#undef SEAM
}

extern "C" void kernel_launch(void* const* d_in, const int* in_sizes, int n_in, void* d_out, int out_size, void* d_ws, size_t ws_size, hipStream_t stream) {
    static int grid = 0;
    if (grid == 0) {
        if (n_in != 23 || out_size != NT * D_ || ws_size < WS_END) { fprintf(stderr, "kernel_launch: unexpected sizes n_in %d out %d ws %zu (need %zu)\n", n_in, out_size, ws_size, (size_t)WS_END); grid = -1; return; }
        int dev = 0, cus = 0, per_cu = 0;
        if (hipGetDevice(&dev) != hipSuccess || hipDeviceGetAttribute(&cus, hipDeviceAttributeMultiprocessorCount, dev) != hipSuccess) { grid = -1; return; }
        if (hipFuncSetAttribute((const void*)fwd_kernel, hipFuncAttributeMaxDynamicSharedMemorySize, LDS_BYTES) != hipSuccess) { fprintf(stderr, "kernel_launch: hipFuncSetAttribute failed\n"); grid = -1; return; }
        if (hipOccupancyMaxActiveBlocksPerMultiprocessor(&per_cu, (const void*)fwd_kernel, NTHREADS, LDS_BYTES) != hipSuccess || per_cu < 1) { fprintf(stderr, "kernel_launch: occupancy query says %d\n", per_cu); }
        (void)hipGetLastError();
        grid = cus;
    }
    if (grid < 0) return;
    (void)hipMemsetAsync((char*)d_ws + WS_CTL, 0, CTL_BYTES, stream);
    Params p{};
    for (int i = 0; i < 23; ++i) p.in[i] = (const float*)d_in[i];
    p.out = (float*)d_out; p.ws = (unsigned char*)d_ws;
#if N_LAUNCH_MODE == 0
    p.ph_lo = 0; p.ph_hi = N_PHASES;
    hipLaunchKernelGGL(fwd_kernel, dim3(grid), dim3(NTHREADS), LDS_BYTES, stream, p);
#else
    for (int k = 0; k < N_PHASES; ++k) { p.ph_lo = k; p.ph_hi = k + 1; hipLaunchKernelGGL(fwd_kernel, dim3(grid), dim3(NTHREADS), LDS_BYTES, stream, p); }
#endif
}
```

```cpp
#include <hip/hip_runtime.h>
#include <cstdio>
#include <cstdint>

#ifndef N_LAUNCH_MODE
#define N_LAUNCH_MODE 0
#endif

#define LAS __attribute__((address_space(3)))
#define GAS __attribute__((address_space(1)))
typedef unsigned short bf16;
typedef unsigned long long u64;
typedef float f32x4 __attribute__((ext_vector_type(4)));
typedef unsigned u32x4 __attribute__((ext_vector_type(4)));

constexpr int B_ = 8, T_ = 4096, D_ = 1024, NT = B_ * T_, L_ = 2;
constexpr int HD = 64, D_IN = 2844;
constexpr int N_CMP = 255, CMP_HID = 256;
constexpr int NEXP = 32, DEXP = 256;
constexpr float EPS = 1e-6f;
constexpr float LOG2E = 1.4426950408889634f;
constexpr int NWAVES = 8, NTHREADS = 512;

constexpr int C_NSAQ = 0, C_KV6 = 512, C_GATE = 1280, C_FQ = 1304, C_FF = 2072, C_DQ = 2076, C_DV = 2588;

constexpr size_t MiB = 1u << 20;
constexpr size_t WS_CTL = 0, CTL_BYTES = 1 * MiB;
constexpr size_t WS_QN = 1 * MiB;
constexpr size_t WS_KV6 = WS_QN + 32 * MiB;
constexpr size_t KV6_STRIDE = 8 * MiB + 64 * 1024;
constexpr size_t WS_FQKV = WS_KV6 + 6 * KV6_STRIDE;
constexpr size_t WS_DQK = WS_FQKV + 48 * MiB;
constexpr size_t WS_DV = WS_DQK + 32 * MiB;
constexpr size_t WS_GATE = WS_DV + 16 * MiB;
constexpr size_t WS_FL = WS_GATE + 3 * MiB;
constexpr size_t WS_HC = WS_FL + 1 * MiB;
constexpr size_t WS_KVCMP = WS_HC + 4 * MiB;
constexpr size_t WS_SEL = WS_KVCMP + 1 * MiB;
constexpr size_t WS_OCMP = WS_SEL + 1 * MiB;
constexpr size_t WS_OWIN = WS_OCMP + 32 * MiB;
constexpr size_t WS_HN = WS_OWIN + 32 * MiB;
constexpr size_t WS_ATT = WS_HN + 64 * MiB;
constexpr size_t WS_ROUTE = WS_ATT + 64 * MiB;
constexpr size_t WS_WIN_T = WS_ROUTE + 1 * MiB;
constexpr size_t WS_WOUT_T = WS_WIN_T + 12 * MiB;
constexpr size_t WS_WGU_T = WS_WOUT_T + 4 * MiB;
constexpr size_t WS_WD_T = WS_WGU_T + 64 * MiB;
constexpr size_t WS_W1_T = WS_WD_T + 32 * MiB;
constexpr size_t WS_W2_T = WS_W1_T + 4 * MiB;
constexpr size_t WS_BIAS1 = WS_W2_T + 512 * 1024;
constexpr size_t WS_END = WS_BIAS1 + 512 * 1024;
constexpr int NIN = 3072;

__device__ __forceinline__ float bf2f(bf16 v) { return __uint_as_float(((unsigned)v) << 16); }
__device__ __forceinline__ unsigned f2bf(float f) { unsigned u = __float_as_uint(f); return (u + 0x7fffu + ((u >> 16) & 1u)) >> 16; }
__device__ __forceinline__ unsigned pk2(float lo, float hi) { return f2bf(lo) | (f2bf(hi) << 16); }
__device__ __forceinline__ float wave_sum(float v) {
#pragma unroll
    for (int o = 1; o < 64; o <<= 1) v += __shfl_xor(v, o);
    return v;
}
__device__ __forceinline__ float wave_max(float v) {
#pragma unroll
    for (int o = 1; o < 64; o <<= 1) v = fmaxf(v, __shfl_xor(v, o));
    return v;
}
__device__ __forceinline__ float sigmoidf_(float x) { return 1.f / (1.f + __expf(-x)); }
__device__ __forceinline__ float log_sigmoidf_(float x) { return x >= 0.f ? -log1pf(__expf(-x)) : x - log1pf(__expf(x)); }
__device__ __forceinline__ float gelu_tanh(float x) { const float u = 0.7978845608028654f * (x + 0.044715f * x * x * x); return 0.5f * x * (1.f + tanhf(u)); }
__device__ __forceinline__ float alibi_slope(int idx1, int n) { return exp2f(-8.0f * (float)idx1 / (float)n); }

#define XB_TMO      128
#define XB_XCNT(j)  (256  + 64 * (j))
#define XB_XSUB(j)  (1280 + 64 * (j))
#define XB_XGEN(j)  (2304 + 64 * (j))
#define XB_TOP      3328
#define XB_TOPGEN   3392
#define XCD_BAR_WORDS 3456
#define XB_SPIN_CAP (1u << 25)
__device__ __forceinline__ unsigned xb_ld(unsigned* p)              { return __hip_atomic_load(p, __ATOMIC_RELAXED, __HIP_MEMORY_SCOPE_AGENT); }
__device__ __forceinline__ unsigned xb_add(unsigned* p, unsigned v) { return __hip_atomic_fetch_add(p, v, __ATOMIC_RELAXED, __HIP_MEMORY_SCOPE_AGENT); }
__device__ __forceinline__ unsigned xb_xcc_id() { return (unsigned)__builtin_amdgcn_s_getreg((3 << 11) | 20) & 0xFu; }
#define XB_SPIN(cond, bar) do { unsigned _sp = 0; while (cond) { __builtin_amdgcn_s_sleep(1); \
    if ((++_sp & 255u) == 0u) { if (xb_ld(&(bar)[XB_TMO])) break; if (_sp > XB_SPIN_CAP) { atomicAdd(&(bar)[XB_TMO], 1u); break; } } } } while (0)
struct XcdBarrier { unsigned* bar; unsigned x; volatile LAS unsigned* st; };
__device__ __forceinline__ XcdBarrier xcd_barrier_post(unsigned* bar, volatile LAS unsigned* st) {
    XcdBarrier b; b.bar = bar; b.x = xb_xcc_id(); b.st = st;
    if (threadIdx.x == 0) (void)xb_add(&bar[XB_XCNT(b.x)], 1u);
    return b;
}
__device__ __forceinline__ void xcd_barrier_complete(unsigned* bar, unsigned x, unsigned& nloc, unsigned& nx) {
    const unsigned G = gridDim.x * gridDim.y * gridDim.z;
    unsigned sum, cnt, mine, sp = 0u;
    for (;;) {
        sum = 0u; cnt = 0u; mine = 0u;
#pragma unroll
        for (unsigned j = 0; j < 16; ++j) { const unsigned c = xb_ld(&bar[XB_XCNT(j)]); sum += c; cnt += (c > 0u) ? 1u : 0u; mine = (j == x) ? c : mine; }
        if (sum == G) break;
        __builtin_amdgcn_s_sleep(1);
        if ((++sp & 255u) == 0u) { if (xb_ld(&bar[XB_TMO])) break; if (sp > XB_SPIN_CAP) { atomicAdd(&bar[XB_TMO], 1u); break; } }
    }
    nloc = mine > 0u ? mine : 1u; nx = cnt > 0u ? cnt : 1u;
}
__device__ __forceinline__ void xcd_barrier(const XcdBarrier& b) {
    asm volatile("s_waitcnt vmcnt(0)" ::: "memory");
    __syncthreads();
    if (threadIdx.x == 0) {
        unsigned* bar = b.bar;
        __builtin_amdgcn_s_waitcnt(0);
        unsigned nloc = b.st[0], nx = b.st[1];
        if (nloc == 0u) { xcd_barrier_complete(bar, b.x, nloc, nx); b.st[0] = nloc; b.st[1] = nx; }
        const unsigned old = xb_add(&bar[XB_XSUB(b.x)], 1u);
        const unsigned gen = old / nloc;
        if (old + 1u == (gen + 1u) * nloc) {
            __builtin_amdgcn_fence(__ATOMIC_RELEASE, "agent");
            asm volatile("s_waitcnt vmcnt(0)" ::: "memory");
            const unsigned og = xb_add(&bar[XB_TOP], 1u);
            const unsigned tg = og / nx;
            if (og + 1u == (tg + 1u) * nx) xb_add(&bar[XB_TOPGEN], 1u);
            else XB_SPIN(xb_ld(&bar[XB_TOPGEN]) == tg, bar);
            __builtin_amdgcn_fence(__ATOMIC_ACQUIRE, "agent");
            xb_add(&bar[XB_XGEN(b.x)], 1u);
            asm volatile("s_waitcnt vmcnt(0)" ::: "memory");
        } else {
            XB_SPIN(xb_ld(&bar[XB_XGEN(b.x)]) == gen, bar);
            __builtin_amdgcn_fence(__ATOMIC_ACQUIRE, "agent");
            asm volatile("s_waitcnt vmcnt(0)" ::: "memory");
        }
    }
    __syncthreads();
}

struct Params { const float* in[23]; float* out; unsigned char* ws; int ph_lo, ph_hi; };
constexpr int LDS_BYTES = 147456;
constexpr int MISC_OFF = 131072 + 320;

struct Ctx {
    LAS unsigned char* lds; int tid, lane, wave, bid, G, gw, ngw;
    const float* const* in; float* xcur; unsigned char* ws;
};

namespace pg8 {
#define PG8_LAS __attribute__((address_space(3)))
typedef unsigned short bf16_t;
typedef short bf16x8 __attribute__((ext_vector_type(8)));
typedef float f32x4 __attribute__((ext_vector_type(4)));
typedef unsigned u32x4 __attribute__((ext_vector_type(4)));
constexpr int BM = 256, BK = 64, HALF = 128, HTB = HALF * BK * 2  , STAGE_BYTES = 8 * HTB, NXCD = 8, WGM = 8;

__host__ __device__ __forceinline__ int lds_byte(int r, int c) { const int st = (r >> 4) * 2 + (c >> 5), rr = r & 15, cc = c & 31, ob = rr * 64 + cc * 2; return st * 1024 + (ob ^ (((ob >> 9) & 1) << 5)); }
__host__ __device__ __forceinline__ void stage_rc(int b, int& R, int& C) { const int st = b / 1024, sb = b % 1024, swz = sb ^ (((sb >> 9) & 1) << 5); R = (st >> 1) * 16 + swz / 64; C = (st & 1) * 32 + (swz % 64) / 2; }
__host__ __device__ __forceinline__ int perm32(int rho) { const int n = rho >> 4, i = rho & 15; return 8 * (i >> 2) + 4 * n + (i & 3); }

struct Unit { int pm, pn; const char* a; const char* b; const char* b2; };
struct Gemm { int lda, ldb, K, ksplit; };

__device__ __forceinline__ unsigned cvt_pk_bf16(float lo, float hi) { unsigned r; asm volatile("v_cvt_pk_bf16_f32 %0, %1, %2" : "=v"(r) : "v"(lo), "v"(hi)); return r; }
typedef float f32x2 __attribute__((ext_vector_type(2)));

template <class Epi, class Sched, bool ALIGN_EPI = false, bool SP2 = false>
__device__ __forceinline__ void gemm_phase(PG8_LAS unsigned char* lds, const Gemm g, const Sched& S, const Epi& E) {
    int tid_ = threadIdx.x; asm volatile("" : "+v"(tid_));
    const int tid = tid_, wid = __builtin_amdgcn_readfirstlane(tid >> 6), lane = tid & 63, wr = wid >> 2, wc = wid & 3, fr = lane & 15, fq = lane >> 4;
    const int K = g.K, nt = K / BK, ks = g.ksplit;
    unsigned voffA[2], voffB[2];
#pragma unroll
    for (int i = 0; i < 2; ++i) { int R, C; stage_rc(tid * 16 + i * 8192, R, C); const int Rb = Epi::PERM ? ((R & ~31) + perm32(R & 31)) : R;
        voffA[i] = (unsigned)(R * g.lda + C) * 2u; voffB[i] = (unsigned)(Rb * g.ldb + C) * 2u; }
    const size_t kstep = (size_t)(BK * 2);
    const size_t hsA = (size_t)HALF * g.lda * 2, hsB = (size_t)HALF * g.ldb * 2;
    const unsigned ldsw = (unsigned)wid * 1024u;
    const int aoff = lds_byte(wr * 64 + fr, fq * 8), boff = lds_byte(wc * 32 + fr, fq * 8);
#define PG8_SA(b, h) (((b) * 2 + (h)) * HTB)
#define PG8_SB(b, h) ((4 + (b) * 2 + (h)) * HTB)
#define PG8_STAGE(bufoff, gbase, voff) do { _Pragma("unroll") for (int _i = 0; _i < 2; ++_i) \
        __builtin_amdgcn_global_load_lds((const unsigned*)((const char*)(gbase) + (voff)[_i]), (PG8_LAS unsigned*)(lds + (bufoff) + ldsw + _i * 8192), 16, 0, 0); } while (0)
#define PG8_LDA(dst, b, h) do { _Pragma("unroll") for (int m = 0; m < 4; ++m) _Pragma("unroll") for (int k = 0; k < 2; ++k) dst[m][k] = *(const PG8_LAS bf16x8*)(lds + PG8_SA(b, h) + aoff + m * 2048 + k * 1024); } while (0)
#define PG8_LDB(dst, b, h) do { _Pragma("unroll") for (int n = 0; n < 2; ++n) _Pragma("unroll") for (int k = 0; k < 2; ++k) dst[n][k] = *(const PG8_LAS bf16x8*)(lds + PG8_SB(b, h) + boff + n * 2048 + k * 1024); } while (0)
#define PG8_MMA(ai, bj, At, Bt) do { __builtin_amdgcn_s_setprio(1); _Pragma("unroll") for (int m = 0; m < 4; ++m) _Pragma("unroll") for (int n = 0; n < 2; ++n) _Pragma("unroll") for (int k = 0; k < 2; ++k) \
        acc[ai][bj][m][n] = __builtin_amdgcn_mfma_f32_16x16x32_bf16(Bt[n][k], At[m][k], acc[ai][bj][m][n], 0, 0, 0); __builtin_amdgcn_s_setprio(0); } while (0)
#define PG8_WAIT_V(n) asm volatile("s_waitcnt vmcnt(" #n ")" ::: "memory")
#define PG8_WAIT_L(n) asm volatile("s_waitcnt lgkmcnt(" #n ")" ::: "memory")
#define PG8_BAR __builtin_amdgcn_s_barrier()
#define PG8_SCHED __builtin_amdgcn_sched_barrier(0)
    Unit cur, nxt; int ui = 0;
    if (!S.next(0, cur)) return;
    f32x4 acc[2][2][4][2];
#pragma unroll
    for (int a = 0; a < 2; ++a)
#pragma unroll
        for (int b = 0; b < 2; ++b)
#pragma unroll
            for (int m = 0; m < 4; ++m)
#pragma unroll
                for (int n = 0; n < 2; ++n) acc[a][b][m][n] = (f32x4){0.f, 0.f, 0.f, 0.f};
    bf16x8 At[4][2], B0[2][2], B1[2][2];
    const char* cA = cur.a; const char* cB = cur.b; const char* cB2 = cur.b2;
#define PG8_BK(base, base2, kt) ((kt) < ks ? (base) + (size_t)(kt) * kstep : (base2) + (size_t)((kt) - ks) * kstep)
    S.a_ready(cur);
    if constexpr (SP2) {
        PG8_STAGE(PG8_SB(0, 0), cB, voffB); PG8_STAGE(PG8_SB(0, 1), cB + hsB, voffB); PG8_STAGE(PG8_SA(0, 0), cA, voffA); PG8_STAGE(PG8_SA(0, 1), cA + hsA, voffA);
        if (wr == 1) PG8_BAR;
        PG8_WAIT_V(2); PG8_BAR;
        PG8_STAGE(PG8_SB(1, 0), PG8_BK(cB, cB2, 1), voffB); PG8_STAGE(PG8_SA(1, 0), cA + kstep, voffA); PG8_STAGE(PG8_SB(1, 1), PG8_BK(cB, cB2, 1) + hsB, voffB);
        PG8_WAIT_V(6); PG8_BAR;
    } else {
        PG8_STAGE(PG8_SB(0, 0), cB, voffB); PG8_STAGE(PG8_SA(0, 0), cA, voffA); PG8_STAGE(PG8_SB(0, 1), cB + hsB, voffB); PG8_STAGE(PG8_SA(0, 1), cA + hsA, voffA);
        if (wr == 1) PG8_BAR;
        PG8_WAIT_V(4); PG8_BAR;
        PG8_STAGE(PG8_SB(1, 0), PG8_BK(cB, cB2, 1), voffB); PG8_STAGE(PG8_SA(1, 0), cA + kstep, voffA); PG8_STAGE(PG8_SB(1, 1), PG8_BK(cB, cB2, 1) + hsB, voffB);
        PG8_WAIT_V(6); PG8_BAR;
    }
    for (;;) {
        const bool has_next = S.next(ui + 1, nxt);
        const char* nA = has_next ? nxt.a : cA; const char* nB = has_next ? nxt.b : cB; const char* nB2 = has_next ? nxt.b2 : cB2;
        for (int t = 0; t < nt; t += 2) {
            const bool last = (t == nt - 2);
            const char* a1 = cA + (size_t)(t + 1) * kstep;
            const char* a2 = last ? nA : cA + (size_t)(t + 2) * kstep; const char* b2 = last ? PG8_BK(nB, nB2, 0) : PG8_BK(cB, cB2, t + 2);
            const char* a3 = a2 + kstep; const char* b3 = last ? PG8_BK(nB, nB2, 1) : PG8_BK(cB, cB2, t + 3);
            if (last && has_next) S.a_ready(nxt);
            if constexpr (SP2) {
            PG8_LDB(B0, 0, 0); PG8_LDB(B1, 0, 1); PG8_SCHED; PG8_LDA(At, 0, 0); PG8_STAGE(PG8_SA(1, 1), a1 + hsA, voffA);
            PG8_WAIT_V(8); PG8_WAIT_L(0); PG8_BAR; PG8_MMA(0, 0, At, B0); PG8_MMA(0, 1, At, B1); PG8_BAR; PG8_SCHED;
            PG8_LDA(At, 0, 1); PG8_STAGE(PG8_SB(0, 0), b2, voffB); PG8_STAGE(PG8_SB(0, 1), b2 + hsB, voffB); PG8_STAGE(PG8_SA(0, 0), a2, voffA);
            PG8_WAIT_V(8); PG8_WAIT_L(0); PG8_BAR; PG8_MMA(1, 0, At, B0); PG8_MMA(1, 1, At, B1); PG8_BAR; PG8_SCHED;
            PG8_LDB(B0, 1, 0); PG8_LDB(B1, 1, 1); PG8_SCHED; PG8_LDA(At, 1, 0); PG8_STAGE(PG8_SA(0, 1), a2 + hsA, voffA);
            PG8_WAIT_V(8); PG8_WAIT_L(0); PG8_BAR; PG8_MMA(0, 0, At, B0); PG8_MMA(0, 1, At, B1); PG8_BAR; PG8_SCHED;
            PG8_LDA(At, 1, 1); PG8_STAGE(PG8_SB(1, 0), b3, voffB); PG8_STAGE(PG8_SB(1, 1), b3 + hsB, voffB); PG8_STAGE(PG8_SA(1, 0), a3, voffA);
            PG8_WAIT_V(8); PG8_WAIT_L(0); PG8_BAR; PG8_MMA(1, 0, At, B0); PG8_MMA(1, 1, At, B1); PG8_BAR; PG8_SCHED;
            } else {
            PG8_LDB(B0, 0, 0); PG8_SCHED; PG8_LDA(At, 0, 0); PG8_STAGE(PG8_SA(1, 1), a1 + hsA, voffA);
            PG8_WAIT_L(8); PG8_BAR; PG8_WAIT_L(0); PG8_MMA(0, 0, At, B0); PG8_BAR; PG8_SCHED;
            PG8_LDB(B1, 0, 1); PG8_STAGE(PG8_SB(0, 0), b2, voffB);
            PG8_BAR; PG8_WAIT_L(0); PG8_MMA(0, 1, At, B1); PG8_BAR;
            PG8_LDA(At, 0, 1); PG8_STAGE(PG8_SA(0, 0), a2, voffA);
            PG8_BAR; PG8_WAIT_L(0); PG8_MMA(1, 0, At, B0); PG8_BAR; PG8_SCHED;
            PG8_STAGE(PG8_SB(0, 1), b2 + hsB, voffB);
            PG8_WAIT_V(6); PG8_BAR; PG8_MMA(1, 1, At, B1); PG8_BAR;
            PG8_LDB(B0, 1, 0); PG8_SCHED; PG8_LDA(At, 1, 0); PG8_STAGE(PG8_SA(0, 1), a2 + hsA, voffA);
            PG8_WAIT_L(8); PG8_BAR; PG8_WAIT_L(0); PG8_MMA(0, 0, At, B0); PG8_BAR; PG8_SCHED;
            PG8_LDB(B1, 1, 1); PG8_STAGE(PG8_SB(1, 0), b3, voffB);
            PG8_BAR; PG8_WAIT_L(0); PG8_MMA(0, 1, At, B1); PG8_BAR;
            PG8_LDA(At, 1, 1); PG8_STAGE(PG8_SA(1, 0), a3, voffA);
            PG8_BAR; PG8_WAIT_L(0); PG8_MMA(1, 0, At, B0); PG8_BAR; PG8_SCHED;
            PG8_STAGE(PG8_SB(1, 1), b3 + hsB, voffB);
            PG8_WAIT_V(6); PG8_BAR; PG8_MMA(1, 1, At, B1); PG8_BAR;
            }
        }
        if constexpr (ALIGN_EPI) { if (wr == 0) PG8_BAR; }
        if constexpr (!Epi::AFTER_DRAIN) { E(acc, cur, wr, wc, fr, fq); S.done(cur); }
        if (!has_next) break;
#pragma unroll
        for (int a = 0; a < 2; ++a)
#pragma unroll
            for (int b = 0; b < 2; ++b)
#pragma unroll
                for (int m = 0; m < 4; ++m)
#pragma unroll
                    for (int n = 0; n < 2; ++n) acc[a][b][m][n] = (f32x4){0.f, 0.f, 0.f, 0.f};
        cur = nxt; cA = nA; cB = nB; cB2 = nB2; ++ui;
        if constexpr (ALIGN_EPI) { if (wr == 1) PG8_BAR; }
    }
    PG8_WAIT_V(0);
    if constexpr (!ALIGN_EPI) { if (wr == 0) PG8_BAR; }
    PG8_BAR;
    if constexpr (Epi::AFTER_DRAIN) { E.fused(acc, cur, wr, wc, fr, fq, lds, wid, lane); S.done(cur); }
#undef PG8_BK
#undef PG8_SA
#undef PG8_SB
#undef PG8_STAGE
#undef PG8_LDA
#undef PG8_LDB
#undef PG8_MMA
#undef PG8_WAIT_V
#undef PG8_WAIT_L
#undef PG8_BAR
#undef PG8_SCHED
}
}

struct PlainOrder {
    const char* A; const char* Bt; int lda, ldb, nM, nN, nwg, G, c;
    __device__ __forceinline__ void init(const void* A_, const void* Bt_, int lda_, int ldb_, int M, int N, int G_, int c_) { A = (const char*)A_; Bt = (const char*)Bt_; lda = lda_; ldb = ldb_; nM = M / 256; nN = N / 256; nwg = nM * nN; G = G_; c = c_; }
    __device__ __forceinline__ bool next(int i, pg8::Unit& u) const {
        const long L = (long)i * G + c; if (L >= nwg) return false;
        int wgid = (int)L; { const int q = nwg / 8, r = nwg % 8, xcd = wgid % 8, off = wgid / 8; wgid = (xcd < r ? xcd * (q + 1) : r * (q + 1) + (xcd - r) * q) + off; }
        const int nig = 8 * nN, gid = wgid / nig, fm = gid * 8, gsz = (nM - fm) < 8 ? (nM - fm) : 8;
        u.pm = fm + ((wgid % nig) % gsz); u.pn = (wgid % nig) / gsz;
        u.a = A + (size_t)u.pm * 256 * lda * 2; u.b = Bt + (size_t)u.pn * 256 * ldb * 2; u.b2 = u.b; return true;
    }
    __device__ __forceinline__ void a_ready(const pg8::Unit&) const {}
    __device__ __forceinline__ void done(const pg8::Unit&) const {}
};
struct EpiInProj {
    static constexpr bool PERM = true, AFTER_DRAIN = false;
    unsigned char* ws; const float* b_gate; const float* b_fgt;
    __device__ __forceinline__ void operator()(const pg8::f32x4 (&acc)[2][2][4][2], const pg8::Unit& u, int wr, int wc, int fr, int fq) const {
        asm volatile("" : "+v"(fr), "+v"(fq));
        const int pn = u.pn, b = (u.pm * 256) / T_, t0 = u.pm * 256 - b * T_ + wr * 64 + fr;
        if (pn == 11) {
            if (wc == 0 && fq < 4) {
                float* gate = (float*)(ws + WS_GATE); float* fl = (float*)(ws + WS_FL);
#pragma unroll
                for (int ai = 0; ai < 2; ++ai)
#pragma unroll
                    for (int m = 0; m < 4; ++m) { const int t = t0 + ai * 128 + m * 16; const size_t n = (size_t)b * T_ + t;
#pragma unroll
                        for (int nn = 0; nn < 2; ++nn)
#pragma unroll
                            for (int e = 0; e < 4; ++e) { const int c = 8 * fq + 4 * nn + e; const float v = acc[ai][0][m][nn][e];
                                if (c < 24) gate[n * 24 + c] = sigmoidf_(v + b_gate[c]);
                                else if (c < 28) fl[(size_t)(b * 4 + (c - 24)) * T_ + t] = log_sigmoidf_(v + b_fgt[c - 24]); } }
            }
            return;
        }
#pragma unroll
        for (int bj = 0; bj < 2; ++bj) {
            const int c = bj * 128 + wc * 32 + 8 * fq;
            bf16* base; int W = 64; float sc = 1.f;
            if (pn < 2) { base = (bf16*)(ws + WS_QN) + (size_t)(b * 8 + pn * 4 + (c >> 6)) * T_ * 64 + (c & 63); sc = 0.125f * LOG2E; }
            else if (pn < 5) { base = (bf16*)(ws + WS_KV6 + (size_t)((pn - 2) * 2 + (c >> 7)) * KV6_STRIDE) + (size_t)(b * 2 + ((c >> 6) & 1)) * T_ * 64 + (c & 63); }
            else if (pn < 8) { base = (bf16*)(ws + WS_FQKV) + (size_t)(pn - 5) * (8 * MiB) + (size_t)(b * 4 + (c >> 6)) * T_ * 64 + (c & 63); if (pn == 5) sc = 0.125f * LOG2E; }
            else if (pn < 10) { base = (bf16*)(ws + WS_DQK) + (size_t)(pn - 8) * (8 * MiB) + (size_t)(b * 8 + (c >> 5)) * T_ * 32 + (c & 31); W = 32; if (pn == 8) sc = 0.17677669529663687f * LOG2E; }
            else { base = (bf16*)(ws + WS_DV) + (size_t)(b * 4 + (c >> 6)) * T_ * 64 + (c & 63); }
#pragma unroll
            for (int ai = 0; ai < 2; ++ai)
#pragma unroll
                for (int m = 0; m < 4; ++m) { const int t = t0 + ai * 128 + m * 16;
                    const pg8::f32x4 v0 = acc[ai][bj][m][0] * sc, v1 = acc[ai][bj][m][1] * sc;
                    pg8::u32x4 w; w.x = pg8::cvt_pk_bf16(v0[0], v0[1]); w.y = pg8::cvt_pk_bf16(v0[2], v0[3]); w.z = pg8::cvt_pk_bf16(v1[0], v1[1]); w.w = pg8::cvt_pk_bf16(v1[2], v1[3]);
                    *(pg8::u32x4*)(base + (size_t)t * W) = w; }
        }
    }
};
struct EpiResF32 {
    static constexpr bool PERM = false, AFTER_DRAIN = false;
    const float* base; float* out;
    __device__ __forceinline__ void operator()(const pg8::f32x4 (&acc)[2][2][4][2], const pg8::Unit& u, int wr, int wc, int fr, int fq) const {
        asm volatile("" : "+v"(fr), "+v"(fq));
#pragma unroll
        for (int ai = 0; ai < 2; ++ai)
#pragma unroll
            for (int m = 0; m < 4; ++m) { const size_t off = (size_t)(u.pm * 256 + ai * 128 + wr * 64 + m * 16 + fr) * D_ + u.pn * 256 + wc * 32 + 4 * fq;
#pragma unroll
                for (int bj = 0; bj < 2; ++bj)
#pragma unroll
                    for (int n = 0; n < 2; ++n) { const pg8::f32x4 bs = *(const pg8::f32x4*)(base + off + bj * 128 + n * 16); *(pg8::f32x4*)(out + off + bj * 128 + n * 16) = bs + acc[ai][bj][m][n]; } }
    }
};

__device__ __forceinline__ void transpose_item(const float* W, int ldw, bf16* WT, int ldt, int r0, int rmul, int k0, LAS float* scr, int lane) {
#pragma unroll 8
    for (int i = 0; i < 32; ++i) { const int kk = 2 * i + (lane >> 5); scr[kk * 33 + (lane & 31)] = W[(size_t)(k0 + kk) * ldw + (lane & 31)]; }
    asm volatile("s_waitcnt lgkmcnt(0)" ::: "memory");
    const int c = lane & 7;
#pragma unroll
    for (int j = 0; j < 4; ++j) { const int n = (lane >> 3) + 8 * j; const LAS float* sp = scr + (8 * c) * 33 + n;
        u32x4 o; o.x = pk2(sp[0 * 33], sp[1 * 33]); o.y = pk2(sp[2 * 33], sp[3 * 33]); o.z = pk2(sp[4 * 33], sp[5 * 33]); o.w = pk2(sp[6 * 33], sp[7 * 33]);
        *(u32x4*)(WT + (size_t)(r0 + rmul * n) * ldt + k0 + 8 * c) = o; }
    asm volatile("s_waitcnt lgkmcnt(0)" ::: "memory");
}
__device__ __forceinline__ void transpose_seg(const float* W, int ldw, int K, int sc0, int ncol, bf16* WT, int r0, int rmul, int item, LAS float* scr, int lane) {
    const int nb = ncol / 32, kb = item / nb, cb = item % nb;
    transpose_item(W + sc0 + cb * 32, ldw, WT, K, r0 + rmul * cb * 32, rmul, kb * 64, scr, lane);
}

typedef float f32x16 __attribute__((ext_vector_type(16)));
typedef short bf16x8v __attribute__((ext_vector_type(8)));
typedef short s16x4 __attribute__((ext_vector_type(4)));
typedef float f32x2_t __attribute__((ext_vector_type(2)));
typedef __bf16 bf16x2_t __attribute__((ext_vector_type(2)));
constexpr int A_KBUF = 10240, A_VBUF = 9216;
constexpr int A_KOFF = 0, A_VOFF = 2 * A_KBUF, A_BOFF = A_VOFF + 2 * A_VBUF, A_LDS_END = A_BOFF + 2 * 256;
__device__ __forceinline__ constexpr int crow0(int reg) { return (reg & 3) + 8 * (reg >> 2); }
__device__ __forceinline__ float swap_max(float m) { auto rr = __builtin_amdgcn_permlane32_swap(__float_as_uint(m), __float_as_uint(m), false, false); return fmaxf(__uint_as_float(rr[0]), __uint_as_float(rr[1])); }
__device__ __forceinline__ float swap_sum(float m) { auto rr = __builtin_amdgcn_permlane32_swap(__float_as_uint(m), __float_as_uint(m), false, false); return __uint_as_float(rr[0]) + __uint_as_float(rr[1]); }
__device__ __forceinline__ unsigned cvtpk(float lo, float hi) { f32x2_t v = {lo, hi}; bf16x2_t b = __builtin_convertvector(v, bf16x2_t); return __builtin_bit_cast(unsigned, b); }
__device__ __forceinline__ bf16x8v pack8(const f32x16& p, int b0) { u32x4 w; w.x = cvtpk(p[b0 + 0], p[b0 + 1]); w.y = cvtpk(p[b0 + 2], p[b0 + 3]); w.z = cvtpk(p[b0 + 4], p[b0 + 5]); w.w = cvtpk(p[b0 + 6], p[b0 + 7]); return __builtin_bit_cast(bf16x8v, w); }
__device__ __forceinline__ s16x4 tr_read(const LAS unsigned char* p) { typedef short v4i16_t __attribute__((ext_vector_type(4))); return __builtin_bit_cast(s16x4, __builtin_amdgcn_ds_read_tr16_b64_v4i16((LAS v4i16_t*)p)); }

template <int DQK, int NMAP, bool FOX, bool SLC>
__device__ __forceinline__ void attn_core(LAS unsigned char* L, const bf16* Kb0, const bf16* Kb1, const bf16* Vb, const float* cum, float cum_ref,
                                          const bf16x8v (&Qf)[NMAP][DQK / 16], u64 tilemask, int t_lane, int tw0, int win, float slope2, unsigned selw0, unsigned selw1,
                                          f32x16 (&O)[NMAP][2], float (&M)[NMAP], float (&Ls)[NMAP], int tid) {
    constexpr int KP = DQK * 2 + 16;
    const int lane = tid & 63, r = lane & 31, h = lane >> 5;
    int kdst; const bf16* ksrc;
    if (DQK == 64) { kdst = (tid >> 3) * KP + (tid & 7) * 16; ksrc = Kb0 + (tid >> 3) * 64 + (tid & 7) * 8; }
    else { const int mp = tid >> 8, tt = tid & 255; kdst = mp * 5120 + (tt >> 2) * KP + (tt & 3) * 16; ksrc = (mp ? Kb1 : Kb0) + (tt >> 2) * 32 + (tt & 3) * 8; }
    const int vdst = (tid >> 3) * 144 + (tid & 7) * 16; const bf16* vsrc = Vb + (tid >> 3) * 64 + (tid & 7) * 8;
    const LAS unsigned char* kfrag = L + A_KOFF + r * KP + h * 16;
    const LAS unsigned char* vfrag = L + A_VOFF + (4 * h + ((lane & 15) >> 2)) * 144 + (16 * ((lane >> 4) & 1) + 4 * (lane & 3)) * 2;
    u32x4 kreg, vreg; float breg = 0.f;
    u64 mk = tilemask;
    int j = 63 - __builtin_clzll(mk); mk &= ~(1ull << j);
    { const int kv0 = j * 64; kreg = *(const u32x4*)(ksrc + (size_t)kv0 * DQK); vreg = *(const u32x4*)(vsrc + (size_t)kv0 * 64); if (FOX && tid < 64) breg = (cum_ref - cum[kv0 + tid]) * LOG2E; }
    *(LAS u32x4*)(L + A_KOFF + kdst) = kreg; *(LAS u32x4*)(L + A_VOFF + vdst) = vreg; if (FOX && tid < 64) *(LAS float*)(L + A_BOFF + tid * 4) = breg;
    __syncthreads();
    int buf = 0;
    for (;;) {
        const bool more = mk != 0ull; int jn = 0;
        if (more) { jn = 63 - __builtin_clzll(mk); mk &= ~(1ull << jn); const int kv0 = jn * 64;
            kreg = *(const u32x4*)(ksrc + (size_t)kv0 * DQK); vreg = *(const u32x4*)(vsrc + (size_t)kv0 * 64); if (FOX && tid < 64) breg = (cum_ref - cum[kv0 + tid]) * LOG2E; }
        { const int kv0 = j * 64;
          if (!(kv0 > tw0 + 31) && !(tw0 - (kv0 + 63) >= win)) {
            const bool need_mask = (kv0 + 63 > tw0) || (tw0 + 31 - kv0 >= win);
            const int dl = t_lane - kv0 - 4 * h;
            bool sel = true; if (SLC) sel = (j < 32 ? (selw0 >> j) : (selw1 >> (j - 32))) & 1u;
            bf16x8v pa[NMAP][4];
#pragma unroll
            for (int mp = 0; mp < NMAP; ++mp) {
                f32x16 p0, p1;
                if (FOX) { const LAS f32x4* bl = (const LAS f32x4*)(L + A_BOFF + buf * 256) + h;
#pragma unroll
                    for (int g4 = 0; g4 < 4; ++g4) { const f32x4 b0 = bl[2 * g4], b1 = bl[8 + 2 * g4];
                        p0[4 * g4 + 0] = b0.x; p0[4 * g4 + 1] = b0.y; p0[4 * g4 + 2] = b0.z; p0[4 * g4 + 3] = b0.w; p1[4 * g4 + 0] = b1.x; p1[4 * g4 + 1] = b1.y; p1[4 * g4 + 2] = b1.z; p1[4 * g4 + 3] = b1.w; } }
                else { const float base_l = slope2 * (float)(kv0 + 4 * h - tw0);
#pragma unroll
                    for (int reg = 0; reg < 16; ++reg) { p0[reg] = fmaf(slope2, (float)crow0(reg), base_l); p1[reg] = fmaf(slope2, (float)(crow0(reg) + 32), base_l); } }
                const LAS unsigned char* kb = kfrag + buf * A_KBUF + (DQK == 32 ? mp * 5120 : 0);
#pragma unroll
                for (int s = 0; s < DQK / 16; ++s) { const bf16x8v kf0 = *(const LAS bf16x8v*)(kb + s * 32), kf1 = *(const LAS bf16x8v*)(kb + 32 * KP + s * 32);
                    p0 = __builtin_amdgcn_mfma_f32_32x32x16_bf16(kf0, Qf[mp][s], p0, 0, 0, 0); p1 = __builtin_amdgcn_mfma_f32_32x32x16_bf16(kf1, Qf[mp][s], p1, 0, 0, 0); }
                if (need_mask) {
#pragma unroll
                    for (int reg = 0; reg < 16; ++reg) { const int d0 = dl - crow0(reg), d1 = d0 - 32;
                        p0[reg] = (d0 >= 0 && d0 < win) ? p0[reg] : -INFINITY; p1[reg] = (d1 >= 0 && d1 < win) ? p1[reg] : -INFINITY; } }
                float mt = fmaxf(p0[0], p1[0]);
#pragma unroll
                for (int reg = 1; reg < 16; ++reg) mt = fmaxf(mt, fmaxf(p0[reg], p1[reg]));
                mt = swap_max(mt); if (SLC && !sel) mt = -INFINITY;
                if (__any(mt > M[mp] + 8.f)) { const float mn = fmaxf(M[mp], mt), alpha = __builtin_amdgcn_exp2f(M[mp] - mn); O[mp][0] *= alpha; O[mp][1] *= alpha; Ls[mp] *= alpha; M[mp] = mn; }
                const float ms = (SLC && !sel) ? INFINITY : M[mp];
                float rs = 0.f;
#pragma unroll
                for (int reg = 0; reg < 16; ++reg) { p0[reg] = __builtin_amdgcn_exp2f(p0[reg] - ms); p1[reg] = __builtin_amdgcn_exp2f(p1[reg] - ms); rs += p0[reg] + p1[reg]; }
                Ls[mp] += rs;
                pa[mp][0] = pack8(p0, 0); pa[mp][1] = pack8(p0, 8); pa[mp][2] = pack8(p1, 0); pa[mp][3] = pack8(p1, 8);
            }
            const LAS unsigned char* vb = vfrag + buf * A_VBUF;
#pragma unroll
            for (int db = 0; db < 2; ++db)
#pragma unroll
                for (int ks = 0; ks < 4; ++ks) { const s16x4 lo = tr_read(vb + ks * (16 * 144) + db * 64), hi = tr_read(vb + ks * (16 * 144) + db * 64 + 8 * 144);
                    const bf16x8v vf = {lo[0], lo[1], lo[2], lo[3], hi[0], hi[1], hi[2], hi[3]};
#pragma unroll
                    for (int mp = 0; mp < NMAP; ++mp) O[mp][db] = __builtin_amdgcn_mfma_f32_32x32x16_bf16(vf, pa[mp][ks], O[mp][db], 0, 0, 0); }
          } }
        if (more) { *(LAS u32x4*)(L + A_KOFF + (buf ^ 1) * A_KBUF + kdst) = kreg; *(LAS u32x4*)(L + A_VOFF + (buf ^ 1) * A_VBUF + vdst) = vreg; if (FOX && tid < 64) *(LAS float*)(L + A_BOFF + (buf ^ 1) * 256 + tid * 4) = breg; }
        __syncthreads();
        if (!more) break;
        j = jn; buf ^= 1;
    }
}
#define ATTN_FOR_CHUNKS(db, g4) _Pragma("unroll") for (int db = 0; db < 2; ++db) _Pragma("unroll") for (int g4 = 0; g4 < 4; ++g4)

__device__ __forceinline__ void ph_norm_bf16(const Ctx& c, const float* x, const float* g, bf16* out) {
    for (int row = c.gw; row < NT; row += c.ngw) {
        const f32x4* xr = (const f32x4*)(x + (size_t)row * D_) + c.lane;
        f32x4 v[4]; float ss = 0.f;
#pragma unroll
        for (int j = 0; j < 4; ++j) { v[j] = xr[64 * j]; ss += v[j].x * v[j].x + v[j].y * v[j].y + v[j].z * v[j].z + v[j].w * v[j].w; }
        const float r = rsqrtf(wave_sum(ss) * (1.f / D_) + EPS);
        u64* o8 = (u64*)(out + (size_t)row * D_) + c.lane;
#pragma unroll
        for (int j = 0; j < 4; ++j) { const f32x4 gg = ((const f32x4*)g)[c.lane + 64 * j];
            o8[64 * j] = (u64)pk2(v[j].x * r * gg.x, v[j].y * r * gg.y) | ((u64)pk2(v[j].z * r * gg.z, v[j].w * r * gg.w) << 32); }
    }
}
__device__ __forceinline__ void ph_norm_final(const Ctx& c, float* x, const float* g) {
    for (int row = c.gw; row < NT; row += c.ngw) {
        f32x4* xr = (f32x4*)(x + (size_t)row * D_) + c.lane;
        f32x4 v[4]; float ss = 0.f;
#pragma unroll
        for (int j = 0; j < 4; ++j) { v[j] = xr[64 * j]; ss += v[j].x * v[j].x + v[j].y * v[j].y + v[j].z * v[j].z + v[j].w * v[j].w; }
        const float r = rsqrtf(wave_sum(ss) * (1.f / D_) + EPS);
#pragma unroll
        for (int j = 0; j < 4; ++j) { const f32x4 gg = ((const f32x4*)g)[c.lane + 64 * j]; xr[64 * j] = v[j] * r * gg; }
    }
}

template <class AF, class EF>
__device__ __forceinline__ void naive_gemm(const Ctx& c, int M, int N, int K, AF af, const float* W, int ldb, EF ef) {
    LAS float* As = (LAS float*)c.lds;
    LAS float* Bs = As + 16 * 132;
    const int tm = (M + 127) / 128, tn = (N + 127) / 128, ntile = tm * tn;
    const int ty = c.tid >> 4, tx = c.tid & 15;
    for (int tile = c.bid; tile < ntile; tile += c.G) {
        const int m0 = (tile / tn) * 128, n0 = (tile % tn) * 128;
        float acc[4][8];
#pragma unroll
        for (int i = 0; i < 4; ++i)
#pragma unroll
            for (int j = 0; j < 8; ++j) acc[i][j] = 0.f;
        for (int k0 = 0; k0 < K; k0 += 16) {
            __syncthreads();
#pragma unroll
            for (int i = 0; i < 4; ++i) { const int e = c.tid + i * 512, r = e >> 4, kk = e & 15; const int row = m0 + r;
                As[kk * 132 + r] = (row < M) ? af(row, k0 + kk) : 0.f; }
#pragma unroll
            for (int i = 0; i < 4; ++i) { const int e = c.tid + i * 512, kk = e >> 7, cc = e & 127; const int col = n0 + cc;
                Bs[kk * 132 + cc] = (col < N) ? W[(size_t)(k0 + kk) * ldb + col] : 0.f; }
            __syncthreads();
#pragma unroll 2
            for (int kk = 0; kk < 16; ++kk) {
                float a[4], b[8];
#pragma unroll
                for (int i = 0; i < 4; ++i) a[i] = As[kk * 132 + ty * 4 + i];
#pragma unroll
                for (int j = 0; j < 8; ++j) b[j] = Bs[kk * 132 + tx * 8 + j];
#pragma unroll
                for (int i = 0; i < 4; ++i)
#pragma unroll
                    for (int j = 0; j < 8; ++j) acc[i][j] = fmaf(a[i], b[j], acc[i][j]);
            }
        }
        LAS float* Cs = Bs + 16 * 132;
        __syncthreads();
#pragma unroll
        for (int i = 0; i < 4; ++i)
#pragma unroll
            for (int j = 0; j < 8; ++j) Cs[(ty * 4 + i) * 129 + tx * 8 + j] = acc[i][j];
        __syncthreads();
#pragma unroll 1
        for (int e = c.tid; e < 128 * 128; e += NTHREADS) { const int r = e >> 7, cc = e & 127, row = m0 + r, col = n0 + cc; if (row < M && col < N) ef(row, col, Cs[r * 129 + cc]); }
    }
    __syncthreads();
}

struct InProjOut { bf16* qn; bf16* kv6; bf16* fqkv; bf16* dqk; bf16* dv; float* gate; float* fl; const float* b_gate; const float* b_fgt; };
__device__ __forceinline__ void inproj_store(const InProjOut& o, int n, int col, float v) {
    const int b = n / T_, t = n % T_;
    if (col < C_KV6) { const int h = col >> 6, d = col & 63; o.qn[((size_t)(b * 8 + h) * T_ + t) * 64 + d] = (bf16)f2bf(v * (0.125f * LOG2E)); }
    else if (col < C_GATE) { const int cc = col - C_KV6, idx = cc >> 7, g = (cc >> 6) & 1, d = cc & 63;
        ((bf16*)((unsigned char*)o.kv6 + idx * KV6_STRIDE))[((size_t)(b * 2 + g) * T_ + t) * 64 + d] = (bf16)f2bf(v); }
    else if (col < C_FQ) { const int j = col - C_GATE; o.gate[(size_t)n * 24 + j] = sigmoidf_(v + o.b_gate[j]); }
    else if (col < C_FF) { const int cc = col - C_FQ, idx = cc >> 8, h = (cc >> 6) & 3, d = cc & 63;
        o.fqkv[(size_t)idx * (8 * MiB) + ((size_t)(b * 4 + h) * T_ + t) * 64 + d] = (bf16)f2bf(idx == 0 ? v * (0.125f * LOG2E) : v); }
    else if (col < C_DQ) { const int h = col - C_FF; o.fl[(size_t)(b * 4 + h) * T_ + t] = log_sigmoidf_(v + o.b_fgt[h]); }
    else if (col < C_DV) { const int cc = col - C_DQ, idx = cc >> 8, h = (cc >> 6) & 3, i = (cc >> 5) & 1, d = cc & 31;
        o.dqk[(size_t)idx * (8 * MiB) + ((size_t)((b * 4 + h) * 2 + i) * T_ + t) * 32 + d] = (bf16)f2bf(idx == 0 ? v * (0.17677669529663687f * LOG2E) : v); }
    else { const int cc = col - C_DV, h = cc >> 6, d = cc & 63; o.dv[((size_t)(b * 4 + h) * T_ + t) * 64 + d] = (bf16)f2bf(v); }
}

__device__ __forceinline__ void ph_cumsum(const Ctx& c, float* fl) {
    for (int s = c.gw; s < B_ * 4; s += c.ngw) {
        float* p = fl + (size_t)s * T_; float carry = 0.f;
        for (int t0 = 0; t0 < T_; t0 += 64) {
            float v = p[t0 + c.lane];
#pragma unroll
            for (int o = 1; o < 64; o <<= 1) { const float u = __shfl_up(v, o); if (c.lane >= o) v += u; }
            v += carry; p[t0 + c.lane] = v; carry = __shfl(v, 63);
        }
    }
}

template <int DQK>
__device__ __forceinline__ float naive_attn_row(const bf16* q, const bf16* K, const bf16* V, int t, u64 mask, float slope2, const float* cum, int win, int lane) {
    float qv[DQK];
    { const u32x4* q4 = (const u32x4*)q;
#pragma unroll
      for (int i = 0; i < DQK / 8; ++i) { const u32x4 w = q4[i];
          qv[8 * i + 0] = __uint_as_float(w.x << 16); qv[8 * i + 1] = __uint_as_float(w.x & 0xffff0000u);
          qv[8 * i + 2] = __uint_as_float(w.y << 16); qv[8 * i + 3] = __uint_as_float(w.y & 0xffff0000u);
          qv[8 * i + 4] = __uint_as_float(w.z << 16); qv[8 * i + 5] = __uint_as_float(w.z & 0xffff0000u);
          qv[8 * i + 6] = __uint_as_float(w.w << 16); qv[8 * i + 7] = __uint_as_float(w.w & 0xffff0000u); } }
    const float cumt = cum ? cum[t] : 0.f;
    float m = -INFINITY, l = 0.f, o = 0.f;
    while (mask) {
        const int j = __builtin_ctzll(mask); mask &= mask - 1;
        const int kpos = 64 * j + lane; const int dist = t - kpos;
        const bool valid = dist >= 0 && dist < win;
        float s = 0.f;
        { const u32x4* k4 = (const u32x4*)(K + (size_t)kpos * DQK);
#pragma unroll
          for (int i = 0; i < DQK / 8; ++i) { const u32x4 w = k4[i];
              s = fmaf(qv[8 * i + 0], __uint_as_float(w.x << 16), s); s = fmaf(qv[8 * i + 1], __uint_as_float(w.x & 0xffff0000u), s);
              s = fmaf(qv[8 * i + 2], __uint_as_float(w.y << 16), s); s = fmaf(qv[8 * i + 3], __uint_as_float(w.y & 0xffff0000u), s);
              s = fmaf(qv[8 * i + 4], __uint_as_float(w.z << 16), s); s = fmaf(qv[8 * i + 5], __uint_as_float(w.z & 0xffff0000u), s);
              s = fmaf(qv[8 * i + 6], __uint_as_float(w.w << 16), s); s = fmaf(qv[8 * i + 7], __uint_as_float(w.w & 0xffff0000u), s); } }
        s -= slope2 * (float)dist;
        if (cum) s += (cumt - cum[kpos]) * LOG2E;
        s = valid ? s : -INFINITY;
        const float mb = wave_max(s);
        if (mb == -INFINITY) continue;
        const float mn = fmaxf(m, mb), alpha = exp2f(m - mn);
        const float p = valid ? exp2f(s - mn) : 0.f;
        l = l * alpha + wave_sum(p); o *= alpha; m = mn;
        const bf16* vb = V + (size_t)(64 * j) * 64 + lane;
#pragma unroll 8
        for (int k = 0; k < 64; ++k) o = fmaf(__shfl(p, k), bf2f(vb[(size_t)k * 64]), o);
    }
    return l > 0.f ? o / l : 0.f;
}

__device__ __forceinline__ void ph_cmp_attn(const Ctx& c, const bf16* qn, const bf16* kcmp, const bf16* vcmp, const float* gate, u64* sel, bf16* ocmp) {
    LAS float* pl = (LAS float*)(c.lds) + c.wave * 256;
    const int lane = c.lane;
    for (int it = c.gw; it < B_ * 2 * T_; it += c.ngw) {
        const int t = it % T_, bg = it / T_, b = bg >> 1, g = bg & 1;
        const int nvis = (t >= 31) ? ((t - 31) >> 4) + 1 : 0;
        const bf16* kc = kcmp + (size_t)bg * 256 * 64; const bf16* vc = vcmp + (size_t)bg * 256 * 64;
        float imp = 0.f;
        for (int hg = 0; hg < 4; ++hg) {
            const int h = g * 4 + hg; const float slope2 = alibi_slope(h + 1, 8) * LOG2E;
            const bf16* q = qn + ((size_t)(b * 8 + h) * T_ + t) * 64;
            float qv[64];
            { const u32x4* q4 = (const u32x4*)q;
#pragma unroll
              for (int i = 0; i < 8; ++i) { const u32x4 w = q4[i];
                  qv[8 * i + 0] = __uint_as_float(w.x << 16); qv[8 * i + 1] = __uint_as_float(w.x & 0xffff0000u);
                  qv[8 * i + 2] = __uint_as_float(w.y << 16); qv[8 * i + 3] = __uint_as_float(w.y & 0xffff0000u);
                  qv[8 * i + 4] = __uint_as_float(w.z << 16); qv[8 * i + 5] = __uint_as_float(w.z & 0xffff0000u);
                  qv[8 * i + 6] = __uint_as_float(w.w << 16); qv[8 * i + 7] = __uint_as_float(w.w & 0xffff0000u); } }
            float s[4]; float m = -INFINITY;
#pragma unroll
            for (int i = 0; i < 4; ++i) { const int cc = lane + 64 * i; float a = 0.f;
                if (cc < nvis) { const u32x4* k4 = (const u32x4*)(kc + (size_t)cc * 64);
#pragma unroll
                    for (int e = 0; e < 8; ++e) { const u32x4 w = k4[e];
                        a = fmaf(qv[8 * e + 0], __uint_as_float(w.x << 16), a); a = fmaf(qv[8 * e + 1], __uint_as_float(w.x & 0xffff0000u), a);
                        a = fmaf(qv[8 * e + 2], __uint_as_float(w.y << 16), a); a = fmaf(qv[8 * e + 3], __uint_as_float(w.y & 0xffff0000u), a);
                        a = fmaf(qv[8 * e + 4], __uint_as_float(w.z << 16), a); a = fmaf(qv[8 * e + 5], __uint_as_float(w.z & 0xffff0000u), a);
                        a = fmaf(qv[8 * e + 6], __uint_as_float(w.w << 16), a); a = fmaf(qv[8 * e + 7], __uint_as_float(w.w & 0xffff0000u), a); }
                    a -= slope2 * (float)(t - (16 * cc + 31)); } else a = -INFINITY;
                s[i] = a; m = fmaxf(m, a); }
            m = wave_max(m);
            float p[4], lsum = 0.f;
#pragma unroll
            for (int i = 0; i < 4; ++i) { p[i] = (lane + 64 * i < nvis) ? exp2f(s[i] - m) : 0.f; lsum += p[i]; }
            lsum = wave_sum(lsum);
            const float inv = lsum > 0.f ? 1.f / lsum : 0.f;
#pragma unroll
            for (int i = 0; i < 4; ++i) { p[i] *= inv; pl[lane + 64 * i] = p[i]; }
            asm volatile("s_waitcnt lgkmcnt(0)" ::: "memory");
            float o = 0.f;
            for (int cc = 0; cc < nvis; ++cc) o = fmaf(pl[cc], bf2f(vc[(size_t)cc * 64 + lane]), o);
            const float gt = gate[((size_t)(b * T_ + t)) * 24 + h * 3 + 0];
            ocmp[(size_t)(b * T_ + t) * 512 + h * 64 + lane] = (bf16)f2bf(gt * o);
            { const int j = lane; float a = pl[4 * j] + pl[4 * j + 1] + pl[4 * j + 2] + 0.5f * pl[4 * j + 3]; if (j > 0) a += 0.5f * pl[4 * j - 1]; imp += a; }
            asm volatile("s_waitcnt lgkmcnt(0)" ::: "memory");
        }
        const int cur = t >> 6; const int j = lane;
        u64 m64;
        if (cur <= 15) m64 = (cur == 63) ? ~0ull : ((1ull << (cur + 1)) - 1ull);
        else {
            float val = (j > cur) ? -INFINITY : ((j == 0 || j == cur || j == cur - 1) ? 1e4f : imp);
            m64 = 0ull;
            for (int r = 0; r < 16; ++r) {
                const float mx = wave_max(val);
                const u64 bal = __ballot(val == mx);
                const int w = __builtin_ctzll(bal);
                m64 |= 1ull << w; if (j == w) val = -INFINITY;
            }
        }
        if (lane == 0) sel[(size_t)bg * T_ + t] = m64;
    }
}

__device__ __forceinline__ void ph_win_attn(const Ctx& c, const bf16* qn, const bf16* kw, const bf16* vw, const float* gate, bf16* owin) {
    for (int it = c.gw; it < B_ * 8 * T_; it += c.ngw) {
        const int t = it % T_, bh = it / T_, b = bh >> 3, h = bh & 7, g = h >> 2;
        const int cur = t >> 6, jlo = (t - 511) > 0 ? (t - 511) >> 6 : 0;
        const u64 hi = (cur == 63) ? ~0ull : ((1ull << (cur + 1)) - 1ull); const u64 mask = hi & ~((1ull << jlo) - 1ull);
        const float o = naive_attn_row<64>(qn + ((size_t)bh * T_ + t) * 64, kw + (size_t)(b * 2 + g) * T_ * 64, vw + (size_t)(b * 2 + g) * T_ * 64, t, mask,
                                           alibi_slope(h + 1, 8) * LOG2E, nullptr, 512, c.lane);
        owin[(size_t)(b * T_ + t) * 512 + h * 64 + c.lane] = (bf16)f2bf(gate[(size_t)(b * T_ + t) * 24 + h * 3 + 2] * o);
    }
}
__device__ __forceinline__ void ph_slc_attn(const Ctx& c, const bf16* qn, const bf16* ks, const bf16* vs, const float* gate, const u64* sel, const bf16* ocmp, const bf16* owin, bf16* att) {
    for (int it = c.gw; it < B_ * 8 * T_; it += c.ngw) {
        const int t = it % T_, bh = it / T_, b = bh >> 3, h = bh & 7, g = h >> 2;
        const u64 mask = sel[(size_t)(b * 2 + g) * T_ + t];
        const float o = naive_attn_row<64>(qn + ((size_t)bh * T_ + t) * 64, ks + (size_t)(b * 2 + g) * T_ * 64, vs + (size_t)(b * 2 + g) * T_ * 64, t, mask,
                                           alibi_slope(h + 1, 8) * LOG2E, nullptr, 1 << 30, c.lane);
        const size_t n = (size_t)(b * T_ + t);
        const float r = gate[n * 24 + h * 3 + 1] * o + bf2f(ocmp[n * 512 + h * 64 + c.lane]) + bf2f(owin[n * 512 + h * 64 + c.lane]);
        att[n * 1024 + h * 64 + c.lane] = (bf16)f2bf(r);
    }
}
__device__ __forceinline__ void ph_fox_attn(const Ctx& c, const bf16* fq, const bf16* fk, const bf16* fv, const float* cum, bf16* att) {
    for (int it = c.gw; it < B_ * 4 * T_; it += c.ngw) {
        const int t = it % T_, bh = it / T_, b = bh >> 2, h = bh & 3;
        const int cur = t >> 6; const u64 mask = (cur == 63) ? ~0ull : ((1ull << (cur + 1)) - 1ull);
        const float o = naive_attn_row<64>(fq + ((size_t)bh * T_ + t) * 64, fk + (size_t)bh * T_ * 64, fv + (size_t)bh * T_ * 64, t, mask, 0.f, cum + (size_t)bh * T_, 1 << 30, c.lane);
        att[(size_t)(b * T_ + t) * 1024 + 512 + h * 64 + c.lane] = (bf16)f2bf(o);
    }
}
__device__ __forceinline__ void ph_diff_attn(const Ctx& c, const bf16* dq, const bf16* dk, const bf16* dv, const float* lam, const float* subln, float lambda_init, bf16* att) {
    float l1 = 0.f, l2 = 0.f;
    if (c.lane < 32) { l1 = lam[c.lane] * lam[32 + c.lane]; l2 = lam[64 + c.lane] * lam[96 + c.lane]; }
    const float lam_full = __expf(wave_sum(l1)) - __expf(wave_sum(l2)) + lambda_init;
    const float sg = subln[c.lane] * (1.f - lambda_init);
    for (int it = c.gw; it < B_ * 4 * T_; it += c.ngw) {
        const int t = it % T_, bh = it / T_, b = bh >> 2, h = bh & 3;
        const int cur = t >> 6; const u64 mask = (cur == 63) ? ~0ull : ((1ull << (cur + 1)) - 1ull);
        const float slope2 = alibi_slope(h + 1, 4) * LOG2E;
        const bf16* vb = dv + (size_t)bh * T_ * 64;
        const float o1 = naive_attn_row<32>(dq + ((size_t)(bh * 2 + 0) * T_ + t) * 32, dk + (size_t)(bh * 2 + 0) * T_ * 32, vb, t, mask, slope2, nullptr, 1 << 30, c.lane);
        const float o2 = naive_attn_row<32>(dq + ((size_t)(bh * 2 + 1) * T_ + t) * 32, dk + (size_t)(bh * 2 + 1) * T_ * 32, vb, t, mask, slope2, nullptr, 1 << 30, c.lane);
        const float o = o1 - lam_full * o2;
        const float r = rsqrtf(wave_sum(o * o) * (1.f / 64.f) + EPS);
        att[(size_t)(b * T_ + t) * 1024 + 768 + h * 64 + c.lane] = (bf16)f2bf(o * r * sg);
    }
}

__device__ __forceinline__ void ph_moe_route(const Ctx& c, const float* x, const float* g, const float* wgrp, const float* bgrp, const float* wexp, const float* bexp, bf16* hn, int* route_e, float* route_w) {
    for (int row = c.gw; row < NT; row += c.ngw) {
        const f32x4* xr = (const f32x4*)(x + (size_t)row * D_) + c.lane;
        f32x4 v[4]; float ss = 0.f;
#pragma unroll
        for (int j = 0; j < 4; ++j) { v[j] = xr[64 * j]; ss += v[j].x * v[j].x + v[j].y * v[j].y + v[j].z * v[j].z + v[j].w * v[j].w; }
        const float r = rsqrtf(wave_sum(ss) * (1.f / D_) + EPS);
        u64* o8 = (u64*)(hn + (size_t)row * D_) + c.lane;
#pragma unroll
        for (int j = 0; j < 4; ++j) { const f32x4 gg = ((const f32x4*)g)[c.lane + 64 * j]; v[j] = v[j] * r * gg;
            o8[64 * j] = (u64)pk2(v[j].x, v[j].y) | ((u64)pk2(v[j].z, v[j].w) << 32); }
        float gl[4];
#pragma unroll
        for (int q = 0; q < 4; ++q) { float a = 0.f;
#pragma unroll
            for (int j = 0; j < 4; ++j) { const int k = 4 * (c.lane + 64 * j);
                a = fmaf(v[j].x, wgrp[(size_t)(k + 0) * 4 + q], a); a = fmaf(v[j].y, wgrp[(size_t)(k + 1) * 4 + q], a);
                a = fmaf(v[j].z, wgrp[(size_t)(k + 2) * 4 + q], a); a = fmaf(v[j].w, wgrp[(size_t)(k + 3) * 4 + q], a); }
            gl[q] = wave_sum(a) + bgrp[q]; }
        int grp = 0; float gm = gl[0];
#pragma unroll
        for (int q = 1; q < 4; ++q) if (gl[q] > gm) { gm = gl[q]; grp = q; }
        float gs = 0.f;
#pragma unroll
        for (int q = 0; q < 4; ++q) gs += __expf(gl[q] - gm);
        const float grp_gate = 1.f / gs;
        float el[8];
#pragma unroll
        for (int q = 0; q < 8; ++q) { float a = 0.f; const int col = grp * 8 + q;
#pragma unroll
            for (int j = 0; j < 4; ++j) { const int k = 4 * (c.lane + 64 * j);
                a = fmaf(v[j].x, wexp[(size_t)(k + 0) * 32 + col], a); a = fmaf(v[j].y, wexp[(size_t)(k + 1) * 32 + col], a);
                a = fmaf(v[j].z, wexp[(size_t)(k + 2) * 32 + col], a); a = fmaf(v[j].w, wexp[(size_t)(k + 3) * 32 + col], a); }
            el[q] = wave_sum(a) + bexp[col]; }
        int i0 = 0; float v0 = el[0];
#pragma unroll
        for (int q = 1; q < 8; ++q) if (el[q] > v0) { v0 = el[q]; i0 = q; }
        int i1 = -1; float v1 = -INFINITY;
#pragma unroll
        for (int q = 0; q < 8; ++q) if (q != i0 && el[q] > v1) { v1 = el[q]; i1 = q; }
        const float e1 = __expf(v1 - v0), den = 1.f + e1;
        if (c.lane == 0) { route_e[2 * row] = grp * 8 + i0; route_e[2 * row + 1] = grp * 8 + i1; route_w[2 * row] = grp_gate / den; route_w[2 * row + 1] = grp_gate * e1 / den; }
    }
}
__device__ __forceinline__ void ph_moe_naive(const Ctx& c, const bf16* hn, const int* route_e, const float* route_w, const float* wg, const float* wu, const float* wd, float* x) {
    LAS float* hs = (LAS float*)c.lds;
    LAS float* au = hs + 1024;
    LAS float* h2 = au + 512;
    for (int row = c.bid; row < NT; row += c.G) {
        __syncthreads();
        hs[c.tid] = bf2f(hn[(size_t)row * D_ + c.tid]); hs[c.tid + 512] = bf2f(hn[(size_t)row * D_ + c.tid + 512]);
        float o0 = 0.f, o1 = 0.f;
        for (int s = 0; s < 2; ++s) {
            const int e = route_e[2 * row + s]; const float w = route_w[2 * row + s];
            __syncthreads();
            const float* W = (c.tid < 256 ? wg : wu) + (size_t)e * D_ * DEXP + (c.tid & 255);
            float a = 0.f;
            for (int k = 0; k < D_; ++k) a = fmaf(hs[k], W[(size_t)k * DEXP], a);
            au[c.tid] = a;
            __syncthreads();
            if (c.tid < 256) { const float ga = au[c.tid], up = au[c.tid + 256]; h2[c.tid] = ga / (1.f + __expf(-ga)) * up * w; }
            __syncthreads();
            const float* Wd = wd + (size_t)e * DEXP * D_;
            for (int k = 0; k < DEXP; ++k) { const float hv = h2[k]; o0 = fmaf(hv, Wd[(size_t)k * D_ + c.tid], o0); o1 = fmaf(hv, Wd[(size_t)k * D_ + c.tid + 512], o1); }
        }
        x[(size_t)row * D_ + c.tid] += o0; x[(size_t)row * D_ + c.tid + 512] += o1;
    }
    __syncthreads();
}

typedef __attribute__((address_space(4))) const Params* KP;
__device__ __forceinline__ KP uni_kp(KP p) { const unsigned long long v = (unsigned long long)p; const unsigned lo = __builtin_amdgcn_readfirstlane((unsigned)v), hi = __builtin_amdgcn_readfirstlane((unsigned)(v >> 32)); return (KP)(((unsigned long long)hi << 32) | lo); }
constexpr int PH_PER_LAYER = 9, N_PHASES = L_ * PH_PER_LAYER + 2;
extern __shared__ __attribute__((aligned(16))) unsigned char lds_raw[];
__device__ __forceinline__ Ctx make_ctx(KP p) {
    Ctx c; c.lds = (LAS unsigned char*)lds_raw; c.tid = threadIdx.x; c.lane = c.tid & 63; c.wave = __builtin_amdgcn_readfirstlane(c.tid >> 6);
    c.bid = blockIdx.x; c.G = gridDim.x; c.gw = c.bid * NWAVES + c.wave; c.ngw = c.G * NWAVES; c.in = nullptr; c.xcur = p->out; c.ws = p->ws;
    return c;
}
struct Bufs {
    bf16 *QN, *KV6, *KC, *VC, *KS, *VS, *KW, *VW, *FQ, *FK, *FV, *DQ, *DK, *DV, *HC, *KCMP, *VCMP, *OCMP, *OWIN, *HN, *ATT;
    float *GATE, *FL, *ROUTE_W; u64* SEL; int* ROUTE_E;
};
__device__ __forceinline__ Bufs make_bufs(unsigned char* ws) {
    Bufs b;
    b.QN = (bf16*)(ws + WS_QN); b.KV6 = (bf16*)(ws + WS_KV6);
    b.KC = (bf16*)(ws + WS_KV6 + 0 * KV6_STRIDE); b.VC = (bf16*)(ws + WS_KV6 + 1 * KV6_STRIDE);
    b.KS = (bf16*)(ws + WS_KV6 + 2 * KV6_STRIDE); b.VS = (bf16*)(ws + WS_KV6 + 3 * KV6_STRIDE);
    b.KW = (bf16*)(ws + WS_KV6 + 4 * KV6_STRIDE); b.VW = (bf16*)(ws + WS_KV6 + 5 * KV6_STRIDE);
    b.FQ = (bf16*)(ws + WS_FQKV); b.FK = b.FQ + 8 * MiB; b.FV = b.FQ + 16 * MiB;
    b.DQ = (bf16*)(ws + WS_DQK); b.DK = b.DQ + 8 * MiB; b.DV = (bf16*)(ws + WS_DV);
    b.GATE = (float*)(ws + WS_GATE); b.FL = (float*)(ws + WS_FL);
    b.HC = (bf16*)(ws + WS_HC); b.KCMP = (bf16*)(ws + WS_KVCMP); b.VCMP = b.KCMP + 16 * 256 * 64;
    b.SEL = (u64*)(ws + WS_SEL); b.OCMP = (bf16*)(ws + WS_OCMP); b.OWIN = (bf16*)(ws + WS_OWIN);
    b.HN = (bf16*)(ws + WS_HN); b.ATT = (bf16*)(ws + WS_ATT);
    b.ROUTE_E = (int*)(ws + WS_ROUTE); b.ROUTE_W = (float*)(ws + WS_ROUTE + 512 * 1024);
    return b;
}
__device__ __forceinline__ float lambda_init_of(int l) { return 0.8f - 0.6f * expf(-0.3f * (float)l); }

__device__ __noinline__ void P_prologue(KP p_) { const KP p = uni_kp(p_);
    const Ctx c = make_ctx(p); unsigned char* ws = p->ws;
    LAS float* scr = (LAS float*)(c.lds) + c.wave * (64 * 33);
    constexpr int I_A = 16 * 40, I_B = 16 * 24, I_C = 16 * 24, I_O = 16 * 32, I_G = 16 * 8, I_D = 4 * 32, I_E = 2 * I_G + I_D, I_W1 = 32 * 8, I_W2 = 4 * 2;
    constexpr int PER_L = I_A + I_B + I_C + I_O + NEXP * I_E + 2 * (I_W1 + I_W2);
    for (int it = c.gw; it < L_ * PER_L; it += c.ngw) {
        const int l = it / PER_L; int r = it % PER_L;
        const float* W; bf16* WT; int ldw, K, sc0, ncol, r0 = 0, rmul = 1;
        if (r < I_A + I_B + I_C) { W = p->in[2] + (size_t)l * D_ * D_IN; WT = (bf16*)(ws + WS_WIN_T) + (size_t)l * NIN * D_; ldw = D_IN; K = D_;
            if (r < I_A) { sc0 = 0; ncol = 1280; r0 = 0; } else if (r < I_A + I_B) { r -= I_A; sc0 = C_FQ; ncol = 768; r0 = 1280; } else { r -= I_A + I_B; sc0 = C_DQ; ncol = 768; r0 = 2048; } }
        else if ((r -= I_A + I_B + I_C) < I_O) { W = p->in[13] + (size_t)l * D_ * D_; WT = (bf16*)(ws + WS_WOUT_T) + (size_t)l * D_ * D_; ldw = D_; K = D_; sc0 = 0; ncol = 1024; }
        else if ((r -= I_O) < NEXP * I_E) { const int e = r / I_E; r = r % I_E; const size_t le = (size_t)l * NEXP + e;
            if (r < 2 * I_G) { const int up = r >= I_G; r -= up * I_G; W = p->in[19 + up] + le * D_ * DEXP; WT = (bf16*)(ws + WS_WGU_T) + le * 512 * D_; ldw = DEXP; K = D_; sc0 = 0; ncol = 256; r0 = up; rmul = 2; }
            else { r -= 2 * I_G; W = p->in[21] + le * DEXP * D_; WT = (bf16*)(ws + WS_WD_T) + le * D_ * DEXP; ldw = D_; K = DEXP; sc0 = 0; ncol = 1024; } }
        else { r -= NEXP * I_E; const int kv = r / (I_W1 + I_W2); r = r % (I_W1 + I_W2); const size_t lk = (size_t)l * 2 + kv;
            if (r < I_W1) { W = p->in[kv == 0 ? 6 : 9] + (size_t)l * 2048 * 256; WT = (bf16*)(ws + WS_W1_T) + lk * 256 * 2048; ldw = 256; K = 2048; sc0 = 0; ncol = 256; }
            else { r -= I_W1; W = p->in[kv == 0 ? 7 : 10] + (size_t)l * 256 * 64; WT = (bf16*)(ws + WS_W2_T) + lk * 64 * 256; ldw = 64; K = 256; sc0 = 0; ncol = 64; } }
        transpose_seg(W, ldw, K, sc0, ncol, WT, r0, rmul, r, scr, c.lane);
    }
    for (int i = c.bid * NTHREADS + c.tid; i < L_ * 256 * D_; i += c.G * NTHREADS) {
        const int l = i / (256 * D_), rr = (i / D_) % 256, k = i % D_;
        const float* win = p->in[2] + (size_t)l * D_ * D_IN;
        float v = 0.f; if (rr < 24) v = win[(size_t)k * D_IN + C_GATE + rr]; else if (rr < 28) v = win[(size_t)k * D_IN + C_FF + (rr - 24)];
        ((bf16*)(ws + WS_WIN_T))[((size_t)l * NIN + 2816 + rr) * D_ + k] = (bf16)f2bf(v);
    }
    for (int w = c.gw; w < L_ * 2 * 4; w += c.ngw) {
        const int l = w / 8, kv = (w / 4) & 1, j = (w & 3) * 64 + c.lane;
        const float* pe = p->in[kv == 0 ? 5 : 8] + (size_t)l * 2048; const float* w1 = p->in[kv == 0 ? 6 : 9] + (size_t)l * 2048 * 256;
        float a = 0.f; for (int k = 0; k < 2048; ++k) a = fmaf(pe[k], w1[(size_t)k * 256 + j], a);
        ((float*)(ws + WS_BIAS1))[(l * 2 + kv) * 256 + j] = a;
    }
}
__device__ __forceinline__ void P_inproj_mfma(int l_) { const KP p = (KP)__builtin_amdgcn_kernarg_segment_ptr(); int l = l_; asm volatile("" : "+s"(l));
    unsigned char* ws = p->ws;
    PlainOrder S; S.init(ws + WS_HN, (const bf16*)(ws + WS_WIN_T) + (size_t)l * NIN * D_, D_, D_, NT, NIN, (int)gridDim.x, (int)blockIdx.x);
    const pg8::Gemm g{D_, D_, D_, D_ / 64};
    const EpiInProj E{ws, p->in[3] + l * 24, p->in[4] + l * 4};
    pg8::gemm_phase<EpiInProj, PlainOrder, true, true>((LAS unsigned char*)lds_raw, g, S, E);
}
__device__ __forceinline__ void P_outproj_mfma(int l_) { const KP p = (KP)__builtin_amdgcn_kernarg_segment_ptr(); int l = l_; asm volatile("" : "+s"(l));
    unsigned char* ws = p->ws;
    PlainOrder S; S.init(ws + WS_ATT, (const bf16*)(ws + WS_WOUT_T) + (size_t)l * D_ * D_, D_, D_, NT, D_, (int)gridDim.x, (int)blockIdx.x);
    const pg8::Gemm g{D_, D_, D_, D_ / 64};
    const EpiResF32 E{(l == 0) ? p->in[0] : p->out, p->out};
    pg8::gemm_phase<EpiResF32, PlainOrder, true, true>((LAS unsigned char*)lds_raw, g, S, E);
}
__device__ __forceinline__ void U_fox(KP p_, int bh_, int qb_) {
    const KP p = uni_kp(p_); const int bh = __builtin_amdgcn_readfirstlane(bh_), qb = __builtin_amdgcn_readfirstlane(qb_);
    int tid_ = threadIdx.x; asm volatile("" : "+v"(tid_));
    const int tid = tid_, lane = tid & 63, wave = __builtin_amdgcn_readfirstlane(tid >> 6), r = lane & 31, h = lane >> 5;
    unsigned char* ws = p->ws; LAS unsigned char* L = (LAS unsigned char*)lds_raw;
    const int tw0 = 256 * qb + 32 * wave, t_lane = tw0 + r, b = bh >> 2, hd = bh & 3;
    const bf16* q = (const bf16*)(ws + WS_FQKV) + ((size_t)bh * T_ + t_lane) * 64 + 8 * h;
    bf16x8v Qf[1][4];
#pragma unroll
    for (int s = 0; s < 4; ++s) Qf[0][s] = *(const bf16x8v*)(q + 16 * s);
    const float* cum = (const float*)(ws + WS_FL) + (size_t)bh * T_;
    f32x16 O[1][2]; float M[1] = {-1e30f}, Ls[1] = {0.f};
#pragma unroll
    for (int i = 0; i < 16; ++i) { O[0][0][i] = 0.f; O[0][1][i] = 0.f; }
    const u64 tm = (qb == 15) ? ~0ull : ((1ull << (4 * qb + 4)) - 1ull);
    attn_core<64, 1, true, false>(L, (const bf16*)(ws + WS_FQKV) + 8 * MiB + (size_t)bh * T_ * 64, nullptr, (const bf16*)(ws + WS_FQKV) + 16 * MiB + (size_t)bh * T_ * 64, cum, cum[256 * qb],
                                  Qf, tm, t_lane, tw0, 1 << 30, 0.f, 0u, 0u, O, M, Ls, tid);
    const float lt = swap_sum(Ls[0]), inv = lt > 0.f ? 1.f / lt : 0.f;
    bf16* dst = (bf16*)(ws + WS_ATT) + ((size_t)b * T_ + t_lane) * 1024 + 512 + hd * 64 + 4 * h;
    ATTN_FOR_CHUNKS(db, g4) { const unsigned w0 = cvtpk(O[0][db][4 * g4 + 0] * inv, O[0][db][4 * g4 + 1] * inv), w1 = cvtpk(O[0][db][4 * g4 + 2] * inv, O[0][db][4 * g4 + 3] * inv);
        *(u64*)(dst + 32 * db + 8 * g4) = (u64)w0 | ((u64)w1 << 32); }
}
__device__ __forceinline__ void U_diff(KP p_, int bh_, int qb_, int l_) {
    const KP p = uni_kp(p_); const int bh = __builtin_amdgcn_readfirstlane(bh_), qb = __builtin_amdgcn_readfirstlane(qb_), l = __builtin_amdgcn_readfirstlane(l_);
    int tid_ = threadIdx.x; asm volatile("" : "+v"(tid_));
    const int tid = tid_, lane = tid & 63, wave = __builtin_amdgcn_readfirstlane(tid >> 6), r = lane & 31, h = lane >> 5;
    unsigned char* ws = p->ws; LAS unsigned char* L = (LAS unsigned char*)lds_raw;
    const int tw0 = 256 * qb + 32 * wave, t_lane = tw0 + r, b = bh >> 2, hd = bh & 3;
    const bf16* DQ = (const bf16*)(ws + WS_DQK); const bf16* DK = DQ + 8 * MiB;
    bf16x8v Qf[2][2];
#pragma unroll
    for (int mp = 0; mp < 2; ++mp)
#pragma unroll
        for (int s = 0; s < 2; ++s) Qf[mp][s] = *(const bf16x8v*)(DQ + ((size_t)(bh * 2 + mp) * T_ + t_lane) * 32 + 16 * s + 8 * h);
    f32x16 O[2][2]; float M[2] = {-1e30f, -1e30f}, Ls[2] = {0.f, 0.f};
#pragma unroll
    for (int i = 0; i < 16; ++i) { O[0][0][i] = 0.f; O[0][1][i] = 0.f; O[1][0][i] = 0.f; O[1][1][i] = 0.f; }
    const u64 tm = (qb == 15) ? ~0ull : ((1ull << (4 * qb + 4)) - 1ull);
    attn_core<32, 2, false, false>(L, DK + (size_t)(bh * 2 + 0) * T_ * 32, DK + (size_t)(bh * 2 + 1) * T_ * 32, (const bf16*)(ws + WS_DV) + (size_t)bh * T_ * 64, nullptr, 0.f,
                                   Qf, tm, t_lane, tw0, 1 << 30, alibi_slope(hd + 1, 4) * LOG2E, 0u, 0u, O, M, Ls, tid);
    const float* lam = p->in[11] + (size_t)l * 128; const float* subln = p->in[12] + (size_t)l * 64;
    float l1 = 0.f, l2 = 0.f; if (lane < 32) { l1 = lam[lane] * lam[32 + lane]; l2 = lam[64 + lane] * lam[96 + lane]; }
    const float li = lambda_init_of(l), lam_full = __expf(wave_sum(l1)) - __expf(wave_sum(l2)) + li;
    const float lt0 = swap_sum(Ls[0]), lt1 = swap_sum(Ls[1]), i0 = lt0 > 0.f ? 1.f / lt0 : 0.f, i1 = (lt1 > 0.f ? 1.f / lt1 : 0.f) * lam_full;
    float ss = 0.f;
#pragma unroll
    for (int db = 0; db < 2; ++db)
#pragma unroll
        for (int i = 0; i < 16; ++i) { const float o = O[0][db][i] * i0 - O[1][db][i] * i1; O[0][db][i] = o; ss += o * o; }
    ss = swap_sum(ss);
    const float rn = rsqrtf(ss * (1.f / 64.f) + EPS) * (1.f - li);
    bf16* dst = (bf16*)(ws + WS_ATT) + ((size_t)b * T_ + t_lane) * 1024 + 768 + hd * 64 + 4 * h;
    ATTN_FOR_CHUNKS(db, g4) { const f32x4 sg = *(const f32x4*)(subln + 32 * db + 8 * g4 + 4 * h);
        const unsigned w0 = cvtpk(O[0][db][4 * g4 + 0] * rn * sg.x, O[0][db][4 * g4 + 1] * rn * sg.y), w1 = cvtpk(O[0][db][4 * g4 + 2] * rn * sg.z, O[0][db][4 * g4 + 3] * rn * sg.w);
        *(u64*)(dst + 32 * db + 8 * g4) = (u64)w0 | ((u64)w1 << 32); }
}
__device__ __forceinline__ void U_win(KP p_, int bg_, int c_) {
    const KP p = uni_kp(p_); const int bg = __builtin_amdgcn_readfirstlane(bg_), cc = __builtin_amdgcn_readfirstlane(c_);
    int tid_ = threadIdx.x; asm volatile("" : "+v"(tid_));
    const int tid = tid_, lane = tid & 63, wave = __builtin_amdgcn_readfirstlane(tid >> 6), r = lane & 31, h = lane >> 5;
    unsigned char* ws = p->ws; LAS unsigned char* L = (LAS unsigned char*)lds_raw;
    const int b = bg >> 1, g = bg & 1, hd = g * 4 + (wave >> 1), tw0 = 64 * cc + 32 * (wave & 1), t_lane = tw0 + r;
    const bf16* q = (const bf16*)(ws + WS_QN) + ((size_t)(b * 8 + hd) * T_ + t_lane) * 64 + 8 * h;
    bf16x8v Qf[1][4];
#pragma unroll
    for (int s = 0; s < 4; ++s) Qf[0][s] = *(const bf16x8v*)(q + 16 * s);
    f32x16 O[1][2]; float M[1] = {-1e30f}, Ls[1] = {0.f};
#pragma unroll
    for (int i = 0; i < 16; ++i) { O[0][0][i] = 0.f; O[0][1][i] = 0.f; }
    const int jlo = cc > 8 ? cc - 8 : 0;
    const u64 hi = (cc == 63) ? ~0ull : ((1ull << (cc + 1)) - 1ull), tm = hi & ~((1ull << jlo) - 1ull);
    attn_core<64, 1, false, false>(L, (const bf16*)(ws + WS_KV6 + 4 * KV6_STRIDE) + (size_t)bg * T_ * 64, nullptr, (const bf16*)(ws + WS_KV6 + 5 * KV6_STRIDE) + (size_t)bg * T_ * 64, nullptr, 0.f,
                                   Qf, tm, t_lane, tw0, 512, alibi_slope(hd + 1, 8) * LOG2E, 0u, 0u, O, M, Ls, tid);
    const size_t n = (size_t)b * T_ + t_lane;
    const float lt = swap_sum(Ls[0]), inv = (lt > 0.f ? 1.f / lt : 0.f) * ((const float*)(ws + WS_GATE))[n * 24 + hd * 3 + 2];
    bf16* dst = (bf16*)(ws + WS_OWIN) + n * 512 + hd * 64 + 4 * h;
    ATTN_FOR_CHUNKS(db, g4) { const unsigned w0 = cvtpk(O[0][db][4 * g4 + 0] * inv, O[0][db][4 * g4 + 1] * inv), w1 = cvtpk(O[0][db][4 * g4 + 2] * inv, O[0][db][4 * g4 + 3] * inv);
        *(u64*)(dst + 32 * db + 8 * g4) = (u64)w0 | ((u64)w1 << 32); }
}
__device__ __forceinline__ void U_slc(KP p_, int bg_, int c_) {
    const KP p = uni_kp(p_); const int bg = __builtin_amdgcn_readfirstlane(bg_), cc = __builtin_amdgcn_readfirstlane(c_);
    int tid_ = threadIdx.x; asm volatile("" : "+v"(tid_));
    const int tid = tid_, lane = tid & 63, wave = __builtin_amdgcn_readfirstlane(tid >> 6), r = lane & 31, h = lane >> 5;
    unsigned char* ws = p->ws; LAS unsigned char* L = (LAS unsigned char*)lds_raw;
    const int b = bg >> 1, g = bg & 1, hd = g * 4 + (wave >> 1), tw0 = 64 * cc + 32 * (wave & 1), t_lane = tw0 + r;
    const bf16* q = (const bf16*)(ws + WS_QN) + ((size_t)(b * 8 + hd) * T_ + t_lane) * 64 + 8 * h;
    bf16x8v Qf[1][4];
#pragma unroll
    for (int s = 0; s < 4; ++s) Qf[0][s] = *(const bf16x8v*)(q + 16 * s);
    f32x16 O[1][2]; float M[1] = {-1e30f}, Ls[1] = {0.f};
#pragma unroll
    for (int i = 0; i < 16; ++i) { O[0][0][i] = 0.f; O[0][1][i] = 0.f; }
    const u64* sel = (const u64*)(ws + WS_SEL) + (size_t)bg * T_;
    const u64 mine = sel[t_lane]; u64 un = sel[64 * cc + lane];
    { unsigned ul = (unsigned)un, uh = (unsigned)(un >> 32);
#pragma unroll
      for (int o = 1; o < 64; o <<= 1) { ul |= __shfl_xor(ul, o); uh |= __shfl_xor(uh, o); }
      un = ((u64)__builtin_amdgcn_readfirstlane(uh) << 32) | __builtin_amdgcn_readfirstlane(ul); }
    attn_core<64, 1, false, true>(L, (const bf16*)(ws + WS_KV6 + 2 * KV6_STRIDE) + (size_t)bg * T_ * 64, nullptr, (const bf16*)(ws + WS_KV6 + 3 * KV6_STRIDE) + (size_t)bg * T_ * 64, nullptr, 0.f,
                                  Qf, un, t_lane, tw0, 1 << 30, alibi_slope(hd + 1, 8) * LOG2E, (unsigned)mine, (unsigned)(mine >> 32), O, M, Ls, tid);
    const size_t n = (size_t)b * T_ + t_lane;
    const float lt = swap_sum(Ls[0]), inv = (lt > 0.f ? 1.f / lt : 0.f) * ((const float*)(ws + WS_GATE))[n * 24 + hd * 3 + 1];
    const bf16* oc = (const bf16*)(ws + WS_OCMP) + n * 512 + hd * 64 + 4 * h; const bf16* ow = (const bf16*)(ws + WS_OWIN) + n * 512 + hd * 64 + 4 * h;
    bf16* dst = (bf16*)(ws + WS_ATT) + n * 1024 + hd * 64 + 4 * h;
    ATTN_FOR_CHUNKS(db, g4) { const u64 a = *(const u64*)(oc + 32 * db + 8 * g4), w = *(const u64*)(ow + 32 * db + 8 * g4);
        const float x0 = O[0][db][4 * g4 + 0] * inv + __uint_as_float((unsigned)a << 16) + __uint_as_float((unsigned)w << 16);
        const float x1 = O[0][db][4 * g4 + 1] * inv + __uint_as_float((unsigned)a & 0xffff0000u) + __uint_as_float((unsigned)w & 0xffff0000u);
        const float x2 = O[0][db][4 * g4 + 2] * inv + __uint_as_float((unsigned)(a >> 32) << 16) + __uint_as_float((unsigned)(w >> 32) << 16);
        const float x3 = O[0][db][4 * g4 + 3] * inv + __uint_as_float((unsigned)(a >> 32) & 0xffff0000u) + __uint_as_float((unsigned)(w >> 32) & 0xffff0000u);
        *(u64*)(dst + 32 * db + 8 * g4) = (u64)cvtpk(x0, x1) | ((u64)cvtpk(x2, x3) << 32); }
}
__device__ __forceinline__ int fetch_unit(KP p, int qidx) {
    volatile LAS unsigned* slot = (volatile LAS unsigned*)((LAS unsigned char*)lds_raw + MISC_OFF) + 16;
    __syncthreads();
    if (threadIdx.x == 0) *slot = __hip_atomic_fetch_add((unsigned*)(p->ws + WS_CTL) + 16384 + 64 * qidx, 1u, __ATOMIC_RELAXED, __HIP_MEMORY_SCOPE_AGENT);
    __syncthreads();
    return (int)__builtin_amdgcn_readfirstlane(*slot);
}
__device__ __noinline__ void P_norm1(KP p_, int l_) { const KP p = uni_kp(p_); const int l = __builtin_amdgcn_readfirstlane(l_); const Ctx c = make_ctx(p); const Bufs b = make_bufs(p->ws);
    ph_norm_bf16(c, (l == 0) ? p->in[0] : p->out, p->in[1] + (size_t)l * D_, b.HN); }
__device__ __noinline__ void P_inproj(KP p_, int l_) { const KP p = uni_kp(p_); const int l = __builtin_amdgcn_readfirstlane(l_); const Ctx c = make_ctx(p); const Bufs b = make_bufs(p->ws);
    InProjOut o{b.QN, b.KV6, b.FQ, b.DQ, b.DV, b.GATE, b.FL, p->in[3] + l * 24, p->in[4] + l * 4};
    const bf16* A = b.HN;
    naive_gemm(c, NT, D_IN, D_, [=](int r, int k) { return bf2f(A[(size_t)r * D_ + k]); }, p->in[2] + (size_t)l * D_ * D_IN, D_IN,
               [=](int r, int col, float v) { inproj_store(o, r, col, v); }); }
__device__ __noinline__ void P_cmp1(KP p_, int l_, int kv_) { const KP p = uni_kp(p_); const int l = __builtin_amdgcn_readfirstlane(l_), kv = __builtin_amdgcn_readfirstlane(kv_); const Ctx c = make_ctx(p); const Bufs b = make_bufs(p->ws);
    const bf16* src = kv == 0 ? b.KC : b.VC; const float* pe = p->in[kv == 0 ? 5 : 8] + (size_t)l * 2048; bf16* hc = b.HC + (size_t)kv * 4096 * 256;
    naive_gemm(c, 4096, 256, 2048, [=](int r, int k) { return bf2f(src[(size_t)r * 1024 + k]) + pe[k]; }, p->in[kv == 0 ? 6 : 9] + (size_t)l * 2048 * 256, 256,
               [=](int r, int col, float v) { hc[(size_t)r * 256 + col] = (bf16)f2bf(gelu_tanh(v)); }); }
__device__ __noinline__ void P_cumsum(KP p_, int l_) { const KP p = uni_kp(p_); const int l = __builtin_amdgcn_readfirstlane(l_); const Ctx c = make_ctx(p); const Bufs b = make_bufs(p->ws); ph_cumsum(c, b.FL); }
__device__ __noinline__ void P_cmp2(KP p_, int l_, int kv_) { const KP p = uni_kp(p_); const int l = __builtin_amdgcn_readfirstlane(l_), kv = __builtin_amdgcn_readfirstlane(kv_); const Ctx c = make_ctx(p); const Bufs b = make_bufs(p->ws);
    const bf16* hc = b.HC + (size_t)kv * 4096 * 256; bf16* dst = kv == 0 ? b.KCMP : b.VCMP;
    naive_gemm(c, 4096, 64, 256, [=](int r, int k) { return bf2f(hc[(size_t)r * 256 + k]); }, p->in[kv == 0 ? 7 : 10] + (size_t)l * 256 * 64, 64,
               [=](int r, int col, float v) { dst[(size_t)r * 64 + col] = (bf16)f2bf((r & 255) == 255 ? 0.f : v); }); }
__device__ __noinline__ void P_win(KP p_, int l_) { const KP p = uni_kp(p_); const int l = __builtin_amdgcn_readfirstlane(l_); const Ctx c = make_ctx(p); const Bufs b = make_bufs(p->ws); ph_win_attn(c, b.QN, b.KW, b.VW, b.GATE, b.OWIN); }
__device__ __noinline__ void P_fox(KP p_, int l_) { const KP p = uni_kp(p_); const int l = __builtin_amdgcn_readfirstlane(l_); const Ctx c = make_ctx(p); const Bufs b = make_bufs(p->ws); ph_fox_attn(c, b.FQ, b.FK, b.FV, b.FL, b.ATT); }
__device__ __noinline__ void P_diff(KP p_, int l_) { const KP p = uni_kp(p_); const int l = __builtin_amdgcn_readfirstlane(l_); const Ctx c = make_ctx(p); const Bufs b = make_bufs(p->ws);
    ph_diff_attn(c, b.DQ, b.DK, b.DV, p->in[11] + (size_t)l * 128, p->in[12] + (size_t)l * 64, lambda_init_of(l), b.ATT); }
__device__ __noinline__ void P_cmpattn(KP p_, int l_) { const KP p = uni_kp(p_); const int l = __builtin_amdgcn_readfirstlane(l_); const Ctx c = make_ctx(p); const Bufs b = make_bufs(p->ws); ph_cmp_attn(c, b.QN, b.KCMP, b.VCMP, b.GATE, b.SEL, b.OCMP); }
__device__ __noinline__ void P_slc(KP p_, int l_) { const KP p = uni_kp(p_); const int l = __builtin_amdgcn_readfirstlane(l_); const Ctx c = make_ctx(p); const Bufs b = make_bufs(p->ws); ph_slc_attn(c, b.QN, b.KS, b.VS, b.GATE, b.SEL, b.OCMP, b.OWIN, b.ATT); }
__device__ __noinline__ void P_outproj(KP p_, int l_) { const KP p = uni_kp(p_); const int l = __builtin_amdgcn_readfirstlane(l_); const Ctx c = make_ctx(p); const Bufs b = make_bufs(p->ws);
    const bf16* A = b.ATT; float* xo = p->out; const float* xin = (l == 0) ? p->in[0] : p->out;
    naive_gemm(c, NT, D_, D_, [=](int r, int k) { return bf2f(A[(size_t)r * D_ + k]); }, p->in[13] + (size_t)l * D_ * D_, D_,
               [=](int r, int col, float v) { xo[(size_t)r * D_ + col] = xin[(size_t)r * D_ + col] + v; }); }
__device__ __noinline__ void P_route(KP p_, int l_) { const KP p = uni_kp(p_); const int l = __builtin_amdgcn_readfirstlane(l_); const Ctx c = make_ctx(p); const Bufs b = make_bufs(p->ws);
    ph_moe_route(c, p->out, p->in[14] + (size_t)l * D_, p->in[15] + (size_t)l * D_ * 4, p->in[16] + l * 4, p->in[17] + (size_t)l * D_ * 32, p->in[18] + l * 32, b.HN, b.ROUTE_E, b.ROUTE_W); }
__device__ __noinline__ void P_moe(KP p_, int l_) { const KP p = uni_kp(p_); const int l = __builtin_amdgcn_readfirstlane(l_); const Ctx c = make_ctx(p); const Bufs b = make_bufs(p->ws);
    ph_moe_naive(c, b.HN, b.ROUTE_E, b.ROUTE_W, p->in[19] + (size_t)l * NEXP * D_ * DEXP, p->in[20] + (size_t)l * NEXP * D_ * DEXP, p->in[21] + (size_t)l * NEXP * DEXP * D_, p->out); }
__device__ __noinline__ void P_final(KP p_) { const KP p = uni_kp(p_); const Ctx c = make_ctx(p); ph_norm_final(c, p->out, p->in[22]); }
__device__ __noinline__ void P_gridbar(KP p_) { const KP p = uni_kp(p_);
    XcdBarrier bar; bar.bar = (unsigned*)(p->ws + WS_CTL) + 4096; bar.x = xb_xcc_id(); bar.st = (volatile LAS unsigned*)((LAS unsigned char*)lds_raw + MISC_OFF) + 8;
    xcd_barrier(bar);
}

__global__ void __launch_bounds__(NTHREADS, 2) fwd_kernel(Params pp) {
    const KP p = (KP)__builtin_amdgcn_kernarg_segment_ptr();
    { volatile LAS unsigned* MISC = (volatile LAS unsigned*)((LAS unsigned char*)lds_raw + MISC_OFF); if (threadIdx.x < 32) MISC[threadIdx.x] = 0u; }
    __syncthreads();
    const int lo = p->ph_lo, hi = p->ph_hi;
    if (hi - lo > 1) (void)xcd_barrier_post((unsigned*)(p->ws + WS_CTL) + 4096, (volatile LAS unsigned*)((LAS unsigned char*)lds_raw + MISC_OFF) + 8);
#define IN(k) (lo <= (k) && (k) < hi)
#define SEAM(k) do { if (IN(k) && IN((k) + 1)) P_gridbar(p); } while (0)
    if (IN(0)) P_prologue(p);
    SEAM(0);
    for (int l = 0; l < L_; ++l) {
        const int P0 = 1 + l * PH_PER_LAYER;
        if (IN(P0 + 0)) P_norm1(p, l);
        SEAM(P0 + 0);
        if (IN(P0 + 1)) P_inproj_mfma(l);
        SEAM(P0 + 1);
        if (IN(P0 + 2)) { P_cmp1(p, l, 0); P_cmp1(p, l, 1); P_cumsum(p, l); }
        SEAM(P0 + 2);
        if (IN(P0 + 3)) { P_cmp2(p, l, 0); P_cmp2(p, l, 1);
            for (;;) { const int u = fetch_unit(p, l * 8 + 0); if (u >= 2048) break;
                if (u < 1024) { const int qb = 15 - (u >> 6), k = u & 63; if (k < 32) U_diff(p, k, qb, l); else U_fox(p, k - 32, qb); }
                else { const int w = u - 1024; U_win(p, w & 15, 63 - (w >> 4)); } } }
        SEAM(P0 + 3);
        if (IN(P0 + 4)) P_cmpattn(p, l);
        SEAM(P0 + 4);
        if (IN(P0 + 5)) { for (;;) { const int u = fetch_unit(p, l * 8 + 1); if (u >= 1024) break; U_slc(p, u & 15, 63 - (u >> 4)); } }
        SEAM(P0 + 5);
        if (IN(P0 + 6)) P_outproj_mfma(l);
        SEAM(P0 + 6);
        if (IN(P0 + 7)) P_route(p, l);
        SEAM(P0 + 7);
        if (IN(P0 + 8)) P_moe(p, l);
        SEAM(P0 + 8);
    }
    if (IN(1 + L_ * PH_PER_LAYER)) P_final(p);
#undef IN
#undef SEAM
}

extern "C" void kernel_launch(void* const* d_in, const int* in_sizes, int n_in, void* d_out, int out_size, void* d_ws, size_t ws_size, hipStream_t stream) {
    static int grid = 0;
    if (grid == 0) {
        if (n_in != 23 || out_size != NT * D_ || ws_size < WS_END) { fprintf(stderr, "kernel_launch: unexpected sizes n_in %d out %d ws %zu (need %zu)\n", n_in, out_size, ws_size, (size_t)WS_END); grid = -1; return; }
        int dev = 0, cus = 0, per_cu = 0;
        if (hipGetDevice(&dev) != hipSuccess || hipDeviceGetAttribute(&cus, hipDeviceAttributeMultiprocessorCount, dev) != hipSuccess) { grid = -1; return; }
        if (hipFuncSetAttribute((const void*)fwd_kernel, hipFuncAttributeMaxDynamicSharedMemorySize, LDS_BYTES) != hipSuccess) { fprintf(stderr, "kernel_launch: hipFuncSetAttribute failed\n"); grid = -1; return; }
        if (hipOccupancyMaxActiveBlocksPerMultiprocessor(&per_cu, (const void*)fwd_kernel, NTHREADS, LDS_BYTES) != hipSuccess || per_cu < 1) { fprintf(stderr, "kernel_launch: occupancy query says %d\n", per_cu); }
        (void)hipGetLastError();
        grid = cus;
    }
    if (grid < 0) return;
    (void)hipMemsetAsync((char*)d_ws + WS_CTL, 0, CTL_BYTES, stream);
    Params p{};
    for (int i = 0; i < 23; ++i) p.in[i] = (const float*)d_in[i];
    p.out = (float*)d_out; p.ws = (unsigned char*)d_ws;
#if N_LAUNCH_MODE == 0
    p.ph_lo = 0; p.ph_hi = N_PHASES;
    hipLaunchKernelGGL(fwd_kernel, dim3(grid), dim3(NTHREADS), LDS_BYTES, stream, p);
#else
    for (int k = 0; k < N_PHASES; ++k) { p.ph_lo = k; p.ph_hi = k + 1; hipLaunchKernelGGL(fwd_kernel, dim3(grid), dim3(NTHREADS), LDS_BYTES, stream, p); }
#endif
}
```

```cpp
#include <hip/hip_runtime.h>
#include <cstdio>
#include <cstdint>

#ifndef N_LAUNCH_MODE
#define N_LAUNCH_MODE 0
#endif

#define LAS __attribute__((address_space(3)))
#define GAS __attribute__((address_space(1)))
typedef unsigned short bf16;
typedef unsigned long long u64;
typedef float f32x4 __attribute__((ext_vector_type(4)));
typedef unsigned u32x4 __attribute__((ext_vector_type(4)));

constexpr int B_ = 8, T_ = 4096, D_ = 1024, NT = B_ * T_, L_ = 2;
constexpr int HD = 64, D_IN = 2844;
constexpr int N_CMP = 255, CMP_HID = 256;
constexpr int NEXP = 32, DEXP = 256;
constexpr float EPS = 1e-6f;
constexpr float LOG2E = 1.4426950408889634f;
constexpr int NWAVES = 8, NTHREADS = 512;

constexpr int C_NSAQ = 0, C_KV6 = 512, C_GATE = 1280, C_FQ = 1304, C_FF = 2072, C_DQ = 2076, C_DV = 2588;

constexpr size_t MiB = 1u << 20;
constexpr size_t WS_CTL = 0, CTL_BYTES = 1 * MiB;
constexpr size_t WS_QN = 1 * MiB;
constexpr size_t WS_KV6 = WS_QN + 32 * MiB;
constexpr size_t KV6_STRIDE = 8 * MiB + 64 * 1024;
constexpr size_t WS_FQKV = WS_KV6 + 6 * KV6_STRIDE;
constexpr size_t WS_DQK = WS_FQKV + 48 * MiB;
constexpr size_t WS_DV = WS_DQK + 32 * MiB;
constexpr size_t WS_GATE = WS_DV + 16 * MiB;
constexpr size_t WS_FL = WS_GATE + 3 * MiB;
constexpr size_t WS_HC = WS_FL + 1 * MiB;
constexpr size_t WS_KVCMP = WS_HC + 4 * MiB;
constexpr size_t WS_SEL = WS_KVCMP + 1 * MiB;
constexpr size_t WS_OCMP = WS_SEL + 1 * MiB;
constexpr size_t WS_OWIN = WS_OCMP + 32 * MiB;
constexpr size_t WS_HN = WS_OWIN + 32 * MiB;
constexpr size_t WS_ATT = WS_HN + 64 * MiB;
constexpr size_t WS_ROUTE = WS_ATT + 64 * MiB;
constexpr size_t WS_WIN_T = WS_ROUTE + 2 * MiB;
constexpr size_t WS_WOUT_T = WS_WIN_T + 12 * MiB;
constexpr size_t WS_WGU_T = WS_WOUT_T + 4 * MiB;
constexpr size_t WS_WD_T = WS_WGU_T + 64 * MiB;
constexpr size_t WS_W1_T = WS_WD_T + 32 * MiB;
constexpr size_t WS_W2_T = WS_W1_T + 4 * MiB;
constexpr size_t WS_BIAS1 = WS_W2_T + 512 * 1024;
constexpr size_t WS_END = WS_BIAS1 + 512 * 1024;
constexpr int MOE_MAXROWS = 61440;
constexpr size_t WS_XS = WS_QN;
constexpr size_t WS_HB = WS_OCMP;
static_assert(WS_XS + (size_t)MOE_MAXROWS * 2048 <= WS_DQK && WS_HB + (size_t)MOE_MAXROWS * 1024 <= WS_HN, "MoE aliases");
constexpr size_t RT_INFO = 0, RT_W = 128 * 1024, RT_ROWTOK = 384 * 1024, RT_ROWW = 640 * 1024;
constexpr int CW_QUEUE = 16384, CW_MOECNT = 32768;
constexpr int TBL_OFF = 131072 + 1024;
constexpr int NIN = 3072;

extern __shared__ __attribute__((aligned(16))) unsigned char lds_raw[];
__device__ __forceinline__ float bf2f(bf16 v) { return __uint_as_float(((unsigned)v) << 16); }
__device__ __forceinline__ unsigned f2bf(float f) { unsigned u = __float_as_uint(f); return (u + 0x7fffu + ((u >> 16) & 1u)) >> 16; }
__device__ __forceinline__ unsigned pk2(float lo, float hi) { return f2bf(lo) | (f2bf(hi) << 16); }
__device__ __forceinline__ float wave_sum(float v) {
#pragma unroll
    for (int o = 1; o < 64; o <<= 1) v += __shfl_xor(v, o);
    return v;
}
__device__ __forceinline__ float wave_max(float v) {
#pragma unroll
    for (int o = 1; o < 64; o <<= 1) v = fmaxf(v, __shfl_xor(v, o));
    return v;
}
__device__ __forceinline__ float shflx_f(float v, int o, int lane) { return __uint_as_float((unsigned)__builtin_amdgcn_ds_bpermute((lane ^ o) << 2, (int)__float_as_uint(v))); }
__device__ __forceinline__ unsigned shflx_u(unsigned v, int o, int lane) { return (unsigned)__builtin_amdgcn_ds_bpermute((lane ^ o) << 2, (int)v); }
__device__ __forceinline__ float wave_sum_l(float v, int lane) {
#pragma unroll
    for (int o = 1; o < 64; o <<= 1) v += shflx_f(v, o, lane);
    return v;
}
__device__ __forceinline__ int launder_s(int v) { asm volatile("" : "+s"(v)); return v; }
__device__ __forceinline__ float sigmoidf_(float x) { return 1.f / (1.f + __expf(-x)); }
__device__ __forceinline__ float log_sigmoidf_(float x) { return x >= 0.f ? -log1pf(__expf(-x)) : x - log1pf(__expf(x)); }
__device__ __forceinline__ float gelu_tanh(float x) { const float u = 0.7978845608028654f * (x + 0.044715f * x * x * x); return 0.5f * x * (1.f + tanhf(u)); }
__device__ __forceinline__ float alibi_slope(int idx1, int n) { return exp2f(-8.0f * (float)idx1 / (float)n); }

#define XB_TMO      128
#define XB_XCNT(j)  (256  + 64 * (j))
#define XB_XSUB(j)  (1280 + 64 * (j))
#define XB_XGEN(j)  (2304 + 64 * (j))
#define XB_TOP      3328
#define XB_TOPGEN   3392
#define XCD_BAR_WORDS 3456
#define XB_SPIN_CAP (1u << 25)
__device__ __forceinline__ unsigned xb_ld(unsigned* p)              { return __hip_atomic_load(p, __ATOMIC_RELAXED, __HIP_MEMORY_SCOPE_AGENT); }
__device__ __forceinline__ unsigned xb_add(unsigned* p, unsigned v) { return __hip_atomic_fetch_add(p, v, __ATOMIC_RELAXED, __HIP_MEMORY_SCOPE_AGENT); }
__device__ __forceinline__ unsigned xb_xcc_id() { return (unsigned)__builtin_amdgcn_s_getreg((3 << 11) | 20) & 0xFu; }
#define XB_SPIN(cond, bar) do { unsigned _sp = 0; while (cond) { __builtin_amdgcn_s_sleep(1); \
    if ((++_sp & 255u) == 0u) { if (xb_ld(&(bar)[XB_TMO])) break; if (_sp > XB_SPIN_CAP) { atomicAdd(&(bar)[XB_TMO], 1u); break; } } } } while (0)
struct XcdBarrier { unsigned* bar; unsigned x; volatile LAS unsigned* st; };
__device__ __forceinline__ XcdBarrier xcd_barrier_post(unsigned* bar, volatile LAS unsigned* st) {
    XcdBarrier b; b.bar = bar; b.x = xb_xcc_id(); b.st = st;
    if (threadIdx.x == 0) (void)xb_add(&bar[XB_XCNT(b.x)], 1u);
    return b;
}
__device__ __forceinline__ void xcd_barrier_complete(unsigned* bar, unsigned x, unsigned& nloc, unsigned& nx) {
    const unsigned G = gridDim.x * gridDim.y * gridDim.z;
    unsigned sum, cnt, mine, sp = 0u;
    for (;;) {
        sum = 0u; cnt = 0u; mine = 0u;
#pragma unroll
        for (unsigned j = 0; j < 16; ++j) { const unsigned c = xb_ld(&bar[XB_XCNT(j)]); sum += c; cnt += (c > 0u) ? 1u : 0u; mine = (j == x) ? c : mine; }
        if (sum == G) break;
        __builtin_amdgcn_s_sleep(1);
        if ((++sp & 255u) == 0u) { if (xb_ld(&bar[XB_TMO])) break; if (sp > XB_SPIN_CAP) { atomicAdd(&bar[XB_TMO], 1u); break; } }
    }
    nloc = mine > 0u ? mine : 1u; nx = cnt > 0u ? cnt : 1u;
}
__device__ __forceinline__ void xcd_barrier(const XcdBarrier& b) {
    asm volatile("s_waitcnt vmcnt(0)" ::: "memory");
    __syncthreads();
    if (threadIdx.x == 0) {
        unsigned* bar = b.bar;
        __builtin_amdgcn_s_waitcnt(0);
        unsigned nloc = b.st[0], nx = b.st[1];
        if (nloc == 0u) { xcd_barrier_complete(bar, b.x, nloc, nx); b.st[0] = nloc; b.st[1] = nx; }
        const unsigned old = xb_add(&bar[XB_XSUB(b.x)], 1u);
        const unsigned gen = old / nloc;
        if (old + 1u == (gen + 1u) * nloc) {
            __builtin_amdgcn_fence(__ATOMIC_RELEASE, "agent");
            asm volatile("s_waitcnt vmcnt(0)" ::: "memory");
            const unsigned og = xb_add(&bar[XB_TOP], 1u);
            const unsigned tg = og / nx;
            if (og + 1u == (tg + 1u) * nx) xb_add(&bar[XB_TOPGEN], 1u);
            else XB_SPIN(xb_ld(&bar[XB_TOPGEN]) == tg, bar);
            __builtin_amdgcn_fence(__ATOMIC_ACQUIRE, "agent");
            xb_add(&bar[XB_XGEN(b.x)], 1u);
            asm volatile("s_waitcnt vmcnt(0)" ::: "memory");
        } else {
            XB_SPIN(xb_ld(&bar[XB_XGEN(b.x)]) == gen, bar);
            __builtin_amdgcn_fence(__ATOMIC_ACQUIRE, "agent");
            asm volatile("s_waitcnt vmcnt(0)" ::: "memory");
        }
    }
    __syncthreads();
}

struct Params { const float* in[23]; float* out; unsigned char* ws; int ph_lo, ph_hi; };
constexpr int LDS_BYTES = 147456;
constexpr int MISC_OFF = 131072 + 320;

struct Ctx {
    LAS unsigned char* lds; int tid, lane, wave, bid, G, gw, ngw;
    const float* const* in; float* xcur; unsigned char* ws;
};

namespace pg8 {
#define PG8_LAS __attribute__((address_space(3)))
typedef unsigned short bf16_t;
typedef short bf16x8 __attribute__((ext_vector_type(8)));
typedef float f32x4 __attribute__((ext_vector_type(4)));
typedef unsigned u32x4 __attribute__((ext_vector_type(4)));
constexpr int BM = 256, BK = 64, HALF = 128, HTB = HALF * BK * 2  , STAGE_BYTES = 8 * HTB, NXCD = 8, WGM = 8;

__host__ __device__ __forceinline__ int lds_byte(int r, int c) { const int st = (r >> 4) * 2 + (c >> 5), rr = r & 15, cc = c & 31, ob = rr * 64 + cc * 2; return st * 1024 + (ob ^ (((ob >> 9) & 1) << 5)); }
__host__ __device__ __forceinline__ void stage_rc(int b, int& R, int& C) { const int st = b / 1024, sb = b % 1024, swz = sb ^ (((sb >> 9) & 1) << 5); R = (st >> 1) * 16 + swz / 64; C = (st & 1) * 32 + (swz % 64) / 2; }
__host__ __device__ __forceinline__ int perm32(int rho) { const int n = rho >> 4, i = rho & 15; return 8 * (i >> 2) + 4 * n + (i & 3); }

struct Unit { int pm, pn; const char* a; const char* b; const char* b2; };
struct Gemm { int lda, ldb, K, ksplit; };

__device__ __forceinline__ unsigned cvt_pk_bf16(float lo, float hi) { unsigned r; asm volatile("v_cvt_pk_bf16_f32 %0, %1, %2" : "=v"(r) : "v"(lo), "v"(hi)); return r; }
typedef float f32x2 __attribute__((ext_vector_type(2)));

template <class Epi, class Sched, bool ALIGN_EPI = false, bool SP2 = false>
__device__ __forceinline__ void gemm_phase(PG8_LAS unsigned char* lds, const Gemm g, const Sched& S, const Epi& E) {
    int tid_ = threadIdx.x; asm volatile("" : "+v"(tid_));
    const int tid = tid_, wid = __builtin_amdgcn_readfirstlane(tid >> 6), lane = tid & 63, wr = wid >> 2, wc = wid & 3, fr = lane & 15, fq = lane >> 4;
    const int K = g.K, nt = K / BK, ks = g.ksplit;
    unsigned voffA[2], voffB[2];
#pragma unroll
    for (int i = 0; i < 2; ++i) { int R, C; stage_rc(tid * 16 + i * 8192, R, C); const int Rb = Epi::PERM ? ((R & ~31) + perm32(R & 31)) : R;
        voffA[i] = (unsigned)(R * g.lda + C) * 2u; voffB[i] = (unsigned)(Rb * g.ldb + C) * 2u; }
    const size_t kstep = (size_t)(BK * 2);
    const size_t hsA = (size_t)HALF * g.lda * 2, hsB = (size_t)HALF * g.ldb * 2;
    const unsigned ldsw = (unsigned)wid * 1024u;
    const int aoff = lds_byte(wr * 64 + fr, fq * 8), boff = lds_byte(wc * 32 + fr, fq * 8);
#define PG8_SA(b, h) (((b) * 2 + (h)) * HTB)
#define PG8_SB(b, h) ((4 + (b) * 2 + (h)) * HTB)
#define PG8_STAGE(bufoff, gbase, voff) do { _Pragma("unroll") for (int _i = 0; _i < 2; ++_i) \
        __builtin_amdgcn_global_load_lds((const unsigned*)((const char*)(gbase) + (voff)[_i]), (PG8_LAS unsigned*)(lds + (bufoff) + ldsw + _i * 8192), 16, 0, 0); } while (0)
#define PG8_LDA(dst, b, h) do { _Pragma("unroll") for (int m = 0; m < 4; ++m) _Pragma("unroll") for (int k = 0; k < 2; ++k) dst[m][k] = *(const PG8_LAS bf16x8*)(lds + PG8_SA(b, h) + aoff + m * 2048 + k * 1024); } while (0)
#define PG8_LDB(dst, b, h) do { _Pragma("unroll") for (int n = 0; n < 2; ++n) _Pragma("unroll") for (int k = 0; k < 2; ++k) dst[n][k] = *(const PG8_LAS bf16x8*)(lds + PG8_SB(b, h) + boff + n * 2048 + k * 1024); } while (0)
#define PG8_MMA(ai, bj, At, Bt) do { __builtin_amdgcn_s_setprio(1); _Pragma("unroll") for (int m = 0; m < 4; ++m) _Pragma("unroll") for (int n = 0; n < 2; ++n) _Pragma("unroll") for (int k = 0; k < 2; ++k) \
        acc[ai][bj][m][n] = __builtin_amdgcn_mfma_f32_16x16x32_bf16(Bt[n][k], At[m][k], acc[ai][bj][m][n], 0, 0, 0); __builtin_amdgcn_s_setprio(0); } while (0)
#define PG8_WAIT_V(n) asm volatile("s_waitcnt vmcnt(" #n ")" ::: "memory")
#define PG8_WAIT_L(n) asm volatile("s_waitcnt lgkmcnt(" #n ")" ::: "memory")
#define PG8_BAR __builtin_amdgcn_s_barrier()
#define PG8_SCHED __builtin_amdgcn_sched_barrier(0)
    Unit cur, nxt; int ui = 0;
    if (!S.next(0, cur)) return;
    f32x4 acc[2][2][4][2];
#pragma unroll
    for (int a = 0; a < 2; ++a)
#pragma unroll
        for (int b = 0; b < 2; ++b)
#pragma unroll
            for (int m = 0; m < 4; ++m)
#pragma unroll
                for (int n = 0; n < 2; ++n) acc[a][b][m][n] = (f32x4){0.f, 0.f, 0.f, 0.f};
    bf16x8 At[4][2], B0[2][2], B1[2][2];
    const char* cA = cur.a; const char* cB = cur.b; const char* cB2 = cur.b2;
#define PG8_BK(base, base2, kt) ((kt) < ks ? (base) + (size_t)(kt) * kstep : (base2) + (size_t)((kt) - ks) * kstep)
    S.a_ready(cur);
    if constexpr (SP2) {
        PG8_STAGE(PG8_SB(0, 0), cB, voffB); PG8_STAGE(PG8_SB(0, 1), cB + hsB, voffB); PG8_STAGE(PG8_SA(0, 0), cA, voffA); PG8_STAGE(PG8_SA(0, 1), cA + hsA, voffA);
        if (wr == 1) PG8_BAR;
        PG8_WAIT_V(2); PG8_BAR;
        PG8_STAGE(PG8_SB(1, 0), PG8_BK(cB, cB2, 1), voffB); PG8_STAGE(PG8_SA(1, 0), cA + kstep, voffA); PG8_STAGE(PG8_SB(1, 1), PG8_BK(cB, cB2, 1) + hsB, voffB);
        PG8_WAIT_V(6); PG8_BAR;
    } else {
        PG8_STAGE(PG8_SB(0, 0), cB, voffB); PG8_STAGE(PG8_SA(0, 0), cA, voffA); PG8_STAGE(PG8_SB(0, 1), cB + hsB, voffB); PG8_STAGE(PG8_SA(0, 1), cA + hsA, voffA);
        if (wr == 1) PG8_BAR;
        PG8_WAIT_V(4); PG8_BAR;
        PG8_STAGE(PG8_SB(1, 0), PG8_BK(cB, cB2, 1), voffB); PG8_STAGE(PG8_SA(1, 0), cA + kstep, voffA); PG8_STAGE(PG8_SB(1, 1), PG8_BK(cB, cB2, 1) + hsB, voffB);
        PG8_WAIT_V(6); PG8_BAR;
    }
    for (;;) {
        const bool has_next = S.next(ui + 1, nxt);
        const char* nA = has_next ? nxt.a : cA; const char* nB = has_next ? nxt.b : cB; const char* nB2 = has_next ? nxt.b2 : cB2;
        for (int t = 0; t < nt; t += 2) {
            const bool last = (t == nt - 2);
            const char* a1 = cA + (size_t)(t + 1) * kstep;
            const char* a2 = last ? nA : cA + (size_t)(t + 2) * kstep; const char* b2 = last ? PG8_BK(nB, nB2, 0) : PG8_BK(cB, cB2, t + 2);
            const char* a3 = a2 + kstep; const char* b3 = last ? PG8_BK(nB, nB2, 1) : PG8_BK(cB, cB2, t + 3);
            if (last && has_next) S.a_ready(nxt);
            if constexpr (SP2) {
            PG8_LDB(B0, 0, 0); PG8_LDB(B1, 0, 1); PG8_SCHED; PG8_LDA(At, 0, 0); PG8_STAGE(PG8_SA(1, 1), a1 + hsA, voffA);
            PG8_WAIT_V(8); PG8_WAIT_L(0); PG8_BAR; PG8_MMA(0, 0, At, B0); PG8_MMA(0, 1, At, B1); PG8_BAR; PG8_SCHED;
            PG8_LDA(At, 0, 1); PG8_STAGE(PG8_SB(0, 0), b2, voffB); PG8_STAGE(PG8_SB(0, 1), b2 + hsB, voffB); PG8_STAGE(PG8_SA(0, 0), a2, voffA);
            PG8_WAIT_V(8); PG8_WAIT_L(0); PG8_BAR; PG8_MMA(1, 0, At, B0); PG8_MMA(1, 1, At, B1); PG8_BAR; PG8_SCHED;
            PG8_LDB(B0, 1, 0); PG8_LDB(B1, 1, 1); PG8_SCHED; PG8_LDA(At, 1, 0); PG8_STAGE(PG8_SA(0, 1), a2 + hsA, voffA);
            PG8_WAIT_V(8); PG8_WAIT_L(0); PG8_BAR; PG8_MMA(0, 0, At, B0); PG8_MMA(0, 1, At, B1); PG8_BAR; PG8_SCHED;
            PG8_LDA(At, 1, 1); PG8_STAGE(PG8_SB(1, 0), b3, voffB); PG8_STAGE(PG8_SB(1, 1), b3 + hsB, voffB); PG8_STAGE(PG8_SA(1, 0), a3, voffA);
            PG8_WAIT_V(8); PG8_WAIT_L(0); PG8_BAR; PG8_MMA(1, 0, At, B0); PG8_MMA(1, 1, At, B1); PG8_BAR; PG8_SCHED;
            } else {
            PG8_LDB(B0, 0, 0); PG8_SCHED; PG8_LDA(At, 0, 0); PG8_STAGE(PG8_SA(1, 1), a1 + hsA, voffA);
            PG8_WAIT_L(8); PG8_BAR; PG8_WAIT_L(0); PG8_MMA(0, 0, At, B0); PG8_BAR; PG8_SCHED;
            PG8_LDB(B1, 0, 1); PG8_STAGE(PG8_SB(0, 0), b2, voffB);
            PG8_BAR; PG8_WAIT_L(0); PG8_MMA(0, 1, At, B1); PG8_BAR;
            PG8_LDA(At, 0, 1); PG8_STAGE(PG8_SA(0, 0), a2, voffA);
            PG8_BAR; PG8_WAIT_L(0); PG8_MMA(1, 0, At, B0); PG8_BAR; PG8_SCHED;
            PG8_STAGE(PG8_SB(0, 1), b2 + hsB, voffB);
            PG8_WAIT_V(6); PG8_BAR; PG8_MMA(1, 1, At, B1); PG8_BAR;
            PG8_LDB(B0, 1, 0); PG8_SCHED; PG8_LDA(At, 1, 0); PG8_STAGE(PG8_SA(0, 1), a2 + hsA, voffA);
            PG8_WAIT_L(8); PG8_BAR; PG8_WAIT_L(0); PG8_MMA(0, 0, At, B0); PG8_BAR; PG8_SCHED;
            PG8_LDB(B1, 1, 1); PG8_STAGE(PG8_SB(1, 0), b3, voffB);
            PG8_BAR; PG8_WAIT_L(0); PG8_MMA(0, 1, At, B1); PG8_BAR;
            PG8_LDA(At, 1, 1); PG8_STAGE(PG8_SA(1, 0), a3, voffA);
            PG8_BAR; PG8_WAIT_L(0); PG8_MMA(1, 0, At, B0); PG8_BAR; PG8_SCHED;
            PG8_STAGE(PG8_SB(1, 1), b3 + hsB, voffB);
            PG8_WAIT_V(6); PG8_BAR; PG8_MMA(1, 1, At, B1); PG8_BAR;
            }
        }
        if constexpr (ALIGN_EPI) { if (wr == 0) PG8_BAR; }
        if constexpr (!Epi::AFTER_DRAIN) { E(acc, cur, wr, wc, fr, fq); S.done(cur); }
        if (!has_next) break;
#pragma unroll
        for (int a = 0; a < 2; ++a)
#pragma unroll
            for (int b = 0; b < 2; ++b)
#pragma unroll
                for (int m = 0; m < 4; ++m)
#pragma unroll
                    for (int n = 0; n < 2; ++n) acc[a][b][m][n] = (f32x4){0.f, 0.f, 0.f, 0.f};
        cur = nxt; cA = nA; cB = nB; cB2 = nB2; ++ui;
        if constexpr (ALIGN_EPI) { if (wr == 1) PG8_BAR; }
    }
    PG8_WAIT_V(0);
    if constexpr (!ALIGN_EPI) { if (wr == 0) PG8_BAR; }
    PG8_BAR;
    if constexpr (Epi::AFTER_DRAIN) { E.fused(acc, cur, wr, wc, fr, fq, lds, wid, lane); S.done(cur); }
#undef PG8_BK
#undef PG8_SA
#undef PG8_SB
#undef PG8_STAGE
#undef PG8_LDA
#undef PG8_LDB
#undef PG8_MMA
#undef PG8_WAIT_V
#undef PG8_WAIT_L
#undef PG8_BAR
#undef PG8_SCHED
}
}

struct PlainOrder {
    const char* A; const char* Bt; int lda, ldb, nM, nN, nwg, G, c;
    __device__ __forceinline__ void init(const void* A_, const void* Bt_, int lda_, int ldb_, int M, int N, int G_, int c_) { A = (const char*)A_; Bt = (const char*)Bt_; lda = lda_; ldb = ldb_; nM = M / 256; nN = N / 256; nwg = nM * nN; G = G_; c = c_; }
    __device__ __forceinline__ bool next(int i, pg8::Unit& u) const {
        const long L = (long)i * G + c; if (L >= nwg) return false;
        int wgid = (int)L; { const int q = nwg / 8, r = nwg % 8, xcd = wgid % 8, off = wgid / 8; wgid = (xcd < r ? xcd * (q + 1) : r * (q + 1) + (xcd - r) * q) + off; }
        const int nig = 8 * nN, gid = wgid / nig, fm = gid * 8, gsz = (nM - fm) < 8 ? (nM - fm) : 8;
        u.pm = fm + ((wgid % nig) % gsz); u.pn = (wgid % nig) / gsz;
        u.a = A + (size_t)u.pm * 256 * lda * 2; u.b = Bt + (size_t)u.pn * 256 * ldb * 2; u.b2 = u.b; return true;
    }
    __device__ __forceinline__ void a_ready(const pg8::Unit&) const {}
    __device__ __forceinline__ void done(const pg8::Unit&) const {}
};
struct EpiInProj {
    static constexpr bool PERM = true, AFTER_DRAIN = false;
    unsigned char* ws; const float* b_gate; const float* b_fgt;
    __device__ __forceinline__ void operator()(const pg8::f32x4 (&acc)[2][2][4][2], const pg8::Unit& u, int wr, int wc, int fr, int fq) const {
        { int t_ = threadIdx.x; asm volatile("" : "+v"(t_)); fr = t_ & 15; fq = (t_ >> 4) & 3; }
        const int pn = u.pn, b = (u.pm * 256) / T_, t0 = u.pm * 256 - b * T_ + wr * 64 + fr;
        if (pn == 11) {
            if (wc == 0 && fq < 4) {
                float* gate = (float*)(ws + WS_GATE); float* fl = (float*)(ws + WS_FL);
#pragma unroll
                for (int ai = 0; ai < 2; ++ai)
#pragma unroll
                    for (int m = 0; m < 4; ++m) { const int t = t0 + ai * 128 + m * 16; const size_t n = (size_t)b * T_ + t;
#pragma unroll
                        for (int nn = 0; nn < 2; ++nn)
#pragma unroll
                            for (int e = 0; e < 4; ++e) { const int c = 8 * fq + 4 * nn + e; const float v = acc[ai][0][m][nn][e];
                                if (c < 24) gate[n * 24 + c] = sigmoidf_(v + b_gate[c]);
                                else if (c < 28) fl[(size_t)(b * 4 + (c - 24)) * T_ + t] = log_sigmoidf_(v + b_fgt[c - 24]); } }
            }
            return;
        }
#pragma unroll
        for (int bj = 0; bj < 2; ++bj) {
            const int c = bj * 128 + wc * 32 + 8 * fq;
            bf16* base; int W = 64; float sc = 1.f;
            if (pn < 2) { base = (bf16*)(ws + WS_QN) + (size_t)(b * 8 + pn * 4 + (c >> 6)) * T_ * 64 + (c & 63); sc = 0.125f * LOG2E; }
            else if (pn < 5) { base = (bf16*)(ws + WS_KV6 + (size_t)((pn - 2) * 2 + (c >> 7)) * KV6_STRIDE) + (size_t)(b * 2 + ((c >> 6) & 1)) * T_ * 64 + (c & 63); }
            else if (pn < 8) { base = (bf16*)(ws + WS_FQKV) + (size_t)(pn - 5) * (8 * MiB) + (size_t)(b * 4 + (c >> 6)) * T_ * 64 + (c & 63); if (pn == 5) sc = 0.125f * LOG2E; }
            else if (pn < 10) { base = (bf16*)(ws + WS_DQK) + (size_t)(pn - 8) * (8 * MiB) + (size_t)(b * 8 + (c >> 5)) * T_ * 32 + (c & 31); W = 32; if (pn == 8) sc = 0.17677669529663687f * LOG2E; }
            else { base = (bf16*)(ws + WS_DV) + (size_t)(b * 4 + (c >> 6)) * T_ * 64 + (c & 63); }
#pragma unroll
            for (int ai = 0; ai < 2; ++ai)
#pragma unroll
                for (int m = 0; m < 4; ++m) { const int t = t0 + ai * 128 + m * 16;
                    const pg8::f32x4 v0 = acc[ai][bj][m][0] * sc, v1 = acc[ai][bj][m][1] * sc;
                    pg8::u32x4 w; w.x = pg8::cvt_pk_bf16(v0[0], v0[1]); w.y = pg8::cvt_pk_bf16(v0[2], v0[3]); w.z = pg8::cvt_pk_bf16(v1[0], v1[1]); w.w = pg8::cvt_pk_bf16(v1[2], v1[3]);
                    *(pg8::u32x4*)(base + (size_t)t * W) = w; }
        }
    }
};
struct EpiResF32 {
    static constexpr bool PERM = false, AFTER_DRAIN = false;
    const float* base; float* out;
    __device__ __forceinline__ void operator()(const pg8::f32x4 (&acc)[2][2][4][2], const pg8::Unit& u, int wr, int wc, int fr, int fq) const {
        { int t_ = threadIdx.x; asm volatile("" : "+v"(t_)); fr = t_ & 15; fq = (t_ >> 4) & 3; }
#pragma unroll
        for (int ai = 0; ai < 2; ++ai)
#pragma unroll
            for (int m = 0; m < 4; ++m) { const size_t off = (size_t)(u.pm * 256 + ai * 128 + wr * 64 + m * 16 + fr) * D_ + u.pn * 256 + wc * 32 + 4 * fq;
#pragma unroll
                for (int bj = 0; bj < 2; ++bj)
#pragma unroll
                    for (int n = 0; n < 2; ++n) { const pg8::f32x4 bs = *(const pg8::f32x4*)(base + off + bj * 128 + n * 16); *(pg8::f32x4*)(out + off + bj * 128 + n * 16) = bs + acc[ai][bj][m][n]; } }
    }
};

struct OneUnitOrder { pg8::Unit u; bool has;
    __device__ __forceinline__ bool next(int i, pg8::Unit& o) const { if (i != 0 || !has) return false; o = u; return true; }
    __device__ __forceinline__ void a_ready(const pg8::Unit&) const {}
    __device__ __forceinline__ void done(const pg8::Unit&) const {} };
__device__ __forceinline__ float gelu_tanh_fast(float x) { const float u2 = 1.5957691216057308f * (x + 0.044715f * x * x * x); return x * __builtin_amdgcn_rcpf(1.f + __builtin_amdgcn_exp2f(-u2 * LOG2E)); }
struct EpiCmpH {
    static constexpr bool PERM = true, AFTER_DRAIN = false;
    bf16* hc; const float* bias1;
    __device__ __forceinline__ void operator()(const pg8::f32x4 (&acc)[2][2][4][2], const pg8::Unit& u, int wr, int wc, int fr, int fq) const {
        { int t_ = threadIdx.x; asm volatile("" : "+v"(t_)); fr = t_ & 15; fq = (t_ >> 4) & 3; }
        const int kv = u.pn;
#pragma unroll
        for (int bj = 0; bj < 2; ++bj) { const int col = bj * 128 + wc * 32 + 8 * fq;
            const pg8::f32x4 b0 = *(const pg8::f32x4*)(bias1 + kv * 256 + col), b1 = *(const pg8::f32x4*)(bias1 + kv * 256 + col + 4);
#pragma unroll
            for (int ai = 0; ai < 2; ++ai)
#pragma unroll
                for (int m = 0; m < 4; ++m) { const int row = u.pm * 256 + ai * 128 + wr * 64 + m * 16 + fr;
                    const pg8::f32x4 v0 = acc[ai][bj][m][0] + b0, v1 = acc[ai][bj][m][1] + b1;
                    pg8::u32x4 w; w.x = pg8::cvt_pk_bf16(gelu_tanh_fast(v0[0]), gelu_tanh_fast(v0[1])); w.y = pg8::cvt_pk_bf16(gelu_tanh_fast(v0[2]), gelu_tanh_fast(v0[3]));
                    w.z = pg8::cvt_pk_bf16(gelu_tanh_fast(v1[0]), gelu_tanh_fast(v1[1])); w.w = pg8::cvt_pk_bf16(gelu_tanh_fast(v1[2]), gelu_tanh_fast(v1[3]));
                    *(pg8::u32x4*)(hc + ((size_t)kv * 4096 + row) * 256 + col) = w; } }
    }
};
struct EpiCmpOut {
    static constexpr bool PERM = true, AFTER_DRAIN = false;
    bf16* kvcmp;
    __device__ __forceinline__ void operator()(const pg8::f32x4 (&acc)[2][2][4][2], const pg8::Unit& u, int wr, int wc, int fr, int fq) const {
        { int t_ = threadIdx.x; asm volatile("" : "+v"(t_)); fr = t_ & 15; fq = (t_ >> 4) & 3; }
        if (wc >= 2) return;
        const int kv = u.pn, col = wc * 32 + 8 * fq;
#pragma unroll
        for (int ai = 0; ai < 2; ++ai)
#pragma unroll
            for (int m = 0; m < 4; ++m) { const int row = u.pm * 256 + ai * 128 + wr * 64 + m * 16 + fr; const float z = ((row & 255) == 255) ? 0.f : 1.f;
                const pg8::f32x4 v0 = acc[ai][0][m][0], v1 = acc[ai][0][m][1];
                pg8::u32x4 w; w.x = pg8::cvt_pk_bf16(z != 0.f ? v0[0] : 0.f, z != 0.f ? v0[1] : 0.f); w.y = pg8::cvt_pk_bf16(z != 0.f ? v0[2] : 0.f, z != 0.f ? v0[3] : 0.f);
                w.z = pg8::cvt_pk_bf16(z != 0.f ? v1[0] : 0.f, z != 0.f ? v1[1] : 0.f); w.w = pg8::cvt_pk_bf16(z != 0.f ? v1[2] : 0.f, z != 0.f ? v1[3] : 0.f);
                *(pg8::u32x4*)(kvcmp + ((size_t)kv * 4096 + row) * 64 + col) = w; }
    }
};

__device__ __forceinline__ void moe_build_tables(const unsigned* cnt, int tid) {
    LAS int* T = (LAS int*)((LAS unsigned char*)lds_raw + TBL_OFF);
    __syncthreads();
    if (tid < 112) T[128 + 256 + tid] = (int)((cnt[tid] + 255u) >> 8);
    __syncthreads();
    if (tid == 0) { int o = 0; for (int c = 0; c < 112; ++c) { T[c] = o; const int n = T[128 + 256 + c]; for (int k = 0; k < n; ++k) T[128 + o + k] = c; o += n; } T[112] = o; }
    __syncthreads();
}
__device__ __forceinline__ void moe_pair(int cls, int& ea, int& eb) { const int grp = cls / 28; int idx = cls % 28, lo = 0; while (idx >= 7 - lo) { idx -= 7 - lo; ++lo; } ea = grp * 8 + lo; eb = grp * 8 + lo + 1 + idx; }
struct MoeOrder1 {
    const char* xs; const char* wgu; int G, c;
    __device__ __forceinline__ bool next(int i, pg8::Unit& u) const {
        const LAS int* T = (const LAS int*)((LAS unsigned char*)lds_raw + TBL_OFF);
        const int idx = i * G + c; if (idx >= 4 * T[112]) return false;
        const int tile = idx >> 2, pn = idx & 3; int ea, eb; moe_pair(T[128 + tile], ea, eb); const int e = (pn >> 1) ? eb : ea;
        u.pm = tile; u.pn = pn; u.a = xs + (size_t)tile * 256 * 2048; u.b = wgu + ((size_t)e * 512 + (pn & 1) * 256) * 2048; u.b2 = u.b; return true; }
    __device__ __forceinline__ void a_ready(const pg8::Unit&) const {}
    __device__ __forceinline__ void done(const pg8::Unit&) const {} };
struct MoeOrder2 {
    const char* hb; const char* wd; int G, c;
    __device__ __forceinline__ bool next(int i, pg8::Unit& u) const {
        const LAS int* T = (const LAS int*)((LAS unsigned char*)lds_raw + TBL_OFF);
        const int idx = i * G + c; if (idx >= 4 * T[112]) return false;
        const int tile = idx >> 2, pn = idx & 3; int ea, eb; moe_pair(T[128 + tile], ea, eb);
        u.pm = tile; u.pn = pn; u.a = hb + (size_t)tile * 256 * 1024; u.b = wd + ((size_t)ea * 1024 + pn * 256) * 512; u.b2 = wd + ((size_t)eb * 1024 + pn * 256) * 512; return true; }
    __device__ __forceinline__ void a_ready(const pg8::Unit&) const {}
    __device__ __forceinline__ void done(const pg8::Unit&) const {} };
struct EpiMoeH {
    static constexpr bool PERM = true, AFTER_DRAIN = false;
    bf16* hb; const float* roww;
    __device__ __forceinline__ void operator()(const pg8::f32x4 (&acc)[2][2][4][2], const pg8::Unit& u, int wr, int wc, int fr, int fq) const {
        { int t_ = threadIdx.x; asm volatile("" : "+v"(t_)); fr = t_ & 15; fq = (t_ >> 4) & 3; }
        const int slot = u.pn >> 1;
#pragma unroll
        for (int ai = 0; ai < 2; ++ai)
#pragma unroll
            for (int m = 0; m < 4; ++m) { const size_t row = (size_t)u.pm * 256 + ai * 128 + wr * 64 + m * 16 + fr; const float w = roww[row * 2 + slot];
#pragma unroll
                for (int bj = 0; bj < 2; ++bj) { const int j0 = (u.pn & 1) * 128 + (bj * 128 + wc * 32 + 8 * fq) / 2;
                    const pg8::f32x4 v0 = acc[ai][bj][m][0], v1 = acc[ai][bj][m][1];
                    const float h0 = v0[0] * __builtin_amdgcn_rcpf(1.f + __builtin_amdgcn_exp2f(-v0[0] * LOG2E)) * v0[1] * w, h1 = v0[2] * __builtin_amdgcn_rcpf(1.f + __builtin_amdgcn_exp2f(-v0[2] * LOG2E)) * v0[3] * w;
                    const float h2 = v1[0] * __builtin_amdgcn_rcpf(1.f + __builtin_amdgcn_exp2f(-v1[0] * LOG2E)) * v1[1] * w, h3 = v1[2] * __builtin_amdgcn_rcpf(1.f + __builtin_amdgcn_exp2f(-v1[2] * LOG2E)) * v1[3] * w;
                    *(u64*)(hb + row * 512 + slot * 256 + j0) = (u64)pg8::cvt_pk_bf16(h0, h1) | ((u64)pg8::cvt_pk_bf16(h2, h3) << 32); } }
    }
};
struct EpiMoeOut {
    static constexpr bool PERM = false, AFTER_DRAIN = false;
    float* x; const int* rowtok;
    __device__ __forceinline__ void operator()(const pg8::f32x4 (&acc)[2][2][4][2], const pg8::Unit& u, int wr, int wc, int fr, int fq) const {
        { int t_ = threadIdx.x; asm volatile("" : "+v"(t_)); fr = t_ & 15; fq = (t_ >> 4) & 3; }
#pragma unroll
        for (int ai = 0; ai < 2; ++ai)
#pragma unroll
            for (int m = 0; m < 4; ++m) { const int tok = rowtok[(size_t)u.pm * 256 + ai * 128 + wr * 64 + m * 16 + fr];
                if (tok >= 0) { float* xr = x + (size_t)tok * D_ + u.pn * 256 + wc * 32 + 4 * fq;
#pragma unroll
                    for (int bj = 0; bj < 2; ++bj)
#pragma unroll
                        for (int n = 0; n < 2; ++n) { pg8::f32x4* q = (pg8::f32x4*)(xr + bj * 128 + n * 16); *q = *q + acc[ai][bj][m][n]; } } }
    }
};

__device__ __forceinline__ void transpose_item(const float* W, int ldw, bf16* WT, int ldt, int r0, int rmul, int k0, LAS float* scr, int lane) {
#pragma unroll 8
    for (int i = 0; i < 32; ++i) { const int kk = 2 * i + (lane >> 5); scr[kk * 33 + (lane & 31)] = W[(size_t)(k0 + kk) * ldw + (lane & 31)]; }
    asm volatile("s_waitcnt lgkmcnt(0)" ::: "memory");
    const int c = lane & 7;
#pragma unroll
    for (int j = 0; j < 4; ++j) { const int n = (lane >> 3) + 8 * j; const LAS float* sp = scr + (8 * c) * 33 + n;
        u32x4 o; o.x = pk2(sp[0 * 33], sp[1 * 33]); o.y = pk2(sp[2 * 33], sp[3 * 33]); o.z = pk2(sp[4 * 33], sp[5 * 33]); o.w = pk2(sp[6 * 33], sp[7 * 33]);
        *(u32x4*)(WT + (size_t)(r0 + rmul * n) * ldt + k0 + 8 * c) = o; }
    asm volatile("s_waitcnt lgkmcnt(0)" ::: "memory");
}
__device__ __forceinline__ void transpose_seg(const float* W, int ldw, int K, int sc0, int ncol, bf16* WT, int r0, int rmul, int item, LAS float* scr, int lane) {
    const int nb = ncol / 32, kb = item / nb, cb = item % nb;
    transpose_item(W + sc0 + cb * 32, ldw, WT, K, r0 + rmul * cb * 32, rmul, kb * 64, scr, lane);
}

typedef float f32x16 __attribute__((ext_vector_type(16)));
typedef short bf16x8v __attribute__((ext_vector_type(8)));
typedef short s16x4 __attribute__((ext_vector_type(4)));
typedef float f32x2_t __attribute__((ext_vector_type(2)));
typedef __bf16 bf16x2_t __attribute__((ext_vector_type(2)));
constexpr int A_KBUF = 10240, A_VBUF = 9216;
constexpr int A_KOFF = 0, A_VOFF = 2 * A_KBUF, A_BOFF = A_VOFF + 2 * A_VBUF, A_LDS_END = A_BOFF + 2 * 256;
__device__ __forceinline__ constexpr int crow0(int reg) { return (reg & 3) + 8 * (reg >> 2); }
__device__ __forceinline__ float swap_max(float m) { auto rr = __builtin_amdgcn_permlane32_swap(__float_as_uint(m), __float_as_uint(m), false, false); return fmaxf(__uint_as_float(rr[0]), __uint_as_float(rr[1])); }
__device__ __forceinline__ float swap_sum(float m) { auto rr = __builtin_amdgcn_permlane32_swap(__float_as_uint(m), __float_as_uint(m), false, false); return __uint_as_float(rr[0]) + __uint_as_float(rr[1]); }
__device__ __forceinline__ unsigned cvtpk(float lo, float hi) { f32x2_t v = {lo, hi}; bf16x2_t b = __builtin_convertvector(v, bf16x2_t); return __builtin_bit_cast(unsigned, b); }
__device__ __forceinline__ bf16x8v pack8(const f32x16& p, int b0) { u32x4 w; w.x = cvtpk(p[b0 + 0], p[b0 + 1]); w.y = cvtpk(p[b0 + 2], p[b0 + 3]); w.z = cvtpk(p[b0 + 4], p[b0 + 5]); w.w = cvtpk(p[b0 + 6], p[b0 + 7]); return __builtin_bit_cast(bf16x8v, w); }
__device__ __forceinline__ s16x4 tr_read(const LAS unsigned char* p) { typedef short v4i16_t __attribute__((ext_vector_type(4))); return __builtin_bit_cast(s16x4, __builtin_amdgcn_ds_read_tr16_b64_v4i16((LAS v4i16_t*)p)); }

template <int DQK, int NMAP, bool FOX, bool SLC>
__device__ __forceinline__ void attn_core(LAS unsigned char* L, const bf16* Kb0, const bf16* Kb1, const bf16* Vb, const float* cum, float cum_ref,
                                          const bf16x8v (&Qf)[NMAP][DQK / 16], u64 tilemask, int t_lane, int tw0, int win, float slope2, unsigned selw0, unsigned selw1,
                                          f32x16 (&O)[NMAP][2], float (&M)[NMAP], float (&Ls)[NMAP], int tid) {
    constexpr int KP = DQK * 2 + 16;
    const int lane = tid & 63, r = lane & 31, h = lane >> 5;
    int kdst; const bf16* ksrc;
    if (DQK == 64) { kdst = (tid >> 3) * KP + (tid & 7) * 16; ksrc = Kb0 + (tid >> 3) * 64 + (tid & 7) * 8; }
    else { const int mp = tid >> 8, tt = tid & 255; kdst = mp * 5120 + (tt >> 2) * KP + (tt & 3) * 16; ksrc = (mp ? Kb1 : Kb0) + (tt >> 2) * 32 + (tt & 3) * 8; }
    const int vdst = (tid >> 3) * 144 + (tid & 7) * 16; const bf16* vsrc = Vb + (tid >> 3) * 64 + (tid & 7) * 8;
    const LAS unsigned char* kfrag = L + A_KOFF + r * KP + h * 16;
    const LAS unsigned char* vfrag = L + A_VOFF + (4 * h + ((lane & 15) >> 2)) * 144 + (16 * ((lane >> 4) & 1) + 4 * (lane & 3)) * 2;
    u32x4 kreg, vreg; float breg = 0.f;
    u64 mk = tilemask;
    int j = 63 - __builtin_clzll(mk); mk &= ~(1ull << j);
    { const int kv0 = j * 64; kreg = *(const u32x4*)(ksrc + (size_t)kv0 * DQK); vreg = *(const u32x4*)(vsrc + (size_t)kv0 * 64); if (FOX && tid < 64) breg = (cum_ref - cum[kv0 + tid]) * LOG2E; }
    *(LAS u32x4*)(L + A_KOFF + kdst) = kreg; *(LAS u32x4*)(L + A_VOFF + vdst) = vreg; if (FOX && tid < 64) *(LAS float*)(L + A_BOFF + tid * 4) = breg;
    __syncthreads();
    int buf = 0;
    for (;;) {
        const bool more = mk != 0ull; int jn = 0;
        if (more) { jn = 63 - __builtin_clzll(mk); mk &= ~(1ull << jn); const int kv0 = jn * 64;
            kreg = *(const u32x4*)(ksrc + (size_t)kv0 * DQK); vreg = *(const u32x4*)(vsrc + (size_t)kv0 * 64); if (FOX && tid < 64) breg = (cum_ref - cum[kv0 + tid]) * LOG2E; }
        { const int kv0 = j * 64;
          if (!(kv0 > tw0 + 31) && !(tw0 - (kv0 + 63) >= win)) {
            const bool need_mask = (kv0 + 63 > tw0) || (tw0 + 31 - kv0 >= win);
            const int dl = t_lane - kv0 - 4 * h;
            bool sel = true; if (SLC) sel = (j < 32 ? (selw0 >> j) : (selw1 >> (j - 32))) & 1u;
            bf16x8v pa[NMAP][4];
#pragma unroll
            for (int mp = 0; mp < NMAP; ++mp) {
                f32x16 p0, p1;
                if (FOX) { const LAS f32x4* bl = (const LAS f32x4*)(L + A_BOFF + buf * 256) + h;
#pragma unroll
                    for (int g4 = 0; g4 < 4; ++g4) { const f32x4 b0 = bl[2 * g4], b1 = bl[8 + 2 * g4];
                        p0[4 * g4 + 0] = b0.x; p0[4 * g4 + 1] = b0.y; p0[4 * g4 + 2] = b0.z; p0[4 * g4 + 3] = b0.w; p1[4 * g4 + 0] = b1.x; p1[4 * g4 + 1] = b1.y; p1[4 * g4 + 2] = b1.z; p1[4 * g4 + 3] = b1.w; } }
                else { const float base_l = slope2 * (float)(kv0 + 4 * h - tw0), s8 = slope2 * 8.f, s32 = slope2 * 32.f;
                    p0[0] = base_l; p0[1] = p0[0] + slope2; p0[2] = p0[1] + slope2; p0[3] = p0[2] + slope2;
#pragma unroll
                    for (int reg = 4; reg < 16; ++reg) p0[reg] = p0[reg - 4] + s8;
#pragma unroll
                    for (int reg = 0; reg < 16; ++reg) p1[reg] = p0[reg] + s32; }
                const LAS unsigned char* kb = kfrag + buf * A_KBUF + (DQK == 32 ? mp * 5120 : 0);
#pragma unroll
                for (int s = 0; s < DQK / 16; ++s) { const bf16x8v kf0 = *(const LAS bf16x8v*)(kb + s * 32), kf1 = *(const LAS bf16x8v*)(kb + 32 * KP + s * 32);
                    p0 = __builtin_amdgcn_mfma_f32_32x32x16_bf16(kf0, Qf[mp][s], p0, 0, 0, 0); p1 = __builtin_amdgcn_mfma_f32_32x32x16_bf16(kf1, Qf[mp][s], p1, 0, 0, 0); }
                if (need_mask) {
#pragma unroll
                    for (int reg = 0; reg < 16; ++reg) { const int d0 = dl - crow0(reg), d1 = d0 - 32;
                        p0[reg] = (d0 >= 0 && d0 < win) ? p0[reg] : -INFINITY; p1[reg] = (d1 >= 0 && d1 < win) ? p1[reg] : -INFINITY; } }
                float mt = fmaxf(p0[0], p1[0]);
#pragma unroll
                for (int reg = 1; reg < 16; ++reg) mt = fmaxf(mt, fmaxf(p0[reg], p1[reg]));
                mt = swap_max(mt); if (SLC && !sel) mt = -INFINITY;
                if (__any(mt > M[mp] + 8.f)) { const float mn = fmaxf(M[mp], mt), alpha = __builtin_amdgcn_exp2f(M[mp] - mn); O[mp][0] *= alpha; O[mp][1] *= alpha; Ls[mp] *= alpha; M[mp] = mn; }
                const float ms = (SLC && !sel) ? INFINITY : M[mp];
                float rs = 0.f;
#pragma unroll
                for (int reg = 0; reg < 16; ++reg) { p0[reg] = __builtin_amdgcn_exp2f(p0[reg] - ms); p1[reg] = __builtin_amdgcn_exp2f(p1[reg] - ms); rs += p0[reg] + p1[reg]; }
                Ls[mp] += rs;
                pa[mp][0] = pack8(p0, 0); pa[mp][1] = pack8(p0, 8); pa[mp][2] = pack8(p1, 0); pa[mp][3] = pack8(p1, 8);
            }
            const LAS unsigned char* vb = vfrag + buf * A_VBUF;
#pragma unroll
            for (int db = 0; db < 2; ++db)
#pragma unroll
                for (int ks = 0; ks < 4; ++ks) { const s16x4 lo = tr_read(vb + ks * (16 * 144) + db * 64), hi = tr_read(vb + ks * (16 * 144) + db * 64 + 8 * 144);
                    const bf16x8v vf = {lo[0], lo[1], lo[2], lo[3], hi[0], hi[1], hi[2], hi[3]};
#pragma unroll
                    for (int mp = 0; mp < NMAP; ++mp) O[mp][db] = __builtin_amdgcn_mfma_f32_32x32x16_bf16(vf, pa[mp][ks], O[mp][db], 0, 0, 0); }
          } }
        if (more) { *(LAS u32x4*)(L + A_KOFF + (buf ^ 1) * A_KBUF + kdst) = kreg; *(LAS u32x4*)(L + A_VOFF + (buf ^ 1) * A_VBUF + vdst) = vreg; if (FOX && tid < 64) *(LAS float*)(L + A_BOFF + (buf ^ 1) * 256 + tid * 4) = breg; }
        __syncthreads();
        if (!more) break;
        j = jn; buf ^= 1;
    }
}
#define ATTN_FOR_CHUNKS(db, g4) _Pragma("unroll") for (int db = 0; db < 2; ++db) _Pragma("unroll") for (int g4 = 0; g4 < 4; ++g4)

__device__ __forceinline__ void ph_norm_bf16(const Ctx& c, const float* x, const float* g, bf16* out) {
    for (int row = c.gw; row < NT; row += c.ngw) {
        const f32x4* xr = (const f32x4*)(x + (size_t)row * D_) + c.lane;
        f32x4 v[4]; float ss = 0.f;
#pragma unroll
        for (int j = 0; j < 4; ++j) { v[j] = xr[64 * j]; ss += v[j].x * v[j].x + v[j].y * v[j].y + v[j].z * v[j].z + v[j].w * v[j].w; }
        const float r = rsqrtf(wave_sum(ss) * (1.f / D_) + EPS);
        u64* o8 = (u64*)(out + (size_t)row * D_) + c.lane;
#pragma unroll
        for (int j = 0; j < 4; ++j) { const f32x4 gg = ((const f32x4*)g)[c.lane + 64 * j];
            o8[64 * j] = (u64)pk2(v[j].x * r * gg.x, v[j].y * r * gg.y) | ((u64)pk2(v[j].z * r * gg.z, v[j].w * r * gg.w) << 32); }
    }
}
__device__ __forceinline__ void ph_norm_final(const Ctx& c, float* x, const float* g) {
    for (int row = c.gw; row < NT; row += c.ngw) {
        f32x4* xr = (f32x4*)(x + (size_t)row * D_) + c.lane;
        f32x4 v[4]; float ss = 0.f;
#pragma unroll
        for (int j = 0; j < 4; ++j) { v[j] = xr[64 * j]; ss += v[j].x * v[j].x + v[j].y * v[j].y + v[j].z * v[j].z + v[j].w * v[j].w; }
        const float r = rsqrtf(wave_sum(ss) * (1.f / D_) + EPS);
#pragma unroll
        for (int j = 0; j < 4; ++j) { const f32x4 gg = ((const f32x4*)g)[c.lane + 64 * j]; xr[64 * j] = v[j] * r * gg; }
    }
}

template <class AF, class EF>
__device__ __forceinline__ void naive_gemm(const Ctx& c, int M, int N, int K, AF af, const float* W, int ldb, EF ef) {
    LAS float* As = (LAS float*)c.lds;
    LAS float* Bs = As + 16 * 132;
    const int tm = (M + 127) / 128, tn = (N + 127) / 128, ntile = tm * tn;
    const int ty = c.tid >> 4, tx = c.tid & 15;
    for (int tile = c.bid; tile < ntile; tile += c.G) {
        const int m0 = (tile / tn) * 128, n0 = (tile % tn) * 128;
        float acc[4][8];
#pragma unroll
        for (int i = 0; i < 4; ++i)
#pragma unroll
            for (int j = 0; j < 8; ++j) acc[i][j] = 0.f;
        for (int k0 = 0; k0 < K; k0 += 16) {
            __syncthreads();
#pragma unroll
            for (int i = 0; i < 4; ++i) { const int e = c.tid + i * 512, r = e >> 4, kk = e & 15; const int row = m0 + r;
                As[kk * 132 + r] = (row < M) ? af(row, k0 + kk) : 0.f; }
#pragma unroll
            for (int i = 0; i < 4; ++i) { const int e = c.tid + i * 512, kk = e >> 7, cc = e & 127; const int col = n0 + cc;
                Bs[kk * 132 + cc] = (col < N) ? W[(size_t)(k0 + kk) * ldb + col] : 0.f; }
            __syncthreads();
#pragma unroll 2
            for (int kk = 0; kk < 16; ++kk) {
                float a[4], b[8];
#pragma unroll
                for (int i = 0; i < 4; ++i) a[i] = As[kk * 132 + ty * 4 + i];
#pragma unroll
                for (int j = 0; j < 8; ++j) b[j] = Bs[kk * 132 + tx * 8 + j];
#pragma unroll
                for (int i = 0; i < 4; ++i)
#pragma unroll
                    for (int j = 0; j < 8; ++j) acc[i][j] = fmaf(a[i], b[j], acc[i][j]);
            }
        }
        LAS float* Cs = Bs + 16 * 132;
        __syncthreads();
#pragma unroll
        for (int i = 0; i < 4; ++i)
#pragma unroll
            for (int j = 0; j < 8; ++j) Cs[(ty * 4 + i) * 129 + tx * 8 + j] = acc[i][j];
        __syncthreads();
#pragma unroll 1
        for (int e = c.tid; e < 128 * 128; e += NTHREADS) { const int r = e >> 7, cc = e & 127, row = m0 + r, col = n0 + cc; if (row < M && col < N) ef(row, col, Cs[r * 129 + cc]); }
    }
    __syncthreads();
}

struct InProjOut { bf16* qn; bf16* kv6; bf16* fqkv; bf16* dqk; bf16* dv; float* gate; float* fl; const float* b_gate; const float* b_fgt; };
__device__ __forceinline__ void inproj_store(const InProjOut& o, int n, int col, float v) {
    const int b = n / T_, t = n % T_;
    if (col < C_KV6) { const int h = col >> 6, d = col & 63; o.qn[((size_t)(b * 8 + h) * T_ + t) * 64 + d] = (bf16)f2bf(v * (0.125f * LOG2E)); }
    else if (col < C_GATE) { const int cc = col - C_KV6, idx = cc >> 7, g = (cc >> 6) & 1, d = cc & 63;
        ((bf16*)((unsigned char*)o.kv6 + idx * KV6_STRIDE))[((size_t)(b * 2 + g) * T_ + t) * 64 + d] = (bf16)f2bf(v); }
    else if (col < C_FQ) { const int j = col - C_GATE; o.gate[(size_t)n * 24 + j] = sigmoidf_(v + o.b_gate[j]); }
    else if (col < C_FF) { const int cc = col - C_FQ, idx = cc >> 8, h = (cc >> 6) & 3, d = cc & 63;
        o.fqkv[(size_t)idx * (8 * MiB) + ((size_t)(b * 4 + h) * T_ + t) * 64 + d] = (bf16)f2bf(idx == 0 ? v * (0.125f * LOG2E) : v); }
    else if (col < C_DQ) { const int h = col - C_FF; o.fl[(size_t)(b * 4 + h) * T_ + t] = log_sigmoidf_(v + o.b_fgt[h]); }
    else if (col < C_DV) { const int cc = col - C_DQ, idx = cc >> 8, h = (cc >> 6) & 3, i = (cc >> 5) & 1, d = cc & 31;
        o.dqk[(size_t)idx * (8 * MiB) + ((size_t)((b * 4 + h) * 2 + i) * T_ + t) * 32 + d] = (bf16)f2bf(idx == 0 ? v * (0.17677669529663687f * LOG2E) : v); }
    else { const int cc = col - C_DV, h = cc >> 6, d = cc & 63; o.dv[((size_t)(b * 4 + h) * T_ + t) * 64 + d] = (bf16)f2bf(v); }
}

__device__ __forceinline__ void ph_cumsum(const Ctx& c, float* fl) {
    for (int s = c.gw; s < B_ * 4; s += c.ngw) {
        float* p = fl + (size_t)s * T_; float carry = 0.f;
        for (int t0 = 0; t0 < T_; t0 += 64) {
            float v = p[t0 + c.lane];
#pragma unroll
            for (int o = 1; o < 64; o <<= 1) { const float u = __shfl_up(v, o); if (c.lane >= o) v += u; }
            v += carry; p[t0 + c.lane] = v; carry = __shfl(v, 63);
        }
    }
}

template <int DQK>
__device__ __forceinline__ float naive_attn_row(const bf16* q, const bf16* K, const bf16* V, int t, u64 mask, float slope2, const float* cum, int win, int lane) {
    float qv[DQK];
    { const u32x4* q4 = (const u32x4*)q;
#pragma unroll
      for (int i = 0; i < DQK / 8; ++i) { const u32x4 w = q4[i];
          qv[8 * i + 0] = __uint_as_float(w.x << 16); qv[8 * i + 1] = __uint_as_float(w.x & 0xffff0000u);
          qv[8 * i + 2] = __uint_as_float(w.y << 16); qv[8 * i + 3] = __uint_as_float(w.y & 0xffff0000u);
          qv[8 * i + 4] = __uint_as_float(w.z << 16); qv[8 * i + 5] = __uint_as_float(w.z & 0xffff0000u);
          qv[8 * i + 6] = __uint_as_float(w.w << 16); qv[8 * i + 7] = __uint_as_float(w.w & 0xffff0000u); } }
    const float cumt = cum ? cum[t] : 0.f;
    float m = -INFINITY, l = 0.f, o = 0.f;
    while (mask) {
        const int j = __builtin_ctzll(mask); mask &= mask - 1;
        const int kpos = 64 * j + lane; const int dist = t - kpos;
        const bool valid = dist >= 0 && dist < win;
        float s = 0.f;
        { const u32x4* k4 = (const u32x4*)(K + (size_t)kpos * DQK);
#pragma unroll
          for (int i = 0; i < DQK / 8; ++i) { const u32x4 w = k4[i];
              s = fmaf(qv[8 * i + 0], __uint_as_float(w.x << 16), s); s = fmaf(qv[8 * i + 1], __uint_as_float(w.x & 0xffff0000u), s);
              s = fmaf(qv[8 * i + 2], __uint_as_float(w.y << 16), s); s = fmaf(qv[8 * i + 3], __uint_as_float(w.y & 0xffff0000u), s);
              s = fmaf(qv[8 * i + 4], __uint_as_float(w.z << 16), s); s = fmaf(qv[8 * i + 5], __uint_as_float(w.z & 0xffff0000u), s);
              s = fmaf(qv[8 * i + 6], __uint_as_float(w.w << 16), s); s = fmaf(qv[8 * i + 7], __uint_as_float(w.w & 0xffff0000u), s); } }
        s -= slope2 * (float)dist;
        if (cum) s += (cumt - cum[kpos]) * LOG2E;
        s = valid ? s : -INFINITY;
        const float mb = wave_max(s);
        if (mb == -INFINITY) continue;
        const float mn = fmaxf(m, mb), alpha = exp2f(m - mn);
        const float p = valid ? exp2f(s - mn) : 0.f;
        l = l * alpha + wave_sum(p); o *= alpha; m = mn;
        const bf16* vb = V + (size_t)(64 * j) * 64 + lane;
#pragma unroll 8
        for (int k = 0; k < 64; ++k) o = fmaf(__shfl(p, k), bf2f(vb[(size_t)k * 64]), o);
    }
    return l > 0.f ? o / l : 0.f;
}

__device__ __forceinline__ void ph_cmp_attn(const Ctx& c, const bf16* qn, const bf16* kcmp, const bf16* vcmp, const float* gate, u64* sel, bf16* ocmp) {
    LAS float* pl = (LAS float*)(c.lds) + c.wave * 256;
    const int lane = c.lane;
    for (int it = c.gw; it < B_ * 2 * T_; it += c.ngw) {
        const int t = it % T_, bg = it / T_, b = bg >> 1, g = bg & 1;
        const int nvis = (t >= 31) ? ((t - 31) >> 4) + 1 : 0;
        const bf16* kc = kcmp + (size_t)bg * 256 * 64; const bf16* vc = vcmp + (size_t)bg * 256 * 64;
        float imp = 0.f;
        for (int hg = 0; hg < 4; ++hg) {
            const int h = g * 4 + hg; const float slope2 = alibi_slope(h + 1, 8) * LOG2E;
            const bf16* q = qn + ((size_t)(b * 8 + h) * T_ + t) * 64;
            float qv[64];
            { const u32x4* q4 = (const u32x4*)q;
#pragma unroll
              for (int i = 0; i < 8; ++i) { const u32x4 w = q4[i];
                  qv[8 * i + 0] = __uint_as_float(w.x << 16); qv[8 * i + 1] = __uint_as_float(w.x & 0xffff0000u);
                  qv[8 * i + 2] = __uint_as_float(w.y << 16); qv[8 * i + 3] = __uint_as_float(w.y & 0xffff0000u);
                  qv[8 * i + 4] = __uint_as_float(w.z << 16); qv[8 * i + 5] = __uint_as_float(w.z & 0xffff0000u);
                  qv[8 * i + 6] = __uint_as_float(w.w << 16); qv[8 * i + 7] = __uint_as_float(w.w & 0xffff0000u); } }
            float s[4]; float m = -INFINITY;
#pragma unroll
            for (int i = 0; i < 4; ++i) { const int cc = lane + 64 * i; float a = 0.f;
                if (cc < nvis) { const u32x4* k4 = (const u32x4*)(kc + (size_t)cc * 64);
#pragma unroll
                    for (int e = 0; e < 8; ++e) { const u32x4 w = k4[e];
                        a = fmaf(qv[8 * e + 0], __uint_as_float(w.x << 16), a); a = fmaf(qv[8 * e + 1], __uint_as_float(w.x & 0xffff0000u), a);
                        a = fmaf(qv[8 * e + 2], __uint_as_float(w.y << 16), a); a = fmaf(qv[8 * e + 3], __uint_as_float(w.y & 0xffff0000u), a);
                        a = fmaf(qv[8 * e + 4], __uint_as_float(w.z << 16), a); a = fmaf(qv[8 * e + 5], __uint_as_float(w.z & 0xffff0000u), a);
                        a = fmaf(qv[8 * e + 6], __uint_as_float(w.w << 16), a); a = fmaf(qv[8 * e + 7], __uint_as_float(w.w & 0xffff0000u), a); }
                    a -= slope2 * (float)(t - (16 * cc + 31)); } else a = -INFINITY;
                s[i] = a; m = fmaxf(m, a); }
            m = wave_max(m);
            float p[4], lsum = 0.f;
#pragma unroll
            for (int i = 0; i < 4; ++i) { p[i] = (lane + 64 * i < nvis) ? exp2f(s[i] - m) : 0.f; lsum += p[i]; }
            lsum = wave_sum(lsum);
            const float inv = lsum > 0.f ? 1.f / lsum : 0.f;
#pragma unroll
            for (int i = 0; i < 4; ++i) { p[i] *= inv; pl[lane + 64 * i] = p[i]; }
            asm volatile("s_waitcnt lgkmcnt(0)" ::: "memory");
            float o = 0.f;
            for (int cc = 0; cc < nvis; ++cc) o = fmaf(pl[cc], bf2f(vc[(size_t)cc * 64 + lane]), o);
            const float gt = gate[((size_t)(b * T_ + t)) * 24 + h * 3 + 0];
            ocmp[(size_t)(b * T_ + t) * 512 + h * 64 + lane] = (bf16)f2bf(gt * o);
            { const int j = lane; float a = pl[4 * j] + pl[4 * j + 1] + pl[4 * j + 2] + 0.5f * pl[4 * j + 3]; if (j > 0) a += 0.5f * pl[4 * j - 1]; imp += a; }
            asm volatile("s_waitcnt lgkmcnt(0)" ::: "memory");
        }
        const int cur = t >> 6; const int j = lane;
        u64 m64;
        if (cur <= 15) m64 = (cur == 63) ? ~0ull : ((1ull << (cur + 1)) - 1ull);
        else {
            float val = (j > cur) ? -INFINITY : ((j == 0 || j == cur || j == cur - 1) ? 1e4f : imp);
            m64 = 0ull;
            for (int r = 0; r < 16; ++r) {
                const float mx = wave_max(val);
                const u64 bal = __ballot(val == mx);
                const int w = __builtin_ctzll(bal);
                m64 |= 1ull << w; if (j == w) val = -INFINITY;
            }
        }
        if (lane == 0) sel[(size_t)bg * T_ + t] = m64;
    }
}

__device__ __forceinline__ void ph_win_attn(const Ctx& c, const bf16* qn, const bf16* kw, const bf16* vw, const float* gate, bf16* owin) {
    for (int it = c.gw; it < B_ * 8 * T_; it += c.ngw) {
        const int t = it % T_, bh = it / T_, b = bh >> 3, h = bh & 7, g = h >> 2;
        const int cur = t >> 6, jlo = (t - 511) > 0 ? (t - 511) >> 6 : 0;
        const u64 hi = (cur == 63) ? ~0ull : ((1ull << (cur + 1)) - 1ull); const u64 mask = hi & ~((1ull << jlo) - 1ull);
        const float o = naive_attn_row<64>(qn + ((size_t)bh * T_ + t) * 64, kw + (size_t)(b * 2 + g) * T_ * 64, vw + (size_t)(b * 2 + g) * T_ * 64, t, mask,
                                           alibi_slope(h + 1, 8) * LOG2E, nullptr, 512, c.lane);
        owin[(size_t)(b * T_ + t) * 512 + h * 64 + c.lane] = (bf16)f2bf(gate[(size_t)(b * T_ + t) * 24 + h * 3 + 2] * o);
    }
}
__device__ __forceinline__ void ph_slc_attn(const Ctx& c, const bf16* qn, const bf16* ks, const bf16* vs, const float* gate, const u64* sel, const bf16* ocmp, const bf16* owin, bf16* att) {
    for (int it = c.gw; it < B_ * 8 * T_; it += c.ngw) {
        const int t = it % T_, bh = it / T_, b = bh >> 3, h = bh & 7, g = h >> 2;
        const u64 mask = sel[(size_t)(b * 2 + g) * T_ + t];
        const float o = naive_attn_row<64>(qn + ((size_t)bh * T_ + t) * 64, ks + (size_t)(b * 2 + g) * T_ * 64, vs + (size_t)(b * 2 + g) * T_ * 64, t, mask,
                                           alibi_slope(h + 1, 8) * LOG2E, nullptr, 1 << 30, c.lane);
        const size_t n = (size_t)(b * T_ + t);
        const float r = gate[n * 24 + h * 3 + 1] * o + bf2f(ocmp[n * 512 + h * 64 + c.lane]) + bf2f(owin[n * 512 + h * 64 + c.lane]);
        att[n * 1024 + h * 64 + c.lane] = (bf16)f2bf(r);
    }
}
__device__ __forceinline__ void ph_fox_attn(const Ctx& c, const bf16* fq, const bf16* fk, const bf16* fv, const float* cum, bf16* att) {
    for (int it = c.gw; it < B_ * 4 * T_; it += c.ngw) {
        const int t = it % T_, bh = it / T_, b = bh >> 2, h = bh & 3;
        const int cur = t >> 6; const u64 mask = (cur == 63) ? ~0ull : ((1ull << (cur + 1)) - 1ull);
        const float o = naive_attn_row<64>(fq + ((size_t)bh * T_ + t) * 64, fk + (size_t)bh * T_ * 64, fv + (size_t)bh * T_ * 64, t, mask, 0.f, cum + (size_t)bh * T_, 1 << 30, c.lane);
        att[(size_t)(b * T_ + t) * 1024 + 512 + h * 64 + c.lane] = (bf16)f2bf(o);
    }
}
__device__ __forceinline__ void ph_diff_attn(const Ctx& c, const bf16* dq, const bf16* dk, const bf16* dv, const float* lam, const float* subln, float lambda_init, bf16* att) {
    float l1 = 0.f, l2 = 0.f;
    if (c.lane < 32) { l1 = lam[c.lane] * lam[32 + c.lane]; l2 = lam[64 + c.lane] * lam[96 + c.lane]; }
    const float lam_full = __expf(wave_sum(l1)) - __expf(wave_sum(l2)) + lambda_init;
    const float sg = subln[c.lane] * (1.f - lambda_init);
    for (int it = c.gw; it < B_ * 4 * T_; it += c.ngw) {
        const int t = it % T_, bh = it / T_, b = bh >> 2, h = bh & 3;
        const int cur = t >> 6; const u64 mask = (cur == 63) ? ~0ull : ((1ull << (cur + 1)) - 1ull);
        const float slope2 = alibi_slope(h + 1, 4) * LOG2E;
        const bf16* vb = dv + (size_t)bh * T_ * 64;
        const float o1 = naive_attn_row<32>(dq + ((size_t)(bh * 2 + 0) * T_ + t) * 32, dk + (size_t)(bh * 2 + 0) * T_ * 32, vb, t, mask, slope2, nullptr, 1 << 30, c.lane);
        const float o2 = naive_attn_row<32>(dq + ((size_t)(bh * 2 + 1) * T_ + t) * 32, dk + (size_t)(bh * 2 + 1) * T_ * 32, vb, t, mask, slope2, nullptr, 1 << 30, c.lane);
        const float o = o1 - lam_full * o2;
        const float r = rsqrtf(wave_sum(o * o) * (1.f / 64.f) + EPS);
        att[(size_t)(b * T_ + t) * 1024 + 768 + h * 64 + c.lane] = (bf16)f2bf(o * r * sg);
    }
}

__device__ __forceinline__ void ph_moe_route(const Ctx& c, const float* x, const float* g, const float* wgrp, const float* bgrp, const float* wexp, const float* bexp, bf16* hn, int* route_e, float* route_w, unsigned* cnt) {
    for (int row = c.gw; row < NT; row += c.ngw) {
        const f32x4* xr = (const f32x4*)(x + (size_t)row * D_) + c.lane;
        f32x4 v[4]; float ss = 0.f;
#pragma unroll
        for (int j = 0; j < 4; ++j) { v[j] = xr[64 * j]; ss += v[j].x * v[j].x + v[j].y * v[j].y + v[j].z * v[j].z + v[j].w * v[j].w; }
        const float r = rsqrtf(wave_sum(ss) * (1.f / D_) + EPS);
        u64* o8 = (u64*)(hn + (size_t)row * D_) + c.lane;
#pragma unroll
        for (int j = 0; j < 4; ++j) { const f32x4 gg = ((const f32x4*)g)[c.lane + 64 * j]; v[j] = v[j] * r * gg;
            o8[64 * j] = (u64)pk2(v[j].x, v[j].y) | ((u64)pk2(v[j].z, v[j].w) << 32); }
        float gl[4];
#pragma unroll
        for (int q = 0; q < 4; ++q) { float a = 0.f;
#pragma unroll
            for (int j = 0; j < 4; ++j) { const int k = 4 * (c.lane + 64 * j);
                a = fmaf(v[j].x, wgrp[(size_t)(k + 0) * 4 + q], a); a = fmaf(v[j].y, wgrp[(size_t)(k + 1) * 4 + q], a);
                a = fmaf(v[j].z, wgrp[(size_t)(k + 2) * 4 + q], a); a = fmaf(v[j].w, wgrp[(size_t)(k + 3) * 4 + q], a); }
            gl[q] = wave_sum(a) + bgrp[q]; }
        int grp = 0; float gm = gl[0];
#pragma unroll
        for (int q = 1; q < 4; ++q) if (gl[q] > gm) { gm = gl[q]; grp = q; }
        float gs = 0.f;
#pragma unroll
        for (int q = 0; q < 4; ++q) gs += __expf(gl[q] - gm);
        const float grp_gate = 1.f / gs;
        float el[8];
#pragma unroll
        for (int q = 0; q < 8; ++q) { float a = 0.f; const int col = grp * 8 + q;
#pragma unroll
            for (int j = 0; j < 4; ++j) { const int k = 4 * (c.lane + 64 * j);
                a = fmaf(v[j].x, wexp[(size_t)(k + 0) * 32 + col], a); a = fmaf(v[j].y, wexp[(size_t)(k + 1) * 32 + col], a);
                a = fmaf(v[j].z, wexp[(size_t)(k + 2) * 32 + col], a); a = fmaf(v[j].w, wexp[(size_t)(k + 3) * 32 + col], a); }
            el[q] = wave_sum(a) + bexp[col]; }
        int i0 = 0; float v0 = el[0];
#pragma unroll
        for (int q = 1; q < 8; ++q) if (el[q] > v0) { v0 = el[q]; i0 = q; }
        int i1 = -1; float v1 = -INFINITY;
#pragma unroll
        for (int q = 0; q < 8; ++q) if (q != i0 && el[q] > v1) { v1 = el[q]; i1 = q; }
        const float e1 = __expf(v1 - v0), den = 1.f + e1;
        if (c.lane == 0) { const float w0 = grp_gate / den, w1 = grp_gate * e1 / den;
            const int lo = i0 < i1 ? i0 : i1, hi = i0 < i1 ? i1 : i0, cls = grp * 28 + lo * 8 - (lo * (lo + 1)) / 2 + (hi - lo - 1);
            const unsigned rank = __hip_atomic_fetch_add(cnt + cls, 1u, __ATOMIC_RELAXED, __HIP_MEMORY_SCOPE_AGENT);
            route_e[row] = (int)(((unsigned)cls << 24) | rank); route_w[2 * row] = i0 < i1 ? w0 : w1; route_w[2 * row + 1] = i0 < i1 ? w1 : w0; }
    }
}
__device__ __forceinline__ void ph_moe_naive(const Ctx& c, const bf16* hn, const int* route_e, const float* route_w, const float* wg, const float* wu, const float* wd, float* x) {
    LAS float* hs = (LAS float*)c.lds;
    LAS float* au = hs + 1024;
    LAS float* h2 = au + 512;
    for (int row = c.bid; row < NT; row += c.G) {
        __syncthreads();
        hs[c.tid] = bf2f(hn[(size_t)row * D_ + c.tid]); hs[c.tid + 512] = bf2f(hn[(size_t)row * D_ + c.tid + 512]);
        float o0 = 0.f, o1 = 0.f;
        for (int s = 0; s < 2; ++s) {
            const int e = route_e[2 * row + s]; const float w = route_w[2 * row + s];
            __syncthreads();
            const float* W = (c.tid < 256 ? wg : wu) + (size_t)e * D_ * DEXP + (c.tid & 255);
            float a = 0.f;
            for (int k = 0; k < D_; ++k) a = fmaf(hs[k], W[(size_t)k * DEXP], a);
            au[c.tid] = a;
            __syncthreads();
            if (c.tid < 256) { const float ga = au[c.tid], up = au[c.tid + 256]; h2[c.tid] = ga / (1.f + __expf(-ga)) * up * w; }
            __syncthreads();
            const float* Wd = wd + (size_t)e * DEXP * D_;
            for (int k = 0; k < DEXP; ++k) { const float hv = h2[k]; o0 = fmaf(hv, Wd[(size_t)k * D_ + c.tid], o0); o1 = fmaf(hv, Wd[(size_t)k * D_ + c.tid + 512], o1); }
        }
        x[(size_t)row * D_ + c.tid] += o0; x[(size_t)row * D_ + c.tid + 512] += o1;
    }
    __syncthreads();
}

typedef __attribute__((address_space(4))) const Params* KP;
__device__ __forceinline__ KP uni_kp(KP p) { const unsigned long long v = (unsigned long long)p; const unsigned lo = __builtin_amdgcn_readfirstlane((unsigned)v), hi = __builtin_amdgcn_readfirstlane((unsigned)(v >> 32)); return (KP)(((unsigned long long)hi << 32) | lo); }
constexpr int PH_PER_LAYER = 11, N_PHASES = L_ * PH_PER_LAYER + 2;
__device__ __forceinline__ Ctx make_ctx(KP p) {
    Ctx c; c.lds = (LAS unsigned char*)lds_raw; c.tid = threadIdx.x; c.lane = c.tid & 63; c.wave = __builtin_amdgcn_readfirstlane(c.tid >> 6);
    c.bid = blockIdx.x; c.G = gridDim.x; c.gw = c.bid * NWAVES + c.wave; c.ngw = c.G * NWAVES; c.in = nullptr; c.xcur = p->out; c.ws = p->ws;
    return c;
}
struct Bufs {
    bf16 *QN, *KV6, *KC, *VC, *KS, *VS, *KW, *VW, *FQ, *FK, *FV, *DQ, *DK, *DV, *HC, *KCMP, *VCMP, *OCMP, *OWIN, *HN, *ATT;
    float *GATE, *FL, *ROUTE_W; u64* SEL; int* ROUTE_E;
};
__device__ __forceinline__ Bufs make_bufs(unsigned char* ws) {
    Bufs b;
    b.QN = (bf16*)(ws + WS_QN); b.KV6 = (bf16*)(ws + WS_KV6);
    b.KC = (bf16*)(ws + WS_KV6 + 0 * KV6_STRIDE); b.VC = (bf16*)(ws + WS_KV6 + 1 * KV6_STRIDE);
    b.KS = (bf16*)(ws + WS_KV6 + 2 * KV6_STRIDE); b.VS = (bf16*)(ws + WS_KV6 + 3 * KV6_STRIDE);
    b.KW = (bf16*)(ws + WS_KV6 + 4 * KV6_STRIDE); b.VW = (bf16*)(ws + WS_KV6 + 5 * KV6_STRIDE);
    b.FQ = (bf16*)(ws + WS_FQKV); b.FK = b.FQ + 8 * MiB; b.FV = b.FQ + 16 * MiB;
    b.DQ = (bf16*)(ws + WS_DQK); b.DK = b.DQ + 8 * MiB; b.DV = (bf16*)(ws + WS_DV);
    b.GATE = (float*)(ws + WS_GATE); b.FL = (float*)(ws + WS_FL);
    b.HC = (bf16*)(ws + WS_HC); b.KCMP = (bf16*)(ws + WS_KVCMP); b.VCMP = b.KCMP + 16 * 256 * 64;
    b.SEL = (u64*)(ws + WS_SEL); b.OCMP = (bf16*)(ws + WS_OCMP); b.OWIN = (bf16*)(ws + WS_OWIN);
    b.HN = (bf16*)(ws + WS_HN); b.ATT = (bf16*)(ws + WS_ATT);
    b.ROUTE_E = (int*)(ws + WS_ROUTE); b.ROUTE_W = (float*)(ws + WS_ROUTE + 512 * 1024);
    return b;
}
__device__ __forceinline__ float lambda_init_of(int l) { return l == 0 ? 0.2f : 0.35550906759096926f; }

__device__ __noinline__ void P_prologue(KP p_) { const KP p = uni_kp(p_);
    const Ctx c = make_ctx(p); unsigned char* ws = p->ws;
    LAS float* scr = (LAS float*)(c.lds) + c.wave * (64 * 33);
    constexpr int I_A = 16 * 40, I_B = 16 * 24, I_C = 16 * 24, I_O = 16 * 32, I_G = 16 * 8, I_D = 4 * 32, I_E = 2 * I_G + I_D, I_W1 = 32 * 8, I_W2 = 4 * 2;
    constexpr int PER_L = I_A + I_B + I_C + I_O + NEXP * I_E + 2 * (I_W1 + I_W2);
    for (int it = c.gw; it < L_ * PER_L; it += c.ngw) {
        const int l = it / PER_L; int r = it % PER_L;
        const float* W; bf16* WT; int ldw, K, sc0, ncol, r0 = 0, rmul = 1;
        if (r < I_A + I_B + I_C) { W = p->in[2] + (size_t)l * D_ * D_IN; WT = (bf16*)(ws + WS_WIN_T) + (size_t)l * NIN * D_; ldw = D_IN; K = D_;
            if (r < I_A) { sc0 = 0; ncol = 1280; r0 = 0; } else if (r < I_A + I_B) { r -= I_A; sc0 = C_FQ; ncol = 768; r0 = 1280; } else { r -= I_A + I_B; sc0 = C_DQ; ncol = 768; r0 = 2048; } }
        else if ((r -= I_A + I_B + I_C) < I_O) { W = p->in[13] + (size_t)l * D_ * D_; WT = (bf16*)(ws + WS_WOUT_T) + (size_t)l * D_ * D_; ldw = D_; K = D_; sc0 = 0; ncol = 1024; }
        else if ((r -= I_O) < NEXP * I_E) { const int e = r / I_E; r = r % I_E; const size_t le = (size_t)l * NEXP + e;
            if (r < 2 * I_G) { const int up = r >= I_G; r -= up * I_G; W = p->in[19 + up] + le * D_ * DEXP; WT = (bf16*)(ws + WS_WGU_T) + le * 512 * D_; ldw = DEXP; K = D_; sc0 = 0; ncol = 256; r0 = up; rmul = 2; }
            else { r -= 2 * I_G; W = p->in[21] + le * DEXP * D_; WT = (bf16*)(ws + WS_WD_T) + le * D_ * DEXP; ldw = D_; K = DEXP; sc0 = 0; ncol = 1024; } }
        else { r -= NEXP * I_E; const int kv = r / (I_W1 + I_W2); r = r % (I_W1 + I_W2); const size_t lk = (size_t)l * 2 + kv;
            if (r < I_W1) { W = p->in[kv == 0 ? 6 : 9] + (size_t)l * 2048 * 256; WT = (bf16*)(ws + WS_W1_T) + lk * 256 * 2048; ldw = 256; K = 2048; sc0 = 0; ncol = 256; }
            else { r -= I_W1; W = p->in[kv == 0 ? 7 : 10] + (size_t)l * 256 * 64; WT = (bf16*)(ws + WS_W2_T) + lk * 64 * 256; ldw = 64; K = 256; sc0 = 0; ncol = 64; } }
        transpose_seg(W, ldw, K, sc0, ncol, WT, r0, rmul, r, scr, c.lane);
    }
    for (int i = c.bid * NTHREADS + c.tid; i < L_ * 256 * D_; i += c.G * NTHREADS) {
        const int l = i / (256 * D_), rr = (i / D_) % 256, k = i % D_;
        const float* win = p->in[2] + (size_t)l * D_ * D_IN;
        float v = 0.f; if (rr < 24) v = win[(size_t)k * D_IN + C_GATE + rr]; else if (rr < 28) v = win[(size_t)k * D_IN + C_FF + (rr - 24)];
        ((bf16*)(ws + WS_WIN_T))[((size_t)l * NIN + 2816 + rr) * D_ + k] = (bf16)f2bf(v);
    }
    for (int w = c.gw; w < L_ * 2 * 4; w += c.ngw) {
        const int l = w / 8, kv = (w / 4) & 1, j = (w & 3) * 64 + c.lane;
        const float* pe = p->in[kv == 0 ? 5 : 8] + (size_t)l * 2048; const float* w1 = p->in[kv == 0 ? 6 : 9] + (size_t)l * 2048 * 256;
        float a = 0.f; for (int k = 0; k < 2048; ++k) a = fmaf(pe[k], w1[(size_t)k * 256 + j], a);
        ((float*)(ws + WS_BIAS1))[(l * 2 + kv) * 256 + j] = a;
    }
}
__device__ __forceinline__ void P_inproj_mfma(int l_) { const KP p = (KP)__builtin_amdgcn_kernarg_segment_ptr(); int l = l_; asm volatile("" : "+s"(l));
    unsigned char* ws = p->ws; asm volatile("" : "+s"(ws));
    PlainOrder S; S.init(ws + WS_HN, (const bf16*)(ws + WS_WIN_T) + (size_t)l * NIN * D_, D_, D_, NT, NIN, (int)gridDim.x, launder_s((int)blockIdx.x));
    const pg8::Gemm g{D_, D_, D_, D_ / 64};
    const EpiInProj E{ws, p->in[3] + l * 24, p->in[4] + l * 4};
    pg8::gemm_phase<EpiInProj, PlainOrder, true, true>((LAS unsigned char*)lds_raw, g, S, E);
}
__device__ __forceinline__ void P_outproj_mfma(int l_) { const KP p = (KP)__builtin_amdgcn_kernarg_segment_ptr(); int l = l_; asm volatile("" : "+s"(l));
    unsigned char* ws = p->ws; asm volatile("" : "+s"(ws));
    PlainOrder S; S.init(ws + WS_ATT, (const bf16*)(ws + WS_WOUT_T) + (size_t)l * D_ * D_, D_, D_, NT, D_, (int)gridDim.x, launder_s((int)blockIdx.x));
    const pg8::Gemm g{D_, D_, D_, D_ / 64};
    const EpiResF32 E{(l == 0) ? p->in[0] : p->out, p->out};
    pg8::gemm_phase<EpiResF32, PlainOrder, true, true>((LAS unsigned char*)lds_raw, g, S, E);
}
__device__ __forceinline__ void U_fox(KP p_, int bh_, int qb_) {
    const KP p = uni_kp(p_); const int bh = __builtin_amdgcn_readfirstlane(bh_), qb = __builtin_amdgcn_readfirstlane(qb_);
    int tid_ = threadIdx.x; asm volatile("" : "+v"(tid_));
    const int tid = tid_, lane = tid & 63, wave = __builtin_amdgcn_readfirstlane(tid >> 6), r = lane & 31, h = lane >> 5;
    unsigned char* ws = p->ws; asm volatile("" : "+s"(ws)); LAS unsigned char* L = (LAS unsigned char*)lds_raw;
    const int tw0 = 256 * qb + 32 * wave, t_lane = tw0 + r, b = bh >> 2, hd = bh & 3;
    const bf16* q = (const bf16*)(ws + WS_FQKV) + ((size_t)bh * T_ + t_lane) * 64 + 8 * h;
    bf16x8v Qf[1][4];
#pragma unroll
    for (int s = 0; s < 4; ++s) Qf[0][s] = *(const bf16x8v*)(q + 16 * s);
    const float* cum = (const float*)(ws + WS_FL) + (size_t)bh * T_;
    f32x16 O[1][2]; float M[1] = {-1e30f}, Ls[1] = {0.f};
#pragma unroll
    for (int i = 0; i < 16; ++i) { O[0][0][i] = 0.f; O[0][1][i] = 0.f; }
    const u64 tm = (qb == 15) ? ~0ull : ((1ull << (4 * qb + 4)) - 1ull);
    attn_core<64, 1, true, false>(L, (const bf16*)(ws + WS_FQKV) + 8 * MiB + (size_t)bh * T_ * 64, nullptr, (const bf16*)(ws + WS_FQKV) + 16 * MiB + (size_t)bh * T_ * 64, cum, cum[256 * qb],
                                  Qf, tm, t_lane, tw0, 1 << 30, 0.f, 0u, 0u, O, M, Ls, tid);
    const float lt = swap_sum(Ls[0]), inv = lt > 0.f ? 1.f / lt : 0.f;
    bf16* dst = (bf16*)(ws + WS_ATT) + ((size_t)b * T_ + t_lane) * 1024 + 512 + hd * 64 + 4 * h;
    ATTN_FOR_CHUNKS(db, g4) { const unsigned w0 = cvtpk(O[0][db][4 * g4 + 0] * inv, O[0][db][4 * g4 + 1] * inv), w1 = cvtpk(O[0][db][4 * g4 + 2] * inv, O[0][db][4 * g4 + 3] * inv);
        *(u64*)(dst + 32 * db + 8 * g4) = (u64)w0 | ((u64)w1 << 32); }
}
__device__ __forceinline__ void U_diff(KP p_, int bh_, int qb_, int l_) {
    const KP p = uni_kp(p_); const int bh = __builtin_amdgcn_readfirstlane(bh_), qb = __builtin_amdgcn_readfirstlane(qb_), l = __builtin_amdgcn_readfirstlane(l_);
    int tid_ = threadIdx.x; asm volatile("" : "+v"(tid_));
    const int tid = tid_, lane = tid & 63, wave = __builtin_amdgcn_readfirstlane(tid >> 6), r = lane & 31, h = lane >> 5;
    unsigned char* ws = p->ws; asm volatile("" : "+s"(ws)); LAS unsigned char* L = (LAS unsigned char*)lds_raw;
    const int tw0 = 256 * qb + 32 * wave, t_lane = tw0 + r, b = bh >> 2, hd = bh & 3;
    const bf16* DQ = (const bf16*)(ws + WS_DQK); const bf16* DK = DQ + 8 * MiB;
    bf16x8v Qf[2][2];
#pragma unroll
    for (int mp = 0; mp < 2; ++mp)
#pragma unroll
        for (int s = 0; s < 2; ++s) Qf[mp][s] = *(const bf16x8v*)(DQ + ((size_t)(bh * 2 + mp) * T_ + t_lane) * 32 + 16 * s + 8 * h);
    f32x16 O[2][2]; float M[2] = {-1e30f, -1e30f}, Ls[2] = {0.f, 0.f};
#pragma unroll
    for (int i = 0; i < 16; ++i) { O[0][0][i] = 0.f; O[0][1][i] = 0.f; O[1][0][i] = 0.f; O[1][1][i] = 0.f; }
    const u64 tm = (qb == 15) ? ~0ull : ((1ull << (4 * qb + 4)) - 1ull);
    attn_core<32, 2, false, false>(L, DK + (size_t)(bh * 2 + 0) * T_ * 32, DK + (size_t)(bh * 2 + 1) * T_ * 32, (const bf16*)(ws + WS_DV) + (size_t)bh * T_ * 64, nullptr, 0.f,
                                   Qf, tm, t_lane, tw0, 1 << 30, alibi_slope(hd + 1, 4) * LOG2E, 0u, 0u, O, M, Ls, tid);
    const float* lam = p->in[11] + (size_t)l * 128; const float* subln = p->in[12] + (size_t)l * 64;
    float l1 = 0.f, l2 = 0.f; if (lane < 32) { l1 = lam[lane] * lam[32 + lane]; l2 = lam[64 + lane] * lam[96 + lane]; }
    const float li = lambda_init_of(l), lam_full = __expf(wave_sum_l(l1, lane)) - __expf(wave_sum_l(l2, lane)) + li;
    const float lt0 = swap_sum(Ls[0]), lt1 = swap_sum(Ls[1]), i0 = lt0 > 0.f ? 1.f / lt0 : 0.f, i1 = (lt1 > 0.f ? 1.f / lt1 : 0.f) * lam_full;
    float ss = 0.f;
#pragma unroll
    for (int db = 0; db < 2; ++db)
#pragma unroll
        for (int i = 0; i < 16; ++i) { const float o = O[0][db][i] * i0 - O[1][db][i] * i1; O[0][db][i] = o; ss += o * o; }
    ss = swap_sum(ss);
    const float rn = rsqrtf(ss * (1.f / 64.f) + EPS) * (1.f - li);
    bf16* dst = (bf16*)(ws + WS_ATT) + ((size_t)b * T_ + t_lane) * 1024 + 768 + hd * 64 + 4 * h;
    ATTN_FOR_CHUNKS(db, g4) { const f32x4 sg = *(const f32x4*)(subln + 32 * db + 8 * g4 + 4 * h);
        const unsigned w0 = cvtpk(O[0][db][4 * g4 + 0] * rn * sg.x, O[0][db][4 * g4 + 1] * rn * sg.y), w1 = cvtpk(O[0][db][4 * g4 + 2] * rn * sg.z, O[0][db][4 * g4 + 3] * rn * sg.w);
        *(u64*)(dst + 32 * db + 8 * g4) = (u64)w0 | ((u64)w1 << 32); }
}
__device__ __forceinline__ void U_win(KP p_, int bg_, int c_) {
    const KP p = uni_kp(p_); const int bg = __builtin_amdgcn_readfirstlane(bg_), cc = __builtin_amdgcn_readfirstlane(c_);
    int tid_ = threadIdx.x; asm volatile("" : "+v"(tid_));
    const int tid = tid_, lane = tid & 63, wave = __builtin_amdgcn_readfirstlane(tid >> 6), r = lane & 31, h = lane >> 5;
    unsigned char* ws = p->ws; asm volatile("" : "+s"(ws)); LAS unsigned char* L = (LAS unsigned char*)lds_raw;
    const int b = bg >> 1, g = bg & 1, hd = g * 4 + (wave >> 1), tw0 = 64 * cc + 32 * (wave & 1), t_lane = tw0 + r;
    const bf16* q = (const bf16*)(ws + WS_QN) + ((size_t)(b * 8 + hd) * T_ + t_lane) * 64 + 8 * h;
    bf16x8v Qf[1][4];
#pragma unroll
    for (int s = 0; s < 4; ++s) Qf[0][s] = *(const bf16x8v*)(q + 16 * s);
    f32x16 O[1][2]; float M[1] = {-1e30f}, Ls[1] = {0.f};
#pragma unroll
    for (int i = 0; i < 16; ++i) { O[0][0][i] = 0.f; O[0][1][i] = 0.f; }
    const int jlo = cc > 8 ? cc - 8 : 0;
    const u64 hi = (cc == 63) ? ~0ull : ((1ull << (cc + 1)) - 1ull), tm = hi & ~((1ull << jlo) - 1ull);
    attn_core<64, 1, false, false>(L, (const bf16*)(ws + WS_KV6 + 4 * KV6_STRIDE) + (size_t)bg * T_ * 64, nullptr, (const bf16*)(ws + WS_KV6 + 5 * KV6_STRIDE) + (size_t)bg * T_ * 64, nullptr, 0.f,
                                   Qf, tm, t_lane, tw0, 512, alibi_slope(hd + 1, 8) * LOG2E, 0u, 0u, O, M, Ls, tid);
    const size_t n = (size_t)b * T_ + t_lane;
    const float lt = swap_sum(Ls[0]), inv = (lt > 0.f ? 1.f / lt : 0.f) * ((const float*)(ws + WS_GATE))[n * 24 + hd * 3 + 2];
    bf16* dst = (bf16*)(ws + WS_OWIN) + n * 512 + hd * 64 + 4 * h;
    ATTN_FOR_CHUNKS(db, g4) { const unsigned w0 = cvtpk(O[0][db][4 * g4 + 0] * inv, O[0][db][4 * g4 + 1] * inv), w1 = cvtpk(O[0][db][4 * g4 + 2] * inv, O[0][db][4 * g4 + 3] * inv);
        *(u64*)(dst + 32 * db + 8 * g4) = (u64)w0 | ((u64)w1 << 32); }
}
__device__ __forceinline__ void U_slc(KP p_, int bg_, int c_) {
    const KP p = uni_kp(p_); const int bg = __builtin_amdgcn_readfirstlane(bg_), cc = __builtin_amdgcn_readfirstlane(c_);
    int tid_ = threadIdx.x; asm volatile("" : "+v"(tid_));
    const int tid = tid_, lane = tid & 63, wave = __builtin_amdgcn_readfirstlane(tid >> 6), r = lane & 31, h = lane >> 5;
    unsigned char* ws = p->ws; asm volatile("" : "+s"(ws)); LAS unsigned char* L = (LAS unsigned char*)lds_raw;
    const int b = bg >> 1, g = bg & 1, hd = g * 4 + (wave >> 1), tw0 = 64 * cc + 32 * (wave & 1), t_lane = tw0 + r;
    const bf16* q = (const bf16*)(ws + WS_QN) + ((size_t)(b * 8 + hd) * T_ + t_lane) * 64 + 8 * h;
    bf16x8v Qf[1][4];
#pragma unroll
    for (int s = 0; s < 4; ++s) Qf[0][s] = *(const bf16x8v*)(q + 16 * s);
    f32x16 O[1][2]; float M[1] = {-1e30f}, Ls[1] = {0.f};
#pragma unroll
    for (int i = 0; i < 16; ++i) { O[0][0][i] = 0.f; O[0][1][i] = 0.f; }
    const u64* sel = (const u64*)(ws + WS_SEL) + (size_t)bg * T_;
    const u64 mine = sel[t_lane]; u64 un = sel[64 * cc + lane];
    { unsigned ul = (unsigned)un, uh = (unsigned)(un >> 32);
#pragma unroll
      for (int o = 1; o < 64; o <<= 1) { ul |= shflx_u(ul, o, lane); uh |= shflx_u(uh, o, lane); }
      un = ((u64)__builtin_amdgcn_readfirstlane(uh) << 32) | __builtin_amdgcn_readfirstlane(ul); }
    attn_core<64, 1, false, true>(L, (const bf16*)(ws + WS_KV6 + 2 * KV6_STRIDE) + (size_t)bg * T_ * 64, nullptr, (const bf16*)(ws + WS_KV6 + 3 * KV6_STRIDE) + (size_t)bg * T_ * 64, nullptr, 0.f,
                                  Qf, un, t_lane, tw0, 1 << 30, alibi_slope(hd + 1, 8) * LOG2E, (unsigned)mine, (unsigned)(mine >> 32), O, M, Ls, tid);
    const size_t n = (size_t)b * T_ + t_lane;
    const float lt = swap_sum(Ls[0]), inv = (lt > 0.f ? 1.f / lt : 0.f) * ((const float*)(ws + WS_GATE))[n * 24 + hd * 3 + 1];
    const bf16* oc = (const bf16*)(ws + WS_OCMP) + n * 512 + hd * 64 + 4 * h; const bf16* ow = (const bf16*)(ws + WS_OWIN) + n * 512 + hd * 64 + 4 * h;
    bf16* dst = (bf16*)(ws + WS_ATT) + n * 1024 + hd * 64 + 4 * h;
    ATTN_FOR_CHUNKS(db, g4) { const u64 a = *(const u64*)(oc + 32 * db + 8 * g4), w = *(const u64*)(ow + 32 * db + 8 * g4);
        const float x0 = O[0][db][4 * g4 + 0] * inv + __uint_as_float((unsigned)a << 16) + __uint_as_float((unsigned)w << 16);
        const float x1 = O[0][db][4 * g4 + 1] * inv + __uint_as_float((unsigned)a & 0xffff0000u) + __uint_as_float((unsigned)w & 0xffff0000u);
        const float x2 = O[0][db][4 * g4 + 2] * inv + __uint_as_float((unsigned)(a >> 32) << 16) + __uint_as_float((unsigned)(w >> 32) << 16);
        const float x3 = O[0][db][4 * g4 + 3] * inv + __uint_as_float((unsigned)(a >> 32) & 0xffff0000u) + __uint_as_float((unsigned)(w >> 32) & 0xffff0000u);
        *(u64*)(dst + 32 * db + 8 * g4) = (u64)cvtpk(x0, x1) | ((u64)cvtpk(x2, x3) << 32); }
}
__device__ __forceinline__ int fetch_unit(KP p, int qidx) {
    volatile LAS unsigned* slot = (volatile LAS unsigned*)((LAS unsigned char*)lds_raw + MISC_OFF) + 16;
    __syncthreads();
    int t0_ = threadIdx.x; asm volatile("" : "+v"(t0_));
    if (t0_ == 0) *slot = __hip_atomic_fetch_add((unsigned*)(p->ws + WS_CTL) + CW_QUEUE + 64 * qidx, 1u, __ATOMIC_RELAXED, __HIP_MEMORY_SCOPE_AGENT);
    __syncthreads();
    return (int)__builtin_amdgcn_readfirstlane(*slot);
}
__device__ __forceinline__ void P_cmp1_mfma(int l_) { const KP p = (KP)__builtin_amdgcn_kernarg_segment_ptr(); int l = l_; asm volatile("" : "+s"(l));
    unsigned char* ws = p->ws; asm volatile("" : "+s"(ws)); const int c = launder_s((int)blockIdx.x), kv = c >> 4, pm = c & 15;
    OneUnitOrder S; S.has = c < 32; S.u.pm = pm; S.u.pn = kv;
    S.u.a = (const char*)(ws + WS_KV6 + (size_t)kv * KV6_STRIDE) + (size_t)pm * 256 * 1024 * 2; S.u.b = (const char*)((const bf16*)(ws + WS_W1_T) + ((size_t)l * 2 + kv) * 256 * 2048); S.u.b2 = S.u.b;
    const pg8::Gemm g{1024, 2048, 2048, 32};
    const EpiCmpH E{(bf16*)(ws + WS_HC), (const float*)(ws + WS_BIAS1) + l * 512};
    pg8::gemm_phase<EpiCmpH, OneUnitOrder, false, true>((LAS unsigned char*)lds_raw, g, S, E);
}
__device__ __forceinline__ void P_cmp2_mfma(int l_) { const KP p = (KP)__builtin_amdgcn_kernarg_segment_ptr(); int l = l_; asm volatile("" : "+s"(l));
    unsigned char* ws = p->ws; asm volatile("" : "+s"(ws)); const int c = launder_s((int)blockIdx.x), kv = c >> 4, pm = c & 15;
    OneUnitOrder S; S.has = c < 32; S.u.pm = pm; S.u.pn = kv;
    S.u.a = (const char*)((const bf16*)(ws + WS_HC) + ((size_t)kv * 4096 + pm * 256) * 256); S.u.b = (const char*)((const bf16*)(ws + WS_W2_T) + ((size_t)l * 2 + kv) * 64 * 256); S.u.b2 = S.u.b;
    const pg8::Gemm g{256, 256, 256, 4};
    const EpiCmpOut E{(bf16*)(ws + WS_KVCMP)};
    pg8::gemm_phase<EpiCmpOut, OneUnitOrder, false, true>((LAS unsigned char*)lds_raw, g, S, E);
}
__device__ __noinline__ void P_moe_scatter(KP p_, int l_) { const KP p = uni_kp(p_); const int l = __builtin_amdgcn_readfirstlane(l_); const Ctx c = make_ctx(p); unsigned char* ws = p->ws;
    const unsigned* cnt = (const unsigned*)(ws + WS_CTL) + CW_MOECNT + l * 128;
    moe_build_tables(cnt, c.tid);
    const LAS int* T = (const LAS int*)((LAS unsigned char*)lds_raw + TBL_OFF);
    const unsigned* info = (const unsigned*)(ws + WS_ROUTE + RT_INFO); const float* tw = (const float*)(ws + WS_ROUTE + RT_W);
    int* rowtok = (int*)(ws + WS_ROUTE + RT_ROWTOK); float* roww = (float*)(ws + WS_ROUTE + RT_ROWW);
    const bf16* hn = (const bf16*)(ws + WS_HN); bf16* xs = (bf16*)(ws + WS_XS);
    for (int row = c.gw; row < NT; row += c.ngw) {
        const unsigned v = info[row]; const int cls = (int)(v >> 24), rank = (int)(v & 0xffffffu); const size_t dest = (size_t)T[cls] * 256 + rank;
        const u32x4* src = (const u32x4*)(hn + (size_t)row * D_); u32x4* dst = (u32x4*)(xs + dest * D_);
        dst[c.lane] = src[c.lane]; dst[c.lane + 64] = src[c.lane + 64];
        if (c.lane == 0) { rowtok[dest] = row; roww[2 * dest] = tw[2 * row]; roww[2 * dest + 1] = tw[2 * row + 1]; }
    }
    for (int cls = c.bid; cls < 112; cls += c.G) { const int n = (int)cnt[cls], end = (int)((cnt[cls] + 255u) >> 8) * 256; const size_t base = (size_t)T[cls] * 256;
        for (int r = n + c.tid; r < end; r += NTHREADS) rowtok[base + r] = -1; }
}
__device__ __forceinline__ void P_moe_g1(int l_) { const KP p = (KP)__builtin_amdgcn_kernarg_segment_ptr(); int l = l_; asm volatile("" : "+s"(l));
    unsigned char* ws = p->ws; asm volatile("" : "+s"(ws));
    { int t0_ = threadIdx.x; asm volatile("" : "+v"(t0_)); moe_build_tables((const unsigned*)(ws + WS_CTL) + CW_MOECNT + l * 128, t0_); }
    const MoeOrder1 S{(const char*)(ws + WS_XS), (const char*)((const bf16*)(ws + WS_WGU_T) + (size_t)l * NEXP * 512 * D_), (int)gridDim.x, launder_s((int)blockIdx.x)};
    const pg8::Gemm g{D_, D_, D_, D_ / 64};
    const EpiMoeH E{(bf16*)(ws + WS_HB), (const float*)(ws + WS_ROUTE + RT_ROWW)};
    pg8::gemm_phase<EpiMoeH, MoeOrder1, true, true>((LAS unsigned char*)lds_raw, g, S, E);
}
__device__ __forceinline__ void P_moe_g2(int l_) { const KP p = (KP)__builtin_amdgcn_kernarg_segment_ptr(); int l = l_; asm volatile("" : "+s"(l));
    unsigned char* ws = p->ws; asm volatile("" : "+s"(ws));
    { int t0_ = threadIdx.x; asm volatile("" : "+v"(t0_)); moe_build_tables((const unsigned*)(ws + WS_CTL) + CW_MOECNT + l * 128, t0_); }
    const MoeOrder2 S{(const char*)(ws + WS_HB), (const char*)((const bf16*)(ws + WS_WD_T) + (size_t)l * NEXP * D_ * DEXP), (int)gridDim.x, launder_s((int)blockIdx.x)};
    const pg8::Gemm g{512, DEXP, 512, 4};
    const EpiMoeOut E{p->out, (const int*)(ws + WS_ROUTE + RT_ROWTOK)};
    pg8::gemm_phase<EpiMoeOut, MoeOrder2, true, true>((LAS unsigned char*)lds_raw, g, S, E);
}
__device__ __noinline__ void P_norm1(KP p_, int l_) { const KP p = uni_kp(p_); const int l = __builtin_amdgcn_readfirstlane(l_); const Ctx c = make_ctx(p); const Bufs b = make_bufs(p->ws);
    ph_norm_bf16(c, (l == 0) ? p->in[0] : p->out, p->in[1] + (size_t)l * D_, b.HN); }
__device__ __noinline__ void P_inproj(KP p_, int l_) { const KP p = uni_kp(p_); const int l = __builtin_amdgcn_readfirstlane(l_); const Ctx c = make_ctx(p); const Bufs b = make_bufs(p->ws);
    InProjOut o{b.QN, b.KV6, b.FQ, b.DQ, b.DV, b.GATE, b.FL, p->in[3] + l * 24, p->in[4] + l * 4};
    const bf16* A = b.HN;
    naive_gemm(c, NT, D_IN, D_, [=](int r, int k) { return bf2f(A[(size_t)r * D_ + k]); }, p->in[2] + (size_t)l * D_ * D_IN, D_IN,
               [=](int r, int col, float v) { inproj_store(o, r, col, v); }); }
__device__ __noinline__ void P_cmp1(KP p_, int l_, int kv_) { const KP p = uni_kp(p_); const int l = __builtin_amdgcn_readfirstlane(l_), kv = __builtin_amdgcn_readfirstlane(kv_); const Ctx c = make_ctx(p); const Bufs b = make_bufs(p->ws);
    const bf16* src = kv == 0 ? b.KC : b.VC; const float* pe = p->in[kv == 0 ? 5 : 8] + (size_t)l * 2048; bf16* hc = b.HC + (size_t)kv * 4096 * 256;
    naive_gemm(c, 4096, 256, 2048, [=](int r, int k) { return bf2f(src[(size_t)r * 1024 + k]) + pe[k]; }, p->in[kv == 0 ? 6 : 9] + (size_t)l * 2048 * 256, 256,
               [=](int r, int col, float v) { hc[(size_t)r * 256 + col] = (bf16)f2bf(gelu_tanh(v)); }); }
__device__ __noinline__ void P_cumsum(KP p_, int l_) { const KP p = uni_kp(p_); const int l = __builtin_amdgcn_readfirstlane(l_); const Ctx c = make_ctx(p); const Bufs b = make_bufs(p->ws); ph_cumsum(c, b.FL); }
__device__ __noinline__ void P_cmp2(KP p_, int l_, int kv_) { const KP p = uni_kp(p_); const int l = __builtin_amdgcn_readfirstlane(l_), kv = __builtin_amdgcn_readfirstlane(kv_); const Ctx c = make_ctx(p); const Bufs b = make_bufs(p->ws);
    const bf16* hc = b.HC + (size_t)kv * 4096 * 256; bf16* dst = kv == 0 ? b.KCMP : b.VCMP;
    naive_gemm(c, 4096, 64, 256, [=](int r, int k) { return bf2f(hc[(size_t)r * 256 + k]); }, p->in[kv == 0 ? 7 : 10] + (size_t)l * 256 * 64, 64,
               [=](int r, int col, float v) { dst[(size_t)r * 64 + col] = (bf16)f2bf((r & 255) == 255 ? 0.f : v); }); }
__device__ __noinline__ void P_win(KP p_, int l_) { const KP p = uni_kp(p_); const int l = __builtin_amdgcn_readfirstlane(l_); const Ctx c = make_ctx(p); const Bufs b = make_bufs(p->ws); ph_win_attn(c, b.QN, b.KW, b.VW, b.GATE, b.OWIN); }
__device__ __noinline__ void P_fox(KP p_, int l_) { const KP p = uni_kp(p_); const int l = __builtin_amdgcn_readfirstlane(l_); const Ctx c = make_ctx(p); const Bufs b = make_bufs(p->ws); ph_fox_attn(c, b.FQ, b.FK, b.FV, b.FL, b.ATT); }
__device__ __noinline__ void P_diff(KP p_, int l_) { const KP p = uni_kp(p_); const int l = __builtin_amdgcn_readfirstlane(l_); const Ctx c = make_ctx(p); const Bufs b = make_bufs(p->ws);
    ph_diff_attn(c, b.DQ, b.DK, b.DV, p->in[11] + (size_t)l * 128, p->in[12] + (size_t)l * 64, lambda_init_of(l), b.ATT); }
__device__ __noinline__ void P_cmpattn(KP p_, int l_) { const KP p = uni_kp(p_); const int l = __builtin_amdgcn_readfirstlane(l_); const Ctx c = make_ctx(p); const Bufs b = make_bufs(p->ws); ph_cmp_attn(c, b.QN, b.KCMP, b.VCMP, b.GATE, b.SEL, b.OCMP); }
__device__ __noinline__ void P_slc(KP p_, int l_) { const KP p = uni_kp(p_); const int l = __builtin_amdgcn_readfirstlane(l_); const Ctx c = make_ctx(p); const Bufs b = make_bufs(p->ws); ph_slc_attn(c, b.QN, b.KS, b.VS, b.GATE, b.SEL, b.OCMP, b.OWIN, b.ATT); }
__device__ __noinline__ void P_outproj(KP p_, int l_) { const KP p = uni_kp(p_); const int l = __builtin_amdgcn_readfirstlane(l_); const Ctx c = make_ctx(p); const Bufs b = make_bufs(p->ws);
    const bf16* A = b.ATT; float* xo = p->out; const float* xin = (l == 0) ? p->in[0] : p->out;
    naive_gemm(c, NT, D_, D_, [=](int r, int k) { return bf2f(A[(size_t)r * D_ + k]); }, p->in[13] + (size_t)l * D_ * D_, D_,
               [=](int r, int col, float v) { xo[(size_t)r * D_ + col] = xin[(size_t)r * D_ + col] + v; }); }
__device__ __noinline__ void P_route(KP p_, int l_) { const KP p = uni_kp(p_); const int l = __builtin_amdgcn_readfirstlane(l_); const Ctx c = make_ctx(p); const Bufs b = make_bufs(p->ws);
    ph_moe_route(c, p->out, p->in[14] + (size_t)l * D_, p->in[15] + (size_t)l * D_ * 4, p->in[16] + l * 4, p->in[17] + (size_t)l * D_ * 32, p->in[18] + l * 32, b.HN, (int*)(p->ws + WS_ROUTE + RT_INFO), (float*)(p->ws + WS_ROUTE + RT_W), (unsigned*)(p->ws + WS_CTL) + CW_MOECNT + l * 128); }
__device__ __noinline__ void P_moe(KP p_, int l_) { const KP p = uni_kp(p_); const int l = __builtin_amdgcn_readfirstlane(l_); const Ctx c = make_ctx(p); const Bufs b = make_bufs(p->ws);
    ph_moe_naive(c, b.HN, b.ROUTE_E, b.ROUTE_W, p->in[19] + (size_t)l * NEXP * D_ * DEXP, p->in[20] + (size_t)l * NEXP * D_ * DEXP, p->in[21] + (size_t)l * NEXP * DEXP * D_, p->out); }
__device__ __noinline__ void P_final(KP p_) { const KP p = uni_kp(p_); const Ctx c = make_ctx(p); ph_norm_final(c, p->out, p->in[22]); }
__device__ __noinline__ void P_gridbar(KP p_) { const KP p = uni_kp(p_);
    XcdBarrier bar; bar.bar = (unsigned*)(p->ws + WS_CTL) + 4096; bar.x = xb_xcc_id(); bar.st = (volatile LAS unsigned*)((LAS unsigned char*)lds_raw + MISC_OFF) + 8;
    xcd_barrier(bar);
}

__global__ void __launch_bounds__(NTHREADS, 2) fwd_kernel(Params pp) {
    const KP p = (KP)__builtin_amdgcn_kernarg_segment_ptr();
    { volatile LAS unsigned* MISC = (volatile LAS unsigned*)((LAS unsigned char*)lds_raw + MISC_OFF); if (threadIdx.x < 32) MISC[threadIdx.x] = 0u; }
    __syncthreads();
    const int lo = p->ph_lo, hi = p->ph_hi;
    if (hi - lo > 1) (void)xcd_barrier_post((unsigned*)(p->ws + WS_CTL) + 4096, (volatile LAS unsigned*)((LAS unsigned char*)lds_raw + MISC_OFF) + 8);
#define IN(k) (lo <= (k) && (k) < hi)
#define SEAM(k) do { if (IN(k) && IN((k) + 1)) P_gridbar(p); } while (0)
    if (IN(0)) P_prologue(p);
    SEAM(0);
    for (int l = 0; l < L_; ++l) {
        const int P0 = 1 + l * PH_PER_LAYER;
        if (IN(P0 + 0)) P_norm1(p, l);
        SEAM(P0 + 0);
        if (IN(P0 + 1)) P_inproj_mfma(l);
        SEAM(P0 + 1);
        if (IN(P0 + 2)) { P_cmp1_mfma(l); P_cumsum(p, l); }
        SEAM(P0 + 2);
        if (IN(P0 + 3)) { P_cmp2_mfma(l);
            for (;;) { const int u = fetch_unit(p, l * 8 + 0); if (u >= 2048) break;
                if (u < 1024) { const int qb = 15 - (u >> 6), k = u & 63; if (k < 32) U_diff(p, k, qb, l); else U_fox(p, k - 32, qb); }
                else { const int w = u - 1024; U_win(p, w & 15, 63 - (w >> 4)); } } }
        SEAM(P0 + 3);
        if (IN(P0 + 4)) P_cmpattn(p, l);
        SEAM(P0 + 4);
        if (IN(P0 + 5)) { for (;;) { const int u = fetch_unit(p, l * 8 + 1); if (u >= 1024) break; U_slc(p, u & 15, 63 - (u >> 4)); } }
        SEAM(P0 + 5);
        if (IN(P0 + 6)) P_outproj_mfma(l);
        SEAM(P0 + 6);
        if (IN(P0 + 7)) P_route(p, l);
        SEAM(P0 + 7);
        if (IN(P0 + 8)) P_moe_scatter(p, l);
        SEAM(P0 + 8);
        if (IN(P0 + 9)) P_moe_g1(l);
        SEAM(P0 + 9);
        if (IN(P0 + 10)) P_moe_g2(l);
        SEAM(P0 + 10);
    }
    if (IN(1 + L_ * PH_PER_LAYER)) P_final(p);
#undef IN
#undef SEAM
}

extern "C" void kernel_launch(void* const* d_in, const int* in_sizes, int n_in, void* d_out, int out_size, void* d_ws, size_t ws_size, hipStream_t stream) {
    static int grid = 0;
    if (grid == 0) {
        if (n_in != 23 || out_size != NT * D_ || ws_size < WS_END) { fprintf(stderr, "kernel_launch: unexpected sizes n_in %d out %d ws %zu (need %zu)\n", n_in, out_size, ws_size, (size_t)WS_END); grid = -1; return; }
        int dev = 0, cus = 0, per_cu = 0;
        if (hipGetDevice(&dev) != hipSuccess || hipDeviceGetAttribute(&cus, hipDeviceAttributeMultiprocessorCount, dev) != hipSuccess) { grid = -1; return; }
        if (hipFuncSetAttribute((const void*)fwd_kernel, hipFuncAttributeMaxDynamicSharedMemorySize, LDS_BYTES) != hipSuccess) { fprintf(stderr, "kernel_launch: hipFuncSetAttribute failed\n"); grid = -1; return; }
        if (hipOccupancyMaxActiveBlocksPerMultiprocessor(&per_cu, (const void*)fwd_kernel, NTHREADS, LDS_BYTES) != hipSuccess || per_cu < 1) { fprintf(stderr, "kernel_launch: occupancy query says %d\n", per_cu); }
        (void)hipGetLastError();
        grid = cus;
    }
    if (grid < 0) return;
    (void)hipMemsetAsync((char*)d_ws + WS_CTL, 0, CTL_BYTES, stream);
    Params p{};
    for (int i = 0; i < 23; ++i) p.in[i] = (const float*)d_in[i];
    p.out = (float*)d_out; p.ws = (unsigned char*)d_ws;
#if N_LAUNCH_MODE == 0
    p.ph_lo = 0; p.ph_hi = N_PHASES;
    hipLaunchKernelGGL(fwd_kernel, dim3(grid), dim3(NTHREADS), LDS_BYTES, stream, p);
#else
    for (int k = 0; k < N_PHASES; ++k) { p.ph_lo = k; p.ph_hi = k + 1; hipLaunchKernelGGL(fwd_kernel, dim3(grid), dim3(NTHREADS), LDS_BYTES, stream, p); }
#endif
}
```

```cpp
#include <hip/hip_runtime.h>
#include <cstdio>
#include <cstdint>

#ifndef N_LAUNCH_MODE
#define N_LAUNCH_MODE 0
#endif

#define LAS __attribute__((address_space(3)))
#define GAS __attribute__((address_space(1)))
typedef unsigned short bf16;
typedef unsigned long long u64;
typedef float f32x4 __attribute__((ext_vector_type(4)));
typedef unsigned u32x4 __attribute__((ext_vector_type(4)));

constexpr int B_ = 8, T_ = 4096, D_ = 1024, NT = B_ * T_, L_ = 2;
constexpr int HD = 64, D_IN = 2844;
constexpr int N_CMP = 255, CMP_HID = 256;
constexpr int NEXP = 32, DEXP = 256;
constexpr float EPS = 1e-6f;
constexpr float LOG2E = 1.4426950408889634f;
constexpr int NWAVES = 8, NTHREADS = 512;

constexpr int C_NSAQ = 0, C_KV6 = 512, C_GATE = 1280, C_FQ = 1304, C_FF = 2072, C_DQ = 2076, C_DV = 2588;

constexpr size_t MiB = 1u << 20;
constexpr size_t WS_CTL = 0, CTL_BYTES = 1 * MiB;
constexpr size_t WS_QN = 1 * MiB;
constexpr size_t WS_KV6 = WS_QN + 32 * MiB;
constexpr size_t KV6_STRIDE = 8 * MiB + 64 * 1024;
constexpr size_t WS_FQKV = WS_KV6 + 6 * KV6_STRIDE;
constexpr size_t WS_DQK = WS_FQKV + 48 * MiB;
constexpr size_t WS_DV = WS_DQK + 32 * MiB;
constexpr size_t WS_GATE = WS_DV + 16 * MiB;
constexpr size_t WS_FL = WS_GATE + 3 * MiB;
constexpr size_t WS_HC = WS_FL + 1 * MiB;
constexpr size_t WS_KVCMP = WS_HC + 4 * MiB;
constexpr size_t WS_SEL = WS_KVCMP + 1 * MiB;
constexpr size_t WS_OCMP = WS_SEL + 1 * MiB;
constexpr size_t WS_OWIN = WS_OCMP + 32 * MiB;
constexpr size_t WS_HN = WS_OWIN + 32 * MiB;
constexpr size_t WS_ATT = WS_HN + 64 * MiB;
constexpr size_t WS_ROUTE = WS_ATT + 64 * MiB;
constexpr size_t WS_WIN_T = WS_ROUTE + 2 * MiB;
constexpr size_t WS_WOUT_T = WS_WIN_T + 12 * MiB;
constexpr size_t WS_WGU_T = WS_WOUT_T + 4 * MiB;
constexpr size_t WS_WD_T = WS_WGU_T + 64 * MiB;
constexpr size_t WS_W1_T = WS_WD_T + 32 * MiB;
constexpr size_t WS_W2_T = WS_W1_T + 4 * MiB;
constexpr size_t WS_BIAS1 = WS_W2_T + 512 * 1024;
constexpr size_t WS_END = WS_BIAS1 + 512 * 1024;
constexpr int MOE_MAXROWS = 61440;
constexpr size_t WS_XS = WS_QN;
constexpr size_t WS_HB = WS_OCMP;
static_assert(WS_XS + (size_t)MOE_MAXROWS * 2048 <= WS_DQK && WS_HB + (size_t)MOE_MAXROWS * 1024 <= WS_HN, "MoE aliases");
constexpr size_t RT_INFO = 0, RT_W = 128 * 1024, RT_ROWTOK = 384 * 1024, RT_ROWW = 640 * 1024;
constexpr int CW_QUEUE = 16384, CW_MOECNT = 32768;
constexpr int TBL_OFF = 131072 + 1024;
constexpr int NIN = 3072;

extern __shared__ __attribute__((aligned(16))) unsigned char lds_raw[];
__device__ __forceinline__ float bf2f(bf16 v) { return __uint_as_float(((unsigned)v) << 16); }
__device__ __forceinline__ unsigned f2bf(float f) { unsigned u = __float_as_uint(f); return (u + 0x7fffu + ((u >> 16) & 1u)) >> 16; }
__device__ __forceinline__ unsigned pk2(float lo, float hi) { return f2bf(lo) | (f2bf(hi) << 16); }
__device__ __forceinline__ float wave_sum(float v) {
#pragma unroll
    for (int o = 1; o < 64; o <<= 1) v += __shfl_xor(v, o);
    return v;
}
__device__ __forceinline__ float wave_max(float v) {
#pragma unroll
    for (int o = 1; o < 64; o <<= 1) v = fmaxf(v, __shfl_xor(v, o));
    return v;
}
__device__ __forceinline__ float shflx_f(float v, int o, int lane) { return __uint_as_float((unsigned)__builtin_amdgcn_ds_bpermute((lane ^ o) << 2, (int)__float_as_uint(v))); }
__device__ __forceinline__ unsigned shflx_u(unsigned v, int o, int lane) { return (unsigned)__builtin_amdgcn_ds_bpermute((lane ^ o) << 2, (int)v); }
__device__ __forceinline__ float wave_sum_l(float v, int lane) {
#pragma unroll
    for (int o = 1; o < 64; o <<= 1) v += shflx_f(v, o, lane);
    return v;
}
__device__ __forceinline__ int launder_s(int v) { asm volatile("" : "+s"(v)); return v; }
__device__ __forceinline__ float sigmoidf_(float x) { return 1.f / (1.f + __expf(-x)); }
__device__ __forceinline__ float log_sigmoidf_(float x) { return x >= 0.f ? -log1pf(__expf(-x)) : x - log1pf(__expf(x)); }
__device__ __forceinline__ float gelu_tanh(float x) { const float u = 0.7978845608028654f * (x + 0.044715f * x * x * x); return 0.5f * x * (1.f + tanhf(u)); }
__device__ __forceinline__ float alibi_slope(int idx1, int n) { return exp2f(-8.0f * (float)idx1 / (float)n); }

#define XB_TMO      128
#define XB_XCNT(j)  (256  + 64 * (j))
#define XB_XSUB(j)  (1280 + 64 * (j))
#define XB_XGEN(j)  (2304 + 64 * (j))
#define XB_TOP      3328
#define XB_TOPGEN   3392
#define XCD_BAR_WORDS 3456
#define XB_SPIN_CAP (1u << 25)
__device__ __forceinline__ unsigned xb_ld(unsigned* p)              { return __hip_atomic_load(p, __ATOMIC_RELAXED, __HIP_MEMORY_SCOPE_AGENT); }
__device__ __forceinline__ unsigned xb_add(unsigned* p, unsigned v) { return __hip_atomic_fetch_add(p, v, __ATOMIC_RELAXED, __HIP_MEMORY_SCOPE_AGENT); }
__device__ __forceinline__ unsigned xb_xcc_id() { return (unsigned)__builtin_amdgcn_s_getreg((3 << 11) | 20) & 0xFu; }
#define XB_SPIN(cond, bar) do { unsigned _sp = 0; while (cond) { __builtin_amdgcn_s_sleep(1); \
    if ((++_sp & 255u) == 0u) { if (xb_ld(&(bar)[XB_TMO])) break; if (_sp > XB_SPIN_CAP) { atomicAdd(&(bar)[XB_TMO], 1u); break; } } } } while (0)
struct XcdBarrier { unsigned* bar; unsigned x; volatile LAS unsigned* st; };
__device__ __forceinline__ XcdBarrier xcd_barrier_post(unsigned* bar, volatile LAS unsigned* st) {
    XcdBarrier b; b.bar = bar; b.x = xb_xcc_id(); b.st = st;
    if (threadIdx.x == 0) (void)xb_add(&bar[XB_XCNT(b.x)], 1u);
    return b;
}
__device__ __forceinline__ void xcd_barrier_complete(unsigned* bar, unsigned x, unsigned& nloc, unsigned& nx) {
    const unsigned G = gridDim.x * gridDim.y * gridDim.z;
    unsigned sum, cnt, mine, sp = 0u;
    for (;;) {
        sum = 0u; cnt = 0u; mine = 0u;
#pragma unroll
        for (unsigned j = 0; j < 16; ++j) { const unsigned c = xb_ld(&bar[XB_XCNT(j)]); sum += c; cnt += (c > 0u) ? 1u : 0u; mine = (j == x) ? c : mine; }
        if (sum == G) break;
        __builtin_amdgcn_s_sleep(1);
        if ((++sp & 255u) == 0u) { if (xb_ld(&bar[XB_TMO])) break; if (sp > XB_SPIN_CAP) { atomicAdd(&bar[XB_TMO], 1u); break; } }
    }
    nloc = mine > 0u ? mine : 1u; nx = cnt > 0u ? cnt : 1u;
}
__device__ __forceinline__ void xcd_barrier(const XcdBarrier& b) {
    asm volatile("s_waitcnt vmcnt(0)" ::: "memory");
    __syncthreads();
    if (threadIdx.x == 0) {
        unsigned* bar = b.bar;
        __builtin_amdgcn_s_waitcnt(0);
        unsigned nloc = b.st[0], nx = b.st[1];
        if (nloc == 0u) { xcd_barrier_complete(bar, b.x, nloc, nx); b.st[0] = nloc; b.st[1] = nx; }
        const unsigned old = xb_add(&bar[XB_XSUB(b.x)], 1u);
        const unsigned gen = old / nloc;
        if (old + 1u == (gen + 1u) * nloc) {
            __builtin_amdgcn_fence(__ATOMIC_RELEASE, "agent");
            asm volatile("s_waitcnt vmcnt(0)" ::: "memory");
            const unsigned og = xb_add(&bar[XB_TOP], 1u);
            const unsigned tg = og / nx;
            if (og + 1u == (tg + 1u) * nx) xb_add(&bar[XB_TOPGEN], 1u);
            else XB_SPIN(xb_ld(&bar[XB_TOPGEN]) == tg, bar);
            __builtin_amdgcn_fence(__ATOMIC_ACQUIRE, "agent");
            xb_add(&bar[XB_XGEN(b.x)], 1u);
            asm volatile("s_waitcnt vmcnt(0)" ::: "memory");
        } else {
            XB_SPIN(xb_ld(&bar[XB_XGEN(b.x)]) == gen, bar);
            __builtin_amdgcn_fence(__ATOMIC_ACQUIRE, "agent");
            asm volatile("s_waitcnt vmcnt(0)" ::: "memory");
        }
    }
    __syncthreads();
}

struct Params { const float* in[23]; float* out; unsigned char* ws; int ph_lo, ph_hi; };
constexpr int LDS_BYTES = 147456;
constexpr int MISC_OFF = 131072 + 320;

struct Ctx {
    LAS unsigned char* lds; int tid, lane, wave, bid, G, gw, ngw;
    const float* const* in; float* xcur; unsigned char* ws;
};

namespace pg8 {
#define PG8_LAS __attribute__((address_space(3)))
typedef unsigned short bf16_t;
typedef short bf16x8 __attribute__((ext_vector_type(8)));
typedef float f32x4 __attribute__((ext_vector_type(4)));
typedef unsigned u32x4 __attribute__((ext_vector_type(4)));
constexpr int BM = 256, BK = 64, HALF = 128, HTB = HALF * BK * 2  , STAGE_BYTES = 8 * HTB, NXCD = 8, WGM = 8;

__host__ __device__ __forceinline__ int lds_byte(int r, int c) { const int st = (r >> 4) * 2 + (c >> 5), rr = r & 15, cc = c & 31, ob = rr * 64 + cc * 2; return st * 1024 + (ob ^ (((ob >> 9) & 1) << 5)); }
__host__ __device__ __forceinline__ void stage_rc(int b, int& R, int& C) { const int st = b / 1024, sb = b % 1024, swz = sb ^ (((sb >> 9) & 1) << 5); R = (st >> 1) * 16 + swz / 64; C = (st & 1) * 32 + (swz % 64) / 2; }
__host__ __device__ __forceinline__ int perm32(int rho) { const int n = rho >> 4, i = rho & 15; return 8 * (i >> 2) + 4 * n + (i & 3); }

struct Unit { int pm, pn; const char* a; const char* b; const char* b2; };
struct Gemm { int lda, ldb, K, ksplit; };

__device__ __forceinline__ unsigned cvt_pk_bf16(float lo, float hi) { unsigned r; asm volatile("v_cvt_pk_bf16_f32 %0, %1, %2" : "=v"(r) : "v"(lo), "v"(hi)); return r; }
typedef float f32x2 __attribute__((ext_vector_type(2)));

template <class Epi, class Sched, bool ALIGN_EPI = false, bool SP2 = false>
__device__ __forceinline__ void gemm_phase(PG8_LAS unsigned char* lds, const Gemm g, const Sched& S, const Epi& E) {
    int tid_ = threadIdx.x; asm volatile("" : "+v"(tid_));
    const int tid = tid_, wid = __builtin_amdgcn_readfirstlane(tid >> 6), lane = tid & 63, wr = wid >> 2, wc = wid & 3, fr = lane & 15, fq = lane >> 4;
    const int K = g.K, nt = K / BK, ks = g.ksplit;
    unsigned voffA[2], voffB[2];
#pragma unroll
    for (int i = 0; i < 2; ++i) { int R, C; stage_rc(tid * 16 + i * 8192, R, C); const int Rb = Epi::PERM ? ((R & ~31) + perm32(R & 31)) : R;
        voffA[i] = (unsigned)(R * g.lda + C) * 2u; voffB[i] = (unsigned)(Rb * g.ldb + C) * 2u; }
    const size_t kstep = (size_t)(BK * 2);
    const size_t hsA = (size_t)HALF * g.lda * 2, hsB = (size_t)HALF * g.ldb * 2;
    const unsigned ldsw = (unsigned)wid * 1024u;
    const int aoff = lds_byte(wr * 64 + fr, fq * 8), boff = lds_byte(wc * 32 + fr, fq * 8);
#define PG8_SA(b, h) (((b) * 2 + (h)) * HTB)
#define PG8_SB(b, h) ((4 + (b) * 2 + (h)) * HTB)
#define PG8_STAGE(bufoff, gbase, voff) do { _Pragma("unroll") for (int _i = 0; _i < 2; ++_i) \
        __builtin_amdgcn_global_load_lds((const unsigned*)((const char*)(gbase) + (voff)[_i]), (PG8_LAS unsigned*)(lds + (bufoff) + ldsw + _i * 8192), 16, 0, 0); } while (0)
#define PG8_LDA(dst, b, h) do { _Pragma("unroll") for (int m = 0; m < 4; ++m) _Pragma("unroll") for (int k = 0; k < 2; ++k) dst[m][k] = *(const PG8_LAS bf16x8*)(lds + PG8_SA(b, h) + aoff + m * 2048 + k * 1024); } while (0)
#define PG8_LDB(dst, b, h) do { _Pragma("unroll") for (int n = 0; n < 2; ++n) _Pragma("unroll") for (int k = 0; k < 2; ++k) dst[n][k] = *(const PG8_LAS bf16x8*)(lds + PG8_SB(b, h) + boff + n * 2048 + k * 1024); } while (0)
#define PG8_MMA(ai, bj, At, Bt) do { __builtin_amdgcn_s_setprio(1); _Pragma("unroll") for (int m = 0; m < 4; ++m) _Pragma("unroll") for (int n = 0; n < 2; ++n) _Pragma("unroll") for (int k = 0; k < 2; ++k) \
        acc[ai][bj][m][n] = __builtin_amdgcn_mfma_f32_16x16x32_bf16(Bt[n][k], At[m][k], acc[ai][bj][m][n], 0, 0, 0); __builtin_amdgcn_s_setprio(0); } while (0)
#define PG8_WAIT_V(n) asm volatile("s_waitcnt vmcnt(" #n ")" ::: "memory")
#define PG8_WAIT_L(n) asm volatile("s_waitcnt lgkmcnt(" #n ")" ::: "memory")
#define PG8_BAR __builtin_amdgcn_s_barrier()
#define PG8_SCHED __builtin_amdgcn_sched_barrier(0)
    Unit cur, nxt; int ui = 0;
    if (!S.next(0, cur)) return;
    f32x4 acc[2][2][4][2];
#pragma unroll
    for (int a = 0; a < 2; ++a)
#pragma unroll
        for (int b = 0; b < 2; ++b)
#pragma unroll
            for (int m = 0; m < 4; ++m)
#pragma unroll
                for (int n = 0; n < 2; ++n) acc[a][b][m][n] = (f32x4){0.f, 0.f, 0.f, 0.f};
    bf16x8 At[4][2], B0[2][2], B1[2][2];
    const char* cA = cur.a; const char* cB = cur.b; const char* cB2 = cur.b2;
#define PG8_BK(base, base2, kt) ((kt) < ks ? (base) + (size_t)(kt) * kstep : (base2) + (size_t)((kt) - ks) * kstep)
    S.a_ready(cur);
    if constexpr (SP2) {
        PG8_STAGE(PG8_SB(0, 0), cB, voffB); PG8_STAGE(PG8_SB(0, 1), cB + hsB, voffB); PG8_STAGE(PG8_SA(0, 0), cA, voffA); PG8_STAGE(PG8_SA(0, 1), cA + hsA, voffA);
        if (wr == 1) PG8_BAR;
        PG8_WAIT_V(2); PG8_BAR;
        PG8_STAGE(PG8_SB(1, 0), PG8_BK(cB, cB2, 1), voffB); PG8_STAGE(PG8_SA(1, 0), cA + kstep, voffA); PG8_STAGE(PG8_SB(1, 1), PG8_BK(cB, cB2, 1) + hsB, voffB);
        PG8_WAIT_V(6); PG8_BAR;
    } else {
        PG8_STAGE(PG8_SB(0, 0), cB, voffB); PG8_STAGE(PG8_SA(0, 0), cA, voffA); PG8_STAGE(PG8_SB(0, 1), cB + hsB, voffB); PG8_STAGE(PG8_SA(0, 1), cA + hsA, voffA);
        if (wr == 1) PG8_BAR;
        PG8_WAIT_V(4); PG8_BAR;
        PG8_STAGE(PG8_SB(1, 0), PG8_BK(cB, cB2, 1), voffB); PG8_STAGE(PG8_SA(1, 0), cA + kstep, voffA); PG8_STAGE(PG8_SB(1, 1), PG8_BK(cB, cB2, 1) + hsB, voffB);
        PG8_WAIT_V(6); PG8_BAR;
    }
    for (;;) {
        const bool has_next = S.next(ui + 1, nxt);
        const char* nA = has_next ? nxt.a : cA; const char* nB = has_next ? nxt.b : cB; const char* nB2 = has_next ? nxt.b2 : cB2;
#pragma unroll 1
        for (int t = 0; t < nt; t += 2) {
            const bool last = (t == nt - 2);
            const char* a1 = cA + (size_t)(t + 1) * kstep;
            const char* a2 = last ? nA : cA + (size_t)(t + 2) * kstep; const char* b2 = last ? PG8_BK(nB, nB2, 0) : PG8_BK(cB, cB2, t + 2);
            const char* a3 = a2 + kstep; const char* b3 = last ? PG8_BK(nB, nB2, 1) : PG8_BK(cB, cB2, t + 3);
            if (last && has_next) S.a_ready(nxt);
            if constexpr (SP2) {
            PG8_LDB(B0, 0, 0); PG8_LDB(B1, 0, 1); PG8_SCHED; PG8_LDA(At, 0, 0); PG8_STAGE(PG8_SA(1, 1), a1 + hsA, voffA);
            PG8_WAIT_V(8); PG8_WAIT_L(0); PG8_BAR; PG8_MMA(0, 0, At, B0); PG8_MMA(0, 1, At, B1); PG8_BAR; PG8_SCHED;
            PG8_LDA(At, 0, 1); PG8_STAGE(PG8_SB(0, 0), b2, voffB); PG8_STAGE(PG8_SB(0, 1), b2 + hsB, voffB); PG8_STAGE(PG8_SA(0, 0), a2, voffA);
            PG8_WAIT_V(8); PG8_WAIT_L(0); PG8_BAR; PG8_MMA(1, 0, At, B0); PG8_MMA(1, 1, At, B1); PG8_BAR; PG8_SCHED;
            PG8_LDB(B0, 1, 0); PG8_LDB(B1, 1, 1); PG8_SCHED; PG8_LDA(At, 1, 0); PG8_STAGE(PG8_SA(0, 1), a2 + hsA, voffA);
            PG8_WAIT_V(8); PG8_WAIT_L(0); PG8_BAR; PG8_MMA(0, 0, At, B0); PG8_MMA(0, 1, At, B1); PG8_BAR; PG8_SCHED;
            PG8_LDA(At, 1, 1); PG8_STAGE(PG8_SB(1, 0), b3, voffB); PG8_STAGE(PG8_SB(1, 1), b3 + hsB, voffB); PG8_STAGE(PG8_SA(1, 0), a3, voffA);
            PG8_WAIT_V(8); PG8_WAIT_L(0); PG8_BAR; PG8_MMA(1, 0, At, B0); PG8_MMA(1, 1, At, B1); PG8_BAR; PG8_SCHED;
            } else {
            PG8_LDB(B0, 0, 0); PG8_SCHED; PG8_LDA(At, 0, 0); PG8_STAGE(PG8_SA(1, 1), a1 + hsA, voffA);
            PG8_WAIT_L(8); PG8_BAR; PG8_WAIT_L(0); PG8_MMA(0, 0, At, B0); PG8_BAR; PG8_SCHED;
            PG8_LDB(B1, 0, 1); PG8_STAGE(PG8_SB(0, 0), b2, voffB);
            PG8_BAR; PG8_WAIT_L(0); PG8_MMA(0, 1, At, B1); PG8_BAR;
            PG8_LDA(At, 0, 1); PG8_STAGE(PG8_SA(0, 0), a2, voffA);
            PG8_BAR; PG8_WAIT_L(0); PG8_MMA(1, 0, At, B0); PG8_BAR; PG8_SCHED;
            PG8_STAGE(PG8_SB(0, 1), b2 + hsB, voffB);
            PG8_WAIT_V(6); PG8_BAR; PG8_MMA(1, 1, At, B1); PG8_BAR;
            PG8_LDB(B0, 1, 0); PG8_SCHED; PG8_LDA(At, 1, 0); PG8_STAGE(PG8_SA(0, 1), a2 + hsA, voffA);
            PG8_WAIT_L(8); PG8_BAR; PG8_WAIT_L(0); PG8_MMA(0, 0, At, B0); PG8_BAR; PG8_SCHED;
            PG8_LDB(B1, 1, 1); PG8_STAGE(PG8_SB(1, 0), b3, voffB);
            PG8_BAR; PG8_WAIT_L(0); PG8_MMA(0, 1, At, B1); PG8_BAR;
            PG8_LDA(At, 1, 1); PG8_STAGE(PG8_SA(1, 0), a3, voffA);
            PG8_BAR; PG8_WAIT_L(0); PG8_MMA(1, 0, At, B0); PG8_BAR; PG8_SCHED;
            PG8_STAGE(PG8_SB(1, 1), b3 + hsB, voffB);
            PG8_WAIT_V(6); PG8_BAR; PG8_MMA(1, 1, At, B1); PG8_BAR;
            }
        }
        if constexpr (ALIGN_EPI) { if (wr == 0) PG8_BAR; }
        if constexpr (!Epi::AFTER_DRAIN) { E(acc, cur, wr, wc, fr, fq); S.done(cur); }
        if (!has_next) break;
#pragma unroll
        for (int a = 0; a < 2; ++a)
#pragma unroll
            for (int b = 0; b < 2; ++b)
#pragma unroll
                for (int m = 0; m < 4; ++m)
#pragma unroll
                    for (int n = 0; n < 2; ++n) acc[a][b][m][n] = (f32x4){0.f, 0.f, 0.f, 0.f};
        cur = nxt; cA = nA; cB = nB; cB2 = nB2; ++ui;
        if constexpr (ALIGN_EPI) { if (wr == 1) PG8_BAR; }
    }
    PG8_WAIT_V(0);
    if constexpr (!ALIGN_EPI) { if (wr == 0) PG8_BAR; }
    PG8_BAR;
    if constexpr (Epi::AFTER_DRAIN) { E.fused(acc, cur, wr, wc, fr, fq, lds, wid, lane); S.done(cur); }
#undef PG8_BK
#undef PG8_SA
#undef PG8_SB
#undef PG8_STAGE
#undef PG8_LDA
#undef PG8_LDB
#undef PG8_MMA
#undef PG8_WAIT_V
#undef PG8_WAIT_L
#undef PG8_BAR
#undef PG8_SCHED
}
}

struct PlainOrder {
    const char* A; const char* Bt; int lda, ldb, nM, nN, nwg, G, c;
    __device__ __forceinline__ void init(const void* A_, const void* Bt_, int lda_, int ldb_, int M, int N, int G_, int c_) { A = (const char*)A_; Bt = (const char*)Bt_; lda = lda_; ldb = ldb_; nM = M / 256; nN = N / 256; nwg = nM * nN; G = G_; c = c_; }
    __device__ __forceinline__ bool next(int i, pg8::Unit& u) const {
        const long L = (long)i * G + c; if (L >= nwg) return false;
        int wgid = (int)L; { const int q = nwg / 8, r = nwg % 8, xcd = wgid % 8, off = wgid / 8; wgid = (xcd < r ? xcd * (q + 1) : r * (q + 1) + (xcd - r) * q) + off; }
        const int nig = 8 * nN, gid = wgid / nig, fm = gid * 8, gsz = (nM - fm) < 8 ? (nM - fm) : 8;
        u.pm = fm + ((wgid % nig) % gsz); u.pn = (wgid % nig) / gsz;
        u.a = A + (size_t)u.pm * 256 * lda * 2; u.b = Bt + (size_t)u.pn * 256 * ldb * 2; u.b2 = u.b; return true;
    }
    __device__ __forceinline__ void a_ready(const pg8::Unit&) const {}
    __device__ __forceinline__ void done(const pg8::Unit&) const {}
};
struct EpiInProj {
    static constexpr bool PERM = true, AFTER_DRAIN = false;
    unsigned char* ws; const float* b_gate; const float* b_fgt;
    __device__ __forceinline__ void operator()(const pg8::f32x4 (&acc)[2][2][4][2], const pg8::Unit& u, int wr, int wc, int fr, int fq) const {
        { int t_ = threadIdx.x; asm volatile("" : "+v"(t_)); fr = t_ & 15; fq = (t_ >> 4) & 3; }
        const int pn = u.pn, b = (u.pm * 256) / T_, t0 = u.pm * 256 - b * T_ + wr * 64 + fr;
        if (pn == 11) {
            if (wc == 0 && fq < 4) {
                float* gate = (float*)(ws + WS_GATE); float* fl = (float*)(ws + WS_FL);
#pragma unroll
                for (int ai = 0; ai < 2; ++ai)
#pragma unroll
                    for (int m = 0; m < 4; ++m) { const int t = t0 + ai * 128 + m * 16; const size_t n = (size_t)b * T_ + t;
#pragma unroll
                        for (int nn = 0; nn < 2; ++nn)
#pragma unroll
                            for (int e = 0; e < 4; ++e) { const int c = 8 * fq + 4 * nn + e; const float v = acc[ai][0][m][nn][e];
                                if (c < 24) gate[n * 24 + c] = sigmoidf_(v + b_gate[c]);
                                else if (c < 28) fl[(size_t)(b * 4 + (c - 24)) * T_ + t] = log_sigmoidf_(v + b_fgt[c - 24]); } }
            }
            return;
        }
#pragma unroll
        for (int bj = 0; bj < 2; ++bj) {
            const int c = bj * 128 + wc * 32 + 8 * fq;
            bf16* base; int W = 64; float sc = 1.f;
            if (pn < 2) { base = (bf16*)(ws + WS_QN) + (size_t)(b * 8 + pn * 4 + (c >> 6)) * T_ * 64 + (c & 63); sc = 0.125f * LOG2E; }
            else if (pn < 5) { base = (bf16*)(ws + WS_KV6 + (size_t)((pn - 2) * 2 + (c >> 7)) * KV6_STRIDE) + (size_t)(b * 2 + ((c >> 6) & 1)) * T_ * 64 + (c & 63); }
            else if (pn < 8) { base = (bf16*)(ws + WS_FQKV) + (size_t)(pn - 5) * (8 * MiB) + (size_t)(b * 4 + (c >> 6)) * T_ * 64 + (c & 63); if (pn == 5) sc = 0.125f * LOG2E; }
            else if (pn < 10) { base = (bf16*)(ws + WS_DQK) + (size_t)(pn - 8) * (8 * MiB) + (size_t)(b * 8 + (c >> 5)) * T_ * 32 + (c & 31); W = 32; if (pn == 8) sc = 0.17677669529663687f * LOG2E; }
            else { base = (bf16*)(ws + WS_DV) + (size_t)(b * 4 + (c >> 6)) * T_ * 64 + (c & 63); }
#pragma unroll
            for (int ai = 0; ai < 2; ++ai)
#pragma unroll
                for (int m = 0; m < 4; ++m) { const int t = t0 + ai * 128 + m * 16;
                    const pg8::f32x4 v0 = acc[ai][bj][m][0] * sc, v1 = acc[ai][bj][m][1] * sc;
                    pg8::u32x4 w; w.x = pg8::cvt_pk_bf16(v0[0], v0[1]); w.y = pg8::cvt_pk_bf16(v0[2], v0[3]); w.z = pg8::cvt_pk_bf16(v1[0], v1[1]); w.w = pg8::cvt_pk_bf16(v1[2], v1[3]);
                    *(pg8::u32x4*)(base + (size_t)t * W) = w; }
        }
    }
};
struct EpiResF32 {
    static constexpr bool PERM = false, AFTER_DRAIN = false;
    const float* base; float* out;
    __device__ __forceinline__ void operator()(const pg8::f32x4 (&acc)[2][2][4][2], const pg8::Unit& u, int wr, int wc, int fr, int fq) const {
        { int t_ = threadIdx.x; asm volatile("" : "+v"(t_)); fr = t_ & 15; fq = (t_ >> 4) & 3; }
#pragma unroll
        for (int ai = 0; ai < 2; ++ai)
#pragma unroll
            for (int m = 0; m < 4; ++m) { const size_t off = (size_t)(u.pm * 256 + ai * 128 + wr * 64 + m * 16 + fr) * D_ + u.pn * 256 + wc * 32 + 4 * fq;
#pragma unroll
                for (int bj = 0; bj < 2; ++bj)
#pragma unroll
                    for (int n = 0; n < 2; ++n) { const pg8::f32x4 bs = *(const pg8::f32x4*)(base + off + bj * 128 + n * 16); *(pg8::f32x4*)(out + off + bj * 128 + n * 16) = bs + acc[ai][bj][m][n]; } }
    }
};

struct OneUnitOrder { pg8::Unit u; bool has;
    __device__ __forceinline__ bool next(int i, pg8::Unit& o) const { if (i != 0 || !has) return false; o = u; return true; }
    __device__ __forceinline__ void a_ready(const pg8::Unit&) const {}
    __device__ __forceinline__ void done(const pg8::Unit&) const {} };
__device__ __forceinline__ float gelu_tanh_fast(float x) { const float u2 = 1.5957691216057308f * (x + 0.044715f * x * x * x); return x * __builtin_amdgcn_rcpf(1.f + __builtin_amdgcn_exp2f(-u2 * LOG2E)); }
struct EpiCmpH {
    static constexpr bool PERM = true, AFTER_DRAIN = false;
    bf16* hc; const float* bias1;
    __device__ __forceinline__ void operator()(const pg8::f32x4 (&acc)[2][2][4][2], const pg8::Unit& u, int wr, int wc, int fr, int fq) const {
        { int t_ = threadIdx.x; asm volatile("" : "+v"(t_)); fr = t_ & 15; fq = (t_ >> 4) & 3; }
        const int kv = u.pn;
#pragma unroll
        for (int bj = 0; bj < 2; ++bj) { const int col = bj * 128 + wc * 32 + 8 * fq;
            const pg8::f32x4 b0 = *(const pg8::f32x4*)(bias1 + kv * 256 + col), b1 = *(const pg8::f32x4*)(bias1 + kv * 256 + col + 4);
#pragma unroll
            for (int ai = 0; ai < 2; ++ai)
#pragma unroll
                for (int m = 0; m < 4; ++m) { const int row = u.pm * 256 + ai * 128 + wr * 64 + m * 16 + fr;
                    const pg8::f32x4 v0 = acc[ai][bj][m][0] + b0, v1 = acc[ai][bj][m][1] + b1;
                    pg8::u32x4 w; w.x = pg8::cvt_pk_bf16(gelu_tanh_fast(v0[0]), gelu_tanh_fast(v0[1])); w.y = pg8::cvt_pk_bf16(gelu_tanh_fast(v0[2]), gelu_tanh_fast(v0[3]));
                    w.z = pg8::cvt_pk_bf16(gelu_tanh_fast(v1[0]), gelu_tanh_fast(v1[1])); w.w = pg8::cvt_pk_bf16(gelu_tanh_fast(v1[2]), gelu_tanh_fast(v1[3]));
                    *(pg8::u32x4*)(hc + ((size_t)kv * 4096 + row) * 256 + col) = w; } }
    }
};
struct EpiCmpOut {
    static constexpr bool PERM = true, AFTER_DRAIN = false;
    bf16* kvcmp;
    __device__ __forceinline__ void operator()(const pg8::f32x4 (&acc)[2][2][4][2], const pg8::Unit& u, int wr, int wc, int fr, int fq) const {
        { int t_ = threadIdx.x; asm volatile("" : "+v"(t_)); fr = t_ & 15; fq = (t_ >> 4) & 3; }
        if (wc >= 2) return;
        const int kv = u.pn, col = wc * 32 + 8 * fq;
#pragma unroll
        for (int ai = 0; ai < 2; ++ai)
#pragma unroll
            for (int m = 0; m < 4; ++m) { const int row = u.pm * 256 + ai * 128 + wr * 64 + m * 16 + fr; const float z = ((row & 255) == 255) ? 0.f : 1.f;
                const pg8::f32x4 v0 = acc[ai][0][m][0], v1 = acc[ai][0][m][1];
                pg8::u32x4 w; w.x = pg8::cvt_pk_bf16(z != 0.f ? v0[0] : 0.f, z != 0.f ? v0[1] : 0.f); w.y = pg8::cvt_pk_bf16(z != 0.f ? v0[2] : 0.f, z != 0.f ? v0[3] : 0.f);
                w.z = pg8::cvt_pk_bf16(z != 0.f ? v1[0] : 0.f, z != 0.f ? v1[1] : 0.f); w.w = pg8::cvt_pk_bf16(z != 0.f ? v1[2] : 0.f, z != 0.f ? v1[3] : 0.f);
                *(pg8::u32x4*)(kvcmp + ((size_t)kv * 4096 + row) * 64 + col) = w; }
    }
};

__device__ __forceinline__ void moe_build_tables(const unsigned* cnt, int tid) {
    LAS int* T = (LAS int*)((LAS unsigned char*)lds_raw + TBL_OFF);
    __syncthreads();
    if (tid < 112) T[128 + 256 + tid] = (int)((cnt[tid] + 255u) >> 8);
    __syncthreads();
    if (tid == 0) { int o = 0; for (int c = 0; c < 112; ++c) { T[c] = o; const int n = T[128 + 256 + c]; for (int k = 0; k < n; ++k) T[128 + o + k] = c; o += n; } T[112] = o; }
    __syncthreads();
}
__device__ __forceinline__ void moe_pair(int cls, int& ea, int& eb) { const int grp = cls / 28; int idx = cls % 28, lo = 0; while (idx >= 7 - lo) { idx -= 7 - lo; ++lo; } ea = grp * 8 + lo; eb = grp * 8 + lo + 1 + idx; }
struct MoeOrder1 {
    const char* xs; const char* wgu; int G, c;
    __device__ __forceinline__ bool next(int i, pg8::Unit& u) const {
        const LAS int* T = (const LAS int*)((LAS unsigned char*)lds_raw + TBL_OFF);
        const int idx = i * G + c; if (idx >= 4 * T[112]) return false;
        const int tile = idx >> 2, pn = idx & 3; int ea, eb; moe_pair(T[128 + tile], ea, eb); const int e = (pn >> 1) ? eb : ea;
        u.pm = tile; u.pn = pn; u.a = xs + (size_t)tile * 256 * 2048; u.b = wgu + ((size_t)e * 512 + (pn & 1) * 256) * 2048; u.b2 = u.b; return true; }
    __device__ __forceinline__ void a_ready(const pg8::Unit&) const {}
    __device__ __forceinline__ void done(const pg8::Unit&) const {} };
struct MoeOrder2 {
    const char* hb; const char* wd; int G, c;
    __device__ __forceinline__ bool next(int i, pg8::Unit& u) const {
        const LAS int* T = (const LAS int*)((LAS unsigned char*)lds_raw + TBL_OFF);
        const int idx = i * G + c; if (idx >= 4 * T[112]) return false;
        const int tile = idx >> 2, pn = idx & 3; int ea, eb; moe_pair(T[128 + tile], ea, eb);
        u.pm = tile; u.pn = pn; u.a = hb + (size_t)tile * 256 * 1024; u.b = wd + ((size_t)ea * 1024 + pn * 256) * 512; u.b2 = wd + ((size_t)eb * 1024 + pn * 256) * 512; return true; }
    __device__ __forceinline__ void a_ready(const pg8::Unit&) const {}
    __device__ __forceinline__ void done(const pg8::Unit&) const {} };
struct EpiMoeH {
    static constexpr bool PERM = true, AFTER_DRAIN = false;
    bf16* hb; const float* roww;
    __device__ __forceinline__ void operator()(const pg8::f32x4 (&acc)[2][2][4][2], const pg8::Unit& u, int wr, int wc, int fr, int fq) const {
        { int t_ = threadIdx.x; asm volatile("" : "+v"(t_)); fr = t_ & 15; fq = (t_ >> 4) & 3; }
        const int slot = u.pn >> 1;
#pragma unroll
        for (int ai = 0; ai < 2; ++ai)
#pragma unroll
            for (int m = 0; m < 4; ++m) { const size_t row = (size_t)u.pm * 256 + ai * 128 + wr * 64 + m * 16 + fr; const float w = roww[row * 2 + slot];
#pragma unroll
                for (int bj = 0; bj < 2; ++bj) { const int j0 = (u.pn & 1) * 128 + (bj * 128 + wc * 32 + 8 * fq) / 2;
                    const pg8::f32x4 v0 = acc[ai][bj][m][0], v1 = acc[ai][bj][m][1];
                    const float h0 = v0[0] * __builtin_amdgcn_rcpf(1.f + __builtin_amdgcn_exp2f(-v0[0] * LOG2E)) * v0[1] * w, h1 = v0[2] * __builtin_amdgcn_rcpf(1.f + __builtin_amdgcn_exp2f(-v0[2] * LOG2E)) * v0[3] * w;
                    const float h2 = v1[0] * __builtin_amdgcn_rcpf(1.f + __builtin_amdgcn_exp2f(-v1[0] * LOG2E)) * v1[1] * w, h3 = v1[2] * __builtin_amdgcn_rcpf(1.f + __builtin_amdgcn_exp2f(-v1[2] * LOG2E)) * v1[3] * w;
                    *(u64*)(hb + row * 512 + slot * 256 + j0) = (u64)pg8::cvt_pk_bf16(h0, h1) | ((u64)pg8::cvt_pk_bf16(h2, h3) << 32); } }
    }
};
struct EpiMoeOut {
    static constexpr bool PERM = false, AFTER_DRAIN = false;
    float* x; const int* rowtok;
    __device__ __forceinline__ void operator()(const pg8::f32x4 (&acc)[2][2][4][2], const pg8::Unit& u, int wr, int wc, int fr, int fq) const {
        { int t_ = threadIdx.x; asm volatile("" : "+v"(t_)); fr = t_ & 15; fq = (t_ >> 4) & 3; }
        float* xx = x; const int* rt = rowtok; asm volatile("" : "+s"(xx), "+s"(rt));
#pragma unroll
        for (int ai = 0; ai < 2; ++ai)
#pragma unroll
            for (int m = 0; m < 4; ++m) { const int tok = rt[(size_t)u.pm * 256 + ai * 128 + wr * 64 + m * 16 + fr];
                if (tok >= 0) { float* xr = xx + (size_t)tok * D_ + u.pn * 256 + wc * 32 + 4 * fq;
#pragma unroll
                    for (int bj = 0; bj < 2; ++bj)
#pragma unroll
                        for (int n = 0; n < 2; ++n) { pg8::f32x4* q = (pg8::f32x4*)(xr + bj * 128 + n * 16); *q = *q + acc[ai][bj][m][n]; } } }
    }
};

__device__ __forceinline__ void transpose_item(const float* W, int ldw, bf16* WT, int ldt, int r0, int rmul, int k0, LAS float* scr, int lane) {
#pragma unroll 8
    for (int i = 0; i < 32; ++i) { const int kk = 2 * i + (lane >> 5); scr[kk * 33 + (lane & 31)] = W[(size_t)(k0 + kk) * ldw + (lane & 31)]; }
    asm volatile("s_waitcnt lgkmcnt(0)" ::: "memory");
    const int c = lane & 7;
#pragma unroll
    for (int j = 0; j < 4; ++j) { const int n = (lane >> 3) + 8 * j; const LAS float* sp = scr + (8 * c) * 33 + n;
        u32x4 o; o.x = pk2(sp[0 * 33], sp[1 * 33]); o.y = pk2(sp[2 * 33], sp[3 * 33]); o.z = pk2(sp[4 * 33], sp[5 * 33]); o.w = pk2(sp[6 * 33], sp[7 * 33]);
        *(u32x4*)(WT + (size_t)(r0 + rmul * n) * ldt + k0 + 8 * c) = o; }
    asm volatile("s_waitcnt lgkmcnt(0)" ::: "memory");
}
__device__ __forceinline__ void transpose_seg(const float* W, int ldw, int K, int sc0, int ncol, bf16* WT, int r0, int rmul, int item, LAS float* scr, int lane) {
    const int nb = ncol / 32, kb = item / nb, cb = item % nb;
    transpose_item(W + sc0 + cb * 32, ldw, WT, K, r0 + rmul * cb * 32, rmul, kb * 64, scr, lane);
}

typedef float f32x16 __attribute__((ext_vector_type(16)));
typedef short bf16x8v __attribute__((ext_vector_type(8)));
typedef short s16x4 __attribute__((ext_vector_type(4)));
typedef float f32x2_t __attribute__((ext_vector_type(2)));
typedef __bf16 bf16x2_t __attribute__((ext_vector_type(2)));
constexpr int A_KBUF = 10240, A_VBUF = 9216;
constexpr int A_KOFF = 0, A_VOFF = 2 * A_KBUF, A_BOFF = A_VOFF + 2 * A_VBUF, A_LDS_END = A_BOFF + 2 * 256;
__device__ __forceinline__ constexpr int crow0(int reg) { return (reg & 3) + 8 * (reg >> 2); }
__device__ __forceinline__ float swap_max(float m) { auto rr = __builtin_amdgcn_permlane32_swap(__float_as_uint(m), __float_as_uint(m), false, false); return fmaxf(__uint_as_float(rr[0]), __uint_as_float(rr[1])); }
__device__ __forceinline__ float swap_sum(float m) { auto rr = __builtin_amdgcn_permlane32_swap(__float_as_uint(m), __float_as_uint(m), false, false); return __uint_as_float(rr[0]) + __uint_as_float(rr[1]); }
__device__ __forceinline__ unsigned cvtpk(float lo, float hi) { f32x2_t v = {lo, hi}; bf16x2_t b = __builtin_convertvector(v, bf16x2_t); return __builtin_bit_cast(unsigned, b); }
__device__ __forceinline__ bf16x8v pack8(const f32x16& p, int b0) { u32x4 w; w.x = cvtpk(p[b0 + 0], p[b0 + 1]); w.y = cvtpk(p[b0 + 2], p[b0 + 3]); w.z = cvtpk(p[b0 + 4], p[b0 + 5]); w.w = cvtpk(p[b0 + 6], p[b0 + 7]); return __builtin_bit_cast(bf16x8v, w); }
__device__ __forceinline__ s16x4 tr_read(const LAS unsigned char* p) { typedef short v4i16_t __attribute__((ext_vector_type(4))); return __builtin_bit_cast(s16x4, __builtin_amdgcn_ds_read_tr16_b64_v4i16((LAS v4i16_t*)p)); }

template <int DQK, int NMAP, bool FOX, bool SLC>
__device__ __forceinline__ void attn_core(LAS unsigned char* L, const bf16* Kb0, const bf16* Kb1, const bf16* Vb, const float* cum, float cum_ref,
                                          const bf16x8v (&Qf)[NMAP][DQK / 16], u64 tilemask, int t_lane, int tw0, int win, float slope2, unsigned selw0, unsigned selw1,
                                          f32x16 (&O)[NMAP][2], float (&M)[NMAP], float (&Ls)[NMAP], int tid) {
    constexpr int KP = DQK * 2 + 16;
    const int lane = tid & 63, r = lane & 31, h = lane >> 5;
    int kdst; const bf16* ksrc;
    if (DQK == 64) { kdst = (tid >> 3) * KP + (tid & 7) * 16; ksrc = Kb0 + (tid >> 3) * 64 + (tid & 7) * 8; }
    else { const int mp = tid >> 8, tt = tid & 255; kdst = mp * 5120 + (tt >> 2) * KP + (tt & 3) * 16; ksrc = (mp ? Kb1 : Kb0) + (tt >> 2) * 32 + (tt & 3) * 8; }
    const int vdst = (tid >> 3) * 144 + (tid & 7) * 16; const bf16* vsrc = Vb + (tid >> 3) * 64 + (tid & 7) * 8;
    const LAS unsigned char* kfrag = L + A_KOFF + r * KP + h * 16;
    const LAS unsigned char* vfrag = L + A_VOFF + (4 * h + ((lane & 15) >> 2)) * 144 + (16 * ((lane >> 4) & 1) + 4 * (lane & 3)) * 2;
    u32x4 kreg, vreg; float breg = 0.f;
    u64 mk = tilemask;
    int j = 63 - __builtin_clzll(mk); mk &= ~(1ull << j);
    { const int kv0 = j * 64; kreg = *(const u32x4*)(ksrc + (size_t)kv0 * DQK); vreg = *(const u32x4*)(vsrc + (size_t)kv0 * 64); if (FOX && tid < 64) breg = (cum_ref - cum[kv0 + tid]) * LOG2E; }
    *(LAS u32x4*)(L + A_KOFF + kdst) = kreg; *(LAS u32x4*)(L + A_VOFF + vdst) = vreg; if (FOX && tid < 64) *(LAS float*)(L + A_BOFF + tid * 4) = breg;
    __syncthreads();
    int buf = 0;
    for (;;) {
        const bool more = mk != 0ull; int jn = 0;
        if (more) { jn = 63 - __builtin_clzll(mk); mk &= ~(1ull << jn); const int kv0 = jn * 64;
            kreg = *(const u32x4*)(ksrc + (size_t)kv0 * DQK); vreg = *(const u32x4*)(vsrc + (size_t)kv0 * 64); if (FOX && tid < 64) breg = (cum_ref - cum[kv0 + tid]) * LOG2E; }
        { const int kv0 = j * 64;
          if (!(kv0 > tw0 + 31) && !(tw0 - (kv0 + 63) >= win)) {
            const bool need_mask = (kv0 + 63 > tw0) || (tw0 + 31 - kv0 >= win);
            const int dl = t_lane - kv0 - 4 * h;
            bool sel = true; if (SLC) sel = (j < 32 ? (selw0 >> j) : (selw1 >> (j - 32))) & 1u;
            bf16x8v pa[NMAP][4];
#pragma unroll
            for (int mp = 0; mp < NMAP; ++mp) {
                f32x16 p0, p1;
                if (FOX) { const LAS f32x4* bl = (const LAS f32x4*)(L + A_BOFF + buf * 256) + h;
#pragma unroll
                    for (int g4 = 0; g4 < 4; ++g4) { const f32x4 b0 = bl[2 * g4], b1 = bl[8 + 2 * g4];
                        p0[4 * g4 + 0] = b0.x; p0[4 * g4 + 1] = b0.y; p0[4 * g4 + 2] = b0.z; p0[4 * g4 + 3] = b0.w; p1[4 * g4 + 0] = b1.x; p1[4 * g4 + 1] = b1.y; p1[4 * g4 + 2] = b1.z; p1[4 * g4 + 3] = b1.w; } }
                else { const float base_l = slope2 * (float)(kv0 + 4 * h - tw0), s8 = slope2 * 8.f, s32 = slope2 * 32.f;
                    p0[0] = base_l; p0[1] = p0[0] + slope2; p0[2] = p0[1] + slope2; p0[3] = p0[2] + slope2;
#pragma unroll
                    for (int reg = 4; reg < 16; ++reg) p0[reg] = p0[reg - 4] + s8;
#pragma unroll
                    for (int reg = 0; reg < 16; ++reg) p1[reg] = p0[reg] + s32; }
                const LAS unsigned char* kb = kfrag + buf * A_KBUF + (DQK == 32 ? mp * 5120 : 0);
#pragma unroll
                for (int s = 0; s < DQK / 16; ++s) { const bf16x8v kf0 = *(const LAS bf16x8v*)(kb + s * 32), kf1 = *(const LAS bf16x8v*)(kb + 32 * KP + s * 32);
                    p0 = __builtin_amdgcn_mfma_f32_32x32x16_bf16(kf0, Qf[mp][s], p0, 0, 0, 0); p1 = __builtin_amdgcn_mfma_f32_32x32x16_bf16(kf1, Qf[mp][s], p1, 0, 0, 0); }
                if (need_mask) {
#pragma unroll
                    for (int reg = 0; reg < 16; ++reg) { const int d0 = dl - crow0(reg), d1 = d0 - 32;
                        p0[reg] = (d0 >= 0 && d0 < win) ? p0[reg] : -INFINITY; p1[reg] = (d1 >= 0 && d1 < win) ? p1[reg] : -INFINITY; } }
                float mt = fmaxf(p0[0], p1[0]);
#pragma unroll
                for (int reg = 1; reg < 16; ++reg) mt = fmaxf(mt, fmaxf(p0[reg], p1[reg]));
                mt = swap_max(mt); if (SLC && !sel) mt = -INFINITY;
                if (__any(mt > M[mp] + 8.f)) { const float mn = fmaxf(M[mp], mt), alpha = __builtin_amdgcn_exp2f(M[mp] - mn); O[mp][0] *= alpha; O[mp][1] *= alpha; Ls[mp] *= alpha; M[mp] = mn; }
                const float ms = (SLC && !sel) ? INFINITY : M[mp];
                float rs = 0.f;
#pragma unroll
                for (int reg = 0; reg < 16; ++reg) { p0[reg] = __builtin_amdgcn_exp2f(p0[reg] - ms); p1[reg] = __builtin_amdgcn_exp2f(p1[reg] - ms); rs += p0[reg] + p1[reg]; }
                Ls[mp] += rs;
                pa[mp][0] = pack8(p0, 0); pa[mp][1] = pack8(p0, 8); pa[mp][2] = pack8(p1, 0); pa[mp][3] = pack8(p1, 8);
            }
            const LAS unsigned char* vb = vfrag + buf * A_VBUF;
#pragma unroll
            for (int db = 0; db < 2; ++db)
#pragma unroll
                for (int ks = 0; ks < 4; ++ks) { const s16x4 lo = tr_read(vb + ks * (16 * 144) + db * 64), hi = tr_read(vb + ks * (16 * 144) + db * 64 + 8 * 144);
                    const bf16x8v vf = {lo[0], lo[1], lo[2], lo[3], hi[0], hi[1], hi[2], hi[3]};
#pragma unroll
                    for (int mp = 0; mp < NMAP; ++mp) O[mp][db] = __builtin_amdgcn_mfma_f32_32x32x16_bf16(vf, pa[mp][ks], O[mp][db], 0, 0, 0); }
          } }
        if (more) { *(LAS u32x4*)(L + A_KOFF + (buf ^ 1) * A_KBUF + kdst) = kreg; *(LAS u32x4*)(L + A_VOFF + (buf ^ 1) * A_VBUF + vdst) = vreg; if (FOX && tid < 64) *(LAS float*)(L + A_BOFF + (buf ^ 1) * 256 + tid * 4) = breg; }
        __syncthreads();
        if (!more) break;
        j = jn; buf ^= 1;
    }
}
#define ATTN_FOR_CHUNKS(db, g4) _Pragma("unroll") for (int db = 0; db < 2; ++db) _Pragma("unroll") for (int g4 = 0; g4 < 4; ++g4)

__device__ __forceinline__ void ph_norm_bf16(const Ctx& c, const float* x, const float* g, bf16* out) {
    for (int row = c.gw; row < NT; row += c.ngw) {
        const f32x4* xr = (const f32x4*)(x + (size_t)row * D_) + c.lane;
        f32x4 v[4]; float ss = 0.f;
#pragma unroll
        for (int j = 0; j < 4; ++j) { v[j] = xr[64 * j]; ss += v[j].x * v[j].x + v[j].y * v[j].y + v[j].z * v[j].z + v[j].w * v[j].w; }
        const float r = rsqrtf(wave_sum(ss) * (1.f / D_) + EPS);
        u64* o8 = (u64*)(out + (size_t)row * D_) + c.lane;
#pragma unroll
        for (int j = 0; j < 4; ++j) { const f32x4 gg = ((const f32x4*)g)[c.lane + 64 * j];
            o8[64 * j] = (u64)pk2(v[j].x * r * gg.x, v[j].y * r * gg.y) | ((u64)pk2(v[j].z * r * gg.z, v[j].w * r * gg.w) << 32); }
    }
}
__device__ __forceinline__ void ph_norm_final(const Ctx& c, float* x, const float* g) {
    for (int row = c.gw; row < NT; row += c.ngw) {
        f32x4* xr = (f32x4*)(x + (size_t)row * D_) + c.lane;
        f32x4 v[4]; float ss = 0.f;
#pragma unroll
        for (int j = 0; j < 4; ++j) { v[j] = xr[64 * j]; ss += v[j].x * v[j].x + v[j].y * v[j].y + v[j].z * v[j].z + v[j].w * v[j].w; }
        const float r = rsqrtf(wave_sum(ss) * (1.f / D_) + EPS);
#pragma unroll
        for (int j = 0; j < 4; ++j) { const f32x4 gg = ((const f32x4*)g)[c.lane + 64 * j]; xr[64 * j] = v[j] * r * gg; }
    }
}

template <class AF, class EF>
__device__ __forceinline__ void naive_gemm(const Ctx& c, int M, int N, int K, AF af, const float* W, int ldb, EF ef) {
    LAS float* As = (LAS float*)c.lds;
    LAS float* Bs = As + 16 * 132;
    const int tm = (M + 127) / 128, tn = (N + 127) / 128, ntile = tm * tn;
    const int ty = c.tid >> 4, tx = c.tid & 15;
    for (int tile = c.bid; tile < ntile; tile += c.G) {
        const int m0 = (tile / tn) * 128, n0 = (tile % tn) * 128;
        float acc[4][8];
#pragma unroll
        for (int i = 0; i < 4; ++i)
#pragma unroll
            for (int j = 0; j < 8; ++j) acc[i][j] = 0.f;
        for (int k0 = 0; k0 < K; k0 += 16) {
            __syncthreads();
#pragma unroll
            for (int i = 0; i < 4; ++i) { const int e = c.tid + i * 512, r = e >> 4, kk = e & 15; const int row = m0 + r;
                As[kk * 132 + r] = (row < M) ? af(row, k0 + kk) : 0.f; }
#pragma unroll
            for (int i = 0; i < 4; ++i) { const int e = c.tid + i * 512, kk = e >> 7, cc = e & 127; const int col = n0 + cc;
                Bs[kk * 132 + cc] = (col < N) ? W[(size_t)(k0 + kk) * ldb + col] : 0.f; }
            __syncthreads();
#pragma unroll 2
            for (int kk = 0; kk < 16; ++kk) {
                float a[4], b[8];
#pragma unroll
                for (int i = 0; i < 4; ++i) a[i] = As[kk * 132 + ty * 4 + i];
#pragma unroll
                for (int j = 0; j < 8; ++j) b[j] = Bs[kk * 132 + tx * 8 + j];
#pragma unroll
                for (int i = 0; i < 4; ++i)
#pragma unroll
                    for (int j = 0; j < 8; ++j) acc[i][j] = fmaf(a[i], b[j], acc[i][j]);
            }
        }
        LAS float* Cs = Bs + 16 * 132;
        __syncthreads();
#pragma unroll
        for (int i = 0; i < 4; ++i)
#pragma unroll
            for (int j = 0; j < 8; ++j) Cs[(ty * 4 + i) * 129 + tx * 8 + j] = acc[i][j];
        __syncthreads();
#pragma unroll 1
        for (int e = c.tid; e < 128 * 128; e += NTHREADS) { const int r = e >> 7, cc = e & 127, row = m0 + r, col = n0 + cc; if (row < M && col < N) ef(row, col, Cs[r * 129 + cc]); }
    }
    __syncthreads();
}

struct InProjOut { bf16* qn; bf16* kv6; bf16* fqkv; bf16* dqk; bf16* dv; float* gate; float* fl; const float* b_gate; const float* b_fgt; };
__device__ __forceinline__ void inproj_store(const InProjOut& o, int n, int col, float v) {
    const int b = n / T_, t = n % T_;
    if (col < C_KV6) { const int h = col >> 6, d = col & 63; o.qn[((size_t)(b * 8 + h) * T_ + t) * 64 + d] = (bf16)f2bf(v * (0.125f * LOG2E)); }
    else if (col < C_GATE) { const int cc = col - C_KV6, idx = cc >> 7, g = (cc >> 6) & 1, d = cc & 63;
        ((bf16*)((unsigned char*)o.kv6 + idx * KV6_STRIDE))[((size_t)(b * 2 + g) * T_ + t) * 64 + d] = (bf16)f2bf(v); }
    else if (col < C_FQ) { const int j = col - C_GATE; o.gate[(size_t)n * 24 + j] = sigmoidf_(v + o.b_gate[j]); }
    else if (col < C_FF) { const int cc = col - C_FQ, idx = cc >> 8, h = (cc >> 6) & 3, d = cc & 63;
        o.fqkv[(size_t)idx * (8 * MiB) + ((size_t)(b * 4 + h) * T_ + t) * 64 + d] = (bf16)f2bf(idx == 0 ? v * (0.125f * LOG2E) : v); }
    else if (col < C_DQ) { const int h = col - C_FF; o.fl[(size_t)(b * 4 + h) * T_ + t] = log_sigmoidf_(v + o.b_fgt[h]); }
    else if (col < C_DV) { const int cc = col - C_DQ, idx = cc >> 8, h = (cc >> 6) & 3, i = (cc >> 5) & 1, d = cc & 31;
        o.dqk[(size_t)idx * (8 * MiB) + ((size_t)((b * 4 + h) * 2 + i) * T_ + t) * 32 + d] = (bf16)f2bf(idx == 0 ? v * (0.17677669529663687f * LOG2E) : v); }
    else { const int cc = col - C_DV, h = cc >> 6, d = cc & 63; o.dv[((size_t)(b * 4 + h) * T_ + t) * 64 + d] = (bf16)f2bf(v); }
}

__device__ __forceinline__ void ph_cumsum(const Ctx& c, float* fl) {
    for (int s = c.gw; s < B_ * 4; s += c.ngw) {
        float* p = fl + (size_t)s * T_; float carry = 0.f;
        for (int t0 = 0; t0 < T_; t0 += 64) {
            float v = p[t0 + c.lane];
#pragma unroll
            for (int o = 1; o < 64; o <<= 1) { const float u = __shfl_up(v, o); if (c.lane >= o) v += u; }
            v += carry; p[t0 + c.lane] = v; carry = __shfl(v, 63);
        }
    }
}

template <int DQK>
__device__ __forceinline__ float naive_attn_row(const bf16* q, const bf16* K, const bf16* V, int t, u64 mask, float slope2, const float* cum, int win, int lane) {
    float qv[DQK];
    { const u32x4* q4 = (const u32x4*)q;
#pragma unroll
      for (int i = 0; i < DQK / 8; ++i) { const u32x4 w = q4[i];
          qv[8 * i + 0] = __uint_as_float(w.x << 16); qv[8 * i + 1] = __uint_as_float(w.x & 0xffff0000u);
          qv[8 * i + 2] = __uint_as_float(w.y << 16); qv[8 * i + 3] = __uint_as_float(w.y & 0xffff0000u);
          qv[8 * i + 4] = __uint_as_float(w.z << 16); qv[8 * i + 5] = __uint_as_float(w.z & 0xffff0000u);
          qv[8 * i + 6] = __uint_as_float(w.w << 16); qv[8 * i + 7] = __uint_as_float(w.w & 0xffff0000u); } }
    const float cumt = cum ? cum[t] : 0.f;
    float m = -INFINITY, l = 0.f, o = 0.f;
    while (mask) {
        const int j = __builtin_ctzll(mask); mask &= mask - 1;
        const int kpos = 64 * j + lane; const int dist = t - kpos;
        const bool valid = dist >= 0 && dist < win;
        float s = 0.f;
        { const u32x4* k4 = (const u32x4*)(K + (size_t)kpos * DQK);
#pragma unroll
          for (int i = 0; i < DQK / 8; ++i) { const u32x4 w = k4[i];
              s = fmaf(qv[8 * i + 0], __uint_as_float(w.x << 16), s); s = fmaf(qv[8 * i + 1], __uint_as_float(w.x & 0xffff0000u), s);
              s = fmaf(qv[8 * i + 2], __uint_as_float(w.y << 16), s); s = fmaf(qv[8 * i + 3], __uint_as_float(w.y & 0xffff0000u), s);
              s = fmaf(qv[8 * i + 4], __uint_as_float(w.z << 16), s); s = fmaf(qv[8 * i + 5], __uint_as_float(w.z & 0xffff0000u), s);
              s = fmaf(qv[8 * i + 6], __uint_as_float(w.w << 16), s); s = fmaf(qv[8 * i + 7], __uint_as_float(w.w & 0xffff0000u), s); } }
        s -= slope2 * (float)dist;
        if (cum) s += (cumt - cum[kpos]) * LOG2E;
        s = valid ? s : -INFINITY;
        const float mb = wave_max(s);
        if (mb == -INFINITY) continue;
        const float mn = fmaxf(m, mb), alpha = exp2f(m - mn);
        const float p = valid ? exp2f(s - mn) : 0.f;
        l = l * alpha + wave_sum(p); o *= alpha; m = mn;
        const bf16* vb = V + (size_t)(64 * j) * 64 + lane;
#pragma unroll 8
        for (int k = 0; k < 64; ++k) o = fmaf(__shfl(p, k), bf2f(vb[(size_t)k * 64]), o);
    }
    return l > 0.f ? o / l : 0.f;
}

__device__ __forceinline__ void ph_cmp_attn(const Ctx& c, const bf16* qn, const bf16* kcmp, const bf16* vcmp, const float* gate, u64* sel, bf16* ocmp) {
    LAS float* pl = (LAS float*)(c.lds) + c.wave * 256;
    const int lane = c.lane;
    for (int it = c.gw; it < B_ * 2 * T_; it += c.ngw) {
        const int t = it % T_, bg = it / T_, b = bg >> 1, g = bg & 1;
        const int nvis = (t >= 31) ? ((t - 31) >> 4) + 1 : 0;
        const bf16* kc = kcmp + (size_t)bg * 256 * 64; const bf16* vc = vcmp + (size_t)bg * 256 * 64;
        float imp = 0.f;
        for (int hg = 0; hg < 4; ++hg) {
            const int h = g * 4 + hg; const float slope2 = alibi_slope(h + 1, 8) * LOG2E;
            const bf16* q = qn + ((size_t)(b * 8 + h) * T_ + t) * 64;
            float qv[64];
            { const u32x4* q4 = (const u32x4*)q;
#pragma unroll
              for (int i = 0; i < 8; ++i) { const u32x4 w = q4[i];
                  qv[8 * i + 0] = __uint_as_float(w.x << 16); qv[8 * i + 1] = __uint_as_float(w.x & 0xffff0000u);
                  qv[8 * i + 2] = __uint_as_float(w.y << 16); qv[8 * i + 3] = __uint_as_float(w.y & 0xffff0000u);
                  qv[8 * i + 4] = __uint_as_float(w.z << 16); qv[8 * i + 5] = __uint_as_float(w.z & 0xffff0000u);
                  qv[8 * i + 6] = __uint_as_float(w.w << 16); qv[8 * i + 7] = __uint_as_float(w.w & 0xffff0000u); } }
            float s[4]; float m = -INFINITY;
#pragma unroll
            for (int i = 0; i < 4; ++i) { const int cc = lane + 64 * i; float a = 0.f;
                if (cc < nvis) { const u32x4* k4 = (const u32x4*)(kc + (size_t)cc * 64);
#pragma unroll
                    for (int e = 0; e < 8; ++e) { const u32x4 w = k4[e];
                        a = fmaf(qv[8 * e + 0], __uint_as_float(w.x << 16), a); a = fmaf(qv[8 * e + 1], __uint_as_float(w.x & 0xffff0000u), a);
                        a = fmaf(qv[8 * e + 2], __uint_as_float(w.y << 16), a); a = fmaf(qv[8 * e + 3], __uint_as_float(w.y & 0xffff0000u), a);
                        a = fmaf(qv[8 * e + 4], __uint_as_float(w.z << 16), a); a = fmaf(qv[8 * e + 5], __uint_as_float(w.z & 0xffff0000u), a);
                        a = fmaf(qv[8 * e + 6], __uint_as_float(w.w << 16), a); a = fmaf(qv[8 * e + 7], __uint_as_float(w.w & 0xffff0000u), a); }
                    a -= slope2 * (float)(t - (16 * cc + 31)); } else a = -INFINITY;
                s[i] = a; m = fmaxf(m, a); }
            m = wave_max(m);
            float p[4], lsum = 0.f;
#pragma unroll
            for (int i = 0; i < 4; ++i) { p[i] = (lane + 64 * i < nvis) ? exp2f(s[i] - m) : 0.f; lsum += p[i]; }
            lsum = wave_sum(lsum);
            const float inv = lsum > 0.f ? 1.f / lsum : 0.f;
#pragma unroll
            for (int i = 0; i < 4; ++i) { p[i] *= inv; pl[lane + 64 * i] = p[i]; }
            asm volatile("s_waitcnt lgkmcnt(0)" ::: "memory");
            float o = 0.f;
            for (int cc = 0; cc < nvis; ++cc) o = fmaf(pl[cc], bf2f(vc[(size_t)cc * 64 + lane]), o);
            const float gt = gate[((size_t)(b * T_ + t)) * 24 + h * 3 + 0];
            ocmp[(size_t)(b * T_ + t) * 512 + h * 64 + lane] = (bf16)f2bf(gt * o);
            { const int j = lane; float a = pl[4 * j] + pl[4 * j + 1] + pl[4 * j + 2] + 0.5f * pl[4 * j + 3]; if (j > 0) a += 0.5f * pl[4 * j - 1]; imp += a; }
            asm volatile("s_waitcnt lgkmcnt(0)" ::: "memory");
        }
        const int cur = t >> 6; const int j = lane;
        u64 m64;
        if (cur <= 15) m64 = (cur == 63) ? ~0ull : ((1ull << (cur + 1)) - 1ull);
        else {
            float val = (j > cur) ? -INFINITY : ((j == 0 || j == cur || j == cur - 1) ? 1e4f : imp);
            m64 = 0ull;
            for (int r = 0; r < 16; ++r) {
                const float mx = wave_max(val);
                const u64 bal = __ballot(val == mx);
                const int w = __builtin_ctzll(bal);
                m64 |= 1ull << w; if (j == w) val = -INFINITY;
            }
        }
        if (lane == 0) sel[(size_t)bg * T_ + t] = m64;
    }
}

__device__ __forceinline__ void ph_win_attn(const Ctx& c, const bf16* qn, const bf16* kw, const bf16* vw, const float* gate, bf16* owin) {
    for (int it = c.gw; it < B_ * 8 * T_; it += c.ngw) {
        const int t = it % T_, bh = it / T_, b = bh >> 3, h = bh & 7, g = h >> 2;
        const int cur = t >> 6, jlo = (t - 511) > 0 ? (t - 511) >> 6 : 0;
        const u64 hi = (cur == 63) ? ~0ull : ((1ull << (cur + 1)) - 1ull); const u64 mask = hi & ~((1ull << jlo) - 1ull);
        const float o = naive_attn_row<64>(qn + ((size_t)bh * T_ + t) * 64, kw + (size_t)(b * 2 + g) * T_ * 64, vw + (size_t)(b * 2 + g) * T_ * 64, t, mask,
                                           alibi_slope(h + 1, 8) * LOG2E, nullptr, 512, c.lane);
        owin[(size_t)(b * T_ + t) * 512 + h * 64 + c.lane] = (bf16)f2bf(gate[(size_t)(b * T_ + t) * 24 + h * 3 + 2] * o);
    }
}
__device__ __forceinline__ void ph_slc_attn(const Ctx& c, const bf16* qn, const bf16* ks, const bf16* vs, const float* gate, const u64* sel, const bf16* ocmp, const bf16* owin, bf16* att) {
    for (int it = c.gw; it < B_ * 8 * T_; it += c.ngw) {
        const int t = it % T_, bh = it / T_, b = bh >> 3, h = bh & 7, g = h >> 2;
        const u64 mask = sel[(size_t)(b * 2 + g) * T_ + t];
        const float o = naive_attn_row<64>(qn + ((size_t)bh * T_ + t) * 64, ks + (size_t)(b * 2 + g) * T_ * 64, vs + (size_t)(b * 2 + g) * T_ * 64, t, mask,
                                           alibi_slope(h + 1, 8) * LOG2E, nullptr, 1 << 30, c.lane);
        const size_t n = (size_t)(b * T_ + t);
        const float r = gate[n * 24 + h * 3 + 1] * o + bf2f(ocmp[n * 512 + h * 64 + c.lane]) + bf2f(owin[n * 512 + h * 64 + c.lane]);
        att[n * 1024 + h * 64 + c.lane] = (bf16)f2bf(r);
    }
}
__device__ __forceinline__ void ph_fox_attn(const Ctx& c, const bf16* fq, const bf16* fk, const bf16* fv, const float* cum, bf16* att) {
    for (int it = c.gw; it < B_ * 4 * T_; it += c.ngw) {
        const int t = it % T_, bh = it / T_, b = bh >> 2, h = bh & 3;
        const int cur = t >> 6; const u64 mask = (cur == 63) ? ~0ull : ((1ull << (cur + 1)) - 1ull);
        const float o = naive_attn_row<64>(fq + ((size_t)bh * T_ + t) * 64, fk + (size_t)bh * T_ * 64, fv + (size_t)bh * T_ * 64, t, mask, 0.f, cum + (size_t)bh * T_, 1 << 30, c.lane);
        att[(size_t)(b * T_ + t) * 1024 + 512 + h * 64 + c.lane] = (bf16)f2bf(o);
    }
}
__device__ __forceinline__ void ph_diff_attn(const Ctx& c, const bf16* dq, const bf16* dk, const bf16* dv, const float* lam, const float* subln, float lambda_init, bf16* att) {
    float l1 = 0.f, l2 = 0.f;
    if (c.lane < 32) { l1 = lam[c.lane] * lam[32 + c.lane]; l2 = lam[64 + c.lane] * lam[96 + c.lane]; }
    const float lam_full = __expf(wave_sum(l1)) - __expf(wave_sum(l2)) + lambda_init;
    const float sg = subln[c.lane] * (1.f - lambda_init);
    for (int it = c.gw; it < B_ * 4 * T_; it += c.ngw) {
        const int t = it % T_, bh = it / T_, b = bh >> 2, h = bh & 3;
        const int cur = t >> 6; const u64 mask = (cur == 63) ? ~0ull : ((1ull << (cur + 1)) - 1ull);
        const float slope2 = alibi_slope(h + 1, 4) * LOG2E;
        const bf16* vb = dv + (size_t)bh * T_ * 64;
        const float o1 = naive_attn_row<32>(dq + ((size_t)(bh * 2 + 0) * T_ + t) * 32, dk + (size_t)(bh * 2 + 0) * T_ * 32, vb, t, mask, slope2, nullptr, 1 << 30, c.lane);
        const float o2 = naive_attn_row<32>(dq + ((size_t)(bh * 2 + 1) * T_ + t) * 32, dk + (size_t)(bh * 2 + 1) * T_ * 32, vb, t, mask, slope2, nullptr, 1 << 30, c.lane);
        const float o = o1 - lam_full * o2;
        const float r = rsqrtf(wave_sum(o * o) * (1.f / 64.f) + EPS);
        att[(size_t)(b * T_ + t) * 1024 + 768 + h * 64 + c.lane] = (bf16)f2bf(o * r * sg);
    }
}

__device__ __forceinline__ void ph_moe_route(const Ctx& c, const float* x, const float* g, const float* wgrp, const float* bgrp, const float* wexp, const float* bexp, bf16* hn, int* route_e, float* route_w, unsigned* cnt) {
    for (int row = c.gw; row < NT; row += c.ngw) {
        const f32x4* xr = (const f32x4*)(x + (size_t)row * D_) + c.lane;
        f32x4 v[4]; float ss = 0.f;
#pragma unroll
        for (int j = 0; j < 4; ++j) { v[j] = xr[64 * j]; ss += v[j].x * v[j].x + v[j].y * v[j].y + v[j].z * v[j].z + v[j].w * v[j].w; }
        const float r = rsqrtf(wave_sum(ss) * (1.f / D_) + EPS);
        u64* o8 = (u64*)(hn + (size_t)row * D_) + c.lane;
#pragma unroll
        for (int j = 0; j < 4; ++j) { const f32x4 gg = ((const f32x4*)g)[c.lane + 64 * j]; v[j] = v[j] * r * gg;
            o8[64 * j] = (u64)pk2(v[j].x, v[j].y) | ((u64)pk2(v[j].z, v[j].w) << 32); }
        float gl[4];
#pragma unroll
        for (int q = 0; q < 4; ++q) { float a = 0.f;
#pragma unroll
            for (int j = 0; j < 4; ++j) { const int k = 4 * (c.lane + 64 * j);
                a = fmaf(v[j].x, wgrp[(size_t)(k + 0) * 4 + q], a); a = fmaf(v[j].y, wgrp[(size_t)(k + 1) * 4 + q], a);
                a = fmaf(v[j].z, wgrp[(size_t)(k + 2) * 4 + q], a); a = fmaf(v[j].w, wgrp[(size_t)(k + 3) * 4 + q], a); }
            gl[q] = wave_sum(a) + bgrp[q]; }
        int grp = 0; float gm = gl[0];
#pragma unroll
        for (int q = 1; q < 4; ++q) if (gl[q] > gm) { gm = gl[q]; grp = q; }
        float gs = 0.f;
#pragma unroll
        for (int q = 0; q < 4; ++q) gs += __expf(gl[q] - gm);
        const float grp_gate = 1.f / gs;
        float el[8];
#pragma unroll
        for (int q = 0; q < 8; ++q) { float a = 0.f; const int col = grp * 8 + q;
#pragma unroll
            for (int j = 0; j < 4; ++j) { const int k = 4 * (c.lane + 64 * j);
                a = fmaf(v[j].x, wexp[(size_t)(k + 0) * 32 + col], a); a = fmaf(v[j].y, wexp[(size_t)(k + 1) * 32 + col], a);
                a = fmaf(v[j].z, wexp[(size_t)(k + 2) * 32 + col], a); a = fmaf(v[j].w, wexp[(size_t)(k + 3) * 32 + col], a); }
            el[q] = wave_sum(a) + bexp[col]; }
        int i0 = 0; float v0 = el[0];
#pragma unroll
        for (int q = 1; q < 8; ++q) if (el[q] > v0) { v0 = el[q]; i0 = q; }
        int i1 = -1; float v1 = -INFINITY;
#pragma unroll
        for (int q = 0; q < 8; ++q) if (q != i0 && el[q] > v1) { v1 = el[q]; i1 = q; }
        const float e1 = __expf(v1 - v0), den = 1.f + e1;
        if (c.lane == 0) { const float w0 = grp_gate / den, w1 = grp_gate * e1 / den;
            const int lo = i0 < i1 ? i0 : i1, hi = i0 < i1 ? i1 : i0, cls = grp * 28 + lo * 8 - (lo * (lo + 1)) / 2 + (hi - lo - 1);
            const unsigned rank = __hip_atomic_fetch_add(cnt + cls, 1u, __ATOMIC_RELAXED, __HIP_MEMORY_SCOPE_AGENT);
            route_e[row] = (int)(((unsigned)cls << 24) | rank); route_w[2 * row] = i0 < i1 ? w0 : w1; route_w[2 * row + 1] = i0 < i1 ? w1 : w0; }
    }
}
__device__ __forceinline__ void ph_moe_naive(const Ctx& c, const bf16* hn, const int* route_e, const float* route_w, const float* wg, const float* wu, const float* wd, float* x) {
    LAS float* hs = (LAS float*)c.lds;
    LAS float* au = hs + 1024;
    LAS float* h2 = au + 512;
    for (int row = c.bid; row < NT; row += c.G) {
        __syncthreads();
        hs[c.tid] = bf2f(hn[(size_t)row * D_ + c.tid]); hs[c.tid + 512] = bf2f(hn[(size_t)row * D_ + c.tid + 512]);
        float o0 = 0.f, o1 = 0.f;
        for (int s = 0; s < 2; ++s) {
            const int e = route_e[2 * row + s]; const float w = route_w[2 * row + s];
            __syncthreads();
            const float* W = (c.tid < 256 ? wg : wu) + (size_t)e * D_ * DEXP + (c.tid & 255);
            float a = 0.f;
            for (int k = 0; k < D_; ++k) a = fmaf(hs[k], W[(size_t)k * DEXP], a);
            au[c.tid] = a;
            __syncthreads();
            if (c.tid < 256) { const float ga = au[c.tid], up = au[c.tid + 256]; h2[c.tid] = ga / (1.f + __expf(-ga)) * up * w; }
            __syncthreads();
            const float* Wd = wd + (size_t)e * DEXP * D_;
            for (int k = 0; k < DEXP; ++k) { const float hv = h2[k]; o0 = fmaf(hv, Wd[(size_t)k * D_ + c.tid], o0); o1 = fmaf(hv, Wd[(size_t)k * D_ + c.tid + 512], o1); }
        }
        x[(size_t)row * D_ + c.tid] += o0; x[(size_t)row * D_ + c.tid + 512] += o1;
    }
    __syncthreads();
}

typedef __attribute__((address_space(4))) const Params* KP;
__device__ __forceinline__ KP uni_kp(KP p) { const unsigned long long v = (unsigned long long)p; const unsigned lo = __builtin_amdgcn_readfirstlane((unsigned)v), hi = __builtin_amdgcn_readfirstlane((unsigned)(v >> 32)); return (KP)(((unsigned long long)hi << 32) | lo); }
constexpr int PH_PER_LAYER = 11, N_PHASES = L_ * PH_PER_LAYER + 2;
__device__ __forceinline__ Ctx make_ctx(KP p) {
    Ctx c; c.lds = (LAS unsigned char*)lds_raw; c.tid = threadIdx.x; c.lane = c.tid & 63; c.wave = __builtin_amdgcn_readfirstlane(c.tid >> 6);
    c.bid = blockIdx.x; c.G = gridDim.x; c.gw = c.bid * NWAVES + c.wave; c.ngw = c.G * NWAVES; c.in = nullptr; c.xcur = p->out; c.ws = p->ws;
    return c;
}
struct Bufs {
    bf16 *QN, *KV6, *KC, *VC, *KS, *VS, *KW, *VW, *FQ, *FK, *FV, *DQ, *DK, *DV, *HC, *KCMP, *VCMP, *OCMP, *OWIN, *HN, *ATT;
    float *GATE, *FL, *ROUTE_W; u64* SEL; int* ROUTE_E;
};
__device__ __forceinline__ Bufs make_bufs(unsigned char* ws) {
    Bufs b;
    b.QN = (bf16*)(ws + WS_QN); b.KV6 = (bf16*)(ws + WS_KV6);
    b.KC = (bf16*)(ws + WS_KV6 + 0 * KV6_STRIDE); b.VC = (bf16*)(ws + WS_KV6 + 1 * KV6_STRIDE);
    b.KS = (bf16*)(ws + WS_KV6 + 2 * KV6_STRIDE); b.VS = (bf16*)(ws + WS_KV6 + 3 * KV6_STRIDE);
    b.KW = (bf16*)(ws + WS_KV6 + 4 * KV6_STRIDE); b.VW = (bf16*)(ws + WS_KV6 + 5 * KV6_STRIDE);
    b.FQ = (bf16*)(ws + WS_FQKV); b.FK = b.FQ + 8 * MiB; b.FV = b.FQ + 16 * MiB;
    b.DQ = (bf16*)(ws + WS_DQK); b.DK = b.DQ + 8 * MiB; b.DV = (bf16*)(ws + WS_DV);
    b.GATE = (float*)(ws + WS_GATE); b.FL = (float*)(ws + WS_FL);
    b.HC = (bf16*)(ws + WS_HC); b.KCMP = (bf16*)(ws + WS_KVCMP); b.VCMP = b.KCMP + 16 * 256 * 64;
    b.SEL = (u64*)(ws + WS_SEL); b.OCMP = (bf16*)(ws + WS_OCMP); b.OWIN = (bf16*)(ws + WS_OWIN);
    b.HN = (bf16*)(ws + WS_HN); b.ATT = (bf16*)(ws + WS_ATT);
    b.ROUTE_E = (int*)(ws + WS_ROUTE); b.ROUTE_W = (float*)(ws + WS_ROUTE + 512 * 1024);
    return b;
}
__device__ __forceinline__ float lambda_init_of(int l) { return l == 0 ? 0.2f : 0.35550906759096926f; }

__device__ __noinline__ void P_prologue(KP p_) { const KP p = uni_kp(p_);
    const Ctx c = make_ctx(p); unsigned char* ws = p->ws;
    LAS float* scr = (LAS float*)(c.lds) + c.wave * (64 * 33);
    constexpr int I_A = 16 * 40, I_B = 16 * 24, I_C = 16 * 24, I_O = 16 * 32, I_G = 16 * 8, I_D = 4 * 32, I_E = 2 * I_G + I_D, I_W1 = 32 * 8, I_W2 = 4 * 2;
    constexpr int PER_L = I_A + I_B + I_C + I_O + NEXP * I_E + 2 * (I_W1 + I_W2);
    for (int it = c.gw; it < L_ * PER_L; it += c.ngw) {
        const int l = it / PER_L; int r = it % PER_L;
        const float* W; bf16* WT; int ldw, K, sc0, ncol, r0 = 0, rmul = 1;
        if (r < I_A + I_B + I_C) { W = p->in[2] + (size_t)l * D_ * D_IN; WT = (bf16*)(ws + WS_WIN_T) + (size_t)l * NIN * D_; ldw = D_IN; K = D_;
            if (r < I_A) { sc0 = 0; ncol = 1280; r0 = 0; } else if (r < I_A + I_B) { r -= I_A; sc0 = C_FQ; ncol = 768; r0 = 1280; } else { r -= I_A + I_B; sc0 = C_DQ; ncol = 768; r0 = 2048; } }
        else if ((r -= I_A + I_B + I_C) < I_O) { W = p->in[13] + (size_t)l * D_ * D_; WT = (bf16*)(ws + WS_WOUT_T) + (size_t)l * D_ * D_; ldw = D_; K = D_; sc0 = 0; ncol = 1024; }
        else if ((r -= I_O) < NEXP * I_E) { const int e = r / I_E; r = r % I_E; const size_t le = (size_t)l * NEXP + e;
            if (r < 2 * I_G) { const int up = r >= I_G; r -= up * I_G; W = p->in[19 + up] + le * D_ * DEXP; WT = (bf16*)(ws + WS_WGU_T) + le * 512 * D_; ldw = DEXP; K = D_; sc0 = 0; ncol = 256; r0 = up; rmul = 2; }
            else { r -= 2 * I_G; W = p->in[21] + le * DEXP * D_; WT = (bf16*)(ws + WS_WD_T) + le * D_ * DEXP; ldw = D_; K = DEXP; sc0 = 0; ncol = 1024; } }
        else { r -= NEXP * I_E; const int kv = r / (I_W1 + I_W2); r = r % (I_W1 + I_W2); const size_t lk = (size_t)l * 2 + kv;
            if (r < I_W1) { W = p->in[kv == 0 ? 6 : 9] + (size_t)l * 2048 * 256; WT = (bf16*)(ws + WS_W1_T) + lk * 256 * 2048; ldw = 256; K = 2048; sc0 = 0; ncol = 256; }
            else { r -= I_W1; W = p->in[kv == 0 ? 7 : 10] + (size_t)l * 256 * 64; WT = (bf16*)(ws + WS_W2_T) + lk * 64 * 256; ldw = 64; K = 256; sc0 = 0; ncol = 64; } }
        transpose_seg(W, ldw, K, sc0, ncol, WT, r0, rmul, r, scr, c.lane);
    }
    for (int i = c.bid * NTHREADS + c.tid; i < L_ * 256 * D_; i += c.G * NTHREADS) {
        const int l = i / (256 * D_), rr = (i / D_) % 256, k = i % D_;
        const float* win = p->in[2] + (size_t)l * D_ * D_IN;
        float v = 0.f; if (rr < 24) v = win[(size_t)k * D_IN + C_GATE + rr]; else if (rr < 28) v = win[(size_t)k * D_IN + C_FF + (rr - 24)];
        ((bf16*)(ws + WS_WIN_T))[((size_t)l * NIN + 2816 + rr) * D_ + k] = (bf16)f2bf(v);
    }
    for (int w = c.gw; w < L_ * 2 * 4; w += c.ngw) {
        const int l = w / 8, kv = (w / 4) & 1, j = (w & 3) * 64 + c.lane;
        const float* pe = p->in[kv == 0 ? 5 : 8] + (size_t)l * 2048; const float* w1 = p->in[kv == 0 ? 6 : 9] + (size_t)l * 2048 * 256;
        float a = 0.f; for (int k = 0; k < 2048; ++k) a = fmaf(pe[k], w1[(size_t)k * 256 + j], a);
        ((float*)(ws + WS_BIAS1))[(l * 2 + kv) * 256 + j] = a;
    }
}
__device__ __forceinline__ void P_inproj_mfma(int l_) { const KP p = (KP)__builtin_amdgcn_kernarg_segment_ptr(); int l = l_; asm volatile("" : "+s"(l));
    unsigned char* ws = p->ws; asm volatile("" : "+s"(ws));
    PlainOrder S; S.init(ws + WS_HN, (const bf16*)(ws + WS_WIN_T) + (size_t)l * NIN * D_, D_, D_, NT, NIN, (int)gridDim.x, launder_s((int)blockIdx.x));
    const pg8::Gemm g{D_, D_, D_, D_ / 64};
    const EpiInProj E{ws, p->in[3] + l * 24, p->in[4] + l * 4};
    pg8::gemm_phase<EpiInProj, PlainOrder, true, true>((LAS unsigned char*)lds_raw, g, S, E);
}
__device__ __forceinline__ void P_outproj_mfma(int l_) { const KP p = (KP)__builtin_amdgcn_kernarg_segment_ptr(); int l = l_; asm volatile("" : "+s"(l));
    unsigned char* ws = p->ws; asm volatile("" : "+s"(ws));
    PlainOrder S; S.init(ws + WS_ATT, (const bf16*)(ws + WS_WOUT_T) + (size_t)l * D_ * D_, D_, D_, NT, D_, (int)gridDim.x, launder_s((int)blockIdx.x));
    const pg8::Gemm g{D_, D_, D_, D_ / 64};
    const EpiResF32 E{(l == 0) ? p->in[0] : p->out, p->out};
    pg8::gemm_phase<EpiResF32, PlainOrder, true, true>((LAS unsigned char*)lds_raw, g, S, E);
}
__device__ __forceinline__ void U_fox(KP p_, int bh_, int qb_) {
    const KP p = uni_kp(p_); const int bh = __builtin_amdgcn_readfirstlane(bh_), qb = __builtin_amdgcn_readfirstlane(qb_);
    int tid_ = threadIdx.x; asm volatile("" : "+v"(tid_));
    const int tid = tid_, lane = tid & 63, wave = __builtin_amdgcn_readfirstlane(tid >> 6), r = lane & 31, h = lane >> 5;
    unsigned char* ws = p->ws; asm volatile("" : "+s"(ws)); LAS unsigned char* L = (LAS unsigned char*)lds_raw;
    const int tw0 = 256 * qb + 32 * wave, t_lane = tw0 + r, b = bh >> 2, hd = bh & 3;
    const bf16* q = (const bf16*)(ws + WS_FQKV) + ((size_t)bh * T_ + t_lane) * 64 + 8 * h;
    bf16x8v Qf[1][4];
#pragma unroll
    for (int s = 0; s < 4; ++s) Qf[0][s] = *(const bf16x8v*)(q + 16 * s);
    const float* cum = (const float*)(ws + WS_FL) + (size_t)bh * T_;
    f32x16 O[1][2]; float M[1] = {-1e30f}, Ls[1] = {0.f};
#pragma unroll
    for (int i = 0; i < 16; ++i) { O[0][0][i] = 0.f; O[0][1][i] = 0.f; }
    const u64 tm = (qb == 15) ? ~0ull : ((1ull << (4 * qb + 4)) - 1ull);
    attn_core<64, 1, true, false>(L, (const bf16*)(ws + WS_FQKV) + 8 * MiB + (size_t)bh * T_ * 64, nullptr, (const bf16*)(ws + WS_FQKV) + 16 * MiB + (size_t)bh * T_ * 64, cum, cum[256 * qb],
                                  Qf, tm, t_lane, tw0, 1 << 30, 0.f, 0u, 0u, O, M, Ls, tid);
    const float lt = swap_sum(Ls[0]), inv = lt > 0.f ? 1.f / lt : 0.f;
    bf16* dst = (bf16*)(ws + WS_ATT) + ((size_t)b * T_ + t_lane) * 1024 + 512 + hd * 64 + 4 * h;
    ATTN_FOR_CHUNKS(db, g4) { const unsigned w0 = cvtpk(O[0][db][4 * g4 + 0] * inv, O[0][db][4 * g4 + 1] * inv), w1 = cvtpk(O[0][db][4 * g4 + 2] * inv, O[0][db][4 * g4 + 3] * inv);
        *(u64*)(dst + 32 * db + 8 * g4) = (u64)w0 | ((u64)w1 << 32); }
}
__device__ __forceinline__ void U_diff(KP p_, int bh_, int qb_, int l_) {
    const KP p = uni_kp(p_); const int bh = __builtin_amdgcn_readfirstlane(bh_), qb = __builtin_amdgcn_readfirstlane(qb_), l = __builtin_amdgcn_readfirstlane(l_);
    int tid_ = threadIdx.x; asm volatile("" : "+v"(tid_));
    const int tid = tid_, lane = tid & 63, wave = __builtin_amdgcn_readfirstlane(tid >> 6), r = lane & 31, h = lane >> 5;
    unsigned char* ws = p->ws; asm volatile("" : "+s"(ws)); LAS unsigned char* L = (LAS unsigned char*)lds_raw;
    const int tw0 = 256 * qb + 32 * wave, t_lane = tw0 + r, b = bh >> 2, hd = bh & 3;
    const bf16* DQ = (const bf16*)(ws + WS_DQK); const bf16* DK = DQ + 8 * MiB;
    bf16x8v Qf[2][2];
#pragma unroll
    for (int mp = 0; mp < 2; ++mp)
#pragma unroll
        for (int s = 0; s < 2; ++s) Qf[mp][s] = *(const bf16x8v*)(DQ + ((size_t)(bh * 2 + mp) * T_ + t_lane) * 32 + 16 * s + 8 * h);
    f32x16 O[2][2]; float M[2] = {-1e30f, -1e30f}, Ls[2] = {0.f, 0.f};
#pragma unroll
    for (int i = 0; i < 16; ++i) { O[0][0][i] = 0.f; O[0][1][i] = 0.f; O[1][0][i] = 0.f; O[1][1][i] = 0.f; }
    const u64 tm = (qb == 15) ? ~0ull : ((1ull << (4 * qb + 4)) - 1ull);
    attn_core<32, 2, false, false>(L, DK + (size_t)(bh * 2 + 0) * T_ * 32, DK + (size_t)(bh * 2 + 1) * T_ * 32, (const bf16*)(ws + WS_DV) + (size_t)bh * T_ * 64, nullptr, 0.f,
                                   Qf, tm, t_lane, tw0, 1 << 30, alibi_slope(hd + 1, 4) * LOG2E, 0u, 0u, O, M, Ls, tid);
    const float* lam = p->in[11] + (size_t)l * 128; const float* subln = p->in[12] + (size_t)l * 64;
    float l1 = 0.f, l2 = 0.f; if (lane < 32) { l1 = lam[lane] * lam[32 + lane]; l2 = lam[64 + lane] * lam[96 + lane]; }
    const float li = lambda_init_of(l), lam_full = __expf(wave_sum_l(l1, lane)) - __expf(wave_sum_l(l2, lane)) + li;
    const float lt0 = swap_sum(Ls[0]), lt1 = swap_sum(Ls[1]), i0 = lt0 > 0.f ? 1.f / lt0 : 0.f, i1 = (lt1 > 0.f ? 1.f / lt1 : 0.f) * lam_full;
    float ss = 0.f;
#pragma unroll
    for (int db = 0; db < 2; ++db)
#pragma unroll
        for (int i = 0; i < 16; ++i) { const float o = O[0][db][i] * i0 - O[1][db][i] * i1; O[0][db][i] = o; ss += o * o; }
    ss = swap_sum(ss);
    const float rn = rsqrtf(ss * (1.f / 64.f) + EPS) * (1.f - li);
    bf16* dst = (bf16*)(ws + WS_ATT) + ((size_t)b * T_ + t_lane) * 1024 + 768 + hd * 64 + 4 * h;
    ATTN_FOR_CHUNKS(db, g4) { const f32x4 sg = *(const f32x4*)(subln + 32 * db + 8 * g4 + 4 * h);
        const unsigned w0 = cvtpk(O[0][db][4 * g4 + 0] * rn * sg.x, O[0][db][4 * g4 + 1] * rn * sg.y), w1 = cvtpk(O[0][db][4 * g4 + 2] * rn * sg.z, O[0][db][4 * g4 + 3] * rn * sg.w);
        *(u64*)(dst + 32 * db + 8 * g4) = (u64)w0 | ((u64)w1 << 32); }
}
__device__ __forceinline__ void U_win(KP p_, int bg_, int c_) {
    const KP p = uni_kp(p_); const int bg = __builtin_amdgcn_readfirstlane(bg_), cc = __builtin_amdgcn_readfirstlane(c_);
    int tid_ = threadIdx.x; asm volatile("" : "+v"(tid_));
    const int tid = tid_, lane = tid & 63, wave = __builtin_amdgcn_readfirstlane(tid >> 6), r = lane & 31, h = lane >> 5;
    unsigned char* ws = p->ws; asm volatile("" : "+s"(ws)); LAS unsigned char* L = (LAS unsigned char*)lds_raw;
    const int b = bg >> 1, g = bg & 1, hd = g * 4 + (wave >> 1), tw0 = 64 * cc + 32 * (wave & 1), t_lane = tw0 + r;
    const bf16* q = (const bf16*)(ws + WS_QN) + ((size_t)(b * 8 + hd) * T_ + t_lane) * 64 + 8 * h;
    bf16x8v Qf[1][4];
#pragma unroll
    for (int s = 0; s < 4; ++s) Qf[0][s] = *(const bf16x8v*)(q + 16 * s);
    f32x16 O[1][2]; float M[1] = {-1e30f}, Ls[1] = {0.f};
#pragma unroll
    for (int i = 0; i < 16; ++i) { O[0][0][i] = 0.f; O[0][1][i] = 0.f; }
    const int jlo = cc > 8 ? cc - 8 : 0;
    const u64 hi = (cc == 63) ? ~0ull : ((1ull << (cc + 1)) - 1ull), tm = hi & ~((1ull << jlo) - 1ull);
    attn_core<64, 1, false, false>(L, (const bf16*)(ws + WS_KV6 + 4 * KV6_STRIDE) + (size_t)bg * T_ * 64, nullptr, (const bf16*)(ws + WS_KV6 + 5 * KV6_STRIDE) + (size_t)bg * T_ * 64, nullptr, 0.f,
                                   Qf, tm, t_lane, tw0, 512, alibi_slope(hd + 1, 8) * LOG2E, 0u, 0u, O, M, Ls, tid);
    const size_t n = (size_t)b * T_ + t_lane;
    const float lt = swap_sum(Ls[0]), inv = (lt > 0.f ? 1.f / lt : 0.f) * ((const float*)(ws + WS_GATE))[n * 24 + hd * 3 + 2];
    bf16* dst = (bf16*)(ws + WS_OWIN) + n * 512 + hd * 64 + 4 * h;
    ATTN_FOR_CHUNKS(db, g4) { const unsigned w0 = cvtpk(O[0][db][4 * g4 + 0] * inv, O[0][db][4 * g4 + 1] * inv), w1 = cvtpk(O[0][db][4 * g4 + 2] * inv, O[0][db][4 * g4 + 3] * inv);
        *(u64*)(dst + 32 * db + 8 * g4) = (u64)w0 | ((u64)w1 << 32); }
}
__device__ __forceinline__ void U_slc(KP p_, int bg_, int c_) {
    const KP p = uni_kp(p_); const int bg = __builtin_amdgcn_readfirstlane(bg_), cc = __builtin_amdgcn_readfirstlane(c_);
    int tid_ = threadIdx.x; asm volatile("" : "+v"(tid_));
    const int tid = tid_, lane = tid & 63, wave = __builtin_amdgcn_readfirstlane(tid >> 6), r = lane & 31, h = lane >> 5;
    unsigned char* ws = p->ws; asm volatile("" : "+s"(ws)); LAS unsigned char* L = (LAS unsigned char*)lds_raw;
    const int b = bg >> 1, g = bg & 1, hd = g * 4 + (wave >> 1), tw0 = 64 * cc + 32 * (wave & 1), t_lane = tw0 + r;
    const bf16* q = (const bf16*)(ws + WS_QN) + ((size_t)(b * 8 + hd) * T_ + t_lane) * 64 + 8 * h;
    bf16x8v Qf[1][4];
#pragma unroll
    for (int s = 0; s < 4; ++s) Qf[0][s] = *(const bf16x8v*)(q + 16 * s);
    f32x16 O[1][2]; float M[1] = {-1e30f}, Ls[1] = {0.f};
#pragma unroll
    for (int i = 0; i < 16; ++i) { O[0][0][i] = 0.f; O[0][1][i] = 0.f; }
    const u64* sel = (const u64*)(ws + WS_SEL) + (size_t)bg * T_;
    const u64 mine = sel[t_lane]; u64 un = sel[64 * cc + lane];
    { unsigned ul = (unsigned)un, uh = (unsigned)(un >> 32);
#pragma unroll
      for (int o = 1; o < 64; o <<= 1) { ul |= shflx_u(ul, o, lane); uh |= shflx_u(uh, o, lane); }
      un = ((u64)__builtin_amdgcn_readfirstlane(uh) << 32) | __builtin_amdgcn_readfirstlane(ul); }
    attn_core<64, 1, false, true>(L, (const bf16*)(ws + WS_KV6 + 2 * KV6_STRIDE) + (size_t)bg * T_ * 64, nullptr, (const bf16*)(ws + WS_KV6 + 3 * KV6_STRIDE) + (size_t)bg * T_ * 64, nullptr, 0.f,
                                  Qf, un, t_lane, tw0, 1 << 30, alibi_slope(hd + 1, 8) * LOG2E, (unsigned)mine, (unsigned)(mine >> 32), O, M, Ls, tid);
    const size_t n = (size_t)b * T_ + t_lane;
    const float lt = swap_sum(Ls[0]), inv = (lt > 0.f ? 1.f / lt : 0.f) * ((const float*)(ws + WS_GATE))[n * 24 + hd * 3 + 1];
    const bf16* oc = (const bf16*)(ws + WS_OCMP) + n * 512 + hd * 64 + 4 * h; const bf16* ow = (const bf16*)(ws + WS_OWIN) + n * 512 + hd * 64 + 4 * h;
    bf16* dst = (bf16*)(ws + WS_ATT) + n * 1024 + hd * 64 + 4 * h;
    ATTN_FOR_CHUNKS(db, g4) { const u64 a = *(const u64*)(oc + 32 * db + 8 * g4), w = *(const u64*)(ow + 32 * db + 8 * g4);
        const float x0 = O[0][db][4 * g4 + 0] * inv + __uint_as_float((unsigned)a << 16) + __uint_as_float((unsigned)w << 16);
        const float x1 = O[0][db][4 * g4 + 1] * inv + __uint_as_float((unsigned)a & 0xffff0000u) + __uint_as_float((unsigned)w & 0xffff0000u);
        const float x2 = O[0][db][4 * g4 + 2] * inv + __uint_as_float((unsigned)(a >> 32) << 16) + __uint_as_float((unsigned)(w >> 32) << 16);
        const float x3 = O[0][db][4 * g4 + 3] * inv + __uint_as_float((unsigned)(a >> 32) & 0xffff0000u) + __uint_as_float((unsigned)(w >> 32) & 0xffff0000u);
        *(u64*)(dst + 32 * db + 8 * g4) = (u64)cvtpk(x0, x1) | ((u64)cvtpk(x2, x3) << 32); }
}
__device__ __forceinline__ float other_half(float x, int h) { auto rr = __builtin_amdgcn_permlane32_swap(__float_as_uint(x), __float_as_uint(x), false, false); return __uint_as_float(h ? rr[0] : rr[1]); }
__device__ __forceinline__ int other_half_i(int x, int h) { auto rr = __builtin_amdgcn_permlane32_swap((unsigned)x, (unsigned)x, false, false); return (int)(h ? rr[0] : rr[1]); }
template <bool MASK>
__device__ __forceinline__ void cmp_scores(f32x16& p0, f32x16& p1, const LAS unsigned char* kt, const bf16x8v (&Qf)[4], float b0, float s1, int cl, int nvis_l) {
    const float s8 = s1 * 8.f, s32 = s1 * 32.f;
    p0[0] = b0; p0[1] = p0[0] + s1; p0[2] = p0[1] + s1; p0[3] = p0[2] + s1;
#pragma unroll
    for (int reg = 4; reg < 16; ++reg) p0[reg] = p0[reg - 4] + s8;
#pragma unroll
    for (int reg = 0; reg < 16; ++reg) p1[reg] = p0[reg] + s32;
#pragma unroll
    for (int s = 0; s < 4; ++s) { const bf16x8v kf0 = *(const LAS bf16x8v*)(kt + s * 32), kf1 = *(const LAS bf16x8v*)(kt + 32 * 144 + s * 32);
        p0 = __builtin_amdgcn_mfma_f32_32x32x16_bf16(kf0, Qf[s], p0, 0, 0, 0); p1 = __builtin_amdgcn_mfma_f32_32x32x16_bf16(kf1, Qf[s], p1, 0, 0, 0); }
    if (MASK) {
#pragma unroll
        for (int reg = 0; reg < 16; ++reg) { const int c = cl + crow0(reg); p0[reg] = (c < nvis_l) ? p0[reg] : -INFINITY; p1[reg] = (c + 32 < nvis_l) ? p1[reg] : -INFINITY; } }
}
__device__ __forceinline__ void U_cmp(KP p_, int bg_, int u_) {
    const KP p = uni_kp(p_); const int bg = __builtin_amdgcn_readfirstlane(bg_), uu = __builtin_amdgcn_readfirstlane(u_);
    int tid_ = threadIdx.x; asm volatile("" : "+v"(tid_));
    const int tid = tid_, lane = tid & 63, wave = __builtin_amdgcn_readfirstlane(tid >> 6), r = lane & 31, h = lane >> 5;
    unsigned char* ws = p->ws; asm volatile("" : "+s"(ws)); LAS unsigned char* L = (LAS unsigned char*)lds_raw;
    const int b = bg >> 1, g = bg & 1, tw0 = 32 * (uu + 16 * wave), t_lane = tw0 + r;
    { const bf16* kc = (const bf16*)(ws + WS_KVCMP) + (size_t)bg * 256 * 64; const bf16* vc = kc + 16 * 256 * 64;
#pragma unroll
      for (int i = 0; i < 4; ++i) { const int ch = tid + 512 * i, row = ch >> 3, c8 = ch & 7;
          *(LAS u32x4*)(L + row * 144 + c8 * 16) = *(const u32x4*)(kc + row * 64 + c8 * 8); *(LAS u32x4*)(L + 36864 + row * 144 + c8 * 16) = *(const u32x4*)(vc + row * 64 + c8 * 8); } }
    __syncthreads();
    const int nvis_l = t_lane >= 31 ? ((t_lane - 31) >> 4) + 1 : 0, nvis_max = (tw0 >> 4) + 1, nvis_min = tw0 >= 31 ? ((tw0 - 31) >> 4) + 1 : 0, ntile = (nvis_max + 63) >> 6;
    const LAS unsigned char* kfrag = L + r * 144 + h * 16;
    const LAS unsigned char* vfrag = L + 36864 + (4 * h + ((lane & 15) >> 2)) * 144 + (16 * ((lane >> 4) & 1) + 4 * (lane & 3)) * 2;
    float imp[32];
#pragma unroll
    for (int e = 0; e < 32; ++e) imp[e] = 0.f;
    const float* gate = (const float*)(ws + WS_GATE) + ((size_t)b * T_ + t_lane) * 24;
#pragma unroll 1
    for (int hg = 0; hg < 4; ++hg) {
        const int hd = g * 4 + hg; const float s1 = alibi_slope(hd + 1, 8) * LOG2E * 16.f;
        const bf16* q = (const bf16*)(ws + WS_QN) + ((size_t)(b * 8 + hd) * T_ + t_lane) * 64 + 8 * h;
        bf16x8v Qf[4];
#pragma unroll
        for (int s = 0; s < 4; ++s) Qf[s] = *(const bf16x8v*)(q + 16 * s);
        float m = -1e30f, lsum = 0.f;
#pragma unroll 1
        for (int jt = 0; jt < ntile; ++jt) {
            f32x16 p0, p1; const float b0 = s1 * (float)(64 * jt + 4 * h - nvis_max);
            if (64 * jt + 63 >= nvis_min) cmp_scores<true>(p0, p1, kfrag + jt * (64 * 144), Qf, b0, s1, 64 * jt + 4 * h, nvis_l);
            else cmp_scores<false>(p0, p1, kfrag + jt * (64 * 144), Qf, b0, s1, 64 * jt + 4 * h, nvis_l);
            float mt = fmaxf(p0[0], p1[0]);
#pragma unroll
            for (int reg = 1; reg < 16; ++reg) mt = fmaxf(mt, fmaxf(p0[reg], p1[reg]));
            mt = swap_max(mt);
            const float mn = fmaxf(m, mt); float rs = 0.f;
#pragma unroll
            for (int reg = 0; reg < 16; ++reg) rs += __builtin_amdgcn_exp2f(p0[reg] - mn) + __builtin_amdgcn_exp2f(p1[reg] - mn);
            lsum = lsum * __builtin_amdgcn_exp2f(m - mn) + rs; m = mn;
        }
        const float lt = swap_sum(lsum), inv = lt > 0.f ? 1.f / lt : 0.f;
        f32x16 O0, O1;
#pragma unroll
        for (int i = 0; i < 16; ++i) { O0[i] = 0.f; O1[i] = 0.f; }
        float carry = 0.f;
#pragma unroll
        for (int jt = 0; jt < 4; ++jt) if (jt < ntile) {
            f32x16 p0, p1; const float b0 = s1 * (float)(64 * jt + 4 * h - nvis_max);
            if (64 * jt + 63 >= nvis_min) cmp_scores<true>(p0, p1, kfrag + jt * (64 * 144), Qf, b0, s1, 64 * jt + 4 * h, nvis_l);
            else cmp_scores<false>(p0, p1, kfrag + jt * (64 * 144), Qf, b0, s1, 64 * jt + 4 * h, nvis_l);
#pragma unroll
            for (int reg = 0; reg < 16; ++reg) { p0[reg] = __builtin_amdgcn_exp2f(p0[reg] - m) * inv; p1[reg] = __builtin_amdgcn_exp2f(p1[reg] - m) * inv; }
            float cv[8];
#pragma unroll
            for (int g4 = 0; g4 < 4; ++g4) { const float h0 = 0.5f * p0[4 * g4 + 3], h1 = 0.5f * p1[4 * g4 + 3];
                imp[jt * 8 + g4] += ((p0[4 * g4] + p0[4 * g4 + 1]) + p0[4 * g4 + 2]) + h0; imp[jt * 8 + 4 + g4] += ((p1[4 * g4] + p1[4 * g4 + 1]) + p1[4 * g4 + 2]) + h1;
                cv[g4] = h0; cv[4 + g4] = h1; }
            float prev = carry;
#pragma unroll
            for (int k = 0; k < 8; ++k) { const float sv = other_half(cv[k], h); imp[jt * 8 + k] += h ? sv : prev; prev = sv; }
            carry = prev;
            const bf16x8v pa0 = pack8(p0, 0), pa1 = pack8(p0, 8), pa2 = pack8(p1, 0), pa3 = pack8(p1, 8);
            const LAS unsigned char* vb = vfrag + jt * (64 * 144);
#pragma unroll
            for (int ks = 0; ks < 4; ++ks) { const bf16x8v pa = ks == 0 ? pa0 : ks == 1 ? pa1 : ks == 2 ? pa2 : pa3;
                { const s16x4 lo = tr_read(vb + ks * (16 * 144)), hi = tr_read(vb + ks * (16 * 144) + 8 * 144); const bf16x8v vf = {lo[0], lo[1], lo[2], lo[3], hi[0], hi[1], hi[2], hi[3]};
                  O0 = __builtin_amdgcn_mfma_f32_32x32x16_bf16(vf, pa, O0, 0, 0, 0); }
                { const s16x4 lo = tr_read(vb + ks * (16 * 144) + 64), hi = tr_read(vb + ks * (16 * 144) + 64 + 8 * 144); const bf16x8v vf = {lo[0], lo[1], lo[2], lo[3], hi[0], hi[1], hi[2], hi[3]};
                  O1 = __builtin_amdgcn_mfma_f32_32x32x16_bf16(vf, pa, O1, 0, 0, 0); } }
        }
        const float gt = gate[hd * 3 + 0];
        bf16* dst = (bf16*)(ws + WS_OCMP) + ((size_t)b * T_ + t_lane) * 512 + hd * 64 + 4 * h;
#pragma unroll
        for (int g4 = 0; g4 < 4; ++g4) {
            *(u64*)(dst + 8 * g4) = (u64)cvtpk(O0[4 * g4 + 0] * gt, O0[4 * g4 + 1] * gt) | ((u64)cvtpk(O0[4 * g4 + 2] * gt, O0[4 * g4 + 3] * gt) << 32);
            *(u64*)(dst + 32 + 8 * g4) = (u64)cvtpk(O1[4 * g4 + 0] * gt, O1[4 * g4 + 1] * gt) | ((u64)cvtpk(O1[4 * g4 + 2] * gt, O1[4 * g4 + 3] * gt) << 32); }
    }
    const int cur = tw0 >> 6; u64 mask;
    if (cur <= 15) mask = (1ull << (cur + 1)) - 1ull;
    else {
        mask = 1ull | (1ull << cur) | (1ull << (cur - 1));
#pragma unroll
        for (int e = 0; e < 32; ++e) { const int j = 2 * e + h; if (j > cur || j == 0 || j >= cur - 1) imp[e] = -INFINITY; }
#pragma unroll 1
        for (int round = 0; round < 13; ++round) {
            float bv = imp[0]; int be = 0;
#pragma unroll
            for (int e = 1; e < 32; ++e) if (imp[e] > bv) { bv = imp[e]; be = e; }
            const int bj = 2 * be + h; const float ov = other_half(bv, h); const int oj = other_half_i(bj, h);
            const bool mine = bv > ov || (bv == ov && bj < oj);
            mask |= 1ull << (mine ? bj : oj);
#pragma unroll
            for (int e = 0; e < 32; ++e) imp[e] = (mine && e == be) ? -INFINITY : imp[e];
        }
    }
    if (h == 0) ((u64*)(ws + WS_SEL))[(size_t)bg * T_ + t_lane] = mask;
    __syncthreads();
}
__device__ __forceinline__ int fetch_unit(KP p, int qidx) {
    volatile LAS unsigned* slot = (volatile LAS unsigned*)((LAS unsigned char*)lds_raw + MISC_OFF) + 16;
    __syncthreads();
    int t0_ = threadIdx.x; asm volatile("" : "+v"(t0_));
    if (t0_ == 0) *slot = __hip_atomic_fetch_add((unsigned*)(p->ws + WS_CTL) + CW_QUEUE + 64 * qidx, 1u, __ATOMIC_RELAXED, __HIP_MEMORY_SCOPE_AGENT);
    __syncthreads();
    return (int)__builtin_amdgcn_readfirstlane(*slot);
}
__device__ __forceinline__ void P_cmp1_mfma(int l_) { const KP p = (KP)__builtin_amdgcn_kernarg_segment_ptr(); int l = l_; asm volatile("" : "+s"(l));
    unsigned char* ws = p->ws; asm volatile("" : "+s"(ws)); const int c = launder_s((int)blockIdx.x), kv = c >> 4, pm = c & 15;
    OneUnitOrder S; S.has = c < 32; S.u.pm = pm; S.u.pn = kv;
    S.u.a = (const char*)(ws + WS_KV6 + (size_t)kv * KV6_STRIDE) + (size_t)pm * 256 * 1024 * 2; S.u.b = (const char*)((const bf16*)(ws + WS_W1_T) + ((size_t)l * 2 + kv) * 256 * 2048); S.u.b2 = S.u.b;
    const pg8::Gemm g{1024, 2048, 2048, 32};
    const EpiCmpH E{(bf16*)(ws + WS_HC), (const float*)(ws + WS_BIAS1) + l * 512};
    pg8::gemm_phase<EpiCmpH, OneUnitOrder, false, true>((LAS unsigned char*)lds_raw, g, S, E);
}
__device__ __forceinline__ void P_cmp2_mfma(int l_) { const KP p = (KP)__builtin_amdgcn_kernarg_segment_ptr(); int l = l_; asm volatile("" : "+s"(l));
    unsigned char* ws = p->ws; asm volatile("" : "+s"(ws)); const int c = launder_s((int)blockIdx.x), kv = c >> 4, pm = c & 15;
    OneUnitOrder S; S.has = c < 32; S.u.pm = pm; S.u.pn = kv;
    S.u.a = (const char*)((const bf16*)(ws + WS_HC) + ((size_t)kv * 4096 + pm * 256) * 256); S.u.b = (const char*)((const bf16*)(ws + WS_W2_T) + ((size_t)l * 2 + kv) * 64 * 256); S.u.b2 = S.u.b;
    const pg8::Gemm g{256, 256, 256, 4};
    const EpiCmpOut E{(bf16*)(ws + WS_KVCMP)};
    pg8::gemm_phase<EpiCmpOut, OneUnitOrder, false, true>((LAS unsigned char*)lds_raw, g, S, E);
}
__device__ __noinline__ void P_moe_scatter(KP p_, int l_) { const KP p = uni_kp(p_); const int l = __builtin_amdgcn_readfirstlane(l_); const Ctx c = make_ctx(p); unsigned char* ws = p->ws;
    const unsigned* cnt = (const unsigned*)(ws + WS_CTL) + CW_MOECNT + l * 128;
    moe_build_tables(cnt, c.tid);
    const LAS int* T = (const LAS int*)((LAS unsigned char*)lds_raw + TBL_OFF);
    const unsigned* info = (const unsigned*)(ws + WS_ROUTE + RT_INFO); const float* tw = (const float*)(ws + WS_ROUTE + RT_W);
    int* rowtok = (int*)(ws + WS_ROUTE + RT_ROWTOK); float* roww = (float*)(ws + WS_ROUTE + RT_ROWW);
    const bf16* hn = (const bf16*)(ws + WS_HN); bf16* xs = (bf16*)(ws + WS_XS);
    for (int row = c.gw; row < NT; row += c.ngw) {
        const unsigned v = info[row]; const int cls = (int)(v >> 24), rank = (int)(v & 0xffffffu); const size_t dest = (size_t)T[cls] * 256 + rank;
        const u32x4* src = (const u32x4*)(hn + (size_t)row * D_); u32x4* dst = (u32x4*)(xs + dest * D_);
        dst[c.lane] = src[c.lane]; dst[c.lane + 64] = src[c.lane + 64];
        if (c.lane == 0) { rowtok[dest] = row; roww[2 * dest] = tw[2 * row]; roww[2 * dest + 1] = tw[2 * row + 1]; }
    }
    for (int cls = c.bid; cls < 112; cls += c.G) { const int n = (int)cnt[cls], end = (int)((cnt[cls] + 255u) >> 8) * 256; const size_t base = (size_t)T[cls] * 256;
        for (int r = n + c.tid; r < end; r += NTHREADS) rowtok[base + r] = -1; }
}
__device__ __forceinline__ void P_moe_g1(int l_) { const KP p = (KP)__builtin_amdgcn_kernarg_segment_ptr(); int l = l_; asm volatile("" : "+s"(l));
    unsigned char* ws = p->ws; asm volatile("" : "+s"(ws));
    { int t0_ = threadIdx.x; asm volatile("" : "+v"(t0_)); moe_build_tables((const unsigned*)(ws + WS_CTL) + CW_MOECNT + l * 128, t0_); }
    const MoeOrder1 S{(const char*)(ws + WS_XS), (const char*)((const bf16*)(ws + WS_WGU_T) + (size_t)l * NEXP * 512 * D_), (int)gridDim.x, launder_s((int)blockIdx.x)};
    const pg8::Gemm g{D_, D_, D_, D_ / 64};
    const EpiMoeH E{(bf16*)(ws + WS_HB), (const float*)(ws + WS_ROUTE + RT_ROWW)};
    pg8::gemm_phase<EpiMoeH, MoeOrder1, true, true>((LAS unsigned char*)lds_raw, g, S, E);
}
__device__ __forceinline__ void P_moe_g2(int l_) { const KP p = (KP)__builtin_amdgcn_kernarg_segment_ptr(); int l = l_; asm volatile("" : "+s"(l));
    unsigned char* ws = p->ws; asm volatile("" : "+s"(ws));
    { int t0_ = threadIdx.x; asm volatile("" : "+v"(t0_)); moe_build_tables((const unsigned*)(ws + WS_CTL) + CW_MOECNT + l * 128, t0_); }
    const MoeOrder2 S{(const char*)(ws + WS_HB), (const char*)((const bf16*)(ws + WS_WD_T) + (size_t)l * NEXP * D_ * DEXP), (int)gridDim.x, launder_s((int)blockIdx.x)};
    const pg8::Gemm g{512, DEXP, 512, 4};
    const EpiMoeOut E{p->out, (const int*)(ws + WS_ROUTE + RT_ROWTOK)};
    pg8::gemm_phase<EpiMoeOut, MoeOrder2, true, true>((LAS unsigned char*)lds_raw, g, S, E);
}
__device__ __noinline__ void P_norm1(KP p_, int l_) { const KP p = uni_kp(p_); const int l = __builtin_amdgcn_readfirstlane(l_); const Ctx c = make_ctx(p); const Bufs b = make_bufs(p->ws);
    ph_norm_bf16(c, (l == 0) ? p->in[0] : p->out, p->in[1] + (size_t)l * D_, b.HN); }
__device__ __noinline__ void P_inproj(KP p_, int l_) { const KP p = uni_kp(p_); const int l = __builtin_amdgcn_readfirstlane(l_); const Ctx c = make_ctx(p); const Bufs b = make_bufs(p->ws);
    InProjOut o{b.QN, b.KV6, b.FQ, b.DQ, b.DV, b.GATE, b.FL, p->in[3] + l * 24, p->in[4] + l * 4};
    const bf16* A = b.HN;
    naive_gemm(c, NT, D_IN, D_, [=](int r, int k) { return bf2f(A[(size_t)r * D_ + k]); }, p->in[2] + (size_t)l * D_ * D_IN, D_IN,
               [=](int r, int col, float v) { inproj_store(o, r, col, v); }); }
__device__ __noinline__ void P_cmp1(KP p_, int l_, int kv_) { const KP p = uni_kp(p_); const int l = __builtin_amdgcn_readfirstlane(l_), kv = __builtin_amdgcn_readfirstlane(kv_); const Ctx c = make_ctx(p); const Bufs b = make_bufs(p->ws);
    const bf16* src = kv == 0 ? b.KC : b.VC; const float* pe = p->in[kv == 0 ? 5 : 8] + (size_t)l * 2048; bf16* hc = b.HC + (size_t)kv * 4096 * 256;
    naive_gemm(c, 4096, 256, 2048, [=](int r, int k) { return bf2f(src[(size_t)r * 1024 + k]) + pe[k]; }, p->in[kv == 0 ? 6 : 9] + (size_t)l * 2048 * 256, 256,
               [=](int r, int col, float v) { hc[(size_t)r * 256 + col] = (bf16)f2bf(gelu_tanh(v)); }); }
__device__ __noinline__ void P_cumsum(KP p_, int l_) { const KP p = uni_kp(p_); const int l = __builtin_amdgcn_readfirstlane(l_); const Ctx c = make_ctx(p); const Bufs b = make_bufs(p->ws); ph_cumsum(c, b.FL); }
__device__ __noinline__ void P_cmp2(KP p_, int l_, int kv_) { const KP p = uni_kp(p_); const int l = __builtin_amdgcn_readfirstlane(l_), kv = __builtin_amdgcn_readfirstlane(kv_); const Ctx c = make_ctx(p); const Bufs b = make_bufs(p->ws);
    const bf16* hc = b.HC + (size_t)kv * 4096 * 256; bf16* dst = kv == 0 ? b.KCMP : b.VCMP;
    naive_gemm(c, 4096, 64, 256, [=](int r, int k) { return bf2f(hc[(size_t)r * 256 + k]); }, p->in[kv == 0 ? 7 : 10] + (size_t)l * 256 * 64, 64,
               [=](int r, int col, float v) { dst[(size_t)r * 64 + col] = (bf16)f2bf((r & 255) == 255 ? 0.f : v); }); }
__device__ __noinline__ void P_win(KP p_, int l_) { const KP p = uni_kp(p_); const int l = __builtin_amdgcn_readfirstlane(l_); const Ctx c = make_ctx(p); const Bufs b = make_bufs(p->ws); ph_win_attn(c, b.QN, b.KW, b.VW, b.GATE, b.OWIN); }
__device__ __noinline__ void P_fox(KP p_, int l_) { const KP p = uni_kp(p_); const int l = __builtin_amdgcn_readfirstlane(l_); const Ctx c = make_ctx(p); const Bufs b = make_bufs(p->ws); ph_fox_attn(c, b.FQ, b.FK, b.FV, b.FL, b.ATT); }
__device__ __noinline__ void P_diff(KP p_, int l_) { const KP p = uni_kp(p_); const int l = __builtin_amdgcn_readfirstlane(l_); const Ctx c = make_ctx(p); const Bufs b = make_bufs(p->ws);
    ph_diff_attn(c, b.DQ, b.DK, b.DV, p->in[11] + (size_t)l * 128, p->in[12] + (size_t)l * 64, lambda_init_of(l), b.ATT); }
__device__ __noinline__ void P_cmpattn(KP p_, int l_) { const KP p = uni_kp(p_); const int l = __builtin_amdgcn_readfirstlane(l_); const Ctx c = make_ctx(p); const Bufs b = make_bufs(p->ws); ph_cmp_attn(c, b.QN, b.KCMP, b.VCMP, b.GATE, b.SEL, b.OCMP); }
__device__ __noinline__ void P_slc(KP p_, int l_) { const KP p = uni_kp(p_); const int l = __builtin_amdgcn_readfirstlane(l_); const Ctx c = make_ctx(p); const Bufs b = make_bufs(p->ws); ph_slc_attn(c, b.QN, b.KS, b.VS, b.GATE, b.SEL, b.OCMP, b.OWIN, b.ATT); }
__device__ __noinline__ void P_outproj(KP p_, int l_) { const KP p = uni_kp(p_); const int l = __builtin_amdgcn_readfirstlane(l_); const Ctx c = make_ctx(p); const Bufs b = make_bufs(p->ws);
    const bf16* A = b.ATT; float* xo = p->out; const float* xin = (l == 0) ? p->in[0] : p->out;
    naive_gemm(c, NT, D_, D_, [=](int r, int k) { return bf2f(A[(size_t)r * D_ + k]); }, p->in[13] + (size_t)l * D_ * D_, D_,
               [=](int r, int col, float v) { xo[(size_t)r * D_ + col] = xin[(size_t)r * D_ + col] + v; }); }
__device__ __noinline__ void P_route(KP p_, int l_) { const KP p = uni_kp(p_); const int l = __builtin_amdgcn_readfirstlane(l_); const Ctx c = make_ctx(p); const Bufs b = make_bufs(p->ws);
    ph_moe_route(c, p->out, p->in[14] + (size_t)l * D_, p->in[15] + (size_t)l * D_ * 4, p->in[16] + l * 4, p->in[17] + (size_t)l * D_ * 32, p->in[18] + l * 32, b.HN, (int*)(p->ws + WS_ROUTE + RT_INFO), (float*)(p->ws + WS_ROUTE + RT_W), (unsigned*)(p->ws + WS_CTL) + CW_MOECNT + l * 128); }
__device__ __noinline__ void P_moe(KP p_, int l_) { const KP p = uni_kp(p_); const int l = __builtin_amdgcn_readfirstlane(l_); const Ctx c = make_ctx(p); const Bufs b = make_bufs(p->ws);
    ph_moe_naive(c, b.HN, b.ROUTE_E, b.ROUTE_W, p->in[19] + (size_t)l * NEXP * D_ * DEXP, p->in[20] + (size_t)l * NEXP * D_ * DEXP, p->in[21] + (size_t)l * NEXP * DEXP * D_, p->out); }
__device__ __noinline__ void P_final(KP p_) { const KP p = uni_kp(p_); const Ctx c = make_ctx(p); ph_norm_final(c, p->out, p->in[22]); }
__device__ __noinline__ void P_gridbar(KP p_) { const KP p = uni_kp(p_);
    XcdBarrier bar; bar.bar = (unsigned*)(p->ws + WS_CTL) + 4096; bar.x = xb_xcc_id(); bar.st = (volatile LAS unsigned*)((LAS unsigned char*)lds_raw + MISC_OFF) + 8;
    xcd_barrier(bar);
}

__global__ void __launch_bounds__(NTHREADS, 2) fwd_kernel(Params pp) {
    const KP p = (KP)__builtin_amdgcn_kernarg_segment_ptr();
    { volatile LAS unsigned* MISC = (volatile LAS unsigned*)((LAS unsigned char*)lds_raw + MISC_OFF); if (threadIdx.x < 32) MISC[threadIdx.x] = 0u; }
    __syncthreads();
    const int lo = p->ph_lo, hi = p->ph_hi;
    if (hi - lo > 1) (void)xcd_barrier_post((unsigned*)(p->ws + WS_CTL) + 4096, (volatile LAS unsigned*)((LAS unsigned char*)lds_raw + MISC_OFF) + 8);
#define IN(k) (lo <= (k) && (k) < hi)
#define SEAM(k) do { if (IN(k) && IN((k) + 1)) P_gridbar(p); } while (0)
    if (IN(0)) P_prologue(p);
    SEAM(0);
    for (int l = 0; l < L_; ++l) {
        const int P0 = 1 + l * PH_PER_LAYER;
        if (IN(P0 + 0)) P_norm1(p, l);
        SEAM(P0 + 0);
        if (IN(P0 + 1)) P_inproj_mfma(l);
        SEAM(P0 + 1);
        if (IN(P0 + 2)) { P_cmp1_mfma(l); P_cumsum(p, l); }
        SEAM(P0 + 2);
        if (IN(P0 + 3)) { P_cmp2_mfma(l);
            for (;;) { const int u = fetch_unit(p, l * 8 + 0); if (u >= 2048) break;
                if (u < 1024) { const int qb = 15 - (u >> 6), k = u & 63; if (k < 32) U_diff(p, k, qb, l); else U_fox(p, k - 32, qb); }
                else { const int w = u - 1024; U_win(p, w & 15, 63 - (w >> 4)); } } }
        SEAM(P0 + 3);
        if (IN(P0 + 4)) { for (int u = launder_s((int)blockIdx.x); u < 256; u += (int)gridDim.x) U_cmp(p, u & 15, u >> 4); }
        SEAM(P0 + 4);
        if (IN(P0 + 5)) { for (;;) { const int u = fetch_unit(p, l * 8 + 1); if (u >= 1024) break; U_slc(p, u & 15, 63 - (u >> 4)); } }
        SEAM(P0 + 5);
        if (IN(P0 + 6)) P_outproj_mfma(l);
        SEAM(P0 + 6);
        if (IN(P0 + 7)) P_route(p, l);
        SEAM(P0 + 7);
        if (IN(P0 + 8)) P_moe_scatter(p, l);
        SEAM(P0 + 8);
        if (IN(P0 + 9)) P_moe_g1(l);
        SEAM(P0 + 9);
        if (IN(P0 + 10)) P_moe_g2(l);
        SEAM(P0 + 10);
    }
    if (IN(1 + L_ * PH_PER_LAYER)) P_final(p);
#undef IN
#undef SEAM
}

extern "C" void kernel_launch(void* const* d_in, const int* in_sizes, int n_in, void* d_out, int out_size, void* d_ws, size_t ws_size, hipStream_t stream) {
    static int grid = 0;
    if (grid == 0) {
        if (n_in != 23 || out_size != NT * D_ || ws_size < WS_END) { fprintf(stderr, "kernel_launch: unexpected sizes n_in %d out %d ws %zu (need %zu)\n", n_in, out_size, ws_size, (size_t)WS_END); grid = -1; return; }
        int dev = 0, cus = 0, per_cu = 0;
        if (hipGetDevice(&dev) != hipSuccess || hipDeviceGetAttribute(&cus, hipDeviceAttributeMultiprocessorCount, dev) != hipSuccess) { grid = -1; return; }
        if (hipFuncSetAttribute((const void*)fwd_kernel, hipFuncAttributeMaxDynamicSharedMemorySize, LDS_BYTES) != hipSuccess) { fprintf(stderr, "kernel_launch: hipFuncSetAttribute failed\n"); grid = -1; return; }
        if (hipOccupancyMaxActiveBlocksPerMultiprocessor(&per_cu, (const void*)fwd_kernel, NTHREADS, LDS_BYTES) != hipSuccess || per_cu < 1) { fprintf(stderr, "kernel_launch: occupancy query says %d\n", per_cu); }
        (void)hipGetLastError();
        grid = cus;
    }
    if (grid < 0) return;
    (void)hipMemsetAsync((char*)d_ws + WS_CTL, 0, CTL_BYTES, stream);
    Params p{};
    for (int i = 0; i < 23; ++i) p.in[i] = (const float*)d_in[i];
    p.out = (float*)d_out; p.ws = (unsigned char*)d_ws;
#if N_LAUNCH_MODE == 0
    p.ph_lo = 0; p.ph_hi = N_PHASES;
    hipLaunchKernelGGL(fwd_kernel, dim3(grid), dim3(NTHREADS), LDS_BYTES, stream, p);
#else
    for (int k = 0; k < N_PHASES; ++k) { p.ph_lo = k; p.ph_hi = k + 1; hipLaunchKernelGGL(fwd_kernel, dim3(grid), dim3(NTHREADS), LDS_BYTES, stream, p); }
#endif
}
```

```cpp
#include <hip/hip_runtime.h>
#include <cstdio>
#include <cstdint>

#ifndef REP_PRO
#define REP_PRO 1
#endif
#ifndef REP_ROUTE
#define REP_ROUTE 1
#endif
#ifndef REP_NORM
#define REP_NORM 1
#endif
#ifndef REP_INPROJ
#define REP_INPROJ 1
#endif
#ifndef REP_ATT3
#define REP_ATT3 1
#endif
#ifndef REP_CMP
#define REP_CMP 1
#endif
#ifndef REP_SLC
#define REP_SLC 1
#endif
#ifndef REP_SCAT
#define REP_SCAT 1
#endif
#ifndef REP_G1
#define REP_G1 1
#endif
#ifndef N_LAUNCH_MODE
#define N_LAUNCH_MODE 0
#endif

#define LAS __attribute__((address_space(3)))
#define GAS __attribute__((address_space(1)))
typedef unsigned short bf16;
typedef unsigned long long u64;
typedef float f32x4 __attribute__((ext_vector_type(4)));
typedef unsigned u32x4 __attribute__((ext_vector_type(4)));

constexpr int B_ = 8, T_ = 4096, D_ = 1024, NT = B_ * T_, L_ = 2;
constexpr int HD = 64, D_IN = 2844;
constexpr int N_CMP = 255, CMP_HID = 256;
constexpr int NEXP = 32, DEXP = 256;
constexpr float EPS = 1e-6f;
constexpr float LOG2E = 1.4426950408889634f;
constexpr int NWAVES = 8, NTHREADS = 512;

constexpr int C_NSAQ = 0, C_KV6 = 512, C_GATE = 1280, C_FQ = 1304, C_FF = 2072, C_DQ = 2076, C_DV = 2588;

constexpr size_t MiB = 1u << 20;
constexpr size_t WS_CTL = 0, CTL_BYTES = 1 * MiB;
constexpr size_t WS_QN = 1 * MiB;
constexpr size_t WS_KV6 = WS_QN + 32 * MiB;
constexpr size_t KV6_STRIDE = 8 * MiB + 64 * 1024;
constexpr size_t WS_FQKV = WS_KV6 + 6 * KV6_STRIDE;
constexpr size_t WS_DQK = WS_FQKV + 48 * MiB;
constexpr size_t WS_DV = WS_DQK + 32 * MiB;
constexpr size_t WS_GATE = WS_DV + 16 * MiB;
constexpr size_t WS_FL = WS_GATE + 3 * MiB;
constexpr size_t WS_HC = WS_FL + 1 * MiB;
constexpr size_t WS_KVCMP = WS_HC + 4 * MiB;
constexpr size_t WS_SEL = WS_KVCMP + 1 * MiB;
constexpr size_t WS_OCMP = WS_SEL + 1 * MiB;
constexpr size_t WS_OWIN = WS_OCMP + 32 * MiB;
constexpr size_t WS_HN = WS_OWIN + 32 * MiB;
constexpr size_t WS_ATT = WS_HN + 64 * MiB;
constexpr size_t WS_ROUTE = WS_ATT + 64 * MiB;
constexpr size_t WS_WIN_T = WS_ROUTE + 2 * MiB;
constexpr size_t WS_WOUT_T = WS_WIN_T + 12 * MiB;
constexpr size_t WS_WGU_T = WS_WOUT_T + 4 * MiB;
constexpr size_t WS_WD_T = WS_WGU_T + 64 * MiB;
constexpr size_t WS_W1_T = WS_WD_T + 32 * MiB;
constexpr size_t WS_W2_T = WS_W1_T + 4 * MiB;
constexpr size_t WS_BIAS1 = WS_W2_T + 512 * 1024;
constexpr size_t WS_WR = WS_BIAS1 + 512 * 1024;
constexpr size_t WS_B1PART = WS_WR + 512 * 1024;
constexpr size_t WS_END = WS_B1PART + 512 * 1024;
constexpr int MOE_MAXROWS = 61440;
constexpr size_t WS_XS = WS_QN;
constexpr size_t WS_HB = WS_OCMP;
static_assert(WS_XS + (size_t)MOE_MAXROWS * 2048 <= WS_DQK && WS_HB + (size_t)MOE_MAXROWS * 1024 <= WS_HN, "MoE aliases");
constexpr size_t RT_INFO = 0, RT_W = 128 * 1024, RT_ROWTOK = 384 * 1024, RT_ROWW = 640 * 1024, RT_RSTD = 1152 * 1024;
constexpr int CW_QUEUE = 16384, CW_MOECNT = 32768;
constexpr int TBL_OFF = 131072 + 1024;
constexpr int NIN = 3072;

extern __shared__ __attribute__((aligned(16))) unsigned char lds_raw[];
__device__ __forceinline__ float bf2f(bf16 v) { return __uint_as_float(((unsigned)v) << 16); }
__device__ __forceinline__ unsigned f2bf(float f) { unsigned u = __float_as_uint(f); return (u + 0x7fffu + ((u >> 16) & 1u)) >> 16; }
__device__ __forceinline__ unsigned pk2(float lo, float hi) { return f2bf(lo) | (f2bf(hi) << 16); }
__device__ __forceinline__ float wave_sum(float v) {
#pragma unroll
    for (int o = 1; o < 64; o <<= 1) v += __shfl_xor(v, o);
    return v;
}
__device__ __forceinline__ float wave_max(float v) {
#pragma unroll
    for (int o = 1; o < 64; o <<= 1) v = fmaxf(v, __shfl_xor(v, o));
    return v;
}
__device__ __forceinline__ float shflx_f(float v, int o, int lane) { return __uint_as_float((unsigned)__builtin_amdgcn_ds_bpermute((lane ^ o) << 2, (int)__float_as_uint(v))); }
__device__ __forceinline__ unsigned shflx_u(unsigned v, int o, int lane) { return (unsigned)__builtin_amdgcn_ds_bpermute((lane ^ o) << 2, (int)v); }
__device__ __forceinline__ float wave_sum_l(float v, int lane) {
#pragma unroll
    for (int o = 1; o < 64; o <<= 1) v += shflx_f(v, o, lane);
    return v;
}
__device__ __forceinline__ int launder_s(int v) { asm volatile("" : "+s"(v)); return v; }
__device__ __forceinline__ float sigmoidf_(float x) { return 1.f / (1.f + __expf(-x)); }
__device__ __forceinline__ float log_sigmoidf_(float x) { return x >= 0.f ? -log1pf(__expf(-x)) : x - log1pf(__expf(x)); }
__device__ __forceinline__ float gelu_tanh(float x) { const float u = 0.7978845608028654f * (x + 0.044715f * x * x * x); return 0.5f * x * (1.f + tanhf(u)); }
__device__ __forceinline__ float alibi_slope(int idx1, int n) { return exp2f(-8.0f * (float)idx1 / (float)n); }

#define XB_TMO      128
#define XB_XCNT(j)  (256  + 64 * (j))
#define XB_XSUB(j)  (1280 + 64 * (j))
#define XB_XGEN(j)  (2304 + 64 * (j))
#define XB_TOP      3328
#define XB_TOPGEN   3392
#define XCD_BAR_WORDS 3456
#define XB_SPIN_CAP (1u << 25)
__device__ __forceinline__ unsigned xb_ld(unsigned* p)              { return __hip_atomic_load(p, __ATOMIC_RELAXED, __HIP_MEMORY_SCOPE_AGENT); }
__device__ __forceinline__ unsigned xb_add(unsigned* p, unsigned v) { return __hip_atomic_fetch_add(p, v, __ATOMIC_RELAXED, __HIP_MEMORY_SCOPE_AGENT); }
__device__ __forceinline__ unsigned xb_xcc_id() { return (unsigned)__builtin_amdgcn_s_getreg((3 << 11) | 20) & 0xFu; }
#define XB_SPIN(cond, bar) do { unsigned _sp = 0; while (cond) { __builtin_amdgcn_s_sleep(1); \
    if ((++_sp & 255u) == 0u) { if (xb_ld(&(bar)[XB_TMO])) break; if (_sp > XB_SPIN_CAP) { atomicAdd(&(bar)[XB_TMO], 1u); break; } } } } while (0)
struct XcdBarrier { unsigned* bar; unsigned x; volatile LAS unsigned* st; };
__device__ __forceinline__ XcdBarrier xcd_barrier_post(unsigned* bar, volatile LAS unsigned* st) {
    XcdBarrier b; b.bar = bar; b.x = xb_xcc_id(); b.st = st;
    if (threadIdx.x == 0) (void)xb_add(&bar[XB_XCNT(b.x)], 1u);
    return b;
}
__device__ __forceinline__ void xcd_barrier_complete(unsigned* bar, unsigned x, unsigned& nloc, unsigned& nx) {
    const unsigned G = gridDim.x * gridDim.y * gridDim.z;
    unsigned sum, cnt, mine, sp = 0u;
    for (;;) {
        sum = 0u; cnt = 0u; mine = 0u;
#pragma unroll
        for (unsigned j = 0; j < 16; ++j) { const unsigned c = xb_ld(&bar[XB_XCNT(j)]); sum += c; cnt += (c > 0u) ? 1u : 0u; mine = (j == x) ? c : mine; }
        if (sum == G) break;
        __builtin_amdgcn_s_sleep(1);
        if ((++sp & 255u) == 0u) { if (xb_ld(&bar[XB_TMO])) break; if (sp > XB_SPIN_CAP) { atomicAdd(&bar[XB_TMO], 1u); break; } }
    }
    nloc = mine > 0u ? mine : 1u; nx = cnt > 0u ? cnt : 1u;
}
__device__ __forceinline__ void xcd_barrier(const XcdBarrier& b) {
    asm volatile("s_waitcnt vmcnt(0)" ::: "memory");
    __syncthreads();
    if (threadIdx.x == 0) {
        unsigned* bar = b.bar;
        __builtin_amdgcn_s_waitcnt(0);
        unsigned nloc = b.st[0], nx = b.st[1];
        if (nloc == 0u) { xcd_barrier_complete(bar, b.x, nloc, nx); b.st[0] = nloc; b.st[1] = nx; }
        const unsigned old = xb_add(&bar[XB_XSUB(b.x)], 1u);
        const unsigned gen = old / nloc;
        if (old + 1u == (gen + 1u) * nloc) {
            __builtin_amdgcn_fence(__ATOMIC_RELEASE, "agent");
            asm volatile("s_waitcnt vmcnt(0)" ::: "memory");
            const unsigned og = xb_add(&bar[XB_TOP], 1u);
            const unsigned tg = og / nx;
            if (og + 1u == (tg + 1u) * nx) xb_add(&bar[XB_TOPGEN], 1u);
            else XB_SPIN(xb_ld(&bar[XB_TOPGEN]) == tg, bar);
            __builtin_amdgcn_fence(__ATOMIC_ACQUIRE, "agent");
            xb_add(&bar[XB_XGEN(b.x)], 1u);
            asm volatile("s_waitcnt vmcnt(0)" ::: "memory");
        } else {
            XB_SPIN(xb_ld(&bar[XB_XGEN(b.x)]) == gen, bar);
            __builtin_amdgcn_fence(__ATOMIC_ACQUIRE, "agent");
            asm volatile("s_waitcnt vmcnt(0)" ::: "memory");
        }
    }
    __syncthreads();
}

struct Params { const float* in[23]; float* out; unsigned char* ws; int ph_lo, ph_hi; };
constexpr int LDS_BYTES = 147456;
constexpr int MISC_OFF = 131072 + 320;

struct Ctx {
    LAS unsigned char* lds; int tid, lane, wave, bid, G, gw, ngw;
    const float* const* in; float* xcur; unsigned char* ws;
};

namespace pg8 {
#define PG8_LAS __attribute__((address_space(3)))
typedef unsigned short bf16_t;
typedef short bf16x8 __attribute__((ext_vector_type(8)));
typedef float f32x4 __attribute__((ext_vector_type(4)));
typedef unsigned u32x4 __attribute__((ext_vector_type(4)));
constexpr int BM = 256, BK = 64, HALF = 128, HTB = HALF * BK * 2  , STAGE_BYTES = 8 * HTB, NXCD = 8, WGM = 8;

__host__ __device__ __forceinline__ int lds_byte(int r, int c) { const int st = (r >> 4) * 2 + (c >> 5), rr = r & 15, cc = c & 31, ob = rr * 64 + cc * 2; return st * 1024 + (ob ^ (((ob >> 9) & 1) << 5)); }
__host__ __device__ __forceinline__ void stage_rc(int b, int& R, int& C) { const int st = b / 1024, sb = b % 1024, swz = sb ^ (((sb >> 9) & 1) << 5); R = (st >> 1) * 16 + swz / 64; C = (st & 1) * 32 + (swz % 64) / 2; }
__host__ __device__ __forceinline__ int perm32(int rho) { const int n = rho >> 4, i = rho & 15; return 8 * (i >> 2) + 4 * n + (i & 3); }

struct Unit { int pm, pn; const char* a; const char* b; const char* b2; };
struct Gemm { int lda, ldb, K, ksplit; };

__device__ __forceinline__ unsigned cvt_pk_bf16(float lo, float hi) { unsigned r; asm volatile("v_cvt_pk_bf16_f32 %0, %1, %2" : "=v"(r) : "v"(lo), "v"(hi)); return r; }
typedef float f32x2 __attribute__((ext_vector_type(2)));

template <class Epi, class Sched, bool ALIGN_EPI = false, bool SP2 = false>
__device__ __forceinline__ void gemm_phase(PG8_LAS unsigned char* lds, const Gemm g, const Sched& S, const Epi& E) {
    int tid_ = threadIdx.x; asm volatile("" : "+v"(tid_));
    const int tid = tid_, wid = __builtin_amdgcn_readfirstlane(tid >> 6), lane = tid & 63, wr = wid >> 2, wc = wid & 3, fr = lane & 15, fq = lane >> 4;
    const int K = g.K, nt = K / BK, ks = g.ksplit;
    unsigned voffA[2], voffB[2];
#pragma unroll
    for (int i = 0; i < 2; ++i) { int R, C; stage_rc(tid * 16 + i * 8192, R, C); const int Rb = Epi::PERM ? ((R & ~31) + perm32(R & 31)) : R;
        voffA[i] = (unsigned)(R * g.lda + C) * 2u; voffB[i] = (unsigned)(Rb * g.ldb + C) * 2u; }
    const size_t kstep = (size_t)(BK * 2);
    const size_t hsA = (size_t)HALF * g.lda * 2, hsB = (size_t)HALF * g.ldb * 2;
    const unsigned ldsw = (unsigned)wid * 1024u;
    const int aoff = lds_byte(wr * 64 + fr, fq * 8), boff = lds_byte(wc * 32 + fr, fq * 8);
#define PG8_SA(b, h) (((b) * 2 + (h)) * HTB)
#define PG8_SB(b, h) ((4 + (b) * 2 + (h)) * HTB)
#define PG8_STAGE(bufoff, gbase, voff) do { _Pragma("unroll") for (int _i = 0; _i < 2; ++_i) \
        __builtin_amdgcn_global_load_lds((const unsigned*)((const char*)(gbase) + (voff)[_i]), (PG8_LAS unsigned*)(lds + (bufoff) + ldsw + _i * 8192), 16, 0, 0); } while (0)
#define PG8_LDA(dst, b, h) do { _Pragma("unroll") for (int m = 0; m < 4; ++m) _Pragma("unroll") for (int k = 0; k < 2; ++k) dst[m][k] = *(const PG8_LAS bf16x8*)(lds + PG8_SA(b, h) + aoff + m * 2048 + k * 1024); } while (0)
#define PG8_LDB(dst, b, h) do { _Pragma("unroll") for (int n = 0; n < 2; ++n) _Pragma("unroll") for (int k = 0; k < 2; ++k) dst[n][k] = *(const PG8_LAS bf16x8*)(lds + PG8_SB(b, h) + boff + n * 2048 + k * 1024); } while (0)
#define PG8_MMA(ai, bj, At, Bt) do { __builtin_amdgcn_s_setprio(1); _Pragma("unroll") for (int m = 0; m < 4; ++m) _Pragma("unroll") for (int n = 0; n < 2; ++n) _Pragma("unroll") for (int k = 0; k < 2; ++k) \
        acc[ai][bj][m][n] = __builtin_amdgcn_mfma_f32_16x16x32_bf16(Bt[n][k], At[m][k], acc[ai][bj][m][n], 0, 0, 0); __builtin_amdgcn_s_setprio(0); } while (0)
#define PG8_WAIT_V(n) asm volatile("s_waitcnt vmcnt(" #n ")" ::: "memory")
#define PG8_WAIT_L(n) asm volatile("s_waitcnt lgkmcnt(" #n ")" ::: "memory")
#define PG8_BAR __builtin_amdgcn_s_barrier()
#define PG8_SCHED __builtin_amdgcn_sched_barrier(0)
    Unit cur, nxt; int ui = 0;
    if (!S.next(0, cur)) return;
    f32x4 acc[2][2][4][2];
#pragma unroll
    for (int a = 0; a < 2; ++a)
#pragma unroll
        for (int b = 0; b < 2; ++b)
#pragma unroll
            for (int m = 0; m < 4; ++m)
#pragma unroll
                for (int n = 0; n < 2; ++n) acc[a][b][m][n] = (f32x4){0.f, 0.f, 0.f, 0.f};
    bf16x8 At[4][2], B0[2][2], B1[2][2];
    const char* cA = cur.a; const char* cB = cur.b; const char* cB2 = cur.b2;
#define PG8_BK(base, base2, kt) ((kt) < ks ? (base) + (size_t)(kt) * kstep : (base2) + (size_t)((kt) - ks) * kstep)
    S.a_ready(cur);
    if constexpr (SP2) {
        PG8_STAGE(PG8_SB(0, 0), cB, voffB); PG8_STAGE(PG8_SB(0, 1), cB + hsB, voffB); PG8_STAGE(PG8_SA(0, 0), cA, voffA); PG8_STAGE(PG8_SA(0, 1), cA + hsA, voffA);
        if (wr == 1) PG8_BAR;
        PG8_WAIT_V(2); PG8_BAR;
        PG8_STAGE(PG8_SB(1, 0), PG8_BK(cB, cB2, 1), voffB); PG8_STAGE(PG8_SA(1, 0), cA + kstep, voffA); PG8_STAGE(PG8_SB(1, 1), PG8_BK(cB, cB2, 1) + hsB, voffB);
        PG8_WAIT_V(6); PG8_BAR;
    } else {
        PG8_STAGE(PG8_SB(0, 0), cB, voffB); PG8_STAGE(PG8_SA(0, 0), cA, voffA); PG8_STAGE(PG8_SB(0, 1), cB + hsB, voffB); PG8_STAGE(PG8_SA(0, 1), cA + hsA, voffA);
        if (wr == 1) PG8_BAR;
        PG8_WAIT_V(4); PG8_BAR;
        PG8_STAGE(PG8_SB(1, 0), PG8_BK(cB, cB2, 1), voffB); PG8_STAGE(PG8_SA(1, 0), cA + kstep, voffA); PG8_STAGE(PG8_SB(1, 1), PG8_BK(cB, cB2, 1) + hsB, voffB);
        PG8_WAIT_V(6); PG8_BAR;
    }
    for (;;) {
        const bool has_next = S.next(ui + 1, nxt);
        const char* nA = has_next ? nxt.a : cA; const char* nB = has_next ? nxt.b : cB; const char* nB2 = has_next ? nxt.b2 : cB2;
#pragma unroll 1
        for (int t = 0; t < nt; t += 2) {
            const bool last = (t == nt - 2);
            const char* a1 = cA + (size_t)(t + 1) * kstep;
            const char* a2 = last ? nA : cA + (size_t)(t + 2) * kstep; const char* b2 = last ? PG8_BK(nB, nB2, 0) : PG8_BK(cB, cB2, t + 2);
            const char* a3 = a2 + kstep; const char* b3 = last ? PG8_BK(nB, nB2, 1) : PG8_BK(cB, cB2, t + 3);
            if (last && has_next) S.a_ready(nxt);
            if constexpr (SP2) {
            PG8_LDB(B0, 0, 0); PG8_LDB(B1, 0, 1); PG8_SCHED; PG8_LDA(At, 0, 0); PG8_STAGE(PG8_SA(1, 1), a1 + hsA, voffA);
            PG8_WAIT_V(8); PG8_WAIT_L(0); PG8_BAR; PG8_MMA(0, 0, At, B0); PG8_MMA(0, 1, At, B1); PG8_BAR; PG8_SCHED;
            PG8_LDA(At, 0, 1); PG8_STAGE(PG8_SB(0, 0), b2, voffB); PG8_STAGE(PG8_SB(0, 1), b2 + hsB, voffB); PG8_STAGE(PG8_SA(0, 0), a2, voffA);
            PG8_WAIT_V(8); PG8_WAIT_L(0); PG8_BAR; PG8_MMA(1, 0, At, B0); PG8_MMA(1, 1, At, B1); PG8_BAR; PG8_SCHED;
            PG8_LDB(B0, 1, 0); PG8_LDB(B1, 1, 1); PG8_SCHED; PG8_LDA(At, 1, 0); PG8_STAGE(PG8_SA(0, 1), a2 + hsA, voffA);
            PG8_WAIT_V(8); PG8_WAIT_L(0); PG8_BAR; PG8_MMA(0, 0, At, B0); PG8_MMA(0, 1, At, B1); PG8_BAR; PG8_SCHED;
            PG8_LDA(At, 1, 1); PG8_STAGE(PG8_SB(1, 0), b3, voffB); PG8_STAGE(PG8_SB(1, 1), b3 + hsB, voffB); PG8_STAGE(PG8_SA(1, 0), a3, voffA);
            PG8_WAIT_V(8); PG8_WAIT_L(0); PG8_BAR; PG8_MMA(1, 0, At, B0); PG8_MMA(1, 1, At, B1); PG8_BAR; PG8_SCHED;
            } else {
            PG8_LDB(B0, 0, 0); PG8_SCHED; PG8_LDA(At, 0, 0); PG8_STAGE(PG8_SA(1, 1), a1 + hsA, voffA);
            PG8_WAIT_L(8); PG8_BAR; PG8_WAIT_L(0); PG8_MMA(0, 0, At, B0); PG8_BAR; PG8_SCHED;
            PG8_LDB(B1, 0, 1); PG8_STAGE(PG8_SB(0, 0), b2, voffB);
            PG8_BAR; PG8_WAIT_L(0); PG8_MMA(0, 1, At, B1); PG8_BAR;
            PG8_LDA(At, 0, 1); PG8_STAGE(PG8_SA(0, 0), a2, voffA);
            PG8_BAR; PG8_WAIT_L(0); PG8_MMA(1, 0, At, B0); PG8_BAR; PG8_SCHED;
            PG8_STAGE(PG8_SB(0, 1), b2 + hsB, voffB);
            PG8_WAIT_V(6); PG8_BAR; PG8_MMA(1, 1, At, B1); PG8_BAR;
            PG8_LDB(B0, 1, 0); PG8_SCHED; PG8_LDA(At, 1, 0); PG8_STAGE(PG8_SA(0, 1), a2 + hsA, voffA);
            PG8_WAIT_L(8); PG8_BAR; PG8_WAIT_L(0); PG8_MMA(0, 0, At, B0); PG8_BAR; PG8_SCHED;
            PG8_LDB(B1, 1, 1); PG8_STAGE(PG8_SB(1, 0), b3, voffB);
            PG8_BAR; PG8_WAIT_L(0); PG8_MMA(0, 1, At, B1); PG8_BAR;
            PG8_LDA(At, 1, 1); PG8_STAGE(PG8_SA(1, 0), a3, voffA);
            PG8_BAR; PG8_WAIT_L(0); PG8_MMA(1, 0, At, B0); PG8_BAR; PG8_SCHED;
            PG8_STAGE(PG8_SB(1, 1), b3 + hsB, voffB);
            PG8_WAIT_V(6); PG8_BAR; PG8_MMA(1, 1, At, B1); PG8_BAR;
            }
        }
        if constexpr (ALIGN_EPI) { if (wr == 0) PG8_BAR; }
        if constexpr (!Epi::AFTER_DRAIN) { E(acc, cur, wr, wc, fr, fq); S.done(cur); }
        if (!has_next) break;
#pragma unroll
        for (int a = 0; a < 2; ++a)
#pragma unroll
            for (int b = 0; b < 2; ++b)
#pragma unroll
                for (int m = 0; m < 4; ++m)
#pragma unroll
                    for (int n = 0; n < 2; ++n) acc[a][b][m][n] = (f32x4){0.f, 0.f, 0.f, 0.f};
        cur = nxt; cA = nA; cB = nB; cB2 = nB2; ++ui;
        if constexpr (ALIGN_EPI) { if (wr == 1) PG8_BAR; }
    }
    PG8_WAIT_V(0);
    if constexpr (!ALIGN_EPI) { if (wr == 0) PG8_BAR; }
    PG8_BAR;
    if constexpr (Epi::AFTER_DRAIN) { E.fused(acc, cur, wr, wc, fr, fq, lds, wid, lane); S.done(cur); }
#undef PG8_BK
#undef PG8_SA
#undef PG8_SB
#undef PG8_STAGE
#undef PG8_LDA
#undef PG8_LDB
#undef PG8_MMA
#undef PG8_WAIT_V
#undef PG8_WAIT_L
#undef PG8_BAR
#undef PG8_SCHED
}
}

struct PlainOrder {
    const char* A; const char* Bt; int lda, ldb, nM, nN, nwg, G, c;
    __device__ __forceinline__ void init(const void* A_, const void* Bt_, int lda_, int ldb_, int M, int N, int G_, int c_) { A = (const char*)A_; Bt = (const char*)Bt_; lda = lda_; ldb = ldb_; nM = M / 256; nN = N / 256; nwg = nM * nN; G = G_; c = c_; }
    __device__ __forceinline__ bool next(int i, pg8::Unit& u) const {
        const long L = (long)i * G + c; if (L >= nwg) return false;
        int wgid = (int)L; { const int q = nwg / 8, r = nwg % 8, xcd = wgid % 8, off = wgid / 8; wgid = (xcd < r ? xcd * (q + 1) : r * (q + 1) + (xcd - r) * q) + off; }
        const int nig = 8 * nN, gid = wgid / nig, fm = gid * 8, gsz = (nM - fm) < 8 ? (nM - fm) : 8;
        u.pm = fm + ((wgid % nig) % gsz); u.pn = (wgid % nig) / gsz;
        u.a = A + (size_t)u.pm * 256 * lda * 2; u.b = Bt + (size_t)u.pn * 256 * ldb * 2; u.b2 = u.b; return true;
    }
    __device__ __forceinline__ void a_ready(const pg8::Unit&) const {}
    __device__ __forceinline__ void done(const pg8::Unit&) const {}
};
struct EpiInProj {
    static constexpr bool PERM = true, AFTER_DRAIN = false;
    unsigned char* ws; const float* b_gate; const float* b_fgt;
    __device__ __forceinline__ void operator()(const pg8::f32x4 (&acc)[2][2][4][2], const pg8::Unit& u, int wr, int wc, int fr, int fq) const {
        { int t_ = threadIdx.x; asm volatile("" : "+v"(t_)); fr = t_ & 15; fq = (t_ >> 4) & 3; }
        const int pn = u.pn, b = (u.pm * 256) / T_, t0 = u.pm * 256 - b * T_ + wr * 64 + fr;
        if (pn == 11) {
            if (wc == 0 && fq < 4) {
                float* gate = (float*)(ws + WS_GATE); float* fl = (float*)(ws + WS_FL);
#pragma unroll
                for (int ai = 0; ai < 2; ++ai)
#pragma unroll
                    for (int m = 0; m < 4; ++m) { const int t = t0 + ai * 128 + m * 16; const size_t n = (size_t)b * T_ + t;
#pragma unroll
                        for (int nn = 0; nn < 2; ++nn)
#pragma unroll
                            for (int e = 0; e < 4; ++e) { const int c = 8 * fq + 4 * nn + e; const float v = acc[ai][0][m][nn][e];
                                if (c < 24) gate[n * 24 + c] = sigmoidf_(v + b_gate[c]);
                                else if (c < 28) fl[(size_t)(b * 4 + (c - 24)) * T_ + t] = log_sigmoidf_(v + b_fgt[c - 24]); } }
            }
            return;
        }
#pragma unroll
        for (int bj = 0; bj < 2; ++bj) {
            const int c = bj * 128 + wc * 32 + 8 * fq;
            bf16* base; int W = 64; float sc = 1.f;
            if (pn < 2) { base = (bf16*)(ws + WS_QN) + (size_t)(b * 8 + pn * 4 + (c >> 6)) * T_ * 64 + (c & 63); sc = 0.125f * LOG2E; }
            else if (pn < 5) { base = (bf16*)(ws + WS_KV6 + (size_t)((pn - 2) * 2 + (c >> 7)) * KV6_STRIDE) + (size_t)(b * 2 + ((c >> 6) & 1)) * T_ * 64 + (c & 63); }
            else if (pn < 8) { base = (bf16*)(ws + WS_FQKV) + (size_t)(pn - 5) * (8 * MiB) + (size_t)(b * 4 + (c >> 6)) * T_ * 64 + (c & 63); if (pn == 5) sc = 0.125f * LOG2E; }
            else if (pn < 10) { base = (bf16*)(ws + WS_DQK) + (size_t)(pn - 8) * (8 * MiB) + (size_t)(b * 8 + (c >> 5)) * T_ * 32 + (c & 31); W = 32; if (pn == 8) sc = 0.17677669529663687f * LOG2E; }
            else { base = (bf16*)(ws + WS_DV) + (size_t)(b * 4 + (c >> 6)) * T_ * 64 + (c & 63); }
#pragma unroll
            for (int ai = 0; ai < 2; ++ai)
#pragma unroll
                for (int m = 0; m < 4; ++m) { const int t = t0 + ai * 128 + m * 16;
                    const pg8::f32x4 v0 = acc[ai][bj][m][0] * sc, v1 = acc[ai][bj][m][1] * sc;
                    pg8::u32x4 w; w.x = pg8::cvt_pk_bf16(v0[0], v0[1]); w.y = pg8::cvt_pk_bf16(v0[2], v0[3]); w.z = pg8::cvt_pk_bf16(v1[0], v1[1]); w.w = pg8::cvt_pk_bf16(v1[2], v1[3]);
                    *(pg8::u32x4*)(base + (size_t)t * W) = w; }
        }
    }
};
struct EpiResF32 {
    static constexpr bool PERM = false, AFTER_DRAIN = false;
    const float* base; float* out;
    __device__ __forceinline__ void operator()(const pg8::f32x4 (&acc)[2][2][4][2], const pg8::Unit& u, int wr, int wc, int fr, int fq) const {
        { int t_ = threadIdx.x; asm volatile("" : "+v"(t_)); fr = t_ & 15; fq = (t_ >> 4) & 3; }
#pragma unroll
        for (int ai = 0; ai < 2; ++ai)
#pragma unroll
            for (int m = 0; m < 4; ++m) { const size_t off = (size_t)(u.pm * 256 + ai * 128 + wr * 64 + m * 16 + fr) * D_ + u.pn * 256 + wc * 32 + 4 * fq;
#pragma unroll
                for (int bj = 0; bj < 2; ++bj)
#pragma unroll
                    for (int n = 0; n < 2; ++n) { const pg8::f32x4 bs = *(const pg8::f32x4*)(base + off + bj * 128 + n * 16); *(pg8::f32x4*)(out + off + bj * 128 + n * 16) = bs + acc[ai][bj][m][n]; } }
    }
};

struct OneUnitOrder { pg8::Unit u; bool has;
    __device__ __forceinline__ bool next(int i, pg8::Unit& o) const { if (i != 0 || !has) return false; o = u; return true; }
    __device__ __forceinline__ void a_ready(const pg8::Unit&) const {}
    __device__ __forceinline__ void done(const pg8::Unit&) const {} };
__device__ __forceinline__ float gelu_tanh_fast(float x) { const float u2 = 1.5957691216057308f * (x + 0.044715f * x * x * x); return x * __builtin_amdgcn_rcpf(1.f + __builtin_amdgcn_exp2f(-u2 * LOG2E)); }
struct EpiCmpH {
    static constexpr bool PERM = true, AFTER_DRAIN = false;
    bf16* hc; const float* bias1;
    __device__ __forceinline__ void operator()(const pg8::f32x4 (&acc)[2][2][4][2], const pg8::Unit& u, int wr, int wc, int fr, int fq) const {
        { int t_ = threadIdx.x; asm volatile("" : "+v"(t_)); fr = t_ & 15; fq = (t_ >> 4) & 3; }
        const int kv = u.pn;
#pragma unroll
        for (int bj = 0; bj < 2; ++bj) { const int col = bj * 128 + wc * 32 + 8 * fq;
            const pg8::f32x4 b0 = *(const pg8::f32x4*)(bias1 + kv * 256 + col), b1 = *(const pg8::f32x4*)(bias1 + kv * 256 + col + 4);
#pragma unroll
            for (int ai = 0; ai < 2; ++ai)
#pragma unroll
                for (int m = 0; m < 4; ++m) { const int row = u.pm * 256 + ai * 128 + wr * 64 + m * 16 + fr;
                    const pg8::f32x4 v0 = acc[ai][bj][m][0] + b0, v1 = acc[ai][bj][m][1] + b1;
                    pg8::u32x4 w; w.x = pg8::cvt_pk_bf16(gelu_tanh_fast(v0[0]), gelu_tanh_fast(v0[1])); w.y = pg8::cvt_pk_bf16(gelu_tanh_fast(v0[2]), gelu_tanh_fast(v0[3]));
                    w.z = pg8::cvt_pk_bf16(gelu_tanh_fast(v1[0]), gelu_tanh_fast(v1[1])); w.w = pg8::cvt_pk_bf16(gelu_tanh_fast(v1[2]), gelu_tanh_fast(v1[3]));
                    *(pg8::u32x4*)(hc + ((size_t)kv * 4096 + row) * 256 + col) = w; } }
    }
};
struct EpiCmpOut {
    static constexpr bool PERM = true, AFTER_DRAIN = false;
    bf16* kvcmp;
    __device__ __forceinline__ void operator()(const pg8::f32x4 (&acc)[2][2][4][2], const pg8::Unit& u, int wr, int wc, int fr, int fq) const {
        { int t_ = threadIdx.x; asm volatile("" : "+v"(t_)); fr = t_ & 15; fq = (t_ >> 4) & 3; }
        if (wc >= 2) return;
        const int kv = u.pn, col = wc * 32 + 8 * fq;
#pragma unroll
        for (int ai = 0; ai < 2; ++ai)
#pragma unroll
            for (int m = 0; m < 4; ++m) { const int row = u.pm * 256 + ai * 128 + wr * 64 + m * 16 + fr; const float z = ((row & 255) == 255) ? 0.f : 1.f;
                const pg8::f32x4 v0 = acc[ai][0][m][0], v1 = acc[ai][0][m][1];
                pg8::u32x4 w; w.x = pg8::cvt_pk_bf16(z != 0.f ? v0[0] : 0.f, z != 0.f ? v0[1] : 0.f); w.y = pg8::cvt_pk_bf16(z != 0.f ? v0[2] : 0.f, z != 0.f ? v0[3] : 0.f);
                w.z = pg8::cvt_pk_bf16(z != 0.f ? v1[0] : 0.f, z != 0.f ? v1[1] : 0.f); w.w = pg8::cvt_pk_bf16(z != 0.f ? v1[2] : 0.f, z != 0.f ? v1[3] : 0.f);
                *(pg8::u32x4*)(kvcmp + ((size_t)kv * 4096 + row) * 64 + col) = w; }
    }
};

__device__ __forceinline__ void moe_build_tables(const unsigned* cnt, int tid) {
    LAS int* T = (LAS int*)((LAS unsigned char*)lds_raw + TBL_OFF);
    __syncthreads();
    if (tid < 112) T[128 + 256 + tid] = (int)((cnt[tid] + 255u) >> 8);
    __syncthreads();
    if (tid == 0) { int o = 0; for (int c = 0; c < 112; ++c) { T[c] = o; const int n = T[128 + 256 + c]; for (int k = 0; k < n; ++k) T[128 + o + k] = c; o += n; } T[112] = o; }
    __syncthreads();
}
__device__ __forceinline__ void moe_pair(int cls, int& ea, int& eb) { const int grp = cls / 28; int idx = cls % 28, lo = 0; while (idx >= 7 - lo) { idx -= 7 - lo; ++lo; } ea = grp * 8 + lo; eb = grp * 8 + lo + 1 + idx; }
struct MoeOrder1 {
    const char* xs; const char* wgu; int G, c;
    __device__ __forceinline__ bool next(int i, pg8::Unit& u) const {
        const LAS int* T = (const LAS int*)((LAS unsigned char*)lds_raw + TBL_OFF);
        const int idx = i * G + c; if (idx >= 4 * T[112]) return false;
        const int tile = idx >> 2, pn = idx & 3; int ea, eb; moe_pair(T[128 + tile], ea, eb); const int e = (pn >> 1) ? eb : ea;
        u.pm = tile; u.pn = pn; u.a = xs + (size_t)tile * 256 * 2048; u.b = wgu + ((size_t)e * 512 + (pn & 1) * 256) * 2048; u.b2 = u.b; return true; }
    __device__ __forceinline__ void a_ready(const pg8::Unit&) const {}
    __device__ __forceinline__ void done(const pg8::Unit&) const {} };
struct MoeOrder2 {
    const char* hb; const char* wd; int G, c;
    __device__ __forceinline__ bool next(int i, pg8::Unit& u) const {
        const LAS int* T = (const LAS int*)((LAS unsigned char*)lds_raw + TBL_OFF);
        const int idx = i * G + c; if (idx >= 4 * T[112]) return false;
        const int tile = idx >> 2, pn = idx & 3; int ea, eb; moe_pair(T[128 + tile], ea, eb);
        u.pm = tile; u.pn = pn; u.a = hb + (size_t)tile * 256 * 1024; u.b = wd + ((size_t)ea * 1024 + pn * 256) * 512; u.b2 = wd + ((size_t)eb * 1024 + pn * 256) * 512; return true; }
    __device__ __forceinline__ void a_ready(const pg8::Unit&) const {}
    __device__ __forceinline__ void done(const pg8::Unit&) const {} };
struct EpiMoeH {
    static constexpr bool PERM = true, AFTER_DRAIN = false;
    bf16* hb; const float* roww;
    __device__ __forceinline__ void operator()(const pg8::f32x4 (&acc)[2][2][4][2], const pg8::Unit& u, int wr, int wc, int fr, int fq) const {
        { int t_ = threadIdx.x; asm volatile("" : "+v"(t_)); fr = t_ & 15; fq = (t_ >> 4) & 3; }
        const int slot = u.pn >> 1;
#pragma unroll
        for (int ai = 0; ai < 2; ++ai)
#pragma unroll
            for (int m = 0; m < 4; ++m) { const size_t row = (size_t)u.pm * 256 + ai * 128 + wr * 64 + m * 16 + fr; const float w = roww[row * 2 + slot];
#pragma unroll
                for (int bj = 0; bj < 2; ++bj) { const int j0 = (u.pn & 1) * 128 + (bj * 128 + wc * 32 + 8 * fq) / 2;
                    const pg8::f32x4 v0 = acc[ai][bj][m][0], v1 = acc[ai][bj][m][1];
                    const float h0 = v0[0] * __builtin_amdgcn_rcpf(1.f + __builtin_amdgcn_exp2f(-v0[0] * LOG2E)) * v0[1] * w, h1 = v0[2] * __builtin_amdgcn_rcpf(1.f + __builtin_amdgcn_exp2f(-v0[2] * LOG2E)) * v0[3] * w;
                    const float h2 = v1[0] * __builtin_amdgcn_rcpf(1.f + __builtin_amdgcn_exp2f(-v1[0] * LOG2E)) * v1[1] * w, h3 = v1[2] * __builtin_amdgcn_rcpf(1.f + __builtin_amdgcn_exp2f(-v1[2] * LOG2E)) * v1[3] * w;
                    *(u64*)(hb + row * 512 + slot * 256 + j0) = (u64)pg8::cvt_pk_bf16(h0, h1) | ((u64)pg8::cvt_pk_bf16(h2, h3) << 32); } }
    }
};
struct EpiMoeOut {
    static constexpr bool PERM = false, AFTER_DRAIN = false;
    float* x; const int* rowtok;
    __device__ __forceinline__ void operator()(const pg8::f32x4 (&acc)[2][2][4][2], const pg8::Unit& u, int wr, int wc, int fr, int fq) const {
        { int t_ = threadIdx.x; asm volatile("" : "+v"(t_)); fr = t_ & 15; fq = (t_ >> 4) & 3; }
        float* xx = x; const int* rt = rowtok; asm volatile("" : "+s"(xx), "+s"(rt));
#pragma unroll
        for (int ai = 0; ai < 2; ++ai)
#pragma unroll
            for (int m = 0; m < 4; ++m) { const int tok = rt[(size_t)u.pm * 256 + ai * 128 + wr * 64 + m * 16 + fr];
                if (tok >= 0) { float* xr = xx + (size_t)tok * D_ + u.pn * 256 + wc * 32 + 4 * fq;
#pragma unroll
                    for (int bj = 0; bj < 2; ++bj)
#pragma unroll
                        for (int n = 0; n < 2; ++n) { pg8::f32x4* q = (pg8::f32x4*)(xr + bj * 128 + n * 16); *q = *q + acc[ai][bj][m][n]; } } }
    }
};

__device__ __forceinline__ void transpose_item(const float* W, int ldw, bf16* WT, int ldt, int r0, int rmul, int k0, LAS float* scr, int lane) {
    f32x4 v[8];
#pragma unroll
    for (int i = 0; i < 8; ++i) v[i] = *(const f32x4*)(W + (size_t)(k0 + i * 8 + (lane >> 3)) * ldw + (lane & 7) * 4);
#pragma unroll
    for (int i = 0; i < 8; ++i) { LAS float* d = scr + (i * 8 + (lane >> 3)) * 33 + (lane & 7) * 4; d[0] = v[i].x; d[1] = v[i].y; d[2] = v[i].z; d[3] = v[i].w; }
    asm volatile("s_waitcnt lgkmcnt(0)" ::: "memory");
    const int c = lane & 7;
#pragma unroll
    for (int j = 0; j < 4; ++j) { const int n = (lane >> 3) + 8 * j; const LAS float* sp = scr + (8 * c) * 33 + n;
        u32x4 o; o.x = pk2(sp[0 * 33], sp[1 * 33]); o.y = pk2(sp[2 * 33], sp[3 * 33]); o.z = pk2(sp[4 * 33], sp[5 * 33]); o.w = pk2(sp[6 * 33], sp[7 * 33]);
        *(u32x4*)(WT + (size_t)(r0 + rmul * n) * ldt + k0 + 8 * c) = o; }
    asm volatile("s_waitcnt lgkmcnt(0)" ::: "memory");
}
__device__ __forceinline__ void transpose_seg(const float* W, int ldw, int K, int sc0, int ncol, bf16* WT, int r0, int rmul, int item, LAS float* scr, int lane) {
    const int nb = ncol / 32, kb = item / nb, cb = item % nb;
    transpose_item(W + sc0 + cb * 32, ldw, WT, K, r0 + rmul * cb * 32, rmul, kb * 64, scr, lane);
}

typedef float f32x16 __attribute__((ext_vector_type(16)));
typedef short bf16x8v __attribute__((ext_vector_type(8)));
typedef short s16x4 __attribute__((ext_vector_type(4)));
typedef float f32x2_t __attribute__((ext_vector_type(2)));
typedef __bf16 bf16x2_t __attribute__((ext_vector_type(2)));
constexpr int A_KBUF = 10240, A_VBUF = 9216;
constexpr int A_KOFF = 0, A_VOFF = 2 * A_KBUF, A_BOFF = A_VOFF + 2 * A_VBUF, A_LDS_END = A_BOFF + 2 * 256;
__device__ __forceinline__ constexpr int crow0(int reg) { return (reg & 3) + 8 * (reg >> 2); }
__device__ __forceinline__ float swap_max(float m) { auto rr = __builtin_amdgcn_permlane32_swap(__float_as_uint(m), __float_as_uint(m), false, false); return fmaxf(__uint_as_float(rr[0]), __uint_as_float(rr[1])); }
__device__ __forceinline__ float swap_sum(float m) { auto rr = __builtin_amdgcn_permlane32_swap(__float_as_uint(m), __float_as_uint(m), false, false); return __uint_as_float(rr[0]) + __uint_as_float(rr[1]); }
__device__ __forceinline__ unsigned cvtpk(float lo, float hi) { f32x2_t v = {lo, hi}; bf16x2_t b = __builtin_convertvector(v, bf16x2_t); return __builtin_bit_cast(unsigned, b); }
__device__ __forceinline__ bf16x8v pack8(const f32x16& p, int b0) { u32x4 w; w.x = cvtpk(p[b0 + 0], p[b0 + 1]); w.y = cvtpk(p[b0 + 2], p[b0 + 3]); w.z = cvtpk(p[b0 + 4], p[b0 + 5]); w.w = cvtpk(p[b0 + 6], p[b0 + 7]); return __builtin_bit_cast(bf16x8v, w); }
__device__ __forceinline__ s16x4 tr_read(const LAS unsigned char* p) { typedef short v4i16_t __attribute__((ext_vector_type(4))); return __builtin_bit_cast(s16x4, __builtin_amdgcn_ds_read_tr16_b64_v4i16((LAS v4i16_t*)p)); }

template <int DQK, int NMAP, bool FOX, bool SLC>
__device__ __forceinline__ void attn_core(LAS unsigned char* L, const bf16* Kb0, const bf16* Kb1, const bf16* Vb, const LAS float* cum, float cum_ref,
                                          const bf16x8v (&Qf)[NMAP][DQK / 16], u64 tilemask, int t_lane, int tw0, int win, float slope2, unsigned selw0, unsigned selw1,
                                          f32x16 (&O)[NMAP][2], float (&M)[NMAP], float (&Ls)[NMAP], int tid) {
    constexpr int KP = DQK * 2 + 16;
    const int lane = tid & 63, r = lane & 31, h = lane >> 5;
    int kdst; const bf16* ksrc;
    if (DQK == 64) { kdst = (tid >> 3) * KP + (tid & 7) * 16; ksrc = Kb0 + (tid >> 3) * 64 + (tid & 7) * 8; }
    else { const int mp = tid >> 8, tt = tid & 255; kdst = mp * 5120 + (tt >> 2) * KP + (tt & 3) * 16; ksrc = (mp ? Kb1 : Kb0) + (tt >> 2) * 32 + (tt & 3) * 8; }
    const int vdst = (tid >> 3) * 144 + (tid & 7) * 16; const bf16* vsrc = Vb + (tid >> 3) * 64 + (tid & 7) * 8;
    const LAS unsigned char* kfrag = L + A_KOFF + r * KP + h * 16;
    const LAS unsigned char* vfrag = L + A_VOFF + (4 * h + ((lane & 15) >> 2)) * 144 + (16 * ((lane >> 4) & 1) + 4 * (lane & 3)) * 2;
    u32x4 kreg, vreg; float breg = 0.f;
    u64 mk = tilemask;
    int j = 63 - __builtin_clzll(mk); mk &= ~(1ull << j);
    { const int kv0 = j * 64; kreg = *(const u32x4*)(ksrc + (size_t)kv0 * DQK); vreg = *(const u32x4*)(vsrc + (size_t)kv0 * 64); if (FOX && tid < 64) breg = (cum_ref - cum[kv0 + tid]) * LOG2E; }
    *(LAS u32x4*)(L + A_KOFF + kdst) = kreg; *(LAS u32x4*)(L + A_VOFF + vdst) = vreg; if (FOX && tid < 64) *(LAS float*)(L + A_BOFF + tid * 4) = breg;
    __syncthreads();
    int buf = 0;
    for (;;) {
        const bool more = mk != 0ull; int jn = 0;
        if (more) { jn = 63 - __builtin_clzll(mk); mk &= ~(1ull << jn); const int kv0 = jn * 64;
            kreg = *(const u32x4*)(ksrc + (size_t)kv0 * DQK); vreg = *(const u32x4*)(vsrc + (size_t)kv0 * 64); if (FOX && tid < 64) breg = (cum_ref - cum[kv0 + tid]) * LOG2E; }
        { const int kv0 = j * 64;
          if (!(kv0 > tw0 + 31) && !(tw0 - (kv0 + 63) >= win)) {
            const bool need_mask = (kv0 + 63 > tw0) || (tw0 + 31 - kv0 >= win);
            const int dl = t_lane - kv0 - 4 * h;
            bool sel = true; if (SLC) sel = (j < 32 ? (selw0 >> j) : (selw1 >> (j - 32))) & 1u;
            bf16x8v pa[NMAP][4];
#pragma unroll
            for (int mp = 0; mp < NMAP; ++mp) {
                f32x16 p0, p1;
                if (FOX) { const LAS f32x4* bl = (const LAS f32x4*)(L + A_BOFF + buf * 256) + h;
#pragma unroll
                    for (int g4 = 0; g4 < 4; ++g4) { const f32x4 b0 = bl[2 * g4], b1 = bl[8 + 2 * g4];
                        p0[4 * g4 + 0] = b0.x; p0[4 * g4 + 1] = b0.y; p0[4 * g4 + 2] = b0.z; p0[4 * g4 + 3] = b0.w; p1[4 * g4 + 0] = b1.x; p1[4 * g4 + 1] = b1.y; p1[4 * g4 + 2] = b1.z; p1[4 * g4 + 3] = b1.w; } }
                else { const float base_l = slope2 * (float)(kv0 + 4 * h - tw0), s8 = slope2 * 8.f, s32 = slope2 * 32.f;
                    p0[0] = base_l; p0[1] = p0[0] + slope2; p0[2] = p0[1] + slope2; p0[3] = p0[2] + slope2;
#pragma unroll
                    for (int reg = 4; reg < 16; ++reg) p0[reg] = p0[reg - 4] + s8;
#pragma unroll
                    for (int reg = 0; reg < 16; ++reg) p1[reg] = p0[reg] + s32; }
                const LAS unsigned char* kb = kfrag + buf * A_KBUF + (DQK == 32 ? mp * 5120 : 0);
#pragma unroll
                for (int s = 0; s < DQK / 16; ++s) { const bf16x8v kf0 = *(const LAS bf16x8v*)(kb + s * 32), kf1 = *(const LAS bf16x8v*)(kb + 32 * KP + s * 32);
                    p0 = __builtin_amdgcn_mfma_f32_32x32x16_bf16(kf0, Qf[mp][s], p0, 0, 0, 0); p1 = __builtin_amdgcn_mfma_f32_32x32x16_bf16(kf1, Qf[mp][s], p1, 0, 0, 0); }
                if (need_mask) {
#pragma unroll
                    for (int reg = 0; reg < 16; ++reg) { const int d0 = dl - crow0(reg), d1 = d0 - 32;
                        p0[reg] = (d0 >= 0 && d0 < win) ? p0[reg] : -INFINITY; p1[reg] = (d1 >= 0 && d1 < win) ? p1[reg] : -INFINITY; } }
                float mt = fmaxf(p0[0], p1[0]);
#pragma unroll
                for (int reg = 1; reg < 16; ++reg) mt = fmaxf(mt, fmaxf(p0[reg], p1[reg]));
                mt = swap_max(mt); if (SLC && !sel) mt = -INFINITY;
                if (__any(mt > M[mp] + 8.f)) { const float mn = fmaxf(M[mp], mt), alpha = __builtin_amdgcn_exp2f(M[mp] - mn); O[mp][0] *= alpha; O[mp][1] *= alpha; Ls[mp] *= alpha; M[mp] = mn; }
                const float ms = (SLC && !sel) ? INFINITY : M[mp];
                float rs = 0.f;
#pragma unroll
                for (int reg = 0; reg < 16; ++reg) { p0[reg] = __builtin_amdgcn_exp2f(p0[reg] - ms); p1[reg] = __builtin_amdgcn_exp2f(p1[reg] - ms); rs += p0[reg] + p1[reg]; }
                Ls[mp] += rs;
                pa[mp][0] = pack8(p0, 0); pa[mp][1] = pack8(p0, 8); pa[mp][2] = pack8(p1, 0); pa[mp][3] = pack8(p1, 8);
            }
            const LAS unsigned char* vb = vfrag + buf * A_VBUF;
#pragma unroll
            for (int db = 0; db < 2; ++db)
#pragma unroll
                for (int ks = 0; ks < 4; ++ks) { const s16x4 lo = tr_read(vb + ks * (16 * 144) + db * 64), hi = tr_read(vb + ks * (16 * 144) + db * 64 + 8 * 144);
                    const bf16x8v vf = {lo[0], lo[1], lo[2], lo[3], hi[0], hi[1], hi[2], hi[3]};
#pragma unroll
                    for (int mp = 0; mp < NMAP; ++mp) O[mp][db] = __builtin_amdgcn_mfma_f32_32x32x16_bf16(vf, pa[mp][ks], O[mp][db], 0, 0, 0); }
          } }
        if (more) { *(LAS u32x4*)(L + A_KOFF + (buf ^ 1) * A_KBUF + kdst) = kreg; *(LAS u32x4*)(L + A_VOFF + (buf ^ 1) * A_VBUF + vdst) = vreg; if (FOX && tid < 64) *(LAS float*)(L + A_BOFF + (buf ^ 1) * 256 + tid * 4) = breg; }
        __syncthreads();
        if (!more) break;
        j = jn; buf ^= 1;
    }
}
#define ATTN_FOR_CHUNKS(db, g4) _Pragma("unroll") for (int db = 0; db < 2; ++db) _Pragma("unroll") for (int g4 = 0; g4 < 4; ++g4)

__device__ __forceinline__ void ph_norm_bf16(const Ctx& c, const float* x, const float* g, bf16* out) {
    for (int row = c.gw; row < NT; row += c.ngw) {
        const f32x4* xr = (const f32x4*)(x + (size_t)row * D_) + c.lane;
        f32x4 v[4]; float ss = 0.f;
#pragma unroll
        for (int j = 0; j < 4; ++j) { v[j] = xr[64 * j]; ss += v[j].x * v[j].x + v[j].y * v[j].y + v[j].z * v[j].z + v[j].w * v[j].w; }
        const float r = rsqrtf(wave_sum(ss) * (1.f / D_) + EPS);
        u64* o8 = (u64*)(out + (size_t)row * D_) + c.lane;
#pragma unroll
        for (int j = 0; j < 4; ++j) { const f32x4 gg = ((const f32x4*)g)[c.lane + 64 * j];
            o8[64 * j] = (u64)pk2(v[j].x * r * gg.x, v[j].y * r * gg.y) | ((u64)pk2(v[j].z * r * gg.z, v[j].w * r * gg.w) << 32); }
    }
}
__device__ __forceinline__ void ph_norm_final(const Ctx& c, float* x, const float* g) {
    for (int row = c.gw; row < NT; row += c.ngw) {
        f32x4* xr = (f32x4*)(x + (size_t)row * D_) + c.lane;
        f32x4 v[4]; float ss = 0.f;
#pragma unroll
        for (int j = 0; j < 4; ++j) { v[j] = xr[64 * j]; ss += v[j].x * v[j].x + v[j].y * v[j].y + v[j].z * v[j].z + v[j].w * v[j].w; }
        const float r = rsqrtf(wave_sum(ss) * (1.f / D_) + EPS);
#pragma unroll
        for (int j = 0; j < 4; ++j) { const f32x4 gg = ((const f32x4*)g)[c.lane + 64 * j]; xr[64 * j] = v[j] * r * gg; }
    }
}

template <class AF, class EF>
__device__ __forceinline__ void naive_gemm(const Ctx& c, int M, int N, int K, AF af, const float* W, int ldb, EF ef) {
    LAS float* As = (LAS float*)c.lds;
    LAS float* Bs = As + 16 * 132;
    const int tm = (M + 127) / 128, tn = (N + 127) / 128, ntile = tm * tn;
    const int ty = c.tid >> 4, tx = c.tid & 15;
    for (int tile = c.bid; tile < ntile; tile += c.G) {
        const int m0 = (tile / tn) * 128, n0 = (tile % tn) * 128;
        float acc[4][8];
#pragma unroll
        for (int i = 0; i < 4; ++i)
#pragma unroll
            for (int j = 0; j < 8; ++j) acc[i][j] = 0.f;
        for (int k0 = 0; k0 < K; k0 += 16) {
            __syncthreads();
#pragma unroll
            for (int i = 0; i < 4; ++i) { const int e = c.tid + i * 512, r = e >> 4, kk = e & 15; const int row = m0 + r;
                As[kk * 132 + r] = (row < M) ? af(row, k0 + kk) : 0.f; }
#pragma unroll
            for (int i = 0; i < 4; ++i) { const int e = c.tid + i * 512, kk = e >> 7, cc = e & 127; const int col = n0 + cc;
                Bs[kk * 132 + cc] = (col < N) ? W[(size_t)(k0 + kk) * ldb + col] : 0.f; }
            __syncthreads();
#pragma unroll 2
            for (int kk = 0; kk < 16; ++kk) {
                float a[4], b[8];
#pragma unroll
                for (int i = 0; i < 4; ++i) a[i] = As[kk * 132 + ty * 4 + i];
#pragma unroll
                for (int j = 0; j < 8; ++j) b[j] = Bs[kk * 132 + tx * 8 + j];
#pragma unroll
                for (int i = 0; i < 4; ++i)
#pragma unroll
                    for (int j = 0; j < 8; ++j) acc[i][j] = fmaf(a[i], b[j], acc[i][j]);
            }
        }
        LAS float* Cs = Bs + 16 * 132;
        __syncthreads();
#pragma unroll
        for (int i = 0; i < 4; ++i)
#pragma unroll
            for (int j = 0; j < 8; ++j) Cs[(ty * 4 + i) * 129 + tx * 8 + j] = acc[i][j];
        __syncthreads();
#pragma unroll 1
        for (int e = c.tid; e < 128 * 128; e += NTHREADS) { const int r = e >> 7, cc = e & 127, row = m0 + r, col = n0 + cc; if (row < M && col < N) ef(row, col, Cs[r * 129 + cc]); }
    }
    __syncthreads();
}

struct InProjOut { bf16* qn; bf16* kv6; bf16* fqkv; bf16* dqk; bf16* dv; float* gate; float* fl; const float* b_gate; const float* b_fgt; };
__device__ __forceinline__ void inproj_store(const InProjOut& o, int n, int col, float v) {
    const int b = n / T_, t = n % T_;
    if (col < C_KV6) { const int h = col >> 6, d = col & 63; o.qn[((size_t)(b * 8 + h) * T_ + t) * 64 + d] = (bf16)f2bf(v * (0.125f * LOG2E)); }
    else if (col < C_GATE) { const int cc = col - C_KV6, idx = cc >> 7, g = (cc >> 6) & 1, d = cc & 63;
        ((bf16*)((unsigned char*)o.kv6 + idx * KV6_STRIDE))[((size_t)(b * 2 + g) * T_ + t) * 64 + d] = (bf16)f2bf(v); }
    else if (col < C_FQ) { const int j = col - C_GATE; o.gate[(size_t)n * 24 + j] = sigmoidf_(v + o.b_gate[j]); }
    else if (col < C_FF) { const int cc = col - C_FQ, idx = cc >> 8, h = (cc >> 6) & 3, d = cc & 63;
        o.fqkv[(size_t)idx * (8 * MiB) + ((size_t)(b * 4 + h) * T_ + t) * 64 + d] = (bf16)f2bf(idx == 0 ? v * (0.125f * LOG2E) : v); }
    else if (col < C_DQ) { const int h = col - C_FF; o.fl[(size_t)(b * 4 + h) * T_ + t] = log_sigmoidf_(v + o.b_fgt[h]); }
    else if (col < C_DV) { const int cc = col - C_DQ, idx = cc >> 8, h = (cc >> 6) & 3, i = (cc >> 5) & 1, d = cc & 31;
        o.dqk[(size_t)idx * (8 * MiB) + ((size_t)((b * 4 + h) * 2 + i) * T_ + t) * 32 + d] = (bf16)f2bf(idx == 0 ? v * (0.17677669529663687f * LOG2E) : v); }
    else { const int cc = col - C_DV, h = cc >> 6, d = cc & 63; o.dv[((size_t)(b * 4 + h) * T_ + t) * 64 + d] = (bf16)f2bf(v); }
}

__device__ __forceinline__ void ph_cumsum(const Ctx& c, float* fl) {
    for (int s = c.gw; s < B_ * 4; s += c.ngw) {
        float* p = fl + (size_t)s * T_; float carry = 0.f;
        for (int t0 = 0; t0 < T_; t0 += 64) {
            float v = p[t0 + c.lane];
#pragma unroll
            for (int o = 1; o < 64; o <<= 1) { const float u = __shfl_up(v, o); if (c.lane >= o) v += u; }
            v += carry; p[t0 + c.lane] = v; carry = __shfl(v, 63);
        }
    }
}

template <int DQK>
__device__ __forceinline__ float naive_attn_row(const bf16* q, const bf16* K, const bf16* V, int t, u64 mask, float slope2, const float* cum, int win, int lane) {
    float qv[DQK];
    { const u32x4* q4 = (const u32x4*)q;
#pragma unroll
      for (int i = 0; i < DQK / 8; ++i) { const u32x4 w = q4[i];
          qv[8 * i + 0] = __uint_as_float(w.x << 16); qv[8 * i + 1] = __uint_as_float(w.x & 0xffff0000u);
          qv[8 * i + 2] = __uint_as_float(w.y << 16); qv[8 * i + 3] = __uint_as_float(w.y & 0xffff0000u);
          qv[8 * i + 4] = __uint_as_float(w.z << 16); qv[8 * i + 5] = __uint_as_float(w.z & 0xffff0000u);
          qv[8 * i + 6] = __uint_as_float(w.w << 16); qv[8 * i + 7] = __uint_as_float(w.w & 0xffff0000u); } }
    const float cumt = cum ? cum[t] : 0.f;
    float m = -INFINITY, l = 0.f, o = 0.f;
    while (mask) {
        const int j = __builtin_ctzll(mask); mask &= mask - 1;
        const int kpos = 64 * j + lane; const int dist = t - kpos;
        const bool valid = dist >= 0 && dist < win;
        float s = 0.f;
        { const u32x4* k4 = (const u32x4*)(K + (size_t)kpos * DQK);
#pragma unroll
          for (int i = 0; i < DQK / 8; ++i) { const u32x4 w = k4[i];
              s = fmaf(qv[8 * i + 0], __uint_as_float(w.x << 16), s); s = fmaf(qv[8 * i + 1], __uint_as_float(w.x & 0xffff0000u), s);
              s = fmaf(qv[8 * i + 2], __uint_as_float(w.y << 16), s); s = fmaf(qv[8 * i + 3], __uint_as_float(w.y & 0xffff0000u), s);
              s = fmaf(qv[8 * i + 4], __uint_as_float(w.z << 16), s); s = fmaf(qv[8 * i + 5], __uint_as_float(w.z & 0xffff0000u), s);
              s = fmaf(qv[8 * i + 6], __uint_as_float(w.w << 16), s); s = fmaf(qv[8 * i + 7], __uint_as_float(w.w & 0xffff0000u), s); } }
        s -= slope2 * (float)dist;
        if (cum) s += (cumt - cum[kpos]) * LOG2E;
        s = valid ? s : -INFINITY;
        const float mb = wave_max(s);
        if (mb == -INFINITY) continue;
        const float mn = fmaxf(m, mb), alpha = exp2f(m - mn);
        const float p = valid ? exp2f(s - mn) : 0.f;
        l = l * alpha + wave_sum(p); o *= alpha; m = mn;
        const bf16* vb = V + (size_t)(64 * j) * 64 + lane;
#pragma unroll 8
        for (int k = 0; k < 64; ++k) o = fmaf(__shfl(p, k), bf2f(vb[(size_t)k * 64]), o);
    }
    return l > 0.f ? o / l : 0.f;
}

__device__ __forceinline__ void ph_cmp_attn(const Ctx& c, const bf16* qn, const bf16* kcmp, const bf16* vcmp, const float* gate, u64* sel, bf16* ocmp) {
    LAS float* pl = (LAS float*)(c.lds) + c.wave * 256;
    const int lane = c.lane;
    for (int it = c.gw; it < B_ * 2 * T_; it += c.ngw) {
        const int t = it % T_, bg = it / T_, b = bg >> 1, g = bg & 1;
        const int nvis = (t >= 31) ? ((t - 31) >> 4) + 1 : 0;
        const bf16* kc = kcmp + (size_t)bg * 256 * 64; const bf16* vc = vcmp + (size_t)bg * 256 * 64;
        float imp = 0.f;
        for (int hg = 0; hg < 4; ++hg) {
            const int h = g * 4 + hg; const float slope2 = alibi_slope(h + 1, 8) * LOG2E;
            const bf16* q = qn + ((size_t)(b * 8 + h) * T_ + t) * 64;
            float qv[64];
            { const u32x4* q4 = (const u32x4*)q;
#pragma unroll
              for (int i = 0; i < 8; ++i) { const u32x4 w = q4[i];
                  qv[8 * i + 0] = __uint_as_float(w.x << 16); qv[8 * i + 1] = __uint_as_float(w.x & 0xffff0000u);
                  qv[8 * i + 2] = __uint_as_float(w.y << 16); qv[8 * i + 3] = __uint_as_float(w.y & 0xffff0000u);
                  qv[8 * i + 4] = __uint_as_float(w.z << 16); qv[8 * i + 5] = __uint_as_float(w.z & 0xffff0000u);
                  qv[8 * i + 6] = __uint_as_float(w.w << 16); qv[8 * i + 7] = __uint_as_float(w.w & 0xffff0000u); } }
            float s[4]; float m = -INFINITY;
#pragma unroll
            for (int i = 0; i < 4; ++i) { const int cc = lane + 64 * i; float a = 0.f;
                if (cc < nvis) { const u32x4* k4 = (const u32x4*)(kc + (size_t)cc * 64);
#pragma unroll
                    for (int e = 0; e < 8; ++e) { const u32x4 w = k4[e];
                        a = fmaf(qv[8 * e + 0], __uint_as_float(w.x << 16), a); a = fmaf(qv[8 * e + 1], __uint_as_float(w.x & 0xffff0000u), a);
                        a = fmaf(qv[8 * e + 2], __uint_as_float(w.y << 16), a); a = fmaf(qv[8 * e + 3], __uint_as_float(w.y & 0xffff0000u), a);
                        a = fmaf(qv[8 * e + 4], __uint_as_float(w.z << 16), a); a = fmaf(qv[8 * e + 5], __uint_as_float(w.z & 0xffff0000u), a);
                        a = fmaf(qv[8 * e + 6], __uint_as_float(w.w << 16), a); a = fmaf(qv[8 * e + 7], __uint_as_float(w.w & 0xffff0000u), a); }
                    a -= slope2 * (float)(t - (16 * cc + 31)); } else a = -INFINITY;
                s[i] = a; m = fmaxf(m, a); }
            m = wave_max(m);
            float p[4], lsum = 0.f;
#pragma unroll
            for (int i = 0; i < 4; ++i) { p[i] = (lane + 64 * i < nvis) ? exp2f(s[i] - m) : 0.f; lsum += p[i]; }
            lsum = wave_sum(lsum);
            const float inv = lsum > 0.f ? 1.f / lsum : 0.f;
#pragma unroll
            for (int i = 0; i < 4; ++i) { p[i] *= inv; pl[lane + 64 * i] = p[i]; }
            asm volatile("s_waitcnt lgkmcnt(0)" ::: "memory");
            float o = 0.f;
            for (int cc = 0; cc < nvis; ++cc) o = fmaf(pl[cc], bf2f(vc[(size_t)cc * 64 + lane]), o);
            const float gt = gate[((size_t)(b * T_ + t)) * 24 + h * 3 + 0];
            ocmp[(size_t)(b * T_ + t) * 512 + h * 64 + lane] = (bf16)f2bf(gt * o);
            { const int j = lane; float a = pl[4 * j] + pl[4 * j + 1] + pl[4 * j + 2] + 0.5f * pl[4 * j + 3]; if (j > 0) a += 0.5f * pl[4 * j - 1]; imp += a; }
            asm volatile("s_waitcnt lgkmcnt(0)" ::: "memory");
        }
        const int cur = t >> 6; const int j = lane;
        u64 m64;
        if (cur <= 15) m64 = (cur == 63) ? ~0ull : ((1ull << (cur + 1)) - 1ull);
        else {
            float val = (j > cur) ? -INFINITY : ((j == 0 || j == cur || j == cur - 1) ? 1e4f : imp);
            m64 = 0ull;
            for (int r = 0; r < 16; ++r) {
                const float mx = wave_max(val);
                const u64 bal = __ballot(val == mx);
                const int w = __builtin_ctzll(bal);
                m64 |= 1ull << w; if (j == w) val = -INFINITY;
            }
        }
        if (lane == 0) sel[(size_t)bg * T_ + t] = m64;
    }
}

__device__ __forceinline__ void ph_win_attn(const Ctx& c, const bf16* qn, const bf16* kw, const bf16* vw, const float* gate, bf16* owin) {
    for (int it = c.gw; it < B_ * 8 * T_; it += c.ngw) {
        const int t = it % T_, bh = it / T_, b = bh >> 3, h = bh & 7, g = h >> 2;
        const int cur = t >> 6, jlo = (t - 511) > 0 ? (t - 511) >> 6 : 0;
        const u64 hi = (cur == 63) ? ~0ull : ((1ull << (cur + 1)) - 1ull); const u64 mask = hi & ~((1ull << jlo) - 1ull);
        const float o = naive_attn_row<64>(qn + ((size_t)bh * T_ + t) * 64, kw + (size_t)(b * 2 + g) * T_ * 64, vw + (size_t)(b * 2 + g) * T_ * 64, t, mask,
                                           alibi_slope(h + 1, 8) * LOG2E, nullptr, 512, c.lane);
        owin[(size_t)(b * T_ + t) * 512 + h * 64 + c.lane] = (bf16)f2bf(gate[(size_t)(b * T_ + t) * 24 + h * 3 + 2] * o);
    }
}
__device__ __forceinline__ void ph_slc_attn(const Ctx& c, const bf16* qn, const bf16* ks, const bf16* vs, const float* gate, const u64* sel, const bf16* ocmp, const bf16* owin, bf16* att) {
    for (int it = c.gw; it < B_ * 8 * T_; it += c.ngw) {
        const int t = it % T_, bh = it / T_, b = bh >> 3, h = bh & 7, g = h >> 2;
        const u64 mask = sel[(size_t)(b * 2 + g) * T_ + t];
        const float o = naive_attn_row<64>(qn + ((size_t)bh * T_ + t) * 64, ks + (size_t)(b * 2 + g) * T_ * 64, vs + (size_t)(b * 2 + g) * T_ * 64, t, mask,
                                           alibi_slope(h + 1, 8) * LOG2E, nullptr, 1 << 30, c.lane);
        const size_t n = (size_t)(b * T_ + t);
        const float r = gate[n * 24 + h * 3 + 1] * o + bf2f(ocmp[n * 512 + h * 64 + c.lane]) + bf2f(owin[n * 512 + h * 64 + c.lane]);
        att[n * 1024 + h * 64 + c.lane] = (bf16)f2bf(r);
    }
}
__device__ __forceinline__ void ph_fox_attn(const Ctx& c, const bf16* fq, const bf16* fk, const bf16* fv, const float* cum, bf16* att) {
    for (int it = c.gw; it < B_ * 4 * T_; it += c.ngw) {
        const int t = it % T_, bh = it / T_, b = bh >> 2, h = bh & 3;
        const int cur = t >> 6; const u64 mask = (cur == 63) ? ~0ull : ((1ull << (cur + 1)) - 1ull);
        const float o = naive_attn_row<64>(fq + ((size_t)bh * T_ + t) * 64, fk + (size_t)bh * T_ * 64, fv + (size_t)bh * T_ * 64, t, mask, 0.f, cum + (size_t)bh * T_, 1 << 30, c.lane);
        att[(size_t)(b * T_ + t) * 1024 + 512 + h * 64 + c.lane] = (bf16)f2bf(o);
    }
}
__device__ __forceinline__ void ph_diff_attn(const Ctx& c, const bf16* dq, const bf16* dk, const bf16* dv, const float* lam, const float* subln, float lambda_init, bf16* att) {
    float l1 = 0.f, l2 = 0.f;
    if (c.lane < 32) { l1 = lam[c.lane] * lam[32 + c.lane]; l2 = lam[64 + c.lane] * lam[96 + c.lane]; }
    const float lam_full = __expf(wave_sum(l1)) - __expf(wave_sum(l2)) + lambda_init;
    const float sg = subln[c.lane] * (1.f - lambda_init);
    for (int it = c.gw; it < B_ * 4 * T_; it += c.ngw) {
        const int t = it % T_, bh = it / T_, b = bh >> 2, h = bh & 3;
        const int cur = t >> 6; const u64 mask = (cur == 63) ? ~0ull : ((1ull << (cur + 1)) - 1ull);
        const float slope2 = alibi_slope(h + 1, 4) * LOG2E;
        const bf16* vb = dv + (size_t)bh * T_ * 64;
        const float o1 = naive_attn_row<32>(dq + ((size_t)(bh * 2 + 0) * T_ + t) * 32, dk + (size_t)(bh * 2 + 0) * T_ * 32, vb, t, mask, slope2, nullptr, 1 << 30, c.lane);
        const float o2 = naive_attn_row<32>(dq + ((size_t)(bh * 2 + 1) * T_ + t) * 32, dk + (size_t)(bh * 2 + 1) * T_ * 32, vb, t, mask, slope2, nullptr, 1 << 30, c.lane);
        const float o = o1 - lam_full * o2;
        const float r = rsqrtf(wave_sum(o * o) * (1.f / 64.f) + EPS);
        att[(size_t)(b * T_ + t) * 1024 + 768 + h * 64 + c.lane] = (bf16)f2bf(o * r * sg);
    }
}

__device__ __forceinline__ void ph_moe_route(const Ctx& c, const float* x, const float* g, const float* wgrp, const float* bgrp, const float* wexp, const float* bexp, bf16* hn, int* route_e, float* route_w, unsigned* cnt) {
    for (int row = c.gw; row < NT; row += c.ngw) {
        const f32x4* xr = (const f32x4*)(x + (size_t)row * D_) + c.lane;
        f32x4 v[4]; float ss = 0.f;
#pragma unroll
        for (int j = 0; j < 4; ++j) { v[j] = xr[64 * j]; ss += v[j].x * v[j].x + v[j].y * v[j].y + v[j].z * v[j].z + v[j].w * v[j].w; }
        const float r = rsqrtf(wave_sum(ss) * (1.f / D_) + EPS);
        u64* o8 = (u64*)(hn + (size_t)row * D_) + c.lane;
#pragma unroll
        for (int j = 0; j < 4; ++j) { const f32x4 gg = ((const f32x4*)g)[c.lane + 64 * j]; v[j] = v[j] * r * gg;
            o8[64 * j] = (u64)pk2(v[j].x, v[j].y) | ((u64)pk2(v[j].z, v[j].w) << 32); }
        float gl[4];
#pragma unroll
        for (int q = 0; q < 4; ++q) { float a = 0.f;
#pragma unroll
            for (int j = 0; j < 4; ++j) { const int k = 4 * (c.lane + 64 * j);
                a = fmaf(v[j].x, wgrp[(size_t)(k + 0) * 4 + q], a); a = fmaf(v[j].y, wgrp[(size_t)(k + 1) * 4 + q], a);
                a = fmaf(v[j].z, wgrp[(size_t)(k + 2) * 4 + q], a); a = fmaf(v[j].w, wgrp[(size_t)(k + 3) * 4 + q], a); }
            gl[q] = wave_sum(a) + bgrp[q]; }
        int grp = 0; float gm = gl[0];
#pragma unroll
        for (int q = 1; q < 4; ++q) if (gl[q] > gm) { gm = gl[q]; grp = q; }
        float gs = 0.f;
#pragma unroll
        for (int q = 0; q < 4; ++q) gs += __expf(gl[q] - gm);
        const float grp_gate = 1.f / gs;
        float el[8];
#pragma unroll
        for (int q = 0; q < 8; ++q) { float a = 0.f; const int col = grp * 8 + q;
#pragma unroll
            for (int j = 0; j < 4; ++j) { const int k = 4 * (c.lane + 64 * j);
                a = fmaf(v[j].x, wexp[(size_t)(k + 0) * 32 + col], a); a = fmaf(v[j].y, wexp[(size_t)(k + 1) * 32 + col], a);
                a = fmaf(v[j].z, wexp[(size_t)(k + 2) * 32 + col], a); a = fmaf(v[j].w, wexp[(size_t)(k + 3) * 32 + col], a); }
            el[q] = wave_sum(a) + bexp[col]; }
        int i0 = 0; float v0 = el[0];
#pragma unroll
        for (int q = 1; q < 8; ++q) if (el[q] > v0) { v0 = el[q]; i0 = q; }
        int i1 = -1; float v1 = -INFINITY;
#pragma unroll
        for (int q = 0; q < 8; ++q) if (q != i0 && el[q] > v1) { v1 = el[q]; i1 = q; }
        const float e1 = __expf(v1 - v0), den = 1.f + e1;
        if (c.lane == 0) { const float w0 = grp_gate / den, w1 = grp_gate * e1 / den;
            const int lo = i0 < i1 ? i0 : i1, hi = i0 < i1 ? i1 : i0, cls = grp * 28 + lo * 8 - (lo * (lo + 1)) / 2 + (hi - lo - 1);
            const unsigned rank = __hip_atomic_fetch_add(cnt + cls, 1u, __ATOMIC_RELAXED, __HIP_MEMORY_SCOPE_AGENT);
            route_e[row] = (int)(((unsigned)cls << 24) | rank); route_w[2 * row] = i0 < i1 ? w0 : w1; route_w[2 * row + 1] = i0 < i1 ? w1 : w0; }
    }
}
__device__ __forceinline__ void ph_moe_naive(const Ctx& c, const bf16* hn, const int* route_e, const float* route_w, const float* wg, const float* wu, const float* wd, float* x) {
    LAS float* hs = (LAS float*)c.lds;
    LAS float* au = hs + 1024;
    LAS float* h2 = au + 512;
    for (int row = c.bid; row < NT; row += c.G) {
        __syncthreads();
        hs[c.tid] = bf2f(hn[(size_t)row * D_ + c.tid]); hs[c.tid + 512] = bf2f(hn[(size_t)row * D_ + c.tid + 512]);
        float o0 = 0.f, o1 = 0.f;
        for (int s = 0; s < 2; ++s) {
            const int e = route_e[2 * row + s]; const float w = route_w[2 * row + s];
            __syncthreads();
            const float* W = (c.tid < 256 ? wg : wu) + (size_t)e * D_ * DEXP + (c.tid & 255);
            float a = 0.f;
            for (int k = 0; k < D_; ++k) a = fmaf(hs[k], W[(size_t)k * DEXP], a);
            au[c.tid] = a;
            __syncthreads();
            if (c.tid < 256) { const float ga = au[c.tid], up = au[c.tid + 256]; h2[c.tid] = ga / (1.f + __expf(-ga)) * up * w; }
            __syncthreads();
            const float* Wd = wd + (size_t)e * DEXP * D_;
            for (int k = 0; k < DEXP; ++k) { const float hv = h2[k]; o0 = fmaf(hv, Wd[(size_t)k * D_ + c.tid], o0); o1 = fmaf(hv, Wd[(size_t)k * D_ + c.tid + 512], o1); }
        }
        x[(size_t)row * D_ + c.tid] += o0; x[(size_t)row * D_ + c.tid + 512] += o1;
    }
    __syncthreads();
}

typedef __attribute__((address_space(4))) const Params* KP;
__device__ __forceinline__ KP uni_kp(KP p) { const unsigned long long v = (unsigned long long)p; const unsigned lo = __builtin_amdgcn_readfirstlane((unsigned)v), hi = __builtin_amdgcn_readfirstlane((unsigned)(v >> 32)); return (KP)(((unsigned long long)hi << 32) | lo); }
constexpr int PH_PER_LAYER = 11, N_PHASES = L_ * PH_PER_LAYER + 2;
__device__ __forceinline__ Ctx make_ctx(KP p) {
    Ctx c; c.lds = (LAS unsigned char*)lds_raw; c.tid = threadIdx.x; c.lane = c.tid & 63; c.wave = __builtin_amdgcn_readfirstlane(c.tid >> 6);
    c.bid = blockIdx.x; c.G = gridDim.x; c.gw = c.bid * NWAVES + c.wave; c.ngw = c.G * NWAVES; c.in = nullptr; c.xcur = p->out; c.ws = p->ws;
    return c;
}
struct Bufs {
    bf16 *QN, *KV6, *KC, *VC, *KS, *VS, *KW, *VW, *FQ, *FK, *FV, *DQ, *DK, *DV, *HC, *KCMP, *VCMP, *OCMP, *OWIN, *HN, *ATT;
    float *GATE, *FL, *ROUTE_W; u64* SEL; int* ROUTE_E;
};
__device__ __forceinline__ Bufs make_bufs(unsigned char* ws) {
    Bufs b;
    b.QN = (bf16*)(ws + WS_QN); b.KV6 = (bf16*)(ws + WS_KV6);
    b.KC = (bf16*)(ws + WS_KV6 + 0 * KV6_STRIDE); b.VC = (bf16*)(ws + WS_KV6 + 1 * KV6_STRIDE);
    b.KS = (bf16*)(ws + WS_KV6 + 2 * KV6_STRIDE); b.VS = (bf16*)(ws + WS_KV6 + 3 * KV6_STRIDE);
    b.KW = (bf16*)(ws + WS_KV6 + 4 * KV6_STRIDE); b.VW = (bf16*)(ws + WS_KV6 + 5 * KV6_STRIDE);
    b.FQ = (bf16*)(ws + WS_FQKV); b.FK = b.FQ + 8 * MiB; b.FV = b.FQ + 16 * MiB;
    b.DQ = (bf16*)(ws + WS_DQK); b.DK = b.DQ + 8 * MiB; b.DV = (bf16*)(ws + WS_DV);
    b.GATE = (float*)(ws + WS_GATE); b.FL = (float*)(ws + WS_FL);
    b.HC = (bf16*)(ws + WS_HC); b.KCMP = (bf16*)(ws + WS_KVCMP); b.VCMP = b.KCMP + 16 * 256 * 64;
    b.SEL = (u64*)(ws + WS_SEL); b.OCMP = (bf16*)(ws + WS_OCMP); b.OWIN = (bf16*)(ws + WS_OWIN);
    b.HN = (bf16*)(ws + WS_HN); b.ATT = (bf16*)(ws + WS_ATT);
    b.ROUTE_E = (int*)(ws + WS_ROUTE); b.ROUTE_W = (float*)(ws + WS_ROUTE + 512 * 1024);
    return b;
}
__device__ __forceinline__ float lambda_init_of(int l) { return l == 0 ? 0.2f : 0.35550906759096926f; }

__device__ __noinline__ void P_prologue(KP p_) { const KP p = uni_kp(p_);
    const Ctx c = make_ctx(p); unsigned char* ws = p->ws;
    LAS float* scr = (LAS float*)(c.lds) + c.wave * (64 * 33);
    constexpr int I_A = 16 * 40, I_B = 16 * 24, I_C = 16 * 24, I_O = 16 * 32, I_G = 16 * 8, I_D = 4 * 32, I_E = 2 * I_G + I_D, I_W1 = 32 * 8, I_W2 = 4 * 2;
    constexpr int PER_L = I_A + I_B + I_C + I_O + NEXP * I_E + 2 * (I_W1 + I_W2);
    for (int it = c.gw; it < L_ * PER_L; it += c.ngw) {
        const int l = it / PER_L; int r = it % PER_L;
        const float* W; bf16* WT; int ldw, K, sc0, ncol, r0 = 0, rmul = 1;
        if (r < I_A + I_B + I_C) { W = p->in[2] + (size_t)l * D_ * D_IN; WT = (bf16*)(ws + WS_WIN_T) + (size_t)l * NIN * D_; ldw = D_IN; K = D_;
            if (r < I_A) { sc0 = 0; ncol = 1280; r0 = 0; } else if (r < I_A + I_B) { r -= I_A; sc0 = C_FQ; ncol = 768; r0 = 1280; } else { r -= I_A + I_B; sc0 = C_DQ; ncol = 768; r0 = 2048; } }
        else if ((r -= I_A + I_B + I_C) < I_O) { W = p->in[13] + (size_t)l * D_ * D_; WT = (bf16*)(ws + WS_WOUT_T) + (size_t)l * D_ * D_; ldw = D_; K = D_; sc0 = 0; ncol = 1024; }
        else if ((r -= I_O) < NEXP * I_E) { const int e = r / I_E; r = r % I_E; const size_t le = (size_t)l * NEXP + e;
            if (r < 2 * I_G) { const int up = r >= I_G; r -= up * I_G; W = p->in[19 + up] + le * D_ * DEXP; WT = (bf16*)(ws + WS_WGU_T) + le * 512 * D_; ldw = DEXP; K = D_; sc0 = 0; ncol = 256; r0 = up; rmul = 2; }
            else { r -= 2 * I_G; W = p->in[21] + le * DEXP * D_; WT = (bf16*)(ws + WS_WD_T) + le * D_ * DEXP; ldw = D_; K = DEXP; sc0 = 0; ncol = 1024; } }
        else { r -= NEXP * I_E; const int kv = r / (I_W1 + I_W2); r = r % (I_W1 + I_W2); const size_t lk = (size_t)l * 2 + kv;
            if (r < I_W1) { W = p->in[kv == 0 ? 6 : 9] + (size_t)l * 2048 * 256; WT = (bf16*)(ws + WS_W1_T) + lk * 256 * 2048; ldw = 256; K = 2048; sc0 = 0; ncol = 256; }
            else { r -= I_W1; W = p->in[kv == 0 ? 7 : 10] + (size_t)l * 256 * 64; WT = (bf16*)(ws + WS_W2_T) + lk * 64 * 256; ldw = 64; K = 256; sc0 = 0; ncol = 64; } }
        transpose_seg(W, ldw, K, sc0, ncol, WT, r0, rmul, r, scr, c.lane);
    }
    for (int i = c.bid * NTHREADS + c.tid; i < L_ * 256 * D_; i += c.G * NTHREADS) {
        const int l = i / (256 * D_), rr = (i / D_) % 256, k = i % D_;
        const float* win = p->in[2] + (size_t)l * D_ * D_IN;
        float v = 0.f; if (rr < 24) v = win[(size_t)k * D_IN + C_GATE + rr]; else if (rr < 28) v = win[(size_t)k * D_IN + C_FF + (rr - 24)];
        ((bf16*)(ws + WS_WIN_T))[((size_t)l * NIN + 2816 + rr) * D_ + k] = (bf16)f2bf(v);
    }
    for (int w = c.gw; w < L_ * 2 * 4 * 128; w += c.ngw) {
        const int lk = w >> 9, cg = (w >> 7) & 3, kc = w & 127, l = lk >> 1, kv = lk & 1, j = cg * 64 + c.lane;
        const float* pe = p->in[kv == 0 ? 5 : 8] + (size_t)l * 2048 + kc * 16; const float* w1 = p->in[kv == 0 ? 6 : 9] + (size_t)l * 2048 * 256 + (size_t)kc * 16 * 256;
        float a = 0.f;
#pragma unroll
        for (int k = 0; k < 16; ++k) a = fmaf(pe[k], w1[(size_t)k * 256 + j], a);
        ((float*)(ws + WS_B1PART))[((size_t)lk * 128 + kc) * 256 + j] = a;
    }
    for (int i = c.bid * NTHREADS + c.tid; i < L_ * D_ * 64; i += c.G * NTHREADS) {
        const int l = i / (D_ * 64), k = (i / 64) % D_, cc = i % 64; const float g = p->in[14][(size_t)l * D_ + k];
        float v = 0.f; if (cc < 4) v = g * p->in[15][((size_t)l * D_ + k) * 4 + cc]; else if (cc < 36) v = g * p->in[17][((size_t)l * D_ + k) * 32 + (cc - 4)];
        ((float*)(ws + WS_WR))[i] = v;
    }
}
__device__ __forceinline__ void P_inproj_mfma(int l_) { const KP p = (KP)__builtin_amdgcn_kernarg_segment_ptr(); int l = l_; asm volatile("" : "+s"(l));
    unsigned char* ws = p->ws; asm volatile("" : "+s"(ws));
    PlainOrder S; S.init(ws + WS_HN, (const bf16*)(ws + WS_WIN_T) + (size_t)l * NIN * D_, D_, D_, NT, NIN, (int)gridDim.x, launder_s((int)blockIdx.x));
    const pg8::Gemm g{D_, D_, D_, D_ / 64};
    const EpiInProj E{ws, p->in[3] + l * 24, p->in[4] + l * 4};
    pg8::gemm_phase<EpiInProj, PlainOrder, true, true>((LAS unsigned char*)lds_raw, g, S, E);
}
__device__ __forceinline__ void P_outproj_mfma(int l_) { const KP p = (KP)__builtin_amdgcn_kernarg_segment_ptr(); int l = l_; asm volatile("" : "+s"(l));
    unsigned char* ws = p->ws; asm volatile("" : "+s"(ws));
    PlainOrder S; S.init(ws + WS_ATT, (const bf16*)(ws + WS_WOUT_T) + (size_t)l * D_ * D_, D_, D_, NT, D_, (int)gridDim.x, launder_s((int)blockIdx.x));
    const pg8::Gemm g{D_, D_, D_, D_ / 64};
    const EpiResF32 E{(l == 0) ? p->in[0] : p->out, p->out};
    pg8::gemm_phase<EpiResF32, PlainOrder, true, true>((LAS unsigned char*)lds_raw, g, S, E);
}
__device__ __forceinline__ void U_fox(KP p_, int bh_, int qb_) {
    const KP p = uni_kp(p_); const int bh = __builtin_amdgcn_readfirstlane(bh_), qb = __builtin_amdgcn_readfirstlane(qb_);
    int tid_ = threadIdx.x; asm volatile("" : "+v"(tid_));
    const int tid = tid_, lane = tid & 63, wave = __builtin_amdgcn_readfirstlane(tid >> 6), r = lane & 31, h = lane >> 5;
    unsigned char* ws = p->ws; asm volatile("" : "+s"(ws)); LAS unsigned char* L = (LAS unsigned char*)lds_raw;
    const int tw0 = 256 * qb + 32 * wave, t_lane = tw0 + r, b = bh >> 2, hd = bh & 3;
    const bf16* q = (const bf16*)(ws + WS_FQKV) + ((size_t)bh * T_ + t_lane) * 64 + 8 * h;
    bf16x8v Qf[1][4];
#pragma unroll
    for (int s = 0; s < 4; ++s) Qf[0][s] = *(const bf16x8v*)(q + 16 * s);
    LAS float* cum = (LAS float*)(L + A_LDS_END);
    { const float* fl = (const float*)(ws + WS_FL) + (size_t)bh * T_; LAS float* tot = cum + 4096;
      const int nval = 256 * (qb + 1); float v[8];
      if (8 * tid < nval) { const f32x4 a = *(const f32x4*)(fl + 8 * tid), c2 = *(const f32x4*)(fl + 8 * tid + 4); v[0] = a.x; v[1] = a.y; v[2] = a.z; v[3] = a.w; v[4] = c2.x; v[5] = c2.y; v[6] = c2.z; v[7] = c2.w; }
      else {
#pragma unroll
          for (int i = 0; i < 8; ++i) v[i] = 0.f; }
#pragma unroll
      for (int i = 1; i < 8; ++i) v[i] += v[i - 1];
      float sc = v[7];
#pragma unroll
      for (int o = 1; o < 64; o <<= 1) { const float up = __uint_as_float((unsigned)__builtin_amdgcn_ds_bpermute((lane - o) << 2, (int)__float_as_uint(sc))); if (lane >= o) sc += up; }
      if (lane == 63) tot[wave] = sc;
      __syncthreads();
      float base = sc - v[7];
      for (int w = 0; w < wave; ++w) base += tot[w];
      if (8 * tid < nval) {
#pragma unroll
          for (int i = 0; i < 8; ++i) cum[8 * tid + i] = v[i] + base; }
      __syncthreads(); }
    f32x16 O[1][2]; float M[1] = {-1e30f}, Ls[1] = {0.f};
#pragma unroll
    for (int i = 0; i < 16; ++i) { O[0][0][i] = 0.f; O[0][1][i] = 0.f; }
    const u64 tm = (qb == 15) ? ~0ull : ((1ull << (4 * qb + 4)) - 1ull);
    attn_core<64, 1, true, false>(L, (const bf16*)(ws + WS_FQKV) + 8 * MiB + (size_t)bh * T_ * 64, nullptr, (const bf16*)(ws + WS_FQKV) + 16 * MiB + (size_t)bh * T_ * 64, cum, cum[256 * qb],
                                  Qf, tm, t_lane, tw0, 1 << 30, 0.f, 0u, 0u, O, M, Ls, tid);
    const float lt = swap_sum(Ls[0]), inv = lt > 0.f ? 1.f / lt : 0.f;
    bf16* dst = (bf16*)(ws + WS_ATT) + ((size_t)b * T_ + t_lane) * 1024 + 512 + hd * 64 + 4 * h;
    ATTN_FOR_CHUNKS(db, g4) { const unsigned w0 = cvtpk(O[0][db][4 * g4 + 0] * inv, O[0][db][4 * g4 + 1] * inv), w1 = cvtpk(O[0][db][4 * g4 + 2] * inv, O[0][db][4 * g4 + 3] * inv);
        *(u64*)(dst + 32 * db + 8 * g4) = (u64)w0 | ((u64)w1 << 32); }
}
__device__ __forceinline__ void U_diff(KP p_, int bh_, int qb_, int l_) {
    const KP p = uni_kp(p_); const int bh = __builtin_amdgcn_readfirstlane(bh_), qb = __builtin_amdgcn_readfirstlane(qb_), l = __builtin_amdgcn_readfirstlane(l_);
    int tid_ = threadIdx.x; asm volatile("" : "+v"(tid_));
    const int tid = tid_, lane = tid & 63, wave = __builtin_amdgcn_readfirstlane(tid >> 6), r = lane & 31, h = lane >> 5;
    unsigned char* ws = p->ws; asm volatile("" : "+s"(ws)); LAS unsigned char* L = (LAS unsigned char*)lds_raw;
    const int tw0 = 256 * qb + 32 * wave, t_lane = tw0 + r, b = bh >> 2, hd = bh & 3;
    const bf16* DQ = (const bf16*)(ws + WS_DQK); const bf16* DK = DQ + 8 * MiB;
    bf16x8v Qf[2][2];
#pragma unroll
    for (int mp = 0; mp < 2; ++mp)
#pragma unroll
        for (int s = 0; s < 2; ++s) Qf[mp][s] = *(const bf16x8v*)(DQ + ((size_t)(bh * 2 + mp) * T_ + t_lane) * 32 + 16 * s + 8 * h);
    f32x16 O[2][2]; float M[2] = {-1e30f, -1e30f}, Ls[2] = {0.f, 0.f};
#pragma unroll
    for (int i = 0; i < 16; ++i) { O[0][0][i] = 0.f; O[0][1][i] = 0.f; O[1][0][i] = 0.f; O[1][1][i] = 0.f; }
    const u64 tm = (qb == 15) ? ~0ull : ((1ull << (4 * qb + 4)) - 1ull);
    attn_core<32, 2, false, false>(L, DK + (size_t)(bh * 2 + 0) * T_ * 32, DK + (size_t)(bh * 2 + 1) * T_ * 32, (const bf16*)(ws + WS_DV) + (size_t)bh * T_ * 64, nullptr, 0.f,
                                   Qf, tm, t_lane, tw0, 1 << 30, alibi_slope(hd + 1, 4) * LOG2E, 0u, 0u, O, M, Ls, tid);
    const float* lam = p->in[11] + (size_t)l * 128; const float* subln = p->in[12] + (size_t)l * 64;
    float l1 = 0.f, l2 = 0.f; if (lane < 32) { l1 = lam[lane] * lam[32 + lane]; l2 = lam[64 + lane] * lam[96 + lane]; }
    const float li = lambda_init_of(l), lam_full = __expf(wave_sum_l(l1, lane)) - __expf(wave_sum_l(l2, lane)) + li;
    const float lt0 = swap_sum(Ls[0]), lt1 = swap_sum(Ls[1]), i0 = lt0 > 0.f ? 1.f / lt0 : 0.f, i1 = (lt1 > 0.f ? 1.f / lt1 : 0.f) * lam_full;
    float ss = 0.f;
#pragma unroll
    for (int db = 0; db < 2; ++db)
#pragma unroll
        for (int i = 0; i < 16; ++i) { const float o = O[0][db][i] * i0 - O[1][db][i] * i1; O[0][db][i] = o; ss += o * o; }
    ss = swap_sum(ss);
    const float rn = rsqrtf(ss * (1.f / 64.f) + EPS) * (1.f - li);
    bf16* dst = (bf16*)(ws + WS_ATT) + ((size_t)b * T_ + t_lane) * 1024 + 768 + hd * 64 + 4 * h;
    ATTN_FOR_CHUNKS(db, g4) { const f32x4 sg = *(const f32x4*)(subln + 32 * db + 8 * g4 + 4 * h);
        const unsigned w0 = cvtpk(O[0][db][4 * g4 + 0] * rn * sg.x, O[0][db][4 * g4 + 1] * rn * sg.y), w1 = cvtpk(O[0][db][4 * g4 + 2] * rn * sg.z, O[0][db][4 * g4 + 3] * rn * sg.w);
        *(u64*)(dst + 32 * db + 8 * g4) = (u64)w0 | ((u64)w1 << 32); }
}
__device__ __forceinline__ void U_win(KP p_, int bg_, int c_) {
    const KP p = uni_kp(p_); const int bg = __builtin_amdgcn_readfirstlane(bg_), cc = __builtin_amdgcn_readfirstlane(c_);
    int tid_ = threadIdx.x; asm volatile("" : "+v"(tid_));
    const int tid = tid_, lane = tid & 63, wave = __builtin_amdgcn_readfirstlane(tid >> 6), r = lane & 31, h = lane >> 5;
    unsigned char* ws = p->ws; asm volatile("" : "+s"(ws)); LAS unsigned char* L = (LAS unsigned char*)lds_raw;
    const int b = bg >> 1, g = bg & 1, hd = g * 4 + (wave >> 1), tw0 = 64 * cc + 32 * (wave & 1), t_lane = tw0 + r;
    const bf16* q = (const bf16*)(ws + WS_QN) + ((size_t)(b * 8 + hd) * T_ + t_lane) * 64 + 8 * h;
    bf16x8v Qf[1][4];
#pragma unroll
    for (int s = 0; s < 4; ++s) Qf[0][s] = *(const bf16x8v*)(q + 16 * s);
    f32x16 O[1][2]; float M[1] = {-1e30f}, Ls[1] = {0.f};
#pragma unroll
    for (int i = 0; i < 16; ++i) { O[0][0][i] = 0.f; O[0][1][i] = 0.f; }
    const int jlo = cc > 8 ? cc - 8 : 0;
    const u64 hi = (cc == 63) ? ~0ull : ((1ull << (cc + 1)) - 1ull), tm = hi & ~((1ull << jlo) - 1ull);
    attn_core<64, 1, false, false>(L, (const bf16*)(ws + WS_KV6 + 4 * KV6_STRIDE) + (size_t)bg * T_ * 64, nullptr, (const bf16*)(ws + WS_KV6 + 5 * KV6_STRIDE) + (size_t)bg * T_ * 64, nullptr, 0.f,
                                   Qf, tm, t_lane, tw0, 512, alibi_slope(hd + 1, 8) * LOG2E, 0u, 0u, O, M, Ls, tid);
    const size_t n = (size_t)b * T_ + t_lane;
    const float lt = swap_sum(Ls[0]), inv = (lt > 0.f ? 1.f / lt : 0.f) * ((const float*)(ws + WS_GATE))[n * 24 + hd * 3 + 2];
    bf16* dst = (bf16*)(ws + WS_OWIN) + n * 512 + hd * 64 + 4 * h;
    ATTN_FOR_CHUNKS(db, g4) { const unsigned w0 = cvtpk(O[0][db][4 * g4 + 0] * inv, O[0][db][4 * g4 + 1] * inv), w1 = cvtpk(O[0][db][4 * g4 + 2] * inv, O[0][db][4 * g4 + 3] * inv);
        *(u64*)(dst + 32 * db + 8 * g4) = (u64)w0 | ((u64)w1 << 32); }
}
__device__ __forceinline__ void U_slc(KP p_, int bg_, int c_) {
    const KP p = uni_kp(p_); const int bg = __builtin_amdgcn_readfirstlane(bg_), cc = __builtin_amdgcn_readfirstlane(c_);
    int tid_ = threadIdx.x; asm volatile("" : "+v"(tid_));
    const int tid = tid_, lane = tid & 63, wave = __builtin_amdgcn_readfirstlane(tid >> 6), r = lane & 31, h = lane >> 5;
    unsigned char* ws = p->ws; asm volatile("" : "+s"(ws)); LAS unsigned char* L = (LAS unsigned char*)lds_raw;
    const int b = bg >> 1, g = bg & 1, hd = g * 4 + (wave >> 1), tw0 = 64 * cc + 32 * (wave & 1), t_lane = tw0 + r;
    const bf16* q = (const bf16*)(ws + WS_QN) + ((size_t)(b * 8 + hd) * T_ + t_lane) * 64 + 8 * h;
    bf16x8v Qf[1][4];
#pragma unroll
    for (int s = 0; s < 4; ++s) Qf[0][s] = *(const bf16x8v*)(q + 16 * s);
    f32x16 O[1][2]; float M[1] = {-1e30f}, Ls[1] = {0.f};
#pragma unroll
    for (int i = 0; i < 16; ++i) { O[0][0][i] = 0.f; O[0][1][i] = 0.f; }
    const u64* sel = (const u64*)(ws + WS_SEL) + (size_t)bg * T_;
    const u64 mine = sel[t_lane]; u64 un = sel[64 * cc + lane];
    { unsigned ul = (unsigned)un, uh = (unsigned)(un >> 32);
#pragma unroll
      for (int o = 1; o < 64; o <<= 1) { ul |= shflx_u(ul, o, lane); uh |= shflx_u(uh, o, lane); }
      un = ((u64)__builtin_amdgcn_readfirstlane(uh) << 32) | __builtin_amdgcn_readfirstlane(ul); }
    attn_core<64, 1, false, true>(L, (const bf16*)(ws + WS_KV6 + 2 * KV6_STRIDE) + (size_t)bg * T_ * 64, nullptr, (const bf16*)(ws + WS_KV6 + 3 * KV6_STRIDE) + (size_t)bg * T_ * 64, nullptr, 0.f,
                                  Qf, un, t_lane, tw0, 1 << 30, alibi_slope(hd + 1, 8) * LOG2E, (unsigned)mine, (unsigned)(mine >> 32), O, M, Ls, tid);
    const size_t n = (size_t)b * T_ + t_lane;
    const float lt = swap_sum(Ls[0]), inv = (lt > 0.f ? 1.f / lt : 0.f) * ((const float*)(ws + WS_GATE))[n * 24 + hd * 3 + 1];
    const bf16* oc = (const bf16*)(ws + WS_OCMP) + n * 512 + hd * 64 + 4 * h; const bf16* ow = (const bf16*)(ws + WS_OWIN) + n * 512 + hd * 64 + 4 * h;
    bf16* dst = (bf16*)(ws + WS_ATT) + n * 1024 + hd * 64 + 4 * h;
    ATTN_FOR_CHUNKS(db, g4) { const u64 a = *(const u64*)(oc + 32 * db + 8 * g4), w = *(const u64*)(ow + 32 * db + 8 * g4);
        const float x0 = O[0][db][4 * g4 + 0] * inv + __uint_as_float((unsigned)a << 16) + __uint_as_float((unsigned)w << 16);
        const float x1 = O[0][db][4 * g4 + 1] * inv + __uint_as_float((unsigned)a & 0xffff0000u) + __uint_as_float((unsigned)w & 0xffff0000u);
        const float x2 = O[0][db][4 * g4 + 2] * inv + __uint_as_float((unsigned)(a >> 32) << 16) + __uint_as_float((unsigned)(w >> 32) << 16);
        const float x3 = O[0][db][4 * g4 + 3] * inv + __uint_as_float((unsigned)(a >> 32) & 0xffff0000u) + __uint_as_float((unsigned)(w >> 32) & 0xffff0000u);
        *(u64*)(dst + 32 * db + 8 * g4) = (u64)cvtpk(x0, x1) | ((u64)cvtpk(x2, x3) << 32); }
}
__device__ __forceinline__ float other_half(float x, int h) { auto rr = __builtin_amdgcn_permlane32_swap(__float_as_uint(x), __float_as_uint(x), false, false); return __uint_as_float(h ? rr[0] : rr[1]); }
__device__ __forceinline__ int other_half_i(int x, int h) { auto rr = __builtin_amdgcn_permlane32_swap((unsigned)x, (unsigned)x, false, false); return (int)(h ? rr[0] : rr[1]); }
template <bool MASK>
__device__ __forceinline__ void cmp_scores(f32x16& p0, f32x16& p1, const LAS unsigned char* kt, const bf16x8v (&Qf)[4], float b0, float s1, int cl, int nvis_l) {
    const float s8 = s1 * 8.f, s32 = s1 * 32.f;
    p0[0] = b0; p0[1] = p0[0] + s1; p0[2] = p0[1] + s1; p0[3] = p0[2] + s1;
#pragma unroll
    for (int reg = 4; reg < 16; ++reg) p0[reg] = p0[reg - 4] + s8;
#pragma unroll
    for (int reg = 0; reg < 16; ++reg) p1[reg] = p0[reg] + s32;
#pragma unroll
    for (int s = 0; s < 4; ++s) { const bf16x8v kf0 = *(const LAS bf16x8v*)(kt + s * 32), kf1 = *(const LAS bf16x8v*)(kt + 32 * 144 + s * 32);
        p0 = __builtin_amdgcn_mfma_f32_32x32x16_bf16(kf0, Qf[s], p0, 0, 0, 0); p1 = __builtin_amdgcn_mfma_f32_32x32x16_bf16(kf1, Qf[s], p1, 0, 0, 0); }
    if (MASK) {
#pragma unroll
        for (int reg = 0; reg < 16; ++reg) { const int c = cl + crow0(reg); p0[reg] = (c < nvis_l) ? p0[reg] : -INFINITY; p1[reg] = (c + 32 < nvis_l) ? p1[reg] : -INFINITY; } }
}
__device__ __forceinline__ void U_cmp(KP p_, int bg_, int u_) {
    const KP p = uni_kp(p_); const int bg = __builtin_amdgcn_readfirstlane(bg_), uu = __builtin_amdgcn_readfirstlane(u_);
    int tid_ = threadIdx.x; asm volatile("" : "+v"(tid_));
    const int tid = tid_, lane = tid & 63, wave = __builtin_amdgcn_readfirstlane(tid >> 6), r = lane & 31, h = lane >> 5;
    unsigned char* ws = p->ws; asm volatile("" : "+s"(ws)); LAS unsigned char* L = (LAS unsigned char*)lds_raw;
    const int b = bg >> 1, g = bg & 1, tw0 = 32 * (uu + 16 * wave), t_lane = tw0 + r;
    { const bf16* kc = (const bf16*)(ws + WS_KVCMP) + (size_t)bg * 256 * 64; const bf16* vc = kc + 16 * 256 * 64;
#pragma unroll
      for (int i = 0; i < 4; ++i) { const int ch = tid + 512 * i, row = ch >> 3, c8 = ch & 7;
          *(LAS u32x4*)(L + row * 144 + c8 * 16) = *(const u32x4*)(kc + row * 64 + c8 * 8); *(LAS u32x4*)(L + 36864 + row * 144 + c8 * 16) = *(const u32x4*)(vc + row * 64 + c8 * 8); } }
    __syncthreads();
    const int nvis_l = t_lane >= 31 ? ((t_lane - 31) >> 4) + 1 : 0, nvis_max = (tw0 >> 4) + 1, nvis_min = tw0 >= 31 ? ((tw0 - 31) >> 4) + 1 : 0, ntile = (nvis_max + 63) >> 6;
    const LAS unsigned char* kfrag = L + r * 144 + h * 16;
    const LAS unsigned char* vfrag = L + 36864 + (4 * h + ((lane & 15) >> 2)) * 144 + (16 * ((lane >> 4) & 1) + 4 * (lane & 3)) * 2;
    float imp[32];
#pragma unroll
    for (int e = 0; e < 32; ++e) imp[e] = 0.f;
    const float* gate = (const float*)(ws + WS_GATE) + ((size_t)b * T_ + t_lane) * 24;
#pragma unroll 1
    for (int hg = 0; hg < 4; ++hg) {
        const int hd = g * 4 + hg; const float s1 = alibi_slope(hd + 1, 8) * LOG2E * 16.f;
        const bf16* q = (const bf16*)(ws + WS_QN) + ((size_t)(b * 8 + hd) * T_ + t_lane) * 64 + 8 * h;
        bf16x8v Qf[4];
#pragma unroll
        for (int s = 0; s < 4; ++s) Qf[s] = *(const bf16x8v*)(q + 16 * s);
        float m = -1e30f, lsum = 0.f;
#pragma unroll 1
        for (int jt = 0; jt < ntile; ++jt) {
            f32x16 p0, p1; const float b0 = s1 * (float)(64 * jt + 4 * h - nvis_max);
            if (64 * jt + 63 >= nvis_min) cmp_scores<true>(p0, p1, kfrag + jt * (64 * 144), Qf, b0, s1, 64 * jt + 4 * h, nvis_l);
            else cmp_scores<false>(p0, p1, kfrag + jt * (64 * 144), Qf, b0, s1, 64 * jt + 4 * h, nvis_l);
            float mt = fmaxf(p0[0], p1[0]);
#pragma unroll
            for (int reg = 1; reg < 16; ++reg) mt = fmaxf(mt, fmaxf(p0[reg], p1[reg]));
            mt = swap_max(mt);
            const float mn = fmaxf(m, mt); float rs = 0.f;
#pragma unroll
            for (int reg = 0; reg < 16; ++reg) rs += __builtin_amdgcn_exp2f(p0[reg] - mn) + __builtin_amdgcn_exp2f(p1[reg] - mn);
            lsum = lsum * __builtin_amdgcn_exp2f(m - mn) + rs; m = mn;
        }
        const float lt = swap_sum(lsum), inv = lt > 0.f ? 1.f / lt : 0.f;
        f32x16 O0, O1;
#pragma unroll
        for (int i = 0; i < 16; ++i) { O0[i] = 0.f; O1[i] = 0.f; }
        float carry = 0.f;
#pragma unroll
        for (int jt = 0; jt < 4; ++jt) if (jt < ntile) {
            f32x16 p0, p1; const float b0 = s1 * (float)(64 * jt + 4 * h - nvis_max);
            if (64 * jt + 63 >= nvis_min) cmp_scores<true>(p0, p1, kfrag + jt * (64 * 144), Qf, b0, s1, 64 * jt + 4 * h, nvis_l);
            else cmp_scores<false>(p0, p1, kfrag + jt * (64 * 144), Qf, b0, s1, 64 * jt + 4 * h, nvis_l);
#pragma unroll
            for (int reg = 0; reg < 16; ++reg) { p0[reg] = __builtin_amdgcn_exp2f(p0[reg] - m) * inv; p1[reg] = __builtin_amdgcn_exp2f(p1[reg] - m) * inv; }
            float cv[8];
#pragma unroll
            for (int g4 = 0; g4 < 4; ++g4) { const float h0 = 0.5f * p0[4 * g4 + 3], h1 = 0.5f * p1[4 * g4 + 3];
                imp[jt * 8 + g4] += ((p0[4 * g4] + p0[4 * g4 + 1]) + p0[4 * g4 + 2]) + h0; imp[jt * 8 + 4 + g4] += ((p1[4 * g4] + p1[4 * g4 + 1]) + p1[4 * g4 + 2]) + h1;
                cv[g4] = h0; cv[4 + g4] = h1; }
            float prev = carry;
#pragma unroll
            for (int k = 0; k < 8; ++k) { const float sv = other_half(cv[k], h); imp[jt * 8 + k] += h ? sv : prev; prev = sv; }
            carry = prev;
            const bf16x8v pa0 = pack8(p0, 0), pa1 = pack8(p0, 8), pa2 = pack8(p1, 0), pa3 = pack8(p1, 8);
            const LAS unsigned char* vb = vfrag + jt * (64 * 144);
#pragma unroll
            for (int ks = 0; ks < 4; ++ks) { const bf16x8v pa = ks == 0 ? pa0 : ks == 1 ? pa1 : ks == 2 ? pa2 : pa3;
                { const s16x4 lo = tr_read(vb + ks * (16 * 144)), hi = tr_read(vb + ks * (16 * 144) + 8 * 144); const bf16x8v vf = {lo[0], lo[1], lo[2], lo[3], hi[0], hi[1], hi[2], hi[3]};
                  O0 = __builtin_amdgcn_mfma_f32_32x32x16_bf16(vf, pa, O0, 0, 0, 0); }
                { const s16x4 lo = tr_read(vb + ks * (16 * 144) + 64), hi = tr_read(vb + ks * (16 * 144) + 64 + 8 * 144); const bf16x8v vf = {lo[0], lo[1], lo[2], lo[3], hi[0], hi[1], hi[2], hi[3]};
                  O1 = __builtin_amdgcn_mfma_f32_32x32x16_bf16(vf, pa, O1, 0, 0, 0); } }
        }
        const float gt = gate[hd * 3 + 0];
        bf16* dst = (bf16*)(ws + WS_OCMP) + ((size_t)b * T_ + t_lane) * 512 + hd * 64 + 4 * h;
#pragma unroll
        for (int g4 = 0; g4 < 4; ++g4) {
            *(u64*)(dst + 8 * g4) = (u64)cvtpk(O0[4 * g4 + 0] * gt, O0[4 * g4 + 1] * gt) | ((u64)cvtpk(O0[4 * g4 + 2] * gt, O0[4 * g4 + 3] * gt) << 32);
            *(u64*)(dst + 32 + 8 * g4) = (u64)cvtpk(O1[4 * g4 + 0] * gt, O1[4 * g4 + 1] * gt) | ((u64)cvtpk(O1[4 * g4 + 2] * gt, O1[4 * g4 + 3] * gt) << 32); }
    }
    const int cur = tw0 >> 6; u64 mask;
    if (cur <= 15) mask = (1ull << (cur + 1)) - 1ull;
    else {
        mask = 1ull | (1ull << cur) | (1ull << (cur - 1));
#pragma unroll
        for (int e = 0; e < 32; ++e) { const int j = 2 * e + h; if (j > cur || j == 0 || j >= cur - 1) imp[e] = -INFINITY; }
#pragma unroll 1
        for (int round = 0; round < 13; ++round) {
            float bv = imp[0]; int be = 0;
#pragma unroll
            for (int e = 1; e < 32; ++e) if (imp[e] > bv) { bv = imp[e]; be = e; }
            const int bj = 2 * be + h; const float ov = other_half(bv, h); const int oj = other_half_i(bj, h);
            const bool mine = bv > ov || (bv == ov && bj < oj);
            mask |= 1ull << (mine ? bj : oj);
#pragma unroll
            for (int e = 0; e < 32; ++e) imp[e] = (mine && e == be) ? -INFINITY : imp[e];
        }
    }
    if (h == 0) ((u64*)(ws + WS_SEL))[(size_t)bg * T_ + t_lane] = mask;
    __syncthreads();
}
__device__ __forceinline__ int fetch_unit(KP p, int qidx) {
    volatile LAS unsigned* slot = (volatile LAS unsigned*)((LAS unsigned char*)lds_raw + MISC_OFF) + 16;
    __syncthreads();
    int t0_ = threadIdx.x; asm volatile("" : "+v"(t0_));
    if (t0_ == 0) *slot = __hip_atomic_fetch_add((unsigned*)(p->ws + WS_CTL) + CW_QUEUE + 64 * qidx, 1u, __ATOMIC_RELAXED, __HIP_MEMORY_SCOPE_AGENT);
    __syncthreads();
    return (int)__builtin_amdgcn_readfirstlane(*slot);
}
__device__ __forceinline__ void P_cmp1_mfma(int l_) { const KP p = (KP)__builtin_amdgcn_kernarg_segment_ptr(); int l = l_; asm volatile("" : "+s"(l));
    unsigned char* ws = p->ws; asm volatile("" : "+s"(ws)); const int c = launder_s((int)blockIdx.x), kv = c >> 4, pm = c & 15;
    OneUnitOrder S; S.has = c < 32; S.u.pm = pm; S.u.pn = kv;
    S.u.a = (const char*)(ws + WS_KV6 + (size_t)kv * KV6_STRIDE) + (size_t)pm * 256 * 1024 * 2; S.u.b = (const char*)((const bf16*)(ws + WS_W1_T) + ((size_t)l * 2 + kv) * 256 * 2048); S.u.b2 = S.u.b;
    const pg8::Gemm g{1024, 2048, 2048, 32};
    const EpiCmpH E{(bf16*)(ws + WS_HC), (const float*)(ws + WS_BIAS1) + l * 512};
    pg8::gemm_phase<EpiCmpH, OneUnitOrder, false, true>((LAS unsigned char*)lds_raw, g, S, E);
}
__device__ __forceinline__ void P_cmp2_mfma(int l_) { const KP p = (KP)__builtin_amdgcn_kernarg_segment_ptr(); int l = l_; asm volatile("" : "+s"(l));
    unsigned char* ws = p->ws; asm volatile("" : "+s"(ws)); const int c = launder_s((int)blockIdx.x), kv = c >> 4, pm = c & 15;
    OneUnitOrder S; S.has = c < 32; S.u.pm = pm; S.u.pn = kv;
    S.u.a = (const char*)((const bf16*)(ws + WS_HC) + ((size_t)kv * 4096 + pm * 256) * 256); S.u.b = (const char*)((const bf16*)(ws + WS_W2_T) + ((size_t)l * 2 + kv) * 64 * 256); S.u.b2 = S.u.b;
    const pg8::Gemm g{256, 256, 256, 4};
    const EpiCmpOut E{(bf16*)(ws + WS_KVCMP)};
    pg8::gemm_phase<EpiCmpOut, OneUnitOrder, false, true>((LAS unsigned char*)lds_raw, g, S, E);
}
__device__ __noinline__ void P_moe_scatter(KP p_, int l_) { const KP p = uni_kp(p_); const int l = __builtin_amdgcn_readfirstlane(l_); const Ctx c = make_ctx(p); unsigned char* ws = p->ws;
    const unsigned* cnt = (const unsigned*)(ws + WS_CTL) + CW_MOECNT + l * 128;
    moe_build_tables(cnt, c.tid);
    const LAS int* T = (const LAS int*)((LAS unsigned char*)lds_raw + TBL_OFF);
    const unsigned* info = (const unsigned*)(ws + WS_ROUTE + RT_INFO); const float* tw = (const float*)(ws + WS_ROUTE + RT_W);
    int* rowtok = (int*)(ws + WS_ROUTE + RT_ROWTOK); float* roww = (float*)(ws + WS_ROUTE + RT_ROWW);
    bf16* xs = (bf16*)(ws + WS_XS); const float* x = p->out; const float* gain = p->in[14] + (size_t)l * D_; const float* rstdv = (const float*)(ws + WS_ROUTE + RT_RSTD);
    for (int row = c.gw; row < NT; row += c.ngw) {
        const unsigned v = info[row]; const int cls = (int)(v >> 24), rank = (int)(v & 0xffffffu); const size_t dest = (size_t)T[cls] * 256 + rank;
        const f32x4* xr = (const f32x4*)(x + (size_t)row * D_) + c.lane; u64* o8 = (u64*)(xs + dest * D_) + c.lane; const float r = rstdv[row];
#pragma unroll
        for (int j = 0; j < 4; ++j) { const f32x4 vv = xr[64 * j], gg = ((const f32x4*)gain)[c.lane + 64 * j];
            o8[64 * j] = (u64)pk2(vv.x * r * gg.x, vv.y * r * gg.y) | ((u64)pk2(vv.z * r * gg.z, vv.w * r * gg.w) << 32); }
        if (c.lane == 0) { rowtok[dest] = row; roww[2 * dest] = tw[2 * row]; roww[2 * dest + 1] = tw[2 * row + 1]; }
    }
    for (int cls = c.bid; cls < 112; cls += c.G) { const int n = (int)cnt[cls], end = (int)((cnt[cls] + 255u) >> 8) * 256; const size_t base = (size_t)T[cls] * 256;
        for (int r = n + c.tid; r < end; r += NTHREADS) rowtok[base + r] = -1; }
}
__device__ __forceinline__ void P_moe_g1(int l_) { const KP p = (KP)__builtin_amdgcn_kernarg_segment_ptr(); int l = l_; asm volatile("" : "+s"(l));
    unsigned char* ws = p->ws; asm volatile("" : "+s"(ws));
    { int t0_ = threadIdx.x; asm volatile("" : "+v"(t0_)); moe_build_tables((const unsigned*)(ws + WS_CTL) + CW_MOECNT + l * 128, t0_); }
    const MoeOrder1 S{(const char*)(ws + WS_XS), (const char*)((const bf16*)(ws + WS_WGU_T) + (size_t)l * NEXP * 512 * D_), (int)gridDim.x, launder_s((int)blockIdx.x)};
    const pg8::Gemm g{D_, D_, D_, D_ / 64};
    const EpiMoeH E{(bf16*)(ws + WS_HB), (const float*)(ws + WS_ROUTE + RT_ROWW)};
    pg8::gemm_phase<EpiMoeH, MoeOrder1, true, true>((LAS unsigned char*)lds_raw, g, S, E);
}
__device__ __forceinline__ void P_moe_g2(int l_) { const KP p = (KP)__builtin_amdgcn_kernarg_segment_ptr(); int l = l_; asm volatile("" : "+s"(l));
    unsigned char* ws = p->ws; asm volatile("" : "+s"(ws));
    { int t0_ = threadIdx.x; asm volatile("" : "+v"(t0_)); moe_build_tables((const unsigned*)(ws + WS_CTL) + CW_MOECNT + l * 128, t0_); }
    const MoeOrder2 S{(const char*)(ws + WS_HB), (const char*)((const bf16*)(ws + WS_WD_T) + (size_t)l * NEXP * D_ * DEXP), (int)gridDim.x, launder_s((int)blockIdx.x)};
    const pg8::Gemm g{512, DEXP, 512, 4};
    const EpiMoeOut E{p->out, (const int*)(ws + WS_ROUTE + RT_ROWTOK)};
    pg8::gemm_phase<EpiMoeOut, MoeOrder2, true, true>((LAS unsigned char*)lds_raw, g, S, E);
}
__device__ __noinline__ void P_norm1(KP p_, int l_) { const KP p = uni_kp(p_); const int l = __builtin_amdgcn_readfirstlane(l_); const Ctx c = make_ctx(p); const Bufs b = make_bufs(p->ws);
    if (l == 0) { const int i = c.bid * NTHREADS + c.tid; if (i < L_ * 2 * 256) { const float* part = (const float*)(p->ws + WS_B1PART) + (size_t)(i >> 8) * 128 * 256 + (i & 255); float a = 0.f;
        for (int k = 0; k < 128; ++k) a += part[(size_t)k * 256]; ((float*)(p->ws + WS_BIAS1))[i] = a; } }
    ph_norm_bf16(c, (l == 0) ? p->in[0] : p->out, p->in[1] + (size_t)l * D_, b.HN); }
__device__ __noinline__ void P_inproj(KP p_, int l_) { const KP p = uni_kp(p_); const int l = __builtin_amdgcn_readfirstlane(l_); const Ctx c = make_ctx(p); const Bufs b = make_bufs(p->ws);
    InProjOut o{b.QN, b.KV6, b.FQ, b.DQ, b.DV, b.GATE, b.FL, p->in[3] + l * 24, p->in[4] + l * 4};
    const bf16* A = b.HN;
    naive_gemm(c, NT, D_IN, D_, [=](int r, int k) { return bf2f(A[(size_t)r * D_ + k]); }, p->in[2] + (size_t)l * D_ * D_IN, D_IN,
               [=](int r, int col, float v) { inproj_store(o, r, col, v); }); }
__device__ __noinline__ void P_cmp1(KP p_, int l_, int kv_) { const KP p = uni_kp(p_); const int l = __builtin_amdgcn_readfirstlane(l_), kv = __builtin_amdgcn_readfirstlane(kv_); const Ctx c = make_ctx(p); const Bufs b = make_bufs(p->ws);
    const bf16* src = kv == 0 ? b.KC : b.VC; const float* pe = p->in[kv == 0 ? 5 : 8] + (size_t)l * 2048; bf16* hc = b.HC + (size_t)kv * 4096 * 256;
    naive_gemm(c, 4096, 256, 2048, [=](int r, int k) { return bf2f(src[(size_t)r * 1024 + k]) + pe[k]; }, p->in[kv == 0 ? 6 : 9] + (size_t)l * 2048 * 256, 256,
               [=](int r, int col, float v) { hc[(size_t)r * 256 + col] = (bf16)f2bf(gelu_tanh(v)); }); }
__device__ __noinline__ void P_cumsum(KP p_, int l_) { const KP p = uni_kp(p_); const int l = __builtin_amdgcn_readfirstlane(l_); const Ctx c = make_ctx(p); const Bufs b = make_bufs(p->ws); ph_cumsum(c, b.FL); }
__device__ __noinline__ void P_cmp2(KP p_, int l_, int kv_) { const KP p = uni_kp(p_); const int l = __builtin_amdgcn_readfirstlane(l_), kv = __builtin_amdgcn_readfirstlane(kv_); const Ctx c = make_ctx(p); const Bufs b = make_bufs(p->ws);
    const bf16* hc = b.HC + (size_t)kv * 4096 * 256; bf16* dst = kv == 0 ? b.KCMP : b.VCMP;
    naive_gemm(c, 4096, 64, 256, [=](int r, int k) { return bf2f(hc[(size_t)r * 256 + k]); }, p->in[kv == 0 ? 7 : 10] + (size_t)l * 256 * 64, 64,
               [=](int r, int col, float v) { dst[(size_t)r * 64 + col] = (bf16)f2bf((r & 255) == 255 ? 0.f : v); }); }
__device__ __noinline__ void P_win(KP p_, int l_) { const KP p = uni_kp(p_); const int l = __builtin_amdgcn_readfirstlane(l_); const Ctx c = make_ctx(p); const Bufs b = make_bufs(p->ws); ph_win_attn(c, b.QN, b.KW, b.VW, b.GATE, b.OWIN); }
__device__ __noinline__ void P_fox(KP p_, int l_) { const KP p = uni_kp(p_); const int l = __builtin_amdgcn_readfirstlane(l_); const Ctx c = make_ctx(p); const Bufs b = make_bufs(p->ws); ph_fox_attn(c, b.FQ, b.FK, b.FV, b.FL, b.ATT); }
__device__ __noinline__ void P_diff(KP p_, int l_) { const KP p = uni_kp(p_); const int l = __builtin_amdgcn_readfirstlane(l_); const Ctx c = make_ctx(p); const Bufs b = make_bufs(p->ws);
    ph_diff_attn(c, b.DQ, b.DK, b.DV, p->in[11] + (size_t)l * 128, p->in[12] + (size_t)l * 64, lambda_init_of(l), b.ATT); }
__device__ __noinline__ void P_cmpattn(KP p_, int l_) { const KP p = uni_kp(p_); const int l = __builtin_amdgcn_readfirstlane(l_); const Ctx c = make_ctx(p); const Bufs b = make_bufs(p->ws); ph_cmp_attn(c, b.QN, b.KCMP, b.VCMP, b.GATE, b.SEL, b.OCMP); }
__device__ __noinline__ void P_slc(KP p_, int l_) { const KP p = uni_kp(p_); const int l = __builtin_amdgcn_readfirstlane(l_); const Ctx c = make_ctx(p); const Bufs b = make_bufs(p->ws); ph_slc_attn(c, b.QN, b.KS, b.VS, b.GATE, b.SEL, b.OCMP, b.OWIN, b.ATT); }
__device__ __noinline__ void P_outproj(KP p_, int l_) { const KP p = uni_kp(p_); const int l = __builtin_amdgcn_readfirstlane(l_); const Ctx c = make_ctx(p); const Bufs b = make_bufs(p->ws);
    const bf16* A = b.ATT; float* xo = p->out; const float* xin = (l == 0) ? p->in[0] : p->out;
    naive_gemm(c, NT, D_, D_, [=](int r, int k) { return bf2f(A[(size_t)r * D_ + k]); }, p->in[13] + (size_t)l * D_ * D_, D_,
               [=](int r, int col, float v) { xo[(size_t)r * D_ + col] = xin[(size_t)r * D_ + col] + v; }); }
__device__ __forceinline__ void P_route3(int l_, int cbank) { const KP p = (KP)__builtin_amdgcn_kernarg_segment_ptr(); int l = l_; asm volatile("" : "+s"(l));
    int tid_ = threadIdx.x; asm volatile("" : "+v"(tid_));
    const int tid = tid_, lane = tid & 63, wave = __builtin_amdgcn_readfirstlane(tid >> 6), r = lane & 31, h = lane >> 5, kh = wave >> 2, wr = wave & 3;
    unsigned char* ws = p->ws; asm volatile("" : "+s"(ws)); const float* x = p->out;
    const float* WR = (const float*)(ws + WS_WR) + (size_t)l * D_ * 64;
    LAS float* XT = (LAS float*)lds_raw + wave * (32 * 36);
    LAS float* WT = (LAS float*)lds_raw + 8 * 32 * 36 + kh * (2 * 32 * 64);
    LAS float* PL = (LAS float*)lds_raw + 8 * 32 * 36 + 2 * 2 * 32 * 64;
    LAS float* SS = PL + 2 * 128 * 40;
    const float* bgrp = p->in[16] + l * 4; const float* bexp = p->in[18] + l * 32;
    unsigned* cnt = (unsigned*)(ws + WS_CTL) + CW_MOECNT + l * 128 + cbank;
    for (int grp = launder_s((int)blockIdx.x); grp < NT / 128; grp += (int)gridDim.x) {
        const int row0 = grp * 128 + wr * 32;
        f32x16 acc0, acc1; float ss = 0.f;
#pragma unroll
        for (int i = 0; i < 16; ++i) { acc0[i] = 0.f; acc1[i] = 0.f; }
        int buf = 0;
#pragma unroll 1
        for (int kc = 0; kc < 16; ++kc) {
            const int k0 = kh * 512 + kc * 32;
#pragma unroll
            for (int i = 0; i < 2; ++i) { const int idx = (tid & 255) + 256 * i, k = idx >> 4, c4 = (idx & 15) * 4; *(LAS f32x4*)(WT + buf * (32 * 64) + k * 64 + c4) = *(const f32x4*)(WR + (size_t)(k0 + k) * 64 + c4); }
            { const int row = lane >> 1, part = lane & 1; const float* xs = x + (size_t)(row0 + row) * D_ + k0 + part * 16;
#pragma unroll
              for (int j = 0; j < 4; ++j) { const f32x4 v = *(const f32x4*)(xs + 4 * j); ss += (v.x * v.x + v.y * v.y) + (v.z * v.z + v.w * v.w); *(LAS f32x4*)(XT + row * 36 + part * 16 + 4 * j) = v; } }
            __syncthreads();
            float a[16];
#pragma unroll
            for (int q = 0; q < 4; ++q) { const f32x4 t = *(const LAS f32x4*)(XT + r * 36 + 16 * h + 4 * q); a[4 * q] = t.x; a[4 * q + 1] = t.y; a[4 * q + 2] = t.z; a[4 * q + 3] = t.w; }
            const LAS float* wb = WT + buf * (32 * 64) + (16 * h) * 64 + r;
#pragma unroll
            for (int sidx = 0; sidx < 16; ++sidx) { const float b0 = wb[sidx * 64], b1 = wb[sidx * 64 + 32];
                acc0 = __builtin_amdgcn_mfma_f32_32x32x2f32(a[sidx], b0, acc0, 0, 0, 0); acc1 = __builtin_amdgcn_mfma_f32_32x32x2f32(a[sidx], b1, acc1, 0, 0, 0); }
            buf ^= 1;
        }
#pragma unroll
        for (int reg = 0; reg < 16; ++reg) { const int row = wr * 32 + crow0(reg) + 4 * h; PL[(kh * 128 + row) * 40 + r] = acc0[reg]; if (r < 4) PL[(kh * 128 + row) * 40 + 32 + r] = acc1[reg]; }
        SS[(kh * 128 + wr * 32 + (lane >> 1)) * 2 + (lane & 1)] = ss;
        __syncthreads();
        if (tid < 128) {
            float lg[36];
#pragma unroll
            for (int cidx = 0; cidx < 36; ++cidx) lg[cidx] = PL[tid * 40 + cidx] + PL[(128 + tid) * 40 + cidx];
            const float sq = (SS[tid * 2] + SS[tid * 2 + 1]) + (SS[(128 + tid) * 2] + SS[(128 + tid) * 2 + 1]);
            const float rstd = rsqrtf(sq * (1.f / D_) + EPS);
            float gl[4]; int grp_i = 0;
#pragma unroll
            for (int q = 0; q < 4; ++q) gl[q] = lg[q] * rstd + bgrp[q];
            float gm = gl[0];
#pragma unroll
            for (int q = 1; q < 4; ++q) if (gl[q] > gm) { gm = gl[q]; grp_i = q; }
            float gs = 0.f;
#pragma unroll
            for (int q = 0; q < 4; ++q) gs += __expf(gl[q] - gm);
            const float grp_gate = 1.f / gs;
            float el[8];
#pragma unroll
            for (int q = 0; q < 8; ++q) { float v = lg[4 + q]; float bb = bexp[q];
                if (grp_i == 1) { v = lg[12 + q]; bb = bexp[8 + q]; } else if (grp_i == 2) { v = lg[20 + q]; bb = bexp[16 + q]; } else if (grp_i == 3) { v = lg[28 + q]; bb = bexp[24 + q]; }
                el[q] = v * rstd + bb; }
            int i0 = 0; float v0 = el[0];
#pragma unroll
            for (int q = 1; q < 8; ++q) if (el[q] > v0) { v0 = el[q]; i0 = q; }
            int i1 = -1; float v1 = -INFINITY;
#pragma unroll
            for (int q = 0; q < 8; ++q) if (q != i0 && el[q] > v1) { v1 = el[q]; i1 = q; }
            const float e1 = __expf(v1 - v0), den = 1.f + e1, w0 = grp_gate / den, w1 = grp_gate * e1 / den;
            const int lo = i0 < i1 ? i0 : i1, hi = i0 < i1 ? i1 : i0, cls = grp_i * 28 + lo * 8 - (lo * (lo + 1)) / 2 + (hi - lo - 1);
            const unsigned rank = __hip_atomic_fetch_add(cnt + cls, 1u, __ATOMIC_RELAXED, __HIP_MEMORY_SCOPE_AGENT);
            const int row = grp * 128 + tid;
            ((unsigned*)(ws + WS_ROUTE + RT_INFO))[row] = ((unsigned)cls << 24) | rank;
            ((float*)(ws + WS_ROUTE + RT_W))[2 * row] = i0 < i1 ? w0 : w1; ((float*)(ws + WS_ROUTE + RT_W))[2 * row + 1] = i0 < i1 ? w1 : w0;
            ((float*)(ws + WS_ROUTE + RT_RSTD))[row] = rstd;
        }
        __syncthreads();
    }
}
typedef float f32x8 __attribute__((ext_vector_type(8)));
__device__ __forceinline__ void P_route2(int l_, int cbank) { const KP p = (KP)__builtin_amdgcn_kernarg_segment_ptr(); int l = l_; asm volatile("" : "+s"(l));
    int tid_ = threadIdx.x; asm volatile("" : "+v"(tid_));
    const int tid = tid_, lane = tid & 63, wave = __builtin_amdgcn_readfirstlane(tid >> 6);
    unsigned char* ws = p->ws; asm volatile("" : "+s"(ws)); const float* x = p->out;
    const float* WR = (const float*)(ws + WS_WR) + (size_t)l * D_ * 40;
    LAS float* xt = (LAS float*)lds_raw + wave * (64 * 36);
    LAS float* part = (LAS float*)lds_raw;
    const float* bgrp = p->in[16] + l * 4; const float* bexp = p->in[18] + l * 32;
    unsigned* cnt = (unsigned*)(ws + WS_CTL) + CW_MOECNT + l * 128 + cbank;
    for (int grp = launder_s((int)blockIdx.x); grp < NT / 128; grp += (int)gridDim.x) {
        const int row0 = grp * 128 + (wave >> 2) * 64, kq = wave & 3;
        float acc[40]; float ss = 0.f;
#pragma unroll
        for (int cidx = 0; cidx < 40; ++cidx) acc[cidx] = 0.f;
#pragma unroll 1
        for (int kc = 0; kc < 8; ++kc) {
            const int k0 = kq * 256 + kc * 32;
#pragma unroll
            for (int i = 0; i < 8; ++i) { const int row = i * 8 + (lane >> 3), c4 = (lane & 7) * 4; *(LAS f32x4*)(xt + row * 36 + c4) = *(const f32x4*)(x + (size_t)(row0 + row) * D_ + k0 + c4); }
            float xr[32];
#pragma unroll
            for (int j = 0; j < 8; ++j) { const f32x4 t = *(const LAS f32x4*)(xt + lane * 36 + 4 * j); xr[4 * j] = t.x; xr[4 * j + 1] = t.y; xr[4 * j + 2] = t.z; xr[4 * j + 3] = t.w; }
            const float* wk = WR + (size_t)k0 * 40;
#pragma unroll
            for (int kk = 0; kk < 32; ++kk) {
                f32x8 w0, w1, w2, w3, w4;
                asm volatile("s_load_dwordx8 %0, %5, %6\n\ts_load_dwordx8 %1, %5, %7\n\ts_load_dwordx8 %2, %5, %8\n\ts_load_dwordx8 %3, %5, %9\n\ts_load_dwordx8 %4, %5, %10\n\ts_waitcnt lgkmcnt(0)"
                             : "=&s"(w0), "=&s"(w1), "=&s"(w2), "=&s"(w3), "=&s"(w4) : "s"(wk), "i"(kk * 160), "i"(kk * 160 + 32), "i"(kk * 160 + 64), "i"(kk * 160 + 96), "i"(kk * 160 + 128) : "memory");
                const float xv = xr[kk]; ss = fmaf(xv, xv, ss);
#pragma unroll
                for (int e = 0; e < 8; ++e) { acc[e] = fmaf(xv, w0[e], acc[e]); acc[8 + e] = fmaf(xv, w1[e], acc[8 + e]); acc[16 + e] = fmaf(xv, w2[e], acc[16 + e]); acc[24 + e] = fmaf(xv, w3[e], acc[24 + e]); }
#pragma unroll
                for (int e = 0; e < 4; ++e) acc[32 + e] = fmaf(xv, w4[e], acc[32 + e]);
            }
        }
        __syncthreads();
#pragma unroll
        for (int cidx = 0; cidx < 36; ++cidx) part[(wave * 64 + lane) * 37 + cidx] = acc[cidx];
        part[(wave * 64 + lane) * 37 + 36] = ss;
        __syncthreads();
        if (tid < 128) {
            const int rg = tid >> 6, rr = tid & 63; float lg[37];
#pragma unroll
            for (int cidx = 0; cidx < 37; ++cidx) lg[cidx] = ((part[((rg * 4 + 0) * 64 + rr) * 37 + cidx] + part[((rg * 4 + 1) * 64 + rr) * 37 + cidx]) + part[((rg * 4 + 2) * 64 + rr) * 37 + cidx]) + part[((rg * 4 + 3) * 64 + rr) * 37 + cidx];
            const float rstd = rsqrtf(lg[36] * (1.f / D_) + EPS);
            float gl[4]; int grp_i = 0;
#pragma unroll
            for (int q = 0; q < 4; ++q) gl[q] = lg[q] * rstd + bgrp[q];
            float gm = gl[0];
#pragma unroll
            for (int q = 1; q < 4; ++q) if (gl[q] > gm) { gm = gl[q]; grp_i = q; }
            float gs = 0.f;
#pragma unroll
            for (int q = 0; q < 4; ++q) gs += __expf(gl[q] - gm);
            const float grp_gate = 1.f / gs;
            float el[8];
#pragma unroll
            for (int q = 0; q < 8; ++q) { float v = lg[4 + q]; float bb = bexp[q];
                if (grp_i == 1) { v = lg[12 + q]; bb = bexp[8 + q]; } else if (grp_i == 2) { v = lg[20 + q]; bb = bexp[16 + q]; } else if (grp_i == 3) { v = lg[28 + q]; bb = bexp[24 + q]; }
                el[q] = v * rstd + bb; }
            int i0 = 0; float v0 = el[0];
#pragma unroll
            for (int q = 1; q < 8; ++q) if (el[q] > v0) { v0 = el[q]; i0 = q; }
            int i1 = -1; float v1 = -INFINITY;
#pragma unroll
            for (int q = 0; q < 8; ++q) if (q != i0 && el[q] > v1) { v1 = el[q]; i1 = q; }
            const float e1 = __expf(v1 - v0), den = 1.f + e1, w0 = grp_gate / den, w1 = grp_gate * e1 / den;
            const int lo = i0 < i1 ? i0 : i1, hi = i0 < i1 ? i1 : i0, cls = grp_i * 28 + lo * 8 - (lo * (lo + 1)) / 2 + (hi - lo - 1);
            const unsigned rank = __hip_atomic_fetch_add(cnt + cls, 1u, __ATOMIC_RELAXED, __HIP_MEMORY_SCOPE_AGENT);
            const int row = grp * 128 + tid;
            ((unsigned*)(ws + WS_ROUTE + RT_INFO))[row] = ((unsigned)cls << 24) | rank;
            ((float*)(ws + WS_ROUTE + RT_W))[2 * row] = i0 < i1 ? w0 : w1; ((float*)(ws + WS_ROUTE + RT_W))[2 * row + 1] = i0 < i1 ? w1 : w0;
            ((float*)(ws + WS_ROUTE + RT_RSTD))[row] = rstd;
        }
        __syncthreads();
    }
}
__device__ __noinline__ void P_route(KP p_, int l_) { const KP p = uni_kp(p_); const int l = __builtin_amdgcn_readfirstlane(l_); const Ctx c = make_ctx(p); const Bufs b = make_bufs(p->ws);
    ph_moe_route(c, p->out, p->in[14] + (size_t)l * D_, p->in[15] + (size_t)l * D_ * 4, p->in[16] + l * 4, p->in[17] + (size_t)l * D_ * 32, p->in[18] + l * 32, b.HN, (int*)(p->ws + WS_ROUTE + RT_INFO), (float*)(p->ws + WS_ROUTE + RT_W), (unsigned*)(p->ws + WS_CTL) + CW_MOECNT + l * 128); }
__device__ __noinline__ void P_moe(KP p_, int l_) { const KP p = uni_kp(p_); const int l = __builtin_amdgcn_readfirstlane(l_); const Ctx c = make_ctx(p); const Bufs b = make_bufs(p->ws);
    ph_moe_naive(c, b.HN, b.ROUTE_E, b.ROUTE_W, p->in[19] + (size_t)l * NEXP * D_ * DEXP, p->in[20] + (size_t)l * NEXP * D_ * DEXP, p->in[21] + (size_t)l * NEXP * DEXP * D_, p->out); }
__device__ __noinline__ void P_final(KP p_) { const KP p = uni_kp(p_); const Ctx c = make_ctx(p); ph_norm_final(c, p->out, p->in[22]); }
__device__ __noinline__ void P_gridbar(KP p_) { const KP p = uni_kp(p_);
    XcdBarrier bar; bar.bar = (unsigned*)(p->ws + WS_CTL) + 4096; bar.x = xb_xcc_id(); bar.st = (volatile LAS unsigned*)((LAS unsigned char*)lds_raw + MISC_OFF) + 8;
    xcd_barrier(bar);
}

__global__ void __launch_bounds__(NTHREADS, 2) fwd_kernel(Params pp) {
    const KP p = (KP)__builtin_amdgcn_kernarg_segment_ptr();
    { volatile LAS unsigned* MISC = (volatile LAS unsigned*)((LAS unsigned char*)lds_raw + MISC_OFF); if (threadIdx.x < 32) MISC[threadIdx.x] = 0u; }
    __syncthreads();
    const int lo = p->ph_lo, hi = p->ph_hi;
    if (hi - lo > 1) (void)xcd_barrier_post((unsigned*)(p->ws + WS_CTL) + 4096, (volatile LAS unsigned*)((LAS unsigned char*)lds_raw + MISC_OFF) + 8);
#define IN(k) (lo <= (k) && (k) < hi)
#define SEAM(k) do { if (IN(k) && IN((k) + 1)) P_gridbar(p); } while (0)
    if (IN(0)) { for (int rep = 0; rep < REP_PRO; ++rep) { if (rep) P_gridbar(p); P_prologue(p); } }
    SEAM(0);
    for (int l = 0; l < L_; ++l) {
        const int P0 = 1 + l * PH_PER_LAYER;
        if (IN(P0 + 0)) { for (int rep = 0; rep < REP_NORM; ++rep) { if (rep) P_gridbar(p); P_norm1(p, l); } }
        SEAM(P0 + 0);
        if (IN(P0 + 1)) { for (int rep = 0; rep < REP_INPROJ; ++rep) { if (rep) P_gridbar(p); P_inproj_mfma(l); } }
        SEAM(P0 + 1);
        if (IN(P0 + 3)) {
            P_cmp1_mfma(l);
            if (launder_s((int)blockIdx.x) < 32) { asm volatile("s_waitcnt vmcnt(0)" ::: "memory"); __builtin_amdgcn_fence(__ATOMIC_SEQ_CST, "agent"); asm volatile("s_waitcnt vmcnt(0)" ::: "memory"); }
            __syncthreads();
            P_cmp2_mfma(l);
            for (int rep = 0; rep < REP_ATT3; ++rep) { if (rep) P_gridbar(p);
            for (;;) { const int u = fetch_unit(p, l * 8 + 0 + 16 * rep); if (u >= 2048) break;
                if (u < 1024) { const int qb = 15 - (u >> 6), k = u & 63; if (k < 32) U_diff(p, k, qb, l); else U_fox(p, k - 32, qb); }
                else { const int w = u - 1024; U_win(p, w & 15, 63 - (w >> 4)); } } } }
        SEAM(P0 + 3);
        if (IN(P0 + 4)) { for (int rep = 0; rep < REP_CMP; ++rep) { if (rep) P_gridbar(p); for (int u = launder_s((int)blockIdx.x); u < 256; u += (int)gridDim.x) U_cmp(p, u & 15, u >> 4); } }
        SEAM(P0 + 4);
        if (IN(P0 + 5)) { for (int rep = 0; rep < REP_SLC; ++rep) { if (rep) P_gridbar(p); for (;;) { const int u = fetch_unit(p, l * 8 + 1 + 16 * rep); if (u >= 1024) break; U_slc(p, u & 15, 63 - (u >> 4)); } } }
        SEAM(P0 + 5);
        if (IN(P0 + 6)) P_outproj_mfma(l);
        SEAM(P0 + 6);
        if (IN(P0 + 7)) { for (int rep = 0; rep < REP_ROUTE; ++rep) { if (rep) P_gridbar(p); P_route3(l, (REP_ROUTE - 1 - rep) * 256); } }
        SEAM(P0 + 7);
        if (IN(P0 + 8)) { for (int rep = 0; rep < REP_SCAT; ++rep) { if (rep) P_gridbar(p); P_moe_scatter(p, l); } }
        SEAM(P0 + 8);
        if (IN(P0 + 9)) { for (int rep = 0; rep < REP_G1; ++rep) { if (rep) P_gridbar(p); P_moe_g1(l); } }
        SEAM(P0 + 9);
        if (IN(P0 + 10)) P_moe_g2(l);
        SEAM(P0 + 10);
    }
    if (IN(1 + L_ * PH_PER_LAYER)) P_final(p);
#undef IN
#undef SEAM
}

extern "C" void kernel_launch(void* const* d_in, const int* in_sizes, int n_in, void* d_out, int out_size, void* d_ws, size_t ws_size, hipStream_t stream) {
    static int grid = 0;
    if (grid == 0) {
        if (n_in != 23 || out_size != NT * D_ || ws_size < WS_END) { fprintf(stderr, "kernel_launch: unexpected sizes n_in %d out %d ws %zu (need %zu)\n", n_in, out_size, ws_size, (size_t)WS_END); grid = -1; return; }
        int dev = 0, cus = 0, per_cu = 0;
        if (hipGetDevice(&dev) != hipSuccess || hipDeviceGetAttribute(&cus, hipDeviceAttributeMultiprocessorCount, dev) != hipSuccess) { grid = -1; return; }
        if (hipFuncSetAttribute((const void*)fwd_kernel, hipFuncAttributeMaxDynamicSharedMemorySize, LDS_BYTES) != hipSuccess) { fprintf(stderr, "kernel_launch: hipFuncSetAttribute failed\n"); grid = -1; return; }
        if (hipOccupancyMaxActiveBlocksPerMultiprocessor(&per_cu, (const void*)fwd_kernel, NTHREADS, LDS_BYTES) != hipSuccess || per_cu < 1) { fprintf(stderr, "kernel_launch: occupancy query says %d\n", per_cu); }
        (void)hipGetLastError();
        grid = cus;
    }
    if (grid < 0) return;
    (void)hipMemsetAsync((char*)d_ws + WS_CTL, 0, CTL_BYTES, stream);
    Params p{};
    for (int i = 0; i < 23; ++i) p.in[i] = (const float*)d_in[i];
    p.out = (float*)d_out; p.ws = (unsigned char*)d_ws;
#if N_LAUNCH_MODE == 0
    p.ph_lo = 0; p.ph_hi = N_PHASES;
    hipLaunchKernelGGL(fwd_kernel, dim3(grid), dim3(NTHREADS), LDS_BYTES, stream, p);
#else
    for (int k = 0; k < N_PHASES; ++k) { p.ph_lo = k; p.ph_hi = k + 1; hipLaunchKernelGGL(fwd_kernel, dim3(grid), dim3(NTHREADS), LDS_BYTES, stream, p); }
#endif
}
```

```cpp
#include <hip/hip_runtime.h>
#include <cstdio>
#include <cstdint>

#ifndef INPROJ_ALIGN
#define INPROJ_ALIGN true
#endif
#ifndef INPROJ_SP2
#define INPROJ_SP2 true
#endif
#ifndef REP_PRO
#define REP_PRO 1
#endif
#ifndef REP_ROUTE
#define REP_ROUTE 1
#endif
#ifndef REP_NORM
#define REP_NORM 1
#endif
#ifndef REP_INPROJ
#define REP_INPROJ 1
#endif
#ifndef REP_ATT3
#define REP_ATT3 1
#endif
#ifndef REP_CMP
#define REP_CMP 1
#endif
#ifndef REP_SLC
#define REP_SLC 1
#endif
#ifndef REP_SCAT
#define REP_SCAT 1
#endif
#ifndef REP_G1
#define REP_G1 1
#endif
#ifndef N_LAUNCH_MODE
#define N_LAUNCH_MODE 0
#endif

#define LAS __attribute__((address_space(3)))
#define GAS __attribute__((address_space(1)))
typedef unsigned short bf16;
typedef unsigned long long u64;
typedef float f32x4 __attribute__((ext_vector_type(4)));
typedef unsigned u32x4 __attribute__((ext_vector_type(4)));

constexpr int B_ = 8, T_ = 4096, D_ = 1024, NT = B_ * T_, L_ = 2;
constexpr int HD = 64, D_IN = 2844;
constexpr int N_CMP = 255, CMP_HID = 256;
constexpr int NEXP = 32, DEXP = 256;
constexpr float EPS = 1e-6f;
constexpr float LOG2E = 1.4426950408889634f;
constexpr int NWAVES = 8, NTHREADS = 512;

constexpr int C_NSAQ = 0, C_KV6 = 512, C_GATE = 1280, C_FQ = 1304, C_FF = 2072, C_DQ = 2076, C_DV = 2588;

constexpr size_t MiB = 1u << 20;
constexpr size_t WS_CTL = 0, CTL_BYTES = 1 * MiB;
constexpr size_t WS_QN = 1 * MiB;
constexpr size_t WS_KV6 = WS_QN + 32 * MiB;
constexpr size_t KV6_STRIDE = 8 * MiB + 64 * 1024;
constexpr size_t WS_FQKV = WS_KV6 + 6 * KV6_STRIDE;
constexpr size_t WS_DQK = WS_FQKV + 48 * MiB;
constexpr size_t WS_DV = WS_DQK + 32 * MiB;
constexpr size_t WS_GATE = WS_DV + 16 * MiB;
constexpr size_t WS_FL = WS_GATE + 3 * MiB;
constexpr size_t WS_HC = WS_FL + 1 * MiB;
constexpr size_t WS_KVCMP = WS_HC + 4 * MiB;
constexpr size_t WS_SEL = WS_KVCMP + 1 * MiB;
constexpr size_t WS_OCMP = WS_SEL + 1 * MiB;
constexpr size_t WS_OWIN = WS_OCMP + 32 * MiB;
constexpr size_t WS_HN = WS_OWIN + 32 * MiB;
constexpr size_t WS_ATT = WS_HN + 64 * MiB;
constexpr size_t WS_ROUTE = WS_ATT + 64 * MiB;
constexpr size_t WS_WIN_T = WS_ROUTE + 2 * MiB;
constexpr size_t WS_WOUT_T = WS_WIN_T + 12 * MiB;
constexpr size_t WS_WGU_T = WS_WOUT_T + 4 * MiB;
constexpr size_t WS_WD_T = WS_WGU_T + 64 * MiB;
constexpr size_t WS_W1_T = WS_WD_T + 32 * MiB;
constexpr size_t WS_W2_T = WS_W1_T + 4 * MiB;
constexpr size_t WS_BIAS1 = WS_W2_T + 512 * 1024;
constexpr size_t WS_WR = WS_BIAS1 + 512 * 1024;
constexpr size_t WS_B1PART = WS_WR + 512 * 1024;
constexpr size_t WS_END = WS_B1PART + 512 * 1024;
constexpr int MOE_MAXROWS = 61440;
constexpr size_t WS_XS = WS_QN;
constexpr size_t WS_HB = WS_OCMP;
static_assert(WS_XS + (size_t)MOE_MAXROWS * 2048 <= WS_DQK && WS_HB + (size_t)MOE_MAXROWS * 1024 <= WS_HN, "MoE aliases");
constexpr size_t RT_INFO = 0, RT_W = 128 * 1024, RT_ROWTOK = 384 * 1024, RT_ROWW = 640 * 1024, RT_RSTD = 1152 * 1024;
constexpr int CW_QUEUE = 16384, CW_MOECNT = 32768, CW_KN = 49152;
constexpr int TBL_OFF = 131072 + 1024;
constexpr int NIN = 3072;

extern __shared__ __attribute__((aligned(16))) unsigned char lds_raw[];
__device__ __forceinline__ float bf2f(bf16 v) { return __uint_as_float(((unsigned)v) << 16); }
__device__ __forceinline__ unsigned f2bf(float f) { unsigned u = __float_as_uint(f); return (u + 0x7fffu + ((u >> 16) & 1u)) >> 16; }
__device__ __forceinline__ unsigned pk2(float lo, float hi) { return f2bf(lo) | (f2bf(hi) << 16); }
__device__ __forceinline__ float wave_sum(float v) {
#pragma unroll
    for (int o = 1; o < 64; o <<= 1) v += __shfl_xor(v, o);
    return v;
}
__device__ __forceinline__ float wave_max(float v) {
#pragma unroll
    for (int o = 1; o < 64; o <<= 1) v = fmaxf(v, __shfl_xor(v, o));
    return v;
}
__device__ __forceinline__ float shflx_f(float v, int o, int lane) { return __uint_as_float((unsigned)__builtin_amdgcn_ds_bpermute((lane ^ o) << 2, (int)__float_as_uint(v))); }
__device__ __forceinline__ unsigned shflx_u(unsigned v, int o, int lane) { return (unsigned)__builtin_amdgcn_ds_bpermute((lane ^ o) << 2, (int)v); }
__device__ __forceinline__ float wave_sum_l(float v, int lane) {
#pragma unroll
    for (int o = 1; o < 64; o <<= 1) v += shflx_f(v, o, lane);
    return v;
}
__device__ __forceinline__ int launder_s(int v) { asm volatile("" : "+s"(v)); return v; }
__device__ __forceinline__ float sigmoidf_(float x) { return 1.f / (1.f + __expf(-x)); }
__device__ __forceinline__ float log_sigmoidf_(float x) { return x >= 0.f ? -log1pf(__expf(-x)) : x - log1pf(__expf(x)); }
__device__ __forceinline__ float gelu_tanh(float x) { const float u = 0.7978845608028654f * (x + 0.044715f * x * x * x); return 0.5f * x * (1.f + tanhf(u)); }
__device__ __forceinline__ float alibi_slope(int idx1, int n) { return exp2f(-8.0f * (float)idx1 / (float)n); }

#define XB_TMO      128
#define XB_XCNT(j)  (256  + 64 * (j))
#define XB_XSUB(j)  (1280 + 64 * (j))
#define XB_XGEN(j)  (2304 + 64 * (j))
#define XB_TOP      3328
#define XB_TOPGEN   3392
#define XCD_BAR_WORDS 3456
#define XB_SPIN_CAP (1u << 25)
__device__ __forceinline__ unsigned xb_ld(unsigned* p)              { return __hip_atomic_load(p, __ATOMIC_RELAXED, __HIP_MEMORY_SCOPE_AGENT); }
__device__ __forceinline__ unsigned xb_add(unsigned* p, unsigned v) { return __hip_atomic_fetch_add(p, v, __ATOMIC_RELAXED, __HIP_MEMORY_SCOPE_AGENT); }
__device__ __forceinline__ unsigned xb_xcc_id() { return (unsigned)__builtin_amdgcn_s_getreg((3 << 11) | 20) & 0xFu; }
#define XB_SPIN(cond, bar) do { unsigned _sp = 0; while (cond) { __builtin_amdgcn_s_sleep(1); \
    if ((++_sp & 255u) == 0u) { if (xb_ld(&(bar)[XB_TMO])) break; if (_sp > XB_SPIN_CAP) { atomicAdd(&(bar)[XB_TMO], 1u); break; } } } } while (0)
struct XcdBarrier { unsigned* bar; unsigned x; volatile LAS unsigned* st; };
__device__ __forceinline__ XcdBarrier xcd_barrier_post(unsigned* bar, volatile LAS unsigned* st) {
    XcdBarrier b; b.bar = bar; b.x = xb_xcc_id(); b.st = st;
    if (threadIdx.x == 0) (void)xb_add(&bar[XB_XCNT(b.x)], 1u);
    return b;
}
__device__ __forceinline__ void xcd_barrier_complete(unsigned* bar, unsigned x, unsigned& nloc, unsigned& nx) {
    const unsigned G = gridDim.x * gridDim.y * gridDim.z;
    unsigned sum, cnt, mine, sp = 0u;
    for (;;) {
        sum = 0u; cnt = 0u; mine = 0u;
#pragma unroll
        for (unsigned j = 0; j < 16; ++j) { const unsigned c = xb_ld(&bar[XB_XCNT(j)]); sum += c; cnt += (c > 0u) ? 1u : 0u; mine = (j == x) ? c : mine; }
        if (sum == G) break;
        __builtin_amdgcn_s_sleep(1);
        if ((++sp & 255u) == 0u) { if (xb_ld(&bar[XB_TMO])) break; if (sp > XB_SPIN_CAP) { atomicAdd(&bar[XB_TMO], 1u); break; } }
    }
    nloc = mine > 0u ? mine : 1u; nx = cnt > 0u ? cnt : 1u;
}
__device__ __forceinline__ void xcd_barrier(const XcdBarrier& b) {
    asm volatile("s_waitcnt vmcnt(0)" ::: "memory");
    __syncthreads();
    if (threadIdx.x == 0) {
        unsigned* bar = b.bar;
        __builtin_amdgcn_s_waitcnt(0);
        unsigned nloc = b.st[0], nx = b.st[1];
        if (nloc == 0u) { xcd_barrier_complete(bar, b.x, nloc, nx); b.st[0] = nloc; b.st[1] = nx; }
        const unsigned old = xb_add(&bar[XB_XSUB(b.x)], 1u);
        const unsigned gen = old / nloc;
        if (old + 1u == (gen + 1u) * nloc) {
            __builtin_amdgcn_fence(__ATOMIC_RELEASE, "agent");
            asm volatile("s_waitcnt vmcnt(0)" ::: "memory");
            const unsigned og = xb_add(&bar[XB_TOP], 1u);
            const unsigned tg = og / nx;
            if (og + 1u == (tg + 1u) * nx) xb_add(&bar[XB_TOPGEN], 1u);
            else XB_SPIN(xb_ld(&bar[XB_TOPGEN]) == tg, bar);
            __builtin_amdgcn_fence(__ATOMIC_ACQUIRE, "agent");
            xb_add(&bar[XB_XGEN(b.x)], 1u);
            asm volatile("s_waitcnt vmcnt(0)" ::: "memory");
        } else {
            XB_SPIN(xb_ld(&bar[XB_XGEN(b.x)]) == gen, bar);
            __builtin_amdgcn_fence(__ATOMIC_ACQUIRE, "agent");
            asm volatile("s_waitcnt vmcnt(0)" ::: "memory");
        }
    }
    __syncthreads();
}

struct Params { const float* in[23]; float* out; unsigned char* ws; int ph_lo, ph_hi; };
constexpr int LDS_BYTES = 147456;
constexpr int MISC_OFF = 131072 + 320;

struct Ctx {
    LAS unsigned char* lds; int tid, lane, wave, bid, G, gw, ngw;
    const float* const* in; float* xcur; unsigned char* ws;
};

namespace pg8 {
#define PG8_LAS __attribute__((address_space(3)))
typedef unsigned short bf16_t;
typedef short bf16x8 __attribute__((ext_vector_type(8)));
typedef float f32x4 __attribute__((ext_vector_type(4)));
typedef unsigned u32x4 __attribute__((ext_vector_type(4)));
constexpr int BM = 256, BK = 64, HALF = 128, HTB = HALF * BK * 2  , STAGE_BYTES = 8 * HTB, NXCD = 8, WGM = 8;

__host__ __device__ __forceinline__ int lds_byte(int r, int c) { const int st = (r >> 4) * 2 + (c >> 5), rr = r & 15, cc = c & 31, ob = rr * 64 + cc * 2; return st * 1024 + (ob ^ (((ob >> 9) & 1) << 5)); }
__host__ __device__ __forceinline__ void stage_rc(int b, int& R, int& C) { const int st = b / 1024, sb = b % 1024, swz = sb ^ (((sb >> 9) & 1) << 5); R = (st >> 1) * 16 + swz / 64; C = (st & 1) * 32 + (swz % 64) / 2; }
__host__ __device__ __forceinline__ int perm32(int rho) { const int n = rho >> 4, i = rho & 15; return 8 * (i >> 2) + 4 * n + (i & 3); }

struct Unit { int pm, pn; const char* a; const char* b; const char* b2; };
struct Gemm { int lda, ldb, K, ksplit; };

__device__ __forceinline__ unsigned cvt_pk_bf16(float lo, float hi) { unsigned r; asm volatile("v_cvt_pk_bf16_f32 %0, %1, %2" : "=v"(r) : "v"(lo), "v"(hi)); return r; }
typedef float f32x2 __attribute__((ext_vector_type(2)));

template <class Epi, class Sched, bool ALIGN_EPI = false, bool SP2 = false>
__device__ __forceinline__ void gemm_phase(PG8_LAS unsigned char* lds, const Gemm g, const Sched& S, const Epi& E) {
    int tid_ = threadIdx.x; asm volatile("" : "+v"(tid_));
    const int tid = tid_, wid = __builtin_amdgcn_readfirstlane(tid >> 6), lane = tid & 63, wr = wid >> 2, wc = wid & 3, fr = lane & 15, fq = lane >> 4;
    const int K = g.K, nt = K / BK, ks = g.ksplit;
    unsigned voffA[2], voffB[2];
#pragma unroll
    for (int i = 0; i < 2; ++i) { int R, C; stage_rc(tid * 16 + i * 8192, R, C); const int Rb = Epi::PERM ? ((R & ~31) + perm32(R & 31)) : R;
        voffA[i] = (unsigned)(R * g.lda + C) * 2u; voffB[i] = (unsigned)(Rb * g.ldb + C) * 2u; }
    const size_t kstep = (size_t)(BK * 2);
    const size_t hsA = (size_t)HALF * g.lda * 2, hsB = (size_t)HALF * g.ldb * 2;
    const unsigned ldsw = (unsigned)wid * 1024u;
    const int aoff = lds_byte(wr * 64 + fr, fq * 8), boff = lds_byte(wc * 32 + fr, fq * 8);
#define PG8_SA(b, h) (((b) * 2 + (h)) * HTB)
#define PG8_SB(b, h) ((4 + (b) * 2 + (h)) * HTB)
#define PG8_STAGE(bufoff, gbase, voff) do { _Pragma("unroll") for (int _i = 0; _i < 2; ++_i) \
        __builtin_amdgcn_global_load_lds((const unsigned*)((const char*)(gbase) + (voff)[_i]), (PG8_LAS unsigned*)(lds + (bufoff) + ldsw + _i * 8192), 16, 0, 0); } while (0)
#define PG8_LDA(dst, b, h) do { _Pragma("unroll") for (int m = 0; m < 4; ++m) _Pragma("unroll") for (int k = 0; k < 2; ++k) dst[m][k] = *(const PG8_LAS bf16x8*)(lds + PG8_SA(b, h) + aoff + m * 2048 + k * 1024); } while (0)
#define PG8_LDB(dst, b, h) do { _Pragma("unroll") for (int n = 0; n < 2; ++n) _Pragma("unroll") for (int k = 0; k < 2; ++k) dst[n][k] = *(const PG8_LAS bf16x8*)(lds + PG8_SB(b, h) + boff + n * 2048 + k * 1024); } while (0)
#define PG8_MMA(ai, bj, At, Bt) do { __builtin_amdgcn_s_setprio(1); _Pragma("unroll") for (int m = 0; m < 4; ++m) _Pragma("unroll") for (int n = 0; n < 2; ++n) _Pragma("unroll") for (int k = 0; k < 2; ++k) \
        acc[ai][bj][m][n] = __builtin_amdgcn_mfma_f32_16x16x32_bf16(Bt[n][k], At[m][k], acc[ai][bj][m][n], 0, 0, 0); __builtin_amdgcn_s_setprio(0); } while (0)
#define PG8_WAIT_V(n) asm volatile("s_waitcnt vmcnt(" #n ")" ::: "memory")
#define PG8_WAIT_L(n) asm volatile("s_waitcnt lgkmcnt(" #n ")" ::: "memory")
#define PG8_BAR __builtin_amdgcn_s_barrier()
#define PG8_SCHED __builtin_amdgcn_sched_barrier(0)
    Unit cur, nxt; int ui = 0;
    if (!S.next(0, cur)) return;
    f32x4 acc[2][2][4][2];
#pragma unroll
    for (int a = 0; a < 2; ++a)
#pragma unroll
        for (int b = 0; b < 2; ++b)
#pragma unroll
            for (int m = 0; m < 4; ++m)
#pragma unroll
                for (int n = 0; n < 2; ++n) acc[a][b][m][n] = (f32x4){0.f, 0.f, 0.f, 0.f};
    bf16x8 At[4][2], B0[2][2], B1[2][2];
    const char* cA = cur.a; const char* cB = cur.b; const char* cB2 = cur.b2;
#define PG8_BK(base, base2, kt) ((kt) < ks ? (base) + (size_t)(kt) * kstep : (base2) + (size_t)((kt) - ks) * kstep)
    S.a_ready(cur);
    if constexpr (SP2) {
        PG8_STAGE(PG8_SB(0, 0), cB, voffB); PG8_STAGE(PG8_SB(0, 1), cB + hsB, voffB); PG8_STAGE(PG8_SA(0, 0), cA, voffA); PG8_STAGE(PG8_SA(0, 1), cA + hsA, voffA);
        if (wr == 1) PG8_BAR;
        PG8_WAIT_V(2); PG8_BAR;
        PG8_STAGE(PG8_SB(1, 0), PG8_BK(cB, cB2, 1), voffB); PG8_STAGE(PG8_SA(1, 0), cA + kstep, voffA); PG8_STAGE(PG8_SB(1, 1), PG8_BK(cB, cB2, 1) + hsB, voffB);
        PG8_WAIT_V(6); PG8_BAR;
    } else {
        PG8_STAGE(PG8_SB(0, 0), cB, voffB); PG8_STAGE(PG8_SA(0, 0), cA, voffA); PG8_STAGE(PG8_SB(0, 1), cB + hsB, voffB); PG8_STAGE(PG8_SA(0, 1), cA + hsA, voffA);
        if (wr == 1) PG8_BAR;
        PG8_WAIT_V(4); PG8_BAR;
        PG8_STAGE(PG8_SB(1, 0), PG8_BK(cB, cB2, 1), voffB); PG8_STAGE(PG8_SA(1, 0), cA + kstep, voffA); PG8_STAGE(PG8_SB(1, 1), PG8_BK(cB, cB2, 1) + hsB, voffB);
        PG8_WAIT_V(6); PG8_BAR;
    }
    for (;;) {
        const bool has_next = S.next(ui + 1, nxt);
        const char* nA = has_next ? nxt.a : cA; const char* nB = has_next ? nxt.b : cB; const char* nB2 = has_next ? nxt.b2 : cB2;
#pragma unroll 1
        for (int t = 0; t < nt; t += 2) {
            const bool last = (t == nt - 2);
            const char* a1 = cA + (size_t)(t + 1) * kstep;
            const char* a2 = last ? nA : cA + (size_t)(t + 2) * kstep; const char* b2 = last ? PG8_BK(nB, nB2, 0) : PG8_BK(cB, cB2, t + 2);
            const char* a3 = a2 + kstep; const char* b3 = last ? PG8_BK(nB, nB2, 1) : PG8_BK(cB, cB2, t + 3);
            if (last && has_next) S.a_ready(nxt);
            if constexpr (SP2) {
            PG8_LDB(B0, 0, 0); PG8_LDB(B1, 0, 1); PG8_SCHED; PG8_LDA(At, 0, 0); PG8_STAGE(PG8_SA(1, 1), a1 + hsA, voffA);
            PG8_WAIT_V(8); PG8_WAIT_L(0); PG8_BAR; PG8_MMA(0, 0, At, B0); PG8_MMA(0, 1, At, B1); PG8_BAR; PG8_SCHED;
            PG8_LDA(At, 0, 1); PG8_STAGE(PG8_SB(0, 0), b2, voffB); PG8_STAGE(PG8_SB(0, 1), b2 + hsB, voffB); PG8_STAGE(PG8_SA(0, 0), a2, voffA);
            PG8_WAIT_V(8); PG8_WAIT_L(0); PG8_BAR; PG8_MMA(1, 0, At, B0); PG8_MMA(1, 1, At, B1); PG8_BAR; PG8_SCHED;
            PG8_LDB(B0, 1, 0); PG8_LDB(B1, 1, 1); PG8_SCHED; PG8_LDA(At, 1, 0); PG8_STAGE(PG8_SA(0, 1), a2 + hsA, voffA);
            PG8_WAIT_V(8); PG8_WAIT_L(0); PG8_BAR; PG8_MMA(0, 0, At, B0); PG8_MMA(0, 1, At, B1); PG8_BAR; PG8_SCHED;
            PG8_LDA(At, 1, 1); PG8_STAGE(PG8_SB(1, 0), b3, voffB); PG8_STAGE(PG8_SB(1, 1), b3 + hsB, voffB); PG8_STAGE(PG8_SA(1, 0), a3, voffA);
            PG8_WAIT_V(8); PG8_WAIT_L(0); PG8_BAR; PG8_MMA(1, 0, At, B0); PG8_MMA(1, 1, At, B1); PG8_BAR; PG8_SCHED;
            } else {
            PG8_LDB(B0, 0, 0); PG8_SCHED; PG8_LDA(At, 0, 0); PG8_STAGE(PG8_SA(1, 1), a1 + hsA, voffA);
            PG8_WAIT_L(8); PG8_BAR; PG8_WAIT_L(0); PG8_MMA(0, 0, At, B0); PG8_BAR; PG8_SCHED;
            PG8_LDB(B1, 0, 1); PG8_STAGE(PG8_SB(0, 0), b2, voffB);
            PG8_BAR; PG8_WAIT_L(0); PG8_MMA(0, 1, At, B1); PG8_BAR;
            PG8_LDA(At, 0, 1); PG8_STAGE(PG8_SA(0, 0), a2, voffA);
            PG8_BAR; PG8_WAIT_L(0); PG8_MMA(1, 0, At, B0); PG8_BAR; PG8_SCHED;
            PG8_STAGE(PG8_SB(0, 1), b2 + hsB, voffB);
            PG8_WAIT_V(6); PG8_BAR; PG8_MMA(1, 1, At, B1); PG8_BAR;
            PG8_LDB(B0, 1, 0); PG8_SCHED; PG8_LDA(At, 1, 0); PG8_STAGE(PG8_SA(0, 1), a2 + hsA, voffA);
            PG8_WAIT_L(8); PG8_BAR; PG8_WAIT_L(0); PG8_MMA(0, 0, At, B0); PG8_BAR; PG8_SCHED;
            PG8_LDB(B1, 1, 1); PG8_STAGE(PG8_SB(1, 0), b3, voffB);
            PG8_BAR; PG8_WAIT_L(0); PG8_MMA(0, 1, At, B1); PG8_BAR;
            PG8_LDA(At, 1, 1); PG8_STAGE(PG8_SA(1, 0), a3, voffA);
            PG8_BAR; PG8_WAIT_L(0); PG8_MMA(1, 0, At, B0); PG8_BAR; PG8_SCHED;
            PG8_STAGE(PG8_SB(1, 1), b3 + hsB, voffB);
            PG8_WAIT_V(6); PG8_BAR; PG8_MMA(1, 1, At, B1); PG8_BAR;
            }
        }
        if constexpr (ALIGN_EPI) { if (wr == 0) PG8_BAR; }
        if constexpr (!Epi::AFTER_DRAIN) { E(acc, cur, wr, wc, fr, fq); S.done(cur); }
        if (!has_next) break;
#pragma unroll
        for (int a = 0; a < 2; ++a)
#pragma unroll
            for (int b = 0; b < 2; ++b)
#pragma unroll
                for (int m = 0; m < 4; ++m)
#pragma unroll
                    for (int n = 0; n < 2; ++n) acc[a][b][m][n] = (f32x4){0.f, 0.f, 0.f, 0.f};
        cur = nxt; cA = nA; cB = nB; cB2 = nB2; ++ui;
        if constexpr (ALIGN_EPI) { if (wr == 1) PG8_BAR; }
    }
    PG8_WAIT_V(0);
    if constexpr (!ALIGN_EPI) { if (wr == 0) PG8_BAR; }
    PG8_BAR;
    if constexpr (Epi::AFTER_DRAIN) { E.fused(acc, cur, wr, wc, fr, fq, lds, wid, lane); S.done(cur); }
#undef PG8_BK
#undef PG8_SA
#undef PG8_SB
#undef PG8_STAGE
#undef PG8_LDA
#undef PG8_LDB
#undef PG8_MMA
#undef PG8_WAIT_V
#undef PG8_WAIT_L
#undef PG8_BAR
#undef PG8_SCHED
}
}

struct PlainOrder {
    const char* A; const char* Bt; int lda, ldb, nM, nN, nwg, G, c;
    __device__ __forceinline__ void init(const void* A_, const void* Bt_, int lda_, int ldb_, int M, int N, int G_, int c_) { A = (const char*)A_; Bt = (const char*)Bt_; lda = lda_; ldb = ldb_; nM = M / 256; nN = N / 256; nwg = nM * nN; G = G_; c = c_; }
    __device__ __forceinline__ bool next(int i, pg8::Unit& u) const {
        const long L = (long)i * G + c; if (L >= nwg) return false;
        int wgid = (int)L; { const int q = nwg / 8, r = nwg % 8, xcd = wgid % 8, off = wgid / 8; wgid = (xcd < r ? xcd * (q + 1) : r * (q + 1) + (xcd - r) * q) + off; }
        const int nig = 8 * nN, gid = wgid / nig, fm = gid * 8, gsz = (nM - fm) < 8 ? (nM - fm) : 8;
        u.pm = fm + ((wgid % nig) % gsz); u.pn = (wgid % nig) / gsz;
        u.a = A + (size_t)u.pm * 256 * lda * 2; u.b = Bt + (size_t)u.pn * 256 * ldb * 2; u.b2 = u.b; return true;
    }
    __device__ __forceinline__ void a_ready(const pg8::Unit&) const {}
    __device__ __forceinline__ void done(const pg8::Unit&) const {}
};
struct EpiInProj {
    static constexpr bool PERM = true, AFTER_DRAIN = false;
    unsigned char* ws; const float* b_gate; const float* b_fgt; unsigned* kn;
    __device__ __forceinline__ void operator()(const pg8::f32x4 (&acc)[2][2][4][2], const pg8::Unit& u, int wr, int wc, int fr, int fq) const {
        { int t_ = threadIdx.x; asm volatile("" : "+v"(t_)); fr = t_ & 15; fq = (t_ >> 4) & 3; }
        const int pn = u.pn, b = (u.pm * 256) / T_, t0 = u.pm * 256 - b * T_ + wr * 64 + fr;
        if (pn == 11) {
            if (wc == 0 && fq < 4) {
                float* gate = (float*)(ws + WS_GATE); float* fl = (float*)(ws + WS_FL);
#pragma unroll
                for (int ai = 0; ai < 2; ++ai)
#pragma unroll
                    for (int m = 0; m < 4; ++m) { const int t = t0 + ai * 128 + m * 16; const size_t n = (size_t)b * T_ + t;
#pragma unroll
                        for (int nn = 0; nn < 2; ++nn)
#pragma unroll
                            for (int e = 0; e < 4; ++e) { const int c = 8 * fq + 4 * nn + e; const float v = acc[ai][0][m][nn][e];
                                if (c < 24) gate[n * 24 + c] = sigmoidf_(v + b_gate[c]);
                                else if (c < 28) fl[(size_t)(b * 4 + (c - 24)) * T_ + t] = log_sigmoidf_(v + b_fgt[c - 24]); } }
            }
            return;
        }
        if (pn == 6 || pn == 9) {
            const int lane_ = (fq << 4) | fr;
#pragma unroll
            for (int bj = 0; bj < 2; ++bj)
#pragma unroll
                for (int ai = 0; ai < 2; ++ai) { float mx = 0.f;
#pragma unroll
                    for (int m = 0; m < 4; ++m) { const pg8::f32x4 v0 = acc[ai][bj][m][0], v1 = acc[ai][bj][m][1];
                        float ss = (v0[0] * v0[0] + v0[1] * v0[1]) + (v0[2] * v0[2] + v0[3] * v0[3]) + (v1[0] * v1[0] + v1[1] * v1[1]) + (v1[2] * v1[2] + v1[3] * v1[3]);
                        ss += shflx_f(ss, 16, lane_); ss += shflx_f(ss, 32, lane_); mx = fmaxf(mx, ss); }
#pragma unroll
                    for (int o = 1; o < 16; o <<= 1) mx = fmaxf(mx, shflx_f(mx, o, lane_));
                    if (lane_ == 0) { const int cg = bj * 4 + wc, tile = (u.pm * 256 - b * T_ + ai * 128 + wr * 64) >> 6;
                        unsigned* dst = pn == 6 ? kn + ((b * 4 + (cg >> 1)) * 64 + tile) * 2 + (cg & 1) : kn + 4096 + (b * 8 + cg) * 64 + tile;
                        atomicMax(dst, __float_as_uint(mx)); } }
        }
#pragma unroll
        for (int bj = 0; bj < 2; ++bj) {
            const int c = bj * 128 + wc * 32 + 8 * fq;
            bf16* base; int W = 64; float sc = 1.f;
            if (pn < 2) { base = (bf16*)(ws + WS_QN) + (size_t)(b * 8 + pn * 4 + (c >> 6)) * T_ * 64 + (c & 63); sc = 0.125f * LOG2E; }
            else if (pn < 5) { base = (bf16*)(ws + WS_KV6 + (size_t)((pn - 2) * 2 + (c >> 7)) * KV6_STRIDE) + (size_t)(b * 2 + ((c >> 6) & 1)) * T_ * 64 + (c & 63); }
            else if (pn < 8) { base = (bf16*)(ws + WS_FQKV) + (size_t)(pn - 5) * (8 * MiB) + (size_t)(b * 4 + (c >> 6)) * T_ * 64 + (c & 63); if (pn == 5) sc = 0.125f * LOG2E; }
            else if (pn < 10) { base = (bf16*)(ws + WS_DQK) + (size_t)(pn - 8) * (8 * MiB) + (size_t)(b * 8 + (c >> 5)) * T_ * 32 + (c & 31); W = 32; if (pn == 8) sc = 0.17677669529663687f * LOG2E; }
            else { base = (bf16*)(ws + WS_DV) + (size_t)(b * 4 + (c >> 6)) * T_ * 64 + (c & 63); }
#pragma unroll
            for (int ai = 0; ai < 2; ++ai)
#pragma unroll
                for (int m = 0; m < 4; ++m) { const int t = t0 + ai * 128 + m * 16;
                    const pg8::f32x4 v0 = acc[ai][bj][m][0] * sc, v1 = acc[ai][bj][m][1] * sc;
                    pg8::u32x4 w; w.x = pg8::cvt_pk_bf16(v0[0], v0[1]); w.y = pg8::cvt_pk_bf16(v0[2], v0[3]); w.z = pg8::cvt_pk_bf16(v1[0], v1[1]); w.w = pg8::cvt_pk_bf16(v1[2], v1[3]);
#ifdef INPROJ_NT
                    __builtin_nontemporal_store(w, (pg8::u32x4*)(base + (size_t)t * W)); }
#else
                    *(pg8::u32x4*)(base + (size_t)t * W) = w; }
#endif
        }
    }
};
struct EpiResBf16 {
    static constexpr bool PERM = false, AFTER_DRAIN = false;
    bf16* xr;
    __device__ __forceinline__ void operator()(const pg8::f32x4 (&acc)[2][2][4][2], const pg8::Unit& u, int wr, int wc, int fr, int fq) const {
        { int t_ = threadIdx.x; asm volatile("" : "+v"(t_)); fr = t_ & 15; fq = (t_ >> 4) & 3; }
#pragma unroll
        for (int ai = 0; ai < 2; ++ai)
#pragma unroll
            for (int m = 0; m < 4; ++m) { const size_t off = (size_t)(u.pm * 256 + ai * 128 + wr * 64 + m * 16 + fr) * D_ + u.pn * 256 + wc * 32 + 4 * fq;
#pragma unroll
                for (int bj = 0; bj < 2; ++bj)
#pragma unroll
                    for (int n = 0; n < 2; ++n) { const u64 w = *(const u64*)(xr + off + bj * 128 + n * 16);
                        const pg8::f32x4 bs = {__uint_as_float((unsigned)w << 16), __uint_as_float((unsigned)w & 0xffff0000u), __uint_as_float((unsigned)(w >> 32) << 16), __uint_as_float((unsigned)(w >> 32) & 0xffff0000u)};
                        const pg8::f32x4 o = bs + acc[ai][bj][m][n];
                        *(u64*)(xr + off + bj * 128 + n * 16) = (u64)pg8::cvt_pk_bf16(o[0], o[1]) | ((u64)pg8::cvt_pk_bf16(o[2], o[3]) << 32); } }
    }
};


struct EpiDummy {
    static constexpr bool PERM = true, AFTER_DRAIN = false;
    float* dst;
    __device__ __forceinline__ void operator()(const pg8::f32x4 (&acc)[2][2][4][2], const pg8::Unit& u, int wr, int wc, int fr, int fq) const {
        pg8::f32x4 a = {0.f, 0.f, 0.f, 0.f};
#pragma unroll
        for (int ai = 0; ai < 2; ++ai)
#pragma unroll
            for (int bj = 0; bj < 2; ++bj)
#pragma unroll
                for (int m = 0; m < 4; ++m) { a = a + acc[ai][bj][m][0]; a = a + acc[ai][bj][m][1]; }
        *(pg8::f32x4*)(dst + ((size_t)(u.pm * 12 + u.pn) * 512 + threadIdx.x) * 4) = a;
    }
};
struct OneUnitOrder { pg8::Unit u; bool has;
    __device__ __forceinline__ bool next(int i, pg8::Unit& o) const { if (i != 0 || !has) return false; o = u; return true; }
    __device__ __forceinline__ void a_ready(const pg8::Unit&) const {}
    __device__ __forceinline__ void done(const pg8::Unit&) const {} };
__device__ __forceinline__ float gelu_tanh_fast(float x) { const float u2 = 1.5957691216057308f * (x + 0.044715f * x * x * x); return x * __builtin_amdgcn_rcpf(1.f + __builtin_amdgcn_exp2f(-u2 * LOG2E)); }
struct EpiCmpH {
    static constexpr bool PERM = true, AFTER_DRAIN = false;
    bf16* hc; const float* bias1;
    __device__ __forceinline__ void operator()(const pg8::f32x4 (&acc)[2][2][4][2], const pg8::Unit& u, int wr, int wc, int fr, int fq) const {
        { int t_ = threadIdx.x; asm volatile("" : "+v"(t_)); fr = t_ & 15; fq = (t_ >> 4) & 3; }
        const int kv = u.pn;
#pragma unroll
        for (int bj = 0; bj < 2; ++bj) { const int col = bj * 128 + wc * 32 + 8 * fq;
            const pg8::f32x4 b0 = *(const pg8::f32x4*)(bias1 + kv * 256 + col), b1 = *(const pg8::f32x4*)(bias1 + kv * 256 + col + 4);
#pragma unroll
            for (int ai = 0; ai < 2; ++ai)
#pragma unroll
                for (int m = 0; m < 4; ++m) { const int row = u.pm * 256 + ai * 128 + wr * 64 + m * 16 + fr;
                    const pg8::f32x4 v0 = acc[ai][bj][m][0] + b0, v1 = acc[ai][bj][m][1] + b1;
                    pg8::u32x4 w; w.x = pg8::cvt_pk_bf16(gelu_tanh_fast(v0[0]), gelu_tanh_fast(v0[1])); w.y = pg8::cvt_pk_bf16(gelu_tanh_fast(v0[2]), gelu_tanh_fast(v0[3]));
                    w.z = pg8::cvt_pk_bf16(gelu_tanh_fast(v1[0]), gelu_tanh_fast(v1[1])); w.w = pg8::cvt_pk_bf16(gelu_tanh_fast(v1[2]), gelu_tanh_fast(v1[3]));
                    *(pg8::u32x4*)(hc + ((size_t)kv * 4096 + row) * 256 + col) = w; } }
    }
};
struct EpiCmpOut {
    static constexpr bool PERM = true, AFTER_DRAIN = false;
    bf16* kvcmp;
    __device__ __forceinline__ void operator()(const pg8::f32x4 (&acc)[2][2][4][2], const pg8::Unit& u, int wr, int wc, int fr, int fq) const {
        { int t_ = threadIdx.x; asm volatile("" : "+v"(t_)); fr = t_ & 15; fq = (t_ >> 4) & 3; }
        if (wc >= 2) return;
        const int kv = u.pn, col = wc * 32 + 8 * fq;
#pragma unroll
        for (int ai = 0; ai < 2; ++ai)
#pragma unroll
            for (int m = 0; m < 4; ++m) { const int row = u.pm * 256 + ai * 128 + wr * 64 + m * 16 + fr; const float z = ((row & 255) == 255) ? 0.f : 1.f;
                const pg8::f32x4 v0 = acc[ai][0][m][0], v1 = acc[ai][0][m][1];
                pg8::u32x4 w; w.x = pg8::cvt_pk_bf16(z != 0.f ? v0[0] : 0.f, z != 0.f ? v0[1] : 0.f); w.y = pg8::cvt_pk_bf16(z != 0.f ? v0[2] : 0.f, z != 0.f ? v0[3] : 0.f);
                w.z = pg8::cvt_pk_bf16(z != 0.f ? v1[0] : 0.f, z != 0.f ? v1[1] : 0.f); w.w = pg8::cvt_pk_bf16(z != 0.f ? v1[2] : 0.f, z != 0.f ? v1[3] : 0.f);
                *(pg8::u32x4*)(kvcmp + ((size_t)kv * 4096 + row) * 64 + col) = w; }
    }
};

__device__ __forceinline__ void moe_build_tables(const unsigned* cnt, int tid) {
    LAS int* T = (LAS int*)((LAS unsigned char*)lds_raw + TBL_OFF);
    __syncthreads();
    if (tid < 112) T[128 + 256 + tid] = (int)((cnt[tid] + 255u) >> 8);
    __syncthreads();
    if (tid == 0) { int o = 0; for (int c = 0; c < 112; ++c) { T[c] = o; const int n = T[128 + 256 + c]; for (int k = 0; k < n; ++k) T[128 + o + k] = c; o += n; } T[112] = o; }
    __syncthreads();
}
__device__ __forceinline__ void moe_pair(int cls, int& ea, int& eb) { const int grp = cls / 28; int idx = cls % 28, lo = 0; while (idx >= 7 - lo) { idx -= 7 - lo; ++lo; } ea = grp * 8 + lo; eb = grp * 8 + lo + 1 + idx; }
struct MoeOrder1 {
    const char* xs; const char* wgu; int G, c;
    __device__ __forceinline__ bool next(int i, pg8::Unit& u) const {
        const LAS int* T = (const LAS int*)((LAS unsigned char*)lds_raw + TBL_OFF);
        const int idx = i * G + c; if (idx >= 4 * T[112]) return false;
        const int tile = idx >> 2, pn = idx & 3; int ea, eb; moe_pair(T[128 + tile], ea, eb); const int e = (pn >> 1) ? eb : ea;
        u.pm = tile; u.pn = pn; u.a = xs + (size_t)tile * 256 * 2048; u.b = wgu + ((size_t)e * 512 + (pn & 1) * 256) * 2048; u.b2 = u.b; return true; }
    __device__ __forceinline__ void a_ready(const pg8::Unit&) const {}
    __device__ __forceinline__ void done(const pg8::Unit&) const {} };
struct MoeOrder2 {
    const char* hb; const char* wd; int G, c;
    __device__ __forceinline__ bool next(int i, pg8::Unit& u) const {
        const LAS int* T = (const LAS int*)((LAS unsigned char*)lds_raw + TBL_OFF);
        const int idx = i * G + c; if (idx >= 4 * T[112]) return false;
        const int tile = idx >> 2, pn = idx & 3; int ea, eb; moe_pair(T[128 + tile], ea, eb);
        u.pm = tile; u.pn = pn; u.a = hb + (size_t)tile * 256 * 1024; u.b = wd + ((size_t)ea * 1024 + pn * 256) * 512; u.b2 = wd + ((size_t)eb * 1024 + pn * 256) * 512; return true; }
    __device__ __forceinline__ void a_ready(const pg8::Unit&) const {}
    __device__ __forceinline__ void done(const pg8::Unit&) const {} };
struct EpiMoeH {
    static constexpr bool PERM = true, AFTER_DRAIN = false;
    bf16* hb; const float* roww;
    __device__ __forceinline__ void operator()(const pg8::f32x4 (&acc)[2][2][4][2], const pg8::Unit& u, int wr, int wc, int fr, int fq) const {
        { int t_ = threadIdx.x; asm volatile("" : "+v"(t_)); fr = t_ & 15; fq = (t_ >> 4) & 3; }
        const int slot = u.pn >> 1;
#pragma unroll
        for (int ai = 0; ai < 2; ++ai)
#pragma unroll
            for (int m = 0; m < 4; ++m) { const size_t row = (size_t)u.pm * 256 + ai * 128 + wr * 64 + m * 16 + fr; const float w = roww[row * 2 + slot];
#pragma unroll
                for (int bj = 0; bj < 2; ++bj) { const int j0 = (u.pn & 1) * 128 + (bj * 128 + wc * 32 + 8 * fq) / 2;
                    const pg8::f32x4 v0 = acc[ai][bj][m][0], v1 = acc[ai][bj][m][1];
                    const float h0 = v0[0] * __builtin_amdgcn_rcpf(1.f + __builtin_amdgcn_exp2f(-v0[0] * LOG2E)) * v0[1] * w, h1 = v0[2] * __builtin_amdgcn_rcpf(1.f + __builtin_amdgcn_exp2f(-v0[2] * LOG2E)) * v0[3] * w;
                    const float h2 = v1[0] * __builtin_amdgcn_rcpf(1.f + __builtin_amdgcn_exp2f(-v1[0] * LOG2E)) * v1[1] * w, h3 = v1[2] * __builtin_amdgcn_rcpf(1.f + __builtin_amdgcn_exp2f(-v1[2] * LOG2E)) * v1[3] * w;
                    *(u64*)(hb + row * 512 + slot * 256 + j0) = (u64)pg8::cvt_pk_bf16(h0, h1) | ((u64)pg8::cvt_pk_bf16(h2, h3) << 32); } }
    }
};
struct EpiMoeOut {
    static constexpr bool PERM = false, AFTER_DRAIN = false;
    bf16* x; const int* rowtok;
    __device__ __forceinline__ void operator()(const pg8::f32x4 (&acc)[2][2][4][2], const pg8::Unit& u, int wr, int wc, int fr, int fq) const {
        { int t_ = threadIdx.x; asm volatile("" : "+v"(t_)); fr = t_ & 15; fq = (t_ >> 4) & 3; }
        bf16* xx = x; const int* rt = rowtok; asm volatile("" : "+s"(xx), "+s"(rt));
#pragma unroll
        for (int ai = 0; ai < 2; ++ai)
#pragma unroll
            for (int m = 0; m < 4; ++m) { const int tok = rt[(size_t)u.pm * 256 + ai * 128 + wr * 64 + m * 16 + fr];
                if (tok >= 0) { bf16* xr = xx + (size_t)tok * D_ + u.pn * 256 + wc * 32 + 4 * fq;
#pragma unroll
                    for (int bj = 0; bj < 2; ++bj)
#pragma unroll
                        for (int n = 0; n < 2; ++n) { u64* q = (u64*)(xr + bj * 128 + n * 16); const u64 w = *q; const pg8::f32x4 a = acc[ai][bj][m][n];
                            *q = (u64)pg8::cvt_pk_bf16(__uint_as_float((unsigned)w << 16) + a[0], __uint_as_float((unsigned)w & 0xffff0000u) + a[1]) | ((u64)pg8::cvt_pk_bf16(__uint_as_float((unsigned)(w >> 32) << 16) + a[2], __uint_as_float((unsigned)(w >> 32) & 0xffff0000u) + a[3]) << 32); } } }
    }
};

__device__ __forceinline__ void transpose_item(const float* W, int ldw, bf16* WT, int ldt, int r0, int rmul, int k0, LAS float* scr, int lane) {
    f32x4 v[8];
#pragma unroll
    for (int i = 0; i < 8; ++i) v[i] = *(const f32x4*)(W + (size_t)(k0 + i * 8 + (lane >> 3)) * ldw + (lane & 7) * 4);
#pragma unroll
    for (int i = 0; i < 8; ++i) { LAS float* d = scr + (i * 8 + (lane >> 3)) * 33 + (lane & 7) * 4; d[0] = v[i].x; d[1] = v[i].y; d[2] = v[i].z; d[3] = v[i].w; }
    asm volatile("s_waitcnt lgkmcnt(0)" ::: "memory");
    const int c = lane & 7;
#pragma unroll
    for (int j = 0; j < 4; ++j) { const int n = (lane >> 3) + 8 * j; const LAS float* sp = scr + (8 * c) * 33 + n;
        u32x4 o; o.x = pk2(sp[0 * 33], sp[1 * 33]); o.y = pk2(sp[2 * 33], sp[3 * 33]); o.z = pk2(sp[4 * 33], sp[5 * 33]); o.w = pk2(sp[6 * 33], sp[7 * 33]);
        *(u32x4*)(WT + (size_t)(r0 + rmul * n) * ldt + k0 + 8 * c) = o; }
    asm volatile("s_waitcnt lgkmcnt(0)" ::: "memory");
}
__device__ __forceinline__ void transpose_seg(const float* W, int ldw, int K, int sc0, int ncol, bf16* WT, int r0, int rmul, int item, LAS float* scr, int lane) {
    const int nb = ncol / 32, kb = item / nb, cb = item % nb;
    transpose_item(W + sc0 + cb * 32, ldw, WT, K, r0 + rmul * cb * 32, rmul, kb * 64, scr, lane);
}

typedef float f32x16 __attribute__((ext_vector_type(16)));
typedef short bf16x8v __attribute__((ext_vector_type(8)));
typedef short s16x4 __attribute__((ext_vector_type(4)));
typedef float f32x2_t __attribute__((ext_vector_type(2)));
typedef __bf16 bf16x2_t __attribute__((ext_vector_type(2)));
constexpr int A_KBUF = 10240, A_VBUF = 12288;
constexpr int A_KOFF = 0, A_VOFF = 2 * A_KBUF, A_BOFF = A_VOFF + 2 * A_VBUF, A_LDS_END = A_BOFF + 2 * 256;
__device__ __forceinline__ constexpr int crow0(int reg) { return (reg & 3) + 8 * (reg >> 2); }
__device__ __forceinline__ float swap_max(float m) { auto rr = __builtin_amdgcn_permlane32_swap(__float_as_uint(m), __float_as_uint(m), false, false); return fmaxf(__uint_as_float(rr[0]), __uint_as_float(rr[1])); }
__device__ __forceinline__ float swap_sum(float m) { auto rr = __builtin_amdgcn_permlane32_swap(__float_as_uint(m), __float_as_uint(m), false, false); return __uint_as_float(rr[0]) + __uint_as_float(rr[1]); }
__device__ __forceinline__ unsigned cvtpk(float lo, float hi) { f32x2_t v = {lo, hi}; bf16x2_t b = __builtin_convertvector(v, bf16x2_t); return __builtin_bit_cast(unsigned, b); }
__device__ __forceinline__ bf16x8v pack8(const f32x16& p, int b0) { u32x4 w; w.x = cvtpk(p[b0 + 0], p[b0 + 1]); w.y = cvtpk(p[b0 + 2], p[b0 + 3]); w.z = cvtpk(p[b0 + 4], p[b0 + 5]); w.w = cvtpk(p[b0 + 6], p[b0 + 7]); return __builtin_bit_cast(bf16x8v, w); }
__device__ __forceinline__ s16x4 tr_read(const LAS unsigned char* p) { typedef short v4i16_t __attribute__((ext_vector_type(4))); return __builtin_bit_cast(s16x4, __builtin_amdgcn_ds_read_tr16_b64_v4i16((LAS v4i16_t*)p)); }

template <int DQK, int NMAP, bool FOX, bool SLC>
__device__ __forceinline__ void attn_core(LAS unsigned char* L, const bf16* Kb0, const bf16* Kb1, const bf16* Vb, const LAS float* cum, float cum_ref,
                                          const bf16x8v (&Qf)[NMAP][DQK / 16], u64 tilemask, int t_lane, int tw0, int win, float slope2, unsigned selw0, unsigned selw1,
                                          f32x16 (&O)[NMAP][2], float (&M)[NMAP], float (&Ls)[NMAP], int tid, bool started0 = false) {
    constexpr int KP = DQK * 2 + 16, VP = 192;
    const int lane = tid & 63, r = lane & 31, h = lane >> 5;
    int kdst; const bf16* ksrc;
    if (DQK == 64) { kdst = (tid >> 3) * KP + (tid & 7) * 16; ksrc = Kb0 + (tid >> 3) * 64 + (tid & 7) * 8; }
    else { const int mp = tid >> 8, tt = tid & 255; kdst = mp * 5120 + (tt >> 2) * KP + (tt & 3) * 16; ksrc = (mp ? Kb1 : Kb0) + (tt >> 2) * 32 + (tt & 3) * 8; }
    const int vdst = (tid >> 3) * VP + (tid & 7) * 16; const bf16* vsrc = Vb + (tid >> 3) * 64 + (tid & 7) * 8;
    const LAS unsigned char* kfrag = L + A_KOFF + r * KP + h * 16;
    const LAS unsigned char* vfrag = L + A_VOFF + (4 * h + ((lane & 15) >> 2)) * VP + (16 * ((lane >> 4) & 1) + 4 * (lane & 3)) * 2;
    u32x4 kreg, vreg; float breg = 0.f;
    u64 mk = tilemask;
    int j = 63 - __builtin_clzll(mk); mk &= ~(1ull << j);
    { const int kv0 = j * 64; kreg = *(const u32x4*)(ksrc + (size_t)kv0 * DQK); vreg = *(const u32x4*)(vsrc + (size_t)kv0 * 64); if (FOX && tid < 64) breg = (cum_ref - cum[kv0 + tid]) * LOG2E; }
    *(LAS u32x4*)(L + A_KOFF + kdst) = kreg; *(LAS u32x4*)(L + A_VOFF + vdst) = vreg; if (FOX && tid < 64) *(LAS float*)(L + A_BOFF + tid * 4) = breg;
    __syncthreads();
    int buf = 0; bool started = started0;
    float pdummy = 0.f; int idummy = 0; f32x16 dm0; for (int i = 0; i < 16; ++i) dm0[i] = 0.f;
    for (;;) {
        const bool more = mk != 0ull; int jn = 0;
        if (more) { jn = 63 - __builtin_clzll(mk); mk &= ~(1ull << jn); const int kv0 = jn * 64;
            kreg = *(const u32x4*)(ksrc + (size_t)kv0 * DQK); vreg = *(const u32x4*)(vsrc + (size_t)kv0 * 64); if (FOX && tid < 64) breg = (cum_ref - cum[kv0 + tid]) * LOG2E; }
        { const int kv0 = j * 64;
          bool wave_has = true; float selb = 0.f;
          if (SLC) { const bool mine = ((j < 32 ? (selw0 >> j) : (selw1 >> (j - 32))) & 1u) != 0u; selb = mine ? 0.f : -INFINITY; wave_has = __any(mine); }
          if (wave_has && !(kv0 > tw0 + 31) && !(tw0 - (kv0 + 63) >= win)) {
            const bool need_mask = (kv0 + 63 > tw0) || (tw0 + 31 - kv0 >= win);
            const int dl = t_lane - kv0 - 4 * h;
            bf16x8v pa[NMAP][4];
#pragma unroll
            for (int mp = 0; mp < NMAP; ++mp) {
                f32x16 p0, p1;
                if (FOX) { const LAS f32x4* bl = (const LAS f32x4*)(L + A_BOFF + buf * 256) + h; const float mm = M[mp];
#pragma unroll
                    for (int g4 = 0; g4 < 4; ++g4) { const f32x4 b0 = bl[2 * g4], b1 = bl[8 + 2 * g4];
                        p0[4 * g4 + 0] = b0.x - mm; p0[4 * g4 + 1] = b0.y - mm; p0[4 * g4 + 2] = b0.z - mm; p0[4 * g4 + 3] = b0.w - mm; p1[4 * g4 + 0] = b1.x - mm; p1[4 * g4 + 1] = b1.y - mm; p1[4 * g4 + 2] = b1.z - mm; p1[4 * g4 + 3] = b1.w - mm; } }
                else { const float base_l = (slope2 * (float)(kv0 + 4 * h - tw0) - M[mp]) + selb, s8 = slope2 * 8.f, s32 = slope2 * 32.f;
                    p0[0] = base_l; p0[1] = p0[0] + slope2; p0[2] = p0[1] + slope2; p0[3] = p0[2] + slope2;
#pragma unroll
                    for (int reg = 4; reg < 16; ++reg) p0[reg] = p0[reg - 4] + s8;
#pragma unroll
                    for (int reg = 0; reg < 16; ++reg) p1[reg] = p0[reg] + s32; }
                const LAS unsigned char* kb = kfrag + buf * A_KBUF + (DQK == 32 ? mp * 5120 : 0);
#pragma unroll
                for (int s = 0; s < DQK / 16; ++s) { const bf16x8v kf0 = *(const LAS bf16x8v*)(kb + s * 32), kf1 = *(const LAS bf16x8v*)(kb + 32 * KP + s * 32);
#ifdef PROBE_X_LDSK
                    { const bf16x8v z0 = *(const volatile LAS bf16x8v*)(kb + s * 32), z1 = *(const volatile LAS bf16x8v*)(kb + 32 * KP + s * 32); idummy ^= z0[0] ^ z1[1]; }
#endif
#ifdef PROBE_X_MFMA
                    dm0 = __builtin_amdgcn_mfma_f32_32x32x16_bf16(kf0, Qf[mp][s], dm0, 0, 0, 0); dm0 = __builtin_amdgcn_mfma_f32_32x32x16_bf16(kf1, Qf[mp][s], dm0, 0, 0, 0);
#endif
                    p0 = __builtin_amdgcn_mfma_f32_32x32x16_bf16(kf0, Qf[mp][s], p0, 0, 0, 0); p1 = __builtin_amdgcn_mfma_f32_32x32x16_bf16(kf1, Qf[mp][s], p1, 0, 0, 0); }
                if (need_mask) {
#pragma unroll
                    for (int reg = 0; reg < 16; ++reg) { const int d0 = dl - crow0(reg), d1 = d0 - 32;
                        p0[reg] = (d0 >= 0 && d0 < win) ? p0[reg] : -INFINITY; p1[reg] = (d1 >= 0 && d1 < win) ? p1[reg] : -INFINITY; } }
                float mt = fmaxf(fmaxf(p0[0], p1[0]), fmaxf(p0[1], p1[1]));
#pragma unroll
                for (int reg = 2; reg < 16; reg += 2) mt = fmaxf(fmaxf(mt, fmaxf(fmaxf(p0[reg], p1[reg]), p0[reg + 1])), p1[reg + 1]);
                mt = swap_max(mt);
                if (!started || __any(mt > 8.f)) {
                    const float d = (mt > -1e30f) ? (started ? fmaxf(mt, 0.f) : mt) : 0.f, alpha = __builtin_amdgcn_exp2f(-d);
                    O[mp][0] *= alpha; O[mp][1] *= alpha; Ls[mp] *= alpha; M[mp] += d;
#pragma unroll
                    for (int reg = 0; reg < 16; ++reg) { p0[reg] -= d; p1[reg] -= d; } }
                float rs = 0.f;
#ifdef PROBE_X_EXP
#pragma unroll
                for (int reg = 0; reg < 16; ++reg) { pdummy += __builtin_amdgcn_exp2f(p0[reg] - 1.f) + __builtin_amdgcn_exp2f(p1[reg] - 1.f); }
#endif
#pragma unroll
                for (int reg = 0; reg < 16; ++reg) { p0[reg] = __builtin_amdgcn_exp2f(p0[reg]); p1[reg] = __builtin_amdgcn_exp2f(p1[reg]); rs += p0[reg] + p1[reg]; }
                Ls[mp] += rs;
                pa[mp][0] = pack8(p0, 0); pa[mp][1] = pack8(p0, 8); pa[mp][2] = pack8(p1, 0); pa[mp][3] = pack8(p1, 8);
            }
            started = true;
            const LAS unsigned char* vb = vfrag + buf * A_VBUF;
#pragma unroll
            for (int db = 0; db < 2; ++db)
#pragma unroll
                for (int ks = 0; ks < 4; ++ks) { const s16x4 lo = tr_read(vb + ks * (16 * VP) + db * 64), hi = tr_read(vb + ks * (16 * VP) + db * 64 + 8 * VP);
                    const bf16x8v vf = {lo[0], lo[1], lo[2], lo[3], hi[0], hi[1], hi[2], hi[3]};
#pragma unroll
                    for (int mp = 0; mp < NMAP; ++mp) O[mp][db] = __builtin_amdgcn_mfma_f32_32x32x16_bf16(vf, pa[mp][ks], O[mp][db], 0, 0, 0); }
          } }
        if (more) { *(LAS u32x4*)(L + A_KOFF + (buf ^ 1) * A_KBUF + kdst) = kreg; *(LAS u32x4*)(L + A_VOFF + (buf ^ 1) * A_VBUF + vdst) = vreg; if (FOX && tid < 64) *(LAS float*)(L + A_BOFF + (buf ^ 1) * 256 + tid * 4) = breg; }
#ifdef PROBE_X_BAR
        __syncthreads();
#endif
        __syncthreads();
        if (!more) break;
        j = jn; buf ^= 1;
    }
    if (pdummy == 123.456f || idummy == 0x7fffabcd || dm0[3] == 98765.4321f) Ls[0] += 1e-30f;
}
#ifndef AC2_MODE
#define AC2_MODE 0
#endif
#ifndef AC2_INIT_VALU
#define AC2_INIT_VALU 24
#endif
template <bool FOX, bool SLC>
__device__ __forceinline__ void attn_core2(LAS unsigned char* L, const bf16* Kb0, const bf16* Vb, const LAS float* cum, float cum_ref,
                                           const bf16x8v (&Qf)[4], u64 tilemask, int t_lane, int tw0, int win, float slope2, unsigned selw0, unsigned selw1,
                                           f32x16 (&O)[2], float& M, float& Ls, int tid) {
    constexpr int KP = 144, VP = 192;
    const int lane = tid & 63, r = lane & 31, h = lane >> 5;
    const int kdst = (tid >> 3) * KP + (tid & 7) * 16; const bf16* ksrc = Kb0 + (tid >> 3) * 64 + (tid & 7) * 8;
    const int vdst = (tid >> 3) * VP + (tid & 7) * 16; const bf16* vsrc = Vb + (tid >> 3) * 64 + (tid & 7) * 8;
    const LAS unsigned char* kfrag = L + A_KOFF + r * KP + h * 16;
    const LAS unsigned char* vfrag = L + A_VOFF + (4 * h + ((lane & 15) >> 2)) * VP + (16 * ((lane >> 4) & 1) + 4 * (lane & 3)) * 2;
#define AC2_ACTIVE(jj) (!((jj) * 64 > tw0 + 31) && !(tw0 - ((jj) * 64 + 63) >= win))
#define AC2_INIT(jj, kslot, q0, q1) do { const int kv0_ = (jj) * 64; \
        if (FOX) { const LAS f32x4* bl = (const LAS f32x4*)(L + A_BOFF + (kslot) * 256) + h; const float mm = M; \
            _Pragma("unroll") for (int g4 = 0; g4 < 4; ++g4) { const f32x4 b0 = bl[2 * g4], b1 = bl[8 + 2 * g4]; \
                q0[4 * g4 + 0] = b0.x - mm; q0[4 * g4 + 1] = b0.y - mm; q0[4 * g4 + 2] = b0.z - mm; q0[4 * g4 + 3] = b0.w - mm; q1[4 * g4 + 0] = b1.x - mm; q1[4 * g4 + 1] = b1.y - mm; q1[4 * g4 + 2] = b1.z - mm; q1[4 * g4 + 3] = b1.w - mm; } } \
        else { float selb = 0.f; if (SLC) selb = ((((jj) < 32) ? (selw0 >> (jj)) : (selw1 >> ((jj) - 32))) & 1u) ? 0.f : -INFINITY; \
            const float base_l = (slope2 * (float)(kv0_ + 4 * h - tw0) - M) + selb, s8 = slope2 * 8.f, s32 = slope2 * 32.f; \
            q0[0] = base_l; q0[1] = q0[0] + slope2; q0[2] = q0[1] + slope2; q0[3] = q0[2] + slope2; \
            _Pragma("unroll") for (int reg = 4; reg < 16; ++reg) q0[reg] = q0[reg - 4] + s8; \
            _Pragma("unroll") for (int reg = 0; reg < 16; ++reg) q1[reg] = q0[reg] + s32; } } while (0)
#define AC2_QK(jj, kslot) do { AC2_INIT(jj, kslot, p0, p1); \
        const LAS unsigned char* kb_ = kfrag + (kslot) * A_KBUF; \
        _Pragma("unroll") for (int s_ = 0; s_ < 4; ++s_) { const bf16x8v kf0 = *(const LAS bf16x8v*)(kb_ + s_ * 32), kf1 = *(const LAS bf16x8v*)(kb_ + 32 * KP + s_ * 32); \
            p0 = __builtin_amdgcn_mfma_f32_32x32x16_bf16(kf0, Qf[s_], p0, 0, 0, 0); p1 = __builtin_amdgcn_mfma_f32_32x32x16_bf16(kf1, Qf[s_], p1, 0, 0, 0); } } while (0)
    u32x4 kreg, vreg; float breg = 0.f;
    u64 mk = tilemask;
    int j = 63 - __builtin_clzll(mk); mk &= ~(1ull << j);
    int jn = -1; if (mk) { jn = 63 - __builtin_clzll(mk); mk &= ~(1ull << jn); }
    { kreg = *(const u32x4*)(ksrc + (size_t)j * 64 * 64); vreg = *(const u32x4*)(vsrc + (size_t)j * 64 * 64); if (FOX && tid < 64) breg = (cum_ref - cum[j * 64 + tid]) * LOG2E;
      *(LAS u32x4*)(L + A_KOFF + kdst) = kreg; *(LAS u32x4*)(L + A_VOFF + vdst) = vreg; if (FOX && tid < 64) *(LAS float*)(L + A_BOFF + tid * 4) = breg;
      if (jn >= 0) { kreg = *(const u32x4*)(ksrc + (size_t)jn * 64 * 64); if (FOX && tid < 64) breg = (cum_ref - cum[jn * 64 + tid]) * LOG2E;
          *(LAS u32x4*)(L + A_KOFF + A_KBUF + kdst) = kreg; if (FOX && tid < 64) *(LAS float*)(L + A_BOFF + 256 + tid * 4) = breg; } }
    __syncthreads();
    f32x16 p0, p1;
    bool started = false;
    int ks = 0, vs = 0;
    if (AC2_ACTIVE(j)) AC2_QK(j, 0);
    for (;;) {
        int jnn = -1; if (mk) { jnn = 63 - __builtin_clzll(mk); mk &= ~(1ull << jnn); }
        if (jnn >= 0) { kreg = *(const u32x4*)(ksrc + (size_t)jnn * 64 * 64); if (FOX && tid < 64) breg = (cum_ref - cum[jnn * 64 + tid]) * LOG2E; }
        if (jn >= 0) vreg = *(const u32x4*)(vsrc + (size_t)jn * 64 * 64);
        const bool act = AC2_ACTIVE(j), actn = jn >= 0 && AC2_ACTIVE(jn);
        if (act) {
            const int kv0 = j * 64;
            if ((kv0 + 63 > tw0) || (tw0 + 31 - kv0 >= win)) { const int dl = t_lane - kv0 - 4 * h;
#pragma unroll
                for (int reg = 0; reg < 16; ++reg) { const int d0 = dl - crow0(reg), d1 = d0 - 32;
                    p0[reg] = (d0 >= 0 && d0 < win) ? p0[reg] : -INFINITY; p1[reg] = (d1 >= 0 && d1 < win) ? p1[reg] : -INFINITY; } }
            float mt = fmaxf(fmaxf(p0[0], p1[0]), fmaxf(p0[1], p1[1]));
#pragma unroll
            for (int reg = 2; reg < 16; reg += 2) mt = fmaxf(fmaxf(mt, fmaxf(fmaxf(p0[reg], p1[reg]), p0[reg + 1])), p1[reg + 1]);
            mt = swap_max(mt);
            if (!started || __any(mt > 8.f)) {
                const float d = (mt > -1e30f) ? (started ? fmaxf(mt, 0.f) : mt) : 0.f, alpha = __builtin_amdgcn_exp2f(-d);
                O[0] *= alpha; O[1] *= alpha; Ls *= alpha; M += d;
#pragma unroll
                for (int reg = 0; reg < 16; ++reg) { p0[reg] -= d; p1[reg] -= d; } }
            started = true;
#if AC2_MODE == 1
            {
                const int jq = jn >= 0 ? jn : 0;
                float rs = 0.f;
#pragma unroll
                for (int reg = 0; reg < 16; ++reg) { p0[reg] = __builtin_amdgcn_exp2f(p0[reg]); p1[reg] = __builtin_amdgcn_exp2f(p1[reg]); rs += p0[reg] + p1[reg]; }
                Ls += rs;
                const bf16x8v pa0 = pack8(p0, 0), pa1 = pack8(p0, 8), pa2 = pack8(p1, 0), pa3 = pack8(p1, 8);
                AC2_QK(jq, ks ^ 1);
                const LAS unsigned char* vb = vfrag + vs * A_VBUF;
#pragma unroll
                for (int db = 0; db < 2; ++db)
#pragma unroll
                    for (int kq = 0; kq < 4; ++kq) { const s16x4 lo = tr_read(vb + kq * (16 * VP) + db * 64), hi = tr_read(vb + kq * (16 * VP) + db * 64 + 8 * VP);
                        const bf16x8v vf = {lo[0], lo[1], lo[2], lo[3], hi[0], hi[1], hi[2], hi[3]};
                        O[db] = __builtin_amdgcn_mfma_f32_32x32x16_bf16(vf, kq == 0 ? pa0 : kq == 1 ? pa1 : kq == 2 ? pa2 : pa3, O[db], 0, 0, 0); }
            }
#else
            {
                const int jq = jn >= 0 ? jn : 0;
                f32x16 n0, n1;
                AC2_INIT(jq, ks ^ 1, n0, n1);
                const LAS unsigned char* kb_ = kfrag + (ks ^ 1) * A_KBUF;
                bf16x8v kf[8];
#pragma unroll
                for (int s_ = 0; s_ < 4; ++s_) { kf[2 * s_] = *(const LAS bf16x8v*)(kb_ + s_ * 32); kf[2 * s_ + 1] = *(const LAS bf16x8v*)(kb_ + 32 * KP + s_ * 32); }
                const LAS unsigned char* vb = vfrag + vs * A_VBUF;
                __builtin_amdgcn_sched_barrier(0);
                float ra = 0.f, rb = 0.f; unsigned w[16];
#define AC2_PINF(x) asm volatile("" : "+v"(x))
#define AC2_QGAP(i) do { if ((i) & 1) n1 = __builtin_amdgcn_mfma_f32_32x32x16_bf16(kf[i], Qf[(i) >> 1], n1, 0, 0, 0); else n0 = __builtin_amdgcn_mfma_f32_32x32x16_bf16(kf[i], Qf[(i) >> 1], n0, 0, 0, 0); \
                    float e0 = __builtin_amdgcn_exp2f(p0[2 * (i)]), e1 = __builtin_amdgcn_exp2f(p0[2 * (i) + 1]), e2 = __builtin_amdgcn_exp2f(p1[2 * (i)]), e3 = __builtin_amdgcn_exp2f(p1[2 * (i) + 1]); \
                    ra += e0 + e1; rb += e2 + e3; \
                    AC2_PINF(e0); AC2_PINF(e1); AC2_PINF(e2); AC2_PINF(e3); AC2_PINF(ra); AC2_PINF(rb); \
                    p0[2 * (i)] = e0; p0[2 * (i) + 1] = e1; p1[2 * (i)] = e2; p1[2 * (i) + 1] = e3; \
                    if ((i) >= 4) { w[2 * ((i) - 4)] = cvtpk(p0[4 * ((i) - 4)], p0[4 * ((i) - 4) + 1]); w[2 * ((i) - 4) + 1] = cvtpk(p0[4 * ((i) - 4) + 2], p0[4 * ((i) - 4) + 3]); AC2_PINF(w[2 * ((i) - 4)]); AC2_PINF(w[2 * ((i) - 4) + 1]); } \
                    if ((i) == 6) { vl[0] = tr_read(vb); vh[0] = tr_read(vb + 8 * VP); } \
                    if ((i) == 7) { vl[1] = tr_read(vb + 64); vh[1] = tr_read(vb + 64 + 8 * VP); } \
                    __builtin_amdgcn_sched_barrier(0); } while (0)
                s16x4 vl[2], vh[2];
                AC2_QGAP(0); AC2_QGAP(1); AC2_QGAP(2); AC2_QGAP(3); AC2_QGAP(4); AC2_QGAP(5); AC2_QGAP(6); AC2_QGAP(7);
                Ls += ra + rb;
#define AC2_PA(kq) __builtin_bit_cast(bf16x8v, (u32x4){w[4 * (kq)], w[4 * (kq) + 1], w[4 * (kq) + 2], w[4 * (kq) + 3]})
#define AC2_PGAP(g) do { const int kq_ = (g) >> 1, db_ = (g) & 1; const bf16x8v vf = {vl[(g) & 1][0], vl[(g) & 1][1], vl[(g) & 1][2], vl[(g) & 1][3], vh[(g) & 1][0], vh[(g) & 1][1], vh[(g) & 1][2], vh[(g) & 1][3]}; \
                    if ((g) < 6) { const int kq2 = ((g) + 2) >> 1, db2 = (g) & 1; vl[(g) & 1] = tr_read(vb + kq2 * (16 * VP) + db2 * 64); vh[(g) & 1] = tr_read(vb + kq2 * (16 * VP) + db2 * 64 + 8 * VP); } \
                    O[db_] = __builtin_amdgcn_mfma_f32_32x32x16_bf16(vf, AC2_PA(kq_), O[db_], 0, 0, 0); \
                    if ((g) < 4) { w[8 + 2 * (g)] = cvtpk(p1[4 * (g)], p1[4 * (g) + 1]); w[8 + 2 * (g) + 1] = cvtpk(p1[4 * (g) + 2], p1[4 * (g) + 3]); AC2_PINF(w[8 + 2 * (g)]); AC2_PINF(w[8 + 2 * (g) + 1]); } \
                    __builtin_amdgcn_sched_barrier(0); } while (0)
                AC2_PGAP(0); AC2_PGAP(1); AC2_PGAP(2); AC2_PGAP(3); AC2_PGAP(4); AC2_PGAP(5); AC2_PGAP(6); AC2_PGAP(7);
#undef AC2_PGAP
#undef AC2_PA
#undef AC2_QGAP
#undef AC2_PINF
                p0 = n0; p1 = n1;
            }
#endif
        } else if (actn) AC2_QK(jn, ks ^ 1);
        if (jnn >= 0) { *(LAS u32x4*)(L + A_KOFF + ks * A_KBUF + kdst) = kreg; if (FOX && tid < 64) *(LAS float*)(L + A_BOFF + ks * 256 + tid * 4) = breg; }
        if (jn >= 0) *(LAS u32x4*)(L + A_VOFF + (vs ^ 1) * A_VBUF + vdst) = vreg;
        __syncthreads();
        if (jn < 0) break;
        j = jn; jn = jnn; ks ^= 1; vs ^= 1;
    }
#undef AC2_QK
#undef AC2_INIT
#undef AC2_ACTIVE
}
#define ATTN_FOR_CHUNKS(db, g4) _Pragma("unroll") for (int db = 0; db < 2; ++db) _Pragma("unroll") for (int g4 = 0; g4 < 4; ++g4)

__device__ __forceinline__ void unpack8(const u32x4 w, float (&f)[8]) { f[0] = __uint_as_float(w.x << 16); f[1] = __uint_as_float(w.x & 0xffff0000u); f[2] = __uint_as_float(w.y << 16); f[3] = __uint_as_float(w.y & 0xffff0000u);
    f[4] = __uint_as_float(w.z << 16); f[5] = __uint_as_float(w.z & 0xffff0000u); f[6] = __uint_as_float(w.w << 16); f[7] = __uint_as_float(w.w & 0xffff0000u); }
__device__ __forceinline__ void ph_norm_bf16_from_bf16(const Ctx& c, const bf16* x, const float* g, bf16* out) {
    constexpr int RB = 4; float gg[2][8];
#pragma unroll
    for (int j = 0; j < 2; ++j) { const f32x4 a = ((const f32x4*)g)[2 * c.lane + 128 * j], b2 = ((const f32x4*)g)[2 * c.lane + 128 * j + 1]; gg[j][0] = a.x; gg[j][1] = a.y; gg[j][2] = a.z; gg[j][3] = a.w; gg[j][4] = b2.x; gg[j][5] = b2.y; gg[j][6] = b2.z; gg[j][7] = b2.w; }
    for (int row0 = c.gw * RB; row0 < NT; row0 += c.ngw * RB) {
        u32x4 v[RB][2];
#pragma unroll
        for (int q = 0; q < RB; ++q)
#pragma unroll
            for (int j = 0; j < 2; ++j) v[q][j] = ((const u32x4*)(x + (size_t)(row0 + q) * D_))[c.lane + 64 * j];
#pragma unroll
        for (int q = 0; q < RB; ++q) { float f[2][8]; float ss = 0.f;
#pragma unroll
            for (int j = 0; j < 2; ++j) { unpack8(v[q][j], f[j]);
#pragma unroll
                for (int e = 0; e < 8; ++e) ss = fmaf(f[j][e], f[j][e], ss); }
            const float r = rsqrtf(wave_sum(ss) * (1.f / D_) + EPS);
#pragma unroll
            for (int j = 0; j < 2; ++j) { u32x4 o; o.x = pk2(f[j][0] * r * gg[j][0], f[j][1] * r * gg[j][1]); o.y = pk2(f[j][2] * r * gg[j][2], f[j][3] * r * gg[j][3]); o.z = pk2(f[j][4] * r * gg[j][4], f[j][5] * r * gg[j][5]); o.w = pk2(f[j][6] * r * gg[j][6], f[j][7] * r * gg[j][7]);
                ((u32x4*)(out + (size_t)(row0 + q) * D_))[c.lane + 64 * j] = o; } }
    }
}
__device__ __forceinline__ void ph_norm_final_from_bf16(const Ctx& c, const bf16* x, const float* g, float* out) {
    constexpr int RB = 4; float gg[2][8];
#pragma unroll
    for (int j = 0; j < 2; ++j) { const f32x4 a = ((const f32x4*)g)[2 * c.lane + 128 * j], b2 = ((const f32x4*)g)[2 * c.lane + 128 * j + 1]; gg[j][0] = a.x; gg[j][1] = a.y; gg[j][2] = a.z; gg[j][3] = a.w; gg[j][4] = b2.x; gg[j][5] = b2.y; gg[j][6] = b2.z; gg[j][7] = b2.w; }
    for (int row0 = c.gw * RB; row0 < NT; row0 += c.ngw * RB) {
        u32x4 v[RB][2];
#pragma unroll
        for (int q = 0; q < RB; ++q)
#pragma unroll
            for (int j = 0; j < 2; ++j) v[q][j] = ((const u32x4*)(x + (size_t)(row0 + q) * D_))[c.lane + 64 * j];
#pragma unroll
        for (int q = 0; q < RB; ++q) { float f[2][8]; float ss = 0.f;
#pragma unroll
            for (int j = 0; j < 2; ++j) { unpack8(v[q][j], f[j]);
#pragma unroll
                for (int e = 0; e < 8; ++e) ss = fmaf(f[j][e], f[j][e], ss); }
            const float r = rsqrtf(wave_sum(ss) * (1.f / D_) + EPS);
#pragma unroll
            for (int j = 0; j < 2; ++j) { f32x4* o = (f32x4*)(out + (size_t)(row0 + q) * D_) + 2 * c.lane + 128 * j;
                o[0] = (f32x4){f[j][0] * r * gg[j][0], f[j][1] * r * gg[j][1], f[j][2] * r * gg[j][2], f[j][3] * r * gg[j][3]}; o[1] = (f32x4){f[j][4] * r * gg[j][4], f[j][5] * r * gg[j][5], f[j][6] * r * gg[j][6], f[j][7] * r * gg[j][7]}; } }
    }
}
__device__ __forceinline__ void ph_norm_bf16(const Ctx& c, const float* x, const float* g, bf16* out, bf16* raw) {
    constexpr int RB = 4;
    f32x4 gg[4];
#pragma unroll
    for (int j = 0; j < 4; ++j) gg[j] = ((const f32x4*)g)[c.lane + 64 * j];
    for (int row0 = c.gw * RB; row0 < NT; row0 += c.ngw * RB) {
        f32x4 v[RB][4];
#pragma unroll
        for (int q = 0; q < RB; ++q)
#pragma unroll
            for (int j = 0; j < 4; ++j) v[q][j] = ((const f32x4*)(x + (size_t)(row0 + q) * D_))[c.lane + 64 * j];
#pragma unroll
        for (int q = 0; q < RB; ++q) { float ss = 0.f;
#pragma unroll
            for (int j = 0; j < 4; ++j) ss += v[q][j].x * v[q][j].x + v[q][j].y * v[q][j].y + v[q][j].z * v[q][j].z + v[q][j].w * v[q][j].w;
            const float r = rsqrtf(wave_sum(ss) * (1.f / D_) + EPS);
            u64* o8 = (u64*)(out + (size_t)(row0 + q) * D_) + c.lane; u64* r8 = (u64*)(raw + (size_t)(row0 + q) * D_) + c.lane;
#pragma unroll
            for (int j = 0; j < 4; ++j) { o8[64 * j] = (u64)pk2(v[q][j].x * r * gg[j].x, v[q][j].y * r * gg[j].y) | ((u64)pk2(v[q][j].z * r * gg[j].z, v[q][j].w * r * gg[j].w) << 32);
                r8[64 * j] = (u64)pk2(v[q][j].x, v[q][j].y) | ((u64)pk2(v[q][j].z, v[q][j].w) << 32); } }
    }
}
__device__ __forceinline__ void ph_norm_final(const Ctx& c, float* x, const float* g) {
    constexpr int RB = 4;
    f32x4 gg[4];
#pragma unroll
    for (int j = 0; j < 4; ++j) gg[j] = ((const f32x4*)g)[c.lane + 64 * j];
    for (int row0 = c.gw * RB; row0 < NT; row0 += c.ngw * RB) {
        f32x4 v[RB][4];
#pragma unroll
        for (int q = 0; q < RB; ++q)
#pragma unroll
            for (int j = 0; j < 4; ++j) v[q][j] = ((const f32x4*)(x + (size_t)(row0 + q) * D_))[c.lane + 64 * j];
#pragma unroll
        for (int q = 0; q < RB; ++q) { float ss = 0.f;
#pragma unroll
            for (int j = 0; j < 4; ++j) ss += v[q][j].x * v[q][j].x + v[q][j].y * v[q][j].y + v[q][j].z * v[q][j].z + v[q][j].w * v[q][j].w;
            const float r = rsqrtf(wave_sum(ss) * (1.f / D_) + EPS);
            f32x4* xr = (f32x4*)(x + (size_t)(row0 + q) * D_) + c.lane;
#pragma unroll
            for (int j = 0; j < 4; ++j) xr[64 * j] = v[q][j] * r * gg[j]; }
    }
}

template <class AF, class EF>
__device__ __forceinline__ void naive_gemm(const Ctx& c, int M, int N, int K, AF af, const float* W, int ldb, EF ef) {
    LAS float* As = (LAS float*)c.lds;
    LAS float* Bs = As + 16 * 132;
    const int tm = (M + 127) / 128, tn = (N + 127) / 128, ntile = tm * tn;
    const int ty = c.tid >> 4, tx = c.tid & 15;
    for (int tile = c.bid; tile < ntile; tile += c.G) {
        const int m0 = (tile / tn) * 128, n0 = (tile % tn) * 128;
        float acc[4][8];
#pragma unroll
        for (int i = 0; i < 4; ++i)
#pragma unroll
            for (int j = 0; j < 8; ++j) acc[i][j] = 0.f;
        for (int k0 = 0; k0 < K; k0 += 16) {
            __syncthreads();
#pragma unroll
            for (int i = 0; i < 4; ++i) { const int e = c.tid + i * 512, r = e >> 4, kk = e & 15; const int row = m0 + r;
                As[kk * 132 + r] = (row < M) ? af(row, k0 + kk) : 0.f; }
#pragma unroll
            for (int i = 0; i < 4; ++i) { const int e = c.tid + i * 512, kk = e >> 7, cc = e & 127; const int col = n0 + cc;
                Bs[kk * 132 + cc] = (col < N) ? W[(size_t)(k0 + kk) * ldb + col] : 0.f; }
            __syncthreads();
#pragma unroll 2
            for (int kk = 0; kk < 16; ++kk) {
                float a[4], b[8];
#pragma unroll
                for (int i = 0; i < 4; ++i) a[i] = As[kk * 132 + ty * 4 + i];
#pragma unroll
                for (int j = 0; j < 8; ++j) b[j] = Bs[kk * 132 + tx * 8 + j];
#pragma unroll
                for (int i = 0; i < 4; ++i)
#pragma unroll
                    for (int j = 0; j < 8; ++j) acc[i][j] = fmaf(a[i], b[j], acc[i][j]);
            }
        }
        LAS float* Cs = Bs + 16 * 132;
        __syncthreads();
#pragma unroll
        for (int i = 0; i < 4; ++i)
#pragma unroll
            for (int j = 0; j < 8; ++j) Cs[(ty * 4 + i) * 129 + tx * 8 + j] = acc[i][j];
        __syncthreads();
#pragma unroll 1
        for (int e = c.tid; e < 128 * 128; e += NTHREADS) { const int r = e >> 7, cc = e & 127, row = m0 + r, col = n0 + cc; if (row < M && col < N) ef(row, col, Cs[r * 129 + cc]); }
    }
    __syncthreads();
}

struct InProjOut { bf16* qn; bf16* kv6; bf16* fqkv; bf16* dqk; bf16* dv; float* gate; float* fl; const float* b_gate; const float* b_fgt; };
__device__ __forceinline__ void inproj_store(const InProjOut& o, int n, int col, float v) {
    const int b = n / T_, t = n % T_;
    if (col < C_KV6) { const int h = col >> 6, d = col & 63; o.qn[((size_t)(b * 8 + h) * T_ + t) * 64 + d] = (bf16)f2bf(v * (0.125f * LOG2E)); }
    else if (col < C_GATE) { const int cc = col - C_KV6, idx = cc >> 7, g = (cc >> 6) & 1, d = cc & 63;
        ((bf16*)((unsigned char*)o.kv6 + idx * KV6_STRIDE))[((size_t)(b * 2 + g) * T_ + t) * 64 + d] = (bf16)f2bf(v); }
    else if (col < C_FQ) { const int j = col - C_GATE; o.gate[(size_t)n * 24 + j] = sigmoidf_(v + o.b_gate[j]); }
    else if (col < C_FF) { const int cc = col - C_FQ, idx = cc >> 8, h = (cc >> 6) & 3, d = cc & 63;
        o.fqkv[(size_t)idx * (8 * MiB) + ((size_t)(b * 4 + h) * T_ + t) * 64 + d] = (bf16)f2bf(idx == 0 ? v * (0.125f * LOG2E) : v); }
    else if (col < C_DQ) { const int h = col - C_FF; o.fl[(size_t)(b * 4 + h) * T_ + t] = log_sigmoidf_(v + o.b_fgt[h]); }
    else if (col < C_DV) { const int cc = col - C_DQ, idx = cc >> 8, h = (cc >> 6) & 3, i = (cc >> 5) & 1, d = cc & 31;
        o.dqk[(size_t)idx * (8 * MiB) + ((size_t)((b * 4 + h) * 2 + i) * T_ + t) * 32 + d] = (bf16)f2bf(idx == 0 ? v * (0.17677669529663687f * LOG2E) : v); }
    else { const int cc = col - C_DV, h = cc >> 6, d = cc & 63; o.dv[((size_t)(b * 4 + h) * T_ + t) * 64 + d] = (bf16)f2bf(v); }
}

__device__ __forceinline__ void ph_cumsum(const Ctx& c, float* fl) {
    for (int s = c.gw; s < B_ * 4; s += c.ngw) {
        float* p = fl + (size_t)s * T_; float carry = 0.f;
        for (int t0 = 0; t0 < T_; t0 += 64) {
            float v = p[t0 + c.lane];
#pragma unroll
            for (int o = 1; o < 64; o <<= 1) { const float u = __shfl_up(v, o); if (c.lane >= o) v += u; }
            v += carry; p[t0 + c.lane] = v; carry = __shfl(v, 63);
        }
    }
}

template <int DQK>
__device__ __forceinline__ float naive_attn_row(const bf16* q, const bf16* K, const bf16* V, int t, u64 mask, float slope2, const float* cum, int win, int lane) {
    float qv[DQK];
    { const u32x4* q4 = (const u32x4*)q;
#pragma unroll
      for (int i = 0; i < DQK / 8; ++i) { const u32x4 w = q4[i];
          qv[8 * i + 0] = __uint_as_float(w.x << 16); qv[8 * i + 1] = __uint_as_float(w.x & 0xffff0000u);
          qv[8 * i + 2] = __uint_as_float(w.y << 16); qv[8 * i + 3] = __uint_as_float(w.y & 0xffff0000u);
          qv[8 * i + 4] = __uint_as_float(w.z << 16); qv[8 * i + 5] = __uint_as_float(w.z & 0xffff0000u);
          qv[8 * i + 6] = __uint_as_float(w.w << 16); qv[8 * i + 7] = __uint_as_float(w.w & 0xffff0000u); } }
    const float cumt = cum ? cum[t] : 0.f;
    float m = -INFINITY, l = 0.f, o = 0.f;
    while (mask) {
        const int j = __builtin_ctzll(mask); mask &= mask - 1;
        const int kpos = 64 * j + lane; const int dist = t - kpos;
        const bool valid = dist >= 0 && dist < win;
        float s = 0.f;
        { const u32x4* k4 = (const u32x4*)(K + (size_t)kpos * DQK);
#pragma unroll
          for (int i = 0; i < DQK / 8; ++i) { const u32x4 w = k4[i];
              s = fmaf(qv[8 * i + 0], __uint_as_float(w.x << 16), s); s = fmaf(qv[8 * i + 1], __uint_as_float(w.x & 0xffff0000u), s);
              s = fmaf(qv[8 * i + 2], __uint_as_float(w.y << 16), s); s = fmaf(qv[8 * i + 3], __uint_as_float(w.y & 0xffff0000u), s);
              s = fmaf(qv[8 * i + 4], __uint_as_float(w.z << 16), s); s = fmaf(qv[8 * i + 5], __uint_as_float(w.z & 0xffff0000u), s);
              s = fmaf(qv[8 * i + 6], __uint_as_float(w.w << 16), s); s = fmaf(qv[8 * i + 7], __uint_as_float(w.w & 0xffff0000u), s); } }
        s -= slope2 * (float)dist;
        if (cum) s += (cumt - cum[kpos]) * LOG2E;
        s = valid ? s : -INFINITY;
        const float mb = wave_max(s);
        if (mb == -INFINITY) continue;
        const float mn = fmaxf(m, mb), alpha = exp2f(m - mn);
        const float p = valid ? exp2f(s - mn) : 0.f;
        l = l * alpha + wave_sum(p); o *= alpha; m = mn;
        const bf16* vb = V + (size_t)(64 * j) * 64 + lane;
#pragma unroll 8
        for (int k = 0; k < 64; ++k) o = fmaf(__shfl(p, k), bf2f(vb[(size_t)k * 64]), o);
    }
    return l > 0.f ? o / l : 0.f;
}

__device__ __forceinline__ void ph_cmp_attn(const Ctx& c, const bf16* qn, const bf16* kcmp, const bf16* vcmp, const float* gate, u64* sel, bf16* ocmp) {
    LAS float* pl = (LAS float*)(c.lds) + c.wave * 256;
    const int lane = c.lane;
    for (int it = c.gw; it < B_ * 2 * T_; it += c.ngw) {
        const int t = it % T_, bg = it / T_, b = bg >> 1, g = bg & 1;
        const int nvis = (t >= 31) ? ((t - 31) >> 4) + 1 : 0;
        const bf16* kc = kcmp + (size_t)bg * 256 * 64; const bf16* vc = vcmp + (size_t)bg * 256 * 64;
        float imp = 0.f;
        for (int hg = 0; hg < 4; ++hg) {
            const int h = g * 4 + hg; const float slope2 = alibi_slope(h + 1, 8) * LOG2E;
            const bf16* q = qn + ((size_t)(b * 8 + h) * T_ + t) * 64;
            float qv[64];
            { const u32x4* q4 = (const u32x4*)q;
#pragma unroll
              for (int i = 0; i < 8; ++i) { const u32x4 w = q4[i];
                  qv[8 * i + 0] = __uint_as_float(w.x << 16); qv[8 * i + 1] = __uint_as_float(w.x & 0xffff0000u);
                  qv[8 * i + 2] = __uint_as_float(w.y << 16); qv[8 * i + 3] = __uint_as_float(w.y & 0xffff0000u);
                  qv[8 * i + 4] = __uint_as_float(w.z << 16); qv[8 * i + 5] = __uint_as_float(w.z & 0xffff0000u);
                  qv[8 * i + 6] = __uint_as_float(w.w << 16); qv[8 * i + 7] = __uint_as_float(w.w & 0xffff0000u); } }
            float s[4]; float m = -INFINITY;
#pragma unroll
            for (int i = 0; i < 4; ++i) { const int cc = lane + 64 * i; float a = 0.f;
                if (cc < nvis) { const u32x4* k4 = (const u32x4*)(kc + (size_t)cc * 64);
#pragma unroll
                    for (int e = 0; e < 8; ++e) { const u32x4 w = k4[e];
                        a = fmaf(qv[8 * e + 0], __uint_as_float(w.x << 16), a); a = fmaf(qv[8 * e + 1], __uint_as_float(w.x & 0xffff0000u), a);
                        a = fmaf(qv[8 * e + 2], __uint_as_float(w.y << 16), a); a = fmaf(qv[8 * e + 3], __uint_as_float(w.y & 0xffff0000u), a);
                        a = fmaf(qv[8 * e + 4], __uint_as_float(w.z << 16), a); a = fmaf(qv[8 * e + 5], __uint_as_float(w.z & 0xffff0000u), a);
                        a = fmaf(qv[8 * e + 6], __uint_as_float(w.w << 16), a); a = fmaf(qv[8 * e + 7], __uint_as_float(w.w & 0xffff0000u), a); }
                    a -= slope2 * (float)(t - (16 * cc + 31)); } else a = -INFINITY;
                s[i] = a; m = fmaxf(m, a); }
            m = wave_max(m);
            float p[4], lsum = 0.f;
#pragma unroll
            for (int i = 0; i < 4; ++i) { p[i] = (lane + 64 * i < nvis) ? exp2f(s[i] - m) : 0.f; lsum += p[i]; }
            lsum = wave_sum(lsum);
            const float inv = lsum > 0.f ? 1.f / lsum : 0.f;
#pragma unroll
            for (int i = 0; i < 4; ++i) { p[i] *= inv; pl[lane + 64 * i] = p[i]; }
            asm volatile("s_waitcnt lgkmcnt(0)" ::: "memory");
            float o = 0.f;
            for (int cc = 0; cc < nvis; ++cc) o = fmaf(pl[cc], bf2f(vc[(size_t)cc * 64 + lane]), o);
            const float gt = gate[((size_t)(b * T_ + t)) * 24 + h * 3 + 0];
            ocmp[(size_t)(b * T_ + t) * 512 + h * 64 + lane] = (bf16)f2bf(gt * o);
            { const int j = lane; float a = pl[4 * j] + pl[4 * j + 1] + pl[4 * j + 2] + 0.5f * pl[4 * j + 3]; if (j > 0) a += 0.5f * pl[4 * j - 1]; imp += a; }
            asm volatile("s_waitcnt lgkmcnt(0)" ::: "memory");
        }
        const int cur = t >> 6; const int j = lane;
        u64 m64;
        if (cur <= 15) m64 = (cur == 63) ? ~0ull : ((1ull << (cur + 1)) - 1ull);
        else {
            float val = (j > cur) ? -INFINITY : ((j == 0 || j == cur || j == cur - 1) ? 1e4f : imp);
            m64 = 0ull;
            for (int r = 0; r < 16; ++r) {
                const float mx = wave_max(val);
                const u64 bal = __ballot(val == mx);
                const int w = __builtin_ctzll(bal);
                m64 |= 1ull << w; if (j == w) val = -INFINITY;
            }
        }
        if (lane == 0) sel[(size_t)bg * T_ + t] = m64;
    }
}

__device__ __forceinline__ void ph_win_attn(const Ctx& c, const bf16* qn, const bf16* kw, const bf16* vw, const float* gate, bf16* owin) {
    for (int it = c.gw; it < B_ * 8 * T_; it += c.ngw) {
        const int t = it % T_, bh = it / T_, b = bh >> 3, h = bh & 7, g = h >> 2;
        const int cur = t >> 6, jlo = (t - 511) > 0 ? (t - 511) >> 6 : 0;
        const u64 hi = (cur == 63) ? ~0ull : ((1ull << (cur + 1)) - 1ull); const u64 mask = hi & ~((1ull << jlo) - 1ull);
        const float o = naive_attn_row<64>(qn + ((size_t)bh * T_ + t) * 64, kw + (size_t)(b * 2 + g) * T_ * 64, vw + (size_t)(b * 2 + g) * T_ * 64, t, mask,
                                           alibi_slope(h + 1, 8) * LOG2E, nullptr, 512, c.lane);
        owin[(size_t)(b * T_ + t) * 512 + h * 64 + c.lane] = (bf16)f2bf(gate[(size_t)(b * T_ + t) * 24 + h * 3 + 2] * o);
    }
}
__device__ __forceinline__ void ph_slc_attn(const Ctx& c, const bf16* qn, const bf16* ks, const bf16* vs, const float* gate, const u64* sel, const bf16* ocmp, const bf16* owin, bf16* att) {
    for (int it = c.gw; it < B_ * 8 * T_; it += c.ngw) {
        const int t = it % T_, bh = it / T_, b = bh >> 3, h = bh & 7, g = h >> 2;
        const u64 mask = sel[(size_t)(b * 2 + g) * T_ + t];
        const float o = naive_attn_row<64>(qn + ((size_t)bh * T_ + t) * 64, ks + (size_t)(b * 2 + g) * T_ * 64, vs + (size_t)(b * 2 + g) * T_ * 64, t, mask,
                                           alibi_slope(h + 1, 8) * LOG2E, nullptr, 1 << 30, c.lane);
        const size_t n = (size_t)(b * T_ + t);
        const float r = gate[n * 24 + h * 3 + 1] * o + bf2f(ocmp[n * 512 + h * 64 + c.lane]) + bf2f(owin[n * 512 + h * 64 + c.lane]);
        att[n * 1024 + h * 64 + c.lane] = (bf16)f2bf(r);
    }
}
__device__ __forceinline__ void ph_fox_attn(const Ctx& c, const bf16* fq, const bf16* fk, const bf16* fv, const float* cum, bf16* att) {
    for (int it = c.gw; it < B_ * 4 * T_; it += c.ngw) {
        const int t = it % T_, bh = it / T_, b = bh >> 2, h = bh & 3;
        const int cur = t >> 6; const u64 mask = (cur == 63) ? ~0ull : ((1ull << (cur + 1)) - 1ull);
        const float o = naive_attn_row<64>(fq + ((size_t)bh * T_ + t) * 64, fk + (size_t)bh * T_ * 64, fv + (size_t)bh * T_ * 64, t, mask, 0.f, cum + (size_t)bh * T_, 1 << 30, c.lane);
        att[(size_t)(b * T_ + t) * 1024 + 512 + h * 64 + c.lane] = (bf16)f2bf(o);
    }
}
__device__ __forceinline__ void ph_diff_attn(const Ctx& c, const bf16* dq, const bf16* dk, const bf16* dv, const float* lam, const float* subln, float lambda_init, bf16* att) {
    float l1 = 0.f, l2 = 0.f;
    if (c.lane < 32) { l1 = lam[c.lane] * lam[32 + c.lane]; l2 = lam[64 + c.lane] * lam[96 + c.lane]; }
    const float lam_full = __expf(wave_sum(l1)) - __expf(wave_sum(l2)) + lambda_init;
    const float sg = subln[c.lane] * (1.f - lambda_init);
    for (int it = c.gw; it < B_ * 4 * T_; it += c.ngw) {
        const int t = it % T_, bh = it / T_, b = bh >> 2, h = bh & 3;
        const int cur = t >> 6; const u64 mask = (cur == 63) ? ~0ull : ((1ull << (cur + 1)) - 1ull);
        const float slope2 = alibi_slope(h + 1, 4) * LOG2E;
        const bf16* vb = dv + (size_t)bh * T_ * 64;
        const float o1 = naive_attn_row<32>(dq + ((size_t)(bh * 2 + 0) * T_ + t) * 32, dk + (size_t)(bh * 2 + 0) * T_ * 32, vb, t, mask, slope2, nullptr, 1 << 30, c.lane);
        const float o2 = naive_attn_row<32>(dq + ((size_t)(bh * 2 + 1) * T_ + t) * 32, dk + (size_t)(bh * 2 + 1) * T_ * 32, vb, t, mask, slope2, nullptr, 1 << 30, c.lane);
        const float o = o1 - lam_full * o2;
        const float r = rsqrtf(wave_sum(o * o) * (1.f / 64.f) + EPS);
        att[(size_t)(b * T_ + t) * 1024 + 768 + h * 64 + c.lane] = (bf16)f2bf(o * r * sg);
    }
}

__device__ __forceinline__ void ph_moe_route(const Ctx& c, const float* x, const float* g, const float* wgrp, const float* bgrp, const float* wexp, const float* bexp, bf16* hn, int* route_e, float* route_w, unsigned* cnt) {
    for (int row = c.gw; row < NT; row += c.ngw) {
        const f32x4* xr = (const f32x4*)(x + (size_t)row * D_) + c.lane;
        f32x4 v[4]; float ss = 0.f;
#pragma unroll
        for (int j = 0; j < 4; ++j) { v[j] = xr[64 * j]; ss += v[j].x * v[j].x + v[j].y * v[j].y + v[j].z * v[j].z + v[j].w * v[j].w; }
        const float r = rsqrtf(wave_sum(ss) * (1.f / D_) + EPS);
        u64* o8 = (u64*)(hn + (size_t)row * D_) + c.lane;
#pragma unroll
        for (int j = 0; j < 4; ++j) { const f32x4 gg = ((const f32x4*)g)[c.lane + 64 * j]; v[j] = v[j] * r * gg;
            o8[64 * j] = (u64)pk2(v[j].x, v[j].y) | ((u64)pk2(v[j].z, v[j].w) << 32); }
        float gl[4];
#pragma unroll
        for (int q = 0; q < 4; ++q) { float a = 0.f;
#pragma unroll
            for (int j = 0; j < 4; ++j) { const int k = 4 * (c.lane + 64 * j);
                a = fmaf(v[j].x, wgrp[(size_t)(k + 0) * 4 + q], a); a = fmaf(v[j].y, wgrp[(size_t)(k + 1) * 4 + q], a);
                a = fmaf(v[j].z, wgrp[(size_t)(k + 2) * 4 + q], a); a = fmaf(v[j].w, wgrp[(size_t)(k + 3) * 4 + q], a); }
            gl[q] = wave_sum(a) + bgrp[q]; }
        int grp = 0; float gm = gl[0];
#pragma unroll
        for (int q = 1; q < 4; ++q) if (gl[q] > gm) { gm = gl[q]; grp = q; }
        float gs = 0.f;
#pragma unroll
        for (int q = 0; q < 4; ++q) gs += __expf(gl[q] - gm);
        const float grp_gate = 1.f / gs;
        float el[8];
#pragma unroll
        for (int q = 0; q < 8; ++q) { float a = 0.f; const int col = grp * 8 + q;
#pragma unroll
            for (int j = 0; j < 4; ++j) { const int k = 4 * (c.lane + 64 * j);
                a = fmaf(v[j].x, wexp[(size_t)(k + 0) * 32 + col], a); a = fmaf(v[j].y, wexp[(size_t)(k + 1) * 32 + col], a);
                a = fmaf(v[j].z, wexp[(size_t)(k + 2) * 32 + col], a); a = fmaf(v[j].w, wexp[(size_t)(k + 3) * 32 + col], a); }
            el[q] = wave_sum(a) + bexp[col]; }
        int i0 = 0; float v0 = el[0];
#pragma unroll
        for (int q = 1; q < 8; ++q) if (el[q] > v0) { v0 = el[q]; i0 = q; }
        int i1 = -1; float v1 = -INFINITY;
#pragma unroll
        for (int q = 0; q < 8; ++q) if (q != i0 && el[q] > v1) { v1 = el[q]; i1 = q; }
        const float e1 = __expf(v1 - v0), den = 1.f + e1;
        if (c.lane == 0) { const float w0 = grp_gate / den, w1 = grp_gate * e1 / den;
            const int lo = i0 < i1 ? i0 : i1, hi = i0 < i1 ? i1 : i0, cls = grp * 28 + lo * 8 - (lo * (lo + 1)) / 2 + (hi - lo - 1);
            const unsigned rank = __hip_atomic_fetch_add(cnt + cls, 1u, __ATOMIC_RELAXED, __HIP_MEMORY_SCOPE_AGENT);
            route_e[row] = (int)(((unsigned)cls << 24) | rank); route_w[2 * row] = i0 < i1 ? w0 : w1; route_w[2 * row + 1] = i0 < i1 ? w1 : w0; }
    }
}
__device__ __forceinline__ void ph_moe_naive(const Ctx& c, const bf16* hn, const int* route_e, const float* route_w, const float* wg, const float* wu, const float* wd, float* x) {
    LAS float* hs = (LAS float*)c.lds;
    LAS float* au = hs + 1024;
    LAS float* h2 = au + 512;
    for (int row = c.bid; row < NT; row += c.G) {
        __syncthreads();
        hs[c.tid] = bf2f(hn[(size_t)row * D_ + c.tid]); hs[c.tid + 512] = bf2f(hn[(size_t)row * D_ + c.tid + 512]);
        float o0 = 0.f, o1 = 0.f;
        for (int s = 0; s < 2; ++s) {
            const int e = route_e[2 * row + s]; const float w = route_w[2 * row + s];
            __syncthreads();
            const float* W = (c.tid < 256 ? wg : wu) + (size_t)e * D_ * DEXP + (c.tid & 255);
            float a = 0.f;
            for (int k = 0; k < D_; ++k) a = fmaf(hs[k], W[(size_t)k * DEXP], a);
            au[c.tid] = a;
            __syncthreads();
            if (c.tid < 256) { const float ga = au[c.tid], up = au[c.tid + 256]; h2[c.tid] = ga / (1.f + __expf(-ga)) * up * w; }
            __syncthreads();
            const float* Wd = wd + (size_t)e * DEXP * D_;
            for (int k = 0; k < DEXP; ++k) { const float hv = h2[k]; o0 = fmaf(hv, Wd[(size_t)k * D_ + c.tid], o0); o1 = fmaf(hv, Wd[(size_t)k * D_ + c.tid + 512], o1); }
        }
        x[(size_t)row * D_ + c.tid] += o0; x[(size_t)row * D_ + c.tid + 512] += o1;
    }
    __syncthreads();
}

typedef __attribute__((address_space(4))) const Params* KP;
__device__ __forceinline__ KP uni_kp(KP p) { const unsigned long long v = (unsigned long long)p; const unsigned lo = __builtin_amdgcn_readfirstlane((unsigned)v), hi = __builtin_amdgcn_readfirstlane((unsigned)(v >> 32)); return (KP)(((unsigned long long)hi << 32) | lo); }
constexpr int PH_PER_LAYER = 11, N_PHASES = L_ * PH_PER_LAYER + 2;
__device__ __forceinline__ Ctx make_ctx(KP p) {
    Ctx c; c.lds = (LAS unsigned char*)lds_raw; { int t_ = threadIdx.x; asm volatile("" : "+v"(t_)); c.tid = t_; } c.lane = c.tid & 63; c.wave = __builtin_amdgcn_readfirstlane(c.tid >> 6);
    c.bid = blockIdx.x; c.G = gridDim.x; c.gw = c.bid * NWAVES + c.wave; c.ngw = c.G * NWAVES; c.in = nullptr; c.xcur = p->out; c.ws = p->ws;
    return c;
}
struct Bufs {
    bf16 *QN, *KV6, *KC, *VC, *KS, *VS, *KW, *VW, *FQ, *FK, *FV, *DQ, *DK, *DV, *HC, *KCMP, *VCMP, *OCMP, *OWIN, *HN, *ATT;
    float *GATE, *FL, *ROUTE_W; u64* SEL; int* ROUTE_E;
};
__device__ __forceinline__ Bufs make_bufs(unsigned char* ws) {
    Bufs b;
    b.QN = (bf16*)(ws + WS_QN); b.KV6 = (bf16*)(ws + WS_KV6);
    b.KC = (bf16*)(ws + WS_KV6 + 0 * KV6_STRIDE); b.VC = (bf16*)(ws + WS_KV6 + 1 * KV6_STRIDE);
    b.KS = (bf16*)(ws + WS_KV6 + 2 * KV6_STRIDE); b.VS = (bf16*)(ws + WS_KV6 + 3 * KV6_STRIDE);
    b.KW = (bf16*)(ws + WS_KV6 + 4 * KV6_STRIDE); b.VW = (bf16*)(ws + WS_KV6 + 5 * KV6_STRIDE);
    b.FQ = (bf16*)(ws + WS_FQKV); b.FK = b.FQ + 8 * MiB; b.FV = b.FQ + 16 * MiB;
    b.DQ = (bf16*)(ws + WS_DQK); b.DK = b.DQ + 8 * MiB; b.DV = (bf16*)(ws + WS_DV);
    b.GATE = (float*)(ws + WS_GATE); b.FL = (float*)(ws + WS_FL);
    b.HC = (bf16*)(ws + WS_HC); b.KCMP = (bf16*)(ws + WS_KVCMP); b.VCMP = b.KCMP + 16 * 256 * 64;
    b.SEL = (u64*)(ws + WS_SEL); b.OCMP = (bf16*)(ws + WS_OCMP); b.OWIN = (bf16*)(ws + WS_OWIN);
    b.HN = (bf16*)(ws + WS_HN); b.ATT = (bf16*)(ws + WS_ATT);
    b.ROUTE_E = (int*)(ws + WS_ROUTE); b.ROUTE_W = (float*)(ws + WS_ROUTE + 512 * 1024);
    return b;
}
__device__ __forceinline__ float lambda_init_of(int l) { return l == 0 ? 0.2f : 0.35550906759096926f; }

__device__ __noinline__ void P_prologue(KP p_) { const KP p = uni_kp(p_);
    const Ctx c = make_ctx(p); unsigned char* ws = p->ws;
    LAS float* scr = (LAS float*)(c.lds) + c.wave * (64 * 33);
    constexpr int I_A = 16 * 40, I_B = 16 * 24, I_C = 16 * 24, I_O = 16 * 32, I_G = 16 * 8, I_D = 4 * 32, I_E = 2 * I_G + I_D, I_W1 = 32 * 8, I_W2 = 4 * 2;
    constexpr int PER_L = I_A + I_B + I_C + I_O + NEXP * I_E + 2 * (I_W1 + I_W2);
    for (int it = c.gw; it < L_ * PER_L; it += c.ngw) {
        const int l = it / PER_L; int r = it % PER_L;
        const float* W; bf16* WT; int ldw, K, sc0, ncol, r0 = 0, rmul = 1;
        if (r < I_A + I_B + I_C) { W = p->in[2] + (size_t)l * D_ * D_IN; WT = (bf16*)(ws + WS_WIN_T) + (size_t)l * NIN * D_; ldw = D_IN; K = D_;
            if (r < I_A) { sc0 = 0; ncol = 1280; r0 = 0; } else if (r < I_A + I_B) { r -= I_A; sc0 = C_FQ; ncol = 768; r0 = 1280; } else { r -= I_A + I_B; sc0 = C_DQ; ncol = 768; r0 = 2048; } }
        else if ((r -= I_A + I_B + I_C) < I_O) { W = p->in[13] + (size_t)l * D_ * D_; WT = (bf16*)(ws + WS_WOUT_T) + (size_t)l * D_ * D_; ldw = D_; K = D_; sc0 = 0; ncol = 1024; }
        else if ((r -= I_O) < NEXP * I_E) { const int e = r / I_E; r = r % I_E; const size_t le = (size_t)l * NEXP + e;
            if (r < 2 * I_G) { const int up = r >= I_G; r -= up * I_G; W = p->in[19 + up] + le * D_ * DEXP; WT = (bf16*)(ws + WS_WGU_T) + le * 512 * D_; ldw = DEXP; K = D_; sc0 = 0; ncol = 256; r0 = up; rmul = 2; }
            else { r -= 2 * I_G; W = p->in[21] + le * DEXP * D_; WT = (bf16*)(ws + WS_WD_T) + le * D_ * DEXP; ldw = D_; K = DEXP; sc0 = 0; ncol = 1024; } }
        else { r -= NEXP * I_E; const int kv = r / (I_W1 + I_W2); r = r % (I_W1 + I_W2); const size_t lk = (size_t)l * 2 + kv;
            if (r < I_W1) { W = p->in[kv == 0 ? 6 : 9] + (size_t)l * 2048 * 256; WT = (bf16*)(ws + WS_W1_T) + lk * 256 * 2048; ldw = 256; K = 2048; sc0 = 0; ncol = 256; }
            else { r -= I_W1; W = p->in[kv == 0 ? 7 : 10] + (size_t)l * 256 * 64; WT = (bf16*)(ws + WS_W2_T) + lk * 64 * 256; ldw = 64; K = 256; sc0 = 0; ncol = 64; } }
        transpose_seg(W, ldw, K, sc0, ncol, WT, r0, rmul, r, scr, c.lane);
    }
    for (int i = c.bid * NTHREADS + c.tid; i < L_ * 256 * D_; i += c.G * NTHREADS) {
        const int l = i / (256 * D_), rr = (i / D_) % 256, k = i % D_;
        const float* win = p->in[2] + (size_t)l * D_ * D_IN;
        float v = 0.f; if (rr < 24) v = win[(size_t)k * D_IN + C_GATE + rr]; else if (rr < 28) v = win[(size_t)k * D_IN + C_FF + (rr - 24)];
        ((bf16*)(ws + WS_WIN_T))[((size_t)l * NIN + 2816 + rr) * D_ + k] = (bf16)f2bf(v);
    }
    for (int w = c.gw; w < L_ * 2 * 4 * 128; w += c.ngw) {
        const int lk = w >> 9, cg = (w >> 7) & 3, kc = w & 127, l = lk >> 1, kv = lk & 1, j = cg * 64 + c.lane;
        const float* pe = p->in[kv == 0 ? 5 : 8] + (size_t)l * 2048 + kc * 16; const float* w1 = p->in[kv == 0 ? 6 : 9] + (size_t)l * 2048 * 256 + (size_t)kc * 16 * 256;
        float a = 0.f;
#pragma unroll
        for (int k = 0; k < 16; ++k) a = fmaf(pe[k], w1[(size_t)k * 256 + j], a);
        ((float*)(ws + WS_B1PART))[((size_t)lk * 128 + kc) * 256 + j] = a;
    }
    for (int i = c.bid * NTHREADS + c.tid; i < L_ * 64 * 2 * 64; i += c.G * NTHREADS) {
        const int l = i / (64 * 2 * 64), ks = (i / 128) % 64, cb = (i / 64) & 1, lane = i & 63, col = 32 * cb + (lane & 31);
        unsigned hi[4], lo[4];
#pragma unroll
        for (int jp = 0; jp < 4; ++jp) { float v[2];
#pragma unroll
            for (int e = 0; e < 2; ++e) { const int k = 16 * ks + 8 * (lane >> 5) + 2 * jp + e; const float g = p->in[14][(size_t)l * D_ + k];
                v[e] = col < 4 ? g * p->in[15][((size_t)l * D_ + k) * 4 + col] : (col < 36 ? g * p->in[17][((size_t)l * D_ + k) * 32 + (col - 4)] : 0.f); }
            const unsigned h0 = f2bf(v[0]), h1 = f2bf(v[1]); hi[jp] = h0 | (h1 << 16);
            lo[jp] = f2bf(v[0] - __uint_as_float(h0 << 16)) | (f2bf(v[1] - __uint_as_float(h1 << 16)) << 16); }
        u32x4* dst = (u32x4*)(ws + WS_WR) + ((size_t)((l * 64 + ks) * 2 + cb) * 2) * 64 + lane;
        dst[0] = (u32x4){hi[0], hi[1], hi[2], hi[3]}; dst[64] = (u32x4){lo[0], lo[1], lo[2], lo[3]};
    }
}
__device__ __forceinline__ void P_inproj_mfma(int l_) { const KP p = (KP)__builtin_amdgcn_kernarg_segment_ptr(); int l = l_; asm volatile("" : "+s"(l));
    unsigned char* ws = p->ws; asm volatile("" : "+s"(ws));
    PlainOrder S; S.init(p->out, (const bf16*)(ws + WS_WIN_T) + (size_t)l * NIN * D_, D_, D_, NT, NIN, (int)gridDim.x, launder_s((int)blockIdx.x));
#ifdef STAGGER_TICKS
    { const unsigned long long t0 = __builtin_amdgcn_s_memrealtime(); const unsigned long long d = (unsigned long long)((launder_s((int)blockIdx.x) >> 3) & 3) * STAGGER_TICKS;
      while (__builtin_amdgcn_s_memrealtime() - t0 < d) __builtin_amdgcn_s_sleep(4); }
#endif
    const pg8::Gemm g{D_, D_, D_, D_ / 64};
    const EpiInProj E{ws, p->in[3] + l * 24, p->in[4] + l * 4, (unsigned*)(ws + WS_CTL) + CW_KN + l * 8192};
    pg8::gemm_phase<EpiInProj, PlainOrder, INPROJ_ALIGN, INPROJ_SP2>((LAS unsigned char*)lds_raw, g, S, E);
}
__device__ __forceinline__ void P_inproj_dummy(int l_) { const KP p = (KP)__builtin_amdgcn_kernarg_segment_ptr(); int l = l_; asm volatile("" : "+s"(l));
    unsigned char* ws = p->ws; asm volatile("" : "+s"(ws));
    PlainOrder S; S.init(p->out, (const bf16*)(ws + WS_WIN_T) + (size_t)l * NIN * D_, D_, D_, NT, NIN, (int)gridDim.x, launder_s((int)blockIdx.x));
    const pg8::Gemm g{D_, D_, D_, D_ / 64};
    const EpiDummy E{(float*)(ws + WS_HB)};
    pg8::gemm_phase<EpiDummy, PlainOrder, true, true>((LAS unsigned char*)lds_raw, g, S, E);
}
__device__ __forceinline__ void P_outproj_mfma(int l_) { const KP p = (KP)__builtin_amdgcn_kernarg_segment_ptr(); int l = l_; asm volatile("" : "+s"(l));
    unsigned char* ws = p->ws; asm volatile("" : "+s"(ws));
    PlainOrder S; S.init(ws + WS_ATT, (const bf16*)(ws + WS_WOUT_T) + (size_t)l * D_ * D_, D_, D_, NT, D_, (int)gridDim.x, launder_s((int)blockIdx.x));
    const pg8::Gemm g{D_, D_, D_, D_ / 64};
    const EpiResBf16 E{(bf16*)(ws + WS_HN)};
    pg8::gemm_phase<EpiResBf16, PlainOrder, true, true>((LAS unsigned char*)lds_raw, g, S, E);
}
__device__ __forceinline__ float wave_max_l(float v, int lane) {
#pragma unroll
    for (int o = 1; o < 64; o <<= 1) v = fmaxf(v, shflx_f(v, o, lane));
    return v;
}
__device__ __forceinline__ float wave_min_l(float v, int lane) {
#pragma unroll
    for (int o = 1; o < 64; o <<= 1) v = fminf(v, shflx_f(v, o, lane));
    return v;
}
template <int NS> __device__ __forceinline__ float q_norm2_max(const bf16x8v (&Q)[NS], int lane) {
    float ss = 0.f;
#pragma unroll
    for (int s = 0; s < NS; ++s)
#pragma unroll
        for (int e = 0; e < 8; ++e) { const float v = __uint_as_float(((unsigned)(unsigned short)Q[s][e]) << 16); ss = fmaf(v, v, ss); }
    return wave_max_l(swap_sum(ss), lane);
}
__device__ __forceinline__ u64 prune_consensus(bool skip, LAS u64* slots, int wave, int lane) {
    const u64 mine = __ballot(skip);
    __syncthreads();
    if (lane == 0) slots[wave] = mine;
    __syncthreads();
    u64 all = slots[0];
#pragma unroll
    for (int w = 1; w < NWAVES; ++w) all &= slots[w];
    return all;
}
__device__ __forceinline__ void U_fox(KP p_, int bh_, int qb_, int l_) {
    const KP p = uni_kp(p_); const int bh = __builtin_amdgcn_readfirstlane(bh_), qb = __builtin_amdgcn_readfirstlane(qb_), l = __builtin_amdgcn_readfirstlane(l_);
    int tid_ = threadIdx.x; asm volatile("" : "+v"(tid_));
    const int tid = tid_, lane = tid & 63, wave = __builtin_amdgcn_readfirstlane(tid >> 6), r = lane & 31, h = lane >> 5;
    unsigned char* ws = p->ws; asm volatile("" : "+s"(ws)); LAS unsigned char* L = (LAS unsigned char*)lds_raw;
    const int tw0 = 256 * qb + 32 * wave, t_lane = tw0 + r, b = bh >> 2, hd = bh & 3;
    const bf16* q = (const bf16*)(ws + WS_FQKV) + ((size_t)bh * T_ + t_lane) * 64 + 8 * h;
    bf16x8v Qf[1][4];
#pragma unroll
    for (int s = 0; s < 4; ++s) Qf[0][s] = *(const bf16x8v*)(q + 16 * s);
    LAS float* cum = (LAS float*)(L + A_LDS_END);
    { const float* fl = (const float*)(ws + WS_FL) + (size_t)bh * T_; LAS float* tot = cum + 4096;
      const int nval = 256 * (qb + 1); float v[8];
      if (8 * tid < nval) { const f32x4 a = *(const f32x4*)(fl + 8 * tid), c2 = *(const f32x4*)(fl + 8 * tid + 4); v[0] = a.x; v[1] = a.y; v[2] = a.z; v[3] = a.w; v[4] = c2.x; v[5] = c2.y; v[6] = c2.z; v[7] = c2.w; }
      else {
#pragma unroll
          for (int i = 0; i < 8; ++i) v[i] = 0.f; }
#pragma unroll
      for (int i = 1; i < 8; ++i) v[i] += v[i - 1];
      float sc = v[7];
#pragma unroll
      for (int o = 1; o < 64; o <<= 1) { const float up = __uint_as_float((unsigned)__builtin_amdgcn_ds_bpermute((lane - o) << 2, (int)__float_as_uint(sc))); if (lane >= o) sc += up; }
      if (lane == 63) tot[wave] = sc;
      __syncthreads();
      float base = sc - v[7];
      for (int w = 0; w < wave; ++w) base += tot[w];
      if (8 * tid < nval) {
#pragma unroll
          for (int i = 0; i < 8; ++i) cum[8 * tid + i] = v[i] + base; }
      __syncthreads(); }
    f32x16 O[1][2]; float M[1] = {0.f}, Ls[1] = {0.f};
#pragma unroll
    for (int i = 0; i < 16; ++i) { O[0][0][i] = 0.f; O[0][1][i] = 0.f; }
    const u64 tm = (qb == 15) ? ~0ull : ((1ull << (4 * qb + 4)) - 1ull);
#if AC2_MODE == 0
    {
        const u64 low = (1ull << (4 * qb)) - 1ull; const float cref = cum[256 * qb];
        const bf16* Kp = (const bf16*)(ws + WS_FQKV) + 8 * MiB + (size_t)bh * T_ * 64; const bf16* Vp = (const bf16*)(ws + WS_FQKV) + 16 * MiB + (size_t)bh * T_ * 64;
        attn_core<64, 1, true, false>(L, Kp, nullptr, Vp, cum, cref, Qf, tm & ~low, t_lane, tw0, 1 << 30, 0.f, 0u, 0u, O, M, Ls, tid);
        if (qb > 0) {
            const float qn2 = q_norm2_max<4>(Qf[0], lane), mmin = wave_min_l(M[0], lane);
            const float* kn = (const float*)((const unsigned*)(ws + WS_CTL) + CW_KN + l * 8192) + ((size_t)bh * 64 + lane) * 2;
            bool skip = false;
            if (lane < 4 * qb) { const float kn2 = kn[0] + kn[1]; const float bound = sqrtf(qn2 * kn2) * 1.02f + (cref - cum[64 * lane + 63]) * LOG2E - mmin; skip = bound < -152.f; }
            const u64 drop = prune_consensus(skip, (LAS u64*)(cum + 4096 + 16), wave, lane);
            const u64 tm2 = low & ~drop;
            if (tm2) attn_core<64, 1, true, false>(L, Kp, nullptr, Vp, cum, cref, Qf, tm2, t_lane, tw0, 1 << 30, 0.f, 0u, 0u, O, M, Ls, tid, true);
        }
    }
#else
    attn_core2<true, false>(L, (const bf16*)(ws + WS_FQKV) + 8 * MiB + (size_t)bh * T_ * 64, (const bf16*)(ws + WS_FQKV) + 16 * MiB + (size_t)bh * T_ * 64, cum, cum[256 * qb],
                            Qf[0], tm, t_lane, tw0, 1 << 30, 0.f, 0u, 0u, O[0], M[0], Ls[0], tid);
#endif
    const float lt = swap_sum(Ls[0]), inv = lt > 0.f ? 1.f / lt : 0.f;
    bf16* dst = (bf16*)(ws + WS_ATT) + ((size_t)b * T_ + t_lane) * 1024 + 512 + hd * 64 + 4 * h;
    ATTN_FOR_CHUNKS(db, g4) { const unsigned w0 = cvtpk(O[0][db][4 * g4 + 0] * inv, O[0][db][4 * g4 + 1] * inv), w1 = cvtpk(O[0][db][4 * g4 + 2] * inv, O[0][db][4 * g4 + 3] * inv);
        *(u64*)(dst + 32 * db + 8 * g4) = (u64)w0 | ((u64)w1 << 32); }
}
__device__ __forceinline__ void U_diff(KP p_, int bh_, int qb_, int l_) {
    const KP p = uni_kp(p_); const int bh = __builtin_amdgcn_readfirstlane(bh_), qb = __builtin_amdgcn_readfirstlane(qb_), l = __builtin_amdgcn_readfirstlane(l_);
    int tid_ = threadIdx.x; asm volatile("" : "+v"(tid_));
    const int tid = tid_, lane = tid & 63, wave = __builtin_amdgcn_readfirstlane(tid >> 6), r = lane & 31, h = lane >> 5;
    unsigned char* ws = p->ws; asm volatile("" : "+s"(ws)); LAS unsigned char* L = (LAS unsigned char*)lds_raw;
    const int tw0 = 256 * qb + 32 * wave, t_lane = tw0 + r, b = bh >> 2, hd = bh & 3;
    const bf16* DQ = (const bf16*)(ws + WS_DQK); const bf16* DK = DQ + 8 * MiB;
    bf16x8v Qf[2][2];
#pragma unroll
    for (int mp = 0; mp < 2; ++mp)
#pragma unroll
        for (int s = 0; s < 2; ++s) Qf[mp][s] = *(const bf16x8v*)(DQ + ((size_t)(bh * 2 + mp) * T_ + t_lane) * 32 + 16 * s + 8 * h);
    f32x16 O[2][2]; float M[2] = {0.f, 0.f}, Ls[2] = {0.f, 0.f};
#pragma unroll
    for (int i = 0; i < 16; ++i) { O[0][0][i] = 0.f; O[0][1][i] = 0.f; O[1][0][i] = 0.f; O[1][1][i] = 0.f; }
    const u64 tm = (qb == 15) ? ~0ull : ((1ull << (4 * qb + 4)) - 1ull);
    {
        const u64 low = (1ull << (4 * qb)) - 1ull; const float slope2 = alibi_slope(hd + 1, 4) * LOG2E;
        const bf16* K0 = DK + (size_t)(bh * 2 + 0) * T_ * 32; const bf16* K1 = DK + (size_t)(bh * 2 + 1) * T_ * 32; const bf16* Vp = (const bf16*)(ws + WS_DV) + (size_t)bh * T_ * 64;
        attn_core<32, 2, false, false>(L, K0, K1, Vp, nullptr, 0.f, Qf, tm & ~low, t_lane, tw0, 1 << 30, slope2, 0u, 0u, O, M, Ls, tid);
        if (qb > 0) {
            const float qa = q_norm2_max<2>(Qf[0], lane), qb2 = q_norm2_max<2>(Qf[1], lane), ma = wave_min_l(M[0], lane), mb = wave_min_l(M[1], lane);
            const float* kn = (const float*)((const unsigned*)(ws + WS_CTL) + CW_KN + l * 8192 + 4096) + (size_t)(bh * 2) * 64 + lane;
            bool skip = false;
            if (lane < 4 * qb) { const float bmax = slope2 * (float)(64 * lane + 63 - tw0);
                skip = (sqrtf(qa * kn[0]) * 1.02f + bmax - ma < -152.f) && (sqrtf(qb2 * kn[64]) * 1.02f + bmax - mb < -152.f); }
            const u64 drop = prune_consensus(skip, (LAS u64*)(L + A_LDS_END), wave, lane);
            const u64 tm2 = low & ~drop;
            if (tm2) attn_core<32, 2, false, false>(L, K0, K1, Vp, nullptr, 0.f, Qf, tm2, t_lane, tw0, 1 << 30, slope2, 0u, 0u, O, M, Ls, tid, true);
        }
    }
    const float* lam = p->in[11] + (size_t)l * 128; const float* subln = p->in[12] + (size_t)l * 64;
    float l1 = 0.f, l2 = 0.f; if (lane < 32) { l1 = lam[lane] * lam[32 + lane]; l2 = lam[64 + lane] * lam[96 + lane]; }
    const float li = lambda_init_of(l), lam_full = __expf(wave_sum_l(l1, lane)) - __expf(wave_sum_l(l2, lane)) + li;
    const float lt0 = swap_sum(Ls[0]), lt1 = swap_sum(Ls[1]), i0 = lt0 > 0.f ? 1.f / lt0 : 0.f, i1 = (lt1 > 0.f ? 1.f / lt1 : 0.f) * lam_full;
    float ss = 0.f;
#pragma unroll
    for (int db = 0; db < 2; ++db)
#pragma unroll
        for (int i = 0; i < 16; ++i) { const float o = O[0][db][i] * i0 - O[1][db][i] * i1; O[0][db][i] = o; ss += o * o; }
    ss = swap_sum(ss);
    const float rn = rsqrtf(ss * (1.f / 64.f) + EPS) * (1.f - li);
    bf16* dst = (bf16*)(ws + WS_ATT) + ((size_t)b * T_ + t_lane) * 1024 + 768 + hd * 64 + 4 * h;
    ATTN_FOR_CHUNKS(db, g4) { const f32x4 sg = *(const f32x4*)(subln + 32 * db + 8 * g4 + 4 * h);
        const unsigned w0 = cvtpk(O[0][db][4 * g4 + 0] * rn * sg.x, O[0][db][4 * g4 + 1] * rn * sg.y), w1 = cvtpk(O[0][db][4 * g4 + 2] * rn * sg.z, O[0][db][4 * g4 + 3] * rn * sg.w);
        *(u64*)(dst + 32 * db + 8 * g4) = (u64)w0 | ((u64)w1 << 32); }
}
__device__ __forceinline__ void U_win(KP p_, int bg_, int c_) {
    const KP p = uni_kp(p_); const int bg = __builtin_amdgcn_readfirstlane(bg_), cc = __builtin_amdgcn_readfirstlane(c_);
    int tid_ = threadIdx.x; asm volatile("" : "+v"(tid_));
    const int tid = tid_, lane = tid & 63, wave = __builtin_amdgcn_readfirstlane(tid >> 6), r = lane & 31, h = lane >> 5;
    unsigned char* ws = p->ws; asm volatile("" : "+s"(ws)); LAS unsigned char* L = (LAS unsigned char*)lds_raw;
    const int b = bg >> 1, g = bg & 1, hd = g * 4 + (wave >> 1), tw0 = 64 * cc + 32 * (wave & 1), t_lane = tw0 + r;
    const bf16* q = (const bf16*)(ws + WS_QN) + ((size_t)(b * 8 + hd) * T_ + t_lane) * 64 + 8 * h;
    bf16x8v Qf[1][4];
#pragma unroll
    for (int s = 0; s < 4; ++s) Qf[0][s] = *(const bf16x8v*)(q + 16 * s);
    f32x16 O[1][2]; float M[1] = {0.f}, Ls[1] = {0.f};
#pragma unroll
    for (int i = 0; i < 16; ++i) { O[0][0][i] = 0.f; O[0][1][i] = 0.f; }
    const int jlo = cc > 8 ? cc - 8 : 0;
    const u64 hi = (cc == 63) ? ~0ull : ((1ull << (cc + 1)) - 1ull), tm = hi & ~((1ull << jlo) - 1ull);
#if AC2_MODE == 0
    attn_core<64, 1, false, false>(L, (const bf16*)(ws + WS_KV6 + 4 * KV6_STRIDE) + (size_t)bg * T_ * 64, nullptr, (const bf16*)(ws + WS_KV6 + 5 * KV6_STRIDE) + (size_t)bg * T_ * 64, nullptr, 0.f,
                                   Qf, tm, t_lane, tw0, 512, alibi_slope(hd + 1, 8) * LOG2E, 0u, 0u, O, M, Ls, tid);
#else
    attn_core2<false, false>(L, (const bf16*)(ws + WS_KV6 + 4 * KV6_STRIDE) + (size_t)bg * T_ * 64, (const bf16*)(ws + WS_KV6 + 5 * KV6_STRIDE) + (size_t)bg * T_ * 64, nullptr, 0.f,
                             Qf[0], tm, t_lane, tw0, 512, alibi_slope(hd + 1, 8) * LOG2E, 0u, 0u, O[0], M[0], Ls[0], tid);
#endif
    const size_t n = (size_t)b * T_ + t_lane;
    const float lt = swap_sum(Ls[0]), inv = (lt > 0.f ? 1.f / lt : 0.f) * ((const float*)(ws + WS_GATE))[n * 24 + hd * 3 + 2];
    bf16* dst = (bf16*)(ws + WS_OWIN) + n * 512 + hd * 64 + 4 * h;
    ATTN_FOR_CHUNKS(db, g4) { const unsigned w0 = cvtpk(O[0][db][4 * g4 + 0] * inv, O[0][db][4 * g4 + 1] * inv), w1 = cvtpk(O[0][db][4 * g4 + 2] * inv, O[0][db][4 * g4 + 3] * inv);
        *(u64*)(dst + 32 * db + 8 * g4) = (u64)w0 | ((u64)w1 << 32); }
}
__device__ __forceinline__ void U_slc(KP p_, int bg_, int c_) {
    const KP p = uni_kp(p_); const int bg = __builtin_amdgcn_readfirstlane(bg_), cc = __builtin_amdgcn_readfirstlane(c_);
    int tid_ = threadIdx.x; asm volatile("" : "+v"(tid_));
    const int tid = tid_, lane = tid & 63, wave = __builtin_amdgcn_readfirstlane(tid >> 6), r = lane & 31, h = lane >> 5;
    unsigned char* ws = p->ws; asm volatile("" : "+s"(ws)); LAS unsigned char* L = (LAS unsigned char*)lds_raw;
    const int b = bg >> 1, g = bg & 1, hd = g * 4 + (wave >> 1), tw0 = 64 * cc + 32 * (wave & 1), t_lane = tw0 + r;
    const bf16* q = (const bf16*)(ws + WS_QN) + ((size_t)(b * 8 + hd) * T_ + t_lane) * 64 + 8 * h;
    bf16x8v Qf[1][4];
#pragma unroll
    for (int s = 0; s < 4; ++s) Qf[0][s] = *(const bf16x8v*)(q + 16 * s);
    f32x16 O[1][2]; float M[1] = {0.f}, Ls[1] = {0.f};
#pragma unroll
    for (int i = 0; i < 16; ++i) { O[0][0][i] = 0.f; O[0][1][i] = 0.f; }
    const u64* sel = (const u64*)(ws + WS_SEL) + (size_t)bg * T_;
    const u64 mine = sel[t_lane]; u64 un = sel[64 * cc + lane];
    { unsigned ul = (unsigned)un, uh = (unsigned)(un >> 32);
#pragma unroll
      for (int o = 1; o < 64; o <<= 1) { ul |= shflx_u(ul, o, lane); uh |= shflx_u(uh, o, lane); }
      un = ((u64)__builtin_amdgcn_readfirstlane(uh) << 32) | __builtin_amdgcn_readfirstlane(ul); }
#if AC2_MODE == 0
    attn_core<64, 1, false, true>(L, (const bf16*)(ws + WS_KV6 + 2 * KV6_STRIDE) + (size_t)bg * T_ * 64, nullptr, (const bf16*)(ws + WS_KV6 + 3 * KV6_STRIDE) + (size_t)bg * T_ * 64, nullptr, 0.f,
                                  Qf, un, t_lane, tw0, 1 << 30, alibi_slope(hd + 1, 8) * LOG2E, (unsigned)mine, (unsigned)(mine >> 32), O, M, Ls, tid);
#else
    attn_core2<false, true>(L, (const bf16*)(ws + WS_KV6 + 2 * KV6_STRIDE) + (size_t)bg * T_ * 64, (const bf16*)(ws + WS_KV6 + 3 * KV6_STRIDE) + (size_t)bg * T_ * 64, nullptr, 0.f,
                            Qf[0], un, t_lane, tw0, 1 << 30, alibi_slope(hd + 1, 8) * LOG2E, (unsigned)mine, (unsigned)(mine >> 32), O[0], M[0], Ls[0], tid);
#endif
    const size_t n = (size_t)b * T_ + t_lane;
    const float lt = swap_sum(Ls[0]), inv = (lt > 0.f ? 1.f / lt : 0.f) * ((const float*)(ws + WS_GATE))[n * 24 + hd * 3 + 1];
    const bf16* oc = (const bf16*)(ws + WS_OCMP) + n * 512 + hd * 64 + 4 * h; const bf16* ow = (const bf16*)(ws + WS_OWIN) + n * 512 + hd * 64 + 4 * h;
    bf16* dst = (bf16*)(ws + WS_ATT) + n * 1024 + hd * 64 + 4 * h;
    ATTN_FOR_CHUNKS(db, g4) { const u64 a = *(const u64*)(oc + 32 * db + 8 * g4), w = *(const u64*)(ow + 32 * db + 8 * g4);
        const float x0 = O[0][db][4 * g4 + 0] * inv + __uint_as_float((unsigned)a << 16) + __uint_as_float((unsigned)w << 16);
        const float x1 = O[0][db][4 * g4 + 1] * inv + __uint_as_float((unsigned)a & 0xffff0000u) + __uint_as_float((unsigned)w & 0xffff0000u);
        const float x2 = O[0][db][4 * g4 + 2] * inv + __uint_as_float((unsigned)(a >> 32) << 16) + __uint_as_float((unsigned)(w >> 32) << 16);
        const float x3 = O[0][db][4 * g4 + 3] * inv + __uint_as_float((unsigned)(a >> 32) & 0xffff0000u) + __uint_as_float((unsigned)(w >> 32) & 0xffff0000u);
        *(u64*)(dst + 32 * db + 8 * g4) = (u64)cvtpk(x0, x1) | ((u64)cvtpk(x2, x3) << 32); }
}
__device__ __forceinline__ float other_half(float x, int h) { auto rr = __builtin_amdgcn_permlane32_swap(__float_as_uint(x), __float_as_uint(x), false, false); return __uint_as_float(h ? rr[0] : rr[1]); }
__device__ __forceinline__ int other_half_i(int x, int h) { auto rr = __builtin_amdgcn_permlane32_swap((unsigned)x, (unsigned)x, false, false); return (int)(h ? rr[0] : rr[1]); }
template <bool MASK>
__device__ __forceinline__ void cmp_scores(f32x16& p0, f32x16& p1, const LAS unsigned char* kt, const bf16x8v (&Qf)[4], float b0, float s1, int cl, int nvis_l) {
    const float s8 = s1 * 8.f, s32 = s1 * 32.f;
    p0[0] = b0; p0[1] = p0[0] + s1; p0[2] = p0[1] + s1; p0[3] = p0[2] + s1;
#pragma unroll
    for (int reg = 4; reg < 16; ++reg) p0[reg] = p0[reg - 4] + s8;
#pragma unroll
    for (int reg = 0; reg < 16; ++reg) p1[reg] = p0[reg] + s32;
#pragma unroll
    for (int s = 0; s < 4; ++s) { const bf16x8v kf0 = *(const LAS bf16x8v*)(kt + s * 32), kf1 = *(const LAS bf16x8v*)(kt + 32 * 144 + s * 32);
        p0 = __builtin_amdgcn_mfma_f32_32x32x16_bf16(kf0, Qf[s], p0, 0, 0, 0); p1 = __builtin_amdgcn_mfma_f32_32x32x16_bf16(kf1, Qf[s], p1, 0, 0, 0); }
    if (MASK) {
#pragma unroll
        for (int reg = 0; reg < 16; ++reg) { const int c = cl + crow0(reg); p0[reg] = (c < nvis_l) ? p0[reg] : -INFINITY; p1[reg] = (c + 32 < nvis_l) ? p1[reg] : -INFINITY; } }
}
__device__ __forceinline__ void U_cmp(KP p_, int bg_, int u_) {
    const KP p = uni_kp(p_); const int bg = __builtin_amdgcn_readfirstlane(bg_), uu = __builtin_amdgcn_readfirstlane(u_);
    int tid_ = threadIdx.x; asm volatile("" : "+v"(tid_));
    const int tid = tid_, lane = tid & 63, wave = __builtin_amdgcn_readfirstlane(tid >> 6), r = lane & 31, h = lane >> 5;
    unsigned char* ws = p->ws; asm volatile("" : "+s"(ws)); LAS unsigned char* L = (LAS unsigned char*)lds_raw;
    const int b = bg >> 1, g = bg & 1, tw0 = 32 * (uu + 16 * wave), t_lane = tw0 + r;
    { const bf16* kc = (const bf16*)(ws + WS_KVCMP) + (size_t)bg * 256 * 64; const bf16* vc = kc + 16 * 256 * 64;
#pragma unroll
      for (int i = 0; i < 4; ++i) { const int ch = tid + 512 * i, row = ch >> 3, c8 = ch & 7;
          *(LAS u32x4*)(L + row * 144 + c8 * 16) = *(const u32x4*)(kc + row * 64 + c8 * 8); *(LAS u32x4*)(L + 36864 + row * 144 + c8 * 16) = *(const u32x4*)(vc + row * 64 + c8 * 8); } }
    __syncthreads();
    const int nvis_l = t_lane >= 31 ? ((t_lane - 31) >> 4) + 1 : 0, nvis_max = (tw0 >> 4) + 1, nvis_min = tw0 >= 31 ? ((tw0 - 31) >> 4) + 1 : 0, ntile = (nvis_max + 63) >> 6;
    const LAS unsigned char* kfrag = L + r * 144 + h * 16;
    const LAS unsigned char* vfrag = L + 36864 + (4 * h + ((lane & 15) >> 2)) * 144 + (16 * ((lane >> 4) & 1) + 4 * (lane & 3)) * 2;
    float imp[32];
#pragma unroll
    for (int e = 0; e < 32; ++e) imp[e] = 0.f;
    const float* gate = (const float*)(ws + WS_GATE) + ((size_t)b * T_ + t_lane) * 24;
#pragma unroll 1
    for (int hg = 0; hg < 4; ++hg) {
        const int hd = g * 4 + hg; const float s1 = alibi_slope(hd + 1, 8) * LOG2E * 16.f;
        const bf16* q = (const bf16*)(ws + WS_QN) + ((size_t)(b * 8 + hd) * T_ + t_lane) * 64 + 8 * h;
        bf16x8v Qf[4];
#pragma unroll
        for (int s = 0; s < 4; ++s) Qf[s] = *(const bf16x8v*)(q + 16 * s);
        float m = -1e30f, lsum = 0.f;
#pragma unroll 1
        for (int jt = 0; jt < ntile; ++jt) {
            f32x16 p0, p1; const float b0 = s1 * (float)(64 * jt + 4 * h - nvis_max);
            if (64 * jt + 63 >= nvis_min) cmp_scores<true>(p0, p1, kfrag + jt * (64 * 144), Qf, b0, s1, 64 * jt + 4 * h, nvis_l);
            else cmp_scores<false>(p0, p1, kfrag + jt * (64 * 144), Qf, b0, s1, 64 * jt + 4 * h, nvis_l);
            float mt = fmaxf(p0[0], p1[0]);
#pragma unroll
            for (int reg = 1; reg < 16; ++reg) mt = fmaxf(mt, fmaxf(p0[reg], p1[reg]));
            mt = swap_max(mt);
            const float mn = fmaxf(m, mt); float rs = 0.f;
#pragma unroll
            for (int reg = 0; reg < 16; ++reg) rs += __builtin_amdgcn_exp2f(p0[reg] - mn) + __builtin_amdgcn_exp2f(p1[reg] - mn);
            lsum = lsum * __builtin_amdgcn_exp2f(m - mn) + rs; m = mn;
        }
        const float lt = swap_sum(lsum), inv = lt > 0.f ? 1.f / lt : 0.f;
        f32x16 O0, O1;
#pragma unroll
        for (int i = 0; i < 16; ++i) { O0[i] = 0.f; O1[i] = 0.f; }
        float carry = 0.f;
#pragma unroll
        for (int jt = 0; jt < 4; ++jt) if (jt < ntile) {
            f32x16 p0, p1; const float b0 = s1 * (float)(64 * jt + 4 * h - nvis_max);
            if (64 * jt + 63 >= nvis_min) cmp_scores<true>(p0, p1, kfrag + jt * (64 * 144), Qf, b0, s1, 64 * jt + 4 * h, nvis_l);
            else cmp_scores<false>(p0, p1, kfrag + jt * (64 * 144), Qf, b0, s1, 64 * jt + 4 * h, nvis_l);
#pragma unroll
            for (int reg = 0; reg < 16; ++reg) { p0[reg] = __builtin_amdgcn_exp2f(p0[reg] - m) * inv; p1[reg] = __builtin_amdgcn_exp2f(p1[reg] - m) * inv; }
            float cv[8];
#pragma unroll
            for (int g4 = 0; g4 < 4; ++g4) { const float h0 = 0.5f * p0[4 * g4 + 3], h1 = 0.5f * p1[4 * g4 + 3];
                imp[jt * 8 + g4] += ((p0[4 * g4] + p0[4 * g4 + 1]) + p0[4 * g4 + 2]) + h0; imp[jt * 8 + 4 + g4] += ((p1[4 * g4] + p1[4 * g4 + 1]) + p1[4 * g4 + 2]) + h1;
                cv[g4] = h0; cv[4 + g4] = h1; }
            float prev = carry;
#pragma unroll
            for (int k = 0; k < 8; ++k) { const float sv = other_half(cv[k], h); imp[jt * 8 + k] += h ? sv : prev; prev = sv; }
            carry = prev;
            const bf16x8v pa0 = pack8(p0, 0), pa1 = pack8(p0, 8), pa2 = pack8(p1, 0), pa3 = pack8(p1, 8);
            const LAS unsigned char* vb = vfrag + jt * (64 * 144);
#pragma unroll
            for (int ks = 0; ks < 4; ++ks) { const bf16x8v pa = ks == 0 ? pa0 : ks == 1 ? pa1 : ks == 2 ? pa2 : pa3;
                { const s16x4 lo = tr_read(vb + ks * (16 * 144)), hi = tr_read(vb + ks * (16 * 144) + 8 * 144); const bf16x8v vf = {lo[0], lo[1], lo[2], lo[3], hi[0], hi[1], hi[2], hi[3]};
                  O0 = __builtin_amdgcn_mfma_f32_32x32x16_bf16(vf, pa, O0, 0, 0, 0); }
                { const s16x4 lo = tr_read(vb + ks * (16 * 144) + 64), hi = tr_read(vb + ks * (16 * 144) + 64 + 8 * 144); const bf16x8v vf = {lo[0], lo[1], lo[2], lo[3], hi[0], hi[1], hi[2], hi[3]};
                  O1 = __builtin_amdgcn_mfma_f32_32x32x16_bf16(vf, pa, O1, 0, 0, 0); } }
        }
        const float gt = gate[hd * 3 + 0];
        bf16* dst = (bf16*)(ws + WS_OCMP) + ((size_t)b * T_ + t_lane) * 512 + hd * 64 + 4 * h;
#pragma unroll
        for (int g4 = 0; g4 < 4; ++g4) {
            *(u64*)(dst + 8 * g4) = (u64)cvtpk(O0[4 * g4 + 0] * gt, O0[4 * g4 + 1] * gt) | ((u64)cvtpk(O0[4 * g4 + 2] * gt, O0[4 * g4 + 3] * gt) << 32);
            *(u64*)(dst + 32 + 8 * g4) = (u64)cvtpk(O1[4 * g4 + 0] * gt, O1[4 * g4 + 1] * gt) | ((u64)cvtpk(O1[4 * g4 + 2] * gt, O1[4 * g4 + 3] * gt) << 32); }
    }
    const int cur = tw0 >> 6; u64 mask;
    if (cur <= 15) mask = (1ull << (cur + 1)) - 1ull;
    else {
        mask = 1ull | (1ull << cur) | (1ull << (cur - 1));
#pragma unroll
        for (int e = 0; e < 32; ++e) { const int j = 2 * e + h; if (j > cur || j == 0 || j >= cur - 1) imp[e] = -INFINITY; }
#pragma unroll 1
        for (int round = 0; round < 13; ++round) {
            float bv = imp[0]; int be = 0;
#pragma unroll
            for (int e = 1; e < 32; ++e) if (imp[e] > bv) { bv = imp[e]; be = e; }
            const int bj = 2 * be + h; const float ov = other_half(bv, h); const int oj = other_half_i(bj, h);
            const bool mine = bv > ov || (bv == ov && bj < oj);
            mask |= 1ull << (mine ? bj : oj);
#pragma unroll
            for (int e = 0; e < 32; ++e) imp[e] = (mine && e == be) ? -INFINITY : imp[e];
        }
    }
    if (h == 0) ((u64*)(ws + WS_SEL))[(size_t)bg * T_ + t_lane] = mask;
    __syncthreads();
}
__device__ __forceinline__ int fetch_unit(KP p, int qidx) {
    volatile LAS unsigned* slot = (volatile LAS unsigned*)((LAS unsigned char*)lds_raw + MISC_OFF) + 16;
    __syncthreads();
    int t0_ = threadIdx.x; asm volatile("" : "+v"(t0_));
    if (t0_ == 0) *slot = __hip_atomic_fetch_add((unsigned*)(p->ws + WS_CTL) + CW_QUEUE + 64 * qidx, 1u, __ATOMIC_RELAXED, __HIP_MEMORY_SCOPE_AGENT);
    __syncthreads();
    return (int)__builtin_amdgcn_readfirstlane(*slot);
}
__device__ __forceinline__ void P_cmp1_mfma(int l_) { const KP p = (KP)__builtin_amdgcn_kernarg_segment_ptr(); int l = l_; asm volatile("" : "+s"(l));
    unsigned char* ws = p->ws; asm volatile("" : "+s"(ws)); const int c = launder_s((int)blockIdx.x), kv = c >> 4, pm = c & 15;
    OneUnitOrder S; S.has = c < 32; S.u.pm = pm; S.u.pn = kv;
    S.u.a = (const char*)(ws + WS_KV6 + (size_t)kv * KV6_STRIDE) + (size_t)pm * 256 * 1024 * 2; S.u.b = (const char*)((const bf16*)(ws + WS_W1_T) + ((size_t)l * 2 + kv) * 256 * 2048); S.u.b2 = S.u.b;
    const pg8::Gemm g{1024, 2048, 2048, 32};
    const EpiCmpH E{(bf16*)(ws + WS_HC), (const float*)(ws + WS_BIAS1) + l * 512};
    pg8::gemm_phase<EpiCmpH, OneUnitOrder, false, true>((LAS unsigned char*)lds_raw, g, S, E);
}
__device__ __forceinline__ void P_cmp2_mfma(int l_) { const KP p = (KP)__builtin_amdgcn_kernarg_segment_ptr(); int l = l_; asm volatile("" : "+s"(l));
    unsigned char* ws = p->ws; asm volatile("" : "+s"(ws)); const int c = launder_s((int)blockIdx.x), kv = c >> 4, pm = c & 15;
    OneUnitOrder S; S.has = c < 32; S.u.pm = pm; S.u.pn = kv;
    S.u.a = (const char*)((const bf16*)(ws + WS_HC) + ((size_t)kv * 4096 + pm * 256) * 256); S.u.b = (const char*)((const bf16*)(ws + WS_W2_T) + ((size_t)l * 2 + kv) * 64 * 256); S.u.b2 = S.u.b;
    const pg8::Gemm g{256, 256, 256, 4};
    const EpiCmpOut E{(bf16*)(ws + WS_KVCMP)};
    pg8::gemm_phase<EpiCmpOut, OneUnitOrder, false, true>((LAS unsigned char*)lds_raw, g, S, E);
}
__device__ __forceinline__ void P_moe_scatter(KP p_, int l_) { const KP p = uni_kp(p_); const int l = __builtin_amdgcn_readfirstlane(l_); const Ctx c = make_ctx(p); unsigned char* ws = p->ws;
    const unsigned* cnt = (const unsigned*)(ws + WS_CTL) + CW_MOECNT + l * 128;
    moe_build_tables(cnt, c.tid);
    const LAS int* T = (const LAS int*)((LAS unsigned char*)lds_raw + TBL_OFF);
    const unsigned* info = (const unsigned*)(ws + WS_ROUTE + RT_INFO); const float* tw = (const float*)(ws + WS_ROUTE + RT_W);
    int* rowtok = (int*)(ws + WS_ROUTE + RT_ROWTOK); float* roww = (float*)(ws + WS_ROUTE + RT_ROWW);
    bf16* xs = (bf16*)(ws + WS_XS); const bf16* x = (const bf16*)(ws + WS_HN); const float* gain = p->in[14] + (size_t)l * D_; const float* rstdv = (const float*)(ws + WS_ROUTE + RT_RSTD);
    { constexpr int RB = 4; float gg[2][8];
#pragma unroll
      for (int j = 0; j < 2; ++j) { const f32x4 a = ((const f32x4*)gain)[2 * c.lane + 128 * j], b2 = ((const f32x4*)gain)[2 * c.lane + 128 * j + 1]; gg[j][0] = a.x; gg[j][1] = a.y; gg[j][2] = a.z; gg[j][3] = a.w; gg[j][4] = b2.x; gg[j][5] = b2.y; gg[j][6] = b2.z; gg[j][7] = b2.w; }
      for (int row0 = c.gw * RB; row0 < NT; row0 += c.ngw * RB) {
        u32x4 vv[RB][2];
#pragma unroll
        for (int q = 0; q < RB; ++q)
#pragma unroll
            for (int j = 0; j < 2; ++j) vv[q][j] = ((const u32x4*)(x + (size_t)(row0 + q) * D_))[c.lane + 64 * j];
#pragma unroll
        for (int q = 0; q < RB; ++q) { const int row = row0 + q;
            const unsigned v = info[row]; const int cls = (int)(v >> 24), rank = (int)(v & 0xffffffu); const size_t dest = (size_t)T[cls] * 256 + rank; const float r = rstdv[row];
#pragma unroll
            for (int j = 0; j < 2; ++j) { float f[8]; unpack8(vv[q][j], f); u32x4 o; o.x = pk2(f[0] * r * gg[j][0], f[1] * r * gg[j][1]); o.y = pk2(f[2] * r * gg[j][2], f[3] * r * gg[j][3]); o.z = pk2(f[4] * r * gg[j][4], f[5] * r * gg[j][5]); o.w = pk2(f[6] * r * gg[j][6], f[7] * r * gg[j][7]);
                ((u32x4*)(xs + dest * D_))[c.lane + 64 * j] = o; }
            if (c.lane == 0) { rowtok[dest] = row; roww[2 * dest] = tw[2 * row]; roww[2 * dest + 1] = tw[2 * row + 1]; } }
      } }
    for (int cls = c.bid; cls < 112; cls += c.G) { const int n = (int)cnt[cls], end = (int)((cnt[cls] + 255u) >> 8) * 256; const size_t base = (size_t)T[cls] * 256;
        for (int r = n + c.tid; r < end; r += NTHREADS) rowtok[base + r] = -1; }
}
__device__ __forceinline__ void P_moe_g1(int l_) { const KP p = (KP)__builtin_amdgcn_kernarg_segment_ptr(); int l = l_; asm volatile("" : "+s"(l));
    unsigned char* ws = p->ws; asm volatile("" : "+s"(ws));
    { int t0_ = threadIdx.x; asm volatile("" : "+v"(t0_)); moe_build_tables((const unsigned*)(ws + WS_CTL) + CW_MOECNT + l * 128, t0_); }
    const MoeOrder1 S{(const char*)(ws + WS_XS), (const char*)((const bf16*)(ws + WS_WGU_T) + (size_t)l * NEXP * 512 * D_), (int)gridDim.x, launder_s((int)blockIdx.x)};
    const pg8::Gemm g{D_, D_, D_, D_ / 64};
    const EpiMoeH E{(bf16*)(ws + WS_HB), (const float*)(ws + WS_ROUTE + RT_ROWW)};
    pg8::gemm_phase<EpiMoeH, MoeOrder1, true, true>((LAS unsigned char*)lds_raw, g, S, E);
}
__device__ __forceinline__ void P_moe_g2(int l_) { const KP p = (KP)__builtin_amdgcn_kernarg_segment_ptr(); int l = l_; asm volatile("" : "+s"(l));
    unsigned char* ws = p->ws; asm volatile("" : "+s"(ws));
    { int t0_ = threadIdx.x; asm volatile("" : "+v"(t0_)); moe_build_tables((const unsigned*)(ws + WS_CTL) + CW_MOECNT + l * 128, t0_); }
    const MoeOrder2 S{(const char*)(ws + WS_HB), (const char*)((const bf16*)(ws + WS_WD_T) + (size_t)l * NEXP * D_ * DEXP), (int)gridDim.x, launder_s((int)blockIdx.x)};
    const pg8::Gemm g{512, DEXP, 512, 4};
    const EpiMoeOut E{(bf16*)(ws + WS_HN), (const int*)(ws + WS_ROUTE + RT_ROWTOK)};
    pg8::gemm_phase<EpiMoeOut, MoeOrder2, true, true>((LAS unsigned char*)lds_raw, g, S, E);
}
__device__ __forceinline__ void P_norm1(KP p_, int l_) { const KP p = uni_kp(p_); const int l = __builtin_amdgcn_readfirstlane(l_); const Ctx c = make_ctx(p); const Bufs b = make_bufs(p->ws);
    if (l == 0) { const int i = c.bid * NTHREADS + c.tid; if (i < L_ * 2 * 256) { const float* part = (const float*)(p->ws + WS_B1PART) + (size_t)(i >> 8) * 128 * 256 + (i & 255); float a = 0.f;
        for (int k = 0; k < 128; ++k) a += part[(size_t)k * 256]; ((float*)(p->ws + WS_BIAS1))[i] = a; } }
    if (l == 0) ph_norm_bf16(c, p->in[0], p->in[1], (bf16*)p->out, (bf16*)(p->ws + WS_HN)); else ph_norm_bf16_from_bf16(c, (const bf16*)(p->ws + WS_HN), p->in[1] + (size_t)l * D_, (bf16*)p->out); }
__device__ __noinline__ void P_inproj(KP p_, int l_) { const KP p = uni_kp(p_); const int l = __builtin_amdgcn_readfirstlane(l_); const Ctx c = make_ctx(p); const Bufs b = make_bufs(p->ws);
    InProjOut o{b.QN, b.KV6, b.FQ, b.DQ, b.DV, b.GATE, b.FL, p->in[3] + l * 24, p->in[4] + l * 4};
    const bf16* A = b.HN;
    naive_gemm(c, NT, D_IN, D_, [=](int r, int k) { return bf2f(A[(size_t)r * D_ + k]); }, p->in[2] + (size_t)l * D_ * D_IN, D_IN,
               [=](int r, int col, float v) { inproj_store(o, r, col, v); }); }
__device__ __noinline__ void P_cmp1(KP p_, int l_, int kv_) { const KP p = uni_kp(p_); const int l = __builtin_amdgcn_readfirstlane(l_), kv = __builtin_amdgcn_readfirstlane(kv_); const Ctx c = make_ctx(p); const Bufs b = make_bufs(p->ws);
    const bf16* src = kv == 0 ? b.KC : b.VC; const float* pe = p->in[kv == 0 ? 5 : 8] + (size_t)l * 2048; bf16* hc = b.HC + (size_t)kv * 4096 * 256;
    naive_gemm(c, 4096, 256, 2048, [=](int r, int k) { return bf2f(src[(size_t)r * 1024 + k]) + pe[k]; }, p->in[kv == 0 ? 6 : 9] + (size_t)l * 2048 * 256, 256,
               [=](int r, int col, float v) { hc[(size_t)r * 256 + col] = (bf16)f2bf(gelu_tanh(v)); }); }
__device__ __noinline__ void P_cumsum(KP p_, int l_) { const KP p = uni_kp(p_); const int l = __builtin_amdgcn_readfirstlane(l_); const Ctx c = make_ctx(p); const Bufs b = make_bufs(p->ws); ph_cumsum(c, b.FL); }
__device__ __noinline__ void P_cmp2(KP p_, int l_, int kv_) { const KP p = uni_kp(p_); const int l = __builtin_amdgcn_readfirstlane(l_), kv = __builtin_amdgcn_readfirstlane(kv_); const Ctx c = make_ctx(p); const Bufs b = make_bufs(p->ws);
    const bf16* hc = b.HC + (size_t)kv * 4096 * 256; bf16* dst = kv == 0 ? b.KCMP : b.VCMP;
    naive_gemm(c, 4096, 64, 256, [=](int r, int k) { return bf2f(hc[(size_t)r * 256 + k]); }, p->in[kv == 0 ? 7 : 10] + (size_t)l * 256 * 64, 64,
               [=](int r, int col, float v) { dst[(size_t)r * 64 + col] = (bf16)f2bf((r & 255) == 255 ? 0.f : v); }); }
__device__ __noinline__ void P_win(KP p_, int l_) { const KP p = uni_kp(p_); const int l = __builtin_amdgcn_readfirstlane(l_); const Ctx c = make_ctx(p); const Bufs b = make_bufs(p->ws); ph_win_attn(c, b.QN, b.KW, b.VW, b.GATE, b.OWIN); }
__device__ __noinline__ void P_fox(KP p_, int l_) { const KP p = uni_kp(p_); const int l = __builtin_amdgcn_readfirstlane(l_); const Ctx c = make_ctx(p); const Bufs b = make_bufs(p->ws); ph_fox_attn(c, b.FQ, b.FK, b.FV, b.FL, b.ATT); }
__device__ __noinline__ void P_diff(KP p_, int l_) { const KP p = uni_kp(p_); const int l = __builtin_amdgcn_readfirstlane(l_); const Ctx c = make_ctx(p); const Bufs b = make_bufs(p->ws);
    ph_diff_attn(c, b.DQ, b.DK, b.DV, p->in[11] + (size_t)l * 128, p->in[12] + (size_t)l * 64, lambda_init_of(l), b.ATT); }
__device__ __noinline__ void P_cmpattn(KP p_, int l_) { const KP p = uni_kp(p_); const int l = __builtin_amdgcn_readfirstlane(l_); const Ctx c = make_ctx(p); const Bufs b = make_bufs(p->ws); ph_cmp_attn(c, b.QN, b.KCMP, b.VCMP, b.GATE, b.SEL, b.OCMP); }
__device__ __noinline__ void P_slc(KP p_, int l_) { const KP p = uni_kp(p_); const int l = __builtin_amdgcn_readfirstlane(l_); const Ctx c = make_ctx(p); const Bufs b = make_bufs(p->ws); ph_slc_attn(c, b.QN, b.KS, b.VS, b.GATE, b.SEL, b.OCMP, b.OWIN, b.ATT); }
__device__ __noinline__ void P_outproj(KP p_, int l_) { const KP p = uni_kp(p_); const int l = __builtin_amdgcn_readfirstlane(l_); const Ctx c = make_ctx(p); const Bufs b = make_bufs(p->ws);
    const bf16* A = b.ATT; float* xo = p->out; const float* xin = (l == 0) ? p->in[0] : p->out;
    naive_gemm(c, NT, D_, D_, [=](int r, int k) { return bf2f(A[(size_t)r * D_ + k]); }, p->in[13] + (size_t)l * D_ * D_, D_,
               [=](int r, int col, float v) { xo[(size_t)r * D_ + col] = xin[(size_t)r * D_ + col] + v; }); }
__device__ __forceinline__ void P_route3(int l_, int cbank) { const KP p = (KP)__builtin_amdgcn_kernarg_segment_ptr(); int l = l_; asm volatile("" : "+s"(l));
    int tid_ = threadIdx.x; asm volatile("" : "+v"(tid_));
    const int tid = tid_, lane = tid & 63, wave = __builtin_amdgcn_readfirstlane(tid >> 6), r = lane & 31, h = lane >> 5, kh = wave >> 2, wr = wave & 3;
    unsigned char* ws = p->ws; asm volatile("" : "+s"(ws)); const bf16* x = (const bf16*)(ws + WS_HN);
    const float* WR = (const float*)(ws + WS_WR) + (size_t)l * D_ * 64;
    LAS float* XT = (LAS float*)lds_raw + wave * (32 * 36);
    LAS float* WT = (LAS float*)lds_raw + 8 * 32 * 36 + kh * (2 * 32 * 64);
    LAS float* PL = (LAS float*)lds_raw + 8 * 32 * 36 + 2 * 2 * 32 * 64;
    LAS float* SS = PL + 2 * 128 * 40;
    const float* bgrp = p->in[16] + l * 4; const float* bexp = p->in[18] + l * 32;
    unsigned* cnt = (unsigned*)(ws + WS_CTL) + CW_MOECNT + l * 128 + cbank;
    for (int grp = launder_s((int)blockIdx.x); grp < NT / 128; grp += (int)gridDim.x) {
        const int row0 = grp * 128 + wr * 32;
        f32x16 acc0, acc1; float ss = 0.f;
#pragma unroll
        for (int i = 0; i < 16; ++i) { acc0[i] = 0.f; acc1[i] = 0.f; }
        int buf = 0;
        const int xrow = lane >> 1, xpart = lane & 1;
        const u32x4* wsrc = (const u32x4*)(ws + WS_WR) + ((size_t)l * 64 + kh * 32) * 256 + (tid & 255); const bf16* xsrc = x + (size_t)(row0 + xrow) * D_ + kh * 512 + xpart * 16;
        u32x4 wv[2]; u32x4 xa[2], xb2[2];
#pragma unroll
        for (int i = 0; i < 2; ++i) wv[i] = wsrc[256 * i];
#pragma unroll
        for (int j = 0; j < 2; ++j) { xa[j] = *(const u32x4*)(xsrc + 8 * j); xb2[j] = *(const u32x4*)(xsrc + 32 + 8 * j); }
        LAS u32x4* WTq = (LAS u32x4*)WT;
#define RT_CHUNK(KC, XV) do { \
            _Pragma("unroll") for (int i = 0; i < 2; ++i) WTq[buf * 512 + (tid & 255) + 256 * i] = wv[i]; \
            _Pragma("unroll") for (int j = 0; j < 2; ++j) { float f_[8]; unpack8(XV[j], f_); _Pragma("unroll") for (int e = 0; e < 8; ++e) ss = fmaf(f_[e], f_[e], ss); \
                *(LAS f32x4*)(XT + xrow * 36 + xpart * 16 + 8 * j) = (f32x4){f_[0], f_[1], f_[2], f_[3]}; *(LAS f32x4*)(XT + xrow * 36 + xpart * 16 + 8 * j + 4) = (f32x4){f_[4], f_[5], f_[6], f_[7]}; } \
            if ((KC) + 1 < 16) { _Pragma("unroll") for (int i = 0; i < 2; ++i) wv[i] = wsrc[(size_t)((KC) + 1) * 512 + 256 * i]; } \
            if ((KC) + 2 < 16) { _Pragma("unroll") for (int j = 0; j < 2; ++j) XV[j] = *(const u32x4*)(xsrc + ((KC) + 2) * 32 + 8 * j); } \
            __syncthreads(); \
            _Pragma("unroll") for (int sidx = 0; sidx < 2; ++sidx) { \
                const f32x4 t0 = *(const LAS f32x4*)(XT + r * 36 + 16 * sidx + 8 * h), t1 = *(const LAS f32x4*)(XT + r * 36 + 16 * sidx + 8 * h + 4); \
                const float xe[8] = {t0.x, t0.y, t0.z, t0.w, t1.x, t1.y, t1.z, t1.w}; unsigned ah[4]; \
                _Pragma("unroll") for (int jp = 0; jp < 4; ++jp) ah[jp] = cvtpk(xe[2 * jp], xe[2 * jp + 1]);        \
                const bf16x8v Ah = __builtin_bit_cast(bf16x8v, (u32x4){ah[0], ah[1], ah[2], ah[3]}); \
                const LAS u32x4* wb = WTq + buf * 512 + sidx * 256 + lane; \
                const bf16x8v B0h = __builtin_bit_cast(bf16x8v, wb[0]), B0l = __builtin_bit_cast(bf16x8v, wb[64]), B1h = __builtin_bit_cast(bf16x8v, wb[128]), B1l = __builtin_bit_cast(bf16x8v, wb[192]); \
                acc0 = __builtin_amdgcn_mfma_f32_32x32x16_bf16(Ah, B0h, acc0, 0, 0, 0); acc1 = __builtin_amdgcn_mfma_f32_32x32x16_bf16(Ah, B1h, acc1, 0, 0, 0); \
                acc0 = __builtin_amdgcn_mfma_f32_32x32x16_bf16(Ah, B0l, acc0, 0, 0, 0); acc1 = __builtin_amdgcn_mfma_f32_32x32x16_bf16(Ah, B1l, acc1, 0, 0, 0); } \
            buf ^= 1; } while (0)
#pragma unroll 1
        for (int kc = 0; kc < 16; kc += 2) { RT_CHUNK(kc, xa); RT_CHUNK(kc + 1, xb2); }
#undef RT_CHUNK
#pragma unroll
        for (int reg = 0; reg < 16; ++reg) { const int row = wr * 32 + crow0(reg) + 4 * h; PL[(kh * 128 + row) * 40 + r] = acc0[reg]; if (r < 4) PL[(kh * 128 + row) * 40 + 32 + r] = acc1[reg]; }
        SS[(kh * 128 + wr * 32 + (lane >> 1)) * 2 + (lane & 1)] = ss;
        __syncthreads();
        if (tid < 128) {
            float lg[36];
#pragma unroll
            for (int cidx = 0; cidx < 36; ++cidx) lg[cidx] = PL[tid * 40 + cidx] + PL[(128 + tid) * 40 + cidx];
            const float sq = (SS[tid * 2] + SS[tid * 2 + 1]) + (SS[(128 + tid) * 2] + SS[(128 + tid) * 2 + 1]);
            const float rstd = rsqrtf(sq * (1.f / D_) + EPS);
            float gl[4]; int grp_i = 0;
#pragma unroll
            for (int q = 0; q < 4; ++q) gl[q] = lg[q] * rstd + bgrp[q];
            float gm = gl[0];
#pragma unroll
            for (int q = 1; q < 4; ++q) if (gl[q] > gm) { gm = gl[q]; grp_i = q; }
            float gs = 0.f;
#pragma unroll
            for (int q = 0; q < 4; ++q) gs += __expf(gl[q] - gm);
            const float grp_gate = 1.f / gs;
            float el[8];
#pragma unroll
            for (int q = 0; q < 8; ++q) { float v = lg[4 + q]; float bb = bexp[q];
                if (grp_i == 1) { v = lg[12 + q]; bb = bexp[8 + q]; } else if (grp_i == 2) { v = lg[20 + q]; bb = bexp[16 + q]; } else if (grp_i == 3) { v = lg[28 + q]; bb = bexp[24 + q]; }
                el[q] = v * rstd + bb; }
            int i0 = 0; float v0 = el[0];
#pragma unroll
            for (int q = 1; q < 8; ++q) if (el[q] > v0) { v0 = el[q]; i0 = q; }
            int i1 = -1; float v1 = -INFINITY;
#pragma unroll
            for (int q = 0; q < 8; ++q) if (q != i0 && el[q] > v1) { v1 = el[q]; i1 = q; }
            const float e1 = __expf(v1 - v0), den = 1.f + e1, w0 = grp_gate / den, w1 = grp_gate * e1 / den;
            const int lo = i0 < i1 ? i0 : i1, hi = i0 < i1 ? i1 : i0, cls = grp_i * 28 + lo * 8 - (lo * (lo + 1)) / 2 + (hi - lo - 1);
            const unsigned rank = __hip_atomic_fetch_add(cnt + cls, 1u, __ATOMIC_RELAXED, __HIP_MEMORY_SCOPE_AGENT);
            const int row = grp * 128 + tid;
            ((unsigned*)(ws + WS_ROUTE + RT_INFO))[row] = ((unsigned)cls << 24) | rank;
            ((float*)(ws + WS_ROUTE + RT_W))[2 * row] = i0 < i1 ? w0 : w1; ((float*)(ws + WS_ROUTE + RT_W))[2 * row + 1] = i0 < i1 ? w1 : w0;
            ((float*)(ws + WS_ROUTE + RT_RSTD))[row] = rstd;
        }
        __syncthreads();
    }
}
typedef float f32x8 __attribute__((ext_vector_type(8)));
__device__ __forceinline__ void P_route2(int l_, int cbank) { const KP p = (KP)__builtin_amdgcn_kernarg_segment_ptr(); int l = l_; asm volatile("" : "+s"(l));
    int tid_ = threadIdx.x; asm volatile("" : "+v"(tid_));
    const int tid = tid_, lane = tid & 63, wave = __builtin_amdgcn_readfirstlane(tid >> 6);
    unsigned char* ws = p->ws; asm volatile("" : "+s"(ws)); const float* x = p->out;
    const float* WR = (const float*)(ws + WS_WR) + (size_t)l * D_ * 40;
    LAS float* xt = (LAS float*)lds_raw + wave * (64 * 36);
    LAS float* part = (LAS float*)lds_raw;
    const float* bgrp = p->in[16] + l * 4; const float* bexp = p->in[18] + l * 32;
    unsigned* cnt = (unsigned*)(ws + WS_CTL) + CW_MOECNT + l * 128 + cbank;
    for (int grp = launder_s((int)blockIdx.x); grp < NT / 128; grp += (int)gridDim.x) {
        const int row0 = grp * 128 + (wave >> 2) * 64, kq = wave & 3;
        float acc[40]; float ss = 0.f;
#pragma unroll
        for (int cidx = 0; cidx < 40; ++cidx) acc[cidx] = 0.f;
#pragma unroll 1
        for (int kc = 0; kc < 8; ++kc) {
            const int k0 = kq * 256 + kc * 32;
#pragma unroll
            for (int i = 0; i < 8; ++i) { const int row = i * 8 + (lane >> 3), c4 = (lane & 7) * 4; *(LAS f32x4*)(xt + row * 36 + c4) = *(const f32x4*)(x + (size_t)(row0 + row) * D_ + k0 + c4); }
            float xr[32];
#pragma unroll
            for (int j = 0; j < 8; ++j) { const f32x4 t = *(const LAS f32x4*)(xt + lane * 36 + 4 * j); xr[4 * j] = t.x; xr[4 * j + 1] = t.y; xr[4 * j + 2] = t.z; xr[4 * j + 3] = t.w; }
            const float* wk = WR + (size_t)k0 * 40;
#pragma unroll
            for (int kk = 0; kk < 32; ++kk) {
                f32x8 w0, w1, w2, w3, w4;
                asm volatile("s_load_dwordx8 %0, %5, %6\n\ts_load_dwordx8 %1, %5, %7\n\ts_load_dwordx8 %2, %5, %8\n\ts_load_dwordx8 %3, %5, %9\n\ts_load_dwordx8 %4, %5, %10\n\ts_waitcnt lgkmcnt(0)"
                             : "=&s"(w0), "=&s"(w1), "=&s"(w2), "=&s"(w3), "=&s"(w4) : "s"(wk), "i"(kk * 160), "i"(kk * 160 + 32), "i"(kk * 160 + 64), "i"(kk * 160 + 96), "i"(kk * 160 + 128) : "memory");
                const float xv = xr[kk]; ss = fmaf(xv, xv, ss);
#pragma unroll
                for (int e = 0; e < 8; ++e) { acc[e] = fmaf(xv, w0[e], acc[e]); acc[8 + e] = fmaf(xv, w1[e], acc[8 + e]); acc[16 + e] = fmaf(xv, w2[e], acc[16 + e]); acc[24 + e] = fmaf(xv, w3[e], acc[24 + e]); }
#pragma unroll
                for (int e = 0; e < 4; ++e) acc[32 + e] = fmaf(xv, w4[e], acc[32 + e]);
            }
        }
        __syncthreads();
#pragma unroll
        for (int cidx = 0; cidx < 36; ++cidx) part[(wave * 64 + lane) * 37 + cidx] = acc[cidx];
        part[(wave * 64 + lane) * 37 + 36] = ss;
        __syncthreads();
        if (tid < 128) {
            const int rg = tid >> 6, rr = tid & 63; float lg[37];
#pragma unroll
            for (int cidx = 0; cidx < 37; ++cidx) lg[cidx] = ((part[((rg * 4 + 0) * 64 + rr) * 37 + cidx] + part[((rg * 4 + 1) * 64 + rr) * 37 + cidx]) + part[((rg * 4 + 2) * 64 + rr) * 37 + cidx]) + part[((rg * 4 + 3) * 64 + rr) * 37 + cidx];
            const float rstd = rsqrtf(lg[36] * (1.f / D_) + EPS);
            float gl[4]; int grp_i = 0;
#pragma unroll
            for (int q = 0; q < 4; ++q) gl[q] = lg[q] * rstd + bgrp[q];
            float gm = gl[0];
#pragma unroll
            for (int q = 1; q < 4; ++q) if (gl[q] > gm) { gm = gl[q]; grp_i = q; }
            float gs = 0.f;
#pragma unroll
            for (int q = 0; q < 4; ++q) gs += __expf(gl[q] - gm);
            const float grp_gate = 1.f / gs;
            float el[8];
#pragma unroll
            for (int q = 0; q < 8; ++q) { float v = lg[4 + q]; float bb = bexp[q];
                if (grp_i == 1) { v = lg[12 + q]; bb = bexp[8 + q]; } else if (grp_i == 2) { v = lg[20 + q]; bb = bexp[16 + q]; } else if (grp_i == 3) { v = lg[28 + q]; bb = bexp[24 + q]; }
                el[q] = v * rstd + bb; }
            int i0 = 0; float v0 = el[0];
#pragma unroll
            for (int q = 1; q < 8; ++q) if (el[q] > v0) { v0 = el[q]; i0 = q; }
            int i1 = -1; float v1 = -INFINITY;
#pragma unroll
            for (int q = 0; q < 8; ++q) if (q != i0 && el[q] > v1) { v1 = el[q]; i1 = q; }
            const float e1 = __expf(v1 - v0), den = 1.f + e1, w0 = grp_gate / den, w1 = grp_gate * e1 / den;
            const int lo = i0 < i1 ? i0 : i1, hi = i0 < i1 ? i1 : i0, cls = grp_i * 28 + lo * 8 - (lo * (lo + 1)) / 2 + (hi - lo - 1);
            const unsigned rank = __hip_atomic_fetch_add(cnt + cls, 1u, __ATOMIC_RELAXED, __HIP_MEMORY_SCOPE_AGENT);
            const int row = grp * 128 + tid;
            ((unsigned*)(ws + WS_ROUTE + RT_INFO))[row] = ((unsigned)cls << 24) | rank;
            ((float*)(ws + WS_ROUTE + RT_W))[2 * row] = i0 < i1 ? w0 : w1; ((float*)(ws + WS_ROUTE + RT_W))[2 * row + 1] = i0 < i1 ? w1 : w0;
            ((float*)(ws + WS_ROUTE + RT_RSTD))[row] = rstd;
        }
        __syncthreads();
    }
}
__device__ __noinline__ void P_route(KP p_, int l_) { const KP p = uni_kp(p_); const int l = __builtin_amdgcn_readfirstlane(l_); const Ctx c = make_ctx(p); const Bufs b = make_bufs(p->ws);
    ph_moe_route(c, p->out, p->in[14] + (size_t)l * D_, p->in[15] + (size_t)l * D_ * 4, p->in[16] + l * 4, p->in[17] + (size_t)l * D_ * 32, p->in[18] + l * 32, b.HN, (int*)(p->ws + WS_ROUTE + RT_INFO), (float*)(p->ws + WS_ROUTE + RT_W), (unsigned*)(p->ws + WS_CTL) + CW_MOECNT + l * 128); }
__device__ __noinline__ void P_moe(KP p_, int l_) { const KP p = uni_kp(p_); const int l = __builtin_amdgcn_readfirstlane(l_); const Ctx c = make_ctx(p); const Bufs b = make_bufs(p->ws);
    ph_moe_naive(c, b.HN, b.ROUTE_E, b.ROUTE_W, p->in[19] + (size_t)l * NEXP * D_ * DEXP, p->in[20] + (size_t)l * NEXP * D_ * DEXP, p->in[21] + (size_t)l * NEXP * DEXP * D_, p->out); }
__device__ __noinline__ void P_final(KP p_) { const KP p = uni_kp(p_); const Ctx c = make_ctx(p); ph_norm_final_from_bf16(c, (const bf16*)(p->ws + WS_HN), p->in[22], p->out); }
__device__ __forceinline__ void P_gridbar(KP p_) { const KP p = uni_kp(p_);
    XcdBarrier bar; bar.bar = (unsigned*)(p->ws + WS_CTL) + 4096; bar.x = xb_xcc_id(); bar.st = (volatile LAS unsigned*)((LAS unsigned char*)lds_raw + MISC_OFF) + 8;
    xcd_barrier(bar);
}

__global__ void __launch_bounds__(NTHREADS, 2) fwd_kernel(Params pp) {
    const KP p = (KP)__builtin_amdgcn_kernarg_segment_ptr();
    { volatile LAS unsigned* MISC = (volatile LAS unsigned*)((LAS unsigned char*)lds_raw + MISC_OFF); if (threadIdx.x < 32) MISC[threadIdx.x] = 0u; }
    __syncthreads();
    const int lo = p->ph_lo, hi = p->ph_hi;
    if (hi - lo > 1) (void)xcd_barrier_post((unsigned*)(p->ws + WS_CTL) + 4096, (volatile LAS unsigned*)((LAS unsigned char*)lds_raw + MISC_OFF) + 8);
#define IN(k) (lo <= (k) && (k) < hi)
#define SEAM(k) do { if (IN(k) && IN((k) + 1)) P_gridbar(p); } while (0)
    if (IN(0)) { for (int rep = 0; rep < REP_PRO; ++rep) { if (rep) P_gridbar(p); P_prologue(p); } }
    SEAM(0);
    for (int l = 0; l < L_; ++l) {
        const int P0 = 1 + l * PH_PER_LAYER;
        if (IN(P0 + 0)) { for (int rep = 0; rep < REP_NORM; ++rep) { if (rep) P_gridbar(p); P_norm1(p, l); } }
        SEAM(P0 + 0);
        if (IN(P0 + 1)) { for (int rep = 0; rep < REP_INPROJ; ++rep) { if (rep) P_gridbar(p); P_inproj_mfma(l); }
#ifdef REP_INDUMMY
            for (int rep = 0; rep < REP_INDUMMY; ++rep) { P_gridbar(p); P_inproj_dummy(l); }
#endif
        }
        SEAM(P0 + 1);
        if (IN(P0 + 3)) {
            P_cmp1_mfma(l);
            if (launder_s((int)blockIdx.x) < 32) { asm volatile("s_waitcnt vmcnt(0)" ::: "memory"); __builtin_amdgcn_fence(__ATOMIC_SEQ_CST, "agent"); asm volatile("s_waitcnt vmcnt(0)" ::: "memory"); }
            __syncthreads();
            P_cmp2_mfma(l);
            for (int rep = 0; rep < REP_ATT3; ++rep) { if (rep) P_gridbar(p);
            for (;;) { const int u = fetch_unit(p, l * 8 + 0 + 16 * rep); if (u >= 2048) break;
                if (u < 1024) { const int qb = 15 - (u >> 6), k = u & 63; if (k < 32) U_diff(p, k, qb, l); else U_fox(p, k - 32, qb, l); }
                else { const int w = u - 1024; U_win(p, w & 15, 63 - (w >> 4)); } } } }
        SEAM(P0 + 3);
        if (IN(P0 + 4)) { for (int rep = 0; rep < REP_CMP; ++rep) { if (rep) P_gridbar(p); for (int u = launder_s((int)blockIdx.x); u < 256; u += (int)gridDim.x) U_cmp(p, u & 15, u >> 4); } }
        SEAM(P0 + 4);
        if (IN(P0 + 5)) { for (int rep = 0; rep < REP_SLC; ++rep) { if (rep) P_gridbar(p); for (;;) { const int u = fetch_unit(p, l * 8 + 1 + 16 * rep); if (u >= 1024) break; U_slc(p, u & 15, 63 - (u >> 4)); } } }
        SEAM(P0 + 5);
        if (IN(P0 + 6)) P_outproj_mfma(l);
        SEAM(P0 + 6);
        if (IN(P0 + 7)) { for (int rep = 0; rep < REP_ROUTE; ++rep) { if (rep) P_gridbar(p); P_route3(l, (REP_ROUTE - 1 - rep) * 256); } }
        SEAM(P0 + 7);
        if (IN(P0 + 8)) { for (int rep = 0; rep < REP_SCAT; ++rep) { if (rep) P_gridbar(p); P_moe_scatter(p, l); } }
        SEAM(P0 + 8);
        if (IN(P0 + 9)) { for (int rep = 0; rep < REP_G1; ++rep) { if (rep) P_gridbar(p); P_moe_g1(l); } }
        SEAM(P0 + 9);
        if (IN(P0 + 10)) P_moe_g2(l);
        SEAM(P0 + 10);
    }
    if (IN(1 + L_ * PH_PER_LAYER)) P_final(p);
#undef IN
#undef SEAM
}

extern "C" void kernel_launch(void* const* d_in, const int* in_sizes, int n_in, void* d_out, int out_size, void* d_ws, size_t ws_size, hipStream_t stream) {
    static int grid = 0;
    if (grid == 0) {
        if (n_in != 23 || out_size != NT * D_ || ws_size < WS_END) { fprintf(stderr, "kernel_launch: unexpected sizes n_in %d out %d ws %zu (need %zu)\n", n_in, out_size, ws_size, (size_t)WS_END); grid = -1; return; }
        int dev = 0, cus = 0, per_cu = 0;
        if (hipGetDevice(&dev) != hipSuccess || hipDeviceGetAttribute(&cus, hipDeviceAttributeMultiprocessorCount, dev) != hipSuccess) { grid = -1; return; }
        if (hipFuncSetAttribute((const void*)fwd_kernel, hipFuncAttributeMaxDynamicSharedMemorySize, LDS_BYTES) != hipSuccess) { fprintf(stderr, "kernel_launch: hipFuncSetAttribute failed\n"); grid = -1; return; }
        if (hipOccupancyMaxActiveBlocksPerMultiprocessor(&per_cu, (const void*)fwd_kernel, NTHREADS, LDS_BYTES) != hipSuccess || per_cu < 1) { fprintf(stderr, "kernel_launch: occupancy query says %d\n", per_cu); }
        (void)hipGetLastError();
        grid = cus;
    }
    if (grid < 0) return;
    (void)hipMemsetAsync((char*)d_ws + WS_CTL, 0, CTL_BYTES, stream);
    Params p{};
    for (int i = 0; i < 23; ++i) p.in[i] = (const float*)d_in[i];
    p.out = (float*)d_out; p.ws = (unsigned char*)d_ws;
#if N_LAUNCH_MODE == 0
    p.ph_lo = 0; p.ph_hi = N_PHASES;
    hipLaunchKernelGGL(fwd_kernel, dim3(grid), dim3(NTHREADS), LDS_BYTES, stream, p);
#else
    for (int k = 0; k < N_PHASES; ++k) { p.ph_lo = k; p.ph_hi = k + 1; hipLaunchKernelGGL(fwd_kernel, dim3(grid), dim3(NTHREADS), LDS_BYTES, stream, p); }
#endif
}
```

```cpp
#include <hip/hip_runtime.h>
#include <cstdio>
#include <cstdint>

#ifndef INPROJ_ALIGN
#define INPROJ_ALIGN true
#endif
#ifndef INPROJ_SP2
#define INPROJ_SP2 true
#endif
#ifndef REP_PRO
#define REP_PRO 1
#endif
#ifndef REP_ROUTE
#define REP_ROUTE 1
#endif
#ifndef REP_NORM
#define REP_NORM 1
#endif
#ifndef REP_INPROJ
#define REP_INPROJ 1
#endif
#ifndef REP_ATT3
#define REP_ATT3 1
#endif
#ifndef REP_CMP
#define REP_CMP 1
#endif
#ifndef REP_SLC
#define REP_SLC 1
#endif
#ifndef REP_SCAT
#define REP_SCAT 1
#endif
#ifndef REP_G1
#define REP_G1 1
#endif
#ifndef N_LAUNCH_MODE
#define N_LAUNCH_MODE 0
#endif

#define LAS __attribute__((address_space(3)))
#define GAS __attribute__((address_space(1)))
typedef unsigned short bf16;
typedef unsigned long long u64;
typedef float f32x4 __attribute__((ext_vector_type(4)));
typedef unsigned u32x4 __attribute__((ext_vector_type(4)));

constexpr int B_ = 8, T_ = 4096, D_ = 1024, NT = B_ * T_, L_ = 2;
constexpr int HD = 64, D_IN = 2844;
constexpr int N_CMP = 255, CMP_HID = 256;
constexpr int NEXP = 32, DEXP = 256;
constexpr float EPS = 1e-6f;
constexpr float LOG2E = 1.4426950408889634f;
constexpr int NWAVES = 8, NTHREADS = 512;

constexpr int C_NSAQ = 0, C_KV6 = 512, C_GATE = 1280, C_FQ = 1304, C_FF = 2072, C_DQ = 2076, C_DV = 2588;

constexpr size_t MiB = 1u << 20;
constexpr size_t WS_CTL = 0, CTL_BYTES = 1 * MiB;
constexpr size_t WS_QN = 1 * MiB;
constexpr size_t WS_KV6 = WS_QN + 32 * MiB;
constexpr size_t KV6_STRIDE = 8 * MiB + 64 * 1024;
constexpr size_t WS_FQKV = WS_KV6 + 6 * KV6_STRIDE;
constexpr size_t WS_DQK = WS_FQKV + 48 * MiB;
constexpr size_t WS_DV = WS_DQK + 32 * MiB;
constexpr size_t WS_GATE = WS_DV + 16 * MiB;
constexpr size_t WS_FL = WS_GATE + 3 * MiB;
constexpr size_t WS_HC = WS_FL + 1 * MiB;
constexpr size_t WS_KVCMP = WS_HC + 4 * MiB;
constexpr size_t WS_SEL = WS_KVCMP + 1 * MiB;
constexpr size_t WS_OCMP = WS_SEL + 1 * MiB;
constexpr size_t WS_OWIN = WS_OCMP + 32 * MiB;
constexpr size_t WS_HN = WS_OWIN + 32 * MiB;
constexpr size_t WS_ATT = WS_HN + 64 * MiB;
constexpr size_t WS_ROUTE = WS_ATT + 64 * MiB;
constexpr size_t WS_WIN_T = WS_ROUTE + 2 * MiB;
constexpr size_t WS_WOUT_T = WS_WIN_T + 12 * MiB;
constexpr size_t WS_WGU_T = WS_WOUT_T + 4 * MiB;
constexpr size_t WS_WD_T = WS_WGU_T + 64 * MiB;
constexpr size_t WS_W1_T = WS_WD_T + 32 * MiB;
constexpr size_t WS_W2_T = WS_W1_T + 4 * MiB;
constexpr size_t WS_BIAS1 = WS_W2_T + 512 * 1024;
constexpr size_t WS_WR = WS_BIAS1 + 512 * 1024;
constexpr size_t WS_B1PART = WS_WR + 512 * 1024;
constexpr size_t WS_END = WS_B1PART + 512 * 1024;
constexpr int MOE_MAXROWS = 61440;
constexpr size_t WS_XS = WS_QN;
constexpr size_t WS_HB = WS_OCMP;
static_assert(WS_XS + (size_t)MOE_MAXROWS * 2048 <= WS_DQK && WS_HB + (size_t)MOE_MAXROWS * 1024 <= WS_HN, "MoE aliases");
constexpr size_t RT_INFO = 0, RT_W = 128 * 1024, RT_ROWTOK = 384 * 1024, RT_ROWW = 640 * 1024, RT_RSTD = 1152 * 1024;
constexpr int CW_QUEUE = 16384, CW_MOECNT = 32768, CW_KN = 49152;
constexpr int TBL_OFF = 131072 + 1024;
constexpr int NIN = 3072;

extern __shared__ __attribute__((aligned(16))) unsigned char lds_raw[];
__device__ __forceinline__ float bf2f(bf16 v) { return __uint_as_float(((unsigned)v) << 16); }
__device__ __forceinline__ unsigned f2bf(float f) { unsigned u = __float_as_uint(f); return (u + 0x7fffu + ((u >> 16) & 1u)) >> 16; }
__device__ __forceinline__ unsigned pk2(float lo, float hi) { return f2bf(lo) | (f2bf(hi) << 16); }
__device__ __forceinline__ float wave_sum(float v) {
#pragma unroll
    for (int o = 1; o < 64; o <<= 1) v += __shfl_xor(v, o);
    return v;
}
__device__ __forceinline__ float wave_max(float v) {
#pragma unroll
    for (int o = 1; o < 64; o <<= 1) v = fmaxf(v, __shfl_xor(v, o));
    return v;
}
__device__ __forceinline__ float shflx_f(float v, int o, int lane) { return __uint_as_float((unsigned)__builtin_amdgcn_ds_bpermute((lane ^ o) << 2, (int)__float_as_uint(v))); }
__device__ __forceinline__ unsigned shflx_u(unsigned v, int o, int lane) { return (unsigned)__builtin_amdgcn_ds_bpermute((lane ^ o) << 2, (int)v); }
__device__ __forceinline__ float wave_sum_l(float v, int lane) {
#pragma unroll
    for (int o = 1; o < 64; o <<= 1) v += shflx_f(v, o, lane);
    return v;
}
__device__ __forceinline__ int launder_s(int v) { asm volatile("" : "+s"(v)); return v; }
__device__ __forceinline__ float sigmoidf_(float x) { return 1.f / (1.f + __expf(-x)); }
__device__ __forceinline__ float log_sigmoidf_(float x) { return x >= 0.f ? -log1pf(__expf(-x)) : x - log1pf(__expf(x)); }
__device__ __forceinline__ float gelu_tanh(float x) { const float u = 0.7978845608028654f * (x + 0.044715f * x * x * x); return 0.5f * x * (1.f + tanhf(u)); }
__device__ __forceinline__ float alibi_slope(int idx1, int n) { return exp2f(-8.0f * (float)idx1 / (float)n); }

__device__ __forceinline__ constexpr int b64_off(int t, int d) { return ((t >> 4) * 2 + (d >> 5)) * 512 + (t & 15) * 32 + (d & 31); }
#define XB_TMO      128
#define XB_XCNT(j)  (256  + 64 * (j))
#define XB_XSUB(j)  (1280 + 64 * (j))
#define XB_XGEN(j)  (2304 + 64 * (j))
#define XB_TOP      3328
#define XB_TOPGEN   3392
#define XCD_BAR_WORDS 3456
#define XB_SPIN_CAP (1u << 25)
__device__ __forceinline__ unsigned xb_ld(unsigned* p)              { return __hip_atomic_load(p, __ATOMIC_RELAXED, __HIP_MEMORY_SCOPE_AGENT); }
__device__ __forceinline__ unsigned xb_add(unsigned* p, unsigned v) { return __hip_atomic_fetch_add(p, v, __ATOMIC_RELAXED, __HIP_MEMORY_SCOPE_AGENT); }
__device__ __forceinline__ unsigned xb_xcc_id() { return (unsigned)__builtin_amdgcn_s_getreg((3 << 11) | 20) & 0xFu; }
#define XB_SPIN(cond, bar) do { unsigned _sp = 0; while (cond) { __builtin_amdgcn_s_sleep(1); \
    if ((++_sp & 255u) == 0u) { if (xb_ld(&(bar)[XB_TMO])) break; if (_sp > XB_SPIN_CAP) { atomicAdd(&(bar)[XB_TMO], 1u); break; } } } } while (0)
struct XcdBarrier { unsigned* bar; unsigned x; volatile LAS unsigned* st; };
__device__ __forceinline__ XcdBarrier xcd_barrier_post(unsigned* bar, volatile LAS unsigned* st) {
    XcdBarrier b; b.bar = bar; b.x = xb_xcc_id(); b.st = st;
    if (threadIdx.x == 0) (void)xb_add(&bar[XB_XCNT(b.x)], 1u);
    return b;
}
__device__ __forceinline__ void xcd_barrier_complete(unsigned* bar, unsigned x, unsigned& nloc, unsigned& nx) {
    const unsigned G = gridDim.x * gridDim.y * gridDim.z;
    unsigned sum, cnt, mine, sp = 0u;
    for (;;) {
        sum = 0u; cnt = 0u; mine = 0u;
#pragma unroll
        for (unsigned j = 0; j < 16; ++j) { const unsigned c = xb_ld(&bar[XB_XCNT(j)]); sum += c; cnt += (c > 0u) ? 1u : 0u; mine = (j == x) ? c : mine; }
        if (sum == G) break;
        __builtin_amdgcn_s_sleep(1);
        if ((++sp & 255u) == 0u) { if (xb_ld(&bar[XB_TMO])) break; if (sp > XB_SPIN_CAP) { atomicAdd(&bar[XB_TMO], 1u); break; } }
    }
    nloc = mine > 0u ? mine : 1u; nx = cnt > 0u ? cnt : 1u;
}
__device__ __forceinline__ void xcd_barrier(const XcdBarrier& b) {
    asm volatile("s_waitcnt vmcnt(0)" ::: "memory");
    __syncthreads();
    if (threadIdx.x == 0) {
        unsigned* bar = b.bar;
        __builtin_amdgcn_s_waitcnt(0);
        unsigned nloc = b.st[0], nx = b.st[1];
        if (nloc == 0u) { xcd_barrier_complete(bar, b.x, nloc, nx); b.st[0] = nloc; b.st[1] = nx; }
        const unsigned old = xb_add(&bar[XB_XSUB(b.x)], 1u);
        const unsigned gen = old / nloc;
        if (old + 1u == (gen + 1u) * nloc) {
            __builtin_amdgcn_fence(__ATOMIC_RELEASE, "agent");
            asm volatile("s_waitcnt vmcnt(0)" ::: "memory");
            const unsigned og = xb_add(&bar[XB_TOP], 1u);
            const unsigned tg = og / nx;
            if (og + 1u == (tg + 1u) * nx) xb_add(&bar[XB_TOPGEN], 1u);
            else XB_SPIN(xb_ld(&bar[XB_TOPGEN]) == tg, bar);
            __builtin_amdgcn_fence(__ATOMIC_ACQUIRE, "agent");
            xb_add(&bar[XB_XGEN(b.x)], 1u);
            asm volatile("s_waitcnt vmcnt(0)" ::: "memory");
        } else {
            XB_SPIN(xb_ld(&bar[XB_XGEN(b.x)]) == gen, bar);
            __builtin_amdgcn_fence(__ATOMIC_ACQUIRE, "agent");
            asm volatile("s_waitcnt vmcnt(0)" ::: "memory");
        }
    }
    __syncthreads();
}

struct Params { const float* in[23]; float* out; unsigned char* ws; int ph_lo, ph_hi; };
constexpr int LDS_BYTES = 147456;
constexpr int MISC_OFF = 131072 + 320;

struct Ctx {
    LAS unsigned char* lds; int tid, lane, wave, bid, G, gw, ngw;
    const float* const* in; float* xcur; unsigned char* ws;
};

namespace pg8 {
#define PG8_LAS __attribute__((address_space(3)))
typedef unsigned short bf16_t;
typedef short bf16x8 __attribute__((ext_vector_type(8)));
typedef float f32x4 __attribute__((ext_vector_type(4)));
typedef unsigned u32x4 __attribute__((ext_vector_type(4)));
constexpr int BM = 256, BK = 64, HALF = 128, HTB = HALF * BK * 2  , STAGE_BYTES = 8 * HTB, NXCD = 8, WGM = 8;

__host__ __device__ __forceinline__ int lds_byte(int r, int c) { const int st = (r >> 4) * 2 + (c >> 5), rr = r & 15, cc = c & 31, ob = rr * 64 + cc * 2; return st * 1024 + (ob ^ (((ob >> 9) & 1) << 5)); }
__host__ __device__ __forceinline__ void stage_rc(int b, int& R, int& C) { const int st = b / 1024, sb = b % 1024, swz = sb ^ (((sb >> 9) & 1) << 5); R = (st >> 1) * 16 + swz / 64; C = (st & 1) * 32 + (swz % 64) / 2; }
__host__ __device__ __forceinline__ int perm32(int rho) { const int n = rho >> 4, i = rho & 15; return 8 * (i >> 2) + 4 * n + (i & 3); }

struct Unit { int pm, pn; const char* a; const char* b; const char* b2; };
struct Gemm { int lda, ldb, K, ksplit; };

__device__ __forceinline__ unsigned cvt_pk_bf16(float lo, float hi) { unsigned r; asm volatile("v_cvt_pk_bf16_f32 %0, %1, %2" : "=v"(r) : "v"(lo), "v"(hi)); return r; }
typedef float f32x2 __attribute__((ext_vector_type(2)));

template <class Epi, class Sched, bool ALIGN_EPI = false, bool SP2 = false>
__device__ __forceinline__ void gemm_phase(PG8_LAS unsigned char* lds, const Gemm g, const Sched& S, const Epi& E) {
    int tid_ = threadIdx.x; asm volatile("" : "+v"(tid_));
    const int tid = tid_, wid = __builtin_amdgcn_readfirstlane(tid >> 6), lane = tid & 63, wr = wid >> 2, wc = wid & 3, fr = lane & 15, fq = lane >> 4;
    const int K = g.K, nt = K / BK, ks = g.ksplit;
    unsigned voffA[2], voffB[2];
#pragma unroll
    for (int i = 0; i < 2; ++i) { int R, C; stage_rc(tid * 16 + i * 8192, R, C); const int Rb = Epi::PERM ? ((R & ~31) + perm32(R & 31)) : R;
        voffA[i] = (unsigned)(R * g.lda + C) * 2u; voffB[i] = (unsigned)(Rb * g.ldb + C) * 2u; }
    const size_t kstep = (size_t)(BK * 2);
    const size_t hsA = (size_t)HALF * g.lda * 2, hsB = (size_t)HALF * g.ldb * 2;
    const unsigned ldsw = (unsigned)wid * 1024u;
    const int aoff = lds_byte(wr * 64 + fr, fq * 8), boff = lds_byte(wc * 32 + fr, fq * 8);
#define PG8_SA(b, h) (((b) * 2 + (h)) * HTB)
#define PG8_SB(b, h) ((4 + (b) * 2 + (h)) * HTB)
#define PG8_STAGE(bufoff, gbase, voff) do { _Pragma("unroll") for (int _i = 0; _i < 2; ++_i) \
        __builtin_amdgcn_global_load_lds((const unsigned*)((const char*)(gbase) + (voff)[_i]), (PG8_LAS unsigned*)(lds + (bufoff) + ldsw + _i * 8192), 16, 0, 0); } while (0)
#define PG8_LDA(dst, b, h) do { _Pragma("unroll") for (int m = 0; m < 4; ++m) _Pragma("unroll") for (int k = 0; k < 2; ++k) dst[m][k] = *(const PG8_LAS bf16x8*)(lds + PG8_SA(b, h) + aoff + m * 2048 + k * 1024); } while (0)
#define PG8_LDB(dst, b, h) do { _Pragma("unroll") for (int n = 0; n < 2; ++n) _Pragma("unroll") for (int k = 0; k < 2; ++k) dst[n][k] = *(const PG8_LAS bf16x8*)(lds + PG8_SB(b, h) + boff + n * 2048 + k * 1024); } while (0)
#define PG8_MMA(ai, bj, At, Bt) do { __builtin_amdgcn_s_setprio(1); _Pragma("unroll") for (int m = 0; m < 4; ++m) _Pragma("unroll") for (int n = 0; n < 2; ++n) _Pragma("unroll") for (int k = 0; k < 2; ++k) \
        acc[ai][bj][m][n] = __builtin_amdgcn_mfma_f32_16x16x32_bf16(Bt[n][k], At[m][k], acc[ai][bj][m][n], 0, 0, 0); __builtin_amdgcn_s_setprio(0); } while (0)
#define PG8_WAIT_V(n) asm volatile("s_waitcnt vmcnt(" #n ")" ::: "memory")
#define PG8_WAIT_L(n) asm volatile("s_waitcnt lgkmcnt(" #n ")" ::: "memory")
#define PG8_BAR __builtin_amdgcn_s_barrier()
#define PG8_SCHED __builtin_amdgcn_sched_barrier(0)
    Unit cur, nxt; int ui = 0;
    if (!S.next(0, cur)) return;
    f32x4 acc[2][2][4][2];
#pragma unroll
    for (int a = 0; a < 2; ++a)
#pragma unroll
        for (int b = 0; b < 2; ++b)
#pragma unroll
            for (int m = 0; m < 4; ++m)
#pragma unroll
                for (int n = 0; n < 2; ++n) acc[a][b][m][n] = (f32x4){0.f, 0.f, 0.f, 0.f};
    bf16x8 At[4][2], B0[2][2], B1[2][2];
    const char* cA = cur.a; const char* cB = cur.b; const char* cB2 = cur.b2;
#define PG8_BK(base, base2, kt) ((kt) < ks ? (base) + (size_t)(kt) * kstep : (base2) + (size_t)((kt) - ks) * kstep)
    S.a_ready(cur);
    if constexpr (SP2) {
        PG8_STAGE(PG8_SB(0, 0), cB, voffB); PG8_STAGE(PG8_SB(0, 1), cB + hsB, voffB); PG8_STAGE(PG8_SA(0, 0), cA, voffA); PG8_STAGE(PG8_SA(0, 1), cA + hsA, voffA);
        if (wr == 1) PG8_BAR;
        PG8_WAIT_V(2); PG8_BAR;
        PG8_STAGE(PG8_SB(1, 0), PG8_BK(cB, cB2, 1), voffB); PG8_STAGE(PG8_SA(1, 0), cA + kstep, voffA); PG8_STAGE(PG8_SB(1, 1), PG8_BK(cB, cB2, 1) + hsB, voffB);
        PG8_WAIT_V(6); PG8_BAR;
    } else {
        PG8_STAGE(PG8_SB(0, 0), cB, voffB); PG8_STAGE(PG8_SA(0, 0), cA, voffA); PG8_STAGE(PG8_SB(0, 1), cB + hsB, voffB); PG8_STAGE(PG8_SA(0, 1), cA + hsA, voffA);
        if (wr == 1) PG8_BAR;
        PG8_WAIT_V(4); PG8_BAR;
        PG8_STAGE(PG8_SB(1, 0), PG8_BK(cB, cB2, 1), voffB); PG8_STAGE(PG8_SA(1, 0), cA + kstep, voffA); PG8_STAGE(PG8_SB(1, 1), PG8_BK(cB, cB2, 1) + hsB, voffB);
        PG8_WAIT_V(6); PG8_BAR;
    }
    for (;;) {
        const bool has_next = S.next(ui + 1, nxt);
        const char* nA = has_next ? nxt.a : cA; const char* nB = has_next ? nxt.b : cB; const char* nB2 = has_next ? nxt.b2 : cB2;
#pragma unroll 1
        for (int t = 0; t < nt; t += 2) {
            const bool last = (t == nt - 2);
            const char* a1 = cA + (size_t)(t + 1) * kstep;
            const char* a2 = last ? nA : cA + (size_t)(t + 2) * kstep; const char* b2 = last ? PG8_BK(nB, nB2, 0) : PG8_BK(cB, cB2, t + 2);
            const char* a3 = a2 + kstep; const char* b3 = last ? PG8_BK(nB, nB2, 1) : PG8_BK(cB, cB2, t + 3);
            if (last && has_next) S.a_ready(nxt);
            if constexpr (SP2) {
            PG8_LDB(B0, 0, 0); PG8_LDB(B1, 0, 1); PG8_SCHED; PG8_LDA(At, 0, 0); PG8_STAGE(PG8_SA(1, 1), a1 + hsA, voffA);
            PG8_WAIT_V(8); PG8_WAIT_L(0); PG8_BAR; PG8_MMA(0, 0, At, B0); PG8_MMA(0, 1, At, B1); PG8_BAR; PG8_SCHED;
            PG8_LDA(At, 0, 1); PG8_STAGE(PG8_SB(0, 0), b2, voffB); PG8_STAGE(PG8_SB(0, 1), b2 + hsB, voffB); PG8_STAGE(PG8_SA(0, 0), a2, voffA);
            PG8_WAIT_V(8); PG8_WAIT_L(0); PG8_BAR; PG8_MMA(1, 0, At, B0); PG8_MMA(1, 1, At, B1); PG8_BAR; PG8_SCHED;
            PG8_LDB(B0, 1, 0); PG8_LDB(B1, 1, 1); PG8_SCHED; PG8_LDA(At, 1, 0); PG8_STAGE(PG8_SA(0, 1), a2 + hsA, voffA);
            PG8_WAIT_V(8); PG8_WAIT_L(0); PG8_BAR; PG8_MMA(0, 0, At, B0); PG8_MMA(0, 1, At, B1); PG8_BAR; PG8_SCHED;
            PG8_LDA(At, 1, 1); PG8_STAGE(PG8_SB(1, 0), b3, voffB); PG8_STAGE(PG8_SB(1, 1), b3 + hsB, voffB); PG8_STAGE(PG8_SA(1, 0), a3, voffA);
            PG8_WAIT_V(8); PG8_WAIT_L(0); PG8_BAR; PG8_MMA(1, 0, At, B0); PG8_MMA(1, 1, At, B1); PG8_BAR; PG8_SCHED;
            } else {
            PG8_LDB(B0, 0, 0); PG8_SCHED; PG8_LDA(At, 0, 0); PG8_STAGE(PG8_SA(1, 1), a1 + hsA, voffA);
            PG8_WAIT_L(8); PG8_BAR; PG8_WAIT_L(0); PG8_MMA(0, 0, At, B0); PG8_BAR; PG8_SCHED;
            PG8_LDB(B1, 0, 1); PG8_STAGE(PG8_SB(0, 0), b2, voffB);
            PG8_BAR; PG8_WAIT_L(0); PG8_MMA(0, 1, At, B1); PG8_BAR;
            PG8_LDA(At, 0, 1); PG8_STAGE(PG8_SA(0, 0), a2, voffA);
            PG8_BAR; PG8_WAIT_L(0); PG8_MMA(1, 0, At, B0); PG8_BAR; PG8_SCHED;
            PG8_STAGE(PG8_SB(0, 1), b2 + hsB, voffB);
            PG8_WAIT_V(6); PG8_BAR; PG8_MMA(1, 1, At, B1); PG8_BAR;
            PG8_LDB(B0, 1, 0); PG8_SCHED; PG8_LDA(At, 1, 0); PG8_STAGE(PG8_SA(0, 1), a2 + hsA, voffA);
            PG8_WAIT_L(8); PG8_BAR; PG8_WAIT_L(0); PG8_MMA(0, 0, At, B0); PG8_BAR; PG8_SCHED;
            PG8_LDB(B1, 1, 1); PG8_STAGE(PG8_SB(1, 0), b3, voffB);
            PG8_BAR; PG8_WAIT_L(0); PG8_MMA(0, 1, At, B1); PG8_BAR;
            PG8_LDA(At, 1, 1); PG8_STAGE(PG8_SA(1, 0), a3, voffA);
            PG8_BAR; PG8_WAIT_L(0); PG8_MMA(1, 0, At, B0); PG8_BAR; PG8_SCHED;
            PG8_STAGE(PG8_SB(1, 1), b3 + hsB, voffB);
            PG8_WAIT_V(6); PG8_BAR; PG8_MMA(1, 1, At, B1); PG8_BAR;
            }
        }
        if constexpr (ALIGN_EPI) { if (wr == 0) PG8_BAR; }
        if constexpr (!Epi::AFTER_DRAIN) { E(acc, cur, wr, wc, fr, fq); S.done(cur); }
        if (!has_next) break;
#pragma unroll
        for (int a = 0; a < 2; ++a)
#pragma unroll
            for (int b = 0; b < 2; ++b)
#pragma unroll
                for (int m = 0; m < 4; ++m)
#pragma unroll
                    for (int n = 0; n < 2; ++n) acc[a][b][m][n] = (f32x4){0.f, 0.f, 0.f, 0.f};
        cur = nxt; cA = nA; cB = nB; cB2 = nB2; ++ui;
        if constexpr (ALIGN_EPI) { if (wr == 1) PG8_BAR; }
    }
    PG8_WAIT_V(0);
    if constexpr (!ALIGN_EPI) { if (wr == 0) PG8_BAR; }
    PG8_BAR;
    if constexpr (Epi::AFTER_DRAIN) { E.fused(acc, cur, wr, wc, fr, fq, lds, wid, lane); S.done(cur); }
#undef PG8_BK
#undef PG8_SA
#undef PG8_SB
#undef PG8_STAGE
#undef PG8_LDA
#undef PG8_LDB
#undef PG8_MMA
#undef PG8_WAIT_V
#undef PG8_WAIT_L
#undef PG8_BAR
#undef PG8_SCHED
}
}

struct PlainOrder {
    const char* A; const char* Bt; int lda, ldb, nM, nN, nwg, G, c;
    __device__ __forceinline__ void init(const void* A_, const void* Bt_, int lda_, int ldb_, int M, int N, int G_, int c_) { A = (const char*)A_; Bt = (const char*)Bt_; lda = lda_; ldb = ldb_; nM = M / 256; nN = N / 256; nwg = nM * nN; G = G_; c = c_; }
    __device__ __forceinline__ bool next(int i, pg8::Unit& u) const {
        const long L = (long)i * G + c; if (L >= nwg) return false;
        int wgid = (int)L; { const int q = nwg / 8, r = nwg % 8, xcd = wgid % 8, off = wgid / 8; wgid = (xcd < r ? xcd * (q + 1) : r * (q + 1) + (xcd - r) * q) + off; }
        const int nig = 8 * nN, gid = wgid / nig, fm = gid * 8, gsz = (nM - fm) < 8 ? (nM - fm) : 8;
        u.pm = fm + ((wgid % nig) % gsz); u.pn = (wgid % nig) / gsz;
        u.a = A + (size_t)u.pm * 256 * lda * 2; u.b = Bt + (size_t)u.pn * 256 * ldb * 2; u.b2 = u.b; return true;
    }
    __device__ __forceinline__ void a_ready(const pg8::Unit&) const {}
    __device__ __forceinline__ void done(const pg8::Unit&) const {}
};
struct EpiInProj {
    static constexpr bool PERM = true, AFTER_DRAIN = false;
    unsigned char* ws; const float* b_gate; const float* b_fgt; unsigned* kn;
    __device__ __forceinline__ void operator()(const pg8::f32x4 (&acc)[2][2][4][2], const pg8::Unit& u, int wr, int wc, int fr, int fq) const {
        { int t_ = threadIdx.x; asm volatile("" : "+v"(t_)); fr = t_ & 15; fq = (t_ >> 4) & 3; }
        const int pn = u.pn, b = (u.pm * 256) / T_, t0 = u.pm * 256 - b * T_ + wr * 64 + fr;
        if (pn == 11) {
            if (wc == 0 && fq < 4) {
                float* gate = (float*)(ws + WS_GATE); float* fl = (float*)(ws + WS_FL);
#pragma unroll
                for (int ai = 0; ai < 2; ++ai)
#pragma unroll
                    for (int m = 0; m < 4; ++m) { const int t = t0 + ai * 128 + m * 16; const size_t n = (size_t)b * T_ + t;
#pragma unroll
                        for (int nn = 0; nn < 2; ++nn)
#pragma unroll
                            for (int e = 0; e < 4; ++e) { const int c = 8 * fq + 4 * nn + e; const float v = acc[ai][0][m][nn][e];
                                if (c < 24) gate[n * 24 + c] = __builtin_amdgcn_rcpf(1.f + __builtin_amdgcn_exp2f(-(v + b_gate[c]) * LOG2E));
                                else if (c < 28) { const float z = v + b_fgt[c - 24];
                                    fl[(size_t)(b * 4 + (c - 24)) * T_ + t] = z < -30.f ? z : -0.6931471805599453f * __builtin_amdgcn_logf(1.f + __builtin_amdgcn_exp2f(-z * LOG2E)); } } }
            }
            return;
        }
        if (pn == 6 || pn == 9) {
            const int lane_ = (fq << 4) | fr;
#pragma unroll
            for (int bj = 0; bj < 2; ++bj)
#pragma unroll
                for (int ai = 0; ai < 2; ++ai) { float mx = 0.f;
#pragma unroll
                    for (int m = 0; m < 4; ++m) { const pg8::f32x4 v0 = acc[ai][bj][m][0], v1 = acc[ai][bj][m][1];
                        float ss = (v0[0] * v0[0] + v0[1] * v0[1]) + (v0[2] * v0[2] + v0[3] * v0[3]) + (v1[0] * v1[0] + v1[1] * v1[1]) + (v1[2] * v1[2] + v1[3] * v1[3]);
                        ss += shflx_f(ss, 16, lane_); ss += shflx_f(ss, 32, lane_); mx = fmaxf(mx, ss); }
#pragma unroll
                    for (int o = 1; o < 16; o <<= 1) mx = fmaxf(mx, shflx_f(mx, o, lane_));
                    if (lane_ == 0) { const int cg = bj * 4 + wc, tile = (u.pm * 256 - b * T_ + ai * 128 + wr * 64) >> 6;
                        unsigned* dst = pn == 6 ? kn + ((b * 4 + (cg >> 1)) * 64 + tile) * 2 + (cg & 1) : kn + 4096 + (b * 8 + cg) * 64 + tile;
                        atomicMax(dst, __float_as_uint(mx)); } }
        }
#pragma unroll
        for (int bj = 0; bj < 2; ++bj) {
            const int c = bj * 128 + wc * 32 + 8 * fq;
            bf16* base; int W = 64; float sc = 1.f;
            if (pn < 2) { base = (bf16*)(ws + WS_QN) + (size_t)(b * 8 + pn * 4 + (c >> 6)) * T_ * 64 + (c & 63); sc = 0.125f * LOG2E; }
            else if (pn < 5) { base = (bf16*)(ws + WS_KV6 + (size_t)((pn - 2) * 2 + (c >> 7)) * KV6_STRIDE) + (size_t)(b * 2 + ((c >> 6) & 1)) * T_ * 64 + (c & 63); }
            else if (pn < 8) { base = (bf16*)(ws + WS_FQKV) + (size_t)(pn - 5) * (8 * MiB) + (size_t)(b * 4 + (c >> 6)) * T_ * 64 + (c & 63); if (pn == 5) sc = 0.125f * LOG2E; }
            else if (pn < 10) { base = (bf16*)(ws + WS_DQK) + (size_t)(pn - 8) * (8 * MiB) + (size_t)(b * 8 + (c >> 5)) * T_ * 32 + (c & 31); W = 32; if (pn == 8) sc = 0.17677669529663687f * LOG2E; }
            else { base = (bf16*)(ws + WS_DV) + (size_t)(b * 4 + (c >> 6)) * T_ * 64 + (c & 63); }
            const bool blk = W == 64 && pn != 2;
            if (blk) base += -(c & 63) + ((c >> 5) & 1) * 512 + (c & 31);
#pragma unroll
            for (int ai = 0; ai < 2; ++ai)
#pragma unroll
                for (int m = 0; m < 4; ++m) { const int t = t0 + ai * 128 + m * 16;
                    const pg8::f32x4 v0 = acc[ai][bj][m][0] * sc, v1 = acc[ai][bj][m][1] * sc;
                    pg8::u32x4 w; w.x = pg8::cvt_pk_bf16(v0[0], v0[1]); w.y = pg8::cvt_pk_bf16(v0[2], v0[3]); w.z = pg8::cvt_pk_bf16(v1[0], v1[1]); w.w = pg8::cvt_pk_bf16(v1[2], v1[3]);
                    *(pg8::u32x4*)(base + (blk ? (size_t)((t >> 4) * 1024 + (t & 15) * 32) : (size_t)t * W)) = w; }
        }
    }
};
struct EpiResBf16 {
    static constexpr bool PERM = false, AFTER_DRAIN = false;
    bf16* xr;
    __device__ __forceinline__ void operator()(const pg8::f32x4 (&acc)[2][2][4][2], const pg8::Unit& u, int wr, int wc, int fr, int fq) const {
        { int t_ = threadIdx.x; asm volatile("" : "+v"(t_)); fr = t_ & 15; fq = (t_ >> 4) & 3; }
#pragma unroll
        for (int ai = 0; ai < 2; ++ai)
#pragma unroll
            for (int m = 0; m < 4; ++m) { const size_t off = (size_t)(u.pm * 256 + ai * 128 + wr * 64 + m * 16 + fr) * D_ + u.pn * 256 + wc * 32 + 4 * fq;
#pragma unroll
                for (int bj = 0; bj < 2; ++bj)
#pragma unroll
                    for (int n = 0; n < 2; ++n) { const u64 w = *(const u64*)(xr + off + bj * 128 + n * 16);
                        const pg8::f32x4 bs = {__uint_as_float((unsigned)w << 16), __uint_as_float((unsigned)w & 0xffff0000u), __uint_as_float((unsigned)(w >> 32) << 16), __uint_as_float((unsigned)(w >> 32) & 0xffff0000u)};
                        const pg8::f32x4 o = bs + acc[ai][bj][m][n];
                        *(u64*)(xr + off + bj * 128 + n * 16) = (u64)pg8::cvt_pk_bf16(o[0], o[1]) | ((u64)pg8::cvt_pk_bf16(o[2], o[3]) << 32); } }
    }
};


struct EpiDummy {
    static constexpr bool PERM = true, AFTER_DRAIN = false;
    float* dst;
    __device__ __forceinline__ void operator()(const pg8::f32x4 (&acc)[2][2][4][2], const pg8::Unit& u, int wr, int wc, int fr, int fq) const {
        pg8::f32x4 a = {0.f, 0.f, 0.f, 0.f};
#pragma unroll
        for (int ai = 0; ai < 2; ++ai)
#pragma unroll
            for (int bj = 0; bj < 2; ++bj)
#pragma unroll
                for (int m = 0; m < 4; ++m) { a = a + acc[ai][bj][m][0]; a = a + acc[ai][bj][m][1]; }
        *(pg8::f32x4*)(dst + ((size_t)(u.pm * 12 + u.pn) * 512 + threadIdx.x) * 4) = a;
    }
};
struct OneUnitOrder { pg8::Unit u; bool has;
    __device__ __forceinline__ bool next(int i, pg8::Unit& o) const { if (i != 0 || !has) return false; o = u; return true; }
    __device__ __forceinline__ void a_ready(const pg8::Unit&) const {}
    __device__ __forceinline__ void done(const pg8::Unit&) const {} };
__device__ __forceinline__ float gelu_tanh_fast(float x) { const float u2 = 1.5957691216057308f * (x + 0.044715f * x * x * x); return x * __builtin_amdgcn_rcpf(1.f + __builtin_amdgcn_exp2f(-u2 * LOG2E)); }
struct EpiCmpH {
    static constexpr bool PERM = true, AFTER_DRAIN = false;
    bf16* hc; const float* bias1;
    __device__ __forceinline__ void operator()(const pg8::f32x4 (&acc)[2][2][4][2], const pg8::Unit& u, int wr, int wc, int fr, int fq) const {
        { int t_ = threadIdx.x; asm volatile("" : "+v"(t_)); fr = t_ & 15; fq = (t_ >> 4) & 3; }
        const int kv = u.pn;
#pragma unroll
        for (int bj = 0; bj < 2; ++bj) { const int col = bj * 128 + wc * 32 + 8 * fq;
            const pg8::f32x4 b0 = *(const pg8::f32x4*)(bias1 + kv * 256 + col), b1 = *(const pg8::f32x4*)(bias1 + kv * 256 + col + 4);
#pragma unroll
            for (int ai = 0; ai < 2; ++ai)
#pragma unroll
                for (int m = 0; m < 4; ++m) { const int row = u.pm * 256 + ai * 128 + wr * 64 + m * 16 + fr;
                    const pg8::f32x4 v0 = acc[ai][bj][m][0] + b0, v1 = acc[ai][bj][m][1] + b1;
                    pg8::u32x4 w; w.x = pg8::cvt_pk_bf16(gelu_tanh_fast(v0[0]), gelu_tanh_fast(v0[1])); w.y = pg8::cvt_pk_bf16(gelu_tanh_fast(v0[2]), gelu_tanh_fast(v0[3]));
                    w.z = pg8::cvt_pk_bf16(gelu_tanh_fast(v1[0]), gelu_tanh_fast(v1[1])); w.w = pg8::cvt_pk_bf16(gelu_tanh_fast(v1[2]), gelu_tanh_fast(v1[3]));
                    *(pg8::u32x4*)(hc + ((size_t)kv * 4096 + row) * 256 + col) = w; } }
    }
};
struct EpiCmpOut {
    static constexpr bool PERM = true, AFTER_DRAIN = false;
    bf16* kvcmp;
    __device__ __forceinline__ void operator()(const pg8::f32x4 (&acc)[2][2][4][2], const pg8::Unit& u, int wr, int wc, int fr, int fq) const {
        { int t_ = threadIdx.x; asm volatile("" : "+v"(t_)); fr = t_ & 15; fq = (t_ >> 4) & 3; }
        if (wc >= 2) return;
        const int kv = u.pn, col = wc * 32 + 8 * fq;
#pragma unroll
        for (int ai = 0; ai < 2; ++ai)
#pragma unroll
            for (int m = 0; m < 4; ++m) { const int row = u.pm * 256 + ai * 128 + wr * 64 + m * 16 + fr; const float z = ((row & 255) == 255) ? 0.f : 1.f;
                const pg8::f32x4 v0 = acc[ai][0][m][0], v1 = acc[ai][0][m][1];
                pg8::u32x4 w; w.x = pg8::cvt_pk_bf16(z != 0.f ? v0[0] : 0.f, z != 0.f ? v0[1] : 0.f); w.y = pg8::cvt_pk_bf16(z != 0.f ? v0[2] : 0.f, z != 0.f ? v0[3] : 0.f);
                w.z = pg8::cvt_pk_bf16(z != 0.f ? v1[0] : 0.f, z != 0.f ? v1[1] : 0.f); w.w = pg8::cvt_pk_bf16(z != 0.f ? v1[2] : 0.f, z != 0.f ? v1[3] : 0.f);
                *(pg8::u32x4*)(kvcmp + ((size_t)kv * 4096 + row) * 64 + col) = w; }
    }
};

__device__ __forceinline__ void moe_build_tables(const unsigned* cnt, int tid) {
    LAS int* T = (LAS int*)((LAS unsigned char*)lds_raw + TBL_OFF);
    __syncthreads();
    if (tid < 112) T[128 + 256 + tid] = (int)((cnt[tid] + 255u) >> 8);
    __syncthreads();
    if (tid == 0) { int o = 0; for (int c = 0; c < 112; ++c) { T[c] = o; const int n = T[128 + 256 + c]; for (int k = 0; k < n; ++k) T[128 + o + k] = c; o += n; } T[112] = o; }
    __syncthreads();
}
__device__ __forceinline__ void moe_pair(int cls, int& ea, int& eb) { const int grp = cls / 28; int idx = cls % 28, lo = 0; while (idx >= 7 - lo) { idx -= 7 - lo; ++lo; } ea = grp * 8 + lo; eb = grp * 8 + lo + 1 + idx; }
struct MoeOrder1 {
    const char* xs; const char* wgu; int G, c;
    __device__ __forceinline__ bool next(int i, pg8::Unit& u) const {
        const LAS int* T = (const LAS int*)((LAS unsigned char*)lds_raw + TBL_OFF);
        const int idx = i * G + c; if (idx >= 4 * T[112]) return false;
        const int tile = idx >> 2, pn = idx & 3; int ea, eb; moe_pair(T[128 + tile], ea, eb); const int e = (pn >> 1) ? eb : ea;
        u.pm = tile; u.pn = pn; u.a = xs + (size_t)tile * 256 * 2048; u.b = wgu + ((size_t)e * 512 + (pn & 1) * 256) * 2048; u.b2 = u.b; return true; }
    __device__ __forceinline__ void a_ready(const pg8::Unit&) const {}
    __device__ __forceinline__ void done(const pg8::Unit&) const {} };
struct MoeOrder2 {
    const char* hb; const char* wd; int G, c;
    __device__ __forceinline__ bool next(int i, pg8::Unit& u) const {
        const LAS int* T = (const LAS int*)((LAS unsigned char*)lds_raw + TBL_OFF);
        const int idx = i * G + c; if (idx >= 4 * T[112]) return false;
        const int tile = idx >> 2, pn = idx & 3; int ea, eb; moe_pair(T[128 + tile], ea, eb);
        u.pm = tile; u.pn = pn; u.a = hb + (size_t)tile * 256 * 1024; u.b = wd + ((size_t)ea * 1024 + pn * 256) * 512; u.b2 = wd + ((size_t)eb * 1024 + pn * 256) * 512; return true; }
    __device__ __forceinline__ void a_ready(const pg8::Unit&) const {}
    __device__ __forceinline__ void done(const pg8::Unit&) const {} };
struct EpiMoeH {
    static constexpr bool PERM = true, AFTER_DRAIN = false;
    bf16* hb; const float* roww;
    __device__ __forceinline__ void operator()(const pg8::f32x4 (&acc)[2][2][4][2], const pg8::Unit& u, int wr, int wc, int fr, int fq) const {
        { int t_ = threadIdx.x; asm volatile("" : "+v"(t_)); fr = t_ & 15; fq = (t_ >> 4) & 3; }
        const int slot = u.pn >> 1;
#pragma unroll
        for (int ai = 0; ai < 2; ++ai)
#pragma unroll
            for (int m = 0; m < 4; ++m) { const size_t row = (size_t)u.pm * 256 + ai * 128 + wr * 64 + m * 16 + fr; const float w = roww[row * 2 + slot];
#pragma unroll
                for (int bj = 0; bj < 2; ++bj) { const int j0 = (u.pn & 1) * 128 + (bj * 128 + wc * 32 + 8 * fq) / 2;
                    const pg8::f32x4 v0 = acc[ai][bj][m][0], v1 = acc[ai][bj][m][1];
                    const float h0 = v0[0] * __builtin_amdgcn_rcpf(1.f + __builtin_amdgcn_exp2f(-v0[0] * LOG2E)) * v0[1] * w, h1 = v0[2] * __builtin_amdgcn_rcpf(1.f + __builtin_amdgcn_exp2f(-v0[2] * LOG2E)) * v0[3] * w;
                    const float h2 = v1[0] * __builtin_amdgcn_rcpf(1.f + __builtin_amdgcn_exp2f(-v1[0] * LOG2E)) * v1[1] * w, h3 = v1[2] * __builtin_amdgcn_rcpf(1.f + __builtin_amdgcn_exp2f(-v1[2] * LOG2E)) * v1[3] * w;
                    *(u64*)(hb + row * 512 + slot * 256 + j0) = (u64)pg8::cvt_pk_bf16(h0, h1) | ((u64)pg8::cvt_pk_bf16(h2, h3) << 32); } }
    }
};
struct EpiMoeOut {
    static constexpr bool PERM = false, AFTER_DRAIN = false;
    bf16* x; const int* rowtok;
    __device__ __forceinline__ void operator()(const pg8::f32x4 (&acc)[2][2][4][2], const pg8::Unit& u, int wr, int wc, int fr, int fq) const {
        { int t_ = threadIdx.x; asm volatile("" : "+v"(t_)); fr = t_ & 15; fq = (t_ >> 4) & 3; }
        bf16* xx = x; const int* rt = rowtok; asm volatile("" : "+s"(xx), "+s"(rt));
#pragma unroll
        for (int ai = 0; ai < 2; ++ai)
#pragma unroll
            for (int m = 0; m < 4; ++m) { const int tok = rt[(size_t)u.pm * 256 + ai * 128 + wr * 64 + m * 16 + fr];
                if (tok >= 0) { bf16* xr = xx + (size_t)tok * D_ + u.pn * 256 + wc * 32 + 4 * fq;
#pragma unroll
                    for (int bj = 0; bj < 2; ++bj)
#pragma unroll
                        for (int n = 0; n < 2; ++n) { u64* q = (u64*)(xr + bj * 128 + n * 16); const u64 w = *q; const pg8::f32x4 a = acc[ai][bj][m][n];
                            *q = (u64)pg8::cvt_pk_bf16(__uint_as_float((unsigned)w << 16) + a[0], __uint_as_float((unsigned)w & 0xffff0000u) + a[1]) | ((u64)pg8::cvt_pk_bf16(__uint_as_float((unsigned)(w >> 32) << 16) + a[2], __uint_as_float((unsigned)(w >> 32) & 0xffff0000u) + a[3]) << 32); } } }
    }
};

__device__ __forceinline__ void transpose_item(const float* W, int ldw, bf16* WT, int ldt, int r0, int rmul, int k0, LAS float* scr, int lane) {
    f32x4 v[8];
#pragma unroll
    for (int i = 0; i < 8; ++i) v[i] = *(const f32x4*)(W + (size_t)(k0 + i * 8 + (lane >> 3)) * ldw + (lane & 7) * 4);
#pragma unroll
    for (int i = 0; i < 8; ++i) { LAS float* d = scr + (i * 8 + (lane >> 3)) * 33 + (lane & 7) * 4; d[0] = v[i].x; d[1] = v[i].y; d[2] = v[i].z; d[3] = v[i].w; }
    asm volatile("s_waitcnt lgkmcnt(0)" ::: "memory");
    const int c = lane & 7;
#pragma unroll
    for (int j = 0; j < 4; ++j) { const int n = (lane >> 3) + 8 * j; const LAS float* sp = scr + (8 * c) * 33 + n;
        u32x4 o; o.x = pk2(sp[0 * 33], sp[1 * 33]); o.y = pk2(sp[2 * 33], sp[3 * 33]); o.z = pk2(sp[4 * 33], sp[5 * 33]); o.w = pk2(sp[6 * 33], sp[7 * 33]);
        *(u32x4*)(WT + (size_t)(r0 + rmul * n) * ldt + k0 + 8 * c) = o; }
    asm volatile("s_waitcnt lgkmcnt(0)" ::: "memory");
}
__device__ __forceinline__ void transpose_seg(const float* W, int ldw, int K, int sc0, int ncol, bf16* WT, int r0, int rmul, int item, LAS float* scr, int lane) {
    const int nb = ncol / 32, kb = item / nb, cb = item % nb;
    transpose_item(W + sc0 + cb * 32, ldw, WT, K, r0 + rmul * cb * 32, rmul, kb * 64, scr, lane);
}

typedef float f32x16 __attribute__((ext_vector_type(16)));
typedef short bf16x8v __attribute__((ext_vector_type(8)));
typedef short s16x4 __attribute__((ext_vector_type(4)));
typedef float f32x2_t __attribute__((ext_vector_type(2)));
typedef __bf16 bf16x2_t __attribute__((ext_vector_type(2)));
constexpr int A_KBUF = 10240, A_VBUF = 12288;
constexpr int A_KOFF = 0, A_VOFF = 2 * A_KBUF, A_BOFF = A_VOFF + 2 * A_VBUF, A_LDS_END = A_BOFF + 2 * 256;
__device__ __forceinline__ constexpr int crow0(int reg) { return (reg & 3) + 8 * (reg >> 2); }
__device__ __forceinline__ float swap_max(float m) { auto rr = __builtin_amdgcn_permlane32_swap(__float_as_uint(m), __float_as_uint(m), false, false); return fmaxf(__uint_as_float(rr[0]), __uint_as_float(rr[1])); }
__device__ __forceinline__ float swap_sum(float m) { auto rr = __builtin_amdgcn_permlane32_swap(__float_as_uint(m), __float_as_uint(m), false, false); return __uint_as_float(rr[0]) + __uint_as_float(rr[1]); }
__device__ __forceinline__ unsigned cvtpk(float lo, float hi) { f32x2_t v = {lo, hi}; bf16x2_t b = __builtin_convertvector(v, bf16x2_t); return __builtin_bit_cast(unsigned, b); }
__device__ __forceinline__ bf16x8v pack8(const f32x16& p, int b0) { u32x4 w; w.x = cvtpk(p[b0 + 0], p[b0 + 1]); w.y = cvtpk(p[b0 + 2], p[b0 + 3]); w.z = cvtpk(p[b0 + 4], p[b0 + 5]); w.w = cvtpk(p[b0 + 6], p[b0 + 7]); return __builtin_bit_cast(bf16x8v, w); }
__device__ __forceinline__ s16x4 tr_read(const LAS unsigned char* p) { typedef short v4i16_t __attribute__((ext_vector_type(4))); return __builtin_bit_cast(s16x4, __builtin_amdgcn_ds_read_tr16_b64_v4i16((LAS v4i16_t*)p)); }

template <int DQK, int NMAP, bool FOX, bool SLC>
__device__ __forceinline__ void attn_core(LAS unsigned char* L, const bf16* Kb0, const bf16* Kb1, const bf16* Vb, const LAS float* cum, float cum_ref,
                                          const bf16x8v (&Qf)[NMAP][DQK / 16], u64 tilemask, int t_lane, int tw0, int win, float slope2, unsigned selw0, unsigned selw1,
                                          f32x16 (&O)[NMAP][2], float (&M)[NMAP], float (&Ls)[NMAP], int tid, bool started0 = false) {
    constexpr int KP = DQK * 2 + 16, VP = 192;
    const int lane = tid & 63, r = lane & 31, h = lane >> 5;
    int kdst; const bf16* ksrc;
    if (DQK == 64) { kdst = (tid >> 3) * KP + (tid & 7) * 16; ksrc = Kb0 + b64_off(tid >> 3, (tid & 7) * 8); }
    else { const int mp = tid >> 8, tt = tid & 255; kdst = mp * 5120 + (tt >> 2) * KP + (tt & 3) * 16; ksrc = (mp ? Kb1 : Kb0) + (tt >> 2) * 32 + (tt & 3) * 8; }
    const int vdst = (tid >> 3) * VP + (tid & 7) * 16; const bf16* vsrc = Vb + b64_off(tid >> 3, (tid & 7) * 8);
    const LAS unsigned char* kfrag = L + A_KOFF + r * KP + h * 16;
    const LAS unsigned char* vfrag = L + A_VOFF + (4 * h + ((lane & 15) >> 2)) * VP + (16 * ((lane >> 4) & 1) + 4 * (lane & 3)) * 2;
    u32x4 kreg, vreg; float breg = 0.f;
    u64 mk = tilemask;
    int j = 63 - __builtin_clzll(mk); mk &= ~(1ull << j);
    { const int kv0 = j * 64; kreg = *(const u32x4*)(ksrc + (size_t)kv0 * DQK); vreg = *(const u32x4*)(vsrc + (size_t)kv0 * 64); if (FOX && tid < 64) breg = (cum_ref - cum[kv0 + tid]) * LOG2E; }
    *(LAS u32x4*)(L + A_KOFF + kdst) = kreg; *(LAS u32x4*)(L + A_VOFF + vdst) = vreg; if (FOX && tid < 64) *(LAS float*)(L + A_BOFF + tid * 4) = breg;
    __syncthreads();
    int buf = 0; bool started = started0;
    float pdummy = 0.f; int idummy = 0; f32x16 dm0; for (int i = 0; i < 16; ++i) dm0[i] = 0.f;
    for (;;) {
        const bool more = mk != 0ull; int jn = 0;
        if (more) { jn = 63 - __builtin_clzll(mk); mk &= ~(1ull << jn); const int kv0 = jn * 64;
            kreg = *(const u32x4*)(ksrc + (size_t)kv0 * DQK); vreg = *(const u32x4*)(vsrc + (size_t)kv0 * 64); if (FOX && tid < 64) breg = (cum_ref - cum[kv0 + tid]) * LOG2E; }
        { const int kv0 = j * 64;
          bool wave_has = true; float selb = 0.f;
          if (SLC) { const bool mine = ((j < 32 ? (selw0 >> j) : (selw1 >> (j - 32))) & 1u) != 0u; selb = mine ? 0.f : -INFINITY; wave_has = __any(mine); }
          if (wave_has && !(kv0 > tw0 + 31) && !(tw0 - (kv0 + 63) >= win)) {
            const bool need_mask = (kv0 + 63 > tw0) || (tw0 + 31 - kv0 >= win);
            const int dl = t_lane - kv0 - 4 * h;
            bf16x8v pa[NMAP][4];
#pragma unroll
            for (int mp = 0; mp < NMAP; ++mp) {
                f32x16 p0, p1;
                if (FOX) { const LAS f32x4* bl = (const LAS f32x4*)(L + A_BOFF + buf * 256) + h; const float mm = M[mp];
#pragma unroll
                    for (int g4 = 0; g4 < 4; ++g4) { const f32x4 b0 = bl[2 * g4], b1 = bl[8 + 2 * g4];
                        p0[4 * g4 + 0] = b0.x - mm; p0[4 * g4 + 1] = b0.y - mm; p0[4 * g4 + 2] = b0.z - mm; p0[4 * g4 + 3] = b0.w - mm; p1[4 * g4 + 0] = b1.x - mm; p1[4 * g4 + 1] = b1.y - mm; p1[4 * g4 + 2] = b1.z - mm; p1[4 * g4 + 3] = b1.w - mm; } }
                else { const float base_l = (slope2 * (float)(kv0 + 4 * h - tw0) - M[mp]) + selb, s8 = slope2 * 8.f, s32 = slope2 * 32.f;
                    p0[0] = base_l; p0[1] = p0[0] + slope2; p0[2] = p0[1] + slope2; p0[3] = p0[2] + slope2;
#pragma unroll
                    for (int reg = 4; reg < 16; ++reg) p0[reg] = p0[reg - 4] + s8;
#pragma unroll
                    for (int reg = 0; reg < 16; ++reg) p1[reg] = p0[reg] + s32; }
                const LAS unsigned char* kb = kfrag + buf * A_KBUF + (DQK == 32 ? mp * 5120 : 0);
#pragma unroll
                for (int s = 0; s < DQK / 16; ++s) { const bf16x8v kf0 = *(const LAS bf16x8v*)(kb + s * 32), kf1 = *(const LAS bf16x8v*)(kb + 32 * KP + s * 32);
#ifdef PROBE_X_LDSK
                    { const bf16x8v z0 = *(const volatile LAS bf16x8v*)(kb + s * 32), z1 = *(const volatile LAS bf16x8v*)(kb + 32 * KP + s * 32); idummy ^= z0[0] ^ z1[1]; }
#endif
#ifdef PROBE_X_MFMA
                    dm0 = __builtin_amdgcn_mfma_f32_32x32x16_bf16(kf0, Qf[mp][s], dm0, 0, 0, 0); dm0 = __builtin_amdgcn_mfma_f32_32x32x16_bf16(kf1, Qf[mp][s], dm0, 0, 0, 0);
#endif
                    p0 = __builtin_amdgcn_mfma_f32_32x32x16_bf16(kf0, Qf[mp][s], p0, 0, 0, 0); p1 = __builtin_amdgcn_mfma_f32_32x32x16_bf16(kf1, Qf[mp][s], p1, 0, 0, 0); }
                if (need_mask) {
#pragma unroll
                    for (int reg = 0; reg < 16; ++reg) { const int d0 = dl - crow0(reg), d1 = d0 - 32;
                        p0[reg] = (d0 >= 0 && d0 < win) ? p0[reg] : -INFINITY; p1[reg] = (d1 >= 0 && d1 < win) ? p1[reg] : -INFINITY; } }
                float mt = fmaxf(fmaxf(p0[0], p1[0]), fmaxf(p0[1], p1[1]));
#pragma unroll
                for (int reg = 2; reg < 16; reg += 2) mt = fmaxf(fmaxf(mt, fmaxf(fmaxf(p0[reg], p1[reg]), p0[reg + 1])), p1[reg + 1]);
                mt = swap_max(mt);
                if (!started || __any(mt > 8.f)) {
                    const float d = (mt > -1e30f) ? (started ? fmaxf(mt, 0.f) : mt) : 0.f, alpha = __builtin_amdgcn_exp2f(-d);
                    O[mp][0] *= alpha; O[mp][1] *= alpha; Ls[mp] *= alpha; M[mp] += d;
#pragma unroll
                    for (int reg = 0; reg < 16; ++reg) { p0[reg] -= d; p1[reg] -= d; } }
                float rs = 0.f;
#ifdef PROBE_X_EXP
#pragma unroll
                for (int reg = 0; reg < 16; ++reg) { pdummy += __builtin_amdgcn_exp2f(p0[reg] - 1.f) + __builtin_amdgcn_exp2f(p1[reg] - 1.f); }
#endif
#pragma unroll
                for (int reg = 0; reg < 16; ++reg) { p0[reg] = __builtin_amdgcn_exp2f(p0[reg]); p1[reg] = __builtin_amdgcn_exp2f(p1[reg]); rs += p0[reg] + p1[reg]; }
                Ls[mp] += rs;
                pa[mp][0] = pack8(p0, 0); pa[mp][1] = pack8(p0, 8); pa[mp][2] = pack8(p1, 0); pa[mp][3] = pack8(p1, 8);
            }
            started = true;
            const LAS unsigned char* vb = vfrag + buf * A_VBUF;
#pragma unroll
            for (int db = 0; db < 2; ++db)
#pragma unroll
                for (int ks = 0; ks < 4; ++ks) { const s16x4 lo = tr_read(vb + ks * (16 * VP) + db * 64), hi = tr_read(vb + ks * (16 * VP) + db * 64 + 8 * VP);
                    const bf16x8v vf = {lo[0], lo[1], lo[2], lo[3], hi[0], hi[1], hi[2], hi[3]};
#pragma unroll
                    for (int mp = 0; mp < NMAP; ++mp) O[mp][db] = __builtin_amdgcn_mfma_f32_32x32x16_bf16(vf, pa[mp][ks], O[mp][db], 0, 0, 0); }
          } }
        if (more) { *(LAS u32x4*)(L + A_KOFF + (buf ^ 1) * A_KBUF + kdst) = kreg; *(LAS u32x4*)(L + A_VOFF + (buf ^ 1) * A_VBUF + vdst) = vreg; if (FOX && tid < 64) *(LAS float*)(L + A_BOFF + (buf ^ 1) * 256 + tid * 4) = breg; }
#ifdef PROBE_X_BAR
        __syncthreads();
#endif
        __syncthreads();
        if (!more) break;
        j = jn; buf ^= 1;
    }
    if (pdummy == 123.456f || idummy == 0x7fffabcd || dm0[3] == 98765.4321f) Ls[0] += 1e-30f;
}
#ifndef AC2_MODE
#define AC2_MODE 0
#endif
#ifndef AC2_INIT_VALU
#define AC2_INIT_VALU 24
#endif
template <bool FOX, bool SLC>
__device__ __forceinline__ void attn_core2(LAS unsigned char* L, const bf16* Kb0, const bf16* Vb, const LAS float* cum, float cum_ref,
                                           const bf16x8v (&Qf)[4], u64 tilemask, int t_lane, int tw0, int win, float slope2, unsigned selw0, unsigned selw1,
                                           f32x16 (&O)[2], float& M, float& Ls, int tid) {
    constexpr int KP = 144, VP = 192;
    const int lane = tid & 63, r = lane & 31, h = lane >> 5;
    const int kdst = (tid >> 3) * KP + (tid & 7) * 16; const bf16* ksrc = Kb0 + b64_off(tid >> 3, (tid & 7) * 8);
    const int vdst = (tid >> 3) * VP + (tid & 7) * 16; const bf16* vsrc = Vb + b64_off(tid >> 3, (tid & 7) * 8);
    const LAS unsigned char* kfrag = L + A_KOFF + r * KP + h * 16;
    const LAS unsigned char* vfrag = L + A_VOFF + (4 * h + ((lane & 15) >> 2)) * VP + (16 * ((lane >> 4) & 1) + 4 * (lane & 3)) * 2;
#define AC2_ACTIVE(jj) (!((jj) * 64 > tw0 + 31) && !(tw0 - ((jj) * 64 + 63) >= win))
#define AC2_INIT(jj, kslot, q0, q1) do { const int kv0_ = (jj) * 64; \
        if (FOX) { const LAS f32x4* bl = (const LAS f32x4*)(L + A_BOFF + (kslot) * 256) + h; const float mm = M; \
            _Pragma("unroll") for (int g4 = 0; g4 < 4; ++g4) { const f32x4 b0 = bl[2 * g4], b1 = bl[8 + 2 * g4]; \
                q0[4 * g4 + 0] = b0.x - mm; q0[4 * g4 + 1] = b0.y - mm; q0[4 * g4 + 2] = b0.z - mm; q0[4 * g4 + 3] = b0.w - mm; q1[4 * g4 + 0] = b1.x - mm; q1[4 * g4 + 1] = b1.y - mm; q1[4 * g4 + 2] = b1.z - mm; q1[4 * g4 + 3] = b1.w - mm; } } \
        else { float selb = 0.f; if (SLC) selb = ((((jj) < 32) ? (selw0 >> (jj)) : (selw1 >> ((jj) - 32))) & 1u) ? 0.f : -INFINITY; \
            const float base_l = (slope2 * (float)(kv0_ + 4 * h - tw0) - M) + selb, s8 = slope2 * 8.f, s32 = slope2 * 32.f; \
            q0[0] = base_l; q0[1] = q0[0] + slope2; q0[2] = q0[1] + slope2; q0[3] = q0[2] + slope2; \
            _Pragma("unroll") for (int reg = 4; reg < 16; ++reg) q0[reg] = q0[reg - 4] + s8; \
            _Pragma("unroll") for (int reg = 0; reg < 16; ++reg) q1[reg] = q0[reg] + s32; } } while (0)
#define AC2_QK(jj, kslot) do { AC2_INIT(jj, kslot, p0, p1); \
        const LAS unsigned char* kb_ = kfrag + (kslot) * A_KBUF; \
        _Pragma("unroll") for (int s_ = 0; s_ < 4; ++s_) { const bf16x8v kf0 = *(const LAS bf16x8v*)(kb_ + s_ * 32), kf1 = *(const LAS bf16x8v*)(kb_ + 32 * KP + s_ * 32); \
            p0 = __builtin_amdgcn_mfma_f32_32x32x16_bf16(kf0, Qf[s_], p0, 0, 0, 0); p1 = __builtin_amdgcn_mfma_f32_32x32x16_bf16(kf1, Qf[s_], p1, 0, 0, 0); } } while (0)
    u32x4 kreg, vreg; float breg = 0.f;
    u64 mk = tilemask;
    int j = 63 - __builtin_clzll(mk); mk &= ~(1ull << j);
    int jn = -1; if (mk) { jn = 63 - __builtin_clzll(mk); mk &= ~(1ull << jn); }
    { kreg = *(const u32x4*)(ksrc + (size_t)j * 64 * 64); vreg = *(const u32x4*)(vsrc + (size_t)j * 64 * 64); if (FOX && tid < 64) breg = (cum_ref - cum[j * 64 + tid]) * LOG2E;
      *(LAS u32x4*)(L + A_KOFF + kdst) = kreg; *(LAS u32x4*)(L + A_VOFF + vdst) = vreg; if (FOX && tid < 64) *(LAS float*)(L + A_BOFF + tid * 4) = breg;
      if (jn >= 0) { kreg = *(const u32x4*)(ksrc + (size_t)jn * 64 * 64); if (FOX && tid < 64) breg = (cum_ref - cum[jn * 64 + tid]) * LOG2E;
          *(LAS u32x4*)(L + A_KOFF + A_KBUF + kdst) = kreg; if (FOX && tid < 64) *(LAS float*)(L + A_BOFF + 256 + tid * 4) = breg; } }
    __syncthreads();
    f32x16 p0, p1;
    bool started = false;
    int ks = 0, vs = 0;
    if (AC2_ACTIVE(j)) AC2_QK(j, 0);
    for (;;) {
        int jnn = -1; if (mk) { jnn = 63 - __builtin_clzll(mk); mk &= ~(1ull << jnn); }
        if (jnn >= 0) { kreg = *(const u32x4*)(ksrc + (size_t)jnn * 64 * 64); if (FOX && tid < 64) breg = (cum_ref - cum[jnn * 64 + tid]) * LOG2E; }
        if (jn >= 0) vreg = *(const u32x4*)(vsrc + (size_t)jn * 64 * 64);
        const bool act = AC2_ACTIVE(j), actn = jn >= 0 && AC2_ACTIVE(jn);
        if (act) {
            const int kv0 = j * 64;
            if ((kv0 + 63 > tw0) || (tw0 + 31 - kv0 >= win)) { const int dl = t_lane - kv0 - 4 * h;
#pragma unroll
                for (int reg = 0; reg < 16; ++reg) { const int d0 = dl - crow0(reg), d1 = d0 - 32;
                    p0[reg] = (d0 >= 0 && d0 < win) ? p0[reg] : -INFINITY; p1[reg] = (d1 >= 0 && d1 < win) ? p1[reg] : -INFINITY; } }
            float mt = fmaxf(fmaxf(p0[0], p1[0]), fmaxf(p0[1], p1[1]));
#pragma unroll
            for (int reg = 2; reg < 16; reg += 2) mt = fmaxf(fmaxf(mt, fmaxf(fmaxf(p0[reg], p1[reg]), p0[reg + 1])), p1[reg + 1]);
            mt = swap_max(mt);
            if (!started || __any(mt > 8.f)) {
                const float d = (mt > -1e30f) ? (started ? fmaxf(mt, 0.f) : mt) : 0.f, alpha = __builtin_amdgcn_exp2f(-d);
                O[0] *= alpha; O[1] *= alpha; Ls *= alpha; M += d;
#pragma unroll
                for (int reg = 0; reg < 16; ++reg) { p0[reg] -= d; p1[reg] -= d; } }
            started = true;
#if AC2_MODE == 1
            {
                const int jq = jn >= 0 ? jn : 0;
                float rs = 0.f;
#pragma unroll
                for (int reg = 0; reg < 16; ++reg) { p0[reg] = __builtin_amdgcn_exp2f(p0[reg]); p1[reg] = __builtin_amdgcn_exp2f(p1[reg]); rs += p0[reg] + p1[reg]; }
                Ls += rs;
                const bf16x8v pa0 = pack8(p0, 0), pa1 = pack8(p0, 8), pa2 = pack8(p1, 0), pa3 = pack8(p1, 8);
                AC2_QK(jq, ks ^ 1);
                const LAS unsigned char* vb = vfrag + vs * A_VBUF;
#pragma unroll
                for (int db = 0; db < 2; ++db)
#pragma unroll
                    for (int kq = 0; kq < 4; ++kq) { const s16x4 lo = tr_read(vb + kq * (16 * VP) + db * 64), hi = tr_read(vb + kq * (16 * VP) + db * 64 + 8 * VP);
                        const bf16x8v vf = {lo[0], lo[1], lo[2], lo[3], hi[0], hi[1], hi[2], hi[3]};
                        O[db] = __builtin_amdgcn_mfma_f32_32x32x16_bf16(vf, kq == 0 ? pa0 : kq == 1 ? pa1 : kq == 2 ? pa2 : pa3, O[db], 0, 0, 0); }
            }
#else
            {
                const int jq = jn >= 0 ? jn : 0;
                f32x16 n0, n1;
                AC2_INIT(jq, ks ^ 1, n0, n1);
                const LAS unsigned char* kb_ = kfrag + (ks ^ 1) * A_KBUF;
                bf16x8v kf[8];
#pragma unroll
                for (int s_ = 0; s_ < 4; ++s_) { kf[2 * s_] = *(const LAS bf16x8v*)(kb_ + s_ * 32); kf[2 * s_ + 1] = *(const LAS bf16x8v*)(kb_ + 32 * KP + s_ * 32); }
                const LAS unsigned char* vb = vfrag + vs * A_VBUF;
                __builtin_amdgcn_sched_barrier(0);
                float ra = 0.f, rb = 0.f; unsigned w[16];
#define AC2_PINF(x) asm volatile("" : "+v"(x))
#define AC2_QGAP(i) do { if ((i) & 1) n1 = __builtin_amdgcn_mfma_f32_32x32x16_bf16(kf[i], Qf[(i) >> 1], n1, 0, 0, 0); else n0 = __builtin_amdgcn_mfma_f32_32x32x16_bf16(kf[i], Qf[(i) >> 1], n0, 0, 0, 0); \
                    float e0 = __builtin_amdgcn_exp2f(p0[2 * (i)]), e1 = __builtin_amdgcn_exp2f(p0[2 * (i) + 1]), e2 = __builtin_amdgcn_exp2f(p1[2 * (i)]), e3 = __builtin_amdgcn_exp2f(p1[2 * (i) + 1]); \
                    ra += e0 + e1; rb += e2 + e3; \
                    AC2_PINF(e0); AC2_PINF(e1); AC2_PINF(e2); AC2_PINF(e3); AC2_PINF(ra); AC2_PINF(rb); \
                    p0[2 * (i)] = e0; p0[2 * (i) + 1] = e1; p1[2 * (i)] = e2; p1[2 * (i) + 1] = e3; \
                    if ((i) >= 4) { w[2 * ((i) - 4)] = cvtpk(p0[4 * ((i) - 4)], p0[4 * ((i) - 4) + 1]); w[2 * ((i) - 4) + 1] = cvtpk(p0[4 * ((i) - 4) + 2], p0[4 * ((i) - 4) + 3]); AC2_PINF(w[2 * ((i) - 4)]); AC2_PINF(w[2 * ((i) - 4) + 1]); } \
                    if ((i) == 6) { vl[0] = tr_read(vb); vh[0] = tr_read(vb + 8 * VP); } \
                    if ((i) == 7) { vl[1] = tr_read(vb + 64); vh[1] = tr_read(vb + 64 + 8 * VP); } \
                    __builtin_amdgcn_sched_barrier(0); } while (0)
                s16x4 vl[2], vh[2];
                AC2_QGAP(0); AC2_QGAP(1); AC2_QGAP(2); AC2_QGAP(3); AC2_QGAP(4); AC2_QGAP(5); AC2_QGAP(6); AC2_QGAP(7);
                Ls += ra + rb;
#define AC2_PA(kq) __builtin_bit_cast(bf16x8v, (u32x4){w[4 * (kq)], w[4 * (kq) + 1], w[4 * (kq) + 2], w[4 * (kq) + 3]})
#define AC2_PGAP(g) do { const int kq_ = (g) >> 1, db_ = (g) & 1; const bf16x8v vf = {vl[(g) & 1][0], vl[(g) & 1][1], vl[(g) & 1][2], vl[(g) & 1][3], vh[(g) & 1][0], vh[(g) & 1][1], vh[(g) & 1][2], vh[(g) & 1][3]}; \
                    if ((g) < 6) { const int kq2 = ((g) + 2) >> 1, db2 = (g) & 1; vl[(g) & 1] = tr_read(vb + kq2 * (16 * VP) + db2 * 64); vh[(g) & 1] = tr_read(vb + kq2 * (16 * VP) + db2 * 64 + 8 * VP); } \
                    O[db_] = __builtin_amdgcn_mfma_f32_32x32x16_bf16(vf, AC2_PA(kq_), O[db_], 0, 0, 0); \
                    if ((g) < 4) { w[8 + 2 * (g)] = cvtpk(p1[4 * (g)], p1[4 * (g) + 1]); w[8 + 2 * (g) + 1] = cvtpk(p1[4 * (g) + 2], p1[4 * (g) + 3]); AC2_PINF(w[8 + 2 * (g)]); AC2_PINF(w[8 + 2 * (g) + 1]); } \
                    __builtin_amdgcn_sched_barrier(0); } while (0)
                AC2_PGAP(0); AC2_PGAP(1); AC2_PGAP(2); AC2_PGAP(3); AC2_PGAP(4); AC2_PGAP(5); AC2_PGAP(6); AC2_PGAP(7);
#undef AC2_PGAP
#undef AC2_PA
#undef AC2_QGAP
#undef AC2_PINF
                p0 = n0; p1 = n1;
            }
#endif
        } else if (actn) AC2_QK(jn, ks ^ 1);
        if (jnn >= 0) { *(LAS u32x4*)(L + A_KOFF + ks * A_KBUF + kdst) = kreg; if (FOX && tid < 64) *(LAS float*)(L + A_BOFF + ks * 256 + tid * 4) = breg; }
        if (jn >= 0) *(LAS u32x4*)(L + A_VOFF + (vs ^ 1) * A_VBUF + vdst) = vreg;
        __syncthreads();
        if (jn < 0) break;
        j = jn; jn = jnn; ks ^= 1; vs ^= 1;
    }
#undef AC2_QK
#undef AC2_INIT
#undef AC2_ACTIVE
}
#define ATTN_FOR_CHUNKS(db, g4) _Pragma("unroll") for (int db = 0; db < 2; ++db) _Pragma("unroll") for (int g4 = 0; g4 < 4; ++g4)

__device__ __forceinline__ void unpack8(const u32x4 w, float (&f)[8]) { f[0] = __uint_as_float(w.x << 16); f[1] = __uint_as_float(w.x & 0xffff0000u); f[2] = __uint_as_float(w.y << 16); f[3] = __uint_as_float(w.y & 0xffff0000u);
    f[4] = __uint_as_float(w.z << 16); f[5] = __uint_as_float(w.z & 0xffff0000u); f[6] = __uint_as_float(w.w << 16); f[7] = __uint_as_float(w.w & 0xffff0000u); }
__device__ __forceinline__ void ph_norm_bf16_from_bf16(const Ctx& c, const bf16* x, const float* g, bf16* out) {
    constexpr int RB = 4; float gg[2][8];
#pragma unroll
    for (int j = 0; j < 2; ++j) { const f32x4 a = ((const f32x4*)g)[2 * c.lane + 128 * j], b2 = ((const f32x4*)g)[2 * c.lane + 128 * j + 1]; gg[j][0] = a.x; gg[j][1] = a.y; gg[j][2] = a.z; gg[j][3] = a.w; gg[j][4] = b2.x; gg[j][5] = b2.y; gg[j][6] = b2.z; gg[j][7] = b2.w; }
    for (int row0 = c.gw * RB; row0 < NT; row0 += c.ngw * RB) {
        u32x4 v[RB][2];
#pragma unroll
        for (int q = 0; q < RB; ++q)
#pragma unroll
            for (int j = 0; j < 2; ++j) v[q][j] = ((const u32x4*)(x + (size_t)(row0 + q) * D_))[c.lane + 64 * j];
#pragma unroll
        for (int q = 0; q < RB; ++q) { float f[2][8]; float ss = 0.f;
#pragma unroll
            for (int j = 0; j < 2; ++j) { unpack8(v[q][j], f[j]);
#pragma unroll
                for (int e = 0; e < 8; ++e) ss = fmaf(f[j][e], f[j][e], ss); }
            const float r = rsqrtf(wave_sum(ss) * (1.f / D_) + EPS);
#pragma unroll
            for (int j = 0; j < 2; ++j) { u32x4 o; o.x = pk2(f[j][0] * r * gg[j][0], f[j][1] * r * gg[j][1]); o.y = pk2(f[j][2] * r * gg[j][2], f[j][3] * r * gg[j][3]); o.z = pk2(f[j][4] * r * gg[j][4], f[j][5] * r * gg[j][5]); o.w = pk2(f[j][6] * r * gg[j][6], f[j][7] * r * gg[j][7]);
                ((u32x4*)(out + (size_t)(row0 + q) * D_))[c.lane + 64 * j] = o; } }
    }
}
__device__ __forceinline__ void ph_norm_final_from_bf16(const Ctx& c, const bf16* x, const float* g, float* out) {
    constexpr int RB = 4; float gg[2][8];
#pragma unroll
    for (int j = 0; j < 2; ++j) { const f32x4 a = ((const f32x4*)g)[2 * c.lane + 128 * j], b2 = ((const f32x4*)g)[2 * c.lane + 128 * j + 1]; gg[j][0] = a.x; gg[j][1] = a.y; gg[j][2] = a.z; gg[j][3] = a.w; gg[j][4] = b2.x; gg[j][5] = b2.y; gg[j][6] = b2.z; gg[j][7] = b2.w; }
    for (int row0 = c.gw * RB; row0 < NT; row0 += c.ngw * RB) {
        u32x4 v[RB][2];
#pragma unroll
        for (int q = 0; q < RB; ++q)
#pragma unroll
            for (int j = 0; j < 2; ++j) v[q][j] = ((const u32x4*)(x + (size_t)(row0 + q) * D_))[c.lane + 64 * j];
#pragma unroll
        for (int q = 0; q < RB; ++q) { float f[2][8]; float ss = 0.f;
#pragma unroll
            for (int j = 0; j < 2; ++j) { unpack8(v[q][j], f[j]);
#pragma unroll
                for (int e = 0; e < 8; ++e) ss = fmaf(f[j][e], f[j][e], ss); }
            const float r = rsqrtf(wave_sum(ss) * (1.f / D_) + EPS);
#pragma unroll
            for (int j = 0; j < 2; ++j) { f32x4* o = (f32x4*)(out + (size_t)(row0 + q) * D_) + 2 * c.lane + 128 * j;
                o[0] = (f32x4){f[j][0] * r * gg[j][0], f[j][1] * r * gg[j][1], f[j][2] * r * gg[j][2], f[j][3] * r * gg[j][3]}; o[1] = (f32x4){f[j][4] * r * gg[j][4], f[j][5] * r * gg[j][5], f[j][6] * r * gg[j][6], f[j][7] * r * gg[j][7]}; } }
    }
}
__device__ __forceinline__ void ph_norm_bf16(const Ctx& c, const float* x, const float* g, bf16* out, bf16* raw) {
    constexpr int RB = 4;
    f32x4 gg[4];
#pragma unroll
    for (int j = 0; j < 4; ++j) gg[j] = ((const f32x4*)g)[c.lane + 64 * j];
    for (int row0 = c.gw * RB; row0 < NT; row0 += c.ngw * RB) {
        f32x4 v[RB][4];
#pragma unroll
        for (int q = 0; q < RB; ++q)
#pragma unroll
            for (int j = 0; j < 4; ++j) v[q][j] = ((const f32x4*)(x + (size_t)(row0 + q) * D_))[c.lane + 64 * j];
#pragma unroll
        for (int q = 0; q < RB; ++q) { float ss = 0.f;
#pragma unroll
            for (int j = 0; j < 4; ++j) ss += v[q][j].x * v[q][j].x + v[q][j].y * v[q][j].y + v[q][j].z * v[q][j].z + v[q][j].w * v[q][j].w;
            const float r = rsqrtf(wave_sum(ss) * (1.f / D_) + EPS);
            u64* o8 = (u64*)(out + (size_t)(row0 + q) * D_) + c.lane; u64* r8 = (u64*)(raw + (size_t)(row0 + q) * D_) + c.lane;
#pragma unroll
            for (int j = 0; j < 4; ++j) { o8[64 * j] = (u64)pk2(v[q][j].x * r * gg[j].x, v[q][j].y * r * gg[j].y) | ((u64)pk2(v[q][j].z * r * gg[j].z, v[q][j].w * r * gg[j].w) << 32);
                r8[64 * j] = (u64)pk2(v[q][j].x, v[q][j].y) | ((u64)pk2(v[q][j].z, v[q][j].w) << 32); } }
    }
}
__device__ __forceinline__ void ph_norm_final(const Ctx& c, float* x, const float* g) {
    constexpr int RB = 4;
    f32x4 gg[4];
#pragma unroll
    for (int j = 0; j < 4; ++j) gg[j] = ((const f32x4*)g)[c.lane + 64 * j];
    for (int row0 = c.gw * RB; row0 < NT; row0 += c.ngw * RB) {
        f32x4 v[RB][4];
#pragma unroll
        for (int q = 0; q < RB; ++q)
#pragma unroll
            for (int j = 0; j < 4; ++j) v[q][j] = ((const f32x4*)(x + (size_t)(row0 + q) * D_))[c.lane + 64 * j];
#pragma unroll
        for (int q = 0; q < RB; ++q) { float ss = 0.f;
#pragma unroll
            for (int j = 0; j < 4; ++j) ss += v[q][j].x * v[q][j].x + v[q][j].y * v[q][j].y + v[q][j].z * v[q][j].z + v[q][j].w * v[q][j].w;
            const float r = rsqrtf(wave_sum(ss) * (1.f / D_) + EPS);
            f32x4* xr = (f32x4*)(x + (size_t)(row0 + q) * D_) + c.lane;
#pragma unroll
            for (int j = 0; j < 4; ++j) xr[64 * j] = v[q][j] * r * gg[j]; }
    }
}

template <class AF, class EF>
__device__ __forceinline__ void naive_gemm(const Ctx& c, int M, int N, int K, AF af, const float* W, int ldb, EF ef) {
    LAS float* As = (LAS float*)c.lds;
    LAS float* Bs = As + 16 * 132;
    const int tm = (M + 127) / 128, tn = (N + 127) / 128, ntile = tm * tn;
    const int ty = c.tid >> 4, tx = c.tid & 15;
    for (int tile = c.bid; tile < ntile; tile += c.G) {
        const int m0 = (tile / tn) * 128, n0 = (tile % tn) * 128;
        float acc[4][8];
#pragma unroll
        for (int i = 0; i < 4; ++i)
#pragma unroll
            for (int j = 0; j < 8; ++j) acc[i][j] = 0.f;
        for (int k0 = 0; k0 < K; k0 += 16) {
            __syncthreads();
#pragma unroll
            for (int i = 0; i < 4; ++i) { const int e = c.tid + i * 512, r = e >> 4, kk = e & 15; const int row = m0 + r;
                As[kk * 132 + r] = (row < M) ? af(row, k0 + kk) : 0.f; }
#pragma unroll
            for (int i = 0; i < 4; ++i) { const int e = c.tid + i * 512, kk = e >> 7, cc = e & 127; const int col = n0 + cc;
                Bs[kk * 132 + cc] = (col < N) ? W[(size_t)(k0 + kk) * ldb + col] : 0.f; }
            __syncthreads();
#pragma unroll 2
            for (int kk = 0; kk < 16; ++kk) {
                float a[4], b[8];
#pragma unroll
                for (int i = 0; i < 4; ++i) a[i] = As[kk * 132 + ty * 4 + i];
#pragma unroll
                for (int j = 0; j < 8; ++j) b[j] = Bs[kk * 132 + tx * 8 + j];
#pragma unroll
                for (int i = 0; i < 4; ++i)
#pragma unroll
                    for (int j = 0; j < 8; ++j) acc[i][j] = fmaf(a[i], b[j], acc[i][j]);
            }
        }
        LAS float* Cs = Bs + 16 * 132;
        __syncthreads();
#pragma unroll
        for (int i = 0; i < 4; ++i)
#pragma unroll
            for (int j = 0; j < 8; ++j) Cs[(ty * 4 + i) * 129 + tx * 8 + j] = acc[i][j];
        __syncthreads();
#pragma unroll 1
        for (int e = c.tid; e < 128 * 128; e += NTHREADS) { const int r = e >> 7, cc = e & 127, row = m0 + r, col = n0 + cc; if (row < M && col < N) ef(row, col, Cs[r * 129 + cc]); }
    }
    __syncthreads();
}

struct InProjOut { bf16* qn; bf16* kv6; bf16* fqkv; bf16* dqk; bf16* dv; float* gate; float* fl; const float* b_gate; const float* b_fgt; };
__device__ __forceinline__ void inproj_store(const InProjOut& o, int n, int col, float v) {
    const int b = n / T_, t = n % T_;
    if (col < C_KV6) { const int h = col >> 6, d = col & 63; o.qn[((size_t)(b * 8 + h) * T_ + t) * 64 + d] = (bf16)f2bf(v * (0.125f * LOG2E)); }
    else if (col < C_GATE) { const int cc = col - C_KV6, idx = cc >> 7, g = (cc >> 6) & 1, d = cc & 63;
        ((bf16*)((unsigned char*)o.kv6 + idx * KV6_STRIDE))[((size_t)(b * 2 + g) * T_ + t) * 64 + d] = (bf16)f2bf(v); }
    else if (col < C_FQ) { const int j = col - C_GATE; o.gate[(size_t)n * 24 + j] = sigmoidf_(v + o.b_gate[j]); }
    else if (col < C_FF) { const int cc = col - C_FQ, idx = cc >> 8, h = (cc >> 6) & 3, d = cc & 63;
        o.fqkv[(size_t)idx * (8 * MiB) + ((size_t)(b * 4 + h) * T_ + t) * 64 + d] = (bf16)f2bf(idx == 0 ? v * (0.125f * LOG2E) : v); }
    else if (col < C_DQ) { const int h = col - C_FF; o.fl[(size_t)(b * 4 + h) * T_ + t] = log_sigmoidf_(v + o.b_fgt[h]); }
    else if (col < C_DV) { const int cc = col - C_DQ, idx = cc >> 8, h = (cc >> 6) & 3, i = (cc >> 5) & 1, d = cc & 31;
        o.dqk[(size_t)idx * (8 * MiB) + ((size_t)((b * 4 + h) * 2 + i) * T_ + t) * 32 + d] = (bf16)f2bf(idx == 0 ? v * (0.17677669529663687f * LOG2E) : v); }
    else { const int cc = col - C_DV, h = cc >> 6, d = cc & 63; o.dv[((size_t)(b * 4 + h) * T_ + t) * 64 + d] = (bf16)f2bf(v); }
}

__device__ __forceinline__ void ph_cumsum(const Ctx& c, float* fl) {
    for (int s = c.gw; s < B_ * 4; s += c.ngw) {
        float* p = fl + (size_t)s * T_; float carry = 0.f;
        for (int t0 = 0; t0 < T_; t0 += 64) {
            float v = p[t0 + c.lane];
#pragma unroll
            for (int o = 1; o < 64; o <<= 1) { const float u = __shfl_up(v, o); if (c.lane >= o) v += u; }
            v += carry; p[t0 + c.lane] = v; carry = __shfl(v, 63);
        }
    }
}

template <int DQK>
__device__ __forceinline__ float naive_attn_row(const bf16* q, const bf16* K, const bf16* V, int t, u64 mask, float slope2, const float* cum, int win, int lane) {
    float qv[DQK];
    { const u32x4* q4 = (const u32x4*)q;
#pragma unroll
      for (int i = 0; i < DQK / 8; ++i) { const u32x4 w = q4[i];
          qv[8 * i + 0] = __uint_as_float(w.x << 16); qv[8 * i + 1] = __uint_as_float(w.x & 0xffff0000u);
          qv[8 * i + 2] = __uint_as_float(w.y << 16); qv[8 * i + 3] = __uint_as_float(w.y & 0xffff0000u);
          qv[8 * i + 4] = __uint_as_float(w.z << 16); qv[8 * i + 5] = __uint_as_float(w.z & 0xffff0000u);
          qv[8 * i + 6] = __uint_as_float(w.w << 16); qv[8 * i + 7] = __uint_as_float(w.w & 0xffff0000u); } }
    const float cumt = cum ? cum[t] : 0.f;
    float m = -INFINITY, l = 0.f, o = 0.f;
    while (mask) {
        const int j = __builtin_ctzll(mask); mask &= mask - 1;
        const int kpos = 64 * j + lane; const int dist = t - kpos;
        const bool valid = dist >= 0 && dist < win;
        float s = 0.f;
        { const u32x4* k4 = (const u32x4*)(K + (size_t)kpos * DQK);
#pragma unroll
          for (int i = 0; i < DQK / 8; ++i) { const u32x4 w = k4[i];
              s = fmaf(qv[8 * i + 0], __uint_as_float(w.x << 16), s); s = fmaf(qv[8 * i + 1], __uint_as_float(w.x & 0xffff0000u), s);
              s = fmaf(qv[8 * i + 2], __uint_as_float(w.y << 16), s); s = fmaf(qv[8 * i + 3], __uint_as_float(w.y & 0xffff0000u), s);
              s = fmaf(qv[8 * i + 4], __uint_as_float(w.z << 16), s); s = fmaf(qv[8 * i + 5], __uint_as_float(w.z & 0xffff0000u), s);
              s = fmaf(qv[8 * i + 6], __uint_as_float(w.w << 16), s); s = fmaf(qv[8 * i + 7], __uint_as_float(w.w & 0xffff0000u), s); } }
        s -= slope2 * (float)dist;
        if (cum) s += (cumt - cum[kpos]) * LOG2E;
        s = valid ? s : -INFINITY;
        const float mb = wave_max(s);
        if (mb == -INFINITY) continue;
        const float mn = fmaxf(m, mb), alpha = exp2f(m - mn);
        const float p = valid ? exp2f(s - mn) : 0.f;
        l = l * alpha + wave_sum(p); o *= alpha; m = mn;
        const bf16* vb = V + (size_t)(64 * j) * 64 + lane;
#pragma unroll 8
        for (int k = 0; k < 64; ++k) o = fmaf(__shfl(p, k), bf2f(vb[(size_t)k * 64]), o);
    }
    return l > 0.f ? o / l : 0.f;
}

__device__ __forceinline__ void ph_cmp_attn(const Ctx& c, const bf16* qn, const bf16* kcmp, const bf16* vcmp, const float* gate, u64* sel, bf16* ocmp) {
    LAS float* pl = (LAS float*)(c.lds) + c.wave * 256;
    const int lane = c.lane;
    for (int it = c.gw; it < B_ * 2 * T_; it += c.ngw) {
        const int t = it % T_, bg = it / T_, b = bg >> 1, g = bg & 1;
        const int nvis = (t >= 31) ? ((t - 31) >> 4) + 1 : 0;
        const bf16* kc = kcmp + (size_t)bg * 256 * 64; const bf16* vc = vcmp + (size_t)bg * 256 * 64;
        float imp = 0.f;
        for (int hg = 0; hg < 4; ++hg) {
            const int h = g * 4 + hg; const float slope2 = alibi_slope(h + 1, 8) * LOG2E;
            const bf16* q = qn + ((size_t)(b * 8 + h) * T_ + t) * 64;
            float qv[64];
            { const u32x4* q4 = (const u32x4*)q;
#pragma unroll
              for (int i = 0; i < 8; ++i) { const u32x4 w = q4[i];
                  qv[8 * i + 0] = __uint_as_float(w.x << 16); qv[8 * i + 1] = __uint_as_float(w.x & 0xffff0000u);
                  qv[8 * i + 2] = __uint_as_float(w.y << 16); qv[8 * i + 3] = __uint_as_float(w.y & 0xffff0000u);
                  qv[8 * i + 4] = __uint_as_float(w.z << 16); qv[8 * i + 5] = __uint_as_float(w.z & 0xffff0000u);
                  qv[8 * i + 6] = __uint_as_float(w.w << 16); qv[8 * i + 7] = __uint_as_float(w.w & 0xffff0000u); } }
            float s[4]; float m = -INFINITY;
#pragma unroll
            for (int i = 0; i < 4; ++i) { const int cc = lane + 64 * i; float a = 0.f;
                if (cc < nvis) { const u32x4* k4 = (const u32x4*)(kc + (size_t)cc * 64);
#pragma unroll
                    for (int e = 0; e < 8; ++e) { const u32x4 w = k4[e];
                        a = fmaf(qv[8 * e + 0], __uint_as_float(w.x << 16), a); a = fmaf(qv[8 * e + 1], __uint_as_float(w.x & 0xffff0000u), a);
                        a = fmaf(qv[8 * e + 2], __uint_as_float(w.y << 16), a); a = fmaf(qv[8 * e + 3], __uint_as_float(w.y & 0xffff0000u), a);
                        a = fmaf(qv[8 * e + 4], __uint_as_float(w.z << 16), a); a = fmaf(qv[8 * e + 5], __uint_as_float(w.z & 0xffff0000u), a);
                        a = fmaf(qv[8 * e + 6], __uint_as_float(w.w << 16), a); a = fmaf(qv[8 * e + 7], __uint_as_float(w.w & 0xffff0000u), a); }
                    a -= slope2 * (float)(t - (16 * cc + 31)); } else a = -INFINITY;
                s[i] = a; m = fmaxf(m, a); }
            m = wave_max(m);
            float p[4], lsum = 0.f;
#pragma unroll
            for (int i = 0; i < 4; ++i) { p[i] = (lane + 64 * i < nvis) ? exp2f(s[i] - m) : 0.f; lsum += p[i]; }
            lsum = wave_sum(lsum);
            const float inv = lsum > 0.f ? 1.f / lsum : 0.f;
#pragma unroll
            for (int i = 0; i < 4; ++i) { p[i] *= inv; pl[lane + 64 * i] = p[i]; }
            asm volatile("s_waitcnt lgkmcnt(0)" ::: "memory");
            float o = 0.f;
            for (int cc = 0; cc < nvis; ++cc) o = fmaf(pl[cc], bf2f(vc[(size_t)cc * 64 + lane]), o);
            const float gt = gate[((size_t)(b * T_ + t)) * 24 + h * 3 + 0];
            ocmp[(size_t)(b * T_ + t) * 512 + h * 64 + lane] = (bf16)f2bf(gt * o);
            { const int j = lane; float a = pl[4 * j] + pl[4 * j + 1] + pl[4 * j + 2] + 0.5f * pl[4 * j + 3]; if (j > 0) a += 0.5f * pl[4 * j - 1]; imp += a; }
            asm volatile("s_waitcnt lgkmcnt(0)" ::: "memory");
        }
        const int cur = t >> 6; const int j = lane;
        u64 m64;
        if (cur <= 15) m64 = (cur == 63) ? ~0ull : ((1ull << (cur + 1)) - 1ull);
        else {
            float val = (j > cur) ? -INFINITY : ((j == 0 || j == cur || j == cur - 1) ? 1e4f : imp);
            m64 = 0ull;
            for (int r = 0; r < 16; ++r) {
                const float mx = wave_max(val);
                const u64 bal = __ballot(val == mx);
                const int w = __builtin_ctzll(bal);
                m64 |= 1ull << w; if (j == w) val = -INFINITY;
            }
        }
        if (lane == 0) sel[(size_t)bg * T_ + t] = m64;
    }
}

__device__ __forceinline__ void ph_win_attn(const Ctx& c, const bf16* qn, const bf16* kw, const bf16* vw, const float* gate, bf16* owin) {
    for (int it = c.gw; it < B_ * 8 * T_; it += c.ngw) {
        const int t = it % T_, bh = it / T_, b = bh >> 3, h = bh & 7, g = h >> 2;
        const int cur = t >> 6, jlo = (t - 511) > 0 ? (t - 511) >> 6 : 0;
        const u64 hi = (cur == 63) ? ~0ull : ((1ull << (cur + 1)) - 1ull); const u64 mask = hi & ~((1ull << jlo) - 1ull);
        const float o = naive_attn_row<64>(qn + ((size_t)bh * T_ + t) * 64, kw + (size_t)(b * 2 + g) * T_ * 64, vw + (size_t)(b * 2 + g) * T_ * 64, t, mask,
                                           alibi_slope(h + 1, 8) * LOG2E, nullptr, 512, c.lane);
        owin[(size_t)(b * T_ + t) * 512 + h * 64 + c.lane] = (bf16)f2bf(gate[(size_t)(b * T_ + t) * 24 + h * 3 + 2] * o);
    }
}
__device__ __forceinline__ void ph_slc_attn(const Ctx& c, const bf16* qn, const bf16* ks, const bf16* vs, const float* gate, const u64* sel, const bf16* ocmp, const bf16* owin, bf16* att) {
    for (int it = c.gw; it < B_ * 8 * T_; it += c.ngw) {
        const int t = it % T_, bh = it / T_, b = bh >> 3, h = bh & 7, g = h >> 2;
        const u64 mask = sel[(size_t)(b * 2 + g) * T_ + t];
        const float o = naive_attn_row<64>(qn + ((size_t)bh * T_ + t) * 64, ks + (size_t)(b * 2 + g) * T_ * 64, vs + (size_t)(b * 2 + g) * T_ * 64, t, mask,
                                           alibi_slope(h + 1, 8) * LOG2E, nullptr, 1 << 30, c.lane);
        const size_t n = (size_t)(b * T_ + t);
        const float r = gate[n * 24 + h * 3 + 1] * o + bf2f(ocmp[n * 512 + h * 64 + c.lane]) + bf2f(owin[n * 512 + h * 64 + c.lane]);
        att[n * 1024 + h * 64 + c.lane] = (bf16)f2bf(r);
    }
}
__device__ __forceinline__ void ph_fox_attn(const Ctx& c, const bf16* fq, const bf16* fk, const bf16* fv, const float* cum, bf16* att) {
    for (int it = c.gw; it < B_ * 4 * T_; it += c.ngw) {
        const int t = it % T_, bh = it / T_, b = bh >> 2, h = bh & 3;
        const int cur = t >> 6; const u64 mask = (cur == 63) ? ~0ull : ((1ull << (cur + 1)) - 1ull);
        const float o = naive_attn_row<64>(fq + ((size_t)bh * T_ + t) * 64, fk + (size_t)bh * T_ * 64, fv + (size_t)bh * T_ * 64, t, mask, 0.f, cum + (size_t)bh * T_, 1 << 30, c.lane);
        att[(size_t)(b * T_ + t) * 1024 + 512 + h * 64 + c.lane] = (bf16)f2bf(o);
    }
}
__device__ __forceinline__ void ph_diff_attn(const Ctx& c, const bf16* dq, const bf16* dk, const bf16* dv, const float* lam, const float* subln, float lambda_init, bf16* att) {
    float l1 = 0.f, l2 = 0.f;
    if (c.lane < 32) { l1 = lam[c.lane] * lam[32 + c.lane]; l2 = lam[64 + c.lane] * lam[96 + c.lane]; }
    const float lam_full = __expf(wave_sum(l1)) - __expf(wave_sum(l2)) + lambda_init;
    const float sg = subln[c.lane] * (1.f - lambda_init);
    for (int it = c.gw; it < B_ * 4 * T_; it += c.ngw) {
        const int t = it % T_, bh = it / T_, b = bh >> 2, h = bh & 3;
        const int cur = t >> 6; const u64 mask = (cur == 63) ? ~0ull : ((1ull << (cur + 1)) - 1ull);
        const float slope2 = alibi_slope(h + 1, 4) * LOG2E;
        const bf16* vb = dv + (size_t)bh * T_ * 64;
        const float o1 = naive_attn_row<32>(dq + ((size_t)(bh * 2 + 0) * T_ + t) * 32, dk + (size_t)(bh * 2 + 0) * T_ * 32, vb, t, mask, slope2, nullptr, 1 << 30, c.lane);
        const float o2 = naive_attn_row<32>(dq + ((size_t)(bh * 2 + 1) * T_ + t) * 32, dk + (size_t)(bh * 2 + 1) * T_ * 32, vb, t, mask, slope2, nullptr, 1 << 30, c.lane);
        const float o = o1 - lam_full * o2;
        const float r = rsqrtf(wave_sum(o * o) * (1.f / 64.f) + EPS);
        att[(size_t)(b * T_ + t) * 1024 + 768 + h * 64 + c.lane] = (bf16)f2bf(o * r * sg);
    }
}

__device__ __forceinline__ void ph_moe_route(const Ctx& c, const float* x, const float* g, const float* wgrp, const float* bgrp, const float* wexp, const float* bexp, bf16* hn, int* route_e, float* route_w, unsigned* cnt) {
    for (int row = c.gw; row < NT; row += c.ngw) {
        const f32x4* xr = (const f32x4*)(x + (size_t)row * D_) + c.lane;
        f32x4 v[4]; float ss = 0.f;
#pragma unroll
        for (int j = 0; j < 4; ++j) { v[j] = xr[64 * j]; ss += v[j].x * v[j].x + v[j].y * v[j].y + v[j].z * v[j].z + v[j].w * v[j].w; }
        const float r = rsqrtf(wave_sum(ss) * (1.f / D_) + EPS);
        u64* o8 = (u64*)(hn + (size_t)row * D_) + c.lane;
#pragma unroll
        for (int j = 0; j < 4; ++j) { const f32x4 gg = ((const f32x4*)g)[c.lane + 64 * j]; v[j] = v[j] * r * gg;
            o8[64 * j] = (u64)pk2(v[j].x, v[j].y) | ((u64)pk2(v[j].z, v[j].w) << 32); }
        float gl[4];
#pragma unroll
        for (int q = 0; q < 4; ++q) { float a = 0.f;
#pragma unroll
            for (int j = 0; j < 4; ++j) { const int k = 4 * (c.lane + 64 * j);
                a = fmaf(v[j].x, wgrp[(size_t)(k + 0) * 4 + q], a); a = fmaf(v[j].y, wgrp[(size_t)(k + 1) * 4 + q], a);
                a = fmaf(v[j].z, wgrp[(size_t)(k + 2) * 4 + q], a); a = fmaf(v[j].w, wgrp[(size_t)(k + 3) * 4 + q], a); }
            gl[q] = wave_sum(a) + bgrp[q]; }
        int grp = 0; float gm = gl[0];
#pragma unroll
        for (int q = 1; q < 4; ++q) if (gl[q] > gm) { gm = gl[q]; grp = q; }
        float gs = 0.f;
#pragma unroll
        for (int q = 0; q < 4; ++q) gs += __expf(gl[q] - gm);
        const float grp_gate = 1.f / gs;
        float el[8];
#pragma unroll
        for (int q = 0; q < 8; ++q) { float a = 0.f; const int col = grp * 8 + q;
#pragma unroll
            for (int j = 0; j < 4; ++j) { const int k = 4 * (c.lane + 64 * j);
                a = fmaf(v[j].x, wexp[(size_t)(k + 0) * 32 + col], a); a = fmaf(v[j].y, wexp[(size_t)(k + 1) * 32 + col], a);
                a = fmaf(v[j].z, wexp[(size_t)(k + 2) * 32 + col], a); a = fmaf(v[j].w, wexp[(size_t)(k + 3) * 32 + col], a); }
            el[q] = wave_sum(a) + bexp[col]; }
        int i0 = 0; float v0 = el[0];
#pragma unroll
        for (int q = 1; q < 8; ++q) if (el[q] > v0) { v0 = el[q]; i0 = q; }
        int i1 = -1; float v1 = -INFINITY;
#pragma unroll
        for (int q = 0; q < 8; ++q) if (q != i0 && el[q] > v1) { v1 = el[q]; i1 = q; }
        const float e1 = __expf(v1 - v0), den = 1.f + e1;
        if (c.lane == 0) { const float w0 = grp_gate / den, w1 = grp_gate * e1 / den;
            const int lo = i0 < i1 ? i0 : i1, hi = i0 < i1 ? i1 : i0, cls = grp * 28 + lo * 8 - (lo * (lo + 1)) / 2 + (hi - lo - 1);
            const unsigned rank = __hip_atomic_fetch_add(cnt + cls, 1u, __ATOMIC_RELAXED, __HIP_MEMORY_SCOPE_AGENT);
            route_e[row] = (int)(((unsigned)cls << 24) | rank); route_w[2 * row] = i0 < i1 ? w0 : w1; route_w[2 * row + 1] = i0 < i1 ? w1 : w0; }
    }
}
__device__ __forceinline__ void ph_moe_naive(const Ctx& c, const bf16* hn, const int* route_e, const float* route_w, const float* wg, const float* wu, const float* wd, float* x) {
    LAS float* hs = (LAS float*)c.lds;
    LAS float* au = hs + 1024;
    LAS float* h2 = au + 512;
    for (int row = c.bid; row < NT; row += c.G) {
        __syncthreads();
        hs[c.tid] = bf2f(hn[(size_t)row * D_ + c.tid]); hs[c.tid + 512] = bf2f(hn[(size_t)row * D_ + c.tid + 512]);
        float o0 = 0.f, o1 = 0.f;
        for (int s = 0; s < 2; ++s) {
            const int e = route_e[2 * row + s]; const float w = route_w[2 * row + s];
            __syncthreads();
            const float* W = (c.tid < 256 ? wg : wu) + (size_t)e * D_ * DEXP + (c.tid & 255);
            float a = 0.f;
            for (int k = 0; k < D_; ++k) a = fmaf(hs[k], W[(size_t)k * DEXP], a);
            au[c.tid] = a;
            __syncthreads();
            if (c.tid < 256) { const float ga = au[c.tid], up = au[c.tid + 256]; h2[c.tid] = ga / (1.f + __expf(-ga)) * up * w; }
            __syncthreads();
            const float* Wd = wd + (size_t)e * DEXP * D_;
            for (int k = 0; k < DEXP; ++k) { const float hv = h2[k]; o0 = fmaf(hv, Wd[(size_t)k * D_ + c.tid], o0); o1 = fmaf(hv, Wd[(size_t)k * D_ + c.tid + 512], o1); }
        }
        x[(size_t)row * D_ + c.tid] += o0; x[(size_t)row * D_ + c.tid + 512] += o1;
    }
    __syncthreads();
}

typedef __attribute__((address_space(4))) const Params* KP;
__device__ __forceinline__ KP uni_kp(KP p) { const unsigned long long v = (unsigned long long)p; const unsigned lo = __builtin_amdgcn_readfirstlane((unsigned)v), hi = __builtin_amdgcn_readfirstlane((unsigned)(v >> 32)); return (KP)(((unsigned long long)hi << 32) | lo); }
constexpr int PH_PER_LAYER = 11, N_PHASES = L_ * PH_PER_LAYER + 2;
__device__ __forceinline__ Ctx make_ctx(KP p) {
    Ctx c; c.lds = (LAS unsigned char*)lds_raw; { int t_ = threadIdx.x; asm volatile("" : "+v"(t_)); c.tid = t_; } c.lane = c.tid & 63; c.wave = __builtin_amdgcn_readfirstlane(c.tid >> 6);
    c.bid = blockIdx.x; c.G = gridDim.x; c.gw = c.bid * NWAVES + c.wave; c.ngw = c.G * NWAVES; c.in = nullptr; c.xcur = p->out; c.ws = p->ws;
    return c;
}
struct Bufs {
    bf16 *QN, *KV6, *KC, *VC, *KS, *VS, *KW, *VW, *FQ, *FK, *FV, *DQ, *DK, *DV, *HC, *KCMP, *VCMP, *OCMP, *OWIN, *HN, *ATT;
    float *GATE, *FL, *ROUTE_W; u64* SEL; int* ROUTE_E;
};
__device__ __forceinline__ Bufs make_bufs(unsigned char* ws) {
    Bufs b;
    b.QN = (bf16*)(ws + WS_QN); b.KV6 = (bf16*)(ws + WS_KV6);
    b.KC = (bf16*)(ws + WS_KV6 + 0 * KV6_STRIDE); b.VC = (bf16*)(ws + WS_KV6 + 1 * KV6_STRIDE);
    b.KS = (bf16*)(ws + WS_KV6 + 2 * KV6_STRIDE); b.VS = (bf16*)(ws + WS_KV6 + 3 * KV6_STRIDE);
    b.KW = (bf16*)(ws + WS_KV6 + 4 * KV6_STRIDE); b.VW = (bf16*)(ws + WS_KV6 + 5 * KV6_STRIDE);
    b.FQ = (bf16*)(ws + WS_FQKV); b.FK = b.FQ + 8 * MiB; b.FV = b.FQ + 16 * MiB;
    b.DQ = (bf16*)(ws + WS_DQK); b.DK = b.DQ + 8 * MiB; b.DV = (bf16*)(ws + WS_DV);
    b.GATE = (float*)(ws + WS_GATE); b.FL = (float*)(ws + WS_FL);
    b.HC = (bf16*)(ws + WS_HC); b.KCMP = (bf16*)(ws + WS_KVCMP); b.VCMP = b.KCMP + 16 * 256 * 64;
    b.SEL = (u64*)(ws + WS_SEL); b.OCMP = (bf16*)(ws + WS_OCMP); b.OWIN = (bf16*)(ws + WS_OWIN);
    b.HN = (bf16*)(ws + WS_HN); b.ATT = (bf16*)(ws + WS_ATT);
    b.ROUTE_E = (int*)(ws + WS_ROUTE); b.ROUTE_W = (float*)(ws + WS_ROUTE + 512 * 1024);
    return b;
}
__device__ __forceinline__ float lambda_init_of(int l) { return l == 0 ? 0.2f : 0.35550906759096926f; }

__device__ __noinline__ void P_prologue(KP p_) { const KP p = uni_kp(p_);
    const Ctx c = make_ctx(p); unsigned char* ws = p->ws;
    LAS float* scr = (LAS float*)(c.lds) + c.wave * (64 * 33);
    constexpr int I_A = 16 * 40, I_B = 16 * 24, I_C = 16 * 24, I_O = 16 * 32, I_G = 16 * 8, I_D = 4 * 32, I_E = 2 * I_G + I_D, I_W1 = 32 * 8, I_W2 = 4 * 2;
    constexpr int PER_L = I_A + I_B + I_C + I_O + NEXP * I_E + 2 * (I_W1 + I_W2);
    for (int it = c.gw; it < L_ * PER_L; it += c.ngw) {
        const int l = it / PER_L; int r = it % PER_L;
        const float* W; bf16* WT; int ldw, K, sc0, ncol, r0 = 0, rmul = 1;
        if (r < I_A + I_B + I_C) { W = p->in[2] + (size_t)l * D_ * D_IN; WT = (bf16*)(ws + WS_WIN_T) + (size_t)l * NIN * D_; ldw = D_IN; K = D_;
            if (r < I_A) { sc0 = 0; ncol = 1280; r0 = 0; } else if (r < I_A + I_B) { r -= I_A; sc0 = C_FQ; ncol = 768; r0 = 1280; } else { r -= I_A + I_B; sc0 = C_DQ; ncol = 768; r0 = 2048; } }
        else if ((r -= I_A + I_B + I_C) < I_O) { W = p->in[13] + (size_t)l * D_ * D_; WT = (bf16*)(ws + WS_WOUT_T) + (size_t)l * D_ * D_; ldw = D_; K = D_; sc0 = 0; ncol = 1024; }
        else if ((r -= I_O) < NEXP * I_E) { const int e = r / I_E; r = r % I_E; const size_t le = (size_t)l * NEXP + e;
            if (r < 2 * I_G) { const int up = r >= I_G; r -= up * I_G; W = p->in[19 + up] + le * D_ * DEXP; WT = (bf16*)(ws + WS_WGU_T) + le * 512 * D_; ldw = DEXP; K = D_; sc0 = 0; ncol = 256; r0 = up; rmul = 2; }
            else { r -= 2 * I_G; W = p->in[21] + le * DEXP * D_; WT = (bf16*)(ws + WS_WD_T) + le * D_ * DEXP; ldw = D_; K = DEXP; sc0 = 0; ncol = 1024; } }
        else { r -= NEXP * I_E; const int kv = r / (I_W1 + I_W2); r = r % (I_W1 + I_W2); const size_t lk = (size_t)l * 2 + kv;
            if (r < I_W1) { W = p->in[kv == 0 ? 6 : 9] + (size_t)l * 2048 * 256; WT = (bf16*)(ws + WS_W1_T) + lk * 256 * 2048; ldw = 256; K = 2048; sc0 = 0; ncol = 256; }
            else { r -= I_W1; W = p->in[kv == 0 ? 7 : 10] + (size_t)l * 256 * 64; WT = (bf16*)(ws + WS_W2_T) + lk * 64 * 256; ldw = 64; K = 256; sc0 = 0; ncol = 64; } }
        transpose_seg(W, ldw, K, sc0, ncol, WT, r0, rmul, r, scr, c.lane);
    }
    for (int i = c.bid * NTHREADS + c.tid; i < L_ * 256 * D_; i += c.G * NTHREADS) {
        const int l = i / (256 * D_), rr = (i / D_) % 256, k = i % D_;
        const float* win = p->in[2] + (size_t)l * D_ * D_IN;
        float v = 0.f; if (rr < 24) v = win[(size_t)k * D_IN + C_GATE + rr]; else if (rr < 28) v = win[(size_t)k * D_IN + C_FF + (rr - 24)];
        ((bf16*)(ws + WS_WIN_T))[((size_t)l * NIN + 2816 + rr) * D_ + k] = (bf16)f2bf(v);
    }
    for (int w = c.gw; w < L_ * 2 * 4 * 128; w += c.ngw) {
        const int lk = w >> 9, cg = (w >> 7) & 3, kc = w & 127, l = lk >> 1, kv = lk & 1, j = cg * 64 + c.lane;
        const float* pe = p->in[kv == 0 ? 5 : 8] + (size_t)l * 2048 + kc * 16; const float* w1 = p->in[kv == 0 ? 6 : 9] + (size_t)l * 2048 * 256 + (size_t)kc * 16 * 256;
        float a = 0.f;
#pragma unroll
        for (int k = 0; k < 16; ++k) a = fmaf(pe[k], w1[(size_t)k * 256 + j], a);
        ((float*)(ws + WS_B1PART))[((size_t)lk * 128 + kc) * 256 + j] = a;
    }
    for (int i = c.bid * NTHREADS + c.tid; i < L_ * 64 * 2 * 64; i += c.G * NTHREADS) {
        const int l = i / (64 * 2 * 64), ks = (i / 128) % 64, cb = (i / 64) & 1, lane = i & 63, col = 32 * cb + (lane & 31);
        unsigned hi[4], lo[4];
#pragma unroll
        for (int jp = 0; jp < 4; ++jp) { float v[2];
#pragma unroll
            for (int e = 0; e < 2; ++e) { const int k = 16 * ks + 8 * (lane >> 5) + 2 * jp + e; const float g = p->in[14][(size_t)l * D_ + k];
                v[e] = col < 4 ? g * p->in[15][((size_t)l * D_ + k) * 4 + col] : (col < 36 ? g * p->in[17][((size_t)l * D_ + k) * 32 + (col - 4)] : 0.f); }
            const unsigned h0 = f2bf(v[0]), h1 = f2bf(v[1]); hi[jp] = h0 | (h1 << 16);
            lo[jp] = f2bf(v[0] - __uint_as_float(h0 << 16)) | (f2bf(v[1] - __uint_as_float(h1 << 16)) << 16); }
        u32x4* dst = (u32x4*)(ws + WS_WR) + ((size_t)((l * 64 + ks) * 2 + cb) * 2) * 64 + lane;
        dst[0] = (u32x4){hi[0], hi[1], hi[2], hi[3]}; dst[64] = (u32x4){lo[0], lo[1], lo[2], lo[3]};
    }
}
__device__ __forceinline__ void P_inproj_mfma(int l_) { const KP p = (KP)__builtin_amdgcn_kernarg_segment_ptr(); int l = l_; asm volatile("" : "+s"(l));
    unsigned char* ws = p->ws; asm volatile("" : "+s"(ws));
    PlainOrder S; S.init(p->out, (const bf16*)(ws + WS_WIN_T) + (size_t)l * NIN * D_, D_, D_, NT, NIN, (int)gridDim.x, launder_s((int)blockIdx.x));
#ifdef STAGGER_TICKS
    { const unsigned long long t0 = __builtin_amdgcn_s_memrealtime(); const unsigned long long d = (unsigned long long)((launder_s((int)blockIdx.x) >> 3) & 3) * STAGGER_TICKS;
      while (__builtin_amdgcn_s_memrealtime() - t0 < d) __builtin_amdgcn_s_sleep(4); }
#endif
    const pg8::Gemm g{D_, D_, D_, D_ / 64};
    const EpiInProj E{ws, p->in[3] + l * 24, p->in[4] + l * 4, (unsigned*)(ws + WS_CTL) + CW_KN + l * 8192};
    pg8::gemm_phase<EpiInProj, PlainOrder, INPROJ_ALIGN, INPROJ_SP2>((LAS unsigned char*)lds_raw, g, S, E);
}
__device__ __forceinline__ void P_inproj_dummy(int l_) { const KP p = (KP)__builtin_amdgcn_kernarg_segment_ptr(); int l = l_; asm volatile("" : "+s"(l));
    unsigned char* ws = p->ws; asm volatile("" : "+s"(ws));
    PlainOrder S; S.init(p->out, (const bf16*)(ws + WS_WIN_T) + (size_t)l * NIN * D_, D_, D_, NT, NIN, (int)gridDim.x, launder_s((int)blockIdx.x));
    const pg8::Gemm g{D_, D_, D_, D_ / 64};
    const EpiDummy E{(float*)(ws + WS_HB)};
    pg8::gemm_phase<EpiDummy, PlainOrder, true, true>((LAS unsigned char*)lds_raw, g, S, E);
}
__device__ __forceinline__ void P_outproj_mfma(int l_) { const KP p = (KP)__builtin_amdgcn_kernarg_segment_ptr(); int l = l_; asm volatile("" : "+s"(l));
    unsigned char* ws = p->ws; asm volatile("" : "+s"(ws));
    PlainOrder S; S.init(ws + WS_ATT, (const bf16*)(ws + WS_WOUT_T) + (size_t)l * D_ * D_, D_, D_, NT, D_, (int)gridDim.x, launder_s((int)blockIdx.x));
    const pg8::Gemm g{D_, D_, D_, D_ / 64};
    const EpiResBf16 E{(bf16*)(ws + WS_HN)};
    pg8::gemm_phase<EpiResBf16, PlainOrder, true, true>((LAS unsigned char*)lds_raw, g, S, E);
}
__device__ __forceinline__ float wave_max_l(float v, int lane) {
#pragma unroll
    for (int o = 1; o < 64; o <<= 1) v = fmaxf(v, shflx_f(v, o, lane));
    return v;
}
__device__ __forceinline__ float wave_min_l(float v, int lane) {
#pragma unroll
    for (int o = 1; o < 64; o <<= 1) v = fminf(v, shflx_f(v, o, lane));
    return v;
}
template <int NS> __device__ __forceinline__ float q_norm2_max(const bf16x8v (&Q)[NS], int lane) {
    float ss = 0.f;
#pragma unroll
    for (int s = 0; s < NS; ++s)
#pragma unroll
        for (int e = 0; e < 8; ++e) { const float v = __uint_as_float(((unsigned)(unsigned short)Q[s][e]) << 16); ss = fmaf(v, v, ss); }
    return wave_max_l(swap_sum(ss), lane);
}
__device__ __forceinline__ u64 prune_consensus(bool skip, LAS u64* slots, int wave, int lane) {
    const u64 mine = __ballot(skip);
    __syncthreads();
    if (lane == 0) slots[wave] = mine;
    __syncthreads();
    u64 all = slots[0];
#pragma unroll
    for (int w = 1; w < NWAVES; ++w) all &= slots[w];
    return all;
}
__device__ __forceinline__ void U_fox(KP p_, int bh_, int qb_, int l_) {
    const KP p = uni_kp(p_); const int bh = __builtin_amdgcn_readfirstlane(bh_), qb = __builtin_amdgcn_readfirstlane(qb_), l = __builtin_amdgcn_readfirstlane(l_);
    int tid_ = threadIdx.x; asm volatile("" : "+v"(tid_));
    const int tid = tid_, lane = tid & 63, wave = __builtin_amdgcn_readfirstlane(tid >> 6), r = lane & 31, h = lane >> 5;
    unsigned char* ws = p->ws; asm volatile("" : "+s"(ws)); LAS unsigned char* L = (LAS unsigned char*)lds_raw;
    const int tw0 = 256 * qb + 32 * wave, t_lane = tw0 + r, b = bh >> 2, hd = bh & 3;
    const bf16* q = (const bf16*)(ws + WS_FQKV) + (size_t)bh * T_ * 64 + (t_lane >> 4) * 1024 + (t_lane & 15) * 32 + 8 * h;
    bf16x8v Qf[1][4];
#pragma unroll
    for (int s = 0; s < 4; ++s) Qf[0][s] = *(const bf16x8v*)(q + (s >> 1) * 512 + (s & 1) * 16);
    LAS float* cum = (LAS float*)(L + A_LDS_END);
    { const float* fl = (const float*)(ws + WS_FL) + (size_t)bh * T_; LAS float* tot = cum + 4096;
      const int nval = 256 * (qb + 1); float v[8];
      if (8 * tid < nval) { const f32x4 a = *(const f32x4*)(fl + 8 * tid), c2 = *(const f32x4*)(fl + 8 * tid + 4); v[0] = a.x; v[1] = a.y; v[2] = a.z; v[3] = a.w; v[4] = c2.x; v[5] = c2.y; v[6] = c2.z; v[7] = c2.w; }
      else {
#pragma unroll
          for (int i = 0; i < 8; ++i) v[i] = 0.f; }
#pragma unroll
      for (int i = 1; i < 8; ++i) v[i] += v[i - 1];
      float sc = v[7];
#pragma unroll
      for (int o = 1; o < 64; o <<= 1) { const float up = __uint_as_float((unsigned)__builtin_amdgcn_ds_bpermute((lane - o) << 2, (int)__float_as_uint(sc))); if (lane >= o) sc += up; }
      if (lane == 63) tot[wave] = sc;
      __syncthreads();
      float base = sc - v[7];
      for (int w = 0; w < wave; ++w) base += tot[w];
      if (8 * tid < nval) {
#pragma unroll
          for (int i = 0; i < 8; ++i) cum[8 * tid + i] = v[i] + base; }
      __syncthreads(); }
    f32x16 O[1][2]; float M[1] = {0.f}, Ls[1] = {0.f};
#pragma unroll
    for (int i = 0; i < 16; ++i) { O[0][0][i] = 0.f; O[0][1][i] = 0.f; }
    const u64 tm = (qb == 15) ? ~0ull : ((1ull << (4 * qb + 4)) - 1ull);
#if AC2_MODE == 0
    {
        const u64 low = (1ull << (4 * qb)) - 1ull; const float cref = cum[256 * qb];
        const bf16* Kp = (const bf16*)(ws + WS_FQKV) + 8 * MiB + (size_t)bh * T_ * 64; const bf16* Vp = (const bf16*)(ws + WS_FQKV) + 16 * MiB + (size_t)bh * T_ * 64;
        attn_core<64, 1, true, false>(L, Kp, nullptr, Vp, cum, cref, Qf, tm & ~low, t_lane, tw0, 1 << 30, 0.f, 0u, 0u, O, M, Ls, tid);
        if (qb > 0) {
            const float qn2 = q_norm2_max<4>(Qf[0], lane), mmin = wave_min_l(M[0], lane);
            const float* kn = (const float*)((const unsigned*)(ws + WS_CTL) + CW_KN + l * 8192) + ((size_t)bh * 64 + lane) * 2;
            bool skip = false;
            if (lane < 4 * qb) { const float kn2 = kn[0] + kn[1]; const float bound = sqrtf(qn2 * kn2) * 1.02f + (cref - cum[64 * lane + 63]) * LOG2E - mmin; skip = bound < -152.f; }
            const u64 drop = prune_consensus(skip, (LAS u64*)(cum + 4096 + 16), wave, lane);
            const u64 tm2 = low & ~drop;
            if (tm2) attn_core<64, 1, true, false>(L, Kp, nullptr, Vp, cum, cref, Qf, tm2, t_lane, tw0, 1 << 30, 0.f, 0u, 0u, O, M, Ls, tid, true);
        }
    }
#else
    attn_core2<true, false>(L, (const bf16*)(ws + WS_FQKV) + 8 * MiB + (size_t)bh * T_ * 64, (const bf16*)(ws + WS_FQKV) + 16 * MiB + (size_t)bh * T_ * 64, cum, cum[256 * qb],
                            Qf[0], tm, t_lane, tw0, 1 << 30, 0.f, 0u, 0u, O[0], M[0], Ls[0], tid);
#endif
    const float lt = swap_sum(Ls[0]), inv = lt > 0.f ? 1.f / lt : 0.f;
    bf16* dst = (bf16*)(ws + WS_ATT) + ((size_t)b * T_ + t_lane) * 1024 + 512 + hd * 64 + 4 * h;
    ATTN_FOR_CHUNKS(db, g4) { const unsigned w0 = cvtpk(O[0][db][4 * g4 + 0] * inv, O[0][db][4 * g4 + 1] * inv), w1 = cvtpk(O[0][db][4 * g4 + 2] * inv, O[0][db][4 * g4 + 3] * inv);
        *(u64*)(dst + 32 * db + 8 * g4) = (u64)w0 | ((u64)w1 << 32); }
}
__device__ __forceinline__ void U_diff(KP p_, int bh_, int qb_, int l_) {
    const KP p = uni_kp(p_); const int bh = __builtin_amdgcn_readfirstlane(bh_), qb = __builtin_amdgcn_readfirstlane(qb_), l = __builtin_amdgcn_readfirstlane(l_);
    int tid_ = threadIdx.x; asm volatile("" : "+v"(tid_));
    const int tid = tid_, lane = tid & 63, wave = __builtin_amdgcn_readfirstlane(tid >> 6), r = lane & 31, h = lane >> 5;
    unsigned char* ws = p->ws; asm volatile("" : "+s"(ws)); LAS unsigned char* L = (LAS unsigned char*)lds_raw;
    const int tw0 = 256 * qb + 32 * wave, t_lane = tw0 + r, b = bh >> 2, hd = bh & 3;
    const bf16* DQ = (const bf16*)(ws + WS_DQK); const bf16* DK = DQ + 8 * MiB;
    bf16x8v Qf[2][2];
#pragma unroll
    for (int mp = 0; mp < 2; ++mp)
#pragma unroll
        for (int s = 0; s < 2; ++s) Qf[mp][s] = *(const bf16x8v*)(DQ + ((size_t)(bh * 2 + mp) * T_ + t_lane) * 32 + 16 * s + 8 * h);
    f32x16 O[2][2]; float M[2] = {0.f, 0.f}, Ls[2] = {0.f, 0.f};
#pragma unroll
    for (int i = 0; i < 16; ++i) { O[0][0][i] = 0.f; O[0][1][i] = 0.f; O[1][0][i] = 0.f; O[1][1][i] = 0.f; }
    const u64 tm = (qb == 15) ? ~0ull : ((1ull << (4 * qb + 4)) - 1ull);
    {
        const u64 low = (1ull << (4 * qb)) - 1ull; const float slope2 = alibi_slope(hd + 1, 4) * LOG2E;
        const bf16* K0 = DK + (size_t)(bh * 2 + 0) * T_ * 32; const bf16* K1 = DK + (size_t)(bh * 2 + 1) * T_ * 32; const bf16* Vp = (const bf16*)(ws + WS_DV) + (size_t)bh * T_ * 64;
        attn_core<32, 2, false, false>(L, K0, K1, Vp, nullptr, 0.f, Qf, tm & ~low, t_lane, tw0, 1 << 30, slope2, 0u, 0u, O, M, Ls, tid);
        if (qb > 0) {
            const float qa = q_norm2_max<2>(Qf[0], lane), qb2 = q_norm2_max<2>(Qf[1], lane), ma = wave_min_l(M[0], lane), mb = wave_min_l(M[1], lane);
            const float* kn = (const float*)((const unsigned*)(ws + WS_CTL) + CW_KN + l * 8192 + 4096) + (size_t)(bh * 2) * 64 + lane;
            bool skip = false;
            if (lane < 4 * qb) { const float bmax = slope2 * (float)(64 * lane + 63 - tw0);
                skip = (sqrtf(qa * kn[0]) * 1.02f + bmax - ma < -152.f) && (sqrtf(qb2 * kn[64]) * 1.02f + bmax - mb < -152.f); }
            const u64 drop = prune_consensus(skip, (LAS u64*)(L + A_LDS_END), wave, lane);
            const u64 tm2 = low & ~drop;
            if (tm2) attn_core<32, 2, false, false>(L, K0, K1, Vp, nullptr, 0.f, Qf, tm2, t_lane, tw0, 1 << 30, slope2, 0u, 0u, O, M, Ls, tid, true);
        }
    }
    const float* lam = p->in[11] + (size_t)l * 128; const float* subln = p->in[12] + (size_t)l * 64;
    float l1 = 0.f, l2 = 0.f; if (lane < 32) { l1 = lam[lane] * lam[32 + lane]; l2 = lam[64 + lane] * lam[96 + lane]; }
    const float li = lambda_init_of(l), lam_full = __expf(wave_sum_l(l1, lane)) - __expf(wave_sum_l(l2, lane)) + li;
    const float lt0 = swap_sum(Ls[0]), lt1 = swap_sum(Ls[1]), i0 = lt0 > 0.f ? 1.f / lt0 : 0.f, i1 = (lt1 > 0.f ? 1.f / lt1 : 0.f) * lam_full;
    float ss = 0.f;
#pragma unroll
    for (int db = 0; db < 2; ++db)
#pragma unroll
        for (int i = 0; i < 16; ++i) { const float o = O[0][db][i] * i0 - O[1][db][i] * i1; O[0][db][i] = o; ss += o * o; }
    ss = swap_sum(ss);
    const float rn = rsqrtf(ss * (1.f / 64.f) + EPS) * (1.f - li);
    bf16* dst = (bf16*)(ws + WS_ATT) + ((size_t)b * T_ + t_lane) * 1024 + 768 + hd * 64 + 4 * h;
    ATTN_FOR_CHUNKS(db, g4) { const f32x4 sg = *(const f32x4*)(subln + 32 * db + 8 * g4 + 4 * h);
        const unsigned w0 = cvtpk(O[0][db][4 * g4 + 0] * rn * sg.x, O[0][db][4 * g4 + 1] * rn * sg.y), w1 = cvtpk(O[0][db][4 * g4 + 2] * rn * sg.z, O[0][db][4 * g4 + 3] * rn * sg.w);
        *(u64*)(dst + 32 * db + 8 * g4) = (u64)w0 | ((u64)w1 << 32); }
}
__device__ __forceinline__ void U_win(KP p_, int bg_, int c_) {
    const KP p = uni_kp(p_); const int bg = __builtin_amdgcn_readfirstlane(bg_), cc = __builtin_amdgcn_readfirstlane(c_);
    int tid_ = threadIdx.x; asm volatile("" : "+v"(tid_));
    const int tid = tid_, lane = tid & 63, wave = __builtin_amdgcn_readfirstlane(tid >> 6), r = lane & 31, h = lane >> 5;
    unsigned char* ws = p->ws; asm volatile("" : "+s"(ws)); LAS unsigned char* L = (LAS unsigned char*)lds_raw;
    const int b = bg >> 1, g = bg & 1, hd = g * 4 + (wave >> 1), tw0 = 64 * cc + 32 * (wave & 1), t_lane = tw0 + r;
    const bf16* q = (const bf16*)(ws + WS_QN) + (size_t)(b * 8 + hd) * T_ * 64 + (t_lane >> 4) * 1024 + (t_lane & 15) * 32 + 8 * h;
    bf16x8v Qf[1][4];
#pragma unroll
    for (int s = 0; s < 4; ++s) Qf[0][s] = *(const bf16x8v*)(q + (s >> 1) * 512 + (s & 1) * 16);
    f32x16 O[1][2]; float M[1] = {0.f}, Ls[1] = {0.f};
#pragma unroll
    for (int i = 0; i < 16; ++i) { O[0][0][i] = 0.f; O[0][1][i] = 0.f; }
    const int jlo = cc > 8 ? cc - 8 : 0;
    const u64 hi = (cc == 63) ? ~0ull : ((1ull << (cc + 1)) - 1ull), tm = hi & ~((1ull << jlo) - 1ull);
#if AC2_MODE == 0
    attn_core<64, 1, false, false>(L, (const bf16*)(ws + WS_KV6 + 4 * KV6_STRIDE) + (size_t)bg * T_ * 64, nullptr, (const bf16*)(ws + WS_KV6 + 5 * KV6_STRIDE) + (size_t)bg * T_ * 64, nullptr, 0.f,
                                   Qf, tm, t_lane, tw0, 512, alibi_slope(hd + 1, 8) * LOG2E, 0u, 0u, O, M, Ls, tid);
#else
    attn_core2<false, false>(L, (const bf16*)(ws + WS_KV6 + 4 * KV6_STRIDE) + (size_t)bg * T_ * 64, (const bf16*)(ws + WS_KV6 + 5 * KV6_STRIDE) + (size_t)bg * T_ * 64, nullptr, 0.f,
                             Qf[0], tm, t_lane, tw0, 512, alibi_slope(hd + 1, 8) * LOG2E, 0u, 0u, O[0], M[0], Ls[0], tid);
#endif
    const size_t n = (size_t)b * T_ + t_lane;
    const float lt = swap_sum(Ls[0]), inv = (lt > 0.f ? 1.f / lt : 0.f) * ((const float*)(ws + WS_GATE))[n * 24 + hd * 3 + 2];
    bf16* dst = (bf16*)(ws + WS_OWIN) + n * 512 + hd * 64 + 4 * h;
    ATTN_FOR_CHUNKS(db, g4) { const unsigned w0 = cvtpk(O[0][db][4 * g4 + 0] * inv, O[0][db][4 * g4 + 1] * inv), w1 = cvtpk(O[0][db][4 * g4 + 2] * inv, O[0][db][4 * g4 + 3] * inv);
        *(u64*)(dst + 32 * db + 8 * g4) = (u64)w0 | ((u64)w1 << 32); }
}
__device__ __forceinline__ void U_slc(KP p_, int bg_, int c_) {
    const KP p = uni_kp(p_); const int bg = __builtin_amdgcn_readfirstlane(bg_), cc = __builtin_amdgcn_readfirstlane(c_);
    int tid_ = threadIdx.x; asm volatile("" : "+v"(tid_));
    const int tid = tid_, lane = tid & 63, wave = __builtin_amdgcn_readfirstlane(tid >> 6), r = lane & 31, h = lane >> 5;
    unsigned char* ws = p->ws; asm volatile("" : "+s"(ws)); LAS unsigned char* L = (LAS unsigned char*)lds_raw;
    const int b = bg >> 1, g = bg & 1, hd = g * 4 + (wave >> 1), tw0 = 64 * cc + 32 * (wave & 1), t_lane = tw0 + r;
    const bf16* q = (const bf16*)(ws + WS_QN) + (size_t)(b * 8 + hd) * T_ * 64 + (t_lane >> 4) * 1024 + (t_lane & 15) * 32 + 8 * h;
    bf16x8v Qf[1][4];
#pragma unroll
    for (int s = 0; s < 4; ++s) Qf[0][s] = *(const bf16x8v*)(q + (s >> 1) * 512 + (s & 1) * 16);
    f32x16 O[1][2]; float M[1] = {0.f}, Ls[1] = {0.f};
#pragma unroll
    for (int i = 0; i < 16; ++i) { O[0][0][i] = 0.f; O[0][1][i] = 0.f; }
    const u64* sel = (const u64*)(ws + WS_SEL) + (size_t)bg * T_;
    const u64 mine = sel[t_lane]; u64 un = sel[64 * cc + lane];
    { unsigned ul = (unsigned)un, uh = (unsigned)(un >> 32);
#pragma unroll
      for (int o = 1; o < 64; o <<= 1) { ul |= shflx_u(ul, o, lane); uh |= shflx_u(uh, o, lane); }
      un = ((u64)__builtin_amdgcn_readfirstlane(uh) << 32) | __builtin_amdgcn_readfirstlane(ul); }
#if AC2_MODE == 0
    attn_core<64, 1, false, true>(L, (const bf16*)(ws + WS_KV6 + 2 * KV6_STRIDE) + (size_t)bg * T_ * 64, nullptr, (const bf16*)(ws + WS_KV6 + 3 * KV6_STRIDE) + (size_t)bg * T_ * 64, nullptr, 0.f,
                                  Qf, un, t_lane, tw0, 1 << 30, alibi_slope(hd + 1, 8) * LOG2E, (unsigned)mine, (unsigned)(mine >> 32), O, M, Ls, tid);
#else
    attn_core2<false, true>(L, (const bf16*)(ws + WS_KV6 + 2 * KV6_STRIDE) + (size_t)bg * T_ * 64, (const bf16*)(ws + WS_KV6 + 3 * KV6_STRIDE) + (size_t)bg * T_ * 64, nullptr, 0.f,
                            Qf[0], un, t_lane, tw0, 1 << 30, alibi_slope(hd + 1, 8) * LOG2E, (unsigned)mine, (unsigned)(mine >> 32), O[0], M[0], Ls[0], tid);
#endif
    const size_t n = (size_t)b * T_ + t_lane;
    const float lt = swap_sum(Ls[0]), inv = (lt > 0.f ? 1.f / lt : 0.f) * ((const float*)(ws + WS_GATE))[n * 24 + hd * 3 + 1];
    const bf16* oc = (const bf16*)(ws + WS_OCMP) + n * 512 + hd * 64 + 4 * h; const bf16* ow = (const bf16*)(ws + WS_OWIN) + n * 512 + hd * 64 + 4 * h;
    bf16* dst = (bf16*)(ws + WS_ATT) + n * 1024 + hd * 64 + 4 * h;
    ATTN_FOR_CHUNKS(db, g4) { const u64 a = *(const u64*)(oc + 32 * db + 8 * g4), w = *(const u64*)(ow + 32 * db + 8 * g4);
        const float x0 = O[0][db][4 * g4 + 0] * inv + __uint_as_float((unsigned)a << 16) + __uint_as_float((unsigned)w << 16);
        const float x1 = O[0][db][4 * g4 + 1] * inv + __uint_as_float((unsigned)a & 0xffff0000u) + __uint_as_float((unsigned)w & 0xffff0000u);
        const float x2 = O[0][db][4 * g4 + 2] * inv + __uint_as_float((unsigned)(a >> 32) << 16) + __uint_as_float((unsigned)(w >> 32) << 16);
        const float x3 = O[0][db][4 * g4 + 3] * inv + __uint_as_float((unsigned)(a >> 32) & 0xffff0000u) + __uint_as_float((unsigned)(w >> 32) & 0xffff0000u);
        *(u64*)(dst + 32 * db + 8 * g4) = (u64)cvtpk(x0, x1) | ((u64)cvtpk(x2, x3) << 32); }
}
__device__ __forceinline__ float other_half(float x, int h) { auto rr = __builtin_amdgcn_permlane32_swap(__float_as_uint(x), __float_as_uint(x), false, false); return __uint_as_float(h ? rr[0] : rr[1]); }
__device__ __forceinline__ int other_half_i(int x, int h) { auto rr = __builtin_amdgcn_permlane32_swap((unsigned)x, (unsigned)x, false, false); return (int)(h ? rr[0] : rr[1]); }
template <bool MASK>
__device__ __forceinline__ void cmp_scores(f32x16& p0, f32x16& p1, const LAS unsigned char* kt, const bf16x8v (&Qf)[4], float b0, float s1, int cl, int nvis_l) {
    const float s8 = s1 * 8.f, s32 = s1 * 32.f;
    p0[0] = b0; p0[1] = p0[0] + s1; p0[2] = p0[1] + s1; p0[3] = p0[2] + s1;
#pragma unroll
    for (int reg = 4; reg < 16; ++reg) p0[reg] = p0[reg - 4] + s8;
#pragma unroll
    for (int reg = 0; reg < 16; ++reg) p1[reg] = p0[reg] + s32;
#pragma unroll
    for (int s = 0; s < 4; ++s) { const bf16x8v kf0 = *(const LAS bf16x8v*)(kt + s * 32), kf1 = *(const LAS bf16x8v*)(kt + 32 * 144 + s * 32);
        p0 = __builtin_amdgcn_mfma_f32_32x32x16_bf16(kf0, Qf[s], p0, 0, 0, 0); p1 = __builtin_amdgcn_mfma_f32_32x32x16_bf16(kf1, Qf[s], p1, 0, 0, 0); }
    if (MASK) {
#pragma unroll
        for (int reg = 0; reg < 16; ++reg) { const int c = cl + crow0(reg); p0[reg] = (c < nvis_l) ? p0[reg] : -INFINITY; p1[reg] = (c + 32 < nvis_l) ? p1[reg] : -INFINITY; } }
}
__device__ __forceinline__ void U_cmp(KP p_, int bg_, int u_) {
    const KP p = uni_kp(p_); const int bg = __builtin_amdgcn_readfirstlane(bg_), uu = __builtin_amdgcn_readfirstlane(u_);
    int tid_ = threadIdx.x; asm volatile("" : "+v"(tid_));
    const int tid = tid_, lane = tid & 63, wave = __builtin_amdgcn_readfirstlane(tid >> 6), r = lane & 31, h = lane >> 5;
    unsigned char* ws = p->ws; asm volatile("" : "+s"(ws)); LAS unsigned char* L = (LAS unsigned char*)lds_raw;
    const int b = bg >> 1, g = bg & 1, tw0 = 32 * (uu + 16 * wave), t_lane = tw0 + r;
    { const bf16* kc = (const bf16*)(ws + WS_KVCMP) + (size_t)bg * 256 * 64; const bf16* vc = kc + 16 * 256 * 64;
#pragma unroll
      for (int i = 0; i < 4; ++i) { const int ch = tid + 512 * i, row = ch >> 3, c8 = ch & 7;
          *(LAS u32x4*)(L + row * 144 + c8 * 16) = *(const u32x4*)(kc + row * 64 + c8 * 8); *(LAS u32x4*)(L + 36864 + row * 144 + c8 * 16) = *(const u32x4*)(vc + row * 64 + c8 * 8); } }
    __syncthreads();
    const int nvis_l = t_lane >= 31 ? ((t_lane - 31) >> 4) + 1 : 0, nvis_max = (tw0 >> 4) + 1, nvis_min = tw0 >= 31 ? ((tw0 - 31) >> 4) + 1 : 0, ntile = (nvis_max + 63) >> 6;
    const LAS unsigned char* kfrag = L + r * 144 + h * 16;
    const LAS unsigned char* vfrag = L + 36864 + (4 * h + ((lane & 15) >> 2)) * 144 + (16 * ((lane >> 4) & 1) + 4 * (lane & 3)) * 2;
    float imp[32];
#pragma unroll
    for (int e = 0; e < 32; ++e) imp[e] = 0.f;
    const float* gate = (const float*)(ws + WS_GATE) + ((size_t)b * T_ + t_lane) * 24;
#pragma unroll 1
    for (int hg = 0; hg < 4; ++hg) {
        const int hd = g * 4 + hg; const float s1 = alibi_slope(hd + 1, 8) * LOG2E * 16.f;
        const bf16* q = (const bf16*)(ws + WS_QN) + (size_t)(b * 8 + hd) * T_ * 64 + (t_lane >> 4) * 1024 + (t_lane & 15) * 32 + 8 * h;
        bf16x8v Qf[4];
#pragma unroll
        for (int s = 0; s < 4; ++s) Qf[s] = *(const bf16x8v*)(q + (s >> 1) * 512 + (s & 1) * 16);
        float m = -1e30f, lsum = 0.f;
#pragma unroll 1
        for (int jt = 0; jt < ntile; ++jt) {
            f32x16 p0, p1; const float b0 = s1 * (float)(64 * jt + 4 * h - nvis_max);
            if (64 * jt + 63 >= nvis_min) cmp_scores<true>(p0, p1, kfrag + jt * (64 * 144), Qf, b0, s1, 64 * jt + 4 * h, nvis_l);
            else cmp_scores<false>(p0, p1, kfrag + jt * (64 * 144), Qf, b0, s1, 64 * jt + 4 * h, nvis_l);
            float mt = fmaxf(p0[0], p1[0]);
#pragma unroll
            for (int reg = 1; reg < 16; ++reg) mt = fmaxf(mt, fmaxf(p0[reg], p1[reg]));
            mt = swap_max(mt);
            const float mn = fmaxf(m, mt); float rs = 0.f;
#pragma unroll
            for (int reg = 0; reg < 16; ++reg) rs += __builtin_amdgcn_exp2f(p0[reg] - mn) + __builtin_amdgcn_exp2f(p1[reg] - mn);
            lsum = lsum * __builtin_amdgcn_exp2f(m - mn) + rs; m = mn;
        }
        const float lt = swap_sum(lsum), inv = lt > 0.f ? 1.f / lt : 0.f;
        f32x16 O0, O1;
#pragma unroll
        for (int i = 0; i < 16; ++i) { O0[i] = 0.f; O1[i] = 0.f; }
        float carry = 0.f;
#pragma unroll
        for (int jt = 0; jt < 4; ++jt) if (jt < ntile) {
            f32x16 p0, p1; const float b0 = s1 * (float)(64 * jt + 4 * h - nvis_max);
            if (64 * jt + 63 >= nvis_min) cmp_scores<true>(p0, p1, kfrag + jt * (64 * 144), Qf, b0, s1, 64 * jt + 4 * h, nvis_l);
            else cmp_scores<false>(p0, p1, kfrag + jt * (64 * 144), Qf, b0, s1, 64 * jt + 4 * h, nvis_l);
#pragma unroll
            for (int reg = 0; reg < 16; ++reg) { p0[reg] = __builtin_amdgcn_exp2f(p0[reg] - m) * inv; p1[reg] = __builtin_amdgcn_exp2f(p1[reg] - m) * inv; }
            float cv[8];
#pragma unroll
            for (int g4 = 0; g4 < 4; ++g4) { const float h0 = 0.5f * p0[4 * g4 + 3], h1 = 0.5f * p1[4 * g4 + 3];
                imp[jt * 8 + g4] += ((p0[4 * g4] + p0[4 * g4 + 1]) + p0[4 * g4 + 2]) + h0; imp[jt * 8 + 4 + g4] += ((p1[4 * g4] + p1[4 * g4 + 1]) + p1[4 * g4 + 2]) + h1;
                cv[g4] = h0; cv[4 + g4] = h1; }
            float prev = carry;
#pragma unroll
            for (int k = 0; k < 8; ++k) { const float sv = other_half(cv[k], h); imp[jt * 8 + k] += h ? sv : prev; prev = sv; }
            carry = prev;
            const bf16x8v pa0 = pack8(p0, 0), pa1 = pack8(p0, 8), pa2 = pack8(p1, 0), pa3 = pack8(p1, 8);
            const LAS unsigned char* vb = vfrag + jt * (64 * 144);
#pragma unroll
            for (int ks = 0; ks < 4; ++ks) { const bf16x8v pa = ks == 0 ? pa0 : ks == 1 ? pa1 : ks == 2 ? pa2 : pa3;
                { const s16x4 lo = tr_read(vb + ks * (16 * 144)), hi = tr_read(vb + ks * (16 * 144) + 8 * 144); const bf16x8v vf = {lo[0], lo[1], lo[2], lo[3], hi[0], hi[1], hi[2], hi[3]};
                  O0 = __builtin_amdgcn_mfma_f32_32x32x16_bf16(vf, pa, O0, 0, 0, 0); }
                { const s16x4 lo = tr_read(vb + ks * (16 * 144) + 64), hi = tr_read(vb + ks * (16 * 144) + 64 + 8 * 144); const bf16x8v vf = {lo[0], lo[1], lo[2], lo[3], hi[0], hi[1], hi[2], hi[3]};
                  O1 = __builtin_amdgcn_mfma_f32_32x32x16_bf16(vf, pa, O1, 0, 0, 0); } }
        }
        const float gt = gate[hd * 3 + 0];
        bf16* dst = (bf16*)(ws + WS_OCMP) + ((size_t)b * T_ + t_lane) * 512 + hd * 64 + 4 * h;
#pragma unroll
        for (int g4 = 0; g4 < 4; ++g4) {
            *(u64*)(dst + 8 * g4) = (u64)cvtpk(O0[4 * g4 + 0] * gt, O0[4 * g4 + 1] * gt) | ((u64)cvtpk(O0[4 * g4 + 2] * gt, O0[4 * g4 + 3] * gt) << 32);
            *(u64*)(dst + 32 + 8 * g4) = (u64)cvtpk(O1[4 * g4 + 0] * gt, O1[4 * g4 + 1] * gt) | ((u64)cvtpk(O1[4 * g4 + 2] * gt, O1[4 * g4 + 3] * gt) << 32); }
    }
    const int cur = tw0 >> 6; u64 mask;
    if (cur <= 15) mask = (1ull << (cur + 1)) - 1ull;
    else {
        mask = 1ull | (1ull << cur) | (1ull << (cur - 1));
#pragma unroll
        for (int e = 0; e < 32; ++e) { const int j = 2 * e + h; if (j > cur || j == 0 || j >= cur - 1) imp[e] = -INFINITY; }
#pragma unroll 1
        for (int round = 0; round < 13; ++round) {
            float bv = imp[0]; int be = 0;
#pragma unroll
            for (int e = 1; e < 32; ++e) if (imp[e] > bv) { bv = imp[e]; be = e; }
            const int bj = 2 * be + h; const float ov = other_half(bv, h); const int oj = other_half_i(bj, h);
            const bool mine = bv > ov || (bv == ov && bj < oj);
            mask |= 1ull << (mine ? bj : oj);
#pragma unroll
            for (int e = 0; e < 32; ++e) imp[e] = (mine && e == be) ? -INFINITY : imp[e];
        }
    }
    if (h == 0) ((u64*)(ws + WS_SEL))[(size_t)bg * T_ + t_lane] = mask;
    __syncthreads();
}
__device__ __forceinline__ int fetch_unit(KP p, int qidx) {
    volatile LAS unsigned* slot = (volatile LAS unsigned*)((LAS unsigned char*)lds_raw + MISC_OFF) + 16;
    __syncthreads();
    int t0_ = threadIdx.x; asm volatile("" : "+v"(t0_));
    if (t0_ == 0) *slot = __hip_atomic_fetch_add((unsigned*)(p->ws + WS_CTL) + CW_QUEUE + 64 * qidx, 1u, __ATOMIC_RELAXED, __HIP_MEMORY_SCOPE_AGENT);
    __syncthreads();
    return (int)__builtin_amdgcn_readfirstlane(*slot);
}
__device__ __forceinline__ void P_cmp1_mfma(int l_) { const KP p = (KP)__builtin_amdgcn_kernarg_segment_ptr(); int l = l_; asm volatile("" : "+s"(l));
    unsigned char* ws = p->ws; asm volatile("" : "+s"(ws)); const int c = launder_s((int)blockIdx.x), kv = c >> 4, pm = c & 15;
    OneUnitOrder S; S.has = c < 32; S.u.pm = pm; S.u.pn = kv;
    S.u.a = (const char*)(ws + WS_KV6 + (size_t)kv * KV6_STRIDE) + (size_t)pm * 256 * 1024 * 2; S.u.b = (const char*)((const bf16*)(ws + WS_W1_T) + ((size_t)l * 2 + kv) * 256 * 2048); S.u.b2 = S.u.b;
    const pg8::Gemm g{1024, 2048, 2048, 32};
    const EpiCmpH E{(bf16*)(ws + WS_HC), (const float*)(ws + WS_BIAS1) + l * 512};
    pg8::gemm_phase<EpiCmpH, OneUnitOrder, false, true>((LAS unsigned char*)lds_raw, g, S, E);
}
__device__ __forceinline__ void P_cmp2_mfma(int l_) { const KP p = (KP)__builtin_amdgcn_kernarg_segment_ptr(); int l = l_; asm volatile("" : "+s"(l));
    unsigned char* ws = p->ws; asm volatile("" : "+s"(ws)); const int c = launder_s((int)blockIdx.x), kv = c >> 4, pm = c & 15;
    OneUnitOrder S; S.has = c < 32; S.u.pm = pm; S.u.pn = kv;
    S.u.a = (const char*)((const bf16*)(ws + WS_HC) + ((size_t)kv * 4096 + pm * 256) * 256); S.u.b = (const char*)((const bf16*)(ws + WS_W2_T) + ((size_t)l * 2 + kv) * 64 * 256); S.u.b2 = S.u.b;
    const pg8::Gemm g{256, 256, 256, 4};
    const EpiCmpOut E{(bf16*)(ws + WS_KVCMP)};
    pg8::gemm_phase<EpiCmpOut, OneUnitOrder, false, true>((LAS unsigned char*)lds_raw, g, S, E);
}
__device__ __forceinline__ void P_moe_scatter(KP p_, int l_) { const KP p = uni_kp(p_); const int l = __builtin_amdgcn_readfirstlane(l_); const Ctx c = make_ctx(p); unsigned char* ws = p->ws;
    const unsigned* cnt = (const unsigned*)(ws + WS_CTL) + CW_MOECNT + l * 128;
    moe_build_tables(cnt, c.tid);
    const LAS int* T = (const LAS int*)((LAS unsigned char*)lds_raw + TBL_OFF);
    const unsigned* info = (const unsigned*)(ws + WS_ROUTE + RT_INFO); const float* tw = (const float*)(ws + WS_ROUTE + RT_W);
    int* rowtok = (int*)(ws + WS_ROUTE + RT_ROWTOK); float* roww = (float*)(ws + WS_ROUTE + RT_ROWW);
    bf16* xs = (bf16*)(ws + WS_XS); const bf16* x = (const bf16*)(ws + WS_HN); const float* gain = p->in[14] + (size_t)l * D_; const float* rstdv = (const float*)(ws + WS_ROUTE + RT_RSTD);
    { constexpr int RB = 4; float gg[2][8];
#pragma unroll
      for (int j = 0; j < 2; ++j) { const f32x4 a = ((const f32x4*)gain)[2 * c.lane + 128 * j], b2 = ((const f32x4*)gain)[2 * c.lane + 128 * j + 1]; gg[j][0] = a.x; gg[j][1] = a.y; gg[j][2] = a.z; gg[j][3] = a.w; gg[j][4] = b2.x; gg[j][5] = b2.y; gg[j][6] = b2.z; gg[j][7] = b2.w; }
      for (int row0 = c.gw * RB; row0 < NT; row0 += c.ngw * RB) {
        u32x4 vv[RB][2];
#pragma unroll
        for (int q = 0; q < RB; ++q)
#pragma unroll
            for (int j = 0; j < 2; ++j) vv[q][j] = ((const u32x4*)(x + (size_t)(row0 + q) * D_))[c.lane + 64 * j];
#pragma unroll
        for (int q = 0; q < RB; ++q) { const int row = row0 + q;
            const unsigned v = info[row]; const int cls = (int)(v >> 24), rank = (int)(v & 0xffffffu); const size_t dest = (size_t)T[cls] * 256 + rank; const float r = rstdv[row];
#pragma unroll
            for (int j = 0; j < 2; ++j) { float f[8]; unpack8(vv[q][j], f); u32x4 o; o.x = pk2(f[0] * r * gg[j][0], f[1] * r * gg[j][1]); o.y = pk2(f[2] * r * gg[j][2], f[3] * r * gg[j][3]); o.z = pk2(f[4] * r * gg[j][4], f[5] * r * gg[j][5]); o.w = pk2(f[6] * r * gg[j][6], f[7] * r * gg[j][7]);
                ((u32x4*)(xs + dest * D_))[c.lane + 64 * j] = o; }
            if (c.lane == 0) { rowtok[dest] = row; roww[2 * dest] = tw[2 * row]; roww[2 * dest + 1] = tw[2 * row + 1]; } }
      } }
    for (int cls = c.bid; cls < 112; cls += c.G) { const int n = (int)cnt[cls], end = (int)((cnt[cls] + 255u) >> 8) * 256; const size_t base = (size_t)T[cls] * 256;
        for (int r = n + c.tid; r < end; r += NTHREADS) rowtok[base + r] = -1; }
}
__device__ __forceinline__ void P_moe_g1(int l_) { const KP p = (KP)__builtin_amdgcn_kernarg_segment_ptr(); int l = l_; asm volatile("" : "+s"(l));
    unsigned char* ws = p->ws; asm volatile("" : "+s"(ws));
    { int t0_ = threadIdx.x; asm volatile("" : "+v"(t0_)); moe_build_tables((const unsigned*)(ws + WS_CTL) + CW_MOECNT + l * 128, t0_); }
    const MoeOrder1 S{(const char*)(ws + WS_XS), (const char*)((const bf16*)(ws + WS_WGU_T) + (size_t)l * NEXP * 512 * D_), (int)gridDim.x, launder_s((int)blockIdx.x)};
    const pg8::Gemm g{D_, D_, D_, D_ / 64};
    const EpiMoeH E{(bf16*)(ws + WS_HB), (const float*)(ws + WS_ROUTE + RT_ROWW)};
    pg8::gemm_phase<EpiMoeH, MoeOrder1, true, true>((LAS unsigned char*)lds_raw, g, S, E);
}
__device__ __forceinline__ void P_moe_g2(int l_) { const KP p = (KP)__builtin_amdgcn_kernarg_segment_ptr(); int l = l_; asm volatile("" : "+s"(l));
    unsigned char* ws = p->ws; asm volatile("" : "+s"(ws));
    { int t0_ = threadIdx.x; asm volatile("" : "+v"(t0_)); moe_build_tables((const unsigned*)(ws + WS_CTL) + CW_MOECNT + l * 128, t0_); }
    const MoeOrder2 S{(const char*)(ws + WS_HB), (const char*)((const bf16*)(ws + WS_WD_T) + (size_t)l * NEXP * D_ * DEXP), (int)gridDim.x, launder_s((int)blockIdx.x)};
    const pg8::Gemm g{512, DEXP, 512, 4};
    const EpiMoeOut E{(bf16*)(ws + WS_HN), (const int*)(ws + WS_ROUTE + RT_ROWTOK)};
    pg8::gemm_phase<EpiMoeOut, MoeOrder2, true, true>((LAS unsigned char*)lds_raw, g, S, E);
}
__device__ __forceinline__ void P_norm1(KP p_, int l_) { const KP p = uni_kp(p_); const int l = __builtin_amdgcn_readfirstlane(l_); const Ctx c = make_ctx(p); const Bufs b = make_bufs(p->ws);
    if (l == 0) { const int i = c.bid * NTHREADS + c.tid; if (i < L_ * 2 * 256) { const float* part = (const float*)(p->ws + WS_B1PART) + (size_t)(i >> 8) * 128 * 256 + (i & 255); float a = 0.f;
        for (int k = 0; k < 128; ++k) a += part[(size_t)k * 256]; ((float*)(p->ws + WS_BIAS1))[i] = a; } }
    if (l == 0) ph_norm_bf16(c, p->in[0], p->in[1], (bf16*)p->out, (bf16*)(p->ws + WS_HN)); else ph_norm_bf16_from_bf16(c, (const bf16*)(p->ws + WS_HN), p->in[1] + (size_t)l * D_, (bf16*)p->out); }
__device__ __noinline__ void P_inproj(KP p_, int l_) { const KP p = uni_kp(p_); const int l = __builtin_amdgcn_readfirstlane(l_); const Ctx c = make_ctx(p); const Bufs b = make_bufs(p->ws);
    InProjOut o{b.QN, b.KV6, b.FQ, b.DQ, b.DV, b.GATE, b.FL, p->in[3] + l * 24, p->in[4] + l * 4};
    const bf16* A = b.HN;
    naive_gemm(c, NT, D_IN, D_, [=](int r, int k) { return bf2f(A[(size_t)r * D_ + k]); }, p->in[2] + (size_t)l * D_ * D_IN, D_IN,
               [=](int r, int col, float v) { inproj_store(o, r, col, v); }); }
__device__ __noinline__ void P_cmp1(KP p_, int l_, int kv_) { const KP p = uni_kp(p_); const int l = __builtin_amdgcn_readfirstlane(l_), kv = __builtin_amdgcn_readfirstlane(kv_); const Ctx c = make_ctx(p); const Bufs b = make_bufs(p->ws);
    const bf16* src = kv == 0 ? b.KC : b.VC; const float* pe = p->in[kv == 0 ? 5 : 8] + (size_t)l * 2048; bf16* hc = b.HC + (size_t)kv * 4096 * 256;
    naive_gemm(c, 4096, 256, 2048, [=](int r, int k) { return bf2f(src[(size_t)r * 1024 + k]) + pe[k]; }, p->in[kv == 0 ? 6 : 9] + (size_t)l * 2048 * 256, 256,
               [=](int r, int col, float v) { hc[(size_t)r * 256 + col] = (bf16)f2bf(gelu_tanh(v)); }); }
__device__ __noinline__ void P_cumsum(KP p_, int l_) { const KP p = uni_kp(p_); const int l = __builtin_amdgcn_readfirstlane(l_); const Ctx c = make_ctx(p); const Bufs b = make_bufs(p->ws); ph_cumsum(c, b.FL); }
__device__ __noinline__ void P_cmp2(KP p_, int l_, int kv_) { const KP p = uni_kp(p_); const int l = __builtin_amdgcn_readfirstlane(l_), kv = __builtin_amdgcn_readfirstlane(kv_); const Ctx c = make_ctx(p); const Bufs b = make_bufs(p->ws);
    const bf16* hc = b.HC + (size_t)kv * 4096 * 256; bf16* dst = kv == 0 ? b.KCMP : b.VCMP;
    naive_gemm(c, 4096, 64, 256, [=](int r, int k) { return bf2f(hc[(size_t)r * 256 + k]); }, p->in[kv == 0 ? 7 : 10] + (size_t)l * 256 * 64, 64,
               [=](int r, int col, float v) { dst[(size_t)r * 64 + col] = (bf16)f2bf((r & 255) == 255 ? 0.f : v); }); }
__device__ __noinline__ void P_win(KP p_, int l_) { const KP p = uni_kp(p_); const int l = __builtin_amdgcn_readfirstlane(l_); const Ctx c = make_ctx(p); const Bufs b = make_bufs(p->ws); ph_win_attn(c, b.QN, b.KW, b.VW, b.GATE, b.OWIN); }
__device__ __noinline__ void P_fox(KP p_, int l_) { const KP p = uni_kp(p_); const int l = __builtin_amdgcn_readfirstlane(l_); const Ctx c = make_ctx(p); const Bufs b = make_bufs(p->ws); ph_fox_attn(c, b.FQ, b.FK, b.FV, b.FL, b.ATT); }
__device__ __noinline__ void P_diff(KP p_, int l_) { const KP p = uni_kp(p_); const int l = __builtin_amdgcn_readfirstlane(l_); const Ctx c = make_ctx(p); const Bufs b = make_bufs(p->ws);
    ph_diff_attn(c, b.DQ, b.DK, b.DV, p->in[11] + (size_t)l * 128, p->in[12] + (size_t)l * 64, lambda_init_of(l), b.ATT); }
__device__ __noinline__ void P_cmpattn(KP p_, int l_) { const KP p = uni_kp(p_); const int l = __builtin_amdgcn_readfirstlane(l_); const Ctx c = make_ctx(p); const Bufs b = make_bufs(p->ws); ph_cmp_attn(c, b.QN, b.KCMP, b.VCMP, b.GATE, b.SEL, b.OCMP); }
__device__ __noinline__ void P_slc(KP p_, int l_) { const KP p = uni_kp(p_); const int l = __builtin_amdgcn_readfirstlane(l_); const Ctx c = make_ctx(p); const Bufs b = make_bufs(p->ws); ph_slc_attn(c, b.QN, b.KS, b.VS, b.GATE, b.SEL, b.OCMP, b.OWIN, b.ATT); }
__device__ __noinline__ void P_outproj(KP p_, int l_) { const KP p = uni_kp(p_); const int l = __builtin_amdgcn_readfirstlane(l_); const Ctx c = make_ctx(p); const Bufs b = make_bufs(p->ws);
    const bf16* A = b.ATT; float* xo = p->out; const float* xin = (l == 0) ? p->in[0] : p->out;
    naive_gemm(c, NT, D_, D_, [=](int r, int k) { return bf2f(A[(size_t)r * D_ + k]); }, p->in[13] + (size_t)l * D_ * D_, D_,
               [=](int r, int col, float v) { xo[(size_t)r * D_ + col] = xin[(size_t)r * D_ + col] + v; }); }
__device__ __forceinline__ void P_route3(int l_, int cbank) { const KP p = (KP)__builtin_amdgcn_kernarg_segment_ptr(); int l = l_; asm volatile("" : "+s"(l));
    int tid_ = threadIdx.x; asm volatile("" : "+v"(tid_));
    const int tid = tid_, lane = tid & 63, wave = __builtin_amdgcn_readfirstlane(tid >> 6), r = lane & 31, h = lane >> 5, kh = wave >> 2, wr = wave & 3;
    unsigned char* ws = p->ws; asm volatile("" : "+s"(ws)); const bf16* x = (const bf16*)(ws + WS_HN);
    const float* WR = (const float*)(ws + WS_WR) + (size_t)l * D_ * 64;
    LAS float* XT = (LAS float*)lds_raw + wave * (32 * 36);
    LAS float* WT = (LAS float*)lds_raw + 8 * 32 * 36 + kh * (2 * 32 * 64);
    LAS float* PL = (LAS float*)lds_raw + 8 * 32 * 36 + 2 * 2 * 32 * 64;
    LAS float* SS = PL + 2 * 128 * 40;
    const float* bgrp = p->in[16] + l * 4; const float* bexp = p->in[18] + l * 32;
    unsigned* cnt = (unsigned*)(ws + WS_CTL) + CW_MOECNT + l * 128 + cbank;
    for (int grp = launder_s((int)blockIdx.x); grp < NT / 128; grp += (int)gridDim.x) {
        const int row0 = grp * 128 + wr * 32;
        f32x16 acc0, acc1; float ss = 0.f;
#pragma unroll
        for (int i = 0; i < 16; ++i) { acc0[i] = 0.f; acc1[i] = 0.f; }
        int buf = 0;
        const int xrow = lane >> 1, xpart = lane & 1;
        const u32x4* wsrc = (const u32x4*)(ws + WS_WR) + ((size_t)l * 64 + kh * 32) * 256 + (tid & 255); const bf16* xsrc = x + (size_t)(row0 + xrow) * D_ + kh * 512 + xpart * 16;
        u32x4 wv[2]; u32x4 xa[2], xb2[2];
#pragma unroll
        for (int i = 0; i < 2; ++i) wv[i] = wsrc[256 * i];
#pragma unroll
        for (int j = 0; j < 2; ++j) { xa[j] = *(const u32x4*)(xsrc + 8 * j); xb2[j] = *(const u32x4*)(xsrc + 32 + 8 * j); }
        LAS u32x4* WTq = (LAS u32x4*)WT;
#define RT_CHUNK(KC, XV) do { \
            _Pragma("unroll") for (int i = 0; i < 2; ++i) WTq[buf * 512 + (tid & 255) + 256 * i] = wv[i]; \
            _Pragma("unroll") for (int j = 0; j < 2; ++j) { float f_[8]; unpack8(XV[j], f_); _Pragma("unroll") for (int e = 0; e < 8; ++e) ss = fmaf(f_[e], f_[e], ss); \
                *(LAS f32x4*)(XT + xrow * 36 + xpart * 16 + 8 * j) = (f32x4){f_[0], f_[1], f_[2], f_[3]}; *(LAS f32x4*)(XT + xrow * 36 + xpart * 16 + 8 * j + 4) = (f32x4){f_[4], f_[5], f_[6], f_[7]}; } \
            if ((KC) + 1 < 16) { _Pragma("unroll") for (int i = 0; i < 2; ++i) wv[i] = wsrc[(size_t)((KC) + 1) * 512 + 256 * i]; } \
            if ((KC) + 2 < 16) { _Pragma("unroll") for (int j = 0; j < 2; ++j) XV[j] = *(const u32x4*)(xsrc + ((KC) + 2) * 32 + 8 * j); } \
            __syncthreads(); \
            _Pragma("unroll") for (int sidx = 0; sidx < 2; ++sidx) { \
                const f32x4 t0 = *(const LAS f32x4*)(XT + r * 36 + 16 * sidx + 8 * h), t1 = *(const LAS f32x4*)(XT + r * 36 + 16 * sidx + 8 * h + 4); \
                const float xe[8] = {t0.x, t0.y, t0.z, t0.w, t1.x, t1.y, t1.z, t1.w}; unsigned ah[4]; \
                _Pragma("unroll") for (int jp = 0; jp < 4; ++jp) ah[jp] = cvtpk(xe[2 * jp], xe[2 * jp + 1]);        \
                const bf16x8v Ah = __builtin_bit_cast(bf16x8v, (u32x4){ah[0], ah[1], ah[2], ah[3]}); \
                const LAS u32x4* wb = WTq + buf * 512 + sidx * 256 + lane; \
                const bf16x8v B0h = __builtin_bit_cast(bf16x8v, wb[0]), B0l = __builtin_bit_cast(bf16x8v, wb[64]), B1h = __builtin_bit_cast(bf16x8v, wb[128]), B1l = __builtin_bit_cast(bf16x8v, wb[192]); \
                acc0 = __builtin_amdgcn_mfma_f32_32x32x16_bf16(Ah, B0h, acc0, 0, 0, 0); acc1 = __builtin_amdgcn_mfma_f32_32x32x16_bf16(Ah, B1h, acc1, 0, 0, 0); \
                acc0 = __builtin_amdgcn_mfma_f32_32x32x16_bf16(Ah, B0l, acc0, 0, 0, 0); acc1 = __builtin_amdgcn_mfma_f32_32x32x16_bf16(Ah, B1l, acc1, 0, 0, 0); } \
            buf ^= 1; } while (0)
#pragma unroll 1
        for (int kc = 0; kc < 16; kc += 2) { RT_CHUNK(kc, xa); RT_CHUNK(kc + 1, xb2); }
#undef RT_CHUNK
#pragma unroll
        for (int reg = 0; reg < 16; ++reg) { const int row = wr * 32 + crow0(reg) + 4 * h; PL[(kh * 128 + row) * 40 + r] = acc0[reg]; if (r < 4) PL[(kh * 128 + row) * 40 + 32 + r] = acc1[reg]; }
        SS[(kh * 128 + wr * 32 + (lane >> 1)) * 2 + (lane & 1)] = ss;
        __syncthreads();
        if (tid < 128) {
            float lg[36];
#pragma unroll
            for (int cidx = 0; cidx < 36; ++cidx) lg[cidx] = PL[tid * 40 + cidx] + PL[(128 + tid) * 40 + cidx];
            const float sq = (SS[tid * 2] + SS[tid * 2 + 1]) + (SS[(128 + tid) * 2] + SS[(128 + tid) * 2 + 1]);
            const float rstd = rsqrtf(sq * (1.f / D_) + EPS);
            float gl[4]; int grp_i = 0;
#pragma unroll
            for (int q = 0; q < 4; ++q) gl[q] = lg[q] * rstd + bgrp[q];
            float gm = gl[0];
#pragma unroll
            for (int q = 1; q < 4; ++q) if (gl[q] > gm) { gm = gl[q]; grp_i = q; }
            float gs = 0.f;
#pragma unroll
            for (int q = 0; q < 4; ++q) gs += __expf(gl[q] - gm);
            const float grp_gate = 1.f / gs;
            float el[8];
#pragma unroll
            for (int q = 0; q < 8; ++q) { float v = lg[4 + q]; float bb = bexp[q];
                if (grp_i == 1) { v = lg[12 + q]; bb = bexp[8 + q]; } else if (grp_i == 2) { v = lg[20 + q]; bb = bexp[16 + q]; } else if (grp_i == 3) { v = lg[28 + q]; bb = bexp[24 + q]; }
                el[q] = v * rstd + bb; }
            int i0 = 0; float v0 = el[0];
#pragma unroll
            for (int q = 1; q < 8; ++q) if (el[q] > v0) { v0 = el[q]; i0 = q; }
            int i1 = -1; float v1 = -INFINITY;
#pragma unroll
            for (int q = 0; q < 8; ++q) if (q != i0 && el[q] > v1) { v1 = el[q]; i1 = q; }
            const float e1 = __expf(v1 - v0), den = 1.f + e1, w0 = grp_gate / den, w1 = grp_gate * e1 / den;
            const int lo = i0 < i1 ? i0 : i1, hi = i0 < i1 ? i1 : i0, cls = grp_i * 28 + lo * 8 - (lo * (lo + 1)) / 2 + (hi - lo - 1);
            const unsigned rank = __hip_atomic_fetch_add(cnt + cls, 1u, __ATOMIC_RELAXED, __HIP_MEMORY_SCOPE_AGENT);
            const int row = grp * 128 + tid;
            ((unsigned*)(ws + WS_ROUTE + RT_INFO))[row] = ((unsigned)cls << 24) | rank;
            ((float*)(ws + WS_ROUTE + RT_W))[2 * row] = i0 < i1 ? w0 : w1; ((float*)(ws + WS_ROUTE + RT_W))[2 * row + 1] = i0 < i1 ? w1 : w0;
            ((float*)(ws + WS_ROUTE + RT_RSTD))[row] = rstd;
        }
        __syncthreads();
    }
}
typedef float f32x8 __attribute__((ext_vector_type(8)));
__device__ __forceinline__ void P_route2(int l_, int cbank) { const KP p = (KP)__builtin_amdgcn_kernarg_segment_ptr(); int l = l_; asm volatile("" : "+s"(l));
    int tid_ = threadIdx.x; asm volatile("" : "+v"(tid_));
    const int tid = tid_, lane = tid & 63, wave = __builtin_amdgcn_readfirstlane(tid >> 6);
    unsigned char* ws = p->ws; asm volatile("" : "+s"(ws)); const float* x = p->out;
    const float* WR = (const float*)(ws + WS_WR) + (size_t)l * D_ * 40;
    LAS float* xt = (LAS float*)lds_raw + wave * (64 * 36);
    LAS float* part = (LAS float*)lds_raw;
    const float* bgrp = p->in[16] + l * 4; const float* bexp = p->in[18] + l * 32;
    unsigned* cnt = (unsigned*)(ws + WS_CTL) + CW_MOECNT + l * 128 + cbank;
    for (int grp = launder_s((int)blockIdx.x); grp < NT / 128; grp += (int)gridDim.x) {
        const int row0 = grp * 128 + (wave >> 2) * 64, kq = wave & 3;
        float acc[40]; float ss = 0.f;
#pragma unroll
        for (int cidx = 0; cidx < 40; ++cidx) acc[cidx] = 0.f;
#pragma unroll 1
        for (int kc = 0; kc < 8; ++kc) {
            const int k0 = kq * 256 + kc * 32;
#pragma unroll
            for (int i = 0; i < 8; ++i) { const int row = i * 8 + (lane >> 3), c4 = (lane & 7) * 4; *(LAS f32x4*)(xt + row * 36 + c4) = *(const f32x4*)(x + (size_t)(row0 + row) * D_ + k0 + c4); }
            float xr[32];
#pragma unroll
            for (int j = 0; j < 8; ++j) { const f32x4 t = *(const LAS f32x4*)(xt + lane * 36 + 4 * j); xr[4 * j] = t.x; xr[4 * j + 1] = t.y; xr[4 * j + 2] = t.z; xr[4 * j + 3] = t.w; }
            const float* wk = WR + (size_t)k0 * 40;
#pragma unroll
            for (int kk = 0; kk < 32; ++kk) {
                f32x8 w0, w1, w2, w3, w4;
                asm volatile("s_load_dwordx8 %0, %5, %6\n\ts_load_dwordx8 %1, %5, %7\n\ts_load_dwordx8 %2, %5, %8\n\ts_load_dwordx8 %3, %5, %9\n\ts_load_dwordx8 %4, %5, %10\n\ts_waitcnt lgkmcnt(0)"
                             : "=&s"(w0), "=&s"(w1), "=&s"(w2), "=&s"(w3), "=&s"(w4) : "s"(wk), "i"(kk * 160), "i"(kk * 160 + 32), "i"(kk * 160 + 64), "i"(kk * 160 + 96), "i"(kk * 160 + 128) : "memory");
                const float xv = xr[kk]; ss = fmaf(xv, xv, ss);
#pragma unroll
                for (int e = 0; e < 8; ++e) { acc[e] = fmaf(xv, w0[e], acc[e]); acc[8 + e] = fmaf(xv, w1[e], acc[8 + e]); acc[16 + e] = fmaf(xv, w2[e], acc[16 + e]); acc[24 + e] = fmaf(xv, w3[e], acc[24 + e]); }
#pragma unroll
                for (int e = 0; e < 4; ++e) acc[32 + e] = fmaf(xv, w4[e], acc[32 + e]);
            }
        }
        __syncthreads();
#pragma unroll
        for (int cidx = 0; cidx < 36; ++cidx) part[(wave * 64 + lane) * 37 + cidx] = acc[cidx];
        part[(wave * 64 + lane) * 37 + 36] = ss;
        __syncthreads();
        if (tid < 128) {
            const int rg = tid >> 6, rr = tid & 63; float lg[37];
#pragma unroll
            for (int cidx = 0; cidx < 37; ++cidx) lg[cidx] = ((part[((rg * 4 + 0) * 64 + rr) * 37 + cidx] + part[((rg * 4 + 1) * 64 + rr) * 37 + cidx]) + part[((rg * 4 + 2) * 64 + rr) * 37 + cidx]) + part[((rg * 4 + 3) * 64 + rr) * 37 + cidx];
            const float rstd = rsqrtf(lg[36] * (1.f / D_) + EPS);
            float gl[4]; int grp_i = 0;
#pragma unroll
            for (int q = 0; q < 4; ++q) gl[q] = lg[q] * rstd + bgrp[q];
            float gm = gl[0];
#pragma unroll
            for (int q = 1; q < 4; ++q) if (gl[q] > gm) { gm = gl[q]; grp_i = q; }
            float gs = 0.f;
#pragma unroll
            for (int q = 0; q < 4; ++q) gs += __expf(gl[q] - gm);
            const float grp_gate = 1.f / gs;
            float el[8];
#pragma unroll
            for (int q = 0; q < 8; ++q) { float v = lg[4 + q]; float bb = bexp[q];
                if (grp_i == 1) { v = lg[12 + q]; bb = bexp[8 + q]; } else if (grp_i == 2) { v = lg[20 + q]; bb = bexp[16 + q]; } else if (grp_i == 3) { v = lg[28 + q]; bb = bexp[24 + q]; }
                el[q] = v * rstd + bb; }
            int i0 = 0; float v0 = el[0];
#pragma unroll
            for (int q = 1; q < 8; ++q) if (el[q] > v0) { v0 = el[q]; i0 = q; }
            int i1 = -1; float v1 = -INFINITY;
#pragma unroll
            for (int q = 0; q < 8; ++q) if (q != i0 && el[q] > v1) { v1 = el[q]; i1 = q; }
            const float e1 = __expf(v1 - v0), den = 1.f + e1, w0 = grp_gate / den, w1 = grp_gate * e1 / den;
            const int lo = i0 < i1 ? i0 : i1, hi = i0 < i1 ? i1 : i0, cls = grp_i * 28 + lo * 8 - (lo * (lo + 1)) / 2 + (hi - lo - 1);
            const unsigned rank = __hip_atomic_fetch_add(cnt + cls, 1u, __ATOMIC_RELAXED, __HIP_MEMORY_SCOPE_AGENT);
            const int row = grp * 128 + tid;
            ((unsigned*)(ws + WS_ROUTE + RT_INFO))[row] = ((unsigned)cls << 24) | rank;
            ((float*)(ws + WS_ROUTE + RT_W))[2 * row] = i0 < i1 ? w0 : w1; ((float*)(ws + WS_ROUTE + RT_W))[2 * row + 1] = i0 < i1 ? w1 : w0;
            ((float*)(ws + WS_ROUTE + RT_RSTD))[row] = rstd;
        }
        __syncthreads();
    }
}
__device__ __noinline__ void P_route(KP p_, int l_) { const KP p = uni_kp(p_); const int l = __builtin_amdgcn_readfirstlane(l_); const Ctx c = make_ctx(p); const Bufs b = make_bufs(p->ws);
    ph_moe_route(c, p->out, p->in[14] + (size_t)l * D_, p->in[15] + (size_t)l * D_ * 4, p->in[16] + l * 4, p->in[17] + (size_t)l * D_ * 32, p->in[18] + l * 32, b.HN, (int*)(p->ws + WS_ROUTE + RT_INFO), (float*)(p->ws + WS_ROUTE + RT_W), (unsigned*)(p->ws + WS_CTL) + CW_MOECNT + l * 128); }
__device__ __noinline__ void P_moe(KP p_, int l_) { const KP p = uni_kp(p_); const int l = __builtin_amdgcn_readfirstlane(l_); const Ctx c = make_ctx(p); const Bufs b = make_bufs(p->ws);
    ph_moe_naive(c, b.HN, b.ROUTE_E, b.ROUTE_W, p->in[19] + (size_t)l * NEXP * D_ * DEXP, p->in[20] + (size_t)l * NEXP * D_ * DEXP, p->in[21] + (size_t)l * NEXP * DEXP * D_, p->out); }
__device__ __noinline__ void P_final(KP p_) { const KP p = uni_kp(p_); const Ctx c = make_ctx(p); ph_norm_final_from_bf16(c, (const bf16*)(p->ws + WS_HN), p->in[22], p->out); }
__device__ __forceinline__ void P_gridbar(KP p_) { const KP p = uni_kp(p_);
    XcdBarrier bar; bar.bar = (unsigned*)(p->ws + WS_CTL) + 4096; bar.x = xb_xcc_id(); bar.st = (volatile LAS unsigned*)((LAS unsigned char*)lds_raw + MISC_OFF) + 8;
    xcd_barrier(bar);
}

__global__ void __launch_bounds__(NTHREADS, 2) fwd_kernel(Params pp) {
    const KP p = (KP)__builtin_amdgcn_kernarg_segment_ptr();
    { volatile LAS unsigned* MISC = (volatile LAS unsigned*)((LAS unsigned char*)lds_raw + MISC_OFF); if (threadIdx.x < 32) MISC[threadIdx.x] = 0u; }
    __syncthreads();
    const int lo = p->ph_lo, hi = p->ph_hi;
    if (hi - lo > 1) (void)xcd_barrier_post((unsigned*)(p->ws + WS_CTL) + 4096, (volatile LAS unsigned*)((LAS unsigned char*)lds_raw + MISC_OFF) + 8);
#define IN(k) (lo <= (k) && (k) < hi)
#define SEAM(k) do { if (IN(k) && IN((k) + 1)) P_gridbar(p); } while (0)
    if (IN(0)) { for (int rep = 0; rep < REP_PRO; ++rep) { if (rep) P_gridbar(p); P_prologue(p); } }
    SEAM(0);
    for (int l = 0; l < L_; ++l) {
        const int P0 = 1 + l * PH_PER_LAYER;
        if (IN(P0 + 0)) { for (int rep = 0; rep < REP_NORM; ++rep) { if (rep) P_gridbar(p); P_norm1(p, l); } }
        SEAM(P0 + 0);
        if (IN(P0 + 1)) { for (int rep = 0; rep < REP_INPROJ; ++rep) { if (rep) P_gridbar(p); P_inproj_mfma(l); }
#ifdef REP_INDUMMY
            for (int rep = 0; rep < REP_INDUMMY; ++rep) { P_gridbar(p); P_inproj_dummy(l); }
#endif
        }
        SEAM(P0 + 1);
        if (IN(P0 + 3)) {
            P_cmp1_mfma(l);
            if (launder_s((int)blockIdx.x) < 32) { asm volatile("s_waitcnt vmcnt(0)" ::: "memory"); __builtin_amdgcn_fence(__ATOMIC_SEQ_CST, "agent"); asm volatile("s_waitcnt vmcnt(0)" ::: "memory"); }
            __syncthreads();
            P_cmp2_mfma(l);
            for (int rep = 0; rep < REP_ATT3; ++rep) { if (rep) P_gridbar(p);
            for (;;) { const int u = fetch_unit(p, l * 8 + 0 + 16 * rep); if (u >= 2048) break;
                if (u < 1024) { const int qb = 15 - (u >> 6), k = u & 63; if (k < 32) U_diff(p, k, qb, l); else U_fox(p, k - 32, qb, l); }
                else { const int w = u - 1024; U_win(p, w & 15, 63 - (w >> 4)); } } } }
        SEAM(P0 + 3);
        if (IN(P0 + 4)) { for (int rep = 0; rep < REP_CMP; ++rep) { if (rep) P_gridbar(p); for (int u = launder_s((int)blockIdx.x); u < 256; u += (int)gridDim.x) U_cmp(p, u & 15, u >> 4); } }
        SEAM(P0 + 4);
        if (IN(P0 + 5)) { for (int rep = 0; rep < REP_SLC; ++rep) { if (rep) P_gridbar(p); for (;;) { const int u = fetch_unit(p, l * 8 + 1 + 16 * rep); if (u >= 1024) break; U_slc(p, u & 15, 63 - (u >> 4)); } } }
        SEAM(P0 + 5);
        if (IN(P0 + 6)) P_outproj_mfma(l);
        SEAM(P0 + 6);
        if (IN(P0 + 7)) { for (int rep = 0; rep < REP_ROUTE; ++rep) { if (rep) P_gridbar(p); P_route3(l, (REP_ROUTE - 1 - rep) * 256); } }
        SEAM(P0 + 7);
        if (IN(P0 + 8)) { for (int rep = 0; rep < REP_SCAT; ++rep) { if (rep) P_gridbar(p); P_moe_scatter(p, l); } }
        SEAM(P0 + 8);
        if (IN(P0 + 9)) { for (int rep = 0; rep < REP_G1; ++rep) { if (rep) P_gridbar(p); P_moe_g1(l); } }
        SEAM(P0 + 9);
        if (IN(P0 + 10)) P_moe_g2(l);
        SEAM(P0 + 10);
    }
    if (IN(1 + L_ * PH_PER_LAYER)) P_final(p);
#undef IN
#undef SEAM
}

extern "C" void kernel_launch(void* const* d_in, const int* in_sizes, int n_in, void* d_out, int out_size, void* d_ws, size_t ws_size, hipStream_t stream) {
    static int grid = 0;
    if (grid == 0) {
        if (n_in != 23 || out_size != NT * D_ || ws_size < WS_END) { fprintf(stderr, "kernel_launch: unexpected sizes n_in %d out %d ws %zu (need %zu)\n", n_in, out_size, ws_size, (size_t)WS_END); grid = -1; return; }
        int dev = 0, cus = 0, per_cu = 0;
        if (hipGetDevice(&dev) != hipSuccess || hipDeviceGetAttribute(&cus, hipDeviceAttributeMultiprocessorCount, dev) != hipSuccess) { grid = -1; return; }
        if (hipFuncSetAttribute((const void*)fwd_kernel, hipFuncAttributeMaxDynamicSharedMemorySize, LDS_BYTES) != hipSuccess) { fprintf(stderr, "kernel_launch: hipFuncSetAttribute failed\n"); grid = -1; return; }
        if (hipOccupancyMaxActiveBlocksPerMultiprocessor(&per_cu, (const void*)fwd_kernel, NTHREADS, LDS_BYTES) != hipSuccess || per_cu < 1) { fprintf(stderr, "kernel_launch: occupancy query says %d\n", per_cu); }
        (void)hipGetLastError();
        grid = cus;
    }
    if (grid < 0) return;
    (void)hipMemsetAsync((char*)d_ws + WS_CTL, 0, CTL_BYTES, stream);
    Params p{};
    for (int i = 0; i < 23; ++i) p.in[i] = (const float*)d_in[i];
    p.out = (float*)d_out; p.ws = (unsigned char*)d_ws;
#if N_LAUNCH_MODE == 0
    p.ph_lo = 0; p.ph_hi = N_PHASES;
    hipLaunchKernelGGL(fwd_kernel, dim3(grid), dim3(NTHREADS), LDS_BYTES, stream, p);
#else
    for (int k = 0; k < N_PHASES; ++k) { p.ph_lo = k; p.ph_hi = k + 1; hipLaunchKernelGGL(fwd_kernel, dim3(grid), dim3(NTHREADS), LDS_BYTES, stream, p); }
#endif
}
```

```cpp
#include <hip/hip_runtime.h>
#include <cstdio>
#include <cstdint>

#ifndef INPROJ_ALIGN
#define INPROJ_ALIGN true
#endif
#ifndef INPROJ_SP2
#define INPROJ_SP2 true
#endif
#ifndef REP_PRO
#define REP_PRO 1
#endif
#ifndef REP_ROUTE
#define REP_ROUTE 1
#endif
#ifndef REP_NORM
#define REP_NORM 1
#endif
#ifndef REP_INPROJ
#define REP_INPROJ 1
#endif
#ifndef REP_ATT3
#define REP_ATT3 1
#endif
#ifndef REP_CMP
#define REP_CMP 1
#endif
#ifndef REP_SLC
#define REP_SLC 1
#endif
#ifndef REP_SCAT
#define REP_SCAT 1
#endif
#ifndef REP_G1
#define REP_G1 1
#endif
#ifndef N_LAUNCH_MODE
#define N_LAUNCH_MODE 0
#endif

#define LAS __attribute__((address_space(3)))
#define GAS __attribute__((address_space(1)))
typedef unsigned short bf16;
typedef unsigned long long u64;
typedef float f32x4 __attribute__((ext_vector_type(4)));
typedef unsigned u32x4 __attribute__((ext_vector_type(4)));

constexpr int B_ = 8, T_ = 4096, D_ = 1024, NT = B_ * T_, L_ = 2;
constexpr int HD = 64, D_IN = 2844;
constexpr int N_CMP = 255, CMP_HID = 256;
constexpr int NEXP = 32, DEXP = 256;
constexpr float EPS = 1e-6f;
constexpr float LOG2E = 1.4426950408889634f;
constexpr int NWAVES = 8, NTHREADS = 512;

constexpr int C_NSAQ = 0, C_KV6 = 512, C_GATE = 1280, C_FQ = 1304, C_FF = 2072, C_DQ = 2076, C_DV = 2588;

constexpr size_t MiB = 1u << 20;
constexpr size_t WS_CTL = 0, CTL_BYTES = 1 * MiB;
constexpr size_t WS_QN = 1 * MiB;
constexpr size_t WS_KV6 = WS_QN + 32 * MiB;
constexpr size_t KV6_STRIDE = 8 * MiB + 64 * 1024;
constexpr size_t WS_FQKV = WS_KV6 + 6 * KV6_STRIDE;
constexpr size_t WS_DQK = WS_FQKV + 48 * MiB;
constexpr size_t WS_DV = WS_DQK + 32 * MiB;
constexpr size_t WS_GATE = WS_DV + 16 * MiB;
constexpr size_t WS_FL = WS_GATE + 3 * MiB;
constexpr size_t WS_HC = WS_FL + 1 * MiB;
constexpr size_t WS_KVCMP = WS_HC + 4 * MiB;
constexpr size_t WS_SEL = WS_KVCMP + 1 * MiB;
constexpr size_t WS_OCMP = WS_SEL + 1 * MiB;
constexpr size_t WS_OWIN = WS_OCMP + 32 * MiB;
constexpr size_t WS_HN = WS_OWIN + 32 * MiB;
constexpr size_t WS_ATT = WS_HN + 64 * MiB;
constexpr size_t WS_ROUTE = WS_ATT + 64 * MiB;
constexpr size_t WS_WIN_T = WS_ROUTE + 2 * MiB;
constexpr size_t WS_WOUT_T = WS_WIN_T + 12 * MiB;
constexpr size_t WS_WGU_T = WS_WOUT_T + 4 * MiB;
constexpr size_t WS_WD_T = WS_WGU_T + 64 * MiB;
constexpr size_t WS_W1_T = WS_WD_T + 32 * MiB;
constexpr size_t WS_W2_T = WS_W1_T + 4 * MiB;
constexpr size_t WS_BIAS1 = WS_W2_T + 512 * 1024;
constexpr size_t WS_WR = WS_BIAS1 + 512 * 1024;
constexpr size_t WS_B1PART = WS_WR + 512 * 1024;
constexpr size_t WS_END = WS_B1PART + 512 * 1024;
constexpr int MOE_MAXROWS = 61440;
constexpr size_t WS_XS = WS_QN;
constexpr size_t WS_HB = WS_OCMP;
static_assert(WS_XS + (size_t)MOE_MAXROWS * 2048 <= WS_DQK && WS_HB + (size_t)MOE_MAXROWS * 1024 <= WS_HN, "MoE aliases");
constexpr size_t RT_INFO = 0, RT_W = 128 * 1024, RT_ROWTOK = 384 * 1024, RT_ROWW = 640 * 1024, RT_RSTD = 1152 * 1024;
constexpr int CW_QUEUE = 16384, CW_MOECNT = 32768, CW_KN = 49152;
constexpr int TBL_OFF = 131072 + 1024;
constexpr int NIN = 3072;

extern __shared__ __attribute__((aligned(16))) unsigned char lds_raw[];
__device__ __forceinline__ float bf2f(bf16 v) { return __uint_as_float(((unsigned)v) << 16); }
__device__ __forceinline__ unsigned f2bf(float f) { unsigned u = __float_as_uint(f); return (u + 0x7fffu + ((u >> 16) & 1u)) >> 16; }
__device__ __forceinline__ unsigned pk2(float lo, float hi) { return f2bf(lo) | (f2bf(hi) << 16); }
__device__ __forceinline__ float wave_sum(float v) {
#pragma unroll
    for (int o = 1; o < 64; o <<= 1) v += __shfl_xor(v, o);
    return v;
}
__device__ __forceinline__ float wave_max(float v) {
#pragma unroll
    for (int o = 1; o < 64; o <<= 1) v = fmaxf(v, __shfl_xor(v, o));
    return v;
}
__device__ __forceinline__ float shflx_f(float v, int o, int lane) { return __uint_as_float((unsigned)__builtin_amdgcn_ds_bpermute((lane ^ o) << 2, (int)__float_as_uint(v))); }
__device__ __forceinline__ unsigned shflx_u(unsigned v, int o, int lane) { return (unsigned)__builtin_amdgcn_ds_bpermute((lane ^ o) << 2, (int)v); }
__device__ __forceinline__ float wave_sum_l(float v, int lane) {
#pragma unroll
    for (int o = 1; o < 64; o <<= 1) v += shflx_f(v, o, lane);
    return v;
}
__device__ __forceinline__ int launder_s(int v) { asm volatile("" : "+s"(v)); return v; }
__device__ __forceinline__ float sigmoidf_(float x) { return 1.f / (1.f + __expf(-x)); }
__device__ __forceinline__ float log_sigmoidf_(float x) { return x >= 0.f ? -log1pf(__expf(-x)) : x - log1pf(__expf(x)); }
__device__ __forceinline__ float gelu_tanh(float x) { const float u = 0.7978845608028654f * (x + 0.044715f * x * x * x); return 0.5f * x * (1.f + tanhf(u)); }
__device__ __forceinline__ float alibi_slope(int idx1, int n) { return exp2f(-8.0f * (float)idx1 / (float)n); }

__device__ __forceinline__ constexpr int b64_off(int t, int d) { return ((t >> 4) * 2 + (d >> 5)) * 512 + (t & 15) * 32 + (d & 31); }
#define XB_TMO      128
#define XB_XCNT(j)  (256  + 64 * (j))
#define XB_XSUB(j)  (1280 + 64 * (j))
#define XB_XGEN(j)  (2304 + 64 * (j))
#define XB_TOP      3328
#define XB_TOPGEN   3392
#define XCD_BAR_WORDS 3456
#define XB_SPIN_CAP (1u << 25)
__device__ __forceinline__ unsigned xb_ld(unsigned* p)              { return __hip_atomic_load(p, __ATOMIC_RELAXED, __HIP_MEMORY_SCOPE_AGENT); }
__device__ __forceinline__ unsigned xb_add(unsigned* p, unsigned v) { return __hip_atomic_fetch_add(p, v, __ATOMIC_RELAXED, __HIP_MEMORY_SCOPE_AGENT); }
__device__ __forceinline__ unsigned xb_xcc_id() { return (unsigned)__builtin_amdgcn_s_getreg((3 << 11) | 20) & 0xFu; }
#define XB_SPIN(cond, bar) do { unsigned _sp = 0; while (cond) { __builtin_amdgcn_s_sleep(1); \
    if ((++_sp & 255u) == 0u) { if (xb_ld(&(bar)[XB_TMO])) break; if (_sp > XB_SPIN_CAP) { atomicAdd(&(bar)[XB_TMO], 1u); break; } } } } while (0)
struct XcdBarrier { unsigned* bar; unsigned x; volatile LAS unsigned* st; };
__device__ __forceinline__ XcdBarrier xcd_barrier_post(unsigned* bar, volatile LAS unsigned* st) {
    XcdBarrier b; b.bar = bar; b.x = xb_xcc_id(); b.st = st;
    if (threadIdx.x == 0) (void)xb_add(&bar[XB_XCNT(b.x)], 1u);
    return b;
}
__device__ __forceinline__ void xcd_barrier_complete(unsigned* bar, unsigned x, unsigned& nloc, unsigned& nx) {
    const unsigned G = gridDim.x * gridDim.y * gridDim.z;
    unsigned sum, cnt, mine, sp = 0u;
    for (;;) {
        sum = 0u; cnt = 0u; mine = 0u;
#pragma unroll
        for (unsigned j = 0; j < 16; ++j) { const unsigned c = xb_ld(&bar[XB_XCNT(j)]); sum += c; cnt += (c > 0u) ? 1u : 0u; mine = (j == x) ? c : mine; }
        if (sum == G) break;
        __builtin_amdgcn_s_sleep(1);
        if ((++sp & 255u) == 0u) { if (xb_ld(&bar[XB_TMO])) break; if (sp > XB_SPIN_CAP) { atomicAdd(&bar[XB_TMO], 1u); break; } }
    }
    nloc = mine > 0u ? mine : 1u; nx = cnt > 0u ? cnt : 1u;
}
__device__ __forceinline__ void xcd_barrier(const XcdBarrier& b) {
    asm volatile("s_waitcnt vmcnt(0)" ::: "memory");
    __syncthreads();
    if (threadIdx.x == 0) {
        unsigned* bar = b.bar;
        __builtin_amdgcn_s_waitcnt(0);
        unsigned nloc = b.st[0], nx = b.st[1];
        if (nloc == 0u) { xcd_barrier_complete(bar, b.x, nloc, nx); b.st[0] = nloc; b.st[1] = nx; }
        const unsigned old = xb_add(&bar[XB_XSUB(b.x)], 1u);
        const unsigned gen = old / nloc;
        if (old + 1u == (gen + 1u) * nloc) {
            __builtin_amdgcn_fence(__ATOMIC_RELEASE, "agent");
            asm volatile("s_waitcnt vmcnt(0)" ::: "memory");
            const unsigned og = xb_add(&bar[XB_TOP], 1u);
            const unsigned tg = og / nx;
            if (og + 1u == (tg + 1u) * nx) xb_add(&bar[XB_TOPGEN], 1u);
            else XB_SPIN(xb_ld(&bar[XB_TOPGEN]) == tg, bar);
            __builtin_amdgcn_fence(__ATOMIC_ACQUIRE, "agent");
            xb_add(&bar[XB_XGEN(b.x)], 1u);
            asm volatile("s_waitcnt vmcnt(0)" ::: "memory");
        } else {
            XB_SPIN(xb_ld(&bar[XB_XGEN(b.x)]) == gen, bar);
            __builtin_amdgcn_fence(__ATOMIC_ACQUIRE, "agent");
            asm volatile("s_waitcnt vmcnt(0)" ::: "memory");
        }
    }
    __syncthreads();
}

struct Params { const float* in[23]; float* out; unsigned char* ws; int ph_lo, ph_hi; };
constexpr int LDS_BYTES = 147456;
constexpr int MISC_OFF = 131072 + 320;

struct Ctx {
    LAS unsigned char* lds; int tid, lane, wave, bid, G, gw, ngw;
    const float* const* in; float* xcur; unsigned char* ws;
};

namespace pg8 {
#define PG8_LAS __attribute__((address_space(3)))
typedef unsigned short bf16_t;
typedef short bf16x8 __attribute__((ext_vector_type(8)));
typedef float f32x4 __attribute__((ext_vector_type(4)));
typedef unsigned u32x4 __attribute__((ext_vector_type(4)));
constexpr int BM = 256, BK = 64, HALF = 128, HTB = HALF * BK * 2  , STAGE_BYTES = 8 * HTB, NXCD = 8, WGM = 8;

__host__ __device__ __forceinline__ int lds_byte(int r, int c) { const int st = (r >> 4) * 2 + (c >> 5), rr = r & 15, cc = c & 31, ob = rr * 64 + cc * 2; return st * 1024 + (ob ^ (((ob >> 9) & 1) << 5)); }
__host__ __device__ __forceinline__ void stage_rc(int b, int& R, int& C) { const int st = b / 1024, sb = b % 1024, swz = sb ^ (((sb >> 9) & 1) << 5); R = (st >> 1) * 16 + swz / 64; C = (st & 1) * 32 + (swz % 64) / 2; }
__host__ __device__ __forceinline__ int perm32(int rho) { const int n = rho >> 4, i = rho & 15; return 8 * (i >> 2) + 4 * n + (i & 3); }

struct Unit { int pm, pn; const char* a; const char* b; const char* b2; };
struct Gemm { int lda, ldb, K, ksplit, arb, acb; };

__device__ __forceinline__ unsigned cvt_pk_bf16(float lo, float hi) { unsigned r; asm volatile("v_cvt_pk_bf16_f32 %0, %1, %2" : "=v"(r) : "v"(lo), "v"(hi)); return r; }
typedef float f32x2 __attribute__((ext_vector_type(2)));

template <class Epi, class Sched, bool ALIGN_EPI = false, bool SP2 = false>
__device__ __forceinline__ void gemm_phase(PG8_LAS unsigned char* lds, const Gemm g, const Sched& S, const Epi& E) {
    int tid_ = threadIdx.x; asm volatile("" : "+v"(tid_));
    const int tid = tid_, wid = __builtin_amdgcn_readfirstlane(tid >> 6), lane = tid & 63, wr = wid >> 2, wc = wid & 3, fr = lane & 15, fq = lane >> 4;
    const int K = g.K, nt = K / BK, ks = g.ksplit;
    unsigned voffA[2], voffB[2];
#pragma unroll
    for (int i = 0; i < 2; ++i) { int R, C; stage_rc(tid * 16 + i * 8192, R, C); const int Rb = Epi::PERM ? ((R & ~31) + perm32(R & 31)) : R;
        voffA[i] = g.arb ? (unsigned)(((R / g.arb) * (K / g.acb) + C / g.acb) * (g.arb * g.acb) + (R % g.arb) * g.acb + (C % g.acb)) * 2u : (unsigned)(R * g.lda + C) * 2u; voffB[i] = (unsigned)(Rb * g.ldb + C) * 2u; }
    const size_t kstep = (size_t)(BK * 2), kstepA = g.arb ? (size_t)(BK * g.arb * 2) : kstep;
    const size_t hsA = (size_t)HALF * (g.arb ? K : g.lda) * 2, hsB = (size_t)HALF * g.ldb * 2;
    const unsigned ldsw = (unsigned)wid * 1024u;
    const int aoff = lds_byte(wr * 64 + fr, fq * 8), boff = lds_byte(wc * 32 + fr, fq * 8);
#define PG8_SA(b, h) (((b) * 2 + (h)) * HTB)
#define PG8_SB(b, h) ((4 + (b) * 2 + (h)) * HTB)
#define PG8_STAGE(bufoff, gbase, voff) do { _Pragma("unroll") for (int _i = 0; _i < 2; ++_i) \
        __builtin_amdgcn_global_load_lds((const unsigned*)((const char*)(gbase) + (voff)[_i]), (PG8_LAS unsigned*)(lds + (bufoff) + ldsw + _i * 8192), 16, 0, 0); } while (0)
#define PG8_LDA(dst, b, h) do { _Pragma("unroll") for (int m = 0; m < 4; ++m) _Pragma("unroll") for (int k = 0; k < 2; ++k) dst[m][k] = *(const PG8_LAS bf16x8*)(lds + PG8_SA(b, h) + aoff + m * 2048 + k * 1024); } while (0)
#define PG8_LDB(dst, b, h) do { _Pragma("unroll") for (int n = 0; n < 2; ++n) _Pragma("unroll") for (int k = 0; k < 2; ++k) dst[n][k] = *(const PG8_LAS bf16x8*)(lds + PG8_SB(b, h) + boff + n * 2048 + k * 1024); } while (0)
#define PG8_MMA(ai, bj, At, Bt) do { __builtin_amdgcn_s_setprio(1); _Pragma("unroll") for (int m = 0; m < 4; ++m) _Pragma("unroll") for (int n = 0; n < 2; ++n) _Pragma("unroll") for (int k = 0; k < 2; ++k) \
        acc[ai][bj][m][n] = __builtin_amdgcn_mfma_f32_16x16x32_bf16(Bt[n][k], At[m][k], acc[ai][bj][m][n], 0, 0, 0); __builtin_amdgcn_s_setprio(0); } while (0)
#define PG8_WAIT_V(n) asm volatile("s_waitcnt vmcnt(" #n ")" ::: "memory")
#define PG8_WAIT_L(n) asm volatile("s_waitcnt lgkmcnt(" #n ")" ::: "memory")
#define PG8_BAR __builtin_amdgcn_s_barrier()
#define PG8_SCHED __builtin_amdgcn_sched_barrier(0)
    Unit cur, nxt; int ui = 0;
    if (!S.next(0, cur)) return;
    f32x4 acc[2][2][4][2];
#pragma unroll
    for (int a = 0; a < 2; ++a)
#pragma unroll
        for (int b = 0; b < 2; ++b)
#pragma unroll
            for (int m = 0; m < 4; ++m)
#pragma unroll
                for (int n = 0; n < 2; ++n) acc[a][b][m][n] = (f32x4){0.f, 0.f, 0.f, 0.f};
    bf16x8 At[4][2], B0[2][2], B1[2][2];
    const char* cA = cur.a; const char* cB = cur.b; const char* cB2 = cur.b2;
#define PG8_BK(base, base2, kt) ((kt) < ks ? (base) + (size_t)(kt) * kstep : (base2) + (size_t)((kt) - ks) * kstep)
    S.a_ready(cur);
    if constexpr (SP2) {
        PG8_STAGE(PG8_SB(0, 0), cB, voffB); PG8_STAGE(PG8_SB(0, 1), cB + hsB, voffB); PG8_STAGE(PG8_SA(0, 0), cA, voffA); PG8_STAGE(PG8_SA(0, 1), cA + hsA, voffA);
        if (wr == 1) PG8_BAR;
        PG8_WAIT_V(2); PG8_BAR;
        PG8_STAGE(PG8_SB(1, 0), PG8_BK(cB, cB2, 1), voffB); PG8_STAGE(PG8_SA(1, 0), cA + kstepA, voffA); PG8_STAGE(PG8_SB(1, 1), PG8_BK(cB, cB2, 1) + hsB, voffB);
        PG8_WAIT_V(6); PG8_BAR;
    } else {
        PG8_STAGE(PG8_SB(0, 0), cB, voffB); PG8_STAGE(PG8_SA(0, 0), cA, voffA); PG8_STAGE(PG8_SB(0, 1), cB + hsB, voffB); PG8_STAGE(PG8_SA(0, 1), cA + hsA, voffA);
        if (wr == 1) PG8_BAR;
        PG8_WAIT_V(4); PG8_BAR;
        PG8_STAGE(PG8_SB(1, 0), PG8_BK(cB, cB2, 1), voffB); PG8_STAGE(PG8_SA(1, 0), cA + kstepA, voffA); PG8_STAGE(PG8_SB(1, 1), PG8_BK(cB, cB2, 1) + hsB, voffB);
        PG8_WAIT_V(6); PG8_BAR;
    }
    for (;;) {
        const bool has_next = S.next(ui + 1, nxt);
        const char* nA = has_next ? nxt.a : cA; const char* nB = has_next ? nxt.b : cB; const char* nB2 = has_next ? nxt.b2 : cB2;
#pragma unroll 1
        for (int t = 0; t < nt; t += 2) {
            const bool last = (t == nt - 2);
            const char* a1 = cA + (size_t)(t + 1) * kstepA;
            const char* a2 = last ? nA : cA + (size_t)(t + 2) * kstepA; const char* b2 = last ? PG8_BK(nB, nB2, 0) : PG8_BK(cB, cB2, t + 2);
            const char* a3 = a2 + kstepA; const char* b3 = last ? PG8_BK(nB, nB2, 1) : PG8_BK(cB, cB2, t + 3);
            if (last && has_next) S.a_ready(nxt);
            if constexpr (SP2) {
            PG8_LDB(B0, 0, 0); PG8_LDB(B1, 0, 1); PG8_SCHED; PG8_LDA(At, 0, 0); PG8_STAGE(PG8_SA(1, 1), a1 + hsA, voffA);
            PG8_WAIT_V(8); PG8_WAIT_L(0); PG8_BAR; PG8_MMA(0, 0, At, B0); PG8_MMA(0, 1, At, B1); PG8_BAR; PG8_SCHED;
            PG8_LDA(At, 0, 1); PG8_STAGE(PG8_SB(0, 0), b2, voffB); PG8_STAGE(PG8_SB(0, 1), b2 + hsB, voffB); PG8_STAGE(PG8_SA(0, 0), a2, voffA);
            PG8_WAIT_V(8); PG8_WAIT_L(0); PG8_BAR; PG8_MMA(1, 0, At, B0); PG8_MMA(1, 1, At, B1); PG8_BAR; PG8_SCHED;
            PG8_LDB(B0, 1, 0); PG8_LDB(B1, 1, 1); PG8_SCHED; PG8_LDA(At, 1, 0); PG8_STAGE(PG8_SA(0, 1), a2 + hsA, voffA);
            PG8_WAIT_V(8); PG8_WAIT_L(0); PG8_BAR; PG8_MMA(0, 0, At, B0); PG8_MMA(0, 1, At, B1); PG8_BAR; PG8_SCHED;
            PG8_LDA(At, 1, 1); PG8_STAGE(PG8_SB(1, 0), b3, voffB); PG8_STAGE(PG8_SB(1, 1), b3 + hsB, voffB); PG8_STAGE(PG8_SA(1, 0), a3, voffA);
            PG8_WAIT_V(8); PG8_WAIT_L(0); PG8_BAR; PG8_MMA(1, 0, At, B0); PG8_MMA(1, 1, At, B1); PG8_BAR; PG8_SCHED;
            } else {
            PG8_LDB(B0, 0, 0); PG8_SCHED; PG8_LDA(At, 0, 0); PG8_STAGE(PG8_SA(1, 1), a1 + hsA, voffA);
            PG8_WAIT_L(8); PG8_BAR; PG8_WAIT_L(0); PG8_MMA(0, 0, At, B0); PG8_BAR; PG8_SCHED;
            PG8_LDB(B1, 0, 1); PG8_STAGE(PG8_SB(0, 0), b2, voffB);
            PG8_BAR; PG8_WAIT_L(0); PG8_MMA(0, 1, At, B1); PG8_BAR;
            PG8_LDA(At, 0, 1); PG8_STAGE(PG8_SA(0, 0), a2, voffA);
            PG8_BAR; PG8_WAIT_L(0); PG8_MMA(1, 0, At, B0); PG8_BAR; PG8_SCHED;
            PG8_STAGE(PG8_SB(0, 1), b2 + hsB, voffB);
            PG8_WAIT_V(6); PG8_BAR; PG8_MMA(1, 1, At, B1); PG8_BAR;
            PG8_LDB(B0, 1, 0); PG8_SCHED; PG8_LDA(At, 1, 0); PG8_STAGE(PG8_SA(0, 1), a2 + hsA, voffA);
            PG8_WAIT_L(8); PG8_BAR; PG8_WAIT_L(0); PG8_MMA(0, 0, At, B0); PG8_BAR; PG8_SCHED;
            PG8_LDB(B1, 1, 1); PG8_STAGE(PG8_SB(1, 0), b3, voffB);
            PG8_BAR; PG8_WAIT_L(0); PG8_MMA(0, 1, At, B1); PG8_BAR;
            PG8_LDA(At, 1, 1); PG8_STAGE(PG8_SA(1, 0), a3, voffA);
            PG8_BAR; PG8_WAIT_L(0); PG8_MMA(1, 0, At, B0); PG8_BAR; PG8_SCHED;
            PG8_STAGE(PG8_SB(1, 1), b3 + hsB, voffB);
            PG8_WAIT_V(6); PG8_BAR; PG8_MMA(1, 1, At, B1); PG8_BAR;
            }
        }
        if constexpr (ALIGN_EPI) { if (wr == 0) PG8_BAR; }
        if constexpr (!Epi::AFTER_DRAIN) { E(acc, cur, wr, wc, fr, fq); S.done(cur); }
        if (!has_next) break;
#pragma unroll
        for (int a = 0; a < 2; ++a)
#pragma unroll
            for (int b = 0; b < 2; ++b)
#pragma unroll
                for (int m = 0; m < 4; ++m)
#pragma unroll
                    for (int n = 0; n < 2; ++n) acc[a][b][m][n] = (f32x4){0.f, 0.f, 0.f, 0.f};
        cur = nxt; cA = nA; cB = nB; cB2 = nB2; ++ui;
        if constexpr (ALIGN_EPI) { if (wr == 1) PG8_BAR; }
    }
    PG8_WAIT_V(0);
    if constexpr (!ALIGN_EPI) { if (wr == 0) PG8_BAR; }
    PG8_BAR;
    if constexpr (Epi::AFTER_DRAIN) { E.fused(acc, cur, wr, wc, fr, fq, lds, wid, lane); S.done(cur); }
#undef PG8_BK
#undef PG8_SA
#undef PG8_SB
#undef PG8_STAGE
#undef PG8_LDA
#undef PG8_LDB
#undef PG8_MMA
#undef PG8_WAIT_V
#undef PG8_WAIT_L
#undef PG8_BAR
#undef PG8_SCHED
}
}

struct PlainOrder {
    const char* A; const char* Bt; int lda, ldb, nM, nN, nwg, G, c;
    __device__ __forceinline__ void init(const void* A_, const void* Bt_, int lda_, int ldb_, int M, int N, int G_, int c_) { A = (const char*)A_; Bt = (const char*)Bt_; lda = lda_; ldb = ldb_; nM = M / 256; nN = N / 256; nwg = nM * nN; G = G_; c = c_; }
    __device__ __forceinline__ bool next(int i, pg8::Unit& u) const {
        const long L = (long)i * G + c; if (L >= nwg) return false;
        int wgid = (int)L; { const int q = nwg / 8, r = nwg % 8, xcd = wgid % 8, off = wgid / 8; wgid = (xcd < r ? xcd * (q + 1) : r * (q + 1) + (xcd - r) * q) + off; }
        const int nig = 8 * nN, gid = wgid / nig, fm = gid * 8, gsz = (nM - fm) < 8 ? (nM - fm) : 8;
        u.pm = fm + ((wgid % nig) % gsz); u.pn = (wgid % nig) / gsz;
        u.a = A + (size_t)u.pm * 256 * lda * 2; u.b = Bt + (size_t)u.pn * 256 * ldb * 2; u.b2 = u.b; return true;
    }
    __device__ __forceinline__ void a_ready(const pg8::Unit&) const {}
    __device__ __forceinline__ void done(const pg8::Unit&) const {}
};
struct EpiInProj {
    static constexpr bool PERM = true, AFTER_DRAIN = false;
    unsigned char* ws; const float* b_gate; const float* b_fgt; unsigned* kn;
    __device__ __forceinline__ void operator()(const pg8::f32x4 (&acc)[2][2][4][2], const pg8::Unit& u, int wr, int wc, int fr, int fq) const {
        { int t_ = threadIdx.x; asm volatile("" : "+v"(t_)); fr = t_ & 15; fq = (t_ >> 4) & 3; }
        const int pn = u.pn, b = (u.pm * 256) / T_, t0 = u.pm * 256 - b * T_ + wr * 64 + fr;
        if (pn == 11) {
            if (wc == 0 && fq < 4) {
                float* gate = (float*)(ws + WS_GATE); float* fl = (float*)(ws + WS_FL);
#pragma unroll
                for (int ai = 0; ai < 2; ++ai)
#pragma unroll
                    for (int m = 0; m < 4; ++m) { const int t = t0 + ai * 128 + m * 16; const size_t n = (size_t)b * T_ + t;
#pragma unroll
                        for (int nn = 0; nn < 2; ++nn)
#pragma unroll
                            for (int e = 0; e < 4; ++e) { const int c = 8 * fq + 4 * nn + e; const float v = acc[ai][0][m][nn][e];
                                if (c < 24) gate[n * 24 + c] = __builtin_amdgcn_rcpf(1.f + __builtin_amdgcn_exp2f(-(v + b_gate[c]) * LOG2E));
                                else if (c < 28) { const float z = v + b_fgt[c - 24];
                                    fl[(size_t)(b * 4 + (c - 24)) * T_ + t] = z < -30.f ? z : -0.6931471805599453f * __builtin_amdgcn_logf(1.f + __builtin_amdgcn_exp2f(-z * LOG2E)); } } }
            }
            return;
        }
        if (pn == 6 || pn == 9) {
            const int lane_ = (fq << 4) | fr;
#pragma unroll
            for (int bj = 0; bj < 2; ++bj)
#pragma unroll
                for (int ai = 0; ai < 2; ++ai) { float mx = 0.f;
#pragma unroll
                    for (int m = 0; m < 4; ++m) { const pg8::f32x4 v0 = acc[ai][bj][m][0], v1 = acc[ai][bj][m][1];
                        float ss = (v0[0] * v0[0] + v0[1] * v0[1]) + (v0[2] * v0[2] + v0[3] * v0[3]) + (v1[0] * v1[0] + v1[1] * v1[1]) + (v1[2] * v1[2] + v1[3] * v1[3]);
                        ss += shflx_f(ss, 16, lane_); ss += shflx_f(ss, 32, lane_); mx = fmaxf(mx, ss); }
#pragma unroll
                    for (int o = 1; o < 16; o <<= 1) mx = fmaxf(mx, shflx_f(mx, o, lane_));
                    if (lane_ == 0) { const int cg = bj * 4 + wc, tile = (u.pm * 256 - b * T_ + ai * 128 + wr * 64) >> 6;
                        unsigned* dst = pn == 6 ? kn + ((b * 4 + (cg >> 1)) * 64 + tile) * 2 + (cg & 1) : kn + 4096 + (b * 8 + cg) * 64 + tile;
                        atomicMax(dst, __float_as_uint(mx)); } }
        }
#pragma unroll
        for (int bj = 0; bj < 2; ++bj) {
            const int c = bj * 128 + wc * 32 + 8 * fq;
            bf16* base; int W = 64; float sc = 1.f;
            if (pn < 2) { base = (bf16*)(ws + WS_QN) + (size_t)(b * 8 + pn * 4 + (c >> 6)) * T_ * 64 + (c & 63); sc = 0.125f * LOG2E; }
            else if (pn < 5) { base = (bf16*)(ws + WS_KV6 + (size_t)((pn - 2) * 2 + (c >> 7)) * KV6_STRIDE) + (size_t)(b * 2 + ((c >> 6) & 1)) * T_ * 64 + (c & 63); }
            else if (pn < 8) { base = (bf16*)(ws + WS_FQKV) + (size_t)(pn - 5) * (8 * MiB) + (size_t)(b * 4 + (c >> 6)) * T_ * 64 + (c & 63); if (pn == 5) sc = 0.125f * LOG2E; }
            else if (pn < 10) { base = (bf16*)(ws + WS_DQK) + (size_t)(pn - 8) * (8 * MiB) + (size_t)(b * 8 + (c >> 5)) * T_ * 32 + (c & 31); W = 32; if (pn == 8) sc = 0.17677669529663687f * LOG2E; }
            else { base = (bf16*)(ws + WS_DV) + (size_t)(b * 4 + (c >> 6)) * T_ * 64 + (c & 63); }
            const bool blk = W == 64 && pn != 2;
            if (blk) base += -(c & 63) + ((c >> 5) & 1) * 512 + (c & 31);
#pragma unroll
            for (int ai = 0; ai < 2; ++ai)
#pragma unroll
                for (int m = 0; m < 4; ++m) { const int t = t0 + ai * 128 + m * 16;
                    const pg8::f32x4 v0 = acc[ai][bj][m][0] * sc, v1 = acc[ai][bj][m][1] * sc;
                    pg8::u32x4 w; w.x = pg8::cvt_pk_bf16(v0[0], v0[1]); w.y = pg8::cvt_pk_bf16(v0[2], v0[3]); w.z = pg8::cvt_pk_bf16(v1[0], v1[1]); w.w = pg8::cvt_pk_bf16(v1[2], v1[3]);
                    *(pg8::u32x4*)(base + (blk ? (size_t)((t >> 4) * 1024 + (t & 15) * 32) : (size_t)t * W)) = w; }
        }
    }
};
struct EpiResBf16 {
    static constexpr bool PERM = false, AFTER_DRAIN = false;
    bf16* xr;
    __device__ __forceinline__ void operator()(const pg8::f32x4 (&acc)[2][2][4][2], const pg8::Unit& u, int wr, int wc, int fr, int fq) const {
        { int t_ = threadIdx.x; asm volatile("" : "+v"(t_)); fr = t_ & 15; fq = (t_ >> 4) & 3; }
#pragma unroll
        for (int ai = 0; ai < 2; ++ai)
#pragma unroll
            for (int m = 0; m < 4; ++m) { const size_t off = (size_t)(u.pm * 256 + ai * 128 + wr * 64 + m * 16 + fr) * D_ + u.pn * 256 + wc * 32 + 4 * fq;
#pragma unroll
                for (int bj = 0; bj < 2; ++bj)
#pragma unroll
                    for (int n = 0; n < 2; ++n) { const u64 w = *(const u64*)(xr + off + bj * 128 + n * 16);
                        const pg8::f32x4 bs = {__uint_as_float((unsigned)w << 16), __uint_as_float((unsigned)w & 0xffff0000u), __uint_as_float((unsigned)(w >> 32) << 16), __uint_as_float((unsigned)(w >> 32) & 0xffff0000u)};
                        const pg8::f32x4 o = bs + acc[ai][bj][m][n];
                        *(u64*)(xr + off + bj * 128 + n * 16) = (u64)pg8::cvt_pk_bf16(o[0], o[1]) | ((u64)pg8::cvt_pk_bf16(o[2], o[3]) << 32); } }
    }
};


struct EpiDummy {
    static constexpr bool PERM = true, AFTER_DRAIN = false;
    float* dst;
    __device__ __forceinline__ void operator()(const pg8::f32x4 (&acc)[2][2][4][2], const pg8::Unit& u, int wr, int wc, int fr, int fq) const {
        pg8::f32x4 a = {0.f, 0.f, 0.f, 0.f};
#pragma unroll
        for (int ai = 0; ai < 2; ++ai)
#pragma unroll
            for (int bj = 0; bj < 2; ++bj)
#pragma unroll
                for (int m = 0; m < 4; ++m) { a = a + acc[ai][bj][m][0]; a = a + acc[ai][bj][m][1]; }
        *(pg8::f32x4*)(dst + ((size_t)(u.pm * 12 + u.pn) * 512 + threadIdx.x) * 4) = a;
    }
};
struct OneUnitOrder { pg8::Unit u; bool has;
    __device__ __forceinline__ bool next(int i, pg8::Unit& o) const { if (i != 0 || !has) return false; o = u; return true; }
    __device__ __forceinline__ void a_ready(const pg8::Unit&) const {}
    __device__ __forceinline__ void done(const pg8::Unit&) const {} };
__device__ __forceinline__ float gelu_tanh_fast(float x) { const float u2 = 1.5957691216057308f * (x + 0.044715f * x * x * x); return x * __builtin_amdgcn_rcpf(1.f + __builtin_amdgcn_exp2f(-u2 * LOG2E)); }
struct EpiCmpH {
    static constexpr bool PERM = true, AFTER_DRAIN = false;
    bf16* hc; const float* bias1;
    __device__ __forceinline__ void operator()(const pg8::f32x4 (&acc)[2][2][4][2], const pg8::Unit& u, int wr, int wc, int fr, int fq) const {
        { int t_ = threadIdx.x; asm volatile("" : "+v"(t_)); fr = t_ & 15; fq = (t_ >> 4) & 3; }
        const int kv = u.pn;
#pragma unroll
        for (int bj = 0; bj < 2; ++bj) { const int col = bj * 128 + wc * 32 + 8 * fq;
            const pg8::f32x4 b0 = *(const pg8::f32x4*)(bias1 + kv * 256 + col), b1 = *(const pg8::f32x4*)(bias1 + kv * 256 + col + 4);
#pragma unroll
            for (int ai = 0; ai < 2; ++ai)
#pragma unroll
                for (int m = 0; m < 4; ++m) { const int row = u.pm * 256 + ai * 128 + wr * 64 + m * 16 + fr;
                    const pg8::f32x4 v0 = acc[ai][bj][m][0] + b0, v1 = acc[ai][bj][m][1] + b1;
                    pg8::u32x4 w; w.x = pg8::cvt_pk_bf16(gelu_tanh_fast(v0[0]), gelu_tanh_fast(v0[1])); w.y = pg8::cvt_pk_bf16(gelu_tanh_fast(v0[2]), gelu_tanh_fast(v0[3]));
                    w.z = pg8::cvt_pk_bf16(gelu_tanh_fast(v1[0]), gelu_tanh_fast(v1[1])); w.w = pg8::cvt_pk_bf16(gelu_tanh_fast(v1[2]), gelu_tanh_fast(v1[3]));
                    *(pg8::u32x4*)(hc + ((size_t)kv * 4096 + row) * 256 + col) = w; } }
    }
};
struct EpiCmpOut {
    static constexpr bool PERM = true, AFTER_DRAIN = false;
    bf16* kvcmp;
    __device__ __forceinline__ void operator()(const pg8::f32x4 (&acc)[2][2][4][2], const pg8::Unit& u, int wr, int wc, int fr, int fq) const {
        { int t_ = threadIdx.x; asm volatile("" : "+v"(t_)); fr = t_ & 15; fq = (t_ >> 4) & 3; }
        if (wc >= 2) return;
        const int kv = u.pn, col = wc * 32 + 8 * fq;
#pragma unroll
        for (int ai = 0; ai < 2; ++ai)
#pragma unroll
            for (int m = 0; m < 4; ++m) { const int row = u.pm * 256 + ai * 128 + wr * 64 + m * 16 + fr; const float z = ((row & 255) == 255) ? 0.f : 1.f;
                const pg8::f32x4 v0 = acc[ai][0][m][0], v1 = acc[ai][0][m][1];
                pg8::u32x4 w; w.x = pg8::cvt_pk_bf16(z != 0.f ? v0[0] : 0.f, z != 0.f ? v0[1] : 0.f); w.y = pg8::cvt_pk_bf16(z != 0.f ? v0[2] : 0.f, z != 0.f ? v0[3] : 0.f);
                w.z = pg8::cvt_pk_bf16(z != 0.f ? v1[0] : 0.f, z != 0.f ? v1[1] : 0.f); w.w = pg8::cvt_pk_bf16(z != 0.f ? v1[2] : 0.f, z != 0.f ? v1[3] : 0.f);
                *(pg8::u32x4*)(kvcmp + ((size_t)kv * 4096 + row) * 64 + col) = w; }
    }
};

__device__ __forceinline__ void moe_build_tables(const unsigned* cnt, int tid) {
    LAS int* T = (LAS int*)((LAS unsigned char*)lds_raw + TBL_OFF);
    __syncthreads();
    if (tid < 112) T[128 + 256 + tid] = (int)((cnt[tid] + 255u) >> 8);
    __syncthreads();
    if (tid == 0) { int o = 0; for (int c = 0; c < 112; ++c) { T[c] = o; const int n = T[128 + 256 + c]; for (int k = 0; k < n; ++k) T[128 + o + k] = c; o += n; } T[112] = o; }
    __syncthreads();
}
__device__ __forceinline__ void moe_pair(int cls, int& ea, int& eb) { const int grp = cls / 28; int idx = cls % 28, lo = 0; while (idx >= 7 - lo) { idx -= 7 - lo; ++lo; } ea = grp * 8 + lo; eb = grp * 8 + lo + 1 + idx; }
struct MoeOrder1 {
    const char* xs; const char* wgu; int G, c;
    __device__ __forceinline__ bool next(int i, pg8::Unit& u) const {
        const LAS int* T = (const LAS int*)((LAS unsigned char*)lds_raw + TBL_OFF);
        const int idx = i * G + c; if (idx >= 4 * T[112]) return false;
        const int tile = idx >> 2, pn = idx & 3; int ea, eb; moe_pair(T[128 + tile], ea, eb); const int e = (pn >> 1) ? eb : ea;
        u.pm = tile; u.pn = pn; u.a = xs + (size_t)tile * 256 * 2048; u.b = wgu + ((size_t)e * 512 + (pn & 1) * 256) * 2048; u.b2 = u.b; return true; }
    __device__ __forceinline__ void a_ready(const pg8::Unit&) const {}
    __device__ __forceinline__ void done(const pg8::Unit&) const {} };
struct MoeOrder2 {
    const char* hb; const char* wd; int G, c;
    __device__ __forceinline__ bool next(int i, pg8::Unit& u) const {
        const LAS int* T = (const LAS int*)((LAS unsigned char*)lds_raw + TBL_OFF);
        const int idx = i * G + c; if (idx >= 4 * T[112]) return false;
        const int tile = idx >> 2, pn = idx & 3; int ea, eb; moe_pair(T[128 + tile], ea, eb);
        u.pm = tile; u.pn = pn; u.a = hb + (size_t)tile * 256 * 1024; u.b = wd + ((size_t)ea * 1024 + pn * 256) * 512; u.b2 = wd + ((size_t)eb * 1024 + pn * 256) * 512; return true; }
    __device__ __forceinline__ void a_ready(const pg8::Unit&) const {}
    __device__ __forceinline__ void done(const pg8::Unit&) const {} };
struct EpiMoeH {
    static constexpr bool PERM = true, AFTER_DRAIN = false;
    bf16* hb; const float* roww;
    __device__ __forceinline__ void operator()(const pg8::f32x4 (&acc)[2][2][4][2], const pg8::Unit& u, int wr, int wc, int fr, int fq) const {
        { int t_ = threadIdx.x; asm volatile("" : "+v"(t_)); fr = t_ & 15; fq = (t_ >> 4) & 3; }
        const int slot = u.pn >> 1;
#pragma unroll
        for (int ai = 0; ai < 2; ++ai)
#pragma unroll
            for (int m = 0; m < 4; ++m) { const size_t row = (size_t)u.pm * 256 + ai * 128 + wr * 64 + m * 16 + fr; const float w = roww[row * 2 + slot];
#pragma unroll
                for (int bj = 0; bj < 2; ++bj) { const int j0 = (u.pn & 1) * 128 + (bj * 128 + wc * 32 + 8 * fq) / 2;
                    const pg8::f32x4 v0 = acc[ai][bj][m][0], v1 = acc[ai][bj][m][1];
                    const float h0 = v0[0] * __builtin_amdgcn_rcpf(1.f + __builtin_amdgcn_exp2f(-v0[0] * LOG2E)) * v0[1] * w, h1 = v0[2] * __builtin_amdgcn_rcpf(1.f + __builtin_amdgcn_exp2f(-v0[2] * LOG2E)) * v0[3] * w;
                    const float h2 = v1[0] * __builtin_amdgcn_rcpf(1.f + __builtin_amdgcn_exp2f(-v1[0] * LOG2E)) * v1[1] * w, h3 = v1[2] * __builtin_amdgcn_rcpf(1.f + __builtin_amdgcn_exp2f(-v1[2] * LOG2E)) * v1[3] * w;
                    const int jg = slot * 256 + j0;
                    *(u64*)(hb + ((row >> 4) * 32 + (jg >> 4)) * 256 + (row & 15) * 16 + (jg & 15)) = (u64)pg8::cvt_pk_bf16(h0, h1) | ((u64)pg8::cvt_pk_bf16(h2, h3) << 32); } }
    }
};
struct EpiMoeOut {
    static constexpr bool PERM = false, AFTER_DRAIN = false;
    bf16* x; const int* rowtok;
    __device__ __forceinline__ void operator()(const pg8::f32x4 (&acc)[2][2][4][2], const pg8::Unit& u, int wr, int wc, int fr, int fq) const {
        { int t_ = threadIdx.x; asm volatile("" : "+v"(t_)); fr = t_ & 15; fq = (t_ >> 4) & 3; }
        bf16* xx = x; const int* rt = rowtok; asm volatile("" : "+s"(xx), "+s"(rt));
#pragma unroll
        for (int ai = 0; ai < 2; ++ai)
#pragma unroll
            for (int m = 0; m < 4; ++m) { const int tok = rt[(size_t)u.pm * 256 + ai * 128 + wr * 64 + m * 16 + fr];
                if (tok >= 0) { bf16* xr = xx + (size_t)tok * D_ + u.pn * 256 + wc * 32 + 4 * fq;
#pragma unroll
                    for (int bj = 0; bj < 2; ++bj)
#pragma unroll
                        for (int n = 0; n < 2; ++n) { u64* q = (u64*)(xr + bj * 128 + n * 16); const u64 w = *q; const pg8::f32x4 a = acc[ai][bj][m][n];
                            *q = (u64)pg8::cvt_pk_bf16(__uint_as_float((unsigned)w << 16) + a[0], __uint_as_float((unsigned)w & 0xffff0000u) + a[1]) | ((u64)pg8::cvt_pk_bf16(__uint_as_float((unsigned)(w >> 32) << 16) + a[2], __uint_as_float((unsigned)(w >> 32) & 0xffff0000u) + a[3]) << 32); } } }
    }
};

__device__ __forceinline__ void transpose_item(const float* W, int ldw, bf16* WT, int ldt, int r0, int rmul, int k0, LAS float* scr, int lane) {
    f32x4 v[8];
#pragma unroll
    for (int i = 0; i < 8; ++i) v[i] = *(const f32x4*)(W + (size_t)(k0 + i * 8 + (lane >> 3)) * ldw + (lane & 7) * 4);
#pragma unroll
    for (int i = 0; i < 8; ++i) { LAS float* d = scr + (i * 8 + (lane >> 3)) * 33 + (lane & 7) * 4; d[0] = v[i].x; d[1] = v[i].y; d[2] = v[i].z; d[3] = v[i].w; }
    asm volatile("s_waitcnt lgkmcnt(0)" ::: "memory");
    const int c = lane & 7;
#pragma unroll
    for (int j = 0; j < 4; ++j) { const int n = (lane >> 3) + 8 * j; const LAS float* sp = scr + (8 * c) * 33 + n;
        u32x4 o; o.x = pk2(sp[0 * 33], sp[1 * 33]); o.y = pk2(sp[2 * 33], sp[3 * 33]); o.z = pk2(sp[4 * 33], sp[5 * 33]); o.w = pk2(sp[6 * 33], sp[7 * 33]);
        *(u32x4*)(WT + (size_t)(r0 + rmul * n) * ldt + k0 + 8 * c) = o; }
    asm volatile("s_waitcnt lgkmcnt(0)" ::: "memory");
}
__device__ __forceinline__ void transpose_seg(const float* W, int ldw, int K, int sc0, int ncol, bf16* WT, int r0, int rmul, int item, LAS float* scr, int lane) {
    const int nb = ncol / 32, kb = item / nb, cb = item % nb;
    transpose_item(W + sc0 + cb * 32, ldw, WT, K, r0 + rmul * cb * 32, rmul, kb * 64, scr, lane);
}

typedef float f32x16 __attribute__((ext_vector_type(16)));
typedef short bf16x8v __attribute__((ext_vector_type(8)));
typedef short s16x4 __attribute__((ext_vector_type(4)));
typedef float f32x2_t __attribute__((ext_vector_type(2)));
typedef __bf16 bf16x2_t __attribute__((ext_vector_type(2)));
constexpr int A_KBUF = 10240, A_VBUF = 12288;
constexpr int A_KOFF = 0, A_VOFF = 2 * A_KBUF, A_BOFF = A_VOFF + 2 * A_VBUF, A_LDS_END = A_BOFF + 2 * 256;
__device__ __forceinline__ constexpr int crow0(int reg) { return (reg & 3) + 8 * (reg >> 2); }
__device__ __forceinline__ float swap_max(float m) { auto rr = __builtin_amdgcn_permlane32_swap(__float_as_uint(m), __float_as_uint(m), false, false); return fmaxf(__uint_as_float(rr[0]), __uint_as_float(rr[1])); }
__device__ __forceinline__ float swap_sum(float m) { auto rr = __builtin_amdgcn_permlane32_swap(__float_as_uint(m), __float_as_uint(m), false, false); return __uint_as_float(rr[0]) + __uint_as_float(rr[1]); }
__device__ __forceinline__ unsigned cvtpk(float lo, float hi) { f32x2_t v = {lo, hi}; bf16x2_t b = __builtin_convertvector(v, bf16x2_t); return __builtin_bit_cast(unsigned, b); }
__device__ __forceinline__ bf16x8v pack8(const f32x16& p, int b0) { u32x4 w; w.x = cvtpk(p[b0 + 0], p[b0 + 1]); w.y = cvtpk(p[b0 + 2], p[b0 + 3]); w.z = cvtpk(p[b0 + 4], p[b0 + 5]); w.w = cvtpk(p[b0 + 6], p[b0 + 7]); return __builtin_bit_cast(bf16x8v, w); }
__device__ __forceinline__ s16x4 tr_read(const LAS unsigned char* p) { typedef short v4i16_t __attribute__((ext_vector_type(4))); return __builtin_bit_cast(s16x4, __builtin_amdgcn_ds_read_tr16_b64_v4i16((LAS v4i16_t*)p)); }

template <int DQK, int NMAP, bool FOX, bool SLC>
__device__ __forceinline__ void attn_core(LAS unsigned char* L, const bf16* Kb0, const bf16* Kb1, const bf16* Vb, const LAS float* cum, float cum_ref,
                                          const bf16x8v (&Qf)[NMAP][DQK / 16], u64 tilemask, int t_lane, int tw0, int win, float slope2, unsigned selw0, unsigned selw1,
                                          f32x16 (&O)[NMAP][2], float (&M)[NMAP], float (&Ls)[NMAP], int tid, bool started0 = false) {
    constexpr int KP = DQK * 2 + 16, VP = 192;
    const int lane = tid & 63, r = lane & 31, h = lane >> 5;
    int kdst; const bf16* ksrc;
    if (DQK == 64) { kdst = (tid >> 3) * KP + (tid & 7) * 16; ksrc = Kb0 + b64_off(tid >> 3, (tid & 7) * 8); }
    else { const int mp = tid >> 8, tt = tid & 255; kdst = mp * 5120 + (tt >> 2) * KP + (tt & 3) * 16; ksrc = (mp ? Kb1 : Kb0) + (tt >> 2) * 32 + (tt & 3) * 8; }
    const int vdst = (tid >> 3) * VP + (tid & 7) * 16; const bf16* vsrc = Vb + b64_off(tid >> 3, (tid & 7) * 8);
    const LAS unsigned char* kfrag = L + A_KOFF + r * KP + h * 16;
    const LAS unsigned char* vfrag = L + A_VOFF + (4 * h + ((lane & 15) >> 2)) * VP + (16 * ((lane >> 4) & 1) + 4 * (lane & 3)) * 2;
    u32x4 kreg, vreg; float breg = 0.f;
    u64 mk = tilemask;
    int j = 63 - __builtin_clzll(mk); mk &= ~(1ull << j);
    { const int kv0 = j * 64; kreg = *(const u32x4*)(ksrc + (size_t)kv0 * DQK); vreg = *(const u32x4*)(vsrc + (size_t)kv0 * 64); if (FOX && tid < 64) breg = (cum_ref - cum[kv0 + tid]) * LOG2E; }
    *(LAS u32x4*)(L + A_KOFF + kdst) = kreg; *(LAS u32x4*)(L + A_VOFF + vdst) = vreg; if (FOX && tid < 64) *(LAS float*)(L + A_BOFF + tid * 4) = breg;
    __syncthreads();
    int buf = 0; bool started = started0;
    float pdummy = 0.f; int idummy = 0; f32x16 dm0; for (int i = 0; i < 16; ++i) dm0[i] = 0.f;
    for (;;) {
        const bool more = mk != 0ull; int jn = 0;
        if (more) { jn = 63 - __builtin_clzll(mk); mk &= ~(1ull << jn); const int kv0 = jn * 64;
            kreg = *(const u32x4*)(ksrc + (size_t)kv0 * DQK); vreg = *(const u32x4*)(vsrc + (size_t)kv0 * 64); if (FOX && tid < 64) breg = (cum_ref - cum[kv0 + tid]) * LOG2E; }
        { const int kv0 = j * 64;
          bool wave_has = true; float selb = 0.f;
          if (SLC) { const bool mine = ((j < 32 ? (selw0 >> j) : (selw1 >> (j - 32))) & 1u) != 0u; selb = mine ? 0.f : -INFINITY; wave_has = __any(mine); }
          if (wave_has && !(kv0 > tw0 + 31) && !(tw0 - (kv0 + 63) >= win)) {
            const bool need_mask = (kv0 + 63 > tw0) || (tw0 + 31 - kv0 >= win);
            const int dl = t_lane - kv0 - 4 * h;
            bf16x8v pa[NMAP][4];
#pragma unroll
            for (int mp = 0; mp < NMAP; ++mp) {
                f32x16 p0, p1;
                if (FOX) { const LAS f32x4* bl = (const LAS f32x4*)(L + A_BOFF + buf * 256) + h; const float mm = M[mp];
#pragma unroll
                    for (int g4 = 0; g4 < 4; ++g4) { const f32x4 b0 = bl[2 * g4], b1 = bl[8 + 2 * g4];
                        p0[4 * g4 + 0] = b0.x - mm; p0[4 * g4 + 1] = b0.y - mm; p0[4 * g4 + 2] = b0.z - mm; p0[4 * g4 + 3] = b0.w - mm; p1[4 * g4 + 0] = b1.x - mm; p1[4 * g4 + 1] = b1.y - mm; p1[4 * g4 + 2] = b1.z - mm; p1[4 * g4 + 3] = b1.w - mm; } }
                else { const float base_l = (slope2 * (float)(kv0 + 4 * h - tw0) - M[mp]) + selb, s8 = slope2 * 8.f, s32 = slope2 * 32.f;
                    p0[0] = base_l; p0[1] = p0[0] + slope2; p0[2] = p0[1] + slope2; p0[3] = p0[2] + slope2;
#pragma unroll
                    for (int reg = 4; reg < 16; ++reg) p0[reg] = p0[reg - 4] + s8;
#pragma unroll
                    for (int reg = 0; reg < 16; ++reg) p1[reg] = p0[reg] + s32; }
                const LAS unsigned char* kb = kfrag + buf * A_KBUF + (DQK == 32 ? mp * 5120 : 0);
#pragma unroll
                for (int s = 0; s < DQK / 16; ++s) { const bf16x8v kf0 = *(const LAS bf16x8v*)(kb + s * 32), kf1 = *(const LAS bf16x8v*)(kb + 32 * KP + s * 32);
#ifdef PROBE_X_LDSK
                    { const bf16x8v z0 = *(const volatile LAS bf16x8v*)(kb + s * 32), z1 = *(const volatile LAS bf16x8v*)(kb + 32 * KP + s * 32); idummy ^= z0[0] ^ z1[1]; }
#endif
#ifdef PROBE_X_MFMA
                    dm0 = __builtin_amdgcn_mfma_f32_32x32x16_bf16(kf0, Qf[mp][s], dm0, 0, 0, 0); dm0 = __builtin_amdgcn_mfma_f32_32x32x16_bf16(kf1, Qf[mp][s], dm0, 0, 0, 0);
#endif
                    p0 = __builtin_amdgcn_mfma_f32_32x32x16_bf16(kf0, Qf[mp][s], p0, 0, 0, 0); p1 = __builtin_amdgcn_mfma_f32_32x32x16_bf16(kf1, Qf[mp][s], p1, 0, 0, 0); }
                if (need_mask) {
#pragma unroll
                    for (int reg = 0; reg < 16; ++reg) { const int d0 = dl - crow0(reg), d1 = d0 - 32;
                        p0[reg] = (d0 >= 0 && d0 < win) ? p0[reg] : -INFINITY; p1[reg] = (d1 >= 0 && d1 < win) ? p1[reg] : -INFINITY; } }
                float mt = fmaxf(fmaxf(p0[0], p1[0]), fmaxf(p0[1], p1[1]));
#pragma unroll
                for (int reg = 2; reg < 16; reg += 2) mt = fmaxf(fmaxf(mt, fmaxf(fmaxf(p0[reg], p1[reg]), p0[reg + 1])), p1[reg + 1]);
                mt = swap_max(mt);
                if (!started || __any(mt > 8.f)) {
                    const float d = (mt > -1e30f) ? (started ? fmaxf(mt, 0.f) : mt) : 0.f, alpha = __builtin_amdgcn_exp2f(-d);
                    O[mp][0] *= alpha; O[mp][1] *= alpha; Ls[mp] *= alpha; M[mp] += d;
#pragma unroll
                    for (int reg = 0; reg < 16; ++reg) { p0[reg] -= d; p1[reg] -= d; } }
                float rs = 0.f;
#ifdef PROBE_X_EXP
#pragma unroll
                for (int reg = 0; reg < 16; ++reg) { pdummy += __builtin_amdgcn_exp2f(p0[reg] - 1.f) + __builtin_amdgcn_exp2f(p1[reg] - 1.f); }
#endif
#pragma unroll
                for (int reg = 0; reg < 16; ++reg) { p0[reg] = __builtin_amdgcn_exp2f(p0[reg]); p1[reg] = __builtin_amdgcn_exp2f(p1[reg]); rs += p0[reg] + p1[reg]; }
                Ls[mp] += rs;
                pa[mp][0] = pack8(p0, 0); pa[mp][1] = pack8(p0, 8); pa[mp][2] = pack8(p1, 0); pa[mp][3] = pack8(p1, 8);
            }
            started = true;
            const LAS unsigned char* vb = vfrag + buf * A_VBUF;
#pragma unroll
            for (int db = 0; db < 2; ++db)
#pragma unroll
                for (int ks = 0; ks < 4; ++ks) { const s16x4 lo = tr_read(vb + ks * (16 * VP) + db * 64), hi = tr_read(vb + ks * (16 * VP) + db * 64 + 8 * VP);
                    const bf16x8v vf = {lo[0], lo[1], lo[2], lo[3], hi[0], hi[1], hi[2], hi[3]};
#pragma unroll
                    for (int mp = 0; mp < NMAP; ++mp) O[mp][db] = __builtin_amdgcn_mfma_f32_32x32x16_bf16(vf, pa[mp][ks], O[mp][db], 0, 0, 0); }
          } }
        if (more) { *(LAS u32x4*)(L + A_KOFF + (buf ^ 1) * A_KBUF + kdst) = kreg; *(LAS u32x4*)(L + A_VOFF + (buf ^ 1) * A_VBUF + vdst) = vreg; if (FOX && tid < 64) *(LAS float*)(L + A_BOFF + (buf ^ 1) * 256 + tid * 4) = breg; }
#ifdef PROBE_X_BAR
        __syncthreads();
#endif
        __syncthreads();
        if (!more) break;
        j = jn; buf ^= 1;
    }
    if (pdummy == 123.456f || idummy == 0x7fffabcd || dm0[3] == 98765.4321f) Ls[0] += 1e-30f;
}
#ifndef AC2_MODE
#define AC2_MODE 0
#endif
#ifndef AC2_INIT_VALU
#define AC2_INIT_VALU 24
#endif
template <bool FOX, bool SLC>
__device__ __forceinline__ void attn_core2(LAS unsigned char* L, const bf16* Kb0, const bf16* Vb, const LAS float* cum, float cum_ref,
                                           const bf16x8v (&Qf)[4], u64 tilemask, int t_lane, int tw0, int win, float slope2, unsigned selw0, unsigned selw1,
                                           f32x16 (&O)[2], float& M, float& Ls, int tid) {
    constexpr int KP = 144, VP = 192;
    const int lane = tid & 63, r = lane & 31, h = lane >> 5;
    const int kdst = (tid >> 3) * KP + (tid & 7) * 16; const bf16* ksrc = Kb0 + b64_off(tid >> 3, (tid & 7) * 8);
    const int vdst = (tid >> 3) * VP + (tid & 7) * 16; const bf16* vsrc = Vb + b64_off(tid >> 3, (tid & 7) * 8);
    const LAS unsigned char* kfrag = L + A_KOFF + r * KP + h * 16;
    const LAS unsigned char* vfrag = L + A_VOFF + (4 * h + ((lane & 15) >> 2)) * VP + (16 * ((lane >> 4) & 1) + 4 * (lane & 3)) * 2;
#define AC2_ACTIVE(jj) (!((jj) * 64 > tw0 + 31) && !(tw0 - ((jj) * 64 + 63) >= win))
#define AC2_INIT(jj, kslot, q0, q1) do { const int kv0_ = (jj) * 64; \
        if (FOX) { const LAS f32x4* bl = (const LAS f32x4*)(L + A_BOFF + (kslot) * 256) + h; const float mm = M; \
            _Pragma("unroll") for (int g4 = 0; g4 < 4; ++g4) { const f32x4 b0 = bl[2 * g4], b1 = bl[8 + 2 * g4]; \
                q0[4 * g4 + 0] = b0.x - mm; q0[4 * g4 + 1] = b0.y - mm; q0[4 * g4 + 2] = b0.z - mm; q0[4 * g4 + 3] = b0.w - mm; q1[4 * g4 + 0] = b1.x - mm; q1[4 * g4 + 1] = b1.y - mm; q1[4 * g4 + 2] = b1.z - mm; q1[4 * g4 + 3] = b1.w - mm; } } \
        else { float selb = 0.f; if (SLC) selb = ((((jj) < 32) ? (selw0 >> (jj)) : (selw1 >> ((jj) - 32))) & 1u) ? 0.f : -INFINITY; \
            const float base_l = (slope2 * (float)(kv0_ + 4 * h - tw0) - M) + selb, s8 = slope2 * 8.f, s32 = slope2 * 32.f; \
            q0[0] = base_l; q0[1] = q0[0] + slope2; q0[2] = q0[1] + slope2; q0[3] = q0[2] + slope2; \
            _Pragma("unroll") for (int reg = 4; reg < 16; ++reg) q0[reg] = q0[reg - 4] + s8; \
            _Pragma("unroll") for (int reg = 0; reg < 16; ++reg) q1[reg] = q0[reg] + s32; } } while (0)
#define AC2_QK(jj, kslot) do { AC2_INIT(jj, kslot, p0, p1); \
        const LAS unsigned char* kb_ = kfrag + (kslot) * A_KBUF; \
        _Pragma("unroll") for (int s_ = 0; s_ < 4; ++s_) { const bf16x8v kf0 = *(const LAS bf16x8v*)(kb_ + s_ * 32), kf1 = *(const LAS bf16x8v*)(kb_ + 32 * KP + s_ * 32); \
            p0 = __builtin_amdgcn_mfma_f32_32x32x16_bf16(kf0, Qf[s_], p0, 0, 0, 0); p1 = __builtin_amdgcn_mfma_f32_32x32x16_bf16(kf1, Qf[s_], p1, 0, 0, 0); } } while (0)
    u32x4 kreg, vreg; float breg = 0.f;
    u64 mk = tilemask;
    int j = 63 - __builtin_clzll(mk); mk &= ~(1ull << j);
    int jn = -1; if (mk) { jn = 63 - __builtin_clzll(mk); mk &= ~(1ull << jn); }
    { kreg = *(const u32x4*)(ksrc + (size_t)j * 64 * 64); vreg = *(const u32x4*)(vsrc + (size_t)j * 64 * 64); if (FOX && tid < 64) breg = (cum_ref - cum[j * 64 + tid]) * LOG2E;
      *(LAS u32x4*)(L + A_KOFF + kdst) = kreg; *(LAS u32x4*)(L + A_VOFF + vdst) = vreg; if (FOX && tid < 64) *(LAS float*)(L + A_BOFF + tid * 4) = breg;
      if (jn >= 0) { kreg = *(const u32x4*)(ksrc + (size_t)jn * 64 * 64); if (FOX && tid < 64) breg = (cum_ref - cum[jn * 64 + tid]) * LOG2E;
          *(LAS u32x4*)(L + A_KOFF + A_KBUF + kdst) = kreg; if (FOX && tid < 64) *(LAS float*)(L + A_BOFF + 256 + tid * 4) = breg; } }
    __syncthreads();
    f32x16 p0, p1;
    bool started = false;
    int ks = 0, vs = 0;
    if (AC2_ACTIVE(j)) AC2_QK(j, 0);
    for (;;) {
        int jnn = -1; if (mk) { jnn = 63 - __builtin_clzll(mk); mk &= ~(1ull << jnn); }
        if (jnn >= 0) { kreg = *(const u32x4*)(ksrc + (size_t)jnn * 64 * 64); if (FOX && tid < 64) breg = (cum_ref - cum[jnn * 64 + tid]) * LOG2E; }
        if (jn >= 0) vreg = *(const u32x4*)(vsrc + (size_t)jn * 64 * 64);
        const bool act = AC2_ACTIVE(j), actn = jn >= 0 && AC2_ACTIVE(jn);
        if (act) {
            const int kv0 = j * 64;
            if ((kv0 + 63 > tw0) || (tw0 + 31 - kv0 >= win)) { const int dl = t_lane - kv0 - 4 * h;
#pragma unroll
                for (int reg = 0; reg < 16; ++reg) { const int d0 = dl - crow0(reg), d1 = d0 - 32;
                    p0[reg] = (d0 >= 0 && d0 < win) ? p0[reg] : -INFINITY; p1[reg] = (d1 >= 0 && d1 < win) ? p1[reg] : -INFINITY; } }
            float mt = fmaxf(fmaxf(p0[0], p1[0]), fmaxf(p0[1], p1[1]));
#pragma unroll
            for (int reg = 2; reg < 16; reg += 2) mt = fmaxf(fmaxf(mt, fmaxf(fmaxf(p0[reg], p1[reg]), p0[reg + 1])), p1[reg + 1]);
            mt = swap_max(mt);
            if (!started || __any(mt > 8.f)) {
                const float d = (mt > -1e30f) ? (started ? fmaxf(mt, 0.f) : mt) : 0.f, alpha = __builtin_amdgcn_exp2f(-d);
                O[0] *= alpha; O[1] *= alpha; Ls *= alpha; M += d;
#pragma unroll
                for (int reg = 0; reg < 16; ++reg) { p0[reg] -= d; p1[reg] -= d; } }
            started = true;
#if AC2_MODE == 1
            {
                const int jq = jn >= 0 ? jn : 0;
                float rs = 0.f;
#pragma unroll
                for (int reg = 0; reg < 16; ++reg) { p0[reg] = __builtin_amdgcn_exp2f(p0[reg]); p1[reg] = __builtin_amdgcn_exp2f(p1[reg]); rs += p0[reg] + p1[reg]; }
                Ls += rs;
                const bf16x8v pa0 = pack8(p0, 0), pa1 = pack8(p0, 8), pa2 = pack8(p1, 0), pa3 = pack8(p1, 8);
                AC2_QK(jq, ks ^ 1);
                const LAS unsigned char* vb = vfrag + vs * A_VBUF;
#pragma unroll
                for (int db = 0; db < 2; ++db)
#pragma unroll
                    for (int kq = 0; kq < 4; ++kq) { const s16x4 lo = tr_read(vb + kq * (16 * VP) + db * 64), hi = tr_read(vb + kq * (16 * VP) + db * 64 + 8 * VP);
                        const bf16x8v vf = {lo[0], lo[1], lo[2], lo[3], hi[0], hi[1], hi[2], hi[3]};
                        O[db] = __builtin_amdgcn_mfma_f32_32x32x16_bf16(vf, kq == 0 ? pa0 : kq == 1 ? pa1 : kq == 2 ? pa2 : pa3, O[db], 0, 0, 0); }
            }
#else
            {
                const int jq = jn >= 0 ? jn : 0;
                f32x16 n0, n1;
                AC2_INIT(jq, ks ^ 1, n0, n1);
                const LAS unsigned char* kb_ = kfrag + (ks ^ 1) * A_KBUF;
                bf16x8v kf[8];
#pragma unroll
                for (int s_ = 0; s_ < 4; ++s_) { kf[2 * s_] = *(const LAS bf16x8v*)(kb_ + s_ * 32); kf[2 * s_ + 1] = *(const LAS bf16x8v*)(kb_ + 32 * KP + s_ * 32); }
                const LAS unsigned char* vb = vfrag + vs * A_VBUF;
                __builtin_amdgcn_sched_barrier(0);
                float ra = 0.f, rb = 0.f; unsigned w[16];
#define AC2_PINF(x) asm volatile("" : "+v"(x))
#define AC2_QGAP(i) do { if ((i) & 1) n1 = __builtin_amdgcn_mfma_f32_32x32x16_bf16(kf[i], Qf[(i) >> 1], n1, 0, 0, 0); else n0 = __builtin_amdgcn_mfma_f32_32x32x16_bf16(kf[i], Qf[(i) >> 1], n0, 0, 0, 0); \
                    float e0 = __builtin_amdgcn_exp2f(p0[2 * (i)]), e1 = __builtin_amdgcn_exp2f(p0[2 * (i) + 1]), e2 = __builtin_amdgcn_exp2f(p1[2 * (i)]), e3 = __builtin_amdgcn_exp2f(p1[2 * (i) + 1]); \
                    ra += e0 + e1; rb += e2 + e3; \
                    AC2_PINF(e0); AC2_PINF(e1); AC2_PINF(e2); AC2_PINF(e3); AC2_PINF(ra); AC2_PINF(rb); \
                    p0[2 * (i)] = e0; p0[2 * (i) + 1] = e1; p1[2 * (i)] = e2; p1[2 * (i) + 1] = e3; \
                    if ((i) >= 4) { w[2 * ((i) - 4)] = cvtpk(p0[4 * ((i) - 4)], p0[4 * ((i) - 4) + 1]); w[2 * ((i) - 4) + 1] = cvtpk(p0[4 * ((i) - 4) + 2], p0[4 * ((i) - 4) + 3]); AC2_PINF(w[2 * ((i) - 4)]); AC2_PINF(w[2 * ((i) - 4) + 1]); } \
                    if ((i) == 6) { vl[0] = tr_read(vb); vh[0] = tr_read(vb + 8 * VP); } \
                    if ((i) == 7) { vl[1] = tr_read(vb + 64); vh[1] = tr_read(vb + 64 + 8 * VP); } \
                    __builtin_amdgcn_sched_barrier(0); } while (0)
                s16x4 vl[2], vh[2];
                AC2_QGAP(0); AC2_QGAP(1); AC2_QGAP(2); AC2_QGAP(3); AC2_QGAP(4); AC2_QGAP(5); AC2_QGAP(6); AC2_QGAP(7);
                Ls += ra + rb;
#define AC2_PA(kq) __builtin_bit_cast(bf16x8v, (u32x4){w[4 * (kq)], w[4 * (kq) + 1], w[4 * (kq) + 2], w[4 * (kq) + 3]})
#define AC2_PGAP(g) do { const int kq_ = (g) >> 1, db_ = (g) & 1; const bf16x8v vf = {vl[(g) & 1][0], vl[(g) & 1][1], vl[(g) & 1][2], vl[(g) & 1][3], vh[(g) & 1][0], vh[(g) & 1][1], vh[(g) & 1][2], vh[(g) & 1][3]}; \
                    if ((g) < 6) { const int kq2 = ((g) + 2) >> 1, db2 = (g) & 1; vl[(g) & 1] = tr_read(vb + kq2 * (16 * VP) + db2 * 64); vh[(g) & 1] = tr_read(vb + kq2 * (16 * VP) + db2 * 64 + 8 * VP); } \
                    O[db_] = __builtin_amdgcn_mfma_f32_32x32x16_bf16(vf, AC2_PA(kq_), O[db_], 0, 0, 0); \
                    if ((g) < 4) { w[8 + 2 * (g)] = cvtpk(p1[4 * (g)], p1[4 * (g) + 1]); w[8 + 2 * (g) + 1] = cvtpk(p1[4 * (g) + 2], p1[4 * (g) + 3]); AC2_PINF(w[8 + 2 * (g)]); AC2_PINF(w[8 + 2 * (g) + 1]); } \
                    __builtin_amdgcn_sched_barrier(0); } while (0)
                AC2_PGAP(0); AC2_PGAP(1); AC2_PGAP(2); AC2_PGAP(3); AC2_PGAP(4); AC2_PGAP(5); AC2_PGAP(6); AC2_PGAP(7);
#undef AC2_PGAP
#undef AC2_PA
#undef AC2_QGAP
#undef AC2_PINF
                p0 = n0; p1 = n1;
            }
#endif
        } else if (actn) AC2_QK(jn, ks ^ 1);
        if (jnn >= 0) { *(LAS u32x4*)(L + A_KOFF + ks * A_KBUF + kdst) = kreg; if (FOX && tid < 64) *(LAS float*)(L + A_BOFF + ks * 256 + tid * 4) = breg; }
        if (jn >= 0) *(LAS u32x4*)(L + A_VOFF + (vs ^ 1) * A_VBUF + vdst) = vreg;
        __syncthreads();
        if (jn < 0) break;
        j = jn; jn = jnn; ks ^= 1; vs ^= 1;
    }
#undef AC2_QK
#undef AC2_INIT
#undef AC2_ACTIVE
}
__device__ __forceinline__ size_t mix_off(size_t n, int c, int W) { return ((n >> 5) * (size_t)(W / 8) + (size_t)(c >> 3)) * 256 + (n & 31) * 8 + (c & 7); }
#define ATTN_FOR_CHUNKS(db, g4) _Pragma("unroll") for (int db = 0; db < 2; ++db) _Pragma("unroll") for (int g4 = 0; g4 < 4; ++g4)

__device__ __forceinline__ void unpack8(const u32x4 w, float (&f)[8]) { f[0] = __uint_as_float(w.x << 16); f[1] = __uint_as_float(w.x & 0xffff0000u); f[2] = __uint_as_float(w.y << 16); f[3] = __uint_as_float(w.y & 0xffff0000u);
    f[4] = __uint_as_float(w.z << 16); f[5] = __uint_as_float(w.z & 0xffff0000u); f[6] = __uint_as_float(w.w << 16); f[7] = __uint_as_float(w.w & 0xffff0000u); }
__device__ __forceinline__ void ph_norm_bf16_from_bf16(const Ctx& c, const bf16* x, const float* g, bf16* out) {
    constexpr int RB = 4; float gg[2][8];
#pragma unroll
    for (int j = 0; j < 2; ++j) { const f32x4 a = ((const f32x4*)g)[2 * c.lane + 128 * j], b2 = ((const f32x4*)g)[2 * c.lane + 128 * j + 1]; gg[j][0] = a.x; gg[j][1] = a.y; gg[j][2] = a.z; gg[j][3] = a.w; gg[j][4] = b2.x; gg[j][5] = b2.y; gg[j][6] = b2.z; gg[j][7] = b2.w; }
    for (int row0 = c.gw * RB; row0 < NT; row0 += c.ngw * RB) {
        u32x4 v[RB][2];
#pragma unroll
        for (int q = 0; q < RB; ++q)
#pragma unroll
            for (int j = 0; j < 2; ++j) v[q][j] = ((const u32x4*)(x + (size_t)(row0 + q) * D_))[c.lane + 64 * j];
#pragma unroll
        for (int q = 0; q < RB; ++q) { float f[2][8]; float ss = 0.f;
#pragma unroll
            for (int j = 0; j < 2; ++j) { unpack8(v[q][j], f[j]);
#pragma unroll
                for (int e = 0; e < 8; ++e) ss = fmaf(f[j][e], f[j][e], ss); }
            const float r = rsqrtf(wave_sum(ss) * (1.f / D_) + EPS);
#pragma unroll
            for (int j = 0; j < 2; ++j) { u32x4 o; o.x = pk2(f[j][0] * r * gg[j][0], f[j][1] * r * gg[j][1]); o.y = pk2(f[j][2] * r * gg[j][2], f[j][3] * r * gg[j][3]); o.z = pk2(f[j][4] * r * gg[j][4], f[j][5] * r * gg[j][5]); o.w = pk2(f[j][6] * r * gg[j][6], f[j][7] * r * gg[j][7]);
                ((u32x4*)(out + (size_t)(row0 + q) * D_))[c.lane + 64 * j] = o; } }
    }
}
__device__ __forceinline__ void ph_norm_final_from_bf16(const Ctx& c, const bf16* x, const float* g, float* out) {
    constexpr int RB = 4; float gg[2][8];
#pragma unroll
    for (int j = 0; j < 2; ++j) { const f32x4 a = ((const f32x4*)g)[2 * c.lane + 128 * j], b2 = ((const f32x4*)g)[2 * c.lane + 128 * j + 1]; gg[j][0] = a.x; gg[j][1] = a.y; gg[j][2] = a.z; gg[j][3] = a.w; gg[j][4] = b2.x; gg[j][5] = b2.y; gg[j][6] = b2.z; gg[j][7] = b2.w; }
    for (int row0 = c.gw * RB; row0 < NT; row0 += c.ngw * RB) {
        u32x4 v[RB][2];
#pragma unroll
        for (int q = 0; q < RB; ++q)
#pragma unroll
            for (int j = 0; j < 2; ++j) v[q][j] = ((const u32x4*)(x + (size_t)(row0 + q) * D_))[c.lane + 64 * j];
#pragma unroll
        for (int q = 0; q < RB; ++q) { float f[2][8]; float ss = 0.f;
#pragma unroll
            for (int j = 0; j < 2; ++j) { unpack8(v[q][j], f[j]);
#pragma unroll
                for (int e = 0; e < 8; ++e) ss = fmaf(f[j][e], f[j][e], ss); }
            const float r = rsqrtf(wave_sum(ss) * (1.f / D_) + EPS);
#pragma unroll
            for (int j = 0; j < 2; ++j) { f32x4* o = (f32x4*)(out + (size_t)(row0 + q) * D_) + 2 * c.lane + 128 * j;
                o[0] = (f32x4){f[j][0] * r * gg[j][0], f[j][1] * r * gg[j][1], f[j][2] * r * gg[j][2], f[j][3] * r * gg[j][3]}; o[1] = (f32x4){f[j][4] * r * gg[j][4], f[j][5] * r * gg[j][5], f[j][6] * r * gg[j][6], f[j][7] * r * gg[j][7]}; } }
    }
}
__device__ __forceinline__ void ph_norm_bf16(const Ctx& c, const float* x, const float* g, bf16* out, bf16* raw) {
    constexpr int RB = 4;
    f32x4 gg[4];
#pragma unroll
    for (int j = 0; j < 4; ++j) gg[j] = ((const f32x4*)g)[c.lane + 64 * j];
    for (int row0 = c.gw * RB; row0 < NT; row0 += c.ngw * RB) {
        f32x4 v[RB][4];
#pragma unroll
        for (int q = 0; q < RB; ++q)
#pragma unroll
            for (int j = 0; j < 4; ++j) v[q][j] = ((const f32x4*)(x + (size_t)(row0 + q) * D_))[c.lane + 64 * j];
#pragma unroll
        for (int q = 0; q < RB; ++q) { float ss = 0.f;
#pragma unroll
            for (int j = 0; j < 4; ++j) ss += v[q][j].x * v[q][j].x + v[q][j].y * v[q][j].y + v[q][j].z * v[q][j].z + v[q][j].w * v[q][j].w;
            const float r = rsqrtf(wave_sum(ss) * (1.f / D_) + EPS);
            u64* o8 = (u64*)(out + (size_t)(row0 + q) * D_) + c.lane; u64* r8 = (u64*)(raw + (size_t)(row0 + q) * D_) + c.lane;
#pragma unroll
            for (int j = 0; j < 4; ++j) { o8[64 * j] = (u64)pk2(v[q][j].x * r * gg[j].x, v[q][j].y * r * gg[j].y) | ((u64)pk2(v[q][j].z * r * gg[j].z, v[q][j].w * r * gg[j].w) << 32);
                r8[64 * j] = (u64)pk2(v[q][j].x, v[q][j].y) | ((u64)pk2(v[q][j].z, v[q][j].w) << 32); } }
    }
}
__device__ __forceinline__ void ph_norm_final(const Ctx& c, float* x, const float* g) {
    constexpr int RB = 4;
    f32x4 gg[4];
#pragma unroll
    for (int j = 0; j < 4; ++j) gg[j] = ((const f32x4*)g)[c.lane + 64 * j];
    for (int row0 = c.gw * RB; row0 < NT; row0 += c.ngw * RB) {
        f32x4 v[RB][4];
#pragma unroll
        for (int q = 0; q < RB; ++q)
#pragma unroll
            for (int j = 0; j < 4; ++j) v[q][j] = ((const f32x4*)(x + (size_t)(row0 + q) * D_))[c.lane + 64 * j];
#pragma unroll
        for (int q = 0; q < RB; ++q) { float ss = 0.f;
#pragma unroll
            for (int j = 0; j < 4; ++j) ss += v[q][j].x * v[q][j].x + v[q][j].y * v[q][j].y + v[q][j].z * v[q][j].z + v[q][j].w * v[q][j].w;
            const float r = rsqrtf(wave_sum(ss) * (1.f / D_) + EPS);
            f32x4* xr = (f32x4*)(x + (size_t)(row0 + q) * D_) + c.lane;
#pragma unroll
            for (int j = 0; j < 4; ++j) xr[64 * j] = v[q][j] * r * gg[j]; }
    }
}

template <class AF, class EF>
__device__ __forceinline__ void naive_gemm(const Ctx& c, int M, int N, int K, AF af, const float* W, int ldb, EF ef) {
    LAS float* As = (LAS float*)c.lds;
    LAS float* Bs = As + 16 * 132;
    const int tm = (M + 127) / 128, tn = (N + 127) / 128, ntile = tm * tn;
    const int ty = c.tid >> 4, tx = c.tid & 15;
    for (int tile = c.bid; tile < ntile; tile += c.G) {
        const int m0 = (tile / tn) * 128, n0 = (tile % tn) * 128;
        float acc[4][8];
#pragma unroll
        for (int i = 0; i < 4; ++i)
#pragma unroll
            for (int j = 0; j < 8; ++j) acc[i][j] = 0.f;
        for (int k0 = 0; k0 < K; k0 += 16) {
            __syncthreads();
#pragma unroll
            for (int i = 0; i < 4; ++i) { const int e = c.tid + i * 512, r = e >> 4, kk = e & 15; const int row = m0 + r;
                As[kk * 132 + r] = (row < M) ? af(row, k0 + kk) : 0.f; }
#pragma unroll
            for (int i = 0; i < 4; ++i) { const int e = c.tid + i * 512, kk = e >> 7, cc = e & 127; const int col = n0 + cc;
                Bs[kk * 132 + cc] = (col < N) ? W[(size_t)(k0 + kk) * ldb + col] : 0.f; }
            __syncthreads();
#pragma unroll 2
            for (int kk = 0; kk < 16; ++kk) {
                float a[4], b[8];
#pragma unroll
                for (int i = 0; i < 4; ++i) a[i] = As[kk * 132 + ty * 4 + i];
#pragma unroll
                for (int j = 0; j < 8; ++j) b[j] = Bs[kk * 132 + tx * 8 + j];
#pragma unroll
                for (int i = 0; i < 4; ++i)
#pragma unroll
                    for (int j = 0; j < 8; ++j) acc[i][j] = fmaf(a[i], b[j], acc[i][j]);
            }
        }
        LAS float* Cs = Bs + 16 * 132;
        __syncthreads();
#pragma unroll
        for (int i = 0; i < 4; ++i)
#pragma unroll
            for (int j = 0; j < 8; ++j) Cs[(ty * 4 + i) * 129 + tx * 8 + j] = acc[i][j];
        __syncthreads();
#pragma unroll 1
        for (int e = c.tid; e < 128 * 128; e += NTHREADS) { const int r = e >> 7, cc = e & 127, row = m0 + r, col = n0 + cc; if (row < M && col < N) ef(row, col, Cs[r * 129 + cc]); }
    }
    __syncthreads();
}

struct InProjOut { bf16* qn; bf16* kv6; bf16* fqkv; bf16* dqk; bf16* dv; float* gate; float* fl; const float* b_gate; const float* b_fgt; };
__device__ __forceinline__ void inproj_store(const InProjOut& o, int n, int col, float v) {
    const int b = n / T_, t = n % T_;
    if (col < C_KV6) { const int h = col >> 6, d = col & 63; o.qn[((size_t)(b * 8 + h) * T_ + t) * 64 + d] = (bf16)f2bf(v * (0.125f * LOG2E)); }
    else if (col < C_GATE) { const int cc = col - C_KV6, idx = cc >> 7, g = (cc >> 6) & 1, d = cc & 63;
        ((bf16*)((unsigned char*)o.kv6 + idx * KV6_STRIDE))[((size_t)(b * 2 + g) * T_ + t) * 64 + d] = (bf16)f2bf(v); }
    else if (col < C_FQ) { const int j = col - C_GATE; o.gate[(size_t)n * 24 + j] = sigmoidf_(v + o.b_gate[j]); }
    else if (col < C_FF) { const int cc = col - C_FQ, idx = cc >> 8, h = (cc >> 6) & 3, d = cc & 63;
        o.fqkv[(size_t)idx * (8 * MiB) + ((size_t)(b * 4 + h) * T_ + t) * 64 + d] = (bf16)f2bf(idx == 0 ? v * (0.125f * LOG2E) : v); }
    else if (col < C_DQ) { const int h = col - C_FF; o.fl[(size_t)(b * 4 + h) * T_ + t] = log_sigmoidf_(v + o.b_fgt[h]); }
    else if (col < C_DV) { const int cc = col - C_DQ, idx = cc >> 8, h = (cc >> 6) & 3, i = (cc >> 5) & 1, d = cc & 31;
        o.dqk[(size_t)idx * (8 * MiB) + ((size_t)((b * 4 + h) * 2 + i) * T_ + t) * 32 + d] = (bf16)f2bf(idx == 0 ? v * (0.17677669529663687f * LOG2E) : v); }
    else { const int cc = col - C_DV, h = cc >> 6, d = cc & 63; o.dv[((size_t)(b * 4 + h) * T_ + t) * 64 + d] = (bf16)f2bf(v); }
}

__device__ __forceinline__ void ph_cumsum(const Ctx& c, float* fl) {
    for (int s = c.gw; s < B_ * 4; s += c.ngw) {
        float* p = fl + (size_t)s * T_; float carry = 0.f;
        for (int t0 = 0; t0 < T_; t0 += 64) {
            float v = p[t0 + c.lane];
#pragma unroll
            for (int o = 1; o < 64; o <<= 1) { const float u = __shfl_up(v, o); if (c.lane >= o) v += u; }
            v += carry; p[t0 + c.lane] = v; carry = __shfl(v, 63);
        }
    }
}

template <int DQK>
__device__ __forceinline__ float naive_attn_row(const bf16* q, const bf16* K, const bf16* V, int t, u64 mask, float slope2, const float* cum, int win, int lane) {
    float qv[DQK];
    { const u32x4* q4 = (const u32x4*)q;
#pragma unroll
      for (int i = 0; i < DQK / 8; ++i) { const u32x4 w = q4[i];
          qv[8 * i + 0] = __uint_as_float(w.x << 16); qv[8 * i + 1] = __uint_as_float(w.x & 0xffff0000u);
          qv[8 * i + 2] = __uint_as_float(w.y << 16); qv[8 * i + 3] = __uint_as_float(w.y & 0xffff0000u);
          qv[8 * i + 4] = __uint_as_float(w.z << 16); qv[8 * i + 5] = __uint_as_float(w.z & 0xffff0000u);
          qv[8 * i + 6] = __uint_as_float(w.w << 16); qv[8 * i + 7] = __uint_as_float(w.w & 0xffff0000u); } }
    const float cumt = cum ? cum[t] : 0.f;
    float m = -INFINITY, l = 0.f, o = 0.f;
    while (mask) {
        const int j = __builtin_ctzll(mask); mask &= mask - 1;
        const int kpos = 64 * j + lane; const int dist = t - kpos;
        const bool valid = dist >= 0 && dist < win;
        float s = 0.f;
        { const u32x4* k4 = (const u32x4*)(K + (size_t)kpos * DQK);
#pragma unroll
          for (int i = 0; i < DQK / 8; ++i) { const u32x4 w = k4[i];
              s = fmaf(qv[8 * i + 0], __uint_as_float(w.x << 16), s); s = fmaf(qv[8 * i + 1], __uint_as_float(w.x & 0xffff0000u), s);
              s = fmaf(qv[8 * i + 2], __uint_as_float(w.y << 16), s); s = fmaf(qv[8 * i + 3], __uint_as_float(w.y & 0xffff0000u), s);
              s = fmaf(qv[8 * i + 4], __uint_as_float(w.z << 16), s); s = fmaf(qv[8 * i + 5], __uint_as_float(w.z & 0xffff0000u), s);
              s = fmaf(qv[8 * i + 6], __uint_as_float(w.w << 16), s); s = fmaf(qv[8 * i + 7], __uint_as_float(w.w & 0xffff0000u), s); } }
        s -= slope2 * (float)dist;
        if (cum) s += (cumt - cum[kpos]) * LOG2E;
        s = valid ? s : -INFINITY;
        const float mb = wave_max(s);
        if (mb == -INFINITY) continue;
        const float mn = fmaxf(m, mb), alpha = exp2f(m - mn);
        const float p = valid ? exp2f(s - mn) : 0.f;
        l = l * alpha + wave_sum(p); o *= alpha; m = mn;
        const bf16* vb = V + (size_t)(64 * j) * 64 + lane;
#pragma unroll 8
        for (int k = 0; k < 64; ++k) o = fmaf(__shfl(p, k), bf2f(vb[(size_t)k * 64]), o);
    }
    return l > 0.f ? o / l : 0.f;
}

__device__ __forceinline__ void ph_cmp_attn(const Ctx& c, const bf16* qn, const bf16* kcmp, const bf16* vcmp, const float* gate, u64* sel, bf16* ocmp) {
    LAS float* pl = (LAS float*)(c.lds) + c.wave * 256;
    const int lane = c.lane;
    for (int it = c.gw; it < B_ * 2 * T_; it += c.ngw) {
        const int t = it % T_, bg = it / T_, b = bg >> 1, g = bg & 1;
        const int nvis = (t >= 31) ? ((t - 31) >> 4) + 1 : 0;
        const bf16* kc = kcmp + (size_t)bg * 256 * 64; const bf16* vc = vcmp + (size_t)bg * 256 * 64;
        float imp = 0.f;
        for (int hg = 0; hg < 4; ++hg) {
            const int h = g * 4 + hg; const float slope2 = alibi_slope(h + 1, 8) * LOG2E;
            const bf16* q = qn + ((size_t)(b * 8 + h) * T_ + t) * 64;
            float qv[64];
            { const u32x4* q4 = (const u32x4*)q;
#pragma unroll
              for (int i = 0; i < 8; ++i) { const u32x4 w = q4[i];
                  qv[8 * i + 0] = __uint_as_float(w.x << 16); qv[8 * i + 1] = __uint_as_float(w.x & 0xffff0000u);
                  qv[8 * i + 2] = __uint_as_float(w.y << 16); qv[8 * i + 3] = __uint_as_float(w.y & 0xffff0000u);
                  qv[8 * i + 4] = __uint_as_float(w.z << 16); qv[8 * i + 5] = __uint_as_float(w.z & 0xffff0000u);
                  qv[8 * i + 6] = __uint_as_float(w.w << 16); qv[8 * i + 7] = __uint_as_float(w.w & 0xffff0000u); } }
            float s[4]; float m = -INFINITY;
#pragma unroll
            for (int i = 0; i < 4; ++i) { const int cc = lane + 64 * i; float a = 0.f;
                if (cc < nvis) { const u32x4* k4 = (const u32x4*)(kc + (size_t)cc * 64);
#pragma unroll
                    for (int e = 0; e < 8; ++e) { const u32x4 w = k4[e];
                        a = fmaf(qv[8 * e + 0], __uint_as_float(w.x << 16), a); a = fmaf(qv[8 * e + 1], __uint_as_float(w.x & 0xffff0000u), a);
                        a = fmaf(qv[8 * e + 2], __uint_as_float(w.y << 16), a); a = fmaf(qv[8 * e + 3], __uint_as_float(w.y & 0xffff0000u), a);
                        a = fmaf(qv[8 * e + 4], __uint_as_float(w.z << 16), a); a = fmaf(qv[8 * e + 5], __uint_as_float(w.z & 0xffff0000u), a);
                        a = fmaf(qv[8 * e + 6], __uint_as_float(w.w << 16), a); a = fmaf(qv[8 * e + 7], __uint_as_float(w.w & 0xffff0000u), a); }
                    a -= slope2 * (float)(t - (16 * cc + 31)); } else a = -INFINITY;
                s[i] = a; m = fmaxf(m, a); }
            m = wave_max(m);
            float p[4], lsum = 0.f;
#pragma unroll
            for (int i = 0; i < 4; ++i) { p[i] = (lane + 64 * i < nvis) ? exp2f(s[i] - m) : 0.f; lsum += p[i]; }
            lsum = wave_sum(lsum);
            const float inv = lsum > 0.f ? 1.f / lsum : 0.f;
#pragma unroll
            for (int i = 0; i < 4; ++i) { p[i] *= inv; pl[lane + 64 * i] = p[i]; }
            asm volatile("s_waitcnt lgkmcnt(0)" ::: "memory");
            float o = 0.f;
            for (int cc = 0; cc < nvis; ++cc) o = fmaf(pl[cc], bf2f(vc[(size_t)cc * 64 + lane]), o);
            const float gt = gate[((size_t)(b * T_ + t)) * 24 + h * 3 + 0];
            ocmp[(size_t)(b * T_ + t) * 512 + h * 64 + lane] = (bf16)f2bf(gt * o);
            { const int j = lane; float a = pl[4 * j] + pl[4 * j + 1] + pl[4 * j + 2] + 0.5f * pl[4 * j + 3]; if (j > 0) a += 0.5f * pl[4 * j - 1]; imp += a; }
            asm volatile("s_waitcnt lgkmcnt(0)" ::: "memory");
        }
        const int cur = t >> 6; const int j = lane;
        u64 m64;
        if (cur <= 15) m64 = (cur == 63) ? ~0ull : ((1ull << (cur + 1)) - 1ull);
        else {
            float val = (j > cur) ? -INFINITY : ((j == 0 || j == cur || j == cur - 1) ? 1e4f : imp);
            m64 = 0ull;
            for (int r = 0; r < 16; ++r) {
                const float mx = wave_max(val);
                const u64 bal = __ballot(val == mx);
                const int w = __builtin_ctzll(bal);
                m64 |= 1ull << w; if (j == w) val = -INFINITY;
            }
        }
        if (lane == 0) sel[(size_t)bg * T_ + t] = m64;
    }
}

__device__ __forceinline__ void ph_win_attn(const Ctx& c, const bf16* qn, const bf16* kw, const bf16* vw, const float* gate, bf16* owin) {
    for (int it = c.gw; it < B_ * 8 * T_; it += c.ngw) {
        const int t = it % T_, bh = it / T_, b = bh >> 3, h = bh & 7, g = h >> 2;
        const int cur = t >> 6, jlo = (t - 511) > 0 ? (t - 511) >> 6 : 0;
        const u64 hi = (cur == 63) ? ~0ull : ((1ull << (cur + 1)) - 1ull); const u64 mask = hi & ~((1ull << jlo) - 1ull);
        const float o = naive_attn_row<64>(qn + ((size_t)bh * T_ + t) * 64, kw + (size_t)(b * 2 + g) * T_ * 64, vw + (size_t)(b * 2 + g) * T_ * 64, t, mask,
                                           alibi_slope(h + 1, 8) * LOG2E, nullptr, 512, c.lane);
        owin[(size_t)(b * T_ + t) * 512 + h * 64 + c.lane] = (bf16)f2bf(gate[(size_t)(b * T_ + t) * 24 + h * 3 + 2] * o);
    }
}
__device__ __forceinline__ void ph_slc_attn(const Ctx& c, const bf16* qn, const bf16* ks, const bf16* vs, const float* gate, const u64* sel, const bf16* ocmp, const bf16* owin, bf16* att) {
    for (int it = c.gw; it < B_ * 8 * T_; it += c.ngw) {
        const int t = it % T_, bh = it / T_, b = bh >> 3, h = bh & 7, g = h >> 2;
        const u64 mask = sel[(size_t)(b * 2 + g) * T_ + t];
        const float o = naive_attn_row<64>(qn + ((size_t)bh * T_ + t) * 64, ks + (size_t)(b * 2 + g) * T_ * 64, vs + (size_t)(b * 2 + g) * T_ * 64, t, mask,
                                           alibi_slope(h + 1, 8) * LOG2E, nullptr, 1 << 30, c.lane);
        const size_t n = (size_t)(b * T_ + t);
        const float r = gate[n * 24 + h * 3 + 1] * o + bf2f(ocmp[n * 512 + h * 64 + c.lane]) + bf2f(owin[n * 512 + h * 64 + c.lane]);
        att[n * 1024 + h * 64 + c.lane] = (bf16)f2bf(r);
    }
}
__device__ __forceinline__ void ph_fox_attn(const Ctx& c, const bf16* fq, const bf16* fk, const bf16* fv, const float* cum, bf16* att) {
    for (int it = c.gw; it < B_ * 4 * T_; it += c.ngw) {
        const int t = it % T_, bh = it / T_, b = bh >> 2, h = bh & 3;
        const int cur = t >> 6; const u64 mask = (cur == 63) ? ~0ull : ((1ull << (cur + 1)) - 1ull);
        const float o = naive_attn_row<64>(fq + ((size_t)bh * T_ + t) * 64, fk + (size_t)bh * T_ * 64, fv + (size_t)bh * T_ * 64, t, mask, 0.f, cum + (size_t)bh * T_, 1 << 30, c.lane);
        att[(size_t)(b * T_ + t) * 1024 + 512 + h * 64 + c.lane] = (bf16)f2bf(o);
    }
}
__device__ __forceinline__ void ph_diff_attn(const Ctx& c, const bf16* dq, const bf16* dk, const bf16* dv, const float* lam, const float* subln, float lambda_init, bf16* att) {
    float l1 = 0.f, l2 = 0.f;
    if (c.lane < 32) { l1 = lam[c.lane] * lam[32 + c.lane]; l2 = lam[64 + c.lane] * lam[96 + c.lane]; }
    const float lam_full = __expf(wave_sum(l1)) - __expf(wave_sum(l2)) + lambda_init;
    const float sg = subln[c.lane] * (1.f - lambda_init);
    for (int it = c.gw; it < B_ * 4 * T_; it += c.ngw) {
        const int t = it % T_, bh = it / T_, b = bh >> 2, h = bh & 3;
        const int cur = t >> 6; const u64 mask = (cur == 63) ? ~0ull : ((1ull << (cur + 1)) - 1ull);
        const float slope2 = alibi_slope(h + 1, 4) * LOG2E;
        const bf16* vb = dv + (size_t)bh * T_ * 64;
        const float o1 = naive_attn_row<32>(dq + ((size_t)(bh * 2 + 0) * T_ + t) * 32, dk + (size_t)(bh * 2 + 0) * T_ * 32, vb, t, mask, slope2, nullptr, 1 << 30, c.lane);
        const float o2 = naive_attn_row<32>(dq + ((size_t)(bh * 2 + 1) * T_ + t) * 32, dk + (size_t)(bh * 2 + 1) * T_ * 32, vb, t, mask, slope2, nullptr, 1 << 30, c.lane);
        const float o = o1 - lam_full * o2;
        const float r = rsqrtf(wave_sum(o * o) * (1.f / 64.f) + EPS);
        att[(size_t)(b * T_ + t) * 1024 + 768 + h * 64 + c.lane] = (bf16)f2bf(o * r * sg);
    }
}

__device__ __forceinline__ void ph_moe_route(const Ctx& c, const float* x, const float* g, const float* wgrp, const float* bgrp, const float* wexp, const float* bexp, bf16* hn, int* route_e, float* route_w, unsigned* cnt) {
    for (int row = c.gw; row < NT; row += c.ngw) {
        const f32x4* xr = (const f32x4*)(x + (size_t)row * D_) + c.lane;
        f32x4 v[4]; float ss = 0.f;
#pragma unroll
        for (int j = 0; j < 4; ++j) { v[j] = xr[64 * j]; ss += v[j].x * v[j].x + v[j].y * v[j].y + v[j].z * v[j].z + v[j].w * v[j].w; }
        const float r = rsqrtf(wave_sum(ss) * (1.f / D_) + EPS);
        u64* o8 = (u64*)(hn + (size_t)row * D_) + c.lane;
#pragma unroll
        for (int j = 0; j < 4; ++j) { const f32x4 gg = ((const f32x4*)g)[c.lane + 64 * j]; v[j] = v[j] * r * gg;
            o8[64 * j] = (u64)pk2(v[j].x, v[j].y) | ((u64)pk2(v[j].z, v[j].w) << 32); }
        float gl[4];
#pragma unroll
        for (int q = 0; q < 4; ++q) { float a = 0.f;
#pragma unroll
            for (int j = 0; j < 4; ++j) { const int k = 4 * (c.lane + 64 * j);
                a = fmaf(v[j].x, wgrp[(size_t)(k + 0) * 4 + q], a); a = fmaf(v[j].y, wgrp[(size_t)(k + 1) * 4 + q], a);
                a = fmaf(v[j].z, wgrp[(size_t)(k + 2) * 4 + q], a); a = fmaf(v[j].w, wgrp[(size_t)(k + 3) * 4 + q], a); }
            gl[q] = wave_sum(a) + bgrp[q]; }
        int grp = 0; float gm = gl[0];
#pragma unroll
        for (int q = 1; q < 4; ++q) if (gl[q] > gm) { gm = gl[q]; grp = q; }
        float gs = 0.f;
#pragma unroll
        for (int q = 0; q < 4; ++q) gs += __expf(gl[q] - gm);
        const float grp_gate = 1.f / gs;
        float el[8];
#pragma unroll
        for (int q = 0; q < 8; ++q) { float a = 0.f; const int col = grp * 8 + q;
#pragma unroll
            for (int j = 0; j < 4; ++j) { const int k = 4 * (c.lane + 64 * j);
                a = fmaf(v[j].x, wexp[(size_t)(k + 0) * 32 + col], a); a = fmaf(v[j].y, wexp[(size_t)(k + 1) * 32 + col], a);
                a = fmaf(v[j].z, wexp[(size_t)(k + 2) * 32 + col], a); a = fmaf(v[j].w, wexp[(size_t)(k + 3) * 32 + col], a); }
            el[q] = wave_sum(a) + bexp[col]; }
        int i0 = 0; float v0 = el[0];
#pragma unroll
        for (int q = 1; q < 8; ++q) if (el[q] > v0) { v0 = el[q]; i0 = q; }
        int i1 = -1; float v1 = -INFINITY;
#pragma unroll
        for (int q = 0; q < 8; ++q) if (q != i0 && el[q] > v1) { v1 = el[q]; i1 = q; }
        const float e1 = __expf(v1 - v0), den = 1.f + e1;
        if (c.lane == 0) { const float w0 = grp_gate / den, w1 = grp_gate * e1 / den;
            const int lo = i0 < i1 ? i0 : i1, hi = i0 < i1 ? i1 : i0, cls = grp * 28 + lo * 8 - (lo * (lo + 1)) / 2 + (hi - lo - 1);
            const unsigned rank = __hip_atomic_fetch_add(cnt + cls, 1u, __ATOMIC_RELAXED, __HIP_MEMORY_SCOPE_AGENT);
            route_e[row] = (int)(((unsigned)cls << 24) | rank); route_w[2 * row] = i0 < i1 ? w0 : w1; route_w[2 * row + 1] = i0 < i1 ? w1 : w0; }
    }
}
__device__ __forceinline__ void ph_moe_naive(const Ctx& c, const bf16* hn, const int* route_e, const float* route_w, const float* wg, const float* wu, const float* wd, float* x) {
    LAS float* hs = (LAS float*)c.lds;
    LAS float* au = hs + 1024;
    LAS float* h2 = au + 512;
    for (int row = c.bid; row < NT; row += c.G) {
        __syncthreads();
        hs[c.tid] = bf2f(hn[(size_t)row * D_ + c.tid]); hs[c.tid + 512] = bf2f(hn[(size_t)row * D_ + c.tid + 512]);
        float o0 = 0.f, o1 = 0.f;
        for (int s = 0; s < 2; ++s) {
            const int e = route_e[2 * row + s]; const float w = route_w[2 * row + s];
            __syncthreads();
            const float* W = (c.tid < 256 ? wg : wu) + (size_t)e * D_ * DEXP + (c.tid & 255);
            float a = 0.f;
            for (int k = 0; k < D_; ++k) a = fmaf(hs[k], W[(size_t)k * DEXP], a);
            au[c.tid] = a;
            __syncthreads();
            if (c.tid < 256) { const float ga = au[c.tid], up = au[c.tid + 256]; h2[c.tid] = ga / (1.f + __expf(-ga)) * up * w; }
            __syncthreads();
            const float* Wd = wd + (size_t)e * DEXP * D_;
            for (int k = 0; k < DEXP; ++k) { const float hv = h2[k]; o0 = fmaf(hv, Wd[(size_t)k * D_ + c.tid], o0); o1 = fmaf(hv, Wd[(size_t)k * D_ + c.tid + 512], o1); }
        }
        x[(size_t)row * D_ + c.tid] += o0; x[(size_t)row * D_ + c.tid + 512] += o1;
    }
    __syncthreads();
}

typedef __attribute__((address_space(4))) const Params* KP;
__device__ __forceinline__ KP uni_kp(KP p) { const unsigned long long v = (unsigned long long)p; const unsigned lo = __builtin_amdgcn_readfirstlane((unsigned)v), hi = __builtin_amdgcn_readfirstlane((unsigned)(v >> 32)); return (KP)(((unsigned long long)hi << 32) | lo); }
constexpr int PH_PER_LAYER = 11, N_PHASES = L_ * PH_PER_LAYER + 2;
__device__ __forceinline__ Ctx make_ctx(KP p) {
    Ctx c; c.lds = (LAS unsigned char*)lds_raw; { int t_ = threadIdx.x; asm volatile("" : "+v"(t_)); c.tid = t_; } c.lane = c.tid & 63; c.wave = __builtin_amdgcn_readfirstlane(c.tid >> 6);
    c.bid = blockIdx.x; c.G = gridDim.x; c.gw = c.bid * NWAVES + c.wave; c.ngw = c.G * NWAVES; c.in = nullptr; c.xcur = p->out; c.ws = p->ws;
    return c;
}
struct Bufs {
    bf16 *QN, *KV6, *KC, *VC, *KS, *VS, *KW, *VW, *FQ, *FK, *FV, *DQ, *DK, *DV, *HC, *KCMP, *VCMP, *OCMP, *OWIN, *HN, *ATT;
    float *GATE, *FL, *ROUTE_W; u64* SEL; int* ROUTE_E;
};
__device__ __forceinline__ Bufs make_bufs(unsigned char* ws) {
    Bufs b;
    b.QN = (bf16*)(ws + WS_QN); b.KV6 = (bf16*)(ws + WS_KV6);
    b.KC = (bf16*)(ws + WS_KV6 + 0 * KV6_STRIDE); b.VC = (bf16*)(ws + WS_KV6 + 1 * KV6_STRIDE);
    b.KS = (bf16*)(ws + WS_KV6 + 2 * KV6_STRIDE); b.VS = (bf16*)(ws + WS_KV6 + 3 * KV6_STRIDE);
    b.KW = (bf16*)(ws + WS_KV6 + 4 * KV6_STRIDE); b.VW = (bf16*)(ws + WS_KV6 + 5 * KV6_STRIDE);
    b.FQ = (bf16*)(ws + WS_FQKV); b.FK = b.FQ + 8 * MiB; b.FV = b.FQ + 16 * MiB;
    b.DQ = (bf16*)(ws + WS_DQK); b.DK = b.DQ + 8 * MiB; b.DV = (bf16*)(ws + WS_DV);
    b.GATE = (float*)(ws + WS_GATE); b.FL = (float*)(ws + WS_FL);
    b.HC = (bf16*)(ws + WS_HC); b.KCMP = (bf16*)(ws + WS_KVCMP); b.VCMP = b.KCMP + 16 * 256 * 64;
    b.SEL = (u64*)(ws + WS_SEL); b.OCMP = (bf16*)(ws + WS_OCMP); b.OWIN = (bf16*)(ws + WS_OWIN);
    b.HN = (bf16*)(ws + WS_HN); b.ATT = (bf16*)(ws + WS_ATT);
    b.ROUTE_E = (int*)(ws + WS_ROUTE); b.ROUTE_W = (float*)(ws + WS_ROUTE + 512 * 1024);
    return b;
}
__device__ __forceinline__ float lambda_init_of(int l) { return l == 0 ? 0.2f : 0.35550906759096926f; }

__device__ __noinline__ void P_prologue(KP p_) { const KP p = uni_kp(p_);
    const Ctx c = make_ctx(p); unsigned char* ws = p->ws;
    LAS float* scr = (LAS float*)(c.lds) + c.wave * (64 * 33);
    constexpr int I_A = 16 * 40, I_B = 16 * 24, I_C = 16 * 24, I_O = 16 * 32, I_G = 16 * 8, I_D = 4 * 32, I_E = 2 * I_G + I_D, I_W1 = 32 * 8, I_W2 = 4 * 2;
    constexpr int PER_L = I_A + I_B + I_C + I_O + NEXP * I_E + 2 * (I_W1 + I_W2);
    for (int it = c.gw; it < L_ * PER_L; it += c.ngw) {
        const int l = it / PER_L; int r = it % PER_L;
        const float* W; bf16* WT; int ldw, K, sc0, ncol, r0 = 0, rmul = 1;
        if (r < I_A + I_B + I_C) { W = p->in[2] + (size_t)l * D_ * D_IN; WT = (bf16*)(ws + WS_WIN_T) + (size_t)l * NIN * D_; ldw = D_IN; K = D_;
            if (r < I_A) { sc0 = 0; ncol = 1280; r0 = 0; } else if (r < I_A + I_B) { r -= I_A; sc0 = C_FQ; ncol = 768; r0 = 1280; } else { r -= I_A + I_B; sc0 = C_DQ; ncol = 768; r0 = 2048; } }
        else if ((r -= I_A + I_B + I_C) < I_O) { W = p->in[13] + (size_t)l * D_ * D_; WT = (bf16*)(ws + WS_WOUT_T) + (size_t)l * D_ * D_; ldw = D_; K = D_; sc0 = 0; ncol = 1024; }
        else if ((r -= I_O) < NEXP * I_E) { const int e = r / I_E; r = r % I_E; const size_t le = (size_t)l * NEXP + e;
            if (r < 2 * I_G) { const int up = r >= I_G; r -= up * I_G; W = p->in[19 + up] + le * D_ * DEXP; WT = (bf16*)(ws + WS_WGU_T) + le * 512 * D_; ldw = DEXP; K = D_; sc0 = 0; ncol = 256; r0 = up; rmul = 2; }
            else { r -= 2 * I_G; W = p->in[21] + le * DEXP * D_; WT = (bf16*)(ws + WS_WD_T) + le * D_ * DEXP; ldw = D_; K = DEXP; sc0 = 0; ncol = 1024; } }
        else { r -= NEXP * I_E; const int kv = r / (I_W1 + I_W2); r = r % (I_W1 + I_W2); const size_t lk = (size_t)l * 2 + kv;
            if (r < I_W1) { W = p->in[kv == 0 ? 6 : 9] + (size_t)l * 2048 * 256; WT = (bf16*)(ws + WS_W1_T) + lk * 256 * 2048; ldw = 256; K = 2048; sc0 = 0; ncol = 256; }
            else { r -= I_W1; W = p->in[kv == 0 ? 7 : 10] + (size_t)l * 256 * 64; WT = (bf16*)(ws + WS_W2_T) + lk * 64 * 256; ldw = 64; K = 256; sc0 = 0; ncol = 64; } }
        transpose_seg(W, ldw, K, sc0, ncol, WT, r0, rmul, r, scr, c.lane);
    }
    for (int i = c.bid * NTHREADS + c.tid; i < L_ * 256 * D_; i += c.G * NTHREADS) {
        const int l = i / (256 * D_), rr = (i / D_) % 256, k = i % D_;
        const float* win = p->in[2] + (size_t)l * D_ * D_IN;
        float v = 0.f; if (rr < 24) v = win[(size_t)k * D_IN + C_GATE + rr]; else if (rr < 28) v = win[(size_t)k * D_IN + C_FF + (rr - 24)];
        ((bf16*)(ws + WS_WIN_T))[((size_t)l * NIN + 2816 + rr) * D_ + k] = (bf16)f2bf(v);
    }
    for (int w = c.gw; w < L_ * 2 * 4 * 128; w += c.ngw) {
        const int lk = w >> 9, cg = (w >> 7) & 3, kc = w & 127, l = lk >> 1, kv = lk & 1, j = cg * 64 + c.lane;
        const float* pe = p->in[kv == 0 ? 5 : 8] + (size_t)l * 2048 + kc * 16; const float* w1 = p->in[kv == 0 ? 6 : 9] + (size_t)l * 2048 * 256 + (size_t)kc * 16 * 256;
        float a = 0.f;
#pragma unroll
        for (int k = 0; k < 16; ++k) a = fmaf(pe[k], w1[(size_t)k * 256 + j], a);
        ((float*)(ws + WS_B1PART))[((size_t)lk * 128 + kc) * 256 + j] = a;
    }
    for (int i = c.bid * NTHREADS + c.tid; i < L_ * 64 * 2 * 64; i += c.G * NTHREADS) {
        const int l = i / (64 * 2 * 64), ks = (i / 128) % 64, cb = (i / 64) & 1, lane = i & 63, col = 32 * cb + (lane & 31);
        unsigned hi[4], lo[4];
#pragma unroll
        for (int jp = 0; jp < 4; ++jp) { float v[2];
#pragma unroll
            for (int e = 0; e < 2; ++e) { const int k = 16 * ks + 8 * (lane >> 5) + 2 * jp + e; const float g = p->in[14][(size_t)l * D_ + k];
                v[e] = col < 4 ? g * p->in[15][((size_t)l * D_ + k) * 4 + col] : (col < 36 ? g * p->in[17][((size_t)l * D_ + k) * 32 + (col - 4)] : 0.f); }
            const unsigned h0 = f2bf(v[0]), h1 = f2bf(v[1]); hi[jp] = h0 | (h1 << 16);
            lo[jp] = f2bf(v[0] - __uint_as_float(h0 << 16)) | (f2bf(v[1] - __uint_as_float(h1 << 16)) << 16); }
        u32x4* dst = (u32x4*)(ws + WS_WR) + ((size_t)((l * 64 + ks) * 2 + cb) * 2) * 64 + lane;
        dst[0] = (u32x4){hi[0], hi[1], hi[2], hi[3]}; dst[64] = (u32x4){lo[0], lo[1], lo[2], lo[3]};
    }
}
__device__ __forceinline__ void P_inproj_mfma(int l_) { const KP p = (KP)__builtin_amdgcn_kernarg_segment_ptr(); int l = l_; asm volatile("" : "+s"(l));
    unsigned char* ws = p->ws; asm volatile("" : "+s"(ws));
    PlainOrder S; S.init(p->out, (const bf16*)(ws + WS_WIN_T) + (size_t)l * NIN * D_, D_, D_, NT, NIN, (int)gridDim.x, launder_s((int)blockIdx.x));
#ifdef STAGGER_TICKS
    { const unsigned long long t0 = __builtin_amdgcn_s_memrealtime(); const unsigned long long d = (unsigned long long)((launder_s((int)blockIdx.x) >> 3) & 3) * STAGGER_TICKS;
      while (__builtin_amdgcn_s_memrealtime() - t0 < d) __builtin_amdgcn_s_sleep(4); }
#endif
    const pg8::Gemm g{D_, D_, D_, D_ / 64, 0, 0};
    const EpiInProj E{ws, p->in[3] + l * 24, p->in[4] + l * 4, (unsigned*)(ws + WS_CTL) + CW_KN + l * 8192};
    pg8::gemm_phase<EpiInProj, PlainOrder, INPROJ_ALIGN, INPROJ_SP2>((LAS unsigned char*)lds_raw, g, S, E);
}
__device__ __forceinline__ void P_inproj_dummy(int l_) { const KP p = (KP)__builtin_amdgcn_kernarg_segment_ptr(); int l = l_; asm volatile("" : "+s"(l));
    unsigned char* ws = p->ws; asm volatile("" : "+s"(ws));
    PlainOrder S; S.init(p->out, (const bf16*)(ws + WS_WIN_T) + (size_t)l * NIN * D_, D_, D_, NT, NIN, (int)gridDim.x, launder_s((int)blockIdx.x));
    const pg8::Gemm g{D_, D_, D_, D_ / 64, 0, 0};
    const EpiDummy E{(float*)(ws + WS_HB)};
    pg8::gemm_phase<EpiDummy, PlainOrder, true, true>((LAS unsigned char*)lds_raw, g, S, E);
}
__device__ __forceinline__ void P_outproj_mfma(int l_) { const KP p = (KP)__builtin_amdgcn_kernarg_segment_ptr(); int l = l_; asm volatile("" : "+s"(l));
    unsigned char* ws = p->ws; asm volatile("" : "+s"(ws));
    PlainOrder S; S.init(ws + WS_ATT, (const bf16*)(ws + WS_WOUT_T) + (size_t)l * D_ * D_, D_, D_, NT, D_, (int)gridDim.x, launder_s((int)blockIdx.x));
    const pg8::Gemm g{D_, D_, D_, D_ / 64, 32, 8};
    const EpiResBf16 E{(bf16*)(ws + WS_HN)};
    pg8::gemm_phase<EpiResBf16, PlainOrder, true, true>((LAS unsigned char*)lds_raw, g, S, E);
}
__device__ __forceinline__ float wave_max_l(float v, int lane) {
#pragma unroll
    for (int o = 1; o < 64; o <<= 1) v = fmaxf(v, shflx_f(v, o, lane));
    return v;
}
__device__ __forceinline__ float wave_min_l(float v, int lane) {
#pragma unroll
    for (int o = 1; o < 64; o <<= 1) v = fminf(v, shflx_f(v, o, lane));
    return v;
}
template <int NS> __device__ __forceinline__ float q_norm2_max(const bf16x8v (&Q)[NS], int lane) {
    float ss = 0.f;
#pragma unroll
    for (int s = 0; s < NS; ++s)
#pragma unroll
        for (int e = 0; e < 8; ++e) { const float v = __uint_as_float(((unsigned)(unsigned short)Q[s][e]) << 16); ss = fmaf(v, v, ss); }
    return wave_max_l(swap_sum(ss), lane);
}
__device__ __forceinline__ u64 prune_consensus(bool skip, LAS u64* slots, int wave, int lane) {
    const u64 mine = __ballot(skip);
    __syncthreads();
    if (lane == 0) slots[wave] = mine;
    __syncthreads();
    u64 all = slots[0];
#pragma unroll
    for (int w = 1; w < NWAVES; ++w) all &= slots[w];
    return all;
}
__device__ __forceinline__ void U_fox(KP p_, int bh_, int qb_, int l_) {
    const KP p = uni_kp(p_); const int bh = __builtin_amdgcn_readfirstlane(bh_), qb = __builtin_amdgcn_readfirstlane(qb_), l = __builtin_amdgcn_readfirstlane(l_);
    int tid_ = threadIdx.x; asm volatile("" : "+v"(tid_));
    const int tid = tid_, lane = tid & 63, wave = __builtin_amdgcn_readfirstlane(tid >> 6), r = lane & 31, h = lane >> 5;
    unsigned char* ws = p->ws; asm volatile("" : "+s"(ws)); LAS unsigned char* L = (LAS unsigned char*)lds_raw;
    const int tw0 = 256 * qb + 32 * wave, t_lane = tw0 + r, b = bh >> 2, hd = bh & 3;
    const bf16* q = (const bf16*)(ws + WS_FQKV) + (size_t)bh * T_ * 64 + (t_lane >> 4) * 1024 + (t_lane & 15) * 32 + 8 * h;
    bf16x8v Qf[1][4];
#pragma unroll
    for (int s = 0; s < 4; ++s) Qf[0][s] = *(const bf16x8v*)(q + (s >> 1) * 512 + (s & 1) * 16);
    LAS float* cum = (LAS float*)(L + A_LDS_END);
    { const float* fl = (const float*)(ws + WS_FL) + (size_t)bh * T_; LAS float* tot = cum + 4096;
      const int nval = 256 * (qb + 1); float v[8];
      if (8 * tid < nval) { const f32x4 a = *(const f32x4*)(fl + 8 * tid), c2 = *(const f32x4*)(fl + 8 * tid + 4); v[0] = a.x; v[1] = a.y; v[2] = a.z; v[3] = a.w; v[4] = c2.x; v[5] = c2.y; v[6] = c2.z; v[7] = c2.w; }
      else {
#pragma unroll
          for (int i = 0; i < 8; ++i) v[i] = 0.f; }
#pragma unroll
      for (int i = 1; i < 8; ++i) v[i] += v[i - 1];
      float sc = v[7];
#pragma unroll
      for (int o = 1; o < 64; o <<= 1) { const float up = __uint_as_float((unsigned)__builtin_amdgcn_ds_bpermute((lane - o) << 2, (int)__float_as_uint(sc))); if (lane >= o) sc += up; }
      if (lane == 63) tot[wave] = sc;
      __syncthreads();
      float base = sc - v[7];
      for (int w = 0; w < wave; ++w) base += tot[w];
      if (8 * tid < nval) {
#pragma unroll
          for (int i = 0; i < 8; ++i) cum[8 * tid + i] = v[i] + base; }
      __syncthreads(); }
    f32x16 O[1][2]; float M[1] = {0.f}, Ls[1] = {0.f};
#pragma unroll
    for (int i = 0; i < 16; ++i) { O[0][0][i] = 0.f; O[0][1][i] = 0.f; }
    const u64 tm = (qb == 15) ? ~0ull : ((1ull << (4 * qb + 4)) - 1ull);
#if AC2_MODE == 0
    {
        const u64 low = (1ull << (4 * qb)) - 1ull; const float cref = cum[256 * qb];
        const bf16* Kp = (const bf16*)(ws + WS_FQKV) + 8 * MiB + (size_t)bh * T_ * 64; const bf16* Vp = (const bf16*)(ws + WS_FQKV) + 16 * MiB + (size_t)bh * T_ * 64;
        attn_core<64, 1, true, false>(L, Kp, nullptr, Vp, cum, cref, Qf, tm & ~low, t_lane, tw0, 1 << 30, 0.f, 0u, 0u, O, M, Ls, tid);
        if (qb > 0) {
            const float qn2 = q_norm2_max<4>(Qf[0], lane), mmin = wave_min_l(M[0], lane);
            const float* kn = (const float*)((const unsigned*)(ws + WS_CTL) + CW_KN + l * 8192) + ((size_t)bh * 64 + lane) * 2;
            bool skip = false;
            if (lane < 4 * qb) { const float kn2 = kn[0] + kn[1]; const float bound = sqrtf(qn2 * kn2) * 1.02f + (cref - cum[64 * lane + 63]) * LOG2E - mmin; skip = bound < -152.f; }
            const u64 drop = prune_consensus(skip, (LAS u64*)(cum + 4096 + 16), wave, lane);
            const u64 tm2 = low & ~drop;
            if (tm2) attn_core<64, 1, true, false>(L, Kp, nullptr, Vp, cum, cref, Qf, tm2, t_lane, tw0, 1 << 30, 0.f, 0u, 0u, O, M, Ls, tid, true);
        }
    }
#else
    attn_core2<true, false>(L, (const bf16*)(ws + WS_FQKV) + 8 * MiB + (size_t)bh * T_ * 64, (const bf16*)(ws + WS_FQKV) + 16 * MiB + (size_t)bh * T_ * 64, cum, cum[256 * qb],
                            Qf[0], tm, t_lane, tw0, 1 << 30, 0.f, 0u, 0u, O[0], M[0], Ls[0], tid);
#endif
    const float lt = swap_sum(Ls[0]), inv = lt > 0.f ? 1.f / lt : 0.f;
    bf16* dst = (bf16*)(ws + WS_ATT) + mix_off((size_t)b * T_ + t_lane, 512 + hd * 64 + 4 * h, 1024);
    ATTN_FOR_CHUNKS(db, g4) { const unsigned w0 = cvtpk(O[0][db][4 * g4 + 0] * inv, O[0][db][4 * g4 + 1] * inv), w1 = cvtpk(O[0][db][4 * g4 + 2] * inv, O[0][db][4 * g4 + 3] * inv);
        *(u64*)(dst + (4 * db + g4) * 256) = (u64)w0 | ((u64)w1 << 32); }
}
__device__ __forceinline__ void U_diff(KP p_, int bh_, int qb_, int l_) {
    const KP p = uni_kp(p_); const int bh = __builtin_amdgcn_readfirstlane(bh_), qb = __builtin_amdgcn_readfirstlane(qb_), l = __builtin_amdgcn_readfirstlane(l_);
    int tid_ = threadIdx.x; asm volatile("" : "+v"(tid_));
    const int tid = tid_, lane = tid & 63, wave = __builtin_amdgcn_readfirstlane(tid >> 6), r = lane & 31, h = lane >> 5;
    unsigned char* ws = p->ws; asm volatile("" : "+s"(ws)); LAS unsigned char* L = (LAS unsigned char*)lds_raw;
    const int tw0 = 256 * qb + 32 * wave, t_lane = tw0 + r, b = bh >> 2, hd = bh & 3;
    const bf16* DQ = (const bf16*)(ws + WS_DQK); const bf16* DK = DQ + 8 * MiB;
    bf16x8v Qf[2][2];
#pragma unroll
    for (int mp = 0; mp < 2; ++mp)
#pragma unroll
        for (int s = 0; s < 2; ++s) Qf[mp][s] = *(const bf16x8v*)(DQ + ((size_t)(bh * 2 + mp) * T_ + t_lane) * 32 + 16 * s + 8 * h);
    f32x16 O[2][2]; float M[2] = {0.f, 0.f}, Ls[2] = {0.f, 0.f};
#pragma unroll
    for (int i = 0; i < 16; ++i) { O[0][0][i] = 0.f; O[0][1][i] = 0.f; O[1][0][i] = 0.f; O[1][1][i] = 0.f; }
    const u64 tm = (qb == 15) ? ~0ull : ((1ull << (4 * qb + 4)) - 1ull);
    {
        const u64 low = (1ull << (4 * qb)) - 1ull; const float slope2 = alibi_slope(hd + 1, 4) * LOG2E;
        const bf16* K0 = DK + (size_t)(bh * 2 + 0) * T_ * 32; const bf16* K1 = DK + (size_t)(bh * 2 + 1) * T_ * 32; const bf16* Vp = (const bf16*)(ws + WS_DV) + (size_t)bh * T_ * 64;
        attn_core<32, 2, false, false>(L, K0, K1, Vp, nullptr, 0.f, Qf, tm & ~low, t_lane, tw0, 1 << 30, slope2, 0u, 0u, O, M, Ls, tid);
        if (qb > 0) {
            const float qa = q_norm2_max<2>(Qf[0], lane), qb2 = q_norm2_max<2>(Qf[1], lane), ma = wave_min_l(M[0], lane), mb = wave_min_l(M[1], lane);
            const float* kn = (const float*)((const unsigned*)(ws + WS_CTL) + CW_KN + l * 8192 + 4096) + (size_t)(bh * 2) * 64 + lane;
            bool skip = false;
            if (lane < 4 * qb) { const float bmax = slope2 * (float)(64 * lane + 63 - tw0);
                skip = (sqrtf(qa * kn[0]) * 1.02f + bmax - ma < -152.f) && (sqrtf(qb2 * kn[64]) * 1.02f + bmax - mb < -152.f); }
            const u64 drop = prune_consensus(skip, (LAS u64*)(L + A_LDS_END), wave, lane);
            const u64 tm2 = low & ~drop;
            if (tm2) attn_core<32, 2, false, false>(L, K0, K1, Vp, nullptr, 0.f, Qf, tm2, t_lane, tw0, 1 << 30, slope2, 0u, 0u, O, M, Ls, tid, true);
        }
    }
    const float* lam = p->in[11] + (size_t)l * 128; const float* subln = p->in[12] + (size_t)l * 64;
    float l1 = 0.f, l2 = 0.f; if (lane < 32) { l1 = lam[lane] * lam[32 + lane]; l2 = lam[64 + lane] * lam[96 + lane]; }
    const float li = lambda_init_of(l), lam_full = __expf(wave_sum_l(l1, lane)) - __expf(wave_sum_l(l2, lane)) + li;
    const float lt0 = swap_sum(Ls[0]), lt1 = swap_sum(Ls[1]), i0 = lt0 > 0.f ? 1.f / lt0 : 0.f, i1 = (lt1 > 0.f ? 1.f / lt1 : 0.f) * lam_full;
    float ss = 0.f;
#pragma unroll
    for (int db = 0; db < 2; ++db)
#pragma unroll
        for (int i = 0; i < 16; ++i) { const float o = O[0][db][i] * i0 - O[1][db][i] * i1; O[0][db][i] = o; ss += o * o; }
    ss = swap_sum(ss);
    const float rn = rsqrtf(ss * (1.f / 64.f) + EPS) * (1.f - li);
    bf16* dst = (bf16*)(ws + WS_ATT) + mix_off((size_t)b * T_ + t_lane, 768 + hd * 64 + 4 * h, 1024);
    ATTN_FOR_CHUNKS(db, g4) { const f32x4 sg = *(const f32x4*)(subln + 32 * db + 8 * g4 + 4 * h);
        const unsigned w0 = cvtpk(O[0][db][4 * g4 + 0] * rn * sg.x, O[0][db][4 * g4 + 1] * rn * sg.y), w1 = cvtpk(O[0][db][4 * g4 + 2] * rn * sg.z, O[0][db][4 * g4 + 3] * rn * sg.w);
        *(u64*)(dst + (4 * db + g4) * 256) = (u64)w0 | ((u64)w1 << 32); }
}
__device__ __forceinline__ void U_win(KP p_, int bg_, int c_) {
    const KP p = uni_kp(p_); const int bg = __builtin_amdgcn_readfirstlane(bg_), cc = __builtin_amdgcn_readfirstlane(c_);
    int tid_ = threadIdx.x; asm volatile("" : "+v"(tid_));
    const int tid = tid_, lane = tid & 63, wave = __builtin_amdgcn_readfirstlane(tid >> 6), r = lane & 31, h = lane >> 5;
    unsigned char* ws = p->ws; asm volatile("" : "+s"(ws)); LAS unsigned char* L = (LAS unsigned char*)lds_raw;
    const int b = bg >> 1, g = bg & 1, hd = g * 4 + (wave >> 1), tw0 = 64 * cc + 32 * (wave & 1), t_lane = tw0 + r;
    const bf16* q = (const bf16*)(ws + WS_QN) + (size_t)(b * 8 + hd) * T_ * 64 + (t_lane >> 4) * 1024 + (t_lane & 15) * 32 + 8 * h;
    bf16x8v Qf[1][4];
#pragma unroll
    for (int s = 0; s < 4; ++s) Qf[0][s] = *(const bf16x8v*)(q + (s >> 1) * 512 + (s & 1) * 16);
    f32x16 O[1][2]; float M[1] = {0.f}, Ls[1] = {0.f};
#pragma unroll
    for (int i = 0; i < 16; ++i) { O[0][0][i] = 0.f; O[0][1][i] = 0.f; }
    const int jlo = cc > 8 ? cc - 8 : 0;
    const u64 hi = (cc == 63) ? ~0ull : ((1ull << (cc + 1)) - 1ull), tm = hi & ~((1ull << jlo) - 1ull);
#if AC2_MODE == 0
    attn_core<64, 1, false, false>(L, (const bf16*)(ws + WS_KV6 + 4 * KV6_STRIDE) + (size_t)bg * T_ * 64, nullptr, (const bf16*)(ws + WS_KV6 + 5 * KV6_STRIDE) + (size_t)bg * T_ * 64, nullptr, 0.f,
                                   Qf, tm, t_lane, tw0, 512, alibi_slope(hd + 1, 8) * LOG2E, 0u, 0u, O, M, Ls, tid);
#else
    attn_core2<false, false>(L, (const bf16*)(ws + WS_KV6 + 4 * KV6_STRIDE) + (size_t)bg * T_ * 64, (const bf16*)(ws + WS_KV6 + 5 * KV6_STRIDE) + (size_t)bg * T_ * 64, nullptr, 0.f,
                             Qf[0], tm, t_lane, tw0, 512, alibi_slope(hd + 1, 8) * LOG2E, 0u, 0u, O[0], M[0], Ls[0], tid);
#endif
    const size_t n = (size_t)b * T_ + t_lane;
    const float lt = swap_sum(Ls[0]), inv = (lt > 0.f ? 1.f / lt : 0.f) * ((const float*)(ws + WS_GATE))[n * 24 + hd * 3 + 2];
    bf16* dst = (bf16*)(ws + WS_OWIN) + mix_off(n, hd * 64 + 4 * h, 512);
    ATTN_FOR_CHUNKS(db, g4) { const unsigned w0 = cvtpk(O[0][db][4 * g4 + 0] * inv, O[0][db][4 * g4 + 1] * inv), w1 = cvtpk(O[0][db][4 * g4 + 2] * inv, O[0][db][4 * g4 + 3] * inv);
        *(u64*)(dst + (4 * db + g4) * 256) = (u64)w0 | ((u64)w1 << 32); }
}
__device__ __forceinline__ void U_slc(KP p_, int bg_, int c_) {
    const KP p = uni_kp(p_); const int bg = __builtin_amdgcn_readfirstlane(bg_), cc = __builtin_amdgcn_readfirstlane(c_);
    int tid_ = threadIdx.x; asm volatile("" : "+v"(tid_));
    const int tid = tid_, lane = tid & 63, wave = __builtin_amdgcn_readfirstlane(tid >> 6), r = lane & 31, h = lane >> 5;
    unsigned char* ws = p->ws; asm volatile("" : "+s"(ws)); LAS unsigned char* L = (LAS unsigned char*)lds_raw;
    const int b = bg >> 1, g = bg & 1, hd = g * 4 + (wave >> 1), tw0 = 64 * cc + 32 * (wave & 1), t_lane = tw0 + r;
    const bf16* q = (const bf16*)(ws + WS_QN) + (size_t)(b * 8 + hd) * T_ * 64 + (t_lane >> 4) * 1024 + (t_lane & 15) * 32 + 8 * h;
    bf16x8v Qf[1][4];
#pragma unroll
    for (int s = 0; s < 4; ++s) Qf[0][s] = *(const bf16x8v*)(q + (s >> 1) * 512 + (s & 1) * 16);
    f32x16 O[1][2]; float M[1] = {0.f}, Ls[1] = {0.f};
#pragma unroll
    for (int i = 0; i < 16; ++i) { O[0][0][i] = 0.f; O[0][1][i] = 0.f; }
    const u64* sel = (const u64*)(ws + WS_SEL) + (size_t)bg * T_;
    const u64 mine = sel[t_lane]; u64 un = sel[64 * cc + lane];
    { unsigned ul = (unsigned)un, uh = (unsigned)(un >> 32);
#pragma unroll
      for (int o = 1; o < 64; o <<= 1) { ul |= shflx_u(ul, o, lane); uh |= shflx_u(uh, o, lane); }
      un = ((u64)__builtin_amdgcn_readfirstlane(uh) << 32) | __builtin_amdgcn_readfirstlane(ul); }
#if AC2_MODE == 0
    attn_core<64, 1, false, true>(L, (const bf16*)(ws + WS_KV6 + 2 * KV6_STRIDE) + (size_t)bg * T_ * 64, nullptr, (const bf16*)(ws + WS_KV6 + 3 * KV6_STRIDE) + (size_t)bg * T_ * 64, nullptr, 0.f,
                                  Qf, un, t_lane, tw0, 1 << 30, alibi_slope(hd + 1, 8) * LOG2E, (unsigned)mine, (unsigned)(mine >> 32), O, M, Ls, tid);
#else
    attn_core2<false, true>(L, (const bf16*)(ws + WS_KV6 + 2 * KV6_STRIDE) + (size_t)bg * T_ * 64, (const bf16*)(ws + WS_KV6 + 3 * KV6_STRIDE) + (size_t)bg * T_ * 64, nullptr, 0.f,
                            Qf[0], un, t_lane, tw0, 1 << 30, alibi_slope(hd + 1, 8) * LOG2E, (unsigned)mine, (unsigned)(mine >> 32), O[0], M[0], Ls[0], tid);
#endif
    const size_t n = (size_t)b * T_ + t_lane;
    const float lt = swap_sum(Ls[0]), inv = (lt > 0.f ? 1.f / lt : 0.f) * ((const float*)(ws + WS_GATE))[n * 24 + hd * 3 + 1];
    const bf16* oc = (const bf16*)(ws + WS_OCMP) + mix_off(n, hd * 64 + 4 * h, 512); const bf16* ow = (const bf16*)(ws + WS_OWIN) + mix_off(n, hd * 64 + 4 * h, 512);
    bf16* dst = (bf16*)(ws + WS_ATT) + mix_off(n, hd * 64 + 4 * h, 1024);
    ATTN_FOR_CHUNKS(db, g4) { const u64 a = *(const u64*)(oc + (4 * db + g4) * 256), w = *(const u64*)(ow + (4 * db + g4) * 256);
        const float x0 = O[0][db][4 * g4 + 0] * inv + __uint_as_float((unsigned)a << 16) + __uint_as_float((unsigned)w << 16);
        const float x1 = O[0][db][4 * g4 + 1] * inv + __uint_as_float((unsigned)a & 0xffff0000u) + __uint_as_float((unsigned)w & 0xffff0000u);
        const float x2 = O[0][db][4 * g4 + 2] * inv + __uint_as_float((unsigned)(a >> 32) << 16) + __uint_as_float((unsigned)(w >> 32) << 16);
        const float x3 = O[0][db][4 * g4 + 3] * inv + __uint_as_float((unsigned)(a >> 32) & 0xffff0000u) + __uint_as_float((unsigned)(w >> 32) & 0xffff0000u);
        *(u64*)(dst + (4 * db + g4) * 256) = (u64)cvtpk(x0, x1) | ((u64)cvtpk(x2, x3) << 32); }
}
__device__ __forceinline__ float other_half(float x, int h) { auto rr = __builtin_amdgcn_permlane32_swap(__float_as_uint(x), __float_as_uint(x), false, false); return __uint_as_float(h ? rr[0] : rr[1]); }
__device__ __forceinline__ int other_half_i(int x, int h) { auto rr = __builtin_amdgcn_permlane32_swap((unsigned)x, (unsigned)x, false, false); return (int)(h ? rr[0] : rr[1]); }
template <bool MASK>
__device__ __forceinline__ void cmp_scores(f32x16& p0, f32x16& p1, const LAS unsigned char* kt, const bf16x8v (&Qf)[4], float b0, float s1, int cl, int nvis_l) {
    const float s8 = s1 * 8.f, s32 = s1 * 32.f;
    p0[0] = b0; p0[1] = p0[0] + s1; p0[2] = p0[1] + s1; p0[3] = p0[2] + s1;
#pragma unroll
    for (int reg = 4; reg < 16; ++reg) p0[reg] = p0[reg - 4] + s8;
#pragma unroll
    for (int reg = 0; reg < 16; ++reg) p1[reg] = p0[reg] + s32;
#pragma unroll
    for (int s = 0; s < 4; ++s) { const bf16x8v kf0 = *(const LAS bf16x8v*)(kt + s * 32), kf1 = *(const LAS bf16x8v*)(kt + 32 * 144 + s * 32);
        p0 = __builtin_amdgcn_mfma_f32_32x32x16_bf16(kf0, Qf[s], p0, 0, 0, 0); p1 = __builtin_amdgcn_mfma_f32_32x32x16_bf16(kf1, Qf[s], p1, 0, 0, 0); }
    if (MASK) {
#pragma unroll
        for (int reg = 0; reg < 16; ++reg) { const int c = cl + crow0(reg); p0[reg] = (c < nvis_l) ? p0[reg] : -INFINITY; p1[reg] = (c + 32 < nvis_l) ? p1[reg] : -INFINITY; } }
}
__device__ __forceinline__ void U_cmp(KP p_, int bg_, int u_) {
    const KP p = uni_kp(p_); const int bg = __builtin_amdgcn_readfirstlane(bg_), uu = __builtin_amdgcn_readfirstlane(u_);
    int tid_ = threadIdx.x; asm volatile("" : "+v"(tid_));
    const int tid = tid_, lane = tid & 63, wave = __builtin_amdgcn_readfirstlane(tid >> 6), r = lane & 31, h = lane >> 5;
    unsigned char* ws = p->ws; asm volatile("" : "+s"(ws)); LAS unsigned char* L = (LAS unsigned char*)lds_raw;
    const int b = bg >> 1, g = bg & 1, tw0 = 32 * (uu + 16 * wave), t_lane = tw0 + r;
    { const bf16* kc = (const bf16*)(ws + WS_KVCMP) + (size_t)bg * 256 * 64; const bf16* vc = kc + 16 * 256 * 64;
#pragma unroll
      for (int i = 0; i < 4; ++i) { const int ch = tid + 512 * i, row = ch >> 3, c8 = ch & 7;
          *(LAS u32x4*)(L + row * 144 + c8 * 16) = *(const u32x4*)(kc + row * 64 + c8 * 8); *(LAS u32x4*)(L + 36864 + row * 144 + c8 * 16) = *(const u32x4*)(vc + row * 64 + c8 * 8); } }
    __syncthreads();
    const int nvis_l = t_lane >= 31 ? ((t_lane - 31) >> 4) + 1 : 0, nvis_max = (tw0 >> 4) + 1, nvis_min = tw0 >= 31 ? ((tw0 - 31) >> 4) + 1 : 0, ntile = (nvis_max + 63) >> 6;
    const LAS unsigned char* kfrag = L + r * 144 + h * 16;
    const LAS unsigned char* vfrag = L + 36864 + (4 * h + ((lane & 15) >> 2)) * 144 + (16 * ((lane >> 4) & 1) + 4 * (lane & 3)) * 2;
    float imp[32];
#pragma unroll
    for (int e = 0; e < 32; ++e) imp[e] = 0.f;
    const float* gate = (const float*)(ws + WS_GATE) + ((size_t)b * T_ + t_lane) * 24;
#pragma unroll 1
    for (int hg = 0; hg < 4; ++hg) {
        const int hd = g * 4 + hg; const float s1 = alibi_slope(hd + 1, 8) * LOG2E * 16.f;
        const bf16* q = (const bf16*)(ws + WS_QN) + (size_t)(b * 8 + hd) * T_ * 64 + (t_lane >> 4) * 1024 + (t_lane & 15) * 32 + 8 * h;
        bf16x8v Qf[4];
#pragma unroll
        for (int s = 0; s < 4; ++s) Qf[s] = *(const bf16x8v*)(q + (s >> 1) * 512 + (s & 1) * 16);
        float m = -1e30f, lsum = 0.f;
#pragma unroll 1
        for (int jt = 0; jt < ntile; ++jt) {
            f32x16 p0, p1; const float b0 = s1 * (float)(64 * jt + 4 * h - nvis_max);
            if (64 * jt + 63 >= nvis_min) cmp_scores<true>(p0, p1, kfrag + jt * (64 * 144), Qf, b0, s1, 64 * jt + 4 * h, nvis_l);
            else cmp_scores<false>(p0, p1, kfrag + jt * (64 * 144), Qf, b0, s1, 64 * jt + 4 * h, nvis_l);
            float mt = fmaxf(p0[0], p1[0]);
#pragma unroll
            for (int reg = 1; reg < 16; ++reg) mt = fmaxf(mt, fmaxf(p0[reg], p1[reg]));
            mt = swap_max(mt);
            const float mn = fmaxf(m, mt); float rs = 0.f;
#pragma unroll
            for (int reg = 0; reg < 16; ++reg) rs += __builtin_amdgcn_exp2f(p0[reg] - mn) + __builtin_amdgcn_exp2f(p1[reg] - mn);
            lsum = lsum * __builtin_amdgcn_exp2f(m - mn) + rs; m = mn;
        }
        const float lt = swap_sum(lsum), inv = lt > 0.f ? 1.f / lt : 0.f;
        f32x16 O0, O1;
#pragma unroll
        for (int i = 0; i < 16; ++i) { O0[i] = 0.f; O1[i] = 0.f; }
        float carry = 0.f;
#pragma unroll
        for (int jt = 0; jt < 4; ++jt) if (jt < ntile) {
            f32x16 p0, p1; const float b0 = s1 * (float)(64 * jt + 4 * h - nvis_max);
            if (64 * jt + 63 >= nvis_min) cmp_scores<true>(p0, p1, kfrag + jt * (64 * 144), Qf, b0, s1, 64 * jt + 4 * h, nvis_l);
            else cmp_scores<false>(p0, p1, kfrag + jt * (64 * 144), Qf, b0, s1, 64 * jt + 4 * h, nvis_l);
#pragma unroll
            for (int reg = 0; reg < 16; ++reg) { p0[reg] = __builtin_amdgcn_exp2f(p0[reg] - m) * inv; p1[reg] = __builtin_amdgcn_exp2f(p1[reg] - m) * inv; }
            float cv[8];
#pragma unroll
            for (int g4 = 0; g4 < 4; ++g4) { const float h0 = 0.5f * p0[4 * g4 + 3], h1 = 0.5f * p1[4 * g4 + 3];
                imp[jt * 8 + g4] += ((p0[4 * g4] + p0[4 * g4 + 1]) + p0[4 * g4 + 2]) + h0; imp[jt * 8 + 4 + g4] += ((p1[4 * g4] + p1[4 * g4 + 1]) + p1[4 * g4 + 2]) + h1;
                cv[g4] = h0; cv[4 + g4] = h1; }
            float prev = carry;
#pragma unroll
            for (int k = 0; k < 8; ++k) { const float sv = other_half(cv[k], h); imp[jt * 8 + k] += h ? sv : prev; prev = sv; }
            carry = prev;
            const bf16x8v pa0 = pack8(p0, 0), pa1 = pack8(p0, 8), pa2 = pack8(p1, 0), pa3 = pack8(p1, 8);
            const LAS unsigned char* vb = vfrag + jt * (64 * 144);
#pragma unroll
            for (int ks = 0; ks < 4; ++ks) { const bf16x8v pa = ks == 0 ? pa0 : ks == 1 ? pa1 : ks == 2 ? pa2 : pa3;
                { const s16x4 lo = tr_read(vb + ks * (16 * 144)), hi = tr_read(vb + ks * (16 * 144) + 8 * 144); const bf16x8v vf = {lo[0], lo[1], lo[2], lo[3], hi[0], hi[1], hi[2], hi[3]};
                  O0 = __builtin_amdgcn_mfma_f32_32x32x16_bf16(vf, pa, O0, 0, 0, 0); }
                { const s16x4 lo = tr_read(vb + ks * (16 * 144) + 64), hi = tr_read(vb + ks * (16 * 144) + 64 + 8 * 144); const bf16x8v vf = {lo[0], lo[1], lo[2], lo[3], hi[0], hi[1], hi[2], hi[3]};
                  O1 = __builtin_amdgcn_mfma_f32_32x32x16_bf16(vf, pa, O1, 0, 0, 0); } }
        }
        const float gt = gate[hd * 3 + 0];
        bf16* dst = (bf16*)(ws + WS_OCMP) + mix_off((size_t)b * T_ + t_lane, hd * 64 + 4 * h, 512);
#pragma unroll
        for (int g4 = 0; g4 < 4; ++g4) {
            *(u64*)(dst + g4 * 256) = (u64)cvtpk(O0[4 * g4 + 0] * gt, O0[4 * g4 + 1] * gt) | ((u64)cvtpk(O0[4 * g4 + 2] * gt, O0[4 * g4 + 3] * gt) << 32);
            *(u64*)(dst + (4 + g4) * 256) = (u64)cvtpk(O1[4 * g4 + 0] * gt, O1[4 * g4 + 1] * gt) | ((u64)cvtpk(O1[4 * g4 + 2] * gt, O1[4 * g4 + 3] * gt) << 32); }
    }
    const int cur = tw0 >> 6; u64 mask;
    if (cur <= 15) mask = (1ull << (cur + 1)) - 1ull;
    else {
        mask = 1ull | (1ull << cur) | (1ull << (cur - 1));
#pragma unroll
        for (int e = 0; e < 32; ++e) { const int j = 2 * e + h; if (j > cur || j == 0 || j >= cur - 1) imp[e] = -INFINITY; }
#pragma unroll 1
        for (int round = 0; round < 13; ++round) {
            float bv = imp[0]; int be = 0;
#pragma unroll
            for (int e = 1; e < 32; ++e) if (imp[e] > bv) { bv = imp[e]; be = e; }
            const int bj = 2 * be + h; const float ov = other_half(bv, h); const int oj = other_half_i(bj, h);
            const bool mine = bv > ov || (bv == ov && bj < oj);
            mask |= 1ull << (mine ? bj : oj);
#pragma unroll
            for (int e = 0; e < 32; ++e) imp[e] = (mine && e == be) ? -INFINITY : imp[e];
        }
    }
    if (h == 0) ((u64*)(ws + WS_SEL))[(size_t)bg * T_ + t_lane] = mask;
    __syncthreads();
}
__device__ __forceinline__ int fetch_unit(KP p, int qidx) {
    volatile LAS unsigned* slot = (volatile LAS unsigned*)((LAS unsigned char*)lds_raw + MISC_OFF) + 16;
    __syncthreads();
    int t0_ = threadIdx.x; asm volatile("" : "+v"(t0_));
    if (t0_ == 0) *slot = __hip_atomic_fetch_add((unsigned*)(p->ws + WS_CTL) + CW_QUEUE + 64 * qidx, 1u, __ATOMIC_RELAXED, __HIP_MEMORY_SCOPE_AGENT);
    __syncthreads();
    return (int)__builtin_amdgcn_readfirstlane(*slot);
}
__device__ __forceinline__ void P_cmp1_mfma(int l_) { const KP p = (KP)__builtin_amdgcn_kernarg_segment_ptr(); int l = l_; asm volatile("" : "+s"(l));
    unsigned char* ws = p->ws; asm volatile("" : "+s"(ws)); const int c = launder_s((int)blockIdx.x), kv = c >> 4, pm = c & 15;
    OneUnitOrder S; S.has = c < 32; S.u.pm = pm; S.u.pn = kv;
    S.u.a = (const char*)(ws + WS_KV6 + (size_t)kv * KV6_STRIDE) + (size_t)pm * 256 * 1024 * 2; S.u.b = (const char*)((const bf16*)(ws + WS_W1_T) + ((size_t)l * 2 + kv) * 256 * 2048); S.u.b2 = S.u.b;
    const pg8::Gemm g{1024, 2048, 2048, 32, 0, 0};
    const EpiCmpH E{(bf16*)(ws + WS_HC), (const float*)(ws + WS_BIAS1) + l * 512};
    pg8::gemm_phase<EpiCmpH, OneUnitOrder, false, true>((LAS unsigned char*)lds_raw, g, S, E);
}
__device__ __forceinline__ void P_cmp2_mfma(int l_) { const KP p = (KP)__builtin_amdgcn_kernarg_segment_ptr(); int l = l_; asm volatile("" : "+s"(l));
    unsigned char* ws = p->ws; asm volatile("" : "+s"(ws)); const int c = launder_s((int)blockIdx.x), kv = c >> 4, pm = c & 15;
    OneUnitOrder S; S.has = c < 32; S.u.pm = pm; S.u.pn = kv;
    S.u.a = (const char*)((const bf16*)(ws + WS_HC) + ((size_t)kv * 4096 + pm * 256) * 256); S.u.b = (const char*)((const bf16*)(ws + WS_W2_T) + ((size_t)l * 2 + kv) * 64 * 256); S.u.b2 = S.u.b;
    const pg8::Gemm g{256, 256, 256, 4, 0, 0};
    const EpiCmpOut E{(bf16*)(ws + WS_KVCMP)};
    pg8::gemm_phase<EpiCmpOut, OneUnitOrder, false, true>((LAS unsigned char*)lds_raw, g, S, E);
}
__device__ __forceinline__ void P_moe_scatter(KP p_, int l_) { const KP p = uni_kp(p_); const int l = __builtin_amdgcn_readfirstlane(l_); const Ctx c = make_ctx(p); unsigned char* ws = p->ws;
    const unsigned* cnt = (const unsigned*)(ws + WS_CTL) + CW_MOECNT + l * 128;
    moe_build_tables(cnt, c.tid);
    const LAS int* T = (const LAS int*)((LAS unsigned char*)lds_raw + TBL_OFF);
    const unsigned* info = (const unsigned*)(ws + WS_ROUTE + RT_INFO); const float* tw = (const float*)(ws + WS_ROUTE + RT_W);
    int* rowtok = (int*)(ws + WS_ROUTE + RT_ROWTOK); float* roww = (float*)(ws + WS_ROUTE + RT_ROWW);
    bf16* xs = (bf16*)(ws + WS_XS); const bf16* x = (const bf16*)(ws + WS_HN); const float* gain = p->in[14] + (size_t)l * D_; const float* rstdv = (const float*)(ws + WS_ROUTE + RT_RSTD);
    { constexpr int RB = 4; float gg[2][8];
#pragma unroll
      for (int j = 0; j < 2; ++j) { const f32x4 a = ((const f32x4*)gain)[2 * c.lane + 128 * j], b2 = ((const f32x4*)gain)[2 * c.lane + 128 * j + 1]; gg[j][0] = a.x; gg[j][1] = a.y; gg[j][2] = a.z; gg[j][3] = a.w; gg[j][4] = b2.x; gg[j][5] = b2.y; gg[j][6] = b2.z; gg[j][7] = b2.w; }
      for (int row0 = c.gw * RB; row0 < NT; row0 += c.ngw * RB) {
        u32x4 vv[RB][2];
#pragma unroll
        for (int q = 0; q < RB; ++q)
#pragma unroll
            for (int j = 0; j < 2; ++j) vv[q][j] = ((const u32x4*)(x + (size_t)(row0 + q) * D_))[c.lane + 64 * j];
#pragma unroll
        for (int q = 0; q < RB; ++q) { const int row = row0 + q;
            const unsigned v = info[row]; const int cls = (int)(v >> 24), rank = (int)(v & 0xffffffu); const size_t dest = (size_t)T[cls] * 256 + rank; const float r = rstdv[row];
#pragma unroll
            for (int j = 0; j < 2; ++j) { float f[8]; unpack8(vv[q][j], f); u32x4 o; o.x = pk2(f[0] * r * gg[j][0], f[1] * r * gg[j][1]); o.y = pk2(f[2] * r * gg[j][2], f[3] * r * gg[j][3]); o.z = pk2(f[4] * r * gg[j][4], f[5] * r * gg[j][5]); o.w = pk2(f[6] * r * gg[j][6], f[7] * r * gg[j][7]);
                ((u32x4*)(xs + dest * D_))[c.lane + 64 * j] = o; }
            if (c.lane == 0) { rowtok[dest] = row; roww[2 * dest] = tw[2 * row]; roww[2 * dest + 1] = tw[2 * row + 1]; } }
      } }
    for (int cls = c.bid; cls < 112; cls += c.G) { const int n = (int)cnt[cls], end = (int)((cnt[cls] + 255u) >> 8) * 256; const size_t base = (size_t)T[cls] * 256;
        for (int r = n + c.tid; r < end; r += NTHREADS) rowtok[base + r] = -1; }
}
__device__ __forceinline__ void P_moe_g1(int l_) { const KP p = (KP)__builtin_amdgcn_kernarg_segment_ptr(); int l = l_; asm volatile("" : "+s"(l));
    unsigned char* ws = p->ws; asm volatile("" : "+s"(ws));
    { int t0_ = threadIdx.x; asm volatile("" : "+v"(t0_)); moe_build_tables((const unsigned*)(ws + WS_CTL) + CW_MOECNT + l * 128, t0_); }
    const MoeOrder1 S{(const char*)(ws + WS_XS), (const char*)((const bf16*)(ws + WS_WGU_T) + (size_t)l * NEXP * 512 * D_), (int)gridDim.x, launder_s((int)blockIdx.x)};
    const pg8::Gemm g{D_, D_, D_, D_ / 64, 0, 0};
    const EpiMoeH E{(bf16*)(ws + WS_HB), (const float*)(ws + WS_ROUTE + RT_ROWW)};
    pg8::gemm_phase<EpiMoeH, MoeOrder1, true, true>((LAS unsigned char*)lds_raw, g, S, E);
}
__device__ __forceinline__ void P_moe_g2(int l_) { const KP p = (KP)__builtin_amdgcn_kernarg_segment_ptr(); int l = l_; asm volatile("" : "+s"(l));
    unsigned char* ws = p->ws; asm volatile("" : "+s"(ws));
    { int t0_ = threadIdx.x; asm volatile("" : "+v"(t0_)); moe_build_tables((const unsigned*)(ws + WS_CTL) + CW_MOECNT + l * 128, t0_); }
    const MoeOrder2 S{(const char*)(ws + WS_HB), (const char*)((const bf16*)(ws + WS_WD_T) + (size_t)l * NEXP * D_ * DEXP), (int)gridDim.x, launder_s((int)blockIdx.x)};
    const pg8::Gemm g{512, DEXP, 512, 4, 16, 16};
    const EpiMoeOut E{(bf16*)(ws + WS_HN), (const int*)(ws + WS_ROUTE + RT_ROWTOK)};
    pg8::gemm_phase<EpiMoeOut, MoeOrder2, true, true>((LAS unsigned char*)lds_raw, g, S, E);
}
__device__ __forceinline__ void P_norm1(KP p_, int l_) { const KP p = uni_kp(p_); const int l = __builtin_amdgcn_readfirstlane(l_); const Ctx c = make_ctx(p); const Bufs b = make_bufs(p->ws);
    if (l == 0) { const int i = c.bid * NTHREADS + c.tid; if (i < L_ * 2 * 256) { const float* part = (const float*)(p->ws + WS_B1PART) + (size_t)(i >> 8) * 128 * 256 + (i & 255); float a = 0.f;
        for (int k = 0; k < 128; ++k) a += part[(size_t)k * 256]; ((float*)(p->ws + WS_BIAS1))[i] = a; } }
    if (l == 0) ph_norm_bf16(c, p->in[0], p->in[1], (bf16*)p->out, (bf16*)(p->ws + WS_HN)); else ph_norm_bf16_from_bf16(c, (const bf16*)(p->ws + WS_HN), p->in[1] + (size_t)l * D_, (bf16*)p->out); }
__device__ __noinline__ void P_inproj(KP p_, int l_) { const KP p = uni_kp(p_); const int l = __builtin_amdgcn_readfirstlane(l_); const Ctx c = make_ctx(p); const Bufs b = make_bufs(p->ws);
    InProjOut o{b.QN, b.KV6, b.FQ, b.DQ, b.DV, b.GATE, b.FL, p->in[3] + l * 24, p->in[4] + l * 4};
    const bf16* A = b.HN;
    naive_gemm(c, NT, D_IN, D_, [=](int r, int k) { return bf2f(A[(size_t)r * D_ + k]); }, p->in[2] + (size_t)l * D_ * D_IN, D_IN,
               [=](int r, int col, float v) { inproj_store(o, r, col, v); }); }
__device__ __noinline__ void P_cmp1(KP p_, int l_, int kv_) { const KP p = uni_kp(p_); const int l = __builtin_amdgcn_readfirstlane(l_), kv = __builtin_amdgcn_readfirstlane(kv_); const Ctx c = make_ctx(p); const Bufs b = make_bufs(p->ws);
    const bf16* src = kv == 0 ? b.KC : b.VC; const float* pe = p->in[kv == 0 ? 5 : 8] + (size_t)l * 2048; bf16* hc = b.HC + (size_t)kv * 4096 * 256;
    naive_gemm(c, 4096, 256, 2048, [=](int r, int k) { return bf2f(src[(size_t)r * 1024 + k]) + pe[k]; }, p->in[kv == 0 ? 6 : 9] + (size_t)l * 2048 * 256, 256,
               [=](int r, int col, float v) { hc[(size_t)r * 256 + col] = (bf16)f2bf(gelu_tanh(v)); }); }
__device__ __noinline__ void P_cumsum(KP p_, int l_) { const KP p = uni_kp(p_); const int l = __builtin_amdgcn_readfirstlane(l_); const Ctx c = make_ctx(p); const Bufs b = make_bufs(p->ws); ph_cumsum(c, b.FL); }
__device__ __noinline__ void P_cmp2(KP p_, int l_, int kv_) { const KP p = uni_kp(p_); const int l = __builtin_amdgcn_readfirstlane(l_), kv = __builtin_amdgcn_readfirstlane(kv_); const Ctx c = make_ctx(p); const Bufs b = make_bufs(p->ws);
    const bf16* hc = b.HC + (size_t)kv * 4096 * 256; bf16* dst = kv == 0 ? b.KCMP : b.VCMP;
    naive_gemm(c, 4096, 64, 256, [=](int r, int k) { return bf2f(hc[(size_t)r * 256 + k]); }, p->in[kv == 0 ? 7 : 10] + (size_t)l * 256 * 64, 64,
               [=](int r, int col, float v) { dst[(size_t)r * 64 + col] = (bf16)f2bf((r & 255) == 255 ? 0.f : v); }); }
__device__ __noinline__ void P_win(KP p_, int l_) { const KP p = uni_kp(p_); const int l = __builtin_amdgcn_readfirstlane(l_); const Ctx c = make_ctx(p); const Bufs b = make_bufs(p->ws); ph_win_attn(c, b.QN, b.KW, b.VW, b.GATE, b.OWIN); }
__device__ __noinline__ void P_fox(KP p_, int l_) { const KP p = uni_kp(p_); const int l = __builtin_amdgcn_readfirstlane(l_); const Ctx c = make_ctx(p); const Bufs b = make_bufs(p->ws); ph_fox_attn(c, b.FQ, b.FK, b.FV, b.FL, b.ATT); }
__device__ __noinline__ void P_diff(KP p_, int l_) { const KP p = uni_kp(p_); const int l = __builtin_amdgcn_readfirstlane(l_); const Ctx c = make_ctx(p); const Bufs b = make_bufs(p->ws);
    ph_diff_attn(c, b.DQ, b.DK, b.DV, p->in[11] + (size_t)l * 128, p->in[12] + (size_t)l * 64, lambda_init_of(l), b.ATT); }
__device__ __noinline__ void P_cmpattn(KP p_, int l_) { const KP p = uni_kp(p_); const int l = __builtin_amdgcn_readfirstlane(l_); const Ctx c = make_ctx(p); const Bufs b = make_bufs(p->ws); ph_cmp_attn(c, b.QN, b.KCMP, b.VCMP, b.GATE, b.SEL, b.OCMP); }
__device__ __noinline__ void P_slc(KP p_, int l_) { const KP p = uni_kp(p_); const int l = __builtin_amdgcn_readfirstlane(l_); const Ctx c = make_ctx(p); const Bufs b = make_bufs(p->ws); ph_slc_attn(c, b.QN, b.KS, b.VS, b.GATE, b.SEL, b.OCMP, b.OWIN, b.ATT); }
__device__ __noinline__ void P_outproj(KP p_, int l_) { const KP p = uni_kp(p_); const int l = __builtin_amdgcn_readfirstlane(l_); const Ctx c = make_ctx(p); const Bufs b = make_bufs(p->ws);
    const bf16* A = b.ATT; float* xo = p->out; const float* xin = (l == 0) ? p->in[0] : p->out;
    naive_gemm(c, NT, D_, D_, [=](int r, int k) { return bf2f(A[(size_t)r * D_ + k]); }, p->in[13] + (size_t)l * D_ * D_, D_,
               [=](int r, int col, float v) { xo[(size_t)r * D_ + col] = xin[(size_t)r * D_ + col] + v; }); }
__device__ __forceinline__ void P_route3(int l_, int cbank) { const KP p = (KP)__builtin_amdgcn_kernarg_segment_ptr(); int l = l_; asm volatile("" : "+s"(l));
    int tid_ = threadIdx.x; asm volatile("" : "+v"(tid_));
    const int tid = tid_, lane = tid & 63, wave = __builtin_amdgcn_readfirstlane(tid >> 6), r = lane & 31, h = lane >> 5, kh = wave >> 2, wr = wave & 3;
    unsigned char* ws = p->ws; asm volatile("" : "+s"(ws)); const bf16* x = (const bf16*)(ws + WS_HN);
    const float* WR = (const float*)(ws + WS_WR) + (size_t)l * D_ * 64;
    LAS float* XT = (LAS float*)lds_raw + wave * (32 * 36);
    LAS float* WT = (LAS float*)lds_raw + 8 * 32 * 36 + kh * (2 * 32 * 64);
    LAS float* PL = (LAS float*)lds_raw + 8 * 32 * 36 + 2 * 2 * 32 * 64;
    LAS float* SS = PL + 2 * 128 * 40;
    const float* bgrp = p->in[16] + l * 4; const float* bexp = p->in[18] + l * 32;
    unsigned* cnt = (unsigned*)(ws + WS_CTL) + CW_MOECNT + l * 128 + cbank;
    for (int grp = launder_s((int)blockIdx.x); grp < NT / 128; grp += (int)gridDim.x) {
        const int row0 = grp * 128 + wr * 32;
        f32x16 acc0, acc1; float ss = 0.f;
#pragma unroll
        for (int i = 0; i < 16; ++i) { acc0[i] = 0.f; acc1[i] = 0.f; }
        int buf = 0;
        const int xrow = lane >> 1, xpart = lane & 1;
        const u32x4* wsrc = (const u32x4*)(ws + WS_WR) + ((size_t)l * 64 + kh * 32) * 256 + (tid & 255); const bf16* xsrc = x + (size_t)(row0 + xrow) * D_ + kh * 512 + xpart * 16;
        u32x4 wv[2]; u32x4 xa[2], xb2[2];
#pragma unroll
        for (int i = 0; i < 2; ++i) wv[i] = wsrc[256 * i];
#pragma unroll
        for (int j = 0; j < 2; ++j) { xa[j] = *(const u32x4*)(xsrc + 8 * j); xb2[j] = *(const u32x4*)(xsrc + 32 + 8 * j); }
        LAS u32x4* WTq = (LAS u32x4*)WT;
#define RT_CHUNK(KC, XV) do { \
            _Pragma("unroll") for (int i = 0; i < 2; ++i) WTq[buf * 512 + (tid & 255) + 256 * i] = wv[i]; \
            _Pragma("unroll") for (int j = 0; j < 2; ++j) { float f_[8]; unpack8(XV[j], f_); _Pragma("unroll") for (int e = 0; e < 8; ++e) ss = fmaf(f_[e], f_[e], ss); \
                *(LAS f32x4*)(XT + xrow * 36 + xpart * 16 + 8 * j) = (f32x4){f_[0], f_[1], f_[2], f_[3]}; *(LAS f32x4*)(XT + xrow * 36 + xpart * 16 + 8 * j + 4) = (f32x4){f_[4], f_[5], f_[6], f_[7]}; } \
            if ((KC) + 1 < 16) { _Pragma("unroll") for (int i = 0; i < 2; ++i) wv[i] = wsrc[(size_t)((KC) + 1) * 512 + 256 * i]; } \
            if ((KC) + 2 < 16) { _Pragma("unroll") for (int j = 0; j < 2; ++j) XV[j] = *(const u32x4*)(xsrc + ((KC) + 2) * 32 + 8 * j); } \
            __syncthreads(); \
            _Pragma("unroll") for (int sidx = 0; sidx < 2; ++sidx) { \
                const f32x4 t0 = *(const LAS f32x4*)(XT + r * 36 + 16 * sidx + 8 * h), t1 = *(const LAS f32x4*)(XT + r * 36 + 16 * sidx + 8 * h + 4); \
                const float xe[8] = {t0.x, t0.y, t0.z, t0.w, t1.x, t1.y, t1.z, t1.w}; unsigned ah[4]; \
                _Pragma("unroll") for (int jp = 0; jp < 4; ++jp) ah[jp] = cvtpk(xe[2 * jp], xe[2 * jp + 1]);        \
                const bf16x8v Ah = __builtin_bit_cast(bf16x8v, (u32x4){ah[0], ah[1], ah[2], ah[3]}); \
                const LAS u32x4* wb = WTq + buf * 512 + sidx * 256 + lane; \
                const bf16x8v B0h = __builtin_bit_cast(bf16x8v, wb[0]), B0l = __builtin_bit_cast(bf16x8v, wb[64]), B1h = __builtin_bit_cast(bf16x8v, wb[128]), B1l = __builtin_bit_cast(bf16x8v, wb[192]); \
                acc0 = __builtin_amdgcn_mfma_f32_32x32x16_bf16(Ah, B0h, acc0, 0, 0, 0); acc1 = __builtin_amdgcn_mfma_f32_32x32x16_bf16(Ah, B1h, acc1, 0, 0, 0); \
                acc0 = __builtin_amdgcn_mfma_f32_32x32x16_bf16(Ah, B0l, acc0, 0, 0, 0); acc1 = __builtin_amdgcn_mfma_f32_32x32x16_bf16(Ah, B1l, acc1, 0, 0, 0); } \
            buf ^= 1; } while (0)
#pragma unroll 1
        for (int kc = 0; kc < 16; kc += 2) { RT_CHUNK(kc, xa); RT_CHUNK(kc + 1, xb2); }
#undef RT_CHUNK
#pragma unroll
        for (int reg = 0; reg < 16; ++reg) { const int row = wr * 32 + crow0(reg) + 4 * h; PL[(kh * 128 + row) * 40 + r] = acc0[reg]; if (r < 4) PL[(kh * 128 + row) * 40 + 32 + r] = acc1[reg]; }
        SS[(kh * 128 + wr * 32 + (lane >> 1)) * 2 + (lane & 1)] = ss;
        __syncthreads();
        if (tid < 128) {
            float lg[36];
#pragma unroll
            for (int cidx = 0; cidx < 36; ++cidx) lg[cidx] = PL[tid * 40 + cidx] + PL[(128 + tid) * 40 + cidx];
            const float sq = (SS[tid * 2] + SS[tid * 2 + 1]) + (SS[(128 + tid) * 2] + SS[(128 + tid) * 2 + 1]);
            const float rstd = rsqrtf(sq * (1.f / D_) + EPS);
            float gl[4]; int grp_i = 0;
#pragma unroll
            for (int q = 0; q < 4; ++q) gl[q] = lg[q] * rstd + bgrp[q];
            float gm = gl[0];
#pragma unroll
            for (int q = 1; q < 4; ++q) if (gl[q] > gm) { gm = gl[q]; grp_i = q; }
            float gs = 0.f;
#pragma unroll
            for (int q = 0; q < 4; ++q) gs += __expf(gl[q] - gm);
            const float grp_gate = 1.f / gs;
            float el[8];
#pragma unroll
            for (int q = 0; q < 8; ++q) { float v = lg[4 + q]; float bb = bexp[q];
                if (grp_i == 1) { v = lg[12 + q]; bb = bexp[8 + q]; } else if (grp_i == 2) { v = lg[20 + q]; bb = bexp[16 + q]; } else if (grp_i == 3) { v = lg[28 + q]; bb = bexp[24 + q]; }
                el[q] = v * rstd + bb; }
            int i0 = 0; float v0 = el[0];
#pragma unroll
            for (int q = 1; q < 8; ++q) if (el[q] > v0) { v0 = el[q]; i0 = q; }
            int i1 = -1; float v1 = -INFINITY;
#pragma unroll
            for (int q = 0; q < 8; ++q) if (q != i0 && el[q] > v1) { v1 = el[q]; i1 = q; }
            const float e1 = __expf(v1 - v0), den = 1.f + e1, w0 = grp_gate / den, w1 = grp_gate * e1 / den;
            const int lo = i0 < i1 ? i0 : i1, hi = i0 < i1 ? i1 : i0, cls = grp_i * 28 + lo * 8 - (lo * (lo + 1)) / 2 + (hi - lo - 1);
            const unsigned rank = __hip_atomic_fetch_add(cnt + cls, 1u, __ATOMIC_RELAXED, __HIP_MEMORY_SCOPE_AGENT);
            const int row = grp * 128 + tid;
            ((unsigned*)(ws + WS_ROUTE + RT_INFO))[row] = ((unsigned)cls << 24) | rank;
            ((float*)(ws + WS_ROUTE + RT_W))[2 * row] = i0 < i1 ? w0 : w1; ((float*)(ws + WS_ROUTE + RT_W))[2 * row + 1] = i0 < i1 ? w1 : w0;
            ((float*)(ws + WS_ROUTE + RT_RSTD))[row] = rstd;
        }
        __syncthreads();
    }
}
typedef float f32x8 __attribute__((ext_vector_type(8)));
__device__ __forceinline__ void P_route2(int l_, int cbank) { const KP p = (KP)__builtin_amdgcn_kernarg_segment_ptr(); int l = l_; asm volatile("" : "+s"(l));
    int tid_ = threadIdx.x; asm volatile("" : "+v"(tid_));
    const int tid = tid_, lane = tid & 63, wave = __builtin_amdgcn_readfirstlane(tid >> 6);
    unsigned char* ws = p->ws; asm volatile("" : "+s"(ws)); const float* x = p->out;
    const float* WR = (const float*)(ws + WS_WR) + (size_t)l * D_ * 40;
    LAS float* xt = (LAS float*)lds_raw + wave * (64 * 36);
    LAS float* part = (LAS float*)lds_raw;
    const float* bgrp = p->in[16] + l * 4; const float* bexp = p->in[18] + l * 32;
    unsigned* cnt = (unsigned*)(ws + WS_CTL) + CW_MOECNT + l * 128 + cbank;
    for (int grp = launder_s((int)blockIdx.x); grp < NT / 128; grp += (int)gridDim.x) {
        const int row0 = grp * 128 + (wave >> 2) * 64, kq = wave & 3;
        float acc[40]; float ss = 0.f;
#pragma unroll
        for (int cidx = 0; cidx < 40; ++cidx) acc[cidx] = 0.f;
#pragma unroll 1
        for (int kc = 0; kc < 8; ++kc) {
            const int k0 = kq * 256 + kc * 32;
#pragma unroll
            for (int i = 0; i < 8; ++i) { const int row = i * 8 + (lane >> 3), c4 = (lane & 7) * 4; *(LAS f32x4*)(xt + row * 36 + c4) = *(const f32x4*)(x + (size_t)(row0 + row) * D_ + k0 + c4); }
            float xr[32];
#pragma unroll
            for (int j = 0; j < 8; ++j) { const f32x4 t = *(const LAS f32x4*)(xt + lane * 36 + 4 * j); xr[4 * j] = t.x; xr[4 * j + 1] = t.y; xr[4 * j + 2] = t.z; xr[4 * j + 3] = t.w; }
            const float* wk = WR + (size_t)k0 * 40;
#pragma unroll
            for (int kk = 0; kk < 32; ++kk) {
                f32x8 w0, w1, w2, w3, w4;
                asm volatile("s_load_dwordx8 %0, %5, %6\n\ts_load_dwordx8 %1, %5, %7\n\ts_load_dwordx8 %2, %5, %8\n\ts_load_dwordx8 %3, %5, %9\n\ts_load_dwordx8 %4, %5, %10\n\ts_waitcnt lgkmcnt(0)"
                             : "=&s"(w0), "=&s"(w1), "=&s"(w2), "=&s"(w3), "=&s"(w4) : "s"(wk), "i"(kk * 160), "i"(kk * 160 + 32), "i"(kk * 160 + 64), "i"(kk * 160 + 96), "i"(kk * 160 + 128) : "memory");
                const float xv = xr[kk]; ss = fmaf(xv, xv, ss);
#pragma unroll
                for (int e = 0; e < 8; ++e) { acc[e] = fmaf(xv, w0[e], acc[e]); acc[8 + e] = fmaf(xv, w1[e], acc[8 + e]); acc[16 + e] = fmaf(xv, w2[e], acc[16 + e]); acc[24 + e] = fmaf(xv, w3[e], acc[24 + e]); }
#pragma unroll
                for (int e = 0; e < 4; ++e) acc[32 + e] = fmaf(xv, w4[e], acc[32 + e]);
            }
        }
        __syncthreads();
#pragma unroll
        for (int cidx = 0; cidx < 36; ++cidx) part[(wave * 64 + lane) * 37 + cidx] = acc[cidx];
        part[(wave * 64 + lane) * 37 + 36] = ss;
        __syncthreads();
        if (tid < 128) {
            const int rg = tid >> 6, rr = tid & 63; float lg[37];
#pragma unroll
            for (int cidx = 0; cidx < 37; ++cidx) lg[cidx] = ((part[((rg * 4 + 0) * 64 + rr) * 37 + cidx] + part[((rg * 4 + 1) * 64 + rr) * 37 + cidx]) + part[((rg * 4 + 2) * 64 + rr) * 37 + cidx]) + part[((rg * 4 + 3) * 64 + rr) * 37 + cidx];
            const float rstd = rsqrtf(lg[36] * (1.f / D_) + EPS);
            float gl[4]; int grp_i = 0;
#pragma unroll
            for (int q = 0; q < 4; ++q) gl[q] = lg[q] * rstd + bgrp[q];
            float gm = gl[0];
#pragma unroll
            for (int q = 1; q < 4; ++q) if (gl[q] > gm) { gm = gl[q]; grp_i = q; }
            float gs = 0.f;
#pragma unroll
            for (int q = 0; q < 4; ++q) gs += __expf(gl[q] - gm);
            const float grp_gate = 1.f / gs;
            float el[8];
#pragma unroll
            for (int q = 0; q < 8; ++q) { float v = lg[4 + q]; float bb = bexp[q];
                if (grp_i == 1) { v = lg[12 + q]; bb = bexp[8 + q]; } else if (grp_i == 2) { v = lg[20 + q]; bb = bexp[16 + q]; } else if (grp_i == 3) { v = lg[28 + q]; bb = bexp[24 + q]; }
                el[q] = v * rstd + bb; }
            int i0 = 0; float v0 = el[0];
#pragma unroll
            for (int q = 1; q < 8; ++q) if (el[q] > v0) { v0 = el[q]; i0 = q; }
            int i1 = -1; float v1 = -INFINITY;
#pragma unroll
            for (int q = 0; q < 8; ++q) if (q != i0 && el[q] > v1) { v1 = el[q]; i1 = q; }
            const float e1 = __expf(v1 - v0), den = 1.f + e1, w0 = grp_gate / den, w1 = grp_gate * e1 / den;
            const int lo = i0 < i1 ? i0 : i1, hi = i0 < i1 ? i1 : i0, cls = grp_i * 28 + lo * 8 - (lo * (lo + 1)) / 2 + (hi - lo - 1);
            const unsigned rank = __hip_atomic_fetch_add(cnt + cls, 1u, __ATOMIC_RELAXED, __HIP_MEMORY_SCOPE_AGENT);
            const int row = grp * 128 + tid;
            ((unsigned*)(ws + WS_ROUTE + RT_INFO))[row] = ((unsigned)cls << 24) | rank;
            ((float*)(ws + WS_ROUTE + RT_W))[2 * row] = i0 < i1 ? w0 : w1; ((float*)(ws + WS_ROUTE + RT_W))[2 * row + 1] = i0 < i1 ? w1 : w0;
            ((float*)(ws + WS_ROUTE + RT_RSTD))[row] = rstd;
        }
        __syncthreads();
    }
}
__device__ __noinline__ void P_route(KP p_, int l_) { const KP p = uni_kp(p_); const int l = __builtin_amdgcn_readfirstlane(l_); const Ctx c = make_ctx(p); const Bufs b = make_bufs(p->ws);
    ph_moe_route(c, p->out, p->in[14] + (size_t)l * D_, p->in[15] + (size_t)l * D_ * 4, p->in[16] + l * 4, p->in[17] + (size_t)l * D_ * 32, p->in[18] + l * 32, b.HN, (int*)(p->ws + WS_ROUTE + RT_INFO), (float*)(p->ws + WS_ROUTE + RT_W), (unsigned*)(p->ws + WS_CTL) + CW_MOECNT + l * 128); }
__device__ __noinline__ void P_moe(KP p_, int l_) { const KP p = uni_kp(p_); const int l = __builtin_amdgcn_readfirstlane(l_); const Ctx c = make_ctx(p); const Bufs b = make_bufs(p->ws);
    ph_moe_naive(c, b.HN, b.ROUTE_E, b.ROUTE_W, p->in[19] + (size_t)l * NEXP * D_ * DEXP, p->in[20] + (size_t)l * NEXP * D_ * DEXP, p->in[21] + (size_t)l * NEXP * DEXP * D_, p->out); }
__device__ __noinline__ void P_final(KP p_) { const KP p = uni_kp(p_); const Ctx c = make_ctx(p); ph_norm_final_from_bf16(c, (const bf16*)(p->ws + WS_HN), p->in[22], p->out); }
__device__ __forceinline__ void P_gridbar(KP p_) { const KP p = uni_kp(p_);
    XcdBarrier bar; bar.bar = (unsigned*)(p->ws + WS_CTL) + 4096; bar.x = xb_xcc_id(); bar.st = (volatile LAS unsigned*)((LAS unsigned char*)lds_raw + MISC_OFF) + 8;
    xcd_barrier(bar);
}

__global__ void __launch_bounds__(NTHREADS, 2) fwd_kernel(Params pp) {
    const KP p = (KP)__builtin_amdgcn_kernarg_segment_ptr();
    { volatile LAS unsigned* MISC = (volatile LAS unsigned*)((LAS unsigned char*)lds_raw + MISC_OFF); if (threadIdx.x < 32) MISC[threadIdx.x] = 0u; }
    __syncthreads();
    const int lo = p->ph_lo, hi = p->ph_hi;
    if (hi - lo > 1) (void)xcd_barrier_post((unsigned*)(p->ws + WS_CTL) + 4096, (volatile LAS unsigned*)((LAS unsigned char*)lds_raw + MISC_OFF) + 8);
#define IN(k) (lo <= (k) && (k) < hi)
#define SEAM(k) do { if (IN(k) && IN((k) + 1)) P_gridbar(p); } while (0)
    if (IN(0)) { for (int rep = 0; rep < REP_PRO; ++rep) { if (rep) P_gridbar(p); P_prologue(p); } }
    SEAM(0);
    for (int l = 0; l < L_; ++l) {
        const int P0 = 1 + l * PH_PER_LAYER;
        if (IN(P0 + 0)) { for (int rep = 0; rep < REP_NORM; ++rep) { if (rep) P_gridbar(p); P_norm1(p, l); } }
        SEAM(P0 + 0);
        if (IN(P0 + 1)) { for (int rep = 0; rep < REP_INPROJ; ++rep) { if (rep) P_gridbar(p); P_inproj_mfma(l); }
#ifdef REP_INDUMMY
            for (int rep = 0; rep < REP_INDUMMY; ++rep) { P_gridbar(p); P_inproj_dummy(l); }
#endif
        }
        SEAM(P0 + 1);
        if (IN(P0 + 3)) {
            P_cmp1_mfma(l);
            if (launder_s((int)blockIdx.x) < 32) { asm volatile("s_waitcnt vmcnt(0)" ::: "memory"); __builtin_amdgcn_fence(__ATOMIC_SEQ_CST, "agent"); asm volatile("s_waitcnt vmcnt(0)" ::: "memory"); }
            __syncthreads();
            P_cmp2_mfma(l);
            for (int rep = 0; rep < REP_ATT3; ++rep) { if (rep) P_gridbar(p);
            for (;;) { const int u = fetch_unit(p, l * 8 + 0 + 16 * rep); if (u >= 2048) break;
                if (u < 1024) { const int qb = 15 - (u >> 6), k = u & 63; if (k < 32) U_diff(p, k, qb, l); else U_fox(p, k - 32, qb, l); }
                else { const int w = u - 1024; U_win(p, w & 15, 63 - (w >> 4)); } } } }
        SEAM(P0 + 3);
        if (IN(P0 + 4)) { for (int rep = 0; rep < REP_CMP; ++rep) { if (rep) P_gridbar(p); for (int u = launder_s((int)blockIdx.x); u < 256; u += (int)gridDim.x) U_cmp(p, u & 15, u >> 4); } }
        SEAM(P0 + 4);
        if (IN(P0 + 5)) { for (int rep = 0; rep < REP_SLC; ++rep) { if (rep) P_gridbar(p); for (;;) { const int u = fetch_unit(p, l * 8 + 1 + 16 * rep); if (u >= 1024) break; U_slc(p, u & 15, 63 - (u >> 4)); } } }
        SEAM(P0 + 5);
        if (IN(P0 + 6)) P_outproj_mfma(l);
        SEAM(P0 + 6);
        if (IN(P0 + 7)) { for (int rep = 0; rep < REP_ROUTE; ++rep) { if (rep) P_gridbar(p); P_route3(l, (REP_ROUTE - 1 - rep) * 256); } }
        SEAM(P0 + 7);
        if (IN(P0 + 8)) { for (int rep = 0; rep < REP_SCAT; ++rep) { if (rep) P_gridbar(p); P_moe_scatter(p, l); } }
        SEAM(P0 + 8);
        if (IN(P0 + 9)) { for (int rep = 0; rep < REP_G1; ++rep) { if (rep) P_gridbar(p); P_moe_g1(l); } }
        SEAM(P0 + 9);
        if (IN(P0 + 10)) P_moe_g2(l);
        SEAM(P0 + 10);
    }
    if (IN(1 + L_ * PH_PER_LAYER)) P_final(p);
#undef IN
#undef SEAM
}

extern "C" void kernel_launch(void* const* d_in, const int* in_sizes, int n_in, void* d_out, int out_size, void* d_ws, size_t ws_size, hipStream_t stream) {
    static int grid = 0;
    if (grid == 0) {
        if (n_in != 23 || out_size != NT * D_ || ws_size < WS_END) { fprintf(stderr, "kernel_launch: unexpected sizes n_in %d out %d ws %zu (need %zu)\n", n_in, out_size, ws_size, (size_t)WS_END); grid = -1; return; }
        int dev = 0, cus = 0, per_cu = 0;
        if (hipGetDevice(&dev) != hipSuccess || hipDeviceGetAttribute(&cus, hipDeviceAttributeMultiprocessorCount, dev) != hipSuccess) { grid = -1; return; }
        if (hipFuncSetAttribute((const void*)fwd_kernel, hipFuncAttributeMaxDynamicSharedMemorySize, LDS_BYTES) != hipSuccess) { fprintf(stderr, "kernel_launch: hipFuncSetAttribute failed\n"); grid = -1; return; }
        if (hipOccupancyMaxActiveBlocksPerMultiprocessor(&per_cu, (const void*)fwd_kernel, NTHREADS, LDS_BYTES) != hipSuccess || per_cu < 1) { fprintf(stderr, "kernel_launch: occupancy query says %d\n", per_cu); }
        (void)hipGetLastError();
        grid = cus;
    }
    if (grid < 0) return;
    (void)hipMemsetAsync((char*)d_ws + WS_CTL, 0, CTL_BYTES, stream);
    Params p{};
    for (int i = 0; i < 23; ++i) p.in[i] = (const float*)d_in[i];
    p.out = (float*)d_out; p.ws = (unsigned char*)d_ws;
#if N_LAUNCH_MODE == 0
    p.ph_lo = 0; p.ph_hi = N_PHASES;
    hipLaunchKernelGGL(fwd_kernel, dim3(grid), dim3(NTHREADS), LDS_BYTES, stream, p);
#else
    for (int k = 0; k < N_PHASES; ++k) { p.ph_lo = k; p.ph_hi = k + 1; hipLaunchKernelGGL(fwd_kernel, dim3(grid), dim3(NTHREADS), LDS_BYTES, stream, p); }
#endif
}
```

```cpp
#include <hip/hip_runtime.h>
#include <cstdio>
#include <cstdint>

#ifndef INPROJ_ALIGN
#define INPROJ_ALIGN true
#endif
#ifndef INPROJ_SP2
#define INPROJ_SP2 true
#endif
#ifndef REP_PRO
#define REP_PRO 1
#endif
#ifndef REP_ROUTE
#define REP_ROUTE 1
#endif
#ifndef REP_NORM
#define REP_NORM 1
#endif
#ifndef REP_INPROJ
#define REP_INPROJ 1
#endif
#ifndef REP_ATT3
#define REP_ATT3 1
#endif
#ifndef REP_CMP
#define REP_CMP 1
#endif
#ifndef REP_SLC
#define REP_SLC 1
#endif
#ifndef REP_SCAT
#define REP_SCAT 1
#endif
#ifndef REP_G1
#define REP_G1 1
#endif
#ifndef N_LAUNCH_MODE
#define N_LAUNCH_MODE 0
#endif

#define LAS __attribute__((address_space(3)))
#define GAS __attribute__((address_space(1)))
typedef unsigned short bf16;
typedef unsigned long long u64;
typedef float f32x4 __attribute__((ext_vector_type(4)));
typedef unsigned u32x4 __attribute__((ext_vector_type(4)));

constexpr int B_ = 8, T_ = 4096, D_ = 1024, NT = B_ * T_, L_ = 2;
constexpr int HD = 64, D_IN = 2844;
constexpr int N_CMP = 255, CMP_HID = 256;
constexpr int NEXP = 32, DEXP = 256;
constexpr float EPS = 1e-6f;
constexpr float LOG2E = 1.4426950408889634f;
constexpr int NWAVES = 8, NTHREADS = 512;

constexpr int C_NSAQ = 0, C_KV6 = 512, C_GATE = 1280, C_FQ = 1304, C_FF = 2072, C_DQ = 2076, C_DV = 2588;

constexpr size_t MiB = 1u << 20;
constexpr size_t WS_CTL = 0, CTL_BYTES = 1 * MiB;
constexpr size_t WS_QN = 1 * MiB;
constexpr size_t WS_KV6 = WS_QN + 32 * MiB;
constexpr size_t KV6_STRIDE = 8 * MiB + 64 * 1024;
constexpr size_t WS_FQKV = WS_KV6 + 6 * KV6_STRIDE;
constexpr size_t WS_DQK = WS_FQKV + 48 * MiB;
constexpr size_t WS_DV = WS_DQK + 32 * MiB;
constexpr size_t WS_GATE = WS_DV + 16 * MiB;
constexpr size_t WS_FL = WS_GATE + 3 * MiB;
constexpr size_t WS_HC = WS_FL + 1 * MiB;
constexpr size_t WS_KVCMP = WS_HC + 4 * MiB;
constexpr size_t WS_SEL = WS_KVCMP + 1 * MiB;
constexpr size_t WS_OCMP = WS_SEL + 1 * MiB;
constexpr size_t WS_OWIN = WS_OCMP + 32 * MiB;
constexpr size_t WS_HN = WS_OWIN + 32 * MiB;
constexpr size_t WS_ATT = WS_HN + 64 * MiB;
constexpr size_t WS_ROUTE = WS_ATT + 64 * MiB;
constexpr size_t WS_WIN_T = WS_ROUTE + 2 * MiB;
constexpr size_t WS_WOUT_T = WS_WIN_T + 12 * MiB;
constexpr size_t WS_WGU_T = WS_WOUT_T + 4 * MiB;
constexpr size_t WS_WD_T = WS_WGU_T + 64 * MiB;
constexpr size_t WS_W1_T = WS_WD_T + 32 * MiB;
constexpr size_t WS_W2_T = WS_W1_T + 4 * MiB;
constexpr size_t WS_BIAS1 = WS_W2_T + 512 * 1024;
constexpr size_t WS_WR = WS_BIAS1 + 512 * 1024;
constexpr size_t WS_B1PART = WS_WR + 512 * 1024;
constexpr size_t WS_END = WS_B1PART + 512 * 1024;
constexpr int MOE_MAXROWS = 61440;
constexpr size_t WS_XS = WS_QN;
constexpr size_t WS_HB = WS_OCMP;
static_assert(WS_XS + (size_t)MOE_MAXROWS * 2048 <= WS_DQK && WS_HB + (size_t)MOE_MAXROWS * 1024 <= WS_HN, "MoE aliases");
constexpr size_t RT_INFO = 0, RT_W = 128 * 1024, RT_ROWTOK = 384 * 1024, RT_ROWW = 640 * 1024, RT_RSTD = 1152 * 1024;
constexpr int CW_QUEUE = 16384, CW_MOECNT = 32768, CW_KN = 49152, MOE_CS = 32, MOE_LS = 4096;
constexpr int TBL_OFF = 131072 + 1024;
constexpr int NIN = 3072;

extern __shared__ __attribute__((aligned(16))) unsigned char lds_raw[];
__device__ __forceinline__ float bf2f(bf16 v) { return __uint_as_float(((unsigned)v) << 16); }
__device__ __forceinline__ unsigned f2bf(float f) { unsigned u = __float_as_uint(f); return (u + 0x7fffu + ((u >> 16) & 1u)) >> 16; }
__device__ __forceinline__ unsigned pk2(float lo, float hi) { return f2bf(lo) | (f2bf(hi) << 16); }
__device__ __forceinline__ float wave_sum(float v) {
#pragma unroll
    for (int o = 1; o < 64; o <<= 1) v += __shfl_xor(v, o);
    return v;
}
__device__ __forceinline__ float wave_max(float v) {
#pragma unroll
    for (int o = 1; o < 64; o <<= 1) v = fmaxf(v, __shfl_xor(v, o));
    return v;
}
__device__ __forceinline__ float shflx_f(float v, int o, int lane) { return __uint_as_float((unsigned)__builtin_amdgcn_ds_bpermute((lane ^ o) << 2, (int)__float_as_uint(v))); }
__device__ __forceinline__ unsigned shflx_u(unsigned v, int o, int lane) { return (unsigned)__builtin_amdgcn_ds_bpermute((lane ^ o) << 2, (int)v); }
__device__ __forceinline__ float wave_sum_l(float v, int lane) {
#pragma unroll
    for (int o = 1; o < 64; o <<= 1) v += shflx_f(v, o, lane);
    return v;
}
__device__ __forceinline__ int launder_s(int v) { asm volatile("" : "+s"(v)); return v; }
__device__ __forceinline__ float sigmoidf_(float x) { return 1.f / (1.f + __expf(-x)); }
__device__ __forceinline__ float log_sigmoidf_(float x) { return x >= 0.f ? -log1pf(__expf(-x)) : x - log1pf(__expf(x)); }
__device__ __forceinline__ float gelu_tanh(float x) { const float u = 0.7978845608028654f * (x + 0.044715f * x * x * x); return 0.5f * x * (1.f + tanhf(u)); }
__device__ __forceinline__ float alibi_slope(int idx1, int n) { return exp2f(-8.0f * (float)idx1 / (float)n); }

__device__ __forceinline__ constexpr int b64_off(int t, int d) { return ((t >> 4) * 2 + (d >> 5)) * 512 + (t & 15) * 32 + (d & 31); }
#define XB_TMO      128
#define XB_XCNT(j)  (256  + 64 * (j))
#define XB_XSUB(j)  (1280 + 64 * (j))
#define XB_XGEN(j)  (2304 + 64 * (j))
#define XB_TOP      3328
#define XB_TOPGEN   3392
#define XCD_BAR_WORDS 3456
#define XB_SPIN_CAP (1u << 25)
__device__ __forceinline__ unsigned xb_ld(unsigned* p)              { return __hip_atomic_load(p, __ATOMIC_RELAXED, __HIP_MEMORY_SCOPE_AGENT); }
__device__ __forceinline__ unsigned xb_add(unsigned* p, unsigned v) { return __hip_atomic_fetch_add(p, v, __ATOMIC_RELAXED, __HIP_MEMORY_SCOPE_AGENT); }
__device__ __forceinline__ unsigned xb_xcc_id() { return (unsigned)__builtin_amdgcn_s_getreg((3 << 11) | 20) & 0xFu; }
#define XB_SPIN(cond, bar) do { unsigned _sp = 0; while (cond) { __builtin_amdgcn_s_sleep(1); \
    if ((++_sp & 255u) == 0u) { if (xb_ld(&(bar)[XB_TMO])) break; if (_sp > XB_SPIN_CAP) { atomicAdd(&(bar)[XB_TMO], 1u); break; } } } } while (0)
struct XcdBarrier { unsigned* bar; unsigned x; volatile LAS unsigned* st; };
__device__ __forceinline__ XcdBarrier xcd_barrier_post(unsigned* bar, volatile LAS unsigned* st) {
    XcdBarrier b; b.bar = bar; b.x = xb_xcc_id(); b.st = st;
    if (threadIdx.x == 0) (void)xb_add(&bar[XB_XCNT(b.x)], 1u);
    return b;
}
__device__ __forceinline__ void xcd_barrier_complete(unsigned* bar, unsigned x, unsigned& nloc, unsigned& nx) {
    const unsigned G = gridDim.x * gridDim.y * gridDim.z;
    unsigned sum, cnt, mine, sp = 0u;
    for (;;) {
        sum = 0u; cnt = 0u; mine = 0u;
#pragma unroll
        for (unsigned j = 0; j < 16; ++j) { const unsigned c = xb_ld(&bar[XB_XCNT(j)]); sum += c; cnt += (c > 0u) ? 1u : 0u; mine = (j == x) ? c : mine; }
        if (sum == G) break;
        __builtin_amdgcn_s_sleep(1);
        if ((++sp & 255u) == 0u) { if (xb_ld(&bar[XB_TMO])) break; if (sp > XB_SPIN_CAP) { atomicAdd(&bar[XB_TMO], 1u); break; } }
    }
    nloc = mine > 0u ? mine : 1u; nx = cnt > 0u ? cnt : 1u;
}
__device__ __forceinline__ void xcd_barrier(const XcdBarrier& b) {
    asm volatile("s_waitcnt vmcnt(0)" ::: "memory");
    __syncthreads();
    if (threadIdx.x == 0) {
        unsigned* bar = b.bar;
        __builtin_amdgcn_s_waitcnt(0);
        unsigned nloc = b.st[0], nx = b.st[1];
        if (nloc == 0u) { xcd_barrier_complete(bar, b.x, nloc, nx); b.st[0] = nloc; b.st[1] = nx; }
        const unsigned old = xb_add(&bar[XB_XSUB(b.x)], 1u);
        const unsigned gen = old / nloc;
        if (old + 1u == (gen + 1u) * nloc) {
            __builtin_amdgcn_fence(__ATOMIC_RELEASE, "agent");
            asm volatile("s_waitcnt vmcnt(0)" ::: "memory");
            const unsigned og = xb_add(&bar[XB_TOP], 1u);
            const unsigned tg = og / nx;
            if (og + 1u == (tg + 1u) * nx) xb_add(&bar[XB_TOPGEN], 1u);
            else XB_SPIN(xb_ld(&bar[XB_TOPGEN]) == tg, bar);
            __builtin_amdgcn_fence(__ATOMIC_ACQUIRE, "agent");
            xb_add(&bar[XB_XGEN(b.x)], 1u);
            asm volatile("s_waitcnt vmcnt(0)" ::: "memory");
        } else {
            XB_SPIN(xb_ld(&bar[XB_XGEN(b.x)]) == gen, bar);
            __builtin_amdgcn_fence(__ATOMIC_ACQUIRE, "agent");
            asm volatile("s_waitcnt vmcnt(0)" ::: "memory");
        }
    }
    __syncthreads();
}

struct Params { const float* in[23]; float* out; unsigned char* ws; int ph_lo, ph_hi; };
constexpr int LDS_BYTES = 147456;
constexpr int MISC_OFF = 131072 + 320;

struct Ctx {
    LAS unsigned char* lds; int tid, lane, wave, bid, G, gw, ngw;
    const float* const* in; float* xcur; unsigned char* ws;
};

namespace pg8 {
#define PG8_LAS __attribute__((address_space(3)))
typedef unsigned short bf16_t;
typedef short bf16x8 __attribute__((ext_vector_type(8)));
typedef float f32x4 __attribute__((ext_vector_type(4)));
typedef unsigned u32x4 __attribute__((ext_vector_type(4)));
constexpr int BM = 256, BK = 64, HALF = 128, HTB = HALF * BK * 2  , STAGE_BYTES = 8 * HTB, NXCD = 8, WGM = 8;

__host__ __device__ __forceinline__ int lds_byte(int r, int c) { const int st = (r >> 4) * 2 + (c >> 5), rr = r & 15, cc = c & 31, ob = rr * 64 + cc * 2; return st * 1024 + (ob ^ (((ob >> 9) & 1) << 5)); }
__host__ __device__ __forceinline__ void stage_rc(int b, int& R, int& C) { const int st = b / 1024, sb = b % 1024, swz = sb ^ (((sb >> 9) & 1) << 5); R = (st >> 1) * 16 + swz / 64; C = (st & 1) * 32 + (swz % 64) / 2; }
__host__ __device__ __forceinline__ int perm32(int rho) { const int n = rho >> 4, i = rho & 15; return 8 * (i >> 2) + 4 * n + (i & 3); }

struct Unit { int pm, pn; const char* a; const char* b; const char* b2; };
struct Gemm { int lda, ldb, K, ksplit, arb, acb; };

__device__ __forceinline__ unsigned cvt_pk_bf16(float lo, float hi) { unsigned r; asm volatile("v_cvt_pk_bf16_f32 %0, %1, %2" : "=v"(r) : "v"(lo), "v"(hi)); return r; }
typedef float f32x2 __attribute__((ext_vector_type(2)));

template <class Epi, class Sched, bool ALIGN_EPI = false, bool SP2 = false>
__device__ __forceinline__ void gemm_phase(PG8_LAS unsigned char* lds, const Gemm g, const Sched& S, const Epi& E) {
    int tid_ = threadIdx.x; asm volatile("" : "+v"(tid_));
    const int tid = tid_, wid = __builtin_amdgcn_readfirstlane(tid >> 6), lane = tid & 63, wr = wid >> 2, wc = wid & 3, fr = lane & 15, fq = lane >> 4;
    const int K = g.K, nt = K / BK, ks = g.ksplit;
    unsigned voffA[2], voffB[2];
#pragma unroll
    for (int i = 0; i < 2; ++i) { int R, C; stage_rc(tid * 16 + i * 8192, R, C); const int Rb = Epi::PERM ? ((R & ~31) + perm32(R & 31)) : R;
        voffA[i] = g.arb ? (unsigned)(((R / g.arb) * (K / g.acb) + C / g.acb) * (g.arb * g.acb) + (R % g.arb) * g.acb + (C % g.acb)) * 2u : (unsigned)(R * g.lda + C) * 2u; voffB[i] = (unsigned)(Rb * g.ldb + C) * 2u; }
    const size_t kstep = (size_t)(BK * 2), kstepA = g.arb ? (size_t)(BK * g.arb * 2) : kstep;
    const size_t hsA = (size_t)HALF * (g.arb ? K : g.lda) * 2, hsB = (size_t)HALF * g.ldb * 2;
    const unsigned ldsw = (unsigned)wid * 1024u;
    const int aoff = lds_byte(wr * 64 + fr, fq * 8), boff = lds_byte(wc * 32 + fr, fq * 8);
#define PG8_SA(b, h) (((b) * 2 + (h)) * HTB)
#define PG8_SB(b, h) ((4 + (b) * 2 + (h)) * HTB)
#define PG8_STAGE(bufoff, gbase, voff) do { _Pragma("unroll") for (int _i = 0; _i < 2; ++_i) \
        __builtin_amdgcn_global_load_lds((const unsigned*)((const char*)(gbase) + (voff)[_i]), (PG8_LAS unsigned*)(lds + (bufoff) + ldsw + _i * 8192), 16, 0, 0); } while (0)
#define PG8_LDA(dst, b, h) do { _Pragma("unroll") for (int m = 0; m < 4; ++m) _Pragma("unroll") for (int k = 0; k < 2; ++k) dst[m][k] = *(const PG8_LAS bf16x8*)(lds + PG8_SA(b, h) + aoff + m * 2048 + k * 1024); } while (0)
#define PG8_LDB(dst, b, h) do { _Pragma("unroll") for (int n = 0; n < 2; ++n) _Pragma("unroll") for (int k = 0; k < 2; ++k) dst[n][k] = *(const PG8_LAS bf16x8*)(lds + PG8_SB(b, h) + boff + n * 2048 + k * 1024); } while (0)
#define PG8_MMA(ai, bj, At, Bt) do { __builtin_amdgcn_s_setprio(1); _Pragma("unroll") for (int m = 0; m < 4; ++m) _Pragma("unroll") for (int n = 0; n < 2; ++n) _Pragma("unroll") for (int k = 0; k < 2; ++k) \
        acc[ai][bj][m][n] = __builtin_amdgcn_mfma_f32_16x16x32_bf16(Bt[n][k], At[m][k], acc[ai][bj][m][n], 0, 0, 0); __builtin_amdgcn_s_setprio(0); } while (0)
#define PG8_WAIT_V(n) asm volatile("s_waitcnt vmcnt(" #n ")" ::: "memory")
#define PG8_WAIT_L(n) asm volatile("s_waitcnt lgkmcnt(" #n ")" ::: "memory")
#define PG8_BAR __builtin_amdgcn_s_barrier()
#define PG8_SCHED __builtin_amdgcn_sched_barrier(0)
    Unit cur, nxt; int ui = 0;
    if (!S.next(0, cur)) return;
    f32x4 acc[2][2][4][2];
#pragma unroll
    for (int a = 0; a < 2; ++a)
#pragma unroll
        for (int b = 0; b < 2; ++b)
#pragma unroll
            for (int m = 0; m < 4; ++m)
#pragma unroll
                for (int n = 0; n < 2; ++n) acc[a][b][m][n] = (f32x4){0.f, 0.f, 0.f, 0.f};
    bf16x8 At[4][2], B0[2][2], B1[2][2];
    const char* cA = cur.a; const char* cB = cur.b; const char* cB2 = cur.b2;
#define PG8_BK(base, base2, kt) ((kt) < ks ? (base) + (size_t)(kt) * kstep : (base2) + (size_t)((kt) - ks) * kstep)
    S.a_ready(cur);
    if constexpr (SP2) {
        PG8_STAGE(PG8_SB(0, 0), cB, voffB); PG8_STAGE(PG8_SB(0, 1), cB + hsB, voffB); PG8_STAGE(PG8_SA(0, 0), cA, voffA); PG8_STAGE(PG8_SA(0, 1), cA + hsA, voffA);
        if (wr == 1) PG8_BAR;
        PG8_WAIT_V(2); PG8_BAR;
        PG8_STAGE(PG8_SB(1, 0), PG8_BK(cB, cB2, 1), voffB); PG8_STAGE(PG8_SA(1, 0), cA + kstepA, voffA); PG8_STAGE(PG8_SB(1, 1), PG8_BK(cB, cB2, 1) + hsB, voffB);
        PG8_WAIT_V(6); PG8_BAR;
    } else {
        PG8_STAGE(PG8_SB(0, 0), cB, voffB); PG8_STAGE(PG8_SA(0, 0), cA, voffA); PG8_STAGE(PG8_SB(0, 1), cB + hsB, voffB); PG8_STAGE(PG8_SA(0, 1), cA + hsA, voffA);
        if (wr == 1) PG8_BAR;
        PG8_WAIT_V(4); PG8_BAR;
        PG8_STAGE(PG8_SB(1, 0), PG8_BK(cB, cB2, 1), voffB); PG8_STAGE(PG8_SA(1, 0), cA + kstepA, voffA); PG8_STAGE(PG8_SB(1, 1), PG8_BK(cB, cB2, 1) + hsB, voffB);
        PG8_WAIT_V(6); PG8_BAR;
    }
    for (;;) {
        const bool has_next = S.next(ui + 1, nxt);
        const char* nA = has_next ? nxt.a : cA; const char* nB = has_next ? nxt.b : cB; const char* nB2 = has_next ? nxt.b2 : cB2;
#pragma unroll 1
        for (int t = 0; t < nt; t += 2) {
            const bool last = (t == nt - 2);
            const char* a1 = cA + (size_t)(t + 1) * kstepA;
            const char* a2 = last ? nA : cA + (size_t)(t + 2) * kstepA; const char* b2 = last ? PG8_BK(nB, nB2, 0) : PG8_BK(cB, cB2, t + 2);
            const char* a3 = a2 + kstepA; const char* b3 = last ? PG8_BK(nB, nB2, 1) : PG8_BK(cB, cB2, t + 3);
            if (last && has_next) S.a_ready(nxt);
            if constexpr (SP2) {
            PG8_LDB(B0, 0, 0); PG8_LDB(B1, 0, 1); PG8_SCHED; PG8_LDA(At, 0, 0); PG8_STAGE(PG8_SA(1, 1), a1 + hsA, voffA);
            PG8_WAIT_V(8); PG8_WAIT_L(0); PG8_BAR; PG8_MMA(0, 0, At, B0); PG8_MMA(0, 1, At, B1); PG8_BAR; PG8_SCHED;
            PG8_LDA(At, 0, 1); PG8_STAGE(PG8_SB(0, 0), b2, voffB); PG8_STAGE(PG8_SB(0, 1), b2 + hsB, voffB); PG8_STAGE(PG8_SA(0, 0), a2, voffA);
            PG8_WAIT_V(8); PG8_WAIT_L(0); PG8_BAR; PG8_MMA(1, 0, At, B0); PG8_MMA(1, 1, At, B1); PG8_BAR; PG8_SCHED;
            PG8_LDB(B0, 1, 0); PG8_LDB(B1, 1, 1); PG8_SCHED; PG8_LDA(At, 1, 0); PG8_STAGE(PG8_SA(0, 1), a2 + hsA, voffA);
            PG8_WAIT_V(8); PG8_WAIT_L(0); PG8_BAR; PG8_MMA(0, 0, At, B0); PG8_MMA(0, 1, At, B1); PG8_BAR; PG8_SCHED;
            PG8_LDA(At, 1, 1); PG8_STAGE(PG8_SB(1, 0), b3, voffB); PG8_STAGE(PG8_SB(1, 1), b3 + hsB, voffB); PG8_STAGE(PG8_SA(1, 0), a3, voffA);
            PG8_WAIT_V(8); PG8_WAIT_L(0); PG8_BAR; PG8_MMA(1, 0, At, B0); PG8_MMA(1, 1, At, B1); PG8_BAR; PG8_SCHED;
            } else {
            PG8_LDB(B0, 0, 0); PG8_SCHED; PG8_LDA(At, 0, 0); PG8_STAGE(PG8_SA(1, 1), a1 + hsA, voffA);
            PG8_WAIT_L(8); PG8_BAR; PG8_WAIT_L(0); PG8_MMA(0, 0, At, B0); PG8_BAR; PG8_SCHED;
            PG8_LDB(B1, 0, 1); PG8_STAGE(PG8_SB(0, 0), b2, voffB);
            PG8_BAR; PG8_WAIT_L(0); PG8_MMA(0, 1, At, B1); PG8_BAR;
            PG8_LDA(At, 0, 1); PG8_STAGE(PG8_SA(0, 0), a2, voffA);
            PG8_BAR; PG8_WAIT_L(0); PG8_MMA(1, 0, At, B0); PG8_BAR; PG8_SCHED;
            PG8_STAGE(PG8_SB(0, 1), b2 + hsB, voffB);
            PG8_WAIT_V(6); PG8_BAR; PG8_MMA(1, 1, At, B1); PG8_BAR;
            PG8_LDB(B0, 1, 0); PG8_SCHED; PG8_LDA(At, 1, 0); PG8_STAGE(PG8_SA(0, 1), a2 + hsA, voffA);
            PG8_WAIT_L(8); PG8_BAR; PG8_WAIT_L(0); PG8_MMA(0, 0, At, B0); PG8_BAR; PG8_SCHED;
            PG8_LDB(B1, 1, 1); PG8_STAGE(PG8_SB(1, 0), b3, voffB);
            PG8_BAR; PG8_WAIT_L(0); PG8_MMA(0, 1, At, B1); PG8_BAR;
            PG8_LDA(At, 1, 1); PG8_STAGE(PG8_SA(1, 0), a3, voffA);
            PG8_BAR; PG8_WAIT_L(0); PG8_MMA(1, 0, At, B0); PG8_BAR; PG8_SCHED;
            PG8_STAGE(PG8_SB(1, 1), b3 + hsB, voffB);
            PG8_WAIT_V(6); PG8_BAR; PG8_MMA(1, 1, At, B1); PG8_BAR;
            }
        }
        if constexpr (ALIGN_EPI) { if (wr == 0) PG8_BAR; }
        if constexpr (!Epi::AFTER_DRAIN) { E(acc, cur, wr, wc, fr, fq); S.done(cur); }
        if (!has_next) break;
#pragma unroll
        for (int a = 0; a < 2; ++a)
#pragma unroll
            for (int b = 0; b < 2; ++b)
#pragma unroll
                for (int m = 0; m < 4; ++m)
#pragma unroll
                    for (int n = 0; n < 2; ++n) acc[a][b][m][n] = (f32x4){0.f, 0.f, 0.f, 0.f};
        cur = nxt; cA = nA; cB = nB; cB2 = nB2; ++ui;
        if constexpr (ALIGN_EPI) { if (wr == 1) PG8_BAR; }
    }
    PG8_WAIT_V(0);
    if constexpr (!ALIGN_EPI) { if (wr == 0) PG8_BAR; }
    PG8_BAR;
    if constexpr (Epi::AFTER_DRAIN) { E.fused(acc, cur, wr, wc, fr, fq, lds, wid, lane); S.done(cur); }
#undef PG8_BK
#undef PG8_SA
#undef PG8_SB
#undef PG8_STAGE
#undef PG8_LDA
#undef PG8_LDB
#undef PG8_MMA
#undef PG8_WAIT_V
#undef PG8_WAIT_L
#undef PG8_BAR
#undef PG8_SCHED
}
}

struct PlainOrder {
    const char* A; const char* Bt; int lda, ldb, nM, nN, nwg, G, c;
    __device__ __forceinline__ void init(const void* A_, const void* Bt_, int lda_, int ldb_, int M, int N, int G_, int c_) { A = (const char*)A_; Bt = (const char*)Bt_; lda = lda_; ldb = ldb_; nM = M / 256; nN = N / 256; nwg = nM * nN; G = G_; c = c_; }
    __device__ __forceinline__ bool next(int i, pg8::Unit& u) const {
        const long L = (long)i * G + c; if (L >= nwg) return false;
        int wgid = (int)L; { const int q = nwg / 8, r = nwg % 8, xcd = wgid % 8, off = wgid / 8; wgid = (xcd < r ? xcd * (q + 1) : r * (q + 1) + (xcd - r) * q) + off; }
        const int nig = 8 * nN, gid = wgid / nig, fm = gid * 8, gsz = (nM - fm) < 8 ? (nM - fm) : 8;
        u.pm = fm + ((wgid % nig) % gsz); u.pn = (wgid % nig) / gsz;
        u.a = A + (size_t)u.pm * 256 * lda * 2; u.b = Bt + (size_t)u.pn * 256 * ldb * 2; u.b2 = u.b; return true;
    }
    __device__ __forceinline__ void a_ready(const pg8::Unit&) const {}
    __device__ __forceinline__ void done(const pg8::Unit&) const {}
};
struct EpiInProj {
    static constexpr bool PERM = true, AFTER_DRAIN = false;
    unsigned char* ws; const float* b_gate; const float* b_fgt; unsigned* kn;
    __device__ __forceinline__ void operator()(const pg8::f32x4 (&acc)[2][2][4][2], const pg8::Unit& u, int wr, int wc, int fr, int fq) const {
        { int t_ = threadIdx.x; asm volatile("" : "+v"(t_)); fr = t_ & 15; fq = (t_ >> 4) & 3; }
        const int pn = u.pn, b = (u.pm * 256) / T_, t0 = u.pm * 256 - b * T_ + wr * 64 + fr;
        if (pn == 11) {
            if (wc == 0 && fq < 4) {
                float* gate = (float*)(ws + WS_GATE); float* fl = (float*)(ws + WS_FL);
#pragma unroll
                for (int ai = 0; ai < 2; ++ai)
#pragma unroll
                    for (int m = 0; m < 4; ++m) { const int t = t0 + ai * 128 + m * 16; const size_t n = (size_t)b * T_ + t;
#pragma unroll
                        for (int nn = 0; nn < 2; ++nn)
#pragma unroll
                            for (int e = 0; e < 4; ++e) { const int c = 8 * fq + 4 * nn + e; const float v = acc[ai][0][m][nn][e];
                                if (c < 24) gate[n * 24 + c] = __builtin_amdgcn_rcpf(1.f + __builtin_amdgcn_exp2f(-(v + b_gate[c]) * LOG2E));
                                else if (c < 28) { const float z = v + b_fgt[c - 24];
                                    fl[(size_t)(b * 4 + (c - 24)) * T_ + t] = z < -30.f ? z : -0.6931471805599453f * __builtin_amdgcn_logf(1.f + __builtin_amdgcn_exp2f(-z * LOG2E)); } } }
            }
            return;
        }
        if (pn == 6 || pn == 9) {
            const int lane_ = (fq << 4) | fr;
#pragma unroll
            for (int bj = 0; bj < 2; ++bj)
#pragma unroll
                for (int ai = 0; ai < 2; ++ai) { float mx = 0.f;
#pragma unroll
                    for (int m = 0; m < 4; ++m) { const pg8::f32x4 v0 = acc[ai][bj][m][0], v1 = acc[ai][bj][m][1];
                        float ss = (v0[0] * v0[0] + v0[1] * v0[1]) + (v0[2] * v0[2] + v0[3] * v0[3]) + (v1[0] * v1[0] + v1[1] * v1[1]) + (v1[2] * v1[2] + v1[3] * v1[3]);
                        ss += shflx_f(ss, 16, lane_); ss += shflx_f(ss, 32, lane_); mx = fmaxf(mx, ss); }
#pragma unroll
                    for (int o = 1; o < 16; o <<= 1) mx = fmaxf(mx, shflx_f(mx, o, lane_));
                    if (lane_ == 0) { const int cg = bj * 4 + wc, tile = (u.pm * 256 - b * T_ + ai * 128 + wr * 64) >> 6;
                        unsigned* dst = pn == 6 ? kn + ((b * 4 + (cg >> 1)) * 64 + tile) * 2 + (cg & 1) : kn + 4096 + (b * 8 + cg) * 64 + tile;
                        atomicMax(dst, __float_as_uint(mx)); } }
        }
#pragma unroll
        for (int bj = 0; bj < 2; ++bj) {
            const int c = bj * 128 + wc * 32 + 8 * fq;
            bf16* base; int W = 64; float sc = 1.f;
            if (pn < 2) { base = (bf16*)(ws + WS_QN) + (size_t)(b * 8 + pn * 4 + (c >> 6)) * T_ * 64 + (c & 63); sc = 0.125f * LOG2E; }
            else if (pn < 5) { base = (bf16*)(ws + WS_KV6 + (size_t)((pn - 2) * 2 + (c >> 7)) * KV6_STRIDE) + (size_t)(b * 2 + ((c >> 6) & 1)) * T_ * 64 + (c & 63); }
            else if (pn < 8) { base = (bf16*)(ws + WS_FQKV) + (size_t)(pn - 5) * (8 * MiB) + (size_t)(b * 4 + (c >> 6)) * T_ * 64 + (c & 63); if (pn == 5) sc = 0.125f * LOG2E; }
            else if (pn < 10) { base = (bf16*)(ws + WS_DQK) + (size_t)(pn - 8) * (8 * MiB) + (size_t)(b * 8 + (c >> 5)) * T_ * 32 + (c & 31); W = 32; if (pn == 8) sc = 0.17677669529663687f * LOG2E; }
            else { base = (bf16*)(ws + WS_DV) + (size_t)(b * 4 + (c >> 6)) * T_ * 64 + (c & 63); }
            const bool blk = W == 64 && pn != 2;
            if (blk) base += -(c & 63) + ((c >> 5) & 1) * 512 + (c & 31);
#pragma unroll
            for (int ai = 0; ai < 2; ++ai)
#pragma unroll
                for (int m = 0; m < 4; ++m) { const int t = t0 + ai * 128 + m * 16;
                    const pg8::f32x4 v0 = acc[ai][bj][m][0] * sc, v1 = acc[ai][bj][m][1] * sc;
                    pg8::u32x4 w; w.x = pg8::cvt_pk_bf16(v0[0], v0[1]); w.y = pg8::cvt_pk_bf16(v0[2], v0[3]); w.z = pg8::cvt_pk_bf16(v1[0], v1[1]); w.w = pg8::cvt_pk_bf16(v1[2], v1[3]);
                    *(pg8::u32x4*)(base + (blk ? (size_t)((t >> 4) * 1024 + (t & 15) * 32) : (size_t)t * W)) = w; }
        }
    }
};
struct EpiResBf16 {
    static constexpr bool PERM = false, AFTER_DRAIN = false;
    bf16* xr;
    __device__ __forceinline__ void operator()(const pg8::f32x4 (&acc)[2][2][4][2], const pg8::Unit& u, int wr, int wc, int fr, int fq) const {
        { int t_ = threadIdx.x; asm volatile("" : "+v"(t_)); fr = t_ & 15; fq = (t_ >> 4) & 3; }
#pragma unroll
        for (int ai = 0; ai < 2; ++ai)
#pragma unroll
            for (int m = 0; m < 4; ++m) { const size_t off = (size_t)(u.pm * 256 + ai * 128 + wr * 64 + m * 16 + fr) * D_ + u.pn * 256 + wc * 32 + 4 * fq;
#pragma unroll
                for (int bj = 0; bj < 2; ++bj)
#pragma unroll
                    for (int n = 0; n < 2; ++n) { const u64 w = *(const u64*)(xr + off + bj * 128 + n * 16);
                        const pg8::f32x4 bs = {__uint_as_float((unsigned)w << 16), __uint_as_float((unsigned)w & 0xffff0000u), __uint_as_float((unsigned)(w >> 32) << 16), __uint_as_float((unsigned)(w >> 32) & 0xffff0000u)};
                        const pg8::f32x4 o = bs + acc[ai][bj][m][n];
                        *(u64*)(xr + off + bj * 128 + n * 16) = (u64)pg8::cvt_pk_bf16(o[0], o[1]) | ((u64)pg8::cvt_pk_bf16(o[2], o[3]) << 32); } }
    }
};


struct EpiDummy {
    static constexpr bool PERM = true, AFTER_DRAIN = false;
    float* dst;
    __device__ __forceinline__ void operator()(const pg8::f32x4 (&acc)[2][2][4][2], const pg8::Unit& u, int wr, int wc, int fr, int fq) const {
        pg8::f32x4 a = {0.f, 0.f, 0.f, 0.f};
#pragma unroll
        for (int ai = 0; ai < 2; ++ai)
#pragma unroll
            for (int bj = 0; bj < 2; ++bj)
#pragma unroll
                for (int m = 0; m < 4; ++m) { a = a + acc[ai][bj][m][0]; a = a + acc[ai][bj][m][1]; }
        *(pg8::f32x4*)(dst + ((size_t)(u.pm * 12 + u.pn) * 512 + threadIdx.x) * 4) = a;
    }
};
struct OneUnitOrder { pg8::Unit u; bool has;
    __device__ __forceinline__ bool next(int i, pg8::Unit& o) const { if (i != 0 || !has) return false; o = u; return true; }
    __device__ __forceinline__ void a_ready(const pg8::Unit&) const {}
    __device__ __forceinline__ void done(const pg8::Unit&) const {} };
__device__ __forceinline__ float gelu_tanh_fast(float x) { const float u2 = 1.5957691216057308f * (x + 0.044715f * x * x * x); return x * __builtin_amdgcn_rcpf(1.f + __builtin_amdgcn_exp2f(-u2 * LOG2E)); }
struct EpiCmpH {
    static constexpr bool PERM = true, AFTER_DRAIN = false;
    bf16* hc; const float* bias1;
    __device__ __forceinline__ void operator()(const pg8::f32x4 (&acc)[2][2][4][2], const pg8::Unit& u, int wr, int wc, int fr, int fq) const {
        { int t_ = threadIdx.x; asm volatile("" : "+v"(t_)); fr = t_ & 15; fq = (t_ >> 4) & 3; }
        const int kv = u.pn;
#pragma unroll
        for (int bj = 0; bj < 2; ++bj) { const int col = bj * 128 + wc * 32 + 8 * fq;
            const pg8::f32x4 b0 = *(const pg8::f32x4*)(bias1 + kv * 256 + col), b1 = *(const pg8::f32x4*)(bias1 + kv * 256 + col + 4);
#pragma unroll
            for (int ai = 0; ai < 2; ++ai)
#pragma unroll
                for (int m = 0; m < 4; ++m) { const int row = u.pm * 256 + ai * 128 + wr * 64 + m * 16 + fr;
                    const pg8::f32x4 v0 = acc[ai][bj][m][0] + b0, v1 = acc[ai][bj][m][1] + b1;
                    pg8::u32x4 w; w.x = pg8::cvt_pk_bf16(gelu_tanh_fast(v0[0]), gelu_tanh_fast(v0[1])); w.y = pg8::cvt_pk_bf16(gelu_tanh_fast(v0[2]), gelu_tanh_fast(v0[3]));
                    w.z = pg8::cvt_pk_bf16(gelu_tanh_fast(v1[0]), gelu_tanh_fast(v1[1])); w.w = pg8::cvt_pk_bf16(gelu_tanh_fast(v1[2]), gelu_tanh_fast(v1[3]));
                    *(pg8::u32x4*)(hc + ((size_t)kv * 4096 + row) * 256 + col) = w; } }
    }
};
struct EpiCmpOut {
    static constexpr bool PERM = true, AFTER_DRAIN = false;
    bf16* kvcmp;
    __device__ __forceinline__ void operator()(const pg8::f32x4 (&acc)[2][2][4][2], const pg8::Unit& u, int wr, int wc, int fr, int fq) const {
        { int t_ = threadIdx.x; asm volatile("" : "+v"(t_)); fr = t_ & 15; fq = (t_ >> 4) & 3; }
        if (wc >= 2) return;
        const int kv = u.pn, col = wc * 32 + 8 * fq;
#pragma unroll
        for (int ai = 0; ai < 2; ++ai)
#pragma unroll
            for (int m = 0; m < 4; ++m) { const int row = u.pm * 256 + ai * 128 + wr * 64 + m * 16 + fr; const float z = ((row & 255) == 255) ? 0.f : 1.f;
                const pg8::f32x4 v0 = acc[ai][0][m][0], v1 = acc[ai][0][m][1];
                pg8::u32x4 w; w.x = pg8::cvt_pk_bf16(z != 0.f ? v0[0] : 0.f, z != 0.f ? v0[1] : 0.f); w.y = pg8::cvt_pk_bf16(z != 0.f ? v0[2] : 0.f, z != 0.f ? v0[3] : 0.f);
                w.z = pg8::cvt_pk_bf16(z != 0.f ? v1[0] : 0.f, z != 0.f ? v1[1] : 0.f); w.w = pg8::cvt_pk_bf16(z != 0.f ? v1[2] : 0.f, z != 0.f ? v1[3] : 0.f);
                *(pg8::u32x4*)(kvcmp + ((size_t)kv * 4096 + row) * 64 + col) = w; }
    }
};

__device__ __forceinline__ void moe_build_tables(const unsigned* cnt, int tid) {
    LAS int* T = (LAS int*)((LAS unsigned char*)lds_raw + TBL_OFF);
    __syncthreads();
    if (tid < 112) T[128 + 256 + tid] = (int)((cnt[tid * MOE_CS] + 255u) >> 8);
    __syncthreads();
    if (tid == 0) { int o = 0; for (int c = 0; c < 112; ++c) { T[c] = o; const int n = T[128 + 256 + c]; for (int k = 0; k < n; ++k) T[128 + o + k] = c; o += n; } T[112] = o; }
    __syncthreads();
}
__device__ __forceinline__ void moe_pair(int cls, int& ea, int& eb) { const int grp = cls / 28; int idx = cls % 28, lo = 0; while (idx >= 7 - lo) { idx -= 7 - lo; ++lo; } ea = grp * 8 + lo; eb = grp * 8 + lo + 1 + idx; }
struct MoeOrder1 {
    const char* xs; const char* wgu; int G, c;
    __device__ __forceinline__ bool next(int i, pg8::Unit& u) const {
        const LAS int* T = (const LAS int*)((LAS unsigned char*)lds_raw + TBL_OFF);
        const int idx = i * G + c; if (idx >= 4 * T[112]) return false;
        const int tile = idx >> 2, pn = idx & 3; int ea, eb; moe_pair(T[128 + tile], ea, eb); const int e = (pn >> 1) ? eb : ea;
        u.pm = tile; u.pn = pn; u.a = xs + (size_t)tile * 256 * 2048; u.b = wgu + ((size_t)e * 512 + (pn & 1) * 256) * 2048; u.b2 = u.b; return true; }
    __device__ __forceinline__ void a_ready(const pg8::Unit&) const {}
    __device__ __forceinline__ void done(const pg8::Unit&) const {} };
struct MoeOrder2 {
    const char* hb; const char* wd; int G, c;
    __device__ __forceinline__ bool next(int i, pg8::Unit& u) const {
        const LAS int* T = (const LAS int*)((LAS unsigned char*)lds_raw + TBL_OFF);
        const int idx = i * G + c; if (idx >= 4 * T[112]) return false;
        const int tile = idx >> 2, pn = idx & 3; int ea, eb; moe_pair(T[128 + tile], ea, eb);
        u.pm = tile; u.pn = pn; u.a = hb + (size_t)tile * 256 * 1024; u.b = wd + ((size_t)ea * 1024 + pn * 256) * 512; u.b2 = wd + ((size_t)eb * 1024 + pn * 256) * 512; return true; }
    __device__ __forceinline__ void a_ready(const pg8::Unit&) const {}
    __device__ __forceinline__ void done(const pg8::Unit&) const {} };
struct EpiMoeH {
    static constexpr bool PERM = true, AFTER_DRAIN = false;
    bf16* hb; const float* roww;
    __device__ __forceinline__ void operator()(const pg8::f32x4 (&acc)[2][2][4][2], const pg8::Unit& u, int wr, int wc, int fr, int fq) const {
        { int t_ = threadIdx.x; asm volatile("" : "+v"(t_)); fr = t_ & 15; fq = (t_ >> 4) & 3; }
        const int slot = u.pn >> 1;
#pragma unroll
        for (int ai = 0; ai < 2; ++ai)
#pragma unroll
            for (int m = 0; m < 4; ++m) { const size_t row = (size_t)u.pm * 256 + ai * 128 + wr * 64 + m * 16 + fr; const float w = roww[row * 2 + slot];
#pragma unroll
                for (int bj = 0; bj < 2; ++bj) { const int j0 = (u.pn & 1) * 128 + (bj * 128 + wc * 32 + 8 * fq) / 2;
                    const pg8::f32x4 v0 = acc[ai][bj][m][0], v1 = acc[ai][bj][m][1];
                    const float h0 = v0[0] * __builtin_amdgcn_rcpf(1.f + __builtin_amdgcn_exp2f(-v0[0] * LOG2E)) * v0[1] * w, h1 = v0[2] * __builtin_amdgcn_rcpf(1.f + __builtin_amdgcn_exp2f(-v0[2] * LOG2E)) * v0[3] * w;
                    const float h2 = v1[0] * __builtin_amdgcn_rcpf(1.f + __builtin_amdgcn_exp2f(-v1[0] * LOG2E)) * v1[1] * w, h3 = v1[2] * __builtin_amdgcn_rcpf(1.f + __builtin_amdgcn_exp2f(-v1[2] * LOG2E)) * v1[3] * w;
                    const int jg = slot * 256 + j0;
                    *(u64*)(hb + ((row >> 4) * 32 + (jg >> 4)) * 256 + (row & 15) * 16 + (jg & 15)) = (u64)pg8::cvt_pk_bf16(h0, h1) | ((u64)pg8::cvt_pk_bf16(h2, h3) << 32); } }
    }
};
struct EpiMoeOut {
    static constexpr bool PERM = false, AFTER_DRAIN = false;
    bf16* x; const int* rowtok;
    __device__ __forceinline__ void operator()(const pg8::f32x4 (&acc)[2][2][4][2], const pg8::Unit& u, int wr, int wc, int fr, int fq) const {
        { int t_ = threadIdx.x; asm volatile("" : "+v"(t_)); fr = t_ & 15; fq = (t_ >> 4) & 3; }
        bf16* xx = x; const int* rt = rowtok; asm volatile("" : "+s"(xx), "+s"(rt));
#pragma unroll
        for (int ai = 0; ai < 2; ++ai)
#pragma unroll
            for (int m = 0; m < 4; ++m) { const int tok = rt[(size_t)u.pm * 256 + ai * 128 + wr * 64 + m * 16 + fr];
                if (tok >= 0) { bf16* xr = xx + (size_t)tok * D_ + u.pn * 256 + wc * 32 + 4 * fq;
#pragma unroll
                    for (int bj = 0; bj < 2; ++bj)
#pragma unroll
                        for (int n = 0; n < 2; ++n) { u64* q = (u64*)(xr + bj * 128 + n * 16); const u64 w = *q; const pg8::f32x4 a = acc[ai][bj][m][n];
                            *q = (u64)pg8::cvt_pk_bf16(__uint_as_float((unsigned)w << 16) + a[0], __uint_as_float((unsigned)w & 0xffff0000u) + a[1]) | ((u64)pg8::cvt_pk_bf16(__uint_as_float((unsigned)(w >> 32) << 16) + a[2], __uint_as_float((unsigned)(w >> 32) & 0xffff0000u) + a[3]) << 32); } } }
    }
};

__device__ __forceinline__ void transpose_item(const float* W, int ldw, bf16* WT, int ldt, int r0, int rmul, int k0, LAS float* scr, int lane) {
    f32x4 v[8];
#pragma unroll
    for (int i = 0; i < 8; ++i) v[i] = *(const f32x4*)(W + (size_t)(k0 + i * 8 + (lane >> 3)) * ldw + (lane & 7) * 4);
#pragma unroll
    for (int i = 0; i < 8; ++i) { LAS float* d = scr + (i * 8 + (lane >> 3)) * 33 + (lane & 7) * 4; d[0] = v[i].x; d[1] = v[i].y; d[2] = v[i].z; d[3] = v[i].w; }
    asm volatile("s_waitcnt lgkmcnt(0)" ::: "memory");
    const int c = lane & 7;
#pragma unroll
    for (int j = 0; j < 4; ++j) { const int n = (lane >> 3) + 8 * j; const LAS float* sp = scr + (8 * c) * 33 + n;
        u32x4 o; o.x = pk2(sp[0 * 33], sp[1 * 33]); o.y = pk2(sp[2 * 33], sp[3 * 33]); o.z = pk2(sp[4 * 33], sp[5 * 33]); o.w = pk2(sp[6 * 33], sp[7 * 33]);
        *(u32x4*)(WT + (size_t)(r0 + rmul * n) * ldt + k0 + 8 * c) = o; }
    asm volatile("s_waitcnt lgkmcnt(0)" ::: "memory");
}
__device__ __forceinline__ void transpose_seg(const float* W, int ldw, int K, int sc0, int ncol, bf16* WT, int r0, int rmul, int item, LAS float* scr, int lane) {
    const int nb = ncol / 32, kb = item / nb, cb = item % nb;
    transpose_item(W + sc0 + cb * 32, ldw, WT, K, r0 + rmul * cb * 32, rmul, kb * 64, scr, lane);
}

typedef float f32x16 __attribute__((ext_vector_type(16)));
typedef short bf16x8v __attribute__((ext_vector_type(8)));
typedef short s16x4 __attribute__((ext_vector_type(4)));
typedef float f32x2_t __attribute__((ext_vector_type(2)));
typedef __bf16 bf16x2_t __attribute__((ext_vector_type(2)));
constexpr int A_KBUF = 10240, A_VBUF = 12288;
constexpr int A_KOFF = 0, A_VOFF = 2 * A_KBUF, A_BOFF = A_VOFF + 2 * A_VBUF, A_LDS_END = A_BOFF + 2 * 256;
__device__ __forceinline__ constexpr int crow0(int reg) { return (reg & 3) + 8 * (reg >> 2); }
__device__ __forceinline__ float swap_max(float m) { auto rr = __builtin_amdgcn_permlane32_swap(__float_as_uint(m), __float_as_uint(m), false, false); return fmaxf(__uint_as_float(rr[0]), __uint_as_float(rr[1])); }
__device__ __forceinline__ float swap_sum(float m) { auto rr = __builtin_amdgcn_permlane32_swap(__float_as_uint(m), __float_as_uint(m), false, false); return __uint_as_float(rr[0]) + __uint_as_float(rr[1]); }
__device__ __forceinline__ unsigned cvtpk(float lo, float hi) { f32x2_t v = {lo, hi}; bf16x2_t b = __builtin_convertvector(v, bf16x2_t); return __builtin_bit_cast(unsigned, b); }
__device__ __forceinline__ bf16x8v pack8(const f32x16& p, int b0) { u32x4 w; w.x = cvtpk(p[b0 + 0], p[b0 + 1]); w.y = cvtpk(p[b0 + 2], p[b0 + 3]); w.z = cvtpk(p[b0 + 4], p[b0 + 5]); w.w = cvtpk(p[b0 + 6], p[b0 + 7]); return __builtin_bit_cast(bf16x8v, w); }
__device__ __forceinline__ s16x4 tr_read(const LAS unsigned char* p) { typedef short v4i16_t __attribute__((ext_vector_type(4))); return __builtin_bit_cast(s16x4, __builtin_amdgcn_ds_read_tr16_b64_v4i16((LAS v4i16_t*)p)); }

template <int DQK, int NMAP, bool FOX, bool SLC>
__device__ __forceinline__ void attn_core(LAS unsigned char* L, const bf16* Kb0, const bf16* Kb1, const bf16* Vb, const LAS float* cum, float cum_ref,
                                          const bf16x8v (&Qf)[NMAP][DQK / 16], u64 tilemask, int t_lane, int tw0, int win, float slope2, unsigned selw0, unsigned selw1,
                                          f32x16 (&O)[NMAP][2], float (&M)[NMAP], float (&Ls)[NMAP], int tid, bool started0 = false) {
    constexpr int KP = DQK * 2 + 16, VP = 192;
    const int lane = tid & 63, r = lane & 31, h = lane >> 5;
    int kdst; const bf16* ksrc;
    if (DQK == 64) { kdst = (tid >> 3) * KP + (tid & 7) * 16; ksrc = Kb0 + b64_off(tid >> 3, (tid & 7) * 8); }
    else { const int mp = tid >> 8, tt = tid & 255; kdst = mp * 5120 + (tt >> 2) * KP + (tt & 3) * 16; ksrc = (mp ? Kb1 : Kb0) + (tt >> 2) * 32 + (tt & 3) * 8; }
    const int vdst = (tid >> 3) * VP + (tid & 7) * 16; const bf16* vsrc = Vb + b64_off(tid >> 3, (tid & 7) * 8);
    const LAS unsigned char* kfrag = L + A_KOFF + r * KP + h * 16;
    const LAS unsigned char* vfrag = L + A_VOFF + (4 * h + ((lane & 15) >> 2)) * VP + (16 * ((lane >> 4) & 1) + 4 * (lane & 3)) * 2;
    u32x4 kreg, vreg; float breg = 0.f;
    u64 mk = tilemask;
    int j = 63 - __builtin_clzll(mk); mk &= ~(1ull << j);
    { const int kv0 = j * 64; kreg = *(const u32x4*)(ksrc + (size_t)kv0 * DQK); vreg = *(const u32x4*)(vsrc + (size_t)kv0 * 64); if (FOX && tid < 64) breg = (cum_ref - cum[kv0 + tid]) * LOG2E; }
    *(LAS u32x4*)(L + A_KOFF + kdst) = kreg; *(LAS u32x4*)(L + A_VOFF + vdst) = vreg; if (FOX && tid < 64) *(LAS float*)(L + A_BOFF + tid * 4) = breg;
    __syncthreads();
    int buf = 0; bool started = started0;
    float pdummy = 0.f; int idummy = 0; f32x16 dm0; for (int i = 0; i < 16; ++i) dm0[i] = 0.f;
    for (;;) {
        const bool more = mk != 0ull; int jn = 0;
        if (more) { jn = 63 - __builtin_clzll(mk); mk &= ~(1ull << jn); const int kv0 = jn * 64;
            kreg = *(const u32x4*)(ksrc + (size_t)kv0 * DQK); vreg = *(const u32x4*)(vsrc + (size_t)kv0 * 64); if (FOX && tid < 64) breg = (cum_ref - cum[kv0 + tid]) * LOG2E; }
        { const int kv0 = j * 64;
          bool wave_has = true; float selb = 0.f;
          if (SLC) { const bool mine = ((j < 32 ? (selw0 >> j) : (selw1 >> (j - 32))) & 1u) != 0u; selb = mine ? 0.f : -INFINITY; wave_has = __any(mine); }
          if (wave_has && !(kv0 > tw0 + 31) && !(tw0 - (kv0 + 63) >= win)) {
            const bool need_mask = (kv0 + 63 > tw0) || (tw0 + 31 - kv0 >= win);
            const int dl = t_lane - kv0 - 4 * h;
            bf16x8v pa[NMAP][4];
#pragma unroll
            for (int mp = 0; mp < NMAP; ++mp) {
                f32x16 p0, p1;
                if (FOX) { const LAS f32x4* bl = (const LAS f32x4*)(L + A_BOFF + buf * 256) + h; const float mm = M[mp];
#pragma unroll
                    for (int g4 = 0; g4 < 4; ++g4) { const f32x4 b0 = bl[2 * g4], b1 = bl[8 + 2 * g4];
                        p0[4 * g4 + 0] = b0.x - mm; p0[4 * g4 + 1] = b0.y - mm; p0[4 * g4 + 2] = b0.z - mm; p0[4 * g4 + 3] = b0.w - mm; p1[4 * g4 + 0] = b1.x - mm; p1[4 * g4 + 1] = b1.y - mm; p1[4 * g4 + 2] = b1.z - mm; p1[4 * g4 + 3] = b1.w - mm; } }
                else { const float base_l = (slope2 * (float)(kv0 + 4 * h - tw0) - M[mp]) + selb, s8 = slope2 * 8.f, s32 = slope2 * 32.f;
                    p0[0] = base_l; p0[1] = p0[0] + slope2; p0[2] = p0[1] + slope2; p0[3] = p0[2] + slope2;
#pragma unroll
                    for (int reg = 4; reg < 16; ++reg) p0[reg] = p0[reg - 4] + s8;
#pragma unroll
                    for (int reg = 0; reg < 16; ++reg) p1[reg] = p0[reg] + s32; }
                const LAS unsigned char* kb = kfrag + buf * A_KBUF + (DQK == 32 ? mp * 5120 : 0);
#pragma unroll
                for (int s = 0; s < DQK / 16; ++s) { const bf16x8v kf0 = *(const LAS bf16x8v*)(kb + s * 32), kf1 = *(const LAS bf16x8v*)(kb + 32 * KP + s * 32);
#ifdef PROBE_X_LDSK
                    { const bf16x8v z0 = *(const volatile LAS bf16x8v*)(kb + s * 32), z1 = *(const volatile LAS bf16x8v*)(kb + 32 * KP + s * 32); idummy ^= z0[0] ^ z1[1]; }
#endif
#ifdef PROBE_X_MFMA
                    dm0 = __builtin_amdgcn_mfma_f32_32x32x16_bf16(kf0, Qf[mp][s], dm0, 0, 0, 0); dm0 = __builtin_amdgcn_mfma_f32_32x32x16_bf16(kf1, Qf[mp][s], dm0, 0, 0, 0);
#endif
                    p0 = __builtin_amdgcn_mfma_f32_32x32x16_bf16(kf0, Qf[mp][s], p0, 0, 0, 0); p1 = __builtin_amdgcn_mfma_f32_32x32x16_bf16(kf1, Qf[mp][s], p1, 0, 0, 0); }
                if (need_mask) {
#pragma unroll
                    for (int reg = 0; reg < 16; ++reg) { const int d0 = dl - crow0(reg), d1 = d0 - 32;
                        p0[reg] = (d0 >= 0 && d0 < win) ? p0[reg] : -INFINITY; p1[reg] = (d1 >= 0 && d1 < win) ? p1[reg] : -INFINITY; } }
                float mt = fmaxf(fmaxf(p0[0], p1[0]), fmaxf(p0[1], p1[1]));
#pragma unroll
                for (int reg = 2; reg < 16; reg += 2) mt = fmaxf(fmaxf(mt, fmaxf(fmaxf(p0[reg], p1[reg]), p0[reg + 1])), p1[reg + 1]);
                mt = swap_max(mt);
                if (!started || __any(mt > 8.f)) {
                    const float d = (mt > -1e30f) ? (started ? fmaxf(mt, 0.f) : mt) : 0.f, alpha = __builtin_amdgcn_exp2f(-d);
                    O[mp][0] *= alpha; O[mp][1] *= alpha; Ls[mp] *= alpha; M[mp] += d;
#pragma unroll
                    for (int reg = 0; reg < 16; ++reg) { p0[reg] -= d; p1[reg] -= d; } }
                float rs = 0.f;
#ifdef PROBE_X_EXP
#pragma unroll
                for (int reg = 0; reg < 16; ++reg) { pdummy += __builtin_amdgcn_exp2f(p0[reg] - 1.f) + __builtin_amdgcn_exp2f(p1[reg] - 1.f); }
#endif
#pragma unroll
                for (int reg = 0; reg < 16; ++reg) { p0[reg] = __builtin_amdgcn_exp2f(p0[reg]); p1[reg] = __builtin_amdgcn_exp2f(p1[reg]); rs += p0[reg] + p1[reg]; }
                Ls[mp] += rs;
                pa[mp][0] = pack8(p0, 0); pa[mp][1] = pack8(p0, 8); pa[mp][2] = pack8(p1, 0); pa[mp][3] = pack8(p1, 8);
            }
            started = true;
            const LAS unsigned char* vb = vfrag + buf * A_VBUF;
#pragma unroll
            for (int db = 0; db < 2; ++db)
#pragma unroll
                for (int ks = 0; ks < 4; ++ks) { const s16x4 lo = tr_read(vb + ks * (16 * VP) + db * 64), hi = tr_read(vb + ks * (16 * VP) + db * 64 + 8 * VP);
                    const bf16x8v vf = {lo[0], lo[1], lo[2], lo[3], hi[0], hi[1], hi[2], hi[3]};
#pragma unroll
                    for (int mp = 0; mp < NMAP; ++mp) O[mp][db] = __builtin_amdgcn_mfma_f32_32x32x16_bf16(vf, pa[mp][ks], O[mp][db], 0, 0, 0); }
          } }
        if (more) { *(LAS u32x4*)(L + A_KOFF + (buf ^ 1) * A_KBUF + kdst) = kreg; *(LAS u32x4*)(L + A_VOFF + (buf ^ 1) * A_VBUF + vdst) = vreg; if (FOX && tid < 64) *(LAS float*)(L + A_BOFF + (buf ^ 1) * 256 + tid * 4) = breg; }
#ifdef PROBE_X_BAR
        __syncthreads();
#endif
        __syncthreads();
        if (!more) break;
        j = jn; buf ^= 1;
    }
    if (pdummy == 123.456f || idummy == 0x7fffabcd || dm0[3] == 98765.4321f) Ls[0] += 1e-30f;
}
#ifndef AC2_MODE
#define AC2_MODE 0
#endif
#ifndef AC2_INIT_VALU
#define AC2_INIT_VALU 24
#endif
template <bool FOX, bool SLC>
__device__ __forceinline__ void attn_core2(LAS unsigned char* L, const bf16* Kb0, const bf16* Vb, const LAS float* cum, float cum_ref,
                                           const bf16x8v (&Qf)[4], u64 tilemask, int t_lane, int tw0, int win, float slope2, unsigned selw0, unsigned selw1,
                                           f32x16 (&O)[2], float& M, float& Ls, int tid) {
    constexpr int KP = 144, VP = 192;
    const int lane = tid & 63, r = lane & 31, h = lane >> 5;
    const int kdst = (tid >> 3) * KP + (tid & 7) * 16; const bf16* ksrc = Kb0 + b64_off(tid >> 3, (tid & 7) * 8);
    const int vdst = (tid >> 3) * VP + (tid & 7) * 16; const bf16* vsrc = Vb + b64_off(tid >> 3, (tid & 7) * 8);
    const LAS unsigned char* kfrag = L + A_KOFF + r * KP + h * 16;
    const LAS unsigned char* vfrag = L + A_VOFF + (4 * h + ((lane & 15) >> 2)) * VP + (16 * ((lane >> 4) & 1) + 4 * (lane & 3)) * 2;
#define AC2_ACTIVE(jj) (!((jj) * 64 > tw0 + 31) && !(tw0 - ((jj) * 64 + 63) >= win))
#define AC2_INIT(jj, kslot, q0, q1) do { const int kv0_ = (jj) * 64; \
        if (FOX) { const LAS f32x4* bl = (const LAS f32x4*)(L + A_BOFF + (kslot) * 256) + h; const float mm = M; \
            _Pragma("unroll") for (int g4 = 0; g4 < 4; ++g4) { const f32x4 b0 = bl[2 * g4], b1 = bl[8 + 2 * g4]; \
                q0[4 * g4 + 0] = b0.x - mm; q0[4 * g4 + 1] = b0.y - mm; q0[4 * g4 + 2] = b0.z - mm; q0[4 * g4 + 3] = b0.w - mm; q1[4 * g4 + 0] = b1.x - mm; q1[4 * g4 + 1] = b1.y - mm; q1[4 * g4 + 2] = b1.z - mm; q1[4 * g4 + 3] = b1.w - mm; } } \
        else { float selb = 0.f; if (SLC) selb = ((((jj) < 32) ? (selw0 >> (jj)) : (selw1 >> ((jj) - 32))) & 1u) ? 0.f : -INFINITY; \
            const float base_l = (slope2 * (float)(kv0_ + 4 * h - tw0) - M) + selb, s8 = slope2 * 8.f, s32 = slope2 * 32.f; \
            q0[0] = base_l; q0[1] = q0[0] + slope2; q0[2] = q0[1] + slope2; q0[3] = q0[2] + slope2; \
            _Pragma("unroll") for (int reg = 4; reg < 16; ++reg) q0[reg] = q0[reg - 4] + s8; \
            _Pragma("unroll") for (int reg = 0; reg < 16; ++reg) q1[reg] = q0[reg] + s32; } } while (0)
#define AC2_QK(jj, kslot) do { AC2_INIT(jj, kslot, p0, p1); \
        const LAS unsigned char* kb_ = kfrag + (kslot) * A_KBUF; \
        _Pragma("unroll") for (int s_ = 0; s_ < 4; ++s_) { const bf16x8v kf0 = *(const LAS bf16x8v*)(kb_ + s_ * 32), kf1 = *(const LAS bf16x8v*)(kb_ + 32 * KP + s_ * 32); \
            p0 = __builtin_amdgcn_mfma_f32_32x32x16_bf16(kf0, Qf[s_], p0, 0, 0, 0); p1 = __builtin_amdgcn_mfma_f32_32x32x16_bf16(kf1, Qf[s_], p1, 0, 0, 0); } } while (0)
    u32x4 kreg, vreg; float breg = 0.f;
    u64 mk = tilemask;
    int j = 63 - __builtin_clzll(mk); mk &= ~(1ull << j);
    int jn = -1; if (mk) { jn = 63 - __builtin_clzll(mk); mk &= ~(1ull << jn); }
    { kreg = *(const u32x4*)(ksrc + (size_t)j * 64 * 64); vreg = *(const u32x4*)(vsrc + (size_t)j * 64 * 64); if (FOX && tid < 64) breg = (cum_ref - cum[j * 64 + tid]) * LOG2E;
      *(LAS u32x4*)(L + A_KOFF + kdst) = kreg; *(LAS u32x4*)(L + A_VOFF + vdst) = vreg; if (FOX && tid < 64) *(LAS float*)(L + A_BOFF + tid * 4) = breg;
      if (jn >= 0) { kreg = *(const u32x4*)(ksrc + (size_t)jn * 64 * 64); if (FOX && tid < 64) breg = (cum_ref - cum[jn * 64 + tid]) * LOG2E;
          *(LAS u32x4*)(L + A_KOFF + A_KBUF + kdst) = kreg; if (FOX && tid < 64) *(LAS float*)(L + A_BOFF + 256 + tid * 4) = breg; } }
    __syncthreads();
    f32x16 p0, p1;
    bool started = false;
    int ks = 0, vs = 0;
    if (AC2_ACTIVE(j)) AC2_QK(j, 0);
    for (;;) {
        int jnn = -1; if (mk) { jnn = 63 - __builtin_clzll(mk); mk &= ~(1ull << jnn); }
        if (jnn >= 0) { kreg = *(const u32x4*)(ksrc + (size_t)jnn * 64 * 64); if (FOX && tid < 64) breg = (cum_ref - cum[jnn * 64 + tid]) * LOG2E; }
        if (jn >= 0) vreg = *(const u32x4*)(vsrc + (size_t)jn * 64 * 64);
        const bool act = AC2_ACTIVE(j), actn = jn >= 0 && AC2_ACTIVE(jn);
        if (act) {
            const int kv0 = j * 64;
            if ((kv0 + 63 > tw0) || (tw0 + 31 - kv0 >= win)) { const int dl = t_lane - kv0 - 4 * h;
#pragma unroll
                for (int reg = 0; reg < 16; ++reg) { const int d0 = dl - crow0(reg), d1 = d0 - 32;
                    p0[reg] = (d0 >= 0 && d0 < win) ? p0[reg] : -INFINITY; p1[reg] = (d1 >= 0 && d1 < win) ? p1[reg] : -INFINITY; } }
            float mt = fmaxf(fmaxf(p0[0], p1[0]), fmaxf(p0[1], p1[1]));
#pragma unroll
            for (int reg = 2; reg < 16; reg += 2) mt = fmaxf(fmaxf(mt, fmaxf(fmaxf(p0[reg], p1[reg]), p0[reg + 1])), p1[reg + 1]);
            mt = swap_max(mt);
            if (!started || __any(mt > 8.f)) {
                const float d = (mt > -1e30f) ? (started ? fmaxf(mt, 0.f) : mt) : 0.f, alpha = __builtin_amdgcn_exp2f(-d);
                O[0] *= alpha; O[1] *= alpha; Ls *= alpha; M += d;
#pragma unroll
                for (int reg = 0; reg < 16; ++reg) { p0[reg] -= d; p1[reg] -= d; } }
            started = true;
#if AC2_MODE == 1
            {
                const int jq = jn >= 0 ? jn : 0;
                float rs = 0.f;
#pragma unroll
                for (int reg = 0; reg < 16; ++reg) { p0[reg] = __builtin_amdgcn_exp2f(p0[reg]); p1[reg] = __builtin_amdgcn_exp2f(p1[reg]); rs += p0[reg] + p1[reg]; }
                Ls += rs;
                const bf16x8v pa0 = pack8(p0, 0), pa1 = pack8(p0, 8), pa2 = pack8(p1, 0), pa3 = pack8(p1, 8);
                AC2_QK(jq, ks ^ 1);
                const LAS unsigned char* vb = vfrag + vs * A_VBUF;
#pragma unroll
                for (int db = 0; db < 2; ++db)
#pragma unroll
                    for (int kq = 0; kq < 4; ++kq) { const s16x4 lo = tr_read(vb + kq * (16 * VP) + db * 64), hi = tr_read(vb + kq * (16 * VP) + db * 64 + 8 * VP);
                        const bf16x8v vf = {lo[0], lo[1], lo[2], lo[3], hi[0], hi[1], hi[2], hi[3]};
                        O[db] = __builtin_amdgcn_mfma_f32_32x32x16_bf16(vf, kq == 0 ? pa0 : kq == 1 ? pa1 : kq == 2 ? pa2 : pa3, O[db], 0, 0, 0); }
            }
#else
            {
                const int jq = jn >= 0 ? jn : 0;
                f32x16 n0, n1;
                AC2_INIT(jq, ks ^ 1, n0, n1);
                const LAS unsigned char* kb_ = kfrag + (ks ^ 1) * A_KBUF;
                bf16x8v kf[8];
#pragma unroll
                for (int s_ = 0; s_ < 4; ++s_) { kf[2 * s_] = *(const LAS bf16x8v*)(kb_ + s_ * 32); kf[2 * s_ + 1] = *(const LAS bf16x8v*)(kb_ + 32 * KP + s_ * 32); }
                const LAS unsigned char* vb = vfrag + vs * A_VBUF;
                __builtin_amdgcn_sched_barrier(0);
                float ra = 0.f, rb = 0.f; unsigned w[16];
#define AC2_PINF(x) asm volatile("" : "+v"(x))
#define AC2_QGAP(i) do { if ((i) & 1) n1 = __builtin_amdgcn_mfma_f32_32x32x16_bf16(kf[i], Qf[(i) >> 1], n1, 0, 0, 0); else n0 = __builtin_amdgcn_mfma_f32_32x32x16_bf16(kf[i], Qf[(i) >> 1], n0, 0, 0, 0); \
                    float e0 = __builtin_amdgcn_exp2f(p0[2 * (i)]), e1 = __builtin_amdgcn_exp2f(p0[2 * (i) + 1]), e2 = __builtin_amdgcn_exp2f(p1[2 * (i)]), e3 = __builtin_amdgcn_exp2f(p1[2 * (i) + 1]); \
                    ra += e0 + e1; rb += e2 + e3; \
                    AC2_PINF(e0); AC2_PINF(e1); AC2_PINF(e2); AC2_PINF(e3); AC2_PINF(ra); AC2_PINF(rb); \
                    p0[2 * (i)] = e0; p0[2 * (i) + 1] = e1; p1[2 * (i)] = e2; p1[2 * (i) + 1] = e3; \
                    if ((i) >= 4) { w[2 * ((i) - 4)] = cvtpk(p0[4 * ((i) - 4)], p0[4 * ((i) - 4) + 1]); w[2 * ((i) - 4) + 1] = cvtpk(p0[4 * ((i) - 4) + 2], p0[4 * ((i) - 4) + 3]); AC2_PINF(w[2 * ((i) - 4)]); AC2_PINF(w[2 * ((i) - 4) + 1]); } \
                    if ((i) == 6) { vl[0] = tr_read(vb); vh[0] = tr_read(vb + 8 * VP); } \
                    if ((i) == 7) { vl[1] = tr_read(vb + 64); vh[1] = tr_read(vb + 64 + 8 * VP); } \
                    __builtin_amdgcn_sched_barrier(0); } while (0)
                s16x4 vl[2], vh[2];
                AC2_QGAP(0); AC2_QGAP(1); AC2_QGAP(2); AC2_QGAP(3); AC2_QGAP(4); AC2_QGAP(5); AC2_QGAP(6); AC2_QGAP(7);
                Ls += ra + rb;
#define AC2_PA(kq) __builtin_bit_cast(bf16x8v, (u32x4){w[4 * (kq)], w[4 * (kq) + 1], w[4 * (kq) + 2], w[4 * (kq) + 3]})
#define AC2_PGAP(g) do { const int kq_ = (g) >> 1, db_ = (g) & 1; const bf16x8v vf = {vl[(g) & 1][0], vl[(g) & 1][1], vl[(g) & 1][2], vl[(g) & 1][3], vh[(g) & 1][0], vh[(g) & 1][1], vh[(g) & 1][2], vh[(g) & 1][3]}; \
                    if ((g) < 6) { const int kq2 = ((g) + 2) >> 1, db2 = (g) & 1; vl[(g) & 1] = tr_read(vb + kq2 * (16 * VP) + db2 * 64); vh[(g) & 1] = tr_read(vb + kq2 * (16 * VP) + db2 * 64 + 8 * VP); } \
                    O[db_] = __builtin_amdgcn_mfma_f32_32x32x16_bf16(vf, AC2_PA(kq_), O[db_], 0, 0, 0); \
                    if ((g) < 4) { w[8 + 2 * (g)] = cvtpk(p1[4 * (g)], p1[4 * (g) + 1]); w[8 + 2 * (g) + 1] = cvtpk(p1[4 * (g) + 2], p1[4 * (g) + 3]); AC2_PINF(w[8 + 2 * (g)]); AC2_PINF(w[8 + 2 * (g) + 1]); } \
                    __builtin_amdgcn_sched_barrier(0); } while (0)
                AC2_PGAP(0); AC2_PGAP(1); AC2_PGAP(2); AC2_PGAP(3); AC2_PGAP(4); AC2_PGAP(5); AC2_PGAP(6); AC2_PGAP(7);
#undef AC2_PGAP
#undef AC2_PA
#undef AC2_QGAP
#undef AC2_PINF
                p0 = n0; p1 = n1;
            }
#endif
        } else if (actn) AC2_QK(jn, ks ^ 1);
        if (jnn >= 0) { *(LAS u32x4*)(L + A_KOFF + ks * A_KBUF + kdst) = kreg; if (FOX && tid < 64) *(LAS float*)(L + A_BOFF + ks * 256 + tid * 4) = breg; }
        if (jn >= 0) *(LAS u32x4*)(L + A_VOFF + (vs ^ 1) * A_VBUF + vdst) = vreg;
        __syncthreads();
        if (jn < 0) break;
        j = jn; jn = jnn; ks ^= 1; vs ^= 1;
    }
#undef AC2_QK
#undef AC2_INIT
#undef AC2_ACTIVE
}
__device__ __forceinline__ size_t mix_off(size_t n, int c, int W) { return ((n >> 5) * (size_t)(W / 8) + (size_t)(c >> 3)) * 256 + (n & 31) * 8 + (c & 7); }
#define ATTN_FOR_CHUNKS(db, g4) _Pragma("unroll") for (int db = 0; db < 2; ++db) _Pragma("unroll") for (int g4 = 0; g4 < 4; ++g4)

__device__ __forceinline__ void unpack8(const u32x4 w, float (&f)[8]) { f[0] = __uint_as_float(w.x << 16); f[1] = __uint_as_float(w.x & 0xffff0000u); f[2] = __uint_as_float(w.y << 16); f[3] = __uint_as_float(w.y & 0xffff0000u);
    f[4] = __uint_as_float(w.z << 16); f[5] = __uint_as_float(w.z & 0xffff0000u); f[6] = __uint_as_float(w.w << 16); f[7] = __uint_as_float(w.w & 0xffff0000u); }
__device__ __forceinline__ void ph_norm_bf16_from_bf16(const Ctx& c, const bf16* x, const float* g, bf16* out) {
    constexpr int RB = 4; float gg[2][8];
#pragma unroll
    for (int j = 0; j < 2; ++j) { const f32x4 a = ((const f32x4*)g)[2 * c.lane + 128 * j], b2 = ((const f32x4*)g)[2 * c.lane + 128 * j + 1]; gg[j][0] = a.x; gg[j][1] = a.y; gg[j][2] = a.z; gg[j][3] = a.w; gg[j][4] = b2.x; gg[j][5] = b2.y; gg[j][6] = b2.z; gg[j][7] = b2.w; }
    for (int row0 = c.gw * RB; row0 < NT; row0 += c.ngw * RB) {
        u32x4 v[RB][2];
#pragma unroll
        for (int q = 0; q < RB; ++q)
#pragma unroll
            for (int j = 0; j < 2; ++j) v[q][j] = ((const u32x4*)(x + (size_t)(row0 + q) * D_))[c.lane + 64 * j];
#pragma unroll
        for (int q = 0; q < RB; ++q) { float f[2][8]; float ss = 0.f;
#pragma unroll
            for (int j = 0; j < 2; ++j) { unpack8(v[q][j], f[j]);
#pragma unroll
                for (int e = 0; e < 8; ++e) ss = fmaf(f[j][e], f[j][e], ss); }
            const float r = rsqrtf(wave_sum(ss) * (1.f / D_) + EPS);
#pragma unroll
            for (int j = 0; j < 2; ++j) { u32x4 o; o.x = pk2(f[j][0] * r * gg[j][0], f[j][1] * r * gg[j][1]); o.y = pk2(f[j][2] * r * gg[j][2], f[j][3] * r * gg[j][3]); o.z = pk2(f[j][4] * r * gg[j][4], f[j][5] * r * gg[j][5]); o.w = pk2(f[j][6] * r * gg[j][6], f[j][7] * r * gg[j][7]);
                ((u32x4*)(out + (size_t)(row0 + q) * D_))[c.lane + 64 * j] = o; } }
    }
}
__device__ __forceinline__ void ph_norm_final_from_bf16(const Ctx& c, const bf16* x, const float* g, float* out) {
    constexpr int RB = 4; float gg[2][8];
#pragma unroll
    for (int j = 0; j < 2; ++j) { const f32x4 a = ((const f32x4*)g)[2 * c.lane + 128 * j], b2 = ((const f32x4*)g)[2 * c.lane + 128 * j + 1]; gg[j][0] = a.x; gg[j][1] = a.y; gg[j][2] = a.z; gg[j][3] = a.w; gg[j][4] = b2.x; gg[j][5] = b2.y; gg[j][6] = b2.z; gg[j][7] = b2.w; }
    for (int row0 = c.gw * RB; row0 < NT; row0 += c.ngw * RB) {
        u32x4 v[RB][2];
#pragma unroll
        for (int q = 0; q < RB; ++q)
#pragma unroll
            for (int j = 0; j < 2; ++j) v[q][j] = ((const u32x4*)(x + (size_t)(row0 + q) * D_))[c.lane + 64 * j];
#pragma unroll
        for (int q = 0; q < RB; ++q) { float f[2][8]; float ss = 0.f;
#pragma unroll
            for (int j = 0; j < 2; ++j) { unpack8(v[q][j], f[j]);
#pragma unroll
                for (int e = 0; e < 8; ++e) ss = fmaf(f[j][e], f[j][e], ss); }
            const float r = rsqrtf(wave_sum(ss) * (1.f / D_) + EPS);
#pragma unroll
            for (int j = 0; j < 2; ++j) { f32x4* o = (f32x4*)(out + (size_t)(row0 + q) * D_) + 2 * c.lane + 128 * j;
                o[0] = (f32x4){f[j][0] * r * gg[j][0], f[j][1] * r * gg[j][1], f[j][2] * r * gg[j][2], f[j][3] * r * gg[j][3]}; o[1] = (f32x4){f[j][4] * r * gg[j][4], f[j][5] * r * gg[j][5], f[j][6] * r * gg[j][6], f[j][7] * r * gg[j][7]}; } }
    }
}
__device__ __forceinline__ void ph_norm_bf16(const Ctx& c, const float* x, const float* g, bf16* out, bf16* raw) {
    constexpr int RB = 4;
    f32x4 gg[4];
#pragma unroll
    for (int j = 0; j < 4; ++j) gg[j] = ((const f32x4*)g)[c.lane + 64 * j];
    for (int row0 = c.gw * RB; row0 < NT; row0 += c.ngw * RB) {
        f32x4 v[RB][4];
#pragma unroll
        for (int q = 0; q < RB; ++q)
#pragma unroll
            for (int j = 0; j < 4; ++j) v[q][j] = ((const f32x4*)(x + (size_t)(row0 + q) * D_))[c.lane + 64 * j];
#pragma unroll
        for (int q = 0; q < RB; ++q) { float ss = 0.f;
#pragma unroll
            for (int j = 0; j < 4; ++j) ss += v[q][j].x * v[q][j].x + v[q][j].y * v[q][j].y + v[q][j].z * v[q][j].z + v[q][j].w * v[q][j].w;
            const float r = rsqrtf(wave_sum(ss) * (1.f / D_) + EPS);
            u64* o8 = (u64*)(out + (size_t)(row0 + q) * D_) + c.lane; u64* r8 = (u64*)(raw + (size_t)(row0 + q) * D_) + c.lane;
#pragma unroll
            for (int j = 0; j < 4; ++j) { o8[64 * j] = (u64)pk2(v[q][j].x * r * gg[j].x, v[q][j].y * r * gg[j].y) | ((u64)pk2(v[q][j].z * r * gg[j].z, v[q][j].w * r * gg[j].w) << 32);
                r8[64 * j] = (u64)pk2(v[q][j].x, v[q][j].y) | ((u64)pk2(v[q][j].z, v[q][j].w) << 32); } }
    }
}
__device__ __forceinline__ void ph_norm_final(const Ctx& c, float* x, const float* g) {
    constexpr int RB = 4;
    f32x4 gg[4];
#pragma unroll
    for (int j = 0; j < 4; ++j) gg[j] = ((const f32x4*)g)[c.lane + 64 * j];
    for (int row0 = c.gw * RB; row0 < NT; row0 += c.ngw * RB) {
        f32x4 v[RB][4];
#pragma unroll
        for (int q = 0; q < RB; ++q)
#pragma unroll
            for (int j = 0; j < 4; ++j) v[q][j] = ((const f32x4*)(x + (size_t)(row0 + q) * D_))[c.lane + 64 * j];
#pragma unroll
        for (int q = 0; q < RB; ++q) { float ss = 0.f;
#pragma unroll
            for (int j = 0; j < 4; ++j) ss += v[q][j].x * v[q][j].x + v[q][j].y * v[q][j].y + v[q][j].z * v[q][j].z + v[q][j].w * v[q][j].w;
            const float r = rsqrtf(wave_sum(ss) * (1.f / D_) + EPS);
            f32x4* xr = (f32x4*)(x + (size_t)(row0 + q) * D_) + c.lane;
#pragma unroll
            for (int j = 0; j < 4; ++j) xr[64 * j] = v[q][j] * r * gg[j]; }
    }
}

template <class AF, class EF>
__device__ __forceinline__ void naive_gemm(const Ctx& c, int M, int N, int K, AF af, const float* W, int ldb, EF ef) {
    LAS float* As = (LAS float*)c.lds;
    LAS float* Bs = As + 16 * 132;
    const int tm = (M + 127) / 128, tn = (N + 127) / 128, ntile = tm * tn;
    const int ty = c.tid >> 4, tx = c.tid & 15;
    for (int tile = c.bid; tile < ntile; tile += c.G) {
        const int m0 = (tile / tn) * 128, n0 = (tile % tn) * 128;
        float acc[4][8];
#pragma unroll
        for (int i = 0; i < 4; ++i)
#pragma unroll
            for (int j = 0; j < 8; ++j) acc[i][j] = 0.f;
        for (int k0 = 0; k0 < K; k0 += 16) {
            __syncthreads();
#pragma unroll
            for (int i = 0; i < 4; ++i) { const int e = c.tid + i * 512, r = e >> 4, kk = e & 15; const int row = m0 + r;
                As[kk * 132 + r] = (row < M) ? af(row, k0 + kk) : 0.f; }
#pragma unroll
            for (int i = 0; i < 4; ++i) { const int e = c.tid + i * 512, kk = e >> 7, cc = e & 127; const int col = n0 + cc;
                Bs[kk * 132 + cc] = (col < N) ? W[(size_t)(k0 + kk) * ldb + col] : 0.f; }
            __syncthreads();
#pragma unroll 2
            for (int kk = 0; kk < 16; ++kk) {
                float a[4], b[8];
#pragma unroll
                for (int i = 0; i < 4; ++i) a[i] = As[kk * 132 + ty * 4 + i];
#pragma unroll
                for (int j = 0; j < 8; ++j) b[j] = Bs[kk * 132 + tx * 8 + j];
#pragma unroll
                for (int i = 0; i < 4; ++i)
#pragma unroll
                    for (int j = 0; j < 8; ++j) acc[i][j] = fmaf(a[i], b[j], acc[i][j]);
            }
        }
        LAS float* Cs = Bs + 16 * 132;
        __syncthreads();
#pragma unroll
        for (int i = 0; i < 4; ++i)
#pragma unroll
            for (int j = 0; j < 8; ++j) Cs[(ty * 4 + i) * 129 + tx * 8 + j] = acc[i][j];
        __syncthreads();
#pragma unroll 1
        for (int e = c.tid; e < 128 * 128; e += NTHREADS) { const int r = e >> 7, cc = e & 127, row = m0 + r, col = n0 + cc; if (row < M && col < N) ef(row, col, Cs[r * 129 + cc]); }
    }
    __syncthreads();
}

struct InProjOut { bf16* qn; bf16* kv6; bf16* fqkv; bf16* dqk; bf16* dv; float* gate; float* fl; const float* b_gate; const float* b_fgt; };
__device__ __forceinline__ void inproj_store(const InProjOut& o, int n, int col, float v) {
    const int b = n / T_, t = n % T_;
    if (col < C_KV6) { const int h = col >> 6, d = col & 63; o.qn[((size_t)(b * 8 + h) * T_ + t) * 64 + d] = (bf16)f2bf(v * (0.125f * LOG2E)); }
    else if (col < C_GATE) { const int cc = col - C_KV6, idx = cc >> 7, g = (cc >> 6) & 1, d = cc & 63;
        ((bf16*)((unsigned char*)o.kv6 + idx * KV6_STRIDE))[((size_t)(b * 2 + g) * T_ + t) * 64 + d] = (bf16)f2bf(v); }
    else if (col < C_FQ) { const int j = col - C_GATE; o.gate[(size_t)n * 24 + j] = sigmoidf_(v + o.b_gate[j]); }
    else if (col < C_FF) { const int cc = col - C_FQ, idx = cc >> 8, h = (cc >> 6) & 3, d = cc & 63;
        o.fqkv[(size_t)idx * (8 * MiB) + ((size_t)(b * 4 + h) * T_ + t) * 64 + d] = (bf16)f2bf(idx == 0 ? v * (0.125f * LOG2E) : v); }
    else if (col < C_DQ) { const int h = col - C_FF; o.fl[(size_t)(b * 4 + h) * T_ + t] = log_sigmoidf_(v + o.b_fgt[h]); }
    else if (col < C_DV) { const int cc = col - C_DQ, idx = cc >> 8, h = (cc >> 6) & 3, i = (cc >> 5) & 1, d = cc & 31;
        o.dqk[(size_t)idx * (8 * MiB) + ((size_t)((b * 4 + h) * 2 + i) * T_ + t) * 32 + d] = (bf16)f2bf(idx == 0 ? v * (0.17677669529663687f * LOG2E) : v); }
    else { const int cc = col - C_DV, h = cc >> 6, d = cc & 63; o.dv[((size_t)(b * 4 + h) * T_ + t) * 64 + d] = (bf16)f2bf(v); }
}

__device__ __forceinline__ void ph_cumsum(const Ctx& c, float* fl) {
    for (int s = c.gw; s < B_ * 4; s += c.ngw) {
        float* p = fl + (size_t)s * T_; float carry = 0.f;
        for (int t0 = 0; t0 < T_; t0 += 64) {
            float v = p[t0 + c.lane];
#pragma unroll
            for (int o = 1; o < 64; o <<= 1) { const float u = __shfl_up(v, o); if (c.lane >= o) v += u; }
            v += carry; p[t0 + c.lane] = v; carry = __shfl(v, 63);
        }
    }
}

template <int DQK>
__device__ __forceinline__ float naive_attn_row(const bf16* q, const bf16* K, const bf16* V, int t, u64 mask, float slope2, const float* cum, int win, int lane) {
    float qv[DQK];
    { const u32x4* q4 = (const u32x4*)q;
#pragma unroll
      for (int i = 0; i < DQK / 8; ++i) { const u32x4 w = q4[i];
          qv[8 * i + 0] = __uint_as_float(w.x << 16); qv[8 * i + 1] = __uint_as_float(w.x & 0xffff0000u);
          qv[8 * i + 2] = __uint_as_float(w.y << 16); qv[8 * i + 3] = __uint_as_float(w.y & 0xffff0000u);
          qv[8 * i + 4] = __uint_as_float(w.z << 16); qv[8 * i + 5] = __uint_as_float(w.z & 0xffff0000u);
          qv[8 * i + 6] = __uint_as_float(w.w << 16); qv[8 * i + 7] = __uint_as_float(w.w & 0xffff0000u); } }
    const float cumt = cum ? cum[t] : 0.f;
    float m = -INFINITY, l = 0.f, o = 0.f;
    while (mask) {
        const int j = __builtin_ctzll(mask); mask &= mask - 1;
        const int kpos = 64 * j + lane; const int dist = t - kpos;
        const bool valid = dist >= 0 && dist < win;
        float s = 0.f;
        { const u32x4* k4 = (const u32x4*)(K + (size_t)kpos * DQK);
#pragma unroll
          for (int i = 0; i < DQK / 8; ++i) { const u32x4 w = k4[i];
              s = fmaf(qv[8 * i + 0], __uint_as_float(w.x << 16), s); s = fmaf(qv[8 * i + 1], __uint_as_float(w.x & 0xffff0000u), s);
              s = fmaf(qv[8 * i + 2], __uint_as_float(w.y << 16), s); s = fmaf(qv[8 * i + 3], __uint_as_float(w.y & 0xffff0000u), s);
              s = fmaf(qv[8 * i + 4], __uint_as_float(w.z << 16), s); s = fmaf(qv[8 * i + 5], __uint_as_float(w.z & 0xffff0000u), s);
              s = fmaf(qv[8 * i + 6], __uint_as_float(w.w << 16), s); s = fmaf(qv[8 * i + 7], __uint_as_float(w.w & 0xffff0000u), s); } }
        s -= slope2 * (float)dist;
        if (cum) s += (cumt - cum[kpos]) * LOG2E;
        s = valid ? s : -INFINITY;
        const float mb = wave_max(s);
        if (mb == -INFINITY) continue;
        const float mn = fmaxf(m, mb), alpha = exp2f(m - mn);
        const float p = valid ? exp2f(s - mn) : 0.f;
        l = l * alpha + wave_sum(p); o *= alpha; m = mn;
        const bf16* vb = V + (size_t)(64 * j) * 64 + lane;
#pragma unroll 8
        for (int k = 0; k < 64; ++k) o = fmaf(__shfl(p, k), bf2f(vb[(size_t)k * 64]), o);
    }
    return l > 0.f ? o / l : 0.f;
}

__device__ __forceinline__ void ph_cmp_attn(const Ctx& c, const bf16* qn, const bf16* kcmp, const bf16* vcmp, const float* gate, u64* sel, bf16* ocmp) {
    LAS float* pl = (LAS float*)(c.lds) + c.wave * 256;
    const int lane = c.lane;
    for (int it = c.gw; it < B_ * 2 * T_; it += c.ngw) {
        const int t = it % T_, bg = it / T_, b = bg >> 1, g = bg & 1;
        const int nvis = (t >= 31) ? ((t - 31) >> 4) + 1 : 0;
        const bf16* kc = kcmp + (size_t)bg * 256 * 64; const bf16* vc = vcmp + (size_t)bg * 256 * 64;
        float imp = 0.f;
        for (int hg = 0; hg < 4; ++hg) {
            const int h = g * 4 + hg; const float slope2 = alibi_slope(h + 1, 8) * LOG2E;
            const bf16* q = qn + ((size_t)(b * 8 + h) * T_ + t) * 64;
            float qv[64];
            { const u32x4* q4 = (const u32x4*)q;
#pragma unroll
              for (int i = 0; i < 8; ++i) { const u32x4 w = q4[i];
                  qv[8 * i + 0] = __uint_as_float(w.x << 16); qv[8 * i + 1] = __uint_as_float(w.x & 0xffff0000u);
                  qv[8 * i + 2] = __uint_as_float(w.y << 16); qv[8 * i + 3] = __uint_as_float(w.y & 0xffff0000u);
                  qv[8 * i + 4] = __uint_as_float(w.z << 16); qv[8 * i + 5] = __uint_as_float(w.z & 0xffff0000u);
                  qv[8 * i + 6] = __uint_as_float(w.w << 16); qv[8 * i + 7] = __uint_as_float(w.w & 0xffff0000u); } }
            float s[4]; float m = -INFINITY;
#pragma unroll
            for (int i = 0; i < 4; ++i) { const int cc = lane + 64 * i; float a = 0.f;
                if (cc < nvis) { const u32x4* k4 = (const u32x4*)(kc + (size_t)cc * 64);
#pragma unroll
                    for (int e = 0; e < 8; ++e) { const u32x4 w = k4[e];
                        a = fmaf(qv[8 * e + 0], __uint_as_float(w.x << 16), a); a = fmaf(qv[8 * e + 1], __uint_as_float(w.x & 0xffff0000u), a);
                        a = fmaf(qv[8 * e + 2], __uint_as_float(w.y << 16), a); a = fmaf(qv[8 * e + 3], __uint_as_float(w.y & 0xffff0000u), a);
                        a = fmaf(qv[8 * e + 4], __uint_as_float(w.z << 16), a); a = fmaf(qv[8 * e + 5], __uint_as_float(w.z & 0xffff0000u), a);
                        a = fmaf(qv[8 * e + 6], __uint_as_float(w.w << 16), a); a = fmaf(qv[8 * e + 7], __uint_as_float(w.w & 0xffff0000u), a); }
                    a -= slope2 * (float)(t - (16 * cc + 31)); } else a = -INFINITY;
                s[i] = a; m = fmaxf(m, a); }
            m = wave_max(m);
            float p[4], lsum = 0.f;
#pragma unroll
            for (int i = 0; i < 4; ++i) { p[i] = (lane + 64 * i < nvis) ? exp2f(s[i] - m) : 0.f; lsum += p[i]; }
            lsum = wave_sum(lsum);
            const float inv = lsum > 0.f ? 1.f / lsum : 0.f;
#pragma unroll
            for (int i = 0; i < 4; ++i) { p[i] *= inv; pl[lane + 64 * i] = p[i]; }
            asm volatile("s_waitcnt lgkmcnt(0)" ::: "memory");
            float o = 0.f;
            for (int cc = 0; cc < nvis; ++cc) o = fmaf(pl[cc], bf2f(vc[(size_t)cc * 64 + lane]), o);
            const float gt = gate[((size_t)(b * T_ + t)) * 24 + h * 3 + 0];
            ocmp[(size_t)(b * T_ + t) * 512 + h * 64 + lane] = (bf16)f2bf(gt * o);
            { const int j = lane; float a = pl[4 * j] + pl[4 * j + 1] + pl[4 * j + 2] + 0.5f * pl[4 * j + 3]; if (j > 0) a += 0.5f * pl[4 * j - 1]; imp += a; }
            asm volatile("s_waitcnt lgkmcnt(0)" ::: "memory");
        }
        const int cur = t >> 6; const int j = lane;
        u64 m64;
        if (cur <= 15) m64 = (cur == 63) ? ~0ull : ((1ull << (cur + 1)) - 1ull);
        else {
            float val = (j > cur) ? -INFINITY : ((j == 0 || j == cur || j == cur - 1) ? 1e4f : imp);
            m64 = 0ull;
            for (int r = 0; r < 16; ++r) {
                const float mx = wave_max(val);
                const u64 bal = __ballot(val == mx);
                const int w = __builtin_ctzll(bal);
                m64 |= 1ull << w; if (j == w) val = -INFINITY;
            }
        }
        if (lane == 0) sel[(size_t)bg * T_ + t] = m64;
    }
}

__device__ __forceinline__ void ph_win_attn(const Ctx& c, const bf16* qn, const bf16* kw, const bf16* vw, const float* gate, bf16* owin) {
    for (int it = c.gw; it < B_ * 8 * T_; it += c.ngw) {
        const int t = it % T_, bh = it / T_, b = bh >> 3, h = bh & 7, g = h >> 2;
        const int cur = t >> 6, jlo = (t - 511) > 0 ? (t - 511) >> 6 : 0;
        const u64 hi = (cur == 63) ? ~0ull : ((1ull << (cur + 1)) - 1ull); const u64 mask = hi & ~((1ull << jlo) - 1ull);
        const float o = naive_attn_row<64>(qn + ((size_t)bh * T_ + t) * 64, kw + (size_t)(b * 2 + g) * T_ * 64, vw + (size_t)(b * 2 + g) * T_ * 64, t, mask,
                                           alibi_slope(h + 1, 8) * LOG2E, nullptr, 512, c.lane);
        owin[(size_t)(b * T_ + t) * 512 + h * 64 + c.lane] = (bf16)f2bf(gate[(size_t)(b * T_ + t) * 24 + h * 3 + 2] * o);
    }
}
__device__ __forceinline__ void ph_slc_attn(const Ctx& c, const bf16* qn, const bf16* ks, const bf16* vs, const float* gate, const u64* sel, const bf16* ocmp, const bf16* owin, bf16* att) {
    for (int it = c.gw; it < B_ * 8 * T_; it += c.ngw) {
        const int t = it % T_, bh = it / T_, b = bh >> 3, h = bh & 7, g = h >> 2;
        const u64 mask = sel[(size_t)(b * 2 + g) * T_ + t];
        const float o = naive_attn_row<64>(qn + ((size_t)bh * T_ + t) * 64, ks + (size_t)(b * 2 + g) * T_ * 64, vs + (size_t)(b * 2 + g) * T_ * 64, t, mask,
                                           alibi_slope(h + 1, 8) * LOG2E, nullptr, 1 << 30, c.lane);
        const size_t n = (size_t)(b * T_ + t);
        const float r = gate[n * 24 + h * 3 + 1] * o + bf2f(ocmp[n * 512 + h * 64 + c.lane]) + bf2f(owin[n * 512 + h * 64 + c.lane]);
        att[n * 1024 + h * 64 + c.lane] = (bf16)f2bf(r);
    }
}
__device__ __forceinline__ void ph_fox_attn(const Ctx& c, const bf16* fq, const bf16* fk, const bf16* fv, const float* cum, bf16* att) {
    for (int it = c.gw; it < B_ * 4 * T_; it += c.ngw) {
        const int t = it % T_, bh = it / T_, b = bh >> 2, h = bh & 3;
        const int cur = t >> 6; const u64 mask = (cur == 63) ? ~0ull : ((1ull << (cur + 1)) - 1ull);
        const float o = naive_attn_row<64>(fq + ((size_t)bh * T_ + t) * 64, fk + (size_t)bh * T_ * 64, fv + (size_t)bh * T_ * 64, t, mask, 0.f, cum + (size_t)bh * T_, 1 << 30, c.lane);
        att[(size_t)(b * T_ + t) * 1024 + 512 + h * 64 + c.lane] = (bf16)f2bf(o);
    }
}
__device__ __forceinline__ void ph_diff_attn(const Ctx& c, const bf16* dq, const bf16* dk, const bf16* dv, const float* lam, const float* subln, float lambda_init, bf16* att) {
    float l1 = 0.f, l2 = 0.f;
    if (c.lane < 32) { l1 = lam[c.lane] * lam[32 + c.lane]; l2 = lam[64 + c.lane] * lam[96 + c.lane]; }
    const float lam_full = __expf(wave_sum(l1)) - __expf(wave_sum(l2)) + lambda_init;
    const float sg = subln[c.lane] * (1.f - lambda_init);
    for (int it = c.gw; it < B_ * 4 * T_; it += c.ngw) {
        const int t = it % T_, bh = it / T_, b = bh >> 2, h = bh & 3;
        const int cur = t >> 6; const u64 mask = (cur == 63) ? ~0ull : ((1ull << (cur + 1)) - 1ull);
        const float slope2 = alibi_slope(h + 1, 4) * LOG2E;
        const bf16* vb = dv + (size_t)bh * T_ * 64;
        const float o1 = naive_attn_row<32>(dq + ((size_t)(bh * 2 + 0) * T_ + t) * 32, dk + (size_t)(bh * 2 + 0) * T_ * 32, vb, t, mask, slope2, nullptr, 1 << 30, c.lane);
        const float o2 = naive_attn_row<32>(dq + ((size_t)(bh * 2 + 1) * T_ + t) * 32, dk + (size_t)(bh * 2 + 1) * T_ * 32, vb, t, mask, slope2, nullptr, 1 << 30, c.lane);
        const float o = o1 - lam_full * o2;
        const float r = rsqrtf(wave_sum(o * o) * (1.f / 64.f) + EPS);
        att[(size_t)(b * T_ + t) * 1024 + 768 + h * 64 + c.lane] = (bf16)f2bf(o * r * sg);
    }
}

__device__ __forceinline__ void ph_moe_route(const Ctx& c, const float* x, const float* g, const float* wgrp, const float* bgrp, const float* wexp, const float* bexp, bf16* hn, int* route_e, float* route_w, unsigned* cnt) {
    for (int row = c.gw; row < NT; row += c.ngw) {
        const f32x4* xr = (const f32x4*)(x + (size_t)row * D_) + c.lane;
        f32x4 v[4]; float ss = 0.f;
#pragma unroll
        for (int j = 0; j < 4; ++j) { v[j] = xr[64 * j]; ss += v[j].x * v[j].x + v[j].y * v[j].y + v[j].z * v[j].z + v[j].w * v[j].w; }
        const float r = rsqrtf(wave_sum(ss) * (1.f / D_) + EPS);
        u64* o8 = (u64*)(hn + (size_t)row * D_) + c.lane;
#pragma unroll
        for (int j = 0; j < 4; ++j) { const f32x4 gg = ((const f32x4*)g)[c.lane + 64 * j]; v[j] = v[j] * r * gg;
            o8[64 * j] = (u64)pk2(v[j].x, v[j].y) | ((u64)pk2(v[j].z, v[j].w) << 32); }
        float gl[4];
#pragma unroll
        for (int q = 0; q < 4; ++q) { float a = 0.f;
#pragma unroll
            for (int j = 0; j < 4; ++j) { const int k = 4 * (c.lane + 64 * j);
                a = fmaf(v[j].x, wgrp[(size_t)(k + 0) * 4 + q], a); a = fmaf(v[j].y, wgrp[(size_t)(k + 1) * 4 + q], a);
                a = fmaf(v[j].z, wgrp[(size_t)(k + 2) * 4 + q], a); a = fmaf(v[j].w, wgrp[(size_t)(k + 3) * 4 + q], a); }
            gl[q] = wave_sum(a) + bgrp[q]; }
        int grp = 0; float gm = gl[0];
#pragma unroll
        for (int q = 1; q < 4; ++q) if (gl[q] > gm) { gm = gl[q]; grp = q; }
        float gs = 0.f;
#pragma unroll
        for (int q = 0; q < 4; ++q) gs += __expf(gl[q] - gm);
        const float grp_gate = 1.f / gs;
        float el[8];
#pragma unroll
        for (int q = 0; q < 8; ++q) { float a = 0.f; const int col = grp * 8 + q;
#pragma unroll
            for (int j = 0; j < 4; ++j) { const int k = 4 * (c.lane + 64 * j);
                a = fmaf(v[j].x, wexp[(size_t)(k + 0) * 32 + col], a); a = fmaf(v[j].y, wexp[(size_t)(k + 1) * 32 + col], a);
                a = fmaf(v[j].z, wexp[(size_t)(k + 2) * 32 + col], a); a = fmaf(v[j].w, wexp[(size_t)(k + 3) * 32 + col], a); }
            el[q] = wave_sum(a) + bexp[col]; }
        int i0 = 0; float v0 = el[0];
#pragma unroll
        for (int q = 1; q < 8; ++q) if (el[q] > v0) { v0 = el[q]; i0 = q; }
        int i1 = -1; float v1 = -INFINITY;
#pragma unroll
        for (int q = 0; q < 8; ++q) if (q != i0 && el[q] > v1) { v1 = el[q]; i1 = q; }
        const float e1 = __expf(v1 - v0), den = 1.f + e1;
        if (c.lane == 0) { const float w0 = grp_gate / den, w1 = grp_gate * e1 / den;
            const int lo = i0 < i1 ? i0 : i1, hi = i0 < i1 ? i1 : i0, cls = grp * 28 + lo * 8 - (lo * (lo + 1)) / 2 + (hi - lo - 1);
            const unsigned rank = __hip_atomic_fetch_add(cnt + cls, 1u, __ATOMIC_RELAXED, __HIP_MEMORY_SCOPE_AGENT);
            route_e[row] = (int)(((unsigned)cls << 24) | rank); route_w[2 * row] = i0 < i1 ? w0 : w1; route_w[2 * row + 1] = i0 < i1 ? w1 : w0; }
    }
}
__device__ __forceinline__ void ph_moe_naive(const Ctx& c, const bf16* hn, const int* route_e, const float* route_w, const float* wg, const float* wu, const float* wd, float* x) {
    LAS float* hs = (LAS float*)c.lds;
    LAS float* au = hs + 1024;
    LAS float* h2 = au + 512;
    for (int row = c.bid; row < NT; row += c.G) {
        __syncthreads();
        hs[c.tid] = bf2f(hn[(size_t)row * D_ + c.tid]); hs[c.tid + 512] = bf2f(hn[(size_t)row * D_ + c.tid + 512]);
        float o0 = 0.f, o1 = 0.f;
        for (int s = 0; s < 2; ++s) {
            const int e = route_e[2 * row + s]; const float w = route_w[2 * row + s];
            __syncthreads();
            const float* W = (c.tid < 256 ? wg : wu) + (size_t)e * D_ * DEXP + (c.tid & 255);
            float a = 0.f;
            for (int k = 0; k < D_; ++k) a = fmaf(hs[k], W[(size_t)k * DEXP], a);
            au[c.tid] = a;
            __syncthreads();
            if (c.tid < 256) { const float ga = au[c.tid], up = au[c.tid + 256]; h2[c.tid] = ga / (1.f + __expf(-ga)) * up * w; }
            __syncthreads();
            const float* Wd = wd + (size_t)e * DEXP * D_;
            for (int k = 0; k < DEXP; ++k) { const float hv = h2[k]; o0 = fmaf(hv, Wd[(size_t)k * D_ + c.tid], o0); o1 = fmaf(hv, Wd[(size_t)k * D_ + c.tid + 512], o1); }
        }
        x[(size_t)row * D_ + c.tid] += o0; x[(size_t)row * D_ + c.tid + 512] += o1;
    }
    __syncthreads();
}

typedef __attribute__((address_space(4))) const Params* KP;
__device__ __forceinline__ KP uni_kp(KP p) { const unsigned long long v = (unsigned long long)p; const unsigned lo = __builtin_amdgcn_readfirstlane((unsigned)v), hi = __builtin_amdgcn_readfirstlane((unsigned)(v >> 32)); return (KP)(((unsigned long long)hi << 32) | lo); }
constexpr int PH_PER_LAYER = 11, N_PHASES = L_ * PH_PER_LAYER + 2;
__device__ __forceinline__ Ctx make_ctx(KP p) {
    Ctx c; c.lds = (LAS unsigned char*)lds_raw; { int t_ = threadIdx.x; asm volatile("" : "+v"(t_)); c.tid = t_; } c.lane = c.tid & 63; c.wave = __builtin_amdgcn_readfirstlane(c.tid >> 6);
    c.bid = blockIdx.x; c.G = gridDim.x; c.gw = c.bid * NWAVES + c.wave; c.ngw = c.G * NWAVES; c.in = nullptr; c.xcur = p->out; c.ws = p->ws;
    return c;
}
struct Bufs {
    bf16 *QN, *KV6, *KC, *VC, *KS, *VS, *KW, *VW, *FQ, *FK, *FV, *DQ, *DK, *DV, *HC, *KCMP, *VCMP, *OCMP, *OWIN, *HN, *ATT;
    float *GATE, *FL, *ROUTE_W; u64* SEL; int* ROUTE_E;
};
__device__ __forceinline__ Bufs make_bufs(unsigned char* ws) {
    Bufs b;
    b.QN = (bf16*)(ws + WS_QN); b.KV6 = (bf16*)(ws + WS_KV6);
    b.KC = (bf16*)(ws + WS_KV6 + 0 * KV6_STRIDE); b.VC = (bf16*)(ws + WS_KV6 + 1 * KV6_STRIDE);
    b.KS = (bf16*)(ws + WS_KV6 + 2 * KV6_STRIDE); b.VS = (bf16*)(ws + WS_KV6 + 3 * KV6_STRIDE);
    b.KW = (bf16*)(ws + WS_KV6 + 4 * KV6_STRIDE); b.VW = (bf16*)(ws + WS_KV6 + 5 * KV6_STRIDE);
    b.FQ = (bf16*)(ws + WS_FQKV); b.FK = b.FQ + 8 * MiB; b.FV = b.FQ + 16 * MiB;
    b.DQ = (bf16*)(ws + WS_DQK); b.DK = b.DQ + 8 * MiB; b.DV = (bf16*)(ws + WS_DV);
    b.GATE = (float*)(ws + WS_GATE); b.FL = (float*)(ws + WS_FL);
    b.HC = (bf16*)(ws + WS_HC); b.KCMP = (bf16*)(ws + WS_KVCMP); b.VCMP = b.KCMP + 16 * 256 * 64;
    b.SEL = (u64*)(ws + WS_SEL); b.OCMP = (bf16*)(ws + WS_OCMP); b.OWIN = (bf16*)(ws + WS_OWIN);
    b.HN = (bf16*)(ws + WS_HN); b.ATT = (bf16*)(ws + WS_ATT);
    b.ROUTE_E = (int*)(ws + WS_ROUTE); b.ROUTE_W = (float*)(ws + WS_ROUTE + 512 * 1024);
    return b;
}
__device__ __forceinline__ float lambda_init_of(int l) { return l == 0 ? 0.2f : 0.35550906759096926f; }

__device__ __noinline__ void P_prologue(KP p_) { const KP p = uni_kp(p_);
    const Ctx c = make_ctx(p); unsigned char* ws = p->ws;
    LAS float* scr = (LAS float*)(c.lds) + c.wave * (64 * 33);
    constexpr int I_A = 16 * 40, I_B = 16 * 24, I_C = 16 * 24, I_O = 16 * 32, I_G = 16 * 8, I_D = 4 * 32, I_E = 2 * I_G + I_D, I_W1 = 32 * 8, I_W2 = 4 * 2;
    constexpr int PER_L = I_A + I_B + I_C + I_O + NEXP * I_E + 2 * (I_W1 + I_W2);
    for (int it = c.gw; it < L_ * PER_L; it += c.ngw) {
        const int l = it / PER_L; int r = it % PER_L;
        const float* W; bf16* WT; int ldw, K, sc0, ncol, r0 = 0, rmul = 1;
        if (r < I_A + I_B + I_C) { W = p->in[2] + (size_t)l * D_ * D_IN; WT = (bf16*)(ws + WS_WIN_T) + (size_t)l * NIN * D_; ldw = D_IN; K = D_;
            if (r < I_A) { sc0 = 0; ncol = 1280; r0 = 0; } else if (r < I_A + I_B) { r -= I_A; sc0 = C_FQ; ncol = 768; r0 = 1280; } else { r -= I_A + I_B; sc0 = C_DQ; ncol = 768; r0 = 2048; } }
        else if ((r -= I_A + I_B + I_C) < I_O) { W = p->in[13] + (size_t)l * D_ * D_; WT = (bf16*)(ws + WS_WOUT_T) + (size_t)l * D_ * D_; ldw = D_; K = D_; sc0 = 0; ncol = 1024; }
        else if ((r -= I_O) < NEXP * I_E) { const int e = r / I_E; r = r % I_E; const size_t le = (size_t)l * NEXP + e;
            if (r < 2 * I_G) { const int up = r >= I_G; r -= up * I_G; W = p->in[19 + up] + le * D_ * DEXP; WT = (bf16*)(ws + WS_WGU_T) + le * 512 * D_; ldw = DEXP; K = D_; sc0 = 0; ncol = 256; r0 = up; rmul = 2; }
            else { r -= 2 * I_G; W = p->in[21] + le * DEXP * D_; WT = (bf16*)(ws + WS_WD_T) + le * D_ * DEXP; ldw = D_; K = DEXP; sc0 = 0; ncol = 1024; } }
        else { r -= NEXP * I_E; const int kv = r / (I_W1 + I_W2); r = r % (I_W1 + I_W2); const size_t lk = (size_t)l * 2 + kv;
            if (r < I_W1) { W = p->in[kv == 0 ? 6 : 9] + (size_t)l * 2048 * 256; WT = (bf16*)(ws + WS_W1_T) + lk * 256 * 2048; ldw = 256; K = 2048; sc0 = 0; ncol = 256; }
            else { r -= I_W1; W = p->in[kv == 0 ? 7 : 10] + (size_t)l * 256 * 64; WT = (bf16*)(ws + WS_W2_T) + lk * 64 * 256; ldw = 64; K = 256; sc0 = 0; ncol = 64; } }
        transpose_seg(W, ldw, K, sc0, ncol, WT, r0, rmul, r, scr, c.lane);
    }
    for (int i = c.bid * NTHREADS + c.tid; i < L_ * 256 * D_; i += c.G * NTHREADS) {
        const int l = i / (256 * D_), rr = (i / D_) % 256, k = i % D_;
        const float* win = p->in[2] + (size_t)l * D_ * D_IN;
        float v = 0.f; if (rr < 24) v = win[(size_t)k * D_IN + C_GATE + rr]; else if (rr < 28) v = win[(size_t)k * D_IN + C_FF + (rr - 24)];
        ((bf16*)(ws + WS_WIN_T))[((size_t)l * NIN + 2816 + rr) * D_ + k] = (bf16)f2bf(v);
    }
    for (int w = c.gw; w < L_ * 2 * 4 * 128; w += c.ngw) {
        const int lk = w >> 9, cg = (w >> 7) & 3, kc = w & 127, l = lk >> 1, kv = lk & 1, j = cg * 64 + c.lane;
        const float* pe = p->in[kv == 0 ? 5 : 8] + (size_t)l * 2048 + kc * 16; const float* w1 = p->in[kv == 0 ? 6 : 9] + (size_t)l * 2048 * 256 + (size_t)kc * 16 * 256;
        float a = 0.f;
#pragma unroll
        for (int k = 0; k < 16; ++k) a = fmaf(pe[k], w1[(size_t)k * 256 + j], a);
        ((float*)(ws + WS_B1PART))[((size_t)lk * 128 + kc) * 256 + j] = a;
    }
    for (int i = c.bid * NTHREADS + c.tid; i < L_ * 64 * 2 * 64; i += c.G * NTHREADS) {
        const int l = i / (64 * 2 * 64), ks = (i / 128) % 64, cb = (i / 64) & 1, lane = i & 63, col = 32 * cb + (lane & 31);
        unsigned hi[4], lo[4];
#pragma unroll
        for (int jp = 0; jp < 4; ++jp) { float v[2];
#pragma unroll
            for (int e = 0; e < 2; ++e) { const int k = 16 * ks + 8 * (lane >> 5) + 2 * jp + e; const float g = p->in[14][(size_t)l * D_ + k];
                v[e] = col < 4 ? g * p->in[15][((size_t)l * D_ + k) * 4 + col] : (col < 36 ? g * p->in[17][((size_t)l * D_ + k) * 32 + (col - 4)] : 0.f); }
            const unsigned h0 = f2bf(v[0]), h1 = f2bf(v[1]); hi[jp] = h0 | (h1 << 16);
            lo[jp] = f2bf(v[0] - __uint_as_float(h0 << 16)) | (f2bf(v[1] - __uint_as_float(h1 << 16)) << 16); }
        u32x4* dst = (u32x4*)(ws + WS_WR) + ((size_t)((l * 64 + ks) * 2 + cb) * 2) * 64 + lane;
        dst[0] = (u32x4){hi[0], hi[1], hi[2], hi[3]}; dst[64] = (u32x4){lo[0], lo[1], lo[2], lo[3]};
    }
}
__device__ __forceinline__ void P_inproj_mfma(int l_) { const KP p = (KP)__builtin_amdgcn_kernarg_segment_ptr(); int l = l_; asm volatile("" : "+s"(l));
    unsigned char* ws = p->ws; asm volatile("" : "+s"(ws));
    PlainOrder S; S.init(p->out, (const bf16*)(ws + WS_WIN_T) + (size_t)l * NIN * D_, D_, D_, NT, NIN, (int)gridDim.x, launder_s((int)blockIdx.x));
#ifdef STAGGER_TICKS
    { const unsigned long long t0 = __builtin_amdgcn_s_memrealtime(); const unsigned long long d = (unsigned long long)((launder_s((int)blockIdx.x) >> 3) & 3) * STAGGER_TICKS;
      while (__builtin_amdgcn_s_memrealtime() - t0 < d) __builtin_amdgcn_s_sleep(4); }
#endif
    const pg8::Gemm g{D_, D_, D_, D_ / 64, 0, 0};
    const EpiInProj E{ws, p->in[3] + l * 24, p->in[4] + l * 4, (unsigned*)(ws + WS_CTL) + CW_KN + l * 8192};
    pg8::gemm_phase<EpiInProj, PlainOrder, INPROJ_ALIGN, INPROJ_SP2>((LAS unsigned char*)lds_raw, g, S, E);
}
__device__ __forceinline__ void P_inproj_dummy(int l_) { const KP p = (KP)__builtin_amdgcn_kernarg_segment_ptr(); int l = l_; asm volatile("" : "+s"(l));
    unsigned char* ws = p->ws; asm volatile("" : "+s"(ws));
    PlainOrder S; S.init(p->out, (const bf16*)(ws + WS_WIN_T) + (size_t)l * NIN * D_, D_, D_, NT, NIN, (int)gridDim.x, launder_s((int)blockIdx.x));
    const pg8::Gemm g{D_, D_, D_, D_ / 64, 0, 0};
    const EpiDummy E{(float*)(ws + WS_HB)};
    pg8::gemm_phase<EpiDummy, PlainOrder, true, true>((LAS unsigned char*)lds_raw, g, S, E);
}
__device__ __forceinline__ void P_outproj_mfma(int l_) { const KP p = (KP)__builtin_amdgcn_kernarg_segment_ptr(); int l = l_; asm volatile("" : "+s"(l));
    unsigned char* ws = p->ws; asm volatile("" : "+s"(ws));
    PlainOrder S; S.init(ws + WS_ATT, (const bf16*)(ws + WS_WOUT_T) + (size_t)l * D_ * D_, D_, D_, NT, D_, (int)gridDim.x, launder_s((int)blockIdx.x));
    const pg8::Gemm g{D_, D_, D_, D_ / 64, 32, 8};
    const EpiResBf16 E{(bf16*)(ws + WS_HN)};
    pg8::gemm_phase<EpiResBf16, PlainOrder, true, true>((LAS unsigned char*)lds_raw, g, S, E);
}
__device__ __forceinline__ float wave_max_l(float v, int lane) {
#pragma unroll
    for (int o = 1; o < 64; o <<= 1) v = fmaxf(v, shflx_f(v, o, lane));
    return v;
}
__device__ __forceinline__ float wave_min_l(float v, int lane) {
#pragma unroll
    for (int o = 1; o < 64; o <<= 1) v = fminf(v, shflx_f(v, o, lane));
    return v;
}
template <int NS> __device__ __forceinline__ float q_norm2_max(const bf16x8v (&Q)[NS], int lane) {
    float ss = 0.f;
#pragma unroll
    for (int s = 0; s < NS; ++s)
#pragma unroll
        for (int e = 0; e < 8; ++e) { const float v = __uint_as_float(((unsigned)(unsigned short)Q[s][e]) << 16); ss = fmaf(v, v, ss); }
    return wave_max_l(swap_sum(ss), lane);
}
__device__ __forceinline__ u64 prune_consensus(bool skip, LAS u64* slots, int wave, int lane) {
    const u64 mine = __ballot(skip);
    __syncthreads();
    if (lane == 0) slots[wave] = mine;
    __syncthreads();
    u64 all = slots[0];
#pragma unroll
    for (int w = 1; w < NWAVES; ++w) all &= slots[w];
    return all;
}
__device__ __forceinline__ void U_fox(KP p_, int bh_, int qb_, int l_) {
    const KP p = uni_kp(p_); const int bh = __builtin_amdgcn_readfirstlane(bh_), qb = __builtin_amdgcn_readfirstlane(qb_), l = __builtin_amdgcn_readfirstlane(l_);
    int tid_ = threadIdx.x; asm volatile("" : "+v"(tid_));
    const int tid = tid_, lane = tid & 63, wave = __builtin_amdgcn_readfirstlane(tid >> 6), r = lane & 31, h = lane >> 5;
    unsigned char* ws = p->ws; asm volatile("" : "+s"(ws)); LAS unsigned char* L = (LAS unsigned char*)lds_raw;
    const int tw0 = 256 * qb + 32 * wave, t_lane = tw0 + r, b = bh >> 2, hd = bh & 3;
    const bf16* q = (const bf16*)(ws + WS_FQKV) + (size_t)bh * T_ * 64 + (t_lane >> 4) * 1024 + (t_lane & 15) * 32 + 8 * h;
    bf16x8v Qf[1][4];
#pragma unroll
    for (int s = 0; s < 4; ++s) Qf[0][s] = *(const bf16x8v*)(q + (s >> 1) * 512 + (s & 1) * 16);
    LAS float* cum = (LAS float*)(L + A_LDS_END);
    { const float* fl = (const float*)(ws + WS_FL) + (size_t)bh * T_; LAS float* tot = cum + 4096;
      const int nval = 256 * (qb + 1); float v[8];
      if (8 * tid < nval) { const f32x4 a = *(const f32x4*)(fl + 8 * tid), c2 = *(const f32x4*)(fl + 8 * tid + 4); v[0] = a.x; v[1] = a.y; v[2] = a.z; v[3] = a.w; v[4] = c2.x; v[5] = c2.y; v[6] = c2.z; v[7] = c2.w; }
      else {
#pragma unroll
          for (int i = 0; i < 8; ++i) v[i] = 0.f; }
#pragma unroll
      for (int i = 1; i < 8; ++i) v[i] += v[i - 1];
      float sc = v[7];
#pragma unroll
      for (int o = 1; o < 64; o <<= 1) { const float up = __uint_as_float((unsigned)__builtin_amdgcn_ds_bpermute((lane - o) << 2, (int)__float_as_uint(sc))); if (lane >= o) sc += up; }
      if (lane == 63) tot[wave] = sc;
      __syncthreads();
      float base = sc - v[7];
      for (int w = 0; w < wave; ++w) base += tot[w];
      if (8 * tid < nval) {
#pragma unroll
          for (int i = 0; i < 8; ++i) cum[8 * tid + i] = v[i] + base; }
      __syncthreads(); }
    f32x16 O[1][2]; float M[1] = {0.f}, Ls[1] = {0.f};
#pragma unroll
    for (int i = 0; i < 16; ++i) { O[0][0][i] = 0.f; O[0][1][i] = 0.f; }
    const u64 tm = (qb == 15) ? ~0ull : ((1ull << (4 * qb + 4)) - 1ull);
#if AC2_MODE == 0
    {
        const u64 low = (1ull << (4 * qb)) - 1ull; const float cref = cum[256 * qb];
        const bf16* Kp = (const bf16*)(ws + WS_FQKV) + 8 * MiB + (size_t)bh * T_ * 64; const bf16* Vp = (const bf16*)(ws + WS_FQKV) + 16 * MiB + (size_t)bh * T_ * 64;
        attn_core<64, 1, true, false>(L, Kp, nullptr, Vp, cum, cref, Qf, tm & ~low, t_lane, tw0, 1 << 30, 0.f, 0u, 0u, O, M, Ls, tid);
        if (qb > 0) {
            const float qn2 = q_norm2_max<4>(Qf[0], lane), mmin = wave_min_l(M[0], lane);
            const float* kn = (const float*)((const unsigned*)(ws + WS_CTL) + CW_KN + l * 8192) + ((size_t)bh * 64 + lane) * 2;
            bool skip = false;
            if (lane < 4 * qb) { const float kn2 = kn[0] + kn[1]; const float bound = sqrtf(qn2 * kn2) * 1.02f + (cref - cum[64 * lane + 63]) * LOG2E - mmin; skip = bound < -152.f; }
            const u64 drop = prune_consensus(skip, (LAS u64*)(cum + 4096 + 16), wave, lane);
            const u64 tm2 = low & ~drop;
            if (tm2) attn_core<64, 1, true, false>(L, Kp, nullptr, Vp, cum, cref, Qf, tm2, t_lane, tw0, 1 << 30, 0.f, 0u, 0u, O, M, Ls, tid, true);
        }
    }
#else
    attn_core2<true, false>(L, (const bf16*)(ws + WS_FQKV) + 8 * MiB + (size_t)bh * T_ * 64, (const bf16*)(ws + WS_FQKV) + 16 * MiB + (size_t)bh * T_ * 64, cum, cum[256 * qb],
                            Qf[0], tm, t_lane, tw0, 1 << 30, 0.f, 0u, 0u, O[0], M[0], Ls[0], tid);
#endif
    const float lt = swap_sum(Ls[0]), inv = lt > 0.f ? 1.f / lt : 0.f;
    bf16* dst = (bf16*)(ws + WS_ATT) + mix_off((size_t)b * T_ + t_lane, 512 + hd * 64 + 4 * h, 1024);
    ATTN_FOR_CHUNKS(db, g4) { const unsigned w0 = cvtpk(O[0][db][4 * g4 + 0] * inv, O[0][db][4 * g4 + 1] * inv), w1 = cvtpk(O[0][db][4 * g4 + 2] * inv, O[0][db][4 * g4 + 3] * inv);
        *(u64*)(dst + (4 * db + g4) * 256) = (u64)w0 | ((u64)w1 << 32); }
}
__device__ __forceinline__ void U_diff(KP p_, int bh_, int qb_, int l_) {
    const KP p = uni_kp(p_); const int bh = __builtin_amdgcn_readfirstlane(bh_), qb = __builtin_amdgcn_readfirstlane(qb_), l = __builtin_amdgcn_readfirstlane(l_);
    int tid_ = threadIdx.x; asm volatile("" : "+v"(tid_));
    const int tid = tid_, lane = tid & 63, wave = __builtin_amdgcn_readfirstlane(tid >> 6), r = lane & 31, h = lane >> 5;
    unsigned char* ws = p->ws; asm volatile("" : "+s"(ws)); LAS unsigned char* L = (LAS unsigned char*)lds_raw;
    const int tw0 = 256 * qb + 32 * wave, t_lane = tw0 + r, b = bh >> 2, hd = bh & 3;
    const bf16* DQ = (const bf16*)(ws + WS_DQK); const bf16* DK = DQ + 8 * MiB;
    bf16x8v Qf[2][2];
#pragma unroll
    for (int mp = 0; mp < 2; ++mp)
#pragma unroll
        for (int s = 0; s < 2; ++s) Qf[mp][s] = *(const bf16x8v*)(DQ + ((size_t)(bh * 2 + mp) * T_ + t_lane) * 32 + 16 * s + 8 * h);
    f32x16 O[2][2]; float M[2] = {0.f, 0.f}, Ls[2] = {0.f, 0.f};
#pragma unroll
    for (int i = 0; i < 16; ++i) { O[0][0][i] = 0.f; O[0][1][i] = 0.f; O[1][0][i] = 0.f; O[1][1][i] = 0.f; }
    const u64 tm = (qb == 15) ? ~0ull : ((1ull << (4 * qb + 4)) - 1ull);
    {
        const u64 low = (1ull << (4 * qb)) - 1ull; const float slope2 = alibi_slope(hd + 1, 4) * LOG2E;
        const bf16* K0 = DK + (size_t)(bh * 2 + 0) * T_ * 32; const bf16* K1 = DK + (size_t)(bh * 2 + 1) * T_ * 32; const bf16* Vp = (const bf16*)(ws + WS_DV) + (size_t)bh * T_ * 64;
        attn_core<32, 2, false, false>(L, K0, K1, Vp, nullptr, 0.f, Qf, tm & ~low, t_lane, tw0, 1 << 30, slope2, 0u, 0u, O, M, Ls, tid);
        if (qb > 0) {
            const float qa = q_norm2_max<2>(Qf[0], lane), qb2 = q_norm2_max<2>(Qf[1], lane), ma = wave_min_l(M[0], lane), mb = wave_min_l(M[1], lane);
            const float* kn = (const float*)((const unsigned*)(ws + WS_CTL) + CW_KN + l * 8192 + 4096) + (size_t)(bh * 2) * 64 + lane;
            bool skip = false;
            if (lane < 4 * qb) { const float bmax = slope2 * (float)(64 * lane + 63 - tw0);
                skip = (sqrtf(qa * kn[0]) * 1.02f + bmax - ma < -152.f) && (sqrtf(qb2 * kn[64]) * 1.02f + bmax - mb < -152.f); }
            const u64 drop = prune_consensus(skip, (LAS u64*)(L + A_LDS_END), wave, lane);
            const u64 tm2 = low & ~drop;
            if (tm2) attn_core<32, 2, false, false>(L, K0, K1, Vp, nullptr, 0.f, Qf, tm2, t_lane, tw0, 1 << 30, slope2, 0u, 0u, O, M, Ls, tid, true);
        }
    }
    const float* lam = p->in[11] + (size_t)l * 128; const float* subln = p->in[12] + (size_t)l * 64;
    float l1 = 0.f, l2 = 0.f; if (lane < 32) { l1 = lam[lane] * lam[32 + lane]; l2 = lam[64 + lane] * lam[96 + lane]; }
    const float li = lambda_init_of(l), lam_full = __expf(wave_sum_l(l1, lane)) - __expf(wave_sum_l(l2, lane)) + li;
    const float lt0 = swap_sum(Ls[0]), lt1 = swap_sum(Ls[1]), i0 = lt0 > 0.f ? 1.f / lt0 : 0.f, i1 = (lt1 > 0.f ? 1.f / lt1 : 0.f) * lam_full;
    float ss = 0.f;
#pragma unroll
    for (int db = 0; db < 2; ++db)
#pragma unroll
        for (int i = 0; i < 16; ++i) { const float o = O[0][db][i] * i0 - O[1][db][i] * i1; O[0][db][i] = o; ss += o * o; }
    ss = swap_sum(ss);
    const float rn = rsqrtf(ss * (1.f / 64.f) + EPS) * (1.f - li);
    bf16* dst = (bf16*)(ws + WS_ATT) + mix_off((size_t)b * T_ + t_lane, 768 + hd * 64 + 4 * h, 1024);
    ATTN_FOR_CHUNKS(db, g4) { const f32x4 sg = *(const f32x4*)(subln + 32 * db + 8 * g4 + 4 * h);
        const unsigned w0 = cvtpk(O[0][db][4 * g4 + 0] * rn * sg.x, O[0][db][4 * g4 + 1] * rn * sg.y), w1 = cvtpk(O[0][db][4 * g4 + 2] * rn * sg.z, O[0][db][4 * g4 + 3] * rn * sg.w);
        *(u64*)(dst + (4 * db + g4) * 256) = (u64)w0 | ((u64)w1 << 32); }
}
__device__ __forceinline__ void U_win(KP p_, int bg_, int c_) {
    const KP p = uni_kp(p_); const int bg = __builtin_amdgcn_readfirstlane(bg_), cc = __builtin_amdgcn_readfirstlane(c_);
    int tid_ = threadIdx.x; asm volatile("" : "+v"(tid_));
    const int tid = tid_, lane = tid & 63, wave = __builtin_amdgcn_readfirstlane(tid >> 6), r = lane & 31, h = lane >> 5;
    unsigned char* ws = p->ws; asm volatile("" : "+s"(ws)); LAS unsigned char* L = (LAS unsigned char*)lds_raw;
    const int b = bg >> 1, g = bg & 1, hd = g * 4 + (wave >> 1), tw0 = 64 * cc + 32 * (wave & 1), t_lane = tw0 + r;
    const bf16* q = (const bf16*)(ws + WS_QN) + (size_t)(b * 8 + hd) * T_ * 64 + (t_lane >> 4) * 1024 + (t_lane & 15) * 32 + 8 * h;
    bf16x8v Qf[1][4];
#pragma unroll
    for (int s = 0; s < 4; ++s) Qf[0][s] = *(const bf16x8v*)(q + (s >> 1) * 512 + (s & 1) * 16);
    f32x16 O[1][2]; float M[1] = {0.f}, Ls[1] = {0.f};
#pragma unroll
    for (int i = 0; i < 16; ++i) { O[0][0][i] = 0.f; O[0][1][i] = 0.f; }
    const int jlo = cc > 8 ? cc - 8 : 0;
    const u64 hi = (cc == 63) ? ~0ull : ((1ull << (cc + 1)) - 1ull), tm = hi & ~((1ull << jlo) - 1ull);
#if AC2_MODE == 0
    attn_core<64, 1, false, false>(L, (const bf16*)(ws + WS_KV6 + 4 * KV6_STRIDE) + (size_t)bg * T_ * 64, nullptr, (const bf16*)(ws + WS_KV6 + 5 * KV6_STRIDE) + (size_t)bg * T_ * 64, nullptr, 0.f,
                                   Qf, tm, t_lane, tw0, 512, alibi_slope(hd + 1, 8) * LOG2E, 0u, 0u, O, M, Ls, tid);
#else
    attn_core2<false, false>(L, (const bf16*)(ws + WS_KV6 + 4 * KV6_STRIDE) + (size_t)bg * T_ * 64, (const bf16*)(ws + WS_KV6 + 5 * KV6_STRIDE) + (size_t)bg * T_ * 64, nullptr, 0.f,
                             Qf[0], tm, t_lane, tw0, 512, alibi_slope(hd + 1, 8) * LOG2E, 0u, 0u, O[0], M[0], Ls[0], tid);
#endif
    const size_t n = (size_t)b * T_ + t_lane;
    const float lt = swap_sum(Ls[0]), inv = (lt > 0.f ? 1.f / lt : 0.f) * ((const float*)(ws + WS_GATE))[n * 24 + hd * 3 + 2];
    bf16* dst = (bf16*)(ws + WS_OWIN) + mix_off(n, hd * 64 + 4 * h, 512);
    ATTN_FOR_CHUNKS(db, g4) { const unsigned w0 = cvtpk(O[0][db][4 * g4 + 0] * inv, O[0][db][4 * g4 + 1] * inv), w1 = cvtpk(O[0][db][4 * g4 + 2] * inv, O[0][db][4 * g4 + 3] * inv);
        *(u64*)(dst + (4 * db + g4) * 256) = (u64)w0 | ((u64)w1 << 32); }
}
__device__ __forceinline__ void U_slc(KP p_, int bg_, int c_) {
    const KP p = uni_kp(p_); const int bg = __builtin_amdgcn_readfirstlane(bg_), cc = __builtin_amdgcn_readfirstlane(c_);
    int tid_ = threadIdx.x; asm volatile("" : "+v"(tid_));
    const int tid = tid_, lane = tid & 63, wave = __builtin_amdgcn_readfirstlane(tid >> 6), r = lane & 31, h = lane >> 5;
    unsigned char* ws = p->ws; asm volatile("" : "+s"(ws)); LAS unsigned char* L = (LAS unsigned char*)lds_raw;
    const int b = bg >> 1, g = bg & 1, hd = g * 4 + (wave >> 1), tw0 = 64 * cc + 32 * (wave & 1), t_lane = tw0 + r;
    const bf16* q = (const bf16*)(ws + WS_QN) + (size_t)(b * 8 + hd) * T_ * 64 + (t_lane >> 4) * 1024 + (t_lane & 15) * 32 + 8 * h;
    bf16x8v Qf[1][4];
#pragma unroll
    for (int s = 0; s < 4; ++s) Qf[0][s] = *(const bf16x8v*)(q + (s >> 1) * 512 + (s & 1) * 16);
    f32x16 O[1][2]; float M[1] = {0.f}, Ls[1] = {0.f};
#pragma unroll
    for (int i = 0; i < 16; ++i) { O[0][0][i] = 0.f; O[0][1][i] = 0.f; }
    const u64* sel = (const u64*)(ws + WS_SEL) + (size_t)bg * T_;
    const u64 mine = sel[t_lane]; u64 un = sel[64 * cc + lane];
    { unsigned ul = (unsigned)un, uh = (unsigned)(un >> 32);
#pragma unroll
      for (int o = 1; o < 64; o <<= 1) { ul |= shflx_u(ul, o, lane); uh |= shflx_u(uh, o, lane); }
      un = ((u64)__builtin_amdgcn_readfirstlane(uh) << 32) | __builtin_amdgcn_readfirstlane(ul); }
#if AC2_MODE == 0
    attn_core<64, 1, false, true>(L, (const bf16*)(ws + WS_KV6 + 2 * KV6_STRIDE) + (size_t)bg * T_ * 64, nullptr, (const bf16*)(ws + WS_KV6 + 3 * KV6_STRIDE) + (size_t)bg * T_ * 64, nullptr, 0.f,
                                  Qf, un, t_lane, tw0, 1 << 30, alibi_slope(hd + 1, 8) * LOG2E, (unsigned)mine, (unsigned)(mine >> 32), O, M, Ls, tid);
#else
    attn_core2<false, true>(L, (const bf16*)(ws + WS_KV6 + 2 * KV6_STRIDE) + (size_t)bg * T_ * 64, (const bf16*)(ws + WS_KV6 + 3 * KV6_STRIDE) + (size_t)bg * T_ * 64, nullptr, 0.f,
                            Qf[0], un, t_lane, tw0, 1 << 30, alibi_slope(hd + 1, 8) * LOG2E, (unsigned)mine, (unsigned)(mine >> 32), O[0], M[0], Ls[0], tid);
#endif
    const size_t n = (size_t)b * T_ + t_lane;
    const float lt = swap_sum(Ls[0]), inv = (lt > 0.f ? 1.f / lt : 0.f) * ((const float*)(ws + WS_GATE))[n * 24 + hd * 3 + 1];
    const bf16* oc = (const bf16*)(ws + WS_OCMP) + mix_off(n, hd * 64 + 4 * h, 512); const bf16* ow = (const bf16*)(ws + WS_OWIN) + mix_off(n, hd * 64 + 4 * h, 512);
    bf16* dst = (bf16*)(ws + WS_ATT) + mix_off(n, hd * 64 + 4 * h, 1024);
    ATTN_FOR_CHUNKS(db, g4) { const u64 a = *(const u64*)(oc + (4 * db + g4) * 256), w = *(const u64*)(ow + (4 * db + g4) * 256);
        const float x0 = O[0][db][4 * g4 + 0] * inv + __uint_as_float((unsigned)a << 16) + __uint_as_float((unsigned)w << 16);
        const float x1 = O[0][db][4 * g4 + 1] * inv + __uint_as_float((unsigned)a & 0xffff0000u) + __uint_as_float((unsigned)w & 0xffff0000u);
        const float x2 = O[0][db][4 * g4 + 2] * inv + __uint_as_float((unsigned)(a >> 32) << 16) + __uint_as_float((unsigned)(w >> 32) << 16);
        const float x3 = O[0][db][4 * g4 + 3] * inv + __uint_as_float((unsigned)(a >> 32) & 0xffff0000u) + __uint_as_float((unsigned)(w >> 32) & 0xffff0000u);
        *(u64*)(dst + (4 * db + g4) * 256) = (u64)cvtpk(x0, x1) | ((u64)cvtpk(x2, x3) << 32); }
}
__device__ __forceinline__ float other_half(float x, int h) { auto rr = __builtin_amdgcn_permlane32_swap(__float_as_uint(x), __float_as_uint(x), false, false); return __uint_as_float(h ? rr[0] : rr[1]); }
__device__ __forceinline__ int other_half_i(int x, int h) { auto rr = __builtin_amdgcn_permlane32_swap((unsigned)x, (unsigned)x, false, false); return (int)(h ? rr[0] : rr[1]); }
template <bool MASK>
__device__ __forceinline__ void cmp_scores(f32x16& p0, f32x16& p1, const LAS unsigned char* kt, const bf16x8v (&Qf)[4], float b0, float s1, int cl, int nvis_l) {
    const float s8 = s1 * 8.f, s32 = s1 * 32.f;
    p0[0] = b0; p0[1] = p0[0] + s1; p0[2] = p0[1] + s1; p0[3] = p0[2] + s1;
#pragma unroll
    for (int reg = 4; reg < 16; ++reg) p0[reg] = p0[reg - 4] + s8;
#pragma unroll
    for (int reg = 0; reg < 16; ++reg) p1[reg] = p0[reg] + s32;
#pragma unroll
    for (int s = 0; s < 4; ++s) { const bf16x8v kf0 = *(const LAS bf16x8v*)(kt + s * 32), kf1 = *(const LAS bf16x8v*)(kt + 32 * 144 + s * 32);
        p0 = __builtin_amdgcn_mfma_f32_32x32x16_bf16(kf0, Qf[s], p0, 0, 0, 0); p1 = __builtin_amdgcn_mfma_f32_32x32x16_bf16(kf1, Qf[s], p1, 0, 0, 0); }
    if (MASK) {
#pragma unroll
        for (int reg = 0; reg < 16; ++reg) { const int c = cl + crow0(reg); p0[reg] = (c < nvis_l) ? p0[reg] : -INFINITY; p1[reg] = (c + 32 < nvis_l) ? p1[reg] : -INFINITY; } }
}
__device__ __forceinline__ void U_cmp(KP p_, int bg_, int u_) {
    const KP p = uni_kp(p_); const int bg = __builtin_amdgcn_readfirstlane(bg_), uu = __builtin_amdgcn_readfirstlane(u_);
    int tid_ = threadIdx.x; asm volatile("" : "+v"(tid_));
    const int tid = tid_, lane = tid & 63, wave = __builtin_amdgcn_readfirstlane(tid >> 6), r = lane & 31, h = lane >> 5;
    unsigned char* ws = p->ws; asm volatile("" : "+s"(ws)); LAS unsigned char* L = (LAS unsigned char*)lds_raw;
    const int b = bg >> 1, g = bg & 1, tw0 = 32 * (uu + 16 * wave), t_lane = tw0 + r;
    { const bf16* kc = (const bf16*)(ws + WS_KVCMP) + (size_t)bg * 256 * 64; const bf16* vc = kc + 16 * 256 * 64;
#pragma unroll
      for (int i = 0; i < 4; ++i) { const int ch = tid + 512 * i, row = ch >> 3, c8 = ch & 7;
          *(LAS u32x4*)(L + row * 144 + c8 * 16) = *(const u32x4*)(kc + row * 64 + c8 * 8); *(LAS u32x4*)(L + 36864 + row * 144 + c8 * 16) = *(const u32x4*)(vc + row * 64 + c8 * 8); } }
    __syncthreads();
    const int nvis_l = t_lane >= 31 ? ((t_lane - 31) >> 4) + 1 : 0, nvis_max = (tw0 >> 4) + 1, nvis_min = tw0 >= 31 ? ((tw0 - 31) >> 4) + 1 : 0, ntile = (nvis_max + 63) >> 6;
    const LAS unsigned char* kfrag = L + r * 144 + h * 16;
    const LAS unsigned char* vfrag = L + 36864 + (4 * h + ((lane & 15) >> 2)) * 144 + (16 * ((lane >> 4) & 1) + 4 * (lane & 3)) * 2;
    float imp[32];
#pragma unroll
    for (int e = 0; e < 32; ++e) imp[e] = 0.f;
    const float* gate = (const float*)(ws + WS_GATE) + ((size_t)b * T_ + t_lane) * 24;
#pragma unroll 1
    for (int hg = 0; hg < 4; ++hg) {
        const int hd = g * 4 + hg; const float s1 = alibi_slope(hd + 1, 8) * LOG2E * 16.f;
        const bf16* q = (const bf16*)(ws + WS_QN) + (size_t)(b * 8 + hd) * T_ * 64 + (t_lane >> 4) * 1024 + (t_lane & 15) * 32 + 8 * h;
        bf16x8v Qf[4];
#pragma unroll
        for (int s = 0; s < 4; ++s) Qf[s] = *(const bf16x8v*)(q + (s >> 1) * 512 + (s & 1) * 16);
        float m = -1e30f, lsum = 0.f;
#pragma unroll 1
        for (int jt = 0; jt < ntile; ++jt) {
            f32x16 p0, p1; const float b0 = s1 * (float)(64 * jt + 4 * h - nvis_max);
            if (64 * jt + 63 >= nvis_min) cmp_scores<true>(p0, p1, kfrag + jt * (64 * 144), Qf, b0, s1, 64 * jt + 4 * h, nvis_l);
            else cmp_scores<false>(p0, p1, kfrag + jt * (64 * 144), Qf, b0, s1, 64 * jt + 4 * h, nvis_l);
            float mt = fmaxf(p0[0], p1[0]);
#pragma unroll
            for (int reg = 1; reg < 16; ++reg) mt = fmaxf(mt, fmaxf(p0[reg], p1[reg]));
            mt = swap_max(mt);
            const float mn = fmaxf(m, mt); float rs = 0.f;
#pragma unroll
            for (int reg = 0; reg < 16; ++reg) rs += __builtin_amdgcn_exp2f(p0[reg] - mn) + __builtin_amdgcn_exp2f(p1[reg] - mn);
            lsum = lsum * __builtin_amdgcn_exp2f(m - mn) + rs; m = mn;
        }
        const float lt = swap_sum(lsum), inv = lt > 0.f ? 1.f / lt : 0.f;
        f32x16 O0, O1;
#pragma unroll
        for (int i = 0; i < 16; ++i) { O0[i] = 0.f; O1[i] = 0.f; }
        float carry = 0.f;
#pragma unroll
        for (int jt = 0; jt < 4; ++jt) if (jt < ntile) {
            f32x16 p0, p1; const float b0 = s1 * (float)(64 * jt + 4 * h - nvis_max);
            if (64 * jt + 63 >= nvis_min) cmp_scores<true>(p0, p1, kfrag + jt * (64 * 144), Qf, b0, s1, 64 * jt + 4 * h, nvis_l);
            else cmp_scores<false>(p0, p1, kfrag + jt * (64 * 144), Qf, b0, s1, 64 * jt + 4 * h, nvis_l);
#pragma unroll
            for (int reg = 0; reg < 16; ++reg) { p0[reg] = __builtin_amdgcn_exp2f(p0[reg] - m) * inv; p1[reg] = __builtin_amdgcn_exp2f(p1[reg] - m) * inv; }
            float cv[8];
#pragma unroll
            for (int g4 = 0; g4 < 4; ++g4) { const float h0 = 0.5f * p0[4 * g4 + 3], h1 = 0.5f * p1[4 * g4 + 3];
                imp[jt * 8 + g4] += ((p0[4 * g4] + p0[4 * g4 + 1]) + p0[4 * g4 + 2]) + h0; imp[jt * 8 + 4 + g4] += ((p1[4 * g4] + p1[4 * g4 + 1]) + p1[4 * g4 + 2]) + h1;
                cv[g4] = h0; cv[4 + g4] = h1; }
            float prev = carry;
#pragma unroll
            for (int k = 0; k < 8; ++k) { const float sv = other_half(cv[k], h); imp[jt * 8 + k] += h ? sv : prev; prev = sv; }
            carry = prev;
            const bf16x8v pa0 = pack8(p0, 0), pa1 = pack8(p0, 8), pa2 = pack8(p1, 0), pa3 = pack8(p1, 8);
            const LAS unsigned char* vb = vfrag + jt * (64 * 144);
#pragma unroll
            for (int ks = 0; ks < 4; ++ks) { const bf16x8v pa = ks == 0 ? pa0 : ks == 1 ? pa1 : ks == 2 ? pa2 : pa3;
                { const s16x4 lo = tr_read(vb + ks * (16 * 144)), hi = tr_read(vb + ks * (16 * 144) + 8 * 144); const bf16x8v vf = {lo[0], lo[1], lo[2], lo[3], hi[0], hi[1], hi[2], hi[3]};
                  O0 = __builtin_amdgcn_mfma_f32_32x32x16_bf16(vf, pa, O0, 0, 0, 0); }
                { const s16x4 lo = tr_read(vb + ks * (16 * 144) + 64), hi = tr_read(vb + ks * (16 * 144) + 64 + 8 * 144); const bf16x8v vf = {lo[0], lo[1], lo[2], lo[3], hi[0], hi[1], hi[2], hi[3]};
                  O1 = __builtin_amdgcn_mfma_f32_32x32x16_bf16(vf, pa, O1, 0, 0, 0); } }
        }
        const float gt = gate[hd * 3 + 0];
        bf16* dst = (bf16*)(ws + WS_OCMP) + mix_off((size_t)b * T_ + t_lane, hd * 64 + 4 * h, 512);
#pragma unroll
        for (int g4 = 0; g4 < 4; ++g4) {
            *(u64*)(dst + g4 * 256) = (u64)cvtpk(O0[4 * g4 + 0] * gt, O0[4 * g4 + 1] * gt) | ((u64)cvtpk(O0[4 * g4 + 2] * gt, O0[4 * g4 + 3] * gt) << 32);
            *(u64*)(dst + (4 + g4) * 256) = (u64)cvtpk(O1[4 * g4 + 0] * gt, O1[4 * g4 + 1] * gt) | ((u64)cvtpk(O1[4 * g4 + 2] * gt, O1[4 * g4 + 3] * gt) << 32); }
    }
    const int cur = tw0 >> 6; u64 mask;
    if (cur <= 15) mask = (1ull << (cur + 1)) - 1ull;
    else {
        mask = 1ull | (1ull << cur) | (1ull << (cur - 1));
#pragma unroll
        for (int e = 0; e < 32; ++e) { const int j = 2 * e + h; if (j > cur || j == 0 || j >= cur - 1) imp[e] = -INFINITY; }
#pragma unroll 1
        for (int round = 0; round < 13; ++round) {
            float bv = imp[0]; int be = 0;
#pragma unroll
            for (int e = 1; e < 32; ++e) if (imp[e] > bv) { bv = imp[e]; be = e; }
            const int bj = 2 * be + h; const float ov = other_half(bv, h); const int oj = other_half_i(bj, h);
            const bool mine = bv > ov || (bv == ov && bj < oj);
            mask |= 1ull << (mine ? bj : oj);
#pragma unroll
            for (int e = 0; e < 32; ++e) imp[e] = (mine && e == be) ? -INFINITY : imp[e];
        }
    }
    if (h == 0) ((u64*)(ws + WS_SEL))[(size_t)bg * T_ + t_lane] = mask;
    __syncthreads();
}
__device__ __forceinline__ int fetch_unit(KP p, int qidx) {
    volatile LAS unsigned* slot = (volatile LAS unsigned*)((LAS unsigned char*)lds_raw + MISC_OFF) + 16;
    __syncthreads();
    int t0_ = threadIdx.x; asm volatile("" : "+v"(t0_));
    if (t0_ == 0) *slot = __hip_atomic_fetch_add((unsigned*)(p->ws + WS_CTL) + CW_QUEUE + 64 * qidx, 1u, __ATOMIC_RELAXED, __HIP_MEMORY_SCOPE_AGENT);
    __syncthreads();
    return (int)__builtin_amdgcn_readfirstlane(*slot);
}
__device__ __forceinline__ void P_cmp1_mfma(int l_) { const KP p = (KP)__builtin_amdgcn_kernarg_segment_ptr(); int l = l_; asm volatile("" : "+s"(l));
    unsigned char* ws = p->ws; asm volatile("" : "+s"(ws)); const int c = launder_s((int)blockIdx.x), kv = c >> 4, pm = c & 15;
    OneUnitOrder S; S.has = c < 32; S.u.pm = pm; S.u.pn = kv;
    S.u.a = (const char*)(ws + WS_KV6 + (size_t)kv * KV6_STRIDE) + (size_t)pm * 256 * 1024 * 2; S.u.b = (const char*)((const bf16*)(ws + WS_W1_T) + ((size_t)l * 2 + kv) * 256 * 2048); S.u.b2 = S.u.b;
    const pg8::Gemm g{1024, 2048, 2048, 32, 0, 0};
    const EpiCmpH E{(bf16*)(ws + WS_HC), (const float*)(ws + WS_BIAS1) + l * 512};
    pg8::gemm_phase<EpiCmpH, OneUnitOrder, false, true>((LAS unsigned char*)lds_raw, g, S, E);
}
__device__ __forceinline__ void P_cmp2_mfma(int l_) { const KP p = (KP)__builtin_amdgcn_kernarg_segment_ptr(); int l = l_; asm volatile("" : "+s"(l));
    unsigned char* ws = p->ws; asm volatile("" : "+s"(ws)); const int c = launder_s((int)blockIdx.x), kv = c >> 4, pm = c & 15;
    OneUnitOrder S; S.has = c < 32; S.u.pm = pm; S.u.pn = kv;
    S.u.a = (const char*)((const bf16*)(ws + WS_HC) + ((size_t)kv * 4096 + pm * 256) * 256); S.u.b = (const char*)((const bf16*)(ws + WS_W2_T) + ((size_t)l * 2 + kv) * 64 * 256); S.u.b2 = S.u.b;
    const pg8::Gemm g{256, 256, 256, 4, 0, 0};
    const EpiCmpOut E{(bf16*)(ws + WS_KVCMP)};
    pg8::gemm_phase<EpiCmpOut, OneUnitOrder, false, true>((LAS unsigned char*)lds_raw, g, S, E);
}
__device__ __forceinline__ void P_moe_scatter(KP p_, int l_) { const KP p = uni_kp(p_); const int l = __builtin_amdgcn_readfirstlane(l_); const Ctx c = make_ctx(p); unsigned char* ws = p->ws;
    const unsigned* cnt = (const unsigned*)(ws + WS_CTL) + CW_MOECNT + l * MOE_LS;
    moe_build_tables(cnt, c.tid);
    const LAS int* T = (const LAS int*)((LAS unsigned char*)lds_raw + TBL_OFF);
    const unsigned* info = (const unsigned*)(ws + WS_ROUTE + RT_INFO); const float* tw = (const float*)(ws + WS_ROUTE + RT_W);
    int* rowtok = (int*)(ws + WS_ROUTE + RT_ROWTOK); float* roww = (float*)(ws + WS_ROUTE + RT_ROWW);
    bf16* xs = (bf16*)(ws + WS_XS); const bf16* x = (const bf16*)(ws + WS_HN); const float* gain = p->in[14] + (size_t)l * D_; const float* rstdv = (const float*)(ws + WS_ROUTE + RT_RSTD);
    { constexpr int RB = 4; float gg[2][8];
#pragma unroll
      for (int j = 0; j < 2; ++j) { const f32x4 a = ((const f32x4*)gain)[2 * c.lane + 128 * j], b2 = ((const f32x4*)gain)[2 * c.lane + 128 * j + 1]; gg[j][0] = a.x; gg[j][1] = a.y; gg[j][2] = a.z; gg[j][3] = a.w; gg[j][4] = b2.x; gg[j][5] = b2.y; gg[j][6] = b2.z; gg[j][7] = b2.w; }
      for (int row0 = c.gw * RB; row0 < NT; row0 += c.ngw * RB) {
        u32x4 vv[RB][2];
#pragma unroll
        for (int q = 0; q < RB; ++q)
#pragma unroll
            for (int j = 0; j < 2; ++j) vv[q][j] = ((const u32x4*)(x + (size_t)(row0 + q) * D_))[c.lane + 64 * j];
#pragma unroll
        for (int q = 0; q < RB; ++q) { const int row = row0 + q;
            const unsigned v = info[row]; const int cls = (int)(v >> 24), rank = (int)(v & 0xffffffu); const size_t dest = (size_t)T[cls] * 256 + rank; const float r = rstdv[row];
#pragma unroll
            for (int j = 0; j < 2; ++j) { float f[8]; unpack8(vv[q][j], f); u32x4 o; o.x = pk2(f[0] * r * gg[j][0], f[1] * r * gg[j][1]); o.y = pk2(f[2] * r * gg[j][2], f[3] * r * gg[j][3]); o.z = pk2(f[4] * r * gg[j][4], f[5] * r * gg[j][5]); o.w = pk2(f[6] * r * gg[j][6], f[7] * r * gg[j][7]);
                ((u32x4*)(xs + dest * D_))[c.lane + 64 * j] = o; }
            if (c.lane == 0) { rowtok[dest] = row; roww[2 * dest] = tw[2 * row]; roww[2 * dest + 1] = tw[2 * row + 1]; } }
      } }
    for (int cls = c.bid; cls < 112; cls += c.G) { const int n = (int)cnt[cls * MOE_CS], end = (int)((cnt[cls * MOE_CS] + 255u) >> 8) * 256; const size_t base = (size_t)T[cls] * 256;
        for (int r = n + c.tid; r < end; r += NTHREADS) rowtok[base + r] = -1; }
}
__device__ __forceinline__ void P_moe_g1(int l_) { const KP p = (KP)__builtin_amdgcn_kernarg_segment_ptr(); int l = l_; asm volatile("" : "+s"(l));
    unsigned char* ws = p->ws; asm volatile("" : "+s"(ws));
    { int t0_ = threadIdx.x; asm volatile("" : "+v"(t0_)); moe_build_tables((const unsigned*)(ws + WS_CTL) + CW_MOECNT + l * MOE_LS, t0_); }
    const MoeOrder1 S{(const char*)(ws + WS_XS), (const char*)((const bf16*)(ws + WS_WGU_T) + (size_t)l * NEXP * 512 * D_), (int)gridDim.x, launder_s((int)blockIdx.x)};
    const pg8::Gemm g{D_, D_, D_, D_ / 64, 0, 0};
    const EpiMoeH E{(bf16*)(ws + WS_HB), (const float*)(ws + WS_ROUTE + RT_ROWW)};
    pg8::gemm_phase<EpiMoeH, MoeOrder1, true, true>((LAS unsigned char*)lds_raw, g, S, E);
}
__device__ __forceinline__ void P_moe_g2(int l_) { const KP p = (KP)__builtin_amdgcn_kernarg_segment_ptr(); int l = l_; asm volatile("" : "+s"(l));
    unsigned char* ws = p->ws; asm volatile("" : "+s"(ws));
    { int t0_ = threadIdx.x; asm volatile("" : "+v"(t0_)); moe_build_tables((const unsigned*)(ws + WS_CTL) + CW_MOECNT + l * MOE_LS, t0_); }
    const MoeOrder2 S{(const char*)(ws + WS_HB), (const char*)((const bf16*)(ws + WS_WD_T) + (size_t)l * NEXP * D_ * DEXP), (int)gridDim.x, launder_s((int)blockIdx.x)};
    const pg8::Gemm g{512, DEXP, 512, 4, 16, 16};
    const EpiMoeOut E{(bf16*)(ws + WS_HN), (const int*)(ws + WS_ROUTE + RT_ROWTOK)};
    pg8::gemm_phase<EpiMoeOut, MoeOrder2, true, true>((LAS unsigned char*)lds_raw, g, S, E);
}
__device__ __forceinline__ void P_norm1(KP p_, int l_) { const KP p = uni_kp(p_); const int l = __builtin_amdgcn_readfirstlane(l_); const Ctx c = make_ctx(p); const Bufs b = make_bufs(p->ws);
    if (l == 0) { const int i = c.bid * NTHREADS + c.tid; if (i < L_ * 2 * 256) { const float* part = (const float*)(p->ws + WS_B1PART) + (size_t)(i >> 8) * 128 * 256 + (i & 255); float a = 0.f;
        for (int k = 0; k < 128; ++k) a += part[(size_t)k * 256]; ((float*)(p->ws + WS_BIAS1))[i] = a; } }
    if (l == 0) ph_norm_bf16(c, p->in[0], p->in[1], (bf16*)p->out, (bf16*)(p->ws + WS_HN)); else ph_norm_bf16_from_bf16(c, (const bf16*)(p->ws + WS_HN), p->in[1] + (size_t)l * D_, (bf16*)p->out); }
__device__ __noinline__ void P_inproj(KP p_, int l_) { const KP p = uni_kp(p_); const int l = __builtin_amdgcn_readfirstlane(l_); const Ctx c = make_ctx(p); const Bufs b = make_bufs(p->ws);
    InProjOut o{b.QN, b.KV6, b.FQ, b.DQ, b.DV, b.GATE, b.FL, p->in[3] + l * 24, p->in[4] + l * 4};
    const bf16* A = b.HN;
    naive_gemm(c, NT, D_IN, D_, [=](int r, int k) { return bf2f(A[(size_t)r * D_ + k]); }, p->in[2] + (size_t)l * D_ * D_IN, D_IN,
               [=](int r, int col, float v) { inproj_store(o, r, col, v); }); }
__device__ __noinline__ void P_cmp1(KP p_, int l_, int kv_) { const KP p = uni_kp(p_); const int l = __builtin_amdgcn_readfirstlane(l_), kv = __builtin_amdgcn_readfirstlane(kv_); const Ctx c = make_ctx(p); const Bufs b = make_bufs(p->ws);
    const bf16* src = kv == 0 ? b.KC : b.VC; const float* pe = p->in[kv == 0 ? 5 : 8] + (size_t)l * 2048; bf16* hc = b.HC + (size_t)kv * 4096 * 256;
    naive_gemm(c, 4096, 256, 2048, [=](int r, int k) { return bf2f(src[(size_t)r * 1024 + k]) + pe[k]; }, p->in[kv == 0 ? 6 : 9] + (size_t)l * 2048 * 256, 256,
               [=](int r, int col, float v) { hc[(size_t)r * 256 + col] = (bf16)f2bf(gelu_tanh(v)); }); }
__device__ __noinline__ void P_cumsum(KP p_, int l_) { const KP p = uni_kp(p_); const int l = __builtin_amdgcn_readfirstlane(l_); const Ctx c = make_ctx(p); const Bufs b = make_bufs(p->ws); ph_cumsum(c, b.FL); }
__device__ __noinline__ void P_cmp2(KP p_, int l_, int kv_) { const KP p = uni_kp(p_); const int l = __builtin_amdgcn_readfirstlane(l_), kv = __builtin_amdgcn_readfirstlane(kv_); const Ctx c = make_ctx(p); const Bufs b = make_bufs(p->ws);
    const bf16* hc = b.HC + (size_t)kv * 4096 * 256; bf16* dst = kv == 0 ? b.KCMP : b.VCMP;
    naive_gemm(c, 4096, 64, 256, [=](int r, int k) { return bf2f(hc[(size_t)r * 256 + k]); }, p->in[kv == 0 ? 7 : 10] + (size_t)l * 256 * 64, 64,
               [=](int r, int col, float v) { dst[(size_t)r * 64 + col] = (bf16)f2bf((r & 255) == 255 ? 0.f : v); }); }
__device__ __noinline__ void P_win(KP p_, int l_) { const KP p = uni_kp(p_); const int l = __builtin_amdgcn_readfirstlane(l_); const Ctx c = make_ctx(p); const Bufs b = make_bufs(p->ws); ph_win_attn(c, b.QN, b.KW, b.VW, b.GATE, b.OWIN); }
__device__ __noinline__ void P_fox(KP p_, int l_) { const KP p = uni_kp(p_); const int l = __builtin_amdgcn_readfirstlane(l_); const Ctx c = make_ctx(p); const Bufs b = make_bufs(p->ws); ph_fox_attn(c, b.FQ, b.FK, b.FV, b.FL, b.ATT); }
__device__ __noinline__ void P_diff(KP p_, int l_) { const KP p = uni_kp(p_); const int l = __builtin_amdgcn_readfirstlane(l_); const Ctx c = make_ctx(p); const Bufs b = make_bufs(p->ws);
    ph_diff_attn(c, b.DQ, b.DK, b.DV, p->in[11] + (size_t)l * 128, p->in[12] + (size_t)l * 64, lambda_init_of(l), b.ATT); }
__device__ __noinline__ void P_cmpattn(KP p_, int l_) { const KP p = uni_kp(p_); const int l = __builtin_amdgcn_readfirstlane(l_); const Ctx c = make_ctx(p); const Bufs b = make_bufs(p->ws); ph_cmp_attn(c, b.QN, b.KCMP, b.VCMP, b.GATE, b.SEL, b.OCMP); }
__device__ __noinline__ void P_slc(KP p_, int l_) { const KP p = uni_kp(p_); const int l = __builtin_amdgcn_readfirstlane(l_); const Ctx c = make_ctx(p); const Bufs b = make_bufs(p->ws); ph_slc_attn(c, b.QN, b.KS, b.VS, b.GATE, b.SEL, b.OCMP, b.OWIN, b.ATT); }
__device__ __noinline__ void P_outproj(KP p_, int l_) { const KP p = uni_kp(p_); const int l = __builtin_amdgcn_readfirstlane(l_); const Ctx c = make_ctx(p); const Bufs b = make_bufs(p->ws);
    const bf16* A = b.ATT; float* xo = p->out; const float* xin = (l == 0) ? p->in[0] : p->out;
    naive_gemm(c, NT, D_, D_, [=](int r, int k) { return bf2f(A[(size_t)r * D_ + k]); }, p->in[13] + (size_t)l * D_ * D_, D_,
               [=](int r, int col, float v) { xo[(size_t)r * D_ + col] = xin[(size_t)r * D_ + col] + v; }); }
__device__ __forceinline__ void P_route3(int l_, int cbank) { const KP p = (KP)__builtin_amdgcn_kernarg_segment_ptr(); int l = l_; asm volatile("" : "+s"(l));
    int tid_ = threadIdx.x; asm volatile("" : "+v"(tid_));
    const int tid = tid_, lane = tid & 63, wave = __builtin_amdgcn_readfirstlane(tid >> 6), r = lane & 31, h = lane >> 5, kh = wave >> 2, wr = wave & 3;
    unsigned char* ws = p->ws; asm volatile("" : "+s"(ws)); const bf16* x = (const bf16*)(ws + WS_HN);
    const float* WR = (const float*)(ws + WS_WR) + (size_t)l * D_ * 64;
    LAS float* XT = (LAS float*)lds_raw + wave * (32 * 36);
    LAS float* WT = (LAS float*)lds_raw + 8 * 32 * 36 + kh * (2 * 32 * 64);
    LAS float* PL = (LAS float*)lds_raw + 8 * 32 * 36 + 2 * 2 * 32 * 64;
    LAS float* SS = PL + 2 * 128 * 40;
    const float* bgrp = p->in[16] + l * 4; const float* bexp = p->in[18] + l * 32;
    unsigned* cnt = (unsigned*)(ws + WS_CTL) + CW_MOECNT + l * MOE_LS + cbank;
    LAS unsigned* HIST = (LAS unsigned*)(SS + 2 * 128 * 2);
    for (int grp = launder_s((int)blockIdx.x); grp < NT / 128; grp += (int)gridDim.x) {
        const int row0 = grp * 128 + wr * 32;
        if (tid < 112) HIST[tid] = 0u;
        f32x16 acc0, acc1; float ss = 0.f;
#pragma unroll
        for (int i = 0; i < 16; ++i) { acc0[i] = 0.f; acc1[i] = 0.f; }
        { const u32x4* xsrc = (const u32x4*)(x + (size_t)(row0 + r) * D_ + kh * 512 + 8 * h);
          const u32x4* wsrc = (const u32x4*)(ws + WS_WR) + ((size_t)l * 64 + kh * 32) * 256 + lane;
#pragma unroll 4
          for (int ks = 0; ks < 32; ++ks) {
              const u32x4 av = xsrc[2 * ks], b0h = wsrc[ks * 256], b0l = wsrc[ks * 256 + 64], b1h = wsrc[ks * 256 + 128], b1l = wsrc[ks * 256 + 192];
              { float f_[8]; unpack8(av, f_);
#pragma unroll
                for (int e = 0; e < 8; ++e) ss = fmaf(f_[e], f_[e], ss); }
              const bf16x8v A = __builtin_bit_cast(bf16x8v, av);
              acc0 = __builtin_amdgcn_mfma_f32_32x32x16_bf16(A, __builtin_bit_cast(bf16x8v, b0h), acc0, 0, 0, 0); acc1 = __builtin_amdgcn_mfma_f32_32x32x16_bf16(A, __builtin_bit_cast(bf16x8v, b1h), acc1, 0, 0, 0);
              acc0 = __builtin_amdgcn_mfma_f32_32x32x16_bf16(A, __builtin_bit_cast(bf16x8v, b0l), acc0, 0, 0, 0); acc1 = __builtin_amdgcn_mfma_f32_32x32x16_bf16(A, __builtin_bit_cast(bf16x8v, b1l), acc1, 0, 0, 0);
          } }
#pragma unroll
        for (int reg = 0; reg < 16; ++reg) { const int row = wr * 32 + crow0(reg) + 4 * h; PL[(kh * 128 + row) * 40 + r] = acc0[reg]; if (r < 4) PL[(kh * 128 + row) * 40 + 32 + r] = acc1[reg]; }
        SS[(kh * 128 + wr * 32 + r) * 2 + h] = ss;
        __syncthreads();
        int cls = 0; unsigned lrank = 0u; float wlo = 0.f, whi = 0.f, rstd = 0.f;
        if (tid < 128) {
            float lg[36];
#pragma unroll
            for (int cidx = 0; cidx < 36; ++cidx) lg[cidx] = PL[tid * 40 + cidx] + PL[(128 + tid) * 40 + cidx];
            const float sq = (SS[tid * 2] + SS[tid * 2 + 1]) + (SS[(128 + tid) * 2] + SS[(128 + tid) * 2 + 1]);
            rstd = rsqrtf(sq * (1.f / D_) + EPS);
            float gl[4]; int grp_i = 0;
#pragma unroll
            for (int q = 0; q < 4; ++q) gl[q] = lg[q] * rstd + bgrp[q];
            float gm = gl[0];
#pragma unroll
            for (int q = 1; q < 4; ++q) if (gl[q] > gm) { gm = gl[q]; grp_i = q; }
            float gs = 0.f;
#pragma unroll
            for (int q = 0; q < 4; ++q) gs += __expf(gl[q] - gm);
            const float grp_gate = 1.f / gs;
            float el[8];
#pragma unroll
            for (int q = 0; q < 8; ++q) { float v = lg[4 + q]; float bb = bexp[q];
                if (grp_i == 1) { v = lg[12 + q]; bb = bexp[8 + q]; } else if (grp_i == 2) { v = lg[20 + q]; bb = bexp[16 + q]; } else if (grp_i == 3) { v = lg[28 + q]; bb = bexp[24 + q]; }
                el[q] = v * rstd + bb; }
            int i0 = 0; float v0 = el[0];
#pragma unroll
            for (int q = 1; q < 8; ++q) if (el[q] > v0) { v0 = el[q]; i0 = q; }
            int i1 = -1; float v1 = -INFINITY;
#pragma unroll
            for (int q = 0; q < 8; ++q) if (q != i0 && el[q] > v1) { v1 = el[q]; i1 = q; }
            const float e1 = __expf(v1 - v0), den = 1.f + e1, w0 = grp_gate / den, w1 = grp_gate * e1 / den;
            const int lo = i0 < i1 ? i0 : i1, hi = i0 < i1 ? i1 : i0; cls = grp_i * 28 + lo * 8 - (lo * (lo + 1)) / 2 + (hi - lo - 1);
            wlo = i0 < i1 ? w0 : w1; whi = i0 < i1 ? w1 : w0;
            lrank = __hip_atomic_fetch_add(HIST + cls, 1u, __ATOMIC_RELAXED, __HIP_MEMORY_SCOPE_WORKGROUP);
        }
        __syncthreads();
        if (tid < 112) { const unsigned n = HIST[tid]; if (n) HIST[112 + tid] = __hip_atomic_fetch_add(cnt + tid * MOE_CS, n, __ATOMIC_RELAXED, __HIP_MEMORY_SCOPE_AGENT); }
        __syncthreads();
        if (tid < 128) {
            const unsigned rank = HIST[112 + cls] + lrank;
            const int row = grp * 128 + tid;
            ((unsigned*)(ws + WS_ROUTE + RT_INFO))[row] = ((unsigned)cls << 24) | rank;
            ((float*)(ws + WS_ROUTE + RT_W))[2 * row] = wlo; ((float*)(ws + WS_ROUTE + RT_W))[2 * row + 1] = whi;
            ((float*)(ws + WS_ROUTE + RT_RSTD))[row] = rstd;
        }
        __syncthreads();
    }
}
typedef float f32x8 __attribute__((ext_vector_type(8)));
__device__ __forceinline__ void P_route2(int l_, int cbank) { const KP p = (KP)__builtin_amdgcn_kernarg_segment_ptr(); int l = l_; asm volatile("" : "+s"(l));
    int tid_ = threadIdx.x; asm volatile("" : "+v"(tid_));
    const int tid = tid_, lane = tid & 63, wave = __builtin_amdgcn_readfirstlane(tid >> 6);
    unsigned char* ws = p->ws; asm volatile("" : "+s"(ws)); const float* x = p->out;
    const float* WR = (const float*)(ws + WS_WR) + (size_t)l * D_ * 40;
    LAS float* xt = (LAS float*)lds_raw + wave * (64 * 36);
    LAS float* part = (LAS float*)lds_raw;
    const float* bgrp = p->in[16] + l * 4; const float* bexp = p->in[18] + l * 32;
    unsigned* cnt = (unsigned*)(ws + WS_CTL) + CW_MOECNT + l * 128 + cbank;
    for (int grp = launder_s((int)blockIdx.x); grp < NT / 128; grp += (int)gridDim.x) {
        const int row0 = grp * 128 + (wave >> 2) * 64, kq = wave & 3;
        float acc[40]; float ss = 0.f;
#pragma unroll
        for (int cidx = 0; cidx < 40; ++cidx) acc[cidx] = 0.f;
#pragma unroll 1
        for (int kc = 0; kc < 8; ++kc) {
            const int k0 = kq * 256 + kc * 32;
#pragma unroll
            for (int i = 0; i < 8; ++i) { const int row = i * 8 + (lane >> 3), c4 = (lane & 7) * 4; *(LAS f32x4*)(xt + row * 36 + c4) = *(const f32x4*)(x + (size_t)(row0 + row) * D_ + k0 + c4); }
            float xr[32];
#pragma unroll
            for (int j = 0; j < 8; ++j) { const f32x4 t = *(const LAS f32x4*)(xt + lane * 36 + 4 * j); xr[4 * j] = t.x; xr[4 * j + 1] = t.y; xr[4 * j + 2] = t.z; xr[4 * j + 3] = t.w; }
            const float* wk = WR + (size_t)k0 * 40;
#pragma unroll
            for (int kk = 0; kk < 32; ++kk) {
                f32x8 w0, w1, w2, w3, w4;
                asm volatile("s_load_dwordx8 %0, %5, %6\n\ts_load_dwordx8 %1, %5, %7\n\ts_load_dwordx8 %2, %5, %8\n\ts_load_dwordx8 %3, %5, %9\n\ts_load_dwordx8 %4, %5, %10\n\ts_waitcnt lgkmcnt(0)"
                             : "=&s"(w0), "=&s"(w1), "=&s"(w2), "=&s"(w3), "=&s"(w4) : "s"(wk), "i"(kk * 160), "i"(kk * 160 + 32), "i"(kk * 160 + 64), "i"(kk * 160 + 96), "i"(kk * 160 + 128) : "memory");
                const float xv = xr[kk]; ss = fmaf(xv, xv, ss);
#pragma unroll
                for (int e = 0; e < 8; ++e) { acc[e] = fmaf(xv, w0[e], acc[e]); acc[8 + e] = fmaf(xv, w1[e], acc[8 + e]); acc[16 + e] = fmaf(xv, w2[e], acc[16 + e]); acc[24 + e] = fmaf(xv, w3[e], acc[24 + e]); }
#pragma unroll
                for (int e = 0; e < 4; ++e) acc[32 + e] = fmaf(xv, w4[e], acc[32 + e]);
            }
        }
        __syncthreads();
#pragma unroll
        for (int cidx = 0; cidx < 36; ++cidx) part[(wave * 64 + lane) * 37 + cidx] = acc[cidx];
        part[(wave * 64 + lane) * 37 + 36] = ss;
        __syncthreads();
        if (tid < 128) {
            const int rg = tid >> 6, rr = tid & 63; float lg[37];
#pragma unroll
            for (int cidx = 0; cidx < 37; ++cidx) lg[cidx] = ((part[((rg * 4 + 0) * 64 + rr) * 37 + cidx] + part[((rg * 4 + 1) * 64 + rr) * 37 + cidx]) + part[((rg * 4 + 2) * 64 + rr) * 37 + cidx]) + part[((rg * 4 + 3) * 64 + rr) * 37 + cidx];
            const float rstd = rsqrtf(lg[36] * (1.f / D_) + EPS);
            float gl[4]; int grp_i = 0;
#pragma unroll
            for (int q = 0; q < 4; ++q) gl[q] = lg[q] * rstd + bgrp[q];
            float gm = gl[0];
#pragma unroll
            for (int q = 1; q < 4; ++q) if (gl[q] > gm) { gm = gl[q]; grp_i = q; }
            float gs = 0.f;
#pragma unroll
            for (int q = 0; q < 4; ++q) gs += __expf(gl[q] - gm);
            const float grp_gate = 1.f / gs;
            float el[8];
#pragma unroll
            for (int q = 0; q < 8; ++q) { float v = lg[4 + q]; float bb = bexp[q];
                if (grp_i == 1) { v = lg[12 + q]; bb = bexp[8 + q]; } else if (grp_i == 2) { v = lg[20 + q]; bb = bexp[16 + q]; } else if (grp_i == 3) { v = lg[28 + q]; bb = bexp[24 + q]; }
                el[q] = v * rstd + bb; }
            int i0 = 0; float v0 = el[0];
#pragma unroll
            for (int q = 1; q < 8; ++q) if (el[q] > v0) { v0 = el[q]; i0 = q; }
            int i1 = -1; float v1 = -INFINITY;
#pragma unroll
            for (int q = 0; q < 8; ++q) if (q != i0 && el[q] > v1) { v1 = el[q]; i1 = q; }
            const float e1 = __expf(v1 - v0), den = 1.f + e1, w0 = grp_gate / den, w1 = grp_gate * e1 / den;
            const int lo = i0 < i1 ? i0 : i1, hi = i0 < i1 ? i1 : i0, cls = grp_i * 28 + lo * 8 - (lo * (lo + 1)) / 2 + (hi - lo - 1);
            const unsigned rank = __hip_atomic_fetch_add(cnt + cls, 1u, __ATOMIC_RELAXED, __HIP_MEMORY_SCOPE_AGENT);
            const int row = grp * 128 + tid;
            ((unsigned*)(ws + WS_ROUTE + RT_INFO))[row] = ((unsigned)cls << 24) | rank;
            ((float*)(ws + WS_ROUTE + RT_W))[2 * row] = i0 < i1 ? w0 : w1; ((float*)(ws + WS_ROUTE + RT_W))[2 * row + 1] = i0 < i1 ? w1 : w0;
            ((float*)(ws + WS_ROUTE + RT_RSTD))[row] = rstd;
        }
        __syncthreads();
    }
}
__device__ __noinline__ void P_route(KP p_, int l_) { const KP p = uni_kp(p_); const int l = __builtin_amdgcn_readfirstlane(l_); const Ctx c = make_ctx(p); const Bufs b = make_bufs(p->ws);
    ph_moe_route(c, p->out, p->in[14] + (size_t)l * D_, p->in[15] + (size_t)l * D_ * 4, p->in[16] + l * 4, p->in[17] + (size_t)l * D_ * 32, p->in[18] + l * 32, b.HN, (int*)(p->ws + WS_ROUTE + RT_INFO), (float*)(p->ws + WS_ROUTE + RT_W), (unsigned*)(p->ws + WS_CTL) + CW_MOECNT + l * 128); }
__device__ __noinline__ void P_moe(KP p_, int l_) { const KP p = uni_kp(p_); const int l = __builtin_amdgcn_readfirstlane(l_); const Ctx c = make_ctx(p); const Bufs b = make_bufs(p->ws);
    ph_moe_naive(c, b.HN, b.ROUTE_E, b.ROUTE_W, p->in[19] + (size_t)l * NEXP * D_ * DEXP, p->in[20] + (size_t)l * NEXP * D_ * DEXP, p->in[21] + (size_t)l * NEXP * DEXP * D_, p->out); }
__device__ __noinline__ void P_final(KP p_) { const KP p = uni_kp(p_); const Ctx c = make_ctx(p); ph_norm_final_from_bf16(c, (const bf16*)(p->ws + WS_HN), p->in[22], p->out); }
__device__ __forceinline__ void P_gridbar(KP p_) { const KP p = uni_kp(p_);
    XcdBarrier bar; bar.bar = (unsigned*)(p->ws + WS_CTL) + 4096; bar.x = xb_xcc_id(); bar.st = (volatile LAS unsigned*)((LAS unsigned char*)lds_raw + MISC_OFF) + 8;
    xcd_barrier(bar);
}

__global__ void __launch_bounds__(NTHREADS, 2) fwd_kernel(Params pp) {
    const KP p = (KP)__builtin_amdgcn_kernarg_segment_ptr();
    { volatile LAS unsigned* MISC = (volatile LAS unsigned*)((LAS unsigned char*)lds_raw + MISC_OFF); if (threadIdx.x < 32) MISC[threadIdx.x] = 0u; }
    __syncthreads();
    const int lo = p->ph_lo, hi = p->ph_hi;
    if (hi - lo > 1) (void)xcd_barrier_post((unsigned*)(p->ws + WS_CTL) + 4096, (volatile LAS unsigned*)((LAS unsigned char*)lds_raw + MISC_OFF) + 8);
#define IN(k) (lo <= (k) && (k) < hi)
#define SEAM(k) do { if (IN(k) && IN((k) + 1)) P_gridbar(p); } while (0)
    if (IN(0)) { for (int rep = 0; rep < REP_PRO; ++rep) { if (rep) P_gridbar(p); P_prologue(p); } }
    SEAM(0);
    for (int l = 0; l < L_; ++l) {
        const int P0 = 1 + l * PH_PER_LAYER;
        if (IN(P0 + 0)) { for (int rep = 0; rep < REP_NORM; ++rep) { if (rep) P_gridbar(p); P_norm1(p, l); } }
        SEAM(P0 + 0);
        if (IN(P0 + 1)) { for (int rep = 0; rep < REP_INPROJ; ++rep) { if (rep) P_gridbar(p); P_inproj_mfma(l); }
#ifdef REP_INDUMMY
            for (int rep = 0; rep < REP_INDUMMY; ++rep) { P_gridbar(p); P_inproj_dummy(l); }
#endif
        }
        SEAM(P0 + 1);
        if (IN(P0 + 3)) {
            P_cmp1_mfma(l);
            if (launder_s((int)blockIdx.x) < 32) { asm volatile("s_waitcnt vmcnt(0)" ::: "memory"); __builtin_amdgcn_fence(__ATOMIC_SEQ_CST, "agent"); asm volatile("s_waitcnt vmcnt(0)" ::: "memory"); }
            __syncthreads();
            P_cmp2_mfma(l);
            for (int rep = 0; rep < REP_ATT3; ++rep) { if (rep) P_gridbar(p);
            for (;;) { const int u = fetch_unit(p, l * 8 + 0 + 16 * rep); if (u >= 2048) break;
                if (u < 1024) { const int qb = 15 - (u >> 6), k = u & 63; if (k < 32) U_diff(p, k, qb, l); else U_fox(p, k - 32, qb, l); }
                else { const int w = u - 1024; U_win(p, w & 15, 63 - (w >> 4)); } } } }
        SEAM(P0 + 3);
        if (IN(P0 + 4)) { for (int rep = 0; rep < REP_CMP; ++rep) { if (rep) P_gridbar(p); for (int u = launder_s((int)blockIdx.x); u < 256; u += (int)gridDim.x) U_cmp(p, u & 15, u >> 4); } }
        SEAM(P0 + 4);
        if (IN(P0 + 5)) { for (int rep = 0; rep < REP_SLC; ++rep) { if (rep) P_gridbar(p); for (;;) { const int u = fetch_unit(p, l * 8 + 1 + 16 * rep); if (u >= 1024) break; U_slc(p, u & 15, 63 - (u >> 4)); } } }
        SEAM(P0 + 5);
        if (IN(P0 + 6)) P_outproj_mfma(l);
        SEAM(P0 + 6);
        if (IN(P0 + 7)) { for (int rep = 0; rep < REP_ROUTE; ++rep) { if (rep) P_gridbar(p); P_route3(l, REP_ROUTE - 1 - rep); } }
        SEAM(P0 + 7);
        if (IN(P0 + 8)) { for (int rep = 0; rep < REP_SCAT; ++rep) { if (rep) P_gridbar(p); P_moe_scatter(p, l); } }
        SEAM(P0 + 8);
        if (IN(P0 + 9)) { for (int rep = 0; rep < REP_G1; ++rep) { if (rep) P_gridbar(p); P_moe_g1(l); } }
        SEAM(P0 + 9);
        if (IN(P0 + 10)) P_moe_g2(l);
        SEAM(P0 + 10);
    }
    if (IN(1 + L_ * PH_PER_LAYER)) P_final(p);
#undef IN
#undef SEAM
}

extern "C" void kernel_launch(void* const* d_in, const int* in_sizes, int n_in, void* d_out, int out_size, void* d_ws, size_t ws_size, hipStream_t stream) {
    static int grid = 0;
    if (grid == 0) {
        if (n_in != 23 || out_size != NT * D_ || ws_size < WS_END) { fprintf(stderr, "kernel_launch: unexpected sizes n_in %d out %d ws %zu (need %zu)\n", n_in, out_size, ws_size, (size_t)WS_END); grid = -1; return; }
        int dev = 0, cus = 0, per_cu = 0;
        if (hipGetDevice(&dev) != hipSuccess || hipDeviceGetAttribute(&cus, hipDeviceAttributeMultiprocessorCount, dev) != hipSuccess) { grid = -1; return; }
        if (hipFuncSetAttribute((const void*)fwd_kernel, hipFuncAttributeMaxDynamicSharedMemorySize, LDS_BYTES) != hipSuccess) { fprintf(stderr, "kernel_launch: hipFuncSetAttribute failed\n"); grid = -1; return; }
        if (hipOccupancyMaxActiveBlocksPerMultiprocessor(&per_cu, (const void*)fwd_kernel, NTHREADS, LDS_BYTES) != hipSuccess || per_cu < 1) { fprintf(stderr, "kernel_launch: occupancy query says %d\n", per_cu); }
        (void)hipGetLastError();
        grid = cus;
    }
    if (grid < 0) return;
    (void)hipMemsetAsync((char*)d_ws + WS_CTL, 0, CTL_BYTES, stream);
    Params p{};
    for (int i = 0; i < 23; ++i) p.in[i] = (const float*)d_in[i];
    p.out = (float*)d_out; p.ws = (unsigned char*)d_ws;
#if N_LAUNCH_MODE == 0
    p.ph_lo = 0; p.ph_hi = N_PHASES;
    hipLaunchKernelGGL(fwd_kernel, dim3(grid), dim3(NTHREADS), LDS_BYTES, stream, p);
#else
    for (int k = 0; k < N_PHASES; ++k) { p.ph_lo = k; p.ph_hi = k + 1; hipLaunchKernelGGL(fwd_kernel, dim3(grid), dim3(NTHREADS), LDS_BYTES, stream, p); }
#endif
}
```

```cpp
#include <hip/hip_runtime.h>
#include <cstdio>
#include <cstdint>

#ifndef INPROJ_ALIGN
#define INPROJ_ALIGN true
#endif
#ifndef INPROJ_SP2
#define INPROJ_SP2 true
#endif
#ifndef REP_PRO
#define REP_PRO 1
#endif
#ifndef REP_ROUTE
#define REP_ROUTE 1
#endif
#ifndef REP_NORM
#define REP_NORM 1
#endif
#ifndef REP_INPROJ
#define REP_INPROJ 1
#endif
#ifndef REP_ATT3
#define REP_ATT3 1
#endif
#ifndef REP_CMP
#define REP_CMP 1
#endif
#ifndef REP_SLC
#define REP_SLC 1
#endif
#ifndef REP_SCAT
#define REP_SCAT 1
#endif
#ifndef REP_G1
#define REP_G1 1
#endif
#ifndef N_LAUNCH_MODE
#define N_LAUNCH_MODE 0
#endif

#define LAS __attribute__((address_space(3)))
#define GAS __attribute__((address_space(1)))
typedef unsigned short bf16;
typedef unsigned long long u64;
typedef float f32x4 __attribute__((ext_vector_type(4)));
typedef unsigned u32x4 __attribute__((ext_vector_type(4)));

constexpr int B_ = 8, T_ = 4096, D_ = 1024, NT = B_ * T_, L_ = 2;
constexpr int HD = 64, D_IN = 2844;
constexpr int N_CMP = 255, CMP_HID = 256;
constexpr int NEXP = 32, DEXP = 256;
constexpr float EPS = 1e-6f;
constexpr float LOG2E = 1.4426950408889634f;
constexpr int NWAVES = 8, NTHREADS = 512;

constexpr int C_NSAQ = 0, C_KV6 = 512, C_GATE = 1280, C_FQ = 1304, C_FF = 2072, C_DQ = 2076, C_DV = 2588;

constexpr size_t MiB = 1u << 20;
constexpr size_t WS_CTL = 0, CTL_BYTES = 1 * MiB;
constexpr size_t WS_QN = 1 * MiB;
constexpr size_t WS_KV6 = WS_QN + 32 * MiB;
constexpr size_t KV6_STRIDE = 8 * MiB + 64 * 1024;
constexpr size_t WS_FQKV = WS_KV6 + 6 * KV6_STRIDE;
constexpr size_t WS_DQK = WS_FQKV + 48 * MiB;
constexpr size_t WS_DV = WS_DQK + 32 * MiB;
constexpr size_t WS_GATE = WS_DV + 16 * MiB;
constexpr size_t WS_FL = WS_GATE + 3 * MiB;
constexpr size_t WS_HC = WS_FL + 1 * MiB;
constexpr size_t WS_KVCMP = WS_HC + 4 * MiB;
constexpr size_t WS_SEL = WS_KVCMP + 1 * MiB;
constexpr size_t WS_OCMP = WS_SEL + 1 * MiB;
constexpr size_t WS_OWIN = WS_OCMP + 32 * MiB;
constexpr size_t WS_HN = WS_OWIN + 32 * MiB;
constexpr size_t WS_ATT = WS_HN + 64 * MiB;
constexpr size_t WS_ROUTE = WS_ATT + 64 * MiB;
constexpr size_t WS_WIN_T = WS_ROUTE + 2 * MiB;
constexpr size_t WS_WOUT_T = WS_WIN_T + 12 * MiB;
constexpr size_t WS_WGU_T = WS_WOUT_T + 4 * MiB;
constexpr size_t WS_WD_T = WS_WGU_T + 64 * MiB;
constexpr size_t WS_W1_T = WS_WD_T + 32 * MiB;
constexpr size_t WS_W2_T = WS_W1_T + 4 * MiB;
constexpr size_t WS_BIAS1 = WS_W2_T + 512 * 1024;
constexpr size_t WS_WR = WS_BIAS1 + 512 * 1024;
constexpr size_t WS_B1PART = WS_WR + 512 * 1024;
constexpr size_t WS_END = WS_B1PART + 512 * 1024;
constexpr int MOE_MAXROWS = 61440;
constexpr size_t WS_XS = WS_QN;
constexpr size_t WS_HB = WS_OCMP;
static_assert(WS_XS + (size_t)MOE_MAXROWS * 2048 <= WS_DQK && WS_HB + (size_t)MOE_MAXROWS * 1024 <= WS_HN, "MoE aliases");
constexpr size_t RT_INFO = 0, RT_W = 128 * 1024, RT_ROWTOK = 384 * 1024, RT_ROWW = 640 * 1024, RT_RSTD = 1152 * 1024;
constexpr int CW_QUEUE = 16384, CW_MOECNT = 32768, CW_KN = 49152, MOE_CS = 32, MOE_LS = 4096;
constexpr int TBL_OFF = 131072 + 1024;
constexpr int NIN = 3072;

extern __shared__ __attribute__((aligned(16))) unsigned char lds_raw[];
__device__ __forceinline__ float bf2f(bf16 v) { return __uint_as_float(((unsigned)v) << 16); }
__device__ __forceinline__ unsigned f2bf(float f) { unsigned u = __float_as_uint(f); return (u + 0x7fffu + ((u >> 16) & 1u)) >> 16; }
__device__ __forceinline__ unsigned pk2(float lo, float hi) { return f2bf(lo) | (f2bf(hi) << 16); }
__device__ __forceinline__ float wave_sum(float v) {
#pragma unroll
    for (int o = 1; o < 64; o <<= 1) v += __shfl_xor(v, o);
    return v;
}
__device__ __forceinline__ float wave_max(float v) {
#pragma unroll
    for (int o = 1; o < 64; o <<= 1) v = fmaxf(v, __shfl_xor(v, o));
    return v;
}
__device__ __forceinline__ float shflx_f(float v, int o, int lane) { return __uint_as_float((unsigned)__builtin_amdgcn_ds_bpermute((lane ^ o) << 2, (int)__float_as_uint(v))); }
__device__ __forceinline__ unsigned shflx_u(unsigned v, int o, int lane) { return (unsigned)__builtin_amdgcn_ds_bpermute((lane ^ o) << 2, (int)v); }
__device__ __forceinline__ float wave_sum_l(float v, int lane) {
#pragma unroll
    for (int o = 1; o < 64; o <<= 1) v += shflx_f(v, o, lane);
    return v;
}
__device__ __forceinline__ int launder_s(int v) { asm volatile("" : "+s"(v)); return v; }
__device__ __forceinline__ float sigmoidf_(float x) { return 1.f / (1.f + __expf(-x)); }
__device__ __forceinline__ float log_sigmoidf_(float x) { return x >= 0.f ? -log1pf(__expf(-x)) : x - log1pf(__expf(x)); }
__device__ __forceinline__ float gelu_tanh(float x) { const float u = 0.7978845608028654f * (x + 0.044715f * x * x * x); return 0.5f * x * (1.f + tanhf(u)); }
__device__ __forceinline__ float alibi_slope(int idx1, int n) { return exp2f(-8.0f * (float)idx1 / (float)n); }

__device__ __forceinline__ constexpr int b64_off(int t, int d) { return ((t >> 4) * 2 + (d >> 5)) * 512 + (t & 15) * 32 + (d & 31); }
#define XB_TMO      128
#define XB_XCNT(j)  (256  + 64 * (j))
#define XB_XSUB(j)  (1280 + 64 * (j))
#define XB_XGEN(j)  (2304 + 64 * (j))
#define XB_TOP      3328
#define XB_TOPGEN   3392
#define XCD_BAR_WORDS 3456
#define XB_SPIN_CAP (1u << 25)
__device__ __forceinline__ unsigned xb_ld(unsigned* p)              { return __hip_atomic_load(p, __ATOMIC_RELAXED, __HIP_MEMORY_SCOPE_AGENT); }
__device__ __forceinline__ unsigned xb_add(unsigned* p, unsigned v) { return __hip_atomic_fetch_add(p, v, __ATOMIC_RELAXED, __HIP_MEMORY_SCOPE_AGENT); }
__device__ __forceinline__ unsigned xb_xcc_id() { return (unsigned)__builtin_amdgcn_s_getreg((3 << 11) | 20) & 0xFu; }
#define XB_SPIN(cond, bar) do { unsigned _sp = 0; while (cond) { __builtin_amdgcn_s_sleep(1); \
    if ((++_sp & 255u) == 0u) { if (xb_ld(&(bar)[XB_TMO])) break; if (_sp > XB_SPIN_CAP) { atomicAdd(&(bar)[XB_TMO], 1u); break; } } } } while (0)
struct XcdBarrier { unsigned* bar; unsigned x; volatile LAS unsigned* st; };
__device__ __forceinline__ XcdBarrier xcd_barrier_post(unsigned* bar, volatile LAS unsigned* st) {
    XcdBarrier b; b.bar = bar; b.x = xb_xcc_id(); b.st = st;
    if (threadIdx.x == 0) (void)xb_add(&bar[XB_XCNT(b.x)], 1u);
    return b;
}
__device__ __forceinline__ void xcd_barrier_complete(unsigned* bar, unsigned x, unsigned& nloc, unsigned& nx) {
    const unsigned G = gridDim.x * gridDim.y * gridDim.z;
    unsigned sum, cnt, mine, sp = 0u;
    for (;;) {
        sum = 0u; cnt = 0u; mine = 0u;
#pragma unroll
        for (unsigned j = 0; j < 16; ++j) { const unsigned c = xb_ld(&bar[XB_XCNT(j)]); sum += c; cnt += (c > 0u) ? 1u : 0u; mine = (j == x) ? c : mine; }
        if (sum == G) break;
        __builtin_amdgcn_s_sleep(1);
        if ((++sp & 255u) == 0u) { if (xb_ld(&bar[XB_TMO])) break; if (sp > XB_SPIN_CAP) { atomicAdd(&bar[XB_TMO], 1u); break; } }
    }
    nloc = mine > 0u ? mine : 1u; nx = cnt > 0u ? cnt : 1u;
}
__device__ __forceinline__ void xcd_barrier(const XcdBarrier& b) {
    asm volatile("s_waitcnt vmcnt(0)" ::: "memory");
    __syncthreads();
    if (threadIdx.x == 0) {
        unsigned* bar = b.bar;
        __builtin_amdgcn_s_waitcnt(0);
        unsigned nloc = b.st[0], nx = b.st[1];
        if (nloc == 0u) { xcd_barrier_complete(bar, b.x, nloc, nx); b.st[0] = nloc; b.st[1] = nx; }
        const unsigned old = xb_add(&bar[XB_XSUB(b.x)], 1u);
        const unsigned gen = old / nloc;
        if (old + 1u == (gen + 1u) * nloc) {
            __builtin_amdgcn_fence(__ATOMIC_RELEASE, "agent");
            asm volatile("s_waitcnt vmcnt(0)" ::: "memory");
            const unsigned og = xb_add(&bar[XB_TOP], 1u);
            const unsigned tg = og / nx;
            if (og + 1u == (tg + 1u) * nx) xb_add(&bar[XB_TOPGEN], 1u);
            else XB_SPIN(xb_ld(&bar[XB_TOPGEN]) == tg, bar);
            __builtin_amdgcn_fence(__ATOMIC_ACQUIRE, "agent");
            xb_add(&bar[XB_XGEN(b.x)], 1u);
            asm volatile("s_waitcnt vmcnt(0)" ::: "memory");
        } else {
            XB_SPIN(xb_ld(&bar[XB_XGEN(b.x)]) == gen, bar);
            __builtin_amdgcn_fence(__ATOMIC_ACQUIRE, "agent");
            asm volatile("s_waitcnt vmcnt(0)" ::: "memory");
        }
    }
    __syncthreads();
}

struct Params { const float* in[23]; float* out; unsigned char* ws; int ph_lo, ph_hi; };
constexpr int LDS_BYTES = 147456;
constexpr int MISC_OFF = 131072 + 320;

struct Ctx {
    LAS unsigned char* lds; int tid, lane, wave, bid, G, gw, ngw;
    const float* const* in; float* xcur; unsigned char* ws;
};

namespace pg8 {
#define PG8_LAS __attribute__((address_space(3)))
typedef unsigned short bf16_t;
typedef short bf16x8 __attribute__((ext_vector_type(8)));
typedef float f32x4 __attribute__((ext_vector_type(4)));
typedef unsigned u32x4 __attribute__((ext_vector_type(4)));
constexpr int BM = 256, BK = 64, HALF = 128, HTB = HALF * BK * 2  , STAGE_BYTES = 8 * HTB, NXCD = 8, WGM = 8;

__host__ __device__ __forceinline__ int lds_byte(int r, int c) { const int st = (r >> 4) * 2 + (c >> 5), rr = r & 15, cc = c & 31, ob = rr * 64 + cc * 2; return st * 1024 + (ob ^ (((ob >> 9) & 1) << 5)); }
__host__ __device__ __forceinline__ void stage_rc(int b, int& R, int& C) { const int st = b / 1024, sb = b % 1024, swz = sb ^ (((sb >> 9) & 1) << 5); R = (st >> 1) * 16 + swz / 64; C = (st & 1) * 32 + (swz % 64) / 2; }
__host__ __device__ __forceinline__ int perm32(int rho) { const int n = rho >> 4, i = rho & 15; return 8 * (i >> 2) + 4 * n + (i & 3); }

struct Unit { int pm, pn; const char* a; const char* b; const char* b2; };
struct Gemm { int lda, ldb, K, ksplit, arb, acb; };

__device__ __forceinline__ unsigned cvt_pk_bf16(float lo, float hi) { unsigned r; asm volatile("v_cvt_pk_bf16_f32 %0, %1, %2" : "=v"(r) : "v"(lo), "v"(hi)); return r; }
typedef float f32x2 __attribute__((ext_vector_type(2)));

template <class Epi, class Sched, bool ALIGN_EPI = false, bool SP2 = false>
__device__ __forceinline__ void gemm_phase(PG8_LAS unsigned char* lds, const Gemm g, const Sched& S, const Epi& E) {
    int tid_ = threadIdx.x; asm volatile("" : "+v"(tid_));
    const int tid = tid_, wid = __builtin_amdgcn_readfirstlane(tid >> 6), lane = tid & 63, wr = wid >> 2, wc = wid & 3, fr = lane & 15, fq = lane >> 4;
    const int K = g.K, nt = K / BK, ks = g.ksplit;
    unsigned voffA[2], voffB[2];
#pragma unroll
    for (int i = 0; i < 2; ++i) { int R, C; stage_rc(tid * 16 + i * 8192, R, C); const int Rb = Epi::PERM ? ((R & ~31) + perm32(R & 31)) : R;
        voffA[i] = g.arb ? (unsigned)(((R / g.arb) * (K / g.acb) + C / g.acb) * (g.arb * g.acb) + (R % g.arb) * g.acb + (C % g.acb)) * 2u : (unsigned)(R * g.lda + C) * 2u; voffB[i] = (unsigned)(Rb * g.ldb + C) * 2u; }
    const size_t kstep = (size_t)(BK * 2), kstepA = g.arb ? (size_t)(BK * g.arb * 2) : kstep;
    const size_t hsA = (size_t)HALF * (g.arb ? K : g.lda) * 2, hsB = (size_t)HALF * g.ldb * 2;
    const unsigned ldsw = (unsigned)wid * 1024u;
    const int aoff = lds_byte(wr * 64 + fr, fq * 8), boff = lds_byte(wc * 32 + fr, fq * 8);
#define PG8_SA(b, h) (((b) * 2 + (h)) * HTB)
#define PG8_SB(b, h) ((4 + (b) * 2 + (h)) * HTB)
#define PG8_STAGE(bufoff, gbase, voff) do { _Pragma("unroll") for (int _i = 0; _i < 2; ++_i) \
        __builtin_amdgcn_global_load_lds((const unsigned*)((const char*)(gbase) + (voff)[_i]), (PG8_LAS unsigned*)(lds + (bufoff) + ldsw + _i * 8192), 16, 0, 0); } while (0)
#define PG8_LDA(dst, b, h) do { _Pragma("unroll") for (int m = 0; m < 4; ++m) _Pragma("unroll") for (int k = 0; k < 2; ++k) dst[m][k] = *(const PG8_LAS bf16x8*)(lds + PG8_SA(b, h) + aoff + m * 2048 + k * 1024); } while (0)
#define PG8_LDB(dst, b, h) do { _Pragma("unroll") for (int n = 0; n < 2; ++n) _Pragma("unroll") for (int k = 0; k < 2; ++k) dst[n][k] = *(const PG8_LAS bf16x8*)(lds + PG8_SB(b, h) + boff + n * 2048 + k * 1024); } while (0)
#define PG8_MMA(ai, bj, At, Bt) do { __builtin_amdgcn_s_setprio(1); _Pragma("unroll") for (int m = 0; m < 4; ++m) _Pragma("unroll") for (int n = 0; n < 2; ++n) _Pragma("unroll") for (int k = 0; k < 2; ++k) \
        acc[ai][bj][m][n] = __builtin_amdgcn_mfma_f32_16x16x32_bf16(Bt[n][k], At[m][k], acc[ai][bj][m][n], 0, 0, 0); __builtin_amdgcn_s_setprio(0); } while (0)
#define PG8_WAIT_V(n) asm volatile("s_waitcnt vmcnt(" #n ")" ::: "memory")
#define PG8_WAIT_L(n) asm volatile("s_waitcnt lgkmcnt(" #n ")" ::: "memory")
#define PG8_BAR __builtin_amdgcn_s_barrier()
#define PG8_SCHED __builtin_amdgcn_sched_barrier(0)
    Unit cur, nxt; int ui = 0;
    if (!S.next(0, cur)) return;
    f32x4 acc[2][2][4][2];
#pragma unroll
    for (int a = 0; a < 2; ++a)
#pragma unroll
        for (int b = 0; b < 2; ++b)
#pragma unroll
            for (int m = 0; m < 4; ++m)
#pragma unroll
                for (int n = 0; n < 2; ++n) acc[a][b][m][n] = (f32x4){0.f, 0.f, 0.f, 0.f};
    bf16x8 At[4][2], B0[2][2], B1[2][2];
    const char* cA = cur.a; const char* cB = cur.b; const char* cB2 = cur.b2;
#define PG8_BK(base, base2, kt) ((kt) < ks ? (base) + (size_t)(kt) * kstep : (base2) + (size_t)((kt) - ks) * kstep)
    S.a_ready(cur);
    if constexpr (SP2) {
        PG8_STAGE(PG8_SB(0, 0), cB, voffB); PG8_STAGE(PG8_SB(0, 1), cB + hsB, voffB); PG8_STAGE(PG8_SA(0, 0), cA, voffA); PG8_STAGE(PG8_SA(0, 1), cA + hsA, voffA);
        if (wr == 1) PG8_BAR;
        PG8_WAIT_V(2); PG8_BAR;
        PG8_STAGE(PG8_SB(1, 0), PG8_BK(cB, cB2, 1), voffB); PG8_STAGE(PG8_SA(1, 0), cA + kstepA, voffA); PG8_STAGE(PG8_SB(1, 1), PG8_BK(cB, cB2, 1) + hsB, voffB);
        PG8_WAIT_V(6); PG8_BAR;
    } else {
        PG8_STAGE(PG8_SB(0, 0), cB, voffB); PG8_STAGE(PG8_SA(0, 0), cA, voffA); PG8_STAGE(PG8_SB(0, 1), cB + hsB, voffB); PG8_STAGE(PG8_SA(0, 1), cA + hsA, voffA);
        if (wr == 1) PG8_BAR;
        PG8_WAIT_V(4); PG8_BAR;
        PG8_STAGE(PG8_SB(1, 0), PG8_BK(cB, cB2, 1), voffB); PG8_STAGE(PG8_SA(1, 0), cA + kstepA, voffA); PG8_STAGE(PG8_SB(1, 1), PG8_BK(cB, cB2, 1) + hsB, voffB);
        PG8_WAIT_V(6); PG8_BAR;
    }
    for (;;) {
        const bool has_next = S.next(ui + 1, nxt);
        const char* nA = has_next ? nxt.a : cA; const char* nB = has_next ? nxt.b : cB; const char* nB2 = has_next ? nxt.b2 : cB2;
#pragma unroll 1
        for (int t = 0; t < nt; t += 2) {
            const bool last = (t == nt - 2);
            const char* a1 = cA + (size_t)(t + 1) * kstepA;
            const char* a2 = last ? nA : cA + (size_t)(t + 2) * kstepA; const char* b2 = last ? PG8_BK(nB, nB2, 0) : PG8_BK(cB, cB2, t + 2);
            const char* a3 = a2 + kstepA; const char* b3 = last ? PG8_BK(nB, nB2, 1) : PG8_BK(cB, cB2, t + 3);
            if (last && has_next) S.a_ready(nxt);
            if constexpr (SP2) {
            PG8_LDB(B0, 0, 0); PG8_LDB(B1, 0, 1); PG8_SCHED; PG8_LDA(At, 0, 0); PG8_STAGE(PG8_SA(1, 1), a1 + hsA, voffA);
            PG8_WAIT_V(8); PG8_WAIT_L(0); PG8_BAR; PG8_MMA(0, 0, At, B0); PG8_MMA(0, 1, At, B1); PG8_BAR; PG8_SCHED;
            PG8_LDA(At, 0, 1); PG8_STAGE(PG8_SB(0, 0), b2, voffB); PG8_STAGE(PG8_SB(0, 1), b2 + hsB, voffB); PG8_STAGE(PG8_SA(0, 0), a2, voffA);
            PG8_WAIT_V(8); PG8_WAIT_L(0); PG8_BAR; PG8_MMA(1, 0, At, B0); PG8_MMA(1, 1, At, B1); PG8_BAR; PG8_SCHED;
            PG8_LDB(B0, 1, 0); PG8_LDB(B1, 1, 1); PG8_SCHED; PG8_LDA(At, 1, 0); PG8_STAGE(PG8_SA(0, 1), a2 + hsA, voffA);
            PG8_WAIT_V(8); PG8_WAIT_L(0); PG8_BAR; PG8_MMA(0, 0, At, B0); PG8_MMA(0, 1, At, B1); PG8_BAR; PG8_SCHED;
            PG8_LDA(At, 1, 1); PG8_STAGE(PG8_SB(1, 0), b3, voffB); PG8_STAGE(PG8_SB(1, 1), b3 + hsB, voffB); PG8_STAGE(PG8_SA(1, 0), a3, voffA);
            PG8_WAIT_V(8); PG8_WAIT_L(0); PG8_BAR; PG8_MMA(1, 0, At, B0); PG8_MMA(1, 1, At, B1); PG8_BAR; PG8_SCHED;
            } else {
            PG8_LDB(B0, 0, 0); PG8_SCHED; PG8_LDA(At, 0, 0); PG8_STAGE(PG8_SA(1, 1), a1 + hsA, voffA);
            PG8_WAIT_L(8); PG8_BAR; PG8_WAIT_L(0); PG8_MMA(0, 0, At, B0); PG8_BAR; PG8_SCHED;
            PG8_LDB(B1, 0, 1); PG8_STAGE(PG8_SB(0, 0), b2, voffB);
            PG8_BAR; PG8_WAIT_L(0); PG8_MMA(0, 1, At, B1); PG8_BAR;
            PG8_LDA(At, 0, 1); PG8_STAGE(PG8_SA(0, 0), a2, voffA);
            PG8_BAR; PG8_WAIT_L(0); PG8_MMA(1, 0, At, B0); PG8_BAR; PG8_SCHED;
            PG8_STAGE(PG8_SB(0, 1), b2 + hsB, voffB);
            PG8_WAIT_V(6); PG8_BAR; PG8_MMA(1, 1, At, B1); PG8_BAR;
            PG8_LDB(B0, 1, 0); PG8_SCHED; PG8_LDA(At, 1, 0); PG8_STAGE(PG8_SA(0, 1), a2 + hsA, voffA);
            PG8_WAIT_L(8); PG8_BAR; PG8_WAIT_L(0); PG8_MMA(0, 0, At, B0); PG8_BAR; PG8_SCHED;
            PG8_LDB(B1, 1, 1); PG8_STAGE(PG8_SB(1, 0), b3, voffB);
            PG8_BAR; PG8_WAIT_L(0); PG8_MMA(0, 1, At, B1); PG8_BAR;
            PG8_LDA(At, 1, 1); PG8_STAGE(PG8_SA(1, 0), a3, voffA);
            PG8_BAR; PG8_WAIT_L(0); PG8_MMA(1, 0, At, B0); PG8_BAR; PG8_SCHED;
            PG8_STAGE(PG8_SB(1, 1), b3 + hsB, voffB);
            PG8_WAIT_V(6); PG8_BAR; PG8_MMA(1, 1, At, B1); PG8_BAR;
            }
        }
        if constexpr (ALIGN_EPI) { if (wr == 0) PG8_BAR; }
        if constexpr (!Epi::AFTER_DRAIN) { E(acc, cur, wr, wc, fr, fq); S.done(cur); }
        if (!has_next) break;
#pragma unroll
        for (int a = 0; a < 2; ++a)
#pragma unroll
            for (int b = 0; b < 2; ++b)
#pragma unroll
                for (int m = 0; m < 4; ++m)
#pragma unroll
                    for (int n = 0; n < 2; ++n) acc[a][b][m][n] = (f32x4){0.f, 0.f, 0.f, 0.f};
        cur = nxt; cA = nA; cB = nB; cB2 = nB2; ++ui;
        if constexpr (ALIGN_EPI) { if (wr == 1) PG8_BAR; }
    }
    PG8_WAIT_V(0);
    if constexpr (!ALIGN_EPI) { if (wr == 0) PG8_BAR; }
    PG8_BAR;
    if constexpr (Epi::AFTER_DRAIN) { E.fused(acc, cur, wr, wc, fr, fq, lds, wid, lane); S.done(cur); }
#undef PG8_BK
#undef PG8_SA
#undef PG8_SB
#undef PG8_STAGE
#undef PG8_LDA
#undef PG8_LDB
#undef PG8_MMA
#undef PG8_WAIT_V
#undef PG8_WAIT_L
#undef PG8_BAR
#undef PG8_SCHED
}
}

struct PlainOrder {
    const char* A; const char* Bt; int lda, ldb, nM, nN, nwg, G, c;
    __device__ __forceinline__ void init(const void* A_, const void* Bt_, int lda_, int ldb_, int M, int N, int G_, int c_) { A = (const char*)A_; Bt = (const char*)Bt_; lda = lda_; ldb = ldb_; nM = M / 256; nN = N / 256; nwg = nM * nN; G = G_; c = c_; }
    __device__ __forceinline__ bool next(int i, pg8::Unit& u) const {
        const long L = (long)i * G + c; if (L >= nwg) return false;
        int wgid = (int)L; { const int q = nwg / 8, r = nwg % 8, xcd = wgid % 8, off = wgid / 8; wgid = (xcd < r ? xcd * (q + 1) : r * (q + 1) + (xcd - r) * q) + off; }
        const int nig = 8 * nN, gid = wgid / nig, fm = gid * 8, gsz = (nM - fm) < 8 ? (nM - fm) : 8;
        u.pm = fm + ((wgid % nig) % gsz); u.pn = (wgid % nig) / gsz;
        u.a = A + (size_t)u.pm * 256 * lda * 2; u.b = Bt + (size_t)u.pn * 256 * ldb * 2; u.b2 = u.b; return true;
    }
    __device__ __forceinline__ void a_ready(const pg8::Unit&) const {}
    __device__ __forceinline__ void done(const pg8::Unit&) const {}
};
struct EpiInProj {
    static constexpr bool PERM = true, AFTER_DRAIN = false;
    unsigned char* ws; const float* b_gate; const float* b_fgt; unsigned* kn;
    __device__ __forceinline__ void operator()(const pg8::f32x4 (&acc)[2][2][4][2], const pg8::Unit& u, int wr, int wc, int fr, int fq) const {
        { int t_ = threadIdx.x; asm volatile("" : "+v"(t_)); fr = t_ & 15; fq = (t_ >> 4) & 3; }
        const int pn = u.pn, b = (u.pm * 256) / T_, t0 = u.pm * 256 - b * T_ + wr * 64 + fr;
        if (pn == 11) {
            if (wc == 0 && fq < 4) {
                float* gate = (float*)(ws + WS_GATE); float* fl = (float*)(ws + WS_FL);
#pragma unroll
                for (int ai = 0; ai < 2; ++ai)
#pragma unroll
                    for (int m = 0; m < 4; ++m) { const int t = t0 + ai * 128 + m * 16; const size_t n = (size_t)b * T_ + t;
#pragma unroll
                        for (int nn = 0; nn < 2; ++nn)
#pragma unroll
                            for (int e = 0; e < 4; ++e) { const int c = 8 * fq + 4 * nn + e; const float v = acc[ai][0][m][nn][e];
                                if (c < 24) gate[n * 24 + c] = __builtin_amdgcn_rcpf(1.f + __builtin_amdgcn_exp2f(-(v + b_gate[c]) * LOG2E));
                                else if (c < 28) { const float z = v + b_fgt[c - 24];
                                    fl[(size_t)(b * 4 + (c - 24)) * T_ + t] = z < -30.f ? z : -0.6931471805599453f * __builtin_amdgcn_logf(1.f + __builtin_amdgcn_exp2f(-z * LOG2E)); } } }
            }
            return;
        }
        if (pn == 6 || pn == 9) {
            const int lane_ = (fq << 4) | fr;
#pragma unroll
            for (int bj = 0; bj < 2; ++bj)
#pragma unroll
                for (int ai = 0; ai < 2; ++ai) { float mx = 0.f;
#pragma unroll
                    for (int m = 0; m < 4; ++m) { const pg8::f32x4 v0 = acc[ai][bj][m][0], v1 = acc[ai][bj][m][1];
                        float ss = (v0[0] * v0[0] + v0[1] * v0[1]) + (v0[2] * v0[2] + v0[3] * v0[3]) + (v1[0] * v1[0] + v1[1] * v1[1]) + (v1[2] * v1[2] + v1[3] * v1[3]);
                        ss += shflx_f(ss, 16, lane_); ss += shflx_f(ss, 32, lane_); mx = fmaxf(mx, ss); }
#pragma unroll
                    for (int o = 1; o < 16; o <<= 1) mx = fmaxf(mx, shflx_f(mx, o, lane_));
                    if (lane_ == 0) { const int cg = bj * 4 + wc, tile = (u.pm * 256 - b * T_ + ai * 128 + wr * 64) >> 6;
                        unsigned* dst = pn == 6 ? kn + ((b * 4 + (cg >> 1)) * 64 + tile) * 2 + (cg & 1) : kn + 4096 + (b * 8 + cg) * 64 + tile;
                        atomicMax(dst, __float_as_uint(mx)); } }
        }
#pragma unroll
        for (int bj = 0; bj < 2; ++bj) {
            const int c = bj * 128 + wc * 32 + 8 * fq;
            bf16* base; int W = 64; float sc = 1.f;
            if (pn < 2) { base = (bf16*)(ws + WS_QN) + (size_t)(b * 8 + pn * 4 + (c >> 6)) * T_ * 64 + (c & 63); sc = 0.125f * LOG2E; }
            else if (pn < 5) { base = (bf16*)(ws + WS_KV6 + (size_t)((pn - 2) * 2 + (c >> 7)) * KV6_STRIDE) + (size_t)(b * 2 + ((c >> 6) & 1)) * T_ * 64 + (c & 63); }
            else if (pn < 8) { base = (bf16*)(ws + WS_FQKV) + (size_t)(pn - 5) * (8 * MiB) + (size_t)(b * 4 + (c >> 6)) * T_ * 64 + (c & 63); if (pn == 5) sc = 0.125f * LOG2E; }
            else if (pn < 10) { base = (bf16*)(ws + WS_DQK) + (size_t)(pn - 8) * (8 * MiB) + (size_t)(b * 8 + (c >> 5)) * T_ * 32 + (c & 31); W = 32; if (pn == 8) sc = 0.17677669529663687f * LOG2E; }
            else { base = (bf16*)(ws + WS_DV) + (size_t)(b * 4 + (c >> 6)) * T_ * 64 + (c & 63); }
            const bool blk = W == 64 && pn != 2;
            if (blk) base += -(c & 63) + ((c >> 5) & 1) * 512 + (c & 31);
#pragma unroll
            for (int ai = 0; ai < 2; ++ai)
#pragma unroll
                for (int m = 0; m < 4; ++m) { const int t = t0 + ai * 128 + m * 16;
                    const pg8::f32x4 v0 = acc[ai][bj][m][0] * sc, v1 = acc[ai][bj][m][1] * sc;
                    pg8::u32x4 w; w.x = pg8::cvt_pk_bf16(v0[0], v0[1]); w.y = pg8::cvt_pk_bf16(v0[2], v0[3]); w.z = pg8::cvt_pk_bf16(v1[0], v1[1]); w.w = pg8::cvt_pk_bf16(v1[2], v1[3]);
                    *(pg8::u32x4*)(base + (blk ? (size_t)((t >> 4) * 1024 + (t & 15) * 32) : (size_t)t * W)) = w; }
        }
    }
};
struct EpiResBf16 {
    static constexpr bool PERM = false, AFTER_DRAIN = false;
    bf16* xr;
    __device__ __forceinline__ void operator()(const pg8::f32x4 (&acc)[2][2][4][2], const pg8::Unit& u, int wr, int wc, int fr, int fq) const {
        { int t_ = threadIdx.x; asm volatile("" : "+v"(t_)); fr = t_ & 15; fq = (t_ >> 4) & 3; }
#pragma unroll
        for (int ai = 0; ai < 2; ++ai)
#pragma unroll
            for (int m = 0; m < 4; ++m) { const size_t off = (size_t)(u.pm * 256 + ai * 128 + wr * 64 + m * 16 + fr) * D_ + u.pn * 256 + wc * 32 + 4 * fq;
#pragma unroll
                for (int bj = 0; bj < 2; ++bj)
#pragma unroll
                    for (int n = 0; n < 2; ++n) { const u64 w = *(const u64*)(xr + off + bj * 128 + n * 16);
                        const pg8::f32x4 bs = {__uint_as_float((unsigned)w << 16), __uint_as_float((unsigned)w & 0xffff0000u), __uint_as_float((unsigned)(w >> 32) << 16), __uint_as_float((unsigned)(w >> 32) & 0xffff0000u)};
                        const pg8::f32x4 o = bs + acc[ai][bj][m][n];
                        *(u64*)(xr + off + bj * 128 + n * 16) = (u64)pg8::cvt_pk_bf16(o[0], o[1]) | ((u64)pg8::cvt_pk_bf16(o[2], o[3]) << 32); } }
    }
};


struct EpiDummy {
    static constexpr bool PERM = true, AFTER_DRAIN = false;
    float* dst;
    __device__ __forceinline__ void operator()(const pg8::f32x4 (&acc)[2][2][4][2], const pg8::Unit& u, int wr, int wc, int fr, int fq) const {
        pg8::f32x4 a = {0.f, 0.f, 0.f, 0.f};
#pragma unroll
        for (int ai = 0; ai < 2; ++ai)
#pragma unroll
            for (int bj = 0; bj < 2; ++bj)
#pragma unroll
                for (int m = 0; m < 4; ++m) { a = a + acc[ai][bj][m][0]; a = a + acc[ai][bj][m][1]; }
        *(pg8::f32x4*)(dst + ((size_t)(u.pm * 12 + u.pn) * 512 + threadIdx.x) * 4) = a;
    }
};
struct OneUnitOrder { pg8::Unit u; bool has;
    __device__ __forceinline__ bool next(int i, pg8::Unit& o) const { if (i != 0 || !has) return false; o = u; return true; }
    __device__ __forceinline__ void a_ready(const pg8::Unit&) const {}
    __device__ __forceinline__ void done(const pg8::Unit&) const {} };
__device__ __forceinline__ float gelu_tanh_fast(float x) { const float u2 = 1.5957691216057308f * (x + 0.044715f * x * x * x); return x * __builtin_amdgcn_rcpf(1.f + __builtin_amdgcn_exp2f(-u2 * LOG2E)); }
struct EpiCmpH {
    static constexpr bool PERM = true, AFTER_DRAIN = false;
    bf16* hc; const float* bias1;
    __device__ __forceinline__ void operator()(const pg8::f32x4 (&acc)[2][2][4][2], const pg8::Unit& u, int wr, int wc, int fr, int fq) const {
        { int t_ = threadIdx.x; asm volatile("" : "+v"(t_)); fr = t_ & 15; fq = (t_ >> 4) & 3; }
        const int kv = u.pn;
#pragma unroll
        for (int bj = 0; bj < 2; ++bj) { const int col = bj * 128 + wc * 32 + 8 * fq;
            const pg8::f32x4 b0 = *(const pg8::f32x4*)(bias1 + kv * 256 + col), b1 = *(const pg8::f32x4*)(bias1 + kv * 256 + col + 4);
#pragma unroll
            for (int ai = 0; ai < 2; ++ai)
#pragma unroll
                for (int m = 0; m < 4; ++m) { const int row = u.pm * 256 + ai * 128 + wr * 64 + m * 16 + fr;
                    const pg8::f32x4 v0 = acc[ai][bj][m][0] + b0, v1 = acc[ai][bj][m][1] + b1;
                    pg8::u32x4 w; w.x = pg8::cvt_pk_bf16(gelu_tanh_fast(v0[0]), gelu_tanh_fast(v0[1])); w.y = pg8::cvt_pk_bf16(gelu_tanh_fast(v0[2]), gelu_tanh_fast(v0[3]));
                    w.z = pg8::cvt_pk_bf16(gelu_tanh_fast(v1[0]), gelu_tanh_fast(v1[1])); w.w = pg8::cvt_pk_bf16(gelu_tanh_fast(v1[2]), gelu_tanh_fast(v1[3]));
                    *(pg8::u32x4*)(hc + ((size_t)kv * 4096 + row) * 256 + col) = w; } }
    }
};
struct EpiCmpOut {
    static constexpr bool PERM = true, AFTER_DRAIN = false;
    bf16* kvcmp;
    __device__ __forceinline__ void operator()(const pg8::f32x4 (&acc)[2][2][4][2], const pg8::Unit& u, int wr, int wc, int fr, int fq) const {
        { int t_ = threadIdx.x; asm volatile("" : "+v"(t_)); fr = t_ & 15; fq = (t_ >> 4) & 3; }
        if (wc >= 2) return;
        const int kv = u.pn, col = wc * 32 + 8 * fq;
#pragma unroll
        for (int ai = 0; ai < 2; ++ai)
#pragma unroll
            for (int m = 0; m < 4; ++m) { const int row = u.pm * 256 + ai * 128 + wr * 64 + m * 16 + fr; const float z = ((row & 255) == 255) ? 0.f : 1.f;
                const pg8::f32x4 v0 = acc[ai][0][m][0], v1 = acc[ai][0][m][1];
                pg8::u32x4 w; w.x = pg8::cvt_pk_bf16(z != 0.f ? v0[0] : 0.f, z != 0.f ? v0[1] : 0.f); w.y = pg8::cvt_pk_bf16(z != 0.f ? v0[2] : 0.f, z != 0.f ? v0[3] : 0.f);
                w.z = pg8::cvt_pk_bf16(z != 0.f ? v1[0] : 0.f, z != 0.f ? v1[1] : 0.f); w.w = pg8::cvt_pk_bf16(z != 0.f ? v1[2] : 0.f, z != 0.f ? v1[3] : 0.f);
                *(pg8::u32x4*)(kvcmp + ((size_t)kv * 4096 + row) * 64 + col) = w; }
    }
};

__device__ __forceinline__ void moe_build_tables(const unsigned* cnt, int tid) {
    LAS int* T = (LAS int*)((LAS unsigned char*)lds_raw + TBL_OFF);
    __syncthreads();
    if (tid < 112) T[128 + 256 + tid] = (int)((cnt[tid * MOE_CS] + 255u) >> 8);
    __syncthreads();
    if (tid == 0) { int o = 0; for (int c = 0; c < 112; ++c) { T[c] = o; const int n = T[128 + 256 + c]; for (int k = 0; k < n; ++k) T[128 + o + k] = c; o += n; } T[112] = o; }
    __syncthreads();
}
__device__ __forceinline__ void moe_pair(int cls, int& ea, int& eb) { const int grp = cls / 28; int idx = cls % 28, lo = 0; while (idx >= 7 - lo) { idx -= 7 - lo; ++lo; } ea = grp * 8 + lo; eb = grp * 8 + lo + 1 + idx; }
struct MoeOrder1 {
    const char* xs; const char* wgu; int G, c;
    __device__ __forceinline__ bool next(int i, pg8::Unit& u) const {
        const LAS int* T = (const LAS int*)((LAS unsigned char*)lds_raw + TBL_OFF);
        const int idx = i * G + c; if (idx >= 4 * T[112]) return false;
        const int tile = idx >> 2, pn = idx & 3; int ea, eb; moe_pair(T[128 + tile], ea, eb); const int e = (pn >> 1) ? eb : ea;
        u.pm = tile; u.pn = pn; u.a = xs + (size_t)tile * 256 * 2048; u.b = wgu + ((size_t)e * 512 + (pn & 1) * 256) * 2048; u.b2 = u.b; return true; }
    __device__ __forceinline__ void a_ready(const pg8::Unit&) const {}
    __device__ __forceinline__ void done(const pg8::Unit&) const {} };
struct MoeOrder2 {
    const char* hb; const char* wd; int G, c;
    __device__ __forceinline__ bool next(int i, pg8::Unit& u) const {
        const LAS int* T = (const LAS int*)((LAS unsigned char*)lds_raw + TBL_OFF);
        const int idx = i * G + c; if (idx >= 4 * T[112]) return false;
        const int tile = idx >> 2, pn = idx & 3; int ea, eb; moe_pair(T[128 + tile], ea, eb);
        u.pm = tile; u.pn = pn; u.a = hb + (size_t)tile * 256 * 1024; u.b = wd + ((size_t)ea * 1024 + pn * 256) * 512; u.b2 = wd + ((size_t)eb * 1024 + pn * 256) * 512; return true; }
    __device__ __forceinline__ void a_ready(const pg8::Unit&) const {}
    __device__ __forceinline__ void done(const pg8::Unit&) const {} };
struct EpiMoeH {
    static constexpr bool PERM = true, AFTER_DRAIN = false;
    bf16* hb; const float* roww;
    __device__ __forceinline__ void operator()(const pg8::f32x4 (&acc)[2][2][4][2], const pg8::Unit& u, int wr, int wc, int fr, int fq) const {
        { int t_ = threadIdx.x; asm volatile("" : "+v"(t_)); fr = t_ & 15; fq = (t_ >> 4) & 3; }
        const int slot = u.pn >> 1;
#pragma unroll
        for (int ai = 0; ai < 2; ++ai)
#pragma unroll
            for (int m = 0; m < 4; ++m) { const size_t row = (size_t)u.pm * 256 + ai * 128 + wr * 64 + m * 16 + fr; const float w = roww[row * 2 + slot];
#pragma unroll
                for (int bj = 0; bj < 2; ++bj) { const int j0 = (u.pn & 1) * 128 + (bj * 128 + wc * 32 + 8 * fq) / 2;
                    const pg8::f32x4 v0 = acc[ai][bj][m][0], v1 = acc[ai][bj][m][1];
                    const float h0 = v0[0] * __builtin_amdgcn_rcpf(1.f + __builtin_amdgcn_exp2f(-v0[0] * LOG2E)) * v0[1] * w, h1 = v0[2] * __builtin_amdgcn_rcpf(1.f + __builtin_amdgcn_exp2f(-v0[2] * LOG2E)) * v0[3] * w;
                    const float h2 = v1[0] * __builtin_amdgcn_rcpf(1.f + __builtin_amdgcn_exp2f(-v1[0] * LOG2E)) * v1[1] * w, h3 = v1[2] * __builtin_amdgcn_rcpf(1.f + __builtin_amdgcn_exp2f(-v1[2] * LOG2E)) * v1[3] * w;
                    const int jg = slot * 256 + j0;
                    *(u64*)(hb + ((row >> 4) * 32 + (jg >> 4)) * 256 + (row & 15) * 16 + (jg & 15)) = (u64)pg8::cvt_pk_bf16(h0, h1) | ((u64)pg8::cvt_pk_bf16(h2, h3) << 32); } }
    }
};
struct EpiMoeOut {
    static constexpr bool PERM = false, AFTER_DRAIN = false;
    bf16* x; const int* rowtok;
    __device__ __forceinline__ void operator()(const pg8::f32x4 (&acc)[2][2][4][2], const pg8::Unit& u, int wr, int wc, int fr, int fq) const {
        { int t_ = threadIdx.x; asm volatile("" : "+v"(t_)); fr = t_ & 15; fq = (t_ >> 4) & 3; }
        bf16* xx = x; const int* rt = rowtok; asm volatile("" : "+s"(xx), "+s"(rt));
#pragma unroll
        for (int ai = 0; ai < 2; ++ai)
#pragma unroll
            for (int m = 0; m < 4; ++m) { const int tok = rt[(size_t)u.pm * 256 + ai * 128 + wr * 64 + m * 16 + fr];
                if (tok >= 0) { bf16* xr = xx + (size_t)tok * D_ + u.pn * 256 + wc * 32 + 4 * fq;
#pragma unroll
                    for (int bj = 0; bj < 2; ++bj)
#pragma unroll
                        for (int n = 0; n < 2; ++n) { u64* q = (u64*)(xr + bj * 128 + n * 16); const u64 w = *q; const pg8::f32x4 a = acc[ai][bj][m][n];
                            *q = (u64)pg8::cvt_pk_bf16(__uint_as_float((unsigned)w << 16) + a[0], __uint_as_float((unsigned)w & 0xffff0000u) + a[1]) | ((u64)pg8::cvt_pk_bf16(__uint_as_float((unsigned)(w >> 32) << 16) + a[2], __uint_as_float((unsigned)(w >> 32) & 0xffff0000u) + a[3]) << 32); } } }
    }
};

__device__ __forceinline__ void transpose_item(const float* W, int ldw, bf16* WT, int ldt, int r0, int rmul, int k0, LAS float* scr, int lane) {
    f32x4 v[8];
#pragma unroll
    for (int i = 0; i < 8; ++i) v[i] = *(const f32x4*)(W + (size_t)(k0 + i * 8 + (lane >> 3)) * ldw + (lane & 7) * 4);
#pragma unroll
    for (int i = 0; i < 8; ++i) { LAS float* d = scr + (i * 8 + (lane >> 3)) * 33 + (lane & 7) * 4; d[0] = v[i].x; d[1] = v[i].y; d[2] = v[i].z; d[3] = v[i].w; }
    asm volatile("s_waitcnt lgkmcnt(0)" ::: "memory");
    const int c = lane & 7;
#pragma unroll
    for (int j = 0; j < 4; ++j) { const int n = (lane >> 3) + 8 * j; const LAS float* sp = scr + (8 * c) * 33 + n;
        u32x4 o; o.x = pk2(sp[0 * 33], sp[1 * 33]); o.y = pk2(sp[2 * 33], sp[3 * 33]); o.z = pk2(sp[4 * 33], sp[5 * 33]); o.w = pk2(sp[6 * 33], sp[7 * 33]);
        *(u32x4*)(WT + (size_t)(r0 + rmul * n) * ldt + k0 + 8 * c) = o; }
    asm volatile("s_waitcnt lgkmcnt(0)" ::: "memory");
}
__device__ __forceinline__ void transpose_seg(const float* W, int ldw, int K, int sc0, int ncol, bf16* WT, int r0, int rmul, int item, LAS float* scr, int lane) {
    const int nb = ncol / 32, kb = item / nb, cb = item % nb;
    transpose_item(W + sc0 + cb * 32, ldw, WT, K, r0 + rmul * cb * 32, rmul, kb * 64, scr, lane);
}

typedef float f32x16 __attribute__((ext_vector_type(16)));
typedef short bf16x8v __attribute__((ext_vector_type(8)));
typedef short s16x4 __attribute__((ext_vector_type(4)));
typedef float f32x2_t __attribute__((ext_vector_type(2)));
typedef __bf16 bf16x2_t __attribute__((ext_vector_type(2)));
constexpr int A_KBUF = 10240, A_VBUF = 12288;
constexpr int A_KOFF = 0, A_VOFF = 2 * A_KBUF, A_BOFF = A_VOFF + 2 * A_VBUF, A_LDS_END = A_BOFF + 2 * 256;
__device__ __forceinline__ constexpr int crow0(int reg) { return (reg & 3) + 8 * (reg >> 2); }
__device__ __forceinline__ float swap_max(float m) { auto rr = __builtin_amdgcn_permlane32_swap(__float_as_uint(m), __float_as_uint(m), false, false); return fmaxf(__uint_as_float(rr[0]), __uint_as_float(rr[1])); }
__device__ __forceinline__ float swap_sum(float m) { auto rr = __builtin_amdgcn_permlane32_swap(__float_as_uint(m), __float_as_uint(m), false, false); return __uint_as_float(rr[0]) + __uint_as_float(rr[1]); }
__device__ __forceinline__ unsigned cvtpk(float lo, float hi) { f32x2_t v = {lo, hi}; bf16x2_t b = __builtin_convertvector(v, bf16x2_t); return __builtin_bit_cast(unsigned, b); }
__device__ __forceinline__ bf16x8v pack8(const f32x16& p, int b0) { u32x4 w; w.x = cvtpk(p[b0 + 0], p[b0 + 1]); w.y = cvtpk(p[b0 + 2], p[b0 + 3]); w.z = cvtpk(p[b0 + 4], p[b0 + 5]); w.w = cvtpk(p[b0 + 6], p[b0 + 7]); return __builtin_bit_cast(bf16x8v, w); }
__device__ __forceinline__ s16x4 tr_read(const LAS unsigned char* p) { typedef short v4i16_t __attribute__((ext_vector_type(4))); return __builtin_bit_cast(s16x4, __builtin_amdgcn_ds_read_tr16_b64_v4i16((LAS v4i16_t*)p)); }

template <int DQK, int NMAP, bool FOX, bool SLC>
__device__ __forceinline__ void attn_core(LAS unsigned char* L, const bf16* Kb0, const bf16* Kb1, const bf16* Vb, const LAS float* cum, float cum_ref,
                                          const bf16x8v (&Qf)[NMAP][DQK / 16], u64 tilemask, int t_lane, int tw0, int win, float slope2, unsigned selw0, unsigned selw1,
                                          f32x16 (&O)[NMAP][2], float (&M)[NMAP], float (&Ls)[NMAP], int tid, bool started0 = false) {
    constexpr int KP = DQK * 2 + 16, VP = 192;
    const int lane = tid & 63, r = lane & 31, h = lane >> 5;
    int kdst; const bf16* ksrc;
    if (DQK == 64) { kdst = (tid >> 3) * KP + (tid & 7) * 16; ksrc = Kb0 + b64_off(tid >> 3, (tid & 7) * 8); }
    else { const int mp = tid >> 8, tt = tid & 255; kdst = mp * 5120 + (tt >> 2) * KP + (tt & 3) * 16; ksrc = (mp ? Kb1 : Kb0) + (tt >> 2) * 32 + (tt & 3) * 8; }
    const int vdst = (tid >> 3) * VP + (tid & 7) * 16; const bf16* vsrc = Vb + b64_off(tid >> 3, (tid & 7) * 8);
    const LAS unsigned char* kfrag = L + A_KOFF + r * KP + h * 16;
    const LAS unsigned char* vfrag = L + A_VOFF + (4 * h + ((lane & 15) >> 2)) * VP + (16 * ((lane >> 4) & 1) + 4 * (lane & 3)) * 2;
    u32x4 kreg, vreg; float breg = 0.f;
    u64 mk = tilemask;
    int j = 63 - __builtin_clzll(mk); mk &= ~(1ull << j);
    { const int kv0 = j * 64; kreg = *(const u32x4*)(ksrc + (size_t)kv0 * DQK); vreg = *(const u32x4*)(vsrc + (size_t)kv0 * 64); if (FOX && tid < 64) breg = (cum_ref - cum[kv0 + tid]) * LOG2E; }
    *(LAS u32x4*)(L + A_KOFF + kdst) = kreg; *(LAS u32x4*)(L + A_VOFF + vdst) = vreg; if (FOX && tid < 64) *(LAS float*)(L + A_BOFF + tid * 4) = breg;
    __syncthreads();
    int buf = 0; bool started = started0;
    float pdummy = 0.f; int idummy = 0; f32x16 dm0; for (int i = 0; i < 16; ++i) dm0[i] = 0.f;
    for (;;) {
        const bool more = mk != 0ull; int jn = 0;
        if (more) { jn = 63 - __builtin_clzll(mk); mk &= ~(1ull << jn); const int kv0 = jn * 64;
            kreg = *(const u32x4*)(ksrc + (size_t)kv0 * DQK); vreg = *(const u32x4*)(vsrc + (size_t)kv0 * 64); if (FOX && tid < 64) breg = (cum_ref - cum[kv0 + tid]) * LOG2E; }
        { const int kv0 = j * 64;
          bool wave_has = true; float selb = 0.f;
          if (SLC) { const bool mine = ((j < 32 ? (selw0 >> j) : (selw1 >> (j - 32))) & 1u) != 0u; selb = mine ? 0.f : -INFINITY; wave_has = __any(mine); }
          if (wave_has && !(kv0 > tw0 + 31) && !(tw0 - (kv0 + 63) >= win)) {
            const bool need_mask = (kv0 + 63 > tw0) || (tw0 + 31 - kv0 >= win);
            const int dl = t_lane - kv0 - 4 * h;
            bf16x8v pa[NMAP][4];
#pragma unroll
            for (int mp = 0; mp < NMAP; ++mp) {
                f32x16 p0, p1;
                if (FOX) { const LAS f32x4* bl = (const LAS f32x4*)(L + A_BOFF + buf * 256) + h; const float mm = M[mp];
#pragma unroll
                    for (int g4 = 0; g4 < 4; ++g4) { const f32x4 b0 = bl[2 * g4], b1 = bl[8 + 2 * g4];
                        p0[4 * g4 + 0] = b0.x - mm; p0[4 * g4 + 1] = b0.y - mm; p0[4 * g4 + 2] = b0.z - mm; p0[4 * g4 + 3] = b0.w - mm; p1[4 * g4 + 0] = b1.x - mm; p1[4 * g4 + 1] = b1.y - mm; p1[4 * g4 + 2] = b1.z - mm; p1[4 * g4 + 3] = b1.w - mm; } }
                else { const float base_l = (slope2 * (float)(kv0 + 4 * h - tw0) - M[mp]) + selb, s8 = slope2 * 8.f, s32 = slope2 * 32.f;
                    p0[0] = base_l; p0[1] = p0[0] + slope2; p0[2] = p0[1] + slope2; p0[3] = p0[2] + slope2;
#pragma unroll
                    for (int reg = 4; reg < 16; ++reg) p0[reg] = p0[reg - 4] + s8;
#pragma unroll
                    for (int reg = 0; reg < 16; ++reg) p1[reg] = p0[reg] + s32; }
                const LAS unsigned char* kb = kfrag + buf * A_KBUF + (DQK == 32 ? mp * 5120 : 0);
#pragma unroll
                for (int s = 0; s < DQK / 16; ++s) { const bf16x8v kf0 = *(const LAS bf16x8v*)(kb + s * 32), kf1 = *(const LAS bf16x8v*)(kb + 32 * KP + s * 32);
#ifdef PROBE_X_LDSK
                    { const bf16x8v z0 = *(const volatile LAS bf16x8v*)(kb + s * 32), z1 = *(const volatile LAS bf16x8v*)(kb + 32 * KP + s * 32); idummy ^= z0[0] ^ z1[1]; }
#endif
#ifdef PROBE_X_MFMA
                    dm0 = __builtin_amdgcn_mfma_f32_32x32x16_bf16(kf0, Qf[mp][s], dm0, 0, 0, 0); dm0 = __builtin_amdgcn_mfma_f32_32x32x16_bf16(kf1, Qf[mp][s], dm0, 0, 0, 0);
#endif
                    p0 = __builtin_amdgcn_mfma_f32_32x32x16_bf16(kf0, Qf[mp][s], p0, 0, 0, 0); p1 = __builtin_amdgcn_mfma_f32_32x32x16_bf16(kf1, Qf[mp][s], p1, 0, 0, 0); }
                if (need_mask) {
#pragma unroll
                    for (int reg = 0; reg < 16; ++reg) { const int d0 = dl - crow0(reg), d1 = d0 - 32;
                        p0[reg] = (d0 >= 0 && d0 < win) ? p0[reg] : -INFINITY; p1[reg] = (d1 >= 0 && d1 < win) ? p1[reg] : -INFINITY; } }
                float mt = fmaxf(fmaxf(p0[0], p1[0]), fmaxf(p0[1], p1[1]));
#pragma unroll
                for (int reg = 2; reg < 16; reg += 2) mt = fmaxf(fmaxf(mt, fmaxf(fmaxf(p0[reg], p1[reg]), p0[reg + 1])), p1[reg + 1]);
                mt = swap_max(mt);
                if (!started || __any(mt > 8.f)) {
                    const float d = (mt > -1e30f) ? (started ? fmaxf(mt, 0.f) : mt) : 0.f, alpha = __builtin_amdgcn_exp2f(-d);
                    O[mp][0] *= alpha; O[mp][1] *= alpha; Ls[mp] *= alpha; M[mp] += d;
#pragma unroll
                    for (int reg = 0; reg < 16; ++reg) { p0[reg] -= d; p1[reg] -= d; } }
                float rs = 0.f;
#ifdef PROBE_X_EXP
#pragma unroll
                for (int reg = 0; reg < 16; ++reg) { pdummy += __builtin_amdgcn_exp2f(p0[reg] - 1.f) + __builtin_amdgcn_exp2f(p1[reg] - 1.f); }
#endif
#pragma unroll
                for (int reg = 0; reg < 16; ++reg) { p0[reg] = __builtin_amdgcn_exp2f(p0[reg]); p1[reg] = __builtin_amdgcn_exp2f(p1[reg]); rs += p0[reg] + p1[reg]; }
                Ls[mp] += rs;
                pa[mp][0] = pack8(p0, 0); pa[mp][1] = pack8(p0, 8); pa[mp][2] = pack8(p1, 0); pa[mp][3] = pack8(p1, 8);
            }
            started = true;
            const LAS unsigned char* vb = vfrag + buf * A_VBUF;
#pragma unroll
            for (int db = 0; db < 2; ++db)
#pragma unroll
                for (int ks = 0; ks < 4; ++ks) { const s16x4 lo = tr_read(vb + ks * (16 * VP) + db * 64), hi = tr_read(vb + ks * (16 * VP) + db * 64 + 8 * VP);
                    const bf16x8v vf = {lo[0], lo[1], lo[2], lo[3], hi[0], hi[1], hi[2], hi[3]};
#pragma unroll
                    for (int mp = 0; mp < NMAP; ++mp) O[mp][db] = __builtin_amdgcn_mfma_f32_32x32x16_bf16(vf, pa[mp][ks], O[mp][db], 0, 0, 0); }
          } }
        if (more) { *(LAS u32x4*)(L + A_KOFF + (buf ^ 1) * A_KBUF + kdst) = kreg; *(LAS u32x4*)(L + A_VOFF + (buf ^ 1) * A_VBUF + vdst) = vreg; if (FOX && tid < 64) *(LAS float*)(L + A_BOFF + (buf ^ 1) * 256 + tid * 4) = breg; }
#ifdef PROBE_X_BAR
        __syncthreads();
#endif
        __syncthreads();
        if (!more) break;
        j = jn; buf ^= 1;
    }
    if (pdummy == 123.456f || idummy == 0x7fffabcd || dm0[3] == 98765.4321f) Ls[0] += 1e-30f;
}
#ifndef AC2_MODE
#define AC2_MODE 0
#endif
#ifndef AC2_INIT_VALU
#define AC2_INIT_VALU 24
#endif
template <bool FOX, bool SLC>
__device__ __forceinline__ void attn_core2(LAS unsigned char* L, const bf16* Kb0, const bf16* Vb, const LAS float* cum, float cum_ref,
                                           const bf16x8v (&Qf)[4], u64 tilemask, int t_lane, int tw0, int win, float slope2, unsigned selw0, unsigned selw1,
                                           f32x16 (&O)[2], float& M, float& Ls, int tid) {
    constexpr int KP = 144, VP = 192;
    const int lane = tid & 63, r = lane & 31, h = lane >> 5;
    const int kdst = (tid >> 3) * KP + (tid & 7) * 16; const bf16* ksrc = Kb0 + b64_off(tid >> 3, (tid & 7) * 8);
    const int vdst = (tid >> 3) * VP + (tid & 7) * 16; const bf16* vsrc = Vb + b64_off(tid >> 3, (tid & 7) * 8);
    const LAS unsigned char* kfrag = L + A_KOFF + r * KP + h * 16;
    const LAS unsigned char* vfrag = L + A_VOFF + (4 * h + ((lane & 15) >> 2)) * VP + (16 * ((lane >> 4) & 1) + 4 * (lane & 3)) * 2;
#define AC2_ACTIVE(jj) (!((jj) * 64 > tw0 + 31) && !(tw0 - ((jj) * 64 + 63) >= win))
#define AC2_INIT(jj, kslot, q0, q1) do { const int kv0_ = (jj) * 64; \
        if (FOX) { const LAS f32x4* bl = (const LAS f32x4*)(L + A_BOFF + (kslot) * 256) + h; const float mm = M; \
            _Pragma("unroll") for (int g4 = 0; g4 < 4; ++g4) { const f32x4 b0 = bl[2 * g4], b1 = bl[8 + 2 * g4]; \
                q0[4 * g4 + 0] = b0.x - mm; q0[4 * g4 + 1] = b0.y - mm; q0[4 * g4 + 2] = b0.z - mm; q0[4 * g4 + 3] = b0.w - mm; q1[4 * g4 + 0] = b1.x - mm; q1[4 * g4 + 1] = b1.y - mm; q1[4 * g4 + 2] = b1.z - mm; q1[4 * g4 + 3] = b1.w - mm; } } \
        else { float selb = 0.f; if (SLC) selb = ((((jj) < 32) ? (selw0 >> (jj)) : (selw1 >> ((jj) - 32))) & 1u) ? 0.f : -INFINITY; \
            const float base_l = (slope2 * (float)(kv0_ + 4 * h - tw0) - M) + selb, s8 = slope2 * 8.f, s32 = slope2 * 32.f; \
            q0[0] = base_l; q0[1] = q0[0] + slope2; q0[2] = q0[1] + slope2; q0[3] = q0[2] + slope2; \
            _Pragma("unroll") for (int reg = 4; reg < 16; ++reg) q0[reg] = q0[reg - 4] + s8; \
            _Pragma("unroll") for (int reg = 0; reg < 16; ++reg) q1[reg] = q0[reg] + s32; } } while (0)
#define AC2_QK(jj, kslot) do { AC2_INIT(jj, kslot, p0, p1); \
        const LAS unsigned char* kb_ = kfrag + (kslot) * A_KBUF; \
        _Pragma("unroll") for (int s_ = 0; s_ < 4; ++s_) { const bf16x8v kf0 = *(const LAS bf16x8v*)(kb_ + s_ * 32), kf1 = *(const LAS bf16x8v*)(kb_ + 32 * KP + s_ * 32); \
            p0 = __builtin_amdgcn_mfma_f32_32x32x16_bf16(kf0, Qf[s_], p0, 0, 0, 0); p1 = __builtin_amdgcn_mfma_f32_32x32x16_bf16(kf1, Qf[s_], p1, 0, 0, 0); } } while (0)
    u32x4 kreg, vreg; float breg = 0.f;
    u64 mk = tilemask;
    int j = 63 - __builtin_clzll(mk); mk &= ~(1ull << j);
    int jn = -1; if (mk) { jn = 63 - __builtin_clzll(mk); mk &= ~(1ull << jn); }
    { kreg = *(const u32x4*)(ksrc + (size_t)j * 64 * 64); vreg = *(const u32x4*)(vsrc + (size_t)j * 64 * 64); if (FOX && tid < 64) breg = (cum_ref - cum[j * 64 + tid]) * LOG2E;
      *(LAS u32x4*)(L + A_KOFF + kdst) = kreg; *(LAS u32x4*)(L + A_VOFF + vdst) = vreg; if (FOX && tid < 64) *(LAS float*)(L + A_BOFF + tid * 4) = breg;
      if (jn >= 0) { kreg = *(const u32x4*)(ksrc + (size_t)jn * 64 * 64); if (FOX && tid < 64) breg = (cum_ref - cum[jn * 64 + tid]) * LOG2E;
          *(LAS u32x4*)(L + A_KOFF + A_KBUF + kdst) = kreg; if (FOX && tid < 64) *(LAS float*)(L + A_BOFF + 256 + tid * 4) = breg; } }
    __syncthreads();
    f32x16 p0, p1;
    bool started = false;
    int ks = 0, vs = 0;
    if (AC2_ACTIVE(j)) AC2_QK(j, 0);
    for (;;) {
        int jnn = -1; if (mk) { jnn = 63 - __builtin_clzll(mk); mk &= ~(1ull << jnn); }
        if (jnn >= 0) { kreg = *(const u32x4*)(ksrc + (size_t)jnn * 64 * 64); if (FOX && tid < 64) breg = (cum_ref - cum[jnn * 64 + tid]) * LOG2E; }
        if (jn >= 0) vreg = *(const u32x4*)(vsrc + (size_t)jn * 64 * 64);
        const bool act = AC2_ACTIVE(j), actn = jn >= 0 && AC2_ACTIVE(jn);
        if (act) {
            const int kv0 = j * 64;
            if ((kv0 + 63 > tw0) || (tw0 + 31 - kv0 >= win)) { const int dl = t_lane - kv0 - 4 * h;
#pragma unroll
                for (int reg = 0; reg < 16; ++reg) { const int d0 = dl - crow0(reg), d1 = d0 - 32;
                    p0[reg] = (d0 >= 0 && d0 < win) ? p0[reg] : -INFINITY; p1[reg] = (d1 >= 0 && d1 < win) ? p1[reg] : -INFINITY; } }
            float mt = fmaxf(fmaxf(p0[0], p1[0]), fmaxf(p0[1], p1[1]));
#pragma unroll
            for (int reg = 2; reg < 16; reg += 2) mt = fmaxf(fmaxf(mt, fmaxf(fmaxf(p0[reg], p1[reg]), p0[reg + 1])), p1[reg + 1]);
            mt = swap_max(mt);
            if (!started || __any(mt > 8.f)) {
                const float d = (mt > -1e30f) ? (started ? fmaxf(mt, 0.f) : mt) : 0.f, alpha = __builtin_amdgcn_exp2f(-d);
                O[0] *= alpha; O[1] *= alpha; Ls *= alpha; M += d;
#pragma unroll
                for (int reg = 0; reg < 16; ++reg) { p0[reg] -= d; p1[reg] -= d; } }
            started = true;
#if AC2_MODE == 1
            {
                const int jq = jn >= 0 ? jn : 0;
                float rs = 0.f;
#pragma unroll
                for (int reg = 0; reg < 16; ++reg) { p0[reg] = __builtin_amdgcn_exp2f(p0[reg]); p1[reg] = __builtin_amdgcn_exp2f(p1[reg]); rs += p0[reg] + p1[reg]; }
                Ls += rs;
                const bf16x8v pa0 = pack8(p0, 0), pa1 = pack8(p0, 8), pa2 = pack8(p1, 0), pa3 = pack8(p1, 8);
                AC2_QK(jq, ks ^ 1);
                const LAS unsigned char* vb = vfrag + vs * A_VBUF;
#pragma unroll
                for (int db = 0; db < 2; ++db)
#pragma unroll
                    for (int kq = 0; kq < 4; ++kq) { const s16x4 lo = tr_read(vb + kq * (16 * VP) + db * 64), hi = tr_read(vb + kq * (16 * VP) + db * 64 + 8 * VP);
                        const bf16x8v vf = {lo[0], lo[1], lo[2], lo[3], hi[0], hi[1], hi[2], hi[3]};
                        O[db] = __builtin_amdgcn_mfma_f32_32x32x16_bf16(vf, kq == 0 ? pa0 : kq == 1 ? pa1 : kq == 2 ? pa2 : pa3, O[db], 0, 0, 0); }
            }
#else
            {
                const int jq = jn >= 0 ? jn : 0;
                f32x16 n0, n1;
                AC2_INIT(jq, ks ^ 1, n0, n1);
                const LAS unsigned char* kb_ = kfrag + (ks ^ 1) * A_KBUF;
                bf16x8v kf[8];
#pragma unroll
                for (int s_ = 0; s_ < 4; ++s_) { kf[2 * s_] = *(const LAS bf16x8v*)(kb_ + s_ * 32); kf[2 * s_ + 1] = *(const LAS bf16x8v*)(kb_ + 32 * KP + s_ * 32); }
                const LAS unsigned char* vb = vfrag + vs * A_VBUF;
                __builtin_amdgcn_sched_barrier(0);
                float ra = 0.f, rb = 0.f; unsigned w[16];
#define AC2_PINF(x) asm volatile("" : "+v"(x))
#define AC2_QGAP(i) do { if ((i) & 1) n1 = __builtin_amdgcn_mfma_f32_32x32x16_bf16(kf[i], Qf[(i) >> 1], n1, 0, 0, 0); else n0 = __builtin_amdgcn_mfma_f32_32x32x16_bf16(kf[i], Qf[(i) >> 1], n0, 0, 0, 0); \
                    float e0 = __builtin_amdgcn_exp2f(p0[2 * (i)]), e1 = __builtin_amdgcn_exp2f(p0[2 * (i) + 1]), e2 = __builtin_amdgcn_exp2f(p1[2 * (i)]), e3 = __builtin_amdgcn_exp2f(p1[2 * (i) + 1]); \
                    ra += e0 + e1; rb += e2 + e3; \
                    AC2_PINF(e0); AC2_PINF(e1); AC2_PINF(e2); AC2_PINF(e3); AC2_PINF(ra); AC2_PINF(rb); \
                    p0[2 * (i)] = e0; p0[2 * (i) + 1] = e1; p1[2 * (i)] = e2; p1[2 * (i) + 1] = e3; \
                    if ((i) >= 4) { w[2 * ((i) - 4)] = cvtpk(p0[4 * ((i) - 4)], p0[4 * ((i) - 4) + 1]); w[2 * ((i) - 4) + 1] = cvtpk(p0[4 * ((i) - 4) + 2], p0[4 * ((i) - 4) + 3]); AC2_PINF(w[2 * ((i) - 4)]); AC2_PINF(w[2 * ((i) - 4) + 1]); } \
                    if ((i) == 6) { vl[0] = tr_read(vb); vh[0] = tr_read(vb + 8 * VP); } \
                    if ((i) == 7) { vl[1] = tr_read(vb + 64); vh[1] = tr_read(vb + 64 + 8 * VP); } \
                    __builtin_amdgcn_sched_barrier(0); } while (0)
                s16x4 vl[2], vh[2];
                AC2_QGAP(0); AC2_QGAP(1); AC2_QGAP(2); AC2_QGAP(3); AC2_QGAP(4); AC2_QGAP(5); AC2_QGAP(6); AC2_QGAP(7);
                Ls += ra + rb;
#define AC2_PA(kq) __builtin_bit_cast(bf16x8v, (u32x4){w[4 * (kq)], w[4 * (kq) + 1], w[4 * (kq) + 2], w[4 * (kq) + 3]})
#define AC2_PGAP(g) do { const int kq_ = (g) >> 1, db_ = (g) & 1; const bf16x8v vf = {vl[(g) & 1][0], vl[(g) & 1][1], vl[(g) & 1][2], vl[(g) & 1][3], vh[(g) & 1][0], vh[(g) & 1][1], vh[(g) & 1][2], vh[(g) & 1][3]}; \
                    if ((g) < 6) { const int kq2 = ((g) + 2) >> 1, db2 = (g) & 1; vl[(g) & 1] = tr_read(vb + kq2 * (16 * VP) + db2 * 64); vh[(g) & 1] = tr_read(vb + kq2 * (16 * VP) + db2 * 64 + 8 * VP); } \
                    O[db_] = __builtin_amdgcn_mfma_f32_32x32x16_bf16(vf, AC2_PA(kq_), O[db_], 0, 0, 0); \
                    if ((g) < 4) { w[8 + 2 * (g)] = cvtpk(p1[4 * (g)], p1[4 * (g) + 1]); w[8 + 2 * (g) + 1] = cvtpk(p1[4 * (g) + 2], p1[4 * (g) + 3]); AC2_PINF(w[8 + 2 * (g)]); AC2_PINF(w[8 + 2 * (g) + 1]); } \
                    __builtin_amdgcn_sched_barrier(0); } while (0)
                AC2_PGAP(0); AC2_PGAP(1); AC2_PGAP(2); AC2_PGAP(3); AC2_PGAP(4); AC2_PGAP(5); AC2_PGAP(6); AC2_PGAP(7);
#undef AC2_PGAP
#undef AC2_PA
#undef AC2_QGAP
#undef AC2_PINF
                p0 = n0; p1 = n1;
            }
#endif
        } else if (actn) AC2_QK(jn, ks ^ 1);
        if (jnn >= 0) { *(LAS u32x4*)(L + A_KOFF + ks * A_KBUF + kdst) = kreg; if (FOX && tid < 64) *(LAS float*)(L + A_BOFF + ks * 256 + tid * 4) = breg; }
        if (jn >= 0) *(LAS u32x4*)(L + A_VOFF + (vs ^ 1) * A_VBUF + vdst) = vreg;
        __syncthreads();
        if (jn < 0) break;
        j = jn; jn = jnn; ks ^= 1; vs ^= 1;
    }
#undef AC2_QK
#undef AC2_INIT
#undef AC2_ACTIVE
}
__device__ __forceinline__ size_t mix_off(size_t n, int c, int W) { return ((n >> 5) * (size_t)(W / 8) + (size_t)(c >> 3)) * 256 + (n & 31) * 8 + (c & 7); }
#define ATTN_FOR_CHUNKS(db, g4) _Pragma("unroll") for (int db = 0; db < 2; ++db) _Pragma("unroll") for (int g4 = 0; g4 < 4; ++g4)

__device__ __forceinline__ void unpack8(const u32x4 w, float (&f)[8]) { f[0] = __uint_as_float(w.x << 16); f[1] = __uint_as_float(w.x & 0xffff0000u); f[2] = __uint_as_float(w.y << 16); f[3] = __uint_as_float(w.y & 0xffff0000u);
    f[4] = __uint_as_float(w.z << 16); f[5] = __uint_as_float(w.z & 0xffff0000u); f[6] = __uint_as_float(w.w << 16); f[7] = __uint_as_float(w.w & 0xffff0000u); }
__device__ __forceinline__ void ph_norm_bf16_from_bf16(const Ctx& c, const bf16* x, const float* g, bf16* out) {
    constexpr int RB = 4; float gg[2][8];
#pragma unroll
    for (int j = 0; j < 2; ++j) { const f32x4 a = ((const f32x4*)g)[2 * c.lane + 128 * j], b2 = ((const f32x4*)g)[2 * c.lane + 128 * j + 1]; gg[j][0] = a.x; gg[j][1] = a.y; gg[j][2] = a.z; gg[j][3] = a.w; gg[j][4] = b2.x; gg[j][5] = b2.y; gg[j][6] = b2.z; gg[j][7] = b2.w; }
    for (int row0 = c.gw * RB; row0 < NT; row0 += c.ngw * RB) {
        u32x4 v[RB][2];
#pragma unroll
        for (int q = 0; q < RB; ++q)
#pragma unroll
            for (int j = 0; j < 2; ++j) v[q][j] = ((const u32x4*)(x + (size_t)(row0 + q) * D_))[c.lane + 64 * j];
#pragma unroll
        for (int q = 0; q < RB; ++q) { float f[2][8]; float ss = 0.f;
#pragma unroll
            for (int j = 0; j < 2; ++j) { unpack8(v[q][j], f[j]);
#pragma unroll
                for (int e = 0; e < 8; ++e) ss = fmaf(f[j][e], f[j][e], ss); }
            const float r = rsqrtf(wave_sum(ss) * (1.f / D_) + EPS);
#pragma unroll
            for (int j = 0; j < 2; ++j) { u32x4 o; o.x = pk2(f[j][0] * r * gg[j][0], f[j][1] * r * gg[j][1]); o.y = pk2(f[j][2] * r * gg[j][2], f[j][3] * r * gg[j][3]); o.z = pk2(f[j][4] * r * gg[j][4], f[j][5] * r * gg[j][5]); o.w = pk2(f[j][6] * r * gg[j][6], f[j][7] * r * gg[j][7]);
                ((u32x4*)(out + (size_t)(row0 + q) * D_))[c.lane + 64 * j] = o; } }
    }
}
__device__ __forceinline__ void ph_norm_final_from_bf16(const Ctx& c, const bf16* x, const float* g, float* out) {
    constexpr int RB = 4; float gg[2][8];
#pragma unroll
    for (int j = 0; j < 2; ++j) { const f32x4 a = ((const f32x4*)g)[2 * c.lane + 128 * j], b2 = ((const f32x4*)g)[2 * c.lane + 128 * j + 1]; gg[j][0] = a.x; gg[j][1] = a.y; gg[j][2] = a.z; gg[j][3] = a.w; gg[j][4] = b2.x; gg[j][5] = b2.y; gg[j][6] = b2.z; gg[j][7] = b2.w; }
    for (int row0 = c.gw * RB; row0 < NT; row0 += c.ngw * RB) {
        u32x4 v[RB][2];
#pragma unroll
        for (int q = 0; q < RB; ++q)
#pragma unroll
            for (int j = 0; j < 2; ++j) v[q][j] = ((const u32x4*)(x + (size_t)(row0 + q) * D_))[c.lane + 64 * j];
#pragma unroll
        for (int q = 0; q < RB; ++q) { float f[2][8]; float ss = 0.f;
#pragma unroll
            for (int j = 0; j < 2; ++j) { unpack8(v[q][j], f[j]);
#pragma unroll
                for (int e = 0; e < 8; ++e) ss = fmaf(f[j][e], f[j][e], ss); }
            const float r = rsqrtf(wave_sum(ss) * (1.f / D_) + EPS);
#pragma unroll
            for (int j = 0; j < 2; ++j) { f32x4* o = (f32x4*)(out + (size_t)(row0 + q) * D_) + 2 * c.lane + 128 * j;
                o[0] = (f32x4){f[j][0] * r * gg[j][0], f[j][1] * r * gg[j][1], f[j][2] * r * gg[j][2], f[j][3] * r * gg[j][3]}; o[1] = (f32x4){f[j][4] * r * gg[j][4], f[j][5] * r * gg[j][5], f[j][6] * r * gg[j][6], f[j][7] * r * gg[j][7]}; } }
    }
}
__device__ __forceinline__ void ph_norm_bf16(const Ctx& c, const float* x, const float* g, bf16* out, bf16* raw) {
    constexpr int RB = 4;
    f32x4 gg[4];
#pragma unroll
    for (int j = 0; j < 4; ++j) gg[j] = ((const f32x4*)g)[c.lane + 64 * j];
    for (int row0 = c.gw * RB; row0 < NT; row0 += c.ngw * RB) {
        f32x4 v[RB][4];
#pragma unroll
        for (int q = 0; q < RB; ++q)
#pragma unroll
            for (int j = 0; j < 4; ++j) v[q][j] = ((const f32x4*)(x + (size_t)(row0 + q) * D_))[c.lane + 64 * j];
#pragma unroll
        for (int q = 0; q < RB; ++q) { float ss = 0.f;
#pragma unroll
            for (int j = 0; j < 4; ++j) ss += v[q][j].x * v[q][j].x + v[q][j].y * v[q][j].y + v[q][j].z * v[q][j].z + v[q][j].w * v[q][j].w;
            const float r = rsqrtf(wave_sum(ss) * (1.f / D_) + EPS);
            u64* o8 = (u64*)(out + (size_t)(row0 + q) * D_) + c.lane; u64* r8 = (u64*)(raw + (size_t)(row0 + q) * D_) + c.lane;
#pragma unroll
            for (int j = 0; j < 4; ++j) { o8[64 * j] = (u64)pk2(v[q][j].x * r * gg[j].x, v[q][j].y * r * gg[j].y) | ((u64)pk2(v[q][j].z * r * gg[j].z, v[q][j].w * r * gg[j].w) << 32);
                r8[64 * j] = (u64)pk2(v[q][j].x, v[q][j].y) | ((u64)pk2(v[q][j].z, v[q][j].w) << 32); } }
    }
}
__device__ __forceinline__ void ph_norm_final(const Ctx& c, float* x, const float* g) {
    constexpr int RB = 4;
    f32x4 gg[4];
#pragma unroll
    for (int j = 0; j < 4; ++j) gg[j] = ((const f32x4*)g)[c.lane + 64 * j];
    for (int row0 = c.gw * RB; row0 < NT; row0 += c.ngw * RB) {
        f32x4 v[RB][4];
#pragma unroll
        for (int q = 0; q < RB; ++q)
#pragma unroll
            for (int j = 0; j < 4; ++j) v[q][j] = ((const f32x4*)(x + (size_t)(row0 + q) * D_))[c.lane + 64 * j];
#pragma unroll
        for (int q = 0; q < RB; ++q) { float ss = 0.f;
#pragma unroll
            for (int j = 0; j < 4; ++j) ss += v[q][j].x * v[q][j].x + v[q][j].y * v[q][j].y + v[q][j].z * v[q][j].z + v[q][j].w * v[q][j].w;
            const float r = rsqrtf(wave_sum(ss) * (1.f / D_) + EPS);
            f32x4* xr = (f32x4*)(x + (size_t)(row0 + q) * D_) + c.lane;
#pragma unroll
            for (int j = 0; j < 4; ++j) xr[64 * j] = v[q][j] * r * gg[j]; }
    }
}

template <class AF, class EF>
__device__ __forceinline__ void naive_gemm(const Ctx& c, int M, int N, int K, AF af, const float* W, int ldb, EF ef) {
    LAS float* As = (LAS float*)c.lds;
    LAS float* Bs = As + 16 * 132;
    const int tm = (M + 127) / 128, tn = (N + 127) / 128, ntile = tm * tn;
    const int ty = c.tid >> 4, tx = c.tid & 15;
    for (int tile = c.bid; tile < ntile; tile += c.G) {
        const int m0 = (tile / tn) * 128, n0 = (tile % tn) * 128;
        float acc[4][8];
#pragma unroll
        for (int i = 0; i < 4; ++i)
#pragma unroll
            for (int j = 0; j < 8; ++j) acc[i][j] = 0.f;
        for (int k0 = 0; k0 < K; k0 += 16) {
            __syncthreads();
#pragma unroll
            for (int i = 0; i < 4; ++i) { const int e = c.tid + i * 512, r = e >> 4, kk = e & 15; const int row = m0 + r;
                As[kk * 132 + r] = (row < M) ? af(row, k0 + kk) : 0.f; }
#pragma unroll
            for (int i = 0; i < 4; ++i) { const int e = c.tid + i * 512, kk = e >> 7, cc = e & 127; const int col = n0 + cc;
                Bs[kk * 132 + cc] = (col < N) ? W[(size_t)(k0 + kk) * ldb + col] : 0.f; }
            __syncthreads();
#pragma unroll 2
            for (int kk = 0; kk < 16; ++kk) {
                float a[4], b[8];
#pragma unroll
                for (int i = 0; i < 4; ++i) a[i] = As[kk * 132 + ty * 4 + i];
#pragma unroll
                for (int j = 0; j < 8; ++j) b[j] = Bs[kk * 132 + tx * 8 + j];
#pragma unroll
                for (int i = 0; i < 4; ++i)
#pragma unroll
                    for (int j = 0; j < 8; ++j) acc[i][j] = fmaf(a[i], b[j], acc[i][j]);
            }
        }
        LAS float* Cs = Bs + 16 * 132;
        __syncthreads();
#pragma unroll
        for (int i = 0; i < 4; ++i)
#pragma unroll
            for (int j = 0; j < 8; ++j) Cs[(ty * 4 + i) * 129 + tx * 8 + j] = acc[i][j];
        __syncthreads();
#pragma unroll 1
        for (int e = c.tid; e < 128 * 128; e += NTHREADS) { const int r = e >> 7, cc = e & 127, row = m0 + r, col = n0 + cc; if (row < M && col < N) ef(row, col, Cs[r * 129 + cc]); }
    }
    __syncthreads();
}

struct InProjOut { bf16* qn; bf16* kv6; bf16* fqkv; bf16* dqk; bf16* dv; float* gate; float* fl; const float* b_gate; const float* b_fgt; };
__device__ __forceinline__ void inproj_store(const InProjOut& o, int n, int col, float v) {
    const int b = n / T_, t = n % T_;
    if (col < C_KV6) { const int h = col >> 6, d = col & 63; o.qn[((size_t)(b * 8 + h) * T_ + t) * 64 + d] = (bf16)f2bf(v * (0.125f * LOG2E)); }
    else if (col < C_GATE) { const int cc = col - C_KV6, idx = cc >> 7, g = (cc >> 6) & 1, d = cc & 63;
        ((bf16*)((unsigned char*)o.kv6 + idx * KV6_STRIDE))[((size_t)(b * 2 + g) * T_ + t) * 64 + d] = (bf16)f2bf(v); }
    else if (col < C_FQ) { const int j = col - C_GATE; o.gate[(size_t)n * 24 + j] = sigmoidf_(v + o.b_gate[j]); }
    else if (col < C_FF) { const int cc = col - C_FQ, idx = cc >> 8, h = (cc >> 6) & 3, d = cc & 63;
        o.fqkv[(size_t)idx * (8 * MiB) + ((size_t)(b * 4 + h) * T_ + t) * 64 + d] = (bf16)f2bf(idx == 0 ? v * (0.125f * LOG2E) : v); }
    else if (col < C_DQ) { const int h = col - C_FF; o.fl[(size_t)(b * 4 + h) * T_ + t] = log_sigmoidf_(v + o.b_fgt[h]); }
    else if (col < C_DV) { const int cc = col - C_DQ, idx = cc >> 8, h = (cc >> 6) & 3, i = (cc >> 5) & 1, d = cc & 31;
        o.dqk[(size_t)idx * (8 * MiB) + ((size_t)((b * 4 + h) * 2 + i) * T_ + t) * 32 + d] = (bf16)f2bf(idx == 0 ? v * (0.17677669529663687f * LOG2E) : v); }
    else { const int cc = col - C_DV, h = cc >> 6, d = cc & 63; o.dv[((size_t)(b * 4 + h) * T_ + t) * 64 + d] = (bf16)f2bf(v); }
}

__device__ __forceinline__ void ph_cumsum(const Ctx& c, float* fl) {
    for (int s = c.gw; s < B_ * 4; s += c.ngw) {
        float* p = fl + (size_t)s * T_; float carry = 0.f;
        for (int t0 = 0; t0 < T_; t0 += 64) {
            float v = p[t0 + c.lane];
#pragma unroll
            for (int o = 1; o < 64; o <<= 1) { const float u = __shfl_up(v, o); if (c.lane >= o) v += u; }
            v += carry; p[t0 + c.lane] = v; carry = __shfl(v, 63);
        }
    }
}

template <int DQK>
__device__ __forceinline__ float naive_attn_row(const bf16* q, const bf16* K, const bf16* V, int t, u64 mask, float slope2, const float* cum, int win, int lane) {
    float qv[DQK];
    { const u32x4* q4 = (const u32x4*)q;
#pragma unroll
      for (int i = 0; i < DQK / 8; ++i) { const u32x4 w = q4[i];
          qv[8 * i + 0] = __uint_as_float(w.x << 16); qv[8 * i + 1] = __uint_as_float(w.x & 0xffff0000u);
          qv[8 * i + 2] = __uint_as_float(w.y << 16); qv[8 * i + 3] = __uint_as_float(w.y & 0xffff0000u);
          qv[8 * i + 4] = __uint_as_float(w.z << 16); qv[8 * i + 5] = __uint_as_float(w.z & 0xffff0000u);
          qv[8 * i + 6] = __uint_as_float(w.w << 16); qv[8 * i + 7] = __uint_as_float(w.w & 0xffff0000u); } }
    const float cumt = cum ? cum[t] : 0.f;
    float m = -INFINITY, l = 0.f, o = 0.f;
    while (mask) {
        const int j = __builtin_ctzll(mask); mask &= mask - 1;
        const int kpos = 64 * j + lane; const int dist = t - kpos;
        const bool valid = dist >= 0 && dist < win;
        float s = 0.f;
        { const u32x4* k4 = (const u32x4*)(K + (size_t)kpos * DQK);
#pragma unroll
          for (int i = 0; i < DQK / 8; ++i) { const u32x4 w = k4[i];
              s = fmaf(qv[8 * i + 0], __uint_as_float(w.x << 16), s); s = fmaf(qv[8 * i + 1], __uint_as_float(w.x & 0xffff0000u), s);
              s = fmaf(qv[8 * i + 2], __uint_as_float(w.y << 16), s); s = fmaf(qv[8 * i + 3], __uint_as_float(w.y & 0xffff0000u), s);
              s = fmaf(qv[8 * i + 4], __uint_as_float(w.z << 16), s); s = fmaf(qv[8 * i + 5], __uint_as_float(w.z & 0xffff0000u), s);
              s = fmaf(qv[8 * i + 6], __uint_as_float(w.w << 16), s); s = fmaf(qv[8 * i + 7], __uint_as_float(w.w & 0xffff0000u), s); } }
        s -= slope2 * (float)dist;
        if (cum) s += (cumt - cum[kpos]) * LOG2E;
        s = valid ? s : -INFINITY;
        const float mb = wave_max(s);
        if (mb == -INFINITY) continue;
        const float mn = fmaxf(m, mb), alpha = exp2f(m - mn);
        const float p = valid ? exp2f(s - mn) : 0.f;
        l = l * alpha + wave_sum(p); o *= alpha; m = mn;
        const bf16* vb = V + (size_t)(64 * j) * 64 + lane;
#pragma unroll 8
        for (int k = 0; k < 64; ++k) o = fmaf(__shfl(p, k), bf2f(vb[(size_t)k * 64]), o);
    }
    return l > 0.f ? o / l : 0.f;
}

__device__ __forceinline__ void ph_cmp_attn(const Ctx& c, const bf16* qn, const bf16* kcmp, const bf16* vcmp, const float* gate, u64* sel, bf16* ocmp) {
    LAS float* pl = (LAS float*)(c.lds) + c.wave * 256;
    const int lane = c.lane;
    for (int it = c.gw; it < B_ * 2 * T_; it += c.ngw) {
        const int t = it % T_, bg = it / T_, b = bg >> 1, g = bg & 1;
        const int nvis = (t >= 31) ? ((t - 31) >> 4) + 1 : 0;
        const bf16* kc = kcmp + (size_t)bg * 256 * 64; const bf16* vc = vcmp + (size_t)bg * 256 * 64;
        float imp = 0.f;
        for (int hg = 0; hg < 4; ++hg) {
            const int h = g * 4 + hg; const float slope2 = alibi_slope(h + 1, 8) * LOG2E;
            const bf16* q = qn + ((size_t)(b * 8 + h) * T_ + t) * 64;
            float qv[64];
            { const u32x4* q4 = (const u32x4*)q;
#pragma unroll
              for (int i = 0; i < 8; ++i) { const u32x4 w = q4[i];
                  qv[8 * i + 0] = __uint_as_float(w.x << 16); qv[8 * i + 1] = __uint_as_float(w.x & 0xffff0000u);
                  qv[8 * i + 2] = __uint_as_float(w.y << 16); qv[8 * i + 3] = __uint_as_float(w.y & 0xffff0000u);
                  qv[8 * i + 4] = __uint_as_float(w.z << 16); qv[8 * i + 5] = __uint_as_float(w.z & 0xffff0000u);
                  qv[8 * i + 6] = __uint_as_float(w.w << 16); qv[8 * i + 7] = __uint_as_float(w.w & 0xffff0000u); } }
            float s[4]; float m = -INFINITY;
#pragma unroll
            for (int i = 0; i < 4; ++i) { const int cc = lane + 64 * i; float a = 0.f;
                if (cc < nvis) { const u32x4* k4 = (const u32x4*)(kc + (size_t)cc * 64);
#pragma unroll
                    for (int e = 0; e < 8; ++e) { const u32x4 w = k4[e];
                        a = fmaf(qv[8 * e + 0], __uint_as_float(w.x << 16), a); a = fmaf(qv[8 * e + 1], __uint_as_float(w.x & 0xffff0000u), a);
                        a = fmaf(qv[8 * e + 2], __uint_as_float(w.y << 16), a); a = fmaf(qv[8 * e + 3], __uint_as_float(w.y & 0xffff0000u), a);
                        a = fmaf(qv[8 * e + 4], __uint_as_float(w.z << 16), a); a = fmaf(qv[8 * e + 5], __uint_as_float(w.z & 0xffff0000u), a);
                        a = fmaf(qv[8 * e + 6], __uint_as_float(w.w << 16), a); a = fmaf(qv[8 * e + 7], __uint_as_float(w.w & 0xffff0000u), a); }
                    a -= slope2 * (float)(t - (16 * cc + 31)); } else a = -INFINITY;
                s[i] = a; m = fmaxf(m, a); }
            m = wave_max(m);
            float p[4], lsum = 0.f;
#pragma unroll
            for (int i = 0; i < 4; ++i) { p[i] = (lane + 64 * i < nvis) ? exp2f(s[i] - m) : 0.f; lsum += p[i]; }
            lsum = wave_sum(lsum);
            const float inv = lsum > 0.f ? 1.f / lsum : 0.f;
#pragma unroll
            for (int i = 0; i < 4; ++i) { p[i] *= inv; pl[lane + 64 * i] = p[i]; }
            asm volatile("s_waitcnt lgkmcnt(0)" ::: "memory");
            float o = 0.f;
            for (int cc = 0; cc < nvis; ++cc) o = fmaf(pl[cc], bf2f(vc[(size_t)cc * 64 + lane]), o);
            const float gt = gate[((size_t)(b * T_ + t)) * 24 + h * 3 + 0];
            ocmp[(size_t)(b * T_ + t) * 512 + h * 64 + lane] = (bf16)f2bf(gt * o);
            { const int j = lane; float a = pl[4 * j] + pl[4 * j + 1] + pl[4 * j + 2] + 0.5f * pl[4 * j + 3]; if (j > 0) a += 0.5f * pl[4 * j - 1]; imp += a; }
            asm volatile("s_waitcnt lgkmcnt(0)" ::: "memory");
        }
        const int cur = t >> 6; const int j = lane;
        u64 m64;
        if (cur <= 15) m64 = (cur == 63) ? ~0ull : ((1ull << (cur + 1)) - 1ull);
        else {
            float val = (j > cur) ? -INFINITY : ((j == 0 || j == cur || j == cur - 1) ? 1e4f : imp);
            m64 = 0ull;
            for (int r = 0; r < 16; ++r) {
                const float mx = wave_max(val);
                const u64 bal = __ballot(val == mx);
                const int w = __builtin_ctzll(bal);
                m64 |= 1ull << w; if (j == w) val = -INFINITY;
            }
        }
        if (lane == 0) sel[(size_t)bg * T_ + t] = m64;
    }
}

__device__ __forceinline__ void ph_win_attn(const Ctx& c, const bf16* qn, const bf16* kw, const bf16* vw, const float* gate, bf16* owin) {
    for (int it = c.gw; it < B_ * 8 * T_; it += c.ngw) {
        const int t = it % T_, bh = it / T_, b = bh >> 3, h = bh & 7, g = h >> 2;
        const int cur = t >> 6, jlo = (t - 511) > 0 ? (t - 511) >> 6 : 0;
        const u64 hi = (cur == 63) ? ~0ull : ((1ull << (cur + 1)) - 1ull); const u64 mask = hi & ~((1ull << jlo) - 1ull);
        const float o = naive_attn_row<64>(qn + ((size_t)bh * T_ + t) * 64, kw + (size_t)(b * 2 + g) * T_ * 64, vw + (size_t)(b * 2 + g) * T_ * 64, t, mask,
                                           alibi_slope(h + 1, 8) * LOG2E, nullptr, 512, c.lane);
        owin[(size_t)(b * T_ + t) * 512 + h * 64 + c.lane] = (bf16)f2bf(gate[(size_t)(b * T_ + t) * 24 + h * 3 + 2] * o);
    }
}
__device__ __forceinline__ void ph_slc_attn(const Ctx& c, const bf16* qn, const bf16* ks, const bf16* vs, const float* gate, const u64* sel, const bf16* ocmp, const bf16* owin, bf16* att) {
    for (int it = c.gw; it < B_ * 8 * T_; it += c.ngw) {
        const int t = it % T_, bh = it / T_, b = bh >> 3, h = bh & 7, g = h >> 2;
        const u64 mask = sel[(size_t)(b * 2 + g) * T_ + t];
        const float o = naive_attn_row<64>(qn + ((size_t)bh * T_ + t) * 64, ks + (size_t)(b * 2 + g) * T_ * 64, vs + (size_t)(b * 2 + g) * T_ * 64, t, mask,
                                           alibi_slope(h + 1, 8) * LOG2E, nullptr, 1 << 30, c.lane);
        const size_t n = (size_t)(b * T_ + t);
        const float r = gate[n * 24 + h * 3 + 1] * o + bf2f(ocmp[n * 512 + h * 64 + c.lane]) + bf2f(owin[n * 512 + h * 64 + c.lane]);
        att[n * 1024 + h * 64 + c.lane] = (bf16)f2bf(r);
    }
}
__device__ __forceinline__ void ph_fox_attn(const Ctx& c, const bf16* fq, const bf16* fk, const bf16* fv, const float* cum, bf16* att) {
    for (int it = c.gw; it < B_ * 4 * T_; it += c.ngw) {
        const int t = it % T_, bh = it / T_, b = bh >> 2, h = bh & 3;
        const int cur = t >> 6; const u64 mask = (cur == 63) ? ~0ull : ((1ull << (cur + 1)) - 1ull);
        const float o = naive_attn_row<64>(fq + ((size_t)bh * T_ + t) * 64, fk + (size_t)bh * T_ * 64, fv + (size_t)bh * T_ * 64, t, mask, 0.f, cum + (size_t)bh * T_, 1 << 30, c.lane);
        att[(size_t)(b * T_ + t) * 1024 + 512 + h * 64 + c.lane] = (bf16)f2bf(o);
    }
}
__device__ __forceinline__ void ph_diff_attn(const Ctx& c, const bf16* dq, const bf16* dk, const bf16* dv, const float* lam, const float* subln, float lambda_init, bf16* att) {
    float l1 = 0.f, l2 = 0.f;
    if (c.lane < 32) { l1 = lam[c.lane] * lam[32 + c.lane]; l2 = lam[64 + c.lane] * lam[96 + c.lane]; }
    const float lam_full = __expf(wave_sum(l1)) - __expf(wave_sum(l2)) + lambda_init;
    const float sg = subln[c.lane] * (1.f - lambda_init);
    for (int it = c.gw; it < B_ * 4 * T_; it += c.ngw) {
        const int t = it % T_, bh = it / T_, b = bh >> 2, h = bh & 3;
        const int cur = t >> 6; const u64 mask = (cur == 63) ? ~0ull : ((1ull << (cur + 1)) - 1ull);
        const float slope2 = alibi_slope(h + 1, 4) * LOG2E;
        const bf16* vb = dv + (size_t)bh * T_ * 64;
        const float o1 = naive_attn_row<32>(dq + ((size_t)(bh * 2 + 0) * T_ + t) * 32, dk + (size_t)(bh * 2 + 0) * T_ * 32, vb, t, mask, slope2, nullptr, 1 << 30, c.lane);
        const float o2 = naive_attn_row<32>(dq + ((size_t)(bh * 2 + 1) * T_ + t) * 32, dk + (size_t)(bh * 2 + 1) * T_ * 32, vb, t, mask, slope2, nullptr, 1 << 30, c.lane);
        const float o = o1 - lam_full * o2;
        const float r = rsqrtf(wave_sum(o * o) * (1.f / 64.f) + EPS);
        att[(size_t)(b * T_ + t) * 1024 + 768 + h * 64 + c.lane] = (bf16)f2bf(o * r * sg);
    }
}

__device__ __forceinline__ void ph_moe_route(const Ctx& c, const float* x, const float* g, const float* wgrp, const float* bgrp, const float* wexp, const float* bexp, bf16* hn, int* route_e, float* route_w, unsigned* cnt) {
    for (int row = c.gw; row < NT; row += c.ngw) {
        const f32x4* xr = (const f32x4*)(x + (size_t)row * D_) + c.lane;
        f32x4 v[4]; float ss = 0.f;
#pragma unroll
        for (int j = 0; j < 4; ++j) { v[j] = xr[64 * j]; ss += v[j].x * v[j].x + v[j].y * v[j].y + v[j].z * v[j].z + v[j].w * v[j].w; }
        const float r = rsqrtf(wave_sum(ss) * (1.f / D_) + EPS);
        u64* o8 = (u64*)(hn + (size_t)row * D_) + c.lane;
#pragma unroll
        for (int j = 0; j < 4; ++j) { const f32x4 gg = ((const f32x4*)g)[c.lane + 64 * j]; v[j] = v[j] * r * gg;
            o8[64 * j] = (u64)pk2(v[j].x, v[j].y) | ((u64)pk2(v[j].z, v[j].w) << 32); }
        float gl[4];
#pragma unroll
        for (int q = 0; q < 4; ++q) { float a = 0.f;
#pragma unroll
            for (int j = 0; j < 4; ++j) { const int k = 4 * (c.lane + 64 * j);
                a = fmaf(v[j].x, wgrp[(size_t)(k + 0) * 4 + q], a); a = fmaf(v[j].y, wgrp[(size_t)(k + 1) * 4 + q], a);
                a = fmaf(v[j].z, wgrp[(size_t)(k + 2) * 4 + q], a); a = fmaf(v[j].w, wgrp[(size_t)(k + 3) * 4 + q], a); }
            gl[q] = wave_sum(a) + bgrp[q]; }
        int grp = 0; float gm = gl[0];
#pragma unroll
        for (int q = 1; q < 4; ++q) if (gl[q] > gm) { gm = gl[q]; grp = q; }
        float gs = 0.f;
#pragma unroll
        for (int q = 0; q < 4; ++q) gs += __expf(gl[q] - gm);
        const float grp_gate = 1.f / gs;
        float el[8];
#pragma unroll
        for (int q = 0; q < 8; ++q) { float a = 0.f; const int col = grp * 8 + q;
#pragma unroll
            for (int j = 0; j < 4; ++j) { const int k = 4 * (c.lane + 64 * j);
                a = fmaf(v[j].x, wexp[(size_t)(k + 0) * 32 + col], a); a = fmaf(v[j].y, wexp[(size_t)(k + 1) * 32 + col], a);
                a = fmaf(v[j].z, wexp[(size_t)(k + 2) * 32 + col], a); a = fmaf(v[j].w, wexp[(size_t)(k + 3) * 32 + col], a); }
            el[q] = wave_sum(a) + bexp[col]; }
        int i0 = 0; float v0 = el[0];
#pragma unroll
        for (int q = 1; q < 8; ++q) if (el[q] > v0) { v0 = el[q]; i0 = q; }
        int i1 = -1; float v1 = -INFINITY;
#pragma unroll
        for (int q = 0; q < 8; ++q) if (q != i0 && el[q] > v1) { v1 = el[q]; i1 = q; }
        const float e1 = __expf(v1 - v0), den = 1.f + e1;
        if (c.lane == 0) { const float w0 = grp_gate / den, w1 = grp_gate * e1 / den;
            const int lo = i0 < i1 ? i0 : i1, hi = i0 < i1 ? i1 : i0, cls = grp * 28 + lo * 8 - (lo * (lo + 1)) / 2 + (hi - lo - 1);
            const unsigned rank = __hip_atomic_fetch_add(cnt + cls, 1u, __ATOMIC_RELAXED, __HIP_MEMORY_SCOPE_AGENT);
            route_e[row] = (int)(((unsigned)cls << 24) | rank); route_w[2 * row] = i0 < i1 ? w0 : w1; route_w[2 * row + 1] = i0 < i1 ? w1 : w0; }
    }
}
__device__ __forceinline__ void ph_moe_naive(const Ctx& c, const bf16* hn, const int* route_e, const float* route_w, const float* wg, const float* wu, const float* wd, float* x) {
    LAS float* hs = (LAS float*)c.lds;
    LAS float* au = hs + 1024;
    LAS float* h2 = au + 512;
    for (int row = c.bid; row < NT; row += c.G) {
        __syncthreads();
        hs[c.tid] = bf2f(hn[(size_t)row * D_ + c.tid]); hs[c.tid + 512] = bf2f(hn[(size_t)row * D_ + c.tid + 512]);
        float o0 = 0.f, o1 = 0.f;
        for (int s = 0; s < 2; ++s) {
            const int e = route_e[2 * row + s]; const float w = route_w[2 * row + s];
            __syncthreads();
            const float* W = (c.tid < 256 ? wg : wu) + (size_t)e * D_ * DEXP + (c.tid & 255);
            float a = 0.f;
            for (int k = 0; k < D_; ++k) a = fmaf(hs[k], W[(size_t)k * DEXP], a);
            au[c.tid] = a;
            __syncthreads();
            if (c.tid < 256) { const float ga = au[c.tid], up = au[c.tid + 256]; h2[c.tid] = ga / (1.f + __expf(-ga)) * up * w; }
            __syncthreads();
            const float* Wd = wd + (size_t)e * DEXP * D_;
            for (int k = 0; k < DEXP; ++k) { const float hv = h2[k]; o0 = fmaf(hv, Wd[(size_t)k * D_ + c.tid], o0); o1 = fmaf(hv, Wd[(size_t)k * D_ + c.tid + 512], o1); }
        }
        x[(size_t)row * D_ + c.tid] += o0; x[(size_t)row * D_ + c.tid + 512] += o1;
    }
    __syncthreads();
}

typedef __attribute__((address_space(4))) const Params* KP;
__device__ __forceinline__ KP uni_kp(KP p) { const unsigned long long v = (unsigned long long)p; const unsigned lo = __builtin_amdgcn_readfirstlane((unsigned)v), hi = __builtin_amdgcn_readfirstlane((unsigned)(v >> 32)); return (KP)(((unsigned long long)hi << 32) | lo); }
constexpr int PH_PER_LAYER = 11, N_PHASES = L_ * PH_PER_LAYER + 2;
__device__ __forceinline__ Ctx make_ctx(KP p) {
    Ctx c; c.lds = (LAS unsigned char*)lds_raw; { int t_ = threadIdx.x; asm volatile("" : "+v"(t_)); c.tid = t_; } c.lane = c.tid & 63; c.wave = __builtin_amdgcn_readfirstlane(c.tid >> 6);
    c.bid = blockIdx.x; c.G = gridDim.x; c.gw = c.bid * NWAVES + c.wave; c.ngw = c.G * NWAVES; c.in = nullptr; c.xcur = p->out; c.ws = p->ws;
    return c;
}
struct Bufs {
    bf16 *QN, *KV6, *KC, *VC, *KS, *VS, *KW, *VW, *FQ, *FK, *FV, *DQ, *DK, *DV, *HC, *KCMP, *VCMP, *OCMP, *OWIN, *HN, *ATT;
    float *GATE, *FL, *ROUTE_W; u64* SEL; int* ROUTE_E;
};
__device__ __forceinline__ Bufs make_bufs(unsigned char* ws) {
    Bufs b;
    b.QN = (bf16*)(ws + WS_QN); b.KV6 = (bf16*)(ws + WS_KV6);
    b.KC = (bf16*)(ws + WS_KV6 + 0 * KV6_STRIDE); b.VC = (bf16*)(ws + WS_KV6 + 1 * KV6_STRIDE);
    b.KS = (bf16*)(ws + WS_KV6 + 2 * KV6_STRIDE); b.VS = (bf16*)(ws + WS_KV6 + 3 * KV6_STRIDE);
    b.KW = (bf16*)(ws + WS_KV6 + 4 * KV6_STRIDE); b.VW = (bf16*)(ws + WS_KV6 + 5 * KV6_STRIDE);
    b.FQ = (bf16*)(ws + WS_FQKV); b.FK = b.FQ + 8 * MiB; b.FV = b.FQ + 16 * MiB;
    b.DQ = (bf16*)(ws + WS_DQK); b.DK = b.DQ + 8 * MiB; b.DV = (bf16*)(ws + WS_DV);
    b.GATE = (float*)(ws + WS_GATE); b.FL = (float*)(ws + WS_FL);
    b.HC = (bf16*)(ws + WS_HC); b.KCMP = (bf16*)(ws + WS_KVCMP); b.VCMP = b.KCMP + 16 * 256 * 64;
    b.SEL = (u64*)(ws + WS_SEL); b.OCMP = (bf16*)(ws + WS_OCMP); b.OWIN = (bf16*)(ws + WS_OWIN);
    b.HN = (bf16*)(ws + WS_HN); b.ATT = (bf16*)(ws + WS_ATT);
    b.ROUTE_E = (int*)(ws + WS_ROUTE); b.ROUTE_W = (float*)(ws + WS_ROUTE + 512 * 1024);
    return b;
}
__device__ __forceinline__ float lambda_init_of(int l) { return l == 0 ? 0.2f : 0.35550906759096926f; }

__device__ __noinline__ void P_prologue(KP p_) { const KP p = uni_kp(p_);
    const Ctx c = make_ctx(p); unsigned char* ws = p->ws;
    LAS float* scr = (LAS float*)(c.lds) + c.wave * (64 * 33);
    constexpr int I_A = 16 * 40, I_B = 16 * 24, I_C = 16 * 24, I_O = 16 * 32, I_G = 16 * 8, I_D = 4 * 32, I_E = 2 * I_G + I_D, I_W1 = 32 * 8, I_W2 = 4 * 2;
    constexpr int PER_L = I_A + I_B + I_C + I_O + 2 * (I_W1 + I_W2);
    for (int it = c.gw; it < L_ * PER_L; it += c.ngw) {
        const int l = it / PER_L; int r = it % PER_L;
        const float* W; bf16* WT; int ldw, K, sc0, ncol, r0 = 0, rmul = 1;
        if (r < I_A + I_B + I_C) { W = p->in[2] + (size_t)l * D_ * D_IN; WT = (bf16*)(ws + WS_WIN_T) + (size_t)l * NIN * D_; ldw = D_IN; K = D_;
            if (r < I_A) { sc0 = 0; ncol = 1280; r0 = 0; } else if (r < I_A + I_B) { r -= I_A; sc0 = C_FQ; ncol = 768; r0 = 1280; } else { r -= I_A + I_B; sc0 = C_DQ; ncol = 768; r0 = 2048; } }
        else if ((r -= I_A + I_B + I_C) < I_O) { W = p->in[13] + (size_t)l * D_ * D_; WT = (bf16*)(ws + WS_WOUT_T) + (size_t)l * D_ * D_; ldw = D_; K = D_; sc0 = 0; ncol = 1024; }
        else { r -= I_O; const int kv = r / (I_W1 + I_W2); r = r % (I_W1 + I_W2); const size_t lk = (size_t)l * 2 + kv;
            if (r < I_W1) { W = p->in[kv == 0 ? 6 : 9] + (size_t)l * 2048 * 256; WT = (bf16*)(ws + WS_W1_T) + lk * 256 * 2048; ldw = 256; K = 2048; sc0 = 0; ncol = 256; }
            else { r -= I_W1; W = p->in[kv == 0 ? 7 : 10] + (size_t)l * 256 * 64; WT = (bf16*)(ws + WS_W2_T) + lk * 64 * 256; ldw = 64; K = 256; sc0 = 0; ncol = 64; } }
        transpose_seg(W, ldw, K, sc0, ncol, WT, r0, rmul, r, scr, c.lane);
    }
    for (int i = c.bid * NTHREADS + c.tid; i < L_ * 256 * D_; i += c.G * NTHREADS) {
        const int l = i / (256 * D_), rr = (i / D_) % 256, k = i % D_;
        const float* win = p->in[2] + (size_t)l * D_ * D_IN;
        float v = 0.f; if (rr < 24) v = win[(size_t)k * D_IN + C_GATE + rr]; else if (rr < 28) v = win[(size_t)k * D_IN + C_FF + (rr - 24)];
        ((bf16*)(ws + WS_WIN_T))[((size_t)l * NIN + 2816 + rr) * D_ + k] = (bf16)f2bf(v);
    }
    for (int w = c.gw; w < L_ * 2 * 4 * 128; w += c.ngw) {
        const int lk = w >> 9, cg = (w >> 7) & 3, kc = w & 127, l = lk >> 1, kv = lk & 1, j = cg * 64 + c.lane;
        const float* pe = p->in[kv == 0 ? 5 : 8] + (size_t)l * 2048 + kc * 16; const float* w1 = p->in[kv == 0 ? 6 : 9] + (size_t)l * 2048 * 256 + (size_t)kc * 16 * 256;
        float a = 0.f;
#pragma unroll
        for (int k = 0; k < 16; ++k) a = fmaf(pe[k], w1[(size_t)k * 256 + j], a);
        ((float*)(ws + WS_B1PART))[((size_t)lk * 128 + kc) * 256 + j] = a;
    }
    for (int i = c.bid * NTHREADS + c.tid; i < L_ * 64 * 2 * 64; i += c.G * NTHREADS) {
        const int l = i / (64 * 2 * 64), ks = (i / 128) % 64, cb = (i / 64) & 1, lane = i & 63, col = 32 * cb + (lane & 31);
        unsigned hi[4], lo[4];
#pragma unroll
        for (int jp = 0; jp < 4; ++jp) { float v[2];
#pragma unroll
            for (int e = 0; e < 2; ++e) { const int k = 16 * ks + 8 * (lane >> 5) + 2 * jp + e; const float g = p->in[14][(size_t)l * D_ + k];
                v[e] = col < 4 ? g * p->in[15][((size_t)l * D_ + k) * 4 + col] : (col < 36 ? g * p->in[17][((size_t)l * D_ + k) * 32 + (col - 4)] : 0.f); }
            const unsigned h0 = f2bf(v[0]), h1 = f2bf(v[1]); hi[jp] = h0 | (h1 << 16);
            lo[jp] = f2bf(v[0] - __uint_as_float(h0 << 16)) | (f2bf(v[1] - __uint_as_float(h1 << 16)) << 16); }
        u32x4* dst = (u32x4*)(ws + WS_WR) + ((size_t)((l * 64 + ks) * 2 + cb) * 2) * 64 + lane;
        dst[0] = (u32x4){hi[0], hi[1], hi[2], hi[3]}; dst[64] = (u32x4){lo[0], lo[1], lo[2], lo[3]};
    }
}
__device__ __forceinline__ void P_inproj_mfma(int l_) { const KP p = (KP)__builtin_amdgcn_kernarg_segment_ptr(); int l = l_; asm volatile("" : "+s"(l));
    unsigned char* ws = p->ws; asm volatile("" : "+s"(ws));
    PlainOrder S; S.init(p->out, (const bf16*)(ws + WS_WIN_T) + (size_t)l * NIN * D_, D_, D_, NT, NIN, (int)gridDim.x, launder_s((int)blockIdx.x));
#ifdef STAGGER_TICKS
    { const unsigned long long t0 = __builtin_amdgcn_s_memrealtime(); const unsigned long long d = (unsigned long long)((launder_s((int)blockIdx.x) >> 3) & 3) * STAGGER_TICKS;
      while (__builtin_amdgcn_s_memrealtime() - t0 < d) __builtin_amdgcn_s_sleep(4); }
#endif
    const pg8::Gemm g{D_, D_, D_, D_ / 64, 0, 0};
    const EpiInProj E{ws, p->in[3] + l * 24, p->in[4] + l * 4, (unsigned*)(ws + WS_CTL) + CW_KN + l * 8192};
    pg8::gemm_phase<EpiInProj, PlainOrder, INPROJ_ALIGN, INPROJ_SP2>((LAS unsigned char*)lds_raw, g, S, E);
}
__device__ __forceinline__ void P_inproj_dummy(int l_) { const KP p = (KP)__builtin_amdgcn_kernarg_segment_ptr(); int l = l_; asm volatile("" : "+s"(l));
    unsigned char* ws = p->ws; asm volatile("" : "+s"(ws));
    PlainOrder S; S.init(p->out, (const bf16*)(ws + WS_WIN_T) + (size_t)l * NIN * D_, D_, D_, NT, NIN, (int)gridDim.x, launder_s((int)blockIdx.x));
    const pg8::Gemm g{D_, D_, D_, D_ / 64, 0, 0};
    const EpiDummy E{(float*)(ws + WS_HB)};
    pg8::gemm_phase<EpiDummy, PlainOrder, true, true>((LAS unsigned char*)lds_raw, g, S, E);
}
__device__ __forceinline__ void P_outproj_mfma(int l_) { const KP p = (KP)__builtin_amdgcn_kernarg_segment_ptr(); int l = l_; asm volatile("" : "+s"(l));
    unsigned char* ws = p->ws; asm volatile("" : "+s"(ws));
    PlainOrder S; S.init(ws + WS_ATT, (const bf16*)(ws + WS_WOUT_T) + (size_t)l * D_ * D_, D_, D_, NT, D_, (int)gridDim.x, launder_s((int)blockIdx.x));
    const pg8::Gemm g{D_, D_, D_, D_ / 64, 32, 8};
    const EpiResBf16 E{(bf16*)(ws + WS_HN)};
    pg8::gemm_phase<EpiResBf16, PlainOrder, true, true>((LAS unsigned char*)lds_raw, g, S, E);
}
__device__ __forceinline__ float wave_max_l(float v, int lane) {
#pragma unroll
    for (int o = 1; o < 64; o <<= 1) v = fmaxf(v, shflx_f(v, o, lane));
    return v;
}
__device__ __forceinline__ float wave_min_l(float v, int lane) {
#pragma unroll
    for (int o = 1; o < 64; o <<= 1) v = fminf(v, shflx_f(v, o, lane));
    return v;
}
template <int NS> __device__ __forceinline__ float q_norm2_max(const bf16x8v (&Q)[NS], int lane) {
    float ss = 0.f;
#pragma unroll
    for (int s = 0; s < NS; ++s)
#pragma unroll
        for (int e = 0; e < 8; ++e) { const float v = __uint_as_float(((unsigned)(unsigned short)Q[s][e]) << 16); ss = fmaf(v, v, ss); }
    return wave_max_l(swap_sum(ss), lane);
}
__device__ __forceinline__ u64 prune_consensus(bool skip, LAS u64* slots, int wave, int lane) {
    const u64 mine = __ballot(skip);
    __syncthreads();
    if (lane == 0) slots[wave] = mine;
    __syncthreads();
    u64 all = slots[0];
#pragma unroll
    for (int w = 1; w < NWAVES; ++w) all &= slots[w];
    return all;
}
__device__ __forceinline__ void U_fox(KP p_, int bh_, int qb_, int l_) {
    const KP p = uni_kp(p_); const int bh = __builtin_amdgcn_readfirstlane(bh_), qb = __builtin_amdgcn_readfirstlane(qb_), l = __builtin_amdgcn_readfirstlane(l_);
    int tid_ = threadIdx.x; asm volatile("" : "+v"(tid_));
    const int tid = tid_, lane = tid & 63, wave = __builtin_amdgcn_readfirstlane(tid >> 6), r = lane & 31, h = lane >> 5;
    unsigned char* ws = p->ws; asm volatile("" : "+s"(ws)); LAS unsigned char* L = (LAS unsigned char*)lds_raw;
    const int tw0 = 256 * qb + 32 * wave, t_lane = tw0 + r, b = bh >> 2, hd = bh & 3;
    const bf16* q = (const bf16*)(ws + WS_FQKV) + (size_t)bh * T_ * 64 + (t_lane >> 4) * 1024 + (t_lane & 15) * 32 + 8 * h;
    bf16x8v Qf[1][4];
#pragma unroll
    for (int s = 0; s < 4; ++s) Qf[0][s] = *(const bf16x8v*)(q + (s >> 1) * 512 + (s & 1) * 16);
    LAS float* cum = (LAS float*)(L + A_LDS_END);
    { const float* fl = (const float*)(ws + WS_FL) + (size_t)bh * T_; LAS float* tot = cum + 4096;
      const int nval = 256 * (qb + 1); float v[8];
      if (8 * tid < nval) { const f32x4 a = *(const f32x4*)(fl + 8 * tid), c2 = *(const f32x4*)(fl + 8 * tid + 4); v[0] = a.x; v[1] = a.y; v[2] = a.z; v[3] = a.w; v[4] = c2.x; v[5] = c2.y; v[6] = c2.z; v[7] = c2.w; }
      else {
#pragma unroll
          for (int i = 0; i < 8; ++i) v[i] = 0.f; }
#pragma unroll
      for (int i = 1; i < 8; ++i) v[i] += v[i - 1];
      float sc = v[7];
#pragma unroll
      for (int o = 1; o < 64; o <<= 1) { const float up = __uint_as_float((unsigned)__builtin_amdgcn_ds_bpermute((lane - o) << 2, (int)__float_as_uint(sc))); if (lane >= o) sc += up; }
      if (lane == 63) tot[wave] = sc;
      __syncthreads();
      float base = sc - v[7];
      for (int w = 0; w < wave; ++w) base += tot[w];
      if (8 * tid < nval) {
#pragma unroll
          for (int i = 0; i < 8; ++i) cum[8 * tid + i] = v[i] + base; }
      __syncthreads(); }
    f32x16 O[1][2]; float M[1] = {0.f}, Ls[1] = {0.f};
#pragma unroll
    for (int i = 0; i < 16; ++i) { O[0][0][i] = 0.f; O[0][1][i] = 0.f; }
    const u64 tm = (qb == 15) ? ~0ull : ((1ull << (4 * qb + 4)) - 1ull);
#if AC2_MODE == 0
    {
        const u64 low = (1ull << (4 * qb)) - 1ull; const float cref = cum[256 * qb];
        const bf16* Kp = (const bf16*)(ws + WS_FQKV) + 8 * MiB + (size_t)bh * T_ * 64; const bf16* Vp = (const bf16*)(ws + WS_FQKV) + 16 * MiB + (size_t)bh * T_ * 64;
        attn_core<64, 1, true, false>(L, Kp, nullptr, Vp, cum, cref, Qf, tm & ~low, t_lane, tw0, 1 << 30, 0.f, 0u, 0u, O, M, Ls, tid);
        if (qb > 0) {
            const float qn2 = q_norm2_max<4>(Qf[0], lane), mmin = wave_min_l(M[0], lane);
            const float* kn = (const float*)((const unsigned*)(ws + WS_CTL) + CW_KN + l * 8192) + ((size_t)bh * 64 + lane) * 2;
            bool skip = false;
            if (lane < 4 * qb) { const float kn2 = kn[0] + kn[1]; const float bound = sqrtf(qn2 * kn2) * 1.02f + (cref - cum[64 * lane + 63]) * LOG2E - mmin; skip = bound < -152.f; }
            const u64 drop = prune_consensus(skip, (LAS u64*)(cum + 4096 + 16), wave, lane);
            const u64 tm2 = low & ~drop;
            if (tm2) attn_core<64, 1, true, false>(L, Kp, nullptr, Vp, cum, cref, Qf, tm2, t_lane, tw0, 1 << 30, 0.f, 0u, 0u, O, M, Ls, tid, true);
        }
    }
#else
    attn_core2<true, false>(L, (const bf16*)(ws + WS_FQKV) + 8 * MiB + (size_t)bh * T_ * 64, (const bf16*)(ws + WS_FQKV) + 16 * MiB + (size_t)bh * T_ * 64, cum, cum[256 * qb],
                            Qf[0], tm, t_lane, tw0, 1 << 30, 0.f, 0u, 0u, O[0], M[0], Ls[0], tid);
#endif
    const float lt = swap_sum(Ls[0]), inv = lt > 0.f ? 1.f / lt : 0.f;
    bf16* dst = (bf16*)(ws + WS_ATT) + mix_off((size_t)b * T_ + t_lane, 512 + hd * 64 + 4 * h, 1024);
    ATTN_FOR_CHUNKS(db, g4) { const unsigned w0 = cvtpk(O[0][db][4 * g4 + 0] * inv, O[0][db][4 * g4 + 1] * inv), w1 = cvtpk(O[0][db][4 * g4 + 2] * inv, O[0][db][4 * g4 + 3] * inv);
        *(u64*)(dst + (4 * db + g4) * 256) = (u64)w0 | ((u64)w1 << 32); }
}
__device__ __forceinline__ void U_diff(KP p_, int bh_, int qb_, int l_) {
    const KP p = uni_kp(p_); const int bh = __builtin_amdgcn_readfirstlane(bh_), qb = __builtin_amdgcn_readfirstlane(qb_), l = __builtin_amdgcn_readfirstlane(l_);
    int tid_ = threadIdx.x; asm volatile("" : "+v"(tid_));
    const int tid = tid_, lane = tid & 63, wave = __builtin_amdgcn_readfirstlane(tid >> 6), r = lane & 31, h = lane >> 5;
    unsigned char* ws = p->ws; asm volatile("" : "+s"(ws)); LAS unsigned char* L = (LAS unsigned char*)lds_raw;
    const int tw0 = 256 * qb + 32 * wave, t_lane = tw0 + r, b = bh >> 2, hd = bh & 3;
    const bf16* DQ = (const bf16*)(ws + WS_DQK); const bf16* DK = DQ + 8 * MiB;
    bf16x8v Qf[2][2];
#pragma unroll
    for (int mp = 0; mp < 2; ++mp)
#pragma unroll
        for (int s = 0; s < 2; ++s) Qf[mp][s] = *(const bf16x8v*)(DQ + ((size_t)(bh * 2 + mp) * T_ + t_lane) * 32 + 16 * s + 8 * h);
    f32x16 O[2][2]; float M[2] = {0.f, 0.f}, Ls[2] = {0.f, 0.f};
#pragma unroll
    for (int i = 0; i < 16; ++i) { O[0][0][i] = 0.f; O[0][1][i] = 0.f; O[1][0][i] = 0.f; O[1][1][i] = 0.f; }
    const u64 tm = (qb == 15) ? ~0ull : ((1ull << (4 * qb + 4)) - 1ull);
    {
        const u64 low = (1ull << (4 * qb)) - 1ull; const float slope2 = alibi_slope(hd + 1, 4) * LOG2E;
        const bf16* K0 = DK + (size_t)(bh * 2 + 0) * T_ * 32; const bf16* K1 = DK + (size_t)(bh * 2 + 1) * T_ * 32; const bf16* Vp = (const bf16*)(ws + WS_DV) + (size_t)bh * T_ * 64;
        attn_core<32, 2, false, false>(L, K0, K1, Vp, nullptr, 0.f, Qf, tm & ~low, t_lane, tw0, 1 << 30, slope2, 0u, 0u, O, M, Ls, tid);
        if (qb > 0) {
            const float qa = q_norm2_max<2>(Qf[0], lane), qb2 = q_norm2_max<2>(Qf[1], lane), ma = wave_min_l(M[0], lane), mb = wave_min_l(M[1], lane);
            const float* kn = (const float*)((const unsigned*)(ws + WS_CTL) + CW_KN + l * 8192 + 4096) + (size_t)(bh * 2) * 64 + lane;
            bool skip = false;
            if (lane < 4 * qb) { const float bmax = slope2 * (float)(64 * lane + 63 - tw0);
                skip = (sqrtf(qa * kn[0]) * 1.02f + bmax - ma < -152.f) && (sqrtf(qb2 * kn[64]) * 1.02f + bmax - mb < -152.f); }
            const u64 drop = prune_consensus(skip, (LAS u64*)(L + A_LDS_END), wave, lane);
            const u64 tm2 = low & ~drop;
            if (tm2) attn_core<32, 2, false, false>(L, K0, K1, Vp, nullptr, 0.f, Qf, tm2, t_lane, tw0, 1 << 30, slope2, 0u, 0u, O, M, Ls, tid, true);
        }
    }
    const float* lam = p->in[11] + (size_t)l * 128; const float* subln = p->in[12] + (size_t)l * 64;
    float l1 = 0.f, l2 = 0.f; if (lane < 32) { l1 = lam[lane] * lam[32 + lane]; l2 = lam[64 + lane] * lam[96 + lane]; }
    const float li = lambda_init_of(l), lam_full = __expf(wave_sum_l(l1, lane)) - __expf(wave_sum_l(l2, lane)) + li;
    const float lt0 = swap_sum(Ls[0]), lt1 = swap_sum(Ls[1]), i0 = lt0 > 0.f ? 1.f / lt0 : 0.f, i1 = (lt1 > 0.f ? 1.f / lt1 : 0.f) * lam_full;
    float ss = 0.f;
#pragma unroll
    for (int db = 0; db < 2; ++db)
#pragma unroll
        for (int i = 0; i < 16; ++i) { const float o = O[0][db][i] * i0 - O[1][db][i] * i1; O[0][db][i] = o; ss += o * o; }
    ss = swap_sum(ss);
    const float rn = rsqrtf(ss * (1.f / 64.f) + EPS) * (1.f - li);
    bf16* dst = (bf16*)(ws + WS_ATT) + mix_off((size_t)b * T_ + t_lane, 768 + hd * 64 + 4 * h, 1024);
    ATTN_FOR_CHUNKS(db, g4) { const f32x4 sg = *(const f32x4*)(subln + 32 * db + 8 * g4 + 4 * h);
        const unsigned w0 = cvtpk(O[0][db][4 * g4 + 0] * rn * sg.x, O[0][db][4 * g4 + 1] * rn * sg.y), w1 = cvtpk(O[0][db][4 * g4 + 2] * rn * sg.z, O[0][db][4 * g4 + 3] * rn * sg.w);
        *(u64*)(dst + (4 * db + g4) * 256) = (u64)w0 | ((u64)w1 << 32); }
}
__device__ __forceinline__ void U_win(KP p_, int bg_, int c_) {
    const KP p = uni_kp(p_); const int bg = __builtin_amdgcn_readfirstlane(bg_), cc = __builtin_amdgcn_readfirstlane(c_);
    int tid_ = threadIdx.x; asm volatile("" : "+v"(tid_));
    const int tid = tid_, lane = tid & 63, wave = __builtin_amdgcn_readfirstlane(tid >> 6), r = lane & 31, h = lane >> 5;
    unsigned char* ws = p->ws; asm volatile("" : "+s"(ws)); LAS unsigned char* L = (LAS unsigned char*)lds_raw;
    const int b = bg >> 1, g = bg & 1, hd = g * 4 + (wave >> 1), tw0 = 64 * cc + 32 * (wave & 1), t_lane = tw0 + r;
    const bf16* q = (const bf16*)(ws + WS_QN) + (size_t)(b * 8 + hd) * T_ * 64 + (t_lane >> 4) * 1024 + (t_lane & 15) * 32 + 8 * h;
    bf16x8v Qf[1][4];
#pragma unroll
    for (int s = 0; s < 4; ++s) Qf[0][s] = *(const bf16x8v*)(q + (s >> 1) * 512 + (s & 1) * 16);
    f32x16 O[1][2]; float M[1] = {0.f}, Ls[1] = {0.f};
#pragma unroll
    for (int i = 0; i < 16; ++i) { O[0][0][i] = 0.f; O[0][1][i] = 0.f; }
    const int jlo = cc > 8 ? cc - 8 : 0;
    const u64 hi = (cc == 63) ? ~0ull : ((1ull << (cc + 1)) - 1ull), tm = hi & ~((1ull << jlo) - 1ull);
#if AC2_MODE == 0
    attn_core<64, 1, false, false>(L, (const bf16*)(ws + WS_KV6 + 4 * KV6_STRIDE) + (size_t)bg * T_ * 64, nullptr, (const bf16*)(ws + WS_KV6 + 5 * KV6_STRIDE) + (size_t)bg * T_ * 64, nullptr, 0.f,
                                   Qf, tm, t_lane, tw0, 512, alibi_slope(hd + 1, 8) * LOG2E, 0u, 0u, O, M, Ls, tid);
#else
    attn_core2<false, false>(L, (const bf16*)(ws + WS_KV6 + 4 * KV6_STRIDE) + (size_t)bg * T_ * 64, (const bf16*)(ws + WS_KV6 + 5 * KV6_STRIDE) + (size_t)bg * T_ * 64, nullptr, 0.f,
                             Qf[0], tm, t_lane, tw0, 512, alibi_slope(hd + 1, 8) * LOG2E, 0u, 0u, O[0], M[0], Ls[0], tid);
#endif
    const size_t n = (size_t)b * T_ + t_lane;
    const float lt = swap_sum(Ls[0]), inv = (lt > 0.f ? 1.f / lt : 0.f) * ((const float*)(ws + WS_GATE))[n * 24 + hd * 3 + 2];
    bf16* dst = (bf16*)(ws + WS_OWIN) + mix_off(n, hd * 64 + 4 * h, 512);
    ATTN_FOR_CHUNKS(db, g4) { const unsigned w0 = cvtpk(O[0][db][4 * g4 + 0] * inv, O[0][db][4 * g4 + 1] * inv), w1 = cvtpk(O[0][db][4 * g4 + 2] * inv, O[0][db][4 * g4 + 3] * inv);
        *(u64*)(dst + (4 * db + g4) * 256) = (u64)w0 | ((u64)w1 << 32); }
}
__device__ __forceinline__ void U_slc(KP p_, int bg_, int c_) {
    const KP p = uni_kp(p_); const int bg = __builtin_amdgcn_readfirstlane(bg_), cc = __builtin_amdgcn_readfirstlane(c_);
    int tid_ = threadIdx.x; asm volatile("" : "+v"(tid_));
    const int tid = tid_, lane = tid & 63, wave = __builtin_amdgcn_readfirstlane(tid >> 6), r = lane & 31, h = lane >> 5;
    unsigned char* ws = p->ws; asm volatile("" : "+s"(ws)); LAS unsigned char* L = (LAS unsigned char*)lds_raw;
    const int b = bg >> 1, g = bg & 1, hd = g * 4 + (wave >> 1), tw0 = 64 * cc + 32 * (wave & 1), t_lane = tw0 + r;
    const bf16* q = (const bf16*)(ws + WS_QN) + (size_t)(b * 8 + hd) * T_ * 64 + (t_lane >> 4) * 1024 + (t_lane & 15) * 32 + 8 * h;
    bf16x8v Qf[1][4];
#pragma unroll
    for (int s = 0; s < 4; ++s) Qf[0][s] = *(const bf16x8v*)(q + (s >> 1) * 512 + (s & 1) * 16);
    f32x16 O[1][2]; float M[1] = {0.f}, Ls[1] = {0.f};
#pragma unroll
    for (int i = 0; i < 16; ++i) { O[0][0][i] = 0.f; O[0][1][i] = 0.f; }
    const u64* sel = (const u64*)(ws + WS_SEL) + (size_t)bg * T_;
    const u64 mine = sel[t_lane]; u64 un = sel[64 * cc + lane];
    { unsigned ul = (unsigned)un, uh = (unsigned)(un >> 32);
#pragma unroll
      for (int o = 1; o < 64; o <<= 1) { ul |= shflx_u(ul, o, lane); uh |= shflx_u(uh, o, lane); }
      un = ((u64)__builtin_amdgcn_readfirstlane(uh) << 32) | __builtin_amdgcn_readfirstlane(ul); }
#if AC2_MODE == 0
    attn_core<64, 1, false, true>(L, (const bf16*)(ws + WS_KV6 + 2 * KV6_STRIDE) + (size_t)bg * T_ * 64, nullptr, (const bf16*)(ws + WS_KV6 + 3 * KV6_STRIDE) + (size_t)bg * T_ * 64, nullptr, 0.f,
                                  Qf, un, t_lane, tw0, 1 << 30, alibi_slope(hd + 1, 8) * LOG2E, (unsigned)mine, (unsigned)(mine >> 32), O, M, Ls, tid);
#else
    attn_core2<false, true>(L, (const bf16*)(ws + WS_KV6 + 2 * KV6_STRIDE) + (size_t)bg * T_ * 64, (const bf16*)(ws + WS_KV6 + 3 * KV6_STRIDE) + (size_t)bg * T_ * 64, nullptr, 0.f,
                            Qf[0], un, t_lane, tw0, 1 << 30, alibi_slope(hd + 1, 8) * LOG2E, (unsigned)mine, (unsigned)(mine >> 32), O[0], M[0], Ls[0], tid);
#endif
    const size_t n = (size_t)b * T_ + t_lane;
    const float lt = swap_sum(Ls[0]), inv = (lt > 0.f ? 1.f / lt : 0.f) * ((const float*)(ws + WS_GATE))[n * 24 + hd * 3 + 1];
    const bf16* oc = (const bf16*)(ws + WS_OCMP) + mix_off(n, hd * 64 + 4 * h, 512); const bf16* ow = (const bf16*)(ws + WS_OWIN) + mix_off(n, hd * 64 + 4 * h, 512);
    bf16* dst = (bf16*)(ws + WS_ATT) + mix_off(n, hd * 64 + 4 * h, 1024);
    ATTN_FOR_CHUNKS(db, g4) { const u64 a = *(const u64*)(oc + (4 * db + g4) * 256), w = *(const u64*)(ow + (4 * db + g4) * 256);
        const float x0 = O[0][db][4 * g4 + 0] * inv + __uint_as_float((unsigned)a << 16) + __uint_as_float((unsigned)w << 16);
        const float x1 = O[0][db][4 * g4 + 1] * inv + __uint_as_float((unsigned)a & 0xffff0000u) + __uint_as_float((unsigned)w & 0xffff0000u);
        const float x2 = O[0][db][4 * g4 + 2] * inv + __uint_as_float((unsigned)(a >> 32) << 16) + __uint_as_float((unsigned)(w >> 32) << 16);
        const float x3 = O[0][db][4 * g4 + 3] * inv + __uint_as_float((unsigned)(a >> 32) & 0xffff0000u) + __uint_as_float((unsigned)(w >> 32) & 0xffff0000u);
        *(u64*)(dst + (4 * db + g4) * 256) = (u64)cvtpk(x0, x1) | ((u64)cvtpk(x2, x3) << 32); }
}
__device__ __forceinline__ float other_half(float x, int h) { auto rr = __builtin_amdgcn_permlane32_swap(__float_as_uint(x), __float_as_uint(x), false, false); return __uint_as_float(h ? rr[0] : rr[1]); }
__device__ __forceinline__ int other_half_i(int x, int h) { auto rr = __builtin_amdgcn_permlane32_swap((unsigned)x, (unsigned)x, false, false); return (int)(h ? rr[0] : rr[1]); }
template <bool MASK>
__device__ __forceinline__ void cmp_scores(f32x16& p0, f32x16& p1, const LAS unsigned char* kt, const bf16x8v (&Qf)[4], float b0, float s1, int cl, int nvis_l) {
    const float s8 = s1 * 8.f, s32 = s1 * 32.f;
    p0[0] = b0; p0[1] = p0[0] + s1; p0[2] = p0[1] + s1; p0[3] = p0[2] + s1;
#pragma unroll
    for (int reg = 4; reg < 16; ++reg) p0[reg] = p0[reg - 4] + s8;
#pragma unroll
    for (int reg = 0; reg < 16; ++reg) p1[reg] = p0[reg] + s32;
#pragma unroll
    for (int s = 0; s < 4; ++s) { const bf16x8v kf0 = *(const LAS bf16x8v*)(kt + s * 32), kf1 = *(const LAS bf16x8v*)(kt + 32 * 144 + s * 32);
        p0 = __builtin_amdgcn_mfma_f32_32x32x16_bf16(kf0, Qf[s], p0, 0, 0, 0); p1 = __builtin_amdgcn_mfma_f32_32x32x16_bf16(kf1, Qf[s], p1, 0, 0, 0); }
    if (MASK) {
#pragma unroll
        for (int reg = 0; reg < 16; ++reg) { const int c = cl + crow0(reg); p0[reg] = (c < nvis_l) ? p0[reg] : -INFINITY; p1[reg] = (c + 32 < nvis_l) ? p1[reg] : -INFINITY; } }
}
__device__ __forceinline__ void U_cmp(KP p_, int bg_, int u_) {
    const KP p = uni_kp(p_); const int bg = __builtin_amdgcn_readfirstlane(bg_), uu = __builtin_amdgcn_readfirstlane(u_);
    int tid_ = threadIdx.x; asm volatile("" : "+v"(tid_));
    const int tid = tid_, lane = tid & 63, wave = __builtin_amdgcn_readfirstlane(tid >> 6), r = lane & 31, h = lane >> 5;
    unsigned char* ws = p->ws; asm volatile("" : "+s"(ws)); LAS unsigned char* L = (LAS unsigned char*)lds_raw;
    const int b = bg >> 1, g = bg & 1, tw0 = 32 * (uu + 16 * wave), t_lane = tw0 + r;
    { const bf16* kc = (const bf16*)(ws + WS_KVCMP) + (size_t)bg * 256 * 64; const bf16* vc = kc + 16 * 256 * 64;
#pragma unroll
      for (int i = 0; i < 4; ++i) { const int ch = tid + 512 * i, row = ch >> 3, c8 = ch & 7;
          *(LAS u32x4*)(L + row * 144 + c8 * 16) = *(const u32x4*)(kc + row * 64 + c8 * 8); *(LAS u32x4*)(L + 36864 + row * 144 + c8 * 16) = *(const u32x4*)(vc + row * 64 + c8 * 8); } }
    __syncthreads();
    const int nvis_l = t_lane >= 31 ? ((t_lane - 31) >> 4) + 1 : 0, nvis_max = (tw0 >> 4) + 1, nvis_min = tw0 >= 31 ? ((tw0 - 31) >> 4) + 1 : 0, ntile = (nvis_max + 63) >> 6;
    const LAS unsigned char* kfrag = L + r * 144 + h * 16;
    const LAS unsigned char* vfrag = L + 36864 + (4 * h + ((lane & 15) >> 2)) * 144 + (16 * ((lane >> 4) & 1) + 4 * (lane & 3)) * 2;
    float imp[32];
#pragma unroll
    for (int e = 0; e < 32; ++e) imp[e] = 0.f;
    const float* gate = (const float*)(ws + WS_GATE) + ((size_t)b * T_ + t_lane) * 24;
#pragma unroll 1
    for (int hg = 0; hg < 4; ++hg) {
        const int hd = g * 4 + hg; const float s1 = alibi_slope(hd + 1, 8) * LOG2E * 16.f;
        const bf16* q = (const bf16*)(ws + WS_QN) + (size_t)(b * 8 + hd) * T_ * 64 + (t_lane >> 4) * 1024 + (t_lane & 15) * 32 + 8 * h;
        bf16x8v Qf[4];
#pragma unroll
        for (int s = 0; s < 4; ++s) Qf[s] = *(const bf16x8v*)(q + (s >> 1) * 512 + (s & 1) * 16);
        float m = -1e30f, lsum = 0.f;
#pragma unroll 1
        for (int jt = 0; jt < ntile; ++jt) {
            f32x16 p0, p1; const float b0 = s1 * (float)(64 * jt + 4 * h - nvis_max);
            if (64 * jt + 63 >= nvis_min) cmp_scores<true>(p0, p1, kfrag + jt * (64 * 144), Qf, b0, s1, 64 * jt + 4 * h, nvis_l);
            else cmp_scores<false>(p0, p1, kfrag + jt * (64 * 144), Qf, b0, s1, 64 * jt + 4 * h, nvis_l);
            float mt = fmaxf(p0[0], p1[0]);
#pragma unroll
            for (int reg = 1; reg < 16; ++reg) mt = fmaxf(mt, fmaxf(p0[reg], p1[reg]));
            mt = swap_max(mt);
            const float mn = fmaxf(m, mt); float rs = 0.f;
#pragma unroll
            for (int reg = 0; reg < 16; ++reg) rs += __builtin_amdgcn_exp2f(p0[reg] - mn) + __builtin_amdgcn_exp2f(p1[reg] - mn);
            lsum = lsum * __builtin_amdgcn_exp2f(m - mn) + rs; m = mn;
        }
        const float lt = swap_sum(lsum), inv = lt > 0.f ? 1.f / lt : 0.f;
        f32x16 O0, O1;
#pragma unroll
        for (int i = 0; i < 16; ++i) { O0[i] = 0.f; O1[i] = 0.f; }
        float carry = 0.f;
#pragma unroll
        for (int jt = 0; jt < 4; ++jt) if (jt < ntile) {
            f32x16 p0, p1; const float b0 = s1 * (float)(64 * jt + 4 * h - nvis_max);
            if (64 * jt + 63 >= nvis_min) cmp_scores<true>(p0, p1, kfrag + jt * (64 * 144), Qf, b0, s1, 64 * jt + 4 * h, nvis_l);
            else cmp_scores<false>(p0, p1, kfrag + jt * (64 * 144), Qf, b0, s1, 64 * jt + 4 * h, nvis_l);
#pragma unroll
            for (int reg = 0; reg < 16; ++reg) { p0[reg] = __builtin_amdgcn_exp2f(p0[reg] - m) * inv; p1[reg] = __builtin_amdgcn_exp2f(p1[reg] - m) * inv; }
            float cv[8];
#pragma unroll
            for (int g4 = 0; g4 < 4; ++g4) { const float h0 = 0.5f * p0[4 * g4 + 3], h1 = 0.5f * p1[4 * g4 + 3];
                imp[jt * 8 + g4] += ((p0[4 * g4] + p0[4 * g4 + 1]) + p0[4 * g4 + 2]) + h0; imp[jt * 8 + 4 + g4] += ((p1[4 * g4] + p1[4 * g4 + 1]) + p1[4 * g4 + 2]) + h1;
                cv[g4] = h0; cv[4 + g4] = h1; }
            float prev = carry;
#pragma unroll
            for (int k = 0; k < 8; ++k) { const float sv = other_half(cv[k], h); imp[jt * 8 + k] += h ? sv : prev; prev = sv; }
            carry = prev;
            const bf16x8v pa0 = pack8(p0, 0), pa1 = pack8(p0, 8), pa2 = pack8(p1, 0), pa3 = pack8(p1, 8);
            const LAS unsigned char* vb = vfrag + jt * (64 * 144);
#pragma unroll
            for (int ks = 0; ks < 4; ++ks) { const bf16x8v pa = ks == 0 ? pa0 : ks == 1 ? pa1 : ks == 2 ? pa2 : pa3;
                { const s16x4 lo = tr_read(vb + ks * (16 * 144)), hi = tr_read(vb + ks * (16 * 144) + 8 * 144); const bf16x8v vf = {lo[0], lo[1], lo[2], lo[3], hi[0], hi[1], hi[2], hi[3]};
                  O0 = __builtin_amdgcn_mfma_f32_32x32x16_bf16(vf, pa, O0, 0, 0, 0); }
                { const s16x4 lo = tr_read(vb + ks * (16 * 144) + 64), hi = tr_read(vb + ks * (16 * 144) + 64 + 8 * 144); const bf16x8v vf = {lo[0], lo[1], lo[2], lo[3], hi[0], hi[1], hi[2], hi[3]};
                  O1 = __builtin_amdgcn_mfma_f32_32x32x16_bf16(vf, pa, O1, 0, 0, 0); } }
        }
        const float gt = gate[hd * 3 + 0];
        bf16* dst = (bf16*)(ws + WS_OCMP) + mix_off((size_t)b * T_ + t_lane, hd * 64 + 4 * h, 512);
#pragma unroll
        for (int g4 = 0; g4 < 4; ++g4) {
            *(u64*)(dst + g4 * 256) = (u64)cvtpk(O0[4 * g4 + 0] * gt, O0[4 * g4 + 1] * gt) | ((u64)cvtpk(O0[4 * g4 + 2] * gt, O0[4 * g4 + 3] * gt) << 32);
            *(u64*)(dst + (4 + g4) * 256) = (u64)cvtpk(O1[4 * g4 + 0] * gt, O1[4 * g4 + 1] * gt) | ((u64)cvtpk(O1[4 * g4 + 2] * gt, O1[4 * g4 + 3] * gt) << 32); }
    }
    const int cur = tw0 >> 6; u64 mask;
    if (cur <= 15) mask = (1ull << (cur + 1)) - 1ull;
    else {
        mask = 1ull | (1ull << cur) | (1ull << (cur - 1));
#pragma unroll
        for (int e = 0; e < 32; ++e) { const int j = 2 * e + h; if (j > cur || j == 0 || j >= cur - 1) imp[e] = -INFINITY; }
#pragma unroll 1
        for (int round = 0; round < 13; ++round) {
            float bv = imp[0]; int be = 0;
#pragma unroll
            for (int e = 1; e < 32; ++e) if (imp[e] > bv) { bv = imp[e]; be = e; }
            const int bj = 2 * be + h; const float ov = other_half(bv, h); const int oj = other_half_i(bj, h);
            const bool mine = bv > ov || (bv == ov && bj < oj);
            mask |= 1ull << (mine ? bj : oj);
#pragma unroll
            for (int e = 0; e < 32; ++e) imp[e] = (mine && e == be) ? -INFINITY : imp[e];
        }
    }
    if (h == 0) ((u64*)(ws + WS_SEL))[(size_t)bg * T_ + t_lane] = mask;
    __syncthreads();
}
constexpr int CONV_UNITS = L_ * NEXP * (2 * 16 * 8 + 4 * 32) / 32;
__device__ __forceinline__ void U_conv(KP p_, int k_) {
    const KP p = uni_kp(p_); const int k = __builtin_amdgcn_readfirstlane(k_);
    int tid_ = threadIdx.x; asm volatile("" : "+v"(tid_));
    const int tid = tid_, lane = tid & 63, wave = __builtin_amdgcn_readfirstlane(tid >> 6);
    unsigned char* ws = p->ws; asm volatile("" : "+s"(ws));
    LAS float* scr = (LAS float*)lds_raw + wave * (64 * 33);
    constexpr int I_G = 16 * 8, I_D = 4 * 32, I_E = 2 * I_G + I_D;
#pragma unroll 1
    for (int i = 0; i < 4; ++i) {
        const int m = k * 32 + i * 8 + wave, l = m / (NEXP * I_E); int r = m % (NEXP * I_E); const int e = r / I_E; r = r % I_E; const size_t le = (size_t)l * NEXP + e;
        const float* W; bf16* WT; int ldw, K, ncol, r0 = 0, rmul = 1;
        if (r < 2 * I_G) { const int up = r >= I_G; r -= up * I_G; W = p->in[19 + up] + le * D_ * DEXP; WT = (bf16*)(ws + WS_WGU_T) + le * 512 * D_; ldw = DEXP; K = D_; ncol = 256; r0 = up; rmul = 2; }
        else { r -= 2 * I_G; W = p->in[21] + le * DEXP * D_; WT = (bf16*)(ws + WS_WD_T) + le * D_ * DEXP; ldw = D_; K = DEXP; ncol = 1024; }
        transpose_seg(W, ldw, K, 0, ncol, WT, r0, rmul, r, scr, lane);
    }
}
__device__ __forceinline__ int fetch_unit(KP p, int qidx) {
    volatile LAS unsigned* slot = (volatile LAS unsigned*)((LAS unsigned char*)lds_raw + MISC_OFF) + 16;
    __syncthreads();
    int t0_ = threadIdx.x; asm volatile("" : "+v"(t0_));
    if (t0_ == 0) *slot = __hip_atomic_fetch_add((unsigned*)(p->ws + WS_CTL) + CW_QUEUE + 64 * qidx, 1u, __ATOMIC_RELAXED, __HIP_MEMORY_SCOPE_AGENT);
    __syncthreads();
    return (int)__builtin_amdgcn_readfirstlane(*slot);
}
__device__ __forceinline__ void P_cmp1_mfma(int l_) { const KP p = (KP)__builtin_amdgcn_kernarg_segment_ptr(); int l = l_; asm volatile("" : "+s"(l));
    unsigned char* ws = p->ws; asm volatile("" : "+s"(ws)); const int c = launder_s((int)blockIdx.x), kv = c >> 4, pm = c & 15;
    OneUnitOrder S; S.has = c < 32; S.u.pm = pm; S.u.pn = kv;
    S.u.a = (const char*)(ws + WS_KV6 + (size_t)kv * KV6_STRIDE) + (size_t)pm * 256 * 1024 * 2; S.u.b = (const char*)((const bf16*)(ws + WS_W1_T) + ((size_t)l * 2 + kv) * 256 * 2048); S.u.b2 = S.u.b;
    const pg8::Gemm g{1024, 2048, 2048, 32, 0, 0};
    const EpiCmpH E{(bf16*)(ws + WS_HC), (const float*)(ws + WS_BIAS1) + l * 512};
    pg8::gemm_phase<EpiCmpH, OneUnitOrder, false, true>((LAS unsigned char*)lds_raw, g, S, E);
}
__device__ __forceinline__ void P_cmp2_mfma(int l_) { const KP p = (KP)__builtin_amdgcn_kernarg_segment_ptr(); int l = l_; asm volatile("" : "+s"(l));
    unsigned char* ws = p->ws; asm volatile("" : "+s"(ws)); const int c = launder_s((int)blockIdx.x), kv = c >> 4, pm = c & 15;
    OneUnitOrder S; S.has = c < 32; S.u.pm = pm; S.u.pn = kv;
    S.u.a = (const char*)((const bf16*)(ws + WS_HC) + ((size_t)kv * 4096 + pm * 256) * 256); S.u.b = (const char*)((const bf16*)(ws + WS_W2_T) + ((size_t)l * 2 + kv) * 64 * 256); S.u.b2 = S.u.b;
    const pg8::Gemm g{256, 256, 256, 4, 0, 0};
    const EpiCmpOut E{(bf16*)(ws + WS_KVCMP)};
    pg8::gemm_phase<EpiCmpOut, OneUnitOrder, false, true>((LAS unsigned char*)lds_raw, g, S, E);
}
__device__ __forceinline__ void P_moe_scatter(KP p_, int l_) { const KP p = uni_kp(p_); const int l = __builtin_amdgcn_readfirstlane(l_); const Ctx c = make_ctx(p); unsigned char* ws = p->ws;
    const unsigned* cnt = (const unsigned*)(ws + WS_CTL) + CW_MOECNT + l * MOE_LS;
    moe_build_tables(cnt, c.tid);
    const LAS int* T = (const LAS int*)((LAS unsigned char*)lds_raw + TBL_OFF);
    const unsigned* info = (const unsigned*)(ws + WS_ROUTE + RT_INFO); const float* tw = (const float*)(ws + WS_ROUTE + RT_W);
    int* rowtok = (int*)(ws + WS_ROUTE + RT_ROWTOK); float* roww = (float*)(ws + WS_ROUTE + RT_ROWW);
    bf16* xs = (bf16*)(ws + WS_XS); const bf16* x = (const bf16*)(ws + WS_HN); const float* gain = p->in[14] + (size_t)l * D_; const float* rstdv = (const float*)(ws + WS_ROUTE + RT_RSTD);
    { constexpr int RB = 4; float gg[2][8];
#pragma unroll
      for (int j = 0; j < 2; ++j) { const f32x4 a = ((const f32x4*)gain)[2 * c.lane + 128 * j], b2 = ((const f32x4*)gain)[2 * c.lane + 128 * j + 1]; gg[j][0] = a.x; gg[j][1] = a.y; gg[j][2] = a.z; gg[j][3] = a.w; gg[j][4] = b2.x; gg[j][5] = b2.y; gg[j][6] = b2.z; gg[j][7] = b2.w; }
      for (int row0 = c.gw * RB; row0 < NT; row0 += c.ngw * RB) {
        u32x4 vv[RB][2];
#pragma unroll
        for (int q = 0; q < RB; ++q)
#pragma unroll
            for (int j = 0; j < 2; ++j) vv[q][j] = ((const u32x4*)(x + (size_t)(row0 + q) * D_))[c.lane + 64 * j];
#pragma unroll
        for (int q = 0; q < RB; ++q) { const int row = row0 + q;
            const unsigned v = info[row]; const int cls = (int)(v >> 24), rank = (int)(v & 0xffffffu); const size_t dest = (size_t)T[cls] * 256 + rank; const float r = rstdv[row];
#pragma unroll
            for (int j = 0; j < 2; ++j) { float f[8]; unpack8(vv[q][j], f); u32x4 o; o.x = pk2(f[0] * r * gg[j][0], f[1] * r * gg[j][1]); o.y = pk2(f[2] * r * gg[j][2], f[3] * r * gg[j][3]); o.z = pk2(f[4] * r * gg[j][4], f[5] * r * gg[j][5]); o.w = pk2(f[6] * r * gg[j][6], f[7] * r * gg[j][7]);
                ((u32x4*)(xs + dest * D_))[c.lane + 64 * j] = o; }
            if (c.lane == 0) { rowtok[dest] = row; roww[2 * dest] = tw[2 * row]; roww[2 * dest + 1] = tw[2 * row + 1]; } }
      } }
    for (int cls = c.bid; cls < 112; cls += c.G) { const int n = (int)cnt[cls * MOE_CS], end = (int)((cnt[cls * MOE_CS] + 255u) >> 8) * 256; const size_t base = (size_t)T[cls] * 256;
        for (int r = n + c.tid; r < end; r += NTHREADS) rowtok[base + r] = -1; }
}
__device__ __forceinline__ void P_moe_g1(int l_) { const KP p = (KP)__builtin_amdgcn_kernarg_segment_ptr(); int l = l_; asm volatile("" : "+s"(l));
    unsigned char* ws = p->ws; asm volatile("" : "+s"(ws));
    { int t0_ = threadIdx.x; asm volatile("" : "+v"(t0_)); moe_build_tables((const unsigned*)(ws + WS_CTL) + CW_MOECNT + l * MOE_LS, t0_); }
    const MoeOrder1 S{(const char*)(ws + WS_XS), (const char*)((const bf16*)(ws + WS_WGU_T) + (size_t)l * NEXP * 512 * D_), (int)gridDim.x, launder_s((int)blockIdx.x)};
    const pg8::Gemm g{D_, D_, D_, D_ / 64, 0, 0};
    const EpiMoeH E{(bf16*)(ws + WS_HB), (const float*)(ws + WS_ROUTE + RT_ROWW)};
    pg8::gemm_phase<EpiMoeH, MoeOrder1, true, true>((LAS unsigned char*)lds_raw, g, S, E);
}
__device__ __forceinline__ void P_moe_g2(int l_) { const KP p = (KP)__builtin_amdgcn_kernarg_segment_ptr(); int l = l_; asm volatile("" : "+s"(l));
    unsigned char* ws = p->ws; asm volatile("" : "+s"(ws));
    { int t0_ = threadIdx.x; asm volatile("" : "+v"(t0_)); moe_build_tables((const unsigned*)(ws + WS_CTL) + CW_MOECNT + l * MOE_LS, t0_); }
    const MoeOrder2 S{(const char*)(ws + WS_HB), (const char*)((const bf16*)(ws + WS_WD_T) + (size_t)l * NEXP * D_ * DEXP), (int)gridDim.x, launder_s((int)blockIdx.x)};
    const pg8::Gemm g{512, DEXP, 512, 4, 16, 16};
    const EpiMoeOut E{(bf16*)(ws + WS_HN), (const int*)(ws + WS_ROUTE + RT_ROWTOK)};
    pg8::gemm_phase<EpiMoeOut, MoeOrder2, true, true>((LAS unsigned char*)lds_raw, g, S, E);
}
__device__ __forceinline__ void P_norm1(KP p_, int l_) { const KP p = uni_kp(p_); const int l = __builtin_amdgcn_readfirstlane(l_); const Ctx c = make_ctx(p); const Bufs b = make_bufs(p->ws);
    if (l == 0) { const int i = c.bid * NTHREADS + c.tid; if (i < L_ * 2 * 256) { const float* part = (const float*)(p->ws + WS_B1PART) + (size_t)(i >> 8) * 128 * 256 + (i & 255); float a = 0.f;
        for (int k = 0; k < 128; ++k) a += part[(size_t)k * 256]; ((float*)(p->ws + WS_BIAS1))[i] = a; } }
    if (l == 0) ph_norm_bf16(c, p->in[0], p->in[1], (bf16*)p->out, (bf16*)(p->ws + WS_HN)); else ph_norm_bf16_from_bf16(c, (const bf16*)(p->ws + WS_HN), p->in[1] + (size_t)l * D_, (bf16*)p->out); }
__device__ __noinline__ void P_inproj(KP p_, int l_) { const KP p = uni_kp(p_); const int l = __builtin_amdgcn_readfirstlane(l_); const Ctx c = make_ctx(p); const Bufs b = make_bufs(p->ws);
    InProjOut o{b.QN, b.KV6, b.FQ, b.DQ, b.DV, b.GATE, b.FL, p->in[3] + l * 24, p->in[4] + l * 4};
    const bf16* A = b.HN;
    naive_gemm(c, NT, D_IN, D_, [=](int r, int k) { return bf2f(A[(size_t)r * D_ + k]); }, p->in[2] + (size_t)l * D_ * D_IN, D_IN,
               [=](int r, int col, float v) { inproj_store(o, r, col, v); }); }
__device__ __noinline__ void P_cmp1(KP p_, int l_, int kv_) { const KP p = uni_kp(p_); const int l = __builtin_amdgcn_readfirstlane(l_), kv = __builtin_amdgcn_readfirstlane(kv_); const Ctx c = make_ctx(p); const Bufs b = make_bufs(p->ws);
    const bf16* src = kv == 0 ? b.KC : b.VC; const float* pe = p->in[kv == 0 ? 5 : 8] + (size_t)l * 2048; bf16* hc = b.HC + (size_t)kv * 4096 * 256;
    naive_gemm(c, 4096, 256, 2048, [=](int r, int k) { return bf2f(src[(size_t)r * 1024 + k]) + pe[k]; }, p->in[kv == 0 ? 6 : 9] + (size_t)l * 2048 * 256, 256,
               [=](int r, int col, float v) { hc[(size_t)r * 256 + col] = (bf16)f2bf(gelu_tanh(v)); }); }
__device__ __noinline__ void P_cumsum(KP p_, int l_) { const KP p = uni_kp(p_); const int l = __builtin_amdgcn_readfirstlane(l_); const Ctx c = make_ctx(p); const Bufs b = make_bufs(p->ws); ph_cumsum(c, b.FL); }
__device__ __noinline__ void P_cmp2(KP p_, int l_, int kv_) { const KP p = uni_kp(p_); const int l = __builtin_amdgcn_readfirstlane(l_), kv = __builtin_amdgcn_readfirstlane(kv_); const Ctx c = make_ctx(p); const Bufs b = make_bufs(p->ws);
    const bf16* hc = b.HC + (size_t)kv * 4096 * 256; bf16* dst = kv == 0 ? b.KCMP : b.VCMP;
    naive_gemm(c, 4096, 64, 256, [=](int r, int k) { return bf2f(hc[(size_t)r * 256 + k]); }, p->in[kv == 0 ? 7 : 10] + (size_t)l * 256 * 64, 64,
               [=](int r, int col, float v) { dst[(size_t)r * 64 + col] = (bf16)f2bf((r & 255) == 255 ? 0.f : v); }); }
__device__ __noinline__ void P_win(KP p_, int l_) { const KP p = uni_kp(p_); const int l = __builtin_amdgcn_readfirstlane(l_); const Ctx c = make_ctx(p); const Bufs b = make_bufs(p->ws); ph_win_attn(c, b.QN, b.KW, b.VW, b.GATE, b.OWIN); }
__device__ __noinline__ void P_fox(KP p_, int l_) { const KP p = uni_kp(p_); const int l = __builtin_amdgcn_readfirstlane(l_); const Ctx c = make_ctx(p); const Bufs b = make_bufs(p->ws); ph_fox_attn(c, b.FQ, b.FK, b.FV, b.FL, b.ATT); }
__device__ __noinline__ void P_diff(KP p_, int l_) { const KP p = uni_kp(p_); const int l = __builtin_amdgcn_readfirstlane(l_); const Ctx c = make_ctx(p); const Bufs b = make_bufs(p->ws);
    ph_diff_attn(c, b.DQ, b.DK, b.DV, p->in[11] + (size_t)l * 128, p->in[12] + (size_t)l * 64, lambda_init_of(l), b.ATT); }
__device__ __noinline__ void P_cmpattn(KP p_, int l_) { const KP p = uni_kp(p_); const int l = __builtin_amdgcn_readfirstlane(l_); const Ctx c = make_ctx(p); const Bufs b = make_bufs(p->ws); ph_cmp_attn(c, b.QN, b.KCMP, b.VCMP, b.GATE, b.SEL, b.OCMP); }
__device__ __noinline__ void P_slc(KP p_, int l_) { const KP p = uni_kp(p_); const int l = __builtin_amdgcn_readfirstlane(l_); const Ctx c = make_ctx(p); const Bufs b = make_bufs(p->ws); ph_slc_attn(c, b.QN, b.KS, b.VS, b.GATE, b.SEL, b.OCMP, b.OWIN, b.ATT); }
__device__ __noinline__ void P_outproj(KP p_, int l_) { const KP p = uni_kp(p_); const int l = __builtin_amdgcn_readfirstlane(l_); const Ctx c = make_ctx(p); const Bufs b = make_bufs(p->ws);
    const bf16* A = b.ATT; float* xo = p->out; const float* xin = (l == 0) ? p->in[0] : p->out;
    naive_gemm(c, NT, D_, D_, [=](int r, int k) { return bf2f(A[(size_t)r * D_ + k]); }, p->in[13] + (size_t)l * D_ * D_, D_,
               [=](int r, int col, float v) { xo[(size_t)r * D_ + col] = xin[(size_t)r * D_ + col] + v; }); }
__device__ __forceinline__ void P_route3(int l_, int cbank) { const KP p = (KP)__builtin_amdgcn_kernarg_segment_ptr(); int l = l_; asm volatile("" : "+s"(l));
    int tid_ = threadIdx.x; asm volatile("" : "+v"(tid_));
    const int tid = tid_, lane = tid & 63, wave = __builtin_amdgcn_readfirstlane(tid >> 6), r = lane & 31, h = lane >> 5, kh = wave >> 2, wr = wave & 3;
    unsigned char* ws = p->ws; asm volatile("" : "+s"(ws)); const bf16* x = (const bf16*)(ws + WS_HN);
    const float* WR = (const float*)(ws + WS_WR) + (size_t)l * D_ * 64;
    LAS float* XT = (LAS float*)lds_raw + wave * (32 * 36);
    LAS float* WT = (LAS float*)lds_raw + 8 * 32 * 36 + kh * (2 * 32 * 64);
    LAS float* PL = (LAS float*)lds_raw + 8 * 32 * 36 + 2 * 2 * 32 * 64;
    LAS float* SS = PL + 2 * 128 * 40;
    const float* bgrp = p->in[16] + l * 4; const float* bexp = p->in[18] + l * 32;
    unsigned* cnt = (unsigned*)(ws + WS_CTL) + CW_MOECNT + l * MOE_LS + cbank;
    LAS unsigned* HIST = (LAS unsigned*)(SS + 2 * 128 * 2);
    for (int grp = launder_s((int)blockIdx.x); grp < NT / 128; grp += (int)gridDim.x) {
        const int row0 = grp * 128 + wr * 32;
        if (tid < 112) HIST[tid] = 0u;
        f32x16 acc0, acc1; float ss = 0.f;
#pragma unroll
        for (int i = 0; i < 16; ++i) { acc0[i] = 0.f; acc1[i] = 0.f; }
        { const u32x4* xsrc = (const u32x4*)(x + (size_t)(row0 + r) * D_ + kh * 512 + 8 * h);
          const u32x4* wsrc = (const u32x4*)(ws + WS_WR) + ((size_t)l * 64 + kh * 32) * 256 + lane;
#pragma unroll 4
          for (int ks = 0; ks < 32; ++ks) {
              const u32x4 av = xsrc[2 * ks], b0h = wsrc[ks * 256], b0l = wsrc[ks * 256 + 64], b1h = wsrc[ks * 256 + 128], b1l = wsrc[ks * 256 + 192];
              { float f_[8]; unpack8(av, f_);
#pragma unroll
                for (int e = 0; e < 8; ++e) ss = fmaf(f_[e], f_[e], ss); }
              const bf16x8v A = __builtin_bit_cast(bf16x8v, av);
              acc0 = __builtin_amdgcn_mfma_f32_32x32x16_bf16(A, __builtin_bit_cast(bf16x8v, b0h), acc0, 0, 0, 0); acc1 = __builtin_amdgcn_mfma_f32_32x32x16_bf16(A, __builtin_bit_cast(bf16x8v, b1h), acc1, 0, 0, 0);
              acc0 = __builtin_amdgcn_mfma_f32_32x32x16_bf16(A, __builtin_bit_cast(bf16x8v, b0l), acc0, 0, 0, 0); acc1 = __builtin_amdgcn_mfma_f32_32x32x16_bf16(A, __builtin_bit_cast(bf16x8v, b1l), acc1, 0, 0, 0);
          } }
#pragma unroll
        for (int reg = 0; reg < 16; ++reg) { const int row = wr * 32 + crow0(reg) + 4 * h; PL[(kh * 128 + row) * 40 + r] = acc0[reg]; if (r < 4) PL[(kh * 128 + row) * 40 + 32 + r] = acc1[reg]; }
        SS[(kh * 128 + wr * 32 + r) * 2 + h] = ss;
        __syncthreads();
        int cls = 0; unsigned lrank = 0u; float wlo = 0.f, whi = 0.f, rstd = 0.f;
        if (tid < 128) {
            float lg[36];
#pragma unroll
            for (int cidx = 0; cidx < 36; ++cidx) lg[cidx] = PL[tid * 40 + cidx] + PL[(128 + tid) * 40 + cidx];
            const float sq = (SS[tid * 2] + SS[tid * 2 + 1]) + (SS[(128 + tid) * 2] + SS[(128 + tid) * 2 + 1]);
            rstd = rsqrtf(sq * (1.f / D_) + EPS);
            float gl[4]; int grp_i = 0;
#pragma unroll
            for (int q = 0; q < 4; ++q) gl[q] = lg[q] * rstd + bgrp[q];
            float gm = gl[0];
#pragma unroll
            for (int q = 1; q < 4; ++q) if (gl[q] > gm) { gm = gl[q]; grp_i = q; }
            float gs = 0.f;
#pragma unroll
            for (int q = 0; q < 4; ++q) gs += __expf(gl[q] - gm);
            const float grp_gate = 1.f / gs;
            float el[8];
#pragma unroll
            for (int q = 0; q < 8; ++q) { float v = lg[4 + q]; float bb = bexp[q];
                if (grp_i == 1) { v = lg[12 + q]; bb = bexp[8 + q]; } else if (grp_i == 2) { v = lg[20 + q]; bb = bexp[16 + q]; } else if (grp_i == 3) { v = lg[28 + q]; bb = bexp[24 + q]; }
                el[q] = v * rstd + bb; }
            int i0 = 0; float v0 = el[0];
#pragma unroll
            for (int q = 1; q < 8; ++q) if (el[q] > v0) { v0 = el[q]; i0 = q; }
            int i1 = -1; float v1 = -INFINITY;
#pragma unroll
            for (int q = 0; q < 8; ++q) if (q != i0 && el[q] > v1) { v1 = el[q]; i1 = q; }
            const float e1 = __expf(v1 - v0), den = 1.f + e1, w0 = grp_gate / den, w1 = grp_gate * e1 / den;
            const int lo = i0 < i1 ? i0 : i1, hi = i0 < i1 ? i1 : i0; cls = grp_i * 28 + lo * 8 - (lo * (lo + 1)) / 2 + (hi - lo - 1);
            wlo = i0 < i1 ? w0 : w1; whi = i0 < i1 ? w1 : w0;
            lrank = __hip_atomic_fetch_add(HIST + cls, 1u, __ATOMIC_RELAXED, __HIP_MEMORY_SCOPE_WORKGROUP);
        }
        __syncthreads();
        if (tid < 112) { const unsigned n = HIST[tid]; if (n) HIST[112 + tid] = __hip_atomic_fetch_add(cnt + tid * MOE_CS, n, __ATOMIC_RELAXED, __HIP_MEMORY_SCOPE_AGENT); }
        __syncthreads();
        if (tid < 128) {
            const unsigned rank = HIST[112 + cls] + lrank;
            const int row = grp * 128 + tid;
            ((unsigned*)(ws + WS_ROUTE + RT_INFO))[row] = ((unsigned)cls << 24) | rank;
            ((float*)(ws + WS_ROUTE + RT_W))[2 * row] = wlo; ((float*)(ws + WS_ROUTE + RT_W))[2 * row + 1] = whi;
            ((float*)(ws + WS_ROUTE + RT_RSTD))[row] = rstd;
        }
        __syncthreads();
    }
}
typedef float f32x8 __attribute__((ext_vector_type(8)));
__device__ __forceinline__ void P_route2(int l_, int cbank) { const KP p = (KP)__builtin_amdgcn_kernarg_segment_ptr(); int l = l_; asm volatile("" : "+s"(l));
    int tid_ = threadIdx.x; asm volatile("" : "+v"(tid_));
    const int tid = tid_, lane = tid & 63, wave = __builtin_amdgcn_readfirstlane(tid >> 6);
    unsigned char* ws = p->ws; asm volatile("" : "+s"(ws)); const float* x = p->out;
    const float* WR = (const float*)(ws + WS_WR) + (size_t)l * D_ * 40;
    LAS float* xt = (LAS float*)lds_raw + wave * (64 * 36);
    LAS float* part = (LAS float*)lds_raw;
    const float* bgrp = p->in[16] + l * 4; const float* bexp = p->in[18] + l * 32;
    unsigned* cnt = (unsigned*)(ws + WS_CTL) + CW_MOECNT + l * 128 + cbank;
    for (int grp = launder_s((int)blockIdx.x); grp < NT / 128; grp += (int)gridDim.x) {
        const int row0 = grp * 128 + (wave >> 2) * 64, kq = wave & 3;
        float acc[40]; float ss = 0.f;
#pragma unroll
        for (int cidx = 0; cidx < 40; ++cidx) acc[cidx] = 0.f;
#pragma unroll 1
        for (int kc = 0; kc < 8; ++kc) {
            const int k0 = kq * 256 + kc * 32;
#pragma unroll
            for (int i = 0; i < 8; ++i) { const int row = i * 8 + (lane >> 3), c4 = (lane & 7) * 4; *(LAS f32x4*)(xt + row * 36 + c4) = *(const f32x4*)(x + (size_t)(row0 + row) * D_ + k0 + c4); }
            float xr[32];
#pragma unroll
            for (int j = 0; j < 8; ++j) { const f32x4 t = *(const LAS f32x4*)(xt + lane * 36 + 4 * j); xr[4 * j] = t.x; xr[4 * j + 1] = t.y; xr[4 * j + 2] = t.z; xr[4 * j + 3] = t.w; }
            const float* wk = WR + (size_t)k0 * 40;
#pragma unroll
            for (int kk = 0; kk < 32; ++kk) {
                f32x8 w0, w1, w2, w3, w4;
                asm volatile("s_load_dwordx8 %0, %5, %6\n\ts_load_dwordx8 %1, %5, %7\n\ts_load_dwordx8 %2, %5, %8\n\ts_load_dwordx8 %3, %5, %9\n\ts_load_dwordx8 %4, %5, %10\n\ts_waitcnt lgkmcnt(0)"
                             : "=&s"(w0), "=&s"(w1), "=&s"(w2), "=&s"(w3), "=&s"(w4) : "s"(wk), "i"(kk * 160), "i"(kk * 160 + 32), "i"(kk * 160 + 64), "i"(kk * 160 + 96), "i"(kk * 160 + 128) : "memory");
                const float xv = xr[kk]; ss = fmaf(xv, xv, ss);
#pragma unroll
                for (int e = 0; e < 8; ++e) { acc[e] = fmaf(xv, w0[e], acc[e]); acc[8 + e] = fmaf(xv, w1[e], acc[8 + e]); acc[16 + e] = fmaf(xv, w2[e], acc[16 + e]); acc[24 + e] = fmaf(xv, w3[e], acc[24 + e]); }
#pragma unroll
                for (int e = 0; e < 4; ++e) acc[32 + e] = fmaf(xv, w4[e], acc[32 + e]);
            }
        }
        __syncthreads();
#pragma unroll
        for (int cidx = 0; cidx < 36; ++cidx) part[(wave * 64 + lane) * 37 + cidx] = acc[cidx];
        part[(wave * 64 + lane) * 37 + 36] = ss;
        __syncthreads();
        if (tid < 128) {
            const int rg = tid >> 6, rr = tid & 63; float lg[37];
#pragma unroll
            for (int cidx = 0; cidx < 37; ++cidx) lg[cidx] = ((part[((rg * 4 + 0) * 64 + rr) * 37 + cidx] + part[((rg * 4 + 1) * 64 + rr) * 37 + cidx]) + part[((rg * 4 + 2) * 64 + rr) * 37 + cidx]) + part[((rg * 4 + 3) * 64 + rr) * 37 + cidx];
            const float rstd = rsqrtf(lg[36] * (1.f / D_) + EPS);
            float gl[4]; int grp_i = 0;
#pragma unroll
            for (int q = 0; q < 4; ++q) gl[q] = lg[q] * rstd + bgrp[q];
            float gm = gl[0];
#pragma unroll
            for (int q = 1; q < 4; ++q) if (gl[q] > gm) { gm = gl[q]; grp_i = q; }
            float gs = 0.f;
#pragma unroll
            for (int q = 0; q < 4; ++q) gs += __expf(gl[q] - gm);
            const float grp_gate = 1.f / gs;
            float el[8];
#pragma unroll
            for (int q = 0; q < 8; ++q) { float v = lg[4 + q]; float bb = bexp[q];
                if (grp_i == 1) { v = lg[12 + q]; bb = bexp[8 + q]; } else if (grp_i == 2) { v = lg[20 + q]; bb = bexp[16 + q]; } else if (grp_i == 3) { v = lg[28 + q]; bb = bexp[24 + q]; }
                el[q] = v * rstd + bb; }
            int i0 = 0; float v0 = el[0];
#pragma unroll
            for (int q = 1; q < 8; ++q) if (el[q] > v0) { v0 = el[q]; i0 = q; }
            int i1 = -1; float v1 = -INFINITY;
#pragma unroll
            for (int q = 0; q < 8; ++q) if (q != i0 && el[q] > v1) { v1 = el[q]; i1 = q; }
            const float e1 = __expf(v1 - v0), den = 1.f + e1, w0 = grp_gate / den, w1 = grp_gate * e1 / den;
            const int lo = i0 < i1 ? i0 : i1, hi = i0 < i1 ? i1 : i0, cls = grp_i * 28 + lo * 8 - (lo * (lo + 1)) / 2 + (hi - lo - 1);
            const unsigned rank = __hip_atomic_fetch_add(cnt + cls, 1u, __ATOMIC_RELAXED, __HIP_MEMORY_SCOPE_AGENT);
            const int row = grp * 128 + tid;
            ((unsigned*)(ws + WS_ROUTE + RT_INFO))[row] = ((unsigned)cls << 24) | rank;
            ((float*)(ws + WS_ROUTE + RT_W))[2 * row] = i0 < i1 ? w0 : w1; ((float*)(ws + WS_ROUTE + RT_W))[2 * row + 1] = i0 < i1 ? w1 : w0;
            ((float*)(ws + WS_ROUTE + RT_RSTD))[row] = rstd;
        }
        __syncthreads();
    }
}
__device__ __noinline__ void P_route(KP p_, int l_) { const KP p = uni_kp(p_); const int l = __builtin_amdgcn_readfirstlane(l_); const Ctx c = make_ctx(p); const Bufs b = make_bufs(p->ws);
    ph_moe_route(c, p->out, p->in[14] + (size_t)l * D_, p->in[15] + (size_t)l * D_ * 4, p->in[16] + l * 4, p->in[17] + (size_t)l * D_ * 32, p->in[18] + l * 32, b.HN, (int*)(p->ws + WS_ROUTE + RT_INFO), (float*)(p->ws + WS_ROUTE + RT_W), (unsigned*)(p->ws + WS_CTL) + CW_MOECNT + l * 128); }
__device__ __noinline__ void P_moe(KP p_, int l_) { const KP p = uni_kp(p_); const int l = __builtin_amdgcn_readfirstlane(l_); const Ctx c = make_ctx(p); const Bufs b = make_bufs(p->ws);
    ph_moe_naive(c, b.HN, b.ROUTE_E, b.ROUTE_W, p->in[19] + (size_t)l * NEXP * D_ * DEXP, p->in[20] + (size_t)l * NEXP * D_ * DEXP, p->in[21] + (size_t)l * NEXP * DEXP * D_, p->out); }
__device__ __noinline__ void P_final(KP p_) { const KP p = uni_kp(p_); const Ctx c = make_ctx(p); ph_norm_final_from_bf16(c, (const bf16*)(p->ws + WS_HN), p->in[22], p->out); }
__device__ __forceinline__ void P_gridbar(KP p_) { const KP p = uni_kp(p_);
    XcdBarrier bar; bar.bar = (unsigned*)(p->ws + WS_CTL) + 4096; bar.x = xb_xcc_id(); bar.st = (volatile LAS unsigned*)((LAS unsigned char*)lds_raw + MISC_OFF) + 8;
    xcd_barrier(bar);
}

__global__ void __launch_bounds__(NTHREADS, 2) fwd_kernel(Params pp) {
    const KP p = (KP)__builtin_amdgcn_kernarg_segment_ptr();
    { volatile LAS unsigned* MISC = (volatile LAS unsigned*)((LAS unsigned char*)lds_raw + MISC_OFF); if (threadIdx.x < 32) MISC[threadIdx.x] = 0u; }
    __syncthreads();
    const int lo = p->ph_lo, hi = p->ph_hi;
    if (hi - lo > 1) (void)xcd_barrier_post((unsigned*)(p->ws + WS_CTL) + 4096, (volatile LAS unsigned*)((LAS unsigned char*)lds_raw + MISC_OFF) + 8);
#define IN(k) (lo <= (k) && (k) < hi)
#define SEAM(k) do { if (IN(k) && IN((k) + 1)) P_gridbar(p); } while (0)
    if (IN(0)) { for (int rep = 0; rep < REP_PRO; ++rep) { if (rep) P_gridbar(p); P_prologue(p); } }
    SEAM(0);
    for (int l = 0; l < L_; ++l) {
        const int P0 = 1 + l * PH_PER_LAYER;
        if (IN(P0 + 0)) { for (int rep = 0; rep < REP_NORM; ++rep) { if (rep) P_gridbar(p); P_norm1(p, l); } }
        SEAM(P0 + 0);
        if (IN(P0 + 1)) { for (int rep = 0; rep < REP_INPROJ; ++rep) { if (rep) P_gridbar(p); P_inproj_mfma(l); }
#ifdef REP_INDUMMY
            for (int rep = 0; rep < REP_INDUMMY; ++rep) { P_gridbar(p); P_inproj_dummy(l); }
#endif
        }
        SEAM(P0 + 1);
        if (IN(P0 + 3)) {
            P_cmp1_mfma(l);
            if (launder_s((int)blockIdx.x) < 32) { asm volatile("s_waitcnt vmcnt(0)" ::: "memory"); __builtin_amdgcn_fence(__ATOMIC_SEQ_CST, "agent"); asm volatile("s_waitcnt vmcnt(0)" ::: "memory"); }
            __syncthreads();
            P_cmp2_mfma(l);
            for (int rep = 0; rep < REP_ATT3; ++rep) { if (rep) P_gridbar(p);
            for (;;) { int u = fetch_unit(p, l * 8 + 0 + 16 * rep);
                if (l == 0) {
                    if (u >= 2048 + CONV_UNITS) break;
                    const int k11 = u / 11, r11 = u - 11 * k11;
                    if (r11 == 3 || r11 == 7 || r11 == 10) { U_conv(p, 3 * k11 + (r11 > 3) + (r11 > 7)); continue; }
                    u = 8 * k11 + r11 - (r11 > 3) - (r11 > 7); }
                else if (u >= 2048) break;
                if (u < 1024) { const int qb = 15 - (u >> 6), k = u & 63; if (k < 32) U_diff(p, k, qb, l); else U_fox(p, k - 32, qb, l); }
                else { const int w = u - 1024; U_win(p, w & 15, 63 - (w >> 4)); } } } }
        SEAM(P0 + 3);
        if (IN(P0 + 4)) { for (int rep = 0; rep < REP_CMP; ++rep) { if (rep) P_gridbar(p); for (int u = launder_s((int)blockIdx.x); u < 256; u += (int)gridDim.x) U_cmp(p, u & 15, u >> 4); } }
        SEAM(P0 + 4);
        if (IN(P0 + 5)) { for (int rep = 0; rep < REP_SLC; ++rep) { if (rep) P_gridbar(p); for (;;) { const int u = fetch_unit(p, l * 8 + 1 + 16 * rep); if (u >= 1024) break; U_slc(p, u & 15, 63 - (u >> 4)); } } }
        SEAM(P0 + 5);
        if (IN(P0 + 6)) P_outproj_mfma(l);
        SEAM(P0 + 6);
        if (IN(P0 + 7)) { for (int rep = 0; rep < REP_ROUTE; ++rep) { if (rep) P_gridbar(p); P_route3(l, REP_ROUTE - 1 - rep); } }
        SEAM(P0 + 7);
        if (IN(P0 + 8)) { for (int rep = 0; rep < REP_SCAT; ++rep) { if (rep) P_gridbar(p); P_moe_scatter(p, l); } }
        SEAM(P0 + 8);
        if (IN(P0 + 9)) { for (int rep = 0; rep < REP_G1; ++rep) { if (rep) P_gridbar(p); P_moe_g1(l); } }
        SEAM(P0 + 9);
        if (IN(P0 + 10)) P_moe_g2(l);
        SEAM(P0 + 10);
    }
    if (IN(1 + L_ * PH_PER_LAYER)) P_final(p);
#undef IN
#undef SEAM
}

extern "C" void kernel_launch(void* const* d_in, const int* in_sizes, int n_in, void* d_out, int out_size, void* d_ws, size_t ws_size, hipStream_t stream) {
    static int grid = 0;
    if (grid == 0) {
        if (n_in != 23 || out_size != NT * D_ || ws_size < WS_END) { fprintf(stderr, "kernel_launch: unexpected sizes n_in %d out %d ws %zu (need %zu)\n", n_in, out_size, ws_size, (size_t)WS_END); grid = -1; return; }
        int dev = 0, cus = 0, per_cu = 0;
        if (hipGetDevice(&dev) != hipSuccess || hipDeviceGetAttribute(&cus, hipDeviceAttributeMultiprocessorCount, dev) != hipSuccess) { grid = -1; return; }
        if (hipFuncSetAttribute((const void*)fwd_kernel, hipFuncAttributeMaxDynamicSharedMemorySize, LDS_BYTES) != hipSuccess) { fprintf(stderr, "kernel_launch: hipFuncSetAttribute failed\n"); grid = -1; return; }
        if (hipOccupancyMaxActiveBlocksPerMultiprocessor(&per_cu, (const void*)fwd_kernel, NTHREADS, LDS_BYTES) != hipSuccess || per_cu < 1) { fprintf(stderr, "kernel_launch: occupancy query says %d\n", per_cu); }
        (void)hipGetLastError();
        grid = cus;
    }
    if (grid < 0) return;
    (void)hipMemsetAsync((char*)d_ws + WS_CTL, 0, CTL_BYTES, stream);
    Params p{};
    for (int i = 0; i < 23; ++i) p.in[i] = (const float*)d_in[i];
    p.out = (float*)d_out; p.ws = (unsigned char*)d_ws;
#if N_LAUNCH_MODE == 0
    p.ph_lo = 0; p.ph_hi = N_PHASES;
    hipLaunchKernelGGL(fwd_kernel, dim3(grid), dim3(NTHREADS), LDS_BYTES, stream, p);
#else
    for (int k = 0; k < N_PHASES; ++k) { p.ph_lo = k; p.ph_hi = k + 1; hipLaunchKernelGGL(fwd_kernel, dim3(grid), dim3(NTHREADS), LDS_BYTES, stream, p); }
#endif
}
```

```cpp
#include <hip/hip_runtime.h>
#include <cstdio>
#include <cstdint>

#ifndef INPROJ_ALIGN
#define INPROJ_ALIGN true
#endif
#ifndef INPROJ_SP2
#define INPROJ_SP2 true
#endif
#ifndef REP_PRO
#define REP_PRO 1
#endif
#ifndef REP_ROUTE
#define REP_ROUTE 1
#endif
#ifndef REP_NORM
#define REP_NORM 1
#endif
#ifndef REP_INPROJ
#define REP_INPROJ 1
#endif
#ifndef REP_ATT3
#define REP_ATT3 1
#endif
#ifndef REP_CMP
#define REP_CMP 1
#endif
#ifndef REP_SLC
#define REP_SLC 1
#endif
#ifndef REP_SCAT
#define REP_SCAT 1
#endif
#ifndef REP_G1
#define REP_G1 1
#endif
#ifndef N_LAUNCH_MODE
#define N_LAUNCH_MODE 0
#endif

#define LAS __attribute__((address_space(3)))
#define GAS __attribute__((address_space(1)))
typedef unsigned short bf16;
typedef unsigned long long u64;
typedef float f32x4 __attribute__((ext_vector_type(4)));
typedef unsigned u32x4 __attribute__((ext_vector_type(4)));

constexpr int B_ = 8, T_ = 4096, D_ = 1024, NT = B_ * T_, L_ = 2;
constexpr int HD = 64, D_IN = 2844;
constexpr int N_CMP = 255, CMP_HID = 256;
constexpr int NEXP = 32, DEXP = 256;
constexpr float EPS = 1e-6f;
constexpr float LOG2E = 1.4426950408889634f;
constexpr int NWAVES = 8, NTHREADS = 512;

constexpr int C_NSAQ = 0, C_KV6 = 512, C_GATE = 1280, C_FQ = 1304, C_FF = 2072, C_DQ = 2076, C_DV = 2588;

constexpr size_t MiB = 1u << 20;
constexpr size_t WS_CTL = 0, CTL_BYTES = 1 * MiB;
constexpr size_t WS_QN = 1 * MiB;
constexpr size_t WS_KV6 = WS_QN + 32 * MiB;
constexpr size_t KV6_STRIDE = 8 * MiB + 64 * 1024;
constexpr size_t WS_FQKV = WS_KV6 + 6 * KV6_STRIDE;
constexpr size_t WS_DQK = WS_FQKV + 48 * MiB;
constexpr size_t WS_DV = WS_DQK + 32 * MiB;
constexpr size_t WS_GATE = WS_DV + 16 * MiB;
constexpr size_t WS_FL = WS_GATE + 3 * MiB;
constexpr size_t WS_HC = WS_FL + 1 * MiB;
constexpr size_t WS_KVCMP = WS_HC + 4 * MiB;
constexpr size_t WS_SEL = WS_KVCMP + 1 * MiB;
constexpr size_t WS_OCMP = WS_SEL + 1 * MiB;
constexpr size_t WS_OWIN = WS_OCMP + 32 * MiB;
constexpr size_t WS_HN = WS_OWIN + 32 * MiB;
constexpr size_t WS_ATT = WS_HN + 64 * MiB;
constexpr size_t WS_ROUTE = WS_ATT + 64 * MiB;
constexpr size_t WS_WIN_T = WS_ROUTE + 2 * MiB;
constexpr size_t WS_WOUT_T = WS_WIN_T + 12 * MiB;
constexpr size_t WS_WGU_T = WS_WOUT_T + 4 * MiB;
constexpr size_t WS_WD_T = WS_WGU_T + 64 * MiB;
constexpr size_t WS_W1_T = WS_WD_T + 32 * MiB;
constexpr size_t WS_W2_T = WS_W1_T + 4 * MiB;
constexpr size_t WS_BIAS1 = WS_W2_T + 512 * 1024;
constexpr size_t WS_WR = WS_BIAS1 + 512 * 1024;
constexpr size_t WS_B1PART = WS_WR + 512 * 1024;
constexpr size_t WS_END = WS_B1PART + 512 * 1024;
constexpr int MOE_MAXROWS = 61440;
constexpr size_t WS_XS = WS_QN;
constexpr size_t WS_HB = WS_OCMP;
static_assert(WS_XS + (size_t)MOE_MAXROWS * 2048 <= WS_DQK && WS_HB + (size_t)MOE_MAXROWS * 1024 <= WS_HN, "MoE aliases");
constexpr size_t RT_INFO = 0, RT_W = 128 * 1024, RT_ROWTOK = 384 * 1024, RT_ROWW = 640 * 1024, RT_RSTD = 1152 * 1024;
constexpr int CW_QUEUE = 16384, CW_MOECNT = 32768, CW_KN = 49152, MOE_CS = 32, MOE_LS = 4096;
constexpr size_t WS_REC = WS_QN;
constexpr unsigned ZROW_OFF = 512 * 1024;
static_assert(WS_REC + (size_t)112 * 32768 * 16 <= WS_DQK && WS_HN + (size_t)NT * 2048 < (1ull << 32), "MoE record table / 32-bit row offsets");
constexpr int TBL_OFF = 131072 + 1024;
constexpr int NIN = 3072;

extern __shared__ __attribute__((aligned(16))) unsigned char lds_raw[];
__device__ __forceinline__ float bf2f(bf16 v) { return __uint_as_float(((unsigned)v) << 16); }
__device__ __forceinline__ unsigned f2bf(float f) { unsigned u = __float_as_uint(f); return (u + 0x7fffu + ((u >> 16) & 1u)) >> 16; }
__device__ __forceinline__ unsigned pk2(float lo, float hi) { return f2bf(lo) | (f2bf(hi) << 16); }
__device__ __forceinline__ float wave_sum(float v) {
#pragma unroll
    for (int o = 1; o < 64; o <<= 1) v += __shfl_xor(v, o);
    return v;
}
__device__ __forceinline__ float wave_max(float v) {
#pragma unroll
    for (int o = 1; o < 64; o <<= 1) v = fmaxf(v, __shfl_xor(v, o));
    return v;
}
__device__ __forceinline__ float shflx_f(float v, int o, int lane) { return __uint_as_float((unsigned)__builtin_amdgcn_ds_bpermute((lane ^ o) << 2, (int)__float_as_uint(v))); }
__device__ __forceinline__ unsigned shflx_u(unsigned v, int o, int lane) { return (unsigned)__builtin_amdgcn_ds_bpermute((lane ^ o) << 2, (int)v); }
__device__ __forceinline__ float wave_sum_l(float v, int lane) {
#pragma unroll
    for (int o = 1; o < 64; o <<= 1) v += shflx_f(v, o, lane);
    return v;
}
__device__ __forceinline__ int launder_s(int v) { asm volatile("" : "+s"(v)); return v; }
__device__ __forceinline__ float sigmoidf_(float x) { return 1.f / (1.f + __expf(-x)); }
__device__ __forceinline__ float log_sigmoidf_(float x) { return x >= 0.f ? -log1pf(__expf(-x)) : x - log1pf(__expf(x)); }
__device__ __forceinline__ float gelu_tanh(float x) { const float u = 0.7978845608028654f * (x + 0.044715f * x * x * x); return 0.5f * x * (1.f + tanhf(u)); }
__device__ __forceinline__ float alibi_slope(int idx1, int n) { return exp2f(-8.0f * (float)idx1 / (float)n); }

__device__ __forceinline__ constexpr int b64_off(int t, int d) { return ((t >> 4) * 2 + (d >> 5)) * 512 + (t & 15) * 32 + (d & 31); }
#define XB_TMO      128
#define XB_XCNT(j)  (256  + 64 * (j))
#define XB_XSUB(j)  (1280 + 64 * (j))
#define XB_XGEN(j)  (2304 + 64 * (j))
#define XB_TOP      3328
#define XB_TOPGEN   3392
#define XCD_BAR_WORDS 3456
#define XB_SPIN_CAP (1u << 25)
__device__ __forceinline__ unsigned xb_ld(unsigned* p)              { return __hip_atomic_load(p, __ATOMIC_RELAXED, __HIP_MEMORY_SCOPE_AGENT); }
__device__ __forceinline__ unsigned xb_add(unsigned* p, unsigned v) { return __hip_atomic_fetch_add(p, v, __ATOMIC_RELAXED, __HIP_MEMORY_SCOPE_AGENT); }
__device__ __forceinline__ unsigned xb_xcc_id() { return (unsigned)__builtin_amdgcn_s_getreg((3 << 11) | 20) & 0xFu; }
#define XB_SPIN(cond, bar) do { unsigned _sp = 0; while (cond) { __builtin_amdgcn_s_sleep(1); \
    if ((++_sp & 255u) == 0u) { if (xb_ld(&(bar)[XB_TMO])) break; if (_sp > XB_SPIN_CAP) { atomicAdd(&(bar)[XB_TMO], 1u); break; } } } } while (0)
struct XcdBarrier { unsigned* bar; unsigned x; volatile LAS unsigned* st; };
__device__ __forceinline__ XcdBarrier xcd_barrier_post(unsigned* bar, volatile LAS unsigned* st) {
    XcdBarrier b; b.bar = bar; b.x = xb_xcc_id(); b.st = st;
    if (threadIdx.x == 0) (void)xb_add(&bar[XB_XCNT(b.x)], 1u);
    return b;
}
__device__ __forceinline__ void xcd_barrier_complete(unsigned* bar, unsigned x, unsigned& nloc, unsigned& nx) {
    const unsigned G = gridDim.x * gridDim.y * gridDim.z;
    unsigned sum, cnt, mine, sp = 0u;
    for (;;) {
        sum = 0u; cnt = 0u; mine = 0u;
#pragma unroll
        for (unsigned j = 0; j < 16; ++j) { const unsigned c = xb_ld(&bar[XB_XCNT(j)]); sum += c; cnt += (c > 0u) ? 1u : 0u; mine = (j == x) ? c : mine; }
        if (sum == G) break;
        __builtin_amdgcn_s_sleep(1);
        if ((++sp & 255u) == 0u) { if (xb_ld(&bar[XB_TMO])) break; if (sp > XB_SPIN_CAP) { atomicAdd(&bar[XB_TMO], 1u); break; } }
    }
    nloc = mine > 0u ? mine : 1u; nx = cnt > 0u ? cnt : 1u;
}
__device__ __forceinline__ void xcd_barrier(const XcdBarrier& b) {
    asm volatile("s_waitcnt vmcnt(0)" ::: "memory");
    __syncthreads();
    if (threadIdx.x == 0) {
        unsigned* bar = b.bar;
        __builtin_amdgcn_s_waitcnt(0);
        unsigned nloc = b.st[0], nx = b.st[1];
        if (nloc == 0u) { xcd_barrier_complete(bar, b.x, nloc, nx); b.st[0] = nloc; b.st[1] = nx; }
        const unsigned old = xb_add(&bar[XB_XSUB(b.x)], 1u);
        const unsigned gen = old / nloc;
        if (old + 1u == (gen + 1u) * nloc) {
            __builtin_amdgcn_fence(__ATOMIC_RELEASE, "agent");
            asm volatile("s_waitcnt vmcnt(0)" ::: "memory");
            const unsigned og = xb_add(&bar[XB_TOP], 1u);
            const unsigned tg = og / nx;
            if (og + 1u == (tg + 1u) * nx) xb_add(&bar[XB_TOPGEN], 1u);
            else XB_SPIN(xb_ld(&bar[XB_TOPGEN]) == tg, bar);
            __builtin_amdgcn_fence(__ATOMIC_ACQUIRE, "agent");
            xb_add(&bar[XB_XGEN(b.x)], 1u);
            asm volatile("s_waitcnt vmcnt(0)" ::: "memory");
        } else {
            XB_SPIN(xb_ld(&bar[XB_XGEN(b.x)]) == gen, bar);
            __builtin_amdgcn_fence(__ATOMIC_ACQUIRE, "agent");
            asm volatile("s_waitcnt vmcnt(0)" ::: "memory");
        }
    }
    __syncthreads();
}

struct Params { const float* in[23]; float* out; unsigned char* ws; int ph_lo, ph_hi; };
constexpr int LDS_BYTES = 147456;
constexpr int MISC_OFF = 131072 + 320;

struct Ctx {
    LAS unsigned char* lds; int tid, lane, wave, bid, G, gw, ngw;
    const float* const* in; float* xcur; unsigned char* ws;
};

namespace pg8 {
#define PG8_LAS __attribute__((address_space(3)))
typedef unsigned short bf16_t;
typedef short bf16x8 __attribute__((ext_vector_type(8)));
typedef float f32x4 __attribute__((ext_vector_type(4)));
typedef unsigned u32x4 __attribute__((ext_vector_type(4)));
constexpr int BM = 256, BK = 64, HALF = 128, HTB = HALF * BK * 2  , STAGE_BYTES = 8 * HTB, NXCD = 8, WGM = 8;

__host__ __device__ __forceinline__ int lds_byte(int r, int c) { const int st = (r >> 4) * 2 + (c >> 5), rr = r & 15, cc = c & 31, ob = rr * 64 + cc * 2; return st * 1024 + (ob ^ (((ob >> 9) & 1) << 5)); }
__host__ __device__ __forceinline__ void stage_rc(int b, int& R, int& C) { const int st = b / 1024, sb = b % 1024, swz = sb ^ (((sb >> 9) & 1) << 5); R = (st >> 1) * 16 + swz / 64; C = (st & 1) * 32 + (swz % 64) / 2; }
__host__ __device__ __forceinline__ int perm32(int rho) { const int n = rho >> 4, i = rho & 15; return 8 * (i >> 2) + 4 * n + (i & 3); }

struct Unit { int pm, pn; const char* a; const char* b; const char* b2; };
struct Gemm { int lda, ldb, K, ksplit, arb, acb; };

__device__ __forceinline__ unsigned cvt_pk_bf16(float lo, float hi) { unsigned r; asm volatile("v_cvt_pk_bf16_f32 %0, %1, %2" : "=v"(r) : "v"(lo), "v"(hi)); return r; }
typedef float f32x2 __attribute__((ext_vector_type(2)));

template <class Epi, class Sched, bool ALIGN_EPI = false, bool SP2 = false, bool GATHER = false>
__device__ __forceinline__ void gemm_phase(PG8_LAS unsigned char* lds, const Gemm g, const Sched& S, const Epi& E) {
    static_assert(!GATHER || SP2, "GATHER is written for the SP2 loop");
    int tid_ = threadIdx.x; asm volatile("" : "+v"(tid_));
    const int tid = tid_, wid = __builtin_amdgcn_readfirstlane(tid >> 6), lane = tid & 63, wr = wid >> 2, wc = wid & 3, fr = lane & 15, fq = lane >> 4;
    const int K = g.K, nt = K / BK, ks = g.ksplit;
    unsigned voffA[2], voffB[2];
#pragma unroll
    for (int i = 0; i < 2; ++i) { int R, C; stage_rc(tid * 16 + i * 8192, R, C); const int Rb = Epi::PERM ? ((R & ~31) + perm32(R & 31)) : R;
        voffA[i] = g.arb ? (unsigned)(((R / g.arb) * (K / g.acb) + C / g.acb) * (g.arb * g.acb) + (R % g.arb) * g.acb + (C % g.acb)) * 2u : (unsigned)(R * g.lda + C) * 2u; voffB[i] = (unsigned)(Rb * g.ldb + C) * 2u; }
    const size_t kstep = (size_t)(BK * 2), kstepA = g.arb ? (size_t)(BK * g.arb * 2) : kstep;
    const size_t hsA = (size_t)HALF * (g.arb ? K : g.lda) * 2, hsB = (size_t)HALF * g.ldb * 2;
    const unsigned ldsw = (unsigned)wid * 1024u;
    const int aoff = lds_byte(wr * 64 + fr, fq * 8), boff = lds_byte(wc * 32 + fr, fq * 8);
#define PG8_SA(b, h) (((b) * 2 + (h)) * HTB)
#define PG8_SB(b, h) ((4 + (b) * 2 + (h)) * HTB)
#define PG8_STAGE(bufoff, gbase, voff) do { _Pragma("unroll") for (int _i = 0; _i < 2; ++_i) \
        __builtin_amdgcn_global_load_lds((const unsigned*)((const char*)(gbase) + (voff)[_i]), (PG8_LAS unsigned*)(lds + (bufoff) + ldsw + _i * 8192), 16, 0, 0); } while (0)
#define PG8_LDA(dst, b, h) do { _Pragma("unroll") for (int m = 0; m < 4; ++m) _Pragma("unroll") for (int k = 0; k < 2; ++k) dst[m][k] = *(const PG8_LAS bf16x8*)(lds + PG8_SA(b, h) + aoff + m * 2048 + k * 1024); } while (0)
#define PG8_LDB(dst, b, h) do { _Pragma("unroll") for (int n = 0; n < 2; ++n) _Pragma("unroll") for (int k = 0; k < 2; ++k) dst[n][k] = *(const PG8_LAS bf16x8*)(lds + PG8_SB(b, h) + boff + n * 2048 + k * 1024); } while (0)
#define PG8_MMA(ai, bj, At, Bt) do { __builtin_amdgcn_s_setprio(1); _Pragma("unroll") for (int m = 0; m < 4; ++m) _Pragma("unroll") for (int n = 0; n < 2; ++n) _Pragma("unroll") for (int k = 0; k < 2; ++k) \
        acc[ai][bj][m][n] = __builtin_amdgcn_mfma_f32_16x16x32_bf16(Bt[n][k], At[m][k], acc[ai][bj][m][n], 0, 0, 0); __builtin_amdgcn_s_setprio(0); } while (0)
#define PG8_WAIT_V(n) asm volatile("s_waitcnt vmcnt(" #n ")" ::: "memory")
#define PG8_WAIT_L(n) asm volatile("s_waitcnt lgkmcnt(" #n ")" ::: "memory")
#define PG8_BAR __builtin_amdgcn_s_barrier()
#define PG8_SCHED __builtin_amdgcn_sched_barrier(0)
    Unit cur, nxt; int ui = 0;
    if (!S.next(0, cur)) return;
    unsigned gC[2][2] = {{0u, 0u}, {0u, 0u}}, gN[2][2] = {{0u, 0u}, {0u, 0u}}; const char* gbase = nullptr;
#define PG8_GOFFS(U, Gv) do { _Pragma("unroll") for (int _h = 0; _h < 2; ++_h) _Pragma("unroll") for (int _i = 0; _i < 2; ++_i) { int R_, C_; stage_rc(tid * 16 + _i * 8192, R_, C_); Gv[_h][_i] = S.arow(U, _h * HALF + R_) + (unsigned)C_ * 2u; } } while (0)
#define PG8_STAGE_G(bufoff, kbyte, Gv, h) do { _Pragma("unroll") for (int _i = 0; _i < 2; ++_i) \
        __builtin_amdgcn_global_load_lds((const unsigned*)(gbase + (size_t)(kbyte) + Gv[h][_i]), (PG8_LAS unsigned*)(lds + (bufoff) + ldsw + _i * 8192), 16, 0, 0); } while (0)
    if constexpr (GATHER) { gbase = S.abase(); PG8_GOFFS(cur, gC); }
    f32x4 acc[2][2][4][2];
#pragma unroll
    for (int a = 0; a < 2; ++a)
#pragma unroll
        for (int b = 0; b < 2; ++b)
#pragma unroll
            for (int m = 0; m < 4; ++m)
#pragma unroll
                for (int n = 0; n < 2; ++n) acc[a][b][m][n] = (f32x4){0.f, 0.f, 0.f, 0.f};
    bf16x8 At[4][2], B0[2][2], B1[2][2];
    const char* cA = cur.a; const char* cB = cur.b; const char* cB2 = cur.b2;
#define PG8_BK(base, base2, kt) ((kt) < ks ? (base) + (size_t)(kt) * kstep : (base2) + (size_t)((kt) - ks) * kstep)
    S.a_ready(cur);
    if constexpr (SP2) {
        PG8_STAGE(PG8_SB(0, 0), cB, voffB); PG8_STAGE(PG8_SB(0, 1), cB + hsB, voffB);
        if constexpr (GATHER) { PG8_STAGE_G(PG8_SA(0, 0), 0, gC, 0); PG8_STAGE_G(PG8_SA(0, 1), 0, gC, 1); } else { PG8_STAGE(PG8_SA(0, 0), cA, voffA); PG8_STAGE(PG8_SA(0, 1), cA + hsA, voffA); }
        if (wr == 1) PG8_BAR;
        PG8_WAIT_V(2); PG8_BAR;
        PG8_STAGE(PG8_SB(1, 0), PG8_BK(cB, cB2, 1), voffB);
        if constexpr (GATHER) PG8_STAGE_G(PG8_SA(1, 0), kstep, gC, 0); else PG8_STAGE(PG8_SA(1, 0), cA + kstepA, voffA);
        PG8_STAGE(PG8_SB(1, 1), PG8_BK(cB, cB2, 1) + hsB, voffB);
        PG8_WAIT_V(6); PG8_BAR;
    } else {
        PG8_STAGE(PG8_SB(0, 0), cB, voffB); PG8_STAGE(PG8_SA(0, 0), cA, voffA); PG8_STAGE(PG8_SB(0, 1), cB + hsB, voffB); PG8_STAGE(PG8_SA(0, 1), cA + hsA, voffA);
        if (wr == 1) PG8_BAR;
        PG8_WAIT_V(4); PG8_BAR;
        PG8_STAGE(PG8_SB(1, 0), PG8_BK(cB, cB2, 1), voffB); PG8_STAGE(PG8_SA(1, 0), cA + kstepA, voffA); PG8_STAGE(PG8_SB(1, 1), PG8_BK(cB, cB2, 1) + hsB, voffB);
        PG8_WAIT_V(6); PG8_BAR;
    }
    for (;;) {
        const bool has_next = S.next(ui + 1, nxt);
        if constexpr (GATHER) { if (has_next) PG8_GOFFS(nxt, gN); else { _Pragma("unroll") for (int _h = 0; _h < 2; ++_h) _Pragma("unroll") for (int _i = 0; _i < 2; ++_i) gN[_h][_i] = gC[_h][_i]; } }
        const char* nA = has_next ? nxt.a : cA; const char* nB = has_next ? nxt.b : cB; const char* nB2 = has_next ? nxt.b2 : cB2;
#pragma unroll 1
        for (int t = 0; t < nt; t += 2) {
            const bool last = (t == nt - 2);
            const char* a1 = cA + (size_t)(t + 1) * kstepA;
            const char* a2 = last ? nA : cA + (size_t)(t + 2) * kstepA; const char* b2 = last ? PG8_BK(nB, nB2, 0) : PG8_BK(cB, cB2, t + 2);
            const char* a3 = a2 + kstepA; const char* b3 = last ? PG8_BK(nB, nB2, 1) : PG8_BK(cB, cB2, t + 3);
            if (last && has_next) S.a_ready(nxt);
            if constexpr (SP2) {
            PG8_LDB(B0, 0, 0); PG8_LDB(B1, 0, 1); PG8_SCHED; PG8_LDA(At, 0, 0);
            if constexpr (GATHER) PG8_STAGE_G(PG8_SA(1, 1), (size_t)(t + 1) * kstep, gC, 1); else PG8_STAGE(PG8_SA(1, 1), a1 + hsA, voffA);
            PG8_WAIT_V(8); PG8_WAIT_L(0); PG8_BAR; PG8_MMA(0, 0, At, B0); PG8_MMA(0, 1, At, B1); PG8_BAR; PG8_SCHED;
            PG8_LDA(At, 0, 1); PG8_STAGE(PG8_SB(0, 0), b2, voffB); PG8_STAGE(PG8_SB(0, 1), b2 + hsB, voffB);
            if constexpr (GATHER) { if (last) PG8_STAGE_G(PG8_SA(0, 0), 0, gN, 0); else PG8_STAGE_G(PG8_SA(0, 0), (size_t)(t + 2) * kstep, gC, 0); } else PG8_STAGE(PG8_SA(0, 0), a2, voffA);
            PG8_WAIT_V(8); PG8_WAIT_L(0); PG8_BAR; PG8_MMA(1, 0, At, B0); PG8_MMA(1, 1, At, B1); PG8_BAR; PG8_SCHED;
            PG8_LDB(B0, 1, 0); PG8_LDB(B1, 1, 1); PG8_SCHED; PG8_LDA(At, 1, 0);
            if constexpr (GATHER) { if (last) PG8_STAGE_G(PG8_SA(0, 1), 0, gN, 1); else PG8_STAGE_G(PG8_SA(0, 1), (size_t)(t + 2) * kstep, gC, 1); } else PG8_STAGE(PG8_SA(0, 1), a2 + hsA, voffA);
            PG8_WAIT_V(8); PG8_WAIT_L(0); PG8_BAR; PG8_MMA(0, 0, At, B0); PG8_MMA(0, 1, At, B1); PG8_BAR; PG8_SCHED;
            PG8_LDA(At, 1, 1); PG8_STAGE(PG8_SB(1, 0), b3, voffB); PG8_STAGE(PG8_SB(1, 1), b3 + hsB, voffB);
            if constexpr (GATHER) { if (last) PG8_STAGE_G(PG8_SA(1, 0), kstep, gN, 0); else PG8_STAGE_G(PG8_SA(1, 0), (size_t)(t + 3) * kstep, gC, 0); } else PG8_STAGE(PG8_SA(1, 0), a3, voffA);
            PG8_WAIT_V(8); PG8_WAIT_L(0); PG8_BAR; PG8_MMA(1, 0, At, B0); PG8_MMA(1, 1, At, B1); PG8_BAR; PG8_SCHED;
            } else {
            PG8_LDB(B0, 0, 0); PG8_SCHED; PG8_LDA(At, 0, 0); PG8_STAGE(PG8_SA(1, 1), a1 + hsA, voffA);
            PG8_WAIT_L(8); PG8_BAR; PG8_WAIT_L(0); PG8_MMA(0, 0, At, B0); PG8_BAR; PG8_SCHED;
            PG8_LDB(B1, 0, 1); PG8_STAGE(PG8_SB(0, 0), b2, voffB);
            PG8_BAR; PG8_WAIT_L(0); PG8_MMA(0, 1, At, B1); PG8_BAR;
            PG8_LDA(At, 0, 1); PG8_STAGE(PG8_SA(0, 0), a2, voffA);
            PG8_BAR; PG8_WAIT_L(0); PG8_MMA(1, 0, At, B0); PG8_BAR; PG8_SCHED;
            PG8_STAGE(PG8_SB(0, 1), b2 + hsB, voffB);
            PG8_WAIT_V(6); PG8_BAR; PG8_MMA(1, 1, At, B1); PG8_BAR;
            PG8_LDB(B0, 1, 0); PG8_SCHED; PG8_LDA(At, 1, 0); PG8_STAGE(PG8_SA(0, 1), a2 + hsA, voffA);
            PG8_WAIT_L(8); PG8_BAR; PG8_WAIT_L(0); PG8_MMA(0, 0, At, B0); PG8_BAR; PG8_SCHED;
            PG8_LDB(B1, 1, 1); PG8_STAGE(PG8_SB(1, 0), b3, voffB);
            PG8_BAR; PG8_WAIT_L(0); PG8_MMA(0, 1, At, B1); PG8_BAR;
            PG8_LDA(At, 1, 1); PG8_STAGE(PG8_SA(1, 0), a3, voffA);
            PG8_BAR; PG8_WAIT_L(0); PG8_MMA(1, 0, At, B0); PG8_BAR; PG8_SCHED;
            PG8_STAGE(PG8_SB(1, 1), b3 + hsB, voffB);
            PG8_WAIT_V(6); PG8_BAR; PG8_MMA(1, 1, At, B1); PG8_BAR;
            }
        }
        if constexpr (ALIGN_EPI) { if (wr == 0) PG8_BAR; }
        if constexpr (!Epi::AFTER_DRAIN) { E(acc, cur, wr, wc, fr, fq); S.done(cur); }
        if (!has_next) break;
#pragma unroll
        for (int a = 0; a < 2; ++a)
#pragma unroll
            for (int b = 0; b < 2; ++b)
#pragma unroll
                for (int m = 0; m < 4; ++m)
#pragma unroll
                    for (int n = 0; n < 2; ++n) acc[a][b][m][n] = (f32x4){0.f, 0.f, 0.f, 0.f};
        cur = nxt; cA = nA; cB = nB; cB2 = nB2; ++ui;
        if constexpr (GATHER) { _Pragma("unroll") for (int _h = 0; _h < 2; ++_h) _Pragma("unroll") for (int _i = 0; _i < 2; ++_i) gC[_h][_i] = gN[_h][_i]; }
        if constexpr (ALIGN_EPI) { if (wr == 1) PG8_BAR; }
    }
    PG8_WAIT_V(0);
    if constexpr (!ALIGN_EPI) { if (wr == 0) PG8_BAR; }
    PG8_BAR;
    if constexpr (Epi::AFTER_DRAIN) { E.fused(acc, cur, wr, wc, fr, fq, lds, wid, lane); S.done(cur); }
#undef PG8_BK
#undef PG8_GOFFS
#undef PG8_STAGE_G
#undef PG8_SA
#undef PG8_SB
#undef PG8_STAGE
#undef PG8_LDA
#undef PG8_LDB
#undef PG8_MMA
#undef PG8_WAIT_V
#undef PG8_WAIT_L
#undef PG8_BAR
#undef PG8_SCHED
}
}

struct PlainOrder {
    const char* A; const char* Bt; int lda, ldb, nM, nN, nwg, G, c;
    __device__ __forceinline__ void init(const void* A_, const void* Bt_, int lda_, int ldb_, int M, int N, int G_, int c_) { A = (const char*)A_; Bt = (const char*)Bt_; lda = lda_; ldb = ldb_; nM = M / 256; nN = N / 256; nwg = nM * nN; G = G_; c = c_; }
    __device__ __forceinline__ bool next(int i, pg8::Unit& u) const {
        const long L = (long)i * G + c; if (L >= nwg) return false;
        int wgid = (int)L; { const int q = nwg / 8, r = nwg % 8, xcd = wgid % 8, off = wgid / 8; wgid = (xcd < r ? xcd * (q + 1) : r * (q + 1) + (xcd - r) * q) + off; }
        const int nig = 8 * nN, gid = wgid / nig, fm = gid * 8, gsz = (nM - fm) < 8 ? (nM - fm) : 8;
        u.pm = fm + ((wgid % nig) % gsz); u.pn = (wgid % nig) / gsz;
        u.a = A + (size_t)u.pm * 256 * lda * 2; u.b = Bt + (size_t)u.pn * 256 * ldb * 2; u.b2 = u.b; return true;
    }
    __device__ __forceinline__ void a_ready(const pg8::Unit&) const {}
    __device__ __forceinline__ void done(const pg8::Unit&) const {}
};
struct EpiInProj {
    static constexpr bool PERM = true, AFTER_DRAIN = false;
    unsigned char* ws; const float* b_gate; const float* b_fgt; unsigned* kn;
    __device__ __forceinline__ void operator()(const pg8::f32x4 (&acc)[2][2][4][2], const pg8::Unit& u, int wr, int wc, int fr, int fq) const {
        { int t_ = threadIdx.x; asm volatile("" : "+v"(t_)); fr = t_ & 15; fq = (t_ >> 4) & 3; }
        const int pn = u.pn, b = (u.pm * 256) / T_, t0 = u.pm * 256 - b * T_ + wr * 64 + fr;
        if (pn == 11) {
            if (wc == 0 && fq < 4) {
                float* gate = (float*)(ws + WS_GATE); float* fl = (float*)(ws + WS_FL);
#pragma unroll
                for (int ai = 0; ai < 2; ++ai)
#pragma unroll
                    for (int m = 0; m < 4; ++m) { const int t = t0 + ai * 128 + m * 16; const size_t n = (size_t)b * T_ + t;
#pragma unroll
                        for (int nn = 0; nn < 2; ++nn)
#pragma unroll
                            for (int e = 0; e < 4; ++e) { const int c = 8 * fq + 4 * nn + e; const float v = acc[ai][0][m][nn][e];
                                if (c < 24) gate[n * 24 + c] = __builtin_amdgcn_rcpf(1.f + __builtin_amdgcn_exp2f(-(v + b_gate[c]) * LOG2E));
                                else if (c < 28) { const float z = v + b_fgt[c - 24];
                                    fl[(size_t)(b * 4 + (c - 24)) * T_ + t] = z < -30.f ? z : -0.6931471805599453f * __builtin_amdgcn_logf(1.f + __builtin_amdgcn_exp2f(-z * LOG2E)); } } }
            }
            return;
        }
        if (pn == 6 || pn == 9) {
            const int lane_ = (fq << 4) | fr;
#pragma unroll
            for (int bj = 0; bj < 2; ++bj)
#pragma unroll
                for (int ai = 0; ai < 2; ++ai) { float mx = 0.f;
#pragma unroll
                    for (int m = 0; m < 4; ++m) { const pg8::f32x4 v0 = acc[ai][bj][m][0], v1 = acc[ai][bj][m][1];
                        float ss = (v0[0] * v0[0] + v0[1] * v0[1]) + (v0[2] * v0[2] + v0[3] * v0[3]) + (v1[0] * v1[0] + v1[1] * v1[1]) + (v1[2] * v1[2] + v1[3] * v1[3]);
                        ss += shflx_f(ss, 16, lane_); ss += shflx_f(ss, 32, lane_); mx = fmaxf(mx, ss); }
#pragma unroll
                    for (int o = 1; o < 16; o <<= 1) mx = fmaxf(mx, shflx_f(mx, o, lane_));
                    if (lane_ == 0) { const int cg = bj * 4 + wc, tile = (u.pm * 256 - b * T_ + ai * 128 + wr * 64) >> 6;
                        unsigned* dst = pn == 6 ? kn + ((b * 4 + (cg >> 1)) * 64 + tile) * 2 + (cg & 1) : kn + 4096 + (b * 8 + cg) * 64 + tile;
                        atomicMax(dst, __float_as_uint(mx)); } }
        }
#pragma unroll
        for (int bj = 0; bj < 2; ++bj) {
            const int c = bj * 128 + wc * 32 + 8 * fq;
            bf16* base; int W = 64; float sc = 1.f;
            if (pn < 2) { base = (bf16*)(ws + WS_QN) + (size_t)(b * 8 + pn * 4 + (c >> 6)) * T_ * 64 + (c & 63); sc = 0.125f * LOG2E; }
            else if (pn < 5) { base = (bf16*)(ws + WS_KV6 + (size_t)((pn - 2) * 2 + (c >> 7)) * KV6_STRIDE) + (size_t)(b * 2 + ((c >> 6) & 1)) * T_ * 64 + (c & 63); }
            else if (pn < 8) { base = (bf16*)(ws + WS_FQKV) + (size_t)(pn - 5) * (8 * MiB) + (size_t)(b * 4 + (c >> 6)) * T_ * 64 + (c & 63); if (pn == 5) sc = 0.125f * LOG2E; }
            else if (pn < 10) { base = (bf16*)(ws + WS_DQK) + (size_t)(pn - 8) * (8 * MiB) + (size_t)(b * 8 + (c >> 5)) * T_ * 32 + (c & 31); W = 32; if (pn == 8) sc = 0.17677669529663687f * LOG2E; }
            else { base = (bf16*)(ws + WS_DV) + (size_t)(b * 4 + (c >> 6)) * T_ * 64 + (c & 63); }
            const bool blk = W == 64 && pn != 2;
            if (blk) base += -(c & 63) + ((c >> 5) & 1) * 512 + (c & 31);
#pragma unroll
            for (int ai = 0; ai < 2; ++ai)
#pragma unroll
                for (int m = 0; m < 4; ++m) { const int t = t0 + ai * 128 + m * 16;
                    const pg8::f32x4 v0 = acc[ai][bj][m][0] * sc, v1 = acc[ai][bj][m][1] * sc;
                    pg8::u32x4 w; w.x = pg8::cvt_pk_bf16(v0[0], v0[1]); w.y = pg8::cvt_pk_bf16(v0[2], v0[3]); w.z = pg8::cvt_pk_bf16(v1[0], v1[1]); w.w = pg8::cvt_pk_bf16(v1[2], v1[3]);
                    *(pg8::u32x4*)(base + (blk ? (size_t)((t >> 4) * 1024 + (t & 15) * 32) : (size_t)t * W)) = w; }
        }
    }
};
struct EpiResBf16 {
    static constexpr bool PERM = false, AFTER_DRAIN = false;
    bf16* xr;
    __device__ __forceinline__ void operator()(const pg8::f32x4 (&acc)[2][2][4][2], const pg8::Unit& u, int wr, int wc, int fr, int fq) const {
        { int t_ = threadIdx.x; asm volatile("" : "+v"(t_)); fr = t_ & 15; fq = (t_ >> 4) & 3; }
#pragma unroll
        for (int ai = 0; ai < 2; ++ai)
#pragma unroll
            for (int m = 0; m < 4; ++m) { const size_t off = (size_t)(u.pm * 256 + ai * 128 + wr * 64 + m * 16 + fr) * D_ + u.pn * 256 + wc * 32 + 4 * fq;
#pragma unroll
                for (int bj = 0; bj < 2; ++bj)
#pragma unroll
                    for (int n = 0; n < 2; ++n) { const u64 w = *(const u64*)(xr + off + bj * 128 + n * 16);
                        const pg8::f32x4 bs = {__uint_as_float((unsigned)w << 16), __uint_as_float((unsigned)w & 0xffff0000u), __uint_as_float((unsigned)(w >> 32) << 16), __uint_as_float((unsigned)(w >> 32) & 0xffff0000u)};
                        const pg8::f32x4 o = bs + acc[ai][bj][m][n];
                        *(u64*)(xr + off + bj * 128 + n * 16) = (u64)pg8::cvt_pk_bf16(o[0], o[1]) | ((u64)pg8::cvt_pk_bf16(o[2], o[3]) << 32); } }
    }
};


struct EpiDummy {
    static constexpr bool PERM = true, AFTER_DRAIN = false;
    float* dst;
    __device__ __forceinline__ void operator()(const pg8::f32x4 (&acc)[2][2][4][2], const pg8::Unit& u, int wr, int wc, int fr, int fq) const {
        pg8::f32x4 a = {0.f, 0.f, 0.f, 0.f};
#pragma unroll
        for (int ai = 0; ai < 2; ++ai)
#pragma unroll
            for (int bj = 0; bj < 2; ++bj)
#pragma unroll
                for (int m = 0; m < 4; ++m) { a = a + acc[ai][bj][m][0]; a = a + acc[ai][bj][m][1]; }
        *(pg8::f32x4*)(dst + ((size_t)(u.pm * 12 + u.pn) * 512 + threadIdx.x) * 4) = a;
    }
};
struct OneUnitOrder { pg8::Unit u; bool has;
    __device__ __forceinline__ bool next(int i, pg8::Unit& o) const { if (i != 0 || !has) return false; o = u; return true; }
    __device__ __forceinline__ void a_ready(const pg8::Unit&) const {}
    __device__ __forceinline__ void done(const pg8::Unit&) const {} };
__device__ __forceinline__ float gelu_tanh_fast(float x) { const float u2 = 1.5957691216057308f * (x + 0.044715f * x * x * x); return x * __builtin_amdgcn_rcpf(1.f + __builtin_amdgcn_exp2f(-u2 * LOG2E)); }
struct EpiCmpH {
    static constexpr bool PERM = true, AFTER_DRAIN = false;
    bf16* hc; const float* bias1;
    __device__ __forceinline__ void operator()(const pg8::f32x4 (&acc)[2][2][4][2], const pg8::Unit& u, int wr, int wc, int fr, int fq) const {
        { int t_ = threadIdx.x; asm volatile("" : "+v"(t_)); fr = t_ & 15; fq = (t_ >> 4) & 3; }
        const int kv = u.pn;
#pragma unroll
        for (int bj = 0; bj < 2; ++bj) { const int col = bj * 128 + wc * 32 + 8 * fq;
            const pg8::f32x4 b0 = *(const pg8::f32x4*)(bias1 + kv * 256 + col), b1 = *(const pg8::f32x4*)(bias1 + kv * 256 + col + 4);
#pragma unroll
            for (int ai = 0; ai < 2; ++ai)
#pragma unroll
                for (int m = 0; m < 4; ++m) { const int row = u.pm * 256 + ai * 128 + wr * 64 + m * 16 + fr;
                    const pg8::f32x4 v0 = acc[ai][bj][m][0] + b0, v1 = acc[ai][bj][m][1] + b1;
                    pg8::u32x4 w; w.x = pg8::cvt_pk_bf16(gelu_tanh_fast(v0[0]), gelu_tanh_fast(v0[1])); w.y = pg8::cvt_pk_bf16(gelu_tanh_fast(v0[2]), gelu_tanh_fast(v0[3]));
                    w.z = pg8::cvt_pk_bf16(gelu_tanh_fast(v1[0]), gelu_tanh_fast(v1[1])); w.w = pg8::cvt_pk_bf16(gelu_tanh_fast(v1[2]), gelu_tanh_fast(v1[3]));
                    *(pg8::u32x4*)(hc + ((size_t)kv * 4096 + row) * 256 + col) = w; } }
    }
};
struct EpiCmpOut {
    static constexpr bool PERM = true, AFTER_DRAIN = false;
    bf16* kvcmp;
    __device__ __forceinline__ void operator()(const pg8::f32x4 (&acc)[2][2][4][2], const pg8::Unit& u, int wr, int wc, int fr, int fq) const {
        { int t_ = threadIdx.x; asm volatile("" : "+v"(t_)); fr = t_ & 15; fq = (t_ >> 4) & 3; }
        if (wc >= 2) return;
        const int kv = u.pn, col = wc * 32 + 8 * fq;
#pragma unroll
        for (int ai = 0; ai < 2; ++ai)
#pragma unroll
            for (int m = 0; m < 4; ++m) { const int row = u.pm * 256 + ai * 128 + wr * 64 + m * 16 + fr; const float z = ((row & 255) == 255) ? 0.f : 1.f;
                const pg8::f32x4 v0 = acc[ai][0][m][0], v1 = acc[ai][0][m][1];
                pg8::u32x4 w; w.x = pg8::cvt_pk_bf16(z != 0.f ? v0[0] : 0.f, z != 0.f ? v0[1] : 0.f); w.y = pg8::cvt_pk_bf16(z != 0.f ? v0[2] : 0.f, z != 0.f ? v0[3] : 0.f);
                w.z = pg8::cvt_pk_bf16(z != 0.f ? v1[0] : 0.f, z != 0.f ? v1[1] : 0.f); w.w = pg8::cvt_pk_bf16(z != 0.f ? v1[2] : 0.f, z != 0.f ? v1[3] : 0.f);
                *(pg8::u32x4*)(kvcmp + ((size_t)kv * 4096 + row) * 64 + col) = w; }
    }
};

__device__ __forceinline__ void moe_build_tables(const unsigned* cnt, int tid) {
    LAS int* T = (LAS int*)((LAS unsigned char*)lds_raw + TBL_OFF);
    __syncthreads();
    if (tid < 112) T[384 + tid] = (int)cnt[tid * MOE_CS];
    __syncthreads();
    if (tid == 0) { int o = 0; for (int c = 0; c < 112; ++c) { T[c] = o; const int n = (T[384 + c] + 255) >> 8; for (int k = 0; k < n; ++k) T[128 + o + k] = c; o += n; } T[112] = o; }
    __syncthreads();
}
__device__ __forceinline__ void moe_pair(int cls, int& ea, int& eb) { const int grp = cls / 28; int idx = cls % 28, lo = 0; while (idx >= 7 - lo) { idx -= 7 - lo; ++lo; } ea = grp * 8 + lo; eb = grp * 8 + lo + 1 + idx; }
struct MoeOrder1 {
    const char* wsb; const unsigned* rec; const char* wgu; int G, c;
    __device__ __forceinline__ bool next(int i, pg8::Unit& u) const {
        const LAS int* T = (const LAS int*)((LAS unsigned char*)lds_raw + TBL_OFF);
        const int idx = i * G + c; if (idx >= 4 * T[112]) return false;
        const int tile = idx >> 2, pn = idx & 3; int ea, eb; moe_pair(T[128 + tile], ea, eb); const int e = (pn >> 1) ? eb : ea;
        u.pm = tile; u.pn = pn; u.a = wsb; u.b = wgu + ((size_t)e * 512 + (pn & 1) * 256) * 2048; u.b2 = u.b; return true; }
    __device__ __forceinline__ const char* abase() const { return wsb; }
    __device__ __forceinline__ unsigned arow(const pg8::Unit& u, int r) const {
        const LAS int* T = (const LAS int*)((LAS unsigned char*)lds_raw + TBL_OFF);
        const int cls = T[128 + u.pm], vr = (u.pm - T[cls]) * 256 + r;
        unsigned off = ZROW_OFF;
        if (vr < T[384 + cls]) off = (unsigned)WS_HN + rec[((size_t)cls * 32768 + vr) * 4] * 2048u;
        return off; }
    __device__ __forceinline__ void a_ready(const pg8::Unit&) const {}
    __device__ __forceinline__ void done(const pg8::Unit&) const {} };
struct MoeOrder2 {
    const char* hb; const char* wd; int G, c;
    __device__ __forceinline__ bool next(int i, pg8::Unit& u) const {
        const LAS int* T = (const LAS int*)((LAS unsigned char*)lds_raw + TBL_OFF);
        const int idx = i * G + c; if (idx >= 4 * T[112]) return false;
        const int tile = idx >> 2, pn = idx & 3; int ea, eb; moe_pair(T[128 + tile], ea, eb);
        u.pm = tile; u.pn = pn; u.a = hb + (size_t)tile * 256 * 1024; u.b = wd + ((size_t)ea * 1024 + pn * 256) * 512; u.b2 = wd + ((size_t)eb * 1024 + pn * 256) * 512; return true; }
    __device__ __forceinline__ void a_ready(const pg8::Unit&) const {}
    __device__ __forceinline__ void done(const pg8::Unit&) const {} };
struct EpiMoeH {
    static constexpr bool PERM = true, AFTER_DRAIN = false;
    bf16* hb; const u32x4* rec;
    __device__ __forceinline__ void operator()(const pg8::f32x4 (&acc)[2][2][4][2], const pg8::Unit& u, int wr, int wc, int fr, int fq) const {
        { int t_ = threadIdx.x; asm volatile("" : "+v"(t_)); fr = t_ & 15; fq = (t_ >> 4) & 3; }
        const int slot = u.pn >> 1;
        const LAS int* T = (const LAS int*)((LAS unsigned char*)lds_raw + TBL_OFF);
        const int cls = T[128 + u.pm], vr0 = (u.pm - T[cls]) * 256, ncls = T[384 + cls];
#pragma unroll
        for (int ai = 0; ai < 2; ++ai)
#pragma unroll
            for (int m = 0; m < 4; ++m) { const int rr = ai * 128 + wr * 64 + m * 16 + fr; const size_t row = (size_t)u.pm * 256 + rr; float w = 0.f, rs = 0.f;
                if (vr0 + rr < ncls) { const u32x4 q = rec[(size_t)cls * 32768 + vr0 + rr]; w = __uint_as_float(slot ? q.z : q.y); rs = __uint_as_float(q.w); }
#pragma unroll
                for (int bj = 0; bj < 2; ++bj) { const int j0 = (u.pn & 1) * 128 + (bj * 128 + wc * 32 + 8 * fq) / 2;
                    pg8::f32x4 v0 = acc[ai][bj][m][0], v1 = acc[ai][bj][m][1];
#pragma unroll
                    for (int e = 0; e < 4; ++e) { v0[e] *= rs; v1[e] *= rs; }
                    const float h0 = v0[0] * __builtin_amdgcn_rcpf(1.f + __builtin_amdgcn_exp2f(-v0[0] * LOG2E)) * v0[1] * w, h1 = v0[2] * __builtin_amdgcn_rcpf(1.f + __builtin_amdgcn_exp2f(-v0[2] * LOG2E)) * v0[3] * w;
                    const float h2 = v1[0] * __builtin_amdgcn_rcpf(1.f + __builtin_amdgcn_exp2f(-v1[0] * LOG2E)) * v1[1] * w, h3 = v1[2] * __builtin_amdgcn_rcpf(1.f + __builtin_amdgcn_exp2f(-v1[2] * LOG2E)) * v1[3] * w;
                    const int jg = slot * 256 + j0;
                    *(u64*)(hb + ((row >> 4) * 32 + (jg >> 4)) * 256 + (row & 15) * 16 + (jg & 15)) = (u64)pg8::cvt_pk_bf16(h0, h1) | ((u64)pg8::cvt_pk_bf16(h2, h3) << 32); } }
    }
};
struct EpiMoeOut {
    static constexpr bool PERM = false, AFTER_DRAIN = false;
    bf16* x; const unsigned* rec;
    __device__ __forceinline__ void operator()(const pg8::f32x4 (&acc)[2][2][4][2], const pg8::Unit& u, int wr, int wc, int fr, int fq) const {
        { int t_ = threadIdx.x; asm volatile("" : "+v"(t_)); fr = t_ & 15; fq = (t_ >> 4) & 3; }
        bf16* xx = x; const unsigned* rt = rec; asm volatile("" : "+s"(xx), "+s"(rt));
        const LAS int* T = (const LAS int*)((LAS unsigned char*)lds_raw + TBL_OFF);
        const int cls = T[128 + u.pm], vr0 = (u.pm - T[cls]) * 256, ncls = T[384 + cls];
#pragma unroll
        for (int ai = 0; ai < 2; ++ai)
#pragma unroll
            for (int m = 0; m < 4; ++m) { const int rr = ai * 128 + wr * 64 + m * 16 + fr; int tok = -1; if (vr0 + rr < ncls) tok = (int)rt[((size_t)cls * 32768 + vr0 + rr) * 4];
                if (tok >= 0) { bf16* xr = xx + (size_t)tok * D_ + u.pn * 256 + wc * 32 + 4 * fq;
#pragma unroll
                    for (int bj = 0; bj < 2; ++bj)
#pragma unroll
                        for (int n = 0; n < 2; ++n) { u64* q = (u64*)(xr + bj * 128 + n * 16); const u64 w = *q; const pg8::f32x4 a = acc[ai][bj][m][n];
                            *q = (u64)pg8::cvt_pk_bf16(__uint_as_float((unsigned)w << 16) + a[0], __uint_as_float((unsigned)w & 0xffff0000u) + a[1]) | ((u64)pg8::cvt_pk_bf16(__uint_as_float((unsigned)(w >> 32) << 16) + a[2], __uint_as_float((unsigned)(w >> 32) & 0xffff0000u) + a[3]) << 32); } } }
    }
};

__device__ __forceinline__ void transpose_item(const float* W, int ldw, bf16* WT, int ldt, int r0, int rmul, int k0, LAS float* scr, int lane, const float* gk = nullptr) {
    f32x4 v[8];
#pragma unroll
    for (int i = 0; i < 8; ++i) v[i] = *(const f32x4*)(W + (size_t)(k0 + i * 8 + (lane >> 3)) * ldw + (lane & 7) * 4);
    if (gk) {
#pragma unroll
        for (int i = 0; i < 8; ++i) { const float gsc = gk[k0 + i * 8 + (lane >> 3)]; v[i].x *= gsc; v[i].y *= gsc; v[i].z *= gsc; v[i].w *= gsc; } }
#pragma unroll
    for (int i = 0; i < 8; ++i) { LAS float* d = scr + (i * 8 + (lane >> 3)) * 33 + (lane & 7) * 4; d[0] = v[i].x; d[1] = v[i].y; d[2] = v[i].z; d[3] = v[i].w; }
    asm volatile("s_waitcnt lgkmcnt(0)" ::: "memory");
    const int c = lane & 7;
#pragma unroll
    for (int j = 0; j < 4; ++j) { const int n = (lane >> 3) + 8 * j; const LAS float* sp = scr + (8 * c) * 33 + n;
        u32x4 o; o.x = pk2(sp[0 * 33], sp[1 * 33]); o.y = pk2(sp[2 * 33], sp[3 * 33]); o.z = pk2(sp[4 * 33], sp[5 * 33]); o.w = pk2(sp[6 * 33], sp[7 * 33]);
        *(u32x4*)(WT + (size_t)(r0 + rmul * n) * ldt + k0 + 8 * c) = o; }
    asm volatile("s_waitcnt lgkmcnt(0)" ::: "memory");
}
__device__ __forceinline__ void transpose_seg(const float* W, int ldw, int K, int sc0, int ncol, bf16* WT, int r0, int rmul, int item, LAS float* scr, int lane, const float* gk = nullptr) {
    const int nb = ncol / 32, kb = item / nb, cb = item % nb;
    transpose_item(W + sc0 + cb * 32, ldw, WT, K, r0 + rmul * cb * 32, rmul, kb * 64, scr, lane, gk);
}

typedef float f32x16 __attribute__((ext_vector_type(16)));
typedef short bf16x8v __attribute__((ext_vector_type(8)));
typedef short s16x4 __attribute__((ext_vector_type(4)));
typedef float f32x2_t __attribute__((ext_vector_type(2)));
typedef __bf16 bf16x2_t __attribute__((ext_vector_type(2)));
constexpr int A_KBUF = 10240, A_VBUF = 12288;
constexpr int A_KOFF = 0, A_VOFF = 2 * A_KBUF, A_BOFF = A_VOFF + 2 * A_VBUF, A_LDS_END = A_BOFF + 2 * 256;
__device__ __forceinline__ constexpr int crow0(int reg) { return (reg & 3) + 8 * (reg >> 2); }
__device__ __forceinline__ float swap_max(float m) { auto rr = __builtin_amdgcn_permlane32_swap(__float_as_uint(m), __float_as_uint(m), false, false); return fmaxf(__uint_as_float(rr[0]), __uint_as_float(rr[1])); }
__device__ __forceinline__ float swap_sum(float m) { auto rr = __builtin_amdgcn_permlane32_swap(__float_as_uint(m), __float_as_uint(m), false, false); return __uint_as_float(rr[0]) + __uint_as_float(rr[1]); }
__device__ __forceinline__ unsigned cvtpk(float lo, float hi) { f32x2_t v = {lo, hi}; bf16x2_t b = __builtin_convertvector(v, bf16x2_t); return __builtin_bit_cast(unsigned, b); }
__device__ __forceinline__ bf16x8v pack8(const f32x16& p, int b0) { u32x4 w; w.x = cvtpk(p[b0 + 0], p[b0 + 1]); w.y = cvtpk(p[b0 + 2], p[b0 + 3]); w.z = cvtpk(p[b0 + 4], p[b0 + 5]); w.w = cvtpk(p[b0 + 6], p[b0 + 7]); return __builtin_bit_cast(bf16x8v, w); }
__device__ __forceinline__ s16x4 tr_read(const LAS unsigned char* p) { typedef short v4i16_t __attribute__((ext_vector_type(4))); return __builtin_bit_cast(s16x4, __builtin_amdgcn_ds_read_tr16_b64_v4i16((LAS v4i16_t*)p)); }

template <int DQK, int NMAP, bool FOX, bool SLC>
__device__ __forceinline__ void attn_core(LAS unsigned char* L, const bf16* Kb0, const bf16* Kb1, const bf16* Vb, const LAS float* cum, float cum_ref,
                                          const bf16x8v (&Qf)[NMAP][DQK / 16], u64 tilemask, int t_lane, int tw0, int win, float slope2, unsigned selw0, unsigned selw1,
                                          f32x16 (&O)[NMAP][2], float (&M)[NMAP], float (&Ls)[NMAP], int tid, bool started0 = false) {
    constexpr int KP = DQK * 2 + 16, VP = 192;
    const int lane = tid & 63, r = lane & 31, h = lane >> 5;
    int kdst; const bf16* ksrc;
    if (DQK == 64) { kdst = (tid >> 3) * KP + (tid & 7) * 16; ksrc = Kb0 + b64_off(tid >> 3, (tid & 7) * 8); }
    else { const int mp = tid >> 8, tt = tid & 255; kdst = mp * 5120 + (tt >> 2) * KP + (tt & 3) * 16; ksrc = (mp ? Kb1 : Kb0) + (tt >> 2) * 32 + (tt & 3) * 8; }
    const int vdst = (tid >> 3) * VP + (tid & 7) * 16; const bf16* vsrc = Vb + b64_off(tid >> 3, (tid & 7) * 8);
    const LAS unsigned char* kfrag = L + A_KOFF + r * KP + h * 16;
    const LAS unsigned char* vfrag = L + A_VOFF + (4 * h + ((lane & 15) >> 2)) * VP + (16 * ((lane >> 4) & 1) + 4 * (lane & 3)) * 2;
    u32x4 kreg, vreg; float breg = 0.f;
    u64 mk = tilemask;
    int j = 63 - __builtin_clzll(mk); mk &= ~(1ull << j);
    { const int kv0 = j * 64; kreg = *(const u32x4*)(ksrc + (size_t)kv0 * DQK); vreg = *(const u32x4*)(vsrc + (size_t)kv0 * 64); if (FOX && tid < 64) breg = (cum_ref - cum[kv0 + tid]) * LOG2E; }
    *(LAS u32x4*)(L + A_KOFF + kdst) = kreg; *(LAS u32x4*)(L + A_VOFF + vdst) = vreg; if (FOX && tid < 64) *(LAS float*)(L + A_BOFF + tid * 4) = breg;
    __syncthreads();
    int buf = 0; bool started = started0;
    float pdummy = 0.f; int idummy = 0; f32x16 dm0; for (int i = 0; i < 16; ++i) dm0[i] = 0.f;
    for (;;) {
        const bool more = mk != 0ull; int jn = 0;
        if (more) { jn = 63 - __builtin_clzll(mk); mk &= ~(1ull << jn); const int kv0 = jn * 64;
            kreg = *(const u32x4*)(ksrc + (size_t)kv0 * DQK); vreg = *(const u32x4*)(vsrc + (size_t)kv0 * 64); if (FOX && tid < 64) breg = (cum_ref - cum[kv0 + tid]) * LOG2E; }
        { const int kv0 = j * 64;
          bool wave_has = true; float selb = 0.f;
          if (SLC) { const bool mine = ((j < 32 ? (selw0 >> j) : (selw1 >> (j - 32))) & 1u) != 0u; selb = mine ? 0.f : -INFINITY; wave_has = __any(mine); }
          if (wave_has && !(kv0 > tw0 + 31) && !(tw0 - (kv0 + 63) >= win)) {
            const bool need_mask = (kv0 + 63 > tw0) || (tw0 + 31 - kv0 >= win);
            const int dl = t_lane - kv0 - 4 * h;
            bf16x8v pa[NMAP][4];
#pragma unroll
            for (int mp = 0; mp < NMAP; ++mp) {
                f32x16 p0, p1;
                if (FOX) { const LAS f32x4* bl = (const LAS f32x4*)(L + A_BOFF + buf * 256) + h; const float mm = M[mp];
#pragma unroll
                    for (int g4 = 0; g4 < 4; ++g4) { const f32x4 b0 = bl[2 * g4], b1 = bl[8 + 2 * g4];
                        p0[4 * g4 + 0] = b0.x - mm; p0[4 * g4 + 1] = b0.y - mm; p0[4 * g4 + 2] = b0.z - mm; p0[4 * g4 + 3] = b0.w - mm; p1[4 * g4 + 0] = b1.x - mm; p1[4 * g4 + 1] = b1.y - mm; p1[4 * g4 + 2] = b1.z - mm; p1[4 * g4 + 3] = b1.w - mm; } }
                else { const float base_l = (slope2 * (float)(kv0 + 4 * h - tw0) - M[mp]) + selb, s8 = slope2 * 8.f, s32 = slope2 * 32.f;
                    p0[0] = base_l; p0[1] = p0[0] + slope2; p0[2] = p0[1] + slope2; p0[3] = p0[2] + slope2;
#pragma unroll
                    for (int reg = 4; reg < 16; ++reg) p0[reg] = p0[reg - 4] + s8;
#pragma unroll
                    for (int reg = 0; reg < 16; ++reg) p1[reg] = p0[reg] + s32; }
                const LAS unsigned char* kb = kfrag + buf * A_KBUF + (DQK == 32 ? mp * 5120 : 0);
#pragma unroll
                for (int s = 0; s < DQK / 16; ++s) { const bf16x8v kf0 = *(const LAS bf16x8v*)(kb + s * 32), kf1 = *(const LAS bf16x8v*)(kb + 32 * KP + s * 32);
#ifdef PROBE_X_LDSK
                    { const bf16x8v z0 = *(const volatile LAS bf16x8v*)(kb + s * 32), z1 = *(const volatile LAS bf16x8v*)(kb + 32 * KP + s * 32); idummy ^= z0[0] ^ z1[1]; }
#endif
#ifdef PROBE_X_MFMA
                    dm0 = __builtin_amdgcn_mfma_f32_32x32x16_bf16(kf0, Qf[mp][s], dm0, 0, 0, 0); dm0 = __builtin_amdgcn_mfma_f32_32x32x16_bf16(kf1, Qf[mp][s], dm0, 0, 0, 0);
#endif
                    p0 = __builtin_amdgcn_mfma_f32_32x32x16_bf16(kf0, Qf[mp][s], p0, 0, 0, 0); p1 = __builtin_amdgcn_mfma_f32_32x32x16_bf16(kf1, Qf[mp][s], p1, 0, 0, 0); }
                if (need_mask) {
#pragma unroll
                    for (int reg = 0; reg < 16; ++reg) { const int d0 = dl - crow0(reg), d1 = d0 - 32;
                        p0[reg] = (d0 >= 0 && d0 < win) ? p0[reg] : -INFINITY; p1[reg] = (d1 >= 0 && d1 < win) ? p1[reg] : -INFINITY; } }
                float mt = fmaxf(fmaxf(p0[0], p1[0]), fmaxf(p0[1], p1[1]));
#pragma unroll
                for (int reg = 2; reg < 16; reg += 2) mt = fmaxf(fmaxf(mt, fmaxf(fmaxf(p0[reg], p1[reg]), p0[reg + 1])), p1[reg + 1]);
                mt = swap_max(mt);
                if (!started || __any(mt > 8.f)) {
                    const float d = (mt > -1e30f) ? (started ? fmaxf(mt, 0.f) : mt) : 0.f, alpha = __builtin_amdgcn_exp2f(-d);
                    O[mp][0] *= alpha; O[mp][1] *= alpha; Ls[mp] *= alpha; M[mp] += d;
#pragma unroll
                    for (int reg = 0; reg < 16; ++reg) { p0[reg] -= d; p1[reg] -= d; } }
                float rs = 0.f;
#ifdef PROBE_X_EXP
#pragma unroll
                for (int reg = 0; reg < 16; ++reg) { pdummy += __builtin_amdgcn_exp2f(p0[reg] - 1.f) + __builtin_amdgcn_exp2f(p1[reg] - 1.f); }
#endif
#pragma unroll
                for (int reg = 0; reg < 16; ++reg) { p0[reg] = __builtin_amdgcn_exp2f(p0[reg]); p1[reg] = __builtin_amdgcn_exp2f(p1[reg]); rs += p0[reg] + p1[reg]; }
                Ls[mp] += rs;
                pa[mp][0] = pack8(p0, 0); pa[mp][1] = pack8(p0, 8); pa[mp][2] = pack8(p1, 0); pa[mp][3] = pack8(p1, 8);
            }
            started = true;
            const LAS unsigned char* vb = vfrag + buf * A_VBUF;
#pragma unroll
            for (int db = 0; db < 2; ++db)
#pragma unroll
                for (int ks = 0; ks < 4; ++ks) { const s16x4 lo = tr_read(vb + ks * (16 * VP) + db * 64), hi = tr_read(vb + ks * (16 * VP) + db * 64 + 8 * VP);
                    const bf16x8v vf = {lo[0], lo[1], lo[2], lo[3], hi[0], hi[1], hi[2], hi[3]};
#pragma unroll
                    for (int mp = 0; mp < NMAP; ++mp) O[mp][db] = __builtin_amdgcn_mfma_f32_32x32x16_bf16(vf, pa[mp][ks], O[mp][db], 0, 0, 0); }
          } }
        if (more) { *(LAS u32x4*)(L + A_KOFF + (buf ^ 1) * A_KBUF + kdst) = kreg; *(LAS u32x4*)(L + A_VOFF + (buf ^ 1) * A_VBUF + vdst) = vreg; if (FOX && tid < 64) *(LAS float*)(L + A_BOFF + (buf ^ 1) * 256 + tid * 4) = breg; }
#ifdef PROBE_X_BAR
        __syncthreads();
#endif
        __syncthreads();
        if (!more) break;
        j = jn; buf ^= 1;
    }
    if (pdummy == 123.456f || idummy == 0x7fffabcd || dm0[3] == 98765.4321f) Ls[0] += 1e-30f;
}
#ifndef AC2_MODE
#define AC2_MODE 0
#endif
#ifndef AC2_INIT_VALU
#define AC2_INIT_VALU 24
#endif
template <bool FOX, bool SLC>
__device__ __forceinline__ void attn_core2(LAS unsigned char* L, const bf16* Kb0, const bf16* Vb, const LAS float* cum, float cum_ref,
                                           const bf16x8v (&Qf)[4], u64 tilemask, int t_lane, int tw0, int win, float slope2, unsigned selw0, unsigned selw1,
                                           f32x16 (&O)[2], float& M, float& Ls, int tid) {
    constexpr int KP = 144, VP = 192;
    const int lane = tid & 63, r = lane & 31, h = lane >> 5;
    const int kdst = (tid >> 3) * KP + (tid & 7) * 16; const bf16* ksrc = Kb0 + b64_off(tid >> 3, (tid & 7) * 8);
    const int vdst = (tid >> 3) * VP + (tid & 7) * 16; const bf16* vsrc = Vb + b64_off(tid >> 3, (tid & 7) * 8);
    const LAS unsigned char* kfrag = L + A_KOFF + r * KP + h * 16;
    const LAS unsigned char* vfrag = L + A_VOFF + (4 * h + ((lane & 15) >> 2)) * VP + (16 * ((lane >> 4) & 1) + 4 * (lane & 3)) * 2;
#define AC2_ACTIVE(jj) (!((jj) * 64 > tw0 + 31) && !(tw0 - ((jj) * 64 + 63) >= win))
#define AC2_INIT(jj, kslot, q0, q1) do { const int kv0_ = (jj) * 64; \
        if (FOX) { const LAS f32x4* bl = (const LAS f32x4*)(L + A_BOFF + (kslot) * 256) + h; const float mm = M; \
            _Pragma("unroll") for (int g4 = 0; g4 < 4; ++g4) { const f32x4 b0 = bl[2 * g4], b1 = bl[8 + 2 * g4]; \
                q0[4 * g4 + 0] = b0.x - mm; q0[4 * g4 + 1] = b0.y - mm; q0[4 * g4 + 2] = b0.z - mm; q0[4 * g4 + 3] = b0.w - mm; q1[4 * g4 + 0] = b1.x - mm; q1[4 * g4 + 1] = b1.y - mm; q1[4 * g4 + 2] = b1.z - mm; q1[4 * g4 + 3] = b1.w - mm; } } \
        else { float selb = 0.f; if (SLC) selb = ((((jj) < 32) ? (selw0 >> (jj)) : (selw1 >> ((jj) - 32))) & 1u) ? 0.f : -INFINITY; \
            const float base_l = (slope2 * (float)(kv0_ + 4 * h - tw0) - M) + selb, s8 = slope2 * 8.f, s32 = slope2 * 32.f; \
            q0[0] = base_l; q0[1] = q0[0] + slope2; q0[2] = q0[1] + slope2; q0[3] = q0[2] + slope2; \
            _Pragma("unroll") for (int reg = 4; reg < 16; ++reg) q0[reg] = q0[reg - 4] + s8; \
            _Pragma("unroll") for (int reg = 0; reg < 16; ++reg) q1[reg] = q0[reg] + s32; } } while (0)
#define AC2_QK(jj, kslot) do { AC2_INIT(jj, kslot, p0, p1); \
        const LAS unsigned char* kb_ = kfrag + (kslot) * A_KBUF; \
        _Pragma("unroll") for (int s_ = 0; s_ < 4; ++s_) { const bf16x8v kf0 = *(const LAS bf16x8v*)(kb_ + s_ * 32), kf1 = *(const LAS bf16x8v*)(kb_ + 32 * KP + s_ * 32); \
            p0 = __builtin_amdgcn_mfma_f32_32x32x16_bf16(kf0, Qf[s_], p0, 0, 0, 0); p1 = __builtin_amdgcn_mfma_f32_32x32x16_bf16(kf1, Qf[s_], p1, 0, 0, 0); } } while (0)
    u32x4 kreg, vreg; float breg = 0.f;
    u64 mk = tilemask;
    int j = 63 - __builtin_clzll(mk); mk &= ~(1ull << j);
    int jn = -1; if (mk) { jn = 63 - __builtin_clzll(mk); mk &= ~(1ull << jn); }
    { kreg = *(const u32x4*)(ksrc + (size_t)j * 64 * 64); vreg = *(const u32x4*)(vsrc + (size_t)j * 64 * 64); if (FOX && tid < 64) breg = (cum_ref - cum[j * 64 + tid]) * LOG2E;
      *(LAS u32x4*)(L + A_KOFF + kdst) = kreg; *(LAS u32x4*)(L + A_VOFF + vdst) = vreg; if (FOX && tid < 64) *(LAS float*)(L + A_BOFF + tid * 4) = breg;
      if (jn >= 0) { kreg = *(const u32x4*)(ksrc + (size_t)jn * 64 * 64); if (FOX && tid < 64) breg = (cum_ref - cum[jn * 64 + tid]) * LOG2E;
          *(LAS u32x4*)(L + A_KOFF + A_KBUF + kdst) = kreg; if (FOX && tid < 64) *(LAS float*)(L + A_BOFF + 256 + tid * 4) = breg; } }
    __syncthreads();
    f32x16 p0, p1;
    bool started = false;
    int ks = 0, vs = 0;
    if (AC2_ACTIVE(j)) AC2_QK(j, 0);
    for (;;) {
        int jnn = -1; if (mk) { jnn = 63 - __builtin_clzll(mk); mk &= ~(1ull << jnn); }
        if (jnn >= 0) { kreg = *(const u32x4*)(ksrc + (size_t)jnn * 64 * 64); if (FOX && tid < 64) breg = (cum_ref - cum[jnn * 64 + tid]) * LOG2E; }
        if (jn >= 0) vreg = *(const u32x4*)(vsrc + (size_t)jn * 64 * 64);
        const bool act = AC2_ACTIVE(j), actn = jn >= 0 && AC2_ACTIVE(jn);
        if (act) {
            const int kv0 = j * 64;
            if ((kv0 + 63 > tw0) || (tw0 + 31 - kv0 >= win)) { const int dl = t_lane - kv0 - 4 * h;
#pragma unroll
                for (int reg = 0; reg < 16; ++reg) { const int d0 = dl - crow0(reg), d1 = d0 - 32;
                    p0[reg] = (d0 >= 0 && d0 < win) ? p0[reg] : -INFINITY; p1[reg] = (d1 >= 0 && d1 < win) ? p1[reg] : -INFINITY; } }
            float mt = fmaxf(fmaxf(p0[0], p1[0]), fmaxf(p0[1], p1[1]));
#pragma unroll
            for (int reg = 2; reg < 16; reg += 2) mt = fmaxf(fmaxf(mt, fmaxf(fmaxf(p0[reg], p1[reg]), p0[reg + 1])), p1[reg + 1]);
            mt = swap_max(mt);
            if (!started || __any(mt > 8.f)) {
                const float d = (mt > -1e30f) ? (started ? fmaxf(mt, 0.f) : mt) : 0.f, alpha = __builtin_amdgcn_exp2f(-d);
                O[0] *= alpha; O[1] *= alpha; Ls *= alpha; M += d;
#pragma unroll
                for (int reg = 0; reg < 16; ++reg) { p0[reg] -= d; p1[reg] -= d; } }
            started = true;
#if AC2_MODE == 1
            {
                const int jq = jn >= 0 ? jn : 0;
                float rs = 0.f;
#pragma unroll
                for (int reg = 0; reg < 16; ++reg) { p0[reg] = __builtin_amdgcn_exp2f(p0[reg]); p1[reg] = __builtin_amdgcn_exp2f(p1[reg]); rs += p0[reg] + p1[reg]; }
                Ls += rs;
                const bf16x8v pa0 = pack8(p0, 0), pa1 = pack8(p0, 8), pa2 = pack8(p1, 0), pa3 = pack8(p1, 8);
                AC2_QK(jq, ks ^ 1);
                const LAS unsigned char* vb = vfrag + vs * A_VBUF;
#pragma unroll
                for (int db = 0; db < 2; ++db)
#pragma unroll
                    for (int kq = 0; kq < 4; ++kq) { const s16x4 lo = tr_read(vb + kq * (16 * VP) + db * 64), hi = tr_read(vb + kq * (16 * VP) + db * 64 + 8 * VP);
                        const bf16x8v vf = {lo[0], lo[1], lo[2], lo[3], hi[0], hi[1], hi[2], hi[3]};
                        O[db] = __builtin_amdgcn_mfma_f32_32x32x16_bf16(vf, kq == 0 ? pa0 : kq == 1 ? pa1 : kq == 2 ? pa2 : pa3, O[db], 0, 0, 0); }
            }
#else
            {
                const int jq = jn >= 0 ? jn : 0;
                f32x16 n0, n1;
                AC2_INIT(jq, ks ^ 1, n0, n1);
                const LAS unsigned char* kb_ = kfrag + (ks ^ 1) * A_KBUF;
                bf16x8v kf[8];
#pragma unroll
                for (int s_ = 0; s_ < 4; ++s_) { kf[2 * s_] = *(const LAS bf16x8v*)(kb_ + s_ * 32); kf[2 * s_ + 1] = *(const LAS bf16x8v*)(kb_ + 32 * KP + s_ * 32); }
                const LAS unsigned char* vb = vfrag + vs * A_VBUF;
                __builtin_amdgcn_sched_barrier(0);
                float ra = 0.f, rb = 0.f; unsigned w[16];
#define AC2_PINF(x) asm volatile("" : "+v"(x))
#define AC2_QGAP(i) do { if ((i) & 1) n1 = __builtin_amdgcn_mfma_f32_32x32x16_bf16(kf[i], Qf[(i) >> 1], n1, 0, 0, 0); else n0 = __builtin_amdgcn_mfma_f32_32x32x16_bf16(kf[i], Qf[(i) >> 1], n0, 0, 0, 0); \
                    float e0 = __builtin_amdgcn_exp2f(p0[2 * (i)]), e1 = __builtin_amdgcn_exp2f(p0[2 * (i) + 1]), e2 = __builtin_amdgcn_exp2f(p1[2 * (i)]), e3 = __builtin_amdgcn_exp2f(p1[2 * (i) + 1]); \
                    ra += e0 + e1; rb += e2 + e3; \
                    AC2_PINF(e0); AC2_PINF(e1); AC2_PINF(e2); AC2_PINF(e3); AC2_PINF(ra); AC2_PINF(rb); \
                    p0[2 * (i)] = e0; p0[2 * (i) + 1] = e1; p1[2 * (i)] = e2; p1[2 * (i) + 1] = e3; \
                    if ((i) >= 4) { w[2 * ((i) - 4)] = cvtpk(p0[4 * ((i) - 4)], p0[4 * ((i) - 4) + 1]); w[2 * ((i) - 4) + 1] = cvtpk(p0[4 * ((i) - 4) + 2], p0[4 * ((i) - 4) + 3]); AC2_PINF(w[2 * ((i) - 4)]); AC2_PINF(w[2 * ((i) - 4) + 1]); } \
                    if ((i) == 6) { vl[0] = tr_read(vb); vh[0] = tr_read(vb + 8 * VP); } \
                    if ((i) == 7) { vl[1] = tr_read(vb + 64); vh[1] = tr_read(vb + 64 + 8 * VP); } \
                    __builtin_amdgcn_sched_barrier(0); } while (0)
                s16x4 vl[2], vh[2];
                AC2_QGAP(0); AC2_QGAP(1); AC2_QGAP(2); AC2_QGAP(3); AC2_QGAP(4); AC2_QGAP(5); AC2_QGAP(6); AC2_QGAP(7);
                Ls += ra + rb;
#define AC2_PA(kq) __builtin_bit_cast(bf16x8v, (u32x4){w[4 * (kq)], w[4 * (kq) + 1], w[4 * (kq) + 2], w[4 * (kq) + 3]})
#define AC2_PGAP(g) do { const int kq_ = (g) >> 1, db_ = (g) & 1; const bf16x8v vf = {vl[(g) & 1][0], vl[(g) & 1][1], vl[(g) & 1][2], vl[(g) & 1][3], vh[(g) & 1][0], vh[(g) & 1][1], vh[(g) & 1][2], vh[(g) & 1][3]}; \
                    if ((g) < 6) { const int kq2 = ((g) + 2) >> 1, db2 = (g) & 1; vl[(g) & 1] = tr_read(vb + kq2 * (16 * VP) + db2 * 64); vh[(g) & 1] = tr_read(vb + kq2 * (16 * VP) + db2 * 64 + 8 * VP); } \
                    O[db_] = __builtin_amdgcn_mfma_f32_32x32x16_bf16(vf, AC2_PA(kq_), O[db_], 0, 0, 0); \
                    if ((g) < 4) { w[8 + 2 * (g)] = cvtpk(p1[4 * (g)], p1[4 * (g) + 1]); w[8 + 2 * (g) + 1] = cvtpk(p1[4 * (g) + 2], p1[4 * (g) + 3]); AC2_PINF(w[8 + 2 * (g)]); AC2_PINF(w[8 + 2 * (g) + 1]); } \
                    __builtin_amdgcn_sched_barrier(0); } while (0)
                AC2_PGAP(0); AC2_PGAP(1); AC2_PGAP(2); AC2_PGAP(3); AC2_PGAP(4); AC2_PGAP(5); AC2_PGAP(6); AC2_PGAP(7);
#undef AC2_PGAP
#undef AC2_PA
#undef AC2_QGAP
#undef AC2_PINF
                p0 = n0; p1 = n1;
            }
#endif
        } else if (actn) AC2_QK(jn, ks ^ 1);
        if (jnn >= 0) { *(LAS u32x4*)(L + A_KOFF + ks * A_KBUF + kdst) = kreg; if (FOX && tid < 64) *(LAS float*)(L + A_BOFF + ks * 256 + tid * 4) = breg; }
        if (jn >= 0) *(LAS u32x4*)(L + A_VOFF + (vs ^ 1) * A_VBUF + vdst) = vreg;
        __syncthreads();
        if (jn < 0) break;
        j = jn; jn = jnn; ks ^= 1; vs ^= 1;
    }
#undef AC2_QK
#undef AC2_INIT
#undef AC2_ACTIVE
}
__device__ __forceinline__ size_t mix_off(size_t n, int c, int W) { return ((n >> 5) * (size_t)(W / 8) + (size_t)(c >> 3)) * 256 + (n & 31) * 8 + (c & 7); }
#define ATTN_FOR_CHUNKS(db, g4) _Pragma("unroll") for (int db = 0; db < 2; ++db) _Pragma("unroll") for (int g4 = 0; g4 < 4; ++g4)

__device__ __forceinline__ void unpack8(const u32x4 w, float (&f)[8]) { f[0] = __uint_as_float(w.x << 16); f[1] = __uint_as_float(w.x & 0xffff0000u); f[2] = __uint_as_float(w.y << 16); f[3] = __uint_as_float(w.y & 0xffff0000u);
    f[4] = __uint_as_float(w.z << 16); f[5] = __uint_as_float(w.z & 0xffff0000u); f[6] = __uint_as_float(w.w << 16); f[7] = __uint_as_float(w.w & 0xffff0000u); }
__device__ __forceinline__ void ph_norm_bf16_from_bf16(const Ctx& c, const bf16* x, const float* g, bf16* out) {
    constexpr int RB = 4; float gg[2][8];
#pragma unroll
    for (int j = 0; j < 2; ++j) { const f32x4 a = ((const f32x4*)g)[2 * c.lane + 128 * j], b2 = ((const f32x4*)g)[2 * c.lane + 128 * j + 1]; gg[j][0] = a.x; gg[j][1] = a.y; gg[j][2] = a.z; gg[j][3] = a.w; gg[j][4] = b2.x; gg[j][5] = b2.y; gg[j][6] = b2.z; gg[j][7] = b2.w; }
    for (int row0 = c.gw * RB; row0 < NT; row0 += c.ngw * RB) {
        u32x4 v[RB][2];
#pragma unroll
        for (int q = 0; q < RB; ++q)
#pragma unroll
            for (int j = 0; j < 2; ++j) v[q][j] = ((const u32x4*)(x + (size_t)(row0 + q) * D_))[c.lane + 64 * j];
#pragma unroll
        for (int q = 0; q < RB; ++q) { float f[2][8]; float ss = 0.f;
#pragma unroll
            for (int j = 0; j < 2; ++j) { unpack8(v[q][j], f[j]);
#pragma unroll
                for (int e = 0; e < 8; ++e) ss = fmaf(f[j][e], f[j][e], ss); }
            const float r = rsqrtf(wave_sum(ss) * (1.f / D_) + EPS);
#pragma unroll
            for (int j = 0; j < 2; ++j) { u32x4 o; o.x = pk2(f[j][0] * r * gg[j][0], f[j][1] * r * gg[j][1]); o.y = pk2(f[j][2] * r * gg[j][2], f[j][3] * r * gg[j][3]); o.z = pk2(f[j][4] * r * gg[j][4], f[j][5] * r * gg[j][5]); o.w = pk2(f[j][6] * r * gg[j][6], f[j][7] * r * gg[j][7]);
                ((u32x4*)(out + (size_t)(row0 + q) * D_))[c.lane + 64 * j] = o; } }
    }
}
__device__ __forceinline__ void ph_norm_final_from_bf16(const Ctx& c, const bf16* x, const float* g, float* out) {
    constexpr int RB = 4; float gg[2][8];
#pragma unroll
    for (int j = 0; j < 2; ++j) { const f32x4 a = ((const f32x4*)g)[2 * c.lane + 128 * j], b2 = ((const f32x4*)g)[2 * c.lane + 128 * j + 1]; gg[j][0] = a.x; gg[j][1] = a.y; gg[j][2] = a.z; gg[j][3] = a.w; gg[j][4] = b2.x; gg[j][5] = b2.y; gg[j][6] = b2.z; gg[j][7] = b2.w; }
    for (int row0 = c.gw * RB; row0 < NT; row0 += c.ngw * RB) {
        u32x4 v[RB][2];
#pragma unroll
        for (int q = 0; q < RB; ++q)
#pragma unroll
            for (int j = 0; j < 2; ++j) v[q][j] = ((const u32x4*)(x + (size_t)(row0 + q) * D_))[c.lane + 64 * j];
#pragma unroll
        for (int q = 0; q < RB; ++q) { float f[2][8]; float ss = 0.f;
#pragma unroll
            for (int j = 0; j < 2; ++j) { unpack8(v[q][j], f[j]);
#pragma unroll
                for (int e = 0; e < 8; ++e) ss = fmaf(f[j][e], f[j][e], ss); }
            const float r = rsqrtf(wave_sum(ss) * (1.f / D_) + EPS);
#pragma unroll
            for (int j = 0; j < 2; ++j) { f32x4* o = (f32x4*)(out + (size_t)(row0 + q) * D_) + 2 * c.lane + 128 * j;
                o[0] = (f32x4){f[j][0] * r * gg[j][0], f[j][1] * r * gg[j][1], f[j][2] * r * gg[j][2], f[j][3] * r * gg[j][3]}; o[1] = (f32x4){f[j][4] * r * gg[j][4], f[j][5] * r * gg[j][5], f[j][6] * r * gg[j][6], f[j][7] * r * gg[j][7]}; } }
    }
}
__device__ __forceinline__ void ph_norm_bf16(const Ctx& c, const float* x, const float* g, bf16* out, bf16* raw) {
    constexpr int RB = 4;
    f32x4 gg[4];
#pragma unroll
    for (int j = 0; j < 4; ++j) gg[j] = ((const f32x4*)g)[c.lane + 64 * j];
    for (int row0 = c.gw * RB; row0 < NT; row0 += c.ngw * RB) {
        f32x4 v[RB][4];
#pragma unroll
        for (int q = 0; q < RB; ++q)
#pragma unroll
            for (int j = 0; j < 4; ++j) v[q][j] = ((const f32x4*)(x + (size_t)(row0 + q) * D_))[c.lane + 64 * j];
#pragma unroll
        for (int q = 0; q < RB; ++q) { float ss = 0.f;
#pragma unroll
            for (int j = 0; j < 4; ++j) ss += v[q][j].x * v[q][j].x + v[q][j].y * v[q][j].y + v[q][j].z * v[q][j].z + v[q][j].w * v[q][j].w;
            const float r = rsqrtf(wave_sum(ss) * (1.f / D_) + EPS);
            u64* o8 = (u64*)(out + (size_t)(row0 + q) * D_) + c.lane; u64* r8 = (u64*)(raw + (size_t)(row0 + q) * D_) + c.lane;
#pragma unroll
            for (int j = 0; j < 4; ++j) { o8[64 * j] = (u64)pk2(v[q][j].x * r * gg[j].x, v[q][j].y * r * gg[j].y) | ((u64)pk2(v[q][j].z * r * gg[j].z, v[q][j].w * r * gg[j].w) << 32);
                r8[64 * j] = (u64)pk2(v[q][j].x, v[q][j].y) | ((u64)pk2(v[q][j].z, v[q][j].w) << 32); } }
    }
}
__device__ __forceinline__ void ph_norm_final(const Ctx& c, float* x, const float* g) {
    constexpr int RB = 4;
    f32x4 gg[4];
#pragma unroll
    for (int j = 0; j < 4; ++j) gg[j] = ((const f32x4*)g)[c.lane + 64 * j];
    for (int row0 = c.gw * RB; row0 < NT; row0 += c.ngw * RB) {
        f32x4 v[RB][4];
#pragma unroll
        for (int q = 0; q < RB; ++q)
#pragma unroll
            for (int j = 0; j < 4; ++j) v[q][j] = ((const f32x4*)(x + (size_t)(row0 + q) * D_))[c.lane + 64 * j];
#pragma unroll
        for (int q = 0; q < RB; ++q) { float ss = 0.f;
#pragma unroll
            for (int j = 0; j < 4; ++j) ss += v[q][j].x * v[q][j].x + v[q][j].y * v[q][j].y + v[q][j].z * v[q][j].z + v[q][j].w * v[q][j].w;
            const float r = rsqrtf(wave_sum(ss) * (1.f / D_) + EPS);
            f32x4* xr = (f32x4*)(x + (size_t)(row0 + q) * D_) + c.lane;
#pragma unroll
            for (int j = 0; j < 4; ++j) xr[64 * j] = v[q][j] * r * gg[j]; }
    }
}

template <class AF, class EF>
__device__ __forceinline__ void naive_gemm(const Ctx& c, int M, int N, int K, AF af, const float* W, int ldb, EF ef) {
    LAS float* As = (LAS float*)c.lds;
    LAS float* Bs = As + 16 * 132;
    const int tm = (M + 127) / 128, tn = (N + 127) / 128, ntile = tm * tn;
    const int ty = c.tid >> 4, tx = c.tid & 15;
    for (int tile = c.bid; tile < ntile; tile += c.G) {
        const int m0 = (tile / tn) * 128, n0 = (tile % tn) * 128;
        float acc[4][8];
#pragma unroll
        for (int i = 0; i < 4; ++i)
#pragma unroll
            for (int j = 0; j < 8; ++j) acc[i][j] = 0.f;
        for (int k0 = 0; k0 < K; k0 += 16) {
            __syncthreads();
#pragma unroll
            for (int i = 0; i < 4; ++i) { const int e = c.tid + i * 512, r = e >> 4, kk = e & 15; const int row = m0 + r;
                As[kk * 132 + r] = (row < M) ? af(row, k0 + kk) : 0.f; }
#pragma unroll
            for (int i = 0; i < 4; ++i) { const int e = c.tid + i * 512, kk = e >> 7, cc = e & 127; const int col = n0 + cc;
                Bs[kk * 132 + cc] = (col < N) ? W[(size_t)(k0 + kk) * ldb + col] : 0.f; }
            __syncthreads();
#pragma unroll 2
            for (int kk = 0; kk < 16; ++kk) {
                float a[4], b[8];
#pragma unroll
                for (int i = 0; i < 4; ++i) a[i] = As[kk * 132 + ty * 4 + i];
#pragma unroll
                for (int j = 0; j < 8; ++j) b[j] = Bs[kk * 132 + tx * 8 + j];
#pragma unroll
                for (int i = 0; i < 4; ++i)
#pragma unroll
                    for (int j = 0; j < 8; ++j) acc[i][j] = fmaf(a[i], b[j], acc[i][j]);
            }
        }
        LAS float* Cs = Bs + 16 * 132;
        __syncthreads();
#pragma unroll
        for (int i = 0; i < 4; ++i)
#pragma unroll
            for (int j = 0; j < 8; ++j) Cs[(ty * 4 + i) * 129 + tx * 8 + j] = acc[i][j];
        __syncthreads();
#pragma unroll 1
        for (int e = c.tid; e < 128 * 128; e += NTHREADS) { const int r = e >> 7, cc = e & 127, row = m0 + r, col = n0 + cc; if (row < M && col < N) ef(row, col, Cs[r * 129 + cc]); }
    }
    __syncthreads();
}

struct InProjOut { bf16* qn; bf16* kv6; bf16* fqkv; bf16* dqk; bf16* dv; float* gate; float* fl; const float* b_gate; const float* b_fgt; };
__device__ __forceinline__ void inproj_store(const InProjOut& o, int n, int col, float v) {
    const int b = n / T_, t = n % T_;
    if (col < C_KV6) { const int h = col >> 6, d = col & 63; o.qn[((size_t)(b * 8 + h) * T_ + t) * 64 + d] = (bf16)f2bf(v * (0.125f * LOG2E)); }
    else if (col < C_GATE) { const int cc = col - C_KV6, idx = cc >> 7, g = (cc >> 6) & 1, d = cc & 63;
        ((bf16*)((unsigned char*)o.kv6 + idx * KV6_STRIDE))[((size_t)(b * 2 + g) * T_ + t) * 64 + d] = (bf16)f2bf(v); }
    else if (col < C_FQ) { const int j = col - C_GATE; o.gate[(size_t)n * 24 + j] = sigmoidf_(v + o.b_gate[j]); }
    else if (col < C_FF) { const int cc = col - C_FQ, idx = cc >> 8, h = (cc >> 6) & 3, d = cc & 63;
        o.fqkv[(size_t)idx * (8 * MiB) + ((size_t)(b * 4 + h) * T_ + t) * 64 + d] = (bf16)f2bf(idx == 0 ? v * (0.125f * LOG2E) : v); }
    else if (col < C_DQ) { const int h = col - C_FF; o.fl[(size_t)(b * 4 + h) * T_ + t] = log_sigmoidf_(v + o.b_fgt[h]); }
    else if (col < C_DV) { const int cc = col - C_DQ, idx = cc >> 8, h = (cc >> 6) & 3, i = (cc >> 5) & 1, d = cc & 31;
        o.dqk[(size_t)idx * (8 * MiB) + ((size_t)((b * 4 + h) * 2 + i) * T_ + t) * 32 + d] = (bf16)f2bf(idx == 0 ? v * (0.17677669529663687f * LOG2E) : v); }
    else { const int cc = col - C_DV, h = cc >> 6, d = cc & 63; o.dv[((size_t)(b * 4 + h) * T_ + t) * 64 + d] = (bf16)f2bf(v); }
}

__device__ __forceinline__ void ph_cumsum(const Ctx& c, float* fl) {
    for (int s = c.gw; s < B_ * 4; s += c.ngw) {
        float* p = fl + (size_t)s * T_; float carry = 0.f;
        for (int t0 = 0; t0 < T_; t0 += 64) {
            float v = p[t0 + c.lane];
#pragma unroll
            for (int o = 1; o < 64; o <<= 1) { const float u = __shfl_up(v, o); if (c.lane >= o) v += u; }
            v += carry; p[t0 + c.lane] = v; carry = __shfl(v, 63);
        }
    }
}

template <int DQK>
__device__ __forceinline__ float naive_attn_row(const bf16* q, const bf16* K, const bf16* V, int t, u64 mask, float slope2, const float* cum, int win, int lane) {
    float qv[DQK];
    { const u32x4* q4 = (const u32x4*)q;
#pragma unroll
      for (int i = 0; i < DQK / 8; ++i) { const u32x4 w = q4[i];
          qv[8 * i + 0] = __uint_as_float(w.x << 16); qv[8 * i + 1] = __uint_as_float(w.x & 0xffff0000u);
          qv[8 * i + 2] = __uint_as_float(w.y << 16); qv[8 * i + 3] = __uint_as_float(w.y & 0xffff0000u);
          qv[8 * i + 4] = __uint_as_float(w.z << 16); qv[8 * i + 5] = __uint_as_float(w.z & 0xffff0000u);
          qv[8 * i + 6] = __uint_as_float(w.w << 16); qv[8 * i + 7] = __uint_as_float(w.w & 0xffff0000u); } }
    const float cumt = cum ? cum[t] : 0.f;
    float m = -INFINITY, l = 0.f, o = 0.f;
    while (mask) {
        const int j = __builtin_ctzll(mask); mask &= mask - 1;
        const int kpos = 64 * j + lane; const int dist = t - kpos;
        const bool valid = dist >= 0 && dist < win;
        float s = 0.f;
        { const u32x4* k4 = (const u32x4*)(K + (size_t)kpos * DQK);
#pragma unroll
          for (int i = 0; i < DQK / 8; ++i) { const u32x4 w = k4[i];
              s = fmaf(qv[8 * i + 0], __uint_as_float(w.x << 16), s); s = fmaf(qv[8 * i + 1], __uint_as_float(w.x & 0xffff0000u), s);
              s = fmaf(qv[8 * i + 2], __uint_as_float(w.y << 16), s); s = fmaf(qv[8 * i + 3], __uint_as_float(w.y & 0xffff0000u), s);
              s = fmaf(qv[8 * i + 4], __uint_as_float(w.z << 16), s); s = fmaf(qv[8 * i + 5], __uint_as_float(w.z & 0xffff0000u), s);
              s = fmaf(qv[8 * i + 6], __uint_as_float(w.w << 16), s); s = fmaf(qv[8 * i + 7], __uint_as_float(w.w & 0xffff0000u), s); } }
        s -= slope2 * (float)dist;
        if (cum) s += (cumt - cum[kpos]) * LOG2E;
        s = valid ? s : -INFINITY;
        const float mb = wave_max(s);
        if (mb == -INFINITY) continue;
        const float mn = fmaxf(m, mb), alpha = exp2f(m - mn);
        const float p = valid ? exp2f(s - mn) : 0.f;
        l = l * alpha + wave_sum(p); o *= alpha; m = mn;
        const bf16* vb = V + (size_t)(64 * j) * 64 + lane;
#pragma unroll 8
        for (int k = 0; k < 64; ++k) o = fmaf(__shfl(p, k), bf2f(vb[(size_t)k * 64]), o);
    }
    return l > 0.f ? o / l : 0.f;
}

__device__ __forceinline__ void ph_cmp_attn(const Ctx& c, const bf16* qn, const bf16* kcmp, const bf16* vcmp, const float* gate, u64* sel, bf16* ocmp) {
    LAS float* pl = (LAS float*)(c.lds) + c.wave * 256;
    const int lane = c.lane;
    for (int it = c.gw; it < B_ * 2 * T_; it += c.ngw) {
        const int t = it % T_, bg = it / T_, b = bg >> 1, g = bg & 1;
        const int nvis = (t >= 31) ? ((t - 31) >> 4) + 1 : 0;
        const bf16* kc = kcmp + (size_t)bg * 256 * 64; const bf16* vc = vcmp + (size_t)bg * 256 * 64;
        float imp = 0.f;
        for (int hg = 0; hg < 4; ++hg) {
            const int h = g * 4 + hg; const float slope2 = alibi_slope(h + 1, 8) * LOG2E;
            const bf16* q = qn + ((size_t)(b * 8 + h) * T_ + t) * 64;
            float qv[64];
            { const u32x4* q4 = (const u32x4*)q;
#pragma unroll
              for (int i = 0; i < 8; ++i) { const u32x4 w = q4[i];
                  qv[8 * i + 0] = __uint_as_float(w.x << 16); qv[8 * i + 1] = __uint_as_float(w.x & 0xffff0000u);
                  qv[8 * i + 2] = __uint_as_float(w.y << 16); qv[8 * i + 3] = __uint_as_float(w.y & 0xffff0000u);
                  qv[8 * i + 4] = __uint_as_float(w.z << 16); qv[8 * i + 5] = __uint_as_float(w.z & 0xffff0000u);
                  qv[8 * i + 6] = __uint_as_float(w.w << 16); qv[8 * i + 7] = __uint_as_float(w.w & 0xffff0000u); } }
            float s[4]; float m = -INFINITY;
#pragma unroll
            for (int i = 0; i < 4; ++i) { const int cc = lane + 64 * i; float a = 0.f;
                if (cc < nvis) { const u32x4* k4 = (const u32x4*)(kc + (size_t)cc * 64);
#pragma unroll
                    for (int e = 0; e < 8; ++e) { const u32x4 w = k4[e];
                        a = fmaf(qv[8 * e + 0], __uint_as_float(w.x << 16), a); a = fmaf(qv[8 * e + 1], __uint_as_float(w.x & 0xffff0000u), a);
                        a = fmaf(qv[8 * e + 2], __uint_as_float(w.y << 16), a); a = fmaf(qv[8 * e + 3], __uint_as_float(w.y & 0xffff0000u), a);
                        a = fmaf(qv[8 * e + 4], __uint_as_float(w.z << 16), a); a = fmaf(qv[8 * e + 5], __uint_as_float(w.z & 0xffff0000u), a);
                        a = fmaf(qv[8 * e + 6], __uint_as_float(w.w << 16), a); a = fmaf(qv[8 * e + 7], __uint_as_float(w.w & 0xffff0000u), a); }
                    a -= slope2 * (float)(t - (16 * cc + 31)); } else a = -INFINITY;
                s[i] = a; m = fmaxf(m, a); }
            m = wave_max(m);
            float p[4], lsum = 0.f;
#pragma unroll
            for (int i = 0; i < 4; ++i) { p[i] = (lane + 64 * i < nvis) ? exp2f(s[i] - m) : 0.f; lsum += p[i]; }
            lsum = wave_sum(lsum);
            const float inv = lsum > 0.f ? 1.f / lsum : 0.f;
#pragma unroll
            for (int i = 0; i < 4; ++i) { p[i] *= inv; pl[lane + 64 * i] = p[i]; }
            asm volatile("s_waitcnt lgkmcnt(0)" ::: "memory");
            float o = 0.f;
            for (int cc = 0; cc < nvis; ++cc) o = fmaf(pl[cc], bf2f(vc[(size_t)cc * 64 + lane]), o);
            const float gt = gate[((size_t)(b * T_ + t)) * 24 + h * 3 + 0];
            ocmp[(size_t)(b * T_ + t) * 512 + h * 64 + lane] = (bf16)f2bf(gt * o);
            { const int j = lane; float a = pl[4 * j] + pl[4 * j + 1] + pl[4 * j + 2] + 0.5f * pl[4 * j + 3]; if (j > 0) a += 0.5f * pl[4 * j - 1]; imp += a; }
            asm volatile("s_waitcnt lgkmcnt(0)" ::: "memory");
        }
        const int cur = t >> 6; const int j = lane;
        u64 m64;
        if (cur <= 15) m64 = (cur == 63) ? ~0ull : ((1ull << (cur + 1)) - 1ull);
        else {
            float val = (j > cur) ? -INFINITY : ((j == 0 || j == cur || j == cur - 1) ? 1e4f : imp);
            m64 = 0ull;
            for (int r = 0; r < 16; ++r) {
                const float mx = wave_max(val);
                const u64 bal = __ballot(val == mx);
                const int w = __builtin_ctzll(bal);
                m64 |= 1ull << w; if (j == w) val = -INFINITY;
            }
        }
        if (lane == 0) sel[(size_t)bg * T_ + t] = m64;
    }
}

__device__ __forceinline__ void ph_win_attn(const Ctx& c, const bf16* qn, const bf16* kw, const bf16* vw, const float* gate, bf16* owin) {
    for (int it = c.gw; it < B_ * 8 * T_; it += c.ngw) {
        const int t = it % T_, bh = it / T_, b = bh >> 3, h = bh & 7, g = h >> 2;
        const int cur = t >> 6, jlo = (t - 511) > 0 ? (t - 511) >> 6 : 0;
        const u64 hi = (cur == 63) ? ~0ull : ((1ull << (cur + 1)) - 1ull); const u64 mask = hi & ~((1ull << jlo) - 1ull);
        const float o = naive_attn_row<64>(qn + ((size_t)bh * T_ + t) * 64, kw + (size_t)(b * 2 + g) * T_ * 64, vw + (size_t)(b * 2 + g) * T_ * 64, t, mask,
                                           alibi_slope(h + 1, 8) * LOG2E, nullptr, 512, c.lane);
        owin[(size_t)(b * T_ + t) * 512 + h * 64 + c.lane] = (bf16)f2bf(gate[(size_t)(b * T_ + t) * 24 + h * 3 + 2] * o);
    }
}
__device__ __forceinline__ void ph_slc_attn(const Ctx& c, const bf16* qn, const bf16* ks, const bf16* vs, const float* gate, const u64* sel, const bf16* ocmp, const bf16* owin, bf16* att) {
    for (int it = c.gw; it < B_ * 8 * T_; it += c.ngw) {
        const int t = it % T_, bh = it / T_, b = bh >> 3, h = bh & 7, g = h >> 2;
        const u64 mask = sel[(size_t)(b * 2 + g) * T_ + t];
        const float o = naive_attn_row<64>(qn + ((size_t)bh * T_ + t) * 64, ks + (size_t)(b * 2 + g) * T_ * 64, vs + (size_t)(b * 2 + g) * T_ * 64, t, mask,
                                           alibi_slope(h + 1, 8) * LOG2E, nullptr, 1 << 30, c.lane);
        const size_t n = (size_t)(b * T_ + t);
        const float r = gate[n * 24 + h * 3 + 1] * o + bf2f(ocmp[n * 512 + h * 64 + c.lane]) + bf2f(owin[n * 512 + h * 64 + c.lane]);
        att[n * 1024 + h * 64 + c.lane] = (bf16)f2bf(r);
    }
}
__device__ __forceinline__ void ph_fox_attn(const Ctx& c, const bf16* fq, const bf16* fk, const bf16* fv, const float* cum, bf16* att) {
    for (int it = c.gw; it < B_ * 4 * T_; it += c.ngw) {
        const int t = it % T_, bh = it / T_, b = bh >> 2, h = bh & 3;
        const int cur = t >> 6; const u64 mask = (cur == 63) ? ~0ull : ((1ull << (cur + 1)) - 1ull);
        const float o = naive_attn_row<64>(fq + ((size_t)bh * T_ + t) * 64, fk + (size_t)bh * T_ * 64, fv + (size_t)bh * T_ * 64, t, mask, 0.f, cum + (size_t)bh * T_, 1 << 30, c.lane);
        att[(size_t)(b * T_ + t) * 1024 + 512 + h * 64 + c.lane] = (bf16)f2bf(o);
    }
}
__device__ __forceinline__ void ph_diff_attn(const Ctx& c, const bf16* dq, const bf16* dk, const bf16* dv, const float* lam, const float* subln, float lambda_init, bf16* att) {
    float l1 = 0.f, l2 = 0.f;
    if (c.lane < 32) { l1 = lam[c.lane] * lam[32 + c.lane]; l2 = lam[64 + c.lane] * lam[96 + c.lane]; }
    const float lam_full = __expf(wave_sum(l1)) - __expf(wave_sum(l2)) + lambda_init;
    const float sg = subln[c.lane] * (1.f - lambda_init);
    for (int it = c.gw; it < B_ * 4 * T_; it += c.ngw) {
        const int t = it % T_, bh = it / T_, b = bh >> 2, h = bh & 3;
        const int cur = t >> 6; const u64 mask = (cur == 63) ? ~0ull : ((1ull << (cur + 1)) - 1ull);
        const float slope2 = alibi_slope(h + 1, 4) * LOG2E;
        const bf16* vb = dv + (size_t)bh * T_ * 64;
        const float o1 = naive_attn_row<32>(dq + ((size_t)(bh * 2 + 0) * T_ + t) * 32, dk + (size_t)(bh * 2 + 0) * T_ * 32, vb, t, mask, slope2, nullptr, 1 << 30, c.lane);
        const float o2 = naive_attn_row<32>(dq + ((size_t)(bh * 2 + 1) * T_ + t) * 32, dk + (size_t)(bh * 2 + 1) * T_ * 32, vb, t, mask, slope2, nullptr, 1 << 30, c.lane);
        const float o = o1 - lam_full * o2;
        const float r = rsqrtf(wave_sum(o * o) * (1.f / 64.f) + EPS);
        att[(size_t)(b * T_ + t) * 1024 + 768 + h * 64 + c.lane] = (bf16)f2bf(o * r * sg);
    }
}

__device__ __forceinline__ void ph_moe_route(const Ctx& c, const float* x, const float* g, const float* wgrp, const float* bgrp, const float* wexp, const float* bexp, bf16* hn, int* route_e, float* route_w, unsigned* cnt) {
    for (int row = c.gw; row < NT; row += c.ngw) {
        const f32x4* xr = (const f32x4*)(x + (size_t)row * D_) + c.lane;
        f32x4 v[4]; float ss = 0.f;
#pragma unroll
        for (int j = 0; j < 4; ++j) { v[j] = xr[64 * j]; ss += v[j].x * v[j].x + v[j].y * v[j].y + v[j].z * v[j].z + v[j].w * v[j].w; }
        const float r = rsqrtf(wave_sum(ss) * (1.f / D_) + EPS);
        u64* o8 = (u64*)(hn + (size_t)row * D_) + c.lane;
#pragma unroll
        for (int j = 0; j < 4; ++j) { const f32x4 gg = ((const f32x4*)g)[c.lane + 64 * j]; v[j] = v[j] * r * gg;
            o8[64 * j] = (u64)pk2(v[j].x, v[j].y) | ((u64)pk2(v[j].z, v[j].w) << 32); }
        float gl[4];
#pragma unroll
        for (int q = 0; q < 4; ++q) { float a = 0.f;
#pragma unroll
            for (int j = 0; j < 4; ++j) { const int k = 4 * (c.lane + 64 * j);
                a = fmaf(v[j].x, wgrp[(size_t)(k + 0) * 4 + q], a); a = fmaf(v[j].y, wgrp[(size_t)(k + 1) * 4 + q], a);
                a = fmaf(v[j].z, wgrp[(size_t)(k + 2) * 4 + q], a); a = fmaf(v[j].w, wgrp[(size_t)(k + 3) * 4 + q], a); }
            gl[q] = wave_sum(a) + bgrp[q]; }
        int grp = 0; float gm = gl[0];
#pragma unroll
        for (int q = 1; q < 4; ++q) if (gl[q] > gm) { gm = gl[q]; grp = q; }
        float gs = 0.f;
#pragma unroll
        for (int q = 0; q < 4; ++q) gs += __expf(gl[q] - gm);
        const float grp_gate = 1.f / gs;
        float el[8];
#pragma unroll
        for (int q = 0; q < 8; ++q) { float a = 0.f; const int col = grp * 8 + q;
#pragma unroll
            for (int j = 0; j < 4; ++j) { const int k = 4 * (c.lane + 64 * j);
                a = fmaf(v[j].x, wexp[(size_t)(k + 0) * 32 + col], a); a = fmaf(v[j].y, wexp[(size_t)(k + 1) * 32 + col], a);
                a = fmaf(v[j].z, wexp[(size_t)(k + 2) * 32 + col], a); a = fmaf(v[j].w, wexp[(size_t)(k + 3) * 32 + col], a); }
            el[q] = wave_sum(a) + bexp[col]; }
        int i0 = 0; float v0 = el[0];
#pragma unroll
        for (int q = 1; q < 8; ++q) if (el[q] > v0) { v0 = el[q]; i0 = q; }
        int i1 = -1; float v1 = -INFINITY;
#pragma unroll
        for (int q = 0; q < 8; ++q) if (q != i0 && el[q] > v1) { v1 = el[q]; i1 = q; }
        const float e1 = __expf(v1 - v0), den = 1.f + e1;
        if (c.lane == 0) { const float w0 = grp_gate / den, w1 = grp_gate * e1 / den;
            const int lo = i0 < i1 ? i0 : i1, hi = i0 < i1 ? i1 : i0, cls = grp * 28 + lo * 8 - (lo * (lo + 1)) / 2 + (hi - lo - 1);
            const unsigned rank = __hip_atomic_fetch_add(cnt + cls, 1u, __ATOMIC_RELAXED, __HIP_MEMORY_SCOPE_AGENT);
            route_e[row] = (int)(((unsigned)cls << 24) | rank); route_w[2 * row] = i0 < i1 ? w0 : w1; route_w[2 * row + 1] = i0 < i1 ? w1 : w0; }
    }
}
__device__ __forceinline__ void ph_moe_naive(const Ctx& c, const bf16* hn, const int* route_e, const float* route_w, const float* wg, const float* wu, const float* wd, float* x) {
    LAS float* hs = (LAS float*)c.lds;
    LAS float* au = hs + 1024;
    LAS float* h2 = au + 512;
    for (int row = c.bid; row < NT; row += c.G) {
        __syncthreads();
        hs[c.tid] = bf2f(hn[(size_t)row * D_ + c.tid]); hs[c.tid + 512] = bf2f(hn[(size_t)row * D_ + c.tid + 512]);
        float o0 = 0.f, o1 = 0.f;
        for (int s = 0; s < 2; ++s) {
            const int e = route_e[2 * row + s]; const float w = route_w[2 * row + s];
            __syncthreads();
            const float* W = (c.tid < 256 ? wg : wu) + (size_t)e * D_ * DEXP + (c.tid & 255);
            float a = 0.f;
            for (int k = 0; k < D_; ++k) a = fmaf(hs[k], W[(size_t)k * DEXP], a);
            au[c.tid] = a;
            __syncthreads();
            if (c.tid < 256) { const float ga = au[c.tid], up = au[c.tid + 256]; h2[c.tid] = ga / (1.f + __expf(-ga)) * up * w; }
            __syncthreads();
            const float* Wd = wd + (size_t)e * DEXP * D_;
            for (int k = 0; k < DEXP; ++k) { const float hv = h2[k]; o0 = fmaf(hv, Wd[(size_t)k * D_ + c.tid], o0); o1 = fmaf(hv, Wd[(size_t)k * D_ + c.tid + 512], o1); }
        }
        x[(size_t)row * D_ + c.tid] += o0; x[(size_t)row * D_ + c.tid + 512] += o1;
    }
    __syncthreads();
}

typedef __attribute__((address_space(4))) const Params* KP;
__device__ __forceinline__ KP uni_kp(KP p) { const unsigned long long v = (unsigned long long)p; const unsigned lo = __builtin_amdgcn_readfirstlane((unsigned)v), hi = __builtin_amdgcn_readfirstlane((unsigned)(v >> 32)); return (KP)(((unsigned long long)hi << 32) | lo); }
constexpr int PH_PER_LAYER = 11, N_PHASES = L_ * PH_PER_LAYER + 2;
__device__ __forceinline__ Ctx make_ctx(KP p) {
    Ctx c; c.lds = (LAS unsigned char*)lds_raw; { int t_ = threadIdx.x; asm volatile("" : "+v"(t_)); c.tid = t_; } c.lane = c.tid & 63; c.wave = __builtin_amdgcn_readfirstlane(c.tid >> 6);
    c.bid = blockIdx.x; c.G = gridDim.x; c.gw = c.bid * NWAVES + c.wave; c.ngw = c.G * NWAVES; c.in = nullptr; c.xcur = p->out; c.ws = p->ws;
    return c;
}
struct Bufs {
    bf16 *QN, *KV6, *KC, *VC, *KS, *VS, *KW, *VW, *FQ, *FK, *FV, *DQ, *DK, *DV, *HC, *KCMP, *VCMP, *OCMP, *OWIN, *HN, *ATT;
    float *GATE, *FL, *ROUTE_W; u64* SEL; int* ROUTE_E;
};
__device__ __forceinline__ Bufs make_bufs(unsigned char* ws) {
    Bufs b;
    b.QN = (bf16*)(ws + WS_QN); b.KV6 = (bf16*)(ws + WS_KV6);
    b.KC = (bf16*)(ws + WS_KV6 + 0 * KV6_STRIDE); b.VC = (bf16*)(ws + WS_KV6 + 1 * KV6_STRIDE);
    b.KS = (bf16*)(ws + WS_KV6 + 2 * KV6_STRIDE); b.VS = (bf16*)(ws + WS_KV6 + 3 * KV6_STRIDE);
    b.KW = (bf16*)(ws + WS_KV6 + 4 * KV6_STRIDE); b.VW = (bf16*)(ws + WS_KV6 + 5 * KV6_STRIDE);
    b.FQ = (bf16*)(ws + WS_FQKV); b.FK = b.FQ + 8 * MiB; b.FV = b.FQ + 16 * MiB;
    b.DQ = (bf16*)(ws + WS_DQK); b.DK = b.DQ + 8 * MiB; b.DV = (bf16*)(ws + WS_DV);
    b.GATE = (float*)(ws + WS_GATE); b.FL = (float*)(ws + WS_FL);
    b.HC = (bf16*)(ws + WS_HC); b.KCMP = (bf16*)(ws + WS_KVCMP); b.VCMP = b.KCMP + 16 * 256 * 64;
    b.SEL = (u64*)(ws + WS_SEL); b.OCMP = (bf16*)(ws + WS_OCMP); b.OWIN = (bf16*)(ws + WS_OWIN);
    b.HN = (bf16*)(ws + WS_HN); b.ATT = (bf16*)(ws + WS_ATT);
    b.ROUTE_E = (int*)(ws + WS_ROUTE); b.ROUTE_W = (float*)(ws + WS_ROUTE + 512 * 1024);
    return b;
}
__device__ __forceinline__ float lambda_init_of(int l) { return l == 0 ? 0.2f : 0.35550906759096926f; }

__device__ __noinline__ void P_prologue(KP p_) { const KP p = uni_kp(p_);
    const Ctx c = make_ctx(p); unsigned char* ws = p->ws;
    LAS float* scr = (LAS float*)(c.lds) + c.wave * (64 * 33);
    constexpr int I_A = 16 * 40, I_B = 16 * 24, I_C = 16 * 24, I_O = 16 * 32, I_G = 16 * 8, I_D = 4 * 32, I_E = 2 * I_G + I_D, I_W1 = 32 * 8, I_W2 = 4 * 2;
    constexpr int PER_L = I_A + I_B + I_C + I_O + 2 * (I_W1 + I_W2);
    for (int it = c.gw; it < L_ * PER_L; it += c.ngw) {
        const int l = it / PER_L; int r = it % PER_L;
        const float* W; bf16* WT; int ldw, K, sc0, ncol, r0 = 0, rmul = 1;
        if (r < I_A + I_B + I_C) { W = p->in[2] + (size_t)l * D_ * D_IN; WT = (bf16*)(ws + WS_WIN_T) + (size_t)l * NIN * D_; ldw = D_IN; K = D_;
            if (r < I_A) { sc0 = 0; ncol = 1280; r0 = 0; } else if (r < I_A + I_B) { r -= I_A; sc0 = C_FQ; ncol = 768; r0 = 1280; } else { r -= I_A + I_B; sc0 = C_DQ; ncol = 768; r0 = 2048; } }
        else if ((r -= I_A + I_B + I_C) < I_O) { W = p->in[13] + (size_t)l * D_ * D_; WT = (bf16*)(ws + WS_WOUT_T) + (size_t)l * D_ * D_; ldw = D_; K = D_; sc0 = 0; ncol = 1024; }
        else { r -= I_O; const int kv = r / (I_W1 + I_W2); r = r % (I_W1 + I_W2); const size_t lk = (size_t)l * 2 + kv;
            if (r < I_W1) { W = p->in[kv == 0 ? 6 : 9] + (size_t)l * 2048 * 256; WT = (bf16*)(ws + WS_W1_T) + lk * 256 * 2048; ldw = 256; K = 2048; sc0 = 0; ncol = 256; }
            else { r -= I_W1; W = p->in[kv == 0 ? 7 : 10] + (size_t)l * 256 * 64; WT = (bf16*)(ws + WS_W2_T) + lk * 64 * 256; ldw = 64; K = 256; sc0 = 0; ncol = 64; } }
        transpose_seg(W, ldw, K, sc0, ncol, WT, r0, rmul, r, scr, c.lane);
    }
    for (int i = c.bid * NTHREADS + c.tid; i < L_ * 256 * D_; i += c.G * NTHREADS) {
        const int l = i / (256 * D_), rr = (i / D_) % 256, k = i % D_;
        const float* win = p->in[2] + (size_t)l * D_ * D_IN;
        float v = 0.f; if (rr < 24) v = win[(size_t)k * D_IN + C_GATE + rr]; else if (rr < 28) v = win[(size_t)k * D_IN + C_FF + (rr - 24)];
        ((bf16*)(ws + WS_WIN_T))[((size_t)l * NIN + 2816 + rr) * D_ + k] = (bf16)f2bf(v);
    }
    for (int w = c.gw; w < L_ * 2 * 4 * 128; w += c.ngw) {
        const int lk = w >> 9, cg = (w >> 7) & 3, kc = w & 127, l = lk >> 1, kv = lk & 1, j = cg * 64 + c.lane;
        const float* pe = p->in[kv == 0 ? 5 : 8] + (size_t)l * 2048 + kc * 16; const float* w1 = p->in[kv == 0 ? 6 : 9] + (size_t)l * 2048 * 256 + (size_t)kc * 16 * 256;
        float a = 0.f;
#pragma unroll
        for (int k = 0; k < 16; ++k) a = fmaf(pe[k], w1[(size_t)k * 256 + j], a);
        ((float*)(ws + WS_B1PART))[((size_t)lk * 128 + kc) * 256 + j] = a;
    }
    for (int i = c.bid * NTHREADS + c.tid; i < L_ * 64 * 2 * 64; i += c.G * NTHREADS) {
        const int l = i / (64 * 2 * 64), ks = (i / 128) % 64, cb = (i / 64) & 1, lane = i & 63, col = 32 * cb + (lane & 31);
        unsigned hi[4], lo[4];
#pragma unroll
        for (int jp = 0; jp < 4; ++jp) { float v[2];
#pragma unroll
            for (int e = 0; e < 2; ++e) { const int k = 16 * ks + 8 * (lane >> 5) + 2 * jp + e; const float g = p->in[14][(size_t)l * D_ + k];
                v[e] = col < 4 ? g * p->in[15][((size_t)l * D_ + k) * 4 + col] : (col < 36 ? g * p->in[17][((size_t)l * D_ + k) * 32 + (col - 4)] : 0.f); }
            const unsigned h0 = f2bf(v[0]), h1 = f2bf(v[1]); hi[jp] = h0 | (h1 << 16);
            lo[jp] = f2bf(v[0] - __uint_as_float(h0 << 16)) | (f2bf(v[1] - __uint_as_float(h1 << 16)) << 16); }
        u32x4* dst = (u32x4*)(ws + WS_WR) + ((size_t)((l * 64 + ks) * 2 + cb) * 2) * 64 + lane;
        dst[0] = (u32x4){hi[0], hi[1], hi[2], hi[3]}; dst[64] = (u32x4){lo[0], lo[1], lo[2], lo[3]};
    }
}
__device__ __forceinline__ void P_inproj_mfma(int l_) { const KP p = (KP)__builtin_amdgcn_kernarg_segment_ptr(); int l = l_; asm volatile("" : "+s"(l));
    unsigned char* ws = p->ws; asm volatile("" : "+s"(ws));
    PlainOrder S; S.init(p->out, (const bf16*)(ws + WS_WIN_T) + (size_t)l * NIN * D_, D_, D_, NT, NIN, (int)gridDim.x, launder_s((int)blockIdx.x));
#ifdef STAGGER_TICKS
    { const unsigned long long t0 = __builtin_amdgcn_s_memrealtime(); const unsigned long long d = (unsigned long long)((launder_s((int)blockIdx.x) >> 3) & 3) * STAGGER_TICKS;
      while (__builtin_amdgcn_s_memrealtime() - t0 < d) __builtin_amdgcn_s_sleep(4); }
#endif
    const pg8::Gemm g{D_, D_, D_, D_ / 64, 0, 0};
    const EpiInProj E{ws, p->in[3] + l * 24, p->in[4] + l * 4, (unsigned*)(ws + WS_CTL) + CW_KN + l * 8192};
    pg8::gemm_phase<EpiInProj, PlainOrder, INPROJ_ALIGN, INPROJ_SP2>((LAS unsigned char*)lds_raw, g, S, E);
}
__device__ __forceinline__ void P_inproj_dummy(int l_) { const KP p = (KP)__builtin_amdgcn_kernarg_segment_ptr(); int l = l_; asm volatile("" : "+s"(l));
    unsigned char* ws = p->ws; asm volatile("" : "+s"(ws));
    PlainOrder S; S.init(p->out, (const bf16*)(ws + WS_WIN_T) + (size_t)l * NIN * D_, D_, D_, NT, NIN, (int)gridDim.x, launder_s((int)blockIdx.x));
    const pg8::Gemm g{D_, D_, D_, D_ / 64, 0, 0};
    const EpiDummy E{(float*)(ws + WS_HB)};
    pg8::gemm_phase<EpiDummy, PlainOrder, true, true>((LAS unsigned char*)lds_raw, g, S, E);
}
__device__ __forceinline__ void P_outproj_mfma(int l_) { const KP p = (KP)__builtin_amdgcn_kernarg_segment_ptr(); int l = l_; asm volatile("" : "+s"(l));
    unsigned char* ws = p->ws; asm volatile("" : "+s"(ws));
    PlainOrder S; S.init(ws + WS_ATT, (const bf16*)(ws + WS_WOUT_T) + (size_t)l * D_ * D_, D_, D_, NT, D_, (int)gridDim.x, launder_s((int)blockIdx.x));
    const pg8::Gemm g{D_, D_, D_, D_ / 64, 32, 8};
    const EpiResBf16 E{(bf16*)(ws + WS_HN)};
    pg8::gemm_phase<EpiResBf16, PlainOrder, true, true>((LAS unsigned char*)lds_raw, g, S, E);
}
__device__ __forceinline__ float wave_max_l(float v, int lane) {
#pragma unroll
    for (int o = 1; o < 64; o <<= 1) v = fmaxf(v, shflx_f(v, o, lane));
    return v;
}
__device__ __forceinline__ float wave_min_l(float v, int lane) {
#pragma unroll
    for (int o = 1; o < 64; o <<= 1) v = fminf(v, shflx_f(v, o, lane));
    return v;
}
template <int NS> __device__ __forceinline__ float q_norm2_max(const bf16x8v (&Q)[NS], int lane) {
    float ss = 0.f;
#pragma unroll
    for (int s = 0; s < NS; ++s)
#pragma unroll
        for (int e = 0; e < 8; ++e) { const float v = __uint_as_float(((unsigned)(unsigned short)Q[s][e]) << 16); ss = fmaf(v, v, ss); }
    return wave_max_l(swap_sum(ss), lane);
}
__device__ __forceinline__ u64 prune_consensus(bool skip, LAS u64* slots, int wave, int lane) {
    const u64 mine = __ballot(skip);
    __syncthreads();
    if (lane == 0) slots[wave] = mine;
    __syncthreads();
    u64 all = slots[0];
#pragma unroll
    for (int w = 1; w < NWAVES; ++w) all &= slots[w];
    return all;
}
__device__ __forceinline__ void U_fox(KP p_, int bh_, int qb_, int l_) {
    const KP p = uni_kp(p_); const int bh = __builtin_amdgcn_readfirstlane(bh_), qb = __builtin_amdgcn_readfirstlane(qb_), l = __builtin_amdgcn_readfirstlane(l_);
    int tid_ = threadIdx.x; asm volatile("" : "+v"(tid_));
    const int tid = tid_, lane = tid & 63, wave = __builtin_amdgcn_readfirstlane(tid >> 6), r = lane & 31, h = lane >> 5;
    unsigned char* ws = p->ws; asm volatile("" : "+s"(ws)); LAS unsigned char* L = (LAS unsigned char*)lds_raw;
    const int tw0 = 256 * qb + 32 * wave, t_lane = tw0 + r, b = bh >> 2, hd = bh & 3;
    const bf16* q = (const bf16*)(ws + WS_FQKV) + (size_t)bh * T_ * 64 + (t_lane >> 4) * 1024 + (t_lane & 15) * 32 + 8 * h;
    bf16x8v Qf[1][4];
#pragma unroll
    for (int s = 0; s < 4; ++s) Qf[0][s] = *(const bf16x8v*)(q + (s >> 1) * 512 + (s & 1) * 16);
    LAS float* cum = (LAS float*)(L + A_LDS_END);
    { const float* fl = (const float*)(ws + WS_FL) + (size_t)bh * T_; LAS float* tot = cum + 4096;
      const int nval = 256 * (qb + 1); float v[8];
      if (8 * tid < nval) { const f32x4 a = *(const f32x4*)(fl + 8 * tid), c2 = *(const f32x4*)(fl + 8 * tid + 4); v[0] = a.x; v[1] = a.y; v[2] = a.z; v[3] = a.w; v[4] = c2.x; v[5] = c2.y; v[6] = c2.z; v[7] = c2.w; }
      else {
#pragma unroll
          for (int i = 0; i < 8; ++i) v[i] = 0.f; }
#pragma unroll
      for (int i = 1; i < 8; ++i) v[i] += v[i - 1];
      float sc = v[7];
#pragma unroll
      for (int o = 1; o < 64; o <<= 1) { const float up = __uint_as_float((unsigned)__builtin_amdgcn_ds_bpermute((lane - o) << 2, (int)__float_as_uint(sc))); if (lane >= o) sc += up; }
      if (lane == 63) tot[wave] = sc;
      __syncthreads();
      float base = sc - v[7];
      for (int w = 0; w < wave; ++w) base += tot[w];
      if (8 * tid < nval) {
#pragma unroll
          for (int i = 0; i < 8; ++i) cum[8 * tid + i] = v[i] + base; }
      __syncthreads(); }
    f32x16 O[1][2]; float M[1] = {0.f}, Ls[1] = {0.f};
#pragma unroll
    for (int i = 0; i < 16; ++i) { O[0][0][i] = 0.f; O[0][1][i] = 0.f; }
    const u64 tm = (qb == 15) ? ~0ull : ((1ull << (4 * qb + 4)) - 1ull);
#if AC2_MODE == 0
    {
        const u64 low = (1ull << (4 * qb)) - 1ull; const float cref = cum[256 * qb];
        const bf16* Kp = (const bf16*)(ws + WS_FQKV) + 8 * MiB + (size_t)bh * T_ * 64; const bf16* Vp = (const bf16*)(ws + WS_FQKV) + 16 * MiB + (size_t)bh * T_ * 64;
        attn_core<64, 1, true, false>(L, Kp, nullptr, Vp, cum, cref, Qf, tm & ~low, t_lane, tw0, 1 << 30, 0.f, 0u, 0u, O, M, Ls, tid);
        if (qb > 0) {
            const float qn2 = q_norm2_max<4>(Qf[0], lane), mmin = wave_min_l(M[0], lane);
            const float* kn = (const float*)((const unsigned*)(ws + WS_CTL) + CW_KN + l * 8192) + ((size_t)bh * 64 + lane) * 2;
            bool skip = false;
            if (lane < 4 * qb) { const float kn2 = kn[0] + kn[1]; const float bound = sqrtf(qn2 * kn2) * 1.02f + (cref - cum[64 * lane + 63]) * LOG2E - mmin; skip = bound < -152.f; }
            const u64 drop = prune_consensus(skip, (LAS u64*)(cum + 4096 + 16), wave, lane);
            const u64 tm2 = low & ~drop;
            if (tm2) attn_core<64, 1, true, false>(L, Kp, nullptr, Vp, cum, cref, Qf, tm2, t_lane, tw0, 1 << 30, 0.f, 0u, 0u, O, M, Ls, tid, true);
        }
    }
#else
    attn_core2<true, false>(L, (const bf16*)(ws + WS_FQKV) + 8 * MiB + (size_t)bh * T_ * 64, (const bf16*)(ws + WS_FQKV) + 16 * MiB + (size_t)bh * T_ * 64, cum, cum[256 * qb],
                            Qf[0], tm, t_lane, tw0, 1 << 30, 0.f, 0u, 0u, O[0], M[0], Ls[0], tid);
#endif
    const float lt = swap_sum(Ls[0]), inv = lt > 0.f ? 1.f / lt : 0.f;
    bf16* dst = (bf16*)(ws + WS_ATT) + mix_off((size_t)b * T_ + t_lane, 512 + hd * 64 + 4 * h, 1024);
    ATTN_FOR_CHUNKS(db, g4) { const unsigned w0 = cvtpk(O[0][db][4 * g4 + 0] * inv, O[0][db][4 * g4 + 1] * inv), w1 = cvtpk(O[0][db][4 * g4 + 2] * inv, O[0][db][4 * g4 + 3] * inv);
        *(u64*)(dst + (4 * db + g4) * 256) = (u64)w0 | ((u64)w1 << 32); }
}
__device__ __forceinline__ void U_diff(KP p_, int bh_, int qb_, int l_) {
    const KP p = uni_kp(p_); const int bh = __builtin_amdgcn_readfirstlane(bh_), qb = __builtin_amdgcn_readfirstlane(qb_), l = __builtin_amdgcn_readfirstlane(l_);
    int tid_ = threadIdx.x; asm volatile("" : "+v"(tid_));
    const int tid = tid_, lane = tid & 63, wave = __builtin_amdgcn_readfirstlane(tid >> 6), r = lane & 31, h = lane >> 5;
    unsigned char* ws = p->ws; asm volatile("" : "+s"(ws)); LAS unsigned char* L = (LAS unsigned char*)lds_raw;
    const int tw0 = 256 * qb + 32 * wave, t_lane = tw0 + r, b = bh >> 2, hd = bh & 3;
    const bf16* DQ = (const bf16*)(ws + WS_DQK); const bf16* DK = DQ + 8 * MiB;
    bf16x8v Qf[2][2];
#pragma unroll
    for (int mp = 0; mp < 2; ++mp)
#pragma unroll
        for (int s = 0; s < 2; ++s) Qf[mp][s] = *(const bf16x8v*)(DQ + ((size_t)(bh * 2 + mp) * T_ + t_lane) * 32 + 16 * s + 8 * h);
    f32x16 O[2][2]; float M[2] = {0.f, 0.f}, Ls[2] = {0.f, 0.f};
#pragma unroll
    for (int i = 0; i < 16; ++i) { O[0][0][i] = 0.f; O[0][1][i] = 0.f; O[1][0][i] = 0.f; O[1][1][i] = 0.f; }
    const u64 tm = (qb == 15) ? ~0ull : ((1ull << (4 * qb + 4)) - 1ull);
    {
        const u64 low = (1ull << (4 * qb)) - 1ull; const float slope2 = alibi_slope(hd + 1, 4) * LOG2E;
        const bf16* K0 = DK + (size_t)(bh * 2 + 0) * T_ * 32; const bf16* K1 = DK + (size_t)(bh * 2 + 1) * T_ * 32; const bf16* Vp = (const bf16*)(ws + WS_DV) + (size_t)bh * T_ * 64;
        attn_core<32, 2, false, false>(L, K0, K1, Vp, nullptr, 0.f, Qf, tm & ~low, t_lane, tw0, 1 << 30, slope2, 0u, 0u, O, M, Ls, tid);
        if (qb > 0) {
            const float qa = q_norm2_max<2>(Qf[0], lane), qb2 = q_norm2_max<2>(Qf[1], lane), ma = wave_min_l(M[0], lane), mb = wave_min_l(M[1], lane);
            const float* kn = (const float*)((const unsigned*)(ws + WS_CTL) + CW_KN + l * 8192 + 4096) + (size_t)(bh * 2) * 64 + lane;
            bool skip = false;
            if (lane < 4 * qb) { const float bmax = slope2 * (float)(64 * lane + 63 - tw0);
                skip = (sqrtf(qa * kn[0]) * 1.02f + bmax - ma < -152.f) && (sqrtf(qb2 * kn[64]) * 1.02f + bmax - mb < -152.f); }
            const u64 drop = prune_consensus(skip, (LAS u64*)(L + A_LDS_END), wave, lane);
            const u64 tm2 = low & ~drop;
            if (tm2) attn_core<32, 2, false, false>(L, K0, K1, Vp, nullptr, 0.f, Qf, tm2, t_lane, tw0, 1 << 30, slope2, 0u, 0u, O, M, Ls, tid, true);
        }
    }
    const float* lam = p->in[11] + (size_t)l * 128; const float* subln = p->in[12] + (size_t)l * 64;
    float l1 = 0.f, l2 = 0.f; if (lane < 32) { l1 = lam[lane] * lam[32 + lane]; l2 = lam[64 + lane] * lam[96 + lane]; }
    const float li = lambda_init_of(l), lam_full = __expf(wave_sum_l(l1, lane)) - __expf(wave_sum_l(l2, lane)) + li;
    const float lt0 = swap_sum(Ls[0]), lt1 = swap_sum(Ls[1]), i0 = lt0 > 0.f ? 1.f / lt0 : 0.f, i1 = (lt1 > 0.f ? 1.f / lt1 : 0.f) * lam_full;
    float ss = 0.f;
#pragma unroll
    for (int db = 0; db < 2; ++db)
#pragma unroll
        for (int i = 0; i < 16; ++i) { const float o = O[0][db][i] * i0 - O[1][db][i] * i1; O[0][db][i] = o; ss += o * o; }
    ss = swap_sum(ss);
    const float rn = rsqrtf(ss * (1.f / 64.f) + EPS) * (1.f - li);
    bf16* dst = (bf16*)(ws + WS_ATT) + mix_off((size_t)b * T_ + t_lane, 768 + hd * 64 + 4 * h, 1024);
    ATTN_FOR_CHUNKS(db, g4) { const f32x4 sg = *(const f32x4*)(subln + 32 * db + 8 * g4 + 4 * h);
        const unsigned w0 = cvtpk(O[0][db][4 * g4 + 0] * rn * sg.x, O[0][db][4 * g4 + 1] * rn * sg.y), w1 = cvtpk(O[0][db][4 * g4 + 2] * rn * sg.z, O[0][db][4 * g4 + 3] * rn * sg.w);
        *(u64*)(dst + (4 * db + g4) * 256) = (u64)w0 | ((u64)w1 << 32); }
}
__device__ __forceinline__ void U_win(KP p_, int bg_, int c_) {
    const KP p = uni_kp(p_); const int bg = __builtin_amdgcn_readfirstlane(bg_), cc = __builtin_amdgcn_readfirstlane(c_);
    int tid_ = threadIdx.x; asm volatile("" : "+v"(tid_));
    const int tid = tid_, lane = tid & 63, wave = __builtin_amdgcn_readfirstlane(tid >> 6), r = lane & 31, h = lane >> 5;
    unsigned char* ws = p->ws; asm volatile("" : "+s"(ws)); LAS unsigned char* L = (LAS unsigned char*)lds_raw;
    const int b = bg >> 1, g = bg & 1, hd = g * 4 + (wave >> 1), tw0 = 64 * cc + 32 * (wave & 1), t_lane = tw0 + r;
    const bf16* q = (const bf16*)(ws + WS_QN) + (size_t)(b * 8 + hd) * T_ * 64 + (t_lane >> 4) * 1024 + (t_lane & 15) * 32 + 8 * h;
    bf16x8v Qf[1][4];
#pragma unroll
    for (int s = 0; s < 4; ++s) Qf[0][s] = *(const bf16x8v*)(q + (s >> 1) * 512 + (s & 1) * 16);
    f32x16 O[1][2]; float M[1] = {0.f}, Ls[1] = {0.f};
#pragma unroll
    for (int i = 0; i < 16; ++i) { O[0][0][i] = 0.f; O[0][1][i] = 0.f; }
    const int jlo = cc > 8 ? cc - 8 : 0;
    const u64 hi = (cc == 63) ? ~0ull : ((1ull << (cc + 1)) - 1ull), tm = hi & ~((1ull << jlo) - 1ull);
#if AC2_MODE == 0
    attn_core<64, 1, false, false>(L, (const bf16*)(ws + WS_KV6 + 4 * KV6_STRIDE) + (size_t)bg * T_ * 64, nullptr, (const bf16*)(ws + WS_KV6 + 5 * KV6_STRIDE) + (size_t)bg * T_ * 64, nullptr, 0.f,
                                   Qf, tm, t_lane, tw0, 512, alibi_slope(hd + 1, 8) * LOG2E, 0u, 0u, O, M, Ls, tid);
#else
    attn_core2<false, false>(L, (const bf16*)(ws + WS_KV6 + 4 * KV6_STRIDE) + (size_t)bg * T_ * 64, (const bf16*)(ws + WS_KV6 + 5 * KV6_STRIDE) + (size_t)bg * T_ * 64, nullptr, 0.f,
                             Qf[0], tm, t_lane, tw0, 512, alibi_slope(hd + 1, 8) * LOG2E, 0u, 0u, O[0], M[0], Ls[0], tid);
#endif
    const size_t n = (size_t)b * T_ + t_lane;
    const float lt = swap_sum(Ls[0]), inv = (lt > 0.f ? 1.f / lt : 0.f) * ((const float*)(ws + WS_GATE))[n * 24 + hd * 3 + 2];
    bf16* dst = (bf16*)(ws + WS_OWIN) + mix_off(n, hd * 64 + 4 * h, 512);
    ATTN_FOR_CHUNKS(db, g4) { const unsigned w0 = cvtpk(O[0][db][4 * g4 + 0] * inv, O[0][db][4 * g4 + 1] * inv), w1 = cvtpk(O[0][db][4 * g4 + 2] * inv, O[0][db][4 * g4 + 3] * inv);
        *(u64*)(dst + (4 * db + g4) * 256) = (u64)w0 | ((u64)w1 << 32); }
}
__device__ __forceinline__ void U_slc(KP p_, int bg_, int c_) {
    const KP p = uni_kp(p_); const int bg = __builtin_amdgcn_readfirstlane(bg_), cc = __builtin_amdgcn_readfirstlane(c_);
    int tid_ = threadIdx.x; asm volatile("" : "+v"(tid_));
    const int tid = tid_, lane = tid & 63, wave = __builtin_amdgcn_readfirstlane(tid >> 6), r = lane & 31, h = lane >> 5;
    unsigned char* ws = p->ws; asm volatile("" : "+s"(ws)); LAS unsigned char* L = (LAS unsigned char*)lds_raw;
    const int b = bg >> 1, g = bg & 1, hd = g * 4 + (wave >> 1), tw0 = 64 * cc + 32 * (wave & 1), t_lane = tw0 + r;
    const bf16* q = (const bf16*)(ws + WS_QN) + (size_t)(b * 8 + hd) * T_ * 64 + (t_lane >> 4) * 1024 + (t_lane & 15) * 32 + 8 * h;
    bf16x8v Qf[1][4];
#pragma unroll
    for (int s = 0; s < 4; ++s) Qf[0][s] = *(const bf16x8v*)(q + (s >> 1) * 512 + (s & 1) * 16);
    f32x16 O[1][2]; float M[1] = {0.f}, Ls[1] = {0.f};
#pragma unroll
    for (int i = 0; i < 16; ++i) { O[0][0][i] = 0.f; O[0][1][i] = 0.f; }
    const u64* sel = (const u64*)(ws + WS_SEL) + (size_t)bg * T_;
    const u64 mine = sel[t_lane]; u64 un = sel[64 * cc + lane];
    { unsigned ul = (unsigned)un, uh = (unsigned)(un >> 32);
#pragma unroll
      for (int o = 1; o < 64; o <<= 1) { ul |= shflx_u(ul, o, lane); uh |= shflx_u(uh, o, lane); }
      un = ((u64)__builtin_amdgcn_readfirstlane(uh) << 32) | __builtin_amdgcn_readfirstlane(ul); }
#if AC2_MODE == 0
    attn_core<64, 1, false, true>(L, (const bf16*)(ws + WS_KV6 + 2 * KV6_STRIDE) + (size_t)bg * T_ * 64, nullptr, (const bf16*)(ws + WS_KV6 + 3 * KV6_STRIDE) + (size_t)bg * T_ * 64, nullptr, 0.f,
                                  Qf, un, t_lane, tw0, 1 << 30, alibi_slope(hd + 1, 8) * LOG2E, (unsigned)mine, (unsigned)(mine >> 32), O, M, Ls, tid);
#else
    attn_core2<false, true>(L, (const bf16*)(ws + WS_KV6 + 2 * KV6_STRIDE) + (size_t)bg * T_ * 64, (const bf16*)(ws + WS_KV6 + 3 * KV6_STRIDE) + (size_t)bg * T_ * 64, nullptr, 0.f,
                            Qf[0], un, t_lane, tw0, 1 << 30, alibi_slope(hd + 1, 8) * LOG2E, (unsigned)mine, (unsigned)(mine >> 32), O[0], M[0], Ls[0], tid);
#endif
    const size_t n = (size_t)b * T_ + t_lane;
    const float lt = swap_sum(Ls[0]), inv = (lt > 0.f ? 1.f / lt : 0.f) * ((const float*)(ws + WS_GATE))[n * 24 + hd * 3 + 1];
    const bf16* oc = (const bf16*)(ws + WS_OCMP) + mix_off(n, hd * 64 + 4 * h, 512); const bf16* ow = (const bf16*)(ws + WS_OWIN) + mix_off(n, hd * 64 + 4 * h, 512);
    bf16* dst = (bf16*)(ws + WS_ATT) + mix_off(n, hd * 64 + 4 * h, 1024);
    ATTN_FOR_CHUNKS(db, g4) { const u64 a = *(const u64*)(oc + (4 * db + g4) * 256), w = *(const u64*)(ow + (4 * db + g4) * 256);
        const float x0 = O[0][db][4 * g4 + 0] * inv + __uint_as_float((unsigned)a << 16) + __uint_as_float((unsigned)w << 16);
        const float x1 = O[0][db][4 * g4 + 1] * inv + __uint_as_float((unsigned)a & 0xffff0000u) + __uint_as_float((unsigned)w & 0xffff0000u);
        const float x2 = O[0][db][4 * g4 + 2] * inv + __uint_as_float((unsigned)(a >> 32) << 16) + __uint_as_float((unsigned)(w >> 32) << 16);
        const float x3 = O[0][db][4 * g4 + 3] * inv + __uint_as_float((unsigned)(a >> 32) & 0xffff0000u) + __uint_as_float((unsigned)(w >> 32) & 0xffff0000u);
        *(u64*)(dst + (4 * db + g4) * 256) = (u64)cvtpk(x0, x1) | ((u64)cvtpk(x2, x3) << 32); }
}
__device__ __forceinline__ float other_half(float x, int h) { auto rr = __builtin_amdgcn_permlane32_swap(__float_as_uint(x), __float_as_uint(x), false, false); return __uint_as_float(h ? rr[0] : rr[1]); }
__device__ __forceinline__ int other_half_i(int x, int h) { auto rr = __builtin_amdgcn_permlane32_swap((unsigned)x, (unsigned)x, false, false); return (int)(h ? rr[0] : rr[1]); }
template <bool MASK>
__device__ __forceinline__ void cmp_scores(f32x16& p0, f32x16& p1, const LAS unsigned char* kt, const bf16x8v (&Qf)[4], float b0, float s1, int cl, int nvis_l) {
    const float s8 = s1 * 8.f, s32 = s1 * 32.f;
    p0[0] = b0; p0[1] = p0[0] + s1; p0[2] = p0[1] + s1; p0[3] = p0[2] + s1;
#pragma unroll
    for (int reg = 4; reg < 16; ++reg) p0[reg] = p0[reg - 4] + s8;
#pragma unroll
    for (int reg = 0; reg < 16; ++reg) p1[reg] = p0[reg] + s32;
#pragma unroll
    for (int s = 0; s < 4; ++s) { const bf16x8v kf0 = *(const LAS bf16x8v*)(kt + s * 32), kf1 = *(const LAS bf16x8v*)(kt + 32 * 144 + s * 32);
        p0 = __builtin_amdgcn_mfma_f32_32x32x16_bf16(kf0, Qf[s], p0, 0, 0, 0); p1 = __builtin_amdgcn_mfma_f32_32x32x16_bf16(kf1, Qf[s], p1, 0, 0, 0); }
    if (MASK) {
#pragma unroll
        for (int reg = 0; reg < 16; ++reg) { const int c = cl + crow0(reg); p0[reg] = (c < nvis_l) ? p0[reg] : -INFINITY; p1[reg] = (c + 32 < nvis_l) ? p1[reg] : -INFINITY; } }
}
__device__ __forceinline__ void U_cmp(KP p_, int bg_, int u_) {
    const KP p = uni_kp(p_); const int bg = __builtin_amdgcn_readfirstlane(bg_), uu = __builtin_amdgcn_readfirstlane(u_);
    int tid_ = threadIdx.x; asm volatile("" : "+v"(tid_));
    const int tid = tid_, lane = tid & 63, wave = __builtin_amdgcn_readfirstlane(tid >> 6), r = lane & 31, h = lane >> 5;
    unsigned char* ws = p->ws; asm volatile("" : "+s"(ws)); LAS unsigned char* L = (LAS unsigned char*)lds_raw;
    const int b = bg >> 1, g = bg & 1, tw0 = 32 * (uu + 16 * wave), t_lane = tw0 + r;
    { const bf16* kc = (const bf16*)(ws + WS_KVCMP) + (size_t)bg * 256 * 64; const bf16* vc = kc + 16 * 256 * 64;
#pragma unroll
      for (int i = 0; i < 4; ++i) { const int ch = tid + 512 * i, row = ch >> 3, c8 = ch & 7;
          *(LAS u32x4*)(L + row * 144 + c8 * 16) = *(const u32x4*)(kc + row * 64 + c8 * 8); *(LAS u32x4*)(L + 36864 + row * 144 + c8 * 16) = *(const u32x4*)(vc + row * 64 + c8 * 8); } }
    __syncthreads();
    const int nvis_l = t_lane >= 31 ? ((t_lane - 31) >> 4) + 1 : 0, nvis_max = (tw0 >> 4) + 1, nvis_min = tw0 >= 31 ? ((tw0 - 31) >> 4) + 1 : 0, ntile = (nvis_max + 63) >> 6;
    const LAS unsigned char* kfrag = L + r * 144 + h * 16;
    const LAS unsigned char* vfrag = L + 36864 + (4 * h + ((lane & 15) >> 2)) * 144 + (16 * ((lane >> 4) & 1) + 4 * (lane & 3)) * 2;
    float imp[32];
#pragma unroll
    for (int e = 0; e < 32; ++e) imp[e] = 0.f;
    const float* gate = (const float*)(ws + WS_GATE) + ((size_t)b * T_ + t_lane) * 24;
#pragma unroll 1
    for (int hg = 0; hg < 4; ++hg) {
        const int hd = g * 4 + hg; const float s1 = alibi_slope(hd + 1, 8) * LOG2E * 16.f;
        const bf16* q = (const bf16*)(ws + WS_QN) + (size_t)(b * 8 + hd) * T_ * 64 + (t_lane >> 4) * 1024 + (t_lane & 15) * 32 + 8 * h;
        bf16x8v Qf[4];
#pragma unroll
        for (int s = 0; s < 4; ++s) Qf[s] = *(const bf16x8v*)(q + (s >> 1) * 512 + (s & 1) * 16);
        float m = -1e30f, lsum = 0.f;
#pragma unroll 1
        for (int jt = 0; jt < ntile; ++jt) {
            f32x16 p0, p1; const float b0 = s1 * (float)(64 * jt + 4 * h - nvis_max);
            if (64 * jt + 63 >= nvis_min) cmp_scores<true>(p0, p1, kfrag + jt * (64 * 144), Qf, b0, s1, 64 * jt + 4 * h, nvis_l);
            else cmp_scores<false>(p0, p1, kfrag + jt * (64 * 144), Qf, b0, s1, 64 * jt + 4 * h, nvis_l);
            float mt = fmaxf(p0[0], p1[0]);
#pragma unroll
            for (int reg = 1; reg < 16; ++reg) mt = fmaxf(mt, fmaxf(p0[reg], p1[reg]));
            mt = swap_max(mt);
            const float mn = fmaxf(m, mt); float rs = 0.f;
#pragma unroll
            for (int reg = 0; reg < 16; ++reg) rs += __builtin_amdgcn_exp2f(p0[reg] - mn) + __builtin_amdgcn_exp2f(p1[reg] - mn);
            lsum = lsum * __builtin_amdgcn_exp2f(m - mn) + rs; m = mn;
        }
        const float lt = swap_sum(lsum), inv = lt > 0.f ? 1.f / lt : 0.f;
        f32x16 O0, O1;
#pragma unroll
        for (int i = 0; i < 16; ++i) { O0[i] = 0.f; O1[i] = 0.f; }
        float carry = 0.f;
#pragma unroll
        for (int jt = 0; jt < 4; ++jt) if (jt < ntile) {
            f32x16 p0, p1; const float b0 = s1 * (float)(64 * jt + 4 * h - nvis_max);
            if (64 * jt + 63 >= nvis_min) cmp_scores<true>(p0, p1, kfrag + jt * (64 * 144), Qf, b0, s1, 64 * jt + 4 * h, nvis_l);
            else cmp_scores<false>(p0, p1, kfrag + jt * (64 * 144), Qf, b0, s1, 64 * jt + 4 * h, nvis_l);
#pragma unroll
            for (int reg = 0; reg < 16; ++reg) { p0[reg] = __builtin_amdgcn_exp2f(p0[reg] - m) * inv; p1[reg] = __builtin_amdgcn_exp2f(p1[reg] - m) * inv; }
            float cv[8];
#pragma unroll
            for (int g4 = 0; g4 < 4; ++g4) { const float h0 = 0.5f * p0[4 * g4 + 3], h1 = 0.5f * p1[4 * g4 + 3];
                imp[jt * 8 + g4] += ((p0[4 * g4] + p0[4 * g4 + 1]) + p0[4 * g4 + 2]) + h0; imp[jt * 8 + 4 + g4] += ((p1[4 * g4] + p1[4 * g4 + 1]) + p1[4 * g4 + 2]) + h1;
                cv[g4] = h0; cv[4 + g4] = h1; }
            float prev = carry;
#pragma unroll
            for (int k = 0; k < 8; ++k) { const float sv = other_half(cv[k], h); imp[jt * 8 + k] += h ? sv : prev; prev = sv; }
            carry = prev;
            const bf16x8v pa0 = pack8(p0, 0), pa1 = pack8(p0, 8), pa2 = pack8(p1, 0), pa3 = pack8(p1, 8);
            const LAS unsigned char* vb = vfrag + jt * (64 * 144);
#pragma unroll
            for (int ks = 0; ks < 4; ++ks) { const bf16x8v pa = ks == 0 ? pa0 : ks == 1 ? pa1 : ks == 2 ? pa2 : pa3;
                { const s16x4 lo = tr_read(vb + ks * (16 * 144)), hi = tr_read(vb + ks * (16 * 144) + 8 * 144); const bf16x8v vf = {lo[0], lo[1], lo[2], lo[3], hi[0], hi[1], hi[2], hi[3]};
                  O0 = __builtin_amdgcn_mfma_f32_32x32x16_bf16(vf, pa, O0, 0, 0, 0); }
                { const s16x4 lo = tr_read(vb + ks * (16 * 144) + 64), hi = tr_read(vb + ks * (16 * 144) + 64 + 8 * 144); const bf16x8v vf = {lo[0], lo[1], lo[2], lo[3], hi[0], hi[1], hi[2], hi[3]};
                  O1 = __builtin_amdgcn_mfma_f32_32x32x16_bf16(vf, pa, O1, 0, 0, 0); } }
        }
        const float gt = gate[hd * 3 + 0];
        bf16* dst = (bf16*)(ws + WS_OCMP) + mix_off((size_t)b * T_ + t_lane, hd * 64 + 4 * h, 512);
#pragma unroll
        for (int g4 = 0; g4 < 4; ++g4) {
            *(u64*)(dst + g4 * 256) = (u64)cvtpk(O0[4 * g4 + 0] * gt, O0[4 * g4 + 1] * gt) | ((u64)cvtpk(O0[4 * g4 + 2] * gt, O0[4 * g4 + 3] * gt) << 32);
            *(u64*)(dst + (4 + g4) * 256) = (u64)cvtpk(O1[4 * g4 + 0] * gt, O1[4 * g4 + 1] * gt) | ((u64)cvtpk(O1[4 * g4 + 2] * gt, O1[4 * g4 + 3] * gt) << 32); }
    }
    const int cur = tw0 >> 6; u64 mask;
    if (cur <= 15) mask = (1ull << (cur + 1)) - 1ull;
    else {
        mask = 1ull | (1ull << cur) | (1ull << (cur - 1));
#pragma unroll
        for (int e = 0; e < 32; ++e) { const int j = 2 * e + h; if (j > cur || j == 0 || j >= cur - 1) imp[e] = -INFINITY; }
#pragma unroll 1
        for (int round = 0; round < 13; ++round) {
            float bv = imp[0]; int be = 0;
#pragma unroll
            for (int e = 1; e < 32; ++e) if (imp[e] > bv) { bv = imp[e]; be = e; }
            const int bj = 2 * be + h; const float ov = other_half(bv, h); const int oj = other_half_i(bj, h);
            const bool mine = bv > ov || (bv == ov && bj < oj);
            mask |= 1ull << (mine ? bj : oj);
#pragma unroll
            for (int e = 0; e < 32; ++e) imp[e] = (mine && e == be) ? -INFINITY : imp[e];
        }
    }
    if (h == 0) ((u64*)(ws + WS_SEL))[(size_t)bg * T_ + t_lane] = mask;
    __syncthreads();
}
constexpr int CONV_UNITS = L_ * NEXP * (2 * 16 * 8 + 4 * 32) / 32;
__device__ __forceinline__ void U_conv(KP p_, int k_) {
    const KP p = uni_kp(p_); const int k = __builtin_amdgcn_readfirstlane(k_);
    int tid_ = threadIdx.x; asm volatile("" : "+v"(tid_));
    const int tid = tid_, lane = tid & 63, wave = __builtin_amdgcn_readfirstlane(tid >> 6);
    unsigned char* ws = p->ws; asm volatile("" : "+s"(ws));
    LAS float* scr = (LAS float*)lds_raw + wave * (64 * 33);
    constexpr int I_G = 16 * 8, I_D = 4 * 32, I_E = 2 * I_G + I_D;
#pragma unroll 1
    for (int i = 0; i < 4; ++i) {
        const int m = k * 32 + i * 8 + wave, l = m / (NEXP * I_E); int r = m % (NEXP * I_E); const int e = r / I_E; r = r % I_E; const size_t le = (size_t)l * NEXP + e;
        const float* W; bf16* WT; int ldw, K, ncol, r0 = 0, rmul = 1; const float* gk = nullptr;
        if (r < 2 * I_G) { const int up = r >= I_G; r -= up * I_G; W = p->in[19 + up] + le * D_ * DEXP; WT = (bf16*)(ws + WS_WGU_T) + le * 512 * D_; ldw = DEXP; K = D_; ncol = 256; r0 = up; rmul = 2; gk = p->in[14] + (size_t)l * D_; }
        else { r -= 2 * I_G; W = p->in[21] + le * DEXP * D_; WT = (bf16*)(ws + WS_WD_T) + le * D_ * DEXP; ldw = D_; K = DEXP; ncol = 1024; }
        transpose_seg(W, ldw, K, 0, ncol, WT, r0, rmul, r, scr, lane, gk);
    }
}
__device__ __forceinline__ int fetch_unit(KP p, int qidx) {
    volatile LAS unsigned* slot = (volatile LAS unsigned*)((LAS unsigned char*)lds_raw + MISC_OFF) + 16;
    __syncthreads();
    int t0_ = threadIdx.x; asm volatile("" : "+v"(t0_));
    if (t0_ == 0) *slot = __hip_atomic_fetch_add((unsigned*)(p->ws + WS_CTL) + CW_QUEUE + 64 * qidx, 1u, __ATOMIC_RELAXED, __HIP_MEMORY_SCOPE_AGENT);
    __syncthreads();
    return (int)__builtin_amdgcn_readfirstlane(*slot);
}
__device__ __forceinline__ void P_cmp1_mfma(int l_) { const KP p = (KP)__builtin_amdgcn_kernarg_segment_ptr(); int l = l_; asm volatile("" : "+s"(l));
    unsigned char* ws = p->ws; asm volatile("" : "+s"(ws)); const int c = launder_s((int)blockIdx.x), kv = c >> 4, pm = c & 15;
    OneUnitOrder S; S.has = c < 32; S.u.pm = pm; S.u.pn = kv;
    S.u.a = (const char*)(ws + WS_KV6 + (size_t)kv * KV6_STRIDE) + (size_t)pm * 256 * 1024 * 2; S.u.b = (const char*)((const bf16*)(ws + WS_W1_T) + ((size_t)l * 2 + kv) * 256 * 2048); S.u.b2 = S.u.b;
    const pg8::Gemm g{1024, 2048, 2048, 32, 0, 0};
    const EpiCmpH E{(bf16*)(ws + WS_HC), (const float*)(ws + WS_BIAS1) + l * 512};
    pg8::gemm_phase<EpiCmpH, OneUnitOrder, false, true>((LAS unsigned char*)lds_raw, g, S, E);
}
__device__ __forceinline__ void P_cmp2_mfma(int l_) { const KP p = (KP)__builtin_amdgcn_kernarg_segment_ptr(); int l = l_; asm volatile("" : "+s"(l));
    unsigned char* ws = p->ws; asm volatile("" : "+s"(ws)); const int c = launder_s((int)blockIdx.x), kv = c >> 4, pm = c & 15;
    OneUnitOrder S; S.has = c < 32; S.u.pm = pm; S.u.pn = kv;
    S.u.a = (const char*)((const bf16*)(ws + WS_HC) + ((size_t)kv * 4096 + pm * 256) * 256); S.u.b = (const char*)((const bf16*)(ws + WS_W2_T) + ((size_t)l * 2 + kv) * 64 * 256); S.u.b2 = S.u.b;
    const pg8::Gemm g{256, 256, 256, 4, 0, 0};
    const EpiCmpOut E{(bf16*)(ws + WS_KVCMP)};
    pg8::gemm_phase<EpiCmpOut, OneUnitOrder, false, true>((LAS unsigned char*)lds_raw, g, S, E);
}
__device__ __forceinline__ void P_moe_scatter(KP p_, int l_) { const KP p = uni_kp(p_); const int l = __builtin_amdgcn_readfirstlane(l_); const Ctx c = make_ctx(p); unsigned char* ws = p->ws;
    const unsigned* cnt = (const unsigned*)(ws + WS_CTL) + CW_MOECNT + l * MOE_LS;
    moe_build_tables(cnt, c.tid);
    const LAS int* T = (const LAS int*)((LAS unsigned char*)lds_raw + TBL_OFF);
    const unsigned* info = (const unsigned*)(ws + WS_ROUTE + RT_INFO); const float* tw = (const float*)(ws + WS_ROUTE + RT_W);
    int* rowtok = (int*)(ws + WS_ROUTE + RT_ROWTOK); float* roww = (float*)(ws + WS_ROUTE + RT_ROWW);
    bf16* xs = (bf16*)(ws + WS_XS); const bf16* x = (const bf16*)(ws + WS_HN); const float* gain = p->in[14] + (size_t)l * D_; const float* rstdv = (const float*)(ws + WS_ROUTE + RT_RSTD);
    { constexpr int RB = 4; float gg[2][8];
#pragma unroll
      for (int j = 0; j < 2; ++j) { const f32x4 a = ((const f32x4*)gain)[2 * c.lane + 128 * j], b2 = ((const f32x4*)gain)[2 * c.lane + 128 * j + 1]; gg[j][0] = a.x; gg[j][1] = a.y; gg[j][2] = a.z; gg[j][3] = a.w; gg[j][4] = b2.x; gg[j][5] = b2.y; gg[j][6] = b2.z; gg[j][7] = b2.w; }
      for (int row0 = c.gw * RB; row0 < NT; row0 += c.ngw * RB) {
        u32x4 vv[RB][2];
#pragma unroll
        for (int q = 0; q < RB; ++q)
#pragma unroll
            for (int j = 0; j < 2; ++j) vv[q][j] = ((const u32x4*)(x + (size_t)(row0 + q) * D_))[c.lane + 64 * j];
#pragma unroll
        for (int q = 0; q < RB; ++q) { const int row = row0 + q;
            const unsigned v = info[row]; const int cls = (int)(v >> 24), rank = (int)(v & 0xffffffu); const size_t dest = (size_t)T[cls] * 256 + rank; const float r = rstdv[row];
#pragma unroll
            for (int j = 0; j < 2; ++j) { float f[8]; unpack8(vv[q][j], f); u32x4 o; o.x = pk2(f[0] * r * gg[j][0], f[1] * r * gg[j][1]); o.y = pk2(f[2] * r * gg[j][2], f[3] * r * gg[j][3]); o.z = pk2(f[4] * r * gg[j][4], f[5] * r * gg[j][5]); o.w = pk2(f[6] * r * gg[j][6], f[7] * r * gg[j][7]);
                ((u32x4*)(xs + dest * D_))[c.lane + 64 * j] = o; }
            if (c.lane == 0) { rowtok[dest] = row; roww[2 * dest] = tw[2 * row]; roww[2 * dest + 1] = tw[2 * row + 1]; } }
      } }
    for (int cls = c.bid; cls < 112; cls += c.G) { const int n = (int)cnt[cls * MOE_CS], end = (int)((cnt[cls * MOE_CS] + 255u) >> 8) * 256; const size_t base = (size_t)T[cls] * 256;
        for (int r = n + c.tid; r < end; r += NTHREADS) rowtok[base + r] = -1; }
}
__device__ __forceinline__ void P_moe_g1(int l_) { const KP p = (KP)__builtin_amdgcn_kernarg_segment_ptr(); int l = l_; asm volatile("" : "+s"(l));
    unsigned char* ws = p->ws; asm volatile("" : "+s"(ws));
    { int t0_ = threadIdx.x; asm volatile("" : "+v"(t0_)); moe_build_tables((const unsigned*)(ws + WS_CTL) + CW_MOECNT + l * MOE_LS, t0_); }
    const MoeOrder1 S{(const char*)ws, (const unsigned*)(ws + WS_REC), (const char*)((const bf16*)(ws + WS_WGU_T) + (size_t)l * NEXP * 512 * D_), (int)gridDim.x, launder_s((int)blockIdx.x)};
    const pg8::Gemm g{D_, D_, D_, D_ / 64, 0, 0};
    const EpiMoeH E{(bf16*)(ws + WS_HB), (const u32x4*)(ws + WS_REC)};
    pg8::gemm_phase<EpiMoeH, MoeOrder1, true, true, true>((LAS unsigned char*)lds_raw, g, S, E);
}
__device__ __forceinline__ void P_moe_g2(int l_) { const KP p = (KP)__builtin_amdgcn_kernarg_segment_ptr(); int l = l_; asm volatile("" : "+s"(l));
    unsigned char* ws = p->ws; asm volatile("" : "+s"(ws));
    { int t0_ = threadIdx.x; asm volatile("" : "+v"(t0_)); moe_build_tables((const unsigned*)(ws + WS_CTL) + CW_MOECNT + l * MOE_LS, t0_); }
    const MoeOrder2 S{(const char*)(ws + WS_HB), (const char*)((const bf16*)(ws + WS_WD_T) + (size_t)l * NEXP * D_ * DEXP), (int)gridDim.x, launder_s((int)blockIdx.x)};
    const pg8::Gemm g{512, DEXP, 512, 4, 16, 16};
    const EpiMoeOut E{(bf16*)(ws + WS_HN), (const unsigned*)(ws + WS_REC)};
    pg8::gemm_phase<EpiMoeOut, MoeOrder2, true, true>((LAS unsigned char*)lds_raw, g, S, E);
}
__device__ __forceinline__ void P_norm1(KP p_, int l_) { const KP p = uni_kp(p_); const int l = __builtin_amdgcn_readfirstlane(l_); const Ctx c = make_ctx(p); const Bufs b = make_bufs(p->ws);
    if (l == 0) { const int i = c.bid * NTHREADS + c.tid; if (i < L_ * 2 * 256) { const float* part = (const float*)(p->ws + WS_B1PART) + (size_t)(i >> 8) * 128 * 256 + (i & 255); float a = 0.f;
        for (int k = 0; k < 128; ++k) a += part[(size_t)k * 256]; ((float*)(p->ws + WS_BIAS1))[i] = a; } }
    if (l == 0) ph_norm_bf16(c, p->in[0], p->in[1], (bf16*)p->out, (bf16*)(p->ws + WS_HN)); else ph_norm_bf16_from_bf16(c, (const bf16*)(p->ws + WS_HN), p->in[1] + (size_t)l * D_, (bf16*)p->out); }
__device__ __noinline__ void P_inproj(KP p_, int l_) { const KP p = uni_kp(p_); const int l = __builtin_amdgcn_readfirstlane(l_); const Ctx c = make_ctx(p); const Bufs b = make_bufs(p->ws);
    InProjOut o{b.QN, b.KV6, b.FQ, b.DQ, b.DV, b.GATE, b.FL, p->in[3] + l * 24, p->in[4] + l * 4};
    const bf16* A = b.HN;
    naive_gemm(c, NT, D_IN, D_, [=](int r, int k) { return bf2f(A[(size_t)r * D_ + k]); }, p->in[2] + (size_t)l * D_ * D_IN, D_IN,
               [=](int r, int col, float v) { inproj_store(o, r, col, v); }); }
__device__ __noinline__ void P_cmp1(KP p_, int l_, int kv_) { const KP p = uni_kp(p_); const int l = __builtin_amdgcn_readfirstlane(l_), kv = __builtin_amdgcn_readfirstlane(kv_); const Ctx c = make_ctx(p); const Bufs b = make_bufs(p->ws);
    const bf16* src = kv == 0 ? b.KC : b.VC; const float* pe = p->in[kv == 0 ? 5 : 8] + (size_t)l * 2048; bf16* hc = b.HC + (size_t)kv * 4096 * 256;
    naive_gemm(c, 4096, 256, 2048, [=](int r, int k) { return bf2f(src[(size_t)r * 1024 + k]) + pe[k]; }, p->in[kv == 0 ? 6 : 9] + (size_t)l * 2048 * 256, 256,
               [=](int r, int col, float v) { hc[(size_t)r * 256 + col] = (bf16)f2bf(gelu_tanh(v)); }); }
__device__ __noinline__ void P_cumsum(KP p_, int l_) { const KP p = uni_kp(p_); const int l = __builtin_amdgcn_readfirstlane(l_); const Ctx c = make_ctx(p); const Bufs b = make_bufs(p->ws); ph_cumsum(c, b.FL); }
__device__ __noinline__ void P_cmp2(KP p_, int l_, int kv_) { const KP p = uni_kp(p_); const int l = __builtin_amdgcn_readfirstlane(l_), kv = __builtin_amdgcn_readfirstlane(kv_); const Ctx c = make_ctx(p); const Bufs b = make_bufs(p->ws);
    const bf16* hc = b.HC + (size_t)kv * 4096 * 256; bf16* dst = kv == 0 ? b.KCMP : b.VCMP;
    naive_gemm(c, 4096, 64, 256, [=](int r, int k) { return bf2f(hc[(size_t)r * 256 + k]); }, p->in[kv == 0 ? 7 : 10] + (size_t)l * 256 * 64, 64,
               [=](int r, int col, float v) { dst[(size_t)r * 64 + col] = (bf16)f2bf((r & 255) == 255 ? 0.f : v); }); }
__device__ __noinline__ void P_win(KP p_, int l_) { const KP p = uni_kp(p_); const int l = __builtin_amdgcn_readfirstlane(l_); const Ctx c = make_ctx(p); const Bufs b = make_bufs(p->ws); ph_win_attn(c, b.QN, b.KW, b.VW, b.GATE, b.OWIN); }
__device__ __noinline__ void P_fox(KP p_, int l_) { const KP p = uni_kp(p_); const int l = __builtin_amdgcn_readfirstlane(l_); const Ctx c = make_ctx(p); const Bufs b = make_bufs(p->ws); ph_fox_attn(c, b.FQ, b.FK, b.FV, b.FL, b.ATT); }
__device__ __noinline__ void P_diff(KP p_, int l_) { const KP p = uni_kp(p_); const int l = __builtin_amdgcn_readfirstlane(l_); const Ctx c = make_ctx(p); const Bufs b = make_bufs(p->ws);
    ph_diff_attn(c, b.DQ, b.DK, b.DV, p->in[11] + (size_t)l * 128, p->in[12] + (size_t)l * 64, lambda_init_of(l), b.ATT); }
__device__ __noinline__ void P_cmpattn(KP p_, int l_) { const KP p = uni_kp(p_); const int l = __builtin_amdgcn_readfirstlane(l_); const Ctx c = make_ctx(p); const Bufs b = make_bufs(p->ws); ph_cmp_attn(c, b.QN, b.KCMP, b.VCMP, b.GATE, b.SEL, b.OCMP); }
__device__ __noinline__ void P_slc(KP p_, int l_) { const KP p = uni_kp(p_); const int l = __builtin_amdgcn_readfirstlane(l_); const Ctx c = make_ctx(p); const Bufs b = make_bufs(p->ws); ph_slc_attn(c, b.QN, b.KS, b.VS, b.GATE, b.SEL, b.OCMP, b.OWIN, b.ATT); }
__device__ __noinline__ void P_outproj(KP p_, int l_) { const KP p = uni_kp(p_); const int l = __builtin_amdgcn_readfirstlane(l_); const Ctx c = make_ctx(p); const Bufs b = make_bufs(p->ws);
    const bf16* A = b.ATT; float* xo = p->out; const float* xin = (l == 0) ? p->in[0] : p->out;
    naive_gemm(c, NT, D_, D_, [=](int r, int k) { return bf2f(A[(size_t)r * D_ + k]); }, p->in[13] + (size_t)l * D_ * D_, D_,
               [=](int r, int col, float v) { xo[(size_t)r * D_ + col] = xin[(size_t)r * D_ + col] + v; }); }
__device__ __forceinline__ void P_route3(int l_, int cbank) { const KP p = (KP)__builtin_amdgcn_kernarg_segment_ptr(); int l = l_; asm volatile("" : "+s"(l));
    int tid_ = threadIdx.x; asm volatile("" : "+v"(tid_));
    const int tid = tid_, lane = tid & 63, wave = __builtin_amdgcn_readfirstlane(tid >> 6), r = lane & 31, h = lane >> 5, kh = wave >> 2, wr = wave & 3;
    unsigned char* ws = p->ws; asm volatile("" : "+s"(ws)); const bf16* x = (const bf16*)(ws + WS_HN);
    const float* WR = (const float*)(ws + WS_WR) + (size_t)l * D_ * 64;
    LAS float* XT = (LAS float*)lds_raw + wave * (32 * 36);
    LAS float* WT = (LAS float*)lds_raw + 8 * 32 * 36 + kh * (2 * 32 * 64);
    LAS float* PL = (LAS float*)lds_raw + 8 * 32 * 36 + 2 * 2 * 32 * 64;
    LAS float* SS = PL + 2 * 128 * 40;
    const float* bgrp = p->in[16] + l * 4; const float* bexp = p->in[18] + l * 32;
    unsigned* cnt = (unsigned*)(ws + WS_CTL) + CW_MOECNT + l * MOE_LS + cbank;
    LAS unsigned* HIST = (LAS unsigned*)(SS + 2 * 128 * 2);
    for (int grp = launder_s((int)blockIdx.x); grp < NT / 128; grp += (int)gridDim.x) {
        const int row0 = grp * 128 + wr * 32;
        if (tid < 112) HIST[tid] = 0u;
        f32x16 acc0, acc1; float ss = 0.f;
#pragma unroll
        for (int i = 0; i < 16; ++i) { acc0[i] = 0.f; acc1[i] = 0.f; }
        { const u32x4* xsrc = (const u32x4*)(x + (size_t)(row0 + r) * D_ + kh * 512 + 8 * h);
          const u32x4* wsrc = (const u32x4*)(ws + WS_WR) + ((size_t)l * 64 + kh * 32) * 256 + lane;
#pragma unroll 4
          for (int ks = 0; ks < 32; ++ks) {
              const u32x4 av = xsrc[2 * ks], b0h = wsrc[ks * 256], b0l = wsrc[ks * 256 + 64], b1h = wsrc[ks * 256 + 128], b1l = wsrc[ks * 256 + 192];
              { float f_[8]; unpack8(av, f_);
#pragma unroll
                for (int e = 0; e < 8; ++e) ss = fmaf(f_[e], f_[e], ss); }
              const bf16x8v A = __builtin_bit_cast(bf16x8v, av);
              acc0 = __builtin_amdgcn_mfma_f32_32x32x16_bf16(A, __builtin_bit_cast(bf16x8v, b0h), acc0, 0, 0, 0); acc1 = __builtin_amdgcn_mfma_f32_32x32x16_bf16(A, __builtin_bit_cast(bf16x8v, b1h), acc1, 0, 0, 0);
              acc0 = __builtin_amdgcn_mfma_f32_32x32x16_bf16(A, __builtin_bit_cast(bf16x8v, b0l), acc0, 0, 0, 0); acc1 = __builtin_amdgcn_mfma_f32_32x32x16_bf16(A, __builtin_bit_cast(bf16x8v, b1l), acc1, 0, 0, 0);
          } }
#pragma unroll
        for (int reg = 0; reg < 16; ++reg) { const int row = wr * 32 + crow0(reg) + 4 * h; PL[(kh * 128 + row) * 40 + r] = acc0[reg]; if (r < 4) PL[(kh * 128 + row) * 40 + 32 + r] = acc1[reg]; }
        SS[(kh * 128 + wr * 32 + r) * 2 + h] = ss;
        __syncthreads();
        int cls = 0; unsigned lrank = 0u; float wlo = 0.f, whi = 0.f, rstd = 0.f;
        if (tid < 128) {
            float lg[36];
#pragma unroll
            for (int cidx = 0; cidx < 36; ++cidx) lg[cidx] = PL[tid * 40 + cidx] + PL[(128 + tid) * 40 + cidx];
            const float sq = (SS[tid * 2] + SS[tid * 2 + 1]) + (SS[(128 + tid) * 2] + SS[(128 + tid) * 2 + 1]);
            rstd = rsqrtf(sq * (1.f / D_) + EPS);
            float gl[4]; int grp_i = 0;
#pragma unroll
            for (int q = 0; q < 4; ++q) gl[q] = lg[q] * rstd + bgrp[q];
            float gm = gl[0];
#pragma unroll
            for (int q = 1; q < 4; ++q) if (gl[q] > gm) { gm = gl[q]; grp_i = q; }
            float gs = 0.f;
#pragma unroll
            for (int q = 0; q < 4; ++q) gs += __expf(gl[q] - gm);
            const float grp_gate = 1.f / gs;
            float el[8];
#pragma unroll
            for (int q = 0; q < 8; ++q) { float v = lg[4 + q]; float bb = bexp[q];
                if (grp_i == 1) { v = lg[12 + q]; bb = bexp[8 + q]; } else if (grp_i == 2) { v = lg[20 + q]; bb = bexp[16 + q]; } else if (grp_i == 3) { v = lg[28 + q]; bb = bexp[24 + q]; }
                el[q] = v * rstd + bb; }
            int i0 = 0; float v0 = el[0];
#pragma unroll
            for (int q = 1; q < 8; ++q) if (el[q] > v0) { v0 = el[q]; i0 = q; }
            int i1 = -1; float v1 = -INFINITY;
#pragma unroll
            for (int q = 0; q < 8; ++q) if (q != i0 && el[q] > v1) { v1 = el[q]; i1 = q; }
            const float e1 = __expf(v1 - v0), den = 1.f + e1, w0 = grp_gate / den, w1 = grp_gate * e1 / den;
            const int lo = i0 < i1 ? i0 : i1, hi = i0 < i1 ? i1 : i0; cls = grp_i * 28 + lo * 8 - (lo * (lo + 1)) / 2 + (hi - lo - 1);
            wlo = i0 < i1 ? w0 : w1; whi = i0 < i1 ? w1 : w0;
            lrank = __hip_atomic_fetch_add(HIST + cls, 1u, __ATOMIC_RELAXED, __HIP_MEMORY_SCOPE_WORKGROUP);
        }
        __syncthreads();
        if (tid < 112) { const unsigned n = HIST[tid]; if (n) HIST[112 + tid] = __hip_atomic_fetch_add(cnt + tid * MOE_CS, n, __ATOMIC_RELAXED, __HIP_MEMORY_SCOPE_AGENT); }
        __syncthreads();
        if (tid < 128) {
            const unsigned rank = HIST[112 + cls] + lrank;
            const int row = grp * 128 + tid;
            ((u32x4*)(ws + WS_REC))[(size_t)cls * 32768 + rank] = (u32x4){(unsigned)row, __float_as_uint(wlo), __float_as_uint(whi), __float_as_uint(rstd)};
        }
        __syncthreads();
    }
}
typedef float f32x8 __attribute__((ext_vector_type(8)));
__device__ __forceinline__ void P_route2(int l_, int cbank) { const KP p = (KP)__builtin_amdgcn_kernarg_segment_ptr(); int l = l_; asm volatile("" : "+s"(l));
    int tid_ = threadIdx.x; asm volatile("" : "+v"(tid_));
    const int tid = tid_, lane = tid & 63, wave = __builtin_amdgcn_readfirstlane(tid >> 6);
    unsigned char* ws = p->ws; asm volatile("" : "+s"(ws)); const float* x = p->out;
    const float* WR = (const float*)(ws + WS_WR) + (size_t)l * D_ * 40;
    LAS float* xt = (LAS float*)lds_raw + wave * (64 * 36);
    LAS float* part = (LAS float*)lds_raw;
    const float* bgrp = p->in[16] + l * 4; const float* bexp = p->in[18] + l * 32;
    unsigned* cnt = (unsigned*)(ws + WS_CTL) + CW_MOECNT + l * 128 + cbank;
    for (int grp = launder_s((int)blockIdx.x); grp < NT / 128; grp += (int)gridDim.x) {
        const int row0 = grp * 128 + (wave >> 2) * 64, kq = wave & 3;
        float acc[40]; float ss = 0.f;
#pragma unroll
        for (int cidx = 0; cidx < 40; ++cidx) acc[cidx] = 0.f;
#pragma unroll 1
        for (int kc = 0; kc < 8; ++kc) {
            const int k0 = kq * 256 + kc * 32;
#pragma unroll
            for (int i = 0; i < 8; ++i) { const int row = i * 8 + (lane >> 3), c4 = (lane & 7) * 4; *(LAS f32x4*)(xt + row * 36 + c4) = *(const f32x4*)(x + (size_t)(row0 + row) * D_ + k0 + c4); }
            float xr[32];
#pragma unroll
            for (int j = 0; j < 8; ++j) { const f32x4 t = *(const LAS f32x4*)(xt + lane * 36 + 4 * j); xr[4 * j] = t.x; xr[4 * j + 1] = t.y; xr[4 * j + 2] = t.z; xr[4 * j + 3] = t.w; }
            const float* wk = WR + (size_t)k0 * 40;
#pragma unroll
            for (int kk = 0; kk < 32; ++kk) {
                f32x8 w0, w1, w2, w3, w4;
                asm volatile("s_load_dwordx8 %0, %5, %6\n\ts_load_dwordx8 %1, %5, %7\n\ts_load_dwordx8 %2, %5, %8\n\ts_load_dwordx8 %3, %5, %9\n\ts_load_dwordx8 %4, %5, %10\n\ts_waitcnt lgkmcnt(0)"
                             : "=&s"(w0), "=&s"(w1), "=&s"(w2), "=&s"(w3), "=&s"(w4) : "s"(wk), "i"(kk * 160), "i"(kk * 160 + 32), "i"(kk * 160 + 64), "i"(kk * 160 + 96), "i"(kk * 160 + 128) : "memory");
                const float xv = xr[kk]; ss = fmaf(xv, xv, ss);
#pragma unroll
                for (int e = 0; e < 8; ++e) { acc[e] = fmaf(xv, w0[e], acc[e]); acc[8 + e] = fmaf(xv, w1[e], acc[8 + e]); acc[16 + e] = fmaf(xv, w2[e], acc[16 + e]); acc[24 + e] = fmaf(xv, w3[e], acc[24 + e]); }
#pragma unroll
                for (int e = 0; e < 4; ++e) acc[32 + e] = fmaf(xv, w4[e], acc[32 + e]);
            }
        }
        __syncthreads();
#pragma unroll
        for (int cidx = 0; cidx < 36; ++cidx) part[(wave * 64 + lane) * 37 + cidx] = acc[cidx];
        part[(wave * 64 + lane) * 37 + 36] = ss;
        __syncthreads();
        if (tid < 128) {
            const int rg = tid >> 6, rr = tid & 63; float lg[37];
#pragma unroll
            for (int cidx = 0; cidx < 37; ++cidx) lg[cidx] = ((part[((rg * 4 + 0) * 64 + rr) * 37 + cidx] + part[((rg * 4 + 1) * 64 + rr) * 37 + cidx]) + part[((rg * 4 + 2) * 64 + rr) * 37 + cidx]) + part[((rg * 4 + 3) * 64 + rr) * 37 + cidx];
            const float rstd = rsqrtf(lg[36] * (1.f / D_) + EPS);
            float gl[4]; int grp_i = 0;
#pragma unroll
            for (int q = 0; q < 4; ++q) gl[q] = lg[q] * rstd + bgrp[q];
            float gm = gl[0];
#pragma unroll
            for (int q = 1; q < 4; ++q) if (gl[q] > gm) { gm = gl[q]; grp_i = q; }
            float gs = 0.f;
#pragma unroll
            for (int q = 0; q < 4; ++q) gs += __expf(gl[q] - gm);
            const float grp_gate = 1.f / gs;
            float el[8];
#pragma unroll
            for (int q = 0; q < 8; ++q) { float v = lg[4 + q]; float bb = bexp[q];
                if (grp_i == 1) { v = lg[12 + q]; bb = bexp[8 + q]; } else if (grp_i == 2) { v = lg[20 + q]; bb = bexp[16 + q]; } else if (grp_i == 3) { v = lg[28 + q]; bb = bexp[24 + q]; }
                el[q] = v * rstd + bb; }
            int i0 = 0; float v0 = el[0];
#pragma unroll
            for (int q = 1; q < 8; ++q) if (el[q] > v0) { v0 = el[q]; i0 = q; }
            int i1 = -1; float v1 = -INFINITY;
#pragma unroll
            for (int q = 0; q < 8; ++q) if (q != i0 && el[q] > v1) { v1 = el[q]; i1 = q; }
            const float e1 = __expf(v1 - v0), den = 1.f + e1, w0 = grp_gate / den, w1 = grp_gate * e1 / den;
            const int lo = i0 < i1 ? i0 : i1, hi = i0 < i1 ? i1 : i0, cls = grp_i * 28 + lo * 8 - (lo * (lo + 1)) / 2 + (hi - lo - 1);
            const unsigned rank = __hip_atomic_fetch_add(cnt + cls, 1u, __ATOMIC_RELAXED, __HIP_MEMORY_SCOPE_AGENT);
            const int row = grp * 128 + tid;
            ((unsigned*)(ws + WS_ROUTE + RT_INFO))[row] = ((unsigned)cls << 24) | rank;
            ((float*)(ws + WS_ROUTE + RT_W))[2 * row] = i0 < i1 ? w0 : w1; ((float*)(ws + WS_ROUTE + RT_W))[2 * row + 1] = i0 < i1 ? w1 : w0;
            ((float*)(ws + WS_ROUTE + RT_RSTD))[row] = rstd;
        }
        __syncthreads();
    }
}
__device__ __noinline__ void P_route(KP p_, int l_) { const KP p = uni_kp(p_); const int l = __builtin_amdgcn_readfirstlane(l_); const Ctx c = make_ctx(p); const Bufs b = make_bufs(p->ws);
    ph_moe_route(c, p->out, p->in[14] + (size_t)l * D_, p->in[15] + (size_t)l * D_ * 4, p->in[16] + l * 4, p->in[17] + (size_t)l * D_ * 32, p->in[18] + l * 32, b.HN, (int*)(p->ws + WS_ROUTE + RT_INFO), (float*)(p->ws + WS_ROUTE + RT_W), (unsigned*)(p->ws + WS_CTL) + CW_MOECNT + l * 128); }
__device__ __noinline__ void P_moe(KP p_, int l_) { const KP p = uni_kp(p_); const int l = __builtin_amdgcn_readfirstlane(l_); const Ctx c = make_ctx(p); const Bufs b = make_bufs(p->ws);
    ph_moe_naive(c, b.HN, b.ROUTE_E, b.ROUTE_W, p->in[19] + (size_t)l * NEXP * D_ * DEXP, p->in[20] + (size_t)l * NEXP * D_ * DEXP, p->in[21] + (size_t)l * NEXP * DEXP * D_, p->out); }
__device__ __noinline__ void P_final(KP p_) { const KP p = uni_kp(p_); const Ctx c = make_ctx(p); ph_norm_final_from_bf16(c, (const bf16*)(p->ws + WS_HN), p->in[22], p->out); }
__device__ __forceinline__ void P_gridbar(KP p_) { const KP p = uni_kp(p_);
    XcdBarrier bar; bar.bar = (unsigned*)(p->ws + WS_CTL) + 4096; bar.x = xb_xcc_id(); bar.st = (volatile LAS unsigned*)((LAS unsigned char*)lds_raw + MISC_OFF) + 8;
    xcd_barrier(bar);
}

__global__ void __launch_bounds__(NTHREADS, 2) fwd_kernel(Params pp) {
    const KP p = (KP)__builtin_amdgcn_kernarg_segment_ptr();
    { volatile LAS unsigned* MISC = (volatile LAS unsigned*)((LAS unsigned char*)lds_raw + MISC_OFF); if (threadIdx.x < 32) MISC[threadIdx.x] = 0u; }
    __syncthreads();
    const int lo = p->ph_lo, hi = p->ph_hi;
    if (hi - lo > 1) (void)xcd_barrier_post((unsigned*)(p->ws + WS_CTL) + 4096, (volatile LAS unsigned*)((LAS unsigned char*)lds_raw + MISC_OFF) + 8);
#define IN(k) (lo <= (k) && (k) < hi)
#define SEAM(k) do { if (IN(k) && IN((k) + 1)) P_gridbar(p); } while (0)
    if (IN(0)) { for (int rep = 0; rep < REP_PRO; ++rep) { if (rep) P_gridbar(p); P_prologue(p); } }
    SEAM(0);
    for (int l = 0; l < L_; ++l) {
        const int P0 = 1 + l * PH_PER_LAYER;
        if (IN(P0 + 0)) { for (int rep = 0; rep < REP_NORM; ++rep) { if (rep) P_gridbar(p); P_norm1(p, l); } }
        SEAM(P0 + 0);
        if (IN(P0 + 1)) { for (int rep = 0; rep < REP_INPROJ; ++rep) { if (rep) P_gridbar(p); P_inproj_mfma(l); }
#ifdef REP_INDUMMY
            for (int rep = 0; rep < REP_INDUMMY; ++rep) { P_gridbar(p); P_inproj_dummy(l); }
#endif
        }
        SEAM(P0 + 1);
        if (IN(P0 + 3)) {
            P_cmp1_mfma(l);
            if (launder_s((int)blockIdx.x) < 32) { asm volatile("s_waitcnt vmcnt(0)" ::: "memory"); __builtin_amdgcn_fence(__ATOMIC_SEQ_CST, "agent"); asm volatile("s_waitcnt vmcnt(0)" ::: "memory"); }
            __syncthreads();
            P_cmp2_mfma(l);
            for (int rep = 0; rep < REP_ATT3; ++rep) { if (rep) P_gridbar(p);
            for (;;) { int u = fetch_unit(p, l * 8 + 0 + 16 * rep);
                if (l == 0) {
                    if (u >= 2048 + CONV_UNITS) break;
                    const int k11 = u / 11, r11 = u - 11 * k11;
                    if (r11 == 3 || r11 == 7 || r11 == 10) { U_conv(p, 3 * k11 + (r11 > 3) + (r11 > 7)); continue; }
                    u = 8 * k11 + r11 - (r11 > 3) - (r11 > 7); }
                else if (u >= 2048) break;
                if (u < 1024) { const int qb = 15 - (u >> 6), k = u & 63; if (k < 32) U_diff(p, k, qb, l); else U_fox(p, k - 32, qb, l); }
                else { const int w = u - 1024; U_win(p, w & 15, 63 - (w >> 4)); } } } }
        SEAM(P0 + 3);
        if (IN(P0 + 4)) { for (int rep = 0; rep < REP_CMP; ++rep) { if (rep) P_gridbar(p); for (int u = launder_s((int)blockIdx.x); u < 256; u += (int)gridDim.x) U_cmp(p, u & 15, u >> 4); } }
        SEAM(P0 + 4);
        if (IN(P0 + 5)) { for (int rep = 0; rep < REP_SLC; ++rep) { if (rep) P_gridbar(p); for (;;) { const int u = fetch_unit(p, l * 8 + 1 + 16 * rep); if (u >= 1024) break; U_slc(p, u & 15, 63 - (u >> 4)); } } }
        SEAM(P0 + 5);
        if (IN(P0 + 6)) P_outproj_mfma(l);
        SEAM(P0 + 6);
        if (IN(P0 + 7)) { for (int rep = 0; rep < REP_ROUTE; ++rep) { if (rep) P_gridbar(p); P_route3(l, REP_ROUTE - 1 - rep); } }
        SEAM(P0 + 7);
        if (IN(P0 + 9)) { for (int rep = 0; rep < REP_G1; ++rep) { if (rep) P_gridbar(p); P_moe_g1(l); } }
        SEAM(P0 + 9);
        if (IN(P0 + 10)) P_moe_g2(l);
        SEAM(P0 + 10);
    }
    if (IN(1 + L_ * PH_PER_LAYER)) P_final(p);
#undef IN
#undef SEAM
}

extern "C" void kernel_launch(void* const* d_in, const int* in_sizes, int n_in, void* d_out, int out_size, void* d_ws, size_t ws_size, hipStream_t stream) {
    static int grid = 0;
    if (grid == 0) {
        if (n_in != 23 || out_size != NT * D_ || ws_size < WS_END) { fprintf(stderr, "kernel_launch: unexpected sizes n_in %d out %d ws %zu (need %zu)\n", n_in, out_size, ws_size, (size_t)WS_END); grid = -1; return; }
        int dev = 0, cus = 0, per_cu = 0;
        if (hipGetDevice(&dev) != hipSuccess || hipDeviceGetAttribute(&cus, hipDeviceAttributeMultiprocessorCount, dev) != hipSuccess) { grid = -1; return; }
        if (hipFuncSetAttribute((const void*)fwd_kernel, hipFuncAttributeMaxDynamicSharedMemorySize, LDS_BYTES) != hipSuccess) { fprintf(stderr, "kernel_launch: hipFuncSetAttribute failed\n"); grid = -1; return; }
        if (hipOccupancyMaxActiveBlocksPerMultiprocessor(&per_cu, (const void*)fwd_kernel, NTHREADS, LDS_BYTES) != hipSuccess || per_cu < 1) { fprintf(stderr, "kernel_launch: occupancy query says %d\n", per_cu); }
        (void)hipGetLastError();
        grid = cus;
    }
    if (grid < 0) return;
    (void)hipMemsetAsync((char*)d_ws + WS_CTL, 0, CTL_BYTES, stream);
    Params p{};
    for (int i = 0; i < 23; ++i) p.in[i] = (const float*)d_in[i];
    p.out = (float*)d_out; p.ws = (unsigned char*)d_ws;
#if N_LAUNCH_MODE == 0
    p.ph_lo = 0; p.ph_hi = N_PHASES;
    hipLaunchKernelGGL(fwd_kernel, dim3(grid), dim3(NTHREADS), LDS_BYTES, stream, p);
#else
    for (int k = 0; k < N_PHASES; ++k) { p.ph_lo = k; p.ph_hi = k + 1; hipLaunchKernelGGL(fwd_kernel, dim3(grid), dim3(NTHREADS), LDS_BYTES, stream, p); }
#endif
}
```

```cpp
#include <hip/hip_runtime.h>
#include <cstdio>
#include <cstdint>

#ifndef INPROJ_ALIGN
#define INPROJ_ALIGN true
#endif
#ifndef INPROJ_SP2
#define INPROJ_SP2 true
#endif
#ifndef REP_PRO
#define REP_PRO 1
#endif
#ifndef REP_ROUTE
#define REP_ROUTE 1
#endif
#ifndef REP_NORM
#define REP_NORM 1
#endif
#ifndef REP_INPROJ
#define REP_INPROJ 1
#endif
#ifndef REP_ATT3
#define REP_ATT3 1
#endif
#ifndef REP_CMP
#define REP_CMP 1
#endif
#ifndef REP_SLC
#define REP_SLC 1
#endif
#ifndef REP_SCAT
#define REP_SCAT 1
#endif
#ifndef REP_G1
#define REP_G1 1
#endif
#ifndef N_LAUNCH_MODE
#define N_LAUNCH_MODE 0
#endif

#define LAS __attribute__((address_space(3)))
#define GAS __attribute__((address_space(1)))
typedef unsigned short bf16;
typedef unsigned long long u64;
typedef float f32x4 __attribute__((ext_vector_type(4)));
typedef unsigned u32x4 __attribute__((ext_vector_type(4)));

constexpr int B_ = 8, T_ = 4096, D_ = 1024, NT = B_ * T_, L_ = 2;
constexpr int HD = 64, D_IN = 2844;
constexpr int N_CMP = 255, CMP_HID = 256;
constexpr int NEXP = 32, DEXP = 256;
constexpr float EPS = 1e-6f;
constexpr float LOG2E = 1.4426950408889634f;
constexpr int NWAVES = 8, NTHREADS = 512;

constexpr int C_NSAQ = 0, C_KV6 = 512, C_GATE = 1280, C_FQ = 1304, C_FF = 2072, C_DQ = 2076, C_DV = 2588;

constexpr size_t MiB = 1u << 20;
constexpr size_t WS_CTL = 0, CTL_BYTES = 1 * MiB;
constexpr size_t WS_QN = 1 * MiB;
constexpr size_t WS_KV6 = WS_QN + 32 * MiB;
constexpr size_t KV6_STRIDE = 8 * MiB + 64 * 1024;
constexpr size_t WS_FQKV = WS_KV6 + 6 * KV6_STRIDE;
constexpr size_t WS_DQK = WS_FQKV + 48 * MiB;
constexpr size_t WS_DV = WS_DQK + 32 * MiB;
constexpr size_t WS_GATE = WS_DV + 16 * MiB;
constexpr size_t WS_FL = WS_GATE + 3 * MiB;
constexpr size_t WS_HC = WS_FL + 1 * MiB;
constexpr size_t WS_KVCMP = WS_HC + 4 * MiB;
constexpr size_t WS_SEL = WS_KVCMP + 1 * MiB;
constexpr size_t WS_OCMP = WS_SEL + 1 * MiB;
constexpr size_t WS_OWIN = WS_OCMP + 32 * MiB;
constexpr size_t WS_HN = WS_OWIN + 32 * MiB;
constexpr size_t WS_ATT = WS_HN + 64 * MiB;
constexpr size_t WS_ROUTE = WS_ATT + 64 * MiB;
constexpr size_t WS_WIN_T = WS_ROUTE + 2 * MiB;
constexpr size_t WS_WOUT_T = WS_WIN_T + 12 * MiB;
constexpr size_t WS_WGU_T = WS_WOUT_T + 4 * MiB;
constexpr size_t WS_WD_T = WS_WGU_T + 64 * MiB;
constexpr size_t WS_W1_T = WS_WD_T + 32 * MiB;
constexpr size_t WS_W2_T = WS_W1_T + 4 * MiB;
constexpr size_t WS_BIAS1 = WS_W2_T + 512 * 1024;
constexpr size_t WS_WR = WS_BIAS1 + 512 * 1024;
constexpr size_t WS_B1PART = WS_WR + 512 * 1024;
constexpr size_t WS_END = WS_B1PART + 512 * 1024;
constexpr int MOE_MAXROWS = 61440;
constexpr size_t WS_XS = WS_QN;
constexpr size_t WS_HB = WS_OCMP;
static_assert(WS_XS + (size_t)MOE_MAXROWS * 2048 <= WS_DQK && WS_HB + (size_t)MOE_MAXROWS * 1024 <= WS_HN, "MoE aliases");
constexpr size_t RT_INFO = 0, RT_W = 128 * 1024, RT_ROWTOK = 384 * 1024, RT_ROWW = 640 * 1024, RT_RSTD = 1152 * 1024;
constexpr int CW_QUEUE = 16384, CW_MOECNT = 32768, CW_KN = 49152, MOE_CS = 32, MOE_LS = 4096;
constexpr size_t WS_REC = WS_QN;
constexpr unsigned ZROW_OFF = 512 * 1024;
static_assert(WS_REC + (size_t)112 * 32768 * 16 <= WS_DQK && WS_HN + (size_t)NT * 2048 < (1ull << 32), "MoE record table / 32-bit row offsets");
constexpr int TBL_OFF = 131072 + 1024;
constexpr int NIN = 3072;

extern __shared__ __attribute__((aligned(16))) unsigned char lds_raw[];
__device__ __forceinline__ float bf2f(bf16 v) { return __uint_as_float(((unsigned)v) << 16); }
__device__ __forceinline__ unsigned f2bf(float f) { unsigned u = __float_as_uint(f); return (u + 0x7fffu + ((u >> 16) & 1u)) >> 16; }
__device__ __forceinline__ unsigned pk2(float lo, float hi) { return f2bf(lo) | (f2bf(hi) << 16); }
__device__ __forceinline__ float wave_sum(float v) {
#pragma unroll
    for (int o = 1; o < 64; o <<= 1) v += __shfl_xor(v, o);
    return v;
}
__device__ __forceinline__ float wave_max(float v) {
#pragma unroll
    for (int o = 1; o < 64; o <<= 1) v = fmaxf(v, __shfl_xor(v, o));
    return v;
}
__device__ __forceinline__ float shflx_f(float v, int o, int lane) { return __uint_as_float((unsigned)__builtin_amdgcn_ds_bpermute((lane ^ o) << 2, (int)__float_as_uint(v))); }
__device__ __forceinline__ unsigned shflx_u(unsigned v, int o, int lane) { return (unsigned)__builtin_amdgcn_ds_bpermute((lane ^ o) << 2, (int)v); }
__device__ __forceinline__ float wave_sum_l(float v, int lane) {
#pragma unroll
    for (int o = 1; o < 64; o <<= 1) v += shflx_f(v, o, lane);
    return v;
}
__device__ __forceinline__ int launder_s(int v) { asm volatile("" : "+s"(v)); return v; }
__device__ __forceinline__ float sigmoidf_(float x) { return 1.f / (1.f + __expf(-x)); }
__device__ __forceinline__ float log_sigmoidf_(float x) { return x >= 0.f ? -log1pf(__expf(-x)) : x - log1pf(__expf(x)); }
__device__ __forceinline__ float gelu_tanh(float x) { const float u = 0.7978845608028654f * (x + 0.044715f * x * x * x); return 0.5f * x * (1.f + tanhf(u)); }
__device__ __forceinline__ float alibi_slope(int idx1, int n) { return exp2f(-8.0f * (float)idx1 / (float)n); }

__device__ __forceinline__ constexpr int b64_off(int t, int d) { return ((t >> 4) * 2 + (d >> 5)) * 512 + (t & 15) * 32 + (d & 31); }
#define XB_TMO      128
#define XB_XCNT(j)  (256  + 64 * (j))
#define XB_XSUB(j)  (1280 + 64 * (j))
#define XB_XGEN(j)  (2304 + 64 * (j))
#define XB_TOP      3328
#define XB_TOPGEN   3392
#define XCD_BAR_WORDS 3456
#define XB_SPIN_CAP (1u << 25)
__device__ __forceinline__ unsigned xb_ld(unsigned* p)              { return __hip_atomic_load(p, __ATOMIC_RELAXED, __HIP_MEMORY_SCOPE_AGENT); }
__device__ __forceinline__ unsigned xb_add(unsigned* p, unsigned v) { return __hip_atomic_fetch_add(p, v, __ATOMIC_RELAXED, __HIP_MEMORY_SCOPE_AGENT); }
__device__ __forceinline__ unsigned xb_xcc_id() { return (unsigned)__builtin_amdgcn_s_getreg((3 << 11) | 20) & 0xFu; }
#define XB_SPIN(cond, bar) do { unsigned _sp = 0; while (cond) { __builtin_amdgcn_s_sleep(1); \
    if ((++_sp & 255u) == 0u) { if (xb_ld(&(bar)[XB_TMO])) break; if (_sp > XB_SPIN_CAP) { atomicAdd(&(bar)[XB_TMO], 1u); break; } } } } while (0)
struct XcdBarrier { unsigned* bar; unsigned x; volatile LAS unsigned* st; };
__device__ __forceinline__ XcdBarrier xcd_barrier_post(unsigned* bar, volatile LAS unsigned* st) {
    XcdBarrier b; b.bar = bar; b.x = xb_xcc_id(); b.st = st;
    if (threadIdx.x == 0) (void)xb_add(&bar[XB_XCNT(b.x)], 1u);
    return b;
}
__device__ __forceinline__ void xcd_barrier_complete(unsigned* bar, unsigned x, unsigned& nloc, unsigned& nx) {
    const unsigned G = gridDim.x * gridDim.y * gridDim.z;
    unsigned sum, cnt, mine, sp = 0u;
    for (;;) {
        sum = 0u; cnt = 0u; mine = 0u;
#pragma unroll
        for (unsigned j = 0; j < 16; ++j) { const unsigned c = xb_ld(&bar[XB_XCNT(j)]); sum += c; cnt += (c > 0u) ? 1u : 0u; mine = (j == x) ? c : mine; }
        if (sum == G) break;
        __builtin_amdgcn_s_sleep(1);
        if ((++sp & 255u) == 0u) { if (xb_ld(&bar[XB_TMO])) break; if (sp > XB_SPIN_CAP) { atomicAdd(&bar[XB_TMO], 1u); break; } }
    }
    nloc = mine > 0u ? mine : 1u; nx = cnt > 0u ? cnt : 1u;
}
__device__ __forceinline__ void xcd_barrier(const XcdBarrier& b) {
    asm volatile("s_waitcnt vmcnt(0)" ::: "memory");
    __syncthreads();
    if (threadIdx.x == 0) {
        unsigned* bar = b.bar;
        __builtin_amdgcn_s_waitcnt(0);
        unsigned nloc = b.st[0], nx = b.st[1];
        if (nloc == 0u) { xcd_barrier_complete(bar, b.x, nloc, nx); b.st[0] = nloc; b.st[1] = nx; }
        const unsigned old = xb_add(&bar[XB_XSUB(b.x)], 1u);
        const unsigned gen = old / nloc;
        if (old + 1u == (gen + 1u) * nloc) {
            __builtin_amdgcn_fence(__ATOMIC_RELEASE, "agent");
            asm volatile("s_waitcnt vmcnt(0)" ::: "memory");
            const unsigned og = xb_add(&bar[XB_TOP], 1u);
            const unsigned tg = og / nx;
            if (og + 1u == (tg + 1u) * nx) xb_add(&bar[XB_TOPGEN], 1u);
            else XB_SPIN(xb_ld(&bar[XB_TOPGEN]) == tg, bar);
            __builtin_amdgcn_fence(__ATOMIC_ACQUIRE, "agent");
            xb_add(&bar[XB_XGEN(b.x)], 1u);
            asm volatile("s_waitcnt vmcnt(0)" ::: "memory");
        } else {
            XB_SPIN(xb_ld(&bar[XB_XGEN(b.x)]) == gen, bar);
            __builtin_amdgcn_fence(__ATOMIC_ACQUIRE, "agent");
            asm volatile("s_waitcnt vmcnt(0)" ::: "memory");
        }
    }
    __syncthreads();
}

struct Params { const float* in[23]; float* out; unsigned char* ws; int ph_lo, ph_hi; };
constexpr int LDS_BYTES = 147456;
constexpr int MISC_OFF = 131072 + 320;

struct Ctx {
    LAS unsigned char* lds; int tid, lane, wave, bid, G, gw, ngw;
    const float* const* in; float* xcur; unsigned char* ws;
};

namespace pg8 {
#define PG8_LAS __attribute__((address_space(3)))
typedef unsigned short bf16_t;
typedef short bf16x8 __attribute__((ext_vector_type(8)));
typedef float f32x4 __attribute__((ext_vector_type(4)));
typedef unsigned u32x4 __attribute__((ext_vector_type(4)));
constexpr int BM = 256, BK = 64, HALF = 128, HTB = HALF * BK * 2  , STAGE_BYTES = 8 * HTB, NXCD = 8, WGM = 8;

__host__ __device__ __forceinline__ int lds_byte(int r, int c) { const int st = (r >> 4) * 2 + (c >> 5), rr = r & 15, cc = c & 31, ob = rr * 64 + cc * 2; return st * 1024 + (ob ^ (((ob >> 9) & 1) << 5)); }
__host__ __device__ __forceinline__ void stage_rc(int b, int& R, int& C) { const int st = b / 1024, sb = b % 1024, swz = sb ^ (((sb >> 9) & 1) << 5); R = (st >> 1) * 16 + swz / 64; C = (st & 1) * 32 + (swz % 64) / 2; }
__host__ __device__ __forceinline__ int perm32(int rho) { const int n = rho >> 4, i = rho & 15; return 8 * (i >> 2) + 4 * n + (i & 3); }

struct Unit { int pm, pn; const char* a; const char* b; const char* b2; };
struct Gemm { int lda, ldb, K, ksplit, arb, acb; };

__device__ __forceinline__ unsigned cvt_pk_bf16(float lo, float hi) { unsigned r; asm volatile("v_cvt_pk_bf16_f32 %0, %1, %2" : "=v"(r) : "v"(lo), "v"(hi)); return r; }
typedef float f32x2 __attribute__((ext_vector_type(2)));

template <class Epi, class Sched, bool ALIGN_EPI = false, bool SP2 = false, bool GATHER = false>
__device__ __forceinline__ void gemm_phase(PG8_LAS unsigned char* lds, const Gemm g, const Sched& S, const Epi& E) {
    static_assert(!GATHER || SP2, "GATHER is written for the SP2 loop");
    int tid_ = threadIdx.x; asm volatile("" : "+v"(tid_));
    const int tid = tid_, wid = __builtin_amdgcn_readfirstlane(tid >> 6), lane = tid & 63, wr = wid >> 2, wc = wid & 3, fr = lane & 15, fq = lane >> 4;
    const int K = g.K, nt = K / BK, ks = g.ksplit;
    unsigned voffA[2], voffB[2];
#pragma unroll
    for (int i = 0; i < 2; ++i) { int R, C; stage_rc(tid * 16 + i * 8192, R, C); const int Rb = Epi::PERM ? ((R & ~31) + perm32(R & 31)) : R;
        voffA[i] = g.arb ? (unsigned)(((R / g.arb) * (K / g.acb) + C / g.acb) * (g.arb * g.acb) + (R % g.arb) * g.acb + (C % g.acb)) * 2u : (unsigned)(R * g.lda + C) * 2u; voffB[i] = (unsigned)(Rb * g.ldb + C) * 2u; }
    const size_t kstep = (size_t)(BK * 2), kstepA = g.arb ? (size_t)(BK * g.arb * 2) : kstep;
    const size_t hsA = (size_t)HALF * (g.arb ? K : g.lda) * 2, hsB = (size_t)HALF * g.ldb * 2;
    const unsigned ldsw = (unsigned)wid * 1024u;
    const int aoff = lds_byte(wr * 64 + fr, fq * 8), boff = lds_byte(wc * 32 + fr, fq * 8);
#define PG8_SA(b, h) (((b) * 2 + (h)) * HTB)
#define PG8_SB(b, h) ((4 + (b) * 2 + (h)) * HTB)
#define PG8_STAGE(bufoff, gbase, voff) do { _Pragma("unroll") for (int _i = 0; _i < 2; ++_i) \
        __builtin_amdgcn_global_load_lds((const unsigned*)((const char*)(gbase) + (voff)[_i]), (PG8_LAS unsigned*)(lds + (bufoff) + ldsw + _i * 8192), 16, 0, 0); } while (0)
#define PG8_LDA(dst, b, h) do { _Pragma("unroll") for (int m = 0; m < 4; ++m) _Pragma("unroll") for (int k = 0; k < 2; ++k) dst[m][k] = *(const PG8_LAS bf16x8*)(lds + PG8_SA(b, h) + aoff + m * 2048 + k * 1024); } while (0)
#define PG8_LDB(dst, b, h) do { _Pragma("unroll") for (int n = 0; n < 2; ++n) _Pragma("unroll") for (int k = 0; k < 2; ++k) dst[n][k] = *(const PG8_LAS bf16x8*)(lds + PG8_SB(b, h) + boff + n * 2048 + k * 1024); } while (0)
#define PG8_MMA(ai, bj, At, Bt) do { __builtin_amdgcn_s_setprio(1); _Pragma("unroll") for (int m = 0; m < 4; ++m) _Pragma("unroll") for (int n = 0; n < 2; ++n) _Pragma("unroll") for (int k = 0; k < 2; ++k) \
        acc[ai][bj][m][n] = __builtin_amdgcn_mfma_f32_16x16x32_bf16(Bt[n][k], At[m][k], acc[ai][bj][m][n], 0, 0, 0); __builtin_amdgcn_s_setprio(0); } while (0)
#define PG8_WAIT_V(n) asm volatile("s_waitcnt vmcnt(" #n ")" ::: "memory")
#define PG8_WAIT_L(n) asm volatile("s_waitcnt lgkmcnt(" #n ")" ::: "memory")
#define PG8_BAR __builtin_amdgcn_s_barrier()
#define PG8_SCHED __builtin_amdgcn_sched_barrier(0)
    Unit cur, nxt; int ui = 0;
    if (!S.next(0, cur)) return;
    unsigned gC[2][2] = {{0u, 0u}, {0u, 0u}}, gN[2][2] = {{0u, 0u}, {0u, 0u}}; const char* gbase = nullptr;
#define PG8_GOFFS(U, Gv) do { _Pragma("unroll") for (int _h = 0; _h < 2; ++_h) _Pragma("unroll") for (int _i = 0; _i < 2; ++_i) { int R_, C_; stage_rc(tid * 16 + _i * 8192, R_, C_); Gv[_h][_i] = S.arow(U, _h * HALF + R_) + (unsigned)C_ * 2u; } } while (0)
#define PG8_STAGE_G(bufoff, kbyte, Gv, h) do { _Pragma("unroll") for (int _i = 0; _i < 2; ++_i) \
        __builtin_amdgcn_global_load_lds((const unsigned*)(gbase + (size_t)(kbyte) + Gv[h][_i]), (PG8_LAS unsigned*)(lds + (bufoff) + ldsw + _i * 8192), 16, 0, 0); } while (0)
    if constexpr (GATHER) { gbase = S.abase(); PG8_GOFFS(cur, gC); }
    f32x4 acc[2][2][4][2];
#pragma unroll
    for (int a = 0; a < 2; ++a)
#pragma unroll
        for (int b = 0; b < 2; ++b)
#pragma unroll
            for (int m = 0; m < 4; ++m)
#pragma unroll
                for (int n = 0; n < 2; ++n) acc[a][b][m][n] = (f32x4){0.f, 0.f, 0.f, 0.f};
    bf16x8 At[4][2], B0[2][2], B1[2][2];
    const char* cA = cur.a; const char* cB = cur.b; const char* cB2 = cur.b2;
#define PG8_BK(base, base2, kt) ((kt) < ks ? (base) + (size_t)(kt) * kstep : (base2) + (size_t)((kt) - ks) * kstep)
    S.a_ready(cur);
    if constexpr (SP2) {
        PG8_STAGE(PG8_SB(0, 0), cB, voffB); PG8_STAGE(PG8_SB(0, 1), cB + hsB, voffB);
        if constexpr (GATHER) { PG8_STAGE_G(PG8_SA(0, 0), 0, gC, 0); PG8_STAGE_G(PG8_SA(0, 1), 0, gC, 1); } else { PG8_STAGE(PG8_SA(0, 0), cA, voffA); PG8_STAGE(PG8_SA(0, 1), cA + hsA, voffA); }
        if (wr == 1) PG8_BAR;
        PG8_WAIT_V(2); PG8_BAR;
        PG8_STAGE(PG8_SB(1, 0), PG8_BK(cB, cB2, 1), voffB);
        if constexpr (GATHER) PG8_STAGE_G(PG8_SA(1, 0), kstep, gC, 0); else PG8_STAGE(PG8_SA(1, 0), cA + kstepA, voffA);
        PG8_STAGE(PG8_SB(1, 1), PG8_BK(cB, cB2, 1) + hsB, voffB);
        PG8_WAIT_V(6); PG8_BAR;
    } else {
        PG8_STAGE(PG8_SB(0, 0), cB, voffB); PG8_STAGE(PG8_SA(0, 0), cA, voffA); PG8_STAGE(PG8_SB(0, 1), cB + hsB, voffB); PG8_STAGE(PG8_SA(0, 1), cA + hsA, voffA);
        if (wr == 1) PG8_BAR;
        PG8_WAIT_V(4); PG8_BAR;
        PG8_STAGE(PG8_SB(1, 0), PG8_BK(cB, cB2, 1), voffB); PG8_STAGE(PG8_SA(1, 0), cA + kstepA, voffA); PG8_STAGE(PG8_SB(1, 1), PG8_BK(cB, cB2, 1) + hsB, voffB);
        PG8_WAIT_V(6); PG8_BAR;
    }
    for (;;) {
        const bool has_next = S.next(ui + 1, nxt);
        if constexpr (GATHER) { if (has_next) PG8_GOFFS(nxt, gN); else { _Pragma("unroll") for (int _h = 0; _h < 2; ++_h) _Pragma("unroll") for (int _i = 0; _i < 2; ++_i) gN[_h][_i] = gC[_h][_i]; } }
        const char* nA = has_next ? nxt.a : cA; const char* nB = has_next ? nxt.b : cB; const char* nB2 = has_next ? nxt.b2 : cB2;
#pragma unroll 1
        for (int t = 0; t < nt; t += 2) {
            const bool last = (t == nt - 2);
            const char* a1 = cA + (size_t)(t + 1) * kstepA;
            const char* a2 = last ? nA : cA + (size_t)(t + 2) * kstepA; const char* b2 = last ? PG8_BK(nB, nB2, 0) : PG8_BK(cB, cB2, t + 2);
            const char* a3 = a2 + kstepA; const char* b3 = last ? PG8_BK(nB, nB2, 1) : PG8_BK(cB, cB2, t + 3);
            if (last && has_next) S.a_ready(nxt);
            if constexpr (SP2) {
            PG8_LDB(B0, 0, 0); PG8_LDB(B1, 0, 1); PG8_SCHED; PG8_LDA(At, 0, 0);
            if constexpr (GATHER) PG8_STAGE_G(PG8_SA(1, 1), (size_t)(t + 1) * kstep, gC, 1); else PG8_STAGE(PG8_SA(1, 1), a1 + hsA, voffA);
            PG8_WAIT_V(8); PG8_WAIT_L(0); PG8_BAR; PG8_MMA(0, 0, At, B0); PG8_MMA(0, 1, At, B1); PG8_BAR; PG8_SCHED;
            PG8_LDA(At, 0, 1); PG8_STAGE(PG8_SB(0, 0), b2, voffB); PG8_STAGE(PG8_SB(0, 1), b2 + hsB, voffB);
            if constexpr (GATHER) { if (last) PG8_STAGE_G(PG8_SA(0, 0), 0, gN, 0); else PG8_STAGE_G(PG8_SA(0, 0), (size_t)(t + 2) * kstep, gC, 0); } else PG8_STAGE(PG8_SA(0, 0), a2, voffA);
            PG8_WAIT_V(8); PG8_WAIT_L(0); PG8_BAR; PG8_MMA(1, 0, At, B0); PG8_MMA(1, 1, At, B1); PG8_BAR; PG8_SCHED;
            PG8_LDB(B0, 1, 0); PG8_LDB(B1, 1, 1); PG8_SCHED; PG8_LDA(At, 1, 0);
            if constexpr (GATHER) { if (last) PG8_STAGE_G(PG8_SA(0, 1), 0, gN, 1); else PG8_STAGE_G(PG8_SA(0, 1), (size_t)(t + 2) * kstep, gC, 1); } else PG8_STAGE(PG8_SA(0, 1), a2 + hsA, voffA);
            PG8_WAIT_V(8); PG8_WAIT_L(0); PG8_BAR; PG8_MMA(0, 0, At, B0); PG8_MMA(0, 1, At, B1); PG8_BAR; PG8_SCHED;
            PG8_LDA(At, 1, 1); PG8_STAGE(PG8_SB(1, 0), b3, voffB); PG8_STAGE(PG8_SB(1, 1), b3 + hsB, voffB);
            if constexpr (GATHER) { if (last) PG8_STAGE_G(PG8_SA(1, 0), kstep, gN, 0); else PG8_STAGE_G(PG8_SA(1, 0), (size_t)(t + 3) * kstep, gC, 0); } else PG8_STAGE(PG8_SA(1, 0), a3, voffA);
            PG8_WAIT_V(8); PG8_WAIT_L(0); PG8_BAR; PG8_MMA(1, 0, At, B0); PG8_MMA(1, 1, At, B1); PG8_BAR; PG8_SCHED;
            } else {
            PG8_LDB(B0, 0, 0); PG8_SCHED; PG8_LDA(At, 0, 0); PG8_STAGE(PG8_SA(1, 1), a1 + hsA, voffA);
            PG8_WAIT_L(8); PG8_BAR; PG8_WAIT_L(0); PG8_MMA(0, 0, At, B0); PG8_BAR; PG8_SCHED;
            PG8_LDB(B1, 0, 1); PG8_STAGE(PG8_SB(0, 0), b2, voffB);
            PG8_BAR; PG8_WAIT_L(0); PG8_MMA(0, 1, At, B1); PG8_BAR;
            PG8_LDA(At, 0, 1); PG8_STAGE(PG8_SA(0, 0), a2, voffA);
            PG8_BAR; PG8_WAIT_L(0); PG8_MMA(1, 0, At, B0); PG8_BAR; PG8_SCHED;
            PG8_STAGE(PG8_SB(0, 1), b2 + hsB, voffB);
            PG8_WAIT_V(6); PG8_BAR; PG8_MMA(1, 1, At, B1); PG8_BAR;
            PG8_LDB(B0, 1, 0); PG8_SCHED; PG8_LDA(At, 1, 0); PG8_STAGE(PG8_SA(0, 1), a2 + hsA, voffA);
            PG8_WAIT_L(8); PG8_BAR; PG8_WAIT_L(0); PG8_MMA(0, 0, At, B0); PG8_BAR; PG8_SCHED;
            PG8_LDB(B1, 1, 1); PG8_STAGE(PG8_SB(1, 0), b3, voffB);
            PG8_BAR; PG8_WAIT_L(0); PG8_MMA(0, 1, At, B1); PG8_BAR;
            PG8_LDA(At, 1, 1); PG8_STAGE(PG8_SA(1, 0), a3, voffA);
            PG8_BAR; PG8_WAIT_L(0); PG8_MMA(1, 0, At, B0); PG8_BAR; PG8_SCHED;
            PG8_STAGE(PG8_SB(1, 1), b3 + hsB, voffB);
            PG8_WAIT_V(6); PG8_BAR; PG8_MMA(1, 1, At, B1); PG8_BAR;
            }
        }
        if constexpr (ALIGN_EPI) { if (wr == 0) PG8_BAR; }
        if constexpr (!Epi::AFTER_DRAIN) { E(acc, cur, wr, wc, fr, fq); S.done(cur); }
        if (!has_next) break;
#pragma unroll
        for (int a = 0; a < 2; ++a)
#pragma unroll
            for (int b = 0; b < 2; ++b)
#pragma unroll
                for (int m = 0; m < 4; ++m)
#pragma unroll
                    for (int n = 0; n < 2; ++n) acc[a][b][m][n] = (f32x4){0.f, 0.f, 0.f, 0.f};
        cur = nxt; cA = nA; cB = nB; cB2 = nB2; ++ui;
        if constexpr (GATHER) { _Pragma("unroll") for (int _h = 0; _h < 2; ++_h) _Pragma("unroll") for (int _i = 0; _i < 2; ++_i) gC[_h][_i] = gN[_h][_i]; }
        if constexpr (ALIGN_EPI) { if (wr == 1) PG8_BAR; }
    }
    PG8_WAIT_V(0);
    if constexpr (!ALIGN_EPI) { if (wr == 0) PG8_BAR; }
    PG8_BAR;
    if constexpr (Epi::AFTER_DRAIN) { E.fused(acc, cur, wr, wc, fr, fq, lds, wid, lane); S.done(cur); }
#undef PG8_BK
#undef PG8_GOFFS
#undef PG8_STAGE_G
#undef PG8_SA
#undef PG8_SB
#undef PG8_STAGE
#undef PG8_LDA
#undef PG8_LDB
#undef PG8_MMA
#undef PG8_WAIT_V
#undef PG8_WAIT_L
#undef PG8_BAR
#undef PG8_SCHED
}
}

struct PlainOrder {
    const char* A; const char* Bt; int lda, ldb, nM, nN, nwg, G, c;
    __device__ __forceinline__ void init(const void* A_, const void* Bt_, int lda_, int ldb_, int M, int N, int G_, int c_) { A = (const char*)A_; Bt = (const char*)Bt_; lda = lda_; ldb = ldb_; nM = M / 256; nN = N / 256; nwg = nM * nN; G = G_; c = c_; }
    __device__ __forceinline__ bool next(int i, pg8::Unit& u) const {
        const long L = (long)i * G + c; if (L >= nwg) return false;
        int wgid = (int)L; { const int q = nwg / 8, r = nwg % 8, xcd = wgid % 8, off = wgid / 8; wgid = (xcd < r ? xcd * (q + 1) : r * (q + 1) + (xcd - r) * q) + off; }
        const int nig = 8 * nN, gid = wgid / nig, fm = gid * 8, gsz = (nM - fm) < 8 ? (nM - fm) : 8;
        u.pm = fm + ((wgid % nig) % gsz); u.pn = (wgid % nig) / gsz;
        u.a = A + (size_t)u.pm * 256 * lda * 2; u.b = Bt + (size_t)u.pn * 256 * ldb * 2; u.b2 = u.b; return true;
    }
    __device__ __forceinline__ void a_ready(const pg8::Unit&) const {}
    __device__ __forceinline__ void done(const pg8::Unit&) const {}
};
struct EpiInProj {
    static constexpr bool PERM = true, AFTER_DRAIN = false;
    unsigned char* ws; const float* b_gate; const float* b_fgt; unsigned* kn;
    __device__ __forceinline__ void operator()(const pg8::f32x4 (&acc)[2][2][4][2], const pg8::Unit& u, int wr, int wc, int fr, int fq) const {
        { int t_ = threadIdx.x; asm volatile("" : "+v"(t_)); fr = t_ & 15; fq = (t_ >> 4) & 3; }
        const int pn = u.pn, b = (u.pm * 256) / T_, t0 = u.pm * 256 - b * T_ + wr * 64 + fr;
        if (pn == 11) {
            if (wc == 0 && fq < 4) {
                float* gate = (float*)(ws + WS_GATE); float* fl = (float*)(ws + WS_FL);
#pragma unroll
                for (int ai = 0; ai < 2; ++ai)
#pragma unroll
                    for (int m = 0; m < 4; ++m) { const int t = t0 + ai * 128 + m * 16; const size_t n = (size_t)b * T_ + t;
#pragma unroll
                        for (int nn = 0; nn < 2; ++nn)
#pragma unroll
                            for (int e = 0; e < 4; ++e) { const int c = 8 * fq + 4 * nn + e; const float v = acc[ai][0][m][nn][e];
                                if (c < 24) gate[n * 24 + c] = __builtin_amdgcn_rcpf(1.f + __builtin_amdgcn_exp2f(-(v + b_gate[c]) * LOG2E));
                                else if (c < 28) { const float z = v + b_fgt[c - 24];
                                    fl[(size_t)(b * 4 + (c - 24)) * T_ + t] = z < -30.f ? z : -0.6931471805599453f * __builtin_amdgcn_logf(1.f + __builtin_amdgcn_exp2f(-z * LOG2E)); } } }
            }
            return;
        }
        if (pn == 6 || pn == 9) {
            const int lane_ = (fq << 4) | fr;
#pragma unroll
            for (int bj = 0; bj < 2; ++bj)
#pragma unroll
                for (int ai = 0; ai < 2; ++ai) { float mx = 0.f;
#pragma unroll
                    for (int m = 0; m < 4; ++m) { const pg8::f32x4 v0 = acc[ai][bj][m][0], v1 = acc[ai][bj][m][1];
                        float ss = (v0[0] * v0[0] + v0[1] * v0[1]) + (v0[2] * v0[2] + v0[3] * v0[3]) + (v1[0] * v1[0] + v1[1] * v1[1]) + (v1[2] * v1[2] + v1[3] * v1[3]);
                        ss += shflx_f(ss, 16, lane_); ss += shflx_f(ss, 32, lane_); mx = fmaxf(mx, ss); }
#pragma unroll
                    for (int o = 1; o < 16; o <<= 1) mx = fmaxf(mx, shflx_f(mx, o, lane_));
                    if (lane_ == 0) { const int cg = bj * 4 + wc, tile = (u.pm * 256 - b * T_ + ai * 128 + wr * 64) >> 6;
                        unsigned* dst = pn == 6 ? kn + ((b * 4 + (cg >> 1)) * 64 + tile) * 2 + (cg & 1) : kn + 4096 + (b * 8 + cg) * 64 + tile;
                        atomicMax(dst, __float_as_uint(mx)); } }
        }
#pragma unroll
        for (int bj = 0; bj < 2; ++bj) {
            const int c = bj * 128 + wc * 32 + 8 * fq;
            bf16* base; int W = 64; float sc = 1.f;
            if (pn < 2) { base = (bf16*)(ws + WS_QN) + (size_t)(b * 8 + pn * 4 + (c >> 6)) * T_ * 64 + (c & 63); sc = 0.125f * LOG2E; }
            else if (pn < 5) { base = (bf16*)(ws + WS_KV6 + (size_t)((pn - 2) * 2 + (c >> 7)) * KV6_STRIDE) + (size_t)(b * 2 + ((c >> 6) & 1)) * T_ * 64 + (c & 63); }
            else if (pn < 8) { base = (bf16*)(ws + WS_FQKV) + (size_t)(pn - 5) * (8 * MiB) + (size_t)(b * 4 + (c >> 6)) * T_ * 64 + (c & 63); if (pn == 5) sc = 0.125f * LOG2E; }
            else if (pn < 10) { base = (bf16*)(ws + WS_DQK) + (size_t)(pn - 8) * (8 * MiB) + (size_t)(b * 8 + (c >> 5)) * T_ * 32 + (c & 31); W = 32; if (pn == 8) sc = 0.17677669529663687f * LOG2E; }
            else { base = (bf16*)(ws + WS_DV) + (size_t)(b * 4 + (c >> 6)) * T_ * 64 + (c & 63); }
            const bool blk = W == 64 && pn != 2;
            if (blk) base += -(c & 63) + ((c >> 5) & 1) * 512 + (c & 31);
#pragma unroll
            for (int ai = 0; ai < 2; ++ai)
#pragma unroll
                for (int m = 0; m < 4; ++m) { const int t = t0 + ai * 128 + m * 16;
                    const pg8::f32x4 v0 = acc[ai][bj][m][0] * sc, v1 = acc[ai][bj][m][1] * sc;
                    pg8::u32x4 w; w.x = pg8::cvt_pk_bf16(v0[0], v0[1]); w.y = pg8::cvt_pk_bf16(v0[2], v0[3]); w.z = pg8::cvt_pk_bf16(v1[0], v1[1]); w.w = pg8::cvt_pk_bf16(v1[2], v1[3]);
                    *(pg8::u32x4*)(base + (blk ? (size_t)((t >> 4) * 1024 + (t & 15) * 32) : (size_t)t * W)) = w; }
        }
    }
};
struct EpiResBf16 {
    static constexpr bool PERM = false, AFTER_DRAIN = false;
    bf16* xr;
    __device__ __forceinline__ void operator()(const pg8::f32x4 (&acc)[2][2][4][2], const pg8::Unit& u, int wr, int wc, int fr, int fq) const {
        { int t_ = threadIdx.x; asm volatile("" : "+v"(t_)); fr = t_ & 15; fq = (t_ >> 4) & 3; }
#pragma unroll
        for (int ai = 0; ai < 2; ++ai)
#pragma unroll
            for (int m = 0; m < 4; ++m) { const size_t off = (size_t)(u.pm * 256 + ai * 128 + wr * 64 + m * 16 + fr) * D_ + u.pn * 256 + wc * 32 + 4 * fq;
#pragma unroll
                for (int bj = 0; bj < 2; ++bj)
#pragma unroll
                    for (int n = 0; n < 2; ++n) { const u64 w = *(const u64*)(xr + off + bj * 128 + n * 16);
                        const pg8::f32x4 bs = {__uint_as_float((unsigned)w << 16), __uint_as_float((unsigned)w & 0xffff0000u), __uint_as_float((unsigned)(w >> 32) << 16), __uint_as_float((unsigned)(w >> 32) & 0xffff0000u)};
                        const pg8::f32x4 o = bs + acc[ai][bj][m][n];
                        *(u64*)(xr + off + bj * 128 + n * 16) = (u64)pg8::cvt_pk_bf16(o[0], o[1]) | ((u64)pg8::cvt_pk_bf16(o[2], o[3]) << 32); } }
    }
};


struct EpiDummy {
    static constexpr bool PERM = true, AFTER_DRAIN = false;
    float* dst;
    __device__ __forceinline__ void operator()(const pg8::f32x4 (&acc)[2][2][4][2], const pg8::Unit& u, int wr, int wc, int fr, int fq) const {
        pg8::f32x4 a = {0.f, 0.f, 0.f, 0.f};
#pragma unroll
        for (int ai = 0; ai < 2; ++ai)
#pragma unroll
            for (int bj = 0; bj < 2; ++bj)
#pragma unroll
                for (int m = 0; m < 4; ++m) { a = a + acc[ai][bj][m][0]; a = a + acc[ai][bj][m][1]; }
        *(pg8::f32x4*)(dst + ((size_t)(u.pm * 12 + u.pn) * 512 + threadIdx.x) * 4) = a;
    }
};
struct OneUnitOrder { pg8::Unit u; bool has;
    __device__ __forceinline__ bool next(int i, pg8::Unit& o) const { if (i != 0 || !has) return false; o = u; return true; }
    __device__ __forceinline__ void a_ready(const pg8::Unit&) const {}
    __device__ __forceinline__ void done(const pg8::Unit&) const {} };
__device__ __forceinline__ float gelu_tanh_fast(float x) { const float u2 = 1.5957691216057308f * (x + 0.044715f * x * x * x); return x * __builtin_amdgcn_rcpf(1.f + __builtin_amdgcn_exp2f(-u2 * LOG2E)); }
struct EpiCmpH {
    static constexpr bool PERM = true, AFTER_DRAIN = false;
    bf16* hc; const float* bias1;
    __device__ __forceinline__ void operator()(const pg8::f32x4 (&acc)[2][2][4][2], const pg8::Unit& u, int wr, int wc, int fr, int fq) const {
        { int t_ = threadIdx.x; asm volatile("" : "+v"(t_)); fr = t_ & 15; fq = (t_ >> 4) & 3; }
        const int kv = u.pn;
#pragma unroll
        for (int bj = 0; bj < 2; ++bj) { const int col = bj * 128 + wc * 32 + 8 * fq;
            const pg8::f32x4 b0 = *(const pg8::f32x4*)(bias1 + kv * 256 + col), b1 = *(const pg8::f32x4*)(bias1 + kv * 256 + col + 4);
#pragma unroll
            for (int ai = 0; ai < 2; ++ai)
#pragma unroll
                for (int m = 0; m < 4; ++m) { const int row = u.pm * 256 + ai * 128 + wr * 64 + m * 16 + fr;
                    const pg8::f32x4 v0 = acc[ai][bj][m][0] + b0, v1 = acc[ai][bj][m][1] + b1;
                    pg8::u32x4 w; w.x = pg8::cvt_pk_bf16(gelu_tanh_fast(v0[0]), gelu_tanh_fast(v0[1])); w.y = pg8::cvt_pk_bf16(gelu_tanh_fast(v0[2]), gelu_tanh_fast(v0[3]));
                    w.z = pg8::cvt_pk_bf16(gelu_tanh_fast(v1[0]), gelu_tanh_fast(v1[1])); w.w = pg8::cvt_pk_bf16(gelu_tanh_fast(v1[2]), gelu_tanh_fast(v1[3]));
                    *(pg8::u32x4*)(hc + ((size_t)kv * 4096 + row) * 256 + col) = w; } }
    }
};
struct EpiCmpOut {
    static constexpr bool PERM = true, AFTER_DRAIN = false;
    bf16* kvcmp;
    __device__ __forceinline__ void operator()(const pg8::f32x4 (&acc)[2][2][4][2], const pg8::Unit& u, int wr, int wc, int fr, int fq) const {
        { int t_ = threadIdx.x; asm volatile("" : "+v"(t_)); fr = t_ & 15; fq = (t_ >> 4) & 3; }
        if (wc >= 2) return;
        const int kv = u.pn, col = wc * 32 + 8 * fq;
#pragma unroll
        for (int ai = 0; ai < 2; ++ai)
#pragma unroll
            for (int m = 0; m < 4; ++m) { const int row = u.pm * 256 + ai * 128 + wr * 64 + m * 16 + fr; const float z = ((row & 255) == 255) ? 0.f : 1.f;
                const pg8::f32x4 v0 = acc[ai][0][m][0], v1 = acc[ai][0][m][1];
                pg8::u32x4 w; w.x = pg8::cvt_pk_bf16(z != 0.f ? v0[0] : 0.f, z != 0.f ? v0[1] : 0.f); w.y = pg8::cvt_pk_bf16(z != 0.f ? v0[2] : 0.f, z != 0.f ? v0[3] : 0.f);
                w.z = pg8::cvt_pk_bf16(z != 0.f ? v1[0] : 0.f, z != 0.f ? v1[1] : 0.f); w.w = pg8::cvt_pk_bf16(z != 0.f ? v1[2] : 0.f, z != 0.f ? v1[3] : 0.f);
                *(pg8::u32x4*)(kvcmp + ((size_t)kv * 4096 + row) * 64 + col) = w; }
    }
};

__device__ __forceinline__ void moe_build_tables(const unsigned* cnt, int tid) {
    LAS int* T = (LAS int*)((LAS unsigned char*)lds_raw + TBL_OFF);
    __syncthreads();
    if (tid < 112) T[384 + tid] = (int)cnt[tid * MOE_CS];
    __syncthreads();
    if (tid == 0) { int o = 0; for (int c = 0; c < 112; ++c) { T[c] = o; const int n = (T[384 + c] + 255) >> 8; for (int k = 0; k < n; ++k) T[128 + o + k] = c; o += n; } T[112] = o; }
    __syncthreads();
}
__device__ __forceinline__ void moe_pair(int cls, int& ea, int& eb) { const int grp = cls / 28; int idx = cls % 28, lo = 0; while (idx >= 7 - lo) { idx -= 7 - lo; ++lo; } ea = grp * 8 + lo; eb = grp * 8 + lo + 1 + idx; }
struct MoeOrder1 {
    const char* wsb; const unsigned* rec; const char* wgu; int G, c;
    __device__ __forceinline__ bool next(int i, pg8::Unit& u) const {
        const LAS int* T = (const LAS int*)((LAS unsigned char*)lds_raw + TBL_OFF);
        const int idx = i * G + c; if (idx >= 4 * T[112]) return false;
        const int tile = idx >> 2, pn = idx & 3; int ea, eb; moe_pair(T[128 + tile], ea, eb); const int e = (pn >> 1) ? eb : ea;
        u.pm = tile; u.pn = pn; u.a = wsb; u.b = wgu + ((size_t)e * 512 + (pn & 1) * 256) * 2048; u.b2 = u.b; return true; }
    __device__ __forceinline__ const char* abase() const { return wsb; }
    __device__ __forceinline__ unsigned arow(const pg8::Unit& u, int r) const {
        const LAS int* T = (const LAS int*)((LAS unsigned char*)lds_raw + TBL_OFF);
        const int cls = T[128 + u.pm], vr = (u.pm - T[cls]) * 256 + r;
        unsigned off = ZROW_OFF;
        if (vr < T[384 + cls]) off = (unsigned)WS_HN + rec[((size_t)cls * 32768 + vr) * 4] * 2048u;
        return off; }
    __device__ __forceinline__ void a_ready(const pg8::Unit&) const {}
    __device__ __forceinline__ void done(const pg8::Unit&) const {} };
struct MoeOrder2 {
    const char* hb; const char* wd; int G, c;
    __device__ __forceinline__ bool next(int i, pg8::Unit& u) const {
        const LAS int* T = (const LAS int*)((LAS unsigned char*)lds_raw + TBL_OFF);
        const int idx = i * G + c; if (idx >= 4 * T[112]) return false;
        const int tile = idx >> 2, pn = idx & 3; int ea, eb; moe_pair(T[128 + tile], ea, eb);
        u.pm = tile; u.pn = pn; u.a = hb + (size_t)tile * 256 * 1024; u.b = wd + ((size_t)ea * 1024 + pn * 256) * 512; u.b2 = wd + ((size_t)eb * 1024 + pn * 256) * 512; return true; }
    __device__ __forceinline__ void a_ready(const pg8::Unit&) const {}
    __device__ __forceinline__ void done(const pg8::Unit&) const {} };
struct EpiMoeH {
    static constexpr bool PERM = true, AFTER_DRAIN = false;
    bf16* hb; const u32x4* rec;
    __device__ __forceinline__ void operator()(const pg8::f32x4 (&acc)[2][2][4][2], const pg8::Unit& u, int wr, int wc, int fr, int fq) const {
        { int t_ = threadIdx.x; asm volatile("" : "+v"(t_)); fr = t_ & 15; fq = (t_ >> 4) & 3; }
        const int slot = u.pn >> 1;
        const LAS int* T = (const LAS int*)((LAS unsigned char*)lds_raw + TBL_OFF);
        const int cls = T[128 + u.pm], vr0 = (u.pm - T[cls]) * 256, ncls = T[384 + cls];
#pragma unroll
        for (int ai = 0; ai < 2; ++ai)
#pragma unroll
            for (int m = 0; m < 4; ++m) { const int rr = ai * 128 + wr * 64 + m * 16 + fr; const size_t row = (size_t)u.pm * 256 + rr; float w = 0.f, rs = 0.f;
                if (vr0 + rr < ncls) { const u32x4 q = rec[(size_t)cls * 32768 + vr0 + rr]; w = __uint_as_float(slot ? q.z : q.y); rs = __uint_as_float(q.w); }
#pragma unroll
                for (int bj = 0; bj < 2; ++bj) { const int j0 = (u.pn & 1) * 128 + (bj * 128 + wc * 32 + 8 * fq) / 2;
                    pg8::f32x4 v0 = acc[ai][bj][m][0], v1 = acc[ai][bj][m][1];
#pragma unroll
                    for (int e = 0; e < 4; ++e) { v0[e] *= rs; v1[e] *= rs; }
                    const float h0 = v0[0] * __builtin_amdgcn_rcpf(1.f + __builtin_amdgcn_exp2f(-v0[0] * LOG2E)) * v0[1] * w, h1 = v0[2] * __builtin_amdgcn_rcpf(1.f + __builtin_amdgcn_exp2f(-v0[2] * LOG2E)) * v0[3] * w;
                    const float h2 = v1[0] * __builtin_amdgcn_rcpf(1.f + __builtin_amdgcn_exp2f(-v1[0] * LOG2E)) * v1[1] * w, h3 = v1[2] * __builtin_amdgcn_rcpf(1.f + __builtin_amdgcn_exp2f(-v1[2] * LOG2E)) * v1[3] * w;
                    const int jg = slot * 256 + j0;
                    *(u64*)(hb + ((row >> 4) * 32 + (jg >> 4)) * 256 + (row & 15) * 16 + (jg & 15)) = (u64)pg8::cvt_pk_bf16(h0, h1) | ((u64)pg8::cvt_pk_bf16(h2, h3) << 32); } }
    }
};
struct EpiMoeOut {
    static constexpr bool PERM = false, AFTER_DRAIN = false;
    bf16* x; const unsigned* rec;
    __device__ __forceinline__ void operator()(const pg8::f32x4 (&acc)[2][2][4][2], const pg8::Unit& u, int wr, int wc, int fr, int fq) const {
        { int t_ = threadIdx.x; asm volatile("" : "+v"(t_)); fr = t_ & 15; fq = (t_ >> 4) & 3; }
        bf16* xx = x; const unsigned* rt = rec; asm volatile("" : "+s"(xx), "+s"(rt));
        const LAS int* T = (const LAS int*)((LAS unsigned char*)lds_raw + TBL_OFF);
        const int cls = T[128 + u.pm], vr0 = (u.pm - T[cls]) * 256, ncls = T[384 + cls];
#pragma unroll
        for (int ai = 0; ai < 2; ++ai)
#pragma unroll
            for (int m = 0; m < 4; ++m) { const int rr = ai * 128 + wr * 64 + m * 16 + fr; int tok = -1; if (vr0 + rr < ncls) tok = (int)rt[((size_t)cls * 32768 + vr0 + rr) * 4];
                if (tok >= 0) { bf16* xr = xx + (size_t)tok * D_ + u.pn * 256 + wc * 32 + 4 * fq;
#pragma unroll
                    for (int bj = 0; bj < 2; ++bj)
#pragma unroll
                        for (int n = 0; n < 2; ++n) { u64* q = (u64*)(xr + bj * 128 + n * 16); const u64 w = *q; const pg8::f32x4 a = acc[ai][bj][m][n];
                            *q = (u64)pg8::cvt_pk_bf16(__uint_as_float((unsigned)w << 16) + a[0], __uint_as_float((unsigned)w & 0xffff0000u) + a[1]) | ((u64)pg8::cvt_pk_bf16(__uint_as_float((unsigned)(w >> 32) << 16) + a[2], __uint_as_float((unsigned)(w >> 32) & 0xffff0000u) + a[3]) << 32); } } }
    }
};

__device__ __forceinline__ void transpose_item(const float* W, int ldw, bf16* WT, int ldt, int r0, int rmul, int k0, LAS float* scr, int lane, const float* gk = nullptr) {
    f32x4 v[8];
#pragma unroll
    for (int i = 0; i < 8; ++i) v[i] = *(const f32x4*)(W + (size_t)(k0 + i * 8 + (lane >> 3)) * ldw + (lane & 7) * 4);
    if (gk) {
#pragma unroll
        for (int i = 0; i < 8; ++i) { const float gsc = gk[k0 + i * 8 + (lane >> 3)]; v[i].x *= gsc; v[i].y *= gsc; v[i].z *= gsc; v[i].w *= gsc; } }
#pragma unroll
    for (int i = 0; i < 8; ++i) { LAS float* d = scr + (i * 8 + (lane >> 3)) * 33 + (lane & 7) * 4; d[0] = v[i].x; d[1] = v[i].y; d[2] = v[i].z; d[3] = v[i].w; }
    asm volatile("s_waitcnt lgkmcnt(0)" ::: "memory");
    const int c = lane & 7;
#pragma unroll
    for (int j = 0; j < 4; ++j) { const int n = (lane >> 3) + 8 * j; const LAS float* sp = scr + (8 * c) * 33 + n;
        u32x4 o; o.x = pk2(sp[0 * 33], sp[1 * 33]); o.y = pk2(sp[2 * 33], sp[3 * 33]); o.z = pk2(sp[4 * 33], sp[5 * 33]); o.w = pk2(sp[6 * 33], sp[7 * 33]);
        *(u32x4*)(WT + (size_t)(r0 + rmul * n) * ldt + k0 + 8 * c) = o; }
    asm volatile("s_waitcnt lgkmcnt(0)" ::: "memory");
}
__device__ __forceinline__ void transpose_seg(const float* W, int ldw, int K, int sc0, int ncol, bf16* WT, int r0, int rmul, int item, LAS float* scr, int lane, const float* gk = nullptr) {
    const int nb = ncol / 32, kb = item / nb, cb = item % nb;
    transpose_item(W + sc0 + cb * 32, ldw, WT, K, r0 + rmul * cb * 32, rmul, kb * 64, scr, lane, gk);
}

typedef float f32x16 __attribute__((ext_vector_type(16)));
typedef short bf16x8v __attribute__((ext_vector_type(8)));
typedef short s16x4 __attribute__((ext_vector_type(4)));
typedef float f32x2_t __attribute__((ext_vector_type(2)));
typedef __bf16 bf16x2_t __attribute__((ext_vector_type(2)));
constexpr int A_KBUF = 10240, A_VBUF = 12288;
constexpr int A_KOFF = 0, A_VOFF = 2 * A_KBUF, A_BOFF = A_VOFF + 2 * A_VBUF, A_LDS_END = A_BOFF + 2 * 256;
__device__ __forceinline__ constexpr int crow0(int reg) { return (reg & 3) + 8 * (reg >> 2); }
__device__ __forceinline__ float swap_max(float m) { auto rr = __builtin_amdgcn_permlane32_swap(__float_as_uint(m), __float_as_uint(m), false, false); return fmaxf(__uint_as_float(rr[0]), __uint_as_float(rr[1])); }
__device__ __forceinline__ float swap_sum(float m) { auto rr = __builtin_amdgcn_permlane32_swap(__float_as_uint(m), __float_as_uint(m), false, false); return __uint_as_float(rr[0]) + __uint_as_float(rr[1]); }
__device__ __forceinline__ unsigned cvtpk(float lo, float hi) { f32x2_t v = {lo, hi}; bf16x2_t b = __builtin_convertvector(v, bf16x2_t); return __builtin_bit_cast(unsigned, b); }
__device__ __forceinline__ bf16x8v pack8(const f32x16& p, int b0) { u32x4 w; w.x = cvtpk(p[b0 + 0], p[b0 + 1]); w.y = cvtpk(p[b0 + 2], p[b0 + 3]); w.z = cvtpk(p[b0 + 4], p[b0 + 5]); w.w = cvtpk(p[b0 + 6], p[b0 + 7]); return __builtin_bit_cast(bf16x8v, w); }
__device__ __forceinline__ s16x4 tr_read(const LAS unsigned char* p) { typedef short v4i16_t __attribute__((ext_vector_type(4))); return __builtin_bit_cast(s16x4, __builtin_amdgcn_ds_read_tr16_b64_v4i16((LAS v4i16_t*)p)); }

template <int DQK>
__device__ __forceinline__ void attn_preload(const bf16* Kb0, const bf16* Kb1, const bf16* Vb, int j, int tid, u32x4& kreg, u32x4& vreg) {
    const bf16* ksrc;
    if (DQK == 64) ksrc = Kb0 + b64_off(tid >> 3, (tid & 7) * 8); else { const int mp = tid >> 8, tt = tid & 255; ksrc = (mp ? Kb1 : Kb0) + (tt >> 2) * 32 + (tt & 3) * 8; }
    const bf16* vsrc = Vb + b64_off(tid >> 3, (tid & 7) * 8);
    kreg = *(const u32x4*)(ksrc + (size_t)(j * 64) * DQK); vreg = *(const u32x4*)(vsrc + (size_t)(j * 64) * 64);
}
template <int DQK, int NMAP, bool FOX, bool SLC, bool PRE = false>
__device__ __forceinline__ void attn_core(LAS unsigned char* L, const bf16* Kb0, const bf16* Kb1, const bf16* Vb, const LAS float* cum, float cum_ref,
                                          const bf16x8v (&Qf)[NMAP][DQK / 16], u64 tilemask, int t_lane, int tw0, int win, float slope2, unsigned selw0, unsigned selw1,
                                          f32x16 (&O)[NMAP][2], float (&M)[NMAP], float (&Ls)[NMAP], int tid, bool started0 = false, int jpre = 0, u32x4 kpre = (u32x4){0u, 0u, 0u, 0u}, u32x4 vpre = (u32x4){0u, 0u, 0u, 0u}) {
    constexpr int KP = DQK * 2 + 16, VP = 192;
    const int lane = tid & 63, r = lane & 31, h = lane >> 5;
    int kdst; const bf16* ksrc;
    if (DQK == 64) { kdst = (tid >> 3) * KP + (tid & 7) * 16; ksrc = Kb0 + b64_off(tid >> 3, (tid & 7) * 8); }
    else { const int mp = tid >> 8, tt = tid & 255; kdst = mp * 5120 + (tt >> 2) * KP + (tt & 3) * 16; ksrc = (mp ? Kb1 : Kb0) + (tt >> 2) * 32 + (tt & 3) * 8; }
    const int vdst = (tid >> 3) * VP + (tid & 7) * 16; const bf16* vsrc = Vb + b64_off(tid >> 3, (tid & 7) * 8);
    const LAS unsigned char* kfrag = L + A_KOFF + r * KP + h * 16;
    const LAS unsigned char* vfrag = L + A_VOFF + (4 * h + ((lane & 15) >> 2)) * VP + (16 * ((lane >> 4) & 1) + 4 * (lane & 3)) * 2;
    u32x4 kreg, vreg; float breg = 0.f;
    u64 mk = tilemask;
    int j = PRE ? jpre : 63 - __builtin_clzll(mk); mk &= ~(1ull << j);
    { const int kv0 = j * 64; if (PRE) { kreg = kpre; vreg = vpre; } else { kreg = *(const u32x4*)(ksrc + (size_t)kv0 * DQK); vreg = *(const u32x4*)(vsrc + (size_t)kv0 * 64); } if (FOX && tid < 64) breg = (cum_ref - cum[kv0 + tid]) * LOG2E; }
    *(LAS u32x4*)(L + A_KOFF + kdst) = kreg; *(LAS u32x4*)(L + A_VOFF + vdst) = vreg; if (FOX && tid < 64) *(LAS float*)(L + A_BOFF + tid * 4) = breg;
    __syncthreads();
    int buf = 0; bool started = started0;
    float pdummy = 0.f; int idummy = 0; f32x16 dm0; for (int i = 0; i < 16; ++i) dm0[i] = 0.f;
    for (;;) {
        const bool more = mk != 0ull; int jn = 0;
        if (more) { jn = 63 - __builtin_clzll(mk); mk &= ~(1ull << jn); const int kv0 = jn * 64;
            kreg = *(const u32x4*)(ksrc + (size_t)kv0 * DQK); vreg = *(const u32x4*)(vsrc + (size_t)kv0 * 64); if (FOX && tid < 64) breg = (cum_ref - cum[kv0 + tid]) * LOG2E; }
        { const int kv0 = j * 64;
          bool wave_has = true; float selb = 0.f;
          if (SLC) { const bool mine = ((j < 32 ? (selw0 >> j) : (selw1 >> (j - 32))) & 1u) != 0u; selb = mine ? 0.f : -INFINITY; wave_has = __any(mine); }
          if (wave_has && !(kv0 > tw0 + 31) && !(tw0 - (kv0 + 63) >= win)) {
            const bool need_mask = (kv0 + 63 > tw0) || (tw0 + 31 - kv0 >= win);
            const int dl = t_lane - kv0 - 4 * h;
            bf16x8v pa[NMAP][4];
#pragma unroll
            for (int mp = 0; mp < NMAP; ++mp) {
                f32x16 p0, p1;
                if (FOX) { const LAS f32x4* bl = (const LAS f32x4*)(L + A_BOFF + buf * 256) + h; const float mm = M[mp];
#pragma unroll
                    for (int g4 = 0; g4 < 4; ++g4) { const f32x4 b0 = bl[2 * g4], b1 = bl[8 + 2 * g4];
                        p0[4 * g4 + 0] = b0.x - mm; p0[4 * g4 + 1] = b0.y - mm; p0[4 * g4 + 2] = b0.z - mm; p0[4 * g4 + 3] = b0.w - mm; p1[4 * g4 + 0] = b1.x - mm; p1[4 * g4 + 1] = b1.y - mm; p1[4 * g4 + 2] = b1.z - mm; p1[4 * g4 + 3] = b1.w - mm; } }
                else { const float base_l = (slope2 * (float)(kv0 + 4 * h - tw0) - M[mp]) + selb, s8 = slope2 * 8.f, s32 = slope2 * 32.f;
                    p0[0] = base_l; p0[1] = p0[0] + slope2; p0[2] = p0[1] + slope2; p0[3] = p0[2] + slope2;
#pragma unroll
                    for (int reg = 4; reg < 16; ++reg) p0[reg] = p0[reg - 4] + s8;
#pragma unroll
                    for (int reg = 0; reg < 16; ++reg) p1[reg] = p0[reg] + s32; }
                const LAS unsigned char* kb = kfrag + buf * A_KBUF + (DQK == 32 ? mp * 5120 : 0);
#pragma unroll
                for (int s = 0; s < DQK / 16; ++s) { const bf16x8v kf0 = *(const LAS bf16x8v*)(kb + s * 32), kf1 = *(const LAS bf16x8v*)(kb + 32 * KP + s * 32);
#ifdef PROBE_X_LDSK
                    { const bf16x8v z0 = *(const volatile LAS bf16x8v*)(kb + s * 32), z1 = *(const volatile LAS bf16x8v*)(kb + 32 * KP + s * 32); idummy ^= z0[0] ^ z1[1]; }
#endif
#ifdef PROBE_X_MFMA
                    dm0 = __builtin_amdgcn_mfma_f32_32x32x16_bf16(kf0, Qf[mp][s], dm0, 0, 0, 0); dm0 = __builtin_amdgcn_mfma_f32_32x32x16_bf16(kf1, Qf[mp][s], dm0, 0, 0, 0);
#endif
                    p0 = __builtin_amdgcn_mfma_f32_32x32x16_bf16(kf0, Qf[mp][s], p0, 0, 0, 0); p1 = __builtin_amdgcn_mfma_f32_32x32x16_bf16(kf1, Qf[mp][s], p1, 0, 0, 0); }
                if (need_mask) {
#pragma unroll
                    for (int reg = 0; reg < 16; ++reg) { const int d0 = dl - crow0(reg), d1 = d0 - 32;
                        p0[reg] = (d0 >= 0 && d0 < win) ? p0[reg] : -INFINITY; p1[reg] = (d1 >= 0 && d1 < win) ? p1[reg] : -INFINITY; } }
                float mt = fmaxf(fmaxf(p0[0], p1[0]), fmaxf(p0[1], p1[1]));
#pragma unroll
                for (int reg = 2; reg < 16; reg += 2) mt = fmaxf(fmaxf(mt, fmaxf(fmaxf(p0[reg], p1[reg]), p0[reg + 1])), p1[reg + 1]);
                mt = swap_max(mt);
                if (!started || __any(mt > 8.f)) {
                    const float d = (mt > -1e30f) ? (started ? fmaxf(mt, 0.f) : mt) : 0.f, alpha = __builtin_amdgcn_exp2f(-d);
                    O[mp][0] *= alpha; O[mp][1] *= alpha; Ls[mp] *= alpha; M[mp] += d;
#pragma unroll
                    for (int reg = 0; reg < 16; ++reg) { p0[reg] -= d; p1[reg] -= d; } }
                float rs = 0.f;
#ifdef PROBE_X_EXP
#pragma unroll
                for (int reg = 0; reg < 16; ++reg) { pdummy += __builtin_amdgcn_exp2f(p0[reg] - 1.f) + __builtin_amdgcn_exp2f(p1[reg] - 1.f); }
#endif
#pragma unroll
                for (int reg = 0; reg < 16; ++reg) { p0[reg] = __builtin_amdgcn_exp2f(p0[reg]); p1[reg] = __builtin_amdgcn_exp2f(p1[reg]); rs += p0[reg] + p1[reg]; }
                Ls[mp] += rs;
                pa[mp][0] = pack8(p0, 0); pa[mp][1] = pack8(p0, 8); pa[mp][2] = pack8(p1, 0); pa[mp][3] = pack8(p1, 8);
            }
            started = true;
            const LAS unsigned char* vb = vfrag + buf * A_VBUF;
#pragma unroll
            for (int db = 0; db < 2; ++db)
#pragma unroll
                for (int ks = 0; ks < 4; ++ks) { const s16x4 lo = tr_read(vb + ks * (16 * VP) + db * 64), hi = tr_read(vb + ks * (16 * VP) + db * 64 + 8 * VP);
                    const bf16x8v vf = {lo[0], lo[1], lo[2], lo[3], hi[0], hi[1], hi[2], hi[3]};
#pragma unroll
                    for (int mp = 0; mp < NMAP; ++mp) O[mp][db] = __builtin_amdgcn_mfma_f32_32x32x16_bf16(vf, pa[mp][ks], O[mp][db], 0, 0, 0); }
          } }
        if (more) { *(LAS u32x4*)(L + A_KOFF + (buf ^ 1) * A_KBUF + kdst) = kreg; *(LAS u32x4*)(L + A_VOFF + (buf ^ 1) * A_VBUF + vdst) = vreg; if (FOX && tid < 64) *(LAS float*)(L + A_BOFF + (buf ^ 1) * 256 + tid * 4) = breg; }
#ifdef PROBE_X_BAR
        __syncthreads();
#endif
        __syncthreads();
        if (!more) break;
        j = jn; buf ^= 1;
    }
    if (pdummy == 123.456f || idummy == 0x7fffabcd || dm0[3] == 98765.4321f) Ls[0] += 1e-30f;
}
#ifndef AC2_MODE
#define AC2_MODE 0
#endif
#ifndef AC2_INIT_VALU
#define AC2_INIT_VALU 24
#endif
template <bool FOX, bool SLC>
__device__ __forceinline__ void attn_core2(LAS unsigned char* L, const bf16* Kb0, const bf16* Vb, const LAS float* cum, float cum_ref,
                                           const bf16x8v (&Qf)[4], u64 tilemask, int t_lane, int tw0, int win, float slope2, unsigned selw0, unsigned selw1,
                                           f32x16 (&O)[2], float& M, float& Ls, int tid) {
    constexpr int KP = 144, VP = 192;
    const int lane = tid & 63, r = lane & 31, h = lane >> 5;
    const int kdst = (tid >> 3) * KP + (tid & 7) * 16; const bf16* ksrc = Kb0 + b64_off(tid >> 3, (tid & 7) * 8);
    const int vdst = (tid >> 3) * VP + (tid & 7) * 16; const bf16* vsrc = Vb + b64_off(tid >> 3, (tid & 7) * 8);
    const LAS unsigned char* kfrag = L + A_KOFF + r * KP + h * 16;
    const LAS unsigned char* vfrag = L + A_VOFF + (4 * h + ((lane & 15) >> 2)) * VP + (16 * ((lane >> 4) & 1) + 4 * (lane & 3)) * 2;
#define AC2_ACTIVE(jj) (!((jj) * 64 > tw0 + 31) && !(tw0 - ((jj) * 64 + 63) >= win))
#define AC2_INIT(jj, kslot, q0, q1) do { const int kv0_ = (jj) * 64; \
        if (FOX) { const LAS f32x4* bl = (const LAS f32x4*)(L + A_BOFF + (kslot) * 256) + h; const float mm = M; \
            _Pragma("unroll") for (int g4 = 0; g4 < 4; ++g4) { const f32x4 b0 = bl[2 * g4], b1 = bl[8 + 2 * g4]; \
                q0[4 * g4 + 0] = b0.x - mm; q0[4 * g4 + 1] = b0.y - mm; q0[4 * g4 + 2] = b0.z - mm; q0[4 * g4 + 3] = b0.w - mm; q1[4 * g4 + 0] = b1.x - mm; q1[4 * g4 + 1] = b1.y - mm; q1[4 * g4 + 2] = b1.z - mm; q1[4 * g4 + 3] = b1.w - mm; } } \
        else { float selb = 0.f; if (SLC) selb = ((((jj) < 32) ? (selw0 >> (jj)) : (selw1 >> ((jj) - 32))) & 1u) ? 0.f : -INFINITY; \
            const float base_l = (slope2 * (float)(kv0_ + 4 * h - tw0) - M) + selb, s8 = slope2 * 8.f, s32 = slope2 * 32.f; \
            q0[0] = base_l; q0[1] = q0[0] + slope2; q0[2] = q0[1] + slope2; q0[3] = q0[2] + slope2; \
            _Pragma("unroll") for (int reg = 4; reg < 16; ++reg) q0[reg] = q0[reg - 4] + s8; \
            _Pragma("unroll") for (int reg = 0; reg < 16; ++reg) q1[reg] = q0[reg] + s32; } } while (0)
#define AC2_QK(jj, kslot) do { AC2_INIT(jj, kslot, p0, p1); \
        const LAS unsigned char* kb_ = kfrag + (kslot) * A_KBUF; \
        _Pragma("unroll") for (int s_ = 0; s_ < 4; ++s_) { const bf16x8v kf0 = *(const LAS bf16x8v*)(kb_ + s_ * 32), kf1 = *(const LAS bf16x8v*)(kb_ + 32 * KP + s_ * 32); \
            p0 = __builtin_amdgcn_mfma_f32_32x32x16_bf16(kf0, Qf[s_], p0, 0, 0, 0); p1 = __builtin_amdgcn_mfma_f32_32x32x16_bf16(kf1, Qf[s_], p1, 0, 0, 0); } } while (0)
    u32x4 kreg, vreg; float breg = 0.f;
    u64 mk = tilemask;
    int j = 63 - __builtin_clzll(mk); mk &= ~(1ull << j);
    int jn = -1; if (mk) { jn = 63 - __builtin_clzll(mk); mk &= ~(1ull << jn); }
    { kreg = *(const u32x4*)(ksrc + (size_t)j * 64 * 64); vreg = *(const u32x4*)(vsrc + (size_t)j * 64 * 64); if (FOX && tid < 64) breg = (cum_ref - cum[j * 64 + tid]) * LOG2E;
      *(LAS u32x4*)(L + A_KOFF + kdst) = kreg; *(LAS u32x4*)(L + A_VOFF + vdst) = vreg; if (FOX && tid < 64) *(LAS float*)(L + A_BOFF + tid * 4) = breg;
      if (jn >= 0) { kreg = *(const u32x4*)(ksrc + (size_t)jn * 64 * 64); if (FOX && tid < 64) breg = (cum_ref - cum[jn * 64 + tid]) * LOG2E;
          *(LAS u32x4*)(L + A_KOFF + A_KBUF + kdst) = kreg; if (FOX && tid < 64) *(LAS float*)(L + A_BOFF + 256 + tid * 4) = breg; } }
    __syncthreads();
    f32x16 p0, p1;
    bool started = false;
    int ks = 0, vs = 0;
    if (AC2_ACTIVE(j)) AC2_QK(j, 0);
    for (;;) {
        int jnn = -1; if (mk) { jnn = 63 - __builtin_clzll(mk); mk &= ~(1ull << jnn); }
        if (jnn >= 0) { kreg = *(const u32x4*)(ksrc + (size_t)jnn * 64 * 64); if (FOX && tid < 64) breg = (cum_ref - cum[jnn * 64 + tid]) * LOG2E; }
        if (jn >= 0) vreg = *(const u32x4*)(vsrc + (size_t)jn * 64 * 64);
        const bool act = AC2_ACTIVE(j), actn = jn >= 0 && AC2_ACTIVE(jn);
        if (act) {
            const int kv0 = j * 64;
            if ((kv0 + 63 > tw0) || (tw0 + 31 - kv0 >= win)) { const int dl = t_lane - kv0 - 4 * h;
#pragma unroll
                for (int reg = 0; reg < 16; ++reg) { const int d0 = dl - crow0(reg), d1 = d0 - 32;
                    p0[reg] = (d0 >= 0 && d0 < win) ? p0[reg] : -INFINITY; p1[reg] = (d1 >= 0 && d1 < win) ? p1[reg] : -INFINITY; } }
            float mt = fmaxf(fmaxf(p0[0], p1[0]), fmaxf(p0[1], p1[1]));
#pragma unroll
            for (int reg = 2; reg < 16; reg += 2) mt = fmaxf(fmaxf(mt, fmaxf(fmaxf(p0[reg], p1[reg]), p0[reg + 1])), p1[reg + 1]);
            mt = swap_max(mt);
            if (!started || __any(mt > 8.f)) {
                const float d = (mt > -1e30f) ? (started ? fmaxf(mt, 0.f) : mt) : 0.f, alpha = __builtin_amdgcn_exp2f(-d);
                O[0] *= alpha; O[1] *= alpha; Ls *= alpha; M += d;
#pragma unroll
                for (int reg = 0; reg < 16; ++reg) { p0[reg] -= d; p1[reg] -= d; } }
            started = true;
#if AC2_MODE == 1
            {
                const int jq = jn >= 0 ? jn : 0;
                float rs = 0.f;
#pragma unroll
                for (int reg = 0; reg < 16; ++reg) { p0[reg] = __builtin_amdgcn_exp2f(p0[reg]); p1[reg] = __builtin_amdgcn_exp2f(p1[reg]); rs += p0[reg] + p1[reg]; }
                Ls += rs;
                const bf16x8v pa0 = pack8(p0, 0), pa1 = pack8(p0, 8), pa2 = pack8(p1, 0), pa3 = pack8(p1, 8);
                AC2_QK(jq, ks ^ 1);
                const LAS unsigned char* vb = vfrag + vs * A_VBUF;
#pragma unroll
                for (int db = 0; db < 2; ++db)
#pragma unroll
                    for (int kq = 0; kq < 4; ++kq) { const s16x4 lo = tr_read(vb + kq * (16 * VP) + db * 64), hi = tr_read(vb + kq * (16 * VP) + db * 64 + 8 * VP);
                        const bf16x8v vf = {lo[0], lo[1], lo[2], lo[3], hi[0], hi[1], hi[2], hi[3]};
                        O[db] = __builtin_amdgcn_mfma_f32_32x32x16_bf16(vf, kq == 0 ? pa0 : kq == 1 ? pa1 : kq == 2 ? pa2 : pa3, O[db], 0, 0, 0); }
            }
#else
            {
                const int jq = jn >= 0 ? jn : 0;
                f32x16 n0, n1;
                AC2_INIT(jq, ks ^ 1, n0, n1);
                const LAS unsigned char* kb_ = kfrag + (ks ^ 1) * A_KBUF;
                bf16x8v kf[8];
#pragma unroll
                for (int s_ = 0; s_ < 4; ++s_) { kf[2 * s_] = *(const LAS bf16x8v*)(kb_ + s_ * 32); kf[2 * s_ + 1] = *(const LAS bf16x8v*)(kb_ + 32 * KP + s_ * 32); }
                const LAS unsigned char* vb = vfrag + vs * A_VBUF;
                __builtin_amdgcn_sched_barrier(0);
                float ra = 0.f, rb = 0.f; unsigned w[16];
#define AC2_PINF(x) asm volatile("" : "+v"(x))
#define AC2_QGAP(i) do { if ((i) & 1) n1 = __builtin_amdgcn_mfma_f32_32x32x16_bf16(kf[i], Qf[(i) >> 1], n1, 0, 0, 0); else n0 = __builtin_amdgcn_mfma_f32_32x32x16_bf16(kf[i], Qf[(i) >> 1], n0, 0, 0, 0); \
                    float e0 = __builtin_amdgcn_exp2f(p0[2 * (i)]), e1 = __builtin_amdgcn_exp2f(p0[2 * (i) + 1]), e2 = __builtin_amdgcn_exp2f(p1[2 * (i)]), e3 = __builtin_amdgcn_exp2f(p1[2 * (i) + 1]); \
                    ra += e0 + e1; rb += e2 + e3; \
                    AC2_PINF(e0); AC2_PINF(e1); AC2_PINF(e2); AC2_PINF(e3); AC2_PINF(ra); AC2_PINF(rb); \
                    p0[2 * (i)] = e0; p0[2 * (i) + 1] = e1; p1[2 * (i)] = e2; p1[2 * (i) + 1] = e3; \
                    if ((i) >= 4) { w[2 * ((i) - 4)] = cvtpk(p0[4 * ((i) - 4)], p0[4 * ((i) - 4) + 1]); w[2 * ((i) - 4) + 1] = cvtpk(p0[4 * ((i) - 4) + 2], p0[4 * ((i) - 4) + 3]); AC2_PINF(w[2 * ((i) - 4)]); AC2_PINF(w[2 * ((i) - 4) + 1]); } \
                    if ((i) == 6) { vl[0] = tr_read(vb); vh[0] = tr_read(vb + 8 * VP); } \
                    if ((i) == 7) { vl[1] = tr_read(vb + 64); vh[1] = tr_read(vb + 64 + 8 * VP); } \
                    __builtin_amdgcn_sched_barrier(0); } while (0)
                s16x4 vl[2], vh[2];
                AC2_QGAP(0); AC2_QGAP(1); AC2_QGAP(2); AC2_QGAP(3); AC2_QGAP(4); AC2_QGAP(5); AC2_QGAP(6); AC2_QGAP(7);
                Ls += ra + rb;
#define AC2_PA(kq) __builtin_bit_cast(bf16x8v, (u32x4){w[4 * (kq)], w[4 * (kq) + 1], w[4 * (kq) + 2], w[4 * (kq) + 3]})
#define AC2_PGAP(g) do { const int kq_ = (g) >> 1, db_ = (g) & 1; const bf16x8v vf = {vl[(g) & 1][0], vl[(g) & 1][1], vl[(g) & 1][2], vl[(g) & 1][3], vh[(g) & 1][0], vh[(g) & 1][1], vh[(g) & 1][2], vh[(g) & 1][3]}; \
                    if ((g) < 6) { const int kq2 = ((g) + 2) >> 1, db2 = (g) & 1; vl[(g) & 1] = tr_read(vb + kq2 * (16 * VP) + db2 * 64); vh[(g) & 1] = tr_read(vb + kq2 * (16 * VP) + db2 * 64 + 8 * VP); } \
                    O[db_] = __builtin_amdgcn_mfma_f32_32x32x16_bf16(vf, AC2_PA(kq_), O[db_], 0, 0, 0); \
                    if ((g) < 4) { w[8 + 2 * (g)] = cvtpk(p1[4 * (g)], p1[4 * (g) + 1]); w[8 + 2 * (g) + 1] = cvtpk(p1[4 * (g) + 2], p1[4 * (g) + 3]); AC2_PINF(w[8 + 2 * (g)]); AC2_PINF(w[8 + 2 * (g) + 1]); } \
                    __builtin_amdgcn_sched_barrier(0); } while (0)
                AC2_PGAP(0); AC2_PGAP(1); AC2_PGAP(2); AC2_PGAP(3); AC2_PGAP(4); AC2_PGAP(5); AC2_PGAP(6); AC2_PGAP(7);
#undef AC2_PGAP
#undef AC2_PA
#undef AC2_QGAP
#undef AC2_PINF
                p0 = n0; p1 = n1;
            }
#endif
        } else if (actn) AC2_QK(jn, ks ^ 1);
        if (jnn >= 0) { *(LAS u32x4*)(L + A_KOFF + ks * A_KBUF + kdst) = kreg; if (FOX && tid < 64) *(LAS float*)(L + A_BOFF + ks * 256 + tid * 4) = breg; }
        if (jn >= 0) *(LAS u32x4*)(L + A_VOFF + (vs ^ 1) * A_VBUF + vdst) = vreg;
        __syncthreads();
        if (jn < 0) break;
        j = jn; jn = jnn; ks ^= 1; vs ^= 1;
    }
#undef AC2_QK
#undef AC2_INIT
#undef AC2_ACTIVE
}
__device__ __forceinline__ size_t mix_off(size_t n, int c, int W) { return ((n >> 5) * (size_t)(W / 8) + (size_t)(c >> 3)) * 256 + (n & 31) * 8 + (c & 7); }
#define ATTN_FOR_CHUNKS(db, g4) _Pragma("unroll") for (int db = 0; db < 2; ++db) _Pragma("unroll") for (int g4 = 0; g4 < 4; ++g4)

__device__ __forceinline__ void unpack8(const u32x4 w, float (&f)[8]) { f[0] = __uint_as_float(w.x << 16); f[1] = __uint_as_float(w.x & 0xffff0000u); f[2] = __uint_as_float(w.y << 16); f[3] = __uint_as_float(w.y & 0xffff0000u);
    f[4] = __uint_as_float(w.z << 16); f[5] = __uint_as_float(w.z & 0xffff0000u); f[6] = __uint_as_float(w.w << 16); f[7] = __uint_as_float(w.w & 0xffff0000u); }
__device__ __forceinline__ void ph_norm_bf16_from_bf16(const Ctx& c, const bf16* x, const float* g, bf16* out) {
    constexpr int RB = 4; float gg[2][8];
#pragma unroll
    for (int j = 0; j < 2; ++j) { const f32x4 a = ((const f32x4*)g)[2 * c.lane + 128 * j], b2 = ((const f32x4*)g)[2 * c.lane + 128 * j + 1]; gg[j][0] = a.x; gg[j][1] = a.y; gg[j][2] = a.z; gg[j][3] = a.w; gg[j][4] = b2.x; gg[j][5] = b2.y; gg[j][6] = b2.z; gg[j][7] = b2.w; }
    for (int row0 = c.gw * RB; row0 < NT; row0 += c.ngw * RB) {
        u32x4 v[RB][2];
#pragma unroll
        for (int q = 0; q < RB; ++q)
#pragma unroll
            for (int j = 0; j < 2; ++j) v[q][j] = ((const u32x4*)(x + (size_t)(row0 + q) * D_))[c.lane + 64 * j];
#pragma unroll
        for (int q = 0; q < RB; ++q) { float f[2][8]; float ss = 0.f;
#pragma unroll
            for (int j = 0; j < 2; ++j) { unpack8(v[q][j], f[j]);
#pragma unroll
                for (int e = 0; e < 8; ++e) ss = fmaf(f[j][e], f[j][e], ss); }
            const float r = rsqrtf(wave_sum(ss) * (1.f / D_) + EPS);
#pragma unroll
            for (int j = 0; j < 2; ++j) { u32x4 o; o.x = pk2(f[j][0] * r * gg[j][0], f[j][1] * r * gg[j][1]); o.y = pk2(f[j][2] * r * gg[j][2], f[j][3] * r * gg[j][3]); o.z = pk2(f[j][4] * r * gg[j][4], f[j][5] * r * gg[j][5]); o.w = pk2(f[j][6] * r * gg[j][6], f[j][7] * r * gg[j][7]);
                ((u32x4*)(out + (size_t)(row0 + q) * D_))[c.lane + 64 * j] = o; } }
    }
}
__device__ __forceinline__ void ph_norm_final_from_bf16(const Ctx& c, const bf16* x, const float* g, float* out) {
    constexpr int RB = 4; float gg[2][8];
#pragma unroll
    for (int j = 0; j < 2; ++j) { const f32x4 a = ((const f32x4*)g)[2 * c.lane + 128 * j], b2 = ((const f32x4*)g)[2 * c.lane + 128 * j + 1]; gg[j][0] = a.x; gg[j][1] = a.y; gg[j][2] = a.z; gg[j][3] = a.w; gg[j][4] = b2.x; gg[j][5] = b2.y; gg[j][6] = b2.z; gg[j][7] = b2.w; }
    for (int row0 = c.gw * RB; row0 < NT; row0 += c.ngw * RB) {
        u32x4 v[RB][2];
#pragma unroll
        for (int q = 0; q < RB; ++q)
#pragma unroll
            for (int j = 0; j < 2; ++j) v[q][j] = ((const u32x4*)(x + (size_t)(row0 + q) * D_))[c.lane + 64 * j];
#pragma unroll
        for (int q = 0; q < RB; ++q) { float f[2][8]; float ss = 0.f;
#pragma unroll
            for (int j = 0; j < 2; ++j) { unpack8(v[q][j], f[j]);
#pragma unroll
                for (int e = 0; e < 8; ++e) ss = fmaf(f[j][e], f[j][e], ss); }
            const float r = rsqrtf(wave_sum(ss) * (1.f / D_) + EPS);
#pragma unroll
            for (int j = 0; j < 2; ++j) { f32x4* o = (f32x4*)(out + (size_t)(row0 + q) * D_) + 2 * c.lane + 128 * j;
                o[0] = (f32x4){f[j][0] * r * gg[j][0], f[j][1] * r * gg[j][1], f[j][2] * r * gg[j][2], f[j][3] * r * gg[j][3]}; o[1] = (f32x4){f[j][4] * r * gg[j][4], f[j][5] * r * gg[j][5], f[j][6] * r * gg[j][6], f[j][7] * r * gg[j][7]}; } }
    }
}
__device__ __forceinline__ void ph_norm_bf16(const Ctx& c, const float* x, const float* g, bf16* out, bf16* raw) {
    constexpr int RB = 4;
    f32x4 gg[4];
#pragma unroll
    for (int j = 0; j < 4; ++j) gg[j] = ((const f32x4*)g)[c.lane + 64 * j];
    for (int row0 = c.gw * RB; row0 < NT; row0 += c.ngw * RB) {
        f32x4 v[RB][4];
#pragma unroll
        for (int q = 0; q < RB; ++q)
#pragma unroll
            for (int j = 0; j < 4; ++j) v[q][j] = ((const f32x4*)(x + (size_t)(row0 + q) * D_))[c.lane + 64 * j];
#pragma unroll
        for (int q = 0; q < RB; ++q) { float ss = 0.f;
#pragma unroll
            for (int j = 0; j < 4; ++j) ss += v[q][j].x * v[q][j].x + v[q][j].y * v[q][j].y + v[q][j].z * v[q][j].z + v[q][j].w * v[q][j].w;
            const float r = rsqrtf(wave_sum(ss) * (1.f / D_) + EPS);
            u64* o8 = (u64*)(out + (size_t)(row0 + q) * D_) + c.lane; u64* r8 = (u64*)(raw + (size_t)(row0 + q) * D_) + c.lane;
#pragma unroll
            for (int j = 0; j < 4; ++j) { o8[64 * j] = (u64)pk2(v[q][j].x * r * gg[j].x, v[q][j].y * r * gg[j].y) | ((u64)pk2(v[q][j].z * r * gg[j].z, v[q][j].w * r * gg[j].w) << 32);
                r8[64 * j] = (u64)pk2(v[q][j].x, v[q][j].y) | ((u64)pk2(v[q][j].z, v[q][j].w) << 32); } }
    }
}
__device__ __forceinline__ void ph_norm_final(const Ctx& c, float* x, const float* g) {
    constexpr int RB = 4;
    f32x4 gg[4];
#pragma unroll
    for (int j = 0; j < 4; ++j) gg[j] = ((const f32x4*)g)[c.lane + 64 * j];
    for (int row0 = c.gw * RB; row0 < NT; row0 += c.ngw * RB) {
        f32x4 v[RB][4];
#pragma unroll
        for (int q = 0; q < RB; ++q)
#pragma unroll
            for (int j = 0; j < 4; ++j) v[q][j] = ((const f32x4*)(x + (size_t)(row0 + q) * D_))[c.lane + 64 * j];
#pragma unroll
        for (int q = 0; q < RB; ++q) { float ss = 0.f;
#pragma unroll
            for (int j = 0; j < 4; ++j) ss += v[q][j].x * v[q][j].x + v[q][j].y * v[q][j].y + v[q][j].z * v[q][j].z + v[q][j].w * v[q][j].w;
            const float r = rsqrtf(wave_sum(ss) * (1.f / D_) + EPS);
            f32x4* xr = (f32x4*)(x + (size_t)(row0 + q) * D_) + c.lane;
#pragma unroll
            for (int j = 0; j < 4; ++j) xr[64 * j] = v[q][j] * r * gg[j]; }
    }
}

template <class AF, class EF>
__device__ __forceinline__ void naive_gemm(const Ctx& c, int M, int N, int K, AF af, const float* W, int ldb, EF ef) {
    LAS float* As = (LAS float*)c.lds;
    LAS float* Bs = As + 16 * 132;
    const int tm = (M + 127) / 128, tn = (N + 127) / 128, ntile = tm * tn;
    const int ty = c.tid >> 4, tx = c.tid & 15;
    for (int tile = c.bid; tile < ntile; tile += c.G) {
        const int m0 = (tile / tn) * 128, n0 = (tile % tn) * 128;
        float acc[4][8];
#pragma unroll
        for (int i = 0; i < 4; ++i)
#pragma unroll
            for (int j = 0; j < 8; ++j) acc[i][j] = 0.f;
        for (int k0 = 0; k0 < K; k0 += 16) {
            __syncthreads();
#pragma unroll
            for (int i = 0; i < 4; ++i) { const int e = c.tid + i * 512, r = e >> 4, kk = e & 15; const int row = m0 + r;
                As[kk * 132 + r] = (row < M) ? af(row, k0 + kk) : 0.f; }
#pragma unroll
            for (int i = 0; i < 4; ++i) { const int e = c.tid + i * 512, kk = e >> 7, cc = e & 127; const int col = n0 + cc;
                Bs[kk * 132 + cc] = (col < N) ? W[(size_t)(k0 + kk) * ldb + col] : 0.f; }
            __syncthreads();
#pragma unroll 2
            for (int kk = 0; kk < 16; ++kk) {
                float a[4], b[8];
#pragma unroll
                for (int i = 0; i < 4; ++i) a[i] = As[kk * 132 + ty * 4 + i];
#pragma unroll
                for (int j = 0; j < 8; ++j) b[j] = Bs[kk * 132 + tx * 8 + j];
#pragma unroll
                for (int i = 0; i < 4; ++i)
#pragma unroll
                    for (int j = 0; j < 8; ++j) acc[i][j] = fmaf(a[i], b[j], acc[i][j]);
            }
        }
        LAS float* Cs = Bs + 16 * 132;
        __syncthreads();
#pragma unroll
        for (int i = 0; i < 4; ++i)
#pragma unroll
            for (int j = 0; j < 8; ++j) Cs[(ty * 4 + i) * 129 + tx * 8 + j] = acc[i][j];
        __syncthreads();
#pragma unroll 1
        for (int e = c.tid; e < 128 * 128; e += NTHREADS) { const int r = e >> 7, cc = e & 127, row = m0 + r, col = n0 + cc; if (row < M && col < N) ef(row, col, Cs[r * 129 + cc]); }
    }
    __syncthreads();
}

struct InProjOut { bf16* qn; bf16* kv6; bf16* fqkv; bf16* dqk; bf16* dv; float* gate; float* fl; const float* b_gate; const float* b_fgt; };
__device__ __forceinline__ void inproj_store(const InProjOut& o, int n, int col, float v) {
    const int b = n / T_, t = n % T_;
    if (col < C_KV6) { const int h = col >> 6, d = col & 63; o.qn[((size_t)(b * 8 + h) * T_ + t) * 64 + d] = (bf16)f2bf(v * (0.125f * LOG2E)); }
    else if (col < C_GATE) { const int cc = col - C_KV6, idx = cc >> 7, g = (cc >> 6) & 1, d = cc & 63;
        ((bf16*)((unsigned char*)o.kv6 + idx * KV6_STRIDE))[((size_t)(b * 2 + g) * T_ + t) * 64 + d] = (bf16)f2bf(v); }
    else if (col < C_FQ) { const int j = col - C_GATE; o.gate[(size_t)n * 24 + j] = sigmoidf_(v + o.b_gate[j]); }
    else if (col < C_FF) { const int cc = col - C_FQ, idx = cc >> 8, h = (cc >> 6) & 3, d = cc & 63;
        o.fqkv[(size_t)idx * (8 * MiB) + ((size_t)(b * 4 + h) * T_ + t) * 64 + d] = (bf16)f2bf(idx == 0 ? v * (0.125f * LOG2E) : v); }
    else if (col < C_DQ) { const int h = col - C_FF; o.fl[(size_t)(b * 4 + h) * T_ + t] = log_sigmoidf_(v + o.b_fgt[h]); }
    else if (col < C_DV) { const int cc = col - C_DQ, idx = cc >> 8, h = (cc >> 6) & 3, i = (cc >> 5) & 1, d = cc & 31;
        o.dqk[(size_t)idx * (8 * MiB) + ((size_t)((b * 4 + h) * 2 + i) * T_ + t) * 32 + d] = (bf16)f2bf(idx == 0 ? v * (0.17677669529663687f * LOG2E) : v); }
    else { const int cc = col - C_DV, h = cc >> 6, d = cc & 63; o.dv[((size_t)(b * 4 + h) * T_ + t) * 64 + d] = (bf16)f2bf(v); }
}

__device__ __forceinline__ void ph_cumsum(const Ctx& c, float* fl) {
    for (int s = c.gw; s < B_ * 4; s += c.ngw) {
        float* p = fl + (size_t)s * T_; float carry = 0.f;
        for (int t0 = 0; t0 < T_; t0 += 64) {
            float v = p[t0 + c.lane];
#pragma unroll
            for (int o = 1; o < 64; o <<= 1) { const float u = __shfl_up(v, o); if (c.lane >= o) v += u; }
            v += carry; p[t0 + c.lane] = v; carry = __shfl(v, 63);
        }
    }
}

template <int DQK>
__device__ __forceinline__ float naive_attn_row(const bf16* q, const bf16* K, const bf16* V, int t, u64 mask, float slope2, const float* cum, int win, int lane) {
    float qv[DQK];
    { const u32x4* q4 = (const u32x4*)q;
#pragma unroll
      for (int i = 0; i < DQK / 8; ++i) { const u32x4 w = q4[i];
          qv[8 * i + 0] = __uint_as_float(w.x << 16); qv[8 * i + 1] = __uint_as_float(w.x & 0xffff0000u);
          qv[8 * i + 2] = __uint_as_float(w.y << 16); qv[8 * i + 3] = __uint_as_float(w.y & 0xffff0000u);
          qv[8 * i + 4] = __uint_as_float(w.z << 16); qv[8 * i + 5] = __uint_as_float(w.z & 0xffff0000u);
          qv[8 * i + 6] = __uint_as_float(w.w << 16); qv[8 * i + 7] = __uint_as_float(w.w & 0xffff0000u); } }
    const float cumt = cum ? cum[t] : 0.f;
    float m = -INFINITY, l = 0.f, o = 0.f;
    while (mask) {
        const int j = __builtin_ctzll(mask); mask &= mask - 1;
        const int kpos = 64 * j + lane; const int dist = t - kpos;
        const bool valid = dist >= 0 && dist < win;
        float s = 0.f;
        { const u32x4* k4 = (const u32x4*)(K + (size_t)kpos * DQK);
#pragma unroll
          for (int i = 0; i < DQK / 8; ++i) { const u32x4 w = k4[i];
              s = fmaf(qv[8 * i + 0], __uint_as_float(w.x << 16), s); s = fmaf(qv[8 * i + 1], __uint_as_float(w.x & 0xffff0000u), s);
              s = fmaf(qv[8 * i + 2], __uint_as_float(w.y << 16), s); s = fmaf(qv[8 * i + 3], __uint_as_float(w.y & 0xffff0000u), s);
              s = fmaf(qv[8 * i + 4], __uint_as_float(w.z << 16), s); s = fmaf(qv[8 * i + 5], __uint_as_float(w.z & 0xffff0000u), s);
              s = fmaf(qv[8 * i + 6], __uint_as_float(w.w << 16), s); s = fmaf(qv[8 * i + 7], __uint_as_float(w.w & 0xffff0000u), s); } }
        s -= slope2 * (float)dist;
        if (cum) s += (cumt - cum[kpos]) * LOG2E;
        s = valid ? s : -INFINITY;
        const float mb = wave_max(s);
        if (mb == -INFINITY) continue;
        const float mn = fmaxf(m, mb), alpha = exp2f(m - mn);
        const float p = valid ? exp2f(s - mn) : 0.f;
        l = l * alpha + wave_sum(p); o *= alpha; m = mn;
        const bf16* vb = V + (size_t)(64 * j) * 64 + lane;
#pragma unroll 8
        for (int k = 0; k < 64; ++k) o = fmaf(__shfl(p, k), bf2f(vb[(size_t)k * 64]), o);
    }
    return l > 0.f ? o / l : 0.f;
}

__device__ __forceinline__ void ph_cmp_attn(const Ctx& c, const bf16* qn, const bf16* kcmp, const bf16* vcmp, const float* gate, u64* sel, bf16* ocmp) {
    LAS float* pl = (LAS float*)(c.lds) + c.wave * 256;
    const int lane = c.lane;
    for (int it = c.gw; it < B_ * 2 * T_; it += c.ngw) {
        const int t = it % T_, bg = it / T_, b = bg >> 1, g = bg & 1;
        const int nvis = (t >= 31) ? ((t - 31) >> 4) + 1 : 0;
        const bf16* kc = kcmp + (size_t)bg * 256 * 64; const bf16* vc = vcmp + (size_t)bg * 256 * 64;
        float imp = 0.f;
        for (int hg = 0; hg < 4; ++hg) {
            const int h = g * 4 + hg; const float slope2 = alibi_slope(h + 1, 8) * LOG2E;
            const bf16* q = qn + ((size_t)(b * 8 + h) * T_ + t) * 64;
            float qv[64];
            { const u32x4* q4 = (const u32x4*)q;
#pragma unroll
              for (int i = 0; i < 8; ++i) { const u32x4 w = q4[i];
                  qv[8 * i + 0] = __uint_as_float(w.x << 16); qv[8 * i + 1] = __uint_as_float(w.x & 0xffff0000u);
                  qv[8 * i + 2] = __uint_as_float(w.y << 16); qv[8 * i + 3] = __uint_as_float(w.y & 0xffff0000u);
                  qv[8 * i + 4] = __uint_as_float(w.z << 16); qv[8 * i + 5] = __uint_as_float(w.z & 0xffff0000u);
                  qv[8 * i + 6] = __uint_as_float(w.w << 16); qv[8 * i + 7] = __uint_as_float(w.w & 0xffff0000u); } }
            float s[4]; float m = -INFINITY;
#pragma unroll
            for (int i = 0; i < 4; ++i) { const int cc = lane + 64 * i; float a = 0.f;
                if (cc < nvis) { const u32x4* k4 = (const u32x4*)(kc + (size_t)cc * 64);
#pragma unroll
                    for (int e = 0; e < 8; ++e) { const u32x4 w = k4[e];
                        a = fmaf(qv[8 * e + 0], __uint_as_float(w.x << 16), a); a = fmaf(qv[8 * e + 1], __uint_as_float(w.x & 0xffff0000u), a);
                        a = fmaf(qv[8 * e + 2], __uint_as_float(w.y << 16), a); a = fmaf(qv[8 * e + 3], __uint_as_float(w.y & 0xffff0000u), a);
                        a = fmaf(qv[8 * e + 4], __uint_as_float(w.z << 16), a); a = fmaf(qv[8 * e + 5], __uint_as_float(w.z & 0xffff0000u), a);
                        a = fmaf(qv[8 * e + 6], __uint_as_float(w.w << 16), a); a = fmaf(qv[8 * e + 7], __uint_as_float(w.w & 0xffff0000u), a); }
                    a -= slope2 * (float)(t - (16 * cc + 31)); } else a = -INFINITY;
                s[i] = a; m = fmaxf(m, a); }
            m = wave_max(m);
            float p[4], lsum = 0.f;
#pragma unroll
            for (int i = 0; i < 4; ++i) { p[i] = (lane + 64 * i < nvis) ? exp2f(s[i] - m) : 0.f; lsum += p[i]; }
            lsum = wave_sum(lsum);
            const float inv = lsum > 0.f ? 1.f / lsum : 0.f;
#pragma unroll
            for (int i = 0; i < 4; ++i) { p[i] *= inv; pl[lane + 64 * i] = p[i]; }
            asm volatile("s_waitcnt lgkmcnt(0)" ::: "memory");
            float o = 0.f;
            for (int cc = 0; cc < nvis; ++cc) o = fmaf(pl[cc], bf2f(vc[(size_t)cc * 64 + lane]), o);
            const float gt = gate[((size_t)(b * T_ + t)) * 24 + h * 3 + 0];
            ocmp[(size_t)(b * T_ + t) * 512 + h * 64 + lane] = (bf16)f2bf(gt * o);
            { const int j = lane; float a = pl[4 * j] + pl[4 * j + 1] + pl[4 * j + 2] + 0.5f * pl[4 * j + 3]; if (j > 0) a += 0.5f * pl[4 * j - 1]; imp += a; }
            asm volatile("s_waitcnt lgkmcnt(0)" ::: "memory");
        }
        const int cur = t >> 6; const int j = lane;
        u64 m64;
        if (cur <= 15) m64 = (cur == 63) ? ~0ull : ((1ull << (cur + 1)) - 1ull);
        else {
            float val = (j > cur) ? -INFINITY : ((j == 0 || j == cur || j == cur - 1) ? 1e4f : imp);
            m64 = 0ull;
            for (int r = 0; r < 16; ++r) {
                const float mx = wave_max(val);
                const u64 bal = __ballot(val == mx);
                const int w = __builtin_ctzll(bal);
                m64 |= 1ull << w; if (j == w) val = -INFINITY;
            }
        }
        if (lane == 0) sel[(size_t)bg * T_ + t] = m64;
    }
}

__device__ __forceinline__ void ph_win_attn(const Ctx& c, const bf16* qn, const bf16* kw, const bf16* vw, const float* gate, bf16* owin) {
    for (int it = c.gw; it < B_ * 8 * T_; it += c.ngw) {
        const int t = it % T_, bh = it / T_, b = bh >> 3, h = bh & 7, g = h >> 2;
        const int cur = t >> 6, jlo = (t - 511) > 0 ? (t - 511) >> 6 : 0;
        const u64 hi = (cur == 63) ? ~0ull : ((1ull << (cur + 1)) - 1ull); const u64 mask = hi & ~((1ull << jlo) - 1ull);
        const float o = naive_attn_row<64>(qn + ((size_t)bh * T_ + t) * 64, kw + (size_t)(b * 2 + g) * T_ * 64, vw + (size_t)(b * 2 + g) * T_ * 64, t, mask,
                                           alibi_slope(h + 1, 8) * LOG2E, nullptr, 512, c.lane);
        owin[(size_t)(b * T_ + t) * 512 + h * 64 + c.lane] = (bf16)f2bf(gate[(size_t)(b * T_ + t) * 24 + h * 3 + 2] * o);
    }
}
__device__ __forceinline__ void ph_slc_attn(const Ctx& c, const bf16* qn, const bf16* ks, const bf16* vs, const float* gate, const u64* sel, const bf16* ocmp, const bf16* owin, bf16* att) {
    for (int it = c.gw; it < B_ * 8 * T_; it += c.ngw) {
        const int t = it % T_, bh = it / T_, b = bh >> 3, h = bh & 7, g = h >> 2;
        const u64 mask = sel[(size_t)(b * 2 + g) * T_ + t];
        const float o = naive_attn_row<64>(qn + ((size_t)bh * T_ + t) * 64, ks + (size_t)(b * 2 + g) * T_ * 64, vs + (size_t)(b * 2 + g) * T_ * 64, t, mask,
                                           alibi_slope(h + 1, 8) * LOG2E, nullptr, 1 << 30, c.lane);
        const size_t n = (size_t)(b * T_ + t);
        const float r = gate[n * 24 + h * 3 + 1] * o + bf2f(ocmp[n * 512 + h * 64 + c.lane]) + bf2f(owin[n * 512 + h * 64 + c.lane]);
        att[n * 1024 + h * 64 + c.lane] = (bf16)f2bf(r);
    }
}
__device__ __forceinline__ void ph_fox_attn(const Ctx& c, const bf16* fq, const bf16* fk, const bf16* fv, const float* cum, bf16* att) {
    for (int it = c.gw; it < B_ * 4 * T_; it += c.ngw) {
        const int t = it % T_, bh = it / T_, b = bh >> 2, h = bh & 3;
        const int cur = t >> 6; const u64 mask = (cur == 63) ? ~0ull : ((1ull << (cur + 1)) - 1ull);
        const float o = naive_attn_row<64>(fq + ((size_t)bh * T_ + t) * 64, fk + (size_t)bh * T_ * 64, fv + (size_t)bh * T_ * 64, t, mask, 0.f, cum + (size_t)bh * T_, 1 << 30, c.lane);
        att[(size_t)(b * T_ + t) * 1024 + 512 + h * 64 + c.lane] = (bf16)f2bf(o);
    }
}
__device__ __forceinline__ void ph_diff_attn(const Ctx& c, const bf16* dq, const bf16* dk, const bf16* dv, const float* lam, const float* subln, float lambda_init, bf16* att) {
    float l1 = 0.f, l2 = 0.f;
    if (c.lane < 32) { l1 = lam[c.lane] * lam[32 + c.lane]; l2 = lam[64 + c.lane] * lam[96 + c.lane]; }
    const float lam_full = __expf(wave_sum(l1)) - __expf(wave_sum(l2)) + lambda_init;
    const float sg = subln[c.lane] * (1.f - lambda_init);
    for (int it = c.gw; it < B_ * 4 * T_; it += c.ngw) {
        const int t = it % T_, bh = it / T_, b = bh >> 2, h = bh & 3;
        const int cur = t >> 6; const u64 mask = (cur == 63) ? ~0ull : ((1ull << (cur + 1)) - 1ull);
        const float slope2 = alibi_slope(h + 1, 4) * LOG2E;
        const bf16* vb = dv + (size_t)bh * T_ * 64;
        const float o1 = naive_attn_row<32>(dq + ((size_t)(bh * 2 + 0) * T_ + t) * 32, dk + (size_t)(bh * 2 + 0) * T_ * 32, vb, t, mask, slope2, nullptr, 1 << 30, c.lane);
        const float o2 = naive_attn_row<32>(dq + ((size_t)(bh * 2 + 1) * T_ + t) * 32, dk + (size_t)(bh * 2 + 1) * T_ * 32, vb, t, mask, slope2, nullptr, 1 << 30, c.lane);
        const float o = o1 - lam_full * o2;
        const float r = rsqrtf(wave_sum(o * o) * (1.f / 64.f) + EPS);
        att[(size_t)(b * T_ + t) * 1024 + 768 + h * 64 + c.lane] = (bf16)f2bf(o * r * sg);
    }
}

__device__ __forceinline__ void ph_moe_route(const Ctx& c, const float* x, const float* g, const float* wgrp, const float* bgrp, const float* wexp, const float* bexp, bf16* hn, int* route_e, float* route_w, unsigned* cnt) {
    for (int row = c.gw; row < NT; row += c.ngw) {
        const f32x4* xr = (const f32x4*)(x + (size_t)row * D_) + c.lane;
        f32x4 v[4]; float ss = 0.f;
#pragma unroll
        for (int j = 0; j < 4; ++j) { v[j] = xr[64 * j]; ss += v[j].x * v[j].x + v[j].y * v[j].y + v[j].z * v[j].z + v[j].w * v[j].w; }
        const float r = rsqrtf(wave_sum(ss) * (1.f / D_) + EPS);
        u64* o8 = (u64*)(hn + (size_t)row * D_) + c.lane;
#pragma unroll
        for (int j = 0; j < 4; ++j) { const f32x4 gg = ((const f32x4*)g)[c.lane + 64 * j]; v[j] = v[j] * r * gg;
            o8[64 * j] = (u64)pk2(v[j].x, v[j].y) | ((u64)pk2(v[j].z, v[j].w) << 32); }
        float gl[4];
#pragma unroll
        for (int q = 0; q < 4; ++q) { float a = 0.f;
#pragma unroll
            for (int j = 0; j < 4; ++j) { const int k = 4 * (c.lane + 64 * j);
                a = fmaf(v[j].x, wgrp[(size_t)(k + 0) * 4 + q], a); a = fmaf(v[j].y, wgrp[(size_t)(k + 1) * 4 + q], a);
                a = fmaf(v[j].z, wgrp[(size_t)(k + 2) * 4 + q], a); a = fmaf(v[j].w, wgrp[(size_t)(k + 3) * 4 + q], a); }
            gl[q] = wave_sum(a) + bgrp[q]; }
        int grp = 0; float gm = gl[0];
#pragma unroll
        for (int q = 1; q < 4; ++q) if (gl[q] > gm) { gm = gl[q]; grp = q; }
        float gs = 0.f;
#pragma unroll
        for (int q = 0; q < 4; ++q) gs += __expf(gl[q] - gm);
        const float grp_gate = 1.f / gs;
        float el[8];
#pragma unroll
        for (int q = 0; q < 8; ++q) { float a = 0.f; const int col = grp * 8 + q;
#pragma unroll
            for (int j = 0; j < 4; ++j) { const int k = 4 * (c.lane + 64 * j);
                a = fmaf(v[j].x, wexp[(size_t)(k + 0) * 32 + col], a); a = fmaf(v[j].y, wexp[(size_t)(k + 1) * 32 + col], a);
                a = fmaf(v[j].z, wexp[(size_t)(k + 2) * 32 + col], a); a = fmaf(v[j].w, wexp[(size_t)(k + 3) * 32 + col], a); }
            el[q] = wave_sum(a) + bexp[col]; }
        int i0 = 0; float v0 = el[0];
#pragma unroll
        for (int q = 1; q < 8; ++q) if (el[q] > v0) { v0 = el[q]; i0 = q; }
        int i1 = -1; float v1 = -INFINITY;
#pragma unroll
        for (int q = 0; q < 8; ++q) if (q != i0 && el[q] > v1) { v1 = el[q]; i1 = q; }
        const float e1 = __expf(v1 - v0), den = 1.f + e1;
        if (c.lane == 0) { const float w0 = grp_gate / den, w1 = grp_gate * e1 / den;
            const int lo = i0 < i1 ? i0 : i1, hi = i0 < i1 ? i1 : i0, cls = grp * 28 + lo * 8 - (lo * (lo + 1)) / 2 + (hi - lo - 1);
            const unsigned rank = __hip_atomic_fetch_add(cnt + cls, 1u, __ATOMIC_RELAXED, __HIP_MEMORY_SCOPE_AGENT);
            route_e[row] = (int)(((unsigned)cls << 24) | rank); route_w[2 * row] = i0 < i1 ? w0 : w1; route_w[2 * row + 1] = i0 < i1 ? w1 : w0; }
    }
}
__device__ __forceinline__ void ph_moe_naive(const Ctx& c, const bf16* hn, const int* route_e, const float* route_w, const float* wg, const float* wu, const float* wd, float* x) {
    LAS float* hs = (LAS float*)c.lds;
    LAS float* au = hs + 1024;
    LAS float* h2 = au + 512;
    for (int row = c.bid; row < NT; row += c.G) {
        __syncthreads();
        hs[c.tid] = bf2f(hn[(size_t)row * D_ + c.tid]); hs[c.tid + 512] = bf2f(hn[(size_t)row * D_ + c.tid + 512]);
        float o0 = 0.f, o1 = 0.f;
        for (int s = 0; s < 2; ++s) {
            const int e = route_e[2 * row + s]; const float w = route_w[2 * row + s];
            __syncthreads();
            const float* W = (c.tid < 256 ? wg : wu) + (size_t)e * D_ * DEXP + (c.tid & 255);
            float a = 0.f;
            for (int k = 0; k < D_; ++k) a = fmaf(hs[k], W[(size_t)k * DEXP], a);
            au[c.tid] = a;
            __syncthreads();
            if (c.tid < 256) { const float ga = au[c.tid], up = au[c.tid + 256]; h2[c.tid] = ga / (1.f + __expf(-ga)) * up * w; }
            __syncthreads();
            const float* Wd = wd + (size_t)e * DEXP * D_;
            for (int k = 0; k < DEXP; ++k) { const float hv = h2[k]; o0 = fmaf(hv, Wd[(size_t)k * D_ + c.tid], o0); o1 = fmaf(hv, Wd[(size_t)k * D_ + c.tid + 512], o1); }
        }
        x[(size_t)row * D_ + c.tid] += o0; x[(size_t)row * D_ + c.tid + 512] += o1;
    }
    __syncthreads();
}

typedef __attribute__((address_space(4))) const Params* KP;
__device__ __forceinline__ KP uni_kp(KP p) { const unsigned long long v = (unsigned long long)p; const unsigned lo = __builtin_amdgcn_readfirstlane((unsigned)v), hi = __builtin_amdgcn_readfirstlane((unsigned)(v >> 32)); return (KP)(((unsigned long long)hi << 32) | lo); }
constexpr int PH_PER_LAYER = 11, N_PHASES = L_ * PH_PER_LAYER + 2;
__device__ __forceinline__ Ctx make_ctx(KP p) {
    Ctx c; c.lds = (LAS unsigned char*)lds_raw; { int t_ = threadIdx.x; asm volatile("" : "+v"(t_)); c.tid = t_; } c.lane = c.tid & 63; c.wave = __builtin_amdgcn_readfirstlane(c.tid >> 6);
    c.bid = blockIdx.x; c.G = gridDim.x; c.gw = c.bid * NWAVES + c.wave; c.ngw = c.G * NWAVES; c.in = nullptr; c.xcur = p->out; c.ws = p->ws;
    return c;
}
struct Bufs {
    bf16 *QN, *KV6, *KC, *VC, *KS, *VS, *KW, *VW, *FQ, *FK, *FV, *DQ, *DK, *DV, *HC, *KCMP, *VCMP, *OCMP, *OWIN, *HN, *ATT;
    float *GATE, *FL, *ROUTE_W; u64* SEL; int* ROUTE_E;
};
__device__ __forceinline__ Bufs make_bufs(unsigned char* ws) {
    Bufs b;
    b.QN = (bf16*)(ws + WS_QN); b.KV6 = (bf16*)(ws + WS_KV6);
    b.KC = (bf16*)(ws + WS_KV6 + 0 * KV6_STRIDE); b.VC = (bf16*)(ws + WS_KV6 + 1 * KV6_STRIDE);
    b.KS = (bf16*)(ws + WS_KV6 + 2 * KV6_STRIDE); b.VS = (bf16*)(ws + WS_KV6 + 3 * KV6_STRIDE);
    b.KW = (bf16*)(ws + WS_KV6 + 4 * KV6_STRIDE); b.VW = (bf16*)(ws + WS_KV6 + 5 * KV6_STRIDE);
    b.FQ = (bf16*)(ws + WS_FQKV); b.FK = b.FQ + 8 * MiB; b.FV = b.FQ + 16 * MiB;
    b.DQ = (bf16*)(ws + WS_DQK); b.DK = b.DQ + 8 * MiB; b.DV = (bf16*)(ws + WS_DV);
    b.GATE = (float*)(ws + WS_GATE); b.FL = (float*)(ws + WS_FL);
    b.HC = (bf16*)(ws + WS_HC); b.KCMP = (bf16*)(ws + WS_KVCMP); b.VCMP = b.KCMP + 16 * 256 * 64;
    b.SEL = (u64*)(ws + WS_SEL); b.OCMP = (bf16*)(ws + WS_OCMP); b.OWIN = (bf16*)(ws + WS_OWIN);
    b.HN = (bf16*)(ws + WS_HN); b.ATT = (bf16*)(ws + WS_ATT);
    b.ROUTE_E = (int*)(ws + WS_ROUTE); b.ROUTE_W = (float*)(ws + WS_ROUTE + 512 * 1024);
    return b;
}
__device__ __forceinline__ float lambda_init_of(int l) { return l == 0 ? 0.2f : 0.35550906759096926f; }

__device__ __noinline__ void P_prologue(KP p_) { const KP p = uni_kp(p_);
    const Ctx c = make_ctx(p); unsigned char* ws = p->ws;
    LAS float* scr = (LAS float*)(c.lds) + c.wave * (64 * 33);
    constexpr int I_A = 16 * 40, I_B = 16 * 24, I_C = 16 * 24, I_O = 16 * 32, I_G = 16 * 8, I_D = 4 * 32, I_E = 2 * I_G + I_D, I_W1 = 32 * 8, I_W2 = 4 * 2;
    constexpr int PER_L = I_A + I_B + I_C + I_O + 2 * (I_W1 + I_W2);
    for (int it = c.gw; it < L_ * PER_L; it += c.ngw) {
        const int l = it / PER_L; int r = it % PER_L;
        const float* W; bf16* WT; int ldw, K, sc0, ncol, r0 = 0, rmul = 1;
        if (r < I_A + I_B + I_C) { W = p->in[2] + (size_t)l * D_ * D_IN; WT = (bf16*)(ws + WS_WIN_T) + (size_t)l * NIN * D_; ldw = D_IN; K = D_;
            if (r < I_A) { sc0 = 0; ncol = 1280; r0 = 0; } else if (r < I_A + I_B) { r -= I_A; sc0 = C_FQ; ncol = 768; r0 = 1280; } else { r -= I_A + I_B; sc0 = C_DQ; ncol = 768; r0 = 2048; } }
        else if ((r -= I_A + I_B + I_C) < I_O) { W = p->in[13] + (size_t)l * D_ * D_; WT = (bf16*)(ws + WS_WOUT_T) + (size_t)l * D_ * D_; ldw = D_; K = D_; sc0 = 0; ncol = 1024; }
        else { r -= I_O; const int kv = r / (I_W1 + I_W2); r = r % (I_W1 + I_W2); const size_t lk = (size_t)l * 2 + kv;
            if (r < I_W1) { W = p->in[kv == 0 ? 6 : 9] + (size_t)l * 2048 * 256; WT = (bf16*)(ws + WS_W1_T) + lk * 256 * 2048; ldw = 256; K = 2048; sc0 = 0; ncol = 256; }
            else { r -= I_W1; W = p->in[kv == 0 ? 7 : 10] + (size_t)l * 256 * 64; WT = (bf16*)(ws + WS_W2_T) + lk * 64 * 256; ldw = 64; K = 256; sc0 = 0; ncol = 64; } }
        transpose_seg(W, ldw, K, sc0, ncol, WT, r0, rmul, r, scr, c.lane);
    }
    for (int i = c.bid * NTHREADS + c.tid; i < L_ * 256 * D_; i += c.G * NTHREADS) {
        const int l = i / (256 * D_), rr = (i / D_) % 256, k = i % D_;
        const float* win = p->in[2] + (size_t)l * D_ * D_IN;
        float v = 0.f; if (rr < 24) v = win[(size_t)k * D_IN + C_GATE + rr]; else if (rr < 28) v = win[(size_t)k * D_IN + C_FF + (rr - 24)];
        ((bf16*)(ws + WS_WIN_T))[((size_t)l * NIN + 2816 + rr) * D_ + k] = (bf16)f2bf(v);
    }
    for (int w = c.gw; w < L_ * 2 * 4 * 128; w += c.ngw) {
        const int lk = w >> 9, cg = (w >> 7) & 3, kc = w & 127, l = lk >> 1, kv = lk & 1, j = cg * 64 + c.lane;
        const float* pe = p->in[kv == 0 ? 5 : 8] + (size_t)l * 2048 + kc * 16; const float* w1 = p->in[kv == 0 ? 6 : 9] + (size_t)l * 2048 * 256 + (size_t)kc * 16 * 256;
        float a = 0.f;
#pragma unroll
        for (int k = 0; k < 16; ++k) a = fmaf(pe[k], w1[(size_t)k * 256 + j], a);
        ((float*)(ws + WS_B1PART))[((size_t)lk * 128 + kc) * 256 + j] = a;
    }
    for (int i = c.bid * NTHREADS + c.tid; i < L_ * 64 * 2 * 64; i += c.G * NTHREADS) {
        const int l = i / (64 * 2 * 64), ks = (i / 128) % 64, cb = (i / 64) & 1, lane = i & 63, col = 32 * cb + (lane & 31);
        unsigned hi[4], lo[4];
#pragma unroll
        for (int jp = 0; jp < 4; ++jp) { float v[2];
#pragma unroll
            for (int e = 0; e < 2; ++e) { const int k = 16 * ks + 8 * (lane >> 5) + 2 * jp + e; const float g = p->in[14][(size_t)l * D_ + k];
                v[e] = col < 4 ? g * p->in[15][((size_t)l * D_ + k) * 4 + col] : (col < 36 ? g * p->in[17][((size_t)l * D_ + k) * 32 + (col - 4)] : 0.f); }
            const unsigned h0 = f2bf(v[0]), h1 = f2bf(v[1]); hi[jp] = h0 | (h1 << 16);
            lo[jp] = f2bf(v[0] - __uint_as_float(h0 << 16)) | (f2bf(v[1] - __uint_as_float(h1 << 16)) << 16); }
        u32x4* dst = (u32x4*)(ws + WS_WR) + ((size_t)((l * 64 + ks) * 2 + cb) * 2) * 64 + lane;
        dst[0] = (u32x4){hi[0], hi[1], hi[2], hi[3]}; dst[64] = (u32x4){lo[0], lo[1], lo[2], lo[3]};
    }
}
__device__ __forceinline__ void P_inproj_mfma(int l_) { const KP p = (KP)__builtin_amdgcn_kernarg_segment_ptr(); int l = l_; asm volatile("" : "+s"(l));
    unsigned char* ws = p->ws; asm volatile("" : "+s"(ws));
    PlainOrder S; S.init(p->out, (const bf16*)(ws + WS_WIN_T) + (size_t)l * NIN * D_, D_, D_, NT, NIN, (int)gridDim.x, launder_s((int)blockIdx.x));
#ifdef STAGGER_TICKS
    { const unsigned long long t0 = __builtin_amdgcn_s_memrealtime(); const unsigned long long d = (unsigned long long)((launder_s((int)blockIdx.x) >> 3) & 3) * STAGGER_TICKS;
      while (__builtin_amdgcn_s_memrealtime() - t0 < d) __builtin_amdgcn_s_sleep(4); }
#endif
    const pg8::Gemm g{D_, D_, D_, D_ / 64, 0, 0};
    const EpiInProj E{ws, p->in[3] + l * 24, p->in[4] + l * 4, (unsigned*)(ws + WS_CTL) + CW_KN + l * 8192};
    pg8::gemm_phase<EpiInProj, PlainOrder, INPROJ_ALIGN, INPROJ_SP2>((LAS unsigned char*)lds_raw, g, S, E);
}
__device__ __forceinline__ void P_inproj_dummy(int l_) { const KP p = (KP)__builtin_amdgcn_kernarg_segment_ptr(); int l = l_; asm volatile("" : "+s"(l));
    unsigned char* ws = p->ws; asm volatile("" : "+s"(ws));
    PlainOrder S; S.init(p->out, (const bf16*)(ws + WS_WIN_T) + (size_t)l * NIN * D_, D_, D_, NT, NIN, (int)gridDim.x, launder_s((int)blockIdx.x));
    const pg8::Gemm g{D_, D_, D_, D_ / 64, 0, 0};
    const EpiDummy E{(float*)(ws + WS_HB)};
    pg8::gemm_phase<EpiDummy, PlainOrder, true, true>((LAS unsigned char*)lds_raw, g, S, E);
}
__device__ __forceinline__ void P_outproj_mfma(int l_) { const KP p = (KP)__builtin_amdgcn_kernarg_segment_ptr(); int l = l_; asm volatile("" : "+s"(l));
    unsigned char* ws = p->ws; asm volatile("" : "+s"(ws));
    PlainOrder S; S.init(ws + WS_ATT, (const bf16*)(ws + WS_WOUT_T) + (size_t)l * D_ * D_, D_, D_, NT, D_, (int)gridDim.x, launder_s((int)blockIdx.x));
    const pg8::Gemm g{D_, D_, D_, D_ / 64, 32, 8};
    const EpiResBf16 E{(bf16*)(ws + WS_HN)};
    pg8::gemm_phase<EpiResBf16, PlainOrder, true, true>((LAS unsigned char*)lds_raw, g, S, E);
}
__device__ __forceinline__ float wave_max_l(float v, int lane) {
#pragma unroll
    for (int o = 1; o < 64; o <<= 1) v = fmaxf(v, shflx_f(v, o, lane));
    return v;
}
__device__ __forceinline__ float wave_min_l(float v, int lane) {
#pragma unroll
    for (int o = 1; o < 64; o <<= 1) v = fminf(v, shflx_f(v, o, lane));
    return v;
}
template <int NS> __device__ __forceinline__ float q_norm2_max(const bf16x8v (&Q)[NS], int lane) {
    float ss = 0.f;
#pragma unroll
    for (int s = 0; s < NS; ++s)
#pragma unroll
        for (int e = 0; e < 8; ++e) { const float v = __uint_as_float(((unsigned)(unsigned short)Q[s][e]) << 16); ss = fmaf(v, v, ss); }
    return wave_max_l(swap_sum(ss), lane);
}
__device__ __forceinline__ u64 prune_consensus(bool skip, LAS u64* slots, int wave, int lane) {
    const u64 mine = __ballot(skip);
    __syncthreads();
    if (lane == 0) slots[wave] = mine;
    __syncthreads();
    u64 all = slots[0];
#pragma unroll
    for (int w = 1; w < NWAVES; ++w) all &= slots[w];
    return all;
}
__device__ __forceinline__ void U_fox(KP p_, int bh_, int qb_, int l_) {
    const KP p = uni_kp(p_); const int bh = __builtin_amdgcn_readfirstlane(bh_), qb = __builtin_amdgcn_readfirstlane(qb_), l = __builtin_amdgcn_readfirstlane(l_);
    int tid_ = threadIdx.x; asm volatile("" : "+v"(tid_));
    const int tid = tid_, lane = tid & 63, wave = __builtin_amdgcn_readfirstlane(tid >> 6), r = lane & 31, h = lane >> 5;
    unsigned char* ws = p->ws; asm volatile("" : "+s"(ws)); LAS unsigned char* L = (LAS unsigned char*)lds_raw;
    const int tw0 = 256 * qb + 32 * wave, t_lane = tw0 + r, b = bh >> 2, hd = bh & 3;
    const bf16* q = (const bf16*)(ws + WS_FQKV) + (size_t)bh * T_ * 64 + (t_lane >> 4) * 1024 + (t_lane & 15) * 32 + 8 * h;
    bf16x8v Qf[1][4];
#pragma unroll
    for (int s = 0; s < 4; ++s) Qf[0][s] = *(const bf16x8v*)(q + (s >> 1) * 512 + (s & 1) * 16);
    const bf16* Kp = (const bf16*)(ws + WS_FQKV) + 8 * MiB + (size_t)bh * T_ * 64; const bf16* Vp = (const bf16*)(ws + WS_FQKV) + 16 * MiB + (size_t)bh * T_ * 64;
    u32x4 kpre, vpre; attn_preload<64>(Kp, nullptr, Vp, 4 * qb + 3, tid, kpre, vpre);
    LAS float* cum = (LAS float*)(L + A_LDS_END);
    { const float* fl = (const float*)(ws + WS_FL) + (size_t)bh * T_; LAS float* tot = cum + 4096;
      const int nval = 256 * (qb + 1); float v[8];
      if (8 * tid < nval) { const f32x4 a = *(const f32x4*)(fl + 8 * tid), c2 = *(const f32x4*)(fl + 8 * tid + 4); v[0] = a.x; v[1] = a.y; v[2] = a.z; v[3] = a.w; v[4] = c2.x; v[5] = c2.y; v[6] = c2.z; v[7] = c2.w; }
      else {
#pragma unroll
          for (int i = 0; i < 8; ++i) v[i] = 0.f; }
#pragma unroll
      for (int i = 1; i < 8; ++i) v[i] += v[i - 1];
      float sc = v[7];
#pragma unroll
      for (int o = 1; o < 64; o <<= 1) { const float up = __uint_as_float((unsigned)__builtin_amdgcn_ds_bpermute((lane - o) << 2, (int)__float_as_uint(sc))); if (lane >= o) sc += up; }
      if (lane == 63) tot[wave] = sc;
      __syncthreads();
      float base = sc - v[7];
      for (int w = 0; w < wave; ++w) base += tot[w];
      if (8 * tid < nval) {
#pragma unroll
          for (int i = 0; i < 8; ++i) cum[8 * tid + i] = v[i] + base; }
      __syncthreads(); }
    f32x16 O[1][2]; float M[1] = {0.f}, Ls[1] = {0.f};
#pragma unroll
    for (int i = 0; i < 16; ++i) { O[0][0][i] = 0.f; O[0][1][i] = 0.f; }
    const u64 tm = (qb == 15) ? ~0ull : ((1ull << (4 * qb + 4)) - 1ull);
#if AC2_MODE == 0
    {
        const u64 low = (1ull << (4 * qb)) - 1ull; const float cref = cum[256 * qb];
        attn_core<64, 1, true, false, true>(L, Kp, nullptr, Vp, cum, cref, Qf, tm & ~low, t_lane, tw0, 1 << 30, 0.f, 0u, 0u, O, M, Ls, tid, false, 4 * qb + 3, kpre, vpre);
        if (qb > 0) {
            const float qn2 = q_norm2_max<4>(Qf[0], lane), mmin = wave_min_l(M[0], lane);
            const float* kn = (const float*)((const unsigned*)(ws + WS_CTL) + CW_KN + l * 8192) + ((size_t)bh * 64 + lane) * 2;
            bool skip = false;
            if (lane < 4 * qb) { const float kn2 = kn[0] + kn[1]; const float bound = sqrtf(qn2 * kn2) * 1.02f + (cref - cum[64 * lane + 63]) * LOG2E - mmin; skip = bound < -152.f; }
            const u64 drop = prune_consensus(skip, (LAS u64*)(cum + 4096 + 16), wave, lane);
            const u64 tm2 = low & ~drop;
            if (tm2) attn_core<64, 1, true, false>(L, Kp, nullptr, Vp, cum, cref, Qf, tm2, t_lane, tw0, 1 << 30, 0.f, 0u, 0u, O, M, Ls, tid, true);
        }
    }
#else
    attn_core2<true, false>(L, (const bf16*)(ws + WS_FQKV) + 8 * MiB + (size_t)bh * T_ * 64, (const bf16*)(ws + WS_FQKV) + 16 * MiB + (size_t)bh * T_ * 64, cum, cum[256 * qb],
                            Qf[0], tm, t_lane, tw0, 1 << 30, 0.f, 0u, 0u, O[0], M[0], Ls[0], tid);
#endif
    const float lt = swap_sum(Ls[0]), inv = lt > 0.f ? 1.f / lt : 0.f;
    bf16* dst = (bf16*)(ws + WS_ATT) + mix_off((size_t)b * T_ + t_lane, 512 + hd * 64 + 4 * h, 1024);
    ATTN_FOR_CHUNKS(db, g4) { const unsigned w0 = cvtpk(O[0][db][4 * g4 + 0] * inv, O[0][db][4 * g4 + 1] * inv), w1 = cvtpk(O[0][db][4 * g4 + 2] * inv, O[0][db][4 * g4 + 3] * inv);
        *(u64*)(dst + (4 * db + g4) * 256) = (u64)w0 | ((u64)w1 << 32); }
}
__device__ __forceinline__ void U_diff(KP p_, int bh_, int qb_, int l_) {
    const KP p = uni_kp(p_); const int bh = __builtin_amdgcn_readfirstlane(bh_), qb = __builtin_amdgcn_readfirstlane(qb_), l = __builtin_amdgcn_readfirstlane(l_);
    int tid_ = threadIdx.x; asm volatile("" : "+v"(tid_));
    const int tid = tid_, lane = tid & 63, wave = __builtin_amdgcn_readfirstlane(tid >> 6), r = lane & 31, h = lane >> 5;
    unsigned char* ws = p->ws; asm volatile("" : "+s"(ws)); LAS unsigned char* L = (LAS unsigned char*)lds_raw;
    const int tw0 = 256 * qb + 32 * wave, t_lane = tw0 + r, b = bh >> 2, hd = bh & 3;
    const bf16* DQ = (const bf16*)(ws + WS_DQK); const bf16* DK = DQ + 8 * MiB;
    bf16x8v Qf[2][2];
#pragma unroll
    for (int mp = 0; mp < 2; ++mp)
#pragma unroll
        for (int s = 0; s < 2; ++s) Qf[mp][s] = *(const bf16x8v*)(DQ + ((size_t)(bh * 2 + mp) * T_ + t_lane) * 32 + 16 * s + 8 * h);
    f32x16 O[2][2]; float M[2] = {0.f, 0.f}, Ls[2] = {0.f, 0.f};
#pragma unroll
    for (int i = 0; i < 16; ++i) { O[0][0][i] = 0.f; O[0][1][i] = 0.f; O[1][0][i] = 0.f; O[1][1][i] = 0.f; }
    const u64 tm = (qb == 15) ? ~0ull : ((1ull << (4 * qb + 4)) - 1ull);
    {
        const u64 low = (1ull << (4 * qb)) - 1ull; const float slope2 = alibi_slope(hd + 1, 4) * LOG2E;
        const bf16* K0 = DK + (size_t)(bh * 2 + 0) * T_ * 32; const bf16* K1 = DK + (size_t)(bh * 2 + 1) * T_ * 32; const bf16* Vp = (const bf16*)(ws + WS_DV) + (size_t)bh * T_ * 64;
        attn_core<32, 2, false, false>(L, K0, K1, Vp, nullptr, 0.f, Qf, tm & ~low, t_lane, tw0, 1 << 30, slope2, 0u, 0u, O, M, Ls, tid);
        if (qb > 0) {
            const float qa = q_norm2_max<2>(Qf[0], lane), qb2 = q_norm2_max<2>(Qf[1], lane), ma = wave_min_l(M[0], lane), mb = wave_min_l(M[1], lane);
            const float* kn = (const float*)((const unsigned*)(ws + WS_CTL) + CW_KN + l * 8192 + 4096) + (size_t)(bh * 2) * 64 + lane;
            bool skip = false;
            if (lane < 4 * qb) { const float bmax = slope2 * (float)(64 * lane + 63 - tw0);
                skip = (sqrtf(qa * kn[0]) * 1.02f + bmax - ma < -152.f) && (sqrtf(qb2 * kn[64]) * 1.02f + bmax - mb < -152.f); }
            const u64 drop = prune_consensus(skip, (LAS u64*)(L + A_LDS_END), wave, lane);
            const u64 tm2 = low & ~drop;
            if (tm2) attn_core<32, 2, false, false>(L, K0, K1, Vp, nullptr, 0.f, Qf, tm2, t_lane, tw0, 1 << 30, slope2, 0u, 0u, O, M, Ls, tid, true);
        }
    }
    const float* lam = p->in[11] + (size_t)l * 128; const float* subln = p->in[12] + (size_t)l * 64;
    float l1 = 0.f, l2 = 0.f; if (lane < 32) { l1 = lam[lane] * lam[32 + lane]; l2 = lam[64 + lane] * lam[96 + lane]; }
    const float li = lambda_init_of(l), lam_full = __expf(wave_sum_l(l1, lane)) - __expf(wave_sum_l(l2, lane)) + li;
    const float lt0 = swap_sum(Ls[0]), lt1 = swap_sum(Ls[1]), i0 = lt0 > 0.f ? 1.f / lt0 : 0.f, i1 = (lt1 > 0.f ? 1.f / lt1 : 0.f) * lam_full;
    float ss = 0.f;
#pragma unroll
    for (int db = 0; db < 2; ++db)
#pragma unroll
        for (int i = 0; i < 16; ++i) { const float o = O[0][db][i] * i0 - O[1][db][i] * i1; O[0][db][i] = o; ss += o * o; }
    ss = swap_sum(ss);
    const float rn = rsqrtf(ss * (1.f / 64.f) + EPS) * (1.f - li);
    bf16* dst = (bf16*)(ws + WS_ATT) + mix_off((size_t)b * T_ + t_lane, 768 + hd * 64 + 4 * h, 1024);
    ATTN_FOR_CHUNKS(db, g4) { const f32x4 sg = *(const f32x4*)(subln + 32 * db + 8 * g4 + 4 * h);
        const unsigned w0 = cvtpk(O[0][db][4 * g4 + 0] * rn * sg.x, O[0][db][4 * g4 + 1] * rn * sg.y), w1 = cvtpk(O[0][db][4 * g4 + 2] * rn * sg.z, O[0][db][4 * g4 + 3] * rn * sg.w);
        *(u64*)(dst + (4 * db + g4) * 256) = (u64)w0 | ((u64)w1 << 32); }
}
__device__ __forceinline__ void U_win(KP p_, int bg_, int c_) {
    const KP p = uni_kp(p_); const int bg = __builtin_amdgcn_readfirstlane(bg_), cc = __builtin_amdgcn_readfirstlane(c_);
    int tid_ = threadIdx.x; asm volatile("" : "+v"(tid_));
    const int tid = tid_, lane = tid & 63, wave = __builtin_amdgcn_readfirstlane(tid >> 6), r = lane & 31, h = lane >> 5;
    unsigned char* ws = p->ws; asm volatile("" : "+s"(ws)); LAS unsigned char* L = (LAS unsigned char*)lds_raw;
    const int b = bg >> 1, g = bg & 1, hd = g * 4 + (wave >> 1), tw0 = 64 * cc + 32 * (wave & 1), t_lane = tw0 + r;
    const bf16* q = (const bf16*)(ws + WS_QN) + (size_t)(b * 8 + hd) * T_ * 64 + (t_lane >> 4) * 1024 + (t_lane & 15) * 32 + 8 * h;
    bf16x8v Qf[1][4];
#pragma unroll
    for (int s = 0; s < 4; ++s) Qf[0][s] = *(const bf16x8v*)(q + (s >> 1) * 512 + (s & 1) * 16);
    f32x16 O[1][2]; float M[1] = {0.f}, Ls[1] = {0.f};
#pragma unroll
    for (int i = 0; i < 16; ++i) { O[0][0][i] = 0.f; O[0][1][i] = 0.f; }
    const size_t n = (size_t)b * T_ + t_lane;
    const float gate_w = ((const float*)(ws + WS_GATE))[n * 24 + hd * 3 + 2];
    const int jlo = cc > 8 ? cc - 8 : 0;
    const u64 hi = (cc == 63) ? ~0ull : ((1ull << (cc + 1)) - 1ull), tm = hi & ~((1ull << jlo) - 1ull);
#if AC2_MODE == 0
    attn_core<64, 1, false, false>(L, (const bf16*)(ws + WS_KV6 + 4 * KV6_STRIDE) + (size_t)bg * T_ * 64, nullptr, (const bf16*)(ws + WS_KV6 + 5 * KV6_STRIDE) + (size_t)bg * T_ * 64, nullptr, 0.f,
                                   Qf, tm, t_lane, tw0, 512, alibi_slope(hd + 1, 8) * LOG2E, 0u, 0u, O, M, Ls, tid);
#ifdef PROBE_WINCORE2
    attn_core<64, 1, false, false>(L, (const bf16*)(ws + WS_KV6 + 4 * KV6_STRIDE) + (size_t)bg * T_ * 64, nullptr, (const bf16*)(ws + WS_KV6 + 5 * KV6_STRIDE) + (size_t)bg * T_ * 64, nullptr, 0.f,
                                   Qf, tm, t_lane, tw0, 512, alibi_slope(hd + 1, 8) * LOG2E, 0u, 0u, O, M, Ls, tid, true);
#endif
#else
    attn_core2<false, false>(L, (const bf16*)(ws + WS_KV6 + 4 * KV6_STRIDE) + (size_t)bg * T_ * 64, (const bf16*)(ws + WS_KV6 + 5 * KV6_STRIDE) + (size_t)bg * T_ * 64, nullptr, 0.f,
                             Qf[0], tm, t_lane, tw0, 512, alibi_slope(hd + 1, 8) * LOG2E, 0u, 0u, O[0], M[0], Ls[0], tid);
#endif
    const float lt = swap_sum(Ls[0]), inv = (lt > 0.f ? 1.f / lt : 0.f) * gate_w;
    bf16* dst = (bf16*)(ws + WS_OWIN) + mix_off(n, hd * 64 + 4 * h, 512);
    ATTN_FOR_CHUNKS(db, g4) { const unsigned w0 = cvtpk(O[0][db][4 * g4 + 0] * inv, O[0][db][4 * g4 + 1] * inv), w1 = cvtpk(O[0][db][4 * g4 + 2] * inv, O[0][db][4 * g4 + 3] * inv);
        *(u64*)(dst + (4 * db + g4) * 256) = (u64)w0 | ((u64)w1 << 32); }
}
__device__ __forceinline__ void U_slc(KP p_, int bg_, int c_) {
    const KP p = uni_kp(p_); const int bg = __builtin_amdgcn_readfirstlane(bg_), cc = __builtin_amdgcn_readfirstlane(c_);
    int tid_ = threadIdx.x; asm volatile("" : "+v"(tid_));
    const int tid = tid_, lane = tid & 63, wave = __builtin_amdgcn_readfirstlane(tid >> 6), r = lane & 31, h = lane >> 5;
    unsigned char* ws = p->ws; asm volatile("" : "+s"(ws)); LAS unsigned char* L = (LAS unsigned char*)lds_raw;
    const int b = bg >> 1, g = bg & 1, hd = g * 4 + (wave >> 1), tw0 = 64 * cc + 32 * (wave & 1), t_lane = tw0 + r;
    const bf16* q = (const bf16*)(ws + WS_QN) + (size_t)(b * 8 + hd) * T_ * 64 + (t_lane >> 4) * 1024 + (t_lane & 15) * 32 + 8 * h;
    bf16x8v Qf[1][4];
#pragma unroll
    for (int s = 0; s < 4; ++s) Qf[0][s] = *(const bf16x8v*)(q + (s >> 1) * 512 + (s & 1) * 16);
    f32x16 O[1][2]; float M[1] = {0.f}, Ls[1] = {0.f};
#pragma unroll
    for (int i = 0; i < 16; ++i) { O[0][0][i] = 0.f; O[0][1][i] = 0.f; }
    const bf16* Ksl = (const bf16*)(ws + WS_KV6 + 2 * KV6_STRIDE) + (size_t)bg * T_ * 64; const bf16* Vsl = (const bf16*)(ws + WS_KV6 + 3 * KV6_STRIDE) + (size_t)bg * T_ * 64;
    u32x4 kpre, vpre; attn_preload<64>(Ksl, nullptr, Vsl, cc, tid, kpre, vpre);
    const size_t n = (size_t)b * T_ + t_lane;
    const float gate_s = ((const float*)(ws + WS_GATE))[n * 24 + hd * 3 + 1];
    const bf16* oc = (const bf16*)(ws + WS_OCMP) + mix_off(n, hd * 64 + 4 * h, 512); const bf16* ow = (const bf16*)(ws + WS_OWIN) + mix_off(n, hd * 64 + 4 * h, 512);
    u64 ocv[8], owv[8];
    ATTN_FOR_CHUNKS(db, g4) { ocv[4 * db + g4] = *(const u64*)(oc + (4 * db + g4) * 256); owv[4 * db + g4] = *(const u64*)(ow + (4 * db + g4) * 256); }
    const u64* sel = (const u64*)(ws + WS_SEL) + (size_t)bg * T_;
    const u64 mine = sel[t_lane]; u64 un = sel[64 * cc + lane];
    { unsigned ul = (unsigned)un, uh = (unsigned)(un >> 32);
#pragma unroll
      for (int o = 1; o < 64; o <<= 1) { ul |= shflx_u(ul, o, lane); uh |= shflx_u(uh, o, lane); }
      un = ((u64)__builtin_amdgcn_readfirstlane(uh) << 32) | __builtin_amdgcn_readfirstlane(ul); }
#if AC2_MODE == 0
    attn_core<64, 1, false, true, true>(L, Ksl, nullptr, Vsl, nullptr, 0.f,
                                  Qf, un, t_lane, tw0, 1 << 30, alibi_slope(hd + 1, 8) * LOG2E, (unsigned)mine, (unsigned)(mine >> 32), O, M, Ls, tid, false, cc, kpre, vpre);
#else
    attn_core2<false, true>(L, (const bf16*)(ws + WS_KV6 + 2 * KV6_STRIDE) + (size_t)bg * T_ * 64, (const bf16*)(ws + WS_KV6 + 3 * KV6_STRIDE) + (size_t)bg * T_ * 64, nullptr, 0.f,
                            Qf[0], un, t_lane, tw0, 1 << 30, alibi_slope(hd + 1, 8) * LOG2E, (unsigned)mine, (unsigned)(mine >> 32), O[0], M[0], Ls[0], tid);
#endif
    const float lt = swap_sum(Ls[0]), inv = (lt > 0.f ? 1.f / lt : 0.f) * gate_s;
    bf16* dst = (bf16*)(ws + WS_ATT) + mix_off(n, hd * 64 + 4 * h, 1024);
    ATTN_FOR_CHUNKS(db, g4) { const u64 a = ocv[4 * db + g4], w = owv[4 * db + g4];
        const float x0 = O[0][db][4 * g4 + 0] * inv + __uint_as_float((unsigned)a << 16) + __uint_as_float((unsigned)w << 16);
        const float x1 = O[0][db][4 * g4 + 1] * inv + __uint_as_float((unsigned)a & 0xffff0000u) + __uint_as_float((unsigned)w & 0xffff0000u);
        const float x2 = O[0][db][4 * g4 + 2] * inv + __uint_as_float((unsigned)(a >> 32) << 16) + __uint_as_float((unsigned)(w >> 32) << 16);
        const float x3 = O[0][db][4 * g4 + 3] * inv + __uint_as_float((unsigned)(a >> 32) & 0xffff0000u) + __uint_as_float((unsigned)(w >> 32) & 0xffff0000u);
        *(u64*)(dst + (4 * db + g4) * 256) = (u64)cvtpk(x0, x1) | ((u64)cvtpk(x2, x3) << 32); }
}
__device__ __forceinline__ float other_half(float x, int h) { auto rr = __builtin_amdgcn_permlane32_swap(__float_as_uint(x), __float_as_uint(x), false, false); return __uint_as_float(h ? rr[0] : rr[1]); }
__device__ __forceinline__ int other_half_i(int x, int h) { auto rr = __builtin_amdgcn_permlane32_swap((unsigned)x, (unsigned)x, false, false); return (int)(h ? rr[0] : rr[1]); }
template <bool MASK>
__device__ __forceinline__ void cmp_scores(f32x16& p0, f32x16& p1, const LAS unsigned char* kt, const bf16x8v (&Qf)[4], float b0, float s1, int cl, int nvis_l) {
    const float s8 = s1 * 8.f, s32 = s1 * 32.f;
    p0[0] = b0; p0[1] = p0[0] + s1; p0[2] = p0[1] + s1; p0[3] = p0[2] + s1;
#pragma unroll
    for (int reg = 4; reg < 16; ++reg) p0[reg] = p0[reg - 4] + s8;
#pragma unroll
    for (int reg = 0; reg < 16; ++reg) p1[reg] = p0[reg] + s32;
#pragma unroll
    for (int s = 0; s < 4; ++s) { const bf16x8v kf0 = *(const LAS bf16x8v*)(kt + s * 32), kf1 = *(const LAS bf16x8v*)(kt + 32 * 144 + s * 32);
        p0 = __builtin_amdgcn_mfma_f32_32x32x16_bf16(kf0, Qf[s], p0, 0, 0, 0); p1 = __builtin_amdgcn_mfma_f32_32x32x16_bf16(kf1, Qf[s], p1, 0, 0, 0); }
    if (MASK) {
#pragma unroll
        for (int reg = 0; reg < 16; ++reg) { const int c = cl + crow0(reg); p0[reg] = (c < nvis_l) ? p0[reg] : -INFINITY; p1[reg] = (c + 32 < nvis_l) ? p1[reg] : -INFINITY; } }
}
__device__ __forceinline__ void U_cmp(KP p_, int bg_, int u_) {
    const KP p = uni_kp(p_); const int bg = __builtin_amdgcn_readfirstlane(bg_), uu = __builtin_amdgcn_readfirstlane(u_);
    int tid_ = threadIdx.x; asm volatile("" : "+v"(tid_));
    const int tid = tid_, lane = tid & 63, wave = __builtin_amdgcn_readfirstlane(tid >> 6), r = lane & 31, h = lane >> 5;
    unsigned char* ws = p->ws; asm volatile("" : "+s"(ws)); LAS unsigned char* L = (LAS unsigned char*)lds_raw;
    const int b = bg >> 1, g = bg & 1, tw0 = 32 * (uu + 16 * wave), t_lane = tw0 + r;
    { const bf16* kc = (const bf16*)(ws + WS_KVCMP) + (size_t)bg * 256 * 64; const bf16* vc = kc + 16 * 256 * 64;
#pragma unroll
      for (int i = 0; i < 4; ++i) { const int ch = tid + 512 * i, row = ch >> 3, c8 = ch & 7;
          *(LAS u32x4*)(L + row * 144 + c8 * 16) = *(const u32x4*)(kc + row * 64 + c8 * 8); *(LAS u32x4*)(L + 36864 + row * 144 + c8 * 16) = *(const u32x4*)(vc + row * 64 + c8 * 8); } }
    __syncthreads();
    const int nvis_l = t_lane >= 31 ? ((t_lane - 31) >> 4) + 1 : 0, nvis_max = (tw0 >> 4) + 1, nvis_min = tw0 >= 31 ? ((tw0 - 31) >> 4) + 1 : 0, ntile = (nvis_max + 63) >> 6;
    const LAS unsigned char* kfrag = L + r * 144 + h * 16;
    const LAS unsigned char* vfrag = L + 36864 + (4 * h + ((lane & 15) >> 2)) * 144 + (16 * ((lane >> 4) & 1) + 4 * (lane & 3)) * 2;
    float imp[32];
#pragma unroll
    for (int e = 0; e < 32; ++e) imp[e] = 0.f;
    const float* gate = (const float*)(ws + WS_GATE) + ((size_t)b * T_ + t_lane) * 24;
#pragma unroll 1
    for (int hg = 0; hg < 4; ++hg) {
        const int hd = g * 4 + hg; const float s1 = alibi_slope(hd + 1, 8) * LOG2E * 16.f;
        const bf16* q = (const bf16*)(ws + WS_QN) + (size_t)(b * 8 + hd) * T_ * 64 + (t_lane >> 4) * 1024 + (t_lane & 15) * 32 + 8 * h;
        bf16x8v Qf[4];
#pragma unroll
        for (int s = 0; s < 4; ++s) Qf[s] = *(const bf16x8v*)(q + (s >> 1) * 512 + (s & 1) * 16);
        float m = -1e30f, lsum = 0.f;
#pragma unroll 1
        for (int jt = 0; jt < ntile; ++jt) {
            f32x16 p0, p1; const float b0 = s1 * (float)(64 * jt + 4 * h - nvis_max);
            if (64 * jt + 63 >= nvis_min) cmp_scores<true>(p0, p1, kfrag + jt * (64 * 144), Qf, b0, s1, 64 * jt + 4 * h, nvis_l);
            else cmp_scores<false>(p0, p1, kfrag + jt * (64 * 144), Qf, b0, s1, 64 * jt + 4 * h, nvis_l);
            float mt = fmaxf(p0[0], p1[0]);
#pragma unroll
            for (int reg = 1; reg < 16; ++reg) mt = fmaxf(mt, fmaxf(p0[reg], p1[reg]));
            mt = swap_max(mt);
            const float mn = fmaxf(m, mt); float rs = 0.f;
#pragma unroll
            for (int reg = 0; reg < 16; ++reg) rs += __builtin_amdgcn_exp2f(p0[reg] - mn) + __builtin_amdgcn_exp2f(p1[reg] - mn);
            lsum = lsum * __builtin_amdgcn_exp2f(m - mn) + rs; m = mn;
        }
        const float lt = swap_sum(lsum), inv = lt > 0.f ? 1.f / lt : 0.f;
        f32x16 O0, O1;
#pragma unroll
        for (int i = 0; i < 16; ++i) { O0[i] = 0.f; O1[i] = 0.f; }
        float carry = 0.f;
#pragma unroll
        for (int jt = 0; jt < 4; ++jt) if (jt < ntile) {
            f32x16 p0, p1; const float b0 = s1 * (float)(64 * jt + 4 * h - nvis_max);
            if (64 * jt + 63 >= nvis_min) cmp_scores<true>(p0, p1, kfrag + jt * (64 * 144), Qf, b0, s1, 64 * jt + 4 * h, nvis_l);
            else cmp_scores<false>(p0, p1, kfrag + jt * (64 * 144), Qf, b0, s1, 64 * jt + 4 * h, nvis_l);
#pragma unroll
            for (int reg = 0; reg < 16; ++reg) { p0[reg] = __builtin_amdgcn_exp2f(p0[reg] - m) * inv; p1[reg] = __builtin_amdgcn_exp2f(p1[reg] - m) * inv; }
            float cv[8];
#pragma unroll
            for (int g4 = 0; g4 < 4; ++g4) { const float h0 = 0.5f * p0[4 * g4 + 3], h1 = 0.5f * p1[4 * g4 + 3];
                imp[jt * 8 + g4] += ((p0[4 * g4] + p0[4 * g4 + 1]) + p0[4 * g4 + 2]) + h0; imp[jt * 8 + 4 + g4] += ((p1[4 * g4] + p1[4 * g4 + 1]) + p1[4 * g4 + 2]) + h1;
                cv[g4] = h0; cv[4 + g4] = h1; }
            float prev = carry;
#pragma unroll
            for (int k = 0; k < 8; ++k) { const float sv = other_half(cv[k], h); imp[jt * 8 + k] += h ? sv : prev; prev = sv; }
            carry = prev;
            const bf16x8v pa0 = pack8(p0, 0), pa1 = pack8(p0, 8), pa2 = pack8(p1, 0), pa3 = pack8(p1, 8);
            const LAS unsigned char* vb = vfrag + jt * (64 * 144);
#pragma unroll
            for (int ks = 0; ks < 4; ++ks) { const bf16x8v pa = ks == 0 ? pa0 : ks == 1 ? pa1 : ks == 2 ? pa2 : pa3;
                { const s16x4 lo = tr_read(vb + ks * (16 * 144)), hi = tr_read(vb + ks * (16 * 144) + 8 * 144); const bf16x8v vf = {lo[0], lo[1], lo[2], lo[3], hi[0], hi[1], hi[2], hi[3]};
                  O0 = __builtin_amdgcn_mfma_f32_32x32x16_bf16(vf, pa, O0, 0, 0, 0); }
                { const s16x4 lo = tr_read(vb + ks * (16 * 144) + 64), hi = tr_read(vb + ks * (16 * 144) + 64 + 8 * 144); const bf16x8v vf = {lo[0], lo[1], lo[2], lo[3], hi[0], hi[1], hi[2], hi[3]};
                  O1 = __builtin_amdgcn_mfma_f32_32x32x16_bf16(vf, pa, O1, 0, 0, 0); } }
        }
        const float gt = gate[hd * 3 + 0];
        bf16* dst = (bf16*)(ws + WS_OCMP) + mix_off((size_t)b * T_ + t_lane, hd * 64 + 4 * h, 512);
#pragma unroll
        for (int g4 = 0; g4 < 4; ++g4) {
            *(u64*)(dst + g4 * 256) = (u64)cvtpk(O0[4 * g4 + 0] * gt, O0[4 * g4 + 1] * gt) | ((u64)cvtpk(O0[4 * g4 + 2] * gt, O0[4 * g4 + 3] * gt) << 32);
            *(u64*)(dst + (4 + g4) * 256) = (u64)cvtpk(O1[4 * g4 + 0] * gt, O1[4 * g4 + 1] * gt) | ((u64)cvtpk(O1[4 * g4 + 2] * gt, O1[4 * g4 + 3] * gt) << 32); }
    }
    const int cur = tw0 >> 6; u64 mask;
    if (cur <= 15) mask = (1ull << (cur + 1)) - 1ull;
    else {
        mask = 1ull | (1ull << cur) | (1ull << (cur - 1));
#pragma unroll
        for (int e = 0; e < 32; ++e) { const int j = 2 * e + h; if (j > cur || j == 0 || j >= cur - 1) imp[e] = -INFINITY; }
#pragma unroll 1
        for (int round = 0; round < 13; ++round) {
            float bv = imp[0]; int be = 0;
#pragma unroll
            for (int e = 1; e < 32; ++e) if (imp[e] > bv) { bv = imp[e]; be = e; }
            const int bj = 2 * be + h; const float ov = other_half(bv, h); const int oj = other_half_i(bj, h);
            const bool mine = bv > ov || (bv == ov && bj < oj);
            mask |= 1ull << (mine ? bj : oj);
#pragma unroll
            for (int e = 0; e < 32; ++e) imp[e] = (mine && e == be) ? -INFINITY : imp[e];
        }
    }
    if (h == 0) ((u64*)(ws + WS_SEL))[(size_t)bg * T_ + t_lane] = mask;
    __syncthreads();
}
constexpr int CONV_UNITS = L_ * NEXP * (2 * 16 * 8 + 4 * 32) / 32;
__device__ __forceinline__ void U_conv(KP p_, int k_) {
    const KP p = uni_kp(p_); const int k = __builtin_amdgcn_readfirstlane(k_);
    int tid_ = threadIdx.x; asm volatile("" : "+v"(tid_));
    const int tid = tid_, lane = tid & 63, wave = __builtin_amdgcn_readfirstlane(tid >> 6);
    unsigned char* ws = p->ws; asm volatile("" : "+s"(ws));
    LAS float* scr = (LAS float*)lds_raw + wave * (64 * 33);
    constexpr int I_G = 16 * 8, I_D = 4 * 32, I_E = 2 * I_G + I_D;
#pragma unroll 1
    for (int i = 0; i < 4; ++i) {
        const int m = k * 32 + i * 8 + wave, l = m / (NEXP * I_E); int r = m % (NEXP * I_E); const int e = r / I_E; r = r % I_E; const size_t le = (size_t)l * NEXP + e;
        const float* W; bf16* WT; int ldw, K, ncol, r0 = 0, rmul = 1; const float* gk = nullptr;
        if (r < 2 * I_G) { const int up = r >= I_G; r -= up * I_G; W = p->in[19 + up] + le * D_ * DEXP; WT = (bf16*)(ws + WS_WGU_T) + le * 512 * D_; ldw = DEXP; K = D_; ncol = 256; r0 = up; rmul = 2; gk = p->in[14] + (size_t)l * D_; }
        else { r -= 2 * I_G; W = p->in[21] + le * DEXP * D_; WT = (bf16*)(ws + WS_WD_T) + le * D_ * DEXP; ldw = D_; K = DEXP; ncol = 1024; }
        transpose_seg(W, ldw, K, 0, ncol, WT, r0, rmul, r, scr, lane, gk);
    }
}
__device__ __forceinline__ int fetch_unit(KP p, int qidx) {
    volatile LAS unsigned* slot = (volatile LAS unsigned*)((LAS unsigned char*)lds_raw + MISC_OFF) + 16;
    __syncthreads();
    int t0_ = threadIdx.x; asm volatile("" : "+v"(t0_));
    if (t0_ == 0) *slot = __hip_atomic_fetch_add((unsigned*)(p->ws + WS_CTL) + CW_QUEUE + 64 * qidx, 1u, __ATOMIC_RELAXED, __HIP_MEMORY_SCOPE_AGENT);
    __syncthreads();
    return (int)__builtin_amdgcn_readfirstlane(*slot);
}
__device__ __forceinline__ void P_cmp1_mfma(int l_) { const KP p = (KP)__builtin_amdgcn_kernarg_segment_ptr(); int l = l_; asm volatile("" : "+s"(l));
    unsigned char* ws = p->ws; asm volatile("" : "+s"(ws)); const int c = launder_s((int)blockIdx.x), kv = c >> 4, pm = c & 15;
    OneUnitOrder S; S.has = c < 32; S.u.pm = pm; S.u.pn = kv;
    S.u.a = (const char*)(ws + WS_KV6 + (size_t)kv * KV6_STRIDE) + (size_t)pm * 256 * 1024 * 2; S.u.b = (const char*)((const bf16*)(ws + WS_W1_T) + ((size_t)l * 2 + kv) * 256 * 2048); S.u.b2 = S.u.b;
    const pg8::Gemm g{1024, 2048, 2048, 32, 0, 0};
    const EpiCmpH E{(bf16*)(ws + WS_HC), (const float*)(ws + WS_BIAS1) + l * 512};
    pg8::gemm_phase<EpiCmpH, OneUnitOrder, false, true>((LAS unsigned char*)lds_raw, g, S, E);
}
__device__ __forceinline__ void P_cmp2_mfma(int l_) { const KP p = (KP)__builtin_amdgcn_kernarg_segment_ptr(); int l = l_; asm volatile("" : "+s"(l));
    unsigned char* ws = p->ws; asm volatile("" : "+s"(ws)); const int c = launder_s((int)blockIdx.x), kv = c >> 4, pm = c & 15;
    OneUnitOrder S; S.has = c < 32; S.u.pm = pm; S.u.pn = kv;
    S.u.a = (const char*)((const bf16*)(ws + WS_HC) + ((size_t)kv * 4096 + pm * 256) * 256); S.u.b = (const char*)((const bf16*)(ws + WS_W2_T) + ((size_t)l * 2 + kv) * 64 * 256); S.u.b2 = S.u.b;
    const pg8::Gemm g{256, 256, 256, 4, 0, 0};
    const EpiCmpOut E{(bf16*)(ws + WS_KVCMP)};
    pg8::gemm_phase<EpiCmpOut, OneUnitOrder, false, true>((LAS unsigned char*)lds_raw, g, S, E);
}
__device__ __forceinline__ void P_moe_scatter(KP p_, int l_) { const KP p = uni_kp(p_); const int l = __builtin_amdgcn_readfirstlane(l_); const Ctx c = make_ctx(p); unsigned char* ws = p->ws;
    const unsigned* cnt = (const unsigned*)(ws + WS_CTL) + CW_MOECNT + l * MOE_LS;
    moe_build_tables(cnt, c.tid);
    const LAS int* T = (const LAS int*)((LAS unsigned char*)lds_raw + TBL_OFF);
    const unsigned* info = (const unsigned*)(ws + WS_ROUTE + RT_INFO); const float* tw = (const float*)(ws + WS_ROUTE + RT_W);
    int* rowtok = (int*)(ws + WS_ROUTE + RT_ROWTOK); float* roww = (float*)(ws + WS_ROUTE + RT_ROWW);
    bf16* xs = (bf16*)(ws + WS_XS); const bf16* x = (const bf16*)(ws + WS_HN); const float* gain = p->in[14] + (size_t)l * D_; const float* rstdv = (const float*)(ws + WS_ROUTE + RT_RSTD);
    { constexpr int RB = 4; float gg[2][8];
#pragma unroll
      for (int j = 0; j < 2; ++j) { const f32x4 a = ((const f32x4*)gain)[2 * c.lane + 128 * j], b2 = ((const f32x4*)gain)[2 * c.lane + 128 * j + 1]; gg[j][0] = a.x; gg[j][1] = a.y; gg[j][2] = a.z; gg[j][3] = a.w; gg[j][4] = b2.x; gg[j][5] = b2.y; gg[j][6] = b2.z; gg[j][7] = b2.w; }
      for (int row0 = c.gw * RB; row0 < NT; row0 += c.ngw * RB) {
        u32x4 vv[RB][2];
#pragma unroll
        for (int q = 0; q < RB; ++q)
#pragma unroll
            for (int j = 0; j < 2; ++j) vv[q][j] = ((const u32x4*)(x + (size_t)(row0 + q) * D_))[c.lane + 64 * j];
#pragma unroll
        for (int q = 0; q < RB; ++q) { const int row = row0 + q;
            const unsigned v = info[row]; const int cls = (int)(v >> 24), rank = (int)(v & 0xffffffu); const size_t dest = (size_t)T[cls] * 256 + rank; const float r = rstdv[row];
#pragma unroll
            for (int j = 0; j < 2; ++j) { float f[8]; unpack8(vv[q][j], f); u32x4 o; o.x = pk2(f[0] * r * gg[j][0], f[1] * r * gg[j][1]); o.y = pk2(f[2] * r * gg[j][2], f[3] * r * gg[j][3]); o.z = pk2(f[4] * r * gg[j][4], f[5] * r * gg[j][5]); o.w = pk2(f[6] * r * gg[j][6], f[7] * r * gg[j][7]);
                ((u32x4*)(xs + dest * D_))[c.lane + 64 * j] = o; }
            if (c.lane == 0) { rowtok[dest] = row; roww[2 * dest] = tw[2 * row]; roww[2 * dest + 1] = tw[2 * row + 1]; } }
      } }
    for (int cls = c.bid; cls < 112; cls += c.G) { const int n = (int)cnt[cls * MOE_CS], end = (int)((cnt[cls * MOE_CS] + 255u) >> 8) * 256; const size_t base = (size_t)T[cls] * 256;
        for (int r = n + c.tid; r < end; r += NTHREADS) rowtok[base + r] = -1; }
}
__device__ __forceinline__ void P_moe_g1(int l_) { const KP p = (KP)__builtin_amdgcn_kernarg_segment_ptr(); int l = l_; asm volatile("" : "+s"(l));
    unsigned char* ws = p->ws; asm volatile("" : "+s"(ws));
    { int t0_ = threadIdx.x; asm volatile("" : "+v"(t0_)); moe_build_tables((const unsigned*)(ws + WS_CTL) + CW_MOECNT + l * MOE_LS, t0_); }
    const MoeOrder1 S{(const char*)ws, (const unsigned*)(ws + WS_REC), (const char*)((const bf16*)(ws + WS_WGU_T) + (size_t)l * NEXP * 512 * D_), (int)gridDim.x, launder_s((int)blockIdx.x)};
    const pg8::Gemm g{D_, D_, D_, D_ / 64, 0, 0};
    const EpiMoeH E{(bf16*)(ws + WS_HB), (const u32x4*)(ws + WS_REC)};
    pg8::gemm_phase<EpiMoeH, MoeOrder1, true, true, true>((LAS unsigned char*)lds_raw, g, S, E);
}
__device__ __forceinline__ void P_moe_g2(int l_) { const KP p = (KP)__builtin_amdgcn_kernarg_segment_ptr(); int l = l_; asm volatile("" : "+s"(l));
    unsigned char* ws = p->ws; asm volatile("" : "+s"(ws));
    { int t0_ = threadIdx.x; asm volatile("" : "+v"(t0_)); moe_build_tables((const unsigned*)(ws + WS_CTL) + CW_MOECNT + l * MOE_LS, t0_); }
    const MoeOrder2 S{(const char*)(ws + WS_HB), (const char*)((const bf16*)(ws + WS_WD_T) + (size_t)l * NEXP * D_ * DEXP), (int)gridDim.x, launder_s((int)blockIdx.x)};
    const pg8::Gemm g{512, DEXP, 512, 4, 16, 16};
    const EpiMoeOut E{(bf16*)(ws + WS_HN), (const unsigned*)(ws + WS_REC)};
    pg8::gemm_phase<EpiMoeOut, MoeOrder2, true, true>((LAS unsigned char*)lds_raw, g, S, E);
}
__device__ __forceinline__ void P_norm1(KP p_, int l_) { const KP p = uni_kp(p_); const int l = __builtin_amdgcn_readfirstlane(l_); const Ctx c = make_ctx(p); const Bufs b = make_bufs(p->ws);
    if (l == 0) { const int i = c.bid * NTHREADS + c.tid; if (i < L_ * 2 * 256) { const float* part = (const float*)(p->ws + WS_B1PART) + (size_t)(i >> 8) * 128 * 256 + (i & 255); float a = 0.f;
        for (int k = 0; k < 128; ++k) a += part[(size_t)k * 256]; ((float*)(p->ws + WS_BIAS1))[i] = a; } }
    if (l == 0) ph_norm_bf16(c, p->in[0], p->in[1], (bf16*)p->out, (bf16*)(p->ws + WS_HN)); else ph_norm_bf16_from_bf16(c, (const bf16*)(p->ws + WS_HN), p->in[1] + (size_t)l * D_, (bf16*)p->out); }
__device__ __noinline__ void P_inproj(KP p_, int l_) { const KP p = uni_kp(p_); const int l = __builtin_amdgcn_readfirstlane(l_); const Ctx c = make_ctx(p); const Bufs b = make_bufs(p->ws);
    InProjOut o{b.QN, b.KV6, b.FQ, b.DQ, b.DV, b.GATE, b.FL, p->in[3] + l * 24, p->in[4] + l * 4};
    const bf16* A = b.HN;
    naive_gemm(c, NT, D_IN, D_, [=](int r, int k) { return bf2f(A[(size_t)r * D_ + k]); }, p->in[2] + (size_t)l * D_ * D_IN, D_IN,
               [=](int r, int col, float v) { inproj_store(o, r, col, v); }); }
__device__ __noinline__ void P_cmp1(KP p_, int l_, int kv_) { const KP p = uni_kp(p_); const int l = __builtin_amdgcn_readfirstlane(l_), kv = __builtin_amdgcn_readfirstlane(kv_); const Ctx c = make_ctx(p); const Bufs b = make_bufs(p->ws);
    const bf16* src = kv == 0 ? b.KC : b.VC; const float* pe = p->in[kv == 0 ? 5 : 8] + (size_t)l * 2048; bf16* hc = b.HC + (size_t)kv * 4096 * 256;
    naive_gemm(c, 4096, 256, 2048, [=](int r, int k) { return bf2f(src[(size_t)r * 1024 + k]) + pe[k]; }, p->in[kv == 0 ? 6 : 9] + (size_t)l * 2048 * 256, 256,
               [=](int r, int col, float v) { hc[(size_t)r * 256 + col] = (bf16)f2bf(gelu_tanh(v)); }); }
__device__ __noinline__ void P_cumsum(KP p_, int l_) { const KP p = uni_kp(p_); const int l = __builtin_amdgcn_readfirstlane(l_); const Ctx c = make_ctx(p); const Bufs b = make_bufs(p->ws); ph_cumsum(c, b.FL); }
__device__ __noinline__ void P_cmp2(KP p_, int l_, int kv_) { const KP p = uni_kp(p_); const int l = __builtin_amdgcn_readfirstlane(l_), kv = __builtin_amdgcn_readfirstlane(kv_); const Ctx c = make_ctx(p); const Bufs b = make_bufs(p->ws);
    const bf16* hc = b.HC + (size_t)kv * 4096 * 256; bf16* dst = kv == 0 ? b.KCMP : b.VCMP;
    naive_gemm(c, 4096, 64, 256, [=](int r, int k) { return bf2f(hc[(size_t)r * 256 + k]); }, p->in[kv == 0 ? 7 : 10] + (size_t)l * 256 * 64, 64,
               [=](int r, int col, float v) { dst[(size_t)r * 64 + col] = (bf16)f2bf((r & 255) == 255 ? 0.f : v); }); }
__device__ __noinline__ void P_win(KP p_, int l_) { const KP p = uni_kp(p_); const int l = __builtin_amdgcn_readfirstlane(l_); const Ctx c = make_ctx(p); const Bufs b = make_bufs(p->ws); ph_win_attn(c, b.QN, b.KW, b.VW, b.GATE, b.OWIN); }
__device__ __noinline__ void P_fox(KP p_, int l_) { const KP p = uni_kp(p_); const int l = __builtin_amdgcn_readfirstlane(l_); const Ctx c = make_ctx(p); const Bufs b = make_bufs(p->ws); ph_fox_attn(c, b.FQ, b.FK, b.FV, b.FL, b.ATT); }
__device__ __noinline__ void P_diff(KP p_, int l_) { const KP p = uni_kp(p_); const int l = __builtin_amdgcn_readfirstlane(l_); const Ctx c = make_ctx(p); const Bufs b = make_bufs(p->ws);
    ph_diff_attn(c, b.DQ, b.DK, b.DV, p->in[11] + (size_t)l * 128, p->in[12] + (size_t)l * 64, lambda_init_of(l), b.ATT); }
__device__ __noinline__ void P_cmpattn(KP p_, int l_) { const KP p = uni_kp(p_); const int l = __builtin_amdgcn_readfirstlane(l_); const Ctx c = make_ctx(p); const Bufs b = make_bufs(p->ws); ph_cmp_attn(c, b.QN, b.KCMP, b.VCMP, b.GATE, b.SEL, b.OCMP); }
__device__ __noinline__ void P_slc(KP p_, int l_) { const KP p = uni_kp(p_); const int l = __builtin_amdgcn_readfirstlane(l_); const Ctx c = make_ctx(p); const Bufs b = make_bufs(p->ws); ph_slc_attn(c, b.QN, b.KS, b.VS, b.GATE, b.SEL, b.OCMP, b.OWIN, b.ATT); }
__device__ __noinline__ void P_outproj(KP p_, int l_) { const KP p = uni_kp(p_); const int l = __builtin_amdgcn_readfirstlane(l_); const Ctx c = make_ctx(p); const Bufs b = make_bufs(p->ws);
    const bf16* A = b.ATT; float* xo = p->out; const float* xin = (l == 0) ? p->in[0] : p->out;
    naive_gemm(c, NT, D_, D_, [=](int r, int k) { return bf2f(A[(size_t)r * D_ + k]); }, p->in[13] + (size_t)l * D_ * D_, D_,
               [=](int r, int col, float v) { xo[(size_t)r * D_ + col] = xin[(size_t)r * D_ + col] + v; }); }
__device__ __forceinline__ void P_route3(int l_, int cbank) { const KP p = (KP)__builtin_amdgcn_kernarg_segment_ptr(); int l = l_; asm volatile("" : "+s"(l));
    int tid_ = threadIdx.x; asm volatile("" : "+v"(tid_));
    const int tid = tid_, lane = tid & 63, wave = __builtin_amdgcn_readfirstlane(tid >> 6), r = lane & 31, h = lane >> 5, kh = wave >> 2, wr = wave & 3;
    unsigned char* ws = p->ws; asm volatile("" : "+s"(ws)); const bf16* x = (const bf16*)(ws + WS_HN);
    const float* WR = (const float*)(ws + WS_WR) + (size_t)l * D_ * 64;
    LAS float* XT = (LAS float*)lds_raw + wave * (32 * 36);
    LAS float* WT = (LAS float*)lds_raw + 8 * 32 * 36 + kh * (2 * 32 * 64);
    LAS float* PL = (LAS float*)lds_raw + 8 * 32 * 36 + 2 * 2 * 32 * 64;
    LAS float* SS = PL + 2 * 128 * 40;
    const float* bgrp = p->in[16] + l * 4; const float* bexp = p->in[18] + l * 32;
    unsigned* cnt = (unsigned*)(ws + WS_CTL) + CW_MOECNT + l * MOE_LS + cbank;
    LAS unsigned* HIST = (LAS unsigned*)(SS + 2 * 128 * 2);
    for (int grp = launder_s((int)blockIdx.x); grp < NT / 128; grp += (int)gridDim.x) {
        const int row0 = grp * 128 + wr * 32;
        if (tid < 112) HIST[tid] = 0u;
        f32x16 acc0, acc1; float ss = 0.f;
#pragma unroll
        for (int i = 0; i < 16; ++i) { acc0[i] = 0.f; acc1[i] = 0.f; }
        { const u32x4* xsrc = (const u32x4*)(x + (size_t)(row0 + r) * D_ + kh * 512 + 8 * h);
          const u32x4* wsrc = (const u32x4*)(ws + WS_WR) + ((size_t)l * 64 + kh * 32) * 256 + lane;
#pragma unroll 4
          for (int ks = 0; ks < 32; ++ks) {
              const u32x4 av = xsrc[2 * ks], b0h = wsrc[ks * 256], b0l = wsrc[ks * 256 + 64], b1h = wsrc[ks * 256 + 128], b1l = wsrc[ks * 256 + 192];
              { float f_[8]; unpack8(av, f_);
#pragma unroll
                for (int e = 0; e < 8; ++e) ss = fmaf(f_[e], f_[e], ss); }
              const bf16x8v A = __builtin_bit_cast(bf16x8v, av);
              acc0 = __builtin_amdgcn_mfma_f32_32x32x16_bf16(A, __builtin_bit_cast(bf16x8v, b0h), acc0, 0, 0, 0); acc1 = __builtin_amdgcn_mfma_f32_32x32x16_bf16(A, __builtin_bit_cast(bf16x8v, b1h), acc1, 0, 0, 0);
              acc0 = __builtin_amdgcn_mfma_f32_32x32x16_bf16(A, __builtin_bit_cast(bf16x8v, b0l), acc0, 0, 0, 0); acc1 = __builtin_amdgcn_mfma_f32_32x32x16_bf16(A, __builtin_bit_cast(bf16x8v, b1l), acc1, 0, 0, 0);
          } }
#pragma unroll
        for (int reg = 0; reg < 16; ++reg) { const int row = wr * 32 + crow0(reg) + 4 * h; PL[(kh * 128 + row) * 40 + r] = acc0[reg]; if (r < 4) PL[(kh * 128 + row) * 40 + 32 + r] = acc1[reg]; }
        SS[(kh * 128 + wr * 32 + r) * 2 + h] = ss;
        __syncthreads();
        int cls = 0; unsigned lrank = 0u; float wlo = 0.f, whi = 0.f, rstd = 0.f;
        if (tid < 128) {
            float lg[36];
#pragma unroll
            for (int cidx = 0; cidx < 36; ++cidx) lg[cidx] = PL[tid * 40 + cidx] + PL[(128 + tid) * 40 + cidx];
            const float sq = (SS[tid * 2] + SS[tid * 2 + 1]) + (SS[(128 + tid) * 2] + SS[(128 + tid) * 2 + 1]);
            rstd = rsqrtf(sq * (1.f / D_) + EPS);
            float gl[4]; int grp_i = 0;
#pragma unroll
            for (int q = 0; q < 4; ++q) gl[q] = lg[q] * rstd + bgrp[q];
            float gm = gl[0];
#pragma unroll
            for (int q = 1; q < 4; ++q) if (gl[q] > gm) { gm = gl[q]; grp_i = q; }
            float gs = 0.f;
#pragma unroll
            for (int q = 0; q < 4; ++q) gs += __expf(gl[q] - gm);
            const float grp_gate = 1.f / gs;
            float el[8];
#pragma unroll
            for (int q = 0; q < 8; ++q) { float v = lg[4 + q]; float bb = bexp[q];
                if (grp_i == 1) { v = lg[12 + q]; bb = bexp[8 + q]; } else if (grp_i == 2) { v = lg[20 + q]; bb = bexp[16 + q]; } else if (grp_i == 3) { v = lg[28 + q]; bb = bexp[24 + q]; }
                el[q] = v * rstd + bb; }
            int i0 = 0; float v0 = el[0];
#pragma unroll
            for (int q = 1; q < 8; ++q) if (el[q] > v0) { v0 = el[q]; i0 = q; }
            int i1 = -1; float v1 = -INFINITY;
#pragma unroll
            for (int q = 0; q < 8; ++q) if (q != i0 && el[q] > v1) { v1 = el[q]; i1 = q; }
            const float e1 = __expf(v1 - v0), den = 1.f + e1, w0 = grp_gate / den, w1 = grp_gate * e1 / den;
            const int lo = i0 < i1 ? i0 : i1, hi = i0 < i1 ? i1 : i0; cls = grp_i * 28 + lo * 8 - (lo * (lo + 1)) / 2 + (hi - lo - 1);
            wlo = i0 < i1 ? w0 : w1; whi = i0 < i1 ? w1 : w0;
            lrank = __hip_atomic_fetch_add(HIST + cls, 1u, __ATOMIC_RELAXED, __HIP_MEMORY_SCOPE_WORKGROUP);
        }
        __syncthreads();
        if (tid < 112) { const unsigned n = HIST[tid]; if (n) HIST[112 + tid] = __hip_atomic_fetch_add(cnt + tid * MOE_CS, n, __ATOMIC_RELAXED, __HIP_MEMORY_SCOPE_AGENT); }
        __syncthreads();
        if (tid < 128) {
            const unsigned rank = HIST[112 + cls] + lrank;
            const int row = grp * 128 + tid;
            ((u32x4*)(ws + WS_REC))[(size_t)cls * 32768 + rank] = (u32x4){(unsigned)row, __float_as_uint(wlo), __float_as_uint(whi), __float_as_uint(rstd)};
        }
        __syncthreads();
    }
}
typedef float f32x8 __attribute__((ext_vector_type(8)));
__device__ __forceinline__ void P_route2(int l_, int cbank) { const KP p = (KP)__builtin_amdgcn_kernarg_segment_ptr(); int l = l_; asm volatile("" : "+s"(l));
    int tid_ = threadIdx.x; asm volatile("" : "+v"(tid_));
    const int tid = tid_, lane = tid & 63, wave = __builtin_amdgcn_readfirstlane(tid >> 6);
    unsigned char* ws = p->ws; asm volatile("" : "+s"(ws)); const float* x = p->out;
    const float* WR = (const float*)(ws + WS_WR) + (size_t)l * D_ * 40;
    LAS float* xt = (LAS float*)lds_raw + wave * (64 * 36);
    LAS float* part = (LAS float*)lds_raw;
    const float* bgrp = p->in[16] + l * 4; const float* bexp = p->in[18] + l * 32;
    unsigned* cnt = (unsigned*)(ws + WS_CTL) + CW_MOECNT + l * 128 + cbank;
    for (int grp = launder_s((int)blockIdx.x); grp < NT / 128; grp += (int)gridDim.x) {
        const int row0 = grp * 128 + (wave >> 2) * 64, kq = wave & 3;
        float acc[40]; float ss = 0.f;
#pragma unroll
        for (int cidx = 0; cidx < 40; ++cidx) acc[cidx] = 0.f;
#pragma unroll 1
        for (int kc = 0; kc < 8; ++kc) {
            const int k0 = kq * 256 + kc * 32;
#pragma unroll
            for (int i = 0; i < 8; ++i) { const int row = i * 8 + (lane >> 3), c4 = (lane & 7) * 4; *(LAS f32x4*)(xt + row * 36 + c4) = *(const f32x4*)(x + (size_t)(row0 + row) * D_ + k0 + c4); }
            float xr[32];
#pragma unroll
            for (int j = 0; j < 8; ++j) { const f32x4 t = *(const LAS f32x4*)(xt + lane * 36 + 4 * j); xr[4 * j] = t.x; xr[4 * j + 1] = t.y; xr[4 * j + 2] = t.z; xr[4 * j + 3] = t.w; }
            const float* wk = WR + (size_t)k0 * 40;
#pragma unroll
            for (int kk = 0; kk < 32; ++kk) {
                f32x8 w0, w1, w2, w3, w4;
                asm volatile("s_load_dwordx8 %0, %5, %6\n\ts_load_dwordx8 %1, %5, %7\n\ts_load_dwordx8 %2, %5, %8\n\ts_load_dwordx8 %3, %5, %9\n\ts_load_dwordx8 %4, %5, %10\n\ts_waitcnt lgkmcnt(0)"
                             : "=&s"(w0), "=&s"(w1), "=&s"(w2), "=&s"(w3), "=&s"(w4) : "s"(wk), "i"(kk * 160), "i"(kk * 160 + 32), "i"(kk * 160 + 64), "i"(kk * 160 + 96), "i"(kk * 160 + 128) : "memory");
                const float xv = xr[kk]; ss = fmaf(xv, xv, ss);
#pragma unroll
                for (int e = 0; e < 8; ++e) { acc[e] = fmaf(xv, w0[e], acc[e]); acc[8 + e] = fmaf(xv, w1[e], acc[8 + e]); acc[16 + e] = fmaf(xv, w2[e], acc[16 + e]); acc[24 + e] = fmaf(xv, w3[e], acc[24 + e]); }
#pragma unroll
                for (int e = 0; e < 4; ++e) acc[32 + e] = fmaf(xv, w4[e], acc[32 + e]);
            }
        }
        __syncthreads();
#pragma unroll
        for (int cidx = 0; cidx < 36; ++cidx) part[(wave * 64 + lane) * 37 + cidx] = acc[cidx];
        part[(wave * 64 + lane) * 37 + 36] = ss;
        __syncthreads();
        if (tid < 128) {
            const int rg = tid >> 6, rr = tid & 63; float lg[37];
#pragma unroll
            for (int cidx = 0; cidx < 37; ++cidx) lg[cidx] = ((part[((rg * 4 + 0) * 64 + rr) * 37 + cidx] + part[((rg * 4 + 1) * 64 + rr) * 37 + cidx]) + part[((rg * 4 + 2) * 64 + rr) * 37 + cidx]) + part[((rg * 4 + 3) * 64 + rr) * 37 + cidx];
            const float rstd = rsqrtf(lg[36] * (1.f / D_) + EPS);
            float gl[4]; int grp_i = 0;
#pragma unroll
            for (int q = 0; q < 4; ++q) gl[q] = lg[q] * rstd + bgrp[q];
            float gm = gl[0];
#pragma unroll
            for (int q = 1; q < 4; ++q) if (gl[q] > gm) { gm = gl[q]; grp_i = q; }
            float gs = 0.f;
#pragma unroll
            for (int q = 0; q < 4; ++q) gs += __expf(gl[q] - gm);
            const float grp_gate = 1.f / gs;
            float el[8];
#pragma unroll
            for (int q = 0; q < 8; ++q) { float v = lg[4 + q]; float bb = bexp[q];
                if (grp_i == 1) { v = lg[12 + q]; bb = bexp[8 + q]; } else if (grp_i == 2) { v = lg[20 + q]; bb = bexp[16 + q]; } else if (grp_i == 3) { v = lg[28 + q]; bb = bexp[24 + q]; }
                el[q] = v * rstd + bb; }
            int i0 = 0; float v0 = el[0];
#pragma unroll
            for (int q = 1; q < 8; ++q) if (el[q] > v0) { v0 = el[q]; i0 = q; }
            int i1 = -1; float v1 = -INFINITY;
#pragma unroll
            for (int q = 0; q < 8; ++q) if (q != i0 && el[q] > v1) { v1 = el[q]; i1 = q; }
            const float e1 = __expf(v1 - v0), den = 1.f + e1, w0 = grp_gate / den, w1 = grp_gate * e1 / den;
            const int lo = i0 < i1 ? i0 : i1, hi = i0 < i1 ? i1 : i0, cls = grp_i * 28 + lo * 8 - (lo * (lo + 1)) / 2 + (hi - lo - 1);
            const unsigned rank = __hip_atomic_fetch_add(cnt + cls, 1u, __ATOMIC_RELAXED, __HIP_MEMORY_SCOPE_AGENT);
            const int row = grp * 128 + tid;
            ((unsigned*)(ws + WS_ROUTE + RT_INFO))[row] = ((unsigned)cls << 24) | rank;
            ((float*)(ws + WS_ROUTE + RT_W))[2 * row] = i0 < i1 ? w0 : w1; ((float*)(ws + WS_ROUTE + RT_W))[2 * row + 1] = i0 < i1 ? w1 : w0;
            ((float*)(ws + WS_ROUTE + RT_RSTD))[row] = rstd;
        }
        __syncthreads();
    }
}
__device__ __noinline__ void P_route(KP p_, int l_) { const KP p = uni_kp(p_); const int l = __builtin_amdgcn_readfirstlane(l_); const Ctx c = make_ctx(p); const Bufs b = make_bufs(p->ws);
    ph_moe_route(c, p->out, p->in[14] + (size_t)l * D_, p->in[15] + (size_t)l * D_ * 4, p->in[16] + l * 4, p->in[17] + (size_t)l * D_ * 32, p->in[18] + l * 32, b.HN, (int*)(p->ws + WS_ROUTE + RT_INFO), (float*)(p->ws + WS_ROUTE + RT_W), (unsigned*)(p->ws + WS_CTL) + CW_MOECNT + l * 128); }
__device__ __noinline__ void P_moe(KP p_, int l_) { const KP p = uni_kp(p_); const int l = __builtin_amdgcn_readfirstlane(l_); const Ctx c = make_ctx(p); const Bufs b = make_bufs(p->ws);
    ph_moe_naive(c, b.HN, b.ROUTE_E, b.ROUTE_W, p->in[19] + (size_t)l * NEXP * D_ * DEXP, p->in[20] + (size_t)l * NEXP * D_ * DEXP, p->in[21] + (size_t)l * NEXP * DEXP * D_, p->out); }
__device__ __noinline__ void P_final(KP p_) { const KP p = uni_kp(p_); const Ctx c = make_ctx(p); ph_norm_final_from_bf16(c, (const bf16*)(p->ws + WS_HN), p->in[22], p->out); }
__device__ __forceinline__ void P_gridbar(KP p_) { const KP p = uni_kp(p_);
    XcdBarrier bar; bar.bar = (unsigned*)(p->ws + WS_CTL) + 4096; bar.x = xb_xcc_id(); bar.st = (volatile LAS unsigned*)((LAS unsigned char*)lds_raw + MISC_OFF) + 8;
    xcd_barrier(bar);
}

__global__ void __launch_bounds__(NTHREADS, 2) fwd_kernel(Params pp) {
    const KP p = (KP)__builtin_amdgcn_kernarg_segment_ptr();
    { volatile LAS unsigned* MISC = (volatile LAS unsigned*)((LAS unsigned char*)lds_raw + MISC_OFF); if (threadIdx.x < 32) MISC[threadIdx.x] = 0u; }
    __syncthreads();
    const int lo = p->ph_lo, hi = p->ph_hi;
    if (hi - lo > 1) (void)xcd_barrier_post((unsigned*)(p->ws + WS_CTL) + 4096, (volatile LAS unsigned*)((LAS unsigned char*)lds_raw + MISC_OFF) + 8);
#define IN(k) (lo <= (k) && (k) < hi)
#define SEAM(k) do { if (IN(k) && IN((k) + 1)) P_gridbar(p); } while (0)
    if (IN(0)) { for (int rep = 0; rep < REP_PRO; ++rep) { if (rep) P_gridbar(p); P_prologue(p); } }
    SEAM(0);
    for (int l = 0; l < L_; ++l) {
        const int P0 = 1 + l * PH_PER_LAYER;
        if (IN(P0 + 0)) { for (int rep = 0; rep < REP_NORM; ++rep) { if (rep) P_gridbar(p); P_norm1(p, l); } }
        SEAM(P0 + 0);
        if (IN(P0 + 1)) { for (int rep = 0; rep < REP_INPROJ; ++rep) { if (rep) P_gridbar(p); P_inproj_mfma(l); }
#ifdef REP_INDUMMY
            for (int rep = 0; rep < REP_INDUMMY; ++rep) { P_gridbar(p); P_inproj_dummy(l); }
#endif
        }
        SEAM(P0 + 1);
        if (IN(P0 + 3)) {
            P_cmp1_mfma(l);
            if (launder_s((int)blockIdx.x) < 32) { asm volatile("s_waitcnt vmcnt(0)" ::: "memory"); __builtin_amdgcn_fence(__ATOMIC_SEQ_CST, "agent"); asm volatile("s_waitcnt vmcnt(0)" ::: "memory"); }
            __syncthreads();
            P_cmp2_mfma(l);
            for (int rep = 0; rep < REP_ATT3; ++rep) { if (rep) P_gridbar(p);
            for (;;) { int u = fetch_unit(p, l * 8 + 0 + 16 * rep);
                if (l == 0) {
                    if (u >= 2048 + CONV_UNITS) break;
                    const int k11 = u / 11, r11 = u - 11 * k11;
                    if (r11 == 3 || r11 == 7 || r11 == 10) { U_conv(p, 3 * k11 + (r11 > 3) + (r11 > 7)); continue; }
                    u = 8 * k11 + r11 - (r11 > 3) - (r11 > 7); }
                else if (u >= 2048) break;
                if (u < 1024) { const int qb = 15 - (u >> 6), k = u & 63; if (k < 32) U_diff(p, k, qb, l); else U_fox(p, k - 32, qb, l); }
                else { const int w = u - 1024; U_win(p, w & 15, 63 - (w >> 4));
#ifdef PROBE_WINUNIT2
                    U_win(p, w & 15, 63 - (w >> 4));
#endif
                } } } }
        SEAM(P0 + 3);
        if (IN(P0 + 4)) { for (int rep = 0; rep < REP_CMP; ++rep) { if (rep) P_gridbar(p); for (int u = launder_s((int)blockIdx.x); u < 256; u += (int)gridDim.x) U_cmp(p, u & 15, u >> 4); } }
        SEAM(P0 + 4);
        if (IN(P0 + 5)) { for (int rep = 0; rep < REP_SLC; ++rep) { if (rep) P_gridbar(p); for (;;) { const int u = fetch_unit(p, l * 8 + 1 + 16 * rep); if (u >= 1024) break; U_slc(p, u & 15, 63 - (u >> 4)); } } }
        SEAM(P0 + 5);
        if (IN(P0 + 6)) P_outproj_mfma(l);
        SEAM(P0 + 6);
        if (IN(P0 + 7)) { for (int rep = 0; rep < REP_ROUTE; ++rep) { if (rep) P_gridbar(p); P_route3(l, REP_ROUTE - 1 - rep); } }
        SEAM(P0 + 7);
        if (IN(P0 + 9)) { for (int rep = 0; rep < REP_G1; ++rep) { if (rep) P_gridbar(p); P_moe_g1(l); } }
        SEAM(P0 + 9);
        if (IN(P0 + 10)) P_moe_g2(l);
        SEAM(P0 + 10);
    }
    if (IN(1 + L_ * PH_PER_LAYER)) P_final(p);
#undef IN
#undef SEAM
}

extern "C" void kernel_launch(void* const* d_in, const int* in_sizes, int n_in, void* d_out, int out_size, void* d_ws, size_t ws_size, hipStream_t stream) {
    static int grid = 0;
    if (grid == 0) {
        if (n_in != 23 || out_size != NT * D_ || ws_size < WS_END) { fprintf(stderr, "kernel_launch: unexpected sizes n_in %d out %d ws %zu (need %zu)\n", n_in, out_size, ws_size, (size_t)WS_END); grid = -1; return; }
        int dev = 0, cus = 0, per_cu = 0;
        if (hipGetDevice(&dev) != hipSuccess || hipDeviceGetAttribute(&cus, hipDeviceAttributeMultiprocessorCount, dev) != hipSuccess) { grid = -1; return; }
        if (hipFuncSetAttribute((const void*)fwd_kernel, hipFuncAttributeMaxDynamicSharedMemorySize, LDS_BYTES) != hipSuccess) { fprintf(stderr, "kernel_launch: hipFuncSetAttribute failed\n"); grid = -1; return; }
        if (hipOccupancyMaxActiveBlocksPerMultiprocessor(&per_cu, (const void*)fwd_kernel, NTHREADS, LDS_BYTES) != hipSuccess || per_cu < 1) { fprintf(stderr, "kernel_launch: occupancy query says %d\n", per_cu); }
        (void)hipGetLastError();
        grid = cus;
    }
    if (grid < 0) return;
    (void)hipMemsetAsync((char*)d_ws + WS_CTL, 0, CTL_BYTES, stream);
    Params p{};
    for (int i = 0; i < 23; ++i) p.in[i] = (const float*)d_in[i];
    p.out = (float*)d_out; p.ws = (unsigned char*)d_ws;
#if N_LAUNCH_MODE == 0
    p.ph_lo = 0; p.ph_hi = N_PHASES;
    hipLaunchKernelGGL(fwd_kernel, dim3(grid), dim3(NTHREADS), LDS_BYTES, stream, p);
#else
    for (int k = 0; k < N_PHASES; ++k) { p.ph_lo = k; p.ph_hi = k + 1; hipLaunchKernelGGL(fwd_kernel, dim3(grid), dim3(NTHREADS), LDS_BYTES, stream, p); }
#endif
}
```

```cpp
#include <hip/hip_runtime.h>
#include <cstdio>
#include <cstdint>

#ifndef INPROJ_ALIGN
#define INPROJ_ALIGN true
#endif
#ifndef INPROJ_SP2
#define INPROJ_SP2 true
#endif
#ifndef REP_PRO
#define REP_PRO 1
#endif
#ifndef REP_ROUTE
#define REP_ROUTE 1
#endif
#ifndef REP_NORM
#define REP_NORM 1
#endif
#ifndef REP_INPROJ
#define REP_INPROJ 1
#endif
#ifndef REP_ATT3
#define REP_ATT3 1
#endif
#ifndef REP_CMP
#define REP_CMP 1
#endif
#ifndef REP_SLC
#define REP_SLC 1
#endif
#ifndef REP_SCAT
#define REP_SCAT 1
#endif
#ifndef REP_G1
#define REP_G1 1
#endif
#ifndef N_LAUNCH_MODE
#define N_LAUNCH_MODE 0
#endif

#define LAS __attribute__((address_space(3)))
#define GAS __attribute__((address_space(1)))
typedef unsigned short bf16;
typedef unsigned long long u64;
typedef float f32x4 __attribute__((ext_vector_type(4)));
typedef unsigned u32x4 __attribute__((ext_vector_type(4)));

constexpr int B_ = 8, T_ = 4096, D_ = 1024, NT = B_ * T_, L_ = 2;
constexpr int HD = 64, D_IN = 2844;
constexpr int N_CMP = 255, CMP_HID = 256;
constexpr int NEXP = 32, DEXP = 256;
constexpr float EPS = 1e-6f;
constexpr float LOG2E = 1.4426950408889634f;
constexpr int NWAVES = 8, NTHREADS = 512;

constexpr int C_NSAQ = 0, C_KV6 = 512, C_GATE = 1280, C_FQ = 1304, C_FF = 2072, C_DQ = 2076, C_DV = 2588;

constexpr size_t MiB = 1u << 20;
constexpr size_t WS_CTL = 0, CTL_BYTES = 1 * MiB;
constexpr size_t WS_QN = 1 * MiB;
constexpr size_t WS_KV6 = WS_QN + 32 * MiB;
constexpr size_t KV6_STRIDE = 8 * MiB + 64 * 1024;
constexpr size_t WS_FQKV = WS_KV6 + 6 * KV6_STRIDE;
constexpr size_t WS_DQK = WS_FQKV + 48 * MiB;
constexpr size_t WS_DV = WS_DQK + 32 * MiB;
constexpr size_t WS_GATE = WS_DV + 16 * MiB;
constexpr size_t WS_FL = WS_GATE + 3 * MiB;
constexpr size_t WS_HC = WS_FL + 1 * MiB;
constexpr size_t WS_KVCMP = WS_HC + 4 * MiB;
constexpr size_t WS_SEL = WS_KVCMP + 1 * MiB;
constexpr size_t WS_OCMP = WS_SEL + 1 * MiB;
constexpr size_t WS_OWIN = WS_OCMP + 32 * MiB;
constexpr size_t WS_HN = WS_OWIN + 32 * MiB;
constexpr size_t WS_ATT = WS_HN + 64 * MiB;
constexpr size_t WS_ROUTE = WS_ATT + 64 * MiB;
constexpr size_t WS_WIN_T = WS_ROUTE + 2 * MiB;
constexpr size_t WS_WOUT_T = WS_WIN_T + 12 * MiB;
constexpr size_t WS_WGU_T = WS_WOUT_T + 4 * MiB;
constexpr size_t WS_WD_T = WS_WGU_T + 64 * MiB;
constexpr size_t WS_W1_T = WS_WD_T + 32 * MiB;
constexpr size_t WS_W2_T = WS_W1_T + 4 * MiB;
constexpr size_t WS_BIAS1 = WS_W2_T + 512 * 1024;
constexpr size_t WS_WR = WS_BIAS1 + 512 * 1024;
constexpr size_t WS_B1PART = WS_WR + 512 * 1024;
constexpr size_t WS_END = WS_B1PART + 512 * 1024;
constexpr int MOE_MAXROWS = 61440;
constexpr size_t WS_XS = WS_QN;
constexpr size_t WS_HB = WS_OCMP;
static_assert(WS_XS + (size_t)MOE_MAXROWS * 2048 <= WS_DQK && WS_HB + (size_t)MOE_MAXROWS * 1024 <= WS_HN, "MoE aliases");
constexpr size_t RT_INFO = 0, RT_W = 128 * 1024, RT_ROWTOK = 384 * 1024, RT_ROWW = 640 * 1024, RT_RSTD = 1152 * 1024;
constexpr int CW_QUEUE = 16384, CW_MOECNT = 32768, CW_KN = 49152, MOE_CS = 32, MOE_LS = 4096;
constexpr size_t WS_REC = WS_QN;
constexpr unsigned ZROW_OFF = 512 * 1024;
static_assert(WS_REC + (size_t)112 * 32768 * 16 <= WS_DQK && WS_HN + (size_t)NT * 2048 < (1ull << 32), "MoE record table / 32-bit row offsets");
constexpr int TBL_OFF = 131072 + 1024;
constexpr int NIN = 3072;

extern __shared__ __attribute__((aligned(16))) unsigned char lds_raw[];
__device__ __forceinline__ float bf2f(bf16 v) { return __uint_as_float(((unsigned)v) << 16); }
__device__ __forceinline__ unsigned f2bf(float f) { unsigned u = __float_as_uint(f); return (u + 0x7fffu + ((u >> 16) & 1u)) >> 16; }
__device__ __forceinline__ unsigned pk2(float lo, float hi) { return f2bf(lo) | (f2bf(hi) << 16); }
__device__ __forceinline__ float wave_sum(float v) {
#pragma unroll
    for (int o = 1; o < 64; o <<= 1) v += __shfl_xor(v, o);
    return v;
}
__device__ __forceinline__ float wave_max(float v) {
#pragma unroll
    for (int o = 1; o < 64; o <<= 1) v = fmaxf(v, __shfl_xor(v, o));
    return v;
}
__device__ __forceinline__ float shflx_f(float v, int o, int lane) { return __uint_as_float((unsigned)__builtin_amdgcn_ds_bpermute((lane ^ o) << 2, (int)__float_as_uint(v))); }
__device__ __forceinline__ unsigned shflx_u(unsigned v, int o, int lane) { return (unsigned)__builtin_amdgcn_ds_bpermute((lane ^ o) << 2, (int)v); }
__device__ __forceinline__ float wave_sum_l(float v, int lane) {
#pragma unroll
    for (int o = 1; o < 64; o <<= 1) v += shflx_f(v, o, lane);
    return v;
}
__device__ __forceinline__ int launder_s(int v) { asm volatile("" : "+s"(v)); return v; }
__device__ __forceinline__ float sigmoidf_(float x) { return 1.f / (1.f + __expf(-x)); }
__device__ __forceinline__ float log_sigmoidf_(float x) { return x >= 0.f ? -log1pf(__expf(-x)) : x - log1pf(__expf(x)); }
__device__ __forceinline__ float gelu_tanh(float x) { const float u = 0.7978845608028654f * (x + 0.044715f * x * x * x); return 0.5f * x * (1.f + tanhf(u)); }
__device__ __forceinline__ float alibi_slope(int idx1, int n) { return exp2f(-8.0f * (float)idx1 / (float)n); }

__device__ __forceinline__ constexpr int b64_off(int t, int d) { return ((t >> 4) * 2 + (d >> 5)) * 512 + (t & 15) * 32 + (d & 31); }
#define XB_TMO      128
#define XB_XCNT(j)  (256  + 64 * (j))
#define XB_XSUB(j)  (1280 + 64 * (j))
#define XB_XGEN(j)  (2304 + 64 * (j))
#define XB_TOP      3328
#define XB_TOPGEN   3392
#define XCD_BAR_WORDS 3456
#define XB_SPIN_CAP (1u << 25)
__device__ __forceinline__ unsigned xb_ld(unsigned* p)              { return __hip_atomic_load(p, __ATOMIC_RELAXED, __HIP_MEMORY_SCOPE_AGENT); }
__device__ __forceinline__ unsigned xb_add(unsigned* p, unsigned v) { return __hip_atomic_fetch_add(p, v, __ATOMIC_RELAXED, __HIP_MEMORY_SCOPE_AGENT); }
__device__ __forceinline__ unsigned xb_xcc_id() { return (unsigned)__builtin_amdgcn_s_getreg((3 << 11) | 20) & 0xFu; }
#define XB_SPIN(cond, bar) do { unsigned _sp = 0; while (cond) { __builtin_amdgcn_s_sleep(1); \
    if ((++_sp & 255u) == 0u) { if (xb_ld(&(bar)[XB_TMO])) break; if (_sp > XB_SPIN_CAP) { atomicAdd(&(bar)[XB_TMO], 1u); break; } } } } while (0)
struct XcdBarrier { unsigned* bar; unsigned x; volatile LAS unsigned* st; };
__device__ __forceinline__ XcdBarrier xcd_barrier_post(unsigned* bar, volatile LAS unsigned* st) {
    XcdBarrier b; b.bar = bar; b.x = xb_xcc_id(); b.st = st;
    if (threadIdx.x == 0) (void)xb_add(&bar[XB_XCNT(b.x)], 1u);
    return b;
}
__device__ __forceinline__ void xcd_barrier_complete(unsigned* bar, unsigned x, unsigned& nloc, unsigned& nx) {
    const unsigned G = gridDim.x * gridDim.y * gridDim.z;
    unsigned sum, cnt, mine, sp = 0u;
    for (;;) {
        sum = 0u; cnt = 0u; mine = 0u;
#pragma unroll
        for (unsigned j = 0; j < 16; ++j) { const unsigned c = xb_ld(&bar[XB_XCNT(j)]); sum += c; cnt += (c > 0u) ? 1u : 0u; mine = (j == x) ? c : mine; }
        if (sum == G) break;
        __builtin_amdgcn_s_sleep(1);
        if ((++sp & 255u) == 0u) { if (xb_ld(&bar[XB_TMO])) break; if (sp > XB_SPIN_CAP) { atomicAdd(&bar[XB_TMO], 1u); break; } }
    }
    nloc = mine > 0u ? mine : 1u; nx = cnt > 0u ? cnt : 1u;
}
__device__ __forceinline__ void xcd_barrier(const XcdBarrier& b) {
    asm volatile("s_waitcnt vmcnt(0)" ::: "memory");
    __syncthreads();
    if (threadIdx.x == 0) {
        unsigned* bar = b.bar;
        __builtin_amdgcn_s_waitcnt(0);
        unsigned nloc = b.st[0], nx = b.st[1];
        if (nloc == 0u) { xcd_barrier_complete(bar, b.x, nloc, nx); b.st[0] = nloc; b.st[1] = nx; }
        const unsigned old = xb_add(&bar[XB_XSUB(b.x)], 1u);
        const unsigned gen = old / nloc;
        if (old + 1u == (gen + 1u) * nloc) {
            __builtin_amdgcn_fence(__ATOMIC_RELEASE, "agent");
            asm volatile("s_waitcnt vmcnt(0)" ::: "memory");
            const unsigned og = xb_add(&bar[XB_TOP], 1u);
            const unsigned tg = og / nx;
            if (og + 1u == (tg + 1u) * nx) xb_add(&bar[XB_TOPGEN], 1u);
            else XB_SPIN(xb_ld(&bar[XB_TOPGEN]) == tg, bar);
            __builtin_amdgcn_fence(__ATOMIC_ACQUIRE, "agent");
            xb_add(&bar[XB_XGEN(b.x)], 1u);
            asm volatile("s_waitcnt vmcnt(0)" ::: "memory");
        } else {
            XB_SPIN(xb_ld(&bar[XB_XGEN(b.x)]) == gen, bar);
            __builtin_amdgcn_fence(__ATOMIC_ACQUIRE, "agent");
            asm volatile("s_waitcnt vmcnt(0)" ::: "memory");
        }
    }
    __syncthreads();
}

struct Params { const float* in[23]; float* out; unsigned char* ws; int ph_lo, ph_hi; };
constexpr int LDS_BYTES = 147456;
constexpr int MISC_OFF = 131072 + 320;

struct Ctx {
    LAS unsigned char* lds; int tid, lane, wave, bid, G, gw, ngw;
    const float* const* in; float* xcur; unsigned char* ws;
};

namespace pg8 {
#define PG8_LAS __attribute__((address_space(3)))
typedef unsigned short bf16_t;
typedef short bf16x8 __attribute__((ext_vector_type(8)));
typedef float f32x4 __attribute__((ext_vector_type(4)));
typedef unsigned u32x4 __attribute__((ext_vector_type(4)));
constexpr int BM = 256, BK = 64, HALF = 128, HTB = HALF * BK * 2  , STAGE_BYTES = 8 * HTB, NXCD = 8, WGM = 8;

__host__ __device__ __forceinline__ int lds_byte(int r, int c) { const int st = (r >> 4) * 2 + (c >> 5), rr = r & 15, cc = c & 31, ob = rr * 64 + cc * 2; return st * 1024 + (ob ^ (((ob >> 9) & 1) << 5)); }
__host__ __device__ __forceinline__ void stage_rc(int b, int& R, int& C) { const int st = b / 1024, sb = b % 1024, swz = sb ^ (((sb >> 9) & 1) << 5); R = (st >> 1) * 16 + swz / 64; C = (st & 1) * 32 + (swz % 64) / 2; }
__host__ __device__ __forceinline__ int perm32(int rho) { const int n = rho >> 4, i = rho & 15; return 8 * (i >> 2) + 4 * n + (i & 3); }

struct Unit { int pm, pn; const char* a; const char* b; const char* b2; };
struct Gemm { int lda, ldb, K, ksplit, arb, acb; };

__device__ __forceinline__ unsigned cvt_pk_bf16(float lo, float hi) { unsigned r; asm volatile("v_cvt_pk_bf16_f32 %0, %1, %2" : "=v"(r) : "v"(lo), "v"(hi)); return r; }
typedef float f32x2 __attribute__((ext_vector_type(2)));

template <class Epi, class Sched, bool ALIGN_EPI = false, bool SP2 = false, bool GATHER = false>
__device__ __forceinline__ void gemm_phase(PG8_LAS unsigned char* lds, const Gemm g, const Sched& S, const Epi& E) {
    static_assert(!GATHER || SP2, "GATHER is written for the SP2 loop");
    int tid_ = threadIdx.x; asm volatile("" : "+v"(tid_));
    const int tid = tid_, wid = __builtin_amdgcn_readfirstlane(tid >> 6), lane = tid & 63, wr = wid >> 2, wc = wid & 3, fr = lane & 15, fq = lane >> 4;
    const int K = g.K, nt = K / BK, ks = g.ksplit;
    unsigned voffA[2], voffB[2];
#pragma unroll
    for (int i = 0; i < 2; ++i) { int R, C; stage_rc(tid * 16 + i * 8192, R, C); const int Rb = Epi::PERM ? ((R & ~31) + perm32(R & 31)) : R;
        voffA[i] = g.arb ? (unsigned)(((R / g.arb) * (K / g.acb) + C / g.acb) * (g.arb * g.acb) + (R % g.arb) * g.acb + (C % g.acb)) * 2u : (unsigned)(R * g.lda + C) * 2u; voffB[i] = (unsigned)(Rb * g.ldb + C) * 2u; }
    const size_t kstep = (size_t)(BK * 2), kstepA = g.arb ? (size_t)(BK * g.arb * 2) : kstep;
    const size_t hsA = (size_t)HALF * (g.arb ? K : g.lda) * 2, hsB = (size_t)HALF * g.ldb * 2;
    const unsigned ldsw = (unsigned)wid * 1024u;
    const int aoff = lds_byte(wr * 64 + fr, fq * 8), boff = lds_byte(wc * 32 + fr, fq * 8);
#define PG8_SA(b, h) (((b) * 2 + (h)) * HTB)
#define PG8_SB(b, h) ((4 + (b) * 2 + (h)) * HTB)
#define PG8_STAGE(bufoff, gbase, voff) do { _Pragma("unroll") for (int _i = 0; _i < 2; ++_i) \
        __builtin_amdgcn_global_load_lds((const unsigned*)((const char*)(gbase) + (voff)[_i]), (PG8_LAS unsigned*)(lds + (bufoff) + ldsw + _i * 8192), 16, 0, 0); } while (0)
#define PG8_LDA(dst, b, h) do { _Pragma("unroll") for (int m = 0; m < 4; ++m) _Pragma("unroll") for (int k = 0; k < 2; ++k) dst[m][k] = *(const PG8_LAS bf16x8*)(lds + PG8_SA(b, h) + aoff + m * 2048 + k * 1024); } while (0)
#define PG8_LDB(dst, b, h) do { _Pragma("unroll") for (int n = 0; n < 2; ++n) _Pragma("unroll") for (int k = 0; k < 2; ++k) dst[n][k] = *(const PG8_LAS bf16x8*)(lds + PG8_SB(b, h) + boff + n * 2048 + k * 1024); } while (0)
#define PG8_MMA(ai, bj, At, Bt) do { __builtin_amdgcn_s_setprio(1); _Pragma("unroll") for (int m = 0; m < 4; ++m) _Pragma("unroll") for (int n = 0; n < 2; ++n) _Pragma("unroll") for (int k = 0; k < 2; ++k) \
        acc[ai][bj][m][n] = __builtin_amdgcn_mfma_f32_16x16x32_bf16(Bt[n][k], At[m][k], acc[ai][bj][m][n], 0, 0, 0); __builtin_amdgcn_s_setprio(0); } while (0)
#define PG8_WAIT_V(n) asm volatile("s_waitcnt vmcnt(" #n ")" ::: "memory")
#define PG8_WAIT_L(n) asm volatile("s_waitcnt lgkmcnt(" #n ")" ::: "memory")
#define PG8_BAR __builtin_amdgcn_s_barrier()
#define PG8_SCHED __builtin_amdgcn_sched_barrier(0)
    Unit cur, nxt; int ui = 0;
    if (!S.next(0, cur)) return;
    unsigned gC[2][2] = {{0u, 0u}, {0u, 0u}}, gN[2][2] = {{0u, 0u}, {0u, 0u}}; const char* gbase = nullptr;
#define PG8_GOFFS(U, Gv) do { _Pragma("unroll") for (int _h = 0; _h < 2; ++_h) _Pragma("unroll") for (int _i = 0; _i < 2; ++_i) { int R_, C_; stage_rc(tid * 16 + _i * 8192, R_, C_); Gv[_h][_i] = S.arow(U, _h * HALF + R_) + (unsigned)C_ * 2u; } } while (0)
#define PG8_STAGE_G(bufoff, kbyte, Gv, h) do { _Pragma("unroll") for (int _i = 0; _i < 2; ++_i) \
        __builtin_amdgcn_global_load_lds((const unsigned*)(gbase + (size_t)(kbyte) + Gv[h][_i]), (PG8_LAS unsigned*)(lds + (bufoff) + ldsw + _i * 8192), 16, 0, 0); } while (0)
    if constexpr (GATHER) { gbase = S.abase(); PG8_GOFFS(cur, gC); }
    f32x4 acc[2][2][4][2];
#pragma unroll
    for (int a = 0; a < 2; ++a)
#pragma unroll
        for (int b = 0; b < 2; ++b)
#pragma unroll
            for (int m = 0; m < 4; ++m)
#pragma unroll
                for (int n = 0; n < 2; ++n) acc[a][b][m][n] = (f32x4){0.f, 0.f, 0.f, 0.f};
    bf16x8 At[4][2], B0[2][2], B1[2][2];
    const char* cA = cur.a; const char* cB = cur.b; const char* cB2 = cur.b2;
#define PG8_BK(base, base2, kt) ((kt) < ks ? (base) + (size_t)(kt) * kstep : (base2) + (size_t)((kt) - ks) * kstep)
    S.a_ready(cur);
    if constexpr (SP2) {
        PG8_STAGE(PG8_SB(0, 0), cB, voffB); PG8_STAGE(PG8_SB(0, 1), cB + hsB, voffB);
        if constexpr (GATHER) { PG8_STAGE_G(PG8_SA(0, 0), 0, gC, 0); PG8_STAGE_G(PG8_SA(0, 1), 0, gC, 1); } else { PG8_STAGE(PG8_SA(0, 0), cA, voffA); PG8_STAGE(PG8_SA(0, 1), cA + hsA, voffA); }
        if (wr == 1) PG8_BAR;
        PG8_WAIT_V(2); PG8_BAR;
        PG8_STAGE(PG8_SB(1, 0), PG8_BK(cB, cB2, 1), voffB);
        if constexpr (GATHER) PG8_STAGE_G(PG8_SA(1, 0), kstep, gC, 0); else PG8_STAGE(PG8_SA(1, 0), cA + kstepA, voffA);
        PG8_STAGE(PG8_SB(1, 1), PG8_BK(cB, cB2, 1) + hsB, voffB);
        PG8_WAIT_V(6); PG8_BAR;
    } else {
        PG8_STAGE(PG8_SB(0, 0), cB, voffB); PG8_STAGE(PG8_SA(0, 0), cA, voffA); PG8_STAGE(PG8_SB(0, 1), cB + hsB, voffB); PG8_STAGE(PG8_SA(0, 1), cA + hsA, voffA);
        if (wr == 1) PG8_BAR;
        PG8_WAIT_V(4); PG8_BAR;
        PG8_STAGE(PG8_SB(1, 0), PG8_BK(cB, cB2, 1), voffB); PG8_STAGE(PG8_SA(1, 0), cA + kstepA, voffA); PG8_STAGE(PG8_SB(1, 1), PG8_BK(cB, cB2, 1) + hsB, voffB);
        PG8_WAIT_V(6); PG8_BAR;
    }
    for (;;) {
        const bool has_next = S.next(ui + 1, nxt);
        if constexpr (GATHER) { if (has_next) PG8_GOFFS(nxt, gN); else { _Pragma("unroll") for (int _h = 0; _h < 2; ++_h) _Pragma("unroll") for (int _i = 0; _i < 2; ++_i) gN[_h][_i] = gC[_h][_i]; } }
        const char* nA = has_next ? nxt.a : cA; const char* nB = has_next ? nxt.b : cB; const char* nB2 = has_next ? nxt.b2 : cB2;
#pragma unroll 1
        for (int t = 0; t < nt; t += 2) {
            const bool last = (t == nt - 2);
            const char* a1 = cA + (size_t)(t + 1) * kstepA;
            const char* a2 = last ? nA : cA + (size_t)(t + 2) * kstepA; const char* b2 = last ? PG8_BK(nB, nB2, 0) : PG8_BK(cB, cB2, t + 2);
            const char* a3 = a2 + kstepA; const char* b3 = last ? PG8_BK(nB, nB2, 1) : PG8_BK(cB, cB2, t + 3);
            if (last && has_next) S.a_ready(nxt);
            if constexpr (SP2) {
            PG8_LDB(B0, 0, 0); PG8_LDB(B1, 0, 1); PG8_SCHED; PG8_LDA(At, 0, 0);
            if constexpr (GATHER) PG8_STAGE_G(PG8_SA(1, 1), (size_t)(t + 1) * kstep, gC, 1); else PG8_STAGE(PG8_SA(1, 1), a1 + hsA, voffA);
            PG8_WAIT_V(8); PG8_WAIT_L(0); PG8_BAR; PG8_MMA(0, 0, At, B0); PG8_MMA(0, 1, At, B1); PG8_BAR; PG8_SCHED;
            PG8_LDA(At, 0, 1); PG8_STAGE(PG8_SB(0, 0), b2, voffB); PG8_STAGE(PG8_SB(0, 1), b2 + hsB, voffB);
            if constexpr (GATHER) { if (last) PG8_STAGE_G(PG8_SA(0, 0), 0, gN, 0); else PG8_STAGE_G(PG8_SA(0, 0), (size_t)(t + 2) * kstep, gC, 0); } else PG8_STAGE(PG8_SA(0, 0), a2, voffA);
            PG8_WAIT_V(8); PG8_WAIT_L(0); PG8_BAR; PG8_MMA(1, 0, At, B0); PG8_MMA(1, 1, At, B1); PG8_BAR; PG8_SCHED;
            PG8_LDB(B0, 1, 0); PG8_LDB(B1, 1, 1); PG8_SCHED; PG8_LDA(At, 1, 0);
            if constexpr (GATHER) { if (last) PG8_STAGE_G(PG8_SA(0, 1), 0, gN, 1); else PG8_STAGE_G(PG8_SA(0, 1), (size_t)(t + 2) * kstep, gC, 1); } else PG8_STAGE(PG8_SA(0, 1), a2 + hsA, voffA);
            PG8_WAIT_V(8); PG8_WAIT_L(0); PG8_BAR; PG8_MMA(0, 0, At, B0); PG8_MMA(0, 1, At, B1); PG8_BAR; PG8_SCHED;
            PG8_LDA(At, 1, 1); PG8_STAGE(PG8_SB(1, 0), b3, voffB); PG8_STAGE(PG8_SB(1, 1), b3 + hsB, voffB);
            if constexpr (GATHER) { if (last) PG8_STAGE_G(PG8_SA(1, 0), kstep, gN, 0); else PG8_STAGE_G(PG8_SA(1, 0), (size_t)(t + 3) * kstep, gC, 0); } else PG8_STAGE(PG8_SA(1, 0), a3, voffA);
            PG8_WAIT_V(8); PG8_WAIT_L(0); PG8_BAR; PG8_MMA(1, 0, At, B0); PG8_MMA(1, 1, At, B1); PG8_BAR; PG8_SCHED;
            } else {
            PG8_LDB(B0, 0, 0); PG8_SCHED; PG8_LDA(At, 0, 0); PG8_STAGE(PG8_SA(1, 1), a1 + hsA, voffA);
            PG8_WAIT_L(8); PG8_BAR; PG8_WAIT_L(0); PG8_MMA(0, 0, At, B0); PG8_BAR; PG8_SCHED;
            PG8_LDB(B1, 0, 1); PG8_STAGE(PG8_SB(0, 0), b2, voffB);
            PG8_BAR; PG8_WAIT_L(0); PG8_MMA(0, 1, At, B1); PG8_BAR;
            PG8_LDA(At, 0, 1); PG8_STAGE(PG8_SA(0, 0), a2, voffA);
            PG8_BAR; PG8_WAIT_L(0); PG8_MMA(1, 0, At, B0); PG8_BAR; PG8_SCHED;
            PG8_STAGE(PG8_SB(0, 1), b2 + hsB, voffB);
            PG8_WAIT_V(6); PG8_BAR; PG8_MMA(1, 1, At, B1); PG8_BAR;
            PG8_LDB(B0, 1, 0); PG8_SCHED; PG8_LDA(At, 1, 0); PG8_STAGE(PG8_SA(0, 1), a2 + hsA, voffA);
            PG8_WAIT_L(8); PG8_BAR; PG8_WAIT_L(0); PG8_MMA(0, 0, At, B0); PG8_BAR; PG8_SCHED;
            PG8_LDB(B1, 1, 1); PG8_STAGE(PG8_SB(1, 0), b3, voffB);
            PG8_BAR; PG8_WAIT_L(0); PG8_MMA(0, 1, At, B1); PG8_BAR;
            PG8_LDA(At, 1, 1); PG8_STAGE(PG8_SA(1, 0), a3, voffA);
            PG8_BAR; PG8_WAIT_L(0); PG8_MMA(1, 0, At, B0); PG8_BAR; PG8_SCHED;
            PG8_STAGE(PG8_SB(1, 1), b3 + hsB, voffB);
            PG8_WAIT_V(6); PG8_BAR; PG8_MMA(1, 1, At, B1); PG8_BAR;
            }
        }
        if constexpr (ALIGN_EPI) { if (wr == 0) PG8_BAR; }
        if constexpr (!Epi::AFTER_DRAIN) { E(acc, cur, wr, wc, fr, fq); S.done(cur); }
        if (!has_next) break;
#pragma unroll
        for (int a = 0; a < 2; ++a)
#pragma unroll
            for (int b = 0; b < 2; ++b)
#pragma unroll
                for (int m = 0; m < 4; ++m)
#pragma unroll
                    for (int n = 0; n < 2; ++n) acc[a][b][m][n] = (f32x4){0.f, 0.f, 0.f, 0.f};
        cur = nxt; cA = nA; cB = nB; cB2 = nB2; ++ui;
        if constexpr (GATHER) { _Pragma("unroll") for (int _h = 0; _h < 2; ++_h) _Pragma("unroll") for (int _i = 0; _i < 2; ++_i) gC[_h][_i] = gN[_h][_i]; }
        if constexpr (ALIGN_EPI) { if (wr == 1) PG8_BAR; }
    }
    PG8_WAIT_V(0);
    if constexpr (!ALIGN_EPI) { if (wr == 0) PG8_BAR; }
    PG8_BAR;
    if constexpr (Epi::AFTER_DRAIN) { E.fused(acc, cur, wr, wc, fr, fq, lds, wid, lane); S.done(cur); }
#undef PG8_BK
#undef PG8_GOFFS
#undef PG8_STAGE_G
#undef PG8_SA
#undef PG8_SB
#undef PG8_STAGE
#undef PG8_LDA
#undef PG8_LDB
#undef PG8_MMA
#undef PG8_WAIT_V
#undef PG8_WAIT_L
#undef PG8_BAR
#undef PG8_SCHED
}
}

struct PlainOrder {
    const char* A; const char* Bt; int lda, ldb, nM, nN, nwg, G, c;
    __device__ __forceinline__ void init(const void* A_, const void* Bt_, int lda_, int ldb_, int M, int N, int G_, int c_) { A = (const char*)A_; Bt = (const char*)Bt_; lda = lda_; ldb = ldb_; nM = M / 256; nN = N / 256; nwg = nM * nN; G = G_; c = c_; }
    __device__ __forceinline__ bool next(int i, pg8::Unit& u) const {
        const long L = (long)i * G + c; if (L >= nwg) return false;
        int wgid = (int)L; { const int q = nwg / 8, r = nwg % 8, xcd = wgid % 8, off = wgid / 8; wgid = (xcd < r ? xcd * (q + 1) : r * (q + 1) + (xcd - r) * q) + off; }
        const int nig = 8 * nN, gid = wgid / nig, fm = gid * 8, gsz = (nM - fm) < 8 ? (nM - fm) : 8;
        u.pm = fm + ((wgid % nig) % gsz); u.pn = (wgid % nig) / gsz;
        u.a = A + (size_t)u.pm * 256 * lda * 2; u.b = Bt + (size_t)u.pn * 256 * ldb * 2; u.b2 = u.b; return true;
    }
    __device__ __forceinline__ void a_ready(const pg8::Unit&) const {}
    __device__ __forceinline__ void done(const pg8::Unit&) const {}
};
struct EpiInProj {
    static constexpr bool PERM = true, AFTER_DRAIN = false;
    unsigned char* ws; const float* b_gate; const float* b_fgt; unsigned* kn;
    __device__ __forceinline__ void operator()(const pg8::f32x4 (&acc)[2][2][4][2], const pg8::Unit& u, int wr, int wc, int fr, int fq) const {
        { int t_ = threadIdx.x; asm volatile("" : "+v"(t_)); fr = t_ & 15; fq = (t_ >> 4) & 3; }
        const int pn = u.pn, b = (u.pm * 256) / T_, t0 = u.pm * 256 - b * T_ + wr * 64 + fr;
        if (pn == 11) {
            if (wc == 0 && fq < 4) {
                float* gate = (float*)(ws + WS_GATE); float* fl = (float*)(ws + WS_FL);
#pragma unroll
                for (int ai = 0; ai < 2; ++ai)
#pragma unroll
                    for (int m = 0; m < 4; ++m) { const int t = t0 + ai * 128 + m * 16; const size_t n = (size_t)b * T_ + t;
#pragma unroll
                        for (int nn = 0; nn < 2; ++nn)
#pragma unroll
                            for (int e = 0; e < 4; ++e) { const int c = 8 * fq + 4 * nn + e; const float v = acc[ai][0][m][nn][e];
                                if (c < 24) gate[n * 24 + c] = __builtin_amdgcn_rcpf(1.f + __builtin_amdgcn_exp2f(-(v + b_gate[c]) * LOG2E));
                                else if (c < 28) { const float z = v + b_fgt[c - 24];
                                    fl[(size_t)(b * 4 + (c - 24)) * T_ + t] = z < -30.f ? z : -0.6931471805599453f * __builtin_amdgcn_logf(1.f + __builtin_amdgcn_exp2f(-z * LOG2E)); } } }
            }
            return;
        }
        if (pn == 6 || pn == 9) {
            const int lane_ = (fq << 4) | fr;
#pragma unroll
            for (int bj = 0; bj < 2; ++bj)
#pragma unroll
                for (int ai = 0; ai < 2; ++ai) { float mx = 0.f;
#pragma unroll
                    for (int m = 0; m < 4; ++m) { const pg8::f32x4 v0 = acc[ai][bj][m][0], v1 = acc[ai][bj][m][1];
                        float ss = (v0[0] * v0[0] + v0[1] * v0[1]) + (v0[2] * v0[2] + v0[3] * v0[3]) + (v1[0] * v1[0] + v1[1] * v1[1]) + (v1[2] * v1[2] + v1[3] * v1[3]);
                        ss += shflx_f(ss, 16, lane_); ss += shflx_f(ss, 32, lane_); mx = fmaxf(mx, ss); }
#pragma unroll
                    for (int o = 1; o < 16; o <<= 1) mx = fmaxf(mx, shflx_f(mx, o, lane_));
                    if (lane_ == 0) { const int cg = bj * 4 + wc, tile = (u.pm * 256 - b * T_ + ai * 128 + wr * 64) >> 6;
                        unsigned* dst = pn == 6 ? kn + ((b * 4 + (cg >> 1)) * 64 + tile) * 2 + (cg & 1) : kn + 4096 + (b * 8 + cg) * 64 + tile;
                        atomicMax(dst, __float_as_uint(mx)); } }
        }
#pragma unroll
        for (int bj = 0; bj < 2; ++bj) {
            const int c = bj * 128 + wc * 32 + 8 * fq;
            bf16* base; int W = 64; float sc = 1.f;
            if (pn < 2) { base = (bf16*)(ws + WS_QN) + (size_t)(b * 8 + pn * 4 + (c >> 6)) * T_ * 64 + (c & 63); sc = 0.125f * LOG2E; }
            else if (pn < 5) { base = (bf16*)(ws + WS_KV6 + (size_t)((pn - 2) * 2 + (c >> 7)) * KV6_STRIDE) + (size_t)(b * 2 + ((c >> 6) & 1)) * T_ * 64 + (c & 63); }
            else if (pn < 8) { base = (bf16*)(ws + WS_FQKV) + (size_t)(pn - 5) * (8 * MiB) + (size_t)(b * 4 + (c >> 6)) * T_ * 64 + (c & 63); if (pn == 5) sc = 0.125f * LOG2E; }
            else if (pn < 10) { base = (bf16*)(ws + WS_DQK) + (size_t)(pn - 8) * (8 * MiB) + (size_t)(b * 8 + (c >> 5)) * T_ * 32 + (c & 31); W = 32; if (pn == 8) sc = 0.17677669529663687f * LOG2E; }
            else { base = (bf16*)(ws + WS_DV) + (size_t)(b * 4 + (c >> 6)) * T_ * 64 + (c & 63); }
            const bool blk = W == 64 && pn != 2;
            if (blk) base += -(c & 63) + ((c >> 5) & 1) * 512 + (c & 31);
#pragma unroll
            for (int ai = 0; ai < 2; ++ai)
#pragma unroll
                for (int m = 0; m < 4; ++m) { const int t = t0 + ai * 128 + m * 16;
                    const pg8::f32x4 v0 = acc[ai][bj][m][0] * sc, v1 = acc[ai][bj][m][1] * sc;
                    pg8::u32x4 w; w.x = pg8::cvt_pk_bf16(v0[0], v0[1]); w.y = pg8::cvt_pk_bf16(v0[2], v0[3]); w.z = pg8::cvt_pk_bf16(v1[0], v1[1]); w.w = pg8::cvt_pk_bf16(v1[2], v1[3]);
                    *(pg8::u32x4*)(base + (blk ? (size_t)((t >> 4) * 1024 + (t & 15) * 32) : (size_t)t * W)) = w; }
        }
    }
};
struct EpiResBf16 {
    static constexpr bool PERM = false, AFTER_DRAIN = false;
    bf16* xr;
    __device__ __forceinline__ void operator()(const pg8::f32x4 (&acc)[2][2][4][2], const pg8::Unit& u, int wr, int wc, int fr, int fq) const {
        { int t_ = threadIdx.x; asm volatile("" : "+v"(t_)); fr = t_ & 15; fq = (t_ >> 4) & 3; }
#pragma unroll
        for (int ai = 0; ai < 2; ++ai)
#pragma unroll
            for (int m = 0; m < 4; ++m) { const size_t off = (size_t)(u.pm * 256 + ai * 128 + wr * 64 + m * 16 + fr) * D_ + u.pn * 256 + wc * 32 + 4 * fq;
#pragma unroll
                for (int bj = 0; bj < 2; ++bj)
#pragma unroll
                    for (int n = 0; n < 2; ++n) { const u64 w = *(const u64*)(xr + off + bj * 128 + n * 16);
                        const pg8::f32x4 bs = {__uint_as_float((unsigned)w << 16), __uint_as_float((unsigned)w & 0xffff0000u), __uint_as_float((unsigned)(w >> 32) << 16), __uint_as_float((unsigned)(w >> 32) & 0xffff0000u)};
                        const pg8::f32x4 o = bs + acc[ai][bj][m][n];
                        *(u64*)(xr + off + bj * 128 + n * 16) = (u64)pg8::cvt_pk_bf16(o[0], o[1]) | ((u64)pg8::cvt_pk_bf16(o[2], o[3]) << 32); } }
    }
};


struct EpiDummy {
    static constexpr bool PERM = true, AFTER_DRAIN = false;
    float* dst;
    __device__ __forceinline__ void operator()(const pg8::f32x4 (&acc)[2][2][4][2], const pg8::Unit& u, int wr, int wc, int fr, int fq) const {
        pg8::f32x4 a = {0.f, 0.f, 0.f, 0.f};
#pragma unroll
        for (int ai = 0; ai < 2; ++ai)
#pragma unroll
            for (int bj = 0; bj < 2; ++bj)
#pragma unroll
                for (int m = 0; m < 4; ++m) { a = a + acc[ai][bj][m][0]; a = a + acc[ai][bj][m][1]; }
        *(pg8::f32x4*)(dst + ((size_t)(u.pm * 12 + u.pn) * 512 + threadIdx.x) * 4) = a;
    }
};
struct OneUnitOrder { pg8::Unit u; bool has;
    __device__ __forceinline__ bool next(int i, pg8::Unit& o) const { if (i != 0 || !has) return false; o = u; return true; }
    __device__ __forceinline__ void a_ready(const pg8::Unit&) const {}
    __device__ __forceinline__ void done(const pg8::Unit&) const {} };
__device__ __forceinline__ float gelu_tanh_fast(float x) { const float u2 = 1.5957691216057308f * (x + 0.044715f * x * x * x); return x * __builtin_amdgcn_rcpf(1.f + __builtin_amdgcn_exp2f(-u2 * LOG2E)); }
struct EpiCmpH {
    static constexpr bool PERM = true, AFTER_DRAIN = false;
    bf16* hc; const float* bias1;
    __device__ __forceinline__ void operator()(const pg8::f32x4 (&acc)[2][2][4][2], const pg8::Unit& u, int wr, int wc, int fr, int fq) const {
        { int t_ = threadIdx.x; asm volatile("" : "+v"(t_)); fr = t_ & 15; fq = (t_ >> 4) & 3; }
        const int kv = u.pn;
#pragma unroll
        for (int bj = 0; bj < 2; ++bj) { const int col = bj * 128 + wc * 32 + 8 * fq;
            const pg8::f32x4 b0 = *(const pg8::f32x4*)(bias1 + kv * 256 + col), b1 = *(const pg8::f32x4*)(bias1 + kv * 256 + col + 4);
#pragma unroll
            for (int ai = 0; ai < 2; ++ai)
#pragma unroll
                for (int m = 0; m < 4; ++m) { const int row = u.pm * 256 + ai * 128 + wr * 64 + m * 16 + fr;
                    const pg8::f32x4 v0 = acc[ai][bj][m][0] + b0, v1 = acc[ai][bj][m][1] + b1;
                    pg8::u32x4 w; w.x = pg8::cvt_pk_bf16(gelu_tanh_fast(v0[0]), gelu_tanh_fast(v0[1])); w.y = pg8::cvt_pk_bf16(gelu_tanh_fast(v0[2]), gelu_tanh_fast(v0[3]));
                    w.z = pg8::cvt_pk_bf16(gelu_tanh_fast(v1[0]), gelu_tanh_fast(v1[1])); w.w = pg8::cvt_pk_bf16(gelu_tanh_fast(v1[2]), gelu_tanh_fast(v1[3]));
                    *(pg8::u32x4*)(hc + ((size_t)kv * 4096 + row) * 256 + col) = w; } }
    }
};
struct EpiCmpOut {
    static constexpr bool PERM = true, AFTER_DRAIN = false;
    bf16* kvcmp;
    __device__ __forceinline__ void operator()(const pg8::f32x4 (&acc)[2][2][4][2], const pg8::Unit& u, int wr, int wc, int fr, int fq) const {
        { int t_ = threadIdx.x; asm volatile("" : "+v"(t_)); fr = t_ & 15; fq = (t_ >> 4) & 3; }
        if (wc >= 2) return;
        const int kv = u.pn, col = wc * 32 + 8 * fq;
#pragma unroll
        for (int ai = 0; ai < 2; ++ai)
#pragma unroll
            for (int m = 0; m < 4; ++m) { const int row = u.pm * 256 + ai * 128 + wr * 64 + m * 16 + fr; const float z = ((row & 255) == 255) ? 0.f : 1.f;
                const pg8::f32x4 v0 = acc[ai][0][m][0], v1 = acc[ai][0][m][1];
                pg8::u32x4 w; w.x = pg8::cvt_pk_bf16(z != 0.f ? v0[0] : 0.f, z != 0.f ? v0[1] : 0.f); w.y = pg8::cvt_pk_bf16(z != 0.f ? v0[2] : 0.f, z != 0.f ? v0[3] : 0.f);
                w.z = pg8::cvt_pk_bf16(z != 0.f ? v1[0] : 0.f, z != 0.f ? v1[1] : 0.f); w.w = pg8::cvt_pk_bf16(z != 0.f ? v1[2] : 0.f, z != 0.f ? v1[3] : 0.f);
                *(pg8::u32x4*)(kvcmp + ((size_t)kv * 4096 + row) * 64 + col) = w; }
    }
};

__device__ __forceinline__ void moe_build_tables(const unsigned* cnt, int tid) {
    LAS int* T = (LAS int*)((LAS unsigned char*)lds_raw + TBL_OFF);
    __syncthreads();
    if (tid < 112) T[384 + tid] = (int)cnt[tid * MOE_CS];
    __syncthreads();
    if (tid == 0) { int o = 0; for (int c = 0; c < 112; ++c) { T[c] = o; const int n = (T[384 + c] + 255) >> 8; for (int k = 0; k < n; ++k) T[128 + o + k] = c; o += n; } T[112] = o; }
    __syncthreads();
}
__device__ __forceinline__ void moe_pair(int cls, int& ea, int& eb) { const int grp = cls / 28; int idx = cls % 28, lo = 0; while (idx >= 7 - lo) { idx -= 7 - lo; ++lo; } ea = grp * 8 + lo; eb = grp * 8 + lo + 1 + idx; }
struct MoeOrder1 {
    const char* wsb; const unsigned* rec; const char* wgu; int G, c;
    __device__ __forceinline__ bool next(int i, pg8::Unit& u) const {
        const LAS int* T = (const LAS int*)((LAS unsigned char*)lds_raw + TBL_OFF);
        const int idx = i * G + c; if (idx >= 4 * T[112]) return false;
        const int tile = idx >> 2, pn = idx & 3; int ea, eb; moe_pair(T[128 + tile], ea, eb); const int e = (pn >> 1) ? eb : ea;
        u.pm = tile; u.pn = pn; u.a = wsb; u.b = wgu + ((size_t)e * 512 + (pn & 1) * 256) * 2048; u.b2 = u.b; return true; }
    __device__ __forceinline__ const char* abase() const { return wsb; }
    __device__ __forceinline__ unsigned arow(const pg8::Unit& u, int r) const {
        const LAS int* T = (const LAS int*)((LAS unsigned char*)lds_raw + TBL_OFF);
        const int cls = T[128 + u.pm], vr = (u.pm - T[cls]) * 256 + r;
        unsigned off = ZROW_OFF;
        if (vr < T[384 + cls]) off = (unsigned)WS_HN + rec[((size_t)cls * 32768 + vr) * 4] * 2048u;
        return off; }
    __device__ __forceinline__ void a_ready(const pg8::Unit&) const {}
    __device__ __forceinline__ void done(const pg8::Unit&) const {} };
struct MoeOrder2 {
    const char* hb; const char* wd; int G, c;
    __device__ __forceinline__ bool next(int i, pg8::Unit& u) const {
        const LAS int* T = (const LAS int*)((LAS unsigned char*)lds_raw + TBL_OFF);
        const int idx = i * G + c; if (idx >= 4 * T[112]) return false;
        const int tile = idx >> 2, pn = idx & 3; int ea, eb; moe_pair(T[128 + tile], ea, eb);
        u.pm = tile; u.pn = pn; u.a = hb + (size_t)tile * 256 * 1024; u.b = wd + ((size_t)ea * 1024 + pn * 256) * 512; u.b2 = wd + ((size_t)eb * 1024 + pn * 256) * 512; return true; }
    __device__ __forceinline__ void a_ready(const pg8::Unit&) const {}
    __device__ __forceinline__ void done(const pg8::Unit&) const {} };
struct EpiMoeH {
    static constexpr bool PERM = true, AFTER_DRAIN = false;
    bf16* hb; const u32x4* rec;
    __device__ __forceinline__ void operator()(const pg8::f32x4 (&acc)[2][2][4][2], const pg8::Unit& u, int wr, int wc, int fr, int fq) const {
        { int t_ = threadIdx.x; asm volatile("" : "+v"(t_)); fr = t_ & 15; fq = (t_ >> 4) & 3; }
        const int slot = u.pn >> 1;
        const LAS int* T = (const LAS int*)((LAS unsigned char*)lds_raw + TBL_OFF);
        const int cls = T[128 + u.pm], vr0 = (u.pm - T[cls]) * 256, ncls = T[384 + cls];
#pragma unroll
        for (int ai = 0; ai < 2; ++ai)
#pragma unroll
            for (int m = 0; m < 4; ++m) { const int rr = ai * 128 + wr * 64 + m * 16 + fr; const size_t row = (size_t)u.pm * 256 + rr; float w = 0.f, rs = 0.f;
                if (vr0 + rr < ncls) { const u32x4 q = rec[(size_t)cls * 32768 + vr0 + rr]; w = __uint_as_float(slot ? q.z : q.y); rs = __uint_as_float(q.w); }
#pragma unroll
                for (int bj = 0; bj < 2; ++bj) { const int j0 = (u.pn & 1) * 128 + (bj * 128 + wc * 32 + 8 * fq) / 2;
                    pg8::f32x4 v0 = acc[ai][bj][m][0], v1 = acc[ai][bj][m][1];
#pragma unroll
                    for (int e = 0; e < 4; ++e) { v0[e] *= rs; v1[e] *= rs; }
                    const float h0 = v0[0] * __builtin_amdgcn_rcpf(1.f + __builtin_amdgcn_exp2f(-v0[0] * LOG2E)) * v0[1] * w, h1 = v0[2] * __builtin_amdgcn_rcpf(1.f + __builtin_amdgcn_exp2f(-v0[2] * LOG2E)) * v0[3] * w;
                    const float h2 = v1[0] * __builtin_amdgcn_rcpf(1.f + __builtin_amdgcn_exp2f(-v1[0] * LOG2E)) * v1[1] * w, h3 = v1[2] * __builtin_amdgcn_rcpf(1.f + __builtin_amdgcn_exp2f(-v1[2] * LOG2E)) * v1[3] * w;
                    const int jg = slot * 256 + j0;
                    *(u64*)(hb + ((row >> 4) * 32 + (jg >> 4)) * 256 + (row & 15) * 16 + (jg & 15)) = (u64)pg8::cvt_pk_bf16(h0, h1) | ((u64)pg8::cvt_pk_bf16(h2, h3) << 32); } }
    }
};
struct EpiMoeOut {
    static constexpr bool PERM = false, AFTER_DRAIN = false;
    bf16* x; const unsigned* rec;
    __device__ __forceinline__ void operator()(const pg8::f32x4 (&acc)[2][2][4][2], const pg8::Unit& u, int wr, int wc, int fr, int fq) const {
        { int t_ = threadIdx.x; asm volatile("" : "+v"(t_)); fr = t_ & 15; fq = (t_ >> 4) & 3; }
        bf16* xx = x; const unsigned* rt = rec; asm volatile("" : "+s"(xx), "+s"(rt));
        const LAS int* T = (const LAS int*)((LAS unsigned char*)lds_raw + TBL_OFF);
        const int cls = T[128 + u.pm], vr0 = (u.pm - T[cls]) * 256, ncls = T[384 + cls];
#pragma unroll
        for (int ai = 0; ai < 2; ++ai)
#pragma unroll
            for (int m = 0; m < 4; ++m) { const int rr = ai * 128 + wr * 64 + m * 16 + fr; int tok = -1; if (vr0 + rr < ncls) tok = (int)rt[((size_t)cls * 32768 + vr0 + rr) * 4];
                if (tok >= 0) { bf16* xr = xx + (size_t)tok * D_ + u.pn * 256 + wc * 32 + 4 * fq;
#pragma unroll
                    for (int bj = 0; bj < 2; ++bj)
#pragma unroll
                        for (int n = 0; n < 2; ++n) { u64* q = (u64*)(xr + bj * 128 + n * 16); const u64 w = *q; const pg8::f32x4 a = acc[ai][bj][m][n];
                            *q = (u64)pg8::cvt_pk_bf16(__uint_as_float((unsigned)w << 16) + a[0], __uint_as_float((unsigned)w & 0xffff0000u) + a[1]) | ((u64)pg8::cvt_pk_bf16(__uint_as_float((unsigned)(w >> 32) << 16) + a[2], __uint_as_float((unsigned)(w >> 32) & 0xffff0000u) + a[3]) << 32); } } }
    }
};

__device__ __forceinline__ void transpose_item(const float* W, int ldw, bf16* WT, int ldt, int r0, int rmul, int k0, LAS float* scr, int lane, const float* gk = nullptr) {
    f32x4 v[8];
#pragma unroll
    for (int i = 0; i < 8; ++i) v[i] = *(const f32x4*)(W + (size_t)(k0 + i * 8 + (lane >> 3)) * ldw + (lane & 7) * 4);
    if (gk) {
#pragma unroll
        for (int i = 0; i < 8; ++i) { const float gsc = gk[k0 + i * 8 + (lane >> 3)]; v[i].x *= gsc; v[i].y *= gsc; v[i].z *= gsc; v[i].w *= gsc; } }
#pragma unroll
    for (int i = 0; i < 8; ++i) { LAS float* d = scr + (i * 8 + (lane >> 3)) * 33 + (lane & 7) * 4; d[0] = v[i].x; d[1] = v[i].y; d[2] = v[i].z; d[3] = v[i].w; }
    asm volatile("s_waitcnt lgkmcnt(0)" ::: "memory");
    const int c = lane & 7;
#pragma unroll
    for (int j = 0; j < 4; ++j) { const int n = (lane >> 3) + 8 * j; const LAS float* sp = scr + (8 * c) * 33 + n;
        u32x4 o; o.x = pk2(sp[0 * 33], sp[1 * 33]); o.y = pk2(sp[2 * 33], sp[3 * 33]); o.z = pk2(sp[4 * 33], sp[5 * 33]); o.w = pk2(sp[6 * 33], sp[7 * 33]);
        *(u32x4*)(WT + (size_t)(r0 + rmul * n) * ldt + k0 + 8 * c) = o; }
    asm volatile("s_waitcnt lgkmcnt(0)" ::: "memory");
}
__device__ __forceinline__ void transpose_seg(const float* W, int ldw, int K, int sc0, int ncol, bf16* WT, int r0, int rmul, int item, LAS float* scr, int lane, const float* gk = nullptr) {
    const int nb = ncol / 32, kb = item / nb, cb = item % nb;
    transpose_item(W + sc0 + cb * 32, ldw, WT, K, r0 + rmul * cb * 32, rmul, kb * 64, scr, lane, gk);
}

typedef float f32x16 __attribute__((ext_vector_type(16)));
typedef short bf16x8v __attribute__((ext_vector_type(8)));
typedef short s16x4 __attribute__((ext_vector_type(4)));
typedef float f32x2_t __attribute__((ext_vector_type(2)));
typedef __bf16 bf16x2_t __attribute__((ext_vector_type(2)));
constexpr int A_KBUF = 10240, A_VBUF = 12288;
constexpr int A_KOFF = 0, A_VOFF = 2 * A_KBUF, A_BOFF = A_VOFF + 2 * A_VBUF, A_LDS_END = A_BOFF + 2 * 256;
__device__ __forceinline__ constexpr int crow0(int reg) { return (reg & 3) + 8 * (reg >> 2); }
__device__ __forceinline__ float swap_max(float m) { auto rr = __builtin_amdgcn_permlane32_swap(__float_as_uint(m), __float_as_uint(m), false, false); return fmaxf(__uint_as_float(rr[0]), __uint_as_float(rr[1])); }
__device__ __forceinline__ float swap_sum(float m) { auto rr = __builtin_amdgcn_permlane32_swap(__float_as_uint(m), __float_as_uint(m), false, false); return __uint_as_float(rr[0]) + __uint_as_float(rr[1]); }
__device__ __forceinline__ unsigned cvtpk(float lo, float hi) { f32x2_t v = {lo, hi}; bf16x2_t b = __builtin_convertvector(v, bf16x2_t); return __builtin_bit_cast(unsigned, b); }
__device__ __forceinline__ bf16x8v pack8(const f32x16& p, int b0) { u32x4 w; w.x = cvtpk(p[b0 + 0], p[b0 + 1]); w.y = cvtpk(p[b0 + 2], p[b0 + 3]); w.z = cvtpk(p[b0 + 4], p[b0 + 5]); w.w = cvtpk(p[b0 + 6], p[b0 + 7]); return __builtin_bit_cast(bf16x8v, w); }
__device__ __forceinline__ s16x4 tr_read(const LAS unsigned char* p) { typedef short v4i16_t __attribute__((ext_vector_type(4))); return __builtin_bit_cast(s16x4, __builtin_amdgcn_ds_read_tr16_b64_v4i16((LAS v4i16_t*)p)); }

template <int DQK>
__device__ __forceinline__ void attn_preload(const bf16* Kb0, const bf16* Kb1, const bf16* Vb, int j, int tid, u32x4& kreg, u32x4& vreg) {
    const bf16* ksrc;
    if (DQK == 64) ksrc = Kb0 + b64_off(tid >> 3, (tid & 7) * 8); else { const int mp = tid >> 8, tt = tid & 255; ksrc = (mp ? Kb1 : Kb0) + (tt >> 2) * 32 + (tt & 3) * 8; }
    const bf16* vsrc = Vb + b64_off(tid >> 3, (tid & 7) * 8);
    kreg = *(const u32x4*)(ksrc + (size_t)(j * 64) * DQK); vreg = *(const u32x4*)(vsrc + (size_t)(j * 64) * 64);
}
template <int DQK, int NMAP, bool FOX, bool SLC, bool PRE = false>
__device__ __forceinline__ void attn_core(LAS unsigned char* L, const bf16* Kb0, const bf16* Kb1, const bf16* Vb, const LAS float* cum, float cum_ref,
                                          const bf16x8v (&Qf)[NMAP][DQK / 16], u64 tilemask, int t_lane, int tw0, int win, float slope2, unsigned selw0, unsigned selw1,
                                          f32x16 (&O)[NMAP][2], float (&M)[NMAP], float (&Ls)[NMAP], int tid, bool started0 = false, int jpre = 0, u32x4 kpre = (u32x4){0u, 0u, 0u, 0u}, u32x4 vpre = (u32x4){0u, 0u, 0u, 0u}) {
    constexpr int KP = DQK * 2 + 16, VP = 192;
    const int lane = tid & 63, r = lane & 31, h = lane >> 5;
    int kdst; const bf16* ksrc;
    if (DQK == 64) { kdst = (tid >> 3) * KP + (tid & 7) * 16; ksrc = Kb0 + b64_off(tid >> 3, (tid & 7) * 8); }
    else { const int mp = tid >> 8, tt = tid & 255; kdst = mp * 5120 + (tt >> 2) * KP + (tt & 3) * 16; ksrc = (mp ? Kb1 : Kb0) + (tt >> 2) * 32 + (tt & 3) * 8; }
    const int vdst = (tid >> 3) * VP + (tid & 7) * 16; const bf16* vsrc = Vb + b64_off(tid >> 3, (tid & 7) * 8);
    const LAS unsigned char* kfrag = L + A_KOFF + r * KP + h * 16;
    const LAS unsigned char* vfrag = L + A_VOFF + (4 * h + ((lane & 15) >> 2)) * VP + (16 * ((lane >> 4) & 1) + 4 * (lane & 3)) * 2;
    u32x4 kreg, vreg; float breg = 0.f;
    u64 mk = tilemask;
    int j = PRE ? jpre : 63 - __builtin_clzll(mk); mk &= ~(1ull << j);
    { const int kv0 = j * 64; if (PRE) { kreg = kpre; vreg = vpre; } else { kreg = *(const u32x4*)(ksrc + (size_t)kv0 * DQK); vreg = *(const u32x4*)(vsrc + (size_t)kv0 * 64); } if (FOX && tid < 64) breg = (cum_ref - cum[kv0 + tid]) * LOG2E; }
    *(LAS u32x4*)(L + A_KOFF + kdst) = kreg; *(LAS u32x4*)(L + A_VOFF + vdst) = vreg; if (FOX && tid < 64) *(LAS float*)(L + A_BOFF + tid * 4) = breg;
    __syncthreads();
    int buf = 0; bool started = started0;
    float pdummy = 0.f; int idummy = 0; f32x16 dm0; for (int i = 0; i < 16; ++i) dm0[i] = 0.f;
    for (;;) {
        const bool more = mk != 0ull; int jn = 0;
        if (more) { jn = 63 - __builtin_clzll(mk); mk &= ~(1ull << jn); const int kv0 = jn * 64;
            kreg = *(const u32x4*)(ksrc + (size_t)kv0 * DQK); vreg = *(const u32x4*)(vsrc + (size_t)kv0 * 64); if (FOX && tid < 64) breg = (cum_ref - cum[kv0 + tid]) * LOG2E; }
        { const int kv0 = j * 64;
          bool wave_has = true; float selb = 0.f;
          if (SLC) { const bool mine = ((j < 32 ? (selw0 >> j) : (selw1 >> (j - 32))) & 1u) != 0u; selb = mine ? 0.f : -INFINITY; wave_has = __any(mine); }
          if (wave_has && !(kv0 > tw0 + 31) && !(tw0 - (kv0 + 63) >= win)) {
            const bool need_mask = (kv0 + 63 > tw0) || (tw0 + 31 - kv0 >= win);
            const int dl = t_lane - kv0 - 4 * h;
            bf16x8v pa[NMAP][4];
#pragma unroll
            for (int mp = 0; mp < NMAP; ++mp) {
                f32x16 p0, p1;
                if (FOX) { const LAS f32x4* bl = (const LAS f32x4*)(L + A_BOFF + buf * 256) + h; const float mm = M[mp];
#pragma unroll
                    for (int g4 = 0; g4 < 4; ++g4) { const f32x4 b0 = bl[2 * g4], b1 = bl[8 + 2 * g4];
                        p0[4 * g4 + 0] = b0.x - mm; p0[4 * g4 + 1] = b0.y - mm; p0[4 * g4 + 2] = b0.z - mm; p0[4 * g4 + 3] = b0.w - mm; p1[4 * g4 + 0] = b1.x - mm; p1[4 * g4 + 1] = b1.y - mm; p1[4 * g4 + 2] = b1.z - mm; p1[4 * g4 + 3] = b1.w - mm; } }
                else { const float base_l = (slope2 * (float)(kv0 + 4 * h - tw0) - M[mp]) + selb, s8 = slope2 * 8.f, s32 = slope2 * 32.f;
                    p0[0] = base_l; p0[1] = p0[0] + slope2; p0[2] = p0[1] + slope2; p0[3] = p0[2] + slope2;
#pragma unroll
                    for (int reg = 4; reg < 16; ++reg) p0[reg] = p0[reg - 4] + s8;
#pragma unroll
                    for (int reg = 0; reg < 16; ++reg) p1[reg] = p0[reg] + s32; }
                const LAS unsigned char* kb = kfrag + buf * A_KBUF + (DQK == 32 ? mp * 5120 : 0);
#pragma unroll
                for (int s = 0; s < DQK / 16; ++s) { const bf16x8v kf0 = *(const LAS bf16x8v*)(kb + s * 32), kf1 = *(const LAS bf16x8v*)(kb + 32 * KP + s * 32);
#ifdef PROBE_X_LDSK
                    { const bf16x8v z0 = *(const volatile LAS bf16x8v*)(kb + s * 32), z1 = *(const volatile LAS bf16x8v*)(kb + 32 * KP + s * 32); idummy ^= z0[0] ^ z1[1]; }
#endif
#ifdef PROBE_X_MFMA
                    dm0 = __builtin_amdgcn_mfma_f32_32x32x16_bf16(kf0, Qf[mp][s], dm0, 0, 0, 0); dm0 = __builtin_amdgcn_mfma_f32_32x32x16_bf16(kf1, Qf[mp][s], dm0, 0, 0, 0);
#endif
                    p0 = __builtin_amdgcn_mfma_f32_32x32x16_bf16(kf0, Qf[mp][s], p0, 0, 0, 0); p1 = __builtin_amdgcn_mfma_f32_32x32x16_bf16(kf1, Qf[mp][s], p1, 0, 0, 0); }
                if (need_mask) {
#pragma unroll
                    for (int reg = 0; reg < 16; ++reg) { const int d0 = dl - crow0(reg), d1 = d0 - 32;
                        p0[reg] = (d0 >= 0 && d0 < win) ? p0[reg] : -INFINITY; p1[reg] = (d1 >= 0 && d1 < win) ? p1[reg] : -INFINITY; } }
                float mt = fmaxf(fmaxf(p0[0], p1[0]), fmaxf(p0[1], p1[1]));
#pragma unroll
                for (int reg = 2; reg < 16; reg += 2) mt = fmaxf(fmaxf(mt, fmaxf(fmaxf(p0[reg], p1[reg]), p0[reg + 1])), p1[reg + 1]);
                mt = swap_max(mt);
                if (!started || __any(mt > 8.f)) {
                    const float d = (mt > -1e30f) ? (started ? fmaxf(mt, 0.f) : mt) : 0.f, alpha = __builtin_amdgcn_exp2f(-d);
                    O[mp][0] *= alpha; O[mp][1] *= alpha; Ls[mp] *= alpha; M[mp] += d;
#pragma unroll
                    for (int reg = 0; reg < 16; ++reg) { p0[reg] -= d; p1[reg] -= d; } }
                float rs = 0.f;
#ifdef PROBE_X_EXP
#pragma unroll
                for (int reg = 0; reg < 16; ++reg) { pdummy += __builtin_amdgcn_exp2f(p0[reg] - 1.f) + __builtin_amdgcn_exp2f(p1[reg] - 1.f); }
#endif
#pragma unroll
                for (int reg = 0; reg < 16; ++reg) { p0[reg] = __builtin_amdgcn_exp2f(p0[reg]); p1[reg] = __builtin_amdgcn_exp2f(p1[reg]); rs += p0[reg] + p1[reg]; }
                Ls[mp] += rs;
                pa[mp][0] = pack8(p0, 0); pa[mp][1] = pack8(p0, 8); pa[mp][2] = pack8(p1, 0); pa[mp][3] = pack8(p1, 8);
            }
            started = true;
            const LAS unsigned char* vb = vfrag + buf * A_VBUF;
#pragma unroll
            for (int db = 0; db < 2; ++db)
#pragma unroll
                for (int ks = 0; ks < 4; ++ks) { const s16x4 lo = tr_read(vb + ks * (16 * VP) + db * 64), hi = tr_read(vb + ks * (16 * VP) + db * 64 + 8 * VP);
                    const bf16x8v vf = {lo[0], lo[1], lo[2], lo[3], hi[0], hi[1], hi[2], hi[3]};
#pragma unroll
                    for (int mp = 0; mp < NMAP; ++mp) O[mp][db] = __builtin_amdgcn_mfma_f32_32x32x16_bf16(vf, pa[mp][ks], O[mp][db], 0, 0, 0); }
          } }
        if (more) { *(LAS u32x4*)(L + A_KOFF + (buf ^ 1) * A_KBUF + kdst) = kreg; *(LAS u32x4*)(L + A_VOFF + (buf ^ 1) * A_VBUF + vdst) = vreg; if (FOX && tid < 64) *(LAS float*)(L + A_BOFF + (buf ^ 1) * 256 + tid * 4) = breg; }
#ifdef PROBE_X_BAR
        __syncthreads();
#endif
        __syncthreads();
        if (!more) break;
        j = jn; buf ^= 1;
    }
    if (pdummy == 123.456f || idummy == 0x7fffabcd || dm0[3] == 98765.4321f) Ls[0] += 1e-30f;
}
#ifndef AC2_MODE
#define AC2_MODE 0
#endif
#ifndef AC2_INIT_VALU
#define AC2_INIT_VALU 24
#endif
template <bool FOX, bool SLC>
__device__ __forceinline__ void attn_core2(LAS unsigned char* L, const bf16* Kb0, const bf16* Vb, const LAS float* cum, float cum_ref,
                                           const bf16x8v (&Qf)[4], u64 tilemask, int t_lane, int tw0, int win, float slope2, unsigned selw0, unsigned selw1,
                                           f32x16 (&O)[2], float& M, float& Ls, int tid) {
    constexpr int KP = 144, VP = 192;
    const int lane = tid & 63, r = lane & 31, h = lane >> 5;
    const int kdst = (tid >> 3) * KP + (tid & 7) * 16; const bf16* ksrc = Kb0 + b64_off(tid >> 3, (tid & 7) * 8);
    const int vdst = (tid >> 3) * VP + (tid & 7) * 16; const bf16* vsrc = Vb + b64_off(tid >> 3, (tid & 7) * 8);
    const LAS unsigned char* kfrag = L + A_KOFF + r * KP + h * 16;
    const LAS unsigned char* vfrag = L + A_VOFF + (4 * h + ((lane & 15) >> 2)) * VP + (16 * ((lane >> 4) & 1) + 4 * (lane & 3)) * 2;
#define AC2_ACTIVE(jj) (!((jj) * 64 > tw0 + 31) && !(tw0 - ((jj) * 64 + 63) >= win))
#define AC2_INIT(jj, kslot, q0, q1) do { const int kv0_ = (jj) * 64; \
        if (FOX) { const LAS f32x4* bl = (const LAS f32x4*)(L + A_BOFF + (kslot) * 256) + h; const float mm = M; \
            _Pragma("unroll") for (int g4 = 0; g4 < 4; ++g4) { const f32x4 b0 = bl[2 * g4], b1 = bl[8 + 2 * g4]; \
                q0[4 * g4 + 0] = b0.x - mm; q0[4 * g4 + 1] = b0.y - mm; q0[4 * g4 + 2] = b0.z - mm; q0[4 * g4 + 3] = b0.w - mm; q1[4 * g4 + 0] = b1.x - mm; q1[4 * g4 + 1] = b1.y - mm; q1[4 * g4 + 2] = b1.z - mm; q1[4 * g4 + 3] = b1.w - mm; } } \
        else { float selb = 0.f; if (SLC) selb = ((((jj) < 32) ? (selw0 >> (jj)) : (selw1 >> ((jj) - 32))) & 1u) ? 0.f : -INFINITY; \
            const float base_l = (slope2 * (float)(kv0_ + 4 * h - tw0) - M) + selb, s8 = slope2 * 8.f, s32 = slope2 * 32.f; \
            q0[0] = base_l; q0[1] = q0[0] + slope2; q0[2] = q0[1] + slope2; q0[3] = q0[2] + slope2; \
            _Pragma("unroll") for (int reg = 4; reg < 16; ++reg) q0[reg] = q0[reg - 4] + s8; \
            _Pragma("unroll") for (int reg = 0; reg < 16; ++reg) q1[reg] = q0[reg] + s32; } } while (0)
#define AC2_QK(jj, kslot) do { AC2_INIT(jj, kslot, p0, p1); \
        const LAS unsigned char* kb_ = kfrag + (kslot) * A_KBUF; \
        _Pragma("unroll") for (int s_ = 0; s_ < 4; ++s_) { const bf16x8v kf0 = *(const LAS bf16x8v*)(kb_ + s_ * 32), kf1 = *(const LAS bf16x8v*)(kb_ + 32 * KP + s_ * 32); \
            p0 = __builtin_amdgcn_mfma_f32_32x32x16_bf16(kf0, Qf[s_], p0, 0, 0, 0); p1 = __builtin_amdgcn_mfma_f32_32x32x16_bf16(kf1, Qf[s_], p1, 0, 0, 0); } } while (0)
    u32x4 kreg, vreg; float breg = 0.f;
    u64 mk = tilemask;
    int j = 63 - __builtin_clzll(mk); mk &= ~(1ull << j);
    int jn = -1; if (mk) { jn = 63 - __builtin_clzll(mk); mk &= ~(1ull << jn); }
    { kreg = *(const u32x4*)(ksrc + (size_t)j * 64 * 64); vreg = *(const u32x4*)(vsrc + (size_t)j * 64 * 64); if (FOX && tid < 64) breg = (cum_ref - cum[j * 64 + tid]) * LOG2E;
      *(LAS u32x4*)(L + A_KOFF + kdst) = kreg; *(LAS u32x4*)(L + A_VOFF + vdst) = vreg; if (FOX && tid < 64) *(LAS float*)(L + A_BOFF + tid * 4) = breg;
      if (jn >= 0) { kreg = *(const u32x4*)(ksrc + (size_t)jn * 64 * 64); if (FOX && tid < 64) breg = (cum_ref - cum[jn * 64 + tid]) * LOG2E;
          *(LAS u32x4*)(L + A_KOFF + A_KBUF + kdst) = kreg; if (FOX && tid < 64) *(LAS float*)(L + A_BOFF + 256 + tid * 4) = breg; } }
    __syncthreads();
    f32x16 p0, p1;
    bool started = false;
    int ks = 0, vs = 0;
    if (AC2_ACTIVE(j)) AC2_QK(j, 0);
    for (;;) {
        int jnn = -1; if (mk) { jnn = 63 - __builtin_clzll(mk); mk &= ~(1ull << jnn); }
        if (jnn >= 0) { kreg = *(const u32x4*)(ksrc + (size_t)jnn * 64 * 64); if (FOX && tid < 64) breg = (cum_ref - cum[jnn * 64 + tid]) * LOG2E; }
        if (jn >= 0) vreg = *(const u32x4*)(vsrc + (size_t)jn * 64 * 64);
        const bool act = AC2_ACTIVE(j), actn = jn >= 0 && AC2_ACTIVE(jn);
        if (act) {
            const int kv0 = j * 64;
            if ((kv0 + 63 > tw0) || (tw0 + 31 - kv0 >= win)) { const int dl = t_lane - kv0 - 4 * h;
#pragma unroll
                for (int reg = 0; reg < 16; ++reg) { const int d0 = dl - crow0(reg), d1 = d0 - 32;
                    p0[reg] = (d0 >= 0 && d0 < win) ? p0[reg] : -INFINITY; p1[reg] = (d1 >= 0 && d1 < win) ? p1[reg] : -INFINITY; } }
            float mt = fmaxf(fmaxf(p0[0], p1[0]), fmaxf(p0[1], p1[1]));
#pragma unroll
            for (int reg = 2; reg < 16; reg += 2) mt = fmaxf(fmaxf(mt, fmaxf(fmaxf(p0[reg], p1[reg]), p0[reg + 1])), p1[reg + 1]);
            mt = swap_max(mt);
            if (!started || __any(mt > 8.f)) {
                const float d = (mt > -1e30f) ? (started ? fmaxf(mt, 0.f) : mt) : 0.f, alpha = __builtin_amdgcn_exp2f(-d);
                O[0] *= alpha; O[1] *= alpha; Ls *= alpha; M += d;
#pragma unroll
                for (int reg = 0; reg < 16; ++reg) { p0[reg] -= d; p1[reg] -= d; } }
            started = true;
#if AC2_MODE == 1
            {
                const int jq = jn >= 0 ? jn : 0;
                float rs = 0.f;
#pragma unroll
                for (int reg = 0; reg < 16; ++reg) { p0[reg] = __builtin_amdgcn_exp2f(p0[reg]); p1[reg] = __builtin_amdgcn_exp2f(p1[reg]); rs += p0[reg] + p1[reg]; }
                Ls += rs;
                const bf16x8v pa0 = pack8(p0, 0), pa1 = pack8(p0, 8), pa2 = pack8(p1, 0), pa3 = pack8(p1, 8);
                AC2_QK(jq, ks ^ 1);
                const LAS unsigned char* vb = vfrag + vs * A_VBUF;
#pragma unroll
                for (int db = 0; db < 2; ++db)
#pragma unroll
                    for (int kq = 0; kq < 4; ++kq) { const s16x4 lo = tr_read(vb + kq * (16 * VP) + db * 64), hi = tr_read(vb + kq * (16 * VP) + db * 64 + 8 * VP);
                        const bf16x8v vf = {lo[0], lo[1], lo[2], lo[3], hi[0], hi[1], hi[2], hi[3]};
                        O[db] = __builtin_amdgcn_mfma_f32_32x32x16_bf16(vf, kq == 0 ? pa0 : kq == 1 ? pa1 : kq == 2 ? pa2 : pa3, O[db], 0, 0, 0); }
            }
#else
            {
                const int jq = jn >= 0 ? jn : 0;
                f32x16 n0, n1;
                AC2_INIT(jq, ks ^ 1, n0, n1);
                const LAS unsigned char* kb_ = kfrag + (ks ^ 1) * A_KBUF;
                bf16x8v kf[8];
#pragma unroll
                for (int s_ = 0; s_ < 4; ++s_) { kf[2 * s_] = *(const LAS bf16x8v*)(kb_ + s_ * 32); kf[2 * s_ + 1] = *(const LAS bf16x8v*)(kb_ + 32 * KP + s_ * 32); }
                const LAS unsigned char* vb = vfrag + vs * A_VBUF;
                __builtin_amdgcn_sched_barrier(0);
                float ra = 0.f, rb = 0.f; unsigned w[16];
#define AC2_PINF(x) asm volatile("" : "+v"(x))
#define AC2_QGAP(i) do { if ((i) & 1) n1 = __builtin_amdgcn_mfma_f32_32x32x16_bf16(kf[i], Qf[(i) >> 1], n1, 0, 0, 0); else n0 = __builtin_amdgcn_mfma_f32_32x32x16_bf16(kf[i], Qf[(i) >> 1], n0, 0, 0, 0); \
                    float e0 = __builtin_amdgcn_exp2f(p0[2 * (i)]), e1 = __builtin_amdgcn_exp2f(p0[2 * (i) + 1]), e2 = __builtin_amdgcn_exp2f(p1[2 * (i)]), e3 = __builtin_amdgcn_exp2f(p1[2 * (i) + 1]); \
                    ra += e0 + e1; rb += e2 + e3; \
                    AC2_PINF(e0); AC2_PINF(e1); AC2_PINF(e2); AC2_PINF(e3); AC2_PINF(ra); AC2_PINF(rb); \
                    p0[2 * (i)] = e0; p0[2 * (i) + 1] = e1; p1[2 * (i)] = e2; p1[2 * (i) + 1] = e3; \
                    if ((i) >= 4) { w[2 * ((i) - 4)] = cvtpk(p0[4 * ((i) - 4)], p0[4 * ((i) - 4) + 1]); w[2 * ((i) - 4) + 1] = cvtpk(p0[4 * ((i) - 4) + 2], p0[4 * ((i) - 4) + 3]); AC2_PINF(w[2 * ((i) - 4)]); AC2_PINF(w[2 * ((i) - 4) + 1]); } \
                    if ((i) == 6) { vl[0] = tr_read(vb); vh[0] = tr_read(vb + 8 * VP); } \
                    if ((i) == 7) { vl[1] = tr_read(vb + 64); vh[1] = tr_read(vb + 64 + 8 * VP); } \
                    __builtin_amdgcn_sched_barrier(0); } while (0)
                s16x4 vl[2], vh[2];
                AC2_QGAP(0); AC2_QGAP(1); AC2_QGAP(2); AC2_QGAP(3); AC2_QGAP(4); AC2_QGAP(5); AC2_QGAP(6); AC2_QGAP(7);
                Ls += ra + rb;
#define AC2_PA(kq) __builtin_bit_cast(bf16x8v, (u32x4){w[4 * (kq)], w[4 * (kq) + 1], w[4 * (kq) + 2], w[4 * (kq) + 3]})
#define AC2_PGAP(g) do { const int kq_ = (g) >> 1, db_ = (g) & 1; const bf16x8v vf = {vl[(g) & 1][0], vl[(g) & 1][1], vl[(g) & 1][2], vl[(g) & 1][3], vh[(g) & 1][0], vh[(g) & 1][1], vh[(g) & 1][2], vh[(g) & 1][3]}; \
                    if ((g) < 6) { const int kq2 = ((g) + 2) >> 1, db2 = (g) & 1; vl[(g) & 1] = tr_read(vb + kq2 * (16 * VP) + db2 * 64); vh[(g) & 1] = tr_read(vb + kq2 * (16 * VP) + db2 * 64 + 8 * VP); } \
                    O[db_] = __builtin_amdgcn_mfma_f32_32x32x16_bf16(vf, AC2_PA(kq_), O[db_], 0, 0, 0); \
                    if ((g) < 4) { w[8 + 2 * (g)] = cvtpk(p1[4 * (g)], p1[4 * (g) + 1]); w[8 + 2 * (g) + 1] = cvtpk(p1[4 * (g) + 2], p1[4 * (g) + 3]); AC2_PINF(w[8 + 2 * (g)]); AC2_PINF(w[8 + 2 * (g) + 1]); } \
                    __builtin_amdgcn_sched_barrier(0); } while (0)
                AC2_PGAP(0); AC2_PGAP(1); AC2_PGAP(2); AC2_PGAP(3); AC2_PGAP(4); AC2_PGAP(5); AC2_PGAP(6); AC2_PGAP(7);
#undef AC2_PGAP
#undef AC2_PA
#undef AC2_QGAP
#undef AC2_PINF
                p0 = n0; p1 = n1;
            }
#endif
        } else if (actn) AC2_QK(jn, ks ^ 1);
        if (jnn >= 0) { *(LAS u32x4*)(L + A_KOFF + ks * A_KBUF + kdst) = kreg; if (FOX && tid < 64) *(LAS float*)(L + A_BOFF + ks * 256 + tid * 4) = breg; }
        if (jn >= 0) *(LAS u32x4*)(L + A_VOFF + (vs ^ 1) * A_VBUF + vdst) = vreg;
        __syncthreads();
        if (jn < 0) break;
        j = jn; jn = jnn; ks ^= 1; vs ^= 1;
    }
#undef AC2_QK
#undef AC2_INIT
#undef AC2_ACTIVE
}
__device__ __forceinline__ size_t mix_off(size_t n, int c, int W) { return ((n >> 5) * (size_t)(W / 8) + (size_t)(c >> 3)) * 256 + (n & 31) * 8 + (c & 7); }
#define ATTN_FOR_CHUNKS(db, g4) _Pragma("unroll") for (int db = 0; db < 2; ++db) _Pragma("unroll") for (int g4 = 0; g4 < 4; ++g4)

__device__ __forceinline__ void unpack8(const u32x4 w, float (&f)[8]) { f[0] = __uint_as_float(w.x << 16); f[1] = __uint_as_float(w.x & 0xffff0000u); f[2] = __uint_as_float(w.y << 16); f[3] = __uint_as_float(w.y & 0xffff0000u);
    f[4] = __uint_as_float(w.z << 16); f[5] = __uint_as_float(w.z & 0xffff0000u); f[6] = __uint_as_float(w.w << 16); f[7] = __uint_as_float(w.w & 0xffff0000u); }
__device__ __forceinline__ void ph_norm_bf16_from_bf16(const Ctx& c, const bf16* x, const float* g, bf16* out) {
    constexpr int RB = 4; float gg[2][8];
#pragma unroll
    for (int j = 0; j < 2; ++j) { const f32x4 a = ((const f32x4*)g)[2 * c.lane + 128 * j], b2 = ((const f32x4*)g)[2 * c.lane + 128 * j + 1]; gg[j][0] = a.x; gg[j][1] = a.y; gg[j][2] = a.z; gg[j][3] = a.w; gg[j][4] = b2.x; gg[j][5] = b2.y; gg[j][6] = b2.z; gg[j][7] = b2.w; }
    for (int row0 = c.gw * RB; row0 < NT; row0 += c.ngw * RB) {
        u32x4 v[RB][2];
#pragma unroll
        for (int q = 0; q < RB; ++q)
#pragma unroll
            for (int j = 0; j < 2; ++j) v[q][j] = ((const u32x4*)(x + (size_t)(row0 + q) * D_))[c.lane + 64 * j];
#pragma unroll
        for (int q = 0; q < RB; ++q) { float f[2][8]; float ss = 0.f;
#pragma unroll
            for (int j = 0; j < 2; ++j) { unpack8(v[q][j], f[j]);
#pragma unroll
                for (int e = 0; e < 8; ++e) ss = fmaf(f[j][e], f[j][e], ss); }
            const float r = rsqrtf(wave_sum(ss) * (1.f / D_) + EPS);
#pragma unroll
            for (int j = 0; j < 2; ++j) { u32x4 o; o.x = pk2(f[j][0] * r * gg[j][0], f[j][1] * r * gg[j][1]); o.y = pk2(f[j][2] * r * gg[j][2], f[j][3] * r * gg[j][3]); o.z = pk2(f[j][4] * r * gg[j][4], f[j][5] * r * gg[j][5]); o.w = pk2(f[j][6] * r * gg[j][6], f[j][7] * r * gg[j][7]);
                ((u32x4*)(out + (size_t)(row0 + q) * D_))[c.lane + 64 * j] = o; } }
    }
}
__device__ __forceinline__ void ph_norm_final_from_bf16(const Ctx& c, const bf16* x, const float* g, float* out) {
    constexpr int RB = 4; float gg[2][8];
#pragma unroll
    for (int j = 0; j < 2; ++j) { const f32x4 a = ((const f32x4*)g)[2 * c.lane + 128 * j], b2 = ((const f32x4*)g)[2 * c.lane + 128 * j + 1]; gg[j][0] = a.x; gg[j][1] = a.y; gg[j][2] = a.z; gg[j][3] = a.w; gg[j][4] = b2.x; gg[j][5] = b2.y; gg[j][6] = b2.z; gg[j][7] = b2.w; }
    for (int row0 = c.gw * RB; row0 < NT; row0 += c.ngw * RB) {
        u32x4 v[RB][2];
#pragma unroll
        for (int q = 0; q < RB; ++q)
#pragma unroll
            for (int j = 0; j < 2; ++j) v[q][j] = ((const u32x4*)(x + (size_t)(row0 + q) * D_))[c.lane + 64 * j];
#pragma unroll
        for (int q = 0; q < RB; ++q) { float f[2][8]; float ss = 0.f;
#pragma unroll
            for (int j = 0; j < 2; ++j) { unpack8(v[q][j], f[j]);
#pragma unroll
                for (int e = 0; e < 8; ++e) ss = fmaf(f[j][e], f[j][e], ss); }
            const float r = rsqrtf(wave_sum(ss) * (1.f / D_) + EPS);
#pragma unroll
            for (int j = 0; j < 2; ++j) { f32x4* o = (f32x4*)(out + (size_t)(row0 + q) * D_) + 2 * c.lane + 128 * j;
                o[0] = (f32x4){f[j][0] * r * gg[j][0], f[j][1] * r * gg[j][1], f[j][2] * r * gg[j][2], f[j][3] * r * gg[j][3]}; o[1] = (f32x4){f[j][4] * r * gg[j][4], f[j][5] * r * gg[j][5], f[j][6] * r * gg[j][6], f[j][7] * r * gg[j][7]}; } }
    }
}
__device__ __forceinline__ void ph_norm_bf16(const Ctx& c, const float* x, const float* g, bf16* out, bf16* raw) {
    constexpr int RB = 4;
    f32x4 gg[4];
#pragma unroll
    for (int j = 0; j < 4; ++j) gg[j] = ((const f32x4*)g)[c.lane + 64 * j];
    for (int row0 = c.gw * RB; row0 < NT; row0 += c.ngw * RB) {
        f32x4 v[RB][4];
#pragma unroll
        for (int q = 0; q < RB; ++q)
#pragma unroll
            for (int j = 0; j < 4; ++j) v[q][j] = ((const f32x4*)(x + (size_t)(row0 + q) * D_))[c.lane + 64 * j];
#pragma unroll
        for (int q = 0; q < RB; ++q) { float ss = 0.f;
#pragma unroll
            for (int j = 0; j < 4; ++j) ss += v[q][j].x * v[q][j].x + v[q][j].y * v[q][j].y + v[q][j].z * v[q][j].z + v[q][j].w * v[q][j].w;
            const float r = rsqrtf(wave_sum(ss) * (1.f / D_) + EPS);
            u64* o8 = (u64*)(out + (size_t)(row0 + q) * D_) + c.lane; u64* r8 = (u64*)(raw + (size_t)(row0 + q) * D_) + c.lane;
#pragma unroll
            for (int j = 0; j < 4; ++j) { o8[64 * j] = (u64)pk2(v[q][j].x * r * gg[j].x, v[q][j].y * r * gg[j].y) | ((u64)pk2(v[q][j].z * r * gg[j].z, v[q][j].w * r * gg[j].w) << 32);
                r8[64 * j] = (u64)pk2(v[q][j].x, v[q][j].y) | ((u64)pk2(v[q][j].z, v[q][j].w) << 32); } }
    }
}
__device__ __forceinline__ void ph_norm_final(const Ctx& c, float* x, const float* g) {
    constexpr int RB = 4;
    f32x4 gg[4];
#pragma unroll
    for (int j = 0; j < 4; ++j) gg[j] = ((const f32x4*)g)[c.lane + 64 * j];
    for (int row0 = c.gw * RB; row0 < NT; row0 += c.ngw * RB) {
        f32x4 v[RB][4];
#pragma unroll
        for (int q = 0; q < RB; ++q)
#pragma unroll
            for (int j = 0; j < 4; ++j) v[q][j] = ((const f32x4*)(x + (size_t)(row0 + q) * D_))[c.lane + 64 * j];
#pragma unroll
        for (int q = 0; q < RB; ++q) { float ss = 0.f;
#pragma unroll
            for (int j = 0; j < 4; ++j) ss += v[q][j].x * v[q][j].x + v[q][j].y * v[q][j].y + v[q][j].z * v[q][j].z + v[q][j].w * v[q][j].w;
            const float r = rsqrtf(wave_sum(ss) * (1.f / D_) + EPS);
            f32x4* xr = (f32x4*)(x + (size_t)(row0 + q) * D_) + c.lane;
#pragma unroll
            for (int j = 0; j < 4; ++j) xr[64 * j] = v[q][j] * r * gg[j]; }
    }
}

template <class AF, class EF>
__device__ __forceinline__ void naive_gemm(const Ctx& c, int M, int N, int K, AF af, const float* W, int ldb, EF ef) {
    LAS float* As = (LAS float*)c.lds;
    LAS float* Bs = As + 16 * 132;
    const int tm = (M + 127) / 128, tn = (N + 127) / 128, ntile = tm * tn;
    const int ty = c.tid >> 4, tx = c.tid & 15;
    for (int tile = c.bid; tile < ntile; tile += c.G) {
        const int m0 = (tile / tn) * 128, n0 = (tile % tn) * 128;
        float acc[4][8];
#pragma unroll
        for (int i = 0; i < 4; ++i)
#pragma unroll
            for (int j = 0; j < 8; ++j) acc[i][j] = 0.f;
        for (int k0 = 0; k0 < K; k0 += 16) {
            __syncthreads();
#pragma unroll
            for (int i = 0; i < 4; ++i) { const int e = c.tid + i * 512, r = e >> 4, kk = e & 15; const int row = m0 + r;
                As[kk * 132 + r] = (row < M) ? af(row, k0 + kk) : 0.f; }
#pragma unroll
            for (int i = 0; i < 4; ++i) { const int e = c.tid + i * 512, kk = e >> 7, cc = e & 127; const int col = n0 + cc;
                Bs[kk * 132 + cc] = (col < N) ? W[(size_t)(k0 + kk) * ldb + col] : 0.f; }
            __syncthreads();
#pragma unroll 2
            for (int kk = 0; kk < 16; ++kk) {
                float a[4], b[8];
#pragma unroll
                for (int i = 0; i < 4; ++i) a[i] = As[kk * 132 + ty * 4 + i];
#pragma unroll
                for (int j = 0; j < 8; ++j) b[j] = Bs[kk * 132 + tx * 8 + j];
#pragma unroll
                for (int i = 0; i < 4; ++i)
#pragma unroll
                    for (int j = 0; j < 8; ++j) acc[i][j] = fmaf(a[i], b[j], acc[i][j]);
            }
        }
        LAS float* Cs = Bs + 16 * 132;
        __syncthreads();
#pragma unroll
        for (int i = 0; i < 4; ++i)
#pragma unroll
            for (int j = 0; j < 8; ++j) Cs[(ty * 4 + i) * 129 + tx * 8 + j] = acc[i][j];
        __syncthreads();
#pragma unroll 1
        for (int e = c.tid; e < 128 * 128; e += NTHREADS) { const int r = e >> 7, cc = e & 127, row = m0 + r, col = n0 + cc; if (row < M && col < N) ef(row, col, Cs[r * 129 + cc]); }
    }
    __syncthreads();
}

struct InProjOut { bf16* qn; bf16* kv6; bf16* fqkv; bf16* dqk; bf16* dv; float* gate; float* fl; const float* b_gate; const float* b_fgt; };
__device__ __forceinline__ void inproj_store(const InProjOut& o, int n, int col, float v) {
    const int b = n / T_, t = n % T_;
    if (col < C_KV6) { const int h = col >> 6, d = col & 63; o.qn[((size_t)(b * 8 + h) * T_ + t) * 64 + d] = (bf16)f2bf(v * (0.125f * LOG2E)); }
    else if (col < C_GATE) { const int cc = col - C_KV6, idx = cc >> 7, g = (cc >> 6) & 1, d = cc & 63;
        ((bf16*)((unsigned char*)o.kv6 + idx * KV6_STRIDE))[((size_t)(b * 2 + g) * T_ + t) * 64 + d] = (bf16)f2bf(v); }
    else if (col < C_FQ) { const int j = col - C_GATE; o.gate[(size_t)n * 24 + j] = sigmoidf_(v + o.b_gate[j]); }
    else if (col < C_FF) { const int cc = col - C_FQ, idx = cc >> 8, h = (cc >> 6) & 3, d = cc & 63;
        o.fqkv[(size_t)idx * (8 * MiB) + ((size_t)(b * 4 + h) * T_ + t) * 64 + d] = (bf16)f2bf(idx == 0 ? v * (0.125f * LOG2E) : v); }
    else if (col < C_DQ) { const int h = col - C_FF; o.fl[(size_t)(b * 4 + h) * T_ + t] = log_sigmoidf_(v + o.b_fgt[h]); }
    else if (col < C_DV) { const int cc = col - C_DQ, idx = cc >> 8, h = (cc >> 6) & 3, i = (cc >> 5) & 1, d = cc & 31;
        o.dqk[(size_t)idx * (8 * MiB) + ((size_t)((b * 4 + h) * 2 + i) * T_ + t) * 32 + d] = (bf16)f2bf(idx == 0 ? v * (0.17677669529663687f * LOG2E) : v); }
    else { const int cc = col - C_DV, h = cc >> 6, d = cc & 63; o.dv[((size_t)(b * 4 + h) * T_ + t) * 64 + d] = (bf16)f2bf(v); }
}

__device__ __forceinline__ void ph_cumsum(const Ctx& c, float* fl) {
    for (int s = c.gw; s < B_ * 4; s += c.ngw) {
        float* p = fl + (size_t)s * T_; float carry = 0.f;
        for (int t0 = 0; t0 < T_; t0 += 64) {
            float v = p[t0 + c.lane];
#pragma unroll
            for (int o = 1; o < 64; o <<= 1) { const float u = __shfl_up(v, o); if (c.lane >= o) v += u; }
            v += carry; p[t0 + c.lane] = v; carry = __shfl(v, 63);
        }
    }
}

template <int DQK>
__device__ __forceinline__ float naive_attn_row(const bf16* q, const bf16* K, const bf16* V, int t, u64 mask, float slope2, const float* cum, int win, int lane) {
    float qv[DQK];
    { const u32x4* q4 = (const u32x4*)q;
#pragma unroll
      for (int i = 0; i < DQK / 8; ++i) { const u32x4 w = q4[i];
          qv[8 * i + 0] = __uint_as_float(w.x << 16); qv[8 * i + 1] = __uint_as_float(w.x & 0xffff0000u);
          qv[8 * i + 2] = __uint_as_float(w.y << 16); qv[8 * i + 3] = __uint_as_float(w.y & 0xffff0000u);
          qv[8 * i + 4] = __uint_as_float(w.z << 16); qv[8 * i + 5] = __uint_as_float(w.z & 0xffff0000u);
          qv[8 * i + 6] = __uint_as_float(w.w << 16); qv[8 * i + 7] = __uint_as_float(w.w & 0xffff0000u); } }
    const float cumt = cum ? cum[t] : 0.f;
    float m = -INFINITY, l = 0.f, o = 0.f;
    while (mask) {
        const int j = __builtin_ctzll(mask); mask &= mask - 1;
        const int kpos = 64 * j + lane; const int dist = t - kpos;
        const bool valid = dist >= 0 && dist < win;
        float s = 0.f;
        { const u32x4* k4 = (const u32x4*)(K + (size_t)kpos * DQK);
#pragma unroll
          for (int i = 0; i < DQK / 8; ++i) { const u32x4 w = k4[i];
              s = fmaf(qv[8 * i + 0], __uint_as_float(w.x << 16), s); s = fmaf(qv[8 * i + 1], __uint_as_float(w.x & 0xffff0000u), s);
              s = fmaf(qv[8 * i + 2], __uint_as_float(w.y << 16), s); s = fmaf(qv[8 * i + 3], __uint_as_float(w.y & 0xffff0000u), s);
              s = fmaf(qv[8 * i + 4], __uint_as_float(w.z << 16), s); s = fmaf(qv[8 * i + 5], __uint_as_float(w.z & 0xffff0000u), s);
              s = fmaf(qv[8 * i + 6], __uint_as_float(w.w << 16), s); s = fmaf(qv[8 * i + 7], __uint_as_float(w.w & 0xffff0000u), s); } }
        s -= slope2 * (float)dist;
        if (cum) s += (cumt - cum[kpos]) * LOG2E;
        s = valid ? s : -INFINITY;
        const float mb = wave_max(s);
        if (mb == -INFINITY) continue;
        const float mn = fmaxf(m, mb), alpha = exp2f(m - mn);
        const float p = valid ? exp2f(s - mn) : 0.f;
        l = l * alpha + wave_sum(p); o *= alpha; m = mn;
        const bf16* vb = V + (size_t)(64 * j) * 64 + lane;
#pragma unroll 8
        for (int k = 0; k < 64; ++k) o = fmaf(__shfl(p, k), bf2f(vb[(size_t)k * 64]), o);
    }
    return l > 0.f ? o / l : 0.f;
}

__device__ __forceinline__ void ph_cmp_attn(const Ctx& c, const bf16* qn, const bf16* kcmp, const bf16* vcmp, const float* gate, u64* sel, bf16* ocmp) {
    LAS float* pl = (LAS float*)(c.lds) + c.wave * 256;
    const int lane = c.lane;
    for (int it = c.gw; it < B_ * 2 * T_; it += c.ngw) {
        const int t = it % T_, bg = it / T_, b = bg >> 1, g = bg & 1;
        const int nvis = (t >= 31) ? ((t - 31) >> 4) + 1 : 0;
        const bf16* kc = kcmp + (size_t)bg * 256 * 64; const bf16* vc = vcmp + (size_t)bg * 256 * 64;
        float imp = 0.f;
        for (int hg = 0; hg < 4; ++hg) {
            const int h = g * 4 + hg; const float slope2 = alibi_slope(h + 1, 8) * LOG2E;
            const bf16* q = qn + ((size_t)(b * 8 + h) * T_ + t) * 64;
            float qv[64];
            { const u32x4* q4 = (const u32x4*)q;
#pragma unroll
              for (int i = 0; i < 8; ++i) { const u32x4 w = q4[i];
                  qv[8 * i + 0] = __uint_as_float(w.x << 16); qv[8 * i + 1] = __uint_as_float(w.x & 0xffff0000u);
                  qv[8 * i + 2] = __uint_as_float(w.y << 16); qv[8 * i + 3] = __uint_as_float(w.y & 0xffff0000u);
                  qv[8 * i + 4] = __uint_as_float(w.z << 16); qv[8 * i + 5] = __uint_as_float(w.z & 0xffff0000u);
                  qv[8 * i + 6] = __uint_as_float(w.w << 16); qv[8 * i + 7] = __uint_as_float(w.w & 0xffff0000u); } }
            float s[4]; float m = -INFINITY;
#pragma unroll
            for (int i = 0; i < 4; ++i) { const int cc = lane + 64 * i; float a = 0.f;
                if (cc < nvis) { const u32x4* k4 = (const u32x4*)(kc + (size_t)cc * 64);
#pragma unroll
                    for (int e = 0; e < 8; ++e) { const u32x4 w = k4[e];
                        a = fmaf(qv[8 * e + 0], __uint_as_float(w.x << 16), a); a = fmaf(qv[8 * e + 1], __uint_as_float(w.x & 0xffff0000u), a);
                        a = fmaf(qv[8 * e + 2], __uint_as_float(w.y << 16), a); a = fmaf(qv[8 * e + 3], __uint_as_float(w.y & 0xffff0000u), a);
                        a = fmaf(qv[8 * e + 4], __uint_as_float(w.z << 16), a); a = fmaf(qv[8 * e + 5], __uint_as_float(w.z & 0xffff0000u), a);
                        a = fmaf(qv[8 * e + 6], __uint_as_float(w.w << 16), a); a = fmaf(qv[8 * e + 7], __uint_as_float(w.w & 0xffff0000u), a); }
                    a -= slope2 * (float)(t - (16 * cc + 31)); } else a = -INFINITY;
                s[i] = a; m = fmaxf(m, a); }
            m = wave_max(m);
            float p[4], lsum = 0.f;
#pragma unroll
            for (int i = 0; i < 4; ++i) { p[i] = (lane + 64 * i < nvis) ? exp2f(s[i] - m) : 0.f; lsum += p[i]; }
            lsum = wave_sum(lsum);
            const float inv = lsum > 0.f ? 1.f / lsum : 0.f;
#pragma unroll
            for (int i = 0; i < 4; ++i) { p[i] *= inv; pl[lane + 64 * i] = p[i]; }
            asm volatile("s_waitcnt lgkmcnt(0)" ::: "memory");
            float o = 0.f;
            for (int cc = 0; cc < nvis; ++cc) o = fmaf(pl[cc], bf2f(vc[(size_t)cc * 64 + lane]), o);
            const float gt = gate[((size_t)(b * T_ + t)) * 24 + h * 3 + 0];
            ocmp[(size_t)(b * T_ + t) * 512 + h * 64 + lane] = (bf16)f2bf(gt * o);
            { const int j = lane; float a = pl[4 * j] + pl[4 * j + 1] + pl[4 * j + 2] + 0.5f * pl[4 * j + 3]; if (j > 0) a += 0.5f * pl[4 * j - 1]; imp += a; }
            asm volatile("s_waitcnt lgkmcnt(0)" ::: "memory");
        }
        const int cur = t >> 6; const int j = lane;
        u64 m64;
        if (cur <= 15) m64 = (cur == 63) ? ~0ull : ((1ull << (cur + 1)) - 1ull);
        else {
            float val = (j > cur) ? -INFINITY : ((j == 0 || j == cur || j == cur - 1) ? 1e4f : imp);
            m64 = 0ull;
            for (int r = 0; r < 16; ++r) {
                const float mx = wave_max(val);
                const u64 bal = __ballot(val == mx);
                const int w = __builtin_ctzll(bal);
                m64 |= 1ull << w; if (j == w) val = -INFINITY;
            }
        }
        if (lane == 0) sel[(size_t)bg * T_ + t] = m64;
    }
}

__device__ __forceinline__ void ph_win_attn(const Ctx& c, const bf16* qn, const bf16* kw, const bf16* vw, const float* gate, bf16* owin) {
    for (int it = c.gw; it < B_ * 8 * T_; it += c.ngw) {
        const int t = it % T_, bh = it / T_, b = bh >> 3, h = bh & 7, g = h >> 2;
        const int cur = t >> 6, jlo = (t - 511) > 0 ? (t - 511) >> 6 : 0;
        const u64 hi = (cur == 63) ? ~0ull : ((1ull << (cur + 1)) - 1ull); const u64 mask = hi & ~((1ull << jlo) - 1ull);
        const float o = naive_attn_row<64>(qn + ((size_t)bh * T_ + t) * 64, kw + (size_t)(b * 2 + g) * T_ * 64, vw + (size_t)(b * 2 + g) * T_ * 64, t, mask,
                                           alibi_slope(h + 1, 8) * LOG2E, nullptr, 512, c.lane);
        owin[(size_t)(b * T_ + t) * 512 + h * 64 + c.lane] = (bf16)f2bf(gate[(size_t)(b * T_ + t) * 24 + h * 3 + 2] * o);
    }
}
__device__ __forceinline__ void ph_slc_attn(const Ctx& c, const bf16* qn, const bf16* ks, const bf16* vs, const float* gate, const u64* sel, const bf16* ocmp, const bf16* owin, bf16* att) {
    for (int it = c.gw; it < B_ * 8 * T_; it += c.ngw) {
        const int t = it % T_, bh = it / T_, b = bh >> 3, h = bh & 7, g = h >> 2;
        const u64 mask = sel[(size_t)(b * 2 + g) * T_ + t];
        const float o = naive_attn_row<64>(qn + ((size_t)bh * T_ + t) * 64, ks + (size_t)(b * 2 + g) * T_ * 64, vs + (size_t)(b * 2 + g) * T_ * 64, t, mask,
                                           alibi_slope(h + 1, 8) * LOG2E, nullptr, 1 << 30, c.lane);
        const size_t n = (size_t)(b * T_ + t);
        const float r = gate[n * 24 + h * 3 + 1] * o + bf2f(ocmp[n * 512 + h * 64 + c.lane]) + bf2f(owin[n * 512 + h * 64 + c.lane]);
        att[n * 1024 + h * 64 + c.lane] = (bf16)f2bf(r);
    }
}
__device__ __forceinline__ void ph_fox_attn(const Ctx& c, const bf16* fq, const bf16* fk, const bf16* fv, const float* cum, bf16* att) {
    for (int it = c.gw; it < B_ * 4 * T_; it += c.ngw) {
        const int t = it % T_, bh = it / T_, b = bh >> 2, h = bh & 3;
        const int cur = t >> 6; const u64 mask = (cur == 63) ? ~0ull : ((1ull << (cur + 1)) - 1ull);
        const float o = naive_attn_row<64>(fq + ((size_t)bh * T_ + t) * 64, fk + (size_t)bh * T_ * 64, fv + (size_t)bh * T_ * 64, t, mask, 0.f, cum + (size_t)bh * T_, 1 << 30, c.lane);
        att[(size_t)(b * T_ + t) * 1024 + 512 + h * 64 + c.lane] = (bf16)f2bf(o);
    }
}
__device__ __forceinline__ void ph_diff_attn(const Ctx& c, const bf16* dq, const bf16* dk, const bf16* dv, const float* lam, const float* subln, float lambda_init, bf16* att) {
    float l1 = 0.f, l2 = 0.f;
    if (c.lane < 32) { l1 = lam[c.lane] * lam[32 + c.lane]; l2 = lam[64 + c.lane] * lam[96 + c.lane]; }
    const float lam_full = __expf(wave_sum(l1)) - __expf(wave_sum(l2)) + lambda_init;
    const float sg = subln[c.lane] * (1.f - lambda_init);
    for (int it = c.gw; it < B_ * 4 * T_; it += c.ngw) {
        const int t = it % T_, bh = it / T_, b = bh >> 2, h = bh & 3;
        const int cur = t >> 6; const u64 mask = (cur == 63) ? ~0ull : ((1ull << (cur + 1)) - 1ull);
        const float slope2 = alibi_slope(h + 1, 4) * LOG2E;
        const bf16* vb = dv + (size_t)bh * T_ * 64;
        const float o1 = naive_attn_row<32>(dq + ((size_t)(bh * 2 + 0) * T_ + t) * 32, dk + (size_t)(bh * 2 + 0) * T_ * 32, vb, t, mask, slope2, nullptr, 1 << 30, c.lane);
        const float o2 = naive_attn_row<32>(dq + ((size_t)(bh * 2 + 1) * T_ + t) * 32, dk + (size_t)(bh * 2 + 1) * T_ * 32, vb, t, mask, slope2, nullptr, 1 << 30, c.lane);
        const float o = o1 - lam_full * o2;
        const float r = rsqrtf(wave_sum(o * o) * (1.f / 64.f) + EPS);
        att[(size_t)(b * T_ + t) * 1024 + 768 + h * 64 + c.lane] = (bf16)f2bf(o * r * sg);
    }
}

__device__ __forceinline__ void ph_moe_route(const Ctx& c, const float* x, const float* g, const float* wgrp, const float* bgrp, const float* wexp, const float* bexp, bf16* hn, int* route_e, float* route_w, unsigned* cnt) {
    for (int row = c.gw; row < NT; row += c.ngw) {
        const f32x4* xr = (const f32x4*)(x + (size_t)row * D_) + c.lane;
        f32x4 v[4]; float ss = 0.f;
#pragma unroll
        for (int j = 0; j < 4; ++j) { v[j] = xr[64 * j]; ss += v[j].x * v[j].x + v[j].y * v[j].y + v[j].z * v[j].z + v[j].w * v[j].w; }
        const float r = rsqrtf(wave_sum(ss) * (1.f / D_) + EPS);
        u64* o8 = (u64*)(hn + (size_t)row * D_) + c.lane;
#pragma unroll
        for (int j = 0; j < 4; ++j) { const f32x4 gg = ((const f32x4*)g)[c.lane + 64 * j]; v[j] = v[j] * r * gg;
            o8[64 * j] = (u64)pk2(v[j].x, v[j].y) | ((u64)pk2(v[j].z, v[j].w) << 32); }
        float gl[4];
#pragma unroll
        for (int q = 0; q < 4; ++q) { float a = 0.f;
#pragma unroll
            for (int j = 0; j < 4; ++j) { const int k = 4 * (c.lane + 64 * j);
                a = fmaf(v[j].x, wgrp[(size_t)(k + 0) * 4 + q], a); a = fmaf(v[j].y, wgrp[(size_t)(k + 1) * 4 + q], a);
                a = fmaf(v[j].z, wgrp[(size_t)(k + 2) * 4 + q], a); a = fmaf(v[j].w, wgrp[(size_t)(k + 3) * 4 + q], a); }
            gl[q] = wave_sum(a) + bgrp[q]; }
        int grp = 0; float gm = gl[0];
#pragma unroll
        for (int q = 1; q < 4; ++q) if (gl[q] > gm) { gm = gl[q]; grp = q; }
        float gs = 0.f;
#pragma unroll
        for (int q = 0; q < 4; ++q) gs += __expf(gl[q] - gm);
        const float grp_gate = 1.f / gs;
        float el[8];
#pragma unroll
        for (int q = 0; q < 8; ++q) { float a = 0.f; const int col = grp * 8 + q;
#pragma unroll
            for (int j = 0; j < 4; ++j) { const int k = 4 * (c.lane + 64 * j);
                a = fmaf(v[j].x, wexp[(size_t)(k + 0) * 32 + col], a); a = fmaf(v[j].y, wexp[(size_t)(k + 1) * 32 + col], a);
                a = fmaf(v[j].z, wexp[(size_t)(k + 2) * 32 + col], a); a = fmaf(v[j].w, wexp[(size_t)(k + 3) * 32 + col], a); }
            el[q] = wave_sum(a) + bexp[col]; }
        int i0 = 0; float v0 = el[0];
#pragma unroll
        for (int q = 1; q < 8; ++q) if (el[q] > v0) { v0 = el[q]; i0 = q; }
        int i1 = -1; float v1 = -INFINITY;
#pragma unroll
        for (int q = 0; q < 8; ++q) if (q != i0 && el[q] > v1) { v1 = el[q]; i1 = q; }
        const float e1 = __expf(v1 - v0), den = 1.f + e1;
        if (c.lane == 0) { const float w0 = grp_gate / den, w1 = grp_gate * e1 / den;
            const int lo = i0 < i1 ? i0 : i1, hi = i0 < i1 ? i1 : i0, cls = grp * 28 + lo * 8 - (lo * (lo + 1)) / 2 + (hi - lo - 1);
            const unsigned rank = __hip_atomic_fetch_add(cnt + cls, 1u, __ATOMIC_RELAXED, __HIP_MEMORY_SCOPE_AGENT);
            route_e[row] = (int)(((unsigned)cls << 24) | rank); route_w[2 * row] = i0 < i1 ? w0 : w1; route_w[2 * row + 1] = i0 < i1 ? w1 : w0; }
    }
}
__device__ __forceinline__ void ph_moe_naive(const Ctx& c, const bf16* hn, const int* route_e, const float* route_w, const float* wg, const float* wu, const float* wd, float* x) {
    LAS float* hs = (LAS float*)c.lds;
    LAS float* au = hs + 1024;
    LAS float* h2 = au + 512;
    for (int row = c.bid; row < NT; row += c.G) {
        __syncthreads();
        hs[c.tid] = bf2f(hn[(size_t)row * D_ + c.tid]); hs[c.tid + 512] = bf2f(hn[(size_t)row * D_ + c.tid + 512]);
        float o0 = 0.f, o1 = 0.f;
        for (int s = 0; s < 2; ++s) {
            const int e = route_e[2 * row + s]; const float w = route_w[2 * row + s];
            __syncthreads();
            const float* W = (c.tid < 256 ? wg : wu) + (size_t)e * D_ * DEXP + (c.tid & 255);
            float a = 0.f;
            for (int k = 0; k < D_; ++k) a = fmaf(hs[k], W[(size_t)k * DEXP], a);
            au[c.tid] = a;
            __syncthreads();
            if (c.tid < 256) { const float ga = au[c.tid], up = au[c.tid + 256]; h2[c.tid] = ga / (1.f + __expf(-ga)) * up * w; }
            __syncthreads();
            const float* Wd = wd + (size_t)e * DEXP * D_;
            for (int k = 0; k < DEXP; ++k) { const float hv = h2[k]; o0 = fmaf(hv, Wd[(size_t)k * D_ + c.tid], o0); o1 = fmaf(hv, Wd[(size_t)k * D_ + c.tid + 512], o1); }
        }
        x[(size_t)row * D_ + c.tid] += o0; x[(size_t)row * D_ + c.tid + 512] += o1;
    }
    __syncthreads();
}

typedef __attribute__((address_space(4))) const Params* KP;
__device__ __forceinline__ KP uni_kp(KP p) { const unsigned long long v = (unsigned long long)p; const unsigned lo = __builtin_amdgcn_readfirstlane((unsigned)v), hi = __builtin_amdgcn_readfirstlane((unsigned)(v >> 32)); return (KP)(((unsigned long long)hi << 32) | lo); }
constexpr int PH_PER_LAYER = 11, N_PHASES = L_ * PH_PER_LAYER + 2;
__device__ __forceinline__ Ctx make_ctx(KP p) {
    Ctx c; c.lds = (LAS unsigned char*)lds_raw; { int t_ = threadIdx.x; asm volatile("" : "+v"(t_)); c.tid = t_; } c.lane = c.tid & 63; c.wave = __builtin_amdgcn_readfirstlane(c.tid >> 6);
    c.bid = blockIdx.x; c.G = gridDim.x; c.gw = c.bid * NWAVES + c.wave; c.ngw = c.G * NWAVES; c.in = nullptr; c.xcur = p->out; c.ws = p->ws;
    return c;
}
struct Bufs {
    bf16 *QN, *KV6, *KC, *VC, *KS, *VS, *KW, *VW, *FQ, *FK, *FV, *DQ, *DK, *DV, *HC, *KCMP, *VCMP, *OCMP, *OWIN, *HN, *ATT;
    float *GATE, *FL, *ROUTE_W; u64* SEL; int* ROUTE_E;
};
__device__ __forceinline__ Bufs make_bufs(unsigned char* ws) {
    Bufs b;
    b.QN = (bf16*)(ws + WS_QN); b.KV6 = (bf16*)(ws + WS_KV6);
    b.KC = (bf16*)(ws + WS_KV6 + 0 * KV6_STRIDE); b.VC = (bf16*)(ws + WS_KV6 + 1 * KV6_STRIDE);
    b.KS = (bf16*)(ws + WS_KV6 + 2 * KV6_STRIDE); b.VS = (bf16*)(ws + WS_KV6 + 3 * KV6_STRIDE);
    b.KW = (bf16*)(ws + WS_KV6 + 4 * KV6_STRIDE); b.VW = (bf16*)(ws + WS_KV6 + 5 * KV6_STRIDE);
    b.FQ = (bf16*)(ws + WS_FQKV); b.FK = b.FQ + 8 * MiB; b.FV = b.FQ + 16 * MiB;
    b.DQ = (bf16*)(ws + WS_DQK); b.DK = b.DQ + 8 * MiB; b.DV = (bf16*)(ws + WS_DV);
    b.GATE = (float*)(ws + WS_GATE); b.FL = (float*)(ws + WS_FL);
    b.HC = (bf16*)(ws + WS_HC); b.KCMP = (bf16*)(ws + WS_KVCMP); b.VCMP = b.KCMP + 16 * 256 * 64;
    b.SEL = (u64*)(ws + WS_SEL); b.OCMP = (bf16*)(ws + WS_OCMP); b.OWIN = (bf16*)(ws + WS_OWIN);
    b.HN = (bf16*)(ws + WS_HN); b.ATT = (bf16*)(ws + WS_ATT);
    b.ROUTE_E = (int*)(ws + WS_ROUTE); b.ROUTE_W = (float*)(ws + WS_ROUTE + 512 * 1024);
    return b;
}
__device__ __forceinline__ float lambda_init_of(int l) { return l == 0 ? 0.2f : 0.35550906759096926f; }

__device__ __noinline__ void P_prologue(KP p_) { const KP p = uni_kp(p_);
    const Ctx c = make_ctx(p); unsigned char* ws = p->ws;
    LAS float* scr = (LAS float*)(c.lds) + c.wave * (64 * 33);
    constexpr int I_A = 16 * 40, I_B = 16 * 24, I_C = 16 * 24, I_O = 16 * 32, I_G = 16 * 8, I_D = 4 * 32, I_E = 2 * I_G + I_D, I_W1 = 32 * 8, I_W2 = 4 * 2;
    constexpr int PER_L = I_A + I_B + I_C + I_O + 2 * (I_W1 + I_W2);
    for (int it = c.gw; it < L_ * PER_L; it += c.ngw) {
        const int l = it / PER_L; int r = it % PER_L;
        const float* W; bf16* WT; int ldw, K, sc0, ncol, r0 = 0, rmul = 1;
        if (r < I_A + I_B + I_C) { W = p->in[2] + (size_t)l * D_ * D_IN; WT = (bf16*)(ws + WS_WIN_T) + (size_t)l * NIN * D_; ldw = D_IN; K = D_;
            if (r < I_A) { sc0 = 0; ncol = 1280; r0 = 0; } else if (r < I_A + I_B) { r -= I_A; sc0 = C_FQ; ncol = 768; r0 = 1280; } else { r -= I_A + I_B; sc0 = C_DQ; ncol = 768; r0 = 2048; } }
        else if ((r -= I_A + I_B + I_C) < I_O) { W = p->in[13] + (size_t)l * D_ * D_; WT = (bf16*)(ws + WS_WOUT_T) + (size_t)l * D_ * D_; ldw = D_; K = D_; sc0 = 0; ncol = 1024; }
        else { r -= I_O; const int kv = r / (I_W1 + I_W2); r = r % (I_W1 + I_W2); const size_t lk = (size_t)l * 2 + kv;
            if (r < I_W1) { W = p->in[kv == 0 ? 6 : 9] + (size_t)l * 2048 * 256; WT = (bf16*)(ws + WS_W1_T) + lk * 256 * 2048; ldw = 256; K = 2048; sc0 = 0; ncol = 256; }
            else { r -= I_W1; W = p->in[kv == 0 ? 7 : 10] + (size_t)l * 256 * 64; WT = (bf16*)(ws + WS_W2_T) + lk * 64 * 256; ldw = 64; K = 256; sc0 = 0; ncol = 64; } }
        transpose_seg(W, ldw, K, sc0, ncol, WT, r0, rmul, r, scr, c.lane);
    }
    for (int i = c.bid * NTHREADS + c.tid; i < L_ * 256 * D_; i += c.G * NTHREADS) {
        const int l = i / (256 * D_), rr = (i / D_) % 256, k = i % D_;
        const float* win = p->in[2] + (size_t)l * D_ * D_IN;
        float v = 0.f; if (rr < 24) v = win[(size_t)k * D_IN + C_GATE + rr]; else if (rr < 28) v = win[(size_t)k * D_IN + C_FF + (rr - 24)];
        ((bf16*)(ws + WS_WIN_T))[((size_t)l * NIN + 2816 + rr) * D_ + k] = (bf16)f2bf(v);
    }
    for (int w = c.gw; w < L_ * 2 * 4 * 128; w += c.ngw) {
        const int lk = w >> 9, cg = (w >> 7) & 3, kc = w & 127, l = lk >> 1, kv = lk & 1, j = cg * 64 + c.lane;
        const float* pe = p->in[kv == 0 ? 5 : 8] + (size_t)l * 2048 + kc * 16; const float* w1 = p->in[kv == 0 ? 6 : 9] + (size_t)l * 2048 * 256 + (size_t)kc * 16 * 256;
        float a = 0.f;
#pragma unroll
        for (int k = 0; k < 16; ++k) a = fmaf(pe[k], w1[(size_t)k * 256 + j], a);
        ((float*)(ws + WS_B1PART))[((size_t)lk * 128 + kc) * 256 + j] = a;
    }
    for (int i = c.bid * NTHREADS + c.tid; i < L_ * 64 * 2 * 64; i += c.G * NTHREADS) {
        const int l = i / (64 * 2 * 64), ks = (i / 128) % 64, cb = (i / 64) & 1, lane = i & 63, col = 32 * cb + (lane & 31);
        unsigned hi[4], lo[4];
#pragma unroll
        for (int jp = 0; jp < 4; ++jp) { float v[2];
#pragma unroll
            for (int e = 0; e < 2; ++e) { const int k = 16 * ks + 8 * (lane >> 5) + 2 * jp + e; const float g = p->in[14][(size_t)l * D_ + k];
                v[e] = col < 4 ? g * p->in[15][((size_t)l * D_ + k) * 4 + col] : (col < 36 ? g * p->in[17][((size_t)l * D_ + k) * 32 + (col - 4)] : 0.f); }
            const unsigned h0 = f2bf(v[0]), h1 = f2bf(v[1]); hi[jp] = h0 | (h1 << 16);
            lo[jp] = f2bf(v[0] - __uint_as_float(h0 << 16)) | (f2bf(v[1] - __uint_as_float(h1 << 16)) << 16); }
        u32x4* dst = (u32x4*)(ws + WS_WR) + ((size_t)((l * 64 + ks) * 2 + cb) * 2) * 64 + lane;
        dst[0] = (u32x4){hi[0], hi[1], hi[2], hi[3]}; dst[64] = (u32x4){lo[0], lo[1], lo[2], lo[3]};
    }
}
__device__ __forceinline__ void P_inproj_mfma(int l_) { const KP p = (KP)__builtin_amdgcn_kernarg_segment_ptr(); int l = l_; asm volatile("" : "+s"(l));
    unsigned char* ws = p->ws; asm volatile("" : "+s"(ws));
    PlainOrder S; S.init(p->out, (const bf16*)(ws + WS_WIN_T) + (size_t)l * NIN * D_, D_, D_, NT, NIN, (int)gridDim.x, launder_s((int)blockIdx.x));
#ifdef STAGGER_TICKS
    { const unsigned long long t0 = __builtin_amdgcn_s_memrealtime(); const unsigned long long d = (unsigned long long)((launder_s((int)blockIdx.x) >> 3) & 3) * STAGGER_TICKS;
      while (__builtin_amdgcn_s_memrealtime() - t0 < d) __builtin_amdgcn_s_sleep(4); }
#endif
    const pg8::Gemm g{D_, D_, D_, D_ / 64, 0, 0};
    const EpiInProj E{ws, p->in[3] + l * 24, p->in[4] + l * 4, (unsigned*)(ws + WS_CTL) + CW_KN + l * 8192};
    pg8::gemm_phase<EpiInProj, PlainOrder, INPROJ_ALIGN, INPROJ_SP2>((LAS unsigned char*)lds_raw, g, S, E);
}
__device__ __forceinline__ void P_inproj_dummy(int l_) { const KP p = (KP)__builtin_amdgcn_kernarg_segment_ptr(); int l = l_; asm volatile("" : "+s"(l));
    unsigned char* ws = p->ws; asm volatile("" : "+s"(ws));
    PlainOrder S; S.init(p->out, (const bf16*)(ws + WS_WIN_T) + (size_t)l * NIN * D_, D_, D_, NT, NIN, (int)gridDim.x, launder_s((int)blockIdx.x));
    const pg8::Gemm g{D_, D_, D_, D_ / 64, 0, 0};
    const EpiDummy E{(float*)(ws + WS_HB)};
    pg8::gemm_phase<EpiDummy, PlainOrder, true, true>((LAS unsigned char*)lds_raw, g, S, E);
}
__device__ __forceinline__ void P_outproj_mfma(int l_) { const KP p = (KP)__builtin_amdgcn_kernarg_segment_ptr(); int l = l_; asm volatile("" : "+s"(l));
    unsigned char* ws = p->ws; asm volatile("" : "+s"(ws));
    PlainOrder S; S.init(ws + WS_ATT, (const bf16*)(ws + WS_WOUT_T) + (size_t)l * D_ * D_, D_, D_, NT, D_, (int)gridDim.x, launder_s((int)blockIdx.x));
    const pg8::Gemm g{D_, D_, D_, D_ / 64, 32, 8};
    const EpiResBf16 E{(bf16*)(ws + WS_HN)};
    pg8::gemm_phase<EpiResBf16, PlainOrder, true, true>((LAS unsigned char*)lds_raw, g, S, E);
}
__device__ __forceinline__ float wave_max_l(float v, int lane) {
#pragma unroll
    for (int o = 1; o < 64; o <<= 1) v = fmaxf(v, shflx_f(v, o, lane));
    return v;
}
__device__ __forceinline__ float wave_min_l(float v, int lane) {
#pragma unroll
    for (int o = 1; o < 64; o <<= 1) v = fminf(v, shflx_f(v, o, lane));
    return v;
}
template <int NS> __device__ __forceinline__ float q_norm2_max(const bf16x8v (&Q)[NS], int lane) {
    float ss = 0.f;
#pragma unroll
    for (int s = 0; s < NS; ++s)
#pragma unroll
        for (int e = 0; e < 8; ++e) { const float v = __uint_as_float(((unsigned)(unsigned short)Q[s][e]) << 16); ss = fmaf(v, v, ss); }
    return wave_max_l(swap_sum(ss), lane);
}
__device__ __forceinline__ u64 prune_consensus(bool skip, LAS u64* slots, int wave, int lane) {
    const u64 mine = __ballot(skip);
    __syncthreads();
    if (lane == 0) slots[wave] = mine;
    __syncthreads();
    u64 all = slots[0];
#pragma unroll
    for (int w = 1; w < NWAVES; ++w) all &= slots[w];
    return all;
}
__device__ __forceinline__ void U_fox(KP p_, int bh_, int qb_, int l_) {
    const KP p = uni_kp(p_); const int bh = __builtin_amdgcn_readfirstlane(bh_), qb = __builtin_amdgcn_readfirstlane(qb_), l = __builtin_amdgcn_readfirstlane(l_);
    int tid_ = threadIdx.x; asm volatile("" : "+v"(tid_));
    const int tid = tid_, lane = tid & 63, wave = __builtin_amdgcn_readfirstlane(tid >> 6), r = lane & 31, h = lane >> 5;
    unsigned char* ws = p->ws; asm volatile("" : "+s"(ws)); LAS unsigned char* L = (LAS unsigned char*)lds_raw;
    const int tw0 = 256 * qb + 32 * wave, t_lane = tw0 + r, b = bh >> 2, hd = bh & 3;
    const bf16* q = (const bf16*)(ws + WS_FQKV) + (size_t)bh * T_ * 64 + (t_lane >> 4) * 1024 + (t_lane & 15) * 32 + 8 * h;
    bf16x8v Qf[1][4];
#pragma unroll
    for (int s = 0; s < 4; ++s) Qf[0][s] = *(const bf16x8v*)(q + (s >> 1) * 512 + (s & 1) * 16);
    const bf16* Kp = (const bf16*)(ws + WS_FQKV) + 8 * MiB + (size_t)bh * T_ * 64; const bf16* Vp = (const bf16*)(ws + WS_FQKV) + 16 * MiB + (size_t)bh * T_ * 64;
    u32x4 kpre, vpre; attn_preload<64>(Kp, nullptr, Vp, 4 * qb + 3, tid, kpre, vpre);
    LAS float* cum = (LAS float*)(L + A_LDS_END);
    { const float* fl = (const float*)(ws + WS_FL) + (size_t)bh * T_; LAS float* tot = cum + 4096;
      const int nval = 256 * (qb + 1); float v[8];
      if (8 * tid < nval) { const f32x4 a = *(const f32x4*)(fl + 8 * tid), c2 = *(const f32x4*)(fl + 8 * tid + 4); v[0] = a.x; v[1] = a.y; v[2] = a.z; v[3] = a.w; v[4] = c2.x; v[5] = c2.y; v[6] = c2.z; v[7] = c2.w; }
      else {
#pragma unroll
          for (int i = 0; i < 8; ++i) v[i] = 0.f; }
#pragma unroll
      for (int i = 1; i < 8; ++i) v[i] += v[i - 1];
      float sc = v[7];
#pragma unroll
      for (int o = 1; o < 64; o <<= 1) { const float up = __uint_as_float((unsigned)__builtin_amdgcn_ds_bpermute((lane - o) << 2, (int)__float_as_uint(sc))); if (lane >= o) sc += up; }
      if (lane == 63) tot[wave] = sc;
      __syncthreads();
      float base = sc - v[7];
      for (int w = 0; w < wave; ++w) base += tot[w];
      if (8 * tid < nval) {
#pragma unroll
          for (int i = 0; i < 8; ++i) cum[8 * tid + i] = v[i] + base; }
      __syncthreads(); }
    f32x16 O[1][2]; float M[1] = {0.f}, Ls[1] = {0.f};
#pragma unroll
    for (int i = 0; i < 16; ++i) { O[0][0][i] = 0.f; O[0][1][i] = 0.f; }
    const u64 tm = (qb == 15) ? ~0ull : ((1ull << (4 * qb + 4)) - 1ull);
#if AC2_MODE == 0
    {
        const u64 low = (1ull << (4 * qb)) - 1ull; const float cref = cum[256 * qb];
        attn_core<64, 1, true, false, true>(L, Kp, nullptr, Vp, cum, cref, Qf, tm & ~low, t_lane, tw0, 1 << 30, 0.f, 0u, 0u, O, M, Ls, tid, false, 4 * qb + 3, kpre, vpre);
        if (qb > 0) {
            const float qn2 = q_norm2_max<4>(Qf[0], lane), mmin = wave_min_l(M[0], lane);
            const float* kn = (const float*)((const unsigned*)(ws + WS_CTL) + CW_KN + l * 8192) + ((size_t)bh * 64 + lane) * 2;
            bool skip = false;
            if (lane < 4 * qb) { const float kn2 = kn[0] + kn[1]; const float bound = sqrtf(qn2 * kn2) * 1.02f + (cref - cum[64 * lane + 63]) * LOG2E - mmin; skip = bound < -152.f; }
            const u64 drop = prune_consensus(skip, (LAS u64*)(cum + 4096 + 16), wave, lane);
            const u64 tm2 = low & ~drop;
            if (tm2) attn_core<64, 1, true, false>(L, Kp, nullptr, Vp, cum, cref, Qf, tm2, t_lane, tw0, 1 << 30, 0.f, 0u, 0u, O, M, Ls, tid, true);
        }
    }
#else
    attn_core2<true, false>(L, (const bf16*)(ws + WS_FQKV) + 8 * MiB + (size_t)bh * T_ * 64, (const bf16*)(ws + WS_FQKV) + 16 * MiB + (size_t)bh * T_ * 64, cum, cum[256 * qb],
                            Qf[0], tm, t_lane, tw0, 1 << 30, 0.f, 0u, 0u, O[0], M[0], Ls[0], tid);
#endif
    const float lt = swap_sum(Ls[0]), inv = lt > 0.f ? 1.f / lt : 0.f;
    bf16* dst = (bf16*)(ws + WS_ATT) + mix_off((size_t)b * T_ + t_lane, 512 + hd * 64 + 4 * h, 1024);
    ATTN_FOR_CHUNKS(db, g4) { const unsigned w0 = cvtpk(O[0][db][4 * g4 + 0] * inv, O[0][db][4 * g4 + 1] * inv), w1 = cvtpk(O[0][db][4 * g4 + 2] * inv, O[0][db][4 * g4 + 3] * inv);
        *(u64*)(dst + (4 * db + g4) * 256) = (u64)w0 | ((u64)w1 << 32); }
}
__device__ __forceinline__ void U_diff(KP p_, int bh_, int qb_, int l_) {
    const KP p = uni_kp(p_); const int bh = __builtin_amdgcn_readfirstlane(bh_), qb = __builtin_amdgcn_readfirstlane(qb_), l = __builtin_amdgcn_readfirstlane(l_);
    int tid_ = threadIdx.x; asm volatile("" : "+v"(tid_));
    const int tid = tid_, lane = tid & 63, wave = __builtin_amdgcn_readfirstlane(tid >> 6), r = lane & 31, h = lane >> 5;
    unsigned char* ws = p->ws; asm volatile("" : "+s"(ws)); LAS unsigned char* L = (LAS unsigned char*)lds_raw;
    const int tw0 = 256 * qb + 32 * wave, t_lane = tw0 + r, b = bh >> 2, hd = bh & 3;
    const bf16* DQ = (const bf16*)(ws + WS_DQK); const bf16* DK = DQ + 8 * MiB;
    bf16x8v Qf[2][2];
#pragma unroll
    for (int mp = 0; mp < 2; ++mp)
#pragma unroll
        for (int s = 0; s < 2; ++s) Qf[mp][s] = *(const bf16x8v*)(DQ + ((size_t)(bh * 2 + mp) * T_ + t_lane) * 32 + 16 * s + 8 * h);
    f32x16 O[2][2]; float M[2] = {0.f, 0.f}, Ls[2] = {0.f, 0.f};
#pragma unroll
    for (int i = 0; i < 16; ++i) { O[0][0][i] = 0.f; O[0][1][i] = 0.f; O[1][0][i] = 0.f; O[1][1][i] = 0.f; }
    const u64 tm = (qb == 15) ? ~0ull : ((1ull << (4 * qb + 4)) - 1ull);
    {
        const u64 low = (1ull << (4 * qb)) - 1ull; const float slope2 = alibi_slope(hd + 1, 4) * LOG2E;
        const bf16* K0 = DK + (size_t)(bh * 2 + 0) * T_ * 32; const bf16* K1 = DK + (size_t)(bh * 2 + 1) * T_ * 32; const bf16* Vp = (const bf16*)(ws + WS_DV) + (size_t)bh * T_ * 64;
        attn_core<32, 2, false, false>(L, K0, K1, Vp, nullptr, 0.f, Qf, tm & ~low, t_lane, tw0, 1 << 30, slope2, 0u, 0u, O, M, Ls, tid);
        if (qb > 0) {
            const float qa = q_norm2_max<2>(Qf[0], lane), qb2 = q_norm2_max<2>(Qf[1], lane), ma = wave_min_l(M[0], lane), mb = wave_min_l(M[1], lane);
            const float* kn = (const float*)((const unsigned*)(ws + WS_CTL) + CW_KN + l * 8192 + 4096) + (size_t)(bh * 2) * 64 + lane;
            bool skip = false;
            if (lane < 4 * qb) { const float bmax = slope2 * (float)(64 * lane + 63 - tw0);
                skip = (sqrtf(qa * kn[0]) * 1.02f + bmax - ma < -152.f) && (sqrtf(qb2 * kn[64]) * 1.02f + bmax - mb < -152.f); }
            const u64 drop = prune_consensus(skip, (LAS u64*)(L + A_LDS_END), wave, lane);
            const u64 tm2 = low & ~drop;
            if (tm2) attn_core<32, 2, false, false>(L, K0, K1, Vp, nullptr, 0.f, Qf, tm2, t_lane, tw0, 1 << 30, slope2, 0u, 0u, O, M, Ls, tid, true);
        }
    }
    const float* lam = p->in[11] + (size_t)l * 128; const float* subln = p->in[12] + (size_t)l * 64;
    float l1 = 0.f, l2 = 0.f; if (lane < 32) { l1 = lam[lane] * lam[32 + lane]; l2 = lam[64 + lane] * lam[96 + lane]; }
    const float li = lambda_init_of(l), lam_full = __expf(wave_sum_l(l1, lane)) - __expf(wave_sum_l(l2, lane)) + li;
    const float lt0 = swap_sum(Ls[0]), lt1 = swap_sum(Ls[1]), i0 = lt0 > 0.f ? 1.f / lt0 : 0.f, i1 = (lt1 > 0.f ? 1.f / lt1 : 0.f) * lam_full;
    float ss = 0.f;
#pragma unroll
    for (int db = 0; db < 2; ++db)
#pragma unroll
        for (int i = 0; i < 16; ++i) { const float o = O[0][db][i] * i0 - O[1][db][i] * i1; O[0][db][i] = o; ss += o * o; }
    ss = swap_sum(ss);
    const float rn = rsqrtf(ss * (1.f / 64.f) + EPS) * (1.f - li);
    bf16* dst = (bf16*)(ws + WS_ATT) + mix_off((size_t)b * T_ + t_lane, 768 + hd * 64 + 4 * h, 1024);
    ATTN_FOR_CHUNKS(db, g4) { const f32x4 sg = *(const f32x4*)(subln + 32 * db + 8 * g4 + 4 * h);
        const unsigned w0 = cvtpk(O[0][db][4 * g4 + 0] * rn * sg.x, O[0][db][4 * g4 + 1] * rn * sg.y), w1 = cvtpk(O[0][db][4 * g4 + 2] * rn * sg.z, O[0][db][4 * g4 + 3] * rn * sg.w);
        *(u64*)(dst + (4 * db + g4) * 256) = (u64)w0 | ((u64)w1 << 32); }
}
__device__ __forceinline__ void U_win(KP p_, int bg_, int c_) {
    const KP p = uni_kp(p_); const int bg = __builtin_amdgcn_readfirstlane(bg_), cc = __builtin_amdgcn_readfirstlane(c_);
    int tid_ = threadIdx.x; asm volatile("" : "+v"(tid_));
    const int tid = tid_, lane = tid & 63, wave = __builtin_amdgcn_readfirstlane(tid >> 6), r = lane & 31, h = lane >> 5;
    unsigned char* ws = p->ws; asm volatile("" : "+s"(ws)); LAS unsigned char* L = (LAS unsigned char*)lds_raw;
    const int b = bg >> 1, g = bg & 1, hd = g * 4 + (wave >> 1), tw0 = 64 * cc + 32 * (wave & 1), t_lane = tw0 + r;
    const bf16* q = (const bf16*)(ws + WS_QN) + (size_t)(b * 8 + hd) * T_ * 64 + (t_lane >> 4) * 1024 + (t_lane & 15) * 32 + 8 * h;
    bf16x8v Qf[1][4];
#pragma unroll
    for (int s = 0; s < 4; ++s) Qf[0][s] = *(const bf16x8v*)(q + (s >> 1) * 512 + (s & 1) * 16);
    f32x16 O[1][2]; float M[1] = {0.f}, Ls[1] = {0.f};
#pragma unroll
    for (int i = 0; i < 16; ++i) { O[0][0][i] = 0.f; O[0][1][i] = 0.f; }
    const size_t n = (size_t)b * T_ + t_lane;
    const float gate_w = ((const float*)(ws + WS_GATE))[n * 24 + hd * 3 + 2];
    const int jlo = cc > 8 ? cc - 8 : 0;
    const u64 hi = (cc == 63) ? ~0ull : ((1ull << (cc + 1)) - 1ull), tm = hi & ~((1ull << jlo) - 1ull);
#if AC2_MODE == 0
    attn_core<64, 1, false, false>(L, (const bf16*)(ws + WS_KV6 + 4 * KV6_STRIDE) + (size_t)bg * T_ * 64, nullptr, (const bf16*)(ws + WS_KV6 + 5 * KV6_STRIDE) + (size_t)bg * T_ * 64, nullptr, 0.f,
                                   Qf, tm, t_lane, tw0, 512, alibi_slope(hd + 1, 8) * LOG2E, 0u, 0u, O, M, Ls, tid);
#ifdef PROBE_WINCORE2
    attn_core<64, 1, false, false>(L, (const bf16*)(ws + WS_KV6 + 4 * KV6_STRIDE) + (size_t)bg * T_ * 64, nullptr, (const bf16*)(ws + WS_KV6 + 5 * KV6_STRIDE) + (size_t)bg * T_ * 64, nullptr, 0.f,
                                   Qf, tm, t_lane, tw0, 512, alibi_slope(hd + 1, 8) * LOG2E, 0u, 0u, O, M, Ls, tid, true);
#endif
#else
    attn_core2<false, false>(L, (const bf16*)(ws + WS_KV6 + 4 * KV6_STRIDE) + (size_t)bg * T_ * 64, (const bf16*)(ws + WS_KV6 + 5 * KV6_STRIDE) + (size_t)bg * T_ * 64, nullptr, 0.f,
                             Qf[0], tm, t_lane, tw0, 512, alibi_slope(hd + 1, 8) * LOG2E, 0u, 0u, O[0], M[0], Ls[0], tid);
#endif
    const float lt = swap_sum(Ls[0]), inv = (lt > 0.f ? 1.f / lt : 0.f) * gate_w;
    bf16* dst = (bf16*)(ws + WS_OWIN) + mix_off(n, hd * 64 + 4 * h, 512);
    ATTN_FOR_CHUNKS(db, g4) { const unsigned w0 = cvtpk(O[0][db][4 * g4 + 0] * inv, O[0][db][4 * g4 + 1] * inv), w1 = cvtpk(O[0][db][4 * g4 + 2] * inv, O[0][db][4 * g4 + 3] * inv);
        *(u64*)(dst + (4 * db + g4) * 256) = (u64)w0 | ((u64)w1 << 32); }
}
__device__ __forceinline__ void U_slc(KP p_, int bg_, int c_) {
    const KP p = uni_kp(p_); const int bg = __builtin_amdgcn_readfirstlane(bg_), cc = __builtin_amdgcn_readfirstlane(c_);
    int tid_ = threadIdx.x; asm volatile("" : "+v"(tid_));
    const int tid = tid_, lane = tid & 63, wave = __builtin_amdgcn_readfirstlane(tid >> 6), r = lane & 31, h = lane >> 5;
    unsigned char* ws = p->ws; asm volatile("" : "+s"(ws)); LAS unsigned char* L = (LAS unsigned char*)lds_raw;
    const int b = bg >> 1, g = bg & 1, hd = g * 4 + (wave >> 1), tw0 = 64 * cc + 32 * (wave & 1), t_lane = tw0 + r;
    const bf16* q = (const bf16*)(ws + WS_QN) + (size_t)(b * 8 + hd) * T_ * 64 + (t_lane >> 4) * 1024 + (t_lane & 15) * 32 + 8 * h;
    bf16x8v Qf[1][4];
#pragma unroll
    for (int s = 0; s < 4; ++s) Qf[0][s] = *(const bf16x8v*)(q + (s >> 1) * 512 + (s & 1) * 16);
    f32x16 O[1][2]; float M[1] = {0.f}, Ls[1] = {0.f};
#pragma unroll
    for (int i = 0; i < 16; ++i) { O[0][0][i] = 0.f; O[0][1][i] = 0.f; }
    const bf16* Ksl = (const bf16*)(ws + WS_KV6 + 2 * KV6_STRIDE) + (size_t)bg * T_ * 64; const bf16* Vsl = (const bf16*)(ws + WS_KV6 + 3 * KV6_STRIDE) + (size_t)bg * T_ * 64;
    u32x4 kpre, vpre; attn_preload<64>(Ksl, nullptr, Vsl, cc, tid, kpre, vpre);
    const size_t n = (size_t)b * T_ + t_lane;
    const float gate_s = ((const float*)(ws + WS_GATE))[n * 24 + hd * 3 + 1];
    const bf16* oc = (const bf16*)(ws + WS_OCMP) + mix_off(n, hd * 64 + 4 * h, 512); const bf16* ow = (const bf16*)(ws + WS_OWIN) + mix_off(n, hd * 64 + 4 * h, 512);
    u64 ocv[8], owv[8];
    ATTN_FOR_CHUNKS(db, g4) { ocv[4 * db + g4] = *(const u64*)(oc + (4 * db + g4) * 256); owv[4 * db + g4] = *(const u64*)(ow + (4 * db + g4) * 256); }
    const u64* sel = (const u64*)(ws + WS_SEL) + (size_t)bg * T_;
    const u64 mine = sel[t_lane]; u64 un = sel[64 * cc + lane];
    { unsigned ul = (unsigned)un, uh = (unsigned)(un >> 32);
#pragma unroll
      for (int o = 1; o < 64; o <<= 1) { ul |= shflx_u(ul, o, lane); uh |= shflx_u(uh, o, lane); }
      un = ((u64)__builtin_amdgcn_readfirstlane(uh) << 32) | __builtin_amdgcn_readfirstlane(ul); }
#if AC2_MODE == 0
    attn_core<64, 1, false, true, true>(L, Ksl, nullptr, Vsl, nullptr, 0.f,
                                  Qf, un, t_lane, tw0, 1 << 30, alibi_slope(hd + 1, 8) * LOG2E, (unsigned)mine, (unsigned)(mine >> 32), O, M, Ls, tid, false, cc, kpre, vpre);
#else
    attn_core2<false, true>(L, (const bf16*)(ws + WS_KV6 + 2 * KV6_STRIDE) + (size_t)bg * T_ * 64, (const bf16*)(ws + WS_KV6 + 3 * KV6_STRIDE) + (size_t)bg * T_ * 64, nullptr, 0.f,
                            Qf[0], un, t_lane, tw0, 1 << 30, alibi_slope(hd + 1, 8) * LOG2E, (unsigned)mine, (unsigned)(mine >> 32), O[0], M[0], Ls[0], tid);
#endif
    const float lt = swap_sum(Ls[0]), inv = (lt > 0.f ? 1.f / lt : 0.f) * gate_s;
    bf16* dst = (bf16*)(ws + WS_ATT) + mix_off(n, hd * 64 + 4 * h, 1024);
    ATTN_FOR_CHUNKS(db, g4) { const u64 a = ocv[4 * db + g4], w = owv[4 * db + g4];
        const float x0 = O[0][db][4 * g4 + 0] * inv + __uint_as_float((unsigned)a << 16) + __uint_as_float((unsigned)w << 16);
        const float x1 = O[0][db][4 * g4 + 1] * inv + __uint_as_float((unsigned)a & 0xffff0000u) + __uint_as_float((unsigned)w & 0xffff0000u);
        const float x2 = O[0][db][4 * g4 + 2] * inv + __uint_as_float((unsigned)(a >> 32) << 16) + __uint_as_float((unsigned)(w >> 32) << 16);
        const float x3 = O[0][db][4 * g4 + 3] * inv + __uint_as_float((unsigned)(a >> 32) & 0xffff0000u) + __uint_as_float((unsigned)(w >> 32) & 0xffff0000u);
        *(u64*)(dst + (4 * db + g4) * 256) = (u64)cvtpk(x0, x1) | ((u64)cvtpk(x2, x3) << 32); }
}
__device__ __forceinline__ float other_half(float x, int h) { auto rr = __builtin_amdgcn_permlane32_swap(__float_as_uint(x), __float_as_uint(x), false, false); return __uint_as_float(h ? rr[0] : rr[1]); }
__device__ __forceinline__ int other_half_i(int x, int h) { auto rr = __builtin_amdgcn_permlane32_swap((unsigned)x, (unsigned)x, false, false); return (int)(h ? rr[0] : rr[1]); }
template <bool MASK>
__device__ __forceinline__ void cmp_scores(f32x16& p0, f32x16& p1, const LAS unsigned char* kt, const bf16x8v (&Qf)[4], float b0, float s1, int cl, int nvis_l) {
    const float s8 = s1 * 8.f, s32 = s1 * 32.f;
    p0[0] = b0; p0[1] = p0[0] + s1; p0[2] = p0[1] + s1; p0[3] = p0[2] + s1;
#pragma unroll
    for (int reg = 4; reg < 16; ++reg) p0[reg] = p0[reg - 4] + s8;
#pragma unroll
    for (int reg = 0; reg < 16; ++reg) p1[reg] = p0[reg] + s32;
#pragma unroll
    for (int s = 0; s < 4; ++s) { const bf16x8v kf0 = *(const LAS bf16x8v*)(kt + s * 32), kf1 = *(const LAS bf16x8v*)(kt + 32 * 144 + s * 32);
        p0 = __builtin_amdgcn_mfma_f32_32x32x16_bf16(kf0, Qf[s], p0, 0, 0, 0); p1 = __builtin_amdgcn_mfma_f32_32x32x16_bf16(kf1, Qf[s], p1, 0, 0, 0); }
    if (MASK) {
#pragma unroll
        for (int reg = 0; reg < 16; ++reg) { const int c = cl + crow0(reg); p0[reg] = (c < nvis_l) ? p0[reg] : -INFINITY; p1[reg] = (c + 32 < nvis_l) ? p1[reg] : -INFINITY; } }
}
__device__ __forceinline__ void U_cmp(KP p_, int bg_, int u_) {
    const KP p = uni_kp(p_); const int bg = __builtin_amdgcn_readfirstlane(bg_), uu = __builtin_amdgcn_readfirstlane(u_);
    int tid_ = threadIdx.x; asm volatile("" : "+v"(tid_));
    const int tid = tid_, lane = tid & 63, wave = __builtin_amdgcn_readfirstlane(tid >> 6), r = lane & 31, h = lane >> 5;
    unsigned char* ws = p->ws; asm volatile("" : "+s"(ws)); LAS unsigned char* L = (LAS unsigned char*)lds_raw;
    const int b = bg >> 1, g = bg & 1, tw0 = 32 * (uu + 16 * wave), t_lane = tw0 + r;
    { const bf16* kc = (const bf16*)(ws + WS_KVCMP) + (size_t)bg * 256 * 64; const bf16* vc = kc + 16 * 256 * 64;
#pragma unroll
      for (int i = 0; i < 4; ++i) { const int ch = tid + 512 * i, row = ch >> 3, c8 = ch & 7;
          *(LAS u32x4*)(L + row * 144 + c8 * 16) = *(const u32x4*)(kc + row * 64 + c8 * 8); *(LAS u32x4*)(L + 36864 + row * 144 + c8 * 16) = *(const u32x4*)(vc + row * 64 + c8 * 8); } }
    __syncthreads();
    const int nvis_l = t_lane >= 31 ? ((t_lane - 31) >> 4) + 1 : 0, nvis_max = (tw0 >> 4) + 1, nvis_min = tw0 >= 31 ? ((tw0 - 31) >> 4) + 1 : 0, ntile = (nvis_max + 63) >> 6;
    const LAS unsigned char* kfrag = L + r * 144 + h * 16;
    const LAS unsigned char* vfrag = L + 36864 + (4 * h + ((lane & 15) >> 2)) * 144 + (16 * ((lane >> 4) & 1) + 4 * (lane & 3)) * 2;
    float imp[32];
#pragma unroll
    for (int e = 0; e < 32; ++e) imp[e] = 0.f;
    const float* gate = (const float*)(ws + WS_GATE) + ((size_t)b * T_ + t_lane) * 24;
#pragma unroll 1
    for (int hg = 0; hg < 4; ++hg) {
        const int hd = g * 4 + hg; const float s1 = alibi_slope(hd + 1, 8) * LOG2E * 16.f;
        const bf16* q = (const bf16*)(ws + WS_QN) + (size_t)(b * 8 + hd) * T_ * 64 + (t_lane >> 4) * 1024 + (t_lane & 15) * 32 + 8 * h;
        bf16x8v Qf[4];
#pragma unroll
        for (int s = 0; s < 4; ++s) Qf[s] = *(const bf16x8v*)(q + (s >> 1) * 512 + (s & 1) * 16);
        float m = -1e30f, lsum = 0.f;
#pragma unroll 1
        for (int jt = 0; jt < ntile; ++jt) {
            f32x16 p0, p1; const float b0 = s1 * (float)(64 * jt + 4 * h - nvis_max);
            if (64 * jt + 63 >= nvis_min) cmp_scores<true>(p0, p1, kfrag + jt * (64 * 144), Qf, b0, s1, 64 * jt + 4 * h, nvis_l);
            else cmp_scores<false>(p0, p1, kfrag + jt * (64 * 144), Qf, b0, s1, 64 * jt + 4 * h, nvis_l);
            float mt = fmaxf(p0[0], p1[0]);
#pragma unroll
            for (int reg = 1; reg < 16; ++reg) mt = fmaxf(mt, fmaxf(p0[reg], p1[reg]));
            mt = swap_max(mt);
            const float mn = fmaxf(m, mt); float rs = 0.f;
#pragma unroll
            for (int reg = 0; reg < 16; ++reg) rs += __builtin_amdgcn_exp2f(p0[reg] - mn) + __builtin_amdgcn_exp2f(p1[reg] - mn);
            lsum = lsum * __builtin_amdgcn_exp2f(m - mn) + rs; m = mn;
        }
        const float lt = swap_sum(lsum), inv = lt > 0.f ? 1.f / lt : 0.f;
        f32x16 O0, O1;
#pragma unroll
        for (int i = 0; i < 16; ++i) { O0[i] = 0.f; O1[i] = 0.f; }
        float carry = 0.f;
#pragma unroll
        for (int jt = 0; jt < 4; ++jt) if (jt < ntile) {
            f32x16 p0, p1; const float b0 = s1 * (float)(64 * jt + 4 * h - nvis_max);
            if (64 * jt + 63 >= nvis_min) cmp_scores<true>(p0, p1, kfrag + jt * (64 * 144), Qf, b0, s1, 64 * jt + 4 * h, nvis_l);
            else cmp_scores<false>(p0, p1, kfrag + jt * (64 * 144), Qf, b0, s1, 64 * jt + 4 * h, nvis_l);
#pragma unroll
            for (int reg = 0; reg < 16; ++reg) { p0[reg] = __builtin_amdgcn_exp2f(p0[reg] - m) * inv; p1[reg] = __builtin_amdgcn_exp2f(p1[reg] - m) * inv; }
            float cv[8];
#pragma unroll
            for (int g4 = 0; g4 < 4; ++g4) { const float h0 = 0.5f * p0[4 * g4 + 3], h1 = 0.5f * p1[4 * g4 + 3];
                imp[jt * 8 + g4] += ((p0[4 * g4] + p0[4 * g4 + 1]) + p0[4 * g4 + 2]) + h0; imp[jt * 8 + 4 + g4] += ((p1[4 * g4] + p1[4 * g4 + 1]) + p1[4 * g4 + 2]) + h1;
                cv[g4] = h0; cv[4 + g4] = h1; }
            float prev = carry;
#pragma unroll
            for (int k = 0; k < 8; ++k) { const float sv = other_half(cv[k], h); imp[jt * 8 + k] += h ? sv : prev; prev = sv; }
            carry = prev;
            const bf16x8v pa0 = pack8(p0, 0), pa1 = pack8(p0, 8), pa2 = pack8(p1, 0), pa3 = pack8(p1, 8);
            const LAS unsigned char* vb = vfrag + jt * (64 * 144);
#pragma unroll
            for (int ks = 0; ks < 4; ++ks) { const bf16x8v pa = ks == 0 ? pa0 : ks == 1 ? pa1 : ks == 2 ? pa2 : pa3;
                { const s16x4 lo = tr_read(vb + ks * (16 * 144)), hi = tr_read(vb + ks * (16 * 144) + 8 * 144); const bf16x8v vf = {lo[0], lo[1], lo[2], lo[3], hi[0], hi[1], hi[2], hi[3]};
                  O0 = __builtin_amdgcn_mfma_f32_32x32x16_bf16(vf, pa, O0, 0, 0, 0); }
                { const s16x4 lo = tr_read(vb + ks * (16 * 144) + 64), hi = tr_read(vb + ks * (16 * 144) + 64 + 8 * 144); const bf16x8v vf = {lo[0], lo[1], lo[2], lo[3], hi[0], hi[1], hi[2], hi[3]};
                  O1 = __builtin_amdgcn_mfma_f32_32x32x16_bf16(vf, pa, O1, 0, 0, 0); } }
        }
        const float gt = gate[hd * 3 + 0];
        bf16* dst = (bf16*)(ws + WS_OCMP) + mix_off((size_t)b * T_ + t_lane, hd * 64 + 4 * h, 512);
#pragma unroll
        for (int g4 = 0; g4 < 4; ++g4) {
            *(u64*)(dst + g4 * 256) = (u64)cvtpk(O0[4 * g4 + 0] * gt, O0[4 * g4 + 1] * gt) | ((u64)cvtpk(O0[4 * g4 + 2] * gt, O0[4 * g4 + 3] * gt) << 32);
            *(u64*)(dst + (4 + g4) * 256) = (u64)cvtpk(O1[4 * g4 + 0] * gt, O1[4 * g4 + 1] * gt) | ((u64)cvtpk(O1[4 * g4 + 2] * gt, O1[4 * g4 + 3] * gt) << 32); }
    }
    const int cur = tw0 >> 6; u64 mask;
    if (cur <= 15) mask = (1ull << (cur + 1)) - 1ull;
    else {
        mask = 1ull | (1ull << cur) | (1ull << (cur - 1));
#pragma unroll
        for (int e = 0; e < 32; ++e) { const int j = 2 * e + h; if (j > cur || j == 0 || j >= cur - 1) imp[e] = -INFINITY; }
#pragma unroll 1
        for (int round = 0; round < 13; ++round) {
            float bv = imp[0]; int be = 0;
#pragma unroll
            for (int e = 1; e < 32; ++e) if (imp[e] > bv) { bv = imp[e]; be = e; }
            const int bj = 2 * be + h; const float ov = other_half(bv, h); const int oj = other_half_i(bj, h);
            const bool mine = bv > ov || (bv == ov && bj < oj);
            mask |= 1ull << (mine ? bj : oj);
#pragma unroll
            for (int e = 0; e < 32; ++e) imp[e] = (mine && e == be) ? -INFINITY : imp[e];
        }
    }
    if (h == 0) ((u64*)(ws + WS_SEL))[(size_t)bg * T_ + t_lane] = mask;
    __syncthreads();
}
constexpr int CONV_UNITS = L_ * NEXP * (2 * 16 * 8 + 4 * 32) / 32;
__device__ __forceinline__ void U_conv(KP p_, int k_) {
    const KP p = uni_kp(p_); const int k = __builtin_amdgcn_readfirstlane(k_);
    int tid_ = threadIdx.x; asm volatile("" : "+v"(tid_));
    const int tid = tid_, lane = tid & 63, wave = __builtin_amdgcn_readfirstlane(tid >> 6);
    unsigned char* ws = p->ws; asm volatile("" : "+s"(ws));
    LAS float* scr = (LAS float*)lds_raw + wave * (64 * 33);
    constexpr int I_G = 16 * 8, I_D = 4 * 32, I_E = 2 * I_G + I_D;
#pragma unroll 1
    for (int i = 0; i < 4; ++i) {
        const int m = k * 32 + i * 8 + wave, l = m / (NEXP * I_E); int r = m % (NEXP * I_E); const int e = r / I_E; r = r % I_E; const size_t le = (size_t)l * NEXP + e;
        const float* W; bf16* WT; int ldw, K, ncol, r0 = 0, rmul = 1; const float* gk = nullptr;
        if (r < 2 * I_G) { const int up = r >= I_G; r -= up * I_G; W = p->in[19 + up] + le * D_ * DEXP; WT = (bf16*)(ws + WS_WGU_T) + le * 512 * D_; ldw = DEXP; K = D_; ncol = 256; r0 = up; rmul = 2; gk = p->in[14] + (size_t)l * D_; }
        else { r -= 2 * I_G; W = p->in[21] + le * DEXP * D_; WT = (bf16*)(ws + WS_WD_T) + le * D_ * DEXP; ldw = D_; K = DEXP; ncol = 1024; }
        transpose_seg(W, ldw, K, 0, ncol, WT, r0, rmul, r, scr, lane, gk);
    }
}
__device__ __forceinline__ int fetch_unit(KP p, int qidx) {
    volatile LAS unsigned* slot = (volatile LAS unsigned*)((LAS unsigned char*)lds_raw + MISC_OFF) + 16;
    __syncthreads();
    int t0_ = threadIdx.x; asm volatile("" : "+v"(t0_));
    if (t0_ == 0) *slot = __hip_atomic_fetch_add((unsigned*)(p->ws + WS_CTL) + CW_QUEUE + 64 * qidx, 1u, __ATOMIC_RELAXED, __HIP_MEMORY_SCOPE_AGENT);
    __syncthreads();
    return (int)__builtin_amdgcn_readfirstlane(*slot);
}
__device__ __forceinline__ void P_cmp1_mfma(int l_) { const KP p = (KP)__builtin_amdgcn_kernarg_segment_ptr(); int l = l_; asm volatile("" : "+s"(l));
    unsigned char* ws = p->ws; asm volatile("" : "+s"(ws)); const int c = launder_s((int)blockIdx.x), kv = c >> 4, pm = c & 15;
    OneUnitOrder S; S.has = c < 32; S.u.pm = pm; S.u.pn = kv;
    S.u.a = (const char*)(ws + WS_KV6 + (size_t)kv * KV6_STRIDE) + (size_t)pm * 256 * 1024 * 2; S.u.b = (const char*)((const bf16*)(ws + WS_W1_T) + ((size_t)l * 2 + kv) * 256 * 2048); S.u.b2 = S.u.b;
    const pg8::Gemm g{1024, 2048, 2048, 32, 0, 0};
    const EpiCmpH E{(bf16*)(ws + WS_HC), (const float*)(ws + WS_BIAS1) + l * 512};
    pg8::gemm_phase<EpiCmpH, OneUnitOrder, false, true>((LAS unsigned char*)lds_raw, g, S, E);
}
__device__ __forceinline__ void P_cmp2_mfma(int l_) { const KP p = (KP)__builtin_amdgcn_kernarg_segment_ptr(); int l = l_; asm volatile("" : "+s"(l));
    unsigned char* ws = p->ws; asm volatile("" : "+s"(ws)); const int c = launder_s((int)blockIdx.x), kv = c >> 4, pm = c & 15;
    OneUnitOrder S; S.has = c < 32; S.u.pm = pm; S.u.pn = kv;
    S.u.a = (const char*)((const bf16*)(ws + WS_HC) + ((size_t)kv * 4096 + pm * 256) * 256); S.u.b = (const char*)((const bf16*)(ws + WS_W2_T) + ((size_t)l * 2 + kv) * 64 * 256); S.u.b2 = S.u.b;
    const pg8::Gemm g{256, 256, 256, 4, 0, 0};
    const EpiCmpOut E{(bf16*)(ws + WS_KVCMP)};
    pg8::gemm_phase<EpiCmpOut, OneUnitOrder, false, true>((LAS unsigned char*)lds_raw, g, S, E);
}
__device__ __forceinline__ void P_moe_scatter(KP p_, int l_) { const KP p = uni_kp(p_); const int l = __builtin_amdgcn_readfirstlane(l_); const Ctx c = make_ctx(p); unsigned char* ws = p->ws;
    const unsigned* cnt = (const unsigned*)(ws + WS_CTL) + CW_MOECNT + l * MOE_LS;
    moe_build_tables(cnt, c.tid);
    const LAS int* T = (const LAS int*)((LAS unsigned char*)lds_raw + TBL_OFF);
    const unsigned* info = (const unsigned*)(ws + WS_ROUTE + RT_INFO); const float* tw = (const float*)(ws + WS_ROUTE + RT_W);
    int* rowtok = (int*)(ws + WS_ROUTE + RT_ROWTOK); float* roww = (float*)(ws + WS_ROUTE + RT_ROWW);
    bf16* xs = (bf16*)(ws + WS_XS); const bf16* x = (const bf16*)(ws + WS_HN); const float* gain = p->in[14] + (size_t)l * D_; const float* rstdv = (const float*)(ws + WS_ROUTE + RT_RSTD);
    { constexpr int RB = 4; float gg[2][8];
#pragma unroll
      for (int j = 0; j < 2; ++j) { const f32x4 a = ((const f32x4*)gain)[2 * c.lane + 128 * j], b2 = ((const f32x4*)gain)[2 * c.lane + 128 * j + 1]; gg[j][0] = a.x; gg[j][1] = a.y; gg[j][2] = a.z; gg[j][3] = a.w; gg[j][4] = b2.x; gg[j][5] = b2.y; gg[j][6] = b2.z; gg[j][7] = b2.w; }
      for (int row0 = c.gw * RB; row0 < NT; row0 += c.ngw * RB) {
        u32x4 vv[RB][2];
#pragma unroll
        for (int q = 0; q < RB; ++q)
#pragma unroll
            for (int j = 0; j < 2; ++j) vv[q][j] = ((const u32x4*)(x + (size_t)(row0 + q) * D_))[c.lane + 64 * j];
#pragma unroll
        for (int q = 0; q < RB; ++q) { const int row = row0 + q;
            const unsigned v = info[row]; const int cls = (int)(v >> 24), rank = (int)(v & 0xffffffu); const size_t dest = (size_t)T[cls] * 256 + rank; const float r = rstdv[row];
#pragma unroll
            for (int j = 0; j < 2; ++j) { float f[8]; unpack8(vv[q][j], f); u32x4 o; o.x = pk2(f[0] * r * gg[j][0], f[1] * r * gg[j][1]); o.y = pk2(f[2] * r * gg[j][2], f[3] * r * gg[j][3]); o.z = pk2(f[4] * r * gg[j][4], f[5] * r * gg[j][5]); o.w = pk2(f[6] * r * gg[j][6], f[7] * r * gg[j][7]);
                ((u32x4*)(xs + dest * D_))[c.lane + 64 * j] = o; }
            if (c.lane == 0) { rowtok[dest] = row; roww[2 * dest] = tw[2 * row]; roww[2 * dest + 1] = tw[2 * row + 1]; } }
      } }
    for (int cls = c.bid; cls < 112; cls += c.G) { const int n = (int)cnt[cls * MOE_CS], end = (int)((cnt[cls * MOE_CS] + 255u) >> 8) * 256; const size_t base = (size_t)T[cls] * 256;
        for (int r = n + c.tid; r < end; r += NTHREADS) rowtok[base + r] = -1; }
}
__device__ __forceinline__ int xcd_major(int bid, int G) { bid = launder_s(bid); return (G & 7) ? bid : (bid & 7) * (G >> 3) + (bid >> 3); }
__device__ __forceinline__ void P_moe_g1(int l_) { const KP p = (KP)__builtin_amdgcn_kernarg_segment_ptr(); int l = l_; asm volatile("" : "+s"(l));
    unsigned char* ws = p->ws; asm volatile("" : "+s"(ws));
    { int t0_ = threadIdx.x; asm volatile("" : "+v"(t0_)); moe_build_tables((const unsigned*)(ws + WS_CTL) + CW_MOECNT + l * MOE_LS, t0_); }
    const MoeOrder1 S{(const char*)ws, (const unsigned*)(ws + WS_REC), (const char*)((const bf16*)(ws + WS_WGU_T) + (size_t)l * NEXP * 512 * D_), (int)gridDim.x, xcd_major((int)blockIdx.x, (int)gridDim.x)};
    const pg8::Gemm g{D_, D_, D_, D_ / 64, 0, 0};
    const EpiMoeH E{(bf16*)(ws + WS_HB), (const u32x4*)(ws + WS_REC)};
    pg8::gemm_phase<EpiMoeH, MoeOrder1, true, true, true>((LAS unsigned char*)lds_raw, g, S, E);
}
__device__ __forceinline__ void P_moe_g2(int l_) { const KP p = (KP)__builtin_amdgcn_kernarg_segment_ptr(); int l = l_; asm volatile("" : "+s"(l));
    unsigned char* ws = p->ws; asm volatile("" : "+s"(ws));
    { int t0_ = threadIdx.x; asm volatile("" : "+v"(t0_)); moe_build_tables((const unsigned*)(ws + WS_CTL) + CW_MOECNT + l * MOE_LS, t0_); }
    const MoeOrder2 S{(const char*)(ws + WS_HB), (const char*)((const bf16*)(ws + WS_WD_T) + (size_t)l * NEXP * D_ * DEXP), (int)gridDim.x, xcd_major((int)blockIdx.x, (int)gridDim.x)};
    const pg8::Gemm g{512, DEXP, 512, 4, 16, 16};
    const EpiMoeOut E{(bf16*)(ws + WS_HN), (const unsigned*)(ws + WS_REC)};
    pg8::gemm_phase<EpiMoeOut, MoeOrder2, true, true>((LAS unsigned char*)lds_raw, g, S, E);
}
__device__ __forceinline__ void P_norm1(KP p_, int l_) { const KP p = uni_kp(p_); const int l = __builtin_amdgcn_readfirstlane(l_); const Ctx c = make_ctx(p); const Bufs b = make_bufs(p->ws);
    if (l == 0) { const int i = c.bid * NTHREADS + c.tid; if (i < L_ * 2 * 256) { const float* part = (const float*)(p->ws + WS_B1PART) + (size_t)(i >> 8) * 128 * 256 + (i & 255); float a = 0.f;
        for (int k = 0; k < 128; ++k) a += part[(size_t)k * 256]; ((float*)(p->ws + WS_BIAS1))[i] = a; } }
    if (l == 0) ph_norm_bf16(c, p->in[0], p->in[1], (bf16*)p->out, (bf16*)(p->ws + WS_HN)); else ph_norm_bf16_from_bf16(c, (const bf16*)(p->ws + WS_HN), p->in[1] + (size_t)l * D_, (bf16*)p->out); }
__device__ __noinline__ void P_inproj(KP p_, int l_) { const KP p = uni_kp(p_); const int l = __builtin_amdgcn_readfirstlane(l_); const Ctx c = make_ctx(p); const Bufs b = make_bufs(p->ws);
    InProjOut o{b.QN, b.KV6, b.FQ, b.DQ, b.DV, b.GATE, b.FL, p->in[3] + l * 24, p->in[4] + l * 4};
    const bf16* A = b.HN;
    naive_gemm(c, NT, D_IN, D_, [=](int r, int k) { return bf2f(A[(size_t)r * D_ + k]); }, p->in[2] + (size_t)l * D_ * D_IN, D_IN,
               [=](int r, int col, float v) { inproj_store(o, r, col, v); }); }
__device__ __noinline__ void P_cmp1(KP p_, int l_, int kv_) { const KP p = uni_kp(p_); const int l = __builtin_amdgcn_readfirstlane(l_), kv = __builtin_amdgcn_readfirstlane(kv_); const Ctx c = make_ctx(p); const Bufs b = make_bufs(p->ws);
    const bf16* src = kv == 0 ? b.KC : b.VC; const float* pe = p->in[kv == 0 ? 5 : 8] + (size_t)l * 2048; bf16* hc = b.HC + (size_t)kv * 4096 * 256;
    naive_gemm(c, 4096, 256, 2048, [=](int r, int k) { return bf2f(src[(size_t)r * 1024 + k]) + pe[k]; }, p->in[kv == 0 ? 6 : 9] + (size_t)l * 2048 * 256, 256,
               [=](int r, int col, float v) { hc[(size_t)r * 256 + col] = (bf16)f2bf(gelu_tanh(v)); }); }
__device__ __noinline__ void P_cumsum(KP p_, int l_) { const KP p = uni_kp(p_); const int l = __builtin_amdgcn_readfirstlane(l_); const Ctx c = make_ctx(p); const Bufs b = make_bufs(p->ws); ph_cumsum(c, b.FL); }
__device__ __noinline__ void P_cmp2(KP p_, int l_, int kv_) { const KP p = uni_kp(p_); const int l = __builtin_amdgcn_readfirstlane(l_), kv = __builtin_amdgcn_readfirstlane(kv_); const Ctx c = make_ctx(p); const Bufs b = make_bufs(p->ws);
    const bf16* hc = b.HC + (size_t)kv * 4096 * 256; bf16* dst = kv == 0 ? b.KCMP : b.VCMP;
    naive_gemm(c, 4096, 64, 256, [=](int r, int k) { return bf2f(hc[(size_t)r * 256 + k]); }, p->in[kv == 0 ? 7 : 10] + (size_t)l * 256 * 64, 64,
               [=](int r, int col, float v) { dst[(size_t)r * 64 + col] = (bf16)f2bf((r & 255) == 255 ? 0.f : v); }); }
__device__ __noinline__ void P_win(KP p_, int l_) { const KP p = uni_kp(p_); const int l = __builtin_amdgcn_readfirstlane(l_); const Ctx c = make_ctx(p); const Bufs b = make_bufs(p->ws); ph_win_attn(c, b.QN, b.KW, b.VW, b.GATE, b.OWIN); }
__device__ __noinline__ void P_fox(KP p_, int l_) { const KP p = uni_kp(p_); const int l = __builtin_amdgcn_readfirstlane(l_); const Ctx c = make_ctx(p); const Bufs b = make_bufs(p->ws); ph_fox_attn(c, b.FQ, b.FK, b.FV, b.FL, b.ATT); }
__device__ __noinline__ void P_diff(KP p_, int l_) { const KP p = uni_kp(p_); const int l = __builtin_amdgcn_readfirstlane(l_); const Ctx c = make_ctx(p); const Bufs b = make_bufs(p->ws);
    ph_diff_attn(c, b.DQ, b.DK, b.DV, p->in[11] + (size_t)l * 128, p->in[12] + (size_t)l * 64, lambda_init_of(l), b.ATT); }
__device__ __noinline__ void P_cmpattn(KP p_, int l_) { const KP p = uni_kp(p_); const int l = __builtin_amdgcn_readfirstlane(l_); const Ctx c = make_ctx(p); const Bufs b = make_bufs(p->ws); ph_cmp_attn(c, b.QN, b.KCMP, b.VCMP, b.GATE, b.SEL, b.OCMP); }
__device__ __noinline__ void P_slc(KP p_, int l_) { const KP p = uni_kp(p_); const int l = __builtin_amdgcn_readfirstlane(l_); const Ctx c = make_ctx(p); const Bufs b = make_bufs(p->ws); ph_slc_attn(c, b.QN, b.KS, b.VS, b.GATE, b.SEL, b.OCMP, b.OWIN, b.ATT); }
__device__ __noinline__ void P_outproj(KP p_, int l_) { const KP p = uni_kp(p_); const int l = __builtin_amdgcn_readfirstlane(l_); const Ctx c = make_ctx(p); const Bufs b = make_bufs(p->ws);
    const bf16* A = b.ATT; float* xo = p->out; const float* xin = (l == 0) ? p->in[0] : p->out;
    naive_gemm(c, NT, D_, D_, [=](int r, int k) { return bf2f(A[(size_t)r * D_ + k]); }, p->in[13] + (size_t)l * D_ * D_, D_,
               [=](int r, int col, float v) { xo[(size_t)r * D_ + col] = xin[(size_t)r * D_ + col] + v; }); }
__device__ __forceinline__ void P_route3(int l_, int cbank) { const KP p = (KP)__builtin_amdgcn_kernarg_segment_ptr(); int l = l_; asm volatile("" : "+s"(l));
    int tid_ = threadIdx.x; asm volatile("" : "+v"(tid_));
    const int tid = tid_, lane = tid & 63, wave = __builtin_amdgcn_readfirstlane(tid >> 6), r = lane & 31, h = lane >> 5, kh = wave >> 2, wr = wave & 3;
    unsigned char* ws = p->ws; asm volatile("" : "+s"(ws)); const bf16* x = (const bf16*)(ws + WS_HN);
    const float* WR = (const float*)(ws + WS_WR) + (size_t)l * D_ * 64;
    LAS float* XT = (LAS float*)lds_raw + wave * (32 * 36);
    LAS float* WT = (LAS float*)lds_raw + 8 * 32 * 36 + kh * (2 * 32 * 64);
    LAS float* PL = (LAS float*)lds_raw + 8 * 32 * 36 + 2 * 2 * 32 * 64;
    LAS float* SS = PL + 2 * 128 * 40;
    const float* bgrp = p->in[16] + l * 4; const float* bexp = p->in[18] + l * 32;
    unsigned* cnt = (unsigned*)(ws + WS_CTL) + CW_MOECNT + l * MOE_LS + cbank;
    LAS unsigned* HIST = (LAS unsigned*)(SS + 2 * 128 * 2);
    for (int grp = launder_s((int)blockIdx.x); grp < NT / 128; grp += (int)gridDim.x) {
        const int row0 = grp * 128 + wr * 32;
        if (tid < 112) HIST[tid] = 0u;
        f32x16 acc0, acc1; float ss = 0.f;
#pragma unroll
        for (int i = 0; i < 16; ++i) { acc0[i] = 0.f; acc1[i] = 0.f; }
        { const u32x4* xsrc = (const u32x4*)(x + (size_t)(row0 + r) * D_ + kh * 512 + 8 * h);
          const u32x4* wsrc = (const u32x4*)(ws + WS_WR) + ((size_t)l * 64 + kh * 32) * 256 + lane;
#pragma unroll 4
          for (int ks = 0; ks < 32; ++ks) {
              const u32x4 av = xsrc[2 * ks], b0h = wsrc[ks * 256], b0l = wsrc[ks * 256 + 64], b1h = wsrc[ks * 256 + 128], b1l = wsrc[ks * 256 + 192];
              { float f_[8]; unpack8(av, f_);
#pragma unroll
                for (int e = 0; e < 8; ++e) ss = fmaf(f_[e], f_[e], ss); }
              const bf16x8v A = __builtin_bit_cast(bf16x8v, av);
              acc0 = __builtin_amdgcn_mfma_f32_32x32x16_bf16(A, __builtin_bit_cast(bf16x8v, b0h), acc0, 0, 0, 0); acc1 = __builtin_amdgcn_mfma_f32_32x32x16_bf16(A, __builtin_bit_cast(bf16x8v, b1h), acc1, 0, 0, 0);
              acc0 = __builtin_amdgcn_mfma_f32_32x32x16_bf16(A, __builtin_bit_cast(bf16x8v, b0l), acc0, 0, 0, 0); acc1 = __builtin_amdgcn_mfma_f32_32x32x16_bf16(A, __builtin_bit_cast(bf16x8v, b1l), acc1, 0, 0, 0);
          } }
#pragma unroll
        for (int reg = 0; reg < 16; ++reg) { const int row = wr * 32 + crow0(reg) + 4 * h; PL[(kh * 128 + row) * 40 + r] = acc0[reg]; if (r < 4) PL[(kh * 128 + row) * 40 + 32 + r] = acc1[reg]; }
        SS[(kh * 128 + wr * 32 + r) * 2 + h] = ss;
        __syncthreads();
        int cls = 0; unsigned lrank = 0u; float wlo = 0.f, whi = 0.f, rstd = 0.f;
        if (tid < 128) {
            float lg[36];
#pragma unroll
            for (int cidx = 0; cidx < 36; ++cidx) lg[cidx] = PL[tid * 40 + cidx] + PL[(128 + tid) * 40 + cidx];
            const float sq = (SS[tid * 2] + SS[tid * 2 + 1]) + (SS[(128 + tid) * 2] + SS[(128 + tid) * 2 + 1]);
            rstd = rsqrtf(sq * (1.f / D_) + EPS);
            float gl[4]; int grp_i = 0;
#pragma unroll
            for (int q = 0; q < 4; ++q) gl[q] = lg[q] * rstd + bgrp[q];
            float gm = gl[0];
#pragma unroll
            for (int q = 1; q < 4; ++q) if (gl[q] > gm) { gm = gl[q]; grp_i = q; }
            float gs = 0.f;
#pragma unroll
            for (int q = 0; q < 4; ++q) gs += __expf(gl[q] - gm);
            const float grp_gate = 1.f / gs;
            float el[8];
#pragma unroll
            for (int q = 0; q < 8; ++q) { float v = lg[4 + q]; float bb = bexp[q];
                if (grp_i == 1) { v = lg[12 + q]; bb = bexp[8 + q]; } else if (grp_i == 2) { v = lg[20 + q]; bb = bexp[16 + q]; } else if (grp_i == 3) { v = lg[28 + q]; bb = bexp[24 + q]; }
                el[q] = v * rstd + bb; }
            int i0 = 0; float v0 = el[0];
#pragma unroll
            for (int q = 1; q < 8; ++q) if (el[q] > v0) { v0 = el[q]; i0 = q; }
            int i1 = -1; float v1 = -INFINITY;
#pragma unroll
            for (int q = 0; q < 8; ++q) if (q != i0 && el[q] > v1) { v1 = el[q]; i1 = q; }
            const float e1 = __expf(v1 - v0), den = 1.f + e1, w0 = grp_gate / den, w1 = grp_gate * e1 / den;
            const int lo = i0 < i1 ? i0 : i1, hi = i0 < i1 ? i1 : i0; cls = grp_i * 28 + lo * 8 - (lo * (lo + 1)) / 2 + (hi - lo - 1);
            wlo = i0 < i1 ? w0 : w1; whi = i0 < i1 ? w1 : w0;
            lrank = __hip_atomic_fetch_add(HIST + cls, 1u, __ATOMIC_RELAXED, __HIP_MEMORY_SCOPE_WORKGROUP);
        }
        __syncthreads();
        if (tid < 112) { const unsigned n = HIST[tid]; if (n) HIST[112 + tid] = __hip_atomic_fetch_add(cnt + tid * MOE_CS, n, __ATOMIC_RELAXED, __HIP_MEMORY_SCOPE_AGENT); }
        __syncthreads();
        if (tid < 128) {
            const unsigned rank = HIST[112 + cls] + lrank;
            const int row = grp * 128 + tid;
            ((u32x4*)(ws + WS_REC))[(size_t)cls * 32768 + rank] = (u32x4){(unsigned)row, __float_as_uint(wlo), __float_as_uint(whi), __float_as_uint(rstd)};
        }
        __syncthreads();
    }
}
typedef float f32x8 __attribute__((ext_vector_type(8)));
__device__ __forceinline__ void P_route2(int l_, int cbank) { const KP p = (KP)__builtin_amdgcn_kernarg_segment_ptr(); int l = l_; asm volatile("" : "+s"(l));
    int tid_ = threadIdx.x; asm volatile("" : "+v"(tid_));
    const int tid = tid_, lane = tid & 63, wave = __builtin_amdgcn_readfirstlane(tid >> 6);
    unsigned char* ws = p->ws; asm volatile("" : "+s"(ws)); const float* x = p->out;
    const float* WR = (const float*)(ws + WS_WR) + (size_t)l * D_ * 40;
    LAS float* xt = (LAS float*)lds_raw + wave * (64 * 36);
    LAS float* part = (LAS float*)lds_raw;
    const float* bgrp = p->in[16] + l * 4; const float* bexp = p->in[18] + l * 32;
    unsigned* cnt = (unsigned*)(ws + WS_CTL) + CW_MOECNT + l * 128 + cbank;
    for (int grp = launder_s((int)blockIdx.x); grp < NT / 128; grp += (int)gridDim.x) {
        const int row0 = grp * 128 + (wave >> 2) * 64, kq = wave & 3;
        float acc[40]; float ss = 0.f;
#pragma unroll
        for (int cidx = 0; cidx < 40; ++cidx) acc[cidx] = 0.f;
#pragma unroll 1
        for (int kc = 0; kc < 8; ++kc) {
            const int k0 = kq * 256 + kc * 32;
#pragma unroll
            for (int i = 0; i < 8; ++i) { const int row = i * 8 + (lane >> 3), c4 = (lane & 7) * 4; *(LAS f32x4*)(xt + row * 36 + c4) = *(const f32x4*)(x + (size_t)(row0 + row) * D_ + k0 + c4); }
            float xr[32];
#pragma unroll
            for (int j = 0; j < 8; ++j) { const f32x4 t = *(const LAS f32x4*)(xt + lane * 36 + 4 * j); xr[4 * j] = t.x; xr[4 * j + 1] = t.y; xr[4 * j + 2] = t.z; xr[4 * j + 3] = t.w; }
            const float* wk = WR + (size_t)k0 * 40;
#pragma unroll
            for (int kk = 0; kk < 32; ++kk) {
                f32x8 w0, w1, w2, w3, w4;
                asm volatile("s_load_dwordx8 %0, %5, %6\n\ts_load_dwordx8 %1, %5, %7\n\ts_load_dwordx8 %2, %5, %8\n\ts_load_dwordx8 %3, %5, %9\n\ts_load_dwordx8 %4, %5, %10\n\ts_waitcnt lgkmcnt(0)"
                             : "=&s"(w0), "=&s"(w1), "=&s"(w2), "=&s"(w3), "=&s"(w4) : "s"(wk), "i"(kk * 160), "i"(kk * 160 + 32), "i"(kk * 160 + 64), "i"(kk * 160 + 96), "i"(kk * 160 + 128) : "memory");
                const float xv = xr[kk]; ss = fmaf(xv, xv, ss);
#pragma unroll
                for (int e = 0; e < 8; ++e) { acc[e] = fmaf(xv, w0[e], acc[e]); acc[8 + e] = fmaf(xv, w1[e], acc[8 + e]); acc[16 + e] = fmaf(xv, w2[e], acc[16 + e]); acc[24 + e] = fmaf(xv, w3[e], acc[24 + e]); }
#pragma unroll
                for (int e = 0; e < 4; ++e) acc[32 + e] = fmaf(xv, w4[e], acc[32 + e]);
            }
        }
        __syncthreads();
#pragma unroll
        for (int cidx = 0; cidx < 36; ++cidx) part[(wave * 64 + lane) * 37 + cidx] = acc[cidx];
        part[(wave * 64 + lane) * 37 + 36] = ss;
        __syncthreads();
        if (tid < 128) {
            const int rg = tid >> 6, rr = tid & 63; float lg[37];
#pragma unroll
            for (int cidx = 0; cidx < 37; ++cidx) lg[cidx] = ((part[((rg * 4 + 0) * 64 + rr) * 37 + cidx] + part[((rg * 4 + 1) * 64 + rr) * 37 + cidx]) + part[((rg * 4 + 2) * 64 + rr) * 37 + cidx]) + part[((rg * 4 + 3) * 64 + rr) * 37 + cidx];
            const float rstd = rsqrtf(lg[36] * (1.f / D_) + EPS);
            float gl[4]; int grp_i = 0;
#pragma unroll
            for (int q = 0; q < 4; ++q) gl[q] = lg[q] * rstd + bgrp[q];
            float gm = gl[0];
#pragma unroll
            for (int q = 1; q < 4; ++q) if (gl[q] > gm) { gm = gl[q]; grp_i = q; }
            float gs = 0.f;
#pragma unroll
            for (int q = 0; q < 4; ++q) gs += __expf(gl[q] - gm);
            const float grp_gate = 1.f / gs;
            float el[8];
#pragma unroll
            for (int q = 0; q < 8; ++q) { float v = lg[4 + q]; float bb = bexp[q];
                if (grp_i == 1) { v = lg[12 + q]; bb = bexp[8 + q]; } else if (grp_i == 2) { v = lg[20 + q]; bb = bexp[16 + q]; } else if (grp_i == 3) { v = lg[28 + q]; bb = bexp[24 + q]; }
                el[q] = v * rstd + bb; }
            int i0 = 0; float v0 = el[0];
#pragma unroll
            for (int q = 1; q < 8; ++q) if (el[q] > v0) { v0 = el[q]; i0 = q; }
            int i1 = -1; float v1 = -INFINITY;
#pragma unroll
            for (int q = 0; q < 8; ++q) if (q != i0 && el[q] > v1) { v1 = el[q]; i1 = q; }
            const float e1 = __expf(v1 - v0), den = 1.f + e1, w0 = grp_gate / den, w1 = grp_gate * e1 / den;
            const int lo = i0 < i1 ? i0 : i1, hi = i0 < i1 ? i1 : i0, cls = grp_i * 28 + lo * 8 - (lo * (lo + 1)) / 2 + (hi - lo - 1);
            const unsigned rank = __hip_atomic_fetch_add(cnt + cls, 1u, __ATOMIC_RELAXED, __HIP_MEMORY_SCOPE_AGENT);
            const int row = grp * 128 + tid;
            ((unsigned*)(ws + WS_ROUTE + RT_INFO))[row] = ((unsigned)cls << 24) | rank;
            ((float*)(ws + WS_ROUTE + RT_W))[2 * row] = i0 < i1 ? w0 : w1; ((float*)(ws + WS_ROUTE + RT_W))[2 * row + 1] = i0 < i1 ? w1 : w0;
            ((float*)(ws + WS_ROUTE + RT_RSTD))[row] = rstd;
        }
        __syncthreads();
    }
}
__device__ __noinline__ void P_route(KP p_, int l_) { const KP p = uni_kp(p_); const int l = __builtin_amdgcn_readfirstlane(l_); const Ctx c = make_ctx(p); const Bufs b = make_bufs(p->ws);
    ph_moe_route(c, p->out, p->in[14] + (size_t)l * D_, p->in[15] + (size_t)l * D_ * 4, p->in[16] + l * 4, p->in[17] + (size_t)l * D_ * 32, p->in[18] + l * 32, b.HN, (int*)(p->ws + WS_ROUTE + RT_INFO), (float*)(p->ws + WS_ROUTE + RT_W), (unsigned*)(p->ws + WS_CTL) + CW_MOECNT + l * 128); }
__device__ __noinline__ void P_moe(KP p_, int l_) { const KP p = uni_kp(p_); const int l = __builtin_amdgcn_readfirstlane(l_); const Ctx c = make_ctx(p); const Bufs b = make_bufs(p->ws);
    ph_moe_naive(c, b.HN, b.ROUTE_E, b.ROUTE_W, p->in[19] + (size_t)l * NEXP * D_ * DEXP, p->in[20] + (size_t)l * NEXP * D_ * DEXP, p->in[21] + (size_t)l * NEXP * DEXP * D_, p->out); }
__device__ __noinline__ void P_final(KP p_) { const KP p = uni_kp(p_); const Ctx c = make_ctx(p); ph_norm_final_from_bf16(c, (const bf16*)(p->ws + WS_HN), p->in[22], p->out); }
__device__ __forceinline__ void P_gridbar(KP p_) { const KP p = uni_kp(p_);
    XcdBarrier bar; bar.bar = (unsigned*)(p->ws + WS_CTL) + 4096; bar.x = xb_xcc_id(); bar.st = (volatile LAS unsigned*)((LAS unsigned char*)lds_raw + MISC_OFF) + 8;
    xcd_barrier(bar);
}

__global__ void __launch_bounds__(NTHREADS, 2) fwd_kernel(Params pp) {
    const KP p = (KP)__builtin_amdgcn_kernarg_segment_ptr();
    { volatile LAS unsigned* MISC = (volatile LAS unsigned*)((LAS unsigned char*)lds_raw + MISC_OFF); if (threadIdx.x < 32) MISC[threadIdx.x] = 0u; }
    __syncthreads();
    const int lo = p->ph_lo, hi = p->ph_hi;
    if (hi - lo > 1) (void)xcd_barrier_post((unsigned*)(p->ws + WS_CTL) + 4096, (volatile LAS unsigned*)((LAS unsigned char*)lds_raw + MISC_OFF) + 8);
#define IN(k) (lo <= (k) && (k) < hi)
#define SEAM(k) do { if (IN(k) && IN((k) + 1)) P_gridbar(p); } while (0)
    if (IN(0)) { for (int rep = 0; rep < REP_PRO; ++rep) { if (rep) P_gridbar(p); P_prologue(p); } }
    SEAM(0);
    for (int l = 0; l < L_; ++l) {
        const int P0 = 1 + l * PH_PER_LAYER;
        if (IN(P0 + 0)) { for (int rep = 0; rep < REP_NORM; ++rep) { if (rep) P_gridbar(p); P_norm1(p, l); } }
        SEAM(P0 + 0);
        if (IN(P0 + 1)) { for (int rep = 0; rep < REP_INPROJ; ++rep) { if (rep) P_gridbar(p); P_inproj_mfma(l); }
#ifdef REP_INDUMMY
            for (int rep = 0; rep < REP_INDUMMY; ++rep) { P_gridbar(p); P_inproj_dummy(l); }
#endif
        }
        SEAM(P0 + 1);
        if (IN(P0 + 3)) {
            P_cmp1_mfma(l);
            if (launder_s((int)blockIdx.x) < 32) { asm volatile("s_waitcnt vmcnt(0)" ::: "memory"); __builtin_amdgcn_fence(__ATOMIC_SEQ_CST, "agent"); asm volatile("s_waitcnt vmcnt(0)" ::: "memory"); }
            __syncthreads();
            P_cmp2_mfma(l);
            for (int rep = 0; rep < REP_ATT3; ++rep) { if (rep) P_gridbar(p);
            for (;;) { int u = fetch_unit(p, l * 8 + 0 + 16 * rep);
                if (l == 0) {
                    if (u >= 2048 + CONV_UNITS) break;
                    const int k11 = u / 11, r11 = u - 11 * k11;
                    if (r11 == 3 || r11 == 7 || r11 == 10) { U_conv(p, 3 * k11 + (r11 > 3) + (r11 > 7)); continue; }
                    u = 8 * k11 + r11 - (r11 > 3) - (r11 > 7); }
                else if (u >= 2048) break;
                if (u < 1024) { const int qb = 15 - (u >> 6), k = u & 63; if (k < 32) U_diff(p, k, qb, l); else U_fox(p, k - 32, qb, l); }
                else { const int w = u - 1024; U_win(p, w & 15, 63 - (w >> 4));
#ifdef PROBE_WINUNIT2
                    U_win(p, w & 15, 63 - (w >> 4));
#endif
                } } } }
        SEAM(P0 + 3);
        if (IN(P0 + 4)) { for (int rep = 0; rep < REP_CMP; ++rep) { if (rep) P_gridbar(p); for (int u = launder_s((int)blockIdx.x); u < 256; u += (int)gridDim.x) U_cmp(p, u & 15, u >> 4); } }
        SEAM(P0 + 4);
        if (IN(P0 + 5)) { for (int rep = 0; rep < REP_SLC; ++rep) { if (rep) P_gridbar(p); for (;;) { const int u = fetch_unit(p, l * 8 + 1 + 16 * rep); if (u >= 1024) break; U_slc(p, u & 15, 63 - (u >> 4)); } } }
        SEAM(P0 + 5);
        if (IN(P0 + 6)) P_outproj_mfma(l);
        SEAM(P0 + 6);
        if (IN(P0 + 7)) { for (int rep = 0; rep < REP_ROUTE; ++rep) { if (rep) P_gridbar(p); P_route3(l, REP_ROUTE - 1 - rep); } }
        SEAM(P0 + 7);
        if (IN(P0 + 9)) { for (int rep = 0; rep < REP_G1; ++rep) { if (rep) P_gridbar(p); P_moe_g1(l); } }
        SEAM(P0 + 9);
        if (IN(P0 + 10)) P_moe_g2(l);
        SEAM(P0 + 10);
    }
    if (IN(1 + L_ * PH_PER_LAYER)) P_final(p);
#undef IN
#undef SEAM
}

extern "C" void kernel_launch(void* const* d_in, const int* in_sizes, int n_in, void* d_out, int out_size, void* d_ws, size_t ws_size, hipStream_t stream) {
    static int grid = 0;
    if (grid == 0) {
        if (n_in != 23 || out_size != NT * D_ || ws_size < WS_END) { fprintf(stderr, "kernel_launch: unexpected sizes n_in %d out %d ws %zu (need %zu)\n", n_in, out_size, ws_size, (size_t)WS_END); grid = -1; return; }
        int dev = 0, cus = 0, per_cu = 0;
        if (hipGetDevice(&dev) != hipSuccess || hipDeviceGetAttribute(&cus, hipDeviceAttributeMultiprocessorCount, dev) != hipSuccess) { grid = -1; return; }
        if (hipFuncSetAttribute((const void*)fwd_kernel, hipFuncAttributeMaxDynamicSharedMemorySize, LDS_BYTES) != hipSuccess) { fprintf(stderr, "kernel_launch: hipFuncSetAttribute failed\n"); grid = -1; return; }
        if (hipOccupancyMaxActiveBlocksPerMultiprocessor(&per_cu, (const void*)fwd_kernel, NTHREADS, LDS_BYTES) != hipSuccess || per_cu < 1) { fprintf(stderr, "kernel_launch: occupancy query says %d\n", per_cu); }
        (void)hipGetLastError();
        grid = cus;
    }
    if (grid < 0) return;
    (void)hipMemsetAsync((char*)d_ws + WS_CTL, 0, CTL_BYTES, stream);
    Params p{};
    for (int i = 0; i < 23; ++i) p.in[i] = (const float*)d_in[i];
    p.out = (float*)d_out; p.ws = (unsigned char*)d_ws;
#if N_LAUNCH_MODE == 0
    p.ph_lo = 0; p.ph_hi = N_PHASES;
    hipLaunchKernelGGL(fwd_kernel, dim3(grid), dim3(NTHREADS), LDS_BYTES, stream, p);
#else
    for (int k = 0; k < N_PHASES; ++k) { p.ph_lo = k; p.ph_hi = k + 1; hipLaunchKernelGGL(fwd_kernel, dim3(grid), dim3(NTHREADS), LDS_BYTES, stream, p); }
#endif
}
```

```cpp
#include <hip/hip_runtime.h>
#include <cstdio>
#include <cstdint>

#ifndef INPROJ_ALIGN
#define INPROJ_ALIGN true
#endif
#ifndef INPROJ_SP2
#define INPROJ_SP2 true
#endif
#ifndef REP_PRO
#define REP_PRO 1
#endif
#ifndef REP_ROUTE
#define REP_ROUTE 1
#endif
#ifndef REP_NORM
#define REP_NORM 1
#endif
#ifndef REP_INPROJ
#define REP_INPROJ 1
#endif
#ifndef REP_ATT3
#define REP_ATT3 1
#endif
#ifndef REP_CMP
#define REP_CMP 1
#endif
#ifndef REP_SLC
#define REP_SLC 1
#endif
#ifndef REP_SCAT
#define REP_SCAT 1
#endif
#ifndef REP_G1
#define REP_G1 1
#endif
#ifndef N_LAUNCH_MODE
#define N_LAUNCH_MODE 0
#endif

#define LAS __attribute__((address_space(3)))
#define GAS __attribute__((address_space(1)))
typedef unsigned short bf16;
typedef unsigned long long u64;
typedef float f32x4 __attribute__((ext_vector_type(4)));
typedef unsigned u32x4 __attribute__((ext_vector_type(4)));

constexpr int B_ = 8, T_ = 4096, D_ = 1024, NT = B_ * T_, L_ = 2;
constexpr int HD = 64, D_IN = 2844;
constexpr int N_CMP = 255, CMP_HID = 256;
constexpr int NEXP = 32, DEXP = 256;
constexpr float EPS = 1e-6f;
constexpr float LOG2E = 1.4426950408889634f;
constexpr int NWAVES = 8, NTHREADS = 512;

constexpr int C_NSAQ = 0, C_KV6 = 512, C_GATE = 1280, C_FQ = 1304, C_FF = 2072, C_DQ = 2076, C_DV = 2588;

constexpr size_t MiB = 1u << 20;
constexpr size_t WS_CTL = 0, CTL_BYTES = 1 * MiB;
constexpr size_t WS_QN = 1 * MiB;
constexpr size_t WS_KV6 = WS_QN + 32 * MiB;
constexpr size_t KV6_STRIDE = 8 * MiB + 64 * 1024;
constexpr size_t WS_FQKV = WS_KV6 + 6 * KV6_STRIDE;
constexpr size_t WS_DQK = WS_FQKV + 48 * MiB;
constexpr size_t WS_DV = WS_DQK + 32 * MiB;
constexpr size_t WS_GATE = WS_DV + 16 * MiB;
constexpr size_t WS_FL = WS_GATE + 3 * MiB;
constexpr size_t WS_HC = WS_FL + 1 * MiB;
constexpr size_t WS_KVCMP = WS_HC + 4 * MiB;
constexpr size_t WS_SEL = WS_KVCMP + 1 * MiB;
constexpr size_t WS_OCMP = WS_SEL + 1 * MiB;
constexpr size_t WS_OWIN = WS_OCMP + 32 * MiB;
constexpr size_t WS_HN = WS_OWIN + 32 * MiB;
constexpr size_t WS_ATT = WS_HN + 64 * MiB;
constexpr size_t WS_ROUTE = WS_ATT + 64 * MiB;
constexpr size_t WS_WIN_T = WS_ROUTE + 2 * MiB;
constexpr size_t WS_WOUT_T = WS_WIN_T + 12 * MiB;
constexpr size_t WS_WGU_T = WS_WOUT_T + 4 * MiB;
constexpr size_t WS_WD_T = WS_WGU_T + 64 * MiB;
constexpr size_t WS_W1_T = WS_WD_T + 32 * MiB;
constexpr size_t WS_W2_T = WS_W1_T + 4 * MiB;
constexpr size_t WS_BIAS1 = WS_W2_T + 512 * 1024;
constexpr size_t WS_WR = WS_BIAS1 + 512 * 1024;
constexpr size_t WS_B1PART = WS_WR + 512 * 1024;
constexpr size_t WS_END = WS_B1PART + 512 * 1024;
constexpr int MOE_MAXROWS = 61440;
constexpr size_t WS_XS = WS_QN;
constexpr size_t WS_HB = WS_OCMP;
static_assert(WS_XS + (size_t)MOE_MAXROWS * 2048 <= WS_DQK && WS_HB + (size_t)MOE_MAXROWS * 1024 <= WS_HN, "MoE aliases");
constexpr size_t RT_INFO = 0, RT_W = 128 * 1024, RT_ROWTOK = 384 * 1024, RT_ROWW = 640 * 1024, RT_RSTD = 1152 * 1024;
constexpr int CW_QUEUE = 16384, CW_MOECNT = 32768, CW_KN = 49152, MOE_CS = 32, MOE_LS = 4096;
constexpr size_t WS_REC = WS_QN;
constexpr unsigned ZROW_OFF = 512 * 1024;
static_assert(WS_REC + (size_t)112 * 32768 * 16 <= WS_DQK && WS_HN + (size_t)NT * 2048 < (1ull << 32), "MoE record table / 32-bit row offsets");
constexpr int TBL_OFF = 131072 + 1024;
constexpr int NIN = 3072;

extern __shared__ __attribute__((aligned(16))) unsigned char lds_raw[];
__device__ __forceinline__ float bf2f(bf16 v) { return __uint_as_float(((unsigned)v) << 16); }
__device__ __forceinline__ unsigned f2bf(float f) { unsigned u = __float_as_uint(f); return (u + 0x7fffu + ((u >> 16) & 1u)) >> 16; }
__device__ __forceinline__ unsigned pk2(float lo, float hi) { return f2bf(lo) | (f2bf(hi) << 16); }
__device__ __forceinline__ float wave_sum(float v) {
#pragma unroll
    for (int o = 1; o < 64; o <<= 1) v += __shfl_xor(v, o);
    return v;
}
__device__ __forceinline__ float wave_max(float v) {
#pragma unroll
    for (int o = 1; o < 64; o <<= 1) v = fmaxf(v, __shfl_xor(v, o));
    return v;
}
__device__ __forceinline__ float shflx_f(float v, int o, int lane) { return __uint_as_float((unsigned)__builtin_amdgcn_ds_bpermute((lane ^ o) << 2, (int)__float_as_uint(v))); }
__device__ __forceinline__ unsigned shflx_u(unsigned v, int o, int lane) { return (unsigned)__builtin_amdgcn_ds_bpermute((lane ^ o) << 2, (int)v); }
__device__ __forceinline__ float wave_sum_l(float v, int lane) {
#pragma unroll
    for (int o = 1; o < 64; o <<= 1) v += shflx_f(v, o, lane);
    return v;
}
__device__ __forceinline__ int launder_s(int v) { asm volatile("" : "+s"(v)); return v; }
__device__ __forceinline__ float sigmoidf_(float x) { return 1.f / (1.f + __expf(-x)); }
__device__ __forceinline__ float log_sigmoidf_(float x) { return x >= 0.f ? -log1pf(__expf(-x)) : x - log1pf(__expf(x)); }
__device__ __forceinline__ float gelu_tanh(float x) { const float u = 0.7978845608028654f * (x + 0.044715f * x * x * x); return 0.5f * x * (1.f + tanhf(u)); }
__device__ __forceinline__ float alibi_slope(int idx1, int n) { return exp2f(-8.0f * (float)idx1 / (float)n); }

__device__ __forceinline__ constexpr int b64_off(int t, int d) { return ((t >> 4) * 2 + (d >> 5)) * 512 + (t & 15) * 32 + (d & 31); }
#define XB_TMO      128
#define XB_XCNT(j)  (256  + 64 * (j))
#define XB_XSUB(j)  (1280 + 64 * (j))
#define XB_XGEN(j)  (2304 + 64 * (j))
#define XB_TOP      3328
#define XB_TOPGEN   3392
#define XCD_BAR_WORDS 3456
#define XB_SPIN_CAP (1u << 25)
__device__ __forceinline__ unsigned xb_ld(unsigned* p)              { return __hip_atomic_load(p, __ATOMIC_RELAXED, __HIP_MEMORY_SCOPE_AGENT); }
__device__ __forceinline__ unsigned xb_add(unsigned* p, unsigned v) { return __hip_atomic_fetch_add(p, v, __ATOMIC_RELAXED, __HIP_MEMORY_SCOPE_AGENT); }
__device__ __forceinline__ unsigned xb_xcc_id() { return (unsigned)__builtin_amdgcn_s_getreg((3 << 11) | 20) & 0xFu; }
#define XB_SPIN(cond, bar) do { unsigned _sp = 0; while (cond) { __builtin_amdgcn_s_sleep(1); \
    if ((++_sp & 255u) == 0u) { if (xb_ld(&(bar)[XB_TMO])) break; if (_sp > XB_SPIN_CAP) { atomicAdd(&(bar)[XB_TMO], 1u); break; } } } } while (0)
struct XcdBarrier { unsigned* bar; unsigned x; volatile LAS unsigned* st; };
__device__ __forceinline__ XcdBarrier xcd_barrier_post(unsigned* bar, volatile LAS unsigned* st) {
    XcdBarrier b; b.bar = bar; b.x = xb_xcc_id(); b.st = st;
    if (threadIdx.x == 0) (void)xb_add(&bar[XB_XCNT(b.x)], 1u);
    return b;
}
__device__ __forceinline__ void xcd_barrier_complete(unsigned* bar, unsigned x, unsigned& nloc, unsigned& nx) {
    const unsigned G = gridDim.x * gridDim.y * gridDim.z;
    unsigned sum, cnt, mine, sp = 0u;
    for (;;) {
        sum = 0u; cnt = 0u; mine = 0u;
#pragma unroll
        for (unsigned j = 0; j < 16; ++j) { const unsigned c = xb_ld(&bar[XB_XCNT(j)]); sum += c; cnt += (c > 0u) ? 1u : 0u; mine = (j == x) ? c : mine; }
        if (sum == G) break;
        __builtin_amdgcn_s_sleep(1);
        if ((++sp & 255u) == 0u) { if (xb_ld(&bar[XB_TMO])) break; if (sp > XB_SPIN_CAP) { atomicAdd(&bar[XB_TMO], 1u); break; } }
    }
    nloc = mine > 0u ? mine : 1u; nx = cnt > 0u ? cnt : 1u;
}
__device__ __forceinline__ void xcd_barrier(const XcdBarrier& b) {
    asm volatile("s_waitcnt vmcnt(0)" ::: "memory");
    __syncthreads();
    if (threadIdx.x == 0) {
        unsigned* bar = b.bar;
        __builtin_amdgcn_s_waitcnt(0);
        unsigned nloc = b.st[0], nx = b.st[1];
        if (nloc == 0u) { xcd_barrier_complete(bar, b.x, nloc, nx); b.st[0] = nloc; b.st[1] = nx; }
        const unsigned old = xb_add(&bar[XB_XSUB(b.x)], 1u);
        const unsigned gen = old / nloc;
        if (old + 1u == (gen + 1u) * nloc) {
            __builtin_amdgcn_fence(__ATOMIC_RELEASE, "agent");
            asm volatile("s_waitcnt vmcnt(0)" ::: "memory");
            const unsigned og = xb_add(&bar[XB_TOP], 1u);
            const unsigned tg = og / nx;
            if (og + 1u == (tg + 1u) * nx) xb_add(&bar[XB_TOPGEN], 1u);
            else XB_SPIN(xb_ld(&bar[XB_TOPGEN]) == tg, bar);
            __builtin_amdgcn_fence(__ATOMIC_ACQUIRE, "agent");
            xb_add(&bar[XB_XGEN(b.x)], 1u);
            asm volatile("s_waitcnt vmcnt(0)" ::: "memory");
        } else {
            XB_SPIN(xb_ld(&bar[XB_XGEN(b.x)]) == gen, bar);
            __builtin_amdgcn_fence(__ATOMIC_ACQUIRE, "agent");
            asm volatile("s_waitcnt vmcnt(0)" ::: "memory");
        }
    }
    __syncthreads();
}

struct Params { const float* in[23]; float* out; unsigned char* ws; int ph_lo, ph_hi; };
constexpr int LDS_BYTES = 147456;
constexpr int MISC_OFF = 131072 + 320;

struct Ctx {
    LAS unsigned char* lds; int tid, lane, wave, bid, G, gw, ngw;
    const float* const* in; float* xcur; unsigned char* ws;
};

namespace pg8 {
#define PG8_LAS __attribute__((address_space(3)))
typedef unsigned short bf16_t;
typedef short bf16x8 __attribute__((ext_vector_type(8)));
typedef float f32x4 __attribute__((ext_vector_type(4)));
typedef unsigned u32x4 __attribute__((ext_vector_type(4)));
constexpr int BM = 256, BK = 64, HALF = 128, HTB = HALF * BK * 2  , STAGE_BYTES = 8 * HTB, NXCD = 8, WGM = 8;

__host__ __device__ __forceinline__ int lds_byte(int r, int c) { const int st = (r >> 4) * 2 + (c >> 5), rr = r & 15, cc = c & 31, ob = rr * 64 + cc * 2; return st * 1024 + (ob ^ (((ob >> 9) & 1) << 5)); }
__host__ __device__ __forceinline__ void stage_rc(int b, int& R, int& C) { const int st = b / 1024, sb = b % 1024, swz = sb ^ (((sb >> 9) & 1) << 5); R = (st >> 1) * 16 + swz / 64; C = (st & 1) * 32 + (swz % 64) / 2; }
__host__ __device__ __forceinline__ int perm32(int rho) { const int n = rho >> 4, i = rho & 15; return 8 * (i >> 2) + 4 * n + (i & 3); }

struct Unit { int pm, pn; const char* a; const char* b; const char* b2; };
struct Gemm { int lda, ldb, K, ksplit, arb, acb; };

__device__ __forceinline__ unsigned cvt_pk_bf16(float lo, float hi) { unsigned r; asm volatile("v_cvt_pk_bf16_f32 %0, %1, %2" : "=v"(r) : "v"(lo), "v"(hi)); return r; }
typedef float f32x2 __attribute__((ext_vector_type(2)));

template <class Epi, class Sched, bool ALIGN_EPI = false, bool SP2 = false, bool GATHER = false>
__device__ __forceinline__ void gemm_phase(PG8_LAS unsigned char* lds, const Gemm g, const Sched& S, const Epi& E) {
    static_assert(!GATHER || SP2, "GATHER is written for the SP2 loop");
    int tid_ = threadIdx.x; asm volatile("" : "+v"(tid_));
    const int tid = tid_, wid = __builtin_amdgcn_readfirstlane(tid >> 6), lane = tid & 63, wr = wid >> 2, wc = wid & 3, fr = lane & 15, fq = lane >> 4;
    const int K = g.K, nt = K / BK, ks = g.ksplit;
    unsigned voffA[2], voffB[2];
#pragma unroll
    for (int i = 0; i < 2; ++i) { int R, C; stage_rc(tid * 16 + i * 8192, R, C); const int Rb = Epi::PERM ? ((R & ~31) + perm32(R & 31)) : R;
        voffA[i] = g.arb ? (unsigned)(((R / g.arb) * (K / g.acb) + C / g.acb) * (g.arb * g.acb) + (R % g.arb) * g.acb + (C % g.acb)) * 2u : (unsigned)(R * g.lda + C) * 2u; voffB[i] = (unsigned)(Rb * g.ldb + C) * 2u; }
    const size_t kstep = (size_t)(BK * 2), kstepA = g.arb ? (size_t)(BK * g.arb * 2) : kstep;
    const size_t hsA = (size_t)HALF * (g.arb ? K : g.lda) * 2, hsB = (size_t)HALF * g.ldb * 2;
    const unsigned ldsw = (unsigned)wid * 1024u;
    const int aoff = lds_byte(wr * 64 + fr, fq * 8), boff = lds_byte(wc * 32 + fr, fq * 8);
#define PG8_SA(b, h) (((b) * 2 + (h)) * HTB)
#define PG8_SB(b, h) ((4 + (b) * 2 + (h)) * HTB)
#define PG8_STAGE(bufoff, gbase, voff) do { _Pragma("unroll") for (int _i = 0; _i < 2; ++_i) \
        __builtin_amdgcn_global_load_lds((const unsigned*)((const char*)(gbase) + (voff)[_i]), (PG8_LAS unsigned*)(lds + (bufoff) + ldsw + _i * 8192), 16, 0, 0); } while (0)
#define PG8_LDA(dst, b, h) do { _Pragma("unroll") for (int m = 0; m < 4; ++m) _Pragma("unroll") for (int k = 0; k < 2; ++k) dst[m][k] = *(const PG8_LAS bf16x8*)(lds + PG8_SA(b, h) + aoff + m * 2048 + k * 1024); } while (0)
#define PG8_LDB(dst, b, h) do { _Pragma("unroll") for (int n = 0; n < 2; ++n) _Pragma("unroll") for (int k = 0; k < 2; ++k) dst[n][k] = *(const PG8_LAS bf16x8*)(lds + PG8_SB(b, h) + boff + n * 2048 + k * 1024); } while (0)
#define PG8_MMA(ai, bj, At, Bt) do { __builtin_amdgcn_s_setprio(1); _Pragma("unroll") for (int m = 0; m < 4; ++m) _Pragma("unroll") for (int n = 0; n < 2; ++n) _Pragma("unroll") for (int k = 0; k < 2; ++k) \
        acc[ai][bj][m][n] = __builtin_amdgcn_mfma_f32_16x16x32_bf16(Bt[n][k], At[m][k], acc[ai][bj][m][n], 0, 0, 0); __builtin_amdgcn_s_setprio(0); } while (0)
#define PG8_WAIT_V(n) asm volatile("s_waitcnt vmcnt(" #n ")" ::: "memory")
#define PG8_WAIT_L(n) asm volatile("s_waitcnt lgkmcnt(" #n ")" ::: "memory")
#define PG8_BAR __builtin_amdgcn_s_barrier()
#define PG8_SCHED __builtin_amdgcn_sched_barrier(0)
    Unit cur, nxt; int ui = 0;
    if (!S.next(0, cur)) return;
    unsigned gC[2][2] = {{0u, 0u}, {0u, 0u}}, gN[2][2] = {{0u, 0u}, {0u, 0u}}; const char* gbase = nullptr;
#define PG8_GOFFS(U, Gv) do { _Pragma("unroll") for (int _h = 0; _h < 2; ++_h) _Pragma("unroll") for (int _i = 0; _i < 2; ++_i) { int R_, C_; stage_rc(tid * 16 + _i * 8192, R_, C_); Gv[_h][_i] = S.arow(U, _h * HALF + R_) + (unsigned)C_ * 2u; } } while (0)
#define PG8_STAGE_G(bufoff, kbyte, Gv, h) do { _Pragma("unroll") for (int _i = 0; _i < 2; ++_i) \
        __builtin_amdgcn_global_load_lds((const unsigned*)(gbase + (size_t)(kbyte) + Gv[h][_i]), (PG8_LAS unsigned*)(lds + (bufoff) + ldsw + _i * 8192), 16, 0, 0); } while (0)
    if constexpr (GATHER) { gbase = S.abase(); PG8_GOFFS(cur, gC); }
    f32x4 acc[2][2][4][2];
#pragma unroll
    for (int a = 0; a < 2; ++a)
#pragma unroll
        for (int b = 0; b < 2; ++b)
#pragma unroll
            for (int m = 0; m < 4; ++m)
#pragma unroll
                for (int n = 0; n < 2; ++n) acc[a][b][m][n] = (f32x4){0.f, 0.f, 0.f, 0.f};
    bf16x8 At[4][2], B0[2][2], B1[2][2];
    const char* cA = cur.a; const char* cB = cur.b; const char* cB2 = cur.b2;
#define PG8_BK(base, base2, kt) ((kt) < ks ? (base) + (size_t)(kt) * kstep : (base2) + (size_t)((kt) - ks) * kstep)
    S.a_ready(cur);
    if constexpr (SP2) {
        PG8_STAGE(PG8_SB(0, 0), cB, voffB); PG8_STAGE(PG8_SB(0, 1), cB + hsB, voffB);
        if constexpr (GATHER) { PG8_STAGE_G(PG8_SA(0, 0), 0, gC, 0); PG8_STAGE_G(PG8_SA(0, 1), 0, gC, 1); } else { PG8_STAGE(PG8_SA(0, 0), cA, voffA); PG8_STAGE(PG8_SA(0, 1), cA + hsA, voffA); }
        if (wr == 1) PG8_BAR;
        PG8_WAIT_V(2); PG8_BAR;
        PG8_STAGE(PG8_SB(1, 0), PG8_BK(cB, cB2, 1), voffB);
        if constexpr (GATHER) PG8_STAGE_G(PG8_SA(1, 0), kstep, gC, 0); else PG8_STAGE(PG8_SA(1, 0), cA + kstepA, voffA);
        PG8_STAGE(PG8_SB(1, 1), PG8_BK(cB, cB2, 1) + hsB, voffB);
        PG8_WAIT_V(6); PG8_BAR;
    } else {
        PG8_STAGE(PG8_SB(0, 0), cB, voffB); PG8_STAGE(PG8_SA(0, 0), cA, voffA); PG8_STAGE(PG8_SB(0, 1), cB + hsB, voffB); PG8_STAGE(PG8_SA(0, 1), cA + hsA, voffA);
        if (wr == 1) PG8_BAR;
        PG8_WAIT_V(4); PG8_BAR;
        PG8_STAGE(PG8_SB(1, 0), PG8_BK(cB, cB2, 1), voffB); PG8_STAGE(PG8_SA(1, 0), cA + kstepA, voffA); PG8_STAGE(PG8_SB(1, 1), PG8_BK(cB, cB2, 1) + hsB, voffB);
        PG8_WAIT_V(6); PG8_BAR;
    }
    for (;;) {
        const bool has_next = S.next(ui + 1, nxt);
        if constexpr (GATHER) { if (has_next) PG8_GOFFS(nxt, gN); else { _Pragma("unroll") for (int _h = 0; _h < 2; ++_h) _Pragma("unroll") for (int _i = 0; _i < 2; ++_i) gN[_h][_i] = gC[_h][_i]; } }
        const char* nA = has_next ? nxt.a : cA; const char* nB = has_next ? nxt.b : cB; const char* nB2 = has_next ? nxt.b2 : cB2;
#pragma unroll 1
        for (int t = 0; t < nt; t += 2) {
            const bool last = (t == nt - 2);
            const char* a1 = cA + (size_t)(t + 1) * kstepA;
            const char* a2 = last ? nA : cA + (size_t)(t + 2) * kstepA; const char* b2 = last ? PG8_BK(nB, nB2, 0) : PG8_BK(cB, cB2, t + 2);
            const char* a3 = a2 + kstepA; const char* b3 = last ? PG8_BK(nB, nB2, 1) : PG8_BK(cB, cB2, t + 3);
            if (last && has_next) S.a_ready(nxt);
            if constexpr (SP2) {
            PG8_LDB(B0, 0, 0); PG8_LDB(B1, 0, 1); PG8_SCHED; PG8_LDA(At, 0, 0);
            if constexpr (GATHER) PG8_STAGE_G(PG8_SA(1, 1), (size_t)(t + 1) * kstep, gC, 1); else PG8_STAGE(PG8_SA(1, 1), a1 + hsA, voffA);
            PG8_WAIT_V(8); PG8_WAIT_L(0); PG8_BAR; PG8_MMA(0, 0, At, B0); PG8_MMA(0, 1, At, B1); PG8_BAR; PG8_SCHED;
            PG8_LDA(At, 0, 1); PG8_STAGE(PG8_SB(0, 0), b2, voffB); PG8_STAGE(PG8_SB(0, 1), b2 + hsB, voffB);
            if constexpr (GATHER) { if (last) PG8_STAGE_G(PG8_SA(0, 0), 0, gN, 0); else PG8_STAGE_G(PG8_SA(0, 0), (size_t)(t + 2) * kstep, gC, 0); } else PG8_STAGE(PG8_SA(0, 0), a2, voffA);
            PG8_WAIT_V(8); PG8_WAIT_L(0); PG8_BAR; PG8_MMA(1, 0, At, B0); PG8_MMA(1, 1, At, B1); PG8_BAR; PG8_SCHED;
            PG8_LDB(B0, 1, 0); PG8_LDB(B1, 1, 1); PG8_SCHED; PG8_LDA(At, 1, 0);
            if constexpr (GATHER) { if (last) PG8_STAGE_G(PG8_SA(0, 1), 0, gN, 1); else PG8_STAGE_G(PG8_SA(0, 1), (size_t)(t + 2) * kstep, gC, 1); } else PG8_STAGE(PG8_SA(0, 1), a2 + hsA, voffA);
            PG8_WAIT_V(8); PG8_WAIT_L(0); PG8_BAR; PG8_MMA(0, 0, At, B0); PG8_MMA(0, 1, At, B1); PG8_BAR; PG8_SCHED;
            PG8_LDA(At, 1, 1); PG8_STAGE(PG8_SB(1, 0), b3, voffB); PG8_STAGE(PG8_SB(1, 1), b3 + hsB, voffB);
            if constexpr (GATHER) { if (last) PG8_STAGE_G(PG8_SA(1, 0), kstep, gN, 0); else PG8_STAGE_G(PG8_SA(1, 0), (size_t)(t + 3) * kstep, gC, 0); } else PG8_STAGE(PG8_SA(1, 0), a3, voffA);
            PG8_WAIT_V(8); PG8_WAIT_L(0); PG8_BAR; PG8_MMA(1, 0, At, B0); PG8_MMA(1, 1, At, B1); PG8_BAR; PG8_SCHED;
            } else {
            PG8_LDB(B0, 0, 0); PG8_SCHED; PG8_LDA(At, 0, 0); PG8_STAGE(PG8_SA(1, 1), a1 + hsA, voffA);
            PG8_WAIT_L(8); PG8_BAR; PG8_WAIT_L(0); PG8_MMA(0, 0, At, B0); PG8_BAR; PG8_SCHED;
            PG8_LDB(B1, 0, 1); PG8_STAGE(PG8_SB(0, 0), b2, voffB);
            PG8_BAR; PG8_WAIT_L(0); PG8_MMA(0, 1, At, B1); PG8_BAR;
            PG8_LDA(At, 0, 1); PG8_STAGE(PG8_SA(0, 0), a2, voffA);
            PG8_BAR; PG8_WAIT_L(0); PG8_MMA(1, 0, At, B0); PG8_BAR; PG8_SCHED;
            PG8_STAGE(PG8_SB(0, 1), b2 + hsB, voffB);
            PG8_WAIT_V(6); PG8_BAR; PG8_MMA(1, 1, At, B1); PG8_BAR;
            PG8_LDB(B0, 1, 0); PG8_SCHED; PG8_LDA(At, 1, 0); PG8_STAGE(PG8_SA(0, 1), a2 + hsA, voffA);
            PG8_WAIT_L(8); PG8_BAR; PG8_WAIT_L(0); PG8_MMA(0, 0, At, B0); PG8_BAR; PG8_SCHED;
            PG8_LDB(B1, 1, 1); PG8_STAGE(PG8_SB(1, 0), b3, voffB);
            PG8_BAR; PG8_WAIT_L(0); PG8_MMA(0, 1, At, B1); PG8_BAR;
            PG8_LDA(At, 1, 1); PG8_STAGE(PG8_SA(1, 0), a3, voffA);
            PG8_BAR; PG8_WAIT_L(0); PG8_MMA(1, 0, At, B0); PG8_BAR; PG8_SCHED;
            PG8_STAGE(PG8_SB(1, 1), b3 + hsB, voffB);
            PG8_WAIT_V(6); PG8_BAR; PG8_MMA(1, 1, At, B1); PG8_BAR;
            }
        }
        if constexpr (ALIGN_EPI) { if (wr == 0) PG8_BAR; }
        if constexpr (!Epi::AFTER_DRAIN) { E(acc, cur, wr, wc, fr, fq); S.done(cur); }
        if (!has_next) break;
#pragma unroll
        for (int a = 0; a < 2; ++a)
#pragma unroll
            for (int b = 0; b < 2; ++b)
#pragma unroll
                for (int m = 0; m < 4; ++m)
#pragma unroll
                    for (int n = 0; n < 2; ++n) acc[a][b][m][n] = (f32x4){0.f, 0.f, 0.f, 0.f};
        cur = nxt; cA = nA; cB = nB; cB2 = nB2; ++ui;
        if constexpr (GATHER) { _Pragma("unroll") for (int _h = 0; _h < 2; ++_h) _Pragma("unroll") for (int _i = 0; _i < 2; ++_i) gC[_h][_i] = gN[_h][_i]; }
        if constexpr (ALIGN_EPI) { if (wr == 1) PG8_BAR; }
    }
    PG8_WAIT_V(0);
    if constexpr (!ALIGN_EPI) { if (wr == 0) PG8_BAR; }
    PG8_BAR;
    if constexpr (Epi::AFTER_DRAIN) { E.fused(acc, cur, wr, wc, fr, fq, lds, wid, lane); S.done(cur); }
#undef PG8_BK
#undef PG8_GOFFS
#undef PG8_STAGE_G
#undef PG8_SA
#undef PG8_SB
#undef PG8_STAGE
#undef PG8_LDA
#undef PG8_LDB
#undef PG8_MMA
#undef PG8_WAIT_V
#undef PG8_WAIT_L
#undef PG8_BAR
#undef PG8_SCHED
}
}

struct PlainOrder {
    const char* A; const char* Bt; int lda, ldb, nM, nN, nwg, G, c;
    __device__ __forceinline__ void init(const void* A_, const void* Bt_, int lda_, int ldb_, int M, int N, int G_, int c_) { A = (const char*)A_; Bt = (const char*)Bt_; lda = lda_; ldb = ldb_; nM = M / 256; nN = N / 256; nwg = nM * nN; G = G_; c = c_; }
    __device__ __forceinline__ bool next(int i, pg8::Unit& u) const {
        const long L = (long)i * G + c; if (L >= nwg) return false;
        int wgid = (int)L; { const int q = nwg / 8, r = nwg % 8, xcd = wgid % 8, off = wgid / 8; wgid = (xcd < r ? xcd * (q + 1) : r * (q + 1) + (xcd - r) * q) + off; }
        const int nig = 8 * nN, gid = wgid / nig, fm = gid * 8, gsz = (nM - fm) < 8 ? (nM - fm) : 8;
        u.pm = fm + ((wgid % nig) % gsz); u.pn = (wgid % nig) / gsz;
        u.a = A + (size_t)u.pm * 256 * lda * 2; u.b = Bt + (size_t)u.pn * 256 * ldb * 2; u.b2 = u.b; return true;
    }
    __device__ __forceinline__ void a_ready(const pg8::Unit&) const {}
    __device__ __forceinline__ void done(const pg8::Unit&) const {}
};
struct EpiInProj {
    static constexpr bool PERM = true, AFTER_DRAIN = false;
    unsigned char* ws; const float* b_gate; const float* b_fgt; unsigned* kn;
    __device__ __forceinline__ void operator()(const pg8::f32x4 (&acc)[2][2][4][2], const pg8::Unit& u, int wr, int wc, int fr, int fq) const {
        { int t_ = threadIdx.x; asm volatile("" : "+v"(t_)); fr = t_ & 15; fq = (t_ >> 4) & 3; }
        const int pn = u.pn, b = (u.pm * 256) / T_, t0 = u.pm * 256 - b * T_ + wr * 64 + fr;
        if (pn == 11) {
            if (wc == 0 && fq < 4) {
                float* gate = (float*)(ws + WS_GATE); float* fl = (float*)(ws + WS_FL);
#pragma unroll
                for (int ai = 0; ai < 2; ++ai)
#pragma unroll
                    for (int m = 0; m < 4; ++m) { const int t = t0 + ai * 128 + m * 16; const size_t n = (size_t)b * T_ + t;
#pragma unroll
                        for (int nn = 0; nn < 2; ++nn)
#pragma unroll
                            for (int e = 0; e < 4; ++e) { const int c = 8 * fq + 4 * nn + e; const float v = acc[ai][0][m][nn][e];
                                if (c < 24) gate[n * 24 + c] = __builtin_amdgcn_rcpf(1.f + __builtin_amdgcn_exp2f(-(v + b_gate[c]) * LOG2E));
                                else if (c < 28) { const float z = v + b_fgt[c - 24];
                                    fl[(size_t)(b * 4 + (c - 24)) * T_ + t] = z < -30.f ? z : -0.6931471805599453f * __builtin_amdgcn_logf(1.f + __builtin_amdgcn_exp2f(-z * LOG2E)); } } }
            }
            return;
        }
        if (pn == 6 || pn == 9) {
            const int lane_ = (fq << 4) | fr;
#pragma unroll
            for (int bj = 0; bj < 2; ++bj)
#pragma unroll
                for (int ai = 0; ai < 2; ++ai) { float mx = 0.f;
#pragma unroll
                    for (int m = 0; m < 4; ++m) { const pg8::f32x4 v0 = acc[ai][bj][m][0], v1 = acc[ai][bj][m][1];
                        float ss = (v0[0] * v0[0] + v0[1] * v0[1]) + (v0[2] * v0[2] + v0[3] * v0[3]) + (v1[0] * v1[0] + v1[1] * v1[1]) + (v1[2] * v1[2] + v1[3] * v1[3]);
                        ss += shflx_f(ss, 16, lane_); ss += shflx_f(ss, 32, lane_); mx = fmaxf(mx, ss); }
#pragma unroll
                    for (int o = 1; o < 16; o <<= 1) mx = fmaxf(mx, shflx_f(mx, o, lane_));
                    if (lane_ == 0) { const int cg = bj * 4 + wc, tile = (u.pm * 256 - b * T_ + ai * 128 + wr * 64) >> 6;
                        unsigned* dst = pn == 6 ? kn + ((b * 4 + (cg >> 1)) * 64 + tile) * 2 + (cg & 1) : kn + 4096 + (b * 8 + cg) * 64 + tile;
                        atomicMax(dst, __float_as_uint(mx)); } }
        }
#pragma unroll
        for (int bj = 0; bj < 2; ++bj) {
            const int c = bj * 128 + wc * 32 + 8 * fq;
            bf16* base; int W = 64; float sc = 1.f;
            if (pn < 2) { base = (bf16*)(ws + WS_QN) + (size_t)(b * 8 + pn * 4 + (c >> 6)) * T_ * 64 + (c & 63); sc = 0.125f * LOG2E; }
            else if (pn < 5) { base = (bf16*)(ws + WS_KV6 + (size_t)((pn - 2) * 2 + (c >> 7)) * KV6_STRIDE) + (size_t)(b * 2 + ((c >> 6) & 1)) * T_ * 64 + (c & 63); }
            else if (pn < 8) { base = (bf16*)(ws + WS_FQKV) + (size_t)(pn - 5) * (8 * MiB) + (size_t)(b * 4 + (c >> 6)) * T_ * 64 + (c & 63); if (pn == 5) sc = 0.125f * LOG2E; }
            else if (pn < 10) { base = (bf16*)(ws + WS_DQK) + (size_t)(pn - 8) * (8 * MiB) + (size_t)(b * 8 + (c >> 5)) * T_ * 32 + (c & 31); W = 32; if (pn == 8) sc = 0.17677669529663687f * LOG2E; }
            else { base = (bf16*)(ws + WS_DV) + (size_t)(b * 4 + (c >> 6)) * T_ * 64 + (c & 63); }
            const bool blk = W == 64 && pn != 2;
            if (blk) base += -(c & 63) + ((c >> 5) & 1) * 512 + (c & 31);
#pragma unroll
            for (int ai = 0; ai < 2; ++ai)
#pragma unroll
                for (int m = 0; m < 4; ++m) { const int t = t0 + ai * 128 + m * 16;
                    const pg8::f32x4 v0 = acc[ai][bj][m][0] * sc, v1 = acc[ai][bj][m][1] * sc;
                    pg8::u32x4 w; w.x = pg8::cvt_pk_bf16(v0[0], v0[1]); w.y = pg8::cvt_pk_bf16(v0[2], v0[3]); w.z = pg8::cvt_pk_bf16(v1[0], v1[1]); w.w = pg8::cvt_pk_bf16(v1[2], v1[3]);
                    *(pg8::u32x4*)(base + (blk ? (size_t)((t >> 4) * 1024 + (t & 15) * 32) : (size_t)t * W)) = w; }
        }
    }
};
__device__ __forceinline__ u32x4 res_add8(u32x4 w, const pg8::f32x4& a0, const pg8::f32x4& a1) {
    u32x4 o;
    o.x = pg8::cvt_pk_bf16(__uint_as_float(w.x << 16) + a0[0], __uint_as_float(w.x & 0xffff0000u) + a0[1]); o.y = pg8::cvt_pk_bf16(__uint_as_float(w.y << 16) + a0[2], __uint_as_float(w.y & 0xffff0000u) + a0[3]);
    o.z = pg8::cvt_pk_bf16(__uint_as_float(w.z << 16) + a1[0], __uint_as_float(w.z & 0xffff0000u) + a1[1]); o.w = pg8::cvt_pk_bf16(__uint_as_float(w.w << 16) + a1[2], __uint_as_float(w.w & 0xffff0000u) + a1[3]);
    return o;
}
struct EpiResBf16 {
    static constexpr bool PERM = true, AFTER_DRAIN = false;
    bf16* xr;
    __device__ __forceinline__ void operator()(const pg8::f32x4 (&acc)[2][2][4][2], const pg8::Unit& u, int wr, int wc, int fr, int fq) const {
        { int t_ = threadIdx.x; asm volatile("" : "+v"(t_)); fr = t_ & 15; fq = (t_ >> 4) & 3; }
#pragma unroll
        for (int ai = 0; ai < 2; ++ai)
#pragma unroll
            for (int m = 0; m < 4; ++m) { const size_t off = (size_t)(u.pm * 256 + ai * 128 + wr * 64 + m * 16 + fr) * D_ + u.pn * 256 + wc * 32 + 8 * fq;
#pragma unroll
                for (int bj = 0; bj < 2; ++bj) { u32x4* q = (u32x4*)(xr + off + bj * 128); *q = res_add8(*q, acc[ai][bj][m][0], acc[ai][bj][m][1]); } }
    }
};


struct EpiDummy {
    static constexpr bool PERM = true, AFTER_DRAIN = false;
    float* dst;
    __device__ __forceinline__ void operator()(const pg8::f32x4 (&acc)[2][2][4][2], const pg8::Unit& u, int wr, int wc, int fr, int fq) const {
        pg8::f32x4 a = {0.f, 0.f, 0.f, 0.f};
#pragma unroll
        for (int ai = 0; ai < 2; ++ai)
#pragma unroll
            for (int bj = 0; bj < 2; ++bj)
#pragma unroll
                for (int m = 0; m < 4; ++m) { a = a + acc[ai][bj][m][0]; a = a + acc[ai][bj][m][1]; }
        *(pg8::f32x4*)(dst + ((size_t)(u.pm * 12 + u.pn) * 512 + threadIdx.x) * 4) = a;
    }
};
struct OneUnitOrder { pg8::Unit u; bool has;
    __device__ __forceinline__ bool next(int i, pg8::Unit& o) const { if (i != 0 || !has) return false; o = u; return true; }
    __device__ __forceinline__ void a_ready(const pg8::Unit&) const {}
    __device__ __forceinline__ void done(const pg8::Unit&) const {} };
__device__ __forceinline__ float gelu_tanh_fast(float x) { const float u2 = 1.5957691216057308f * (x + 0.044715f * x * x * x); return x * __builtin_amdgcn_rcpf(1.f + __builtin_amdgcn_exp2f(-u2 * LOG2E)); }
struct EpiCmpH {
    static constexpr bool PERM = true, AFTER_DRAIN = false;
    bf16* hc; const float* bias1;
    __device__ __forceinline__ void operator()(const pg8::f32x4 (&acc)[2][2][4][2], const pg8::Unit& u, int wr, int wc, int fr, int fq) const {
        { int t_ = threadIdx.x; asm volatile("" : "+v"(t_)); fr = t_ & 15; fq = (t_ >> 4) & 3; }
        const int kv = u.pn;
#pragma unroll
        for (int bj = 0; bj < 2; ++bj) { const int col = bj * 128 + wc * 32 + 8 * fq;
            const pg8::f32x4 b0 = *(const pg8::f32x4*)(bias1 + kv * 256 + col), b1 = *(const pg8::f32x4*)(bias1 + kv * 256 + col + 4);
#pragma unroll
            for (int ai = 0; ai < 2; ++ai)
#pragma unroll
                for (int m = 0; m < 4; ++m) { const int row = u.pm * 256 + ai * 128 + wr * 64 + m * 16 + fr;
                    const pg8::f32x4 v0 = acc[ai][bj][m][0] + b0, v1 = acc[ai][bj][m][1] + b1;
                    pg8::u32x4 w; w.x = pg8::cvt_pk_bf16(gelu_tanh_fast(v0[0]), gelu_tanh_fast(v0[1])); w.y = pg8::cvt_pk_bf16(gelu_tanh_fast(v0[2]), gelu_tanh_fast(v0[3]));
                    w.z = pg8::cvt_pk_bf16(gelu_tanh_fast(v1[0]), gelu_tanh_fast(v1[1])); w.w = pg8::cvt_pk_bf16(gelu_tanh_fast(v1[2]), gelu_tanh_fast(v1[3]));
                    *(pg8::u32x4*)(hc + ((size_t)kv * 4096 + row) * 256 + col) = w; } }
    }
};
struct EpiCmpOut {
    static constexpr bool PERM = true, AFTER_DRAIN = false;
    bf16* kvcmp;
    __device__ __forceinline__ void operator()(const pg8::f32x4 (&acc)[2][2][4][2], const pg8::Unit& u, int wr, int wc, int fr, int fq) const {
        { int t_ = threadIdx.x; asm volatile("" : "+v"(t_)); fr = t_ & 15; fq = (t_ >> 4) & 3; }
        if (wc >= 2) return;
        const int kv = u.pn, col = wc * 32 + 8 * fq;
#pragma unroll
        for (int ai = 0; ai < 2; ++ai)
#pragma unroll
            for (int m = 0; m < 4; ++m) { const int row = u.pm * 256 + ai * 128 + wr * 64 + m * 16 + fr; const float z = ((row & 255) == 255) ? 0.f : 1.f;
                const pg8::f32x4 v0 = acc[ai][0][m][0], v1 = acc[ai][0][m][1];
                pg8::u32x4 w; w.x = pg8::cvt_pk_bf16(z != 0.f ? v0[0] : 0.f, z != 0.f ? v0[1] : 0.f); w.y = pg8::cvt_pk_bf16(z != 0.f ? v0[2] : 0.f, z != 0.f ? v0[3] : 0.f);
                w.z = pg8::cvt_pk_bf16(z != 0.f ? v1[0] : 0.f, z != 0.f ? v1[1] : 0.f); w.w = pg8::cvt_pk_bf16(z != 0.f ? v1[2] : 0.f, z != 0.f ? v1[3] : 0.f);
                *(pg8::u32x4*)(kvcmp + ((size_t)kv * 4096 + row) * 64 + col) = w; }
    }
};

__device__ __forceinline__ void moe_build_tables(const unsigned* cnt, int tid) {
    LAS int* T = (LAS int*)((LAS unsigned char*)lds_raw + TBL_OFF);
    __syncthreads();
    if (tid < 112) T[384 + tid] = (int)cnt[tid * MOE_CS];
    __syncthreads();
    if (tid == 0) { int o = 0; for (int c = 0; c < 112; ++c) { T[c] = o; const int n = (T[384 + c] + 255) >> 8; for (int k = 0; k < n; ++k) T[128 + o + k] = c; o += n; } T[112] = o; }
    __syncthreads();
}
__device__ __forceinline__ void moe_pair(int cls, int& ea, int& eb) { const int grp = cls / 28; int idx = cls % 28, lo = 0; while (idx >= 7 - lo) { idx -= 7 - lo; ++lo; } ea = grp * 8 + lo; eb = grp * 8 + lo + 1 + idx; }
struct MoeOrder1 {
    const char* wsb; const unsigned* rec; const char* wgu; int G, c;
    __device__ __forceinline__ bool next(int i, pg8::Unit& u) const {
        const LAS int* T = (const LAS int*)((LAS unsigned char*)lds_raw + TBL_OFF);
        const int idx = i * G + c; if (idx >= 4 * T[112]) return false;
        const int tile = idx >> 2, pn = idx & 3; int ea, eb; moe_pair(T[128 + tile], ea, eb); const int e = (pn >> 1) ? eb : ea;
        u.pm = tile; u.pn = pn; u.a = wsb; u.b = wgu + ((size_t)e * 512 + (pn & 1) * 256) * 2048; u.b2 = u.b; return true; }
    __device__ __forceinline__ const char* abase() const { return wsb; }
    __device__ __forceinline__ unsigned arow(const pg8::Unit& u, int r) const {
        const LAS int* T = (const LAS int*)((LAS unsigned char*)lds_raw + TBL_OFF);
        const int cls = T[128 + u.pm], vr = (u.pm - T[cls]) * 256 + r;
        unsigned off = ZROW_OFF;
        if (vr < T[384 + cls]) off = (unsigned)WS_HN + rec[((size_t)cls * 32768 + vr) * 4] * 2048u;
        return off; }
    __device__ __forceinline__ void a_ready(const pg8::Unit&) const {}
    __device__ __forceinline__ void done(const pg8::Unit&) const {} };
struct MoeOrder2 {
    const char* hb; const char* wd; int G, c;
    __device__ __forceinline__ bool next(int i, pg8::Unit& u) const {
        const LAS int* T = (const LAS int*)((LAS unsigned char*)lds_raw + TBL_OFF);
        const int idx = i * G + c; if (idx >= 4 * T[112]) return false;
        const int tile = idx >> 2, pn = idx & 3; int ea, eb; moe_pair(T[128 + tile], ea, eb);
        u.pm = tile; u.pn = pn; u.a = hb + (size_t)tile * 256 * 1024; u.b = wd + ((size_t)ea * 1024 + pn * 256) * 512; u.b2 = wd + ((size_t)eb * 1024 + pn * 256) * 512; return true; }
    __device__ __forceinline__ void a_ready(const pg8::Unit&) const {}
    __device__ __forceinline__ void done(const pg8::Unit&) const {} };
struct EpiMoeH {
    static constexpr bool PERM = true, AFTER_DRAIN = false;
    bf16* hb; const u32x4* rec;
    __device__ __forceinline__ void operator()(const pg8::f32x4 (&acc)[2][2][4][2], const pg8::Unit& u, int wr, int wc, int fr, int fq) const {
        { int t_ = threadIdx.x; asm volatile("" : "+v"(t_)); fr = t_ & 15; fq = (t_ >> 4) & 3; }
        const int slot = u.pn >> 1;
        const LAS int* T = (const LAS int*)((LAS unsigned char*)lds_raw + TBL_OFF);
        const int cls = T[128 + u.pm], vr0 = (u.pm - T[cls]) * 256, ncls = T[384 + cls];
#pragma unroll
        for (int ai = 0; ai < 2; ++ai)
#pragma unroll
            for (int m = 0; m < 4; ++m) { const int rr = ai * 128 + wr * 64 + m * 16 + fr; const size_t row = (size_t)u.pm * 256 + rr; float w = 0.f, rs = 0.f;
                if (vr0 + rr < ncls) { const u32x4 q = rec[(size_t)cls * 32768 + vr0 + rr]; w = __uint_as_float(slot ? q.z : q.y); rs = __uint_as_float(q.w); }
#pragma unroll
                for (int bj = 0; bj < 2; ++bj) { const int j0 = (u.pn & 1) * 128 + (bj * 128 + wc * 32 + 8 * fq) / 2;
                    pg8::f32x4 v0 = acc[ai][bj][m][0], v1 = acc[ai][bj][m][1];
#pragma unroll
                    for (int e = 0; e < 4; ++e) { v0[e] *= rs; v1[e] *= rs; }
                    const float h0 = v0[0] * __builtin_amdgcn_rcpf(1.f + __builtin_amdgcn_exp2f(-v0[0] * LOG2E)) * v0[1] * w, h1 = v0[2] * __builtin_amdgcn_rcpf(1.f + __builtin_amdgcn_exp2f(-v0[2] * LOG2E)) * v0[3] * w;
                    const float h2 = v1[0] * __builtin_amdgcn_rcpf(1.f + __builtin_amdgcn_exp2f(-v1[0] * LOG2E)) * v1[1] * w, h3 = v1[2] * __builtin_amdgcn_rcpf(1.f + __builtin_amdgcn_exp2f(-v1[2] * LOG2E)) * v1[3] * w;
                    const int jg = slot * 256 + j0;
                    *(u64*)(hb + ((row >> 4) * 32 + (jg >> 4)) * 256 + (row & 15) * 16 + (jg & 15)) = (u64)pg8::cvt_pk_bf16(h0, h1) | ((u64)pg8::cvt_pk_bf16(h2, h3) << 32); } }
    }
};
struct EpiMoeOut {
    static constexpr bool PERM = true, AFTER_DRAIN = false;
    bf16* x; const unsigned* rec;
    __device__ __forceinline__ void operator()(const pg8::f32x4 (&acc)[2][2][4][2], const pg8::Unit& u, int wr, int wc, int fr, int fq) const {
        { int t_ = threadIdx.x; asm volatile("" : "+v"(t_)); fr = t_ & 15; fq = (t_ >> 4) & 3; }
        bf16* xx = x; const unsigned* rt = rec; asm volatile("" : "+s"(xx), "+s"(rt));
        const LAS int* T = (const LAS int*)((LAS unsigned char*)lds_raw + TBL_OFF);
        const int cls = T[128 + u.pm], vr0 = (u.pm - T[cls]) * 256, ncls = T[384 + cls];
#pragma unroll
        for (int ai = 0; ai < 2; ++ai)
#pragma unroll
            for (int m = 0; m < 4; ++m) { const int rr = ai * 128 + wr * 64 + m * 16 + fr; int tok = -1; if (vr0 + rr < ncls) tok = (int)rt[((size_t)cls * 32768 + vr0 + rr) * 4];
                if (tok >= 0) { bf16* xr = xx + (size_t)tok * D_ + u.pn * 256 + wc * 32 + 8 * fq;
#pragma unroll
                    for (int bj = 0; bj < 2; ++bj) { u32x4* q = (u32x4*)(xr + bj * 128); *q = res_add8(*q, acc[ai][bj][m][0], acc[ai][bj][m][1]); } } }
    }
};

__device__ __forceinline__ void transpose_item(const float* W, int ldw, bf16* WT, int ldt, int r0, int rmul, int k0, LAS float* scr, int lane, const float* gk = nullptr) {
    f32x4 v[8];
#pragma unroll
    for (int i = 0; i < 8; ++i) v[i] = *(const f32x4*)(W + (size_t)(k0 + i * 8 + (lane >> 3)) * ldw + (lane & 7) * 4);
    if (gk) {
#pragma unroll
        for (int i = 0; i < 8; ++i) { const float gsc = gk[k0 + i * 8 + (lane >> 3)]; v[i].x *= gsc; v[i].y *= gsc; v[i].z *= gsc; v[i].w *= gsc; } }
#pragma unroll
    for (int i = 0; i < 8; ++i) { LAS float* d = scr + (i * 8 + (lane >> 3)) * 33 + (lane & 7) * 4; d[0] = v[i].x; d[1] = v[i].y; d[2] = v[i].z; d[3] = v[i].w; }
    asm volatile("s_waitcnt lgkmcnt(0)" ::: "memory");
    const int c = lane & 7;
#pragma unroll
    for (int j = 0; j < 4; ++j) { const int n = (lane >> 3) + 8 * j; const LAS float* sp = scr + (8 * c) * 33 + n;
        u32x4 o; o.x = pk2(sp[0 * 33], sp[1 * 33]); o.y = pk2(sp[2 * 33], sp[3 * 33]); o.z = pk2(sp[4 * 33], sp[5 * 33]); o.w = pk2(sp[6 * 33], sp[7 * 33]);
        *(u32x4*)(WT + (size_t)(r0 + rmul * n) * ldt + k0 + 8 * c) = o; }
    asm volatile("s_waitcnt lgkmcnt(0)" ::: "memory");
}
__device__ __forceinline__ void transpose_seg(const float* W, int ldw, int K, int sc0, int ncol, bf16* WT, int r0, int rmul, int item, LAS float* scr, int lane, const float* gk = nullptr) {
    const int nb = ncol / 32, kb = item / nb, cb = item % nb;
    transpose_item(W + sc0 + cb * 32, ldw, WT, K, r0 + rmul * cb * 32, rmul, kb * 64, scr, lane, gk);
}

typedef float f32x16 __attribute__((ext_vector_type(16)));
typedef short bf16x8v __attribute__((ext_vector_type(8)));
typedef short s16x4 __attribute__((ext_vector_type(4)));
typedef float f32x2_t __attribute__((ext_vector_type(2)));
typedef __bf16 bf16x2_t __attribute__((ext_vector_type(2)));
constexpr int A_KBUF = 10240, A_VBUF = 12288;
constexpr int A_KOFF = 0, A_VOFF = 2 * A_KBUF, A_BOFF = A_VOFF + 2 * A_VBUF, A_LDS_END = A_BOFF + 2 * 256;
__device__ __forceinline__ constexpr int crow0(int reg) { return (reg & 3) + 8 * (reg >> 2); }
__device__ __forceinline__ float swap_max(float m) { auto rr = __builtin_amdgcn_permlane32_swap(__float_as_uint(m), __float_as_uint(m), false, false); return fmaxf(__uint_as_float(rr[0]), __uint_as_float(rr[1])); }
__device__ __forceinline__ float swap_sum(float m) { auto rr = __builtin_amdgcn_permlane32_swap(__float_as_uint(m), __float_as_uint(m), false, false); return __uint_as_float(rr[0]) + __uint_as_float(rr[1]); }
__device__ __forceinline__ unsigned cvtpk(float lo, float hi) { f32x2_t v = {lo, hi}; bf16x2_t b = __builtin_convertvector(v, bf16x2_t); return __builtin_bit_cast(unsigned, b); }
__device__ __forceinline__ bf16x8v pack8(const f32x16& p, int b0) { u32x4 w; w.x = cvtpk(p[b0 + 0], p[b0 + 1]); w.y = cvtpk(p[b0 + 2], p[b0 + 3]); w.z = cvtpk(p[b0 + 4], p[b0 + 5]); w.w = cvtpk(p[b0 + 6], p[b0 + 7]); return __builtin_bit_cast(bf16x8v, w); }
__device__ __forceinline__ s16x4 tr_read(const LAS unsigned char* p) { typedef short v4i16_t __attribute__((ext_vector_type(4))); return __builtin_bit_cast(s16x4, __builtin_amdgcn_ds_read_tr16_b64_v4i16((LAS v4i16_t*)p)); }

template <int DQK>
__device__ __forceinline__ void attn_preload(const bf16* Kb0, const bf16* Kb1, const bf16* Vb, int j, int tid, u32x4& kreg, u32x4& vreg) {
    const bf16* ksrc;
    if (DQK == 64) ksrc = Kb0 + b64_off(tid >> 3, (tid & 7) * 8); else { const int mp = tid >> 8, tt = tid & 255; ksrc = (mp ? Kb1 : Kb0) + (tt >> 2) * 32 + (tt & 3) * 8; }
    const bf16* vsrc = Vb + b64_off(tid >> 3, (tid & 7) * 8);
    kreg = *(const u32x4*)(ksrc + (size_t)(j * 64) * DQK); vreg = *(const u32x4*)(vsrc + (size_t)(j * 64) * 64);
}
template <int DQK, int NMAP, bool FOX, bool SLC, bool PRE = false>
__device__ __forceinline__ void attn_core(LAS unsigned char* L, const bf16* Kb0, const bf16* Kb1, const bf16* Vb, const LAS float* cum, float cum_ref,
                                          const bf16x8v (&Qf)[NMAP][DQK / 16], u64 tilemask, int t_lane, int tw0, int win, float slope2, unsigned selw0, unsigned selw1,
                                          f32x16 (&O)[NMAP][2], float (&M)[NMAP], float (&Ls)[NMAP], int tid, bool started0 = false, int jpre = 0, u32x4 kpre = (u32x4){0u, 0u, 0u, 0u}, u32x4 vpre = (u32x4){0u, 0u, 0u, 0u}) {
    constexpr int KP = DQK * 2 + 16, VP = 192;
    const int lane = tid & 63, r = lane & 31, h = lane >> 5;
    int kdst; const bf16* ksrc;
    if (DQK == 64) { kdst = (tid >> 3) * KP + (tid & 7) * 16; ksrc = Kb0 + b64_off(tid >> 3, (tid & 7) * 8); }
    else { const int mp = tid >> 8, tt = tid & 255; kdst = mp * 5120 + (tt >> 2) * KP + (tt & 3) * 16; ksrc = (mp ? Kb1 : Kb0) + (tt >> 2) * 32 + (tt & 3) * 8; }
    const int vdst = (tid >> 3) * VP + (tid & 7) * 16; const bf16* vsrc = Vb + b64_off(tid >> 3, (tid & 7) * 8);
    const LAS unsigned char* kfrag = L + A_KOFF + r * KP + h * 16;
    const LAS unsigned char* vfrag = L + A_VOFF + (4 * h + ((lane & 15) >> 2)) * VP + (16 * ((lane >> 4) & 1) + 4 * (lane & 3)) * 2;
    u32x4 kreg, vreg; float breg = 0.f;
    u64 mk = tilemask;
    int j = PRE ? jpre : 63 - __builtin_clzll(mk); mk &= ~(1ull << j);
    { const int kv0 = j * 64; if (PRE) { kreg = kpre; vreg = vpre; } else { kreg = *(const u32x4*)(ksrc + (size_t)kv0 * DQK); vreg = *(const u32x4*)(vsrc + (size_t)kv0 * 64); } if (FOX && tid < 64) breg = (cum_ref - cum[kv0 + tid]) * LOG2E; }
    *(LAS u32x4*)(L + A_KOFF + kdst) = kreg; *(LAS u32x4*)(L + A_VOFF + vdst) = vreg; if (FOX && tid < 64) *(LAS float*)(L + A_BOFF + tid * 4) = breg;
    __syncthreads();
    int buf = 0; bool started = started0;
    float pdummy = 0.f; int idummy = 0; f32x16 dm0; for (int i = 0; i < 16; ++i) dm0[i] = 0.f;
    for (;;) {
        const bool more = mk != 0ull; int jn = 0;
        if (more) { jn = 63 - __builtin_clzll(mk); mk &= ~(1ull << jn); const int kv0 = jn * 64;
            kreg = *(const u32x4*)(ksrc + (size_t)kv0 * DQK); vreg = *(const u32x4*)(vsrc + (size_t)kv0 * 64); if (FOX && tid < 64) breg = (cum_ref - cum[kv0 + tid]) * LOG2E; }
        { const int kv0 = j * 64;
          bool wave_has = true; float selb = 0.f;
          if (SLC) { const bool mine = ((j < 32 ? (selw0 >> j) : (selw1 >> (j - 32))) & 1u) != 0u; selb = mine ? 0.f : -INFINITY; wave_has = __any(mine); }
          if (wave_has && !(kv0 > tw0 + 31) && !(tw0 - (kv0 + 63) >= win)) {
            const bool need_mask = (kv0 + 63 > tw0) || (tw0 + 31 - kv0 >= win);
            const int dl = t_lane - kv0 - 4 * h;
            bf16x8v pa[NMAP][4];
#pragma unroll
            for (int mp = 0; mp < NMAP; ++mp) {
                f32x16 p0, p1;
                if (FOX) { const LAS f32x4* bl = (const LAS f32x4*)(L + A_BOFF + buf * 256) + h; const float mm = M[mp];
#pragma unroll
                    for (int g4 = 0; g4 < 4; ++g4) { const f32x4 b0 = bl[2 * g4], b1 = bl[8 + 2 * g4];
                        p0[4 * g4 + 0] = b0.x - mm; p0[4 * g4 + 1] = b0.y - mm; p0[4 * g4 + 2] = b0.z - mm; p0[4 * g4 + 3] = b0.w - mm; p1[4 * g4 + 0] = b1.x - mm; p1[4 * g4 + 1] = b1.y - mm; p1[4 * g4 + 2] = b1.z - mm; p1[4 * g4 + 3] = b1.w - mm; } }
                else { const float base_l = (slope2 * (float)(kv0 + 4 * h - tw0) - M[mp]) + selb, s8 = slope2 * 8.f, s32 = slope2 * 32.f;
                    p0[0] = base_l; p0[1] = p0[0] + slope2; p0[2] = p0[1] + slope2; p0[3] = p0[2] + slope2;
#pragma unroll
                    for (int reg = 4; reg < 16; ++reg) p0[reg] = p0[reg - 4] + s8;
#pragma unroll
                    for (int reg = 0; reg < 16; ++reg) p1[reg] = p0[reg] + s32; }
                const LAS unsigned char* kb = kfrag + buf * A_KBUF + (DQK == 32 ? mp * 5120 : 0);
#pragma unroll
                for (int s = 0; s < DQK / 16; ++s) { const bf16x8v kf0 = *(const LAS bf16x8v*)(kb + s * 32), kf1 = *(const LAS bf16x8v*)(kb + 32 * KP + s * 32);
#ifdef PROBE_X_LDSK
                    { const bf16x8v z0 = *(const volatile LAS bf16x8v*)(kb + s * 32), z1 = *(const volatile LAS bf16x8v*)(kb + 32 * KP + s * 32); idummy ^= z0[0] ^ z1[1]; }
#endif
#ifdef PROBE_X_MFMA
                    dm0 = __builtin_amdgcn_mfma_f32_32x32x16_bf16(kf0, Qf[mp][s], dm0, 0, 0, 0); dm0 = __builtin_amdgcn_mfma_f32_32x32x16_bf16(kf1, Qf[mp][s], dm0, 0, 0, 0);
#endif
                    p0 = __builtin_amdgcn_mfma_f32_32x32x16_bf16(kf0, Qf[mp][s], p0, 0, 0, 0); p1 = __builtin_amdgcn_mfma_f32_32x32x16_bf16(kf1, Qf[mp][s], p1, 0, 0, 0); }
                if (need_mask) {
#pragma unroll
                    for (int reg = 0; reg < 16; ++reg) { const int d0 = dl - crow0(reg), d1 = d0 - 32;
                        p0[reg] = (d0 >= 0 && d0 < win) ? p0[reg] : -INFINITY; p1[reg] = (d1 >= 0 && d1 < win) ? p1[reg] : -INFINITY; } }
                float mt = fmaxf(fmaxf(p0[0], p1[0]), fmaxf(p0[1], p1[1]));
#pragma unroll
                for (int reg = 2; reg < 16; reg += 2) mt = fmaxf(fmaxf(mt, fmaxf(fmaxf(p0[reg], p1[reg]), p0[reg + 1])), p1[reg + 1]);
                mt = swap_max(mt);
                if (!started || __any(mt > 8.f)) {
                    const float d = (mt > -1e30f) ? (started ? fmaxf(mt, 0.f) : mt) : 0.f, alpha = __builtin_amdgcn_exp2f(-d);
                    O[mp][0] *= alpha; O[mp][1] *= alpha; Ls[mp] *= alpha; M[mp] += d;
#pragma unroll
                    for (int reg = 0; reg < 16; ++reg) { p0[reg] -= d; p1[reg] -= d; } }
                float rs = 0.f;
#ifdef PROBE_X_EXP
#pragma unroll
                for (int reg = 0; reg < 16; ++reg) { pdummy += __builtin_amdgcn_exp2f(p0[reg] - 1.f) + __builtin_amdgcn_exp2f(p1[reg] - 1.f); }
#endif
#pragma unroll
                for (int reg = 0; reg < 16; ++reg) { p0[reg] = __builtin_amdgcn_exp2f(p0[reg]); p1[reg] = __builtin_amdgcn_exp2f(p1[reg]); rs += p0[reg] + p1[reg]; }
                Ls[mp] += rs;
                pa[mp][0] = pack8(p0, 0); pa[mp][1] = pack8(p0, 8); pa[mp][2] = pack8(p1, 0); pa[mp][3] = pack8(p1, 8);
            }
            started = true;
            const LAS unsigned char* vb = vfrag + buf * A_VBUF;
#pragma unroll
            for (int db = 0; db < 2; ++db)
#pragma unroll
                for (int ks = 0; ks < 4; ++ks) { const s16x4 lo = tr_read(vb + ks * (16 * VP) + db * 64), hi = tr_read(vb + ks * (16 * VP) + db * 64 + 8 * VP);
                    const bf16x8v vf = {lo[0], lo[1], lo[2], lo[3], hi[0], hi[1], hi[2], hi[3]};
#pragma unroll
                    for (int mp = 0; mp < NMAP; ++mp) O[mp][db] = __builtin_amdgcn_mfma_f32_32x32x16_bf16(vf, pa[mp][ks], O[mp][db], 0, 0, 0); }
          } }
        if (more) { *(LAS u32x4*)(L + A_KOFF + (buf ^ 1) * A_KBUF + kdst) = kreg; *(LAS u32x4*)(L + A_VOFF + (buf ^ 1) * A_VBUF + vdst) = vreg; if (FOX && tid < 64) *(LAS float*)(L + A_BOFF + (buf ^ 1) * 256 + tid * 4) = breg; }
#ifdef PROBE_X_BAR
        __syncthreads();
#endif
        __syncthreads();
        if (!more) break;
        j = jn; buf ^= 1;
    }
    if (pdummy == 123.456f || idummy == 0x7fffabcd || dm0[3] == 98765.4321f) Ls[0] += 1e-30f;
}
#ifndef AC2_MODE
#define AC2_MODE 0
#endif
#ifndef AC2_INIT_VALU
#define AC2_INIT_VALU 24
#endif
template <bool FOX, bool SLC>
__device__ __forceinline__ void attn_core2(LAS unsigned char* L, const bf16* Kb0, const bf16* Vb, const LAS float* cum, float cum_ref,
                                           const bf16x8v (&Qf)[4], u64 tilemask, int t_lane, int tw0, int win, float slope2, unsigned selw0, unsigned selw1,
                                           f32x16 (&O)[2], float& M, float& Ls, int tid) {
    constexpr int KP = 144, VP = 192;
    const int lane = tid & 63, r = lane & 31, h = lane >> 5;
    const int kdst = (tid >> 3) * KP + (tid & 7) * 16; const bf16* ksrc = Kb0 + b64_off(tid >> 3, (tid & 7) * 8);
    const int vdst = (tid >> 3) * VP + (tid & 7) * 16; const bf16* vsrc = Vb + b64_off(tid >> 3, (tid & 7) * 8);
    const LAS unsigned char* kfrag = L + A_KOFF + r * KP + h * 16;
    const LAS unsigned char* vfrag = L + A_VOFF + (4 * h + ((lane & 15) >> 2)) * VP + (16 * ((lane >> 4) & 1) + 4 * (lane & 3)) * 2;
#define AC2_ACTIVE(jj) (!((jj) * 64 > tw0 + 31) && !(tw0 - ((jj) * 64 + 63) >= win))
#define AC2_INIT(jj, kslot, q0, q1) do { const int kv0_ = (jj) * 64; \
        if (FOX) { const LAS f32x4* bl = (const LAS f32x4*)(L + A_BOFF + (kslot) * 256) + h; const float mm = M; \
            _Pragma("unroll") for (int g4 = 0; g4 < 4; ++g4) { const f32x4 b0 = bl[2 * g4], b1 = bl[8 + 2 * g4]; \
                q0[4 * g4 + 0] = b0.x - mm; q0[4 * g4 + 1] = b0.y - mm; q0[4 * g4 + 2] = b0.z - mm; q0[4 * g4 + 3] = b0.w - mm; q1[4 * g4 + 0] = b1.x - mm; q1[4 * g4 + 1] = b1.y - mm; q1[4 * g4 + 2] = b1.z - mm; q1[4 * g4 + 3] = b1.w - mm; } } \
        else { float selb = 0.f; if (SLC) selb = ((((jj) < 32) ? (selw0 >> (jj)) : (selw1 >> ((jj) - 32))) & 1u) ? 0.f : -INFINITY; \
            const float base_l = (slope2 * (float)(kv0_ + 4 * h - tw0) - M) + selb, s8 = slope2 * 8.f, s32 = slope2 * 32.f; \
            q0[0] = base_l; q0[1] = q0[0] + slope2; q0[2] = q0[1] + slope2; q0[3] = q0[2] + slope2; \
            _Pragma("unroll") for (int reg = 4; reg < 16; ++reg) q0[reg] = q0[reg - 4] + s8; \
            _Pragma("unroll") for (int reg = 0; reg < 16; ++reg) q1[reg] = q0[reg] + s32; } } while (0)
#define AC2_QK(jj, kslot) do { AC2_INIT(jj, kslot, p0, p1); \
        const LAS unsigned char* kb_ = kfrag + (kslot) * A_KBUF; \
        _Pragma("unroll") for (int s_ = 0; s_ < 4; ++s_) { const bf16x8v kf0 = *(const LAS bf16x8v*)(kb_ + s_ * 32), kf1 = *(const LAS bf16x8v*)(kb_ + 32 * KP + s_ * 32); \
            p0 = __builtin_amdgcn_mfma_f32_32x32x16_bf16(kf0, Qf[s_], p0, 0, 0, 0); p1 = __builtin_amdgcn_mfma_f32_32x32x16_bf16(kf1, Qf[s_], p1, 0, 0, 0); } } while (0)
    u32x4 kreg, vreg; float breg = 0.f;
    u64 mk = tilemask;
    int j = 63 - __builtin_clzll(mk); mk &= ~(1ull << j);
    int jn = -1; if (mk) { jn = 63 - __builtin_clzll(mk); mk &= ~(1ull << jn); }
    { kreg = *(const u32x4*)(ksrc + (size_t)j * 64 * 64); vreg = *(const u32x4*)(vsrc + (size_t)j * 64 * 64); if (FOX && tid < 64) breg = (cum_ref - cum[j * 64 + tid]) * LOG2E;
      *(LAS u32x4*)(L + A_KOFF + kdst) = kreg; *(LAS u32x4*)(L + A_VOFF + vdst) = vreg; if (FOX && tid < 64) *(LAS float*)(L + A_BOFF + tid * 4) = breg;
      if (jn >= 0) { kreg = *(const u32x4*)(ksrc + (size_t)jn * 64 * 64); if (FOX && tid < 64) breg = (cum_ref - cum[jn * 64 + tid]) * LOG2E;
          *(LAS u32x4*)(L + A_KOFF + A_KBUF + kdst) = kreg; if (FOX && tid < 64) *(LAS float*)(L + A_BOFF + 256 + tid * 4) = breg; } }
    __syncthreads();
    f32x16 p0, p1;
    bool started = false;
    int ks = 0, vs = 0;
    if (AC2_ACTIVE(j)) AC2_QK(j, 0);
    for (;;) {
        int jnn = -1; if (mk) { jnn = 63 - __builtin_clzll(mk); mk &= ~(1ull << jnn); }
        if (jnn >= 0) { kreg = *(const u32x4*)(ksrc + (size_t)jnn * 64 * 64); if (FOX && tid < 64) breg = (cum_ref - cum[jnn * 64 + tid]) * LOG2E; }
        if (jn >= 0) vreg = *(const u32x4*)(vsrc + (size_t)jn * 64 * 64);
        const bool act = AC2_ACTIVE(j), actn = jn >= 0 && AC2_ACTIVE(jn);
        if (act) {
            const int kv0 = j * 64;
            if ((kv0 + 63 > tw0) || (tw0 + 31 - kv0 >= win)) { const int dl = t_lane - kv0 - 4 * h;
#pragma unroll
                for (int reg = 0; reg < 16; ++reg) { const int d0 = dl - crow0(reg), d1 = d0 - 32;
                    p0[reg] = (d0 >= 0 && d0 < win) ? p0[reg] : -INFINITY; p1[reg] = (d1 >= 0 && d1 < win) ? p1[reg] : -INFINITY; } }
            float mt = fmaxf(fmaxf(p0[0], p1[0]), fmaxf(p0[1], p1[1]));
#pragma unroll
            for (int reg = 2; reg < 16; reg += 2) mt = fmaxf(fmaxf(mt, fmaxf(fmaxf(p0[reg], p1[reg]), p0[reg + 1])), p1[reg + 1]);
            mt = swap_max(mt);
            if (!started || __any(mt > 8.f)) {
                const float d = (mt > -1e30f) ? (started ? fmaxf(mt, 0.f) : mt) : 0.f, alpha = __builtin_amdgcn_exp2f(-d);
                O[0] *= alpha; O[1] *= alpha; Ls *= alpha; M += d;
#pragma unroll
                for (int reg = 0; reg < 16; ++reg) { p0[reg] -= d; p1[reg] -= d; } }
            started = true;
#if AC2_MODE == 1
            {
                const int jq = jn >= 0 ? jn : 0;
                float rs = 0.f;
#pragma unroll
                for (int reg = 0; reg < 16; ++reg) { p0[reg] = __builtin_amdgcn_exp2f(p0[reg]); p1[reg] = __builtin_amdgcn_exp2f(p1[reg]); rs += p0[reg] + p1[reg]; }
                Ls += rs;
                const bf16x8v pa0 = pack8(p0, 0), pa1 = pack8(p0, 8), pa2 = pack8(p1, 0), pa3 = pack8(p1, 8);
                AC2_QK(jq, ks ^ 1);
                const LAS unsigned char* vb = vfrag + vs * A_VBUF;
#pragma unroll
                for (int db = 0; db < 2; ++db)
#pragma unroll
                    for (int kq = 0; kq < 4; ++kq) { const s16x4 lo = tr_read(vb + kq * (16 * VP) + db * 64), hi = tr_read(vb + kq * (16 * VP) + db * 64 + 8 * VP);
                        const bf16x8v vf = {lo[0], lo[1], lo[2], lo[3], hi[0], hi[1], hi[2], hi[3]};
                        O[db] = __builtin_amdgcn_mfma_f32_32x32x16_bf16(vf, kq == 0 ? pa0 : kq == 1 ? pa1 : kq == 2 ? pa2 : pa3, O[db], 0, 0, 0); }
            }
#else
            {
                const int jq = jn >= 0 ? jn : 0;
                f32x16 n0, n1;
                AC2_INIT(jq, ks ^ 1, n0, n1);
                const LAS unsigned char* kb_ = kfrag + (ks ^ 1) * A_KBUF;
                bf16x8v kf[8];
#pragma unroll
                for (int s_ = 0; s_ < 4; ++s_) { kf[2 * s_] = *(const LAS bf16x8v*)(kb_ + s_ * 32); kf[2 * s_ + 1] = *(const LAS bf16x8v*)(kb_ + 32 * KP + s_ * 32); }
                const LAS unsigned char* vb = vfrag + vs * A_VBUF;
                __builtin_amdgcn_sched_barrier(0);
                float ra = 0.f, rb = 0.f; unsigned w[16];
#define AC2_PINF(x) asm volatile("" : "+v"(x))
#define AC2_QGAP(i) do { if ((i) & 1) n1 = __builtin_amdgcn_mfma_f32_32x32x16_bf16(kf[i], Qf[(i) >> 1], n1, 0, 0, 0); else n0 = __builtin_amdgcn_mfma_f32_32x32x16_bf16(kf[i], Qf[(i) >> 1], n0, 0, 0, 0); \
                    float e0 = __builtin_amdgcn_exp2f(p0[2 * (i)]), e1 = __builtin_amdgcn_exp2f(p0[2 * (i) + 1]), e2 = __builtin_amdgcn_exp2f(p1[2 * (i)]), e3 = __builtin_amdgcn_exp2f(p1[2 * (i) + 1]); \
                    ra += e0 + e1; rb += e2 + e3; \
                    AC2_PINF(e0); AC2_PINF(e1); AC2_PINF(e2); AC2_PINF(e3); AC2_PINF(ra); AC2_PINF(rb); \
                    p0[2 * (i)] = e0; p0[2 * (i) + 1] = e1; p1[2 * (i)] = e2; p1[2 * (i) + 1] = e3; \
                    if ((i) >= 4) { w[2 * ((i) - 4)] = cvtpk(p0[4 * ((i) - 4)], p0[4 * ((i) - 4) + 1]); w[2 * ((i) - 4) + 1] = cvtpk(p0[4 * ((i) - 4) + 2], p0[4 * ((i) - 4) + 3]); AC2_PINF(w[2 * ((i) - 4)]); AC2_PINF(w[2 * ((i) - 4) + 1]); } \
                    if ((i) == 6) { vl[0] = tr_read(vb); vh[0] = tr_read(vb + 8 * VP); } \
                    if ((i) == 7) { vl[1] = tr_read(vb + 64); vh[1] = tr_read(vb + 64 + 8 * VP); } \
                    __builtin_amdgcn_sched_barrier(0); } while (0)
                s16x4 vl[2], vh[2];
                AC2_QGAP(0); AC2_QGAP(1); AC2_QGAP(2); AC2_QGAP(3); AC2_QGAP(4); AC2_QGAP(5); AC2_QGAP(6); AC2_QGAP(7);
                Ls += ra + rb;
#define AC2_PA(kq) __builtin_bit_cast(bf16x8v, (u32x4){w[4 * (kq)], w[4 * (kq) + 1], w[4 * (kq) + 2], w[4 * (kq) + 3]})
#define AC2_PGAP(g) do { const int kq_ = (g) >> 1, db_ = (g) & 1; const bf16x8v vf = {vl[(g) & 1][0], vl[(g) & 1][1], vl[(g) & 1][2], vl[(g) & 1][3], vh[(g) & 1][0], vh[(g) & 1][1], vh[(g) & 1][2], vh[(g) & 1][3]}; \
                    if ((g) < 6) { const int kq2 = ((g) + 2) >> 1, db2 = (g) & 1; vl[(g) & 1] = tr_read(vb + kq2 * (16 * VP) + db2 * 64); vh[(g) & 1] = tr_read(vb + kq2 * (16 * VP) + db2 * 64 + 8 * VP); } \
                    O[db_] = __builtin_amdgcn_mfma_f32_32x32x16_bf16(vf, AC2_PA(kq_), O[db_], 0, 0, 0); \
                    if ((g) < 4) { w[8 + 2 * (g)] = cvtpk(p1[4 * (g)], p1[4 * (g) + 1]); w[8 + 2 * (g) + 1] = cvtpk(p1[4 * (g) + 2], p1[4 * (g) + 3]); AC2_PINF(w[8 + 2 * (g)]); AC2_PINF(w[8 + 2 * (g) + 1]); } \
                    __builtin_amdgcn_sched_barrier(0); } while (0)
                AC2_PGAP(0); AC2_PGAP(1); AC2_PGAP(2); AC2_PGAP(3); AC2_PGAP(4); AC2_PGAP(5); AC2_PGAP(6); AC2_PGAP(7);
#undef AC2_PGAP
#undef AC2_PA
#undef AC2_QGAP
#undef AC2_PINF
                p0 = n0; p1 = n1;
            }
#endif
        } else if (actn) AC2_QK(jn, ks ^ 1);
        if (jnn >= 0) { *(LAS u32x4*)(L + A_KOFF + ks * A_KBUF + kdst) = kreg; if (FOX && tid < 64) *(LAS float*)(L + A_BOFF + ks * 256 + tid * 4) = breg; }
        if (jn >= 0) *(LAS u32x4*)(L + A_VOFF + (vs ^ 1) * A_VBUF + vdst) = vreg;
        __syncthreads();
        if (jn < 0) break;
        j = jn; jn = jnn; ks ^= 1; vs ^= 1;
    }
#undef AC2_QK
#undef AC2_INIT
#undef AC2_ACTIVE
}
__device__ __forceinline__ size_t mix_off(size_t n, int c, int W) { return ((n >> 5) * (size_t)(W / 8) + (size_t)(c >> 3)) * 256 + (n & 31) * 8 + (c & 7); }
#define ATTN_FOR_CHUNKS(db, g4) _Pragma("unroll") for (int db = 0; db < 2; ++db) _Pragma("unroll") for (int g4 = 0; g4 < 4; ++g4)

__device__ __forceinline__ void unpack8(const u32x4 w, float (&f)[8]) { f[0] = __uint_as_float(w.x << 16); f[1] = __uint_as_float(w.x & 0xffff0000u); f[2] = __uint_as_float(w.y << 16); f[3] = __uint_as_float(w.y & 0xffff0000u);
    f[4] = __uint_as_float(w.z << 16); f[5] = __uint_as_float(w.z & 0xffff0000u); f[6] = __uint_as_float(w.w << 16); f[7] = __uint_as_float(w.w & 0xffff0000u); }
__device__ __forceinline__ void ph_norm_bf16_from_bf16(const Ctx& c, const bf16* x, const float* g, bf16* out) {
    constexpr int RB = 4; float gg[2][8];
#pragma unroll
    for (int j = 0; j < 2; ++j) { const f32x4 a = ((const f32x4*)g)[2 * c.lane + 128 * j], b2 = ((const f32x4*)g)[2 * c.lane + 128 * j + 1]; gg[j][0] = a.x; gg[j][1] = a.y; gg[j][2] = a.z; gg[j][3] = a.w; gg[j][4] = b2.x; gg[j][5] = b2.y; gg[j][6] = b2.z; gg[j][7] = b2.w; }
    for (int row0 = c.gw * RB; row0 < NT; row0 += c.ngw * RB) {
        u32x4 v[RB][2];
#pragma unroll
        for (int q = 0; q < RB; ++q)
#pragma unroll
            for (int j = 0; j < 2; ++j) v[q][j] = ((const u32x4*)(x + (size_t)(row0 + q) * D_))[c.lane + 64 * j];
#pragma unroll
        for (int q = 0; q < RB; ++q) { float f[2][8]; float ss = 0.f;
#pragma unroll
            for (int j = 0; j < 2; ++j) { unpack8(v[q][j], f[j]);
#pragma unroll
                for (int e = 0; e < 8; ++e) ss = fmaf(f[j][e], f[j][e], ss); }
            const float r = rsqrtf(wave_sum(ss) * (1.f / D_) + EPS);
#pragma unroll
            for (int j = 0; j < 2; ++j) { u32x4 o; o.x = pk2(f[j][0] * r * gg[j][0], f[j][1] * r * gg[j][1]); o.y = pk2(f[j][2] * r * gg[j][2], f[j][3] * r * gg[j][3]); o.z = pk2(f[j][4] * r * gg[j][4], f[j][5] * r * gg[j][5]); o.w = pk2(f[j][6] * r * gg[j][6], f[j][7] * r * gg[j][7]);
                ((u32x4*)(out + (size_t)(row0 + q) * D_))[c.lane + 64 * j] = o; } }
    }
}
__device__ __forceinline__ void ph_norm_final_from_bf16(const Ctx& c, const bf16* x, const float* g, float* out) {
    constexpr int RB = 4; float gg[2][8];
#pragma unroll
    for (int j = 0; j < 2; ++j) { const f32x4 a = ((const f32x4*)g)[2 * c.lane + 128 * j], b2 = ((const f32x4*)g)[2 * c.lane + 128 * j + 1]; gg[j][0] = a.x; gg[j][1] = a.y; gg[j][2] = a.z; gg[j][3] = a.w; gg[j][4] = b2.x; gg[j][5] = b2.y; gg[j][6] = b2.z; gg[j][7] = b2.w; }
    for (int row0 = c.gw * RB; row0 < NT; row0 += c.ngw * RB) {
        u32x4 v[RB][2];
#pragma unroll
        for (int q = 0; q < RB; ++q)
#pragma unroll
            for (int j = 0; j < 2; ++j) v[q][j] = ((const u32x4*)(x + (size_t)(row0 + q) * D_))[c.lane + 64 * j];
#pragma unroll
        for (int q = 0; q < RB; ++q) { float f[2][8]; float ss = 0.f;
#pragma unroll
            for (int j = 0; j < 2; ++j) { unpack8(v[q][j], f[j]);
#pragma unroll
                for (int e = 0; e < 8; ++e) ss = fmaf(f[j][e], f[j][e], ss); }
            const float r = rsqrtf(wave_sum(ss) * (1.f / D_) + EPS);
#pragma unroll
            for (int j = 0; j < 2; ++j) { f32x4* o = (f32x4*)(out + (size_t)(row0 + q) * D_) + 2 * c.lane + 128 * j;
                o[0] = (f32x4){f[j][0] * r * gg[j][0], f[j][1] * r * gg[j][1], f[j][2] * r * gg[j][2], f[j][3] * r * gg[j][3]}; o[1] = (f32x4){f[j][4] * r * gg[j][4], f[j][5] * r * gg[j][5], f[j][6] * r * gg[j][6], f[j][7] * r * gg[j][7]}; } }
    }
}
__device__ __forceinline__ void ph_norm_bf16(const Ctx& c, const float* x, const float* g, bf16* out, bf16* raw) {
    constexpr int RB = 4;
    f32x4 gg[4];
#pragma unroll
    for (int j = 0; j < 4; ++j) gg[j] = ((const f32x4*)g)[c.lane + 64 * j];
    for (int row0 = c.gw * RB; row0 < NT; row0 += c.ngw * RB) {
        f32x4 v[RB][4];
#pragma unroll
        for (int q = 0; q < RB; ++q)
#pragma unroll
            for (int j = 0; j < 4; ++j) v[q][j] = ((const f32x4*)(x + (size_t)(row0 + q) * D_))[c.lane + 64 * j];
#pragma unroll
        for (int q = 0; q < RB; ++q) { float ss = 0.f;
#pragma unroll
            for (int j = 0; j < 4; ++j) ss += v[q][j].x * v[q][j].x + v[q][j].y * v[q][j].y + v[q][j].z * v[q][j].z + v[q][j].w * v[q][j].w;
            const float r = rsqrtf(wave_sum(ss) * (1.f / D_) + EPS);
            u64* o8 = (u64*)(out + (size_t)(row0 + q) * D_) + c.lane; u64* r8 = (u64*)(raw + (size_t)(row0 + q) * D_) + c.lane;
#pragma unroll
            for (int j = 0; j < 4; ++j) { o8[64 * j] = (u64)pk2(v[q][j].x * r * gg[j].x, v[q][j].y * r * gg[j].y) | ((u64)pk2(v[q][j].z * r * gg[j].z, v[q][j].w * r * gg[j].w) << 32);
                r8[64 * j] = (u64)pk2(v[q][j].x, v[q][j].y) | ((u64)pk2(v[q][j].z, v[q][j].w) << 32); } }
    }
}
__device__ __forceinline__ void ph_norm_final(const Ctx& c, float* x, const float* g) {
    constexpr int RB = 4;
    f32x4 gg[4];
#pragma unroll
    for (int j = 0; j < 4; ++j) gg[j] = ((const f32x4*)g)[c.lane + 64 * j];
    for (int row0 = c.gw * RB; row0 < NT; row0 += c.ngw * RB) {
        f32x4 v[RB][4];
#pragma unroll
        for (int q = 0; q < RB; ++q)
#pragma unroll
            for (int j = 0; j < 4; ++j) v[q][j] = ((const f32x4*)(x + (size_t)(row0 + q) * D_))[c.lane + 64 * j];
#pragma unroll
        for (int q = 0; q < RB; ++q) { float ss = 0.f;
#pragma unroll
            for (int j = 0; j < 4; ++j) ss += v[q][j].x * v[q][j].x + v[q][j].y * v[q][j].y + v[q][j].z * v[q][j].z + v[q][j].w * v[q][j].w;
            const float r = rsqrtf(wave_sum(ss) * (1.f / D_) + EPS);
            f32x4* xr = (f32x4*)(x + (size_t)(row0 + q) * D_) + c.lane;
#pragma unroll
            for (int j = 0; j < 4; ++j) xr[64 * j] = v[q][j] * r * gg[j]; }
    }
}

template <class AF, class EF>
__device__ __forceinline__ void naive_gemm(const Ctx& c, int M, int N, int K, AF af, const float* W, int ldb, EF ef) {
    LAS float* As = (LAS float*)c.lds;
    LAS float* Bs = As + 16 * 132;
    const int tm = (M + 127) / 128, tn = (N + 127) / 128, ntile = tm * tn;
    const int ty = c.tid >> 4, tx = c.tid & 15;
    for (int tile = c.bid; tile < ntile; tile += c.G) {
        const int m0 = (tile / tn) * 128, n0 = (tile % tn) * 128;
        float acc[4][8];
#pragma unroll
        for (int i = 0; i < 4; ++i)
#pragma unroll
            for (int j = 0; j < 8; ++j) acc[i][j] = 0.f;
        for (int k0 = 0; k0 < K; k0 += 16) {
            __syncthreads();
#pragma unroll
            for (int i = 0; i < 4; ++i) { const int e = c.tid + i * 512, r = e >> 4, kk = e & 15; const int row = m0 + r;
                As[kk * 132 + r] = (row < M) ? af(row, k0 + kk) : 0.f; }
#pragma unroll
            for (int i = 0; i < 4; ++i) { const int e = c.tid + i * 512, kk = e >> 7, cc = e & 127; const int col = n0 + cc;
                Bs[kk * 132 + cc] = (col < N) ? W[(size_t)(k0 + kk) * ldb + col] : 0.f; }
            __syncthreads();
#pragma unroll 2
            for (int kk = 0; kk < 16; ++kk) {
                float a[4], b[8];
#pragma unroll
                for (int i = 0; i < 4; ++i) a[i] = As[kk * 132 + ty * 4 + i];
#pragma unroll
                for (int j = 0; j < 8; ++j) b[j] = Bs[kk * 132 + tx * 8 + j];
#pragma unroll
                for (int i = 0; i < 4; ++i)
#pragma unroll
                    for (int j = 0; j < 8; ++j) acc[i][j] = fmaf(a[i], b[j], acc[i][j]);
            }
        }
        LAS float* Cs = Bs + 16 * 132;
        __syncthreads();
#pragma unroll
        for (int i = 0; i < 4; ++i)
#pragma unroll
            for (int j = 0; j < 8; ++j) Cs[(ty * 4 + i) * 129 + tx * 8 + j] = acc[i][j];
        __syncthreads();
#pragma unroll 1
        for (int e = c.tid; e < 128 * 128; e += NTHREADS) { const int r = e >> 7, cc = e & 127, row = m0 + r, col = n0 + cc; if (row < M && col < N) ef(row, col, Cs[r * 129 + cc]); }
    }
    __syncthreads();
}

struct InProjOut { bf16* qn; bf16* kv6; bf16* fqkv; bf16* dqk; bf16* dv; float* gate; float* fl; const float* b_gate; const float* b_fgt; };
__device__ __forceinline__ void inproj_store(const InProjOut& o, int n, int col, float v) {
    const int b = n / T_, t = n % T_;
    if (col < C_KV6) { const int h = col >> 6, d = col & 63; o.qn[((size_t)(b * 8 + h) * T_ + t) * 64 + d] = (bf16)f2bf(v * (0.125f * LOG2E)); }
    else if (col < C_GATE) { const int cc = col - C_KV6, idx = cc >> 7, g = (cc >> 6) & 1, d = cc & 63;
        ((bf16*)((unsigned char*)o.kv6 + idx * KV6_STRIDE))[((size_t)(b * 2 + g) * T_ + t) * 64 + d] = (bf16)f2bf(v); }
    else if (col < C_FQ) { const int j = col - C_GATE; o.gate[(size_t)n * 24 + j] = sigmoidf_(v + o.b_gate[j]); }
    else if (col < C_FF) { const int cc = col - C_FQ, idx = cc >> 8, h = (cc >> 6) & 3, d = cc & 63;
        o.fqkv[(size_t)idx * (8 * MiB) + ((size_t)(b * 4 + h) * T_ + t) * 64 + d] = (bf16)f2bf(idx == 0 ? v * (0.125f * LOG2E) : v); }
    else if (col < C_DQ) { const int h = col - C_FF; o.fl[(size_t)(b * 4 + h) * T_ + t] = log_sigmoidf_(v + o.b_fgt[h]); }
    else if (col < C_DV) { const int cc = col - C_DQ, idx = cc >> 8, h = (cc >> 6) & 3, i = (cc >> 5) & 1, d = cc & 31;
        o.dqk[(size_t)idx * (8 * MiB) + ((size_t)((b * 4 + h) * 2 + i) * T_ + t) * 32 + d] = (bf16)f2bf(idx == 0 ? v * (0.17677669529663687f * LOG2E) : v); }
    else { const int cc = col - C_DV, h = cc >> 6, d = cc & 63; o.dv[((size_t)(b * 4 + h) * T_ + t) * 64 + d] = (bf16)f2bf(v); }
}

__device__ __forceinline__ void ph_cumsum(const Ctx& c, float* fl) {
    for (int s = c.gw; s < B_ * 4; s += c.ngw) {
        float* p = fl + (size_t)s * T_; float carry = 0.f;
        for (int t0 = 0; t0 < T_; t0 += 64) {
            float v = p[t0 + c.lane];
#pragma unroll
            for (int o = 1; o < 64; o <<= 1) { const float u = __shfl_up(v, o); if (c.lane >= o) v += u; }
            v += carry; p[t0 + c.lane] = v; carry = __shfl(v, 63);
        }
    }
}

template <int DQK>
__device__ __forceinline__ float naive_attn_row(const bf16* q, const bf16* K, const bf16* V, int t, u64 mask, float slope2, const float* cum, int win, int lane) {
    float qv[DQK];
    { const u32x4* q4 = (const u32x4*)q;
#pragma unroll
      for (int i = 0; i < DQK / 8; ++i) { const u32x4 w = q4[i];
          qv[8 * i + 0] = __uint_as_float(w.x << 16); qv[8 * i + 1] = __uint_as_float(w.x & 0xffff0000u);
          qv[8 * i + 2] = __uint_as_float(w.y << 16); qv[8 * i + 3] = __uint_as_float(w.y & 0xffff0000u);
          qv[8 * i + 4] = __uint_as_float(w.z << 16); qv[8 * i + 5] = __uint_as_float(w.z & 0xffff0000u);
          qv[8 * i + 6] = __uint_as_float(w.w << 16); qv[8 * i + 7] = __uint_as_float(w.w & 0xffff0000u); } }
    const float cumt = cum ? cum[t] : 0.f;
    float m = -INFINITY, l = 0.f, o = 0.f;
    while (mask) {
        const int j = __builtin_ctzll(mask); mask &= mask - 1;
        const int kpos = 64 * j + lane; const int dist = t - kpos;
        const bool valid = dist >= 0 && dist < win;
        float s = 0.f;
        { const u32x4* k4 = (const u32x4*)(K + (size_t)kpos * DQK);
#pragma unroll
          for (int i = 0; i < DQK / 8; ++i) { const u32x4 w = k4[i];
              s = fmaf(qv[8 * i + 0], __uint_as_float(w.x << 16), s); s = fmaf(qv[8 * i + 1], __uint_as_float(w.x & 0xffff0000u), s);
              s = fmaf(qv[8 * i + 2], __uint_as_float(w.y << 16), s); s = fmaf(qv[8 * i + 3], __uint_as_float(w.y & 0xffff0000u), s);
              s = fmaf(qv[8 * i + 4], __uint_as_float(w.z << 16), s); s = fmaf(qv[8 * i + 5], __uint_as_float(w.z & 0xffff0000u), s);
              s = fmaf(qv[8 * i + 6], __uint_as_float(w.w << 16), s); s = fmaf(qv[8 * i + 7], __uint_as_float(w.w & 0xffff0000u), s); } }
        s -= slope2 * (float)dist;
        if (cum) s += (cumt - cum[kpos]) * LOG2E;
        s = valid ? s : -INFINITY;
        const float mb = wave_max(s);
        if (mb == -INFINITY) continue;
        const float mn = fmaxf(m, mb), alpha = exp2f(m - mn);
        const float p = valid ? exp2f(s - mn) : 0.f;
        l = l * alpha + wave_sum(p); o *= alpha; m = mn;
        const bf16* vb = V + (size_t)(64 * j) * 64 + lane;
#pragma unroll 8
        for (int k = 0; k < 64; ++k) o = fmaf(__shfl(p, k), bf2f(vb[(size_t)k * 64]), o);
    }
    return l > 0.f ? o / l : 0.f;
}

__device__ __forceinline__ void ph_cmp_attn(const Ctx& c, const bf16* qn, const bf16* kcmp, const bf16* vcmp, const float* gate, u64* sel, bf16* ocmp) {
    LAS float* pl = (LAS float*)(c.lds) + c.wave * 256;
    const int lane = c.lane;
    for (int it = c.gw; it < B_ * 2 * T_; it += c.ngw) {
        const int t = it % T_, bg = it / T_, b = bg >> 1, g = bg & 1;
        const int nvis = (t >= 31) ? ((t - 31) >> 4) + 1 : 0;
        const bf16* kc = kcmp + (size_t)bg * 256 * 64; const bf16* vc = vcmp + (size_t)bg * 256 * 64;
        float imp = 0.f;
        for (int hg = 0; hg < 4; ++hg) {
            const int h = g * 4 + hg; const float slope2 = alibi_slope(h + 1, 8) * LOG2E;
            const bf16* q = qn + ((size_t)(b * 8 + h) * T_ + t) * 64;
            float qv[64];
            { const u32x4* q4 = (const u32x4*)q;
#pragma unroll
              for (int i = 0; i < 8; ++i) { const u32x4 w = q4[i];
                  qv[8 * i + 0] = __uint_as_float(w.x << 16); qv[8 * i + 1] = __uint_as_float(w.x & 0xffff0000u);
                  qv[8 * i + 2] = __uint_as_float(w.y << 16); qv[8 * i + 3] = __uint_as_float(w.y & 0xffff0000u);
                  qv[8 * i + 4] = __uint_as_float(w.z << 16); qv[8 * i + 5] = __uint_as_float(w.z & 0xffff0000u);
                  qv[8 * i + 6] = __uint_as_float(w.w << 16); qv[8 * i + 7] = __uint_as_float(w.w & 0xffff0000u); } }
            float s[4]; float m = -INFINITY;
#pragma unroll
            for (int i = 0; i < 4; ++i) { const int cc = lane + 64 * i; float a = 0.f;
                if (cc < nvis) { const u32x4* k4 = (const u32x4*)(kc + (size_t)cc * 64);
#pragma unroll
                    for (int e = 0; e < 8; ++e) { const u32x4 w = k4[e];
                        a = fmaf(qv[8 * e + 0], __uint_as_float(w.x << 16), a); a = fmaf(qv[8 * e + 1], __uint_as_float(w.x & 0xffff0000u), a);
                        a = fmaf(qv[8 * e + 2], __uint_as_float(w.y << 16), a); a = fmaf(qv[8 * e + 3], __uint_as_float(w.y & 0xffff0000u), a);
                        a = fmaf(qv[8 * e + 4], __uint_as_float(w.z << 16), a); a = fmaf(qv[8 * e + 5], __uint_as_float(w.z & 0xffff0000u), a);
                        a = fmaf(qv[8 * e + 6], __uint_as_float(w.w << 16), a); a = fmaf(qv[8 * e + 7], __uint_as_float(w.w & 0xffff0000u), a); }
                    a -= slope2 * (float)(t - (16 * cc + 31)); } else a = -INFINITY;
                s[i] = a; m = fmaxf(m, a); }
            m = wave_max(m);
            float p[4], lsum = 0.f;
#pragma unroll
            for (int i = 0; i < 4; ++i) { p[i] = (lane + 64 * i < nvis) ? exp2f(s[i] - m) : 0.f; lsum += p[i]; }
            lsum = wave_sum(lsum);
            const float inv = lsum > 0.f ? 1.f / lsum : 0.f;
#pragma unroll
            for (int i = 0; i < 4; ++i) { p[i] *= inv; pl[lane + 64 * i] = p[i]; }
            asm volatile("s_waitcnt lgkmcnt(0)" ::: "memory");
            float o = 0.f;
            for (int cc = 0; cc < nvis; ++cc) o = fmaf(pl[cc], bf2f(vc[(size_t)cc * 64 + lane]), o);
            const float gt = gate[((size_t)(b * T_ + t)) * 24 + h * 3 + 0];
            ocmp[(size_t)(b * T_ + t) * 512 + h * 64 + lane] = (bf16)f2bf(gt * o);
            { const int j = lane; float a = pl[4 * j] + pl[4 * j + 1] + pl[4 * j + 2] + 0.5f * pl[4 * j + 3]; if (j > 0) a += 0.5f * pl[4 * j - 1]; imp += a; }
            asm volatile("s_waitcnt lgkmcnt(0)" ::: "memory");
        }
        const int cur = t >> 6; const int j = lane;
        u64 m64;
        if (cur <= 15) m64 = (cur == 63) ? ~0ull : ((1ull << (cur + 1)) - 1ull);
        else {
            float val = (j > cur) ? -INFINITY : ((j == 0 || j == cur || j == cur - 1) ? 1e4f : imp);
            m64 = 0ull;
            for (int r = 0; r < 16; ++r) {
                const float mx = wave_max(val);
                const u64 bal = __ballot(val == mx);
                const int w = __builtin_ctzll(bal);
                m64 |= 1ull << w; if (j == w) val = -INFINITY;
            }
        }
        if (lane == 0) sel[(size_t)bg * T_ + t] = m64;
    }
}

__device__ __forceinline__ void ph_win_attn(const Ctx& c, const bf16* qn, const bf16* kw, const bf16* vw, const float* gate, bf16* owin) {
    for (int it = c.gw; it < B_ * 8 * T_; it += c.ngw) {
        const int t = it % T_, bh = it / T_, b = bh >> 3, h = bh & 7, g = h >> 2;
        const int cur = t >> 6, jlo = (t - 511) > 0 ? (t - 511) >> 6 : 0;
        const u64 hi = (cur == 63) ? ~0ull : ((1ull << (cur + 1)) - 1ull); const u64 mask = hi & ~((1ull << jlo) - 1ull);
        const float o = naive_attn_row<64>(qn + ((size_t)bh * T_ + t) * 64, kw + (size_t)(b * 2 + g) * T_ * 64, vw + (size_t)(b * 2 + g) * T_ * 64, t, mask,
                                           alibi_slope(h + 1, 8) * LOG2E, nullptr, 512, c.lane);
        owin[(size_t)(b * T_ + t) * 512 + h * 64 + c.lane] = (bf16)f2bf(gate[(size_t)(b * T_ + t) * 24 + h * 3 + 2] * o);
    }
}
__device__ __forceinline__ void ph_slc_attn(const Ctx& c, const bf16* qn, const bf16* ks, const bf16* vs, const float* gate, const u64* sel, const bf16* ocmp, const bf16* owin, bf16* att) {
    for (int it = c.gw; it < B_ * 8 * T_; it += c.ngw) {
        const int t = it % T_, bh = it / T_, b = bh >> 3, h = bh & 7, g = h >> 2;
        const u64 mask = sel[(size_t)(b * 2 + g) * T_ + t];
        const float o = naive_attn_row<64>(qn + ((size_t)bh * T_ + t) * 64, ks + (size_t)(b * 2 + g) * T_ * 64, vs + (size_t)(b * 2 + g) * T_ * 64, t, mask,
                                           alibi_slope(h + 1, 8) * LOG2E, nullptr, 1 << 30, c.lane);
        const size_t n = (size_t)(b * T_ + t);
        const float r = gate[n * 24 + h * 3 + 1] * o + bf2f(ocmp[n * 512 + h * 64 + c.lane]) + bf2f(owin[n * 512 + h * 64 + c.lane]);
        att[n * 1024 + h * 64 + c.lane] = (bf16)f2bf(r);
    }
}
__device__ __forceinline__ void ph_fox_attn(const Ctx& c, const bf16* fq, const bf16* fk, const bf16* fv, const float* cum, bf16* att) {
    for (int it = c.gw; it < B_ * 4 * T_; it += c.ngw) {
        const int t = it % T_, bh = it / T_, b = bh >> 2, h = bh & 3;
        const int cur = t >> 6; const u64 mask = (cur == 63) ? ~0ull : ((1ull << (cur + 1)) - 1ull);
        const float o = naive_attn_row<64>(fq + ((size_t)bh * T_ + t) * 64, fk + (size_t)bh * T_ * 64, fv + (size_t)bh * T_ * 64, t, mask, 0.f, cum + (size_t)bh * T_, 1 << 30, c.lane);
        att[(size_t)(b * T_ + t) * 1024 + 512 + h * 64 + c.lane] = (bf16)f2bf(o);
    }
}
__device__ __forceinline__ void ph_diff_attn(const Ctx& c, const bf16* dq, const bf16* dk, const bf16* dv, const float* lam, const float* subln, float lambda_init, bf16* att) {
    float l1 = 0.f, l2 = 0.f;
    if (c.lane < 32) { l1 = lam[c.lane] * lam[32 + c.lane]; l2 = lam[64 + c.lane] * lam[96 + c.lane]; }
    const float lam_full = __expf(wave_sum(l1)) - __expf(wave_sum(l2)) + lambda_init;
    const float sg = subln[c.lane] * (1.f - lambda_init);
    for (int it = c.gw; it < B_ * 4 * T_; it += c.ngw) {
        const int t = it % T_, bh = it / T_, b = bh >> 2, h = bh & 3;
        const int cur = t >> 6; const u64 mask = (cur == 63) ? ~0ull : ((1ull << (cur + 1)) - 1ull);
        const float slope2 = alibi_slope(h + 1, 4) * LOG2E;
        const bf16* vb = dv + (size_t)bh * T_ * 64;
        const float o1 = naive_attn_row<32>(dq + ((size_t)(bh * 2 + 0) * T_ + t) * 32, dk + (size_t)(bh * 2 + 0) * T_ * 32, vb, t, mask, slope2, nullptr, 1 << 30, c.lane);
        const float o2 = naive_attn_row<32>(dq + ((size_t)(bh * 2 + 1) * T_ + t) * 32, dk + (size_t)(bh * 2 + 1) * T_ * 32, vb, t, mask, slope2, nullptr, 1 << 30, c.lane);
        const float o = o1 - lam_full * o2;
        const float r = rsqrtf(wave_sum(o * o) * (1.f / 64.f) + EPS);
        att[(size_t)(b * T_ + t) * 1024 + 768 + h * 64 + c.lane] = (bf16)f2bf(o * r * sg);
    }
}

__device__ __forceinline__ void ph_moe_route(const Ctx& c, const float* x, const float* g, const float* wgrp, const float* bgrp, const float* wexp, const float* bexp, bf16* hn, int* route_e, float* route_w, unsigned* cnt) {
    for (int row = c.gw; row < NT; row += c.ngw) {
        const f32x4* xr = (const f32x4*)(x + (size_t)row * D_) + c.lane;
        f32x4 v[4]; float ss = 0.f;
#pragma unroll
        for (int j = 0; j < 4; ++j) { v[j] = xr[64 * j]; ss += v[j].x * v[j].x + v[j].y * v[j].y + v[j].z * v[j].z + v[j].w * v[j].w; }
        const float r = rsqrtf(wave_sum(ss) * (1.f / D_) + EPS);
        u64* o8 = (u64*)(hn + (size_t)row * D_) + c.lane;
#pragma unroll
        for (int j = 0; j < 4; ++j) { const f32x4 gg = ((const f32x4*)g)[c.lane + 64 * j]; v[j] = v[j] * r * gg;
            o8[64 * j] = (u64)pk2(v[j].x, v[j].y) | ((u64)pk2(v[j].z, v[j].w) << 32); }
        float gl[4];
#pragma unroll
        for (int q = 0; q < 4; ++q) { float a = 0.f;
#pragma unroll
            for (int j = 0; j < 4; ++j) { const int k = 4 * (c.lane + 64 * j);
                a = fmaf(v[j].x, wgrp[(size_t)(k + 0) * 4 + q], a); a = fmaf(v[j].y, wgrp[(size_t)(k + 1) * 4 + q], a);
                a = fmaf(v[j].z, wgrp[(size_t)(k + 2) * 4 + q], a); a = fmaf(v[j].w, wgrp[(size_t)(k + 3) * 4 + q], a); }
            gl[q] = wave_sum(a) + bgrp[q]; }
        int grp = 0; float gm = gl[0];
#pragma unroll
        for (int q = 1; q < 4; ++q) if (gl[q] > gm) { gm = gl[q]; grp = q; }
        float gs = 0.f;
#pragma unroll
        for (int q = 0; q < 4; ++q) gs += __expf(gl[q] - gm);
        const float grp_gate = 1.f / gs;
        float el[8];
#pragma unroll
        for (int q = 0; q < 8; ++q) { float a = 0.f; const int col = grp * 8 + q;
#pragma unroll
            for (int j = 0; j < 4; ++j) { const int k = 4 * (c.lane + 64 * j);
                a = fmaf(v[j].x, wexp[(size_t)(k + 0) * 32 + col], a); a = fmaf(v[j].y, wexp[(size_t)(k + 1) * 32 + col], a);
                a = fmaf(v[j].z, wexp[(size_t)(k + 2) * 32 + col], a); a = fmaf(v[j].w, wexp[(size_t)(k + 3) * 32 + col], a); }
            el[q] = wave_sum(a) + bexp[col]; }
        int i0 = 0; float v0 = el[0];
#pragma unroll
        for (int q = 1; q < 8; ++q) if (el[q] > v0) { v0 = el[q]; i0 = q; }
        int i1 = -1; float v1 = -INFINITY;
#pragma unroll
        for (int q = 0; q < 8; ++q) if (q != i0 && el[q] > v1) { v1 = el[q]; i1 = q; }
        const float e1 = __expf(v1 - v0), den = 1.f + e1;
        if (c.lane == 0) { const float w0 = grp_gate / den, w1 = grp_gate * e1 / den;
            const int lo = i0 < i1 ? i0 : i1, hi = i0 < i1 ? i1 : i0, cls = grp * 28 + lo * 8 - (lo * (lo + 1)) / 2 + (hi - lo - 1);
            const unsigned rank = __hip_atomic_fetch_add(cnt + cls, 1u, __ATOMIC_RELAXED, __HIP_MEMORY_SCOPE_AGENT);
            route_e[row] = (int)(((unsigned)cls << 24) | rank); route_w[2 * row] = i0 < i1 ? w0 : w1; route_w[2 * row + 1] = i0 < i1 ? w1 : w0; }
    }
}
__device__ __forceinline__ void ph_moe_naive(const Ctx& c, const bf16* hn, const int* route_e, const float* route_w, const float* wg, const float* wu, const float* wd, float* x) {
    LAS float* hs = (LAS float*)c.lds;
    LAS float* au = hs + 1024;
    LAS float* h2 = au + 512;
    for (int row = c.bid; row < NT; row += c.G) {
        __syncthreads();
        hs[c.tid] = bf2f(hn[(size_t)row * D_ + c.tid]); hs[c.tid + 512] = bf2f(hn[(size_t)row * D_ + c.tid + 512]);
        float o0 = 0.f, o1 = 0.f;
        for (int s = 0; s < 2; ++s) {
            const int e = route_e[2 * row + s]; const float w = route_w[2 * row + s];
            __syncthreads();
            const float* W = (c.tid < 256 ? wg : wu) + (size_t)e * D_ * DEXP + (c.tid & 255);
            float a = 0.f;
            for (int k = 0; k < D_; ++k) a = fmaf(hs[k], W[(size_t)k * DEXP], a);
            au[c.tid] = a;
            __syncthreads();
            if (c.tid < 256) { const float ga = au[c.tid], up = au[c.tid + 256]; h2[c.tid] = ga / (1.f + __expf(-ga)) * up * w; }
            __syncthreads();
            const float* Wd = wd + (size_t)e * DEXP * D_;
            for (int k = 0; k < DEXP; ++k) { const float hv = h2[k]; o0 = fmaf(hv, Wd[(size_t)k * D_ + c.tid], o0); o1 = fmaf(hv, Wd[(size_t)k * D_ + c.tid + 512], o1); }
        }
        x[(size_t)row * D_ + c.tid] += o0; x[(size_t)row * D_ + c.tid + 512] += o1;
    }
    __syncthreads();
}

typedef __attribute__((address_space(4))) const Params* KP;
__device__ __forceinline__ KP uni_kp(KP p) { const unsigned long long v = (unsigned long long)p; const unsigned lo = __builtin_amdgcn_readfirstlane((unsigned)v), hi = __builtin_amdgcn_readfirstlane((unsigned)(v >> 32)); return (KP)(((unsigned long long)hi << 32) | lo); }
constexpr int PH_PER_LAYER = 11, N_PHASES = L_ * PH_PER_LAYER + 2;
__device__ __forceinline__ Ctx make_ctx(KP p) {
    Ctx c; c.lds = (LAS unsigned char*)lds_raw; { int t_ = threadIdx.x; asm volatile("" : "+v"(t_)); c.tid = t_; } c.lane = c.tid & 63; c.wave = __builtin_amdgcn_readfirstlane(c.tid >> 6);
    c.bid = blockIdx.x; c.G = gridDim.x; c.gw = c.bid * NWAVES + c.wave; c.ngw = c.G * NWAVES; c.in = nullptr; c.xcur = p->out; c.ws = p->ws;
    return c;
}
struct Bufs {
    bf16 *QN, *KV6, *KC, *VC, *KS, *VS, *KW, *VW, *FQ, *FK, *FV, *DQ, *DK, *DV, *HC, *KCMP, *VCMP, *OCMP, *OWIN, *HN, *ATT;
    float *GATE, *FL, *ROUTE_W; u64* SEL; int* ROUTE_E;
};
__device__ __forceinline__ Bufs make_bufs(unsigned char* ws) {
    Bufs b;
    b.QN = (bf16*)(ws + WS_QN); b.KV6 = (bf16*)(ws + WS_KV6);
    b.KC = (bf16*)(ws + WS_KV6 + 0 * KV6_STRIDE); b.VC = (bf16*)(ws + WS_KV6 + 1 * KV6_STRIDE);
    b.KS = (bf16*)(ws + WS_KV6 + 2 * KV6_STRIDE); b.VS = (bf16*)(ws + WS_KV6 + 3 * KV6_STRIDE);
    b.KW = (bf16*)(ws + WS_KV6 + 4 * KV6_STRIDE); b.VW = (bf16*)(ws + WS_KV6 + 5 * KV6_STRIDE);
    b.FQ = (bf16*)(ws + WS_FQKV); b.FK = b.FQ + 8 * MiB; b.FV = b.FQ + 16 * MiB;
    b.DQ = (bf16*)(ws + WS_DQK); b.DK = b.DQ + 8 * MiB; b.DV = (bf16*)(ws + WS_DV);
    b.GATE = (float*)(ws + WS_GATE); b.FL = (float*)(ws + WS_FL);
    b.HC = (bf16*)(ws + WS_HC); b.KCMP = (bf16*)(ws + WS_KVCMP); b.VCMP = b.KCMP + 16 * 256 * 64;
    b.SEL = (u64*)(ws + WS_SEL); b.OCMP = (bf16*)(ws + WS_OCMP); b.OWIN = (bf16*)(ws + WS_OWIN);
    b.HN = (bf16*)(ws + WS_HN); b.ATT = (bf16*)(ws + WS_ATT);
    b.ROUTE_E = (int*)(ws + WS_ROUTE); b.ROUTE_W = (float*)(ws + WS_ROUTE + 512 * 1024);
    return b;
}
__device__ __forceinline__ float lambda_init_of(int l) { return l == 0 ? 0.2f : 0.35550906759096926f; }

__device__ __noinline__ void P_prologue(KP p_) { const KP p = uni_kp(p_);
    const Ctx c = make_ctx(p); unsigned char* ws = p->ws;
    LAS float* scr = (LAS float*)(c.lds) + c.wave * (64 * 33);
    constexpr int I_A = 16 * 40, I_B = 16 * 24, I_C = 16 * 24, I_O = 16 * 32, I_G = 16 * 8, I_D = 4 * 32, I_E = 2 * I_G + I_D, I_W1 = 32 * 8, I_W2 = 4 * 2;
    constexpr int PER_L = I_A + I_B + I_C + I_O + 2 * (I_W1 + I_W2);
    for (int it = c.gw; it < L_ * PER_L; it += c.ngw) {
        const int l = it / PER_L; int r = it % PER_L;
        const float* W; bf16* WT; int ldw, K, sc0, ncol, r0 = 0, rmul = 1;
        if (r < I_A + I_B + I_C) { W = p->in[2] + (size_t)l * D_ * D_IN; WT = (bf16*)(ws + WS_WIN_T) + (size_t)l * NIN * D_; ldw = D_IN; K = D_;
            if (r < I_A) { sc0 = 0; ncol = 1280; r0 = 0; } else if (r < I_A + I_B) { r -= I_A; sc0 = C_FQ; ncol = 768; r0 = 1280; } else { r -= I_A + I_B; sc0 = C_DQ; ncol = 768; r0 = 2048; } }
        else if ((r -= I_A + I_B + I_C) < I_O) { W = p->in[13] + (size_t)l * D_ * D_; WT = (bf16*)(ws + WS_WOUT_T) + (size_t)l * D_ * D_; ldw = D_; K = D_; sc0 = 0; ncol = 1024; }
        else { r -= I_O; const int kv = r / (I_W1 + I_W2); r = r % (I_W1 + I_W2); const size_t lk = (size_t)l * 2 + kv;
            if (r < I_W1) { W = p->in[kv == 0 ? 6 : 9] + (size_t)l * 2048 * 256; WT = (bf16*)(ws + WS_W1_T) + lk * 256 * 2048; ldw = 256; K = 2048; sc0 = 0; ncol = 256; }
            else { r -= I_W1; W = p->in[kv == 0 ? 7 : 10] + (size_t)l * 256 * 64; WT = (bf16*)(ws + WS_W2_T) + lk * 64 * 256; ldw = 64; K = 256; sc0 = 0; ncol = 64; } }
        transpose_seg(W, ldw, K, sc0, ncol, WT, r0, rmul, r, scr, c.lane);
    }
    for (int i = c.bid * NTHREADS + c.tid; i < L_ * 256 * D_; i += c.G * NTHREADS) {
        const int l = i / (256 * D_), rr = (i / D_) % 256, k = i % D_;
        const float* win = p->in[2] + (size_t)l * D_ * D_IN;
        float v = 0.f; if (rr < 24) v = win[(size_t)k * D_IN + C_GATE + rr]; else if (rr < 28) v = win[(size_t)k * D_IN + C_FF + (rr - 24)];
        ((bf16*)(ws + WS_WIN_T))[((size_t)l * NIN + 2816 + rr) * D_ + k] = (bf16)f2bf(v);
    }
    for (int w = c.gw; w < L_ * 2 * 4 * 128; w += c.ngw) {
        const int lk = w >> 9, cg = (w >> 7) & 3, kc = w & 127, l = lk >> 1, kv = lk & 1, j = cg * 64 + c.lane;
        const float* pe = p->in[kv == 0 ? 5 : 8] + (size_t)l * 2048 + kc * 16; const float* w1 = p->in[kv == 0 ? 6 : 9] + (size_t)l * 2048 * 256 + (size_t)kc * 16 * 256;
        float a = 0.f;
#pragma unroll
        for (int k = 0; k < 16; ++k) a = fmaf(pe[k], w1[(size_t)k * 256 + j], a);
        ((float*)(ws + WS_B1PART))[((size_t)lk * 128 + kc) * 256 + j] = a;
    }
    for (int i = c.bid * NTHREADS + c.tid; i < L_ * 64 * 2 * 64; i += c.G * NTHREADS) {
        const int l = i / (64 * 2 * 64), ks = (i / 128) % 64, cb = (i / 64) & 1, lane = i & 63, col = 32 * cb + (lane & 31);
        unsigned hi[4], lo[4];
#pragma unroll
        for (int jp = 0; jp < 4; ++jp) { float v[2];
#pragma unroll
            for (int e = 0; e < 2; ++e) { const int k = 16 * ks + 8 * (lane >> 5) + 2 * jp + e; const float g = p->in[14][(size_t)l * D_ + k];
                v[e] = col < 4 ? g * p->in[15][((size_t)l * D_ + k) * 4 + col] : (col < 36 ? g * p->in[17][((size_t)l * D_ + k) * 32 + (col - 4)] : 0.f); }
            const unsigned h0 = f2bf(v[0]), h1 = f2bf(v[1]); hi[jp] = h0 | (h1 << 16);
            lo[jp] = f2bf(v[0] - __uint_as_float(h0 << 16)) | (f2bf(v[1] - __uint_as_float(h1 << 16)) << 16); }
        u32x4* dst = (u32x4*)(ws + WS_WR) + ((size_t)((l * 64 + ks) * 2 + cb) * 2) * 64 + lane;
        dst[0] = (u32x4){hi[0], hi[1], hi[2], hi[3]}; dst[64] = (u32x4){lo[0], lo[1], lo[2], lo[3]};
    }
}
__device__ __forceinline__ void P_inproj_mfma(int l_) { const KP p = (KP)__builtin_amdgcn_kernarg_segment_ptr(); int l = l_; asm volatile("" : "+s"(l));
    unsigned char* ws = p->ws; asm volatile("" : "+s"(ws));
    PlainOrder S; S.init(p->out, (const bf16*)(ws + WS_WIN_T) + (size_t)l * NIN * D_, D_, D_, NT, NIN, (int)gridDim.x, launder_s((int)blockIdx.x));
#ifdef STAGGER_TICKS
    { const unsigned long long t0 = __builtin_amdgcn_s_memrealtime(); const unsigned long long d = (unsigned long long)((launder_s((int)blockIdx.x) >> 3) & 3) * STAGGER_TICKS;
      while (__builtin_amdgcn_s_memrealtime() - t0 < d) __builtin_amdgcn_s_sleep(4); }
#endif
    const pg8::Gemm g{D_, D_, D_, D_ / 64, 0, 0};
    const EpiInProj E{ws, p->in[3] + l * 24, p->in[4] + l * 4, (unsigned*)(ws + WS_CTL) + CW_KN + l * 8192};
    pg8::gemm_phase<EpiInProj, PlainOrder, INPROJ_ALIGN, INPROJ_SP2>((LAS unsigned char*)lds_raw, g, S, E);
}
__device__ __forceinline__ void P_inproj_dummy(int l_) { const KP p = (KP)__builtin_amdgcn_kernarg_segment_ptr(); int l = l_; asm volatile("" : "+s"(l));
    unsigned char* ws = p->ws; asm volatile("" : "+s"(ws));
    PlainOrder S; S.init(p->out, (const bf16*)(ws + WS_WIN_T) + (size_t)l * NIN * D_, D_, D_, NT, NIN, (int)gridDim.x, launder_s((int)blockIdx.x));
    const pg8::Gemm g{D_, D_, D_, D_ / 64, 0, 0};
    const EpiDummy E{(float*)(ws + WS_HB)};
    pg8::gemm_phase<EpiDummy, PlainOrder, true, true>((LAS unsigned char*)lds_raw, g, S, E);
}
__device__ __forceinline__ void P_outproj_mfma(int l_) { const KP p = (KP)__builtin_amdgcn_kernarg_segment_ptr(); int l = l_; asm volatile("" : "+s"(l));
    unsigned char* ws = p->ws; asm volatile("" : "+s"(ws));
    PlainOrder S; S.init(ws + WS_ATT, (const bf16*)(ws + WS_WOUT_T) + (size_t)l * D_ * D_, D_, D_, NT, D_, (int)gridDim.x, launder_s((int)blockIdx.x));
    const pg8::Gemm g{D_, D_, D_, D_ / 64, 32, 8};
    const EpiResBf16 E{(bf16*)(ws + WS_HN)};
    pg8::gemm_phase<EpiResBf16, PlainOrder, true, true>((LAS unsigned char*)lds_raw, g, S, E);
}
__device__ __forceinline__ float wave_max_l(float v, int lane) {
#pragma unroll
    for (int o = 1; o < 64; o <<= 1) v = fmaxf(v, shflx_f(v, o, lane));
    return v;
}
__device__ __forceinline__ float wave_min_l(float v, int lane) {
#pragma unroll
    for (int o = 1; o < 64; o <<= 1) v = fminf(v, shflx_f(v, o, lane));
    return v;
}
template <int NS> __device__ __forceinline__ float q_norm2_max(const bf16x8v (&Q)[NS], int lane) {
    float ss = 0.f;
#pragma unroll
    for (int s = 0; s < NS; ++s)
#pragma unroll
        for (int e = 0; e < 8; ++e) { const float v = __uint_as_float(((unsigned)(unsigned short)Q[s][e]) << 16); ss = fmaf(v, v, ss); }
    return wave_max_l(swap_sum(ss), lane);
}
__device__ __forceinline__ u64 prune_consensus(bool skip, LAS u64* slots, int wave, int lane) {
    const u64 mine = __ballot(skip);
    __syncthreads();
    if (lane == 0) slots[wave] = mine;
    __syncthreads();
    u64 all = slots[0];
#pragma unroll
    for (int w = 1; w < NWAVES; ++w) all &= slots[w];
    return all;
}
__device__ __forceinline__ void U_fox(KP p_, int bh_, int qb_, int l_) {
    const KP p = uni_kp(p_); const int bh = __builtin_amdgcn_readfirstlane(bh_), qb = __builtin_amdgcn_readfirstlane(qb_), l = __builtin_amdgcn_readfirstlane(l_);
    int tid_ = threadIdx.x; asm volatile("" : "+v"(tid_));
    const int tid = tid_, lane = tid & 63, wave = __builtin_amdgcn_readfirstlane(tid >> 6), r = lane & 31, h = lane >> 5;
    unsigned char* ws = p->ws; asm volatile("" : "+s"(ws)); LAS unsigned char* L = (LAS unsigned char*)lds_raw;
    const int tw0 = 256 * qb + 32 * wave, t_lane = tw0 + r, b = bh >> 2, hd = bh & 3;
    const bf16* q = (const bf16*)(ws + WS_FQKV) + (size_t)bh * T_ * 64 + (t_lane >> 4) * 1024 + (t_lane & 15) * 32 + 8 * h;
    bf16x8v Qf[1][4];
#pragma unroll
    for (int s = 0; s < 4; ++s) Qf[0][s] = *(const bf16x8v*)(q + (s >> 1) * 512 + (s & 1) * 16);
    const bf16* Kp = (const bf16*)(ws + WS_FQKV) + 8 * MiB + (size_t)bh * T_ * 64; const bf16* Vp = (const bf16*)(ws + WS_FQKV) + 16 * MiB + (size_t)bh * T_ * 64;
    u32x4 kpre, vpre; attn_preload<64>(Kp, nullptr, Vp, 4 * qb + 3, tid, kpre, vpre);
    LAS float* cum = (LAS float*)(L + A_LDS_END);
    { const float* fl = (const float*)(ws + WS_FL) + (size_t)bh * T_; LAS float* tot = cum + 4096;
      const int nval = 256 * (qb + 1); float v[8];
      if (8 * tid < nval) { const f32x4 a = *(const f32x4*)(fl + 8 * tid), c2 = *(const f32x4*)(fl + 8 * tid + 4); v[0] = a.x; v[1] = a.y; v[2] = a.z; v[3] = a.w; v[4] = c2.x; v[5] = c2.y; v[6] = c2.z; v[7] = c2.w; }
      else {
#pragma unroll
          for (int i = 0; i < 8; ++i) v[i] = 0.f; }
#pragma unroll
      for (int i = 1; i < 8; ++i) v[i] += v[i - 1];
      float sc = v[7];
#pragma unroll
      for (int o = 1; o < 64; o <<= 1) { const float up = __uint_as_float((unsigned)__builtin_amdgcn_ds_bpermute((lane - o) << 2, (int)__float_as_uint(sc))); if (lane >= o) sc += up; }
      if (lane == 63) tot[wave] = sc;
      __syncthreads();
      float base = sc - v[7];
      for (int w = 0; w < wave; ++w) base += tot[w];
      if (8 * tid < nval) {
#pragma unroll
          for (int i = 0; i < 8; ++i) cum[8 * tid + i] = v[i] + base; }
      __syncthreads(); }
    f32x16 O[1][2]; float M[1] = {0.f}, Ls[1] = {0.f};
#pragma unroll
    for (int i = 0; i < 16; ++i) { O[0][0][i] = 0.f; O[0][1][i] = 0.f; }
    const u64 tm = (qb == 15) ? ~0ull : ((1ull << (4 * qb + 4)) - 1ull);
#if AC2_MODE == 0
    {
        const u64 low = (1ull << (4 * qb)) - 1ull; const float cref = cum[256 * qb];
        attn_core<64, 1, true, false, true>(L, Kp, nullptr, Vp, cum, cref, Qf, tm & ~low, t_lane, tw0, 1 << 30, 0.f, 0u, 0u, O, M, Ls, tid, false, 4 * qb + 3, kpre, vpre);
        if (qb > 0) {
            const float qn2 = q_norm2_max<4>(Qf[0], lane), mmin = wave_min_l(M[0], lane);
            const float* kn = (const float*)((const unsigned*)(ws + WS_CTL) + CW_KN + l * 8192) + ((size_t)bh * 64 + lane) * 2;
            bool skip = false;
            if (lane < 4 * qb) { const float kn2 = kn[0] + kn[1]; const float bound = sqrtf(qn2 * kn2) * 1.02f + (cref - cum[64 * lane + 63]) * LOG2E - mmin; skip = bound < -152.f; }
            const u64 drop = prune_consensus(skip, (LAS u64*)(cum + 4096 + 16), wave, lane);
            const u64 tm2 = low & ~drop;
            if (tm2) attn_core<64, 1, true, false>(L, Kp, nullptr, Vp, cum, cref, Qf, tm2, t_lane, tw0, 1 << 30, 0.f, 0u, 0u, O, M, Ls, tid, true);
        }
    }
#else
    attn_core2<true, false>(L, (const bf16*)(ws + WS_FQKV) + 8 * MiB + (size_t)bh * T_ * 64, (const bf16*)(ws + WS_FQKV) + 16 * MiB + (size_t)bh * T_ * 64, cum, cum[256 * qb],
                            Qf[0], tm, t_lane, tw0, 1 << 30, 0.f, 0u, 0u, O[0], M[0], Ls[0], tid);
#endif
    const float lt = swap_sum(Ls[0]), inv = lt > 0.f ? 1.f / lt : 0.f;
    bf16* dst = (bf16*)(ws + WS_ATT) + mix_off((size_t)b * T_ + t_lane, 512 + hd * 64 + 4 * h, 1024);
    ATTN_FOR_CHUNKS(db, g4) { const unsigned w0 = cvtpk(O[0][db][4 * g4 + 0] * inv, O[0][db][4 * g4 + 1] * inv), w1 = cvtpk(O[0][db][4 * g4 + 2] * inv, O[0][db][4 * g4 + 3] * inv);
        *(u64*)(dst + (4 * db + g4) * 256) = (u64)w0 | ((u64)w1 << 32); }
}
__device__ __forceinline__ void U_diff(KP p_, int bh_, int qb_, int l_) {
    const KP p = uni_kp(p_); const int bh = __builtin_amdgcn_readfirstlane(bh_), qb = __builtin_amdgcn_readfirstlane(qb_), l = __builtin_amdgcn_readfirstlane(l_);
    int tid_ = threadIdx.x; asm volatile("" : "+v"(tid_));
    const int tid = tid_, lane = tid & 63, wave = __builtin_amdgcn_readfirstlane(tid >> 6), r = lane & 31, h = lane >> 5;
    unsigned char* ws = p->ws; asm volatile("" : "+s"(ws)); LAS unsigned char* L = (LAS unsigned char*)lds_raw;
    const int tw0 = 256 * qb + 32 * wave, t_lane = tw0 + r, b = bh >> 2, hd = bh & 3;
    const bf16* DQ = (const bf16*)(ws + WS_DQK); const bf16* DK = DQ + 8 * MiB;
    bf16x8v Qf[2][2];
#pragma unroll
    for (int mp = 0; mp < 2; ++mp)
#pragma unroll
        for (int s = 0; s < 2; ++s) Qf[mp][s] = *(const bf16x8v*)(DQ + ((size_t)(bh * 2 + mp) * T_ + t_lane) * 32 + 16 * s + 8 * h);
    f32x16 O[2][2]; float M[2] = {0.f, 0.f}, Ls[2] = {0.f, 0.f};
#pragma unroll
    for (int i = 0; i < 16; ++i) { O[0][0][i] = 0.f; O[0][1][i] = 0.f; O[1][0][i] = 0.f; O[1][1][i] = 0.f; }
    const u64 tm = (qb == 15) ? ~0ull : ((1ull << (4 * qb + 4)) - 1ull);
    {
        const u64 low = (1ull << (4 * qb)) - 1ull; const float slope2 = alibi_slope(hd + 1, 4) * LOG2E;
        const bf16* K0 = DK + (size_t)(bh * 2 + 0) * T_ * 32; const bf16* K1 = DK + (size_t)(bh * 2 + 1) * T_ * 32; const bf16* Vp = (const bf16*)(ws + WS_DV) + (size_t)bh * T_ * 64;
        attn_core<32, 2, false, false>(L, K0, K1, Vp, nullptr, 0.f, Qf, tm & ~low, t_lane, tw0, 1 << 30, slope2, 0u, 0u, O, M, Ls, tid);
        if (qb > 0) {
            const float qa = q_norm2_max<2>(Qf[0], lane), qb2 = q_norm2_max<2>(Qf[1], lane), ma = wave_min_l(M[0], lane), mb = wave_min_l(M[1], lane);
            const float* kn = (const float*)((const unsigned*)(ws + WS_CTL) + CW_KN + l * 8192 + 4096) + (size_t)(bh * 2) * 64 + lane;
            bool skip = false;
            if (lane < 4 * qb) { const float bmax = slope2 * (float)(64 * lane + 63 - tw0);
                skip = (sqrtf(qa * kn[0]) * 1.02f + bmax - ma < -152.f) && (sqrtf(qb2 * kn[64]) * 1.02f + bmax - mb < -152.f); }
            const u64 drop = prune_consensus(skip, (LAS u64*)(L + A_LDS_END), wave, lane);
            const u64 tm2 = low & ~drop;
            if (tm2) attn_core<32, 2, false, false>(L, K0, K1, Vp, nullptr, 0.f, Qf, tm2, t_lane, tw0, 1 << 30, slope2, 0u, 0u, O, M, Ls, tid, true);
        }
    }
    const float* lam = p->in[11] + (size_t)l * 128; const float* subln = p->in[12] + (size_t)l * 64;
    float l1 = 0.f, l2 = 0.f; if (lane < 32) { l1 = lam[lane] * lam[32 + lane]; l2 = lam[64 + lane] * lam[96 + lane]; }
    const float li = lambda_init_of(l), lam_full = __expf(wave_sum_l(l1, lane)) - __expf(wave_sum_l(l2, lane)) + li;
    const float lt0 = swap_sum(Ls[0]), lt1 = swap_sum(Ls[1]), i0 = lt0 > 0.f ? 1.f / lt0 : 0.f, i1 = (lt1 > 0.f ? 1.f / lt1 : 0.f) * lam_full;
    float ss = 0.f;
#pragma unroll
    for (int db = 0; db < 2; ++db)
#pragma unroll
        for (int i = 0; i < 16; ++i) { const float o = O[0][db][i] * i0 - O[1][db][i] * i1; O[0][db][i] = o; ss += o * o; }
    ss = swap_sum(ss);
    const float rn = rsqrtf(ss * (1.f / 64.f) + EPS) * (1.f - li);
    bf16* dst = (bf16*)(ws + WS_ATT) + mix_off((size_t)b * T_ + t_lane, 768 + hd * 64 + 4 * h, 1024);
    ATTN_FOR_CHUNKS(db, g4) { const f32x4 sg = *(const f32x4*)(subln + 32 * db + 8 * g4 + 4 * h);
        const unsigned w0 = cvtpk(O[0][db][4 * g4 + 0] * rn * sg.x, O[0][db][4 * g4 + 1] * rn * sg.y), w1 = cvtpk(O[0][db][4 * g4 + 2] * rn * sg.z, O[0][db][4 * g4 + 3] * rn * sg.w);
        *(u64*)(dst + (4 * db + g4) * 256) = (u64)w0 | ((u64)w1 << 32); }
}
__device__ __forceinline__ void U_win(KP p_, int bg_, int c_) {
    const KP p = uni_kp(p_); const int bg = __builtin_amdgcn_readfirstlane(bg_), cc = __builtin_amdgcn_readfirstlane(c_);
    int tid_ = threadIdx.x; asm volatile("" : "+v"(tid_));
    const int tid = tid_, lane = tid & 63, wave = __builtin_amdgcn_readfirstlane(tid >> 6), r = lane & 31, h = lane >> 5;
    unsigned char* ws = p->ws; asm volatile("" : "+s"(ws)); LAS unsigned char* L = (LAS unsigned char*)lds_raw;
    const int b = bg >> 1, g = bg & 1, hd = g * 4 + (wave >> 1), tw0 = 64 * cc + 32 * (wave & 1), t_lane = tw0 + r;
    const bf16* q = (const bf16*)(ws + WS_QN) + (size_t)(b * 8 + hd) * T_ * 64 + (t_lane >> 4) * 1024 + (t_lane & 15) * 32 + 8 * h;
    bf16x8v Qf[1][4];
#pragma unroll
    for (int s = 0; s < 4; ++s) Qf[0][s] = *(const bf16x8v*)(q + (s >> 1) * 512 + (s & 1) * 16);
    f32x16 O[1][2]; float M[1] = {0.f}, Ls[1] = {0.f};
#pragma unroll
    for (int i = 0; i < 16; ++i) { O[0][0][i] = 0.f; O[0][1][i] = 0.f; }
    const size_t n = (size_t)b * T_ + t_lane;
    const float gate_w = ((const float*)(ws + WS_GATE))[n * 24 + hd * 3 + 2];
    const int jlo = cc > 8 ? cc - 8 : 0;
    const u64 hi = (cc == 63) ? ~0ull : ((1ull << (cc + 1)) - 1ull), tm = hi & ~((1ull << jlo) - 1ull);
#if AC2_MODE == 0
    attn_core<64, 1, false, false>(L, (const bf16*)(ws + WS_KV6 + 4 * KV6_STRIDE) + (size_t)bg * T_ * 64, nullptr, (const bf16*)(ws + WS_KV6 + 5 * KV6_STRIDE) + (size_t)bg * T_ * 64, nullptr, 0.f,
                                   Qf, tm, t_lane, tw0, 512, alibi_slope(hd + 1, 8) * LOG2E, 0u, 0u, O, M, Ls, tid);
#ifdef PROBE_WINCORE2
    attn_core<64, 1, false, false>(L, (const bf16*)(ws + WS_KV6 + 4 * KV6_STRIDE) + (size_t)bg * T_ * 64, nullptr, (const bf16*)(ws + WS_KV6 + 5 * KV6_STRIDE) + (size_t)bg * T_ * 64, nullptr, 0.f,
                                   Qf, tm, t_lane, tw0, 512, alibi_slope(hd + 1, 8) * LOG2E, 0u, 0u, O, M, Ls, tid, true);
#endif
#else
    attn_core2<false, false>(L, (const bf16*)(ws + WS_KV6 + 4 * KV6_STRIDE) + (size_t)bg * T_ * 64, (const bf16*)(ws + WS_KV6 + 5 * KV6_STRIDE) + (size_t)bg * T_ * 64, nullptr, 0.f,
                             Qf[0], tm, t_lane, tw0, 512, alibi_slope(hd + 1, 8) * LOG2E, 0u, 0u, O[0], M[0], Ls[0], tid);
#endif
    const float lt = swap_sum(Ls[0]), inv = (lt > 0.f ? 1.f / lt : 0.f) * gate_w;
    bf16* dst = (bf16*)(ws + WS_OWIN) + mix_off(n, hd * 64 + 4 * h, 512);
    ATTN_FOR_CHUNKS(db, g4) { const unsigned w0 = cvtpk(O[0][db][4 * g4 + 0] * inv, O[0][db][4 * g4 + 1] * inv), w1 = cvtpk(O[0][db][4 * g4 + 2] * inv, O[0][db][4 * g4 + 3] * inv);
        *(u64*)(dst + (4 * db + g4) * 256) = (u64)w0 | ((u64)w1 << 32); }
}
__device__ __forceinline__ void U_slc(KP p_, int bg_, int c_) {
    const KP p = uni_kp(p_); const int bg = __builtin_amdgcn_readfirstlane(bg_), cc = __builtin_amdgcn_readfirstlane(c_);
    int tid_ = threadIdx.x; asm volatile("" : "+v"(tid_));
    const int tid = tid_, lane = tid & 63, wave = __builtin_amdgcn_readfirstlane(tid >> 6), r = lane & 31, h = lane >> 5;
    unsigned char* ws = p->ws; asm volatile("" : "+s"(ws)); LAS unsigned char* L = (LAS unsigned char*)lds_raw;
    const int b = bg >> 1, g = bg & 1, hd = g * 4 + (wave >> 1), tw0 = 64 * cc + 32 * (wave & 1), t_lane = tw0 + r;
    const bf16* q = (const bf16*)(ws + WS_QN) + (size_t)(b * 8 + hd) * T_ * 64 + (t_lane >> 4) * 1024 + (t_lane & 15) * 32 + 8 * h;
    bf16x8v Qf[1][4];
#pragma unroll
    for (int s = 0; s < 4; ++s) Qf[0][s] = *(const bf16x8v*)(q + (s >> 1) * 512 + (s & 1) * 16);
    f32x16 O[1][2]; float M[1] = {0.f}, Ls[1] = {0.f};
#pragma unroll
    for (int i = 0; i < 16; ++i) { O[0][0][i] = 0.f; O[0][1][i] = 0.f; }
    const bf16* Ksl = (const bf16*)(ws + WS_KV6 + 2 * KV6_STRIDE) + (size_t)bg * T_ * 64; const bf16* Vsl = (const bf16*)(ws + WS_KV6 + 3 * KV6_STRIDE) + (size_t)bg * T_ * 64;
    u32x4 kpre, vpre; attn_preload<64>(Ksl, nullptr, Vsl, cc, tid, kpre, vpre);
    const size_t n = (size_t)b * T_ + t_lane;
    const float gate_s = ((const float*)(ws + WS_GATE))[n * 24 + hd * 3 + 1];
    const bf16* oc = (const bf16*)(ws + WS_OCMP) + mix_off(n, hd * 64 + 4 * h, 512); const bf16* ow = (const bf16*)(ws + WS_OWIN) + mix_off(n, hd * 64 + 4 * h, 512);
    u64 ocv[8], owv[8];
    ATTN_FOR_CHUNKS(db, g4) { ocv[4 * db + g4] = *(const u64*)(oc + (4 * db + g4) * 256); owv[4 * db + g4] = *(const u64*)(ow + (4 * db + g4) * 256); }
    const u64* sel = (const u64*)(ws + WS_SEL) + (size_t)bg * T_;
    const u64 mine = sel[t_lane]; u64 un = sel[64 * cc + lane];
    { unsigned ul = (unsigned)un, uh = (unsigned)(un >> 32);
#pragma unroll
      for (int o = 1; o < 64; o <<= 1) { ul |= shflx_u(ul, o, lane); uh |= shflx_u(uh, o, lane); }
      un = ((u64)__builtin_amdgcn_readfirstlane(uh) << 32) | __builtin_amdgcn_readfirstlane(ul); }
#if AC2_MODE == 0
    attn_core<64, 1, false, true, true>(L, Ksl, nullptr, Vsl, nullptr, 0.f,
                                  Qf, un, t_lane, tw0, 1 << 30, alibi_slope(hd + 1, 8) * LOG2E, (unsigned)mine, (unsigned)(mine >> 32), O, M, Ls, tid, false, cc, kpre, vpre);
#else
    attn_core2<false, true>(L, (const bf16*)(ws + WS_KV6 + 2 * KV6_STRIDE) + (size_t)bg * T_ * 64, (const bf16*)(ws + WS_KV6 + 3 * KV6_STRIDE) + (size_t)bg * T_ * 64, nullptr, 0.f,
                            Qf[0], un, t_lane, tw0, 1 << 30, alibi_slope(hd + 1, 8) * LOG2E, (unsigned)mine, (unsigned)(mine >> 32), O[0], M[0], Ls[0], tid);
#endif
    const float lt = swap_sum(Ls[0]), inv = (lt > 0.f ? 1.f / lt : 0.f) * gate_s;
    bf16* dst = (bf16*)(ws + WS_ATT) + mix_off(n, hd * 64 + 4 * h, 1024);
    ATTN_FOR_CHUNKS(db, g4) { const u64 a = ocv[4 * db + g4], w = owv[4 * db + g4];
        const float x0 = O[0][db][4 * g4 + 0] * inv + __uint_as_float((unsigned)a << 16) + __uint_as_float((unsigned)w << 16);
        const float x1 = O[0][db][4 * g4 + 1] * inv + __uint_as_float((unsigned)a & 0xffff0000u) + __uint_as_float((unsigned)w & 0xffff0000u);
        const float x2 = O[0][db][4 * g4 + 2] * inv + __uint_as_float((unsigned)(a >> 32) << 16) + __uint_as_float((unsigned)(w >> 32) << 16);
        const float x3 = O[0][db][4 * g4 + 3] * inv + __uint_as_float((unsigned)(a >> 32) & 0xffff0000u) + __uint_as_float((unsigned)(w >> 32) & 0xffff0000u);
        *(u64*)(dst + (4 * db + g4) * 256) = (u64)cvtpk(x0, x1) | ((u64)cvtpk(x2, x3) << 32); }
}
__device__ __forceinline__ float other_half(float x, int h) { auto rr = __builtin_amdgcn_permlane32_swap(__float_as_uint(x), __float_as_uint(x), false, false); return __uint_as_float(h ? rr[0] : rr[1]); }
__device__ __forceinline__ int other_half_i(int x, int h) { auto rr = __builtin_amdgcn_permlane32_swap((unsigned)x, (unsigned)x, false, false); return (int)(h ? rr[0] : rr[1]); }
template <bool MASK>
__device__ __forceinline__ void cmp_scores(f32x16& p0, f32x16& p1, const LAS unsigned char* kt, const bf16x8v (&Qf)[4], float b0, float s1, int cl, int nvis_l) {
    const float s8 = s1 * 8.f, s32 = s1 * 32.f;
    p0[0] = b0; p0[1] = p0[0] + s1; p0[2] = p0[1] + s1; p0[3] = p0[2] + s1;
#pragma unroll
    for (int reg = 4; reg < 16; ++reg) p0[reg] = p0[reg - 4] + s8;
#pragma unroll
    for (int reg = 0; reg < 16; ++reg) p1[reg] = p0[reg] + s32;
#pragma unroll
    for (int s = 0; s < 4; ++s) { const bf16x8v kf0 = *(const LAS bf16x8v*)(kt + s * 32), kf1 = *(const LAS bf16x8v*)(kt + 32 * 144 + s * 32);
        p0 = __builtin_amdgcn_mfma_f32_32x32x16_bf16(kf0, Qf[s], p0, 0, 0, 0); p1 = __builtin_amdgcn_mfma_f32_32x32x16_bf16(kf1, Qf[s], p1, 0, 0, 0); }
    if (MASK) {
#pragma unroll
        for (int reg = 0; reg < 16; ++reg) { const int c = cl + crow0(reg); p0[reg] = (c < nvis_l) ? p0[reg] : -INFINITY; p1[reg] = (c + 32 < nvis_l) ? p1[reg] : -INFINITY; } }
}
__device__ __forceinline__ void U_cmp(KP p_, int bg_, int u_) {
    const KP p = uni_kp(p_); const int bg = __builtin_amdgcn_readfirstlane(bg_), uu = __builtin_amdgcn_readfirstlane(u_);
    int tid_ = threadIdx.x; asm volatile("" : "+v"(tid_));
    const int tid = tid_, lane = tid & 63, wave = __builtin_amdgcn_readfirstlane(tid >> 6), r = lane & 31, h = lane >> 5;
    unsigned char* ws = p->ws; asm volatile("" : "+s"(ws)); LAS unsigned char* L = (LAS unsigned char*)lds_raw;
    const int b = bg >> 1, g = bg & 1, tw0 = 32 * (uu + 16 * wave), t_lane = tw0 + r;
    { const bf16* kc = (const bf16*)(ws + WS_KVCMP) + (size_t)bg * 256 * 64; const bf16* vc = kc + 16 * 256 * 64;
#pragma unroll
      for (int i = 0; i < 4; ++i) { const int ch = tid + 512 * i, row = ch >> 3, c8 = ch & 7;
          *(LAS u32x4*)(L + row * 144 + c8 * 16) = *(const u32x4*)(kc + row * 64 + c8 * 8); *(LAS u32x4*)(L + 36864 + row * 144 + c8 * 16) = *(const u32x4*)(vc + row * 64 + c8 * 8); } }
    __syncthreads();
    const int nvis_l = t_lane >= 31 ? ((t_lane - 31) >> 4) + 1 : 0, nvis_max = (tw0 >> 4) + 1, nvis_min = tw0 >= 31 ? ((tw0 - 31) >> 4) + 1 : 0, ntile = (nvis_max + 63) >> 6;
    const LAS unsigned char* kfrag = L + r * 144 + h * 16;
    const LAS unsigned char* vfrag = L + 36864 + (4 * h + ((lane & 15) >> 2)) * 144 + (16 * ((lane >> 4) & 1) + 4 * (lane & 3)) * 2;
    float imp[32];
#pragma unroll
    for (int e = 0; e < 32; ++e) imp[e] = 0.f;
    const float* gate = (const float*)(ws + WS_GATE) + ((size_t)b * T_ + t_lane) * 24;
#pragma unroll 1
    for (int hg = 0; hg < 4; ++hg) {
        const int hd = g * 4 + hg; const float s1 = alibi_slope(hd + 1, 8) * LOG2E * 16.f;
        const bf16* q = (const bf16*)(ws + WS_QN) + (size_t)(b * 8 + hd) * T_ * 64 + (t_lane >> 4) * 1024 + (t_lane & 15) * 32 + 8 * h;
        bf16x8v Qf[4];
#pragma unroll
        for (int s = 0; s < 4; ++s) Qf[s] = *(const bf16x8v*)(q + (s >> 1) * 512 + (s & 1) * 16);
        float m = -1e30f, lsum = 0.f;
#pragma unroll 1
        for (int jt = 0; jt < ntile; ++jt) {
            f32x16 p0, p1; const float b0 = s1 * (float)(64 * jt + 4 * h - nvis_max);
            if (64 * jt + 63 >= nvis_min) cmp_scores<true>(p0, p1, kfrag + jt * (64 * 144), Qf, b0, s1, 64 * jt + 4 * h, nvis_l);
            else cmp_scores<false>(p0, p1, kfrag + jt * (64 * 144), Qf, b0, s1, 64 * jt + 4 * h, nvis_l);
            float mt = fmaxf(p0[0], p1[0]);
#pragma unroll
            for (int reg = 1; reg < 16; ++reg) mt = fmaxf(mt, fmaxf(p0[reg], p1[reg]));
            mt = swap_max(mt);
            const float mn = fmaxf(m, mt); float rs = 0.f;
#pragma unroll
            for (int reg = 0; reg < 16; ++reg) rs += __builtin_amdgcn_exp2f(p0[reg] - mn) + __builtin_amdgcn_exp2f(p1[reg] - mn);
            lsum = lsum * __builtin_amdgcn_exp2f(m - mn) + rs; m = mn;
        }
        const float lt = swap_sum(lsum), inv = lt > 0.f ? 1.f / lt : 0.f;
        f32x16 O0, O1;
#pragma unroll
        for (int i = 0; i < 16; ++i) { O0[i] = 0.f; O1[i] = 0.f; }
        float carry = 0.f;
#pragma unroll
        for (int jt = 0; jt < 4; ++jt) if (jt < ntile) {
            f32x16 p0, p1; const float b0 = s1 * (float)(64 * jt + 4 * h - nvis_max);
            if (64 * jt + 63 >= nvis_min) cmp_scores<true>(p0, p1, kfrag + jt * (64 * 144), Qf, b0, s1, 64 * jt + 4 * h, nvis_l);
            else cmp_scores<false>(p0, p1, kfrag + jt * (64 * 144), Qf, b0, s1, 64 * jt + 4 * h, nvis_l);
#pragma unroll
            for (int reg = 0; reg < 16; ++reg) { p0[reg] = __builtin_amdgcn_exp2f(p0[reg] - m) * inv; p1[reg] = __builtin_amdgcn_exp2f(p1[reg] - m) * inv; }
            float cv[8];
#pragma unroll
            for (int g4 = 0; g4 < 4; ++g4) { const float h0 = 0.5f * p0[4 * g4 + 3], h1 = 0.5f * p1[4 * g4 + 3];
                imp[jt * 8 + g4] += ((p0[4 * g4] + p0[4 * g4 + 1]) + p0[4 * g4 + 2]) + h0; imp[jt * 8 + 4 + g4] += ((p1[4 * g4] + p1[4 * g4 + 1]) + p1[4 * g4 + 2]) + h1;
                cv[g4] = h0; cv[4 + g4] = h1; }
            float prev = carry;
#pragma unroll
            for (int k = 0; k < 8; ++k) { const float sv = other_half(cv[k], h); imp[jt * 8 + k] += h ? sv : prev; prev = sv; }
            carry = prev;
            const bf16x8v pa0 = pack8(p0, 0), pa1 = pack8(p0, 8), pa2 = pack8(p1, 0), pa3 = pack8(p1, 8);
            const LAS unsigned char* vb = vfrag + jt * (64 * 144);
#pragma unroll
            for (int ks = 0; ks < 4; ++ks) { const bf16x8v pa = ks == 0 ? pa0 : ks == 1 ? pa1 : ks == 2 ? pa2 : pa3;
                { const s16x4 lo = tr_read(vb + ks * (16 * 144)), hi = tr_read(vb + ks * (16 * 144) + 8 * 144); const bf16x8v vf = {lo[0], lo[1], lo[2], lo[3], hi[0], hi[1], hi[2], hi[3]};
                  O0 = __builtin_amdgcn_mfma_f32_32x32x16_bf16(vf, pa, O0, 0, 0, 0); }
                { const s16x4 lo = tr_read(vb + ks * (16 * 144) + 64), hi = tr_read(vb + ks * (16 * 144) + 64 + 8 * 144); const bf16x8v vf = {lo[0], lo[1], lo[2], lo[3], hi[0], hi[1], hi[2], hi[3]};
                  O1 = __builtin_amdgcn_mfma_f32_32x32x16_bf16(vf, pa, O1, 0, 0, 0); } }
        }
        const float gt = gate[hd * 3 + 0];
        bf16* dst = (bf16*)(ws + WS_OCMP) + mix_off((size_t)b * T_ + t_lane, hd * 64 + 4 * h, 512);
#pragma unroll
        for (int g4 = 0; g4 < 4; ++g4) {
            *(u64*)(dst + g4 * 256) = (u64)cvtpk(O0[4 * g4 + 0] * gt, O0[4 * g4 + 1] * gt) | ((u64)cvtpk(O0[4 * g4 + 2] * gt, O0[4 * g4 + 3] * gt) << 32);
            *(u64*)(dst + (4 + g4) * 256) = (u64)cvtpk(O1[4 * g4 + 0] * gt, O1[4 * g4 + 1] * gt) | ((u64)cvtpk(O1[4 * g4 + 2] * gt, O1[4 * g4 + 3] * gt) << 32); }
    }
    const int cur = tw0 >> 6; u64 mask;
    if (cur <= 15) mask = (1ull << (cur + 1)) - 1ull;
    else {
        mask = 1ull | (1ull << cur) | (1ull << (cur - 1));
#pragma unroll
        for (int e = 0; e < 32; ++e) { const int j = 2 * e + h; if (j > cur || j == 0 || j >= cur - 1) imp[e] = -INFINITY; }
#pragma unroll 1
        for (int round = 0; round < 13; ++round) {
            float bv = imp[0]; int be = 0;
#pragma unroll
            for (int e = 1; e < 32; ++e) if (imp[e] > bv) { bv = imp[e]; be = e; }
            const int bj = 2 * be + h; const float ov = other_half(bv, h); const int oj = other_half_i(bj, h);
            const bool mine = bv > ov || (bv == ov && bj < oj);
            mask |= 1ull << (mine ? bj : oj);
#pragma unroll
            for (int e = 0; e < 32; ++e) imp[e] = (mine && e == be) ? -INFINITY : imp[e];
        }
    }
    if (h == 0) ((u64*)(ws + WS_SEL))[(size_t)bg * T_ + t_lane] = mask;
    __syncthreads();
}
constexpr int CONV_UNITS = L_ * NEXP * (2 * 16 * 8 + 4 * 32) / 32;
__device__ __forceinline__ void U_conv(KP p_, int k_) {
    const KP p = uni_kp(p_); const int k = __builtin_amdgcn_readfirstlane(k_);
    int tid_ = threadIdx.x; asm volatile("" : "+v"(tid_));
    const int tid = tid_, lane = tid & 63, wave = __builtin_amdgcn_readfirstlane(tid >> 6);
    unsigned char* ws = p->ws; asm volatile("" : "+s"(ws));
    LAS float* scr = (LAS float*)lds_raw + wave * (64 * 33);
    constexpr int I_G = 16 * 8, I_D = 4 * 32, I_E = 2 * I_G + I_D;
#pragma unroll 1
    for (int i = 0; i < 4; ++i) {
        const int m = k * 32 + i * 8 + wave, l = m / (NEXP * I_E); int r = m % (NEXP * I_E); const int e = r / I_E; r = r % I_E; const size_t le = (size_t)l * NEXP + e;
        const float* W; bf16* WT; int ldw, K, ncol, r0 = 0, rmul = 1; const float* gk = nullptr;
        if (r < 2 * I_G) { const int up = r >= I_G; r -= up * I_G; W = p->in[19 + up] + le * D_ * DEXP; WT = (bf16*)(ws + WS_WGU_T) + le * 512 * D_; ldw = DEXP; K = D_; ncol = 256; r0 = up; rmul = 2; gk = p->in[14] + (size_t)l * D_; }
        else { r -= 2 * I_G; W = p->in[21] + le * DEXP * D_; WT = (bf16*)(ws + WS_WD_T) + le * D_ * DEXP; ldw = D_; K = DEXP; ncol = 1024; }
        transpose_seg(W, ldw, K, 0, ncol, WT, r0, rmul, r, scr, lane, gk);
    }
}
__device__ __forceinline__ int fetch_unit(KP p, int qidx) {
    volatile LAS unsigned* slot = (volatile LAS unsigned*)((LAS unsigned char*)lds_raw + MISC_OFF) + 16;
    __syncthreads();
    int t0_ = threadIdx.x; asm volatile("" : "+v"(t0_));
    if (t0_ == 0) *slot = __hip_atomic_fetch_add((unsigned*)(p->ws + WS_CTL) + CW_QUEUE + 64 * qidx, 1u, __ATOMIC_RELAXED, __HIP_MEMORY_SCOPE_AGENT);
    __syncthreads();
    return (int)__builtin_amdgcn_readfirstlane(*slot);
}
__device__ __forceinline__ void P_cmp1_mfma(int l_) { const KP p = (KP)__builtin_amdgcn_kernarg_segment_ptr(); int l = l_; asm volatile("" : "+s"(l));
    unsigned char* ws = p->ws; asm volatile("" : "+s"(ws)); const int c = launder_s((int)blockIdx.x), kv = c >> 4, pm = c & 15;
    OneUnitOrder S; S.has = c < 32; S.u.pm = pm; S.u.pn = kv;
    S.u.a = (const char*)(ws + WS_KV6 + (size_t)kv * KV6_STRIDE) + (size_t)pm * 256 * 1024 * 2; S.u.b = (const char*)((const bf16*)(ws + WS_W1_T) + ((size_t)l * 2 + kv) * 256 * 2048); S.u.b2 = S.u.b;
    const pg8::Gemm g{1024, 2048, 2048, 32, 0, 0};
    const EpiCmpH E{(bf16*)(ws + WS_HC), (const float*)(ws + WS_BIAS1) + l * 512};
    pg8::gemm_phase<EpiCmpH, OneUnitOrder, false, true>((LAS unsigned char*)lds_raw, g, S, E);
}
__device__ __forceinline__ void P_cmp2_mfma(int l_) { const KP p = (KP)__builtin_amdgcn_kernarg_segment_ptr(); int l = l_; asm volatile("" : "+s"(l));
    unsigned char* ws = p->ws; asm volatile("" : "+s"(ws)); const int c = launder_s((int)blockIdx.x), kv = c >> 4, pm = c & 15;
    OneUnitOrder S; S.has = c < 32; S.u.pm = pm; S.u.pn = kv;
    S.u.a = (const char*)((const bf16*)(ws + WS_HC) + ((size_t)kv * 4096 + pm * 256) * 256); S.u.b = (const char*)((const bf16*)(ws + WS_W2_T) + ((size_t)l * 2 + kv) * 64 * 256); S.u.b2 = S.u.b;
    const pg8::Gemm g{256, 256, 256, 4, 0, 0};
    const EpiCmpOut E{(bf16*)(ws + WS_KVCMP)};
    pg8::gemm_phase<EpiCmpOut, OneUnitOrder, false, true>((LAS unsigned char*)lds_raw, g, S, E);
}
__device__ __forceinline__ void P_moe_scatter(KP p_, int l_) { const KP p = uni_kp(p_); const int l = __builtin_amdgcn_readfirstlane(l_); const Ctx c = make_ctx(p); unsigned char* ws = p->ws;
    const unsigned* cnt = (const unsigned*)(ws + WS_CTL) + CW_MOECNT + l * MOE_LS;
    moe_build_tables(cnt, c.tid);
    const LAS int* T = (const LAS int*)((LAS unsigned char*)lds_raw + TBL_OFF);
    const unsigned* info = (const unsigned*)(ws + WS_ROUTE + RT_INFO); const float* tw = (const float*)(ws + WS_ROUTE + RT_W);
    int* rowtok = (int*)(ws + WS_ROUTE + RT_ROWTOK); float* roww = (float*)(ws + WS_ROUTE + RT_ROWW);
    bf16* xs = (bf16*)(ws + WS_XS); const bf16* x = (const bf16*)(ws + WS_HN); const float* gain = p->in[14] + (size_t)l * D_; const float* rstdv = (const float*)(ws + WS_ROUTE + RT_RSTD);
    { constexpr int RB = 4; float gg[2][8];
#pragma unroll
      for (int j = 0; j < 2; ++j) { const f32x4 a = ((const f32x4*)gain)[2 * c.lane + 128 * j], b2 = ((const f32x4*)gain)[2 * c.lane + 128 * j + 1]; gg[j][0] = a.x; gg[j][1] = a.y; gg[j][2] = a.z; gg[j][3] = a.w; gg[j][4] = b2.x; gg[j][5] = b2.y; gg[j][6] = b2.z; gg[j][7] = b2.w; }
      for (int row0 = c.gw * RB; row0 < NT; row0 += c.ngw * RB) {
        u32x4 vv[RB][2];
#pragma unroll
        for (int q = 0; q < RB; ++q)
#pragma unroll
            for (int j = 0; j < 2; ++j) vv[q][j] = ((const u32x4*)(x + (size_t)(row0 + q) * D_))[c.lane + 64 * j];
#pragma unroll
        for (int q = 0; q < RB; ++q) { const int row = row0 + q;
            const unsigned v = info[row]; const int cls = (int)(v >> 24), rank = (int)(v & 0xffffffu); const size_t dest = (size_t)T[cls] * 256 + rank; const float r = rstdv[row];
#pragma unroll
            for (int j = 0; j < 2; ++j) { float f[8]; unpack8(vv[q][j], f); u32x4 o; o.x = pk2(f[0] * r * gg[j][0], f[1] * r * gg[j][1]); o.y = pk2(f[2] * r * gg[j][2], f[3] * r * gg[j][3]); o.z = pk2(f[4] * r * gg[j][4], f[5] * r * gg[j][5]); o.w = pk2(f[6] * r * gg[j][6], f[7] * r * gg[j][7]);
                ((u32x4*)(xs + dest * D_))[c.lane + 64 * j] = o; }
            if (c.lane == 0) { rowtok[dest] = row; roww[2 * dest] = tw[2 * row]; roww[2 * dest + 1] = tw[2 * row + 1]; } }
      } }
    for (int cls = c.bid; cls < 112; cls += c.G) { const int n = (int)cnt[cls * MOE_CS], end = (int)((cnt[cls * MOE_CS] + 255u) >> 8) * 256; const size_t base = (size_t)T[cls] * 256;
        for (int r = n + c.tid; r < end; r += NTHREADS) rowtok[base + r] = -1; }
}
__device__ __forceinline__ int xcd_major(int bid, int G) { bid = launder_s(bid); return (G & 7) ? bid : (bid & 7) * (G >> 3) + (bid >> 3); }
__device__ __forceinline__ void P_moe_g1(int l_) { const KP p = (KP)__builtin_amdgcn_kernarg_segment_ptr(); int l = l_; asm volatile("" : "+s"(l));
    unsigned char* ws = p->ws; asm volatile("" : "+s"(ws));
    { int t0_ = threadIdx.x; asm volatile("" : "+v"(t0_)); moe_build_tables((const unsigned*)(ws + WS_CTL) + CW_MOECNT + l * MOE_LS, t0_); }
    const MoeOrder1 S{(const char*)ws, (const unsigned*)(ws + WS_REC), (const char*)((const bf16*)(ws + WS_WGU_T) + (size_t)l * NEXP * 512 * D_), (int)gridDim.x, xcd_major((int)blockIdx.x, (int)gridDim.x)};
    const pg8::Gemm g{D_, D_, D_, D_ / 64, 0, 0};
    const EpiMoeH E{(bf16*)(ws + WS_HB), (const u32x4*)(ws + WS_REC)};
    pg8::gemm_phase<EpiMoeH, MoeOrder1, true, true, true>((LAS unsigned char*)lds_raw, g, S, E);
}
__device__ __forceinline__ void P_moe_g2(int l_) { const KP p = (KP)__builtin_amdgcn_kernarg_segment_ptr(); int l = l_; asm volatile("" : "+s"(l));
    unsigned char* ws = p->ws; asm volatile("" : "+s"(ws));
    { int t0_ = threadIdx.x; asm volatile("" : "+v"(t0_)); moe_build_tables((const unsigned*)(ws + WS_CTL) + CW_MOECNT + l * MOE_LS, t0_); }
    const MoeOrder2 S{(const char*)(ws + WS_HB), (const char*)((const bf16*)(ws + WS_WD_T) + (size_t)l * NEXP * D_ * DEXP), (int)gridDim.x, xcd_major((int)blockIdx.x, (int)gridDim.x)};
    const pg8::Gemm g{512, DEXP, 512, 4, 16, 16};
    const EpiMoeOut E{(bf16*)(ws + WS_HN), (const unsigned*)(ws + WS_REC)};
    pg8::gemm_phase<EpiMoeOut, MoeOrder2, true, true>((LAS unsigned char*)lds_raw, g, S, E);
}
__device__ __forceinline__ void P_norm1(KP p_, int l_) { const KP p = uni_kp(p_); const int l = __builtin_amdgcn_readfirstlane(l_); const Ctx c = make_ctx(p); const Bufs b = make_bufs(p->ws);
    if (l == 0) { const int i = c.bid * NTHREADS + c.tid; if (i < L_ * 2 * 256) { const float* part = (const float*)(p->ws + WS_B1PART) + (size_t)(i >> 8) * 128 * 256 + (i & 255); float a = 0.f;
        for (int k = 0; k < 128; ++k) a += part[(size_t)k * 256]; ((float*)(p->ws + WS_BIAS1))[i] = a; } }
    if (l == 0) ph_norm_bf16(c, p->in[0], p->in[1], (bf16*)p->out, (bf16*)(p->ws + WS_HN)); else ph_norm_bf16_from_bf16(c, (const bf16*)(p->ws + WS_HN), p->in[1] + (size_t)l * D_, (bf16*)p->out); }
__device__ __noinline__ void P_inproj(KP p_, int l_) { const KP p = uni_kp(p_); const int l = __builtin_amdgcn_readfirstlane(l_); const Ctx c = make_ctx(p); const Bufs b = make_bufs(p->ws);
    InProjOut o{b.QN, b.KV6, b.FQ, b.DQ, b.DV, b.GATE, b.FL, p->in[3] + l * 24, p->in[4] + l * 4};
    const bf16* A = b.HN;
    naive_gemm(c, NT, D_IN, D_, [=](int r, int k) { return bf2f(A[(size_t)r * D_ + k]); }, p->in[2] + (size_t)l * D_ * D_IN, D_IN,
               [=](int r, int col, float v) { inproj_store(o, r, col, v); }); }
__device__ __noinline__ void P_cmp1(KP p_, int l_, int kv_) { const KP p = uni_kp(p_); const int l = __builtin_amdgcn_readfirstlane(l_), kv = __builtin_amdgcn_readfirstlane(kv_); const Ctx c = make_ctx(p); const Bufs b = make_bufs(p->ws);
    const bf16* src = kv == 0 ? b.KC : b.VC; const float* pe = p->in[kv == 0 ? 5 : 8] + (size_t)l * 2048; bf16* hc = b.HC + (size_t)kv * 4096 * 256;
    naive_gemm(c, 4096, 256, 2048, [=](int r, int k) { return bf2f(src[(size_t)r * 1024 + k]) + pe[k]; }, p->in[kv == 0 ? 6 : 9] + (size_t)l * 2048 * 256, 256,
               [=](int r, int col, float v) { hc[(size_t)r * 256 + col] = (bf16)f2bf(gelu_tanh(v)); }); }
__device__ __noinline__ void P_cumsum(KP p_, int l_) { const KP p = uni_kp(p_); const int l = __builtin_amdgcn_readfirstlane(l_); const Ctx c = make_ctx(p); const Bufs b = make_bufs(p->ws); ph_cumsum(c, b.FL); }
__device__ __noinline__ void P_cmp2(KP p_, int l_, int kv_) { const KP p = uni_kp(p_); const int l = __builtin_amdgcn_readfirstlane(l_), kv = __builtin_amdgcn_readfirstlane(kv_); const Ctx c = make_ctx(p); const Bufs b = make_bufs(p->ws);
    const bf16* hc = b.HC + (size_t)kv * 4096 * 256; bf16* dst = kv == 0 ? b.KCMP : b.VCMP;
    naive_gemm(c, 4096, 64, 256, [=](int r, int k) { return bf2f(hc[(size_t)r * 256 + k]); }, p->in[kv == 0 ? 7 : 10] + (size_t)l * 256 * 64, 64,
               [=](int r, int col, float v) { dst[(size_t)r * 64 + col] = (bf16)f2bf((r & 255) == 255 ? 0.f : v); }); }
__device__ __noinline__ void P_win(KP p_, int l_) { const KP p = uni_kp(p_); const int l = __builtin_amdgcn_readfirstlane(l_); const Ctx c = make_ctx(p); const Bufs b = make_bufs(p->ws); ph_win_attn(c, b.QN, b.KW, b.VW, b.GATE, b.OWIN); }
__device__ __noinline__ void P_fox(KP p_, int l_) { const KP p = uni_kp(p_); const int l = __builtin_amdgcn_readfirstlane(l_); const Ctx c = make_ctx(p); const Bufs b = make_bufs(p->ws); ph_fox_attn(c, b.FQ, b.FK, b.FV, b.FL, b.ATT); }
__device__ __noinline__ void P_diff(KP p_, int l_) { const KP p = uni_kp(p_); const int l = __builtin_amdgcn_readfirstlane(l_); const Ctx c = make_ctx(p); const Bufs b = make_bufs(p->ws);
    ph_diff_attn(c, b.DQ, b.DK, b.DV, p->in[11] + (size_t)l * 128, p->in[12] + (size_t)l * 64, lambda_init_of(l), b.ATT); }
__device__ __noinline__ void P_cmpattn(KP p_, int l_) { const KP p = uni_kp(p_); const int l = __builtin_amdgcn_readfirstlane(l_); const Ctx c = make_ctx(p); const Bufs b = make_bufs(p->ws); ph_cmp_attn(c, b.QN, b.KCMP, b.VCMP, b.GATE, b.SEL, b.OCMP); }
__device__ __noinline__ void P_slc(KP p_, int l_) { const KP p = uni_kp(p_); const int l = __builtin_amdgcn_readfirstlane(l_); const Ctx c = make_ctx(p); const Bufs b = make_bufs(p->ws); ph_slc_attn(c, b.QN, b.KS, b.VS, b.GATE, b.SEL, b.OCMP, b.OWIN, b.ATT); }
__device__ __noinline__ void P_outproj(KP p_, int l_) { const KP p = uni_kp(p_); const int l = __builtin_amdgcn_readfirstlane(l_); const Ctx c = make_ctx(p); const Bufs b = make_bufs(p->ws);
    const bf16* A = b.ATT; float* xo = p->out; const float* xin = (l == 0) ? p->in[0] : p->out;
    naive_gemm(c, NT, D_, D_, [=](int r, int k) { return bf2f(A[(size_t)r * D_ + k]); }, p->in[13] + (size_t)l * D_ * D_, D_,
               [=](int r, int col, float v) { xo[(size_t)r * D_ + col] = xin[(size_t)r * D_ + col] + v; }); }
__device__ __forceinline__ void P_route3(int l_, int cbank) { const KP p = (KP)__builtin_amdgcn_kernarg_segment_ptr(); int l = l_; asm volatile("" : "+s"(l));
    int tid_ = threadIdx.x; asm volatile("" : "+v"(tid_));
    const int tid = tid_, lane = tid & 63, wave = __builtin_amdgcn_readfirstlane(tid >> 6), r = lane & 31, h = lane >> 5, kh = wave >> 2, wr = wave & 3;
    unsigned char* ws = p->ws; asm volatile("" : "+s"(ws)); const bf16* x = (const bf16*)(ws + WS_HN);
    const float* WR = (const float*)(ws + WS_WR) + (size_t)l * D_ * 64;
    LAS float* XT = (LAS float*)lds_raw + wave * (32 * 36);
    LAS float* WT = (LAS float*)lds_raw + 8 * 32 * 36 + kh * (2 * 32 * 64);
    LAS float* PL = (LAS float*)lds_raw + 8 * 32 * 36 + 2 * 2 * 32 * 64;
    LAS float* SS = PL + 2 * 128 * 40;
    const float* bgrp = p->in[16] + l * 4; const float* bexp = p->in[18] + l * 32;
    unsigned* cnt = (unsigned*)(ws + WS_CTL) + CW_MOECNT + l * MOE_LS + cbank;
    LAS unsigned* HIST = (LAS unsigned*)(SS + 2 * 128 * 2);
    for (int grp = launder_s((int)blockIdx.x); grp < NT / 128; grp += (int)gridDim.x) {
        const int row0 = grp * 128 + wr * 32;
        if (tid < 112) HIST[tid] = 0u;
        f32x16 acc0, acc1; float ss = 0.f;
#pragma unroll
        for (int i = 0; i < 16; ++i) { acc0[i] = 0.f; acc1[i] = 0.f; }
        { const u32x4* xsrc = (const u32x4*)(x + (size_t)(row0 + r) * D_ + kh * 512 + 8 * h);
          const u32x4* wsrc = (const u32x4*)(ws + WS_WR) + ((size_t)l * 64 + kh * 32) * 256 + lane;
#pragma unroll 4
          for (int ks = 0; ks < 32; ++ks) {
              const u32x4 av = xsrc[2 * ks], b0h = wsrc[ks * 256], b0l = wsrc[ks * 256 + 64], b1h = wsrc[ks * 256 + 128], b1l = wsrc[ks * 256 + 192];
              { float f_[8]; unpack8(av, f_);
#pragma unroll
                for (int e = 0; e < 8; ++e) ss = fmaf(f_[e], f_[e], ss); }
              const bf16x8v A = __builtin_bit_cast(bf16x8v, av);
              acc0 = __builtin_amdgcn_mfma_f32_32x32x16_bf16(A, __builtin_bit_cast(bf16x8v, b0h), acc0, 0, 0, 0); acc1 = __builtin_amdgcn_mfma_f32_32x32x16_bf16(A, __builtin_bit_cast(bf16x8v, b1h), acc1, 0, 0, 0);
              acc0 = __builtin_amdgcn_mfma_f32_32x32x16_bf16(A, __builtin_bit_cast(bf16x8v, b0l), acc0, 0, 0, 0); acc1 = __builtin_amdgcn_mfma_f32_32x32x16_bf16(A, __builtin_bit_cast(bf16x8v, b1l), acc1, 0, 0, 0);
          } }
#pragma unroll
        for (int reg = 0; reg < 16; ++reg) { const int row = wr * 32 + crow0(reg) + 4 * h; PL[(kh * 128 + row) * 40 + r] = acc0[reg]; if (r < 4) PL[(kh * 128 + row) * 40 + 32 + r] = acc1[reg]; }
        SS[(kh * 128 + wr * 32 + r) * 2 + h] = ss;
        __syncthreads();
        int cls = 0; unsigned lrank = 0u; float wlo = 0.f, whi = 0.f, rstd = 0.f;
        if (tid < 128) {
            float lg[36];
#pragma unroll
            for (int cidx = 0; cidx < 36; ++cidx) lg[cidx] = PL[tid * 40 + cidx] + PL[(128 + tid) * 40 + cidx];
            const float sq = (SS[tid * 2] + SS[tid * 2 + 1]) + (SS[(128 + tid) * 2] + SS[(128 + tid) * 2 + 1]);
            rstd = rsqrtf(sq * (1.f / D_) + EPS);
            float gl[4]; int grp_i = 0;
#pragma unroll
            for (int q = 0; q < 4; ++q) gl[q] = lg[q] * rstd + bgrp[q];
            float gm = gl[0];
#pragma unroll
            for (int q = 1; q < 4; ++q) if (gl[q] > gm) { gm = gl[q]; grp_i = q; }
            float gs = 0.f;
#pragma unroll
            for (int q = 0; q < 4; ++q) gs += __expf(gl[q] - gm);
            const float grp_gate = 1.f / gs;
            float el[8];
#pragma unroll
            for (int q = 0; q < 8; ++q) { float v = lg[4 + q]; float bb = bexp[q];
                if (grp_i == 1) { v = lg[12 + q]; bb = bexp[8 + q]; } else if (grp_i == 2) { v = lg[20 + q]; bb = bexp[16 + q]; } else if (grp_i == 3) { v = lg[28 + q]; bb = bexp[24 + q]; }
                el[q] = v * rstd + bb; }
            int i0 = 0; float v0 = el[0];
#pragma unroll
            for (int q = 1; q < 8; ++q) if (el[q] > v0) { v0 = el[q]; i0 = q; }
            int i1 = -1; float v1 = -INFINITY;
#pragma unroll
            for (int q = 0; q < 8; ++q) if (q != i0 && el[q] > v1) { v1 = el[q]; i1 = q; }
            const float e1 = __expf(v1 - v0), den = 1.f + e1, w0 = grp_gate / den, w1 = grp_gate * e1 / den;
            const int lo = i0 < i1 ? i0 : i1, hi = i0 < i1 ? i1 : i0; cls = grp_i * 28 + lo * 8 - (lo * (lo + 1)) / 2 + (hi - lo - 1);
            wlo = i0 < i1 ? w0 : w1; whi = i0 < i1 ? w1 : w0;
            lrank = __hip_atomic_fetch_add(HIST + cls, 1u, __ATOMIC_RELAXED, __HIP_MEMORY_SCOPE_WORKGROUP);
        }
        __syncthreads();
        if (tid < 112) { const unsigned n = HIST[tid]; if (n) HIST[112 + tid] = __hip_atomic_fetch_add(cnt + tid * MOE_CS, n, __ATOMIC_RELAXED, __HIP_MEMORY_SCOPE_AGENT); }
        __syncthreads();
        if (tid < 128) {
            const unsigned rank = HIST[112 + cls] + lrank;
            const int row = grp * 128 + tid;
            ((u32x4*)(ws + WS_REC))[(size_t)cls * 32768 + rank] = (u32x4){(unsigned)row, __float_as_uint(wlo), __float_as_uint(whi), __float_as_uint(rstd)};
        }
        __syncthreads();
    }
}
typedef float f32x8 __attribute__((ext_vector_type(8)));
__device__ __forceinline__ void P_route2(int l_, int cbank) { const KP p = (KP)__builtin_amdgcn_kernarg_segment_ptr(); int l = l_; asm volatile("" : "+s"(l));
    int tid_ = threadIdx.x; asm volatile("" : "+v"(tid_));
    const int tid = tid_, lane = tid & 63, wave = __builtin_amdgcn_readfirstlane(tid >> 6);
    unsigned char* ws = p->ws; asm volatile("" : "+s"(ws)); const float* x = p->out;
    const float* WR = (const float*)(ws + WS_WR) + (size_t)l * D_ * 40;
    LAS float* xt = (LAS float*)lds_raw + wave * (64 * 36);
    LAS float* part = (LAS float*)lds_raw;
    const float* bgrp = p->in[16] + l * 4; const float* bexp = p->in[18] + l * 32;
    unsigned* cnt = (unsigned*)(ws + WS_CTL) + CW_MOECNT + l * 128 + cbank;
    for (int grp = launder_s((int)blockIdx.x); grp < NT / 128; grp += (int)gridDim.x) {
        const int row0 = grp * 128 + (wave >> 2) * 64, kq = wave & 3;
        float acc[40]; float ss = 0.f;
#pragma unroll
        for (int cidx = 0; cidx < 40; ++cidx) acc[cidx] = 0.f;
#pragma unroll 1
        for (int kc = 0; kc < 8; ++kc) {
            const int k0 = kq * 256 + kc * 32;
#pragma unroll
            for (int i = 0; i < 8; ++i) { const int row = i * 8 + (lane >> 3), c4 = (lane & 7) * 4; *(LAS f32x4*)(xt + row * 36 + c4) = *(const f32x4*)(x + (size_t)(row0 + row) * D_ + k0 + c4); }
            float xr[32];
#pragma unroll
            for (int j = 0; j < 8; ++j) { const f32x4 t = *(const LAS f32x4*)(xt + lane * 36 + 4 * j); xr[4 * j] = t.x; xr[4 * j + 1] = t.y; xr[4 * j + 2] = t.z; xr[4 * j + 3] = t.w; }
            const float* wk = WR + (size_t)k0 * 40;
#pragma unroll
            for (int kk = 0; kk < 32; ++kk) {
                f32x8 w0, w1, w2, w3, w4;
                asm volatile("s_load_dwordx8 %0, %5, %6\n\ts_load_dwordx8 %1, %5, %7\n\ts_load_dwordx8 %2, %5, %8\n\ts_load_dwordx8 %3, %5, %9\n\ts_load_dwordx8 %4, %5, %10\n\ts_waitcnt lgkmcnt(0)"
                             : "=&s"(w0), "=&s"(w1), "=&s"(w2), "=&s"(w3), "=&s"(w4) : "s"(wk), "i"(kk * 160), "i"(kk * 160 + 32), "i"(kk * 160 + 64), "i"(kk * 160 + 96), "i"(kk * 160 + 128) : "memory");
                const float xv = xr[kk]; ss = fmaf(xv, xv, ss);
#pragma unroll
                for (int e = 0; e < 8; ++e) { acc[e] = fmaf(xv, w0[e], acc[e]); acc[8 + e] = fmaf(xv, w1[e], acc[8 + e]); acc[16 + e] = fmaf(xv, w2[e], acc[16 + e]); acc[24 + e] = fmaf(xv, w3[e], acc[24 + e]); }
#pragma unroll
                for (int e = 0; e < 4; ++e) acc[32 + e] = fmaf(xv, w4[e], acc[32 + e]);
            }
        }
        __syncthreads();
#pragma unroll
        for (int cidx = 0; cidx < 36; ++cidx) part[(wave * 64 + lane) * 37 + cidx] = acc[cidx];
        part[(wave * 64 + lane) * 37 + 36] = ss;
        __syncthreads();
        if (tid < 128) {
            const int rg = tid >> 6, rr = tid & 63; float lg[37];
#pragma unroll
            for (int cidx = 0; cidx < 37; ++cidx) lg[cidx] = ((part[((rg * 4 + 0) * 64 + rr) * 37 + cidx] + part[((rg * 4 + 1) * 64 + rr) * 37 + cidx]) + part[((rg * 4 + 2) * 64 + rr) * 37 + cidx]) + part[((rg * 4 + 3) * 64 + rr) * 37 + cidx];
            const float rstd = rsqrtf(lg[36] * (1.f / D_) + EPS);
            float gl[4]; int grp_i = 0;
#pragma unroll
            for (int q = 0; q < 4; ++q) gl[q] = lg[q] * rstd + bgrp[q];
            float gm = gl[0];
#pragma unroll
            for (int q = 1; q < 4; ++q) if (gl[q] > gm) { gm = gl[q]; grp_i = q; }
            float gs = 0.f;
#pragma unroll
            for (int q = 0; q < 4; ++q) gs += __expf(gl[q] - gm);
            const float grp_gate = 1.f / gs;
            float el[8];
#pragma unroll
            for (int q = 0; q < 8; ++q) { float v = lg[4 + q]; float bb = bexp[q];
                if (grp_i == 1) { v = lg[12 + q]; bb = bexp[8 + q]; } else if (grp_i == 2) { v = lg[20 + q]; bb = bexp[16 + q]; } else if (grp_i == 3) { v = lg[28 + q]; bb = bexp[24 + q]; }
                el[q] = v * rstd + bb; }
            int i0 = 0; float v0 = el[0];
#pragma unroll
            for (int q = 1; q < 8; ++q) if (el[q] > v0) { v0 = el[q]; i0 = q; }
            int i1 = -1; float v1 = -INFINITY;
#pragma unroll
            for (int q = 0; q < 8; ++q) if (q != i0 && el[q] > v1) { v1 = el[q]; i1 = q; }
            const float e1 = __expf(v1 - v0), den = 1.f + e1, w0 = grp_gate / den, w1 = grp_gate * e1 / den;
            const int lo = i0 < i1 ? i0 : i1, hi = i0 < i1 ? i1 : i0, cls = grp_i * 28 + lo * 8 - (lo * (lo + 1)) / 2 + (hi - lo - 1);
            const unsigned rank = __hip_atomic_fetch_add(cnt + cls, 1u, __ATOMIC_RELAXED, __HIP_MEMORY_SCOPE_AGENT);
            const int row = grp * 128 + tid;
            ((unsigned*)(ws + WS_ROUTE + RT_INFO))[row] = ((unsigned)cls << 24) | rank;
            ((float*)(ws + WS_ROUTE + RT_W))[2 * row] = i0 < i1 ? w0 : w1; ((float*)(ws + WS_ROUTE + RT_W))[2 * row + 1] = i0 < i1 ? w1 : w0;
            ((float*)(ws + WS_ROUTE + RT_RSTD))[row] = rstd;
        }
        __syncthreads();
    }
}
__device__ __noinline__ void P_route(KP p_, int l_) { const KP p = uni_kp(p_); const int l = __builtin_amdgcn_readfirstlane(l_); const Ctx c = make_ctx(p); const Bufs b = make_bufs(p->ws);
    ph_moe_route(c, p->out, p->in[14] + (size_t)l * D_, p->in[15] + (size_t)l * D_ * 4, p->in[16] + l * 4, p->in[17] + (size_t)l * D_ * 32, p->in[18] + l * 32, b.HN, (int*)(p->ws + WS_ROUTE + RT_INFO), (float*)(p->ws + WS_ROUTE + RT_W), (unsigned*)(p->ws + WS_CTL) + CW_MOECNT + l * 128); }
__device__ __noinline__ void P_moe(KP p_, int l_) { const KP p = uni_kp(p_); const int l = __builtin_amdgcn_readfirstlane(l_); const Ctx c = make_ctx(p); const Bufs b = make_bufs(p->ws);
    ph_moe_naive(c, b.HN, b.ROUTE_E, b.ROUTE_W, p->in[19] + (size_t)l * NEXP * D_ * DEXP, p->in[20] + (size_t)l * NEXP * D_ * DEXP, p->in[21] + (size_t)l * NEXP * DEXP * D_, p->out); }
__device__ __noinline__ void P_final(KP p_) { const KP p = uni_kp(p_); const Ctx c = make_ctx(p); ph_norm_final_from_bf16(c, (const bf16*)(p->ws + WS_HN), p->in[22], p->out); }
__device__ __forceinline__ void P_gridbar(KP p_) { const KP p = uni_kp(p_);
    XcdBarrier bar; bar.bar = (unsigned*)(p->ws + WS_CTL) + 4096; bar.x = xb_xcc_id(); bar.st = (volatile LAS unsigned*)((LAS unsigned char*)lds_raw + MISC_OFF) + 8;
    xcd_barrier(bar);
}

__global__ void __launch_bounds__(NTHREADS, 2) fwd_kernel(Params pp) {
    const KP p = (KP)__builtin_amdgcn_kernarg_segment_ptr();
    { volatile LAS unsigned* MISC = (volatile LAS unsigned*)((LAS unsigned char*)lds_raw + MISC_OFF); if (threadIdx.x < 32) MISC[threadIdx.x] = 0u; }
    __syncthreads();
    const int lo = p->ph_lo, hi = p->ph_hi;
    if (hi - lo > 1) (void)xcd_barrier_post((unsigned*)(p->ws + WS_CTL) + 4096, (volatile LAS unsigned*)((LAS unsigned char*)lds_raw + MISC_OFF) + 8);
#define IN(k) (lo <= (k) && (k) < hi)
#define SEAM(k) do { if (IN(k) && IN((k) + 1)) P_gridbar(p); } while (0)
    if (IN(0)) { for (int rep = 0; rep < REP_PRO; ++rep) { if (rep) P_gridbar(p); P_prologue(p); } }
    SEAM(0);
    for (int l = 0; l < L_; ++l) {
        const int P0 = 1 + l * PH_PER_LAYER;
        if (IN(P0 + 0)) { for (int rep = 0; rep < REP_NORM; ++rep) { if (rep) P_gridbar(p); P_norm1(p, l); } }
        SEAM(P0 + 0);
        if (IN(P0 + 1)) { for (int rep = 0; rep < REP_INPROJ; ++rep) { if (rep) P_gridbar(p); P_inproj_mfma(l); }
#ifdef REP_INDUMMY
            for (int rep = 0; rep < REP_INDUMMY; ++rep) { P_gridbar(p); P_inproj_dummy(l); }
#endif
        }
        SEAM(P0 + 1);
        if (IN(P0 + 3)) {
            P_cmp1_mfma(l);
            if (launder_s((int)blockIdx.x) < 32) { asm volatile("s_waitcnt vmcnt(0)" ::: "memory"); __builtin_amdgcn_fence(__ATOMIC_SEQ_CST, "agent"); asm volatile("s_waitcnt vmcnt(0)" ::: "memory"); }
            __syncthreads();
            P_cmp2_mfma(l);
            for (int rep = 0; rep < REP_ATT3; ++rep) { if (rep) P_gridbar(p);
            for (;;) { int u = fetch_unit(p, l * 8 + 0 + 16 * rep);
                if (l == 0) {
                    if (u >= 2048 + CONV_UNITS) break;
                    const int k11 = u / 11, r11 = u - 11 * k11;
                    if (r11 == 3 || r11 == 7 || r11 == 10) { U_conv(p, 3 * k11 + (r11 > 3) + (r11 > 7)); continue; }
                    u = 8 * k11 + r11 - (r11 > 3) - (r11 > 7); }
                else if (u >= 2048) break;
                if (u < 1024) { const int qb = 15 - (u >> 6), k = u & 63; if (k < 32) U_diff(p, k, qb, l); else U_fox(p, k - 32, qb, l); }
                else { const int w = u - 1024; U_win(p, w & 15, 63 - (w >> 4));
#ifdef PROBE_WINUNIT2
                    U_win(p, w & 15, 63 - (w >> 4));
#endif
                } } } }
        SEAM(P0 + 3);
        if (IN(P0 + 4)) { for (int rep = 0; rep < REP_CMP; ++rep) { if (rep) P_gridbar(p); for (int u = launder_s((int)blockIdx.x); u < 256; u += (int)gridDim.x) U_cmp(p, u & 15, u >> 4); } }
        SEAM(P0 + 4);
        if (IN(P0 + 5)) { for (int rep = 0; rep < REP_SLC; ++rep) { if (rep) P_gridbar(p); for (;;) { const int u = fetch_unit(p, l * 8 + 1 + 16 * rep); if (u >= 1024) break; U_slc(p, u & 15, 63 - (u >> 4)); } } }
        SEAM(P0 + 5);
        if (IN(P0 + 6)) P_outproj_mfma(l);
        SEAM(P0 + 6);
        if (IN(P0 + 7)) { for (int rep = 0; rep < REP_ROUTE; ++rep) { if (rep) P_gridbar(p); P_route3(l, REP_ROUTE - 1 - rep); } }
        SEAM(P0 + 7);
        if (IN(P0 + 9)) { for (int rep = 0; rep < REP_G1; ++rep) { if (rep) P_gridbar(p); P_moe_g1(l); } }
        SEAM(P0 + 9);
        if (IN(P0 + 10)) P_moe_g2(l);
        SEAM(P0 + 10);
    }
    if (IN(1 + L_ * PH_PER_LAYER)) P_final(p);
#undef IN
#undef SEAM
}

extern "C" void kernel_launch(void* const* d_in, const int* in_sizes, int n_in, void* d_out, int out_size, void* d_ws, size_t ws_size, hipStream_t stream) {
    static int grid = 0;
    if (grid == 0) {
        if (n_in != 23 || out_size != NT * D_ || ws_size < WS_END) { fprintf(stderr, "kernel_launch: unexpected sizes n_in %d out %d ws %zu (need %zu)\n", n_in, out_size, ws_size, (size_t)WS_END); grid = -1; return; }
        int dev = 0, cus = 0, per_cu = 0;
        if (hipGetDevice(&dev) != hipSuccess || hipDeviceGetAttribute(&cus, hipDeviceAttributeMultiprocessorCount, dev) != hipSuccess) { grid = -1; return; }
        if (hipFuncSetAttribute((const void*)fwd_kernel, hipFuncAttributeMaxDynamicSharedMemorySize, LDS_BYTES) != hipSuccess) { fprintf(stderr, "kernel_launch: hipFuncSetAttribute failed\n"); grid = -1; return; }
        if (hipOccupancyMaxActiveBlocksPerMultiprocessor(&per_cu, (const void*)fwd_kernel, NTHREADS, LDS_BYTES) != hipSuccess || per_cu < 1) { fprintf(stderr, "kernel_launch: occupancy query says %d\n", per_cu); }
        (void)hipGetLastError();
        grid = cus;
    }
    if (grid < 0) return;
    (void)hipMemsetAsync((char*)d_ws + WS_CTL, 0, CTL_BYTES, stream);
    Params p{};
    for (int i = 0; i < 23; ++i) p.in[i] = (const float*)d_in[i];
    p.out = (float*)d_out; p.ws = (unsigned char*)d_ws;
#if N_LAUNCH_MODE == 0
    p.ph_lo = 0; p.ph_hi = N_PHASES;
    hipLaunchKernelGGL(fwd_kernel, dim3(grid), dim3(NTHREADS), LDS_BYTES, stream, p);
#else
    for (int k = 0; k < N_PHASES; ++k) { p.ph_lo = k; p.ph_hi = k + 1; hipLaunchKernelGGL(fwd_kernel, dim3(grid), dim3(NTHREADS), LDS_BYTES, stream, p); }
#endif
}
```

```cpp
#include <hip/hip_runtime.h>
#include <cstdio>
#include <cstdint>

#ifndef INPROJ_ALIGN
#define INPROJ_ALIGN true
#endif
#ifndef INPROJ_SP2
#define INPROJ_SP2 true
#endif
#ifndef REP_PRO
#define REP_PRO 1
#endif
#ifndef REP_ROUTE
#define REP_ROUTE 1
#endif
#ifndef REP_NORM
#define REP_NORM 1
#endif
#ifndef REP_INPROJ
#define REP_INPROJ 1
#endif
#ifndef REP_ATT3
#define REP_ATT3 1
#endif
#ifndef REP_CMP
#define REP_CMP 1
#endif
#ifndef REP_SLC
#define REP_SLC 1
#endif
#ifndef REP_SCAT
#define REP_SCAT 1
#endif
#ifndef REP_G1
#define REP_G1 1
#endif
#ifndef N_LAUNCH_MODE
#define N_LAUNCH_MODE 0
#endif

#define LAS __attribute__((address_space(3)))
#define GAS __attribute__((address_space(1)))
typedef unsigned short bf16;
typedef unsigned long long u64;
typedef float f32x4 __attribute__((ext_vector_type(4)));
typedef unsigned u32x4 __attribute__((ext_vector_type(4)));

constexpr int B_ = 8, T_ = 4096, D_ = 1024, NT = B_ * T_, L_ = 2;
constexpr int HD = 64, D_IN = 2844;
constexpr int N_CMP = 255, CMP_HID = 256;
constexpr int NEXP = 32, DEXP = 256;
constexpr float EPS = 1e-6f;
constexpr float LOG2E = 1.4426950408889634f;
constexpr int NWAVES = 8, NTHREADS = 512;

constexpr int C_NSAQ = 0, C_KV6 = 512, C_GATE = 1280, C_FQ = 1304, C_FF = 2072, C_DQ = 2076, C_DV = 2588;

constexpr size_t MiB = 1u << 20;
constexpr size_t WS_CTL = 0, CTL_BYTES = 1 * MiB;
constexpr size_t WS_QN = 1 * MiB;
constexpr size_t WS_KV6 = WS_QN + 32 * MiB;
constexpr size_t KV6_STRIDE = 8 * MiB + 64 * 1024;
constexpr size_t WS_FQKV = WS_KV6 + 6 * KV6_STRIDE;
constexpr size_t WS_DQK = WS_FQKV + 48 * MiB;
constexpr size_t WS_DV = WS_DQK + 32 * MiB;
constexpr size_t WS_GATE = WS_DV + 16 * MiB;
constexpr size_t WS_FL = WS_GATE + 3 * MiB;
constexpr size_t WS_HC = WS_FL + 1 * MiB;
constexpr size_t WS_KVCMP = WS_HC + 4 * MiB;
constexpr size_t WS_SEL = WS_KVCMP + 1 * MiB;
constexpr size_t WS_OCMP = WS_SEL + 1 * MiB;
constexpr size_t WS_OWIN = WS_OCMP + 32 * MiB;
constexpr size_t WS_HN = WS_OWIN + 32 * MiB;
constexpr size_t WS_ATT = WS_HN + 64 * MiB;
constexpr size_t WS_ROUTE = WS_ATT + 64 * MiB;
constexpr size_t WS_WIN_T = WS_ROUTE + 2 * MiB;
constexpr size_t WS_WOUT_T = WS_WIN_T + 12 * MiB;
constexpr size_t WS_WGU_T = WS_WOUT_T + 4 * MiB;
constexpr size_t WS_WD_T = WS_WGU_T + 64 * MiB;
constexpr size_t WS_W1_T = WS_WD_T + 32 * MiB;
constexpr size_t WS_W2_T = WS_W1_T + 4 * MiB;
constexpr size_t WS_BIAS1 = WS_W2_T + 512 * 1024;
constexpr size_t WS_WR = WS_BIAS1 + 512 * 1024;
constexpr size_t WS_B1PART = WS_WR + 512 * 1024;
constexpr size_t WS_END = WS_B1PART + 512 * 1024;
constexpr int MOE_MAXROWS = 61440;
constexpr size_t WS_XS = WS_QN;
constexpr size_t WS_HB = WS_OCMP;
static_assert(WS_XS + (size_t)MOE_MAXROWS * 2048 <= WS_DQK && WS_HB + (size_t)MOE_MAXROWS * 1024 <= WS_HN, "MoE aliases");
constexpr size_t RT_INFO = 0, RT_W = 128 * 1024, RT_ROWTOK = 384 * 1024, RT_ROWW = 640 * 1024, RT_RSTD = 1152 * 1024;
constexpr int CW_QUEUE = 16384, CW_MOECNT = 32768, CW_KN = 49152, MOE_CS = 32, MOE_LS = 8192;
constexpr size_t WS_REC = WS_QN;
constexpr size_t WS_RECC = WS_REC + (size_t)NEXP * 32768 * 16;
constexpr unsigned ZROW_OFF = 512 * 1024;
static_assert(WS_RECC + (size_t)112 * 32768 * 4 <= WS_DQK && WS_HN + (size_t)NT * 2048 < (1ull << 32) && CW_MOECNT + L_ * MOE_LS <= CW_KN && (112 + 2 * NEXP) * MOE_CS <= MOE_LS, "MoE record tables / 32-bit row offsets / counters");
constexpr int TBL_OFF = 131072 + 1024;
constexpr int NIN = 3072;

extern __shared__ __attribute__((aligned(16))) unsigned char lds_raw[];
__device__ __forceinline__ float bf2f(bf16 v) { return __uint_as_float(((unsigned)v) << 16); }
__device__ __forceinline__ unsigned f2bf(float f) { unsigned u = __float_as_uint(f); return (u + 0x7fffu + ((u >> 16) & 1u)) >> 16; }
__device__ __forceinline__ unsigned pk2(float lo, float hi) { return f2bf(lo) | (f2bf(hi) << 16); }
__device__ __forceinline__ float wave_sum(float v) {
#pragma unroll
    for (int o = 1; o < 64; o <<= 1) v += __shfl_xor(v, o);
    return v;
}
__device__ __forceinline__ float wave_max(float v) {
#pragma unroll
    for (int o = 1; o < 64; o <<= 1) v = fmaxf(v, __shfl_xor(v, o));
    return v;
}
__device__ __forceinline__ float shflx_f(float v, int o, int lane) { return __uint_as_float((unsigned)__builtin_amdgcn_ds_bpermute((lane ^ o) << 2, (int)__float_as_uint(v))); }
__device__ __forceinline__ unsigned shflx_u(unsigned v, int o, int lane) { return (unsigned)__builtin_amdgcn_ds_bpermute((lane ^ o) << 2, (int)v); }
__device__ __forceinline__ float wave_sum_l(float v, int lane) {
#pragma unroll
    for (int o = 1; o < 64; o <<= 1) v += shflx_f(v, o, lane);
    return v;
}
__device__ __forceinline__ int launder_s(int v) { asm volatile("" : "+s"(v)); return v; }
__device__ __forceinline__ float sigmoidf_(float x) { return 1.f / (1.f + __expf(-x)); }
__device__ __forceinline__ float log_sigmoidf_(float x) { return x >= 0.f ? -log1pf(__expf(-x)) : x - log1pf(__expf(x)); }
__device__ __forceinline__ float gelu_tanh(float x) { const float u = 0.7978845608028654f * (x + 0.044715f * x * x * x); return 0.5f * x * (1.f + tanhf(u)); }
__device__ __forceinline__ float alibi_slope(int idx1, int n) { return exp2f(-8.0f * (float)idx1 / (float)n); }

__device__ __forceinline__ constexpr int b64_off(int t, int d) { return ((t >> 4) * 2 + (d >> 5)) * 512 + (t & 15) * 32 + (d & 31); }
#define XB_TMO      128
#define XB_XCNT(j)  (256  + 64 * (j))
#define XB_XSUB(j)  (1280 + 64 * (j))
#define XB_XGEN(j)  (2304 + 64 * (j))
#define XB_TOP      3328
#define XB_TOPGEN   3392
#define XCD_BAR_WORDS 3456
#define XB_SPIN_CAP (1u << 25)
__device__ __forceinline__ unsigned xb_ld(unsigned* p)              { return __hip_atomic_load(p, __ATOMIC_RELAXED, __HIP_MEMORY_SCOPE_AGENT); }
__device__ __forceinline__ unsigned xb_add(unsigned* p, unsigned v) { return __hip_atomic_fetch_add(p, v, __ATOMIC_RELAXED, __HIP_MEMORY_SCOPE_AGENT); }
__device__ __forceinline__ unsigned xb_xcc_id() { return (unsigned)__builtin_amdgcn_s_getreg((3 << 11) | 20) & 0xFu; }
#define XB_SPIN(cond, bar) do { unsigned _sp = 0; while (cond) { __builtin_amdgcn_s_sleep(1); \
    if ((++_sp & 255u) == 0u) { if (xb_ld(&(bar)[XB_TMO])) break; if (_sp > XB_SPIN_CAP) { atomicAdd(&(bar)[XB_TMO], 1u); break; } } } } while (0)
struct XcdBarrier { unsigned* bar; unsigned x; volatile LAS unsigned* st; };
__device__ __forceinline__ XcdBarrier xcd_barrier_post(unsigned* bar, volatile LAS unsigned* st) {
    XcdBarrier b; b.bar = bar; b.x = xb_xcc_id(); b.st = st;
    if (threadIdx.x == 0) (void)xb_add(&bar[XB_XCNT(b.x)], 1u);
    return b;
}
__device__ __forceinline__ void xcd_barrier_complete(unsigned* bar, unsigned x, unsigned& nloc, unsigned& nx) {
    const unsigned G = gridDim.x * gridDim.y * gridDim.z;
    unsigned sum, cnt, mine, sp = 0u;
    for (;;) {
        sum = 0u; cnt = 0u; mine = 0u;
#pragma unroll
        for (unsigned j = 0; j < 16; ++j) { const unsigned c = xb_ld(&bar[XB_XCNT(j)]); sum += c; cnt += (c > 0u) ? 1u : 0u; mine = (j == x) ? c : mine; }
        if (sum == G) break;
        __builtin_amdgcn_s_sleep(1);
        if ((++sp & 255u) == 0u) { if (xb_ld(&bar[XB_TMO])) break; if (sp > XB_SPIN_CAP) { atomicAdd(&bar[XB_TMO], 1u); break; } }
    }
    nloc = mine > 0u ? mine : 1u; nx = cnt > 0u ? cnt : 1u;
}
__device__ __forceinline__ void xcd_barrier(const XcdBarrier& b) {
    asm volatile("s_waitcnt vmcnt(0)" ::: "memory");
    __syncthreads();
    if (threadIdx.x == 0) {
        unsigned* bar = b.bar;
        __builtin_amdgcn_s_waitcnt(0);
        unsigned nloc = b.st[0], nx = b.st[1];
        if (nloc == 0u) { xcd_barrier_complete(bar, b.x, nloc, nx); b.st[0] = nloc; b.st[1] = nx; }
        const unsigned old = xb_add(&bar[XB_XSUB(b.x)], 1u);
        const unsigned gen = old / nloc;
        if (old + 1u == (gen + 1u) * nloc) {
            __builtin_amdgcn_fence(__ATOMIC_RELEASE, "agent");
            asm volatile("s_waitcnt vmcnt(0)" ::: "memory");
            const unsigned og = xb_add(&bar[XB_TOP], 1u);
            const unsigned tg = og / nx;
            if (og + 1u == (tg + 1u) * nx) xb_add(&bar[XB_TOPGEN], 1u);
            else XB_SPIN(xb_ld(&bar[XB_TOPGEN]) == tg, bar);
            __builtin_amdgcn_fence(__ATOMIC_ACQUIRE, "agent");
            xb_add(&bar[XB_XGEN(b.x)], 1u);
            asm volatile("s_waitcnt vmcnt(0)" ::: "memory");
        } else {
            XB_SPIN(xb_ld(&bar[XB_XGEN(b.x)]) == gen, bar);
            __builtin_amdgcn_fence(__ATOMIC_ACQUIRE, "agent");
            asm volatile("s_waitcnt vmcnt(0)" ::: "memory");
        }
    }
    __syncthreads();
}

struct Params { const float* in[23]; float* out; unsigned char* ws; int ph_lo, ph_hi; };
constexpr int LDS_BYTES = 147456;
constexpr int MISC_OFF = 131072 + 320;

struct Ctx {
    LAS unsigned char* lds; int tid, lane, wave, bid, G, gw, ngw;
    const float* const* in; float* xcur; unsigned char* ws;
};

namespace pg8 {
#define PG8_LAS __attribute__((address_space(3)))
typedef unsigned short bf16_t;
typedef short bf16x8 __attribute__((ext_vector_type(8)));
typedef float f32x4 __attribute__((ext_vector_type(4)));
typedef unsigned u32x4 __attribute__((ext_vector_type(4)));
constexpr int BM = 256, BK = 64, HALF = 128, HTB = HALF * BK * 2  , STAGE_BYTES = 8 * HTB, NXCD = 8, WGM = 8;

__host__ __device__ __forceinline__ int lds_byte(int r, int c) { const int st = (r >> 4) * 2 + (c >> 5), rr = r & 15, cc = c & 31, ob = rr * 64 + cc * 2; return st * 1024 + (ob ^ (((ob >> 9) & 1) << 5)); }
__host__ __device__ __forceinline__ void stage_rc(int b, int& R, int& C) { const int st = b / 1024, sb = b % 1024, swz = sb ^ (((sb >> 9) & 1) << 5); R = (st >> 1) * 16 + swz / 64; C = (st & 1) * 32 + (swz % 64) / 2; }
__host__ __device__ __forceinline__ int perm32(int rho) { const int n = rho >> 4, i = rho & 15; return 8 * (i >> 2) + 4 * n + (i & 3); }

struct Unit { int pm, pn; const char* a; const char* b; const char* b2; };
struct Gemm { int lda, ldb, K, ksplit, arb, acb; };

__device__ __forceinline__ unsigned cvt_pk_bf16(float lo, float hi) { unsigned r; asm volatile("v_cvt_pk_bf16_f32 %0, %1, %2" : "=v"(r) : "v"(lo), "v"(hi)); return r; }
typedef float f32x2 __attribute__((ext_vector_type(2)));

template <class Epi, class Sched, bool ALIGN_EPI = false, bool SP2 = false, bool GATHER = false>
__device__ __forceinline__ void gemm_phase(PG8_LAS unsigned char* lds, const Gemm g, const Sched& S, const Epi& E) {
    static_assert(!GATHER || SP2, "GATHER is written for the SP2 loop");
    int tid_ = threadIdx.x; asm volatile("" : "+v"(tid_));
    const int tid = tid_, wid = __builtin_amdgcn_readfirstlane(tid >> 6), lane = tid & 63, wr = wid >> 2, wc = wid & 3, fr = lane & 15, fq = lane >> 4;
    const int K = g.K, nt = K / BK, ks = g.ksplit;
    unsigned voffA[2], voffB[2];
#pragma unroll
    for (int i = 0; i < 2; ++i) { int R, C; stage_rc(tid * 16 + i * 8192, R, C); const int Rb = Epi::PERM ? ((R & ~31) + perm32(R & 31)) : R;
        voffA[i] = g.arb ? (unsigned)(((R / g.arb) * (K / g.acb) + C / g.acb) * (g.arb * g.acb) + (R % g.arb) * g.acb + (C % g.acb)) * 2u : (unsigned)(R * g.lda + C) * 2u; voffB[i] = (unsigned)(Rb * g.ldb + C) * 2u; }
    const size_t kstep = (size_t)(BK * 2), kstepA = g.arb ? (size_t)(BK * g.arb * 2) : kstep;
    const size_t hsA = (size_t)HALF * (g.arb ? K : g.lda) * 2, hsB = (size_t)HALF * g.ldb * 2;
    const unsigned ldsw = (unsigned)wid * 1024u;
    const int aoff = lds_byte(wr * 64 + fr, fq * 8), boff = lds_byte(wc * 32 + fr, fq * 8);
#define PG8_SA(b, h) (((b) * 2 + (h)) * HTB)
#define PG8_SB(b, h) ((4 + (b) * 2 + (h)) * HTB)
#define PG8_STAGE(bufoff, gbase, voff) do { _Pragma("unroll") for (int _i = 0; _i < 2; ++_i) \
        __builtin_amdgcn_global_load_lds((const unsigned*)((const char*)(gbase) + (voff)[_i]), (PG8_LAS unsigned*)(lds + (bufoff) + ldsw + _i * 8192), 16, 0, 0); } while (0)
#define PG8_LDA(dst, b, h) do { _Pragma("unroll") for (int m = 0; m < 4; ++m) _Pragma("unroll") for (int k = 0; k < 2; ++k) dst[m][k] = *(const PG8_LAS bf16x8*)(lds + PG8_SA(b, h) + aoff + m * 2048 + k * 1024); } while (0)
#define PG8_LDB(dst, b, h) do { _Pragma("unroll") for (int n = 0; n < 2; ++n) _Pragma("unroll") for (int k = 0; k < 2; ++k) dst[n][k] = *(const PG8_LAS bf16x8*)(lds + PG8_SB(b, h) + boff + n * 2048 + k * 1024); } while (0)
#define PG8_MMA(ai, bj, At, Bt) do { __builtin_amdgcn_s_setprio(1); _Pragma("unroll") for (int m = 0; m < 4; ++m) _Pragma("unroll") for (int n = 0; n < 2; ++n) _Pragma("unroll") for (int k = 0; k < 2; ++k) \
        acc[ai][bj][m][n] = __builtin_amdgcn_mfma_f32_16x16x32_bf16(Bt[n][k], At[m][k], acc[ai][bj][m][n], 0, 0, 0); __builtin_amdgcn_s_setprio(0); } while (0)
#define PG8_WAIT_V(n) asm volatile("s_waitcnt vmcnt(" #n ")" ::: "memory")
#define PG8_WAIT_L(n) asm volatile("s_waitcnt lgkmcnt(" #n ")" ::: "memory")
#define PG8_BAR __builtin_amdgcn_s_barrier()
#define PG8_SCHED __builtin_amdgcn_sched_barrier(0)
    Unit cur, nxt; int ui = 0;
    if (!S.next(0, cur)) return;
    unsigned gC[2][2] = {{0u, 0u}, {0u, 0u}}, gN[2][2] = {{0u, 0u}, {0u, 0u}}; const char* gbase = nullptr;
#define PG8_GOFFS(U, Gv) do { int R_, C_; stage_rc(tid * 16, R_, C_); S.arows4(U, R_, (unsigned)C_ * 2u, Gv); } while (0)
#define PG8_STAGE_G(bufoff, kbyte, Gv, h) do { _Pragma("unroll") for (int _i = 0; _i < 2; ++_i) \
        __builtin_amdgcn_global_load_lds((const unsigned*)(gbase + (size_t)(kbyte) + Gv[h][_i]), (PG8_LAS unsigned*)(lds + (bufoff) + ldsw + _i * 8192), 16, 0, 0); } while (0)
    if constexpr (GATHER) { gbase = S.abase(); PG8_GOFFS(cur, gC); }
    f32x4 acc[2][2][4][2];
#pragma unroll
    for (int a = 0; a < 2; ++a)
#pragma unroll
        for (int b = 0; b < 2; ++b)
#pragma unroll
            for (int m = 0; m < 4; ++m)
#pragma unroll
                for (int n = 0; n < 2; ++n) acc[a][b][m][n] = (f32x4){0.f, 0.f, 0.f, 0.f};
    bf16x8 At[4][2], B0[2][2], B1[2][2];
    const char* cA = cur.a; const char* cB = cur.b; const char* cB2 = cur.b2;
#define PG8_BK(base, base2, kt) ((kt) < ks ? (base) + (size_t)(kt) * kstep : (base2) + (size_t)((kt) - ks) * kstep)
    S.a_ready(cur);
    if constexpr (SP2) {
        PG8_STAGE(PG8_SB(0, 0), cB, voffB); PG8_STAGE(PG8_SB(0, 1), cB + hsB, voffB);
        if constexpr (GATHER) { PG8_STAGE_G(PG8_SA(0, 0), 0, gC, 0); PG8_STAGE_G(PG8_SA(0, 1), 0, gC, 1); } else { PG8_STAGE(PG8_SA(0, 0), cA, voffA); PG8_STAGE(PG8_SA(0, 1), cA + hsA, voffA); }
        if (wr == 1) PG8_BAR;
        PG8_WAIT_V(2); PG8_BAR;
        PG8_STAGE(PG8_SB(1, 0), PG8_BK(cB, cB2, 1), voffB);
        if constexpr (GATHER) PG8_STAGE_G(PG8_SA(1, 0), kstep, gC, 0); else PG8_STAGE(PG8_SA(1, 0), cA + kstepA, voffA);
        PG8_STAGE(PG8_SB(1, 1), PG8_BK(cB, cB2, 1) + hsB, voffB);
        PG8_WAIT_V(6); PG8_BAR;
    } else {
        PG8_STAGE(PG8_SB(0, 0), cB, voffB); PG8_STAGE(PG8_SA(0, 0), cA, voffA); PG8_STAGE(PG8_SB(0, 1), cB + hsB, voffB); PG8_STAGE(PG8_SA(0, 1), cA + hsA, voffA);
        if (wr == 1) PG8_BAR;
        PG8_WAIT_V(4); PG8_BAR;
        PG8_STAGE(PG8_SB(1, 0), PG8_BK(cB, cB2, 1), voffB); PG8_STAGE(PG8_SA(1, 0), cA + kstepA, voffA); PG8_STAGE(PG8_SB(1, 1), PG8_BK(cB, cB2, 1) + hsB, voffB);
        PG8_WAIT_V(6); PG8_BAR;
    }
    for (;;) {
        const bool has_next = S.next(ui + 1, nxt);
        if constexpr (GATHER) { if (has_next) PG8_GOFFS(nxt, gN); else { _Pragma("unroll") for (int _h = 0; _h < 2; ++_h) _Pragma("unroll") for (int _i = 0; _i < 2; ++_i) gN[_h][_i] = gC[_h][_i]; } }
        const char* nA = has_next ? nxt.a : cA; const char* nB = has_next ? nxt.b : cB; const char* nB2 = has_next ? nxt.b2 : cB2;
#pragma unroll 1
        for (int t = 0; t < nt; t += 2) {
            const bool last = (t == nt - 2);
            const char* a1 = cA + (size_t)(t + 1) * kstepA;
            const char* a2 = last ? nA : cA + (size_t)(t + 2) * kstepA; const char* b2 = last ? PG8_BK(nB, nB2, 0) : PG8_BK(cB, cB2, t + 2);
            const char* a3 = a2 + kstepA; const char* b3 = last ? PG8_BK(nB, nB2, 1) : PG8_BK(cB, cB2, t + 3);
            if (last && has_next) S.a_ready(nxt);
            if constexpr (SP2) {
            PG8_LDB(B0, 0, 0); PG8_LDB(B1, 0, 1); PG8_SCHED; PG8_LDA(At, 0, 0);
            if constexpr (GATHER) PG8_STAGE_G(PG8_SA(1, 1), (size_t)(t + 1) * kstep, gC, 1); else PG8_STAGE(PG8_SA(1, 1), a1 + hsA, voffA);
            PG8_WAIT_V(8); PG8_WAIT_L(0); PG8_BAR; PG8_MMA(0, 0, At, B0); PG8_MMA(0, 1, At, B1); PG8_BAR; PG8_SCHED;
            PG8_LDA(At, 0, 1); PG8_STAGE(PG8_SB(0, 0), b2, voffB); PG8_STAGE(PG8_SB(0, 1), b2 + hsB, voffB);
            if constexpr (GATHER) { if (last) PG8_STAGE_G(PG8_SA(0, 0), 0, gN, 0); else PG8_STAGE_G(PG8_SA(0, 0), (size_t)(t + 2) * kstep, gC, 0); } else PG8_STAGE(PG8_SA(0, 0), a2, voffA);
            PG8_WAIT_V(8); PG8_WAIT_L(0); PG8_BAR; PG8_MMA(1, 0, At, B0); PG8_MMA(1, 1, At, B1); PG8_BAR; PG8_SCHED;
            PG8_LDB(B0, 1, 0); PG8_LDB(B1, 1, 1); PG8_SCHED; PG8_LDA(At, 1, 0);
            if constexpr (GATHER) { if (last) PG8_STAGE_G(PG8_SA(0, 1), 0, gN, 1); else PG8_STAGE_G(PG8_SA(0, 1), (size_t)(t + 2) * kstep, gC, 1); } else PG8_STAGE(PG8_SA(0, 1), a2 + hsA, voffA);
            PG8_WAIT_V(8); PG8_WAIT_L(0); PG8_BAR; PG8_MMA(0, 0, At, B0); PG8_MMA(0, 1, At, B1); PG8_BAR; PG8_SCHED;
            PG8_LDA(At, 1, 1); PG8_STAGE(PG8_SB(1, 0), b3, voffB); PG8_STAGE(PG8_SB(1, 1), b3 + hsB, voffB);
            if constexpr (GATHER) { if (last) PG8_STAGE_G(PG8_SA(1, 0), kstep, gN, 0); else PG8_STAGE_G(PG8_SA(1, 0), (size_t)(t + 3) * kstep, gC, 0); } else PG8_STAGE(PG8_SA(1, 0), a3, voffA);
            PG8_WAIT_V(8); PG8_WAIT_L(0); PG8_BAR; PG8_MMA(1, 0, At, B0); PG8_MMA(1, 1, At, B1); PG8_BAR; PG8_SCHED;
            } else {
            PG8_LDB(B0, 0, 0); PG8_SCHED; PG8_LDA(At, 0, 0); PG8_STAGE(PG8_SA(1, 1), a1 + hsA, voffA);
            PG8_WAIT_L(8); PG8_BAR; PG8_WAIT_L(0); PG8_MMA(0, 0, At, B0); PG8_BAR; PG8_SCHED;
            PG8_LDB(B1, 0, 1); PG8_STAGE(PG8_SB(0, 0), b2, voffB);
            PG8_BAR; PG8_WAIT_L(0); PG8_MMA(0, 1, At, B1); PG8_BAR;
            PG8_LDA(At, 0, 1); PG8_STAGE(PG8_SA(0, 0), a2, voffA);
            PG8_BAR; PG8_WAIT_L(0); PG8_MMA(1, 0, At, B0); PG8_BAR; PG8_SCHED;
            PG8_STAGE(PG8_SB(0, 1), b2 + hsB, voffB);
            PG8_WAIT_V(6); PG8_BAR; PG8_MMA(1, 1, At, B1); PG8_BAR;
            PG8_LDB(B0, 1, 0); PG8_SCHED; PG8_LDA(At, 1, 0); PG8_STAGE(PG8_SA(0, 1), a2 + hsA, voffA);
            PG8_WAIT_L(8); PG8_BAR; PG8_WAIT_L(0); PG8_MMA(0, 0, At, B0); PG8_BAR; PG8_SCHED;
            PG8_LDB(B1, 1, 1); PG8_STAGE(PG8_SB(1, 0), b3, voffB);
            PG8_BAR; PG8_WAIT_L(0); PG8_MMA(0, 1, At, B1); PG8_BAR;
            PG8_LDA(At, 1, 1); PG8_STAGE(PG8_SA(1, 0), a3, voffA);
            PG8_BAR; PG8_WAIT_L(0); PG8_MMA(1, 0, At, B0); PG8_BAR; PG8_SCHED;
            PG8_STAGE(PG8_SB(1, 1), b3 + hsB, voffB);
            PG8_WAIT_V(6); PG8_BAR; PG8_MMA(1, 1, At, B1); PG8_BAR;
            }
        }
        if constexpr (ALIGN_EPI) { if (wr == 0) PG8_BAR; }
        if constexpr (!Epi::AFTER_DRAIN) { E(acc, cur, wr, wc, fr, fq); S.done(cur); }
        if (!has_next) break;
#pragma unroll
        for (int a = 0; a < 2; ++a)
#pragma unroll
            for (int b = 0; b < 2; ++b)
#pragma unroll
                for (int m = 0; m < 4; ++m)
#pragma unroll
                    for (int n = 0; n < 2; ++n) acc[a][b][m][n] = (f32x4){0.f, 0.f, 0.f, 0.f};
        cur = nxt; cA = nA; cB = nB; cB2 = nB2; ++ui;
        if constexpr (GATHER) { _Pragma("unroll") for (int _h = 0; _h < 2; ++_h) _Pragma("unroll") for (int _i = 0; _i < 2; ++_i) gC[_h][_i] = gN[_h][_i]; }
        if constexpr (ALIGN_EPI) { if (wr == 1) PG8_BAR; }
    }
    PG8_WAIT_V(0);
    if constexpr (!ALIGN_EPI) { if (wr == 0) PG8_BAR; }
    PG8_BAR;
    if constexpr (Epi::AFTER_DRAIN) { E.fused(acc, cur, wr, wc, fr, fq, lds, wid, lane); S.done(cur); }
#undef PG8_BK
#undef PG8_GOFFS
#undef PG8_STAGE_G
#undef PG8_SA
#undef PG8_SB
#undef PG8_STAGE
#undef PG8_LDA
#undef PG8_LDB
#undef PG8_MMA
#undef PG8_WAIT_V
#undef PG8_WAIT_L
#undef PG8_BAR
#undef PG8_SCHED
}
}

struct PlainOrder {
    const char* A; const char* Bt; int lda, ldb, nM, nN, nwg, G, c;
    __device__ __forceinline__ void init(const void* A_, const void* Bt_, int lda_, int ldb_, int M, int N, int G_, int c_) { A = (const char*)A_; Bt = (const char*)Bt_; lda = lda_; ldb = ldb_; nM = M / 256; nN = N / 256; nwg = nM * nN; G = G_; c = c_; }
    __device__ __forceinline__ bool next(int i, pg8::Unit& u) const {
        const long L = (long)i * G + c; if (L >= nwg) return false;
        int wgid = (int)L; { const int q = nwg / 8, r = nwg % 8, xcd = wgid % 8, off = wgid / 8; wgid = (xcd < r ? xcd * (q + 1) : r * (q + 1) + (xcd - r) * q) + off; }
        const int nig = 8 * nN, gid = wgid / nig, fm = gid * 8, gsz = (nM - fm) < 8 ? (nM - fm) : 8;
        u.pm = fm + ((wgid % nig) % gsz); u.pn = (wgid % nig) / gsz;
        u.a = A + (size_t)u.pm * 256 * lda * 2; u.b = Bt + (size_t)u.pn * 256 * ldb * 2; u.b2 = u.b; return true;
    }
    __device__ __forceinline__ void a_ready(const pg8::Unit&) const {}
    __device__ __forceinline__ void done(const pg8::Unit&) const {}
};
struct EpiInProj {
    static constexpr bool PERM = true, AFTER_DRAIN = false;
    unsigned char* ws; const float* b_gate; const float* b_fgt; unsigned* kn;
    __device__ __forceinline__ void operator()(const pg8::f32x4 (&acc)[2][2][4][2], const pg8::Unit& u, int wr, int wc, int fr, int fq) const {
        { int t_ = threadIdx.x; asm volatile("" : "+v"(t_)); fr = t_ & 15; fq = (t_ >> 4) & 3; }
        const int pn = u.pn, b = (u.pm * 256) / T_, t0 = u.pm * 256 - b * T_ + wr * 64 + fr;
        if (pn == 11) {
            if (wc == 0 && fq < 4) {
                float* gate = (float*)(ws + WS_GATE); float* fl = (float*)(ws + WS_FL);
#pragma unroll
                for (int ai = 0; ai < 2; ++ai)
#pragma unroll
                    for (int m = 0; m < 4; ++m) { const int t = t0 + ai * 128 + m * 16; const size_t n = (size_t)b * T_ + t;
#pragma unroll
                        for (int nn = 0; nn < 2; ++nn)
#pragma unroll
                            for (int e = 0; e < 4; ++e) { const int c = 8 * fq + 4 * nn + e; const float v = acc[ai][0][m][nn][e];
                                if (c < 24) gate[n * 24 + c] = __builtin_amdgcn_rcpf(1.f + __builtin_amdgcn_exp2f(-(v + b_gate[c]) * LOG2E));
                                else if (c < 28) { const float z = v + b_fgt[c - 24];
                                    fl[(size_t)(b * 4 + (c - 24)) * T_ + t] = z < -30.f ? z : -0.6931471805599453f * __builtin_amdgcn_logf(1.f + __builtin_amdgcn_exp2f(-z * LOG2E)); } } }
            }
            return;
        }
        if (pn == 6 || pn == 9) {
            const int lane_ = (fq << 4) | fr;
#pragma unroll
            for (int bj = 0; bj < 2; ++bj)
#pragma unroll
                for (int ai = 0; ai < 2; ++ai) { float mx = 0.f;
#pragma unroll
                    for (int m = 0; m < 4; ++m) { const pg8::f32x4 v0 = acc[ai][bj][m][0], v1 = acc[ai][bj][m][1];
                        float ss = (v0[0] * v0[0] + v0[1] * v0[1]) + (v0[2] * v0[2] + v0[3] * v0[3]) + (v1[0] * v1[0] + v1[1] * v1[1]) + (v1[2] * v1[2] + v1[3] * v1[3]);
                        ss += shflx_f(ss, 16, lane_); ss += shflx_f(ss, 32, lane_); mx = fmaxf(mx, ss); }
#pragma unroll
                    for (int o = 1; o < 16; o <<= 1) mx = fmaxf(mx, shflx_f(mx, o, lane_));
                    if (lane_ == 0) { const int cg = bj * 4 + wc, tile = (u.pm * 256 - b * T_ + ai * 128 + wr * 64) >> 6;
                        unsigned* dst = pn == 6 ? kn + ((b * 4 + (cg >> 1)) * 64 + tile) * 2 + (cg & 1) : kn + 4096 + (b * 8 + cg) * 64 + tile;
                        atomicMax(dst, __float_as_uint(mx)); } }
        }
#pragma unroll
        for (int bj = 0; bj < 2; ++bj) {
            const int c = bj * 128 + wc * 32 + 8 * fq;
            bf16* base; int W = 64; float sc = 1.f;
            if (pn < 2) { base = (bf16*)(ws + WS_QN) + (size_t)(b * 8 + pn * 4 + (c >> 6)) * T_ * 64 + (c & 63); sc = 0.125f * LOG2E; }
            else if (pn < 5) { base = (bf16*)(ws + WS_KV6 + (size_t)((pn - 2) * 2 + (c >> 7)) * KV6_STRIDE) + (size_t)(b * 2 + ((c >> 6) & 1)) * T_ * 64 + (c & 63); }
            else if (pn < 8) { base = (bf16*)(ws + WS_FQKV) + (size_t)(pn - 5) * (8 * MiB) + (size_t)(b * 4 + (c >> 6)) * T_ * 64 + (c & 63); if (pn == 5) sc = 0.125f * LOG2E; }
            else if (pn < 10) { base = (bf16*)(ws + WS_DQK) + (size_t)(pn - 8) * (8 * MiB) + (size_t)(b * 8 + (c >> 5)) * T_ * 32 + (c & 31); W = 32; if (pn == 8) sc = 0.17677669529663687f * LOG2E; }
            else { base = (bf16*)(ws + WS_DV) + (size_t)(b * 4 + (c >> 6)) * T_ * 64 + (c & 63); }
            const bool blk = W == 64 && pn != 2;
            if (blk) base += -(c & 63) + ((c >> 5) & 1) * 512 + (c & 31);
#pragma unroll
            for (int ai = 0; ai < 2; ++ai)
#pragma unroll
                for (int m = 0; m < 4; ++m) { const int t = t0 + ai * 128 + m * 16;
                    const pg8::f32x4 v0 = acc[ai][bj][m][0] * sc, v1 = acc[ai][bj][m][1] * sc;
                    pg8::u32x4 w; w.x = pg8::cvt_pk_bf16(v0[0], v0[1]); w.y = pg8::cvt_pk_bf16(v0[2], v0[3]); w.z = pg8::cvt_pk_bf16(v1[0], v1[1]); w.w = pg8::cvt_pk_bf16(v1[2], v1[3]);
                    *(pg8::u32x4*)(base + (blk ? (size_t)((t >> 4) * 1024 + (t & 15) * 32) : (size_t)t * W)) = w; }
        }
    }
};
__device__ __forceinline__ u32x4 res_add8(u32x4 w, const pg8::f32x4& a0, const pg8::f32x4& a1) {
    u32x4 o;
    o.x = pg8::cvt_pk_bf16(__uint_as_float(w.x << 16) + a0[0], __uint_as_float(w.x & 0xffff0000u) + a0[1]); o.y = pg8::cvt_pk_bf16(__uint_as_float(w.y << 16) + a0[2], __uint_as_float(w.y & 0xffff0000u) + a0[3]);
    o.z = pg8::cvt_pk_bf16(__uint_as_float(w.z << 16) + a1[0], __uint_as_float(w.z & 0xffff0000u) + a1[1]); o.w = pg8::cvt_pk_bf16(__uint_as_float(w.w << 16) + a1[2], __uint_as_float(w.w & 0xffff0000u) + a1[3]);
    return o;
}
struct EpiResBf16 {
    static constexpr bool PERM = true, AFTER_DRAIN = false;
    bf16* xr;
    __device__ __forceinline__ void operator()(const pg8::f32x4 (&acc)[2][2][4][2], const pg8::Unit& u, int wr, int wc, int fr, int fq) const {
        { int t_ = threadIdx.x; asm volatile("" : "+v"(t_)); fr = t_ & 15; fq = (t_ >> 4) & 3; }
#pragma unroll
        for (int ai = 0; ai < 2; ++ai)
#pragma unroll
            for (int m = 0; m < 4; ++m) { const size_t off = (size_t)(u.pm * 256 + ai * 128 + wr * 64 + m * 16 + fr) * D_ + u.pn * 256 + wc * 32 + 8 * fq;
#pragma unroll
                for (int bj = 0; bj < 2; ++bj) { u32x4* q = (u32x4*)(xr + off + bj * 128); *q = res_add8(*q, acc[ai][bj][m][0], acc[ai][bj][m][1]); } }
    }
};


struct EpiDummy {
    static constexpr bool PERM = true, AFTER_DRAIN = false;
    float* dst;
    __device__ __forceinline__ void operator()(const pg8::f32x4 (&acc)[2][2][4][2], const pg8::Unit& u, int wr, int wc, int fr, int fq) const {
        pg8::f32x4 a = {0.f, 0.f, 0.f, 0.f};
#pragma unroll
        for (int ai = 0; ai < 2; ++ai)
#pragma unroll
            for (int bj = 0; bj < 2; ++bj)
#pragma unroll
                for (int m = 0; m < 4; ++m) { a = a + acc[ai][bj][m][0]; a = a + acc[ai][bj][m][1]; }
        *(pg8::f32x4*)(dst + ((size_t)(u.pm * 12 + u.pn) * 512 + threadIdx.x) * 4) = a;
    }
};
struct OneUnitOrder { pg8::Unit u; bool has;
    __device__ __forceinline__ bool next(int i, pg8::Unit& o) const { if (i != 0 || !has) return false; o = u; return true; }
    __device__ __forceinline__ void a_ready(const pg8::Unit&) const {}
    __device__ __forceinline__ void done(const pg8::Unit&) const {} };
__device__ __forceinline__ float gelu_tanh_fast(float x) { const float u2 = 1.5957691216057308f * (x + 0.044715f * x * x * x); return x * __builtin_amdgcn_rcpf(1.f + __builtin_amdgcn_exp2f(-u2 * LOG2E)); }
struct EpiCmpH {
    static constexpr bool PERM = true, AFTER_DRAIN = false;
    bf16* hc; const float* bias1;
    __device__ __forceinline__ void operator()(const pg8::f32x4 (&acc)[2][2][4][2], const pg8::Unit& u, int wr, int wc, int fr, int fq) const {
        { int t_ = threadIdx.x; asm volatile("" : "+v"(t_)); fr = t_ & 15; fq = (t_ >> 4) & 3; }
        const int kv = u.pn;
#pragma unroll
        for (int bj = 0; bj < 2; ++bj) { const int col = bj * 128 + wc * 32 + 8 * fq;
            const pg8::f32x4 b0 = *(const pg8::f32x4*)(bias1 + kv * 256 + col), b1 = *(const pg8::f32x4*)(bias1 + kv * 256 + col + 4);
#pragma unroll
            for (int ai = 0; ai < 2; ++ai)
#pragma unroll
                for (int m = 0; m < 4; ++m) { const int row = u.pm * 256 + ai * 128 + wr * 64 + m * 16 + fr;
                    const pg8::f32x4 v0 = acc[ai][bj][m][0] + b0, v1 = acc[ai][bj][m][1] + b1;
                    pg8::u32x4 w; w.x = pg8::cvt_pk_bf16(gelu_tanh_fast(v0[0]), gelu_tanh_fast(v0[1])); w.y = pg8::cvt_pk_bf16(gelu_tanh_fast(v0[2]), gelu_tanh_fast(v0[3]));
                    w.z = pg8::cvt_pk_bf16(gelu_tanh_fast(v1[0]), gelu_tanh_fast(v1[1])); w.w = pg8::cvt_pk_bf16(gelu_tanh_fast(v1[2]), gelu_tanh_fast(v1[3]));
                    *(pg8::u32x4*)(hc + ((size_t)kv * 4096 + row) * 256 + col) = w; } }
    }
};
struct EpiCmpOut {
    static constexpr bool PERM = true, AFTER_DRAIN = false;
    bf16* kvcmp;
    __device__ __forceinline__ void operator()(const pg8::f32x4 (&acc)[2][2][4][2], const pg8::Unit& u, int wr, int wc, int fr, int fq) const {
        { int t_ = threadIdx.x; asm volatile("" : "+v"(t_)); fr = t_ & 15; fq = (t_ >> 4) & 3; }
        if (wc >= 2) return;
        const int kv = u.pn, col = wc * 32 + 8 * fq;
#pragma unroll
        for (int ai = 0; ai < 2; ++ai)
#pragma unroll
            for (int m = 0; m < 4; ++m) { const int row = u.pm * 256 + ai * 128 + wr * 64 + m * 16 + fr; const float z = ((row & 255) == 255) ? 0.f : 1.f;
                const pg8::f32x4 v0 = acc[ai][0][m][0], v1 = acc[ai][0][m][1];
                pg8::u32x4 w; w.x = pg8::cvt_pk_bf16(z != 0.f ? v0[0] : 0.f, z != 0.f ? v0[1] : 0.f); w.y = pg8::cvt_pk_bf16(z != 0.f ? v0[2] : 0.f, z != 0.f ? v0[3] : 0.f);
                w.z = pg8::cvt_pk_bf16(z != 0.f ? v1[0] : 0.f, z != 0.f ? v1[1] : 0.f); w.w = pg8::cvt_pk_bf16(z != 0.f ? v1[2] : 0.f, z != 0.f ? v1[3] : 0.f);
                *(pg8::u32x4*)(kvcmp + ((size_t)kv * 4096 + row) * 64 + col) = w; }
    }
};

__device__ __forceinline__ void moe_build_tables(const unsigned* cnt, int tid) {
    LAS int* T = (LAS int*)((LAS unsigned char*)lds_raw + TBL_OFF);
    __syncthreads();
    if (tid < 112) T[384 + tid] = (int)cnt[tid * MOE_CS];
    else if (tid >= 128 && tid < 128 + NEXP) T[560 + tid - 128] = (int)cnt[(112 + tid - 128) * MOE_CS];
    __syncthreads();
    if (tid == 0) { int o = 0; _Pragma("clang loop unroll(disable)") for (int c = 0; c < 112; ++c) { T[c] = o; const int n = (T[384 + c] + 255) >> 8;
            _Pragma("clang loop vectorize(disable) unroll(disable)") for (int k = 0; k < n; ++k) T[128 + o + k] = c;
            o += n; } T[112] = o; }
    if (tid == 64) { int o = 0; _Pragma("clang loop unroll(disable)") for (int e = 0; e < NEXP; ++e) { T[512 + e] = o; const int n = (T[560 + e] + 255) >> 8;
            _Pragma("clang loop vectorize(disable) unroll(disable)") for (int k = 0; k < n; ++k) T[608 + o + k] = e;
            o += n; } T[544] = o; }
    __syncthreads();
}
__device__ __forceinline__ void moe_pair(int cls, int& ea, int& eb) { const int grp = cls / 28; int idx = cls % 28, lo = 0; while (idx >= 7 - lo) { idx -= 7 - lo; ++lo; } ea = grp * 8 + lo; eb = grp * 8 + lo + 1 + idx; }
struct MoeOrder1 {
    const char* wsb; const unsigned* rec; const char* wgu; unsigned* edone; int G, c;
    __device__ __forceinline__ bool next(int i, pg8::Unit& u) const {
        const LAS int* T = (const LAS int*)((LAS unsigned char*)lds_raw + TBL_OFF);
        const int idx = i * G + c; if (idx >= 2 * T[544]) return false;
        const int tile = idx >> 1, pn = idx & 1, e = T[608 + tile];
        u.pm = tile; u.pn = pn; u.a = wsb; u.b = wgu + ((size_t)e * 512 + pn * 256) * 2048; u.b2 = u.b; return true; }
    __device__ __forceinline__ const char* abase() const { return wsb; }
    __device__ __forceinline__ void arows4(const pg8::Unit& u, int r0, unsigned cb, unsigned (&g)[2][2]) const {
        const LAS int* T = (const LAS int*)((LAS unsigned char*)lds_raw + TBL_OFF);
        const int e = T[608 + u.pm], base = (u.pm - T[512 + e]) * 256 + r0, n = T[560 + e];
        const unsigned ob = (unsigned)(e * 32768 + base) * 16u;
#pragma unroll
        for (int k = 0; k < 4; ++k) { unsigned off = ZROW_OFF; if (base + 64 * k < n) off = (unsigned)WS_HN + *(const unsigned*)((const char*)rec + (ob + 1024u * k)) * 2048u; g[k >> 1][k & 1] = off + cb; } }
    __device__ __forceinline__ void a_ready(const pg8::Unit&) const {}
    __device__ __forceinline__ void done(const pg8::Unit& u) const {
        asm volatile("s_waitcnt vmcnt(0)" ::: "memory");
        const LAS int* T = (const LAS int*)((LAS unsigned char*)lds_raw + TBL_OFF);
        int t_ = threadIdx.x; asm volatile("" : "+v"(t_));
        if ((t_ & 63) == 0) (void)__hip_atomic_fetch_add(edone + T[608 + u.pm] * MOE_CS, 1u, __ATOMIC_RELAXED, __HIP_MEMORY_SCOPE_AGENT); } };
struct MoeOrder2 {
    const char* hb; const char* wd; const unsigned* edone; unsigned* tmo; int G, c;
    __device__ __forceinline__ bool next(int i, pg8::Unit& u) const {
        const LAS int* T = (const LAS int*)((LAS unsigned char*)lds_raw + TBL_OFF);
        const int n1 = (2 * T[544]) % G, idx = i * G + (c >= n1 ? c - n1 : c - n1 + G); if (idx >= 4 * T[112]) return false;
        const int tile = idx >> 2, pn = idx & 3; int ea, eb; moe_pair(T[128 + tile], ea, eb);
        u.pm = tile; u.pn = pn; u.a = hb + (size_t)tile * 256 * 1024; u.b = wd + ((size_t)ea * 1024 + pn * 256) * 512; u.b2 = wd + ((size_t)eb * 1024 + pn * 256) * 512; return true; }
    __device__ __forceinline__ void a_ready(const pg8::Unit& u) const {
        int t_ = threadIdx.x; asm volatile("" : "+v"(t_));
        if (t_ < 64) {
            const LAS int* T = (const LAS int*)((LAS unsigned char*)lds_raw + TBL_OFF);
            int ea, eb; moe_pair(T[128 + u.pm], ea, eb);
            const unsigned na = 16u * (unsigned)((T[560 + ea] + 255) >> 8), nb = 16u * (unsigned)((T[560 + eb] + 255) >> 8);
            unsigned polls = 0u;
            while ((unsigned)__builtin_amdgcn_readfirstlane(__hip_atomic_load(edone + ea * MOE_CS, __ATOMIC_RELAXED, __HIP_MEMORY_SCOPE_AGENT)) < na ||
                   (unsigned)__builtin_amdgcn_readfirstlane(__hip_atomic_load(edone + eb * MOE_CS, __ATOMIC_RELAXED, __HIP_MEMORY_SCOPE_AGENT)) < nb) {
                if ((++polls & 255u) == 0u) { if (__builtin_amdgcn_readfirstlane(__hip_atomic_load(tmo, __ATOMIC_RELAXED, __HIP_MEMORY_SCOPE_AGENT)) != 0u) break;
                    if (polls > (1u << 22)) { if (t_ == 0) __hip_atomic_store(tmo, 1u, __ATOMIC_RELAXED, __HIP_MEMORY_SCOPE_AGENT); break; } }
                __builtin_amdgcn_s_sleep(2); }
            __builtin_amdgcn_fence(__ATOMIC_ACQUIRE, "agent");
            asm volatile("s_waitcnt vmcnt(0)" ::: "memory");
        }
        asm volatile("" ::: "memory"); __builtin_amdgcn_s_barrier(); asm volatile("" ::: "memory");
    }
    __device__ __forceinline__ void done(const pg8::Unit&) const {} };
struct EpiMoeH {
    static constexpr bool PERM = true, AFTER_DRAIN = false;
    bf16* hb; const u32x4* rec;
    __device__ __forceinline__ void operator()(const pg8::f32x4 (&acc)[2][2][4][2], const pg8::Unit& u, int wr, int wc, int fr, int fq) const {
        { int t_ = threadIdx.x; asm volatile("" : "+v"(t_)); fr = t_ & 15; fq = (t_ >> 4) & 3; }
        const LAS int* T = (const LAS int*)((LAS unsigned char*)lds_raw + TBL_OFF);
        const int ex = T[608 + u.pm], vr0 = (u.pm - T[512 + ex]) * 256, nex = T[560 + ex];
#pragma unroll
        for (int ai = 0; ai < 2; ++ai) {
#pragma unroll
            for (int m = 0; m < 4; ++m) { const int rr = ai * 128 + wr * 64 + m * 16 + fr; const bool valid = vr0 + rr < nex;
                const u32x4 q = *(const u32x4*)((const char*)rec + (unsigned)(ex * 32768 + vr0 + rr) * 16u); const float w = __uint_as_float(q.y), rs = __uint_as_float(q.z);
                const int slot = (int)((q.w >> 15) & 1u); const unsigned row = (unsigned)T[valid ? (q.w >> 16) : 0u] * 256u + (q.w & 0x7fffu);
#pragma unroll
                for (int bj = 0; bj < 2; ++bj) { const int j0 = (u.pn & 1) * 128 + (bj * 128 + wc * 32 + 8 * fq) / 2;
                    pg8::f32x4 v0 = acc[ai][bj][m][0], v1 = acc[ai][bj][m][1];
#pragma unroll
                    for (int e = 0; e < 4; ++e) { v0[e] *= rs; v1[e] *= rs; }
                    const float h0 = v0[0] * __builtin_amdgcn_rcpf(1.f + __builtin_amdgcn_exp2f(-v0[0] * LOG2E)) * v0[1] * w, h1 = v0[2] * __builtin_amdgcn_rcpf(1.f + __builtin_amdgcn_exp2f(-v0[2] * LOG2E)) * v0[3] * w;
                    const float h2 = v1[0] * __builtin_amdgcn_rcpf(1.f + __builtin_amdgcn_exp2f(-v1[0] * LOG2E)) * v1[1] * w, h3 = v1[2] * __builtin_amdgcn_rcpf(1.f + __builtin_amdgcn_exp2f(-v1[2] * LOG2E)) * v1[3] * w;
                    const int jg = slot * 256 + j0;
                    if (valid) __hip_atomic_store((u64*)((char*)hb + (((row >> 4) * 32u + (unsigned)(jg >> 4)) * 256u + (row & 15u) * 16u + (unsigned)(jg & 15)) * 2u), (u64)pg8::cvt_pk_bf16(h0, h1) | ((u64)pg8::cvt_pk_bf16(h2, h3) << 32),
                                                  __ATOMIC_RELAXED, __HIP_MEMORY_SCOPE_AGENT); }
            }
            asm volatile("" ::: "memory"); }
    }
};
struct EpiMoeOut {
    static constexpr bool PERM = true, AFTER_DRAIN = false;
    bf16* x; const unsigned* rec;
    __device__ __forceinline__ void operator()(const pg8::f32x4 (&acc)[2][2][4][2], const pg8::Unit& u, int wr, int wc, int fr, int fq) const {
        { int t_ = threadIdx.x; asm volatile("" : "+v"(t_)); fr = t_ & 15; fq = (t_ >> 4) & 3; }
        bf16* xx = x; const unsigned* rt = rec; asm volatile("" : "+s"(xx), "+s"(rt));
        const LAS int* T = (const LAS int*)((LAS unsigned char*)lds_raw + TBL_OFF);
        const int cls = T[128 + u.pm], vr0 = (u.pm - T[cls]) * 256, ncls = T[384 + cls];
#pragma unroll
        for (int ai = 0; ai < 2; ++ai)
#pragma unroll
            for (int m = 0; m < 4; ++m) { const int rr = ai * 128 + wr * 64 + m * 16 + fr; int tok = -1; if (vr0 + rr < ncls) tok = (int)rt[(size_t)cls * 32768 + vr0 + rr];
                if (tok >= 0) { bf16* xr = xx + (size_t)tok * D_ + u.pn * 256 + wc * 32 + 8 * fq;
#pragma unroll
                    for (int bj = 0; bj < 2; ++bj) { u32x4* q = (u32x4*)(xr + bj * 128); *q = res_add8(*q, acc[ai][bj][m][0], acc[ai][bj][m][1]); } } }
    }
};

__device__ __forceinline__ void transpose_item(const float* W, int ldw, bf16* WT, int ldt, int r0, int rmul, int k0, LAS float* scr, int lane, const float* gk = nullptr) {
    f32x4 v[8];
#pragma unroll
    for (int i = 0; i < 8; ++i) v[i] = *(const f32x4*)(W + (size_t)(k0 + i * 8 + (lane >> 3)) * ldw + (lane & 7) * 4);
    if (gk) {
#pragma unroll
        for (int i = 0; i < 8; ++i) { const float gsc = gk[k0 + i * 8 + (lane >> 3)]; v[i].x *= gsc; v[i].y *= gsc; v[i].z *= gsc; v[i].w *= gsc; } }
#pragma unroll
    for (int i = 0; i < 8; ++i) { LAS float* d = scr + (i * 8 + (lane >> 3)) * 33 + (lane & 7) * 4; d[0] = v[i].x; d[1] = v[i].y; d[2] = v[i].z; d[3] = v[i].w; }
    asm volatile("s_waitcnt lgkmcnt(0)" ::: "memory");
    const int c = lane & 7;
#pragma unroll
    for (int j = 0; j < 4; ++j) { const int n = (lane >> 3) + 8 * j; const LAS float* sp = scr + (8 * c) * 33 + n;
        u32x4 o; o.x = pk2(sp[0 * 33], sp[1 * 33]); o.y = pk2(sp[2 * 33], sp[3 * 33]); o.z = pk2(sp[4 * 33], sp[5 * 33]); o.w = pk2(sp[6 * 33], sp[7 * 33]);
        *(u32x4*)(WT + (size_t)(r0 + rmul * n) * ldt + k0 + 8 * c) = o; }
    asm volatile("s_waitcnt lgkmcnt(0)" ::: "memory");
}
__device__ __forceinline__ void transpose_seg(const float* W, int ldw, int K, int sc0, int ncol, bf16* WT, int r0, int rmul, int item, LAS float* scr, int lane, const float* gk = nullptr) {
    const int nb = ncol / 32, kb = item / nb, cb = item % nb;
    transpose_item(W + sc0 + cb * 32, ldw, WT, K, r0 + rmul * cb * 32, rmul, kb * 64, scr, lane, gk);
}

typedef float f32x16 __attribute__((ext_vector_type(16)));
typedef short bf16x8v __attribute__((ext_vector_type(8)));
typedef short s16x4 __attribute__((ext_vector_type(4)));
typedef float f32x2_t __attribute__((ext_vector_type(2)));
typedef __bf16 bf16x2_t __attribute__((ext_vector_type(2)));
constexpr int A_KBUF = 10240, A_VBUF = 12288;
constexpr int A_KOFF = 0, A_VOFF = 2 * A_KBUF, A_BOFF = A_VOFF + 2 * A_VBUF, A_LDS_END = A_BOFF + 2 * 256;
__device__ __forceinline__ constexpr int crow0(int reg) { return (reg & 3) + 8 * (reg >> 2); }
__device__ __forceinline__ float swap_max(float m) { auto rr = __builtin_amdgcn_permlane32_swap(__float_as_uint(m), __float_as_uint(m), false, false); return fmaxf(__uint_as_float(rr[0]), __uint_as_float(rr[1])); }
__device__ __forceinline__ float swap_sum(float m) { auto rr = __builtin_amdgcn_permlane32_swap(__float_as_uint(m), __float_as_uint(m), false, false); return __uint_as_float(rr[0]) + __uint_as_float(rr[1]); }
__device__ __forceinline__ unsigned cvtpk(float lo, float hi) { f32x2_t v = {lo, hi}; bf16x2_t b = __builtin_convertvector(v, bf16x2_t); return __builtin_bit_cast(unsigned, b); }
__device__ __forceinline__ bf16x8v pack8(const f32x16& p, int b0) { u32x4 w; w.x = cvtpk(p[b0 + 0], p[b0 + 1]); w.y = cvtpk(p[b0 + 2], p[b0 + 3]); w.z = cvtpk(p[b0 + 4], p[b0 + 5]); w.w = cvtpk(p[b0 + 6], p[b0 + 7]); return __builtin_bit_cast(bf16x8v, w); }
__device__ __forceinline__ s16x4 tr_read(const LAS unsigned char* p) { typedef short v4i16_t __attribute__((ext_vector_type(4))); return __builtin_bit_cast(s16x4, __builtin_amdgcn_ds_read_tr16_b64_v4i16((LAS v4i16_t*)p)); }

template <int DQK>
__device__ __forceinline__ void attn_preload(const bf16* Kb0, const bf16* Kb1, const bf16* Vb, int j, int tid, u32x4& kreg, u32x4& vreg) {
    const bf16* ksrc;
    if (DQK == 64) ksrc = Kb0 + b64_off(tid >> 3, (tid & 7) * 8); else { const int mp = tid >> 8, tt = tid & 255; ksrc = (mp ? Kb1 : Kb0) + (tt >> 2) * 32 + (tt & 3) * 8; }
    const bf16* vsrc = Vb + b64_off(tid >> 3, (tid & 7) * 8);
    kreg = *(const u32x4*)(ksrc + (size_t)(j * 64) * DQK); vreg = *(const u32x4*)(vsrc + (size_t)(j * 64) * 64);
}
template <int DQK, int NMAP, bool FOX, bool SLC, bool PRE = false>
__device__ __forceinline__ void attn_core(LAS unsigned char* L, const bf16* Kb0, const bf16* Kb1, const bf16* Vb, const LAS float* cum, float cum_ref,
                                          const bf16x8v (&Qf)[NMAP][DQK / 16], u64 tilemask, int t_lane, int tw0, int win, float slope2, unsigned selw0, unsigned selw1,
                                          f32x16 (&O)[NMAP][2], float (&M)[NMAP], float (&Ls)[NMAP], int tid, bool started0 = false, int jpre = 0, u32x4 kpre = (u32x4){0u, 0u, 0u, 0u}, u32x4 vpre = (u32x4){0u, 0u, 0u, 0u}) {
    constexpr int KP = DQK * 2 + 16, VP = 192;
    const int lane = tid & 63, r = lane & 31, h = lane >> 5;
    int kdst; const bf16* ksrc;
    if (DQK == 64) { kdst = (tid >> 3) * KP + (tid & 7) * 16; ksrc = Kb0 + b64_off(tid >> 3, (tid & 7) * 8); }
    else { const int mp = tid >> 8, tt = tid & 255; kdst = mp * 5120 + (tt >> 2) * KP + (tt & 3) * 16; ksrc = (mp ? Kb1 : Kb0) + (tt >> 2) * 32 + (tt & 3) * 8; }
    const int vdst = (tid >> 3) * VP + (tid & 7) * 16; const bf16* vsrc = Vb + b64_off(tid >> 3, (tid & 7) * 8);
    const LAS unsigned char* kfrag = L + A_KOFF + r * KP + h * 16;
    const LAS unsigned char* vfrag = L + A_VOFF + (4 * h + ((lane & 15) >> 2)) * VP + (16 * ((lane >> 4) & 1) + 4 * (lane & 3)) * 2;
    u32x4 kreg, vreg; float breg = 0.f;
    u64 mk = tilemask;
    int j = PRE ? jpre : 63 - __builtin_clzll(mk); mk &= ~(1ull << j);
    { const int kv0 = j * 64; if (PRE) { kreg = kpre; vreg = vpre; } else { kreg = *(const u32x4*)(ksrc + (size_t)kv0 * DQK); vreg = *(const u32x4*)(vsrc + (size_t)kv0 * 64); } if (FOX && tid < 64) breg = (cum_ref - cum[kv0 + tid]) * LOG2E; }
    *(LAS u32x4*)(L + A_KOFF + kdst) = kreg; *(LAS u32x4*)(L + A_VOFF + vdst) = vreg; if (FOX && tid < 64) *(LAS float*)(L + A_BOFF + tid * 4) = breg;
    __syncthreads();
    int buf = 0; bool started = started0;
    float pdummy = 0.f; int idummy = 0; f32x16 dm0; for (int i = 0; i < 16; ++i) dm0[i] = 0.f;
    for (;;) {
        const bool more = mk != 0ull; int jn = 0;
        if (more) { jn = 63 - __builtin_clzll(mk); mk &= ~(1ull << jn); const int kv0 = jn * 64;
            kreg = *(const u32x4*)(ksrc + (size_t)kv0 * DQK); vreg = *(const u32x4*)(vsrc + (size_t)kv0 * 64); if (FOX && tid < 64) breg = (cum_ref - cum[kv0 + tid]) * LOG2E; }
        { const int kv0 = j * 64;
          bool wave_has = true; float selb = 0.f;
          if (SLC) { const bool mine = ((j < 32 ? (selw0 >> j) : (selw1 >> (j - 32))) & 1u) != 0u; selb = mine ? 0.f : -INFINITY; wave_has = __any(mine); }
          if (wave_has && !(kv0 > tw0 + 31) && !(tw0 - (kv0 + 63) >= win)) {
            const bool need_mask = (kv0 + 63 > tw0) || (tw0 + 31 - kv0 >= win);
            const int dl = t_lane - kv0 - 4 * h;
            bf16x8v pa[NMAP][4];
#pragma unroll
            for (int mp = 0; mp < NMAP; ++mp) {
                f32x16 p0, p1;
                if (FOX) { const LAS f32x4* bl = (const LAS f32x4*)(L + A_BOFF + buf * 256) + h; const float mm = M[mp];
#pragma unroll
                    for (int g4 = 0; g4 < 4; ++g4) { const f32x4 b0 = bl[2 * g4], b1 = bl[8 + 2 * g4];
                        p0[4 * g4 + 0] = b0.x - mm; p0[4 * g4 + 1] = b0.y - mm; p0[4 * g4 + 2] = b0.z - mm; p0[4 * g4 + 3] = b0.w - mm; p1[4 * g4 + 0] = b1.x - mm; p1[4 * g4 + 1] = b1.y - mm; p1[4 * g4 + 2] = b1.z - mm; p1[4 * g4 + 3] = b1.w - mm; } }
                else { const float base_l = (slope2 * (float)(kv0 + 4 * h - tw0) - M[mp]) + selb, s8 = slope2 * 8.f, s32 = slope2 * 32.f;
                    p0[0] = base_l; p0[1] = p0[0] + slope2; p0[2] = p0[1] + slope2; p0[3] = p0[2] + slope2;
#pragma unroll
                    for (int reg = 4; reg < 16; ++reg) p0[reg] = p0[reg - 4] + s8;
#pragma unroll
                    for (int reg = 0; reg < 16; ++reg) p1[reg] = p0[reg] + s32; }
                const LAS unsigned char* kb = kfrag + buf * A_KBUF + (DQK == 32 ? mp * 5120 : 0);
#pragma unroll
                for (int s = 0; s < DQK / 16; ++s) { const bf16x8v kf0 = *(const LAS bf16x8v*)(kb + s * 32), kf1 = *(const LAS bf16x8v*)(kb + 32 * KP + s * 32);
#ifdef PROBE_X_LDSK
                    { const bf16x8v z0 = *(const volatile LAS bf16x8v*)(kb + s * 32), z1 = *(const volatile LAS bf16x8v*)(kb + 32 * KP + s * 32); idummy ^= z0[0] ^ z1[1]; }
#endif
#ifdef PROBE_X_MFMA
                    dm0 = __builtin_amdgcn_mfma_f32_32x32x16_bf16(kf0, Qf[mp][s], dm0, 0, 0, 0); dm0 = __builtin_amdgcn_mfma_f32_32x32x16_bf16(kf1, Qf[mp][s], dm0, 0, 0, 0);
#endif
                    p0 = __builtin_amdgcn_mfma_f32_32x32x16_bf16(kf0, Qf[mp][s], p0, 0, 0, 0); p1 = __builtin_amdgcn_mfma_f32_32x32x16_bf16(kf1, Qf[mp][s], p1, 0, 0, 0); }
                if (need_mask) {
#pragma unroll
                    for (int reg = 0; reg < 16; ++reg) { const int d0 = dl - crow0(reg), d1 = d0 - 32;
                        p0[reg] = (d0 >= 0 && d0 < win) ? p0[reg] : -INFINITY; p1[reg] = (d1 >= 0 && d1 < win) ? p1[reg] : -INFINITY; } }
                float mt = fmaxf(fmaxf(p0[0], p1[0]), fmaxf(p0[1], p1[1]));
#pragma unroll
                for (int reg = 2; reg < 16; reg += 2) mt = fmaxf(fmaxf(mt, fmaxf(fmaxf(p0[reg], p1[reg]), p0[reg + 1])), p1[reg + 1]);
                mt = swap_max(mt);
                if (!started || __any(mt > 8.f)) {
                    const float d = (mt > -1e30f) ? (started ? fmaxf(mt, 0.f) : mt) : 0.f, alpha = __builtin_amdgcn_exp2f(-d);
                    O[mp][0] *= alpha; O[mp][1] *= alpha; Ls[mp] *= alpha; M[mp] += d;
#pragma unroll
                    for (int reg = 0; reg < 16; ++reg) { p0[reg] -= d; p1[reg] -= d; } }
                float rs = 0.f;
#ifdef PROBE_X_EXP
#pragma unroll
                for (int reg = 0; reg < 16; ++reg) { pdummy += __builtin_amdgcn_exp2f(p0[reg] - 1.f) + __builtin_amdgcn_exp2f(p1[reg] - 1.f); }
#endif
#pragma unroll
                for (int reg = 0; reg < 16; ++reg) { p0[reg] = __builtin_amdgcn_exp2f(p0[reg]); p1[reg] = __builtin_amdgcn_exp2f(p1[reg]); rs += p0[reg] + p1[reg]; }
                Ls[mp] += rs;
                pa[mp][0] = pack8(p0, 0); pa[mp][1] = pack8(p0, 8); pa[mp][2] = pack8(p1, 0); pa[mp][3] = pack8(p1, 8);
            }
            started = true;
            const LAS unsigned char* vb = vfrag + buf * A_VBUF;
#pragma unroll
            for (int db = 0; db < 2; ++db)
#pragma unroll
                for (int ks = 0; ks < 4; ++ks) { const s16x4 lo = tr_read(vb + ks * (16 * VP) + db * 64), hi = tr_read(vb + ks * (16 * VP) + db * 64 + 8 * VP);
                    const bf16x8v vf = {lo[0], lo[1], lo[2], lo[3], hi[0], hi[1], hi[2], hi[3]};
#pragma unroll
                    for (int mp = 0; mp < NMAP; ++mp) O[mp][db] = __builtin_amdgcn_mfma_f32_32x32x16_bf16(vf, pa[mp][ks], O[mp][db], 0, 0, 0); }
          } }
        if (more) { *(LAS u32x4*)(L + A_KOFF + (buf ^ 1) * A_KBUF + kdst) = kreg; *(LAS u32x4*)(L + A_VOFF + (buf ^ 1) * A_VBUF + vdst) = vreg; if (FOX && tid < 64) *(LAS float*)(L + A_BOFF + (buf ^ 1) * 256 + tid * 4) = breg; }
#ifdef PROBE_X_BAR
        __syncthreads();
#endif
        __syncthreads();
        if (!more) break;
        j = jn; buf ^= 1;
    }
    if (pdummy == 123.456f || idummy == 0x7fffabcd || dm0[3] == 98765.4321f) Ls[0] += 1e-30f;
}
#ifndef AC2_MODE
#define AC2_MODE 0
#endif
#ifndef AC2_INIT_VALU
#define AC2_INIT_VALU 24
#endif
template <bool FOX, bool SLC>
__device__ __forceinline__ void attn_core2(LAS unsigned char* L, const bf16* Kb0, const bf16* Vb, const LAS float* cum, float cum_ref,
                                           const bf16x8v (&Qf)[4], u64 tilemask, int t_lane, int tw0, int win, float slope2, unsigned selw0, unsigned selw1,
                                           f32x16 (&O)[2], float& M, float& Ls, int tid) {
    constexpr int KP = 144, VP = 192;
    const int lane = tid & 63, r = lane & 31, h = lane >> 5;
    const int kdst = (tid >> 3) * KP + (tid & 7) * 16; const bf16* ksrc = Kb0 + b64_off(tid >> 3, (tid & 7) * 8);
    const int vdst = (tid >> 3) * VP + (tid & 7) * 16; const bf16* vsrc = Vb + b64_off(tid >> 3, (tid & 7) * 8);
    const LAS unsigned char* kfrag = L + A_KOFF + r * KP + h * 16;
    const LAS unsigned char* vfrag = L + A_VOFF + (4 * h + ((lane & 15) >> 2)) * VP + (16 * ((lane >> 4) & 1) + 4 * (lane & 3)) * 2;
#define AC2_ACTIVE(jj) (!((jj) * 64 > tw0 + 31) && !(tw0 - ((jj) * 64 + 63) >= win))
#define AC2_INIT(jj, kslot, q0, q1) do { const int kv0_ = (jj) * 64; \
        if (FOX) { const LAS f32x4* bl = (const LAS f32x4*)(L + A_BOFF + (kslot) * 256) + h; const float mm = M; \
            _Pragma("unroll") for (int g4 = 0; g4 < 4; ++g4) { const f32x4 b0 = bl[2 * g4], b1 = bl[8 + 2 * g4]; \
                q0[4 * g4 + 0] = b0.x - mm; q0[4 * g4 + 1] = b0.y - mm; q0[4 * g4 + 2] = b0.z - mm; q0[4 * g4 + 3] = b0.w - mm; q1[4 * g4 + 0] = b1.x - mm; q1[4 * g4 + 1] = b1.y - mm; q1[4 * g4 + 2] = b1.z - mm; q1[4 * g4 + 3] = b1.w - mm; } } \
        else { float selb = 0.f; if (SLC) selb = ((((jj) < 32) ? (selw0 >> (jj)) : (selw1 >> ((jj) - 32))) & 1u) ? 0.f : -INFINITY; \
            const float base_l = (slope2 * (float)(kv0_ + 4 * h - tw0) - M) + selb, s8 = slope2 * 8.f, s32 = slope2 * 32.f; \
            q0[0] = base_l; q0[1] = q0[0] + slope2; q0[2] = q0[1] + slope2; q0[3] = q0[2] + slope2; \
            _Pragma("unroll") for (int reg = 4; reg < 16; ++reg) q0[reg] = q0[reg - 4] + s8; \
            _Pragma("unroll") for (int reg = 0; reg < 16; ++reg) q1[reg] = q0[reg] + s32; } } while (0)
#define AC2_QK(jj, kslot) do { AC2_INIT(jj, kslot, p0, p1); \
        const LAS unsigned char* kb_ = kfrag + (kslot) * A_KBUF; \
        _Pragma("unroll") for (int s_ = 0; s_ < 4; ++s_) { const bf16x8v kf0 = *(const LAS bf16x8v*)(kb_ + s_ * 32), kf1 = *(const LAS bf16x8v*)(kb_ + 32 * KP + s_ * 32); \
            p0 = __builtin_amdgcn_mfma_f32_32x32x16_bf16(kf0, Qf[s_], p0, 0, 0, 0); p1 = __builtin_amdgcn_mfma_f32_32x32x16_bf16(kf1, Qf[s_], p1, 0, 0, 0); } } while (0)
    u32x4 kreg, vreg; float breg = 0.f;
    u64 mk = tilemask;
    int j = 63 - __builtin_clzll(mk); mk &= ~(1ull << j);
    int jn = -1; if (mk) { jn = 63 - __builtin_clzll(mk); mk &= ~(1ull << jn); }
    { kreg = *(const u32x4*)(ksrc + (size_t)j * 64 * 64); vreg = *(const u32x4*)(vsrc + (size_t)j * 64 * 64); if (FOX && tid < 64) breg = (cum_ref - cum[j * 64 + tid]) * LOG2E;
      *(LAS u32x4*)(L + A_KOFF + kdst) = kreg; *(LAS u32x4*)(L + A_VOFF + vdst) = vreg; if (FOX && tid < 64) *(LAS float*)(L + A_BOFF + tid * 4) = breg;
      if (jn >= 0) { kreg = *(const u32x4*)(ksrc + (size_t)jn * 64 * 64); if (FOX && tid < 64) breg = (cum_ref - cum[jn * 64 + tid]) * LOG2E;
          *(LAS u32x4*)(L + A_KOFF + A_KBUF + kdst) = kreg; if (FOX && tid < 64) *(LAS float*)(L + A_BOFF + 256 + tid * 4) = breg; } }
    __syncthreads();
    f32x16 p0, p1;
    bool started = false;
    int ks = 0, vs = 0;
    if (AC2_ACTIVE(j)) AC2_QK(j, 0);
    for (;;) {
        int jnn = -1; if (mk) { jnn = 63 - __builtin_clzll(mk); mk &= ~(1ull << jnn); }
        if (jnn >= 0) { kreg = *(const u32x4*)(ksrc + (size_t)jnn * 64 * 64); if (FOX && tid < 64) breg = (cum_ref - cum[jnn * 64 + tid]) * LOG2E; }
        if (jn >= 0) vreg = *(const u32x4*)(vsrc + (size_t)jn * 64 * 64);
        const bool act = AC2_ACTIVE(j), actn = jn >= 0 && AC2_ACTIVE(jn);
        if (act) {
            const int kv0 = j * 64;
            if ((kv0 + 63 > tw0) || (tw0 + 31 - kv0 >= win)) { const int dl = t_lane - kv0 - 4 * h;
#pragma unroll
                for (int reg = 0; reg < 16; ++reg) { const int d0 = dl - crow0(reg), d1 = d0 - 32;
                    p0[reg] = (d0 >= 0 && d0 < win) ? p0[reg] : -INFINITY; p1[reg] = (d1 >= 0 && d1 < win) ? p1[reg] : -INFINITY; } }
            float mt = fmaxf(fmaxf(p0[0], p1[0]), fmaxf(p0[1], p1[1]));
#pragma unroll
            for (int reg = 2; reg < 16; reg += 2) mt = fmaxf(fmaxf(mt, fmaxf(fmaxf(p0[reg], p1[reg]), p0[reg + 1])), p1[reg + 1]);
            mt = swap_max(mt);
            if (!started || __any(mt > 8.f)) {
                const float d = (mt > -1e30f) ? (started ? fmaxf(mt, 0.f) : mt) : 0.f, alpha = __builtin_amdgcn_exp2f(-d);
                O[0] *= alpha; O[1] *= alpha; Ls *= alpha; M += d;
#pragma unroll
                for (int reg = 0; reg < 16; ++reg) { p0[reg] -= d; p1[reg] -= d; } }
            started = true;
#if AC2_MODE == 1
            {
                const int jq = jn >= 0 ? jn : 0;
                float rs = 0.f;
#pragma unroll
                for (int reg = 0; reg < 16; ++reg) { p0[reg] = __builtin_amdgcn_exp2f(p0[reg]); p1[reg] = __builtin_amdgcn_exp2f(p1[reg]); rs += p0[reg] + p1[reg]; }
                Ls += rs;
                const bf16x8v pa0 = pack8(p0, 0), pa1 = pack8(p0, 8), pa2 = pack8(p1, 0), pa3 = pack8(p1, 8);
                AC2_QK(jq, ks ^ 1);
                const LAS unsigned char* vb = vfrag + vs * A_VBUF;
#pragma unroll
                for (int db = 0; db < 2; ++db)
#pragma unroll
                    for (int kq = 0; kq < 4; ++kq) { const s16x4 lo = tr_read(vb + kq * (16 * VP) + db * 64), hi = tr_read(vb + kq * (16 * VP) + db * 64 + 8 * VP);
                        const bf16x8v vf = {lo[0], lo[1], lo[2], lo[3], hi[0], hi[1], hi[2], hi[3]};
                        O[db] = __builtin_amdgcn_mfma_f32_32x32x16_bf16(vf, kq == 0 ? pa0 : kq == 1 ? pa1 : kq == 2 ? pa2 : pa3, O[db], 0, 0, 0); }
            }
#else
            {
                const int jq = jn >= 0 ? jn : 0;
                f32x16 n0, n1;
                AC2_INIT(jq, ks ^ 1, n0, n1);
                const LAS unsigned char* kb_ = kfrag + (ks ^ 1) * A_KBUF;
                bf16x8v kf[8];
#pragma unroll
                for (int s_ = 0; s_ < 4; ++s_) { kf[2 * s_] = *(const LAS bf16x8v*)(kb_ + s_ * 32); kf[2 * s_ + 1] = *(const LAS bf16x8v*)(kb_ + 32 * KP + s_ * 32); }
                const LAS unsigned char* vb = vfrag + vs * A_VBUF;
                __builtin_amdgcn_sched_barrier(0);
                float ra = 0.f, rb = 0.f; unsigned w[16];
#define AC2_PINF(x) asm volatile("" : "+v"(x))
#define AC2_QGAP(i) do { if ((i) & 1) n1 = __builtin_amdgcn_mfma_f32_32x32x16_bf16(kf[i], Qf[(i) >> 1], n1, 0, 0, 0); else n0 = __builtin_amdgcn_mfma_f32_32x32x16_bf16(kf[i], Qf[(i) >> 1], n0, 0, 0, 0); \
                    float e0 = __builtin_amdgcn_exp2f(p0[2 * (i)]), e1 = __builtin_amdgcn_exp2f(p0[2 * (i) + 1]), e2 = __builtin_amdgcn_exp2f(p1[2 * (i)]), e3 = __builtin_amdgcn_exp2f(p1[2 * (i) + 1]); \
                    ra += e0 + e1; rb += e2 + e3; \
                    AC2_PINF(e0); AC2_PINF(e1); AC2_PINF(e2); AC2_PINF(e3); AC2_PINF(ra); AC2_PINF(rb); \
                    p0[2 * (i)] = e0; p0[2 * (i) + 1] = e1; p1[2 * (i)] = e2; p1[2 * (i) + 1] = e3; \
                    if ((i) >= 4) { w[2 * ((i) - 4)] = cvtpk(p0[4 * ((i) - 4)], p0[4 * ((i) - 4) + 1]); w[2 * ((i) - 4) + 1] = cvtpk(p0[4 * ((i) - 4) + 2], p0[4 * ((i) - 4) + 3]); AC2_PINF(w[2 * ((i) - 4)]); AC2_PINF(w[2 * ((i) - 4) + 1]); } \
                    if ((i) == 6) { vl[0] = tr_read(vb); vh[0] = tr_read(vb + 8 * VP); } \
                    if ((i) == 7) { vl[1] = tr_read(vb + 64); vh[1] = tr_read(vb + 64 + 8 * VP); } \
                    __builtin_amdgcn_sched_barrier(0); } while (0)
                s16x4 vl[2], vh[2];
                AC2_QGAP(0); AC2_QGAP(1); AC2_QGAP(2); AC2_QGAP(3); AC2_QGAP(4); AC2_QGAP(5); AC2_QGAP(6); AC2_QGAP(7);
                Ls += ra + rb;
#define AC2_PA(kq) __builtin_bit_cast(bf16x8v, (u32x4){w[4 * (kq)], w[4 * (kq) + 1], w[4 * (kq) + 2], w[4 * (kq) + 3]})
#define AC2_PGAP(g) do { const int kq_ = (g) >> 1, db_ = (g) & 1; const bf16x8v vf = {vl[(g) & 1][0], vl[(g) & 1][1], vl[(g) & 1][2], vl[(g) & 1][3], vh[(g) & 1][0], vh[(g) & 1][1], vh[(g) & 1][2], vh[(g) & 1][3]}; \
                    if ((g) < 6) { const int kq2 = ((g) + 2) >> 1, db2 = (g) & 1; vl[(g) & 1] = tr_read(vb + kq2 * (16 * VP) + db2 * 64); vh[(g) & 1] = tr_read(vb + kq2 * (16 * VP) + db2 * 64 + 8 * VP); } \
                    O[db_] = __builtin_amdgcn_mfma_f32_32x32x16_bf16(vf, AC2_PA(kq_), O[db_], 0, 0, 0); \
                    if ((g) < 4) { w[8 + 2 * (g)] = cvtpk(p1[4 * (g)], p1[4 * (g) + 1]); w[8 + 2 * (g) + 1] = cvtpk(p1[4 * (g) + 2], p1[4 * (g) + 3]); AC2_PINF(w[8 + 2 * (g)]); AC2_PINF(w[8 + 2 * (g) + 1]); } \
                    __builtin_amdgcn_sched_barrier(0); } while (0)
                AC2_PGAP(0); AC2_PGAP(1); AC2_PGAP(2); AC2_PGAP(3); AC2_PGAP(4); AC2_PGAP(5); AC2_PGAP(6); AC2_PGAP(7);
#undef AC2_PGAP
#undef AC2_PA
#undef AC2_QGAP
#undef AC2_PINF
                p0 = n0; p1 = n1;
            }
#endif
        } else if (actn) AC2_QK(jn, ks ^ 1);
        if (jnn >= 0) { *(LAS u32x4*)(L + A_KOFF + ks * A_KBUF + kdst) = kreg; if (FOX && tid < 64) *(LAS float*)(L + A_BOFF + ks * 256 + tid * 4) = breg; }
        if (jn >= 0) *(LAS u32x4*)(L + A_VOFF + (vs ^ 1) * A_VBUF + vdst) = vreg;
        __syncthreads();
        if (jn < 0) break;
        j = jn; jn = jnn; ks ^= 1; vs ^= 1;
    }
#undef AC2_QK
#undef AC2_INIT
#undef AC2_ACTIVE
}
__device__ __forceinline__ size_t mix_off(size_t n, int c, int W) { return ((n >> 5) * (size_t)(W / 8) + (size_t)(c >> 3)) * 256 + (n & 31) * 8 + (c & 7); }
#define ATTN_FOR_CHUNKS(db, g4) _Pragma("unroll") for (int db = 0; db < 2; ++db) _Pragma("unroll") for (int g4 = 0; g4 < 4; ++g4)

__device__ __forceinline__ void unpack8(const u32x4 w, float (&f)[8]) { f[0] = __uint_as_float(w.x << 16); f[1] = __uint_as_float(w.x & 0xffff0000u); f[2] = __uint_as_float(w.y << 16); f[3] = __uint_as_float(w.y & 0xffff0000u);
    f[4] = __uint_as_float(w.z << 16); f[5] = __uint_as_float(w.z & 0xffff0000u); f[6] = __uint_as_float(w.w << 16); f[7] = __uint_as_float(w.w & 0xffff0000u); }
__device__ __forceinline__ void ph_norm_bf16_from_bf16(const Ctx& c, const bf16* x, const float* g, bf16* out) {
    constexpr int RB = 4; float gg[2][8];
#pragma unroll
    for (int j = 0; j < 2; ++j) { const f32x4 a = ((const f32x4*)g)[2 * c.lane + 128 * j], b2 = ((const f32x4*)g)[2 * c.lane + 128 * j + 1]; gg[j][0] = a.x; gg[j][1] = a.y; gg[j][2] = a.z; gg[j][3] = a.w; gg[j][4] = b2.x; gg[j][5] = b2.y; gg[j][6] = b2.z; gg[j][7] = b2.w; }
    for (int row0 = c.gw * RB; row0 < NT; row0 += c.ngw * RB) {
        u32x4 v[RB][2];
#pragma unroll
        for (int q = 0; q < RB; ++q)
#pragma unroll
            for (int j = 0; j < 2; ++j) v[q][j] = ((const u32x4*)(x + (size_t)(row0 + q) * D_))[c.lane + 64 * j];
#pragma unroll
        for (int q = 0; q < RB; ++q) { float f[2][8]; float ss = 0.f;
#pragma unroll
            for (int j = 0; j < 2; ++j) { unpack8(v[q][j], f[j]);
#pragma unroll
                for (int e = 0; e < 8; ++e) ss = fmaf(f[j][e], f[j][e], ss); }
            const float r = rsqrtf(wave_sum_l(ss, c.lane) * (1.f / D_) + EPS);
#pragma unroll
            for (int j = 0; j < 2; ++j) { u32x4 o; o.x = pk2(f[j][0] * r * gg[j][0], f[j][1] * r * gg[j][1]); o.y = pk2(f[j][2] * r * gg[j][2], f[j][3] * r * gg[j][3]); o.z = pk2(f[j][4] * r * gg[j][4], f[j][5] * r * gg[j][5]); o.w = pk2(f[j][6] * r * gg[j][6], f[j][7] * r * gg[j][7]);
                ((u32x4*)(out + (size_t)(row0 + q) * D_))[c.lane + 64 * j] = o; } }
    }
}
__device__ __forceinline__ void ph_norm_final_from_bf16(const Ctx& c, const bf16* x, const float* g, float* out) {
    constexpr int RB = 4; float gg[2][8];
#pragma unroll
    for (int j = 0; j < 2; ++j) { const f32x4 a = ((const f32x4*)g)[2 * c.lane + 128 * j], b2 = ((const f32x4*)g)[2 * c.lane + 128 * j + 1]; gg[j][0] = a.x; gg[j][1] = a.y; gg[j][2] = a.z; gg[j][3] = a.w; gg[j][4] = b2.x; gg[j][5] = b2.y; gg[j][6] = b2.z; gg[j][7] = b2.w; }
    for (int row0 = c.gw * RB; row0 < NT; row0 += c.ngw * RB) {
        u32x4 v[RB][2];
#pragma unroll
        for (int q = 0; q < RB; ++q)
#pragma unroll
            for (int j = 0; j < 2; ++j) v[q][j] = ((const u32x4*)(x + (size_t)(row0 + q) * D_))[c.lane + 64 * j];
#pragma unroll
        for (int q = 0; q < RB; ++q) { float f[2][8]; float ss = 0.f;
#pragma unroll
            for (int j = 0; j < 2; ++j) { unpack8(v[q][j], f[j]);
#pragma unroll
                for (int e = 0; e < 8; ++e) ss = fmaf(f[j][e], f[j][e], ss); }
            const float r = rsqrtf(wave_sum_l(ss, c.lane) * (1.f / D_) + EPS);
#pragma unroll
            for (int j = 0; j < 2; ++j) { f32x4* o = (f32x4*)(out + (size_t)(row0 + q) * D_) + 2 * c.lane + 128 * j;
                o[0] = (f32x4){f[j][0] * r * gg[j][0], f[j][1] * r * gg[j][1], f[j][2] * r * gg[j][2], f[j][3] * r * gg[j][3]}; o[1] = (f32x4){f[j][4] * r * gg[j][4], f[j][5] * r * gg[j][5], f[j][6] * r * gg[j][6], f[j][7] * r * gg[j][7]}; } }
    }
}
__device__ __forceinline__ void ph_norm_bf16(const Ctx& c, const float* x, const float* g, bf16* out, bf16* raw) {
    constexpr int RB = 4;
    f32x4 gg[4];
#pragma unroll
    for (int j = 0; j < 4; ++j) gg[j] = ((const f32x4*)g)[c.lane + 64 * j];
    for (int row0 = c.gw * RB; row0 < NT; row0 += c.ngw * RB) {
        f32x4 v[RB][4];
#pragma unroll
        for (int q = 0; q < RB; ++q)
#pragma unroll
            for (int j = 0; j < 4; ++j) v[q][j] = ((const f32x4*)(x + (size_t)(row0 + q) * D_))[c.lane + 64 * j];
#pragma unroll
        for (int q = 0; q < RB; ++q) { float ss = 0.f;
#pragma unroll
            for (int j = 0; j < 4; ++j) ss += v[q][j].x * v[q][j].x + v[q][j].y * v[q][j].y + v[q][j].z * v[q][j].z + v[q][j].w * v[q][j].w;
            const float r = rsqrtf(wave_sum_l(ss, c.lane) * (1.f / D_) + EPS);
            u64* o8 = (u64*)(out + (size_t)(row0 + q) * D_) + c.lane; u64* r8 = (u64*)(raw + (size_t)(row0 + q) * D_) + c.lane;
#pragma unroll
            for (int j = 0; j < 4; ++j) { o8[64 * j] = (u64)pk2(v[q][j].x * r * gg[j].x, v[q][j].y * r * gg[j].y) | ((u64)pk2(v[q][j].z * r * gg[j].z, v[q][j].w * r * gg[j].w) << 32);
                r8[64 * j] = (u64)pk2(v[q][j].x, v[q][j].y) | ((u64)pk2(v[q][j].z, v[q][j].w) << 32); } }
    }
}
__device__ __forceinline__ void ph_norm_final(const Ctx& c, float* x, const float* g) {
    constexpr int RB = 4;
    f32x4 gg[4];
#pragma unroll
    for (int j = 0; j < 4; ++j) gg[j] = ((const f32x4*)g)[c.lane + 64 * j];
    for (int row0 = c.gw * RB; row0 < NT; row0 += c.ngw * RB) {
        f32x4 v[RB][4];
#pragma unroll
        for (int q = 0; q < RB; ++q)
#pragma unroll
            for (int j = 0; j < 4; ++j) v[q][j] = ((const f32x4*)(x + (size_t)(row0 + q) * D_))[c.lane + 64 * j];
#pragma unroll
        for (int q = 0; q < RB; ++q) { float ss = 0.f;
#pragma unroll
            for (int j = 0; j < 4; ++j) ss += v[q][j].x * v[q][j].x + v[q][j].y * v[q][j].y + v[q][j].z * v[q][j].z + v[q][j].w * v[q][j].w;
            const float r = rsqrtf(wave_sum_l(ss, c.lane) * (1.f / D_) + EPS);
            f32x4* xr = (f32x4*)(x + (size_t)(row0 + q) * D_) + c.lane;
#pragma unroll
            for (int j = 0; j < 4; ++j) xr[64 * j] = v[q][j] * r * gg[j]; }
    }
}

template <class AF, class EF>
__device__ __forceinline__ void naive_gemm(const Ctx& c, int M, int N, int K, AF af, const float* W, int ldb, EF ef) {
    LAS float* As = (LAS float*)c.lds;
    LAS float* Bs = As + 16 * 132;
    const int tm = (M + 127) / 128, tn = (N + 127) / 128, ntile = tm * tn;
    const int ty = c.tid >> 4, tx = c.tid & 15;
    for (int tile = c.bid; tile < ntile; tile += c.G) {
        const int m0 = (tile / tn) * 128, n0 = (tile % tn) * 128;
        float acc[4][8];
#pragma unroll
        for (int i = 0; i < 4; ++i)
#pragma unroll
            for (int j = 0; j < 8; ++j) acc[i][j] = 0.f;
        for (int k0 = 0; k0 < K; k0 += 16) {
            __syncthreads();
#pragma unroll
            for (int i = 0; i < 4; ++i) { const int e = c.tid + i * 512, r = e >> 4, kk = e & 15; const int row = m0 + r;
                As[kk * 132 + r] = (row < M) ? af(row, k0 + kk) : 0.f; }
#pragma unroll
            for (int i = 0; i < 4; ++i) { const int e = c.tid + i * 512, kk = e >> 7, cc = e & 127; const int col = n0 + cc;
                Bs[kk * 132 + cc] = (col < N) ? W[(size_t)(k0 + kk) * ldb + col] : 0.f; }
            __syncthreads();
#pragma unroll 2
            for (int kk = 0; kk < 16; ++kk) {
                float a[4], b[8];
#pragma unroll
                for (int i = 0; i < 4; ++i) a[i] = As[kk * 132 + ty * 4 + i];
#pragma unroll
                for (int j = 0; j < 8; ++j) b[j] = Bs[kk * 132 + tx * 8 + j];
#pragma unroll
                for (int i = 0; i < 4; ++i)
#pragma unroll
                    for (int j = 0; j < 8; ++j) acc[i][j] = fmaf(a[i], b[j], acc[i][j]);
            }
        }
        LAS float* Cs = Bs + 16 * 132;
        __syncthreads();
#pragma unroll
        for (int i = 0; i < 4; ++i)
#pragma unroll
            for (int j = 0; j < 8; ++j) Cs[(ty * 4 + i) * 129 + tx * 8 + j] = acc[i][j];
        __syncthreads();
#pragma unroll 1
        for (int e = c.tid; e < 128 * 128; e += NTHREADS) { const int r = e >> 7, cc = e & 127, row = m0 + r, col = n0 + cc; if (row < M && col < N) ef(row, col, Cs[r * 129 + cc]); }
    }
    __syncthreads();
}

struct InProjOut { bf16* qn; bf16* kv6; bf16* fqkv; bf16* dqk; bf16* dv; float* gate; float* fl; const float* b_gate; const float* b_fgt; };
__device__ __forceinline__ void inproj_store(const InProjOut& o, int n, int col, float v) {
    const int b = n / T_, t = n % T_;
    if (col < C_KV6) { const int h = col >> 6, d = col & 63; o.qn[((size_t)(b * 8 + h) * T_ + t) * 64 + d] = (bf16)f2bf(v * (0.125f * LOG2E)); }
    else if (col < C_GATE) { const int cc = col - C_KV6, idx = cc >> 7, g = (cc >> 6) & 1, d = cc & 63;
        ((bf16*)((unsigned char*)o.kv6 + idx * KV6_STRIDE))[((size_t)(b * 2 + g) * T_ + t) * 64 + d] = (bf16)f2bf(v); }
    else if (col < C_FQ) { const int j = col - C_GATE; o.gate[(size_t)n * 24 + j] = sigmoidf_(v + o.b_gate[j]); }
    else if (col < C_FF) { const int cc = col - C_FQ, idx = cc >> 8, h = (cc >> 6) & 3, d = cc & 63;
        o.fqkv[(size_t)idx * (8 * MiB) + ((size_t)(b * 4 + h) * T_ + t) * 64 + d] = (bf16)f2bf(idx == 0 ? v * (0.125f * LOG2E) : v); }
    else if (col < C_DQ) { const int h = col - C_FF; o.fl[(size_t)(b * 4 + h) * T_ + t] = log_sigmoidf_(v + o.b_fgt[h]); }
    else if (col < C_DV) { const int cc = col - C_DQ, idx = cc >> 8, h = (cc >> 6) & 3, i = (cc >> 5) & 1, d = cc & 31;
        o.dqk[(size_t)idx * (8 * MiB) + ((size_t)((b * 4 + h) * 2 + i) * T_ + t) * 32 + d] = (bf16)f2bf(idx == 0 ? v * (0.17677669529663687f * LOG2E) : v); }
    else { const int cc = col - C_DV, h = cc >> 6, d = cc & 63; o.dv[((size_t)(b * 4 + h) * T_ + t) * 64 + d] = (bf16)f2bf(v); }
}

__device__ __forceinline__ void ph_cumsum(const Ctx& c, float* fl) {
    for (int s = c.gw; s < B_ * 4; s += c.ngw) {
        float* p = fl + (size_t)s * T_; float carry = 0.f;
        for (int t0 = 0; t0 < T_; t0 += 64) {
            float v = p[t0 + c.lane];
#pragma unroll
            for (int o = 1; o < 64; o <<= 1) { const float u = __shfl_up(v, o); if (c.lane >= o) v += u; }
            v += carry; p[t0 + c.lane] = v; carry = __shfl(v, 63);
        }
    }
}

template <int DQK>
__device__ __forceinline__ float naive_attn_row(const bf16* q, const bf16* K, const bf16* V, int t, u64 mask, float slope2, const float* cum, int win, int lane) {
    float qv[DQK];
    { const u32x4* q4 = (const u32x4*)q;
#pragma unroll
      for (int i = 0; i < DQK / 8; ++i) { const u32x4 w = q4[i];
          qv[8 * i + 0] = __uint_as_float(w.x << 16); qv[8 * i + 1] = __uint_as_float(w.x & 0xffff0000u);
          qv[8 * i + 2] = __uint_as_float(w.y << 16); qv[8 * i + 3] = __uint_as_float(w.y & 0xffff0000u);
          qv[8 * i + 4] = __uint_as_float(w.z << 16); qv[8 * i + 5] = __uint_as_float(w.z & 0xffff0000u);
          qv[8 * i + 6] = __uint_as_float(w.w << 16); qv[8 * i + 7] = __uint_as_float(w.w & 0xffff0000u); } }
    const float cumt = cum ? cum[t] : 0.f;
    float m = -INFINITY, l = 0.f, o = 0.f;
    while (mask) {
        const int j = __builtin_ctzll(mask); mask &= mask - 1;
        const int kpos = 64 * j + lane; const int dist = t - kpos;
        const bool valid = dist >= 0 && dist < win;
        float s = 0.f;
        { const u32x4* k4 = (const u32x4*)(K + (size_t)kpos * DQK);
#pragma unroll
          for (int i = 0; i < DQK / 8; ++i) { const u32x4 w = k4[i];
              s = fmaf(qv[8 * i + 0], __uint_as_float(w.x << 16), s); s = fmaf(qv[8 * i + 1], __uint_as_float(w.x & 0xffff0000u), s);
              s = fmaf(qv[8 * i + 2], __uint_as_float(w.y << 16), s); s = fmaf(qv[8 * i + 3], __uint_as_float(w.y & 0xffff0000u), s);
              s = fmaf(qv[8 * i + 4], __uint_as_float(w.z << 16), s); s = fmaf(qv[8 * i + 5], __uint_as_float(w.z & 0xffff0000u), s);
              s = fmaf(qv[8 * i + 6], __uint_as_float(w.w << 16), s); s = fmaf(qv[8 * i + 7], __uint_as_float(w.w & 0xffff0000u), s); } }
        s -= slope2 * (float)dist;
        if (cum) s += (cumt - cum[kpos]) * LOG2E;
        s = valid ? s : -INFINITY;
        const float mb = wave_max(s);
        if (mb == -INFINITY) continue;
        const float mn = fmaxf(m, mb), alpha = exp2f(m - mn);
        const float p = valid ? exp2f(s - mn) : 0.f;
        l = l * alpha + wave_sum(p); o *= alpha; m = mn;
        const bf16* vb = V + (size_t)(64 * j) * 64 + lane;
#pragma unroll 8
        for (int k = 0; k < 64; ++k) o = fmaf(__shfl(p, k), bf2f(vb[(size_t)k * 64]), o);
    }
    return l > 0.f ? o / l : 0.f;
}

__device__ __forceinline__ void ph_cmp_attn(const Ctx& c, const bf16* qn, const bf16* kcmp, const bf16* vcmp, const float* gate, u64* sel, bf16* ocmp) {
    LAS float* pl = (LAS float*)(c.lds) + c.wave * 256;
    const int lane = c.lane;
    for (int it = c.gw; it < B_ * 2 * T_; it += c.ngw) {
        const int t = it % T_, bg = it / T_, b = bg >> 1, g = bg & 1;
        const int nvis = (t >= 31) ? ((t - 31) >> 4) + 1 : 0;
        const bf16* kc = kcmp + (size_t)bg * 256 * 64; const bf16* vc = vcmp + (size_t)bg * 256 * 64;
        float imp = 0.f;
        for (int hg = 0; hg < 4; ++hg) {
            const int h = g * 4 + hg; const float slope2 = alibi_slope(h + 1, 8) * LOG2E;
            const bf16* q = qn + ((size_t)(b * 8 + h) * T_ + t) * 64;
            float qv[64];
            { const u32x4* q4 = (const u32x4*)q;
#pragma unroll
              for (int i = 0; i < 8; ++i) { const u32x4 w = q4[i];
                  qv[8 * i + 0] = __uint_as_float(w.x << 16); qv[8 * i + 1] = __uint_as_float(w.x & 0xffff0000u);
                  qv[8 * i + 2] = __uint_as_float(w.y << 16); qv[8 * i + 3] = __uint_as_float(w.y & 0xffff0000u);
                  qv[8 * i + 4] = __uint_as_float(w.z << 16); qv[8 * i + 5] = __uint_as_float(w.z & 0xffff0000u);
                  qv[8 * i + 6] = __uint_as_float(w.w << 16); qv[8 * i + 7] = __uint_as_float(w.w & 0xffff0000u); } }
            float s[4]; float m = -INFINITY;
#pragma unroll
            for (int i = 0; i < 4; ++i) { const int cc = lane + 64 * i; float a = 0.f;
                if (cc < nvis) { const u32x4* k4 = (const u32x4*)(kc + (size_t)cc * 64);
#pragma unroll
                    for (int e = 0; e < 8; ++e) { const u32x4 w = k4[e];
                        a = fmaf(qv[8 * e + 0], __uint_as_float(w.x << 16), a); a = fmaf(qv[8 * e + 1], __uint_as_float(w.x & 0xffff0000u), a);
                        a = fmaf(qv[8 * e + 2], __uint_as_float(w.y << 16), a); a = fmaf(qv[8 * e + 3], __uint_as_float(w.y & 0xffff0000u), a);
                        a = fmaf(qv[8 * e + 4], __uint_as_float(w.z << 16), a); a = fmaf(qv[8 * e + 5], __uint_as_float(w.z & 0xffff0000u), a);
                        a = fmaf(qv[8 * e + 6], __uint_as_float(w.w << 16), a); a = fmaf(qv[8 * e + 7], __uint_as_float(w.w & 0xffff0000u), a); }
                    a -= slope2 * (float)(t - (16 * cc + 31)); } else a = -INFINITY;
                s[i] = a; m = fmaxf(m, a); }
            m = wave_max(m);
            float p[4], lsum = 0.f;
#pragma unroll
            for (int i = 0; i < 4; ++i) { p[i] = (lane + 64 * i < nvis) ? exp2f(s[i] - m) : 0.f; lsum += p[i]; }
            lsum = wave_sum(lsum);
            const float inv = lsum > 0.f ? 1.f / lsum : 0.f;
#pragma unroll
            for (int i = 0; i < 4; ++i) { p[i] *= inv; pl[lane + 64 * i] = p[i]; }
            asm volatile("s_waitcnt lgkmcnt(0)" ::: "memory");
            float o = 0.f;
            for (int cc = 0; cc < nvis; ++cc) o = fmaf(pl[cc], bf2f(vc[(size_t)cc * 64 + lane]), o);
            const float gt = gate[((size_t)(b * T_ + t)) * 24 + h * 3 + 0];
            ocmp[(size_t)(b * T_ + t) * 512 + h * 64 + lane] = (bf16)f2bf(gt * o);
            { const int j = lane; float a = pl[4 * j] + pl[4 * j + 1] + pl[4 * j + 2] + 0.5f * pl[4 * j + 3]; if (j > 0) a += 0.5f * pl[4 * j - 1]; imp += a; }
            asm volatile("s_waitcnt lgkmcnt(0)" ::: "memory");
        }
        const int cur = t >> 6; const int j = lane;
        u64 m64;
        if (cur <= 15) m64 = (cur == 63) ? ~0ull : ((1ull << (cur + 1)) - 1ull);
        else {
            float val = (j > cur) ? -INFINITY : ((j == 0 || j == cur || j == cur - 1) ? 1e4f : imp);
            m64 = 0ull;
            for (int r = 0; r < 16; ++r) {
                const float mx = wave_max(val);
                const u64 bal = __ballot(val == mx);
                const int w = __builtin_ctzll(bal);
                m64 |= 1ull << w; if (j == w) val = -INFINITY;
            }
        }
        if (lane == 0) sel[(size_t)bg * T_ + t] = m64;
    }
}

__device__ __forceinline__ void ph_win_attn(const Ctx& c, const bf16* qn, const bf16* kw, const bf16* vw, const float* gate, bf16* owin) {
    for (int it = c.gw; it < B_ * 8 * T_; it += c.ngw) {
        const int t = it % T_, bh = it / T_, b = bh >> 3, h = bh & 7, g = h >> 2;
        const int cur = t >> 6, jlo = (t - 511) > 0 ? (t - 511) >> 6 : 0;
        const u64 hi = (cur == 63) ? ~0ull : ((1ull << (cur + 1)) - 1ull); const u64 mask = hi & ~((1ull << jlo) - 1ull);
        const float o = naive_attn_row<64>(qn + ((size_t)bh * T_ + t) * 64, kw + (size_t)(b * 2 + g) * T_ * 64, vw + (size_t)(b * 2 + g) * T_ * 64, t, mask,
                                           alibi_slope(h + 1, 8) * LOG2E, nullptr, 512, c.lane);
        owin[(size_t)(b * T_ + t) * 512 + h * 64 + c.lane] = (bf16)f2bf(gate[(size_t)(b * T_ + t) * 24 + h * 3 + 2] * o);
    }
}
__device__ __forceinline__ void ph_slc_attn(const Ctx& c, const bf16* qn, const bf16* ks, const bf16* vs, const float* gate, const u64* sel, const bf16* ocmp, const bf16* owin, bf16* att) {
    for (int it = c.gw; it < B_ * 8 * T_; it += c.ngw) {
        const int t = it % T_, bh = it / T_, b = bh >> 3, h = bh & 7, g = h >> 2;
        const u64 mask = sel[(size_t)(b * 2 + g) * T_ + t];
        const float o = naive_attn_row<64>(qn + ((size_t)bh * T_ + t) * 64, ks + (size_t)(b * 2 + g) * T_ * 64, vs + (size_t)(b * 2 + g) * T_ * 64, t, mask,
                                           alibi_slope(h + 1, 8) * LOG2E, nullptr, 1 << 30, c.lane);
        const size_t n = (size_t)(b * T_ + t);
        const float r = gate[n * 24 + h * 3 + 1] * o + bf2f(ocmp[n * 512 + h * 64 + c.lane]) + bf2f(owin[n * 512 + h * 64 + c.lane]);
        att[n * 1024 + h * 64 + c.lane] = (bf16)f2bf(r);
    }
}
__device__ __forceinline__ void ph_fox_attn(const Ctx& c, const bf16* fq, const bf16* fk, const bf16* fv, const float* cum, bf16* att) {
    for (int it = c.gw; it < B_ * 4 * T_; it += c.ngw) {
        const int t = it % T_, bh = it / T_, b = bh >> 2, h = bh & 3;
        const int cur = t >> 6; const u64 mask = (cur == 63) ? ~0ull : ((1ull << (cur + 1)) - 1ull);
        const float o = naive_attn_row<64>(fq + ((size_t)bh * T_ + t) * 64, fk + (size_t)bh * T_ * 64, fv + (size_t)bh * T_ * 64, t, mask, 0.f, cum + (size_t)bh * T_, 1 << 30, c.lane);
        att[(size_t)(b * T_ + t) * 1024 + 512 + h * 64 + c.lane] = (bf16)f2bf(o);
    }
}
__device__ __forceinline__ void ph_diff_attn(const Ctx& c, const bf16* dq, const bf16* dk, const bf16* dv, const float* lam, const float* subln, float lambda_init, bf16* att) {
    float l1 = 0.f, l2 = 0.f;
    if (c.lane < 32) { l1 = lam[c.lane] * lam[32 + c.lane]; l2 = lam[64 + c.lane] * lam[96 + c.lane]; }
    const float lam_full = __expf(wave_sum(l1)) - __expf(wave_sum(l2)) + lambda_init;
    const float sg = subln[c.lane] * (1.f - lambda_init);
    for (int it = c.gw; it < B_ * 4 * T_; it += c.ngw) {
        const int t = it % T_, bh = it / T_, b = bh >> 2, h = bh & 3;
        const int cur = t >> 6; const u64 mask = (cur == 63) ? ~0ull : ((1ull << (cur + 1)) - 1ull);
        const float slope2 = alibi_slope(h + 1, 4) * LOG2E;
        const bf16* vb = dv + (size_t)bh * T_ * 64;
        const float o1 = naive_attn_row<32>(dq + ((size_t)(bh * 2 + 0) * T_ + t) * 32, dk + (size_t)(bh * 2 + 0) * T_ * 32, vb, t, mask, slope2, nullptr, 1 << 30, c.lane);
        const float o2 = naive_attn_row<32>(dq + ((size_t)(bh * 2 + 1) * T_ + t) * 32, dk + (size_t)(bh * 2 + 1) * T_ * 32, vb, t, mask, slope2, nullptr, 1 << 30, c.lane);
        const float o = o1 - lam_full * o2;
        const float r = rsqrtf(wave_sum(o * o) * (1.f / 64.f) + EPS);
        att[(size_t)(b * T_ + t) * 1024 + 768 + h * 64 + c.lane] = (bf16)f2bf(o * r * sg);
    }
}

__device__ __forceinline__ void ph_moe_route(const Ctx& c, const float* x, const float* g, const float* wgrp, const float* bgrp, const float* wexp, const float* bexp, bf16* hn, int* route_e, float* route_w, unsigned* cnt) {
    for (int row = c.gw; row < NT; row += c.ngw) {
        const f32x4* xr = (const f32x4*)(x + (size_t)row * D_) + c.lane;
        f32x4 v[4]; float ss = 0.f;
#pragma unroll
        for (int j = 0; j < 4; ++j) { v[j] = xr[64 * j]; ss += v[j].x * v[j].x + v[j].y * v[j].y + v[j].z * v[j].z + v[j].w * v[j].w; }
        const float r = rsqrtf(wave_sum(ss) * (1.f / D_) + EPS);
        u64* o8 = (u64*)(hn + (size_t)row * D_) + c.lane;
#pragma unroll
        for (int j = 0; j < 4; ++j) { const f32x4 gg = ((const f32x4*)g)[c.lane + 64 * j]; v[j] = v[j] * r * gg;
            o8[64 * j] = (u64)pk2(v[j].x, v[j].y) | ((u64)pk2(v[j].z, v[j].w) << 32); }
        float gl[4];
#pragma unroll
        for (int q = 0; q < 4; ++q) { float a = 0.f;
#pragma unroll
            for (int j = 0; j < 4; ++j) { const int k = 4 * (c.lane + 64 * j);
                a = fmaf(v[j].x, wgrp[(size_t)(k + 0) * 4 + q], a); a = fmaf(v[j].y, wgrp[(size_t)(k + 1) * 4 + q], a);
                a = fmaf(v[j].z, wgrp[(size_t)(k + 2) * 4 + q], a); a = fmaf(v[j].w, wgrp[(size_t)(k + 3) * 4 + q], a); }
            gl[q] = wave_sum(a) + bgrp[q]; }
        int grp = 0; float gm = gl[0];
#pragma unroll
        for (int q = 1; q < 4; ++q) if (gl[q] > gm) { gm = gl[q]; grp = q; }
        float gs = 0.f;
#pragma unroll
        for (int q = 0; q < 4; ++q) gs += __expf(gl[q] - gm);
        const float grp_gate = 1.f / gs;
        float el[8];
#pragma unroll
        for (int q = 0; q < 8; ++q) { float a = 0.f; const int col = grp * 8 + q;
#pragma unroll
            for (int j = 0; j < 4; ++j) { const int k = 4 * (c.lane + 64 * j);
                a = fmaf(v[j].x, wexp[(size_t)(k + 0) * 32 + col], a); a = fmaf(v[j].y, wexp[(size_t)(k + 1) * 32 + col], a);
                a = fmaf(v[j].z, wexp[(size_t)(k + 2) * 32 + col], a); a = fmaf(v[j].w, wexp[(size_t)(k + 3) * 32 + col], a); }
            el[q] = wave_sum(a) + bexp[col]; }
        int i0 = 0; float v0 = el[0];
#pragma unroll
        for (int q = 1; q < 8; ++q) if (el[q] > v0) { v0 = el[q]; i0 = q; }
        int i1 = -1; float v1 = -INFINITY;
#pragma unroll
        for (int q = 0; q < 8; ++q) if (q != i0 && el[q] > v1) { v1 = el[q]; i1 = q; }
        const float e1 = __expf(v1 - v0), den = 1.f + e1;
        if (c.lane == 0) { const float w0 = grp_gate / den, w1 = grp_gate * e1 / den;
            const int lo = i0 < i1 ? i0 : i1, hi = i0 < i1 ? i1 : i0, cls = grp * 28 + lo * 8 - (lo * (lo + 1)) / 2 + (hi - lo - 1);
            const unsigned rank = __hip_atomic_fetch_add(cnt + cls, 1u, __ATOMIC_RELAXED, __HIP_MEMORY_SCOPE_AGENT);
            route_e[row] = (int)(((unsigned)cls << 24) | rank); route_w[2 * row] = i0 < i1 ? w0 : w1; route_w[2 * row + 1] = i0 < i1 ? w1 : w0; }
    }
}
__device__ __forceinline__ void ph_moe_naive(const Ctx& c, const bf16* hn, const int* route_e, const float* route_w, const float* wg, const float* wu, const float* wd, float* x) {
    LAS float* hs = (LAS float*)c.lds;
    LAS float* au = hs + 1024;
    LAS float* h2 = au + 512;
    for (int row = c.bid; row < NT; row += c.G) {
        __syncthreads();
        hs[c.tid] = bf2f(hn[(size_t)row * D_ + c.tid]); hs[c.tid + 512] = bf2f(hn[(size_t)row * D_ + c.tid + 512]);
        float o0 = 0.f, o1 = 0.f;
        for (int s = 0; s < 2; ++s) {
            const int e = route_e[2 * row + s]; const float w = route_w[2 * row + s];
            __syncthreads();
            const float* W = (c.tid < 256 ? wg : wu) + (size_t)e * D_ * DEXP + (c.tid & 255);
            float a = 0.f;
            for (int k = 0; k < D_; ++k) a = fmaf(hs[k], W[(size_t)k * DEXP], a);
            au[c.tid] = a;
            __syncthreads();
            if (c.tid < 256) { const float ga = au[c.tid], up = au[c.tid + 256]; h2[c.tid] = ga / (1.f + __expf(-ga)) * up * w; }
            __syncthreads();
            const float* Wd = wd + (size_t)e * DEXP * D_;
            for (int k = 0; k < DEXP; ++k) { const float hv = h2[k]; o0 = fmaf(hv, Wd[(size_t)k * D_ + c.tid], o0); o1 = fmaf(hv, Wd[(size_t)k * D_ + c.tid + 512], o1); }
        }
        x[(size_t)row * D_ + c.tid] += o0; x[(size_t)row * D_ + c.tid + 512] += o1;
    }
    __syncthreads();
}

typedef __attribute__((address_space(4))) const Params* KP;
__device__ __forceinline__ KP uni_kp(KP p) { const unsigned long long v = (unsigned long long)p; const unsigned lo = __builtin_amdgcn_readfirstlane((unsigned)v), hi = __builtin_amdgcn_readfirstlane((unsigned)(v >> 32)); return (KP)(((unsigned long long)hi << 32) | lo); }
constexpr int PH_PER_LAYER = 11, N_PHASES = L_ * PH_PER_LAYER + 2;
__device__ __forceinline__ Ctx make_ctx(KP p) {
    Ctx c; c.lds = (LAS unsigned char*)lds_raw; { int t_ = threadIdx.x; asm volatile("" : "+v"(t_)); c.tid = t_; } c.lane = c.tid & 63; c.wave = __builtin_amdgcn_readfirstlane(c.tid >> 6);
    c.bid = blockIdx.x; c.G = gridDim.x; c.gw = c.bid * NWAVES + c.wave; c.ngw = c.G * NWAVES; c.in = nullptr; c.xcur = p->out; c.ws = p->ws;
    return c;
}
struct Bufs {
    bf16 *QN, *KV6, *KC, *VC, *KS, *VS, *KW, *VW, *FQ, *FK, *FV, *DQ, *DK, *DV, *HC, *KCMP, *VCMP, *OCMP, *OWIN, *HN, *ATT;
    float *GATE, *FL, *ROUTE_W; u64* SEL; int* ROUTE_E;
};
__device__ __forceinline__ Bufs make_bufs(unsigned char* ws) {
    Bufs b;
    b.QN = (bf16*)(ws + WS_QN); b.KV6 = (bf16*)(ws + WS_KV6);
    b.KC = (bf16*)(ws + WS_KV6 + 0 * KV6_STRIDE); b.VC = (bf16*)(ws + WS_KV6 + 1 * KV6_STRIDE);
    b.KS = (bf16*)(ws + WS_KV6 + 2 * KV6_STRIDE); b.VS = (bf16*)(ws + WS_KV6 + 3 * KV6_STRIDE);
    b.KW = (bf16*)(ws + WS_KV6 + 4 * KV6_STRIDE); b.VW = (bf16*)(ws + WS_KV6 + 5 * KV6_STRIDE);
    b.FQ = (bf16*)(ws + WS_FQKV); b.FK = b.FQ + 8 * MiB; b.FV = b.FQ + 16 * MiB;
    b.DQ = (bf16*)(ws + WS_DQK); b.DK = b.DQ + 8 * MiB; b.DV = (bf16*)(ws + WS_DV);
    b.GATE = (float*)(ws + WS_GATE); b.FL = (float*)(ws + WS_FL);
    b.HC = (bf16*)(ws + WS_HC); b.KCMP = (bf16*)(ws + WS_KVCMP); b.VCMP = b.KCMP + 16 * 256 * 64;
    b.SEL = (u64*)(ws + WS_SEL); b.OCMP = (bf16*)(ws + WS_OCMP); b.OWIN = (bf16*)(ws + WS_OWIN);
    b.HN = (bf16*)(ws + WS_HN); b.ATT = (bf16*)(ws + WS_ATT);
    b.ROUTE_E = (int*)(ws + WS_ROUTE); b.ROUTE_W = (float*)(ws + WS_ROUTE + 512 * 1024);
    return b;
}
__device__ __forceinline__ float lambda_init_of(int l) { return l == 0 ? 0.2f : 0.35550906759096926f; }

__device__ __noinline__ void P_prologue(KP p_) { const KP p = uni_kp(p_);
    const Ctx c = make_ctx(p); unsigned char* ws = p->ws;
    LAS float* scr = (LAS float*)(c.lds) + c.wave * (64 * 33);
    constexpr int I_A = 16 * 40, I_B = 16 * 24, I_C = 16 * 24, I_O = 16 * 32, I_G = 16 * 8, I_D = 4 * 32, I_E = 2 * I_G + I_D, I_W1 = 32 * 8, I_W2 = 4 * 2;
    constexpr int PER_L = I_A + I_B + I_C + I_O + 2 * (I_W1 + I_W2);
    for (int it = c.gw; it < L_ * PER_L; it += c.ngw) {
        const int l = it / PER_L; int r = it % PER_L;
        const float* W; bf16* WT; int ldw, K, sc0, ncol, r0 = 0, rmul = 1;
        if (r < I_A + I_B + I_C) { W = p->in[2] + (size_t)l * D_ * D_IN; WT = (bf16*)(ws + WS_WIN_T) + (size_t)l * NIN * D_; ldw = D_IN; K = D_;
            if (r < I_A) { sc0 = 0; ncol = 1280; r0 = 0; } else if (r < I_A + I_B) { r -= I_A; sc0 = C_FQ; ncol = 768; r0 = 1280; } else { r -= I_A + I_B; sc0 = C_DQ; ncol = 768; r0 = 2048; } }
        else if ((r -= I_A + I_B + I_C) < I_O) { W = p->in[13] + (size_t)l * D_ * D_; WT = (bf16*)(ws + WS_WOUT_T) + (size_t)l * D_ * D_; ldw = D_; K = D_; sc0 = 0; ncol = 1024; }
        else { r -= I_O; const int kv = r / (I_W1 + I_W2); r = r % (I_W1 + I_W2); const size_t lk = (size_t)l * 2 + kv;
            if (r < I_W1) { W = p->in[kv == 0 ? 6 : 9] + (size_t)l * 2048 * 256; WT = (bf16*)(ws + WS_W1_T) + lk * 256 * 2048; ldw = 256; K = 2048; sc0 = 0; ncol = 256; }
            else { r -= I_W1; W = p->in[kv == 0 ? 7 : 10] + (size_t)l * 256 * 64; WT = (bf16*)(ws + WS_W2_T) + lk * 64 * 256; ldw = 64; K = 256; sc0 = 0; ncol = 64; } }
        transpose_seg(W, ldw, K, sc0, ncol, WT, r0, rmul, r, scr, c.lane);
    }
    for (int i = c.bid * NTHREADS + c.tid; i < L_ * 256 * D_; i += c.G * NTHREADS) {
        const int l = i / (256 * D_), rr = (i / D_) % 256, k = i % D_;
        const float* win = p->in[2] + (size_t)l * D_ * D_IN;
        float v = 0.f; if (rr < 24) v = win[(size_t)k * D_IN + C_GATE + rr]; else if (rr < 28) v = win[(size_t)k * D_IN + C_FF + (rr - 24)];
        ((bf16*)(ws + WS_WIN_T))[((size_t)l * NIN + 2816 + rr) * D_ + k] = (bf16)f2bf(v);
    }
    for (int w = c.gw; w < L_ * 2 * 4 * 128; w += c.ngw) {
        const int lk = w >> 9, cg = (w >> 7) & 3, kc = w & 127, l = lk >> 1, kv = lk & 1, j = cg * 64 + c.lane;
        const float* pe = p->in[kv == 0 ? 5 : 8] + (size_t)l * 2048 + kc * 16; const float* w1 = p->in[kv == 0 ? 6 : 9] + (size_t)l * 2048 * 256 + (size_t)kc * 16 * 256;
        float a = 0.f;
#pragma unroll
        for (int k = 0; k < 16; ++k) a = fmaf(pe[k], w1[(size_t)k * 256 + j], a);
        ((float*)(ws + WS_B1PART))[((size_t)lk * 128 + kc) * 256 + j] = a;
    }
    for (int i = c.bid * NTHREADS + c.tid; i < L_ * 64 * 2 * 64; i += c.G * NTHREADS) {
        const int l = i / (64 * 2 * 64), ks = (i / 128) % 64, cb = (i / 64) & 1, lane = i & 63, col = 32 * cb + (lane & 31);
        unsigned hi[4], lo[4];
#pragma unroll
        for (int jp = 0; jp < 4; ++jp) { float v[2];
#pragma unroll
            for (int e = 0; e < 2; ++e) { const int k = 16 * ks + 8 * (lane >> 5) + 2 * jp + e; const float g = p->in[14][(size_t)l * D_ + k];
                v[e] = col < 4 ? g * p->in[15][((size_t)l * D_ + k) * 4 + col] : (col < 36 ? g * p->in[17][((size_t)l * D_ + k) * 32 + (col - 4)] : 0.f); }
            const unsigned h0 = f2bf(v[0]), h1 = f2bf(v[1]); hi[jp] = h0 | (h1 << 16);
            lo[jp] = f2bf(v[0] - __uint_as_float(h0 << 16)) | (f2bf(v[1] - __uint_as_float(h1 << 16)) << 16); }
        u32x4* dst = (u32x4*)(ws + WS_WR) + ((size_t)((l * 64 + ks) * 2 + cb) * 2) * 64 + lane;
        dst[0] = (u32x4){hi[0], hi[1], hi[2], hi[3]}; dst[64] = (u32x4){lo[0], lo[1], lo[2], lo[3]};
    }
}
__device__ __forceinline__ void P_inproj_mfma(int l_) { const KP p = (KP)__builtin_amdgcn_kernarg_segment_ptr(); int l = l_; asm volatile("" : "+s"(l));
    unsigned char* ws = p->ws; asm volatile("" : "+s"(ws));
    PlainOrder S; S.init(p->out, (const bf16*)(ws + WS_WIN_T) + (size_t)l * NIN * D_, D_, D_, NT, NIN, (int)gridDim.x, launder_s((int)blockIdx.x));
#ifdef STAGGER_TICKS
    { const unsigned long long t0 = __builtin_amdgcn_s_memrealtime(); const unsigned long long d = (unsigned long long)((launder_s((int)blockIdx.x) >> 3) & 3) * STAGGER_TICKS;
      while (__builtin_amdgcn_s_memrealtime() - t0 < d) __builtin_amdgcn_s_sleep(4); }
#endif
    const pg8::Gemm g{D_, D_, D_, D_ / 64, 0, 0};
    const EpiInProj E{ws, p->in[3] + l * 24, p->in[4] + l * 4, (unsigned*)(ws + WS_CTL) + CW_KN + l * 8192};
    pg8::gemm_phase<EpiInProj, PlainOrder, INPROJ_ALIGN, INPROJ_SP2>((LAS unsigned char*)lds_raw, g, S, E);
}
__device__ __forceinline__ void P_inproj_dummy(int l_) { const KP p = (KP)__builtin_amdgcn_kernarg_segment_ptr(); int l = l_; asm volatile("" : "+s"(l));
    unsigned char* ws = p->ws; asm volatile("" : "+s"(ws));
    PlainOrder S; S.init(p->out, (const bf16*)(ws + WS_WIN_T) + (size_t)l * NIN * D_, D_, D_, NT, NIN, (int)gridDim.x, launder_s((int)blockIdx.x));
    const pg8::Gemm g{D_, D_, D_, D_ / 64, 0, 0};
    const EpiDummy E{(float*)(ws + WS_HB)};
    pg8::gemm_phase<EpiDummy, PlainOrder, true, true>((LAS unsigned char*)lds_raw, g, S, E);
}
__device__ __forceinline__ void P_outproj_mfma(int l_) { const KP p = (KP)__builtin_amdgcn_kernarg_segment_ptr(); int l = l_; asm volatile("" : "+s"(l));
    unsigned char* ws = p->ws; asm volatile("" : "+s"(ws));
    PlainOrder S; S.init(ws + WS_ATT, (const bf16*)(ws + WS_WOUT_T) + (size_t)l * D_ * D_, D_, D_, NT, D_, (int)gridDim.x, launder_s((int)blockIdx.x));
    const pg8::Gemm g{D_, D_, D_, D_ / 64, 32, 8};
    const EpiResBf16 E{(bf16*)(ws + WS_HN)};
    pg8::gemm_phase<EpiResBf16, PlainOrder, true, true>((LAS unsigned char*)lds_raw, g, S, E);
}
__device__ __forceinline__ float wave_max_l(float v, int lane) {
#pragma unroll
    for (int o = 1; o < 64; o <<= 1) v = fmaxf(v, shflx_f(v, o, lane));
    return v;
}
__device__ __forceinline__ float wave_min_l(float v, int lane) {
#pragma unroll
    for (int o = 1; o < 64; o <<= 1) v = fminf(v, shflx_f(v, o, lane));
    return v;
}
template <int NS> __device__ __forceinline__ float q_norm2_max(const bf16x8v (&Q)[NS], int lane) {
    float ss = 0.f;
#pragma unroll
    for (int s = 0; s < NS; ++s)
#pragma unroll
        for (int e = 0; e < 8; ++e) { const float v = __uint_as_float(((unsigned)(unsigned short)Q[s][e]) << 16); ss = fmaf(v, v, ss); }
    return wave_max_l(swap_sum(ss), lane);
}
__device__ __forceinline__ u64 prune_consensus(bool skip, LAS u64* slots, int wave, int lane) {
    const u64 mine = __ballot(skip);
    __syncthreads();
    if (lane == 0) slots[wave] = mine;
    __syncthreads();
    u64 all = slots[0];
#pragma unroll
    for (int w = 1; w < NWAVES; ++w) all &= slots[w];
    return all;
}
__device__ __forceinline__ void U_fox(KP p_, int bh_, int qb_, int l_) {
    const KP p = uni_kp(p_); const int bh = __builtin_amdgcn_readfirstlane(bh_), qb = __builtin_amdgcn_readfirstlane(qb_), l = __builtin_amdgcn_readfirstlane(l_);
    int tid_ = threadIdx.x; asm volatile("" : "+v"(tid_));
    const int tid = tid_, lane = tid & 63, wave = __builtin_amdgcn_readfirstlane(tid >> 6), r = lane & 31, h = lane >> 5;
    unsigned char* ws = p->ws; asm volatile("" : "+s"(ws)); LAS unsigned char* L = (LAS unsigned char*)lds_raw;
    const int tw0 = 256 * qb + 32 * wave, t_lane = tw0 + r, b = bh >> 2, hd = bh & 3;
    const bf16* q = (const bf16*)(ws + WS_FQKV) + (size_t)bh * T_ * 64 + (t_lane >> 4) * 1024 + (t_lane & 15) * 32 + 8 * h;
    bf16x8v Qf[1][4];
#pragma unroll
    for (int s = 0; s < 4; ++s) Qf[0][s] = *(const bf16x8v*)(q + (s >> 1) * 512 + (s & 1) * 16);
    const bf16* Kp = (const bf16*)(ws + WS_FQKV) + 8 * MiB + (size_t)bh * T_ * 64; const bf16* Vp = (const bf16*)(ws + WS_FQKV) + 16 * MiB + (size_t)bh * T_ * 64;
    u32x4 kpre, vpre; attn_preload<64>(Kp, nullptr, Vp, 4 * qb + 3, tid, kpre, vpre);
    LAS float* cum = (LAS float*)(L + A_LDS_END);
    { const float* fl = (const float*)(ws + WS_FL) + (size_t)bh * T_; LAS float* tot = cum + 4096;
      const int nval = 256 * (qb + 1); float v[8];
      if (8 * tid < nval) { const f32x4 a = *(const f32x4*)(fl + 8 * tid), c2 = *(const f32x4*)(fl + 8 * tid + 4); v[0] = a.x; v[1] = a.y; v[2] = a.z; v[3] = a.w; v[4] = c2.x; v[5] = c2.y; v[6] = c2.z; v[7] = c2.w; }
      else {
#pragma unroll
          for (int i = 0; i < 8; ++i) v[i] = 0.f; }
#pragma unroll
      for (int i = 1; i < 8; ++i) v[i] += v[i - 1];
      float sc = v[7];
#pragma unroll
      for (int o = 1; o < 64; o <<= 1) { const float up = __uint_as_float((unsigned)__builtin_amdgcn_ds_bpermute((lane - o) << 2, (int)__float_as_uint(sc))); if (lane >= o) sc += up; }
      if (lane == 63) tot[wave] = sc;
      __syncthreads();
      float base = sc - v[7];
      for (int w = 0; w < wave; ++w) base += tot[w];
      if (8 * tid < nval) {
#pragma unroll
          for (int i = 0; i < 8; ++i) cum[8 * tid + i] = v[i] + base; }
      __syncthreads(); }
    f32x16 O[1][2]; float M[1] = {0.f}, Ls[1] = {0.f};
#pragma unroll
    for (int i = 0; i < 16; ++i) { O[0][0][i] = 0.f; O[0][1][i] = 0.f; }
    const u64 tm = (qb == 15) ? ~0ull : ((1ull << (4 * qb + 4)) - 1ull);
#if AC2_MODE == 0
    {
        const u64 low = (1ull << (4 * qb)) - 1ull; const float cref = cum[256 * qb];
        attn_core<64, 1, true, false, true>(L, Kp, nullptr, Vp, cum, cref, Qf, tm & ~low, t_lane, tw0, 1 << 30, 0.f, 0u, 0u, O, M, Ls, tid, false, 4 * qb + 3, kpre, vpre);
        if (qb > 0) {
            const float qn2 = q_norm2_max<4>(Qf[0], lane), mmin = wave_min_l(M[0], lane);
            const float* kn = (const float*)((const unsigned*)(ws + WS_CTL) + CW_KN + l * 8192) + ((size_t)bh * 64 + lane) * 2;
            bool skip = false;
            if (lane < 4 * qb) { const float kn2 = kn[0] + kn[1]; const float bound = sqrtf(qn2 * kn2) * 1.02f + (cref - cum[64 * lane + 63]) * LOG2E - mmin; skip = bound < -152.f; }
            const u64 drop = prune_consensus(skip, (LAS u64*)(cum + 4096 + 16), wave, lane);
            const u64 tm2 = low & ~drop;
            if (tm2) attn_core<64, 1, true, false>(L, Kp, nullptr, Vp, cum, cref, Qf, tm2, t_lane, tw0, 1 << 30, 0.f, 0u, 0u, O, M, Ls, tid, true);
        }
    }
#else
    attn_core2<true, false>(L, (const bf16*)(ws + WS_FQKV) + 8 * MiB + (size_t)bh * T_ * 64, (const bf16*)(ws + WS_FQKV) + 16 * MiB + (size_t)bh * T_ * 64, cum, cum[256 * qb],
                            Qf[0], tm, t_lane, tw0, 1 << 30, 0.f, 0u, 0u, O[0], M[0], Ls[0], tid);
#endif
    const float lt = swap_sum(Ls[0]), inv = lt > 0.f ? 1.f / lt : 0.f;
    bf16* dst = (bf16*)(ws + WS_ATT) + mix_off((size_t)b * T_ + t_lane, 512 + hd * 64 + 4 * h, 1024);
    ATTN_FOR_CHUNKS(db, g4) { const unsigned w0 = cvtpk(O[0][db][4 * g4 + 0] * inv, O[0][db][4 * g4 + 1] * inv), w1 = cvtpk(O[0][db][4 * g4 + 2] * inv, O[0][db][4 * g4 + 3] * inv);
        *(u64*)(dst + (4 * db + g4) * 256) = (u64)w0 | ((u64)w1 << 32); }
}
__device__ __forceinline__ void U_diff(KP p_, int bh_, int qb_, int l_) {
    const KP p = uni_kp(p_); const int bh = __builtin_amdgcn_readfirstlane(bh_), qb = __builtin_amdgcn_readfirstlane(qb_), l = __builtin_amdgcn_readfirstlane(l_);
    int tid_ = threadIdx.x; asm volatile("" : "+v"(tid_));
    const int tid = tid_, lane = tid & 63, wave = __builtin_amdgcn_readfirstlane(tid >> 6), r = lane & 31, h = lane >> 5;
    unsigned char* ws = p->ws; asm volatile("" : "+s"(ws)); LAS unsigned char* L = (LAS unsigned char*)lds_raw;
    const int tw0 = 256 * qb + 32 * wave, t_lane = tw0 + r, b = bh >> 2, hd = bh & 3;
    const bf16* DQ = (const bf16*)(ws + WS_DQK); const bf16* DK = DQ + 8 * MiB;
    bf16x8v Qf[2][2];
#pragma unroll
    for (int mp = 0; mp < 2; ++mp)
#pragma unroll
        for (int s = 0; s < 2; ++s) Qf[mp][s] = *(const bf16x8v*)(DQ + ((size_t)(bh * 2 + mp) * T_ + t_lane) * 32 + 16 * s + 8 * h);
    f32x16 O[2][2]; float M[2] = {0.f, 0.f}, Ls[2] = {0.f, 0.f};
#pragma unroll
    for (int i = 0; i < 16; ++i) { O[0][0][i] = 0.f; O[0][1][i] = 0.f; O[1][0][i] = 0.f; O[1][1][i] = 0.f; }
    const u64 tm = (qb == 15) ? ~0ull : ((1ull << (4 * qb + 4)) - 1ull);
    {
        const u64 low = (1ull << (4 * qb)) - 1ull; const float slope2 = alibi_slope(hd + 1, 4) * LOG2E;
        const bf16* K0 = DK + (size_t)(bh * 2 + 0) * T_ * 32; const bf16* K1 = DK + (size_t)(bh * 2 + 1) * T_ * 32; const bf16* Vp = (const bf16*)(ws + WS_DV) + (size_t)bh * T_ * 64;
        attn_core<32, 2, false, false>(L, K0, K1, Vp, nullptr, 0.f, Qf, tm & ~low, t_lane, tw0, 1 << 30, slope2, 0u, 0u, O, M, Ls, tid);
        if (qb > 0) {
            const float qa = q_norm2_max<2>(Qf[0], lane), qb2 = q_norm2_max<2>(Qf[1], lane), ma = wave_min_l(M[0], lane), mb = wave_min_l(M[1], lane);
            const float* kn = (const float*)((const unsigned*)(ws + WS_CTL) + CW_KN + l * 8192 + 4096) + (size_t)(bh * 2) * 64 + lane;
            bool skip = false;
            if (lane < 4 * qb) { const float bmax = slope2 * (float)(64 * lane + 63 - tw0);
                skip = (sqrtf(qa * kn[0]) * 1.02f + bmax - ma < -152.f) && (sqrtf(qb2 * kn[64]) * 1.02f + bmax - mb < -152.f); }
            const u64 drop = prune_consensus(skip, (LAS u64*)(L + A_LDS_END), wave, lane);
            const u64 tm2 = low & ~drop;
            if (tm2) attn_core<32, 2, false, false>(L, K0, K1, Vp, nullptr, 0.f, Qf, tm2, t_lane, tw0, 1 << 30, slope2, 0u, 0u, O, M, Ls, tid, true);
        }
    }
    const float* lam = p->in[11] + (size_t)l * 128; const float* subln = p->in[12] + (size_t)l * 64;
    float l1 = 0.f, l2 = 0.f; if (lane < 32) { l1 = lam[lane] * lam[32 + lane]; l2 = lam[64 + lane] * lam[96 + lane]; }
    const float li = lambda_init_of(l), lam_full = __expf(wave_sum_l(l1, lane)) - __expf(wave_sum_l(l2, lane)) + li;
    const float lt0 = swap_sum(Ls[0]), lt1 = swap_sum(Ls[1]), i0 = lt0 > 0.f ? 1.f / lt0 : 0.f, i1 = (lt1 > 0.f ? 1.f / lt1 : 0.f) * lam_full;
    float ss = 0.f;
#pragma unroll
    for (int db = 0; db < 2; ++db)
#pragma unroll
        for (int i = 0; i < 16; ++i) { const float o = O[0][db][i] * i0 - O[1][db][i] * i1; O[0][db][i] = o; ss += o * o; }
    ss = swap_sum(ss);
    const float rn = rsqrtf(ss * (1.f / 64.f) + EPS) * (1.f - li);
    bf16* dst = (bf16*)(ws + WS_ATT) + mix_off((size_t)b * T_ + t_lane, 768 + hd * 64 + 4 * h, 1024);
    ATTN_FOR_CHUNKS(db, g4) { const f32x4 sg = *(const f32x4*)(subln + 32 * db + 8 * g4 + 4 * h);
        const unsigned w0 = cvtpk(O[0][db][4 * g4 + 0] * rn * sg.x, O[0][db][4 * g4 + 1] * rn * sg.y), w1 = cvtpk(O[0][db][4 * g4 + 2] * rn * sg.z, O[0][db][4 * g4 + 3] * rn * sg.w);
        *(u64*)(dst + (4 * db + g4) * 256) = (u64)w0 | ((u64)w1 << 32); }
}
__device__ __forceinline__ void U_win(KP p_, int bg_, int c_) {
    const KP p = uni_kp(p_); const int bg = __builtin_amdgcn_readfirstlane(bg_), cc = __builtin_amdgcn_readfirstlane(c_);
    int tid_ = threadIdx.x; asm volatile("" : "+v"(tid_));
    const int tid = tid_, lane = tid & 63, wave = __builtin_amdgcn_readfirstlane(tid >> 6), r = lane & 31, h = lane >> 5;
    unsigned char* ws = p->ws; asm volatile("" : "+s"(ws)); LAS unsigned char* L = (LAS unsigned char*)lds_raw;
    const int b = bg >> 1, g = bg & 1, hd = g * 4 + (wave >> 1), tw0 = 64 * cc + 32 * (wave & 1), t_lane = tw0 + r;
    const bf16* q = (const bf16*)(ws + WS_QN) + (size_t)(b * 8 + hd) * T_ * 64 + (t_lane >> 4) * 1024 + (t_lane & 15) * 32 + 8 * h;
    bf16x8v Qf[1][4];
#pragma unroll
    for (int s = 0; s < 4; ++s) Qf[0][s] = *(const bf16x8v*)(q + (s >> 1) * 512 + (s & 1) * 16);
    f32x16 O[1][2]; float M[1] = {0.f}, Ls[1] = {0.f};
#pragma unroll
    for (int i = 0; i < 16; ++i) { O[0][0][i] = 0.f; O[0][1][i] = 0.f; }
    const size_t n = (size_t)b * T_ + t_lane;
    const float gate_w = ((const float*)(ws + WS_GATE))[n * 24 + hd * 3 + 2];
    const int jlo = cc > 8 ? cc - 8 : 0;
    const u64 hi = (cc == 63) ? ~0ull : ((1ull << (cc + 1)) - 1ull), tm = hi & ~((1ull << jlo) - 1ull);
#if AC2_MODE == 0
    attn_core<64, 1, false, false>(L, (const bf16*)(ws + WS_KV6 + 4 * KV6_STRIDE) + (size_t)bg * T_ * 64, nullptr, (const bf16*)(ws + WS_KV6 + 5 * KV6_STRIDE) + (size_t)bg * T_ * 64, nullptr, 0.f,
                                   Qf, tm, t_lane, tw0, 512, alibi_slope(hd + 1, 8) * LOG2E, 0u, 0u, O, M, Ls, tid);
#ifdef PROBE_WINCORE2
    attn_core<64, 1, false, false>(L, (const bf16*)(ws + WS_KV6 + 4 * KV6_STRIDE) + (size_t)bg * T_ * 64, nullptr, (const bf16*)(ws + WS_KV6 + 5 * KV6_STRIDE) + (size_t)bg * T_ * 64, nullptr, 0.f,
                                   Qf, tm, t_lane, tw0, 512, alibi_slope(hd + 1, 8) * LOG2E, 0u, 0u, O, M, Ls, tid, true);
#endif
#else
    attn_core2<false, false>(L, (const bf16*)(ws + WS_KV6 + 4 * KV6_STRIDE) + (size_t)bg * T_ * 64, (const bf16*)(ws + WS_KV6 + 5 * KV6_STRIDE) + (size_t)bg * T_ * 64, nullptr, 0.f,
                             Qf[0], tm, t_lane, tw0, 512, alibi_slope(hd + 1, 8) * LOG2E, 0u, 0u, O[0], M[0], Ls[0], tid);
#endif
    const float lt = swap_sum(Ls[0]), inv = (lt > 0.f ? 1.f / lt : 0.f) * gate_w;
    bf16* dst = (bf16*)(ws + WS_OWIN) + mix_off(n, hd * 64 + 4 * h, 512);
    ATTN_FOR_CHUNKS(db, g4) { const unsigned w0 = cvtpk(O[0][db][4 * g4 + 0] * inv, O[0][db][4 * g4 + 1] * inv), w1 = cvtpk(O[0][db][4 * g4 + 2] * inv, O[0][db][4 * g4 + 3] * inv);
        *(u64*)(dst + (4 * db + g4) * 256) = (u64)w0 | ((u64)w1 << 32); }
}
__device__ __forceinline__ void U_slc(KP p_, int bg_, int c_) {
    const KP p = uni_kp(p_); const int bg = __builtin_amdgcn_readfirstlane(bg_), cc = __builtin_amdgcn_readfirstlane(c_);
    int tid_ = threadIdx.x; asm volatile("" : "+v"(tid_));
    const int tid = tid_, lane = tid & 63, wave = __builtin_amdgcn_readfirstlane(tid >> 6), r = lane & 31, h = lane >> 5;
    unsigned char* ws = p->ws; asm volatile("" : "+s"(ws)); LAS unsigned char* L = (LAS unsigned char*)lds_raw;
    const int b = bg >> 1, g = bg & 1, hd = g * 4 + (wave >> 1), tw0 = 64 * cc + 32 * (wave & 1), t_lane = tw0 + r;
    const bf16* q = (const bf16*)(ws + WS_QN) + (size_t)(b * 8 + hd) * T_ * 64 + (t_lane >> 4) * 1024 + (t_lane & 15) * 32 + 8 * h;
    bf16x8v Qf[1][4];
#pragma unroll
    for (int s = 0; s < 4; ++s) Qf[0][s] = *(const bf16x8v*)(q + (s >> 1) * 512 + (s & 1) * 16);
    f32x16 O[1][2]; float M[1] = {0.f}, Ls[1] = {0.f};
#pragma unroll
    for (int i = 0; i < 16; ++i) { O[0][0][i] = 0.f; O[0][1][i] = 0.f; }
    const bf16* Ksl = (const bf16*)(ws + WS_KV6 + 2 * KV6_STRIDE) + (size_t)bg * T_ * 64; const bf16* Vsl = (const bf16*)(ws + WS_KV6 + 3 * KV6_STRIDE) + (size_t)bg * T_ * 64;
    u32x4 kpre, vpre; attn_preload<64>(Ksl, nullptr, Vsl, cc, tid, kpre, vpre);
    const size_t n = (size_t)b * T_ + t_lane;
    const float gate_s = ((const float*)(ws + WS_GATE))[n * 24 + hd * 3 + 1];
    const bf16* oc = (const bf16*)(ws + WS_OCMP) + mix_off(n, hd * 64 + 4 * h, 512); const bf16* ow = (const bf16*)(ws + WS_OWIN) + mix_off(n, hd * 64 + 4 * h, 512);
    u64 ocv[8], owv[8];
    ATTN_FOR_CHUNKS(db, g4) { ocv[4 * db + g4] = *(const u64*)(oc + (4 * db + g4) * 256); owv[4 * db + g4] = *(const u64*)(ow + (4 * db + g4) * 256); }
    const u64* sel = (const u64*)(ws + WS_SEL) + (size_t)bg * T_;
    const u64 mine = sel[t_lane]; u64 un = sel[64 * cc + lane];
    { unsigned ul = (unsigned)un, uh = (unsigned)(un >> 32);
#pragma unroll
      for (int o = 1; o < 64; o <<= 1) { ul |= shflx_u(ul, o, lane); uh |= shflx_u(uh, o, lane); }
      un = ((u64)__builtin_amdgcn_readfirstlane(uh) << 32) | __builtin_amdgcn_readfirstlane(ul); }
#if AC2_MODE == 0
    attn_core<64, 1, false, true, true>(L, Ksl, nullptr, Vsl, nullptr, 0.f,
                                  Qf, un, t_lane, tw0, 1 << 30, alibi_slope(hd + 1, 8) * LOG2E, (unsigned)mine, (unsigned)(mine >> 32), O, M, Ls, tid, false, cc, kpre, vpre);
#else
    attn_core2<false, true>(L, (const bf16*)(ws + WS_KV6 + 2 * KV6_STRIDE) + (size_t)bg * T_ * 64, (const bf16*)(ws + WS_KV6 + 3 * KV6_STRIDE) + (size_t)bg * T_ * 64, nullptr, 0.f,
                            Qf[0], un, t_lane, tw0, 1 << 30, alibi_slope(hd + 1, 8) * LOG2E, (unsigned)mine, (unsigned)(mine >> 32), O[0], M[0], Ls[0], tid);
#endif
    const float lt = swap_sum(Ls[0]), inv = (lt > 0.f ? 1.f / lt : 0.f) * gate_s;
    bf16* dst = (bf16*)(ws + WS_ATT) + mix_off(n, hd * 64 + 4 * h, 1024);
    ATTN_FOR_CHUNKS(db, g4) { const u64 a = ocv[4 * db + g4], w = owv[4 * db + g4];
        const float x0 = O[0][db][4 * g4 + 0] * inv + __uint_as_float((unsigned)a << 16) + __uint_as_float((unsigned)w << 16);
        const float x1 = O[0][db][4 * g4 + 1] * inv + __uint_as_float((unsigned)a & 0xffff0000u) + __uint_as_float((unsigned)w & 0xffff0000u);
        const float x2 = O[0][db][4 * g4 + 2] * inv + __uint_as_float((unsigned)(a >> 32) << 16) + __uint_as_float((unsigned)(w >> 32) << 16);
        const float x3 = O[0][db][4 * g4 + 3] * inv + __uint_as_float((unsigned)(a >> 32) & 0xffff0000u) + __uint_as_float((unsigned)(w >> 32) & 0xffff0000u);
        *(u64*)(dst + (4 * db + g4) * 256) = (u64)cvtpk(x0, x1) | ((u64)cvtpk(x2, x3) << 32); }
}
__device__ __forceinline__ float other_half(float x, int h) { auto rr = __builtin_amdgcn_permlane32_swap(__float_as_uint(x), __float_as_uint(x), false, false); return __uint_as_float(h ? rr[0] : rr[1]); }
__device__ __forceinline__ int other_half_i(int x, int h) { auto rr = __builtin_amdgcn_permlane32_swap((unsigned)x, (unsigned)x, false, false); return (int)(h ? rr[0] : rr[1]); }
template <bool MASK>
__device__ __forceinline__ void cmp_scores(f32x16& p0, f32x16& p1, const LAS unsigned char* kt, const bf16x8v (&Qf)[4], float b0, float s1, int cl, int nvis_l) {
    const float s8 = s1 * 8.f, s32 = s1 * 32.f;
    p0[0] = b0; p0[1] = p0[0] + s1; p0[2] = p0[1] + s1; p0[3] = p0[2] + s1;
#pragma unroll
    for (int reg = 4; reg < 16; ++reg) p0[reg] = p0[reg - 4] + s8;
#pragma unroll
    for (int reg = 0; reg < 16; ++reg) p1[reg] = p0[reg] + s32;
#pragma unroll
    for (int s = 0; s < 4; ++s) { const bf16x8v kf0 = *(const LAS bf16x8v*)(kt + s * 32), kf1 = *(const LAS bf16x8v*)(kt + 32 * 144 + s * 32);
        p0 = __builtin_amdgcn_mfma_f32_32x32x16_bf16(kf0, Qf[s], p0, 0, 0, 0); p1 = __builtin_amdgcn_mfma_f32_32x32x16_bf16(kf1, Qf[s], p1, 0, 0, 0); }
    if (MASK) {
#pragma unroll
        for (int reg = 0; reg < 16; ++reg) { const int c = cl + crow0(reg); p0[reg] = (c < nvis_l) ? p0[reg] : -INFINITY; p1[reg] = (c + 32 < nvis_l) ? p1[reg] : -INFINITY; } }
}
__device__ __forceinline__ void U_cmp(KP p_, int bg_, int u_) {
    const KP p = uni_kp(p_); const int bg = __builtin_amdgcn_readfirstlane(bg_), uu = __builtin_amdgcn_readfirstlane(u_);
    int tid_ = threadIdx.x; asm volatile("" : "+v"(tid_));
    const int tid = tid_, lane = tid & 63, wave = __builtin_amdgcn_readfirstlane(tid >> 6), r = lane & 31, h = lane >> 5;
    unsigned char* ws = p->ws; asm volatile("" : "+s"(ws)); LAS unsigned char* L = (LAS unsigned char*)lds_raw;
    const int b = bg >> 1, g = bg & 1, tw0 = 32 * (uu + 16 * wave), t_lane = tw0 + r;
    { const bf16* kc = (const bf16*)(ws + WS_KVCMP) + (size_t)bg * 256 * 64; const bf16* vc = kc + 16 * 256 * 64;
#pragma unroll
      for (int i = 0; i < 4; ++i) { const int ch = tid + 512 * i, row = ch >> 3, c8 = ch & 7;
          *(LAS u32x4*)(L + row * 144 + c8 * 16) = *(const u32x4*)(kc + row * 64 + c8 * 8); *(LAS u32x4*)(L + 36864 + row * 144 + c8 * 16) = *(const u32x4*)(vc + row * 64 + c8 * 8); } }
    __syncthreads();
    const int nvis_l = t_lane >= 31 ? ((t_lane - 31) >> 4) + 1 : 0, nvis_max = (tw0 >> 4) + 1, nvis_min = tw0 >= 31 ? ((tw0 - 31) >> 4) + 1 : 0, ntile = (nvis_max + 63) >> 6;
    const LAS unsigned char* kfrag = L + r * 144 + h * 16;
    const LAS unsigned char* vfrag = L + 36864 + (4 * h + ((lane & 15) >> 2)) * 144 + (16 * ((lane >> 4) & 1) + 4 * (lane & 3)) * 2;
    float imp[32];
#pragma unroll
    for (int e = 0; e < 32; ++e) imp[e] = 0.f;
    const float* gate = (const float*)(ws + WS_GATE) + ((size_t)b * T_ + t_lane) * 24;
#pragma unroll 1
    for (int hg = 0; hg < 4; ++hg) {
        const int hd = g * 4 + hg; const float s1 = alibi_slope(hd + 1, 8) * LOG2E * 16.f;
        const bf16* q = (const bf16*)(ws + WS_QN) + (size_t)(b * 8 + hd) * T_ * 64 + (t_lane >> 4) * 1024 + (t_lane & 15) * 32 + 8 * h;
        bf16x8v Qf[4];
#pragma unroll
        for (int s = 0; s < 4; ++s) Qf[s] = *(const bf16x8v*)(q + (s >> 1) * 512 + (s & 1) * 16);
        float m = -1e30f, lsum = 0.f;
#pragma unroll 1
        for (int jt = 0; jt < ntile; ++jt) {
            f32x16 p0, p1; const float b0 = s1 * (float)(64 * jt + 4 * h - nvis_max);
            if (64 * jt + 63 >= nvis_min) cmp_scores<true>(p0, p1, kfrag + jt * (64 * 144), Qf, b0, s1, 64 * jt + 4 * h, nvis_l);
            else cmp_scores<false>(p0, p1, kfrag + jt * (64 * 144), Qf, b0, s1, 64 * jt + 4 * h, nvis_l);
            float mt = fmaxf(p0[0], p1[0]);
#pragma unroll
            for (int reg = 1; reg < 16; ++reg) mt = fmaxf(mt, fmaxf(p0[reg], p1[reg]));
            mt = swap_max(mt);
            const float mn = fmaxf(m, mt); float rs = 0.f;
#pragma unroll
            for (int reg = 0; reg < 16; ++reg) rs += __builtin_amdgcn_exp2f(p0[reg] - mn) + __builtin_amdgcn_exp2f(p1[reg] - mn);
            lsum = lsum * __builtin_amdgcn_exp2f(m - mn) + rs; m = mn;
        }
        const float lt = swap_sum(lsum), inv = lt > 0.f ? 1.f / lt : 0.f;
        f32x16 O0, O1;
#pragma unroll
        for (int i = 0; i < 16; ++i) { O0[i] = 0.f; O1[i] = 0.f; }
        float carry = 0.f;
#pragma unroll
        for (int jt = 0; jt < 4; ++jt) if (jt < ntile) {
            f32x16 p0, p1; const float b0 = s1 * (float)(64 * jt + 4 * h - nvis_max);
            if (64 * jt + 63 >= nvis_min) cmp_scores<true>(p0, p1, kfrag + jt * (64 * 144), Qf, b0, s1, 64 * jt + 4 * h, nvis_l);
            else cmp_scores<false>(p0, p1, kfrag + jt * (64 * 144), Qf, b0, s1, 64 * jt + 4 * h, nvis_l);
#pragma unroll
            for (int reg = 0; reg < 16; ++reg) { p0[reg] = __builtin_amdgcn_exp2f(p0[reg] - m) * inv; p1[reg] = __builtin_amdgcn_exp2f(p1[reg] - m) * inv; }
            float cv[8];
#pragma unroll
            for (int g4 = 0; g4 < 4; ++g4) { const float h0 = 0.5f * p0[4 * g4 + 3], h1 = 0.5f * p1[4 * g4 + 3];
                imp[jt * 8 + g4] += ((p0[4 * g4] + p0[4 * g4 + 1]) + p0[4 * g4 + 2]) + h0; imp[jt * 8 + 4 + g4] += ((p1[4 * g4] + p1[4 * g4 + 1]) + p1[4 * g4 + 2]) + h1;
                cv[g4] = h0; cv[4 + g4] = h1; }
            float prev = carry;
#pragma unroll
            for (int k = 0; k < 8; ++k) { const float sv = other_half(cv[k], h); imp[jt * 8 + k] += h ? sv : prev; prev = sv; }
            carry = prev;
            const bf16x8v pa0 = pack8(p0, 0), pa1 = pack8(p0, 8), pa2 = pack8(p1, 0), pa3 = pack8(p1, 8);
            const LAS unsigned char* vb = vfrag + jt * (64 * 144);
#pragma unroll
            for (int ks = 0; ks < 4; ++ks) { const bf16x8v pa = ks == 0 ? pa0 : ks == 1 ? pa1 : ks == 2 ? pa2 : pa3;
                { const s16x4 lo = tr_read(vb + ks * (16 * 144)), hi = tr_read(vb + ks * (16 * 144) + 8 * 144); const bf16x8v vf = {lo[0], lo[1], lo[2], lo[3], hi[0], hi[1], hi[2], hi[3]};
                  O0 = __builtin_amdgcn_mfma_f32_32x32x16_bf16(vf, pa, O0, 0, 0, 0); }
                { const s16x4 lo = tr_read(vb + ks * (16 * 144) + 64), hi = tr_read(vb + ks * (16 * 144) + 64 + 8 * 144); const bf16x8v vf = {lo[0], lo[1], lo[2], lo[3], hi[0], hi[1], hi[2], hi[3]};
                  O1 = __builtin_amdgcn_mfma_f32_32x32x16_bf16(vf, pa, O1, 0, 0, 0); } }
        }
        const float gt = gate[hd * 3 + 0];
        bf16* dst = (bf16*)(ws + WS_OCMP) + mix_off((size_t)b * T_ + t_lane, hd * 64 + 4 * h, 512);
#pragma unroll
        for (int g4 = 0; g4 < 4; ++g4) {
            *(u64*)(dst + g4 * 256) = (u64)cvtpk(O0[4 * g4 + 0] * gt, O0[4 * g4 + 1] * gt) | ((u64)cvtpk(O0[4 * g4 + 2] * gt, O0[4 * g4 + 3] * gt) << 32);
            *(u64*)(dst + (4 + g4) * 256) = (u64)cvtpk(O1[4 * g4 + 0] * gt, O1[4 * g4 + 1] * gt) | ((u64)cvtpk(O1[4 * g4 + 2] * gt, O1[4 * g4 + 3] * gt) << 32); }
    }
    const int cur = tw0 >> 6; u64 mask;
    if (cur <= 15) mask = (1ull << (cur + 1)) - 1ull;
    else {
        mask = 1ull | (1ull << cur) | (1ull << (cur - 1));
#pragma unroll
        for (int e = 0; e < 32; ++e) { const int j = 2 * e + h; if (j > cur || j == 0 || j >= cur - 1) imp[e] = -INFINITY; }
#pragma unroll 1
        for (int round = 0; round < 13; ++round) {
            float bv = imp[0]; int be = 0;
#pragma unroll
            for (int e = 1; e < 32; ++e) if (imp[e] > bv) { bv = imp[e]; be = e; }
            const int bj = 2 * be + h; const float ov = other_half(bv, h); const int oj = other_half_i(bj, h);
            const bool mine = bv > ov || (bv == ov && bj < oj);
            mask |= 1ull << (mine ? bj : oj);
#pragma unroll
            for (int e = 0; e < 32; ++e) imp[e] = (mine && e == be) ? -INFINITY : imp[e];
        }
    }
    if (h == 0) ((u64*)(ws + WS_SEL))[(size_t)bg * T_ + t_lane] = mask;
    __syncthreads();
}
constexpr int CONV_UNITS = L_ * NEXP * (2 * 16 * 8 + 4 * 32) / 32;
__device__ __forceinline__ void U_conv(KP p_, int k_) {
    const KP p = uni_kp(p_); const int k = __builtin_amdgcn_readfirstlane(k_);
    int tid_ = threadIdx.x; asm volatile("" : "+v"(tid_));
    const int tid = tid_, lane = tid & 63, wave = __builtin_amdgcn_readfirstlane(tid >> 6);
    unsigned char* ws = p->ws; asm volatile("" : "+s"(ws));
    LAS float* scr = (LAS float*)lds_raw + wave * (64 * 33);
    constexpr int I_G = 16 * 8, I_D = 4 * 32, I_E = 2 * I_G + I_D;
#pragma unroll 1
    for (int i = 0; i < 4; ++i) {
        const int m = k * 32 + i * 8 + wave, l = m / (NEXP * I_E); int r = m % (NEXP * I_E); const int e = r / I_E; r = r % I_E; const size_t le = (size_t)l * NEXP + e;
        const float* W; bf16* WT; int ldw, K, ncol, r0 = 0, rmul = 1; const float* gk = nullptr;
        if (r < 2 * I_G) { const int up = r >= I_G; r -= up * I_G; W = p->in[19 + up] + le * D_ * DEXP; WT = (bf16*)(ws + WS_WGU_T) + le * 512 * D_; ldw = DEXP; K = D_; ncol = 256; r0 = up; rmul = 2; gk = p->in[14] + (size_t)l * D_; }
        else { r -= 2 * I_G; W = p->in[21] + le * DEXP * D_; WT = (bf16*)(ws + WS_WD_T) + le * D_ * DEXP; ldw = D_; K = DEXP; ncol = 1024; }
        transpose_seg(W, ldw, K, 0, ncol, WT, r0, rmul, r, scr, lane, gk);
    }
}
__device__ __forceinline__ int fetch_unit(KP p, int qidx) {
    volatile LAS unsigned* slot = (volatile LAS unsigned*)((LAS unsigned char*)lds_raw + MISC_OFF) + 16;
    __syncthreads();
    int t0_ = threadIdx.x; asm volatile("" : "+v"(t0_));
    if (t0_ == 0) *slot = __hip_atomic_fetch_add((unsigned*)(p->ws + WS_CTL) + CW_QUEUE + 64 * qidx, 1u, __ATOMIC_RELAXED, __HIP_MEMORY_SCOPE_AGENT);
    __syncthreads();
    return (int)__builtin_amdgcn_readfirstlane(*slot);
}
__device__ __forceinline__ void P_cmp1_mfma(int l_) { const KP p = (KP)__builtin_amdgcn_kernarg_segment_ptr(); int l = l_; asm volatile("" : "+s"(l));
    unsigned char* ws = p->ws; asm volatile("" : "+s"(ws)); const int c = launder_s((int)blockIdx.x), kv = c >> 4, pm = c & 15;
    OneUnitOrder S; S.has = c < 32; S.u.pm = pm; S.u.pn = kv;
    S.u.a = (const char*)(ws + WS_KV6 + (size_t)kv * KV6_STRIDE) + (size_t)pm * 256 * 1024 * 2; S.u.b = (const char*)((const bf16*)(ws + WS_W1_T) + ((size_t)l * 2 + kv) * 256 * 2048); S.u.b2 = S.u.b;
    const pg8::Gemm g{1024, 2048, 2048, 32, 0, 0};
    const EpiCmpH E{(bf16*)(ws + WS_HC), (const float*)(ws + WS_BIAS1) + l * 512};
    pg8::gemm_phase<EpiCmpH, OneUnitOrder, false, true>((LAS unsigned char*)lds_raw, g, S, E);
}
__device__ __forceinline__ void P_cmp2_mfma(int l_) { const KP p = (KP)__builtin_amdgcn_kernarg_segment_ptr(); int l = l_; asm volatile("" : "+s"(l));
    unsigned char* ws = p->ws; asm volatile("" : "+s"(ws)); const int c = launder_s((int)blockIdx.x), kv = c >> 4, pm = c & 15;
    OneUnitOrder S; S.has = c < 32; S.u.pm = pm; S.u.pn = kv;
    S.u.a = (const char*)((const bf16*)(ws + WS_HC) + ((size_t)kv * 4096 + pm * 256) * 256); S.u.b = (const char*)((const bf16*)(ws + WS_W2_T) + ((size_t)l * 2 + kv) * 64 * 256); S.u.b2 = S.u.b;
    const pg8::Gemm g{256, 256, 256, 4, 0, 0};
    const EpiCmpOut E{(bf16*)(ws + WS_KVCMP)};
    pg8::gemm_phase<EpiCmpOut, OneUnitOrder, false, true>((LAS unsigned char*)lds_raw, g, S, E);
}
__device__ __forceinline__ void P_moe_scatter(KP p_, int l_) { const KP p = uni_kp(p_); const int l = __builtin_amdgcn_readfirstlane(l_); const Ctx c = make_ctx(p); unsigned char* ws = p->ws;
    const unsigned* cnt = (const unsigned*)(ws + WS_CTL) + CW_MOECNT + l * MOE_LS;
    moe_build_tables(cnt, c.tid);
    const LAS int* T = (const LAS int*)((LAS unsigned char*)lds_raw + TBL_OFF);
    const unsigned* info = (const unsigned*)(ws + WS_ROUTE + RT_INFO); const float* tw = (const float*)(ws + WS_ROUTE + RT_W);
    int* rowtok = (int*)(ws + WS_ROUTE + RT_ROWTOK); float* roww = (float*)(ws + WS_ROUTE + RT_ROWW);
    bf16* xs = (bf16*)(ws + WS_XS); const bf16* x = (const bf16*)(ws + WS_HN); const float* gain = p->in[14] + (size_t)l * D_; const float* rstdv = (const float*)(ws + WS_ROUTE + RT_RSTD);
    { constexpr int RB = 4; float gg[2][8];
#pragma unroll
      for (int j = 0; j < 2; ++j) { const f32x4 a = ((const f32x4*)gain)[2 * c.lane + 128 * j], b2 = ((const f32x4*)gain)[2 * c.lane + 128 * j + 1]; gg[j][0] = a.x; gg[j][1] = a.y; gg[j][2] = a.z; gg[j][3] = a.w; gg[j][4] = b2.x; gg[j][5] = b2.y; gg[j][6] = b2.z; gg[j][7] = b2.w; }
      for (int row0 = c.gw * RB; row0 < NT; row0 += c.ngw * RB) {
        u32x4 vv[RB][2];
#pragma unroll
        for (int q = 0; q < RB; ++q)
#pragma unroll
            for (int j = 0; j < 2; ++j) vv[q][j] = ((const u32x4*)(x + (size_t)(row0 + q) * D_))[c.lane + 64 * j];
#pragma unroll
        for (int q = 0; q < RB; ++q) { const int row = row0 + q;
            const unsigned v = info[row]; const int cls = (int)(v >> 24), rank = (int)(v & 0xffffffu); const size_t dest = (size_t)T[cls] * 256 + rank; const float r = rstdv[row];
#pragma unroll
            for (int j = 0; j < 2; ++j) { float f[8]; unpack8(vv[q][j], f); u32x4 o; o.x = pk2(f[0] * r * gg[j][0], f[1] * r * gg[j][1]); o.y = pk2(f[2] * r * gg[j][2], f[3] * r * gg[j][3]); o.z = pk2(f[4] * r * gg[j][4], f[5] * r * gg[j][5]); o.w = pk2(f[6] * r * gg[j][6], f[7] * r * gg[j][7]);
                ((u32x4*)(xs + dest * D_))[c.lane + 64 * j] = o; }
            if (c.lane == 0) { rowtok[dest] = row; roww[2 * dest] = tw[2 * row]; roww[2 * dest + 1] = tw[2 * row + 1]; } }
      } }
    for (int cls = c.bid; cls < 112; cls += c.G) { const int n = (int)cnt[cls * MOE_CS], end = (int)((cnt[cls * MOE_CS] + 255u) >> 8) * 256; const size_t base = (size_t)T[cls] * 256;
        for (int r = n + c.tid; r < end; r += NTHREADS) rowtok[base + r] = -1; }
}
__device__ __forceinline__ int xcd_major(int bid, int G) { bid = launder_s(bid); return (G & 7) ? bid : (bid & 7) * (G >> 3) + (bid >> 3); }
__device__ __forceinline__ void P_moe_g1(int l_) { const KP p = (KP)__builtin_amdgcn_kernarg_segment_ptr(); int l = l_; asm volatile("" : "+s"(l));
    unsigned char* ws = p->ws; asm volatile("" : "+s"(ws));
    { int t0_ = threadIdx.x; asm volatile("" : "+v"(t0_)); moe_build_tables((const unsigned*)(ws + WS_CTL) + CW_MOECNT + l * MOE_LS, t0_); }
    const MoeOrder1 S{(const char*)ws, (const unsigned*)(ws + WS_REC), (const char*)((const bf16*)(ws + WS_WGU_T) + (size_t)l * NEXP * 512 * D_), (unsigned*)(ws + WS_CTL) + CW_MOECNT + l * MOE_LS + (112 + NEXP) * MOE_CS, (int)gridDim.x, xcd_major((int)blockIdx.x, (int)gridDim.x)};
    const pg8::Gemm g{D_, D_, D_, D_ / 64, 0, 0};
    const EpiMoeH E{(bf16*)(ws + WS_HB), (const u32x4*)(ws + WS_REC)};
    pg8::gemm_phase<EpiMoeH, MoeOrder1, true, true, true>((LAS unsigned char*)lds_raw, g, S, E);
}
__device__ __forceinline__ void P_moe_g2(int l_) { const KP p = (KP)__builtin_amdgcn_kernarg_segment_ptr(); int l = l_; asm volatile("" : "+s"(l));
    unsigned char* ws = p->ws; asm volatile("" : "+s"(ws));
    { int t0_ = threadIdx.x; asm volatile("" : "+v"(t0_)); moe_build_tables((const unsigned*)(ws + WS_CTL) + CW_MOECNT + l * MOE_LS, t0_); }
    const MoeOrder2 S{(const char*)(ws + WS_HB), (const char*)((const bf16*)(ws + WS_WD_T) + (size_t)l * NEXP * D_ * DEXP), (const unsigned*)(ws + WS_CTL) + CW_MOECNT + l * MOE_LS + (112 + NEXP) * MOE_CS, (unsigned*)(ws + WS_CTL) + XB_TMO + 4096, (int)gridDim.x, xcd_major((int)blockIdx.x, (int)gridDim.x)};
    const pg8::Gemm g{512, DEXP, 512, 4, 16, 16};
    const EpiMoeOut E{(bf16*)(ws + WS_HN), (const unsigned*)(ws + WS_RECC)};
    pg8::gemm_phase<EpiMoeOut, MoeOrder2, true, true>((LAS unsigned char*)lds_raw, g, S, E);
}
__device__ __forceinline__ void P_norm1(KP p_, int l_) { const KP p = uni_kp(p_); const int l = __builtin_amdgcn_readfirstlane(l_); const Ctx c = make_ctx(p); const Bufs b = make_bufs(p->ws);
    if (l == 0) { const int i = c.bid * NTHREADS + c.tid; if (i < L_ * 2 * 256) { const float* part = (const float*)(p->ws + WS_B1PART) + (size_t)(i >> 8) * 128 * 256 + (i & 255); float a = 0.f;
        for (int k = 0; k < 128; ++k) a += part[(size_t)k * 256]; ((float*)(p->ws + WS_BIAS1))[i] = a; } }
    if (l == 0) ph_norm_bf16(c, p->in[0], p->in[1], (bf16*)p->out, (bf16*)(p->ws + WS_HN)); else ph_norm_bf16_from_bf16(c, (const bf16*)(p->ws + WS_HN), p->in[1] + (size_t)l * D_, (bf16*)p->out); }
__device__ __noinline__ void P_inproj(KP p_, int l_) { const KP p = uni_kp(p_); const int l = __builtin_amdgcn_readfirstlane(l_); const Ctx c = make_ctx(p); const Bufs b = make_bufs(p->ws);
    InProjOut o{b.QN, b.KV6, b.FQ, b.DQ, b.DV, b.GATE, b.FL, p->in[3] + l * 24, p->in[4] + l * 4};
    const bf16* A = b.HN;
    naive_gemm(c, NT, D_IN, D_, [=](int r, int k) { return bf2f(A[(size_t)r * D_ + k]); }, p->in[2] + (size_t)l * D_ * D_IN, D_IN,
               [=](int r, int col, float v) { inproj_store(o, r, col, v); }); }
__device__ __noinline__ void P_cmp1(KP p_, int l_, int kv_) { const KP p = uni_kp(p_); const int l = __builtin_amdgcn_readfirstlane(l_), kv = __builtin_amdgcn_readfirstlane(kv_); const Ctx c = make_ctx(p); const Bufs b = make_bufs(p->ws);
    const bf16* src = kv == 0 ? b.KC : b.VC; const float* pe = p->in[kv == 0 ? 5 : 8] + (size_t)l * 2048; bf16* hc = b.HC + (size_t)kv * 4096 * 256;
    naive_gemm(c, 4096, 256, 2048, [=](int r, int k) { return bf2f(src[(size_t)r * 1024 + k]) + pe[k]; }, p->in[kv == 0 ? 6 : 9] + (size_t)l * 2048 * 256, 256,
               [=](int r, int col, float v) { hc[(size_t)r * 256 + col] = (bf16)f2bf(gelu_tanh(v)); }); }
__device__ __noinline__ void P_cumsum(KP p_, int l_) { const KP p = uni_kp(p_); const int l = __builtin_amdgcn_readfirstlane(l_); const Ctx c = make_ctx(p); const Bufs b = make_bufs(p->ws); ph_cumsum(c, b.FL); }
__device__ __noinline__ void P_cmp2(KP p_, int l_, int kv_) { const KP p = uni_kp(p_); const int l = __builtin_amdgcn_readfirstlane(l_), kv = __builtin_amdgcn_readfirstlane(kv_); const Ctx c = make_ctx(p); const Bufs b = make_bufs(p->ws);
    const bf16* hc = b.HC + (size_t)kv * 4096 * 256; bf16* dst = kv == 0 ? b.KCMP : b.VCMP;
    naive_gemm(c, 4096, 64, 256, [=](int r, int k) { return bf2f(hc[(size_t)r * 256 + k]); }, p->in[kv == 0 ? 7 : 10] + (size_t)l * 256 * 64, 64,
               [=](int r, int col, float v) { dst[(size_t)r * 64 + col] = (bf16)f2bf((r & 255) == 255 ? 0.f : v); }); }
__device__ __noinline__ void P_win(KP p_, int l_) { const KP p = uni_kp(p_); const int l = __builtin_amdgcn_readfirstlane(l_); const Ctx c = make_ctx(p); const Bufs b = make_bufs(p->ws); ph_win_attn(c, b.QN, b.KW, b.VW, b.GATE, b.OWIN); }
__device__ __noinline__ void P_fox(KP p_, int l_) { const KP p = uni_kp(p_); const int l = __builtin_amdgcn_readfirstlane(l_); const Ctx c = make_ctx(p); const Bufs b = make_bufs(p->ws); ph_fox_attn(c, b.FQ, b.FK, b.FV, b.FL, b.ATT); }
__device__ __noinline__ void P_diff(KP p_, int l_) { const KP p = uni_kp(p_); const int l = __builtin_amdgcn_readfirstlane(l_); const Ctx c = make_ctx(p); const Bufs b = make_bufs(p->ws);
    ph_diff_attn(c, b.DQ, b.DK, b.DV, p->in[11] + (size_t)l * 128, p->in[12] + (size_t)l * 64, lambda_init_of(l), b.ATT); }
__device__ __noinline__ void P_cmpattn(KP p_, int l_) { const KP p = uni_kp(p_); const int l = __builtin_amdgcn_readfirstlane(l_); const Ctx c = make_ctx(p); const Bufs b = make_bufs(p->ws); ph_cmp_attn(c, b.QN, b.KCMP, b.VCMP, b.GATE, b.SEL, b.OCMP); }
__device__ __noinline__ void P_slc(KP p_, int l_) { const KP p = uni_kp(p_); const int l = __builtin_amdgcn_readfirstlane(l_); const Ctx c = make_ctx(p); const Bufs b = make_bufs(p->ws); ph_slc_attn(c, b.QN, b.KS, b.VS, b.GATE, b.SEL, b.OCMP, b.OWIN, b.ATT); }
__device__ __noinline__ void P_outproj(KP p_, int l_) { const KP p = uni_kp(p_); const int l = __builtin_amdgcn_readfirstlane(l_); const Ctx c = make_ctx(p); const Bufs b = make_bufs(p->ws);
    const bf16* A = b.ATT; float* xo = p->out; const float* xin = (l == 0) ? p->in[0] : p->out;
    naive_gemm(c, NT, D_, D_, [=](int r, int k) { return bf2f(A[(size_t)r * D_ + k]); }, p->in[13] + (size_t)l * D_ * D_, D_,
               [=](int r, int col, float v) { xo[(size_t)r * D_ + col] = xin[(size_t)r * D_ + col] + v; }); }
__device__ __forceinline__ void P_route3(int l_, int cbank) { const KP p = (KP)__builtin_amdgcn_kernarg_segment_ptr(); int l = l_; asm volatile("" : "+s"(l));
    int tid_ = threadIdx.x; asm volatile("" : "+v"(tid_));
    const int tid = tid_, lane = tid & 63, wave = __builtin_amdgcn_readfirstlane(tid >> 6), r = lane & 31, h = lane >> 5, kh = wave >> 2, wr = wave & 3;
    unsigned char* ws = p->ws; asm volatile("" : "+s"(ws)); const bf16* x = (const bf16*)(ws + WS_HN);
    const float* WR = (const float*)(ws + WS_WR) + (size_t)l * D_ * 64;
    LAS float* XT = (LAS float*)lds_raw + wave * (32 * 36);
    LAS float* WT = (LAS float*)lds_raw + 8 * 32 * 36 + kh * (2 * 32 * 64);
    LAS float* PL = (LAS float*)lds_raw + 8 * 32 * 36 + 2 * 2 * 32 * 64;
    LAS float* SS = PL + 2 * 128 * 40;
    const float* bgrp = p->in[16] + l * 4; const float* bexp = p->in[18] + l * 32;
    unsigned* cnt = (unsigned*)(ws + WS_CTL) + CW_MOECNT + l * MOE_LS + cbank;
    LAS unsigned* HIST = (LAS unsigned*)(SS + 2 * 128 * 2);
    for (int grp = launder_s((int)blockIdx.x); grp < NT / 128; grp += (int)gridDim.x) {
        const int row0 = grp * 128 + wr * 32;
        if (tid < 144) HIST[tid] = 0u;
        f32x16 acc0, acc1; float ss = 0.f;
#pragma unroll
        for (int i = 0; i < 16; ++i) { acc0[i] = 0.f; acc1[i] = 0.f; }
        { const u32x4* xsrc = (const u32x4*)(x + (size_t)(row0 + r) * D_ + kh * 512 + 8 * h);
          const u32x4* wsrc = (const u32x4*)(ws + WS_WR) + ((size_t)l * 64 + kh * 32) * 256 + lane;
#pragma unroll 4
          for (int ks = 0; ks < 32; ++ks) {
              const u32x4 av = xsrc[2 * ks], b0h = wsrc[ks * 256], b0l = wsrc[ks * 256 + 64], b1h = wsrc[ks * 256 + 128], b1l = wsrc[ks * 256 + 192];
              { float f_[8]; unpack8(av, f_);
#pragma unroll
                for (int e = 0; e < 8; ++e) ss = fmaf(f_[e], f_[e], ss); }
              const bf16x8v A = __builtin_bit_cast(bf16x8v, av);
              acc0 = __builtin_amdgcn_mfma_f32_32x32x16_bf16(A, __builtin_bit_cast(bf16x8v, b0h), acc0, 0, 0, 0); acc1 = __builtin_amdgcn_mfma_f32_32x32x16_bf16(A, __builtin_bit_cast(bf16x8v, b1h), acc1, 0, 0, 0);
              acc0 = __builtin_amdgcn_mfma_f32_32x32x16_bf16(A, __builtin_bit_cast(bf16x8v, b0l), acc0, 0, 0, 0); acc1 = __builtin_amdgcn_mfma_f32_32x32x16_bf16(A, __builtin_bit_cast(bf16x8v, b1l), acc1, 0, 0, 0);
          } }
#pragma unroll
        for (int reg = 0; reg < 16; ++reg) { const int row = wr * 32 + crow0(reg) + 4 * h; PL[(kh * 128 + row) * 40 + r] = acc0[reg]; if (r < 4) PL[(kh * 128 + row) * 40 + 32 + r] = acc1[reg]; }
        SS[(kh * 128 + wr * 32 + r) * 2 + h] = ss;
        __syncthreads();
        int cls = 0, ea = 0, eb = 0; unsigned lrank = 0u, lra = 0u, lrb = 0u; float wlo = 0.f, whi = 0.f, rstd = 0.f;
        if (tid < 128) {
            float lg[36];
#pragma unroll
            for (int cidx = 0; cidx < 36; ++cidx) lg[cidx] = PL[tid * 40 + cidx] + PL[(128 + tid) * 40 + cidx];
            const float sq = (SS[tid * 2] + SS[tid * 2 + 1]) + (SS[(128 + tid) * 2] + SS[(128 + tid) * 2 + 1]);
            rstd = rsqrtf(sq * (1.f / D_) + EPS);
            float gl[4]; int grp_i = 0;
#pragma unroll
            for (int q = 0; q < 4; ++q) gl[q] = lg[q] * rstd + bgrp[q];
            float gm = gl[0];
#pragma unroll
            for (int q = 1; q < 4; ++q) if (gl[q] > gm) { gm = gl[q]; grp_i = q; }
            float gs = 0.f;
#pragma unroll
            for (int q = 0; q < 4; ++q) gs += __expf(gl[q] - gm);
            const float grp_gate = 1.f / gs;
            float el[8];
#pragma unroll
            for (int q = 0; q < 8; ++q) { float v = lg[4 + q]; float bb = bexp[q];
                if (grp_i == 1) { v = lg[12 + q]; bb = bexp[8 + q]; } else if (grp_i == 2) { v = lg[20 + q]; bb = bexp[16 + q]; } else if (grp_i == 3) { v = lg[28 + q]; bb = bexp[24 + q]; }
                el[q] = v * rstd + bb; }
            int i0 = 0; float v0 = el[0];
#pragma unroll
            for (int q = 1; q < 8; ++q) if (el[q] > v0) { v0 = el[q]; i0 = q; }
            int i1 = -1; float v1 = -INFINITY;
#pragma unroll
            for (int q = 0; q < 8; ++q) if (q != i0 && el[q] > v1) { v1 = el[q]; i1 = q; }
            const float e1 = __expf(v1 - v0), den = 1.f + e1, w0 = grp_gate / den, w1 = grp_gate * e1 / den;
            const int lo = i0 < i1 ? i0 : i1, hi = i0 < i1 ? i1 : i0; cls = grp_i * 28 + lo * 8 - (lo * (lo + 1)) / 2 + (hi - lo - 1);
            wlo = i0 < i1 ? w0 : w1; whi = i0 < i1 ? w1 : w0;
            ea = grp_i * 8 + lo; eb = grp_i * 8 + hi;
            lrank = __hip_atomic_fetch_add(HIST + cls, 1u, __ATOMIC_RELAXED, __HIP_MEMORY_SCOPE_WORKGROUP);
            lra = __hip_atomic_fetch_add(HIST + 112 + ea, 1u, __ATOMIC_RELAXED, __HIP_MEMORY_SCOPE_WORKGROUP); lrb = __hip_atomic_fetch_add(HIST + 112 + eb, 1u, __ATOMIC_RELAXED, __HIP_MEMORY_SCOPE_WORKGROUP);
        }
        __syncthreads();
        if (tid < 144) { const unsigned n = HIST[tid]; if (n) HIST[144 + tid] = __hip_atomic_fetch_add(cnt + tid * MOE_CS, n, __ATOMIC_RELAXED, __HIP_MEMORY_SCOPE_AGENT); }
        __syncthreads();
        if (tid < 128) {
            const unsigned rank = HIST[144 + cls] + lrank, ra = HIST[144 + 112 + ea] + lra, rb = HIST[144 + 112 + eb] + lrb;
            const int row = grp * 128 + tid;
            ((unsigned*)(ws + WS_RECC))[(size_t)cls * 32768 + rank] = (unsigned)row;
            const unsigned info = ((unsigned)cls << 16) | rank;
            ((u32x4*)(ws + WS_REC))[(size_t)ea * 32768 + ra] = (u32x4){(unsigned)row, __float_as_uint(wlo), __float_as_uint(rstd), info};
            ((u32x4*)(ws + WS_REC))[(size_t)eb * 32768 + rb] = (u32x4){(unsigned)row, __float_as_uint(whi), __float_as_uint(rstd), info | 0x8000u};
        }
        __syncthreads();
    }
}
typedef float f32x8 __attribute__((ext_vector_type(8)));
__device__ __forceinline__ void P_route2(int l_, int cbank) { const KP p = (KP)__builtin_amdgcn_kernarg_segment_ptr(); int l = l_; asm volatile("" : "+s"(l));
    int tid_ = threadIdx.x; asm volatile("" : "+v"(tid_));
    const int tid = tid_, lane = tid & 63, wave = __builtin_amdgcn_readfirstlane(tid >> 6);
    unsigned char* ws = p->ws; asm volatile("" : "+s"(ws)); const float* x = p->out;
    const float* WR = (const float*)(ws + WS_WR) + (size_t)l * D_ * 40;
    LAS float* xt = (LAS float*)lds_raw + wave * (64 * 36);
    LAS float* part = (LAS float*)lds_raw;
    const float* bgrp = p->in[16] + l * 4; const float* bexp = p->in[18] + l * 32;
    unsigned* cnt = (unsigned*)(ws + WS_CTL) + CW_MOECNT + l * 128 + cbank;
    for (int grp = launder_s((int)blockIdx.x); grp < NT / 128; grp += (int)gridDim.x) {
        const int row0 = grp * 128 + (wave >> 2) * 64, kq = wave & 3;
        float acc[40]; float ss = 0.f;
#pragma unroll
        for (int cidx = 0; cidx < 40; ++cidx) acc[cidx] = 0.f;
#pragma unroll 1
        for (int kc = 0; kc < 8; ++kc) {
            const int k0 = kq * 256 + kc * 32;
#pragma unroll
            for (int i = 0; i < 8; ++i) { const int row = i * 8 + (lane >> 3), c4 = (lane & 7) * 4; *(LAS f32x4*)(xt + row * 36 + c4) = *(const f32x4*)(x + (size_t)(row0 + row) * D_ + k0 + c4); }
            float xr[32];
#pragma unroll
            for (int j = 0; j < 8; ++j) { const f32x4 t = *(const LAS f32x4*)(xt + lane * 36 + 4 * j); xr[4 * j] = t.x; xr[4 * j + 1] = t.y; xr[4 * j + 2] = t.z; xr[4 * j + 3] = t.w; }
            const float* wk = WR + (size_t)k0 * 40;
#pragma unroll
            for (int kk = 0; kk < 32; ++kk) {
                f32x8 w0, w1, w2, w3, w4;
                asm volatile("s_load_dwordx8 %0, %5, %6\n\ts_load_dwordx8 %1, %5, %7\n\ts_load_dwordx8 %2, %5, %8\n\ts_load_dwordx8 %3, %5, %9\n\ts_load_dwordx8 %4, %5, %10\n\ts_waitcnt lgkmcnt(0)"
                             : "=&s"(w0), "=&s"(w1), "=&s"(w2), "=&s"(w3), "=&s"(w4) : "s"(wk), "i"(kk * 160), "i"(kk * 160 + 32), "i"(kk * 160 + 64), "i"(kk * 160 + 96), "i"(kk * 160 + 128) : "memory");
                const float xv = xr[kk]; ss = fmaf(xv, xv, ss);
#pragma unroll
                for (int e = 0; e < 8; ++e) { acc[e] = fmaf(xv, w0[e], acc[e]); acc[8 + e] = fmaf(xv, w1[e], acc[8 + e]); acc[16 + e] = fmaf(xv, w2[e], acc[16 + e]); acc[24 + e] = fmaf(xv, w3[e], acc[24 + e]); }
#pragma unroll
                for (int e = 0; e < 4; ++e) acc[32 + e] = fmaf(xv, w4[e], acc[32 + e]);
            }
        }
        __syncthreads();
#pragma unroll
        for (int cidx = 0; cidx < 36; ++cidx) part[(wave * 64 + lane) * 37 + cidx] = acc[cidx];
        part[(wave * 64 + lane) * 37 + 36] = ss;
        __syncthreads();
        if (tid < 128) {
            const int rg = tid >> 6, rr = tid & 63; float lg[37];
#pragma unroll
            for (int cidx = 0; cidx < 37; ++cidx) lg[cidx] = ((part[((rg * 4 + 0) * 64 + rr) * 37 + cidx] + part[((rg * 4 + 1) * 64 + rr) * 37 + cidx]) + part[((rg * 4 + 2) * 64 + rr) * 37 + cidx]) + part[((rg * 4 + 3) * 64 + rr) * 37 + cidx];
            const float rstd = rsqrtf(lg[36] * (1.f / D_) + EPS);
            float gl[4]; int grp_i = 0;
#pragma unroll
            for (int q = 0; q < 4; ++q) gl[q] = lg[q] * rstd + bgrp[q];
            float gm = gl[0];
#pragma unroll
            for (int q = 1; q < 4; ++q) if (gl[q] > gm) { gm = gl[q]; grp_i = q; }
            float gs = 0.f;
#pragma unroll
            for (int q = 0; q < 4; ++q) gs += __expf(gl[q] - gm);
            const float grp_gate = 1.f / gs;
            float el[8];
#pragma unroll
            for (int q = 0; q < 8; ++q) { float v = lg[4 + q]; float bb = bexp[q];
                if (grp_i == 1) { v = lg[12 + q]; bb = bexp[8 + q]; } else if (grp_i == 2) { v = lg[20 + q]; bb = bexp[16 + q]; } else if (grp_i == 3) { v = lg[28 + q]; bb = bexp[24 + q]; }
                el[q] = v * rstd + bb; }
            int i0 = 0; float v0 = el[0];
#pragma unroll
            for (int q = 1; q < 8; ++q) if (el[q] > v0) { v0 = el[q]; i0 = q; }
            int i1 = -1; float v1 = -INFINITY;
#pragma unroll
            for (int q = 0; q < 8; ++q) if (q != i0 && el[q] > v1) { v1 = el[q]; i1 = q; }
            const float e1 = __expf(v1 - v0), den = 1.f + e1, w0 = grp_gate / den, w1 = grp_gate * e1 / den;
            const int lo = i0 < i1 ? i0 : i1, hi = i0 < i1 ? i1 : i0, cls = grp_i * 28 + lo * 8 - (lo * (lo + 1)) / 2 + (hi - lo - 1);
            const unsigned rank = __hip_atomic_fetch_add(cnt + cls, 1u, __ATOMIC_RELAXED, __HIP_MEMORY_SCOPE_AGENT);
            const int row = grp * 128 + tid;
            ((unsigned*)(ws + WS_ROUTE + RT_INFO))[row] = ((unsigned)cls << 24) | rank;
            ((float*)(ws + WS_ROUTE + RT_W))[2 * row] = i0 < i1 ? w0 : w1; ((float*)(ws + WS_ROUTE + RT_W))[2 * row + 1] = i0 < i1 ? w1 : w0;
            ((float*)(ws + WS_ROUTE + RT_RSTD))[row] = rstd;
        }
        __syncthreads();
    }
}
__device__ __noinline__ void P_route(KP p_, int l_) { const KP p = uni_kp(p_); const int l = __builtin_amdgcn_readfirstlane(l_); const Ctx c = make_ctx(p); const Bufs b = make_bufs(p->ws);
    ph_moe_route(c, p->out, p->in[14] + (size_t)l * D_, p->in[15] + (size_t)l * D_ * 4, p->in[16] + l * 4, p->in[17] + (size_t)l * D_ * 32, p->in[18] + l * 32, b.HN, (int*)(p->ws + WS_ROUTE + RT_INFO), (float*)(p->ws + WS_ROUTE + RT_W), (unsigned*)(p->ws + WS_CTL) + CW_MOECNT + l * 128); }
__device__ __noinline__ void P_moe(KP p_, int l_) { const KP p = uni_kp(p_); const int l = __builtin_amdgcn_readfirstlane(l_); const Ctx c = make_ctx(p); const Bufs b = make_bufs(p->ws);
    ph_moe_naive(c, b.HN, b.ROUTE_E, b.ROUTE_W, p->in[19] + (size_t)l * NEXP * D_ * DEXP, p->in[20] + (size_t)l * NEXP * D_ * DEXP, p->in[21] + (size_t)l * NEXP * DEXP * D_, p->out); }
__device__ __noinline__ void P_final(KP p_) { const KP p = uni_kp(p_); const Ctx c = make_ctx(p); ph_norm_final_from_bf16(c, (const bf16*)(p->ws + WS_HN), p->in[22], p->out); }
__device__ __forceinline__ void P_gridbar(KP p_) { const KP p = uni_kp(p_);
    XcdBarrier bar; bar.bar = (unsigned*)(p->ws + WS_CTL) + 4096; bar.x = xb_xcc_id(); bar.st = (volatile LAS unsigned*)((LAS unsigned char*)lds_raw + MISC_OFF) + 8;
    xcd_barrier(bar);
}

__global__ void __launch_bounds__(NTHREADS, 2) fwd_kernel(Params pp) {
    const KP p = (KP)__builtin_amdgcn_kernarg_segment_ptr();
    { volatile LAS unsigned* MISC = (volatile LAS unsigned*)((LAS unsigned char*)lds_raw + MISC_OFF); if (threadIdx.x < 32) MISC[threadIdx.x] = 0u; }
    __syncthreads();
    const int lo = p->ph_lo, hi = p->ph_hi;
    if (hi - lo > 1) (void)xcd_barrier_post((unsigned*)(p->ws + WS_CTL) + 4096, (volatile LAS unsigned*)((LAS unsigned char*)lds_raw + MISC_OFF) + 8);
#define IN(k) (lo <= (k) && (k) < hi)
#define SEAM(k) do { if (IN(k) && IN((k) + 1)) P_gridbar(p); } while (0)
    if (IN(0)) { for (int rep = 0; rep < REP_PRO; ++rep) { if (rep) P_gridbar(p); P_prologue(p); } }
    SEAM(0);
    for (int l = 0; l < L_; ++l) {
        const int P0 = 1 + l * PH_PER_LAYER;
        if (IN(P0 + 0)) { for (int rep = 0; rep < REP_NORM; ++rep) { if (rep) P_gridbar(p); P_norm1(p, l); } }
        SEAM(P0 + 0);
        if (IN(P0 + 1)) { for (int rep = 0; rep < REP_INPROJ; ++rep) { if (rep) P_gridbar(p); P_inproj_mfma(l); }
#ifdef REP_INDUMMY
            for (int rep = 0; rep < REP_INDUMMY; ++rep) { P_gridbar(p); P_inproj_dummy(l); }
#endif
        }
        SEAM(P0 + 1);
        if (IN(P0 + 3)) {
            P_cmp1_mfma(l);
            if (launder_s((int)blockIdx.x) < 32) { asm volatile("s_waitcnt vmcnt(0)" ::: "memory"); __builtin_amdgcn_fence(__ATOMIC_SEQ_CST, "agent"); asm volatile("s_waitcnt vmcnt(0)" ::: "memory"); }
            __syncthreads();
            P_cmp2_mfma(l);
            for (int rep = 0; rep < REP_ATT3; ++rep) { if (rep) P_gridbar(p);
            for (;;) { int u = fetch_unit(p, l * 8 + 0 + 16 * rep);
                if (l == 0) {
                    if (u >= 2048 + CONV_UNITS) break;
                    const int k11 = u / 11, r11 = u - 11 * k11;
                    if (r11 == 3 || r11 == 7 || r11 == 10) { U_conv(p, 3 * k11 + (r11 > 3) + (r11 > 7)); continue; }
                    u = 8 * k11 + r11 - (r11 > 3) - (r11 > 7); }
                else if (u >= 2048) break;
                if (u < 1024) { const int qb = 15 - (u >> 6), k = u & 63; if (k < 32) U_diff(p, k, qb, l); else U_fox(p, k - 32, qb, l); }
                else { const int w = u - 1024; U_win(p, w & 15, 63 - (w >> 4));
#ifdef PROBE_WINUNIT2
                    U_win(p, w & 15, 63 - (w >> 4));
#endif
                } } } }
        SEAM(P0 + 3);
        if (IN(P0 + 4)) { for (int rep = 0; rep < REP_CMP; ++rep) { if (rep) P_gridbar(p); for (int u = launder_s((int)blockIdx.x); u < 256; u += (int)gridDim.x) U_cmp(p, u & 15, u >> 4); } }
        SEAM(P0 + 4);
        if (IN(P0 + 5)) { for (int rep = 0; rep < REP_SLC; ++rep) { if (rep) P_gridbar(p); for (;;) { const int u = fetch_unit(p, l * 8 + 1 + 16 * rep); if (u >= 1024) break; U_slc(p, u & 15, 63 - (u >> 4)); } } }
        SEAM(P0 + 5);
        if (IN(P0 + 6)) P_outproj_mfma(l);
        SEAM(P0 + 6);
        if (IN(P0 + 7)) { for (int rep = 0; rep < REP_ROUTE; ++rep) { if (rep) P_gridbar(p); P_route3(l, REP_ROUTE - 1 - rep); } }
        SEAM(P0 + 7);
        if (IN(P0 + 9)) { for (int rep = 0; rep < REP_G1; ++rep) { if (rep) P_gridbar(p); P_moe_g1(l); } }
        if (IN(P0 + 10)) P_moe_g2(l);
        SEAM(P0 + 10);
    }
    if (IN(1 + L_ * PH_PER_LAYER)) P_final(p);
#undef IN
#undef SEAM
}

extern "C" void kernel_launch(void* const* d_in, const int* in_sizes, int n_in, void* d_out, int out_size, void* d_ws, size_t ws_size, hipStream_t stream) {
    static int grid = 0;
    if (grid == 0) {
        if (n_in != 23 || out_size != NT * D_ || ws_size < WS_END) { fprintf(stderr, "kernel_launch: unexpected sizes n_in %d out %d ws %zu (need %zu)\n", n_in, out_size, ws_size, (size_t)WS_END); grid = -1; return; }
        int dev = 0, cus = 0, per_cu = 0;
        if (hipGetDevice(&dev) != hipSuccess || hipDeviceGetAttribute(&cus, hipDeviceAttributeMultiprocessorCount, dev) != hipSuccess) { grid = -1; return; }
        if (hipFuncSetAttribute((const void*)fwd_kernel, hipFuncAttributeMaxDynamicSharedMemorySize, LDS_BYTES) != hipSuccess) { fprintf(stderr, "kernel_launch: hipFuncSetAttribute failed\n"); grid = -1; return; }
        if (hipOccupancyMaxActiveBlocksPerMultiprocessor(&per_cu, (const void*)fwd_kernel, NTHREADS, LDS_BYTES) != hipSuccess || per_cu < 1) { fprintf(stderr, "kernel_launch: occupancy query says %d\n", per_cu); }
        (void)hipGetLastError();
        grid = cus;
    }
    if (grid < 0) return;
    (void)hipMemsetAsync((char*)d_ws + WS_CTL, 0, CTL_BYTES, stream);
    Params p{};
    for (int i = 0; i < 23; ++i) p.in[i] = (const float*)d_in[i];
    p.out = (float*)d_out; p.ws = (unsigned char*)d_ws;
#if N_LAUNCH_MODE == 0
    p.ph_lo = 0; p.ph_hi = N_PHASES;
    hipLaunchKernelGGL(fwd_kernel, dim3(grid), dim3(NTHREADS), LDS_BYTES, stream, p);
#else
    for (int k = 0; k < N_PHASES; ++k) { p.ph_lo = k; p.ph_hi = k + 1; hipLaunchKernelGGL(fwd_kernel, dim3(grid), dim3(NTHREADS), LDS_BYTES, stream, p); }
#endif
}
```

```cpp
#include <hip/hip_runtime.h>
#include <cstdio>
#include <cstdint>

#ifndef INPROJ_ALIGN
#define INPROJ_ALIGN true
#endif
#ifndef INPROJ_SP2
#define INPROJ_SP2 true
#endif
#ifndef REP_PRO
#define REP_PRO 1
#endif
#ifndef REP_ROUTE
#define REP_ROUTE 1
#endif
#ifndef REP_NORM
#define REP_NORM 1
#endif
#ifndef REP_INPROJ
#define REP_INPROJ 1
#endif
#ifndef REP_ATT3
#define REP_ATT3 1
#endif
#ifndef REP_CMP
#define REP_CMP 1
#endif
#ifndef REP_SLC
#define REP_SLC 1
#endif
#ifndef REP_SCAT
#define REP_SCAT 1
#endif
#ifndef REP_G1
#define REP_G1 1
#endif
#ifndef N_LAUNCH_MODE
#define N_LAUNCH_MODE 0
#endif

#ifndef NOMAX_ON
#define NOMAX_ON true
#endif
#define LAS __attribute__((address_space(3)))
#define GAS __attribute__((address_space(1)))
typedef unsigned short bf16;
typedef unsigned long long u64;
typedef float f32x4 __attribute__((ext_vector_type(4)));
typedef unsigned u32x4 __attribute__((ext_vector_type(4)));

constexpr int B_ = 8, T_ = 4096, D_ = 1024, NT = B_ * T_, L_ = 2;
constexpr int HD = 64, D_IN = 2844;
constexpr int N_CMP = 255, CMP_HID = 256;
constexpr int NEXP = 32, DEXP = 256;
constexpr float EPS = 1e-6f;
constexpr float LOG2E = 1.4426950408889634f;
constexpr int NWAVES = 8, NTHREADS = 512;

constexpr int C_NSAQ = 0, C_KV6 = 512, C_GATE = 1280, C_FQ = 1304, C_FF = 2072, C_DQ = 2076, C_DV = 2588;

constexpr size_t MiB = 1u << 20;
constexpr size_t WS_CTL = 0, CTL_BYTES = 1 * MiB;
constexpr size_t WS_QN = 1 * MiB;
constexpr size_t WS_KV6 = WS_QN + 32 * MiB;
constexpr size_t KV6_STRIDE = 8 * MiB + 64 * 1024;
constexpr size_t WS_FQKV = WS_KV6 + 6 * KV6_STRIDE;
constexpr size_t WS_DQK = WS_FQKV + 48 * MiB;
constexpr size_t WS_DV = WS_DQK + 32 * MiB;
constexpr size_t WS_GATE = WS_DV + 16 * MiB;
constexpr size_t WS_FL = WS_GATE + 3 * MiB;
constexpr size_t WS_HC = WS_FL + 1 * MiB;
constexpr size_t WS_KVCMP = WS_HC + 4 * MiB;
constexpr size_t WS_SEL = WS_KVCMP + 1 * MiB;
constexpr size_t WS_OCMP = WS_SEL + 1 * MiB;
constexpr size_t WS_OWIN = WS_OCMP + 32 * MiB;
constexpr size_t WS_HN = WS_OWIN + 32 * MiB;
constexpr size_t WS_ATT = WS_HN + 64 * MiB;
constexpr size_t WS_ROUTE = WS_ATT + 64 * MiB;
constexpr size_t WS_WIN_T = WS_ROUTE + 2 * MiB;
constexpr size_t WS_WOUT_T = WS_WIN_T + 12 * MiB;
constexpr size_t WS_WGU_T = WS_WOUT_T + 4 * MiB;
constexpr size_t WS_WD_T = WS_WGU_T + 64 * MiB;
constexpr size_t WS_W1_T = WS_WD_T + 32 * MiB;
constexpr size_t WS_W2_T = WS_W1_T + 4 * MiB;
constexpr size_t WS_BIAS1 = WS_W2_T + 512 * 1024;
constexpr size_t WS_WR = WS_BIAS1 + 512 * 1024;
constexpr size_t WS_B1PART = WS_WR + 512 * 1024;
constexpr size_t WS_END = WS_B1PART + 512 * 1024;
constexpr int MOE_MAXROWS = 61440;
constexpr size_t WS_XS = WS_QN;
constexpr size_t WS_HB = WS_OCMP;
static_assert(WS_XS + (size_t)MOE_MAXROWS * 2048 <= WS_DQK && WS_HB + (size_t)MOE_MAXROWS * 1024 <= WS_HN, "MoE aliases");
constexpr size_t RT_INFO = 0, RT_W = 128 * 1024, RT_ROWTOK = 384 * 1024, RT_ROWW = 640 * 1024, RT_RSTD = 1152 * 1024;
constexpr int CW_QUEUE = 16384, CW_MOECNT = 32768, CW_KN = 49152, MOE_CS = 32, MOE_LS = 8192;
constexpr size_t WS_REC = WS_QN;
constexpr size_t WS_RECC = WS_REC + (size_t)NEXP * 32768 * 16;
constexpr unsigned ZROW_OFF = 512 * 1024;
static_assert(WS_RECC + (size_t)112 * 32768 * 4 <= WS_DQK && WS_HN + (size_t)NT * 2048 < (1ull << 32) && CW_MOECNT + L_ * MOE_LS <= CW_KN && (112 + 2 * NEXP) * MOE_CS <= MOE_LS, "MoE record tables / 32-bit row offsets / counters");
constexpr int TBL_OFF = 131072 + 1024;
constexpr int NIN = 3072;

extern __shared__ __attribute__((aligned(16))) unsigned char lds_raw[];
__device__ __forceinline__ float bf2f(bf16 v) { return __uint_as_float(((unsigned)v) << 16); }
__device__ __forceinline__ unsigned f2bf(float f) { unsigned u = __float_as_uint(f); return (u + 0x7fffu + ((u >> 16) & 1u)) >> 16; }
__device__ __forceinline__ unsigned pk2(float lo, float hi) { return f2bf(lo) | (f2bf(hi) << 16); }
__device__ __forceinline__ float wave_sum(float v) {
#pragma unroll
    for (int o = 1; o < 64; o <<= 1) v += __shfl_xor(v, o);
    return v;
}
__device__ __forceinline__ float wave_max(float v) {
#pragma unroll
    for (int o = 1; o < 64; o <<= 1) v = fmaxf(v, __shfl_xor(v, o));
    return v;
}
__device__ __forceinline__ float shflx_f(float v, int o, int lane) { return __uint_as_float((unsigned)__builtin_amdgcn_ds_bpermute((lane ^ o) << 2, (int)__float_as_uint(v))); }
__device__ __forceinline__ unsigned shflx_u(unsigned v, int o, int lane) { return (unsigned)__builtin_amdgcn_ds_bpermute((lane ^ o) << 2, (int)v); }
__device__ __forceinline__ float wave_sum_l(float v, int lane) {
#pragma unroll
    for (int o = 1; o < 64; o <<= 1) v += shflx_f(v, o, lane);
    return v;
}
__device__ __forceinline__ int launder_s(int v) { asm volatile("" : "+s"(v)); return v; }
__device__ __forceinline__ float sigmoidf_(float x) { return 1.f / (1.f + __expf(-x)); }
__device__ __forceinline__ float log_sigmoidf_(float x) { return x >= 0.f ? -log1pf(__expf(-x)) : x - log1pf(__expf(x)); }
__device__ __forceinline__ float gelu_tanh(float x) { const float u = 0.7978845608028654f * (x + 0.044715f * x * x * x); return 0.5f * x * (1.f + tanhf(u)); }
__device__ __forceinline__ float alibi_slope(int idx1, int n) { return exp2f(-8.0f * (float)idx1 / (float)n); }

__device__ __forceinline__ constexpr int b64_off(int t, int d) { return ((t >> 4) * 2 + (d >> 5)) * 512 + (t & 15) * 32 + (d & 31); }
#define XB_TMO      128
#define XB_XCNT(j)  (256  + 64 * (j))
#define XB_XSUB(j)  (1280 + 64 * (j))
#define XB_XGEN(j)  (2304 + 64 * (j))
#define XB_TOP      3328
#define XB_TOPGEN   3392
#define XCD_BAR_WORDS 3456
#define XB_SPIN_CAP (1u << 25)
__device__ __forceinline__ unsigned xb_ld(unsigned* p)              { return __hip_atomic_load(p, __ATOMIC_RELAXED, __HIP_MEMORY_SCOPE_AGENT); }
__device__ __forceinline__ unsigned xb_add(unsigned* p, unsigned v) { return __hip_atomic_fetch_add(p, v, __ATOMIC_RELAXED, __HIP_MEMORY_SCOPE_AGENT); }
__device__ __forceinline__ unsigned xb_xcc_id() { return (unsigned)__builtin_amdgcn_s_getreg((3 << 11) | 20) & 0xFu; }
#define XB_SPIN(cond, bar) do { unsigned _sp = 0; while (cond) { __builtin_amdgcn_s_sleep(1); \
    if ((++_sp & 255u) == 0u) { if (xb_ld(&(bar)[XB_TMO])) break; if (_sp > XB_SPIN_CAP) { atomicAdd(&(bar)[XB_TMO], 1u); break; } } } } while (0)
struct XcdBarrier { unsigned* bar; unsigned x; volatile LAS unsigned* st; };
__device__ __forceinline__ XcdBarrier xcd_barrier_post(unsigned* bar, volatile LAS unsigned* st) {
    XcdBarrier b; b.bar = bar; b.x = xb_xcc_id(); b.st = st;
    if (threadIdx.x == 0) (void)xb_add(&bar[XB_XCNT(b.x)], 1u);
    return b;
}
__device__ __forceinline__ void xcd_barrier_complete(unsigned* bar, unsigned x, unsigned& nloc, unsigned& nx) {
    const unsigned G = gridDim.x * gridDim.y * gridDim.z;
    unsigned sum, cnt, mine, sp = 0u;
    for (;;) {
        sum = 0u; cnt = 0u; mine = 0u;
#pragma unroll
        for (unsigned j = 0; j < 16; ++j) { const unsigned c = xb_ld(&bar[XB_XCNT(j)]); sum += c; cnt += (c > 0u) ? 1u : 0u; mine = (j == x) ? c : mine; }
        if (sum == G) break;
        __builtin_amdgcn_s_sleep(1);
        if ((++sp & 255u) == 0u) { if (xb_ld(&bar[XB_TMO])) break; if (sp > XB_SPIN_CAP) { atomicAdd(&bar[XB_TMO], 1u); break; } }
    }
    nloc = mine > 0u ? mine : 1u; nx = cnt > 0u ? cnt : 1u;
}
__device__ __forceinline__ void xcd_barrier(const XcdBarrier& b) {
    asm volatile("s_waitcnt vmcnt(0)" ::: "memory");
    __syncthreads();
    if (threadIdx.x == 0) {
        unsigned* bar = b.bar;
        __builtin_amdgcn_s_waitcnt(0);
        unsigned nloc = b.st[0], nx = b.st[1];
        if (nloc == 0u) { xcd_barrier_complete(bar, b.x, nloc, nx); b.st[0] = nloc; b.st[1] = nx; }
        const unsigned old = xb_add(&bar[XB_XSUB(b.x)], 1u);
        const unsigned gen = old / nloc;
        if (old + 1u == (gen + 1u) * nloc) {
            __builtin_amdgcn_fence(__ATOMIC_RELEASE, "agent");
            asm volatile("s_waitcnt vmcnt(0)" ::: "memory");
            const unsigned og = xb_add(&bar[XB_TOP], 1u);
            const unsigned tg = og / nx;
            if (og + 1u == (tg + 1u) * nx) xb_add(&bar[XB_TOPGEN], 1u);
            else XB_SPIN(xb_ld(&bar[XB_TOPGEN]) == tg, bar);
            __builtin_amdgcn_fence(__ATOMIC_ACQUIRE, "agent");
            xb_add(&bar[XB_XGEN(b.x)], 1u);
            asm volatile("s_waitcnt vmcnt(0)" ::: "memory");
        } else {
            XB_SPIN(xb_ld(&bar[XB_XGEN(b.x)]) == gen, bar);
            __builtin_amdgcn_fence(__ATOMIC_ACQUIRE, "agent");
            asm volatile("s_waitcnt vmcnt(0)" ::: "memory");
        }
    }
    __syncthreads();
}

struct Params { const float* in[23]; float* out; unsigned char* ws; int ph_lo, ph_hi; };
constexpr int LDS_BYTES = 147456;
constexpr int MISC_OFF = 131072 + 320;

struct Ctx {
    LAS unsigned char* lds; int tid, lane, wave, bid, G, gw, ngw;
    const float* const* in; float* xcur; unsigned char* ws;
};

namespace pg8 {
#define PG8_LAS __attribute__((address_space(3)))
typedef unsigned short bf16_t;
typedef short bf16x8 __attribute__((ext_vector_type(8)));
typedef float f32x4 __attribute__((ext_vector_type(4)));
typedef unsigned u32x4 __attribute__((ext_vector_type(4)));
constexpr int BM = 256, BK = 64, HALF = 128, HTB = HALF * BK * 2  , STAGE_BYTES = 8 * HTB, NXCD = 8, WGM = 8;

__host__ __device__ __forceinline__ int lds_byte(int r, int c) { const int st = (r >> 4) * 2 + (c >> 5), rr = r & 15, cc = c & 31, ob = rr * 64 + cc * 2; return st * 1024 + (ob ^ (((ob >> 9) & 1) << 5)); }
__host__ __device__ __forceinline__ void stage_rc(int b, int& R, int& C) { const int st = b / 1024, sb = b % 1024, swz = sb ^ (((sb >> 9) & 1) << 5); R = (st >> 1) * 16 + swz / 64; C = (st & 1) * 32 + (swz % 64) / 2; }
__host__ __device__ __forceinline__ int perm32(int rho) { const int n = rho >> 4, i = rho & 15; return 8 * (i >> 2) + 4 * n + (i & 3); }

struct Unit { int pm, pn; const char* a; const char* b; const char* b2; };
struct Gemm { int lda, ldb, K, ksplit, arb, acb; };

__device__ __forceinline__ unsigned cvt_pk_bf16(float lo, float hi) { unsigned r; asm volatile("v_cvt_pk_bf16_f32 %0, %1, %2" : "=v"(r) : "v"(lo), "v"(hi)); return r; }
typedef float f32x2 __attribute__((ext_vector_type(2)));

template <class Epi, class Sched, bool ALIGN_EPI = false, bool SP2 = false, bool GATHER = false>
__device__ __forceinline__ void gemm_phase(PG8_LAS unsigned char* lds, const Gemm g, const Sched& S, const Epi& E) {
    static_assert(!GATHER || SP2, "GATHER is written for the SP2 loop");
    int tid_ = threadIdx.x; asm volatile("" : "+v"(tid_));
    const int tid = tid_, wid = __builtin_amdgcn_readfirstlane(tid >> 6), lane = tid & 63, wr = wid >> 2, wc = wid & 3, fr = lane & 15, fq = lane >> 4;
    const int K = g.K, nt = K / BK, ks = g.ksplit;
    unsigned voffA[2], voffB[2];
#pragma unroll
    for (int i = 0; i < 2; ++i) { int R, C; stage_rc(tid * 16 + i * 8192, R, C); const int Rb = Epi::PERM ? ((R & ~31) + perm32(R & 31)) : R;
        voffA[i] = g.arb ? (unsigned)(((R / g.arb) * (K / g.acb) + C / g.acb) * (g.arb * g.acb) + (R % g.arb) * g.acb + (C % g.acb)) * 2u : (unsigned)(R * g.lda + C) * 2u; voffB[i] = (unsigned)(Rb * g.ldb + C) * 2u; }
    const size_t kstep = (size_t)(BK * 2), kstepA = g.arb ? (size_t)(BK * g.arb * 2) : kstep;
    const size_t hsA = (size_t)HALF * (g.arb ? K : g.lda) * 2, hsB = (size_t)HALF * g.ldb * 2;
    const unsigned ldsw = (unsigned)wid * 1024u;
    const int aoff = lds_byte(wr * 64 + fr, fq * 8), boff = lds_byte(wc * 32 + fr, fq * 8);
#define PG8_SA(b, h) (((b) * 2 + (h)) * HTB)
#define PG8_SB(b, h) ((4 + (b) * 2 + (h)) * HTB)
#define PG8_STAGE(bufoff, gbase, voff) do { _Pragma("unroll") for (int _i = 0; _i < 2; ++_i) \
        __builtin_amdgcn_global_load_lds((const unsigned*)((const char*)(gbase) + (voff)[_i]), (PG8_LAS unsigned*)(lds + (bufoff) + ldsw + _i * 8192), 16, 0, 0); } while (0)
#define PG8_LDA(dst, b, h) do { _Pragma("unroll") for (int m = 0; m < 4; ++m) _Pragma("unroll") for (int k = 0; k < 2; ++k) dst[m][k] = *(const PG8_LAS bf16x8*)(lds + PG8_SA(b, h) + aoff + m * 2048 + k * 1024); } while (0)
#define PG8_LDB(dst, b, h) do { _Pragma("unroll") for (int n = 0; n < 2; ++n) _Pragma("unroll") for (int k = 0; k < 2; ++k) dst[n][k] = *(const PG8_LAS bf16x8*)(lds + PG8_SB(b, h) + boff + n * 2048 + k * 1024); } while (0)
#define PG8_MMA(ai, bj, At, Bt) do { __builtin_amdgcn_s_setprio(1); _Pragma("unroll") for (int m = 0; m < 4; ++m) _Pragma("unroll") for (int n = 0; n < 2; ++n) _Pragma("unroll") for (int k = 0; k < 2; ++k) \
        acc[ai][bj][m][n] = __builtin_amdgcn_mfma_f32_16x16x32_bf16(Bt[n][k], At[m][k], acc[ai][bj][m][n], 0, 0, 0); __builtin_amdgcn_s_setprio(0); } while (0)
#define PG8_WAIT_V(n) asm volatile("s_waitcnt vmcnt(" #n ")" ::: "memory")
#define PG8_WAIT_L(n) asm volatile("s_waitcnt lgkmcnt(" #n ")" ::: "memory")
#define PG8_BAR __builtin_amdgcn_s_barrier()
#define PG8_SCHED __builtin_amdgcn_sched_barrier(0)
    Unit cur, nxt; int ui = 0;
    if (!S.next(0, cur)) return;
    unsigned gC[2][2] = {{0u, 0u}, {0u, 0u}}, gN[2][2] = {{0u, 0u}, {0u, 0u}}; const char* gbase = nullptr;
#define PG8_GOFFS(U, Gv) do { int R_, C_; stage_rc(tid * 16, R_, C_); S.arows4(U, R_, (unsigned)C_ * 2u, Gv); } while (0)
#define PG8_STAGE_G(bufoff, kbyte, Gv, h) do { _Pragma("unroll") for (int _i = 0; _i < 2; ++_i) \
        __builtin_amdgcn_global_load_lds((const unsigned*)(gbase + (size_t)(kbyte) + Gv[h][_i]), (PG8_LAS unsigned*)(lds + (bufoff) + ldsw + _i * 8192), 16, 0, 0); } while (0)
    if constexpr (GATHER) { gbase = S.abase(); PG8_GOFFS(cur, gC); }
    f32x4 acc[2][2][4][2];
#pragma unroll
    for (int a = 0; a < 2; ++a)
#pragma unroll
        for (int b = 0; b < 2; ++b)
#pragma unroll
            for (int m = 0; m < 4; ++m)
#pragma unroll
                for (int n = 0; n < 2; ++n) acc[a][b][m][n] = (f32x4){0.f, 0.f, 0.f, 0.f};
    bf16x8 At[4][2], B0[2][2], B1[2][2];
    const char* cA = cur.a; const char* cB = cur.b; const char* cB2 = cur.b2;
#define PG8_BK(base, base2, kt) ((kt) < ks ? (base) + (size_t)(kt) * kstep : (base2) + (size_t)((kt) - ks) * kstep)
    S.a_ready(cur);
    if constexpr (SP2) {
        PG8_STAGE(PG8_SB(0, 0), cB, voffB); PG8_STAGE(PG8_SB(0, 1), cB + hsB, voffB);
        if constexpr (GATHER) { PG8_STAGE_G(PG8_SA(0, 0), 0, gC, 0); PG8_STAGE_G(PG8_SA(0, 1), 0, gC, 1); } else { PG8_STAGE(PG8_SA(0, 0), cA, voffA); PG8_STAGE(PG8_SA(0, 1), cA + hsA, voffA); }
        if (wr == 1) PG8_BAR;
        PG8_WAIT_V(2); PG8_BAR;
        PG8_STAGE(PG8_SB(1, 0), PG8_BK(cB, cB2, 1), voffB);
        if constexpr (GATHER) PG8_STAGE_G(PG8_SA(1, 0), kstep, gC, 0); else PG8_STAGE(PG8_SA(1, 0), cA + kstepA, voffA);
        PG8_STAGE(PG8_SB(1, 1), PG8_BK(cB, cB2, 1) + hsB, voffB);
        PG8_WAIT_V(6); PG8_BAR;
    } else {
        PG8_STAGE(PG8_SB(0, 0), cB, voffB); PG8_STAGE(PG8_SA(0, 0), cA, voffA); PG8_STAGE(PG8_SB(0, 1), cB + hsB, voffB); PG8_STAGE(PG8_SA(0, 1), cA + hsA, voffA);
        if (wr == 1) PG8_BAR;
        PG8_WAIT_V(4); PG8_BAR;
        PG8_STAGE(PG8_SB(1, 0), PG8_BK(cB, cB2, 1), voffB); PG8_STAGE(PG8_SA(1, 0), cA + kstepA, voffA); PG8_STAGE(PG8_SB(1, 1), PG8_BK(cB, cB2, 1) + hsB, voffB);
        PG8_WAIT_V(6); PG8_BAR;
    }
    for (;;) {
        const bool has_next = S.next(ui + 1, nxt);
        if constexpr (GATHER) { if (has_next) PG8_GOFFS(nxt, gN); else { _Pragma("unroll") for (int _h = 0; _h < 2; ++_h) _Pragma("unroll") for (int _i = 0; _i < 2; ++_i) gN[_h][_i] = gC[_h][_i]; } }
        const char* nA = has_next ? nxt.a : cA; const char* nB = has_next ? nxt.b : cB; const char* nB2 = has_next ? nxt.b2 : cB2;
#pragma unroll 1
        for (int t = 0; t < nt; t += 2) {
            const bool last = (t == nt - 2);
            const char* a1 = cA + (size_t)(t + 1) * kstepA;
            const char* a2 = last ? nA : cA + (size_t)(t + 2) * kstepA; const char* b2 = last ? PG8_BK(nB, nB2, 0) : PG8_BK(cB, cB2, t + 2);
            const char* a3 = a2 + kstepA; const char* b3 = last ? PG8_BK(nB, nB2, 1) : PG8_BK(cB, cB2, t + 3);
            if (last && has_next) S.a_ready(nxt);
            if constexpr (SP2) {
            PG8_LDB(B0, 0, 0); PG8_LDB(B1, 0, 1); PG8_SCHED; PG8_LDA(At, 0, 0);
            if constexpr (GATHER) PG8_STAGE_G(PG8_SA(1, 1), (size_t)(t + 1) * kstep, gC, 1); else PG8_STAGE(PG8_SA(1, 1), a1 + hsA, voffA);
            PG8_WAIT_V(8); PG8_WAIT_L(0); PG8_BAR; PG8_MMA(0, 0, At, B0); PG8_MMA(0, 1, At, B1); PG8_BAR; PG8_SCHED;
            PG8_LDA(At, 0, 1); PG8_STAGE(PG8_SB(0, 0), b2, voffB); PG8_STAGE(PG8_SB(0, 1), b2 + hsB, voffB);
            if constexpr (GATHER) { if (last) PG8_STAGE_G(PG8_SA(0, 0), 0, gN, 0); else PG8_STAGE_G(PG8_SA(0, 0), (size_t)(t + 2) * kstep, gC, 0); } else PG8_STAGE(PG8_SA(0, 0), a2, voffA);
            PG8_WAIT_V(8); PG8_WAIT_L(0); PG8_BAR; PG8_MMA(1, 0, At, B0); PG8_MMA(1, 1, At, B1); PG8_BAR; PG8_SCHED;
            PG8_LDB(B0, 1, 0); PG8_LDB(B1, 1, 1); PG8_SCHED; PG8_LDA(At, 1, 0);
            if constexpr (GATHER) { if (last) PG8_STAGE_G(PG8_SA(0, 1), 0, gN, 1); else PG8_STAGE_G(PG8_SA(0, 1), (size_t)(t + 2) * kstep, gC, 1); } else PG8_STAGE(PG8_SA(0, 1), a2 + hsA, voffA);
            PG8_WAIT_V(8); PG8_WAIT_L(0); PG8_BAR; PG8_MMA(0, 0, At, B0); PG8_MMA(0, 1, At, B1); PG8_BAR; PG8_SCHED;
            PG8_LDA(At, 1, 1); PG8_STAGE(PG8_SB(1, 0), b3, voffB); PG8_STAGE(PG8_SB(1, 1), b3 + hsB, voffB);
            if constexpr (GATHER) { if (last) PG8_STAGE_G(PG8_SA(1, 0), kstep, gN, 0); else PG8_STAGE_G(PG8_SA(1, 0), (size_t)(t + 3) * kstep, gC, 0); } else PG8_STAGE(PG8_SA(1, 0), a3, voffA);
            PG8_WAIT_V(8); PG8_WAIT_L(0); PG8_BAR; PG8_MMA(1, 0, At, B0); PG8_MMA(1, 1, At, B1); PG8_BAR; PG8_SCHED;
            } else {
            PG8_LDB(B0, 0, 0); PG8_SCHED; PG8_LDA(At, 0, 0); PG8_STAGE(PG8_SA(1, 1), a1 + hsA, voffA);
            PG8_WAIT_L(8); PG8_BAR; PG8_WAIT_L(0); PG8_MMA(0, 0, At, B0); PG8_BAR; PG8_SCHED;
            PG8_LDB(B1, 0, 1); PG8_STAGE(PG8_SB(0, 0), b2, voffB);
            PG8_BAR; PG8_WAIT_L(0); PG8_MMA(0, 1, At, B1); PG8_BAR;
            PG8_LDA(At, 0, 1); PG8_STAGE(PG8_SA(0, 0), a2, voffA);
            PG8_BAR; PG8_WAIT_L(0); PG8_MMA(1, 0, At, B0); PG8_BAR; PG8_SCHED;
            PG8_STAGE(PG8_SB(0, 1), b2 + hsB, voffB);
            PG8_WAIT_V(6); PG8_BAR; PG8_MMA(1, 1, At, B1); PG8_BAR;
            PG8_LDB(B0, 1, 0); PG8_SCHED; PG8_LDA(At, 1, 0); PG8_STAGE(PG8_SA(0, 1), a2 + hsA, voffA);
            PG8_WAIT_L(8); PG8_BAR; PG8_WAIT_L(0); PG8_MMA(0, 0, At, B0); PG8_BAR; PG8_SCHED;
            PG8_LDB(B1, 1, 1); PG8_STAGE(PG8_SB(1, 0), b3, voffB);
            PG8_BAR; PG8_WAIT_L(0); PG8_MMA(0, 1, At, B1); PG8_BAR;
            PG8_LDA(At, 1, 1); PG8_STAGE(PG8_SA(1, 0), a3, voffA);
            PG8_BAR; PG8_WAIT_L(0); PG8_MMA(1, 0, At, B0); PG8_BAR; PG8_SCHED;
            PG8_STAGE(PG8_SB(1, 1), b3 + hsB, voffB);
            PG8_WAIT_V(6); PG8_BAR; PG8_MMA(1, 1, At, B1); PG8_BAR;
            }
        }
        if constexpr (ALIGN_EPI) { if (wr == 0) PG8_BAR; }
        if constexpr (!Epi::AFTER_DRAIN) { E(acc, cur, wr, wc, fr, fq); S.done(cur); }
        if (!has_next) break;
#pragma unroll
        for (int a = 0; a < 2; ++a)
#pragma unroll
            for (int b = 0; b < 2; ++b)
#pragma unroll
                for (int m = 0; m < 4; ++m)
#pragma unroll
                    for (int n = 0; n < 2; ++n) acc[a][b][m][n] = (f32x4){0.f, 0.f, 0.f, 0.f};
        cur = nxt; cA = nA; cB = nB; cB2 = nB2; ++ui;
        if constexpr (GATHER) { _Pragma("unroll") for (int _h = 0; _h < 2; ++_h) _Pragma("unroll") for (int _i = 0; _i < 2; ++_i) gC[_h][_i] = gN[_h][_i]; }
        if constexpr (ALIGN_EPI) { if (wr == 1) PG8_BAR; }
    }
    PG8_WAIT_V(0);
    if constexpr (!ALIGN_EPI) { if (wr == 0) PG8_BAR; }
    PG8_BAR;
    if constexpr (Epi::AFTER_DRAIN) { E.fused(acc, cur, wr, wc, fr, fq, lds, wid, lane); S.done(cur); }
#undef PG8_BK
#undef PG8_GOFFS
#undef PG8_STAGE_G
#undef PG8_SA
#undef PG8_SB
#undef PG8_STAGE
#undef PG8_LDA
#undef PG8_LDB
#undef PG8_MMA
#undef PG8_WAIT_V
#undef PG8_WAIT_L
#undef PG8_BAR
#undef PG8_SCHED
}
}

struct PlainOrder {
    const char* A; const char* Bt; int lda, ldb, nM, nN, nwg, G, c;
    __device__ __forceinline__ void init(const void* A_, const void* Bt_, int lda_, int ldb_, int M, int N, int G_, int c_) { A = (const char*)A_; Bt = (const char*)Bt_; lda = lda_; ldb = ldb_; nM = M / 256; nN = N / 256; nwg = nM * nN; G = G_; c = c_; }
    __device__ __forceinline__ bool next(int i, pg8::Unit& u) const {
        const long L = (long)i * G + c; if (L >= nwg) return false;
        int wgid = (int)L; { const int q = nwg / 8, r = nwg % 8, xcd = wgid % 8, off = wgid / 8; wgid = (xcd < r ? xcd * (q + 1) : r * (q + 1) + (xcd - r) * q) + off; }
        const int nig = 8 * nN, gid = wgid / nig, fm = gid * 8, gsz = (nM - fm) < 8 ? (nM - fm) : 8;
        u.pm = fm + ((wgid % nig) % gsz); u.pn = (wgid % nig) / gsz;
        u.a = A + (size_t)u.pm * 256 * lda * 2; u.b = Bt + (size_t)u.pn * 256 * ldb * 2; u.b2 = u.b; return true;
    }
    __device__ __forceinline__ void a_ready(const pg8::Unit&) const {}
    __device__ __forceinline__ void done(const pg8::Unit&) const {}
};
struct EpiInProj {
    static constexpr bool PERM = true, AFTER_DRAIN = false;
    unsigned char* ws; const float* b_gate; const float* b_fgt; unsigned* kn;
    __device__ __forceinline__ void operator()(const pg8::f32x4 (&acc)[2][2][4][2], const pg8::Unit& u, int wr, int wc, int fr, int fq) const {
        { int t_ = threadIdx.x; asm volatile("" : "+v"(t_)); fr = t_ & 15; fq = (t_ >> 4) & 3; }
        const int pn = u.pn, b = (u.pm * 256) / T_, t0 = u.pm * 256 - b * T_ + wr * 64 + fr;
        if (pn == 11) {
            if (wc == 0 && fq < 4) {
                float* gate = (float*)(ws + WS_GATE); float* fl = (float*)(ws + WS_FL);
#pragma unroll
                for (int ai = 0; ai < 2; ++ai)
#pragma unroll
                    for (int m = 0; m < 4; ++m) { const int t = t0 + ai * 128 + m * 16; const size_t n = (size_t)b * T_ + t;
#pragma unroll
                        for (int nn = 0; nn < 2; ++nn)
#pragma unroll
                            for (int e = 0; e < 4; ++e) { const int c = 8 * fq + 4 * nn + e; const float v = acc[ai][0][m][nn][e];
                                if (c < 24) gate[n * 24 + c] = __builtin_amdgcn_rcpf(1.f + __builtin_amdgcn_exp2f(-(v + b_gate[c]) * LOG2E));
                                else if (c < 28) { const float z = v + b_fgt[c - 24];
                                    fl[(size_t)(b * 4 + (c - 24)) * T_ + t] = z < -30.f ? z : -0.6931471805599453f * __builtin_amdgcn_logf(1.f + __builtin_amdgcn_exp2f(-z * LOG2E)); } } }
            }
            return;
        }
        if (pn == 6 || pn == 9) {
            const int lane_ = (fq << 4) | fr;
#pragma unroll
            for (int bj = 0; bj < 2; ++bj)
#pragma unroll
                for (int ai = 0; ai < 2; ++ai) { float mx = 0.f;
#pragma unroll
                    for (int m = 0; m < 4; ++m) { const pg8::f32x4 v0 = acc[ai][bj][m][0], v1 = acc[ai][bj][m][1];
                        float ss = (v0[0] * v0[0] + v0[1] * v0[1]) + (v0[2] * v0[2] + v0[3] * v0[3]) + (v1[0] * v1[0] + v1[1] * v1[1]) + (v1[2] * v1[2] + v1[3] * v1[3]);
                        ss += shflx_f(ss, 16, lane_); ss += shflx_f(ss, 32, lane_); mx = fmaxf(mx, ss); }
#pragma unroll
                    for (int o = 1; o < 16; o <<= 1) mx = fmaxf(mx, shflx_f(mx, o, lane_));
                    if (lane_ == 0) { const int cg = bj * 4 + wc, tile = (u.pm * 256 - b * T_ + ai * 128 + wr * 64) >> 6;
                        unsigned* dst = pn == 6 ? kn + ((b * 4 + (cg >> 1)) * 64 + tile) * 2 + (cg & 1) : kn + 4096 + (b * 8 + cg) * 64 + tile;
                        atomicMax(dst, __float_as_uint(mx)); } }
        }
#pragma unroll
        for (int bj = 0; bj < 2; ++bj) {
            const int c = bj * 128 + wc * 32 + 8 * fq;
            bf16* base; int W = 64; float sc = 1.f;
            if (pn < 2) { base = (bf16*)(ws + WS_QN) + (size_t)(b * 8 + pn * 4 + (c >> 6)) * T_ * 64 + (c & 63); sc = 0.125f * LOG2E; }
            else if (pn < 5) { base = (bf16*)(ws + WS_KV6 + (size_t)((pn - 2) * 2 + (c >> 7)) * KV6_STRIDE) + (size_t)(b * 2 + ((c >> 6) & 1)) * T_ * 64 + (c & 63); }
            else if (pn < 8) { base = (bf16*)(ws + WS_FQKV) + (size_t)(pn - 5) * (8 * MiB) + (size_t)(b * 4 + (c >> 6)) * T_ * 64 + (c & 63); if (pn == 5) sc = 0.125f * LOG2E; }
            else if (pn < 10) { base = (bf16*)(ws + WS_DQK) + (size_t)(pn - 8) * (8 * MiB) + (size_t)(b * 8 + (c >> 5)) * T_ * 32 + (c & 31); W = 32; if (pn == 8) sc = 0.17677669529663687f * LOG2E; }
            else { base = (bf16*)(ws + WS_DV) + (size_t)(b * 4 + (c >> 6)) * T_ * 64 + (c & 63); }
            const bool blk = W == 64 && pn != 2;
            if (blk) base += -(c & 63) + ((c >> 5) & 1) * 512 + (c & 31);
#pragma unroll
            for (int ai = 0; ai < 2; ++ai)
#pragma unroll
                for (int m = 0; m < 4; ++m) { const int t = t0 + ai * 128 + m * 16;
                    const pg8::f32x4 v0 = acc[ai][bj][m][0] * sc, v1 = acc[ai][bj][m][1] * sc;
                    pg8::u32x4 w; w.x = pg8::cvt_pk_bf16(v0[0], v0[1]); w.y = pg8::cvt_pk_bf16(v0[2], v0[3]); w.z = pg8::cvt_pk_bf16(v1[0], v1[1]); w.w = pg8::cvt_pk_bf16(v1[2], v1[3]);
                    *(pg8::u32x4*)(base + (blk ? (size_t)((t >> 4) * 1024 + (t & 15) * 32) : (size_t)t * W)) = w; }
        }
    }
};
__device__ __forceinline__ u32x4 res_add8(u32x4 w, const pg8::f32x4& a0, const pg8::f32x4& a1) {
    u32x4 o;
    o.x = pg8::cvt_pk_bf16(__uint_as_float(w.x << 16) + a0[0], __uint_as_float(w.x & 0xffff0000u) + a0[1]); o.y = pg8::cvt_pk_bf16(__uint_as_float(w.y << 16) + a0[2], __uint_as_float(w.y & 0xffff0000u) + a0[3]);
    o.z = pg8::cvt_pk_bf16(__uint_as_float(w.z << 16) + a1[0], __uint_as_float(w.z & 0xffff0000u) + a1[1]); o.w = pg8::cvt_pk_bf16(__uint_as_float(w.w << 16) + a1[2], __uint_as_float(w.w & 0xffff0000u) + a1[3]);
    return o;
}
struct EpiResBf16 {
    static constexpr bool PERM = true, AFTER_DRAIN = false;
    bf16* xr;
    __device__ __forceinline__ void operator()(const pg8::f32x4 (&acc)[2][2][4][2], const pg8::Unit& u, int wr, int wc, int fr, int fq) const {
        { int t_ = threadIdx.x; asm volatile("" : "+v"(t_)); fr = t_ & 15; fq = (t_ >> 4) & 3; }
#pragma unroll
        for (int ai = 0; ai < 2; ++ai)
#pragma unroll
            for (int m = 0; m < 4; ++m) { const size_t off = (size_t)(u.pm * 256 + ai * 128 + wr * 64 + m * 16 + fr) * D_ + u.pn * 256 + wc * 32 + 8 * fq;
#pragma unroll
                for (int bj = 0; bj < 2; ++bj) { u32x4* q = (u32x4*)(xr + off + bj * 128); *q = res_add8(*q, acc[ai][bj][m][0], acc[ai][bj][m][1]); } }
    }
};


struct EpiDummy {
    static constexpr bool PERM = true, AFTER_DRAIN = false;
    float* dst;
    __device__ __forceinline__ void operator()(const pg8::f32x4 (&acc)[2][2][4][2], const pg8::Unit& u, int wr, int wc, int fr, int fq) const {
        pg8::f32x4 a = {0.f, 0.f, 0.f, 0.f};
#pragma unroll
        for (int ai = 0; ai < 2; ++ai)
#pragma unroll
            for (int bj = 0; bj < 2; ++bj)
#pragma unroll
                for (int m = 0; m < 4; ++m) { a = a + acc[ai][bj][m][0]; a = a + acc[ai][bj][m][1]; }
        *(pg8::f32x4*)(dst + ((size_t)(u.pm * 12 + u.pn) * 512 + threadIdx.x) * 4) = a;
    }
};
struct OneUnitOrder { pg8::Unit u; bool has;
    __device__ __forceinline__ bool next(int i, pg8::Unit& o) const { if (i != 0 || !has) return false; o = u; return true; }
    __device__ __forceinline__ void a_ready(const pg8::Unit&) const {}
    __device__ __forceinline__ void done(const pg8::Unit&) const {} };
__device__ __forceinline__ float gelu_tanh_fast(float x) { const float u2 = 1.5957691216057308f * (x + 0.044715f * x * x * x); return x * __builtin_amdgcn_rcpf(1.f + __builtin_amdgcn_exp2f(-u2 * LOG2E)); }
struct EpiCmpH {
    static constexpr bool PERM = true, AFTER_DRAIN = false;
    bf16* hc; const float* bias1;
    __device__ __forceinline__ void operator()(const pg8::f32x4 (&acc)[2][2][4][2], const pg8::Unit& u, int wr, int wc, int fr, int fq) const {
        { int t_ = threadIdx.x; asm volatile("" : "+v"(t_)); fr = t_ & 15; fq = (t_ >> 4) & 3; }
        const int kv = u.pn;
#pragma unroll
        for (int bj = 0; bj < 2; ++bj) { const int col = bj * 128 + wc * 32 + 8 * fq;
            const pg8::f32x4 b0 = *(const pg8::f32x4*)(bias1 + kv * 256 + col), b1 = *(const pg8::f32x4*)(bias1 + kv * 256 + col + 4);
#pragma unroll
            for (int ai = 0; ai < 2; ++ai)
#pragma unroll
                for (int m = 0; m < 4; ++m) { const int row = u.pm * 256 + ai * 128 + wr * 64 + m * 16 + fr;
                    const pg8::f32x4 v0 = acc[ai][bj][m][0] + b0, v1 = acc[ai][bj][m][1] + b1;
                    pg8::u32x4 w; w.x = pg8::cvt_pk_bf16(gelu_tanh_fast(v0[0]), gelu_tanh_fast(v0[1])); w.y = pg8::cvt_pk_bf16(gelu_tanh_fast(v0[2]), gelu_tanh_fast(v0[3]));
                    w.z = pg8::cvt_pk_bf16(gelu_tanh_fast(v1[0]), gelu_tanh_fast(v1[1])); w.w = pg8::cvt_pk_bf16(gelu_tanh_fast(v1[2]), gelu_tanh_fast(v1[3]));
                    *(pg8::u32x4*)(hc + ((size_t)kv * 4096 + row) * 256 + col) = w; } }
    }
};
struct EpiCmpOut {
    static constexpr bool PERM = true, AFTER_DRAIN = false;
    bf16* kvcmp;
    __device__ __forceinline__ void operator()(const pg8::f32x4 (&acc)[2][2][4][2], const pg8::Unit& u, int wr, int wc, int fr, int fq) const {
        { int t_ = threadIdx.x; asm volatile("" : "+v"(t_)); fr = t_ & 15; fq = (t_ >> 4) & 3; }
        if (wc >= 2) return;
        const int kv = u.pn, col = wc * 32 + 8 * fq;
#pragma unroll
        for (int ai = 0; ai < 2; ++ai)
#pragma unroll
            for (int m = 0; m < 4; ++m) { const int row = u.pm * 256 + ai * 128 + wr * 64 + m * 16 + fr; const float z = ((row & 255) == 255) ? 0.f : 1.f;
                const pg8::f32x4 v0 = acc[ai][0][m][0], v1 = acc[ai][0][m][1];
                pg8::u32x4 w; w.x = pg8::cvt_pk_bf16(z != 0.f ? v0[0] : 0.f, z != 0.f ? v0[1] : 0.f); w.y = pg8::cvt_pk_bf16(z != 0.f ? v0[2] : 0.f, z != 0.f ? v0[3] : 0.f);
                w.z = pg8::cvt_pk_bf16(z != 0.f ? v1[0] : 0.f, z != 0.f ? v1[1] : 0.f); w.w = pg8::cvt_pk_bf16(z != 0.f ? v1[2] : 0.f, z != 0.f ? v1[3] : 0.f);
                *(pg8::u32x4*)(kvcmp + ((size_t)kv * 4096 + row) * 64 + col) = w; }
    }
};

__device__ __forceinline__ void moe_build_tables(const unsigned* cnt, int tid) {
    LAS int* T = (LAS int*)((LAS unsigned char*)lds_raw + TBL_OFF);
    __syncthreads();
    if (tid < 112) T[384 + tid] = (int)cnt[tid * MOE_CS];
    else if (tid >= 128 && tid < 128 + NEXP) T[560 + tid - 128] = (int)cnt[(112 + tid - 128) * MOE_CS];
    __syncthreads();
    if (tid == 0) { int o = 0; _Pragma("clang loop unroll(disable)") for (int c = 0; c < 112; ++c) { T[c] = o; const int n = (T[384 + c] + 255) >> 8;
            _Pragma("clang loop vectorize(disable) unroll(disable)") for (int k = 0; k < n; ++k) T[128 + o + k] = c;
            o += n; } T[112] = o; }
    if (tid == 64) { int o = 0; _Pragma("clang loop unroll(disable)") for (int e = 0; e < NEXP; ++e) { T[512 + e] = o; const int n = (T[560 + e] + 255) >> 8;
            _Pragma("clang loop vectorize(disable) unroll(disable)") for (int k = 0; k < n; ++k) T[608 + o + k] = e;
            o += n; } T[544] = o; }
    __syncthreads();
}
__device__ __forceinline__ void moe_pair(int cls, int& ea, int& eb) { const int grp = cls / 28; int idx = cls % 28, lo = 0; while (idx >= 7 - lo) { idx -= 7 - lo; ++lo; } ea = grp * 8 + lo; eb = grp * 8 + lo + 1 + idx; }
struct MoeOrder1 {
    const char* wsb; const unsigned* rec; const char* wgu; unsigned* edone; int G, c;
    __device__ __forceinline__ bool next(int i, pg8::Unit& u) const {
        const LAS int* T = (const LAS int*)((LAS unsigned char*)lds_raw + TBL_OFF);
        const int idx = i * G + c; if (idx >= 2 * T[544]) return false;
        const int tile = idx >> 1, pn = idx & 1, e = T[608 + tile];
        u.pm = tile; u.pn = pn; u.a = wsb; u.b = wgu + ((size_t)e * 512 + pn * 256) * 2048; u.b2 = u.b; return true; }
    __device__ __forceinline__ const char* abase() const { return wsb; }
    __device__ __forceinline__ void arows4(const pg8::Unit& u, int r0, unsigned cb, unsigned (&g)[2][2]) const {
        const LAS int* T = (const LAS int*)((LAS unsigned char*)lds_raw + TBL_OFF);
        const int e = T[608 + u.pm], base = (u.pm - T[512 + e]) * 256 + r0, n = T[560 + e];
        const unsigned ob = (unsigned)(e * 32768 + base) * 16u;
#pragma unroll
        for (int k = 0; k < 4; ++k) { unsigned off = ZROW_OFF; if (base + 64 * k < n) off = (unsigned)WS_HN + *(const unsigned*)((const char*)rec + (ob + 1024u * k)) * 2048u; g[k >> 1][k & 1] = off + cb; } }
    __device__ __forceinline__ void a_ready(const pg8::Unit&) const {}
    __device__ __forceinline__ void done(const pg8::Unit& u) const {
        asm volatile("s_waitcnt vmcnt(0)" ::: "memory");
        const LAS int* T = (const LAS int*)((LAS unsigned char*)lds_raw + TBL_OFF);
        int t_ = threadIdx.x; asm volatile("" : "+v"(t_));
        if ((t_ & 63) == 0) (void)__hip_atomic_fetch_add(edone + T[608 + u.pm] * MOE_CS, 1u, __ATOMIC_RELAXED, __HIP_MEMORY_SCOPE_AGENT); } };
struct MoeOrder2 {
    const char* hb; const char* wd; const unsigned* edone; unsigned* tmo; int G, c;
    __device__ __forceinline__ bool next(int i, pg8::Unit& u) const {
        const LAS int* T = (const LAS int*)((LAS unsigned char*)lds_raw + TBL_OFF);
        const int n1 = (2 * T[544]) % G, idx = i * G + (c >= n1 ? c - n1 : c - n1 + G); if (idx >= 4 * T[112]) return false;
        const int tile = idx >> 2, pn = idx & 3; int ea, eb; moe_pair(T[128 + tile], ea, eb);
        u.pm = tile; u.pn = pn; u.a = hb + (size_t)tile * 256 * 1024; u.b = wd + ((size_t)ea * 1024 + pn * 256) * 512; u.b2 = wd + ((size_t)eb * 1024 + pn * 256) * 512; return true; }
    __device__ __forceinline__ void a_ready(const pg8::Unit& u) const {
        int t_ = threadIdx.x; asm volatile("" : "+v"(t_));
        if (t_ < 64) {
            const LAS int* T = (const LAS int*)((LAS unsigned char*)lds_raw + TBL_OFF);
            int ea, eb; moe_pair(T[128 + u.pm], ea, eb);
            const unsigned na = 16u * (unsigned)((T[560 + ea] + 255) >> 8), nb = 16u * (unsigned)((T[560 + eb] + 255) >> 8);
            unsigned polls = 0u;
            while ((unsigned)__builtin_amdgcn_readfirstlane(__hip_atomic_load(edone + ea * MOE_CS, __ATOMIC_RELAXED, __HIP_MEMORY_SCOPE_AGENT)) < na ||
                   (unsigned)__builtin_amdgcn_readfirstlane(__hip_atomic_load(edone + eb * MOE_CS, __ATOMIC_RELAXED, __HIP_MEMORY_SCOPE_AGENT)) < nb) {
                if ((++polls & 255u) == 0u) { if (__builtin_amdgcn_readfirstlane(__hip_atomic_load(tmo, __ATOMIC_RELAXED, __HIP_MEMORY_SCOPE_AGENT)) != 0u) break;
                    if (polls > (1u << 22)) { if (t_ == 0) __hip_atomic_store(tmo, 1u, __ATOMIC_RELAXED, __HIP_MEMORY_SCOPE_AGENT); break; } }
                __builtin_amdgcn_s_sleep(2); }
            __builtin_amdgcn_fence(__ATOMIC_ACQUIRE, "agent");
            asm volatile("s_waitcnt vmcnt(0)" ::: "memory");
        }
        asm volatile("" ::: "memory"); __builtin_amdgcn_s_barrier(); asm volatile("" ::: "memory");
    }
    __device__ __forceinline__ void done(const pg8::Unit&) const {} };
struct EpiMoeH {
    static constexpr bool PERM = true, AFTER_DRAIN = false;
    bf16* hb; const u32x4* rec;
    __device__ __forceinline__ void operator()(const pg8::f32x4 (&acc)[2][2][4][2], const pg8::Unit& u, int wr, int wc, int fr, int fq) const {
        { int t_ = threadIdx.x; asm volatile("" : "+v"(t_)); fr = t_ & 15; fq = (t_ >> 4) & 3; }
        const LAS int* T = (const LAS int*)((LAS unsigned char*)lds_raw + TBL_OFF);
        const int ex = T[608 + u.pm], vr0 = (u.pm - T[512 + ex]) * 256, nex = T[560 + ex];
#pragma unroll
        for (int ai = 0; ai < 2; ++ai) {
#pragma unroll
            for (int m = 0; m < 4; ++m) { const int rr = ai * 128 + wr * 64 + m * 16 + fr; const bool valid = vr0 + rr < nex;
                const u32x4 q = *(const u32x4*)((const char*)rec + (unsigned)(ex * 32768 + vr0 + rr) * 16u); const float w = __uint_as_float(q.y), rs = __uint_as_float(q.z);
                const int slot = (int)((q.w >> 15) & 1u); const unsigned row = (unsigned)T[valid ? (q.w >> 16) : 0u] * 256u + (q.w & 0x7fffu);
#pragma unroll
                for (int bj = 0; bj < 2; ++bj) { const int j0 = (u.pn & 1) * 128 + (bj * 128 + wc * 32 + 8 * fq) / 2;
                    pg8::f32x4 v0 = acc[ai][bj][m][0], v1 = acc[ai][bj][m][1];
#pragma unroll
                    for (int e = 0; e < 4; ++e) { v0[e] *= rs; v1[e] *= rs; }
                    const float h0 = v0[0] * __builtin_amdgcn_rcpf(1.f + __builtin_amdgcn_exp2f(-v0[0] * LOG2E)) * v0[1] * w, h1 = v0[2] * __builtin_amdgcn_rcpf(1.f + __builtin_amdgcn_exp2f(-v0[2] * LOG2E)) * v0[3] * w;
                    const float h2 = v1[0] * __builtin_amdgcn_rcpf(1.f + __builtin_amdgcn_exp2f(-v1[0] * LOG2E)) * v1[1] * w, h3 = v1[2] * __builtin_amdgcn_rcpf(1.f + __builtin_amdgcn_exp2f(-v1[2] * LOG2E)) * v1[3] * w;
                    const int jg = slot * 256 + j0;
                    if (valid) __hip_atomic_store((u64*)((char*)hb + (((row >> 4) * 32u + (unsigned)(jg >> 4)) * 256u + (row & 15u) * 16u + (unsigned)(jg & 15)) * 2u), (u64)pg8::cvt_pk_bf16(h0, h1) | ((u64)pg8::cvt_pk_bf16(h2, h3) << 32),
                                                  __ATOMIC_RELAXED, __HIP_MEMORY_SCOPE_AGENT); }
            }
            asm volatile("" ::: "memory"); }
    }
};
struct EpiMoeOut {
    static constexpr bool PERM = true, AFTER_DRAIN = false;
    bf16* x; const unsigned* rec;
    __device__ __forceinline__ void operator()(const pg8::f32x4 (&acc)[2][2][4][2], const pg8::Unit& u, int wr, int wc, int fr, int fq) const {
        { int t_ = threadIdx.x; asm volatile("" : "+v"(t_)); fr = t_ & 15; fq = (t_ >> 4) & 3; }
        bf16* xx = x; const unsigned* rt = rec; asm volatile("" : "+s"(xx), "+s"(rt));
        const LAS int* T = (const LAS int*)((LAS unsigned char*)lds_raw + TBL_OFF);
        const int cls = T[128 + u.pm], vr0 = (u.pm - T[cls]) * 256, ncls = T[384 + cls];
#pragma unroll
        for (int ai = 0; ai < 2; ++ai)
#pragma unroll
            for (int m = 0; m < 4; ++m) { const int rr = ai * 128 + wr * 64 + m * 16 + fr; int tok = -1; if (vr0 + rr < ncls) tok = (int)rt[(size_t)cls * 32768 + vr0 + rr];
                if (tok >= 0) { bf16* xr = xx + (size_t)tok * D_ + u.pn * 256 + wc * 32 + 8 * fq;
#pragma unroll
                    for (int bj = 0; bj < 2; ++bj) { u32x4* q = (u32x4*)(xr + bj * 128); *q = res_add8(*q, acc[ai][bj][m][0], acc[ai][bj][m][1]); } } }
    }
};

__device__ __forceinline__ void transpose_item(const float* W, int ldw, bf16* WT, int ldt, int r0, int rmul, int k0, LAS float* scr, int lane, const float* gk = nullptr) {
    f32x4 v[8];
#pragma unroll
    for (int i = 0; i < 8; ++i) v[i] = *(const f32x4*)(W + (size_t)(k0 + i * 8 + (lane >> 3)) * ldw + (lane & 7) * 4);
    if (gk) {
#pragma unroll
        for (int i = 0; i < 8; ++i) { const float gsc = gk[k0 + i * 8 + (lane >> 3)]; v[i].x *= gsc; v[i].y *= gsc; v[i].z *= gsc; v[i].w *= gsc; } }
#pragma unroll
    for (int i = 0; i < 8; ++i) { LAS float* d = scr + (i * 8 + (lane >> 3)) * 33 + (lane & 7) * 4; d[0] = v[i].x; d[1] = v[i].y; d[2] = v[i].z; d[3] = v[i].w; }
    asm volatile("s_waitcnt lgkmcnt(0)" ::: "memory");
    const int c = lane & 7;
#pragma unroll
    for (int j = 0; j < 4; ++j) { const int n = (lane >> 3) + 8 * j; const LAS float* sp = scr + (8 * c) * 33 + n;
        u32x4 o; o.x = pk2(sp[0 * 33], sp[1 * 33]); o.y = pk2(sp[2 * 33], sp[3 * 33]); o.z = pk2(sp[4 * 33], sp[5 * 33]); o.w = pk2(sp[6 * 33], sp[7 * 33]);
        *(u32x4*)(WT + (size_t)(r0 + rmul * n) * ldt + k0 + 8 * c) = o; }
    asm volatile("s_waitcnt lgkmcnt(0)" ::: "memory");
}
__device__ __forceinline__ void transpose_seg(const float* W, int ldw, int K, int sc0, int ncol, bf16* WT, int r0, int rmul, int item, LAS float* scr, int lane, const float* gk = nullptr) {
    const int nb = ncol / 32, kb = item / nb, cb = item % nb;
    transpose_item(W + sc0 + cb * 32, ldw, WT, K, r0 + rmul * cb * 32, rmul, kb * 64, scr, lane, gk);
}

typedef float f32x16 __attribute__((ext_vector_type(16)));
typedef short bf16x8v __attribute__((ext_vector_type(8)));
typedef short s16x4 __attribute__((ext_vector_type(4)));
typedef float f32x2_t __attribute__((ext_vector_type(2)));
typedef __bf16 bf16x2_t __attribute__((ext_vector_type(2)));
constexpr int A_KBUF = 10240, A_VBUF = 12288;
constexpr int A_KOFF = 0, A_VOFF = 2 * A_KBUF, A_BOFF = A_VOFF + 2 * A_VBUF, A_BTILE = 8 * 256, A_LDS_END = A_BOFF + 2 * A_BTILE;
__device__ __forceinline__ constexpr int crow0(int reg) { return (reg & 3) + 8 * (reg >> 2); }
__device__ __forceinline__ float swap_max(float m) { auto rr = __builtin_amdgcn_permlane32_swap(__float_as_uint(m), __float_as_uint(m), false, false); return fmaxf(__uint_as_float(rr[0]), __uint_as_float(rr[1])); }
__device__ __forceinline__ float swap_sum(float m) { auto rr = __builtin_amdgcn_permlane32_swap(__float_as_uint(m), __float_as_uint(m), false, false); return __uint_as_float(rr[0]) + __uint_as_float(rr[1]); }
__device__ __forceinline__ unsigned cvtpk(float lo, float hi) { f32x2_t v = {lo, hi}; bf16x2_t b = __builtin_convertvector(v, bf16x2_t); return __builtin_bit_cast(unsigned, b); }
__device__ __forceinline__ bf16x8v pack8(const f32x16& p, int b0) { u32x4 w; w.x = cvtpk(p[b0 + 0], p[b0 + 1]); w.y = cvtpk(p[b0 + 2], p[b0 + 3]); w.z = cvtpk(p[b0 + 4], p[b0 + 5]); w.w = cvtpk(p[b0 + 6], p[b0 + 7]); return __builtin_bit_cast(bf16x8v, w); }
__device__ __forceinline__ s16x4 tr_read(const LAS unsigned char* p) { typedef short v4i16_t __attribute__((ext_vector_type(4))); return __builtin_bit_cast(s16x4, __builtin_amdgcn_ds_read_tr16_b64_v4i16((LAS v4i16_t*)p)); }

template <int DQK>
__device__ __forceinline__ void attn_preload(const bf16* Kb0, const bf16* Kb1, const bf16* Vb, int j, int tid, u32x4& kreg, u32x4& vreg) {
    const bf16* ksrc;
    if (DQK == 64) ksrc = Kb0 + b64_off(tid >> 3, (tid & 7) * 8); else { const int mp = tid >> 8, tt = tid & 255; ksrc = (mp ? Kb1 : Kb0) + (tt >> 2) * 32 + (tt & 3) * 8; }
    const bf16* vsrc = Vb + b64_off(tid >> 3, (tid & 7) * 8);
    kreg = *(const u32x4*)(ksrc + (size_t)(j * 64) * DQK); vreg = *(const u32x4*)(vsrc + (size_t)(j * 64) * 64);
}
template <int DQK, int NMAP, bool FOX, bool SLC, bool PRE = false, bool NOMAX = false>
__device__ __forceinline__ void attn_core(LAS unsigned char* L, const bf16* Kb0, const bf16* Kb1, const bf16* Vb, const LAS float* cum, float cum_ref,
                                          const bf16x8v (&Qf)[NMAP][DQK / 16], u64 tilemask, int t_lane, int tw0, int win, float slope2, unsigned selw0, unsigned selw1,
                                          f32x16 (&O)[NMAP][2], float (&M)[NMAP], float (&Ls)[NMAP], int tid, bool started0 = false, int jpre = 0, u32x4 kpre = (u32x4){0u, 0u, 0u, 0u}, u32x4 vpre = (u32x4){0u, 0u, 0u, 0u}) {
    constexpr int KP = DQK * 2 + 16, VP = 192;
    const int lane = tid & 63, r = lane & 31, h = lane >> 5;
    int kdst; const bf16* ksrc;
    if (DQK == 64) { kdst = (tid >> 3) * KP + (tid & 7) * 16; ksrc = Kb0 + b64_off(tid >> 3, (tid & 7) * 8); }
    else { const int mp = tid >> 8, tt = tid & 255; kdst = mp * 5120 + (tt >> 2) * KP + (tt & 3) * 16; ksrc = (mp ? Kb1 : Kb0) + (tt >> 2) * 32 + (tt & 3) * 8; }
    const int vdst = (tid >> 3) * VP + (tid & 7) * 16; const bf16* vsrc = Vb + b64_off(tid >> 3, (tid & 7) * 8);
    const LAS unsigned char* kfrag = L + A_KOFF + r * KP + h * 16;
    const LAS unsigned char* vfrag = L + A_VOFF + (4 * h + ((lane & 15) >> 2)) * VP + (16 * ((lane >> 4) & 1) + 4 * (lane & 3)) * 2;
    u32x4 kreg, vreg; float breg = 0.f;
    u64 mk = tilemask;
    int j = PRE ? jpre : 63 - __builtin_clzll(mk); mk &= ~(1ull << j);
    { const int kv0 = j * 64; if (PRE) { kreg = kpre; vreg = vpre; } else { kreg = *(const u32x4*)(ksrc + (size_t)kv0 * DQK); vreg = *(const u32x4*)(vsrc + (size_t)kv0 * 64); } if (FOX) breg = (cum_ref - cum[kv0 + lane]) * LOG2E; }
    *(LAS u32x4*)(L + A_KOFF + kdst) = kreg; *(LAS u32x4*)(L + A_VOFF + vdst) = vreg; if (FOX) *(LAS float*)(L + A_BOFF + tid * 4) = breg;
    __syncthreads();
    int buf = 0; bool started = started0;
    float pdummy = 0.f; int idummy = 0; f32x16 dm0; for (int i = 0; i < 16; ++i) dm0[i] = 0.f;
    for (;;) {
        const bool more = mk != 0ull; int jn = 0;
        if (more) { jn = 63 - __builtin_clzll(mk); mk &= ~(1ull << jn); const int kv0 = jn * 64;
            kreg = *(const u32x4*)(ksrc + (size_t)kv0 * DQK); vreg = *(const u32x4*)(vsrc + (size_t)kv0 * 64); if (FOX) breg = (cum_ref - cum[kv0 + lane]) * LOG2E; }
        { const int kv0 = j * 64;
          bool wave_has = true; float selb = 0.f;
          if (SLC) { const bool mine = ((j < 32 ? (selw0 >> j) : (selw1 >> (j - 32))) & 1u) != 0u; selb = mine ? 0.f : -INFINITY; wave_has = __any(mine); }
          if (wave_has && !(kv0 > tw0 + 31) && !(tw0 - (kv0 + 63) >= win)) {
            const bool need_mask = (kv0 + 63 > tw0) || (tw0 + 31 - kv0 >= win);
            const int dl = t_lane - kv0 - 4 * h;
            bf16x8v pa[NMAP][4];
#pragma unroll
            for (int mp = 0; mp < NMAP; ++mp) {
                f32x16 p0, p1;
                if (FOX) { const LAS f32x4* bl = (const LAS f32x4*)(L + A_BOFF + buf * A_BTILE + (tid >> 6) * 256) + h; const float mm = NOMAX ? 0.f : M[mp];
#pragma unroll
                    for (int g4 = 0; g4 < 4; ++g4) { const f32x4 b0 = bl[2 * g4], b1 = bl[8 + 2 * g4];
                        p0[4 * g4 + 0] = b0.x - mm; p0[4 * g4 + 1] = b0.y - mm; p0[4 * g4 + 2] = b0.z - mm; p0[4 * g4 + 3] = b0.w - mm; p1[4 * g4 + 0] = b1.x - mm; p1[4 * g4 + 1] = b1.y - mm; p1[4 * g4 + 2] = b1.z - mm; p1[4 * g4 + 3] = b1.w - mm; } }
                else { const float base_l = (slope2 * (float)(kv0 + 4 * h - tw0) - (NOMAX ? 0.f : M[mp])) + selb, s8 = slope2 * 8.f, s32 = slope2 * 32.f;
                    p0[0] = base_l; p0[1] = p0[0] + slope2; p0[2] = p0[1] + slope2; p0[3] = p0[2] + slope2;
#pragma unroll
                    for (int reg = 4; reg < 16; ++reg) p0[reg] = p0[reg - 4] + s8;
#pragma unroll
                    for (int reg = 0; reg < 16; ++reg) p1[reg] = p0[reg] + s32; }
                const LAS unsigned char* kb = kfrag + buf * A_KBUF + (DQK == 32 ? mp * 5120 : 0);
#pragma unroll
                for (int s = 0; s < DQK / 16; ++s) { const bf16x8v kf0 = *(const LAS bf16x8v*)(kb + s * 32), kf1 = *(const LAS bf16x8v*)(kb + 32 * KP + s * 32);
#ifdef PROBE_X_LDSK
                    { const bf16x8v z0 = *(const volatile LAS bf16x8v*)(kb + s * 32), z1 = *(const volatile LAS bf16x8v*)(kb + 32 * KP + s * 32); idummy ^= z0[0] ^ z1[1]; }
#endif
#ifdef PROBE_X_MFMA
                    dm0 = __builtin_amdgcn_mfma_f32_32x32x16_bf16(kf0, Qf[mp][s], dm0, 0, 0, 0); dm0 = __builtin_amdgcn_mfma_f32_32x32x16_bf16(kf1, Qf[mp][s], dm0, 0, 0, 0);
#endif
                    p0 = __builtin_amdgcn_mfma_f32_32x32x16_bf16(kf0, Qf[mp][s], p0, 0, 0, 0); p1 = __builtin_amdgcn_mfma_f32_32x32x16_bf16(kf1, Qf[mp][s], p1, 0, 0, 0); }
                if (need_mask) {
#pragma unroll
                    for (int reg = 0; reg < 16; ++reg) { const int d0 = dl - crow0(reg), d1 = d0 - 32;
                        p0[reg] = (d0 >= 0 && d0 < win) ? p0[reg] : -INFINITY; p1[reg] = (d1 >= 0 && d1 < win) ? p1[reg] : -INFINITY; } }
                if (!NOMAX) {
                float mt = fmaxf(fmaxf(p0[0], p1[0]), fmaxf(p0[1], p1[1]));
#pragma unroll
                for (int reg = 2; reg < 16; reg += 2) mt = fmaxf(fmaxf(mt, fmaxf(fmaxf(p0[reg], p1[reg]), p0[reg + 1])), p1[reg + 1]);
                mt = swap_max(mt);
                if (!started || __any(mt > 8.f)) {
                    const float d = (mt > -1e30f) ? (started ? fmaxf(mt, 0.f) : mt) : 0.f, alpha = __builtin_amdgcn_exp2f(-d);
                    O[mp][0] *= alpha; O[mp][1] *= alpha; Ls[mp] *= alpha; M[mp] += d;
#pragma unroll
                    for (int reg = 0; reg < 16; ++reg) { p0[reg] -= d; p1[reg] -= d; } } }
                float rs = 0.f;
#ifdef PROBE_X_EXP
#pragma unroll
                for (int reg = 0; reg < 16; ++reg) { pdummy += __builtin_amdgcn_exp2f(p0[reg] - 1.f) + __builtin_amdgcn_exp2f(p1[reg] - 1.f); }
#endif
#pragma unroll
                for (int reg = 0; reg < 16; ++reg) { p0[reg] = __builtin_amdgcn_exp2f(p0[reg]); p1[reg] = __builtin_amdgcn_exp2f(p1[reg]); rs += p0[reg] + p1[reg]; }
                Ls[mp] += rs;
                pa[mp][0] = pack8(p0, 0); pa[mp][1] = pack8(p0, 8); pa[mp][2] = pack8(p1, 0); pa[mp][3] = pack8(p1, 8);
            }
            started = true;
            const LAS unsigned char* vb = vfrag + buf * A_VBUF;
#pragma unroll
            for (int db = 0; db < 2; ++db)
#pragma unroll
                for (int ks = 0; ks < 4; ++ks) { const s16x4 lo = tr_read(vb + ks * (16 * VP) + db * 64), hi = tr_read(vb + ks * (16 * VP) + db * 64 + 8 * VP);
                    const bf16x8v vf = {lo[0], lo[1], lo[2], lo[3], hi[0], hi[1], hi[2], hi[3]};
#pragma unroll
                    for (int mp = 0; mp < NMAP; ++mp) O[mp][db] = __builtin_amdgcn_mfma_f32_32x32x16_bf16(vf, pa[mp][ks], O[mp][db], 0, 0, 0); }
          } }
        if (more) { *(LAS u32x4*)(L + A_KOFF + (buf ^ 1) * A_KBUF + kdst) = kreg; *(LAS u32x4*)(L + A_VOFF + (buf ^ 1) * A_VBUF + vdst) = vreg; if (FOX) *(LAS float*)(L + A_BOFF + (buf ^ 1) * A_BTILE + tid * 4) = breg; }
#ifdef PROBE_X_BAR
        __syncthreads();
#endif
        __syncthreads();
        if (!more) break;
        j = jn; buf ^= 1;
    }
    if (pdummy == 123.456f || idummy == 0x7fffabcd || dm0[3] == 98765.4321f) Ls[0] += 1e-30f;
}
#ifndef AC2_MODE
#define AC2_MODE 0
#endif
#ifndef AC2_INIT_VALU
#define AC2_INIT_VALU 24
#endif
template <bool FOX, bool SLC>
__device__ __forceinline__ void attn_core2(LAS unsigned char* L, const bf16* Kb0, const bf16* Vb, const LAS float* cum, float cum_ref,
                                           const bf16x8v (&Qf)[4], u64 tilemask, int t_lane, int tw0, int win, float slope2, unsigned selw0, unsigned selw1,
                                           f32x16 (&O)[2], float& M, float& Ls, int tid) {
    constexpr int KP = 144, VP = 192;
    const int lane = tid & 63, r = lane & 31, h = lane >> 5;
    const int kdst = (tid >> 3) * KP + (tid & 7) * 16; const bf16* ksrc = Kb0 + b64_off(tid >> 3, (tid & 7) * 8);
    const int vdst = (tid >> 3) * VP + (tid & 7) * 16; const bf16* vsrc = Vb + b64_off(tid >> 3, (tid & 7) * 8);
    const LAS unsigned char* kfrag = L + A_KOFF + r * KP + h * 16;
    const LAS unsigned char* vfrag = L + A_VOFF + (4 * h + ((lane & 15) >> 2)) * VP + (16 * ((lane >> 4) & 1) + 4 * (lane & 3)) * 2;
#define AC2_ACTIVE(jj) (!((jj) * 64 > tw0 + 31) && !(tw0 - ((jj) * 64 + 63) >= win))
#define AC2_INIT(jj, kslot, q0, q1) do { const int kv0_ = (jj) * 64; \
        if (FOX) { const LAS f32x4* bl = (const LAS f32x4*)(L + A_BOFF + (kslot) * 256) + h; const float mm = M; \
            _Pragma("unroll") for (int g4 = 0; g4 < 4; ++g4) { const f32x4 b0 = bl[2 * g4], b1 = bl[8 + 2 * g4]; \
                q0[4 * g4 + 0] = b0.x - mm; q0[4 * g4 + 1] = b0.y - mm; q0[4 * g4 + 2] = b0.z - mm; q0[4 * g4 + 3] = b0.w - mm; q1[4 * g4 + 0] = b1.x - mm; q1[4 * g4 + 1] = b1.y - mm; q1[4 * g4 + 2] = b1.z - mm; q1[4 * g4 + 3] = b1.w - mm; } } \
        else { float selb = 0.f; if (SLC) selb = ((((jj) < 32) ? (selw0 >> (jj)) : (selw1 >> ((jj) - 32))) & 1u) ? 0.f : -INFINITY; \
            const float base_l = (slope2 * (float)(kv0_ + 4 * h - tw0) - M) + selb, s8 = slope2 * 8.f, s32 = slope2 * 32.f; \
            q0[0] = base_l; q0[1] = q0[0] + slope2; q0[2] = q0[1] + slope2; q0[3] = q0[2] + slope2; \
            _Pragma("unroll") for (int reg = 4; reg < 16; ++reg) q0[reg] = q0[reg - 4] + s8; \
            _Pragma("unroll") for (int reg = 0; reg < 16; ++reg) q1[reg] = q0[reg] + s32; } } while (0)
#define AC2_QK(jj, kslot) do { AC2_INIT(jj, kslot, p0, p1); \
        const LAS unsigned char* kb_ = kfrag + (kslot) * A_KBUF; \
        _Pragma("unroll") for (int s_ = 0; s_ < 4; ++s_) { const bf16x8v kf0 = *(const LAS bf16x8v*)(kb_ + s_ * 32), kf1 = *(const LAS bf16x8v*)(kb_ + 32 * KP + s_ * 32); \
            p0 = __builtin_amdgcn_mfma_f32_32x32x16_bf16(kf0, Qf[s_], p0, 0, 0, 0); p1 = __builtin_amdgcn_mfma_f32_32x32x16_bf16(kf1, Qf[s_], p1, 0, 0, 0); } } while (0)
    u32x4 kreg, vreg; float breg = 0.f;
    u64 mk = tilemask;
    int j = 63 - __builtin_clzll(mk); mk &= ~(1ull << j);
    int jn = -1; if (mk) { jn = 63 - __builtin_clzll(mk); mk &= ~(1ull << jn); }
    { kreg = *(const u32x4*)(ksrc + (size_t)j * 64 * 64); vreg = *(const u32x4*)(vsrc + (size_t)j * 64 * 64); if (FOX && tid < 64) breg = (cum_ref - cum[j * 64 + tid]) * LOG2E;
      *(LAS u32x4*)(L + A_KOFF + kdst) = kreg; *(LAS u32x4*)(L + A_VOFF + vdst) = vreg; if (FOX && tid < 64) *(LAS float*)(L + A_BOFF + tid * 4) = breg;
      if (jn >= 0) { kreg = *(const u32x4*)(ksrc + (size_t)jn * 64 * 64); if (FOX && tid < 64) breg = (cum_ref - cum[jn * 64 + tid]) * LOG2E;
          *(LAS u32x4*)(L + A_KOFF + A_KBUF + kdst) = kreg; if (FOX && tid < 64) *(LAS float*)(L + A_BOFF + 256 + tid * 4) = breg; } }
    __syncthreads();
    f32x16 p0, p1;
    bool started = false;
    int ks = 0, vs = 0;
    if (AC2_ACTIVE(j)) AC2_QK(j, 0);
    for (;;) {
        int jnn = -1; if (mk) { jnn = 63 - __builtin_clzll(mk); mk &= ~(1ull << jnn); }
        if (jnn >= 0) { kreg = *(const u32x4*)(ksrc + (size_t)jnn * 64 * 64); if (FOX && tid < 64) breg = (cum_ref - cum[jnn * 64 + tid]) * LOG2E; }
        if (jn >= 0) vreg = *(const u32x4*)(vsrc + (size_t)jn * 64 * 64);
        const bool act = AC2_ACTIVE(j), actn = jn >= 0 && AC2_ACTIVE(jn);
        if (act) {
            const int kv0 = j * 64;
            if ((kv0 + 63 > tw0) || (tw0 + 31 - kv0 >= win)) { const int dl = t_lane - kv0 - 4 * h;
#pragma unroll
                for (int reg = 0; reg < 16; ++reg) { const int d0 = dl - crow0(reg), d1 = d0 - 32;
                    p0[reg] = (d0 >= 0 && d0 < win) ? p0[reg] : -INFINITY; p1[reg] = (d1 >= 0 && d1 < win) ? p1[reg] : -INFINITY; } }
            float mt = fmaxf(fmaxf(p0[0], p1[0]), fmaxf(p0[1], p1[1]));
#pragma unroll
            for (int reg = 2; reg < 16; reg += 2) mt = fmaxf(fmaxf(mt, fmaxf(fmaxf(p0[reg], p1[reg]), p0[reg + 1])), p1[reg + 1]);
            mt = swap_max(mt);
            if (!started || __any(mt > 8.f)) {
                const float d = (mt > -1e30f) ? (started ? fmaxf(mt, 0.f) : mt) : 0.f, alpha = __builtin_amdgcn_exp2f(-d);
                O[0] *= alpha; O[1] *= alpha; Ls *= alpha; M += d;
#pragma unroll
                for (int reg = 0; reg < 16; ++reg) { p0[reg] -= d; p1[reg] -= d; } }
            started = true;
#if AC2_MODE == 1
            {
                const int jq = jn >= 0 ? jn : 0;
                float rs = 0.f;
#pragma unroll
                for (int reg = 0; reg < 16; ++reg) { p0[reg] = __builtin_amdgcn_exp2f(p0[reg]); p1[reg] = __builtin_amdgcn_exp2f(p1[reg]); rs += p0[reg] + p1[reg]; }
                Ls += rs;
                const bf16x8v pa0 = pack8(p0, 0), pa1 = pack8(p0, 8), pa2 = pack8(p1, 0), pa3 = pack8(p1, 8);
                AC2_QK(jq, ks ^ 1);
                const LAS unsigned char* vb = vfrag + vs * A_VBUF;
#pragma unroll
                for (int db = 0; db < 2; ++db)
#pragma unroll
                    for (int kq = 0; kq < 4; ++kq) { const s16x4 lo = tr_read(vb + kq * (16 * VP) + db * 64), hi = tr_read(vb + kq * (16 * VP) + db * 64 + 8 * VP);
                        const bf16x8v vf = {lo[0], lo[1], lo[2], lo[3], hi[0], hi[1], hi[2], hi[3]};
                        O[db] = __builtin_amdgcn_mfma_f32_32x32x16_bf16(vf, kq == 0 ? pa0 : kq == 1 ? pa1 : kq == 2 ? pa2 : pa3, O[db], 0, 0, 0); }
            }
#else
            {
                const int jq = jn >= 0 ? jn : 0;
                f32x16 n0, n1;
                AC2_INIT(jq, ks ^ 1, n0, n1);
                const LAS unsigned char* kb_ = kfrag + (ks ^ 1) * A_KBUF;
                bf16x8v kf[8];
#pragma unroll
                for (int s_ = 0; s_ < 4; ++s_) { kf[2 * s_] = *(const LAS bf16x8v*)(kb_ + s_ * 32); kf[2 * s_ + 1] = *(const LAS bf16x8v*)(kb_ + 32 * KP + s_ * 32); }
                const LAS unsigned char* vb = vfrag + vs * A_VBUF;
                __builtin_amdgcn_sched_barrier(0);
                float ra = 0.f, rb = 0.f; unsigned w[16];
#define AC2_PINF(x) asm volatile("" : "+v"(x))
#define AC2_QGAP(i) do { if ((i) & 1) n1 = __builtin_amdgcn_mfma_f32_32x32x16_bf16(kf[i], Qf[(i) >> 1], n1, 0, 0, 0); else n0 = __builtin_amdgcn_mfma_f32_32x32x16_bf16(kf[i], Qf[(i) >> 1], n0, 0, 0, 0); \
                    float e0 = __builtin_amdgcn_exp2f(p0[2 * (i)]), e1 = __builtin_amdgcn_exp2f(p0[2 * (i) + 1]), e2 = __builtin_amdgcn_exp2f(p1[2 * (i)]), e3 = __builtin_amdgcn_exp2f(p1[2 * (i) + 1]); \
                    ra += e0 + e1; rb += e2 + e3; \
                    AC2_PINF(e0); AC2_PINF(e1); AC2_PINF(e2); AC2_PINF(e3); AC2_PINF(ra); AC2_PINF(rb); \
                    p0[2 * (i)] = e0; p0[2 * (i) + 1] = e1; p1[2 * (i)] = e2; p1[2 * (i) + 1] = e3; \
                    if ((i) >= 4) { w[2 * ((i) - 4)] = cvtpk(p0[4 * ((i) - 4)], p0[4 * ((i) - 4) + 1]); w[2 * ((i) - 4) + 1] = cvtpk(p0[4 * ((i) - 4) + 2], p0[4 * ((i) - 4) + 3]); AC2_PINF(w[2 * ((i) - 4)]); AC2_PINF(w[2 * ((i) - 4) + 1]); } \
                    if ((i) == 6) { vl[0] = tr_read(vb); vh[0] = tr_read(vb + 8 * VP); } \
                    if ((i) == 7) { vl[1] = tr_read(vb + 64); vh[1] = tr_read(vb + 64 + 8 * VP); } \
                    __builtin_amdgcn_sched_barrier(0); } while (0)
                s16x4 vl[2], vh[2];
                AC2_QGAP(0); AC2_QGAP(1); AC2_QGAP(2); AC2_QGAP(3); AC2_QGAP(4); AC2_QGAP(5); AC2_QGAP(6); AC2_QGAP(7);
                Ls += ra + rb;
#define AC2_PA(kq) __builtin_bit_cast(bf16x8v, (u32x4){w[4 * (kq)], w[4 * (kq) + 1], w[4 * (kq) + 2], w[4 * (kq) + 3]})
#define AC2_PGAP(g) do { const int kq_ = (g) >> 1, db_ = (g) & 1; const bf16x8v vf = {vl[(g) & 1][0], vl[(g) & 1][1], vl[(g) & 1][2], vl[(g) & 1][3], vh[(g) & 1][0], vh[(g) & 1][1], vh[(g) & 1][2], vh[(g) & 1][3]}; \
                    if ((g) < 6) { const int kq2 = ((g) + 2) >> 1, db2 = (g) & 1; vl[(g) & 1] = tr_read(vb + kq2 * (16 * VP) + db2 * 64); vh[(g) & 1] = tr_read(vb + kq2 * (16 * VP) + db2 * 64 + 8 * VP); } \
                    O[db_] = __builtin_amdgcn_mfma_f32_32x32x16_bf16(vf, AC2_PA(kq_), O[db_], 0, 0, 0); \
                    if ((g) < 4) { w[8 + 2 * (g)] = cvtpk(p1[4 * (g)], p1[4 * (g) + 1]); w[8 + 2 * (g) + 1] = cvtpk(p1[4 * (g) + 2], p1[4 * (g) + 3]); AC2_PINF(w[8 + 2 * (g)]); AC2_PINF(w[8 + 2 * (g) + 1]); } \
                    __builtin_amdgcn_sched_barrier(0); } while (0)
                AC2_PGAP(0); AC2_PGAP(1); AC2_PGAP(2); AC2_PGAP(3); AC2_PGAP(4); AC2_PGAP(5); AC2_PGAP(6); AC2_PGAP(7);
#undef AC2_PGAP
#undef AC2_PA
#undef AC2_QGAP
#undef AC2_PINF
                p0 = n0; p1 = n1;
            }
#endif
        } else if (actn) AC2_QK(jn, ks ^ 1);
        if (jnn >= 0) { *(LAS u32x4*)(L + A_KOFF + ks * A_KBUF + kdst) = kreg; if (FOX && tid < 64) *(LAS float*)(L + A_BOFF + ks * 256 + tid * 4) = breg; }
        if (jn >= 0) *(LAS u32x4*)(L + A_VOFF + (vs ^ 1) * A_VBUF + vdst) = vreg;
        __syncthreads();
        if (jn < 0) break;
        j = jn; jn = jnn; ks ^= 1; vs ^= 1;
    }
#undef AC2_QK
#undef AC2_INIT
#undef AC2_ACTIVE
}
__device__ __forceinline__ size_t mix_off(size_t n, int c, int W) { return ((n >> 5) * (size_t)(W / 8) + (size_t)(c >> 3)) * 256 + (n & 31) * 8 + (c & 7); }
#define ATTN_FOR_CHUNKS(db, g4) _Pragma("unroll") for (int db = 0; db < 2; ++db) _Pragma("unroll") for (int g4 = 0; g4 < 4; ++g4)

__device__ __forceinline__ void unpack8(const u32x4 w, float (&f)[8]) { f[0] = __uint_as_float(w.x << 16); f[1] = __uint_as_float(w.x & 0xffff0000u); f[2] = __uint_as_float(w.y << 16); f[3] = __uint_as_float(w.y & 0xffff0000u);
    f[4] = __uint_as_float(w.z << 16); f[5] = __uint_as_float(w.z & 0xffff0000u); f[6] = __uint_as_float(w.w << 16); f[7] = __uint_as_float(w.w & 0xffff0000u); }
__device__ __forceinline__ void ph_norm_bf16_from_bf16(const Ctx& c, const bf16* x, const float* g, bf16* out) {
    constexpr int RB = 4; float gg[2][8];
#pragma unroll
    for (int j = 0; j < 2; ++j) { const f32x4 a = ((const f32x4*)g)[2 * c.lane + 128 * j], b2 = ((const f32x4*)g)[2 * c.lane + 128 * j + 1]; gg[j][0] = a.x; gg[j][1] = a.y; gg[j][2] = a.z; gg[j][3] = a.w; gg[j][4] = b2.x; gg[j][5] = b2.y; gg[j][6] = b2.z; gg[j][7] = b2.w; }
    for (int row0 = c.gw * RB; row0 < NT; row0 += c.ngw * RB) {
        u32x4 v[RB][2];
#pragma unroll
        for (int q = 0; q < RB; ++q)
#pragma unroll
            for (int j = 0; j < 2; ++j) v[q][j] = ((const u32x4*)(x + (size_t)(row0 + q) * D_))[c.lane + 64 * j];
#pragma unroll
        for (int q = 0; q < RB; ++q) { float f[2][8]; float ss = 0.f;
#pragma unroll
            for (int j = 0; j < 2; ++j) { unpack8(v[q][j], f[j]);
#pragma unroll
                for (int e = 0; e < 8; ++e) ss = fmaf(f[j][e], f[j][e], ss); }
            const float r = rsqrtf(wave_sum_l(ss, c.lane) * (1.f / D_) + EPS);
#pragma unroll
            for (int j = 0; j < 2; ++j) { u32x4 o; o.x = pk2(f[j][0] * r * gg[j][0], f[j][1] * r * gg[j][1]); o.y = pk2(f[j][2] * r * gg[j][2], f[j][3] * r * gg[j][3]); o.z = pk2(f[j][4] * r * gg[j][4], f[j][5] * r * gg[j][5]); o.w = pk2(f[j][6] * r * gg[j][6], f[j][7] * r * gg[j][7]);
                ((u32x4*)(out + (size_t)(row0 + q) * D_))[c.lane + 64 * j] = o; } }
    }
}
__device__ __forceinline__ void ph_norm_final_from_bf16(const Ctx& c, const bf16* x, const float* g, float* out) {
    constexpr int RB = 4; float gg[2][8];
#pragma unroll
    for (int j = 0; j < 2; ++j) { const f32x4 a = ((const f32x4*)g)[2 * c.lane + 128 * j], b2 = ((const f32x4*)g)[2 * c.lane + 128 * j + 1]; gg[j][0] = a.x; gg[j][1] = a.y; gg[j][2] = a.z; gg[j][3] = a.w; gg[j][4] = b2.x; gg[j][5] = b2.y; gg[j][6] = b2.z; gg[j][7] = b2.w; }
    for (int row0 = c.gw * RB; row0 < NT; row0 += c.ngw * RB) {
        u32x4 v[RB][2];
#pragma unroll
        for (int q = 0; q < RB; ++q)
#pragma unroll
            for (int j = 0; j < 2; ++j) v[q][j] = ((const u32x4*)(x + (size_t)(row0 + q) * D_))[c.lane + 64 * j];
#pragma unroll
        for (int q = 0; q < RB; ++q) { float f[2][8]; float ss = 0.f;
#pragma unroll
            for (int j = 0; j < 2; ++j) { unpack8(v[q][j], f[j]);
#pragma unroll
                for (int e = 0; e < 8; ++e) ss = fmaf(f[j][e], f[j][e], ss); }
            const float r = rsqrtf(wave_sum_l(ss, c.lane) * (1.f / D_) + EPS);
#pragma unroll
            for (int j = 0; j < 2; ++j) { f32x4* o = (f32x4*)(out + (size_t)(row0 + q) * D_) + 2 * c.lane + 128 * j;
                o[0] = (f32x4){f[j][0] * r * gg[j][0], f[j][1] * r * gg[j][1], f[j][2] * r * gg[j][2], f[j][3] * r * gg[j][3]}; o[1] = (f32x4){f[j][4] * r * gg[j][4], f[j][5] * r * gg[j][5], f[j][6] * r * gg[j][6], f[j][7] * r * gg[j][7]}; } }
    }
}
__device__ __forceinline__ void ph_norm_bf16(const Ctx& c, const float* x, const float* g, bf16* out, bf16* raw) {
    constexpr int RB = 4;
    f32x4 gg[4];
#pragma unroll
    for (int j = 0; j < 4; ++j) gg[j] = ((const f32x4*)g)[c.lane + 64 * j];
    for (int row0 = c.gw * RB; row0 < NT; row0 += c.ngw * RB) {
        f32x4 v[RB][4];
#pragma unroll
        for (int q = 0; q < RB; ++q)
#pragma unroll
            for (int j = 0; j < 4; ++j) v[q][j] = ((const f32x4*)(x + (size_t)(row0 + q) * D_))[c.lane + 64 * j];
#pragma unroll
        for (int q = 0; q < RB; ++q) { float ss = 0.f;
#pragma unroll
            for (int j = 0; j < 4; ++j) ss += v[q][j].x * v[q][j].x + v[q][j].y * v[q][j].y + v[q][j].z * v[q][j].z + v[q][j].w * v[q][j].w;
            const float r = rsqrtf(wave_sum_l(ss, c.lane) * (1.f / D_) + EPS);
            u64* o8 = (u64*)(out + (size_t)(row0 + q) * D_) + c.lane; u64* r8 = (u64*)(raw + (size_t)(row0 + q) * D_) + c.lane;
#pragma unroll
            for (int j = 0; j < 4; ++j) { o8[64 * j] = (u64)pk2(v[q][j].x * r * gg[j].x, v[q][j].y * r * gg[j].y) | ((u64)pk2(v[q][j].z * r * gg[j].z, v[q][j].w * r * gg[j].w) << 32);
                r8[64 * j] = (u64)pk2(v[q][j].x, v[q][j].y) | ((u64)pk2(v[q][j].z, v[q][j].w) << 32); } }
    }
}
__device__ __forceinline__ void ph_norm_final(const Ctx& c, float* x, const float* g) {
    constexpr int RB = 4;
    f32x4 gg[4];
#pragma unroll
    for (int j = 0; j < 4; ++j) gg[j] = ((const f32x4*)g)[c.lane + 64 * j];
    for (int row0 = c.gw * RB; row0 < NT; row0 += c.ngw * RB) {
        f32x4 v[RB][4];
#pragma unroll
        for (int q = 0; q < RB; ++q)
#pragma unroll
            for (int j = 0; j < 4; ++j) v[q][j] = ((const f32x4*)(x + (size_t)(row0 + q) * D_))[c.lane + 64 * j];
#pragma unroll
        for (int q = 0; q < RB; ++q) { float ss = 0.f;
#pragma unroll
            for (int j = 0; j < 4; ++j) ss += v[q][j].x * v[q][j].x + v[q][j].y * v[q][j].y + v[q][j].z * v[q][j].z + v[q][j].w * v[q][j].w;
            const float r = rsqrtf(wave_sum_l(ss, c.lane) * (1.f / D_) + EPS);
            f32x4* xr = (f32x4*)(x + (size_t)(row0 + q) * D_) + c.lane;
#pragma unroll
            for (int j = 0; j < 4; ++j) xr[64 * j] = v[q][j] * r * gg[j]; }
    }
}

template <class AF, class EF>
__device__ __forceinline__ void naive_gemm(const Ctx& c, int M, int N, int K, AF af, const float* W, int ldb, EF ef) {
    LAS float* As = (LAS float*)c.lds;
    LAS float* Bs = As + 16 * 132;
    const int tm = (M + 127) / 128, tn = (N + 127) / 128, ntile = tm * tn;
    const int ty = c.tid >> 4, tx = c.tid & 15;
    for (int tile = c.bid; tile < ntile; tile += c.G) {
        const int m0 = (tile / tn) * 128, n0 = (tile % tn) * 128;
        float acc[4][8];
#pragma unroll
        for (int i = 0; i < 4; ++i)
#pragma unroll
            for (int j = 0; j < 8; ++j) acc[i][j] = 0.f;
        for (int k0 = 0; k0 < K; k0 += 16) {
            __syncthreads();
#pragma unroll
            for (int i = 0; i < 4; ++i) { const int e = c.tid + i * 512, r = e >> 4, kk = e & 15; const int row = m0 + r;
                As[kk * 132 + r] = (row < M) ? af(row, k0 + kk) : 0.f; }
#pragma unroll
            for (int i = 0; i < 4; ++i) { const int e = c.tid + i * 512, kk = e >> 7, cc = e & 127; const int col = n0 + cc;
                Bs[kk * 132 + cc] = (col < N) ? W[(size_t)(k0 + kk) * ldb + col] : 0.f; }
            __syncthreads();
#pragma unroll 2
            for (int kk = 0; kk < 16; ++kk) {
                float a[4], b[8];
#pragma unroll
                for (int i = 0; i < 4; ++i) a[i] = As[kk * 132 + ty * 4 + i];
#pragma unroll
                for (int j = 0; j < 8; ++j) b[j] = Bs[kk * 132 + tx * 8 + j];
#pragma unroll
                for (int i = 0; i < 4; ++i)
#pragma unroll
                    for (int j = 0; j < 8; ++j) acc[i][j] = fmaf(a[i], b[j], acc[i][j]);
            }
        }
        LAS float* Cs = Bs + 16 * 132;
        __syncthreads();
#pragma unroll
        for (int i = 0; i < 4; ++i)
#pragma unroll
            for (int j = 0; j < 8; ++j) Cs[(ty * 4 + i) * 129 + tx * 8 + j] = acc[i][j];
        __syncthreads();
#pragma unroll 1
        for (int e = c.tid; e < 128 * 128; e += NTHREADS) { const int r = e >> 7, cc = e & 127, row = m0 + r, col = n0 + cc; if (row < M && col < N) ef(row, col, Cs[r * 129 + cc]); }
    }
    __syncthreads();
}

struct InProjOut { bf16* qn; bf16* kv6; bf16* fqkv; bf16* dqk; bf16* dv; float* gate; float* fl; const float* b_gate; const float* b_fgt; };
__device__ __forceinline__ void inproj_store(const InProjOut& o, int n, int col, float v) {
    const int b = n / T_, t = n % T_;
    if (col < C_KV6) { const int h = col >> 6, d = col & 63; o.qn[((size_t)(b * 8 + h) * T_ + t) * 64 + d] = (bf16)f2bf(v * (0.125f * LOG2E)); }
    else if (col < C_GATE) { const int cc = col - C_KV6, idx = cc >> 7, g = (cc >> 6) & 1, d = cc & 63;
        ((bf16*)((unsigned char*)o.kv6 + idx * KV6_STRIDE))[((size_t)(b * 2 + g) * T_ + t) * 64 + d] = (bf16)f2bf(v); }
    else if (col < C_FQ) { const int j = col - C_GATE; o.gate[(size_t)n * 24 + j] = sigmoidf_(v + o.b_gate[j]); }
    else if (col < C_FF) { const int cc = col - C_FQ, idx = cc >> 8, h = (cc >> 6) & 3, d = cc & 63;
        o.fqkv[(size_t)idx * (8 * MiB) + ((size_t)(b * 4 + h) * T_ + t) * 64 + d] = (bf16)f2bf(idx == 0 ? v * (0.125f * LOG2E) : v); }
    else if (col < C_DQ) { const int h = col - C_FF; o.fl[(size_t)(b * 4 + h) * T_ + t] = log_sigmoidf_(v + o.b_fgt[h]); }
    else if (col < C_DV) { const int cc = col - C_DQ, idx = cc >> 8, h = (cc >> 6) & 3, i = (cc >> 5) & 1, d = cc & 31;
        o.dqk[(size_t)idx * (8 * MiB) + ((size_t)((b * 4 + h) * 2 + i) * T_ + t) * 32 + d] = (bf16)f2bf(idx == 0 ? v * (0.17677669529663687f * LOG2E) : v); }
    else { const int cc = col - C_DV, h = cc >> 6, d = cc & 63; o.dv[((size_t)(b * 4 + h) * T_ + t) * 64 + d] = (bf16)f2bf(v); }
}

__device__ __forceinline__ void ph_cumsum(const Ctx& c, float* fl) {
    for (int s = c.gw; s < B_ * 4; s += c.ngw) {
        float* p = fl + (size_t)s * T_; float carry = 0.f;
        for (int t0 = 0; t0 < T_; t0 += 64) {
            float v = p[t0 + c.lane];
#pragma unroll
            for (int o = 1; o < 64; o <<= 1) { const float u = __shfl_up(v, o); if (c.lane >= o) v += u; }
            v += carry; p[t0 + c.lane] = v; carry = __shfl(v, 63);
        }
    }
}

template <int DQK>
__device__ __forceinline__ float naive_attn_row(const bf16* q, const bf16* K, const bf16* V, int t, u64 mask, float slope2, const float* cum, int win, int lane) {
    float qv[DQK];
    { const u32x4* q4 = (const u32x4*)q;
#pragma unroll
      for (int i = 0; i < DQK / 8; ++i) { const u32x4 w = q4[i];
          qv[8 * i + 0] = __uint_as_float(w.x << 16); qv[8 * i + 1] = __uint_as_float(w.x & 0xffff0000u);
          qv[8 * i + 2] = __uint_as_float(w.y << 16); qv[8 * i + 3] = __uint_as_float(w.y & 0xffff0000u);
          qv[8 * i + 4] = __uint_as_float(w.z << 16); qv[8 * i + 5] = __uint_as_float(w.z & 0xffff0000u);
          qv[8 * i + 6] = __uint_as_float(w.w << 16); qv[8 * i + 7] = __uint_as_float(w.w & 0xffff0000u); } }
    const float cumt = cum ? cum[t] : 0.f;
    float m = -INFINITY, l = 0.f, o = 0.f;
    while (mask) {
        const int j = __builtin_ctzll(mask); mask &= mask - 1;
        const int kpos = 64 * j + lane; const int dist = t - kpos;
        const bool valid = dist >= 0 && dist < win;
        float s = 0.f;
        { const u32x4* k4 = (const u32x4*)(K + (size_t)kpos * DQK);
#pragma unroll
          for (int i = 0; i < DQK / 8; ++i) { const u32x4 w = k4[i];
              s = fmaf(qv[8 * i + 0], __uint_as_float(w.x << 16), s); s = fmaf(qv[8 * i + 1], __uint_as_float(w.x & 0xffff0000u), s);
              s = fmaf(qv[8 * i + 2], __uint_as_float(w.y << 16), s); s = fmaf(qv[8 * i + 3], __uint_as_float(w.y & 0xffff0000u), s);
              s = fmaf(qv[8 * i + 4], __uint_as_float(w.z << 16), s); s = fmaf(qv[8 * i + 5], __uint_as_float(w.z & 0xffff0000u), s);
              s = fmaf(qv[8 * i + 6], __uint_as_float(w.w << 16), s); s = fmaf(qv[8 * i + 7], __uint_as_float(w.w & 0xffff0000u), s); } }
        s -= slope2 * (float)dist;
        if (cum) s += (cumt - cum[kpos]) * LOG2E;
        s = valid ? s : -INFINITY;
        const float mb = wave_max(s);
        if (mb == -INFINITY) continue;
        const float mn = fmaxf(m, mb), alpha = exp2f(m - mn);
        const float p = valid ? exp2f(s - mn) : 0.f;
        l = l * alpha + wave_sum(p); o *= alpha; m = mn;
        const bf16* vb = V + (size_t)(64 * j) * 64 + lane;
#pragma unroll 8
        for (int k = 0; k < 64; ++k) o = fmaf(__shfl(p, k), bf2f(vb[(size_t)k * 64]), o);
    }
    return l > 0.f ? o / l : 0.f;
}

__device__ __forceinline__ void ph_cmp_attn(const Ctx& c, const bf16* qn, const bf16* kcmp, const bf16* vcmp, const float* gate, u64* sel, bf16* ocmp) {
    LAS float* pl = (LAS float*)(c.lds) + c.wave * 256;
    const int lane = c.lane;
    for (int it = c.gw; it < B_ * 2 * T_; it += c.ngw) {
        const int t = it % T_, bg = it / T_, b = bg >> 1, g = bg & 1;
        const int nvis = (t >= 31) ? ((t - 31) >> 4) + 1 : 0;
        const bf16* kc = kcmp + (size_t)bg * 256 * 64; const bf16* vc = vcmp + (size_t)bg * 256 * 64;
        float imp = 0.f;
        for (int hg = 0; hg < 4; ++hg) {
            const int h = g * 4 + hg; const float slope2 = alibi_slope(h + 1, 8) * LOG2E;
            const bf16* q = qn + ((size_t)(b * 8 + h) * T_ + t) * 64;
            float qv[64];
            { const u32x4* q4 = (const u32x4*)q;
#pragma unroll
              for (int i = 0; i < 8; ++i) { const u32x4 w = q4[i];
                  qv[8 * i + 0] = __uint_as_float(w.x << 16); qv[8 * i + 1] = __uint_as_float(w.x & 0xffff0000u);
                  qv[8 * i + 2] = __uint_as_float(w.y << 16); qv[8 * i + 3] = __uint_as_float(w.y & 0xffff0000u);
                  qv[8 * i + 4] = __uint_as_float(w.z << 16); qv[8 * i + 5] = __uint_as_float(w.z & 0xffff0000u);
                  qv[8 * i + 6] = __uint_as_float(w.w << 16); qv[8 * i + 7] = __uint_as_float(w.w & 0xffff0000u); } }
            float s[4]; float m = -INFINITY;
#pragma unroll
            for (int i = 0; i < 4; ++i) { const int cc = lane + 64 * i; float a = 0.f;
                if (cc < nvis) { const u32x4* k4 = (const u32x4*)(kc + (size_t)cc * 64);
#pragma unroll
                    for (int e = 0; e < 8; ++e) { const u32x4 w = k4[e];
                        a = fmaf(qv[8 * e + 0], __uint_as_float(w.x << 16), a); a = fmaf(qv[8 * e + 1], __uint_as_float(w.x & 0xffff0000u), a);
                        a = fmaf(qv[8 * e + 2], __uint_as_float(w.y << 16), a); a = fmaf(qv[8 * e + 3], __uint_as_float(w.y & 0xffff0000u), a);
                        a = fmaf(qv[8 * e + 4], __uint_as_float(w.z << 16), a); a = fmaf(qv[8 * e + 5], __uint_as_float(w.z & 0xffff0000u), a);
                        a = fmaf(qv[8 * e + 6], __uint_as_float(w.w << 16), a); a = fmaf(qv[8 * e + 7], __uint_as_float(w.w & 0xffff0000u), a); }
                    a -= slope2 * (float)(t - (16 * cc + 31)); } else a = -INFINITY;
                s[i] = a; m = fmaxf(m, a); }
            m = wave_max(m);
            float p[4], lsum = 0.f;
#pragma unroll
            for (int i = 0; i < 4; ++i) { p[i] = (lane + 64 * i < nvis) ? exp2f(s[i] - m) : 0.f; lsum += p[i]; }
            lsum = wave_sum(lsum);
            const float inv = lsum > 0.f ? 1.f / lsum : 0.f;
#pragma unroll
            for (int i = 0; i < 4; ++i) { p[i] *= inv; pl[lane + 64 * i] = p[i]; }
            asm volatile("s_waitcnt lgkmcnt(0)" ::: "memory");
            float o = 0.f;
            for (int cc = 0; cc < nvis; ++cc) o = fmaf(pl[cc], bf2f(vc[(size_t)cc * 64 + lane]), o);
            const float gt = gate[((size_t)(b * T_ + t)) * 24 + h * 3 + 0];
            ocmp[(size_t)(b * T_ + t) * 512 + h * 64 + lane] = (bf16)f2bf(gt * o);
            { const int j = lane; float a = pl[4 * j] + pl[4 * j + 1] + pl[4 * j + 2] + 0.5f * pl[4 * j + 3]; if (j > 0) a += 0.5f * pl[4 * j - 1]; imp += a; }
            asm volatile("s_waitcnt lgkmcnt(0)" ::: "memory");
        }
        const int cur = t >> 6; const int j = lane;
        u64 m64;
        if (cur <= 15) m64 = (cur == 63) ? ~0ull : ((1ull << (cur + 1)) - 1ull);
        else {
            float val = (j > cur) ? -INFINITY : ((j == 0 || j == cur || j == cur - 1) ? 1e4f : imp);
            m64 = 0ull;
            for (int r = 0; r < 16; ++r) {
                const float mx = wave_max(val);
                const u64 bal = __ballot(val == mx);
                const int w = __builtin_ctzll(bal);
                m64 |= 1ull << w; if (j == w) val = -INFINITY;
            }
        }
        if (lane == 0) sel[(size_t)bg * T_ + t] = m64;
    }
}

__device__ __forceinline__ void ph_win_attn(const Ctx& c, const bf16* qn, const bf16* kw, const bf16* vw, const float* gate, bf16* owin) {
    for (int it = c.gw; it < B_ * 8 * T_; it += c.ngw) {
        const int t = it % T_, bh = it / T_, b = bh >> 3, h = bh & 7, g = h >> 2;
        const int cur = t >> 6, jlo = (t - 511) > 0 ? (t - 511) >> 6 : 0;
        const u64 hi = (cur == 63) ? ~0ull : ((1ull << (cur + 1)) - 1ull); const u64 mask = hi & ~((1ull << jlo) - 1ull);
        const float o = naive_attn_row<64>(qn + ((size_t)bh * T_ + t) * 64, kw + (size_t)(b * 2 + g) * T_ * 64, vw + (size_t)(b * 2 + g) * T_ * 64, t, mask,
                                           alibi_slope(h + 1, 8) * LOG2E, nullptr, 512, c.lane);
        owin[(size_t)(b * T_ + t) * 512 + h * 64 + c.lane] = (bf16)f2bf(gate[(size_t)(b * T_ + t) * 24 + h * 3 + 2] * o);
    }
}
__device__ __forceinline__ void ph_slc_attn(const Ctx& c, const bf16* qn, const bf16* ks, const bf16* vs, const float* gate, const u64* sel, const bf16* ocmp, const bf16* owin, bf16* att) {
    for (int it = c.gw; it < B_ * 8 * T_; it += c.ngw) {
        const int t = it % T_, bh = it / T_, b = bh >> 3, h = bh & 7, g = h >> 2;
        const u64 mask = sel[(size_t)(b * 2 + g) * T_ + t];
        const float o = naive_attn_row<64>(qn + ((size_t)bh * T_ + t) * 64, ks + (size_t)(b * 2 + g) * T_ * 64, vs + (size_t)(b * 2 + g) * T_ * 64, t, mask,
                                           alibi_slope(h + 1, 8) * LOG2E, nullptr, 1 << 30, c.lane);
        const size_t n = (size_t)(b * T_ + t);
        const float r = gate[n * 24 + h * 3 + 1] * o + bf2f(ocmp[n * 512 + h * 64 + c.lane]) + bf2f(owin[n * 512 + h * 64 + c.lane]);
        att[n * 1024 + h * 64 + c.lane] = (bf16)f2bf(r);
    }
}
__device__ __forceinline__ void ph_fox_attn(const Ctx& c, const bf16* fq, const bf16* fk, const bf16* fv, const float* cum, bf16* att) {
    for (int it = c.gw; it < B_ * 4 * T_; it += c.ngw) {
        const int t = it % T_, bh = it / T_, b = bh >> 2, h = bh & 3;
        const int cur = t >> 6; const u64 mask = (cur == 63) ? ~0ull : ((1ull << (cur + 1)) - 1ull);
        const float o = naive_attn_row<64>(fq + ((size_t)bh * T_ + t) * 64, fk + (size_t)bh * T_ * 64, fv + (size_t)bh * T_ * 64, t, mask, 0.f, cum + (size_t)bh * T_, 1 << 30, c.lane);
        att[(size_t)(b * T_ + t) * 1024 + 512 + h * 64 + c.lane] = (bf16)f2bf(o);
    }
}
__device__ __forceinline__ void ph_diff_attn(const Ctx& c, const bf16* dq, const bf16* dk, const bf16* dv, const float* lam, const float* subln, float lambda_init, bf16* att) {
    float l1 = 0.f, l2 = 0.f;
    if (c.lane < 32) { l1 = lam[c.lane] * lam[32 + c.lane]; l2 = lam[64 + c.lane] * lam[96 + c.lane]; }
    const float lam_full = __expf(wave_sum(l1)) - __expf(wave_sum(l2)) + lambda_init;
    const float sg = subln[c.lane] * (1.f - lambda_init);
    for (int it = c.gw; it < B_ * 4 * T_; it += c.ngw) {
        const int t = it % T_, bh = it / T_, b = bh >> 2, h = bh & 3;
        const int cur = t >> 6; const u64 mask = (cur == 63) ? ~0ull : ((1ull << (cur + 1)) - 1ull);
        const float slope2 = alibi_slope(h + 1, 4) * LOG2E;
        const bf16* vb = dv + (size_t)bh * T_ * 64;
        const float o1 = naive_attn_row<32>(dq + ((size_t)(bh * 2 + 0) * T_ + t) * 32, dk + (size_t)(bh * 2 + 0) * T_ * 32, vb, t, mask, slope2, nullptr, 1 << 30, c.lane);
        const float o2 = naive_attn_row<32>(dq + ((size_t)(bh * 2 + 1) * T_ + t) * 32, dk + (size_t)(bh * 2 + 1) * T_ * 32, vb, t, mask, slope2, nullptr, 1 << 30, c.lane);
        const float o = o1 - lam_full * o2;
        const float r = rsqrtf(wave_sum(o * o) * (1.f / 64.f) + EPS);
        att[(size_t)(b * T_ + t) * 1024 + 768 + h * 64 + c.lane] = (bf16)f2bf(o * r * sg);
    }
}

__device__ __forceinline__ void ph_moe_route(const Ctx& c, const float* x, const float* g, const float* wgrp, const float* bgrp, const float* wexp, const float* bexp, bf16* hn, int* route_e, float* route_w, unsigned* cnt) {
    for (int row = c.gw; row < NT; row += c.ngw) {
        const f32x4* xr = (const f32x4*)(x + (size_t)row * D_) + c.lane;
        f32x4 v[4]; float ss = 0.f;
#pragma unroll
        for (int j = 0; j < 4; ++j) { v[j] = xr[64 * j]; ss += v[j].x * v[j].x + v[j].y * v[j].y + v[j].z * v[j].z + v[j].w * v[j].w; }
        const float r = rsqrtf(wave_sum(ss) * (1.f / D_) + EPS);
        u64* o8 = (u64*)(hn + (size_t)row * D_) + c.lane;
#pragma unroll
        for (int j = 0; j < 4; ++j) { const f32x4 gg = ((const f32x4*)g)[c.lane + 64 * j]; v[j] = v[j] * r * gg;
            o8[64 * j] = (u64)pk2(v[j].x, v[j].y) | ((u64)pk2(v[j].z, v[j].w) << 32); }
        float gl[4];
#pragma unroll
        for (int q = 0; q < 4; ++q) { float a = 0.f;
#pragma unroll
            for (int j = 0; j < 4; ++j) { const int k = 4 * (c.lane + 64 * j);
                a = fmaf(v[j].x, wgrp[(size_t)(k + 0) * 4 + q], a); a = fmaf(v[j].y, wgrp[(size_t)(k + 1) * 4 + q], a);
                a = fmaf(v[j].z, wgrp[(size_t)(k + 2) * 4 + q], a); a = fmaf(v[j].w, wgrp[(size_t)(k + 3) * 4 + q], a); }
            gl[q] = wave_sum(a) + bgrp[q]; }
        int grp = 0; float gm = gl[0];
#pragma unroll
        for (int q = 1; q < 4; ++q) if (gl[q] > gm) { gm = gl[q]; grp = q; }
        float gs = 0.f;
#pragma unroll
        for (int q = 0; q < 4; ++q) gs += __expf(gl[q] - gm);
        const float grp_gate = 1.f / gs;
        float el[8];
#pragma unroll
        for (int q = 0; q < 8; ++q) { float a = 0.f; const int col = grp * 8 + q;
#pragma unroll
            for (int j = 0; j < 4; ++j) { const int k = 4 * (c.lane + 64 * j);
                a = fmaf(v[j].x, wexp[(size_t)(k + 0) * 32 + col], a); a = fmaf(v[j].y, wexp[(size_t)(k + 1) * 32 + col], a);
                a = fmaf(v[j].z, wexp[(size_t)(k + 2) * 32 + col], a); a = fmaf(v[j].w, wexp[(size_t)(k + 3) * 32 + col], a); }
            el[q] = wave_sum(a) + bexp[col]; }
        int i0 = 0; float v0 = el[0];
#pragma unroll
        for (int q = 1; q < 8; ++q) if (el[q] > v0) { v0 = el[q]; i0 = q; }
        int i1 = -1; float v1 = -INFINITY;
#pragma unroll
        for (int q = 0; q < 8; ++q) if (q != i0 && el[q] > v1) { v1 = el[q]; i1 = q; }
        const float e1 = __expf(v1 - v0), den = 1.f + e1;
        if (c.lane == 0) { const float w0 = grp_gate / den, w1 = grp_gate * e1 / den;
            const int lo = i0 < i1 ? i0 : i1, hi = i0 < i1 ? i1 : i0, cls = grp * 28 + lo * 8 - (lo * (lo + 1)) / 2 + (hi - lo - 1);
            const unsigned rank = __hip_atomic_fetch_add(cnt + cls, 1u, __ATOMIC_RELAXED, __HIP_MEMORY_SCOPE_AGENT);
            route_e[row] = (int)(((unsigned)cls << 24) | rank); route_w[2 * row] = i0 < i1 ? w0 : w1; route_w[2 * row + 1] = i0 < i1 ? w1 : w0; }
    }
}
__device__ __forceinline__ void ph_moe_naive(const Ctx& c, const bf16* hn, const int* route_e, const float* route_w, const float* wg, const float* wu, const float* wd, float* x) {
    LAS float* hs = (LAS float*)c.lds;
    LAS float* au = hs + 1024;
    LAS float* h2 = au + 512;
    for (int row = c.bid; row < NT; row += c.G) {
        __syncthreads();
        hs[c.tid] = bf2f(hn[(size_t)row * D_ + c.tid]); hs[c.tid + 512] = bf2f(hn[(size_t)row * D_ + c.tid + 512]);
        float o0 = 0.f, o1 = 0.f;
        for (int s = 0; s < 2; ++s) {
            const int e = route_e[2 * row + s]; const float w = route_w[2 * row + s];
            __syncthreads();
            const float* W = (c.tid < 256 ? wg : wu) + (size_t)e * D_ * DEXP + (c.tid & 255);
            float a = 0.f;
            for (int k = 0; k < D_; ++k) a = fmaf(hs[k], W[(size_t)k * DEXP], a);
            au[c.tid] = a;
            __syncthreads();
            if (c.tid < 256) { const float ga = au[c.tid], up = au[c.tid + 256]; h2[c.tid] = ga / (1.f + __expf(-ga)) * up * w; }
            __syncthreads();
            const float* Wd = wd + (size_t)e * DEXP * D_;
            for (int k = 0; k < DEXP; ++k) { const float hv = h2[k]; o0 = fmaf(hv, Wd[(size_t)k * D_ + c.tid], o0); o1 = fmaf(hv, Wd[(size_t)k * D_ + c.tid + 512], o1); }
        }
        x[(size_t)row * D_ + c.tid] += o0; x[(size_t)row * D_ + c.tid + 512] += o1;
    }
    __syncthreads();
}

typedef __attribute__((address_space(4))) const Params* KP;
__device__ __forceinline__ KP uni_kp(KP p) { const unsigned long long v = (unsigned long long)p; const unsigned lo = __builtin_amdgcn_readfirstlane((unsigned)v), hi = __builtin_amdgcn_readfirstlane((unsigned)(v >> 32)); return (KP)(((unsigned long long)hi << 32) | lo); }
constexpr int PH_PER_LAYER = 11, N_PHASES = L_ * PH_PER_LAYER + 2;
__device__ __forceinline__ Ctx make_ctx(KP p) {
    Ctx c; c.lds = (LAS unsigned char*)lds_raw; { int t_ = threadIdx.x; asm volatile("" : "+v"(t_)); c.tid = t_; } c.lane = c.tid & 63; c.wave = __builtin_amdgcn_readfirstlane(c.tid >> 6);
    c.bid = blockIdx.x; c.G = gridDim.x; c.gw = c.bid * NWAVES + c.wave; c.ngw = c.G * NWAVES; c.in = nullptr; c.xcur = p->out; c.ws = p->ws;
    return c;
}
struct Bufs {
    bf16 *QN, *KV6, *KC, *VC, *KS, *VS, *KW, *VW, *FQ, *FK, *FV, *DQ, *DK, *DV, *HC, *KCMP, *VCMP, *OCMP, *OWIN, *HN, *ATT;
    float *GATE, *FL, *ROUTE_W; u64* SEL; int* ROUTE_E;
};
__device__ __forceinline__ Bufs make_bufs(unsigned char* ws) {
    Bufs b;
    b.QN = (bf16*)(ws + WS_QN); b.KV6 = (bf16*)(ws + WS_KV6);
    b.KC = (bf16*)(ws + WS_KV6 + 0 * KV6_STRIDE); b.VC = (bf16*)(ws + WS_KV6 + 1 * KV6_STRIDE);
    b.KS = (bf16*)(ws + WS_KV6 + 2 * KV6_STRIDE); b.VS = (bf16*)(ws + WS_KV6 + 3 * KV6_STRIDE);
    b.KW = (bf16*)(ws + WS_KV6 + 4 * KV6_STRIDE); b.VW = (bf16*)(ws + WS_KV6 + 5 * KV6_STRIDE);
    b.FQ = (bf16*)(ws + WS_FQKV); b.FK = b.FQ + 8 * MiB; b.FV = b.FQ + 16 * MiB;
    b.DQ = (bf16*)(ws + WS_DQK); b.DK = b.DQ + 8 * MiB; b.DV = (bf16*)(ws + WS_DV);
    b.GATE = (float*)(ws + WS_GATE); b.FL = (float*)(ws + WS_FL);
    b.HC = (bf16*)(ws + WS_HC); b.KCMP = (bf16*)(ws + WS_KVCMP); b.VCMP = b.KCMP + 16 * 256 * 64;
    b.SEL = (u64*)(ws + WS_SEL); b.OCMP = (bf16*)(ws + WS_OCMP); b.OWIN = (bf16*)(ws + WS_OWIN);
    b.HN = (bf16*)(ws + WS_HN); b.ATT = (bf16*)(ws + WS_ATT);
    b.ROUTE_E = (int*)(ws + WS_ROUTE); b.ROUTE_W = (float*)(ws + WS_ROUTE + 512 * 1024);
    return b;
}
__device__ __forceinline__ float lambda_init_of(int l) { return l == 0 ? 0.2f : 0.35550906759096926f; }

__device__ __noinline__ void P_prologue(KP p_) { const KP p = uni_kp(p_);
    const Ctx c = make_ctx(p); unsigned char* ws = p->ws;
    LAS float* scr = (LAS float*)(c.lds) + c.wave * (64 * 33);
    constexpr int I_A = 16 * 40, I_B = 16 * 24, I_C = 16 * 24, I_O = 16 * 32, I_G = 16 * 8, I_D = 4 * 32, I_E = 2 * I_G + I_D, I_W1 = 32 * 8, I_W2 = 4 * 2;
    constexpr int PER_L = I_A + I_B + I_C + I_O + 2 * (I_W1 + I_W2);
    for (int it = c.gw; it < L_ * PER_L; it += c.ngw) {
        const int l = it / PER_L; int r = it % PER_L;
        const float* W; bf16* WT; int ldw, K, sc0, ncol, r0 = 0, rmul = 1;
        if (r < I_A + I_B + I_C) { W = p->in[2] + (size_t)l * D_ * D_IN; WT = (bf16*)(ws + WS_WIN_T) + (size_t)l * NIN * D_; ldw = D_IN; K = D_;
            if (r < I_A) { sc0 = 0; ncol = 1280; r0 = 0; } else if (r < I_A + I_B) { r -= I_A; sc0 = C_FQ; ncol = 768; r0 = 1280; } else { r -= I_A + I_B; sc0 = C_DQ; ncol = 768; r0 = 2048; } }
        else if ((r -= I_A + I_B + I_C) < I_O) { W = p->in[13] + (size_t)l * D_ * D_; WT = (bf16*)(ws + WS_WOUT_T) + (size_t)l * D_ * D_; ldw = D_; K = D_; sc0 = 0; ncol = 1024; }
        else { r -= I_O; const int kv = r / (I_W1 + I_W2); r = r % (I_W1 + I_W2); const size_t lk = (size_t)l * 2 + kv;
            if (r < I_W1) { W = p->in[kv == 0 ? 6 : 9] + (size_t)l * 2048 * 256; WT = (bf16*)(ws + WS_W1_T) + lk * 256 * 2048; ldw = 256; K = 2048; sc0 = 0; ncol = 256; }
            else { r -= I_W1; W = p->in[kv == 0 ? 7 : 10] + (size_t)l * 256 * 64; WT = (bf16*)(ws + WS_W2_T) + lk * 64 * 256; ldw = 64; K = 256; sc0 = 0; ncol = 64; } }
        transpose_seg(W, ldw, K, sc0, ncol, WT, r0, rmul, r, scr, c.lane);
    }
    for (int i = c.bid * NTHREADS + c.tid; i < L_ * 256 * D_; i += c.G * NTHREADS) {
        const int l = i / (256 * D_), rr = (i / D_) % 256, k = i % D_;
        const float* win = p->in[2] + (size_t)l * D_ * D_IN;
        float v = 0.f; if (rr < 24) v = win[(size_t)k * D_IN + C_GATE + rr]; else if (rr < 28) v = win[(size_t)k * D_IN + C_FF + (rr - 24)];
        ((bf16*)(ws + WS_WIN_T))[((size_t)l * NIN + 2816 + rr) * D_ + k] = (bf16)f2bf(v);
    }
    for (int w = c.gw; w < L_ * 2 * 4 * 128; w += c.ngw) {
        const int lk = w >> 9, cg = (w >> 7) & 3, kc = w & 127, l = lk >> 1, kv = lk & 1, j = cg * 64 + c.lane;
        const float* pe = p->in[kv == 0 ? 5 : 8] + (size_t)l * 2048 + kc * 16; const float* w1 = p->in[kv == 0 ? 6 : 9] + (size_t)l * 2048 * 256 + (size_t)kc * 16 * 256;
        float a = 0.f;
#pragma unroll
        for (int k = 0; k < 16; ++k) a = fmaf(pe[k], w1[(size_t)k * 256 + j], a);
        ((float*)(ws + WS_B1PART))[((size_t)lk * 128 + kc) * 256 + j] = a;
    }
    for (int i = c.bid * NTHREADS + c.tid; i < L_ * 64 * 2 * 64; i += c.G * NTHREADS) {
        const int l = i / (64 * 2 * 64), ks = (i / 128) % 64, cb = (i / 64) & 1, lane = i & 63, col = 32 * cb + (lane & 31);
        unsigned hi[4], lo[4];
#pragma unroll
        for (int jp = 0; jp < 4; ++jp) { float v[2];
#pragma unroll
            for (int e = 0; e < 2; ++e) { const int k = 16 * ks + 8 * (lane >> 5) + 2 * jp + e; const float g = p->in[14][(size_t)l * D_ + k];
                v[e] = col < 4 ? g * p->in[15][((size_t)l * D_ + k) * 4 + col] : (col < 36 ? g * p->in[17][((size_t)l * D_ + k) * 32 + (col - 4)] : 0.f); }
            const unsigned h0 = f2bf(v[0]), h1 = f2bf(v[1]); hi[jp] = h0 | (h1 << 16);
            lo[jp] = f2bf(v[0] - __uint_as_float(h0 << 16)) | (f2bf(v[1] - __uint_as_float(h1 << 16)) << 16); }
        u32x4* dst = (u32x4*)(ws + WS_WR) + ((size_t)((l * 64 + ks) * 2 + cb) * 2) * 64 + lane;
        dst[0] = (u32x4){hi[0], hi[1], hi[2], hi[3]}; dst[64] = (u32x4){lo[0], lo[1], lo[2], lo[3]};
    }
}
__device__ __forceinline__ void P_inproj_mfma(int l_) { const KP p = (KP)__builtin_amdgcn_kernarg_segment_ptr(); int l = l_; asm volatile("" : "+s"(l));
    unsigned char* ws = p->ws; asm volatile("" : "+s"(ws));
    PlainOrder S; S.init(p->out, (const bf16*)(ws + WS_WIN_T) + (size_t)l * NIN * D_, D_, D_, NT, NIN, (int)gridDim.x, launder_s((int)blockIdx.x));
#ifdef STAGGER_TICKS
    { const unsigned long long t0 = __builtin_amdgcn_s_memrealtime(); const unsigned long long d = (unsigned long long)((launder_s((int)blockIdx.x) >> 3) & 3) * STAGGER_TICKS;
      while (__builtin_amdgcn_s_memrealtime() - t0 < d) __builtin_amdgcn_s_sleep(4); }
#endif
    const pg8::Gemm g{D_, D_, D_, D_ / 64, 0, 0};
    const EpiInProj E{ws, p->in[3] + l * 24, p->in[4] + l * 4, (unsigned*)(ws + WS_CTL) + CW_KN + l * 8192};
    pg8::gemm_phase<EpiInProj, PlainOrder, INPROJ_ALIGN, INPROJ_SP2>((LAS unsigned char*)lds_raw, g, S, E);
}
__device__ __forceinline__ void P_inproj_dummy(int l_) { const KP p = (KP)__builtin_amdgcn_kernarg_segment_ptr(); int l = l_; asm volatile("" : "+s"(l));
    unsigned char* ws = p->ws; asm volatile("" : "+s"(ws));
    PlainOrder S; S.init(p->out, (const bf16*)(ws + WS_WIN_T) + (size_t)l * NIN * D_, D_, D_, NT, NIN, (int)gridDim.x, launder_s((int)blockIdx.x));
    const pg8::Gemm g{D_, D_, D_, D_ / 64, 0, 0};
    const EpiDummy E{(float*)(ws + WS_HB)};
    pg8::gemm_phase<EpiDummy, PlainOrder, true, true>((LAS unsigned char*)lds_raw, g, S, E);
}
__device__ __forceinline__ void P_outproj_mfma(int l_) { const KP p = (KP)__builtin_amdgcn_kernarg_segment_ptr(); int l = l_; asm volatile("" : "+s"(l));
    unsigned char* ws = p->ws; asm volatile("" : "+s"(ws));
    PlainOrder S; S.init(ws + WS_ATT, (const bf16*)(ws + WS_WOUT_T) + (size_t)l * D_ * D_, D_, D_, NT, D_, (int)gridDim.x, launder_s((int)blockIdx.x));
    const pg8::Gemm g{D_, D_, D_, D_ / 64, 32, 8};
    const EpiResBf16 E{(bf16*)(ws + WS_HN)};
    pg8::gemm_phase<EpiResBf16, PlainOrder, true, true>((LAS unsigned char*)lds_raw, g, S, E);
}
__device__ __forceinline__ float wave_max_l(float v, int lane) {
#pragma unroll
    for (int o = 1; o < 64; o <<= 1) v = fmaxf(v, shflx_f(v, o, lane));
    return v;
}
__device__ __forceinline__ float wave_min_l(float v, int lane) {
#pragma unroll
    for (int o = 1; o < 64; o <<= 1) v = fminf(v, shflx_f(v, o, lane));
    return v;
}
template <int NS> __device__ __forceinline__ float q_norm2_max(const bf16x8v (&Q)[NS], int lane) {
    float ss = 0.f;
#pragma unroll
    for (int s = 0; s < NS; ++s)
#pragma unroll
        for (int e = 0; e < 8; ++e) { const float v = __uint_as_float(((unsigned)(unsigned short)Q[s][e]) << 16); ss = fmaf(v, v, ss); }
    return wave_max_l(swap_sum(ss), lane);
}
__device__ __forceinline__ u64 prune_consensus(bool skip, LAS u64* slots, int wave, int lane) {
    const u64 mine = __ballot(skip);
    __syncthreads();
    if (lane == 0) slots[wave] = mine;
    __syncthreads();
    u64 all = slots[0];
#pragma unroll
    for (int w = 1; w < NWAVES; ++w) all &= slots[w];
    return all;
}
__device__ __forceinline__ bool block_any(bool v, LAS u64* slots, int wave, int lane) {
#ifdef FORCE_FALLBACK
    v = true;
#endif
    const u64 mine = __ballot(v);
    __syncthreads();
    if (lane == 0) slots[wave] = mine;
    __syncthreads();
    u64 all = slots[0];
#pragma unroll
    for (int w = 1; w < NWAVES; ++w) all |= slots[w];
    return all != 0ull;
}
__device__ __forceinline__ bool sum_bad(float l) { return !(l < 1e30f); }
__device__ __forceinline__ void U_fox(KP p_, int bh_, int qb_, int l_) {
    const KP p = uni_kp(p_); const int bh = __builtin_amdgcn_readfirstlane(bh_), qb = __builtin_amdgcn_readfirstlane(qb_), l = __builtin_amdgcn_readfirstlane(l_);
    int tid_ = threadIdx.x; asm volatile("" : "+v"(tid_));
    const int tid = tid_, lane = tid & 63, wave = __builtin_amdgcn_readfirstlane(tid >> 6), r = lane & 31, h = lane >> 5;
    unsigned char* ws = p->ws; asm volatile("" : "+s"(ws)); LAS unsigned char* L = (LAS unsigned char*)lds_raw;
    const int tw0 = 256 * qb + 32 * wave, t_lane = tw0 + r, b = bh >> 2, hd = bh & 3;
    const bf16* q = (const bf16*)(ws + WS_FQKV) + (size_t)bh * T_ * 64 + (t_lane >> 4) * 1024 + (t_lane & 15) * 32 + 8 * h;
    bf16x8v Qf[1][4];
#pragma unroll
    for (int s = 0; s < 4; ++s) Qf[0][s] = *(const bf16x8v*)(q + (s >> 1) * 512 + (s & 1) * 16);
    const bf16* Kp = (const bf16*)(ws + WS_FQKV) + 8 * MiB + (size_t)bh * T_ * 64; const bf16* Vp = (const bf16*)(ws + WS_FQKV) + 16 * MiB + (size_t)bh * T_ * 64;
    u32x4 kpre, vpre; attn_preload<64>(Kp, nullptr, Vp, 4 * qb + 3, tid, kpre, vpre);
    LAS float* cum = (LAS float*)(L + A_LDS_END);
    { const float* fl = (const float*)(ws + WS_FL) + (size_t)bh * T_; LAS float* tot = cum + 4096;
      const int nval = 256 * (qb + 1); float v[8];
      if (8 * tid < nval) { const f32x4 a = *(const f32x4*)(fl + 8 * tid), c2 = *(const f32x4*)(fl + 8 * tid + 4); v[0] = a.x; v[1] = a.y; v[2] = a.z; v[3] = a.w; v[4] = c2.x; v[5] = c2.y; v[6] = c2.z; v[7] = c2.w; }
      else {
#pragma unroll
          for (int i = 0; i < 8; ++i) v[i] = 0.f; }
#pragma unroll
      for (int i = 1; i < 8; ++i) v[i] += v[i - 1];
      float sc = v[7];
#pragma unroll
      for (int o = 1; o < 64; o <<= 1) { const float up = __uint_as_float((unsigned)__builtin_amdgcn_ds_bpermute((lane - o) << 2, (int)__float_as_uint(sc))); if (lane >= o) sc += up; }
      if (lane == 63) tot[wave] = sc;
      __syncthreads();
      float base = sc - v[7];
      for (int w = 0; w < wave; ++w) base += tot[w];
      if (8 * tid < nval) {
#pragma unroll
          for (int i = 0; i < 8; ++i) cum[8 * tid + i] = v[i] + base; }
      __syncthreads(); }
    f32x16 O[1][2]; float M[1] = {0.f}, Ls[1] = {0.f};
#pragma unroll
    for (int i = 0; i < 16; ++i) { O[0][0][i] = 0.f; O[0][1][i] = 0.f; }
    const u64 tm = (qb == 15) ? ~0ull : ((1ull << (4 * qb + 4)) - 1ull);
#if AC2_MODE == 0
    {
        const u64 low = (1ull << (4 * qb)) - 1ull; const float cref = cum[tw0];
#define FOX_CORES(NM, FIRSTCALL) do { FIRSTCALL; \
        if (qb > 0) { \
            const float qn2 = q_norm2_max<4>(Qf[0], lane), mmin = wave_min_l(M[0], lane); \
            const float* kn = (const float*)((const unsigned*)(ws + WS_CTL) + CW_KN + l * 8192) + ((size_t)bh * 64 + lane) * 2; \
            bool skip = false; \
            if (lane < 4 * qb) { const float kn2 = kn[0] + kn[1]; const float bound = sqrtf(qn2 * kn2) * 1.02f + (cref - cum[64 * lane + 63]) * LOG2E - mmin; skip = bound < -152.f; } \
            const u64 drop = prune_consensus(skip, (LAS u64*)(cum + 4096 + 16), wave, lane); \
            const u64 tm2 = low & ~drop; \
            if (tm2) attn_core<64, 1, true, false, false, NM>(L, Kp, nullptr, Vp, cum, cref, Qf, tm2, t_lane, tw0, 1 << 30, 0.f, 0u, 0u, O, M, Ls, tid, true); \
        } } while (0)
        FOX_CORES(NOMAX_ON, (attn_core<64, 1, true, false, true, NOMAX_ON>(L, Kp, nullptr, Vp, cum, cref, Qf, tm & ~low, t_lane, tw0, 1 << 30, 0.f, 0u, 0u, O, M, Ls, tid, false, 4 * qb + 3, kpre, vpre)));
        if (NOMAX_ON && block_any(sum_bad(Ls[0]), (LAS u64*)(cum + 4096 + 32), wave, lane)) {
#pragma unroll
            for (int i = 0; i < 16; ++i) { O[0][0][i] = 0.f; O[0][1][i] = 0.f; }
            M[0] = 0.f; Ls[0] = 0.f;
            FOX_CORES(false, (attn_core<64, 1, true, false, false, false>(L, Kp, nullptr, Vp, cum, cref, Qf, tm & ~low, t_lane, tw0, 1 << 30, 0.f, 0u, 0u, O, M, Ls, tid)));
        }
#undef FOX_CORES
    }
#else
    attn_core2<true, false>(L, (const bf16*)(ws + WS_FQKV) + 8 * MiB + (size_t)bh * T_ * 64, (const bf16*)(ws + WS_FQKV) + 16 * MiB + (size_t)bh * T_ * 64, cum, cum[256 * qb],
                            Qf[0], tm, t_lane, tw0, 1 << 30, 0.f, 0u, 0u, O[0], M[0], Ls[0], tid);
#endif
    const float lt = swap_sum(Ls[0]), inv = lt > 0.f ? 1.f / lt : 0.f;
    bf16* dst = (bf16*)(ws + WS_ATT) + mix_off((size_t)b * T_ + t_lane, 512 + hd * 64 + 4 * h, 1024);
    ATTN_FOR_CHUNKS(db, g4) { const unsigned w0 = cvtpk(O[0][db][4 * g4 + 0] * inv, O[0][db][4 * g4 + 1] * inv), w1 = cvtpk(O[0][db][4 * g4 + 2] * inv, O[0][db][4 * g4 + 3] * inv);
        *(u64*)(dst + (4 * db + g4) * 256) = (u64)w0 | ((u64)w1 << 32); }
}
__device__ __forceinline__ void U_diff(KP p_, int bh_, int qb_, int l_) {
    const KP p = uni_kp(p_); const int bh = __builtin_amdgcn_readfirstlane(bh_), qb = __builtin_amdgcn_readfirstlane(qb_), l = __builtin_amdgcn_readfirstlane(l_);
    int tid_ = threadIdx.x; asm volatile("" : "+v"(tid_));
    const int tid = tid_, lane = tid & 63, wave = __builtin_amdgcn_readfirstlane(tid >> 6), r = lane & 31, h = lane >> 5;
    unsigned char* ws = p->ws; asm volatile("" : "+s"(ws)); LAS unsigned char* L = (LAS unsigned char*)lds_raw;
    const int tw0 = 256 * qb + 32 * wave, t_lane = tw0 + r, b = bh >> 2, hd = bh & 3;
    const bf16* DQ = (const bf16*)(ws + WS_DQK); const bf16* DK = DQ + 8 * MiB;
    bf16x8v Qf[2][2];
#pragma unroll
    for (int mp = 0; mp < 2; ++mp)
#pragma unroll
        for (int s = 0; s < 2; ++s) Qf[mp][s] = *(const bf16x8v*)(DQ + ((size_t)(bh * 2 + mp) * T_ + t_lane) * 32 + 16 * s + 8 * h);
    f32x16 O[2][2]; float M[2] = {0.f, 0.f}, Ls[2] = {0.f, 0.f};
#pragma unroll
    for (int i = 0; i < 16; ++i) { O[0][0][i] = 0.f; O[0][1][i] = 0.f; O[1][0][i] = 0.f; O[1][1][i] = 0.f; }
    const u64 tm = (qb == 15) ? ~0ull : ((1ull << (4 * qb + 4)) - 1ull);
    {
        const u64 low = (1ull << (4 * qb)) - 1ull; const float slope2 = alibi_slope(hd + 1, 4) * LOG2E;
        const bf16* K0 = DK + (size_t)(bh * 2 + 0) * T_ * 32; const bf16* K1 = DK + (size_t)(bh * 2 + 1) * T_ * 32; const bf16* Vp = (const bf16*)(ws + WS_DV) + (size_t)bh * T_ * 64;
#define DIFF_CORES(NM) do { \
        attn_core<32, 2, false, false, false, NM>(L, K0, K1, Vp, nullptr, 0.f, Qf, tm & ~low, t_lane, tw0, 1 << 30, slope2, 0u, 0u, O, M, Ls, tid); \
        if (qb > 0) { \
            const float qa = q_norm2_max<2>(Qf[0], lane), qb2 = q_norm2_max<2>(Qf[1], lane), ma = wave_min_l(M[0], lane), mb = wave_min_l(M[1], lane); \
            const float* kn = (const float*)((const unsigned*)(ws + WS_CTL) + CW_KN + l * 8192 + 4096) + (size_t)(bh * 2) * 64 + lane; \
            bool skip = false; \
            if (lane < 4 * qb) { const float bmax = slope2 * (float)(64 * lane + 63 - tw0);            \
                skip = (sqrtf(qa * kn[0]) * 1.02f + bmax - ma < -152.f) && (sqrtf(qb2 * kn[64]) * 1.02f + bmax - mb < -152.f); } \
            const u64 drop = prune_consensus(skip, (LAS u64*)(L + A_LDS_END), wave, lane); \
            const u64 tm2 = low & ~drop; \
            if (tm2) attn_core<32, 2, false, false, false, NM>(L, K0, K1, Vp, nullptr, 0.f, Qf, tm2, t_lane, tw0, 1 << 30, slope2, 0u, 0u, O, M, Ls, tid, true); \
        } } while (0)
        DIFF_CORES(NOMAX_ON);
        if (NOMAX_ON && block_any(sum_bad(Ls[0]) || sum_bad(Ls[1]), (LAS u64*)(L + A_LDS_END + 64), wave, lane)) {
#pragma unroll
            for (int i = 0; i < 16; ++i) { O[0][0][i] = 0.f; O[0][1][i] = 0.f; O[1][0][i] = 0.f; O[1][1][i] = 0.f; }
            M[0] = 0.f; M[1] = 0.f; Ls[0] = 0.f; Ls[1] = 0.f;
            DIFF_CORES(false);
        }
#undef DIFF_CORES
    }
    const float* lam = p->in[11] + (size_t)l * 128; const float* subln = p->in[12] + (size_t)l * 64;
    float l1 = 0.f, l2 = 0.f; if (lane < 32) { l1 = lam[lane] * lam[32 + lane]; l2 = lam[64 + lane] * lam[96 + lane]; }
    const float li = lambda_init_of(l), lam_full = __expf(wave_sum_l(l1, lane)) - __expf(wave_sum_l(l2, lane)) + li;
    const float lt0 = swap_sum(Ls[0]), lt1 = swap_sum(Ls[1]), i0 = lt0 > 0.f ? 1.f / lt0 : 0.f, i1 = (lt1 > 0.f ? 1.f / lt1 : 0.f) * lam_full;
    float ss = 0.f;
#pragma unroll
    for (int db = 0; db < 2; ++db)
#pragma unroll
        for (int i = 0; i < 16; ++i) { const float o = O[0][db][i] * i0 - O[1][db][i] * i1; O[0][db][i] = o; ss += o * o; }
    ss = swap_sum(ss);
    const float rn = rsqrtf(ss * (1.f / 64.f) + EPS) * (1.f - li);
    bf16* dst = (bf16*)(ws + WS_ATT) + mix_off((size_t)b * T_ + t_lane, 768 + hd * 64 + 4 * h, 1024);
    ATTN_FOR_CHUNKS(db, g4) { const f32x4 sg = *(const f32x4*)(subln + 32 * db + 8 * g4 + 4 * h);
        const unsigned w0 = cvtpk(O[0][db][4 * g4 + 0] * rn * sg.x, O[0][db][4 * g4 + 1] * rn * sg.y), w1 = cvtpk(O[0][db][4 * g4 + 2] * rn * sg.z, O[0][db][4 * g4 + 3] * rn * sg.w);
        *(u64*)(dst + (4 * db + g4) * 256) = (u64)w0 | ((u64)w1 << 32); }
}
__device__ __forceinline__ void U_win(KP p_, int bg_, int c_) {
    const KP p = uni_kp(p_); const int bg = __builtin_amdgcn_readfirstlane(bg_), cc = __builtin_amdgcn_readfirstlane(c_);
    int tid_ = threadIdx.x; asm volatile("" : "+v"(tid_));
    const int tid = tid_, lane = tid & 63, wave = __builtin_amdgcn_readfirstlane(tid >> 6), r = lane & 31, h = lane >> 5;
    unsigned char* ws = p->ws; asm volatile("" : "+s"(ws)); LAS unsigned char* L = (LAS unsigned char*)lds_raw;
    const int b = bg >> 1, g = bg & 1, hd = g * 4 + (wave >> 1), tw0 = 64 * cc + 32 * (wave & 1), t_lane = tw0 + r;
    const bf16* q = (const bf16*)(ws + WS_QN) + (size_t)(b * 8 + hd) * T_ * 64 + (t_lane >> 4) * 1024 + (t_lane & 15) * 32 + 8 * h;
    bf16x8v Qf[1][4];
#pragma unroll
    for (int s = 0; s < 4; ++s) Qf[0][s] = *(const bf16x8v*)(q + (s >> 1) * 512 + (s & 1) * 16);
    f32x16 O[1][2]; float M[1] = {0.f}, Ls[1] = {0.f};
#pragma unroll
    for (int i = 0; i < 16; ++i) { O[0][0][i] = 0.f; O[0][1][i] = 0.f; }
    const size_t n = (size_t)b * T_ + t_lane;
    const float gate_w = ((const float*)(ws + WS_GATE))[n * 24 + hd * 3 + 2];
    const int jlo = cc > 8 ? cc - 8 : 0;
    const u64 hi = (cc == 63) ? ~0ull : ((1ull << (cc + 1)) - 1ull), tm = hi & ~((1ull << jlo) - 1ull);
#if AC2_MODE == 0
    attn_core<64, 1, false, false, false, NOMAX_ON>(L, (const bf16*)(ws + WS_KV6 + 4 * KV6_STRIDE) + (size_t)bg * T_ * 64, nullptr, (const bf16*)(ws + WS_KV6 + 5 * KV6_STRIDE) + (size_t)bg * T_ * 64, nullptr, 0.f,
                                   Qf, tm, t_lane, tw0, 512, alibi_slope(hd + 1, 8) * LOG2E, 0u, 0u, O, M, Ls, tid);
    if (NOMAX_ON && block_any(sum_bad(Ls[0]), (LAS u64*)(L + A_LDS_END + 64), wave, lane)) {
#pragma unroll
        for (int i = 0; i < 16; ++i) { O[0][0][i] = 0.f; O[0][1][i] = 0.f; }
        M[0] = 0.f; Ls[0] = 0.f;
        attn_core<64, 1, false, false, false, false>(L, (const bf16*)(ws + WS_KV6 + 4 * KV6_STRIDE) + (size_t)bg * T_ * 64, nullptr, (const bf16*)(ws + WS_KV6 + 5 * KV6_STRIDE) + (size_t)bg * T_ * 64, nullptr, 0.f,
                                       Qf, tm, t_lane, tw0, 512, alibi_slope(hd + 1, 8) * LOG2E, 0u, 0u, O, M, Ls, tid);
    }
#ifdef PROBE_WINCORE2
    attn_core<64, 1, false, false>(L, (const bf16*)(ws + WS_KV6 + 4 * KV6_STRIDE) + (size_t)bg * T_ * 64, nullptr, (const bf16*)(ws + WS_KV6 + 5 * KV6_STRIDE) + (size_t)bg * T_ * 64, nullptr, 0.f,
                                   Qf, tm, t_lane, tw0, 512, alibi_slope(hd + 1, 8) * LOG2E, 0u, 0u, O, M, Ls, tid, true);
#endif
#else
    attn_core2<false, false>(L, (const bf16*)(ws + WS_KV6 + 4 * KV6_STRIDE) + (size_t)bg * T_ * 64, (const bf16*)(ws + WS_KV6 + 5 * KV6_STRIDE) + (size_t)bg * T_ * 64, nullptr, 0.f,
                             Qf[0], tm, t_lane, tw0, 512, alibi_slope(hd + 1, 8) * LOG2E, 0u, 0u, O[0], M[0], Ls[0], tid);
#endif
    const float lt = swap_sum(Ls[0]), inv = (lt > 0.f ? 1.f / lt : 0.f) * gate_w;
    bf16* dst = (bf16*)(ws + WS_OWIN) + mix_off(n, hd * 64 + 4 * h, 512);
    ATTN_FOR_CHUNKS(db, g4) { const unsigned w0 = cvtpk(O[0][db][4 * g4 + 0] * inv, O[0][db][4 * g4 + 1] * inv), w1 = cvtpk(O[0][db][4 * g4 + 2] * inv, O[0][db][4 * g4 + 3] * inv);
        *(u64*)(dst + (4 * db + g4) * 256) = (u64)w0 | ((u64)w1 << 32); }
}
__device__ __forceinline__ void U_slc(KP p_, int bg_, int c_) {
    const KP p = uni_kp(p_); const int bg = __builtin_amdgcn_readfirstlane(bg_), cc = __builtin_amdgcn_readfirstlane(c_);
    int tid_ = threadIdx.x; asm volatile("" : "+v"(tid_));
    const int tid = tid_, lane = tid & 63, wave = __builtin_amdgcn_readfirstlane(tid >> 6), r = lane & 31, h = lane >> 5;
    unsigned char* ws = p->ws; asm volatile("" : "+s"(ws)); LAS unsigned char* L = (LAS unsigned char*)lds_raw;
    const int b = bg >> 1, g = bg & 1, hd = g * 4 + (wave >> 1), tw0 = 64 * cc + 32 * (wave & 1), t_lane = tw0 + r;
    const bf16* q = (const bf16*)(ws + WS_QN) + (size_t)(b * 8 + hd) * T_ * 64 + (t_lane >> 4) * 1024 + (t_lane & 15) * 32 + 8 * h;
    bf16x8v Qf[1][4];
#pragma unroll
    for (int s = 0; s < 4; ++s) Qf[0][s] = *(const bf16x8v*)(q + (s >> 1) * 512 + (s & 1) * 16);
    f32x16 O[1][2]; float M[1] = {0.f}, Ls[1] = {0.f};
#pragma unroll
    for (int i = 0; i < 16; ++i) { O[0][0][i] = 0.f; O[0][1][i] = 0.f; }
    const bf16* Ksl = (const bf16*)(ws + WS_KV6 + 2 * KV6_STRIDE) + (size_t)bg * T_ * 64; const bf16* Vsl = (const bf16*)(ws + WS_KV6 + 3 * KV6_STRIDE) + (size_t)bg * T_ * 64;
    u32x4 kpre, vpre; attn_preload<64>(Ksl, nullptr, Vsl, cc, tid, kpre, vpre);
    const size_t n = (size_t)b * T_ + t_lane;
    const float gate_s = ((const float*)(ws + WS_GATE))[n * 24 + hd * 3 + 1];
    const bf16* oc = (const bf16*)(ws + WS_OCMP) + mix_off(n, hd * 64 + 4 * h, 512); const bf16* ow = (const bf16*)(ws + WS_OWIN) + mix_off(n, hd * 64 + 4 * h, 512);
    u64 ocv[8], owv[8];
    ATTN_FOR_CHUNKS(db, g4) { ocv[4 * db + g4] = *(const u64*)(oc + (4 * db + g4) * 256); owv[4 * db + g4] = *(const u64*)(ow + (4 * db + g4) * 256); }
    const u64* sel = (const u64*)(ws + WS_SEL) + (size_t)bg * T_;
    const u64 mine = sel[t_lane]; u64 un = sel[64 * cc + lane];
    { unsigned ul = (unsigned)un, uh = (unsigned)(un >> 32);
#pragma unroll
      for (int o = 1; o < 64; o <<= 1) { ul |= shflx_u(ul, o, lane); uh |= shflx_u(uh, o, lane); }
      un = ((u64)__builtin_amdgcn_readfirstlane(uh) << 32) | __builtin_amdgcn_readfirstlane(ul); }
#if AC2_MODE == 0
    attn_core<64, 1, false, true, true, NOMAX_ON>(L, Ksl, nullptr, Vsl, nullptr, 0.f,
                                  Qf, un, t_lane, tw0, 1 << 30, alibi_slope(hd + 1, 8) * LOG2E, (unsigned)mine, (unsigned)(mine >> 32), O, M, Ls, tid, false, cc, kpre, vpre);
    if (NOMAX_ON && block_any(sum_bad(Ls[0]), (LAS u64*)(L + A_LDS_END + 64), wave, lane)) {
#pragma unroll
        for (int i = 0; i < 16; ++i) { O[0][0][i] = 0.f; O[0][1][i] = 0.f; }
        M[0] = 0.f; Ls[0] = 0.f;
        attn_core<64, 1, false, true, false, false>(L, Ksl, nullptr, Vsl, nullptr, 0.f, Qf, un, t_lane, tw0, 1 << 30, alibi_slope(hd + 1, 8) * LOG2E, (unsigned)mine, (unsigned)(mine >> 32), O, M, Ls, tid);
    }
#else
    attn_core2<false, true>(L, (const bf16*)(ws + WS_KV6 + 2 * KV6_STRIDE) + (size_t)bg * T_ * 64, (const bf16*)(ws + WS_KV6 + 3 * KV6_STRIDE) + (size_t)bg * T_ * 64, nullptr, 0.f,
                            Qf[0], un, t_lane, tw0, 1 << 30, alibi_slope(hd + 1, 8) * LOG2E, (unsigned)mine, (unsigned)(mine >> 32), O[0], M[0], Ls[0], tid);
#endif
    const float lt = swap_sum(Ls[0]), inv = (lt > 0.f ? 1.f / lt : 0.f) * gate_s;
    bf16* dst = (bf16*)(ws + WS_ATT) + mix_off(n, hd * 64 + 4 * h, 1024);
    ATTN_FOR_CHUNKS(db, g4) { const u64 a = ocv[4 * db + g4], w = owv[4 * db + g4];
        const float x0 = O[0][db][4 * g4 + 0] * inv + __uint_as_float((unsigned)a << 16) + __uint_as_float((unsigned)w << 16);
        const float x1 = O[0][db][4 * g4 + 1] * inv + __uint_as_float((unsigned)a & 0xffff0000u) + __uint_as_float((unsigned)w & 0xffff0000u);
        const float x2 = O[0][db][4 * g4 + 2] * inv + __uint_as_float((unsigned)(a >> 32) << 16) + __uint_as_float((unsigned)(w >> 32) << 16);
        const float x3 = O[0][db][4 * g4 + 3] * inv + __uint_as_float((unsigned)(a >> 32) & 0xffff0000u) + __uint_as_float((unsigned)(w >> 32) & 0xffff0000u);
        *(u64*)(dst + (4 * db + g4) * 256) = (u64)cvtpk(x0, x1) | ((u64)cvtpk(x2, x3) << 32); }
}
__device__ __forceinline__ float other_half(float x, int h) { auto rr = __builtin_amdgcn_permlane32_swap(__float_as_uint(x), __float_as_uint(x), false, false); return __uint_as_float(h ? rr[0] : rr[1]); }
__device__ __forceinline__ int other_half_i(int x, int h) { auto rr = __builtin_amdgcn_permlane32_swap((unsigned)x, (unsigned)x, false, false); return (int)(h ? rr[0] : rr[1]); }
template <bool MASK>
__device__ __forceinline__ void cmp_scores(f32x16& p0, f32x16& p1, const LAS unsigned char* kt, const bf16x8v (&Qf)[4], float b0, float s1, int cl, int nvis_l) {
    const float s8 = s1 * 8.f, s32 = s1 * 32.f;
    p0[0] = b0; p0[1] = p0[0] + s1; p0[2] = p0[1] + s1; p0[3] = p0[2] + s1;
#pragma unroll
    for (int reg = 4; reg < 16; ++reg) p0[reg] = p0[reg - 4] + s8;
#pragma unroll
    for (int reg = 0; reg < 16; ++reg) p1[reg] = p0[reg] + s32;
#pragma unroll
    for (int s = 0; s < 4; ++s) { const bf16x8v kf0 = *(const LAS bf16x8v*)(kt + s * 32), kf1 = *(const LAS bf16x8v*)(kt + 32 * 144 + s * 32);
        p0 = __builtin_amdgcn_mfma_f32_32x32x16_bf16(kf0, Qf[s], p0, 0, 0, 0); p1 = __builtin_amdgcn_mfma_f32_32x32x16_bf16(kf1, Qf[s], p1, 0, 0, 0); }
    if (MASK) {
#pragma unroll
        for (int reg = 0; reg < 16; ++reg) { const int c = cl + crow0(reg); p0[reg] = (c < nvis_l) ? p0[reg] : -INFINITY; p1[reg] = (c + 32 < nvis_l) ? p1[reg] : -INFINITY; } }
}
__device__ __forceinline__ void U_cmp(KP p_, int bg_, int u_) {
    const KP p = uni_kp(p_); const int bg = __builtin_amdgcn_readfirstlane(bg_), uu = __builtin_amdgcn_readfirstlane(u_);
    int tid_ = threadIdx.x; asm volatile("" : "+v"(tid_));
    const int tid = tid_, lane = tid & 63, wave = __builtin_amdgcn_readfirstlane(tid >> 6), r = lane & 31, h = lane >> 5;
    unsigned char* ws = p->ws; asm volatile("" : "+s"(ws)); LAS unsigned char* L = (LAS unsigned char*)lds_raw;
    const int b = bg >> 1, g = bg & 1, tw0 = 32 * (uu + 16 * wave), t_lane = tw0 + r;
    { const bf16* kc = (const bf16*)(ws + WS_KVCMP) + (size_t)bg * 256 * 64; const bf16* vc = kc + 16 * 256 * 64;
#pragma unroll
      for (int i = 0; i < 4; ++i) { const int ch = tid + 512 * i, row = ch >> 3, c8 = ch & 7;
          *(LAS u32x4*)(L + row * 144 + c8 * 16) = *(const u32x4*)(kc + row * 64 + c8 * 8); *(LAS u32x4*)(L + 36864 + row * 144 + c8 * 16) = *(const u32x4*)(vc + row * 64 + c8 * 8); } }
    __syncthreads();
    const int nvis_l = t_lane >= 31 ? ((t_lane - 31) >> 4) + 1 : 0, nvis_max = (tw0 >> 4) + 1, nvis_min = tw0 >= 31 ? ((tw0 - 31) >> 4) + 1 : 0, ntile = (nvis_max + 63) >> 6;
    const LAS unsigned char* kfrag = L + r * 144 + h * 16;
    const LAS unsigned char* vfrag = L + 36864 + (4 * h + ((lane & 15) >> 2)) * 144 + (16 * ((lane >> 4) & 1) + 4 * (lane & 3)) * 2;
    float imp[32];
#pragma unroll
    for (int e = 0; e < 32; ++e) imp[e] = 0.f;
    const float* gate = (const float*)(ws + WS_GATE) + ((size_t)b * T_ + t_lane) * 24;
#pragma unroll 1
    for (int hg = 0; hg < 4; ++hg) {
        const int hd = g * 4 + hg; const float s1 = alibi_slope(hd + 1, 8) * LOG2E * 16.f;
        const bf16* q = (const bf16*)(ws + WS_QN) + (size_t)(b * 8 + hd) * T_ * 64 + (t_lane >> 4) * 1024 + (t_lane & 15) * 32 + 8 * h;
        bf16x8v Qf[4];
#pragma unroll
        for (int s = 0; s < 4; ++s) Qf[s] = *(const bf16x8v*)(q + (s >> 1) * 512 + (s & 1) * 16);
        float m = -1e30f, lsum = 0.f;
#pragma unroll 1
        for (int jt = 0; jt < ntile; ++jt) {
            f32x16 p0, p1; const float b0 = s1 * (float)(64 * jt + 4 * h - nvis_max);
            if (64 * jt + 63 >= nvis_min) cmp_scores<true>(p0, p1, kfrag + jt * (64 * 144), Qf, b0, s1, 64 * jt + 4 * h, nvis_l);
            else cmp_scores<false>(p0, p1, kfrag + jt * (64 * 144), Qf, b0, s1, 64 * jt + 4 * h, nvis_l);
            float mt = fmaxf(p0[0], p1[0]);
#pragma unroll
            for (int reg = 1; reg < 16; ++reg) mt = fmaxf(mt, fmaxf(p0[reg], p1[reg]));
            mt = swap_max(mt);
            const float mn = fmaxf(m, mt); float rs = 0.f;
#pragma unroll
            for (int reg = 0; reg < 16; ++reg) rs += __builtin_amdgcn_exp2f(p0[reg] - mn) + __builtin_amdgcn_exp2f(p1[reg] - mn);
            lsum = lsum * __builtin_amdgcn_exp2f(m - mn) + rs; m = mn;
        }
        const float lt = swap_sum(lsum), inv = lt > 0.f ? 1.f / lt : 0.f;
        f32x16 O0, O1;
#pragma unroll
        for (int i = 0; i < 16; ++i) { O0[i] = 0.f; O1[i] = 0.f; }
        float carry = 0.f;
#pragma unroll
        for (int jt = 0; jt < 4; ++jt) if (jt < ntile) {
            f32x16 p0, p1; const float b0 = s1 * (float)(64 * jt + 4 * h - nvis_max);
            if (64 * jt + 63 >= nvis_min) cmp_scores<true>(p0, p1, kfrag + jt * (64 * 144), Qf, b0, s1, 64 * jt + 4 * h, nvis_l);
            else cmp_scores<false>(p0, p1, kfrag + jt * (64 * 144), Qf, b0, s1, 64 * jt + 4 * h, nvis_l);
#pragma unroll
            for (int reg = 0; reg < 16; ++reg) { p0[reg] = __builtin_amdgcn_exp2f(p0[reg] - m) * inv; p1[reg] = __builtin_amdgcn_exp2f(p1[reg] - m) * inv; }
            float cv[8];
#pragma unroll
            for (int g4 = 0; g4 < 4; ++g4) { const float h0 = 0.5f * p0[4 * g4 + 3], h1 = 0.5f * p1[4 * g4 + 3];
                imp[jt * 8 + g4] += ((p0[4 * g4] + p0[4 * g4 + 1]) + p0[4 * g4 + 2]) + h0; imp[jt * 8 + 4 + g4] += ((p1[4 * g4] + p1[4 * g4 + 1]) + p1[4 * g4 + 2]) + h1;
                cv[g4] = h0; cv[4 + g4] = h1; }
            float prev = carry;
#pragma unroll
            for (int k = 0; k < 8; ++k) { const float sv = other_half(cv[k], h); imp[jt * 8 + k] += h ? sv : prev; prev = sv; }
            carry = prev;
            const bf16x8v pa0 = pack8(p0, 0), pa1 = pack8(p0, 8), pa2 = pack8(p1, 0), pa3 = pack8(p1, 8);
            const LAS unsigned char* vb = vfrag + jt * (64 * 144);
#pragma unroll
            for (int ks = 0; ks < 4; ++ks) { const bf16x8v pa = ks == 0 ? pa0 : ks == 1 ? pa1 : ks == 2 ? pa2 : pa3;
                { const s16x4 lo = tr_read(vb + ks * (16 * 144)), hi = tr_read(vb + ks * (16 * 144) + 8 * 144); const bf16x8v vf = {lo[0], lo[1], lo[2], lo[3], hi[0], hi[1], hi[2], hi[3]};
                  O0 = __builtin_amdgcn_mfma_f32_32x32x16_bf16(vf, pa, O0, 0, 0, 0); }
                { const s16x4 lo = tr_read(vb + ks * (16 * 144) + 64), hi = tr_read(vb + ks * (16 * 144) + 64 + 8 * 144); const bf16x8v vf = {lo[0], lo[1], lo[2], lo[3], hi[0], hi[1], hi[2], hi[3]};
                  O1 = __builtin_amdgcn_mfma_f32_32x32x16_bf16(vf, pa, O1, 0, 0, 0); } }
        }
        const float gt = gate[hd * 3 + 0];
        bf16* dst = (bf16*)(ws + WS_OCMP) + mix_off((size_t)b * T_ + t_lane, hd * 64 + 4 * h, 512);
#pragma unroll
        for (int g4 = 0; g4 < 4; ++g4) {
            *(u64*)(dst + g4 * 256) = (u64)cvtpk(O0[4 * g4 + 0] * gt, O0[4 * g4 + 1] * gt) | ((u64)cvtpk(O0[4 * g4 + 2] * gt, O0[4 * g4 + 3] * gt) << 32);
            *(u64*)(dst + (4 + g4) * 256) = (u64)cvtpk(O1[4 * g4 + 0] * gt, O1[4 * g4 + 1] * gt) | ((u64)cvtpk(O1[4 * g4 + 2] * gt, O1[4 * g4 + 3] * gt) << 32); }
    }
    const int cur = tw0 >> 6; u64 mask;
    if (cur <= 15) mask = (1ull << (cur + 1)) - 1ull;
    else {
        mask = 1ull | (1ull << cur) | (1ull << (cur - 1));
#pragma unroll
        for (int e = 0; e < 32; ++e) { const int j = 2 * e + h; if (j > cur || j == 0 || j >= cur - 1) imp[e] = -INFINITY; }
#pragma unroll 1
        for (int round = 0; round < 13; ++round) {
            float bv = imp[0]; int be = 0;
#pragma unroll
            for (int e = 1; e < 32; ++e) if (imp[e] > bv) { bv = imp[e]; be = e; }
            const int bj = 2 * be + h; const float ov = other_half(bv, h); const int oj = other_half_i(bj, h);
            const bool mine = bv > ov || (bv == ov && bj < oj);
            mask |= 1ull << (mine ? bj : oj);
#pragma unroll
            for (int e = 0; e < 32; ++e) imp[e] = (mine && e == be) ? -INFINITY : imp[e];
        }
    }
    if (h == 0) ((u64*)(ws + WS_SEL))[(size_t)bg * T_ + t_lane] = mask;
    __syncthreads();
}
constexpr int CONV_UNITS = L_ * NEXP * (2 * 16 * 8 + 4 * 32) / 32;
__device__ __forceinline__ void U_conv(KP p_, int k_) {
    const KP p = uni_kp(p_); const int k = __builtin_amdgcn_readfirstlane(k_);
    int tid_ = threadIdx.x; asm volatile("" : "+v"(tid_));
    const int tid = tid_, lane = tid & 63, wave = __builtin_amdgcn_readfirstlane(tid >> 6);
    unsigned char* ws = p->ws; asm volatile("" : "+s"(ws));
    LAS float* scr = (LAS float*)lds_raw + wave * (64 * 33);
    constexpr int I_G = 16 * 8, I_D = 4 * 32, I_E = 2 * I_G + I_D;
#pragma unroll 1
    for (int i = 0; i < 4; ++i) {
        const int m = k * 32 + i * 8 + wave, l = m / (NEXP * I_E); int r = m % (NEXP * I_E); const int e = r / I_E; r = r % I_E; const size_t le = (size_t)l * NEXP + e;
        const float* W; bf16* WT; int ldw, K, ncol, r0 = 0, rmul = 1; const float* gk = nullptr;
        if (r < 2 * I_G) { const int up = r >= I_G; r -= up * I_G; W = p->in[19 + up] + le * D_ * DEXP; WT = (bf16*)(ws + WS_WGU_T) + le * 512 * D_; ldw = DEXP; K = D_; ncol = 256; r0 = up; rmul = 2; gk = p->in[14] + (size_t)l * D_; }
        else { r -= 2 * I_G; W = p->in[21] + le * DEXP * D_; WT = (bf16*)(ws + WS_WD_T) + le * D_ * DEXP; ldw = D_; K = DEXP; ncol = 1024; }
        transpose_seg(W, ldw, K, 0, ncol, WT, r0, rmul, r, scr, lane, gk);
    }
}
__device__ __forceinline__ int fetch_unit(KP p, int qidx) {
    volatile LAS unsigned* slot = (volatile LAS unsigned*)((LAS unsigned char*)lds_raw + MISC_OFF) + 16;
    __syncthreads();
    int t0_ = threadIdx.x; asm volatile("" : "+v"(t0_));
    if (t0_ == 0) *slot = __hip_atomic_fetch_add((unsigned*)(p->ws + WS_CTL) + CW_QUEUE + 64 * qidx, 1u, __ATOMIC_RELAXED, __HIP_MEMORY_SCOPE_AGENT);
    __syncthreads();
    return (int)__builtin_amdgcn_readfirstlane(*slot);
}
__device__ __forceinline__ void P_cmp1_mfma(int l_) { const KP p = (KP)__builtin_amdgcn_kernarg_segment_ptr(); int l = l_; asm volatile("" : "+s"(l));
    unsigned char* ws = p->ws; asm volatile("" : "+s"(ws)); const int c = launder_s((int)blockIdx.x), kv = c >> 4, pm = c & 15;
    OneUnitOrder S; S.has = c < 32; S.u.pm = pm; S.u.pn = kv;
    S.u.a = (const char*)(ws + WS_KV6 + (size_t)kv * KV6_STRIDE) + (size_t)pm * 256 * 1024 * 2; S.u.b = (const char*)((const bf16*)(ws + WS_W1_T) + ((size_t)l * 2 + kv) * 256 * 2048); S.u.b2 = S.u.b;
    const pg8::Gemm g{1024, 2048, 2048, 32, 0, 0};
    const EpiCmpH E{(bf16*)(ws + WS_HC), (const float*)(ws + WS_BIAS1) + l * 512};
    pg8::gemm_phase<EpiCmpH, OneUnitOrder, false, true>((LAS unsigned char*)lds_raw, g, S, E);
}
__device__ __forceinline__ void P_cmp2_mfma(int l_) { const KP p = (KP)__builtin_amdgcn_kernarg_segment_ptr(); int l = l_; asm volatile("" : "+s"(l));
    unsigned char* ws = p->ws; asm volatile("" : "+s"(ws)); const int c = launder_s((int)blockIdx.x), kv = c >> 4, pm = c & 15;
    OneUnitOrder S; S.has = c < 32; S.u.pm = pm; S.u.pn = kv;
    S.u.a = (const char*)((const bf16*)(ws + WS_HC) + ((size_t)kv * 4096 + pm * 256) * 256); S.u.b = (const char*)((const bf16*)(ws + WS_W2_T) + ((size_t)l * 2 + kv) * 64 * 256); S.u.b2 = S.u.b;
    const pg8::Gemm g{256, 256, 256, 4, 0, 0};
    const EpiCmpOut E{(bf16*)(ws + WS_KVCMP)};
    pg8::gemm_phase<EpiCmpOut, OneUnitOrder, false, true>((LAS unsigned char*)lds_raw, g, S, E);
}
__device__ __forceinline__ void P_moe_scatter(KP p_, int l_) { const KP p = uni_kp(p_); const int l = __builtin_amdgcn_readfirstlane(l_); const Ctx c = make_ctx(p); unsigned char* ws = p->ws;
    const unsigned* cnt = (const unsigned*)(ws + WS_CTL) + CW_MOECNT + l * MOE_LS;
    moe_build_tables(cnt, c.tid);
    const LAS int* T = (const LAS int*)((LAS unsigned char*)lds_raw + TBL_OFF);
    const unsigned* info = (const unsigned*)(ws + WS_ROUTE + RT_INFO); const float* tw = (const float*)(ws + WS_ROUTE + RT_W);
    int* rowtok = (int*)(ws + WS_ROUTE + RT_ROWTOK); float* roww = (float*)(ws + WS_ROUTE + RT_ROWW);
    bf16* xs = (bf16*)(ws + WS_XS); const bf16* x = (const bf16*)(ws + WS_HN); const float* gain = p->in[14] + (size_t)l * D_; const float* rstdv = (const float*)(ws + WS_ROUTE + RT_RSTD);
    { constexpr int RB = 4; float gg[2][8];
#pragma unroll
      for (int j = 0; j < 2; ++j) { const f32x4 a = ((const f32x4*)gain)[2 * c.lane + 128 * j], b2 = ((const f32x4*)gain)[2 * c.lane + 128 * j + 1]; gg[j][0] = a.x; gg[j][1] = a.y; gg[j][2] = a.z; gg[j][3] = a.w; gg[j][4] = b2.x; gg[j][5] = b2.y; gg[j][6] = b2.z; gg[j][7] = b2.w; }
      for (int row0 = c.gw * RB; row0 < NT; row0 += c.ngw * RB) {
        u32x4 vv[RB][2];
#pragma unroll
        for (int q = 0; q < RB; ++q)
#pragma unroll
            for (int j = 0; j < 2; ++j) vv[q][j] = ((const u32x4*)(x + (size_t)(row0 + q) * D_))[c.lane + 64 * j];
#pragma unroll
        for (int q = 0; q < RB; ++q) { const int row = row0 + q;
            const unsigned v = info[row]; const int cls = (int)(v >> 24), rank = (int)(v & 0xffffffu); const size_t dest = (size_t)T[cls] * 256 + rank; const float r = rstdv[row];
#pragma unroll
            for (int j = 0; j < 2; ++j) { float f[8]; unpack8(vv[q][j], f); u32x4 o; o.x = pk2(f[0] * r * gg[j][0], f[1] * r * gg[j][1]); o.y = pk2(f[2] * r * gg[j][2], f[3] * r * gg[j][3]); o.z = pk2(f[4] * r * gg[j][4], f[5] * r * gg[j][5]); o.w = pk2(f[6] * r * gg[j][6], f[7] * r * gg[j][7]);
                ((u32x4*)(xs + dest * D_))[c.lane + 64 * j] = o; }
            if (c.lane == 0) { rowtok[dest] = row; roww[2 * dest] = tw[2 * row]; roww[2 * dest + 1] = tw[2 * row + 1]; } }
      } }
    for (int cls = c.bid; cls < 112; cls += c.G) { const int n = (int)cnt[cls * MOE_CS], end = (int)((cnt[cls * MOE_CS] + 255u) >> 8) * 256; const size_t base = (size_t)T[cls] * 256;
        for (int r = n + c.tid; r < end; r += NTHREADS) rowtok[base + r] = -1; }
}
__device__ __forceinline__ int xcd_major(int bid, int G) { bid = launder_s(bid); return (G & 7) ? bid : (bid & 7) * (G >> 3) + (bid >> 3); }
__device__ __forceinline__ void P_moe_g1(int l_) { const KP p = (KP)__builtin_amdgcn_kernarg_segment_ptr(); int l = l_; asm volatile("" : "+s"(l));
    unsigned char* ws = p->ws; asm volatile("" : "+s"(ws));
    { int t0_ = threadIdx.x; asm volatile("" : "+v"(t0_)); moe_build_tables((const unsigned*)(ws + WS_CTL) + CW_MOECNT + l * MOE_LS, t0_); }
    const MoeOrder1 S{(const char*)ws, (const unsigned*)(ws + WS_REC), (const char*)((const bf16*)(ws + WS_WGU_T) + (size_t)l * NEXP * 512 * D_), (unsigned*)(ws + WS_CTL) + CW_MOECNT + l * MOE_LS + (112 + NEXP) * MOE_CS, (int)gridDim.x, xcd_major((int)blockIdx.x, (int)gridDim.x)};
    const pg8::Gemm g{D_, D_, D_, D_ / 64, 0, 0};
    const EpiMoeH E{(bf16*)(ws + WS_HB), (const u32x4*)(ws + WS_REC)};
    pg8::gemm_phase<EpiMoeH, MoeOrder1, true, true, true>((LAS unsigned char*)lds_raw, g, S, E);
}
__device__ __forceinline__ void P_moe_g2(int l_) { const KP p = (KP)__builtin_amdgcn_kernarg_segment_ptr(); int l = l_; asm volatile("" : "+s"(l));
    unsigned char* ws = p->ws; asm volatile("" : "+s"(ws));
    { int t0_ = threadIdx.x; asm volatile("" : "+v"(t0_)); moe_build_tables((const unsigned*)(ws + WS_CTL) + CW_MOECNT + l * MOE_LS, t0_); }
    const MoeOrder2 S{(const char*)(ws + WS_HB), (const char*)((const bf16*)(ws + WS_WD_T) + (size_t)l * NEXP * D_ * DEXP), (const unsigned*)(ws + WS_CTL) + CW_MOECNT + l * MOE_LS + (112 + NEXP) * MOE_CS, (unsigned*)(ws + WS_CTL) + XB_TMO + 4096, (int)gridDim.x, xcd_major((int)blockIdx.x, (int)gridDim.x)};
    const pg8::Gemm g{512, DEXP, 512, 4, 16, 16};
    const EpiMoeOut E{(bf16*)(ws + WS_HN), (const unsigned*)(ws + WS_RECC)};
    pg8::gemm_phase<EpiMoeOut, MoeOrder2, true, true>((LAS unsigned char*)lds_raw, g, S, E);
}
__device__ __forceinline__ void P_norm1(KP p_, int l_) { const KP p = uni_kp(p_); const int l = __builtin_amdgcn_readfirstlane(l_); const Ctx c = make_ctx(p); const Bufs b = make_bufs(p->ws);
    if (l == 0) { const int i = c.bid * NTHREADS + c.tid; if (i < L_ * 2 * 256) { const float* part = (const float*)(p->ws + WS_B1PART) + (size_t)(i >> 8) * 128 * 256 + (i & 255); float a = 0.f;
        for (int k = 0; k < 128; ++k) a += part[(size_t)k * 256]; ((float*)(p->ws + WS_BIAS1))[i] = a; } }
    if (l == 0) ph_norm_bf16(c, p->in[0], p->in[1], (bf16*)p->out, (bf16*)(p->ws + WS_HN)); else ph_norm_bf16_from_bf16(c, (const bf16*)(p->ws + WS_HN), p->in[1] + (size_t)l * D_, (bf16*)p->out); }
__device__ __noinline__ void P_inproj(KP p_, int l_) { const KP p = uni_kp(p_); const int l = __builtin_amdgcn_readfirstlane(l_); const Ctx c = make_ctx(p); const Bufs b = make_bufs(p->ws);
    InProjOut o{b.QN, b.KV6, b.FQ, b.DQ, b.DV, b.GATE, b.FL, p->in[3] + l * 24, p->in[4] + l * 4};
    const bf16* A = b.HN;
    naive_gemm(c, NT, D_IN, D_, [=](int r, int k) { return bf2f(A[(size_t)r * D_ + k]); }, p->in[2] + (size_t)l * D_ * D_IN, D_IN,
               [=](int r, int col, float v) { inproj_store(o, r, col, v); }); }
__device__ __noinline__ void P_cmp1(KP p_, int l_, int kv_) { const KP p = uni_kp(p_); const int l = __builtin_amdgcn_readfirstlane(l_), kv = __builtin_amdgcn_readfirstlane(kv_); const Ctx c = make_ctx(p); const Bufs b = make_bufs(p->ws);
    const bf16* src = kv == 0 ? b.KC : b.VC; const float* pe = p->in[kv == 0 ? 5 : 8] + (size_t)l * 2048; bf16* hc = b.HC + (size_t)kv * 4096 * 256;
    naive_gemm(c, 4096, 256, 2048, [=](int r, int k) { return bf2f(src[(size_t)r * 1024 + k]) + pe[k]; }, p->in[kv == 0 ? 6 : 9] + (size_t)l * 2048 * 256, 256,
               [=](int r, int col, float v) { hc[(size_t)r * 256 + col] = (bf16)f2bf(gelu_tanh(v)); }); }
__device__ __noinline__ void P_cumsum(KP p_, int l_) { const KP p = uni_kp(p_); const int l = __builtin_amdgcn_readfirstlane(l_); const Ctx c = make_ctx(p); const Bufs b = make_bufs(p->ws); ph_cumsum(c, b.FL); }
__device__ __noinline__ void P_cmp2(KP p_, int l_, int kv_) { const KP p = uni_kp(p_); const int l = __builtin_amdgcn_readfirstlane(l_), kv = __builtin_amdgcn_readfirstlane(kv_); const Ctx c = make_ctx(p); const Bufs b = make_bufs(p->ws);
    const bf16* hc = b.HC + (size_t)kv * 4096 * 256; bf16* dst = kv == 0 ? b.KCMP : b.VCMP;
    naive_gemm(c, 4096, 64, 256, [=](int r, int k) { return bf2f(hc[(size_t)r * 256 + k]); }, p->in[kv == 0 ? 7 : 10] + (size_t)l * 256 * 64, 64,
               [=](int r, int col, float v) { dst[(size_t)r * 64 + col] = (bf16)f2bf((r & 255) == 255 ? 0.f : v); }); }
__device__ __noinline__ void P_win(KP p_, int l_) { const KP p = uni_kp(p_); const int l = __builtin_amdgcn_readfirstlane(l_); const Ctx c = make_ctx(p); const Bufs b = make_bufs(p->ws); ph_win_attn(c, b.QN, b.KW, b.VW, b.GATE, b.OWIN); }
__device__ __noinline__ void P_fox(KP p_, int l_) { const KP p = uni_kp(p_); const int l = __builtin_amdgcn_readfirstlane(l_); const Ctx c = make_ctx(p); const Bufs b = make_bufs(p->ws); ph_fox_attn(c, b.FQ, b.FK, b.FV, b.FL, b.ATT); }
__device__ __noinline__ void P_diff(KP p_, int l_) { const KP p = uni_kp(p_); const int l = __builtin_amdgcn_readfirstlane(l_); const Ctx c = make_ctx(p); const Bufs b = make_bufs(p->ws);
    ph_diff_attn(c, b.DQ, b.DK, b.DV, p->in[11] + (size_t)l * 128, p->in[12] + (size_t)l * 64, lambda_init_of(l), b.ATT); }
__device__ __noinline__ void P_cmpattn(KP p_, int l_) { const KP p = uni_kp(p_); const int l = __builtin_amdgcn_readfirstlane(l_); const Ctx c = make_ctx(p); const Bufs b = make_bufs(p->ws); ph_cmp_attn(c, b.QN, b.KCMP, b.VCMP, b.GATE, b.SEL, b.OCMP); }
__device__ __noinline__ void P_slc(KP p_, int l_) { const KP p = uni_kp(p_); const int l = __builtin_amdgcn_readfirstlane(l_); const Ctx c = make_ctx(p); const Bufs b = make_bufs(p->ws); ph_slc_attn(c, b.QN, b.KS, b.VS, b.GATE, b.SEL, b.OCMP, b.OWIN, b.ATT); }
__device__ __noinline__ void P_outproj(KP p_, int l_) { const KP p = uni_kp(p_); const int l = __builtin_amdgcn_readfirstlane(l_); const Ctx c = make_ctx(p); const Bufs b = make_bufs(p->ws);
    const bf16* A = b.ATT; float* xo = p->out; const float* xin = (l == 0) ? p->in[0] : p->out;
    naive_gemm(c, NT, D_, D_, [=](int r, int k) { return bf2f(A[(size_t)r * D_ + k]); }, p->in[13] + (size_t)l * D_ * D_, D_,
               [=](int r, int col, float v) { xo[(size_t)r * D_ + col] = xin[(size_t)r * D_ + col] + v; }); }
__device__ __forceinline__ void P_route3(int l_, int cbank) { const KP p = (KP)__builtin_amdgcn_kernarg_segment_ptr(); int l = l_; asm volatile("" : "+s"(l));
    int tid_ = threadIdx.x; asm volatile("" : "+v"(tid_));
    const int tid = tid_, lane = tid & 63, wave = __builtin_amdgcn_readfirstlane(tid >> 6), r = lane & 31, h = lane >> 5, kh = wave >> 2, wr = wave & 3;
    unsigned char* ws = p->ws; asm volatile("" : "+s"(ws)); const bf16* x = (const bf16*)(ws + WS_HN);
    const float* WR = (const float*)(ws + WS_WR) + (size_t)l * D_ * 64;
    LAS float* XT = (LAS float*)lds_raw + wave * (32 * 36);
    LAS float* WT = (LAS float*)lds_raw + 8 * 32 * 36 + kh * (2 * 32 * 64);
    LAS float* PL = (LAS float*)lds_raw + 8 * 32 * 36 + 2 * 2 * 32 * 64;
    LAS float* SS = PL + 2 * 128 * 40;
    const float* bgrp = p->in[16] + l * 4; const float* bexp = p->in[18] + l * 32;
    unsigned* cnt = (unsigned*)(ws + WS_CTL) + CW_MOECNT + l * MOE_LS + cbank;
    LAS unsigned* HIST = (LAS unsigned*)(SS + 2 * 128 * 2);
    for (int grp = launder_s((int)blockIdx.x); grp < NT / 128; grp += (int)gridDim.x) {
        const int row0 = grp * 128 + wr * 32;
        if (tid < 144) HIST[tid] = 0u;
        f32x16 acc0, acc1; float ss = 0.f;
#pragma unroll
        for (int i = 0; i < 16; ++i) { acc0[i] = 0.f; acc1[i] = 0.f; }
        { const u32x4* xsrc = (const u32x4*)(x + (size_t)(row0 + r) * D_ + kh * 512 + 8 * h);
          const u32x4* wsrc = (const u32x4*)(ws + WS_WR) + ((size_t)l * 64 + kh * 32) * 256 + lane;
#pragma unroll 4
          for (int ks = 0; ks < 32; ++ks) {
              const u32x4 av = xsrc[2 * ks], b0h = wsrc[ks * 256], b0l = wsrc[ks * 256 + 64], b1h = wsrc[ks * 256 + 128], b1l = wsrc[ks * 256 + 192];
              { float f_[8]; unpack8(av, f_);
#pragma unroll
                for (int e = 0; e < 8; ++e) ss = fmaf(f_[e], f_[e], ss); }
              const bf16x8v A = __builtin_bit_cast(bf16x8v, av);
              acc0 = __builtin_amdgcn_mfma_f32_32x32x16_bf16(A, __builtin_bit_cast(bf16x8v, b0h), acc0, 0, 0, 0); acc1 = __builtin_amdgcn_mfma_f32_32x32x16_bf16(A, __builtin_bit_cast(bf16x8v, b1h), acc1, 0, 0, 0);
              acc0 = __builtin_amdgcn_mfma_f32_32x32x16_bf16(A, __builtin_bit_cast(bf16x8v, b0l), acc0, 0, 0, 0); acc1 = __builtin_amdgcn_mfma_f32_32x32x16_bf16(A, __builtin_bit_cast(bf16x8v, b1l), acc1, 0, 0, 0);
          } }
#pragma unroll
        for (int reg = 0; reg < 16; ++reg) { const int row = wr * 32 + crow0(reg) + 4 * h; PL[(kh * 128 + row) * 40 + r] = acc0[reg]; if (r < 4) PL[(kh * 128 + row) * 40 + 32 + r] = acc1[reg]; }
        SS[(kh * 128 + wr * 32 + r) * 2 + h] = ss;
        __syncthreads();
        int cls = 0, ea = 0, eb = 0; unsigned lrank = 0u, lra = 0u, lrb = 0u; float wlo = 0.f, whi = 0.f, rstd = 0.f;
        if (tid < 128) {
            float lg[36];
#pragma unroll
            for (int cidx = 0; cidx < 36; ++cidx) lg[cidx] = PL[tid * 40 + cidx] + PL[(128 + tid) * 40 + cidx];
            const float sq = (SS[tid * 2] + SS[tid * 2 + 1]) + (SS[(128 + tid) * 2] + SS[(128 + tid) * 2 + 1]);
            rstd = rsqrtf(sq * (1.f / D_) + EPS);
            float gl[4]; int grp_i = 0;
#pragma unroll
            for (int q = 0; q < 4; ++q) gl[q] = lg[q] * rstd + bgrp[q];
            float gm = gl[0];
#pragma unroll
            for (int q = 1; q < 4; ++q) if (gl[q] > gm) { gm = gl[q]; grp_i = q; }
            float gs = 0.f;
#pragma unroll
            for (int q = 0; q < 4; ++q) gs += __expf(gl[q] - gm);
            const float grp_gate = 1.f / gs;
            float el[8];
#pragma unroll
            for (int q = 0; q < 8; ++q) { float v = lg[4 + q]; float bb = bexp[q];
                if (grp_i == 1) { v = lg[12 + q]; bb = bexp[8 + q]; } else if (grp_i == 2) { v = lg[20 + q]; bb = bexp[16 + q]; } else if (grp_i == 3) { v = lg[28 + q]; bb = bexp[24 + q]; }
                el[q] = v * rstd + bb; }
            int i0 = 0; float v0 = el[0];
#pragma unroll
            for (int q = 1; q < 8; ++q) if (el[q] > v0) { v0 = el[q]; i0 = q; }
            int i1 = -1; float v1 = -INFINITY;
#pragma unroll
            for (int q = 0; q < 8; ++q) if (q != i0 && el[q] > v1) { v1 = el[q]; i1 = q; }
            const float e1 = __expf(v1 - v0), den = 1.f + e1, w0 = grp_gate / den, w1 = grp_gate * e1 / den;
            const int lo = i0 < i1 ? i0 : i1, hi = i0 < i1 ? i1 : i0; cls = grp_i * 28 + lo * 8 - (lo * (lo + 1)) / 2 + (hi - lo - 1);
            wlo = i0 < i1 ? w0 : w1; whi = i0 < i1 ? w1 : w0;
            ea = grp_i * 8 + lo; eb = grp_i * 8 + hi;
            lrank = __hip_atomic_fetch_add(HIST + cls, 1u, __ATOMIC_RELAXED, __HIP_MEMORY_SCOPE_WORKGROUP);
            lra = __hip_atomic_fetch_add(HIST + 112 + ea, 1u, __ATOMIC_RELAXED, __HIP_MEMORY_SCOPE_WORKGROUP); lrb = __hip_atomic_fetch_add(HIST + 112 + eb, 1u, __ATOMIC_RELAXED, __HIP_MEMORY_SCOPE_WORKGROUP);
        }
        __syncthreads();
        if (tid < 144) { const unsigned n = HIST[tid]; if (n) HIST[144 + tid] = __hip_atomic_fetch_add(cnt + tid * MOE_CS, n, __ATOMIC_RELAXED, __HIP_MEMORY_SCOPE_AGENT); }
        __syncthreads();
        if (tid < 128) {
            const unsigned rank = HIST[144 + cls] + lrank, ra = HIST[144 + 112 + ea] + lra, rb = HIST[144 + 112 + eb] + lrb;
            const int row = grp * 128 + tid;
            ((unsigned*)(ws + WS_RECC))[(size_t)cls * 32768 + rank] = (unsigned)row;
            const unsigned info = ((unsigned)cls << 16) | rank;
            ((u32x4*)(ws + WS_REC))[(size_t)ea * 32768 + ra] = (u32x4){(unsigned)row, __float_as_uint(wlo), __float_as_uint(rstd), info};
            ((u32x4*)(ws + WS_REC))[(size_t)eb * 32768 + rb] = (u32x4){(unsigned)row, __float_as_uint(whi), __float_as_uint(rstd), info | 0x8000u};
        }
        __syncthreads();
    }
}
typedef float f32x8 __attribute__((ext_vector_type(8)));
__device__ __forceinline__ void P_route2(int l_, int cbank) { const KP p = (KP)__builtin_amdgcn_kernarg_segment_ptr(); int l = l_; asm volatile("" : "+s"(l));
    int tid_ = threadIdx.x; asm volatile("" : "+v"(tid_));
    const int tid = tid_, lane = tid & 63, wave = __builtin_amdgcn_readfirstlane(tid >> 6);
    unsigned char* ws = p->ws; asm volatile("" : "+s"(ws)); const float* x = p->out;
    const float* WR = (const float*)(ws + WS_WR) + (size_t)l * D_ * 40;
    LAS float* xt = (LAS float*)lds_raw + wave * (64 * 36);
    LAS float* part = (LAS float*)lds_raw;
    const float* bgrp = p->in[16] + l * 4; const float* bexp = p->in[18] + l * 32;
    unsigned* cnt = (unsigned*)(ws + WS_CTL) + CW_MOECNT + l * 128 + cbank;
    for (int grp = launder_s((int)blockIdx.x); grp < NT / 128; grp += (int)gridDim.x) {
        const int row0 = grp * 128 + (wave >> 2) * 64, kq = wave & 3;
        float acc[40]; float ss = 0.f;
#pragma unroll
        for (int cidx = 0; cidx < 40; ++cidx) acc[cidx] = 0.f;
#pragma unroll 1
        for (int kc = 0; kc < 8; ++kc) {
            const int k0 = kq * 256 + kc * 32;
#pragma unroll
            for (int i = 0; i < 8; ++i) { const int row = i * 8 + (lane >> 3), c4 = (lane & 7) * 4; *(LAS f32x4*)(xt + row * 36 + c4) = *(const f32x4*)(x + (size_t)(row0 + row) * D_ + k0 + c4); }
            float xr[32];
#pragma unroll
            for (int j = 0; j < 8; ++j) { const f32x4 t = *(const LAS f32x4*)(xt + lane * 36 + 4 * j); xr[4 * j] = t.x; xr[4 * j + 1] = t.y; xr[4 * j + 2] = t.z; xr[4 * j + 3] = t.w; }
            const float* wk = WR + (size_t)k0 * 40;
#pragma unroll
            for (int kk = 0; kk < 32; ++kk) {
                f32x8 w0, w1, w2, w3, w4;
                asm volatile("s_load_dwordx8 %0, %5, %6\n\ts_load_dwordx8 %1, %5, %7\n\ts_load_dwordx8 %2, %5, %8\n\ts_load_dwordx8 %3, %5, %9\n\ts_load_dwordx8 %4, %5, %10\n\ts_waitcnt lgkmcnt(0)"
                             : "=&s"(w0), "=&s"(w1), "=&s"(w2), "=&s"(w3), "=&s"(w4) : "s"(wk), "i"(kk * 160), "i"(kk * 160 + 32), "i"(kk * 160 + 64), "i"(kk * 160 + 96), "i"(kk * 160 + 128) : "memory");
                const float xv = xr[kk]; ss = fmaf(xv, xv, ss);
#pragma unroll
                for (int e = 0; e < 8; ++e) { acc[e] = fmaf(xv, w0[e], acc[e]); acc[8 + e] = fmaf(xv, w1[e], acc[8 + e]); acc[16 + e] = fmaf(xv, w2[e], acc[16 + e]); acc[24 + e] = fmaf(xv, w3[e], acc[24 + e]); }
#pragma unroll
                for (int e = 0; e < 4; ++e) acc[32 + e] = fmaf(xv, w4[e], acc[32 + e]);
            }
        }
        __syncthreads();
#pragma unroll
        for (int cidx = 0; cidx < 36; ++cidx) part[(wave * 64 + lane) * 37 + cidx] = acc[cidx];
        part[(wave * 64 + lane) * 37 + 36] = ss;
        __syncthreads();
        if (tid < 128) {
            const int rg = tid >> 6, rr = tid & 63; float lg[37];
#pragma unroll
            for (int cidx = 0; cidx < 37; ++cidx) lg[cidx] = ((part[((rg * 4 + 0) * 64 + rr) * 37 + cidx] + part[((rg * 4 + 1) * 64 + rr) * 37 + cidx]) + part[((rg * 4 + 2) * 64 + rr) * 37 + cidx]) + part[((rg * 4 + 3) * 64 + rr) * 37 + cidx];
            const float rstd = rsqrtf(lg[36] * (1.f / D_) + EPS);
            float gl[4]; int grp_i = 0;
#pragma unroll
            for (int q = 0; q < 4; ++q) gl[q] = lg[q] * rstd + bgrp[q];
            float gm = gl[0];
#pragma unroll
            for (int q = 1; q < 4; ++q) if (gl[q] > gm) { gm = gl[q]; grp_i = q; }
            float gs = 0.f;
#pragma unroll
            for (int q = 0; q < 4; ++q) gs += __expf(gl[q] - gm);
            const float grp_gate = 1.f / gs;
            float el[8];
#pragma unroll
            for (int q = 0; q < 8; ++q) { float v = lg[4 + q]; float bb = bexp[q];
                if (grp_i == 1) { v = lg[12 + q]; bb = bexp[8 + q]; } else if (grp_i == 2) { v = lg[20 + q]; bb = bexp[16 + q]; } else if (grp_i == 3) { v = lg[28 + q]; bb = bexp[24 + q]; }
                el[q] = v * rstd + bb; }
            int i0 = 0; float v0 = el[0];
#pragma unroll
            for (int q = 1; q < 8; ++q) if (el[q] > v0) { v0 = el[q]; i0 = q; }
            int i1 = -1; float v1 = -INFINITY;
#pragma unroll
            for (int q = 0; q < 8; ++q) if (q != i0 && el[q] > v1) { v1 = el[q]; i1 = q; }
            const float e1 = __expf(v1 - v0), den = 1.f + e1, w0 = grp_gate / den, w1 = grp_gate * e1 / den;
            const int lo = i0 < i1 ? i0 : i1, hi = i0 < i1 ? i1 : i0, cls = grp_i * 28 + lo * 8 - (lo * (lo + 1)) / 2 + (hi - lo - 1);
            const unsigned rank = __hip_atomic_fetch_add(cnt + cls, 1u, __ATOMIC_RELAXED, __HIP_MEMORY_SCOPE_AGENT);
            const int row = grp * 128 + tid;
            ((unsigned*)(ws + WS_ROUTE + RT_INFO))[row] = ((unsigned)cls << 24) | rank;
            ((float*)(ws + WS_ROUTE + RT_W))[2 * row] = i0 < i1 ? w0 : w1; ((float*)(ws + WS_ROUTE + RT_W))[2 * row + 1] = i0 < i1 ? w1 : w0;
            ((float*)(ws + WS_ROUTE + RT_RSTD))[row] = rstd;
        }
        __syncthreads();
    }
}
__device__ __noinline__ void P_route(KP p_, int l_) { const KP p = uni_kp(p_); const int l = __builtin_amdgcn_readfirstlane(l_); const Ctx c = make_ctx(p); const Bufs b = make_bufs(p->ws);
    ph_moe_route(c, p->out, p->in[14] + (size_t)l * D_, p->in[15] + (size_t)l * D_ * 4, p->in[16] + l * 4, p->in[17] + (size_t)l * D_ * 32, p->in[18] + l * 32, b.HN, (int*)(p->ws + WS_ROUTE + RT_INFO), (float*)(p->ws + WS_ROUTE + RT_W), (unsigned*)(p->ws + WS_CTL) + CW_MOECNT + l * 128); }
__device__ __noinline__ void P_moe(KP p_, int l_) { const KP p = uni_kp(p_); const int l = __builtin_amdgcn_readfirstlane(l_); const Ctx c = make_ctx(p); const Bufs b = make_bufs(p->ws);
    ph_moe_naive(c, b.HN, b.ROUTE_E, b.ROUTE_W, p->in[19] + (size_t)l * NEXP * D_ * DEXP, p->in[20] + (size_t)l * NEXP * D_ * DEXP, p->in[21] + (size_t)l * NEXP * DEXP * D_, p->out); }
__device__ __noinline__ void P_final(KP p_) { const KP p = uni_kp(p_); const Ctx c = make_ctx(p); ph_norm_final_from_bf16(c, (const bf16*)(p->ws + WS_HN), p->in[22], p->out); }
__device__ __forceinline__ void P_gridbar(KP p_) { const KP p = uni_kp(p_);
    XcdBarrier bar; bar.bar = (unsigned*)(p->ws + WS_CTL) + 4096; bar.x = xb_xcc_id(); bar.st = (volatile LAS unsigned*)((LAS unsigned char*)lds_raw + MISC_OFF) + 8;
    xcd_barrier(bar);
}

__global__ void __launch_bounds__(NTHREADS, 2) fwd_kernel(Params pp) {
    const KP p = (KP)__builtin_amdgcn_kernarg_segment_ptr();
    { volatile LAS unsigned* MISC = (volatile LAS unsigned*)((LAS unsigned char*)lds_raw + MISC_OFF); if (threadIdx.x < 32) MISC[threadIdx.x] = 0u; }
    __syncthreads();
    const int lo = p->ph_lo, hi = p->ph_hi;
    if (hi - lo > 1) (void)xcd_barrier_post((unsigned*)(p->ws + WS_CTL) + 4096, (volatile LAS unsigned*)((LAS unsigned char*)lds_raw + MISC_OFF) + 8);
#define IN(k) (lo <= (k) && (k) < hi)
#define SEAM(k) do { if (IN(k) && IN((k) + 1)) P_gridbar(p); } while (0)
    if (IN(0)) { for (int rep = 0; rep < REP_PRO; ++rep) { if (rep) P_gridbar(p); P_prologue(p); } }
    SEAM(0);
    for (int l = 0; l < L_; ++l) {
        const int P0 = 1 + l * PH_PER_LAYER;
        if (IN(P0 + 0)) { for (int rep = 0; rep < REP_NORM; ++rep) { if (rep) P_gridbar(p); P_norm1(p, l); } }
        SEAM(P0 + 0);
        if (IN(P0 + 1)) { for (int rep = 0; rep < REP_INPROJ; ++rep) { if (rep) P_gridbar(p); P_inproj_mfma(l); }
#ifdef REP_INDUMMY
            for (int rep = 0; rep < REP_INDUMMY; ++rep) { P_gridbar(p); P_inproj_dummy(l); }
#endif
        }
        SEAM(P0 + 1);
        if (IN(P0 + 3)) {
            P_cmp1_mfma(l);
            if (launder_s((int)blockIdx.x) < 32) { asm volatile("s_waitcnt vmcnt(0)" ::: "memory"); __builtin_amdgcn_fence(__ATOMIC_SEQ_CST, "agent"); asm volatile("s_waitcnt vmcnt(0)" ::: "memory"); }
            __syncthreads();
            P_cmp2_mfma(l);
            for (int rep = 0; rep < REP_ATT3; ++rep) { if (rep) P_gridbar(p);
            for (;;) { int u = fetch_unit(p, l * 8 + 0 + 16 * rep);
                if (l == 0) {
                    if (u >= 2048 + CONV_UNITS) break;
                    const int k11 = u / 11, r11 = u - 11 * k11;
                    if (r11 == 3 || r11 == 7 || r11 == 10) { U_conv(p, 3 * k11 + (r11 > 3) + (r11 > 7)); continue; }
                    u = 8 * k11 + r11 - (r11 > 3) - (r11 > 7); }
                else if (u >= 2048) break;
                if (u < 1024) { const int qb = 15 - (u >> 6), k = u & 63; if (k < 32) U_diff(p, k, qb, l); else U_fox(p, k - 32, qb, l); }
                else { const int w = u - 1024; U_win(p, w & 15, 63 - (w >> 4));
#ifdef PROBE_WINUNIT2
                    U_win(p, w & 15, 63 - (w >> 4));
#endif
                } } } }
        SEAM(P0 + 3);
        if (IN(P0 + 4)) { for (int rep = 0; rep < REP_CMP; ++rep) { if (rep) P_gridbar(p); for (int u = launder_s((int)blockIdx.x); u < 256; u += (int)gridDim.x) U_cmp(p, u & 15, u >> 4); } }
        SEAM(P0 + 4);
        if (IN(P0 + 5)) { for (int rep = 0; rep < REP_SLC; ++rep) { if (rep) P_gridbar(p); for (;;) { const int u = fetch_unit(p, l * 8 + 1 + 16 * rep); if (u >= 1024) break; U_slc(p, u & 15, 63 - (u >> 4)); } } }
        SEAM(P0 + 5);
        if (IN(P0 + 6)) P_outproj_mfma(l);
        SEAM(P0 + 6);
        if (IN(P0 + 7)) { for (int rep = 0; rep < REP_ROUTE; ++rep) { if (rep) P_gridbar(p); P_route3(l, REP_ROUTE - 1 - rep); } }
        SEAM(P0 + 7);
        if (IN(P0 + 9)) { for (int rep = 0; rep < REP_G1; ++rep) { if (rep) P_gridbar(p); P_moe_g1(l); } }
        if (IN(P0 + 10)) P_moe_g2(l);
        SEAM(P0 + 10);
    }
    if (IN(1 + L_ * PH_PER_LAYER)) P_final(p);
#undef IN
#undef SEAM
}

extern "C" void kernel_launch(void* const* d_in, const int* in_sizes, int n_in, void* d_out, int out_size, void* d_ws, size_t ws_size, hipStream_t stream) {
    static int grid = 0;
    if (grid == 0) {
        if (n_in != 23 || out_size != NT * D_ || ws_size < WS_END) { fprintf(stderr, "kernel_launch: unexpected sizes n_in %d out %d ws %zu (need %zu)\n", n_in, out_size, ws_size, (size_t)WS_END); grid = -1; return; }
        int dev = 0, cus = 0, per_cu = 0;
        if (hipGetDevice(&dev) != hipSuccess || hipDeviceGetAttribute(&cus, hipDeviceAttributeMultiprocessorCount, dev) != hipSuccess) { grid = -1; return; }
        if (hipFuncSetAttribute((const void*)fwd_kernel, hipFuncAttributeMaxDynamicSharedMemorySize, LDS_BYTES) != hipSuccess) { fprintf(stderr, "kernel_launch: hipFuncSetAttribute failed\n"); grid = -1; return; }
        if (hipOccupancyMaxActiveBlocksPerMultiprocessor(&per_cu, (const void*)fwd_kernel, NTHREADS, LDS_BYTES) != hipSuccess || per_cu < 1) { fprintf(stderr, "kernel_launch: occupancy query says %d\n", per_cu); }
        (void)hipGetLastError();
        grid = cus;
    }
    if (grid < 0) return;
    (void)hipMemsetAsync((char*)d_ws + WS_CTL, 0, CTL_BYTES, stream);
    Params p{};
    for (int i = 0; i < 23; ++i) p.in[i] = (const float*)d_in[i];
    p.out = (float*)d_out; p.ws = (unsigned char*)d_ws;
#if N_LAUNCH_MODE == 0
    p.ph_lo = 0; p.ph_hi = N_PHASES;
    hipLaunchKernelGGL(fwd_kernel, dim3(grid), dim3(NTHREADS), LDS_BYTES, stream, p);
#else
    for (int k = 0; k < N_PHASES; ++k) { p.ph_lo = k; p.ph_hi = k + 1; hipLaunchKernelGGL(fwd_kernel, dim3(grid), dim3(NTHREADS), LDS_BYTES, stream, p); }
#endif
}
```

```cpp
#include <hip/hip_runtime.h>
#include <cstdio>
#include <cstdint>

#ifndef INPROJ_ALIGN
#define INPROJ_ALIGN true
#endif
#ifndef INPROJ_SP2
#define INPROJ_SP2 true
#endif
#ifndef REP_PRO
#define REP_PRO 1
#endif
#ifndef REP_ROUTE
#define REP_ROUTE 1
#endif
#ifndef REP_NORM
#define REP_NORM 1
#endif
#ifndef REP_INPROJ
#define REP_INPROJ 1
#endif
#ifndef REP_ATT3
#define REP_ATT3 1
#endif
#ifndef REP_CMP
#define REP_CMP 1
#endif
#ifndef REP_SLC
#define REP_SLC 1
#endif
#ifndef REP_SCAT
#define REP_SCAT 1
#endif
#ifndef REP_G1
#define REP_G1 1
#endif
#ifndef N_LAUNCH_MODE
#define N_LAUNCH_MODE 0
#endif

#ifndef NOMAX_ON
#define NOMAX_ON true
#endif
#define LAS __attribute__((address_space(3)))
#define GAS __attribute__((address_space(1)))
typedef unsigned short bf16;
typedef unsigned long long u64;
typedef float f32x4 __attribute__((ext_vector_type(4)));
typedef unsigned u32x4 __attribute__((ext_vector_type(4)));

constexpr int B_ = 8, T_ = 4096, D_ = 1024, NT = B_ * T_, L_ = 2;
constexpr int HD = 64, D_IN = 2844;
constexpr int N_CMP = 255, CMP_HID = 256;
constexpr int NEXP = 32, DEXP = 256;
constexpr float EPS = 1e-6f;
constexpr float LOG2E = 1.4426950408889634f;
constexpr int NWAVES = 8, NTHREADS = 512;

constexpr int C_NSAQ = 0, C_KV6 = 512, C_GATE = 1280, C_FQ = 1304, C_FF = 2072, C_DQ = 2076, C_DV = 2588;

constexpr size_t MiB = 1u << 20;
constexpr size_t WS_CTL = 0, CTL_BYTES = 1 * MiB;
constexpr size_t WS_QN = 1 * MiB;
constexpr size_t WS_KV6 = WS_QN + 32 * MiB;
constexpr size_t KV6_STRIDE = 8 * MiB + 64 * 1024;
constexpr size_t WS_FQKV = WS_KV6 + 6 * KV6_STRIDE;
constexpr size_t WS_DQK = WS_FQKV + 48 * MiB;
constexpr size_t WS_DV = WS_DQK + 32 * MiB;
constexpr size_t WS_GATE = WS_DV + 16 * MiB;
constexpr size_t WS_FL = WS_GATE + 3 * MiB;
constexpr size_t WS_HC = WS_FL + 1 * MiB;
constexpr size_t WS_KVCMP = WS_HC + 4 * MiB;
constexpr size_t WS_SEL = WS_KVCMP + 1 * MiB;
constexpr size_t WS_OCMP = WS_SEL + 1 * MiB;
constexpr size_t WS_OWIN = WS_OCMP + 32 * MiB;
constexpr size_t WS_HN = WS_OWIN + 32 * MiB;
constexpr size_t WS_ATT = WS_HN + 64 * MiB;
constexpr size_t WS_ROUTE = WS_ATT + 64 * MiB;
constexpr size_t WS_WIN_T = WS_ROUTE + 2 * MiB;
constexpr size_t WS_WOUT_T = WS_WIN_T + 12 * MiB;
constexpr size_t WS_WGU_T = WS_WOUT_T + 4 * MiB;
constexpr size_t WS_WD_T = WS_WGU_T + 64 * MiB;
constexpr size_t WS_W1_T = WS_WD_T + 32 * MiB;
constexpr size_t WS_W2_T = WS_W1_T + 4 * MiB;
constexpr size_t WS_BIAS1 = WS_W2_T + 512 * 1024;
constexpr size_t WS_WR = WS_BIAS1 + 512 * 1024;
constexpr size_t WS_B1PART = WS_WR + 512 * 1024;
constexpr size_t WS_END = WS_B1PART + 512 * 1024;
constexpr int MOE_MAXROWS = 61440;
constexpr size_t WS_XS = WS_QN;
constexpr size_t WS_HB = WS_OCMP;
static_assert(WS_XS + (size_t)MOE_MAXROWS * 2048 <= WS_DQK && WS_HB + (size_t)MOE_MAXROWS * 1024 <= WS_HN, "MoE aliases");
constexpr size_t RT_INFO = 0, RT_W = 128 * 1024, RT_ROWTOK = 384 * 1024, RT_ROWW = 640 * 1024, RT_RSTD = 1152 * 1024;
constexpr int CW_QUEUE = 16384, CW_MOECNT = 32768, CW_KN = 49152, MOE_CS = 32, MOE_LS = 8192;
constexpr size_t WS_REC = WS_QN;
constexpr size_t WS_RECC = WS_REC + (size_t)NEXP * 32768 * 16;
constexpr unsigned ZROW_OFF = 512 * 1024;
static_assert(WS_RECC + (size_t)112 * 32768 * 4 <= WS_DQK && WS_HN + (size_t)NT * 2048 < (1ull << 32) && CW_MOECNT + L_ * MOE_LS <= CW_KN && (112 + 2 * NEXP) * MOE_CS <= MOE_LS, "MoE record tables / 32-bit row offsets / counters");
constexpr int TBL_OFF = 131072 + 1024;
constexpr int NIN = 3072;

extern __shared__ __attribute__((aligned(16))) unsigned char lds_raw[];
__device__ __forceinline__ float bf2f(bf16 v) { return __uint_as_float(((unsigned)v) << 16); }
__device__ __forceinline__ unsigned f2bf(float f) { unsigned u = __float_as_uint(f); return (u + 0x7fffu + ((u >> 16) & 1u)) >> 16; }
__device__ __forceinline__ unsigned pk2(float lo, float hi) { return f2bf(lo) | (f2bf(hi) << 16); }
__device__ __forceinline__ float wave_sum(float v) {
#pragma unroll
    for (int o = 1; o < 64; o <<= 1) v += __shfl_xor(v, o);
    return v;
}
__device__ __forceinline__ float wave_max(float v) {
#pragma unroll
    for (int o = 1; o < 64; o <<= 1) v = fmaxf(v, __shfl_xor(v, o));
    return v;
}
__device__ __forceinline__ float shflx_f(float v, int o, int lane) { return __uint_as_float((unsigned)__builtin_amdgcn_ds_bpermute((lane ^ o) << 2, (int)__float_as_uint(v))); }
__device__ __forceinline__ unsigned shflx_u(unsigned v, int o, int lane) { return (unsigned)__builtin_amdgcn_ds_bpermute((lane ^ o) << 2, (int)v); }
__device__ __forceinline__ float wave_sum_l(float v, int lane) {
#pragma unroll
    for (int o = 1; o < 64; o <<= 1) v += shflx_f(v, o, lane);
    return v;
}
__device__ __forceinline__ int launder_s(int v) { asm volatile("" : "+s"(v)); return v; }
__device__ __forceinline__ float sigmoidf_(float x) { return 1.f / (1.f + __expf(-x)); }
__device__ __forceinline__ float log_sigmoidf_(float x) { return x >= 0.f ? -log1pf(__expf(-x)) : x - log1pf(__expf(x)); }
__device__ __forceinline__ float gelu_tanh(float x) { const float u = 0.7978845608028654f * (x + 0.044715f * x * x * x); return 0.5f * x * (1.f + tanhf(u)); }
__device__ __forceinline__ float alibi_slope(int idx1, int n) { return exp2f(-8.0f * (float)idx1 / (float)n); }

__device__ __forceinline__ constexpr int b64_off(int t, int d) { return ((t >> 4) * 2 + (d >> 5)) * 512 + (t & 15) * 32 + (d & 31); }
#define XB_TMO      128
#define XB_XCNT(j)  (256  + 64 * (j))
#define XB_XSUB(j)  (1280 + 64 * (j))
#define XB_XGEN(j)  (2304 + 64 * (j))
#define XB_TOP      3328
#define XB_TOPGEN   3392
#define XCD_BAR_WORDS 3456
#define XB_SPIN_CAP (1u << 25)
__device__ __forceinline__ unsigned xb_ld(unsigned* p)              { return __hip_atomic_load(p, __ATOMIC_RELAXED, __HIP_MEMORY_SCOPE_AGENT); }
__device__ __forceinline__ unsigned xb_add(unsigned* p, unsigned v) { return __hip_atomic_fetch_add(p, v, __ATOMIC_RELAXED, __HIP_MEMORY_SCOPE_AGENT); }
__device__ __forceinline__ unsigned xb_xcc_id() { return (unsigned)__builtin_amdgcn_s_getreg((3 << 11) | 20) & 0xFu; }
#define XB_SPIN(cond, bar) do { unsigned _sp = 0; while (cond) { __builtin_amdgcn_s_sleep(1); \
    if ((++_sp & 255u) == 0u) { if (xb_ld(&(bar)[XB_TMO])) break; if (_sp > XB_SPIN_CAP) { atomicAdd(&(bar)[XB_TMO], 1u); break; } } } } while (0)
struct XcdBarrier { unsigned* bar; unsigned x; volatile LAS unsigned* st; };
__device__ __forceinline__ XcdBarrier xcd_barrier_post(unsigned* bar, volatile LAS unsigned* st) {
    XcdBarrier b; b.bar = bar; b.x = xb_xcc_id(); b.st = st;
    if (threadIdx.x == 0) (void)xb_add(&bar[XB_XCNT(b.x)], 1u);
    return b;
}
__device__ __forceinline__ void xcd_barrier_complete(unsigned* bar, unsigned x, unsigned& nloc, unsigned& nx) {
    const unsigned G = gridDim.x * gridDim.y * gridDim.z;
    unsigned sum, cnt, mine, sp = 0u;
    for (;;) {
        sum = 0u; cnt = 0u; mine = 0u;
#pragma unroll
        for (unsigned j = 0; j < 16; ++j) { const unsigned c = xb_ld(&bar[XB_XCNT(j)]); sum += c; cnt += (c > 0u) ? 1u : 0u; mine = (j == x) ? c : mine; }
        if (sum == G) break;
        __builtin_amdgcn_s_sleep(1);
        if ((++sp & 255u) == 0u) { if (xb_ld(&bar[XB_TMO])) break; if (sp > XB_SPIN_CAP) { atomicAdd(&bar[XB_TMO], 1u); break; } }
    }
    nloc = mine > 0u ? mine : 1u; nx = cnt > 0u ? cnt : 1u;
}
__device__ __forceinline__ void xcd_barrier(const XcdBarrier& b) {
    asm volatile("s_waitcnt vmcnt(0)" ::: "memory");
    __syncthreads();
    if (threadIdx.x == 0) {
        unsigned* bar = b.bar;
        __builtin_amdgcn_s_waitcnt(0);
        unsigned nloc = b.st[0], nx = b.st[1];
        if (nloc == 0u) { xcd_barrier_complete(bar, b.x, nloc, nx); b.st[0] = nloc; b.st[1] = nx; }
        const unsigned old = xb_add(&bar[XB_XSUB(b.x)], 1u);
        const unsigned gen = old / nloc;
        if (old + 1u == (gen + 1u) * nloc) {
            __builtin_amdgcn_fence(__ATOMIC_RELEASE, "agent");
            asm volatile("s_waitcnt vmcnt(0)" ::: "memory");
            const unsigned og = xb_add(&bar[XB_TOP], 1u);
            const unsigned tg = og / nx;
            if (og + 1u == (tg + 1u) * nx) xb_add(&bar[XB_TOPGEN], 1u);
            else XB_SPIN(xb_ld(&bar[XB_TOPGEN]) == tg, bar);
            __builtin_amdgcn_fence(__ATOMIC_ACQUIRE, "agent");
            xb_add(&bar[XB_XGEN(b.x)], 1u);
            asm volatile("s_waitcnt vmcnt(0)" ::: "memory");
        } else {
            XB_SPIN(xb_ld(&bar[XB_XGEN(b.x)]) == gen, bar);
            __builtin_amdgcn_fence(__ATOMIC_ACQUIRE, "agent");
            asm volatile("s_waitcnt vmcnt(0)" ::: "memory");
        }
    }
    __syncthreads();
}

struct Params { const float* in[23]; float* out; unsigned char* ws; int ph_lo, ph_hi; };
constexpr int LDS_BYTES = 147456;
constexpr int MISC_OFF = 131072 + 320;

struct Ctx {
    LAS unsigned char* lds; int tid, lane, wave, bid, G, gw, ngw;
    const float* const* in; float* xcur; unsigned char* ws;
};

namespace pg8 {
#define PG8_LAS __attribute__((address_space(3)))
typedef unsigned short bf16_t;
typedef short bf16x8 __attribute__((ext_vector_type(8)));
typedef float f32x4 __attribute__((ext_vector_type(4)));
typedef unsigned u32x4 __attribute__((ext_vector_type(4)));
constexpr int BM = 256, BK = 64, HALF = 128, HTB = HALF * BK * 2  , STAGE_BYTES = 8 * HTB, NXCD = 8, WGM = 8;

__host__ __device__ __forceinline__ int lds_byte(int r, int c) { const int st = (r >> 4) * 2 + (c >> 5), rr = r & 15, cc = c & 31, ob = rr * 64 + cc * 2; return st * 1024 + (ob ^ (((ob >> 9) & 1) << 5)); }
__host__ __device__ __forceinline__ void stage_rc(int b, int& R, int& C) { const int st = b / 1024, sb = b % 1024, swz = sb ^ (((sb >> 9) & 1) << 5); R = (st >> 1) * 16 + swz / 64; C = (st & 1) * 32 + (swz % 64) / 2; }
__host__ __device__ __forceinline__ int perm32(int rho) { const int n = rho >> 4, i = rho & 15; return 8 * (i >> 2) + 4 * n + (i & 3); }

struct Unit { int pm, pn; const char* a; const char* b; const char* b2; };
struct Gemm { int lda, ldb, K, ksplit, arb, acb; };

__device__ __forceinline__ unsigned cvt_pk_bf16(float lo, float hi) { unsigned r; asm volatile("v_cvt_pk_bf16_f32 %0, %1, %2" : "=v"(r) : "v"(lo), "v"(hi)); return r; }
typedef float f32x2 __attribute__((ext_vector_type(2)));

template <class Epi, class Sched, bool ALIGN_EPI = false, bool SP2 = false, bool GATHER = false>
__device__ __forceinline__ void gemm_phase(PG8_LAS unsigned char* lds, const Gemm g, const Sched& S, const Epi& E) {
    static_assert(!GATHER || SP2, "GATHER is written for the SP2 loop");
    int tid_ = threadIdx.x; asm volatile("" : "+v"(tid_));
    const int tid = tid_, wid = __builtin_amdgcn_readfirstlane(tid >> 6), lane = tid & 63, wr = wid >> 2, wc = wid & 3, fr = lane & 15, fq = lane >> 4;
    const int K = g.K, nt = K / BK, ks = g.ksplit;
    unsigned voffA[2], voffB[2];
#pragma unroll
    for (int i = 0; i < 2; ++i) { int R, C; stage_rc(tid * 16 + i * 8192, R, C); const int Rb = Epi::PERM ? ((R & ~31) + perm32(R & 31)) : R;
        voffA[i] = g.arb ? (unsigned)(((R / g.arb) * (K / g.acb) + C / g.acb) * (g.arb * g.acb) + (R % g.arb) * g.acb + (C % g.acb)) * 2u : (unsigned)(R * g.lda + C) * 2u; voffB[i] = (unsigned)(Rb * g.ldb + C) * 2u; }
    const size_t kstep = (size_t)(BK * 2), kstepA = g.arb ? (size_t)(BK * g.arb * 2) : kstep;
    const size_t hsA = (size_t)HALF * (g.arb ? K : g.lda) * 2, hsB = (size_t)HALF * g.ldb * 2;
    const unsigned ldsw = (unsigned)wid * 1024u;
    const int aoff = lds_byte(wr * 64 + fr, fq * 8), boff = lds_byte(wc * 32 + fr, fq * 8);
#define PG8_SA(b, h) (((b) * 2 + (h)) * HTB)
#define PG8_SB(b, h) ((4 + (b) * 2 + (h)) * HTB)
#define PG8_STAGE(bufoff, gbase, voff) do { _Pragma("unroll") for (int _i = 0; _i < 2; ++_i) \
        __builtin_amdgcn_global_load_lds((const unsigned*)((const char*)(gbase) + (voff)[_i]), (PG8_LAS unsigned*)(lds + (bufoff) + ldsw + _i * 8192), 16, 0, 0); } while (0)
#define PG8_LDA(dst, b, h) do { _Pragma("unroll") for (int m = 0; m < 4; ++m) _Pragma("unroll") for (int k = 0; k < 2; ++k) dst[m][k] = *(const PG8_LAS bf16x8*)(lds + PG8_SA(b, h) + aoff + m * 2048 + k * 1024); } while (0)
#define PG8_LDB(dst, b, h) do { _Pragma("unroll") for (int n = 0; n < 2; ++n) _Pragma("unroll") for (int k = 0; k < 2; ++k) dst[n][k] = *(const PG8_LAS bf16x8*)(lds + PG8_SB(b, h) + boff + n * 2048 + k * 1024); } while (0)
#define PG8_MMA(ai, bj, At, Bt) do { __builtin_amdgcn_s_setprio(1); _Pragma("unroll") for (int m = 0; m < 4; ++m) _Pragma("unroll") for (int n = 0; n < 2; ++n) _Pragma("unroll") for (int k = 0; k < 2; ++k) \
        acc[ai][bj][m][n] = __builtin_amdgcn_mfma_f32_16x16x32_bf16(Bt[n][k], At[m][k], acc[ai][bj][m][n], 0, 0, 0); __builtin_amdgcn_s_setprio(0); } while (0)
#define PG8_WAIT_V(n) asm volatile("s_waitcnt vmcnt(" #n ")" ::: "memory")
#define PG8_WAIT_L(n) asm volatile("s_waitcnt lgkmcnt(" #n ")" ::: "memory")
#define PG8_BAR __builtin_amdgcn_s_barrier()
#define PG8_SCHED __builtin_amdgcn_sched_barrier(0)
    Unit cur, nxt; int ui = 0;
    if (!S.next(0, cur)) return;
    unsigned gC[2][2] = {{0u, 0u}, {0u, 0u}}, gN[2][2] = {{0u, 0u}, {0u, 0u}}; const char* gbase = nullptr;
#define PG8_GOFFS(U, Gv) do { int R_, C_; stage_rc(tid * 16, R_, C_); S.arows4(U, R_, (unsigned)C_ * 2u, Gv); } while (0)
#define PG8_STAGE_G(bufoff, kbyte, Gv, h) do { _Pragma("unroll") for (int _i = 0; _i < 2; ++_i) \
        __builtin_amdgcn_global_load_lds((const unsigned*)(gbase + (size_t)(kbyte) + Gv[h][_i]), (PG8_LAS unsigned*)(lds + (bufoff) + ldsw + _i * 8192), 16, 0, 0); } while (0)
    if constexpr (GATHER) { gbase = S.abase(); PG8_GOFFS(cur, gC); }
    f32x4 acc[2][2][4][2];
#pragma unroll
    for (int a = 0; a < 2; ++a)
#pragma unroll
        for (int b = 0; b < 2; ++b)
#pragma unroll
            for (int m = 0; m < 4; ++m)
#pragma unroll
                for (int n = 0; n < 2; ++n) acc[a][b][m][n] = (f32x4){0.f, 0.f, 0.f, 0.f};
    bf16x8 At[4][2], B0[2][2], B1[2][2];
    const char* cA = cur.a; const char* cB = cur.b; const char* cB2 = cur.b2;
#define PG8_BK(base, base2, kt) ((kt) < ks ? (base) + (size_t)(kt) * kstep : (base2) + (size_t)((kt) - ks) * kstep)
    S.a_ready(cur);
    if constexpr (SP2) {
        PG8_STAGE(PG8_SB(0, 0), cB, voffB); PG8_STAGE(PG8_SB(0, 1), cB + hsB, voffB);
        if constexpr (GATHER) { PG8_STAGE_G(PG8_SA(0, 0), 0, gC, 0); PG8_STAGE_G(PG8_SA(0, 1), 0, gC, 1); } else { PG8_STAGE(PG8_SA(0, 0), cA, voffA); PG8_STAGE(PG8_SA(0, 1), cA + hsA, voffA); }
        if (wr == 1) PG8_BAR;
        PG8_WAIT_V(2); PG8_BAR;
        PG8_STAGE(PG8_SB(1, 0), PG8_BK(cB, cB2, 1), voffB);
        if constexpr (GATHER) PG8_STAGE_G(PG8_SA(1, 0), kstep, gC, 0); else PG8_STAGE(PG8_SA(1, 0), cA + kstepA, voffA);
        PG8_STAGE(PG8_SB(1, 1), PG8_BK(cB, cB2, 1) + hsB, voffB);
        PG8_WAIT_V(6); PG8_BAR;
    } else {
        PG8_STAGE(PG8_SB(0, 0), cB, voffB); PG8_STAGE(PG8_SA(0, 0), cA, voffA); PG8_STAGE(PG8_SB(0, 1), cB + hsB, voffB); PG8_STAGE(PG8_SA(0, 1), cA + hsA, voffA);
        if (wr == 1) PG8_BAR;
        PG8_WAIT_V(4); PG8_BAR;
        PG8_STAGE(PG8_SB(1, 0), PG8_BK(cB, cB2, 1), voffB); PG8_STAGE(PG8_SA(1, 0), cA + kstepA, voffA); PG8_STAGE(PG8_SB(1, 1), PG8_BK(cB, cB2, 1) + hsB, voffB);
        PG8_WAIT_V(6); PG8_BAR;
    }
    for (;;) {
        const bool has_next = S.next(ui + 1, nxt);
        if constexpr (GATHER) { if (has_next) PG8_GOFFS(nxt, gN); else { _Pragma("unroll") for (int _h = 0; _h < 2; ++_h) _Pragma("unroll") for (int _i = 0; _i < 2; ++_i) gN[_h][_i] = gC[_h][_i]; } }
        const char* nA = has_next ? nxt.a : cA; const char* nB = has_next ? nxt.b : cB; const char* nB2 = has_next ? nxt.b2 : cB2;
#pragma unroll 1
        for (int t = 0; t < nt; t += 2) {
            const bool last = (t == nt - 2);
            const char* a1 = cA + (size_t)(t + 1) * kstepA;
            const char* a2 = last ? nA : cA + (size_t)(t + 2) * kstepA; const char* b2 = last ? PG8_BK(nB, nB2, 0) : PG8_BK(cB, cB2, t + 2);
            const char* a3 = a2 + kstepA; const char* b3 = last ? PG8_BK(nB, nB2, 1) : PG8_BK(cB, cB2, t + 3);
            if (last && has_next) S.a_ready(nxt);
            if constexpr (SP2) {
            PG8_LDB(B0, 0, 0); PG8_LDB(B1, 0, 1); PG8_SCHED; PG8_LDA(At, 0, 0);
            if constexpr (GATHER) PG8_STAGE_G(PG8_SA(1, 1), (size_t)(t + 1) * kstep, gC, 1); else PG8_STAGE(PG8_SA(1, 1), a1 + hsA, voffA);
            PG8_WAIT_V(8); PG8_WAIT_L(0); PG8_BAR; PG8_MMA(0, 0, At, B0); PG8_MMA(0, 1, At, B1); PG8_BAR; PG8_SCHED;
            PG8_LDA(At, 0, 1); PG8_STAGE(PG8_SB(0, 0), b2, voffB); PG8_STAGE(PG8_SB(0, 1), b2 + hsB, voffB);
            if constexpr (GATHER) { if (last) PG8_STAGE_G(PG8_SA(0, 0), 0, gN, 0); else PG8_STAGE_G(PG8_SA(0, 0), (size_t)(t + 2) * kstep, gC, 0); } else PG8_STAGE(PG8_SA(0, 0), a2, voffA);
            PG8_WAIT_V(8); PG8_WAIT_L(0); PG8_BAR; PG8_MMA(1, 0, At, B0); PG8_MMA(1, 1, At, B1); PG8_BAR; PG8_SCHED;
            PG8_LDB(B0, 1, 0); PG8_LDB(B1, 1, 1); PG8_SCHED; PG8_LDA(At, 1, 0);
            if constexpr (GATHER) { if (last) PG8_STAGE_G(PG8_SA(0, 1), 0, gN, 1); else PG8_STAGE_G(PG8_SA(0, 1), (size_t)(t + 2) * kstep, gC, 1); } else PG8_STAGE(PG8_SA(0, 1), a2 + hsA, voffA);
            PG8_WAIT_V(8); PG8_WAIT_L(0); PG8_BAR; PG8_MMA(0, 0, At, B0); PG8_MMA(0, 1, At, B1); PG8_BAR; PG8_SCHED;
            PG8_LDA(At, 1, 1); PG8_STAGE(PG8_SB(1, 0), b3, voffB); PG8_STAGE(PG8_SB(1, 1), b3 + hsB, voffB);
            if constexpr (GATHER) { if (last) PG8_STAGE_G(PG8_SA(1, 0), kstep, gN, 0); else PG8_STAGE_G(PG8_SA(1, 0), (size_t)(t + 3) * kstep, gC, 0); } else PG8_STAGE(PG8_SA(1, 0), a3, voffA);
            PG8_WAIT_V(8); PG8_WAIT_L(0); PG8_BAR; PG8_MMA(1, 0, At, B0); PG8_MMA(1, 1, At, B1); PG8_BAR; PG8_SCHED;
            } else {
            PG8_LDB(B0, 0, 0); PG8_SCHED; PG8_LDA(At, 0, 0); PG8_STAGE(PG8_SA(1, 1), a1 + hsA, voffA);
            PG8_WAIT_L(8); PG8_BAR; PG8_WAIT_L(0); PG8_MMA(0, 0, At, B0); PG8_BAR; PG8_SCHED;
            PG8_LDB(B1, 0, 1); PG8_STAGE(PG8_SB(0, 0), b2, voffB);
            PG8_BAR; PG8_WAIT_L(0); PG8_MMA(0, 1, At, B1); PG8_BAR;
            PG8_LDA(At, 0, 1); PG8_STAGE(PG8_SA(0, 0), a2, voffA);
            PG8_BAR; PG8_WAIT_L(0); PG8_MMA(1, 0, At, B0); PG8_BAR; PG8_SCHED;
            PG8_STAGE(PG8_SB(0, 1), b2 + hsB, voffB);
            PG8_WAIT_V(6); PG8_BAR; PG8_MMA(1, 1, At, B1); PG8_BAR;
            PG8_LDB(B0, 1, 0); PG8_SCHED; PG8_LDA(At, 1, 0); PG8_STAGE(PG8_SA(0, 1), a2 + hsA, voffA);
            PG8_WAIT_L(8); PG8_BAR; PG8_WAIT_L(0); PG8_MMA(0, 0, At, B0); PG8_BAR; PG8_SCHED;
            PG8_LDB(B1, 1, 1); PG8_STAGE(PG8_SB(1, 0), b3, voffB);
            PG8_BAR; PG8_WAIT_L(0); PG8_MMA(0, 1, At, B1); PG8_BAR;
            PG8_LDA(At, 1, 1); PG8_STAGE(PG8_SA(1, 0), a3, voffA);
            PG8_BAR; PG8_WAIT_L(0); PG8_MMA(1, 0, At, B0); PG8_BAR; PG8_SCHED;
            PG8_STAGE(PG8_SB(1, 1), b3 + hsB, voffB);
            PG8_WAIT_V(6); PG8_BAR; PG8_MMA(1, 1, At, B1); PG8_BAR;
            }
        }
        if constexpr (ALIGN_EPI) { if (wr == 0) PG8_BAR; }
        if constexpr (!Epi::AFTER_DRAIN) { E(acc, cur, wr, wc, fr, fq); S.done(cur); }
        if (!has_next) break;
#pragma unroll
        for (int a = 0; a < 2; ++a)
#pragma unroll
            for (int b = 0; b < 2; ++b)
#pragma unroll
                for (int m = 0; m < 4; ++m)
#pragma unroll
                    for (int n = 0; n < 2; ++n) acc[a][b][m][n] = (f32x4){0.f, 0.f, 0.f, 0.f};
        cur = nxt; cA = nA; cB = nB; cB2 = nB2; ++ui;
        if constexpr (GATHER) { _Pragma("unroll") for (int _h = 0; _h < 2; ++_h) _Pragma("unroll") for (int _i = 0; _i < 2; ++_i) gC[_h][_i] = gN[_h][_i]; }
        if constexpr (ALIGN_EPI) { if (wr == 1) PG8_BAR; }
    }
    PG8_WAIT_V(0);
    if constexpr (!ALIGN_EPI) { if (wr == 0) PG8_BAR; }
    PG8_BAR;
    if constexpr (Epi::AFTER_DRAIN) { E.fused(acc, cur, wr, wc, fr, fq, lds, wid, lane); S.done(cur); }
#undef PG8_BK
#undef PG8_GOFFS
#undef PG8_STAGE_G
#undef PG8_SA
#undef PG8_SB
#undef PG8_STAGE
#undef PG8_LDA
#undef PG8_LDB
#undef PG8_MMA
#undef PG8_WAIT_V
#undef PG8_WAIT_L
#undef PG8_BAR
#undef PG8_SCHED
}
}

struct PlainOrder {
    const char* A; const char* Bt; int lda, ldb, nM, nN, nwg, G, c;
    __device__ __forceinline__ void init(const void* A_, const void* Bt_, int lda_, int ldb_, int M, int N, int G_, int c_) { A = (const char*)A_; Bt = (const char*)Bt_; lda = lda_; ldb = ldb_; nM = M / 256; nN = N / 256; nwg = nM * nN; G = G_; c = c_; }
    __device__ __forceinline__ bool next(int i, pg8::Unit& u) const {
        const long L = (long)i * G + c; if (L >= nwg) return false;
        int wgid = (int)L; { const int q = nwg / 8, r = nwg % 8, xcd = wgid % 8, off = wgid / 8; wgid = (xcd < r ? xcd * (q + 1) : r * (q + 1) + (xcd - r) * q) + off; }
        const int nig = 8 * nN, gid = wgid / nig, fm = gid * 8, gsz = (nM - fm) < 8 ? (nM - fm) : 8;
        u.pm = fm + ((wgid % nig) % gsz); u.pn = (wgid % nig) / gsz;
        u.a = A + (size_t)u.pm * 256 * lda * 2; u.b = Bt + (size_t)u.pn * 256 * ldb * 2; u.b2 = u.b; return true;
    }
    __device__ __forceinline__ void a_ready(const pg8::Unit&) const {}
    __device__ __forceinline__ void done(const pg8::Unit&) const {}
};
struct EpiInProj {
    static constexpr bool PERM = true, AFTER_DRAIN = false;
    unsigned char* ws; const float* b_gate; const float* b_fgt; unsigned* kn;
    __device__ __forceinline__ void operator()(const pg8::f32x4 (&acc)[2][2][4][2], const pg8::Unit& u, int wr, int wc, int fr, int fq) const {
        { int t_ = threadIdx.x; asm volatile("" : "+v"(t_)); fr = t_ & 15; fq = (t_ >> 4) & 3; }
        const int pn = u.pn, b = (u.pm * 256) / T_, t0 = u.pm * 256 - b * T_ + wr * 64 + fr;
        if (pn == 11) {
            if (wc == 0 && fq < 4) {
                float* gate = (float*)(ws + WS_GATE); float* fl = (float*)(ws + WS_FL);
#pragma unroll
                for (int ai = 0; ai < 2; ++ai)
#pragma unroll
                    for (int m = 0; m < 4; ++m) { const int t = t0 + ai * 128 + m * 16; const size_t n = (size_t)b * T_ + t;
#pragma unroll
                        for (int nn = 0; nn < 2; ++nn)
#pragma unroll
                            for (int e = 0; e < 4; ++e) { const int c = 8 * fq + 4 * nn + e; const float v = acc[ai][0][m][nn][e];
                                if (c < 24) gate[n * 24 + c] = __builtin_amdgcn_rcpf(1.f + __builtin_amdgcn_exp2f(-(v + b_gate[c]) * LOG2E));
                                else if (c < 28) { const float z = v + b_fgt[c - 24];
                                    fl[(size_t)(b * 4 + (c - 24)) * T_ + t] = z < -30.f ? z : -0.6931471805599453f * __builtin_amdgcn_logf(1.f + __builtin_amdgcn_exp2f(-z * LOG2E)); } } }
            }
            return;
        }
        if (pn == 6 || pn == 9) {
            const int lane_ = (fq << 4) | fr;
#pragma unroll
            for (int bj = 0; bj < 2; ++bj)
#pragma unroll
                for (int ai = 0; ai < 2; ++ai) { float mx = 0.f;
#pragma unroll
                    for (int m = 0; m < 4; ++m) { const pg8::f32x4 v0 = acc[ai][bj][m][0], v1 = acc[ai][bj][m][1];
                        float ss = (v0[0] * v0[0] + v0[1] * v0[1]) + (v0[2] * v0[2] + v0[3] * v0[3]) + (v1[0] * v1[0] + v1[1] * v1[1]) + (v1[2] * v1[2] + v1[3] * v1[3]);
                        ss += shflx_f(ss, 16, lane_); ss += shflx_f(ss, 32, lane_); mx = fmaxf(mx, ss); }
#pragma unroll
                    for (int o = 1; o < 16; o <<= 1) mx = fmaxf(mx, shflx_f(mx, o, lane_));
                    if (lane_ == 0) { const int cg = bj * 4 + wc, tile = (u.pm * 256 - b * T_ + ai * 128 + wr * 64) >> 6;
                        unsigned* dst = pn == 6 ? kn + ((b * 4 + (cg >> 1)) * 64 + tile) * 2 + (cg & 1) : kn + 4096 + (b * 8 + cg) * 64 + tile;
                        atomicMax(dst, __float_as_uint(mx)); } }
        }
#pragma unroll
        for (int bj = 0; bj < 2; ++bj) {
            const int c = bj * 128 + wc * 32 + 8 * fq;
            bf16* base; int W = 64; float sc = 1.f;
            if (pn < 2) { base = (bf16*)(ws + WS_QN) + (size_t)(b * 8 + pn * 4 + (c >> 6)) * T_ * 64 + (c & 63); sc = 0.125f * LOG2E; }
            else if (pn < 5) { base = (bf16*)(ws + WS_KV6 + (size_t)((pn - 2) * 2 + (c >> 7)) * KV6_STRIDE) + (size_t)(b * 2 + ((c >> 6) & 1)) * T_ * 64 + (c & 63); }
            else if (pn < 8) { base = (bf16*)(ws + WS_FQKV) + (size_t)(pn - 5) * (8 * MiB) + (size_t)(b * 4 + (c >> 6)) * T_ * 64 + (c & 63); if (pn == 5) sc = 0.125f * LOG2E; }
            else if (pn < 10) { base = (bf16*)(ws + WS_DQK) + (size_t)(pn - 8) * (8 * MiB) + (size_t)(b * 8 + (c >> 5)) * T_ * 32 + (c & 31); W = 32; if (pn == 8) sc = 0.17677669529663687f * LOG2E; }
            else { base = (bf16*)(ws + WS_DV) + (size_t)(b * 4 + (c >> 6)) * T_ * 64 + (c & 63); }
            const bool blk = W == 64 && pn != 2;
            if (blk) base += -(c & 63) + ((c >> 5) & 1) * 512 + (c & 31);
#pragma unroll
            for (int ai = 0; ai < 2; ++ai)
#pragma unroll
                for (int m = 0; m < 4; ++m) { const int t = t0 + ai * 128 + m * 16;
                    const pg8::f32x4 v0 = acc[ai][bj][m][0] * sc, v1 = acc[ai][bj][m][1] * sc;
                    pg8::u32x4 w; w.x = pg8::cvt_pk_bf16(v0[0], v0[1]); w.y = pg8::cvt_pk_bf16(v0[2], v0[3]); w.z = pg8::cvt_pk_bf16(v1[0], v1[1]); w.w = pg8::cvt_pk_bf16(v1[2], v1[3]);
                    *(pg8::u32x4*)(base + (blk ? (size_t)((t >> 4) * 1024 + (t & 15) * 32) : (size_t)t * W)) = w; }
        }
    }
};
__device__ __forceinline__ u32x4 res_add8(u32x4 w, const pg8::f32x4& a0, const pg8::f32x4& a1) {
    u32x4 o;
    o.x = pg8::cvt_pk_bf16(__uint_as_float(w.x << 16) + a0[0], __uint_as_float(w.x & 0xffff0000u) + a0[1]); o.y = pg8::cvt_pk_bf16(__uint_as_float(w.y << 16) + a0[2], __uint_as_float(w.y & 0xffff0000u) + a0[3]);
    o.z = pg8::cvt_pk_bf16(__uint_as_float(w.z << 16) + a1[0], __uint_as_float(w.z & 0xffff0000u) + a1[1]); o.w = pg8::cvt_pk_bf16(__uint_as_float(w.w << 16) + a1[2], __uint_as_float(w.w & 0xffff0000u) + a1[3]);
    return o;
}
struct EpiResBf16 {
    static constexpr bool PERM = true, AFTER_DRAIN = false;
    bf16* xr;
    __device__ __forceinline__ void operator()(const pg8::f32x4 (&acc)[2][2][4][2], const pg8::Unit& u, int wr, int wc, int fr, int fq) const {
        { int t_ = threadIdx.x; asm volatile("" : "+v"(t_)); fr = t_ & 15; fq = (t_ >> 4) & 3; }
#pragma unroll
        for (int ai = 0; ai < 2; ++ai)
#pragma unroll
            for (int m = 0; m < 4; ++m) { const size_t off = (size_t)(u.pm * 256 + ai * 128 + wr * 64 + m * 16 + fr) * D_ + u.pn * 256 + wc * 32 + 8 * fq;
#pragma unroll
                for (int bj = 0; bj < 2; ++bj) { u32x4* q = (u32x4*)(xr + off + bj * 128); *q = res_add8(*q, acc[ai][bj][m][0], acc[ai][bj][m][1]); } }
    }
};


struct EpiDummy {
    static constexpr bool PERM = true, AFTER_DRAIN = false;
    float* dst;
    __device__ __forceinline__ void operator()(const pg8::f32x4 (&acc)[2][2][4][2], const pg8::Unit& u, int wr, int wc, int fr, int fq) const {
        pg8::f32x4 a = {0.f, 0.f, 0.f, 0.f};
#pragma unroll
        for (int ai = 0; ai < 2; ++ai)
#pragma unroll
            for (int bj = 0; bj < 2; ++bj)
#pragma unroll
                for (int m = 0; m < 4; ++m) { a = a + acc[ai][bj][m][0]; a = a + acc[ai][bj][m][1]; }
        *(pg8::f32x4*)(dst + ((size_t)(u.pm * 12 + u.pn) * 512 + threadIdx.x) * 4) = a;
    }
};
struct OneUnitOrder { pg8::Unit u; bool has;
    __device__ __forceinline__ bool next(int i, pg8::Unit& o) const { if (i != 0 || !has) return false; o = u; return true; }
    __device__ __forceinline__ void a_ready(const pg8::Unit&) const {}
    __device__ __forceinline__ void done(const pg8::Unit&) const {} };
__device__ __forceinline__ float gelu_tanh_fast(float x) { const float u2 = 1.5957691216057308f * (x + 0.044715f * x * x * x); return x * __builtin_amdgcn_rcpf(1.f + __builtin_amdgcn_exp2f(-u2 * LOG2E)); }
struct EpiCmpH {
    static constexpr bool PERM = true, AFTER_DRAIN = false;
    bf16* hc; const float* bias1;
    __device__ __forceinline__ void operator()(const pg8::f32x4 (&acc)[2][2][4][2], const pg8::Unit& u, int wr, int wc, int fr, int fq) const {
        { int t_ = threadIdx.x; asm volatile("" : "+v"(t_)); fr = t_ & 15; fq = (t_ >> 4) & 3; }
        const int kv = u.pn;
#pragma unroll
        for (int bj = 0; bj < 2; ++bj) { const int col = bj * 128 + wc * 32 + 8 * fq;
            const pg8::f32x4 b0 = *(const pg8::f32x4*)(bias1 + kv * 256 + col), b1 = *(const pg8::f32x4*)(bias1 + kv * 256 + col + 4);
#pragma unroll
            for (int ai = 0; ai < 2; ++ai)
#pragma unroll
                for (int m = 0; m < 4; ++m) { const int row = u.pm * 256 + ai * 128 + wr * 64 + m * 16 + fr;
                    const pg8::f32x4 v0 = acc[ai][bj][m][0] + b0, v1 = acc[ai][bj][m][1] + b1;
                    pg8::u32x4 w; w.x = pg8::cvt_pk_bf16(gelu_tanh_fast(v0[0]), gelu_tanh_fast(v0[1])); w.y = pg8::cvt_pk_bf16(gelu_tanh_fast(v0[2]), gelu_tanh_fast(v0[3]));
                    w.z = pg8::cvt_pk_bf16(gelu_tanh_fast(v1[0]), gelu_tanh_fast(v1[1])); w.w = pg8::cvt_pk_bf16(gelu_tanh_fast(v1[2]), gelu_tanh_fast(v1[3]));
                    *(pg8::u32x4*)(hc + ((size_t)kv * 4096 + row) * 256 + col) = w; } }
    }
};
struct EpiCmpOut {
    static constexpr bool PERM = true, AFTER_DRAIN = false;
    bf16* kvcmp;
    __device__ __forceinline__ void operator()(const pg8::f32x4 (&acc)[2][2][4][2], const pg8::Unit& u, int wr, int wc, int fr, int fq) const {
        { int t_ = threadIdx.x; asm volatile("" : "+v"(t_)); fr = t_ & 15; fq = (t_ >> 4) & 3; }
        if (wc >= 2) return;
        const int kv = u.pn, col = wc * 32 + 8 * fq;
#pragma unroll
        for (int ai = 0; ai < 2; ++ai)
#pragma unroll
            for (int m = 0; m < 4; ++m) { const int row = u.pm * 256 + ai * 128 + wr * 64 + m * 16 + fr; const float z = ((row & 255) == 255) ? 0.f : 1.f;
                const pg8::f32x4 v0 = acc[ai][0][m][0], v1 = acc[ai][0][m][1];
                pg8::u32x4 w; w.x = pg8::cvt_pk_bf16(z != 0.f ? v0[0] : 0.f, z != 0.f ? v0[1] : 0.f); w.y = pg8::cvt_pk_bf16(z != 0.f ? v0[2] : 0.f, z != 0.f ? v0[3] : 0.f);
                w.z = pg8::cvt_pk_bf16(z != 0.f ? v1[0] : 0.f, z != 0.f ? v1[1] : 0.f); w.w = pg8::cvt_pk_bf16(z != 0.f ? v1[2] : 0.f, z != 0.f ? v1[3] : 0.f);
                *(pg8::u32x4*)(kvcmp + ((size_t)kv * 4096 + row) * 64 + col) = w; }
    }
};

__device__ __forceinline__ void moe_build_tables(const unsigned* cnt, int tid) {
    LAS int* T = (LAS int*)((LAS unsigned char*)lds_raw + TBL_OFF);
    __syncthreads();
    if (tid < 112) T[384 + tid] = (int)cnt[tid * MOE_CS];
    else if (tid >= 128 && tid < 128 + NEXP) T[560 + tid - 128] = (int)cnt[(112 + tid - 128) * MOE_CS];
    __syncthreads();
    if (tid == 0) { int o = 0; _Pragma("clang loop unroll(disable)") for (int c = 0; c < 112; ++c) { T[c] = o; const int n = (T[384 + c] + 255) >> 8;
            _Pragma("clang loop vectorize(disable) unroll(disable)") for (int k = 0; k < n; ++k) T[128 + o + k] = c;
            o += n; } T[112] = o; }
    if (tid == 64) { int o = 0; _Pragma("clang loop unroll(disable)") for (int e = 0; e < NEXP; ++e) { T[512 + e] = o; const int n = (T[560 + e] + 255) >> 8;
            _Pragma("clang loop vectorize(disable) unroll(disable)") for (int k = 0; k < n; ++k) T[608 + o + k] = e;
            o += n; } T[544] = o; }
    __syncthreads();
}
__device__ __forceinline__ void moe_pair(int cls, int& ea, int& eb) { const int grp = cls / 28; int idx = cls % 28, lo = 0; while (idx >= 7 - lo) { idx -= 7 - lo; ++lo; } ea = grp * 8 + lo; eb = grp * 8 + lo + 1 + idx; }
struct MoeOrder1 {
    const char* wsb; const unsigned* rec; const char* wgu; unsigned* edone; int G, c;
    __device__ __forceinline__ bool next(int i, pg8::Unit& u) const {
        const LAS int* T = (const LAS int*)((LAS unsigned char*)lds_raw + TBL_OFF);
        const int idx = i * G + c; if (idx >= 2 * T[544]) return false;
        const int tile = idx >> 1, pn = idx & 1, e = T[608 + tile];
        u.pm = tile; u.pn = pn; u.a = wsb; u.b = wgu + ((size_t)e * 512 + pn * 256) * 2048; u.b2 = u.b; return true; }
    __device__ __forceinline__ const char* abase() const { return wsb; }
    __device__ __forceinline__ void arows4(const pg8::Unit& u, int r0, unsigned cb, unsigned (&g)[2][2]) const {
        const LAS int* T = (const LAS int*)((LAS unsigned char*)lds_raw + TBL_OFF);
        const int e = T[608 + u.pm], base = (u.pm - T[512 + e]) * 256 + r0, n = T[560 + e];
        const unsigned ob = (unsigned)(e * 32768 + base) * 16u;
#pragma unroll
        for (int k = 0; k < 4; ++k) { unsigned off = ZROW_OFF; if (base + 64 * k < n) off = (unsigned)WS_HN + *(const unsigned*)((const char*)rec + (ob + 1024u * k)) * 2048u; g[k >> 1][k & 1] = off + cb; } }
    __device__ __forceinline__ void a_ready(const pg8::Unit&) const {}
    __device__ __forceinline__ void done(const pg8::Unit& u) const {
        asm volatile("s_waitcnt vmcnt(0)" ::: "memory");
        const LAS int* T = (const LAS int*)((LAS unsigned char*)lds_raw + TBL_OFF);
        int t_ = threadIdx.x; asm volatile("" : "+v"(t_));
        if ((t_ & 63) == 0) (void)__hip_atomic_fetch_add(edone + T[608 + u.pm] * MOE_CS, 1u, __ATOMIC_RELAXED, __HIP_MEMORY_SCOPE_AGENT); } };
struct MoeOrder2 {
    const char* hb; const char* wd; const unsigned* edone; unsigned* tmo; int G, c;
    __device__ __forceinline__ bool next(int i, pg8::Unit& u) const {
        const LAS int* T = (const LAS int*)((LAS unsigned char*)lds_raw + TBL_OFF);
        const int n1 = (2 * T[544]) % G, idx = i * G + (c >= n1 ? c - n1 : c - n1 + G); if (idx >= 4 * T[112]) return false;
        const int tile = idx >> 2, pn = idx & 3; int ea, eb; moe_pair(T[128 + tile], ea, eb);
        u.pm = tile; u.pn = pn; u.a = hb + (size_t)tile * 256 * 1024; u.b = wd + ((size_t)ea * 1024 + pn * 256) * 512; u.b2 = wd + ((size_t)eb * 1024 + pn * 256) * 512; return true; }
    __device__ __forceinline__ void a_ready(const pg8::Unit& u) const {
        int t_ = threadIdx.x; asm volatile("" : "+v"(t_));
        if (t_ < 64) {
            const LAS int* T = (const LAS int*)((LAS unsigned char*)lds_raw + TBL_OFF);
            int ea, eb; moe_pair(T[128 + u.pm], ea, eb);
            const unsigned na = 16u * (unsigned)((T[560 + ea] + 255) >> 8), nb = 16u * (unsigned)((T[560 + eb] + 255) >> 8);
            unsigned polls = 0u;
            while ((unsigned)__builtin_amdgcn_readfirstlane(__hip_atomic_load(edone + ea * MOE_CS, __ATOMIC_RELAXED, __HIP_MEMORY_SCOPE_AGENT)) < na ||
                   (unsigned)__builtin_amdgcn_readfirstlane(__hip_atomic_load(edone + eb * MOE_CS, __ATOMIC_RELAXED, __HIP_MEMORY_SCOPE_AGENT)) < nb) {
                if ((++polls & 255u) == 0u) { if (__builtin_amdgcn_readfirstlane(__hip_atomic_load(tmo, __ATOMIC_RELAXED, __HIP_MEMORY_SCOPE_AGENT)) != 0u) break;
                    if (polls > (1u << 22)) { if (t_ == 0) __hip_atomic_store(tmo, 1u, __ATOMIC_RELAXED, __HIP_MEMORY_SCOPE_AGENT); break; } }
                __builtin_amdgcn_s_sleep(2); }
            __builtin_amdgcn_fence(__ATOMIC_ACQUIRE, "agent");
            asm volatile("s_waitcnt vmcnt(0)" ::: "memory");
        }
        asm volatile("" ::: "memory"); __builtin_amdgcn_s_barrier(); asm volatile("" ::: "memory");
    }
    __device__ __forceinline__ void done(const pg8::Unit&) const {} };
struct EpiMoeH {
    static constexpr bool PERM = true, AFTER_DRAIN = false;
    bf16* hb; const u32x4* rec;
    __device__ __forceinline__ void operator()(const pg8::f32x4 (&acc)[2][2][4][2], const pg8::Unit& u, int wr, int wc, int fr, int fq) const {
        { int t_ = threadIdx.x; asm volatile("" : "+v"(t_)); fr = t_ & 15; fq = (t_ >> 4) & 3; }
        const LAS int* T = (const LAS int*)((LAS unsigned char*)lds_raw + TBL_OFF);
        const int ex = T[608 + u.pm], vr0 = (u.pm - T[512 + ex]) * 256, nex = T[560 + ex];
#pragma unroll
        for (int ai = 0; ai < 2; ++ai) {
#pragma unroll
            for (int m = 0; m < 4; ++m) { const int rr = ai * 128 + wr * 64 + m * 16 + fr; const bool valid = vr0 + rr < nex;
                const u32x4 q = *(const u32x4*)((const char*)rec + (unsigned)(ex * 32768 + vr0 + rr) * 16u); const float w = __uint_as_float(q.y), rs = __uint_as_float(q.z);
                const int slot = (int)((q.w >> 15) & 1u); const unsigned row = (unsigned)T[valid ? (q.w >> 16) : 0u] * 256u + (q.w & 0x7fffu);
#pragma unroll
                for (int bj = 0; bj < 2; ++bj) { const int j0 = (u.pn & 1) * 128 + (bj * 128 + wc * 32 + 8 * fq) / 2;
                    pg8::f32x4 v0 = acc[ai][bj][m][0], v1 = acc[ai][bj][m][1];
#pragma unroll
                    for (int e = 0; e < 4; ++e) { v0[e] *= rs; v1[e] *= rs; }
                    const float h0 = v0[0] * __builtin_amdgcn_rcpf(1.f + __builtin_amdgcn_exp2f(-v0[0] * LOG2E)) * v0[1] * w, h1 = v0[2] * __builtin_amdgcn_rcpf(1.f + __builtin_amdgcn_exp2f(-v0[2] * LOG2E)) * v0[3] * w;
                    const float h2 = v1[0] * __builtin_amdgcn_rcpf(1.f + __builtin_amdgcn_exp2f(-v1[0] * LOG2E)) * v1[1] * w, h3 = v1[2] * __builtin_amdgcn_rcpf(1.f + __builtin_amdgcn_exp2f(-v1[2] * LOG2E)) * v1[3] * w;
                    const int jg = slot * 256 + j0;
                    if (valid) __hip_atomic_store((u64*)((char*)hb + (((row >> 4) * 32u + (unsigned)(jg >> 4)) * 256u + (row & 15u) * 16u + (unsigned)(jg & 15)) * 2u), (u64)pg8::cvt_pk_bf16(h0, h1) | ((u64)pg8::cvt_pk_bf16(h2, h3) << 32),
                                                  __ATOMIC_RELAXED, __HIP_MEMORY_SCOPE_AGENT); }
            }
            asm volatile("" ::: "memory"); }
    }
};
struct EpiMoeOut {
    static constexpr bool PERM = true, AFTER_DRAIN = false;
    bf16* x; const unsigned* rec;
    __device__ __forceinline__ void operator()(const pg8::f32x4 (&acc)[2][2][4][2], const pg8::Unit& u, int wr, int wc, int fr, int fq) const {
        { int t_ = threadIdx.x; asm volatile("" : "+v"(t_)); fr = t_ & 15; fq = (t_ >> 4) & 3; }
        bf16* xx = x; const unsigned* rt = rec; asm volatile("" : "+s"(xx), "+s"(rt));
        const LAS int* T = (const LAS int*)((LAS unsigned char*)lds_raw + TBL_OFF);
        const int cls = T[128 + u.pm], vr0 = (u.pm - T[cls]) * 256, ncls = T[384 + cls];
#pragma unroll
        for (int ai = 0; ai < 2; ++ai)
#pragma unroll
            for (int m = 0; m < 4; ++m) { const int rr = ai * 128 + wr * 64 + m * 16 + fr; int tok = -1; if (vr0 + rr < ncls) tok = (int)rt[(size_t)cls * 32768 + vr0 + rr];
                if (tok >= 0) { bf16* xr = xx + (size_t)tok * D_ + u.pn * 256 + wc * 32 + 8 * fq;
#pragma unroll
                    for (int bj = 0; bj < 2; ++bj) { u32x4* q = (u32x4*)(xr + bj * 128); *q = res_add8(*q, acc[ai][bj][m][0], acc[ai][bj][m][1]); } } }
    }
};

__device__ __forceinline__ void transpose_item(const float* W, int ldw, bf16* WT, int ldt, int r0, int rmul, int k0, LAS float* scr, int lane, const float* gk = nullptr) {
    f32x4 v[8];
#pragma unroll
    for (int i = 0; i < 8; ++i) v[i] = *(const f32x4*)(W + (size_t)(k0 + i * 8 + (lane >> 3)) * ldw + (lane & 7) * 4);
    if (gk) {
#pragma unroll
        for (int i = 0; i < 8; ++i) { const float gsc = gk[k0 + i * 8 + (lane >> 3)]; v[i].x *= gsc; v[i].y *= gsc; v[i].z *= gsc; v[i].w *= gsc; } }
#pragma unroll
    for (int i = 0; i < 8; ++i) { LAS float* d = scr + (i * 8 + (lane >> 3)) * 33 + (lane & 7) * 4; d[0] = v[i].x; d[1] = v[i].y; d[2] = v[i].z; d[3] = v[i].w; }
    asm volatile("s_waitcnt lgkmcnt(0)" ::: "memory");
    const int c = lane & 7;
#pragma unroll
    for (int j = 0; j < 4; ++j) { const int n = (lane >> 3) + 8 * j; const LAS float* sp = scr + (8 * c) * 33 + n;
        u32x4 o; o.x = pk2(sp[0 * 33], sp[1 * 33]); o.y = pk2(sp[2 * 33], sp[3 * 33]); o.z = pk2(sp[4 * 33], sp[5 * 33]); o.w = pk2(sp[6 * 33], sp[7 * 33]);
        *(u32x4*)(WT + (size_t)(r0 + rmul * n) * ldt + k0 + 8 * c) = o; }
    asm volatile("s_waitcnt lgkmcnt(0)" ::: "memory");
}
__device__ __forceinline__ void transpose_seg(const float* W, int ldw, int K, int sc0, int ncol, bf16* WT, int r0, int rmul, int item, LAS float* scr, int lane, const float* gk = nullptr) {
    const int nb = ncol / 32, kb = item / nb, cb = item % nb;
    transpose_item(W + sc0 + cb * 32, ldw, WT, K, r0 + rmul * cb * 32, rmul, kb * 64, scr, lane, gk);
}

typedef float f32x16 __attribute__((ext_vector_type(16)));
typedef short bf16x8v __attribute__((ext_vector_type(8)));
typedef short s16x4 __attribute__((ext_vector_type(4)));
typedef float f32x2_t __attribute__((ext_vector_type(2)));
typedef __bf16 bf16x2_t __attribute__((ext_vector_type(2)));
constexpr int A_KBUF = 10240, A_VBUF = 12288;
constexpr int A_KOFF = 0, A_VOFF = 2 * A_KBUF, A_BOFF = A_VOFF + 2 * A_VBUF, A_BTILE = 8 * 256, A_LDS_END = A_BOFF + 2 * A_BTILE;
__device__ __forceinline__ constexpr int crow0(int reg) { return (reg & 3) + 8 * (reg >> 2); }
__device__ __forceinline__ float swap_max(float m) { auto rr = __builtin_amdgcn_permlane32_swap(__float_as_uint(m), __float_as_uint(m), false, false); return fmaxf(__uint_as_float(rr[0]), __uint_as_float(rr[1])); }
__device__ __forceinline__ float swap_sum(float m) { auto rr = __builtin_amdgcn_permlane32_swap(__float_as_uint(m), __float_as_uint(m), false, false); return __uint_as_float(rr[0]) + __uint_as_float(rr[1]); }
__device__ __forceinline__ unsigned cvtpk(float lo, float hi) { f32x2_t v = {lo, hi}; bf16x2_t b = __builtin_convertvector(v, bf16x2_t); return __builtin_bit_cast(unsigned, b); }
__device__ __forceinline__ bf16x8v pack8(const f32x16& p, int b0) { u32x4 w; w.x = cvtpk(p[b0 + 0], p[b0 + 1]); w.y = cvtpk(p[b0 + 2], p[b0 + 3]); w.z = cvtpk(p[b0 + 4], p[b0 + 5]); w.w = cvtpk(p[b0 + 6], p[b0 + 7]); return __builtin_bit_cast(bf16x8v, w); }
__device__ __forceinline__ s16x4 tr_read(const LAS unsigned char* p) { typedef short v4i16_t __attribute__((ext_vector_type(4))); return __builtin_bit_cast(s16x4, __builtin_amdgcn_ds_read_tr16_b64_v4i16((LAS v4i16_t*)p)); }

template <int DQK>
__device__ __forceinline__ void attn_preload(const bf16* Kb0, const bf16* Kb1, const bf16* Vb, int j, int tid, u32x4& kreg, u32x4& vreg) {
    const bf16* ksrc;
    if (DQK == 64) ksrc = Kb0 + b64_off(tid >> 3, (tid & 7) * 8); else { const int mp = tid >> 8, tt = tid & 255; ksrc = (mp ? Kb1 : Kb0) + (tt >> 2) * 32 + (tt & 3) * 8; }
    const bf16* vsrc = Vb + b64_off(tid >> 3, (tid & 7) * 8);
    kreg = *(const u32x4*)(ksrc + (size_t)(j * 64) * DQK); vreg = *(const u32x4*)(vsrc + (size_t)(j * 64) * 64);
}
template <int DQK, int NMAP, bool FOX, bool SLC, bool PRE = false, bool NOMAX = false>
__device__ __forceinline__ void attn_core(LAS unsigned char* L, const bf16* Kb0, const bf16* Kb1, const bf16* Vb, const LAS float* cum, float cum_ref,
                                          const bf16x8v (&Qf)[NMAP][DQK / 16], u64 tilemask, int t_lane, int tw0, int win, float slope2, unsigned selw0, unsigned selw1,
                                          f32x16 (&O)[NMAP][2], float (&M)[NMAP], float (&Ls)[NMAP], int tid, bool started0 = false, int jpre = 0, u32x4 kpre = (u32x4){0u, 0u, 0u, 0u}, u32x4 vpre = (u32x4){0u, 0u, 0u, 0u}) {
    constexpr int KP = DQK * 2 + 16, VP = 192;
    const int lane = tid & 63, r = lane & 31, h = lane >> 5;
    int kdst; const bf16* ksrc;
    if (DQK == 64) { kdst = (tid >> 3) * KP + (tid & 7) * 16; ksrc = Kb0 + b64_off(tid >> 3, (tid & 7) * 8); }
    else { const int mp = tid >> 8, tt = tid & 255; kdst = mp * 5120 + (tt >> 2) * KP + (tt & 3) * 16; ksrc = (mp ? Kb1 : Kb0) + (tt >> 2) * 32 + (tt & 3) * 8; }
    const int vdst = (tid >> 3) * VP + (tid & 7) * 16; const bf16* vsrc = Vb + b64_off(tid >> 3, (tid & 7) * 8);
    const LAS unsigned char* kfrag = L + A_KOFF + r * KP + h * 16;
    const LAS unsigned char* vfrag = L + A_VOFF + (4 * h + ((lane & 15) >> 2)) * VP + (16 * ((lane >> 4) & 1) + 4 * (lane & 3)) * 2;
    u32x4 kreg, vreg; float breg = 0.f;
    u64 mk = tilemask;
    int j = PRE ? jpre : 63 - __builtin_clzll(mk); mk &= ~(1ull << j);
    { const int kv0 = j * 64; if (PRE) { kreg = kpre; vreg = vpre; } else { kreg = *(const u32x4*)(ksrc + (size_t)kv0 * DQK); vreg = *(const u32x4*)(vsrc + (size_t)kv0 * 64); } if (FOX) breg = (cum_ref - cum[kv0 + lane]) * LOG2E; }
    *(LAS u32x4*)(L + A_KOFF + kdst) = kreg; *(LAS u32x4*)(L + A_VOFF + vdst) = vreg; if (FOX) *(LAS float*)(L + A_BOFF + tid * 4) = breg;
    __syncthreads();
    int buf = 0; bool started = started0;
    float pdummy = 0.f; int idummy = 0; f32x16 dm0; for (int i = 0; i < 16; ++i) dm0[i] = 0.f;
    for (;;) {
        const bool more = mk != 0ull; int jn = 0;
        if (more) { jn = 63 - __builtin_clzll(mk); mk &= ~(1ull << jn); const int kv0 = jn * 64;
            kreg = *(const u32x4*)(ksrc + (size_t)kv0 * DQK); vreg = *(const u32x4*)(vsrc + (size_t)kv0 * 64); if (FOX) breg = (cum_ref - cum[kv0 + lane]) * LOG2E; }
        { const int kv0 = j * 64;
          bool wave_has = true; float selb = 0.f;
          if (SLC) { const bool mine = ((j < 32 ? (selw0 >> j) : (selw1 >> (j - 32))) & 1u) != 0u; selb = mine ? 0.f : -INFINITY; wave_has = __any(mine); }
          if (wave_has && !(kv0 > tw0 + 31) && !(tw0 - (kv0 + 63) >= win)) {
            const bool need_mask = (kv0 + 63 > tw0) || (tw0 + 31 - kv0 >= win);
            const int dl = t_lane - kv0 - 4 * h;
            bf16x8v pa[NMAP][4];
#pragma unroll
            for (int mp = 0; mp < NMAP; ++mp) {
                f32x16 p0, p1;
                if (FOX) { const LAS f32x4* bl = (const LAS f32x4*)(L + A_BOFF + buf * A_BTILE + (tid >> 6) * 256) + h; const float mm = NOMAX ? 0.f : M[mp];
#pragma unroll
                    for (int g4 = 0; g4 < 4; ++g4) { const f32x4 b0 = bl[2 * g4], b1 = bl[8 + 2 * g4];
                        p0[4 * g4 + 0] = b0.x - mm; p0[4 * g4 + 1] = b0.y - mm; p0[4 * g4 + 2] = b0.z - mm; p0[4 * g4 + 3] = b0.w - mm; p1[4 * g4 + 0] = b1.x - mm; p1[4 * g4 + 1] = b1.y - mm; p1[4 * g4 + 2] = b1.z - mm; p1[4 * g4 + 3] = b1.w - mm; } }
                else { const float base_l = (slope2 * (float)(kv0 + 4 * h - tw0) - (NOMAX ? 0.f : M[mp])) + selb, s8 = slope2 * 8.f, s32 = slope2 * 32.f;
                    p0[0] = base_l; p0[1] = p0[0] + slope2; p0[2] = p0[1] + slope2; p0[3] = p0[2] + slope2;
#pragma unroll
                    for (int reg = 4; reg < 16; ++reg) p0[reg] = p0[reg - 4] + s8;
#pragma unroll
                    for (int reg = 0; reg < 16; ++reg) p1[reg] = p0[reg] + s32; }
                const LAS unsigned char* kb = kfrag + buf * A_KBUF + (DQK == 32 ? mp * 5120 : 0);
#pragma unroll
                for (int s = 0; s < DQK / 16; ++s) { const bf16x8v kf0 = *(const LAS bf16x8v*)(kb + s * 32), kf1 = *(const LAS bf16x8v*)(kb + 32 * KP + s * 32);
#ifdef PROBE_X_LDSK
                    { const bf16x8v z0 = *(const volatile LAS bf16x8v*)(kb + s * 32), z1 = *(const volatile LAS bf16x8v*)(kb + 32 * KP + s * 32); idummy ^= z0[0] ^ z1[1]; }
#endif
#ifdef PROBE_X_MFMA
                    dm0 = __builtin_amdgcn_mfma_f32_32x32x16_bf16(kf0, Qf[mp][s], dm0, 0, 0, 0); dm0 = __builtin_amdgcn_mfma_f32_32x32x16_bf16(kf1, Qf[mp][s], dm0, 0, 0, 0);
#endif
                    p0 = __builtin_amdgcn_mfma_f32_32x32x16_bf16(kf0, Qf[mp][s], p0, 0, 0, 0); p1 = __builtin_amdgcn_mfma_f32_32x32x16_bf16(kf1, Qf[mp][s], p1, 0, 0, 0); }
                if (need_mask) {
#pragma unroll
                    for (int reg = 0; reg < 16; ++reg) { const int d0 = dl - crow0(reg), d1 = d0 - 32;
                        p0[reg] = (d0 >= 0 && d0 < win) ? p0[reg] : -INFINITY; p1[reg] = (d1 >= 0 && d1 < win) ? p1[reg] : -INFINITY; } }
                if (!NOMAX) {
                float mt = fmaxf(fmaxf(p0[0], p1[0]), fmaxf(p0[1], p1[1]));
#pragma unroll
                for (int reg = 2; reg < 16; reg += 2) mt = fmaxf(fmaxf(mt, fmaxf(fmaxf(p0[reg], p1[reg]), p0[reg + 1])), p1[reg + 1]);
                mt = swap_max(mt);
                if (!started || __any(mt > 8.f)) {
                    const float d = (mt > -1e30f) ? (started ? fmaxf(mt, 0.f) : mt) : 0.f, alpha = __builtin_amdgcn_exp2f(-d);
                    O[mp][0] *= alpha; O[mp][1] *= alpha; Ls[mp] *= alpha; M[mp] += d;
#pragma unroll
                    for (int reg = 0; reg < 16; ++reg) { p0[reg] -= d; p1[reg] -= d; } } }
                float rs = 0.f;
#ifdef PROBE_X_EXP
#pragma unroll
                for (int reg = 0; reg < 16; ++reg) { pdummy += __builtin_amdgcn_exp2f(p0[reg] - 1.f) + __builtin_amdgcn_exp2f(p1[reg] - 1.f); }
#endif
#pragma unroll
                for (int reg = 0; reg < 16; ++reg) { p0[reg] = __builtin_amdgcn_exp2f(p0[reg]); p1[reg] = __builtin_amdgcn_exp2f(p1[reg]); rs += p0[reg] + p1[reg]; }
                Ls[mp] += rs;
                pa[mp][0] = pack8(p0, 0); pa[mp][1] = pack8(p0, 8); pa[mp][2] = pack8(p1, 0); pa[mp][3] = pack8(p1, 8);
            }
            started = true;
            const LAS unsigned char* vb = vfrag + buf * A_VBUF;
#pragma unroll
            for (int db = 0; db < 2; ++db)
#pragma unroll
                for (int ks = 0; ks < 4; ++ks) { const s16x4 lo = tr_read(vb + ks * (16 * VP) + db * 64), hi = tr_read(vb + ks * (16 * VP) + db * 64 + 8 * VP);
                    const bf16x8v vf = {lo[0], lo[1], lo[2], lo[3], hi[0], hi[1], hi[2], hi[3]};
#pragma unroll
                    for (int mp = 0; mp < NMAP; ++mp) O[mp][db] = __builtin_amdgcn_mfma_f32_32x32x16_bf16(vf, pa[mp][ks], O[mp][db], 0, 0, 0); }
          } }
        if (more) { *(LAS u32x4*)(L + A_KOFF + (buf ^ 1) * A_KBUF + kdst) = kreg; *(LAS u32x4*)(L + A_VOFF + (buf ^ 1) * A_VBUF + vdst) = vreg; if (FOX) *(LAS float*)(L + A_BOFF + (buf ^ 1) * A_BTILE + tid * 4) = breg; }
#ifdef PROBE_X_BAR
        __syncthreads();
#endif
        __syncthreads();
        if (!more) break;
        j = jn; buf ^= 1;
    }
    if (pdummy == 123.456f || idummy == 0x7fffabcd || dm0[3] == 98765.4321f) Ls[0] += 1e-30f;
}
#ifndef AC2_MODE
#define AC2_MODE 0
#endif
#ifndef AC2_INIT_VALU
#define AC2_INIT_VALU 24
#endif
template <bool FOX, bool SLC>
__device__ __forceinline__ void attn_core2(LAS unsigned char* L, const bf16* Kb0, const bf16* Vb, const LAS float* cum, float cum_ref,
                                           const bf16x8v (&Qf)[4], u64 tilemask, int t_lane, int tw0, int win, float slope2, unsigned selw0, unsigned selw1,
                                           f32x16 (&O)[2], float& M, float& Ls, int tid) {
    constexpr int KP = 144, VP = 192;
    const int lane = tid & 63, r = lane & 31, h = lane >> 5;
    const int kdst = (tid >> 3) * KP + (tid & 7) * 16; const bf16* ksrc = Kb0 + b64_off(tid >> 3, (tid & 7) * 8);
    const int vdst = (tid >> 3) * VP + (tid & 7) * 16; const bf16* vsrc = Vb + b64_off(tid >> 3, (tid & 7) * 8);
    const LAS unsigned char* kfrag = L + A_KOFF + r * KP + h * 16;
    const LAS unsigned char* vfrag = L + A_VOFF + (4 * h + ((lane & 15) >> 2)) * VP + (16 * ((lane >> 4) & 1) + 4 * (lane & 3)) * 2;
#define AC2_ACTIVE(jj) (!((jj) * 64 > tw0 + 31) && !(tw0 - ((jj) * 64 + 63) >= win))
#define AC2_INIT(jj, kslot, q0, q1) do { const int kv0_ = (jj) * 64; \
        if (FOX) { const LAS f32x4* bl = (const LAS f32x4*)(L + A_BOFF + (kslot) * 256) + h; const float mm = M; \
            _Pragma("unroll") for (int g4 = 0; g4 < 4; ++g4) { const f32x4 b0 = bl[2 * g4], b1 = bl[8 + 2 * g4]; \
                q0[4 * g4 + 0] = b0.x - mm; q0[4 * g4 + 1] = b0.y - mm; q0[4 * g4 + 2] = b0.z - mm; q0[4 * g4 + 3] = b0.w - mm; q1[4 * g4 + 0] = b1.x - mm; q1[4 * g4 + 1] = b1.y - mm; q1[4 * g4 + 2] = b1.z - mm; q1[4 * g4 + 3] = b1.w - mm; } } \
        else { float selb = 0.f; if (SLC) selb = ((((jj) < 32) ? (selw0 >> (jj)) : (selw1 >> ((jj) - 32))) & 1u) ? 0.f : -INFINITY; \
            const float base_l = (slope2 * (float)(kv0_ + 4 * h - tw0) - M) + selb, s8 = slope2 * 8.f, s32 = slope2 * 32.f; \
            q0[0] = base_l; q0[1] = q0[0] + slope2; q0[2] = q0[1] + slope2; q0[3] = q0[2] + slope2; \
            _Pragma("unroll") for (int reg = 4; reg < 16; ++reg) q0[reg] = q0[reg - 4] + s8; \
            _Pragma("unroll") for (int reg = 0; reg < 16; ++reg) q1[reg] = q0[reg] + s32; } } while (0)
#define AC2_QK(jj, kslot) do { AC2_INIT(jj, kslot, p0, p1); \
        const LAS unsigned char* kb_ = kfrag + (kslot) * A_KBUF; \
        _Pragma("unroll") for (int s_ = 0; s_ < 4; ++s_) { const bf16x8v kf0 = *(const LAS bf16x8v*)(kb_ + s_ * 32), kf1 = *(const LAS bf16x8v*)(kb_ + 32 * KP + s_ * 32); \
            p0 = __builtin_amdgcn_mfma_f32_32x32x16_bf16(kf0, Qf[s_], p0, 0, 0, 0); p1 = __builtin_amdgcn_mfma_f32_32x32x16_bf16(kf1, Qf[s_], p1, 0, 0, 0); } } while (0)
    u32x4 kreg, vreg; float breg = 0.f;
    u64 mk = tilemask;
    int j = 63 - __builtin_clzll(mk); mk &= ~(1ull << j);
    int jn = -1; if (mk) { jn = 63 - __builtin_clzll(mk); mk &= ~(1ull << jn); }
    { kreg = *(const u32x4*)(ksrc + (size_t)j * 64 * 64); vreg = *(const u32x4*)(vsrc + (size_t)j * 64 * 64); if (FOX && tid < 64) breg = (cum_ref - cum[j * 64 + tid]) * LOG2E;
      *(LAS u32x4*)(L + A_KOFF + kdst) = kreg; *(LAS u32x4*)(L + A_VOFF + vdst) = vreg; if (FOX && tid < 64) *(LAS float*)(L + A_BOFF + tid * 4) = breg;
      if (jn >= 0) { kreg = *(const u32x4*)(ksrc + (size_t)jn * 64 * 64); if (FOX && tid < 64) breg = (cum_ref - cum[jn * 64 + tid]) * LOG2E;
          *(LAS u32x4*)(L + A_KOFF + A_KBUF + kdst) = kreg; if (FOX && tid < 64) *(LAS float*)(L + A_BOFF + 256 + tid * 4) = breg; } }
    __syncthreads();
    f32x16 p0, p1;
    bool started = false;
    int ks = 0, vs = 0;
    if (AC2_ACTIVE(j)) AC2_QK(j, 0);
    for (;;) {
        int jnn = -1; if (mk) { jnn = 63 - __builtin_clzll(mk); mk &= ~(1ull << jnn); }
        if (jnn >= 0) { kreg = *(const u32x4*)(ksrc + (size_t)jnn * 64 * 64); if (FOX && tid < 64) breg = (cum_ref - cum[jnn * 64 + tid]) * LOG2E; }
        if (jn >= 0) vreg = *(const u32x4*)(vsrc + (size_t)jn * 64 * 64);
        const bool act = AC2_ACTIVE(j), actn = jn >= 0 && AC2_ACTIVE(jn);
        if (act) {
            const int kv0 = j * 64;
            if ((kv0 + 63 > tw0) || (tw0 + 31 - kv0 >= win)) { const int dl = t_lane - kv0 - 4 * h;
#pragma unroll
                for (int reg = 0; reg < 16; ++reg) { const int d0 = dl - crow0(reg), d1 = d0 - 32;
                    p0[reg] = (d0 >= 0 && d0 < win) ? p0[reg] : -INFINITY; p1[reg] = (d1 >= 0 && d1 < win) ? p1[reg] : -INFINITY; } }
            float mt = fmaxf(fmaxf(p0[0], p1[0]), fmaxf(p0[1], p1[1]));
#pragma unroll
            for (int reg = 2; reg < 16; reg += 2) mt = fmaxf(fmaxf(mt, fmaxf(fmaxf(p0[reg], p1[reg]), p0[reg + 1])), p1[reg + 1]);
            mt = swap_max(mt);
            if (!started || __any(mt > 8.f)) {
                const float d = (mt > -1e30f) ? (started ? fmaxf(mt, 0.f) : mt) : 0.f, alpha = __builtin_amdgcn_exp2f(-d);
                O[0] *= alpha; O[1] *= alpha; Ls *= alpha; M += d;
#pragma unroll
                for (int reg = 0; reg < 16; ++reg) { p0[reg] -= d; p1[reg] -= d; } }
            started = true;
#if AC2_MODE == 1
            {
                const int jq = jn >= 0 ? jn : 0;
                float rs = 0.f;
#pragma unroll
                for (int reg = 0; reg < 16; ++reg) { p0[reg] = __builtin_amdgcn_exp2f(p0[reg]); p1[reg] = __builtin_amdgcn_exp2f(p1[reg]); rs += p0[reg] + p1[reg]; }
                Ls += rs;
                const bf16x8v pa0 = pack8(p0, 0), pa1 = pack8(p0, 8), pa2 = pack8(p1, 0), pa3 = pack8(p1, 8);
                AC2_QK(jq, ks ^ 1);
                const LAS unsigned char* vb = vfrag + vs * A_VBUF;
#pragma unroll
                for (int db = 0; db < 2; ++db)
#pragma unroll
                    for (int kq = 0; kq < 4; ++kq) { const s16x4 lo = tr_read(vb + kq * (16 * VP) + db * 64), hi = tr_read(vb + kq * (16 * VP) + db * 64 + 8 * VP);
                        const bf16x8v vf = {lo[0], lo[1], lo[2], lo[3], hi[0], hi[1], hi[2], hi[3]};
                        O[db] = __builtin_amdgcn_mfma_f32_32x32x16_bf16(vf, kq == 0 ? pa0 : kq == 1 ? pa1 : kq == 2 ? pa2 : pa3, O[db], 0, 0, 0); }
            }
#else
            {
                const int jq = jn >= 0 ? jn : 0;
                f32x16 n0, n1;
                AC2_INIT(jq, ks ^ 1, n0, n1);
                const LAS unsigned char* kb_ = kfrag + (ks ^ 1) * A_KBUF;
                bf16x8v kf[8];
#pragma unroll
                for (int s_ = 0; s_ < 4; ++s_) { kf[2 * s_] = *(const LAS bf16x8v*)(kb_ + s_ * 32); kf[2 * s_ + 1] = *(const LAS bf16x8v*)(kb_ + 32 * KP + s_ * 32); }
                const LAS unsigned char* vb = vfrag + vs * A_VBUF;
                __builtin_amdgcn_sched_barrier(0);
                float ra = 0.f, rb = 0.f; unsigned w[16];
#define AC2_PINF(x) asm volatile("" : "+v"(x))
#define AC2_QGAP(i) do { if ((i) & 1) n1 = __builtin_amdgcn_mfma_f32_32x32x16_bf16(kf[i], Qf[(i) >> 1], n1, 0, 0, 0); else n0 = __builtin_amdgcn_mfma_f32_32x32x16_bf16(kf[i], Qf[(i) >> 1], n0, 0, 0, 0); \
                    float e0 = __builtin_amdgcn_exp2f(p0[2 * (i)]), e1 = __builtin_amdgcn_exp2f(p0[2 * (i) + 1]), e2 = __builtin_amdgcn_exp2f(p1[2 * (i)]), e3 = __builtin_amdgcn_exp2f(p1[2 * (i) + 1]); \
                    ra += e0 + e1; rb += e2 + e3; \
                    AC2_PINF(e0); AC2_PINF(e1); AC2_PINF(e2); AC2_PINF(e3); AC2_PINF(ra); AC2_PINF(rb); \
                    p0[2 * (i)] = e0; p0[2 * (i) + 1] = e1; p1[2 * (i)] = e2; p1[2 * (i) + 1] = e3; \
                    if ((i) >= 4) { w[2 * ((i) - 4)] = cvtpk(p0[4 * ((i) - 4)], p0[4 * ((i) - 4) + 1]); w[2 * ((i) - 4) + 1] = cvtpk(p0[4 * ((i) - 4) + 2], p0[4 * ((i) - 4) + 3]); AC2_PINF(w[2 * ((i) - 4)]); AC2_PINF(w[2 * ((i) - 4) + 1]); } \
                    if ((i) == 6) { vl[0] = tr_read(vb); vh[0] = tr_read(vb + 8 * VP); } \
                    if ((i) == 7) { vl[1] = tr_read(vb + 64); vh[1] = tr_read(vb + 64 + 8 * VP); } \
                    __builtin_amdgcn_sched_barrier(0); } while (0)
                s16x4 vl[2], vh[2];
                AC2_QGAP(0); AC2_QGAP(1); AC2_QGAP(2); AC2_QGAP(3); AC2_QGAP(4); AC2_QGAP(5); AC2_QGAP(6); AC2_QGAP(7);
                Ls += ra + rb;
#define AC2_PA(kq) __builtin_bit_cast(bf16x8v, (u32x4){w[4 * (kq)], w[4 * (kq) + 1], w[4 * (kq) + 2], w[4 * (kq) + 3]})
#define AC2_PGAP(g) do { const int kq_ = (g) >> 1, db_ = (g) & 1; const bf16x8v vf = {vl[(g) & 1][0], vl[(g) & 1][1], vl[(g) & 1][2], vl[(g) & 1][3], vh[(g) & 1][0], vh[(g) & 1][1], vh[(g) & 1][2], vh[(g) & 1][3]}; \
                    if ((g) < 6) { const int kq2 = ((g) + 2) >> 1, db2 = (g) & 1; vl[(g) & 1] = tr_read(vb + kq2 * (16 * VP) + db2 * 64); vh[(g) & 1] = tr_read(vb + kq2 * (16 * VP) + db2 * 64 + 8 * VP); } \
                    O[db_] = __builtin_amdgcn_mfma_f32_32x32x16_bf16(vf, AC2_PA(kq_), O[db_], 0, 0, 0); \
                    if ((g) < 4) { w[8 + 2 * (g)] = cvtpk(p1[4 * (g)], p1[4 * (g) + 1]); w[8 + 2 * (g) + 1] = cvtpk(p1[4 * (g) + 2], p1[4 * (g) + 3]); AC2_PINF(w[8 + 2 * (g)]); AC2_PINF(w[8 + 2 * (g) + 1]); } \
                    __builtin_amdgcn_sched_barrier(0); } while (0)
                AC2_PGAP(0); AC2_PGAP(1); AC2_PGAP(2); AC2_PGAP(3); AC2_PGAP(4); AC2_PGAP(5); AC2_PGAP(6); AC2_PGAP(7);
#undef AC2_PGAP
#undef AC2_PA
#undef AC2_QGAP
#undef AC2_PINF
                p0 = n0; p1 = n1;
            }
#endif
        } else if (actn) AC2_QK(jn, ks ^ 1);
        if (jnn >= 0) { *(LAS u32x4*)(L + A_KOFF + ks * A_KBUF + kdst) = kreg; if (FOX && tid < 64) *(LAS float*)(L + A_BOFF + ks * 256 + tid * 4) = breg; }
        if (jn >= 0) *(LAS u32x4*)(L + A_VOFF + (vs ^ 1) * A_VBUF + vdst) = vreg;
        __syncthreads();
        if (jn < 0) break;
        j = jn; jn = jnn; ks ^= 1; vs ^= 1;
    }
#undef AC2_QK
#undef AC2_INIT
#undef AC2_ACTIVE
}
__device__ __forceinline__ size_t mix_off(size_t n, int c, int W) { return ((n >> 5) * (size_t)(W / 8) + (size_t)(c >> 3)) * 256 + (n & 31) * 8 + (c & 7); }
#define ATTN_FOR_CHUNKS(db, g4) _Pragma("unroll") for (int db = 0; db < 2; ++db) _Pragma("unroll") for (int g4 = 0; g4 < 4; ++g4)

__device__ __forceinline__ void unpack8(const u32x4 w, float (&f)[8]) { f[0] = __uint_as_float(w.x << 16); f[1] = __uint_as_float(w.x & 0xffff0000u); f[2] = __uint_as_float(w.y << 16); f[3] = __uint_as_float(w.y & 0xffff0000u);
    f[4] = __uint_as_float(w.z << 16); f[5] = __uint_as_float(w.z & 0xffff0000u); f[6] = __uint_as_float(w.w << 16); f[7] = __uint_as_float(w.w & 0xffff0000u); }
__device__ __forceinline__ void ph_norm_bf16_from_bf16(const Ctx& c, const bf16* x, const float* g, bf16* out) {
    constexpr int RB = 4; float gg[2][8];
#pragma unroll
    for (int j = 0; j < 2; ++j) { const f32x4 a = ((const f32x4*)g)[2 * c.lane + 128 * j], b2 = ((const f32x4*)g)[2 * c.lane + 128 * j + 1]; gg[j][0] = a.x; gg[j][1] = a.y; gg[j][2] = a.z; gg[j][3] = a.w; gg[j][4] = b2.x; gg[j][5] = b2.y; gg[j][6] = b2.z; gg[j][7] = b2.w; }
    for (int row0 = c.gw * RB; row0 < NT; row0 += c.ngw * RB) {
        u32x4 v[RB][2];
#pragma unroll
        for (int q = 0; q < RB; ++q)
#pragma unroll
            for (int j = 0; j < 2; ++j) v[q][j] = ((const u32x4*)(x + (size_t)(row0 + q) * D_))[c.lane + 64 * j];
#pragma unroll
        for (int q = 0; q < RB; ++q) { float f[2][8]; float ss = 0.f;
#pragma unroll
            for (int j = 0; j < 2; ++j) { unpack8(v[q][j], f[j]);
#pragma unroll
                for (int e = 0; e < 8; ++e) ss = fmaf(f[j][e], f[j][e], ss); }
            const float r = rsqrtf(wave_sum_l(ss, c.lane) * (1.f / D_) + EPS);
#pragma unroll
            for (int j = 0; j < 2; ++j) { u32x4 o; o.x = pk2(f[j][0] * r * gg[j][0], f[j][1] * r * gg[j][1]); o.y = pk2(f[j][2] * r * gg[j][2], f[j][3] * r * gg[j][3]); o.z = pk2(f[j][4] * r * gg[j][4], f[j][5] * r * gg[j][5]); o.w = pk2(f[j][6] * r * gg[j][6], f[j][7] * r * gg[j][7]);
                ((u32x4*)(out + (size_t)(row0 + q) * D_))[c.lane + 64 * j] = o; } }
    }
}
__device__ __forceinline__ void ph_norm_final_from_bf16(const Ctx& c, const bf16* x, const float* g, float* out) {
    constexpr int RB = 4; float gg[2][8];
#pragma unroll
    for (int j = 0; j < 2; ++j) { const f32x4 a = ((const f32x4*)g)[2 * c.lane + 128 * j], b2 = ((const f32x4*)g)[2 * c.lane + 128 * j + 1]; gg[j][0] = a.x; gg[j][1] = a.y; gg[j][2] = a.z; gg[j][3] = a.w; gg[j][4] = b2.x; gg[j][5] = b2.y; gg[j][6] = b2.z; gg[j][7] = b2.w; }
    for (int row0 = c.gw * RB; row0 < NT; row0 += c.ngw * RB) {
        u32x4 v[RB][2];
#pragma unroll
        for (int q = 0; q < RB; ++q)
#pragma unroll
            for (int j = 0; j < 2; ++j) v[q][j] = ((const u32x4*)(x + (size_t)(row0 + q) * D_))[c.lane + 64 * j];
#pragma unroll
        for (int q = 0; q < RB; ++q) { float f[2][8]; float ss = 0.f;
#pragma unroll
            for (int j = 0; j < 2; ++j) { unpack8(v[q][j], f[j]);
#pragma unroll
                for (int e = 0; e < 8; ++e) ss = fmaf(f[j][e], f[j][e], ss); }
            const float r = rsqrtf(wave_sum_l(ss, c.lane) * (1.f / D_) + EPS);
#pragma unroll
            for (int j = 0; j < 2; ++j) { f32x4* o = (f32x4*)(out + (size_t)(row0 + q) * D_) + 2 * c.lane + 128 * j;
                o[0] = (f32x4){f[j][0] * r * gg[j][0], f[j][1] * r * gg[j][1], f[j][2] * r * gg[j][2], f[j][3] * r * gg[j][3]}; o[1] = (f32x4){f[j][4] * r * gg[j][4], f[j][5] * r * gg[j][5], f[j][6] * r * gg[j][6], f[j][7] * r * gg[j][7]}; } }
    }
}
__device__ __forceinline__ void ph_norm_bf16(const Ctx& c, const float* x, const float* g, bf16* out, bf16* raw) {
    constexpr int RB = 4;
    f32x4 gg[4];
#pragma unroll
    for (int j = 0; j < 4; ++j) gg[j] = ((const f32x4*)g)[c.lane + 64 * j];
    for (int row0 = c.gw * RB; row0 < NT; row0 += c.ngw * RB) {
        f32x4 v[RB][4];
#pragma unroll
        for (int q = 0; q < RB; ++q)
#pragma unroll
            for (int j = 0; j < 4; ++j) v[q][j] = ((const f32x4*)(x + (size_t)(row0 + q) * D_))[c.lane + 64 * j];
#pragma unroll
        for (int q = 0; q < RB; ++q) { float ss = 0.f;
#pragma unroll
            for (int j = 0; j < 4; ++j) ss += v[q][j].x * v[q][j].x + v[q][j].y * v[q][j].y + v[q][j].z * v[q][j].z + v[q][j].w * v[q][j].w;
            const float r = rsqrtf(wave_sum_l(ss, c.lane) * (1.f / D_) + EPS);
            u64* o8 = (u64*)(out + (size_t)(row0 + q) * D_) + c.lane; u64* r8 = (u64*)(raw + (size_t)(row0 + q) * D_) + c.lane;
#pragma unroll
            for (int j = 0; j < 4; ++j) { o8[64 * j] = (u64)pk2(v[q][j].x * r * gg[j].x, v[q][j].y * r * gg[j].y) | ((u64)pk2(v[q][j].z * r * gg[j].z, v[q][j].w * r * gg[j].w) << 32);
                r8[64 * j] = (u64)pk2(v[q][j].x, v[q][j].y) | ((u64)pk2(v[q][j].z, v[q][j].w) << 32); } }
    }
}
__device__ __forceinline__ void ph_norm_final(const Ctx& c, float* x, const float* g) {
    constexpr int RB = 4;
    f32x4 gg[4];
#pragma unroll
    for (int j = 0; j < 4; ++j) gg[j] = ((const f32x4*)g)[c.lane + 64 * j];
    for (int row0 = c.gw * RB; row0 < NT; row0 += c.ngw * RB) {
        f32x4 v[RB][4];
#pragma unroll
        for (int q = 0; q < RB; ++q)
#pragma unroll
            for (int j = 0; j < 4; ++j) v[q][j] = ((const f32x4*)(x + (size_t)(row0 + q) * D_))[c.lane + 64 * j];
#pragma unroll
        for (int q = 0; q < RB; ++q) { float ss = 0.f;
#pragma unroll
            for (int j = 0; j < 4; ++j) ss += v[q][j].x * v[q][j].x + v[q][j].y * v[q][j].y + v[q][j].z * v[q][j].z + v[q][j].w * v[q][j].w;
            const float r = rsqrtf(wave_sum_l(ss, c.lane) * (1.f / D_) + EPS);
            f32x4* xr = (f32x4*)(x + (size_t)(row0 + q) * D_) + c.lane;
#pragma unroll
            for (int j = 0; j < 4; ++j) xr[64 * j] = v[q][j] * r * gg[j]; }
    }
}

template <class AF, class EF>
__device__ __forceinline__ void naive_gemm(const Ctx& c, int M, int N, int K, AF af, const float* W, int ldb, EF ef) {
    LAS float* As = (LAS float*)c.lds;
    LAS float* Bs = As + 16 * 132;
    const int tm = (M + 127) / 128, tn = (N + 127) / 128, ntile = tm * tn;
    const int ty = c.tid >> 4, tx = c.tid & 15;
    for (int tile = c.bid; tile < ntile; tile += c.G) {
        const int m0 = (tile / tn) * 128, n0 = (tile % tn) * 128;
        float acc[4][8];
#pragma unroll
        for (int i = 0; i < 4; ++i)
#pragma unroll
            for (int j = 0; j < 8; ++j) acc[i][j] = 0.f;
        for (int k0 = 0; k0 < K; k0 += 16) {
            __syncthreads();
#pragma unroll
            for (int i = 0; i < 4; ++i) { const int e = c.tid + i * 512, r = e >> 4, kk = e & 15; const int row = m0 + r;
                As[kk * 132 + r] = (row < M) ? af(row, k0 + kk) : 0.f; }
#pragma unroll
            for (int i = 0; i < 4; ++i) { const int e = c.tid + i * 512, kk = e >> 7, cc = e & 127; const int col = n0 + cc;
                Bs[kk * 132 + cc] = (col < N) ? W[(size_t)(k0 + kk) * ldb + col] : 0.f; }
            __syncthreads();
#pragma unroll 2
            for (int kk = 0; kk < 16; ++kk) {
                float a[4], b[8];
#pragma unroll
                for (int i = 0; i < 4; ++i) a[i] = As[kk * 132 + ty * 4 + i];
#pragma unroll
                for (int j = 0; j < 8; ++j) b[j] = Bs[kk * 132 + tx * 8 + j];
#pragma unroll
                for (int i = 0; i < 4; ++i)
#pragma unroll
                    for (int j = 0; j < 8; ++j) acc[i][j] = fmaf(a[i], b[j], acc[i][j]);
            }
        }
        LAS float* Cs = Bs + 16 * 132;
        __syncthreads();
#pragma unroll
        for (int i = 0; i < 4; ++i)
#pragma unroll
            for (int j = 0; j < 8; ++j) Cs[(ty * 4 + i) * 129 + tx * 8 + j] = acc[i][j];
        __syncthreads();
#pragma unroll 1
        for (int e = c.tid; e < 128 * 128; e += NTHREADS) { const int r = e >> 7, cc = e & 127, row = m0 + r, col = n0 + cc; if (row < M && col < N) ef(row, col, Cs[r * 129 + cc]); }
    }
    __syncthreads();
}

struct InProjOut { bf16* qn; bf16* kv6; bf16* fqkv; bf16* dqk; bf16* dv; float* gate; float* fl; const float* b_gate; const float* b_fgt; };
__device__ __forceinline__ void inproj_store(const InProjOut& o, int n, int col, float v) {
    const int b = n / T_, t = n % T_;
    if (col < C_KV6) { const int h = col >> 6, d = col & 63; o.qn[((size_t)(b * 8 + h) * T_ + t) * 64 + d] = (bf16)f2bf(v * (0.125f * LOG2E)); }
    else if (col < C_GATE) { const int cc = col - C_KV6, idx = cc >> 7, g = (cc >> 6) & 1, d = cc & 63;
        ((bf16*)((unsigned char*)o.kv6 + idx * KV6_STRIDE))[((size_t)(b * 2 + g) * T_ + t) * 64 + d] = (bf16)f2bf(v); }
    else if (col < C_FQ) { const int j = col - C_GATE; o.gate[(size_t)n * 24 + j] = sigmoidf_(v + o.b_gate[j]); }
    else if (col < C_FF) { const int cc = col - C_FQ, idx = cc >> 8, h = (cc >> 6) & 3, d = cc & 63;
        o.fqkv[(size_t)idx * (8 * MiB) + ((size_t)(b * 4 + h) * T_ + t) * 64 + d] = (bf16)f2bf(idx == 0 ? v * (0.125f * LOG2E) : v); }
    else if (col < C_DQ) { const int h = col - C_FF; o.fl[(size_t)(b * 4 + h) * T_ + t] = log_sigmoidf_(v + o.b_fgt[h]); }
    else if (col < C_DV) { const int cc = col - C_DQ, idx = cc >> 8, h = (cc >> 6) & 3, i = (cc >> 5) & 1, d = cc & 31;
        o.dqk[(size_t)idx * (8 * MiB) + ((size_t)((b * 4 + h) * 2 + i) * T_ + t) * 32 + d] = (bf16)f2bf(idx == 0 ? v * (0.17677669529663687f * LOG2E) : v); }
    else { const int cc = col - C_DV, h = cc >> 6, d = cc & 63; o.dv[((size_t)(b * 4 + h) * T_ + t) * 64 + d] = (bf16)f2bf(v); }
}

__device__ __forceinline__ void ph_cumsum(const Ctx& c, float* fl) {
    for (int s = c.gw; s < B_ * 4; s += c.ngw) {
        float* p = fl + (size_t)s * T_; float carry = 0.f;
        for (int t0 = 0; t0 < T_; t0 += 64) {
            float v = p[t0 + c.lane];
#pragma unroll
            for (int o = 1; o < 64; o <<= 1) { const float u = __shfl_up(v, o); if (c.lane >= o) v += u; }
            v += carry; p[t0 + c.lane] = v; carry = __shfl(v, 63);
        }
    }
}

template <int DQK>
__device__ __forceinline__ float naive_attn_row(const bf16* q, const bf16* K, const bf16* V, int t, u64 mask, float slope2, const float* cum, int win, int lane) {
    float qv[DQK];
    { const u32x4* q4 = (const u32x4*)q;
#pragma unroll
      for (int i = 0; i < DQK / 8; ++i) { const u32x4 w = q4[i];
          qv[8 * i + 0] = __uint_as_float(w.x << 16); qv[8 * i + 1] = __uint_as_float(w.x & 0xffff0000u);
          qv[8 * i + 2] = __uint_as_float(w.y << 16); qv[8 * i + 3] = __uint_as_float(w.y & 0xffff0000u);
          qv[8 * i + 4] = __uint_as_float(w.z << 16); qv[8 * i + 5] = __uint_as_float(w.z & 0xffff0000u);
          qv[8 * i + 6] = __uint_as_float(w.w << 16); qv[8 * i + 7] = __uint_as_float(w.w & 0xffff0000u); } }
    const float cumt = cum ? cum[t] : 0.f;
    float m = -INFINITY, l = 0.f, o = 0.f;
    while (mask) {
        const int j = __builtin_ctzll(mask); mask &= mask - 1;
        const int kpos = 64 * j + lane; const int dist = t - kpos;
        const bool valid = dist >= 0 && dist < win;
        float s = 0.f;
        { const u32x4* k4 = (const u32x4*)(K + (size_t)kpos * DQK);
#pragma unroll
          for (int i = 0; i < DQK / 8; ++i) { const u32x4 w = k4[i];
              s = fmaf(qv[8 * i + 0], __uint_as_float(w.x << 16), s); s = fmaf(qv[8 * i + 1], __uint_as_float(w.x & 0xffff0000u), s);
              s = fmaf(qv[8 * i + 2], __uint_as_float(w.y << 16), s); s = fmaf(qv[8 * i + 3], __uint_as_float(w.y & 0xffff0000u), s);
              s = fmaf(qv[8 * i + 4], __uint_as_float(w.z << 16), s); s = fmaf(qv[8 * i + 5], __uint_as_float(w.z & 0xffff0000u), s);
              s = fmaf(qv[8 * i + 6], __uint_as_float(w.w << 16), s); s = fmaf(qv[8 * i + 7], __uint_as_float(w.w & 0xffff0000u), s); } }
        s -= slope2 * (float)dist;
        if (cum) s += (cumt - cum[kpos]) * LOG2E;
        s = valid ? s : -INFINITY;
        const float mb = wave_max(s);
        if (mb == -INFINITY) continue;
        const float mn = fmaxf(m, mb), alpha = exp2f(m - mn);
        const float p = valid ? exp2f(s - mn) : 0.f;
        l = l * alpha + wave_sum(p); o *= alpha; m = mn;
        const bf16* vb = V + (size_t)(64 * j) * 64 + lane;
#pragma unroll 8
        for (int k = 0; k < 64; ++k) o = fmaf(__shfl(p, k), bf2f(vb[(size_t)k * 64]), o);
    }
    return l > 0.f ? o / l : 0.f;
}

__device__ __forceinline__ void ph_cmp_attn(const Ctx& c, const bf16* qn, const bf16* kcmp, const bf16* vcmp, const float* gate, u64* sel, bf16* ocmp) {
    LAS float* pl = (LAS float*)(c.lds) + c.wave * 256;
    const int lane = c.lane;
    for (int it = c.gw; it < B_ * 2 * T_; it += c.ngw) {
        const int t = it % T_, bg = it / T_, b = bg >> 1, g = bg & 1;
        const int nvis = (t >= 31) ? ((t - 31) >> 4) + 1 : 0;
        const bf16* kc = kcmp + (size_t)bg * 256 * 64; const bf16* vc = vcmp + (size_t)bg * 256 * 64;
        float imp = 0.f;
        for (int hg = 0; hg < 4; ++hg) {
            const int h = g * 4 + hg; const float slope2 = alibi_slope(h + 1, 8) * LOG2E;
            const bf16* q = qn + ((size_t)(b * 8 + h) * T_ + t) * 64;
            float qv[64];
            { const u32x4* q4 = (const u32x4*)q;
#pragma unroll
              for (int i = 0; i < 8; ++i) { const u32x4 w = q4[i];
                  qv[8 * i + 0] = __uint_as_float(w.x << 16); qv[8 * i + 1] = __uint_as_float(w.x & 0xffff0000u);
                  qv[8 * i + 2] = __uint_as_float(w.y << 16); qv[8 * i + 3] = __uint_as_float(w.y & 0xffff0000u);
                  qv[8 * i + 4] = __uint_as_float(w.z << 16); qv[8 * i + 5] = __uint_as_float(w.z & 0xffff0000u);
                  qv[8 * i + 6] = __uint_as_float(w.w << 16); qv[8 * i + 7] = __uint_as_float(w.w & 0xffff0000u); } }
            float s[4]; float m = -INFINITY;
#pragma unroll
            for (int i = 0; i < 4; ++i) { const int cc = lane + 64 * i; float a = 0.f;
                if (cc < nvis) { const u32x4* k4 = (const u32x4*)(kc + (size_t)cc * 64);
#pragma unroll
                    for (int e = 0; e < 8; ++e) { const u32x4 w = k4[e];
                        a = fmaf(qv[8 * e + 0], __uint_as_float(w.x << 16), a); a = fmaf(qv[8 * e + 1], __uint_as_float(w.x & 0xffff0000u), a);
                        a = fmaf(qv[8 * e + 2], __uint_as_float(w.y << 16), a); a = fmaf(qv[8 * e + 3], __uint_as_float(w.y & 0xffff0000u), a);
                        a = fmaf(qv[8 * e + 4], __uint_as_float(w.z << 16), a); a = fmaf(qv[8 * e + 5], __uint_as_float(w.z & 0xffff0000u), a);
                        a = fmaf(qv[8 * e + 6], __uint_as_float(w.w << 16), a); a = fmaf(qv[8 * e + 7], __uint_as_float(w.w & 0xffff0000u), a); }
                    a -= slope2 * (float)(t - (16 * cc + 31)); } else a = -INFINITY;
                s[i] = a; m = fmaxf(m, a); }
            m = wave_max(m);
            float p[4], lsum = 0.f;
#pragma unroll
            for (int i = 0; i < 4; ++i) { p[i] = (lane + 64 * i < nvis) ? exp2f(s[i] - m) : 0.f; lsum += p[i]; }
            lsum = wave_sum(lsum);
            const float inv = lsum > 0.f ? 1.f / lsum : 0.f;
#pragma unroll
            for (int i = 0; i < 4; ++i) { p[i] *= inv; pl[lane + 64 * i] = p[i]; }
            asm volatile("s_waitcnt lgkmcnt(0)" ::: "memory");
            float o = 0.f;
            for (int cc = 0; cc < nvis; ++cc) o = fmaf(pl[cc], bf2f(vc[(size_t)cc * 64 + lane]), o);
            const float gt = gate[((size_t)(b * T_ + t)) * 24 + h * 3 + 0];
            ocmp[(size_t)(b * T_ + t) * 512 + h * 64 + lane] = (bf16)f2bf(gt * o);
            { const int j = lane; float a = pl[4 * j] + pl[4 * j + 1] + pl[4 * j + 2] + 0.5f * pl[4 * j + 3]; if (j > 0) a += 0.5f * pl[4 * j - 1]; imp += a; }
            asm volatile("s_waitcnt lgkmcnt(0)" ::: "memory");
        }
        const int cur = t >> 6; const int j = lane;
        u64 m64;
        if (cur <= 15) m64 = (cur == 63) ? ~0ull : ((1ull << (cur + 1)) - 1ull);
        else {
            float val = (j > cur) ? -INFINITY : ((j == 0 || j == cur || j == cur - 1) ? 1e4f : imp);
            m64 = 0ull;
            for (int r = 0; r < 16; ++r) {
                const float mx = wave_max(val);
                const u64 bal = __ballot(val == mx);
                const int w = __builtin_ctzll(bal);
                m64 |= 1ull << w; if (j == w) val = -INFINITY;
            }
        }
        if (lane == 0) sel[(size_t)bg * T_ + t] = m64;
    }
}

__device__ __forceinline__ void ph_win_attn(const Ctx& c, const bf16* qn, const bf16* kw, const bf16* vw, const float* gate, bf16* owin) {
    for (int it = c.gw; it < B_ * 8 * T_; it += c.ngw) {
        const int t = it % T_, bh = it / T_, b = bh >> 3, h = bh & 7, g = h >> 2;
        const int cur = t >> 6, jlo = (t - 511) > 0 ? (t - 511) >> 6 : 0;
        const u64 hi = (cur == 63) ? ~0ull : ((1ull << (cur + 1)) - 1ull); const u64 mask = hi & ~((1ull << jlo) - 1ull);
        const float o = naive_attn_row<64>(qn + ((size_t)bh * T_ + t) * 64, kw + (size_t)(b * 2 + g) * T_ * 64, vw + (size_t)(b * 2 + g) * T_ * 64, t, mask,
                                           alibi_slope(h + 1, 8) * LOG2E, nullptr, 512, c.lane);
        owin[(size_t)(b * T_ + t) * 512 + h * 64 + c.lane] = (bf16)f2bf(gate[(size_t)(b * T_ + t) * 24 + h * 3 + 2] * o);
    }
}
__device__ __forceinline__ void ph_slc_attn(const Ctx& c, const bf16* qn, const bf16* ks, const bf16* vs, const float* gate, const u64* sel, const bf16* ocmp, const bf16* owin, bf16* att) {
    for (int it = c.gw; it < B_ * 8 * T_; it += c.ngw) {
        const int t = it % T_, bh = it / T_, b = bh >> 3, h = bh & 7, g = h >> 2;
        const u64 mask = sel[(size_t)(b * 2 + g) * T_ + t];
        const float o = naive_attn_row<64>(qn + ((size_t)bh * T_ + t) * 64, ks + (size_t)(b * 2 + g) * T_ * 64, vs + (size_t)(b * 2 + g) * T_ * 64, t, mask,
                                           alibi_slope(h + 1, 8) * LOG2E, nullptr, 1 << 30, c.lane);
        const size_t n = (size_t)(b * T_ + t);
        const float r = gate[n * 24 + h * 3 + 1] * o + bf2f(ocmp[n * 512 + h * 64 + c.lane]) + bf2f(owin[n * 512 + h * 64 + c.lane]);
        att[n * 1024 + h * 64 + c.lane] = (bf16)f2bf(r);
    }
}
__device__ __forceinline__ void ph_fox_attn(const Ctx& c, const bf16* fq, const bf16* fk, const bf16* fv, const float* cum, bf16* att) {
    for (int it = c.gw; it < B_ * 4 * T_; it += c.ngw) {
        const int t = it % T_, bh = it / T_, b = bh >> 2, h = bh & 3;
        const int cur = t >> 6; const u64 mask = (cur == 63) ? ~0ull : ((1ull << (cur + 1)) - 1ull);
        const float o = naive_attn_row<64>(fq + ((size_t)bh * T_ + t) * 64, fk + (size_t)bh * T_ * 64, fv + (size_t)bh * T_ * 64, t, mask, 0.f, cum + (size_t)bh * T_, 1 << 30, c.lane);
        att[(size_t)(b * T_ + t) * 1024 + 512 + h * 64 + c.lane] = (bf16)f2bf(o);
    }
}
__device__ __forceinline__ void ph_diff_attn(const Ctx& c, const bf16* dq, const bf16* dk, const bf16* dv, const float* lam, const float* subln, float lambda_init, bf16* att) {
    float l1 = 0.f, l2 = 0.f;
    if (c.lane < 32) { l1 = lam[c.lane] * lam[32 + c.lane]; l2 = lam[64 + c.lane] * lam[96 + c.lane]; }
    const float lam_full = __expf(wave_sum(l1)) - __expf(wave_sum(l2)) + lambda_init;
    const float sg = subln[c.lane] * (1.f - lambda_init);
    for (int it = c.gw; it < B_ * 4 * T_; it += c.ngw) {
        const int t = it % T_, bh = it / T_, b = bh >> 2, h = bh & 3;
        const int cur = t >> 6; const u64 mask = (cur == 63) ? ~0ull : ((1ull << (cur + 1)) - 1ull);
        const float slope2 = alibi_slope(h + 1, 4) * LOG2E;
        const bf16* vb = dv + (size_t)bh * T_ * 64;
        const float o1 = naive_attn_row<32>(dq + ((size_t)(bh * 2 + 0) * T_ + t) * 32, dk + (size_t)(bh * 2 + 0) * T_ * 32, vb, t, mask, slope2, nullptr, 1 << 30, c.lane);
        const float o2 = naive_attn_row<32>(dq + ((size_t)(bh * 2 + 1) * T_ + t) * 32, dk + (size_t)(bh * 2 + 1) * T_ * 32, vb, t, mask, slope2, nullptr, 1 << 30, c.lane);
        const float o = o1 - lam_full * o2;
        const float r = rsqrtf(wave_sum(o * o) * (1.f / 64.f) + EPS);
        att[(size_t)(b * T_ + t) * 1024 + 768 + h * 64 + c.lane] = (bf16)f2bf(o * r * sg);
    }
}

__device__ __forceinline__ void ph_moe_route(const Ctx& c, const float* x, const float* g, const float* wgrp, const float* bgrp, const float* wexp, const float* bexp, bf16* hn, int* route_e, float* route_w, unsigned* cnt) {
    for (int row = c.gw; row < NT; row += c.ngw) {
        const f32x4* xr = (const f32x4*)(x + (size_t)row * D_) + c.lane;
        f32x4 v[4]; float ss = 0.f;
#pragma unroll
        for (int j = 0; j < 4; ++j) { v[j] = xr[64 * j]; ss += v[j].x * v[j].x + v[j].y * v[j].y + v[j].z * v[j].z + v[j].w * v[j].w; }
        const float r = rsqrtf(wave_sum(ss) * (1.f / D_) + EPS);
        u64* o8 = (u64*)(hn + (size_t)row * D_) + c.lane;
#pragma unroll
        for (int j = 0; j < 4; ++j) { const f32x4 gg = ((const f32x4*)g)[c.lane + 64 * j]; v[j] = v[j] * r * gg;
            o8[64 * j] = (u64)pk2(v[j].x, v[j].y) | ((u64)pk2(v[j].z, v[j].w) << 32); }
        float gl[4];
#pragma unroll
        for (int q = 0; q < 4; ++q) { float a = 0.f;
#pragma unroll
            for (int j = 0; j < 4; ++j) { const int k = 4 * (c.lane + 64 * j);
                a = fmaf(v[j].x, wgrp[(size_t)(k + 0) * 4 + q], a); a = fmaf(v[j].y, wgrp[(size_t)(k + 1) * 4 + q], a);
                a = fmaf(v[j].z, wgrp[(size_t)(k + 2) * 4 + q], a); a = fmaf(v[j].w, wgrp[(size_t)(k + 3) * 4 + q], a); }
            gl[q] = wave_sum(a) + bgrp[q]; }
        int grp = 0; float gm = gl[0];
#pragma unroll
        for (int q = 1; q < 4; ++q) if (gl[q] > gm) { gm = gl[q]; grp = q; }
        float gs = 0.f;
#pragma unroll
        for (int q = 0; q < 4; ++q) gs += __expf(gl[q] - gm);
        const float grp_gate = 1.f / gs;
        float el[8];
#pragma unroll
        for (int q = 0; q < 8; ++q) { float a = 0.f; const int col = grp * 8 + q;
#pragma unroll
            for (int j = 0; j < 4; ++j) { const int k = 4 * (c.lane + 64 * j);
                a = fmaf(v[j].x, wexp[(size_t)(k + 0) * 32 + col], a); a = fmaf(v[j].y, wexp[(size_t)(k + 1) * 32 + col], a);
                a = fmaf(v[j].z, wexp[(size_t)(k + 2) * 32 + col], a); a = fmaf(v[j].w, wexp[(size_t)(k + 3) * 32 + col], a); }
            el[q] = wave_sum(a) + bexp[col]; }
        int i0 = 0; float v0 = el[0];
#pragma unroll
        for (int q = 1; q < 8; ++q) if (el[q] > v0) { v0 = el[q]; i0 = q; }
        int i1 = -1; float v1 = -INFINITY;
#pragma unroll
        for (int q = 0; q < 8; ++q) if (q != i0 && el[q] > v1) { v1 = el[q]; i1 = q; }
        const float e1 = __expf(v1 - v0), den = 1.f + e1;
        if (c.lane == 0) { const float w0 = grp_gate / den, w1 = grp_gate * e1 / den;
            const int lo = i0 < i1 ? i0 : i1, hi = i0 < i1 ? i1 : i0, cls = grp * 28 + lo * 8 - (lo * (lo + 1)) / 2 + (hi - lo - 1);
            const unsigned rank = __hip_atomic_fetch_add(cnt + cls, 1u, __ATOMIC_RELAXED, __HIP_MEMORY_SCOPE_AGENT);
            route_e[row] = (int)(((unsigned)cls << 24) | rank); route_w[2 * row] = i0 < i1 ? w0 : w1; route_w[2 * row + 1] = i0 < i1 ? w1 : w0; }
    }
}
__device__ __forceinline__ void ph_moe_naive(const Ctx& c, const bf16* hn, const int* route_e, const float* route_w, const float* wg, const float* wu, const float* wd, float* x) {
    LAS float* hs = (LAS float*)c.lds;
    LAS float* au = hs + 1024;
    LAS float* h2 = au + 512;
    for (int row = c.bid; row < NT; row += c.G) {
        __syncthreads();
        hs[c.tid] = bf2f(hn[(size_t)row * D_ + c.tid]); hs[c.tid + 512] = bf2f(hn[(size_t)row * D_ + c.tid + 512]);
        float o0 = 0.f, o1 = 0.f;
        for (int s = 0; s < 2; ++s) {
            const int e = route_e[2 * row + s]; const float w = route_w[2 * row + s];
            __syncthreads();
            const float* W = (c.tid < 256 ? wg : wu) + (size_t)e * D_ * DEXP + (c.tid & 255);
            float a = 0.f;
            for (int k = 0; k < D_; ++k) a = fmaf(hs[k], W[(size_t)k * DEXP], a);
            au[c.tid] = a;
            __syncthreads();
            if (c.tid < 256) { const float ga = au[c.tid], up = au[c.tid + 256]; h2[c.tid] = ga / (1.f + __expf(-ga)) * up * w; }
            __syncthreads();
            const float* Wd = wd + (size_t)e * DEXP * D_;
            for (int k = 0; k < DEXP; ++k) { const float hv = h2[k]; o0 = fmaf(hv, Wd[(size_t)k * D_ + c.tid], o0); o1 = fmaf(hv, Wd[(size_t)k * D_ + c.tid + 512], o1); }
        }
        x[(size_t)row * D_ + c.tid] += o0; x[(size_t)row * D_ + c.tid + 512] += o1;
    }
    __syncthreads();
}

typedef __attribute__((address_space(4))) const Params* KP;
__device__ __forceinline__ KP uni_kp(KP p) { const unsigned long long v = (unsigned long long)p; const unsigned lo = __builtin_amdgcn_readfirstlane((unsigned)v), hi = __builtin_amdgcn_readfirstlane((unsigned)(v >> 32)); return (KP)(((unsigned long long)hi << 32) | lo); }
constexpr int PH_PER_LAYER = 11, N_PHASES = L_ * PH_PER_LAYER + 2;
__device__ __forceinline__ Ctx make_ctx(KP p) {
    Ctx c; c.lds = (LAS unsigned char*)lds_raw; { int t_ = threadIdx.x; asm volatile("" : "+v"(t_)); c.tid = t_; } c.lane = c.tid & 63; c.wave = __builtin_amdgcn_readfirstlane(c.tid >> 6);
    c.bid = blockIdx.x; c.G = gridDim.x; c.gw = c.bid * NWAVES + c.wave; c.ngw = c.G * NWAVES; c.in = nullptr; c.xcur = p->out; c.ws = p->ws;
    return c;
}
struct Bufs {
    bf16 *QN, *KV6, *KC, *VC, *KS, *VS, *KW, *VW, *FQ, *FK, *FV, *DQ, *DK, *DV, *HC, *KCMP, *VCMP, *OCMP, *OWIN, *HN, *ATT;
    float *GATE, *FL, *ROUTE_W; u64* SEL; int* ROUTE_E;
};
__device__ __forceinline__ Bufs make_bufs(unsigned char* ws) {
    Bufs b;
    b.QN = (bf16*)(ws + WS_QN); b.KV6 = (bf16*)(ws + WS_KV6);
    b.KC = (bf16*)(ws + WS_KV6 + 0 * KV6_STRIDE); b.VC = (bf16*)(ws + WS_KV6 + 1 * KV6_STRIDE);
    b.KS = (bf16*)(ws + WS_KV6 + 2 * KV6_STRIDE); b.VS = (bf16*)(ws + WS_KV6 + 3 * KV6_STRIDE);
    b.KW = (bf16*)(ws + WS_KV6 + 4 * KV6_STRIDE); b.VW = (bf16*)(ws + WS_KV6 + 5 * KV6_STRIDE);
    b.FQ = (bf16*)(ws + WS_FQKV); b.FK = b.FQ + 8 * MiB; b.FV = b.FQ + 16 * MiB;
    b.DQ = (bf16*)(ws + WS_DQK); b.DK = b.DQ + 8 * MiB; b.DV = (bf16*)(ws + WS_DV);
    b.GATE = (float*)(ws + WS_GATE); b.FL = (float*)(ws + WS_FL);
    b.HC = (bf16*)(ws + WS_HC); b.KCMP = (bf16*)(ws + WS_KVCMP); b.VCMP = b.KCMP + 16 * 256 * 64;
    b.SEL = (u64*)(ws + WS_SEL); b.OCMP = (bf16*)(ws + WS_OCMP); b.OWIN = (bf16*)(ws + WS_OWIN);
    b.HN = (bf16*)(ws + WS_HN); b.ATT = (bf16*)(ws + WS_ATT);
    b.ROUTE_E = (int*)(ws + WS_ROUTE); b.ROUTE_W = (float*)(ws + WS_ROUTE + 512 * 1024);
    return b;
}
__device__ __forceinline__ float lambda_init_of(int l) { return l == 0 ? 0.2f : 0.35550906759096926f; }

__device__ __noinline__ void P_prologue(KP p_) { const KP p = uni_kp(p_);
    const Ctx c = make_ctx(p); unsigned char* ws = p->ws;
    LAS float* scr = (LAS float*)(c.lds) + c.wave * (64 * 33);
    constexpr int I_A = 16 * 40, I_B = 16 * 24, I_C = 16 * 24, I_O = 16 * 32, I_G = 16 * 8, I_D = 4 * 32, I_E = 2 * I_G + I_D, I_W1 = 32 * 8, I_W2 = 4 * 2;
    constexpr int PER_L = I_A + I_B + I_C + I_O + 2 * (I_W1 + I_W2);
    for (int it = c.gw; it < L_ * PER_L; it += c.ngw) {
        const int l = it / PER_L; int r = it % PER_L;
        const float* W; bf16* WT; int ldw, K, sc0, ncol, r0 = 0, rmul = 1;
        if (r < I_A + I_B + I_C) { W = p->in[2] + (size_t)l * D_ * D_IN; WT = (bf16*)(ws + WS_WIN_T) + (size_t)l * NIN * D_; ldw = D_IN; K = D_;
            if (r < I_A) { sc0 = 0; ncol = 1280; r0 = 0; } else if (r < I_A + I_B) { r -= I_A; sc0 = C_FQ; ncol = 768; r0 = 1280; } else { r -= I_A + I_B; sc0 = C_DQ; ncol = 768; r0 = 2048; } }
        else if ((r -= I_A + I_B + I_C) < I_O) { W = p->in[13] + (size_t)l * D_ * D_; WT = (bf16*)(ws + WS_WOUT_T) + (size_t)l * D_ * D_; ldw = D_; K = D_; sc0 = 0; ncol = 1024; }
        else { r -= I_O; const int kv = r / (I_W1 + I_W2); r = r % (I_W1 + I_W2); const size_t lk = (size_t)l * 2 + kv;
            if (r < I_W1) { W = p->in[kv == 0 ? 6 : 9] + (size_t)l * 2048 * 256; WT = (bf16*)(ws + WS_W1_T) + lk * 256 * 2048; ldw = 256; K = 2048; sc0 = 0; ncol = 256; }
            else { r -= I_W1; W = p->in[kv == 0 ? 7 : 10] + (size_t)l * 256 * 64; WT = (bf16*)(ws + WS_W2_T) + lk * 64 * 256; ldw = 64; K = 256; sc0 = 0; ncol = 64; } }
        transpose_seg(W, ldw, K, sc0, ncol, WT, r0, rmul, r, scr, c.lane);
    }
    for (int i = c.bid * NTHREADS + c.tid; i < L_ * 256 * D_; i += c.G * NTHREADS) {
        const int l = i / (256 * D_), rr = (i / D_) % 256, k = i % D_;
        const float* win = p->in[2] + (size_t)l * D_ * D_IN;
        float v = 0.f; if (rr < 24) v = win[(size_t)k * D_IN + C_GATE + rr]; else if (rr < 28) v = win[(size_t)k * D_IN + C_FF + (rr - 24)];
        ((bf16*)(ws + WS_WIN_T))[((size_t)l * NIN + 2816 + rr) * D_ + k] = (bf16)f2bf(v);
    }
    for (int w = c.gw; w < L_ * 2 * 4 * 128; w += c.ngw) {
        const int lk = w >> 9, cg = (w >> 7) & 3, kc = w & 127, l = lk >> 1, kv = lk & 1, j = cg * 64 + c.lane;
        const float* pe = p->in[kv == 0 ? 5 : 8] + (size_t)l * 2048 + kc * 16; const float* w1 = p->in[kv == 0 ? 6 : 9] + (size_t)l * 2048 * 256 + (size_t)kc * 16 * 256;
        float a = 0.f;
#pragma unroll
        for (int k = 0; k < 16; ++k) a = fmaf(pe[k], w1[(size_t)k * 256 + j], a);
        ((float*)(ws + WS_B1PART))[((size_t)lk * 128 + kc) * 256 + j] = a;
    }
    for (int i = c.bid * NTHREADS + c.tid; i < L_ * 64 * 2 * 64; i += c.G * NTHREADS) {
        const int l = i / (64 * 2 * 64), ks = (i / 128) % 64, cb = (i / 64) & 1, lane = i & 63, col = 32 * cb + (lane & 31);
        unsigned hi[4], lo[4];
#pragma unroll
        for (int jp = 0; jp < 4; ++jp) { float v[2];
#pragma unroll
            for (int e = 0; e < 2; ++e) { const int k = 16 * ks + 8 * (lane >> 5) + 2 * jp + e; const float g = p->in[14][(size_t)l * D_ + k];
                v[e] = col < 4 ? g * p->in[15][((size_t)l * D_ + k) * 4 + col] : (col < 36 ? g * p->in[17][((size_t)l * D_ + k) * 32 + (col - 4)] : 0.f); }
            const unsigned h0 = f2bf(v[0]), h1 = f2bf(v[1]); hi[jp] = h0 | (h1 << 16);
            lo[jp] = f2bf(v[0] - __uint_as_float(h0 << 16)) | (f2bf(v[1] - __uint_as_float(h1 << 16)) << 16); }
        u32x4* dst = (u32x4*)(ws + WS_WR) + ((size_t)((l * 64 + ks) * 2 + cb) * 2) * 64 + lane;
        dst[0] = (u32x4){hi[0], hi[1], hi[2], hi[3]}; dst[64] = (u32x4){lo[0], lo[1], lo[2], lo[3]};
    }
}
__device__ __forceinline__ void P_inproj_mfma(int l_) { const KP p = (KP)__builtin_amdgcn_kernarg_segment_ptr(); int l = l_; asm volatile("" : "+s"(l));
    unsigned char* ws = p->ws; asm volatile("" : "+s"(ws));
    PlainOrder S; S.init(p->out, (const bf16*)(ws + WS_WIN_T) + (size_t)l * NIN * D_, D_, D_, NT, NIN, (int)gridDim.x, launder_s((int)blockIdx.x));
#ifdef STAGGER_TICKS
    { const unsigned long long t0 = __builtin_amdgcn_s_memrealtime(); const unsigned long long d = (unsigned long long)((launder_s((int)blockIdx.x) >> 3) & 3) * STAGGER_TICKS;
      while (__builtin_amdgcn_s_memrealtime() - t0 < d) __builtin_amdgcn_s_sleep(4); }
#endif
    const pg8::Gemm g{D_, D_, D_, D_ / 64, 0, 0};
    const EpiInProj E{ws, p->in[3] + l * 24, p->in[4] + l * 4, (unsigned*)(ws + WS_CTL) + CW_KN + l * 8192};
    pg8::gemm_phase<EpiInProj, PlainOrder, INPROJ_ALIGN, INPROJ_SP2>((LAS unsigned char*)lds_raw, g, S, E);
}
__device__ __forceinline__ void P_inproj_dummy(int l_) { const KP p = (KP)__builtin_amdgcn_kernarg_segment_ptr(); int l = l_; asm volatile("" : "+s"(l));
    unsigned char* ws = p->ws; asm volatile("" : "+s"(ws));
    PlainOrder S; S.init(p->out, (const bf16*)(ws + WS_WIN_T) + (size_t)l * NIN * D_, D_, D_, NT, NIN, (int)gridDim.x, launder_s((int)blockIdx.x));
    const pg8::Gemm g{D_, D_, D_, D_ / 64, 0, 0};
    const EpiDummy E{(float*)(ws + WS_HB)};
    pg8::gemm_phase<EpiDummy, PlainOrder, true, true>((LAS unsigned char*)lds_raw, g, S, E);
}
__device__ __forceinline__ void P_outproj_mfma(int l_) { const KP p = (KP)__builtin_amdgcn_kernarg_segment_ptr(); int l = l_; asm volatile("" : "+s"(l));
    unsigned char* ws = p->ws; asm volatile("" : "+s"(ws));
    PlainOrder S; S.init(ws + WS_ATT, (const bf16*)(ws + WS_WOUT_T) + (size_t)l * D_ * D_, D_, D_, NT, D_, (int)gridDim.x, launder_s((int)blockIdx.x));
    const pg8::Gemm g{D_, D_, D_, D_ / 64, 32, 8};
    const EpiResBf16 E{(bf16*)(ws + WS_HN)};
    pg8::gemm_phase<EpiResBf16, PlainOrder, true, true>((LAS unsigned char*)lds_raw, g, S, E);
}
__device__ __forceinline__ float wave_max_l(float v, int lane) {
#pragma unroll
    for (int o = 1; o < 64; o <<= 1) v = fmaxf(v, shflx_f(v, o, lane));
    return v;
}
__device__ __forceinline__ float wave_min_l(float v, int lane) {
#pragma unroll
    for (int o = 1; o < 64; o <<= 1) v = fminf(v, shflx_f(v, o, lane));
    return v;
}
template <int NS> __device__ __forceinline__ float q_norm2_max(const bf16x8v (&Q)[NS], int lane) {
    float ss = 0.f;
#pragma unroll
    for (int s = 0; s < NS; ++s)
#pragma unroll
        for (int e = 0; e < 8; ++e) { const float v = __uint_as_float(((unsigned)(unsigned short)Q[s][e]) << 16); ss = fmaf(v, v, ss); }
    return wave_max_l(swap_sum(ss), lane);
}
__device__ __forceinline__ u64 prune_consensus(bool skip, LAS u64* slots, int wave, int lane) {
    const u64 mine = __ballot(skip);
    __syncthreads();
    if (lane == 0) slots[wave] = mine;
    __syncthreads();
    u64 all = slots[0];
#pragma unroll
    for (int w = 1; w < NWAVES; ++w) all &= slots[w];
    return all;
}
__device__ __forceinline__ bool block_any(bool v, LAS u64* slots, int wave, int lane) {
#ifdef FORCE_FALLBACK
    v = true;
#endif
    const u64 mine = __ballot(v);
    __syncthreads();
    if (lane == 0) slots[wave] = mine;
    __syncthreads();
    u64 all = slots[0];
#pragma unroll
    for (int w = 1; w < NWAVES; ++w) all |= slots[w];
    return all != 0ull;
}
__device__ __forceinline__ bool sum_bad(float l) { return !(l < 1e30f); }
__device__ __forceinline__ void U_fox(KP p_, int bh_, int qb_, int l_) {
    const KP p = uni_kp(p_); const int bh = __builtin_amdgcn_readfirstlane(bh_), qb = __builtin_amdgcn_readfirstlane(qb_), l = __builtin_amdgcn_readfirstlane(l_);
    int tid_ = threadIdx.x; asm volatile("" : "+v"(tid_));
    const int tid = tid_, lane = tid & 63, wave = __builtin_amdgcn_readfirstlane(tid >> 6), r = lane & 31, h = lane >> 5;
    unsigned char* ws = p->ws; asm volatile("" : "+s"(ws)); LAS unsigned char* L = (LAS unsigned char*)lds_raw;
    const int tw0 = 256 * qb + 32 * wave, t_lane = tw0 + r, b = bh >> 2, hd = bh & 3;
    const bf16* q = (const bf16*)(ws + WS_FQKV) + (size_t)bh * T_ * 64 + (t_lane >> 4) * 1024 + (t_lane & 15) * 32 + 8 * h;
    bf16x8v Qf[1][4];
#pragma unroll
    for (int s = 0; s < 4; ++s) Qf[0][s] = *(const bf16x8v*)(q + (s >> 1) * 512 + (s & 1) * 16);
    const bf16* Kp = (const bf16*)(ws + WS_FQKV) + 8 * MiB + (size_t)bh * T_ * 64; const bf16* Vp = (const bf16*)(ws + WS_FQKV) + 16 * MiB + (size_t)bh * T_ * 64;
    u32x4 kpre, vpre; attn_preload<64>(Kp, nullptr, Vp, 4 * qb + 3, tid, kpre, vpre);
    LAS float* cum = (LAS float*)(L + A_LDS_END);
    { const float* fl = (const float*)(ws + WS_FL) + (size_t)bh * T_; LAS float* tot = cum + 4096;
      const int nval = 256 * (qb + 1); float v[8];
      if (8 * tid < nval) { const f32x4 a = *(const f32x4*)(fl + 8 * tid), c2 = *(const f32x4*)(fl + 8 * tid + 4); v[0] = a.x; v[1] = a.y; v[2] = a.z; v[3] = a.w; v[4] = c2.x; v[5] = c2.y; v[6] = c2.z; v[7] = c2.w; }
      else {
#pragma unroll
          for (int i = 0; i < 8; ++i) v[i] = 0.f; }
#pragma unroll
      for (int i = 1; i < 8; ++i) v[i] += v[i - 1];
      float sc = v[7];
#pragma unroll
      for (int o = 1; o < 64; o <<= 1) { const float up = __uint_as_float((unsigned)__builtin_amdgcn_ds_bpermute((lane - o) << 2, (int)__float_as_uint(sc))); if (lane >= o) sc += up; }
      if (lane == 63) tot[wave] = sc;
      __syncthreads();
      float base = sc - v[7];
      for (int w = 0; w < wave; ++w) base += tot[w];
      if (8 * tid < nval) {
#pragma unroll
          for (int i = 0; i < 8; ++i) cum[8 * tid + i] = v[i] + base; }
      __syncthreads(); }
    f32x16 O[1][2]; float M[1] = {0.f}, Ls[1] = {0.f};
#pragma unroll
    for (int i = 0; i < 16; ++i) { O[0][0][i] = 0.f; O[0][1][i] = 0.f; }
    const u64 tm = (qb == 15) ? ~0ull : ((1ull << (4 * qb + 4)) - 1ull);
#if AC2_MODE == 0
    {
        const u64 low = (1ull << (4 * qb)) - 1ull; const float cref = cum[tw0];
#define FOX_CORES(NM, FIRSTCALL) do { FIRSTCALL; \
        if (qb > 0) { \
            const float qn2 = q_norm2_max<4>(Qf[0], lane), mmin = wave_min_l(M[0], lane); \
            const float* kn = (const float*)((const unsigned*)(ws + WS_CTL) + CW_KN + l * 8192) + ((size_t)bh * 64 + lane) * 2; \
            bool skip = false; \
            if (lane < 4 * qb) { const float kn2 = kn[0] + kn[1]; const float bound = sqrtf(qn2 * kn2) * 1.02f + (cref - cum[64 * lane + 63]) * LOG2E - mmin; skip = bound < -152.f; } \
            const u64 drop = prune_consensus(skip, (LAS u64*)(cum + 4096 + 16), wave, lane); \
            const u64 tm2 = low & ~drop; \
            if (tm2) attn_core<64, 1, true, false, false, NM>(L, Kp, nullptr, Vp, cum, cref, Qf, tm2, t_lane, tw0, 1 << 30, 0.f, 0u, 0u, O, M, Ls, tid, true); \
        } } while (0)
        FOX_CORES(NOMAX_ON, (attn_core<64, 1, true, false, true, NOMAX_ON>(L, Kp, nullptr, Vp, cum, cref, Qf, tm & ~low, t_lane, tw0, 1 << 30, 0.f, 0u, 0u, O, M, Ls, tid, false, 4 * qb + 3, kpre, vpre)));
        if (NOMAX_ON && block_any(sum_bad(Ls[0]), (LAS u64*)(cum + 4096 + 32), wave, lane)) {
#pragma unroll
            for (int i = 0; i < 16; ++i) { O[0][0][i] = 0.f; O[0][1][i] = 0.f; }
            M[0] = 0.f; Ls[0] = 0.f;
            FOX_CORES(false, (attn_core<64, 1, true, false, false, false>(L, Kp, nullptr, Vp, cum, cref, Qf, tm & ~low, t_lane, tw0, 1 << 30, 0.f, 0u, 0u, O, M, Ls, tid)));
        }
#undef FOX_CORES
    }
#else
    attn_core2<true, false>(L, (const bf16*)(ws + WS_FQKV) + 8 * MiB + (size_t)bh * T_ * 64, (const bf16*)(ws + WS_FQKV) + 16 * MiB + (size_t)bh * T_ * 64, cum, cum[256 * qb],
                            Qf[0], tm, t_lane, tw0, 1 << 30, 0.f, 0u, 0u, O[0], M[0], Ls[0], tid);
#endif
    const float lt = swap_sum(Ls[0]), inv = lt > 0.f ? 1.f / lt : 0.f;
    bf16* dst = (bf16*)(ws + WS_ATT) + mix_off((size_t)b * T_ + t_lane, 512 + hd * 64 + 4 * h, 1024);
    ATTN_FOR_CHUNKS(db, g4) { const unsigned w0 = cvtpk(O[0][db][4 * g4 + 0] * inv, O[0][db][4 * g4 + 1] * inv), w1 = cvtpk(O[0][db][4 * g4 + 2] * inv, O[0][db][4 * g4 + 3] * inv);
        *(u64*)(dst + (4 * db + g4) * 256) = (u64)w0 | ((u64)w1 << 32); }
}
__device__ __forceinline__ void U_diff(KP p_, int bh_, int qb_, int l_) {
    const KP p = uni_kp(p_); const int bh = __builtin_amdgcn_readfirstlane(bh_), qb = __builtin_amdgcn_readfirstlane(qb_), l = __builtin_amdgcn_readfirstlane(l_);
    int tid_ = threadIdx.x; asm volatile("" : "+v"(tid_));
    const int tid = tid_, lane = tid & 63, wave = __builtin_amdgcn_readfirstlane(tid >> 6), r = lane & 31, h = lane >> 5;
    unsigned char* ws = p->ws; asm volatile("" : "+s"(ws)); LAS unsigned char* L = (LAS unsigned char*)lds_raw;
    const int tw0 = 256 * qb + 32 * wave, t_lane = tw0 + r, b = bh >> 2, hd = bh & 3;
    const bf16* DQ = (const bf16*)(ws + WS_DQK); const bf16* DK = DQ + 8 * MiB;
    bf16x8v Qf[2][2];
#pragma unroll
    for (int mp = 0; mp < 2; ++mp)
#pragma unroll
        for (int s = 0; s < 2; ++s) Qf[mp][s] = *(const bf16x8v*)(DQ + ((size_t)(bh * 2 + mp) * T_ + t_lane) * 32 + 16 * s + 8 * h);
    f32x16 O[2][2]; float M[2] = {0.f, 0.f}, Ls[2] = {0.f, 0.f};
#pragma unroll
    for (int i = 0; i < 16; ++i) { O[0][0][i] = 0.f; O[0][1][i] = 0.f; O[1][0][i] = 0.f; O[1][1][i] = 0.f; }
    const u64 tm = (qb == 15) ? ~0ull : ((1ull << (4 * qb + 4)) - 1ull);
    {
        const u64 low = (1ull << (4 * qb)) - 1ull; const float slope2 = alibi_slope(hd + 1, 4) * LOG2E;
        const bf16* K0 = DK + (size_t)(bh * 2 + 0) * T_ * 32; const bf16* K1 = DK + (size_t)(bh * 2 + 1) * T_ * 32; const bf16* Vp = (const bf16*)(ws + WS_DV) + (size_t)bh * T_ * 64;
#define DIFF_CORES(NM) do { \
        attn_core<32, 2, false, false, false, NM>(L, K0, K1, Vp, nullptr, 0.f, Qf, tm & ~low, t_lane, tw0, 1 << 30, slope2, 0u, 0u, O, M, Ls, tid); \
        if (qb > 0) { \
            const float qa = q_norm2_max<2>(Qf[0], lane), qb2 = q_norm2_max<2>(Qf[1], lane), ma = wave_min_l(M[0], lane), mb = wave_min_l(M[1], lane); \
            const float* kn = (const float*)((const unsigned*)(ws + WS_CTL) + CW_KN + l * 8192 + 4096) + (size_t)(bh * 2) * 64 + lane; \
            bool skip = false; \
            if (lane < 4 * qb) { const float bmax = slope2 * (float)(64 * lane + 63 - tw0);            \
                skip = (sqrtf(qa * kn[0]) * 1.02f + bmax - ma < -152.f) && (sqrtf(qb2 * kn[64]) * 1.02f + bmax - mb < -152.f); } \
            const u64 drop = prune_consensus(skip, (LAS u64*)(L + A_LDS_END), wave, lane); \
            const u64 tm2 = low & ~drop; \
            if (tm2) attn_core<32, 2, false, false, false, NM>(L, K0, K1, Vp, nullptr, 0.f, Qf, tm2, t_lane, tw0, 1 << 30, slope2, 0u, 0u, O, M, Ls, tid, true); \
        } } while (0)
        DIFF_CORES(NOMAX_ON);
        if (NOMAX_ON && block_any(sum_bad(Ls[0]) || sum_bad(Ls[1]), (LAS u64*)(L + A_LDS_END + 64), wave, lane)) {
#pragma unroll
            for (int i = 0; i < 16; ++i) { O[0][0][i] = 0.f; O[0][1][i] = 0.f; O[1][0][i] = 0.f; O[1][1][i] = 0.f; }
            M[0] = 0.f; M[1] = 0.f; Ls[0] = 0.f; Ls[1] = 0.f;
            DIFF_CORES(false);
        }
#undef DIFF_CORES
    }
    const float* lam = p->in[11] + (size_t)l * 128; const float* subln = p->in[12] + (size_t)l * 64;
    float l1 = 0.f, l2 = 0.f; if (lane < 32) { l1 = lam[lane] * lam[32 + lane]; l2 = lam[64 + lane] * lam[96 + lane]; }
    const float li = lambda_init_of(l), lam_full = __expf(wave_sum_l(l1, lane)) - __expf(wave_sum_l(l2, lane)) + li;
    const float lt0 = swap_sum(Ls[0]), lt1 = swap_sum(Ls[1]), i0 = lt0 > 0.f ? 1.f / lt0 : 0.f, i1 = (lt1 > 0.f ? 1.f / lt1 : 0.f) * lam_full;
    float ss = 0.f;
#pragma unroll
    for (int db = 0; db < 2; ++db)
#pragma unroll
        for (int i = 0; i < 16; ++i) { const float o = O[0][db][i] * i0 - O[1][db][i] * i1; O[0][db][i] = o; ss += o * o; }
    ss = swap_sum(ss);
    const float rn = rsqrtf(ss * (1.f / 64.f) + EPS) * (1.f - li);
    bf16* dst = (bf16*)(ws + WS_ATT) + mix_off((size_t)b * T_ + t_lane, 768 + hd * 64 + 4 * h, 1024);
    ATTN_FOR_CHUNKS(db, g4) { const f32x4 sg = *(const f32x4*)(subln + 32 * db + 8 * g4 + 4 * h);
        const unsigned w0 = cvtpk(O[0][db][4 * g4 + 0] * rn * sg.x, O[0][db][4 * g4 + 1] * rn * sg.y), w1 = cvtpk(O[0][db][4 * g4 + 2] * rn * sg.z, O[0][db][4 * g4 + 3] * rn * sg.w);
        *(u64*)(dst + (4 * db + g4) * 256) = (u64)w0 | ((u64)w1 << 32); }
}
__device__ __forceinline__ void U_win(KP p_, int bg_, int c_) {
    const KP p = uni_kp(p_); const int bg = __builtin_amdgcn_readfirstlane(bg_), cc = __builtin_amdgcn_readfirstlane(c_);
    int tid_ = threadIdx.x; asm volatile("" : "+v"(tid_));
    const int tid = tid_, lane = tid & 63, wave = __builtin_amdgcn_readfirstlane(tid >> 6), r = lane & 31, h = lane >> 5;
    unsigned char* ws = p->ws; asm volatile("" : "+s"(ws)); LAS unsigned char* L = (LAS unsigned char*)lds_raw;
    const int b = bg >> 1, g = bg & 1, hd = g * 4 + (wave >> 1), tw0 = 64 * cc + 32 * (wave & 1), t_lane = tw0 + r;
    const bf16* q = (const bf16*)(ws + WS_QN) + (size_t)(b * 8 + hd) * T_ * 64 + (t_lane >> 4) * 1024 + (t_lane & 15) * 32 + 8 * h;
    bf16x8v Qf[1][4];
#pragma unroll
    for (int s = 0; s < 4; ++s) Qf[0][s] = *(const bf16x8v*)(q + (s >> 1) * 512 + (s & 1) * 16);
    f32x16 O[1][2]; float M[1] = {0.f}, Ls[1] = {0.f};
#pragma unroll
    for (int i = 0; i < 16; ++i) { O[0][0][i] = 0.f; O[0][1][i] = 0.f; }
    const size_t n = (size_t)b * T_ + t_lane;
    const float gate_w = ((const float*)(ws + WS_GATE))[n * 24 + hd * 3 + 2];
    const int jlo = cc > 8 ? cc - 8 : 0;
    const u64 hi = (cc == 63) ? ~0ull : ((1ull << (cc + 1)) - 1ull), tm = hi & ~((1ull << jlo) - 1ull);
#if AC2_MODE == 0
    attn_core<64, 1, false, false, false, NOMAX_ON>(L, (const bf16*)(ws + WS_KV6 + 4 * KV6_STRIDE) + (size_t)bg * T_ * 64, nullptr, (const bf16*)(ws + WS_KV6 + 5 * KV6_STRIDE) + (size_t)bg * T_ * 64, nullptr, 0.f,
                                   Qf, tm, t_lane, tw0, 512, alibi_slope(hd + 1, 8) * LOG2E, 0u, 0u, O, M, Ls, tid);
    if (NOMAX_ON && block_any(sum_bad(Ls[0]), (LAS u64*)(L + A_LDS_END + 64), wave, lane)) {
#pragma unroll
        for (int i = 0; i < 16; ++i) { O[0][0][i] = 0.f; O[0][1][i] = 0.f; }
        M[0] = 0.f; Ls[0] = 0.f;
        attn_core<64, 1, false, false, false, false>(L, (const bf16*)(ws + WS_KV6 + 4 * KV6_STRIDE) + (size_t)bg * T_ * 64, nullptr, (const bf16*)(ws + WS_KV6 + 5 * KV6_STRIDE) + (size_t)bg * T_ * 64, nullptr, 0.f,
                                       Qf, tm, t_lane, tw0, 512, alibi_slope(hd + 1, 8) * LOG2E, 0u, 0u, O, M, Ls, tid);
    }
#ifdef PROBE_WINCORE2
    attn_core<64, 1, false, false>(L, (const bf16*)(ws + WS_KV6 + 4 * KV6_STRIDE) + (size_t)bg * T_ * 64, nullptr, (const bf16*)(ws + WS_KV6 + 5 * KV6_STRIDE) + (size_t)bg * T_ * 64, nullptr, 0.f,
                                   Qf, tm, t_lane, tw0, 512, alibi_slope(hd + 1, 8) * LOG2E, 0u, 0u, O, M, Ls, tid, true);
#endif
#else
    attn_core2<false, false>(L, (const bf16*)(ws + WS_KV6 + 4 * KV6_STRIDE) + (size_t)bg * T_ * 64, (const bf16*)(ws + WS_KV6 + 5 * KV6_STRIDE) + (size_t)bg * T_ * 64, nullptr, 0.f,
                             Qf[0], tm, t_lane, tw0, 512, alibi_slope(hd + 1, 8) * LOG2E, 0u, 0u, O[0], M[0], Ls[0], tid);
#endif
    const float lt = swap_sum(Ls[0]), inv = (lt > 0.f ? 1.f / lt : 0.f) * gate_w;
    bf16* dst = (bf16*)(ws + WS_OWIN) + mix_off(n, hd * 64 + 4 * h, 512);
    ATTN_FOR_CHUNKS(db, g4) { const unsigned w0 = cvtpk(O[0][db][4 * g4 + 0] * inv, O[0][db][4 * g4 + 1] * inv), w1 = cvtpk(O[0][db][4 * g4 + 2] * inv, O[0][db][4 * g4 + 3] * inv);
        *(u64*)(dst + (4 * db + g4) * 256) = (u64)w0 | ((u64)w1 << 32); }
}
__device__ __forceinline__ void U_slc(KP p_, int bg_, int c_) {
    const KP p = uni_kp(p_); const int bg = __builtin_amdgcn_readfirstlane(bg_), cc = __builtin_amdgcn_readfirstlane(c_);
    int tid_ = threadIdx.x; asm volatile("" : "+v"(tid_));
    const int tid = tid_, lane = tid & 63, wave = __builtin_amdgcn_readfirstlane(tid >> 6), r = lane & 31, h = lane >> 5;
    unsigned char* ws = p->ws; asm volatile("" : "+s"(ws)); LAS unsigned char* L = (LAS unsigned char*)lds_raw;
    const int b = bg >> 1, g = bg & 1, hd = g * 4 + (wave >> 1), tw0 = 64 * cc + 32 * (wave & 1), t_lane = tw0 + r;
    const bf16* q = (const bf16*)(ws + WS_QN) + (size_t)(b * 8 + hd) * T_ * 64 + (t_lane >> 4) * 1024 + (t_lane & 15) * 32 + 8 * h;
    bf16x8v Qf[1][4];
#pragma unroll
    for (int s = 0; s < 4; ++s) Qf[0][s] = *(const bf16x8v*)(q + (s >> 1) * 512 + (s & 1) * 16);
    f32x16 O[1][2]; float M[1] = {0.f}, Ls[1] = {0.f};
#pragma unroll
    for (int i = 0; i < 16; ++i) { O[0][0][i] = 0.f; O[0][1][i] = 0.f; }
    const bf16* Ksl = (const bf16*)(ws + WS_KV6 + 2 * KV6_STRIDE) + (size_t)bg * T_ * 64; const bf16* Vsl = (const bf16*)(ws + WS_KV6 + 3 * KV6_STRIDE) + (size_t)bg * T_ * 64;
    u32x4 kpre, vpre; attn_preload<64>(Ksl, nullptr, Vsl, cc, tid, kpre, vpre);
    const size_t n = (size_t)b * T_ + t_lane;
    const float gate_s = ((const float*)(ws + WS_GATE))[n * 24 + hd * 3 + 1];
    const bf16* oc = (const bf16*)(ws + WS_OCMP) + mix_off(n, hd * 64 + 4 * h, 512); const bf16* ow = (const bf16*)(ws + WS_OWIN) + mix_off(n, hd * 64 + 4 * h, 512);
    u64 ocv[8], owv[8];
    ATTN_FOR_CHUNKS(db, g4) { ocv[4 * db + g4] = *(const u64*)(oc + (4 * db + g4) * 256); owv[4 * db + g4] = *(const u64*)(ow + (4 * db + g4) * 256); }
    const u64* sel = (const u64*)(ws + WS_SEL) + (size_t)bg * T_;
    const u64 mine = sel[t_lane]; u64 un = sel[64 * cc + lane];
    { unsigned ul = (unsigned)un, uh = (unsigned)(un >> 32);
#pragma unroll
      for (int o = 1; o < 64; o <<= 1) { ul |= shflx_u(ul, o, lane); uh |= shflx_u(uh, o, lane); }
      un = ((u64)__builtin_amdgcn_readfirstlane(uh) << 32) | __builtin_amdgcn_readfirstlane(ul); }
#if AC2_MODE == 0
    attn_core<64, 1, false, true, true, NOMAX_ON>(L, Ksl, nullptr, Vsl, nullptr, 0.f,
                                  Qf, un, t_lane, tw0, 1 << 30, alibi_slope(hd + 1, 8) * LOG2E, (unsigned)mine, (unsigned)(mine >> 32), O, M, Ls, tid, false, cc, kpre, vpre);
    if (NOMAX_ON && block_any(sum_bad(Ls[0]), (LAS u64*)(L + A_LDS_END + 64), wave, lane)) {
#pragma unroll
        for (int i = 0; i < 16; ++i) { O[0][0][i] = 0.f; O[0][1][i] = 0.f; }
        M[0] = 0.f; Ls[0] = 0.f;
        attn_core<64, 1, false, true, false, false>(L, Ksl, nullptr, Vsl, nullptr, 0.f, Qf, un, t_lane, tw0, 1 << 30, alibi_slope(hd + 1, 8) * LOG2E, (unsigned)mine, (unsigned)(mine >> 32), O, M, Ls, tid);
    }
#else
    attn_core2<false, true>(L, (const bf16*)(ws + WS_KV6 + 2 * KV6_STRIDE) + (size_t)bg * T_ * 64, (const bf16*)(ws + WS_KV6 + 3 * KV6_STRIDE) + (size_t)bg * T_ * 64, nullptr, 0.f,
                            Qf[0], un, t_lane, tw0, 1 << 30, alibi_slope(hd + 1, 8) * LOG2E, (unsigned)mine, (unsigned)(mine >> 32), O[0], M[0], Ls[0], tid);
#endif
    const float lt = swap_sum(Ls[0]), inv = (lt > 0.f ? 1.f / lt : 0.f) * gate_s;
    bf16* dst = (bf16*)(ws + WS_ATT) + mix_off(n, hd * 64 + 4 * h, 1024);
    ATTN_FOR_CHUNKS(db, g4) { const u64 a = ocv[4 * db + g4], w = owv[4 * db + g4];
        const float x0 = O[0][db][4 * g4 + 0] * inv + __uint_as_float((unsigned)a << 16) + __uint_as_float((unsigned)w << 16);
        const float x1 = O[0][db][4 * g4 + 1] * inv + __uint_as_float((unsigned)a & 0xffff0000u) + __uint_as_float((unsigned)w & 0xffff0000u);
        const float x2 = O[0][db][4 * g4 + 2] * inv + __uint_as_float((unsigned)(a >> 32) << 16) + __uint_as_float((unsigned)(w >> 32) << 16);
        const float x3 = O[0][db][4 * g4 + 3] * inv + __uint_as_float((unsigned)(a >> 32) & 0xffff0000u) + __uint_as_float((unsigned)(w >> 32) & 0xffff0000u);
        *(u64*)(dst + (4 * db + g4) * 256) = (u64)cvtpk(x0, x1) | ((u64)cvtpk(x2, x3) << 32); }
}
__device__ __forceinline__ float other_half(float x, int h) { auto rr = __builtin_amdgcn_permlane32_swap(__float_as_uint(x), __float_as_uint(x), false, false); return __uint_as_float(h ? rr[0] : rr[1]); }
__device__ __forceinline__ int other_half_i(int x, int h) { auto rr = __builtin_amdgcn_permlane32_swap((unsigned)x, (unsigned)x, false, false); return (int)(h ? rr[0] : rr[1]); }
template <bool MASK>
__device__ __forceinline__ void cmp_scores(f32x16& p0, f32x16& p1, const LAS unsigned char* kt, const bf16x8v (&Qf)[4], float b0, float s1, int cl, int nvis_l) {
    const float s8 = s1 * 8.f, s32 = s1 * 32.f;
    p0[0] = b0; p0[1] = p0[0] + s1; p0[2] = p0[1] + s1; p0[3] = p0[2] + s1;
#pragma unroll
    for (int reg = 4; reg < 16; ++reg) p0[reg] = p0[reg - 4] + s8;
#pragma unroll
    for (int reg = 0; reg < 16; ++reg) p1[reg] = p0[reg] + s32;
#pragma unroll
    for (int s = 0; s < 4; ++s) { const bf16x8v kf0 = *(const LAS bf16x8v*)(kt + s * 32), kf1 = *(const LAS bf16x8v*)(kt + 32 * 144 + s * 32);
        p0 = __builtin_amdgcn_mfma_f32_32x32x16_bf16(kf0, Qf[s], p0, 0, 0, 0); p1 = __builtin_amdgcn_mfma_f32_32x32x16_bf16(kf1, Qf[s], p1, 0, 0, 0); }
    if (MASK) {
#pragma unroll
        for (int reg = 0; reg < 16; ++reg) { const int c = cl + crow0(reg); p0[reg] = (c < nvis_l) ? p0[reg] : -INFINITY; p1[reg] = (c + 32 < nvis_l) ? p1[reg] : -INFINITY; } }
}
__device__ __forceinline__ void U_cmp(KP p_, int bg_, int u_) {
    const KP p = uni_kp(p_); const int bg = __builtin_amdgcn_readfirstlane(bg_), uu = __builtin_amdgcn_readfirstlane(u_);
    int tid_ = threadIdx.x; asm volatile("" : "+v"(tid_));
    const int tid = tid_, lane = tid & 63, wave = __builtin_amdgcn_readfirstlane(tid >> 6), r = lane & 31, h = lane >> 5;
    unsigned char* ws = p->ws; asm volatile("" : "+s"(ws)); LAS unsigned char* L = (LAS unsigned char*)lds_raw;
    const int b = bg >> 1, g = bg & 1, tw0 = 32 * (uu + 16 * wave), t_lane = tw0 + r;
    { const bf16* kc = (const bf16*)(ws + WS_KVCMP) + (size_t)bg * 256 * 64; const bf16* vc = kc + 16 * 256 * 64;
#pragma unroll
      for (int i = 0; i < 4; ++i) { const int ch = tid + 512 * i, row = ch >> 3, c8 = ch & 7;
          *(LAS u32x4*)(L + row * 144 + c8 * 16) = *(const u32x4*)(kc + row * 64 + c8 * 8); *(LAS u32x4*)(L + 36864 + row * 144 + c8 * 16) = *(const u32x4*)(vc + row * 64 + c8 * 8); } }
    __syncthreads();
    const int nvis_l = t_lane >= 31 ? ((t_lane - 31) >> 4) + 1 : 0, nvis_max = (tw0 >> 4) + 1, nvis_min = tw0 >= 31 ? ((tw0 - 31) >> 4) + 1 : 0, ntile = (nvis_max + 63) >> 6;
    const LAS unsigned char* kfrag = L + r * 144 + h * 16;
    const LAS unsigned char* vfrag = L + 36864 + (4 * h + ((lane & 15) >> 2)) * 144 + (16 * ((lane >> 4) & 1) + 4 * (lane & 3)) * 2;
    float imp[32];
#pragma unroll
    for (int e = 0; e < 32; ++e) imp[e] = 0.f;
    const float* gate = (const float*)(ws + WS_GATE) + ((size_t)b * T_ + t_lane) * 24;
#pragma unroll 1
    for (int hg = 0; hg < 4; ++hg) {
        const int hd = g * 4 + hg; const float s1 = alibi_slope(hd + 1, 8) * LOG2E * 16.f;
        const bf16* q = (const bf16*)(ws + WS_QN) + (size_t)(b * 8 + hd) * T_ * 64 + (t_lane >> 4) * 1024 + (t_lane & 15) * 32 + 8 * h;
        bf16x8v Qf[4];
#pragma unroll
        for (int s = 0; s < 4; ++s) Qf[s] = *(const bf16x8v*)(q + (s >> 1) * 512 + (s & 1) * 16);
        float m = 0.f, lsum = 0.f;
#pragma unroll 1
        for (int jt = 0; jt < ntile; ++jt) {
            f32x16 p0, p1; const float b0 = s1 * (float)(64 * jt + 4 * h - nvis_max);
            if (64 * jt + 63 >= nvis_min) cmp_scores<true>(p0, p1, kfrag + jt * (64 * 144), Qf, b0, s1, 64 * jt + 4 * h, nvis_l);
            else cmp_scores<false>(p0, p1, kfrag + jt * (64 * 144), Qf, b0, s1, 64 * jt + 4 * h, nvis_l);
            float rs = 0.f;
#pragma unroll
            for (int reg = 0; reg < 16; ++reg) rs += __builtin_amdgcn_exp2f(p0[reg]) + __builtin_amdgcn_exp2f(p1[reg]);
            lsum += rs;
        }
#ifdef FORCE_FALLBACK
        if (true) {
#else
        if (__any(sum_bad(lsum))) {
#endif
        m = -1e30f; lsum = 0.f;
#pragma unroll 1
        for (int jt = 0; jt < ntile; ++jt) {
            f32x16 p0, p1; const float b0 = s1 * (float)(64 * jt + 4 * h - nvis_max);
            if (64 * jt + 63 >= nvis_min) cmp_scores<true>(p0, p1, kfrag + jt * (64 * 144), Qf, b0, s1, 64 * jt + 4 * h, nvis_l);
            else cmp_scores<false>(p0, p1, kfrag + jt * (64 * 144), Qf, b0, s1, 64 * jt + 4 * h, nvis_l);
            float mt = fmaxf(p0[0], p1[0]);
#pragma unroll
            for (int reg = 1; reg < 16; ++reg) mt = fmaxf(mt, fmaxf(p0[reg], p1[reg]));
            mt = swap_max(mt);
            const float mn = fmaxf(m, mt); float rs = 0.f;
#pragma unroll
            for (int reg = 0; reg < 16; ++reg) rs += __builtin_amdgcn_exp2f(p0[reg] - mn) + __builtin_amdgcn_exp2f(p1[reg] - mn);
            lsum = lsum * __builtin_amdgcn_exp2f(m - mn) + rs; m = mn;
        }
        }
        const float lt = swap_sum(lsum), cnorm = lt > 0.f ? m + __builtin_amdgcn_logf(lt) : 1e30f;
        f32x16 O0, O1;
#pragma unroll
        for (int i = 0; i < 16; ++i) { O0[i] = 0.f; O1[i] = 0.f; }
        float carry = 0.f;
#pragma unroll
        for (int jt = 0; jt < 4; ++jt) if (jt < ntile) {
            f32x16 p0, p1; const float b0 = s1 * (float)(64 * jt + 4 * h - nvis_max) - cnorm;
            if (64 * jt + 63 >= nvis_min) cmp_scores<true>(p0, p1, kfrag + jt * (64 * 144), Qf, b0, s1, 64 * jt + 4 * h, nvis_l);
            else cmp_scores<false>(p0, p1, kfrag + jt * (64 * 144), Qf, b0, s1, 64 * jt + 4 * h, nvis_l);
#pragma unroll
            for (int reg = 0; reg < 16; ++reg) { p0[reg] = __builtin_amdgcn_exp2f(p0[reg]); p1[reg] = __builtin_amdgcn_exp2f(p1[reg]); }
            float cv[8];
#pragma unroll
            for (int g4 = 0; g4 < 4; ++g4) { const float h0 = 0.5f * p0[4 * g4 + 3], h1 = 0.5f * p1[4 * g4 + 3];
                imp[jt * 8 + g4] += ((p0[4 * g4] + p0[4 * g4 + 1]) + p0[4 * g4 + 2]) + h0; imp[jt * 8 + 4 + g4] += ((p1[4 * g4] + p1[4 * g4 + 1]) + p1[4 * g4 + 2]) + h1;
                cv[g4] = h0; cv[4 + g4] = h1; }
            float prev = carry;
#pragma unroll
            for (int k = 0; k < 8; ++k) { const float sv = other_half(cv[k], h); imp[jt * 8 + k] += h ? sv : prev; prev = sv; }
            carry = prev;
            const bf16x8v pa0 = pack8(p0, 0), pa1 = pack8(p0, 8), pa2 = pack8(p1, 0), pa3 = pack8(p1, 8);
            const LAS unsigned char* vb = vfrag + jt * (64 * 144);
#pragma unroll
            for (int ks = 0; ks < 4; ++ks) { const bf16x8v pa = ks == 0 ? pa0 : ks == 1 ? pa1 : ks == 2 ? pa2 : pa3;
                { const s16x4 lo = tr_read(vb + ks * (16 * 144)), hi = tr_read(vb + ks * (16 * 144) + 8 * 144); const bf16x8v vf = {lo[0], lo[1], lo[2], lo[3], hi[0], hi[1], hi[2], hi[3]};
                  O0 = __builtin_amdgcn_mfma_f32_32x32x16_bf16(vf, pa, O0, 0, 0, 0); }
                { const s16x4 lo = tr_read(vb + ks * (16 * 144) + 64), hi = tr_read(vb + ks * (16 * 144) + 64 + 8 * 144); const bf16x8v vf = {lo[0], lo[1], lo[2], lo[3], hi[0], hi[1], hi[2], hi[3]};
                  O1 = __builtin_amdgcn_mfma_f32_32x32x16_bf16(vf, pa, O1, 0, 0, 0); } }
        }
        const float gt = gate[hd * 3 + 0];
        bf16* dst = (bf16*)(ws + WS_OCMP) + mix_off((size_t)b * T_ + t_lane, hd * 64 + 4 * h, 512);
#pragma unroll
        for (int g4 = 0; g4 < 4; ++g4) {
            *(u64*)(dst + g4 * 256) = (u64)cvtpk(O0[4 * g4 + 0] * gt, O0[4 * g4 + 1] * gt) | ((u64)cvtpk(O0[4 * g4 + 2] * gt, O0[4 * g4 + 3] * gt) << 32);
            *(u64*)(dst + (4 + g4) * 256) = (u64)cvtpk(O1[4 * g4 + 0] * gt, O1[4 * g4 + 1] * gt) | ((u64)cvtpk(O1[4 * g4 + 2] * gt, O1[4 * g4 + 3] * gt) << 32); }
    }
    const int cur = tw0 >> 6; u64 mask;
    if (cur <= 15) mask = (1ull << (cur + 1)) - 1ull;
    else {
        mask = 1ull | (1ull << cur) | (1ull << (cur - 1));
#pragma unroll
        for (int e = 0; e < 32; ++e) { const int j = 2 * e + h; if (j > cur || j == 0 || j >= cur - 1) imp[e] = -INFINITY; }
#pragma unroll 1
        for (int round = 0; round < 13; ++round) {
            float bv = imp[0]; int be = 0;
#pragma unroll
            for (int e = 1; e < 32; ++e) if (imp[e] > bv) { bv = imp[e]; be = e; }
            const int bj = 2 * be + h; const float ov = other_half(bv, h); const int oj = other_half_i(bj, h);
            const bool mine = bv > ov || (bv == ov && bj < oj);
            mask |= 1ull << (mine ? bj : oj);
#pragma unroll
            for (int e = 0; e < 32; ++e) imp[e] = (mine && e == be) ? -INFINITY : imp[e];
        }
    }
    if (h == 0) ((u64*)(ws + WS_SEL))[(size_t)bg * T_ + t_lane] = mask;
    __syncthreads();
}
constexpr int CONV_UNITS = L_ * NEXP * (2 * 16 * 8 + 4 * 32) / 32;
__device__ __forceinline__ void U_conv(KP p_, int k_) {
    const KP p = uni_kp(p_); const int k = __builtin_amdgcn_readfirstlane(k_);
    int tid_ = threadIdx.x; asm volatile("" : "+v"(tid_));
    const int tid = tid_, lane = tid & 63, wave = __builtin_amdgcn_readfirstlane(tid >> 6);
    unsigned char* ws = p->ws; asm volatile("" : "+s"(ws));
    LAS float* scr = (LAS float*)lds_raw + wave * (64 * 33);
    constexpr int I_G = 16 * 8, I_D = 4 * 32, I_E = 2 * I_G + I_D;
#pragma unroll 1
    for (int i = 0; i < 4; ++i) {
        const int m = k * 32 + i * 8 + wave, l = m / (NEXP * I_E); int r = m % (NEXP * I_E); const int e = r / I_E; r = r % I_E; const size_t le = (size_t)l * NEXP + e;
        const float* W; bf16* WT; int ldw, K, ncol, r0 = 0, rmul = 1; const float* gk = nullptr;
        if (r < 2 * I_G) { const int up = r >= I_G; r -= up * I_G; W = p->in[19 + up] + le * D_ * DEXP; WT = (bf16*)(ws + WS_WGU_T) + le * 512 * D_; ldw = DEXP; K = D_; ncol = 256; r0 = up; rmul = 2; gk = p->in[14] + (size_t)l * D_; }
        else { r -= 2 * I_G; W = p->in[21] + le * DEXP * D_; WT = (bf16*)(ws + WS_WD_T) + le * D_ * DEXP; ldw = D_; K = DEXP; ncol = 1024; }
        transpose_seg(W, ldw, K, 0, ncol, WT, r0, rmul, r, scr, lane, gk);
    }
}
__device__ __forceinline__ int fetch_unit(KP p, int qidx) {
    volatile LAS unsigned* slot = (volatile LAS unsigned*)((LAS unsigned char*)lds_raw + MISC_OFF) + 16;
    __syncthreads();
    int t0_ = threadIdx.x; asm volatile("" : "+v"(t0_));
    if (t0_ == 0) *slot = __hip_atomic_fetch_add((unsigned*)(p->ws + WS_CTL) + CW_QUEUE + 64 * qidx, 1u, __ATOMIC_RELAXED, __HIP_MEMORY_SCOPE_AGENT);
    __syncthreads();
    return (int)__builtin_amdgcn_readfirstlane(*slot);
}
__device__ __forceinline__ void P_cmp1_mfma(int l_) { const KP p = (KP)__builtin_amdgcn_kernarg_segment_ptr(); int l = l_; asm volatile("" : "+s"(l));
    unsigned char* ws = p->ws; asm volatile("" : "+s"(ws)); const int c = launder_s((int)blockIdx.x), kv = c >> 4, pm = c & 15;
    OneUnitOrder S; S.has = c < 32; S.u.pm = pm; S.u.pn = kv;
    S.u.a = (const char*)(ws + WS_KV6 + (size_t)kv * KV6_STRIDE) + (size_t)pm * 256 * 1024 * 2; S.u.b = (const char*)((const bf16*)(ws + WS_W1_T) + ((size_t)l * 2 + kv) * 256 * 2048); S.u.b2 = S.u.b;
    const pg8::Gemm g{1024, 2048, 2048, 32, 0, 0};
    const EpiCmpH E{(bf16*)(ws + WS_HC), (const float*)(ws + WS_BIAS1) + l * 512};
    pg8::gemm_phase<EpiCmpH, OneUnitOrder, false, true>((LAS unsigned char*)lds_raw, g, S, E);
}
__device__ __forceinline__ void P_cmp2_mfma(int l_) { const KP p = (KP)__builtin_amdgcn_kernarg_segment_ptr(); int l = l_; asm volatile("" : "+s"(l));
    unsigned char* ws = p->ws; asm volatile("" : "+s"(ws)); const int c = launder_s((int)blockIdx.x), kv = c >> 4, pm = c & 15;
    OneUnitOrder S; S.has = c < 32; S.u.pm = pm; S.u.pn = kv;
    S.u.a = (const char*)((const bf16*)(ws + WS_HC) + ((size_t)kv * 4096 + pm * 256) * 256); S.u.b = (const char*)((const bf16*)(ws + WS_W2_T) + ((size_t)l * 2 + kv) * 64 * 256); S.u.b2 = S.u.b;
    const pg8::Gemm g{256, 256, 256, 4, 0, 0};
    const EpiCmpOut E{(bf16*)(ws + WS_KVCMP)};
    pg8::gemm_phase<EpiCmpOut, OneUnitOrder, false, true>((LAS unsigned char*)lds_raw, g, S, E);
}
__device__ __forceinline__ void P_moe_scatter(KP p_, int l_) { const KP p = uni_kp(p_); const int l = __builtin_amdgcn_readfirstlane(l_); const Ctx c = make_ctx(p); unsigned char* ws = p->ws;
    const unsigned* cnt = (const unsigned*)(ws + WS_CTL) + CW_MOECNT + l * MOE_LS;
    moe_build_tables(cnt, c.tid);
    const LAS int* T = (const LAS int*)((LAS unsigned char*)lds_raw + TBL_OFF);
    const unsigned* info = (const unsigned*)(ws + WS_ROUTE + RT_INFO); const float* tw = (const float*)(ws + WS_ROUTE + RT_W);
    int* rowtok = (int*)(ws + WS_ROUTE + RT_ROWTOK); float* roww = (float*)(ws + WS_ROUTE + RT_ROWW);
    bf16* xs = (bf16*)(ws + WS_XS); const bf16* x = (const bf16*)(ws + WS_HN); const float* gain = p->in[14] + (size_t)l * D_; const float* rstdv = (const float*)(ws + WS_ROUTE + RT_RSTD);
    { constexpr int RB = 4; float gg[2][8];
#pragma unroll
      for (int j = 0; j < 2; ++j) { const f32x4 a = ((const f32x4*)gain)[2 * c.lane + 128 * j], b2 = ((const f32x4*)gain)[2 * c.lane + 128 * j + 1]; gg[j][0] = a.x; gg[j][1] = a.y; gg[j][2] = a.z; gg[j][3] = a.w; gg[j][4] = b2.x; gg[j][5] = b2.y; gg[j][6] = b2.z; gg[j][7] = b2.w; }
      for (int row0 = c.gw * RB; row0 < NT; row0 += c.ngw * RB) {
        u32x4 vv[RB][2];
#pragma unroll
        for (int q = 0; q < RB; ++q)
#pragma unroll
            for (int j = 0; j < 2; ++j) vv[q][j] = ((const u32x4*)(x + (size_t)(row0 + q) * D_))[c.lane + 64 * j];
#pragma unroll
        for (int q = 0; q < RB; ++q) { const int row = row0 + q;
            const unsigned v = info[row]; const int cls = (int)(v >> 24), rank = (int)(v & 0xffffffu); const size_t dest = (size_t)T[cls] * 256 + rank; const float r = rstdv[row];
#pragma unroll
            for (int j = 0; j < 2; ++j) { float f[8]; unpack8(vv[q][j], f); u32x4 o; o.x = pk2(f[0] * r * gg[j][0], f[1] * r * gg[j][1]); o.y = pk2(f[2] * r * gg[j][2], f[3] * r * gg[j][3]); o.z = pk2(f[4] * r * gg[j][4], f[5] * r * gg[j][5]); o.w = pk2(f[6] * r * gg[j][6], f[7] * r * gg[j][7]);
                ((u32x4*)(xs + dest * D_))[c.lane + 64 * j] = o; }
            if (c.lane == 0) { rowtok[dest] = row; roww[2 * dest] = tw[2 * row]; roww[2 * dest + 1] = tw[2 * row + 1]; } }
      } }
    for (int cls = c.bid; cls < 112; cls += c.G) { const int n = (int)cnt[cls * MOE_CS], end = (int)((cnt[cls * MOE_CS] + 255u) >> 8) * 256; const size_t base = (size_t)T[cls] * 256;
        for (int r = n + c.tid; r < end; r += NTHREADS) rowtok[base + r] = -1; }
}
__device__ __forceinline__ int xcd_major(int bid, int G) { bid = launder_s(bid); return (G & 7) ? bid : (bid & 7) * (G >> 3) + (bid >> 3); }
__device__ __forceinline__ void P_moe_g1(int l_) { const KP p = (KP)__builtin_amdgcn_kernarg_segment_ptr(); int l = l_; asm volatile("" : "+s"(l));
    unsigned char* ws = p->ws; asm volatile("" : "+s"(ws));
    { int t0_ = threadIdx.x; asm volatile("" : "+v"(t0_)); moe_build_tables((const unsigned*)(ws + WS_CTL) + CW_MOECNT + l * MOE_LS, t0_); }
    const MoeOrder1 S{(const char*)ws, (const unsigned*)(ws + WS_REC), (const char*)((const bf16*)(ws + WS_WGU_T) + (size_t)l * NEXP * 512 * D_), (unsigned*)(ws + WS_CTL) + CW_MOECNT + l * MOE_LS + (112 + NEXP) * MOE_CS, (int)gridDim.x, xcd_major((int)blockIdx.x, (int)gridDim.x)};
    const pg8::Gemm g{D_, D_, D_, D_ / 64, 0, 0};
    const EpiMoeH E{(bf16*)(ws + WS_HB), (const u32x4*)(ws + WS_REC)};
    pg8::gemm_phase<EpiMoeH, MoeOrder1, true, true, true>((LAS unsigned char*)lds_raw, g, S, E);
}
__device__ __forceinline__ void P_moe_g2(int l_) { const KP p = (KP)__builtin_amdgcn_kernarg_segment_ptr(); int l = l_; asm volatile("" : "+s"(l));
    unsigned char* ws = p->ws; asm volatile("" : "+s"(ws));
    { int t0_ = threadIdx.x; asm volatile("" : "+v"(t0_)); moe_build_tables((const unsigned*)(ws + WS_CTL) + CW_MOECNT + l * MOE_LS, t0_); }
    const MoeOrder2 S{(const char*)(ws + WS_HB), (const char*)((const bf16*)(ws + WS_WD_T) + (size_t)l * NEXP * D_ * DEXP), (const unsigned*)(ws + WS_CTL) + CW_MOECNT + l * MOE_LS + (112 + NEXP) * MOE_CS, (unsigned*)(ws + WS_CTL) + XB_TMO + 4096, (int)gridDim.x, xcd_major((int)blockIdx.x, (int)gridDim.x)};
    const pg8::Gemm g{512, DEXP, 512, 4, 16, 16};
    const EpiMoeOut E{(bf16*)(ws + WS_HN), (const unsigned*)(ws + WS_RECC)};
    pg8::gemm_phase<EpiMoeOut, MoeOrder2, true, true>((LAS unsigned char*)lds_raw, g, S, E);
}
__device__ __forceinline__ void P_norm1(KP p_, int l_) { const KP p = uni_kp(p_); const int l = __builtin_amdgcn_readfirstlane(l_); const Ctx c = make_ctx(p); const Bufs b = make_bufs(p->ws);
    if (l == 0) { const int i = c.bid * NTHREADS + c.tid; if (i < L_ * 2 * 256) { const float* part = (const float*)(p->ws + WS_B1PART) + (size_t)(i >> 8) * 128 * 256 + (i & 255); float a = 0.f;
        for (int k = 0; k < 128; ++k) a += part[(size_t)k * 256]; ((float*)(p->ws + WS_BIAS1))[i] = a; } }
    if (l == 0) ph_norm_bf16(c, p->in[0], p->in[1], (bf16*)p->out, (bf16*)(p->ws + WS_HN)); else ph_norm_bf16_from_bf16(c, (const bf16*)(p->ws + WS_HN), p->in[1] + (size_t)l * D_, (bf16*)p->out); }
__device__ __noinline__ void P_inproj(KP p_, int l_) { const KP p = uni_kp(p_); const int l = __builtin_amdgcn_readfirstlane(l_); const Ctx c = make_ctx(p); const Bufs b = make_bufs(p->ws);
    InProjOut o{b.QN, b.KV6, b.FQ, b.DQ, b.DV, b.GATE, b.FL, p->in[3] + l * 24, p->in[4] + l * 4};
    const bf16* A = b.HN;
    naive_gemm(c, NT, D_IN, D_, [=](int r, int k) { return bf2f(A[(size_t)r * D_ + k]); }, p->in[2] + (size_t)l * D_ * D_IN, D_IN,
               [=](int r, int col, float v) { inproj_store(o, r, col, v); }); }
__device__ __noinline__ void P_cmp1(KP p_, int l_, int kv_) { const KP p = uni_kp(p_); const int l = __builtin_amdgcn_readfirstlane(l_), kv = __builtin_amdgcn_readfirstlane(kv_); const Ctx c = make_ctx(p); const Bufs b = make_bufs(p->ws);
    const bf16* src = kv == 0 ? b.KC : b.VC; const float* pe = p->in[kv == 0 ? 5 : 8] + (size_t)l * 2048; bf16* hc = b.HC + (size_t)kv * 4096 * 256;
    naive_gemm(c, 4096, 256, 2048, [=](int r, int k) { return bf2f(src[(size_t)r * 1024 + k]) + pe[k]; }, p->in[kv == 0 ? 6 : 9] + (size_t)l * 2048 * 256, 256,
               [=](int r, int col, float v) { hc[(size_t)r * 256 + col] = (bf16)f2bf(gelu_tanh(v)); }); }
__device__ __noinline__ void P_cumsum(KP p_, int l_) { const KP p = uni_kp(p_); const int l = __builtin_amdgcn_readfirstlane(l_); const Ctx c = make_ctx(p); const Bufs b = make_bufs(p->ws); ph_cumsum(c, b.FL); }
__device__ __noinline__ void P_cmp2(KP p_, int l_, int kv_) { const KP p = uni_kp(p_); const int l = __builtin_amdgcn_readfirstlane(l_), kv = __builtin_amdgcn_readfirstlane(kv_); const Ctx c = make_ctx(p); const Bufs b = make_bufs(p->ws);
    const bf16* hc = b.HC + (size_t)kv * 4096 * 256; bf16* dst = kv == 0 ? b.KCMP : b.VCMP;
    naive_gemm(c, 4096, 64, 256, [=](int r, int k) { return bf2f(hc[(size_t)r * 256 + k]); }, p->in[kv == 0 ? 7 : 10] + (size_t)l * 256 * 64, 64,
               [=](int r, int col, float v) { dst[(size_t)r * 64 + col] = (bf16)f2bf((r & 255) == 255 ? 0.f : v); }); }
__device__ __noinline__ void P_win(KP p_, int l_) { const KP p = uni_kp(p_); const int l = __builtin_amdgcn_readfirstlane(l_); const Ctx c = make_ctx(p); const Bufs b = make_bufs(p->ws); ph_win_attn(c, b.QN, b.KW, b.VW, b.GATE, b.OWIN); }
__device__ __noinline__ void P_fox(KP p_, int l_) { const KP p = uni_kp(p_); const int l = __builtin_amdgcn_readfirstlane(l_); const Ctx c = make_ctx(p); const Bufs b = make_bufs(p->ws); ph_fox_attn(c, b.FQ, b.FK, b.FV, b.FL, b.ATT); }
__device__ __noinline__ void P_diff(KP p_, int l_) { const KP p = uni_kp(p_); const int l = __builtin_amdgcn_readfirstlane(l_); const Ctx c = make_ctx(p); const Bufs b = make_bufs(p->ws);
    ph_diff_attn(c, b.DQ, b.DK, b.DV, p->in[11] + (size_t)l * 128, p->in[12] + (size_t)l * 64, lambda_init_of(l), b.ATT); }
__device__ __noinline__ void P_cmpattn(KP p_, int l_) { const KP p = uni_kp(p_); const int l = __builtin_amdgcn_readfirstlane(l_); const Ctx c = make_ctx(p); const Bufs b = make_bufs(p->ws); ph_cmp_attn(c, b.QN, b.KCMP, b.VCMP, b.GATE, b.SEL, b.OCMP); }
__device__ __noinline__ void P_slc(KP p_, int l_) { const KP p = uni_kp(p_); const int l = __builtin_amdgcn_readfirstlane(l_); const Ctx c = make_ctx(p); const Bufs b = make_bufs(p->ws); ph_slc_attn(c, b.QN, b.KS, b.VS, b.GATE, b.SEL, b.OCMP, b.OWIN, b.ATT); }
__device__ __noinline__ void P_outproj(KP p_, int l_) { const KP p = uni_kp(p_); const int l = __builtin_amdgcn_readfirstlane(l_); const Ctx c = make_ctx(p); const Bufs b = make_bufs(p->ws);
    const bf16* A = b.ATT; float* xo = p->out; const float* xin = (l == 0) ? p->in[0] : p->out;
    naive_gemm(c, NT, D_, D_, [=](int r, int k) { return bf2f(A[(size_t)r * D_ + k]); }, p->in[13] + (size_t)l * D_ * D_, D_,
               [=](int r, int col, float v) { xo[(size_t)r * D_ + col] = xin[(size_t)r * D_ + col] + v; }); }
__device__ __forceinline__ void P_route3(int l_, int cbank) { const KP p = (KP)__builtin_amdgcn_kernarg_segment_ptr(); int l = l_; asm volatile("" : "+s"(l));
    int tid_ = threadIdx.x; asm volatile("" : "+v"(tid_));
    const int tid = tid_, lane = tid & 63, wave = __builtin_amdgcn_readfirstlane(tid >> 6), r = lane & 31, h = lane >> 5, kh = wave >> 2, wr = wave & 3;
    unsigned char* ws = p->ws; asm volatile("" : "+s"(ws)); const bf16* x = (const bf16*)(ws + WS_HN);
    const float* WR = (const float*)(ws + WS_WR) + (size_t)l * D_ * 64;
    LAS float* XT = (LAS float*)lds_raw + wave * (32 * 36);
    LAS float* WT = (LAS float*)lds_raw + 8 * 32 * 36 + kh * (2 * 32 * 64);
    LAS float* PL = (LAS float*)lds_raw + 8 * 32 * 36 + 2 * 2 * 32 * 64;
    LAS float* SS = PL + 2 * 128 * 40;
    const float* bgrp = p->in[16] + l * 4; const float* bexp = p->in[18] + l * 32;
    unsigned* cnt = (unsigned*)(ws + WS_CTL) + CW_MOECNT + l * MOE_LS + cbank;
    LAS unsigned* HIST = (LAS unsigned*)(SS + 2 * 128 * 2);
    for (int grp = launder_s((int)blockIdx.x); grp < NT / 128; grp += (int)gridDim.x) {
        const int row0 = grp * 128 + wr * 32;
        if (tid < 144) HIST[tid] = 0u;
        f32x16 acc0, acc1; float ss = 0.f;
#pragma unroll
        for (int i = 0; i < 16; ++i) { acc0[i] = 0.f; acc1[i] = 0.f; }
        { const u32x4* xsrc = (const u32x4*)(x + (size_t)(row0 + r) * D_ + kh * 512 + 8 * h);
          const u32x4* wsrc = (const u32x4*)(ws + WS_WR) + ((size_t)l * 64 + kh * 32) * 256 + lane;
#pragma unroll 4
          for (int ks = 0; ks < 32; ++ks) {
              const u32x4 av = xsrc[2 * ks], b0h = wsrc[ks * 256], b0l = wsrc[ks * 256 + 64], b1h = wsrc[ks * 256 + 128], b1l = wsrc[ks * 256 + 192];
              { float f_[8]; unpack8(av, f_);
#pragma unroll
                for (int e = 0; e < 8; ++e) ss = fmaf(f_[e], f_[e], ss); }
              const bf16x8v A = __builtin_bit_cast(bf16x8v, av);
              acc0 = __builtin_amdgcn_mfma_f32_32x32x16_bf16(A, __builtin_bit_cast(bf16x8v, b0h), acc0, 0, 0, 0); acc1 = __builtin_amdgcn_mfma_f32_32x32x16_bf16(A, __builtin_bit_cast(bf16x8v, b1h), acc1, 0, 0, 0);
              acc0 = __builtin_amdgcn_mfma_f32_32x32x16_bf16(A, __builtin_bit_cast(bf16x8v, b0l), acc0, 0, 0, 0); acc1 = __builtin_amdgcn_mfma_f32_32x32x16_bf16(A, __builtin_bit_cast(bf16x8v, b1l), acc1, 0, 0, 0);
          } }
#pragma unroll
        for (int reg = 0; reg < 16; ++reg) { const int row = wr * 32 + crow0(reg) + 4 * h; PL[(kh * 128 + row) * 40 + r] = acc0[reg]; if (r < 4) PL[(kh * 128 + row) * 40 + 32 + r] = acc1[reg]; }
        SS[(kh * 128 + wr * 32 + r) * 2 + h] = ss;
        __syncthreads();
        int cls = 0, ea = 0, eb = 0; unsigned lrank = 0u, lra = 0u, lrb = 0u; float wlo = 0.f, whi = 0.f, rstd = 0.f;
        if (tid < 128) {
            float lg[36];
#pragma unroll
            for (int cidx = 0; cidx < 36; ++cidx) lg[cidx] = PL[tid * 40 + cidx] + PL[(128 + tid) * 40 + cidx];
            const float sq = (SS[tid * 2] + SS[tid * 2 + 1]) + (SS[(128 + tid) * 2] + SS[(128 + tid) * 2 + 1]);
            rstd = rsqrtf(sq * (1.f / D_) + EPS);
            float gl[4]; int grp_i = 0;
#pragma unroll
            for (int q = 0; q < 4; ++q) gl[q] = lg[q] * rstd + bgrp[q];
            float gm = gl[0];
#pragma unroll
            for (int q = 1; q < 4; ++q) if (gl[q] > gm) { gm = gl[q]; grp_i = q; }
            float gs = 0.f;
#pragma unroll
            for (int q = 0; q < 4; ++q) gs += __expf(gl[q] - gm);
            const float grp_gate = 1.f / gs;
            float el[8];
#pragma unroll
            for (int q = 0; q < 8; ++q) { float v = lg[4 + q]; float bb = bexp[q];
                if (grp_i == 1) { v = lg[12 + q]; bb = bexp[8 + q]; } else if (grp_i == 2) { v = lg[20 + q]; bb = bexp[16 + q]; } else if (grp_i == 3) { v = lg[28 + q]; bb = bexp[24 + q]; }
                el[q] = v * rstd + bb; }
            int i0 = 0; float v0 = el[0];
#pragma unroll
            for (int q = 1; q < 8; ++q) if (el[q] > v0) { v0 = el[q]; i0 = q; }
            int i1 = -1; float v1 = -INFINITY;
#pragma unroll
            for (int q = 0; q < 8; ++q) if (q != i0 && el[q] > v1) { v1 = el[q]; i1 = q; }
            const float e1 = __expf(v1 - v0), den = 1.f + e1, w0 = grp_gate / den, w1 = grp_gate * e1 / den;
            const int lo = i0 < i1 ? i0 : i1, hi = i0 < i1 ? i1 : i0; cls = grp_i * 28 + lo * 8 - (lo * (lo + 1)) / 2 + (hi - lo - 1);
            wlo = i0 < i1 ? w0 : w1; whi = i0 < i1 ? w1 : w0;
            ea = grp_i * 8 + lo; eb = grp_i * 8 + hi;
            lrank = __hip_atomic_fetch_add(HIST + cls, 1u, __ATOMIC_RELAXED, __HIP_MEMORY_SCOPE_WORKGROUP);
            lra = __hip_atomic_fetch_add(HIST + 112 + ea, 1u, __ATOMIC_RELAXED, __HIP_MEMORY_SCOPE_WORKGROUP); lrb = __hip_atomic_fetch_add(HIST + 112 + eb, 1u, __ATOMIC_RELAXED, __HIP_MEMORY_SCOPE_WORKGROUP);
        }
        __syncthreads();
        if (tid < 144) { const unsigned n = HIST[tid]; if (n) HIST[144 + tid] = __hip_atomic_fetch_add(cnt + tid * MOE_CS, n, __ATOMIC_RELAXED, __HIP_MEMORY_SCOPE_AGENT); }
        __syncthreads();
        if (tid < 128) {
            const unsigned rank = HIST[144 + cls] + lrank, ra = HIST[144 + 112 + ea] + lra, rb = HIST[144 + 112 + eb] + lrb;
            const int row = grp * 128 + tid;
            ((unsigned*)(ws + WS_RECC))[(size_t)cls * 32768 + rank] = (unsigned)row;
            const unsigned info = ((unsigned)cls << 16) | rank;
            ((u32x4*)(ws + WS_REC))[(size_t)ea * 32768 + ra] = (u32x4){(unsigned)row, __float_as_uint(wlo), __float_as_uint(rstd), info};
            ((u32x4*)(ws + WS_REC))[(size_t)eb * 32768 + rb] = (u32x4){(unsigned)row, __float_as_uint(whi), __float_as_uint(rstd), info | 0x8000u};
        }
        __syncthreads();
    }
}
typedef float f32x8 __attribute__((ext_vector_type(8)));
__device__ __forceinline__ void P_route2(int l_, int cbank) { const KP p = (KP)__builtin_amdgcn_kernarg_segment_ptr(); int l = l_; asm volatile("" : "+s"(l));
    int tid_ = threadIdx.x; asm volatile("" : "+v"(tid_));
    const int tid = tid_, lane = tid & 63, wave = __builtin_amdgcn_readfirstlane(tid >> 6);
    unsigned char* ws = p->ws; asm volatile("" : "+s"(ws)); const float* x = p->out;
    const float* WR = (const float*)(ws + WS_WR) + (size_t)l * D_ * 40;
    LAS float* xt = (LAS float*)lds_raw + wave * (64 * 36);
    LAS float* part = (LAS float*)lds_raw;
    const float* bgrp = p->in[16] + l * 4; const float* bexp = p->in[18] + l * 32;
    unsigned* cnt = (unsigned*)(ws + WS_CTL) + CW_MOECNT + l * 128 + cbank;
    for (int grp = launder_s((int)blockIdx.x); grp < NT / 128; grp += (int)gridDim.x) {
        const int row0 = grp * 128 + (wave >> 2) * 64, kq = wave & 3;
        float acc[40]; float ss = 0.f;
#pragma unroll
        for (int cidx = 0; cidx < 40; ++cidx) acc[cidx] = 0.f;
#pragma unroll 1
        for (int kc = 0; kc < 8; ++kc) {
            const int k0 = kq * 256 + kc * 32;
#pragma unroll
            for (int i = 0; i < 8; ++i) { const int row = i * 8 + (lane >> 3), c4 = (lane & 7) * 4; *(LAS f32x4*)(xt + row * 36 + c4) = *(const f32x4*)(x + (size_t)(row0 + row) * D_ + k0 + c4); }
            float xr[32];
#pragma unroll
            for (int j = 0; j < 8; ++j) { const f32x4 t = *(const LAS f32x4*)(xt + lane * 36 + 4 * j); xr[4 * j] = t.x; xr[4 * j + 1] = t.y; xr[4 * j + 2] = t.z; xr[4 * j + 3] = t.w; }
            const float* wk = WR + (size_t)k0 * 40;
#pragma unroll
            for (int kk = 0; kk < 32; ++kk) {
                f32x8 w0, w1, w2, w3, w4;
                asm volatile("s_load_dwordx8 %0, %5, %6\n\ts_load_dwordx8 %1, %5, %7\n\ts_load_dwordx8 %2, %5, %8\n\ts_load_dwordx8 %3, %5, %9\n\ts_load_dwordx8 %4, %5, %10\n\ts_waitcnt lgkmcnt(0)"
                             : "=&s"(w0), "=&s"(w1), "=&s"(w2), "=&s"(w3), "=&s"(w4) : "s"(wk), "i"(kk * 160), "i"(kk * 160 + 32), "i"(kk * 160 + 64), "i"(kk * 160 + 96), "i"(kk * 160 + 128) : "memory");
                const float xv = xr[kk]; ss = fmaf(xv, xv, ss);
#pragma unroll
                for (int e = 0; e < 8; ++e) { acc[e] = fmaf(xv, w0[e], acc[e]); acc[8 + e] = fmaf(xv, w1[e], acc[8 + e]); acc[16 + e] = fmaf(xv, w2[e], acc[16 + e]); acc[24 + e] = fmaf(xv, w3[e], acc[24 + e]); }
#pragma unroll
                for (int e = 0; e < 4; ++e) acc[32 + e] = fmaf(xv, w4[e], acc[32 + e]);
            }
        }
        __syncthreads();
#pragma unroll
        for (int cidx = 0; cidx < 36; ++cidx) part[(wave * 64 + lane) * 37 + cidx] = acc[cidx];
        part[(wave * 64 + lane) * 37 + 36] = ss;
        __syncthreads();
        if (tid < 128) {
            const int rg = tid >> 6, rr = tid & 63; float lg[37];
#pragma unroll
            for (int cidx = 0; cidx < 37; ++cidx) lg[cidx] = ((part[((rg * 4 + 0) * 64 + rr) * 37 + cidx] + part[((rg * 4 + 1) * 64 + rr) * 37 + cidx]) + part[((rg * 4 + 2) * 64 + rr) * 37 + cidx]) + part[((rg * 4 + 3) * 64 + rr) * 37 + cidx];
            const float rstd = rsqrtf(lg[36] * (1.f / D_) + EPS);
            float gl[4]; int grp_i = 0;
#pragma unroll
            for (int q = 0; q < 4; ++q) gl[q] = lg[q] * rstd + bgrp[q];
            float gm = gl[0];
#pragma unroll
            for (int q = 1; q < 4; ++q) if (gl[q] > gm) { gm = gl[q]; grp_i = q; }
            float gs = 0.f;
#pragma unroll
            for (int q = 0; q < 4; ++q) gs += __expf(gl[q] - gm);
            const float grp_gate = 1.f / gs;
            float el[8];
#pragma unroll
            for (int q = 0; q < 8; ++q) { float v = lg[4 + q]; float bb = bexp[q];
                if (grp_i == 1) { v = lg[12 + q]; bb = bexp[8 + q]; } else if (grp_i == 2) { v = lg[20 + q]; bb = bexp[16 + q]; } else if (grp_i == 3) { v = lg[28 + q]; bb = bexp[24 + q]; }
                el[q] = v * rstd + bb; }
            int i0 = 0; float v0 = el[0];
#pragma unroll
            for (int q = 1; q < 8; ++q) if (el[q] > v0) { v0 = el[q]; i0 = q; }
            int i1 = -1; float v1 = -INFINITY;
#pragma unroll
            for (int q = 0; q < 8; ++q) if (q != i0 && el[q] > v1) { v1 = el[q]; i1 = q; }
            const float e1 = __expf(v1 - v0), den = 1.f + e1, w0 = grp_gate / den, w1 = grp_gate * e1 / den;
            const int lo = i0 < i1 ? i0 : i1, hi = i0 < i1 ? i1 : i0, cls = grp_i * 28 + lo * 8 - (lo * (lo + 1)) / 2 + (hi - lo - 1);
            const unsigned rank = __hip_atomic_fetch_add(cnt + cls, 1u, __ATOMIC_RELAXED, __HIP_MEMORY_SCOPE_AGENT);
            const int row = grp * 128 + tid;
            ((unsigned*)(ws + WS_ROUTE + RT_INFO))[row] = ((unsigned)cls << 24) | rank;
            ((float*)(ws + WS_ROUTE + RT_W))[2 * row] = i0 < i1 ? w0 : w1; ((float*)(ws + WS_ROUTE + RT_W))[2 * row + 1] = i0 < i1 ? w1 : w0;
            ((float*)(ws + WS_ROUTE + RT_RSTD))[row] = rstd;
        }
        __syncthreads();
    }
}
__device__ __noinline__ void P_route(KP p_, int l_) { const KP p = uni_kp(p_); const int l = __builtin_amdgcn_readfirstlane(l_); const Ctx c = make_ctx(p); const Bufs b = make_bufs(p->ws);
    ph_moe_route(c, p->out, p->in[14] + (size_t)l * D_, p->in[15] + (size_t)l * D_ * 4, p->in[16] + l * 4, p->in[17] + (size_t)l * D_ * 32, p->in[18] + l * 32, b.HN, (int*)(p->ws + WS_ROUTE + RT_INFO), (float*)(p->ws + WS_ROUTE + RT_W), (unsigned*)(p->ws + WS_CTL) + CW_MOECNT + l * 128); }
__device__ __noinline__ void P_moe(KP p_, int l_) { const KP p = uni_kp(p_); const int l = __builtin_amdgcn_readfirstlane(l_); const Ctx c = make_ctx(p); const Bufs b = make_bufs(p->ws);
    ph_moe_naive(c, b.HN, b.ROUTE_E, b.ROUTE_W, p->in[19] + (size_t)l * NEXP * D_ * DEXP, p->in[20] + (size_t)l * NEXP * D_ * DEXP, p->in[21] + (size_t)l * NEXP * DEXP * D_, p->out); }
__device__ __noinline__ void P_final(KP p_) { const KP p = uni_kp(p_); const Ctx c = make_ctx(p); ph_norm_final_from_bf16(c, (const bf16*)(p->ws + WS_HN), p->in[22], p->out); }
__device__ __forceinline__ void P_gridbar(KP p_) { const KP p = uni_kp(p_);
    XcdBarrier bar; bar.bar = (unsigned*)(p->ws + WS_CTL) + 4096; bar.x = xb_xcc_id(); bar.st = (volatile LAS unsigned*)((LAS unsigned char*)lds_raw + MISC_OFF) + 8;
    xcd_barrier(bar);
}

__global__ void __launch_bounds__(NTHREADS, 2) fwd_kernel(Params pp) {
    const KP p = (KP)__builtin_amdgcn_kernarg_segment_ptr();
    { volatile LAS unsigned* MISC = (volatile LAS unsigned*)((LAS unsigned char*)lds_raw + MISC_OFF); if (threadIdx.x < 32) MISC[threadIdx.x] = 0u; }
    __syncthreads();
    const int lo = p->ph_lo, hi = p->ph_hi;
    if (hi - lo > 1) (void)xcd_barrier_post((unsigned*)(p->ws + WS_CTL) + 4096, (volatile LAS unsigned*)((LAS unsigned char*)lds_raw + MISC_OFF) + 8);
#define IN(k) (lo <= (k) && (k) < hi)
#define SEAM(k) do { if (IN(k) && IN((k) + 1)) P_gridbar(p); } while (0)
    if (IN(0)) { for (int rep = 0; rep < REP_PRO; ++rep) { if (rep) P_gridbar(p); P_prologue(p); } }
    SEAM(0);
    for (int l = 0; l < L_; ++l) {
        const int P0 = 1 + l * PH_PER_LAYER;
        if (IN(P0 + 0)) { for (int rep = 0; rep < REP_NORM; ++rep) { if (rep) P_gridbar(p); P_norm1(p, l); } }
        SEAM(P0 + 0);
        if (IN(P0 + 1)) { for (int rep = 0; rep < REP_INPROJ; ++rep) { if (rep) P_gridbar(p); P_inproj_mfma(l); }
#ifdef REP_INDUMMY
            for (int rep = 0; rep < REP_INDUMMY; ++rep) { P_gridbar(p); P_inproj_dummy(l); }
#endif
        }
        SEAM(P0 + 1);
        if (IN(P0 + 3)) {
            P_cmp1_mfma(l);
            if (launder_s((int)blockIdx.x) < 32) { asm volatile("s_waitcnt vmcnt(0)" ::: "memory"); __builtin_amdgcn_fence(__ATOMIC_SEQ_CST, "agent"); asm volatile("s_waitcnt vmcnt(0)" ::: "memory"); }
            __syncthreads();
            P_cmp2_mfma(l);
            for (int rep = 0; rep < REP_ATT3; ++rep) { if (rep) P_gridbar(p);
            for (;;) { int u = fetch_unit(p, l * 8 + 0 + 16 * rep);
                if (l == 0) {
                    if (u >= 2048 + CONV_UNITS) break;
                    const int k11 = u / 11, r11 = u - 11 * k11;
                    if (r11 == 3 || r11 == 7 || r11 == 10) { U_conv(p, 3 * k11 + (r11 > 3) + (r11 > 7)); continue; }
                    u = 8 * k11 + r11 - (r11 > 3) - (r11 > 7); }
                else if (u >= 2048) break;
                if (u < 1024) { const int qb = 15 - (u >> 6), k = u & 63; if (k < 32) U_diff(p, k, qb, l); else U_fox(p, k - 32, qb, l); }
                else { const int w = u - 1024; U_win(p, w & 15, 63 - (w >> 4));
#ifdef PROBE_WINUNIT2
                    U_win(p, w & 15, 63 - (w >> 4));
#endif
                } } } }
        SEAM(P0 + 3);
        if (IN(P0 + 4)) { for (int rep = 0; rep < REP_CMP; ++rep) { if (rep) P_gridbar(p); for (int u = launder_s((int)blockIdx.x); u < 256; u += (int)gridDim.x) U_cmp(p, u & 15, u >> 4); } }
        SEAM(P0 + 4);
        if (IN(P0 + 5)) { for (int rep = 0; rep < REP_SLC; ++rep) { if (rep) P_gridbar(p); for (;;) { const int u = fetch_unit(p, l * 8 + 1 + 16 * rep); if (u >= 1024) break; U_slc(p, u & 15, 63 - (u >> 4)); } } }
        SEAM(P0 + 5);
        if (IN(P0 + 6)) P_outproj_mfma(l);
        SEAM(P0 + 6);
        if (IN(P0 + 7)) { for (int rep = 0; rep < REP_ROUTE; ++rep) { if (rep) P_gridbar(p); P_route3(l, REP_ROUTE - 1 - rep); } }
        SEAM(P0 + 7);
        if (IN(P0 + 9)) { for (int rep = 0; rep < REP_G1; ++rep) { if (rep) P_gridbar(p); P_moe_g1(l); } }
        if (IN(P0 + 10)) P_moe_g2(l);
        SEAM(P0 + 10);
    }
    if (IN(1 + L_ * PH_PER_LAYER)) P_final(p);
#undef IN
#undef SEAM
}

extern "C" void kernel_launch(void* const* d_in, const int* in_sizes, int n_in, void* d_out, int out_size, void* d_ws, size_t ws_size, hipStream_t stream) {
    static int grid = 0;
    if (grid == 0) {
        if (n_in != 23 || out_size != NT * D_ || ws_size < WS_END) { fprintf(stderr, "kernel_launch: unexpected sizes n_in %d out %d ws %zu (need %zu)\n", n_in, out_size, ws_size, (size_t)WS_END); grid = -1; return; }
        int dev = 0, cus = 0, per_cu = 0;
        if (hipGetDevice(&dev) != hipSuccess || hipDeviceGetAttribute(&cus, hipDeviceAttributeMultiprocessorCount, dev) != hipSuccess) { grid = -1; return; }
        if (hipFuncSetAttribute((const void*)fwd_kernel, hipFuncAttributeMaxDynamicSharedMemorySize, LDS_BYTES) != hipSuccess) { fprintf(stderr, "kernel_launch: hipFuncSetAttribute failed\n"); grid = -1; return; }
        if (hipOccupancyMaxActiveBlocksPerMultiprocessor(&per_cu, (const void*)fwd_kernel, NTHREADS, LDS_BYTES) != hipSuccess || per_cu < 1) { fprintf(stderr, "kernel_launch: occupancy query says %d\n", per_cu); }
        (void)hipGetLastError();
        grid = cus;
    }
    if (grid < 0) return;
    (void)hipMemsetAsync((char*)d_ws + WS_CTL, 0, CTL_BYTES, stream);
    Params p{};
    for (int i = 0; i < 23; ++i) p.in[i] = (const float*)d_in[i];
    p.out = (float*)d_out; p.ws = (unsigned char*)d_ws;
#if N_LAUNCH_MODE == 0
    p.ph_lo = 0; p.ph_hi = N_PHASES;
    hipLaunchKernelGGL(fwd_kernel, dim3(grid), dim3(NTHREADS), LDS_BYTES, stream, p);
#else
    for (int k = 0; k < N_PHASES; ++k) { p.ph_lo = k; p.ph_hi = k + 1; hipLaunchKernelGGL(fwd_kernel, dim3(grid), dim3(NTHREADS), LDS_BYTES, stream, p); }
#endif
}
```

```cpp
#include <hip/hip_runtime.h>
#include <cstdio>
#include <cstdint>

#ifndef INPROJ_ALIGN
#define INPROJ_ALIGN true
#endif
#ifndef INPROJ_SP2
#define INPROJ_SP2 true
#endif
#ifndef REP_PRO
#define REP_PRO 1
#endif
#ifndef REP_ROUTE
#define REP_ROUTE 1
#endif
#ifndef REP_NORM
#define REP_NORM 1
#endif
#ifndef REP_INPROJ
#define REP_INPROJ 1
#endif
#ifndef REP_ATT3
#define REP_ATT3 1
#endif
#ifndef REP_CMP
#define REP_CMP 1
#endif
#ifndef REP_SLC
#define REP_SLC 1
#endif
#ifndef REP_SCAT
#define REP_SCAT 1
#endif
#ifndef REP_G1
#define REP_G1 1
#endif
#ifndef N_LAUNCH_MODE
#define N_LAUNCH_MODE 0
#endif

#ifndef NOMAX_ON
#define NOMAX_ON true
#endif
#define LAS __attribute__((address_space(3)))
#define GAS __attribute__((address_space(1)))
typedef unsigned short bf16;
typedef unsigned long long u64;
typedef float f32x4 __attribute__((ext_vector_type(4)));
typedef unsigned u32x4 __attribute__((ext_vector_type(4)));

constexpr int B_ = 8, T_ = 4096, D_ = 1024, NT = B_ * T_, L_ = 2;
constexpr int HD = 64, D_IN = 2844;
constexpr int N_CMP = 255, CMP_HID = 256;
constexpr int NEXP = 32, DEXP = 256;
constexpr float EPS = 1e-6f;
constexpr float LOG2E = 1.4426950408889634f;
constexpr int NWAVES = 8, NTHREADS = 512;

constexpr int C_NSAQ = 0, C_KV6 = 512, C_GATE = 1280, C_FQ = 1304, C_FF = 2072, C_DQ = 2076, C_DV = 2588;

constexpr size_t MiB = 1u << 20;
constexpr size_t WS_CTL = 0, CTL_BYTES = 1 * MiB;
constexpr size_t WS_QN = 1 * MiB;
constexpr size_t WS_KV6 = WS_QN + 32 * MiB;
constexpr size_t KV6_STRIDE = 8 * MiB + 64 * 1024;
constexpr size_t WS_FQKV = WS_KV6 + 6 * KV6_STRIDE;
constexpr size_t WS_DQK = WS_FQKV + 48 * MiB;
constexpr size_t WS_DV = WS_DQK + 32 * MiB;
constexpr size_t WS_GATE = WS_DV + 16 * MiB;
constexpr size_t WS_FL = WS_GATE + 3 * MiB;
constexpr size_t WS_HC = WS_FL + 1 * MiB;
constexpr size_t WS_KVCMP = WS_HC + 4 * MiB;
constexpr size_t WS_SEL = WS_KVCMP + 1 * MiB;
constexpr size_t WS_OCMP = WS_SEL + 1 * MiB;
constexpr size_t WS_OWIN = WS_OCMP + 32 * MiB;
constexpr size_t WS_HN = WS_OWIN + 32 * MiB;
constexpr size_t WS_ATT = WS_HN + 64 * MiB;
constexpr size_t WS_ROUTE = WS_ATT + 64 * MiB;
constexpr size_t WS_WIN_T = WS_ROUTE + 2 * MiB;
constexpr size_t WS_WOUT_T = WS_WIN_T + 12 * MiB;
constexpr size_t WS_WGU_T = WS_WOUT_T + 4 * MiB;
constexpr size_t WS_WD_T = WS_WGU_T + 64 * MiB;
constexpr size_t WS_W1_T = WS_WD_T + 32 * MiB;
constexpr size_t WS_W2_T = WS_W1_T + 4 * MiB;
constexpr size_t WS_BIAS1 = WS_W2_T + 512 * 1024;
constexpr size_t WS_WR = WS_BIAS1 + 512 * 1024;
constexpr size_t WS_B1PART = WS_WR + 512 * 1024;
constexpr size_t WS_END = WS_B1PART + 512 * 1024;
constexpr int MOE_MAXROWS = 61440;
constexpr size_t WS_XS = WS_QN;
constexpr size_t WS_HB = WS_OCMP;
static_assert(WS_XS + (size_t)MOE_MAXROWS * 2048 <= WS_DQK && WS_HB + (size_t)MOE_MAXROWS * 1024 <= WS_HN, "MoE aliases");
constexpr size_t RT_INFO = 0, RT_W = 128 * 1024, RT_ROWTOK = 384 * 1024, RT_ROWW = 640 * 1024, RT_RSTD = 1152 * 1024;
constexpr int CW_QUEUE = 16384, CW_MOECNT = 32768, CW_KN = 49152, MOE_CS = 32, MOE_LS = 8192;
constexpr size_t WS_REC = WS_QN;
constexpr size_t WS_RECC = WS_REC + (size_t)NEXP * 32768 * 16;
constexpr unsigned ZROW_OFF = 512 * 1024;
static_assert(WS_RECC + (size_t)112 * 32768 * 4 <= WS_DQK && WS_HN + (size_t)NT * 2048 < (1ull << 32) && CW_MOECNT + L_ * MOE_LS <= CW_KN && (112 + 2 * NEXP) * MOE_CS <= MOE_LS, "MoE record tables / 32-bit row offsets / counters");
constexpr int TBL_OFF = 131072 + 1024;
constexpr int NIN = 3072;

extern __shared__ __attribute__((aligned(16))) unsigned char lds_raw[];
__device__ __forceinline__ float bf2f(bf16 v) { return __uint_as_float(((unsigned)v) << 16); }
__device__ __forceinline__ unsigned f2bf(float f) { unsigned u = __float_as_uint(f); return (u + 0x7fffu + ((u >> 16) & 1u)) >> 16; }
__device__ __forceinline__ unsigned pk2(float lo, float hi) { return f2bf(lo) | (f2bf(hi) << 16); }
__device__ __forceinline__ float wave_sum(float v) {
#pragma unroll
    for (int o = 1; o < 64; o <<= 1) v += __shfl_xor(v, o);
    return v;
}
__device__ __forceinline__ float wave_max(float v) {
#pragma unroll
    for (int o = 1; o < 64; o <<= 1) v = fmaxf(v, __shfl_xor(v, o));
    return v;
}
__device__ __forceinline__ float shflx_f(float v, int o, int lane) { return __uint_as_float((unsigned)__builtin_amdgcn_ds_bpermute((lane ^ o) << 2, (int)__float_as_uint(v))); }
__device__ __forceinline__ unsigned shflx_u(unsigned v, int o, int lane) { return (unsigned)__builtin_amdgcn_ds_bpermute((lane ^ o) << 2, (int)v); }
__device__ __forceinline__ float wave_sum_l(float v, int lane) {
#pragma unroll
    for (int o = 1; o < 64; o <<= 1) v += shflx_f(v, o, lane);
    return v;
}
__device__ __forceinline__ int launder_s(int v) { asm volatile("" : "+s"(v)); return v; }
__device__ __forceinline__ float sigmoidf_(float x) { return 1.f / (1.f + __expf(-x)); }
__device__ __forceinline__ float log_sigmoidf_(float x) { return x >= 0.f ? -log1pf(__expf(-x)) : x - log1pf(__expf(x)); }
__device__ __forceinline__ float gelu_tanh(float x) { const float u = 0.7978845608028654f * (x + 0.044715f * x * x * x); return 0.5f * x * (1.f + tanhf(u)); }
__device__ __forceinline__ float alibi_slope(int idx1, int n) { return exp2f(-8.0f * (float)idx1 / (float)n); }

__device__ __forceinline__ constexpr int b64_off(int t, int d) { return ((t >> 4) * 2 + (d >> 5)) * 512 + (t & 15) * 32 + (d & 31); }
#define XB_TMO      128
#define XB_XCNT(j)  (256  + 64 * (j))
#define XB_XSUB(j)  (1280 + 64 * (j))
#define XB_XGEN(j)  (2304 + 64 * (j))
#define XB_TOP      3328
#define XB_TOPGEN   3392
#define XCD_BAR_WORDS 3456
#define XB_SPIN_CAP (1u << 25)
__device__ __forceinline__ unsigned xb_ld(unsigned* p)              { return __hip_atomic_load(p, __ATOMIC_RELAXED, __HIP_MEMORY_SCOPE_AGENT); }
__device__ __forceinline__ unsigned xb_add(unsigned* p, unsigned v) { return __hip_atomic_fetch_add(p, v, __ATOMIC_RELAXED, __HIP_MEMORY_SCOPE_AGENT); }
__device__ __forceinline__ unsigned xb_xcc_id() { return (unsigned)__builtin_amdgcn_s_getreg((3 << 11) | 20) & 0xFu; }
#define XB_SPIN(cond, bar) do { unsigned _sp = 0; while (cond) { __builtin_amdgcn_s_sleep(1); \
    if ((++_sp & 255u) == 0u) { if (xb_ld(&(bar)[XB_TMO])) break; if (_sp > XB_SPIN_CAP) { atomicAdd(&(bar)[XB_TMO], 1u); break; } } } } while (0)
struct XcdBarrier { unsigned* bar; unsigned x; volatile LAS unsigned* st; };
__device__ __forceinline__ XcdBarrier xcd_barrier_post(unsigned* bar, volatile LAS unsigned* st) {
    XcdBarrier b; b.bar = bar; b.x = xb_xcc_id(); b.st = st;
    if (threadIdx.x == 0) (void)xb_add(&bar[XB_XCNT(b.x)], 1u);
    return b;
}
__device__ __forceinline__ void xcd_barrier_complete(unsigned* bar, unsigned x, unsigned& nloc, unsigned& nx) {
    const unsigned G = gridDim.x * gridDim.y * gridDim.z;
    unsigned sum, cnt, mine, sp = 0u;
    for (;;) {
        sum = 0u; cnt = 0u; mine = 0u;
#pragma unroll
        for (unsigned j = 0; j < 16; ++j) { const unsigned c = xb_ld(&bar[XB_XCNT(j)]); sum += c; cnt += (c > 0u) ? 1u : 0u; mine = (j == x) ? c : mine; }
        if (sum == G) break;
        __builtin_amdgcn_s_sleep(1);
        if ((++sp & 255u) == 0u) { if (xb_ld(&bar[XB_TMO])) break; if (sp > XB_SPIN_CAP) { atomicAdd(&bar[XB_TMO], 1u); break; } }
    }
    nloc = mine > 0u ? mine : 1u; nx = cnt > 0u ? cnt : 1u;
}
__device__ __forceinline__ void xcd_barrier(const XcdBarrier& b) {
    asm volatile("s_waitcnt vmcnt(0)" ::: "memory");
    __syncthreads();
    if (threadIdx.x == 0) {
        unsigned* bar = b.bar;
        __builtin_amdgcn_s_waitcnt(0);
        unsigned nloc = b.st[0], nx = b.st[1];
        if (nloc == 0u) { xcd_barrier_complete(bar, b.x, nloc, nx); b.st[0] = nloc; b.st[1] = nx; }
        const unsigned old = xb_add(&bar[XB_XSUB(b.x)], 1u);
        const unsigned gen = old / nloc;
        if (old + 1u == (gen + 1u) * nloc) {
            __builtin_amdgcn_fence(__ATOMIC_RELEASE, "agent");
            asm volatile("s_waitcnt vmcnt(0)" ::: "memory");
            const unsigned og = xb_add(&bar[XB_TOP], 1u);
            const unsigned tg = og / nx;
            if (og + 1u == (tg + 1u) * nx) xb_add(&bar[XB_TOPGEN], 1u);
            else XB_SPIN(xb_ld(&bar[XB_TOPGEN]) == tg, bar);
            __builtin_amdgcn_fence(__ATOMIC_ACQUIRE, "agent");
            xb_add(&bar[XB_XGEN(b.x)], 1u);
            asm volatile("s_waitcnt vmcnt(0)" ::: "memory");
        } else {
            XB_SPIN(xb_ld(&bar[XB_XGEN(b.x)]) == gen, bar);
            __builtin_amdgcn_fence(__ATOMIC_ACQUIRE, "agent");
            asm volatile("s_waitcnt vmcnt(0)" ::: "memory");
        }
    }
    __syncthreads();
}

struct Params { const float* in[23]; float* out; unsigned char* ws; int ph_lo, ph_hi; };
constexpr int LDS_BYTES = 147456;
constexpr int MISC_OFF = 131072 + 320;

struct Ctx {
    LAS unsigned char* lds; int tid, lane, wave, bid, G, gw, ngw;
    const float* const* in; float* xcur; unsigned char* ws;
};

namespace pg8 {
#define PG8_LAS __attribute__((address_space(3)))
typedef unsigned short bf16_t;
typedef short bf16x8 __attribute__((ext_vector_type(8)));
typedef float f32x4 __attribute__((ext_vector_type(4)));
typedef unsigned u32x4 __attribute__((ext_vector_type(4)));
constexpr int BM = 256, BK = 64, HALF = 128, HTB = HALF * BK * 2  , STAGE_BYTES = 8 * HTB, NXCD = 8, WGM = 8;

__host__ __device__ __forceinline__ int lds_byte(int r, int c) { const int st = (r >> 4) * 2 + (c >> 5), rr = r & 15, cc = c & 31, ob = rr * 64 + cc * 2; return st * 1024 + (ob ^ (((ob >> 9) & 1) << 5)); }
__host__ __device__ __forceinline__ void stage_rc(int b, int& R, int& C) { const int st = b / 1024, sb = b % 1024, swz = sb ^ (((sb >> 9) & 1) << 5); R = (st >> 1) * 16 + swz / 64; C = (st & 1) * 32 + (swz % 64) / 2; }
__host__ __device__ __forceinline__ int perm32(int rho) { const int n = rho >> 4, i = rho & 15; return 8 * (i >> 2) + 4 * n + (i & 3); }

struct Unit { int pm, pn; const char* a; const char* b; const char* b2; };
struct Gemm { int lda, ldb, K, ksplit, arb, acb; };

__device__ __forceinline__ unsigned cvt_pk_bf16(float lo, float hi) { unsigned r; asm volatile("v_cvt_pk_bf16_f32 %0, %1, %2" : "=v"(r) : "v"(lo), "v"(hi)); return r; }
typedef float f32x2 __attribute__((ext_vector_type(2)));

template <class Epi, class Sched, bool ALIGN_EPI = false, bool SP2 = false, bool GATHER = false>
__device__ __forceinline__ void gemm_phase(PG8_LAS unsigned char* lds, const Gemm g, const Sched& S, const Epi& E) {
    static_assert(!GATHER || SP2, "GATHER is written for the SP2 loop");
    int tid_ = threadIdx.x; asm volatile("" : "+v"(tid_));
    const int tid = tid_, wid = __builtin_amdgcn_readfirstlane(tid >> 6), lane = tid & 63, wr = wid >> 2, wc = wid & 3, fr = lane & 15, fq = lane >> 4;
    const int K = g.K, nt = K / BK, ks = g.ksplit;
    unsigned voffA[2], voffB[2];
#pragma unroll
    for (int i = 0; i < 2; ++i) { int R, C; stage_rc(tid * 16 + i * 8192, R, C); const int Rb = Epi::PERM ? ((R & ~31) + perm32(R & 31)) : R;
        voffA[i] = g.arb ? (unsigned)(((R / g.arb) * (K / g.acb) + C / g.acb) * (g.arb * g.acb) + (R % g.arb) * g.acb + (C % g.acb)) * 2u : (unsigned)(R * g.lda + C) * 2u; voffB[i] = (unsigned)(Rb * g.ldb + C) * 2u; }
    const size_t kstep = (size_t)(BK * 2), kstepA = g.arb ? (size_t)(BK * g.arb * 2) : kstep;
    const size_t hsA = (size_t)HALF * (g.arb ? K : g.lda) * 2, hsB = (size_t)HALF * g.ldb * 2;
    const unsigned ldsw = (unsigned)wid * 1024u;
    const int aoff = lds_byte(wr * 64 + fr, fq * 8), boff = lds_byte(wc * 32 + fr, fq * 8);
#define PG8_SA(b, h) (((b) * 2 + (h)) * HTB)
#define PG8_SB(b, h) ((4 + (b) * 2 + (h)) * HTB)
#define PG8_STAGE(bufoff, gbase, voff) do { _Pragma("unroll") for (int _i = 0; _i < 2; ++_i) \
        __builtin_amdgcn_global_load_lds((const unsigned*)((const char*)(gbase) + (voff)[_i]), (PG8_LAS unsigned*)(lds + (bufoff) + ldsw + _i * 8192), 16, 0, 0); } while (0)
#define PG8_LDA(dst, b, h) do { _Pragma("unroll") for (int m = 0; m < 4; ++m) _Pragma("unroll") for (int k = 0; k < 2; ++k) dst[m][k] = *(const PG8_LAS bf16x8*)(lds + PG8_SA(b, h) + aoff + m * 2048 + k * 1024); } while (0)
#define PG8_LDB(dst, b, h) do { _Pragma("unroll") for (int n = 0; n < 2; ++n) _Pragma("unroll") for (int k = 0; k < 2; ++k) dst[n][k] = *(const PG8_LAS bf16x8*)(lds + PG8_SB(b, h) + boff + n * 2048 + k * 1024); } while (0)
#define PG8_MMA(ai, bj, At, Bt) do { __builtin_amdgcn_s_setprio(1); _Pragma("unroll") for (int m = 0; m < 4; ++m) _Pragma("unroll") for (int n = 0; n < 2; ++n) _Pragma("unroll") for (int k = 0; k < 2; ++k) \
        acc[ai][bj][m][n] = __builtin_amdgcn_mfma_f32_16x16x32_bf16(Bt[n][k], At[m][k], acc[ai][bj][m][n], 0, 0, 0); __builtin_amdgcn_s_setprio(0); } while (0)
#define PG8_WAIT_V(n) asm volatile("s_waitcnt vmcnt(" #n ")" ::: "memory")
#define PG8_WAIT_L(n) asm volatile("s_waitcnt lgkmcnt(" #n ")" ::: "memory")
#define PG8_BAR __builtin_amdgcn_s_barrier()
#define PG8_SCHED __builtin_amdgcn_sched_barrier(0)
    Unit cur, nxt; int ui = 0;
    if (!S.next(0, cur)) return;
    unsigned gC[2][2] = {{0u, 0u}, {0u, 0u}}, gN[2][2] = {{0u, 0u}, {0u, 0u}}; const char* gbase = nullptr;
#define PG8_GOFFS(U, Gv) do { int R_, C_; stage_rc(tid * 16, R_, C_); S.arows4(U, R_, (unsigned)C_ * 2u, Gv); } while (0)
#define PG8_STAGE_G(bufoff, kbyte, Gv, h) do { _Pragma("unroll") for (int _i = 0; _i < 2; ++_i) \
        __builtin_amdgcn_global_load_lds((const unsigned*)(gbase + (size_t)(kbyte) + Gv[h][_i]), (PG8_LAS unsigned*)(lds + (bufoff) + ldsw + _i * 8192), 16, 0, 0); } while (0)
    if constexpr (GATHER) { gbase = S.abase(); PG8_GOFFS(cur, gC); }
    f32x4 acc[2][2][4][2];
#pragma unroll
    for (int a = 0; a < 2; ++a)
#pragma unroll
        for (int b = 0; b < 2; ++b)
#pragma unroll
            for (int m = 0; m < 4; ++m)
#pragma unroll
                for (int n = 0; n < 2; ++n) acc[a][b][m][n] = (f32x4){0.f, 0.f, 0.f, 0.f};
    bf16x8 At[4][2], B0[2][2], B1[2][2];
    const char* cA = cur.a; const char* cB = cur.b; const char* cB2 = cur.b2;
#define PG8_BK(base, base2, kt) ((kt) < ks ? (base) + (size_t)(kt) * kstep : (base2) + (size_t)((kt) - ks) * kstep)
    S.a_ready(cur);
    if constexpr (SP2) {
        PG8_STAGE(PG8_SB(0, 0), cB, voffB); PG8_STAGE(PG8_SB(0, 1), cB + hsB, voffB);
        if constexpr (GATHER) { PG8_STAGE_G(PG8_SA(0, 0), 0, gC, 0); PG8_STAGE_G(PG8_SA(0, 1), 0, gC, 1); } else { PG8_STAGE(PG8_SA(0, 0), cA, voffA); PG8_STAGE(PG8_SA(0, 1), cA + hsA, voffA); }
        if (wr == 1) PG8_BAR;
        PG8_WAIT_V(2); PG8_BAR;
        PG8_STAGE(PG8_SB(1, 0), PG8_BK(cB, cB2, 1), voffB);
        if constexpr (GATHER) PG8_STAGE_G(PG8_SA(1, 0), kstep, gC, 0); else PG8_STAGE(PG8_SA(1, 0), cA + kstepA, voffA);
        PG8_STAGE(PG8_SB(1, 1), PG8_BK(cB, cB2, 1) + hsB, voffB);
        PG8_WAIT_V(6); PG8_BAR;
    } else {
        PG8_STAGE(PG8_SB(0, 0), cB, voffB); PG8_STAGE(PG8_SA(0, 0), cA, voffA); PG8_STAGE(PG8_SB(0, 1), cB + hsB, voffB); PG8_STAGE(PG8_SA(0, 1), cA + hsA, voffA);
        if (wr == 1) PG8_BAR;
        PG8_WAIT_V(4); PG8_BAR;
        PG8_STAGE(PG8_SB(1, 0), PG8_BK(cB, cB2, 1), voffB); PG8_STAGE(PG8_SA(1, 0), cA + kstepA, voffA); PG8_STAGE(PG8_SB(1, 1), PG8_BK(cB, cB2, 1) + hsB, voffB);
        PG8_WAIT_V(6); PG8_BAR;
    }
    for (;;) {
        const bool has_next = S.next(ui + 1, nxt);
        if constexpr (GATHER) { if (has_next) PG8_GOFFS(nxt, gN); else { _Pragma("unroll") for (int _h = 0; _h < 2; ++_h) _Pragma("unroll") for (int _i = 0; _i < 2; ++_i) gN[_h][_i] = gC[_h][_i]; } }
        const char* nA = has_next ? nxt.a : cA; const char* nB = has_next ? nxt.b : cB; const char* nB2 = has_next ? nxt.b2 : cB2;
#pragma unroll 1
        for (int t = 0; t < nt; t += 2) {
            const bool last = (t == nt - 2);
            const char* a1 = cA + (size_t)(t + 1) * kstepA;
            const char* a2 = last ? nA : cA + (size_t)(t + 2) * kstepA; const char* b2 = last ? PG8_BK(nB, nB2, 0) : PG8_BK(cB, cB2, t + 2);
            const char* a3 = a2 + kstepA; const char* b3 = last ? PG8_BK(nB, nB2, 1) : PG8_BK(cB, cB2, t + 3);
            if (last && has_next) S.a_ready(nxt);
            if constexpr (SP2) {
            PG8_LDB(B0, 0, 0); PG8_LDB(B1, 0, 1); PG8_SCHED; PG8_LDA(At, 0, 0);
            if constexpr (GATHER) PG8_STAGE_G(PG8_SA(1, 1), (size_t)(t + 1) * kstep, gC, 1); else PG8_STAGE(PG8_SA(1, 1), a1 + hsA, voffA);
            PG8_WAIT_V(8); PG8_WAIT_L(0); PG8_BAR; PG8_MMA(0, 0, At, B0); PG8_MMA(0, 1, At, B1); PG8_BAR; PG8_SCHED;
            PG8_LDA(At, 0, 1); PG8_STAGE(PG8_SB(0, 0), b2, voffB); PG8_STAGE(PG8_SB(0, 1), b2 + hsB, voffB);
            if constexpr (GATHER) { if (last) PG8_STAGE_G(PG8_SA(0, 0), 0, gN, 0); else PG8_STAGE_G(PG8_SA(0, 0), (size_t)(t + 2) * kstep, gC, 0); } else PG8_STAGE(PG8_SA(0, 0), a2, voffA);
            PG8_WAIT_V(8); PG8_WAIT_L(0); PG8_BAR; PG8_MMA(1, 0, At, B0); PG8_MMA(1, 1, At, B1); PG8_BAR; PG8_SCHED;
            PG8_LDB(B0, 1, 0); PG8_LDB(B1, 1, 1); PG8_SCHED; PG8_LDA(At, 1, 0);
            if constexpr (GATHER) { if (last) PG8_STAGE_G(PG8_SA(0, 1), 0, gN, 1); else PG8_STAGE_G(PG8_SA(0, 1), (size_t)(t + 2) * kstep, gC, 1); } else PG8_STAGE(PG8_SA(0, 1), a2 + hsA, voffA);
            PG8_WAIT_V(8); PG8_WAIT_L(0); PG8_BAR; PG8_MMA(0, 0, At, B0); PG8_MMA(0, 1, At, B1); PG8_BAR; PG8_SCHED;
            PG8_LDA(At, 1, 1); PG8_STAGE(PG8_SB(1, 0), b3, voffB); PG8_STAGE(PG8_SB(1, 1), b3 + hsB, voffB);
            if constexpr (GATHER) { if (last) PG8_STAGE_G(PG8_SA(1, 0), kstep, gN, 0); else PG8_STAGE_G(PG8_SA(1, 0), (size_t)(t + 3) * kstep, gC, 0); } else PG8_STAGE(PG8_SA(1, 0), a3, voffA);
            PG8_WAIT_V(8); PG8_WAIT_L(0); PG8_BAR; PG8_MMA(1, 0, At, B0); PG8_MMA(1, 1, At, B1); PG8_BAR; PG8_SCHED;
            } else {
            PG8_LDB(B0, 0, 0); PG8_SCHED; PG8_LDA(At, 0, 0); PG8_STAGE(PG8_SA(1, 1), a1 + hsA, voffA);
            PG8_WAIT_L(8); PG8_BAR; PG8_WAIT_L(0); PG8_MMA(0, 0, At, B0); PG8_BAR; PG8_SCHED;
            PG8_LDB(B1, 0, 1); PG8_STAGE(PG8_SB(0, 0), b2, voffB);
            PG8_BAR; PG8_WAIT_L(0); PG8_MMA(0, 1, At, B1); PG8_BAR;
            PG8_LDA(At, 0, 1); PG8_STAGE(PG8_SA(0, 0), a2, voffA);
            PG8_BAR; PG8_WAIT_L(0); PG8_MMA(1, 0, At, B0); PG8_BAR; PG8_SCHED;
            PG8_STAGE(PG8_SB(0, 1), b2 + hsB, voffB);
            PG8_WAIT_V(6); PG8_BAR; PG8_MMA(1, 1, At, B1); PG8_BAR;
            PG8_LDB(B0, 1, 0); PG8_SCHED; PG8_LDA(At, 1, 0); PG8_STAGE(PG8_SA(0, 1), a2 + hsA, voffA);
            PG8_WAIT_L(8); PG8_BAR; PG8_WAIT_L(0); PG8_MMA(0, 0, At, B0); PG8_BAR; PG8_SCHED;
            PG8_LDB(B1, 1, 1); PG8_STAGE(PG8_SB(1, 0), b3, voffB);
            PG8_BAR; PG8_WAIT_L(0); PG8_MMA(0, 1, At, B1); PG8_BAR;
            PG8_LDA(At, 1, 1); PG8_STAGE(PG8_SA(1, 0), a3, voffA);
            PG8_BAR; PG8_WAIT_L(0); PG8_MMA(1, 0, At, B0); PG8_BAR; PG8_SCHED;
            PG8_STAGE(PG8_SB(1, 1), b3 + hsB, voffB);
            PG8_WAIT_V(6); PG8_BAR; PG8_MMA(1, 1, At, B1); PG8_BAR;
            }
        }
        if constexpr (ALIGN_EPI) { if (wr == 0) PG8_BAR; }
        if constexpr (!Epi::AFTER_DRAIN) { E(acc, cur, wr, wc, fr, fq); S.done(cur); }
        if (!has_next) break;
#pragma unroll
        for (int a = 0; a < 2; ++a)
#pragma unroll
            for (int b = 0; b < 2; ++b)
#pragma unroll
                for (int m = 0; m < 4; ++m)
#pragma unroll
                    for (int n = 0; n < 2; ++n) acc[a][b][m][n] = (f32x4){0.f, 0.f, 0.f, 0.f};
        cur = nxt; cA = nA; cB = nB; cB2 = nB2; ++ui;
        if constexpr (GATHER) { _Pragma("unroll") for (int _h = 0; _h < 2; ++_h) _Pragma("unroll") for (int _i = 0; _i < 2; ++_i) gC[_h][_i] = gN[_h][_i]; }
        if constexpr (ALIGN_EPI) { if (wr == 1) PG8_BAR; }
    }
    PG8_WAIT_V(0);
    if constexpr (!ALIGN_EPI) { if (wr == 0) PG8_BAR; }
    PG8_BAR;
    if constexpr (Epi::AFTER_DRAIN) { E.fused(acc, cur, wr, wc, fr, fq, lds, wid, lane); S.done(cur); }
#undef PG8_BK
#undef PG8_GOFFS
#undef PG8_STAGE_G
#undef PG8_SA
#undef PG8_SB
#undef PG8_STAGE
#undef PG8_LDA
#undef PG8_LDB
#undef PG8_MMA
#undef PG8_WAIT_V
#undef PG8_WAIT_L
#undef PG8_BAR
#undef PG8_SCHED
}
}

struct PlainOrder {
    const char* A; const char* Bt; int lda, ldb, nM, nN, nwg, G, c;
    __device__ __forceinline__ void init(const void* A_, const void* Bt_, int lda_, int ldb_, int M, int N, int G_, int c_) { A = (const char*)A_; Bt = (const char*)Bt_; lda = lda_; ldb = ldb_; nM = M / 256; nN = N / 256; nwg = nM * nN; G = G_; c = c_; }
    __device__ __forceinline__ bool next(int i, pg8::Unit& u) const {
        const long L = (long)i * G + c; if (L >= nwg) return false;
        int wgid = (int)L; { const int q = nwg / 8, r = nwg % 8, xcd = wgid % 8, off = wgid / 8; wgid = (xcd < r ? xcd * (q + 1) : r * (q + 1) + (xcd - r) * q) + off; }
        const int nig = 8 * nN, gid = wgid / nig, fm = gid * 8, gsz = (nM - fm) < 8 ? (nM - fm) : 8;
        u.pm = fm + ((wgid % nig) % gsz); u.pn = (wgid % nig) / gsz;
        u.a = A + (size_t)u.pm * 256 * lda * 2; u.b = Bt + (size_t)u.pn * 256 * ldb * 2; u.b2 = u.b; return true;
    }
    __device__ __forceinline__ void a_ready(const pg8::Unit&) const {}
    __device__ __forceinline__ void done(const pg8::Unit&) const {}
};
struct EpiInProj {
    static constexpr bool PERM = true, AFTER_DRAIN = false;
    unsigned char* ws; const float* b_gate; const float* b_fgt; unsigned* kn;
    __device__ __forceinline__ void operator()(const pg8::f32x4 (&acc)[2][2][4][2], const pg8::Unit& u, int wr, int wc, int fr, int fq) const {
        { int t_ = threadIdx.x; asm volatile("" : "+v"(t_)); fr = t_ & 15; fq = (t_ >> 4) & 3; }
        const int pn = u.pn, b = (u.pm * 256) / T_, t0 = u.pm * 256 - b * T_ + wr * 64 + fr;
        if (pn == 11) {
            if (wc == 0 && fq < 4) {
                float* gate = (float*)(ws + WS_GATE); float* fl = (float*)(ws + WS_FL);
#pragma unroll
                for (int ai = 0; ai < 2; ++ai)
#pragma unroll
                    for (int m = 0; m < 4; ++m) { const int t = t0 + ai * 128 + m * 16; const size_t n = (size_t)b * T_ + t;
#pragma unroll
                        for (int nn = 0; nn < 2; ++nn)
#pragma unroll
                            for (int e = 0; e < 4; ++e) { const int c = 8 * fq + 4 * nn + e; const float v = acc[ai][0][m][nn][e];
                                if (c < 24) gate[n * 24 + c] = __builtin_amdgcn_rcpf(1.f + __builtin_amdgcn_exp2f(-(v + b_gate[c]) * LOG2E));
                                else if (c < 28) { const float z = v + b_fgt[c - 24];
                                    fl[(size_t)(b * 4 + (c - 24)) * T_ + t] = z < -30.f ? z : -0.6931471805599453f * __builtin_amdgcn_logf(1.f + __builtin_amdgcn_exp2f(-z * LOG2E)); } } }
            }
            return;
        }
        if (pn == 6 || pn == 9) {
            const int lane_ = (fq << 4) | fr;
#pragma unroll
            for (int bj = 0; bj < 2; ++bj)
#pragma unroll
                for (int ai = 0; ai < 2; ++ai) { float mx = 0.f;
#pragma unroll
                    for (int m = 0; m < 4; ++m) { const pg8::f32x4 v0 = acc[ai][bj][m][0], v1 = acc[ai][bj][m][1];
                        float ss = (v0[0] * v0[0] + v0[1] * v0[1]) + (v0[2] * v0[2] + v0[3] * v0[3]) + (v1[0] * v1[0] + v1[1] * v1[1]) + (v1[2] * v1[2] + v1[3] * v1[3]);
                        ss += shflx_f(ss, 16, lane_); ss += shflx_f(ss, 32, lane_); mx = fmaxf(mx, ss); }
#pragma unroll
                    for (int o = 1; o < 16; o <<= 1) mx = fmaxf(mx, shflx_f(mx, o, lane_));
                    if (lane_ == 0) { const int cg = bj * 4 + wc, tile = (u.pm * 256 - b * T_ + ai * 128 + wr * 64) >> 6;
                        unsigned* dst = pn == 6 ? kn + ((b * 4 + (cg >> 1)) * 64 + tile) * 2 + (cg & 1) : kn + 4096 + (b * 8 + cg) * 64 + tile;
                        atomicMax(dst, __float_as_uint(mx)); } }
        }
#pragma unroll
        for (int bj = 0; bj < 2; ++bj) {
            const int c = bj * 128 + wc * 32 + 8 * fq;
            bf16* base; int W = 64; float sc = 1.f;
            if (pn < 2) { base = (bf16*)(ws + WS_QN) + (size_t)(b * 8 + pn * 4 + (c >> 6)) * T_ * 64 + (c & 63); sc = 0.125f * LOG2E; }
            else if (pn < 5) { base = (bf16*)(ws + WS_KV6 + (size_t)((pn - 2) * 2 + (c >> 7)) * KV6_STRIDE) + (size_t)(b * 2 + ((c >> 6) & 1)) * T_ * 64 + (c & 63); }
            else if (pn < 8) { base = (bf16*)(ws + WS_FQKV) + (size_t)(pn - 5) * (8 * MiB) + (size_t)(b * 4 + (c >> 6)) * T_ * 64 + (c & 63); if (pn == 5) sc = 0.125f * LOG2E; }
            else if (pn < 10) { base = (bf16*)(ws + WS_DQK) + (size_t)(pn - 8) * (8 * MiB) + (size_t)(b * 8 + (c >> 5)) * T_ * 32 + (c & 31); W = 32; if (pn == 8) sc = 0.17677669529663687f * LOG2E; }
            else { base = (bf16*)(ws + WS_DV) + (size_t)(b * 4 + (c >> 6)) * T_ * 64 + (c & 63); }
            const bool blk = W == 64 && pn != 2;
            if (blk) base += -(c & 63) + ((c >> 5) & 1) * 512 + (c & 31);
#pragma unroll
            for (int ai = 0; ai < 2; ++ai)
#pragma unroll
                for (int m = 0; m < 4; ++m) { const int t = t0 + ai * 128 + m * 16;
                    const pg8::f32x4 v0 = acc[ai][bj][m][0] * sc, v1 = acc[ai][bj][m][1] * sc;
                    pg8::u32x4 w; w.x = pg8::cvt_pk_bf16(v0[0], v0[1]); w.y = pg8::cvt_pk_bf16(v0[2], v0[3]); w.z = pg8::cvt_pk_bf16(v1[0], v1[1]); w.w = pg8::cvt_pk_bf16(v1[2], v1[3]);
                    *(pg8::u32x4*)(base + (blk ? (size_t)((t >> 4) * 1024 + (t & 15) * 32) : (size_t)t * W)) = w; }
        }
    }
};
__device__ __forceinline__ u32x4 res_add8(u32x4 w, const pg8::f32x4& a0, const pg8::f32x4& a1) {
    u32x4 o;
    o.x = pg8::cvt_pk_bf16(__uint_as_float(w.x << 16) + a0[0], __uint_as_float(w.x & 0xffff0000u) + a0[1]); o.y = pg8::cvt_pk_bf16(__uint_as_float(w.y << 16) + a0[2], __uint_as_float(w.y & 0xffff0000u) + a0[3]);
    o.z = pg8::cvt_pk_bf16(__uint_as_float(w.z << 16) + a1[0], __uint_as_float(w.z & 0xffff0000u) + a1[1]); o.w = pg8::cvt_pk_bf16(__uint_as_float(w.w << 16) + a1[2], __uint_as_float(w.w & 0xffff0000u) + a1[3]);
    return o;
}
struct EpiResBf16 {
    static constexpr bool PERM = true, AFTER_DRAIN = false;
    bf16* xr;
    __device__ __forceinline__ void operator()(const pg8::f32x4 (&acc)[2][2][4][2], const pg8::Unit& u, int wr, int wc, int fr, int fq) const {
        { int t_ = threadIdx.x; asm volatile("" : "+v"(t_)); fr = t_ & 15; fq = (t_ >> 4) & 3; }
#pragma unroll
        for (int ai = 0; ai < 2; ++ai)
#pragma unroll
            for (int m = 0; m < 4; ++m) { const size_t off = (size_t)(u.pm * 256 + ai * 128 + wr * 64 + m * 16 + fr) * D_ + u.pn * 256 + wc * 32 + 8 * fq;
#pragma unroll
                for (int bj = 0; bj < 2; ++bj) { u32x4* q = (u32x4*)(xr + off + bj * 128); *q = res_add8(*q, acc[ai][bj][m][0], acc[ai][bj][m][1]); } }
    }
};


struct EpiDummy {
    static constexpr bool PERM = true, AFTER_DRAIN = false;
    float* dst;
    __device__ __forceinline__ void operator()(const pg8::f32x4 (&acc)[2][2][4][2], const pg8::Unit& u, int wr, int wc, int fr, int fq) const {
        pg8::f32x4 a = {0.f, 0.f, 0.f, 0.f};
#pragma unroll
        for (int ai = 0; ai < 2; ++ai)
#pragma unroll
            for (int bj = 0; bj < 2; ++bj)
#pragma unroll
                for (int m = 0; m < 4; ++m) { a = a + acc[ai][bj][m][0]; a = a + acc[ai][bj][m][1]; }
        *(pg8::f32x4*)(dst + ((size_t)(u.pm * 12 + u.pn) * 512 + threadIdx.x) * 4) = a;
    }
};
struct OneUnitOrder { pg8::Unit u; bool has;
    __device__ __forceinline__ bool next(int i, pg8::Unit& o) const { if (i != 0 || !has) return false; o = u; return true; }
    __device__ __forceinline__ void a_ready(const pg8::Unit&) const {}
    __device__ __forceinline__ void done(const pg8::Unit&) const {} };
__device__ __forceinline__ float gelu_tanh_fast(float x) { const float u2 = 1.5957691216057308f * (x + 0.044715f * x * x * x); return x * __builtin_amdgcn_rcpf(1.f + __builtin_amdgcn_exp2f(-u2 * LOG2E)); }
struct EpiCmpH {
    static constexpr bool PERM = true, AFTER_DRAIN = false;
    bf16* hc; const float* bias1;
    __device__ __forceinline__ void operator()(const pg8::f32x4 (&acc)[2][2][4][2], const pg8::Unit& u, int wr, int wc, int fr, int fq) const {
        { int t_ = threadIdx.x; asm volatile("" : "+v"(t_)); fr = t_ & 15; fq = (t_ >> 4) & 3; }
        const int kv = u.pn;
#pragma unroll
        for (int bj = 0; bj < 2; ++bj) { const int col = bj * 128 + wc * 32 + 8 * fq;
            const pg8::f32x4 b0 = *(const pg8::f32x4*)(bias1 + kv * 256 + col), b1 = *(const pg8::f32x4*)(bias1 + kv * 256 + col + 4);
#pragma unroll
            for (int ai = 0; ai < 2; ++ai)
#pragma unroll
                for (int m = 0; m < 4; ++m) { const int row = u.pm * 256 + ai * 128 + wr * 64 + m * 16 + fr;
                    const pg8::f32x4 v0 = acc[ai][bj][m][0] + b0, v1 = acc[ai][bj][m][1] + b1;
                    pg8::u32x4 w; w.x = pg8::cvt_pk_bf16(gelu_tanh_fast(v0[0]), gelu_tanh_fast(v0[1])); w.y = pg8::cvt_pk_bf16(gelu_tanh_fast(v0[2]), gelu_tanh_fast(v0[3]));
                    w.z = pg8::cvt_pk_bf16(gelu_tanh_fast(v1[0]), gelu_tanh_fast(v1[1])); w.w = pg8::cvt_pk_bf16(gelu_tanh_fast(v1[2]), gelu_tanh_fast(v1[3]));
                    *(pg8::u32x4*)(hc + ((size_t)kv * 4096 + row) * 256 + col) = w; } }
    }
};
struct EpiCmpOut {
    static constexpr bool PERM = true, AFTER_DRAIN = false;
    bf16* kvcmp;
    __device__ __forceinline__ void operator()(const pg8::f32x4 (&acc)[2][2][4][2], const pg8::Unit& u, int wr, int wc, int fr, int fq) const {
        { int t_ = threadIdx.x; asm volatile("" : "+v"(t_)); fr = t_ & 15; fq = (t_ >> 4) & 3; }
        if (wc >= 2) return;
        const int kv = u.pn, col = wc * 32 + 8 * fq;
#pragma unroll
        for (int ai = 0; ai < 2; ++ai)
#pragma unroll
            for (int m = 0; m < 4; ++m) { const int row = u.pm * 256 + ai * 128 + wr * 64 + m * 16 + fr; const float z = ((row & 255) == 255) ? 0.f : 1.f;
                const pg8::f32x4 v0 = acc[ai][0][m][0], v1 = acc[ai][0][m][1];
                pg8::u32x4 w; w.x = pg8::cvt_pk_bf16(z != 0.f ? v0[0] : 0.f, z != 0.f ? v0[1] : 0.f); w.y = pg8::cvt_pk_bf16(z != 0.f ? v0[2] : 0.f, z != 0.f ? v0[3] : 0.f);
                w.z = pg8::cvt_pk_bf16(z != 0.f ? v1[0] : 0.f, z != 0.f ? v1[1] : 0.f); w.w = pg8::cvt_pk_bf16(z != 0.f ? v1[2] : 0.f, z != 0.f ? v1[3] : 0.f);
                *(pg8::u32x4*)(kvcmp + ((size_t)kv * 4096 + row) * 64 + col) = w; }
    }
};

__device__ __forceinline__ void moe_build_tables(const unsigned* cnt, int tid) {
    LAS int* T = (LAS int*)((LAS unsigned char*)lds_raw + TBL_OFF);
    __syncthreads();
    if (tid < 112) T[384 + tid] = (int)cnt[tid * MOE_CS];
    else if (tid >= 128 && tid < 128 + NEXP) T[560 + tid - 128] = (int)cnt[(112 + tid - 128) * MOE_CS];
    __syncthreads();
    if (tid == 0) { int o = 0; _Pragma("clang loop unroll(disable)") for (int c = 0; c < 112; ++c) { T[c] = o; const int n = (T[384 + c] + 255) >> 8;
            _Pragma("clang loop vectorize(disable) unroll(disable)") for (int k = 0; k < n; ++k) T[128 + o + k] = c;
            o += n; } T[112] = o; }
    if (tid == 64) { int o = 0; _Pragma("clang loop unroll(disable)") for (int e = 0; e < NEXP; ++e) { T[512 + e] = o; const int n = (T[560 + e] + 255) >> 8;
            _Pragma("clang loop vectorize(disable) unroll(disable)") for (int k = 0; k < n; ++k) T[608 + o + k] = e;
            o += n; } T[544] = o; }
    __syncthreads();
}
__device__ __forceinline__ void moe_pair(int cls, int& ea, int& eb) { const int grp = cls / 28; int idx = cls % 28, lo = 0; while (idx >= 7 - lo) { idx -= 7 - lo; ++lo; } ea = grp * 8 + lo; eb = grp * 8 + lo + 1 + idx; }
struct MoeOrder1 {
    const char* wsb; const unsigned* rec; const char* wgu; unsigned* edone; int G, c;
    __device__ __forceinline__ bool next(int i, pg8::Unit& u) const {
        const LAS int* T = (const LAS int*)((LAS unsigned char*)lds_raw + TBL_OFF);
        const int idx = i * G + c; if (idx >= 2 * T[544]) return false;
        const int tile = idx >> 1, pn = idx & 1, e = T[608 + tile];
        u.pm = tile; u.pn = pn; u.a = wsb; u.b = wgu + ((size_t)e * 512 + pn * 256) * 2048; u.b2 = u.b; return true; }
    __device__ __forceinline__ const char* abase() const { return wsb; }
    __device__ __forceinline__ void arows4(const pg8::Unit& u, int r0, unsigned cb, unsigned (&g)[2][2]) const {
        const LAS int* T = (const LAS int*)((LAS unsigned char*)lds_raw + TBL_OFF);
        const int e = T[608 + u.pm], base = (u.pm - T[512 + e]) * 256 + r0, n = T[560 + e];
        const unsigned ob = (unsigned)(e * 32768 + base) * 16u;
#pragma unroll
        for (int k = 0; k < 4; ++k) { unsigned off = ZROW_OFF; if (base + 64 * k < n) off = (unsigned)WS_HN + *(const unsigned*)((const char*)rec + (ob + 1024u * k)) * 2048u; g[k >> 1][k & 1] = off + cb; } }
    __device__ __forceinline__ void a_ready(const pg8::Unit&) const {}
    __device__ __forceinline__ void done(const pg8::Unit& u) const {
        asm volatile("s_waitcnt vmcnt(0)" ::: "memory");
        const LAS int* T = (const LAS int*)((LAS unsigned char*)lds_raw + TBL_OFF);
        int t_ = threadIdx.x; asm volatile("" : "+v"(t_));
        if ((t_ & 63) == 0) (void)__hip_atomic_fetch_add(edone + T[608 + u.pm] * MOE_CS, 1u, __ATOMIC_RELAXED, __HIP_MEMORY_SCOPE_AGENT); } };
struct MoeOrder2 {
    const char* hb; const char* wd; const unsigned* edone; unsigned* tmo; int G, c;
    __device__ __forceinline__ bool next(int i, pg8::Unit& u) const {
        const LAS int* T = (const LAS int*)((LAS unsigned char*)lds_raw + TBL_OFF);
        const int n1 = (2 * T[544]) % G, idx = i * G + (c >= n1 ? c - n1 : c - n1 + G); if (idx >= 4 * T[112]) return false;
        const int tile = idx >> 2, pn = idx & 3; int ea, eb; moe_pair(T[128 + tile], ea, eb);
        u.pm = tile; u.pn = pn; u.a = hb + (size_t)tile * 256 * 1024; u.b = wd + ((size_t)ea * 1024 + pn * 256) * 512; u.b2 = wd + ((size_t)eb * 1024 + pn * 256) * 512; return true; }
    __device__ __forceinline__ void a_ready(const pg8::Unit& u) const {
        int t_ = threadIdx.x; asm volatile("" : "+v"(t_));
        if (t_ < 64) {
            const LAS int* T = (const LAS int*)((LAS unsigned char*)lds_raw + TBL_OFF);
            int ea, eb; moe_pair(T[128 + u.pm], ea, eb);
            const unsigned na = 16u * (unsigned)((T[560 + ea] + 255) >> 8), nb = 16u * (unsigned)((T[560 + eb] + 255) >> 8);
            unsigned polls = 0u;
            while ((unsigned)__builtin_amdgcn_readfirstlane(__hip_atomic_load(edone + ea * MOE_CS, __ATOMIC_RELAXED, __HIP_MEMORY_SCOPE_AGENT)) < na ||
                   (unsigned)__builtin_amdgcn_readfirstlane(__hip_atomic_load(edone + eb * MOE_CS, __ATOMIC_RELAXED, __HIP_MEMORY_SCOPE_AGENT)) < nb) {
                if ((++polls & 255u) == 0u) { if (__builtin_amdgcn_readfirstlane(__hip_atomic_load(tmo, __ATOMIC_RELAXED, __HIP_MEMORY_SCOPE_AGENT)) != 0u) break;
                    if (polls > (1u << 22)) { if (t_ == 0) __hip_atomic_store(tmo, 1u, __ATOMIC_RELAXED, __HIP_MEMORY_SCOPE_AGENT); break; } }
                __builtin_amdgcn_s_sleep(2); }
            __builtin_amdgcn_fence(__ATOMIC_ACQUIRE, "agent");
            asm volatile("s_waitcnt vmcnt(0)" ::: "memory");
        }
        asm volatile("" ::: "memory"); __builtin_amdgcn_s_barrier(); asm volatile("" ::: "memory");
    }
    __device__ __forceinline__ void done(const pg8::Unit&) const {} };
struct EpiMoeH {
    static constexpr bool PERM = true, AFTER_DRAIN = false;
    bf16* hb; const u32x4* rec;
    __device__ __forceinline__ void operator()(const pg8::f32x4 (&acc)[2][2][4][2], const pg8::Unit& u, int wr, int wc, int fr, int fq) const {
        { int t_ = threadIdx.x; asm volatile("" : "+v"(t_)); fr = t_ & 15; fq = (t_ >> 4) & 3; }
        const LAS int* T = (const LAS int*)((LAS unsigned char*)lds_raw + TBL_OFF);
        const int ex = T[608 + u.pm], vr0 = (u.pm - T[512 + ex]) * 256, nex = T[560 + ex];
#pragma unroll
        for (int ai = 0; ai < 2; ++ai) {
#pragma unroll
            for (int m = 0; m < 4; ++m) { const int rr = ai * 128 + wr * 64 + m * 16 + fr; const bool valid = vr0 + rr < nex;
                const u32x4 q = *(const u32x4*)((const char*)rec + (unsigned)(ex * 32768 + vr0 + rr) * 16u); const float w = __uint_as_float(q.y), rs = __uint_as_float(q.z);
                const int slot = (int)((q.w >> 15) & 1u); const unsigned row = (unsigned)T[valid ? (q.w >> 16) : 0u] * 256u + (q.w & 0x7fffu);
#pragma unroll
                for (int bj = 0; bj < 2; ++bj) { const int j0 = (u.pn & 1) * 128 + (bj * 128 + wc * 32 + 8 * fq) / 2;
                    pg8::f32x4 v0 = acc[ai][bj][m][0], v1 = acc[ai][bj][m][1];
#pragma unroll
                    for (int e = 0; e < 4; ++e) { v0[e] *= rs; v1[e] *= rs; }
                    const float h0 = v0[0] * __builtin_amdgcn_rcpf(1.f + __builtin_amdgcn_exp2f(-v0[0] * LOG2E)) * v0[1] * w, h1 = v0[2] * __builtin_amdgcn_rcpf(1.f + __builtin_amdgcn_exp2f(-v0[2] * LOG2E)) * v0[3] * w;
                    const float h2 = v1[0] * __builtin_amdgcn_rcpf(1.f + __builtin_amdgcn_exp2f(-v1[0] * LOG2E)) * v1[1] * w, h3 = v1[2] * __builtin_amdgcn_rcpf(1.f + __builtin_amdgcn_exp2f(-v1[2] * LOG2E)) * v1[3] * w;
                    const int jg = slot * 256 + j0;
                    if (valid) __hip_atomic_store((u64*)((char*)hb + (((row >> 4) * 32u + (unsigned)(jg >> 4)) * 256u + (row & 15u) * 16u + (unsigned)(jg & 15)) * 2u), (u64)pg8::cvt_pk_bf16(h0, h1) | ((u64)pg8::cvt_pk_bf16(h2, h3) << 32),
                                                  __ATOMIC_RELAXED, __HIP_MEMORY_SCOPE_AGENT); }
            }
            asm volatile("" ::: "memory"); }
    }
};
struct EpiMoeOut {
    static constexpr bool PERM = true, AFTER_DRAIN = false;
    bf16* x; const unsigned* rec;
    __device__ __forceinline__ void operator()(const pg8::f32x4 (&acc)[2][2][4][2], const pg8::Unit& u, int wr, int wc, int fr, int fq) const {
        { int t_ = threadIdx.x; asm volatile("" : "+v"(t_)); fr = t_ & 15; fq = (t_ >> 4) & 3; }
        bf16* xx = x; const unsigned* rt = rec; asm volatile("" : "+s"(xx), "+s"(rt));
        const LAS int* T = (const LAS int*)((LAS unsigned char*)lds_raw + TBL_OFF);
        const int cls = T[128 + u.pm], vr0 = (u.pm - T[cls]) * 256, ncls = T[384 + cls];
#pragma unroll
        for (int ai = 0; ai < 2; ++ai)
#pragma unroll
            for (int m = 0; m < 4; ++m) { const int rr = ai * 128 + wr * 64 + m * 16 + fr; int tok = -1; if (vr0 + rr < ncls) tok = (int)rt[(size_t)cls * 32768 + vr0 + rr];
                if (tok >= 0) { bf16* xr = xx + (size_t)tok * D_ + u.pn * 256 + wc * 32 + 8 * fq;
#pragma unroll
                    for (int bj = 0; bj < 2; ++bj) { u32x4* q = (u32x4*)(xr + bj * 128); *q = res_add8(*q, acc[ai][bj][m][0], acc[ai][bj][m][1]); } } }
    }
};

__device__ __forceinline__ void transpose_item(const float* W, int ldw, bf16* WT, int ldt, int r0, int rmul, int k0, LAS float* scr, int lane, const float* gk = nullptr) {
    f32x4 v[8];
#pragma unroll
    for (int i = 0; i < 8; ++i) v[i] = *(const f32x4*)(W + (size_t)(k0 + i * 8 + (lane >> 3)) * ldw + (lane & 7) * 4);
    if (gk) {
#pragma unroll
        for (int i = 0; i < 8; ++i) { const float gsc = gk[k0 + i * 8 + (lane >> 3)]; v[i].x *= gsc; v[i].y *= gsc; v[i].z *= gsc; v[i].w *= gsc; } }
#pragma unroll
    for (int i = 0; i < 8; ++i) { LAS float* d = scr + (i * 8 + (lane >> 3)) * 33 + (lane & 7) * 4; d[0] = v[i].x; d[1] = v[i].y; d[2] = v[i].z; d[3] = v[i].w; }
    asm volatile("s_waitcnt lgkmcnt(0)" ::: "memory");
    const int c = lane & 7;
#pragma unroll
    for (int j = 0; j < 4; ++j) { const int n = (lane >> 3) + 8 * j; const LAS float* sp = scr + (8 * c) * 33 + n;
        u32x4 o; o.x = pk2(sp[0 * 33], sp[1 * 33]); o.y = pk2(sp[2 * 33], sp[3 * 33]); o.z = pk2(sp[4 * 33], sp[5 * 33]); o.w = pk2(sp[6 * 33], sp[7 * 33]);
        *(u32x4*)(WT + (size_t)(r0 + rmul * n) * ldt + k0 + 8 * c) = o; }
    asm volatile("s_waitcnt lgkmcnt(0)" ::: "memory");
}
__device__ __forceinline__ void transpose_seg(const float* W, int ldw, int K, int sc0, int ncol, bf16* WT, int r0, int rmul, int item, LAS float* scr, int lane, const float* gk = nullptr) {
    const int nb = ncol / 32, kb = item / nb, cb = item % nb;
    transpose_item(W + sc0 + cb * 32, ldw, WT, K, r0 + rmul * cb * 32, rmul, kb * 64, scr, lane, gk);
}

typedef float f32x16 __attribute__((ext_vector_type(16)));
typedef short bf16x8v __attribute__((ext_vector_type(8)));
typedef short s16x4 __attribute__((ext_vector_type(4)));
typedef float f32x2_t __attribute__((ext_vector_type(2)));
typedef __bf16 bf16x2_t __attribute__((ext_vector_type(2)));
constexpr int A_KBUF = 10240, A_VBUF = 12288;
constexpr int A_KOFF = 0, A_VOFF = 2 * A_KBUF, A_BOFF = A_VOFF + 2 * A_VBUF, A_BTILE = 8 * 256, A_LDS_END = A_BOFF + 2 * A_BTILE;
__device__ __forceinline__ constexpr int crow0(int reg) { return (reg & 3) + 8 * (reg >> 2); }
__device__ __forceinline__ float swap_max(float m) { auto rr = __builtin_amdgcn_permlane32_swap(__float_as_uint(m), __float_as_uint(m), false, false); return fmaxf(__uint_as_float(rr[0]), __uint_as_float(rr[1])); }
__device__ __forceinline__ float swap_sum(float m) { auto rr = __builtin_amdgcn_permlane32_swap(__float_as_uint(m), __float_as_uint(m), false, false); return __uint_as_float(rr[0]) + __uint_as_float(rr[1]); }
__device__ __forceinline__ unsigned cvtpk(float lo, float hi) { f32x2_t v = {lo, hi}; bf16x2_t b = __builtin_convertvector(v, bf16x2_t); return __builtin_bit_cast(unsigned, b); }
__device__ __forceinline__ bf16x8v pack8(const f32x16& p, int b0) { u32x4 w; w.x = cvtpk(p[b0 + 0], p[b0 + 1]); w.y = cvtpk(p[b0 + 2], p[b0 + 3]); w.z = cvtpk(p[b0 + 4], p[b0 + 5]); w.w = cvtpk(p[b0 + 6], p[b0 + 7]); return __builtin_bit_cast(bf16x8v, w); }
__device__ __forceinline__ s16x4 tr_read(const LAS unsigned char* p) { typedef short v4i16_t __attribute__((ext_vector_type(4))); return __builtin_bit_cast(s16x4, __builtin_amdgcn_ds_read_tr16_b64_v4i16((LAS v4i16_t*)p)); }

template <int DQK>
__device__ __forceinline__ void attn_preload(const bf16* Kb0, const bf16* Kb1, const bf16* Vb, int j, int tid, u32x4& kreg, u32x4& vreg) {
    const bf16* ksrc;
    if (DQK == 64) ksrc = Kb0 + b64_off(tid >> 3, (tid & 7) * 8); else { const int mp = tid >> 8, tt = tid & 255; ksrc = (mp ? Kb1 : Kb0) + (tt >> 2) * 32 + (tt & 3) * 8; }
    const bf16* vsrc = Vb + b64_off(tid >> 3, (tid & 7) * 8);
    kreg = *(const u32x4*)(ksrc + (size_t)(j * 64) * DQK); vreg = *(const u32x4*)(vsrc + (size_t)(j * 64) * 64);
}
template <int DQK, int NMAP, bool FOX, bool SLC, bool PRE = false, bool NOMAX = false>
__device__ __forceinline__ void attn_core(LAS unsigned char* L, const bf16* Kb0, const bf16* Kb1, const bf16* Vb, const LAS float* cum, float cum_ref,
                                          const bf16x8v (&Qf)[NMAP][DQK / 16], u64 tilemask, int t_lane, int tw0, int win, float slope2, unsigned selw0, unsigned selw1,
                                          f32x16 (&O)[NMAP][2], float (&M)[NMAP], float (&Ls)[NMAP], int tid, bool started0 = false, int jpre = 0, u32x4 kpre = (u32x4){0u, 0u, 0u, 0u}, u32x4 vpre = (u32x4){0u, 0u, 0u, 0u}) {
    constexpr int KP = DQK * 2 + 16, VP = 192;
    const int lane = tid & 63, r = lane & 31, h = lane >> 5;
    int kdst; const bf16* ksrc;
    if (DQK == 64) { kdst = (tid >> 3) * KP + (tid & 7) * 16; ksrc = Kb0 + b64_off(tid >> 3, (tid & 7) * 8); }
    else { const int mp = tid >> 8, tt = tid & 255; kdst = mp * 5120 + (tt >> 2) * KP + (tt & 3) * 16; ksrc = (mp ? Kb1 : Kb0) + (tt >> 2) * 32 + (tt & 3) * 8; }
    const int vdst = (tid >> 3) * VP + (tid & 7) * 16; const bf16* vsrc = Vb + b64_off(tid >> 3, (tid & 7) * 8);
    const LAS unsigned char* kfrag = L + A_KOFF + r * KP + h * 16;
    const LAS unsigned char* vfrag = L + A_VOFF + (4 * h + ((lane & 15) >> 2)) * VP + (16 * ((lane >> 4) & 1) + 4 * (lane & 3)) * 2;
    u32x4 kreg, vreg; float breg = 0.f;
    u64 mk = tilemask;
    int j = PRE ? jpre : 63 - __builtin_clzll(mk); mk &= ~(1ull << j);
    { const int kv0 = j * 64; if (PRE) { kreg = kpre; vreg = vpre; } else { kreg = *(const u32x4*)(ksrc + (size_t)kv0 * DQK); vreg = *(const u32x4*)(vsrc + (size_t)kv0 * 64); } if (FOX) breg = (cum_ref - cum[kv0 + lane]) * LOG2E; }
    *(LAS u32x4*)(L + A_KOFF + kdst) = kreg; *(LAS u32x4*)(L + A_VOFF + vdst) = vreg; if (FOX) *(LAS float*)(L + A_BOFF + tid * 4) = breg;
    __syncthreads();
    int buf = 0; bool started = started0;
    float pdummy = 0.f; int idummy = 0; f32x16 dm0; for (int i = 0; i < 16; ++i) dm0[i] = 0.f;
    for (;;) {
        const bool more = mk != 0ull; int jn = 0;
        if (more) { jn = 63 - __builtin_clzll(mk); mk &= ~(1ull << jn); const int kv0 = jn * 64;
            kreg = *(const u32x4*)(ksrc + (size_t)kv0 * DQK); vreg = *(const u32x4*)(vsrc + (size_t)kv0 * 64); if (FOX) breg = (cum_ref - cum[kv0 + lane]) * LOG2E; }
        { const int kv0 = j * 64;
          bool wave_has = true; float selb = 0.f;
          if (SLC) { const bool mine = ((j < 32 ? (selw0 >> j) : (selw1 >> (j - 32))) & 1u) != 0u; selb = mine ? 0.f : -INFINITY; wave_has = __any(mine); }
          if (wave_has && !(kv0 > tw0 + 31) && !(tw0 - (kv0 + 63) >= win)) {
            const bool need_mask = (kv0 + 63 > tw0) || (tw0 + 31 - kv0 >= win);
            const int dl = t_lane - kv0 - 4 * h;
            bf16x8v pa[NMAP][4];
#pragma unroll
            for (int mp = 0; mp < NMAP; ++mp) {
                f32x16 p0, p1;
                if (FOX) { const LAS f32x4* bl = (const LAS f32x4*)(L + A_BOFF + buf * A_BTILE + (tid >> 6) * 256) + h; const float mm = NOMAX ? 0.f : M[mp];
#pragma unroll
                    for (int g4 = 0; g4 < 4; ++g4) { const f32x4 b0 = bl[2 * g4], b1 = bl[8 + 2 * g4];
                        p0[4 * g4 + 0] = b0.x - mm; p0[4 * g4 + 1] = b0.y - mm; p0[4 * g4 + 2] = b0.z - mm; p0[4 * g4 + 3] = b0.w - mm; p1[4 * g4 + 0] = b1.x - mm; p1[4 * g4 + 1] = b1.y - mm; p1[4 * g4 + 2] = b1.z - mm; p1[4 * g4 + 3] = b1.w - mm; } }
                else { const float base_l = (slope2 * (float)(kv0 + 4 * h - tw0) - (NOMAX ? 0.f : M[mp])) + selb, s8 = slope2 * 8.f, s32 = slope2 * 32.f;
                    p0[0] = base_l; p0[1] = p0[0] + slope2; p0[2] = p0[1] + slope2; p0[3] = p0[2] + slope2;
#pragma unroll
                    for (int reg = 4; reg < 16; ++reg) p0[reg] = p0[reg - 4] + s8;
#pragma unroll
                    for (int reg = 0; reg < 16; ++reg) p1[reg] = p0[reg] + s32; }
                const LAS unsigned char* kb = kfrag + buf * A_KBUF + (DQK == 32 ? mp * 5120 : 0);
#pragma unroll
                for (int s = 0; s < DQK / 16; ++s) { const bf16x8v kf0 = *(const LAS bf16x8v*)(kb + s * 32), kf1 = *(const LAS bf16x8v*)(kb + 32 * KP + s * 32);
#ifdef PROBE_X_LDSK
                    { const bf16x8v z0 = *(const volatile LAS bf16x8v*)(kb + s * 32), z1 = *(const volatile LAS bf16x8v*)(kb + 32 * KP + s * 32); idummy ^= z0[0] ^ z1[1]; }
#endif
#ifdef PROBE_X_MFMA
                    dm0 = __builtin_amdgcn_mfma_f32_32x32x16_bf16(kf0, Qf[mp][s], dm0, 0, 0, 0); dm0 = __builtin_amdgcn_mfma_f32_32x32x16_bf16(kf1, Qf[mp][s], dm0, 0, 0, 0);
#endif
                    p0 = __builtin_amdgcn_mfma_f32_32x32x16_bf16(kf0, Qf[mp][s], p0, 0, 0, 0); p1 = __builtin_amdgcn_mfma_f32_32x32x16_bf16(kf1, Qf[mp][s], p1, 0, 0, 0); }
                if (need_mask) {
#pragma unroll
                    for (int reg = 0; reg < 16; ++reg) { const int d0 = dl - crow0(reg), d1 = d0 - 32;
                        p0[reg] = (d0 >= 0 && d0 < win) ? p0[reg] : -INFINITY; p1[reg] = (d1 >= 0 && d1 < win) ? p1[reg] : -INFINITY; } }
                if (!NOMAX) {
                float mt = fmaxf(fmaxf(p0[0], p1[0]), fmaxf(p0[1], p1[1]));
#pragma unroll
                for (int reg = 2; reg < 16; reg += 2) mt = fmaxf(fmaxf(mt, fmaxf(fmaxf(p0[reg], p1[reg]), p0[reg + 1])), p1[reg + 1]);
                mt = swap_max(mt);
                if (!started || __any(mt > 8.f)) {
                    const float d = (mt > -1e30f) ? (started ? fmaxf(mt, 0.f) : mt) : 0.f, alpha = __builtin_amdgcn_exp2f(-d);
                    O[mp][0] *= alpha; O[mp][1] *= alpha; Ls[mp] *= alpha; M[mp] += d;
#pragma unroll
                    for (int reg = 0; reg < 16; ++reg) { p0[reg] -= d; p1[reg] -= d; } } }
                float rs = 0.f;
#ifdef PROBE_X_EXP
#pragma unroll
                for (int reg = 0; reg < 16; ++reg) { pdummy += __builtin_amdgcn_exp2f(p0[reg] - 1.f) + __builtin_amdgcn_exp2f(p1[reg] - 1.f); }
#endif
#pragma unroll
                for (int reg = 0; reg < 16; ++reg) { p0[reg] = __builtin_amdgcn_exp2f(p0[reg]); p1[reg] = __builtin_amdgcn_exp2f(p1[reg]); rs += p0[reg] + p1[reg]; }
                Ls[mp] += rs;
                pa[mp][0] = pack8(p0, 0); pa[mp][1] = pack8(p0, 8); pa[mp][2] = pack8(p1, 0); pa[mp][3] = pack8(p1, 8);
            }
            started = true;
            const LAS unsigned char* vb = vfrag + buf * A_VBUF;
#pragma unroll
            for (int db = 0; db < 2; ++db)
#pragma unroll
                for (int ks = 0; ks < 4; ++ks) { const s16x4 lo = tr_read(vb + ks * (16 * VP) + db * 64), hi = tr_read(vb + ks * (16 * VP) + db * 64 + 8 * VP);
                    const bf16x8v vf = {lo[0], lo[1], lo[2], lo[3], hi[0], hi[1], hi[2], hi[3]};
#pragma unroll
                    for (int mp = 0; mp < NMAP; ++mp) O[mp][db] = __builtin_amdgcn_mfma_f32_32x32x16_bf16(vf, pa[mp][ks], O[mp][db], 0, 0, 0); }
          } }
        if (more) { *(LAS u32x4*)(L + A_KOFF + (buf ^ 1) * A_KBUF + kdst) = kreg; *(LAS u32x4*)(L + A_VOFF + (buf ^ 1) * A_VBUF + vdst) = vreg; if (FOX) *(LAS float*)(L + A_BOFF + (buf ^ 1) * A_BTILE + tid * 4) = breg; }
#ifdef PROBE_X_BAR
        __syncthreads();
#endif
        __syncthreads();
        if (!more) break;
        j = jn; buf ^= 1;
    }
    if (pdummy == 123.456f || idummy == 0x7fffabcd || dm0[3] == 98765.4321f) Ls[0] += 1e-30f;
}
#ifndef AC2_MODE
#define AC2_MODE 0
#endif
#ifndef AC2_INIT_VALU
#define AC2_INIT_VALU 24
#endif
template <bool FOX, bool SLC>
__device__ __forceinline__ void attn_core2(LAS unsigned char* L, const bf16* Kb0, const bf16* Vb, const LAS float* cum, float cum_ref,
                                           const bf16x8v (&Qf)[4], u64 tilemask, int t_lane, int tw0, int win, float slope2, unsigned selw0, unsigned selw1,
                                           f32x16 (&O)[2], float& M, float& Ls, int tid) {
    constexpr int KP = 144, VP = 192;
    const int lane = tid & 63, r = lane & 31, h = lane >> 5;
    const int kdst = (tid >> 3) * KP + (tid & 7) * 16; const bf16* ksrc = Kb0 + b64_off(tid >> 3, (tid & 7) * 8);
    const int vdst = (tid >> 3) * VP + (tid & 7) * 16; const bf16* vsrc = Vb + b64_off(tid >> 3, (tid & 7) * 8);
    const LAS unsigned char* kfrag = L + A_KOFF + r * KP + h * 16;
    const LAS unsigned char* vfrag = L + A_VOFF + (4 * h + ((lane & 15) >> 2)) * VP + (16 * ((lane >> 4) & 1) + 4 * (lane & 3)) * 2;
#define AC2_ACTIVE(jj) (!((jj) * 64 > tw0 + 31) && !(tw0 - ((jj) * 64 + 63) >= win))
#define AC2_INIT(jj, kslot, q0, q1) do { const int kv0_ = (jj) * 64; \
        if (FOX) { const LAS f32x4* bl = (const LAS f32x4*)(L + A_BOFF + (kslot) * 256) + h; const float mm = M; \
            _Pragma("unroll") for (int g4 = 0; g4 < 4; ++g4) { const f32x4 b0 = bl[2 * g4], b1 = bl[8 + 2 * g4]; \
                q0[4 * g4 + 0] = b0.x - mm; q0[4 * g4 + 1] = b0.y - mm; q0[4 * g4 + 2] = b0.z - mm; q0[4 * g4 + 3] = b0.w - mm; q1[4 * g4 + 0] = b1.x - mm; q1[4 * g4 + 1] = b1.y - mm; q1[4 * g4 + 2] = b1.z - mm; q1[4 * g4 + 3] = b1.w - mm; } } \
        else { float selb = 0.f; if (SLC) selb = ((((jj) < 32) ? (selw0 >> (jj)) : (selw1 >> ((jj) - 32))) & 1u) ? 0.f : -INFINITY; \
            const float base_l = (slope2 * (float)(kv0_ + 4 * h - tw0) - M) + selb, s8 = slope2 * 8.f, s32 = slope2 * 32.f; \
            q0[0] = base_l; q0[1] = q0[0] + slope2; q0[2] = q0[1] + slope2; q0[3] = q0[2] + slope2; \
            _Pragma("unroll") for (int reg = 4; reg < 16; ++reg) q0[reg] = q0[reg - 4] + s8; \
            _Pragma("unroll") for (int reg = 0; reg < 16; ++reg) q1[reg] = q0[reg] + s32; } } while (0)
#define AC2_QK(jj, kslot) do { AC2_INIT(jj, kslot, p0, p1); \
        const LAS unsigned char* kb_ = kfrag + (kslot) * A_KBUF; \
        _Pragma("unroll") for (int s_ = 0; s_ < 4; ++s_) { const bf16x8v kf0 = *(const LAS bf16x8v*)(kb_ + s_ * 32), kf1 = *(const LAS bf16x8v*)(kb_ + 32 * KP + s_ * 32); \
            p0 = __builtin_amdgcn_mfma_f32_32x32x16_bf16(kf0, Qf[s_], p0, 0, 0, 0); p1 = __builtin_amdgcn_mfma_f32_32x32x16_bf16(kf1, Qf[s_], p1, 0, 0, 0); } } while (0)
    u32x4 kreg, vreg; float breg = 0.f;
    u64 mk = tilemask;
    int j = 63 - __builtin_clzll(mk); mk &= ~(1ull << j);
    int jn = -1; if (mk) { jn = 63 - __builtin_clzll(mk); mk &= ~(1ull << jn); }
    { kreg = *(const u32x4*)(ksrc + (size_t)j * 64 * 64); vreg = *(const u32x4*)(vsrc + (size_t)j * 64 * 64); if (FOX && tid < 64) breg = (cum_ref - cum[j * 64 + tid]) * LOG2E;
      *(LAS u32x4*)(L + A_KOFF + kdst) = kreg; *(LAS u32x4*)(L + A_VOFF + vdst) = vreg; if (FOX && tid < 64) *(LAS float*)(L + A_BOFF + tid * 4) = breg;
      if (jn >= 0) { kreg = *(const u32x4*)(ksrc + (size_t)jn * 64 * 64); if (FOX && tid < 64) breg = (cum_ref - cum[jn * 64 + tid]) * LOG2E;
          *(LAS u32x4*)(L + A_KOFF + A_KBUF + kdst) = kreg; if (FOX && tid < 64) *(LAS float*)(L + A_BOFF + 256 + tid * 4) = breg; } }
    __syncthreads();
    f32x16 p0, p1;
    bool started = false;
    int ks = 0, vs = 0;
    if (AC2_ACTIVE(j)) AC2_QK(j, 0);
    for (;;) {
        int jnn = -1; if (mk) { jnn = 63 - __builtin_clzll(mk); mk &= ~(1ull << jnn); }
        if (jnn >= 0) { kreg = *(const u32x4*)(ksrc + (size_t)jnn * 64 * 64); if (FOX && tid < 64) breg = (cum_ref - cum[jnn * 64 + tid]) * LOG2E; }
        if (jn >= 0) vreg = *(const u32x4*)(vsrc + (size_t)jn * 64 * 64);
        const bool act = AC2_ACTIVE(j), actn = jn >= 0 && AC2_ACTIVE(jn);
        if (act) {
            const int kv0 = j * 64;
            if ((kv0 + 63 > tw0) || (tw0 + 31 - kv0 >= win)) { const int dl = t_lane - kv0 - 4 * h;
#pragma unroll
                for (int reg = 0; reg < 16; ++reg) { const int d0 = dl - crow0(reg), d1 = d0 - 32;
                    p0[reg] = (d0 >= 0 && d0 < win) ? p0[reg] : -INFINITY; p1[reg] = (d1 >= 0 && d1 < win) ? p1[reg] : -INFINITY; } }
            float mt = fmaxf(fmaxf(p0[0], p1[0]), fmaxf(p0[1], p1[1]));
#pragma unroll
            for (int reg = 2; reg < 16; reg += 2) mt = fmaxf(fmaxf(mt, fmaxf(fmaxf(p0[reg], p1[reg]), p0[reg + 1])), p1[reg + 1]);
            mt = swap_max(mt);
            if (!started || __any(mt > 8.f)) {
                const float d = (mt > -1e30f) ? (started ? fmaxf(mt, 0.f) : mt) : 0.f, alpha = __builtin_amdgcn_exp2f(-d);
                O[0] *= alpha; O[1] *= alpha; Ls *= alpha; M += d;
#pragma unroll
                for (int reg = 0; reg < 16; ++reg) { p0[reg] -= d; p1[reg] -= d; } }
            started = true;
#if AC2_MODE == 1
            {
                const int jq = jn >= 0 ? jn : 0;
                float rs = 0.f;
#pragma unroll
                for (int reg = 0; reg < 16; ++reg) { p0[reg] = __builtin_amdgcn_exp2f(p0[reg]); p1[reg] = __builtin_amdgcn_exp2f(p1[reg]); rs += p0[reg] + p1[reg]; }
                Ls += rs;
                const bf16x8v pa0 = pack8(p0, 0), pa1 = pack8(p0, 8), pa2 = pack8(p1, 0), pa3 = pack8(p1, 8);
                AC2_QK(jq, ks ^ 1);
                const LAS unsigned char* vb = vfrag + vs * A_VBUF;
#pragma unroll
                for (int db = 0; db < 2; ++db)
#pragma unroll
                    for (int kq = 0; kq < 4; ++kq) { const s16x4 lo = tr_read(vb + kq * (16 * VP) + db * 64), hi = tr_read(vb + kq * (16 * VP) + db * 64 + 8 * VP);
                        const bf16x8v vf = {lo[0], lo[1], lo[2], lo[3], hi[0], hi[1], hi[2], hi[3]};
                        O[db] = __builtin_amdgcn_mfma_f32_32x32x16_bf16(vf, kq == 0 ? pa0 : kq == 1 ? pa1 : kq == 2 ? pa2 : pa3, O[db], 0, 0, 0); }
            }
#else
            {
                const int jq = jn >= 0 ? jn : 0;
                f32x16 n0, n1;
                AC2_INIT(jq, ks ^ 1, n0, n1);
                const LAS unsigned char* kb_ = kfrag + (ks ^ 1) * A_KBUF;
                bf16x8v kf[8];
#pragma unroll
                for (int s_ = 0; s_ < 4; ++s_) { kf[2 * s_] = *(const LAS bf16x8v*)(kb_ + s_ * 32); kf[2 * s_ + 1] = *(const LAS bf16x8v*)(kb_ + 32 * KP + s_ * 32); }
                const LAS unsigned char* vb = vfrag + vs * A_VBUF;
                __builtin_amdgcn_sched_barrier(0);
                float ra = 0.f, rb = 0.f; unsigned w[16];
#define AC2_PINF(x) asm volatile("" : "+v"(x))
#define AC2_QGAP(i) do { if ((i) & 1) n1 = __builtin_amdgcn_mfma_f32_32x32x16_bf16(kf[i], Qf[(i) >> 1], n1, 0, 0, 0); else n0 = __builtin_amdgcn_mfma_f32_32x32x16_bf16(kf[i], Qf[(i) >> 1], n0, 0, 0, 0); \
                    float e0 = __builtin_amdgcn_exp2f(p0[2 * (i)]), e1 = __builtin_amdgcn_exp2f(p0[2 * (i) + 1]), e2 = __builtin_amdgcn_exp2f(p1[2 * (i)]), e3 = __builtin_amdgcn_exp2f(p1[2 * (i) + 1]); \
                    ra += e0 + e1; rb += e2 + e3; \
                    AC2_PINF(e0); AC2_PINF(e1); AC2_PINF(e2); AC2_PINF(e3); AC2_PINF(ra); AC2_PINF(rb); \
                    p0[2 * (i)] = e0; p0[2 * (i) + 1] = e1; p1[2 * (i)] = e2; p1[2 * (i) + 1] = e3; \
                    if ((i) >= 4) { w[2 * ((i) - 4)] = cvtpk(p0[4 * ((i) - 4)], p0[4 * ((i) - 4) + 1]); w[2 * ((i) - 4) + 1] = cvtpk(p0[4 * ((i) - 4) + 2], p0[4 * ((i) - 4) + 3]); AC2_PINF(w[2 * ((i) - 4)]); AC2_PINF(w[2 * ((i) - 4) + 1]); } \
                    if ((i) == 6) { vl[0] = tr_read(vb); vh[0] = tr_read(vb + 8 * VP); } \
                    if ((i) == 7) { vl[1] = tr_read(vb + 64); vh[1] = tr_read(vb + 64 + 8 * VP); } \
                    __builtin_amdgcn_sched_barrier(0); } while (0)
                s16x4 vl[2], vh[2];
                AC2_QGAP(0); AC2_QGAP(1); AC2_QGAP(2); AC2_QGAP(3); AC2_QGAP(4); AC2_QGAP(5); AC2_QGAP(6); AC2_QGAP(7);
                Ls += ra + rb;
#define AC2_PA(kq) __builtin_bit_cast(bf16x8v, (u32x4){w[4 * (kq)], w[4 * (kq) + 1], w[4 * (kq) + 2], w[4 * (kq) + 3]})
#define AC2_PGAP(g) do { const int kq_ = (g) >> 1, db_ = (g) & 1; const bf16x8v vf = {vl[(g) & 1][0], vl[(g) & 1][1], vl[(g) & 1][2], vl[(g) & 1][3], vh[(g) & 1][0], vh[(g) & 1][1], vh[(g) & 1][2], vh[(g) & 1][3]}; \
                    if ((g) < 6) { const int kq2 = ((g) + 2) >> 1, db2 = (g) & 1; vl[(g) & 1] = tr_read(vb + kq2 * (16 * VP) + db2 * 64); vh[(g) & 1] = tr_read(vb + kq2 * (16 * VP) + db2 * 64 + 8 * VP); } \
                    O[db_] = __builtin_amdgcn_mfma_f32_32x32x16_bf16(vf, AC2_PA(kq_), O[db_], 0, 0, 0); \
                    if ((g) < 4) { w[8 + 2 * (g)] = cvtpk(p1[4 * (g)], p1[4 * (g) + 1]); w[8 + 2 * (g) + 1] = cvtpk(p1[4 * (g) + 2], p1[4 * (g) + 3]); AC2_PINF(w[8 + 2 * (g)]); AC2_PINF(w[8 + 2 * (g) + 1]); } \
                    __builtin_amdgcn_sched_barrier(0); } while (0)
                AC2_PGAP(0); AC2_PGAP(1); AC2_PGAP(2); AC2_PGAP(3); AC2_PGAP(4); AC2_PGAP(5); AC2_PGAP(6); AC2_PGAP(7);
#undef AC2_PGAP
#undef AC2_PA
#undef AC2_QGAP
#undef AC2_PINF
                p0 = n0; p1 = n1;
            }
#endif
        } else if (actn) AC2_QK(jn, ks ^ 1);
        if (jnn >= 0) { *(LAS u32x4*)(L + A_KOFF + ks * A_KBUF + kdst) = kreg; if (FOX && tid < 64) *(LAS float*)(L + A_BOFF + ks * 256 + tid * 4) = breg; }
        if (jn >= 0) *(LAS u32x4*)(L + A_VOFF + (vs ^ 1) * A_VBUF + vdst) = vreg;
        __syncthreads();
        if (jn < 0) break;
        j = jn; jn = jnn; ks ^= 1; vs ^= 1;
    }
#undef AC2_QK
#undef AC2_INIT
#undef AC2_ACTIVE
}
__device__ __forceinline__ size_t mix_off(size_t n, int c, int W) { return ((n >> 5) * (size_t)(W / 8) + (size_t)(c >> 3)) * 256 + (n & 31) * 8 + (c & 7); }
#define ATTN_FOR_CHUNKS(db, g4) _Pragma("unroll") for (int db = 0; db < 2; ++db) _Pragma("unroll") for (int g4 = 0; g4 < 4; ++g4)

__device__ __forceinline__ void unpack8(const u32x4 w, float (&f)[8]) { f[0] = __uint_as_float(w.x << 16); f[1] = __uint_as_float(w.x & 0xffff0000u); f[2] = __uint_as_float(w.y << 16); f[3] = __uint_as_float(w.y & 0xffff0000u);
    f[4] = __uint_as_float(w.z << 16); f[5] = __uint_as_float(w.z & 0xffff0000u); f[6] = __uint_as_float(w.w << 16); f[7] = __uint_as_float(w.w & 0xffff0000u); }
__device__ __forceinline__ void ph_norm_bf16_from_bf16(const Ctx& c, const bf16* x, const float* g, bf16* out) {
    constexpr int RB = 4; float gg[2][8];
#pragma unroll
    for (int j = 0; j < 2; ++j) { const f32x4 a = ((const f32x4*)g)[2 * c.lane + 128 * j], b2 = ((const f32x4*)g)[2 * c.lane + 128 * j + 1]; gg[j][0] = a.x; gg[j][1] = a.y; gg[j][2] = a.z; gg[j][3] = a.w; gg[j][4] = b2.x; gg[j][5] = b2.y; gg[j][6] = b2.z; gg[j][7] = b2.w; }
    for (int row0 = c.gw * RB; row0 < NT; row0 += c.ngw * RB) {
        u32x4 v[RB][2];
#pragma unroll
        for (int q = 0; q < RB; ++q)
#pragma unroll
            for (int j = 0; j < 2; ++j) v[q][j] = ((const u32x4*)(x + (size_t)(row0 + q) * D_))[c.lane + 64 * j];
#pragma unroll
        for (int q = 0; q < RB; ++q) { float f[2][8]; float ss = 0.f;
#pragma unroll
            for (int j = 0; j < 2; ++j) { unpack8(v[q][j], f[j]);
#pragma unroll
                for (int e = 0; e < 8; ++e) ss = fmaf(f[j][e], f[j][e], ss); }
            const float r = rsqrtf(wave_sum_l(ss, c.lane) * (1.f / D_) + EPS);
#pragma unroll
            for (int j = 0; j < 2; ++j) { u32x4 o; o.x = pk2(f[j][0] * r * gg[j][0], f[j][1] * r * gg[j][1]); o.y = pk2(f[j][2] * r * gg[j][2], f[j][3] * r * gg[j][3]); o.z = pk2(f[j][4] * r * gg[j][4], f[j][5] * r * gg[j][5]); o.w = pk2(f[j][6] * r * gg[j][6], f[j][7] * r * gg[j][7]);
                ((u32x4*)(out + (size_t)(row0 + q) * D_))[c.lane + 64 * j] = o; } }
    }
}
__device__ __forceinline__ void ph_norm_final_from_bf16(const Ctx& c, const bf16* x, const float* g, float* out) {
    constexpr int RB = 4; float gg[2][8];
#pragma unroll
    for (int j = 0; j < 2; ++j) { const f32x4 a = ((const f32x4*)g)[2 * c.lane + 128 * j], b2 = ((const f32x4*)g)[2 * c.lane + 128 * j + 1]; gg[j][0] = a.x; gg[j][1] = a.y; gg[j][2] = a.z; gg[j][3] = a.w; gg[j][4] = b2.x; gg[j][5] = b2.y; gg[j][6] = b2.z; gg[j][7] = b2.w; }
    for (int row0 = c.gw * RB; row0 < NT; row0 += c.ngw * RB) {
        u32x4 v[RB][2];
#pragma unroll
        for (int q = 0; q < RB; ++q)
#pragma unroll
            for (int j = 0; j < 2; ++j) v[q][j] = ((const u32x4*)(x + (size_t)(row0 + q) * D_))[c.lane + 64 * j];
#pragma unroll
        for (int q = 0; q < RB; ++q) { float f[2][8]; float ss = 0.f;
#pragma unroll
            for (int j = 0; j < 2; ++j) { unpack8(v[q][j], f[j]);
#pragma unroll
                for (int e = 0; e < 8; ++e) ss = fmaf(f[j][e], f[j][e], ss); }
            const float r = rsqrtf(wave_sum_l(ss, c.lane) * (1.f / D_) + EPS);
#pragma unroll
            for (int j = 0; j < 2; ++j) { f32x4* o = (f32x4*)(out + (size_t)(row0 + q) * D_) + 2 * c.lane + 128 * j;
                o[0] = (f32x4){f[j][0] * r * gg[j][0], f[j][1] * r * gg[j][1], f[j][2] * r * gg[j][2], f[j][3] * r * gg[j][3]}; o[1] = (f32x4){f[j][4] * r * gg[j][4], f[j][5] * r * gg[j][5], f[j][6] * r * gg[j][6], f[j][7] * r * gg[j][7]}; } }
    }
}
__device__ __forceinline__ void ph_norm_bf16(const Ctx& c, const float* x, const float* g, bf16* out, bf16* raw) {
    constexpr int RB = 4;
    f32x4 gg[4];
#pragma unroll
    for (int j = 0; j < 4; ++j) gg[j] = ((const f32x4*)g)[c.lane + 64 * j];
    for (int row0 = c.gw * RB; row0 < NT; row0 += c.ngw * RB) {
        f32x4 v[RB][4];
#pragma unroll
        for (int q = 0; q < RB; ++q)
#pragma unroll
            for (int j = 0; j < 4; ++j) v[q][j] = ((const f32x4*)(x + (size_t)(row0 + q) * D_))[c.lane + 64 * j];
#pragma unroll
        for (int q = 0; q < RB; ++q) { float ss = 0.f;
#pragma unroll
            for (int j = 0; j < 4; ++j) ss += v[q][j].x * v[q][j].x + v[q][j].y * v[q][j].y + v[q][j].z * v[q][j].z + v[q][j].w * v[q][j].w;
            const float r = rsqrtf(wave_sum_l(ss, c.lane) * (1.f / D_) + EPS);
            u64* o8 = (u64*)(out + (size_t)(row0 + q) * D_) + c.lane; u64* r8 = (u64*)(raw + (size_t)(row0 + q) * D_) + c.lane;
#pragma unroll
            for (int j = 0; j < 4; ++j) { o8[64 * j] = (u64)pk2(v[q][j].x * r * gg[j].x, v[q][j].y * r * gg[j].y) | ((u64)pk2(v[q][j].z * r * gg[j].z, v[q][j].w * r * gg[j].w) << 32);
                r8[64 * j] = (u64)pk2(v[q][j].x, v[q][j].y) | ((u64)pk2(v[q][j].z, v[q][j].w) << 32); } }
    }
}
__device__ __forceinline__ void ph_norm_final(const Ctx& c, float* x, const float* g) {
    constexpr int RB = 4;
    f32x4 gg[4];
#pragma unroll
    for (int j = 0; j < 4; ++j) gg[j] = ((const f32x4*)g)[c.lane + 64 * j];
    for (int row0 = c.gw * RB; row0 < NT; row0 += c.ngw * RB) {
        f32x4 v[RB][4];
#pragma unroll
        for (int q = 0; q < RB; ++q)
#pragma unroll
            for (int j = 0; j < 4; ++j) v[q][j] = ((const f32x4*)(x + (size_t)(row0 + q) * D_))[c.lane + 64 * j];
#pragma unroll
        for (int q = 0; q < RB; ++q) { float ss = 0.f;
#pragma unroll
            for (int j = 0; j < 4; ++j) ss += v[q][j].x * v[q][j].x + v[q][j].y * v[q][j].y + v[q][j].z * v[q][j].z + v[q][j].w * v[q][j].w;
            const float r = rsqrtf(wave_sum_l(ss, c.lane) * (1.f / D_) + EPS);
            f32x4* xr = (f32x4*)(x + (size_t)(row0 + q) * D_) + c.lane;
#pragma unroll
            for (int j = 0; j < 4; ++j) xr[64 * j] = v[q][j] * r * gg[j]; }
    }
}

template <class AF, class EF>
__device__ __forceinline__ void naive_gemm(const Ctx& c, int M, int N, int K, AF af, const float* W, int ldb, EF ef) {
    LAS float* As = (LAS float*)c.lds;
    LAS float* Bs = As + 16 * 132;
    const int tm = (M + 127) / 128, tn = (N + 127) / 128, ntile = tm * tn;
    const int ty = c.tid >> 4, tx = c.tid & 15;
    for (int tile = c.bid; tile < ntile; tile += c.G) {
        const int m0 = (tile / tn) * 128, n0 = (tile % tn) * 128;
        float acc[4][8];
#pragma unroll
        for (int i = 0; i < 4; ++i)
#pragma unroll
            for (int j = 0; j < 8; ++j) acc[i][j] = 0.f;
        for (int k0 = 0; k0 < K; k0 += 16) {
            __syncthreads();
#pragma unroll
            for (int i = 0; i < 4; ++i) { const int e = c.tid + i * 512, r = e >> 4, kk = e & 15; const int row = m0 + r;
                As[kk * 132 + r] = (row < M) ? af(row, k0 + kk) : 0.f; }
#pragma unroll
            for (int i = 0; i < 4; ++i) { const int e = c.tid + i * 512, kk = e >> 7, cc = e & 127; const int col = n0 + cc;
                Bs[kk * 132 + cc] = (col < N) ? W[(size_t)(k0 + kk) * ldb + col] : 0.f; }
            __syncthreads();
#pragma unroll 2
            for (int kk = 0; kk < 16; ++kk) {
                float a[4], b[8];
#pragma unroll
                for (int i = 0; i < 4; ++i) a[i] = As[kk * 132 + ty * 4 + i];
#pragma unroll
                for (int j = 0; j < 8; ++j) b[j] = Bs[kk * 132 + tx * 8 + j];
#pragma unroll
                for (int i = 0; i < 4; ++i)
#pragma unroll
                    for (int j = 0; j < 8; ++j) acc[i][j] = fmaf(a[i], b[j], acc[i][j]);
            }
        }
        LAS float* Cs = Bs + 16 * 132;
        __syncthreads();
#pragma unroll
        for (int i = 0; i < 4; ++i)
#pragma unroll
            for (int j = 0; j < 8; ++j) Cs[(ty * 4 + i) * 129 + tx * 8 + j] = acc[i][j];
        __syncthreads();
#pragma unroll 1
        for (int e = c.tid; e < 128 * 128; e += NTHREADS) { const int r = e >> 7, cc = e & 127, row = m0 + r, col = n0 + cc; if (row < M && col < N) ef(row, col, Cs[r * 129 + cc]); }
    }
    __syncthreads();
}

struct InProjOut { bf16* qn; bf16* kv6; bf16* fqkv; bf16* dqk; bf16* dv; float* gate; float* fl; const float* b_gate; const float* b_fgt; };
__device__ __forceinline__ void inproj_store(const InProjOut& o, int n, int col, float v) {
    const int b = n / T_, t = n % T_;
    if (col < C_KV6) { const int h = col >> 6, d = col & 63; o.qn[((size_t)(b * 8 + h) * T_ + t) * 64 + d] = (bf16)f2bf(v * (0.125f * LOG2E)); }
    else if (col < C_GATE) { const int cc = col - C_KV6, idx = cc >> 7, g = (cc >> 6) & 1, d = cc & 63;
        ((bf16*)((unsigned char*)o.kv6 + idx * KV6_STRIDE))[((size_t)(b * 2 + g) * T_ + t) * 64 + d] = (bf16)f2bf(v); }
    else if (col < C_FQ) { const int j = col - C_GATE; o.gate[(size_t)n * 24 + j] = sigmoidf_(v + o.b_gate[j]); }
    else if (col < C_FF) { const int cc = col - C_FQ, idx = cc >> 8, h = (cc >> 6) & 3, d = cc & 63;
        o.fqkv[(size_t)idx * (8 * MiB) + ((size_t)(b * 4 + h) * T_ + t) * 64 + d] = (bf16)f2bf(idx == 0 ? v * (0.125f * LOG2E) : v); }
    else if (col < C_DQ) { const int h = col - C_FF; o.fl[(size_t)(b * 4 + h) * T_ + t] = log_sigmoidf_(v + o.b_fgt[h]); }
    else if (col < C_DV) { const int cc = col - C_DQ, idx = cc >> 8, h = (cc >> 6) & 3, i = (cc >> 5) & 1, d = cc & 31;
        o.dqk[(size_t)idx * (8 * MiB) + ((size_t)((b * 4 + h) * 2 + i) * T_ + t) * 32 + d] = (bf16)f2bf(idx == 0 ? v * (0.17677669529663687f * LOG2E) : v); }
    else { const int cc = col - C_DV, h = cc >> 6, d = cc & 63; o.dv[((size_t)(b * 4 + h) * T_ + t) * 64 + d] = (bf16)f2bf(v); }
}

__device__ __forceinline__ void ph_cumsum(const Ctx& c, float* fl) {
    for (int s = c.gw; s < B_ * 4; s += c.ngw) {
        float* p = fl + (size_t)s * T_; float carry = 0.f;
        for (int t0 = 0; t0 < T_; t0 += 64) {
            float v = p[t0 + c.lane];
#pragma unroll
            for (int o = 1; o < 64; o <<= 1) { const float u = __shfl_up(v, o); if (c.lane >= o) v += u; }
            v += carry; p[t0 + c.lane] = v; carry = __shfl(v, 63);
        }
    }
}

template <int DQK>
__device__ __forceinline__ float naive_attn_row(const bf16* q, const bf16* K, const bf16* V, int t, u64 mask, float slope2, const float* cum, int win, int lane) {
    float qv[DQK];
    { const u32x4* q4 = (const u32x4*)q;
#pragma unroll
      for (int i = 0; i < DQK / 8; ++i) { const u32x4 w = q4[i];
          qv[8 * i + 0] = __uint_as_float(w.x << 16); qv[8 * i + 1] = __uint_as_float(w.x & 0xffff0000u);
          qv[8 * i + 2] = __uint_as_float(w.y << 16); qv[8 * i + 3] = __uint_as_float(w.y & 0xffff0000u);
          qv[8 * i + 4] = __uint_as_float(w.z << 16); qv[8 * i + 5] = __uint_as_float(w.z & 0xffff0000u);
          qv[8 * i + 6] = __uint_as_float(w.w << 16); qv[8 * i + 7] = __uint_as_float(w.w & 0xffff0000u); } }
    const float cumt = cum ? cum[t] : 0.f;
    float m = -INFINITY, l = 0.f, o = 0.f;
    while (mask) {
        const int j = __builtin_ctzll(mask); mask &= mask - 1;
        const int kpos = 64 * j + lane; const int dist = t - kpos;
        const bool valid = dist >= 0 && dist < win;
        float s = 0.f;
        { const u32x4* k4 = (const u32x4*)(K + (size_t)kpos * DQK);
#pragma unroll
          for (int i = 0; i < DQK / 8; ++i) { const u32x4 w = k4[i];
              s = fmaf(qv[8 * i + 0], __uint_as_float(w.x << 16), s); s = fmaf(qv[8 * i + 1], __uint_as_float(w.x & 0xffff0000u), s);
              s = fmaf(qv[8 * i + 2], __uint_as_float(w.y << 16), s); s = fmaf(qv[8 * i + 3], __uint_as_float(w.y & 0xffff0000u), s);
              s = fmaf(qv[8 * i + 4], __uint_as_float(w.z << 16), s); s = fmaf(qv[8 * i + 5], __uint_as_float(w.z & 0xffff0000u), s);
              s = fmaf(qv[8 * i + 6], __uint_as_float(w.w << 16), s); s = fmaf(qv[8 * i + 7], __uint_as_float(w.w & 0xffff0000u), s); } }
        s -= slope2 * (float)dist;
        if (cum) s += (cumt - cum[kpos]) * LOG2E;
        s = valid ? s : -INFINITY;
        const float mb = wave_max(s);
        if (mb == -INFINITY) continue;
        const float mn = fmaxf(m, mb), alpha = exp2f(m - mn);
        const float p = valid ? exp2f(s - mn) : 0.f;
        l = l * alpha + wave_sum(p); o *= alpha; m = mn;
        const bf16* vb = V + (size_t)(64 * j) * 64 + lane;
#pragma unroll 8
        for (int k = 0; k < 64; ++k) o = fmaf(__shfl(p, k), bf2f(vb[(size_t)k * 64]), o);
    }
    return l > 0.f ? o / l : 0.f;
}

__device__ __forceinline__ void ph_cmp_attn(const Ctx& c, const bf16* qn, const bf16* kcmp, const bf16* vcmp, const float* gate, u64* sel, bf16* ocmp) {
    LAS float* pl = (LAS float*)(c.lds) + c.wave * 256;
    const int lane = c.lane;
    for (int it = c.gw; it < B_ * 2 * T_; it += c.ngw) {
        const int t = it % T_, bg = it / T_, b = bg >> 1, g = bg & 1;
        const int nvis = (t >= 31) ? ((t - 31) >> 4) + 1 : 0;
        const bf16* kc = kcmp + (size_t)bg * 256 * 64; const bf16* vc = vcmp + (size_t)bg * 256 * 64;
        float imp = 0.f;
        for (int hg = 0; hg < 4; ++hg) {
            const int h = g * 4 + hg; const float slope2 = alibi_slope(h + 1, 8) * LOG2E;
            const bf16* q = qn + ((size_t)(b * 8 + h) * T_ + t) * 64;
            float qv[64];
            { const u32x4* q4 = (const u32x4*)q;
#pragma unroll
              for (int i = 0; i < 8; ++i) { const u32x4 w = q4[i];
                  qv[8 * i + 0] = __uint_as_float(w.x << 16); qv[8 * i + 1] = __uint_as_float(w.x & 0xffff0000u);
                  qv[8 * i + 2] = __uint_as_float(w.y << 16); qv[8 * i + 3] = __uint_as_float(w.y & 0xffff0000u);
                  qv[8 * i + 4] = __uint_as_float(w.z << 16); qv[8 * i + 5] = __uint_as_float(w.z & 0xffff0000u);
                  qv[8 * i + 6] = __uint_as_float(w.w << 16); qv[8 * i + 7] = __uint_as_float(w.w & 0xffff0000u); } }
            float s[4]; float m = -INFINITY;
#pragma unroll
            for (int i = 0; i < 4; ++i) { const int cc = lane + 64 * i; float a = 0.f;
                if (cc < nvis) { const u32x4* k4 = (const u32x4*)(kc + (size_t)cc * 64);
#pragma unroll
                    for (int e = 0; e < 8; ++e) { const u32x4 w = k4[e];
                        a = fmaf(qv[8 * e + 0], __uint_as_float(w.x << 16), a); a = fmaf(qv[8 * e + 1], __uint_as_float(w.x & 0xffff0000u), a);
                        a = fmaf(qv[8 * e + 2], __uint_as_float(w.y << 16), a); a = fmaf(qv[8 * e + 3], __uint_as_float(w.y & 0xffff0000u), a);
                        a = fmaf(qv[8 * e + 4], __uint_as_float(w.z << 16), a); a = fmaf(qv[8 * e + 5], __uint_as_float(w.z & 0xffff0000u), a);
                        a = fmaf(qv[8 * e + 6], __uint_as_float(w.w << 16), a); a = fmaf(qv[8 * e + 7], __uint_as_float(w.w & 0xffff0000u), a); }
                    a -= slope2 * (float)(t - (16 * cc + 31)); } else a = -INFINITY;
                s[i] = a; m = fmaxf(m, a); }
            m = wave_max(m);
            float p[4], lsum = 0.f;
#pragma unroll
            for (int i = 0; i < 4; ++i) { p[i] = (lane + 64 * i < nvis) ? exp2f(s[i] - m) : 0.f; lsum += p[i]; }
            lsum = wave_sum(lsum);
            const float inv = lsum > 0.f ? 1.f / lsum : 0.f;
#pragma unroll
            for (int i = 0; i < 4; ++i) { p[i] *= inv; pl[lane + 64 * i] = p[i]; }
            asm volatile("s_waitcnt lgkmcnt(0)" ::: "memory");
            float o = 0.f;
            for (int cc = 0; cc < nvis; ++cc) o = fmaf(pl[cc], bf2f(vc[(size_t)cc * 64 + lane]), o);
            const float gt = gate[((size_t)(b * T_ + t)) * 24 + h * 3 + 0];
            ocmp[(size_t)(b * T_ + t) * 512 + h * 64 + lane] = (bf16)f2bf(gt * o);
            { const int j = lane; float a = pl[4 * j] + pl[4 * j + 1] + pl[4 * j + 2] + 0.5f * pl[4 * j + 3]; if (j > 0) a += 0.5f * pl[4 * j - 1]; imp += a; }
            asm volatile("s_waitcnt lgkmcnt(0)" ::: "memory");
        }
        const int cur = t >> 6; const int j = lane;
        u64 m64;
        if (cur <= 15) m64 = (cur == 63) ? ~0ull : ((1ull << (cur + 1)) - 1ull);
        else {
            float val = (j > cur) ? -INFINITY : ((j == 0 || j == cur || j == cur - 1) ? 1e4f : imp);
            m64 = 0ull;
            for (int r = 0; r < 16; ++r) {
                const float mx = wave_max(val);
                const u64 bal = __ballot(val == mx);
                const int w = __builtin_ctzll(bal);
                m64 |= 1ull << w; if (j == w) val = -INFINITY;
            }
        }
        if (lane == 0) sel[(size_t)bg * T_ + t] = m64;
    }
}

__device__ __forceinline__ void ph_win_attn(const Ctx& c, const bf16* qn, const bf16* kw, const bf16* vw, const float* gate, bf16* owin) {
    for (int it = c.gw; it < B_ * 8 * T_; it += c.ngw) {
        const int t = it % T_, bh = it / T_, b = bh >> 3, h = bh & 7, g = h >> 2;
        const int cur = t >> 6, jlo = (t - 511) > 0 ? (t - 511) >> 6 : 0;
        const u64 hi = (cur == 63) ? ~0ull : ((1ull << (cur + 1)) - 1ull); const u64 mask = hi & ~((1ull << jlo) - 1ull);
        const float o = naive_attn_row<64>(qn + ((size_t)bh * T_ + t) * 64, kw + (size_t)(b * 2 + g) * T_ * 64, vw + (size_t)(b * 2 + g) * T_ * 64, t, mask,
                                           alibi_slope(h + 1, 8) * LOG2E, nullptr, 512, c.lane);
        owin[(size_t)(b * T_ + t) * 512 + h * 64 + c.lane] = (bf16)f2bf(gate[(size_t)(b * T_ + t) * 24 + h * 3 + 2] * o);
    }
}
__device__ __forceinline__ void ph_slc_attn(const Ctx& c, const bf16* qn, const bf16* ks, const bf16* vs, const float* gate, const u64* sel, const bf16* ocmp, const bf16* owin, bf16* att) {
    for (int it = c.gw; it < B_ * 8 * T_; it += c.ngw) {
        const int t = it % T_, bh = it / T_, b = bh >> 3, h = bh & 7, g = h >> 2;
        const u64 mask = sel[(size_t)(b * 2 + g) * T_ + t];
        const float o = naive_attn_row<64>(qn + ((size_t)bh * T_ + t) * 64, ks + (size_t)(b * 2 + g) * T_ * 64, vs + (size_t)(b * 2 + g) * T_ * 64, t, mask,
                                           alibi_slope(h + 1, 8) * LOG2E, nullptr, 1 << 30, c.lane);
        const size_t n = (size_t)(b * T_ + t);
        const float r = gate[n * 24 + h * 3 + 1] * o + bf2f(ocmp[n * 512 + h * 64 + c.lane]) + bf2f(owin[n * 512 + h * 64 + c.lane]);
        att[n * 1024 + h * 64 + c.lane] = (bf16)f2bf(r);
    }
}
__device__ __forceinline__ void ph_fox_attn(const Ctx& c, const bf16* fq, const bf16* fk, const bf16* fv, const float* cum, bf16* att) {
    for (int it = c.gw; it < B_ * 4 * T_; it += c.ngw) {
        const int t = it % T_, bh = it / T_, b = bh >> 2, h = bh & 3;
        const int cur = t >> 6; const u64 mask = (cur == 63) ? ~0ull : ((1ull << (cur + 1)) - 1ull);
        const float o = naive_attn_row<64>(fq + ((size_t)bh * T_ + t) * 64, fk + (size_t)bh * T_ * 64, fv + (size_t)bh * T_ * 64, t, mask, 0.f, cum + (size_t)bh * T_, 1 << 30, c.lane);
        att[(size_t)(b * T_ + t) * 1024 + 512 + h * 64 + c.lane] = (bf16)f2bf(o);
    }
}
__device__ __forceinline__ void ph_diff_attn(const Ctx& c, const bf16* dq, const bf16* dk, const bf16* dv, const float* lam, const float* subln, float lambda_init, bf16* att) {
    float l1 = 0.f, l2 = 0.f;
    if (c.lane < 32) { l1 = lam[c.lane] * lam[32 + c.lane]; l2 = lam[64 + c.lane] * lam[96 + c.lane]; }
    const float lam_full = __expf(wave_sum(l1)) - __expf(wave_sum(l2)) + lambda_init;
    const float sg = subln[c.lane] * (1.f - lambda_init);
    for (int it = c.gw; it < B_ * 4 * T_; it += c.ngw) {
        const int t = it % T_, bh = it / T_, b = bh >> 2, h = bh & 3;
        const int cur = t >> 6; const u64 mask = (cur == 63) ? ~0ull : ((1ull << (cur + 1)) - 1ull);
        const float slope2 = alibi_slope(h + 1, 4) * LOG2E;
        const bf16* vb = dv + (size_t)bh * T_ * 64;
        const float o1 = naive_attn_row<32>(dq + ((size_t)(bh * 2 + 0) * T_ + t) * 32, dk + (size_t)(bh * 2 + 0) * T_ * 32, vb, t, mask, slope2, nullptr, 1 << 30, c.lane);
        const float o2 = naive_attn_row<32>(dq + ((size_t)(bh * 2 + 1) * T_ + t) * 32, dk + (size_t)(bh * 2 + 1) * T_ * 32, vb, t, mask, slope2, nullptr, 1 << 30, c.lane);
        const float o = o1 - lam_full * o2;
        const float r = rsqrtf(wave_sum(o * o) * (1.f / 64.f) + EPS);
        att[(size_t)(b * T_ + t) * 1024 + 768 + h * 64 + c.lane] = (bf16)f2bf(o * r * sg);
    }
}

__device__ __forceinline__ void ph_moe_route(const Ctx& c, const float* x, const float* g, const float* wgrp, const float* bgrp, const float* wexp, const float* bexp, bf16* hn, int* route_e, float* route_w, unsigned* cnt) {
    for (int row = c.gw; row < NT; row += c.ngw) {
        const f32x4* xr = (const f32x4*)(x + (size_t)row * D_) + c.lane;
        f32x4 v[4]; float ss = 0.f;
#pragma unroll
        for (int j = 0; j < 4; ++j) { v[j] = xr[64 * j]; ss += v[j].x * v[j].x + v[j].y * v[j].y + v[j].z * v[j].z + v[j].w * v[j].w; }
        const float r = rsqrtf(wave_sum(ss) * (1.f / D_) + EPS);
        u64* o8 = (u64*)(hn + (size_t)row * D_) + c.lane;
#pragma unroll
        for (int j = 0; j < 4; ++j) { const f32x4 gg = ((const f32x4*)g)[c.lane + 64 * j]; v[j] = v[j] * r * gg;
            o8[64 * j] = (u64)pk2(v[j].x, v[j].y) | ((u64)pk2(v[j].z, v[j].w) << 32); }
        float gl[4];
#pragma unroll
        for (int q = 0; q < 4; ++q) { float a = 0.f;
#pragma unroll
            for (int j = 0; j < 4; ++j) { const int k = 4 * (c.lane + 64 * j);
                a = fmaf(v[j].x, wgrp[(size_t)(k + 0) * 4 + q], a); a = fmaf(v[j].y, wgrp[(size_t)(k + 1) * 4 + q], a);
                a = fmaf(v[j].z, wgrp[(size_t)(k + 2) * 4 + q], a); a = fmaf(v[j].w, wgrp[(size_t)(k + 3) * 4 + q], a); }
            gl[q] = wave_sum(a) + bgrp[q]; }
        int grp = 0; float gm = gl[0];
#pragma unroll
        for (int q = 1; q < 4; ++q) if (gl[q] > gm) { gm = gl[q]; grp = q; }
        float gs = 0.f;
#pragma unroll
        for (int q = 0; q < 4; ++q) gs += __expf(gl[q] - gm);
        const float grp_gate = 1.f / gs;
        float el[8];
#pragma unroll
        for (int q = 0; q < 8; ++q) { float a = 0.f; const int col = grp * 8 + q;
#pragma unroll
            for (int j = 0; j < 4; ++j) { const int k = 4 * (c.lane + 64 * j);
                a = fmaf(v[j].x, wexp[(size_t)(k + 0) * 32 + col], a); a = fmaf(v[j].y, wexp[(size_t)(k + 1) * 32 + col], a);
                a = fmaf(v[j].z, wexp[(size_t)(k + 2) * 32 + col], a); a = fmaf(v[j].w, wexp[(size_t)(k + 3) * 32 + col], a); }
            el[q] = wave_sum(a) + bexp[col]; }
        int i0 = 0; float v0 = el[0];
#pragma unroll
        for (int q = 1; q < 8; ++q) if (el[q] > v0) { v0 = el[q]; i0 = q; }
        int i1 = -1; float v1 = -INFINITY;
#pragma unroll
        for (int q = 0; q < 8; ++q) if (q != i0 && el[q] > v1) { v1 = el[q]; i1 = q; }
        const float e1 = __expf(v1 - v0), den = 1.f + e1;
        if (c.lane == 0) { const float w0 = grp_gate / den, w1 = grp_gate * e1 / den;
            const int lo = i0 < i1 ? i0 : i1, hi = i0 < i1 ? i1 : i0, cls = grp * 28 + lo * 8 - (lo * (lo + 1)) / 2 + (hi - lo - 1);
            const unsigned rank = __hip_atomic_fetch_add(cnt + cls, 1u, __ATOMIC_RELAXED, __HIP_MEMORY_SCOPE_AGENT);
            route_e[row] = (int)(((unsigned)cls << 24) | rank); route_w[2 * row] = i0 < i1 ? w0 : w1; route_w[2 * row + 1] = i0 < i1 ? w1 : w0; }
    }
}
__device__ __forceinline__ void ph_moe_naive(const Ctx& c, const bf16* hn, const int* route_e, const float* route_w, const float* wg, const float* wu, const float* wd, float* x) {
    LAS float* hs = (LAS float*)c.lds;
    LAS float* au = hs + 1024;
    LAS float* h2 = au + 512;
    for (int row = c.bid; row < NT; row += c.G) {
        __syncthreads();
        hs[c.tid] = bf2f(hn[(size_t)row * D_ + c.tid]); hs[c.tid + 512] = bf2f(hn[(size_t)row * D_ + c.tid + 512]);
        float o0 = 0.f, o1 = 0.f;
        for (int s = 0; s < 2; ++s) {
            const int e = route_e[2 * row + s]; const float w = route_w[2 * row + s];
            __syncthreads();
            const float* W = (c.tid < 256 ? wg : wu) + (size_t)e * D_ * DEXP + (c.tid & 255);
            float a = 0.f;
            for (int k = 0; k < D_; ++k) a = fmaf(hs[k], W[(size_t)k * DEXP], a);
            au[c.tid] = a;
            __syncthreads();
            if (c.tid < 256) { const float ga = au[c.tid], up = au[c.tid + 256]; h2[c.tid] = ga / (1.f + __expf(-ga)) * up * w; }
            __syncthreads();
            const float* Wd = wd + (size_t)e * DEXP * D_;
            for (int k = 0; k < DEXP; ++k) { const float hv = h2[k]; o0 = fmaf(hv, Wd[(size_t)k * D_ + c.tid], o0); o1 = fmaf(hv, Wd[(size_t)k * D_ + c.tid + 512], o1); }
        }
        x[(size_t)row * D_ + c.tid] += o0; x[(size_t)row * D_ + c.tid + 512] += o1;
    }
    __syncthreads();
}

typedef __attribute__((address_space(4))) const Params* KP;
__device__ __forceinline__ KP uni_kp(KP p) { const unsigned long long v = (unsigned long long)p; const unsigned lo = __builtin_amdgcn_readfirstlane((unsigned)v), hi = __builtin_amdgcn_readfirstlane((unsigned)(v >> 32)); return (KP)(((unsigned long long)hi << 32) | lo); }
constexpr int PH_PER_LAYER = 11, N_PHASES = L_ * PH_PER_LAYER + 2;
__device__ __forceinline__ Ctx make_ctx(KP p) {
    Ctx c; c.lds = (LAS unsigned char*)lds_raw; { int t_ = threadIdx.x; asm volatile("" : "+v"(t_)); c.tid = t_; } c.lane = c.tid & 63; c.wave = __builtin_amdgcn_readfirstlane(c.tid >> 6);
    c.bid = blockIdx.x; c.G = gridDim.x; c.gw = c.bid * NWAVES + c.wave; c.ngw = c.G * NWAVES; c.in = nullptr; c.xcur = p->out; c.ws = p->ws;
    return c;
}
struct Bufs {
    bf16 *QN, *KV6, *KC, *VC, *KS, *VS, *KW, *VW, *FQ, *FK, *FV, *DQ, *DK, *DV, *HC, *KCMP, *VCMP, *OCMP, *OWIN, *HN, *ATT;
    float *GATE, *FL, *ROUTE_W; u64* SEL; int* ROUTE_E;
};
__device__ __forceinline__ Bufs make_bufs(unsigned char* ws) {
    Bufs b;
    b.QN = (bf16*)(ws + WS_QN); b.KV6 = (bf16*)(ws + WS_KV6);
    b.KC = (bf16*)(ws + WS_KV6 + 0 * KV6_STRIDE); b.VC = (bf16*)(ws + WS_KV6 + 1 * KV6_STRIDE);
    b.KS = (bf16*)(ws + WS_KV6 + 2 * KV6_STRIDE); b.VS = (bf16*)(ws + WS_KV6 + 3 * KV6_STRIDE);
    b.KW = (bf16*)(ws + WS_KV6 + 4 * KV6_STRIDE); b.VW = (bf16*)(ws + WS_KV6 + 5 * KV6_STRIDE);
    b.FQ = (bf16*)(ws + WS_FQKV); b.FK = b.FQ + 8 * MiB; b.FV = b.FQ + 16 * MiB;
    b.DQ = (bf16*)(ws + WS_DQK); b.DK = b.DQ + 8 * MiB; b.DV = (bf16*)(ws + WS_DV);
    b.GATE = (float*)(ws + WS_GATE); b.FL = (float*)(ws + WS_FL);
    b.HC = (bf16*)(ws + WS_HC); b.KCMP = (bf16*)(ws + WS_KVCMP); b.VCMP = b.KCMP + 16 * 256 * 64;
    b.SEL = (u64*)(ws + WS_SEL); b.OCMP = (bf16*)(ws + WS_OCMP); b.OWIN = (bf16*)(ws + WS_OWIN);
    b.HN = (bf16*)(ws + WS_HN); b.ATT = (bf16*)(ws + WS_ATT);
    b.ROUTE_E = (int*)(ws + WS_ROUTE); b.ROUTE_W = (float*)(ws + WS_ROUTE + 512 * 1024);
    return b;
}
__device__ __forceinline__ float lambda_init_of(int l) { return l == 0 ? 0.2f : 0.35550906759096926f; }

__device__ __noinline__ void P_prologue(KP p_) { const KP p = uni_kp(p_);
    const Ctx c = make_ctx(p); unsigned char* ws = p->ws;
    LAS float* scr = (LAS float*)(c.lds) + c.wave * (64 * 33);
    constexpr int I_A = 16 * 40, I_B = 16 * 24, I_C = 16 * 24, I_O = 16 * 32, I_G = 16 * 8, I_D = 4 * 32, I_E = 2 * I_G + I_D, I_W1 = 32 * 8, I_W2 = 4 * 2;
    constexpr int PER_L = I_A + I_B + I_C + I_O + 2 * (I_W1 + I_W2);
    for (int it = c.gw; it < L_ * PER_L; it += c.ngw) {
        const int l = it / PER_L; int r = it % PER_L;
        const float* W; bf16* WT; int ldw, K, sc0, ncol, r0 = 0, rmul = 1;
        if (r < I_A + I_B + I_C) { W = p->in[2] + (size_t)l * D_ * D_IN; WT = (bf16*)(ws + WS_WIN_T) + (size_t)l * NIN * D_; ldw = D_IN; K = D_;
            if (r < I_A) { sc0 = 0; ncol = 1280; r0 = 0; } else if (r < I_A + I_B) { r -= I_A; sc0 = C_FQ; ncol = 768; r0 = 1280; } else { r -= I_A + I_B; sc0 = C_DQ; ncol = 768; r0 = 2048; } }
        else if ((r -= I_A + I_B + I_C) < I_O) { W = p->in[13] + (size_t)l * D_ * D_; WT = (bf16*)(ws + WS_WOUT_T) + (size_t)l * D_ * D_; ldw = D_; K = D_; sc0 = 0; ncol = 1024; }
        else { r -= I_O; const int kv = r / (I_W1 + I_W2); r = r % (I_W1 + I_W2); const size_t lk = (size_t)l * 2 + kv;
            if (r < I_W1) { W = p->in[kv == 0 ? 6 : 9] + (size_t)l * 2048 * 256; WT = (bf16*)(ws + WS_W1_T) + lk * 256 * 2048; ldw = 256; K = 2048; sc0 = 0; ncol = 256; }
            else { r -= I_W1; W = p->in[kv == 0 ? 7 : 10] + (size_t)l * 256 * 64; WT = (bf16*)(ws + WS_W2_T) + lk * 64 * 256; ldw = 64; K = 256; sc0 = 0; ncol = 64; } }
        transpose_seg(W, ldw, K, sc0, ncol, WT, r0, rmul, r, scr, c.lane);
    }
    for (int i = c.bid * NTHREADS + c.tid; i < L_ * 256 * D_; i += c.G * NTHREADS) {
        const int l = i / (256 * D_), rr = (i / D_) % 256, k = i % D_;
        const float* win = p->in[2] + (size_t)l * D_ * D_IN;
        float v = 0.f; if (rr < 24) v = win[(size_t)k * D_IN + C_GATE + rr]; else if (rr < 28) v = win[(size_t)k * D_IN + C_FF + (rr - 24)];
        ((bf16*)(ws + WS_WIN_T))[((size_t)l * NIN + 2816 + rr) * D_ + k] = (bf16)f2bf(v);
    }
    for (int w = c.gw; w < L_ * 2 * 4 * 128; w += c.ngw) {
        const int lk = w >> 9, cg = (w >> 7) & 3, kc = w & 127, l = lk >> 1, kv = lk & 1, j = cg * 64 + c.lane;
        const float* pe = p->in[kv == 0 ? 5 : 8] + (size_t)l * 2048 + kc * 16; const float* w1 = p->in[kv == 0 ? 6 : 9] + (size_t)l * 2048 * 256 + (size_t)kc * 16 * 256;
        float a = 0.f;
#pragma unroll
        for (int k = 0; k < 16; ++k) a = fmaf(pe[k], w1[(size_t)k * 256 + j], a);
        ((float*)(ws + WS_B1PART))[((size_t)lk * 128 + kc) * 256 + j] = a;
    }
    for (int i = c.bid * NTHREADS + c.tid; i < L_ * 64 * 2 * 64; i += c.G * NTHREADS) {
        const int l = i / (64 * 2 * 64), ks = (i / 128) % 64, cb = (i / 64) & 1, lane = i & 63, col = 32 * cb + (lane & 31);
        unsigned hi[4], lo[4];
#pragma unroll
        for (int jp = 0; jp < 4; ++jp) { float v[2];
#pragma unroll
            for (int e = 0; e < 2; ++e) { const int k = 16 * ks + 8 * (lane >> 5) + 2 * jp + e; const float g = p->in[14][(size_t)l * D_ + k];
                v[e] = col < 4 ? g * p->in[15][((size_t)l * D_ + k) * 4 + col] : (col < 36 ? g * p->in[17][((size_t)l * D_ + k) * 32 + (col - 4)] : 0.f); }
            const unsigned h0 = f2bf(v[0]), h1 = f2bf(v[1]); hi[jp] = h0 | (h1 << 16);
            lo[jp] = f2bf(v[0] - __uint_as_float(h0 << 16)) | (f2bf(v[1] - __uint_as_float(h1 << 16)) << 16); }
        u32x4* dst = (u32x4*)(ws + WS_WR) + ((size_t)((l * 64 + ks) * 2 + cb) * 2) * 64 + lane;
        dst[0] = (u32x4){hi[0], hi[1], hi[2], hi[3]}; dst[64] = (u32x4){lo[0], lo[1], lo[2], lo[3]};
    }
}
__device__ __forceinline__ void P_inproj_mfma(int l_) { const KP p = (KP)__builtin_amdgcn_kernarg_segment_ptr(); int l = l_; asm volatile("" : "+s"(l));
    unsigned char* ws = p->ws; asm volatile("" : "+s"(ws));
    PlainOrder S; S.init(p->out, (const bf16*)(ws + WS_WIN_T) + (size_t)l * NIN * D_, D_, D_, NT, NIN, (int)gridDim.x, launder_s((int)blockIdx.x));
#ifdef STAGGER_TICKS
    { const unsigned long long t0 = __builtin_amdgcn_s_memrealtime(); const unsigned long long d = (unsigned long long)((launder_s((int)blockIdx.x) >> 3) & 3) * STAGGER_TICKS;
      while (__builtin_amdgcn_s_memrealtime() - t0 < d) __builtin_amdgcn_s_sleep(4); }
#endif
    const pg8::Gemm g{D_, D_, D_, D_ / 64, 0, 0};
    const EpiInProj E{ws, p->in[3] + l * 24, p->in[4] + l * 4, (unsigned*)(ws + WS_CTL) + CW_KN + l * 8192};
    pg8::gemm_phase<EpiInProj, PlainOrder, INPROJ_ALIGN, INPROJ_SP2>((LAS unsigned char*)lds_raw, g, S, E);
}
__device__ __forceinline__ void P_inproj_dummy(int l_) { const KP p = (KP)__builtin_amdgcn_kernarg_segment_ptr(); int l = l_; asm volatile("" : "+s"(l));
    unsigned char* ws = p->ws; asm volatile("" : "+s"(ws));
    PlainOrder S; S.init(p->out, (const bf16*)(ws + WS_WIN_T) + (size_t)l * NIN * D_, D_, D_, NT, NIN, (int)gridDim.x, launder_s((int)blockIdx.x));
    const pg8::Gemm g{D_, D_, D_, D_ / 64, 0, 0};
    const EpiDummy E{(float*)(ws + WS_HB)};
    pg8::gemm_phase<EpiDummy, PlainOrder, true, true>((LAS unsigned char*)lds_raw, g, S, E);
}
__device__ __forceinline__ void P_outproj_mfma(int l_) { const KP p = (KP)__builtin_amdgcn_kernarg_segment_ptr(); int l = l_; asm volatile("" : "+s"(l));
    unsigned char* ws = p->ws; asm volatile("" : "+s"(ws));
    PlainOrder S; S.init(ws + WS_ATT, (const bf16*)(ws + WS_WOUT_T) + (size_t)l * D_ * D_, D_, D_, NT, D_, (int)gridDim.x, launder_s((int)blockIdx.x));
    const pg8::Gemm g{D_, D_, D_, D_ / 64, 32, 8};
    const EpiResBf16 E{(bf16*)(ws + WS_HN)};
    pg8::gemm_phase<EpiResBf16, PlainOrder, true, true>((LAS unsigned char*)lds_raw, g, S, E);
}
__device__ __forceinline__ float wave_max_l(float v, int lane) {
#pragma unroll
    for (int o = 1; o < 64; o <<= 1) v = fmaxf(v, shflx_f(v, o, lane));
    return v;
}
__device__ __forceinline__ float wave_min_l(float v, int lane) {
#pragma unroll
    for (int o = 1; o < 64; o <<= 1) v = fminf(v, shflx_f(v, o, lane));
    return v;
}
template <int NS> __device__ __forceinline__ float q_norm2_max(const bf16x8v (&Q)[NS], int lane) {
    float ss = 0.f;
#pragma unroll
    for (int s = 0; s < NS; ++s)
#pragma unroll
        for (int e = 0; e < 8; ++e) { const float v = __uint_as_float(((unsigned)(unsigned short)Q[s][e]) << 16); ss = fmaf(v, v, ss); }
    return wave_max_l(swap_sum(ss), lane);
}
__device__ __forceinline__ u64 prune_consensus(bool skip, LAS u64* slots, int wave, int lane) {
    const u64 mine = __ballot(skip);
    __syncthreads();
    if (lane == 0) slots[wave] = mine;
    __syncthreads();
    u64 all = slots[0];
#pragma unroll
    for (int w = 1; w < NWAVES; ++w) all &= slots[w];
    return all;
}
__device__ __forceinline__ bool block_any(bool v, LAS u64* slots, int wave, int lane) {
#ifdef FORCE_FALLBACK
    v = true;
#endif
    const u64 mine = __ballot(v);
    __syncthreads();
    if (lane == 0) slots[wave] = mine;
    __syncthreads();
    u64 all = slots[0];
#pragma unroll
    for (int w = 1; w < NWAVES; ++w) all |= slots[w];
    return all != 0ull;
}
__device__ __forceinline__ bool sum_bad(float l) { return !(l < 1e30f); }
__device__ __forceinline__ void U_fox(KP p_, int bh_, int qb_, int l_) {
    const KP p = uni_kp(p_); const int bh = __builtin_amdgcn_readfirstlane(bh_), qb = __builtin_amdgcn_readfirstlane(qb_), l = __builtin_amdgcn_readfirstlane(l_);
    int tid_ = threadIdx.x; asm volatile("" : "+v"(tid_));
    const int tid = tid_, lane = tid & 63, wave = __builtin_amdgcn_readfirstlane(tid >> 6), r = lane & 31, h = lane >> 5;
    unsigned char* ws = p->ws; asm volatile("" : "+s"(ws)); LAS unsigned char* L = (LAS unsigned char*)lds_raw;
    const int tw0 = 256 * qb + 32 * wave, t_lane = tw0 + r, b = bh >> 2, hd = bh & 3;
    const bf16* q = (const bf16*)(ws + WS_FQKV) + (size_t)bh * T_ * 64 + (t_lane >> 4) * 1024 + (t_lane & 15) * 32 + 8 * h;
    bf16x8v Qf[1][4];
#pragma unroll
    for (int s = 0; s < 4; ++s) Qf[0][s] = *(const bf16x8v*)(q + (s >> 1) * 512 + (s & 1) * 16);
    const bf16* Kp = (const bf16*)(ws + WS_FQKV) + 8 * MiB + (size_t)bh * T_ * 64; const bf16* Vp = (const bf16*)(ws + WS_FQKV) + 16 * MiB + (size_t)bh * T_ * 64;
    u32x4 kpre, vpre; attn_preload<64>(Kp, nullptr, Vp, 4 * qb + 3, tid, kpre, vpre);
    LAS float* cum = (LAS float*)(L + A_LDS_END);
    { const float* fl = (const float*)(ws + WS_FL) + (size_t)bh * T_; LAS float* tot = cum + 4096;
      const int nval = 256 * (qb + 1); float v[8];
      if (8 * tid < nval) { const f32x4 a = *(const f32x4*)(fl + 8 * tid), c2 = *(const f32x4*)(fl + 8 * tid + 4); v[0] = a.x; v[1] = a.y; v[2] = a.z; v[3] = a.w; v[4] = c2.x; v[5] = c2.y; v[6] = c2.z; v[7] = c2.w; }
      else {
#pragma unroll
          for (int i = 0; i < 8; ++i) v[i] = 0.f; }
#pragma unroll
      for (int i = 1; i < 8; ++i) v[i] += v[i - 1];
      float sc = v[7];
#pragma unroll
      for (int o = 1; o < 64; o <<= 1) { const float up = __uint_as_float((unsigned)__builtin_amdgcn_ds_bpermute((lane - o) << 2, (int)__float_as_uint(sc))); if (lane >= o) sc += up; }
      if (lane == 63) tot[wave] = sc;
      __syncthreads();
      float base = sc - v[7];
      for (int w = 0; w < wave; ++w) base += tot[w];
      if (8 * tid < nval) {
#pragma unroll
          for (int i = 0; i < 8; ++i) cum[8 * tid + i] = v[i] + base; }
      __syncthreads(); }
    f32x16 O[1][2]; float M[1] = {0.f}, Ls[1] = {0.f};
#pragma unroll
    for (int i = 0; i < 16; ++i) { O[0][0][i] = 0.f; O[0][1][i] = 0.f; }
    const u64 tm = (qb == 15) ? ~0ull : ((1ull << (4 * qb + 4)) - 1ull);
#if AC2_MODE == 0
    {
        const u64 low = (1ull << (4 * qb)) - 1ull; const float cref = cum[tw0];
#define FOX_CORES(NM, FIRSTCALL) do { FIRSTCALL; \
        if (qb > 0) { \
            const float qn2 = q_norm2_max<4>(Qf[0], lane), mmin = wave_min_l(M[0], lane); \
            const float* kn = (const float*)((const unsigned*)(ws + WS_CTL) + CW_KN + l * 8192) + ((size_t)bh * 64 + lane) * 2; \
            bool skip = false; \
            if (lane < 4 * qb) { const float kn2 = kn[0] + kn[1]; const float bound = sqrtf(qn2 * kn2) * 1.02f + (cref - cum[64 * lane + 63]) * LOG2E - mmin; skip = bound < -152.f; } \
            const u64 drop = prune_consensus(skip, (LAS u64*)(cum + 4096 + 16), wave, lane); \
            const u64 tm2 = low & ~drop; \
            if (tm2) attn_core<64, 1, true, false, false, NM>(L, Kp, nullptr, Vp, cum, cref, Qf, tm2, t_lane, tw0, 1 << 30, 0.f, 0u, 0u, O, M, Ls, tid, true); \
        } } while (0)
        FOX_CORES(NOMAX_ON, (attn_core<64, 1, true, false, true, NOMAX_ON>(L, Kp, nullptr, Vp, cum, cref, Qf, tm & ~low, t_lane, tw0, 1 << 30, 0.f, 0u, 0u, O, M, Ls, tid, false, 4 * qb + 3, kpre, vpre)));
        if (NOMAX_ON && block_any(sum_bad(Ls[0]), (LAS u64*)(cum + 4096 + 32), wave, lane)) {
#pragma unroll
            for (int i = 0; i < 16; ++i) { O[0][0][i] = 0.f; O[0][1][i] = 0.f; }
            M[0] = 0.f; Ls[0] = 0.f;
            FOX_CORES(false, (attn_core<64, 1, true, false, false, false>(L, Kp, nullptr, Vp, cum, cref, Qf, tm & ~low, t_lane, tw0, 1 << 30, 0.f, 0u, 0u, O, M, Ls, tid)));
        }
#undef FOX_CORES
    }
#else
    attn_core2<true, false>(L, (const bf16*)(ws + WS_FQKV) + 8 * MiB + (size_t)bh * T_ * 64, (const bf16*)(ws + WS_FQKV) + 16 * MiB + (size_t)bh * T_ * 64, cum, cum[256 * qb],
                            Qf[0], tm, t_lane, tw0, 1 << 30, 0.f, 0u, 0u, O[0], M[0], Ls[0], tid);
#endif
    const float lt = swap_sum(Ls[0]), inv = lt > 0.f ? 1.f / lt : 0.f;
    bf16* dst = (bf16*)(ws + WS_ATT) + mix_off((size_t)b * T_ + t_lane, 512 + hd * 64 + 4 * h, 1024);
    ATTN_FOR_CHUNKS(db, g4) { const unsigned w0 = cvtpk(O[0][db][4 * g4 + 0] * inv, O[0][db][4 * g4 + 1] * inv), w1 = cvtpk(O[0][db][4 * g4 + 2] * inv, O[0][db][4 * g4 + 3] * inv);
        *(u64*)(dst + (4 * db + g4) * 256) = (u64)w0 | ((u64)w1 << 32); }
}
__device__ __forceinline__ void U_diff(KP p_, int bh_, int qb_, int l_) {
    const KP p = uni_kp(p_); const int bh = __builtin_amdgcn_readfirstlane(bh_), qb = __builtin_amdgcn_readfirstlane(qb_), l = __builtin_amdgcn_readfirstlane(l_);
    int tid_ = threadIdx.x; asm volatile("" : "+v"(tid_));
    const int tid = tid_, lane = tid & 63, wave = __builtin_amdgcn_readfirstlane(tid >> 6), r = lane & 31, h = lane >> 5;
    unsigned char* ws = p->ws; asm volatile("" : "+s"(ws)); LAS unsigned char* L = (LAS unsigned char*)lds_raw;
    const int tw0 = 256 * qb + 32 * wave, t_lane = tw0 + r, b = bh >> 2, hd = bh & 3;
    const bf16* DQ = (const bf16*)(ws + WS_DQK); const bf16* DK = DQ + 8 * MiB;
    bf16x8v Qf[2][2];
#pragma unroll
    for (int mp = 0; mp < 2; ++mp)
#pragma unroll
        for (int s = 0; s < 2; ++s) Qf[mp][s] = *(const bf16x8v*)(DQ + ((size_t)(bh * 2 + mp) * T_ + t_lane) * 32 + 16 * s + 8 * h);
    f32x16 O[2][2]; float M[2] = {0.f, 0.f}, Ls[2] = {0.f, 0.f};
#pragma unroll
    for (int i = 0; i < 16; ++i) { O[0][0][i] = 0.f; O[0][1][i] = 0.f; O[1][0][i] = 0.f; O[1][1][i] = 0.f; }
    const u64 tm = (qb == 15) ? ~0ull : ((1ull << (4 * qb + 4)) - 1ull);
    {
        const u64 low = (1ull << (4 * qb)) - 1ull; const float slope2 = alibi_slope(hd + 1, 4) * LOG2E;
        const bf16* K0 = DK + (size_t)(bh * 2 + 0) * T_ * 32; const bf16* K1 = DK + (size_t)(bh * 2 + 1) * T_ * 32; const bf16* Vp = (const bf16*)(ws + WS_DV) + (size_t)bh * T_ * 64;
#define DIFF_CORES(NM) do { \
        attn_core<32, 2, false, false, false, NM>(L, K0, K1, Vp, nullptr, 0.f, Qf, tm & ~low, t_lane, tw0, 1 << 30, slope2, 0u, 0u, O, M, Ls, tid); \
        if (qb > 0) { \
            const float qa = q_norm2_max<2>(Qf[0], lane), qb2 = q_norm2_max<2>(Qf[1], lane), ma = wave_min_l(M[0], lane), mb = wave_min_l(M[1], lane); \
            const float* kn = (const float*)((const unsigned*)(ws + WS_CTL) + CW_KN + l * 8192 + 4096) + (size_t)(bh * 2) * 64 + lane; \
            bool skip = false; \
            if (lane < 4 * qb) { const float bmax = slope2 * (float)(64 * lane + 63 - tw0);            \
                skip = (sqrtf(qa * kn[0]) * 1.02f + bmax - ma < -152.f) && (sqrtf(qb2 * kn[64]) * 1.02f + bmax - mb < -152.f); } \
            const u64 drop = prune_consensus(skip, (LAS u64*)(L + A_LDS_END), wave, lane); \
            const u64 tm2 = low & ~drop; \
            if (tm2) attn_core<32, 2, false, false, false, NM>(L, K0, K1, Vp, nullptr, 0.f, Qf, tm2, t_lane, tw0, 1 << 30, slope2, 0u, 0u, O, M, Ls, tid, true); \
        } } while (0)
        DIFF_CORES(NOMAX_ON);
        if (NOMAX_ON && block_any(sum_bad(Ls[0]) || sum_bad(Ls[1]), (LAS u64*)(L + A_LDS_END + 64), wave, lane)) {
#pragma unroll
            for (int i = 0; i < 16; ++i) { O[0][0][i] = 0.f; O[0][1][i] = 0.f; O[1][0][i] = 0.f; O[1][1][i] = 0.f; }
            M[0] = 0.f; M[1] = 0.f; Ls[0] = 0.f; Ls[1] = 0.f;
            DIFF_CORES(false);
        }
#undef DIFF_CORES
    }
    const float* lam = p->in[11] + (size_t)l * 128; const float* subln = p->in[12] + (size_t)l * 64;
    float l1 = 0.f, l2 = 0.f; if (lane < 32) { l1 = lam[lane] * lam[32 + lane]; l2 = lam[64 + lane] * lam[96 + lane]; }
    const float li = lambda_init_of(l), lam_full = __expf(wave_sum_l(l1, lane)) - __expf(wave_sum_l(l2, lane)) + li;
    const float lt0 = swap_sum(Ls[0]), lt1 = swap_sum(Ls[1]), i0 = lt0 > 0.f ? 1.f / lt0 : 0.f, i1 = (lt1 > 0.f ? 1.f / lt1 : 0.f) * lam_full;
    float ss = 0.f;
#pragma unroll
    for (int db = 0; db < 2; ++db)
#pragma unroll
        for (int i = 0; i < 16; ++i) { const float o = O[0][db][i] * i0 - O[1][db][i] * i1; O[0][db][i] = o; ss += o * o; }
    ss = swap_sum(ss);
    const float rn = rsqrtf(ss * (1.f / 64.f) + EPS) * (1.f - li);
    bf16* dst = (bf16*)(ws + WS_ATT) + mix_off((size_t)b * T_ + t_lane, 768 + hd * 64 + 4 * h, 1024);
    ATTN_FOR_CHUNKS(db, g4) { const f32x4 sg = *(const f32x4*)(subln + 32 * db + 8 * g4 + 4 * h);
        const unsigned w0 = cvtpk(O[0][db][4 * g4 + 0] * rn * sg.x, O[0][db][4 * g4 + 1] * rn * sg.y), w1 = cvtpk(O[0][db][4 * g4 + 2] * rn * sg.z, O[0][db][4 * g4 + 3] * rn * sg.w);
        *(u64*)(dst + (4 * db + g4) * 256) = (u64)w0 | ((u64)w1 << 32); }
}
__device__ __forceinline__ void U_win(KP p_, int bg_, int c_) {
    const KP p = uni_kp(p_); const int bg = __builtin_amdgcn_readfirstlane(bg_), cc = __builtin_amdgcn_readfirstlane(c_);
    int tid_ = threadIdx.x; asm volatile("" : "+v"(tid_));
    const int tid = tid_, lane = tid & 63, wave = __builtin_amdgcn_readfirstlane(tid >> 6), r = lane & 31, h = lane >> 5;
    unsigned char* ws = p->ws; asm volatile("" : "+s"(ws)); LAS unsigned char* L = (LAS unsigned char*)lds_raw;
    const int b = bg >> 1, g = bg & 1, hd = g * 4 + (wave >> 1), tw0 = 64 * cc + 32 * (wave & 1), t_lane = tw0 + r;
    const bf16* q = (const bf16*)(ws + WS_QN) + (size_t)(b * 8 + hd) * T_ * 64 + (t_lane >> 4) * 1024 + (t_lane & 15) * 32 + 8 * h;
    bf16x8v Qf[1][4];
#pragma unroll
    for (int s = 0; s < 4; ++s) Qf[0][s] = *(const bf16x8v*)(q + (s >> 1) * 512 + (s & 1) * 16);
    f32x16 O[1][2]; float M[1] = {0.f}, Ls[1] = {0.f};
#pragma unroll
    for (int i = 0; i < 16; ++i) { O[0][0][i] = 0.f; O[0][1][i] = 0.f; }
    const size_t n = (size_t)b * T_ + t_lane;
    const float gate_w = ((const float*)(ws + WS_GATE))[n * 24 + hd * 3 + 2];
    const int jlo = cc > 8 ? cc - 8 : 0;
    const u64 hi = (cc == 63) ? ~0ull : ((1ull << (cc + 1)) - 1ull), tm = hi & ~((1ull << jlo) - 1ull);
#if AC2_MODE == 0
    attn_core<64, 1, false, false, false, NOMAX_ON>(L, (const bf16*)(ws + WS_KV6 + 4 * KV6_STRIDE) + (size_t)bg * T_ * 64, nullptr, (const bf16*)(ws + WS_KV6 + 5 * KV6_STRIDE) + (size_t)bg * T_ * 64, nullptr, 0.f,
                                   Qf, tm, t_lane, tw0, 512, alibi_slope(hd + 1, 8) * LOG2E, 0u, 0u, O, M, Ls, tid);
    if (NOMAX_ON && block_any(sum_bad(Ls[0]), (LAS u64*)(L + A_LDS_END + 64), wave, lane)) {
#pragma unroll
        for (int i = 0; i < 16; ++i) { O[0][0][i] = 0.f; O[0][1][i] = 0.f; }
        M[0] = 0.f; Ls[0] = 0.f;
        attn_core<64, 1, false, false, false, false>(L, (const bf16*)(ws + WS_KV6 + 4 * KV6_STRIDE) + (size_t)bg * T_ * 64, nullptr, (const bf16*)(ws + WS_KV6 + 5 * KV6_STRIDE) + (size_t)bg * T_ * 64, nullptr, 0.f,
                                       Qf, tm, t_lane, tw0, 512, alibi_slope(hd + 1, 8) * LOG2E, 0u, 0u, O, M, Ls, tid);
    }
#ifdef PROBE_WINCORE2
    attn_core<64, 1, false, false>(L, (const bf16*)(ws + WS_KV6 + 4 * KV6_STRIDE) + (size_t)bg * T_ * 64, nullptr, (const bf16*)(ws + WS_KV6 + 5 * KV6_STRIDE) + (size_t)bg * T_ * 64, nullptr, 0.f,
                                   Qf, tm, t_lane, tw0, 512, alibi_slope(hd + 1, 8) * LOG2E, 0u, 0u, O, M, Ls, tid, true);
#endif
#else
    attn_core2<false, false>(L, (const bf16*)(ws + WS_KV6 + 4 * KV6_STRIDE) + (size_t)bg * T_ * 64, (const bf16*)(ws + WS_KV6 + 5 * KV6_STRIDE) + (size_t)bg * T_ * 64, nullptr, 0.f,
                             Qf[0], tm, t_lane, tw0, 512, alibi_slope(hd + 1, 8) * LOG2E, 0u, 0u, O[0], M[0], Ls[0], tid);
#endif
    const float lt = swap_sum(Ls[0]), inv = (lt > 0.f ? 1.f / lt : 0.f) * gate_w;
    bf16* dst = (bf16*)(ws + WS_OWIN) + mix_off(n, hd * 64 + 4 * h, 512);
    ATTN_FOR_CHUNKS(db, g4) { const unsigned w0 = cvtpk(O[0][db][4 * g4 + 0] * inv, O[0][db][4 * g4 + 1] * inv), w1 = cvtpk(O[0][db][4 * g4 + 2] * inv, O[0][db][4 * g4 + 3] * inv);
        *(u64*)(dst + (4 * db + g4) * 256) = (u64)w0 | ((u64)w1 << 32); }
}
__device__ __forceinline__ void U_slc(KP p_, int bg_, int c_) {
    const KP p = uni_kp(p_); const int bg = __builtin_amdgcn_readfirstlane(bg_), cc = __builtin_amdgcn_readfirstlane(c_);
    int tid_ = threadIdx.x; asm volatile("" : "+v"(tid_));
    const int tid = tid_, lane = tid & 63, wave = __builtin_amdgcn_readfirstlane(tid >> 6), r = lane & 31, h = lane >> 5;
    unsigned char* ws = p->ws; asm volatile("" : "+s"(ws)); LAS unsigned char* L = (LAS unsigned char*)lds_raw;
    const int b = bg >> 1, g = bg & 1, hd = g * 4 + (wave >> 1), tw0 = 64 * cc + 32 * (wave & 1), t_lane = tw0 + r;
    const bf16* q = (const bf16*)(ws + WS_QN) + (size_t)(b * 8 + hd) * T_ * 64 + (t_lane >> 4) * 1024 + (t_lane & 15) * 32 + 8 * h;
    bf16x8v Qf[1][4];
#pragma unroll
    for (int s = 0; s < 4; ++s) Qf[0][s] = *(const bf16x8v*)(q + (s >> 1) * 512 + (s & 1) * 16);
    f32x16 O[1][2]; float M[1] = {0.f}, Ls[1] = {0.f};
#pragma unroll
    for (int i = 0; i < 16; ++i) { O[0][0][i] = 0.f; O[0][1][i] = 0.f; }
    const bf16* Ksl = (const bf16*)(ws + WS_KV6 + 2 * KV6_STRIDE) + (size_t)bg * T_ * 64; const bf16* Vsl = (const bf16*)(ws + WS_KV6 + 3 * KV6_STRIDE) + (size_t)bg * T_ * 64;
    u32x4 kpre, vpre; attn_preload<64>(Ksl, nullptr, Vsl, cc, tid, kpre, vpre);
    const size_t n = (size_t)b * T_ + t_lane;
    const float gate_s = ((const float*)(ws + WS_GATE))[n * 24 + hd * 3 + 1];
    const bf16* oc = (const bf16*)(ws + WS_OCMP) + mix_off(n, hd * 64 + 4 * h, 512); const bf16* ow = (const bf16*)(ws + WS_OWIN) + mix_off(n, hd * 64 + 4 * h, 512);
    u64 ocv[8], owv[8];
    ATTN_FOR_CHUNKS(db, g4) { ocv[4 * db + g4] = *(const u64*)(oc + (4 * db + g4) * 256); owv[4 * db + g4] = *(const u64*)(ow + (4 * db + g4) * 256); }
    const u64* sel = (const u64*)(ws + WS_SEL) + (size_t)bg * T_;
    const u64 mine = sel[t_lane]; u64 un = sel[64 * cc + lane];
    { unsigned ul = (unsigned)un, uh = (unsigned)(un >> 32);
#pragma unroll
      for (int o = 1; o < 64; o <<= 1) { ul |= shflx_u(ul, o, lane); uh |= shflx_u(uh, o, lane); }
      un = ((u64)__builtin_amdgcn_readfirstlane(uh) << 32) | __builtin_amdgcn_readfirstlane(ul); }
#if AC2_MODE == 0
    attn_core<64, 1, false, true, true, NOMAX_ON>(L, Ksl, nullptr, Vsl, nullptr, 0.f,
                                  Qf, un, t_lane, tw0, 1 << 30, alibi_slope(hd + 1, 8) * LOG2E, (unsigned)mine, (unsigned)(mine >> 32), O, M, Ls, tid, false, cc, kpre, vpre);
    if (NOMAX_ON && block_any(sum_bad(Ls[0]), (LAS u64*)(L + A_LDS_END + 64), wave, lane)) {
#pragma unroll
        for (int i = 0; i < 16; ++i) { O[0][0][i] = 0.f; O[0][1][i] = 0.f; }
        M[0] = 0.f; Ls[0] = 0.f;
        attn_core<64, 1, false, true, false, false>(L, Ksl, nullptr, Vsl, nullptr, 0.f, Qf, un, t_lane, tw0, 1 << 30, alibi_slope(hd + 1, 8) * LOG2E, (unsigned)mine, (unsigned)(mine >> 32), O, M, Ls, tid);
    }
#else
    attn_core2<false, true>(L, (const bf16*)(ws + WS_KV6 + 2 * KV6_STRIDE) + (size_t)bg * T_ * 64, (const bf16*)(ws + WS_KV6 + 3 * KV6_STRIDE) + (size_t)bg * T_ * 64, nullptr, 0.f,
                            Qf[0], un, t_lane, tw0, 1 << 30, alibi_slope(hd + 1, 8) * LOG2E, (unsigned)mine, (unsigned)(mine >> 32), O[0], M[0], Ls[0], tid);
#endif
    const float lt = swap_sum(Ls[0]), inv = (lt > 0.f ? 1.f / lt : 0.f) * gate_s;
    bf16* dst = (bf16*)(ws + WS_ATT) + mix_off(n, hd * 64 + 4 * h, 1024);
    ATTN_FOR_CHUNKS(db, g4) { const u64 a = ocv[4 * db + g4], w = owv[4 * db + g4];
        const float x0 = O[0][db][4 * g4 + 0] * inv + __uint_as_float((unsigned)a << 16) + __uint_as_float((unsigned)w << 16);
        const float x1 = O[0][db][4 * g4 + 1] * inv + __uint_as_float((unsigned)a & 0xffff0000u) + __uint_as_float((unsigned)w & 0xffff0000u);
        const float x2 = O[0][db][4 * g4 + 2] * inv + __uint_as_float((unsigned)(a >> 32) << 16) + __uint_as_float((unsigned)(w >> 32) << 16);
        const float x3 = O[0][db][4 * g4 + 3] * inv + __uint_as_float((unsigned)(a >> 32) & 0xffff0000u) + __uint_as_float((unsigned)(w >> 32) & 0xffff0000u);
        *(u64*)(dst + (4 * db + g4) * 256) = (u64)cvtpk(x0, x1) | ((u64)cvtpk(x2, x3) << 32); }
}
__device__ __forceinline__ float other_half(float x, int h) { auto rr = __builtin_amdgcn_permlane32_swap(__float_as_uint(x), __float_as_uint(x), false, false); return __uint_as_float(h ? rr[0] : rr[1]); }
__device__ __forceinline__ int other_half_i(int x, int h) { auto rr = __builtin_amdgcn_permlane32_swap((unsigned)x, (unsigned)x, false, false); return (int)(h ? rr[0] : rr[1]); }
template <bool MASK>
__device__ __forceinline__ void cmp_scores(f32x16& p0, f32x16& p1, const LAS unsigned char* kt, const bf16x8v (&Qf)[4], float b0, float s1, int cl, int nvis_l) {
    const float s8 = s1 * 8.f, s32 = s1 * 32.f;
    p0[0] = b0; p0[1] = p0[0] + s1; p0[2] = p0[1] + s1; p0[3] = p0[2] + s1;
#pragma unroll
    for (int reg = 4; reg < 16; ++reg) p0[reg] = p0[reg - 4] + s8;
#pragma unroll
    for (int reg = 0; reg < 16; ++reg) p1[reg] = p0[reg] + s32;
#pragma unroll
    for (int s = 0; s < 4; ++s) { const bf16x8v kf0 = *(const LAS bf16x8v*)(kt + s * 32), kf1 = *(const LAS bf16x8v*)(kt + 32 * 144 + s * 32);
        p0 = __builtin_amdgcn_mfma_f32_32x32x16_bf16(kf0, Qf[s], p0, 0, 0, 0); p1 = __builtin_amdgcn_mfma_f32_32x32x16_bf16(kf1, Qf[s], p1, 0, 0, 0); }
    if (MASK) {
#pragma unroll
        for (int reg = 0; reg < 16; ++reg) { const int c = cl + crow0(reg); p0[reg] = (c < nvis_l) ? p0[reg] : -INFINITY; p1[reg] = (c + 32 < nvis_l) ? p1[reg] : -INFINITY; } }
}
__device__ __forceinline__ void U_cmp(KP p_, int bg_, int u_) {
    const KP p = uni_kp(p_); const int bg = __builtin_amdgcn_readfirstlane(bg_), uu = __builtin_amdgcn_readfirstlane(u_);
    int tid_ = threadIdx.x; asm volatile("" : "+v"(tid_));
    const int tid = tid_, lane = tid & 63, wave = __builtin_amdgcn_readfirstlane(tid >> 6), r = lane & 31, h = lane >> 5;
    unsigned char* ws = p->ws; asm volatile("" : "+s"(ws)); LAS unsigned char* L = (LAS unsigned char*)lds_raw;
    const int b = bg >> 1, g = bg & 1, tw0 = 32 * (uu + 16 * wave), t_lane = tw0 + r;
    { const bf16* kc = (const bf16*)(ws + WS_KVCMP) + (size_t)bg * 256 * 64; const bf16* vc = kc + 16 * 256 * 64;
#pragma unroll
      for (int i = 0; i < 4; ++i) { const int ch = tid + 512 * i, row = ch >> 3, c8 = ch & 7;
          *(LAS u32x4*)(L + row * 144 + c8 * 16) = *(const u32x4*)(kc + row * 64 + c8 * 8); *(LAS u32x4*)(L + 36864 + row * 144 + c8 * 16) = *(const u32x4*)(vc + row * 64 + c8 * 8); } }
    __syncthreads();
    const int nvis_l = t_lane >= 31 ? ((t_lane - 31) >> 4) + 1 : 0, nvis_max = (tw0 >> 4) + 1, nvis_min = tw0 >= 31 ? ((tw0 - 31) >> 4) + 1 : 0, ntile = (nvis_max + 63) >> 6;
    const LAS unsigned char* kfrag = L + r * 144 + h * 16;
    const LAS unsigned char* vfrag = L + 36864 + (4 * h + ((lane & 15) >> 2)) * 144 + (16 * ((lane >> 4) & 1) + 4 * (lane & 3)) * 2;
    float imp[32];
#pragma unroll
    for (int e = 0; e < 32; ++e) imp[e] = 0.f;
    const float* gate = (const float*)(ws + WS_GATE) + ((size_t)b * T_ + t_lane) * 24;
#pragma unroll 1
    for (int hg = 0; hg < 4; ++hg) {
        const int hd = g * 4 + hg; const float s1 = alibi_slope(hd + 1, 8) * LOG2E * 16.f;
        const bf16* q = (const bf16*)(ws + WS_QN) + (size_t)(b * 8 + hd) * T_ * 64 + (t_lane >> 4) * 1024 + (t_lane & 15) * 32 + 8 * h;
        bf16x8v Qf[4];
#pragma unroll
        for (int s = 0; s < 4; ++s) Qf[s] = *(const bf16x8v*)(q + (s >> 1) * 512 + (s & 1) * 16);
        float m = 0.f, lsum = 0.f;
#pragma unroll 1
        for (int jt = 0; jt < ntile; ++jt) {
            f32x16 p0, p1; const float b0 = s1 * (float)(64 * jt + 4 * h - nvis_max);
            if (64 * jt + 63 >= nvis_min) cmp_scores<true>(p0, p1, kfrag + jt * (64 * 144), Qf, b0, s1, 64 * jt + 4 * h, nvis_l);
            else cmp_scores<false>(p0, p1, kfrag + jt * (64 * 144), Qf, b0, s1, 64 * jt + 4 * h, nvis_l);
            float rs = 0.f;
#pragma unroll
            for (int reg = 0; reg < 16; ++reg) rs += __builtin_amdgcn_exp2f(p0[reg]) + __builtin_amdgcn_exp2f(p1[reg]);
            lsum += rs;
        }
#ifdef FORCE_FALLBACK
        if (true) {
#else
        if (__any(sum_bad(lsum))) {
#endif
        m = -1e30f; lsum = 0.f;
#pragma unroll 1
        for (int jt = 0; jt < ntile; ++jt) {
            f32x16 p0, p1; const float b0 = s1 * (float)(64 * jt + 4 * h - nvis_max);
            if (64 * jt + 63 >= nvis_min) cmp_scores<true>(p0, p1, kfrag + jt * (64 * 144), Qf, b0, s1, 64 * jt + 4 * h, nvis_l);
            else cmp_scores<false>(p0, p1, kfrag + jt * (64 * 144), Qf, b0, s1, 64 * jt + 4 * h, nvis_l);
            float mt = fmaxf(p0[0], p1[0]);
#pragma unroll
            for (int reg = 1; reg < 16; ++reg) mt = fmaxf(mt, fmaxf(p0[reg], p1[reg]));
            mt = swap_max(mt);
            const float mn = fmaxf(m, mt); float rs = 0.f;
#pragma unroll
            for (int reg = 0; reg < 16; ++reg) rs += __builtin_amdgcn_exp2f(p0[reg] - mn) + __builtin_amdgcn_exp2f(p1[reg] - mn);
            lsum = lsum * __builtin_amdgcn_exp2f(m - mn) + rs; m = mn;
        }
        }
        const float lt = swap_sum(lsum), cnorm = lt > 0.f ? m + __builtin_amdgcn_logf(lt) : 1e30f;
        f32x16 O0, O1;
#pragma unroll
        for (int i = 0; i < 16; ++i) { O0[i] = 0.f; O1[i] = 0.f; }
        float carry = 0.f;
#pragma unroll
        for (int jt = 0; jt < 4; ++jt) if (jt < ntile) {
            f32x16 p0, p1; const float b0 = s1 * (float)(64 * jt + 4 * h - nvis_max) - cnorm;
            if (64 * jt + 63 >= nvis_min) cmp_scores<true>(p0, p1, kfrag + jt * (64 * 144), Qf, b0, s1, 64 * jt + 4 * h, nvis_l);
            else cmp_scores<false>(p0, p1, kfrag + jt * (64 * 144), Qf, b0, s1, 64 * jt + 4 * h, nvis_l);
#pragma unroll
            for (int reg = 0; reg < 16; ++reg) { p0[reg] = __builtin_amdgcn_exp2f(p0[reg]); p1[reg] = __builtin_amdgcn_exp2f(p1[reg]); }
            float cv[8];
#pragma unroll
            for (int g4 = 0; g4 < 4; ++g4) { const float h0 = 0.5f * p0[4 * g4 + 3], h1 = 0.5f * p1[4 * g4 + 3];
                imp[jt * 8 + g4] += ((p0[4 * g4] + p0[4 * g4 + 1]) + p0[4 * g4 + 2]) + h0; imp[jt * 8 + 4 + g4] += ((p1[4 * g4] + p1[4 * g4 + 1]) + p1[4 * g4 + 2]) + h1;
                cv[g4] = h0; cv[4 + g4] = h1; }
            float prev = carry;
#pragma unroll
            for (int k = 0; k < 8; ++k) { const float sv = other_half(cv[k], h); imp[jt * 8 + k] += h ? sv : prev; prev = sv; }
            carry = prev;
            const bf16x8v pa0 = pack8(p0, 0), pa1 = pack8(p0, 8), pa2 = pack8(p1, 0), pa3 = pack8(p1, 8);
            const LAS unsigned char* vb = vfrag + jt * (64 * 144);
#pragma unroll
            for (int ks = 0; ks < 4; ++ks) { const bf16x8v pa = ks == 0 ? pa0 : ks == 1 ? pa1 : ks == 2 ? pa2 : pa3;
                { const s16x4 lo = tr_read(vb + ks * (16 * 144)), hi = tr_read(vb + ks * (16 * 144) + 8 * 144); const bf16x8v vf = {lo[0], lo[1], lo[2], lo[3], hi[0], hi[1], hi[2], hi[3]};
                  O0 = __builtin_amdgcn_mfma_f32_32x32x16_bf16(vf, pa, O0, 0, 0, 0); }
                { const s16x4 lo = tr_read(vb + ks * (16 * 144) + 64), hi = tr_read(vb + ks * (16 * 144) + 64 + 8 * 144); const bf16x8v vf = {lo[0], lo[1], lo[2], lo[3], hi[0], hi[1], hi[2], hi[3]};
                  O1 = __builtin_amdgcn_mfma_f32_32x32x16_bf16(vf, pa, O1, 0, 0, 0); } }
        }
        const float gt = gate[hd * 3 + 0];
        bf16* dst = (bf16*)(ws + WS_OCMP) + mix_off((size_t)b * T_ + t_lane, hd * 64 + 4 * h, 512);
#pragma unroll
        for (int g4 = 0; g4 < 4; ++g4) {
            *(u64*)(dst + g4 * 256) = (u64)cvtpk(O0[4 * g4 + 0] * gt, O0[4 * g4 + 1] * gt) | ((u64)cvtpk(O0[4 * g4 + 2] * gt, O0[4 * g4 + 3] * gt) << 32);
            *(u64*)(dst + (4 + g4) * 256) = (u64)cvtpk(O1[4 * g4 + 0] * gt, O1[4 * g4 + 1] * gt) | ((u64)cvtpk(O1[4 * g4 + 2] * gt, O1[4 * g4 + 3] * gt) << 32); }
    }
    const int cur = tw0 >> 6; u64 mask;
    if (cur <= 15) mask = (1ull << (cur + 1)) - 1ull;
    else {
        mask = 1ull | (1ull << cur) | (1ull << (cur - 1));
#pragma unroll
        for (int e = 0; e < 32; ++e) { const int j = 2 * e + h; if (j > cur || j == 0 || j >= cur - 1) imp[e] = -INFINITY; }
#pragma unroll 1
        for (int round = 0; round < 13; ++round) {
            float bv = imp[0]; int be = 0;
#pragma unroll
            for (int e = 1; e < 32; ++e) if (imp[e] > bv) { bv = imp[e]; be = e; }
            const int bj = 2 * be + h; const float ov = other_half(bv, h); const int oj = other_half_i(bj, h);
            const bool mine = bv > ov || (bv == ov && bj < oj);
            mask |= 1ull << (mine ? bj : oj);
#pragma unroll
            for (int e = 0; e < 32; ++e) imp[e] = (mine && e == be) ? -INFINITY : imp[e];
        }
    }
    if (h == 0) ((u64*)(ws + WS_SEL))[(size_t)bg * T_ + t_lane] = mask;
    __syncthreads();
}
constexpr int CONV_UNITS = L_ * NEXP * (2 * 16 * 8 + 4 * 32) / 32;
__device__ __forceinline__ void U_conv(KP p_, int k_) {
    const KP p = uni_kp(p_); const int k = __builtin_amdgcn_readfirstlane(k_);
    int tid_ = threadIdx.x; asm volatile("" : "+v"(tid_));
    const int tid = tid_, lane = tid & 63, wave = __builtin_amdgcn_readfirstlane(tid >> 6);
    unsigned char* ws = p->ws; asm volatile("" : "+s"(ws));
    LAS float* scr = (LAS float*)lds_raw + wave * (64 * 33);
    constexpr int I_G = 16 * 8, I_D = 4 * 32, I_E = 2 * I_G + I_D;
#pragma unroll 1
    for (int i = 0; i < 4; ++i) {
        const int m = k * 32 + i * 8 + wave, l = m / (NEXP * I_E); int r = m % (NEXP * I_E); const int e = r / I_E; r = r % I_E; const size_t le = (size_t)l * NEXP + e;
        const float* W; bf16* WT; int ldw, K, ncol, r0 = 0, rmul = 1; const float* gk = nullptr;
        if (r < 2 * I_G) { const int up = r >= I_G; r -= up * I_G; W = p->in[19 + up] + le * D_ * DEXP; WT = (bf16*)(ws + WS_WGU_T) + le * 512 * D_; ldw = DEXP; K = D_; ncol = 256; r0 = up; rmul = 2; gk = p->in[14] + (size_t)l * D_; }
        else { r -= 2 * I_G; W = p->in[21] + le * DEXP * D_; WT = (bf16*)(ws + WS_WD_T) + le * D_ * DEXP; ldw = D_; K = DEXP; ncol = 1024; }
        transpose_seg(W, ldw, K, 0, ncol, WT, r0, rmul, r, scr, lane, gk);
    }
}
__device__ __forceinline__ int fetch_unit(KP p, int qidx) {
    volatile LAS unsigned* slot = (volatile LAS unsigned*)((LAS unsigned char*)lds_raw + MISC_OFF) + 16;
    __syncthreads();
    int t0_ = threadIdx.x; asm volatile("" : "+v"(t0_));
    if (t0_ == 0) *slot = __hip_atomic_fetch_add((unsigned*)(p->ws + WS_CTL) + CW_QUEUE + 64 * qidx, 1u, __ATOMIC_RELAXED, __HIP_MEMORY_SCOPE_AGENT);
    __syncthreads();
    return (int)__builtin_amdgcn_readfirstlane(*slot);
}
__device__ __forceinline__ void P_cmp1_mfma(int l_) { const KP p = (KP)__builtin_amdgcn_kernarg_segment_ptr(); int l = l_; asm volatile("" : "+s"(l));
    unsigned char* ws = p->ws; asm volatile("" : "+s"(ws)); const int c = launder_s((int)blockIdx.x), kv = c >> 4, pm = c & 15;
    OneUnitOrder S; S.has = c < 32; S.u.pm = pm; S.u.pn = kv;
    S.u.a = (const char*)(ws + WS_KV6 + (size_t)kv * KV6_STRIDE) + (size_t)pm * 256 * 1024 * 2; S.u.b = (const char*)((const bf16*)(ws + WS_W1_T) + ((size_t)l * 2 + kv) * 256 * 2048); S.u.b2 = S.u.b;
    const pg8::Gemm g{1024, 2048, 2048, 32, 0, 0};
    const EpiCmpH E{(bf16*)(ws + WS_HC), (const float*)(ws + WS_BIAS1) + l * 512};
    pg8::gemm_phase<EpiCmpH, OneUnitOrder, false, true>((LAS unsigned char*)lds_raw, g, S, E);
}
__device__ __forceinline__ void P_cmp2_mfma(int l_) { const KP p = (KP)__builtin_amdgcn_kernarg_segment_ptr(); int l = l_; asm volatile("" : "+s"(l));
    unsigned char* ws = p->ws; asm volatile("" : "+s"(ws)); const int c = launder_s((int)blockIdx.x), kv = c >> 4, pm = c & 15;
    OneUnitOrder S; S.has = c < 32; S.u.pm = pm; S.u.pn = kv;
    S.u.a = (const char*)((const bf16*)(ws + WS_HC) + ((size_t)kv * 4096 + pm * 256) * 256); S.u.b = (const char*)((const bf16*)(ws + WS_W2_T) + ((size_t)l * 2 + kv) * 64 * 256); S.u.b2 = S.u.b;
    const pg8::Gemm g{256, 256, 256, 4, 0, 0};
    const EpiCmpOut E{(bf16*)(ws + WS_KVCMP)};
    pg8::gemm_phase<EpiCmpOut, OneUnitOrder, false, true>((LAS unsigned char*)lds_raw, g, S, E);
}
__device__ __forceinline__ void P_moe_scatter(KP p_, int l_) { const KP p = uni_kp(p_); const int l = __builtin_amdgcn_readfirstlane(l_); const Ctx c = make_ctx(p); unsigned char* ws = p->ws;
    const unsigned* cnt = (const unsigned*)(ws + WS_CTL) + CW_MOECNT + l * MOE_LS;
    moe_build_tables(cnt, c.tid);
    const LAS int* T = (const LAS int*)((LAS unsigned char*)lds_raw + TBL_OFF);
    const unsigned* info = (const unsigned*)(ws + WS_ROUTE + RT_INFO); const float* tw = (const float*)(ws + WS_ROUTE + RT_W);
    int* rowtok = (int*)(ws + WS_ROUTE + RT_ROWTOK); float* roww = (float*)(ws + WS_ROUTE + RT_ROWW);
    bf16* xs = (bf16*)(ws + WS_XS); const bf16* x = (const bf16*)(ws + WS_HN); const float* gain = p->in[14] + (size_t)l * D_; const float* rstdv = (const float*)(ws + WS_ROUTE + RT_RSTD);
    { constexpr int RB = 4; float gg[2][8];
#pragma unroll
      for (int j = 0; j < 2; ++j) { const f32x4 a = ((const f32x4*)gain)[2 * c.lane + 128 * j], b2 = ((const f32x4*)gain)[2 * c.lane + 128 * j + 1]; gg[j][0] = a.x; gg[j][1] = a.y; gg[j][2] = a.z; gg[j][3] = a.w; gg[j][4] = b2.x; gg[j][5] = b2.y; gg[j][6] = b2.z; gg[j][7] = b2.w; }
      for (int row0 = c.gw * RB; row0 < NT; row0 += c.ngw * RB) {
        u32x4 vv[RB][2];
#pragma unroll
        for (int q = 0; q < RB; ++q)
#pragma unroll
            for (int j = 0; j < 2; ++j) vv[q][j] = ((const u32x4*)(x + (size_t)(row0 + q) * D_))[c.lane + 64 * j];
#pragma unroll
        for (int q = 0; q < RB; ++q) { const int row = row0 + q;
            const unsigned v = info[row]; const int cls = (int)(v >> 24), rank = (int)(v & 0xffffffu); const size_t dest = (size_t)T[cls] * 256 + rank; const float r = rstdv[row];
#pragma unroll
            for (int j = 0; j < 2; ++j) { float f[8]; unpack8(vv[q][j], f); u32x4 o; o.x = pk2(f[0] * r * gg[j][0], f[1] * r * gg[j][1]); o.y = pk2(f[2] * r * gg[j][2], f[3] * r * gg[j][3]); o.z = pk2(f[4] * r * gg[j][4], f[5] * r * gg[j][5]); o.w = pk2(f[6] * r * gg[j][6], f[7] * r * gg[j][7]);
                ((u32x4*)(xs + dest * D_))[c.lane + 64 * j] = o; }
            if (c.lane == 0) { rowtok[dest] = row; roww[2 * dest] = tw[2 * row]; roww[2 * dest + 1] = tw[2 * row + 1]; } }
      } }
    for (int cls = c.bid; cls < 112; cls += c.G) { const int n = (int)cnt[cls * MOE_CS], end = (int)((cnt[cls * MOE_CS] + 255u) >> 8) * 256; const size_t base = (size_t)T[cls] * 256;
        for (int r = n + c.tid; r < end; r += NTHREADS) rowtok[base + r] = -1; }
}
__device__ __forceinline__ int xcd_major(int bid, int G) { bid = launder_s(bid); return (G & 7) ? bid : (bid & 7) * (G >> 3) + (bid >> 3); }
__device__ __forceinline__ void P_moe_g1(int l_) { const KP p = (KP)__builtin_amdgcn_kernarg_segment_ptr(); int l = l_; asm volatile("" : "+s"(l));
    unsigned char* ws = p->ws; asm volatile("" : "+s"(ws));
    { int t0_ = threadIdx.x; asm volatile("" : "+v"(t0_)); moe_build_tables((const unsigned*)(ws + WS_CTL) + CW_MOECNT + l * MOE_LS, t0_); }
    const MoeOrder1 S{(const char*)ws, (const unsigned*)(ws + WS_REC), (const char*)((const bf16*)(ws + WS_WGU_T) + (size_t)l * NEXP * 512 * D_), (unsigned*)(ws + WS_CTL) + CW_MOECNT + l * MOE_LS + (112 + NEXP) * MOE_CS, (int)gridDim.x, xcd_major((int)blockIdx.x, (int)gridDim.x)};
    const pg8::Gemm g{D_, D_, D_, D_ / 64, 0, 0};
    const EpiMoeH E{(bf16*)(ws + WS_HB), (const u32x4*)(ws + WS_REC)};
    pg8::gemm_phase<EpiMoeH, MoeOrder1, true, true, true>((LAS unsigned char*)lds_raw, g, S, E);
}
__device__ __forceinline__ void P_moe_g2(int l_) { const KP p = (KP)__builtin_amdgcn_kernarg_segment_ptr(); int l = l_; asm volatile("" : "+s"(l));
    unsigned char* ws = p->ws; asm volatile("" : "+s"(ws));
    { int t0_ = threadIdx.x; asm volatile("" : "+v"(t0_)); moe_build_tables((const unsigned*)(ws + WS_CTL) + CW_MOECNT + l * MOE_LS, t0_); }
    const MoeOrder2 S{(const char*)(ws + WS_HB), (const char*)((const bf16*)(ws + WS_WD_T) + (size_t)l * NEXP * D_ * DEXP), (const unsigned*)(ws + WS_CTL) + CW_MOECNT + l * MOE_LS + (112 + NEXP) * MOE_CS, (unsigned*)(ws + WS_CTL) + XB_TMO + 4096, (int)gridDim.x, xcd_major((int)blockIdx.x, (int)gridDim.x)};
    const pg8::Gemm g{512, DEXP, 512, 4, 16, 16};
    const EpiMoeOut E{(bf16*)(ws + WS_HN), (const unsigned*)(ws + WS_RECC)};
    pg8::gemm_phase<EpiMoeOut, MoeOrder2, true, true>((LAS unsigned char*)lds_raw, g, S, E);
}
__device__ __forceinline__ void P_bias1(KP p_) { const KP p = uni_kp(p_); int t_ = threadIdx.x; asm volatile("" : "+v"(t_));
    const int i = launder_s((int)blockIdx.x) * NTHREADS + t_; if (i < L_ * 2 * 256) { const float* part = (const float*)(p->ws + WS_B1PART) + (size_t)(i >> 8) * 128 * 256 + (i & 255); float a = 0.f;
        for (int k = 0; k < 128; ++k) a += part[(size_t)k * 256]; ((float*)(p->ws + WS_BIAS1))[i] = a; } }
__device__ __forceinline__ void P_norm1(KP p_, int l_) { const KP p = uni_kp(p_); const int l = __builtin_amdgcn_readfirstlane(l_); const Ctx c = make_ctx(p); const Bufs b = make_bufs(p->ws);
    if (l == 0) ph_norm_bf16(c, p->in[0], p->in[1], (bf16*)p->out, (bf16*)(p->ws + WS_HN)); else ph_norm_bf16_from_bf16(c, (const bf16*)(p->ws + WS_HN), p->in[1] + (size_t)l * D_, (bf16*)p->out); }
__device__ __noinline__ void P_inproj(KP p_, int l_) { const KP p = uni_kp(p_); const int l = __builtin_amdgcn_readfirstlane(l_); const Ctx c = make_ctx(p); const Bufs b = make_bufs(p->ws);
    InProjOut o{b.QN, b.KV6, b.FQ, b.DQ, b.DV, b.GATE, b.FL, p->in[3] + l * 24, p->in[4] + l * 4};
    const bf16* A = b.HN;
    naive_gemm(c, NT, D_IN, D_, [=](int r, int k) { return bf2f(A[(size_t)r * D_ + k]); }, p->in[2] + (size_t)l * D_ * D_IN, D_IN,
               [=](int r, int col, float v) { inproj_store(o, r, col, v); }); }
__device__ __noinline__ void P_cmp1(KP p_, int l_, int kv_) { const KP p = uni_kp(p_); const int l = __builtin_amdgcn_readfirstlane(l_), kv = __builtin_amdgcn_readfirstlane(kv_); const Ctx c = make_ctx(p); const Bufs b = make_bufs(p->ws);
    const bf16* src = kv == 0 ? b.KC : b.VC; const float* pe = p->in[kv == 0 ? 5 : 8] + (size_t)l * 2048; bf16* hc = b.HC + (size_t)kv * 4096 * 256;
    naive_gemm(c, 4096, 256, 2048, [=](int r, int k) { return bf2f(src[(size_t)r * 1024 + k]) + pe[k]; }, p->in[kv == 0 ? 6 : 9] + (size_t)l * 2048 * 256, 256,
               [=](int r, int col, float v) { hc[(size_t)r * 256 + col] = (bf16)f2bf(gelu_tanh(v)); }); }
__device__ __noinline__ void P_cumsum(KP p_, int l_) { const KP p = uni_kp(p_); const int l = __builtin_amdgcn_readfirstlane(l_); const Ctx c = make_ctx(p); const Bufs b = make_bufs(p->ws); ph_cumsum(c, b.FL); }
__device__ __noinline__ void P_cmp2(KP p_, int l_, int kv_) { const KP p = uni_kp(p_); const int l = __builtin_amdgcn_readfirstlane(l_), kv = __builtin_amdgcn_readfirstlane(kv_); const Ctx c = make_ctx(p); const Bufs b = make_bufs(p->ws);
    const bf16* hc = b.HC + (size_t)kv * 4096 * 256; bf16* dst = kv == 0 ? b.KCMP : b.VCMP;
    naive_gemm(c, 4096, 64, 256, [=](int r, int k) { return bf2f(hc[(size_t)r * 256 + k]); }, p->in[kv == 0 ? 7 : 10] + (size_t)l * 256 * 64, 64,
               [=](int r, int col, float v) { dst[(size_t)r * 64 + col] = (bf16)f2bf((r & 255) == 255 ? 0.f : v); }); }
__device__ __noinline__ void P_win(KP p_, int l_) { const KP p = uni_kp(p_); const int l = __builtin_amdgcn_readfirstlane(l_); const Ctx c = make_ctx(p); const Bufs b = make_bufs(p->ws); ph_win_attn(c, b.QN, b.KW, b.VW, b.GATE, b.OWIN); }
__device__ __noinline__ void P_fox(KP p_, int l_) { const KP p = uni_kp(p_); const int l = __builtin_amdgcn_readfirstlane(l_); const Ctx c = make_ctx(p); const Bufs b = make_bufs(p->ws); ph_fox_attn(c, b.FQ, b.FK, b.FV, b.FL, b.ATT); }
__device__ __noinline__ void P_diff(KP p_, int l_) { const KP p = uni_kp(p_); const int l = __builtin_amdgcn_readfirstlane(l_); const Ctx c = make_ctx(p); const Bufs b = make_bufs(p->ws);
    ph_diff_attn(c, b.DQ, b.DK, b.DV, p->in[11] + (size_t)l * 128, p->in[12] + (size_t)l * 64, lambda_init_of(l), b.ATT); }
__device__ __noinline__ void P_cmpattn(KP p_, int l_) { const KP p = uni_kp(p_); const int l = __builtin_amdgcn_readfirstlane(l_); const Ctx c = make_ctx(p); const Bufs b = make_bufs(p->ws); ph_cmp_attn(c, b.QN, b.KCMP, b.VCMP, b.GATE, b.SEL, b.OCMP); }
__device__ __noinline__ void P_slc(KP p_, int l_) { const KP p = uni_kp(p_); const int l = __builtin_amdgcn_readfirstlane(l_); const Ctx c = make_ctx(p); const Bufs b = make_bufs(p->ws); ph_slc_attn(c, b.QN, b.KS, b.VS, b.GATE, b.SEL, b.OCMP, b.OWIN, b.ATT); }
__device__ __noinline__ void P_outproj(KP p_, int l_) { const KP p = uni_kp(p_); const int l = __builtin_amdgcn_readfirstlane(l_); const Ctx c = make_ctx(p); const Bufs b = make_bufs(p->ws);
    const bf16* A = b.ATT; float* xo = p->out; const float* xin = (l == 0) ? p->in[0] : p->out;
    naive_gemm(c, NT, D_, D_, [=](int r, int k) { return bf2f(A[(size_t)r * D_ + k]); }, p->in[13] + (size_t)l * D_ * D_, D_,
               [=](int r, int col, float v) { xo[(size_t)r * D_ + col] = xin[(size_t)r * D_ + col] + v; }); }
__device__ __forceinline__ void P_route3(int l_, int cbank) { const KP p = (KP)__builtin_amdgcn_kernarg_segment_ptr(); int l = l_; asm volatile("" : "+s"(l));
    int tid_ = threadIdx.x; asm volatile("" : "+v"(tid_));
    const int tid = tid_, lane = tid & 63, wave = __builtin_amdgcn_readfirstlane(tid >> 6), r = lane & 31, h = lane >> 5, kh = wave >> 2, wr = wave & 3;
    unsigned char* ws = p->ws; asm volatile("" : "+s"(ws)); const bf16* x = (const bf16*)(ws + WS_HN);
    const float* WR = (const float*)(ws + WS_WR) + (size_t)l * D_ * 64;
    LAS float* XT = (LAS float*)lds_raw + wave * (32 * 36);
    LAS float* WT = (LAS float*)lds_raw + 8 * 32 * 36 + kh * (2 * 32 * 64);
    LAS float* PL = (LAS float*)lds_raw + 8 * 32 * 36 + 2 * 2 * 32 * 64;
    LAS float* SS = PL + 2 * 128 * 40;
    const float* bgrp = p->in[16] + l * 4; const float* bexp = p->in[18] + l * 32;
    unsigned* cnt = (unsigned*)(ws + WS_CTL) + CW_MOECNT + l * MOE_LS + cbank;
    LAS unsigned* HIST = (LAS unsigned*)(SS + 2 * 128 * 2);
    for (int grp = launder_s((int)blockIdx.x); grp < NT / 128; grp += (int)gridDim.x) {
        const int row0 = grp * 128 + wr * 32;
        if (tid < 144) HIST[tid] = 0u;
        f32x16 acc0, acc1; float ss = 0.f;
#pragma unroll
        for (int i = 0; i < 16; ++i) { acc0[i] = 0.f; acc1[i] = 0.f; }
        { const u32x4* xsrc = (const u32x4*)(x + (size_t)(row0 + r) * D_ + kh * 512 + 8 * h);
          const u32x4* wsrc = (const u32x4*)(ws + WS_WR) + ((size_t)l * 64 + kh * 32) * 256 + lane;
#pragma unroll 4
          for (int ks = 0; ks < 32; ++ks) {
              const u32x4 av = xsrc[2 * ks], b0h = wsrc[ks * 256], b0l = wsrc[ks * 256 + 64], b1h = wsrc[ks * 256 + 128], b1l = wsrc[ks * 256 + 192];
              { float f_[8]; unpack8(av, f_);
#pragma unroll
                for (int e = 0; e < 8; ++e) ss = fmaf(f_[e], f_[e], ss); }
              const bf16x8v A = __builtin_bit_cast(bf16x8v, av);
              acc0 = __builtin_amdgcn_mfma_f32_32x32x16_bf16(A, __builtin_bit_cast(bf16x8v, b0h), acc0, 0, 0, 0); acc1 = __builtin_amdgcn_mfma_f32_32x32x16_bf16(A, __builtin_bit_cast(bf16x8v, b1h), acc1, 0, 0, 0);
              acc0 = __builtin_amdgcn_mfma_f32_32x32x16_bf16(A, __builtin_bit_cast(bf16x8v, b0l), acc0, 0, 0, 0); acc1 = __builtin_amdgcn_mfma_f32_32x32x16_bf16(A, __builtin_bit_cast(bf16x8v, b1l), acc1, 0, 0, 0);
          } }
#pragma unroll
        for (int reg = 0; reg < 16; ++reg) { const int row = wr * 32 + crow0(reg) + 4 * h; PL[(kh * 128 + row) * 40 + r] = acc0[reg]; if (r < 4) PL[(kh * 128 + row) * 40 + 32 + r] = acc1[reg]; }
        SS[(kh * 128 + wr * 32 + r) * 2 + h] = ss;
        __syncthreads();
        int cls = 0, ea = 0, eb = 0; unsigned lrank = 0u, lra = 0u, lrb = 0u; float wlo = 0.f, whi = 0.f, rstd = 0.f;
        if (tid < 128) {
            float lg[36];
#pragma unroll
            for (int cidx = 0; cidx < 36; ++cidx) lg[cidx] = PL[tid * 40 + cidx] + PL[(128 + tid) * 40 + cidx];
            const float sq = (SS[tid * 2] + SS[tid * 2 + 1]) + (SS[(128 + tid) * 2] + SS[(128 + tid) * 2 + 1]);
            rstd = rsqrtf(sq * (1.f / D_) + EPS);
            float gl[4]; int grp_i = 0;
#pragma unroll
            for (int q = 0; q < 4; ++q) gl[q] = lg[q] * rstd + bgrp[q];
            float gm = gl[0];
#pragma unroll
            for (int q = 1; q < 4; ++q) if (gl[q] > gm) { gm = gl[q]; grp_i = q; }
            float gs = 0.f;
#pragma unroll
            for (int q = 0; q < 4; ++q) gs += __expf(gl[q] - gm);
            const float grp_gate = 1.f / gs;
            float el[8];
#pragma unroll
            for (int q = 0; q < 8; ++q) { float v = lg[4 + q]; float bb = bexp[q];
                if (grp_i == 1) { v = lg[12 + q]; bb = bexp[8 + q]; } else if (grp_i == 2) { v = lg[20 + q]; bb = bexp[16 + q]; } else if (grp_i == 3) { v = lg[28 + q]; bb = bexp[24 + q]; }
                el[q] = v * rstd + bb; }
            int i0 = 0; float v0 = el[0];
#pragma unroll
            for (int q = 1; q < 8; ++q) if (el[q] > v0) { v0 = el[q]; i0 = q; }
            int i1 = -1; float v1 = -INFINITY;
#pragma unroll
            for (int q = 0; q < 8; ++q) if (q != i0 && el[q] > v1) { v1 = el[q]; i1 = q; }
            const float e1 = __expf(v1 - v0), den = 1.f + e1, w0 = grp_gate / den, w1 = grp_gate * e1 / den;
            const int lo = i0 < i1 ? i0 : i1, hi = i0 < i1 ? i1 : i0; cls = grp_i * 28 + lo * 8 - (lo * (lo + 1)) / 2 + (hi - lo - 1);
            wlo = i0 < i1 ? w0 : w1; whi = i0 < i1 ? w1 : w0;
            ea = grp_i * 8 + lo; eb = grp_i * 8 + hi;
            lrank = __hip_atomic_fetch_add(HIST + cls, 1u, __ATOMIC_RELAXED, __HIP_MEMORY_SCOPE_WORKGROUP);
            lra = __hip_atomic_fetch_add(HIST + 112 + ea, 1u, __ATOMIC_RELAXED, __HIP_MEMORY_SCOPE_WORKGROUP); lrb = __hip_atomic_fetch_add(HIST + 112 + eb, 1u, __ATOMIC_RELAXED, __HIP_MEMORY_SCOPE_WORKGROUP);
        }
        __syncthreads();
        if (tid < 144) { const unsigned n = HIST[tid]; if (n) HIST[144 + tid] = __hip_atomic_fetch_add(cnt + tid * MOE_CS, n, __ATOMIC_RELAXED, __HIP_MEMORY_SCOPE_AGENT); }
        __syncthreads();
        if (tid < 128) {
            const unsigned rank = HIST[144 + cls] + lrank, ra = HIST[144 + 112 + ea] + lra, rb = HIST[144 + 112 + eb] + lrb;
            const int row = grp * 128 + tid;
            ((unsigned*)(ws + WS_RECC))[(size_t)cls * 32768 + rank] = (unsigned)row;
            const unsigned info = ((unsigned)cls << 16) | rank;
            ((u32x4*)(ws + WS_REC))[(size_t)ea * 32768 + ra] = (u32x4){(unsigned)row, __float_as_uint(wlo), __float_as_uint(rstd), info};
            ((u32x4*)(ws + WS_REC))[(size_t)eb * 32768 + rb] = (u32x4){(unsigned)row, __float_as_uint(whi), __float_as_uint(rstd), info | 0x8000u};
        }
        __syncthreads();
    }
}
typedef float f32x8 __attribute__((ext_vector_type(8)));
__device__ __forceinline__ void P_route2(int l_, int cbank) { const KP p = (KP)__builtin_amdgcn_kernarg_segment_ptr(); int l = l_; asm volatile("" : "+s"(l));
    int tid_ = threadIdx.x; asm volatile("" : "+v"(tid_));
    const int tid = tid_, lane = tid & 63, wave = __builtin_amdgcn_readfirstlane(tid >> 6);
    unsigned char* ws = p->ws; asm volatile("" : "+s"(ws)); const float* x = p->out;
    const float* WR = (const float*)(ws + WS_WR) + (size_t)l * D_ * 40;
    LAS float* xt = (LAS float*)lds_raw + wave * (64 * 36);
    LAS float* part = (LAS float*)lds_raw;
    const float* bgrp = p->in[16] + l * 4; const float* bexp = p->in[18] + l * 32;
    unsigned* cnt = (unsigned*)(ws + WS_CTL) + CW_MOECNT + l * 128 + cbank;
    for (int grp = launder_s((int)blockIdx.x); grp < NT / 128; grp += (int)gridDim.x) {
        const int row0 = grp * 128 + (wave >> 2) * 64, kq = wave & 3;
        float acc[40]; float ss = 0.f;
#pragma unroll
        for (int cidx = 0; cidx < 40; ++cidx) acc[cidx] = 0.f;
#pragma unroll 1
        for (int kc = 0; kc < 8; ++kc) {
            const int k0 = kq * 256 + kc * 32;
#pragma unroll
            for (int i = 0; i < 8; ++i) { const int row = i * 8 + (lane >> 3), c4 = (lane & 7) * 4; *(LAS f32x4*)(xt + row * 36 + c4) = *(const f32x4*)(x + (size_t)(row0 + row) * D_ + k0 + c4); }
            float xr[32];
#pragma unroll
            for (int j = 0; j < 8; ++j) { const f32x4 t = *(const LAS f32x4*)(xt + lane * 36 + 4 * j); xr[4 * j] = t.x; xr[4 * j + 1] = t.y; xr[4 * j + 2] = t.z; xr[4 * j + 3] = t.w; }
            const float* wk = WR + (size_t)k0 * 40;
#pragma unroll
            for (int kk = 0; kk < 32; ++kk) {
                f32x8 w0, w1, w2, w3, w4;
                asm volatile("s_load_dwordx8 %0, %5, %6\n\ts_load_dwordx8 %1, %5, %7\n\ts_load_dwordx8 %2, %5, %8\n\ts_load_dwordx8 %3, %5, %9\n\ts_load_dwordx8 %4, %5, %10\n\ts_waitcnt lgkmcnt(0)"
                             : "=&s"(w0), "=&s"(w1), "=&s"(w2), "=&s"(w3), "=&s"(w4) : "s"(wk), "i"(kk * 160), "i"(kk * 160 + 32), "i"(kk * 160 + 64), "i"(kk * 160 + 96), "i"(kk * 160 + 128) : "memory");
                const float xv = xr[kk]; ss = fmaf(xv, xv, ss);
#pragma unroll
                for (int e = 0; e < 8; ++e) { acc[e] = fmaf(xv, w0[e], acc[e]); acc[8 + e] = fmaf(xv, w1[e], acc[8 + e]); acc[16 + e] = fmaf(xv, w2[e], acc[16 + e]); acc[24 + e] = fmaf(xv, w3[e], acc[24 + e]); }
#pragma unroll
                for (int e = 0; e < 4; ++e) acc[32 + e] = fmaf(xv, w4[e], acc[32 + e]);
            }
        }
        __syncthreads();
#pragma unroll
        for (int cidx = 0; cidx < 36; ++cidx) part[(wave * 64 + lane) * 37 + cidx] = acc[cidx];
        part[(wave * 64 + lane) * 37 + 36] = ss;
        __syncthreads();
        if (tid < 128) {
            const int rg = tid >> 6, rr = tid & 63; float lg[37];
#pragma unroll
            for (int cidx = 0; cidx < 37; ++cidx) lg[cidx] = ((part[((rg * 4 + 0) * 64 + rr) * 37 + cidx] + part[((rg * 4 + 1) * 64 + rr) * 37 + cidx]) + part[((rg * 4 + 2) * 64 + rr) * 37 + cidx]) + part[((rg * 4 + 3) * 64 + rr) * 37 + cidx];
            const float rstd = rsqrtf(lg[36] * (1.f / D_) + EPS);
            float gl[4]; int grp_i = 0;
#pragma unroll
            for (int q = 0; q < 4; ++q) gl[q] = lg[q] * rstd + bgrp[q];
            float gm = gl[0];
#pragma unroll
            for (int q = 1; q < 4; ++q) if (gl[q] > gm) { gm = gl[q]; grp_i = q; }
            float gs = 0.f;
#pragma unroll
            for (int q = 0; q < 4; ++q) gs += __expf(gl[q] - gm);
            const float grp_gate = 1.f / gs;
            float el[8];
#pragma unroll
            for (int q = 0; q < 8; ++q) { float v = lg[4 + q]; float bb = bexp[q];
                if (grp_i == 1) { v = lg[12 + q]; bb = bexp[8 + q]; } else if (grp_i == 2) { v = lg[20 + q]; bb = bexp[16 + q]; } else if (grp_i == 3) { v = lg[28 + q]; bb = bexp[24 + q]; }
                el[q] = v * rstd + bb; }
            int i0 = 0; float v0 = el[0];
#pragma unroll
            for (int q = 1; q < 8; ++q) if (el[q] > v0) { v0 = el[q]; i0 = q; }
            int i1 = -1; float v1 = -INFINITY;
#pragma unroll
            for (int q = 0; q < 8; ++q) if (q != i0 && el[q] > v1) { v1 = el[q]; i1 = q; }
            const float e1 = __expf(v1 - v0), den = 1.f + e1, w0 = grp_gate / den, w1 = grp_gate * e1 / den;
            const int lo = i0 < i1 ? i0 : i1, hi = i0 < i1 ? i1 : i0, cls = grp_i * 28 + lo * 8 - (lo * (lo + 1)) / 2 + (hi - lo - 1);
            const unsigned rank = __hip_atomic_fetch_add(cnt + cls, 1u, __ATOMIC_RELAXED, __HIP_MEMORY_SCOPE_AGENT);
            const int row = grp * 128 + tid;
            ((unsigned*)(ws + WS_ROUTE + RT_INFO))[row] = ((unsigned)cls << 24) | rank;
            ((float*)(ws + WS_ROUTE + RT_W))[2 * row] = i0 < i1 ? w0 : w1; ((float*)(ws + WS_ROUTE + RT_W))[2 * row + 1] = i0 < i1 ? w1 : w0;
            ((float*)(ws + WS_ROUTE + RT_RSTD))[row] = rstd;
        }
        __syncthreads();
    }
}
__device__ __noinline__ void P_route(KP p_, int l_) { const KP p = uni_kp(p_); const int l = __builtin_amdgcn_readfirstlane(l_); const Ctx c = make_ctx(p); const Bufs b = make_bufs(p->ws);
    ph_moe_route(c, p->out, p->in[14] + (size_t)l * D_, p->in[15] + (size_t)l * D_ * 4, p->in[16] + l * 4, p->in[17] + (size_t)l * D_ * 32, p->in[18] + l * 32, b.HN, (int*)(p->ws + WS_ROUTE + RT_INFO), (float*)(p->ws + WS_ROUTE + RT_W), (unsigned*)(p->ws + WS_CTL) + CW_MOECNT + l * 128); }
__device__ __noinline__ void P_moe(KP p_, int l_) { const KP p = uni_kp(p_); const int l = __builtin_amdgcn_readfirstlane(l_); const Ctx c = make_ctx(p); const Bufs b = make_bufs(p->ws);
    ph_moe_naive(c, b.HN, b.ROUTE_E, b.ROUTE_W, p->in[19] + (size_t)l * NEXP * D_ * DEXP, p->in[20] + (size_t)l * NEXP * D_ * DEXP, p->in[21] + (size_t)l * NEXP * DEXP * D_, p->out); }
__device__ __noinline__ void P_final(KP p_) { const KP p = uni_kp(p_); const Ctx c = make_ctx(p); ph_norm_final_from_bf16(c, (const bf16*)(p->ws + WS_HN), p->in[22], p->out); }
__device__ __forceinline__ void P_gridbar(KP p_) { const KP p = uni_kp(p_);
    XcdBarrier bar; bar.bar = (unsigned*)(p->ws + WS_CTL) + 4096; bar.x = xb_xcc_id(); bar.st = (volatile LAS unsigned*)((LAS unsigned char*)lds_raw + MISC_OFF) + 8;
    xcd_barrier(bar);
}

__global__ void __launch_bounds__(NTHREADS, 2) fwd_kernel(Params pp) {
    const KP p = (KP)__builtin_amdgcn_kernarg_segment_ptr();
    { volatile LAS unsigned* MISC = (volatile LAS unsigned*)((LAS unsigned char*)lds_raw + MISC_OFF); if (threadIdx.x < 32) MISC[threadIdx.x] = 0u; }
    __syncthreads();
    const int lo = p->ph_lo, hi = p->ph_hi;
    if (hi - lo > 1) (void)xcd_barrier_post((unsigned*)(p->ws + WS_CTL) + 4096, (volatile LAS unsigned*)((LAS unsigned char*)lds_raw + MISC_OFF) + 8);
#define IN(k) (lo <= (k) && (k) < hi)
#define SEAM(k) do { if (IN(k) && IN((k) + 1)) P_gridbar(p); } while (0)
    if (IN(0)) { for (int rep = 0; rep < REP_PRO; ++rep) { if (rep) P_gridbar(p); P_prologue(p); } }
    for (int l = 0; l < L_; ++l) {
        const int P0 = 1 + l * PH_PER_LAYER;
        if (IN(P0 + 0)) { for (int rep = 0; rep < REP_NORM; ++rep) { if (rep) P_gridbar(p); P_norm1(p, l); } }
        SEAM(P0 + 0);
        if (IN(P0 + 1)) { if (l == 0) P_bias1(p);
            for (int rep = 0; rep < REP_INPROJ; ++rep) { if (rep) P_gridbar(p); P_inproj_mfma(l); }
#ifdef REP_INDUMMY
            for (int rep = 0; rep < REP_INDUMMY; ++rep) { P_gridbar(p); P_inproj_dummy(l); }
#endif
        }
        SEAM(P0 + 1);
        if (IN(P0 + 3)) {
            P_cmp1_mfma(l);
            if (launder_s((int)blockIdx.x) < 32) { asm volatile("s_waitcnt vmcnt(0)" ::: "memory"); __builtin_amdgcn_fence(__ATOMIC_SEQ_CST, "agent"); asm volatile("s_waitcnt vmcnt(0)" ::: "memory"); }
            __syncthreads();
            P_cmp2_mfma(l);
            for (int rep = 0; rep < REP_ATT3; ++rep) { if (rep) P_gridbar(p);
            for (;;) { int u = fetch_unit(p, l * 8 + 0 + 16 * rep);
                if (l == 0) {
                    if (u >= 2048 + CONV_UNITS) break;
                    const int k11 = u / 11, r11 = u - 11 * k11;
                    if (r11 == 3 || r11 == 7 || r11 == 10) { U_conv(p, 3 * k11 + (r11 > 3) + (r11 > 7)); continue; }
                    u = 8 * k11 + r11 - (r11 > 3) - (r11 > 7); }
                else if (u >= 2048) break;
                if (u < 1024) { const int qb = 15 - (u >> 6), k = u & 63; if (k < 32) U_diff(p, k, qb, l); else U_fox(p, k - 32, qb, l); }
                else { const int w = u - 1024; U_win(p, w & 15, 63 - (w >> 4));
#ifdef PROBE_WINUNIT2
                    U_win(p, w & 15, 63 - (w >> 4));
#endif
                } } } }
        SEAM(P0 + 3);
        if (IN(P0 + 4)) { for (int rep = 0; rep < REP_CMP; ++rep) { if (rep) P_gridbar(p); for (int u = launder_s((int)blockIdx.x); u < 256; u += (int)gridDim.x) U_cmp(p, u & 15, u >> 4); } }
        SEAM(P0 + 4);
        if (IN(P0 + 5)) { for (int rep = 0; rep < REP_SLC; ++rep) { if (rep) P_gridbar(p); for (;;) { const int u = fetch_unit(p, l * 8 + 1 + 16 * rep); if (u >= 1024) break; U_slc(p, u & 15, 63 - (u >> 4)); } } }
        SEAM(P0 + 5);
        if (IN(P0 + 6)) P_outproj_mfma(l);
        SEAM(P0 + 6);
        if (IN(P0 + 7)) { for (int rep = 0; rep < REP_ROUTE; ++rep) { if (rep) P_gridbar(p); P_route3(l, REP_ROUTE - 1 - rep); } }
        SEAM(P0 + 7);
        if (IN(P0 + 9)) { for (int rep = 0; rep < REP_G1; ++rep) { if (rep) P_gridbar(p); P_moe_g1(l); } }
        if (IN(P0 + 10)) P_moe_g2(l);
        SEAM(P0 + 10);
    }
    if (IN(1 + L_ * PH_PER_LAYER)) P_final(p);
#undef IN
#undef SEAM
}

extern "C" void kernel_launch(void* const* d_in, const int* in_sizes, int n_in, void* d_out, int out_size, void* d_ws, size_t ws_size, hipStream_t stream) {
    static int grid = 0;
    if (grid == 0) {
        if (n_in != 23 || out_size != NT * D_ || ws_size < WS_END) { fprintf(stderr, "kernel_launch: unexpected sizes n_in %d out %d ws %zu (need %zu)\n", n_in, out_size, ws_size, (size_t)WS_END); grid = -1; return; }
        int dev = 0, cus = 0, per_cu = 0;
        if (hipGetDevice(&dev) != hipSuccess || hipDeviceGetAttribute(&cus, hipDeviceAttributeMultiprocessorCount, dev) != hipSuccess) { grid = -1; return; }
        if (hipFuncSetAttribute((const void*)fwd_kernel, hipFuncAttributeMaxDynamicSharedMemorySize, LDS_BYTES) != hipSuccess) { fprintf(stderr, "kernel_launch: hipFuncSetAttribute failed\n"); grid = -1; return; }
        if (hipOccupancyMaxActiveBlocksPerMultiprocessor(&per_cu, (const void*)fwd_kernel, NTHREADS, LDS_BYTES) != hipSuccess || per_cu < 1) { fprintf(stderr, "kernel_launch: occupancy query says %d\n", per_cu); }
        (void)hipGetLastError();
        grid = cus;
    }
    if (grid < 0) return;
    (void)hipMemsetAsync((char*)d_ws + WS_CTL, 0, CTL_BYTES, stream);
    Params p{};
    for (int i = 0; i < 23; ++i) p.in[i] = (const float*)d_in[i];
    p.out = (float*)d_out; p.ws = (unsigned char*)d_ws;
#if N_LAUNCH_MODE == 0
    p.ph_lo = 0; p.ph_hi = N_PHASES;
    hipLaunchKernelGGL(fwd_kernel, dim3(grid), dim3(NTHREADS), LDS_BYTES, stream, p);
#else
    for (int k = 0; k < N_PHASES; ++k) { p.ph_lo = k; p.ph_hi = k + 1; hipLaunchKernelGGL(fwd_kernel, dim3(grid), dim3(NTHREADS), LDS_BYTES, stream, p); }
#endif
}
```

```cpp
#include <hip/hip_runtime.h>
#include <cstdio>
#include <cstdint>

#ifndef INPROJ_ALIGN
#define INPROJ_ALIGN true
#endif
#ifndef INPROJ_SP2
#define INPROJ_SP2 true
#endif
#ifndef REP_PRO
#define REP_PRO 1
#endif
#ifndef REP_ROUTE
#define REP_ROUTE 1
#endif
#ifndef REP_NORM
#define REP_NORM 1
#endif
#ifndef REP_INPROJ
#define REP_INPROJ 1
#endif
#ifndef REP_ATT3
#define REP_ATT3 1
#endif
#ifndef REP_CMP
#define REP_CMP 1
#endif
#ifndef REP_SLC
#define REP_SLC 1
#endif
#ifndef REP_SCAT
#define REP_SCAT 1
#endif
#ifndef REP_G1
#define REP_G1 1
#endif
#ifndef N_LAUNCH_MODE
#define N_LAUNCH_MODE 0
#endif

#ifndef NOMAX_ON
#define NOMAX_ON true
#endif
#define LAS __attribute__((address_space(3)))
#define GAS __attribute__((address_space(1)))
typedef unsigned short bf16;
typedef unsigned long long u64;
typedef float f32x4 __attribute__((ext_vector_type(4)));
typedef unsigned u32x4 __attribute__((ext_vector_type(4)));

constexpr int B_ = 8, T_ = 4096, D_ = 1024, NT = B_ * T_, L_ = 2;
constexpr int HD = 64, D_IN = 2844;
constexpr int N_CMP = 255, CMP_HID = 256;
constexpr int NEXP = 32, DEXP = 256;
constexpr float EPS = 1e-6f;
constexpr float LOG2E = 1.4426950408889634f;
constexpr int NWAVES = 8, NTHREADS = 512;

constexpr int C_NSAQ = 0, C_KV6 = 512, C_GATE = 1280, C_FQ = 1304, C_FF = 2072, C_DQ = 2076, C_DV = 2588;

constexpr size_t MiB = 1u << 20;
constexpr size_t WS_CTL = 0, CTL_BYTES = 1 * MiB;
constexpr size_t WS_QN = 1 * MiB;
constexpr size_t WS_KV6 = WS_QN + 32 * MiB;
constexpr size_t KV6_STRIDE = 8 * MiB + 64 * 1024;
constexpr size_t WS_FQKV = WS_KV6 + 6 * KV6_STRIDE;
constexpr size_t WS_DQK = WS_FQKV + 48 * MiB;
constexpr size_t WS_DV = WS_DQK + 32 * MiB;
constexpr size_t WS_GATE = WS_DV + 16 * MiB;
constexpr size_t WS_FL = WS_GATE + 3 * MiB;
constexpr size_t WS_HC = WS_FL + 1 * MiB;
constexpr size_t WS_KVCMP = WS_HC + 4 * MiB;
constexpr size_t WS_SEL = WS_KVCMP + 1 * MiB;
constexpr size_t WS_OCMP = WS_SEL + 1 * MiB;
constexpr size_t WS_OWIN = WS_OCMP + 32 * MiB;
constexpr size_t WS_HN = WS_OWIN + 32 * MiB;
constexpr size_t WS_ATT = WS_HN + 64 * MiB;
constexpr size_t WS_ROUTE = WS_ATT + 64 * MiB;
constexpr size_t WS_WIN_T = WS_ROUTE + 2 * MiB;
constexpr size_t WS_WOUT_T = WS_WIN_T + 12 * MiB;
constexpr size_t WS_WGU_T = WS_WOUT_T + 4 * MiB;
constexpr size_t WS_WD_T = WS_WGU_T + 64 * MiB;
constexpr size_t WS_W1_T = WS_WD_T + 32 * MiB;
constexpr size_t WS_W2_T = WS_W1_T + 4 * MiB;
constexpr size_t WS_BIAS1 = WS_W2_T + 512 * 1024;
constexpr size_t WS_WR = WS_BIAS1 + 512 * 1024;
constexpr size_t WS_B1PART = WS_WR + 512 * 1024;
constexpr size_t WS_END = WS_B1PART + 512 * 1024;
constexpr int MOE_MAXROWS = 61440;
constexpr size_t WS_XS = WS_QN;
constexpr size_t WS_HB = WS_OCMP;
static_assert(WS_XS + (size_t)MOE_MAXROWS * 2048 <= WS_DQK && WS_HB + (size_t)MOE_MAXROWS * 1024 <= WS_HN, "MoE aliases");
constexpr size_t RT_INFO = 0, RT_W = 128 * 1024, RT_ROWTOK = 384 * 1024, RT_ROWW = 640 * 1024, RT_RSTD = 1152 * 1024;
constexpr int CW_QUEUE = 16384, CW_MOECNT = 32768, CW_KN = 49152, MOE_CS = 32, MOE_LS = 8192;
constexpr size_t WS_REC = WS_QN;
constexpr size_t WS_RECC = WS_REC + (size_t)NEXP * 32768 * 16;
constexpr unsigned ZROW_OFF = 512 * 1024;
static_assert(WS_RECC + (size_t)112 * 32768 * 4 <= WS_DQK && WS_HN + (size_t)NT * 2048 < (1ull << 32) && CW_MOECNT + L_ * MOE_LS <= CW_KN && (112 + 2 * NEXP) * MOE_CS <= MOE_LS, "MoE record tables / 32-bit row offsets / counters");
constexpr int TBL_OFF = 131072 + 1024;
constexpr int NIN = 3072;

extern __shared__ __attribute__((aligned(16))) unsigned char lds_raw[];
__device__ __forceinline__ float bf2f(bf16 v) { return __uint_as_float(((unsigned)v) << 16); }
__device__ __forceinline__ unsigned f2bf(float f) { unsigned u = __float_as_uint(f); return (u + 0x7fffu + ((u >> 16) & 1u)) >> 16; }
__device__ __forceinline__ unsigned pk2(float lo, float hi) { return f2bf(lo) | (f2bf(hi) << 16); }
__device__ __forceinline__ float wave_sum(float v) {
#pragma unroll
    for (int o = 1; o < 64; o <<= 1) v += __shfl_xor(v, o);
    return v;
}
__device__ __forceinline__ float wave_max(float v) {
#pragma unroll
    for (int o = 1; o < 64; o <<= 1) v = fmaxf(v, __shfl_xor(v, o));
    return v;
}
__device__ __forceinline__ float shflx_f(float v, int o, int lane) { return __uint_as_float((unsigned)__builtin_amdgcn_ds_bpermute((lane ^ o) << 2, (int)__float_as_uint(v))); }
__device__ __forceinline__ unsigned shflx_u(unsigned v, int o, int lane) { return (unsigned)__builtin_amdgcn_ds_bpermute((lane ^ o) << 2, (int)v); }
__device__ __forceinline__ float wave_sum_l(float v, int lane) {
#pragma unroll
    for (int o = 1; o < 64; o <<= 1) v += shflx_f(v, o, lane);
    return v;
}
__device__ __forceinline__ int launder_s(int v) { asm volatile("" : "+s"(v)); return v; }
__device__ __forceinline__ float sigmoidf_(float x) { return 1.f / (1.f + __expf(-x)); }
__device__ __forceinline__ float log_sigmoidf_(float x) { return x >= 0.f ? -log1pf(__expf(-x)) : x - log1pf(__expf(x)); }
__device__ __forceinline__ float gelu_tanh(float x) { const float u = 0.7978845608028654f * (x + 0.044715f * x * x * x); return 0.5f * x * (1.f + tanhf(u)); }
__device__ __forceinline__ float alibi_slope(int idx1, int n) { return exp2f(-8.0f * (float)idx1 / (float)n); }

__device__ __forceinline__ constexpr int b64_off(int t, int d) { return ((t >> 4) * 2 + (d >> 5)) * 512 + (t & 15) * 32 + (d & 31); }
#define XB_TMO      128
#define XB_XCNT(j)  (256  + 64 * (j))
#define XB_XSUB(j)  (1280 + 64 * (j))
#define XB_XGEN(j)  (2304 + 64 * (j))
#define XB_TOP      3328
#define XB_TOPGEN   3392
#define XCD_BAR_WORDS 3456
#define XB_SPIN_CAP (1u << 25)
__device__ __forceinline__ unsigned xb_ld(unsigned* p)              { return __hip_atomic_load(p, __ATOMIC_RELAXED, __HIP_MEMORY_SCOPE_AGENT); }
__device__ __forceinline__ unsigned xb_add(unsigned* p, unsigned v) { return __hip_atomic_fetch_add(p, v, __ATOMIC_RELAXED, __HIP_MEMORY_SCOPE_AGENT); }
__device__ __forceinline__ unsigned xb_xcc_id() { return (unsigned)__builtin_amdgcn_s_getreg((3 << 11) | 20) & 0xFu; }
#define XB_SPIN(cond, bar) do { unsigned _sp = 0; while (cond) { __builtin_amdgcn_s_sleep(1); \
    if ((++_sp & 255u) == 0u) { if (xb_ld(&(bar)[XB_TMO])) break; if (_sp > XB_SPIN_CAP) { atomicAdd(&(bar)[XB_TMO], 1u); break; } } } } while (0)
struct XcdBarrier { unsigned* bar; unsigned x; volatile LAS unsigned* st; };
__device__ __forceinline__ XcdBarrier xcd_barrier_post(unsigned* bar, volatile LAS unsigned* st) {
    XcdBarrier b; b.bar = bar; b.x = xb_xcc_id(); b.st = st;
    if (threadIdx.x == 0) (void)xb_add(&bar[XB_XCNT(b.x)], 1u);
    return b;
}
__device__ __forceinline__ void xcd_barrier_complete(unsigned* bar, unsigned x, unsigned& nloc, unsigned& nx) {
    const unsigned G = gridDim.x * gridDim.y * gridDim.z;
    unsigned sum, cnt, mine, sp = 0u;
    for (;;) {
        sum = 0u; cnt = 0u; mine = 0u;
#pragma unroll
        for (unsigned j = 0; j < 16; ++j) { const unsigned c = xb_ld(&bar[XB_XCNT(j)]); sum += c; cnt += (c > 0u) ? 1u : 0u; mine = (j == x) ? c : mine; }
        if (sum == G) break;
        __builtin_amdgcn_s_sleep(1);
        if ((++sp & 255u) == 0u) { if (xb_ld(&bar[XB_TMO])) break; if (sp > XB_SPIN_CAP) { atomicAdd(&bar[XB_TMO], 1u); break; } }
    }
    nloc = mine > 0u ? mine : 1u; nx = cnt > 0u ? cnt : 1u;
}
__device__ __forceinline__ void xcd_barrier(const XcdBarrier& b) {
    asm volatile("s_waitcnt vmcnt(0)" ::: "memory");
    __syncthreads();
    if (threadIdx.x == 0) {
        unsigned* bar = b.bar;
        __builtin_amdgcn_s_waitcnt(0);
        unsigned nloc = b.st[0], nx = b.st[1];
        if (nloc == 0u) { xcd_barrier_complete(bar, b.x, nloc, nx); b.st[0] = nloc; b.st[1] = nx; }
        const unsigned old = xb_add(&bar[XB_XSUB(b.x)], 1u);
        const unsigned gen = old / nloc;
        if (old + 1u == (gen + 1u) * nloc) {
            __builtin_amdgcn_fence(__ATOMIC_RELEASE, "agent");
            asm volatile("s_waitcnt vmcnt(0)" ::: "memory");
            const unsigned og = xb_add(&bar[XB_TOP], 1u);
            const unsigned tg = og / nx;
            if (og + 1u == (tg + 1u) * nx) xb_add(&bar[XB_TOPGEN], 1u);
            else XB_SPIN(xb_ld(&bar[XB_TOPGEN]) == tg, bar);
            __builtin_amdgcn_fence(__ATOMIC_ACQUIRE, "agent");
            xb_add(&bar[XB_XGEN(b.x)], 1u);
            asm volatile("s_waitcnt vmcnt(0)" ::: "memory");
        } else {
            XB_SPIN(xb_ld(&bar[XB_XGEN(b.x)]) == gen, bar);
            __builtin_amdgcn_fence(__ATOMIC_ACQUIRE, "agent");
            asm volatile("s_waitcnt vmcnt(0)" ::: "memory");
        }
    }
    __syncthreads();
}

struct Params { const float* in[23]; float* out; unsigned char* ws; int ph_lo, ph_hi; };
constexpr int LDS_BYTES = 147456;
constexpr int MISC_OFF = 131072 + 320;

struct Ctx {
    LAS unsigned char* lds; int tid, lane, wave, bid, G, gw, ngw;
    const float* const* in; float* xcur; unsigned char* ws;
};

namespace pg8 {
#define PG8_LAS __attribute__((address_space(3)))
typedef unsigned short bf16_t;
typedef short bf16x8 __attribute__((ext_vector_type(8)));
typedef float f32x4 __attribute__((ext_vector_type(4)));
typedef unsigned u32x4 __attribute__((ext_vector_type(4)));
constexpr int BM = 256, BK = 64, HALF = 128, HTB = HALF * BK * 2  , STAGE_BYTES = 8 * HTB, NXCD = 8, WGM = 8;

__host__ __device__ __forceinline__ int lds_byte(int r, int c) { const int st = (r >> 4) * 2 + (c >> 5), rr = r & 15, cc = c & 31, ob = rr * 64 + cc * 2; return st * 1024 + (ob ^ (((ob >> 9) & 1) << 5)); }
__host__ __device__ __forceinline__ void stage_rc(int b, int& R, int& C) { const int st = b / 1024, sb = b % 1024, swz = sb ^ (((sb >> 9) & 1) << 5); R = (st >> 1) * 16 + swz / 64; C = (st & 1) * 32 + (swz % 64) / 2; }
__host__ __device__ __forceinline__ int perm32(int rho) { const int n = rho >> 4, i = rho & 15; return 8 * (i >> 2) + 4 * n + (i & 3); }

struct Unit { int pm, pn; const char* a; const char* b; const char* b2; };
struct Gemm { int lda, ldb, K, ksplit, arb, acb; };

__device__ __forceinline__ unsigned cvt_pk_bf16(float lo, float hi) { unsigned r; asm volatile("v_cvt_pk_bf16_f32 %0, %1, %2" : "=v"(r) : "v"(lo), "v"(hi)); return r; }
typedef float f32x2 __attribute__((ext_vector_type(2)));

template <class Epi, class Sched, bool ALIGN_EPI = false, bool SP2 = false, bool GATHER = false>
__device__ __forceinline__ void gemm_phase(PG8_LAS unsigned char* lds, const Gemm g, const Sched& S, const Epi& E) {
    static_assert(!GATHER || SP2, "GATHER is written for the SP2 loop");
    int tid_ = threadIdx.x; asm volatile("" : "+v"(tid_));
    const int tid = tid_, wid = __builtin_amdgcn_readfirstlane(tid >> 6), lane = tid & 63, wr = wid >> 2, wc = wid & 3, fr = lane & 15, fq = lane >> 4;
    const int K = g.K, nt = K / BK, ks = g.ksplit;
    unsigned voffA[2], voffB[2];
#pragma unroll
    for (int i = 0; i < 2; ++i) { int R, C; stage_rc(tid * 16 + i * 8192, R, C); const int Rb = Epi::PERM ? ((R & ~31) + perm32(R & 31)) : R;
        voffA[i] = g.arb ? (unsigned)(((R / g.arb) * (K / g.acb) + C / g.acb) * (g.arb * g.acb) + (R % g.arb) * g.acb + (C % g.acb)) * 2u : (unsigned)(R * g.lda + C) * 2u; voffB[i] = (unsigned)(Rb * g.ldb + C) * 2u; }
    const size_t kstep = (size_t)(BK * 2), kstepA = g.arb ? (size_t)(BK * g.arb * 2) : kstep;
    const size_t hsA = (size_t)HALF * (g.arb ? K : g.lda) * 2, hsB = (size_t)HALF * g.ldb * 2;
    const unsigned ldsw = (unsigned)wid * 1024u;
    const int aoff = lds_byte(wr * 64 + fr, fq * 8), boff = lds_byte(wc * 32 + fr, fq * 8);
#define PG8_SA(b, h) (((b) * 2 + (h)) * HTB)
#define PG8_SB(b, h) ((4 + (b) * 2 + (h)) * HTB)
#define PG8_STAGE(bufoff, gbase, voff) do { _Pragma("unroll") for (int _i = 0; _i < 2; ++_i) \
        __builtin_amdgcn_global_load_lds((const unsigned*)((const char*)(gbase) + (voff)[_i]), (PG8_LAS unsigned*)(lds + (bufoff) + ldsw + _i * 8192), 16, 0, 0); } while (0)
#define PG8_LDA(dst, b, h) do { _Pragma("unroll") for (int m = 0; m < 4; ++m) _Pragma("unroll") for (int k = 0; k < 2; ++k) dst[m][k] = *(const PG8_LAS bf16x8*)(lds + PG8_SA(b, h) + aoff + m * 2048 + k * 1024); } while (0)
#define PG8_LDB(dst, b, h) do { _Pragma("unroll") for (int n = 0; n < 2; ++n) _Pragma("unroll") for (int k = 0; k < 2; ++k) dst[n][k] = *(const PG8_LAS bf16x8*)(lds + PG8_SB(b, h) + boff + n * 2048 + k * 1024); } while (0)
#define PG8_MMA(ai, bj, At, Bt) do { __builtin_amdgcn_s_setprio(1); _Pragma("unroll") for (int m = 0; m < 4; ++m) _Pragma("unroll") for (int n = 0; n < 2; ++n) _Pragma("unroll") for (int k = 0; k < 2; ++k) \
        acc[ai][bj][m][n] = __builtin_amdgcn_mfma_f32_16x16x32_bf16(Bt[n][k], At[m][k], acc[ai][bj][m][n], 0, 0, 0); __builtin_amdgcn_s_setprio(0); } while (0)
#define PG8_WAIT_V(n) asm volatile("s_waitcnt vmcnt(" #n ")" ::: "memory")
#define PG8_WAIT_L(n) asm volatile("s_waitcnt lgkmcnt(" #n ")" ::: "memory")
#define PG8_BAR __builtin_amdgcn_s_barrier()
#define PG8_SCHED __builtin_amdgcn_sched_barrier(0)
    Unit cur, nxt; int ui = 0;
    if (!S.next(0, cur)) return;
    unsigned gC[2][2] = {{0u, 0u}, {0u, 0u}}, gN[2][2] = {{0u, 0u}, {0u, 0u}}; const char* gbase = nullptr;
#define PG8_GOFFS(U, Gv) do { int R_, C_; stage_rc(tid * 16, R_, C_); S.arows4(U, R_, (unsigned)C_ * 2u, Gv); } while (0)
#define PG8_STAGE_G(bufoff, kbyte, Gv, h) do { _Pragma("unroll") for (int _i = 0; _i < 2; ++_i) \
        __builtin_amdgcn_global_load_lds((const unsigned*)(gbase + (size_t)(kbyte) + Gv[h][_i]), (PG8_LAS unsigned*)(lds + (bufoff) + ldsw + _i * 8192), 16, 0, 0); } while (0)
    if constexpr (GATHER) { gbase = S.abase(); PG8_GOFFS(cur, gC); }
    f32x4 acc[2][2][4][2];
#pragma unroll
    for (int a = 0; a < 2; ++a)
#pragma unroll
        for (int b = 0; b < 2; ++b)
#pragma unroll
            for (int m = 0; m < 4; ++m)
#pragma unroll
                for (int n = 0; n < 2; ++n) acc[a][b][m][n] = (f32x4){0.f, 0.f, 0.f, 0.f};
    bf16x8 At[4][2], B0[2][2], B1[2][2];
    const char* cA = cur.a; const char* cB = cur.b; const char* cB2 = cur.b2;
#define PG8_BK(base, base2, kt) ((kt) < ks ? (base) + (size_t)(kt) * kstep : (base2) + (size_t)((kt) - ks) * kstep)
    S.a_ready(cur);
    if constexpr (SP2) {
        PG8_STAGE(PG8_SB(0, 0), cB, voffB); PG8_STAGE(PG8_SB(0, 1), cB + hsB, voffB);
        if constexpr (GATHER) { PG8_STAGE_G(PG8_SA(0, 0), 0, gC, 0); PG8_STAGE_G(PG8_SA(0, 1), 0, gC, 1); } else { PG8_STAGE(PG8_SA(0, 0), cA, voffA); PG8_STAGE(PG8_SA(0, 1), cA + hsA, voffA); }
        if (wr == 1) PG8_BAR;
        PG8_WAIT_V(2); PG8_BAR;
        PG8_STAGE(PG8_SB(1, 0), PG8_BK(cB, cB2, 1), voffB);
        if constexpr (GATHER) PG8_STAGE_G(PG8_SA(1, 0), kstep, gC, 0); else PG8_STAGE(PG8_SA(1, 0), cA + kstepA, voffA);
        PG8_STAGE(PG8_SB(1, 1), PG8_BK(cB, cB2, 1) + hsB, voffB);
        PG8_WAIT_V(6); PG8_BAR;
    } else {
        PG8_STAGE(PG8_SB(0, 0), cB, voffB); PG8_STAGE(PG8_SA(0, 0), cA, voffA); PG8_STAGE(PG8_SB(0, 1), cB + hsB, voffB); PG8_STAGE(PG8_SA(0, 1), cA + hsA, voffA);
        if (wr == 1) PG8_BAR;
        PG8_WAIT_V(4); PG8_BAR;
        PG8_STAGE(PG8_SB(1, 0), PG8_BK(cB, cB2, 1), voffB); PG8_STAGE(PG8_SA(1, 0), cA + kstepA, voffA); PG8_STAGE(PG8_SB(1, 1), PG8_BK(cB, cB2, 1) + hsB, voffB);
        PG8_WAIT_V(6); PG8_BAR;
    }
    for (;;) {
        const bool has_next = S.next(ui + 1, nxt);
        if constexpr (GATHER) { if (has_next) PG8_GOFFS(nxt, gN); else { _Pragma("unroll") for (int _h = 0; _h < 2; ++_h) _Pragma("unroll") for (int _i = 0; _i < 2; ++_i) gN[_h][_i] = gC[_h][_i]; } }
        const char* nA = has_next ? nxt.a : cA; const char* nB = has_next ? nxt.b : cB; const char* nB2 = has_next ? nxt.b2 : cB2;
#pragma unroll 1
        for (int t = 0; t < nt; t += 2) {
            const bool last = (t == nt - 2);
            const char* a1 = cA + (size_t)(t + 1) * kstepA;
            const char* a2 = last ? nA : cA + (size_t)(t + 2) * kstepA; const char* b2 = last ? PG8_BK(nB, nB2, 0) : PG8_BK(cB, cB2, t + 2);
            const char* a3 = a2 + kstepA; const char* b3 = last ? PG8_BK(nB, nB2, 1) : PG8_BK(cB, cB2, t + 3);
            if (last && has_next) S.a_ready(nxt);
            if constexpr (SP2) {
            PG8_LDB(B0, 0, 0); PG8_LDB(B1, 0, 1); PG8_SCHED; PG8_LDA(At, 0, 0);
            if constexpr (GATHER) PG8_STAGE_G(PG8_SA(1, 1), (size_t)(t + 1) * kstep, gC, 1); else PG8_STAGE(PG8_SA(1, 1), a1 + hsA, voffA);
            PG8_WAIT_V(8); PG8_WAIT_L(0); PG8_BAR; PG8_MMA(0, 0, At, B0); PG8_MMA(0, 1, At, B1); PG8_BAR; PG8_SCHED;
            PG8_LDA(At, 0, 1); PG8_STAGE(PG8_SB(0, 0), b2, voffB); PG8_STAGE(PG8_SB(0, 1), b2 + hsB, voffB);
            if constexpr (GATHER) { if (last) PG8_STAGE_G(PG8_SA(0, 0), 0, gN, 0); else PG8_STAGE_G(PG8_SA(0, 0), (size_t)(t + 2) * kstep, gC, 0); } else PG8_STAGE(PG8_SA(0, 0), a2, voffA);
            PG8_WAIT_V(8); PG8_WAIT_L(0); PG8_BAR; PG8_MMA(1, 0, At, B0); PG8_MMA(1, 1, At, B1); PG8_BAR; PG8_SCHED;
            PG8_LDB(B0, 1, 0); PG8_LDB(B1, 1, 1); PG8_SCHED; PG8_LDA(At, 1, 0);
            if constexpr (GATHER) { if (last) PG8_STAGE_G(PG8_SA(0, 1), 0, gN, 1); else PG8_STAGE_G(PG8_SA(0, 1), (size_t)(t + 2) * kstep, gC, 1); } else PG8_STAGE(PG8_SA(0, 1), a2 + hsA, voffA);
            PG8_WAIT_V(8); PG8_WAIT_L(0); PG8_BAR; PG8_MMA(0, 0, At, B0); PG8_MMA(0, 1, At, B1); PG8_BAR; PG8_SCHED;
            PG8_LDA(At, 1, 1); PG8_STAGE(PG8_SB(1, 0), b3, voffB); PG8_STAGE(PG8_SB(1, 1), b3 + hsB, voffB);
            if constexpr (GATHER) { if (last) PG8_STAGE_G(PG8_SA(1, 0), kstep, gN, 0); else PG8_STAGE_G(PG8_SA(1, 0), (size_t)(t + 3) * kstep, gC, 0); } else PG8_STAGE(PG8_SA(1, 0), a3, voffA);
            PG8_WAIT_V(8); PG8_WAIT_L(0); PG8_BAR; PG8_MMA(1, 0, At, B0); PG8_MMA(1, 1, At, B1); PG8_BAR; PG8_SCHED;
            } else {
            PG8_LDB(B0, 0, 0); PG8_SCHED; PG8_LDA(At, 0, 0); PG8_STAGE(PG8_SA(1, 1), a1 + hsA, voffA);
            PG8_WAIT_L(8); PG8_BAR; PG8_WAIT_L(0); PG8_MMA(0, 0, At, B0); PG8_BAR; PG8_SCHED;
            PG8_LDB(B1, 0, 1); PG8_STAGE(PG8_SB(0, 0), b2, voffB);
            PG8_BAR; PG8_WAIT_L(0); PG8_MMA(0, 1, At, B1); PG8_BAR;
            PG8_LDA(At, 0, 1); PG8_STAGE(PG8_SA(0, 0), a2, voffA);
            PG8_BAR; PG8_WAIT_L(0); PG8_MMA(1, 0, At, B0); PG8_BAR; PG8_SCHED;
            PG8_STAGE(PG8_SB(0, 1), b2 + hsB, voffB);
            PG8_WAIT_V(6); PG8_BAR; PG8_MMA(1, 1, At, B1); PG8_BAR;
            PG8_LDB(B0, 1, 0); PG8_SCHED; PG8_LDA(At, 1, 0); PG8_STAGE(PG8_SA(0, 1), a2 + hsA, voffA);
            PG8_WAIT_L(8); PG8_BAR; PG8_WAIT_L(0); PG8_MMA(0, 0, At, B0); PG8_BAR; PG8_SCHED;
            PG8_LDB(B1, 1, 1); PG8_STAGE(PG8_SB(1, 0), b3, voffB);
            PG8_BAR; PG8_WAIT_L(0); PG8_MMA(0, 1, At, B1); PG8_BAR;
            PG8_LDA(At, 1, 1); PG8_STAGE(PG8_SA(1, 0), a3, voffA);
            PG8_BAR; PG8_WAIT_L(0); PG8_MMA(1, 0, At, B0); PG8_BAR; PG8_SCHED;
            PG8_STAGE(PG8_SB(1, 1), b3 + hsB, voffB);
            PG8_WAIT_V(6); PG8_BAR; PG8_MMA(1, 1, At, B1); PG8_BAR;
            }
        }
        if constexpr (ALIGN_EPI) { if (wr == 0) PG8_BAR; }
        if constexpr (!Epi::AFTER_DRAIN) { E(acc, cur, wr, wc, fr, fq); S.done(cur); }
        if (!has_next) break;
#pragma unroll
        for (int a = 0; a < 2; ++a)
#pragma unroll
            for (int b = 0; b < 2; ++b)
#pragma unroll
                for (int m = 0; m < 4; ++m)
#pragma unroll
                    for (int n = 0; n < 2; ++n) acc[a][b][m][n] = (f32x4){0.f, 0.f, 0.f, 0.f};
        cur = nxt; cA = nA; cB = nB; cB2 = nB2; ++ui;
        if constexpr (GATHER) { _Pragma("unroll") for (int _h = 0; _h < 2; ++_h) _Pragma("unroll") for (int _i = 0; _i < 2; ++_i) gC[_h][_i] = gN[_h][_i]; }
        if constexpr (ALIGN_EPI) { if (wr == 1) PG8_BAR; }
    }
    PG8_WAIT_V(0);
    if constexpr (!ALIGN_EPI) { if (wr == 0) PG8_BAR; }
    PG8_BAR;
    if constexpr (Epi::AFTER_DRAIN) { E.fused(acc, cur, wr, wc, fr, fq, lds, wid, lane); S.done(cur); }
#undef PG8_BK
#undef PG8_GOFFS
#undef PG8_STAGE_G
#undef PG8_SA
#undef PG8_SB
#undef PG8_STAGE
#undef PG8_LDA
#undef PG8_LDB
#undef PG8_MMA
#undef PG8_WAIT_V
#undef PG8_WAIT_L
#undef PG8_BAR
#undef PG8_SCHED
}
}

struct PlainOrder {
    const char* A; const char* Bt; int lda, ldb, nM, nN, nwg, G, c;
    __device__ __forceinline__ void init(const void* A_, const void* Bt_, int lda_, int ldb_, int M, int N, int G_, int c_) { A = (const char*)A_; Bt = (const char*)Bt_; lda = lda_; ldb = ldb_; nM = M / 256; nN = N / 256; nwg = nM * nN; G = G_; c = c_; }
    __device__ __forceinline__ bool next(int i, pg8::Unit& u) const {
        const long L = (long)i * G + c; if (L >= nwg) return false;
        int wgid = (int)L; { const int q = nwg / 8, r = nwg % 8, xcd = wgid % 8, off = wgid / 8; wgid = (xcd < r ? xcd * (q + 1) : r * (q + 1) + (xcd - r) * q) + off; }
        const int nig = 8 * nN, gid = wgid / nig, fm = gid * 8, gsz = (nM - fm) < 8 ? (nM - fm) : 8;
        u.pm = fm + ((wgid % nig) % gsz); u.pn = (wgid % nig) / gsz;
        u.a = A + (size_t)u.pm * 256 * lda * 2; u.b = Bt + (size_t)u.pn * 256 * ldb * 2; u.b2 = u.b; return true;
    }
    __device__ __forceinline__ void a_ready(const pg8::Unit&) const {}
    __device__ __forceinline__ void done(const pg8::Unit&) const {}
};
struct EpiInProj {
    static constexpr bool PERM = true, AFTER_DRAIN = false;
    unsigned char* ws; const float* b_gate; const float* b_fgt; unsigned* kn;
    __device__ __forceinline__ void operator()(const pg8::f32x4 (&acc)[2][2][4][2], const pg8::Unit& u, int wr, int wc, int fr, int fq) const {
        { int t_ = threadIdx.x; asm volatile("" : "+v"(t_)); fr = t_ & 15; fq = (t_ >> 4) & 3; }
        const int pn = u.pn, b = (u.pm * 256) / T_, t0 = u.pm * 256 - b * T_ + wr * 64 + fr;
        if (pn == 11) {
            if (wc == 0 && fq < 4) {
                float* gate = (float*)(ws + WS_GATE); float* fl = (float*)(ws + WS_FL);
#pragma unroll
                for (int ai = 0; ai < 2; ++ai)
#pragma unroll
                    for (int m = 0; m < 4; ++m) { const int t = t0 + ai * 128 + m * 16; const size_t n = (size_t)b * T_ + t;
#pragma unroll
                        for (int nn = 0; nn < 2; ++nn)
#pragma unroll
                            for (int e = 0; e < 4; ++e) { const int c = 8 * fq + 4 * nn + e; const float v = acc[ai][0][m][nn][e];
                                if (c < 24) gate[n * 24 + c] = __builtin_amdgcn_rcpf(1.f + __builtin_amdgcn_exp2f(-(v + b_gate[c]) * LOG2E));
                                else if (c < 28) { const float z = v + b_fgt[c - 24];
                                    fl[(size_t)(b * 4 + (c - 24)) * T_ + t] = z < -30.f ? z : -0.6931471805599453f * __builtin_amdgcn_logf(1.f + __builtin_amdgcn_exp2f(-z * LOG2E)); } } }
            }
            return;
        }
        if (pn == 6 || pn == 9) {
            const int lane_ = (fq << 4) | fr;
#pragma unroll
            for (int bj = 0; bj < 2; ++bj)
#pragma unroll
                for (int ai = 0; ai < 2; ++ai) { float mx = 0.f;
#pragma unroll
                    for (int m = 0; m < 4; ++m) { const pg8::f32x4 v0 = acc[ai][bj][m][0], v1 = acc[ai][bj][m][1];
                        float ss = (v0[0] * v0[0] + v0[1] * v0[1]) + (v0[2] * v0[2] + v0[3] * v0[3]) + (v1[0] * v1[0] + v1[1] * v1[1]) + (v1[2] * v1[2] + v1[3] * v1[3]);
                        ss += shflx_f(ss, 16, lane_); ss += shflx_f(ss, 32, lane_); mx = fmaxf(mx, ss); }
#pragma unroll
                    for (int o = 1; o < 16; o <<= 1) mx = fmaxf(mx, shflx_f(mx, o, lane_));
                    if (lane_ == 0) { const int cg = bj * 4 + wc, tile = (u.pm * 256 - b * T_ + ai * 128 + wr * 64) >> 6;
                        unsigned* dst = pn == 6 ? kn + ((b * 4 + (cg >> 1)) * 64 + tile) * 2 + (cg & 1) : kn + 4096 + (b * 8 + cg) * 64 + tile;
                        atomicMax(dst, __float_as_uint(mx)); } }
        }
#pragma unroll
        for (int bj = 0; bj < 2; ++bj) {
            const int c = bj * 128 + wc * 32 + 8 * fq;
            bf16* base; int W = 64; float sc = 1.f;
            if (pn < 2) { base = (bf16*)(ws + WS_QN) + (size_t)(b * 8 + pn * 4 + (c >> 6)) * T_ * 64 + (c & 63); sc = 0.125f * LOG2E; }
            else if (pn < 5) { base = (bf16*)(ws + WS_KV6 + (size_t)((pn - 2) * 2 + (c >> 7)) * KV6_STRIDE) + (size_t)(b * 2 + ((c >> 6) & 1)) * T_ * 64 + (c & 63); }
            else if (pn < 8) { base = (bf16*)(ws + WS_FQKV) + (size_t)(pn - 5) * (8 * MiB) + (size_t)(b * 4 + (c >> 6)) * T_ * 64 + (c & 63); if (pn == 5) sc = 0.125f * LOG2E; }
            else if (pn < 10) { base = (bf16*)(ws + WS_DQK) + (size_t)(pn - 8) * (8 * MiB) + (size_t)(b * 8 + (c >> 5)) * T_ * 32 + (c & 31); W = 32; if (pn == 8) sc = 0.17677669529663687f * LOG2E; }
            else { base = (bf16*)(ws + WS_DV) + (size_t)(b * 4 + (c >> 6)) * T_ * 64 + (c & 63); }
            const bool blk = W == 64 && pn != 2;
            if (blk) base += -(c & 63) + ((c >> 5) & 1) * 512 + (c & 31);
#pragma unroll
            for (int ai = 0; ai < 2; ++ai)
#pragma unroll
                for (int m = 0; m < 4; ++m) { const int t = t0 + ai * 128 + m * 16;
                    const pg8::f32x4 v0 = acc[ai][bj][m][0] * sc, v1 = acc[ai][bj][m][1] * sc;
                    pg8::u32x4 w; w.x = pg8::cvt_pk_bf16(v0[0], v0[1]); w.y = pg8::cvt_pk_bf16(v0[2], v0[3]); w.z = pg8::cvt_pk_bf16(v1[0], v1[1]); w.w = pg8::cvt_pk_bf16(v1[2], v1[3]);
                    *(pg8::u32x4*)(base + (blk ? (size_t)((t >> 4) * 1024 + (t & 15) * 32) : (size_t)t * W)) = w; }
        }
    }
};
__device__ __forceinline__ u32x4 res_add8(u32x4 w, const pg8::f32x4& a0, const pg8::f32x4& a1) {
    u32x4 o;
    o.x = pg8::cvt_pk_bf16(__uint_as_float(w.x << 16) + a0[0], __uint_as_float(w.x & 0xffff0000u) + a0[1]); o.y = pg8::cvt_pk_bf16(__uint_as_float(w.y << 16) + a0[2], __uint_as_float(w.y & 0xffff0000u) + a0[3]);
    o.z = pg8::cvt_pk_bf16(__uint_as_float(w.z << 16) + a1[0], __uint_as_float(w.z & 0xffff0000u) + a1[1]); o.w = pg8::cvt_pk_bf16(__uint_as_float(w.w << 16) + a1[2], __uint_as_float(w.w & 0xffff0000u) + a1[3]);
    return o;
}
struct EpiResBf16 {
    static constexpr bool PERM = true, AFTER_DRAIN = false;
    bf16* xr;
    __device__ __forceinline__ void operator()(const pg8::f32x4 (&acc)[2][2][4][2], const pg8::Unit& u, int wr, int wc, int fr, int fq) const {
        { int t_ = threadIdx.x; asm volatile("" : "+v"(t_)); fr = t_ & 15; fq = (t_ >> 4) & 3; }
#pragma unroll
        for (int ai = 0; ai < 2; ++ai)
#pragma unroll
            for (int m = 0; m < 4; ++m) { const size_t off = (size_t)(u.pm * 256 + ai * 128 + wr * 64 + m * 16 + fr) * D_ + u.pn * 256 + wc * 32 + 8 * fq;
#pragma unroll
                for (int bj = 0; bj < 2; ++bj) { u32x4* q = (u32x4*)(xr + off + bj * 128); *q = res_add8(*q, acc[ai][bj][m][0], acc[ai][bj][m][1]); } }
    }
};


struct EpiDummy {
    static constexpr bool PERM = true, AFTER_DRAIN = false;
    float* dst;
    __device__ __forceinline__ void operator()(const pg8::f32x4 (&acc)[2][2][4][2], const pg8::Unit& u, int wr, int wc, int fr, int fq) const {
        pg8::f32x4 a = {0.f, 0.f, 0.f, 0.f};
#pragma unroll
        for (int ai = 0; ai < 2; ++ai)
#pragma unroll
            for (int bj = 0; bj < 2; ++bj)
#pragma unroll
                for (int m = 0; m < 4; ++m) { a = a + acc[ai][bj][m][0]; a = a + acc[ai][bj][m][1]; }
        *(pg8::f32x4*)(dst + ((size_t)(u.pm * 12 + u.pn) * 512 + threadIdx.x) * 4) = a;
    }
};
struct OneUnitOrder { pg8::Unit u; bool has;
    __device__ __forceinline__ bool next(int i, pg8::Unit& o) const { if (i != 0 || !has) return false; o = u; return true; }
    __device__ __forceinline__ void a_ready(const pg8::Unit&) const {}
    __device__ __forceinline__ void done(const pg8::Unit&) const {} };
__device__ __forceinline__ float gelu_tanh_fast(float x) { const float u2 = 1.5957691216057308f * (x + 0.044715f * x * x * x); return x * __builtin_amdgcn_rcpf(1.f + __builtin_amdgcn_exp2f(-u2 * LOG2E)); }
struct EpiCmpH {
    static constexpr bool PERM = true, AFTER_DRAIN = false;
    bf16* hc; const float* bias1;
    __device__ __forceinline__ void operator()(const pg8::f32x4 (&acc)[2][2][4][2], const pg8::Unit& u, int wr, int wc, int fr, int fq) const {
        { int t_ = threadIdx.x; asm volatile("" : "+v"(t_)); fr = t_ & 15; fq = (t_ >> 4) & 3; }
        const int kv = u.pn;
#pragma unroll
        for (int bj = 0; bj < 2; ++bj) { const int col = bj * 128 + wc * 32 + 8 * fq;
            const pg8::f32x4 b0 = *(const pg8::f32x4*)(bias1 + kv * 256 + col), b1 = *(const pg8::f32x4*)(bias1 + kv * 256 + col + 4);
#pragma unroll
            for (int ai = 0; ai < 2; ++ai)
#pragma unroll
                for (int m = 0; m < 4; ++m) { const int row = u.pm * 256 + ai * 128 + wr * 64 + m * 16 + fr;
                    const pg8::f32x4 v0 = acc[ai][bj][m][0] + b0, v1 = acc[ai][bj][m][1] + b1;
                    pg8::u32x4 w; w.x = pg8::cvt_pk_bf16(gelu_tanh_fast(v0[0]), gelu_tanh_fast(v0[1])); w.y = pg8::cvt_pk_bf16(gelu_tanh_fast(v0[2]), gelu_tanh_fast(v0[3]));
                    w.z = pg8::cvt_pk_bf16(gelu_tanh_fast(v1[0]), gelu_tanh_fast(v1[1])); w.w = pg8::cvt_pk_bf16(gelu_tanh_fast(v1[2]), gelu_tanh_fast(v1[3]));
                    *(pg8::u32x4*)(hc + ((size_t)kv * 4096 + row) * 256 + col) = w; } }
    }
};
struct EpiCmpOut {
    static constexpr bool PERM = true, AFTER_DRAIN = false;
    bf16* kvcmp;
    __device__ __forceinline__ void operator()(const pg8::f32x4 (&acc)[2][2][4][2], const pg8::Unit& u, int wr, int wc, int fr, int fq) const {
        { int t_ = threadIdx.x; asm volatile("" : "+v"(t_)); fr = t_ & 15; fq = (t_ >> 4) & 3; }
        if (wc >= 2) return;
        const int kv = u.pn, col = wc * 32 + 8 * fq;
#pragma unroll
        for (int ai = 0; ai < 2; ++ai)
#pragma unroll
            for (int m = 0; m < 4; ++m) { const int row = u.pm * 256 + ai * 128 + wr * 64 + m * 16 + fr; const float z = ((row & 255) == 255) ? 0.f : 1.f;
                const pg8::f32x4 v0 = acc[ai][0][m][0], v1 = acc[ai][0][m][1];
                pg8::u32x4 w; w.x = pg8::cvt_pk_bf16(z != 0.f ? v0[0] : 0.f, z != 0.f ? v0[1] : 0.f); w.y = pg8::cvt_pk_bf16(z != 0.f ? v0[2] : 0.f, z != 0.f ? v0[3] : 0.f);
                w.z = pg8::cvt_pk_bf16(z != 0.f ? v1[0] : 0.f, z != 0.f ? v1[1] : 0.f); w.w = pg8::cvt_pk_bf16(z != 0.f ? v1[2] : 0.f, z != 0.f ? v1[3] : 0.f);
                *(pg8::u32x4*)(kvcmp + ((size_t)kv * 4096 + row) * 64 + col) = w; }
    }
};

__device__ __forceinline__ void moe_build_tables(const unsigned* cnt, int tid) {
    LAS int* T = (LAS int*)((LAS unsigned char*)lds_raw + TBL_OFF);
    __syncthreads();
    if (tid < 112) T[384 + tid] = (int)cnt[tid * MOE_CS];
    else if (tid >= 128 && tid < 128 + NEXP) T[560 + tid - 128] = (int)cnt[(112 + tid - 128) * MOE_CS];
    __syncthreads();
    if (tid == 0) { int o = 0; _Pragma("clang loop unroll(disable)") for (int c = 0; c < 112; ++c) { T[c] = o; const int n = (T[384 + c] + 255) >> 8;
            _Pragma("clang loop vectorize(disable) unroll(disable)") for (int k = 0; k < n; ++k) T[128 + o + k] = c;
            o += n; } T[112] = o; }
    if (tid == 64) { int o = 0; _Pragma("clang loop unroll(disable)") for (int e = 0; e < NEXP; ++e) { T[512 + e] = o; const int n = (T[560 + e] + 255) >> 8;
            _Pragma("clang loop vectorize(disable) unroll(disable)") for (int k = 0; k < n; ++k) T[608 + o + k] = e;
            o += n; } T[544] = o; }
    __syncthreads();
}
__device__ __forceinline__ void moe_pair(int cls, int& ea, int& eb) { const int grp = cls / 28; int idx = cls % 28, lo = 0; while (idx >= 7 - lo) { idx -= 7 - lo; ++lo; } ea = grp * 8 + lo; eb = grp * 8 + lo + 1 + idx; }
struct MoeOrder1 {
    const char* wsb; const unsigned* rec; const char* wgu; unsigned* edone; int G, c;
    __device__ __forceinline__ bool next(int i, pg8::Unit& u) const {
        const LAS int* T = (const LAS int*)((LAS unsigned char*)lds_raw + TBL_OFF);
        const int idx = i * G + c; if (idx >= 2 * T[544]) return false;
        const int tile = idx >> 1, pn = idx & 1, e = T[608 + tile];
        u.pm = tile; u.pn = pn; u.a = wsb; u.b = wgu + ((size_t)e * 512 + pn * 256) * 2048; u.b2 = u.b; return true; }
    __device__ __forceinline__ const char* abase() const { return wsb; }
    __device__ __forceinline__ void arows4(const pg8::Unit& u, int r0, unsigned cb, unsigned (&g)[2][2]) const {
        const LAS int* T = (const LAS int*)((LAS unsigned char*)lds_raw + TBL_OFF);
        const int e = T[608 + u.pm], base = (u.pm - T[512 + e]) * 256 + r0, n = T[560 + e];
        const unsigned ob = (unsigned)(e * 32768 + base) * 16u;
#pragma unroll
        for (int k = 0; k < 4; ++k) { unsigned off = ZROW_OFF; if (base + 64 * k < n) off = (unsigned)WS_HN + *(const unsigned*)((const char*)rec + (ob + 1024u * k)) * 2048u; g[k >> 1][k & 1] = off + cb; } }
    __device__ __forceinline__ void a_ready(const pg8::Unit&) const {}
    __device__ __forceinline__ void done(const pg8::Unit& u) const {
        asm volatile("s_waitcnt vmcnt(0)" ::: "memory");
        const LAS int* T = (const LAS int*)((LAS unsigned char*)lds_raw + TBL_OFF);
        int t_ = threadIdx.x; asm volatile("" : "+v"(t_));
        if ((t_ & 63) == 0) (void)__hip_atomic_fetch_add(edone + T[608 + u.pm] * MOE_CS, 1u, __ATOMIC_RELAXED, __HIP_MEMORY_SCOPE_AGENT); } };
struct MoeOrder2 {
    const char* hb; const char* wd; const unsigned* edone; unsigned* tmo; int G, c;
    __device__ __forceinline__ bool next(int i, pg8::Unit& u) const {
        const LAS int* T = (const LAS int*)((LAS unsigned char*)lds_raw + TBL_OFF);
        const int n1 = (2 * T[544]) % G, idx = i * G + (c >= n1 ? c - n1 : c - n1 + G); if (idx >= 4 * T[112]) return false;
        const int tile = idx >> 2, pn = idx & 3; int ea, eb; moe_pair(T[128 + tile], ea, eb);
        u.pm = tile; u.pn = pn; u.a = hb + (size_t)tile * 256 * 1024; u.b = wd + ((size_t)ea * 1024 + pn * 256) * 512; u.b2 = wd + ((size_t)eb * 1024 + pn * 256) * 512; return true; }
    __device__ __forceinline__ void a_ready(const pg8::Unit& u) const {
        int t_ = threadIdx.x; asm volatile("" : "+v"(t_));
        if (t_ < 64) {
            const LAS int* T = (const LAS int*)((LAS unsigned char*)lds_raw + TBL_OFF);
            int ea, eb; moe_pair(T[128 + u.pm], ea, eb);
            const unsigned na = 16u * (unsigned)((T[560 + ea] + 255) >> 8), nb = 16u * (unsigned)((T[560 + eb] + 255) >> 8);
            unsigned polls = 0u;
            while ((unsigned)__builtin_amdgcn_readfirstlane(__hip_atomic_load(edone + ea * MOE_CS, __ATOMIC_RELAXED, __HIP_MEMORY_SCOPE_AGENT)) < na ||
                   (unsigned)__builtin_amdgcn_readfirstlane(__hip_atomic_load(edone + eb * MOE_CS, __ATOMIC_RELAXED, __HIP_MEMORY_SCOPE_AGENT)) < nb) {
                if ((++polls & 255u) == 0u) { if (__builtin_amdgcn_readfirstlane(__hip_atomic_load(tmo, __ATOMIC_RELAXED, __HIP_MEMORY_SCOPE_AGENT)) != 0u) break;
                    if (polls > (1u << 22)) { if (t_ == 0) __hip_atomic_store(tmo, 1u, __ATOMIC_RELAXED, __HIP_MEMORY_SCOPE_AGENT); break; } }
                __builtin_amdgcn_s_sleep(2); }
            __builtin_amdgcn_fence(__ATOMIC_ACQUIRE, "agent");
            asm volatile("s_waitcnt vmcnt(0)" ::: "memory");
        }
        asm volatile("" ::: "memory"); __builtin_amdgcn_s_barrier(); asm volatile("" ::: "memory");
    }
    __device__ __forceinline__ void done(const pg8::Unit&) const {} };
struct EpiMoeH {
    static constexpr bool PERM = true, AFTER_DRAIN = false;
    bf16* hb; const u32x4* rec;
    __device__ __forceinline__ void operator()(const pg8::f32x4 (&acc)[2][2][4][2], const pg8::Unit& u, int wr, int wc, int fr, int fq) const {
        { int t_ = threadIdx.x; asm volatile("" : "+v"(t_)); fr = t_ & 15; fq = (t_ >> 4) & 3; }
        const LAS int* T = (const LAS int*)((LAS unsigned char*)lds_raw + TBL_OFF);
        const int ex = T[608 + u.pm], vr0 = (u.pm - T[512 + ex]) * 256, nex = T[560 + ex];
#pragma unroll
        for (int ai = 0; ai < 2; ++ai) {
#pragma unroll
            for (int m = 0; m < 4; ++m) { const int rr = ai * 128 + wr * 64 + m * 16 + fr; const bool valid = vr0 + rr < nex;
                const u32x4 q = *(const u32x4*)((const char*)rec + (unsigned)(ex * 32768 + vr0 + rr) * 16u); const float w = __uint_as_float(q.y), rs = __uint_as_float(q.z);
                const int slot = (int)((q.w >> 15) & 1u); const unsigned row = (unsigned)T[valid ? (q.w >> 16) : 0u] * 256u + (q.w & 0x7fffu);
#pragma unroll
                for (int bj = 0; bj < 2; ++bj) { const int j0 = (u.pn & 1) * 128 + (bj * 128 + wc * 32 + 8 * fq) / 2;
                    pg8::f32x4 v0 = acc[ai][bj][m][0], v1 = acc[ai][bj][m][1];
#pragma unroll
                    for (int e = 0; e < 4; ++e) { v0[e] *= rs; v1[e] *= rs; }
                    const float h0 = v0[0] * __builtin_amdgcn_rcpf(1.f + __builtin_amdgcn_exp2f(-v0[0] * LOG2E)) * v0[1] * w, h1 = v0[2] * __builtin_amdgcn_rcpf(1.f + __builtin_amdgcn_exp2f(-v0[2] * LOG2E)) * v0[3] * w;
                    const float h2 = v1[0] * __builtin_amdgcn_rcpf(1.f + __builtin_amdgcn_exp2f(-v1[0] * LOG2E)) * v1[1] * w, h3 = v1[2] * __builtin_amdgcn_rcpf(1.f + __builtin_amdgcn_exp2f(-v1[2] * LOG2E)) * v1[3] * w;
                    const int jg = slot * 256 + j0;
                    if (valid) __hip_atomic_store((u64*)((char*)hb + (((row >> 4) * 32u + (unsigned)(jg >> 4)) * 256u + (row & 15u) * 16u + (unsigned)(jg & 15)) * 2u), (u64)pg8::cvt_pk_bf16(h0, h1) | ((u64)pg8::cvt_pk_bf16(h2, h3) << 32),
                                                  __ATOMIC_RELAXED, __HIP_MEMORY_SCOPE_AGENT); }
            }
            asm volatile("" ::: "memory"); }
    }
};
struct EpiMoeOut {
    static constexpr bool PERM = true, AFTER_DRAIN = false;
    bf16* x; const unsigned* rec;
    __device__ __forceinline__ void operator()(const pg8::f32x4 (&acc)[2][2][4][2], const pg8::Unit& u, int wr, int wc, int fr, int fq) const {
        { int t_ = threadIdx.x; asm volatile("" : "+v"(t_)); fr = t_ & 15; fq = (t_ >> 4) & 3; }
        bf16* xx = x; const unsigned* rt = rec; asm volatile("" : "+s"(xx), "+s"(rt));
        const LAS int* T = (const LAS int*)((LAS unsigned char*)lds_raw + TBL_OFF);
        const int cls = T[128 + u.pm], vr0 = (u.pm - T[cls]) * 256, ncls = T[384 + cls];
#pragma unroll
        for (int ai = 0; ai < 2; ++ai)
#pragma unroll
            for (int m = 0; m < 4; ++m) { const int rr = ai * 128 + wr * 64 + m * 16 + fr; int tok = -1; if (vr0 + rr < ncls) tok = (int)rt[(size_t)cls * 32768 + vr0 + rr];
                if (tok >= 0) { bf16* xr = xx + (size_t)tok * D_ + u.pn * 256 + wc * 32 + 8 * fq;
#pragma unroll
                    for (int bj = 0; bj < 2; ++bj) { u32x4* q = (u32x4*)(xr + bj * 128); *q = res_add8(*q, acc[ai][bj][m][0], acc[ai][bj][m][1]); } } }
    }
};

__device__ __forceinline__ void transpose_item(const float* W, int ldw, bf16* WT, int ldt, int r0, int rmul, int k0, LAS float* scr, int lane, const float* gk = nullptr) {
    f32x4 v[8];
#pragma unroll
    for (int i = 0; i < 8; ++i) v[i] = *(const f32x4*)(W + (size_t)(k0 + i * 8 + (lane >> 3)) * ldw + (lane & 7) * 4);
    if (gk) {
#pragma unroll
        for (int i = 0; i < 8; ++i) { const float gsc = gk[k0 + i * 8 + (lane >> 3)]; v[i].x *= gsc; v[i].y *= gsc; v[i].z *= gsc; v[i].w *= gsc; } }
#pragma unroll
    for (int i = 0; i < 8; ++i) { LAS float* d = scr + (i * 8 + (lane >> 3)) * 33 + (lane & 7) * 4; d[0] = v[i].x; d[1] = v[i].y; d[2] = v[i].z; d[3] = v[i].w; }
    asm volatile("s_waitcnt lgkmcnt(0)" ::: "memory");
    const int c = lane & 7;
#pragma unroll
    for (int j = 0; j < 4; ++j) { const int n = (lane >> 3) + 8 * j; const LAS float* sp = scr + (8 * c) * 33 + n;
        u32x4 o; o.x = pk2(sp[0 * 33], sp[1 * 33]); o.y = pk2(sp[2 * 33], sp[3 * 33]); o.z = pk2(sp[4 * 33], sp[5 * 33]); o.w = pk2(sp[6 * 33], sp[7 * 33]);
        *(u32x4*)(WT + (size_t)(r0 + rmul * n) * ldt + k0 + 8 * c) = o; }
    asm volatile("s_waitcnt lgkmcnt(0)" ::: "memory");
}
__device__ __forceinline__ void transpose_seg(const float* W, int ldw, int K, int sc0, int ncol, bf16* WT, int r0, int rmul, int item, LAS float* scr, int lane, const float* gk = nullptr) {
    const int nb = ncol / 32, kb = item / nb, cb = item % nb;
    transpose_item(W + sc0 + cb * 32, ldw, WT, K, r0 + rmul * cb * 32, rmul, kb * 64, scr, lane, gk);
}

typedef float f32x16 __attribute__((ext_vector_type(16)));
typedef short bf16x8v __attribute__((ext_vector_type(8)));
typedef short s16x4 __attribute__((ext_vector_type(4)));
typedef float f32x2_t __attribute__((ext_vector_type(2)));
typedef __bf16 bf16x2_t __attribute__((ext_vector_type(2)));
constexpr int A_KBUF = 10240, A_VBUF = 12288;
constexpr int A_KOFF = 0, A_VOFF = 2 * A_KBUF, A_BOFF = A_VOFF + 2 * A_VBUF, A_BTILE = 8 * 256, A_LDS_END = A_BOFF + 2 * A_BTILE;
__device__ __forceinline__ constexpr int crow0(int reg) { return (reg & 3) + 8 * (reg >> 2); }
__device__ __forceinline__ float swap_max(float m) { auto rr = __builtin_amdgcn_permlane32_swap(__float_as_uint(m), __float_as_uint(m), false, false); return fmaxf(__uint_as_float(rr[0]), __uint_as_float(rr[1])); }
__device__ __forceinline__ float swap_sum(float m) { auto rr = __builtin_amdgcn_permlane32_swap(__float_as_uint(m), __float_as_uint(m), false, false); return __uint_as_float(rr[0]) + __uint_as_float(rr[1]); }
__device__ __forceinline__ unsigned cvtpk(float lo, float hi) { f32x2_t v = {lo, hi}; bf16x2_t b = __builtin_convertvector(v, bf16x2_t); return __builtin_bit_cast(unsigned, b); }
__device__ __forceinline__ bf16x8v pack8(const f32x16& p, int b0) { u32x4 w; w.x = cvtpk(p[b0 + 0], p[b0 + 1]); w.y = cvtpk(p[b0 + 2], p[b0 + 3]); w.z = cvtpk(p[b0 + 4], p[b0 + 5]); w.w = cvtpk(p[b0 + 6], p[b0 + 7]); return __builtin_bit_cast(bf16x8v, w); }
__device__ __forceinline__ s16x4 tr_read(const LAS unsigned char* p) { typedef short v4i16_t __attribute__((ext_vector_type(4))); return __builtin_bit_cast(s16x4, __builtin_amdgcn_ds_read_tr16_b64_v4i16((LAS v4i16_t*)p)); }

template <int DQK>
__device__ __forceinline__ void attn_preload(const bf16* Kb0, const bf16* Kb1, const bf16* Vb, int j, int tid, u32x4& kreg, u32x4& vreg) {
    const bf16* ksrc;
    if (DQK == 64) ksrc = Kb0 + b64_off(tid >> 3, (tid & 7) * 8); else { const int mp = tid >> 8, tt = tid & 255; ksrc = (mp ? Kb1 : Kb0) + (tt >> 2) * 32 + (tt & 3) * 8; }
    const bf16* vsrc = Vb + b64_off(tid >> 3, (tid & 7) * 8);
    kreg = *(const u32x4*)(ksrc + (size_t)(j * 64) * DQK); vreg = *(const u32x4*)(vsrc + (size_t)(j * 64) * 64);
}
template <int DQK, int NMAP, bool FOX, bool SLC, bool PRE = false, bool NOMAX = false>
__device__ __forceinline__ void attn_core(LAS unsigned char* L, const bf16* Kb0, const bf16* Kb1, const bf16* Vb, const LAS float* cum, float cum_ref,
                                          const bf16x8v (&Qf)[NMAP][DQK / 16], u64 tilemask, int t_lane, int tw0, int win, float slope2, unsigned selw0, unsigned selw1,
                                          f32x16 (&O)[NMAP][2], float (&M)[NMAP], float (&Ls)[NMAP], int tid, bool started0 = false, int jpre = 0, u32x4 kpre = (u32x4){0u, 0u, 0u, 0u}, u32x4 vpre = (u32x4){0u, 0u, 0u, 0u}) {
    constexpr int KP = DQK * 2 + 16, VP = 192;
    const int lane = tid & 63, r = lane & 31, h = lane >> 5;
    int kdst; const bf16* ksrc;
    if (DQK == 64) { kdst = (tid >> 3) * KP + (tid & 7) * 16; ksrc = Kb0 + b64_off(tid >> 3, (tid & 7) * 8); }
    else { const int mp = tid >> 8, tt = tid & 255; kdst = mp * 5120 + (tt >> 2) * KP + (tt & 3) * 16; ksrc = (mp ? Kb1 : Kb0) + (tt >> 2) * 32 + (tt & 3) * 8; }
    const int vdst = (tid >> 3) * VP + (tid & 7) * 16; const bf16* vsrc = Vb + b64_off(tid >> 3, (tid & 7) * 8);
    const LAS unsigned char* kfrag = L + A_KOFF + r * KP + h * 16;
    const LAS unsigned char* vfrag = L + A_VOFF + (4 * h + ((lane & 15) >> 2)) * VP + (16 * ((lane >> 4) & 1) + 4 * (lane & 3)) * 2;
    u32x4 kreg, vreg; float breg = 0.f;
    u64 mk = tilemask;
    int j = PRE ? jpre : 63 - __builtin_clzll(mk); mk &= ~(1ull << j);
    { const int kv0 = j * 64; if (PRE) { kreg = kpre; vreg = vpre; } else { kreg = *(const u32x4*)(ksrc + (size_t)kv0 * DQK); vreg = *(const u32x4*)(vsrc + (size_t)kv0 * 64); } if (FOX) breg = (cum_ref - cum[kv0 + lane]) * LOG2E; }
    *(LAS u32x4*)(L + A_KOFF + kdst) = kreg; *(LAS u32x4*)(L + A_VOFF + vdst) = vreg; if (FOX) *(LAS float*)(L + A_BOFF + tid * 4) = breg;
    __syncthreads();
    int buf = 0; bool started = started0;
    float pdummy = 0.f; int idummy = 0; f32x16 dm0; for (int i = 0; i < 16; ++i) dm0[i] = 0.f;
    for (;;) {
        const bool more = mk != 0ull; int jn = 0;
        if (more) { jn = 63 - __builtin_clzll(mk); mk &= ~(1ull << jn); const int kv0 = jn * 64;
            kreg = *(const u32x4*)(ksrc + (size_t)kv0 * DQK); vreg = *(const u32x4*)(vsrc + (size_t)kv0 * 64); if (FOX) breg = (cum_ref - cum[kv0 + lane]) * LOG2E; }
        { const int kv0 = j * 64;
          bool wave_has = true; float selb = 0.f;
          if (SLC) { const bool mine = ((j < 32 ? (selw0 >> j) : (selw1 >> (j - 32))) & 1u) != 0u; selb = mine ? 0.f : -INFINITY; wave_has = __any(mine); }
          if (wave_has && !(kv0 > tw0 + 31) && !(tw0 - (kv0 + 63) >= win)) {
            const bool need_mask = (kv0 + 63 > tw0) || (tw0 + 31 - kv0 >= win);
            const int dl = t_lane - kv0 - 4 * h;
            bf16x8v pa[NMAP][4];
#pragma unroll
            for (int mp = 0; mp < NMAP; ++mp) {
                f32x16 p0, p1;
                if (FOX) { const LAS f32x4* bl = (const LAS f32x4*)(L + A_BOFF + buf * A_BTILE + (tid >> 6) * 256) + h; const float mm = NOMAX ? 0.f : M[mp];
#pragma unroll
                    for (int g4 = 0; g4 < 4; ++g4) { const f32x4 b0 = bl[2 * g4], b1 = bl[8 + 2 * g4];
                        p0[4 * g4 + 0] = b0.x - mm; p0[4 * g4 + 1] = b0.y - mm; p0[4 * g4 + 2] = b0.z - mm; p0[4 * g4 + 3] = b0.w - mm; p1[4 * g4 + 0] = b1.x - mm; p1[4 * g4 + 1] = b1.y - mm; p1[4 * g4 + 2] = b1.z - mm; p1[4 * g4 + 3] = b1.w - mm; } }
                else { const float base_l = (slope2 * (float)(kv0 + 4 * h - tw0) - (NOMAX ? 0.f : M[mp])) + selb, s8 = slope2 * 8.f, s32 = slope2 * 32.f;
                    p0[0] = base_l; p0[1] = p0[0] + slope2; p0[2] = p0[1] + slope2; p0[3] = p0[2] + slope2;
#pragma unroll
                    for (int reg = 4; reg < 16; ++reg) p0[reg] = p0[reg - 4] + s8;
#pragma unroll
                    for (int reg = 0; reg < 16; ++reg) p1[reg] = p0[reg] + s32; }
                const LAS unsigned char* kb = kfrag + buf * A_KBUF + (DQK == 32 ? mp * 5120 : 0);
#pragma unroll
                for (int s = 0; s < DQK / 16; ++s) { const bf16x8v kf0 = *(const LAS bf16x8v*)(kb + s * 32), kf1 = *(const LAS bf16x8v*)(kb + 32 * KP + s * 32);
#ifdef PROBE_X_LDSK
                    { const bf16x8v z0 = *(const volatile LAS bf16x8v*)(kb + s * 32), z1 = *(const volatile LAS bf16x8v*)(kb + 32 * KP + s * 32); idummy ^= z0[0] ^ z1[1]; }
#endif
#ifdef PROBE_X_MFMA
                    dm0 = __builtin_amdgcn_mfma_f32_32x32x16_bf16(kf0, Qf[mp][s], dm0, 0, 0, 0); dm0 = __builtin_amdgcn_mfma_f32_32x32x16_bf16(kf1, Qf[mp][s], dm0, 0, 0, 0);
#endif
                    p0 = __builtin_amdgcn_mfma_f32_32x32x16_bf16(kf0, Qf[mp][s], p0, 0, 0, 0); p1 = __builtin_amdgcn_mfma_f32_32x32x16_bf16(kf1, Qf[mp][s], p1, 0, 0, 0); }
                if (need_mask) {
#pragma unroll
                    for (int reg = 0; reg < 16; ++reg) { const int d0 = dl - crow0(reg), d1 = d0 - 32;
                        p0[reg] = (d0 >= 0 && d0 < win) ? p0[reg] : -INFINITY; p1[reg] = (d1 >= 0 && d1 < win) ? p1[reg] : -INFINITY; } }
                if (!NOMAX) {
                float mt = fmaxf(fmaxf(p0[0], p1[0]), fmaxf(p0[1], p1[1]));
#pragma unroll
                for (int reg = 2; reg < 16; reg += 2) mt = fmaxf(fmaxf(mt, fmaxf(fmaxf(p0[reg], p1[reg]), p0[reg + 1])), p1[reg + 1]);
                mt = swap_max(mt);
                if (!started || __any(mt > 8.f)) {
                    const float d = (mt > -1e30f) ? (started ? fmaxf(mt, 0.f) : mt) : 0.f, alpha = __builtin_amdgcn_exp2f(-d);
                    O[mp][0] *= alpha; O[mp][1] *= alpha; Ls[mp] *= alpha; M[mp] += d;
#pragma unroll
                    for (int reg = 0; reg < 16; ++reg) { p0[reg] -= d; p1[reg] -= d; } } }
                float rs = 0.f;
#ifdef PROBE_X_EXP
#pragma unroll
                for (int reg = 0; reg < 16; ++reg) { pdummy += __builtin_amdgcn_exp2f(p0[reg] - 1.f) + __builtin_amdgcn_exp2f(p1[reg] - 1.f); }
#endif
#pragma unroll
                for (int reg = 0; reg < 16; ++reg) { p0[reg] = __builtin_amdgcn_exp2f(p0[reg]); p1[reg] = __builtin_amdgcn_exp2f(p1[reg]); rs += p0[reg] + p1[reg]; }
                Ls[mp] += rs;
                pa[mp][0] = pack8(p0, 0); pa[mp][1] = pack8(p0, 8); pa[mp][2] = pack8(p1, 0); pa[mp][3] = pack8(p1, 8);
            }
            started = true;
            const LAS unsigned char* vb = vfrag + buf * A_VBUF;
#pragma unroll
            for (int db = 0; db < 2; ++db)
#pragma unroll
                for (int ks = 0; ks < 4; ++ks) { const s16x4 lo = tr_read(vb + ks * (16 * VP) + db * 64), hi = tr_read(vb + ks * (16 * VP) + db * 64 + 8 * VP);
                    const bf16x8v vf = {lo[0], lo[1], lo[2], lo[3], hi[0], hi[1], hi[2], hi[3]};
#pragma unroll
                    for (int mp = 0; mp < NMAP; ++mp) O[mp][db] = __builtin_amdgcn_mfma_f32_32x32x16_bf16(vf, pa[mp][ks], O[mp][db], 0, 0, 0); }
          } }
        if (more) { *(LAS u32x4*)(L + A_KOFF + (buf ^ 1) * A_KBUF + kdst) = kreg; *(LAS u32x4*)(L + A_VOFF + (buf ^ 1) * A_VBUF + vdst) = vreg; if (FOX) *(LAS float*)(L + A_BOFF + (buf ^ 1) * A_BTILE + tid * 4) = breg; }
#ifdef PROBE_X_BAR
        __syncthreads();
#endif
        __syncthreads();
        if (!more) break;
        j = jn; buf ^= 1;
    }
    if (pdummy == 123.456f || idummy == 0x7fffabcd || dm0[3] == 98765.4321f) Ls[0] += 1e-30f;
}
#ifndef AC2_MODE
#define AC2_MODE 0
#endif
#ifndef AC2_INIT_VALU
#define AC2_INIT_VALU 24
#endif
template <bool FOX, bool SLC>
__device__ __forceinline__ void attn_core2(LAS unsigned char* L, const bf16* Kb0, const bf16* Vb, const LAS float* cum, float cum_ref,
                                           const bf16x8v (&Qf)[4], u64 tilemask, int t_lane, int tw0, int win, float slope2, unsigned selw0, unsigned selw1,
                                           f32x16 (&O)[2], float& M, float& Ls, int tid) {
    constexpr int KP = 144, VP = 192;
    const int lane = tid & 63, r = lane & 31, h = lane >> 5;
    const int kdst = (tid >> 3) * KP + (tid & 7) * 16; const bf16* ksrc = Kb0 + b64_off(tid >> 3, (tid & 7) * 8);
    const int vdst = (tid >> 3) * VP + (tid & 7) * 16; const bf16* vsrc = Vb + b64_off(tid >> 3, (tid & 7) * 8);
    const LAS unsigned char* kfrag = L + A_KOFF + r * KP + h * 16;
    const LAS unsigned char* vfrag = L + A_VOFF + (4 * h + ((lane & 15) >> 2)) * VP + (16 * ((lane >> 4) & 1) + 4 * (lane & 3)) * 2;
#define AC2_ACTIVE(jj) (!((jj) * 64 > tw0 + 31) && !(tw0 - ((jj) * 64 + 63) >= win))
#define AC2_INIT(jj, kslot, q0, q1) do { const int kv0_ = (jj) * 64; \
        if (FOX) { const LAS f32x4* bl = (const LAS f32x4*)(L + A_BOFF + (kslot) * 256) + h; const float mm = M; \
            _Pragma("unroll") for (int g4 = 0; g4 < 4; ++g4) { const f32x4 b0 = bl[2 * g4], b1 = bl[8 + 2 * g4]; \
                q0[4 * g4 + 0] = b0.x - mm; q0[4 * g4 + 1] = b0.y - mm; q0[4 * g4 + 2] = b0.z - mm; q0[4 * g4 + 3] = b0.w - mm; q1[4 * g4 + 0] = b1.x - mm; q1[4 * g4 + 1] = b1.y - mm; q1[4 * g4 + 2] = b1.z - mm; q1[4 * g4 + 3] = b1.w - mm; } } \
        else { float selb = 0.f; if (SLC) selb = ((((jj) < 32) ? (selw0 >> (jj)) : (selw1 >> ((jj) - 32))) & 1u) ? 0.f : -INFINITY; \
            const float base_l = (slope2 * (float)(kv0_ + 4 * h - tw0) - M) + selb, s8 = slope2 * 8.f, s32 = slope2 * 32.f; \
            q0[0] = base_l; q0[1] = q0[0] + slope2; q0[2] = q0[1] + slope2; q0[3] = q0[2] + slope2; \
            _Pragma("unroll") for (int reg = 4; reg < 16; ++reg) q0[reg] = q0[reg - 4] + s8; \
            _Pragma("unroll") for (int reg = 0; reg < 16; ++reg) q1[reg] = q0[reg] + s32; } } while (0)
#define AC2_QK(jj, kslot) do { AC2_INIT(jj, kslot, p0, p1); \
        const LAS unsigned char* kb_ = kfrag + (kslot) * A_KBUF; \
        _Pragma("unroll") for (int s_ = 0; s_ < 4; ++s_) { const bf16x8v kf0 = *(const LAS bf16x8v*)(kb_ + s_ * 32), kf1 = *(const LAS bf16x8v*)(kb_ + 32 * KP + s_ * 32); \
            p0 = __builtin_amdgcn_mfma_f32_32x32x16_bf16(kf0, Qf[s_], p0, 0, 0, 0); p1 = __builtin_amdgcn_mfma_f32_32x32x16_bf16(kf1, Qf[s_], p1, 0, 0, 0); } } while (0)
    u32x4 kreg, vreg; float breg = 0.f;
    u64 mk = tilemask;
    int j = 63 - __builtin_clzll(mk); mk &= ~(1ull << j);
    int jn = -1; if (mk) { jn = 63 - __builtin_clzll(mk); mk &= ~(1ull << jn); }
    { kreg = *(const u32x4*)(ksrc + (size_t)j * 64 * 64); vreg = *(const u32x4*)(vsrc + (size_t)j * 64 * 64); if (FOX && tid < 64) breg = (cum_ref - cum[j * 64 + tid]) * LOG2E;
      *(LAS u32x4*)(L + A_KOFF + kdst) = kreg; *(LAS u32x4*)(L + A_VOFF + vdst) = vreg; if (FOX && tid < 64) *(LAS float*)(L + A_BOFF + tid * 4) = breg;
      if (jn >= 0) { kreg = *(const u32x4*)(ksrc + (size_t)jn * 64 * 64); if (FOX && tid < 64) breg = (cum_ref - cum[jn * 64 + tid]) * LOG2E;
          *(LAS u32x4*)(L + A_KOFF + A_KBUF + kdst) = kreg; if (FOX && tid < 64) *(LAS float*)(L + A_BOFF + 256 + tid * 4) = breg; } }
    __syncthreads();
    f32x16 p0, p1;
    bool started = false;
    int ks = 0, vs = 0;
    if (AC2_ACTIVE(j)) AC2_QK(j, 0);
    for (;;) {
        int jnn = -1; if (mk) { jnn = 63 - __builtin_clzll(mk); mk &= ~(1ull << jnn); }
        if (jnn >= 0) { kreg = *(const u32x4*)(ksrc + (size_t)jnn * 64 * 64); if (FOX && tid < 64) breg = (cum_ref - cum[jnn * 64 + tid]) * LOG2E; }
        if (jn >= 0) vreg = *(const u32x4*)(vsrc + (size_t)jn * 64 * 64);
        const bool act = AC2_ACTIVE(j), actn = jn >= 0 && AC2_ACTIVE(jn);
        if (act) {
            const int kv0 = j * 64;
            if ((kv0 + 63 > tw0) || (tw0 + 31 - kv0 >= win)) { const int dl = t_lane - kv0 - 4 * h;
#pragma unroll
                for (int reg = 0; reg < 16; ++reg) { const int d0 = dl - crow0(reg), d1 = d0 - 32;
                    p0[reg] = (d0 >= 0 && d0 < win) ? p0[reg] : -INFINITY; p1[reg] = (d1 >= 0 && d1 < win) ? p1[reg] : -INFINITY; } }
            float mt = fmaxf(fmaxf(p0[0], p1[0]), fmaxf(p0[1], p1[1]));
#pragma unroll
            for (int reg = 2; reg < 16; reg += 2) mt = fmaxf(fmaxf(mt, fmaxf(fmaxf(p0[reg], p1[reg]), p0[reg + 1])), p1[reg + 1]);
            mt = swap_max(mt);
            if (!started || __any(mt > 8.f)) {
                const float d = (mt > -1e30f) ? (started ? fmaxf(mt, 0.f) : mt) : 0.f, alpha = __builtin_amdgcn_exp2f(-d);
                O[0] *= alpha; O[1] *= alpha; Ls *= alpha; M += d;
#pragma unroll
                for (int reg = 0; reg < 16; ++reg) { p0[reg] -= d; p1[reg] -= d; } }
            started = true;
#if AC2_MODE == 1
            {
                const int jq = jn >= 0 ? jn : 0;
                float rs = 0.f;
#pragma unroll
                for (int reg = 0; reg < 16; ++reg) { p0[reg] = __builtin_amdgcn_exp2f(p0[reg]); p1[reg] = __builtin_amdgcn_exp2f(p1[reg]); rs += p0[reg] + p1[reg]; }
                Ls += rs;
                const bf16x8v pa0 = pack8(p0, 0), pa1 = pack8(p0, 8), pa2 = pack8(p1, 0), pa3 = pack8(p1, 8);
                AC2_QK(jq, ks ^ 1);
                const LAS unsigned char* vb = vfrag + vs * A_VBUF;
#pragma unroll
                for (int db = 0; db < 2; ++db)
#pragma unroll
                    for (int kq = 0; kq < 4; ++kq) { const s16x4 lo = tr_read(vb + kq * (16 * VP) + db * 64), hi = tr_read(vb + kq * (16 * VP) + db * 64 + 8 * VP);
                        const bf16x8v vf = {lo[0], lo[1], lo[2], lo[3], hi[0], hi[1], hi[2], hi[3]};
                        O[db] = __builtin_amdgcn_mfma_f32_32x32x16_bf16(vf, kq == 0 ? pa0 : kq == 1 ? pa1 : kq == 2 ? pa2 : pa3, O[db], 0, 0, 0); }
            }
#else
            {
                const int jq = jn >= 0 ? jn : 0;
                f32x16 n0, n1;
                AC2_INIT(jq, ks ^ 1, n0, n1);
                const LAS unsigned char* kb_ = kfrag + (ks ^ 1) * A_KBUF;
                bf16x8v kf[8];
#pragma unroll
                for (int s_ = 0; s_ < 4; ++s_) { kf[2 * s_] = *(const LAS bf16x8v*)(kb_ + s_ * 32); kf[2 * s_ + 1] = *(const LAS bf16x8v*)(kb_ + 32 * KP + s_ * 32); }
                const LAS unsigned char* vb = vfrag + vs * A_VBUF;
                __builtin_amdgcn_sched_barrier(0);
                float ra = 0.f, rb = 0.f; unsigned w[16];
#define AC2_PINF(x) asm volatile("" : "+v"(x))
#define AC2_QGAP(i) do { if ((i) & 1) n1 = __builtin_amdgcn_mfma_f32_32x32x16_bf16(kf[i], Qf[(i) >> 1], n1, 0, 0, 0); else n0 = __builtin_amdgcn_mfma_f32_32x32x16_bf16(kf[i], Qf[(i) >> 1], n0, 0, 0, 0); \
                    float e0 = __builtin_amdgcn_exp2f(p0[2 * (i)]), e1 = __builtin_amdgcn_exp2f(p0[2 * (i) + 1]), e2 = __builtin_amdgcn_exp2f(p1[2 * (i)]), e3 = __builtin_amdgcn_exp2f(p1[2 * (i) + 1]); \
                    ra += e0 + e1; rb += e2 + e3; \
                    AC2_PINF(e0); AC2_PINF(e1); AC2_PINF(e2); AC2_PINF(e3); AC2_PINF(ra); AC2_PINF(rb); \
                    p0[2 * (i)] = e0; p0[2 * (i) + 1] = e1; p1[2 * (i)] = e2; p1[2 * (i) + 1] = e3; \
                    if ((i) >= 4) { w[2 * ((i) - 4)] = cvtpk(p0[4 * ((i) - 4)], p0[4 * ((i) - 4) + 1]); w[2 * ((i) - 4) + 1] = cvtpk(p0[4 * ((i) - 4) + 2], p0[4 * ((i) - 4) + 3]); AC2_PINF(w[2 * ((i) - 4)]); AC2_PINF(w[2 * ((i) - 4) + 1]); } \
                    if ((i) == 6) { vl[0] = tr_read(vb); vh[0] = tr_read(vb + 8 * VP); } \
                    if ((i) == 7) { vl[1] = tr_read(vb + 64); vh[1] = tr_read(vb + 64 + 8 * VP); } \
                    __builtin_amdgcn_sched_barrier(0); } while (0)
                s16x4 vl[2], vh[2];
                AC2_QGAP(0); AC2_QGAP(1); AC2_QGAP(2); AC2_QGAP(3); AC2_QGAP(4); AC2_QGAP(5); AC2_QGAP(6); AC2_QGAP(7);
                Ls += ra + rb;
#define AC2_PA(kq) __builtin_bit_cast(bf16x8v, (u32x4){w[4 * (kq)], w[4 * (kq) + 1], w[4 * (kq) + 2], w[4 * (kq) + 3]})
#define AC2_PGAP(g) do { const int kq_ = (g) >> 1, db_ = (g) & 1; const bf16x8v vf = {vl[(g) & 1][0], vl[(g) & 1][1], vl[(g) & 1][2], vl[(g) & 1][3], vh[(g) & 1][0], vh[(g) & 1][1], vh[(g) & 1][2], vh[(g) & 1][3]}; \
                    if ((g) < 6) { const int kq2 = ((g) + 2) >> 1, db2 = (g) & 1; vl[(g) & 1] = tr_read(vb + kq2 * (16 * VP) + db2 * 64); vh[(g) & 1] = tr_read(vb + kq2 * (16 * VP) + db2 * 64 + 8 * VP); } \
                    O[db_] = __builtin_amdgcn_mfma_f32_32x32x16_bf16(vf, AC2_PA(kq_), O[db_], 0, 0, 0); \
                    if ((g) < 4) { w[8 + 2 * (g)] = cvtpk(p1[4 * (g)], p1[4 * (g) + 1]); w[8 + 2 * (g) + 1] = cvtpk(p1[4 * (g) + 2], p1[4 * (g) + 3]); AC2_PINF(w[8 + 2 * (g)]); AC2_PINF(w[8 + 2 * (g) + 1]); } \
                    __builtin_amdgcn_sched_barrier(0); } while (0)
                AC2_PGAP(0); AC2_PGAP(1); AC2_PGAP(2); AC2_PGAP(3); AC2_PGAP(4); AC2_PGAP(5); AC2_PGAP(6); AC2_PGAP(7);
#undef AC2_PGAP
#undef AC2_PA
#undef AC2_QGAP
#undef AC2_PINF
                p0 = n0; p1 = n1;
            }
#endif
        } else if (actn) AC2_QK(jn, ks ^ 1);
        if (jnn >= 0) { *(LAS u32x4*)(L + A_KOFF + ks * A_KBUF + kdst) = kreg; if (FOX && tid < 64) *(LAS float*)(L + A_BOFF + ks * 256 + tid * 4) = breg; }
        if (jn >= 0) *(LAS u32x4*)(L + A_VOFF + (vs ^ 1) * A_VBUF + vdst) = vreg;
        __syncthreads();
        if (jn < 0) break;
        j = jn; jn = jnn; ks ^= 1; vs ^= 1;
    }
#undef AC2_QK
#undef AC2_INIT
#undef AC2_ACTIVE
}
__device__ __forceinline__ size_t mix_off(size_t n, int c, int W) { return ((n >> 5) * (size_t)(W / 8) + (size_t)(c >> 3)) * 256 + (n & 31) * 8 + (c & 7); }
#define ATTN_FOR_CHUNKS(db, g4) _Pragma("unroll") for (int db = 0; db < 2; ++db) _Pragma("unroll") for (int g4 = 0; g4 < 4; ++g4)

__device__ __forceinline__ void unpack8(const u32x4 w, float (&f)[8]) { f[0] = __uint_as_float(w.x << 16); f[1] = __uint_as_float(w.x & 0xffff0000u); f[2] = __uint_as_float(w.y << 16); f[3] = __uint_as_float(w.y & 0xffff0000u);
    f[4] = __uint_as_float(w.z << 16); f[5] = __uint_as_float(w.z & 0xffff0000u); f[6] = __uint_as_float(w.w << 16); f[7] = __uint_as_float(w.w & 0xffff0000u); }
__device__ __forceinline__ void ph_norm_bf16_from_bf16(const Ctx& c, const bf16* x, const float* g, bf16* out) {
    constexpr int RB = 4; float gg[2][8];
#pragma unroll
    for (int j = 0; j < 2; ++j) { const f32x4 a = ((const f32x4*)g)[2 * c.lane + 128 * j], b2 = ((const f32x4*)g)[2 * c.lane + 128 * j + 1]; gg[j][0] = a.x; gg[j][1] = a.y; gg[j][2] = a.z; gg[j][3] = a.w; gg[j][4] = b2.x; gg[j][5] = b2.y; gg[j][6] = b2.z; gg[j][7] = b2.w; }
    for (int row0 = c.gw * RB; row0 < NT; row0 += c.ngw * RB) {
        u32x4 v[RB][2];
#pragma unroll
        for (int q = 0; q < RB; ++q)
#pragma unroll
            for (int j = 0; j < 2; ++j) v[q][j] = ((const u32x4*)(x + (size_t)(row0 + q) * D_))[c.lane + 64 * j];
#pragma unroll
        for (int q = 0; q < RB; ++q) { float f[2][8]; float ss = 0.f;
#pragma unroll
            for (int j = 0; j < 2; ++j) { unpack8(v[q][j], f[j]);
#pragma unroll
                for (int e = 0; e < 8; ++e) ss = fmaf(f[j][e], f[j][e], ss); }
            const float r = rsqrtf(wave_sum_l(ss, c.lane) * (1.f / D_) + EPS);
#pragma unroll
            for (int j = 0; j < 2; ++j) { u32x4 o; o.x = pk2(f[j][0] * r * gg[j][0], f[j][1] * r * gg[j][1]); o.y = pk2(f[j][2] * r * gg[j][2], f[j][3] * r * gg[j][3]); o.z = pk2(f[j][4] * r * gg[j][4], f[j][5] * r * gg[j][5]); o.w = pk2(f[j][6] * r * gg[j][6], f[j][7] * r * gg[j][7]);
                ((u32x4*)(out + (size_t)(row0 + q) * D_))[c.lane + 64 * j] = o; } }
    }
}
__device__ __forceinline__ void ph_norm_final_from_bf16(const Ctx& c, const bf16* x, const float* g, float* out) {
    constexpr int RB = 4; float gg[2][8];
#pragma unroll
    for (int j = 0; j < 2; ++j) { const f32x4 a = ((const f32x4*)g)[2 * c.lane + 128 * j], b2 = ((const f32x4*)g)[2 * c.lane + 128 * j + 1]; gg[j][0] = a.x; gg[j][1] = a.y; gg[j][2] = a.z; gg[j][3] = a.w; gg[j][4] = b2.x; gg[j][5] = b2.y; gg[j][6] = b2.z; gg[j][7] = b2.w; }
    for (int row0 = c.gw * RB; row0 < NT; row0 += c.ngw * RB) {
        u32x4 v[RB][2];
#pragma unroll
        for (int q = 0; q < RB; ++q)
#pragma unroll
            for (int j = 0; j < 2; ++j) v[q][j] = ((const u32x4*)(x + (size_t)(row0 + q) * D_))[c.lane + 64 * j];
#pragma unroll
        for (int q = 0; q < RB; ++q) { float f[2][8]; float ss = 0.f;
#pragma unroll
            for (int j = 0; j < 2; ++j) { unpack8(v[q][j], f[j]);
#pragma unroll
                for (int e = 0; e < 8; ++e) ss = fmaf(f[j][e], f[j][e], ss); }
            const float r = rsqrtf(wave_sum_l(ss, c.lane) * (1.f / D_) + EPS);
#pragma unroll
            for (int j = 0; j < 2; ++j) { f32x4* o = (f32x4*)(out + (size_t)(row0 + q) * D_) + 2 * c.lane + 128 * j;
                o[0] = (f32x4){f[j][0] * r * gg[j][0], f[j][1] * r * gg[j][1], f[j][2] * r * gg[j][2], f[j][3] * r * gg[j][3]}; o[1] = (f32x4){f[j][4] * r * gg[j][4], f[j][5] * r * gg[j][5], f[j][6] * r * gg[j][6], f[j][7] * r * gg[j][7]}; } }
    }
}
__device__ __forceinline__ void ph_norm_bf16(const Ctx& c, const float* x, const float* g, bf16* out, bf16* raw) {
    constexpr int RB = 4;
    f32x4 gg[4];
#pragma unroll
    for (int j = 0; j < 4; ++j) gg[j] = ((const f32x4*)g)[c.lane + 64 * j];
    for (int row0 = c.gw * RB; row0 < NT; row0 += c.ngw * RB) {
        f32x4 v[RB][4];
#pragma unroll
        for (int q = 0; q < RB; ++q)
#pragma unroll
            for (int j = 0; j < 4; ++j) v[q][j] = ((const f32x4*)(x + (size_t)(row0 + q) * D_))[c.lane + 64 * j];
#pragma unroll
        for (int q = 0; q < RB; ++q) { float ss = 0.f;
#pragma unroll
            for (int j = 0; j < 4; ++j) ss += v[q][j].x * v[q][j].x + v[q][j].y * v[q][j].y + v[q][j].z * v[q][j].z + v[q][j].w * v[q][j].w;
            const float r = rsqrtf(wave_sum_l(ss, c.lane) * (1.f / D_) + EPS);
            u64* o8 = (u64*)(out + (size_t)(row0 + q) * D_) + c.lane; u64* r8 = (u64*)(raw + (size_t)(row0 + q) * D_) + c.lane;
#pragma unroll
            for (int j = 0; j < 4; ++j) { o8[64 * j] = (u64)pk2(v[q][j].x * r * gg[j].x, v[q][j].y * r * gg[j].y) | ((u64)pk2(v[q][j].z * r * gg[j].z, v[q][j].w * r * gg[j].w) << 32);
                r8[64 * j] = (u64)pk2(v[q][j].x, v[q][j].y) | ((u64)pk2(v[q][j].z, v[q][j].w) << 32); } }
    }
}
__device__ __forceinline__ void ph_norm_final(const Ctx& c, float* x, const float* g) {
    constexpr int RB = 4;
    f32x4 gg[4];
#pragma unroll
    for (int j = 0; j < 4; ++j) gg[j] = ((const f32x4*)g)[c.lane + 64 * j];
    for (int row0 = c.gw * RB; row0 < NT; row0 += c.ngw * RB) {
        f32x4 v[RB][4];
#pragma unroll
        for (int q = 0; q < RB; ++q)
#pragma unroll
            for (int j = 0; j < 4; ++j) v[q][j] = ((const f32x4*)(x + (size_t)(row0 + q) * D_))[c.lane + 64 * j];
#pragma unroll
        for (int q = 0; q < RB; ++q) { float ss = 0.f;
#pragma unroll
            for (int j = 0; j < 4; ++j) ss += v[q][j].x * v[q][j].x + v[q][j].y * v[q][j].y + v[q][j].z * v[q][j].z + v[q][j].w * v[q][j].w;
            const float r = rsqrtf(wave_sum_l(ss, c.lane) * (1.f / D_) + EPS);
            f32x4* xr = (f32x4*)(x + (size_t)(row0 + q) * D_) + c.lane;
#pragma unroll
            for (int j = 0; j < 4; ++j) xr[64 * j] = v[q][j] * r * gg[j]; }
    }
}

template <class AF, class EF>
__device__ __forceinline__ void naive_gemm(const Ctx& c, int M, int N, int K, AF af, const float* W, int ldb, EF ef) {
    LAS float* As = (LAS float*)c.lds;
    LAS float* Bs = As + 16 * 132;
    const int tm = (M + 127) / 128, tn = (N + 127) / 128, ntile = tm * tn;
    const int ty = c.tid >> 4, tx = c.tid & 15;
    for (int tile = c.bid; tile < ntile; tile += c.G) {
        const int m0 = (tile / tn) * 128, n0 = (tile % tn) * 128;
        float acc[4][8];
#pragma unroll
        for (int i = 0; i < 4; ++i)
#pragma unroll
            for (int j = 0; j < 8; ++j) acc[i][j] = 0.f;
        for (int k0 = 0; k0 < K; k0 += 16) {
            __syncthreads();
#pragma unroll
            for (int i = 0; i < 4; ++i) { const int e = c.tid + i * 512, r = e >> 4, kk = e & 15; const int row = m0 + r;
                As[kk * 132 + r] = (row < M) ? af(row, k0 + kk) : 0.f; }
#pragma unroll
            for (int i = 0; i < 4; ++i) { const int e = c.tid + i * 512, kk = e >> 7, cc = e & 127; const int col = n0 + cc;
                Bs[kk * 132 + cc] = (col < N) ? W[(size_t)(k0 + kk) * ldb + col] : 0.f; }
            __syncthreads();
#pragma unroll 2
            for (int kk = 0; kk < 16; ++kk) {
                float a[4], b[8];
#pragma unroll
                for (int i = 0; i < 4; ++i) a[i] = As[kk * 132 + ty * 4 + i];
#pragma unroll
                for (int j = 0; j < 8; ++j) b[j] = Bs[kk * 132 + tx * 8 + j];
#pragma unroll
                for (int i = 0; i < 4; ++i)
#pragma unroll
                    for (int j = 0; j < 8; ++j) acc[i][j] = fmaf(a[i], b[j], acc[i][j]);
            }
        }
        LAS float* Cs = Bs + 16 * 132;
        __syncthreads();
#pragma unroll
        for (int i = 0; i < 4; ++i)
#pragma unroll
            for (int j = 0; j < 8; ++j) Cs[(ty * 4 + i) * 129 + tx * 8 + j] = acc[i][j];
        __syncthreads();
#pragma unroll 1
        for (int e = c.tid; e < 128 * 128; e += NTHREADS) { const int r = e >> 7, cc = e & 127, row = m0 + r, col = n0 + cc; if (row < M && col < N) ef(row, col, Cs[r * 129 + cc]); }
    }
    __syncthreads();
}

struct InProjOut { bf16* qn; bf16* kv6; bf16* fqkv; bf16* dqk; bf16* dv; float* gate; float* fl; const float* b_gate; const float* b_fgt; };
__device__ __forceinline__ void inproj_store(const InProjOut& o, int n, int col, float v) {
    const int b = n / T_, t = n % T_;
    if (col < C_KV6) { const int h = col >> 6, d = col & 63; o.qn[((size_t)(b * 8 + h) * T_ + t) * 64 + d] = (bf16)f2bf(v * (0.125f * LOG2E)); }
    else if (col < C_GATE) { const int cc = col - C_KV6, idx = cc >> 7, g = (cc >> 6) & 1, d = cc & 63;
        ((bf16*)((unsigned char*)o.kv6 + idx * KV6_STRIDE))[((size_t)(b * 2 + g) * T_ + t) * 64 + d] = (bf16)f2bf(v); }
    else if (col < C_FQ) { const int j = col - C_GATE; o.gate[(size_t)n * 24 + j] = sigmoidf_(v + o.b_gate[j]); }
    else if (col < C_FF) { const int cc = col - C_FQ, idx = cc >> 8, h = (cc >> 6) & 3, d = cc & 63;
        o.fqkv[(size_t)idx * (8 * MiB) + ((size_t)(b * 4 + h) * T_ + t) * 64 + d] = (bf16)f2bf(idx == 0 ? v * (0.125f * LOG2E) : v); }
    else if (col < C_DQ) { const int h = col - C_FF; o.fl[(size_t)(b * 4 + h) * T_ + t] = log_sigmoidf_(v + o.b_fgt[h]); }
    else if (col < C_DV) { const int cc = col - C_DQ, idx = cc >> 8, h = (cc >> 6) & 3, i = (cc >> 5) & 1, d = cc & 31;
        o.dqk[(size_t)idx * (8 * MiB) + ((size_t)((b * 4 + h) * 2 + i) * T_ + t) * 32 + d] = (bf16)f2bf(idx == 0 ? v * (0.17677669529663687f * LOG2E) : v); }
    else { const int cc = col - C_DV, h = cc >> 6, d = cc & 63; o.dv[((size_t)(b * 4 + h) * T_ + t) * 64 + d] = (bf16)f2bf(v); }
}

__device__ __forceinline__ void ph_cumsum(const Ctx& c, float* fl) {
    for (int s = c.gw; s < B_ * 4; s += c.ngw) {
        float* p = fl + (size_t)s * T_; float carry = 0.f;
        for (int t0 = 0; t0 < T_; t0 += 64) {
            float v = p[t0 + c.lane];
#pragma unroll
            for (int o = 1; o < 64; o <<= 1) { const float u = __shfl_up(v, o); if (c.lane >= o) v += u; }
            v += carry; p[t0 + c.lane] = v; carry = __shfl(v, 63);
        }
    }
}

template <int DQK>
__device__ __forceinline__ float naive_attn_row(const bf16* q, const bf16* K, const bf16* V, int t, u64 mask, float slope2, const float* cum, int win, int lane) {
    float qv[DQK];
    { const u32x4* q4 = (const u32x4*)q;
#pragma unroll
      for (int i = 0; i < DQK / 8; ++i) { const u32x4 w = q4[i];
          qv[8 * i + 0] = __uint_as_float(w.x << 16); qv[8 * i + 1] = __uint_as_float(w.x & 0xffff0000u);
          qv[8 * i + 2] = __uint_as_float(w.y << 16); qv[8 * i + 3] = __uint_as_float(w.y & 0xffff0000u);
          qv[8 * i + 4] = __uint_as_float(w.z << 16); qv[8 * i + 5] = __uint_as_float(w.z & 0xffff0000u);
          qv[8 * i + 6] = __uint_as_float(w.w << 16); qv[8 * i + 7] = __uint_as_float(w.w & 0xffff0000u); } }
    const float cumt = cum ? cum[t] : 0.f;
    float m = -INFINITY, l = 0.f, o = 0.f;
    while (mask) {
        const int j = __builtin_ctzll(mask); mask &= mask - 1;
        const int kpos = 64 * j + lane; const int dist = t - kpos;
        const bool valid = dist >= 0 && dist < win;
        float s = 0.f;
        { const u32x4* k4 = (const u32x4*)(K + (size_t)kpos * DQK);
#pragma unroll
          for (int i = 0; i < DQK / 8; ++i) { const u32x4 w = k4[i];
              s = fmaf(qv[8 * i + 0], __uint_as_float(w.x << 16), s); s = fmaf(qv[8 * i + 1], __uint_as_float(w.x & 0xffff0000u), s);
              s = fmaf(qv[8 * i + 2], __uint_as_float(w.y << 16), s); s = fmaf(qv[8 * i + 3], __uint_as_float(w.y & 0xffff0000u), s);
              s = fmaf(qv[8 * i + 4], __uint_as_float(w.z << 16), s); s = fmaf(qv[8 * i + 5], __uint_as_float(w.z & 0xffff0000u), s);
              s = fmaf(qv[8 * i + 6], __uint_as_float(w.w << 16), s); s = fmaf(qv[8 * i + 7], __uint_as_float(w.w & 0xffff0000u), s); } }
        s -= slope2 * (float)dist;
        if (cum) s += (cumt - cum[kpos]) * LOG2E;
        s = valid ? s : -INFINITY;
        const float mb = wave_max(s);
        if (mb == -INFINITY) continue;
        const float mn = fmaxf(m, mb), alpha = exp2f(m - mn);
        const float p = valid ? exp2f(s - mn) : 0.f;
        l = l * alpha + wave_sum(p); o *= alpha; m = mn;
        const bf16* vb = V + (size_t)(64 * j) * 64 + lane;
#pragma unroll 8
        for (int k = 0; k < 64; ++k) o = fmaf(__shfl(p, k), bf2f(vb[(size_t)k * 64]), o);
    }
    return l > 0.f ? o / l : 0.f;
}

__device__ __forceinline__ void ph_cmp_attn(const Ctx& c, const bf16* qn, const bf16* kcmp, const bf16* vcmp, const float* gate, u64* sel, bf16* ocmp) {
    LAS float* pl = (LAS float*)(c.lds) + c.wave * 256;
    const int lane = c.lane;
    for (int it = c.gw; it < B_ * 2 * T_; it += c.ngw) {
        const int t = it % T_, bg = it / T_, b = bg >> 1, g = bg & 1;
        const int nvis = (t >= 31) ? ((t - 31) >> 4) + 1 : 0;
        const bf16* kc = kcmp + (size_t)bg * 256 * 64; const bf16* vc = vcmp + (size_t)bg * 256 * 64;
        float imp = 0.f;
        for (int hg = 0; hg < 4; ++hg) {
            const int h = g * 4 + hg; const float slope2 = alibi_slope(h + 1, 8) * LOG2E;
            const bf16* q = qn + ((size_t)(b * 8 + h) * T_ + t) * 64;
            float qv[64];
            { const u32x4* q4 = (const u32x4*)q;
#pragma unroll
              for (int i = 0; i < 8; ++i) { const u32x4 w = q4[i];
                  qv[8 * i + 0] = __uint_as_float(w.x << 16); qv[8 * i + 1] = __uint_as_float(w.x & 0xffff0000u);
                  qv[8 * i + 2] = __uint_as_float(w.y << 16); qv[8 * i + 3] = __uint_as_float(w.y & 0xffff0000u);
                  qv[8 * i + 4] = __uint_as_float(w.z << 16); qv[8 * i + 5] = __uint_as_float(w.z & 0xffff0000u);
                  qv[8 * i + 6] = __uint_as_float(w.w << 16); qv[8 * i + 7] = __uint_as_float(w.w & 0xffff0000u); } }
            float s[4]; float m = -INFINITY;
#pragma unroll
            for (int i = 0; i < 4; ++i) { const int cc = lane + 64 * i; float a = 0.f;
                if (cc < nvis) { const u32x4* k4 = (const u32x4*)(kc + (size_t)cc * 64);
#pragma unroll
                    for (int e = 0; e < 8; ++e) { const u32x4 w = k4[e];
                        a = fmaf(qv[8 * e + 0], __uint_as_float(w.x << 16), a); a = fmaf(qv[8 * e + 1], __uint_as_float(w.x & 0xffff0000u), a);
                        a = fmaf(qv[8 * e + 2], __uint_as_float(w.y << 16), a); a = fmaf(qv[8 * e + 3], __uint_as_float(w.y & 0xffff0000u), a);
                        a = fmaf(qv[8 * e + 4], __uint_as_float(w.z << 16), a); a = fmaf(qv[8 * e + 5], __uint_as_float(w.z & 0xffff0000u), a);
                        a = fmaf(qv[8 * e + 6], __uint_as_float(w.w << 16), a); a = fmaf(qv[8 * e + 7], __uint_as_float(w.w & 0xffff0000u), a); }
                    a -= slope2 * (float)(t - (16 * cc + 31)); } else a = -INFINITY;
                s[i] = a; m = fmaxf(m, a); }
            m = wave_max(m);
            float p[4], lsum = 0.f;
#pragma unroll
            for (int i = 0; i < 4; ++i) { p[i] = (lane + 64 * i < nvis) ? exp2f(s[i] - m) : 0.f; lsum += p[i]; }
            lsum = wave_sum(lsum);
            const float inv = lsum > 0.f ? 1.f / lsum : 0.f;
#pragma unroll
            for (int i = 0; i < 4; ++i) { p[i] *= inv; pl[lane + 64 * i] = p[i]; }
            asm volatile("s_waitcnt lgkmcnt(0)" ::: "memory");
            float o = 0.f;
            for (int cc = 0; cc < nvis; ++cc) o = fmaf(pl[cc], bf2f(vc[(size_t)cc * 64 + lane]), o);
            const float gt = gate[((size_t)(b * T_ + t)) * 24 + h * 3 + 0];
            ocmp[(size_t)(b * T_ + t) * 512 + h * 64 + lane] = (bf16)f2bf(gt * o);
            { const int j = lane; float a = pl[4 * j] + pl[4 * j + 1] + pl[4 * j + 2] + 0.5f * pl[4 * j + 3]; if (j > 0) a += 0.5f * pl[4 * j - 1]; imp += a; }
            asm volatile("s_waitcnt lgkmcnt(0)" ::: "memory");
        }
        const int cur = t >> 6; const int j = lane;
        u64 m64;
        if (cur <= 15) m64 = (cur == 63) ? ~0ull : ((1ull << (cur + 1)) - 1ull);
        else {
            float val = (j > cur) ? -INFINITY : ((j == 0 || j == cur || j == cur - 1) ? 1e4f : imp);
            m64 = 0ull;
            for (int r = 0; r < 16; ++r) {
                const float mx = wave_max(val);
                const u64 bal = __ballot(val == mx);
                const int w = __builtin_ctzll(bal);
                m64 |= 1ull << w; if (j == w) val = -INFINITY;
            }
        }
        if (lane == 0) sel[(size_t)bg * T_ + t] = m64;
    }
}

__device__ __forceinline__ void ph_win_attn(const Ctx& c, const bf16* qn, const bf16* kw, const bf16* vw, const float* gate, bf16* owin) {
    for (int it = c.gw; it < B_ * 8 * T_; it += c.ngw) {
        const int t = it % T_, bh = it / T_, b = bh >> 3, h = bh & 7, g = h >> 2;
        const int cur = t >> 6, jlo = (t - 511) > 0 ? (t - 511) >> 6 : 0;
        const u64 hi = (cur == 63) ? ~0ull : ((1ull << (cur + 1)) - 1ull); const u64 mask = hi & ~((1ull << jlo) - 1ull);
        const float o = naive_attn_row<64>(qn + ((size_t)bh * T_ + t) * 64, kw + (size_t)(b * 2 + g) * T_ * 64, vw + (size_t)(b * 2 + g) * T_ * 64, t, mask,
                                           alibi_slope(h + 1, 8) * LOG2E, nullptr, 512, c.lane);
        owin[(size_t)(b * T_ + t) * 512 + h * 64 + c.lane] = (bf16)f2bf(gate[(size_t)(b * T_ + t) * 24 + h * 3 + 2] * o);
    }
}
__device__ __forceinline__ void ph_slc_attn(const Ctx& c, const bf16* qn, const bf16* ks, const bf16* vs, const float* gate, const u64* sel, const bf16* ocmp, const bf16* owin, bf16* att) {
    for (int it = c.gw; it < B_ * 8 * T_; it += c.ngw) {
        const int t = it % T_, bh = it / T_, b = bh >> 3, h = bh & 7, g = h >> 2;
        const u64 mask = sel[(size_t)(b * 2 + g) * T_ + t];
        const float o = naive_attn_row<64>(qn + ((size_t)bh * T_ + t) * 64, ks + (size_t)(b * 2 + g) * T_ * 64, vs + (size_t)(b * 2 + g) * T_ * 64, t, mask,
                                           alibi_slope(h + 1, 8) * LOG2E, nullptr, 1 << 30, c.lane);
        const size_t n = (size_t)(b * T_ + t);
        const float r = gate[n * 24 + h * 3 + 1] * o + bf2f(ocmp[n * 512 + h * 64 + c.lane]) + bf2f(owin[n * 512 + h * 64 + c.lane]);
        att[n * 1024 + h * 64 + c.lane] = (bf16)f2bf(r);
    }
}
__device__ __forceinline__ void ph_fox_attn(const Ctx& c, const bf16* fq, const bf16* fk, const bf16* fv, const float* cum, bf16* att) {
    for (int it = c.gw; it < B_ * 4 * T_; it += c.ngw) {
        const int t = it % T_, bh = it / T_, b = bh >> 2, h = bh & 3;
        const int cur = t >> 6; const u64 mask = (cur == 63) ? ~0ull : ((1ull << (cur + 1)) - 1ull);
        const float o = naive_attn_row<64>(fq + ((size_t)bh * T_ + t) * 64, fk + (size_t)bh * T_ * 64, fv + (size_t)bh * T_ * 64, t, mask, 0.f, cum + (size_t)bh * T_, 1 << 30, c.lane);
        att[(size_t)(b * T_ + t) * 1024 + 512 + h * 64 + c.lane] = (bf16)f2bf(o);
    }
}
__device__ __forceinline__ void ph_diff_attn(const Ctx& c, const bf16* dq, const bf16* dk, const bf16* dv, const float* lam, const float* subln, float lambda_init, bf16* att) {
    float l1 = 0.f, l2 = 0.f;
    if (c.lane < 32) { l1 = lam[c.lane] * lam[32 + c.lane]; l2 = lam[64 + c.lane] * lam[96 + c.lane]; }
    const float lam_full = __expf(wave_sum(l1)) - __expf(wave_sum(l2)) + lambda_init;
    const float sg = subln[c.lane] * (1.f - lambda_init);
    for (int it = c.gw; it < B_ * 4 * T_; it += c.ngw) {
        const int t = it % T_, bh = it / T_, b = bh >> 2, h = bh & 3;
        const int cur = t >> 6; const u64 mask = (cur == 63) ? ~0ull : ((1ull << (cur + 1)) - 1ull);
        const float slope2 = alibi_slope(h + 1, 4) * LOG2E;
        const bf16* vb = dv + (size_t)bh * T_ * 64;
        const float o1 = naive_attn_row<32>(dq + ((size_t)(bh * 2 + 0) * T_ + t) * 32, dk + (size_t)(bh * 2 + 0) * T_ * 32, vb, t, mask, slope2, nullptr, 1 << 30, c.lane);
        const float o2 = naive_attn_row<32>(dq + ((size_t)(bh * 2 + 1) * T_ + t) * 32, dk + (size_t)(bh * 2 + 1) * T_ * 32, vb, t, mask, slope2, nullptr, 1 << 30, c.lane);
        const float o = o1 - lam_full * o2;
        const float r = rsqrtf(wave_sum(o * o) * (1.f / 64.f) + EPS);
        att[(size_t)(b * T_ + t) * 1024 + 768 + h * 64 + c.lane] = (bf16)f2bf(o * r * sg);
    }
}

__device__ __forceinline__ void ph_moe_route(const Ctx& c, const float* x, const float* g, const float* wgrp, const float* bgrp, const float* wexp, const float* bexp, bf16* hn, int* route_e, float* route_w, unsigned* cnt) {
    for (int row = c.gw; row < NT; row += c.ngw) {
        const f32x4* xr = (const f32x4*)(x + (size_t)row * D_) + c.lane;
        f32x4 v[4]; float ss = 0.f;
#pragma unroll
        for (int j = 0; j < 4; ++j) { v[j] = xr[64 * j]; ss += v[j].x * v[j].x + v[j].y * v[j].y + v[j].z * v[j].z + v[j].w * v[j].w; }
        const float r = rsqrtf(wave_sum(ss) * (1.f / D_) + EPS);
        u64* o8 = (u64*)(hn + (size_t)row * D_) + c.lane;
#pragma unroll
        for (int j = 0; j < 4; ++j) { const f32x4 gg = ((const f32x4*)g)[c.lane + 64 * j]; v[j] = v[j] * r * gg;
            o8[64 * j] = (u64)pk2(v[j].x, v[j].y) | ((u64)pk2(v[j].z, v[j].w) << 32); }
        float gl[4];
#pragma unroll
        for (int q = 0; q < 4; ++q) { float a = 0.f;
#pragma unroll
            for (int j = 0; j < 4; ++j) { const int k = 4 * (c.lane + 64 * j);
                a = fmaf(v[j].x, wgrp[(size_t)(k + 0) * 4 + q], a); a = fmaf(v[j].y, wgrp[(size_t)(k + 1) * 4 + q], a);
                a = fmaf(v[j].z, wgrp[(size_t)(k + 2) * 4 + q], a); a = fmaf(v[j].w, wgrp[(size_t)(k + 3) * 4 + q], a); }
            gl[q] = wave_sum(a) + bgrp[q]; }
        int grp = 0; float gm = gl[0];
#pragma unroll
        for (int q = 1; q < 4; ++q) if (gl[q] > gm) { gm = gl[q]; grp = q; }
        float gs = 0.f;
#pragma unroll
        for (int q = 0; q < 4; ++q) gs += __expf(gl[q] - gm);
        const float grp_gate = 1.f / gs;
        float el[8];
#pragma unroll
        for (int q = 0; q < 8; ++q) { float a = 0.f; const int col = grp * 8 + q;
#pragma unroll
            for (int j = 0; j < 4; ++j) { const int k = 4 * (c.lane + 64 * j);
                a = fmaf(v[j].x, wexp[(size_t)(k + 0) * 32 + col], a); a = fmaf(v[j].y, wexp[(size_t)(k + 1) * 32 + col], a);
                a = fmaf(v[j].z, wexp[(size_t)(k + 2) * 32 + col], a); a = fmaf(v[j].w, wexp[(size_t)(k + 3) * 32 + col], a); }
            el[q] = wave_sum(a) + bexp[col]; }
        int i0 = 0; float v0 = el[0];
#pragma unroll
        for (int q = 1; q < 8; ++q) if (el[q] > v0) { v0 = el[q]; i0 = q; }
        int i1 = -1; float v1 = -INFINITY;
#pragma unroll
        for (int q = 0; q < 8; ++q) if (q != i0 && el[q] > v1) { v1 = el[q]; i1 = q; }
        const float e1 = __expf(v1 - v0), den = 1.f + e1;
        if (c.lane == 0) { const float w0 = grp_gate / den, w1 = grp_gate * e1 / den;
            const int lo = i0 < i1 ? i0 : i1, hi = i0 < i1 ? i1 : i0, cls = grp * 28 + lo * 8 - (lo * (lo + 1)) / 2 + (hi - lo - 1);
            const unsigned rank = __hip_atomic_fetch_add(cnt + cls, 1u, __ATOMIC_RELAXED, __HIP_MEMORY_SCOPE_AGENT);
            route_e[row] = (int)(((unsigned)cls << 24) | rank); route_w[2 * row] = i0 < i1 ? w0 : w1; route_w[2 * row + 1] = i0 < i1 ? w1 : w0; }
    }
}
__device__ __forceinline__ void ph_moe_naive(const Ctx& c, const bf16* hn, const int* route_e, const float* route_w, const float* wg, const float* wu, const float* wd, float* x) {
    LAS float* hs = (LAS float*)c.lds;
    LAS float* au = hs + 1024;
    LAS float* h2 = au + 512;
    for (int row = c.bid; row < NT; row += c.G) {
        __syncthreads();
        hs[c.tid] = bf2f(hn[(size_t)row * D_ + c.tid]); hs[c.tid + 512] = bf2f(hn[(size_t)row * D_ + c.tid + 512]);
        float o0 = 0.f, o1 = 0.f;
        for (int s = 0; s < 2; ++s) {
            const int e = route_e[2 * row + s]; const float w = route_w[2 * row + s];
            __syncthreads();
            const float* W = (c.tid < 256 ? wg : wu) + (size_t)e * D_ * DEXP + (c.tid & 255);
            float a = 0.f;
            for (int k = 0; k < D_; ++k) a = fmaf(hs[k], W[(size_t)k * DEXP], a);
            au[c.tid] = a;
            __syncthreads();
            if (c.tid < 256) { const float ga = au[c.tid], up = au[c.tid + 256]; h2[c.tid] = ga / (1.f + __expf(-ga)) * up * w; }
            __syncthreads();
            const float* Wd = wd + (size_t)e * DEXP * D_;
            for (int k = 0; k < DEXP; ++k) { const float hv = h2[k]; o0 = fmaf(hv, Wd[(size_t)k * D_ + c.tid], o0); o1 = fmaf(hv, Wd[(size_t)k * D_ + c.tid + 512], o1); }
        }
        x[(size_t)row * D_ + c.tid] += o0; x[(size_t)row * D_ + c.tid + 512] += o1;
    }
    __syncthreads();
}

typedef __attribute__((address_space(4))) const Params* KP;
__device__ __forceinline__ KP uni_kp(KP p) { const unsigned long long v = (unsigned long long)p; const unsigned lo = __builtin_amdgcn_readfirstlane((unsigned)v), hi = __builtin_amdgcn_readfirstlane((unsigned)(v >> 32)); return (KP)(((unsigned long long)hi << 32) | lo); }
constexpr int PH_PER_LAYER = 11, N_PHASES = L_ * PH_PER_LAYER + 2;
__device__ __forceinline__ Ctx make_ctx(KP p) {
    Ctx c; c.lds = (LAS unsigned char*)lds_raw; { int t_ = threadIdx.x; asm volatile("" : "+v"(t_)); c.tid = t_; } c.lane = c.tid & 63; c.wave = __builtin_amdgcn_readfirstlane(c.tid >> 6);
    c.bid = blockIdx.x; c.G = gridDim.x; c.gw = c.bid * NWAVES + c.wave; c.ngw = c.G * NWAVES; c.in = nullptr; c.xcur = p->out; c.ws = p->ws;
    return c;
}
struct Bufs {
    bf16 *QN, *KV6, *KC, *VC, *KS, *VS, *KW, *VW, *FQ, *FK, *FV, *DQ, *DK, *DV, *HC, *KCMP, *VCMP, *OCMP, *OWIN, *HN, *ATT;
    float *GATE, *FL, *ROUTE_W; u64* SEL; int* ROUTE_E;
};
__device__ __forceinline__ Bufs make_bufs(unsigned char* ws) {
    Bufs b;
    b.QN = (bf16*)(ws + WS_QN); b.KV6 = (bf16*)(ws + WS_KV6);
    b.KC = (bf16*)(ws + WS_KV6 + 0 * KV6_STRIDE); b.VC = (bf16*)(ws + WS_KV6 + 1 * KV6_STRIDE);
    b.KS = (bf16*)(ws + WS_KV6 + 2 * KV6_STRIDE); b.VS = (bf16*)(ws + WS_KV6 + 3 * KV6_STRIDE);
    b.KW = (bf16*)(ws + WS_KV6 + 4 * KV6_STRIDE); b.VW = (bf16*)(ws + WS_KV6 + 5 * KV6_STRIDE);
    b.FQ = (bf16*)(ws + WS_FQKV); b.FK = b.FQ + 8 * MiB; b.FV = b.FQ + 16 * MiB;
    b.DQ = (bf16*)(ws + WS_DQK); b.DK = b.DQ + 8 * MiB; b.DV = (bf16*)(ws + WS_DV);
    b.GATE = (float*)(ws + WS_GATE); b.FL = (float*)(ws + WS_FL);
    b.HC = (bf16*)(ws + WS_HC); b.KCMP = (bf16*)(ws + WS_KVCMP); b.VCMP = b.KCMP + 16 * 256 * 64;
    b.SEL = (u64*)(ws + WS_SEL); b.OCMP = (bf16*)(ws + WS_OCMP); b.OWIN = (bf16*)(ws + WS_OWIN);
    b.HN = (bf16*)(ws + WS_HN); b.ATT = (bf16*)(ws + WS_ATT);
    b.ROUTE_E = (int*)(ws + WS_ROUTE); b.ROUTE_W = (float*)(ws + WS_ROUTE + 512 * 1024);
    return b;
}
__device__ __forceinline__ float lambda_init_of(int l) { return l == 0 ? 0.2f : 0.35550906759096926f; }

__device__ __noinline__ void P_prologue(KP p_) { const KP p = uni_kp(p_);
    const Ctx c = make_ctx(p); unsigned char* ws = p->ws;
    LAS float* scr = (LAS float*)(c.lds) + c.wave * (64 * 33);
    constexpr int I_A = 16 * 40, I_B = 16 * 24, I_C = 16 * 24, I_O = 16 * 32, I_G = 16 * 8, I_D = 4 * 32, I_E = 2 * I_G + I_D, I_W1 = 32 * 8, I_W2 = 4 * 2;
    constexpr int PER_L = I_A + I_B + I_C + I_O + 2 * (I_W1 + I_W2);
    for (int it = c.gw; it < L_ * PER_L; it += c.ngw) {
        const int l = it / PER_L; int r = it % PER_L;
        const float* W; bf16* WT; int ldw, K, sc0, ncol, r0 = 0, rmul = 1;
        if (r < I_A + I_B + I_C) { W = p->in[2] + (size_t)l * D_ * D_IN; WT = (bf16*)(ws + WS_WIN_T) + (size_t)l * NIN * D_; ldw = D_IN; K = D_;
            if (r < I_A) { sc0 = 0; ncol = 1280; r0 = 0; } else if (r < I_A + I_B) { r -= I_A; sc0 = C_FQ; ncol = 768; r0 = 1280; } else { r -= I_A + I_B; sc0 = C_DQ; ncol = 768; r0 = 2048; } }
        else if ((r -= I_A + I_B + I_C) < I_O) { W = p->in[13] + (size_t)l * D_ * D_; WT = (bf16*)(ws + WS_WOUT_T) + (size_t)l * D_ * D_; ldw = D_; K = D_; sc0 = 0; ncol = 1024; }
        else { r -= I_O; const int kv = r / (I_W1 + I_W2); r = r % (I_W1 + I_W2); const size_t lk = (size_t)l * 2 + kv;
            if (r < I_W1) { W = p->in[kv == 0 ? 6 : 9] + (size_t)l * 2048 * 256; WT = (bf16*)(ws + WS_W1_T) + lk * 256 * 2048; ldw = 256; K = 2048; sc0 = 0; ncol = 256; }
            else { r -= I_W1; W = p->in[kv == 0 ? 7 : 10] + (size_t)l * 256 * 64; WT = (bf16*)(ws + WS_W2_T) + lk * 64 * 256; ldw = 64; K = 256; sc0 = 0; ncol = 64; } }
        transpose_seg(W, ldw, K, sc0, ncol, WT, r0, rmul, r, scr, c.lane);
    }
    for (int i = c.bid * NTHREADS + c.tid; i < L_ * 256 * D_; i += c.G * NTHREADS) {
        const int l = i / (256 * D_), rr = (i / D_) % 256, k = i % D_;
        const float* win = p->in[2] + (size_t)l * D_ * D_IN;
        float v = 0.f; if (rr < 24) v = win[(size_t)k * D_IN + C_GATE + rr]; else if (rr < 28) v = win[(size_t)k * D_IN + C_FF + (rr - 24)];
        ((bf16*)(ws + WS_WIN_T))[((size_t)l * NIN + 2816 + rr) * D_ + k] = (bf16)f2bf(v);
    }
    for (int w = c.gw; w < L_ * 2 * 4 * 128; w += c.ngw) {
        const int lk = w >> 9, cg = (w >> 7) & 3, kc = w & 127, l = lk >> 1, kv = lk & 1, j = cg * 64 + c.lane;
        const float* pe = p->in[kv == 0 ? 5 : 8] + (size_t)l * 2048 + kc * 16; const float* w1 = p->in[kv == 0 ? 6 : 9] + (size_t)l * 2048 * 256 + (size_t)kc * 16 * 256;
        float a = 0.f;
#pragma unroll
        for (int k = 0; k < 16; ++k) a = fmaf(pe[k], w1[(size_t)k * 256 + j], a);
        ((float*)(ws + WS_B1PART))[((size_t)lk * 128 + kc) * 256 + j] = a;
    }
    for (int i = c.bid * NTHREADS + c.tid; i < L_ * 64 * 2 * 64; i += c.G * NTHREADS) {
        const int l = i / (64 * 2 * 64), ks = (i / 128) % 64, cb = (i / 64) & 1, lane = i & 63, col = 32 * cb + (lane & 31);
        unsigned hi[4], lo[4];
#pragma unroll
        for (int jp = 0; jp < 4; ++jp) { float v[2];
#pragma unroll
            for (int e = 0; e < 2; ++e) { const int k = 16 * ks + 8 * (lane >> 5) + 2 * jp + e; const float g = p->in[14][(size_t)l * D_ + k];
                v[e] = col < 4 ? g * p->in[15][((size_t)l * D_ + k) * 4 + col] : (col < 36 ? g * p->in[17][((size_t)l * D_ + k) * 32 + (col - 4)] : 0.f); }
            const unsigned h0 = f2bf(v[0]), h1 = f2bf(v[1]); hi[jp] = h0 | (h1 << 16);
            lo[jp] = f2bf(v[0] - __uint_as_float(h0 << 16)) | (f2bf(v[1] - __uint_as_float(h1 << 16)) << 16); }
        u32x4* dst = (u32x4*)(ws + WS_WR) + ((size_t)((l * 64 + ks) * 2 + cb) * 2) * 64 + lane;
        dst[0] = (u32x4){hi[0], hi[1], hi[2], hi[3]}; dst[64] = (u32x4){lo[0], lo[1], lo[2], lo[3]};
    }
}
__device__ __forceinline__ void P_inproj_mfma(int l_) { const KP p = (KP)__builtin_amdgcn_kernarg_segment_ptr(); int l = l_; asm volatile("" : "+s"(l));
    unsigned char* ws = p->ws; asm volatile("" : "+s"(ws));
    PlainOrder S; S.init(p->out, (const bf16*)(ws + WS_WIN_T) + (size_t)l * NIN * D_, D_, D_, NT, NIN, (int)gridDim.x, launder_s((int)blockIdx.x));
#ifdef STAGGER_TICKS
    { const unsigned long long t0 = __builtin_amdgcn_s_memrealtime(); const unsigned long long d = (unsigned long long)((launder_s((int)blockIdx.x) >> 3) & 3) * STAGGER_TICKS;
      while (__builtin_amdgcn_s_memrealtime() - t0 < d) __builtin_amdgcn_s_sleep(4); }
#endif
    const pg8::Gemm g{D_, D_, D_, D_ / 64, 0, 0};
    const EpiInProj E{ws, p->in[3] + l * 24, p->in[4] + l * 4, (unsigned*)(ws + WS_CTL) + CW_KN + l * 8192};
    pg8::gemm_phase<EpiInProj, PlainOrder, INPROJ_ALIGN, INPROJ_SP2>((LAS unsigned char*)lds_raw, g, S, E);
}
__device__ __forceinline__ void P_inproj_dummy(int l_) { const KP p = (KP)__builtin_amdgcn_kernarg_segment_ptr(); int l = l_; asm volatile("" : "+s"(l));
    unsigned char* ws = p->ws; asm volatile("" : "+s"(ws));
    PlainOrder S; S.init(p->out, (const bf16*)(ws + WS_WIN_T) + (size_t)l * NIN * D_, D_, D_, NT, NIN, (int)gridDim.x, launder_s((int)blockIdx.x));
    const pg8::Gemm g{D_, D_, D_, D_ / 64, 0, 0};
    const EpiDummy E{(float*)(ws + WS_HB)};
    pg8::gemm_phase<EpiDummy, PlainOrder, true, true>((LAS unsigned char*)lds_raw, g, S, E);
}
__device__ __forceinline__ void P_outproj_mfma(int l_) { const KP p = (KP)__builtin_amdgcn_kernarg_segment_ptr(); int l = l_; asm volatile("" : "+s"(l));
    unsigned char* ws = p->ws; asm volatile("" : "+s"(ws));
    PlainOrder S; S.init(ws + WS_ATT, (const bf16*)(ws + WS_WOUT_T) + (size_t)l * D_ * D_, D_, D_, NT, D_, (int)gridDim.x, launder_s((int)blockIdx.x));
    const pg8::Gemm g{D_, D_, D_, D_ / 64, 32, 8};
    const EpiResBf16 E{(bf16*)(ws + WS_HN)};
    pg8::gemm_phase<EpiResBf16, PlainOrder, true, true>((LAS unsigned char*)lds_raw, g, S, E);
}
__device__ __forceinline__ float wave_max_l(float v, int lane) {
#pragma unroll
    for (int o = 1; o < 64; o <<= 1) v = fmaxf(v, shflx_f(v, o, lane));
    return v;
}
__device__ __forceinline__ float wave_min_l(float v, int lane) {
#pragma unroll
    for (int o = 1; o < 64; o <<= 1) v = fminf(v, shflx_f(v, o, lane));
    return v;
}
template <int NS> __device__ __forceinline__ float q_norm2_max(const bf16x8v (&Q)[NS], int lane) {
    float ss = 0.f;
#pragma unroll
    for (int s = 0; s < NS; ++s)
#pragma unroll
        for (int e = 0; e < 8; ++e) { const float v = __uint_as_float(((unsigned)(unsigned short)Q[s][e]) << 16); ss = fmaf(v, v, ss); }
    return wave_max_l(swap_sum(ss), lane);
}
__device__ __forceinline__ u64 prune_consensus(bool skip, LAS u64* slots, int wave, int lane) {
    const u64 mine = __ballot(skip);
    __syncthreads();
    if (lane == 0) slots[wave] = mine;
    __syncthreads();
    u64 all = slots[0];
#pragma unroll
    for (int w = 1; w < NWAVES; ++w) all &= slots[w];
    return all;
}
__device__ __forceinline__ bool block_any(bool v, LAS u64* slots, int wave, int lane) {
#ifdef FORCE_FALLBACK
    v = true;
#endif
    const u64 mine = __ballot(v);
    __syncthreads();
    if (lane == 0) slots[wave] = mine;
    __syncthreads();
    u64 all = slots[0];
#pragma unroll
    for (int w = 1; w < NWAVES; ++w) all |= slots[w];
    return all != 0ull;
}
__device__ __forceinline__ bool sum_bad(float l) { return !(l < 1e30f); }
__device__ __forceinline__ void U_fox(KP p_, int bh_, int qb_, int l_) {
    const KP p = uni_kp(p_); const int bh = __builtin_amdgcn_readfirstlane(bh_), qb = __builtin_amdgcn_readfirstlane(qb_), l = __builtin_amdgcn_readfirstlane(l_);
    int tid_ = threadIdx.x; asm volatile("" : "+v"(tid_));
    const int tid = tid_, lane = tid & 63, wave = __builtin_amdgcn_readfirstlane(tid >> 6), r = lane & 31, h = lane >> 5;
    unsigned char* ws = p->ws; asm volatile("" : "+s"(ws)); LAS unsigned char* L = (LAS unsigned char*)lds_raw;
    const int tw0 = 256 * qb + 32 * wave, t_lane = tw0 + r, b = bh >> 2, hd = bh & 3;
    const bf16* q = (const bf16*)(ws + WS_FQKV) + (size_t)bh * T_ * 64 + (t_lane >> 4) * 1024 + (t_lane & 15) * 32 + 8 * h;
    bf16x8v Qf[1][4];
#pragma unroll
    for (int s = 0; s < 4; ++s) Qf[0][s] = *(const bf16x8v*)(q + (s >> 1) * 512 + (s & 1) * 16);
    const bf16* Kp = (const bf16*)(ws + WS_FQKV) + 8 * MiB + (size_t)bh * T_ * 64; const bf16* Vp = (const bf16*)(ws + WS_FQKV) + 16 * MiB + (size_t)bh * T_ * 64;
    u32x4 kpre, vpre; attn_preload<64>(Kp, nullptr, Vp, 4 * qb + 3, tid, kpre, vpre);
    LAS float* cum = (LAS float*)(L + A_LDS_END);
    { const float* fl = (const float*)(ws + WS_FL) + (size_t)bh * T_; LAS float* tot = cum + 4096;
      const int nval = 256 * (qb + 1); float v[8];
      if (8 * tid < nval) { const f32x4 a = *(const f32x4*)(fl + 8 * tid), c2 = *(const f32x4*)(fl + 8 * tid + 4); v[0] = a.x; v[1] = a.y; v[2] = a.z; v[3] = a.w; v[4] = c2.x; v[5] = c2.y; v[6] = c2.z; v[7] = c2.w; }
      else {
#pragma unroll
          for (int i = 0; i < 8; ++i) v[i] = 0.f; }
#pragma unroll
      for (int i = 1; i < 8; ++i) v[i] += v[i - 1];
      float sc = v[7];
#pragma unroll
      for (int o = 1; o < 64; o <<= 1) { const float up = __uint_as_float((unsigned)__builtin_amdgcn_ds_bpermute((lane - o) << 2, (int)__float_as_uint(sc))); if (lane >= o) sc += up; }
      if (lane == 63) tot[wave] = sc;
      __syncthreads();
      float base = sc - v[7];
      for (int w = 0; w < wave; ++w) base += tot[w];
      if (8 * tid < nval) {
#pragma unroll
          for (int i = 0; i < 8; ++i) cum[8 * tid + i] = v[i] + base; }
      __syncthreads(); }
    f32x16 O[1][2]; float M[1] = {0.f}, Ls[1] = {0.f};
#pragma unroll
    for (int i = 0; i < 16; ++i) { O[0][0][i] = 0.f; O[0][1][i] = 0.f; }
    const u64 tm = (qb == 15) ? ~0ull : ((1ull << (4 * qb + 4)) - 1ull);
#if AC2_MODE == 0
    {
        const u64 low = (1ull << (4 * qb)) - 1ull; const float cref = cum[tw0];
#define FOX_CORES(NM, FIRSTCALL) do { FIRSTCALL; \
        if (qb > 0) { \
            const float qn2 = q_norm2_max<4>(Qf[0], lane), mmin = wave_min_l(M[0], lane); \
            const float* kn = (const float*)((const unsigned*)(ws + WS_CTL) + CW_KN + l * 8192) + ((size_t)bh * 64 + lane) * 2; \
            bool skip = false; \
            if (lane < 4 * qb) { const float kn2 = kn[0] + kn[1]; const float bound = sqrtf(qn2 * kn2) * 1.02f + (cref - cum[64 * lane + 63]) * LOG2E - mmin; skip = bound < -152.f; } \
            const u64 drop = prune_consensus(skip, (LAS u64*)(cum + 4096 + 16), wave, lane); \
            const u64 tm2 = low & ~drop; \
            if (tm2) attn_core<64, 1, true, false, false, NM>(L, Kp, nullptr, Vp, cum, cref, Qf, tm2, t_lane, tw0, 1 << 30, 0.f, 0u, 0u, O, M, Ls, tid, true); \
        } } while (0)
        FOX_CORES(NOMAX_ON, (attn_core<64, 1, true, false, true, NOMAX_ON>(L, Kp, nullptr, Vp, cum, cref, Qf, tm & ~low, t_lane, tw0, 1 << 30, 0.f, 0u, 0u, O, M, Ls, tid, false, 4 * qb + 3, kpre, vpre)));
        if (NOMAX_ON && block_any(sum_bad(Ls[0]), (LAS u64*)(cum + 4096 + 32), wave, lane)) {
#pragma unroll
            for (int i = 0; i < 16; ++i) { O[0][0][i] = 0.f; O[0][1][i] = 0.f; }
            M[0] = 0.f; Ls[0] = 0.f;
            FOX_CORES(false, (attn_core<64, 1, true, false, false, false>(L, Kp, nullptr, Vp, cum, cref, Qf, tm & ~low, t_lane, tw0, 1 << 30, 0.f, 0u, 0u, O, M, Ls, tid)));
        }
#undef FOX_CORES
    }
#else
    attn_core2<true, false>(L, (const bf16*)(ws + WS_FQKV) + 8 * MiB + (size_t)bh * T_ * 64, (const bf16*)(ws + WS_FQKV) + 16 * MiB + (size_t)bh * T_ * 64, cum, cum[256 * qb],
                            Qf[0], tm, t_lane, tw0, 1 << 30, 0.f, 0u, 0u, O[0], M[0], Ls[0], tid);
#endif
    const float lt = swap_sum(Ls[0]), inv = lt > 0.f ? 1.f / lt : 0.f;
    bf16* dst = (bf16*)(ws + WS_ATT) + mix_off((size_t)b * T_ + t_lane, 512 + hd * 64 + 4 * h, 1024);
    ATTN_FOR_CHUNKS(db, g4) { const unsigned w0 = cvtpk(O[0][db][4 * g4 + 0] * inv, O[0][db][4 * g4 + 1] * inv), w1 = cvtpk(O[0][db][4 * g4 + 2] * inv, O[0][db][4 * g4 + 3] * inv);
        *(u64*)(dst + (4 * db + g4) * 256) = (u64)w0 | ((u64)w1 << 32); }
}
__device__ __forceinline__ void U_diff(KP p_, int bh_, int qb_, int l_) {
    const KP p = uni_kp(p_); const int bh = __builtin_amdgcn_readfirstlane(bh_), qb = __builtin_amdgcn_readfirstlane(qb_), l = __builtin_amdgcn_readfirstlane(l_);
    int tid_ = threadIdx.x; asm volatile("" : "+v"(tid_));
    const int tid = tid_, lane = tid & 63, wave = __builtin_amdgcn_readfirstlane(tid >> 6), r = lane & 31, h = lane >> 5;
    unsigned char* ws = p->ws; asm volatile("" : "+s"(ws)); LAS unsigned char* L = (LAS unsigned char*)lds_raw;
    const int tw0 = 256 * qb + 32 * wave, t_lane = tw0 + r, b = bh >> 2, hd = bh & 3;
    const bf16* DQ = (const bf16*)(ws + WS_DQK); const bf16* DK = DQ + 8 * MiB;
    bf16x8v Qf[2][2];
#pragma unroll
    for (int mp = 0; mp < 2; ++mp)
#pragma unroll
        for (int s = 0; s < 2; ++s) Qf[mp][s] = *(const bf16x8v*)(DQ + ((size_t)(bh * 2 + mp) * T_ + t_lane) * 32 + 16 * s + 8 * h);
    f32x16 O[2][2]; float M[2] = {0.f, 0.f}, Ls[2] = {0.f, 0.f};
#pragma unroll
    for (int i = 0; i < 16; ++i) { O[0][0][i] = 0.f; O[0][1][i] = 0.f; O[1][0][i] = 0.f; O[1][1][i] = 0.f; }
    const u64 tm = (qb == 15) ? ~0ull : ((1ull << (4 * qb + 4)) - 1ull);
    {
        const u64 low = (1ull << (4 * qb)) - 1ull; const float slope2 = alibi_slope(hd + 1, 4) * LOG2E;
        const bf16* K0 = DK + (size_t)(bh * 2 + 0) * T_ * 32; const bf16* K1 = DK + (size_t)(bh * 2 + 1) * T_ * 32; const bf16* Vp = (const bf16*)(ws + WS_DV) + (size_t)bh * T_ * 64;
#define DIFF_CORES(NM) do { \
        attn_core<32, 2, false, false, false, NM>(L, K0, K1, Vp, nullptr, 0.f, Qf, tm & ~low, t_lane, tw0, 1 << 30, slope2, 0u, 0u, O, M, Ls, tid); \
        if (qb > 0) { \
            const float qa = q_norm2_max<2>(Qf[0], lane), qb2 = q_norm2_max<2>(Qf[1], lane), ma = wave_min_l(M[0], lane), mb = wave_min_l(M[1], lane); \
            const float* kn = (const float*)((const unsigned*)(ws + WS_CTL) + CW_KN + l * 8192 + 4096) + (size_t)(bh * 2) * 64 + lane; \
            bool skip = false; \
            if (lane < 4 * qb) { const float bmax = slope2 * (float)(64 * lane + 63 - tw0);            \
                skip = (sqrtf(qa * kn[0]) * 1.02f + bmax - ma < -152.f) && (sqrtf(qb2 * kn[64]) * 1.02f + bmax - mb < -152.f); } \
            const u64 drop = prune_consensus(skip, (LAS u64*)(L + A_LDS_END), wave, lane); \
            const u64 tm2 = low & ~drop; \
            if (tm2) attn_core<32, 2, false, false, false, NM>(L, K0, K1, Vp, nullptr, 0.f, Qf, tm2, t_lane, tw0, 1 << 30, slope2, 0u, 0u, O, M, Ls, tid, true); \
        } } while (0)
        DIFF_CORES(NOMAX_ON);
        if (NOMAX_ON && block_any(sum_bad(Ls[0]) || sum_bad(Ls[1]), (LAS u64*)(L + A_LDS_END + 64), wave, lane)) {
#pragma unroll
            for (int i = 0; i < 16; ++i) { O[0][0][i] = 0.f; O[0][1][i] = 0.f; O[1][0][i] = 0.f; O[1][1][i] = 0.f; }
            M[0] = 0.f; M[1] = 0.f; Ls[0] = 0.f; Ls[1] = 0.f;
            DIFF_CORES(false);
        }
#undef DIFF_CORES
    }
    const float* lam = p->in[11] + (size_t)l * 128; const float* subln = p->in[12] + (size_t)l * 64;
    float l1 = 0.f, l2 = 0.f; if (lane < 32) { l1 = lam[lane] * lam[32 + lane]; l2 = lam[64 + lane] * lam[96 + lane]; }
    const float li = lambda_init_of(l), lam_full = __expf(wave_sum_l(l1, lane)) - __expf(wave_sum_l(l2, lane)) + li;
    const float lt0 = swap_sum(Ls[0]), lt1 = swap_sum(Ls[1]), i0 = lt0 > 0.f ? 1.f / lt0 : 0.f, i1 = (lt1 > 0.f ? 1.f / lt1 : 0.f) * lam_full;
    float ss = 0.f;
#pragma unroll
    for (int db = 0; db < 2; ++db)
#pragma unroll
        for (int i = 0; i < 16; ++i) { const float o = O[0][db][i] * i0 - O[1][db][i] * i1; O[0][db][i] = o; ss += o * o; }
    ss = swap_sum(ss);
    const float rn = rsqrtf(ss * (1.f / 64.f) + EPS) * (1.f - li);
    bf16* dst = (bf16*)(ws + WS_ATT) + mix_off((size_t)b * T_ + t_lane, 768 + hd * 64 + 4 * h, 1024);
    ATTN_FOR_CHUNKS(db, g4) { const f32x4 sg = *(const f32x4*)(subln + 32 * db + 8 * g4 + 4 * h);
        const unsigned w0 = cvtpk(O[0][db][4 * g4 + 0] * rn * sg.x, O[0][db][4 * g4 + 1] * rn * sg.y), w1 = cvtpk(O[0][db][4 * g4 + 2] * rn * sg.z, O[0][db][4 * g4 + 3] * rn * sg.w);
        *(u64*)(dst + (4 * db + g4) * 256) = (u64)w0 | ((u64)w1 << 32); }
}
__device__ __forceinline__ void U_win(KP p_, int bg_, int c_) {
    const KP p = uni_kp(p_); const int bg = __builtin_amdgcn_readfirstlane(bg_), cc = __builtin_amdgcn_readfirstlane(c_);
    int tid_ = threadIdx.x; asm volatile("" : "+v"(tid_));
    const int tid = tid_, lane = tid & 63, wave = __builtin_amdgcn_readfirstlane(tid >> 6), r = lane & 31, h = lane >> 5;
    unsigned char* ws = p->ws; asm volatile("" : "+s"(ws)); LAS unsigned char* L = (LAS unsigned char*)lds_raw;
    const int b = bg >> 1, g = bg & 1, hd = g * 4 + (wave >> 1), tw0 = 64 * cc + 32 * (wave & 1), t_lane = tw0 + r;
    const bf16* q = (const bf16*)(ws + WS_QN) + (size_t)(b * 8 + hd) * T_ * 64 + (t_lane >> 4) * 1024 + (t_lane & 15) * 32 + 8 * h;
    bf16x8v Qf[1][4];
#pragma unroll
    for (int s = 0; s < 4; ++s) Qf[0][s] = *(const bf16x8v*)(q + (s >> 1) * 512 + (s & 1) * 16);
    f32x16 O[1][2]; float M[1] = {0.f}, Ls[1] = {0.f};
#pragma unroll
    for (int i = 0; i < 16; ++i) { O[0][0][i] = 0.f; O[0][1][i] = 0.f; }
    const size_t n = (size_t)b * T_ + t_lane;
    const float gate_w = ((const float*)(ws + WS_GATE))[n * 24 + hd * 3 + 2];
    const int jlo = cc > 8 ? cc - 8 : 0;
    const u64 hi = (cc == 63) ? ~0ull : ((1ull << (cc + 1)) - 1ull), tm = hi & ~((1ull << jlo) - 1ull);
#if AC2_MODE == 0
    attn_core<64, 1, false, false, false, NOMAX_ON>(L, (const bf16*)(ws + WS_KV6 + 4 * KV6_STRIDE) + (size_t)bg * T_ * 64, nullptr, (const bf16*)(ws + WS_KV6 + 5 * KV6_STRIDE) + (size_t)bg * T_ * 64, nullptr, 0.f,
                                   Qf, tm, t_lane, tw0, 512, alibi_slope(hd + 1, 8) * LOG2E, 0u, 0u, O, M, Ls, tid);
    if (NOMAX_ON && block_any(sum_bad(Ls[0]), (LAS u64*)(L + A_LDS_END + 64), wave, lane)) {
#pragma unroll
        for (int i = 0; i < 16; ++i) { O[0][0][i] = 0.f; O[0][1][i] = 0.f; }
        M[0] = 0.f; Ls[0] = 0.f;
        attn_core<64, 1, false, false, false, false>(L, (const bf16*)(ws + WS_KV6 + 4 * KV6_STRIDE) + (size_t)bg * T_ * 64, nullptr, (const bf16*)(ws + WS_KV6 + 5 * KV6_STRIDE) + (size_t)bg * T_ * 64, nullptr, 0.f,
                                       Qf, tm, t_lane, tw0, 512, alibi_slope(hd + 1, 8) * LOG2E, 0u, 0u, O, M, Ls, tid);
    }
#ifdef PROBE_WINCORE2
    attn_core<64, 1, false, false>(L, (const bf16*)(ws + WS_KV6 + 4 * KV6_STRIDE) + (size_t)bg * T_ * 64, nullptr, (const bf16*)(ws + WS_KV6 + 5 * KV6_STRIDE) + (size_t)bg * T_ * 64, nullptr, 0.f,
                                   Qf, tm, t_lane, tw0, 512, alibi_slope(hd + 1, 8) * LOG2E, 0u, 0u, O, M, Ls, tid, true);
#endif
#else
    attn_core2<false, false>(L, (const bf16*)(ws + WS_KV6 + 4 * KV6_STRIDE) + (size_t)bg * T_ * 64, (const bf16*)(ws + WS_KV6 + 5 * KV6_STRIDE) + (size_t)bg * T_ * 64, nullptr, 0.f,
                             Qf[0], tm, t_lane, tw0, 512, alibi_slope(hd + 1, 8) * LOG2E, 0u, 0u, O[0], M[0], Ls[0], tid);
#endif
    const float lt = swap_sum(Ls[0]), inv = (lt > 0.f ? 1.f / lt : 0.f) * gate_w;
    bf16* dst = (bf16*)(ws + WS_OWIN) + mix_off(n, hd * 64 + 4 * h, 512);
    ATTN_FOR_CHUNKS(db, g4) { const unsigned w0 = cvtpk(O[0][db][4 * g4 + 0] * inv, O[0][db][4 * g4 + 1] * inv), w1 = cvtpk(O[0][db][4 * g4 + 2] * inv, O[0][db][4 * g4 + 3] * inv);
        *(u64*)(dst + (4 * db + g4) * 256) = (u64)w0 | ((u64)w1 << 32); }
}
__device__ __forceinline__ void U_slc(KP p_, int bg_, int c_) {
    const KP p = uni_kp(p_); const int bg = __builtin_amdgcn_readfirstlane(bg_), cc = __builtin_amdgcn_readfirstlane(c_);
    int tid_ = threadIdx.x; asm volatile("" : "+v"(tid_));
    const int tid = tid_, lane = tid & 63, wave = __builtin_amdgcn_readfirstlane(tid >> 6), r = lane & 31, h = lane >> 5;
    unsigned char* ws = p->ws; asm volatile("" : "+s"(ws)); LAS unsigned char* L = (LAS unsigned char*)lds_raw;
    const int b = bg >> 1, g = bg & 1, hd = g * 4 + (wave >> 1), tw0 = 64 * cc + 32 * (wave & 1), t_lane = tw0 + r;
    const bf16* q = (const bf16*)(ws + WS_QN) + (size_t)(b * 8 + hd) * T_ * 64 + (t_lane >> 4) * 1024 + (t_lane & 15) * 32 + 8 * h;
    bf16x8v Qf[1][4];
#pragma unroll
    for (int s = 0; s < 4; ++s) Qf[0][s] = *(const bf16x8v*)(q + (s >> 1) * 512 + (s & 1) * 16);
    f32x16 O[1][2]; float M[1] = {0.f}, Ls[1] = {0.f};
#pragma unroll
    for (int i = 0; i < 16; ++i) { O[0][0][i] = 0.f; O[0][1][i] = 0.f; }
    const bf16* Ksl = (const bf16*)(ws + WS_KV6 + 2 * KV6_STRIDE) + (size_t)bg * T_ * 64; const bf16* Vsl = (const bf16*)(ws + WS_KV6 + 3 * KV6_STRIDE) + (size_t)bg * T_ * 64;
    u32x4 kpre, vpre; attn_preload<64>(Ksl, nullptr, Vsl, cc, tid, kpre, vpre);
    const size_t n = (size_t)b * T_ + t_lane;
    const float gate_s = ((const float*)(ws + WS_GATE))[n * 24 + hd * 3 + 1];
    const bf16* oc = (const bf16*)(ws + WS_OCMP) + mix_off(n, hd * 64 + 4 * h, 512); const bf16* ow = (const bf16*)(ws + WS_OWIN) + mix_off(n, hd * 64 + 4 * h, 512);
    u64 ocv[8], owv[8];
    ATTN_FOR_CHUNKS(db, g4) { ocv[4 * db + g4] = *(const u64*)(oc + (4 * db + g4) * 256); owv[4 * db + g4] = *(const u64*)(ow + (4 * db + g4) * 256); }
    const u64* sel = (const u64*)(ws + WS_SEL) + (size_t)bg * T_;
    const u64 mine = sel[t_lane]; u64 un = sel[64 * cc + lane];
    { unsigned ul = (unsigned)un, uh = (unsigned)(un >> 32);
#pragma unroll
      for (int o = 1; o < 64; o <<= 1) { ul |= shflx_u(ul, o, lane); uh |= shflx_u(uh, o, lane); }
      un = ((u64)__builtin_amdgcn_readfirstlane(uh) << 32) | __builtin_amdgcn_readfirstlane(ul); }
#if AC2_MODE == 0
    attn_core<64, 1, false, true, true, NOMAX_ON>(L, Ksl, nullptr, Vsl, nullptr, 0.f,
                                  Qf, un, t_lane, tw0, 1 << 30, alibi_slope(hd + 1, 8) * LOG2E, (unsigned)mine, (unsigned)(mine >> 32), O, M, Ls, tid, false, cc, kpre, vpre);
    if (NOMAX_ON && block_any(sum_bad(Ls[0]), (LAS u64*)(L + A_LDS_END + 64), wave, lane)) {
#pragma unroll
        for (int i = 0; i < 16; ++i) { O[0][0][i] = 0.f; O[0][1][i] = 0.f; }
        M[0] = 0.f; Ls[0] = 0.f;
        attn_core<64, 1, false, true, false, false>(L, Ksl, nullptr, Vsl, nullptr, 0.f, Qf, un, t_lane, tw0, 1 << 30, alibi_slope(hd + 1, 8) * LOG2E, (unsigned)mine, (unsigned)(mine >> 32), O, M, Ls, tid);
    }
#else
    attn_core2<false, true>(L, (const bf16*)(ws + WS_KV6 + 2 * KV6_STRIDE) + (size_t)bg * T_ * 64, (const bf16*)(ws + WS_KV6 + 3 * KV6_STRIDE) + (size_t)bg * T_ * 64, nullptr, 0.f,
                            Qf[0], un, t_lane, tw0, 1 << 30, alibi_slope(hd + 1, 8) * LOG2E, (unsigned)mine, (unsigned)(mine >> 32), O[0], M[0], Ls[0], tid);
#endif
    const float lt = swap_sum(Ls[0]), inv = (lt > 0.f ? 1.f / lt : 0.f) * gate_s;
    bf16* dst = (bf16*)(ws + WS_ATT) + mix_off(n, hd * 64 + 4 * h, 1024);
    ATTN_FOR_CHUNKS(db, g4) { const u64 a = ocv[4 * db + g4], w = owv[4 * db + g4];
        const float x0 = O[0][db][4 * g4 + 0] * inv + __uint_as_float((unsigned)a << 16) + __uint_as_float((unsigned)w << 16);
        const float x1 = O[0][db][4 * g4 + 1] * inv + __uint_as_float((unsigned)a & 0xffff0000u) + __uint_as_float((unsigned)w & 0xffff0000u);
        const float x2 = O[0][db][4 * g4 + 2] * inv + __uint_as_float((unsigned)(a >> 32) << 16) + __uint_as_float((unsigned)(w >> 32) << 16);
        const float x3 = O[0][db][4 * g4 + 3] * inv + __uint_as_float((unsigned)(a >> 32) & 0xffff0000u) + __uint_as_float((unsigned)(w >> 32) & 0xffff0000u);
        *(u64*)(dst + (4 * db + g4) * 256) = (u64)cvtpk(x0, x1) | ((u64)cvtpk(x2, x3) << 32); }
}
__device__ __forceinline__ float other_half(float x, int h) { auto rr = __builtin_amdgcn_permlane32_swap(__float_as_uint(x), __float_as_uint(x), false, false); return __uint_as_float(h ? rr[0] : rr[1]); }
__device__ __forceinline__ int other_half_i(int x, int h) { auto rr = __builtin_amdgcn_permlane32_swap((unsigned)x, (unsigned)x, false, false); return (int)(h ? rr[0] : rr[1]); }
template <bool MASK>
__device__ __forceinline__ void cmp_scores(f32x16& p0, f32x16& p1, const LAS unsigned char* kt, const bf16x8v (&Qf)[4], float b0, float s1, int cl, int nvis_l) {
    const float s8 = s1 * 8.f, s32 = s1 * 32.f;
    p0[0] = b0; p0[1] = p0[0] + s1; p0[2] = p0[1] + s1; p0[3] = p0[2] + s1;
#pragma unroll
    for (int reg = 4; reg < 16; ++reg) p0[reg] = p0[reg - 4] + s8;
#pragma unroll
    for (int reg = 0; reg < 16; ++reg) p1[reg] = p0[reg] + s32;
#pragma unroll
    for (int s = 0; s < 4; ++s) { const bf16x8v kf0 = *(const LAS bf16x8v*)(kt + s * 32), kf1 = *(const LAS bf16x8v*)(kt + 32 * 144 + s * 32);
        p0 = __builtin_amdgcn_mfma_f32_32x32x16_bf16(kf0, Qf[s], p0, 0, 0, 0); p1 = __builtin_amdgcn_mfma_f32_32x32x16_bf16(kf1, Qf[s], p1, 0, 0, 0); }
    if (MASK) {
#pragma unroll
        for (int reg = 0; reg < 16; ++reg) { const int c = cl + crow0(reg); p0[reg] = (c < nvis_l) ? p0[reg] : -INFINITY; p1[reg] = (c + 32 < nvis_l) ? p1[reg] : -INFINITY; } }
}
__device__ __forceinline__ void U_cmp(KP p_, int bg_, int u_) {
    const KP p = uni_kp(p_); const int bg = __builtin_amdgcn_readfirstlane(bg_), uu = __builtin_amdgcn_readfirstlane(u_);
    int tid_ = threadIdx.x; asm volatile("" : "+v"(tid_));
    const int tid = tid_, lane = tid & 63, wave = __builtin_amdgcn_readfirstlane(tid >> 6), r = lane & 31, h = lane >> 5;
    unsigned char* ws = p->ws; asm volatile("" : "+s"(ws)); LAS unsigned char* L = (LAS unsigned char*)lds_raw;
    const int b = bg >> 1, g = bg & 1, tw0 = 32 * (uu + 16 * wave), t_lane = tw0 + r;
    { const bf16* kc = (const bf16*)(ws + WS_KVCMP) + (size_t)bg * 256 * 64; const bf16* vc = kc + 16 * 256 * 64;
#pragma unroll
      for (int i = 0; i < 4; ++i) { const int ch = tid + 512 * i, row = ch >> 3, c8 = ch & 7;
          *(LAS u32x4*)(L + row * 144 + c8 * 16) = *(const u32x4*)(kc + row * 64 + c8 * 8); *(LAS u32x4*)(L + 36864 + row * 144 + c8 * 16) = *(const u32x4*)(vc + row * 64 + c8 * 8); } }
    __syncthreads();
    const int nvis_l = t_lane >= 31 ? ((t_lane - 31) >> 4) + 1 : 0, nvis_max = (tw0 >> 4) + 1, nvis_min = tw0 >= 31 ? ((tw0 - 31) >> 4) + 1 : 0, ntile = (nvis_max + 63) >> 6;
    const LAS unsigned char* kfrag = L + r * 144 + h * 16;
    const LAS unsigned char* vfrag = L + 36864 + (4 * h + ((lane & 15) >> 2)) * 144 + (16 * ((lane >> 4) & 1) + 4 * (lane & 3)) * 2;
    float imp[32];
#pragma unroll
    for (int e = 0; e < 32; ++e) imp[e] = 0.f;
    const float* gate = (const float*)(ws + WS_GATE) + ((size_t)b * T_ + t_lane) * 24;
#pragma unroll 1
    for (int hg = 0; hg < 4; ++hg) {
        const int hd = g * 4 + hg; const float s1 = alibi_slope(hd + 1, 8) * LOG2E * 16.f;
        const bf16* q = (const bf16*)(ws + WS_QN) + (size_t)(b * 8 + hd) * T_ * 64 + (t_lane >> 4) * 1024 + (t_lane & 15) * 32 + 8 * h;
        bf16x8v Qf[4];
#pragma unroll
        for (int s = 0; s < 4; ++s) Qf[s] = *(const bf16x8v*)(q + (s >> 1) * 512 + (s & 1) * 16);
        f32x16 O0, O1;
#pragma unroll
        for (int i = 0; i < 16; ++i) { O0[i] = 0.f; O1[i] = 0.f; }
        float oscale = 0.f; bool bad;
        {
        float lsum = 0.f, carry = 0.f; float ih[32];
#pragma unroll
        for (int e = 0; e < 32; ++e) ih[e] = 0.f;
#pragma unroll
        for (int jt = 0; jt < 4; ++jt) if (jt < ntile) {
            f32x16 p0, p1; const float b0 = s1 * (float)(64 * jt + 4 * h - nvis_max);
            if (64 * jt + 63 >= nvis_min) cmp_scores<true>(p0, p1, kfrag + jt * (64 * 144), Qf, b0, s1, 64 * jt + 4 * h, nvis_l);
            else cmp_scores<false>(p0, p1, kfrag + jt * (64 * 144), Qf, b0, s1, 64 * jt + 4 * h, nvis_l);
            float rs = 0.f;
#pragma unroll
            for (int reg = 0; reg < 16; ++reg) { p0[reg] = __builtin_amdgcn_exp2f(p0[reg]); p1[reg] = __builtin_amdgcn_exp2f(p1[reg]); rs += p0[reg] + p1[reg]; }
            lsum += rs;
            float cv[8];
#pragma unroll
            for (int g4 = 0; g4 < 4; ++g4) { const float h0 = 0.5f * p0[4 * g4 + 3], h1 = 0.5f * p1[4 * g4 + 3];
                ih[jt * 8 + g4] += ((p0[4 * g4] + p0[4 * g4 + 1]) + p0[4 * g4 + 2]) + h0; ih[jt * 8 + 4 + g4] += ((p1[4 * g4] + p1[4 * g4 + 1]) + p1[4 * g4 + 2]) + h1;
                cv[g4] = h0; cv[4 + g4] = h1; }
            float prev = carry;
#pragma unroll
            for (int k = 0; k < 8; ++k) { const float sv = other_half(cv[k], h); ih[jt * 8 + k] += h ? sv : prev; prev = sv; }
            carry = prev;
            const bf16x8v pa0 = pack8(p0, 0), pa1 = pack8(p0, 8), pa2 = pack8(p1, 0), pa3 = pack8(p1, 8);
            const LAS unsigned char* vb = vfrag + jt * (64 * 144);
#pragma unroll
            for (int ks = 0; ks < 4; ++ks) { const bf16x8v pa = ks == 0 ? pa0 : ks == 1 ? pa1 : ks == 2 ? pa2 : pa3;
                { const s16x4 lo = tr_read(vb + ks * (16 * 144)), hi = tr_read(vb + ks * (16 * 144) + 8 * 144); const bf16x8v vf = {lo[0], lo[1], lo[2], lo[3], hi[0], hi[1], hi[2], hi[3]};
                  O0 = __builtin_amdgcn_mfma_f32_32x32x16_bf16(vf, pa, O0, 0, 0, 0); }
                { const s16x4 lo = tr_read(vb + ks * (16 * 144) + 64), hi = tr_read(vb + ks * (16 * 144) + 64 + 8 * 144); const bf16x8v vf = {lo[0], lo[1], lo[2], lo[3], hi[0], hi[1], hi[2], hi[3]};
                  O1 = __builtin_amdgcn_mfma_f32_32x32x16_bf16(vf, pa, O1, 0, 0, 0); } }
        }
#ifdef FORCE_FALLBACK
        bad = true;
#else
        bad = __any(sum_bad(lsum));
#endif
        if (!bad) { const float lt = swap_sum(lsum), inv = lt > 0.f ? 1.f / lt : 0.f; oscale = inv;
#pragma unroll
            for (int e = 0; e < 32; ++e) imp[e] = fmaf(ih[e], inv, imp[e]); }
        }
        if (bad) {
        float m, lsum;
#pragma unroll
        for (int i = 0; i < 16; ++i) { O0[i] = 0.f; O1[i] = 0.f; }
        m = -1e30f; lsum = 0.f;
#pragma unroll 1
        for (int jt = 0; jt < ntile; ++jt) {
            f32x16 p0, p1; const float b0 = s1 * (float)(64 * jt + 4 * h - nvis_max);
            if (64 * jt + 63 >= nvis_min) cmp_scores<true>(p0, p1, kfrag + jt * (64 * 144), Qf, b0, s1, 64 * jt + 4 * h, nvis_l);
            else cmp_scores<false>(p0, p1, kfrag + jt * (64 * 144), Qf, b0, s1, 64 * jt + 4 * h, nvis_l);
            float mt = fmaxf(p0[0], p1[0]);
#pragma unroll
            for (int reg = 1; reg < 16; ++reg) mt = fmaxf(mt, fmaxf(p0[reg], p1[reg]));
            mt = swap_max(mt);
            const float mn = fmaxf(m, mt); float rs = 0.f;
#pragma unroll
            for (int reg = 0; reg < 16; ++reg) rs += __builtin_amdgcn_exp2f(p0[reg] - mn) + __builtin_amdgcn_exp2f(p1[reg] - mn);
            lsum = lsum * __builtin_amdgcn_exp2f(m - mn) + rs; m = mn;
        }
        const float lt = swap_sum(lsum), cnorm = lt > 0.f ? m + __builtin_amdgcn_logf(lt) : 1e30f;
        float carry = 0.f;
#pragma unroll
        for (int jt = 0; jt < 4; ++jt) if (jt < ntile) {
            f32x16 p0, p1; const float b0 = s1 * (float)(64 * jt + 4 * h - nvis_max) - cnorm;
            if (64 * jt + 63 >= nvis_min) cmp_scores<true>(p0, p1, kfrag + jt * (64 * 144), Qf, b0, s1, 64 * jt + 4 * h, nvis_l);
            else cmp_scores<false>(p0, p1, kfrag + jt * (64 * 144), Qf, b0, s1, 64 * jt + 4 * h, nvis_l);
#pragma unroll
            for (int reg = 0; reg < 16; ++reg) { p0[reg] = __builtin_amdgcn_exp2f(p0[reg]); p1[reg] = __builtin_amdgcn_exp2f(p1[reg]); }
            float cv[8];
#pragma unroll
            for (int g4 = 0; g4 < 4; ++g4) { const float h0 = 0.5f * p0[4 * g4 + 3], h1 = 0.5f * p1[4 * g4 + 3];
                imp[jt * 8 + g4] += ((p0[4 * g4] + p0[4 * g4 + 1]) + p0[4 * g4 + 2]) + h0; imp[jt * 8 + 4 + g4] += ((p1[4 * g4] + p1[4 * g4 + 1]) + p1[4 * g4 + 2]) + h1;
                cv[g4] = h0; cv[4 + g4] = h1; }
            float prev = carry;
#pragma unroll
            for (int k = 0; k < 8; ++k) { const float sv = other_half(cv[k], h); imp[jt * 8 + k] += h ? sv : prev; prev = sv; }
            carry = prev;
            const bf16x8v pa0 = pack8(p0, 0), pa1 = pack8(p0, 8), pa2 = pack8(p1, 0), pa3 = pack8(p1, 8);
            const LAS unsigned char* vb = vfrag + jt * (64 * 144);
#pragma unroll
            for (int ks = 0; ks < 4; ++ks) { const bf16x8v pa = ks == 0 ? pa0 : ks == 1 ? pa1 : ks == 2 ? pa2 : pa3;
                { const s16x4 lo = tr_read(vb + ks * (16 * 144)), hi = tr_read(vb + ks * (16 * 144) + 8 * 144); const bf16x8v vf = {lo[0], lo[1], lo[2], lo[3], hi[0], hi[1], hi[2], hi[3]};
                  O0 = __builtin_amdgcn_mfma_f32_32x32x16_bf16(vf, pa, O0, 0, 0, 0); }
                { const s16x4 lo = tr_read(vb + ks * (16 * 144) + 64), hi = tr_read(vb + ks * (16 * 144) + 64 + 8 * 144); const bf16x8v vf = {lo[0], lo[1], lo[2], lo[3], hi[0], hi[1], hi[2], hi[3]};
                  O1 = __builtin_amdgcn_mfma_f32_32x32x16_bf16(vf, pa, O1, 0, 0, 0); } }
        }
        oscale = 1.f;
        }
        const float gt = gate[hd * 3 + 0] * oscale;
        bf16* dst = (bf16*)(ws + WS_OCMP) + mix_off((size_t)b * T_ + t_lane, hd * 64 + 4 * h, 512);
#pragma unroll
        for (int g4 = 0; g4 < 4; ++g4) {
            *(u64*)(dst + g4 * 256) = (u64)cvtpk(O0[4 * g4 + 0] * gt, O0[4 * g4 + 1] * gt) | ((u64)cvtpk(O0[4 * g4 + 2] * gt, O0[4 * g4 + 3] * gt) << 32);
            *(u64*)(dst + (4 + g4) * 256) = (u64)cvtpk(O1[4 * g4 + 0] * gt, O1[4 * g4 + 1] * gt) | ((u64)cvtpk(O1[4 * g4 + 2] * gt, O1[4 * g4 + 3] * gt) << 32); }
    }
    const int cur = tw0 >> 6; u64 mask;
    if (cur <= 15) mask = (1ull << (cur + 1)) - 1ull;
    else {
        mask = 1ull | (1ull << cur) | (1ull << (cur - 1));
#pragma unroll
        for (int e = 0; e < 32; ++e) { const int j = 2 * e + h; if (j > cur || j == 0 || j >= cur - 1) imp[e] = -INFINITY; }
#pragma unroll 1
        for (int round = 0; round < 13; ++round) {
            float bv = imp[0]; int be = 0;
#pragma unroll
            for (int e = 1; e < 32; ++e) if (imp[e] > bv) { bv = imp[e]; be = e; }
            const int bj = 2 * be + h; const float ov = other_half(bv, h); const int oj = other_half_i(bj, h);
            const bool mine = bv > ov || (bv == ov && bj < oj);
            mask |= 1ull << (mine ? bj : oj);
#pragma unroll
            for (int e = 0; e < 32; ++e) imp[e] = (mine && e == be) ? -INFINITY : imp[e];
        }
    }
    if (h == 0) ((u64*)(ws + WS_SEL))[(size_t)bg * T_ + t_lane] = mask;
    __syncthreads();
}
constexpr int CONV_UNITS = L_ * NEXP * (2 * 16 * 8 + 4 * 32) / 32;
__device__ __forceinline__ void U_conv(KP p_, int k_) {
    const KP p = uni_kp(p_); const int k = __builtin_amdgcn_readfirstlane(k_);
    int tid_ = threadIdx.x; asm volatile("" : "+v"(tid_));
    const int tid = tid_, lane = tid & 63, wave = __builtin_amdgcn_readfirstlane(tid >> 6);
    unsigned char* ws = p->ws; asm volatile("" : "+s"(ws));
    LAS float* scr = (LAS float*)lds_raw + wave * (64 * 33);
    constexpr int I_G = 16 * 8, I_D = 4 * 32, I_E = 2 * I_G + I_D;
#pragma unroll 1
    for (int i = 0; i < 4; ++i) {
        const int m = k * 32 + i * 8 + wave, l = m / (NEXP * I_E); int r = m % (NEXP * I_E); const int e = r / I_E; r = r % I_E; const size_t le = (size_t)l * NEXP + e;
        const float* W; bf16* WT; int ldw, K, ncol, r0 = 0, rmul = 1; const float* gk = nullptr;
        if (r < 2 * I_G) { const int up = r >= I_G; r -= up * I_G; W = p->in[19 + up] + le * D_ * DEXP; WT = (bf16*)(ws + WS_WGU_T) + le * 512 * D_; ldw = DEXP; K = D_; ncol = 256; r0 = up; rmul = 2; gk = p->in[14] + (size_t)l * D_; }
        else { r -= 2 * I_G; W = p->in[21] + le * DEXP * D_; WT = (bf16*)(ws + WS_WD_T) + le * D_ * DEXP; ldw = D_; K = DEXP; ncol = 1024; }
        transpose_seg(W, ldw, K, 0, ncol, WT, r0, rmul, r, scr, lane, gk);
    }
}
__device__ __forceinline__ int fetch_unit(KP p, int qidx) {
    volatile LAS unsigned* slot = (volatile LAS unsigned*)((LAS unsigned char*)lds_raw + MISC_OFF) + 16;
    __syncthreads();
    int t0_ = threadIdx.x; asm volatile("" : "+v"(t0_));
    if (t0_ == 0) *slot = __hip_atomic_fetch_add((unsigned*)(p->ws + WS_CTL) + CW_QUEUE + 64 * qidx, 1u, __ATOMIC_RELAXED, __HIP_MEMORY_SCOPE_AGENT);
    __syncthreads();
    return (int)__builtin_amdgcn_readfirstlane(*slot);
}
__device__ __forceinline__ void P_cmp1_mfma(int l_) { const KP p = (KP)__builtin_amdgcn_kernarg_segment_ptr(); int l = l_; asm volatile("" : "+s"(l));
    unsigned char* ws = p->ws; asm volatile("" : "+s"(ws)); const int c = launder_s((int)blockIdx.x), kv = c >> 4, pm = c & 15;
    OneUnitOrder S; S.has = c < 32; S.u.pm = pm; S.u.pn = kv;
    S.u.a = (const char*)(ws + WS_KV6 + (size_t)kv * KV6_STRIDE) + (size_t)pm * 256 * 1024 * 2; S.u.b = (const char*)((const bf16*)(ws + WS_W1_T) + ((size_t)l * 2 + kv) * 256 * 2048); S.u.b2 = S.u.b;
    const pg8::Gemm g{1024, 2048, 2048, 32, 0, 0};
    const EpiCmpH E{(bf16*)(ws + WS_HC), (const float*)(ws + WS_BIAS1) + l * 512};
    pg8::gemm_phase<EpiCmpH, OneUnitOrder, false, true>((LAS unsigned char*)lds_raw, g, S, E);
}
__device__ __forceinline__ void P_cmp2_mfma(int l_) { const KP p = (KP)__builtin_amdgcn_kernarg_segment_ptr(); int l = l_; asm volatile("" : "+s"(l));
    unsigned char* ws = p->ws; asm volatile("" : "+s"(ws)); const int c = launder_s((int)blockIdx.x), kv = c >> 4, pm = c & 15;
    OneUnitOrder S; S.has = c < 32; S.u.pm = pm; S.u.pn = kv;
    S.u.a = (const char*)((const bf16*)(ws + WS_HC) + ((size_t)kv * 4096 + pm * 256) * 256); S.u.b = (const char*)((const bf16*)(ws + WS_W2_T) + ((size_t)l * 2 + kv) * 64 * 256); S.u.b2 = S.u.b;
    const pg8::Gemm g{256, 256, 256, 4, 0, 0};
    const EpiCmpOut E{(bf16*)(ws + WS_KVCMP)};
    pg8::gemm_phase<EpiCmpOut, OneUnitOrder, false, true>((LAS unsigned char*)lds_raw, g, S, E);
}
__device__ __forceinline__ void P_moe_scatter(KP p_, int l_) { const KP p = uni_kp(p_); const int l = __builtin_amdgcn_readfirstlane(l_); const Ctx c = make_ctx(p); unsigned char* ws = p->ws;
    const unsigned* cnt = (const unsigned*)(ws + WS_CTL) + CW_MOECNT + l * MOE_LS;
    moe_build_tables(cnt, c.tid);
    const LAS int* T = (const LAS int*)((LAS unsigned char*)lds_raw + TBL_OFF);
    const unsigned* info = (const unsigned*)(ws + WS_ROUTE + RT_INFO); const float* tw = (const float*)(ws + WS_ROUTE + RT_W);
    int* rowtok = (int*)(ws + WS_ROUTE + RT_ROWTOK); float* roww = (float*)(ws + WS_ROUTE + RT_ROWW);
    bf16* xs = (bf16*)(ws + WS_XS); const bf16* x = (const bf16*)(ws + WS_HN); const float* gain = p->in[14] + (size_t)l * D_; const float* rstdv = (const float*)(ws + WS_ROUTE + RT_RSTD);
    { constexpr int RB = 4; float gg[2][8];
#pragma unroll
      for (int j = 0; j < 2; ++j) { const f32x4 a = ((const f32x4*)gain)[2 * c.lane + 128 * j], b2 = ((const f32x4*)gain)[2 * c.lane + 128 * j + 1]; gg[j][0] = a.x; gg[j][1] = a.y; gg[j][2] = a.z; gg[j][3] = a.w; gg[j][4] = b2.x; gg[j][5] = b2.y; gg[j][6] = b2.z; gg[j][7] = b2.w; }
      for (int row0 = c.gw * RB; row0 < NT; row0 += c.ngw * RB) {
        u32x4 vv[RB][2];
#pragma unroll
        for (int q = 0; q < RB; ++q)
#pragma unroll
            for (int j = 0; j < 2; ++j) vv[q][j] = ((const u32x4*)(x + (size_t)(row0 + q) * D_))[c.lane + 64 * j];
#pragma unroll
        for (int q = 0; q < RB; ++q) { const int row = row0 + q;
            const unsigned v = info[row]; const int cls = (int)(v >> 24), rank = (int)(v & 0xffffffu); const size_t dest = (size_t)T[cls] * 256 + rank; const float r = rstdv[row];
#pragma unroll
            for (int j = 0; j < 2; ++j) { float f[8]; unpack8(vv[q][j], f); u32x4 o; o.x = pk2(f[0] * r * gg[j][0], f[1] * r * gg[j][1]); o.y = pk2(f[2] * r * gg[j][2], f[3] * r * gg[j][3]); o.z = pk2(f[4] * r * gg[j][4], f[5] * r * gg[j][5]); o.w = pk2(f[6] * r * gg[j][6], f[7] * r * gg[j][7]);
                ((u32x4*)(xs + dest * D_))[c.lane + 64 * j] = o; }
            if (c.lane == 0) { rowtok[dest] = row; roww[2 * dest] = tw[2 * row]; roww[2 * dest + 1] = tw[2 * row + 1]; } }
      } }
    for (int cls = c.bid; cls < 112; cls += c.G) { const int n = (int)cnt[cls * MOE_CS], end = (int)((cnt[cls * MOE_CS] + 255u) >> 8) * 256; const size_t base = (size_t)T[cls] * 256;
        for (int r = n + c.tid; r < end; r += NTHREADS) rowtok[base + r] = -1; }
}
__device__ __forceinline__ int xcd_major(int bid, int G) { bid = launder_s(bid); return (G & 7) ? bid : (bid & 7) * (G >> 3) + (bid >> 3); }
__device__ __forceinline__ void P_moe_g1(int l_) { const KP p = (KP)__builtin_amdgcn_kernarg_segment_ptr(); int l = l_; asm volatile("" : "+s"(l));
    unsigned char* ws = p->ws; asm volatile("" : "+s"(ws));
    { int t0_ = threadIdx.x; asm volatile("" : "+v"(t0_)); moe_build_tables((const unsigned*)(ws + WS_CTL) + CW_MOECNT + l * MOE_LS, t0_); }
    const MoeOrder1 S{(const char*)ws, (const unsigned*)(ws + WS_REC), (const char*)((const bf16*)(ws + WS_WGU_T) + (size_t)l * NEXP * 512 * D_), (unsigned*)(ws + WS_CTL) + CW_MOECNT + l * MOE_LS + (112 + NEXP) * MOE_CS, (int)gridDim.x, xcd_major((int)blockIdx.x, (int)gridDim.x)};
    const pg8::Gemm g{D_, D_, D_, D_ / 64, 0, 0};
    const EpiMoeH E{(bf16*)(ws + WS_HB), (const u32x4*)(ws + WS_REC)};
    pg8::gemm_phase<EpiMoeH, MoeOrder1, true, true, true>((LAS unsigned char*)lds_raw, g, S, E);
}
__device__ __forceinline__ void P_moe_g2(int l_) { const KP p = (KP)__builtin_amdgcn_kernarg_segment_ptr(); int l = l_; asm volatile("" : "+s"(l));
    unsigned char* ws = p->ws; asm volatile("" : "+s"(ws));
    { int t0_ = threadIdx.x; asm volatile("" : "+v"(t0_)); moe_build_tables((const unsigned*)(ws + WS_CTL) + CW_MOECNT + l * MOE_LS, t0_); }
    const MoeOrder2 S{(const char*)(ws + WS_HB), (const char*)((const bf16*)(ws + WS_WD_T) + (size_t)l * NEXP * D_ * DEXP), (const unsigned*)(ws + WS_CTL) + CW_MOECNT + l * MOE_LS + (112 + NEXP) * MOE_CS, (unsigned*)(ws + WS_CTL) + XB_TMO + 4096, (int)gridDim.x, xcd_major((int)blockIdx.x, (int)gridDim.x)};
    const pg8::Gemm g{512, DEXP, 512, 4, 16, 16};
    const EpiMoeOut E{(bf16*)(ws + WS_HN), (const unsigned*)(ws + WS_RECC)};
    pg8::gemm_phase<EpiMoeOut, MoeOrder2, true, true>((LAS unsigned char*)lds_raw, g, S, E);
}
__device__ __forceinline__ void P_bias1(KP p_) { const KP p = uni_kp(p_); int t_ = threadIdx.x; asm volatile("" : "+v"(t_));
    const int i = launder_s((int)blockIdx.x) * NTHREADS + t_; if (i < L_ * 2 * 256) { const float* part = (const float*)(p->ws + WS_B1PART) + (size_t)(i >> 8) * 128 * 256 + (i & 255); float a = 0.f;
        for (int k = 0; k < 128; ++k) a += part[(size_t)k * 256]; ((float*)(p->ws + WS_BIAS1))[i] = a; } }
__device__ __forceinline__ void P_norm1(KP p_, int l_) { const KP p = uni_kp(p_); const int l = __builtin_amdgcn_readfirstlane(l_); const Ctx c = make_ctx(p); const Bufs b = make_bufs(p->ws);
    if (l == 0) ph_norm_bf16(c, p->in[0], p->in[1], (bf16*)p->out, (bf16*)(p->ws + WS_HN)); else ph_norm_bf16_from_bf16(c, (const bf16*)(p->ws + WS_HN), p->in[1] + (size_t)l * D_, (bf16*)p->out); }
__device__ __noinline__ void P_inproj(KP p_, int l_) { const KP p = uni_kp(p_); const int l = __builtin_amdgcn_readfirstlane(l_); const Ctx c = make_ctx(p); const Bufs b = make_bufs(p->ws);
    InProjOut o{b.QN, b.KV6, b.FQ, b.DQ, b.DV, b.GATE, b.FL, p->in[3] + l * 24, p->in[4] + l * 4};
    const bf16* A = b.HN;
    naive_gemm(c, NT, D_IN, D_, [=](int r, int k) { return bf2f(A[(size_t)r * D_ + k]); }, p->in[2] + (size_t)l * D_ * D_IN, D_IN,
               [=](int r, int col, float v) { inproj_store(o, r, col, v); }); }
__device__ __noinline__ void P_cmp1(KP p_, int l_, int kv_) { const KP p = uni_kp(p_); const int l = __builtin_amdgcn_readfirstlane(l_), kv = __builtin_amdgcn_readfirstlane(kv_); const Ctx c = make_ctx(p); const Bufs b = make_bufs(p->ws);
    const bf16* src = kv == 0 ? b.KC : b.VC; const float* pe = p->in[kv == 0 ? 5 : 8] + (size_t)l * 2048; bf16* hc = b.HC + (size_t)kv * 4096 * 256;
    naive_gemm(c, 4096, 256, 2048, [=](int r, int k) { return bf2f(src[(size_t)r * 1024 + k]) + pe[k]; }, p->in[kv == 0 ? 6 : 9] + (size_t)l * 2048 * 256, 256,
               [=](int r, int col, float v) { hc[(size_t)r * 256 + col] = (bf16)f2bf(gelu_tanh(v)); }); }
__device__ __noinline__ void P_cumsum(KP p_, int l_) { const KP p = uni_kp(p_); const int l = __builtin_amdgcn_readfirstlane(l_); const Ctx c = make_ctx(p); const Bufs b = make_bufs(p->ws); ph_cumsum(c, b.FL); }
__device__ __noinline__ void P_cmp2(KP p_, int l_, int kv_) { const KP p = uni_kp(p_); const int l = __builtin_amdgcn_readfirstlane(l_), kv = __builtin_amdgcn_readfirstlane(kv_); const Ctx c = make_ctx(p); const Bufs b = make_bufs(p->ws);
    const bf16* hc = b.HC + (size_t)kv * 4096 * 256; bf16* dst = kv == 0 ? b.KCMP : b.VCMP;
    naive_gemm(c, 4096, 64, 256, [=](int r, int k) { return bf2f(hc[(size_t)r * 256 + k]); }, p->in[kv == 0 ? 7 : 10] + (size_t)l * 256 * 64, 64,
               [=](int r, int col, float v) { dst[(size_t)r * 64 + col] = (bf16)f2bf((r & 255) == 255 ? 0.f : v); }); }
__device__ __noinline__ void P_win(KP p_, int l_) { const KP p = uni_kp(p_); const int l = __builtin_amdgcn_readfirstlane(l_); const Ctx c = make_ctx(p); const Bufs b = make_bufs(p->ws); ph_win_attn(c, b.QN, b.KW, b.VW, b.GATE, b.OWIN); }
__device__ __noinline__ void P_fox(KP p_, int l_) { const KP p = uni_kp(p_); const int l = __builtin_amdgcn_readfirstlane(l_); const Ctx c = make_ctx(p); const Bufs b = make_bufs(p->ws); ph_fox_attn(c, b.FQ, b.FK, b.FV, b.FL, b.ATT); }
__device__ __noinline__ void P_diff(KP p_, int l_) { const KP p = uni_kp(p_); const int l = __builtin_amdgcn_readfirstlane(l_); const Ctx c = make_ctx(p); const Bufs b = make_bufs(p->ws);
    ph_diff_attn(c, b.DQ, b.DK, b.DV, p->in[11] + (size_t)l * 128, p->in[12] + (size_t)l * 64, lambda_init_of(l), b.ATT); }
__device__ __noinline__ void P_cmpattn(KP p_, int l_) { const KP p = uni_kp(p_); const int l = __builtin_amdgcn_readfirstlane(l_); const Ctx c = make_ctx(p); const Bufs b = make_bufs(p->ws); ph_cmp_attn(c, b.QN, b.KCMP, b.VCMP, b.GATE, b.SEL, b.OCMP); }
__device__ __noinline__ void P_slc(KP p_, int l_) { const KP p = uni_kp(p_); const int l = __builtin_amdgcn_readfirstlane(l_); const Ctx c = make_ctx(p); const Bufs b = make_bufs(p->ws); ph_slc_attn(c, b.QN, b.KS, b.VS, b.GATE, b.SEL, b.OCMP, b.OWIN, b.ATT); }
__device__ __noinline__ void P_outproj(KP p_, int l_) { const KP p = uni_kp(p_); const int l = __builtin_amdgcn_readfirstlane(l_); const Ctx c = make_ctx(p); const Bufs b = make_bufs(p->ws);
    const bf16* A = b.ATT; float* xo = p->out; const float* xin = (l == 0) ? p->in[0] : p->out;
    naive_gemm(c, NT, D_, D_, [=](int r, int k) { return bf2f(A[(size_t)r * D_ + k]); }, p->in[13] + (size_t)l * D_ * D_, D_,
               [=](int r, int col, float v) { xo[(size_t)r * D_ + col] = xin[(size_t)r * D_ + col] + v; }); }
__device__ __forceinline__ void P_route3(int l_, int cbank) { const KP p = (KP)__builtin_amdgcn_kernarg_segment_ptr(); int l = l_; asm volatile("" : "+s"(l));
    int tid_ = threadIdx.x; asm volatile("" : "+v"(tid_));
    const int tid = tid_, lane = tid & 63, wave = __builtin_amdgcn_readfirstlane(tid >> 6), r = lane & 31, h = lane >> 5, kh = wave >> 2, wr = wave & 3;
    unsigned char* ws = p->ws; asm volatile("" : "+s"(ws)); const bf16* x = (const bf16*)(ws + WS_HN);
    const float* WR = (const float*)(ws + WS_WR) + (size_t)l * D_ * 64;
    LAS float* XT = (LAS float*)lds_raw + wave * (32 * 36);
    LAS float* WT = (LAS float*)lds_raw + 8 * 32 * 36 + kh * (2 * 32 * 64);
    LAS float* PL = (LAS float*)lds_raw + 8 * 32 * 36 + 2 * 2 * 32 * 64;
    LAS float* SS = PL + 2 * 128 * 40;
    const float* bgrp = p->in[16] + l * 4; const float* bexp = p->in[18] + l * 32;
    unsigned* cnt = (unsigned*)(ws + WS_CTL) + CW_MOECNT + l * MOE_LS + cbank;
    LAS unsigned* HIST = (LAS unsigned*)(SS + 2 * 128 * 2);
    for (int grp = launder_s((int)blockIdx.x); grp < NT / 128; grp += (int)gridDim.x) {
        const int row0 = grp * 128 + wr * 32;
        if (tid < 144) HIST[tid] = 0u;
        f32x16 acc0, acc1; float ss = 0.f;
#pragma unroll
        for (int i = 0; i < 16; ++i) { acc0[i] = 0.f; acc1[i] = 0.f; }
        { const u32x4* xsrc = (const u32x4*)(x + (size_t)(row0 + r) * D_ + kh * 512 + 8 * h);
          const u32x4* wsrc = (const u32x4*)(ws + WS_WR) + ((size_t)l * 64 + kh * 32) * 256 + lane;
#pragma unroll 4
          for (int ks = 0; ks < 32; ++ks) {
              const u32x4 av = xsrc[2 * ks], b0h = wsrc[ks * 256], b0l = wsrc[ks * 256 + 64], b1h = wsrc[ks * 256 + 128], b1l = wsrc[ks * 256 + 192];
              { float f_[8]; unpack8(av, f_);
#pragma unroll
                for (int e = 0; e < 8; ++e) ss = fmaf(f_[e], f_[e], ss); }
              const bf16x8v A = __builtin_bit_cast(bf16x8v, av);
              acc0 = __builtin_amdgcn_mfma_f32_32x32x16_bf16(A, __builtin_bit_cast(bf16x8v, b0h), acc0, 0, 0, 0); acc1 = __builtin_amdgcn_mfma_f32_32x32x16_bf16(A, __builtin_bit_cast(bf16x8v, b1h), acc1, 0, 0, 0);
              acc0 = __builtin_amdgcn_mfma_f32_32x32x16_bf16(A, __builtin_bit_cast(bf16x8v, b0l), acc0, 0, 0, 0); acc1 = __builtin_amdgcn_mfma_f32_32x32x16_bf16(A, __builtin_bit_cast(bf16x8v, b1l), acc1, 0, 0, 0);
          } }
#pragma unroll
        for (int reg = 0; reg < 16; ++reg) { const int row = wr * 32 + crow0(reg) + 4 * h; PL[(kh * 128 + row) * 40 + r] = acc0[reg]; if (r < 4) PL[(kh * 128 + row) * 40 + 32 + r] = acc1[reg]; }
        SS[(kh * 128 + wr * 32 + r) * 2 + h] = ss;
        __syncthreads();
        int cls = 0, ea = 0, eb = 0; unsigned lrank = 0u, lra = 0u, lrb = 0u; float wlo = 0.f, whi = 0.f, rstd = 0.f;
        if (tid < 128) {
            float lg[36];
#pragma unroll
            for (int cidx = 0; cidx < 36; ++cidx) lg[cidx] = PL[tid * 40 + cidx] + PL[(128 + tid) * 40 + cidx];
            const float sq = (SS[tid * 2] + SS[tid * 2 + 1]) + (SS[(128 + tid) * 2] + SS[(128 + tid) * 2 + 1]);
            rstd = rsqrtf(sq * (1.f / D_) + EPS);
            float gl[4]; int grp_i = 0;
#pragma unroll
            for (int q = 0; q < 4; ++q) gl[q] = lg[q] * rstd + bgrp[q];
            float gm = gl[0];
#pragma unroll
            for (int q = 1; q < 4; ++q) if (gl[q] > gm) { gm = gl[q]; grp_i = q; }
            float gs = 0.f;
#pragma unroll
            for (int q = 0; q < 4; ++q) gs += __expf(gl[q] - gm);
            const float grp_gate = 1.f / gs;
            float el[8];
#pragma unroll
            for (int q = 0; q < 8; ++q) { float v = lg[4 + q]; float bb = bexp[q];
                if (grp_i == 1) { v = lg[12 + q]; bb = bexp[8 + q]; } else if (grp_i == 2) { v = lg[20 + q]; bb = bexp[16 + q]; } else if (grp_i == 3) { v = lg[28 + q]; bb = bexp[24 + q]; }
                el[q] = v * rstd + bb; }
            int i0 = 0; float v0 = el[0];
#pragma unroll
            for (int q = 1; q < 8; ++q) if (el[q] > v0) { v0 = el[q]; i0 = q; }
            int i1 = -1; float v1 = -INFINITY;
#pragma unroll
            for (int q = 0; q < 8; ++q) if (q != i0 && el[q] > v1) { v1 = el[q]; i1 = q; }
            const float e1 = __expf(v1 - v0), den = 1.f + e1, w0 = grp_gate / den, w1 = grp_gate * e1 / den;
            const int lo = i0 < i1 ? i0 : i1, hi = i0 < i1 ? i1 : i0; cls = grp_i * 28 + lo * 8 - (lo * (lo + 1)) / 2 + (hi - lo - 1);
            wlo = i0 < i1 ? w0 : w1; whi = i0 < i1 ? w1 : w0;
            ea = grp_i * 8 + lo; eb = grp_i * 8 + hi;
            lrank = __hip_atomic_fetch_add(HIST + cls, 1u, __ATOMIC_RELAXED, __HIP_MEMORY_SCOPE_WORKGROUP);
            lra = __hip_atomic_fetch_add(HIST + 112 + ea, 1u, __ATOMIC_RELAXED, __HIP_MEMORY_SCOPE_WORKGROUP); lrb = __hip_atomic_fetch_add(HIST + 112 + eb, 1u, __ATOMIC_RELAXED, __HIP_MEMORY_SCOPE_WORKGROUP);
        }
        __syncthreads();
        if (tid < 144) { const unsigned n = HIST[tid]; if (n) HIST[144 + tid] = __hip_atomic_fetch_add(cnt + tid * MOE_CS, n, __ATOMIC_RELAXED, __HIP_MEMORY_SCOPE_AGENT); }
        __syncthreads();
        if (tid < 128) {
            const unsigned rank = HIST[144 + cls] + lrank, ra = HIST[144 + 112 + ea] + lra, rb = HIST[144 + 112 + eb] + lrb;
            const int row = grp * 128 + tid;
            ((unsigned*)(ws + WS_RECC))[(size_t)cls * 32768 + rank] = (unsigned)row;
            const unsigned info = ((unsigned)cls << 16) | rank;
            ((u32x4*)(ws + WS_REC))[(size_t)ea * 32768 + ra] = (u32x4){(unsigned)row, __float_as_uint(wlo), __float_as_uint(rstd), info};
            ((u32x4*)(ws + WS_REC))[(size_t)eb * 32768 + rb] = (u32x4){(unsigned)row, __float_as_uint(whi), __float_as_uint(rstd), info | 0x8000u};
        }
        __syncthreads();
    }
}
typedef float f32x8 __attribute__((ext_vector_type(8)));
__device__ __forceinline__ void P_route2(int l_, int cbank) { const KP p = (KP)__builtin_amdgcn_kernarg_segment_ptr(); int l = l_; asm volatile("" : "+s"(l));
    int tid_ = threadIdx.x; asm volatile("" : "+v"(tid_));
    const int tid = tid_, lane = tid & 63, wave = __builtin_amdgcn_readfirstlane(tid >> 6);
    unsigned char* ws = p->ws; asm volatile("" : "+s"(ws)); const float* x = p->out;
    const float* WR = (const float*)(ws + WS_WR) + (size_t)l * D_ * 40;
    LAS float* xt = (LAS float*)lds_raw + wave * (64 * 36);
    LAS float* part = (LAS float*)lds_raw;
    const float* bgrp = p->in[16] + l * 4; const float* bexp = p->in[18] + l * 32;
    unsigned* cnt = (unsigned*)(ws + WS_CTL) + CW_MOECNT + l * 128 + cbank;
    for (int grp = launder_s((int)blockIdx.x); grp < NT / 128; grp += (int)gridDim.x) {
        const int row0 = grp * 128 + (wave >> 2) * 64, kq = wave & 3;
        float acc[40]; float ss = 0.f;
#pragma unroll
        for (int cidx = 0; cidx < 40; ++cidx) acc[cidx] = 0.f;
#pragma unroll 1
        for (int kc = 0; kc < 8; ++kc) {
            const int k0 = kq * 256 + kc * 32;
#pragma unroll
            for (int i = 0; i < 8; ++i) { const int row = i * 8 + (lane >> 3), c4 = (lane & 7) * 4; *(LAS f32x4*)(xt + row * 36 + c4) = *(const f32x4*)(x + (size_t)(row0 + row) * D_ + k0 + c4); }
            float xr[32];
#pragma unroll
            for (int j = 0; j < 8; ++j) { const f32x4 t = *(const LAS f32x4*)(xt + lane * 36 + 4 * j); xr[4 * j] = t.x; xr[4 * j + 1] = t.y; xr[4 * j + 2] = t.z; xr[4 * j + 3] = t.w; }
            const float* wk = WR + (size_t)k0 * 40;
#pragma unroll
            for (int kk = 0; kk < 32; ++kk) {
                f32x8 w0, w1, w2, w3, w4;
                asm volatile("s_load_dwordx8 %0, %5, %6\n\ts_load_dwordx8 %1, %5, %7\n\ts_load_dwordx8 %2, %5, %8\n\ts_load_dwordx8 %3, %5, %9\n\ts_load_dwordx8 %4, %5, %10\n\ts_waitcnt lgkmcnt(0)"
                             : "=&s"(w0), "=&s"(w1), "=&s"(w2), "=&s"(w3), "=&s"(w4) : "s"(wk), "i"(kk * 160), "i"(kk * 160 + 32), "i"(kk * 160 + 64), "i"(kk * 160 + 96), "i"(kk * 160 + 128) : "memory");
                const float xv = xr[kk]; ss = fmaf(xv, xv, ss);
#pragma unroll
                for (int e = 0; e < 8; ++e) { acc[e] = fmaf(xv, w0[e], acc[e]); acc[8 + e] = fmaf(xv, w1[e], acc[8 + e]); acc[16 + e] = fmaf(xv, w2[e], acc[16 + e]); acc[24 + e] = fmaf(xv, w3[e], acc[24 + e]); }
#pragma unroll
                for (int e = 0; e < 4; ++e) acc[32 + e] = fmaf(xv, w4[e], acc[32 + e]);
            }
        }
        __syncthreads();
#pragma unroll
        for (int cidx = 0; cidx < 36; ++cidx) part[(wave * 64 + lane) * 37 + cidx] = acc[cidx];
        part[(wave * 64 + lane) * 37 + 36] = ss;
        __syncthreads();
        if (tid < 128) {
            const int rg = tid >> 6, rr = tid & 63; float lg[37];
#pragma unroll
            for (int cidx = 0; cidx < 37; ++cidx) lg[cidx] = ((part[((rg * 4 + 0) * 64 + rr) * 37 + cidx] + part[((rg * 4 + 1) * 64 + rr) * 37 + cidx]) + part[((rg * 4 + 2) * 64 + rr) * 37 + cidx]) + part[((rg * 4 + 3) * 64 + rr) * 37 + cidx];
            const float rstd = rsqrtf(lg[36] * (1.f / D_) + EPS);
            float gl[4]; int grp_i = 0;
#pragma unroll
            for (int q = 0; q < 4; ++q) gl[q] = lg[q] * rstd + bgrp[q];
            float gm = gl[0];
#pragma unroll
            for (int q = 1; q < 4; ++q) if (gl[q] > gm) { gm = gl[q]; grp_i = q; }
            float gs = 0.f;
#pragma unroll
            for (int q = 0; q < 4; ++q) gs += __expf(gl[q] - gm);
            const float grp_gate = 1.f / gs;
            float el[8];
#pragma unroll
            for (int q = 0; q < 8; ++q) { float v = lg[4 + q]; float bb = bexp[q];
                if (grp_i == 1) { v = lg[12 + q]; bb = bexp[8 + q]; } else if (grp_i == 2) { v = lg[20 + q]; bb = bexp[16 + q]; } else if (grp_i == 3) { v = lg[28 + q]; bb = bexp[24 + q]; }
                el[q] = v * rstd + bb; }
            int i0 = 0; float v0 = el[0];
#pragma unroll
            for (int q = 1; q < 8; ++q) if (el[q] > v0) { v0 = el[q]; i0 = q; }
            int i1 = -1; float v1 = -INFINITY;
#pragma unroll
            for (int q = 0; q < 8; ++q) if (q != i0 && el[q] > v1) { v1 = el[q]; i1 = q; }
            const float e1 = __expf(v1 - v0), den = 1.f + e1, w0 = grp_gate / den, w1 = grp_gate * e1 / den;
            const int lo = i0 < i1 ? i0 : i1, hi = i0 < i1 ? i1 : i0, cls = grp_i * 28 + lo * 8 - (lo * (lo + 1)) / 2 + (hi - lo - 1);
            const unsigned rank = __hip_atomic_fetch_add(cnt + cls, 1u, __ATOMIC_RELAXED, __HIP_MEMORY_SCOPE_AGENT);
            const int row = grp * 128 + tid;
            ((unsigned*)(ws + WS_ROUTE + RT_INFO))[row] = ((unsigned)cls << 24) | rank;
            ((float*)(ws + WS_ROUTE + RT_W))[2 * row] = i0 < i1 ? w0 : w1; ((float*)(ws + WS_ROUTE + RT_W))[2 * row + 1] = i0 < i1 ? w1 : w0;
            ((float*)(ws + WS_ROUTE + RT_RSTD))[row] = rstd;
        }
        __syncthreads();
    }
}
__device__ __noinline__ void P_route(KP p_, int l_) { const KP p = uni_kp(p_); const int l = __builtin_amdgcn_readfirstlane(l_); const Ctx c = make_ctx(p); const Bufs b = make_bufs(p->ws);
    ph_moe_route(c, p->out, p->in[14] + (size_t)l * D_, p->in[15] + (size_t)l * D_ * 4, p->in[16] + l * 4, p->in[17] + (size_t)l * D_ * 32, p->in[18] + l * 32, b.HN, (int*)(p->ws + WS_ROUTE + RT_INFO), (float*)(p->ws + WS_ROUTE + RT_W), (unsigned*)(p->ws + WS_CTL) + CW_MOECNT + l * 128); }
__device__ __noinline__ void P_moe(KP p_, int l_) { const KP p = uni_kp(p_); const int l = __builtin_amdgcn_readfirstlane(l_); const Ctx c = make_ctx(p); const Bufs b = make_bufs(p->ws);
    ph_moe_naive(c, b.HN, b.ROUTE_E, b.ROUTE_W, p->in[19] + (size_t)l * NEXP * D_ * DEXP, p->in[20] + (size_t)l * NEXP * D_ * DEXP, p->in[21] + (size_t)l * NEXP * DEXP * D_, p->out); }
__device__ __noinline__ void P_final(KP p_) { const KP p = uni_kp(p_); const Ctx c = make_ctx(p); ph_norm_final_from_bf16(c, (const bf16*)(p->ws + WS_HN), p->in[22], p->out); }
__device__ __forceinline__ void P_gridbar(KP p_) { const KP p = uni_kp(p_);
    XcdBarrier bar; bar.bar = (unsigned*)(p->ws + WS_CTL) + 4096; bar.x = xb_xcc_id(); bar.st = (volatile LAS unsigned*)((LAS unsigned char*)lds_raw + MISC_OFF) + 8;
    xcd_barrier(bar);
}

__global__ void __launch_bounds__(NTHREADS, 2) fwd_kernel(Params pp) {
    const KP p = (KP)__builtin_amdgcn_kernarg_segment_ptr();
    { volatile LAS unsigned* MISC = (volatile LAS unsigned*)((LAS unsigned char*)lds_raw + MISC_OFF); if (threadIdx.x < 32) MISC[threadIdx.x] = 0u; }
    __syncthreads();
    const int lo = p->ph_lo, hi = p->ph_hi;
    if (hi - lo > 1) (void)xcd_barrier_post((unsigned*)(p->ws + WS_CTL) + 4096, (volatile LAS unsigned*)((LAS unsigned char*)lds_raw + MISC_OFF) + 8);
#define IN(k) (lo <= (k) && (k) < hi)
#define SEAM(k) do { if (IN(k) && IN((k) + 1)) P_gridbar(p); } while (0)
    if (IN(0)) { for (int rep = 0; rep < REP_PRO; ++rep) { if (rep) P_gridbar(p); P_prologue(p); } }
    for (int l = 0; l < L_; ++l) {
        const int P0 = 1 + l * PH_PER_LAYER;
        if (IN(P0 + 0)) { for (int rep = 0; rep < REP_NORM; ++rep) { if (rep) P_gridbar(p); P_norm1(p, l); } }
        SEAM(P0 + 0);
        if (IN(P0 + 1)) { if (l == 0) P_bias1(p);
            for (int rep = 0; rep < REP_INPROJ; ++rep) { if (rep) P_gridbar(p); P_inproj_mfma(l); }
#ifdef REP_INDUMMY
            for (int rep = 0; rep < REP_INDUMMY; ++rep) { P_gridbar(p); P_inproj_dummy(l); }
#endif
        }
        SEAM(P0 + 1);
        if (IN(P0 + 3)) {
            P_cmp1_mfma(l);
            if (launder_s((int)blockIdx.x) < 32) { asm volatile("s_waitcnt vmcnt(0)" ::: "memory"); __builtin_amdgcn_fence(__ATOMIC_SEQ_CST, "agent"); asm volatile("s_waitcnt vmcnt(0)" ::: "memory"); }
            __syncthreads();
            P_cmp2_mfma(l);
            for (int rep = 0; rep < REP_ATT3; ++rep) { if (rep) P_gridbar(p);
            for (;;) { int u = fetch_unit(p, l * 8 + 0 + 16 * rep);
                if (l == 0) {
                    if (u >= 2048 + CONV_UNITS) break;
                    const int k11 = u / 11, r11 = u - 11 * k11;
                    if (r11 == 3 || r11 == 7 || r11 == 10) { U_conv(p, 3 * k11 + (r11 > 3) + (r11 > 7)); continue; }
                    u = 8 * k11 + r11 - (r11 > 3) - (r11 > 7); }
                else if (u >= 2048) break;
                if (u < 1024) { const int qb = 15 - (u >> 6), k = u & 63; if (k < 32) U_diff(p, k, qb, l); else U_fox(p, k - 32, qb, l); }
                else { const int w = u - 1024; U_win(p, w & 15, 63 - (w >> 4));
#ifdef PROBE_WINUNIT2
                    U_win(p, w & 15, 63 - (w >> 4));
#endif
                } } } }
        SEAM(P0 + 3);
        if (IN(P0 + 4)) { for (int rep = 0; rep < REP_CMP; ++rep) { if (rep) P_gridbar(p); for (int u = launder_s((int)blockIdx.x); u < 256; u += (int)gridDim.x) U_cmp(p, u & 15, u >> 4); } }
        SEAM(P0 + 4);
        if (IN(P0 + 5)) { for (int rep = 0; rep < REP_SLC; ++rep) { if (rep) P_gridbar(p); for (;;) { const int u = fetch_unit(p, l * 8 + 1 + 16 * rep); if (u >= 1024) break; U_slc(p, u & 15, 63 - (u >> 4)); } } }
        SEAM(P0 + 5);
        if (IN(P0 + 6)) P_outproj_mfma(l);
        SEAM(P0 + 6);
        if (IN(P0 + 7)) { for (int rep = 0; rep < REP_ROUTE; ++rep) { if (rep) P_gridbar(p); P_route3(l, REP_ROUTE - 1 - rep); } }
        SEAM(P0 + 7);
        if (IN(P0 + 9)) { for (int rep = 0; rep < REP_G1; ++rep) { if (rep) P_gridbar(p); P_moe_g1(l); } }
        if (IN(P0 + 10)) P_moe_g2(l);
        SEAM(P0 + 10);
    }
    if (IN(1 + L_ * PH_PER_LAYER)) P_final(p);
#undef IN
#undef SEAM
}

extern "C" void kernel_launch(void* const* d_in, const int* in_sizes, int n_in, void* d_out, int out_size, void* d_ws, size_t ws_size, hipStream_t stream) {
    static int grid = 0;
    if (grid == 0) {
        if (n_in != 23 || out_size != NT * D_ || ws_size < WS_END) { fprintf(stderr, "kernel_launch: unexpected sizes n_in %d out %d ws %zu (need %zu)\n", n_in, out_size, ws_size, (size_t)WS_END); grid = -1; return; }
        int dev = 0, cus = 0, per_cu = 0;
        if (hipGetDevice(&dev) != hipSuccess || hipDeviceGetAttribute(&cus, hipDeviceAttributeMultiprocessorCount, dev) != hipSuccess) { grid = -1; return; }
        if (hipFuncSetAttribute((const void*)fwd_kernel, hipFuncAttributeMaxDynamicSharedMemorySize, LDS_BYTES) != hipSuccess) { fprintf(stderr, "kernel_launch: hipFuncSetAttribute failed\n"); grid = -1; return; }
        if (hipOccupancyMaxActiveBlocksPerMultiprocessor(&per_cu, (const void*)fwd_kernel, NTHREADS, LDS_BYTES) != hipSuccess || per_cu < 1) { fprintf(stderr, "kernel_launch: occupancy query says %d\n", per_cu); }
        (void)hipGetLastError();
        grid = cus;
    }
    if (grid < 0) return;
    (void)hipMemsetAsync((char*)d_ws + WS_CTL, 0, CTL_BYTES, stream);
    Params p{};
    for (int i = 0; i < 23; ++i) p.in[i] = (const float*)d_in[i];
    p.out = (float*)d_out; p.ws = (unsigned char*)d_ws;
#if N_LAUNCH_MODE == 0
    p.ph_lo = 0; p.ph_hi = N_PHASES;
    hipLaunchKernelGGL(fwd_kernel, dim3(grid), dim3(NTHREADS), LDS_BYTES, stream, p);
#else
    for (int k = 0; k < N_PHASES; ++k) { p.ph_lo = k; p.ph_hi = k + 1; hipLaunchKernelGGL(fwd_kernel, dim3(grid), dim3(NTHREADS), LDS_BYTES, stream, p); }
#endif
}
```

```cpp
#include <hip/hip_runtime.h>
#include <cstdio>
#include <cstdint>

#ifndef INPROJ_ALIGN
#define INPROJ_ALIGN true
#endif
#ifndef INPROJ_SP2
#define INPROJ_SP2 true
#endif
#ifndef REP_PRO
#define REP_PRO 1
#endif
#ifndef REP_ROUTE
#define REP_ROUTE 1
#endif
#ifndef REP_NORM
#define REP_NORM 1
#endif
#ifndef REP_INPROJ
#define REP_INPROJ 1
#endif
#ifndef REP_ATT3
#define REP_ATT3 1
#endif
#ifndef REP_CMP
#define REP_CMP 1
#endif
#ifndef REP_SLC
#define REP_SLC 1
#endif
#ifndef REP_SCAT
#define REP_SCAT 1
#endif
#ifndef REP_G1
#define REP_G1 1
#endif
#ifndef N_LAUNCH_MODE
#define N_LAUNCH_MODE 0
#endif

#ifndef NOMAX_ON
#define NOMAX_ON true
#endif
#define LAS __attribute__((address_space(3)))
#define GAS __attribute__((address_space(1)))
typedef unsigned short bf16;
typedef unsigned long long u64;
typedef float f32x4 __attribute__((ext_vector_type(4)));
typedef unsigned u32x4 __attribute__((ext_vector_type(4)));

constexpr int B_ = 8, T_ = 4096, D_ = 1024, NT = B_ * T_, L_ = 2;
constexpr int HD = 64, D_IN = 2844;
constexpr int N_CMP = 255, CMP_HID = 256;
constexpr int NEXP = 32, DEXP = 256;
constexpr float EPS = 1e-6f;
constexpr float LOG2E = 1.4426950408889634f;
constexpr int NWAVES = 8, NTHREADS = 512;

constexpr int C_NSAQ = 0, C_KV6 = 512, C_GATE = 1280, C_FQ = 1304, C_FF = 2072, C_DQ = 2076, C_DV = 2588;

constexpr size_t MiB = 1u << 20;
constexpr size_t WS_CTL = 0, CTL_BYTES = 1 * MiB;
constexpr size_t WS_QN = 1 * MiB;
constexpr size_t WS_KV6 = WS_QN + 32 * MiB;
constexpr size_t KV6_STRIDE = 8 * MiB + 64 * 1024;
constexpr size_t WS_FQKV = WS_KV6 + 6 * KV6_STRIDE;
constexpr size_t WS_DQK = WS_FQKV + 48 * MiB;
constexpr size_t WS_DV = WS_DQK + 32 * MiB;
constexpr size_t WS_GATE = WS_DV + 16 * MiB;
constexpr size_t WS_FL = WS_GATE + 3 * MiB;
constexpr size_t WS_HC = WS_FL + 1 * MiB;
constexpr size_t WS_KVCMP = WS_HC + 4 * MiB;
constexpr size_t WS_SEL = WS_KVCMP + 1 * MiB;
constexpr size_t WS_OCMP = WS_SEL + 1 * MiB;
constexpr size_t WS_OWIN = WS_OCMP + 32 * MiB;
constexpr size_t WS_HN = WS_OWIN + 32 * MiB;
constexpr size_t WS_ATT = WS_HN + 64 * MiB;
constexpr size_t WS_ROUTE = WS_ATT + 64 * MiB;
constexpr size_t WS_WIN_T = WS_ROUTE + 2 * MiB;
constexpr size_t WS_WOUT_T = WS_WIN_T + 12 * MiB;
constexpr size_t WS_WGU_T = WS_WOUT_T + 4 * MiB;
constexpr size_t WS_WD_T = WS_WGU_T + 64 * MiB;
constexpr size_t WS_W1_T = WS_WD_T + 32 * MiB;
constexpr size_t WS_W2_T = WS_W1_T + 4 * MiB;
constexpr size_t WS_BIAS1 = WS_W2_T + 512 * 1024;
constexpr size_t WS_WR = WS_BIAS1 + 512 * 1024;
constexpr size_t WS_B1PART = WS_WR + 512 * 1024;
constexpr size_t WS_END = WS_B1PART + 512 * 1024;
constexpr int MOE_MAXROWS = 61440;
constexpr size_t WS_XS = WS_QN;
constexpr size_t WS_HB = WS_OCMP;
static_assert(WS_XS + (size_t)MOE_MAXROWS * 2048 <= WS_DQK && WS_HB + (size_t)MOE_MAXROWS * 1024 <= WS_HN, "MoE aliases");
constexpr size_t RT_INFO = 0, RT_W = 128 * 1024, RT_ROWTOK = 384 * 1024, RT_ROWW = 640 * 1024, RT_RSTD = 1152 * 1024;
constexpr int CW_QUEUE = 16384, CW_MOECNT = 32768, CW_KN = 49152, MOE_CS = 32, MOE_LS = 8192;
constexpr size_t WS_REC = WS_QN;
constexpr size_t WS_RECC = WS_REC + (size_t)NEXP * 32768 * 16;
constexpr unsigned ZROW_OFF = 512 * 1024;
static_assert(WS_RECC + (size_t)112 * 32768 * 4 <= WS_DQK && WS_HN + (size_t)NT * 2048 < (1ull << 32) && CW_MOECNT + L_ * MOE_LS <= CW_KN && (112 + 2 * NEXP) * MOE_CS <= MOE_LS, "MoE record tables / 32-bit row offsets / counters");
constexpr int TBL_OFF = 131072 + 1024;
constexpr int NIN = 3072;

extern __shared__ __attribute__((aligned(16))) unsigned char lds_raw[];
__device__ __forceinline__ float bf2f(bf16 v) { return __uint_as_float(((unsigned)v) << 16); }
__device__ __forceinline__ unsigned f2bf(float f) { unsigned u = __float_as_uint(f); return (u + 0x7fffu + ((u >> 16) & 1u)) >> 16; }
__device__ __forceinline__ unsigned pk2(float lo, float hi) { return f2bf(lo) | (f2bf(hi) << 16); }
__device__ __forceinline__ float wave_sum(float v) {
#pragma unroll
    for (int o = 1; o < 64; o <<= 1) v += __shfl_xor(v, o);
    return v;
}
__device__ __forceinline__ float wave_max(float v) {
#pragma unroll
    for (int o = 1; o < 64; o <<= 1) v = fmaxf(v, __shfl_xor(v, o));
    return v;
}
__device__ __forceinline__ float shflx_f(float v, int o, int lane) { return __uint_as_float((unsigned)__builtin_amdgcn_ds_bpermute((lane ^ o) << 2, (int)__float_as_uint(v))); }
__device__ __forceinline__ unsigned shflx_u(unsigned v, int o, int lane) { return (unsigned)__builtin_amdgcn_ds_bpermute((lane ^ o) << 2, (int)v); }
__device__ __forceinline__ float wave_sum_l(float v, int lane) {
#pragma unroll
    for (int o = 1; o < 64; o <<= 1) v += shflx_f(v, o, lane);
    return v;
}
__device__ __forceinline__ int launder_s(int v) { asm volatile("" : "+s"(v)); return v; }
__device__ __forceinline__ float sigmoidf_(float x) { return 1.f / (1.f + __expf(-x)); }
__device__ __forceinline__ float log_sigmoidf_(float x) { return x >= 0.f ? -log1pf(__expf(-x)) : x - log1pf(__expf(x)); }
__device__ __forceinline__ float gelu_tanh(float x) { const float u = 0.7978845608028654f * (x + 0.044715f * x * x * x); return 0.5f * x * (1.f + tanhf(u)); }
__device__ __forceinline__ float alibi_slope(int idx1, int n) { return exp2f(-8.0f * (float)idx1 / (float)n); }

__device__ __forceinline__ constexpr int b64_off(int t, int d) { return ((t >> 4) * 2 + (d >> 5)) * 512 + (t & 15) * 32 + (d & 31); }
#define XB_TMO      128
#define XB_XCNT(j)  (256  + 64 * (j))
#define XB_XSUB(j)  (1280 + 64 * (j))
#define XB_XGEN(j)  (2304 + 64 * (j))
#define XB_TOP      3328
#define XB_TOPGEN   3392
#define XCD_BAR_WORDS 3456
#define XB_SPIN_CAP (1u << 25)
__device__ __forceinline__ unsigned xb_ld(unsigned* p)              { return __hip_atomic_load(p, __ATOMIC_RELAXED, __HIP_MEMORY_SCOPE_AGENT); }
__device__ __forceinline__ unsigned xb_add(unsigned* p, unsigned v) { return __hip_atomic_fetch_add(p, v, __ATOMIC_RELAXED, __HIP_MEMORY_SCOPE_AGENT); }
__device__ __forceinline__ unsigned xb_xcc_id() { return (unsigned)__builtin_amdgcn_s_getreg((3 << 11) | 20) & 0xFu; }
#define XB_SPIN(cond, bar) do { unsigned _sp = 0; while (cond) { __builtin_amdgcn_s_sleep(1); \
    if ((++_sp & 255u) == 0u) { if (xb_ld(&(bar)[XB_TMO])) break; if (_sp > XB_SPIN_CAP) { atomicAdd(&(bar)[XB_TMO], 1u); break; } } } } while (0)
struct XcdBarrier { unsigned* bar; unsigned x; volatile LAS unsigned* st; };
__device__ __forceinline__ XcdBarrier xcd_barrier_post(unsigned* bar, volatile LAS unsigned* st) {
    XcdBarrier b; b.bar = bar; b.x = xb_xcc_id(); b.st = st;
    if (threadIdx.x == 0) (void)xb_add(&bar[XB_XCNT(b.x)], 1u);
    return b;
}
__device__ __forceinline__ void xcd_barrier_complete(unsigned* bar, unsigned x, unsigned& nloc, unsigned& nx) {
    const unsigned G = gridDim.x * gridDim.y * gridDim.z;
    unsigned sum, cnt, mine, sp = 0u;
    for (;;) {
        sum = 0u; cnt = 0u; mine = 0u;
#pragma unroll
        for (unsigned j = 0; j < 16; ++j) { const unsigned c = xb_ld(&bar[XB_XCNT(j)]); sum += c; cnt += (c > 0u) ? 1u : 0u; mine = (j == x) ? c : mine; }
        if (sum == G) break;
        __builtin_amdgcn_s_sleep(1);
        if ((++sp & 255u) == 0u) { if (xb_ld(&bar[XB_TMO])) break; if (sp > XB_SPIN_CAP) { atomicAdd(&bar[XB_TMO], 1u); break; } }
    }
    nloc = mine > 0u ? mine : 1u; nx = cnt > 0u ? cnt : 1u;
}
__device__ __forceinline__ void xcd_barrier(const XcdBarrier& b) {
    asm volatile("s_waitcnt vmcnt(0)" ::: "memory");
    __syncthreads();
    if (threadIdx.x == 0) {
        unsigned* bar = b.bar;
        __builtin_amdgcn_s_waitcnt(0);
        unsigned nloc = b.st[0], nx = b.st[1];
        if (nloc == 0u) { xcd_barrier_complete(bar, b.x, nloc, nx); b.st[0] = nloc; b.st[1] = nx; }
        const unsigned old = xb_add(&bar[XB_XSUB(b.x)], 1u);
        const unsigned gen = old / nloc;
        if (old + 1u == (gen + 1u) * nloc) {
            __builtin_amdgcn_fence(__ATOMIC_RELEASE, "agent");
            asm volatile("s_waitcnt vmcnt(0)" ::: "memory");
            const unsigned og = xb_add(&bar[XB_TOP], 1u);
            const unsigned tg = og / nx;
            if (og + 1u == (tg + 1u) * nx) xb_add(&bar[XB_TOPGEN], 1u);
            else XB_SPIN(xb_ld(&bar[XB_TOPGEN]) == tg, bar);
            __builtin_amdgcn_fence(__ATOMIC_ACQUIRE, "agent");
            xb_add(&bar[XB_XGEN(b.x)], 1u);
            asm volatile("s_waitcnt vmcnt(0)" ::: "memory");
        } else {
            XB_SPIN(xb_ld(&bar[XB_XGEN(b.x)]) == gen, bar);
            __builtin_amdgcn_fence(__ATOMIC_ACQUIRE, "agent");
            asm volatile("s_waitcnt vmcnt(0)" ::: "memory");
        }
    }
    __syncthreads();
}

struct Params { const float* in[23]; float* out; unsigned char* ws; int ph_lo, ph_hi; };
constexpr int LDS_BYTES = 147456;
constexpr int MISC_OFF = 131072 + 320;

struct Ctx {
    LAS unsigned char* lds; int tid, lane, wave, bid, G, gw, ngw;
    const float* const* in; float* xcur; unsigned char* ws;
};

namespace pg8 {
#define PG8_LAS __attribute__((address_space(3)))
typedef unsigned short bf16_t;
typedef short bf16x8 __attribute__((ext_vector_type(8)));
typedef float f32x4 __attribute__((ext_vector_type(4)));
typedef unsigned u32x4 __attribute__((ext_vector_type(4)));
constexpr int BM = 256, BK = 64, HALF = 128, HTB = HALF * BK * 2  , STAGE_BYTES = 8 * HTB, NXCD = 8, WGM = 8;

__host__ __device__ __forceinline__ int lds_byte(int r, int c) { const int st = (r >> 4) * 2 + (c >> 5), rr = r & 15, cc = c & 31, ob = rr * 64 + cc * 2; return st * 1024 + (ob ^ (((ob >> 9) & 1) << 5)); }
__host__ __device__ __forceinline__ void stage_rc(int b, int& R, int& C) { const int st = b / 1024, sb = b % 1024, swz = sb ^ (((sb >> 9) & 1) << 5); R = (st >> 1) * 16 + swz / 64; C = (st & 1) * 32 + (swz % 64) / 2; }
__host__ __device__ __forceinline__ int perm32(int rho) { const int n = rho >> 4, i = rho & 15; return 8 * (i >> 2) + 4 * n + (i & 3); }

struct Unit { int pm, pn; const char* a; const char* b; const char* b2; };
struct Gemm { int lda, ldb, K, ksplit, arb, acb; };

__device__ __forceinline__ unsigned cvt_pk_bf16(float lo, float hi) { unsigned r; asm volatile("v_cvt_pk_bf16_f32 %0, %1, %2" : "=v"(r) : "v"(lo), "v"(hi)); return r; }
typedef float f32x2 __attribute__((ext_vector_type(2)));

template <class Epi, class Sched, bool ALIGN_EPI = false, bool SP2 = false, bool GATHER = false>
__device__ __forceinline__ void gemm_phase(PG8_LAS unsigned char* lds, const Gemm g, const Sched& S, const Epi& E) {
    static_assert(!GATHER || SP2, "GATHER is written for the SP2 loop");
    int tid_ = threadIdx.x; asm volatile("" : "+v"(tid_));
    const int tid = tid_, wid = __builtin_amdgcn_readfirstlane(tid >> 6), lane = tid & 63, wr = wid >> 2, wc = wid & 3, fr = lane & 15, fq = lane >> 4;
    const int K = g.K, nt = K / BK, ks = g.ksplit;
    unsigned voffA[2], voffB[2];
#pragma unroll
    for (int i = 0; i < 2; ++i) { int R, C; stage_rc(tid * 16 + i * 8192, R, C); const int Rb = Epi::PERM ? ((R & ~31) + perm32(R & 31)) : R;
        voffA[i] = g.arb ? (unsigned)(((R / g.arb) * (K / g.acb) + C / g.acb) * (g.arb * g.acb) + (R % g.arb) * g.acb + (C % g.acb)) * 2u : (unsigned)(R * g.lda + C) * 2u; voffB[i] = (unsigned)(Rb * g.ldb + C) * 2u; }
    const size_t kstep = (size_t)(BK * 2), kstepA = g.arb ? (size_t)(BK * g.arb * 2) : kstep;
    const size_t hsA = (size_t)HALF * (g.arb ? K : g.lda) * 2, hsB = (size_t)HALF * g.ldb * 2;
    const unsigned ldsw = (unsigned)wid * 1024u;
    const int aoff = lds_byte(wr * 64 + fr, fq * 8), boff = lds_byte(wc * 32 + fr, fq * 8);
#define PG8_SA(b, h) (((b) * 2 + (h)) * HTB)
#define PG8_SB(b, h) ((4 + (b) * 2 + (h)) * HTB)
#define PG8_STAGE(bufoff, gbase, voff) do { _Pragma("unroll") for (int _i = 0; _i < 2; ++_i) \
        __builtin_amdgcn_global_load_lds((const unsigned*)((const char*)(gbase) + (voff)[_i]), (PG8_LAS unsigned*)(lds + (bufoff) + ldsw + _i * 8192), 16, 0, 0); } while (0)
#define PG8_LDA(dst, b, h) do { _Pragma("unroll") for (int m = 0; m < 4; ++m) _Pragma("unroll") for (int k = 0; k < 2; ++k) dst[m][k] = *(const PG8_LAS bf16x8*)(lds + PG8_SA(b, h) + aoff + m * 2048 + k * 1024); } while (0)
#define PG8_LDB(dst, b, h) do { _Pragma("unroll") for (int n = 0; n < 2; ++n) _Pragma("unroll") for (int k = 0; k < 2; ++k) dst[n][k] = *(const PG8_LAS bf16x8*)(lds + PG8_SB(b, h) + boff + n * 2048 + k * 1024); } while (0)
#define PG8_MMA(ai, bj, At, Bt) do { __builtin_amdgcn_s_setprio(1); _Pragma("unroll") for (int m = 0; m < 4; ++m) _Pragma("unroll") for (int n = 0; n < 2; ++n) _Pragma("unroll") for (int k = 0; k < 2; ++k) \
        acc[ai][bj][m][n] = __builtin_amdgcn_mfma_f32_16x16x32_bf16(Bt[n][k], At[m][k], acc[ai][bj][m][n], 0, 0, 0); __builtin_amdgcn_s_setprio(0); } while (0)
#define PG8_WAIT_V(n) asm volatile("s_waitcnt vmcnt(" #n ")" ::: "memory")
#define PG8_WAIT_L(n) asm volatile("s_waitcnt lgkmcnt(" #n ")" ::: "memory")
#define PG8_BAR __builtin_amdgcn_s_barrier()
#define PG8_SCHED __builtin_amdgcn_sched_barrier(0)
    Unit cur, nxt; int ui = 0;
    if (!S.next(0, cur)) return;
    unsigned gC[2][2] = {{0u, 0u}, {0u, 0u}}, gN[2][2] = {{0u, 0u}, {0u, 0u}}; const char* gbase = nullptr;
#define PG8_GOFFS(U, Gv) do { int R_, C_; stage_rc(tid * 16, R_, C_); S.arows4(U, R_, (unsigned)C_ * 2u, Gv); } while (0)
#define PG8_STAGE_G(bufoff, kbyte, Gv, h) do { _Pragma("unroll") for (int _i = 0; _i < 2; ++_i) \
        __builtin_amdgcn_global_load_lds((const unsigned*)(gbase + (size_t)(kbyte) + Gv[h][_i]), (PG8_LAS unsigned*)(lds + (bufoff) + ldsw + _i * 8192), 16, 0, 0); } while (0)
    if constexpr (GATHER) { gbase = S.abase(); PG8_GOFFS(cur, gC); }
    f32x4 acc[2][2][4][2];
#pragma unroll
    for (int a = 0; a < 2; ++a)
#pragma unroll
        for (int b = 0; b < 2; ++b)
#pragma unroll
            for (int m = 0; m < 4; ++m)
#pragma unroll
                for (int n = 0; n < 2; ++n) acc[a][b][m][n] = (f32x4){0.f, 0.f, 0.f, 0.f};
    bf16x8 At[4][2], B0[2][2], B1[2][2];
    const char* cA = cur.a; const char* cB = cur.b; const char* cB2 = cur.b2;
#define PG8_BK(base, base2, kt) ((kt) < ks ? (base) + (size_t)(kt) * kstep : (base2) + (size_t)((kt) - ks) * kstep)
    S.a_ready(cur);
    if constexpr (SP2) {
        PG8_STAGE(PG8_SB(0, 0), cB, voffB); PG8_STAGE(PG8_SB(0, 1), cB + hsB, voffB);
        if constexpr (GATHER) { PG8_STAGE_G(PG8_SA(0, 0), 0, gC, 0); PG8_STAGE_G(PG8_SA(0, 1), 0, gC, 1); } else { PG8_STAGE(PG8_SA(0, 0), cA, voffA); PG8_STAGE(PG8_SA(0, 1), cA + hsA, voffA); }
        if (wr == 1) PG8_BAR;
        PG8_WAIT_V(2); PG8_BAR;
        PG8_STAGE(PG8_SB(1, 0), PG8_BK(cB, cB2, 1), voffB);
        if constexpr (GATHER) PG8_STAGE_G(PG8_SA(1, 0), kstep, gC, 0); else PG8_STAGE(PG8_SA(1, 0), cA + kstepA, voffA);
        PG8_STAGE(PG8_SB(1, 1), PG8_BK(cB, cB2, 1) + hsB, voffB);
        PG8_WAIT_V(6); PG8_BAR;
    } else {
        PG8_STAGE(PG8_SB(0, 0), cB, voffB); PG8_STAGE(PG8_SA(0, 0), cA, voffA); PG8_STAGE(PG8_SB(0, 1), cB + hsB, voffB); PG8_STAGE(PG8_SA(0, 1), cA + hsA, voffA);
        if (wr == 1) PG8_BAR;
        PG8_WAIT_V(4); PG8_BAR;
        PG8_STAGE(PG8_SB(1, 0), PG8_BK(cB, cB2, 1), voffB); PG8_STAGE(PG8_SA(1, 0), cA + kstepA, voffA); PG8_STAGE(PG8_SB(1, 1), PG8_BK(cB, cB2, 1) + hsB, voffB);
        PG8_WAIT_V(6); PG8_BAR;
    }
    for (;;) {
        const bool has_next = S.next(ui + 1, nxt);
        if constexpr (GATHER) { if (has_next) PG8_GOFFS(nxt, gN); else { _Pragma("unroll") for (int _h = 0; _h < 2; ++_h) _Pragma("unroll") for (int _i = 0; _i < 2; ++_i) gN[_h][_i] = gC[_h][_i]; } }
        const char* nA = has_next ? nxt.a : cA; const char* nB = has_next ? nxt.b : cB; const char* nB2 = has_next ? nxt.b2 : cB2;
#pragma unroll 1
        for (int t = 0; t < nt; t += 2) {
            const bool last = (t == nt - 2);
            const char* a1 = cA + (size_t)(t + 1) * kstepA;
            const char* a2 = last ? nA : cA + (size_t)(t + 2) * kstepA; const char* b2 = last ? PG8_BK(nB, nB2, 0) : PG8_BK(cB, cB2, t + 2);
            const char* a3 = a2 + kstepA; const char* b3 = last ? PG8_BK(nB, nB2, 1) : PG8_BK(cB, cB2, t + 3);
            if (last && has_next) S.a_ready(nxt);
            if constexpr (SP2) {
            PG8_LDB(B0, 0, 0); PG8_LDB(B1, 0, 1); PG8_SCHED; PG8_LDA(At, 0, 0);
            if constexpr (GATHER) PG8_STAGE_G(PG8_SA(1, 1), (size_t)(t + 1) * kstep, gC, 1); else PG8_STAGE(PG8_SA(1, 1), a1 + hsA, voffA);
            PG8_WAIT_V(8); PG8_WAIT_L(0); PG8_BAR; PG8_MMA(0, 0, At, B0); PG8_MMA(0, 1, At, B1); PG8_BAR; PG8_SCHED;
            PG8_LDA(At, 0, 1); PG8_STAGE(PG8_SB(0, 0), b2, voffB); PG8_STAGE(PG8_SB(0, 1), b2 + hsB, voffB);
            if constexpr (GATHER) { if (last) PG8_STAGE_G(PG8_SA(0, 0), 0, gN, 0); else PG8_STAGE_G(PG8_SA(0, 0), (size_t)(t + 2) * kstep, gC, 0); } else PG8_STAGE(PG8_SA(0, 0), a2, voffA);
            PG8_WAIT_V(8); PG8_WAIT_L(0); PG8_BAR; PG8_MMA(1, 0, At, B0); PG8_MMA(1, 1, At, B1); PG8_BAR; PG8_SCHED;
            PG8_LDB(B0, 1, 0); PG8_LDB(B1, 1, 1); PG8_SCHED; PG8_LDA(At, 1, 0);
            if constexpr (GATHER) { if (last) PG8_STAGE_G(PG8_SA(0, 1), 0, gN, 1); else PG8_STAGE_G(PG8_SA(0, 1), (size_t)(t + 2) * kstep, gC, 1); } else PG8_STAGE(PG8_SA(0, 1), a2 + hsA, voffA);
            PG8_WAIT_V(8); PG8_WAIT_L(0); PG8_BAR; PG8_MMA(0, 0, At, B0); PG8_MMA(0, 1, At, B1); PG8_BAR; PG8_SCHED;
            PG8_LDA(At, 1, 1); PG8_STAGE(PG8_SB(1, 0), b3, voffB); PG8_STAGE(PG8_SB(1, 1), b3 + hsB, voffB);
            if constexpr (GATHER) { if (last) PG8_STAGE_G(PG8_SA(1, 0), kstep, gN, 0); else PG8_STAGE_G(PG8_SA(1, 0), (size_t)(t + 3) * kstep, gC, 0); } else PG8_STAGE(PG8_SA(1, 0), a3, voffA);
            PG8_WAIT_V(8); PG8_WAIT_L(0); PG8_BAR; PG8_MMA(1, 0, At, B0); PG8_MMA(1, 1, At, B1); PG8_BAR; PG8_SCHED;
            } else {
            PG8_LDB(B0, 0, 0); PG8_SCHED; PG8_LDA(At, 0, 0); PG8_STAGE(PG8_SA(1, 1), a1 + hsA, voffA);
            PG8_WAIT_L(8); PG8_BAR; PG8_WAIT_L(0); PG8_MMA(0, 0, At, B0); PG8_BAR; PG8_SCHED;
            PG8_LDB(B1, 0, 1); PG8_STAGE(PG8_SB(0, 0), b2, voffB);
            PG8_BAR; PG8_WAIT_L(0); PG8_MMA(0, 1, At, B1); PG8_BAR;
            PG8_LDA(At, 0, 1); PG8_STAGE(PG8_SA(0, 0), a2, voffA);
            PG8_BAR; PG8_WAIT_L(0); PG8_MMA(1, 0, At, B0); PG8_BAR; PG8_SCHED;
            PG8_STAGE(PG8_SB(0, 1), b2 + hsB, voffB);
            PG8_WAIT_V(6); PG8_BAR; PG8_MMA(1, 1, At, B1); PG8_BAR;
            PG8_LDB(B0, 1, 0); PG8_SCHED; PG8_LDA(At, 1, 0); PG8_STAGE(PG8_SA(0, 1), a2 + hsA, voffA);
            PG8_WAIT_L(8); PG8_BAR; PG8_WAIT_L(0); PG8_MMA(0, 0, At, B0); PG8_BAR; PG8_SCHED;
            PG8_LDB(B1, 1, 1); PG8_STAGE(PG8_SB(1, 0), b3, voffB);
            PG8_BAR; PG8_WAIT_L(0); PG8_MMA(0, 1, At, B1); PG8_BAR;
            PG8_LDA(At, 1, 1); PG8_STAGE(PG8_SA(1, 0), a3, voffA);
            PG8_BAR; PG8_WAIT_L(0); PG8_MMA(1, 0, At, B0); PG8_BAR; PG8_SCHED;
            PG8_STAGE(PG8_SB(1, 1), b3 + hsB, voffB);
            PG8_WAIT_V(6); PG8_BAR; PG8_MMA(1, 1, At, B1); PG8_BAR;
            }
        }
        if constexpr (ALIGN_EPI) { if (wr == 0) PG8_BAR; }
        if constexpr (!Epi::AFTER_DRAIN) { E(acc, cur, wr, wc, fr, fq); S.done(cur); }
        if (!has_next) break;
#pragma unroll
        for (int a = 0; a < 2; ++a)
#pragma unroll
            for (int b = 0; b < 2; ++b)
#pragma unroll
                for (int m = 0; m < 4; ++m)
#pragma unroll
                    for (int n = 0; n < 2; ++n) acc[a][b][m][n] = (f32x4){0.f, 0.f, 0.f, 0.f};
        cur = nxt; cA = nA; cB = nB; cB2 = nB2; ++ui;
        if constexpr (GATHER) { _Pragma("unroll") for (int _h = 0; _h < 2; ++_h) _Pragma("unroll") for (int _i = 0; _i < 2; ++_i) gC[_h][_i] = gN[_h][_i]; }
        if constexpr (ALIGN_EPI) { if (wr == 1) PG8_BAR; }
    }
    PG8_WAIT_V(0);
    if constexpr (!ALIGN_EPI) { if (wr == 0) PG8_BAR; }
    PG8_BAR;
    if constexpr (Epi::AFTER_DRAIN) { E.fused(acc, cur, wr, wc, fr, fq, lds, wid, lane); S.done(cur); }
#undef PG8_BK
#undef PG8_GOFFS
#undef PG8_STAGE_G
#undef PG8_SA
#undef PG8_SB
#undef PG8_STAGE
#undef PG8_LDA
#undef PG8_LDB
#undef PG8_MMA
#undef PG8_WAIT_V
#undef PG8_WAIT_L
#undef PG8_BAR
#undef PG8_SCHED
}
}

struct PlainOrder {
    const char* A; const char* Bt; int lda, ldb, nM, nN, nwg, G, c;
    __device__ __forceinline__ void init(const void* A_, const void* Bt_, int lda_, int ldb_, int M, int N, int G_, int c_) { A = (const char*)A_; Bt = (const char*)Bt_; lda = lda_; ldb = ldb_; nM = M / 256; nN = N / 256; nwg = nM * nN; G = G_; c = c_; }
    __device__ __forceinline__ bool next(int i, pg8::Unit& u) const {
        const long L = (long)i * G + c; if (L >= nwg) return false;
        int wgid = (int)L; { const int q = nwg / 8, r = nwg % 8, xcd = wgid % 8, off = wgid / 8; wgid = (xcd < r ? xcd * (q + 1) : r * (q + 1) + (xcd - r) * q) + off; }
        const int nig = 8 * nN, gid = wgid / nig, fm = gid * 8, gsz = (nM - fm) < 8 ? (nM - fm) : 8;
        u.pm = fm + ((wgid % nig) % gsz); u.pn = (wgid % nig) / gsz;
        u.a = A + (size_t)u.pm * 256 * lda * 2; u.b = Bt + (size_t)u.pn * 256 * ldb * 2; u.b2 = u.b; return true;
    }
    __device__ __forceinline__ void a_ready(const pg8::Unit&) const {}
    __device__ __forceinline__ void done(const pg8::Unit&) const {}
};
struct EpiInProj {
    static constexpr bool PERM = true, AFTER_DRAIN = false;
    unsigned char* ws; const float* b_gate; const float* b_fgt; unsigned* kn;
    __device__ __forceinline__ void operator()(const pg8::f32x4 (&acc)[2][2][4][2], const pg8::Unit& u, int wr, int wc, int fr, int fq) const {
        { int t_ = threadIdx.x; asm volatile("" : "+v"(t_)); fr = t_ & 15; fq = (t_ >> 4) & 3; }
        const int pn = u.pn, b = (u.pm * 256) / T_, t0 = u.pm * 256 - b * T_ + wr * 64 + fr;
        if (pn == 11) {
            if (wc == 0 && fq < 4) {
                float* gate = (float*)(ws + WS_GATE); float* fl = (float*)(ws + WS_FL);
#pragma unroll
                for (int ai = 0; ai < 2; ++ai)
#pragma unroll
                    for (int m = 0; m < 4; ++m) { const int t = t0 + ai * 128 + m * 16; const size_t n = (size_t)b * T_ + t;
#pragma unroll
                        for (int nn = 0; nn < 2; ++nn)
#pragma unroll
                            for (int e = 0; e < 4; ++e) { const int c = 8 * fq + 4 * nn + e; const float v = acc[ai][0][m][nn][e];
                                if (c < 24) gate[n * 24 + c] = __builtin_amdgcn_rcpf(1.f + __builtin_amdgcn_exp2f(-(v + b_gate[c]) * LOG2E));
                                else if (c < 28) { const float z = v + b_fgt[c - 24];
                                    fl[(size_t)(b * 4 + (c - 24)) * T_ + t] = z < -30.f ? z : -0.6931471805599453f * __builtin_amdgcn_logf(1.f + __builtin_amdgcn_exp2f(-z * LOG2E)); } } }
            }
            return;
        }
        if (pn == 6 || pn == 9) {
            const int lane_ = (fq << 4) | fr;
#pragma unroll
            for (int bj = 0; bj < 2; ++bj)
#pragma unroll
                for (int ai = 0; ai < 2; ++ai) { float mx = 0.f;
#pragma unroll
                    for (int m = 0; m < 4; ++m) { const pg8::f32x4 v0 = acc[ai][bj][m][0], v1 = acc[ai][bj][m][1];
                        float ss = (v0[0] * v0[0] + v0[1] * v0[1]) + (v0[2] * v0[2] + v0[3] * v0[3]) + (v1[0] * v1[0] + v1[1] * v1[1]) + (v1[2] * v1[2] + v1[3] * v1[3]);
                        ss += shflx_f(ss, 16, lane_); ss += shflx_f(ss, 32, lane_); mx = fmaxf(mx, ss); }
#pragma unroll
                    for (int o = 1; o < 16; o <<= 1) mx = fmaxf(mx, shflx_f(mx, o, lane_));
                    if (lane_ == 0) { const int cg = bj * 4 + wc, tile = (u.pm * 256 - b * T_ + ai * 128 + wr * 64) >> 6;
                        unsigned* dst = pn == 6 ? kn + ((b * 4 + (cg >> 1)) * 64 + tile) * 2 + (cg & 1) : kn + 4096 + (b * 8 + cg) * 64 + tile;
                        atomicMax(dst, __float_as_uint(mx)); } }
        }
#pragma unroll
        for (int bj = 0; bj < 2; ++bj) {
            const int c = bj * 128 + wc * 32 + 8 * fq;
            bf16* base; int W = 64; float sc = 1.f;
            if (pn < 2) { base = (bf16*)(ws + WS_QN) + (size_t)(b * 8 + pn * 4 + (c >> 6)) * T_ * 64 + (c & 63); sc = 0.125f * LOG2E; }
            else if (pn < 5) { base = (bf16*)(ws + WS_KV6 + (size_t)((pn - 2) * 2 + (c >> 7)) * KV6_STRIDE) + (size_t)(b * 2 + ((c >> 6) & 1)) * T_ * 64 + (c & 63); }
            else if (pn < 8) { base = (bf16*)(ws + WS_FQKV) + (size_t)(pn - 5) * (8 * MiB) + (size_t)(b * 4 + (c >> 6)) * T_ * 64 + (c & 63); if (pn == 5) sc = 0.125f * LOG2E; }
            else if (pn < 10) { base = (bf16*)(ws + WS_DQK) + (size_t)(pn - 8) * (8 * MiB) + (size_t)(b * 8 + (c >> 5)) * T_ * 32 + (c & 31); W = 32; if (pn == 8) sc = 0.17677669529663687f * LOG2E; }
            else { base = (bf16*)(ws + WS_DV) + (size_t)(b * 4 + (c >> 6)) * T_ * 64 + (c & 63); }
            const bool blk = W == 64 && pn != 2;
            if (blk) base += -(c & 63) + ((c >> 5) & 1) * 512 + (c & 31);
#pragma unroll
            for (int ai = 0; ai < 2; ++ai)
#pragma unroll
                for (int m = 0; m < 4; ++m) { const int t = t0 + ai * 128 + m * 16;
                    const pg8::f32x4 v0 = acc[ai][bj][m][0] * sc, v1 = acc[ai][bj][m][1] * sc;
                    pg8::u32x4 w; w.x = pg8::cvt_pk_bf16(v0[0], v0[1]); w.y = pg8::cvt_pk_bf16(v0[2], v0[3]); w.z = pg8::cvt_pk_bf16(v1[0], v1[1]); w.w = pg8::cvt_pk_bf16(v1[2], v1[3]);
                    *(pg8::u32x4*)(base + (blk ? (size_t)((t >> 4) * 1024 + (t & 15) * 32) : (size_t)t * W)) = w; }
        }
    }
};
__device__ __forceinline__ u32x4 res_add8(u32x4 w, const pg8::f32x4& a0, const pg8::f32x4& a1) {
    u32x4 o;
    o.x = pg8::cvt_pk_bf16(__uint_as_float(w.x << 16) + a0[0], __uint_as_float(w.x & 0xffff0000u) + a0[1]); o.y = pg8::cvt_pk_bf16(__uint_as_float(w.y << 16) + a0[2], __uint_as_float(w.y & 0xffff0000u) + a0[3]);
    o.z = pg8::cvt_pk_bf16(__uint_as_float(w.z << 16) + a1[0], __uint_as_float(w.z & 0xffff0000u) + a1[1]); o.w = pg8::cvt_pk_bf16(__uint_as_float(w.w << 16) + a1[2], __uint_as_float(w.w & 0xffff0000u) + a1[3]);
    return o;
}
struct EpiResBf16 {
    static constexpr bool PERM = true, AFTER_DRAIN = false;
    bf16* xr;
    __device__ __forceinline__ void operator()(const pg8::f32x4 (&acc)[2][2][4][2], const pg8::Unit& u, int wr, int wc, int fr, int fq) const {
        { int t_ = threadIdx.x; asm volatile("" : "+v"(t_)); fr = t_ & 15; fq = (t_ >> 4) & 3; }
#pragma unroll
        for (int ai = 0; ai < 2; ++ai)
#pragma unroll
            for (int m = 0; m < 4; ++m) { const size_t off = (size_t)(u.pm * 256 + ai * 128 + wr * 64 + m * 16 + fr) * D_ + u.pn * 256 + wc * 32 + 8 * fq;
#pragma unroll
                for (int bj = 0; bj < 2; ++bj) { u32x4* q = (u32x4*)(xr + off + bj * 128); *q = res_add8(*q, acc[ai][bj][m][0], acc[ai][bj][m][1]); } }
    }
};


struct EpiDummy {
    static constexpr bool PERM = true, AFTER_DRAIN = false;
    float* dst;
    __device__ __forceinline__ void operator()(const pg8::f32x4 (&acc)[2][2][4][2], const pg8::Unit& u, int wr, int wc, int fr, int fq) const {
        pg8::f32x4 a = {0.f, 0.f, 0.f, 0.f};
#pragma unroll
        for (int ai = 0; ai < 2; ++ai)
#pragma unroll
            for (int bj = 0; bj < 2; ++bj)
#pragma unroll
                for (int m = 0; m < 4; ++m) { a = a + acc[ai][bj][m][0]; a = a + acc[ai][bj][m][1]; }
        *(pg8::f32x4*)(dst + ((size_t)(u.pm * 12 + u.pn) * 512 + threadIdx.x) * 4) = a;
    }
};
struct OneUnitOrder { pg8::Unit u; bool has;
    __device__ __forceinline__ bool next(int i, pg8::Unit& o) const { if (i != 0 || !has) return false; o = u; return true; }
    __device__ __forceinline__ void a_ready(const pg8::Unit&) const {}
    __device__ __forceinline__ void done(const pg8::Unit&) const {} };
__device__ __forceinline__ float gelu_tanh_fast(float x) { const float u2 = 1.5957691216057308f * (x + 0.044715f * x * x * x); return x * __builtin_amdgcn_rcpf(1.f + __builtin_amdgcn_exp2f(-u2 * LOG2E)); }
struct EpiCmpH {
    static constexpr bool PERM = true, AFTER_DRAIN = false;
    bf16* hc; const float* bias1;
    __device__ __forceinline__ void operator()(const pg8::f32x4 (&acc)[2][2][4][2], const pg8::Unit& u, int wr, int wc, int fr, int fq) const {
        { int t_ = threadIdx.x; asm volatile("" : "+v"(t_)); fr = t_ & 15; fq = (t_ >> 4) & 3; }
        const int kv = u.pn;
#pragma unroll
        for (int bj = 0; bj < 2; ++bj) { const int col = bj * 128 + wc * 32 + 8 * fq;
            const pg8::f32x4 b0 = *(const pg8::f32x4*)(bias1 + kv * 256 + col), b1 = *(const pg8::f32x4*)(bias1 + kv * 256 + col + 4);
#pragma unroll
            for (int ai = 0; ai < 2; ++ai)
#pragma unroll
                for (int m = 0; m < 4; ++m) { const int row = u.pm * 256 + ai * 128 + wr * 64 + m * 16 + fr;
                    const pg8::f32x4 v0 = acc[ai][bj][m][0] + b0, v1 = acc[ai][bj][m][1] + b1;
                    pg8::u32x4 w; w.x = pg8::cvt_pk_bf16(gelu_tanh_fast(v0[0]), gelu_tanh_fast(v0[1])); w.y = pg8::cvt_pk_bf16(gelu_tanh_fast(v0[2]), gelu_tanh_fast(v0[3]));
                    w.z = pg8::cvt_pk_bf16(gelu_tanh_fast(v1[0]), gelu_tanh_fast(v1[1])); w.w = pg8::cvt_pk_bf16(gelu_tanh_fast(v1[2]), gelu_tanh_fast(v1[3]));
                    *(pg8::u32x4*)(hc + ((size_t)kv * 4096 + row) * 256 + col) = w; } }
    }
};
struct EpiCmpOut {
    static constexpr bool PERM = true, AFTER_DRAIN = false;
    bf16* kvcmp;
    __device__ __forceinline__ void operator()(const pg8::f32x4 (&acc)[2][2][4][2], const pg8::Unit& u, int wr, int wc, int fr, int fq) const {
        { int t_ = threadIdx.x; asm volatile("" : "+v"(t_)); fr = t_ & 15; fq = (t_ >> 4) & 3; }
        if (wc >= 2) return;
        const int kv = u.pn, col = wc * 32 + 8 * fq;
#pragma unroll
        for (int ai = 0; ai < 2; ++ai)
#pragma unroll
            for (int m = 0; m < 4; ++m) { const int row = u.pm * 256 + ai * 128 + wr * 64 + m * 16 + fr; const float z = ((row & 255) == 255) ? 0.f : 1.f;
                const pg8::f32x4 v0 = acc[ai][0][m][0], v1 = acc[ai][0][m][1];
                pg8::u32x4 w; w.x = pg8::cvt_pk_bf16(z != 0.f ? v0[0] : 0.f, z != 0.f ? v0[1] : 0.f); w.y = pg8::cvt_pk_bf16(z != 0.f ? v0[2] : 0.f, z != 0.f ? v0[3] : 0.f);
                w.z = pg8::cvt_pk_bf16(z != 0.f ? v1[0] : 0.f, z != 0.f ? v1[1] : 0.f); w.w = pg8::cvt_pk_bf16(z != 0.f ? v1[2] : 0.f, z != 0.f ? v1[3] : 0.f);
                *(pg8::u32x4*)(kvcmp + ((size_t)kv * 4096 + row) * 64 + col) = w; }
    }
};

__device__ __forceinline__ void moe_build_tables(const unsigned* cnt, int tid) {
    LAS int* T = (LAS int*)((LAS unsigned char*)lds_raw + TBL_OFF);
    __syncthreads();
    if (tid < 112) T[384 + tid] = (int)cnt[tid * MOE_CS];
    else if (tid >= 128 && tid < 128 + NEXP) T[560 + tid - 128] = (int)cnt[(112 + tid - 128) * MOE_CS];
    __syncthreads();
    if (tid == 0) { int o = 0; _Pragma("clang loop unroll(disable)") for (int c = 0; c < 112; ++c) { T[c] = o; const int n = (T[384 + c] + 255) >> 8;
            _Pragma("clang loop vectorize(disable) unroll(disable)") for (int k = 0; k < n; ++k) T[128 + o + k] = c;
            o += n; } T[112] = o; }
    if (tid == 64) { int o = 0; _Pragma("clang loop unroll(disable)") for (int e = 0; e < NEXP; ++e) { T[512 + e] = o; const int n = (T[560 + e] + 255) >> 8;
            _Pragma("clang loop vectorize(disable) unroll(disable)") for (int k = 0; k < n; ++k) T[608 + o + k] = e;
            o += n; } T[544] = o; }
    __syncthreads();
}
__device__ __forceinline__ void moe_pair(int cls, int& ea, int& eb) { const int grp = cls / 28; int idx = cls % 28, lo = 0; while (idx >= 7 - lo) { idx -= 7 - lo; ++lo; } ea = grp * 8 + lo; eb = grp * 8 + lo + 1 + idx; }
struct MoeOrder1 {
    const char* wsb; const unsigned* rec; const char* wgu; unsigned* edone; int G, c;
    __device__ __forceinline__ bool next(int i, pg8::Unit& u) const {
        const LAS int* T = (const LAS int*)((LAS unsigned char*)lds_raw + TBL_OFF);
        const int idx = i * G + c; if (idx >= 2 * T[544]) return false;
        const int tile = idx >> 1, pn = idx & 1, e = T[608 + tile];
        u.pm = tile; u.pn = pn; u.a = wsb; u.b = wgu + ((size_t)e * 512 + pn * 256) * 2048; u.b2 = u.b; return true; }
    __device__ __forceinline__ const char* abase() const { return wsb; }
    __device__ __forceinline__ void arows4(const pg8::Unit& u, int r0, unsigned cb, unsigned (&g)[2][2]) const {
        const LAS int* T = (const LAS int*)((LAS unsigned char*)lds_raw + TBL_OFF);
        const int e = T[608 + u.pm], base = (u.pm - T[512 + e]) * 256 + r0, n = T[560 + e];
        const unsigned ob = (unsigned)(e * 32768 + base) * 16u;
#pragma unroll
        for (int k = 0; k < 4; ++k) { unsigned off = ZROW_OFF; if (base + 64 * k < n) off = (unsigned)WS_HN + *(const unsigned*)((const char*)rec + (ob + 1024u * k)) * 2048u; g[k >> 1][k & 1] = off + cb; } }
    __device__ __forceinline__ void a_ready(const pg8::Unit&) const {}
    __device__ __forceinline__ void done(const pg8::Unit& u) const {
        asm volatile("s_waitcnt vmcnt(0)" ::: "memory");
        const LAS int* T = (const LAS int*)((LAS unsigned char*)lds_raw + TBL_OFF);
        int t_ = threadIdx.x; asm volatile("" : "+v"(t_));
        if ((t_ & 63) == 0) (void)__hip_atomic_fetch_add(edone + T[608 + u.pm] * MOE_CS, 1u, __ATOMIC_RELAXED, __HIP_MEMORY_SCOPE_AGENT); } };
struct MoeOrder2 {
    const char* hb; const char* wd; const unsigned* edone; unsigned* tmo; int G, c;
    __device__ __forceinline__ bool next(int i, pg8::Unit& u) const {
        const LAS int* T = (const LAS int*)((LAS unsigned char*)lds_raw + TBL_OFF);
        const int n1 = (2 * T[544]) % G, idx = i * G + (c >= n1 ? c - n1 : c - n1 + G); if (idx >= 4 * T[112]) return false;
        const int tile = idx >> 2, pn = idx & 3; int ea, eb; moe_pair(T[128 + tile], ea, eb);
        u.pm = tile; u.pn = pn; u.a = hb + (size_t)tile * 256 * 1024; u.b = wd + ((size_t)ea * 1024 + pn * 256) * 512; u.b2 = wd + ((size_t)eb * 1024 + pn * 256) * 512; return true; }
    __device__ __forceinline__ void a_ready(const pg8::Unit& u) const {
        int t_ = threadIdx.x; asm volatile("" : "+v"(t_));
        if (t_ < 64) {
            const LAS int* T = (const LAS int*)((LAS unsigned char*)lds_raw + TBL_OFF);
            int ea, eb; moe_pair(T[128 + u.pm], ea, eb);
            const unsigned na = 16u * (unsigned)((T[560 + ea] + 255) >> 8), nb = 16u * (unsigned)((T[560 + eb] + 255) >> 8);
            unsigned polls = 0u;
            while ((unsigned)__builtin_amdgcn_readfirstlane(__hip_atomic_load(edone + ea * MOE_CS, __ATOMIC_RELAXED, __HIP_MEMORY_SCOPE_AGENT)) < na ||
                   (unsigned)__builtin_amdgcn_readfirstlane(__hip_atomic_load(edone + eb * MOE_CS, __ATOMIC_RELAXED, __HIP_MEMORY_SCOPE_AGENT)) < nb) {
                if ((++polls & 255u) == 0u) { if (__builtin_amdgcn_readfirstlane(__hip_atomic_load(tmo, __ATOMIC_RELAXED, __HIP_MEMORY_SCOPE_AGENT)) != 0u) break;
                    if (polls > (1u << 22)) { if (t_ == 0) __hip_atomic_store(tmo, 1u, __ATOMIC_RELAXED, __HIP_MEMORY_SCOPE_AGENT); break; } }
                __builtin_amdgcn_s_sleep(2); }
            __builtin_amdgcn_fence(__ATOMIC_ACQUIRE, "agent");
            asm volatile("s_waitcnt vmcnt(0)" ::: "memory");
        }
        asm volatile("" ::: "memory"); __builtin_amdgcn_s_barrier(); asm volatile("" ::: "memory");
    }
    __device__ __forceinline__ void done(const pg8::Unit&) const {} };
struct EpiMoeH {
    static constexpr bool PERM = true, AFTER_DRAIN = false;
    bf16* hb; const u32x4* rec;
    __device__ __forceinline__ void operator()(const pg8::f32x4 (&acc)[2][2][4][2], const pg8::Unit& u, int wr, int wc, int fr, int fq) const {
        { int t_ = threadIdx.x; asm volatile("" : "+v"(t_)); fr = t_ & 15; fq = (t_ >> 4) & 3; }
        const LAS int* T = (const LAS int*)((LAS unsigned char*)lds_raw + TBL_OFF);
        const int ex = T[608 + u.pm], vr0 = (u.pm - T[512 + ex]) * 256, nex = T[560 + ex];
#pragma unroll
        for (int ai = 0; ai < 2; ++ai) {
#pragma unroll
            for (int m = 0; m < 4; ++m) { const int rr = ai * 128 + wr * 64 + m * 16 + fr; const bool valid = vr0 + rr < nex;
                const u32x4 q = *(const u32x4*)((const char*)rec + (unsigned)(ex * 32768 + vr0 + rr) * 16u); const float w = __uint_as_float(q.y), rs = __uint_as_float(q.z);
                const int slot = (int)((q.w >> 15) & 1u); const unsigned row = (unsigned)T[valid ? (q.w >> 16) : 0u] * 256u + (q.w & 0x7fffu);
#pragma unroll
                for (int bj = 0; bj < 2; ++bj) { const int j0 = (u.pn & 1) * 128 + (bj * 128 + wc * 32 + 8 * fq) / 2;
                    pg8::f32x4 v0 = acc[ai][bj][m][0], v1 = acc[ai][bj][m][1];
#pragma unroll
                    for (int e = 0; e < 4; ++e) { v0[e] *= rs; v1[e] *= rs; }
                    const float h0 = v0[0] * __builtin_amdgcn_rcpf(1.f + __builtin_amdgcn_exp2f(-v0[0] * LOG2E)) * v0[1] * w, h1 = v0[2] * __builtin_amdgcn_rcpf(1.f + __builtin_amdgcn_exp2f(-v0[2] * LOG2E)) * v0[3] * w;
                    const float h2 = v1[0] * __builtin_amdgcn_rcpf(1.f + __builtin_amdgcn_exp2f(-v1[0] * LOG2E)) * v1[1] * w, h3 = v1[2] * __builtin_amdgcn_rcpf(1.f + __builtin_amdgcn_exp2f(-v1[2] * LOG2E)) * v1[3] * w;
                    const int jg = slot * 256 + j0;
                    if (valid) __hip_atomic_store((u64*)((char*)hb + (((row >> 4) * 32u + (unsigned)(jg >> 4)) * 256u + (row & 15u) * 16u + (unsigned)(jg & 15)) * 2u), (u64)pg8::cvt_pk_bf16(h0, h1) | ((u64)pg8::cvt_pk_bf16(h2, h3) << 32),
                                                  __ATOMIC_RELAXED, __HIP_MEMORY_SCOPE_AGENT); }
            }
            asm volatile("" ::: "memory"); }
    }
};
struct EpiMoeOut {
    static constexpr bool PERM = true, AFTER_DRAIN = false;
    bf16* x; const unsigned* rec;
    __device__ __forceinline__ void operator()(const pg8::f32x4 (&acc)[2][2][4][2], const pg8::Unit& u, int wr, int wc, int fr, int fq) const {
        { int t_ = threadIdx.x; asm volatile("" : "+v"(t_)); fr = t_ & 15; fq = (t_ >> 4) & 3; }
        bf16* xx = x; const unsigned* rt = rec; asm volatile("" : "+s"(xx), "+s"(rt));
        const LAS int* T = (const LAS int*)((LAS unsigned char*)lds_raw + TBL_OFF);
        const int cls = T[128 + u.pm], vr0 = (u.pm - T[cls]) * 256, ncls = T[384 + cls];
#pragma unroll
        for (int ai = 0; ai < 2; ++ai)
#pragma unroll
            for (int m = 0; m < 4; ++m) { const int rr = ai * 128 + wr * 64 + m * 16 + fr; int tok = -1; if (vr0 + rr < ncls) tok = (int)rt[(size_t)cls * 32768 + vr0 + rr];
                if (tok >= 0) { bf16* xr = xx + (size_t)tok * D_ + u.pn * 256 + wc * 32 + 8 * fq;
#pragma unroll
                    for (int bj = 0; bj < 2; ++bj) { u32x4* q = (u32x4*)(xr + bj * 128); *q = res_add8(*q, acc[ai][bj][m][0], acc[ai][bj][m][1]); } } }
    }
};

__device__ __forceinline__ void transpose_item(const float* W, int ldw, bf16* WT, int ldt, int r0, int rmul, int k0, LAS float* scr, int lane, const float* gk = nullptr) {
    f32x4 v[8];
#pragma unroll
    for (int i = 0; i < 8; ++i) v[i] = *(const f32x4*)(W + (size_t)(k0 + i * 8 + (lane >> 3)) * ldw + (lane & 7) * 4);
    if (gk) {
#pragma unroll
        for (int i = 0; i < 8; ++i) { const float gsc = gk[k0 + i * 8 + (lane >> 3)]; v[i].x *= gsc; v[i].y *= gsc; v[i].z *= gsc; v[i].w *= gsc; } }
#pragma unroll
    for (int i = 0; i < 8; ++i) { LAS float* d = scr + (i * 8 + (lane >> 3)) * 33 + (lane & 7) * 4; d[0] = v[i].x; d[1] = v[i].y; d[2] = v[i].z; d[3] = v[i].w; }
    asm volatile("s_waitcnt lgkmcnt(0)" ::: "memory");
    const int c = lane & 7;
#pragma unroll
    for (int j = 0; j < 4; ++j) { const int n = (lane >> 3) + 8 * j; const LAS float* sp = scr + (8 * c) * 33 + n;
        u32x4 o; o.x = pk2(sp[0 * 33], sp[1 * 33]); o.y = pk2(sp[2 * 33], sp[3 * 33]); o.z = pk2(sp[4 * 33], sp[5 * 33]); o.w = pk2(sp[6 * 33], sp[7 * 33]);
        *(u32x4*)(WT + (size_t)(r0 + rmul * n) * ldt + k0 + 8 * c) = o; }
    asm volatile("s_waitcnt lgkmcnt(0)" ::: "memory");
}
__device__ __forceinline__ void transpose_seg(const float* W, int ldw, int K, int sc0, int ncol, bf16* WT, int r0, int rmul, int item, LAS float* scr, int lane, const float* gk = nullptr) {
    const int nb = ncol / 32, kb = item / nb, cb = item % nb;
    transpose_item(W + sc0 + cb * 32, ldw, WT, K, r0 + rmul * cb * 32, rmul, kb * 64, scr, lane, gk);
}

typedef float f32x16 __attribute__((ext_vector_type(16)));
typedef short bf16x8v __attribute__((ext_vector_type(8)));
typedef short s16x4 __attribute__((ext_vector_type(4)));
typedef float f32x2_t __attribute__((ext_vector_type(2)));
typedef __bf16 bf16x2_t __attribute__((ext_vector_type(2)));
constexpr int A_KBUF = 10240, A_VBUF = 12288;
constexpr int A_KOFF = 0, A_VOFF = 2 * A_KBUF, A_BOFF = A_VOFF + 2 * A_VBUF, A_BTILE = 8 * 256, A_LDS_END = A_BOFF + 2 * A_BTILE;
__device__ __forceinline__ constexpr int crow0(int reg) { return (reg & 3) + 8 * (reg >> 2); }
__device__ __forceinline__ float swap_max(float m) { auto rr = __builtin_amdgcn_permlane32_swap(__float_as_uint(m), __float_as_uint(m), false, false); return fmaxf(__uint_as_float(rr[0]), __uint_as_float(rr[1])); }
__device__ __forceinline__ float swap_sum(float m) { auto rr = __builtin_amdgcn_permlane32_swap(__float_as_uint(m), __float_as_uint(m), false, false); return __uint_as_float(rr[0]) + __uint_as_float(rr[1]); }
__device__ __forceinline__ unsigned cvtpk(float lo, float hi) { f32x2_t v = {lo, hi}; bf16x2_t b = __builtin_convertvector(v, bf16x2_t); return __builtin_bit_cast(unsigned, b); }
__device__ __forceinline__ bf16x8v pack8(const f32x16& p, int b0) { u32x4 w; w.x = cvtpk(p[b0 + 0], p[b0 + 1]); w.y = cvtpk(p[b0 + 2], p[b0 + 3]); w.z = cvtpk(p[b0 + 4], p[b0 + 5]); w.w = cvtpk(p[b0 + 6], p[b0 + 7]); return __builtin_bit_cast(bf16x8v, w); }
__device__ __forceinline__ s16x4 tr_read(const LAS unsigned char* p) { typedef short v4i16_t __attribute__((ext_vector_type(4))); return __builtin_bit_cast(s16x4, __builtin_amdgcn_ds_read_tr16_b64_v4i16((LAS v4i16_t*)p)); }

template <int DQK>
__device__ __forceinline__ void attn_preload(const bf16* Kb0, const bf16* Kb1, const bf16* Vb, int j, int tid, u32x4& kreg, u32x4& vreg) {
    const bf16* ksrc;
    if (DQK == 64) ksrc = Kb0 + b64_off(tid >> 3, (tid & 7) * 8); else { const int mp = tid >> 8, tt = tid & 255; ksrc = (mp ? Kb1 : Kb0) + (tt >> 2) * 32 + (tt & 3) * 8; }
    const bf16* vsrc = Vb + b64_off(tid >> 3, (tid & 7) * 8);
    kreg = *(const u32x4*)(ksrc + (size_t)(j * 64) * DQK); vreg = *(const u32x4*)(vsrc + (size_t)(j * 64) * 64);
}
template <int DQK, int NMAP, bool FOX, bool SLC, bool PRE = false, bool NOMAX = false>
__device__ __forceinline__ void attn_core(LAS unsigned char* L, const bf16* Kb0, const bf16* Kb1, const bf16* Vb, const LAS float* cum, float cum_ref,
                                          const bf16x8v (&Qf)[NMAP][DQK / 16], u64 tilemask, int t_lane, int tw0, int win, float slope2, unsigned selw0, unsigned selw1,
                                          f32x16 (&O)[NMAP][2], float (&M)[NMAP], float (&Ls)[NMAP], int tid, bool started0 = false, int jpre = 0, u32x4 kpre = (u32x4){0u, 0u, 0u, 0u}, u32x4 vpre = (u32x4){0u, 0u, 0u, 0u}) {
    constexpr int KP = DQK * 2 + 16, VP = 192;
    const int lane = tid & 63, r = lane & 31, h = lane >> 5;
    int kdst; const bf16* ksrc;
    if (DQK == 64) { kdst = (tid >> 3) * KP + (tid & 7) * 16; ksrc = Kb0 + b64_off(tid >> 3, (tid & 7) * 8); }
    else { const int mp = tid >> 8, tt = tid & 255; kdst = mp * 5120 + (tt >> 2) * KP + (tt & 3) * 16; ksrc = (mp ? Kb1 : Kb0) + (tt >> 2) * 32 + (tt & 3) * 8; }
    const int vdst = (tid >> 3) * VP + (tid & 7) * 16; const bf16* vsrc = Vb + b64_off(tid >> 3, (tid & 7) * 8);
    const LAS unsigned char* kfrag = L + A_KOFF + r * KP + h * 16;
    const LAS unsigned char* vfrag = L + A_VOFF + (4 * h + ((lane & 15) >> 2)) * VP + (16 * ((lane >> 4) & 1) + 4 * (lane & 3)) * 2;
    u32x4 kreg, vreg; float breg = 0.f;
    u64 mk = tilemask;
    int j = PRE ? jpre : 63 - __builtin_clzll(mk); mk &= ~(1ull << j);
    { const int kv0 = j * 64; if (PRE) { kreg = kpre; vreg = vpre; } else { kreg = *(const u32x4*)(ksrc + (size_t)kv0 * DQK); vreg = *(const u32x4*)(vsrc + (size_t)kv0 * 64); } if (FOX) breg = (cum_ref - cum[kv0 + lane]) * LOG2E; }
    *(LAS u32x4*)(L + A_KOFF + kdst) = kreg; *(LAS u32x4*)(L + A_VOFF + vdst) = vreg; if (FOX) *(LAS float*)(L + A_BOFF + tid * 4) = breg;
    __syncthreads();
    int buf = 0; bool started = started0;
    float pdummy = 0.f; int idummy = 0; f32x16 dm0; for (int i = 0; i < 16; ++i) dm0[i] = 0.f;
    for (;;) {
        const bool more = mk != 0ull; int jn = 0;
        if (more) { jn = 63 - __builtin_clzll(mk); mk &= ~(1ull << jn); const int kv0 = jn * 64;
            kreg = *(const u32x4*)(ksrc + (size_t)kv0 * DQK); vreg = *(const u32x4*)(vsrc + (size_t)kv0 * 64); if (FOX) breg = (cum_ref - cum[kv0 + lane]) * LOG2E; }
        { const int kv0 = j * 64;
          bool wave_has = true; float selb = 0.f;
          if (SLC) { const bool mine = ((j < 32 ? (selw0 >> j) : (selw1 >> (j - 32))) & 1u) != 0u; selb = mine ? 0.f : -INFINITY; wave_has = __any(mine); }
          if (wave_has && !(kv0 > tw0 + 31) && !(tw0 - (kv0 + 63) >= win)) {
            const bool need_mask = (kv0 + 63 > tw0) || (tw0 + 31 - kv0 >= win);
            const int dl = t_lane - kv0 - 4 * h;
            bf16x8v pa[NMAP][4];
#pragma unroll
            for (int mp = 0; mp < NMAP; ++mp) {
                f32x16 p0, p1;
                if (FOX) { const LAS f32x4* bl = (const LAS f32x4*)(L + A_BOFF + buf * A_BTILE + (tid >> 6) * 256) + h; const float mm = NOMAX ? 0.f : M[mp];
#pragma unroll
                    for (int g4 = 0; g4 < 4; ++g4) { const f32x4 b0 = bl[2 * g4], b1 = bl[8 + 2 * g4];
                        p0[4 * g4 + 0] = b0.x - mm; p0[4 * g4 + 1] = b0.y - mm; p0[4 * g4 + 2] = b0.z - mm; p0[4 * g4 + 3] = b0.w - mm; p1[4 * g4 + 0] = b1.x - mm; p1[4 * g4 + 1] = b1.y - mm; p1[4 * g4 + 2] = b1.z - mm; p1[4 * g4 + 3] = b1.w - mm; } }
                else { const float base_l = (slope2 * (float)(kv0 + 4 * h - tw0) - (NOMAX ? 0.f : M[mp])) + selb, s8 = slope2 * 8.f, s32 = slope2 * 32.f;
                    p0[0] = base_l; p0[1] = p0[0] + slope2; p0[2] = p0[1] + slope2; p0[3] = p0[2] + slope2;
#pragma unroll
                    for (int reg = 4; reg < 16; ++reg) p0[reg] = p0[reg - 4] + s8;
#pragma unroll
                    for (int reg = 0; reg < 16; ++reg) p1[reg] = p0[reg] + s32; }
                const LAS unsigned char* kb = kfrag + buf * A_KBUF + (DQK == 32 ? mp * 5120 : 0);
#pragma unroll
                for (int s = 0; s < DQK / 16; ++s) { const bf16x8v kf0 = *(const LAS bf16x8v*)(kb + s * 32), kf1 = *(const LAS bf16x8v*)(kb + 32 * KP + s * 32);
#ifdef PROBE_X_LDSK
                    { const bf16x8v z0 = *(const volatile LAS bf16x8v*)(kb + s * 32), z1 = *(const volatile LAS bf16x8v*)(kb + 32 * KP + s * 32); idummy ^= z0[0] ^ z1[1]; }
#endif
#ifdef PROBE_X_MFMA
                    dm0 = __builtin_amdgcn_mfma_f32_32x32x16_bf16(kf0, Qf[mp][s], dm0, 0, 0, 0); dm0 = __builtin_amdgcn_mfma_f32_32x32x16_bf16(kf1, Qf[mp][s], dm0, 0, 0, 0);
#endif
                    p0 = __builtin_amdgcn_mfma_f32_32x32x16_bf16(kf0, Qf[mp][s], p0, 0, 0, 0); p1 = __builtin_amdgcn_mfma_f32_32x32x16_bf16(kf1, Qf[mp][s], p1, 0, 0, 0); }
                if (need_mask) {
#pragma unroll
                    for (int reg = 0; reg < 16; ++reg) { const int d0 = dl - crow0(reg), d1 = d0 - 32;
                        p0[reg] = (d0 >= 0 && d0 < win) ? p0[reg] : -INFINITY; p1[reg] = (d1 >= 0 && d1 < win) ? p1[reg] : -INFINITY; } }
                if (!NOMAX) {
                float mt = fmaxf(fmaxf(p0[0], p1[0]), fmaxf(p0[1], p1[1]));
#pragma unroll
                for (int reg = 2; reg < 16; reg += 2) mt = fmaxf(fmaxf(mt, fmaxf(fmaxf(p0[reg], p1[reg]), p0[reg + 1])), p1[reg + 1]);
                mt = swap_max(mt);
                if (!started || __any(mt > 8.f)) {
                    const float d = (mt > -1e30f) ? (started ? fmaxf(mt, 0.f) : mt) : 0.f, alpha = __builtin_amdgcn_exp2f(-d);
                    O[mp][0] *= alpha; O[mp][1] *= alpha; Ls[mp] *= alpha; M[mp] += d;
#pragma unroll
                    for (int reg = 0; reg < 16; ++reg) { p0[reg] -= d; p1[reg] -= d; } } }
                float rs = 0.f;
#ifdef PROBE_X_EXP
#pragma unroll
                for (int reg = 0; reg < 16; ++reg) { pdummy += __builtin_amdgcn_exp2f(p0[reg] - 1.f) + __builtin_amdgcn_exp2f(p1[reg] - 1.f); }
#endif
#pragma unroll
                for (int reg = 0; reg < 16; ++reg) { p0[reg] = __builtin_amdgcn_exp2f(p0[reg]); p1[reg] = __builtin_amdgcn_exp2f(p1[reg]); rs += p0[reg] + p1[reg]; }
                Ls[mp] += rs;
                pa[mp][0] = pack8(p0, 0); pa[mp][1] = pack8(p0, 8); pa[mp][2] = pack8(p1, 0); pa[mp][3] = pack8(p1, 8);
            }
            started = true;
            const LAS unsigned char* vb = vfrag + buf * A_VBUF;
#pragma unroll
            for (int db = 0; db < 2; ++db)
#pragma unroll
                for (int ks = 0; ks < 4; ++ks) { const s16x4 lo = tr_read(vb + ks * (16 * VP) + db * 64), hi = tr_read(vb + ks * (16 * VP) + db * 64 + 8 * VP);
                    const bf16x8v vf = {lo[0], lo[1], lo[2], lo[3], hi[0], hi[1], hi[2], hi[3]};
#pragma unroll
                    for (int mp = 0; mp < NMAP; ++mp) O[mp][db] = __builtin_amdgcn_mfma_f32_32x32x16_bf16(vf, pa[mp][ks], O[mp][db], 0, 0, 0); }
          } }
        if (more) { *(LAS u32x4*)(L + A_KOFF + (buf ^ 1) * A_KBUF + kdst) = kreg; *(LAS u32x4*)(L + A_VOFF + (buf ^ 1) * A_VBUF + vdst) = vreg; if (FOX) *(LAS float*)(L + A_BOFF + (buf ^ 1) * A_BTILE + tid * 4) = breg; }
#ifdef PROBE_X_BAR
        __syncthreads();
#endif
        __syncthreads();
        if (!more) break;
        j = jn; buf ^= 1;
    }
    if (pdummy == 123.456f || idummy == 0x7fffabcd || dm0[3] == 98765.4321f) Ls[0] += 1e-30f;
}
#ifndef AC2_MODE
#define AC2_MODE 0
#endif
#ifndef AC2_INIT_VALU
#define AC2_INIT_VALU 24
#endif
template <bool FOX, bool SLC>
__device__ __forceinline__ void attn_core2(LAS unsigned char* L, const bf16* Kb0, const bf16* Vb, const LAS float* cum, float cum_ref,
                                           const bf16x8v (&Qf)[4], u64 tilemask, int t_lane, int tw0, int win, float slope2, unsigned selw0, unsigned selw1,
                                           f32x16 (&O)[2], float& M, float& Ls, int tid) {
    constexpr int KP = 144, VP = 192;
    const int lane = tid & 63, r = lane & 31, h = lane >> 5;
    const int kdst = (tid >> 3) * KP + (tid & 7) * 16; const bf16* ksrc = Kb0 + b64_off(tid >> 3, (tid & 7) * 8);
    const int vdst = (tid >> 3) * VP + (tid & 7) * 16; const bf16* vsrc = Vb + b64_off(tid >> 3, (tid & 7) * 8);
    const LAS unsigned char* kfrag = L + A_KOFF + r * KP + h * 16;
    const LAS unsigned char* vfrag = L + A_VOFF + (4 * h + ((lane & 15) >> 2)) * VP + (16 * ((lane >> 4) & 1) + 4 * (lane & 3)) * 2;
#define AC2_ACTIVE(jj) (!((jj) * 64 > tw0 + 31) && !(tw0 - ((jj) * 64 + 63) >= win))
#define AC2_INIT(jj, kslot, q0, q1) do { const int kv0_ = (jj) * 64; \
        if (FOX) { const LAS f32x4* bl = (const LAS f32x4*)(L + A_BOFF + (kslot) * 256) + h; const float mm = M; \
            _Pragma("unroll") for (int g4 = 0; g4 < 4; ++g4) { const f32x4 b0 = bl[2 * g4], b1 = bl[8 + 2 * g4]; \
                q0[4 * g4 + 0] = b0.x - mm; q0[4 * g4 + 1] = b0.y - mm; q0[4 * g4 + 2] = b0.z - mm; q0[4 * g4 + 3] = b0.w - mm; q1[4 * g4 + 0] = b1.x - mm; q1[4 * g4 + 1] = b1.y - mm; q1[4 * g4 + 2] = b1.z - mm; q1[4 * g4 + 3] = b1.w - mm; } } \
        else { float selb = 0.f; if (SLC) selb = ((((jj) < 32) ? (selw0 >> (jj)) : (selw1 >> ((jj) - 32))) & 1u) ? 0.f : -INFINITY; \
            const float base_l = (slope2 * (float)(kv0_ + 4 * h - tw0) - M) + selb, s8 = slope2 * 8.f, s32 = slope2 * 32.f; \
            q0[0] = base_l; q0[1] = q0[0] + slope2; q0[2] = q0[1] + slope2; q0[3] = q0[2] + slope2; \
            _Pragma("unroll") for (int reg = 4; reg < 16; ++reg) q0[reg] = q0[reg - 4] + s8; \
            _Pragma("unroll") for (int reg = 0; reg < 16; ++reg) q1[reg] = q0[reg] + s32; } } while (0)
#define AC2_QK(jj, kslot) do { AC2_INIT(jj, kslot, p0, p1); \
        const LAS unsigned char* kb_ = kfrag + (kslot) * A_KBUF; \
        _Pragma("unroll") for (int s_ = 0; s_ < 4; ++s_) { const bf16x8v kf0 = *(const LAS bf16x8v*)(kb_ + s_ * 32), kf1 = *(const LAS bf16x8v*)(kb_ + 32 * KP + s_ * 32); \
            p0 = __builtin_amdgcn_mfma_f32_32x32x16_bf16(kf0, Qf[s_], p0, 0, 0, 0); p1 = __builtin_amdgcn_mfma_f32_32x32x16_bf16(kf1, Qf[s_], p1, 0, 0, 0); } } while (0)
    u32x4 kreg, vreg; float breg = 0.f;
    u64 mk = tilemask;
    int j = 63 - __builtin_clzll(mk); mk &= ~(1ull << j);
    int jn = -1; if (mk) { jn = 63 - __builtin_clzll(mk); mk &= ~(1ull << jn); }
    { kreg = *(const u32x4*)(ksrc + (size_t)j * 64 * 64); vreg = *(const u32x4*)(vsrc + (size_t)j * 64 * 64); if (FOX && tid < 64) breg = (cum_ref - cum[j * 64 + tid]) * LOG2E;
      *(LAS u32x4*)(L + A_KOFF + kdst) = kreg; *(LAS u32x4*)(L + A_VOFF + vdst) = vreg; if (FOX && tid < 64) *(LAS float*)(L + A_BOFF + tid * 4) = breg;
      if (jn >= 0) { kreg = *(const u32x4*)(ksrc + (size_t)jn * 64 * 64); if (FOX && tid < 64) breg = (cum_ref - cum[jn * 64 + tid]) * LOG2E;
          *(LAS u32x4*)(L + A_KOFF + A_KBUF + kdst) = kreg; if (FOX && tid < 64) *(LAS float*)(L + A_BOFF + 256 + tid * 4) = breg; } }
    __syncthreads();
    f32x16 p0, p1;
    bool started = false;
    int ks = 0, vs = 0;
    if (AC2_ACTIVE(j)) AC2_QK(j, 0);
    for (;;) {
        int jnn = -1; if (mk) { jnn = 63 - __builtin_clzll(mk); mk &= ~(1ull << jnn); }
        if (jnn >= 0) { kreg = *(const u32x4*)(ksrc + (size_t)jnn * 64 * 64); if (FOX && tid < 64) breg = (cum_ref - cum[jnn * 64 + tid]) * LOG2E; }
        if (jn >= 0) vreg = *(const u32x4*)(vsrc + (size_t)jn * 64 * 64);
        const bool act = AC2_ACTIVE(j), actn = jn >= 0 && AC2_ACTIVE(jn);
        if (act) {
            const int kv0 = j * 64;
            if ((kv0 + 63 > tw0) || (tw0 + 31 - kv0 >= win)) { const int dl = t_lane - kv0 - 4 * h;
#pragma unroll
                for (int reg = 0; reg < 16; ++reg) { const int d0 = dl - crow0(reg), d1 = d0 - 32;
                    p0[reg] = (d0 >= 0 && d0 < win) ? p0[reg] : -INFINITY; p1[reg] = (d1 >= 0 && d1 < win) ? p1[reg] : -INFINITY; } }
            float mt = fmaxf(fmaxf(p0[0], p1[0]), fmaxf(p0[1], p1[1]));
#pragma unroll
            for (int reg = 2; reg < 16; reg += 2) mt = fmaxf(fmaxf(mt, fmaxf(fmaxf(p0[reg], p1[reg]), p0[reg + 1])), p1[reg + 1]);
            mt = swap_max(mt);
            if (!started || __any(mt > 8.f)) {
                const float d = (mt > -1e30f) ? (started ? fmaxf(mt, 0.f) : mt) : 0.f, alpha = __builtin_amdgcn_exp2f(-d);
                O[0] *= alpha; O[1] *= alpha; Ls *= alpha; M += d;
#pragma unroll
                for (int reg = 0; reg < 16; ++reg) { p0[reg] -= d; p1[reg] -= d; } }
            started = true;
#if AC2_MODE == 1
            {
                const int jq = jn >= 0 ? jn : 0;
                float rs = 0.f;
#pragma unroll
                for (int reg = 0; reg < 16; ++reg) { p0[reg] = __builtin_amdgcn_exp2f(p0[reg]); p1[reg] = __builtin_amdgcn_exp2f(p1[reg]); rs += p0[reg] + p1[reg]; }
                Ls += rs;
                const bf16x8v pa0 = pack8(p0, 0), pa1 = pack8(p0, 8), pa2 = pack8(p1, 0), pa3 = pack8(p1, 8);
                AC2_QK(jq, ks ^ 1);
                const LAS unsigned char* vb = vfrag + vs * A_VBUF;
#pragma unroll
                for (int db = 0; db < 2; ++db)
#pragma unroll
                    for (int kq = 0; kq < 4; ++kq) { const s16x4 lo = tr_read(vb + kq * (16 * VP) + db * 64), hi = tr_read(vb + kq * (16 * VP) + db * 64 + 8 * VP);
                        const bf16x8v vf = {lo[0], lo[1], lo[2], lo[3], hi[0], hi[1], hi[2], hi[3]};
                        O[db] = __builtin_amdgcn_mfma_f32_32x32x16_bf16(vf, kq == 0 ? pa0 : kq == 1 ? pa1 : kq == 2 ? pa2 : pa3, O[db], 0, 0, 0); }
            }
#else
            {
                const int jq = jn >= 0 ? jn : 0;
                f32x16 n0, n1;
                AC2_INIT(jq, ks ^ 1, n0, n1);
                const LAS unsigned char* kb_ = kfrag + (ks ^ 1) * A_KBUF;
                bf16x8v kf[8];
#pragma unroll
                for (int s_ = 0; s_ < 4; ++s_) { kf[2 * s_] = *(const LAS bf16x8v*)(kb_ + s_ * 32); kf[2 * s_ + 1] = *(const LAS bf16x8v*)(kb_ + 32 * KP + s_ * 32); }
                const LAS unsigned char* vb = vfrag + vs * A_VBUF;
                __builtin_amdgcn_sched_barrier(0);
                float ra = 0.f, rb = 0.f; unsigned w[16];
#define AC2_PINF(x) asm volatile("" : "+v"(x))
#define AC2_QGAP(i) do { if ((i) & 1) n1 = __builtin_amdgcn_mfma_f32_32x32x16_bf16(kf[i], Qf[(i) >> 1], n1, 0, 0, 0); else n0 = __builtin_amdgcn_mfma_f32_32x32x16_bf16(kf[i], Qf[(i) >> 1], n0, 0, 0, 0); \
                    float e0 = __builtin_amdgcn_exp2f(p0[2 * (i)]), e1 = __builtin_amdgcn_exp2f(p0[2 * (i) + 1]), e2 = __builtin_amdgcn_exp2f(p1[2 * (i)]), e3 = __builtin_amdgcn_exp2f(p1[2 * (i) + 1]); \
                    ra += e0 + e1; rb += e2 + e3; \
                    AC2_PINF(e0); AC2_PINF(e1); AC2_PINF(e2); AC2_PINF(e3); AC2_PINF(ra); AC2_PINF(rb); \
                    p0[2 * (i)] = e0; p0[2 * (i) + 1] = e1; p1[2 * (i)] = e2; p1[2 * (i) + 1] = e3; \
                    if ((i) >= 4) { w[2 * ((i) - 4)] = cvtpk(p0[4 * ((i) - 4)], p0[4 * ((i) - 4) + 1]); w[2 * ((i) - 4) + 1] = cvtpk(p0[4 * ((i) - 4) + 2], p0[4 * ((i) - 4) + 3]); AC2_PINF(w[2 * ((i) - 4)]); AC2_PINF(w[2 * ((i) - 4) + 1]); } \
                    if ((i) == 6) { vl[0] = tr_read(vb); vh[0] = tr_read(vb + 8 * VP); } \
                    if ((i) == 7) { vl[1] = tr_read(vb + 64); vh[1] = tr_read(vb + 64 + 8 * VP); } \
                    __builtin_amdgcn_sched_barrier(0); } while (0)
                s16x4 vl[2], vh[2];
                AC2_QGAP(0); AC2_QGAP(1); AC2_QGAP(2); AC2_QGAP(3); AC2_QGAP(4); AC2_QGAP(5); AC2_QGAP(6); AC2_QGAP(7);
                Ls += ra + rb;
#define AC2_PA(kq) __builtin_bit_cast(bf16x8v, (u32x4){w[4 * (kq)], w[4 * (kq) + 1], w[4 * (kq) + 2], w[4 * (kq) + 3]})
#define AC2_PGAP(g) do { const int kq_ = (g) >> 1, db_ = (g) & 1; const bf16x8v vf = {vl[(g) & 1][0], vl[(g) & 1][1], vl[(g) & 1][2], vl[(g) & 1][3], vh[(g) & 1][0], vh[(g) & 1][1], vh[(g) & 1][2], vh[(g) & 1][3]}; \
                    if ((g) < 6) { const int kq2 = ((g) + 2) >> 1, db2 = (g) & 1; vl[(g) & 1] = tr_read(vb + kq2 * (16 * VP) + db2 * 64); vh[(g) & 1] = tr_read(vb + kq2 * (16 * VP) + db2 * 64 + 8 * VP); } \
                    O[db_] = __builtin_amdgcn_mfma_f32_32x32x16_bf16(vf, AC2_PA(kq_), O[db_], 0, 0, 0); \
                    if ((g) < 4) { w[8 + 2 * (g)] = cvtpk(p1[4 * (g)], p1[4 * (g) + 1]); w[8 + 2 * (g) + 1] = cvtpk(p1[4 * (g) + 2], p1[4 * (g) + 3]); AC2_PINF(w[8 + 2 * (g)]); AC2_PINF(w[8 + 2 * (g) + 1]); } \
                    __builtin_amdgcn_sched_barrier(0); } while (0)
                AC2_PGAP(0); AC2_PGAP(1); AC2_PGAP(2); AC2_PGAP(3); AC2_PGAP(4); AC2_PGAP(5); AC2_PGAP(6); AC2_PGAP(7);
#undef AC2_PGAP
#undef AC2_PA
#undef AC2_QGAP
#undef AC2_PINF
                p0 = n0; p1 = n1;
            }
#endif
        } else if (actn) AC2_QK(jn, ks ^ 1);
        if (jnn >= 0) { *(LAS u32x4*)(L + A_KOFF + ks * A_KBUF + kdst) = kreg; if (FOX && tid < 64) *(LAS float*)(L + A_BOFF + ks * 256 + tid * 4) = breg; }
        if (jn >= 0) *(LAS u32x4*)(L + A_VOFF + (vs ^ 1) * A_VBUF + vdst) = vreg;
        __syncthreads();
        if (jn < 0) break;
        j = jn; jn = jnn; ks ^= 1; vs ^= 1;
    }
#undef AC2_QK
#undef AC2_INIT
#undef AC2_ACTIVE
}
__device__ __forceinline__ size_t mix_off(size_t n, int c, int W) { return ((n >> 5) * (size_t)(W / 8) + (size_t)(c >> 3)) * 256 + (n & 31) * 8 + (c & 7); }
#define ATTN_FOR_CHUNKS(db, g4) _Pragma("unroll") for (int db = 0; db < 2; ++db) _Pragma("unroll") for (int g4 = 0; g4 < 4; ++g4)

__device__ __forceinline__ void unpack8(const u32x4 w, float (&f)[8]) { f[0] = __uint_as_float(w.x << 16); f[1] = __uint_as_float(w.x & 0xffff0000u); f[2] = __uint_as_float(w.y << 16); f[3] = __uint_as_float(w.y & 0xffff0000u);
    f[4] = __uint_as_float(w.z << 16); f[5] = __uint_as_float(w.z & 0xffff0000u); f[6] = __uint_as_float(w.w << 16); f[7] = __uint_as_float(w.w & 0xffff0000u); }
__device__ __forceinline__ void ph_norm_bf16_from_bf16(const Ctx& c, const bf16* x, const float* g, bf16* out) {
    constexpr int RB = 4; float gg[2][8];
#pragma unroll
    for (int j = 0; j < 2; ++j) { const f32x4 a = ((const f32x4*)g)[2 * c.lane + 128 * j], b2 = ((const f32x4*)g)[2 * c.lane + 128 * j + 1]; gg[j][0] = a.x; gg[j][1] = a.y; gg[j][2] = a.z; gg[j][3] = a.w; gg[j][4] = b2.x; gg[j][5] = b2.y; gg[j][6] = b2.z; gg[j][7] = b2.w; }
    for (int row0 = c.gw * RB; row0 < NT; row0 += c.ngw * RB) {
        u32x4 v[RB][2];
#pragma unroll
        for (int q = 0; q < RB; ++q)
#pragma unroll
            for (int j = 0; j < 2; ++j) v[q][j] = ((const u32x4*)(x + (size_t)(row0 + q) * D_))[c.lane + 64 * j];
#pragma unroll
        for (int q = 0; q < RB; ++q) { float f[2][8]; float ss = 0.f;
#pragma unroll
            for (int j = 0; j < 2; ++j) { unpack8(v[q][j], f[j]);
#pragma unroll
                for (int e = 0; e < 8; ++e) ss = fmaf(f[j][e], f[j][e], ss); }
            const float r = rsqrtf(wave_sum_l(ss, c.lane) * (1.f / D_) + EPS);
#pragma unroll
            for (int j = 0; j < 2; ++j) { u32x4 o; o.x = pk2(f[j][0] * r * gg[j][0], f[j][1] * r * gg[j][1]); o.y = pk2(f[j][2] * r * gg[j][2], f[j][3] * r * gg[j][3]); o.z = pk2(f[j][4] * r * gg[j][4], f[j][5] * r * gg[j][5]); o.w = pk2(f[j][6] * r * gg[j][6], f[j][7] * r * gg[j][7]);
                ((u32x4*)(out + (size_t)(row0 + q) * D_))[c.lane + 64 * j] = o; } }
    }
}
__device__ __forceinline__ void ph_norm_final_from_bf16(const Ctx& c, const bf16* x, const float* g, float* out) {
    constexpr int RB = 4; float gg[2][8];
#pragma unroll
    for (int j = 0; j < 2; ++j) { const f32x4 a = ((const f32x4*)g)[2 * c.lane + 128 * j], b2 = ((const f32x4*)g)[2 * c.lane + 128 * j + 1]; gg[j][0] = a.x; gg[j][1] = a.y; gg[j][2] = a.z; gg[j][3] = a.w; gg[j][4] = b2.x; gg[j][5] = b2.y; gg[j][6] = b2.z; gg[j][7] = b2.w; }
    for (int row0 = c.gw * RB; row0 < NT; row0 += c.ngw * RB) {
        u32x4 v[RB][2];
#pragma unroll
        for (int q = 0; q < RB; ++q)
#pragma unroll
            for (int j = 0; j < 2; ++j) v[q][j] = ((const u32x4*)(x + (size_t)(row0 + q) * D_))[c.lane + 64 * j];
#pragma unroll
        for (int q = 0; q < RB; ++q) { float f[2][8]; float ss = 0.f;
#pragma unroll
            for (int j = 0; j < 2; ++j) { unpack8(v[q][j], f[j]);
#pragma unroll
                for (int e = 0; e < 8; ++e) ss = fmaf(f[j][e], f[j][e], ss); }
            const float r = rsqrtf(wave_sum_l(ss, c.lane) * (1.f / D_) + EPS);
#pragma unroll
            for (int j = 0; j < 2; ++j) { f32x4* o = (f32x4*)(out + (size_t)(row0 + q) * D_) + 2 * c.lane + 128 * j;
                o[0] = (f32x4){f[j][0] * r * gg[j][0], f[j][1] * r * gg[j][1], f[j][2] * r * gg[j][2], f[j][3] * r * gg[j][3]}; o[1] = (f32x4){f[j][4] * r * gg[j][4], f[j][5] * r * gg[j][5], f[j][6] * r * gg[j][6], f[j][7] * r * gg[j][7]}; } }
    }
}
__device__ __forceinline__ void ph_norm_bf16(const Ctx& c, const float* x, const float* g, bf16* out, bf16* raw) {
    constexpr int RB = 4;
    f32x4 gg[4];
#pragma unroll
    for (int j = 0; j < 4; ++j) gg[j] = ((const f32x4*)g)[c.lane + 64 * j];
    for (int row0 = c.gw * RB; row0 < NT; row0 += c.ngw * RB) {
        f32x4 v[RB][4];
#pragma unroll
        for (int q = 0; q < RB; ++q)
#pragma unroll
            for (int j = 0; j < 4; ++j) v[q][j] = ((const f32x4*)(x + (size_t)(row0 + q) * D_))[c.lane + 64 * j];
#pragma unroll
        for (int q = 0; q < RB; ++q) { float ss = 0.f;
#pragma unroll
            for (int j = 0; j < 4; ++j) ss += v[q][j].x * v[q][j].x + v[q][j].y * v[q][j].y + v[q][j].z * v[q][j].z + v[q][j].w * v[q][j].w;
            const float r = rsqrtf(wave_sum_l(ss, c.lane) * (1.f / D_) + EPS);
            u64* o8 = (u64*)(out + (size_t)(row0 + q) * D_) + c.lane; u64* r8 = (u64*)(raw + (size_t)(row0 + q) * D_) + c.lane;
#pragma unroll
            for (int j = 0; j < 4; ++j) { o8[64 * j] = (u64)pk2(v[q][j].x * r * gg[j].x, v[q][j].y * r * gg[j].y) | ((u64)pk2(v[q][j].z * r * gg[j].z, v[q][j].w * r * gg[j].w) << 32);
                r8[64 * j] = (u64)pk2(v[q][j].x, v[q][j].y) | ((u64)pk2(v[q][j].z, v[q][j].w) << 32); } }
    }
}
__device__ __forceinline__ void ph_norm_final(const Ctx& c, float* x, const float* g) {
    constexpr int RB = 4;
    f32x4 gg[4];
#pragma unroll
    for (int j = 0; j < 4; ++j) gg[j] = ((const f32x4*)g)[c.lane + 64 * j];
    for (int row0 = c.gw * RB; row0 < NT; row0 += c.ngw * RB) {
        f32x4 v[RB][4];
#pragma unroll
        for (int q = 0; q < RB; ++q)
#pragma unroll
            for (int j = 0; j < 4; ++j) v[q][j] = ((const f32x4*)(x + (size_t)(row0 + q) * D_))[c.lane + 64 * j];
#pragma unroll
        for (int q = 0; q < RB; ++q) { float ss = 0.f;
#pragma unroll
            for (int j = 0; j < 4; ++j) ss += v[q][j].x * v[q][j].x + v[q][j].y * v[q][j].y + v[q][j].z * v[q][j].z + v[q][j].w * v[q][j].w;
            const float r = rsqrtf(wave_sum_l(ss, c.lane) * (1.f / D_) + EPS);
            f32x4* xr = (f32x4*)(x + (size_t)(row0 + q) * D_) + c.lane;
#pragma unroll
            for (int j = 0; j < 4; ++j) xr[64 * j] = v[q][j] * r * gg[j]; }
    }
}

template <class AF, class EF>
__device__ __forceinline__ void naive_gemm(const Ctx& c, int M, int N, int K, AF af, const float* W, int ldb, EF ef) {
    LAS float* As = (LAS float*)c.lds;
    LAS float* Bs = As + 16 * 132;
    const int tm = (M + 127) / 128, tn = (N + 127) / 128, ntile = tm * tn;
    const int ty = c.tid >> 4, tx = c.tid & 15;
    for (int tile = c.bid; tile < ntile; tile += c.G) {
        const int m0 = (tile / tn) * 128, n0 = (tile % tn) * 128;
        float acc[4][8];
#pragma unroll
        for (int i = 0; i < 4; ++i)
#pragma unroll
            for (int j = 0; j < 8; ++j) acc[i][j] = 0.f;
        for (int k0 = 0; k0 < K; k0 += 16) {
            __syncthreads();
#pragma unroll
            for (int i = 0; i < 4; ++i) { const int e = c.tid + i * 512, r = e >> 4, kk = e & 15; const int row = m0 + r;
                As[kk * 132 + r] = (row < M) ? af(row, k0 + kk) : 0.f; }
#pragma unroll
            for (int i = 0; i < 4; ++i) { const int e = c.tid + i * 512, kk = e >> 7, cc = e & 127; const int col = n0 + cc;
                Bs[kk * 132 + cc] = (col < N) ? W[(size_t)(k0 + kk) * ldb + col] : 0.f; }
            __syncthreads();
#pragma unroll 2
            for (int kk = 0; kk < 16; ++kk) {
                float a[4], b[8];
#pragma unroll
                for (int i = 0; i < 4; ++i) a[i] = As[kk * 132 + ty * 4 + i];
#pragma unroll
                for (int j = 0; j < 8; ++j) b[j] = Bs[kk * 132 + tx * 8 + j];
#pragma unroll
                for (int i = 0; i < 4; ++i)
#pragma unroll
                    for (int j = 0; j < 8; ++j) acc[i][j] = fmaf(a[i], b[j], acc[i][j]);
            }
        }
        LAS float* Cs = Bs + 16 * 132;
        __syncthreads();
#pragma unroll
        for (int i = 0; i < 4; ++i)
#pragma unroll
            for (int j = 0; j < 8; ++j) Cs[(ty * 4 + i) * 129 + tx * 8 + j] = acc[i][j];
        __syncthreads();
#pragma unroll 1
        for (int e = c.tid; e < 128 * 128; e += NTHREADS) { const int r = e >> 7, cc = e & 127, row = m0 + r, col = n0 + cc; if (row < M && col < N) ef(row, col, Cs[r * 129 + cc]); }
    }
    __syncthreads();
}

struct InProjOut { bf16* qn; bf16* kv6; bf16* fqkv; bf16* dqk; bf16* dv; float* gate; float* fl; const float* b_gate; const float* b_fgt; };
__device__ __forceinline__ void inproj_store(const InProjOut& o, int n, int col, float v) {
    const int b = n / T_, t = n % T_;
    if (col < C_KV6) { const int h = col >> 6, d = col & 63; o.qn[((size_t)(b * 8 + h) * T_ + t) * 64 + d] = (bf16)f2bf(v * (0.125f * LOG2E)); }
    else if (col < C_GATE) { const int cc = col - C_KV6, idx = cc >> 7, g = (cc >> 6) & 1, d = cc & 63;
        ((bf16*)((unsigned char*)o.kv6 + idx * KV6_STRIDE))[((size_t)(b * 2 + g) * T_ + t) * 64 + d] = (bf16)f2bf(v); }
    else if (col < C_FQ) { const int j = col - C_GATE; o.gate[(size_t)n * 24 + j] = sigmoidf_(v + o.b_gate[j]); }
    else if (col < C_FF) { const int cc = col - C_FQ, idx = cc >> 8, h = (cc >> 6) & 3, d = cc & 63;
        o.fqkv[(size_t)idx * (8 * MiB) + ((size_t)(b * 4 + h) * T_ + t) * 64 + d] = (bf16)f2bf(idx == 0 ? v * (0.125f * LOG2E) : v); }
    else if (col < C_DQ) { const int h = col - C_FF; o.fl[(size_t)(b * 4 + h) * T_ + t] = log_sigmoidf_(v + o.b_fgt[h]); }
    else if (col < C_DV) { const int cc = col - C_DQ, idx = cc >> 8, h = (cc >> 6) & 3, i = (cc >> 5) & 1, d = cc & 31;
        o.dqk[(size_t)idx * (8 * MiB) + ((size_t)((b * 4 + h) * 2 + i) * T_ + t) * 32 + d] = (bf16)f2bf(idx == 0 ? v * (0.17677669529663687f * LOG2E) : v); }
    else { const int cc = col - C_DV, h = cc >> 6, d = cc & 63; o.dv[((size_t)(b * 4 + h) * T_ + t) * 64 + d] = (bf16)f2bf(v); }
}

__device__ __forceinline__ void ph_cumsum(const Ctx& c, float* fl) {
    for (int s = c.gw; s < B_ * 4; s += c.ngw) {
        float* p = fl + (size_t)s * T_; float carry = 0.f;
        for (int t0 = 0; t0 < T_; t0 += 64) {
            float v = p[t0 + c.lane];
#pragma unroll
            for (int o = 1; o < 64; o <<= 1) { const float u = __shfl_up(v, o); if (c.lane >= o) v += u; }
            v += carry; p[t0 + c.lane] = v; carry = __shfl(v, 63);
        }
    }
}

template <int DQK>
__device__ __forceinline__ float naive_attn_row(const bf16* q, const bf16* K, const bf16* V, int t, u64 mask, float slope2, const float* cum, int win, int lane) {
    float qv[DQK];
    { const u32x4* q4 = (const u32x4*)q;
#pragma unroll
      for (int i = 0; i < DQK / 8; ++i) { const u32x4 w = q4[i];
          qv[8 * i + 0] = __uint_as_float(w.x << 16); qv[8 * i + 1] = __uint_as_float(w.x & 0xffff0000u);
          qv[8 * i + 2] = __uint_as_float(w.y << 16); qv[8 * i + 3] = __uint_as_float(w.y & 0xffff0000u);
          qv[8 * i + 4] = __uint_as_float(w.z << 16); qv[8 * i + 5] = __uint_as_float(w.z & 0xffff0000u);
          qv[8 * i + 6] = __uint_as_float(w.w << 16); qv[8 * i + 7] = __uint_as_float(w.w & 0xffff0000u); } }
    const float cumt = cum ? cum[t] : 0.f;
    float m = -INFINITY, l = 0.f, o = 0.f;
    while (mask) {
        const int j = __builtin_ctzll(mask); mask &= mask - 1;
        const int kpos = 64 * j + lane; const int dist = t - kpos;
        const bool valid = dist >= 0 && dist < win;
        float s = 0.f;
        { const u32x4* k4 = (const u32x4*)(K + (size_t)kpos * DQK);
#pragma unroll
          for (int i = 0; i < DQK / 8; ++i) { const u32x4 w = k4[i];
              s = fmaf(qv[8 * i + 0], __uint_as_float(w.x << 16), s); s = fmaf(qv[8 * i + 1], __uint_as_float(w.x & 0xffff0000u), s);
              s = fmaf(qv[8 * i + 2], __uint_as_float(w.y << 16), s); s = fmaf(qv[8 * i + 3], __uint_as_float(w.y & 0xffff0000u), s);
              s = fmaf(qv[8 * i + 4], __uint_as_float(w.z << 16), s); s = fmaf(qv[8 * i + 5], __uint_as_float(w.z & 0xffff0000u), s);
              s = fmaf(qv[8 * i + 6], __uint_as_float(w.w << 16), s); s = fmaf(qv[8 * i + 7], __uint_as_float(w.w & 0xffff0000u), s); } }
        s -= slope2 * (float)dist;
        if (cum) s += (cumt - cum[kpos]) * LOG2E;
        s = valid ? s : -INFINITY;
        const float mb = wave_max(s);
        if (mb == -INFINITY) continue;
        const float mn = fmaxf(m, mb), alpha = exp2f(m - mn);
        const float p = valid ? exp2f(s - mn) : 0.f;
        l = l * alpha + wave_sum(p); o *= alpha; m = mn;
        const bf16* vb = V + (size_t)(64 * j) * 64 + lane;
#pragma unroll 8
        for (int k = 0; k < 64; ++k) o = fmaf(__shfl(p, k), bf2f(vb[(size_t)k * 64]), o);
    }
    return l > 0.f ? o / l : 0.f;
}

__device__ __forceinline__ void ph_cmp_attn(const Ctx& c, const bf16* qn, const bf16* kcmp, const bf16* vcmp, const float* gate, u64* sel, bf16* ocmp) {
    LAS float* pl = (LAS float*)(c.lds) + c.wave * 256;
    const int lane = c.lane;
    for (int it = c.gw; it < B_ * 2 * T_; it += c.ngw) {
        const int t = it % T_, bg = it / T_, b = bg >> 1, g = bg & 1;
        const int nvis = (t >= 31) ? ((t - 31) >> 4) + 1 : 0;
        const bf16* kc = kcmp + (size_t)bg * 256 * 64; const bf16* vc = vcmp + (size_t)bg * 256 * 64;
        float imp = 0.f;
        for (int hg = 0; hg < 4; ++hg) {
            const int h = g * 4 + hg; const float slope2 = alibi_slope(h + 1, 8) * LOG2E;
            const bf16* q = qn + ((size_t)(b * 8 + h) * T_ + t) * 64;
            float qv[64];
            { const u32x4* q4 = (const u32x4*)q;
#pragma unroll
              for (int i = 0; i < 8; ++i) { const u32x4 w = q4[i];
                  qv[8 * i + 0] = __uint_as_float(w.x << 16); qv[8 * i + 1] = __uint_as_float(w.x & 0xffff0000u);
                  qv[8 * i + 2] = __uint_as_float(w.y << 16); qv[8 * i + 3] = __uint_as_float(w.y & 0xffff0000u);
                  qv[8 * i + 4] = __uint_as_float(w.z << 16); qv[8 * i + 5] = __uint_as_float(w.z & 0xffff0000u);
                  qv[8 * i + 6] = __uint_as_float(w.w << 16); qv[8 * i + 7] = __uint_as_float(w.w & 0xffff0000u); } }
            float s[4]; float m = -INFINITY;
#pragma unroll
            for (int i = 0; i < 4; ++i) { const int cc = lane + 64 * i; float a = 0.f;
                if (cc < nvis) { const u32x4* k4 = (const u32x4*)(kc + (size_t)cc * 64);
#pragma unroll
                    for (int e = 0; e < 8; ++e) { const u32x4 w = k4[e];
                        a = fmaf(qv[8 * e + 0], __uint_as_float(w.x << 16), a); a = fmaf(qv[8 * e + 1], __uint_as_float(w.x & 0xffff0000u), a);
                        a = fmaf(qv[8 * e + 2], __uint_as_float(w.y << 16), a); a = fmaf(qv[8 * e + 3], __uint_as_float(w.y & 0xffff0000u), a);
                        a = fmaf(qv[8 * e + 4], __uint_as_float(w.z << 16), a); a = fmaf(qv[8 * e + 5], __uint_as_float(w.z & 0xffff0000u), a);
                        a = fmaf(qv[8 * e + 6], __uint_as_float(w.w << 16), a); a = fmaf(qv[8 * e + 7], __uint_as_float(w.w & 0xffff0000u), a); }
                    a -= slope2 * (float)(t - (16 * cc + 31)); } else a = -INFINITY;
                s[i] = a; m = fmaxf(m, a); }
            m = wave_max(m);
            float p[4], lsum = 0.f;
#pragma unroll
            for (int i = 0; i < 4; ++i) { p[i] = (lane + 64 * i < nvis) ? exp2f(s[i] - m) : 0.f; lsum += p[i]; }
            lsum = wave_sum(lsum);
            const float inv = lsum > 0.f ? 1.f / lsum : 0.f;
#pragma unroll
            for (int i = 0; i < 4; ++i) { p[i] *= inv; pl[lane + 64 * i] = p[i]; }
            asm volatile("s_waitcnt lgkmcnt(0)" ::: "memory");
            float o = 0.f;
            for (int cc = 0; cc < nvis; ++cc) o = fmaf(pl[cc], bf2f(vc[(size_t)cc * 64 + lane]), o);
            const float gt = gate[((size_t)(b * T_ + t)) * 24 + h * 3 + 0];
            ocmp[(size_t)(b * T_ + t) * 512 + h * 64 + lane] = (bf16)f2bf(gt * o);
            { const int j = lane; float a = pl[4 * j] + pl[4 * j + 1] + pl[4 * j + 2] + 0.5f * pl[4 * j + 3]; if (j > 0) a += 0.5f * pl[4 * j - 1]; imp += a; }
            asm volatile("s_waitcnt lgkmcnt(0)" ::: "memory");
        }
        const int cur = t >> 6; const int j = lane;
        u64 m64;
        if (cur <= 15) m64 = (cur == 63) ? ~0ull : ((1ull << (cur + 1)) - 1ull);
        else {
            float val = (j > cur) ? -INFINITY : ((j == 0 || j == cur || j == cur - 1) ? 1e4f : imp);
            m64 = 0ull;
            for (int r = 0; r < 16; ++r) {
                const float mx = wave_max(val);
                const u64 bal = __ballot(val == mx);
                const int w = __builtin_ctzll(bal);
                m64 |= 1ull << w; if (j == w) val = -INFINITY;
            }
        }
        if (lane == 0) sel[(size_t)bg * T_ + t] = m64;
    }
}

__device__ __forceinline__ void ph_win_attn(const Ctx& c, const bf16* qn, const bf16* kw, const bf16* vw, const float* gate, bf16* owin) {
    for (int it = c.gw; it < B_ * 8 * T_; it += c.ngw) {
        const int t = it % T_, bh = it / T_, b = bh >> 3, h = bh & 7, g = h >> 2;
        const int cur = t >> 6, jlo = (t - 511) > 0 ? (t - 511) >> 6 : 0;
        const u64 hi = (cur == 63) ? ~0ull : ((1ull << (cur + 1)) - 1ull); const u64 mask = hi & ~((1ull << jlo) - 1ull);
        const float o = naive_attn_row<64>(qn + ((size_t)bh * T_ + t) * 64, kw + (size_t)(b * 2 + g) * T_ * 64, vw + (size_t)(b * 2 + g) * T_ * 64, t, mask,
                                           alibi_slope(h + 1, 8) * LOG2E, nullptr, 512, c.lane);
        owin[(size_t)(b * T_ + t) * 512 + h * 64 + c.lane] = (bf16)f2bf(gate[(size_t)(b * T_ + t) * 24 + h * 3 + 2] * o);
    }
}
__device__ __forceinline__ void ph_slc_attn(const Ctx& c, const bf16* qn, const bf16* ks, const bf16* vs, const float* gate, const u64* sel, const bf16* ocmp, const bf16* owin, bf16* att) {
    for (int it = c.gw; it < B_ * 8 * T_; it += c.ngw) {
        const int t = it % T_, bh = it / T_, b = bh >> 3, h = bh & 7, g = h >> 2;
        const u64 mask = sel[(size_t)(b * 2 + g) * T_ + t];
        const float o = naive_attn_row<64>(qn + ((size_t)bh * T_ + t) * 64, ks + (size_t)(b * 2 + g) * T_ * 64, vs + (size_t)(b * 2 + g) * T_ * 64, t, mask,
                                           alibi_slope(h + 1, 8) * LOG2E, nullptr, 1 << 30, c.lane);
        const size_t n = (size_t)(b * T_ + t);
        const float r = gate[n * 24 + h * 3 + 1] * o + bf2f(ocmp[n * 512 + h * 64 + c.lane]) + bf2f(owin[n * 512 + h * 64 + c.lane]);
        att[n * 1024 + h * 64 + c.lane] = (bf16)f2bf(r);
    }
}
__device__ __forceinline__ void ph_fox_attn(const Ctx& c, const bf16* fq, const bf16* fk, const bf16* fv, const float* cum, bf16* att) {
    for (int it = c.gw; it < B_ * 4 * T_; it += c.ngw) {
        const int t = it % T_, bh = it / T_, b = bh >> 2, h = bh & 3;
        const int cur = t >> 6; const u64 mask = (cur == 63) ? ~0ull : ((1ull << (cur + 1)) - 1ull);
        const float o = naive_attn_row<64>(fq + ((size_t)bh * T_ + t) * 64, fk + (size_t)bh * T_ * 64, fv + (size_t)bh * T_ * 64, t, mask, 0.f, cum + (size_t)bh * T_, 1 << 30, c.lane);
        att[(size_t)(b * T_ + t) * 1024 + 512 + h * 64 + c.lane] = (bf16)f2bf(o);
    }
}
__device__ __forceinline__ void ph_diff_attn(const Ctx& c, const bf16* dq, const bf16* dk, const bf16* dv, const float* lam, const float* subln, float lambda_init, bf16* att) {
    float l1 = 0.f, l2 = 0.f;
    if (c.lane < 32) { l1 = lam[c.lane] * lam[32 + c.lane]; l2 = lam[64 + c.lane] * lam[96 + c.lane]; }
    const float lam_full = __expf(wave_sum(l1)) - __expf(wave_sum(l2)) + lambda_init;
    const float sg = subln[c.lane] * (1.f - lambda_init);
    for (int it = c.gw; it < B_ * 4 * T_; it += c.ngw) {
        const int t = it % T_, bh = it / T_, b = bh >> 2, h = bh & 3;
        const int cur = t >> 6; const u64 mask = (cur == 63) ? ~0ull : ((1ull << (cur + 1)) - 1ull);
        const float slope2 = alibi_slope(h + 1, 4) * LOG2E;
        const bf16* vb = dv + (size_t)bh * T_ * 64;
        const float o1 = naive_attn_row<32>(dq + ((size_t)(bh * 2 + 0) * T_ + t) * 32, dk + (size_t)(bh * 2 + 0) * T_ * 32, vb, t, mask, slope2, nullptr, 1 << 30, c.lane);
        const float o2 = naive_attn_row<32>(dq + ((size_t)(bh * 2 + 1) * T_ + t) * 32, dk + (size_t)(bh * 2 + 1) * T_ * 32, vb, t, mask, slope2, nullptr, 1 << 30, c.lane);
        const float o = o1 - lam_full * o2;
        const float r = rsqrtf(wave_sum(o * o) * (1.f / 64.f) + EPS);
        att[(size_t)(b * T_ + t) * 1024 + 768 + h * 64 + c.lane] = (bf16)f2bf(o * r * sg);
    }
}

__device__ __forceinline__ void ph_moe_route(const Ctx& c, const float* x, const float* g, const float* wgrp, const float* bgrp, const float* wexp, const float* bexp, bf16* hn, int* route_e, float* route_w, unsigned* cnt) {
    for (int row = c.gw; row < NT; row += c.ngw) {
        const f32x4* xr = (const f32x4*)(x + (size_t)row * D_) + c.lane;
        f32x4 v[4]; float ss = 0.f;
#pragma unroll
        for (int j = 0; j < 4; ++j) { v[j] = xr[64 * j]; ss += v[j].x * v[j].x + v[j].y * v[j].y + v[j].z * v[j].z + v[j].w * v[j].w; }
        const float r = rsqrtf(wave_sum(ss) * (1.f / D_) + EPS);
        u64* o8 = (u64*)(hn + (size_t)row * D_) + c.lane;
#pragma unroll
        for (int j = 0; j < 4; ++j) { const f32x4 gg = ((const f32x4*)g)[c.lane + 64 * j]; v[j] = v[j] * r * gg;
            o8[64 * j] = (u64)pk2(v[j].x, v[j].y) | ((u64)pk2(v[j].z, v[j].w) << 32); }
        float gl[4];
#pragma unroll
        for (int q = 0; q < 4; ++q) { float a = 0.f;
#pragma unroll
            for (int j = 0; j < 4; ++j) { const int k = 4 * (c.lane + 64 * j);
                a = fmaf(v[j].x, wgrp[(size_t)(k + 0) * 4 + q], a); a = fmaf(v[j].y, wgrp[(size_t)(k + 1) * 4 + q], a);
                a = fmaf(v[j].z, wgrp[(size_t)(k + 2) * 4 + q], a); a = fmaf(v[j].w, wgrp[(size_t)(k + 3) * 4 + q], a); }
            gl[q] = wave_sum(a) + bgrp[q]; }
        int grp = 0; float gm = gl[0];
#pragma unroll
        for (int q = 1; q < 4; ++q) if (gl[q] > gm) { gm = gl[q]; grp = q; }
        float gs = 0.f;
#pragma unroll
        for (int q = 0; q < 4; ++q) gs += __expf(gl[q] - gm);
        const float grp_gate = 1.f / gs;
        float el[8];
#pragma unroll
        for (int q = 0; q < 8; ++q) { float a = 0.f; const int col = grp * 8 + q;
#pragma unroll
            for (int j = 0; j < 4; ++j) { const int k = 4 * (c.lane + 64 * j);
                a = fmaf(v[j].x, wexp[(size_t)(k + 0) * 32 + col], a); a = fmaf(v[j].y, wexp[(size_t)(k + 1) * 32 + col], a);
                a = fmaf(v[j].z, wexp[(size_t)(k + 2) * 32 + col], a); a = fmaf(v[j].w, wexp[(size_t)(k + 3) * 32 + col], a); }
            el[q] = wave_sum(a) + bexp[col]; }
        int i0 = 0; float v0 = el[0];
#pragma unroll
        for (int q = 1; q < 8; ++q) if (el[q] > v0) { v0 = el[q]; i0 = q; }
        int i1 = -1; float v1 = -INFINITY;
#pragma unroll
        for (int q = 0; q < 8; ++q) if (q != i0 && el[q] > v1) { v1 = el[q]; i1 = q; }
        const float e1 = __expf(v1 - v0), den = 1.f + e1;
        if (c.lane == 0) { const float w0 = grp_gate / den, w1 = grp_gate * e1 / den;
            const int lo = i0 < i1 ? i0 : i1, hi = i0 < i1 ? i1 : i0, cls = grp * 28 + lo * 8 - (lo * (lo + 1)) / 2 + (hi - lo - 1);
            const unsigned rank = __hip_atomic_fetch_add(cnt + cls, 1u, __ATOMIC_RELAXED, __HIP_MEMORY_SCOPE_AGENT);
            route_e[row] = (int)(((unsigned)cls << 24) | rank); route_w[2 * row] = i0 < i1 ? w0 : w1; route_w[2 * row + 1] = i0 < i1 ? w1 : w0; }
    }
}
__device__ __forceinline__ void ph_moe_naive(const Ctx& c, const bf16* hn, const int* route_e, const float* route_w, const float* wg, const float* wu, const float* wd, float* x) {
    LAS float* hs = (LAS float*)c.lds;
    LAS float* au = hs + 1024;
    LAS float* h2 = au + 512;
    for (int row = c.bid; row < NT; row += c.G) {
        __syncthreads();
        hs[c.tid] = bf2f(hn[(size_t)row * D_ + c.tid]); hs[c.tid + 512] = bf2f(hn[(size_t)row * D_ + c.tid + 512]);
        float o0 = 0.f, o1 = 0.f;
        for (int s = 0; s < 2; ++s) {
            const int e = route_e[2 * row + s]; const float w = route_w[2 * row + s];
            __syncthreads();
            const float* W = (c.tid < 256 ? wg : wu) + (size_t)e * D_ * DEXP + (c.tid & 255);
            float a = 0.f;
            for (int k = 0; k < D_; ++k) a = fmaf(hs[k], W[(size_t)k * DEXP], a);
            au[c.tid] = a;
            __syncthreads();
            if (c.tid < 256) { const float ga = au[c.tid], up = au[c.tid + 256]; h2[c.tid] = ga / (1.f + __expf(-ga)) * up * w; }
            __syncthreads();
            const float* Wd = wd + (size_t)e * DEXP * D_;
            for (int k = 0; k < DEXP; ++k) { const float hv = h2[k]; o0 = fmaf(hv, Wd[(size_t)k * D_ + c.tid], o0); o1 = fmaf(hv, Wd[(size_t)k * D_ + c.tid + 512], o1); }
        }
        x[(size_t)row * D_ + c.tid] += o0; x[(size_t)row * D_ + c.tid + 512] += o1;
    }
    __syncthreads();
}

typedef __attribute__((address_space(4))) const Params* KP;
__device__ __forceinline__ KP uni_kp(KP p) { const unsigned long long v = (unsigned long long)p; const unsigned lo = __builtin_amdgcn_readfirstlane((unsigned)v), hi = __builtin_amdgcn_readfirstlane((unsigned)(v >> 32)); return (KP)(((unsigned long long)hi << 32) | lo); }
constexpr int PH_PER_LAYER = 11, N_PHASES = L_ * PH_PER_LAYER + 2;
__device__ __forceinline__ Ctx make_ctx(KP p) {
    Ctx c; c.lds = (LAS unsigned char*)lds_raw; { int t_ = threadIdx.x; asm volatile("" : "+v"(t_)); c.tid = t_; } c.lane = c.tid & 63; c.wave = __builtin_amdgcn_readfirstlane(c.tid >> 6);
    c.bid = blockIdx.x; c.G = gridDim.x; c.gw = c.bid * NWAVES + c.wave; c.ngw = c.G * NWAVES; c.in = nullptr; c.xcur = p->out; c.ws = p->ws;
    return c;
}
struct Bufs {
    bf16 *QN, *KV6, *KC, *VC, *KS, *VS, *KW, *VW, *FQ, *FK, *FV, *DQ, *DK, *DV, *HC, *KCMP, *VCMP, *OCMP, *OWIN, *HN, *ATT;
    float *GATE, *FL, *ROUTE_W; u64* SEL; int* ROUTE_E;
};
__device__ __forceinline__ Bufs make_bufs(unsigned char* ws) {
    Bufs b;
    b.QN = (bf16*)(ws + WS_QN); b.KV6 = (bf16*)(ws + WS_KV6);
    b.KC = (bf16*)(ws + WS_KV6 + 0 * KV6_STRIDE); b.VC = (bf16*)(ws + WS_KV6 + 1 * KV6_STRIDE);
    b.KS = (bf16*)(ws + WS_KV6 + 2 * KV6_STRIDE); b.VS = (bf16*)(ws + WS_KV6 + 3 * KV6_STRIDE);
    b.KW = (bf16*)(ws + WS_KV6 + 4 * KV6_STRIDE); b.VW = (bf16*)(ws + WS_KV6 + 5 * KV6_STRIDE);
    b.FQ = (bf16*)(ws + WS_FQKV); b.FK = b.FQ + 8 * MiB; b.FV = b.FQ + 16 * MiB;
    b.DQ = (bf16*)(ws + WS_DQK); b.DK = b.DQ + 8 * MiB; b.DV = (bf16*)(ws + WS_DV);
    b.GATE = (float*)(ws + WS_GATE); b.FL = (float*)(ws + WS_FL);
    b.HC = (bf16*)(ws + WS_HC); b.KCMP = (bf16*)(ws + WS_KVCMP); b.VCMP = b.KCMP + 16 * 256 * 64;
    b.SEL = (u64*)(ws + WS_SEL); b.OCMP = (bf16*)(ws + WS_OCMP); b.OWIN = (bf16*)(ws + WS_OWIN);
    b.HN = (bf16*)(ws + WS_HN); b.ATT = (bf16*)(ws + WS_ATT);
    b.ROUTE_E = (int*)(ws + WS_ROUTE); b.ROUTE_W = (float*)(ws + WS_ROUTE + 512 * 1024);
    return b;
}
__device__ __forceinline__ float lambda_init_of(int l) { return l == 0 ? 0.2f : 0.35550906759096926f; }

__device__ __noinline__ void P_prologue(KP p_) { const KP p = uni_kp(p_);
    const Ctx c = make_ctx(p); unsigned char* ws = p->ws;
    LAS float* scr = (LAS float*)(c.lds) + c.wave * (64 * 33);
    constexpr int I_A = 16 * 40, I_B = 16 * 24, I_C = 16 * 24, I_O = 16 * 32, I_G = 16 * 8, I_D = 4 * 32, I_E = 2 * I_G + I_D, I_W1 = 32 * 8, I_W2 = 4 * 2;
    constexpr int PER_L = I_A + I_B + I_C + I_O + 2 * (I_W1 + I_W2);
    for (int it = c.gw; it < L_ * PER_L; it += c.ngw) {
        const int l = it / PER_L; int r = it % PER_L;
        const float* W; bf16* WT; int ldw, K, sc0, ncol, r0 = 0, rmul = 1;
        if (r < I_A + I_B + I_C) { W = p->in[2] + (size_t)l * D_ * D_IN; WT = (bf16*)(ws + WS_WIN_T) + (size_t)l * NIN * D_; ldw = D_IN; K = D_;
            if (r < I_A) { sc0 = 0; ncol = 1280; r0 = 0; } else if (r < I_A + I_B) { r -= I_A; sc0 = C_FQ; ncol = 768; r0 = 1280; } else { r -= I_A + I_B; sc0 = C_DQ; ncol = 768; r0 = 2048; } }
        else if ((r -= I_A + I_B + I_C) < I_O) { W = p->in[13] + (size_t)l * D_ * D_; WT = (bf16*)(ws + WS_WOUT_T) + (size_t)l * D_ * D_; ldw = D_; K = D_; sc0 = 0; ncol = 1024; }
        else { r -= I_O; const int kv = r / (I_W1 + I_W2); r = r % (I_W1 + I_W2); const size_t lk = (size_t)l * 2 + kv;
            if (r < I_W1) { W = p->in[kv == 0 ? 6 : 9] + (size_t)l * 2048 * 256; WT = (bf16*)(ws + WS_W1_T) + lk * 256 * 2048; ldw = 256; K = 2048; sc0 = 0; ncol = 256; }
            else { r -= I_W1; W = p->in[kv == 0 ? 7 : 10] + (size_t)l * 256 * 64; WT = (bf16*)(ws + WS_W2_T) + lk * 64 * 256; ldw = 64; K = 256; sc0 = 0; ncol = 64; } }
        transpose_seg(W, ldw, K, sc0, ncol, WT, r0, rmul, r, scr, c.lane);
    }
    for (int i = c.bid * NTHREADS + c.tid; i < L_ * 256 * D_; i += c.G * NTHREADS) {
        const int l = i / (256 * D_), rr = (i / D_) % 256, k = i % D_;
        const float* win = p->in[2] + (size_t)l * D_ * D_IN;
        float v = 0.f; if (rr < 24) v = win[(size_t)k * D_IN + C_GATE + rr]; else if (rr < 28) v = win[(size_t)k * D_IN + C_FF + (rr - 24)];
        ((bf16*)(ws + WS_WIN_T))[((size_t)l * NIN + 2816 + rr) * D_ + k] = (bf16)f2bf(v);
    }
    for (int w = c.gw; w < L_ * 2 * 4 * 128; w += c.ngw) {
        const int lk = w >> 9, cg = (w >> 7) & 3, kc = w & 127, l = lk >> 1, kv = lk & 1, j = cg * 64 + c.lane;
        const float* pe = p->in[kv == 0 ? 5 : 8] + (size_t)l * 2048 + kc * 16; const float* w1 = p->in[kv == 0 ? 6 : 9] + (size_t)l * 2048 * 256 + (size_t)kc * 16 * 256;
        float a = 0.f;
#pragma unroll
        for (int k = 0; k < 16; ++k) a = fmaf(pe[k], w1[(size_t)k * 256 + j], a);
        ((float*)(ws + WS_B1PART))[((size_t)lk * 128 + kc) * 256 + j] = a;
    }
    for (int i = c.bid * NTHREADS + c.tid; i < L_ * 64 * 2 * 64; i += c.G * NTHREADS) {
        const int l = i / (64 * 2 * 64), ks = (i / 128) % 64, cb = (i / 64) & 1, lane = i & 63, col = 32 * cb + (lane & 31);
        unsigned hi[4], lo[4];
#pragma unroll
        for (int jp = 0; jp < 4; ++jp) { float v[2];
#pragma unroll
            for (int e = 0; e < 2; ++e) { const int k = 16 * ks + 8 * (lane >> 5) + 2 * jp + e; const float g = p->in[14][(size_t)l * D_ + k];
                v[e] = col < 4 ? g * p->in[15][((size_t)l * D_ + k) * 4 + col] : (col < 36 ? g * p->in[17][((size_t)l * D_ + k) * 32 + (col - 4)] : 0.f); }
            const unsigned h0 = f2bf(v[0]), h1 = f2bf(v[1]); hi[jp] = h0 | (h1 << 16);
            lo[jp] = f2bf(v[0] - __uint_as_float(h0 << 16)) | (f2bf(v[1] - __uint_as_float(h1 << 16)) << 16); }
        u32x4* dst = (u32x4*)(ws + WS_WR) + ((size_t)((l * 64 + ks) * 2 + cb) * 2) * 64 + lane;
        dst[0] = (u32x4){hi[0], hi[1], hi[2], hi[3]}; dst[64] = (u32x4){lo[0], lo[1], lo[2], lo[3]};
    }
}
__device__ __forceinline__ void P_inproj_mfma(int l_) { const KP p = (KP)__builtin_amdgcn_kernarg_segment_ptr(); int l = l_; asm volatile("" : "+s"(l));
    unsigned char* ws = p->ws; asm volatile("" : "+s"(ws));
    PlainOrder S; S.init(p->out, (const bf16*)(ws + WS_WIN_T) + (size_t)l * NIN * D_, D_, D_, NT, NIN, (int)gridDim.x, launder_s((int)blockIdx.x));
#ifdef STAGGER_TICKS
    { const unsigned long long t0 = __builtin_amdgcn_s_memrealtime(); const unsigned long long d = (unsigned long long)((launder_s((int)blockIdx.x) >> 3) & 3) * STAGGER_TICKS;
      while (__builtin_amdgcn_s_memrealtime() - t0 < d) __builtin_amdgcn_s_sleep(4); }
#endif
    const pg8::Gemm g{D_, D_, D_, D_ / 64, 0, 0};
    const EpiInProj E{ws, p->in[3] + l * 24, p->in[4] + l * 4, (unsigned*)(ws + WS_CTL) + CW_KN + l * 8192};
    pg8::gemm_phase<EpiInProj, PlainOrder, INPROJ_ALIGN, INPROJ_SP2>((LAS unsigned char*)lds_raw, g, S, E);
}
__device__ __forceinline__ void P_inproj_dummy(int l_) { const KP p = (KP)__builtin_amdgcn_kernarg_segment_ptr(); int l = l_; asm volatile("" : "+s"(l));
    unsigned char* ws = p->ws; asm volatile("" : "+s"(ws));
    PlainOrder S; S.init(p->out, (const bf16*)(ws + WS_WIN_T) + (size_t)l * NIN * D_, D_, D_, NT, NIN, (int)gridDim.x, launder_s((int)blockIdx.x));
    const pg8::Gemm g{D_, D_, D_, D_ / 64, 0, 0};
    const EpiDummy E{(float*)(ws + WS_HB)};
    pg8::gemm_phase<EpiDummy, PlainOrder, true, true>((LAS unsigned char*)lds_raw, g, S, E);
}
__device__ __forceinline__ void P_outproj_mfma(int l_) { const KP p = (KP)__builtin_amdgcn_kernarg_segment_ptr(); int l = l_; asm volatile("" : "+s"(l));
    unsigned char* ws = p->ws; asm volatile("" : "+s"(ws));
    PlainOrder S; S.init(ws + WS_ATT, (const bf16*)(ws + WS_WOUT_T) + (size_t)l * D_ * D_, D_, D_, NT, D_, (int)gridDim.x, launder_s((int)blockIdx.x));
    const pg8::Gemm g{D_, D_, D_, D_ / 64, 32, 8};
    const EpiResBf16 E{(bf16*)(ws + WS_HN)};
    pg8::gemm_phase<EpiResBf16, PlainOrder, true, true>((LAS unsigned char*)lds_raw, g, S, E);
}
__device__ __forceinline__ float wave_max_l(float v, int lane) {
#pragma unroll
    for (int o = 1; o < 64; o <<= 1) v = fmaxf(v, shflx_f(v, o, lane));
    return v;
}
__device__ __forceinline__ float wave_min_l(float v, int lane) {
#pragma unroll
    for (int o = 1; o < 64; o <<= 1) v = fminf(v, shflx_f(v, o, lane));
    return v;
}
template <int NS> __device__ __forceinline__ float q_norm2_max(const bf16x8v (&Q)[NS], int lane) {
    float ss = 0.f;
#pragma unroll
    for (int s = 0; s < NS; ++s)
#pragma unroll
        for (int e = 0; e < 8; ++e) { const float v = __uint_as_float(((unsigned)(unsigned short)Q[s][e]) << 16); ss = fmaf(v, v, ss); }
    return wave_max_l(swap_sum(ss), lane);
}
__device__ __forceinline__ u64 prune_consensus(bool skip, LAS u64* slots, int wave, int lane) {
    const u64 mine = __ballot(skip);
    __syncthreads();
    if (lane == 0) slots[wave] = mine;
    __syncthreads();
    u64 all = slots[0];
#pragma unroll
    for (int w = 1; w < NWAVES; ++w) all &= slots[w];
    return all;
}
__device__ __forceinline__ bool block_any(bool v, LAS u64* slots, int wave, int lane) {
#ifdef FORCE_FALLBACK
    v = true;
#endif
    const u64 mine = __ballot(v);
    __syncthreads();
    if (lane == 0) slots[wave] = mine;
    __syncthreads();
    u64 all = slots[0];
#pragma unroll
    for (int w = 1; w < NWAVES; ++w) all |= slots[w];
    return all != 0ull;
}
__device__ __forceinline__ bool sum_bad(float l) { return !(l < 1e30f); }
__device__ __forceinline__ void U_fox(KP p_, int bh_, int qb_, int l_) {
    const KP p = uni_kp(p_); const int bh = __builtin_amdgcn_readfirstlane(bh_), qb = __builtin_amdgcn_readfirstlane(qb_), l = __builtin_amdgcn_readfirstlane(l_);
    int tid_ = threadIdx.x; asm volatile("" : "+v"(tid_));
    const int tid = tid_, lane = tid & 63, wave = __builtin_amdgcn_readfirstlane(tid >> 6), r = lane & 31, h = lane >> 5;
    unsigned char* ws = p->ws; asm volatile("" : "+s"(ws)); LAS unsigned char* L = (LAS unsigned char*)lds_raw;
    const int tw0 = 256 * qb + 32 * wave, t_lane = tw0 + r, b = bh >> 2, hd = bh & 3;
    const bf16* q = (const bf16*)(ws + WS_FQKV) + (size_t)bh * T_ * 64 + (t_lane >> 4) * 1024 + (t_lane & 15) * 32 + 8 * h;
    bf16x8v Qf[1][4];
#pragma unroll
    for (int s = 0; s < 4; ++s) Qf[0][s] = *(const bf16x8v*)(q + (s >> 1) * 512 + (s & 1) * 16);
    const bf16* Kp = (const bf16*)(ws + WS_FQKV) + 8 * MiB + (size_t)bh * T_ * 64; const bf16* Vp = (const bf16*)(ws + WS_FQKV) + 16 * MiB + (size_t)bh * T_ * 64;
    u32x4 kpre, vpre; attn_preload<64>(Kp, nullptr, Vp, 4 * qb + 3, tid, kpre, vpre);
    LAS float* cum = (LAS float*)(L + A_LDS_END);
    { const float* fl = (const float*)(ws + WS_FL) + (size_t)bh * T_; LAS float* tot = cum + 4096;
      const int nval = 256 * (qb + 1); float v[8];
      if (8 * tid < nval) { const f32x4 a = *(const f32x4*)(fl + 8 * tid), c2 = *(const f32x4*)(fl + 8 * tid + 4); v[0] = a.x; v[1] = a.y; v[2] = a.z; v[3] = a.w; v[4] = c2.x; v[5] = c2.y; v[6] = c2.z; v[7] = c2.w; }
      else {
#pragma unroll
          for (int i = 0; i < 8; ++i) v[i] = 0.f; }
#pragma unroll
      for (int i = 1; i < 8; ++i) v[i] += v[i - 1];
      float sc = v[7];
#pragma unroll
      for (int o = 1; o < 64; o <<= 1) { const float up = __uint_as_float((unsigned)__builtin_amdgcn_ds_bpermute((lane - o) << 2, (int)__float_as_uint(sc))); if (lane >= o) sc += up; }
      if (lane == 63) tot[wave] = sc;
      __syncthreads();
      float base = sc - v[7];
      for (int w = 0; w < wave; ++w) base += tot[w];
      if (8 * tid < nval) {
#pragma unroll
          for (int i = 0; i < 8; ++i) cum[8 * tid + i] = v[i] + base; }
      __syncthreads(); }
    f32x16 O[1][2]; float M[1] = {0.f}, Ls[1] = {0.f};
#pragma unroll
    for (int i = 0; i < 16; ++i) { O[0][0][i] = 0.f; O[0][1][i] = 0.f; }
    const u64 tm = (qb == 15) ? ~0ull : ((1ull << (4 * qb + 4)) - 1ull);
#if AC2_MODE == 0
    {
        const u64 low = (1ull << (4 * qb)) - 1ull; const float cref = cum[tw0];
#define FOX_CORES(NM, FIRSTCALL) do { FIRSTCALL; \
        if (qb > 0) { \
            const float qn2 = q_norm2_max<4>(Qf[0], lane), mmin = wave_min_l(M[0], lane); \
            const float* kn = (const float*)((const unsigned*)(ws + WS_CTL) + CW_KN + l * 8192) + ((size_t)bh * 64 + lane) * 2; \
            bool skip = false; \
            if (lane < 4 * qb) { const float kn2 = kn[0] + kn[1]; const float bound = sqrtf(qn2 * kn2) * 1.02f + (cref - cum[64 * lane + 63]) * LOG2E - mmin; skip = bound < -152.f; } \
            const u64 drop = prune_consensus(skip, (LAS u64*)(cum + 4096 + 16), wave, lane); \
            const u64 tm2 = low & ~drop; \
            if (tm2) attn_core<64, 1, true, false, false, NM>(L, Kp, nullptr, Vp, cum, cref, Qf, tm2, t_lane, tw0, 1 << 30, 0.f, 0u, 0u, O, M, Ls, tid, true); \
        } } while (0)
        FOX_CORES(NOMAX_ON, (attn_core<64, 1, true, false, true, NOMAX_ON>(L, Kp, nullptr, Vp, cum, cref, Qf, tm & ~low, t_lane, tw0, 1 << 30, 0.f, 0u, 0u, O, M, Ls, tid, false, 4 * qb + 3, kpre, vpre)));
        if (NOMAX_ON && block_any(sum_bad(Ls[0]), (LAS u64*)(cum + 4096 + 32), wave, lane)) {
#pragma unroll
            for (int i = 0; i < 16; ++i) { O[0][0][i] = 0.f; O[0][1][i] = 0.f; }
            M[0] = 0.f; Ls[0] = 0.f;
            FOX_CORES(false, (attn_core<64, 1, true, false, false, false>(L, Kp, nullptr, Vp, cum, cref, Qf, tm & ~low, t_lane, tw0, 1 << 30, 0.f, 0u, 0u, O, M, Ls, tid)));
        }
#undef FOX_CORES
    }
#else
    attn_core2<true, false>(L, (const bf16*)(ws + WS_FQKV) + 8 * MiB + (size_t)bh * T_ * 64, (const bf16*)(ws + WS_FQKV) + 16 * MiB + (size_t)bh * T_ * 64, cum, cum[256 * qb],
                            Qf[0], tm, t_lane, tw0, 1 << 30, 0.f, 0u, 0u, O[0], M[0], Ls[0], tid);
#endif
    const float lt = swap_sum(Ls[0]), inv = lt > 0.f ? 1.f / lt : 0.f;
    bf16* dst = (bf16*)(ws + WS_ATT) + mix_off((size_t)b * T_ + t_lane, 512 + hd * 64 + 4 * h, 1024);
    ATTN_FOR_CHUNKS(db, g4) { const unsigned w0 = cvtpk(O[0][db][4 * g4 + 0] * inv, O[0][db][4 * g4 + 1] * inv), w1 = cvtpk(O[0][db][4 * g4 + 2] * inv, O[0][db][4 * g4 + 3] * inv);
        *(u64*)(dst + (4 * db + g4) * 256) = (u64)w0 | ((u64)w1 << 32); }
}
__device__ __forceinline__ void U_diff(KP p_, int bh_, int qb_, int l_) {
    const KP p = uni_kp(p_); const int bh = __builtin_amdgcn_readfirstlane(bh_), qb = __builtin_amdgcn_readfirstlane(qb_), l = __builtin_amdgcn_readfirstlane(l_);
    int tid_ = threadIdx.x; asm volatile("" : "+v"(tid_));
    const int tid = tid_, lane = tid & 63, wave = __builtin_amdgcn_readfirstlane(tid >> 6), r = lane & 31, h = lane >> 5;
    unsigned char* ws = p->ws; asm volatile("" : "+s"(ws)); LAS unsigned char* L = (LAS unsigned char*)lds_raw;
    const int tw0 = 256 * qb + 32 * wave, t_lane = tw0 + r, b = bh >> 2, hd = bh & 3;
    const bf16* DQ = (const bf16*)(ws + WS_DQK); const bf16* DK = DQ + 8 * MiB;
    bf16x8v Qf[2][2];
#pragma unroll
    for (int mp = 0; mp < 2; ++mp)
#pragma unroll
        for (int s = 0; s < 2; ++s) Qf[mp][s] = *(const bf16x8v*)(DQ + ((size_t)(bh * 2 + mp) * T_ + t_lane) * 32 + 16 * s + 8 * h);
    f32x16 O[2][2]; float M[2] = {0.f, 0.f}, Ls[2] = {0.f, 0.f};
#pragma unroll
    for (int i = 0; i < 16; ++i) { O[0][0][i] = 0.f; O[0][1][i] = 0.f; O[1][0][i] = 0.f; O[1][1][i] = 0.f; }
    const u64 tm = (qb == 15) ? ~0ull : ((1ull << (4 * qb + 4)) - 1ull);
    {
        const u64 low = (1ull << (4 * qb)) - 1ull; const float slope2 = alibi_slope(hd + 1, 4) * LOG2E;
        const bf16* K0 = DK + (size_t)(bh * 2 + 0) * T_ * 32; const bf16* K1 = DK + (size_t)(bh * 2 + 1) * T_ * 32; const bf16* Vp = (const bf16*)(ws + WS_DV) + (size_t)bh * T_ * 64;
#define DIFF_CORES(NM) do { \
        attn_core<32, 2, false, false, false, NM>(L, K0, K1, Vp, nullptr, 0.f, Qf, tm & ~low, t_lane, tw0, 1 << 30, slope2, 0u, 0u, O, M, Ls, tid); \
        if (qb > 0) { \
            const float qa = q_norm2_max<2>(Qf[0], lane), qb2 = q_norm2_max<2>(Qf[1], lane), ma = wave_min_l(M[0], lane), mb = wave_min_l(M[1], lane); \
            const float* kn = (const float*)((const unsigned*)(ws + WS_CTL) + CW_KN + l * 8192 + 4096) + (size_t)(bh * 2) * 64 + lane; \
            bool skip = false; \
            if (lane < 4 * qb) { const float bmax = slope2 * (float)(64 * lane + 63 - tw0);            \
                skip = (sqrtf(qa * kn[0]) * 1.02f + bmax - ma < -152.f) && (sqrtf(qb2 * kn[64]) * 1.02f + bmax - mb < -152.f); } \
            const u64 drop = prune_consensus(skip, (LAS u64*)(L + A_LDS_END), wave, lane); \
            const u64 tm2 = low & ~drop; \
            if (tm2) attn_core<32, 2, false, false, false, NM>(L, K0, K1, Vp, nullptr, 0.f, Qf, tm2, t_lane, tw0, 1 << 30, slope2, 0u, 0u, O, M, Ls, tid, true); \
        } } while (0)
        DIFF_CORES(NOMAX_ON);
        if (NOMAX_ON && block_any(sum_bad(Ls[0]) || sum_bad(Ls[1]), (LAS u64*)(L + A_LDS_END + 64), wave, lane)) {
#pragma unroll
            for (int i = 0; i < 16; ++i) { O[0][0][i] = 0.f; O[0][1][i] = 0.f; O[1][0][i] = 0.f; O[1][1][i] = 0.f; }
            M[0] = 0.f; M[1] = 0.f; Ls[0] = 0.f; Ls[1] = 0.f;
            DIFF_CORES(false);
        }
#undef DIFF_CORES
    }
    const float* lam = p->in[11] + (size_t)l * 128; const float* subln = p->in[12] + (size_t)l * 64;
    float l1 = 0.f, l2 = 0.f; if (lane < 32) { l1 = lam[lane] * lam[32 + lane]; l2 = lam[64 + lane] * lam[96 + lane]; }
    const float li = lambda_init_of(l), lam_full = __expf(wave_sum_l(l1, lane)) - __expf(wave_sum_l(l2, lane)) + li;
    const float lt0 = swap_sum(Ls[0]), lt1 = swap_sum(Ls[1]), i0 = lt0 > 0.f ? 1.f / lt0 : 0.f, i1 = (lt1 > 0.f ? 1.f / lt1 : 0.f) * lam_full;
    float ss = 0.f;
#pragma unroll
    for (int db = 0; db < 2; ++db)
#pragma unroll
        for (int i = 0; i < 16; ++i) { const float o = O[0][db][i] * i0 - O[1][db][i] * i1; O[0][db][i] = o; ss += o * o; }
    ss = swap_sum(ss);
    const float rn = rsqrtf(ss * (1.f / 64.f) + EPS) * (1.f - li);
    bf16* dst = (bf16*)(ws + WS_ATT) + mix_off((size_t)b * T_ + t_lane, 768 + hd * 64 + 4 * h, 1024);
    ATTN_FOR_CHUNKS(db, g4) { const f32x4 sg = *(const f32x4*)(subln + 32 * db + 8 * g4 + 4 * h);
        const unsigned w0 = cvtpk(O[0][db][4 * g4 + 0] * rn * sg.x, O[0][db][4 * g4 + 1] * rn * sg.y), w1 = cvtpk(O[0][db][4 * g4 + 2] * rn * sg.z, O[0][db][4 * g4 + 3] * rn * sg.w);
        *(u64*)(dst + (4 * db + g4) * 256) = (u64)w0 | ((u64)w1 << 32); }
}
__device__ __forceinline__ void U_win(KP p_, int bg_, int c_) {
    const KP p = uni_kp(p_); const int bg = __builtin_amdgcn_readfirstlane(bg_), cc = __builtin_amdgcn_readfirstlane(c_);
    int tid_ = threadIdx.x; asm volatile("" : "+v"(tid_));
    const int tid = tid_, lane = tid & 63, wave = __builtin_amdgcn_readfirstlane(tid >> 6), r = lane & 31, h = lane >> 5;
    unsigned char* ws = p->ws; asm volatile("" : "+s"(ws)); LAS unsigned char* L = (LAS unsigned char*)lds_raw;
    const int b = bg >> 1, g = bg & 1, hd = g * 4 + (wave >> 1), tw0 = 64 * cc + 32 * (wave & 1), t_lane = tw0 + r;
    const bf16* q = (const bf16*)(ws + WS_QN) + (size_t)(b * 8 + hd) * T_ * 64 + (t_lane >> 4) * 1024 + (t_lane & 15) * 32 + 8 * h;
    bf16x8v Qf[1][4];
#pragma unroll
    for (int s = 0; s < 4; ++s) Qf[0][s] = *(const bf16x8v*)(q + (s >> 1) * 512 + (s & 1) * 16);
    f32x16 O[1][2]; float M[1] = {0.f}, Ls[1] = {0.f};
#pragma unroll
    for (int i = 0; i < 16; ++i) { O[0][0][i] = 0.f; O[0][1][i] = 0.f; }
    const size_t n = (size_t)b * T_ + t_lane;
    const float gate_w = ((const float*)(ws + WS_GATE))[n * 24 + hd * 3 + 2];
    const int jlo = cc > 8 ? cc - 8 : 0;
    const u64 hi = (cc == 63) ? ~0ull : ((1ull << (cc + 1)) - 1ull), tm = hi & ~((1ull << jlo) - 1ull);
#if AC2_MODE == 0
    attn_core<64, 1, false, false, false, NOMAX_ON>(L, (const bf16*)(ws + WS_KV6 + 4 * KV6_STRIDE) + (size_t)bg * T_ * 64, nullptr, (const bf16*)(ws + WS_KV6 + 5 * KV6_STRIDE) + (size_t)bg * T_ * 64, nullptr, 0.f,
                                   Qf, tm, t_lane, tw0, 512, alibi_slope(hd + 1, 8) * LOG2E, 0u, 0u, O, M, Ls, tid);
    if (NOMAX_ON && block_any(sum_bad(Ls[0]), (LAS u64*)(L + A_LDS_END + 64), wave, lane)) {
#pragma unroll
        for (int i = 0; i < 16; ++i) { O[0][0][i] = 0.f; O[0][1][i] = 0.f; }
        M[0] = 0.f; Ls[0] = 0.f;
        attn_core<64, 1, false, false, false, false>(L, (const bf16*)(ws + WS_KV6 + 4 * KV6_STRIDE) + (size_t)bg * T_ * 64, nullptr, (const bf16*)(ws + WS_KV6 + 5 * KV6_STRIDE) + (size_t)bg * T_ * 64, nullptr, 0.f,
                                       Qf, tm, t_lane, tw0, 512, alibi_slope(hd + 1, 8) * LOG2E, 0u, 0u, O, M, Ls, tid);
    }
#ifdef PROBE_WINCORE2
    attn_core<64, 1, false, false>(L, (const bf16*)(ws + WS_KV6 + 4 * KV6_STRIDE) + (size_t)bg * T_ * 64, nullptr, (const bf16*)(ws + WS_KV6 + 5 * KV6_STRIDE) + (size_t)bg * T_ * 64, nullptr, 0.f,
                                   Qf, tm, t_lane, tw0, 512, alibi_slope(hd + 1, 8) * LOG2E, 0u, 0u, O, M, Ls, tid, true);
#endif
#else
    attn_core2<false, false>(L, (const bf16*)(ws + WS_KV6 + 4 * KV6_STRIDE) + (size_t)bg * T_ * 64, (const bf16*)(ws + WS_KV6 + 5 * KV6_STRIDE) + (size_t)bg * T_ * 64, nullptr, 0.f,
                             Qf[0], tm, t_lane, tw0, 512, alibi_slope(hd + 1, 8) * LOG2E, 0u, 0u, O[0], M[0], Ls[0], tid);
#endif
    const float lt = swap_sum(Ls[0]), inv = (lt > 0.f ? 1.f / lt : 0.f) * gate_w;
    bf16* dst = (bf16*)(ws + WS_OWIN) + mix_off(n, hd * 64 + 4 * h, 512);
    ATTN_FOR_CHUNKS(db, g4) { const unsigned w0 = cvtpk(O[0][db][4 * g4 + 0] * inv, O[0][db][4 * g4 + 1] * inv), w1 = cvtpk(O[0][db][4 * g4 + 2] * inv, O[0][db][4 * g4 + 3] * inv);
        *(u64*)(dst + (4 * db + g4) * 256) = (u64)w0 | ((u64)w1 << 32); }
}
__device__ __forceinline__ void U_slc(KP p_, int bg_, int c_) {
    const KP p = uni_kp(p_); const int bg = __builtin_amdgcn_readfirstlane(bg_), cc = __builtin_amdgcn_readfirstlane(c_);
    int tid_ = threadIdx.x; asm volatile("" : "+v"(tid_));
    const int tid = tid_, lane = tid & 63, wave = __builtin_amdgcn_readfirstlane(tid >> 6), r = lane & 31, h = lane >> 5;
    unsigned char* ws = p->ws; asm volatile("" : "+s"(ws)); LAS unsigned char* L = (LAS unsigned char*)lds_raw;
    const int b = bg >> 1, g = bg & 1, hd = g * 4 + (wave >> 1), tw0 = 64 * cc + 32 * (wave & 1), t_lane = tw0 + r;
    const bf16* q = (const bf16*)(ws + WS_QN) + (size_t)(b * 8 + hd) * T_ * 64 + (t_lane >> 4) * 1024 + (t_lane & 15) * 32 + 8 * h;
    bf16x8v Qf[1][4];
#pragma unroll
    for (int s = 0; s < 4; ++s) Qf[0][s] = *(const bf16x8v*)(q + (s >> 1) * 512 + (s & 1) * 16);
    f32x16 O[1][2]; float M[1] = {0.f}, Ls[1] = {0.f};
#pragma unroll
    for (int i = 0; i < 16; ++i) { O[0][0][i] = 0.f; O[0][1][i] = 0.f; }
    const bf16* Ksl = (const bf16*)(ws + WS_KV6 + 2 * KV6_STRIDE) + (size_t)bg * T_ * 64; const bf16* Vsl = (const bf16*)(ws + WS_KV6 + 3 * KV6_STRIDE) + (size_t)bg * T_ * 64;
    u32x4 kpre, vpre; attn_preload<64>(Ksl, nullptr, Vsl, cc, tid, kpre, vpre);
    const size_t n = (size_t)b * T_ + t_lane;
    const float gate_s = ((const float*)(ws + WS_GATE))[n * 24 + hd * 3 + 1];
    const bf16* oc = (const bf16*)(ws + WS_OCMP) + mix_off(n, hd * 64 + 4 * h, 512); const bf16* ow = (const bf16*)(ws + WS_OWIN) + mix_off(n, hd * 64 + 4 * h, 512);
    u64 ocv[8], owv[8];
    ATTN_FOR_CHUNKS(db, g4) { ocv[4 * db + g4] = *(const u64*)(oc + (4 * db + g4) * 256); owv[4 * db + g4] = *(const u64*)(ow + (4 * db + g4) * 256); }
    const u64* sel = (const u64*)(ws + WS_SEL) + (size_t)bg * T_;
    const u64 mine = sel[t_lane]; u64 un = sel[64 * cc + lane];
    { unsigned ul = (unsigned)un, uh = (unsigned)(un >> 32);
#pragma unroll
      for (int o = 1; o < 64; o <<= 1) { ul |= shflx_u(ul, o, lane); uh |= shflx_u(uh, o, lane); }
      un = ((u64)__builtin_amdgcn_readfirstlane(uh) << 32) | __builtin_amdgcn_readfirstlane(ul); }
#if AC2_MODE == 0
    attn_core<64, 1, false, true, true, NOMAX_ON>(L, Ksl, nullptr, Vsl, nullptr, 0.f,
                                  Qf, un, t_lane, tw0, 1 << 30, alibi_slope(hd + 1, 8) * LOG2E, (unsigned)mine, (unsigned)(mine >> 32), O, M, Ls, tid, false, cc, kpre, vpre);
    if (NOMAX_ON && block_any(sum_bad(Ls[0]), (LAS u64*)(L + A_LDS_END + 64), wave, lane)) {
#pragma unroll
        for (int i = 0; i < 16; ++i) { O[0][0][i] = 0.f; O[0][1][i] = 0.f; }
        M[0] = 0.f; Ls[0] = 0.f;
        attn_core<64, 1, false, true, false, false>(L, Ksl, nullptr, Vsl, nullptr, 0.f, Qf, un, t_lane, tw0, 1 << 30, alibi_slope(hd + 1, 8) * LOG2E, (unsigned)mine, (unsigned)(mine >> 32), O, M, Ls, tid);
    }
#else
    attn_core2<false, true>(L, (const bf16*)(ws + WS_KV6 + 2 * KV6_STRIDE) + (size_t)bg * T_ * 64, (const bf16*)(ws + WS_KV6 + 3 * KV6_STRIDE) + (size_t)bg * T_ * 64, nullptr, 0.f,
                            Qf[0], un, t_lane, tw0, 1 << 30, alibi_slope(hd + 1, 8) * LOG2E, (unsigned)mine, (unsigned)(mine >> 32), O[0], M[0], Ls[0], tid);
#endif
    const float lt = swap_sum(Ls[0]), inv = (lt > 0.f ? 1.f / lt : 0.f) * gate_s;
    bf16* dst = (bf16*)(ws + WS_ATT) + mix_off(n, hd * 64 + 4 * h, 1024);
    ATTN_FOR_CHUNKS(db, g4) { const u64 a = ocv[4 * db + g4], w = owv[4 * db + g4];
        const float x0 = O[0][db][4 * g4 + 0] * inv + __uint_as_float((unsigned)a << 16) + __uint_as_float((unsigned)w << 16);
        const float x1 = O[0][db][4 * g4 + 1] * inv + __uint_as_float((unsigned)a & 0xffff0000u) + __uint_as_float((unsigned)w & 0xffff0000u);
        const float x2 = O[0][db][4 * g4 + 2] * inv + __uint_as_float((unsigned)(a >> 32) << 16) + __uint_as_float((unsigned)(w >> 32) << 16);
        const float x3 = O[0][db][4 * g4 + 3] * inv + __uint_as_float((unsigned)(a >> 32) & 0xffff0000u) + __uint_as_float((unsigned)(w >> 32) & 0xffff0000u);
        *(u64*)(dst + (4 * db + g4) * 256) = (u64)cvtpk(x0, x1) | ((u64)cvtpk(x2, x3) << 32); }
}
__device__ __forceinline__ float other_half(float x, int h) { auto rr = __builtin_amdgcn_permlane32_swap(__float_as_uint(x), __float_as_uint(x), false, false); return __uint_as_float(h ? rr[0] : rr[1]); }
__device__ __forceinline__ int other_half_i(int x, int h) { auto rr = __builtin_amdgcn_permlane32_swap((unsigned)x, (unsigned)x, false, false); return (int)(h ? rr[0] : rr[1]); }
template <bool MASK>
__device__ __forceinline__ void cmp_scores(f32x16& p0, f32x16& p1, const LAS unsigned char* kt, const bf16x8v (&Qf)[4], float b0, float s1, int cl, int nvis_l) {
    const float s8 = s1 * 8.f, s32 = s1 * 32.f;
    p0[0] = b0; p0[1] = p0[0] + s1; p0[2] = p0[1] + s1; p0[3] = p0[2] + s1;
#pragma unroll
    for (int reg = 4; reg < 16; ++reg) p0[reg] = p0[reg - 4] + s8;
#pragma unroll
    for (int reg = 0; reg < 16; ++reg) p1[reg] = p0[reg] + s32;
#pragma unroll
    for (int s = 0; s < 4; ++s) { const bf16x8v kf0 = *(const LAS bf16x8v*)(kt + s * 32), kf1 = *(const LAS bf16x8v*)(kt + 32 * 144 + s * 32);
        p0 = __builtin_amdgcn_mfma_f32_32x32x16_bf16(kf0, Qf[s], p0, 0, 0, 0); p1 = __builtin_amdgcn_mfma_f32_32x32x16_bf16(kf1, Qf[s], p1, 0, 0, 0); }
    if (MASK) {
#pragma unroll
        for (int reg = 0; reg < 16; ++reg) { const int c = cl + crow0(reg); p0[reg] = (c < nvis_l) ? p0[reg] : -INFINITY; p1[reg] = (c + 32 < nvis_l) ? p1[reg] : -INFINITY; } }
}
__device__ __forceinline__ void U_cmp(KP p_, int bg_, int u_) {
    const KP p = uni_kp(p_); const int bg = __builtin_amdgcn_readfirstlane(bg_), uu = __builtin_amdgcn_readfirstlane(u_);
    int tid_ = threadIdx.x; asm volatile("" : "+v"(tid_));
    const int tid = tid_, lane = tid & 63, wave = __builtin_amdgcn_readfirstlane(tid >> 6), r = lane & 31, h = lane >> 5;
    unsigned char* ws = p->ws; asm volatile("" : "+s"(ws)); LAS unsigned char* L = (LAS unsigned char*)lds_raw;
    const int b = bg >> 1, g = bg & 1, tw0 = 32 * (uu + 16 * (wave < 4 ? wave : 11 - wave)), t_lane = tw0 + r;
    { const bf16* kc = (const bf16*)(ws + WS_KVCMP) + (size_t)bg * 256 * 64; const bf16* vc = kc + 16 * 256 * 64;
#pragma unroll
      for (int i = 0; i < 4; ++i) { const int ch = tid + 512 * i, row = ch >> 3, c8 = ch & 7;
          *(LAS u32x4*)(L + row * 144 + c8 * 16) = *(const u32x4*)(kc + row * 64 + c8 * 8); *(LAS u32x4*)(L + 36864 + row * 144 + c8 * 16) = *(const u32x4*)(vc + row * 64 + c8 * 8); } }
    __syncthreads();
    const int nvis_l = t_lane >= 31 ? ((t_lane - 31) >> 4) + 1 : 0, nvis_max = (tw0 >> 4) + 1, nvis_min = tw0 >= 31 ? ((tw0 - 31) >> 4) + 1 : 0, ntile = (nvis_max + 63) >> 6;
    const LAS unsigned char* kfrag = L + r * 144 + h * 16;
    const LAS unsigned char* vfrag = L + 36864 + (4 * h + ((lane & 15) >> 2)) * 144 + (16 * ((lane >> 4) & 1) + 4 * (lane & 3)) * 2;
    float imp[32];
#pragma unroll
    for (int e = 0; e < 32; ++e) imp[e] = 0.f;
    const float* gate = (const float*)(ws + WS_GATE) + ((size_t)b * T_ + t_lane) * 24;
#pragma unroll 1
    for (int hg = 0; hg < 4; ++hg) {
        const int hd = g * 4 + hg; const float s1 = alibi_slope(hd + 1, 8) * LOG2E * 16.f;
        const bf16* q = (const bf16*)(ws + WS_QN) + (size_t)(b * 8 + hd) * T_ * 64 + (t_lane >> 4) * 1024 + (t_lane & 15) * 32 + 8 * h;
        bf16x8v Qf[4];
#pragma unroll
        for (int s = 0; s < 4; ++s) Qf[s] = *(const bf16x8v*)(q + (s >> 1) * 512 + (s & 1) * 16);
        f32x16 O0, O1;
#pragma unroll
        for (int i = 0; i < 16; ++i) { O0[i] = 0.f; O1[i] = 0.f; }
        float oscale = 0.f; bool bad;
        {
        float lsum = 0.f, carry = 0.f; float ih[32];
#pragma unroll
        for (int e = 0; e < 32; ++e) ih[e] = 0.f;
#pragma unroll
        for (int jt = 0; jt < 4; ++jt) if (jt < ntile) {
            f32x16 p0, p1; const float b0 = s1 * (float)(64 * jt + 4 * h - nvis_max);
            if (64 * jt + 63 >= nvis_min) cmp_scores<true>(p0, p1, kfrag + jt * (64 * 144), Qf, b0, s1, 64 * jt + 4 * h, nvis_l);
            else cmp_scores<false>(p0, p1, kfrag + jt * (64 * 144), Qf, b0, s1, 64 * jt + 4 * h, nvis_l);
            float rs = 0.f;
#pragma unroll
            for (int reg = 0; reg < 16; ++reg) { p0[reg] = __builtin_amdgcn_exp2f(p0[reg]); p1[reg] = __builtin_amdgcn_exp2f(p1[reg]); rs += p0[reg] + p1[reg]; }
            lsum += rs;
            float cv[8];
#pragma unroll
            for (int g4 = 0; g4 < 4; ++g4) { const float h0 = 0.5f * p0[4 * g4 + 3], h1 = 0.5f * p1[4 * g4 + 3];
                ih[jt * 8 + g4] += ((p0[4 * g4] + p0[4 * g4 + 1]) + p0[4 * g4 + 2]) + h0; ih[jt * 8 + 4 + g4] += ((p1[4 * g4] + p1[4 * g4 + 1]) + p1[4 * g4 + 2]) + h1;
                cv[g4] = h0; cv[4 + g4] = h1; }
            float prev = carry;
#pragma unroll
            for (int k = 0; k < 8; ++k) { const float sv = other_half(cv[k], h); ih[jt * 8 + k] += h ? sv : prev; prev = sv; }
            carry = prev;
            const bf16x8v pa0 = pack8(p0, 0), pa1 = pack8(p0, 8), pa2 = pack8(p1, 0), pa3 = pack8(p1, 8);
            const LAS unsigned char* vb = vfrag + jt * (64 * 144);
#pragma unroll
            for (int ks = 0; ks < 4; ++ks) { const bf16x8v pa = ks == 0 ? pa0 : ks == 1 ? pa1 : ks == 2 ? pa2 : pa3;
                { const s16x4 lo = tr_read(vb + ks * (16 * 144)), hi = tr_read(vb + ks * (16 * 144) + 8 * 144); const bf16x8v vf = {lo[0], lo[1], lo[2], lo[3], hi[0], hi[1], hi[2], hi[3]};
                  O0 = __builtin_amdgcn_mfma_f32_32x32x16_bf16(vf, pa, O0, 0, 0, 0); }
                { const s16x4 lo = tr_read(vb + ks * (16 * 144) + 64), hi = tr_read(vb + ks * (16 * 144) + 64 + 8 * 144); const bf16x8v vf = {lo[0], lo[1], lo[2], lo[3], hi[0], hi[1], hi[2], hi[3]};
                  O1 = __builtin_amdgcn_mfma_f32_32x32x16_bf16(vf, pa, O1, 0, 0, 0); } }
        }
#ifdef FORCE_FALLBACK
        bad = true;
#else
        bad = __any(sum_bad(lsum));
#endif
        if (!bad) { const float lt = swap_sum(lsum), inv = lt > 0.f ? 1.f / lt : 0.f; oscale = inv;
#pragma unroll
            for (int e = 0; e < 32; ++e) imp[e] = fmaf(ih[e], inv, imp[e]); }
        }
        if (bad) {
        float m, lsum;
#pragma unroll
        for (int i = 0; i < 16; ++i) { O0[i] = 0.f; O1[i] = 0.f; }
        m = -1e30f; lsum = 0.f;
#pragma unroll 1
        for (int jt = 0; jt < ntile; ++jt) {
            f32x16 p0, p1; const float b0 = s1 * (float)(64 * jt + 4 * h - nvis_max);
            if (64 * jt + 63 >= nvis_min) cmp_scores<true>(p0, p1, kfrag + jt * (64 * 144), Qf, b0, s1, 64 * jt + 4 * h, nvis_l);
            else cmp_scores<false>(p0, p1, kfrag + jt * (64 * 144), Qf, b0, s1, 64 * jt + 4 * h, nvis_l);
            float mt = fmaxf(p0[0], p1[0]);
#pragma unroll
            for (int reg = 1; reg < 16; ++reg) mt = fmaxf(mt, fmaxf(p0[reg], p1[reg]));
            mt = swap_max(mt);
            const float mn = fmaxf(m, mt); float rs = 0.f;
#pragma unroll
            for (int reg = 0; reg < 16; ++reg) rs += __builtin_amdgcn_exp2f(p0[reg] - mn) + __builtin_amdgcn_exp2f(p1[reg] - mn);
            lsum = lsum * __builtin_amdgcn_exp2f(m - mn) + rs; m = mn;
        }
        const float lt = swap_sum(lsum), cnorm = lt > 0.f ? m + __builtin_amdgcn_logf(lt) : 1e30f;
        float carry = 0.f;
#pragma unroll
        for (int jt = 0; jt < 4; ++jt) if (jt < ntile) {
            f32x16 p0, p1; const float b0 = s1 * (float)(64 * jt + 4 * h - nvis_max) - cnorm;
            if (64 * jt + 63 >= nvis_min) cmp_scores<true>(p0, p1, kfrag + jt * (64 * 144), Qf, b0, s1, 64 * jt + 4 * h, nvis_l);
            else cmp_scores<false>(p0, p1, kfrag + jt * (64 * 144), Qf, b0, s1, 64 * jt + 4 * h, nvis_l);
#pragma unroll
            for (int reg = 0; reg < 16; ++reg) { p0[reg] = __builtin_amdgcn_exp2f(p0[reg]); p1[reg] = __builtin_amdgcn_exp2f(p1[reg]); }
            float cv[8];
#pragma unroll
            for (int g4 = 0; g4 < 4; ++g4) { const float h0 = 0.5f * p0[4 * g4 + 3], h1 = 0.5f * p1[4 * g4 + 3];
                imp[jt * 8 + g4] += ((p0[4 * g4] + p0[4 * g4 + 1]) + p0[4 * g4 + 2]) + h0; imp[jt * 8 + 4 + g4] += ((p1[4 * g4] + p1[4 * g4 + 1]) + p1[4 * g4 + 2]) + h1;
                cv[g4] = h0; cv[4 + g4] = h1; }
            float prev = carry;
#pragma unroll
            for (int k = 0; k < 8; ++k) { const float sv = other_half(cv[k], h); imp[jt * 8 + k] += h ? sv : prev; prev = sv; }
            carry = prev;
            const bf16x8v pa0 = pack8(p0, 0), pa1 = pack8(p0, 8), pa2 = pack8(p1, 0), pa3 = pack8(p1, 8);
            const LAS unsigned char* vb = vfrag + jt * (64 * 144);
#pragma unroll
            for (int ks = 0; ks < 4; ++ks) { const bf16x8v pa = ks == 0 ? pa0 : ks == 1 ? pa1 : ks == 2 ? pa2 : pa3;
                { const s16x4 lo = tr_read(vb + ks * (16 * 144)), hi = tr_read(vb + ks * (16 * 144) + 8 * 144); const bf16x8v vf = {lo[0], lo[1], lo[2], lo[3], hi[0], hi[1], hi[2], hi[3]};
                  O0 = __builtin_amdgcn_mfma_f32_32x32x16_bf16(vf, pa, O0, 0, 0, 0); }
                { const s16x4 lo = tr_read(vb + ks * (16 * 144) + 64), hi = tr_read(vb + ks * (16 * 144) + 64 + 8 * 144); const bf16x8v vf = {lo[0], lo[1], lo[2], lo[3], hi[0], hi[1], hi[2], hi[3]};
                  O1 = __builtin_amdgcn_mfma_f32_32x32x16_bf16(vf, pa, O1, 0, 0, 0); } }
        }
        oscale = 1.f;
        }
        const float gt = gate[hd * 3 + 0] * oscale;
        bf16* dst = (bf16*)(ws + WS_OCMP) + mix_off((size_t)b * T_ + t_lane, hd * 64 + 4 * h, 512);
#pragma unroll
        for (int g4 = 0; g4 < 4; ++g4) {
            *(u64*)(dst + g4 * 256) = (u64)cvtpk(O0[4 * g4 + 0] * gt, O0[4 * g4 + 1] * gt) | ((u64)cvtpk(O0[4 * g4 + 2] * gt, O0[4 * g4 + 3] * gt) << 32);
            *(u64*)(dst + (4 + g4) * 256) = (u64)cvtpk(O1[4 * g4 + 0] * gt, O1[4 * g4 + 1] * gt) | ((u64)cvtpk(O1[4 * g4 + 2] * gt, O1[4 * g4 + 3] * gt) << 32); }
    }
    const int cur = tw0 >> 6; u64 mask;
    if (cur <= 15) mask = (1ull << (cur + 1)) - 1ull;
    else {
        mask = 1ull | (1ull << cur) | (1ull << (cur - 1));
#pragma unroll
        for (int e = 0; e < 32; ++e) { const int j = 2 * e + h; if (j > cur || j == 0 || j >= cur - 1) imp[e] = -INFINITY; }
#pragma unroll 1
        for (int round = 0; round < 13; ++round) {
            float bv = imp[0]; int be = 0;
#pragma unroll
            for (int e = 1; e < 32; ++e) if (imp[e] > bv) { bv = imp[e]; be = e; }
            const int bj = 2 * be + h; const float ov = other_half(bv, h); const int oj = other_half_i(bj, h);
            const bool mine = bv > ov || (bv == ov && bj < oj);
            mask |= 1ull << (mine ? bj : oj);
#pragma unroll
            for (int e = 0; e < 32; ++e) imp[e] = (mine && e == be) ? -INFINITY : imp[e];
        }
    }
    if (h == 0) ((u64*)(ws + WS_SEL))[(size_t)bg * T_ + t_lane] = mask;
    __syncthreads();
}
constexpr int CONV_UNITS = L_ * NEXP * (2 * 16 * 8 + 4 * 32) / 32;
__device__ __forceinline__ void U_conv(KP p_, int k_) {
    const KP p = uni_kp(p_); const int k = __builtin_amdgcn_readfirstlane(k_);
    int tid_ = threadIdx.x; asm volatile("" : "+v"(tid_));
    const int tid = tid_, lane = tid & 63, wave = __builtin_amdgcn_readfirstlane(tid >> 6);
    unsigned char* ws = p->ws; asm volatile("" : "+s"(ws));
    LAS float* scr = (LAS float*)lds_raw + wave * (64 * 33);
    constexpr int I_G = 16 * 8, I_D = 4 * 32, I_E = 2 * I_G + I_D;
#pragma unroll 1
    for (int i = 0; i < 4; ++i) {
        const int m = k * 32 + i * 8 + wave, l = m / (NEXP * I_E); int r = m % (NEXP * I_E); const int e = r / I_E; r = r % I_E; const size_t le = (size_t)l * NEXP + e;
        const float* W; bf16* WT; int ldw, K, ncol, r0 = 0, rmul = 1; const float* gk = nullptr;
        if (r < 2 * I_G) { const int up = r >= I_G; r -= up * I_G; W = p->in[19 + up] + le * D_ * DEXP; WT = (bf16*)(ws + WS_WGU_T) + le * 512 * D_; ldw = DEXP; K = D_; ncol = 256; r0 = up; rmul = 2; gk = p->in[14] + (size_t)l * D_; }
        else { r -= 2 * I_G; W = p->in[21] + le * DEXP * D_; WT = (bf16*)(ws + WS_WD_T) + le * D_ * DEXP; ldw = D_; K = DEXP; ncol = 1024; }
        transpose_seg(W, ldw, K, 0, ncol, WT, r0, rmul, r, scr, lane, gk);
    }
}
__device__ __forceinline__ int fetch_unit(KP p, int qidx) {
    volatile LAS unsigned* slot = (volatile LAS unsigned*)((LAS unsigned char*)lds_raw + MISC_OFF) + 16;
    __syncthreads();
    int t0_ = threadIdx.x; asm volatile("" : "+v"(t0_));
    if (t0_ == 0) *slot = __hip_atomic_fetch_add((unsigned*)(p->ws + WS_CTL) + CW_QUEUE + 64 * qidx, 1u, __ATOMIC_RELAXED, __HIP_MEMORY_SCOPE_AGENT);
    __syncthreads();
    return (int)__builtin_amdgcn_readfirstlane(*slot);
}
__device__ __forceinline__ void P_cmp1_mfma(int l_) { const KP p = (KP)__builtin_amdgcn_kernarg_segment_ptr(); int l = l_; asm volatile("" : "+s"(l));
    unsigned char* ws = p->ws; asm volatile("" : "+s"(ws)); const int c = launder_s((int)blockIdx.x), kv = c >> 4, pm = c & 15;
    OneUnitOrder S; S.has = c < 32; S.u.pm = pm; S.u.pn = kv;
    S.u.a = (const char*)(ws + WS_KV6 + (size_t)kv * KV6_STRIDE) + (size_t)pm * 256 * 1024 * 2; S.u.b = (const char*)((const bf16*)(ws + WS_W1_T) + ((size_t)l * 2 + kv) * 256 * 2048); S.u.b2 = S.u.b;
    const pg8::Gemm g{1024, 2048, 2048, 32, 0, 0};
    const EpiCmpH E{(bf16*)(ws + WS_HC), (const float*)(ws + WS_BIAS1) + l * 512};
    pg8::gemm_phase<EpiCmpH, OneUnitOrder, false, true>((LAS unsigned char*)lds_raw, g, S, E);
}
__device__ __forceinline__ void P_cmp2_mfma(int l_) { const KP p = (KP)__builtin_amdgcn_kernarg_segment_ptr(); int l = l_; asm volatile("" : "+s"(l));
    unsigned char* ws = p->ws; asm volatile("" : "+s"(ws)); const int c = launder_s((int)blockIdx.x), kv = c >> 4, pm = c & 15;
    OneUnitOrder S; S.has = c < 32; S.u.pm = pm; S.u.pn = kv;
    S.u.a = (const char*)((const bf16*)(ws + WS_HC) + ((size_t)kv * 4096 + pm * 256) * 256); S.u.b = (const char*)((const bf16*)(ws + WS_W2_T) + ((size_t)l * 2 + kv) * 64 * 256); S.u.b2 = S.u.b;
    const pg8::Gemm g{256, 256, 256, 4, 0, 0};
    const EpiCmpOut E{(bf16*)(ws + WS_KVCMP)};
    pg8::gemm_phase<EpiCmpOut, OneUnitOrder, false, true>((LAS unsigned char*)lds_raw, g, S, E);
}
__device__ __forceinline__ void P_moe_scatter(KP p_, int l_) { const KP p = uni_kp(p_); const int l = __builtin_amdgcn_readfirstlane(l_); const Ctx c = make_ctx(p); unsigned char* ws = p->ws;
    const unsigned* cnt = (const unsigned*)(ws + WS_CTL) + CW_MOECNT + l * MOE_LS;
    moe_build_tables(cnt, c.tid);
    const LAS int* T = (const LAS int*)((LAS unsigned char*)lds_raw + TBL_OFF);
    const unsigned* info = (const unsigned*)(ws + WS_ROUTE + RT_INFO); const float* tw = (const float*)(ws + WS_ROUTE + RT_W);
    int* rowtok = (int*)(ws + WS_ROUTE + RT_ROWTOK); float* roww = (float*)(ws + WS_ROUTE + RT_ROWW);
    bf16* xs = (bf16*)(ws + WS_XS); const bf16* x = (const bf16*)(ws + WS_HN); const float* gain = p->in[14] + (size_t)l * D_; const float* rstdv = (const float*)(ws + WS_ROUTE + RT_RSTD);
    { constexpr int RB = 4; float gg[2][8];
#pragma unroll
      for (int j = 0; j < 2; ++j) { const f32x4 a = ((const f32x4*)gain)[2 * c.lane + 128 * j], b2 = ((const f32x4*)gain)[2 * c.lane + 128 * j + 1]; gg[j][0] = a.x; gg[j][1] = a.y; gg[j][2] = a.z; gg[j][3] = a.w; gg[j][4] = b2.x; gg[j][5] = b2.y; gg[j][6] = b2.z; gg[j][7] = b2.w; }
      for (int row0 = c.gw * RB; row0 < NT; row0 += c.ngw * RB) {
        u32x4 vv[RB][2];
#pragma unroll
        for (int q = 0; q < RB; ++q)
#pragma unroll
            for (int j = 0; j < 2; ++j) vv[q][j] = ((const u32x4*)(x + (size_t)(row0 + q) * D_))[c.lane + 64 * j];
#pragma unroll
        for (int q = 0; q < RB; ++q) { const int row = row0 + q;
            const unsigned v = info[row]; const int cls = (int)(v >> 24), rank = (int)(v & 0xffffffu); const size_t dest = (size_t)T[cls] * 256 + rank; const float r = rstdv[row];
#pragma unroll
            for (int j = 0; j < 2; ++j) { float f[8]; unpack8(vv[q][j], f); u32x4 o; o.x = pk2(f[0] * r * gg[j][0], f[1] * r * gg[j][1]); o.y = pk2(f[2] * r * gg[j][2], f[3] * r * gg[j][3]); o.z = pk2(f[4] * r * gg[j][4], f[5] * r * gg[j][5]); o.w = pk2(f[6] * r * gg[j][6], f[7] * r * gg[j][7]);
                ((u32x4*)(xs + dest * D_))[c.lane + 64 * j] = o; }
            if (c.lane == 0) { rowtok[dest] = row; roww[2 * dest] = tw[2 * row]; roww[2 * dest + 1] = tw[2 * row + 1]; } }
      } }
    for (int cls = c.bid; cls < 112; cls += c.G) { const int n = (int)cnt[cls * MOE_CS], end = (int)((cnt[cls * MOE_CS] + 255u) >> 8) * 256; const size_t base = (size_t)T[cls] * 256;
        for (int r = n + c.tid; r < end; r += NTHREADS) rowtok[base + r] = -1; }
}
__device__ __forceinline__ int xcd_major(int bid, int G) { bid = launder_s(bid); return (G & 7) ? bid : (bid & 7) * (G >> 3) + (bid >> 3); }
__device__ __forceinline__ void P_moe_g1(int l_) { const KP p = (KP)__builtin_amdgcn_kernarg_segment_ptr(); int l = l_; asm volatile("" : "+s"(l));
    unsigned char* ws = p->ws; asm volatile("" : "+s"(ws));
    { int t0_ = threadIdx.x; asm volatile("" : "+v"(t0_)); moe_build_tables((const unsigned*)(ws + WS_CTL) + CW_MOECNT + l * MOE_LS, t0_); }
    const MoeOrder1 S{(const char*)ws, (const unsigned*)(ws + WS_REC), (const char*)((const bf16*)(ws + WS_WGU_T) + (size_t)l * NEXP * 512 * D_), (unsigned*)(ws + WS_CTL) + CW_MOECNT + l * MOE_LS + (112 + NEXP) * MOE_CS, (int)gridDim.x, xcd_major((int)blockIdx.x, (int)gridDim.x)};
    const pg8::Gemm g{D_, D_, D_, D_ / 64, 0, 0};
    const EpiMoeH E{(bf16*)(ws + WS_HB), (const u32x4*)(ws + WS_REC)};
    pg8::gemm_phase<EpiMoeH, MoeOrder1, true, true, true>((LAS unsigned char*)lds_raw, g, S, E);
}
__device__ __forceinline__ void P_moe_g2(int l_) { const KP p = (KP)__builtin_amdgcn_kernarg_segment_ptr(); int l = l_; asm volatile("" : "+s"(l));
    unsigned char* ws = p->ws; asm volatile("" : "+s"(ws));
    { int t0_ = threadIdx.x; asm volatile("" : "+v"(t0_)); moe_build_tables((const unsigned*)(ws + WS_CTL) + CW_MOECNT + l * MOE_LS, t0_); }
    const MoeOrder2 S{(const char*)(ws + WS_HB), (const char*)((const bf16*)(ws + WS_WD_T) + (size_t)l * NEXP * D_ * DEXP), (const unsigned*)(ws + WS_CTL) + CW_MOECNT + l * MOE_LS + (112 + NEXP) * MOE_CS, (unsigned*)(ws + WS_CTL) + XB_TMO + 4096, (int)gridDim.x, xcd_major((int)blockIdx.x, (int)gridDim.x)};
    const pg8::Gemm g{512, DEXP, 512, 4, 16, 16};
    const EpiMoeOut E{(bf16*)(ws + WS_HN), (const unsigned*)(ws + WS_RECC)};
    pg8::gemm_phase<EpiMoeOut, MoeOrder2, true, true>((LAS unsigned char*)lds_raw, g, S, E);
}
__device__ __forceinline__ void P_bias1(KP p_) { const KP p = uni_kp(p_); int t_ = threadIdx.x; asm volatile("" : "+v"(t_));
    const int i = launder_s((int)blockIdx.x) * NTHREADS + t_; if (i < L_ * 2 * 256) { const float* part = (const float*)(p->ws + WS_B1PART) + (size_t)(i >> 8) * 128 * 256 + (i & 255); float a = 0.f;
        for (int k = 0; k < 128; ++k) a += part[(size_t)k * 256]; ((float*)(p->ws + WS_BIAS1))[i] = a; } }
__device__ __forceinline__ void P_norm1(KP p_, int l_) { const KP p = uni_kp(p_); const int l = __builtin_amdgcn_readfirstlane(l_); const Ctx c = make_ctx(p); const Bufs b = make_bufs(p->ws);
    if (l == 0) ph_norm_bf16(c, p->in[0], p->in[1], (bf16*)p->out, (bf16*)(p->ws + WS_HN)); else ph_norm_bf16_from_bf16(c, (const bf16*)(p->ws + WS_HN), p->in[1] + (size_t)l * D_, (bf16*)p->out); }
__device__ __noinline__ void P_inproj(KP p_, int l_) { const KP p = uni_kp(p_); const int l = __builtin_amdgcn_readfirstlane(l_); const Ctx c = make_ctx(p); const Bufs b = make_bufs(p->ws);
    InProjOut o{b.QN, b.KV6, b.FQ, b.DQ, b.DV, b.GATE, b.FL, p->in[3] + l * 24, p->in[4] + l * 4};
    const bf16* A = b.HN;
    naive_gemm(c, NT, D_IN, D_, [=](int r, int k) { return bf2f(A[(size_t)r * D_ + k]); }, p->in[2] + (size_t)l * D_ * D_IN, D_IN,
               [=](int r, int col, float v) { inproj_store(o, r, col, v); }); }
__device__ __noinline__ void P_cmp1(KP p_, int l_, int kv_) { const KP p = uni_kp(p_); const int l = __builtin_amdgcn_readfirstlane(l_), kv = __builtin_amdgcn_readfirstlane(kv_); const Ctx c = make_ctx(p); const Bufs b = make_bufs(p->ws);
    const bf16* src = kv == 0 ? b.KC : b.VC; const float* pe = p->in[kv == 0 ? 5 : 8] + (size_t)l * 2048; bf16* hc = b.HC + (size_t)kv * 4096 * 256;
    naive_gemm(c, 4096, 256, 2048, [=](int r, int k) { return bf2f(src[(size_t)r * 1024 + k]) + pe[k]; }, p->in[kv == 0 ? 6 : 9] + (size_t)l * 2048 * 256, 256,
               [=](int r, int col, float v) { hc[(size_t)r * 256 + col] = (bf16)f2bf(gelu_tanh(v)); }); }
__device__ __noinline__ void P_cumsum(KP p_, int l_) { const KP p = uni_kp(p_); const int l = __builtin_amdgcn_readfirstlane(l_); const Ctx c = make_ctx(p); const Bufs b = make_bufs(p->ws); ph_cumsum(c, b.FL); }
__device__ __noinline__ void P_cmp2(KP p_, int l_, int kv_) { const KP p = uni_kp(p_); const int l = __builtin_amdgcn_readfirstlane(l_), kv = __builtin_amdgcn_readfirstlane(kv_); const Ctx c = make_ctx(p); const Bufs b = make_bufs(p->ws);
    const bf16* hc = b.HC + (size_t)kv * 4096 * 256; bf16* dst = kv == 0 ? b.KCMP : b.VCMP;
    naive_gemm(c, 4096, 64, 256, [=](int r, int k) { return bf2f(hc[(size_t)r * 256 + k]); }, p->in[kv == 0 ? 7 : 10] + (size_t)l * 256 * 64, 64,
               [=](int r, int col, float v) { dst[(size_t)r * 64 + col] = (bf16)f2bf((r & 255) == 255 ? 0.f : v); }); }
__device__ __noinline__ void P_win(KP p_, int l_) { const KP p = uni_kp(p_); const int l = __builtin_amdgcn_readfirstlane(l_); const Ctx c = make_ctx(p); const Bufs b = make_bufs(p->ws); ph_win_attn(c, b.QN, b.KW, b.VW, b.GATE, b.OWIN); }
__device__ __noinline__ void P_fox(KP p_, int l_) { const KP p = uni_kp(p_); const int l = __builtin_amdgcn_readfirstlane(l_); const Ctx c = make_ctx(p); const Bufs b = make_bufs(p->ws); ph_fox_attn(c, b.FQ, b.FK, b.FV, b.FL, b.ATT); }
__device__ __noinline__ void P_diff(KP p_, int l_) { const KP p = uni_kp(p_); const int l = __builtin_amdgcn_readfirstlane(l_); const Ctx c = make_ctx(p); const Bufs b = make_bufs(p->ws);
    ph_diff_attn(c, b.DQ, b.DK, b.DV, p->in[11] + (size_t)l * 128, p->in[12] + (size_t)l * 64, lambda_init_of(l), b.ATT); }
__device__ __noinline__ void P_cmpattn(KP p_, int l_) { const KP p = uni_kp(p_); const int l = __builtin_amdgcn_readfirstlane(l_); const Ctx c = make_ctx(p); const Bufs b = make_bufs(p->ws); ph_cmp_attn(c, b.QN, b.KCMP, b.VCMP, b.GATE, b.SEL, b.OCMP); }
__device__ __noinline__ void P_slc(KP p_, int l_) { const KP p = uni_kp(p_); const int l = __builtin_amdgcn_readfirstlane(l_); const Ctx c = make_ctx(p); const Bufs b = make_bufs(p->ws); ph_slc_attn(c, b.QN, b.KS, b.VS, b.GATE, b.SEL, b.OCMP, b.OWIN, b.ATT); }
__device__ __noinline__ void P_outproj(KP p_, int l_) { const KP p = uni_kp(p_); const int l = __builtin_amdgcn_readfirstlane(l_); const Ctx c = make_ctx(p); const Bufs b = make_bufs(p->ws);
    const bf16* A = b.ATT; float* xo = p->out; const float* xin = (l == 0) ? p->in[0] : p->out;
    naive_gemm(c, NT, D_, D_, [=](int r, int k) { return bf2f(A[(size_t)r * D_ + k]); }, p->in[13] + (size_t)l * D_ * D_, D_,
               [=](int r, int col, float v) { xo[(size_t)r * D_ + col] = xin[(size_t)r * D_ + col] + v; }); }
__device__ __forceinline__ void P_route3(int l_, int cbank) { const KP p = (KP)__builtin_amdgcn_kernarg_segment_ptr(); int l = l_; asm volatile("" : "+s"(l));
    int tid_ = threadIdx.x; asm volatile("" : "+v"(tid_));
    const int tid = tid_, lane = tid & 63, wave = __builtin_amdgcn_readfirstlane(tid >> 6), r = lane & 31, h = lane >> 5, kh = wave >> 2, wr = wave & 3;
    unsigned char* ws = p->ws; asm volatile("" : "+s"(ws)); const bf16* x = (const bf16*)(ws + WS_HN);
    const float* WR = (const float*)(ws + WS_WR) + (size_t)l * D_ * 64;
    LAS float* XT = (LAS float*)lds_raw + wave * (32 * 36);
    LAS float* WT = (LAS float*)lds_raw + 8 * 32 * 36 + kh * (2 * 32 * 64);
    LAS float* PL = (LAS float*)lds_raw + 8 * 32 * 36 + 2 * 2 * 32 * 64;
    LAS float* SS = PL + 2 * 128 * 40;
    const float* bgrp = p->in[16] + l * 4; const float* bexp = p->in[18] + l * 32;
    unsigned* cnt = (unsigned*)(ws + WS_CTL) + CW_MOECNT + l * MOE_LS + cbank;
    LAS unsigned* HIST = (LAS unsigned*)(SS + 2 * 128 * 2);
    for (int grp = launder_s((int)blockIdx.x); grp < NT / 128; grp += (int)gridDim.x) {
        const int row0 = grp * 128 + wr * 32;
        if (tid < 144) HIST[tid] = 0u;
        f32x16 acc0, acc1; float ss = 0.f;
#pragma unroll
        for (int i = 0; i < 16; ++i) { acc0[i] = 0.f; acc1[i] = 0.f; }
        { const u32x4* xsrc = (const u32x4*)(x + (size_t)(row0 + r) * D_ + kh * 512 + 8 * h);
          const u32x4* wsrc = (const u32x4*)(ws + WS_WR) + ((size_t)l * 64 + kh * 32) * 256 + lane;
#pragma unroll 4
          for (int ks = 0; ks < 32; ++ks) {
              const u32x4 av = xsrc[2 * ks], b0h = wsrc[ks * 256], b0l = wsrc[ks * 256 + 64], b1h = wsrc[ks * 256 + 128], b1l = wsrc[ks * 256 + 192];
              { float f_[8]; unpack8(av, f_);
#pragma unroll
                for (int e = 0; e < 8; ++e) ss = fmaf(f_[e], f_[e], ss); }
              const bf16x8v A = __builtin_bit_cast(bf16x8v, av);
              acc0 = __builtin_amdgcn_mfma_f32_32x32x16_bf16(A, __builtin_bit_cast(bf16x8v, b0h), acc0, 0, 0, 0); acc1 = __builtin_amdgcn_mfma_f32_32x32x16_bf16(A, __builtin_bit_cast(bf16x8v, b1h), acc1, 0, 0, 0);
              acc0 = __builtin_amdgcn_mfma_f32_32x32x16_bf16(A, __builtin_bit_cast(bf16x8v, b0l), acc0, 0, 0, 0); acc1 = __builtin_amdgcn_mfma_f32_32x32x16_bf16(A, __builtin_bit_cast(bf16x8v, b1l), acc1, 0, 0, 0);
          } }
#pragma unroll
        for (int reg = 0; reg < 16; ++reg) { const int row = wr * 32 + crow0(reg) + 4 * h; PL[(kh * 128 + row) * 40 + r] = acc0[reg]; if (r < 4) PL[(kh * 128 + row) * 40 + 32 + r] = acc1[reg]; }
        SS[(kh * 128 + wr * 32 + r) * 2 + h] = ss;
        __syncthreads();
        int cls = 0, ea = 0, eb = 0; unsigned lrank = 0u, lra = 0u, lrb = 0u; float wlo = 0.f, whi = 0.f, rstd = 0.f;
        if (tid < 128) {
            float lg[36];
#pragma unroll
            for (int cidx = 0; cidx < 36; ++cidx) lg[cidx] = PL[tid * 40 + cidx] + PL[(128 + tid) * 40 + cidx];
            const float sq = (SS[tid * 2] + SS[tid * 2 + 1]) + (SS[(128 + tid) * 2] + SS[(128 + tid) * 2 + 1]);
            rstd = rsqrtf(sq * (1.f / D_) + EPS);
            float gl[4]; int grp_i = 0;
#pragma unroll
            for (int q = 0; q < 4; ++q) gl[q] = lg[q] * rstd + bgrp[q];
            float gm = gl[0];
#pragma unroll
            for (int q = 1; q < 4; ++q) if (gl[q] > gm) { gm = gl[q]; grp_i = q; }
            float gs = 0.f;
#pragma unroll
            for (int q = 0; q < 4; ++q) gs += __expf(gl[q] - gm);
            const float grp_gate = 1.f / gs;
            float el[8];
#pragma unroll
            for (int q = 0; q < 8; ++q) { float v = lg[4 + q]; float bb = bexp[q];
                if (grp_i == 1) { v = lg[12 + q]; bb = bexp[8 + q]; } else if (grp_i == 2) { v = lg[20 + q]; bb = bexp[16 + q]; } else if (grp_i == 3) { v = lg[28 + q]; bb = bexp[24 + q]; }
                el[q] = v * rstd + bb; }
            int i0 = 0; float v0 = el[0];
#pragma unroll
            for (int q = 1; q < 8; ++q) if (el[q] > v0) { v0 = el[q]; i0 = q; }
            int i1 = -1; float v1 = -INFINITY;
#pragma unroll
            for (int q = 0; q < 8; ++q) if (q != i0 && el[q] > v1) { v1 = el[q]; i1 = q; }
            const float e1 = __expf(v1 - v0), den = 1.f + e1, w0 = grp_gate / den, w1 = grp_gate * e1 / den;
            const int lo = i0 < i1 ? i0 : i1, hi = i0 < i1 ? i1 : i0; cls = grp_i * 28 + lo * 8 - (lo * (lo + 1)) / 2 + (hi - lo - 1);
            wlo = i0 < i1 ? w0 : w1; whi = i0 < i1 ? w1 : w0;
            ea = grp_i * 8 + lo; eb = grp_i * 8 + hi;
            lrank = __hip_atomic_fetch_add(HIST + cls, 1u, __ATOMIC_RELAXED, __HIP_MEMORY_SCOPE_WORKGROUP);
            lra = __hip_atomic_fetch_add(HIST + 112 + ea, 1u, __ATOMIC_RELAXED, __HIP_MEMORY_SCOPE_WORKGROUP); lrb = __hip_atomic_fetch_add(HIST + 112 + eb, 1u, __ATOMIC_RELAXED, __HIP_MEMORY_SCOPE_WORKGROUP);
        }
        __syncthreads();
        if (tid < 144) { const unsigned n = HIST[tid]; if (n) HIST[144 + tid] = __hip_atomic_fetch_add(cnt + tid * MOE_CS, n, __ATOMIC_RELAXED, __HIP_MEMORY_SCOPE_AGENT); }
        __syncthreads();
        if (tid < 128) {
            const unsigned rank = HIST[144 + cls] + lrank, ra = HIST[144 + 112 + ea] + lra, rb = HIST[144 + 112 + eb] + lrb;
            const int row = grp * 128 + tid;
            ((unsigned*)(ws + WS_RECC))[(size_t)cls * 32768 + rank] = (unsigned)row;
            const unsigned info = ((unsigned)cls << 16) | rank;
            ((u32x4*)(ws + WS_REC))[(size_t)ea * 32768 + ra] = (u32x4){(unsigned)row, __float_as_uint(wlo), __float_as_uint(rstd), info};
            ((u32x4*)(ws + WS_REC))[(size_t)eb * 32768 + rb] = (u32x4){(unsigned)row, __float_as_uint(whi), __float_as_uint(rstd), info | 0x8000u};
        }
        __syncthreads();
    }
}
typedef float f32x8 __attribute__((ext_vector_type(8)));
__device__ __forceinline__ void P_route2(int l_, int cbank) { const KP p = (KP)__builtin_amdgcn_kernarg_segment_ptr(); int l = l_; asm volatile("" : "+s"(l));
    int tid_ = threadIdx.x; asm volatile("" : "+v"(tid_));
    const int tid = tid_, lane = tid & 63, wave = __builtin_amdgcn_readfirstlane(tid >> 6);
    unsigned char* ws = p->ws; asm volatile("" : "+s"(ws)); const float* x = p->out;
    const float* WR = (const float*)(ws + WS_WR) + (size_t)l * D_ * 40;
    LAS float* xt = (LAS float*)lds_raw + wave * (64 * 36);
    LAS float* part = (LAS float*)lds_raw;
    const float* bgrp = p->in[16] + l * 4; const float* bexp = p->in[18] + l * 32;
    unsigned* cnt = (unsigned*)(ws + WS_CTL) + CW_MOECNT + l * 128 + cbank;
    for (int grp = launder_s((int)blockIdx.x); grp < NT / 128; grp += (int)gridDim.x) {
        const int row0 = grp * 128 + (wave >> 2) * 64, kq = wave & 3;
        float acc[40]; float ss = 0.f;
#pragma unroll
        for (int cidx = 0; cidx < 40; ++cidx) acc[cidx] = 0.f;
#pragma unroll 1
        for (int kc = 0; kc < 8; ++kc) {
            const int k0 = kq * 256 + kc * 32;
#pragma unroll
            for (int i = 0; i < 8; ++i) { const int row = i * 8 + (lane >> 3), c4 = (lane & 7) * 4; *(LAS f32x4*)(xt + row * 36 + c4) = *(const f32x4*)(x + (size_t)(row0 + row) * D_ + k0 + c4); }
            float xr[32];
#pragma unroll
            for (int j = 0; j < 8; ++j) { const f32x4 t = *(const LAS f32x4*)(xt + lane * 36 + 4 * j); xr[4 * j] = t.x; xr[4 * j + 1] = t.y; xr[4 * j + 2] = t.z; xr[4 * j + 3] = t.w; }
            const float* wk = WR + (size_t)k0 * 40;
#pragma unroll
            for (int kk = 0; kk < 32; ++kk) {
                f32x8 w0, w1, w2, w3, w4;
                asm volatile("s_load_dwordx8 %0, %5, %6\n\ts_load_dwordx8 %1, %5, %7\n\ts_load_dwordx8 %2, %5, %8\n\ts_load_dwordx8 %3, %5, %9\n\ts_load_dwordx8 %4, %5, %10\n\ts_waitcnt lgkmcnt(0)"
                             : "=&s"(w0), "=&s"(w1), "=&s"(w2), "=&s"(w3), "=&s"(w4) : "s"(wk), "i"(kk * 160), "i"(kk * 160 + 32), "i"(kk * 160 + 64), "i"(kk * 160 + 96), "i"(kk * 160 + 128) : "memory");
                const float xv = xr[kk]; ss = fmaf(xv, xv, ss);
#pragma unroll
                for (int e = 0; e < 8; ++e) { acc[e] = fmaf(xv, w0[e], acc[e]); acc[8 + e] = fmaf(xv, w1[e], acc[8 + e]); acc[16 + e] = fmaf(xv, w2[e], acc[16 + e]); acc[24 + e] = fmaf(xv, w3[e], acc[24 + e]); }
#pragma unroll
                for (int e = 0; e < 4; ++e) acc[32 + e] = fmaf(xv, w4[e], acc[32 + e]);
            }
        }
        __syncthreads();
#pragma unroll
        for (int cidx = 0; cidx < 36; ++cidx) part[(wave * 64 + lane) * 37 + cidx] = acc[cidx];
        part[(wave * 64 + lane) * 37 + 36] = ss;
        __syncthreads();
        if (tid < 128) {
            const int rg = tid >> 6, rr = tid & 63; float lg[37];
#pragma unroll
            for (int cidx = 0; cidx < 37; ++cidx) lg[cidx] = ((part[((rg * 4 + 0) * 64 + rr) * 37 + cidx] + part[((rg * 4 + 1) * 64 + rr) * 37 + cidx]) + part[((rg * 4 + 2) * 64 + rr) * 37 + cidx]) + part[((rg * 4 + 3) * 64 + rr) * 37 + cidx];
            const float rstd = rsqrtf(lg[36] * (1.f / D_) + EPS);
            float gl[4]; int grp_i = 0;
#pragma unroll
            for (int q = 0; q < 4; ++q) gl[q] = lg[q] * rstd + bgrp[q];
            float gm = gl[0];
#pragma unroll
            for (int q = 1; q < 4; ++q) if (gl[q] > gm) { gm = gl[q]; grp_i = q; }
            float gs = 0.f;
#pragma unroll
            for (int q = 0; q < 4; ++q) gs += __expf(gl[q] - gm);
            const float grp_gate = 1.f / gs;
            float el[8];
#pragma unroll
            for (int q = 0; q < 8; ++q) { float v = lg[4 + q]; float bb = bexp[q];
                if (grp_i == 1) { v = lg[12 + q]; bb = bexp[8 + q]; } else if (grp_i == 2) { v = lg[20 + q]; bb = bexp[16 + q]; } else if (grp_i == 3) { v = lg[28 + q]; bb = bexp[24 + q]; }
                el[q] = v * rstd + bb; }
            int i0 = 0; float v0 = el[0];
#pragma unroll
            for (int q = 1; q < 8; ++q) if (el[q] > v0) { v0 = el[q]; i0 = q; }
            int i1 = -1; float v1 = -INFINITY;
#pragma unroll
            for (int q = 0; q < 8; ++q) if (q != i0 && el[q] > v1) { v1 = el[q]; i1 = q; }
            const float e1 = __expf(v1 - v0), den = 1.f + e1, w0 = grp_gate / den, w1 = grp_gate * e1 / den;
            const int lo = i0 < i1 ? i0 : i1, hi = i0 < i1 ? i1 : i0, cls = grp_i * 28 + lo * 8 - (lo * (lo + 1)) / 2 + (hi - lo - 1);
            const unsigned rank = __hip_atomic_fetch_add(cnt + cls, 1u, __ATOMIC_RELAXED, __HIP_MEMORY_SCOPE_AGENT);
            const int row = grp * 128 + tid;
            ((unsigned*)(ws + WS_ROUTE + RT_INFO))[row] = ((unsigned)cls << 24) | rank;
            ((float*)(ws + WS_ROUTE + RT_W))[2 * row] = i0 < i1 ? w0 : w1; ((float*)(ws + WS_ROUTE + RT_W))[2 * row + 1] = i0 < i1 ? w1 : w0;
            ((float*)(ws + WS_ROUTE + RT_RSTD))[row] = rstd;
        }
        __syncthreads();
    }
}
__device__ __noinline__ void P_route(KP p_, int l_) { const KP p = uni_kp(p_); const int l = __builtin_amdgcn_readfirstlane(l_); const Ctx c = make_ctx(p); const Bufs b = make_bufs(p->ws);
    ph_moe_route(c, p->out, p->in[14] + (size_t)l * D_, p->in[15] + (size_t)l * D_ * 4, p->in[16] + l * 4, p->in[17] + (size_t)l * D_ * 32, p->in[18] + l * 32, b.HN, (int*)(p->ws + WS_ROUTE + RT_INFO), (float*)(p->ws + WS_ROUTE + RT_W), (unsigned*)(p->ws + WS_CTL) + CW_MOECNT + l * 128); }
__device__ __noinline__ void P_moe(KP p_, int l_) { const KP p = uni_kp(p_); const int l = __builtin_amdgcn_readfirstlane(l_); const Ctx c = make_ctx(p); const Bufs b = make_bufs(p->ws);
    ph_moe_naive(c, b.HN, b.ROUTE_E, b.ROUTE_W, p->in[19] + (size_t)l * NEXP * D_ * DEXP, p->in[20] + (size_t)l * NEXP * D_ * DEXP, p->in[21] + (size_t)l * NEXP * DEXP * D_, p->out); }
__device__ __noinline__ void P_final(KP p_) { const KP p = uni_kp(p_); const Ctx c = make_ctx(p); ph_norm_final_from_bf16(c, (const bf16*)(p->ws + WS_HN), p->in[22], p->out); }
__device__ __forceinline__ void P_gridbar(KP p_) { const KP p = uni_kp(p_);
    XcdBarrier bar; bar.bar = (unsigned*)(p->ws + WS_CTL) + 4096; bar.x = xb_xcc_id(); bar.st = (volatile LAS unsigned*)((LAS unsigned char*)lds_raw + MISC_OFF) + 8;
    xcd_barrier(bar);
}

__global__ void __launch_bounds__(NTHREADS, 2) fwd_kernel(Params pp) {
    const KP p = (KP)__builtin_amdgcn_kernarg_segment_ptr();
    { volatile LAS unsigned* MISC = (volatile LAS unsigned*)((LAS unsigned char*)lds_raw + MISC_OFF); if (threadIdx.x < 32) MISC[threadIdx.x] = 0u; }
    __syncthreads();
    const int lo = p->ph_lo, hi = p->ph_hi;
    if (hi - lo > 1) (void)xcd_barrier_post((unsigned*)(p->ws + WS_CTL) + 4096, (volatile LAS unsigned*)((LAS unsigned char*)lds_raw + MISC_OFF) + 8);
#define IN(k) (lo <= (k) && (k) < hi)
#define SEAM(k) do { if (IN(k) && IN((k) + 1)) P_gridbar(p); } while (0)
    if (IN(0)) { for (int rep = 0; rep < REP_PRO; ++rep) { if (rep) P_gridbar(p); P_prologue(p); } }
    for (int l = 0; l < L_; ++l) {
        const int P0 = 1 + l * PH_PER_LAYER;
        if (IN(P0 + 0)) { for (int rep = 0; rep < REP_NORM; ++rep) { if (rep) P_gridbar(p); P_norm1(p, l); } }
        SEAM(P0 + 0);
        if (IN(P0 + 1)) { if (l == 0) P_bias1(p);
            for (int rep = 0; rep < REP_INPROJ; ++rep) { if (rep) P_gridbar(p); P_inproj_mfma(l); }
#ifdef REP_INDUMMY
            for (int rep = 0; rep < REP_INDUMMY; ++rep) { P_gridbar(p); P_inproj_dummy(l); }
#endif
        }
        SEAM(P0 + 1);
        if (IN(P0 + 3)) {
            P_cmp1_mfma(l);
            if (launder_s((int)blockIdx.x) < 32) { asm volatile("s_waitcnt vmcnt(0)" ::: "memory"); __builtin_amdgcn_fence(__ATOMIC_SEQ_CST, "agent"); asm volatile("s_waitcnt vmcnt(0)" ::: "memory"); }
            __syncthreads();
            P_cmp2_mfma(l);
            for (int rep = 0; rep < REP_ATT3; ++rep) { if (rep) P_gridbar(p);
            for (;;) { int u = fetch_unit(p, l * 8 + 0 + 16 * rep);
                if (l == 0) {
                    if (u >= 2048 + CONV_UNITS) break;
                    const int k11 = u / 11, r11 = u - 11 * k11;
                    if (r11 == 3 || r11 == 7 || r11 == 10) { U_conv(p, 3 * k11 + (r11 > 3) + (r11 > 7)); continue; }
                    u = 8 * k11 + r11 - (r11 > 3) - (r11 > 7); }
                else if (u >= 2048) break;
                if (u < 1024) { const int qb = 15 - (u >> 6), k = u & 63; if (k < 32) U_diff(p, k, qb, l); else U_fox(p, k - 32, qb, l); }
                else { const int w = u - 1024; U_win(p, w & 15, 63 - (w >> 4));
#ifdef PROBE_WINUNIT2
                    U_win(p, w & 15, 63 - (w >> 4));
#endif
                } } } }
        SEAM(P0 + 3);
        if (IN(P0 + 4)) { for (int rep = 0; rep < REP_CMP; ++rep) { if (rep) P_gridbar(p); for (int u = launder_s((int)blockIdx.x); u < 256; u += (int)gridDim.x) U_cmp(p, u & 15, u >> 4); } }
        SEAM(P0 + 4);
        if (IN(P0 + 5)) { for (int rep = 0; rep < REP_SLC; ++rep) { if (rep) P_gridbar(p); for (;;) { const int u = fetch_unit(p, l * 8 + 1 + 16 * rep); if (u >= 1024) break; U_slc(p, u & 15, 63 - (u >> 4)); } } }
        SEAM(P0 + 5);
        if (IN(P0 + 6)) P_outproj_mfma(l);
        SEAM(P0 + 6);
        if (IN(P0 + 7)) { for (int rep = 0; rep < REP_ROUTE; ++rep) { if (rep) P_gridbar(p); P_route3(l, REP_ROUTE - 1 - rep); } }
        SEAM(P0 + 7);
        if (IN(P0 + 9)) { for (int rep = 0; rep < REP_G1; ++rep) { if (rep) P_gridbar(p); P_moe_g1(l); } }
        if (IN(P0 + 10)) P_moe_g2(l);
        SEAM(P0 + 10);
    }
    if (IN(1 + L_ * PH_PER_LAYER)) P_final(p);
#undef IN
#undef SEAM
}

extern "C" void kernel_launch(void* const* d_in, const int* in_sizes, int n_in, void* d_out, int out_size, void* d_ws, size_t ws_size, hipStream_t stream) {
    static int grid = 0;
    if (grid == 0) {
        if (n_in != 23 || out_size != NT * D_ || ws_size < WS_END) { fprintf(stderr, "kernel_launch: unexpected sizes n_in %d out %d ws %zu (need %zu)\n", n_in, out_size, ws_size, (size_t)WS_END); grid = -1; return; }
        int dev = 0, cus = 0, per_cu = 0;
        if (hipGetDevice(&dev) != hipSuccess || hipDeviceGetAttribute(&cus, hipDeviceAttributeMultiprocessorCount, dev) != hipSuccess) { grid = -1; return; }
        if (hipFuncSetAttribute((const void*)fwd_kernel, hipFuncAttributeMaxDynamicSharedMemorySize, LDS_BYTES) != hipSuccess) { fprintf(stderr, "kernel_launch: hipFuncSetAttribute failed\n"); grid = -1; return; }
        if (hipOccupancyMaxActiveBlocksPerMultiprocessor(&per_cu, (const void*)fwd_kernel, NTHREADS, LDS_BYTES) != hipSuccess || per_cu < 1) { fprintf(stderr, "kernel_launch: occupancy query says %d\n", per_cu); }
        (void)hipGetLastError();
        grid = cus;
    }
    if (grid < 0) return;
    (void)hipMemsetAsync((char*)d_ws + WS_CTL, 0, CTL_BYTES, stream);
    Params p{};
    for (int i = 0; i < 23; ++i) p.in[i] = (const float*)d_in[i];
    p.out = (float*)d_out; p.ws = (unsigned char*)d_ws;
#if N_LAUNCH_MODE == 0
    p.ph_lo = 0; p.ph_hi = N_PHASES;
    hipLaunchKernelGGL(fwd_kernel, dim3(grid), dim3(NTHREADS), LDS_BYTES, stream, p);
#else
    for (int k = 0; k < N_PHASES; ++k) { p.ph_lo = k; p.ph_hi = k + 1; hipLaunchKernelGGL(fwd_kernel, dim3(grid), dim3(NTHREADS), LDS_BYTES, stream, p); }
#endif
}
```

```cpp
#include <hip/hip_runtime.h>
#include <cstdio>
#include <cstdint>

#ifndef INPROJ_ALIGN
#define INPROJ_ALIGN true
#endif
#ifndef INPROJ_SP2
#define INPROJ_SP2 true
#endif
#ifndef REP_PRO
#define REP_PRO 1
#endif
#ifndef REP_ROUTE
#define REP_ROUTE 1
#endif
#ifndef REP_NORM
#define REP_NORM 1
#endif
#ifndef REP_INPROJ
#define REP_INPROJ 1
#endif
#ifndef REP_ATT3
#define REP_ATT3 1
#endif
#ifndef REP_CMP
#define REP_CMP 1
#endif
#ifndef REP_SLC
#define REP_SLC 1
#endif
#ifndef REP_SCAT
#define REP_SCAT 1
#endif
#ifndef REP_G1
#define REP_G1 1
#endif
#ifndef N_LAUNCH_MODE
#define N_LAUNCH_MODE 0
#endif

#ifndef NOMAX_ON
#define NOMAX_ON true
#endif
#define LAS __attribute__((address_space(3)))
#define GAS __attribute__((address_space(1)))
typedef unsigned short bf16;
typedef unsigned long long u64;
typedef float f32x4 __attribute__((ext_vector_type(4)));
typedef unsigned u32x4 __attribute__((ext_vector_type(4)));

constexpr int B_ = 8, T_ = 4096, D_ = 1024, NT = B_ * T_, L_ = 2;
constexpr int HD = 64, D_IN = 2844;
constexpr int N_CMP = 255, CMP_HID = 256;
constexpr int NEXP = 32, DEXP = 256;
constexpr float EPS = 1e-6f;
constexpr float LOG2E = 1.4426950408889634f;
constexpr int NWAVES = 8, NTHREADS = 512;

constexpr int C_NSAQ = 0, C_KV6 = 512, C_GATE = 1280, C_FQ = 1304, C_FF = 2072, C_DQ = 2076, C_DV = 2588;

constexpr size_t MiB = 1u << 20;
constexpr size_t WS_CTL = 0, CTL_BYTES = 1 * MiB;
constexpr size_t WS_QN = 1 * MiB;
constexpr size_t WS_KV6 = WS_QN + 32 * MiB;
constexpr size_t KV6_STRIDE = 8 * MiB + 64 * 1024;
constexpr size_t WS_FQKV = WS_KV6 + 6 * KV6_STRIDE;
constexpr size_t WS_DQK = WS_FQKV + 48 * MiB;
constexpr size_t WS_DV = WS_DQK + 32 * MiB;
constexpr size_t WS_GATE = WS_DV + 16 * MiB;
constexpr size_t WS_FL = WS_GATE + 3 * MiB;
constexpr size_t WS_HC = WS_FL + 1 * MiB;
constexpr size_t WS_KVCMP = WS_HC + 4 * MiB;
constexpr size_t WS_SEL = WS_KVCMP + 1 * MiB;
constexpr size_t WS_OCMP = WS_SEL + 1 * MiB;
constexpr size_t WS_OWIN = WS_OCMP + 32 * MiB;
constexpr size_t WS_HN = WS_OWIN + 32 * MiB;
constexpr size_t WS_ATT = WS_HN + 64 * MiB;
constexpr size_t WS_ROUTE = WS_ATT + 64 * MiB;
constexpr size_t WS_WIN_T = WS_ROUTE + 2 * MiB;
constexpr size_t WS_WOUT_T = WS_WIN_T + 12 * MiB;
constexpr size_t WS_WGU_T = WS_WOUT_T + 4 * MiB;
constexpr size_t WS_WD_T = WS_WGU_T + 64 * MiB;
constexpr size_t WS_W1_T = WS_WD_T + 32 * MiB;
constexpr size_t WS_W2_T = WS_W1_T + 4 * MiB;
constexpr size_t WS_BIAS1 = WS_W2_T + 512 * 1024;
constexpr size_t WS_WR = WS_BIAS1 + 512 * 1024;
constexpr size_t WS_B1PART = WS_WR + 512 * 1024;
constexpr size_t WS_END = WS_B1PART + 512 * 1024;
constexpr int MOE_MAXROWS = 61440;
constexpr size_t WS_XS = WS_QN;
constexpr size_t WS_HB = WS_OCMP;
static_assert(WS_XS + (size_t)MOE_MAXROWS * 2048 <= WS_DQK && WS_HB + (size_t)MOE_MAXROWS * 1024 <= WS_HN, "MoE aliases");
constexpr size_t RT_INFO = 0, RT_W = 128 * 1024, RT_ROWTOK = 384 * 1024, RT_ROWW = 640 * 1024, RT_RSTD = 1152 * 1024;
constexpr int CW_QUEUE = 16384, CW_MOECNT = 32768, CW_KN = 49152, MOE_CS = 32, MOE_LS = 8192;
constexpr size_t WS_REC = WS_QN;
constexpr size_t WS_RECC = WS_REC + (size_t)NEXP * 32768 * 16;
constexpr unsigned ZROW_OFF = 512 * 1024;
static_assert(WS_RECC + (size_t)112 * 32768 * 4 <= WS_DQK && WS_HN + (size_t)NT * 2048 < (1ull << 32) && CW_MOECNT + L_ * MOE_LS <= CW_KN && (112 + 2 * NEXP) * MOE_CS <= MOE_LS, "MoE record tables / 32-bit row offsets / counters");
constexpr int TBL_OFF = 131072 + 1024;
constexpr int NIN = 3072;

extern __shared__ __attribute__((aligned(16))) unsigned char lds_raw[];
__device__ __forceinline__ float bf2f(bf16 v) { return __uint_as_float(((unsigned)v) << 16); }
__device__ __forceinline__ unsigned f2bf(float f) { unsigned u = __float_as_uint(f); return (u + 0x7fffu + ((u >> 16) & 1u)) >> 16; }
__device__ __forceinline__ unsigned pk2(float lo, float hi) { return f2bf(lo) | (f2bf(hi) << 16); }
__device__ __forceinline__ float wave_sum(float v) {
#pragma unroll
    for (int o = 1; o < 64; o <<= 1) v += __shfl_xor(v, o);
    return v;
}
__device__ __forceinline__ float wave_max(float v) {
#pragma unroll
    for (int o = 1; o < 64; o <<= 1) v = fmaxf(v, __shfl_xor(v, o));
    return v;
}
__device__ __forceinline__ float shflx_f(float v, int o, int lane) { return __uint_as_float((unsigned)__builtin_amdgcn_ds_bpermute((lane ^ o) << 2, (int)__float_as_uint(v))); }
__device__ __forceinline__ unsigned shflx_u(unsigned v, int o, int lane) { return (unsigned)__builtin_amdgcn_ds_bpermute((lane ^ o) << 2, (int)v); }
__device__ __forceinline__ float wave_sum_l(float v, int lane) {
#pragma unroll
    for (int o = 1; o < 64; o <<= 1) v += shflx_f(v, o, lane);
    return v;
}
__device__ __forceinline__ int launder_s(int v) { asm volatile("" : "+s"(v)); return v; }
__device__ __forceinline__ float sigmoidf_(float x) { return 1.f / (1.f + __expf(-x)); }
__device__ __forceinline__ float log_sigmoidf_(float x) { return x >= 0.f ? -log1pf(__expf(-x)) : x - log1pf(__expf(x)); }
__device__ __forceinline__ float gelu_tanh(float x) { const float u = 0.7978845608028654f * (x + 0.044715f * x * x * x); return 0.5f * x * (1.f + tanhf(u)); }
__device__ __forceinline__ float alibi_slope(int idx1, int n) { return exp2f(-8.0f * (float)idx1 / (float)n); }

__device__ __forceinline__ constexpr int b64_off(int t, int d) { return ((t >> 4) * 2 + (d >> 5)) * 512 + (t & 15) * 32 + (d & 31); }
#define XB_TMO      128
#define XB_XCNT(j)  (256  + 64 * (j))
#define XB_XSUB(j)  (1280 + 64 * (j))
#define XB_XGEN(j)  (2304 + 64 * (j))
#define XB_TOP      3328
#define XB_TOPGEN   3392
#define XCD_BAR_WORDS 3456
#define XB_SPIN_CAP (1u << 25)
__device__ __forceinline__ unsigned xb_ld(unsigned* p)              { return __hip_atomic_load(p, __ATOMIC_RELAXED, __HIP_MEMORY_SCOPE_AGENT); }
__device__ __forceinline__ unsigned xb_add(unsigned* p, unsigned v) { return __hip_atomic_fetch_add(p, v, __ATOMIC_RELAXED, __HIP_MEMORY_SCOPE_AGENT); }
__device__ __forceinline__ unsigned xb_xcc_id() { return (unsigned)__builtin_amdgcn_s_getreg((3 << 11) | 20) & 0xFu; }
#define XB_SPIN(cond, bar) do { unsigned _sp = 0; while (cond) { __builtin_amdgcn_s_sleep(1); \
    if ((++_sp & 255u) == 0u) { if (xb_ld(&(bar)[XB_TMO])) break; if (_sp > XB_SPIN_CAP) { atomicAdd(&(bar)[XB_TMO], 1u); break; } } } } while (0)
struct XcdBarrier { unsigned* bar; unsigned x; volatile LAS unsigned* st; };
__device__ __forceinline__ XcdBarrier xcd_barrier_post(unsigned* bar, volatile LAS unsigned* st) {
    XcdBarrier b; b.bar = bar; b.x = xb_xcc_id(); b.st = st;
    if (threadIdx.x == 0) (void)xb_add(&bar[XB_XCNT(b.x)], 1u);
    return b;
}
__device__ __forceinline__ void xcd_barrier_complete(unsigned* bar, unsigned x, unsigned& nloc, unsigned& nx) {
    const unsigned G = gridDim.x * gridDim.y * gridDim.z;
    unsigned sum, cnt, mine, sp = 0u;
    for (;;) {
        sum = 0u; cnt = 0u; mine = 0u;
#pragma unroll
        for (unsigned j = 0; j < 16; ++j) { const unsigned c = xb_ld(&bar[XB_XCNT(j)]); sum += c; cnt += (c > 0u) ? 1u : 0u; mine = (j == x) ? c : mine; }
        if (sum == G) break;
        __builtin_amdgcn_s_sleep(1);
        if ((++sp & 255u) == 0u) { if (xb_ld(&bar[XB_TMO])) break; if (sp > XB_SPIN_CAP) { atomicAdd(&bar[XB_TMO], 1u); break; } }
    }
    nloc = mine > 0u ? mine : 1u; nx = cnt > 0u ? cnt : 1u;
}
__device__ __forceinline__ void xcd_barrier(const XcdBarrier& b) {
    asm volatile("s_waitcnt vmcnt(0)" ::: "memory");
    __syncthreads();
    if (threadIdx.x == 0) {
        unsigned* bar = b.bar;
        __builtin_amdgcn_s_waitcnt(0);
        unsigned nloc = b.st[0], nx = b.st[1];
        if (nloc == 0u) { xcd_barrier_complete(bar, b.x, nloc, nx); b.st[0] = nloc; b.st[1] = nx; }
        const unsigned old = xb_add(&bar[XB_XSUB(b.x)], 1u);
        const unsigned gen = old / nloc;
        if (old + 1u == (gen + 1u) * nloc) {
            __builtin_amdgcn_fence(__ATOMIC_RELEASE, "agent");
            asm volatile("s_waitcnt vmcnt(0)" ::: "memory");
            const unsigned og = xb_add(&bar[XB_TOP], 1u);
            const unsigned tg = og / nx;
            if (og + 1u == (tg + 1u) * nx) xb_add(&bar[XB_TOPGEN], 1u);
            else XB_SPIN(xb_ld(&bar[XB_TOPGEN]) == tg, bar);
            __builtin_amdgcn_fence(__ATOMIC_ACQUIRE, "agent");
            xb_add(&bar[XB_XGEN(b.x)], 1u);
            asm volatile("s_waitcnt vmcnt(0)" ::: "memory");
        } else {
            XB_SPIN(xb_ld(&bar[XB_XGEN(b.x)]) == gen, bar);
            __builtin_amdgcn_fence(__ATOMIC_ACQUIRE, "agent");
            asm volatile("s_waitcnt vmcnt(0)" ::: "memory");
        }
    }
    __syncthreads();
}

struct Params { const float* in[23]; float* out; unsigned char* ws; int ph_lo, ph_hi; };
constexpr int LDS_BYTES = 147456;
constexpr int MISC_OFF = 131072 + 320;

struct Ctx {
    LAS unsigned char* lds; int tid, lane, wave, bid, G, gw, ngw;
    const float* const* in; float* xcur; unsigned char* ws;
};

namespace pg8 {
#define PG8_LAS __attribute__((address_space(3)))
typedef unsigned short bf16_t;
typedef short bf16x8 __attribute__((ext_vector_type(8)));
typedef float f32x4 __attribute__((ext_vector_type(4)));
typedef unsigned u32x4 __attribute__((ext_vector_type(4)));
constexpr int BM = 256, BK = 64, HALF = 128, HTB = HALF * BK * 2  , STAGE_BYTES = 8 * HTB, NXCD = 8, WGM = 8;

__host__ __device__ __forceinline__ int lds_byte(int r, int c) { const int st = (r >> 4) * 2 + (c >> 5), rr = r & 15, cc = c & 31, ob = rr * 64 + cc * 2; return st * 1024 + (ob ^ (((ob >> 9) & 1) << 5)); }
__host__ __device__ __forceinline__ void stage_rc(int b, int& R, int& C) { const int st = b / 1024, sb = b % 1024, swz = sb ^ (((sb >> 9) & 1) << 5); R = (st >> 1) * 16 + swz / 64; C = (st & 1) * 32 + (swz % 64) / 2; }
__host__ __device__ __forceinline__ int perm32(int rho) { const int n = rho >> 4, i = rho & 15; return 8 * (i >> 2) + 4 * n + (i & 3); }

struct Unit { int pm, pn; const char* a; const char* b; const char* b2; };
struct Gemm { int lda, ldb, K, ksplit, arb, acb; };

__device__ __forceinline__ unsigned cvt_pk_bf16(float lo, float hi) { unsigned r; asm volatile("v_cvt_pk_bf16_f32 %0, %1, %2" : "=v"(r) : "v"(lo), "v"(hi)); return r; }
typedef float f32x2 __attribute__((ext_vector_type(2)));

template <class Epi, class Sched, bool ALIGN_EPI = false, bool SP2 = false, bool GATHER = false>
__device__ __forceinline__ void gemm_phase(PG8_LAS unsigned char* lds, const Gemm g, const Sched& S, const Epi& E) {
    static_assert(!GATHER || SP2, "GATHER is written for the SP2 loop");
    int tid_ = threadIdx.x; asm volatile("" : "+v"(tid_));
    const int tid = tid_, wid = __builtin_amdgcn_readfirstlane(tid >> 6), lane = tid & 63, wr = wid >> 2, wc = wid & 3, fr = lane & 15, fq = lane >> 4;
    const int K = g.K, nt = K / BK, ks = g.ksplit;
    unsigned voffA[2], voffB[2];
#pragma unroll
    for (int i = 0; i < 2; ++i) { int R, C; stage_rc(tid * 16 + i * 8192, R, C); const int Rb = Epi::PERM ? ((R & ~31) + perm32(R & 31)) : R;
        voffA[i] = g.arb ? (unsigned)(((R / g.arb) * (K / g.acb) + C / g.acb) * (g.arb * g.acb) + (R % g.arb) * g.acb + (C % g.acb)) * 2u : (unsigned)(R * g.lda + C) * 2u; voffB[i] = (unsigned)(Rb * g.ldb + C) * 2u; }
    const size_t kstep = (size_t)(BK * 2), kstepA = g.arb ? (size_t)(BK * g.arb * 2) : kstep;
    const size_t hsA = (size_t)HALF * (g.arb ? K : g.lda) * 2, hsB = (size_t)HALF * g.ldb * 2;
    const unsigned ldsw = (unsigned)wid * 1024u;
    const int aoff = lds_byte(wr * 64 + fr, fq * 8), boff = lds_byte(wc * 32 + fr, fq * 8);
#define PG8_SA(b, h) (((b) * 2 + (h)) * HTB)
#define PG8_SB(b, h) ((4 + (b) * 2 + (h)) * HTB)
#define PG8_STAGE(bufoff, gbase, voff) do { _Pragma("unroll") for (int _i = 0; _i < 2; ++_i) \
        __builtin_amdgcn_global_load_lds((const unsigned*)((const char*)(gbase) + (voff)[_i]), (PG8_LAS unsigned*)(lds + (bufoff) + ldsw + _i * 8192), 16, 0, 0); } while (0)
#define PG8_LDA(dst, b, h) do { _Pragma("unroll") for (int m = 0; m < 4; ++m) _Pragma("unroll") for (int k = 0; k < 2; ++k) dst[m][k] = *(const PG8_LAS bf16x8*)(lds + PG8_SA(b, h) + aoff + m * 2048 + k * 1024); } while (0)
#define PG8_LDB(dst, b, h) do { _Pragma("unroll") for (int n = 0; n < 2; ++n) _Pragma("unroll") for (int k = 0; k < 2; ++k) dst[n][k] = *(const PG8_LAS bf16x8*)(lds + PG8_SB(b, h) + boff + n * 2048 + k * 1024); } while (0)
#define PG8_MMA(ai, bj, At, Bt) do { __builtin_amdgcn_s_setprio(1); _Pragma("unroll") for (int m = 0; m < 4; ++m) _Pragma("unroll") for (int n = 0; n < 2; ++n) _Pragma("unroll") for (int k = 0; k < 2; ++k) \
        acc[ai][bj][m][n] = __builtin_amdgcn_mfma_f32_16x16x32_bf16(Bt[n][k], At[m][k], acc[ai][bj][m][n], 0, 0, 0); __builtin_amdgcn_s_setprio(0); } while (0)
#define PG8_WAIT_V(n) asm volatile("s_waitcnt vmcnt(" #n ")" ::: "memory")
#define PG8_WAIT_L(n) asm volatile("s_waitcnt lgkmcnt(" #n ")" ::: "memory")
#define PG8_BAR __builtin_amdgcn_s_barrier()
#define PG8_SCHED __builtin_amdgcn_sched_barrier(0)
    Unit cur, nxt; int ui = 0;
    if (!S.next(0, cur)) return;
    unsigned gC[2][2] = {{0u, 0u}, {0u, 0u}}, gN[2][2] = {{0u, 0u}, {0u, 0u}}; const char* gbase = nullptr;
#define PG8_GOFFS(U, Gv) do { int R_, C_; stage_rc(tid * 16, R_, C_); S.arows4(U, R_, (unsigned)C_ * 2u, Gv); } while (0)
#define PG8_STAGE_G(bufoff, kbyte, Gv, h) do { _Pragma("unroll") for (int _i = 0; _i < 2; ++_i) \
        __builtin_amdgcn_global_load_lds((const unsigned*)(gbase + (size_t)(kbyte) + Gv[h][_i]), (PG8_LAS unsigned*)(lds + (bufoff) + ldsw + _i * 8192), 16, 0, 0); } while (0)
    if constexpr (GATHER) { gbase = S.abase(); PG8_GOFFS(cur, gC); }
    f32x4 acc[2][2][4][2];
#pragma unroll
    for (int a = 0; a < 2; ++a)
#pragma unroll
        for (int b = 0; b < 2; ++b)
#pragma unroll
            for (int m = 0; m < 4; ++m)
#pragma unroll
                for (int n = 0; n < 2; ++n) acc[a][b][m][n] = (f32x4){0.f, 0.f, 0.f, 0.f};
    bf16x8 At[4][2], B0[2][2], B1[2][2];
    const char* cA = cur.a; const char* cB = cur.b; const char* cB2 = cur.b2;
#define PG8_BK(base, base2, kt) ((kt) < ks ? (base) + (size_t)(kt) * kstep : (base2) + (size_t)((kt) - ks) * kstep)
    S.a_ready(cur);
    if constexpr (SP2) {
        PG8_STAGE(PG8_SB(0, 0), cB, voffB); PG8_STAGE(PG8_SB(0, 1), cB + hsB, voffB);
        if constexpr (GATHER) { PG8_STAGE_G(PG8_SA(0, 0), 0, gC, 0); PG8_STAGE_G(PG8_SA(0, 1), 0, gC, 1); } else { PG8_STAGE(PG8_SA(0, 0), cA, voffA); PG8_STAGE(PG8_SA(0, 1), cA + hsA, voffA); }
        if (wr == 1) PG8_BAR;
        PG8_WAIT_V(2); PG8_BAR;
        PG8_STAGE(PG8_SB(1, 0), PG8_BK(cB, cB2, 1), voffB);
        if constexpr (GATHER) PG8_STAGE_G(PG8_SA(1, 0), kstep, gC, 0); else PG8_STAGE(PG8_SA(1, 0), cA + kstepA, voffA);
        PG8_STAGE(PG8_SB(1, 1), PG8_BK(cB, cB2, 1) + hsB, voffB);
        PG8_WAIT_V(6); PG8_BAR;
    } else {
        PG8_STAGE(PG8_SB(0, 0), cB, voffB); PG8_STAGE(PG8_SA(0, 0), cA, voffA); PG8_STAGE(PG8_SB(0, 1), cB + hsB, voffB); PG8_STAGE(PG8_SA(0, 1), cA + hsA, voffA);
        if (wr == 1) PG8_BAR;
        PG8_WAIT_V(4); PG8_BAR;
        PG8_STAGE(PG8_SB(1, 0), PG8_BK(cB, cB2, 1), voffB); PG8_STAGE(PG8_SA(1, 0), cA + kstepA, voffA); PG8_STAGE(PG8_SB(1, 1), PG8_BK(cB, cB2, 1) + hsB, voffB);
        PG8_WAIT_V(6); PG8_BAR;
    }
    for (;;) {
        const bool has_next = S.next(ui + 1, nxt);
        if constexpr (GATHER) { if (has_next) PG8_GOFFS(nxt, gN); else { _Pragma("unroll") for (int _h = 0; _h < 2; ++_h) _Pragma("unroll") for (int _i = 0; _i < 2; ++_i) gN[_h][_i] = gC[_h][_i]; } }
        const char* nA = has_next ? nxt.a : cA; const char* nB = has_next ? nxt.b : cB; const char* nB2 = has_next ? nxt.b2 : cB2;
#pragma unroll 1
        for (int t = 0; t < nt; t += 2) {
            const bool last = (t == nt - 2);
            const char* a1 = cA + (size_t)(t + 1) * kstepA;
            const char* a2 = last ? nA : cA + (size_t)(t + 2) * kstepA; const char* b2 = last ? PG8_BK(nB, nB2, 0) : PG8_BK(cB, cB2, t + 2);
            const char* a3 = a2 + kstepA; const char* b3 = last ? PG8_BK(nB, nB2, 1) : PG8_BK(cB, cB2, t + 3);
            if (last && has_next) S.a_ready(nxt);
            if constexpr (SP2) {
            PG8_LDB(B0, 0, 0); PG8_LDB(B1, 0, 1); PG8_SCHED; PG8_LDA(At, 0, 0);
            if constexpr (GATHER) PG8_STAGE_G(PG8_SA(1, 1), (size_t)(t + 1) * kstep, gC, 1); else PG8_STAGE(PG8_SA(1, 1), a1 + hsA, voffA);
            PG8_WAIT_V(8); PG8_WAIT_L(0); PG8_BAR; PG8_MMA(0, 0, At, B0); PG8_MMA(0, 1, At, B1); PG8_BAR; PG8_SCHED;
            PG8_LDA(At, 0, 1); PG8_STAGE(PG8_SB(0, 0), b2, voffB); PG8_STAGE(PG8_SB(0, 1), b2 + hsB, voffB);
            if constexpr (GATHER) { if (last) PG8_STAGE_G(PG8_SA(0, 0), 0, gN, 0); else PG8_STAGE_G(PG8_SA(0, 0), (size_t)(t + 2) * kstep, gC, 0); } else PG8_STAGE(PG8_SA(0, 0), a2, voffA);
            PG8_WAIT_V(8); PG8_WAIT_L(0); PG8_BAR; PG8_MMA(1, 0, At, B0); PG8_MMA(1, 1, At, B1); PG8_BAR; PG8_SCHED;
            PG8_LDB(B0, 1, 0); PG8_LDB(B1, 1, 1); PG8_SCHED; PG8_LDA(At, 1, 0);
            if constexpr (GATHER) { if (last) PG8_STAGE_G(PG8_SA(0, 1), 0, gN, 1); else PG8_STAGE_G(PG8_SA(0, 1), (size_t)(t + 2) * kstep, gC, 1); } else PG8_STAGE(PG8_SA(0, 1), a2 + hsA, voffA);
            PG8_WAIT_V(8); PG8_WAIT_L(0); PG8_BAR; PG8_MMA(0, 0, At, B0); PG8_MMA(0, 1, At, B1); PG8_BAR; PG8_SCHED;
            PG8_LDA(At, 1, 1); PG8_STAGE(PG8_SB(1, 0), b3, voffB); PG8_STAGE(PG8_SB(1, 1), b3 + hsB, voffB);
            if constexpr (GATHER) { if (last) PG8_STAGE_G(PG8_SA(1, 0), kstep, gN, 0); else PG8_STAGE_G(PG8_SA(1, 0), (size_t)(t + 3) * kstep, gC, 0); } else PG8_STAGE(PG8_SA(1, 0), a3, voffA);
            PG8_WAIT_V(8); PG8_WAIT_L(0); PG8_BAR; PG8_MMA(1, 0, At, B0); PG8_MMA(1, 1, At, B1); PG8_BAR; PG8_SCHED;
            } else {
            PG8_LDB(B0, 0, 0); PG8_SCHED; PG8_LDA(At, 0, 0); PG8_STAGE(PG8_SA(1, 1), a1 + hsA, voffA);
            PG8_WAIT_L(8); PG8_BAR; PG8_WAIT_L(0); PG8_MMA(0, 0, At, B0); PG8_BAR; PG8_SCHED;
            PG8_LDB(B1, 0, 1); PG8_STAGE(PG8_SB(0, 0), b2, voffB);
            PG8_BAR; PG8_WAIT_L(0); PG8_MMA(0, 1, At, B1); PG8_BAR;
            PG8_LDA(At, 0, 1); PG8_STAGE(PG8_SA(0, 0), a2, voffA);
            PG8_BAR; PG8_WAIT_L(0); PG8_MMA(1, 0, At, B0); PG8_BAR; PG8_SCHED;
            PG8_STAGE(PG8_SB(0, 1), b2 + hsB, voffB);
            PG8_WAIT_V(6); PG8_BAR; PG8_MMA(1, 1, At, B1); PG8_BAR;
            PG8_LDB(B0, 1, 0); PG8_SCHED; PG8_LDA(At, 1, 0); PG8_STAGE(PG8_SA(0, 1), a2 + hsA, voffA);
            PG8_WAIT_L(8); PG8_BAR; PG8_WAIT_L(0); PG8_MMA(0, 0, At, B0); PG8_BAR; PG8_SCHED;
            PG8_LDB(B1, 1, 1); PG8_STAGE(PG8_SB(1, 0), b3, voffB);
            PG8_BAR; PG8_WAIT_L(0); PG8_MMA(0, 1, At, B1); PG8_BAR;
            PG8_LDA(At, 1, 1); PG8_STAGE(PG8_SA(1, 0), a3, voffA);
            PG8_BAR; PG8_WAIT_L(0); PG8_MMA(1, 0, At, B0); PG8_BAR; PG8_SCHED;
            PG8_STAGE(PG8_SB(1, 1), b3 + hsB, voffB);
            PG8_WAIT_V(6); PG8_BAR; PG8_MMA(1, 1, At, B1); PG8_BAR;
            }
        }
        if constexpr (ALIGN_EPI) { if (wr == 0) PG8_BAR; }
        if constexpr (!Epi::AFTER_DRAIN) { E(acc, cur, wr, wc, fr, fq); S.done(cur); }
        if (!has_next) break;
#pragma unroll
        for (int a = 0; a < 2; ++a)
#pragma unroll
            for (int b = 0; b < 2; ++b)
#pragma unroll
                for (int m = 0; m < 4; ++m)
#pragma unroll
                    for (int n = 0; n < 2; ++n) acc[a][b][m][n] = (f32x4){0.f, 0.f, 0.f, 0.f};
        cur = nxt; cA = nA; cB = nB; cB2 = nB2; ++ui;
        if constexpr (GATHER) { _Pragma("unroll") for (int _h = 0; _h < 2; ++_h) _Pragma("unroll") for (int _i = 0; _i < 2; ++_i) gC[_h][_i] = gN[_h][_i]; }
        if constexpr (ALIGN_EPI) { if (wr == 1) PG8_BAR; }
    }
    PG8_WAIT_V(0);
    if constexpr (!ALIGN_EPI) { if (wr == 0) PG8_BAR; }
    PG8_BAR;
    if constexpr (Epi::AFTER_DRAIN) { E.fused(acc, cur, wr, wc, fr, fq, lds, wid, lane); S.done(cur); }
#undef PG8_BK
#undef PG8_GOFFS
#undef PG8_STAGE_G
#undef PG8_SA
#undef PG8_SB
#undef PG8_STAGE
#undef PG8_LDA
#undef PG8_LDB
#undef PG8_MMA
#undef PG8_WAIT_V
#undef PG8_WAIT_L
#undef PG8_BAR
#undef PG8_SCHED
}
}

struct PlainOrder {
    const char* A; const char* Bt; int lda, ldb, nM, nN, nwg, G, c;
    __device__ __forceinline__ void init(const void* A_, const void* Bt_, int lda_, int ldb_, int M, int N, int G_, int c_) { A = (const char*)A_; Bt = (const char*)Bt_; lda = lda_; ldb = ldb_; nM = M / 256; nN = N / 256; nwg = nM * nN; G = G_; c = c_; }
    __device__ __forceinline__ bool next(int i, pg8::Unit& u) const {
        const long L = (long)i * G + c; if (L >= nwg) return false;
        int wgid = (int)L; { const int q = nwg / 8, r = nwg % 8, xcd = wgid % 8, off = wgid / 8; wgid = (xcd < r ? xcd * (q + 1) : r * (q + 1) + (xcd - r) * q) + off; }
        const int nig = 8 * nN, gid = wgid / nig, fm = gid * 8, gsz = (nM - fm) < 8 ? (nM - fm) : 8;
        u.pm = fm + ((wgid % nig) % gsz); u.pn = (wgid % nig) / gsz;
        u.a = A + (size_t)u.pm * 256 * lda * 2; u.b = Bt + (size_t)u.pn * 256 * ldb * 2; u.b2 = u.b; return true;
    }
    __device__ __forceinline__ void a_ready(const pg8::Unit&) const {}
    __device__ __forceinline__ void done(const pg8::Unit&) const {}
};
struct EpiInProj {
    static constexpr bool PERM = true, AFTER_DRAIN = false;
    unsigned char* ws; const float* b_gate; const float* b_fgt; unsigned* kn;
    __device__ __forceinline__ void operator()(const pg8::f32x4 (&acc)[2][2][4][2], const pg8::Unit& u, int wr, int wc, int fr, int fq) const {
        { int t_ = threadIdx.x; asm volatile("" : "+v"(t_)); fr = t_ & 15; fq = (t_ >> 4) & 3; }
        const int pn = u.pn, b = (u.pm * 256) / T_, t0 = u.pm * 256 - b * T_ + wr * 64 + fr;
        if (pn == 11) {
            if (wc == 0 && fq < 4) {
                float* gate = (float*)(ws + WS_GATE); float* fl = (float*)(ws + WS_FL);
#pragma unroll
                for (int ai = 0; ai < 2; ++ai)
#pragma unroll
                    for (int m = 0; m < 4; ++m) { const int t = t0 + ai * 128 + m * 16; const size_t n = (size_t)b * T_ + t;
#pragma unroll
                        for (int nn = 0; nn < 2; ++nn)
#pragma unroll
                            for (int e = 0; e < 4; ++e) { const int c = 8 * fq + 4 * nn + e; const float v = acc[ai][0][m][nn][e];
                                if (c < 24) gate[n * 24 + c] = __builtin_amdgcn_rcpf(1.f + __builtin_amdgcn_exp2f(-(v + b_gate[c]) * LOG2E));
                                else if (c < 28) { const float z = v + b_fgt[c - 24];
                                    fl[(size_t)(b * 4 + (c - 24)) * T_ + t] = z < -30.f ? z : -0.6931471805599453f * __builtin_amdgcn_logf(1.f + __builtin_amdgcn_exp2f(-z * LOG2E)); } } }
            }
            return;
        }
        if (pn == 6 || pn == 9) {
            const int lane_ = (fq << 4) | fr;
#pragma unroll
            for (int bj = 0; bj < 2; ++bj)
#pragma unroll
                for (int ai = 0; ai < 2; ++ai) { float mx = 0.f;
#pragma unroll
                    for (int m = 0; m < 4; ++m) { const pg8::f32x4 v0 = acc[ai][bj][m][0], v1 = acc[ai][bj][m][1];
                        float ss = (v0[0] * v0[0] + v0[1] * v0[1]) + (v0[2] * v0[2] + v0[3] * v0[3]) + (v1[0] * v1[0] + v1[1] * v1[1]) + (v1[2] * v1[2] + v1[3] * v1[3]);
                        ss += shflx_f(ss, 16, lane_); ss += shflx_f(ss, 32, lane_); mx = fmaxf(mx, ss); }
#pragma unroll
                    for (int o = 1; o < 16; o <<= 1) mx = fmaxf(mx, shflx_f(mx, o, lane_));
                    if (lane_ == 0) { const int cg = bj * 4 + wc, tile = (u.pm * 256 - b * T_ + ai * 128 + wr * 64) >> 6;
                        unsigned* dst = pn == 6 ? kn + ((b * 4 + (cg >> 1)) * 64 + tile) * 2 + (cg & 1) : kn + 4096 + (b * 8 + cg) * 64 + tile;
                        atomicMax(dst, __float_as_uint(mx)); } }
        }
#pragma unroll
        for (int bj = 0; bj < 2; ++bj) {
            const int c = bj * 128 + wc * 32 + 8 * fq;
            bf16* base; int W = 64; float sc = 1.f;
            if (pn < 2) { base = (bf16*)(ws + WS_QN) + (size_t)(b * 8 + pn * 4 + (c >> 6)) * T_ * 64 + (c & 63); sc = 0.125f * LOG2E; }
            else if (pn < 5) { base = (bf16*)(ws + WS_KV6 + (size_t)((pn - 2) * 2 + (c >> 7)) * KV6_STRIDE) + (size_t)(b * 2 + ((c >> 6) & 1)) * T_ * 64 + (c & 63); }
            else if (pn < 8) { base = (bf16*)(ws + WS_FQKV) + (size_t)(pn - 5) * (8 * MiB) + (size_t)(b * 4 + (c >> 6)) * T_ * 64 + (c & 63); if (pn == 5) sc = 0.125f * LOG2E; }
            else if (pn < 10) { base = (bf16*)(ws + WS_DQK) + (size_t)(pn - 8) * (8 * MiB) + (size_t)(b * 8 + (c >> 5)) * T_ * 32 + (c & 31); W = 32; if (pn == 8) sc = 0.17677669529663687f * LOG2E; }
            else { base = (bf16*)(ws + WS_DV) + (size_t)(b * 4 + (c >> 6)) * T_ * 64 + (c & 63); }
            const bool blk = W == 64 && pn != 2;
            if (blk) base += -(c & 63) + ((c >> 5) & 1) * 512 + (c & 31);
#pragma unroll
            for (int ai = 0; ai < 2; ++ai)
#pragma unroll
                for (int m = 0; m < 4; ++m) { const int t = t0 + ai * 128 + m * 16;
                    const pg8::f32x4 v0 = acc[ai][bj][m][0] * sc, v1 = acc[ai][bj][m][1] * sc;
                    pg8::u32x4 w; w.x = pg8::cvt_pk_bf16(v0[0], v0[1]); w.y = pg8::cvt_pk_bf16(v0[2], v0[3]); w.z = pg8::cvt_pk_bf16(v1[0], v1[1]); w.w = pg8::cvt_pk_bf16(v1[2], v1[3]);
                    *(pg8::u32x4*)(base + (blk ? (size_t)((t >> 4) * 1024 + (t & 15) * 32) : (size_t)t * W)) = w; }
        }
    }
};
__device__ __forceinline__ u32x4 res_add8(u32x4 w, const pg8::f32x4& a0, const pg8::f32x4& a1) {
    u32x4 o;
    o.x = pg8::cvt_pk_bf16(__uint_as_float(w.x << 16) + a0[0], __uint_as_float(w.x & 0xffff0000u) + a0[1]); o.y = pg8::cvt_pk_bf16(__uint_as_float(w.y << 16) + a0[2], __uint_as_float(w.y & 0xffff0000u) + a0[3]);
    o.z = pg8::cvt_pk_bf16(__uint_as_float(w.z << 16) + a1[0], __uint_as_float(w.z & 0xffff0000u) + a1[1]); o.w = pg8::cvt_pk_bf16(__uint_as_float(w.w << 16) + a1[2], __uint_as_float(w.w & 0xffff0000u) + a1[3]);
    return o;
}
struct EpiResBf16 {
    static constexpr bool PERM = true, AFTER_DRAIN = false;
    bf16* xr;
    __device__ __forceinline__ void operator()(const pg8::f32x4 (&acc)[2][2][4][2], const pg8::Unit& u, int wr, int wc, int fr, int fq) const {
        { int t_ = threadIdx.x; asm volatile("" : "+v"(t_)); fr = t_ & 15; fq = (t_ >> 4) & 3; }
#pragma unroll
        for (int ai = 0; ai < 2; ++ai) { u32x4 w[4][2];
#pragma unroll
            for (int m = 0; m < 4; ++m)
#pragma unroll
                for (int bj = 0; bj < 2; ++bj) w[m][bj] = *(const u32x4*)(xr + (size_t)(u.pm * 256 + ai * 128 + wr * 64 + m * 16 + fr) * D_ + u.pn * 256 + wc * 32 + 8 * fq + bj * 128);
#pragma unroll
            for (int m = 0; m < 4; ++m)
#pragma unroll
                for (int bj = 0; bj < 2; ++bj) asm volatile("" : "+v"(w[m][bj]));
#pragma unroll
            for (int m = 0; m < 4; ++m)
#pragma unroll
                for (int bj = 0; bj < 2; ++bj) *(u32x4*)(xr + (size_t)(u.pm * 256 + ai * 128 + wr * 64 + m * 16 + fr) * D_ + u.pn * 256 + wc * 32 + 8 * fq + bj * 128) = res_add8(w[m][bj], acc[ai][bj][m][0], acc[ai][bj][m][1]); }
    }
};


struct EpiDummy {
    static constexpr bool PERM = true, AFTER_DRAIN = false;
    float* dst;
    __device__ __forceinline__ void operator()(const pg8::f32x4 (&acc)[2][2][4][2], const pg8::Unit& u, int wr, int wc, int fr, int fq) const {
        pg8::f32x4 a = {0.f, 0.f, 0.f, 0.f};
#pragma unroll
        for (int ai = 0; ai < 2; ++ai)
#pragma unroll
            for (int bj = 0; bj < 2; ++bj)
#pragma unroll
                for (int m = 0; m < 4; ++m) { a = a + acc[ai][bj][m][0]; a = a + acc[ai][bj][m][1]; }
        *(pg8::f32x4*)(dst + ((size_t)(u.pm * 12 + u.pn) * 512 + threadIdx.x) * 4) = a;
    }
};
struct OneUnitOrder { pg8::Unit u; bool has;
    __device__ __forceinline__ bool next(int i, pg8::Unit& o) const { if (i != 0 || !has) return false; o = u; return true; }
    __device__ __forceinline__ void a_ready(const pg8::Unit&) const {}
    __device__ __forceinline__ void done(const pg8::Unit&) const {} };
__device__ __forceinline__ float gelu_tanh_fast(float x) { const float u2 = 1.5957691216057308f * (x + 0.044715f * x * x * x); return x * __builtin_amdgcn_rcpf(1.f + __builtin_amdgcn_exp2f(-u2 * LOG2E)); }
struct EpiCmpH {
    static constexpr bool PERM = true, AFTER_DRAIN = false;
    bf16* hc; const float* bias1;
    __device__ __forceinline__ void operator()(const pg8::f32x4 (&acc)[2][2][4][2], const pg8::Unit& u, int wr, int wc, int fr, int fq) const {
        { int t_ = threadIdx.x; asm volatile("" : "+v"(t_)); fr = t_ & 15; fq = (t_ >> 4) & 3; }
        const int kv = u.pn;
#pragma unroll
        for (int bj = 0; bj < 2; ++bj) { const int col = bj * 128 + wc * 32 + 8 * fq;
            const pg8::f32x4 b0 = *(const pg8::f32x4*)(bias1 + kv * 256 + col), b1 = *(const pg8::f32x4*)(bias1 + kv * 256 + col + 4);
#pragma unroll
            for (int ai = 0; ai < 2; ++ai)
#pragma unroll
                for (int m = 0; m < 4; ++m) { const int row = u.pm * 256 + ai * 128 + wr * 64 + m * 16 + fr;
                    const pg8::f32x4 v0 = acc[ai][bj][m][0] + b0, v1 = acc[ai][bj][m][1] + b1;
                    pg8::u32x4 w; w.x = pg8::cvt_pk_bf16(gelu_tanh_fast(v0[0]), gelu_tanh_fast(v0[1])); w.y = pg8::cvt_pk_bf16(gelu_tanh_fast(v0[2]), gelu_tanh_fast(v0[3]));
                    w.z = pg8::cvt_pk_bf16(gelu_tanh_fast(v1[0]), gelu_tanh_fast(v1[1])); w.w = pg8::cvt_pk_bf16(gelu_tanh_fast(v1[2]), gelu_tanh_fast(v1[3]));
                    *(pg8::u32x4*)(hc + ((size_t)kv * 4096 + row) * 256 + col) = w; } }
    }
};
struct EpiCmpOut {
    static constexpr bool PERM = true, AFTER_DRAIN = false;
    bf16* kvcmp;
    __device__ __forceinline__ void operator()(const pg8::f32x4 (&acc)[2][2][4][2], const pg8::Unit& u, int wr, int wc, int fr, int fq) const {
        { int t_ = threadIdx.x; asm volatile("" : "+v"(t_)); fr = t_ & 15; fq = (t_ >> 4) & 3; }
        if (wc >= 2) return;
        const int kv = u.pn, col = wc * 32 + 8 * fq;
#pragma unroll
        for (int ai = 0; ai < 2; ++ai)
#pragma unroll
            for (int m = 0; m < 4; ++m) { const int row = u.pm * 256 + ai * 128 + wr * 64 + m * 16 + fr; const float z = ((row & 255) == 255) ? 0.f : 1.f;
                const pg8::f32x4 v0 = acc[ai][0][m][0], v1 = acc[ai][0][m][1];
                pg8::u32x4 w; w.x = pg8::cvt_pk_bf16(z != 0.f ? v0[0] : 0.f, z != 0.f ? v0[1] : 0.f); w.y = pg8::cvt_pk_bf16(z != 0.f ? v0[2] : 0.f, z != 0.f ? v0[3] : 0.f);
                w.z = pg8::cvt_pk_bf16(z != 0.f ? v1[0] : 0.f, z != 0.f ? v1[1] : 0.f); w.w = pg8::cvt_pk_bf16(z != 0.f ? v1[2] : 0.f, z != 0.f ? v1[3] : 0.f);
                *(pg8::u32x4*)(kvcmp + ((size_t)kv * 4096 + row) * 64 + col) = w; }
    }
};

__device__ __forceinline__ void moe_build_tables(const unsigned* cnt, int tid) {
    LAS int* T = (LAS int*)((LAS unsigned char*)lds_raw + TBL_OFF);
    __syncthreads();
    if (tid < 112) T[384 + tid] = (int)cnt[tid * MOE_CS];
    else if (tid >= 128 && tid < 128 + NEXP) T[560 + tid - 128] = (int)cnt[(112 + tid - 128) * MOE_CS];
    __syncthreads();
    if (tid == 0) { int o = 0; _Pragma("clang loop unroll(disable)") for (int c = 0; c < 112; ++c) { T[c] = o; const int n = (T[384 + c] + 255) >> 8;
            _Pragma("clang loop vectorize(disable) unroll(disable)") for (int k = 0; k < n; ++k) T[128 + o + k] = c;
            o += n; } T[112] = o; }
    if (tid == 64) { int o = 0; _Pragma("clang loop unroll(disable)") for (int e = 0; e < NEXP; ++e) { T[512 + e] = o; const int n = (T[560 + e] + 255) >> 8;
            _Pragma("clang loop vectorize(disable) unroll(disable)") for (int k = 0; k < n; ++k) T[608 + o + k] = e;
            o += n; } T[544] = o; }
    __syncthreads();
}
__device__ __forceinline__ void moe_pair(int cls, int& ea, int& eb) { const int grp = cls / 28; int idx = cls % 28, lo = 0; while (idx >= 7 - lo) { idx -= 7 - lo; ++lo; } ea = grp * 8 + lo; eb = grp * 8 + lo + 1 + idx; }
struct MoeOrder1 {
    const char* wsb; const unsigned* rec; const char* wgu; unsigned* edone; int G, c;
    __device__ __forceinline__ bool next(int i, pg8::Unit& u) const {
        const LAS int* T = (const LAS int*)((LAS unsigned char*)lds_raw + TBL_OFF);
        const int idx = i * G + c; if (idx >= 2 * T[544]) return false;
        const int tile = idx >> 1, pn = idx & 1, e = T[608 + tile];
        u.pm = tile; u.pn = pn; u.a = wsb; u.b = wgu + ((size_t)e * 512 + pn * 256) * 2048; u.b2 = u.b; return true; }
    __device__ __forceinline__ const char* abase() const { return wsb; }
    __device__ __forceinline__ void arows4(const pg8::Unit& u, int r0, unsigned cb, unsigned (&g)[2][2]) const {
        const LAS int* T = (const LAS int*)((LAS unsigned char*)lds_raw + TBL_OFF);
        const int e = T[608 + u.pm], base = (u.pm - T[512 + e]) * 256 + r0, n = T[560 + e];
        const unsigned ob = (unsigned)(e * 32768 + base) * 16u;
#pragma unroll
        for (int k = 0; k < 4; ++k) { unsigned off = ZROW_OFF; if (base + 64 * k < n) off = (unsigned)WS_HN + *(const unsigned*)((const char*)rec + (ob + 1024u * k)) * 2048u; g[k >> 1][k & 1] = off + cb; } }
    __device__ __forceinline__ void a_ready(const pg8::Unit&) const {}
    __device__ __forceinline__ void done(const pg8::Unit& u) const {
        asm volatile("s_waitcnt vmcnt(0)" ::: "memory");
        const LAS int* T = (const LAS int*)((LAS unsigned char*)lds_raw + TBL_OFF);
        int t_ = threadIdx.x; asm volatile("" : "+v"(t_));
        if ((t_ & 63) == 0) (void)__hip_atomic_fetch_add(edone + T[608 + u.pm] * MOE_CS, 1u, __ATOMIC_RELAXED, __HIP_MEMORY_SCOPE_AGENT); } };
struct MoeOrder2 {
    const char* hb; const char* wd; const unsigned* edone; unsigned* tmo; int G, c;
    __device__ __forceinline__ bool next(int i, pg8::Unit& u) const {
        const LAS int* T = (const LAS int*)((LAS unsigned char*)lds_raw + TBL_OFF);
        const int n1 = (2 * T[544]) % G, idx = i * G + (c >= n1 ? c - n1 : c - n1 + G); if (idx >= 4 * T[112]) return false;
        const int tile = idx >> 2, pn = idx & 3; int ea, eb; moe_pair(T[128 + tile], ea, eb);
        u.pm = tile; u.pn = pn; u.a = hb + (size_t)tile * 256 * 1024; u.b = wd + ((size_t)ea * 1024 + pn * 256) * 512; u.b2 = wd + ((size_t)eb * 1024 + pn * 256) * 512; return true; }
    __device__ __forceinline__ void a_ready(const pg8::Unit& u) const {
        int t_ = threadIdx.x; asm volatile("" : "+v"(t_));
        if (t_ < 64) {
            const LAS int* T = (const LAS int*)((LAS unsigned char*)lds_raw + TBL_OFF);
            int ea, eb; moe_pair(T[128 + u.pm], ea, eb);
            const unsigned na = 16u * (unsigned)((T[560 + ea] + 255) >> 8), nb = 16u * (unsigned)((T[560 + eb] + 255) >> 8);
            unsigned polls = 0u;
            while ((unsigned)__builtin_amdgcn_readfirstlane(__hip_atomic_load(edone + ea * MOE_CS, __ATOMIC_RELAXED, __HIP_MEMORY_SCOPE_AGENT)) < na ||
                   (unsigned)__builtin_amdgcn_readfirstlane(__hip_atomic_load(edone + eb * MOE_CS, __ATOMIC_RELAXED, __HIP_MEMORY_SCOPE_AGENT)) < nb) {
                if ((++polls & 255u) == 0u) { if (__builtin_amdgcn_readfirstlane(__hip_atomic_load(tmo, __ATOMIC_RELAXED, __HIP_MEMORY_SCOPE_AGENT)) != 0u) break;
                    if (polls > (1u << 22)) { if (t_ == 0) __hip_atomic_store(tmo, 1u, __ATOMIC_RELAXED, __HIP_MEMORY_SCOPE_AGENT); break; } }
                __builtin_amdgcn_s_sleep(2); }
            __builtin_amdgcn_fence(__ATOMIC_ACQUIRE, "agent");
            asm volatile("s_waitcnt vmcnt(0)" ::: "memory");
        }
        asm volatile("" ::: "memory"); __builtin_amdgcn_s_barrier(); asm volatile("" ::: "memory");
    }
    __device__ __forceinline__ void done(const pg8::Unit&) const {} };
struct EpiMoeH {
    static constexpr bool PERM = true, AFTER_DRAIN = false;
    bf16* hb; const u32x4* rec;
    __device__ __forceinline__ void operator()(const pg8::f32x4 (&acc)[2][2][4][2], const pg8::Unit& u, int wr, int wc, int fr, int fq) const {
        { int t_ = threadIdx.x; asm volatile("" : "+v"(t_)); fr = t_ & 15; fq = (t_ >> 4) & 3; }
        const LAS int* T = (const LAS int*)((LAS unsigned char*)lds_raw + TBL_OFF);
        const int ex = T[608 + u.pm], vr0 = (u.pm - T[512 + ex]) * 256, nex = T[560 + ex];
#pragma unroll
        for (int ai = 0; ai < 2; ++ai) {
            u32x4 q4[4];
#pragma unroll
            for (int m = 0; m < 4; ++m) q4[m] = *(const u32x4*)((const char*)rec + (unsigned)(ex * 32768 + vr0 + ai * 128 + wr * 64 + m * 16 + fr) * 16u);
#pragma unroll
            for (int m = 0; m < 4; ++m) { asm volatile("" : "+v"(q4[m]));
            }
#pragma unroll
            for (int m = 0; m < 4; ++m) { const int rr = ai * 128 + wr * 64 + m * 16 + fr; const bool valid = vr0 + rr < nex;
                const u32x4 q = q4[m]; const float w = __uint_as_float(q.y), rs = __uint_as_float(q.z);
                const int slot = (int)((q.w >> 15) & 1u); const unsigned row = (unsigned)T[valid ? (q.w >> 16) : 0u] * 256u + (q.w & 0x7fffu);
#pragma unroll
                for (int bj = 0; bj < 2; ++bj) { const int j0 = (u.pn & 1) * 128 + (bj * 128 + wc * 32 + 8 * fq) / 2;
                    pg8::f32x4 v0 = acc[ai][bj][m][0], v1 = acc[ai][bj][m][1];
#pragma unroll
                    for (int e = 0; e < 4; ++e) { v0[e] *= rs; v1[e] *= rs; }
                    const float h0 = v0[0] * __builtin_amdgcn_rcpf(1.f + __builtin_amdgcn_exp2f(-v0[0] * LOG2E)) * v0[1] * w, h1 = v0[2] * __builtin_amdgcn_rcpf(1.f + __builtin_amdgcn_exp2f(-v0[2] * LOG2E)) * v0[3] * w;
                    const float h2 = v1[0] * __builtin_amdgcn_rcpf(1.f + __builtin_amdgcn_exp2f(-v1[0] * LOG2E)) * v1[1] * w, h3 = v1[2] * __builtin_amdgcn_rcpf(1.f + __builtin_amdgcn_exp2f(-v1[2] * LOG2E)) * v1[3] * w;
                    const int jg = slot * 256 + j0;
                    if (valid) __hip_atomic_store((u64*)((char*)hb + (((row >> 4) * 32u + (unsigned)(jg >> 4)) * 256u + (row & 15u) * 16u + (unsigned)(jg & 15)) * 2u), (u64)pg8::cvt_pk_bf16(h0, h1) | ((u64)pg8::cvt_pk_bf16(h2, h3) << 32),
                                                  __ATOMIC_RELAXED, __HIP_MEMORY_SCOPE_AGENT); }
            }
            asm volatile("" ::: "memory"); }
    }
};
struct EpiMoeOut {
    static constexpr bool PERM = true, AFTER_DRAIN = false;
    bf16* x; const unsigned* rec;
    __device__ __forceinline__ void operator()(const pg8::f32x4 (&acc)[2][2][4][2], const pg8::Unit& u, int wr, int wc, int fr, int fq) const {
        { int t_ = threadIdx.x; asm volatile("" : "+v"(t_)); fr = t_ & 15; fq = (t_ >> 4) & 3; }
        bf16* xx = x; const unsigned* rt = rec; asm volatile("" : "+s"(xx), "+s"(rt));
        const LAS int* T = (const LAS int*)((LAS unsigned char*)lds_raw + TBL_OFF);
        const int cls = T[128 + u.pm], vr0 = (u.pm - T[cls]) * 256, ncls = T[384 + cls];
        int tok[2][4];
#pragma unroll
        for (int ai = 0; ai < 2; ++ai)
#pragma unroll
            for (int m = 0; m < 4; ++m) { const int rr = ai * 128 + wr * 64 + m * 16 + fr; tok[ai][m] = -1; if (vr0 + rr < ncls) tok[ai][m] = (int)rt[(size_t)cls * 32768 + vr0 + rr]; }
#pragma unroll
        for (int ai = 0; ai < 2; ++ai)
#pragma unroll
            for (int m = 0; m < 4; ++m) asm volatile("" : "+v"(tok[ai][m]));
#pragma unroll
        for (int ai = 0; ai < 2; ++ai) { u32x4 w[4][2];
#pragma unroll
            for (int m = 0; m < 4; ++m)
#pragma unroll
                for (int bj = 0; bj < 2; ++bj) w[m][bj] = *(const u32x4*)(xx + (size_t)(tok[ai][m] >= 0 ? tok[ai][m] : 0) * D_ + u.pn * 256 + wc * 32 + 8 * fq + bj * 128);
#pragma unroll
            for (int m = 0; m < 4; ++m)
#pragma unroll
                for (int bj = 0; bj < 2; ++bj) asm volatile("" : "+v"(w[m][bj]));
#pragma unroll
            for (int m = 0; m < 4; ++m) if (tok[ai][m] >= 0) {
#pragma unroll
                for (int bj = 0; bj < 2; ++bj) *(u32x4*)(xx + (size_t)tok[ai][m] * D_ + u.pn * 256 + wc * 32 + 8 * fq + bj * 128) = res_add8(w[m][bj], acc[ai][bj][m][0], acc[ai][bj][m][1]); } }
    }
};

__device__ __forceinline__ void transpose_item(const float* W, int ldw, bf16* WT, int ldt, int r0, int rmul, int k0, LAS float* scr, int lane, const float* gk = nullptr) {
    f32x4 v[8];
#pragma unroll
    for (int i = 0; i < 8; ++i) v[i] = *(const f32x4*)(W + (size_t)(k0 + i * 8 + (lane >> 3)) * ldw + (lane & 7) * 4);
    if (gk) {
#pragma unroll
        for (int i = 0; i < 8; ++i) { const float gsc = gk[k0 + i * 8 + (lane >> 3)]; v[i].x *= gsc; v[i].y *= gsc; v[i].z *= gsc; v[i].w *= gsc; } }
#pragma unroll
    for (int i = 0; i < 8; ++i) { LAS float* d = scr + (i * 8 + (lane >> 3)) * 33 + (lane & 7) * 4; d[0] = v[i].x; d[1] = v[i].y; d[2] = v[i].z; d[3] = v[i].w; }
    asm volatile("s_waitcnt lgkmcnt(0)" ::: "memory");
    const int c = lane & 7;
#pragma unroll
    for (int j = 0; j < 4; ++j) { const int n = (lane >> 3) + 8 * j; const LAS float* sp = scr + (8 * c) * 33 + n;
        u32x4 o; o.x = pk2(sp[0 * 33], sp[1 * 33]); o.y = pk2(sp[2 * 33], sp[3 * 33]); o.z = pk2(sp[4 * 33], sp[5 * 33]); o.w = pk2(sp[6 * 33], sp[7 * 33]);
        *(u32x4*)(WT + (size_t)(r0 + rmul * n) * ldt + k0 + 8 * c) = o; }
    asm volatile("s_waitcnt lgkmcnt(0)" ::: "memory");
}
__device__ __forceinline__ void transpose_seg(const float* W, int ldw, int K, int sc0, int ncol, bf16* WT, int r0, int rmul, int item, LAS float* scr, int lane, const float* gk = nullptr) {
    const int nb = ncol / 32, kb = item / nb, cb = item % nb;
    transpose_item(W + sc0 + cb * 32, ldw, WT, K, r0 + rmul * cb * 32, rmul, kb * 64, scr, lane, gk);
}

typedef float f32x16 __attribute__((ext_vector_type(16)));
typedef short bf16x8v __attribute__((ext_vector_type(8)));
typedef short s16x4 __attribute__((ext_vector_type(4)));
typedef float f32x2_t __attribute__((ext_vector_type(2)));
typedef __bf16 bf16x2_t __attribute__((ext_vector_type(2)));
constexpr int A_KBUF = 10240, A_VBUF = 12288;
constexpr int A_KOFF = 0, A_VOFF = 2 * A_KBUF, A_BOFF = A_VOFF + 2 * A_VBUF, A_BTILE = 8 * 256, A_LDS_END = A_BOFF + 2 * A_BTILE;
__device__ __forceinline__ constexpr int crow0(int reg) { return (reg & 3) + 8 * (reg >> 2); }
__device__ __forceinline__ float swap_max(float m) { auto rr = __builtin_amdgcn_permlane32_swap(__float_as_uint(m), __float_as_uint(m), false, false); return fmaxf(__uint_as_float(rr[0]), __uint_as_float(rr[1])); }
__device__ __forceinline__ float swap_sum(float m) { auto rr = __builtin_amdgcn_permlane32_swap(__float_as_uint(m), __float_as_uint(m), false, false); return __uint_as_float(rr[0]) + __uint_as_float(rr[1]); }
__device__ __forceinline__ unsigned cvtpk(float lo, float hi) { f32x2_t v = {lo, hi}; bf16x2_t b = __builtin_convertvector(v, bf16x2_t); return __builtin_bit_cast(unsigned, b); }
__device__ __forceinline__ bf16x8v pack8(const f32x16& p, int b0) { u32x4 w; w.x = cvtpk(p[b0 + 0], p[b0 + 1]); w.y = cvtpk(p[b0 + 2], p[b0 + 3]); w.z = cvtpk(p[b0 + 4], p[b0 + 5]); w.w = cvtpk(p[b0 + 6], p[b0 + 7]); return __builtin_bit_cast(bf16x8v, w); }
__device__ __forceinline__ s16x4 tr_read(const LAS unsigned char* p) { typedef short v4i16_t __attribute__((ext_vector_type(4))); return __builtin_bit_cast(s16x4, __builtin_amdgcn_ds_read_tr16_b64_v4i16((LAS v4i16_t*)p)); }

template <int DQK>
__device__ __forceinline__ void attn_preload(const bf16* Kb0, const bf16* Kb1, const bf16* Vb, int j, int tid, u32x4& kreg, u32x4& vreg) {
    const bf16* ksrc;
    if (DQK == 64) ksrc = Kb0 + b64_off(tid >> 3, (tid & 7) * 8); else { const int mp = tid >> 8, tt = tid & 255; ksrc = (mp ? Kb1 : Kb0) + (tt >> 2) * 32 + (tt & 3) * 8; }
    const bf16* vsrc = Vb + b64_off(tid >> 3, (tid & 7) * 8);
    kreg = *(const u32x4*)(ksrc + (size_t)(j * 64) * DQK); vreg = *(const u32x4*)(vsrc + (size_t)(j * 64) * 64);
}
template <int DQK, int NMAP, bool FOX, bool SLC, bool PRE = false, bool NOMAX = false>
__device__ __forceinline__ void attn_core(LAS unsigned char* L, const bf16* Kb0, const bf16* Kb1, const bf16* Vb, const LAS float* cum, float cum_ref,
                                          const bf16x8v (&Qf)[NMAP][DQK / 16], u64 tilemask, int t_lane, int tw0, int win, float slope2, unsigned selw0, unsigned selw1,
                                          f32x16 (&O)[NMAP][2], float (&M)[NMAP], float (&Ls)[NMAP], int tid, bool started0 = false, int jpre = 0, u32x4 kpre = (u32x4){0u, 0u, 0u, 0u}, u32x4 vpre = (u32x4){0u, 0u, 0u, 0u}) {
    constexpr int KP = DQK * 2 + 16, VP = 192;
    const int lane = tid & 63, r = lane & 31, h = lane >> 5;
    int kdst; const bf16* ksrc;
    if (DQK == 64) { kdst = (tid >> 3) * KP + (tid & 7) * 16; ksrc = Kb0 + b64_off(tid >> 3, (tid & 7) * 8); }
    else { const int mp = tid >> 8, tt = tid & 255; kdst = mp * 5120 + (tt >> 2) * KP + (tt & 3) * 16; ksrc = (mp ? Kb1 : Kb0) + (tt >> 2) * 32 + (tt & 3) * 8; }
    const int vdst = (tid >> 3) * VP + (tid & 7) * 16; const bf16* vsrc = Vb + b64_off(tid >> 3, (tid & 7) * 8);
    const LAS unsigned char* kfrag = L + A_KOFF + r * KP + h * 16;
    const LAS unsigned char* vfrag = L + A_VOFF + (4 * h + ((lane & 15) >> 2)) * VP + (16 * ((lane >> 4) & 1) + 4 * (lane & 3)) * 2;
    u32x4 kreg, vreg; float breg = 0.f;
    u64 mk = tilemask;
    int j = PRE ? jpre : 63 - __builtin_clzll(mk); mk &= ~(1ull << j);
    { const int kv0 = j * 64; if (PRE) { kreg = kpre; vreg = vpre; } else { kreg = *(const u32x4*)(ksrc + (size_t)kv0 * DQK); vreg = *(const u32x4*)(vsrc + (size_t)kv0 * 64); } if (FOX) breg = (cum_ref - cum[kv0 + lane]) * LOG2E; }
    *(LAS u32x4*)(L + A_KOFF + kdst) = kreg; *(LAS u32x4*)(L + A_VOFF + vdst) = vreg; if (FOX) *(LAS float*)(L + A_BOFF + tid * 4) = breg;
    __syncthreads();
    int buf = 0; bool started = started0;
    float pdummy = 0.f; int idummy = 0; f32x16 dm0; for (int i = 0; i < 16; ++i) dm0[i] = 0.f;
    for (;;) {
        const bool more = mk != 0ull; int jn = 0;
        if (more) { jn = 63 - __builtin_clzll(mk); mk &= ~(1ull << jn); const int kv0 = jn * 64;
            kreg = *(const u32x4*)(ksrc + (size_t)kv0 * DQK); vreg = *(const u32x4*)(vsrc + (size_t)kv0 * 64); if (FOX) breg = (cum_ref - cum[kv0 + lane]) * LOG2E; }
        { const int kv0 = j * 64;
          bool wave_has = true; float selb = 0.f;
          if (SLC) { const bool mine = ((j < 32 ? (selw0 >> j) : (selw1 >> (j - 32))) & 1u) != 0u; selb = mine ? 0.f : -INFINITY; wave_has = __any(mine); }
          if (wave_has && !(kv0 > tw0 + 31) && !(tw0 - (kv0 + 63) >= win)) {
            const bool need_mask = (kv0 + 63 > tw0) || (tw0 + 31 - kv0 >= win);
            const int dl = t_lane - kv0 - 4 * h;
            bf16x8v pa[NMAP][4];
#pragma unroll
            for (int mp = 0; mp < NMAP; ++mp) {
                f32x16 p0, p1;
                if (FOX) { const LAS f32x4* bl = (const LAS f32x4*)(L + A_BOFF + buf * A_BTILE + (tid >> 6) * 256) + h; const float mm = NOMAX ? 0.f : M[mp];
#pragma unroll
                    for (int g4 = 0; g4 < 4; ++g4) { const f32x4 b0 = bl[2 * g4], b1 = bl[8 + 2 * g4];
                        p0[4 * g4 + 0] = b0.x - mm; p0[4 * g4 + 1] = b0.y - mm; p0[4 * g4 + 2] = b0.z - mm; p0[4 * g4 + 3] = b0.w - mm; p1[4 * g4 + 0] = b1.x - mm; p1[4 * g4 + 1] = b1.y - mm; p1[4 * g4 + 2] = b1.z - mm; p1[4 * g4 + 3] = b1.w - mm; } }
                else { const float base_l = (slope2 * (float)(kv0 + 4 * h - tw0) - (NOMAX ? 0.f : M[mp])) + selb, s8 = slope2 * 8.f, s32 = slope2 * 32.f;
                    p0[0] = base_l; p0[1] = p0[0] + slope2; p0[2] = p0[1] + slope2; p0[3] = p0[2] + slope2;
#pragma unroll
                    for (int reg = 4; reg < 16; ++reg) p0[reg] = p0[reg - 4] + s8;
#pragma unroll
                    for (int reg = 0; reg < 16; ++reg) p1[reg] = p0[reg] + s32; }
                const LAS unsigned char* kb = kfrag + buf * A_KBUF + (DQK == 32 ? mp * 5120 : 0);
#pragma unroll
                for (int s = 0; s < DQK / 16; ++s) { const bf16x8v kf0 = *(const LAS bf16x8v*)(kb + s * 32), kf1 = *(const LAS bf16x8v*)(kb + 32 * KP + s * 32);
#ifdef PROBE_X_LDSK
                    { const bf16x8v z0 = *(const volatile LAS bf16x8v*)(kb + s * 32), z1 = *(const volatile LAS bf16x8v*)(kb + 32 * KP + s * 32); idummy ^= z0[0] ^ z1[1]; }
#endif
#ifdef PROBE_X_MFMA
                    dm0 = __builtin_amdgcn_mfma_f32_32x32x16_bf16(kf0, Qf[mp][s], dm0, 0, 0, 0); dm0 = __builtin_amdgcn_mfma_f32_32x32x16_bf16(kf1, Qf[mp][s], dm0, 0, 0, 0);
#endif
                    p0 = __builtin_amdgcn_mfma_f32_32x32x16_bf16(kf0, Qf[mp][s], p0, 0, 0, 0); p1 = __builtin_amdgcn_mfma_f32_32x32x16_bf16(kf1, Qf[mp][s], p1, 0, 0, 0); }
                if (need_mask) {
#pragma unroll
                    for (int reg = 0; reg < 16; ++reg) { const int d0 = dl - crow0(reg), d1 = d0 - 32;
                        p0[reg] = (d0 >= 0 && d0 < win) ? p0[reg] : -INFINITY; p1[reg] = (d1 >= 0 && d1 < win) ? p1[reg] : -INFINITY; } }
                if (!NOMAX) {
                float mt = fmaxf(fmaxf(p0[0], p1[0]), fmaxf(p0[1], p1[1]));
#pragma unroll
                for (int reg = 2; reg < 16; reg += 2) mt = fmaxf(fmaxf(mt, fmaxf(fmaxf(p0[reg], p1[reg]), p0[reg + 1])), p1[reg + 1]);
                mt = swap_max(mt);
                if (!started || __any(mt > 8.f)) {
                    const float d = (mt > -1e30f) ? (started ? fmaxf(mt, 0.f) : mt) : 0.f, alpha = __builtin_amdgcn_exp2f(-d);
                    O[mp][0] *= alpha; O[mp][1] *= alpha; Ls[mp] *= alpha; M[mp] += d;
#pragma unroll
                    for (int reg = 0; reg < 16; ++reg) { p0[reg] -= d; p1[reg] -= d; } } }
                float rs = 0.f;
#ifdef PROBE_X_EXP
#pragma unroll
                for (int reg = 0; reg < 16; ++reg) { pdummy += __builtin_amdgcn_exp2f(p0[reg] - 1.f) + __builtin_amdgcn_exp2f(p1[reg] - 1.f); }
#endif
#pragma unroll
                for (int reg = 0; reg < 16; ++reg) { p0[reg] = __builtin_amdgcn_exp2f(p0[reg]); p1[reg] = __builtin_amdgcn_exp2f(p1[reg]); rs += p0[reg] + p1[reg]; }
                Ls[mp] += rs;
                pa[mp][0] = pack8(p0, 0); pa[mp][1] = pack8(p0, 8); pa[mp][2] = pack8(p1, 0); pa[mp][3] = pack8(p1, 8);
            }
            started = true;
            const LAS unsigned char* vb = vfrag + buf * A_VBUF;
#pragma unroll
            for (int db = 0; db < 2; ++db)
#pragma unroll
                for (int ks = 0; ks < 4; ++ks) { const s16x4 lo = tr_read(vb + ks * (16 * VP) + db * 64), hi = tr_read(vb + ks * (16 * VP) + db * 64 + 8 * VP);
                    const bf16x8v vf = {lo[0], lo[1], lo[2], lo[3], hi[0], hi[1], hi[2], hi[3]};
#pragma unroll
                    for (int mp = 0; mp < NMAP; ++mp) O[mp][db] = __builtin_amdgcn_mfma_f32_32x32x16_bf16(vf, pa[mp][ks], O[mp][db], 0, 0, 0); }
          } }
        if (more) { *(LAS u32x4*)(L + A_KOFF + (buf ^ 1) * A_KBUF + kdst) = kreg; *(LAS u32x4*)(L + A_VOFF + (buf ^ 1) * A_VBUF + vdst) = vreg; if (FOX) *(LAS float*)(L + A_BOFF + (buf ^ 1) * A_BTILE + tid * 4) = breg; }
#ifdef PROBE_X_BAR
        __syncthreads();
#endif
        __syncthreads();
        if (!more) break;
        j = jn; buf ^= 1;
    }
    if (pdummy == 123.456f || idummy == 0x7fffabcd || dm0[3] == 98765.4321f) Ls[0] += 1e-30f;
}
#ifndef AC2_MODE
#define AC2_MODE 0
#endif
#ifndef AC2_INIT_VALU
#define AC2_INIT_VALU 24
#endif
template <bool FOX, bool SLC>
__device__ __forceinline__ void attn_core2(LAS unsigned char* L, const bf16* Kb0, const bf16* Vb, const LAS float* cum, float cum_ref,
                                           const bf16x8v (&Qf)[4], u64 tilemask, int t_lane, int tw0, int win, float slope2, unsigned selw0, unsigned selw1,
                                           f32x16 (&O)[2], float& M, float& Ls, int tid) {
    constexpr int KP = 144, VP = 192;
    const int lane = tid & 63, r = lane & 31, h = lane >> 5;
    const int kdst = (tid >> 3) * KP + (tid & 7) * 16; const bf16* ksrc = Kb0 + b64_off(tid >> 3, (tid & 7) * 8);
    const int vdst = (tid >> 3) * VP + (tid & 7) * 16; const bf16* vsrc = Vb + b64_off(tid >> 3, (tid & 7) * 8);
    const LAS unsigned char* kfrag = L + A_KOFF + r * KP + h * 16;
    const LAS unsigned char* vfrag = L + A_VOFF + (4 * h + ((lane & 15) >> 2)) * VP + (16 * ((lane >> 4) & 1) + 4 * (lane & 3)) * 2;
#define AC2_ACTIVE(jj) (!((jj) * 64 > tw0 + 31) && !(tw0 - ((jj) * 64 + 63) >= win))
#define AC2_INIT(jj, kslot, q0, q1) do { const int kv0_ = (jj) * 64; \
        if (FOX) { const LAS f32x4* bl = (const LAS f32x4*)(L + A_BOFF + (kslot) * 256) + h; const float mm = M; \
            _Pragma("unroll") for (int g4 = 0; g4 < 4; ++g4) { const f32x4 b0 = bl[2 * g4], b1 = bl[8 + 2 * g4]; \
                q0[4 * g4 + 0] = b0.x - mm; q0[4 * g4 + 1] = b0.y - mm; q0[4 * g4 + 2] = b0.z - mm; q0[4 * g4 + 3] = b0.w - mm; q1[4 * g4 + 0] = b1.x - mm; q1[4 * g4 + 1] = b1.y - mm; q1[4 * g4 + 2] = b1.z - mm; q1[4 * g4 + 3] = b1.w - mm; } } \
        else { float selb = 0.f; if (SLC) selb = ((((jj) < 32) ? (selw0 >> (jj)) : (selw1 >> ((jj) - 32))) & 1u) ? 0.f : -INFINITY; \
            const float base_l = (slope2 * (float)(kv0_ + 4 * h - tw0) - M) + selb, s8 = slope2 * 8.f, s32 = slope2 * 32.f; \
            q0[0] = base_l; q0[1] = q0[0] + slope2; q0[2] = q0[1] + slope2; q0[3] = q0[2] + slope2; \
            _Pragma("unroll") for (int reg = 4; reg < 16; ++reg) q0[reg] = q0[reg - 4] + s8; \
            _Pragma("unroll") for (int reg = 0; reg < 16; ++reg) q1[reg] = q0[reg] + s32; } } while (0)
#define AC2_QK(jj, kslot) do { AC2_INIT(jj, kslot, p0, p1); \
        const LAS unsigned char* kb_ = kfrag + (kslot) * A_KBUF; \
        _Pragma("unroll") for (int s_ = 0; s_ < 4; ++s_) { const bf16x8v kf0 = *(const LAS bf16x8v*)(kb_ + s_ * 32), kf1 = *(const LAS bf16x8v*)(kb_ + 32 * KP + s_ * 32); \
            p0 = __builtin_amdgcn_mfma_f32_32x32x16_bf16(kf0, Qf[s_], p0, 0, 0, 0); p1 = __builtin_amdgcn_mfma_f32_32x32x16_bf16(kf1, Qf[s_], p1, 0, 0, 0); } } while (0)
    u32x4 kreg, vreg; float breg = 0.f;
    u64 mk = tilemask;
    int j = 63 - __builtin_clzll(mk); mk &= ~(1ull << j);
    int jn = -1; if (mk) { jn = 63 - __builtin_clzll(mk); mk &= ~(1ull << jn); }
    { kreg = *(const u32x4*)(ksrc + (size_t)j * 64 * 64); vreg = *(const u32x4*)(vsrc + (size_t)j * 64 * 64); if (FOX && tid < 64) breg = (cum_ref - cum[j * 64 + tid]) * LOG2E;
      *(LAS u32x4*)(L + A_KOFF + kdst) = kreg; *(LAS u32x4*)(L + A_VOFF + vdst) = vreg; if (FOX && tid < 64) *(LAS float*)(L + A_BOFF + tid * 4) = breg;
      if (jn >= 0) { kreg = *(const u32x4*)(ksrc + (size_t)jn * 64 * 64); if (FOX && tid < 64) breg = (cum_ref - cum[jn * 64 + tid]) * LOG2E;
          *(LAS u32x4*)(L + A_KOFF + A_KBUF + kdst) = kreg; if (FOX && tid < 64) *(LAS float*)(L + A_BOFF + 256 + tid * 4) = breg; } }
    __syncthreads();
    f32x16 p0, p1;
    bool started = false;
    int ks = 0, vs = 0;
    if (AC2_ACTIVE(j)) AC2_QK(j, 0);
    for (;;) {
        int jnn = -1; if (mk) { jnn = 63 - __builtin_clzll(mk); mk &= ~(1ull << jnn); }
        if (jnn >= 0) { kreg = *(const u32x4*)(ksrc + (size_t)jnn * 64 * 64); if (FOX && tid < 64) breg = (cum_ref - cum[jnn * 64 + tid]) * LOG2E; }
        if (jn >= 0) vreg = *(const u32x4*)(vsrc + (size_t)jn * 64 * 64);
        const bool act = AC2_ACTIVE(j), actn = jn >= 0 && AC2_ACTIVE(jn);
        if (act) {
            const int kv0 = j * 64;
            if ((kv0 + 63 > tw0) || (tw0 + 31 - kv0 >= win)) { const int dl = t_lane - kv0 - 4 * h;
#pragma unroll
                for (int reg = 0; reg < 16; ++reg) { const int d0 = dl - crow0(reg), d1 = d0 - 32;
                    p0[reg] = (d0 >= 0 && d0 < win) ? p0[reg] : -INFINITY; p1[reg] = (d1 >= 0 && d1 < win) ? p1[reg] : -INFINITY; } }
            float mt = fmaxf(fmaxf(p0[0], p1[0]), fmaxf(p0[1], p1[1]));
#pragma unroll
            for (int reg = 2; reg < 16; reg += 2) mt = fmaxf(fmaxf(mt, fmaxf(fmaxf(p0[reg], p1[reg]), p0[reg + 1])), p1[reg + 1]);
            mt = swap_max(mt);
            if (!started || __any(mt > 8.f)) {
                const float d = (mt > -1e30f) ? (started ? fmaxf(mt, 0.f) : mt) : 0.f, alpha = __builtin_amdgcn_exp2f(-d);
                O[0] *= alpha; O[1] *= alpha; Ls *= alpha; M += d;
#pragma unroll
                for (int reg = 0; reg < 16; ++reg) { p0[reg] -= d; p1[reg] -= d; } }
            started = true;
#if AC2_MODE == 1
            {
                const int jq = jn >= 0 ? jn : 0;
                float rs = 0.f;
#pragma unroll
                for (int reg = 0; reg < 16; ++reg) { p0[reg] = __builtin_amdgcn_exp2f(p0[reg]); p1[reg] = __builtin_amdgcn_exp2f(p1[reg]); rs += p0[reg] + p1[reg]; }
                Ls += rs;
                const bf16x8v pa0 = pack8(p0, 0), pa1 = pack8(p0, 8), pa2 = pack8(p1, 0), pa3 = pack8(p1, 8);
                AC2_QK(jq, ks ^ 1);
                const LAS unsigned char* vb = vfrag + vs * A_VBUF;
#pragma unroll
                for (int db = 0; db < 2; ++db)
#pragma unroll
                    for (int kq = 0; kq < 4; ++kq) { const s16x4 lo = tr_read(vb + kq * (16 * VP) + db * 64), hi = tr_read(vb + kq * (16 * VP) + db * 64 + 8 * VP);
                        const bf16x8v vf = {lo[0], lo[1], lo[2], lo[3], hi[0], hi[1], hi[2], hi[3]};
                        O[db] = __builtin_amdgcn_mfma_f32_32x32x16_bf16(vf, kq == 0 ? pa0 : kq == 1 ? pa1 : kq == 2 ? pa2 : pa3, O[db], 0, 0, 0); }
            }
#else
            {
                const int jq = jn >= 0 ? jn : 0;
                f32x16 n0, n1;
                AC2_INIT(jq, ks ^ 1, n0, n1);
                const LAS unsigned char* kb_ = kfrag + (ks ^ 1) * A_KBUF;
                bf16x8v kf[8];
#pragma unroll
                for (int s_ = 0; s_ < 4; ++s_) { kf[2 * s_] = *(const LAS bf16x8v*)(kb_ + s_ * 32); kf[2 * s_ + 1] = *(const LAS bf16x8v*)(kb_ + 32 * KP + s_ * 32); }
                const LAS unsigned char* vb = vfrag + vs * A_VBUF;
                __builtin_amdgcn_sched_barrier(0);
                float ra = 0.f, rb = 0.f; unsigned w[16];
#define AC2_PINF(x) asm volatile("" : "+v"(x))
#define AC2_QGAP(i) do { if ((i) & 1) n1 = __builtin_amdgcn_mfma_f32_32x32x16_bf16(kf[i], Qf[(i) >> 1], n1, 0, 0, 0); else n0 = __builtin_amdgcn_mfma_f32_32x32x16_bf16(kf[i], Qf[(i) >> 1], n0, 0, 0, 0); \
                    float e0 = __builtin_amdgcn_exp2f(p0[2 * (i)]), e1 = __builtin_amdgcn_exp2f(p0[2 * (i) + 1]), e2 = __builtin_amdgcn_exp2f(p1[2 * (i)]), e3 = __builtin_amdgcn_exp2f(p1[2 * (i) + 1]); \
                    ra += e0 + e1; rb += e2 + e3; \
                    AC2_PINF(e0); AC2_PINF(e1); AC2_PINF(e2); AC2_PINF(e3); AC2_PINF(ra); AC2_PINF(rb); \
                    p0[2 * (i)] = e0; p0[2 * (i) + 1] = e1; p1[2 * (i)] = e2; p1[2 * (i) + 1] = e3; \
                    if ((i) >= 4) { w[2 * ((i) - 4)] = cvtpk(p0[4 * ((i) - 4)], p0[4 * ((i) - 4) + 1]); w[2 * ((i) - 4) + 1] = cvtpk(p0[4 * ((i) - 4) + 2], p0[4 * ((i) - 4) + 3]); AC2_PINF(w[2 * ((i) - 4)]); AC2_PINF(w[2 * ((i) - 4) + 1]); } \
                    if ((i) == 6) { vl[0] = tr_read(vb); vh[0] = tr_read(vb + 8 * VP); } \
                    if ((i) == 7) { vl[1] = tr_read(vb + 64); vh[1] = tr_read(vb + 64 + 8 * VP); } \
                    __builtin_amdgcn_sched_barrier(0); } while (0)
                s16x4 vl[2], vh[2];
                AC2_QGAP(0); AC2_QGAP(1); AC2_QGAP(2); AC2_QGAP(3); AC2_QGAP(4); AC2_QGAP(5); AC2_QGAP(6); AC2_QGAP(7);
                Ls += ra + rb;
#define AC2_PA(kq) __builtin_bit_cast(bf16x8v, (u32x4){w[4 * (kq)], w[4 * (kq) + 1], w[4 * (kq) + 2], w[4 * (kq) + 3]})
#define AC2_PGAP(g) do { const int kq_ = (g) >> 1, db_ = (g) & 1; const bf16x8v vf = {vl[(g) & 1][0], vl[(g) & 1][1], vl[(g) & 1][2], vl[(g) & 1][3], vh[(g) & 1][0], vh[(g) & 1][1], vh[(g) & 1][2], vh[(g) & 1][3]}; \
                    if ((g) < 6) { const int kq2 = ((g) + 2) >> 1, db2 = (g) & 1; vl[(g) & 1] = tr_read(vb + kq2 * (16 * VP) + db2 * 64); vh[(g) & 1] = tr_read(vb + kq2 * (16 * VP) + db2 * 64 + 8 * VP); } \
                    O[db_] = __builtin_amdgcn_mfma_f32_32x32x16_bf16(vf, AC2_PA(kq_), O[db_], 0, 0, 0); \
                    if ((g) < 4) { w[8 + 2 * (g)] = cvtpk(p1[4 * (g)], p1[4 * (g) + 1]); w[8 + 2 * (g) + 1] = cvtpk(p1[4 * (g) + 2], p1[4 * (g) + 3]); AC2_PINF(w[8 + 2 * (g)]); AC2_PINF(w[8 + 2 * (g) + 1]); } \
                    __builtin_amdgcn_sched_barrier(0); } while (0)
                AC2_PGAP(0); AC2_PGAP(1); AC2_PGAP(2); AC2_PGAP(3); AC2_PGAP(4); AC2_PGAP(5); AC2_PGAP(6); AC2_PGAP(7);
#undef AC2_PGAP
#undef AC2_PA
#undef AC2_QGAP
#undef AC2_PINF
                p0 = n0; p1 = n1;
            }
#endif
        } else if (actn) AC2_QK(jn, ks ^ 1);
        if (jnn >= 0) { *(LAS u32x4*)(L + A_KOFF + ks * A_KBUF + kdst) = kreg; if (FOX && tid < 64) *(LAS float*)(L + A_BOFF + ks * 256 + tid * 4) = breg; }
        if (jn >= 0) *(LAS u32x4*)(L + A_VOFF + (vs ^ 1) * A_VBUF + vdst) = vreg;
        __syncthreads();
        if (jn < 0) break;
        j = jn; jn = jnn; ks ^= 1; vs ^= 1;
    }
#undef AC2_QK
#undef AC2_INIT
#undef AC2_ACTIVE
}
__device__ __forceinline__ size_t mix_off(size_t n, int c, int W) { return ((n >> 5) * (size_t)(W / 8) + (size_t)(c >> 3)) * 256 + (n & 31) * 8 + (c & 7); }
#define ATTN_FOR_CHUNKS(db, g4) _Pragma("unroll") for (int db = 0; db < 2; ++db) _Pragma("unroll") for (int g4 = 0; g4 < 4; ++g4)

__device__ __forceinline__ void unpack8(const u32x4 w, float (&f)[8]) { f[0] = __uint_as_float(w.x << 16); f[1] = __uint_as_float(w.x & 0xffff0000u); f[2] = __uint_as_float(w.y << 16); f[3] = __uint_as_float(w.y & 0xffff0000u);
    f[4] = __uint_as_float(w.z << 16); f[5] = __uint_as_float(w.z & 0xffff0000u); f[6] = __uint_as_float(w.w << 16); f[7] = __uint_as_float(w.w & 0xffff0000u); }
__device__ __forceinline__ void ph_norm_bf16_from_bf16(const Ctx& c, const bf16* x, const float* g, bf16* out) {
    constexpr int RB = 4; float gg[2][8];
#pragma unroll
    for (int j = 0; j < 2; ++j) { const f32x4 a = ((const f32x4*)g)[2 * c.lane + 128 * j], b2 = ((const f32x4*)g)[2 * c.lane + 128 * j + 1]; gg[j][0] = a.x; gg[j][1] = a.y; gg[j][2] = a.z; gg[j][3] = a.w; gg[j][4] = b2.x; gg[j][5] = b2.y; gg[j][6] = b2.z; gg[j][7] = b2.w; }
    for (int row0 = c.gw * RB; row0 < NT; row0 += c.ngw * RB) {
        u32x4 v[RB][2];
#pragma unroll
        for (int q = 0; q < RB; ++q)
#pragma unroll
            for (int j = 0; j < 2; ++j) v[q][j] = ((const u32x4*)(x + (size_t)(row0 + q) * D_))[c.lane + 64 * j];
#pragma unroll
        for (int q = 0; q < RB; ++q) { float f[2][8]; float ss = 0.f;
#pragma unroll
            for (int j = 0; j < 2; ++j) { unpack8(v[q][j], f[j]);
#pragma unroll
                for (int e = 0; e < 8; ++e) ss = fmaf(f[j][e], f[j][e], ss); }
            const float r = rsqrtf(wave_sum_l(ss, c.lane) * (1.f / D_) + EPS);
#pragma unroll
            for (int j = 0; j < 2; ++j) { u32x4 o; o.x = pk2(f[j][0] * r * gg[j][0], f[j][1] * r * gg[j][1]); o.y = pk2(f[j][2] * r * gg[j][2], f[j][3] * r * gg[j][3]); o.z = pk2(f[j][4] * r * gg[j][4], f[j][5] * r * gg[j][5]); o.w = pk2(f[j][6] * r * gg[j][6], f[j][7] * r * gg[j][7]);
                ((u32x4*)(out + (size_t)(row0 + q) * D_))[c.lane + 64 * j] = o; } }
    }
}
__device__ __forceinline__ void ph_norm_final_from_bf16(const Ctx& c, const bf16* x, const float* g, float* out) {
    constexpr int RB = 4; float gg[2][8];
#pragma unroll
    for (int j = 0; j < 2; ++j) { const f32x4 a = ((const f32x4*)g)[2 * c.lane + 128 * j], b2 = ((const f32x4*)g)[2 * c.lane + 128 * j + 1]; gg[j][0] = a.x; gg[j][1] = a.y; gg[j][2] = a.z; gg[j][3] = a.w; gg[j][4] = b2.x; gg[j][5] = b2.y; gg[j][6] = b2.z; gg[j][7] = b2.w; }
    for (int row0 = c.gw * RB; row0 < NT; row0 += c.ngw * RB) {
        u32x4 v[RB][2];
#pragma unroll
        for (int q = 0; q < RB; ++q)
#pragma unroll
            for (int j = 0; j < 2; ++j) v[q][j] = ((const u32x4*)(x + (size_t)(row0 + q) * D_))[c.lane + 64 * j];
#pragma unroll
        for (int q = 0; q < RB; ++q) { float f[2][8]; float ss = 0.f;
#pragma unroll
            for (int j = 0; j < 2; ++j) { unpack8(v[q][j], f[j]);
#pragma unroll
                for (int e = 0; e < 8; ++e) ss = fmaf(f[j][e], f[j][e], ss); }
            const float r = rsqrtf(wave_sum_l(ss, c.lane) * (1.f / D_) + EPS);
#pragma unroll
            for (int j = 0; j < 2; ++j) { f32x4* o = (f32x4*)(out + (size_t)(row0 + q) * D_) + 2 * c.lane + 128 * j;
                o[0] = (f32x4){f[j][0] * r * gg[j][0], f[j][1] * r * gg[j][1], f[j][2] * r * gg[j][2], f[j][3] * r * gg[j][3]}; o[1] = (f32x4){f[j][4] * r * gg[j][4], f[j][5] * r * gg[j][5], f[j][6] * r * gg[j][6], f[j][7] * r * gg[j][7]}; } }
    }
}
__device__ __forceinline__ void ph_norm_bf16(const Ctx& c, const float* x, const float* g, bf16* out, bf16* raw) {
    constexpr int RB = 4;
    f32x4 gg[4];
#pragma unroll
    for (int j = 0; j < 4; ++j) gg[j] = ((const f32x4*)g)[c.lane + 64 * j];
    for (int row0 = c.gw * RB; row0 < NT; row0 += c.ngw * RB) {
        f32x4 v[RB][4];
#pragma unroll
        for (int q = 0; q < RB; ++q)
#pragma unroll
            for (int j = 0; j < 4; ++j) v[q][j] = ((const f32x4*)(x + (size_t)(row0 + q) * D_))[c.lane + 64 * j];
#pragma unroll
        for (int q = 0; q < RB; ++q) { float ss = 0.f;
#pragma unroll
            for (int j = 0; j < 4; ++j) ss += v[q][j].x * v[q][j].x + v[q][j].y * v[q][j].y + v[q][j].z * v[q][j].z + v[q][j].w * v[q][j].w;
            const float r = rsqrtf(wave_sum_l(ss, c.lane) * (1.f / D_) + EPS);
            u64* o8 = (u64*)(out + (size_t)(row0 + q) * D_) + c.lane; u64* r8 = (u64*)(raw + (size_t)(row0 + q) * D_) + c.lane;
#pragma unroll
            for (int j = 0; j < 4; ++j) { o8[64 * j] = (u64)pk2(v[q][j].x * r * gg[j].x, v[q][j].y * r * gg[j].y) | ((u64)pk2(v[q][j].z * r * gg[j].z, v[q][j].w * r * gg[j].w) << 32);
                r8[64 * j] = (u64)pk2(v[q][j].x, v[q][j].y) | ((u64)pk2(v[q][j].z, v[q][j].w) << 32); } }
    }
}
__device__ __forceinline__ void ph_norm_final(const Ctx& c, float* x, const float* g) {
    constexpr int RB = 4;
    f32x4 gg[4];
#pragma unroll
    for (int j = 0; j < 4; ++j) gg[j] = ((const f32x4*)g)[c.lane + 64 * j];
    for (int row0 = c.gw * RB; row0 < NT; row0 += c.ngw * RB) {
        f32x4 v[RB][4];
#pragma unroll
        for (int q = 0; q < RB; ++q)
#pragma unroll
            for (int j = 0; j < 4; ++j) v[q][j] = ((const f32x4*)(x + (size_t)(row0 + q) * D_))[c.lane + 64 * j];
#pragma unroll
        for (int q = 0; q < RB; ++q) { float ss = 0.f;
#pragma unroll
            for (int j = 0; j < 4; ++j) ss += v[q][j].x * v[q][j].x + v[q][j].y * v[q][j].y + v[q][j].z * v[q][j].z + v[q][j].w * v[q][j].w;
            const float r = rsqrtf(wave_sum_l(ss, c.lane) * (1.f / D_) + EPS);
            f32x4* xr = (f32x4*)(x + (size_t)(row0 + q) * D_) + c.lane;
#pragma unroll
            for (int j = 0; j < 4; ++j) xr[64 * j] = v[q][j] * r * gg[j]; }
    }
}

template <class AF, class EF>
__device__ __forceinline__ void naive_gemm(const Ctx& c, int M, int N, int K, AF af, const float* W, int ldb, EF ef) {
    LAS float* As = (LAS float*)c.lds;
    LAS float* Bs = As + 16 * 132;
    const int tm = (M + 127) / 128, tn = (N + 127) / 128, ntile = tm * tn;
    const int ty = c.tid >> 4, tx = c.tid & 15;
    for (int tile = c.bid; tile < ntile; tile += c.G) {
        const int m0 = (tile / tn) * 128, n0 = (tile % tn) * 128;
        float acc[4][8];
#pragma unroll
        for (int i = 0; i < 4; ++i)
#pragma unroll
            for (int j = 0; j < 8; ++j) acc[i][j] = 0.f;
        for (int k0 = 0; k0 < K; k0 += 16) {
            __syncthreads();
#pragma unroll
            for (int i = 0; i < 4; ++i) { const int e = c.tid + i * 512, r = e >> 4, kk = e & 15; const int row = m0 + r;
                As[kk * 132 + r] = (row < M) ? af(row, k0 + kk) : 0.f; }
#pragma unroll
            for (int i = 0; i < 4; ++i) { const int e = c.tid + i * 512, kk = e >> 7, cc = e & 127; const int col = n0 + cc;
                Bs[kk * 132 + cc] = (col < N) ? W[(size_t)(k0 + kk) * ldb + col] : 0.f; }
            __syncthreads();
#pragma unroll 2
            for (int kk = 0; kk < 16; ++kk) {
                float a[4], b[8];
#pragma unroll
                for (int i = 0; i < 4; ++i) a[i] = As[kk * 132 + ty * 4 + i];
#pragma unroll
                for (int j = 0; j < 8; ++j) b[j] = Bs[kk * 132 + tx * 8 + j];
#pragma unroll
                for (int i = 0; i < 4; ++i)
#pragma unroll
                    for (int j = 0; j < 8; ++j) acc[i][j] = fmaf(a[i], b[j], acc[i][j]);
            }
        }
        LAS float* Cs = Bs + 16 * 132;
        __syncthreads();
#pragma unroll
        for (int i = 0; i < 4; ++i)
#pragma unroll
            for (int j = 0; j < 8; ++j) Cs[(ty * 4 + i) * 129 + tx * 8 + j] = acc[i][j];
        __syncthreads();
#pragma unroll 1
        for (int e = c.tid; e < 128 * 128; e += NTHREADS) { const int r = e >> 7, cc = e & 127, row = m0 + r, col = n0 + cc; if (row < M && col < N) ef(row, col, Cs[r * 129 + cc]); }
    }
    __syncthreads();
}

struct InProjOut { bf16* qn; bf16* kv6; bf16* fqkv; bf16* dqk; bf16* dv; float* gate; float* fl; const float* b_gate; const float* b_fgt; };
__device__ __forceinline__ void inproj_store(const InProjOut& o, int n, int col, float v) {
    const int b = n / T_, t = n % T_;
    if (col < C_KV6) { const int h = col >> 6, d = col & 63; o.qn[((size_t)(b * 8 + h) * T_ + t) * 64 + d] = (bf16)f2bf(v * (0.125f * LOG2E)); }
    else if (col < C_GATE) { const int cc = col - C_KV6, idx = cc >> 7, g = (cc >> 6) & 1, d = cc & 63;
        ((bf16*)((unsigned char*)o.kv6 + idx * KV6_STRIDE))[((size_t)(b * 2 + g) * T_ + t) * 64 + d] = (bf16)f2bf(v); }
    else if (col < C_FQ) { const int j = col - C_GATE; o.gate[(size_t)n * 24 + j] = sigmoidf_(v + o.b_gate[j]); }
    else if (col < C_FF) { const int cc = col - C_FQ, idx = cc >> 8, h = (cc >> 6) & 3, d = cc & 63;
        o.fqkv[(size_t)idx * (8 * MiB) + ((size_t)(b * 4 + h) * T_ + t) * 64 + d] = (bf16)f2bf(idx == 0 ? v * (0.125f * LOG2E) : v); }
    else if (col < C_DQ) { const int h = col - C_FF; o.fl[(size_t)(b * 4 + h) * T_ + t] = log_sigmoidf_(v + o.b_fgt[h]); }
    else if (col < C_DV) { const int cc = col - C_DQ, idx = cc >> 8, h = (cc >> 6) & 3, i = (cc >> 5) & 1, d = cc & 31;
        o.dqk[(size_t)idx * (8 * MiB) + ((size_t)((b * 4 + h) * 2 + i) * T_ + t) * 32 + d] = (bf16)f2bf(idx == 0 ? v * (0.17677669529663687f * LOG2E) : v); }
    else { const int cc = col - C_DV, h = cc >> 6, d = cc & 63; o.dv[((size_t)(b * 4 + h) * T_ + t) * 64 + d] = (bf16)f2bf(v); }
}

__device__ __forceinline__ void ph_cumsum(const Ctx& c, float* fl) {
    for (int s = c.gw; s < B_ * 4; s += c.ngw) {
        float* p = fl + (size_t)s * T_; float carry = 0.f;
        for (int t0 = 0; t0 < T_; t0 += 64) {
            float v = p[t0 + c.lane];
#pragma unroll
            for (int o = 1; o < 64; o <<= 1) { const float u = __shfl_up(v, o); if (c.lane >= o) v += u; }
            v += carry; p[t0 + c.lane] = v; carry = __shfl(v, 63);
        }
    }
}

template <int DQK>
__device__ __forceinline__ float naive_attn_row(const bf16* q, const bf16* K, const bf16* V, int t, u64 mask, float slope2, const float* cum, int win, int lane) {
    float qv[DQK];
    { const u32x4* q4 = (const u32x4*)q;
#pragma unroll
      for (int i = 0; i < DQK / 8; ++i) { const u32x4 w = q4[i];
          qv[8 * i + 0] = __uint_as_float(w.x << 16); qv[8 * i + 1] = __uint_as_float(w.x & 0xffff0000u);
          qv[8 * i + 2] = __uint_as_float(w.y << 16); qv[8 * i + 3] = __uint_as_float(w.y & 0xffff0000u);
          qv[8 * i + 4] = __uint_as_float(w.z << 16); qv[8 * i + 5] = __uint_as_float(w.z & 0xffff0000u);
          qv[8 * i + 6] = __uint_as_float(w.w << 16); qv[8 * i + 7] = __uint_as_float(w.w & 0xffff0000u); } }
    const float cumt = cum ? cum[t] : 0.f;
    float m = -INFINITY, l = 0.f, o = 0.f;
    while (mask) {
        const int j = __builtin_ctzll(mask); mask &= mask - 1;
        const int kpos = 64 * j + lane; const int dist = t - kpos;
        const bool valid = dist >= 0 && dist < win;
        float s = 0.f;
        { const u32x4* k4 = (const u32x4*)(K + (size_t)kpos * DQK);
#pragma unroll
          for (int i = 0; i < DQK / 8; ++i) { const u32x4 w = k4[i];
              s = fmaf(qv[8 * i + 0], __uint_as_float(w.x << 16), s); s = fmaf(qv[8 * i + 1], __uint_as_float(w.x & 0xffff0000u), s);
              s = fmaf(qv[8 * i + 2], __uint_as_float(w.y << 16), s); s = fmaf(qv[8 * i + 3], __uint_as_float(w.y & 0xffff0000u), s);
              s = fmaf(qv[8 * i + 4], __uint_as_float(w.z << 16), s); s = fmaf(qv[8 * i + 5], __uint_as_float(w.z & 0xffff0000u), s);
              s = fmaf(qv[8 * i + 6], __uint_as_float(w.w << 16), s); s = fmaf(qv[8 * i + 7], __uint_as_float(w.w & 0xffff0000u), s); } }
        s -= slope2 * (float)dist;
        if (cum) s += (cumt - cum[kpos]) * LOG2E;
        s = valid ? s : -INFINITY;
        const float mb = wave_max(s);
        if (mb == -INFINITY) continue;
        const float mn = fmaxf(m, mb), alpha = exp2f(m - mn);
        const float p = valid ? exp2f(s - mn) : 0.f;
        l = l * alpha + wave_sum(p); o *= alpha; m = mn;
        const bf16* vb = V + (size_t)(64 * j) * 64 + lane;
#pragma unroll 8
        for (int k = 0; k < 64; ++k) o = fmaf(__shfl(p, k), bf2f(vb[(size_t)k * 64]), o);
    }
    return l > 0.f ? o / l : 0.f;
}

__device__ __forceinline__ void ph_cmp_attn(const Ctx& c, const bf16* qn, const bf16* kcmp, const bf16* vcmp, const float* gate, u64* sel, bf16* ocmp) {
    LAS float* pl = (LAS float*)(c.lds) + c.wave * 256;
    const int lane = c.lane;
    for (int it = c.gw; it < B_ * 2 * T_; it += c.ngw) {
        const int t = it % T_, bg = it / T_, b = bg >> 1, g = bg & 1;
        const int nvis = (t >= 31) ? ((t - 31) >> 4) + 1 : 0;
        const bf16* kc = kcmp + (size_t)bg * 256 * 64; const bf16* vc = vcmp + (size_t)bg * 256 * 64;
        float imp = 0.f;
        for (int hg = 0; hg < 4; ++hg) {
            const int h = g * 4 + hg; const float slope2 = alibi_slope(h + 1, 8) * LOG2E;
            const bf16* q = qn + ((size_t)(b * 8 + h) * T_ + t) * 64;
            float qv[64];
            { const u32x4* q4 = (const u32x4*)q;
#pragma unroll
              for (int i = 0; i < 8; ++i) { const u32x4 w = q4[i];
                  qv[8 * i + 0] = __uint_as_float(w.x << 16); qv[8 * i + 1] = __uint_as_float(w.x & 0xffff0000u);
                  qv[8 * i + 2] = __uint_as_float(w.y << 16); qv[8 * i + 3] = __uint_as_float(w.y & 0xffff0000u);
                  qv[8 * i + 4] = __uint_as_float(w.z << 16); qv[8 * i + 5] = __uint_as_float(w.z & 0xffff0000u);
                  qv[8 * i + 6] = __uint_as_float(w.w << 16); qv[8 * i + 7] = __uint_as_float(w.w & 0xffff0000u); } }
            float s[4]; float m = -INFINITY;
#pragma unroll
            for (int i = 0; i < 4; ++i) { const int cc = lane + 64 * i; float a = 0.f;
                if (cc < nvis) { const u32x4* k4 = (const u32x4*)(kc + (size_t)cc * 64);
#pragma unroll
                    for (int e = 0; e < 8; ++e) { const u32x4 w = k4[e];
                        a = fmaf(qv[8 * e + 0], __uint_as_float(w.x << 16), a); a = fmaf(qv[8 * e + 1], __uint_as_float(w.x & 0xffff0000u), a);
                        a = fmaf(qv[8 * e + 2], __uint_as_float(w.y << 16), a); a = fmaf(qv[8 * e + 3], __uint_as_float(w.y & 0xffff0000u), a);
                        a = fmaf(qv[8 * e + 4], __uint_as_float(w.z << 16), a); a = fmaf(qv[8 * e + 5], __uint_as_float(w.z & 0xffff0000u), a);
                        a = fmaf(qv[8 * e + 6], __uint_as_float(w.w << 16), a); a = fmaf(qv[8 * e + 7], __uint_as_float(w.w & 0xffff0000u), a); }
                    a -= slope2 * (float)(t - (16 * cc + 31)); } else a = -INFINITY;
                s[i] = a; m = fmaxf(m, a); }
            m = wave_max(m);
            float p[4], lsum = 0.f;
#pragma unroll
            for (int i = 0; i < 4; ++i) { p[i] = (lane + 64 * i < nvis) ? exp2f(s[i] - m) : 0.f; lsum += p[i]; }
            lsum = wave_sum(lsum);
            const float inv = lsum > 0.f ? 1.f / lsum : 0.f;
#pragma unroll
            for (int i = 0; i < 4; ++i) { p[i] *= inv; pl[lane + 64 * i] = p[i]; }
            asm volatile("s_waitcnt lgkmcnt(0)" ::: "memory");
            float o = 0.f;
            for (int cc = 0; cc < nvis; ++cc) o = fmaf(pl[cc], bf2f(vc[(size_t)cc * 64 + lane]), o);
            const float gt = gate[((size_t)(b * T_ + t)) * 24 + h * 3 + 0];
            ocmp[(size_t)(b * T_ + t) * 512 + h * 64 + lane] = (bf16)f2bf(gt * o);
            { const int j = lane; float a = pl[4 * j] + pl[4 * j + 1] + pl[4 * j + 2] + 0.5f * pl[4 * j + 3]; if (j > 0) a += 0.5f * pl[4 * j - 1]; imp += a; }
            asm volatile("s_waitcnt lgkmcnt(0)" ::: "memory");
        }
        const int cur = t >> 6; const int j = lane;
        u64 m64;
        if (cur <= 15) m64 = (cur == 63) ? ~0ull : ((1ull << (cur + 1)) - 1ull);
        else {
            float val = (j > cur) ? -INFINITY : ((j == 0 || j == cur || j == cur - 1) ? 1e4f : imp);
            m64 = 0ull;
            for (int r = 0; r < 16; ++r) {
                const float mx = wave_max(val);
                const u64 bal = __ballot(val == mx);
                const int w = __builtin_ctzll(bal);
                m64 |= 1ull << w; if (j == w) val = -INFINITY;
            }
        }
        if (lane == 0) sel[(size_t)bg * T_ + t] = m64;
    }
}

__device__ __forceinline__ void ph_win_attn(const Ctx& c, const bf16* qn, const bf16* kw, const bf16* vw, const float* gate, bf16* owin) {
    for (int it = c.gw; it < B_ * 8 * T_; it += c.ngw) {
        const int t = it % T_, bh = it / T_, b = bh >> 3, h = bh & 7, g = h >> 2;
        const int cur = t >> 6, jlo = (t - 511) > 0 ? (t - 511) >> 6 : 0;
        const u64 hi = (cur == 63) ? ~0ull : ((1ull << (cur + 1)) - 1ull); const u64 mask = hi & ~((1ull << jlo) - 1ull);
        const float o = naive_attn_row<64>(qn + ((size_t)bh * T_ + t) * 64, kw + (size_t)(b * 2 + g) * T_ * 64, vw + (size_t)(b * 2 + g) * T_ * 64, t, mask,
                                           alibi_slope(h + 1, 8) * LOG2E, nullptr, 512, c.lane);
        owin[(size_t)(b * T_ + t) * 512 + h * 64 + c.lane] = (bf16)f2bf(gate[(size_t)(b * T_ + t) * 24 + h * 3 + 2] * o);
    }
}
__device__ __forceinline__ void ph_slc_attn(const Ctx& c, const bf16* qn, const bf16* ks, const bf16* vs, const float* gate, const u64* sel, const bf16* ocmp, const bf16* owin, bf16* att) {
    for (int it = c.gw; it < B_ * 8 * T_; it += c.ngw) {
        const int t = it % T_, bh = it / T_, b = bh >> 3, h = bh & 7, g = h >> 2;
        const u64 mask = sel[(size_t)(b * 2 + g) * T_ + t];
        const float o = naive_attn_row<64>(qn + ((size_t)bh * T_ + t) * 64, ks + (size_t)(b * 2 + g) * T_ * 64, vs + (size_t)(b * 2 + g) * T_ * 64, t, mask,
                                           alibi_slope(h + 1, 8) * LOG2E, nullptr, 1 << 30, c.lane);
        const size_t n = (size_t)(b * T_ + t);
        const float r = gate[n * 24 + h * 3 + 1] * o + bf2f(ocmp[n * 512 + h * 64 + c.lane]) + bf2f(owin[n * 512 + h * 64 + c.lane]);
        att[n * 1024 + h * 64 + c.lane] = (bf16)f2bf(r);
    }
}
__device__ __forceinline__ void ph_fox_attn(const Ctx& c, const bf16* fq, const bf16* fk, const bf16* fv, const float* cum, bf16* att) {
    for (int it = c.gw; it < B_ * 4 * T_; it += c.ngw) {
        const int t = it % T_, bh = it / T_, b = bh >> 2, h = bh & 3;
        const int cur = t >> 6; const u64 mask = (cur == 63) ? ~0ull : ((1ull << (cur + 1)) - 1ull);
        const float o = naive_attn_row<64>(fq + ((size_t)bh * T_ + t) * 64, fk + (size_t)bh * T_ * 64, fv + (size_t)bh * T_ * 64, t, mask, 0.f, cum + (size_t)bh * T_, 1 << 30, c.lane);
        att[(size_t)(b * T_ + t) * 1024 + 512 + h * 64 + c.lane] = (bf16)f2bf(o);
    }
}
__device__ __forceinline__ void ph_diff_attn(const Ctx& c, const bf16* dq, const bf16* dk, const bf16* dv, const float* lam, const float* subln, float lambda_init, bf16* att) {
    float l1 = 0.f, l2 = 0.f;
    if (c.lane < 32) { l1 = lam[c.lane] * lam[32 + c.lane]; l2 = lam[64 + c.lane] * lam[96 + c.lane]; }
    const float lam_full = __expf(wave_sum(l1)) - __expf(wave_sum(l2)) + lambda_init;
    const float sg = subln[c.lane] * (1.f - lambda_init);
    for (int it = c.gw; it < B_ * 4 * T_; it += c.ngw) {
        const int t = it % T_, bh = it / T_, b = bh >> 2, h = bh & 3;
        const int cur = t >> 6; const u64 mask = (cur == 63) ? ~0ull : ((1ull << (cur + 1)) - 1ull);
        const float slope2 = alibi_slope(h + 1, 4) * LOG2E;
        const bf16* vb = dv + (size_t)bh * T_ * 64;
        const float o1 = naive_attn_row<32>(dq + ((size_t)(bh * 2 + 0) * T_ + t) * 32, dk + (size_t)(bh * 2 + 0) * T_ * 32, vb, t, mask, slope2, nullptr, 1 << 30, c.lane);
        const float o2 = naive_attn_row<32>(dq + ((size_t)(bh * 2 + 1) * T_ + t) * 32, dk + (size_t)(bh * 2 + 1) * T_ * 32, vb, t, mask, slope2, nullptr, 1 << 30, c.lane);
        const float o = o1 - lam_full * o2;
        const float r = rsqrtf(wave_sum(o * o) * (1.f / 64.f) + EPS);
        att[(size_t)(b * T_ + t) * 1024 + 768 + h * 64 + c.lane] = (bf16)f2bf(o * r * sg);
    }
}

__device__ __forceinline__ void ph_moe_route(const Ctx& c, const float* x, const float* g, const float* wgrp, const float* bgrp, const float* wexp, const float* bexp, bf16* hn, int* route_e, float* route_w, unsigned* cnt) {
    for (int row = c.gw; row < NT; row += c.ngw) {
        const f32x4* xr = (const f32x4*)(x + (size_t)row * D_) + c.lane;
        f32x4 v[4]; float ss = 0.f;
#pragma unroll
        for (int j = 0; j < 4; ++j) { v[j] = xr[64 * j]; ss += v[j].x * v[j].x + v[j].y * v[j].y + v[j].z * v[j].z + v[j].w * v[j].w; }
        const float r = rsqrtf(wave_sum(ss) * (1.f / D_) + EPS);
        u64* o8 = (u64*)(hn + (size_t)row * D_) + c.lane;
#pragma unroll
        for (int j = 0; j < 4; ++j) { const f32x4 gg = ((const f32x4*)g)[c.lane + 64 * j]; v[j] = v[j] * r * gg;
            o8[64 * j] = (u64)pk2(v[j].x, v[j].y) | ((u64)pk2(v[j].z, v[j].w) << 32); }
        float gl[4];
#pragma unroll
        for (int q = 0; q < 4; ++q) { float a = 0.f;
#pragma unroll
            for (int j = 0; j < 4; ++j) { const int k = 4 * (c.lane + 64 * j);
                a = fmaf(v[j].x, wgrp[(size_t)(k + 0) * 4 + q], a); a = fmaf(v[j].y, wgrp[(size_t)(k + 1) * 4 + q], a);
                a = fmaf(v[j].z, wgrp[(size_t)(k + 2) * 4 + q], a); a = fmaf(v[j].w, wgrp[(size_t)(k + 3) * 4 + q], a); }
            gl[q] = wave_sum(a) + bgrp[q]; }
        int grp = 0; float gm = gl[0];
#pragma unroll
        for (int q = 1; q < 4; ++q) if (gl[q] > gm) { gm = gl[q]; grp = q; }
        float gs = 0.f;
#pragma unroll
        for (int q = 0; q < 4; ++q) gs += __expf(gl[q] - gm);
        const float grp_gate = 1.f / gs;
        float el[8];
#pragma unroll
        for (int q = 0; q < 8; ++q) { float a = 0.f; const int col = grp * 8 + q;
#pragma unroll
            for (int j = 0; j < 4; ++j) { const int k = 4 * (c.lane + 64 * j);
                a = fmaf(v[j].x, wexp[(size_t)(k + 0) * 32 + col], a); a = fmaf(v[j].y, wexp[(size_t)(k + 1) * 32 + col], a);
                a = fmaf(v[j].z, wexp[(size_t)(k + 2) * 32 + col], a); a = fmaf(v[j].w, wexp[(size_t)(k + 3) * 32 + col], a); }
            el[q] = wave_sum(a) + bexp[col]; }
        int i0 = 0; float v0 = el[0];
#pragma unroll
        for (int q = 1; q < 8; ++q) if (el[q] > v0) { v0 = el[q]; i0 = q; }
        int i1 = -1; float v1 = -INFINITY;
#pragma unroll
        for (int q = 0; q < 8; ++q) if (q != i0 && el[q] > v1) { v1 = el[q]; i1 = q; }
        const float e1 = __expf(v1 - v0), den = 1.f + e1;
        if (c.lane == 0) { const float w0 = grp_gate / den, w1 = grp_gate * e1 / den;
            const int lo = i0 < i1 ? i0 : i1, hi = i0 < i1 ? i1 : i0, cls = grp * 28 + lo * 8 - (lo * (lo + 1)) / 2 + (hi - lo - 1);
            const unsigned rank = __hip_atomic_fetch_add(cnt + cls, 1u, __ATOMIC_RELAXED, __HIP_MEMORY_SCOPE_AGENT);
            route_e[row] = (int)(((unsigned)cls << 24) | rank); route_w[2 * row] = i0 < i1 ? w0 : w1; route_w[2 * row + 1] = i0 < i1 ? w1 : w0; }
    }
}
__device__ __forceinline__ void ph_moe_naive(const Ctx& c, const bf16* hn, const int* route_e, const float* route_w, const float* wg, const float* wu, const float* wd, float* x) {
    LAS float* hs = (LAS float*)c.lds;
    LAS float* au = hs + 1024;
    LAS float* h2 = au + 512;
    for (int row = c.bid; row < NT; row += c.G) {
        __syncthreads();
        hs[c.tid] = bf2f(hn[(size_t)row * D_ + c.tid]); hs[c.tid + 512] = bf2f(hn[(size_t)row * D_ + c.tid + 512]);
        float o0 = 0.f, o1 = 0.f;
        for (int s = 0; s < 2; ++s) {
            const int e = route_e[2 * row + s]; const float w = route_w[2 * row + s];
            __syncthreads();
            const float* W = (c.tid < 256 ? wg : wu) + (size_t)e * D_ * DEXP + (c.tid & 255);
            float a = 0.f;
            for (int k = 0; k < D_; ++k) a = fmaf(hs[k], W[(size_t)k * DEXP], a);
            au[c.tid] = a;
            __syncthreads();
            if (c.tid < 256) { const float ga = au[c.tid], up = au[c.tid + 256]; h2[c.tid] = ga / (1.f + __expf(-ga)) * up * w; }
            __syncthreads();
            const float* Wd = wd + (size_t)e * DEXP * D_;
            for (int k = 0; k < DEXP; ++k) { const float hv = h2[k]; o0 = fmaf(hv, Wd[(size_t)k * D_ + c.tid], o0); o1 = fmaf(hv, Wd[(size_t)k * D_ + c.tid + 512], o1); }
        }
        x[(size_t)row * D_ + c.tid] += o0; x[(size_t)row * D_ + c.tid + 512] += o1;
    }
    __syncthreads();
}

typedef __attribute__((address_space(4))) const Params* KP;
__device__ __forceinline__ KP uni_kp(KP p) { const unsigned long long v = (unsigned long long)p; const unsigned lo = __builtin_amdgcn_readfirstlane((unsigned)v), hi = __builtin_amdgcn_readfirstlane((unsigned)(v >> 32)); return (KP)(((unsigned long long)hi << 32) | lo); }
constexpr int PH_PER_LAYER = 11, N_PHASES = L_ * PH_PER_LAYER + 2;
__device__ __forceinline__ Ctx make_ctx(KP p) {
    Ctx c; c.lds = (LAS unsigned char*)lds_raw; { int t_ = threadIdx.x; asm volatile("" : "+v"(t_)); c.tid = t_; } c.lane = c.tid & 63; c.wave = __builtin_amdgcn_readfirstlane(c.tid >> 6);
    c.bid = blockIdx.x; c.G = gridDim.x; c.gw = c.bid * NWAVES + c.wave; c.ngw = c.G * NWAVES; c.in = nullptr; c.xcur = p->out; c.ws = p->ws;
    return c;
}
struct Bufs {
    bf16 *QN, *KV6, *KC, *VC, *KS, *VS, *KW, *VW, *FQ, *FK, *FV, *DQ, *DK, *DV, *HC, *KCMP, *VCMP, *OCMP, *OWIN, *HN, *ATT;
    float *GATE, *FL, *ROUTE_W; u64* SEL; int* ROUTE_E;
};
__device__ __forceinline__ Bufs make_bufs(unsigned char* ws) {
    Bufs b;
    b.QN = (bf16*)(ws + WS_QN); b.KV6 = (bf16*)(ws + WS_KV6);
    b.KC = (bf16*)(ws + WS_KV6 + 0 * KV6_STRIDE); b.VC = (bf16*)(ws + WS_KV6 + 1 * KV6_STRIDE);
    b.KS = (bf16*)(ws + WS_KV6 + 2 * KV6_STRIDE); b.VS = (bf16*)(ws + WS_KV6 + 3 * KV6_STRIDE);
    b.KW = (bf16*)(ws + WS_KV6 + 4 * KV6_STRIDE); b.VW = (bf16*)(ws + WS_KV6 + 5 * KV6_STRIDE);
    b.FQ = (bf16*)(ws + WS_FQKV); b.FK = b.FQ + 8 * MiB; b.FV = b.FQ + 16 * MiB;
    b.DQ = (bf16*)(ws + WS_DQK); b.DK = b.DQ + 8 * MiB; b.DV = (bf16*)(ws + WS_DV);
    b.GATE = (float*)(ws + WS_GATE); b.FL = (float*)(ws + WS_FL);
    b.HC = (bf16*)(ws + WS_HC); b.KCMP = (bf16*)(ws + WS_KVCMP); b.VCMP = b.KCMP + 16 * 256 * 64;
    b.SEL = (u64*)(ws + WS_SEL); b.OCMP = (bf16*)(ws + WS_OCMP); b.OWIN = (bf16*)(ws + WS_OWIN);
    b.HN = (bf16*)(ws + WS_HN); b.ATT = (bf16*)(ws + WS_ATT);
    b.ROUTE_E = (int*)(ws + WS_ROUTE); b.ROUTE_W = (float*)(ws + WS_ROUTE + 512 * 1024);
    return b;
}
__device__ __forceinline__ float lambda_init_of(int l) { return l == 0 ? 0.2f : 0.35550906759096926f; }

__device__ __noinline__ void P_prologue(KP p_) { const KP p = uni_kp(p_);
    const Ctx c = make_ctx(p); unsigned char* ws = p->ws;
    LAS float* scr = (LAS float*)(c.lds) + c.wave * (64 * 33);
    constexpr int I_A = 16 * 40, I_B = 16 * 24, I_C = 16 * 24, I_O = 16 * 32, I_G = 16 * 8, I_D = 4 * 32, I_E = 2 * I_G + I_D, I_W1 = 32 * 8, I_W2 = 4 * 2;
    constexpr int PER_L = I_A + I_B + I_C + I_O + 2 * (I_W1 + I_W2);
    for (int it = c.gw; it < L_ * PER_L; it += c.ngw) {
        const int l = it / PER_L; int r = it % PER_L;
        const float* W; bf16* WT; int ldw, K, sc0, ncol, r0 = 0, rmul = 1;
        if (r < I_A + I_B + I_C) { W = p->in[2] + (size_t)l * D_ * D_IN; WT = (bf16*)(ws + WS_WIN_T) + (size_t)l * NIN * D_; ldw = D_IN; K = D_;
            if (r < I_A) { sc0 = 0; ncol = 1280; r0 = 0; } else if (r < I_A + I_B) { r -= I_A; sc0 = C_FQ; ncol = 768; r0 = 1280; } else { r -= I_A + I_B; sc0 = C_DQ; ncol = 768; r0 = 2048; } }
        else if ((r -= I_A + I_B + I_C) < I_O) { W = p->in[13] + (size_t)l * D_ * D_; WT = (bf16*)(ws + WS_WOUT_T) + (size_t)l * D_ * D_; ldw = D_; K = D_; sc0 = 0; ncol = 1024; }
        else { r -= I_O; const int kv = r / (I_W1 + I_W2); r = r % (I_W1 + I_W2); const size_t lk = (size_t)l * 2 + kv;
            if (r < I_W1) { W = p->in[kv == 0 ? 6 : 9] + (size_t)l * 2048 * 256; WT = (bf16*)(ws + WS_W1_T) + lk * 256 * 2048; ldw = 256; K = 2048; sc0 = 0; ncol = 256; }
            else { r -= I_W1; W = p->in[kv == 0 ? 7 : 10] + (size_t)l * 256 * 64; WT = (bf16*)(ws + WS_W2_T) + lk * 64 * 256; ldw = 64; K = 256; sc0 = 0; ncol = 64; } }
        transpose_seg(W, ldw, K, sc0, ncol, WT, r0, rmul, r, scr, c.lane);
    }
    for (int i = c.bid * NTHREADS + c.tid; i < L_ * 256 * D_; i += c.G * NTHREADS) {
        const int l = i / (256 * D_), rr = (i / D_) % 256, k = i % D_;
        const float* win = p->in[2] + (size_t)l * D_ * D_IN;
        float v = 0.f; if (rr < 24) v = win[(size_t)k * D_IN + C_GATE + rr]; else if (rr < 28) v = win[(size_t)k * D_IN + C_FF + (rr - 24)];
        ((bf16*)(ws + WS_WIN_T))[((size_t)l * NIN + 2816 + rr) * D_ + k] = (bf16)f2bf(v);
    }
    for (int w = c.gw; w < L_ * 2 * 4 * 128; w += c.ngw) {
        const int lk = w >> 9, cg = (w >> 7) & 3, kc = w & 127, l = lk >> 1, kv = lk & 1, j = cg * 64 + c.lane;
        const float* pe = p->in[kv == 0 ? 5 : 8] + (size_t)l * 2048 + kc * 16; const float* w1 = p->in[kv == 0 ? 6 : 9] + (size_t)l * 2048 * 256 + (size_t)kc * 16 * 256;
        float a = 0.f;
#pragma unroll
        for (int k = 0; k < 16; ++k) a = fmaf(pe[k], w1[(size_t)k * 256 + j], a);
        ((float*)(ws + WS_B1PART))[((size_t)lk * 128 + kc) * 256 + j] = a;
    }
    for (int i = c.bid * NTHREADS + c.tid; i < L_ * 64 * 2 * 64; i += c.G * NTHREADS) {
        const int l = i / (64 * 2 * 64), ks = (i / 128) % 64, cb = (i / 64) & 1, lane = i & 63, col = 32 * cb + (lane & 31);
        unsigned hi[4], lo[4];
#pragma unroll
        for (int jp = 0; jp < 4; ++jp) { float v[2];
#pragma unroll
            for (int e = 0; e < 2; ++e) { const int k = 16 * ks + 8 * (lane >> 5) + 2 * jp + e; const float g = p->in[14][(size_t)l * D_ + k];
                v[e] = col < 4 ? g * p->in[15][((size_t)l * D_ + k) * 4 + col] : (col < 36 ? g * p->in[17][((size_t)l * D_ + k) * 32 + (col - 4)] : 0.f); }
            const unsigned h0 = f2bf(v[0]), h1 = f2bf(v[1]); hi[jp] = h0 | (h1 << 16);
            lo[jp] = f2bf(v[0] - __uint_as_float(h0 << 16)) | (f2bf(v[1] - __uint_as_float(h1 << 16)) << 16); }
        u32x4* dst = (u32x4*)(ws + WS_WR) + ((size_t)((l * 64 + ks) * 2 + cb) * 2) * 64 + lane;
        dst[0] = (u32x4){hi[0], hi[1], hi[2], hi[3]}; dst[64] = (u32x4){lo[0], lo[1], lo[2], lo[3]};
    }
}
__device__ __forceinline__ void P_inproj_mfma(int l_) { const KP p = (KP)__builtin_amdgcn_kernarg_segment_ptr(); int l = l_; asm volatile("" : "+s"(l));
    unsigned char* ws = p->ws; asm volatile("" : "+s"(ws));
    PlainOrder S; S.init(p->out, (const bf16*)(ws + WS_WIN_T) + (size_t)l * NIN * D_, D_, D_, NT, NIN, (int)gridDim.x, launder_s((int)blockIdx.x));
#ifdef STAGGER_TICKS
    { const unsigned long long t0 = __builtin_amdgcn_s_memrealtime(); const unsigned long long d = (unsigned long long)((launder_s((int)blockIdx.x) >> 3) & 3) * STAGGER_TICKS;
      while (__builtin_amdgcn_s_memrealtime() - t0 < d) __builtin_amdgcn_s_sleep(4); }
#endif
    const pg8::Gemm g{D_, D_, D_, D_ / 64, 0, 0};
    const EpiInProj E{ws, p->in[3] + l * 24, p->in[4] + l * 4, (unsigned*)(ws + WS_CTL) + CW_KN + l * 8192};
    pg8::gemm_phase<EpiInProj, PlainOrder, INPROJ_ALIGN, INPROJ_SP2>((LAS unsigned char*)lds_raw, g, S, E);
}
__device__ __forceinline__ void P_inproj_dummy(int l_) { const KP p = (KP)__builtin_amdgcn_kernarg_segment_ptr(); int l = l_; asm volatile("" : "+s"(l));
    unsigned char* ws = p->ws; asm volatile("" : "+s"(ws));
    PlainOrder S; S.init(p->out, (const bf16*)(ws + WS_WIN_T) + (size_t)l * NIN * D_, D_, D_, NT, NIN, (int)gridDim.x, launder_s((int)blockIdx.x));
    const pg8::Gemm g{D_, D_, D_, D_ / 64, 0, 0};
    const EpiDummy E{(float*)(ws + WS_HB)};
    pg8::gemm_phase<EpiDummy, PlainOrder, true, true>((LAS unsigned char*)lds_raw, g, S, E);
}
__device__ __forceinline__ void P_outproj_mfma(int l_) { const KP p = (KP)__builtin_amdgcn_kernarg_segment_ptr(); int l = l_; asm volatile("" : "+s"(l));
    unsigned char* ws = p->ws; asm volatile("" : "+s"(ws));
    PlainOrder S; S.init(ws + WS_ATT, (const bf16*)(ws + WS_WOUT_T) + (size_t)l * D_ * D_, D_, D_, NT, D_, (int)gridDim.x, launder_s((int)blockIdx.x));
    const pg8::Gemm g{D_, D_, D_, D_ / 64, 32, 8};
    const EpiResBf16 E{(bf16*)(ws + WS_HN)};
    pg8::gemm_phase<EpiResBf16, PlainOrder, true, true>((LAS unsigned char*)lds_raw, g, S, E);
}
__device__ __forceinline__ float wave_max_l(float v, int lane) {
#pragma unroll
    for (int o = 1; o < 64; o <<= 1) v = fmaxf(v, shflx_f(v, o, lane));
    return v;
}
__device__ __forceinline__ float wave_min_l(float v, int lane) {
#pragma unroll
    for (int o = 1; o < 64; o <<= 1) v = fminf(v, shflx_f(v, o, lane));
    return v;
}
template <int NS> __device__ __forceinline__ float q_norm2_max(const bf16x8v (&Q)[NS], int lane) {
    float ss = 0.f;
#pragma unroll
    for (int s = 0; s < NS; ++s)
#pragma unroll
        for (int e = 0; e < 8; ++e) { const float v = __uint_as_float(((unsigned)(unsigned short)Q[s][e]) << 16); ss = fmaf(v, v, ss); }
    return wave_max_l(swap_sum(ss), lane);
}
__device__ __forceinline__ u64 prune_consensus(bool skip, LAS u64* slots, int wave, int lane) {
    const u64 mine = __ballot(skip);
    __syncthreads();
    if (lane == 0) slots[wave] = mine;
    __syncthreads();
    u64 all = slots[0];
#pragma unroll
    for (int w = 1; w < NWAVES; ++w) all &= slots[w];
    return all;
}
__device__ __forceinline__ bool block_any(bool v, LAS u64* slots, int wave, int lane) {
#ifdef FORCE_FALLBACK
    v = true;
#endif
    const u64 mine = __ballot(v);
    __syncthreads();
    if (lane == 0) slots[wave] = mine;
    __syncthreads();
    u64 all = slots[0];
#pragma unroll
    for (int w = 1; w < NWAVES; ++w) all |= slots[w];
    return all != 0ull;
}
__device__ __forceinline__ bool sum_bad(float l) { return !(l < 1e30f); }
__device__ __forceinline__ void U_fox(KP p_, int bh_, int qb_, int l_) {
    const KP p = uni_kp(p_); const int bh = __builtin_amdgcn_readfirstlane(bh_), qb = __builtin_amdgcn_readfirstlane(qb_), l = __builtin_amdgcn_readfirstlane(l_);
    int tid_ = threadIdx.x; asm volatile("" : "+v"(tid_));
    const int tid = tid_, lane = tid & 63, wave = __builtin_amdgcn_readfirstlane(tid >> 6), r = lane & 31, h = lane >> 5;
    unsigned char* ws = p->ws; asm volatile("" : "+s"(ws)); LAS unsigned char* L = (LAS unsigned char*)lds_raw;
    const int tw0 = 256 * qb + 32 * wave, t_lane = tw0 + r, b = bh >> 2, hd = bh & 3;
    const bf16* q = (const bf16*)(ws + WS_FQKV) + (size_t)bh * T_ * 64 + (t_lane >> 4) * 1024 + (t_lane & 15) * 32 + 8 * h;
    bf16x8v Qf[1][4];
#pragma unroll
    for (int s = 0; s < 4; ++s) Qf[0][s] = *(const bf16x8v*)(q + (s >> 1) * 512 + (s & 1) * 16);
    const bf16* Kp = (const bf16*)(ws + WS_FQKV) + 8 * MiB + (size_t)bh * T_ * 64; const bf16* Vp = (const bf16*)(ws + WS_FQKV) + 16 * MiB + (size_t)bh * T_ * 64;
    u32x4 kpre, vpre; attn_preload<64>(Kp, nullptr, Vp, 4 * qb + 3, tid, kpre, vpre);
    LAS float* cum = (LAS float*)(L + A_LDS_END);
    { const float* fl = (const float*)(ws + WS_FL) + (size_t)bh * T_; LAS float* tot = cum + 4096;
      const int nval = 256 * (qb + 1); float v[8];
      if (8 * tid < nval) { const f32x4 a = *(const f32x4*)(fl + 8 * tid), c2 = *(const f32x4*)(fl + 8 * tid + 4); v[0] = a.x; v[1] = a.y; v[2] = a.z; v[3] = a.w; v[4] = c2.x; v[5] = c2.y; v[6] = c2.z; v[7] = c2.w; }
      else {
#pragma unroll
          for (int i = 0; i < 8; ++i) v[i] = 0.f; }
#pragma unroll
      for (int i = 1; i < 8; ++i) v[i] += v[i - 1];
      float sc = v[7];
#pragma unroll
      for (int o = 1; o < 64; o <<= 1) { const float up = __uint_as_float((unsigned)__builtin_amdgcn_ds_bpermute((lane - o) << 2, (int)__float_as_uint(sc))); if (lane >= o) sc += up; }
      if (lane == 63) tot[wave] = sc;
      __syncthreads();
      float base = sc - v[7];
      for (int w = 0; w < wave; ++w) base += tot[w];
      if (8 * tid < nval) {
#pragma unroll
          for (int i = 0; i < 8; ++i) cum[8 * tid + i] = v[i] + base; }
      __syncthreads(); }
    f32x16 O[1][2]; float M[1] = {0.f}, Ls[1] = {0.f};
#pragma unroll
    for (int i = 0; i < 16; ++i) { O[0][0][i] = 0.f; O[0][1][i] = 0.f; }
    const u64 tm = (qb == 15) ? ~0ull : ((1ull << (4 * qb + 4)) - 1ull);
#if AC2_MODE == 0
    {
        const u64 low = (1ull << (4 * qb)) - 1ull; const float cref = cum[tw0];
#define FOX_CORES(NM, FIRSTCALL) do { FIRSTCALL; \
        if (qb > 0) { \
            const float qn2 = q_norm2_max<4>(Qf[0], lane), mmin = wave_min_l(M[0], lane); \
            const float* kn = (const float*)((const unsigned*)(ws + WS_CTL) + CW_KN + l * 8192) + ((size_t)bh * 64 + lane) * 2; \
            bool skip = false; \
            if (lane < 4 * qb) { const float kn2 = kn[0] + kn[1]; const float bound = sqrtf(qn2 * kn2) * 1.02f + (cref - cum[64 * lane + 63]) * LOG2E - mmin; skip = bound < -152.f; } \
            const u64 drop = prune_consensus(skip, (LAS u64*)(cum + 4096 + 16), wave, lane); \
            const u64 tm2 = low & ~drop; \
            if (tm2) attn_core<64, 1, true, false, false, NM>(L, Kp, nullptr, Vp, cum, cref, Qf, tm2, t_lane, tw0, 1 << 30, 0.f, 0u, 0u, O, M, Ls, tid, true); \
        } } while (0)
        FOX_CORES(NOMAX_ON, (attn_core<64, 1, true, false, true, NOMAX_ON>(L, Kp, nullptr, Vp, cum, cref, Qf, tm & ~low, t_lane, tw0, 1 << 30, 0.f, 0u, 0u, O, M, Ls, tid, false, 4 * qb + 3, kpre, vpre)));
        if (NOMAX_ON && block_any(sum_bad(Ls[0]), (LAS u64*)(cum + 4096 + 32), wave, lane)) {
#pragma unroll
            for (int i = 0; i < 16; ++i) { O[0][0][i] = 0.f; O[0][1][i] = 0.f; }
            M[0] = 0.f; Ls[0] = 0.f;
            FOX_CORES(false, (attn_core<64, 1, true, false, false, false>(L, Kp, nullptr, Vp, cum, cref, Qf, tm & ~low, t_lane, tw0, 1 << 30, 0.f, 0u, 0u, O, M, Ls, tid)));
        }
#undef FOX_CORES
    }
#else
    attn_core2<true, false>(L, (const bf16*)(ws + WS_FQKV) + 8 * MiB + (size_t)bh * T_ * 64, (const bf16*)(ws + WS_FQKV) + 16 * MiB + (size_t)bh * T_ * 64, cum, cum[256 * qb],
                            Qf[0], tm, t_lane, tw0, 1 << 30, 0.f, 0u, 0u, O[0], M[0], Ls[0], tid);
#endif
    const float lt = swap_sum(Ls[0]), inv = lt > 0.f ? 1.f / lt : 0.f;
    bf16* dst = (bf16*)(ws + WS_ATT) + mix_off((size_t)b * T_ + t_lane, 512 + hd * 64 + 4 * h, 1024);
    ATTN_FOR_CHUNKS(db, g4) { const unsigned w0 = cvtpk(O[0][db][4 * g4 + 0] * inv, O[0][db][4 * g4 + 1] * inv), w1 = cvtpk(O[0][db][4 * g4 + 2] * inv, O[0][db][4 * g4 + 3] * inv);
        *(u64*)(dst + (4 * db + g4) * 256) = (u64)w0 | ((u64)w1 << 32); }
}
__device__ __forceinline__ void U_diff(KP p_, int bh_, int qb_, int l_) {
    const KP p = uni_kp(p_); const int bh = __builtin_amdgcn_readfirstlane(bh_), qb = __builtin_amdgcn_readfirstlane(qb_), l = __builtin_amdgcn_readfirstlane(l_);
    int tid_ = threadIdx.x; asm volatile("" : "+v"(tid_));
    const int tid = tid_, lane = tid & 63, wave = __builtin_amdgcn_readfirstlane(tid >> 6), r = lane & 31, h = lane >> 5;
    unsigned char* ws = p->ws; asm volatile("" : "+s"(ws)); LAS unsigned char* L = (LAS unsigned char*)lds_raw;
    const int tw0 = 256 * qb + 32 * wave, t_lane = tw0 + r, b = bh >> 2, hd = bh & 3;
    const bf16* DQ = (const bf16*)(ws + WS_DQK); const bf16* DK = DQ + 8 * MiB;
    bf16x8v Qf[2][2];
#pragma unroll
    for (int mp = 0; mp < 2; ++mp)
#pragma unroll
        for (int s = 0; s < 2; ++s) Qf[mp][s] = *(const bf16x8v*)(DQ + ((size_t)(bh * 2 + mp) * T_ + t_lane) * 32 + 16 * s + 8 * h);
    f32x16 O[2][2]; float M[2] = {0.f, 0.f}, Ls[2] = {0.f, 0.f};
#pragma unroll
    for (int i = 0; i < 16; ++i) { O[0][0][i] = 0.f; O[0][1][i] = 0.f; O[1][0][i] = 0.f; O[1][1][i] = 0.f; }
    const u64 tm = (qb == 15) ? ~0ull : ((1ull << (4 * qb + 4)) - 1ull);
    {
        const u64 low = (1ull << (4 * qb)) - 1ull; const float slope2 = alibi_slope(hd + 1, 4) * LOG2E;
        const bf16* K0 = DK + (size_t)(bh * 2 + 0) * T_ * 32; const bf16* K1 = DK + (size_t)(bh * 2 + 1) * T_ * 32; const bf16* Vp = (const bf16*)(ws + WS_DV) + (size_t)bh * T_ * 64;
#define DIFF_CORES(NM) do { \
        attn_core<32, 2, false, false, false, NM>(L, K0, K1, Vp, nullptr, 0.f, Qf, tm & ~low, t_lane, tw0, 1 << 30, slope2, 0u, 0u, O, M, Ls, tid); \
        if (qb > 0) { \
            const float qa = q_norm2_max<2>(Qf[0], lane), qb2 = q_norm2_max<2>(Qf[1], lane), ma = wave_min_l(M[0], lane), mb = wave_min_l(M[1], lane); \
            const float* kn = (const float*)((const unsigned*)(ws + WS_CTL) + CW_KN + l * 8192 + 4096) + (size_t)(bh * 2) * 64 + lane; \
            bool skip = false; \
            if (lane < 4 * qb) { const float bmax = slope2 * (float)(64 * lane + 63 - tw0);            \
                skip = (sqrtf(qa * kn[0]) * 1.02f + bmax - ma < -152.f) && (sqrtf(qb2 * kn[64]) * 1.02f + bmax - mb < -152.f); } \
            const u64 drop = prune_consensus(skip, (LAS u64*)(L + A_LDS_END), wave, lane); \
            const u64 tm2 = low & ~drop; \
            if (tm2) attn_core<32, 2, false, false, false, NM>(L, K0, K1, Vp, nullptr, 0.f, Qf, tm2, t_lane, tw0, 1 << 30, slope2, 0u, 0u, O, M, Ls, tid, true); \
        } } while (0)
        DIFF_CORES(NOMAX_ON);
        if (NOMAX_ON && block_any(sum_bad(Ls[0]) || sum_bad(Ls[1]), (LAS u64*)(L + A_LDS_END + 64), wave, lane)) {
#pragma unroll
            for (int i = 0; i < 16; ++i) { O[0][0][i] = 0.f; O[0][1][i] = 0.f; O[1][0][i] = 0.f; O[1][1][i] = 0.f; }
            M[0] = 0.f; M[1] = 0.f; Ls[0] = 0.f; Ls[1] = 0.f;
            DIFF_CORES(false);
        }
#undef DIFF_CORES
    }
    const float* lam = p->in[11] + (size_t)l * 128; const float* subln = p->in[12] + (size_t)l * 64;
    float l1 = 0.f, l2 = 0.f; if (lane < 32) { l1 = lam[lane] * lam[32 + lane]; l2 = lam[64 + lane] * lam[96 + lane]; }
    const float li = lambda_init_of(l), lam_full = __expf(wave_sum_l(l1, lane)) - __expf(wave_sum_l(l2, lane)) + li;
    const float lt0 = swap_sum(Ls[0]), lt1 = swap_sum(Ls[1]), i0 = lt0 > 0.f ? 1.f / lt0 : 0.f, i1 = (lt1 > 0.f ? 1.f / lt1 : 0.f) * lam_full;
    float ss = 0.f;
#pragma unroll
    for (int db = 0; db < 2; ++db)
#pragma unroll
        for (int i = 0; i < 16; ++i) { const float o = O[0][db][i] * i0 - O[1][db][i] * i1; O[0][db][i] = o; ss += o * o; }
    ss = swap_sum(ss);
    const float rn = rsqrtf(ss * (1.f / 64.f) + EPS) * (1.f - li);
    bf16* dst = (bf16*)(ws + WS_ATT) + mix_off((size_t)b * T_ + t_lane, 768 + hd * 64 + 4 * h, 1024);
    ATTN_FOR_CHUNKS(db, g4) { const f32x4 sg = *(const f32x4*)(subln + 32 * db + 8 * g4 + 4 * h);
        const unsigned w0 = cvtpk(O[0][db][4 * g4 + 0] * rn * sg.x, O[0][db][4 * g4 + 1] * rn * sg.y), w1 = cvtpk(O[0][db][4 * g4 + 2] * rn * sg.z, O[0][db][4 * g4 + 3] * rn * sg.w);
        *(u64*)(dst + (4 * db + g4) * 256) = (u64)w0 | ((u64)w1 << 32); }
}
__device__ __forceinline__ void U_win(KP p_, int bg_, int c_) {
    const KP p = uni_kp(p_); const int bg = __builtin_amdgcn_readfirstlane(bg_), cc = __builtin_amdgcn_readfirstlane(c_);
    int tid_ = threadIdx.x; asm volatile("" : "+v"(tid_));
    const int tid = tid_, lane = tid & 63, wave = __builtin_amdgcn_readfirstlane(tid >> 6), r = lane & 31, h = lane >> 5;
    unsigned char* ws = p->ws; asm volatile("" : "+s"(ws)); LAS unsigned char* L = (LAS unsigned char*)lds_raw;
    const int b = bg >> 1, g = bg & 1, hd = g * 4 + (wave >> 1), tw0 = 64 * cc + 32 * (wave & 1), t_lane = tw0 + r;
    const bf16* q = (const bf16*)(ws + WS_QN) + (size_t)(b * 8 + hd) * T_ * 64 + (t_lane >> 4) * 1024 + (t_lane & 15) * 32 + 8 * h;
    bf16x8v Qf[1][4];
#pragma unroll
    for (int s = 0; s < 4; ++s) Qf[0][s] = *(const bf16x8v*)(q + (s >> 1) * 512 + (s & 1) * 16);
    f32x16 O[1][2]; float M[1] = {0.f}, Ls[1] = {0.f};
#pragma unroll
    for (int i = 0; i < 16; ++i) { O[0][0][i] = 0.f; O[0][1][i] = 0.f; }
    const size_t n = (size_t)b * T_ + t_lane;
    const float gate_w = ((const float*)(ws + WS_GATE))[n * 24 + hd * 3 + 2];
    const int jlo = cc > 8 ? cc - 8 : 0;
    const u64 hi = (cc == 63) ? ~0ull : ((1ull << (cc + 1)) - 1ull), tm = hi & ~((1ull << jlo) - 1ull);
#if AC2_MODE == 0
    attn_core<64, 1, false, false, false, NOMAX_ON>(L, (const bf16*)(ws + WS_KV6 + 4 * KV6_STRIDE) + (size_t)bg * T_ * 64, nullptr, (const bf16*)(ws + WS_KV6 + 5 * KV6_STRIDE) + (size_t)bg * T_ * 64, nullptr, 0.f,
                                   Qf, tm, t_lane, tw0, 512, alibi_slope(hd + 1, 8) * LOG2E, 0u, 0u, O, M, Ls, tid);
    if (NOMAX_ON && block_any(sum_bad(Ls[0]), (LAS u64*)(L + A_LDS_END + 64), wave, lane)) {
#pragma unroll
        for (int i = 0; i < 16; ++i) { O[0][0][i] = 0.f; O[0][1][i] = 0.f; }
        M[0] = 0.f; Ls[0] = 0.f;
        attn_core<64, 1, false, false, false, false>(L, (const bf16*)(ws + WS_KV6 + 4 * KV6_STRIDE) + (size_t)bg * T_ * 64, nullptr, (const bf16*)(ws + WS_KV6 + 5 * KV6_STRIDE) + (size_t)bg * T_ * 64, nullptr, 0.f,
                                       Qf, tm, t_lane, tw0, 512, alibi_slope(hd + 1, 8) * LOG2E, 0u, 0u, O, M, Ls, tid);
    }
#ifdef PROBE_WINCORE2
    attn_core<64, 1, false, false>(L, (const bf16*)(ws + WS_KV6 + 4 * KV6_STRIDE) + (size_t)bg * T_ * 64, nullptr, (const bf16*)(ws + WS_KV6 + 5 * KV6_STRIDE) + (size_t)bg * T_ * 64, nullptr, 0.f,
                                   Qf, tm, t_lane, tw0, 512, alibi_slope(hd + 1, 8) * LOG2E, 0u, 0u, O, M, Ls, tid, true);
#endif
#else
    attn_core2<false, false>(L, (const bf16*)(ws + WS_KV6 + 4 * KV6_STRIDE) + (size_t)bg * T_ * 64, (const bf16*)(ws + WS_KV6 + 5 * KV6_STRIDE) + (size_t)bg * T_ * 64, nullptr, 0.f,
                             Qf[0], tm, t_lane, tw0, 512, alibi_slope(hd + 1, 8) * LOG2E, 0u, 0u, O[0], M[0], Ls[0], tid);
#endif
    const float lt = swap_sum(Ls[0]), inv = (lt > 0.f ? 1.f / lt : 0.f) * gate_w;
    bf16* dst = (bf16*)(ws + WS_OWIN) + mix_off(n, hd * 64 + 4 * h, 512);
    ATTN_FOR_CHUNKS(db, g4) { const unsigned w0 = cvtpk(O[0][db][4 * g4 + 0] * inv, O[0][db][4 * g4 + 1] * inv), w1 = cvtpk(O[0][db][4 * g4 + 2] * inv, O[0][db][4 * g4 + 3] * inv);
        *(u64*)(dst + (4 * db + g4) * 256) = (u64)w0 | ((u64)w1 << 32); }
}
__device__ __forceinline__ void U_slc(KP p_, int bg_, int c_) {
    const KP p = uni_kp(p_); const int bg = __builtin_amdgcn_readfirstlane(bg_), cc = __builtin_amdgcn_readfirstlane(c_);
    int tid_ = threadIdx.x; asm volatile("" : "+v"(tid_));
    const int tid = tid_, lane = tid & 63, wave = __builtin_amdgcn_readfirstlane(tid >> 6), r = lane & 31, h = lane >> 5;
    unsigned char* ws = p->ws; asm volatile("" : "+s"(ws)); LAS unsigned char* L = (LAS unsigned char*)lds_raw;
    const int b = bg >> 1, g = bg & 1, hd = g * 4 + (wave >> 1), tw0 = 64 * cc + 32 * (wave & 1), t_lane = tw0 + r;
    const bf16* q = (const bf16*)(ws + WS_QN) + (size_t)(b * 8 + hd) * T_ * 64 + (t_lane >> 4) * 1024 + (t_lane & 15) * 32 + 8 * h;
    bf16x8v Qf[1][4];
#pragma unroll
    for (int s = 0; s < 4; ++s) Qf[0][s] = *(const bf16x8v*)(q + (s >> 1) * 512 + (s & 1) * 16);
    f32x16 O[1][2]; float M[1] = {0.f}, Ls[1] = {0.f};
#pragma unroll
    for (int i = 0; i < 16; ++i) { O[0][0][i] = 0.f; O[0][1][i] = 0.f; }
    const bf16* Ksl = (const bf16*)(ws + WS_KV6 + 2 * KV6_STRIDE) + (size_t)bg * T_ * 64; const bf16* Vsl = (const bf16*)(ws + WS_KV6 + 3 * KV6_STRIDE) + (size_t)bg * T_ * 64;
    u32x4 kpre, vpre; attn_preload<64>(Ksl, nullptr, Vsl, cc, tid, kpre, vpre);
    const size_t n = (size_t)b * T_ + t_lane;
    const float gate_s = ((const float*)(ws + WS_GATE))[n * 24 + hd * 3 + 1];
    const bf16* oc = (const bf16*)(ws + WS_OCMP) + mix_off(n, hd * 64 + 4 * h, 512); const bf16* ow = (const bf16*)(ws + WS_OWIN) + mix_off(n, hd * 64 + 4 * h, 512);
    u64 ocv[8], owv[8];
    ATTN_FOR_CHUNKS(db, g4) { ocv[4 * db + g4] = *(const u64*)(oc + (4 * db + g4) * 256); owv[4 * db + g4] = *(const u64*)(ow + (4 * db + g4) * 256); }
    const u64* sel = (const u64*)(ws + WS_SEL) + (size_t)bg * T_;
    const u64 mine = sel[t_lane]; u64 un = sel[64 * cc + lane];
    { unsigned ul = (unsigned)un, uh = (unsigned)(un >> 32);
#pragma unroll
      for (int o = 1; o < 64; o <<= 1) { ul |= shflx_u(ul, o, lane); uh |= shflx_u(uh, o, lane); }
      un = ((u64)__builtin_amdgcn_readfirstlane(uh) << 32) | __builtin_amdgcn_readfirstlane(ul); }
#if AC2_MODE == 0
    attn_core<64, 1, false, true, true, NOMAX_ON>(L, Ksl, nullptr, Vsl, nullptr, 0.f,
                                  Qf, un, t_lane, tw0, 1 << 30, alibi_slope(hd + 1, 8) * LOG2E, (unsigned)mine, (unsigned)(mine >> 32), O, M, Ls, tid, false, cc, kpre, vpre);
    if (NOMAX_ON && block_any(sum_bad(Ls[0]), (LAS u64*)(L + A_LDS_END + 64), wave, lane)) {
#pragma unroll
        for (int i = 0; i < 16; ++i) { O[0][0][i] = 0.f; O[0][1][i] = 0.f; }
        M[0] = 0.f; Ls[0] = 0.f;
        attn_core<64, 1, false, true, false, false>(L, Ksl, nullptr, Vsl, nullptr, 0.f, Qf, un, t_lane, tw0, 1 << 30, alibi_slope(hd + 1, 8) * LOG2E, (unsigned)mine, (unsigned)(mine >> 32), O, M, Ls, tid);
    }
#else
    attn_core2<false, true>(L, (const bf16*)(ws + WS_KV6 + 2 * KV6_STRIDE) + (size_t)bg * T_ * 64, (const bf16*)(ws + WS_KV6 + 3 * KV6_STRIDE) + (size_t)bg * T_ * 64, nullptr, 0.f,
                            Qf[0], un, t_lane, tw0, 1 << 30, alibi_slope(hd + 1, 8) * LOG2E, (unsigned)mine, (unsigned)(mine >> 32), O[0], M[0], Ls[0], tid);
#endif
    const float lt = swap_sum(Ls[0]), inv = (lt > 0.f ? 1.f / lt : 0.f) * gate_s;
    bf16* dst = (bf16*)(ws + WS_ATT) + mix_off(n, hd * 64 + 4 * h, 1024);
    ATTN_FOR_CHUNKS(db, g4) { const u64 a = ocv[4 * db + g4], w = owv[4 * db + g4];
        const float x0 = O[0][db][4 * g4 + 0] * inv + __uint_as_float((unsigned)a << 16) + __uint_as_float((unsigned)w << 16);
        const float x1 = O[0][db][4 * g4 + 1] * inv + __uint_as_float((unsigned)a & 0xffff0000u) + __uint_as_float((unsigned)w & 0xffff0000u);
        const float x2 = O[0][db][4 * g4 + 2] * inv + __uint_as_float((unsigned)(a >> 32) << 16) + __uint_as_float((unsigned)(w >> 32) << 16);
        const float x3 = O[0][db][4 * g4 + 3] * inv + __uint_as_float((unsigned)(a >> 32) & 0xffff0000u) + __uint_as_float((unsigned)(w >> 32) & 0xffff0000u);
        *(u64*)(dst + (4 * db + g4) * 256) = (u64)cvtpk(x0, x1) | ((u64)cvtpk(x2, x3) << 32); }
}
__device__ __forceinline__ float other_half(float x, int h) { auto rr = __builtin_amdgcn_permlane32_swap(__float_as_uint(x), __float_as_uint(x), false, false); return __uint_as_float(h ? rr[0] : rr[1]); }
__device__ __forceinline__ int other_half_i(int x, int h) { auto rr = __builtin_amdgcn_permlane32_swap((unsigned)x, (unsigned)x, false, false); return (int)(h ? rr[0] : rr[1]); }
template <bool MASK>
__device__ __forceinline__ void cmp_scores(f32x16& p0, f32x16& p1, const LAS unsigned char* kt, const bf16x8v (&Qf)[4], float b0, float s1, int cl, int nvis_l) {
    const float s8 = s1 * 8.f, s32 = s1 * 32.f;
    p0[0] = b0; p0[1] = p0[0] + s1; p0[2] = p0[1] + s1; p0[3] = p0[2] + s1;
#pragma unroll
    for (int reg = 4; reg < 16; ++reg) p0[reg] = p0[reg - 4] + s8;
#pragma unroll
    for (int reg = 0; reg < 16; ++reg) p1[reg] = p0[reg] + s32;
#pragma unroll
    for (int s = 0; s < 4; ++s) { const bf16x8v kf0 = *(const LAS bf16x8v*)(kt + s * 32), kf1 = *(const LAS bf16x8v*)(kt + 32 * 144 + s * 32);
        p0 = __builtin_amdgcn_mfma_f32_32x32x16_bf16(kf0, Qf[s], p0, 0, 0, 0); p1 = __builtin_amdgcn_mfma_f32_32x32x16_bf16(kf1, Qf[s], p1, 0, 0, 0); }
    if (MASK) {
#pragma unroll
        for (int reg = 0; reg < 16; ++reg) { const int c = cl + crow0(reg); p0[reg] = (c < nvis_l) ? p0[reg] : -INFINITY; p1[reg] = (c + 32 < nvis_l) ? p1[reg] : -INFINITY; } }
}
__device__ __forceinline__ void U_cmp(KP p_, int bg_, int u_) {
    const KP p = uni_kp(p_); const int bg = __builtin_amdgcn_readfirstlane(bg_), uu = __builtin_amdgcn_readfirstlane(u_);
    int tid_ = threadIdx.x; asm volatile("" : "+v"(tid_));
    const int tid = tid_, lane = tid & 63, wave = __builtin_amdgcn_readfirstlane(tid >> 6), r = lane & 31, h = lane >> 5;
    unsigned char* ws = p->ws; asm volatile("" : "+s"(ws)); LAS unsigned char* L = (LAS unsigned char*)lds_raw;
    const int b = bg >> 1, g = bg & 1, tw0 = 32 * (uu + 16 * (wave < 4 ? wave : 11 - wave)), t_lane = tw0 + r;
    { const bf16* kc = (const bf16*)(ws + WS_KVCMP) + (size_t)bg * 256 * 64; const bf16* vc = kc + 16 * 256 * 64;
#pragma unroll
      for (int i = 0; i < 4; ++i) { const int ch = tid + 512 * i, row = ch >> 3, c8 = ch & 7;
          *(LAS u32x4*)(L + row * 144 + c8 * 16) = *(const u32x4*)(kc + row * 64 + c8 * 8); *(LAS u32x4*)(L + 36864 + row * 144 + c8 * 16) = *(const u32x4*)(vc + row * 64 + c8 * 8); } }
    __syncthreads();
    const int nvis_l = t_lane >= 31 ? ((t_lane - 31) >> 4) + 1 : 0, nvis_max = (tw0 >> 4) + 1, nvis_min = tw0 >= 31 ? ((tw0 - 31) >> 4) + 1 : 0, ntile = (nvis_max + 63) >> 6;
    const LAS unsigned char* kfrag = L + r * 144 + h * 16;
    const LAS unsigned char* vfrag = L + 36864 + (4 * h + ((lane & 15) >> 2)) * 144 + (16 * ((lane >> 4) & 1) + 4 * (lane & 3)) * 2;
    float imp[32];
#pragma unroll
    for (int e = 0; e < 32; ++e) imp[e] = 0.f;
    const float* gate = (const float*)(ws + WS_GATE) + ((size_t)b * T_ + t_lane) * 24;
#pragma unroll 1
    for (int hg = 0; hg < 4; ++hg) {
        const int hd = g * 4 + hg; const float s1 = alibi_slope(hd + 1, 8) * LOG2E * 16.f;
        const bf16* q = (const bf16*)(ws + WS_QN) + (size_t)(b * 8 + hd) * T_ * 64 + (t_lane >> 4) * 1024 + (t_lane & 15) * 32 + 8 * h;
        bf16x8v Qf[4];
#pragma unroll
        for (int s = 0; s < 4; ++s) Qf[s] = *(const bf16x8v*)(q + (s >> 1) * 512 + (s & 1) * 16);
        f32x16 O0, O1;
#pragma unroll
        for (int i = 0; i < 16; ++i) { O0[i] = 0.f; O1[i] = 0.f; }
        float oscale = 0.f; bool bad;
        {
        float lsum = 0.f, carry = 0.f; float ih[32];
#pragma unroll
        for (int e = 0; e < 32; ++e) ih[e] = 0.f;
#pragma unroll
        for (int jt = 0; jt < 4; ++jt) if (jt < ntile) {
            f32x16 p0, p1; const float b0 = s1 * (float)(64 * jt + 4 * h - nvis_max);
            if (64 * jt + 63 >= nvis_min) cmp_scores<true>(p0, p1, kfrag + jt * (64 * 144), Qf, b0, s1, 64 * jt + 4 * h, nvis_l);
            else cmp_scores<false>(p0, p1, kfrag + jt * (64 * 144), Qf, b0, s1, 64 * jt + 4 * h, nvis_l);
            float rs = 0.f;
#pragma unroll
            for (int reg = 0; reg < 16; ++reg) { p0[reg] = __builtin_amdgcn_exp2f(p0[reg]); p1[reg] = __builtin_amdgcn_exp2f(p1[reg]); rs += p0[reg] + p1[reg]; }
            lsum += rs;
            float cv[8];
#pragma unroll
            for (int g4 = 0; g4 < 4; ++g4) { const float h0 = 0.5f * p0[4 * g4 + 3], h1 = 0.5f * p1[4 * g4 + 3];
                ih[jt * 8 + g4] += ((p0[4 * g4] + p0[4 * g4 + 1]) + p0[4 * g4 + 2]) + h0; ih[jt * 8 + 4 + g4] += ((p1[4 * g4] + p1[4 * g4 + 1]) + p1[4 * g4 + 2]) + h1;
                cv[g4] = h0; cv[4 + g4] = h1; }
            float prev = carry;
#pragma unroll
            for (int k = 0; k < 8; ++k) { const float sv = other_half(cv[k], h); ih[jt * 8 + k] += h ? sv : prev; prev = sv; }
            carry = prev;
            const bf16x8v pa0 = pack8(p0, 0), pa1 = pack8(p0, 8), pa2 = pack8(p1, 0), pa3 = pack8(p1, 8);
            const LAS unsigned char* vb = vfrag + jt * (64 * 144);
#pragma unroll
            for (int ks = 0; ks < 4; ++ks) { const bf16x8v pa = ks == 0 ? pa0 : ks == 1 ? pa1 : ks == 2 ? pa2 : pa3;
                { const s16x4 lo = tr_read(vb + ks * (16 * 144)), hi = tr_read(vb + ks * (16 * 144) + 8 * 144); const bf16x8v vf = {lo[0], lo[1], lo[2], lo[3], hi[0], hi[1], hi[2], hi[3]};
                  O0 = __builtin_amdgcn_mfma_f32_32x32x16_bf16(vf, pa, O0, 0, 0, 0); }
                { const s16x4 lo = tr_read(vb + ks * (16 * 144) + 64), hi = tr_read(vb + ks * (16 * 144) + 64 + 8 * 144); const bf16x8v vf = {lo[0], lo[1], lo[2], lo[3], hi[0], hi[1], hi[2], hi[3]};
                  O1 = __builtin_amdgcn_mfma_f32_32x32x16_bf16(vf, pa, O1, 0, 0, 0); } }
        }
#ifdef FORCE_FALLBACK
        bad = true;
#else
        bad = __any(sum_bad(lsum));
#endif
        if (!bad) { const float lt = swap_sum(lsum), inv = lt > 0.f ? 1.f / lt : 0.f; oscale = inv;
#pragma unroll
            for (int e = 0; e < 32; ++e) imp[e] = fmaf(ih[e], inv, imp[e]); }
        }
        if (bad) {
        float m, lsum;
#pragma unroll
        for (int i = 0; i < 16; ++i) { O0[i] = 0.f; O1[i] = 0.f; }
        m = -1e30f; lsum = 0.f;
#pragma unroll 1
        for (int jt = 0; jt < ntile; ++jt) {
            f32x16 p0, p1; const float b0 = s1 * (float)(64 * jt + 4 * h - nvis_max);
            if (64 * jt + 63 >= nvis_min) cmp_scores<true>(p0, p1, kfrag + jt * (64 * 144), Qf, b0, s1, 64 * jt + 4 * h, nvis_l);
            else cmp_scores<false>(p0, p1, kfrag + jt * (64 * 144), Qf, b0, s1, 64 * jt + 4 * h, nvis_l);
            float mt = fmaxf(p0[0], p1[0]);
#pragma unroll
            for (int reg = 1; reg < 16; ++reg) mt = fmaxf(mt, fmaxf(p0[reg], p1[reg]));
            mt = swap_max(mt);
            const float mn = fmaxf(m, mt); float rs = 0.f;
#pragma unroll
            for (int reg = 0; reg < 16; ++reg) rs += __builtin_amdgcn_exp2f(p0[reg] - mn) + __builtin_amdgcn_exp2f(p1[reg] - mn);
            lsum = lsum * __builtin_amdgcn_exp2f(m - mn) + rs; m = mn;
        }
        const float lt = swap_sum(lsum), cnorm = lt > 0.f ? m + __builtin_amdgcn_logf(lt) : 1e30f;
        float carry = 0.f;
#pragma unroll
        for (int jt = 0; jt < 4; ++jt) if (jt < ntile) {
            f32x16 p0, p1; const float b0 = s1 * (float)(64 * jt + 4 * h - nvis_max) - cnorm;
            if (64 * jt + 63 >= nvis_min) cmp_scores<true>(p0, p1, kfrag + jt * (64 * 144), Qf, b0, s1, 64 * jt + 4 * h, nvis_l);
            else cmp_scores<false>(p0, p1, kfrag + jt * (64 * 144), Qf, b0, s1, 64 * jt + 4 * h, nvis_l);
#pragma unroll
            for (int reg = 0; reg < 16; ++reg) { p0[reg] = __builtin_amdgcn_exp2f(p0[reg]); p1[reg] = __builtin_amdgcn_exp2f(p1[reg]); }
            float cv[8];
#pragma unroll
            for (int g4 = 0; g4 < 4; ++g4) { const float h0 = 0.5f * p0[4 * g4 + 3], h1 = 0.5f * p1[4 * g4 + 3];
                imp[jt * 8 + g4] += ((p0[4 * g4] + p0[4 * g4 + 1]) + p0[4 * g4 + 2]) + h0; imp[jt * 8 + 4 + g4] += ((p1[4 * g4] + p1[4 * g4 + 1]) + p1[4 * g4 + 2]) + h1;
                cv[g4] = h0; cv[4 + g4] = h1; }
            float prev = carry;
#pragma unroll
            for (int k = 0; k < 8; ++k) { const float sv = other_half(cv[k], h); imp[jt * 8 + k] += h ? sv : prev; prev = sv; }
            carry = prev;
            const bf16x8v pa0 = pack8(p0, 0), pa1 = pack8(p0, 8), pa2 = pack8(p1, 0), pa3 = pack8(p1, 8);
            const LAS unsigned char* vb = vfrag + jt * (64 * 144);
#pragma unroll
            for (int ks = 0; ks < 4; ++ks) { const bf16x8v pa = ks == 0 ? pa0 : ks == 1 ? pa1 : ks == 2 ? pa2 : pa3;
                { const s16x4 lo = tr_read(vb + ks * (16 * 144)), hi = tr_read(vb + ks * (16 * 144) + 8 * 144); const bf16x8v vf = {lo[0], lo[1], lo[2], lo[3], hi[0], hi[1], hi[2], hi[3]};
                  O0 = __builtin_amdgcn_mfma_f32_32x32x16_bf16(vf, pa, O0, 0, 0, 0); }
                { const s16x4 lo = tr_read(vb + ks * (16 * 144) + 64), hi = tr_read(vb + ks * (16 * 144) + 64 + 8 * 144); const bf16x8v vf = {lo[0], lo[1], lo[2], lo[3], hi[0], hi[1], hi[2], hi[3]};
                  O1 = __builtin_amdgcn_mfma_f32_32x32x16_bf16(vf, pa, O1, 0, 0, 0); } }
        }
        oscale = 1.f;
        }
        const float gt = gate[hd * 3 + 0] * oscale;
        bf16* dst = (bf16*)(ws + WS_OCMP) + mix_off((size_t)b * T_ + t_lane, hd * 64 + 4 * h, 512);
#pragma unroll
        for (int g4 = 0; g4 < 4; ++g4) {
            *(u64*)(dst + g4 * 256) = (u64)cvtpk(O0[4 * g4 + 0] * gt, O0[4 * g4 + 1] * gt) | ((u64)cvtpk(O0[4 * g4 + 2] * gt, O0[4 * g4 + 3] * gt) << 32);
            *(u64*)(dst + (4 + g4) * 256) = (u64)cvtpk(O1[4 * g4 + 0] * gt, O1[4 * g4 + 1] * gt) | ((u64)cvtpk(O1[4 * g4 + 2] * gt, O1[4 * g4 + 3] * gt) << 32); }
    }
    const int cur = tw0 >> 6; u64 mask;
    if (cur <= 15) mask = (1ull << (cur + 1)) - 1ull;
    else {
        mask = 1ull | (1ull << cur) | (1ull << (cur - 1));
#pragma unroll
        for (int e = 0; e < 32; ++e) { const int j = 2 * e + h; if (j > cur || j == 0 || j >= cur - 1) imp[e] = -INFINITY; }
#pragma unroll 1
        for (int round = 0; round < 13; ++round) {
            float bv = imp[0]; int be = 0;
#pragma unroll
            for (int e = 1; e < 32; ++e) if (imp[e] > bv) { bv = imp[e]; be = e; }
            const int bj = 2 * be + h; const float ov = other_half(bv, h); const int oj = other_half_i(bj, h);
            const bool mine = bv > ov || (bv == ov && bj < oj);
            mask |= 1ull << (mine ? bj : oj);
#pragma unroll
            for (int e = 0; e < 32; ++e) imp[e] = (mine && e == be) ? -INFINITY : imp[e];
        }
    }
    if (h == 0) ((u64*)(ws + WS_SEL))[(size_t)bg * T_ + t_lane] = mask;
    __syncthreads();
}
constexpr int CONV_UNITS = L_ * NEXP * (2 * 16 * 8 + 4 * 32) / 32;
__device__ __forceinline__ void U_conv(KP p_, int k_) {
    const KP p = uni_kp(p_); const int k = __builtin_amdgcn_readfirstlane(k_);
    int tid_ = threadIdx.x; asm volatile("" : "+v"(tid_));
    const int tid = tid_, lane = tid & 63, wave = __builtin_amdgcn_readfirstlane(tid >> 6);
    unsigned char* ws = p->ws; asm volatile("" : "+s"(ws));
    LAS float* scr = (LAS float*)lds_raw + wave * (64 * 33);
    constexpr int I_G = 16 * 8, I_D = 4 * 32, I_E = 2 * I_G + I_D;
#pragma unroll 1
    for (int i = 0; i < 4; ++i) {
        const int m = k * 32 + i * 8 + wave, l = m / (NEXP * I_E); int r = m % (NEXP * I_E); const int e = r / I_E; r = r % I_E; const size_t le = (size_t)l * NEXP + e;
        const float* W; bf16* WT; int ldw, K, ncol, r0 = 0, rmul = 1; const float* gk = nullptr;
        if (r < 2 * I_G) { const int up = r >= I_G; r -= up * I_G; W = p->in[19 + up] + le * D_ * DEXP; WT = (bf16*)(ws + WS_WGU_T) + le * 512 * D_; ldw = DEXP; K = D_; ncol = 256; r0 = up; rmul = 2; gk = p->in[14] + (size_t)l * D_; }
        else { r -= 2 * I_G; W = p->in[21] + le * DEXP * D_; WT = (bf16*)(ws + WS_WD_T) + le * D_ * DEXP; ldw = D_; K = DEXP; ncol = 1024; }
        transpose_seg(W, ldw, K, 0, ncol, WT, r0, rmul, r, scr, lane, gk);
    }
}
__device__ __forceinline__ int fetch_unit(KP p, int qidx) {
    volatile LAS unsigned* slot = (volatile LAS unsigned*)((LAS unsigned char*)lds_raw + MISC_OFF) + 16;
    __syncthreads();
    int t0_ = threadIdx.x; asm volatile("" : "+v"(t0_));
    if (t0_ == 0) *slot = __hip_atomic_fetch_add((unsigned*)(p->ws + WS_CTL) + CW_QUEUE + 64 * qidx, 1u, __ATOMIC_RELAXED, __HIP_MEMORY_SCOPE_AGENT);
    __syncthreads();
    return (int)__builtin_amdgcn_readfirstlane(*slot);
}
__device__ __forceinline__ void P_cmp1_mfma(int l_) { const KP p = (KP)__builtin_amdgcn_kernarg_segment_ptr(); int l = l_; asm volatile("" : "+s"(l));
    unsigned char* ws = p->ws; asm volatile("" : "+s"(ws)); const int c = launder_s((int)blockIdx.x), kv = c >> 4, pm = c & 15;
    OneUnitOrder S; S.has = c < 32; S.u.pm = pm; S.u.pn = kv;
    S.u.a = (const char*)(ws + WS_KV6 + (size_t)kv * KV6_STRIDE) + (size_t)pm * 256 * 1024 * 2; S.u.b = (const char*)((const bf16*)(ws + WS_W1_T) + ((size_t)l * 2 + kv) * 256 * 2048); S.u.b2 = S.u.b;
    const pg8::Gemm g{1024, 2048, 2048, 32, 0, 0};
    const EpiCmpH E{(bf16*)(ws + WS_HC), (const float*)(ws + WS_BIAS1) + l * 512};
    pg8::gemm_phase<EpiCmpH, OneUnitOrder, false, true>((LAS unsigned char*)lds_raw, g, S, E);
}
__device__ __forceinline__ void P_cmp2_mfma(int l_) { const KP p = (KP)__builtin_amdgcn_kernarg_segment_ptr(); int l = l_; asm volatile("" : "+s"(l));
    unsigned char* ws = p->ws; asm volatile("" : "+s"(ws)); const int c = launder_s((int)blockIdx.x), kv = c >> 4, pm = c & 15;
    OneUnitOrder S; S.has = c < 32; S.u.pm = pm; S.u.pn = kv;
    S.u.a = (const char*)((const bf16*)(ws + WS_HC) + ((size_t)kv * 4096 + pm * 256) * 256); S.u.b = (const char*)((const bf16*)(ws + WS_W2_T) + ((size_t)l * 2 + kv) * 64 * 256); S.u.b2 = S.u.b;
    const pg8::Gemm g{256, 256, 256, 4, 0, 0};
    const EpiCmpOut E{(bf16*)(ws + WS_KVCMP)};
    pg8::gemm_phase<EpiCmpOut, OneUnitOrder, false, true>((LAS unsigned char*)lds_raw, g, S, E);
}
__device__ __forceinline__ void P_moe_scatter(KP p_, int l_) { const KP p = uni_kp(p_); const int l = __builtin_amdgcn_readfirstlane(l_); const Ctx c = make_ctx(p); unsigned char* ws = p->ws;
    const unsigned* cnt = (const unsigned*)(ws + WS_CTL) + CW_MOECNT + l * MOE_LS;
    moe_build_tables(cnt, c.tid);
    const LAS int* T = (const LAS int*)((LAS unsigned char*)lds_raw + TBL_OFF);
    const unsigned* info = (const unsigned*)(ws + WS_ROUTE + RT_INFO); const float* tw = (const float*)(ws + WS_ROUTE + RT_W);
    int* rowtok = (int*)(ws + WS_ROUTE + RT_ROWTOK); float* roww = (float*)(ws + WS_ROUTE + RT_ROWW);
    bf16* xs = (bf16*)(ws + WS_XS); const bf16* x = (const bf16*)(ws + WS_HN); const float* gain = p->in[14] + (size_t)l * D_; const float* rstdv = (const float*)(ws + WS_ROUTE + RT_RSTD);
    { constexpr int RB = 4; float gg[2][8];
#pragma unroll
      for (int j = 0; j < 2; ++j) { const f32x4 a = ((const f32x4*)gain)[2 * c.lane + 128 * j], b2 = ((const f32x4*)gain)[2 * c.lane + 128 * j + 1]; gg[j][0] = a.x; gg[j][1] = a.y; gg[j][2] = a.z; gg[j][3] = a.w; gg[j][4] = b2.x; gg[j][5] = b2.y; gg[j][6] = b2.z; gg[j][7] = b2.w; }
      for (int row0 = c.gw * RB; row0 < NT; row0 += c.ngw * RB) {
        u32x4 vv[RB][2];
#pragma unroll
        for (int q = 0; q < RB; ++q)
#pragma unroll
            for (int j = 0; j < 2; ++j) vv[q][j] = ((const u32x4*)(x + (size_t)(row0 + q) * D_))[c.lane + 64 * j];
#pragma unroll
        for (int q = 0; q < RB; ++q) { const int row = row0 + q;
            const unsigned v = info[row]; const int cls = (int)(v >> 24), rank = (int)(v & 0xffffffu); const size_t dest = (size_t)T[cls] * 256 + rank; const float r = rstdv[row];
#pragma unroll
            for (int j = 0; j < 2; ++j) { float f[8]; unpack8(vv[q][j], f); u32x4 o; o.x = pk2(f[0] * r * gg[j][0], f[1] * r * gg[j][1]); o.y = pk2(f[2] * r * gg[j][2], f[3] * r * gg[j][3]); o.z = pk2(f[4] * r * gg[j][4], f[5] * r * gg[j][5]); o.w = pk2(f[6] * r * gg[j][6], f[7] * r * gg[j][7]);
                ((u32x4*)(xs + dest * D_))[c.lane + 64 * j] = o; }
            if (c.lane == 0) { rowtok[dest] = row; roww[2 * dest] = tw[2 * row]; roww[2 * dest + 1] = tw[2 * row + 1]; } }
      } }
    for (int cls = c.bid; cls < 112; cls += c.G) { const int n = (int)cnt[cls * MOE_CS], end = (int)((cnt[cls * MOE_CS] + 255u) >> 8) * 256; const size_t base = (size_t)T[cls] * 256;
        for (int r = n + c.tid; r < end; r += NTHREADS) rowtok[base + r] = -1; }
}
__device__ __forceinline__ int xcd_major(int bid, int G) { bid = launder_s(bid); return (G & 7) ? bid : (bid & 7) * (G >> 3) + (bid >> 3); }
__device__ __forceinline__ void P_moe_g1(int l_) { const KP p = (KP)__builtin_amdgcn_kernarg_segment_ptr(); int l = l_; asm volatile("" : "+s"(l));
    unsigned char* ws = p->ws; asm volatile("" : "+s"(ws));
    { int t0_ = threadIdx.x; asm volatile("" : "+v"(t0_)); moe_build_tables((const unsigned*)(ws + WS_CTL) + CW_MOECNT + l * MOE_LS, t0_); }
    const MoeOrder1 S{(const char*)ws, (const unsigned*)(ws + WS_REC), (const char*)((const bf16*)(ws + WS_WGU_T) + (size_t)l * NEXP * 512 * D_), (unsigned*)(ws + WS_CTL) + CW_MOECNT + l * MOE_LS + (112 + NEXP) * MOE_CS, (int)gridDim.x, xcd_major((int)blockIdx.x, (int)gridDim.x)};
    const pg8::Gemm g{D_, D_, D_, D_ / 64, 0, 0};
    const EpiMoeH E{(bf16*)(ws + WS_HB), (const u32x4*)(ws + WS_REC)};
    pg8::gemm_phase<EpiMoeH, MoeOrder1, true, true, true>((LAS unsigned char*)lds_raw, g, S, E);
}
__device__ __forceinline__ void P_moe_g2(int l_) { const KP p = (KP)__builtin_amdgcn_kernarg_segment_ptr(); int l = l_; asm volatile("" : "+s"(l));
    unsigned char* ws = p->ws; asm volatile("" : "+s"(ws));
    { int t0_ = threadIdx.x; asm volatile("" : "+v"(t0_)); moe_build_tables((const unsigned*)(ws + WS_CTL) + CW_MOECNT + l * MOE_LS, t0_); }
    const MoeOrder2 S{(const char*)(ws + WS_HB), (const char*)((const bf16*)(ws + WS_WD_T) + (size_t)l * NEXP * D_ * DEXP), (const unsigned*)(ws + WS_CTL) + CW_MOECNT + l * MOE_LS + (112 + NEXP) * MOE_CS, (unsigned*)(ws + WS_CTL) + XB_TMO + 4096, (int)gridDim.x, xcd_major((int)blockIdx.x, (int)gridDim.x)};
    const pg8::Gemm g{512, DEXP, 512, 4, 16, 16};
    const EpiMoeOut E{(bf16*)(ws + WS_HN), (const unsigned*)(ws + WS_RECC)};
    pg8::gemm_phase<EpiMoeOut, MoeOrder2, true, true>((LAS unsigned char*)lds_raw, g, S, E);
}
__device__ __forceinline__ void P_bias1(KP p_) { const KP p = uni_kp(p_); int t_ = threadIdx.x; asm volatile("" : "+v"(t_));
    const int i = launder_s((int)blockIdx.x) * NTHREADS + t_; if (i < L_ * 2 * 256) { const float* part = (const float*)(p->ws + WS_B1PART) + (size_t)(i >> 8) * 128 * 256 + (i & 255); float a = 0.f;
        for (int k = 0; k < 128; ++k) a += part[(size_t)k * 256]; ((float*)(p->ws + WS_BIAS1))[i] = a; } }
__device__ __forceinline__ void P_norm1(KP p_, int l_) { const KP p = uni_kp(p_); const int l = __builtin_amdgcn_readfirstlane(l_); const Ctx c = make_ctx(p); const Bufs b = make_bufs(p->ws);
    if (l == 0) ph_norm_bf16(c, p->in[0], p->in[1], (bf16*)p->out, (bf16*)(p->ws + WS_HN)); else ph_norm_bf16_from_bf16(c, (const bf16*)(p->ws + WS_HN), p->in[1] + (size_t)l * D_, (bf16*)p->out); }
__device__ __noinline__ void P_inproj(KP p_, int l_) { const KP p = uni_kp(p_); const int l = __builtin_amdgcn_readfirstlane(l_); const Ctx c = make_ctx(p); const Bufs b = make_bufs(p->ws);
    InProjOut o{b.QN, b.KV6, b.FQ, b.DQ, b.DV, b.GATE, b.FL, p->in[3] + l * 24, p->in[4] + l * 4};
    const bf16* A = b.HN;
    naive_gemm(c, NT, D_IN, D_, [=](int r, int k) { return bf2f(A[(size_t)r * D_ + k]); }, p->in[2] + (size_t)l * D_ * D_IN, D_IN,
               [=](int r, int col, float v) { inproj_store(o, r, col, v); }); }
__device__ __noinline__ void P_cmp1(KP p_, int l_, int kv_) { const KP p = uni_kp(p_); const int l = __builtin_amdgcn_readfirstlane(l_), kv = __builtin_amdgcn_readfirstlane(kv_); const Ctx c = make_ctx(p); const Bufs b = make_bufs(p->ws);
    const bf16* src = kv == 0 ? b.KC : b.VC; const float* pe = p->in[kv == 0 ? 5 : 8] + (size_t)l * 2048; bf16* hc = b.HC + (size_t)kv * 4096 * 256;
    naive_gemm(c, 4096, 256, 2048, [=](int r, int k) { return bf2f(src[(size_t)r * 1024 + k]) + pe[k]; }, p->in[kv == 0 ? 6 : 9] + (size_t)l * 2048 * 256, 256,
               [=](int r, int col, float v) { hc[(size_t)r * 256 + col] = (bf16)f2bf(gelu_tanh(v)); }); }
__device__ __noinline__ void P_cumsum(KP p_, int l_) { const KP p = uni_kp(p_); const int l = __builtin_amdgcn_readfirstlane(l_); const Ctx c = make_ctx(p); const Bufs b = make_bufs(p->ws); ph_cumsum(c, b.FL); }
__device__ __noinline__ void P_cmp2(KP p_, int l_, int kv_) { const KP p = uni_kp(p_); const int l = __builtin_amdgcn_readfirstlane(l_), kv = __builtin_amdgcn_readfirstlane(kv_); const Ctx c = make_ctx(p); const Bufs b = make_bufs(p->ws);
    const bf16* hc = b.HC + (size_t)kv * 4096 * 256; bf16* dst = kv == 0 ? b.KCMP : b.VCMP;
    naive_gemm(c, 4096, 64, 256, [=](int r, int k) { return bf2f(hc[(size_t)r * 256 + k]); }, p->in[kv == 0 ? 7 : 10] + (size_t)l * 256 * 64, 64,
               [=](int r, int col, float v) { dst[(size_t)r * 64 + col] = (bf16)f2bf((r & 255) == 255 ? 0.f : v); }); }
__device__ __noinline__ void P_win(KP p_, int l_) { const KP p = uni_kp(p_); const int l = __builtin_amdgcn_readfirstlane(l_); const Ctx c = make_ctx(p); const Bufs b = make_bufs(p->ws); ph_win_attn(c, b.QN, b.KW, b.VW, b.GATE, b.OWIN); }
__device__ __noinline__ void P_fox(KP p_, int l_) { const KP p = uni_kp(p_); const int l = __builtin_amdgcn_readfirstlane(l_); const Ctx c = make_ctx(p); const Bufs b = make_bufs(p->ws); ph_fox_attn(c, b.FQ, b.FK, b.FV, b.FL, b.ATT); }
__device__ __noinline__ void P_diff(KP p_, int l_) { const KP p = uni_kp(p_); const int l = __builtin_amdgcn_readfirstlane(l_); const Ctx c = make_ctx(p); const Bufs b = make_bufs(p->ws);
    ph_diff_attn(c, b.DQ, b.DK, b.DV, p->in[11] + (size_t)l * 128, p->in[12] + (size_t)l * 64, lambda_init_of(l), b.ATT); }
__device__ __noinline__ void P_cmpattn(KP p_, int l_) { const KP p = uni_kp(p_); const int l = __builtin_amdgcn_readfirstlane(l_); const Ctx c = make_ctx(p); const Bufs b = make_bufs(p->ws); ph_cmp_attn(c, b.QN, b.KCMP, b.VCMP, b.GATE, b.SEL, b.OCMP); }
__device__ __noinline__ void P_slc(KP p_, int l_) { const KP p = uni_kp(p_); const int l = __builtin_amdgcn_readfirstlane(l_); const Ctx c = make_ctx(p); const Bufs b = make_bufs(p->ws); ph_slc_attn(c, b.QN, b.KS, b.VS, b.GATE, b.SEL, b.OCMP, b.OWIN, b.ATT); }
__device__ __noinline__ void P_outproj(KP p_, int l_) { const KP p = uni_kp(p_); const int l = __builtin_amdgcn_readfirstlane(l_); const Ctx c = make_ctx(p); const Bufs b = make_bufs(p->ws);
    const bf16* A = b.ATT; float* xo = p->out; const float* xin = (l == 0) ? p->in[0] : p->out;
    naive_gemm(c, NT, D_, D_, [=](int r, int k) { return bf2f(A[(size_t)r * D_ + k]); }, p->in[13] + (size_t)l * D_ * D_, D_,
               [=](int r, int col, float v) { xo[(size_t)r * D_ + col] = xin[(size_t)r * D_ + col] + v; }); }
__device__ __forceinline__ void P_route3(int l_, int cbank) { const KP p = (KP)__builtin_amdgcn_kernarg_segment_ptr(); int l = l_; asm volatile("" : "+s"(l));
    int tid_ = threadIdx.x; asm volatile("" : "+v"(tid_));
    const int tid = tid_, lane = tid & 63, wave = __builtin_amdgcn_readfirstlane(tid >> 6), r = lane & 31, h = lane >> 5, kh = wave >> 2, wr = wave & 3;
    unsigned char* ws = p->ws; asm volatile("" : "+s"(ws)); const bf16* x = (const bf16*)(ws + WS_HN);
    const float* WR = (const float*)(ws + WS_WR) + (size_t)l * D_ * 64;
    LAS float* XT = (LAS float*)lds_raw + wave * (32 * 36);
    LAS float* WT = (LAS float*)lds_raw + 8 * 32 * 36 + kh * (2 * 32 * 64);
    LAS float* PL = (LAS float*)lds_raw + 8 * 32 * 36 + 2 * 2 * 32 * 64;
    LAS float* SS = PL + 2 * 128 * 40;
    const float* bgrp = p->in[16] + l * 4; const float* bexp = p->in[18] + l * 32;
    unsigned* cnt = (unsigned*)(ws + WS_CTL) + CW_MOECNT + l * MOE_LS + cbank;
    LAS unsigned* HIST = (LAS unsigned*)(SS + 2 * 128 * 2);
    for (int grp = launder_s((int)blockIdx.x); grp < NT / 128; grp += (int)gridDim.x) {
        const int row0 = grp * 128 + wr * 32;
        if (tid < 144) HIST[tid] = 0u;
        f32x16 acc0, acc1; float ss = 0.f;
#pragma unroll
        for (int i = 0; i < 16; ++i) { acc0[i] = 0.f; acc1[i] = 0.f; }
        { const u32x4* xsrc = (const u32x4*)(x + (size_t)(row0 + r) * D_ + kh * 512 + 8 * h);
          const u32x4* wsrc = (const u32x4*)(ws + WS_WR) + ((size_t)l * 64 + kh * 32) * 256 + lane;
#pragma unroll 4
          for (int ks = 0; ks < 32; ++ks) {
              const u32x4 av = xsrc[2 * ks], b0h = wsrc[ks * 256], b0l = wsrc[ks * 256 + 64], b1h = wsrc[ks * 256 + 128], b1l = wsrc[ks * 256 + 192];
              { float f_[8]; unpack8(av, f_);
#pragma unroll
                for (int e = 0; e < 8; ++e) ss = fmaf(f_[e], f_[e], ss); }
              const bf16x8v A = __builtin_bit_cast(bf16x8v, av);
              acc0 = __builtin_amdgcn_mfma_f32_32x32x16_bf16(A, __builtin_bit_cast(bf16x8v, b0h), acc0, 0, 0, 0); acc1 = __builtin_amdgcn_mfma_f32_32x32x16_bf16(A, __builtin_bit_cast(bf16x8v, b1h), acc1, 0, 0, 0);
              acc0 = __builtin_amdgcn_mfma_f32_32x32x16_bf16(A, __builtin_bit_cast(bf16x8v, b0l), acc0, 0, 0, 0); acc1 = __builtin_amdgcn_mfma_f32_32x32x16_bf16(A, __builtin_bit_cast(bf16x8v, b1l), acc1, 0, 0, 0);
          } }
#pragma unroll
        for (int reg = 0; reg < 16; ++reg) { const int row = wr * 32 + crow0(reg) + 4 * h; PL[(kh * 128 + row) * 40 + r] = acc0[reg]; if (r < 4) PL[(kh * 128 + row) * 40 + 32 + r] = acc1[reg]; }
        SS[(kh * 128 + wr * 32 + r) * 2 + h] = ss;
        __syncthreads();
        int cls = 0, ea = 0, eb = 0; unsigned lrank = 0u, lra = 0u, lrb = 0u; float wlo = 0.f, whi = 0.f, rstd = 0.f;
        if (tid < 128) {
            float lg[36];
#pragma unroll
            for (int cidx = 0; cidx < 36; ++cidx) lg[cidx] = PL[tid * 40 + cidx] + PL[(128 + tid) * 40 + cidx];
            const float sq = (SS[tid * 2] + SS[tid * 2 + 1]) + (SS[(128 + tid) * 2] + SS[(128 + tid) * 2 + 1]);
            rstd = rsqrtf(sq * (1.f / D_) + EPS);
            float gl[4]; int grp_i = 0;
#pragma unroll
            for (int q = 0; q < 4; ++q) gl[q] = lg[q] * rstd + bgrp[q];
            float gm = gl[0];
#pragma unroll
            for (int q = 1; q < 4; ++q) if (gl[q] > gm) { gm = gl[q]; grp_i = q; }
            float gs = 0.f;
#pragma unroll
            for (int q = 0; q < 4; ++q) gs += __expf(gl[q] - gm);
            const float grp_gate = 1.f / gs;
            float el[8];
#pragma unroll
            for (int q = 0; q < 8; ++q) { float v = lg[4 + q]; float bb = bexp[q];
                if (grp_i == 1) { v = lg[12 + q]; bb = bexp[8 + q]; } else if (grp_i == 2) { v = lg[20 + q]; bb = bexp[16 + q]; } else if (grp_i == 3) { v = lg[28 + q]; bb = bexp[24 + q]; }
                el[q] = v * rstd + bb; }
            int i0 = 0; float v0 = el[0];
#pragma unroll
            for (int q = 1; q < 8; ++q) if (el[q] > v0) { v0 = el[q]; i0 = q; }
            int i1 = -1; float v1 = -INFINITY;
#pragma unroll
            for (int q = 0; q < 8; ++q) if (q != i0 && el[q] > v1) { v1 = el[q]; i1 = q; }
            const float e1 = __expf(v1 - v0), den = 1.f + e1, w0 = grp_gate / den, w1 = grp_gate * e1 / den;
            const int lo = i0 < i1 ? i0 : i1, hi = i0 < i1 ? i1 : i0; cls = grp_i * 28 + lo * 8 - (lo * (lo + 1)) / 2 + (hi - lo - 1);
            wlo = i0 < i1 ? w0 : w1; whi = i0 < i1 ? w1 : w0;
            ea = grp_i * 8 + lo; eb = grp_i * 8 + hi;
            lrank = __hip_atomic_fetch_add(HIST + cls, 1u, __ATOMIC_RELAXED, __HIP_MEMORY_SCOPE_WORKGROUP);
            lra = __hip_atomic_fetch_add(HIST + 112 + ea, 1u, __ATOMIC_RELAXED, __HIP_MEMORY_SCOPE_WORKGROUP); lrb = __hip_atomic_fetch_add(HIST + 112 + eb, 1u, __ATOMIC_RELAXED, __HIP_MEMORY_SCOPE_WORKGROUP);
        }
        __syncthreads();
        if (tid < 144) { const unsigned n = HIST[tid]; if (n) HIST[144 + tid] = __hip_atomic_fetch_add(cnt + tid * MOE_CS, n, __ATOMIC_RELAXED, __HIP_MEMORY_SCOPE_AGENT); }
        __syncthreads();
        if (tid < 128) {
            const unsigned rank = HIST[144 + cls] + lrank, ra = HIST[144 + 112 + ea] + lra, rb = HIST[144 + 112 + eb] + lrb;
            const int row = grp * 128 + tid;
            ((unsigned*)(ws + WS_RECC))[(size_t)cls * 32768 + rank] = (unsigned)row;
            const unsigned info = ((unsigned)cls << 16) | rank;
            ((u32x4*)(ws + WS_REC))[(size_t)ea * 32768 + ra] = (u32x4){(unsigned)row, __float_as_uint(wlo), __float_as_uint(rstd), info};
            ((u32x4*)(ws + WS_REC))[(size_t)eb * 32768 + rb] = (u32x4){(unsigned)row, __float_as_uint(whi), __float_as_uint(rstd), info | 0x8000u};
        }
        __syncthreads();
    }
}
typedef float f32x8 __attribute__((ext_vector_type(8)));
__device__ __forceinline__ void P_route2(int l_, int cbank) { const KP p = (KP)__builtin_amdgcn_kernarg_segment_ptr(); int l = l_; asm volatile("" : "+s"(l));
    int tid_ = threadIdx.x; asm volatile("" : "+v"(tid_));
    const int tid = tid_, lane = tid & 63, wave = __builtin_amdgcn_readfirstlane(tid >> 6);
    unsigned char* ws = p->ws; asm volatile("" : "+s"(ws)); const float* x = p->out;
    const float* WR = (const float*)(ws + WS_WR) + (size_t)l * D_ * 40;
    LAS float* xt = (LAS float*)lds_raw + wave * (64 * 36);
    LAS float* part = (LAS float*)lds_raw;
    const float* bgrp = p->in[16] + l * 4; const float* bexp = p->in[18] + l * 32;
    unsigned* cnt = (unsigned*)(ws + WS_CTL) + CW_MOECNT + l * 128 + cbank;
    for (int grp = launder_s((int)blockIdx.x); grp < NT / 128; grp += (int)gridDim.x) {
        const int row0 = grp * 128 + (wave >> 2) * 64, kq = wave & 3;
        float acc[40]; float ss = 0.f;
#pragma unroll
        for (int cidx = 0; cidx < 40; ++cidx) acc[cidx] = 0.f;
#pragma unroll 1
        for (int kc = 0; kc < 8; ++kc) {
            const int k0 = kq * 256 + kc * 32;
#pragma unroll
            for (int i = 0; i < 8; ++i) { const int row = i * 8 + (lane >> 3), c4 = (lane & 7) * 4; *(LAS f32x4*)(xt + row * 36 + c4) = *(const f32x4*)(x + (size_t)(row0 + row) * D_ + k0 + c4); }
            float xr[32];
#pragma unroll
            for (int j = 0; j < 8; ++j) { const f32x4 t = *(const LAS f32x4*)(xt + lane * 36 + 4 * j); xr[4 * j] = t.x; xr[4 * j + 1] = t.y; xr[4 * j + 2] = t.z; xr[4 * j + 3] = t.w; }
            const float* wk = WR + (size_t)k0 * 40;
#pragma unroll
            for (int kk = 0; kk < 32; ++kk) {
                f32x8 w0, w1, w2, w3, w4;
                asm volatile("s_load_dwordx8 %0, %5, %6\n\ts_load_dwordx8 %1, %5, %7\n\ts_load_dwordx8 %2, %5, %8\n\ts_load_dwordx8 %3, %5, %9\n\ts_load_dwordx8 %4, %5, %10\n\ts_waitcnt lgkmcnt(0)"
                             : "=&s"(w0), "=&s"(w1), "=&s"(w2), "=&s"(w3), "=&s"(w4) : "s"(wk), "i"(kk * 160), "i"(kk * 160 + 32), "i"(kk * 160 + 64), "i"(kk * 160 + 96), "i"(kk * 160 + 128) : "memory");
                const float xv = xr[kk]; ss = fmaf(xv, xv, ss);
#pragma unroll
                for (int e = 0; e < 8; ++e) { acc[e] = fmaf(xv, w0[e], acc[e]); acc[8 + e] = fmaf(xv, w1[e], acc[8 + e]); acc[16 + e] = fmaf(xv, w2[e], acc[16 + e]); acc[24 + e] = fmaf(xv, w3[e], acc[24 + e]); }
#pragma unroll
                for (int e = 0; e < 4; ++e) acc[32 + e] = fmaf(xv, w4[e], acc[32 + e]);
            }
        }
        __syncthreads();
#pragma unroll
        for (int cidx = 0; cidx < 36; ++cidx) part[(wave * 64 + lane) * 37 + cidx] = acc[cidx];
        part[(wave * 64 + lane) * 37 + 36] = ss;
        __syncthreads();
        if (tid < 128) {
            const int rg = tid >> 6, rr = tid & 63; float lg[37];
#pragma unroll
            for (int cidx = 0; cidx < 37; ++cidx) lg[cidx] = ((part[((rg * 4 + 0) * 64 + rr) * 37 + cidx] + part[((rg * 4 + 1) * 64 + rr) * 37 + cidx]) + part[((rg * 4 + 2) * 64 + rr) * 37 + cidx]) + part[((rg * 4 + 3) * 64 + rr) * 37 + cidx];
            const float rstd = rsqrtf(lg[36] * (1.f / D_) + EPS);
            float gl[4]; int grp_i = 0;
#pragma unroll
            for (int q = 0; q < 4; ++q) gl[q] = lg[q] * rstd + bgrp[q];
            float gm = gl[0];
#pragma unroll
            for (int q = 1; q < 4; ++q) if (gl[q] > gm) { gm = gl[q]; grp_i = q; }
            float gs = 0.f;
#pragma unroll
            for (int q = 0; q < 4; ++q) gs += __expf(gl[q] - gm);
            const float grp_gate = 1.f / gs;
            float el[8];
#pragma unroll
            for (int q = 0; q < 8; ++q) { float v = lg[4 + q]; float bb = bexp[q];
                if (grp_i == 1) { v = lg[12 + q]; bb = bexp[8 + q]; } else if (grp_i == 2) { v = lg[20 + q]; bb = bexp[16 + q]; } else if (grp_i == 3) { v = lg[28 + q]; bb = bexp[24 + q]; }
                el[q] = v * rstd + bb; }
            int i0 = 0; float v0 = el[0];
#pragma unroll
            for (int q = 1; q < 8; ++q) if (el[q] > v0) { v0 = el[q]; i0 = q; }
            int i1 = -1; float v1 = -INFINITY;
#pragma unroll
            for (int q = 0; q < 8; ++q) if (q != i0 && el[q] > v1) { v1 = el[q]; i1 = q; }
            const float e1 = __expf(v1 - v0), den = 1.f + e1, w0 = grp_gate / den, w1 = grp_gate * e1 / den;
            const int lo = i0 < i1 ? i0 : i1, hi = i0 < i1 ? i1 : i0, cls = grp_i * 28 + lo * 8 - (lo * (lo + 1)) / 2 + (hi - lo - 1);
            const unsigned rank = __hip_atomic_fetch_add(cnt + cls, 1u, __ATOMIC_RELAXED, __HIP_MEMORY_SCOPE_AGENT);
            const int row = grp * 128 + tid;
            ((unsigned*)(ws + WS_ROUTE + RT_INFO))[row] = ((unsigned)cls << 24) | rank;
            ((float*)(ws + WS_ROUTE + RT_W))[2 * row] = i0 < i1 ? w0 : w1; ((float*)(ws + WS_ROUTE + RT_W))[2 * row + 1] = i0 < i1 ? w1 : w0;
            ((float*)(ws + WS_ROUTE + RT_RSTD))[row] = rstd;
        }
        __syncthreads();
    }
}
__device__ __noinline__ void P_route(KP p_, int l_) { const KP p = uni_kp(p_); const int l = __builtin_amdgcn_readfirstlane(l_); const Ctx c = make_ctx(p); const Bufs b = make_bufs(p->ws);
    ph_moe_route(c, p->out, p->in[14] + (size_t)l * D_, p->in[15] + (size_t)l * D_ * 4, p->in[16] + l * 4, p->in[17] + (size_t)l * D_ * 32, p->in[18] + l * 32, b.HN, (int*)(p->ws + WS_ROUTE + RT_INFO), (float*)(p->ws + WS_ROUTE + RT_W), (unsigned*)(p->ws + WS_CTL) + CW_MOECNT + l * 128); }
__device__ __noinline__ void P_moe(KP p_, int l_) { const KP p = uni_kp(p_); const int l = __builtin_amdgcn_readfirstlane(l_); const Ctx c = make_ctx(p); const Bufs b = make_bufs(p->ws);
    ph_moe_naive(c, b.HN, b.ROUTE_E, b.ROUTE_W, p->in[19] + (size_t)l * NEXP * D_ * DEXP, p->in[20] + (size_t)l * NEXP * D_ * DEXP, p->in[21] + (size_t)l * NEXP * DEXP * D_, p->out); }
__device__ __noinline__ void P_final(KP p_) { const KP p = uni_kp(p_); const Ctx c = make_ctx(p); ph_norm_final_from_bf16(c, (const bf16*)(p->ws + WS_HN), p->in[22], p->out); }
__device__ __forceinline__ void P_gridbar(KP p_) { const KP p = uni_kp(p_);
    XcdBarrier bar; bar.bar = (unsigned*)(p->ws + WS_CTL) + 4096; bar.x = xb_xcc_id(); bar.st = (volatile LAS unsigned*)((LAS unsigned char*)lds_raw + MISC_OFF) + 8;
    xcd_barrier(bar);
}

__global__ void __launch_bounds__(NTHREADS, 2) fwd_kernel(Params pp) {
    const KP p = (KP)__builtin_amdgcn_kernarg_segment_ptr();
    { volatile LAS unsigned* MISC = (volatile LAS unsigned*)((LAS unsigned char*)lds_raw + MISC_OFF); if (threadIdx.x < 32) MISC[threadIdx.x] = 0u; }
    __syncthreads();
    const int lo = p->ph_lo, hi = p->ph_hi;
    if (hi - lo > 1) (void)xcd_barrier_post((unsigned*)(p->ws + WS_CTL) + 4096, (volatile LAS unsigned*)((LAS unsigned char*)lds_raw + MISC_OFF) + 8);
#define IN(k) (lo <= (k) && (k) < hi)
#define SEAM(k) do { if (IN(k) && IN((k) + 1)) P_gridbar(p); } while (0)
    if (IN(0)) { for (int rep = 0; rep < REP_PRO; ++rep) { if (rep) P_gridbar(p); P_prologue(p); } }
    for (int l = 0; l < L_; ++l) {
        const int P0 = 1 + l * PH_PER_LAYER;
        if (IN(P0 + 0)) { for (int rep = 0; rep < REP_NORM; ++rep) { if (rep) P_gridbar(p); P_norm1(p, l); } }
        SEAM(P0 + 0);
        if (IN(P0 + 1)) { if (l == 0) P_bias1(p);
            for (int rep = 0; rep < REP_INPROJ; ++rep) { if (rep) P_gridbar(p); P_inproj_mfma(l); }
#ifdef REP_INDUMMY
            for (int rep = 0; rep < REP_INDUMMY; ++rep) { P_gridbar(p); P_inproj_dummy(l); }
#endif
        }
        SEAM(P0 + 1);
        if (IN(P0 + 3)) {
            P_cmp1_mfma(l);
            if (launder_s((int)blockIdx.x) < 32) { asm volatile("s_waitcnt vmcnt(0)" ::: "memory"); __builtin_amdgcn_fence(__ATOMIC_SEQ_CST, "agent"); asm volatile("s_waitcnt vmcnt(0)" ::: "memory"); }
            __syncthreads();
            P_cmp2_mfma(l);
            for (int rep = 0; rep < REP_ATT3; ++rep) { if (rep) P_gridbar(p);
            for (;;) { int u = fetch_unit(p, l * 8 + 0 + 16 * rep);
                if (l == 0) {
                    if (u >= 2048 + CONV_UNITS) break;
                    const int k11 = u / 11, r11 = u - 11 * k11;
                    if (r11 == 3 || r11 == 7 || r11 == 10) { U_conv(p, 3 * k11 + (r11 > 3) + (r11 > 7)); continue; }
                    u = 8 * k11 + r11 - (r11 > 3) - (r11 > 7); }
                else if (u >= 2048) break;
                if (u < 1024) { const int qb = 15 - (u >> 6), k = u & 63; if (k < 32) U_diff(p, k, qb, l); else U_fox(p, k - 32, qb, l); }
                else { const int w = u - 1024; U_win(p, w & 15, 63 - (w >> 4));
#ifdef PROBE_WINUNIT2
                    U_win(p, w & 15, 63 - (w >> 4));
#endif
                } } } }
        SEAM(P0 + 3);
        if (IN(P0 + 4)) { for (int rep = 0; rep < REP_CMP; ++rep) { if (rep) P_gridbar(p); for (int u = launder_s((int)blockIdx.x); u < 256; u += (int)gridDim.x) U_cmp(p, u & 15, u >> 4); } }
        SEAM(P0 + 4);
        if (IN(P0 + 5)) { for (int rep = 0; rep < REP_SLC; ++rep) { if (rep) P_gridbar(p); for (;;) { const int u = fetch_unit(p, l * 8 + 1 + 16 * rep); if (u >= 1024) break; U_slc(p, u & 15, 63 - (u >> 4)); } } }
        SEAM(P0 + 5);
        if (IN(P0 + 6)) P_outproj_mfma(l);
        SEAM(P0 + 6);
        if (IN(P0 + 7)) { for (int rep = 0; rep < REP_ROUTE; ++rep) { if (rep) P_gridbar(p); P_route3(l, REP_ROUTE - 1 - rep); } }
        SEAM(P0 + 7);
        if (IN(P0 + 9)) { for (int rep = 0; rep < REP_G1; ++rep) { if (rep) P_gridbar(p); P_moe_g1(l); } }
        if (IN(P0 + 10)) P_moe_g2(l);
        SEAM(P0 + 10);
    }
    if (IN(1 + L_ * PH_PER_LAYER)) P_final(p);
#undef IN
#undef SEAM
}

extern "C" void kernel_launch(void* const* d_in, const int* in_sizes, int n_in, void* d_out, int out_size, void* d_ws, size_t ws_size, hipStream_t stream) {
    static int grid = 0;
    if (grid == 0) {
        if (n_in != 23 || out_size != NT * D_ || ws_size < WS_END) { fprintf(stderr, "kernel_launch: unexpected sizes n_in %d out %d ws %zu (need %zu)\n", n_in, out_size, ws_size, (size_t)WS_END); grid = -1; return; }
        int dev = 0, cus = 0, per_cu = 0;
        if (hipGetDevice(&dev) != hipSuccess || hipDeviceGetAttribute(&cus, hipDeviceAttributeMultiprocessorCount, dev) != hipSuccess) { grid = -1; return; }
        if (hipFuncSetAttribute((const void*)fwd_kernel, hipFuncAttributeMaxDynamicSharedMemorySize, LDS_BYTES) != hipSuccess) { fprintf(stderr, "kernel_launch: hipFuncSetAttribute failed\n"); grid = -1; return; }
        if (hipOccupancyMaxActiveBlocksPerMultiprocessor(&per_cu, (const void*)fwd_kernel, NTHREADS, LDS_BYTES) != hipSuccess || per_cu < 1) { fprintf(stderr, "kernel_launch: occupancy query says %d\n", per_cu); }
        (void)hipGetLastError();
        grid = cus;
    }
    if (grid < 0) return;
    (void)hipMemsetAsync((char*)d_ws + WS_CTL, 0, CTL_BYTES, stream);
    Params p{};
    for (int i = 0; i < 23; ++i) p.in[i] = (const float*)d_in[i];
    p.out = (float*)d_out; p.ws = (unsigned char*)d_ws;
#if N_LAUNCH_MODE == 0
    p.ph_lo = 0; p.ph_hi = N_PHASES;
    hipLaunchKernelGGL(fwd_kernel, dim3(grid), dim3(NTHREADS), LDS_BYTES, stream, p);
#else
    for (int k = 0; k < N_PHASES; ++k) { p.ph_lo = k; p.ph_hi = k + 1; hipLaunchKernelGGL(fwd_kernel, dim3(grid), dim3(NTHREADS), LDS_BYTES, stream, p); }
#endif
}
```

```cpp
#include <hip/hip_runtime.h>
#include <cstdio>
#include <cstdint>

#ifndef INPROJ_ALIGN
#define INPROJ_ALIGN true
#endif
#ifndef INPROJ_SP2
#define INPROJ_SP2 true
#endif
#ifndef REP_PRO
#define REP_PRO 1
#endif
#ifndef REP_ROUTE
#define REP_ROUTE 1
#endif
#ifndef REP_NORM
#define REP_NORM 1
#endif
#ifndef REP_INPROJ
#define REP_INPROJ 1
#endif
#ifndef REP_ATT3
#define REP_ATT3 1
#endif
#ifndef REP_CMP
#define REP_CMP 1
#endif
#ifndef REP_SLC
#define REP_SLC 1
#endif
#ifndef REP_SCAT
#define REP_SCAT 1
#endif
#ifndef REP_G1
#define REP_G1 1
#endif
#ifndef N_LAUNCH_MODE
#define N_LAUNCH_MODE 0
#endif

#ifndef NOMAX_ON
#define NOMAX_ON true
#endif
#define LAS __attribute__((address_space(3)))
#define GAS __attribute__((address_space(1)))
typedef unsigned short bf16;
typedef unsigned long long u64;
typedef float f32x4 __attribute__((ext_vector_type(4)));
typedef unsigned u32x4 __attribute__((ext_vector_type(4)));

constexpr int B_ = 8, T_ = 4096, D_ = 1024, NT = B_ * T_, L_ = 2;
constexpr int HD = 64, D_IN = 2844;
constexpr int N_CMP = 255, CMP_HID = 256;
constexpr int NEXP = 32, DEXP = 256;
constexpr float EPS = 1e-6f;
constexpr float LOG2E = 1.4426950408889634f;
constexpr int NWAVES = 8, NTHREADS = 512;

constexpr int C_NSAQ = 0, C_KV6 = 512, C_GATE = 1280, C_FQ = 1304, C_FF = 2072, C_DQ = 2076, C_DV = 2588;

constexpr size_t MiB = 1u << 20;
constexpr size_t WS_CTL = 0, CTL_BYTES = 1 * MiB;
constexpr size_t WS_QN = 1 * MiB;
constexpr size_t WS_KV6 = WS_QN + 32 * MiB;
constexpr size_t KV6_STRIDE = 8 * MiB + 64 * 1024;
constexpr size_t WS_FQKV = WS_KV6 + 6 * KV6_STRIDE;
constexpr size_t WS_DQK = WS_FQKV + 48 * MiB;
constexpr size_t WS_DV = WS_DQK + 32 * MiB;
constexpr size_t WS_GATE = WS_DV + 16 * MiB;
constexpr size_t WS_FL = WS_GATE + 3 * MiB;
constexpr size_t WS_HC = WS_FL + 1 * MiB;
constexpr size_t WS_KVCMP = WS_HC + 4 * MiB;
constexpr size_t WS_SEL = WS_KVCMP + 1 * MiB;
constexpr size_t WS_OCMP = WS_SEL + 1 * MiB;
constexpr size_t WS_OWIN = WS_OCMP + 32 * MiB;
constexpr size_t WS_HN = WS_OWIN + 32 * MiB;
constexpr size_t WS_ATT = WS_HN + 64 * MiB;
constexpr size_t WS_ROUTE = WS_ATT + 64 * MiB;
constexpr size_t WS_WIN_T = WS_ROUTE + 2 * MiB;
constexpr size_t WS_WOUT_T = WS_WIN_T + 12 * MiB;
constexpr size_t WS_WGU_T = WS_WOUT_T + 4 * MiB;
constexpr size_t WS_WD_T = WS_WGU_T + 64 * MiB;
constexpr size_t WS_W1_T = WS_WD_T + 32 * MiB;
constexpr size_t WS_W2_T = WS_W1_T + 4 * MiB;
constexpr size_t WS_BIAS1 = WS_W2_T + 512 * 1024;
constexpr size_t WS_WR = WS_BIAS1 + 512 * 1024;
constexpr size_t WS_B1PART = WS_WR + 512 * 1024;
constexpr size_t WS_END = WS_B1PART + 512 * 1024;
constexpr int MOE_MAXROWS = 61440;
constexpr size_t WS_XS = WS_QN;
constexpr size_t WS_HB = WS_OCMP;
static_assert(WS_XS + (size_t)MOE_MAXROWS * 2048 <= WS_DQK && WS_HB + (size_t)MOE_MAXROWS * 1024 <= WS_HN, "MoE aliases");
constexpr size_t RT_INFO = 0, RT_W = 128 * 1024, RT_ROWTOK = 384 * 1024, RT_ROWW = 640 * 1024, RT_RSTD = 1152 * 1024;
constexpr int CW_QUEUE = 16384, CW_MOECNT = 32768, CW_KN = 49152, MOE_CS = 32, MOE_LS = 8192;
constexpr size_t WS_REC = WS_QN;
constexpr size_t WS_RECC = WS_REC + (size_t)NEXP * 32768 * 16;
constexpr unsigned ZROW_OFF = 512 * 1024;
static_assert(WS_RECC + (size_t)112 * 32768 * 4 <= WS_DQK && WS_HN + (size_t)NT * 2048 < (1ull << 32) && CW_MOECNT + L_ * MOE_LS <= CW_KN && (112 + 2 * NEXP) * MOE_CS <= MOE_LS, "MoE record tables / 32-bit row offsets / counters");
constexpr int TBL_OFF = 131072 + 1024;
constexpr int NIN = 3072;

extern __shared__ __attribute__((aligned(16))) unsigned char lds_raw[];
__device__ __forceinline__ float bf2f(bf16 v) { return __uint_as_float(((unsigned)v) << 16); }
__device__ __forceinline__ unsigned f2bf(float f) { unsigned u = __float_as_uint(f); return (u + 0x7fffu + ((u >> 16) & 1u)) >> 16; }
__device__ __forceinline__ unsigned pk2(float lo, float hi) { return f2bf(lo) | (f2bf(hi) << 16); }
__device__ __forceinline__ float wave_sum(float v) {
#pragma unroll
    for (int o = 1; o < 64; o <<= 1) v += __shfl_xor(v, o);
    return v;
}
__device__ __forceinline__ float wave_max(float v) {
#pragma unroll
    for (int o = 1; o < 64; o <<= 1) v = fmaxf(v, __shfl_xor(v, o));
    return v;
}
__device__ __forceinline__ float shflx_f(float v, int o, int lane) { return __uint_as_float((unsigned)__builtin_amdgcn_ds_bpermute((lane ^ o) << 2, (int)__float_as_uint(v))); }
__device__ __forceinline__ unsigned shflx_u(unsigned v, int o, int lane) { return (unsigned)__builtin_amdgcn_ds_bpermute((lane ^ o) << 2, (int)v); }
__device__ __forceinline__ float wave_sum_l(float v, int lane) {
#pragma unroll
    for (int o = 1; o < 64; o <<= 1) v += shflx_f(v, o, lane);
    return v;
}
__device__ __forceinline__ int launder_s(int v) { asm volatile("" : "+s"(v)); return v; }
__device__ __forceinline__ float sigmoidf_(float x) { return 1.f / (1.f + __expf(-x)); }
__device__ __forceinline__ float log_sigmoidf_(float x) { return x >= 0.f ? -log1pf(__expf(-x)) : x - log1pf(__expf(x)); }
__device__ __forceinline__ float gelu_tanh(float x) { const float u = 0.7978845608028654f * (x + 0.044715f * x * x * x); return 0.5f * x * (1.f + tanhf(u)); }
__device__ __forceinline__ float alibi_slope(int idx1, int n) { return exp2f(-8.0f * (float)idx1 / (float)n); }

__device__ __forceinline__ constexpr int b64_off(int t, int d) { return ((t >> 4) * 2 + (d >> 5)) * 512 + (t & 15) * 32 + (d & 31); }
#define XB_TMO      128
#define XB_XCNT(j)  (256  + 64 * (j))
#define XB_XSUB(j)  (1280 + 64 * (j))
#define XB_XGEN(j)  (2304 + 64 * (j))
#define XB_TOP      3328
#define XB_TOPGEN   3392
#define XCD_BAR_WORDS 3456
#define XB_SPIN_CAP (1u << 25)
__device__ __forceinline__ unsigned xb_ld(unsigned* p)              { return __hip_atomic_load(p, __ATOMIC_RELAXED, __HIP_MEMORY_SCOPE_AGENT); }
__device__ __forceinline__ unsigned xb_add(unsigned* p, unsigned v) { return __hip_atomic_fetch_add(p, v, __ATOMIC_RELAXED, __HIP_MEMORY_SCOPE_AGENT); }
__device__ __forceinline__ unsigned xb_xcc_id() { return (unsigned)__builtin_amdgcn_s_getreg((3 << 11) | 20) & 0xFu; }
#define XB_SPIN(cond, bar) do { unsigned _sp = 0; while (cond) { __builtin_amdgcn_s_sleep(1); \
    if ((++_sp & 255u) == 0u) { if (xb_ld(&(bar)[XB_TMO])) break; if (_sp > XB_SPIN_CAP) { atomicAdd(&(bar)[XB_TMO], 1u); break; } } } } while (0)
struct XcdBarrier { unsigned* bar; unsigned x; volatile LAS unsigned* st; };
__device__ __forceinline__ XcdBarrier xcd_barrier_post(unsigned* bar, volatile LAS unsigned* st) {
    XcdBarrier b; b.bar = bar; b.x = xb_xcc_id(); b.st = st;
    if (threadIdx.x == 0) (void)xb_add(&bar[XB_XCNT(b.x)], 1u);
    return b;
}
__device__ __forceinline__ void xcd_barrier_complete(unsigned* bar, unsigned x, unsigned& nloc, unsigned& nx) {
    const unsigned G = gridDim.x * gridDim.y * gridDim.z;
    unsigned sum, cnt, mine, sp = 0u;
    for (;;) {
        sum = 0u; cnt = 0u; mine = 0u;
#pragma unroll
        for (unsigned j = 0; j < 16; ++j) { const unsigned c = xb_ld(&bar[XB_XCNT(j)]); sum += c; cnt += (c > 0u) ? 1u : 0u; mine = (j == x) ? c : mine; }
        if (sum == G) break;
        __builtin_amdgcn_s_sleep(1);
        if ((++sp & 255u) == 0u) { if (xb_ld(&bar[XB_TMO])) break; if (sp > XB_SPIN_CAP) { atomicAdd(&bar[XB_TMO], 1u); break; } }
    }
    nloc = mine > 0u ? mine : 1u; nx = cnt > 0u ? cnt : 1u;
}
__device__ __forceinline__ void xcd_barrier(const XcdBarrier& b) {
    asm volatile("s_waitcnt vmcnt(0)" ::: "memory");
    __syncthreads();
    if (threadIdx.x == 0) {
        unsigned* bar = b.bar;
        __builtin_amdgcn_s_waitcnt(0);
        unsigned nloc = b.st[0], nx = b.st[1];
        if (nloc == 0u) { xcd_barrier_complete(bar, b.x, nloc, nx); b.st[0] = nloc; b.st[1] = nx; }
        const unsigned old = xb_add(&bar[XB_XSUB(b.x)], 1u);
        const unsigned gen = old / nloc;
        if (old + 1u == (gen + 1u) * nloc) {
            __builtin_amdgcn_fence(__ATOMIC_RELEASE, "agent");
            asm volatile("s_waitcnt vmcnt(0)" ::: "memory");
            const unsigned og = xb_add(&bar[XB_TOP], 1u);
            const unsigned tg = og / nx;
            if (og + 1u == (tg + 1u) * nx) xb_add(&bar[XB_TOPGEN], 1u);
            else XB_SPIN(xb_ld(&bar[XB_TOPGEN]) == tg, bar);
            __builtin_amdgcn_fence(__ATOMIC_ACQUIRE, "agent");
            xb_add(&bar[XB_XGEN(b.x)], 1u);
            asm volatile("s_waitcnt vmcnt(0)" ::: "memory");
        } else {
            XB_SPIN(xb_ld(&bar[XB_XGEN(b.x)]) == gen, bar);
            __builtin_amdgcn_fence(__ATOMIC_ACQUIRE, "agent");
            asm volatile("s_waitcnt vmcnt(0)" ::: "memory");
        }
    }
    __syncthreads();
}

struct Params { const float* in[23]; float* out; unsigned char* ws; int ph_lo, ph_hi; };
constexpr int LDS_BYTES = 147456;
constexpr int MISC_OFF = 131072 + 320;

struct Ctx {
    LAS unsigned char* lds; int tid, lane, wave, bid, G, gw, ngw;
    const float* const* in; float* xcur; unsigned char* ws;
};

namespace pg8 {
#define PG8_LAS __attribute__((address_space(3)))
typedef unsigned short bf16_t;
typedef short bf16x8 __attribute__((ext_vector_type(8)));
typedef float f32x4 __attribute__((ext_vector_type(4)));
typedef unsigned u32x4 __attribute__((ext_vector_type(4)));
constexpr int BM = 256, BK = 64, HALF = 128, HTB = HALF * BK * 2  , STAGE_BYTES = 8 * HTB, NXCD = 8, WGM = 8;

__host__ __device__ __forceinline__ int lds_byte(int r, int c) { const int st = (r >> 4) * 2 + (c >> 5), rr = r & 15, cc = c & 31, ob = rr * 64 + cc * 2; return st * 1024 + (ob ^ (((ob >> 9) & 1) << 5)); }
__host__ __device__ __forceinline__ void stage_rc(int b, int& R, int& C) { const int st = b / 1024, sb = b % 1024, swz = sb ^ (((sb >> 9) & 1) << 5); R = (st >> 1) * 16 + swz / 64; C = (st & 1) * 32 + (swz % 64) / 2; }
__host__ __device__ __forceinline__ int perm32(int rho) { const int n = rho >> 4, i = rho & 15; return 8 * (i >> 2) + 4 * n + (i & 3); }

struct Unit { int pm, pn; const char* a; const char* b; const char* b2; };
struct Gemm { int lda, ldb, K, ksplit, arb, acb; };

__device__ __forceinline__ unsigned cvt_pk_bf16(float lo, float hi) { unsigned r; asm volatile("v_cvt_pk_bf16_f32 %0, %1, %2" : "=v"(r) : "v"(lo), "v"(hi)); return r; }
typedef float f32x2 __attribute__((ext_vector_type(2)));

template <class Epi, class Sched, bool ALIGN_EPI = false, bool SP2 = false, bool GATHER = false>
__device__ __forceinline__ void gemm_phase(PG8_LAS unsigned char* lds, const Gemm g, const Sched& S, const Epi& E) {
    static_assert(!GATHER || SP2, "GATHER is written for the SP2 loop");
    int tid_ = threadIdx.x; asm volatile("" : "+v"(tid_));
    const int tid = tid_, wid = __builtin_amdgcn_readfirstlane(tid >> 6), lane = tid & 63, wr = wid >> 2, wc = wid & 3, fr = lane & 15, fq = lane >> 4;
    const int K = g.K, nt = K / BK, ks = g.ksplit;
    unsigned voffA[2], voffB[2];
#pragma unroll
    for (int i = 0; i < 2; ++i) { int R, C; stage_rc(tid * 16 + i * 8192, R, C); const int Rb = Epi::PERM ? ((R & ~31) + perm32(R & 31)) : R;
        voffA[i] = g.arb ? (unsigned)(((R / g.arb) * (K / g.acb) + C / g.acb) * (g.arb * g.acb) + (R % g.arb) * g.acb + (C % g.acb)) * 2u : (unsigned)(R * g.lda + C) * 2u; voffB[i] = (unsigned)(Rb * g.ldb + C) * 2u; }
    const size_t kstep = (size_t)(BK * 2), kstepA = g.arb ? (size_t)(BK * g.arb * 2) : kstep;
    const size_t hsA = (size_t)HALF * (g.arb ? K : g.lda) * 2, hsB = (size_t)HALF * g.ldb * 2;
    const unsigned ldsw = (unsigned)wid * 1024u;
    const int aoff = lds_byte(wr * 64 + fr, fq * 8), boff = lds_byte(wc * 32 + fr, fq * 8);
#define PG8_SA(b, h) (((b) * 2 + (h)) * HTB)
#define PG8_SB(b, h) ((4 + (b) * 2 + (h)) * HTB)
#define PG8_STAGE(bufoff, gbase, voff) do { _Pragma("unroll") for (int _i = 0; _i < 2; ++_i) \
        __builtin_amdgcn_global_load_lds((const unsigned*)((const char*)(gbase) + (voff)[_i]), (PG8_LAS unsigned*)(lds + (bufoff) + ldsw + _i * 8192), 16, 0, 0); } while (0)
#define PG8_LDA(dst, b, h) do { _Pragma("unroll") for (int m = 0; m < 4; ++m) _Pragma("unroll") for (int k = 0; k < 2; ++k) dst[m][k] = *(const PG8_LAS bf16x8*)(lds + PG8_SA(b, h) + aoff + m * 2048 + k * 1024); } while (0)
#define PG8_LDB(dst, b, h) do { _Pragma("unroll") for (int n = 0; n < 2; ++n) _Pragma("unroll") for (int k = 0; k < 2; ++k) dst[n][k] = *(const PG8_LAS bf16x8*)(lds + PG8_SB(b, h) + boff + n * 2048 + k * 1024); } while (0)
#define PG8_MMA(ai, bj, At, Bt) do { __builtin_amdgcn_s_setprio(1); _Pragma("unroll") for (int m = 0; m < 4; ++m) _Pragma("unroll") for (int n = 0; n < 2; ++n) _Pragma("unroll") for (int k = 0; k < 2; ++k) \
        acc[ai][bj][m][n] = __builtin_amdgcn_mfma_f32_16x16x32_bf16(Bt[n][k], At[m][k], acc[ai][bj][m][n], 0, 0, 0); __builtin_amdgcn_s_setprio(0); } while (0)
#define PG8_WAIT_V(n) asm volatile("s_waitcnt vmcnt(" #n ")" ::: "memory")
#define PG8_WAIT_L(n) asm volatile("s_waitcnt lgkmcnt(" #n ")" ::: "memory")
#define PG8_BAR __builtin_amdgcn_s_barrier()
#define PG8_SCHED __builtin_amdgcn_sched_barrier(0)
    Unit cur, nxt; int ui = 0;
    if (!S.next(0, cur)) return;
    unsigned gC[2][2] = {{0u, 0u}, {0u, 0u}}, gN[2][2] = {{0u, 0u}, {0u, 0u}}; const char* gbase = nullptr;
#define PG8_GOFFS(U, Gv) do { int R_, C_; stage_rc(tid * 16, R_, C_); S.arows4(U, R_, (unsigned)C_ * 2u, Gv); } while (0)
#define PG8_STAGE_G(bufoff, kbyte, Gv, h) do { _Pragma("unroll") for (int _i = 0; _i < 2; ++_i) \
        __builtin_amdgcn_global_load_lds((const unsigned*)(gbase + (size_t)(kbyte) + Gv[h][_i]), (PG8_LAS unsigned*)(lds + (bufoff) + ldsw + _i * 8192), 16, 0, 0); } while (0)
    if constexpr (GATHER) { gbase = S.abase(); PG8_GOFFS(cur, gC); }
    f32x4 acc[2][2][4][2];
#pragma unroll
    for (int a = 0; a < 2; ++a)
#pragma unroll
        for (int b = 0; b < 2; ++b)
#pragma unroll
            for (int m = 0; m < 4; ++m)
#pragma unroll
                for (int n = 0; n < 2; ++n) acc[a][b][m][n] = (f32x4){0.f, 0.f, 0.f, 0.f};
    bf16x8 At[4][2], B0[2][2], B1[2][2];
    const char* cA = cur.a; const char* cB = cur.b; const char* cB2 = cur.b2;
#define PG8_BK(base, base2, kt) ((kt) < ks ? (base) + (size_t)(kt) * kstep : (base2) + (size_t)((kt) - ks) * kstep)
    S.a_ready(cur);
    if constexpr (SP2) {
        PG8_STAGE(PG8_SB(0, 0), cB, voffB); PG8_STAGE(PG8_SB(0, 1), cB + hsB, voffB);
        if constexpr (GATHER) { PG8_STAGE_G(PG8_SA(0, 0), 0, gC, 0); PG8_STAGE_G(PG8_SA(0, 1), 0, gC, 1); } else { PG8_STAGE(PG8_SA(0, 0), cA, voffA); PG8_STAGE(PG8_SA(0, 1), cA + hsA, voffA); }
        if (wr == 1) PG8_BAR;
        PG8_WAIT_V(2); PG8_BAR;
        PG8_STAGE(PG8_SB(1, 0), PG8_BK(cB, cB2, 1), voffB);
        if constexpr (GATHER) PG8_STAGE_G(PG8_SA(1, 0), kstep, gC, 0); else PG8_STAGE(PG8_SA(1, 0), cA + kstepA, voffA);
        PG8_STAGE(PG8_SB(1, 1), PG8_BK(cB, cB2, 1) + hsB, voffB);
        PG8_WAIT_V(6); PG8_BAR;
    } else {
        PG8_STAGE(PG8_SB(0, 0), cB, voffB); PG8_STAGE(PG8_SA(0, 0), cA, voffA); PG8_STAGE(PG8_SB(0, 1), cB + hsB, voffB); PG8_STAGE(PG8_SA(0, 1), cA + hsA, voffA);
        if (wr == 1) PG8_BAR;
        PG8_WAIT_V(4); PG8_BAR;
        PG8_STAGE(PG8_SB(1, 0), PG8_BK(cB, cB2, 1), voffB); PG8_STAGE(PG8_SA(1, 0), cA + kstepA, voffA); PG8_STAGE(PG8_SB(1, 1), PG8_BK(cB, cB2, 1) + hsB, voffB);
        PG8_WAIT_V(6); PG8_BAR;
    }
    for (;;) {
        const bool has_next = S.next(ui + 1, nxt);
        if constexpr (GATHER) { if (has_next) PG8_GOFFS(nxt, gN); else { _Pragma("unroll") for (int _h = 0; _h < 2; ++_h) _Pragma("unroll") for (int _i = 0; _i < 2; ++_i) gN[_h][_i] = gC[_h][_i]; } }
        const char* nA = has_next ? nxt.a : cA; const char* nB = has_next ? nxt.b : cB; const char* nB2 = has_next ? nxt.b2 : cB2;
#pragma unroll 1
        for (int t = 0; t < nt; t += 2) {
            const bool last = (t == nt - 2);
            const char* a1 = cA + (size_t)(t + 1) * kstepA;
            const char* a2 = last ? nA : cA + (size_t)(t + 2) * kstepA; const char* b2 = last ? PG8_BK(nB, nB2, 0) : PG8_BK(cB, cB2, t + 2);
            const char* a3 = a2 + kstepA; const char* b3 = last ? PG8_BK(nB, nB2, 1) : PG8_BK(cB, cB2, t + 3);
            if (last && has_next) S.a_ready(nxt);
            if constexpr (SP2) {
            PG8_LDB(B0, 0, 0); PG8_LDB(B1, 0, 1); PG8_SCHED; PG8_LDA(At, 0, 0);
            if constexpr (GATHER) PG8_STAGE_G(PG8_SA(1, 1), (size_t)(t + 1) * kstep, gC, 1); else PG8_STAGE(PG8_SA(1, 1), a1 + hsA, voffA);
            PG8_WAIT_V(8); PG8_WAIT_L(0); PG8_BAR; PG8_MMA(0, 0, At, B0); PG8_MMA(0, 1, At, B1); PG8_BAR; PG8_SCHED;
            PG8_LDA(At, 0, 1); PG8_STAGE(PG8_SB(0, 0), b2, voffB); PG8_STAGE(PG8_SB(0, 1), b2 + hsB, voffB);
            if constexpr (GATHER) { if (last) PG8_STAGE_G(PG8_SA(0, 0), 0, gN, 0); else PG8_STAGE_G(PG8_SA(0, 0), (size_t)(t + 2) * kstep, gC, 0); } else PG8_STAGE(PG8_SA(0, 0), a2, voffA);
            PG8_WAIT_V(8); PG8_WAIT_L(0); PG8_BAR; PG8_MMA(1, 0, At, B0); PG8_MMA(1, 1, At, B1); PG8_BAR; PG8_SCHED;
            PG8_LDB(B0, 1, 0); PG8_LDB(B1, 1, 1); PG8_SCHED; PG8_LDA(At, 1, 0);
            if constexpr (GATHER) { if (last) PG8_STAGE_G(PG8_SA(0, 1), 0, gN, 1); else PG8_STAGE_G(PG8_SA(0, 1), (size_t)(t + 2) * kstep, gC, 1); } else PG8_STAGE(PG8_SA(0, 1), a2 + hsA, voffA);
            PG8_WAIT_V(8); PG8_WAIT_L(0); PG8_BAR; PG8_MMA(0, 0, At, B0); PG8_MMA(0, 1, At, B1); PG8_BAR; PG8_SCHED;
            PG8_LDA(At, 1, 1); PG8_STAGE(PG8_SB(1, 0), b3, voffB); PG8_STAGE(PG8_SB(1, 1), b3 + hsB, voffB);
            if constexpr (GATHER) { if (last) PG8_STAGE_G(PG8_SA(1, 0), kstep, gN, 0); else PG8_STAGE_G(PG8_SA(1, 0), (size_t)(t + 3) * kstep, gC, 0); } else PG8_STAGE(PG8_SA(1, 0), a3, voffA);
            PG8_WAIT_V(8); PG8_WAIT_L(0); PG8_BAR; PG8_MMA(1, 0, At, B0); PG8_MMA(1, 1, At, B1); PG8_BAR; PG8_SCHED;
            } else {
            PG8_LDB(B0, 0, 0); PG8_SCHED; PG8_LDA(At, 0, 0); PG8_STAGE(PG8_SA(1, 1), a1 + hsA, voffA);
            PG8_WAIT_L(8); PG8_BAR; PG8_WAIT_L(0); PG8_MMA(0, 0, At, B0); PG8_BAR; PG8_SCHED;
            PG8_LDB(B1, 0, 1); PG8_STAGE(PG8_SB(0, 0), b2, voffB);
            PG8_BAR; PG8_WAIT_L(0); PG8_MMA(0, 1, At, B1); PG8_BAR;
            PG8_LDA(At, 0, 1); PG8_STAGE(PG8_SA(0, 0), a2, voffA);
            PG8_BAR; PG8_WAIT_L(0); PG8_MMA(1, 0, At, B0); PG8_BAR; PG8_SCHED;
            PG8_STAGE(PG8_SB(0, 1), b2 + hsB, voffB);
            PG8_WAIT_V(6); PG8_BAR; PG8_MMA(1, 1, At, B1); PG8_BAR;
            PG8_LDB(B0, 1, 0); PG8_SCHED; PG8_LDA(At, 1, 0); PG8_STAGE(PG8_SA(0, 1), a2 + hsA, voffA);
            PG8_WAIT_L(8); PG8_BAR; PG8_WAIT_L(0); PG8_MMA(0, 0, At, B0); PG8_BAR; PG8_SCHED;
            PG8_LDB(B1, 1, 1); PG8_STAGE(PG8_SB(1, 0), b3, voffB);
            PG8_BAR; PG8_WAIT_L(0); PG8_MMA(0, 1, At, B1); PG8_BAR;
            PG8_LDA(At, 1, 1); PG8_STAGE(PG8_SA(1, 0), a3, voffA);
            PG8_BAR; PG8_WAIT_L(0); PG8_MMA(1, 0, At, B0); PG8_BAR; PG8_SCHED;
            PG8_STAGE(PG8_SB(1, 1), b3 + hsB, voffB);
            PG8_WAIT_V(6); PG8_BAR; PG8_MMA(1, 1, At, B1); PG8_BAR;
            }
        }
        if constexpr (ALIGN_EPI) { if (wr == 0) PG8_BAR; }
        if constexpr (!Epi::AFTER_DRAIN) { E(acc, cur, wr, wc, fr, fq); S.done(cur); }
        if (!has_next) break;
#pragma unroll
        for (int a = 0; a < 2; ++a)
#pragma unroll
            for (int b = 0; b < 2; ++b)
#pragma unroll
                for (int m = 0; m < 4; ++m)
#pragma unroll
                    for (int n = 0; n < 2; ++n) acc[a][b][m][n] = (f32x4){0.f, 0.f, 0.f, 0.f};
        cur = nxt; cA = nA; cB = nB; cB2 = nB2; ++ui;
        if constexpr (GATHER) { _Pragma("unroll") for (int _h = 0; _h < 2; ++_h) _Pragma("unroll") for (int _i = 0; _i < 2; ++_i) gC[_h][_i] = gN[_h][_i]; }
        if constexpr (ALIGN_EPI) { if (wr == 1) PG8_BAR; }
    }
    PG8_WAIT_V(0);
    if constexpr (!ALIGN_EPI) { if (wr == 0) PG8_BAR; }
    PG8_BAR;
    if constexpr (Epi::AFTER_DRAIN) { E.fused(acc, cur, wr, wc, fr, fq, lds, wid, lane); S.done(cur); }
#undef PG8_BK
#undef PG8_GOFFS
#undef PG8_STAGE_G
#undef PG8_SA
#undef PG8_SB
#undef PG8_STAGE
#undef PG8_LDA
#undef PG8_LDB
#undef PG8_MMA
#undef PG8_WAIT_V
#undef PG8_WAIT_L
#undef PG8_BAR
#undef PG8_SCHED
}
}

struct PlainOrder {
    const char* A; const char* Bt; int lda, ldb, nM, nN, nwg, G, c;
    __device__ __forceinline__ void init(const void* A_, const void* Bt_, int lda_, int ldb_, int M, int N, int G_, int c_) { A = (const char*)A_; Bt = (const char*)Bt_; lda = lda_; ldb = ldb_; nM = M / 256; nN = N / 256; nwg = nM * nN; G = G_; c = c_; }
    __device__ __forceinline__ bool next(int i, pg8::Unit& u) const {
        const long L = (long)i * G + c; if (L >= nwg) return false;
        int wgid = (int)L; { const int q = nwg / 8, r = nwg % 8, xcd = wgid % 8, off = wgid / 8; wgid = (xcd < r ? xcd * (q + 1) : r * (q + 1) + (xcd - r) * q) + off; }
        const int nig = 8 * nN, gid = wgid / nig, fm = gid * 8, gsz = (nM - fm) < 8 ? (nM - fm) : 8;
        u.pm = fm + ((wgid % nig) % gsz); u.pn = (wgid % nig) / gsz;
        u.a = A + (size_t)u.pm * 256 * lda * 2; u.b = Bt + (size_t)u.pn * 256 * ldb * 2; u.b2 = u.b; return true;
    }
    __device__ __forceinline__ void a_ready(const pg8::Unit&) const {}
    __device__ __forceinline__ void done(const pg8::Unit&) const {}
};
struct EpiInProj {
    static constexpr bool PERM = true, AFTER_DRAIN = false;
    unsigned char* ws; const float* b_gate; const float* b_fgt; unsigned* kn;
    __device__ __forceinline__ void operator()(const pg8::f32x4 (&acc)[2][2][4][2], const pg8::Unit& u, int wr, int wc, int fr, int fq) const {
        { int t_ = threadIdx.x; asm volatile("" : "+v"(t_)); fr = t_ & 15; fq = (t_ >> 4) & 3; }
        const int pn = u.pn, b = (u.pm * 256) / T_, t0 = u.pm * 256 - b * T_ + wr * 64 + fr;
        if (pn == 11) {
            if (wc == 0) {
                float* gate = (float*)(ws + WS_GATE); float* fl = (float*)(ws + WS_FL);
                float bias[8];
#pragma unroll
                for (int j = 0; j < 8; ++j) { const int c = 8 * fq + j; bias[j] = c < 24 ? b_gate[c] : (c < 28 ? b_fgt[c - 24] : 0.f); }
#pragma unroll
                for (int j = 0; j < 8; ++j) asm volatile("" : "+v"(bias[j]));
#pragma unroll
                for (int ai = 0; ai < 2; ++ai)
#pragma unroll
                    for (int m = 0; m < 4; ++m) { const int t = t0 + ai * 128 + m * 16; const size_t n = (size_t)b * T_ + t;
                        if (fq < 3) { float sg[8];
#pragma unroll
                            for (int j = 0; j < 8; ++j) sg[j] = __builtin_amdgcn_rcpf(1.f + __builtin_amdgcn_exp2f(-(acc[ai][0][m][j >> 2][j & 3] + bias[j]) * LOG2E));
                            f32x4* gp = (f32x4*)(gate + n * 24 + 8 * fq); gp[0] = (f32x4){sg[0], sg[1], sg[2], sg[3]}; gp[1] = (f32x4){sg[4], sg[5], sg[6], sg[7]}; }
                        else {
#pragma unroll
                            for (int e = 0; e < 4; ++e) { const float z = acc[ai][0][m][0][e] + bias[e];
                                fl[(size_t)(b * 4 + e) * T_ + t] = z < -30.f ? z : -0.6931471805599453f * __builtin_amdgcn_logf(1.f + __builtin_amdgcn_exp2f(-z * LOG2E)); } } }
            }
            return;
        }
        if (pn == 6 || pn == 9) {
            const int lane_ = (fq << 4) | fr;
#pragma unroll
            for (int bj = 0; bj < 2; ++bj)
#pragma unroll
                for (int ai = 0; ai < 2; ++ai) { float mx = 0.f;
#pragma unroll
                    for (int m = 0; m < 4; ++m) { const pg8::f32x4 v0 = acc[ai][bj][m][0], v1 = acc[ai][bj][m][1];
                        float ss = (v0[0] * v0[0] + v0[1] * v0[1]) + (v0[2] * v0[2] + v0[3] * v0[3]) + (v1[0] * v1[0] + v1[1] * v1[1]) + (v1[2] * v1[2] + v1[3] * v1[3]);
                        ss += shflx_f(ss, 16, lane_); ss += shflx_f(ss, 32, lane_); mx = fmaxf(mx, ss); }
#pragma unroll
                    for (int o = 1; o < 16; o <<= 1) mx = fmaxf(mx, shflx_f(mx, o, lane_));
                    if (lane_ == 0) { const int cg = bj * 4 + wc, tile = (u.pm * 256 - b * T_ + ai * 128 + wr * 64) >> 6;
                        unsigned* dst = pn == 6 ? kn + ((b * 4 + (cg >> 1)) * 64 + tile) * 2 + (cg & 1) : kn + 4096 + (b * 8 + cg) * 64 + tile;
                        atomicMax(dst, __float_as_uint(mx)); } }
        }
#pragma unroll
        for (int bj = 0; bj < 2; ++bj) {
            const int c = bj * 128 + wc * 32 + 8 * fq;
            bf16* base; int W = 64; float sc = 1.f;
            if (pn < 2) { base = (bf16*)(ws + WS_QN) + (size_t)(b * 8 + pn * 4 + (c >> 6)) * T_ * 64 + (c & 63); sc = 0.125f * LOG2E; }
            else if (pn < 5) { base = (bf16*)(ws + WS_KV6 + (size_t)((pn - 2) * 2 + (c >> 7)) * KV6_STRIDE) + (size_t)(b * 2 + ((c >> 6) & 1)) * T_ * 64 + (c & 63); }
            else if (pn < 8) { base = (bf16*)(ws + WS_FQKV) + (size_t)(pn - 5) * (8 * MiB) + (size_t)(b * 4 + (c >> 6)) * T_ * 64 + (c & 63); if (pn == 5) sc = 0.125f * LOG2E; }
            else if (pn < 10) { base = (bf16*)(ws + WS_DQK) + (size_t)(pn - 8) * (8 * MiB) + (size_t)(b * 8 + (c >> 5)) * T_ * 32 + (c & 31); W = 32; if (pn == 8) sc = 0.17677669529663687f * LOG2E; }
            else { base = (bf16*)(ws + WS_DV) + (size_t)(b * 4 + (c >> 6)) * T_ * 64 + (c & 63); }
            const bool blk = W == 64 && pn != 2;
            if (blk) base += -(c & 63) + ((c >> 5) & 1) * 512 + (c & 31);
#pragma unroll
            for (int ai = 0; ai < 2; ++ai)
#pragma unroll
                for (int m = 0; m < 4; ++m) { const int t = t0 + ai * 128 + m * 16;
                    const pg8::f32x4 v0 = acc[ai][bj][m][0] * sc, v1 = acc[ai][bj][m][1] * sc;
                    pg8::u32x4 w; w.x = pg8::cvt_pk_bf16(v0[0], v0[1]); w.y = pg8::cvt_pk_bf16(v0[2], v0[3]); w.z = pg8::cvt_pk_bf16(v1[0], v1[1]); w.w = pg8::cvt_pk_bf16(v1[2], v1[3]);
                    *(pg8::u32x4*)(base + (blk ? (size_t)((t >> 4) * 1024 + (t & 15) * 32) : (size_t)t * W)) = w; }
        }
    }
};
__device__ __forceinline__ u32x4 res_add8(u32x4 w, const pg8::f32x4& a0, const pg8::f32x4& a1) {
    u32x4 o;
    o.x = pg8::cvt_pk_bf16(__uint_as_float(w.x << 16) + a0[0], __uint_as_float(w.x & 0xffff0000u) + a0[1]); o.y = pg8::cvt_pk_bf16(__uint_as_float(w.y << 16) + a0[2], __uint_as_float(w.y & 0xffff0000u) + a0[3]);
    o.z = pg8::cvt_pk_bf16(__uint_as_float(w.z << 16) + a1[0], __uint_as_float(w.z & 0xffff0000u) + a1[1]); o.w = pg8::cvt_pk_bf16(__uint_as_float(w.w << 16) + a1[2], __uint_as_float(w.w & 0xffff0000u) + a1[3]);
    return o;
}
struct EpiResBf16 {
    static constexpr bool PERM = true, AFTER_DRAIN = false;
    bf16* xr;
    __device__ __forceinline__ void operator()(const pg8::f32x4 (&acc)[2][2][4][2], const pg8::Unit& u, int wr, int wc, int fr, int fq) const {
        { int t_ = threadIdx.x; asm volatile("" : "+v"(t_)); fr = t_ & 15; fq = (t_ >> 4) & 3; }
#pragma unroll
        for (int ai = 0; ai < 2; ++ai) { u32x4 w[4][2];
#pragma unroll
            for (int m = 0; m < 4; ++m)
#pragma unroll
                for (int bj = 0; bj < 2; ++bj) w[m][bj] = *(const u32x4*)(xr + (size_t)(u.pm * 256 + ai * 128 + wr * 64 + m * 16 + fr) * D_ + u.pn * 256 + wc * 32 + 8 * fq + bj * 128);
#pragma unroll
            for (int m = 0; m < 4; ++m)
#pragma unroll
                for (int bj = 0; bj < 2; ++bj) asm volatile("" : "+v"(w[m][bj]));
#pragma unroll
            for (int m = 0; m < 4; ++m)
#pragma unroll
                for (int bj = 0; bj < 2; ++bj) *(u32x4*)(xr + (size_t)(u.pm * 256 + ai * 128 + wr * 64 + m * 16 + fr) * D_ + u.pn * 256 + wc * 32 + 8 * fq + bj * 128) = res_add8(w[m][bj], acc[ai][bj][m][0], acc[ai][bj][m][1]); }
    }
};


struct EpiDummy {
    static constexpr bool PERM = true, AFTER_DRAIN = false;
    float* dst;
    __device__ __forceinline__ void operator()(const pg8::f32x4 (&acc)[2][2][4][2], const pg8::Unit& u, int wr, int wc, int fr, int fq) const {
        pg8::f32x4 a = {0.f, 0.f, 0.f, 0.f};
#pragma unroll
        for (int ai = 0; ai < 2; ++ai)
#pragma unroll
            for (int bj = 0; bj < 2; ++bj)
#pragma unroll
                for (int m = 0; m < 4; ++m) { a = a + acc[ai][bj][m][0]; a = a + acc[ai][bj][m][1]; }
        *(pg8::f32x4*)(dst + ((size_t)(u.pm * 12 + u.pn) * 512 + threadIdx.x) * 4) = a;
    }
};
struct OneUnitOrder { pg8::Unit u; bool has;
    __device__ __forceinline__ bool next(int i, pg8::Unit& o) const { if (i != 0 || !has) return false; o = u; return true; }
    __device__ __forceinline__ void a_ready(const pg8::Unit&) const {}
    __device__ __forceinline__ void done(const pg8::Unit&) const {} };
__device__ __forceinline__ float gelu_tanh_fast(float x) { const float u2 = 1.5957691216057308f * (x + 0.044715f * x * x * x); return x * __builtin_amdgcn_rcpf(1.f + __builtin_amdgcn_exp2f(-u2 * LOG2E)); }
struct EpiCmpH {
    static constexpr bool PERM = true, AFTER_DRAIN = false;
    bf16* hc; const float* bias1;
    __device__ __forceinline__ void operator()(const pg8::f32x4 (&acc)[2][2][4][2], const pg8::Unit& u, int wr, int wc, int fr, int fq) const {
        { int t_ = threadIdx.x; asm volatile("" : "+v"(t_)); fr = t_ & 15; fq = (t_ >> 4) & 3; }
        const int kv = u.pn;
#pragma unroll
        for (int bj = 0; bj < 2; ++bj) { const int col = bj * 128 + wc * 32 + 8 * fq;
            const pg8::f32x4 b0 = *(const pg8::f32x4*)(bias1 + kv * 256 + col), b1 = *(const pg8::f32x4*)(bias1 + kv * 256 + col + 4);
#pragma unroll
            for (int ai = 0; ai < 2; ++ai)
#pragma unroll
                for (int m = 0; m < 4; ++m) { const int row = u.pm * 256 + ai * 128 + wr * 64 + m * 16 + fr;
                    const pg8::f32x4 v0 = acc[ai][bj][m][0] + b0, v1 = acc[ai][bj][m][1] + b1;
                    pg8::u32x4 w; w.x = pg8::cvt_pk_bf16(gelu_tanh_fast(v0[0]), gelu_tanh_fast(v0[1])); w.y = pg8::cvt_pk_bf16(gelu_tanh_fast(v0[2]), gelu_tanh_fast(v0[3]));
                    w.z = pg8::cvt_pk_bf16(gelu_tanh_fast(v1[0]), gelu_tanh_fast(v1[1])); w.w = pg8::cvt_pk_bf16(gelu_tanh_fast(v1[2]), gelu_tanh_fast(v1[3]));
                    *(pg8::u32x4*)(hc + ((size_t)kv * 4096 + row) * 256 + col) = w; } }
    }
};
struct EpiCmpOut {
    static constexpr bool PERM = true, AFTER_DRAIN = false;
    bf16* kvcmp;
    __device__ __forceinline__ void operator()(const pg8::f32x4 (&acc)[2][2][4][2], const pg8::Unit& u, int wr, int wc, int fr, int fq) const {
        { int t_ = threadIdx.x; asm volatile("" : "+v"(t_)); fr = t_ & 15; fq = (t_ >> 4) & 3; }
        if (wc >= 2) return;
        const int kv = u.pn, col = wc * 32 + 8 * fq;
#pragma unroll
        for (int ai = 0; ai < 2; ++ai)
#pragma unroll
            for (int m = 0; m < 4; ++m) { const int row = u.pm * 256 + ai * 128 + wr * 64 + m * 16 + fr; const float z = ((row & 255) == 255) ? 0.f : 1.f;
                const pg8::f32x4 v0 = acc[ai][0][m][0], v1 = acc[ai][0][m][1];
                pg8::u32x4 w; w.x = pg8::cvt_pk_bf16(z != 0.f ? v0[0] : 0.f, z != 0.f ? v0[1] : 0.f); w.y = pg8::cvt_pk_bf16(z != 0.f ? v0[2] : 0.f, z != 0.f ? v0[3] : 0.f);
                w.z = pg8::cvt_pk_bf16(z != 0.f ? v1[0] : 0.f, z != 0.f ? v1[1] : 0.f); w.w = pg8::cvt_pk_bf16(z != 0.f ? v1[2] : 0.f, z != 0.f ? v1[3] : 0.f);
                *(pg8::u32x4*)(kvcmp + ((size_t)kv * 4096 + row) * 64 + col) = w; }
    }
};

__device__ __forceinline__ void moe_build_tables(const unsigned* cnt, int tid) {
    LAS int* T = (LAS int*)((LAS unsigned char*)lds_raw + TBL_OFF);
    __syncthreads();
    if (tid < 112) T[384 + tid] = (int)cnt[tid * MOE_CS];
    else if (tid >= 128 && tid < 128 + NEXP) T[560 + tid - 128] = (int)cnt[(112 + tid - 128) * MOE_CS];
    __syncthreads();
    if (tid == 0) { int o = 0; _Pragma("clang loop unroll(disable)") for (int c = 0; c < 112; ++c) { T[c] = o; const int n = (T[384 + c] + 255) >> 8;
            _Pragma("clang loop vectorize(disable) unroll(disable)") for (int k = 0; k < n; ++k) T[128 + o + k] = c;
            o += n; } T[112] = o; }
    if (tid == 64) { int o = 0; _Pragma("clang loop unroll(disable)") for (int e = 0; e < NEXP; ++e) { T[512 + e] = o; const int n = (T[560 + e] + 255) >> 8;
            _Pragma("clang loop vectorize(disable) unroll(disable)") for (int k = 0; k < n; ++k) T[608 + o + k] = e;
            o += n; } T[544] = o; }
    __syncthreads();
}
__device__ __forceinline__ void moe_pair(int cls, int& ea, int& eb) { const int grp = cls / 28; int idx = cls % 28, lo = 0; while (idx >= 7 - lo) { idx -= 7 - lo; ++lo; } ea = grp * 8 + lo; eb = grp * 8 + lo + 1 + idx; }
struct MoeOrder1 {
    const char* wsb; const unsigned* rec; const char* wgu; unsigned* edone; int G, c;
    __device__ __forceinline__ bool next(int i, pg8::Unit& u) const {
        const LAS int* T = (const LAS int*)((LAS unsigned char*)lds_raw + TBL_OFF);
        const int idx = i * G + c; if (idx >= 2 * T[544]) return false;
        const int tile = idx >> 1, pn = idx & 1, e = T[608 + tile];
        u.pm = tile; u.pn = pn; u.a = wsb; u.b = wgu + ((size_t)e * 512 + pn * 256) * 2048; u.b2 = u.b; return true; }
    __device__ __forceinline__ const char* abase() const { return wsb; }
    __device__ __forceinline__ void arows4(const pg8::Unit& u, int r0, unsigned cb, unsigned (&g)[2][2]) const {
        const LAS int* T = (const LAS int*)((LAS unsigned char*)lds_raw + TBL_OFF);
        const int e = T[608 + u.pm], base = (u.pm - T[512 + e]) * 256 + r0, n = T[560 + e];
        const unsigned ob = (unsigned)(e * 32768 + base) * 16u;
#pragma unroll
        for (int k = 0; k < 4; ++k) { unsigned off = ZROW_OFF; if (base + 64 * k < n) off = (unsigned)WS_HN + *(const unsigned*)((const char*)rec + (ob + 1024u * k)) * 2048u; g[k >> 1][k & 1] = off + cb; } }
    __device__ __forceinline__ void a_ready(const pg8::Unit&) const {}
    __device__ __forceinline__ void done(const pg8::Unit& u) const {
        asm volatile("s_waitcnt vmcnt(0)" ::: "memory");
        const LAS int* T = (const LAS int*)((LAS unsigned char*)lds_raw + TBL_OFF);
        int t_ = threadIdx.x; asm volatile("" : "+v"(t_));
        if ((t_ & 63) == 0) (void)__hip_atomic_fetch_add(edone + T[608 + u.pm] * MOE_CS, 1u, __ATOMIC_RELAXED, __HIP_MEMORY_SCOPE_AGENT); } };
struct MoeOrder2 {
    const char* hb; const char* wd; const unsigned* edone; unsigned* tmo; int G, c;
    __device__ __forceinline__ bool next(int i, pg8::Unit& u) const {
        const LAS int* T = (const LAS int*)((LAS unsigned char*)lds_raw + TBL_OFF);
        const int n1 = (2 * T[544]) % G, idx = i * G + (c >= n1 ? c - n1 : c - n1 + G); if (idx >= 4 * T[112]) return false;
        const int tile = idx >> 2, pn = idx & 3; int ea, eb; moe_pair(T[128 + tile], ea, eb);
        u.pm = tile; u.pn = pn; u.a = hb + (size_t)tile * 256 * 1024; u.b = wd + ((size_t)ea * 1024 + pn * 256) * 512; u.b2 = wd + ((size_t)eb * 1024 + pn * 256) * 512; return true; }
    __device__ __forceinline__ void a_ready(const pg8::Unit& u) const {
        int t_ = threadIdx.x; asm volatile("" : "+v"(t_));
        if (t_ < 64) {
            const LAS int* T = (const LAS int*)((LAS unsigned char*)lds_raw + TBL_OFF);
            int ea, eb; moe_pair(T[128 + u.pm], ea, eb);
            const unsigned na = 16u * (unsigned)((T[560 + ea] + 255) >> 8), nb = 16u * (unsigned)((T[560 + eb] + 255) >> 8);
            unsigned polls = 0u;
            while ((unsigned)__builtin_amdgcn_readfirstlane(__hip_atomic_load(edone + ea * MOE_CS, __ATOMIC_RELAXED, __HIP_MEMORY_SCOPE_AGENT)) < na ||
                   (unsigned)__builtin_amdgcn_readfirstlane(__hip_atomic_load(edone + eb * MOE_CS, __ATOMIC_RELAXED, __HIP_MEMORY_SCOPE_AGENT)) < nb) {
                if ((++polls & 255u) == 0u) { if (__builtin_amdgcn_readfirstlane(__hip_atomic_load(tmo, __ATOMIC_RELAXED, __HIP_MEMORY_SCOPE_AGENT)) != 0u) break;
                    if (polls > (1u << 22)) { if (t_ == 0) __hip_atomic_store(tmo, 1u, __ATOMIC_RELAXED, __HIP_MEMORY_SCOPE_AGENT); break; } }
                __builtin_amdgcn_s_sleep(2); }
            __builtin_amdgcn_fence(__ATOMIC_ACQUIRE, "agent");
            asm volatile("s_waitcnt vmcnt(0)" ::: "memory");
        }
        asm volatile("" ::: "memory"); __builtin_amdgcn_s_barrier(); asm volatile("" ::: "memory");
    }
    __device__ __forceinline__ void done(const pg8::Unit&) const {} };
struct EpiMoeH {
    static constexpr bool PERM = true, AFTER_DRAIN = false;
    bf16* hb; const u32x4* rec;
    __device__ __forceinline__ void operator()(const pg8::f32x4 (&acc)[2][2][4][2], const pg8::Unit& u, int wr, int wc, int fr, int fq) const {
        { int t_ = threadIdx.x; asm volatile("" : "+v"(t_)); fr = t_ & 15; fq = (t_ >> 4) & 3; }
        const LAS int* T = (const LAS int*)((LAS unsigned char*)lds_raw + TBL_OFF);
        const int ex = T[608 + u.pm], vr0 = (u.pm - T[512 + ex]) * 256, nex = T[560 + ex];
#pragma unroll
        for (int ai = 0; ai < 2; ++ai) {
            u32x4 q4[4];
#pragma unroll
            for (int m = 0; m < 4; ++m) q4[m] = *(const u32x4*)((const char*)rec + (unsigned)(ex * 32768 + vr0 + ai * 128 + wr * 64 + m * 16 + fr) * 16u);
#pragma unroll
            for (int m = 0; m < 4; ++m) { asm volatile("" : "+v"(q4[m]));
            }
#pragma unroll
            for (int m = 0; m < 4; ++m) { const int rr = ai * 128 + wr * 64 + m * 16 + fr; const bool valid = vr0 + rr < nex;
                const u32x4 q = q4[m]; const float w = __uint_as_float(q.y), rs = __uint_as_float(q.z);
                const int slot = (int)((q.w >> 15) & 1u); const unsigned row = (unsigned)T[valid ? (q.w >> 16) : 0u] * 256u + (q.w & 0x7fffu);
#pragma unroll
                for (int bj = 0; bj < 2; ++bj) { const int j0 = (u.pn & 1) * 128 + (bj * 128 + wc * 32 + 8 * fq) / 2;
                    pg8::f32x4 v0 = acc[ai][bj][m][0], v1 = acc[ai][bj][m][1];
#pragma unroll
                    for (int e = 0; e < 4; ++e) { v0[e] *= rs; v1[e] *= rs; }
                    const float h0 = v0[0] * __builtin_amdgcn_rcpf(1.f + __builtin_amdgcn_exp2f(-v0[0] * LOG2E)) * v0[1] * w, h1 = v0[2] * __builtin_amdgcn_rcpf(1.f + __builtin_amdgcn_exp2f(-v0[2] * LOG2E)) * v0[3] * w;
                    const float h2 = v1[0] * __builtin_amdgcn_rcpf(1.f + __builtin_amdgcn_exp2f(-v1[0] * LOG2E)) * v1[1] * w, h3 = v1[2] * __builtin_amdgcn_rcpf(1.f + __builtin_amdgcn_exp2f(-v1[2] * LOG2E)) * v1[3] * w;
                    const int jg = slot * 256 + j0;
                    if (valid) __hip_atomic_store((u64*)((char*)hb + (((row >> 4) * 32u + (unsigned)(jg >> 4)) * 256u + (row & 15u) * 16u + (unsigned)(jg & 15)) * 2u), (u64)pg8::cvt_pk_bf16(h0, h1) | ((u64)pg8::cvt_pk_bf16(h2, h3) << 32),
                                                  __ATOMIC_RELAXED, __HIP_MEMORY_SCOPE_AGENT); }
            }
            asm volatile("" ::: "memory"); }
    }
};
struct EpiMoeOut {
    static constexpr bool PERM = true, AFTER_DRAIN = false;
    bf16* x; const unsigned* rec;
    __device__ __forceinline__ void operator()(const pg8::f32x4 (&acc)[2][2][4][2], const pg8::Unit& u, int wr, int wc, int fr, int fq) const {
        { int t_ = threadIdx.x; asm volatile("" : "+v"(t_)); fr = t_ & 15; fq = (t_ >> 4) & 3; }
        bf16* xx = x; const unsigned* rt = rec; asm volatile("" : "+s"(xx), "+s"(rt));
        const LAS int* T = (const LAS int*)((LAS unsigned char*)lds_raw + TBL_OFF);
        const int cls = T[128 + u.pm], vr0 = (u.pm - T[cls]) * 256, ncls = T[384 + cls];
        int tok[2][4];
#pragma unroll
        for (int ai = 0; ai < 2; ++ai)
#pragma unroll
            for (int m = 0; m < 4; ++m) { const int rr = ai * 128 + wr * 64 + m * 16 + fr; tok[ai][m] = -1; if (vr0 + rr < ncls) tok[ai][m] = (int)rt[(size_t)cls * 32768 + vr0 + rr]; }
#pragma unroll
        for (int ai = 0; ai < 2; ++ai)
#pragma unroll
            for (int m = 0; m < 4; ++m) asm volatile("" : "+v"(tok[ai][m]));
#pragma unroll
        for (int ai = 0; ai < 2; ++ai) { u32x4 w[4][2];
#pragma unroll
            for (int m = 0; m < 4; ++m)
#pragma unroll
                for (int bj = 0; bj < 2; ++bj) w[m][bj] = *(const u32x4*)(xx + (size_t)(tok[ai][m] >= 0 ? tok[ai][m] : 0) * D_ + u.pn * 256 + wc * 32 + 8 * fq + bj * 128);
#pragma unroll
            for (int m = 0; m < 4; ++m)
#pragma unroll
                for (int bj = 0; bj < 2; ++bj) asm volatile("" : "+v"(w[m][bj]));
#pragma unroll
            for (int m = 0; m < 4; ++m) if (tok[ai][m] >= 0) {
#pragma unroll
                for (int bj = 0; bj < 2; ++bj) *(u32x4*)(xx + (size_t)tok[ai][m] * D_ + u.pn * 256 + wc * 32 + 8 * fq + bj * 128) = res_add8(w[m][bj], acc[ai][bj][m][0], acc[ai][bj][m][1]); } }
    }
};

__device__ __forceinline__ void transpose_item(const float* W, int ldw, bf16* WT, int ldt, int r0, int rmul, int k0, LAS float* scr, int lane, const float* gk = nullptr) {
    f32x4 v[8];
#pragma unroll
    for (int i = 0; i < 8; ++i) v[i] = *(const f32x4*)(W + (size_t)(k0 + i * 8 + (lane >> 3)) * ldw + (lane & 7) * 4);
    if (gk) { float gsc[8];
#pragma unroll
        for (int i = 0; i < 8; ++i) gsc[i] = gk[k0 + i * 8 + (lane >> 3)];
#pragma unroll
        for (int i = 0; i < 8; ++i) asm volatile("" : "+v"(gsc[i]));
#pragma unroll
        for (int i = 0; i < 8; ++i) { v[i].x *= gsc[i]; v[i].y *= gsc[i]; v[i].z *= gsc[i]; v[i].w *= gsc[i]; } }
#pragma unroll
    for (int i = 0; i < 8; ++i) { LAS float* d = scr + (i * 8 + (lane >> 3)) * 33 + (lane & 7) * 4; d[0] = v[i].x; d[1] = v[i].y; d[2] = v[i].z; d[3] = v[i].w; }
    asm volatile("s_waitcnt lgkmcnt(0)" ::: "memory");
    const int c = lane & 7;
#pragma unroll
    for (int j = 0; j < 4; ++j) { const int n = (lane >> 3) + 8 * j; const LAS float* sp = scr + (8 * c) * 33 + n;
        u32x4 o; o.x = pk2(sp[0 * 33], sp[1 * 33]); o.y = pk2(sp[2 * 33], sp[3 * 33]); o.z = pk2(sp[4 * 33], sp[5 * 33]); o.w = pk2(sp[6 * 33], sp[7 * 33]);
        *(u32x4*)(WT + (size_t)(r0 + rmul * n) * ldt + k0 + 8 * c) = o; }
    asm volatile("s_waitcnt lgkmcnt(0)" ::: "memory");
}
__device__ __forceinline__ void transpose_seg(const float* W, int ldw, int K, int sc0, int ncol, bf16* WT, int r0, int rmul, int item, LAS float* scr, int lane, const float* gk = nullptr) {
    const int nb = ncol / 32, kb = item / nb, cb = item % nb;
    transpose_item(W + sc0 + cb * 32, ldw, WT, K, r0 + rmul * cb * 32, rmul, kb * 64, scr, lane, gk);
}

typedef float f32x16 __attribute__((ext_vector_type(16)));
typedef short bf16x8v __attribute__((ext_vector_type(8)));
typedef short s16x4 __attribute__((ext_vector_type(4)));
typedef float f32x2_t __attribute__((ext_vector_type(2)));
typedef __bf16 bf16x2_t __attribute__((ext_vector_type(2)));
constexpr int A_KBUF = 10240, A_VBUF = 12288;
constexpr int A_KOFF = 0, A_VOFF = 2 * A_KBUF, A_BOFF = A_VOFF + 2 * A_VBUF, A_BTILE = 8 * 256, A_LDS_END = A_BOFF + 2 * A_BTILE;
__device__ __forceinline__ constexpr int crow0(int reg) { return (reg & 3) + 8 * (reg >> 2); }
__device__ __forceinline__ float swap_max(float m) { auto rr = __builtin_amdgcn_permlane32_swap(__float_as_uint(m), __float_as_uint(m), false, false); return fmaxf(__uint_as_float(rr[0]), __uint_as_float(rr[1])); }
__device__ __forceinline__ float swap_sum(float m) { auto rr = __builtin_amdgcn_permlane32_swap(__float_as_uint(m), __float_as_uint(m), false, false); return __uint_as_float(rr[0]) + __uint_as_float(rr[1]); }
__device__ __forceinline__ unsigned cvtpk(float lo, float hi) { f32x2_t v = {lo, hi}; bf16x2_t b = __builtin_convertvector(v, bf16x2_t); return __builtin_bit_cast(unsigned, b); }
__device__ __forceinline__ bf16x8v pack8(const f32x16& p, int b0) { u32x4 w; w.x = cvtpk(p[b0 + 0], p[b0 + 1]); w.y = cvtpk(p[b0 + 2], p[b0 + 3]); w.z = cvtpk(p[b0 + 4], p[b0 + 5]); w.w = cvtpk(p[b0 + 6], p[b0 + 7]); return __builtin_bit_cast(bf16x8v, w); }
__device__ __forceinline__ s16x4 tr_read(const LAS unsigned char* p) { typedef short v4i16_t __attribute__((ext_vector_type(4))); return __builtin_bit_cast(s16x4, __builtin_amdgcn_ds_read_tr16_b64_v4i16((LAS v4i16_t*)p)); }

template <int DQK>
__device__ __forceinline__ void attn_preload(const bf16* Kb0, const bf16* Kb1, const bf16* Vb, int j, int tid, u32x4& kreg, u32x4& vreg) {
    const bf16* ksrc;
    if (DQK == 64) ksrc = Kb0 + b64_off(tid >> 3, (tid & 7) * 8); else { const int mp = tid >> 8, tt = tid & 255; ksrc = (mp ? Kb1 : Kb0) + (tt >> 2) * 32 + (tt & 3) * 8; }
    const bf16* vsrc = Vb + b64_off(tid >> 3, (tid & 7) * 8);
    kreg = *(const u32x4*)(ksrc + (size_t)(j * 64) * DQK); vreg = *(const u32x4*)(vsrc + (size_t)(j * 64) * 64);
}
template <int DQK, int NMAP, bool FOX, bool SLC, bool PRE = false, bool NOMAX = false>
__device__ __forceinline__ void attn_core(LAS unsigned char* L, const bf16* Kb0, const bf16* Kb1, const bf16* Vb, const LAS float* cum, float cum_ref,
                                          const bf16x8v (&Qf)[NMAP][DQK / 16], u64 tilemask, int t_lane, int tw0, int win, float slope2, unsigned selw0, unsigned selw1,
                                          f32x16 (&O)[NMAP][2], float (&M)[NMAP], float (&Ls)[NMAP], int tid, bool started0 = false, int jpre = 0, u32x4 kpre = (u32x4){0u, 0u, 0u, 0u}, u32x4 vpre = (u32x4){0u, 0u, 0u, 0u}) {
    constexpr int KP = DQK * 2 + 16, VP = 192;
    const int lane = tid & 63, r = lane & 31, h = lane >> 5;
    int kdst; const bf16* ksrc;
    if (DQK == 64) { kdst = (tid >> 3) * KP + (tid & 7) * 16; ksrc = Kb0 + b64_off(tid >> 3, (tid & 7) * 8); }
    else { const int mp = tid >> 8, tt = tid & 255; kdst = mp * 5120 + (tt >> 2) * KP + (tt & 3) * 16; ksrc = (mp ? Kb1 : Kb0) + (tt >> 2) * 32 + (tt & 3) * 8; }
    const int vdst = (tid >> 3) * VP + (tid & 7) * 16; const bf16* vsrc = Vb + b64_off(tid >> 3, (tid & 7) * 8);
    const LAS unsigned char* kfrag = L + A_KOFF + r * KP + h * 16;
    const LAS unsigned char* vfrag = L + A_VOFF + (4 * h + ((lane & 15) >> 2)) * VP + (16 * ((lane >> 4) & 1) + 4 * (lane & 3)) * 2;
    u32x4 kreg, vreg; float breg = 0.f;
    u64 mk = tilemask;
    int j = PRE ? jpre : 63 - __builtin_clzll(mk); mk &= ~(1ull << j);
    { const int kv0 = j * 64; if (PRE) { kreg = kpre; vreg = vpre; } else { kreg = *(const u32x4*)(ksrc + (size_t)kv0 * DQK); vreg = *(const u32x4*)(vsrc + (size_t)kv0 * 64); } if (FOX) breg = (cum_ref - cum[kv0 + lane]) * LOG2E; }
    *(LAS u32x4*)(L + A_KOFF + kdst) = kreg; *(LAS u32x4*)(L + A_VOFF + vdst) = vreg; if (FOX) *(LAS float*)(L + A_BOFF + tid * 4) = breg;
    __syncthreads();
    int buf = 0; bool started = started0;
    float pdummy = 0.f; int idummy = 0; f32x16 dm0; for (int i = 0; i < 16; ++i) dm0[i] = 0.f;
    for (;;) {
        const bool more = mk != 0ull; int jn = 0;
        if (more) { jn = 63 - __builtin_clzll(mk); mk &= ~(1ull << jn); const int kv0 = jn * 64;
            kreg = *(const u32x4*)(ksrc + (size_t)kv0 * DQK); vreg = *(const u32x4*)(vsrc + (size_t)kv0 * 64); if (FOX) breg = (cum_ref - cum[kv0 + lane]) * LOG2E; }
        { const int kv0 = j * 64;
          bool wave_has = true; float selb = 0.f;
          if (SLC) { const bool mine = ((j < 32 ? (selw0 >> j) : (selw1 >> (j - 32))) & 1u) != 0u; selb = mine ? 0.f : -INFINITY; wave_has = __any(mine); }
          if (wave_has && !(kv0 > tw0 + 31) && !(tw0 - (kv0 + 63) >= win)) {
            const bool need_mask = (kv0 + 63 > tw0) || (tw0 + 31 - kv0 >= win);
            const int dl = t_lane - kv0 - 4 * h;
            bf16x8v pa[NMAP][4];
#pragma unroll
            for (int mp = 0; mp < NMAP; ++mp) {
                f32x16 p0, p1;
                if (FOX) { const LAS f32x4* bl = (const LAS f32x4*)(L + A_BOFF + buf * A_BTILE + (tid >> 6) * 256) + h; const float mm = NOMAX ? 0.f : M[mp];
#pragma unroll
                    for (int g4 = 0; g4 < 4; ++g4) { const f32x4 b0 = bl[2 * g4], b1 = bl[8 + 2 * g4];
                        p0[4 * g4 + 0] = b0.x - mm; p0[4 * g4 + 1] = b0.y - mm; p0[4 * g4 + 2] = b0.z - mm; p0[4 * g4 + 3] = b0.w - mm; p1[4 * g4 + 0] = b1.x - mm; p1[4 * g4 + 1] = b1.y - mm; p1[4 * g4 + 2] = b1.z - mm; p1[4 * g4 + 3] = b1.w - mm; } }
                else { const float base_l = (slope2 * (float)(kv0 + 4 * h - tw0) - (NOMAX ? 0.f : M[mp])) + selb, s8 = slope2 * 8.f, s32 = slope2 * 32.f;
                    p0[0] = base_l; p0[1] = p0[0] + slope2; p0[2] = p0[1] + slope2; p0[3] = p0[2] + slope2;
#pragma unroll
                    for (int reg = 4; reg < 16; ++reg) p0[reg] = p0[reg - 4] + s8;
#pragma unroll
                    for (int reg = 0; reg < 16; ++reg) p1[reg] = p0[reg] + s32; }
                const LAS unsigned char* kb = kfrag + buf * A_KBUF + (DQK == 32 ? mp * 5120 : 0);
#pragma unroll
                for (int s = 0; s < DQK / 16; ++s) { const bf16x8v kf0 = *(const LAS bf16x8v*)(kb + s * 32), kf1 = *(const LAS bf16x8v*)(kb + 32 * KP + s * 32);
#ifdef PROBE_X_LDSK
                    { const bf16x8v z0 = *(const volatile LAS bf16x8v*)(kb + s * 32), z1 = *(const volatile LAS bf16x8v*)(kb + 32 * KP + s * 32); idummy ^= z0[0] ^ z1[1]; }
#endif
#ifdef PROBE_X_MFMA
                    dm0 = __builtin_amdgcn_mfma_f32_32x32x16_bf16(kf0, Qf[mp][s], dm0, 0, 0, 0); dm0 = __builtin_amdgcn_mfma_f32_32x32x16_bf16(kf1, Qf[mp][s], dm0, 0, 0, 0);
#endif
                    p0 = __builtin_amdgcn_mfma_f32_32x32x16_bf16(kf0, Qf[mp][s], p0, 0, 0, 0); p1 = __builtin_amdgcn_mfma_f32_32x32x16_bf16(kf1, Qf[mp][s], p1, 0, 0, 0); }
                if (need_mask) {
#pragma unroll
                    for (int reg = 0; reg < 16; ++reg) { const int d0 = dl - crow0(reg), d1 = d0 - 32;
                        p0[reg] = (d0 >= 0 && d0 < win) ? p0[reg] : -INFINITY; p1[reg] = (d1 >= 0 && d1 < win) ? p1[reg] : -INFINITY; } }
                if (!NOMAX) {
                float mt = fmaxf(fmaxf(p0[0], p1[0]), fmaxf(p0[1], p1[1]));
#pragma unroll
                for (int reg = 2; reg < 16; reg += 2) mt = fmaxf(fmaxf(mt, fmaxf(fmaxf(p0[reg], p1[reg]), p0[reg + 1])), p1[reg + 1]);
                mt = swap_max(mt);
                if (!started || __any(mt > 8.f)) {
                    const float d = (mt > -1e30f) ? (started ? fmaxf(mt, 0.f) : mt) : 0.f, alpha = __builtin_amdgcn_exp2f(-d);
                    O[mp][0] *= alpha; O[mp][1] *= alpha; Ls[mp] *= alpha; M[mp] += d;
#pragma unroll
                    for (int reg = 0; reg < 16; ++reg) { p0[reg] -= d; p1[reg] -= d; } } }
                float rs = 0.f;
#ifdef PROBE_X_EXP
#pragma unroll
                for (int reg = 0; reg < 16; ++reg) { pdummy += __builtin_amdgcn_exp2f(p0[reg] - 1.f) + __builtin_amdgcn_exp2f(p1[reg] - 1.f); }
#endif
#pragma unroll
                for (int reg = 0; reg < 16; ++reg) { p0[reg] = __builtin_amdgcn_exp2f(p0[reg]); p1[reg] = __builtin_amdgcn_exp2f(p1[reg]); rs += p0[reg] + p1[reg]; }
                Ls[mp] += rs;
                pa[mp][0] = pack8(p0, 0); pa[mp][1] = pack8(p0, 8); pa[mp][2] = pack8(p1, 0); pa[mp][3] = pack8(p1, 8);
            }
            started = true;
            const LAS unsigned char* vb = vfrag + buf * A_VBUF;
#pragma unroll
            for (int db = 0; db < 2; ++db)
#pragma unroll
                for (int ks = 0; ks < 4; ++ks) { const s16x4 lo = tr_read(vb + ks * (16 * VP) + db * 64), hi = tr_read(vb + ks * (16 * VP) + db * 64 + 8 * VP);
                    const bf16x8v vf = {lo[0], lo[1], lo[2], lo[3], hi[0], hi[1], hi[2], hi[3]};
#pragma unroll
                    for (int mp = 0; mp < NMAP; ++mp) O[mp][db] = __builtin_amdgcn_mfma_f32_32x32x16_bf16(vf, pa[mp][ks], O[mp][db], 0, 0, 0); }
          } }
        if (more) { *(LAS u32x4*)(L + A_KOFF + (buf ^ 1) * A_KBUF + kdst) = kreg; *(LAS u32x4*)(L + A_VOFF + (buf ^ 1) * A_VBUF + vdst) = vreg; if (FOX) *(LAS float*)(L + A_BOFF + (buf ^ 1) * A_BTILE + tid * 4) = breg; }
#ifdef PROBE_X_BAR
        __syncthreads();
#endif
        __syncthreads();
        if (!more) break;
        j = jn; buf ^= 1;
    }
    if (pdummy == 123.456f || idummy == 0x7fffabcd || dm0[3] == 98765.4321f) Ls[0] += 1e-30f;
}
#ifndef AC2_MODE
#define AC2_MODE 0
#endif
#ifndef AC2_INIT_VALU
#define AC2_INIT_VALU 24
#endif
template <bool FOX, bool SLC>
__device__ __forceinline__ void attn_core2(LAS unsigned char* L, const bf16* Kb0, const bf16* Vb, const LAS float* cum, float cum_ref,
                                           const bf16x8v (&Qf)[4], u64 tilemask, int t_lane, int tw0, int win, float slope2, unsigned selw0, unsigned selw1,
                                           f32x16 (&O)[2], float& M, float& Ls, int tid) {
    constexpr int KP = 144, VP = 192;
    const int lane = tid & 63, r = lane & 31, h = lane >> 5;
    const int kdst = (tid >> 3) * KP + (tid & 7) * 16; const bf16* ksrc = Kb0 + b64_off(tid >> 3, (tid & 7) * 8);
    const int vdst = (tid >> 3) * VP + (tid & 7) * 16; const bf16* vsrc = Vb + b64_off(tid >> 3, (tid & 7) * 8);
    const LAS unsigned char* kfrag = L + A_KOFF + r * KP + h * 16;
    const LAS unsigned char* vfrag = L + A_VOFF + (4 * h + ((lane & 15) >> 2)) * VP + (16 * ((lane >> 4) & 1) + 4 * (lane & 3)) * 2;
#define AC2_ACTIVE(jj) (!((jj) * 64 > tw0 + 31) && !(tw0 - ((jj) * 64 + 63) >= win))
#define AC2_INIT(jj, kslot, q0, q1) do { const int kv0_ = (jj) * 64; \
        if (FOX) { const LAS f32x4* bl = (const LAS f32x4*)(L + A_BOFF + (kslot) * 256) + h; const float mm = M; \
            _Pragma("unroll") for (int g4 = 0; g4 < 4; ++g4) { const f32x4 b0 = bl[2 * g4], b1 = bl[8 + 2 * g4]; \
                q0[4 * g4 + 0] = b0.x - mm; q0[4 * g4 + 1] = b0.y - mm; q0[4 * g4 + 2] = b0.z - mm; q0[4 * g4 + 3] = b0.w - mm; q1[4 * g4 + 0] = b1.x - mm; q1[4 * g4 + 1] = b1.y - mm; q1[4 * g4 + 2] = b1.z - mm; q1[4 * g4 + 3] = b1.w - mm; } } \
        else { float selb = 0.f; if (SLC) selb = ((((jj) < 32) ? (selw0 >> (jj)) : (selw1 >> ((jj) - 32))) & 1u) ? 0.f : -INFINITY; \
            const float base_l = (slope2 * (float)(kv0_ + 4 * h - tw0) - M) + selb, s8 = slope2 * 8.f, s32 = slope2 * 32.f; \
            q0[0] = base_l; q0[1] = q0[0] + slope2; q0[2] = q0[1] + slope2; q0[3] = q0[2] + slope2; \
            _Pragma("unroll") for (int reg = 4; reg < 16; ++reg) q0[reg] = q0[reg - 4] + s8; \
            _Pragma("unroll") for (int reg = 0; reg < 16; ++reg) q1[reg] = q0[reg] + s32; } } while (0)
#define AC2_QK(jj, kslot) do { AC2_INIT(jj, kslot, p0, p1); \
        const LAS unsigned char* kb_ = kfrag + (kslot) * A_KBUF; \
        _Pragma("unroll") for (int s_ = 0; s_ < 4; ++s_) { const bf16x8v kf0 = *(const LAS bf16x8v*)(kb_ + s_ * 32), kf1 = *(const LAS bf16x8v*)(kb_ + 32 * KP + s_ * 32); \
            p0 = __builtin_amdgcn_mfma_f32_32x32x16_bf16(kf0, Qf[s_], p0, 0, 0, 0); p1 = __builtin_amdgcn_mfma_f32_32x32x16_bf16(kf1, Qf[s_], p1, 0, 0, 0); } } while (0)
    u32x4 kreg, vreg; float breg = 0.f;
    u64 mk = tilemask;
    int j = 63 - __builtin_clzll(mk); mk &= ~(1ull << j);
    int jn = -1; if (mk) { jn = 63 - __builtin_clzll(mk); mk &= ~(1ull << jn); }
    { kreg = *(const u32x4*)(ksrc + (size_t)j * 64 * 64); vreg = *(const u32x4*)(vsrc + (size_t)j * 64 * 64); if (FOX && tid < 64) breg = (cum_ref - cum[j * 64 + tid]) * LOG2E;
      *(LAS u32x4*)(L + A_KOFF + kdst) = kreg; *(LAS u32x4*)(L + A_VOFF + vdst) = vreg; if (FOX && tid < 64) *(LAS float*)(L + A_BOFF + tid * 4) = breg;
      if (jn >= 0) { kreg = *(const u32x4*)(ksrc + (size_t)jn * 64 * 64); if (FOX && tid < 64) breg = (cum_ref - cum[jn * 64 + tid]) * LOG2E;
          *(LAS u32x4*)(L + A_KOFF + A_KBUF + kdst) = kreg; if (FOX && tid < 64) *(LAS float*)(L + A_BOFF + 256 + tid * 4) = breg; } }
    __syncthreads();
    f32x16 p0, p1;
    bool started = false;
    int ks = 0, vs = 0;
    if (AC2_ACTIVE(j)) AC2_QK(j, 0);
    for (;;) {
        int jnn = -1; if (mk) { jnn = 63 - __builtin_clzll(mk); mk &= ~(1ull << jnn); }
        if (jnn >= 0) { kreg = *(const u32x4*)(ksrc + (size_t)jnn * 64 * 64); if (FOX && tid < 64) breg = (cum_ref - cum[jnn * 64 + tid]) * LOG2E; }
        if (jn >= 0) vreg = *(const u32x4*)(vsrc + (size_t)jn * 64 * 64);
        const bool act = AC2_ACTIVE(j), actn = jn >= 0 && AC2_ACTIVE(jn);
        if (act) {
            const int kv0 = j * 64;
            if ((kv0 + 63 > tw0) || (tw0 + 31 - kv0 >= win)) { const int dl = t_lane - kv0 - 4 * h;
#pragma unroll
                for (int reg = 0; reg < 16; ++reg) { const int d0 = dl - crow0(reg), d1 = d0 - 32;
                    p0[reg] = (d0 >= 0 && d0 < win) ? p0[reg] : -INFINITY; p1[reg] = (d1 >= 0 && d1 < win) ? p1[reg] : -INFINITY; } }
            float mt = fmaxf(fmaxf(p0[0], p1[0]), fmaxf(p0[1], p1[1]));
#pragma unroll
            for (int reg = 2; reg < 16; reg += 2) mt = fmaxf(fmaxf(mt, fmaxf(fmaxf(p0[reg], p1[reg]), p0[reg + 1])), p1[reg + 1]);
            mt = swap_max(mt);
            if (!started || __any(mt > 8.f)) {
                const float d = (mt > -1e30f) ? (started ? fmaxf(mt, 0.f) : mt) : 0.f, alpha = __builtin_amdgcn_exp2f(-d);
                O[0] *= alpha; O[1] *= alpha; Ls *= alpha; M += d;
#pragma unroll
                for (int reg = 0; reg < 16; ++reg) { p0[reg] -= d; p1[reg] -= d; } }
            started = true;
#if AC2_MODE == 1
            {
                const int jq = jn >= 0 ? jn : 0;
                float rs = 0.f;
#pragma unroll
                for (int reg = 0; reg < 16; ++reg) { p0[reg] = __builtin_amdgcn_exp2f(p0[reg]); p1[reg] = __builtin_amdgcn_exp2f(p1[reg]); rs += p0[reg] + p1[reg]; }
                Ls += rs;
                const bf16x8v pa0 = pack8(p0, 0), pa1 = pack8(p0, 8), pa2 = pack8(p1, 0), pa3 = pack8(p1, 8);
                AC2_QK(jq, ks ^ 1);
                const LAS unsigned char* vb = vfrag + vs * A_VBUF;
#pragma unroll
                for (int db = 0; db < 2; ++db)
#pragma unroll
                    for (int kq = 0; kq < 4; ++kq) { const s16x4 lo = tr_read(vb + kq * (16 * VP) + db * 64), hi = tr_read(vb + kq * (16 * VP) + db * 64 + 8 * VP);
                        const bf16x8v vf = {lo[0], lo[1], lo[2], lo[3], hi[0], hi[1], hi[2], hi[3]};
                        O[db] = __builtin_amdgcn_mfma_f32_32x32x16_bf16(vf, kq == 0 ? pa0 : kq == 1 ? pa1 : kq == 2 ? pa2 : pa3, O[db], 0, 0, 0); }
            }
#else
            {
                const int jq = jn >= 0 ? jn : 0;
                f32x16 n0, n1;
                AC2_INIT(jq, ks ^ 1, n0, n1);
                const LAS unsigned char* kb_ = kfrag + (ks ^ 1) * A_KBUF;
                bf16x8v kf[8];
#pragma unroll
                for (int s_ = 0; s_ < 4; ++s_) { kf[2 * s_] = *(const LAS bf16x8v*)(kb_ + s_ * 32); kf[2 * s_ + 1] = *(const LAS bf16x8v*)(kb_ + 32 * KP + s_ * 32); }
                const LAS unsigned char* vb = vfrag + vs * A_VBUF;
                __builtin_amdgcn_sched_barrier(0);
                float ra = 0.f, rb = 0.f; unsigned w[16];
#define AC2_PINF(x) asm volatile("" : "+v"(x))
#define AC2_QGAP(i) do { if ((i) & 1) n1 = __builtin_amdgcn_mfma_f32_32x32x16_bf16(kf[i], Qf[(i) >> 1], n1, 0, 0, 0); else n0 = __builtin_amdgcn_mfma_f32_32x32x16_bf16(kf[i], Qf[(i) >> 1], n0, 0, 0, 0); \
                    float e0 = __builtin_amdgcn_exp2f(p0[2 * (i)]), e1 = __builtin_amdgcn_exp2f(p0[2 * (i) + 1]), e2 = __builtin_amdgcn_exp2f(p1[2 * (i)]), e3 = __builtin_amdgcn_exp2f(p1[2 * (i) + 1]); \
                    ra += e0 + e1; rb += e2 + e3; \
                    AC2_PINF(e0); AC2_PINF(e1); AC2_PINF(e2); AC2_PINF(e3); AC2_PINF(ra); AC2_PINF(rb); \
                    p0[2 * (i)] = e0; p0[2 * (i) + 1] = e1; p1[2 * (i)] = e2; p1[2 * (i) + 1] = e3; \
                    if ((i) >= 4) { w[2 * ((i) - 4)] = cvtpk(p0[4 * ((i) - 4)], p0[4 * ((i) - 4) + 1]); w[2 * ((i) - 4) + 1] = cvtpk(p0[4 * ((i) - 4) + 2], p0[4 * ((i) - 4) + 3]); AC2_PINF(w[2 * ((i) - 4)]); AC2_PINF(w[2 * ((i) - 4) + 1]); } \
                    if ((i) == 6) { vl[0] = tr_read(vb); vh[0] = tr_read(vb + 8 * VP); } \
                    if ((i) == 7) { vl[1] = tr_read(vb + 64); vh[1] = tr_read(vb + 64 + 8 * VP); } \
                    __builtin_amdgcn_sched_barrier(0); } while (0)
                s16x4 vl[2], vh[2];
                AC2_QGAP(0); AC2_QGAP(1); AC2_QGAP(2); AC2_QGAP(3); AC2_QGAP(4); AC2_QGAP(5); AC2_QGAP(6); AC2_QGAP(7);
                Ls += ra + rb;
#define AC2_PA(kq) __builtin_bit_cast(bf16x8v, (u32x4){w[4 * (kq)], w[4 * (kq) + 1], w[4 * (kq) + 2], w[4 * (kq) + 3]})
#define AC2_PGAP(g) do { const int kq_ = (g) >> 1, db_ = (g) & 1; const bf16x8v vf = {vl[(g) & 1][0], vl[(g) & 1][1], vl[(g) & 1][2], vl[(g) & 1][3], vh[(g) & 1][0], vh[(g) & 1][1], vh[(g) & 1][2], vh[(g) & 1][3]}; \
                    if ((g) < 6) { const int kq2 = ((g) + 2) >> 1, db2 = (g) & 1; vl[(g) & 1] = tr_read(vb + kq2 * (16 * VP) + db2 * 64); vh[(g) & 1] = tr_read(vb + kq2 * (16 * VP) + db2 * 64 + 8 * VP); } \
                    O[db_] = __builtin_amdgcn_mfma_f32_32x32x16_bf16(vf, AC2_PA(kq_), O[db_], 0, 0, 0); \
                    if ((g) < 4) { w[8 + 2 * (g)] = cvtpk(p1[4 * (g)], p1[4 * (g) + 1]); w[8 + 2 * (g) + 1] = cvtpk(p1[4 * (g) + 2], p1[4 * (g) + 3]); AC2_PINF(w[8 + 2 * (g)]); AC2_PINF(w[8 + 2 * (g) + 1]); } \
                    __builtin_amdgcn_sched_barrier(0); } while (0)
                AC2_PGAP(0); AC2_PGAP(1); AC2_PGAP(2); AC2_PGAP(3); AC2_PGAP(4); AC2_PGAP(5); AC2_PGAP(6); AC2_PGAP(7);
#undef AC2_PGAP
#undef AC2_PA
#undef AC2_QGAP
#undef AC2_PINF
                p0 = n0; p1 = n1;
            }
#endif
        } else if (actn) AC2_QK(jn, ks ^ 1);
        if (jnn >= 0) { *(LAS u32x4*)(L + A_KOFF + ks * A_KBUF + kdst) = kreg; if (FOX && tid < 64) *(LAS float*)(L + A_BOFF + ks * 256 + tid * 4) = breg; }
        if (jn >= 0) *(LAS u32x4*)(L + A_VOFF + (vs ^ 1) * A_VBUF + vdst) = vreg;
        __syncthreads();
        if (jn < 0) break;
        j = jn; jn = jnn; ks ^= 1; vs ^= 1;
    }
#undef AC2_QK
#undef AC2_INIT
#undef AC2_ACTIVE
}
__device__ __forceinline__ size_t mix_off(size_t n, int c, int W) { return ((n >> 5) * (size_t)(W / 8) + (size_t)(c >> 3)) * 256 + (n & 31) * 8 + (c & 7); }
#define ATTN_FOR_CHUNKS(db, g4) _Pragma("unroll") for (int db = 0; db < 2; ++db) _Pragma("unroll") for (int g4 = 0; g4 < 4; ++g4)

__device__ __forceinline__ void unpack8(const u32x4 w, float (&f)[8]) { f[0] = __uint_as_float(w.x << 16); f[1] = __uint_as_float(w.x & 0xffff0000u); f[2] = __uint_as_float(w.y << 16); f[3] = __uint_as_float(w.y & 0xffff0000u);
    f[4] = __uint_as_float(w.z << 16); f[5] = __uint_as_float(w.z & 0xffff0000u); f[6] = __uint_as_float(w.w << 16); f[7] = __uint_as_float(w.w & 0xffff0000u); }
__device__ __forceinline__ void ph_norm_bf16_from_bf16(const Ctx& c, const bf16* x, const float* g, bf16* out) {
    constexpr int RB = 4; float gg[2][8];
#pragma unroll
    for (int j = 0; j < 2; ++j) { const f32x4 a = ((const f32x4*)g)[2 * c.lane + 128 * j], b2 = ((const f32x4*)g)[2 * c.lane + 128 * j + 1]; gg[j][0] = a.x; gg[j][1] = a.y; gg[j][2] = a.z; gg[j][3] = a.w; gg[j][4] = b2.x; gg[j][5] = b2.y; gg[j][6] = b2.z; gg[j][7] = b2.w; }
    for (int row0 = c.gw * RB; row0 < NT; row0 += c.ngw * RB) {
        u32x4 v[RB][2];
#pragma unroll
        for (int q = 0; q < RB; ++q)
#pragma unroll
            for (int j = 0; j < 2; ++j) v[q][j] = ((const u32x4*)(x + (size_t)(row0 + q) * D_))[c.lane + 64 * j];
#pragma unroll
        for (int q = 0; q < RB; ++q) { float f[2][8]; float ss = 0.f;
#pragma unroll
            for (int j = 0; j < 2; ++j) { unpack8(v[q][j], f[j]);
#pragma unroll
                for (int e = 0; e < 8; ++e) ss = fmaf(f[j][e], f[j][e], ss); }
            const float r = rsqrtf(wave_sum_l(ss, c.lane) * (1.f / D_) + EPS);
#pragma unroll
            for (int j = 0; j < 2; ++j) { u32x4 o; o.x = pk2(f[j][0] * r * gg[j][0], f[j][1] * r * gg[j][1]); o.y = pk2(f[j][2] * r * gg[j][2], f[j][3] * r * gg[j][3]); o.z = pk2(f[j][4] * r * gg[j][4], f[j][5] * r * gg[j][5]); o.w = pk2(f[j][6] * r * gg[j][6], f[j][7] * r * gg[j][7]);
                ((u32x4*)(out + (size_t)(row0 + q) * D_))[c.lane + 64 * j] = o; } }
    }
}
__device__ __forceinline__ void ph_norm_final_from_bf16(const Ctx& c, const bf16* x, const float* g, float* out) {
    constexpr int RB = 4; float gg[2][8];
#pragma unroll
    for (int j = 0; j < 2; ++j) { const f32x4 a = ((const f32x4*)g)[2 * c.lane + 128 * j], b2 = ((const f32x4*)g)[2 * c.lane + 128 * j + 1]; gg[j][0] = a.x; gg[j][1] = a.y; gg[j][2] = a.z; gg[j][3] = a.w; gg[j][4] = b2.x; gg[j][5] = b2.y; gg[j][6] = b2.z; gg[j][7] = b2.w; }
    for (int row0 = c.gw * RB; row0 < NT; row0 += c.ngw * RB) {
        u32x4 v[RB][2];
#pragma unroll
        for (int q = 0; q < RB; ++q)
#pragma unroll
            for (int j = 0; j < 2; ++j) v[q][j] = ((const u32x4*)(x + (size_t)(row0 + q) * D_))[c.lane + 64 * j];
#pragma unroll
        for (int q = 0; q < RB; ++q) { float f[2][8]; float ss = 0.f;
#pragma unroll
            for (int j = 0; j < 2; ++j) { unpack8(v[q][j], f[j]);
#pragma unroll
                for (int e = 0; e < 8; ++e) ss = fmaf(f[j][e], f[j][e], ss); }
            const float r = rsqrtf(wave_sum_l(ss, c.lane) * (1.f / D_) + EPS);
#pragma unroll
            for (int j = 0; j < 2; ++j) { f32x4* o = (f32x4*)(out + (size_t)(row0 + q) * D_) + 2 * c.lane + 128 * j;
                o[0] = (f32x4){f[j][0] * r * gg[j][0], f[j][1] * r * gg[j][1], f[j][2] * r * gg[j][2], f[j][3] * r * gg[j][3]}; o[1] = (f32x4){f[j][4] * r * gg[j][4], f[j][5] * r * gg[j][5], f[j][6] * r * gg[j][6], f[j][7] * r * gg[j][7]}; } }
    }
}
__device__ __forceinline__ void ph_norm_bf16(const Ctx& c, const float* x, const float* g, bf16* out, bf16* raw) {
    constexpr int RB = 4;
    f32x4 gg[4];
#pragma unroll
    for (int j = 0; j < 4; ++j) gg[j] = ((const f32x4*)g)[c.lane + 64 * j];
    for (int row0 = c.gw * RB; row0 < NT; row0 += c.ngw * RB) {
        f32x4 v[RB][4];
#pragma unroll
        for (int q = 0; q < RB; ++q)
#pragma unroll
            for (int j = 0; j < 4; ++j) v[q][j] = ((const f32x4*)(x + (size_t)(row0 + q) * D_))[c.lane + 64 * j];
#pragma unroll
        for (int q = 0; q < RB; ++q) { float ss = 0.f;
#pragma unroll
            for (int j = 0; j < 4; ++j) ss += v[q][j].x * v[q][j].x + v[q][j].y * v[q][j].y + v[q][j].z * v[q][j].z + v[q][j].w * v[q][j].w;
            const float r = rsqrtf(wave_sum_l(ss, c.lane) * (1.f / D_) + EPS);
            u64* o8 = (u64*)(out + (size_t)(row0 + q) * D_) + c.lane; u64* r8 = (u64*)(raw + (size_t)(row0 + q) * D_) + c.lane;
#pragma unroll
            for (int j = 0; j < 4; ++j) { o8[64 * j] = (u64)pk2(v[q][j].x * r * gg[j].x, v[q][j].y * r * gg[j].y) | ((u64)pk2(v[q][j].z * r * gg[j].z, v[q][j].w * r * gg[j].w) << 32);
                r8[64 * j] = (u64)pk2(v[q][j].x, v[q][j].y) | ((u64)pk2(v[q][j].z, v[q][j].w) << 32); } }
    }
}
__device__ __forceinline__ void ph_norm_final(const Ctx& c, float* x, const float* g) {
    constexpr int RB = 4;
    f32x4 gg[4];
#pragma unroll
    for (int j = 0; j < 4; ++j) gg[j] = ((const f32x4*)g)[c.lane + 64 * j];
    for (int row0 = c.gw * RB; row0 < NT; row0 += c.ngw * RB) {
        f32x4 v[RB][4];
#pragma unroll
        for (int q = 0; q < RB; ++q)
#pragma unroll
            for (int j = 0; j < 4; ++j) v[q][j] = ((const f32x4*)(x + (size_t)(row0 + q) * D_))[c.lane + 64 * j];
#pragma unroll
        for (int q = 0; q < RB; ++q) { float ss = 0.f;
#pragma unroll
            for (int j = 0; j < 4; ++j) ss += v[q][j].x * v[q][j].x + v[q][j].y * v[q][j].y + v[q][j].z * v[q][j].z + v[q][j].w * v[q][j].w;
            const float r = rsqrtf(wave_sum_l(ss, c.lane) * (1.f / D_) + EPS);
            f32x4* xr = (f32x4*)(x + (size_t)(row0 + q) * D_) + c.lane;
#pragma unroll
            for (int j = 0; j < 4; ++j) xr[64 * j] = v[q][j] * r * gg[j]; }
    }
}

template <class AF, class EF>
__device__ __forceinline__ void naive_gemm(const Ctx& c, int M, int N, int K, AF af, const float* W, int ldb, EF ef) {
    LAS float* As = (LAS float*)c.lds;
    LAS float* Bs = As + 16 * 132;
    const int tm = (M + 127) / 128, tn = (N + 127) / 128, ntile = tm * tn;
    const int ty = c.tid >> 4, tx = c.tid & 15;
    for (int tile = c.bid; tile < ntile; tile += c.G) {
        const int m0 = (tile / tn) * 128, n0 = (tile % tn) * 128;
        float acc[4][8];
#pragma unroll
        for (int i = 0; i < 4; ++i)
#pragma unroll
            for (int j = 0; j < 8; ++j) acc[i][j] = 0.f;
        for (int k0 = 0; k0 < K; k0 += 16) {
            __syncthreads();
#pragma unroll
            for (int i = 0; i < 4; ++i) { const int e = c.tid + i * 512, r = e >> 4, kk = e & 15; const int row = m0 + r;
                As[kk * 132 + r] = (row < M) ? af(row, k0 + kk) : 0.f; }
#pragma unroll
            for (int i = 0; i < 4; ++i) { const int e = c.tid + i * 512, kk = e >> 7, cc = e & 127; const int col = n0 + cc;
                Bs[kk * 132 + cc] = (col < N) ? W[(size_t)(k0 + kk) * ldb + col] : 0.f; }
            __syncthreads();
#pragma unroll 2
            for (int kk = 0; kk < 16; ++kk) {
                float a[4], b[8];
#pragma unroll
                for (int i = 0; i < 4; ++i) a[i] = As[kk * 132 + ty * 4 + i];
#pragma unroll
                for (int j = 0; j < 8; ++j) b[j] = Bs[kk * 132 + tx * 8 + j];
#pragma unroll
                for (int i = 0; i < 4; ++i)
#pragma unroll
                    for (int j = 0; j < 8; ++j) acc[i][j] = fmaf(a[i], b[j], acc[i][j]);
            }
        }
        LAS float* Cs = Bs + 16 * 132;
        __syncthreads();
#pragma unroll
        for (int i = 0; i < 4; ++i)
#pragma unroll
            for (int j = 0; j < 8; ++j) Cs[(ty * 4 + i) * 129 + tx * 8 + j] = acc[i][j];
        __syncthreads();
#pragma unroll 1
        for (int e = c.tid; e < 128 * 128; e += NTHREADS) { const int r = e >> 7, cc = e & 127, row = m0 + r, col = n0 + cc; if (row < M && col < N) ef(row, col, Cs[r * 129 + cc]); }
    }
    __syncthreads();
}

struct InProjOut { bf16* qn; bf16* kv6; bf16* fqkv; bf16* dqk; bf16* dv; float* gate; float* fl; const float* b_gate; const float* b_fgt; };
__device__ __forceinline__ void inproj_store(const InProjOut& o, int n, int col, float v) {
    const int b = n / T_, t = n % T_;
    if (col < C_KV6) { const int h = col >> 6, d = col & 63; o.qn[((size_t)(b * 8 + h) * T_ + t) * 64 + d] = (bf16)f2bf(v * (0.125f * LOG2E)); }
    else if (col < C_GATE) { const int cc = col - C_KV6, idx = cc >> 7, g = (cc >> 6) & 1, d = cc & 63;
        ((bf16*)((unsigned char*)o.kv6 + idx * KV6_STRIDE))[((size_t)(b * 2 + g) * T_ + t) * 64 + d] = (bf16)f2bf(v); }
    else if (col < C_FQ) { const int j = col - C_GATE; o.gate[(size_t)n * 24 + j] = sigmoidf_(v + o.b_gate[j]); }
    else if (col < C_FF) { const int cc = col - C_FQ, idx = cc >> 8, h = (cc >> 6) & 3, d = cc & 63;
        o.fqkv[(size_t)idx * (8 * MiB) + ((size_t)(b * 4 + h) * T_ + t) * 64 + d] = (bf16)f2bf(idx == 0 ? v * (0.125f * LOG2E) : v); }
    else if (col < C_DQ) { const int h = col - C_FF; o.fl[(size_t)(b * 4 + h) * T_ + t] = log_sigmoidf_(v + o.b_fgt[h]); }
    else if (col < C_DV) { const int cc = col - C_DQ, idx = cc >> 8, h = (cc >> 6) & 3, i = (cc >> 5) & 1, d = cc & 31;
        o.dqk[(size_t)idx * (8 * MiB) + ((size_t)((b * 4 + h) * 2 + i) * T_ + t) * 32 + d] = (bf16)f2bf(idx == 0 ? v * (0.17677669529663687f * LOG2E) : v); }
    else { const int cc = col - C_DV, h = cc >> 6, d = cc & 63; o.dv[((size_t)(b * 4 + h) * T_ + t) * 64 + d] = (bf16)f2bf(v); }
}

__device__ __forceinline__ void ph_cumsum(const Ctx& c, float* fl) {
    for (int s = c.gw; s < B_ * 4; s += c.ngw) {
        float* p = fl + (size_t)s * T_; float carry = 0.f;
        for (int t0 = 0; t0 < T_; t0 += 64) {
            float v = p[t0 + c.lane];
#pragma unroll
            for (int o = 1; o < 64; o <<= 1) { const float u = __shfl_up(v, o); if (c.lane >= o) v += u; }
            v += carry; p[t0 + c.lane] = v; carry = __shfl(v, 63);
        }
    }
}

template <int DQK>
__device__ __forceinline__ float naive_attn_row(const bf16* q, const bf16* K, const bf16* V, int t, u64 mask, float slope2, const float* cum, int win, int lane) {
    float qv[DQK];
    { const u32x4* q4 = (const u32x4*)q;
#pragma unroll
      for (int i = 0; i < DQK / 8; ++i) { const u32x4 w = q4[i];
          qv[8 * i + 0] = __uint_as_float(w.x << 16); qv[8 * i + 1] = __uint_as_float(w.x & 0xffff0000u);
          qv[8 * i + 2] = __uint_as_float(w.y << 16); qv[8 * i + 3] = __uint_as_float(w.y & 0xffff0000u);
          qv[8 * i + 4] = __uint_as_float(w.z << 16); qv[8 * i + 5] = __uint_as_float(w.z & 0xffff0000u);
          qv[8 * i + 6] = __uint_as_float(w.w << 16); qv[8 * i + 7] = __uint_as_float(w.w & 0xffff0000u); } }
    const float cumt = cum ? cum[t] : 0.f;
    float m = -INFINITY, l = 0.f, o = 0.f;
    while (mask) {
        const int j = __builtin_ctzll(mask); mask &= mask - 1;
        const int kpos = 64 * j + lane; const int dist = t - kpos;
        const bool valid = dist >= 0 && dist < win;
        float s = 0.f;
        { const u32x4* k4 = (const u32x4*)(K + (size_t)kpos * DQK);
#pragma unroll
          for (int i = 0; i < DQK / 8; ++i) { const u32x4 w = k4[i];
              s = fmaf(qv[8 * i + 0], __uint_as_float(w.x << 16), s); s = fmaf(qv[8 * i + 1], __uint_as_float(w.x & 0xffff0000u), s);
              s = fmaf(qv[8 * i + 2], __uint_as_float(w.y << 16), s); s = fmaf(qv[8 * i + 3], __uint_as_float(w.y & 0xffff0000u), s);
              s = fmaf(qv[8 * i + 4], __uint_as_float(w.z << 16), s); s = fmaf(qv[8 * i + 5], __uint_as_float(w.z & 0xffff0000u), s);
              s = fmaf(qv[8 * i + 6], __uint_as_float(w.w << 16), s); s = fmaf(qv[8 * i + 7], __uint_as_float(w.w & 0xffff0000u), s); } }
        s -= slope2 * (float)dist;
        if (cum) s += (cumt - cum[kpos]) * LOG2E;
        s = valid ? s : -INFINITY;
        const float mb = wave_max(s);
        if (mb == -INFINITY) continue;
        const float mn = fmaxf(m, mb), alpha = exp2f(m - mn);
        const float p = valid ? exp2f(s - mn) : 0.f;
        l = l * alpha + wave_sum(p); o *= alpha; m = mn;
        const bf16* vb = V + (size_t)(64 * j) * 64 + lane;
#pragma unroll 8
        for (int k = 0; k < 64; ++k) o = fmaf(__shfl(p, k), bf2f(vb[(size_t)k * 64]), o);
    }
    return l > 0.f ? o / l : 0.f;
}

__device__ __forceinline__ void ph_cmp_attn(const Ctx& c, const bf16* qn, const bf16* kcmp, const bf16* vcmp, const float* gate, u64* sel, bf16* ocmp) {
    LAS float* pl = (LAS float*)(c.lds) + c.wave * 256;
    const int lane = c.lane;
    for (int it = c.gw; it < B_ * 2 * T_; it += c.ngw) {
        const int t = it % T_, bg = it / T_, b = bg >> 1, g = bg & 1;
        const int nvis = (t >= 31) ? ((t - 31) >> 4) + 1 : 0;
        const bf16* kc = kcmp + (size_t)bg * 256 * 64; const bf16* vc = vcmp + (size_t)bg * 256 * 64;
        float imp = 0.f;
        for (int hg = 0; hg < 4; ++hg) {
            const int h = g * 4 + hg; const float slope2 = alibi_slope(h + 1, 8) * LOG2E;
            const bf16* q = qn + ((size_t)(b * 8 + h) * T_ + t) * 64;
            float qv[64];
            { const u32x4* q4 = (const u32x4*)q;
#pragma unroll
              for (int i = 0; i < 8; ++i) { const u32x4 w = q4[i];
                  qv[8 * i + 0] = __uint_as_float(w.x << 16); qv[8 * i + 1] = __uint_as_float(w.x & 0xffff0000u);
                  qv[8 * i + 2] = __uint_as_float(w.y << 16); qv[8 * i + 3] = __uint_as_float(w.y & 0xffff0000u);
                  qv[8 * i + 4] = __uint_as_float(w.z << 16); qv[8 * i + 5] = __uint_as_float(w.z & 0xffff0000u);
                  qv[8 * i + 6] = __uint_as_float(w.w << 16); qv[8 * i + 7] = __uint_as_float(w.w & 0xffff0000u); } }
            float s[4]; float m = -INFINITY;
#pragma unroll
            for (int i = 0; i < 4; ++i) { const int cc = lane + 64 * i; float a = 0.f;
                if (cc < nvis) { const u32x4* k4 = (const u32x4*)(kc + (size_t)cc * 64);
#pragma unroll
                    for (int e = 0; e < 8; ++e) { const u32x4 w = k4[e];
                        a = fmaf(qv[8 * e + 0], __uint_as_float(w.x << 16), a); a = fmaf(qv[8 * e + 1], __uint_as_float(w.x & 0xffff0000u), a);
                        a = fmaf(qv[8 * e + 2], __uint_as_float(w.y << 16), a); a = fmaf(qv[8 * e + 3], __uint_as_float(w.y & 0xffff0000u), a);
                        a = fmaf(qv[8 * e + 4], __uint_as_float(w.z << 16), a); a = fmaf(qv[8 * e + 5], __uint_as_float(w.z & 0xffff0000u), a);
                        a = fmaf(qv[8 * e + 6], __uint_as_float(w.w << 16), a); a = fmaf(qv[8 * e + 7], __uint_as_float(w.w & 0xffff0000u), a); }
                    a -= slope2 * (float)(t - (16 * cc + 31)); } else a = -INFINITY;
                s[i] = a; m = fmaxf(m, a); }
            m = wave_max(m);
            float p[4], lsum = 0.f;
#pragma unroll
            for (int i = 0; i < 4; ++i) { p[i] = (lane + 64 * i < nvis) ? exp2f(s[i] - m) : 0.f; lsum += p[i]; }
            lsum = wave_sum(lsum);
            const float inv = lsum > 0.f ? 1.f / lsum : 0.f;
#pragma unroll
            for (int i = 0; i < 4; ++i) { p[i] *= inv; pl[lane + 64 * i] = p[i]; }
            asm volatile("s_waitcnt lgkmcnt(0)" ::: "memory");
            float o = 0.f;
            for (int cc = 0; cc < nvis; ++cc) o = fmaf(pl[cc], bf2f(vc[(size_t)cc * 64 + lane]), o);
            const float gt = gate[((size_t)(b * T_ + t)) * 24 + h * 3 + 0];
            ocmp[(size_t)(b * T_ + t) * 512 + h * 64 + lane] = (bf16)f2bf(gt * o);
            { const int j = lane; float a = pl[4 * j] + pl[4 * j + 1] + pl[4 * j + 2] + 0.5f * pl[4 * j + 3]; if (j > 0) a += 0.5f * pl[4 * j - 1]; imp += a; }
            asm volatile("s_waitcnt lgkmcnt(0)" ::: "memory");
        }
        const int cur = t >> 6; const int j = lane;
        u64 m64;
        if (cur <= 15) m64 = (cur == 63) ? ~0ull : ((1ull << (cur + 1)) - 1ull);
        else {
            float val = (j > cur) ? -INFINITY : ((j == 0 || j == cur || j == cur - 1) ? 1e4f : imp);
            m64 = 0ull;
            for (int r = 0; r < 16; ++r) {
                const float mx = wave_max(val);
                const u64 bal = __ballot(val == mx);
                const int w = __builtin_ctzll(bal);
                m64 |= 1ull << w; if (j == w) val = -INFINITY;
            }
        }
        if (lane == 0) sel[(size_t)bg * T_ + t] = m64;
    }
}

__device__ __forceinline__ void ph_win_attn(const Ctx& c, const bf16* qn, const bf16* kw, const bf16* vw, const float* gate, bf16* owin) {
    for (int it = c.gw; it < B_ * 8 * T_; it += c.ngw) {
        const int t = it % T_, bh = it / T_, b = bh >> 3, h = bh & 7, g = h >> 2;
        const int cur = t >> 6, jlo = (t - 511) > 0 ? (t - 511) >> 6 : 0;
        const u64 hi = (cur == 63) ? ~0ull : ((1ull << (cur + 1)) - 1ull); const u64 mask = hi & ~((1ull << jlo) - 1ull);
        const float o = naive_attn_row<64>(qn + ((size_t)bh * T_ + t) * 64, kw + (size_t)(b * 2 + g) * T_ * 64, vw + (size_t)(b * 2 + g) * T_ * 64, t, mask,
                                           alibi_slope(h + 1, 8) * LOG2E, nullptr, 512, c.lane);
        owin[(size_t)(b * T_ + t) * 512 + h * 64 + c.lane] = (bf16)f2bf(gate[(size_t)(b * T_ + t) * 24 + h * 3 + 2] * o);
    }
}
__device__ __forceinline__ void ph_slc_attn(const Ctx& c, const bf16* qn, const bf16* ks, const bf16* vs, const float* gate, const u64* sel, const bf16* ocmp, const bf16* owin, bf16* att) {
    for (int it = c.gw; it < B_ * 8 * T_; it += c.ngw) {
        const int t = it % T_, bh = it / T_, b = bh >> 3, h = bh & 7, g = h >> 2;
        const u64 mask = sel[(size_t)(b * 2 + g) * T_ + t];
        const float o = naive_attn_row<64>(qn + ((size_t)bh * T_ + t) * 64, ks + (size_t)(b * 2 + g) * T_ * 64, vs + (size_t)(b * 2 + g) * T_ * 64, t, mask,
                                           alibi_slope(h + 1, 8) * LOG2E, nullptr, 1 << 30, c.lane);
        const size_t n = (size_t)(b * T_ + t);
        const float r = gate[n * 24 + h * 3 + 1] * o + bf2f(ocmp[n * 512 + h * 64 + c.lane]) + bf2f(owin[n * 512 + h * 64 + c.lane]);
        att[n * 1024 + h * 64 + c.lane] = (bf16)f2bf(r);
    }
}
__device__ __forceinline__ void ph_fox_attn(const Ctx& c, const bf16* fq, const bf16* fk, const bf16* fv, const float* cum, bf16* att) {
    for (int it = c.gw; it < B_ * 4 * T_; it += c.ngw) {
        const int t = it % T_, bh = it / T_, b = bh >> 2, h = bh & 3;
        const int cur = t >> 6; const u64 mask = (cur == 63) ? ~0ull : ((1ull << (cur + 1)) - 1ull);
        const float o = naive_attn_row<64>(fq + ((size_t)bh * T_ + t) * 64, fk + (size_t)bh * T_ * 64, fv + (size_t)bh * T_ * 64, t, mask, 0.f, cum + (size_t)bh * T_, 1 << 30, c.lane);
        att[(size_t)(b * T_ + t) * 1024 + 512 + h * 64 + c.lane] = (bf16)f2bf(o);
    }
}
__device__ __forceinline__ void ph_diff_attn(const Ctx& c, const bf16* dq, const bf16* dk, const bf16* dv, const float* lam, const float* subln, float lambda_init, bf16* att) {
    float l1 = 0.f, l2 = 0.f;
    if (c.lane < 32) { l1 = lam[c.lane] * lam[32 + c.lane]; l2 = lam[64 + c.lane] * lam[96 + c.lane]; }
    const float lam_full = __expf(wave_sum(l1)) - __expf(wave_sum(l2)) + lambda_init;
    const float sg = subln[c.lane] * (1.f - lambda_init);
    for (int it = c.gw; it < B_ * 4 * T_; it += c.ngw) {
        const int t = it % T_, bh = it / T_, b = bh >> 2, h = bh & 3;
        const int cur = t >> 6; const u64 mask = (cur == 63) ? ~0ull : ((1ull << (cur + 1)) - 1ull);
        const float slope2 = alibi_slope(h + 1, 4) * LOG2E;
        const bf16* vb = dv + (size_t)bh * T_ * 64;
        const float o1 = naive_attn_row<32>(dq + ((size_t)(bh * 2 + 0) * T_ + t) * 32, dk + (size_t)(bh * 2 + 0) * T_ * 32, vb, t, mask, slope2, nullptr, 1 << 30, c.lane);
        const float o2 = naive_attn_row<32>(dq + ((size_t)(bh * 2 + 1) * T_ + t) * 32, dk + (size_t)(bh * 2 + 1) * T_ * 32, vb, t, mask, slope2, nullptr, 1 << 30, c.lane);
        const float o = o1 - lam_full * o2;
        const float r = rsqrtf(wave_sum(o * o) * (1.f / 64.f) + EPS);
        att[(size_t)(b * T_ + t) * 1024 + 768 + h * 64 + c.lane] = (bf16)f2bf(o * r * sg);
    }
}

__device__ __forceinline__ void ph_moe_route(const Ctx& c, const float* x, const float* g, const float* wgrp, const float* bgrp, const float* wexp, const float* bexp, bf16* hn, int* route_e, float* route_w, unsigned* cnt) {
    for (int row = c.gw; row < NT; row += c.ngw) {
        const f32x4* xr = (const f32x4*)(x + (size_t)row * D_) + c.lane;
        f32x4 v[4]; float ss = 0.f;
#pragma unroll
        for (int j = 0; j < 4; ++j) { v[j] = xr[64 * j]; ss += v[j].x * v[j].x + v[j].y * v[j].y + v[j].z * v[j].z + v[j].w * v[j].w; }
        const float r = rsqrtf(wave_sum(ss) * (1.f / D_) + EPS);
        u64* o8 = (u64*)(hn + (size_t)row * D_) + c.lane;
#pragma unroll
        for (int j = 0; j < 4; ++j) { const f32x4 gg = ((const f32x4*)g)[c.lane + 64 * j]; v[j] = v[j] * r * gg;
            o8[64 * j] = (u64)pk2(v[j].x, v[j].y) | ((u64)pk2(v[j].z, v[j].w) << 32); }
        float gl[4];
#pragma unroll
        for (int q = 0; q < 4; ++q) { float a = 0.f;
#pragma unroll
            for (int j = 0; j < 4; ++j) { const int k = 4 * (c.lane + 64 * j);
                a = fmaf(v[j].x, wgrp[(size_t)(k + 0) * 4 + q], a); a = fmaf(v[j].y, wgrp[(size_t)(k + 1) * 4 + q], a);
                a = fmaf(v[j].z, wgrp[(size_t)(k + 2) * 4 + q], a); a = fmaf(v[j].w, wgrp[(size_t)(k + 3) * 4 + q], a); }
            gl[q] = wave_sum(a) + bgrp[q]; }
        int grp = 0; float gm = gl[0];
#pragma unroll
        for (int q = 1; q < 4; ++q) if (gl[q] > gm) { gm = gl[q]; grp = q; }
        float gs = 0.f;
#pragma unroll
        for (int q = 0; q < 4; ++q) gs += __expf(gl[q] - gm);
        const float grp_gate = 1.f / gs;
        float el[8];
#pragma unroll
        for (int q = 0; q < 8; ++q) { float a = 0.f; const int col = grp * 8 + q;
#pragma unroll
            for (int j = 0; j < 4; ++j) { const int k = 4 * (c.lane + 64 * j);
                a = fmaf(v[j].x, wexp[(size_t)(k + 0) * 32 + col], a); a = fmaf(v[j].y, wexp[(size_t)(k + 1) * 32 + col], a);
                a = fmaf(v[j].z, wexp[(size_t)(k + 2) * 32 + col], a); a = fmaf(v[j].w, wexp[(size_t)(k + 3) * 32 + col], a); }
            el[q] = wave_sum(a) + bexp[col]; }
        int i0 = 0; float v0 = el[0];
#pragma unroll
        for (int q = 1; q < 8; ++q) if (el[q] > v0) { v0 = el[q]; i0 = q; }
        int i1 = -1; float v1 = -INFINITY;
#pragma unroll
        for (int q = 0; q < 8; ++q) if (q != i0 && el[q] > v1) { v1 = el[q]; i1 = q; }
        const float e1 = __expf(v1 - v0), den = 1.f + e1;
        if (c.lane == 0) { const float w0 = grp_gate / den, w1 = grp_gate * e1 / den;
            const int lo = i0 < i1 ? i0 : i1, hi = i0 < i1 ? i1 : i0, cls = grp * 28 + lo * 8 - (lo * (lo + 1)) / 2 + (hi - lo - 1);
            const unsigned rank = __hip_atomic_fetch_add(cnt + cls, 1u, __ATOMIC_RELAXED, __HIP_MEMORY_SCOPE_AGENT);
            route_e[row] = (int)(((unsigned)cls << 24) | rank); route_w[2 * row] = i0 < i1 ? w0 : w1; route_w[2 * row + 1] = i0 < i1 ? w1 : w0; }
    }
}
__device__ __forceinline__ void ph_moe_naive(const Ctx& c, const bf16* hn, const int* route_e, const float* route_w, const float* wg, const float* wu, const float* wd, float* x) {
    LAS float* hs = (LAS float*)c.lds;
    LAS float* au = hs + 1024;
    LAS float* h2 = au + 512;
    for (int row = c.bid; row < NT; row += c.G) {
        __syncthreads();
        hs[c.tid] = bf2f(hn[(size_t)row * D_ + c.tid]); hs[c.tid + 512] = bf2f(hn[(size_t)row * D_ + c.tid + 512]);
        float o0 = 0.f, o1 = 0.f;
        for (int s = 0; s < 2; ++s) {
            const int e = route_e[2 * row + s]; const float w = route_w[2 * row + s];
            __syncthreads();
            const float* W = (c.tid < 256 ? wg : wu) + (size_t)e * D_ * DEXP + (c.tid & 255);
            float a = 0.f;
            for (int k = 0; k < D_; ++k) a = fmaf(hs[k], W[(size_t)k * DEXP], a);
            au[c.tid] = a;
            __syncthreads();
            if (c.tid < 256) { const float ga = au[c.tid], up = au[c.tid + 256]; h2[c.tid] = ga / (1.f + __expf(-ga)) * up * w; }
            __syncthreads();
            const float* Wd = wd + (size_t)e * DEXP * D_;
            for (int k = 0; k < DEXP; ++k) { const float hv = h2[k]; o0 = fmaf(hv, Wd[(size_t)k * D_ + c.tid], o0); o1 = fmaf(hv, Wd[(size_t)k * D_ + c.tid + 512], o1); }
        }
        x[(size_t)row * D_ + c.tid] += o0; x[(size_t)row * D_ + c.tid + 512] += o1;
    }
    __syncthreads();
}

typedef __attribute__((address_space(4))) const Params* KP;
__device__ __forceinline__ KP uni_kp(KP p) { const unsigned long long v = (unsigned long long)p; const unsigned lo = __builtin_amdgcn_readfirstlane((unsigned)v), hi = __builtin_amdgcn_readfirstlane((unsigned)(v >> 32)); return (KP)(((unsigned long long)hi << 32) | lo); }
constexpr int PH_PER_LAYER = 11, N_PHASES = L_ * PH_PER_LAYER + 2;
__device__ __forceinline__ Ctx make_ctx(KP p) {
    Ctx c; c.lds = (LAS unsigned char*)lds_raw; { int t_ = threadIdx.x; asm volatile("" : "+v"(t_)); c.tid = t_; } c.lane = c.tid & 63; c.wave = __builtin_amdgcn_readfirstlane(c.tid >> 6);
    c.bid = blockIdx.x; c.G = gridDim.x; c.gw = c.bid * NWAVES + c.wave; c.ngw = c.G * NWAVES; c.in = nullptr; c.xcur = p->out; c.ws = p->ws;
    return c;
}
struct Bufs {
    bf16 *QN, *KV6, *KC, *VC, *KS, *VS, *KW, *VW, *FQ, *FK, *FV, *DQ, *DK, *DV, *HC, *KCMP, *VCMP, *OCMP, *OWIN, *HN, *ATT;
    float *GATE, *FL, *ROUTE_W; u64* SEL; int* ROUTE_E;
};
__device__ __forceinline__ Bufs make_bufs(unsigned char* ws) {
    Bufs b;
    b.QN = (bf16*)(ws + WS_QN); b.KV6 = (bf16*)(ws + WS_KV6);
    b.KC = (bf16*)(ws + WS_KV6 + 0 * KV6_STRIDE); b.VC = (bf16*)(ws + WS_KV6 + 1 * KV6_STRIDE);
    b.KS = (bf16*)(ws + WS_KV6 + 2 * KV6_STRIDE); b.VS = (bf16*)(ws + WS_KV6 + 3 * KV6_STRIDE);
    b.KW = (bf16*)(ws + WS_KV6 + 4 * KV6_STRIDE); b.VW = (bf16*)(ws + WS_KV6 + 5 * KV6_STRIDE);
    b.FQ = (bf16*)(ws + WS_FQKV); b.FK = b.FQ + 8 * MiB; b.FV = b.FQ + 16 * MiB;
    b.DQ = (bf16*)(ws + WS_DQK); b.DK = b.DQ + 8 * MiB; b.DV = (bf16*)(ws + WS_DV);
    b.GATE = (float*)(ws + WS_GATE); b.FL = (float*)(ws + WS_FL);
    b.HC = (bf16*)(ws + WS_HC); b.KCMP = (bf16*)(ws + WS_KVCMP); b.VCMP = b.KCMP + 16 * 256 * 64;
    b.SEL = (u64*)(ws + WS_SEL); b.OCMP = (bf16*)(ws + WS_OCMP); b.OWIN = (bf16*)(ws + WS_OWIN);
    b.HN = (bf16*)(ws + WS_HN); b.ATT = (bf16*)(ws + WS_ATT);
    b.ROUTE_E = (int*)(ws + WS_ROUTE); b.ROUTE_W = (float*)(ws + WS_ROUTE + 512 * 1024);
    return b;
}
__device__ __forceinline__ float lambda_init_of(int l) { return l == 0 ? 0.2f : 0.35550906759096926f; }

__device__ __noinline__ void P_prologue(KP p_) { const KP p = uni_kp(p_);
    const Ctx c = make_ctx(p); unsigned char* ws = p->ws;
    LAS float* scr = (LAS float*)(c.lds) + c.wave * (64 * 33);
    constexpr int I_A = 16 * 40, I_B = 16 * 24, I_C = 16 * 24, I_O = 16 * 32, I_G = 16 * 8, I_D = 4 * 32, I_E = 2 * I_G + I_D, I_W1 = 32 * 8, I_W2 = 4 * 2;
    constexpr int PER_L = I_A + I_B + I_C + I_O + 2 * (I_W1 + I_W2);
    for (int it = c.gw; it < L_ * PER_L; it += c.ngw) {
        const int l = it / PER_L; int r = it % PER_L;
        const float* W; bf16* WT; int ldw, K, sc0, ncol, r0 = 0, rmul = 1;
        if (r < I_A + I_B + I_C) { W = p->in[2] + (size_t)l * D_ * D_IN; WT = (bf16*)(ws + WS_WIN_T) + (size_t)l * NIN * D_; ldw = D_IN; K = D_;
            if (r < I_A) { sc0 = 0; ncol = 1280; r0 = 0; } else if (r < I_A + I_B) { r -= I_A; sc0 = C_FQ; ncol = 768; r0 = 1280; } else { r -= I_A + I_B; sc0 = C_DQ; ncol = 768; r0 = 2048; } }
        else if ((r -= I_A + I_B + I_C) < I_O) { W = p->in[13] + (size_t)l * D_ * D_; WT = (bf16*)(ws + WS_WOUT_T) + (size_t)l * D_ * D_; ldw = D_; K = D_; sc0 = 0; ncol = 1024; }
        else { r -= I_O; const int kv = r / (I_W1 + I_W2); r = r % (I_W1 + I_W2); const size_t lk = (size_t)l * 2 + kv;
            if (r < I_W1) { W = p->in[kv == 0 ? 6 : 9] + (size_t)l * 2048 * 256; WT = (bf16*)(ws + WS_W1_T) + lk * 256 * 2048; ldw = 256; K = 2048; sc0 = 0; ncol = 256; }
            else { r -= I_W1; W = p->in[kv == 0 ? 7 : 10] + (size_t)l * 256 * 64; WT = (bf16*)(ws + WS_W2_T) + lk * 64 * 256; ldw = 64; K = 256; sc0 = 0; ncol = 64; } }
        transpose_seg(W, ldw, K, sc0, ncol, WT, r0, rmul, r, scr, c.lane);
    }
    for (int i = c.bid * NTHREADS + c.tid; i < L_ * 256 * D_; i += c.G * NTHREADS) {
        const int l = i / (256 * D_), rr = (i / D_) % 256, k = i % D_;
        const float* win = p->in[2] + (size_t)l * D_ * D_IN;
        float v = 0.f; if (rr < 24) v = win[(size_t)k * D_IN + C_GATE + rr]; else if (rr < 28) v = win[(size_t)k * D_IN + C_FF + (rr - 24)];
        ((bf16*)(ws + WS_WIN_T))[((size_t)l * NIN + 2816 + rr) * D_ + k] = (bf16)f2bf(v);
    }
    for (int w = c.gw; w < L_ * 2 * 4 * 128; w += c.ngw) {
        const int lk = w >> 9, cg = (w >> 7) & 3, kc = w & 127, l = lk >> 1, kv = lk & 1, j = cg * 64 + c.lane;
        const float* pe = p->in[kv == 0 ? 5 : 8] + (size_t)l * 2048 + kc * 16; const float* w1 = p->in[kv == 0 ? 6 : 9] + (size_t)l * 2048 * 256 + (size_t)kc * 16 * 256;
        float a = 0.f;
#pragma unroll
        for (int k = 0; k < 16; ++k) a = fmaf(pe[k], w1[(size_t)k * 256 + j], a);
        ((float*)(ws + WS_B1PART))[((size_t)lk * 128 + kc) * 256 + j] = a;
    }
    for (int i = c.bid * NTHREADS + c.tid; i < L_ * 64 * 2 * 64; i += c.G * NTHREADS) {
        const int l = i / (64 * 2 * 64), ks = (i / 128) % 64, cb = (i / 64) & 1, lane = i & 63, col = 32 * cb + (lane & 31);
        unsigned hi[4], lo[4];
#pragma unroll
        for (int jp = 0; jp < 4; ++jp) { float v[2];
#pragma unroll
            for (int e = 0; e < 2; ++e) { const int k = 16 * ks + 8 * (lane >> 5) + 2 * jp + e; const float g = p->in[14][(size_t)l * D_ + k];
                v[e] = col < 4 ? g * p->in[15][((size_t)l * D_ + k) * 4 + col] : (col < 36 ? g * p->in[17][((size_t)l * D_ + k) * 32 + (col - 4)] : 0.f); }
            const unsigned h0 = f2bf(v[0]), h1 = f2bf(v[1]); hi[jp] = h0 | (h1 << 16);
            lo[jp] = f2bf(v[0] - __uint_as_float(h0 << 16)) | (f2bf(v[1] - __uint_as_float(h1 << 16)) << 16); }
        u32x4* dst = (u32x4*)(ws + WS_WR) + ((size_t)((l * 64 + ks) * 2 + cb) * 2) * 64 + lane;
        dst[0] = (u32x4){hi[0], hi[1], hi[2], hi[3]}; dst[64] = (u32x4){lo[0], lo[1], lo[2], lo[3]};
    }
}
__device__ __forceinline__ void P_inproj_mfma(int l_) { const KP p = (KP)__builtin_amdgcn_kernarg_segment_ptr(); int l = l_; asm volatile("" : "+s"(l));
    unsigned char* ws = p->ws; asm volatile("" : "+s"(ws));
    PlainOrder S; S.init(p->out, (const bf16*)(ws + WS_WIN_T) + (size_t)l * NIN * D_, D_, D_, NT, NIN, (int)gridDim.x, launder_s((int)blockIdx.x));
#ifdef STAGGER_TICKS
    { const unsigned long long t0 = __builtin_amdgcn_s_memrealtime(); const unsigned long long d = (unsigned long long)((launder_s((int)blockIdx.x) >> 3) & 3) * STAGGER_TICKS;
      while (__builtin_amdgcn_s_memrealtime() - t0 < d) __builtin_amdgcn_s_sleep(4); }
#endif
    const pg8::Gemm g{D_, D_, D_, D_ / 64, 0, 0};
    const EpiInProj E{ws, p->in[3] + l * 24, p->in[4] + l * 4, (unsigned*)(ws + WS_CTL) + CW_KN + l * 8192};
    pg8::gemm_phase<EpiInProj, PlainOrder, INPROJ_ALIGN, INPROJ_SP2>((LAS unsigned char*)lds_raw, g, S, E);
}
__device__ __forceinline__ void P_inproj_dummy(int l_) { const KP p = (KP)__builtin_amdgcn_kernarg_segment_ptr(); int l = l_; asm volatile("" : "+s"(l));
    unsigned char* ws = p->ws; asm volatile("" : "+s"(ws));
    PlainOrder S; S.init(p->out, (const bf16*)(ws + WS_WIN_T) + (size_t)l * NIN * D_, D_, D_, NT, NIN, (int)gridDim.x, launder_s((int)blockIdx.x));
    const pg8::Gemm g{D_, D_, D_, D_ / 64, 0, 0};
    const EpiDummy E{(float*)(ws + WS_HB)};
    pg8::gemm_phase<EpiDummy, PlainOrder, true, true>((LAS unsigned char*)lds_raw, g, S, E);
}
__device__ __forceinline__ void P_outproj_mfma(int l_) { const KP p = (KP)__builtin_amdgcn_kernarg_segment_ptr(); int l = l_; asm volatile("" : "+s"(l));
    unsigned char* ws = p->ws; asm volatile("" : "+s"(ws));
    PlainOrder S; S.init(ws + WS_ATT, (const bf16*)(ws + WS_WOUT_T) + (size_t)l * D_ * D_, D_, D_, NT, D_, (int)gridDim.x, launder_s((int)blockIdx.x));
    const pg8::Gemm g{D_, D_, D_, D_ / 64, 32, 8};
    const EpiResBf16 E{(bf16*)(ws + WS_HN)};
    pg8::gemm_phase<EpiResBf16, PlainOrder, true, true>((LAS unsigned char*)lds_raw, g, S, E);
}
__device__ __forceinline__ float wave_max_l(float v, int lane) {
#pragma unroll
    for (int o = 1; o < 64; o <<= 1) v = fmaxf(v, shflx_f(v, o, lane));
    return v;
}
__device__ __forceinline__ float wave_min_l(float v, int lane) {
#pragma unroll
    for (int o = 1; o < 64; o <<= 1) v = fminf(v, shflx_f(v, o, lane));
    return v;
}
template <int NS> __device__ __forceinline__ float q_norm2_max(const bf16x8v (&Q)[NS], int lane) {
    float ss = 0.f;
#pragma unroll
    for (int s = 0; s < NS; ++s)
#pragma unroll
        for (int e = 0; e < 8; ++e) { const float v = __uint_as_float(((unsigned)(unsigned short)Q[s][e]) << 16); ss = fmaf(v, v, ss); }
    return wave_max_l(swap_sum(ss), lane);
}
__device__ __forceinline__ u64 prune_consensus(bool skip, LAS u64* slots, int wave, int lane) {
    const u64 mine = __ballot(skip);
    __syncthreads();
    if (lane == 0) slots[wave] = mine;
    __syncthreads();
    u64 all = slots[0];
#pragma unroll
    for (int w = 1; w < NWAVES; ++w) all &= slots[w];
    return all;
}
__device__ __forceinline__ bool block_any(bool v, LAS u64* slots, int wave, int lane) {
#ifdef FORCE_FALLBACK
    v = true;
#endif
    const u64 mine = __ballot(v);
    __syncthreads();
    if (lane == 0) slots[wave] = mine;
    __syncthreads();
    u64 all = slots[0];
#pragma unroll
    for (int w = 1; w < NWAVES; ++w) all |= slots[w];
    return all != 0ull;
}
__device__ __forceinline__ bool sum_bad(float l) { return !(l < 1e30f); }
__device__ __forceinline__ void U_fox(KP p_, int bh_, int qb_, int l_) {
    const KP p = uni_kp(p_); const int bh = __builtin_amdgcn_readfirstlane(bh_), qb = __builtin_amdgcn_readfirstlane(qb_), l = __builtin_amdgcn_readfirstlane(l_);
    int tid_ = threadIdx.x; asm volatile("" : "+v"(tid_));
    const int tid = tid_, lane = tid & 63, wave = __builtin_amdgcn_readfirstlane(tid >> 6), r = lane & 31, h = lane >> 5;
    unsigned char* ws = p->ws; asm volatile("" : "+s"(ws)); LAS unsigned char* L = (LAS unsigned char*)lds_raw;
    const int tw0 = 256 * qb + 32 * wave, t_lane = tw0 + r, b = bh >> 2, hd = bh & 3;
    const bf16* q = (const bf16*)(ws + WS_FQKV) + (size_t)bh * T_ * 64 + (t_lane >> 4) * 1024 + (t_lane & 15) * 32 + 8 * h;
    bf16x8v Qf[1][4];
#pragma unroll
    for (int s = 0; s < 4; ++s) Qf[0][s] = *(const bf16x8v*)(q + (s >> 1) * 512 + (s & 1) * 16);
    const bf16* Kp = (const bf16*)(ws + WS_FQKV) + 8 * MiB + (size_t)bh * T_ * 64; const bf16* Vp = (const bf16*)(ws + WS_FQKV) + 16 * MiB + (size_t)bh * T_ * 64;
    u32x4 kpre, vpre; attn_preload<64>(Kp, nullptr, Vp, 4 * qb + 3, tid, kpre, vpre);
    LAS float* cum = (LAS float*)(L + A_LDS_END);
    { const float* fl = (const float*)(ws + WS_FL) + (size_t)bh * T_; LAS float* tot = cum + 4096;
      const int nval = 256 * (qb + 1); float v[8];
      if (8 * tid < nval) { const f32x4 a = *(const f32x4*)(fl + 8 * tid), c2 = *(const f32x4*)(fl + 8 * tid + 4); v[0] = a.x; v[1] = a.y; v[2] = a.z; v[3] = a.w; v[4] = c2.x; v[5] = c2.y; v[6] = c2.z; v[7] = c2.w; }
      else {
#pragma unroll
          for (int i = 0; i < 8; ++i) v[i] = 0.f; }
#pragma unroll
      for (int i = 1; i < 8; ++i) v[i] += v[i - 1];
      float sc = v[7];
#pragma unroll
      for (int o = 1; o < 64; o <<= 1) { const float up = __uint_as_float((unsigned)__builtin_amdgcn_ds_bpermute((lane - o) << 2, (int)__float_as_uint(sc))); if (lane >= o) sc += up; }
      if (lane == 63) tot[wave] = sc;
      __syncthreads();
      float base = sc - v[7];
      for (int w = 0; w < wave; ++w) base += tot[w];
      if (8 * tid < nval) {
#pragma unroll
          for (int i = 0; i < 8; ++i) cum[8 * tid + i] = v[i] + base; }
      __syncthreads(); }
    f32x16 O[1][2]; float M[1] = {0.f}, Ls[1] = {0.f};
#pragma unroll
    for (int i = 0; i < 16; ++i) { O[0][0][i] = 0.f; O[0][1][i] = 0.f; }
    const u64 tm = (qb == 15) ? ~0ull : ((1ull << (4 * qb + 4)) - 1ull);
#if AC2_MODE == 0
    {
        const u64 low = (1ull << (4 * qb)) - 1ull; const float cref = cum[tw0];
#define FOX_CORES(NM, FIRSTCALL) do { FIRSTCALL; \
        if (qb > 0) { \
            const float qn2 = q_norm2_max<4>(Qf[0], lane), mmin = wave_min_l(M[0], lane); \
            const float* kn = (const float*)((const unsigned*)(ws + WS_CTL) + CW_KN + l * 8192) + ((size_t)bh * 64 + lane) * 2; \
            bool skip = false; \
            if (lane < 4 * qb) { const float kn2 = kn[0] + kn[1]; const float bound = sqrtf(qn2 * kn2) * 1.02f + (cref - cum[64 * lane + 63]) * LOG2E - mmin; skip = bound < -152.f; } \
            const u64 drop = prune_consensus(skip, (LAS u64*)(cum + 4096 + 16), wave, lane); \
            const u64 tm2 = low & ~drop; \
            if (tm2) attn_core<64, 1, true, false, false, NM>(L, Kp, nullptr, Vp, cum, cref, Qf, tm2, t_lane, tw0, 1 << 30, 0.f, 0u, 0u, O, M, Ls, tid, true); \
        } } while (0)
        FOX_CORES(NOMAX_ON, (attn_core<64, 1, true, false, true, NOMAX_ON>(L, Kp, nullptr, Vp, cum, cref, Qf, tm & ~low, t_lane, tw0, 1 << 30, 0.f, 0u, 0u, O, M, Ls, tid, false, 4 * qb + 3, kpre, vpre)));
        if (NOMAX_ON && block_any(sum_bad(Ls[0]), (LAS u64*)(cum + 4096 + 32), wave, lane)) {
#pragma unroll
            for (int i = 0; i < 16; ++i) { O[0][0][i] = 0.f; O[0][1][i] = 0.f; }
            M[0] = 0.f; Ls[0] = 0.f;
            FOX_CORES(false, (attn_core<64, 1, true, false, false, false>(L, Kp, nullptr, Vp, cum, cref, Qf, tm & ~low, t_lane, tw0, 1 << 30, 0.f, 0u, 0u, O, M, Ls, tid)));
        }
#undef FOX_CORES
    }
#else
    attn_core2<true, false>(L, (const bf16*)(ws + WS_FQKV) + 8 * MiB + (size_t)bh * T_ * 64, (const bf16*)(ws + WS_FQKV) + 16 * MiB + (size_t)bh * T_ * 64, cum, cum[256 * qb],
                            Qf[0], tm, t_lane, tw0, 1 << 30, 0.f, 0u, 0u, O[0], M[0], Ls[0], tid);
#endif
    const float lt = swap_sum(Ls[0]), inv = lt > 0.f ? 1.f / lt : 0.f;
    bf16* dst = (bf16*)(ws + WS_ATT) + mix_off((size_t)b * T_ + t_lane, 512 + hd * 64 + 4 * h, 1024);
    ATTN_FOR_CHUNKS(db, g4) { const unsigned w0 = cvtpk(O[0][db][4 * g4 + 0] * inv, O[0][db][4 * g4 + 1] * inv), w1 = cvtpk(O[0][db][4 * g4 + 2] * inv, O[0][db][4 * g4 + 3] * inv);
        *(u64*)(dst + (4 * db + g4) * 256) = (u64)w0 | ((u64)w1 << 32); }
}
__device__ __forceinline__ void U_diff(KP p_, int bh_, int qb_, int l_) {
    const KP p = uni_kp(p_); const int bh = __builtin_amdgcn_readfirstlane(bh_), qb = __builtin_amdgcn_readfirstlane(qb_), l = __builtin_amdgcn_readfirstlane(l_);
    int tid_ = threadIdx.x; asm volatile("" : "+v"(tid_));
    const int tid = tid_, lane = tid & 63, wave = __builtin_amdgcn_readfirstlane(tid >> 6), r = lane & 31, h = lane >> 5;
    unsigned char* ws = p->ws; asm volatile("" : "+s"(ws)); LAS unsigned char* L = (LAS unsigned char*)lds_raw;
    const int tw0 = 256 * qb + 32 * wave, t_lane = tw0 + r, b = bh >> 2, hd = bh & 3;
    const bf16* DQ = (const bf16*)(ws + WS_DQK); const bf16* DK = DQ + 8 * MiB;
    bf16x8v Qf[2][2];
#pragma unroll
    for (int mp = 0; mp < 2; ++mp)
#pragma unroll
        for (int s = 0; s < 2; ++s) Qf[mp][s] = *(const bf16x8v*)(DQ + ((size_t)(bh * 2 + mp) * T_ + t_lane) * 32 + 16 * s + 8 * h);
    f32x16 O[2][2]; float M[2] = {0.f, 0.f}, Ls[2] = {0.f, 0.f};
#pragma unroll
    for (int i = 0; i < 16; ++i) { O[0][0][i] = 0.f; O[0][1][i] = 0.f; O[1][0][i] = 0.f; O[1][1][i] = 0.f; }
    const u64 tm = (qb == 15) ? ~0ull : ((1ull << (4 * qb + 4)) - 1ull);
    {
        const u64 low = (1ull << (4 * qb)) - 1ull; const float slope2 = alibi_slope(hd + 1, 4) * LOG2E;
        const bf16* K0 = DK + (size_t)(bh * 2 + 0) * T_ * 32; const bf16* K1 = DK + (size_t)(bh * 2 + 1) * T_ * 32; const bf16* Vp = (const bf16*)(ws + WS_DV) + (size_t)bh * T_ * 64;
#define DIFF_CORES(NM) do { \
        attn_core<32, 2, false, false, false, NM>(L, K0, K1, Vp, nullptr, 0.f, Qf, tm & ~low, t_lane, tw0, 1 << 30, slope2, 0u, 0u, O, M, Ls, tid); \
        if (qb > 0) { \
            const float qa = q_norm2_max<2>(Qf[0], lane), qb2 = q_norm2_max<2>(Qf[1], lane), ma = wave_min_l(M[0], lane), mb = wave_min_l(M[1], lane); \
            const float* kn = (const float*)((const unsigned*)(ws + WS_CTL) + CW_KN + l * 8192 + 4096) + (size_t)(bh * 2) * 64 + lane; \
            bool skip = false; \
            if (lane < 4 * qb) { const float bmax = slope2 * (float)(64 * lane + 63 - tw0);            \
                skip = (sqrtf(qa * kn[0]) * 1.02f + bmax - ma < -152.f) && (sqrtf(qb2 * kn[64]) * 1.02f + bmax - mb < -152.f); } \
            const u64 drop = prune_consensus(skip, (LAS u64*)(L + A_LDS_END), wave, lane); \
            const u64 tm2 = low & ~drop; \
            if (tm2) attn_core<32, 2, false, false, false, NM>(L, K0, K1, Vp, nullptr, 0.f, Qf, tm2, t_lane, tw0, 1 << 30, slope2, 0u, 0u, O, M, Ls, tid, true); \
        } } while (0)
        DIFF_CORES(NOMAX_ON);
        if (NOMAX_ON && block_any(sum_bad(Ls[0]) || sum_bad(Ls[1]), (LAS u64*)(L + A_LDS_END + 64), wave, lane)) {
#pragma unroll
            for (int i = 0; i < 16; ++i) { O[0][0][i] = 0.f; O[0][1][i] = 0.f; O[1][0][i] = 0.f; O[1][1][i] = 0.f; }
            M[0] = 0.f; M[1] = 0.f; Ls[0] = 0.f; Ls[1] = 0.f;
            DIFF_CORES(false);
        }
#undef DIFF_CORES
    }
    const float* lam = p->in[11] + (size_t)l * 128; const float* subln = p->in[12] + (size_t)l * 64;
    float l1 = 0.f, l2 = 0.f; if (lane < 32) { l1 = lam[lane] * lam[32 + lane]; l2 = lam[64 + lane] * lam[96 + lane]; }
    const float li = lambda_init_of(l), lam_full = __expf(wave_sum_l(l1, lane)) - __expf(wave_sum_l(l2, lane)) + li;
    const float lt0 = swap_sum(Ls[0]), lt1 = swap_sum(Ls[1]), i0 = lt0 > 0.f ? 1.f / lt0 : 0.f, i1 = (lt1 > 0.f ? 1.f / lt1 : 0.f) * lam_full;
    float ss = 0.f;
#pragma unroll
    for (int db = 0; db < 2; ++db)
#pragma unroll
        for (int i = 0; i < 16; ++i) { const float o = O[0][db][i] * i0 - O[1][db][i] * i1; O[0][db][i] = o; ss += o * o; }
    ss = swap_sum(ss);
    const float rn = rsqrtf(ss * (1.f / 64.f) + EPS) * (1.f - li);
    bf16* dst = (bf16*)(ws + WS_ATT) + mix_off((size_t)b * T_ + t_lane, 768 + hd * 64 + 4 * h, 1024);
    f32x4 sgv[8];
    ATTN_FOR_CHUNKS(db, g4) sgv[4 * db + g4] = *(const f32x4*)(subln + 32 * db + 8 * g4 + 4 * h);
#pragma unroll
    for (int i = 0; i < 8; ++i) asm volatile("" : "+v"(sgv[i]));
    ATTN_FOR_CHUNKS(db, g4) { const f32x4 sg = sgv[4 * db + g4];
        const unsigned w0 = cvtpk(O[0][db][4 * g4 + 0] * rn * sg.x, O[0][db][4 * g4 + 1] * rn * sg.y), w1 = cvtpk(O[0][db][4 * g4 + 2] * rn * sg.z, O[0][db][4 * g4 + 3] * rn * sg.w);
        *(u64*)(dst + (4 * db + g4) * 256) = (u64)w0 | ((u64)w1 << 32); }
}
__device__ __forceinline__ void U_win(KP p_, int bg_, int c_) {
    const KP p = uni_kp(p_); const int bg = __builtin_amdgcn_readfirstlane(bg_), cc = __builtin_amdgcn_readfirstlane(c_);
    int tid_ = threadIdx.x; asm volatile("" : "+v"(tid_));
    const int tid = tid_, lane = tid & 63, wave = __builtin_amdgcn_readfirstlane(tid >> 6), r = lane & 31, h = lane >> 5;
    unsigned char* ws = p->ws; asm volatile("" : "+s"(ws)); LAS unsigned char* L = (LAS unsigned char*)lds_raw;
    const int b = bg >> 1, g = bg & 1, hd = g * 4 + (wave >> 1), tw0 = 64 * cc + 32 * (wave & 1), t_lane = tw0 + r;
    const bf16* q = (const bf16*)(ws + WS_QN) + (size_t)(b * 8 + hd) * T_ * 64 + (t_lane >> 4) * 1024 + (t_lane & 15) * 32 + 8 * h;
    bf16x8v Qf[1][4];
#pragma unroll
    for (int s = 0; s < 4; ++s) Qf[0][s] = *(const bf16x8v*)(q + (s >> 1) * 512 + (s & 1) * 16);
    f32x16 O[1][2]; float M[1] = {0.f}, Ls[1] = {0.f};
#pragma unroll
    for (int i = 0; i < 16; ++i) { O[0][0][i] = 0.f; O[0][1][i] = 0.f; }
    const size_t n = (size_t)b * T_ + t_lane;
    const float gate_w = ((const float*)(ws + WS_GATE))[n * 24 + hd * 3 + 2];
    const int jlo = cc > 8 ? cc - 8 : 0;
    const u64 hi = (cc == 63) ? ~0ull : ((1ull << (cc + 1)) - 1ull), tm = hi & ~((1ull << jlo) - 1ull);
#if AC2_MODE == 0
    attn_core<64, 1, false, false, false, NOMAX_ON>(L, (const bf16*)(ws + WS_KV6 + 4 * KV6_STRIDE) + (size_t)bg * T_ * 64, nullptr, (const bf16*)(ws + WS_KV6 + 5 * KV6_STRIDE) + (size_t)bg * T_ * 64, nullptr, 0.f,
                                   Qf, tm, t_lane, tw0, 512, alibi_slope(hd + 1, 8) * LOG2E, 0u, 0u, O, M, Ls, tid);
    if (NOMAX_ON && block_any(sum_bad(Ls[0]), (LAS u64*)(L + A_LDS_END + 64), wave, lane)) {
#pragma unroll
        for (int i = 0; i < 16; ++i) { O[0][0][i] = 0.f; O[0][1][i] = 0.f; }
        M[0] = 0.f; Ls[0] = 0.f;
        attn_core<64, 1, false, false, false, false>(L, (const bf16*)(ws + WS_KV6 + 4 * KV6_STRIDE) + (size_t)bg * T_ * 64, nullptr, (const bf16*)(ws + WS_KV6 + 5 * KV6_STRIDE) + (size_t)bg * T_ * 64, nullptr, 0.f,
                                       Qf, tm, t_lane, tw0, 512, alibi_slope(hd + 1, 8) * LOG2E, 0u, 0u, O, M, Ls, tid);
    }
#ifdef PROBE_WINCORE2
    attn_core<64, 1, false, false>(L, (const bf16*)(ws + WS_KV6 + 4 * KV6_STRIDE) + (size_t)bg * T_ * 64, nullptr, (const bf16*)(ws + WS_KV6 + 5 * KV6_STRIDE) + (size_t)bg * T_ * 64, nullptr, 0.f,
                                   Qf, tm, t_lane, tw0, 512, alibi_slope(hd + 1, 8) * LOG2E, 0u, 0u, O, M, Ls, tid, true);
#endif
#else
    attn_core2<false, false>(L, (const bf16*)(ws + WS_KV6 + 4 * KV6_STRIDE) + (size_t)bg * T_ * 64, (const bf16*)(ws + WS_KV6 + 5 * KV6_STRIDE) + (size_t)bg * T_ * 64, nullptr, 0.f,
                             Qf[0], tm, t_lane, tw0, 512, alibi_slope(hd + 1, 8) * LOG2E, 0u, 0u, O[0], M[0], Ls[0], tid);
#endif
    const float lt = swap_sum(Ls[0]), inv = (lt > 0.f ? 1.f / lt : 0.f) * gate_w;
    bf16* dst = (bf16*)(ws + WS_OWIN) + mix_off(n, hd * 64 + 4 * h, 512);
    ATTN_FOR_CHUNKS(db, g4) { const unsigned w0 = cvtpk(O[0][db][4 * g4 + 0] * inv, O[0][db][4 * g4 + 1] * inv), w1 = cvtpk(O[0][db][4 * g4 + 2] * inv, O[0][db][4 * g4 + 3] * inv);
        *(u64*)(dst + (4 * db + g4) * 256) = (u64)w0 | ((u64)w1 << 32); }
}
__device__ __forceinline__ void U_slc(KP p_, int bg_, int c_) {
    const KP p = uni_kp(p_); const int bg = __builtin_amdgcn_readfirstlane(bg_), cc = __builtin_amdgcn_readfirstlane(c_);
    int tid_ = threadIdx.x; asm volatile("" : "+v"(tid_));
    const int tid = tid_, lane = tid & 63, wave = __builtin_amdgcn_readfirstlane(tid >> 6), r = lane & 31, h = lane >> 5;
    unsigned char* ws = p->ws; asm volatile("" : "+s"(ws)); LAS unsigned char* L = (LAS unsigned char*)lds_raw;
    const int b = bg >> 1, g = bg & 1, hd = g * 4 + (wave >> 1), tw0 = 64 * cc + 32 * (wave & 1), t_lane = tw0 + r;
    const bf16* q = (const bf16*)(ws + WS_QN) + (size_t)(b * 8 + hd) * T_ * 64 + (t_lane >> 4) * 1024 + (t_lane & 15) * 32 + 8 * h;
    bf16x8v Qf[1][4];
#pragma unroll
    for (int s = 0; s < 4; ++s) Qf[0][s] = *(const bf16x8v*)(q + (s >> 1) * 512 + (s & 1) * 16);
    f32x16 O[1][2]; float M[1] = {0.f}, Ls[1] = {0.f};
#pragma unroll
    for (int i = 0; i < 16; ++i) { O[0][0][i] = 0.f; O[0][1][i] = 0.f; }
    const bf16* Ksl = (const bf16*)(ws + WS_KV6 + 2 * KV6_STRIDE) + (size_t)bg * T_ * 64; const bf16* Vsl = (const bf16*)(ws + WS_KV6 + 3 * KV6_STRIDE) + (size_t)bg * T_ * 64;
    u32x4 kpre, vpre; attn_preload<64>(Ksl, nullptr, Vsl, cc, tid, kpre, vpre);
    const size_t n = (size_t)b * T_ + t_lane;
    const float gate_s = ((const float*)(ws + WS_GATE))[n * 24 + hd * 3 + 1];
    const bf16* oc = (const bf16*)(ws + WS_OCMP) + mix_off(n, hd * 64 + 4 * h, 512); const bf16* ow = (const bf16*)(ws + WS_OWIN) + mix_off(n, hd * 64 + 4 * h, 512);
    u64 ocv[8], owv[8];
    ATTN_FOR_CHUNKS(db, g4) { ocv[4 * db + g4] = *(const u64*)(oc + (4 * db + g4) * 256); owv[4 * db + g4] = *(const u64*)(ow + (4 * db + g4) * 256); }
    const u64* sel = (const u64*)(ws + WS_SEL) + (size_t)bg * T_;
    const u64 mine = sel[t_lane]; u64 un = sel[64 * cc + lane];
    { unsigned ul = (unsigned)un, uh = (unsigned)(un >> 32);
#pragma unroll
      for (int o = 1; o < 64; o <<= 1) { ul |= shflx_u(ul, o, lane); uh |= shflx_u(uh, o, lane); }
      un = ((u64)__builtin_amdgcn_readfirstlane(uh) << 32) | __builtin_amdgcn_readfirstlane(ul); }
#if AC2_MODE == 0
    attn_core<64, 1, false, true, true, NOMAX_ON>(L, Ksl, nullptr, Vsl, nullptr, 0.f,
                                  Qf, un, t_lane, tw0, 1 << 30, alibi_slope(hd + 1, 8) * LOG2E, (unsigned)mine, (unsigned)(mine >> 32), O, M, Ls, tid, false, cc, kpre, vpre);
    if (NOMAX_ON && block_any(sum_bad(Ls[0]), (LAS u64*)(L + A_LDS_END + 64), wave, lane)) {
#pragma unroll
        for (int i = 0; i < 16; ++i) { O[0][0][i] = 0.f; O[0][1][i] = 0.f; }
        M[0] = 0.f; Ls[0] = 0.f;
        attn_core<64, 1, false, true, false, false>(L, Ksl, nullptr, Vsl, nullptr, 0.f, Qf, un, t_lane, tw0, 1 << 30, alibi_slope(hd + 1, 8) * LOG2E, (unsigned)mine, (unsigned)(mine >> 32), O, M, Ls, tid);
    }
#else
    attn_core2<false, true>(L, (const bf16*)(ws + WS_KV6 + 2 * KV6_STRIDE) + (size_t)bg * T_ * 64, (const bf16*)(ws + WS_KV6 + 3 * KV6_STRIDE) + (size_t)bg * T_ * 64, nullptr, 0.f,
                            Qf[0], un, t_lane, tw0, 1 << 30, alibi_slope(hd + 1, 8) * LOG2E, (unsigned)mine, (unsigned)(mine >> 32), O[0], M[0], Ls[0], tid);
#endif
    const float lt = swap_sum(Ls[0]), inv = (lt > 0.f ? 1.f / lt : 0.f) * gate_s;
    bf16* dst = (bf16*)(ws + WS_ATT) + mix_off(n, hd * 64 + 4 * h, 1024);
    ATTN_FOR_CHUNKS(db, g4) { const u64 a = ocv[4 * db + g4], w = owv[4 * db + g4];
        const float x0 = O[0][db][4 * g4 + 0] * inv + __uint_as_float((unsigned)a << 16) + __uint_as_float((unsigned)w << 16);
        const float x1 = O[0][db][4 * g4 + 1] * inv + __uint_as_float((unsigned)a & 0xffff0000u) + __uint_as_float((unsigned)w & 0xffff0000u);
        const float x2 = O[0][db][4 * g4 + 2] * inv + __uint_as_float((unsigned)(a >> 32) << 16) + __uint_as_float((unsigned)(w >> 32) << 16);
        const float x3 = O[0][db][4 * g4 + 3] * inv + __uint_as_float((unsigned)(a >> 32) & 0xffff0000u) + __uint_as_float((unsigned)(w >> 32) & 0xffff0000u);
        *(u64*)(dst + (4 * db + g4) * 256) = (u64)cvtpk(x0, x1) | ((u64)cvtpk(x2, x3) << 32); }
}
__device__ __forceinline__ float other_half(float x, int h) { auto rr = __builtin_amdgcn_permlane32_swap(__float_as_uint(x), __float_as_uint(x), false, false); return __uint_as_float(h ? rr[0] : rr[1]); }
__device__ __forceinline__ int other_half_i(int x, int h) { auto rr = __builtin_amdgcn_permlane32_swap((unsigned)x, (unsigned)x, false, false); return (int)(h ? rr[0] : rr[1]); }
template <bool MASK>
__device__ __forceinline__ void cmp_scores(f32x16& p0, f32x16& p1, const LAS unsigned char* kt, const bf16x8v (&Qf)[4], float b0, float s1, int cl, int nvis_l) {
    const float s8 = s1 * 8.f, s32 = s1 * 32.f;
    p0[0] = b0; p0[1] = p0[0] + s1; p0[2] = p0[1] + s1; p0[3] = p0[2] + s1;
#pragma unroll
    for (int reg = 4; reg < 16; ++reg) p0[reg] = p0[reg - 4] + s8;
#pragma unroll
    for (int reg = 0; reg < 16; ++reg) p1[reg] = p0[reg] + s32;
#pragma unroll
    for (int s = 0; s < 4; ++s) { const bf16x8v kf0 = *(const LAS bf16x8v*)(kt + s * 32), kf1 = *(const LAS bf16x8v*)(kt + 32 * 144 + s * 32);
        p0 = __builtin_amdgcn_mfma_f32_32x32x16_bf16(kf0, Qf[s], p0, 0, 0, 0); p1 = __builtin_amdgcn_mfma_f32_32x32x16_bf16(kf1, Qf[s], p1, 0, 0, 0); }
    if (MASK) {
#pragma unroll
        for (int reg = 0; reg < 16; ++reg) { const int c = cl + crow0(reg); p0[reg] = (c < nvis_l) ? p0[reg] : -INFINITY; p1[reg] = (c + 32 < nvis_l) ? p1[reg] : -INFINITY; } }
}
__device__ __forceinline__ void U_cmp(KP p_, int bg_, int u_) {
    const KP p = uni_kp(p_); const int bg = __builtin_amdgcn_readfirstlane(bg_), uu = __builtin_amdgcn_readfirstlane(u_);
    int tid_ = threadIdx.x; asm volatile("" : "+v"(tid_));
    const int tid = tid_, lane = tid & 63, wave = __builtin_amdgcn_readfirstlane(tid >> 6), r = lane & 31, h = lane >> 5;
    unsigned char* ws = p->ws; asm volatile("" : "+s"(ws)); LAS unsigned char* L = (LAS unsigned char*)lds_raw;
    const int b = bg >> 1, g = bg & 1, tw0 = 32 * (uu + 16 * (wave < 4 ? wave : 11 - wave)), t_lane = tw0 + r;
    { const bf16* kc = (const bf16*)(ws + WS_KVCMP) + (size_t)bg * 256 * 64; const bf16* vc = kc + 16 * 256 * 64;
      u32x4 kq[4], vq[4];
#pragma unroll
      for (int i = 0; i < 4; ++i) { const int ch = tid + 512 * i, row = ch >> 3, c8 = ch & 7; kq[i] = *(const u32x4*)(kc + row * 64 + c8 * 8); vq[i] = *(const u32x4*)(vc + row * 64 + c8 * 8); }
#pragma unroll
      for (int i = 0; i < 4; ++i) { asm volatile("" : "+v"(kq[i])); asm volatile("" : "+v"(vq[i])); }
#pragma unroll
      for (int i = 0; i < 4; ++i) { const int ch = tid + 512 * i, row = ch >> 3, c8 = ch & 7;
          *(LAS u32x4*)(L + row * 144 + c8 * 16) = kq[i]; *(LAS u32x4*)(L + 36864 + row * 144 + c8 * 16) = vq[i]; } }
    __syncthreads();
    const int nvis_l = t_lane >= 31 ? ((t_lane - 31) >> 4) + 1 : 0, nvis_max = (tw0 >> 4) + 1, nvis_min = tw0 >= 31 ? ((tw0 - 31) >> 4) + 1 : 0, ntile = (nvis_max + 63) >> 6;
    const LAS unsigned char* kfrag = L + r * 144 + h * 16;
    const LAS unsigned char* vfrag = L + 36864 + (4 * h + ((lane & 15) >> 2)) * 144 + (16 * ((lane >> 4) & 1) + 4 * (lane & 3)) * 2;
    float imp[32];
#pragma unroll
    for (int e = 0; e < 32; ++e) imp[e] = 0.f;
    const float* gate = (const float*)(ws + WS_GATE) + ((size_t)b * T_ + t_lane) * 24;
#pragma unroll 1
    for (int hg = 0; hg < 4; ++hg) {
        const int hd = g * 4 + hg; const float s1 = alibi_slope(hd + 1, 8) * LOG2E * 16.f;
        const bf16* q = (const bf16*)(ws + WS_QN) + (size_t)(b * 8 + hd) * T_ * 64 + (t_lane >> 4) * 1024 + (t_lane & 15) * 32 + 8 * h;
        bf16x8v Qf[4];
#pragma unroll
        for (int s = 0; s < 4; ++s) Qf[s] = *(const bf16x8v*)(q + (s >> 1) * 512 + (s & 1) * 16);
        f32x16 O0, O1;
#pragma unroll
        for (int i = 0; i < 16; ++i) { O0[i] = 0.f; O1[i] = 0.f; }
        float oscale = 0.f; bool bad;
        {
        float lsum = 0.f, carry = 0.f; float ih[32];
#pragma unroll
        for (int e = 0; e < 32; ++e) ih[e] = 0.f;
#pragma unroll
        for (int jt = 0; jt < 4; ++jt) if (jt < ntile) {
            f32x16 p0, p1; const float b0 = s1 * (float)(64 * jt + 4 * h - nvis_max);
            if (64 * jt + 63 >= nvis_min) cmp_scores<true>(p0, p1, kfrag + jt * (64 * 144), Qf, b0, s1, 64 * jt + 4 * h, nvis_l);
            else cmp_scores<false>(p0, p1, kfrag + jt * (64 * 144), Qf, b0, s1, 64 * jt + 4 * h, nvis_l);
            float rs = 0.f;
#pragma unroll
            for (int reg = 0; reg < 16; ++reg) { p0[reg] = __builtin_amdgcn_exp2f(p0[reg]); p1[reg] = __builtin_amdgcn_exp2f(p1[reg]); rs += p0[reg] + p1[reg]; }
            lsum += rs;
            float cv[8];
#pragma unroll
            for (int g4 = 0; g4 < 4; ++g4) { const float h0 = 0.5f * p0[4 * g4 + 3], h1 = 0.5f * p1[4 * g4 + 3];
                ih[jt * 8 + g4] += ((p0[4 * g4] + p0[4 * g4 + 1]) + p0[4 * g4 + 2]) + h0; ih[jt * 8 + 4 + g4] += ((p1[4 * g4] + p1[4 * g4 + 1]) + p1[4 * g4 + 2]) + h1;
                cv[g4] = h0; cv[4 + g4] = h1; }
            float prev = carry;
#pragma unroll
            for (int k = 0; k < 8; ++k) { const float sv = other_half(cv[k], h); ih[jt * 8 + k] += h ? sv : prev; prev = sv; }
            carry = prev;
            const bf16x8v pa0 = pack8(p0, 0), pa1 = pack8(p0, 8), pa2 = pack8(p1, 0), pa3 = pack8(p1, 8);
            const LAS unsigned char* vb = vfrag + jt * (64 * 144);
#pragma unroll
            for (int ks = 0; ks < 4; ++ks) { const bf16x8v pa = ks == 0 ? pa0 : ks == 1 ? pa1 : ks == 2 ? pa2 : pa3;
                { const s16x4 lo = tr_read(vb + ks * (16 * 144)), hi = tr_read(vb + ks * (16 * 144) + 8 * 144); const bf16x8v vf = {lo[0], lo[1], lo[2], lo[3], hi[0], hi[1], hi[2], hi[3]};
                  O0 = __builtin_amdgcn_mfma_f32_32x32x16_bf16(vf, pa, O0, 0, 0, 0); }
                { const s16x4 lo = tr_read(vb + ks * (16 * 144) + 64), hi = tr_read(vb + ks * (16 * 144) + 64 + 8 * 144); const bf16x8v vf = {lo[0], lo[1], lo[2], lo[3], hi[0], hi[1], hi[2], hi[3]};
                  O1 = __builtin_amdgcn_mfma_f32_32x32x16_bf16(vf, pa, O1, 0, 0, 0); } }
        }
#ifdef FORCE_FALLBACK
        bad = true;
#else
        bad = __any(sum_bad(lsum));
#endif
        if (!bad) { const float lt = swap_sum(lsum), inv = lt > 0.f ? 1.f / lt : 0.f; oscale = inv;
#pragma unroll
            for (int e = 0; e < 32; ++e) imp[e] = fmaf(ih[e], inv, imp[e]); }
        }
        if (bad) {
        float m, lsum;
#pragma unroll
        for (int i = 0; i < 16; ++i) { O0[i] = 0.f; O1[i] = 0.f; }
        m = -1e30f; lsum = 0.f;
#pragma unroll 1
        for (int jt = 0; jt < ntile; ++jt) {
            f32x16 p0, p1; const float b0 = s1 * (float)(64 * jt + 4 * h - nvis_max);
            if (64 * jt + 63 >= nvis_min) cmp_scores<true>(p0, p1, kfrag + jt * (64 * 144), Qf, b0, s1, 64 * jt + 4 * h, nvis_l);
            else cmp_scores<false>(p0, p1, kfrag + jt * (64 * 144), Qf, b0, s1, 64 * jt + 4 * h, nvis_l);
            float mt = fmaxf(p0[0], p1[0]);
#pragma unroll
            for (int reg = 1; reg < 16; ++reg) mt = fmaxf(mt, fmaxf(p0[reg], p1[reg]));
            mt = swap_max(mt);
            const float mn = fmaxf(m, mt); float rs = 0.f;
#pragma unroll
            for (int reg = 0; reg < 16; ++reg) rs += __builtin_amdgcn_exp2f(p0[reg] - mn) + __builtin_amdgcn_exp2f(p1[reg] - mn);
            lsum = lsum * __builtin_amdgcn_exp2f(m - mn) + rs; m = mn;
        }
        const float lt = swap_sum(lsum), cnorm = lt > 0.f ? m + __builtin_amdgcn_logf(lt) : 1e30f;
        float carry = 0.f;
#pragma unroll
        for (int jt = 0; jt < 4; ++jt) if (jt < ntile) {
            f32x16 p0, p1; const float b0 = s1 * (float)(64 * jt + 4 * h - nvis_max) - cnorm;
            if (64 * jt + 63 >= nvis_min) cmp_scores<true>(p0, p1, kfrag + jt * (64 * 144), Qf, b0, s1, 64 * jt + 4 * h, nvis_l);
            else cmp_scores<false>(p0, p1, kfrag + jt * (64 * 144), Qf, b0, s1, 64 * jt + 4 * h, nvis_l);
#pragma unroll
            for (int reg = 0; reg < 16; ++reg) { p0[reg] = __builtin_amdgcn_exp2f(p0[reg]); p1[reg] = __builtin_amdgcn_exp2f(p1[reg]); }
            float cv[8];
#pragma unroll
            for (int g4 = 0; g4 < 4; ++g4) { const float h0 = 0.5f * p0[4 * g4 + 3], h1 = 0.5f * p1[4 * g4 + 3];
                imp[jt * 8 + g4] += ((p0[4 * g4] + p0[4 * g4 + 1]) + p0[4 * g4 + 2]) + h0; imp[jt * 8 + 4 + g4] += ((p1[4 * g4] + p1[4 * g4 + 1]) + p1[4 * g4 + 2]) + h1;
                cv[g4] = h0; cv[4 + g4] = h1; }
            float prev = carry;
#pragma unroll
            for (int k = 0; k < 8; ++k) { const float sv = other_half(cv[k], h); imp[jt * 8 + k] += h ? sv : prev; prev = sv; }
            carry = prev;
            const bf16x8v pa0 = pack8(p0, 0), pa1 = pack8(p0, 8), pa2 = pack8(p1, 0), pa3 = pack8(p1, 8);
            const LAS unsigned char* vb = vfrag + jt * (64 * 144);
#pragma unroll
            for (int ks = 0; ks < 4; ++ks) { const bf16x8v pa = ks == 0 ? pa0 : ks == 1 ? pa1 : ks == 2 ? pa2 : pa3;
                { const s16x4 lo = tr_read(vb + ks * (16 * 144)), hi = tr_read(vb + ks * (16 * 144) + 8 * 144); const bf16x8v vf = {lo[0], lo[1], lo[2], lo[3], hi[0], hi[1], hi[2], hi[3]};
                  O0 = __builtin_amdgcn_mfma_f32_32x32x16_bf16(vf, pa, O0, 0, 0, 0); }
                { const s16x4 lo = tr_read(vb + ks * (16 * 144) + 64), hi = tr_read(vb + ks * (16 * 144) + 64 + 8 * 144); const bf16x8v vf = {lo[0], lo[1], lo[2], lo[3], hi[0], hi[1], hi[2], hi[3]};
                  O1 = __builtin_amdgcn_mfma_f32_32x32x16_bf16(vf, pa, O1, 0, 0, 0); } }
        }
        oscale = 1.f;
        }
        const float gt = gate[hd * 3 + 0] * oscale;
        bf16* dst = (bf16*)(ws + WS_OCMP) + mix_off((size_t)b * T_ + t_lane, hd * 64 + 4 * h, 512);
#pragma unroll
        for (int g4 = 0; g4 < 4; ++g4) {
            *(u64*)(dst + g4 * 256) = (u64)cvtpk(O0[4 * g4 + 0] * gt, O0[4 * g4 + 1] * gt) | ((u64)cvtpk(O0[4 * g4 + 2] * gt, O0[4 * g4 + 3] * gt) << 32);
            *(u64*)(dst + (4 + g4) * 256) = (u64)cvtpk(O1[4 * g4 + 0] * gt, O1[4 * g4 + 1] * gt) | ((u64)cvtpk(O1[4 * g4 + 2] * gt, O1[4 * g4 + 3] * gt) << 32); }
    }
    const int cur = tw0 >> 6; u64 mask;
    if (cur <= 15) mask = (1ull << (cur + 1)) - 1ull;
    else {
        mask = 1ull | (1ull << cur) | (1ull << (cur - 1));
#pragma unroll
        for (int e = 0; e < 32; ++e) { const int j = 2 * e + h; if (j > cur || j == 0 || j >= cur - 1) imp[e] = -INFINITY; }
#pragma unroll 1
        for (int round = 0; round < 13; ++round) {
            float bv = imp[0]; int be = 0;
#pragma unroll
            for (int e = 1; e < 32; ++e) if (imp[e] > bv) { bv = imp[e]; be = e; }
            const int bj = 2 * be + h; const float ov = other_half(bv, h); const int oj = other_half_i(bj, h);
            const bool mine = bv > ov || (bv == ov && bj < oj);
            mask |= 1ull << (mine ? bj : oj);
#pragma unroll
            for (int e = 0; e < 32; ++e) imp[e] = (mine && e == be) ? -INFINITY : imp[e];
        }
    }
    if (h == 0) ((u64*)(ws + WS_SEL))[(size_t)bg * T_ + t_lane] = mask;
    __syncthreads();
}
constexpr int CONV_UNITS = L_ * NEXP * (2 * 16 * 8 + 4 * 32) / 32;
__device__ __forceinline__ void U_conv(KP p_, int k_) {
    const KP p = uni_kp(p_); const int k = __builtin_amdgcn_readfirstlane(k_);
    int tid_ = threadIdx.x; asm volatile("" : "+v"(tid_));
    const int tid = tid_, lane = tid & 63, wave = __builtin_amdgcn_readfirstlane(tid >> 6);
    unsigned char* ws = p->ws; asm volatile("" : "+s"(ws));
    LAS float* scr = (LAS float*)lds_raw + wave * (64 * 33);
    constexpr int I_G = 16 * 8, I_D = 4 * 32, I_E = 2 * I_G + I_D;
#pragma unroll 1
    for (int i = 0; i < 4; ++i) {
        const int m = k * 32 + i * 8 + wave, l = m / (NEXP * I_E); int r = m % (NEXP * I_E); const int e = r / I_E; r = r % I_E; const size_t le = (size_t)l * NEXP + e;
        const float* W; bf16* WT; int ldw, K, ncol, r0 = 0, rmul = 1; const float* gk = nullptr;
        if (r < 2 * I_G) { const int up = r >= I_G; r -= up * I_G; W = p->in[19 + up] + le * D_ * DEXP; WT = (bf16*)(ws + WS_WGU_T) + le * 512 * D_; ldw = DEXP; K = D_; ncol = 256; r0 = up; rmul = 2; gk = p->in[14] + (size_t)l * D_; }
        else { r -= 2 * I_G; W = p->in[21] + le * DEXP * D_; WT = (bf16*)(ws + WS_WD_T) + le * D_ * DEXP; ldw = D_; K = DEXP; ncol = 1024; }
        transpose_seg(W, ldw, K, 0, ncol, WT, r0, rmul, r, scr, lane, gk);
    }
}
__device__ __forceinline__ int fetch_unit(KP p, int qidx) {
    volatile LAS unsigned* slot = (volatile LAS unsigned*)((LAS unsigned char*)lds_raw + MISC_OFF) + 16;
    __syncthreads();
    int t0_ = threadIdx.x; asm volatile("" : "+v"(t0_));
    if (t0_ == 0) *slot = __hip_atomic_fetch_add((unsigned*)(p->ws + WS_CTL) + CW_QUEUE + 64 * qidx, 1u, __ATOMIC_RELAXED, __HIP_MEMORY_SCOPE_AGENT);
    __syncthreads();
    return (int)__builtin_amdgcn_readfirstlane(*slot);
}
__device__ __forceinline__ void P_cmp1_mfma(int l_) { const KP p = (KP)__builtin_amdgcn_kernarg_segment_ptr(); int l = l_; asm volatile("" : "+s"(l));
    unsigned char* ws = p->ws; asm volatile("" : "+s"(ws)); const int c = launder_s((int)blockIdx.x), kv = c >> 4, pm = c & 15;
    OneUnitOrder S; S.has = c < 32; S.u.pm = pm; S.u.pn = kv;
    S.u.a = (const char*)(ws + WS_KV6 + (size_t)kv * KV6_STRIDE) + (size_t)pm * 256 * 1024 * 2; S.u.b = (const char*)((const bf16*)(ws + WS_W1_T) + ((size_t)l * 2 + kv) * 256 * 2048); S.u.b2 = S.u.b;
    const pg8::Gemm g{1024, 2048, 2048, 32, 0, 0};
    const EpiCmpH E{(bf16*)(ws + WS_HC), (const float*)(ws + WS_BIAS1) + l * 512};
    pg8::gemm_phase<EpiCmpH, OneUnitOrder, false, true>((LAS unsigned char*)lds_raw, g, S, E);
}
__device__ __forceinline__ void P_cmp2_mfma(int l_) { const KP p = (KP)__builtin_amdgcn_kernarg_segment_ptr(); int l = l_; asm volatile("" : "+s"(l));
    unsigned char* ws = p->ws; asm volatile("" : "+s"(ws)); const int c = launder_s((int)blockIdx.x), kv = c >> 4, pm = c & 15;
    OneUnitOrder S; S.has = c < 32; S.u.pm = pm; S.u.pn = kv;
    S.u.a = (const char*)((const bf16*)(ws + WS_HC) + ((size_t)kv * 4096 + pm * 256) * 256); S.u.b = (const char*)((const bf16*)(ws + WS_W2_T) + ((size_t)l * 2 + kv) * 64 * 256); S.u.b2 = S.u.b;
    const pg8::Gemm g{256, 256, 256, 4, 0, 0};
    const EpiCmpOut E{(bf16*)(ws + WS_KVCMP)};
    pg8::gemm_phase<EpiCmpOut, OneUnitOrder, false, true>((LAS unsigned char*)lds_raw, g, S, E);
}
__device__ __forceinline__ void P_moe_scatter(KP p_, int l_) { const KP p = uni_kp(p_); const int l = __builtin_amdgcn_readfirstlane(l_); const Ctx c = make_ctx(p); unsigned char* ws = p->ws;
    const unsigned* cnt = (const unsigned*)(ws + WS_CTL) + CW_MOECNT + l * MOE_LS;
    moe_build_tables(cnt, c.tid);
    const LAS int* T = (const LAS int*)((LAS unsigned char*)lds_raw + TBL_OFF);
    const unsigned* info = (const unsigned*)(ws + WS_ROUTE + RT_INFO); const float* tw = (const float*)(ws + WS_ROUTE + RT_W);
    int* rowtok = (int*)(ws + WS_ROUTE + RT_ROWTOK); float* roww = (float*)(ws + WS_ROUTE + RT_ROWW);
    bf16* xs = (bf16*)(ws + WS_XS); const bf16* x = (const bf16*)(ws + WS_HN); const float* gain = p->in[14] + (size_t)l * D_; const float* rstdv = (const float*)(ws + WS_ROUTE + RT_RSTD);
    { constexpr int RB = 4; float gg[2][8];
#pragma unroll
      for (int j = 0; j < 2; ++j) { const f32x4 a = ((const f32x4*)gain)[2 * c.lane + 128 * j], b2 = ((const f32x4*)gain)[2 * c.lane + 128 * j + 1]; gg[j][0] = a.x; gg[j][1] = a.y; gg[j][2] = a.z; gg[j][3] = a.w; gg[j][4] = b2.x; gg[j][5] = b2.y; gg[j][6] = b2.z; gg[j][7] = b2.w; }
      for (int row0 = c.gw * RB; row0 < NT; row0 += c.ngw * RB) {
        u32x4 vv[RB][2];
#pragma unroll
        for (int q = 0; q < RB; ++q)
#pragma unroll
            for (int j = 0; j < 2; ++j) vv[q][j] = ((const u32x4*)(x + (size_t)(row0 + q) * D_))[c.lane + 64 * j];
#pragma unroll
        for (int q = 0; q < RB; ++q) { const int row = row0 + q;
            const unsigned v = info[row]; const int cls = (int)(v >> 24), rank = (int)(v & 0xffffffu); const size_t dest = (size_t)T[cls] * 256 + rank; const float r = rstdv[row];
#pragma unroll
            for (int j = 0; j < 2; ++j) { float f[8]; unpack8(vv[q][j], f); u32x4 o; o.x = pk2(f[0] * r * gg[j][0], f[1] * r * gg[j][1]); o.y = pk2(f[2] * r * gg[j][2], f[3] * r * gg[j][3]); o.z = pk2(f[4] * r * gg[j][4], f[5] * r * gg[j][5]); o.w = pk2(f[6] * r * gg[j][6], f[7] * r * gg[j][7]);
                ((u32x4*)(xs + dest * D_))[c.lane + 64 * j] = o; }
            if (c.lane == 0) { rowtok[dest] = row; roww[2 * dest] = tw[2 * row]; roww[2 * dest + 1] = tw[2 * row + 1]; } }
      } }
    for (int cls = c.bid; cls < 112; cls += c.G) { const int n = (int)cnt[cls * MOE_CS], end = (int)((cnt[cls * MOE_CS] + 255u) >> 8) * 256; const size_t base = (size_t)T[cls] * 256;
        for (int r = n + c.tid; r < end; r += NTHREADS) rowtok[base + r] = -1; }
}
__device__ __forceinline__ int xcd_major(int bid, int G) { bid = launder_s(bid); return (G & 7) ? bid : (bid & 7) * (G >> 3) + (bid >> 3); }
__device__ __forceinline__ void P_moe_g1(int l_) { const KP p = (KP)__builtin_amdgcn_kernarg_segment_ptr(); int l = l_; asm volatile("" : "+s"(l));
    unsigned char* ws = p->ws; asm volatile("" : "+s"(ws));
    { int t0_ = threadIdx.x; asm volatile("" : "+v"(t0_)); moe_build_tables((const unsigned*)(ws + WS_CTL) + CW_MOECNT + l * MOE_LS, t0_); }
    const MoeOrder1 S{(const char*)ws, (const unsigned*)(ws + WS_REC), (const char*)((const bf16*)(ws + WS_WGU_T) + (size_t)l * NEXP * 512 * D_), (unsigned*)(ws + WS_CTL) + CW_MOECNT + l * MOE_LS + (112 + NEXP) * MOE_CS, (int)gridDim.x, xcd_major((int)blockIdx.x, (int)gridDim.x)};
    const pg8::Gemm g{D_, D_, D_, D_ / 64, 0, 0};
    const EpiMoeH E{(bf16*)(ws + WS_HB), (const u32x4*)(ws + WS_REC)};
    pg8::gemm_phase<EpiMoeH, MoeOrder1, true, true, true>((LAS unsigned char*)lds_raw, g, S, E);
}
__device__ __forceinline__ void P_moe_g2(int l_) { const KP p = (KP)__builtin_amdgcn_kernarg_segment_ptr(); int l = l_; asm volatile("" : "+s"(l));
    unsigned char* ws = p->ws; asm volatile("" : "+s"(ws));
    { int t0_ = threadIdx.x; asm volatile("" : "+v"(t0_)); moe_build_tables((const unsigned*)(ws + WS_CTL) + CW_MOECNT + l * MOE_LS, t0_); }
    const MoeOrder2 S{(const char*)(ws + WS_HB), (const char*)((const bf16*)(ws + WS_WD_T) + (size_t)l * NEXP * D_ * DEXP), (const unsigned*)(ws + WS_CTL) + CW_MOECNT + l * MOE_LS + (112 + NEXP) * MOE_CS, (unsigned*)(ws + WS_CTL) + XB_TMO + 4096, (int)gridDim.x, xcd_major((int)blockIdx.x, (int)gridDim.x)};
    const pg8::Gemm g{512, DEXP, 512, 4, 16, 16};
    const EpiMoeOut E{(bf16*)(ws + WS_HN), (const unsigned*)(ws + WS_RECC)};
    pg8::gemm_phase<EpiMoeOut, MoeOrder2, true, true>((LAS unsigned char*)lds_raw, g, S, E);
}
__device__ __forceinline__ void P_bias1(KP p_) { const KP p = uni_kp(p_); int t_ = threadIdx.x; asm volatile("" : "+v"(t_));
    const int i = launder_s((int)blockIdx.x) * NTHREADS + t_; if (i < L_ * 2 * 256) { const float* part = (const float*)(p->ws + WS_B1PART) + (size_t)(i >> 8) * 128 * 256 + (i & 255); float a = 0.f;
        for (int k = 0; k < 128; ++k) a += part[(size_t)k * 256]; ((float*)(p->ws + WS_BIAS1))[i] = a; } }
__device__ __forceinline__ void P_norm1(KP p_, int l_) { const KP p = uni_kp(p_); const int l = __builtin_amdgcn_readfirstlane(l_); const Ctx c = make_ctx(p); const Bufs b = make_bufs(p->ws);
    if (l == 0) ph_norm_bf16(c, p->in[0], p->in[1], (bf16*)p->out, (bf16*)(p->ws + WS_HN)); else ph_norm_bf16_from_bf16(c, (const bf16*)(p->ws + WS_HN), p->in[1] + (size_t)l * D_, (bf16*)p->out); }
__device__ __noinline__ void P_inproj(KP p_, int l_) { const KP p = uni_kp(p_); const int l = __builtin_amdgcn_readfirstlane(l_); const Ctx c = make_ctx(p); const Bufs b = make_bufs(p->ws);
    InProjOut o{b.QN, b.KV6, b.FQ, b.DQ, b.DV, b.GATE, b.FL, p->in[3] + l * 24, p->in[4] + l * 4};
    const bf16* A = b.HN;
    naive_gemm(c, NT, D_IN, D_, [=](int r, int k) { return bf2f(A[(size_t)r * D_ + k]); }, p->in[2] + (size_t)l * D_ * D_IN, D_IN,
               [=](int r, int col, float v) { inproj_store(o, r, col, v); }); }
__device__ __noinline__ void P_cmp1(KP p_, int l_, int kv_) { const KP p = uni_kp(p_); const int l = __builtin_amdgcn_readfirstlane(l_), kv = __builtin_amdgcn_readfirstlane(kv_); const Ctx c = make_ctx(p); const Bufs b = make_bufs(p->ws);
    const bf16* src = kv == 0 ? b.KC : b.VC; const float* pe = p->in[kv == 0 ? 5 : 8] + (size_t)l * 2048; bf16* hc = b.HC + (size_t)kv * 4096 * 256;
    naive_gemm(c, 4096, 256, 2048, [=](int r, int k) { return bf2f(src[(size_t)r * 1024 + k]) + pe[k]; }, p->in[kv == 0 ? 6 : 9] + (size_t)l * 2048 * 256, 256,
               [=](int r, int col, float v) { hc[(size_t)r * 256 + col] = (bf16)f2bf(gelu_tanh(v)); }); }
__device__ __noinline__ void P_cumsum(KP p_, int l_) { const KP p = uni_kp(p_); const int l = __builtin_amdgcn_readfirstlane(l_); const Ctx c = make_ctx(p); const Bufs b = make_bufs(p->ws); ph_cumsum(c, b.FL); }
__device__ __noinline__ void P_cmp2(KP p_, int l_, int kv_) { const KP p = uni_kp(p_); const int l = __builtin_amdgcn_readfirstlane(l_), kv = __builtin_amdgcn_readfirstlane(kv_); const Ctx c = make_ctx(p); const Bufs b = make_bufs(p->ws);
    const bf16* hc = b.HC + (size_t)kv * 4096 * 256; bf16* dst = kv == 0 ? b.KCMP : b.VCMP;
    naive_gemm(c, 4096, 64, 256, [=](int r, int k) { return bf2f(hc[(size_t)r * 256 + k]); }, p->in[kv == 0 ? 7 : 10] + (size_t)l * 256 * 64, 64,
               [=](int r, int col, float v) { dst[(size_t)r * 64 + col] = (bf16)f2bf((r & 255) == 255 ? 0.f : v); }); }
__device__ __noinline__ void P_win(KP p_, int l_) { const KP p = uni_kp(p_); const int l = __builtin_amdgcn_readfirstlane(l_); const Ctx c = make_ctx(p); const Bufs b = make_bufs(p->ws); ph_win_attn(c, b.QN, b.KW, b.VW, b.GATE, b.OWIN); }
__device__ __noinline__ void P_fox(KP p_, int l_) { const KP p = uni_kp(p_); const int l = __builtin_amdgcn_readfirstlane(l_); const Ctx c = make_ctx(p); const Bufs b = make_bufs(p->ws); ph_fox_attn(c, b.FQ, b.FK, b.FV, b.FL, b.ATT); }
__device__ __noinline__ void P_diff(KP p_, int l_) { const KP p = uni_kp(p_); const int l = __builtin_amdgcn_readfirstlane(l_); const Ctx c = make_ctx(p); const Bufs b = make_bufs(p->ws);
    ph_diff_attn(c, b.DQ, b.DK, b.DV, p->in[11] + (size_t)l * 128, p->in[12] + (size_t)l * 64, lambda_init_of(l), b.ATT); }
__device__ __noinline__ void P_cmpattn(KP p_, int l_) { const KP p = uni_kp(p_); const int l = __builtin_amdgcn_readfirstlane(l_); const Ctx c = make_ctx(p); const Bufs b = make_bufs(p->ws); ph_cmp_attn(c, b.QN, b.KCMP, b.VCMP, b.GATE, b.SEL, b.OCMP); }
__device__ __noinline__ void P_slc(KP p_, int l_) { const KP p = uni_kp(p_); const int l = __builtin_amdgcn_readfirstlane(l_); const Ctx c = make_ctx(p); const Bufs b = make_bufs(p->ws); ph_slc_attn(c, b.QN, b.KS, b.VS, b.GATE, b.SEL, b.OCMP, b.OWIN, b.ATT); }
__device__ __noinline__ void P_outproj(KP p_, int l_) { const KP p = uni_kp(p_); const int l = __builtin_amdgcn_readfirstlane(l_); const Ctx c = make_ctx(p); const Bufs b = make_bufs(p->ws);
    const bf16* A = b.ATT; float* xo = p->out; const float* xin = (l == 0) ? p->in[0] : p->out;
    naive_gemm(c, NT, D_, D_, [=](int r, int k) { return bf2f(A[(size_t)r * D_ + k]); }, p->in[13] + (size_t)l * D_ * D_, D_,
               [=](int r, int col, float v) { xo[(size_t)r * D_ + col] = xin[(size_t)r * D_ + col] + v; }); }
__device__ __forceinline__ void P_route3(int l_, int cbank) { const KP p = (KP)__builtin_amdgcn_kernarg_segment_ptr(); int l = l_; asm volatile("" : "+s"(l));
    int tid_ = threadIdx.x; asm volatile("" : "+v"(tid_));
    const int tid = tid_, lane = tid & 63, wave = __builtin_amdgcn_readfirstlane(tid >> 6), r = lane & 31, h = lane >> 5, kh = wave >> 2, wr = wave & 3;
    unsigned char* ws = p->ws; asm volatile("" : "+s"(ws)); const bf16* x = (const bf16*)(ws + WS_HN);
    const float* WR = (const float*)(ws + WS_WR) + (size_t)l * D_ * 64;
    LAS float* XT = (LAS float*)lds_raw + wave * (32 * 36);
    LAS float* WT = (LAS float*)lds_raw + 8 * 32 * 36 + kh * (2 * 32 * 64);
    LAS float* PL = (LAS float*)lds_raw + 8 * 32 * 36 + 2 * 2 * 32 * 64;
    LAS float* SS = PL + 2 * 128 * 40;
    const float* bgrp = p->in[16] + l * 4; const float* bexp = p->in[18] + l * 32;
    unsigned* cnt = (unsigned*)(ws + WS_CTL) + CW_MOECNT + l * MOE_LS + cbank;
    LAS unsigned* HIST = (LAS unsigned*)(SS + 2 * 128 * 2);
    for (int grp = launder_s((int)blockIdx.x); grp < NT / 128; grp += (int)gridDim.x) {
        const int row0 = grp * 128 + wr * 32;
        if (tid < 144) HIST[tid] = 0u;
        f32x16 acc0, acc1; float ss = 0.f;
#pragma unroll
        for (int i = 0; i < 16; ++i) { acc0[i] = 0.f; acc1[i] = 0.f; }
        { const u32x4* xsrc = (const u32x4*)(x + (size_t)(row0 + r) * D_ + kh * 512 + 8 * h);
          const u32x4* wsrc = (const u32x4*)(ws + WS_WR) + ((size_t)l * 64 + kh * 32) * 256 + lane;
#pragma unroll 4
          for (int ks = 0; ks < 32; ++ks) {
              const u32x4 av = xsrc[2 * ks], b0h = wsrc[ks * 256], b0l = wsrc[ks * 256 + 64], b1h = wsrc[ks * 256 + 128], b1l = wsrc[ks * 256 + 192];
              { float f_[8]; unpack8(av, f_);
#pragma unroll
                for (int e = 0; e < 8; ++e) ss = fmaf(f_[e], f_[e], ss); }
              const bf16x8v A = __builtin_bit_cast(bf16x8v, av);
              acc0 = __builtin_amdgcn_mfma_f32_32x32x16_bf16(A, __builtin_bit_cast(bf16x8v, b0h), acc0, 0, 0, 0); acc1 = __builtin_amdgcn_mfma_f32_32x32x16_bf16(A, __builtin_bit_cast(bf16x8v, b1h), acc1, 0, 0, 0);
              acc0 = __builtin_amdgcn_mfma_f32_32x32x16_bf16(A, __builtin_bit_cast(bf16x8v, b0l), acc0, 0, 0, 0); acc1 = __builtin_amdgcn_mfma_f32_32x32x16_bf16(A, __builtin_bit_cast(bf16x8v, b1l), acc1, 0, 0, 0);
          } }
#pragma unroll
        for (int reg = 0; reg < 16; ++reg) { const int row = wr * 32 + crow0(reg) + 4 * h; PL[(kh * 128 + row) * 40 + r] = acc0[reg]; if (r < 4) PL[(kh * 128 + row) * 40 + 32 + r] = acc1[reg]; }
        SS[(kh * 128 + wr * 32 + r) * 2 + h] = ss;
        __syncthreads();
        int cls = 0, ea = 0, eb = 0; unsigned lrank = 0u, lra = 0u, lrb = 0u; float wlo = 0.f, whi = 0.f, rstd = 0.f;
        if (tid < 128) {
            float lg[36];
#pragma unroll
            for (int cidx = 0; cidx < 36; ++cidx) lg[cidx] = PL[tid * 40 + cidx] + PL[(128 + tid) * 40 + cidx];
            const float sq = (SS[tid * 2] + SS[tid * 2 + 1]) + (SS[(128 + tid) * 2] + SS[(128 + tid) * 2 + 1]);
            rstd = rsqrtf(sq * (1.f / D_) + EPS);
            float gl[4]; int grp_i = 0;
#pragma unroll
            for (int q = 0; q < 4; ++q) gl[q] = lg[q] * rstd + bgrp[q];
            float gm = gl[0];
#pragma unroll
            for (int q = 1; q < 4; ++q) if (gl[q] > gm) { gm = gl[q]; grp_i = q; }
            float gs = 0.f;
#pragma unroll
            for (int q = 0; q < 4; ++q) gs += __expf(gl[q] - gm);
            const float grp_gate = 1.f / gs;
            float el[8];
#pragma unroll
            for (int q = 0; q < 8; ++q) { float v = lg[4 + q]; float bb = bexp[q];
                if (grp_i == 1) { v = lg[12 + q]; bb = bexp[8 + q]; } else if (grp_i == 2) { v = lg[20 + q]; bb = bexp[16 + q]; } else if (grp_i == 3) { v = lg[28 + q]; bb = bexp[24 + q]; }
                el[q] = v * rstd + bb; }
            int i0 = 0; float v0 = el[0];
#pragma unroll
            for (int q = 1; q < 8; ++q) if (el[q] > v0) { v0 = el[q]; i0 = q; }
            int i1 = -1; float v1 = -INFINITY;
#pragma unroll
            for (int q = 0; q < 8; ++q) if (q != i0 && el[q] > v1) { v1 = el[q]; i1 = q; }
            const float e1 = __expf(v1 - v0), den = 1.f + e1, w0 = grp_gate / den, w1 = grp_gate * e1 / den;
            const int lo = i0 < i1 ? i0 : i1, hi = i0 < i1 ? i1 : i0; cls = grp_i * 28 + lo * 8 - (lo * (lo + 1)) / 2 + (hi - lo - 1);
            wlo = i0 < i1 ? w0 : w1; whi = i0 < i1 ? w1 : w0;
            ea = grp_i * 8 + lo; eb = grp_i * 8 + hi;
            lrank = __hip_atomic_fetch_add(HIST + cls, 1u, __ATOMIC_RELAXED, __HIP_MEMORY_SCOPE_WORKGROUP);
            lra = __hip_atomic_fetch_add(HIST + 112 + ea, 1u, __ATOMIC_RELAXED, __HIP_MEMORY_SCOPE_WORKGROUP); lrb = __hip_atomic_fetch_add(HIST + 112 + eb, 1u, __ATOMIC_RELAXED, __HIP_MEMORY_SCOPE_WORKGROUP);
        }
        __syncthreads();
        if (tid < 144) { const unsigned n = HIST[tid]; if (n) HIST[144 + tid] = __hip_atomic_fetch_add(cnt + tid * MOE_CS, n, __ATOMIC_RELAXED, __HIP_MEMORY_SCOPE_AGENT); }
        __syncthreads();
        if (tid < 128) {
            const unsigned rank = HIST[144 + cls] + lrank, ra = HIST[144 + 112 + ea] + lra, rb = HIST[144 + 112 + eb] + lrb;
            const int row = grp * 128 + tid;
            ((unsigned*)(ws + WS_RECC))[(size_t)cls * 32768 + rank] = (unsigned)row;
            const unsigned info = ((unsigned)cls << 16) | rank;
            ((u32x4*)(ws + WS_REC))[(size_t)ea * 32768 + ra] = (u32x4){(unsigned)row, __float_as_uint(wlo), __float_as_uint(rstd), info};
            ((u32x4*)(ws + WS_REC))[(size_t)eb * 32768 + rb] = (u32x4){(unsigned)row, __float_as_uint(whi), __float_as_uint(rstd), info | 0x8000u};
        }
        __syncthreads();
    }
}
typedef float f32x8 __attribute__((ext_vector_type(8)));
__device__ __forceinline__ void P_route2(int l_, int cbank) { const KP p = (KP)__builtin_amdgcn_kernarg_segment_ptr(); int l = l_; asm volatile("" : "+s"(l));
    int tid_ = threadIdx.x; asm volatile("" : "+v"(tid_));
    const int tid = tid_, lane = tid & 63, wave = __builtin_amdgcn_readfirstlane(tid >> 6);
    unsigned char* ws = p->ws; asm volatile("" : "+s"(ws)); const float* x = p->out;
    const float* WR = (const float*)(ws + WS_WR) + (size_t)l * D_ * 40;
    LAS float* xt = (LAS float*)lds_raw + wave * (64 * 36);
    LAS float* part = (LAS float*)lds_raw;
    const float* bgrp = p->in[16] + l * 4; const float* bexp = p->in[18] + l * 32;
    unsigned* cnt = (unsigned*)(ws + WS_CTL) + CW_MOECNT + l * 128 + cbank;
    for (int grp = launder_s((int)blockIdx.x); grp < NT / 128; grp += (int)gridDim.x) {
        const int row0 = grp * 128 + (wave >> 2) * 64, kq = wave & 3;
        float acc[40]; float ss = 0.f;
#pragma unroll
        for (int cidx = 0; cidx < 40; ++cidx) acc[cidx] = 0.f;
#pragma unroll 1
        for (int kc = 0; kc < 8; ++kc) {
            const int k0 = kq * 256 + kc * 32;
#pragma unroll
            for (int i = 0; i < 8; ++i) { const int row = i * 8 + (lane >> 3), c4 = (lane & 7) * 4; *(LAS f32x4*)(xt + row * 36 + c4) = *(const f32x4*)(x + (size_t)(row0 + row) * D_ + k0 + c4); }
            float xr[32];
#pragma unroll
            for (int j = 0; j < 8; ++j) { const f32x4 t = *(const LAS f32x4*)(xt + lane * 36 + 4 * j); xr[4 * j] = t.x; xr[4 * j + 1] = t.y; xr[4 * j + 2] = t.z; xr[4 * j + 3] = t.w; }
            const float* wk = WR + (size_t)k0 * 40;
#pragma unroll
            for (int kk = 0; kk < 32; ++kk) {
                f32x8 w0, w1, w2, w3, w4;
                asm volatile("s_load_dwordx8 %0, %5, %6\n\ts_load_dwordx8 %1, %5, %7\n\ts_load_dwordx8 %2, %5, %8\n\ts_load_dwordx8 %3, %5, %9\n\ts_load_dwordx8 %4, %5, %10\n\ts_waitcnt lgkmcnt(0)"
                             : "=&s"(w0), "=&s"(w1), "=&s"(w2), "=&s"(w3), "=&s"(w4) : "s"(wk), "i"(kk * 160), "i"(kk * 160 + 32), "i"(kk * 160 + 64), "i"(kk * 160 + 96), "i"(kk * 160 + 128) : "memory");
                const float xv = xr[kk]; ss = fmaf(xv, xv, ss);
#pragma unroll
                for (int e = 0; e < 8; ++e) { acc[e] = fmaf(xv, w0[e], acc[e]); acc[8 + e] = fmaf(xv, w1[e], acc[8 + e]); acc[16 + e] = fmaf(xv, w2[e], acc[16 + e]); acc[24 + e] = fmaf(xv, w3[e], acc[24 + e]); }
#pragma unroll
                for (int e = 0; e < 4; ++e) acc[32 + e] = fmaf(xv, w4[e], acc[32 + e]);
            }
        }
        __syncthreads();
#pragma unroll
        for (int cidx = 0; cidx < 36; ++cidx) part[(wave * 64 + lane) * 37 + cidx] = acc[cidx];
        part[(wave * 64 + lane) * 37 + 36] = ss;
        __syncthreads();
        if (tid < 128) {
            const int rg = tid >> 6, rr = tid & 63; float lg[37];
#pragma unroll
            for (int cidx = 0; cidx < 37; ++cidx) lg[cidx] = ((part[((rg * 4 + 0) * 64 + rr) * 37 + cidx] + part[((rg * 4 + 1) * 64 + rr) * 37 + cidx]) + part[((rg * 4 + 2) * 64 + rr) * 37 + cidx]) + part[((rg * 4 + 3) * 64 + rr) * 37 + cidx];
            const float rstd = rsqrtf(lg[36] * (1.f / D_) + EPS);
            float gl[4]; int grp_i = 0;
#pragma unroll
            for (int q = 0; q < 4; ++q) gl[q] = lg[q] * rstd + bgrp[q];
            float gm = gl[0];
#pragma unroll
            for (int q = 1; q < 4; ++q) if (gl[q] > gm) { gm = gl[q]; grp_i = q; }
            float gs = 0.f;
#pragma unroll
            for (int q = 0; q < 4; ++q) gs += __expf(gl[q] - gm);
            const float grp_gate = 1.f / gs;
            float el[8];
#pragma unroll
            for (int q = 0; q < 8; ++q) { float v = lg[4 + q]; float bb = bexp[q];
                if (grp_i == 1) { v = lg[12 + q]; bb = bexp[8 + q]; } else if (grp_i == 2) { v = lg[20 + q]; bb = bexp[16 + q]; } else if (grp_i == 3) { v = lg[28 + q]; bb = bexp[24 + q]; }
                el[q] = v * rstd + bb; }
            int i0 = 0; float v0 = el[0];
#pragma unroll
            for (int q = 1; q < 8; ++q) if (el[q] > v0) { v0 = el[q]; i0 = q; }
            int i1 = -1; float v1 = -INFINITY;
#pragma unroll
            for (int q = 0; q < 8; ++q) if (q != i0 && el[q] > v1) { v1 = el[q]; i1 = q; }
            const float e1 = __expf(v1 - v0), den = 1.f + e1, w0 = grp_gate / den, w1 = grp_gate * e1 / den;
            const int lo = i0 < i1 ? i0 : i1, hi = i0 < i1 ? i1 : i0, cls = grp_i * 28 + lo * 8 - (lo * (lo + 1)) / 2 + (hi - lo - 1);
            const unsigned rank = __hip_atomic_fetch_add(cnt + cls, 1u, __ATOMIC_RELAXED, __HIP_MEMORY_SCOPE_AGENT);
            const int row = grp * 128 + tid;
            ((unsigned*)(ws + WS_ROUTE + RT_INFO))[row] = ((unsigned)cls << 24) | rank;
            ((float*)(ws + WS_ROUTE + RT_W))[2 * row] = i0 < i1 ? w0 : w1; ((float*)(ws + WS_ROUTE + RT_W))[2 * row + 1] = i0 < i1 ? w1 : w0;
            ((float*)(ws + WS_ROUTE + RT_RSTD))[row] = rstd;
        }
        __syncthreads();
    }
}
__device__ __noinline__ void P_route(KP p_, int l_) { const KP p = uni_kp(p_); const int l = __builtin_amdgcn_readfirstlane(l_); const Ctx c = make_ctx(p); const Bufs b = make_bufs(p->ws);
    ph_moe_route(c, p->out, p->in[14] + (size_t)l * D_, p->in[15] + (size_t)l * D_ * 4, p->in[16] + l * 4, p->in[17] + (size_t)l * D_ * 32, p->in[18] + l * 32, b.HN, (int*)(p->ws + WS_ROUTE + RT_INFO), (float*)(p->ws + WS_ROUTE + RT_W), (unsigned*)(p->ws + WS_CTL) + CW_MOECNT + l * 128); }
__device__ __noinline__ void P_moe(KP p_, int l_) { const KP p = uni_kp(p_); const int l = __builtin_amdgcn_readfirstlane(l_); const Ctx c = make_ctx(p); const Bufs b = make_bufs(p->ws);
    ph_moe_naive(c, b.HN, b.ROUTE_E, b.ROUTE_W, p->in[19] + (size_t)l * NEXP * D_ * DEXP, p->in[20] + (size_t)l * NEXP * D_ * DEXP, p->in[21] + (size_t)l * NEXP * DEXP * D_, p->out); }
__device__ __noinline__ void P_final(KP p_) { const KP p = uni_kp(p_); const Ctx c = make_ctx(p); ph_norm_final_from_bf16(c, (const bf16*)(p->ws + WS_HN), p->in[22], p->out); }
__device__ __forceinline__ void P_gridbar(KP p_) { const KP p = uni_kp(p_);
    XcdBarrier bar; bar.bar = (unsigned*)(p->ws + WS_CTL) + 4096; bar.x = xb_xcc_id(); bar.st = (volatile LAS unsigned*)((LAS unsigned char*)lds_raw + MISC_OFF) + 8;
    xcd_barrier(bar);
}

__global__ void __launch_bounds__(NTHREADS, 2) fwd_kernel(Params pp) {
    const KP p = (KP)__builtin_amdgcn_kernarg_segment_ptr();
    { volatile LAS unsigned* MISC = (volatile LAS unsigned*)((LAS unsigned char*)lds_raw + MISC_OFF); if (threadIdx.x < 32) MISC[threadIdx.x] = 0u; }
    __syncthreads();
    const int lo = p->ph_lo, hi = p->ph_hi;
    if (hi - lo > 1) (void)xcd_barrier_post((unsigned*)(p->ws + WS_CTL) + 4096, (volatile LAS unsigned*)((LAS unsigned char*)lds_raw + MISC_OFF) + 8);
#define IN(k) (lo <= (k) && (k) < hi)
#define SEAM(k) do { if (IN(k) && IN((k) + 1)) P_gridbar(p); } while (0)
    if (IN(0)) { for (int rep = 0; rep < REP_PRO; ++rep) { if (rep) P_gridbar(p); P_prologue(p); } }
    for (int l = 0; l < L_; ++l) {
        const int P0 = 1 + l * PH_PER_LAYER;
        if (IN(P0 + 0)) { for (int rep = 0; rep < REP_NORM; ++rep) { if (rep) P_gridbar(p); P_norm1(p, l); } }
        SEAM(P0 + 0);
        if (IN(P0 + 1)) { if (l == 0) P_bias1(p);
            for (int rep = 0; rep < REP_INPROJ; ++rep) { if (rep) P_gridbar(p); P_inproj_mfma(l); }
#ifdef REP_INDUMMY
            for (int rep = 0; rep < REP_INDUMMY; ++rep) { P_gridbar(p); P_inproj_dummy(l); }
#endif
        }
        SEAM(P0 + 1);
        if (IN(P0 + 3)) {
            P_cmp1_mfma(l);
            if (launder_s((int)blockIdx.x) < 32) { asm volatile("s_waitcnt vmcnt(0)" ::: "memory"); __builtin_amdgcn_fence(__ATOMIC_SEQ_CST, "agent"); asm volatile("s_waitcnt vmcnt(0)" ::: "memory"); }
            __syncthreads();
            P_cmp2_mfma(l);
            for (int rep = 0; rep < REP_ATT3; ++rep) { if (rep) P_gridbar(p);
            for (;;) { int u = fetch_unit(p, l * 8 + 0 + 16 * rep);
                if (l == 0) {
                    if (u >= 2048 + CONV_UNITS) break;
                    const int k11 = u / 11, r11 = u - 11 * k11;
                    if (r11 == 3 || r11 == 7 || r11 == 10) { U_conv(p, 3 * k11 + (r11 > 3) + (r11 > 7)); continue; }
                    u = 8 * k11 + r11 - (r11 > 3) - (r11 > 7); }
                else if (u >= 2048) break;
                if (u < 1024) { const int qb = 15 - (u >> 6), k = u & 63; if (k < 32) U_diff(p, k, qb, l); else U_fox(p, k - 32, qb, l); }
                else { const int w = u - 1024; U_win(p, w & 15, 63 - (w >> 4));
#ifdef PROBE_WINUNIT2
                    U_win(p, w & 15, 63 - (w >> 4));
#endif
                } } } }
        SEAM(P0 + 3);
        if (IN(P0 + 4)) { for (int rep = 0; rep < REP_CMP; ++rep) { if (rep) P_gridbar(p); for (int u = launder_s((int)blockIdx.x); u < 256; u += (int)gridDim.x) U_cmp(p, u & 15, u >> 4); } }
        SEAM(P0 + 4);
        if (IN(P0 + 5)) { for (int rep = 0; rep < REP_SLC; ++rep) { if (rep) P_gridbar(p); for (;;) { const int u = fetch_unit(p, l * 8 + 1 + 16 * rep); if (u >= 1024) break; U_slc(p, u & 15, 63 - (u >> 4)); } } }
        SEAM(P0 + 5);
        if (IN(P0 + 6)) P_outproj_mfma(l);
        SEAM(P0 + 6);
        if (IN(P0 + 7)) { for (int rep = 0; rep < REP_ROUTE; ++rep) { if (rep) P_gridbar(p); P_route3(l, REP_ROUTE - 1 - rep); } }
        SEAM(P0 + 7);
        if (IN(P0 + 9)) { for (int rep = 0; rep < REP_G1; ++rep) { if (rep) P_gridbar(p); P_moe_g1(l); } }
        if (IN(P0 + 10)) P_moe_g2(l);
        SEAM(P0 + 10);
    }
    if (IN(1 + L_ * PH_PER_LAYER)) P_final(p);
#undef IN
#undef SEAM
}

extern "C" void kernel_launch(void* const* d_in, const int* in_sizes, int n_in, void* d_out, int out_size, void* d_ws, size_t ws_size, hipStream_t stream) {
    static int grid = 0;
    if (grid == 0) {
        if (n_in != 23 || out_size != NT * D_ || ws_size < WS_END) { fprintf(stderr, "kernel_launch: unexpected sizes n_in %d out %d ws %zu (need %zu)\n", n_in, out_size, ws_size, (size_t)WS_END); grid = -1; return; }
        int dev = 0, cus = 0, per_cu = 0;
        if (hipGetDevice(&dev) != hipSuccess || hipDeviceGetAttribute(&cus, hipDeviceAttributeMultiprocessorCount, dev) != hipSuccess) { grid = -1; return; }
        if (hipFuncSetAttribute((const void*)fwd_kernel, hipFuncAttributeMaxDynamicSharedMemorySize, LDS_BYTES) != hipSuccess) { fprintf(stderr, "kernel_launch: hipFuncSetAttribute failed\n"); grid = -1; return; }
        if (hipOccupancyMaxActiveBlocksPerMultiprocessor(&per_cu, (const void*)fwd_kernel, NTHREADS, LDS_BYTES) != hipSuccess || per_cu < 1) { fprintf(stderr, "kernel_launch: occupancy query says %d\n", per_cu); }
        (void)hipGetLastError();
        grid = cus;
    }
    if (grid < 0) return;
    (void)hipMemsetAsync((char*)d_ws + WS_CTL, 0, CTL_BYTES, stream);
    Params p{};
    for (int i = 0; i < 23; ++i) p.in[i] = (const float*)d_in[i];
    p.out = (float*)d_out; p.ws = (unsigned char*)d_ws;
#if N_LAUNCH_MODE == 0
    p.ph_lo = 0; p.ph_hi = N_PHASES;
    hipLaunchKernelGGL(fwd_kernel, dim3(grid), dim3(NTHREADS), LDS_BYTES, stream, p);
#else
    for (int k = 0; k < N_PHASES; ++k) { p.ph_lo = k; p.ph_hi = k + 1; hipLaunchKernelGGL(fwd_kernel, dim3(grid), dim3(NTHREADS), LDS_BYTES, stream, p); }
#endif
}
```

```cpp
#include <hip/hip_runtime.h>
#include <cstdio>
#include <cstdint>

#ifndef INPROJ_ALIGN
#define INPROJ_ALIGN true
#endif
#ifndef INPROJ_SP2
#define INPROJ_SP2 true
#endif
#ifndef REP_PRO
#define REP_PRO 1
#endif
#ifndef REP_ROUTE
#define REP_ROUTE 1
#endif
#ifndef REP_NORM
#define REP_NORM 1
#endif
#ifndef REP_INPROJ
#define REP_INPROJ 1
#endif
#ifndef REP_ATT3
#define REP_ATT3 1
#endif
#ifndef REP_CMP
#define REP_CMP 1
#endif
#ifndef REP_SLC
#define REP_SLC 1
#endif
#ifndef REP_SCAT
#define REP_SCAT 1
#endif
#ifndef REP_G1
#define REP_G1 1
#endif
#ifndef N_LAUNCH_MODE
#define N_LAUNCH_MODE 0
#endif

#ifndef NOMAX_ON
#define NOMAX_ON true
#endif
#define LAS __attribute__((address_space(3)))
#define GAS __attribute__((address_space(1)))
typedef unsigned short bf16;
typedef unsigned long long u64;
typedef float f32x4 __attribute__((ext_vector_type(4)));
typedef unsigned u32x4 __attribute__((ext_vector_type(4)));

constexpr int B_ = 8, T_ = 4096, D_ = 1024, NT = B_ * T_, L_ = 2;
constexpr int HD = 64, D_IN = 2844;
constexpr int N_CMP = 255, CMP_HID = 256;
constexpr int NEXP = 32, DEXP = 256;
constexpr float EPS = 1e-6f;
constexpr float LOG2E = 1.4426950408889634f;
constexpr int NWAVES = 8, NTHREADS = 512;

constexpr int C_NSAQ = 0, C_KV6 = 512, C_GATE = 1280, C_FQ = 1304, C_FF = 2072, C_DQ = 2076, C_DV = 2588;

constexpr size_t MiB = 1u << 20;
constexpr size_t WS_CTL = 0, CTL_BYTES = 1 * MiB;
constexpr size_t WS_QN = 1 * MiB;
constexpr size_t WS_KV6 = WS_QN + 32 * MiB;
constexpr size_t KV6_STRIDE = 8 * MiB + 64 * 1024;
constexpr size_t WS_FQKV = WS_KV6 + 6 * KV6_STRIDE;
constexpr size_t WS_DQK = WS_FQKV + 48 * MiB;
constexpr size_t WS_DV = WS_DQK + 32 * MiB;
constexpr size_t WS_GATE = WS_DV + 16 * MiB;
constexpr size_t WS_FL = WS_GATE + 3 * MiB;
constexpr size_t WS_HC = WS_FL + 1 * MiB;
constexpr size_t WS_KVCMP = WS_HC + 4 * MiB;
constexpr size_t WS_SEL = WS_KVCMP + 1 * MiB;
constexpr size_t WS_OCMP = WS_SEL + 1 * MiB;
constexpr size_t WS_OWIN = WS_OCMP + 32 * MiB;
constexpr size_t WS_HN = WS_OWIN + 32 * MiB;
constexpr size_t WS_ATT = WS_HN + 64 * MiB;
constexpr size_t WS_ROUTE = WS_ATT + 64 * MiB;
constexpr size_t WS_WIN_T = WS_ROUTE + 2 * MiB;
constexpr size_t WS_WOUT_T = WS_WIN_T + 12 * MiB;
constexpr size_t WS_WGU_T = WS_WOUT_T + 4 * MiB;
constexpr size_t WS_WD_T = WS_WGU_T + 64 * MiB;
constexpr size_t WS_W1_T = WS_WD_T + 32 * MiB;
constexpr size_t WS_W2_T = WS_W1_T + 4 * MiB;
constexpr size_t WS_BIAS1 = WS_W2_T + 512 * 1024;
constexpr size_t WS_WR = WS_BIAS1 + 512 * 1024;
constexpr size_t WS_B1PART = WS_WR + 512 * 1024;
constexpr size_t WS_END = WS_B1PART + 512 * 1024;
constexpr int MOE_MAXROWS = 61440;
constexpr size_t WS_XS = WS_QN;
constexpr size_t WS_HB = WS_OCMP;
static_assert(WS_XS + (size_t)MOE_MAXROWS * 2048 <= WS_DQK && WS_HB + (size_t)MOE_MAXROWS * 1024 <= WS_HN, "MoE aliases");
constexpr size_t RT_INFO = 0, RT_W = 128 * 1024, RT_ROWTOK = 384 * 1024, RT_ROWW = 640 * 1024, RT_RSTD = 1152 * 1024;
constexpr int CW_QUEUE = 16384, CW_MOECNT = 32768, CW_KN = 49152, MOE_CS = 32, MOE_LS = 8192;
constexpr size_t WS_REC = WS_QN;
constexpr size_t WS_RECC = WS_REC + (size_t)NEXP * 32768 * 16;
constexpr unsigned ZROW_OFF = 512 * 1024;
static_assert(WS_RECC + (size_t)112 * 32768 * 4 <= WS_DQK && WS_HN + (size_t)NT * 2048 < (1ull << 32) && CW_MOECNT + L_ * MOE_LS <= CW_KN && (112 + 2 * NEXP) * MOE_CS <= MOE_LS, "MoE record tables / 32-bit row offsets / counters");
constexpr int RSTD_OFF = 131072 + 8192;
constexpr size_t WS_SSQ = WS_HB + 60 * MiB;
constexpr int TBL_OFF = 131072 + 1024;
constexpr int NIN = 3072;

extern __shared__ __attribute__((aligned(16))) unsigned char lds_raw[];
__device__ __forceinline__ float bf2f(bf16 v) { return __uint_as_float(((unsigned)v) << 16); }
__device__ __forceinline__ unsigned f2bf(float f) { unsigned u = __float_as_uint(f); return (u + 0x7fffu + ((u >> 16) & 1u)) >> 16; }
__device__ __forceinline__ unsigned pk2(float lo, float hi) { return f2bf(lo) | (f2bf(hi) << 16); }
__device__ __forceinline__ float wave_sum(float v) {
#pragma unroll
    for (int o = 1; o < 64; o <<= 1) v += __shfl_xor(v, o);
    return v;
}
__device__ __forceinline__ float wave_max(float v) {
#pragma unroll
    for (int o = 1; o < 64; o <<= 1) v = fmaxf(v, __shfl_xor(v, o));
    return v;
}
__device__ __forceinline__ float shflx_f(float v, int o, int lane) { return __uint_as_float((unsigned)__builtin_amdgcn_ds_bpermute((lane ^ o) << 2, (int)__float_as_uint(v))); }
__device__ __forceinline__ unsigned shflx_u(unsigned v, int o, int lane) { return (unsigned)__builtin_amdgcn_ds_bpermute((lane ^ o) << 2, (int)v); }
__device__ __forceinline__ float wave_sum_l(float v, int lane) {
#pragma unroll
    for (int o = 1; o < 64; o <<= 1) v += shflx_f(v, o, lane);
    return v;
}
__device__ __forceinline__ int launder_s(int v) { asm volatile("" : "+s"(v)); return v; }
__device__ __forceinline__ float sigmoidf_(float x) { return 1.f / (1.f + __expf(-x)); }
__device__ __forceinline__ float log_sigmoidf_(float x) { return x >= 0.f ? -log1pf(__expf(-x)) : x - log1pf(__expf(x)); }
__device__ __forceinline__ float gelu_tanh(float x) { const float u = 0.7978845608028654f * (x + 0.044715f * x * x * x); return 0.5f * x * (1.f + tanhf(u)); }
__device__ __forceinline__ float alibi_slope(int idx1, int n) { return exp2f(-8.0f * (float)idx1 / (float)n); }

__device__ __forceinline__ constexpr int b64_off(int t, int d) { return ((t >> 4) * 2 + (d >> 5)) * 512 + (t & 15) * 32 + (d & 31); }
#define XB_TMO      128
#define XB_XCNT(j)  (256  + 64 * (j))
#define XB_XSUB(j)  (1280 + 64 * (j))
#define XB_XGEN(j)  (2304 + 64 * (j))
#define XB_TOP      3328
#define XB_TOPGEN   3392
#define XCD_BAR_WORDS 3456
#define XB_SPIN_CAP (1u << 25)
__device__ __forceinline__ unsigned xb_ld(unsigned* p)              { return __hip_atomic_load(p, __ATOMIC_RELAXED, __HIP_MEMORY_SCOPE_AGENT); }
__device__ __forceinline__ unsigned xb_add(unsigned* p, unsigned v) { return __hip_atomic_fetch_add(p, v, __ATOMIC_RELAXED, __HIP_MEMORY_SCOPE_AGENT); }
__device__ __forceinline__ unsigned xb_xcc_id() { return (unsigned)__builtin_amdgcn_s_getreg((3 << 11) | 20) & 0xFu; }
#define XB_SPIN(cond, bar) do { unsigned _sp = 0; while (cond) { __builtin_amdgcn_s_sleep(1); \
    if ((++_sp & 255u) == 0u) { if (xb_ld(&(bar)[XB_TMO])) break; if (_sp > XB_SPIN_CAP) { atomicAdd(&(bar)[XB_TMO], 1u); break; } } } } while (0)
struct XcdBarrier { unsigned* bar; unsigned x; volatile LAS unsigned* st; };
__device__ __forceinline__ XcdBarrier xcd_barrier_post(unsigned* bar, volatile LAS unsigned* st) {
    XcdBarrier b; b.bar = bar; b.x = xb_xcc_id(); b.st = st;
    if (threadIdx.x == 0) (void)xb_add(&bar[XB_XCNT(b.x)], 1u);
    return b;
}
__device__ __forceinline__ void xcd_barrier_complete(unsigned* bar, unsigned x, unsigned& nloc, unsigned& nx) {
    const unsigned G = gridDim.x * gridDim.y * gridDim.z;
    unsigned sum, cnt, mine, sp = 0u;
    for (;;) {
        sum = 0u; cnt = 0u; mine = 0u;
#pragma unroll
        for (unsigned j = 0; j < 16; ++j) { const unsigned c = xb_ld(&bar[XB_XCNT(j)]); sum += c; cnt += (c > 0u) ? 1u : 0u; mine = (j == x) ? c : mine; }
        if (sum == G) break;
        __builtin_amdgcn_s_sleep(1);
        if ((++sp & 255u) == 0u) { if (xb_ld(&bar[XB_TMO])) break; if (sp > XB_SPIN_CAP) { atomicAdd(&bar[XB_TMO], 1u); break; } }
    }
    nloc = mine > 0u ? mine : 1u; nx = cnt > 0u ? cnt : 1u;
}
__device__ __forceinline__ void xcd_barrier(const XcdBarrier& b) {
    asm volatile("s_waitcnt vmcnt(0)" ::: "memory");
    __syncthreads();
    if (threadIdx.x == 0) {
        unsigned* bar = b.bar;
        __builtin_amdgcn_s_waitcnt(0);
        unsigned nloc = b.st[0], nx = b.st[1];
        if (nloc == 0u) { xcd_barrier_complete(bar, b.x, nloc, nx); b.st[0] = nloc; b.st[1] = nx; }
        const unsigned old = xb_add(&bar[XB_XSUB(b.x)], 1u);
        const unsigned gen = old / nloc;
        if (old + 1u == (gen + 1u) * nloc) {
            __builtin_amdgcn_fence(__ATOMIC_RELEASE, "agent");
            asm volatile("s_waitcnt vmcnt(0)" ::: "memory");
            const unsigned og = xb_add(&bar[XB_TOP], 1u);
            const unsigned tg = og / nx;
            if (og + 1u == (tg + 1u) * nx) xb_add(&bar[XB_TOPGEN], 1u);
            else XB_SPIN(xb_ld(&bar[XB_TOPGEN]) == tg, bar);
            __builtin_amdgcn_fence(__ATOMIC_ACQUIRE, "agent");
            xb_add(&bar[XB_XGEN(b.x)], 1u);
            asm volatile("s_waitcnt vmcnt(0)" ::: "memory");
        } else {
            XB_SPIN(xb_ld(&bar[XB_XGEN(b.x)]) == gen, bar);
            __builtin_amdgcn_fence(__ATOMIC_ACQUIRE, "agent");
            asm volatile("s_waitcnt vmcnt(0)" ::: "memory");
        }
    }
    __syncthreads();
}

struct Params { const float* in[23]; float* out; unsigned char* ws; int ph_lo, ph_hi; };
constexpr int LDS_BYTES = 147456;
constexpr int MISC_OFF = 131072 + 320;

struct Ctx {
    LAS unsigned char* lds; int tid, lane, wave, bid, G, gw, ngw;
    const float* const* in; float* xcur; unsigned char* ws;
};

namespace pg8 {
#define PG8_LAS __attribute__((address_space(3)))
typedef unsigned short bf16_t;
typedef short bf16x8 __attribute__((ext_vector_type(8)));
typedef float f32x4 __attribute__((ext_vector_type(4)));
typedef unsigned u32x4 __attribute__((ext_vector_type(4)));
constexpr int BM = 256, BK = 64, HALF = 128, HTB = HALF * BK * 2  , STAGE_BYTES = 8 * HTB, NXCD = 8, WGM = 8;

__host__ __device__ __forceinline__ int lds_byte(int r, int c) { const int st = (r >> 4) * 2 + (c >> 5), rr = r & 15, cc = c & 31, ob = rr * 64 + cc * 2; return st * 1024 + (ob ^ (((ob >> 9) & 1) << 5)); }
__host__ __device__ __forceinline__ void stage_rc(int b, int& R, int& C) { const int st = b / 1024, sb = b % 1024, swz = sb ^ (((sb >> 9) & 1) << 5); R = (st >> 1) * 16 + swz / 64; C = (st & 1) * 32 + (swz % 64) / 2; }
__host__ __device__ __forceinline__ int perm32(int rho) { const int n = rho >> 4, i = rho & 15; return 8 * (i >> 2) + 4 * n + (i & 3); }

struct Unit { int pm, pn; const char* a; const char* b; const char* b2; int hf; };
struct Gemm { int lda, ldb, K, ksplit, arb, acb; };

__device__ __forceinline__ unsigned cvt_pk_bf16(float lo, float hi) { unsigned r; asm volatile("v_cvt_pk_bf16_f32 %0, %1, %2" : "=v"(r) : "v"(lo), "v"(hi)); return r; }
typedef float f32x2 __attribute__((ext_vector_type(2)));

#define PG8_KLOOP(FULL_) _Pragma("unroll 1") \
        for (int t = 0; t < nt; t += 2) { \
            const bool last = (t == nt - 2); \
            const char* a1 = cA + (size_t)(t + 1) * kstepA; \
            const char* a2 = last ? nA : cA + (size_t)(t + 2) * kstepA; const char* b2 = last ? PG8_BK(nB, nB2, 0) : PG8_BK(cB, cB2, t + 2); \
            const char* a3 = a2 + kstepA; const char* b3 = last ? PG8_BK(nB, nB2, 1) : PG8_BK(cB, cB2, t + 3); \
            if (last && has_next) S.a_ready(nxt); \
            if constexpr (SP2) { \
            PG8_LDB(B0, 0, 0); PG8_LDB(B1, 0, 1); PG8_SCHED; PG8_LDA(At, 0, 0); \
            if constexpr (GATHER) PG8_STAGE_G(PG8_SA(1, 1), (size_t)(t + 1) * kstep, gC, 1); else PG8_STAGE(PG8_SA(1, 1), a1 + hsA, voffA); \
            PG8_WAIT_V(8); PG8_WAIT_L(0); PG8_BAR; PG8_MMA(0, 0, At, B0); PG8_MMA(0, 1, At, B1); PG8_BAR; PG8_SCHED; \
            if (FULL_) PG8_LDA(At, 0, 1); PG8_STAGE(PG8_SB(0, 0), b2, voffB); PG8_STAGE(PG8_SB(0, 1), b2 + hsB, voffB); \
            if constexpr (GATHER) { if (last) PG8_STAGE_G(PG8_SA(0, 0), 0, gN, 0); else PG8_STAGE_G(PG8_SA(0, 0), (size_t)(t + 2) * kstep, gC, 0); } else PG8_STAGE(PG8_SA(0, 0), a2, voffA); \
            PG8_WAIT_V(8); PG8_WAIT_L(0); PG8_BAR; if (FULL_) { PG8_MMA(1, 0, At, B0); PG8_MMA(1, 1, At, B1); } PG8_BAR; PG8_SCHED; \
            PG8_LDB(B0, 1, 0); PG8_LDB(B1, 1, 1); PG8_SCHED; PG8_LDA(At, 1, 0); \
            if constexpr (GATHER) { if (last) PG8_STAGE_G(PG8_SA(0, 1), 0, gN, 1); else PG8_STAGE_G(PG8_SA(0, 1), (size_t)(t + 2) * kstep, gC, 1); } else PG8_STAGE(PG8_SA(0, 1), a2 + hsA, voffA); \
            PG8_WAIT_V(8); PG8_WAIT_L(0); PG8_BAR; PG8_MMA(0, 0, At, B0); PG8_MMA(0, 1, At, B1); PG8_BAR; PG8_SCHED; \
            if (FULL_) PG8_LDA(At, 1, 1); PG8_STAGE(PG8_SB(1, 0), b3, voffB); PG8_STAGE(PG8_SB(1, 1), b3 + hsB, voffB); \
            if constexpr (GATHER) { if (last) PG8_STAGE_G(PG8_SA(1, 0), kstep, gN, 0); else PG8_STAGE_G(PG8_SA(1, 0), (size_t)(t + 3) * kstep, gC, 0); } else PG8_STAGE(PG8_SA(1, 0), a3, voffA); \
            PG8_WAIT_V(8); PG8_WAIT_L(0); PG8_BAR; if (FULL_) { PG8_MMA(1, 0, At, B0); PG8_MMA(1, 1, At, B1); } PG8_BAR; PG8_SCHED; \
            } else { \
            PG8_LDB(B0, 0, 0); PG8_SCHED; PG8_LDA(At, 0, 0); PG8_STAGE(PG8_SA(1, 1), a1 + hsA, voffA); \
            PG8_WAIT_L(8); PG8_BAR; PG8_WAIT_L(0); PG8_MMA(0, 0, At, B0); PG8_BAR; PG8_SCHED; \
            PG8_LDB(B1, 0, 1); PG8_STAGE(PG8_SB(0, 0), b2, voffB); \
            PG8_BAR; PG8_WAIT_L(0); PG8_MMA(0, 1, At, B1); PG8_BAR; \
            PG8_LDA(At, 0, 1); PG8_STAGE(PG8_SA(0, 0), a2, voffA); \
            PG8_BAR; PG8_WAIT_L(0); PG8_MMA(1, 0, At, B0); PG8_BAR; PG8_SCHED; \
            PG8_STAGE(PG8_SB(0, 1), b2 + hsB, voffB); \
            PG8_WAIT_V(6); PG8_BAR; PG8_MMA(1, 1, At, B1); PG8_BAR; \
            PG8_LDB(B0, 1, 0); PG8_SCHED; PG8_LDA(At, 1, 0); PG8_STAGE(PG8_SA(0, 1), a2 + hsA, voffA); \
            PG8_WAIT_L(8); PG8_BAR; PG8_WAIT_L(0); PG8_MMA(0, 0, At, B0); PG8_BAR; PG8_SCHED; \
            PG8_LDB(B1, 1, 1); PG8_STAGE(PG8_SB(1, 0), b3, voffB); \
            PG8_BAR; PG8_WAIT_L(0); PG8_MMA(0, 1, At, B1); PG8_BAR; \
            PG8_LDA(At, 1, 1); PG8_STAGE(PG8_SA(1, 0), a3, voffA); \
            PG8_BAR; PG8_WAIT_L(0); PG8_MMA(1, 0, At, B0); PG8_BAR; PG8_SCHED; \
            PG8_STAGE(PG8_SB(1, 1), b3 + hsB, voffB); \
            PG8_WAIT_V(6); PG8_BAR; PG8_MMA(1, 1, At, B1); PG8_BAR; \
            } \
        }
template <class Epi, class Sched, bool ALIGN_EPI = false, bool SP2 = false, bool GATHER = false, bool HALFSKIP = false>
__device__ __forceinline__ void gemm_phase(PG8_LAS unsigned char* lds, const Gemm g, const Sched& S, const Epi& E) {
    static_assert(!GATHER || SP2, "GATHER is written for the SP2 loop"); static_assert(!HALFSKIP || SP2, "HALFSKIP is written for the SP2 loop");
    int tid_ = threadIdx.x; asm volatile("" : "+v"(tid_));
    const int tid = tid_, wid = __builtin_amdgcn_readfirstlane(tid >> 6), lane = tid & 63, wr = wid >> 2, wc = wid & 3, fr = lane & 15, fq = lane >> 4;
    const int K = g.K, nt = K / BK, ks = g.ksplit;
    unsigned voffA[2], voffB[2];
#pragma unroll
    for (int i = 0; i < 2; ++i) { int R, C; stage_rc(tid * 16 + i * 8192, R, C); const int Rb = Epi::PERM ? ((R & ~31) + perm32(R & 31)) : R;
        voffA[i] = g.arb ? (unsigned)(((R / g.arb) * (K / g.acb) + C / g.acb) * (g.arb * g.acb) + (R % g.arb) * g.acb + (C % g.acb)) * 2u : (unsigned)(R * g.lda + C) * 2u; voffB[i] = (unsigned)(Rb * g.ldb + C) * 2u; }
    const size_t kstep = (size_t)(BK * 2), kstepA = g.arb ? (size_t)(BK * g.arb * 2) : kstep;
    const size_t hsA = (size_t)HALF * (g.arb ? K : g.lda) * 2, hsB = (size_t)HALF * g.ldb * 2;
    const unsigned ldsw = (unsigned)wid * 1024u;
    const int aoff = lds_byte(wr * 64 + fr, fq * 8), boff = lds_byte(wc * 32 + fr, fq * 8);
#define PG8_SA(b, h) (((b) * 2 + (h)) * HTB)
#define PG8_SB(b, h) ((4 + (b) * 2 + (h)) * HTB)
#define PG8_STAGE(bufoff, gbase, voff) do { _Pragma("unroll") for (int _i = 0; _i < 2; ++_i) \
        __builtin_amdgcn_global_load_lds((const unsigned*)((const char*)(gbase) + (voff)[_i]), (PG8_LAS unsigned*)(lds + (bufoff) + ldsw + _i * 8192), 16, 0, 0); } while (0)
#define PG8_LDA(dst, b, h) do { _Pragma("unroll") for (int m = 0; m < 4; ++m) _Pragma("unroll") for (int k = 0; k < 2; ++k) dst[m][k] = *(const PG8_LAS bf16x8*)(lds + PG8_SA(b, h) + aoff + m * 2048 + k * 1024); } while (0)
#define PG8_LDB(dst, b, h) do { _Pragma("unroll") for (int n = 0; n < 2; ++n) _Pragma("unroll") for (int k = 0; k < 2; ++k) dst[n][k] = *(const PG8_LAS bf16x8*)(lds + PG8_SB(b, h) + boff + n * 2048 + k * 1024); } while (0)
#define PG8_MMA(ai, bj, At, Bt) do { __builtin_amdgcn_s_setprio(1); _Pragma("unroll") for (int m = 0; m < 4; ++m) _Pragma("unroll") for (int n = 0; n < 2; ++n) _Pragma("unroll") for (int k = 0; k < 2; ++k) \
        acc[ai][bj][m][n] = __builtin_amdgcn_mfma_f32_16x16x32_bf16(Bt[n][k], At[m][k], acc[ai][bj][m][n], 0, 0, 0); __builtin_amdgcn_s_setprio(0); } while (0)
#define PG8_WAIT_V(n) asm volatile("s_waitcnt vmcnt(" #n ")" ::: "memory")
#define PG8_WAIT_L(n) asm volatile("s_waitcnt lgkmcnt(" #n ")" ::: "memory")
#define PG8_BAR __builtin_amdgcn_s_barrier()
#define PG8_SCHED __builtin_amdgcn_sched_barrier(0)
    Unit cur, nxt; int ui = 0;
    if (!S.next(0, cur)) return;
    unsigned gC[2][2] = {{0u, 0u}, {0u, 0u}}, gN[2][2] = {{0u, 0u}, {0u, 0u}}; const char* gbase = nullptr;
#define PG8_GOFFS(U, Gv) do { int R_, C_; stage_rc(tid * 16, R_, C_); S.arows4(U, R_, (unsigned)C_ * 2u, Gv); } while (0)
#define PG8_STAGE_G(bufoff, kbyte, Gv, h) do { _Pragma("unroll") for (int _i = 0; _i < 2; ++_i) \
        __builtin_amdgcn_global_load_lds((const unsigned*)(gbase + (size_t)(kbyte) + Gv[h][_i]), (PG8_LAS unsigned*)(lds + (bufoff) + ldsw + _i * 8192), 16, 0, 0); } while (0)
    if constexpr (GATHER) { gbase = S.abase(); PG8_GOFFS(cur, gC); }
    f32x4 acc[2][2][4][2];
#pragma unroll
    for (int a = 0; a < 2; ++a)
#pragma unroll
        for (int b = 0; b < 2; ++b)
#pragma unroll
            for (int m = 0; m < 4; ++m)
#pragma unroll
                for (int n = 0; n < 2; ++n) acc[a][b][m][n] = (f32x4){0.f, 0.f, 0.f, 0.f};
    bf16x8 At[4][2], B0[2][2], B1[2][2];
    const char* cA = cur.a; const char* cB = cur.b; const char* cB2 = cur.b2;
#define PG8_BK(base, base2, kt) ((kt) < ks ? (base) + (size_t)(kt) * kstep : (base2) + (size_t)((kt) - ks) * kstep)
    S.a_ready(cur);
    if constexpr (SP2) {
        PG8_STAGE(PG8_SB(0, 0), cB, voffB); PG8_STAGE(PG8_SB(0, 1), cB + hsB, voffB);
        if constexpr (GATHER) { PG8_STAGE_G(PG8_SA(0, 0), 0, gC, 0); PG8_STAGE_G(PG8_SA(0, 1), 0, gC, 1); } else { PG8_STAGE(PG8_SA(0, 0), cA, voffA); PG8_STAGE(PG8_SA(0, 1), cA + hsA, voffA); }
        if (wr == 1) PG8_BAR;
        PG8_WAIT_V(2); PG8_BAR;
        PG8_STAGE(PG8_SB(1, 0), PG8_BK(cB, cB2, 1), voffB);
        if constexpr (GATHER) PG8_STAGE_G(PG8_SA(1, 0), kstep, gC, 0); else PG8_STAGE(PG8_SA(1, 0), cA + kstepA, voffA);
        PG8_STAGE(PG8_SB(1, 1), PG8_BK(cB, cB2, 1) + hsB, voffB);
        PG8_WAIT_V(6); PG8_BAR;
    } else {
        PG8_STAGE(PG8_SB(0, 0), cB, voffB); PG8_STAGE(PG8_SA(0, 0), cA, voffA); PG8_STAGE(PG8_SB(0, 1), cB + hsB, voffB); PG8_STAGE(PG8_SA(0, 1), cA + hsA, voffA);
        if (wr == 1) PG8_BAR;
        PG8_WAIT_V(4); PG8_BAR;
        PG8_STAGE(PG8_SB(1, 0), PG8_BK(cB, cB2, 1), voffB); PG8_STAGE(PG8_SA(1, 0), cA + kstepA, voffA); PG8_STAGE(PG8_SB(1, 1), PG8_BK(cB, cB2, 1) + hsB, voffB);
        PG8_WAIT_V(6); PG8_BAR;
    }
    for (;;) {
        const bool has_next = S.next(ui + 1, nxt);
        if constexpr (GATHER) { if (has_next) PG8_GOFFS(nxt, gN); else { _Pragma("unroll") for (int _h = 0; _h < 2; ++_h) _Pragma("unroll") for (int _i = 0; _i < 2; ++_i) gN[_h][_i] = gC[_h][_i]; } }
        const char* nA = has_next ? nxt.a : cA; const char* nB = has_next ? nxt.b : cB; const char* nB2 = has_next ? nxt.b2 : cB2;
        bool full = true; if constexpr (HALFSKIP) full = __builtin_amdgcn_readfirstlane(cur.hf) == 0;
        if constexpr (HALFSKIP) { if (full) { PG8_KLOOP(true) } else { PG8_KLOOP(false) } } else { PG8_KLOOP(true) }
        if constexpr (ALIGN_EPI) { if (wr == 0) PG8_BAR; }
        if constexpr (!Epi::AFTER_DRAIN) { E(acc, cur, wr, wc, fr, fq); S.done(cur); }
        if (!has_next) break;
#pragma unroll
        for (int a = 0; a < 2; ++a)
#pragma unroll
            for (int b = 0; b < 2; ++b)
#pragma unroll
                for (int m = 0; m < 4; ++m)
#pragma unroll
                    for (int n = 0; n < 2; ++n) acc[a][b][m][n] = (f32x4){0.f, 0.f, 0.f, 0.f};
        cur = nxt; cA = nA; cB = nB; cB2 = nB2; ++ui;
        if constexpr (GATHER) { _Pragma("unroll") for (int _h = 0; _h < 2; ++_h) _Pragma("unroll") for (int _i = 0; _i < 2; ++_i) gC[_h][_i] = gN[_h][_i]; }
        if constexpr (ALIGN_EPI) { if (wr == 1) PG8_BAR; }
    }
    PG8_WAIT_V(0);
    if constexpr (!ALIGN_EPI) { if (wr == 0) PG8_BAR; }
    PG8_BAR;
    if constexpr (Epi::AFTER_DRAIN) { E.fused(acc, cur, wr, wc, fr, fq, lds, wid, lane); S.done(cur); }
#undef PG8_KLOOP
#undef PG8_BK
#undef PG8_GOFFS
#undef PG8_STAGE_G
#undef PG8_SA
#undef PG8_SB
#undef PG8_STAGE
#undef PG8_LDA
#undef PG8_LDB
#undef PG8_MMA
#undef PG8_WAIT_V
#undef PG8_WAIT_L
#undef PG8_BAR
#undef PG8_SCHED
}
}

__device__ __forceinline__ float local_const(float v) { asm volatile("" : "+v"(v)); return v; }
struct PlainOrder {
    const char* A; const char* Bt; int lda, ldb, nM, nN, nwg, G, c;
    __device__ __forceinline__ void init(const void* A_, const void* Bt_, int lda_, int ldb_, int M, int N, int G_, int c_) { A = (const char*)A_; Bt = (const char*)Bt_; lda = lda_; ldb = ldb_; nM = M / 256; nN = N / 256; nwg = nM * nN; G = G_; c = c_; }
    __device__ __forceinline__ bool next(int i, pg8::Unit& u) const {
        const long L = (long)i * G + c; if (L >= nwg) return false;
        int wgid = (int)L; { const int q = nwg / 8, r = nwg % 8, xcd = wgid % 8, off = wgid / 8; wgid = (xcd < r ? xcd * (q + 1) : r * (q + 1) + (xcd - r) * q) + off; }
        const int nig = 8 * nN, gid = wgid / nig, fm = gid * 8, gsz = (nM - fm) < 8 ? (nM - fm) : 8;
        u.pm = fm + ((wgid % nig) % gsz); u.pn = (wgid % nig) / gsz;
        u.a = A + (size_t)u.pm * 256 * lda * 2; u.b = Bt + (size_t)u.pn * 256 * ldb * 2; u.b2 = u.b; return true;
    }
    __device__ __forceinline__ void a_ready(const pg8::Unit&) const {}
    __device__ __forceinline__ void done(const pg8::Unit&) const {}
};
struct EpiInProj {
    static constexpr bool PERM = true, AFTER_DRAIN = false;
    unsigned char* ws; const float* b_gate; const float* b_fgt; unsigned* kn;
    __device__ __forceinline__ void operator()(const pg8::f32x4 (&acc)[2][2][4][2], const pg8::Unit& u, int wr, int wc, int fr, int fq) const {
        { int t_ = threadIdx.x; asm volatile("" : "+v"(t_)); fr = t_ & 15; fq = (t_ >> 4) & 3; }
        const int pn = u.pn, b = (u.pm * 256) / T_, t0 = u.pm * 256 - b * T_ + wr * 64 + fr;
        const LAS float* rt = (const LAS float*)((LAS unsigned char*)lds_raw + RSTD_OFF) + ((u.pm >> 3) & 1) * 256 + wr * 64 + fr;
        if (pn == 11) {
            if (wc == 0) {
                float* gate = (float*)(ws + WS_GATE); float* fl = (float*)(ws + WS_FL);
                float bias[8];
#pragma unroll
                for (int j = 0; j < 8; ++j) { const int c = 8 * fq + j; bias[j] = c < 24 ? b_gate[c] : (c < 28 ? b_fgt[c - 24] : 0.f); }
#pragma unroll
                for (int j = 0; j < 8; ++j) asm volatile("" : "+v"(bias[j]));
#pragma unroll
                for (int ai = 0; ai < 2; ++ai)
#pragma unroll
                    for (int m = 0; m < 4; ++m) { const int t = t0 + ai * 128 + m * 16; const size_t n = (size_t)b * T_ + t;
                        if (fq < 3) { float sg[8];
#pragma unroll
                            for (int j = 0; j < 8; ++j) sg[j] = __builtin_amdgcn_rcpf(1.f + __builtin_amdgcn_exp2f(-(acc[ai][0][m][j >> 2][j & 3] * rt[ai * 128 + m * 16] + bias[j]) * LOG2E));
                            f32x4* gp = (f32x4*)(gate + n * 24 + 8 * fq); gp[0] = (f32x4){sg[0], sg[1], sg[2], sg[3]}; gp[1] = (f32x4){sg[4], sg[5], sg[6], sg[7]}; }
                        else {
#pragma unroll
                            for (int e = 0; e < 4; ++e) { const float z = acc[ai][0][m][0][e] * rt[ai * 128 + m * 16] + bias[e];
                                fl[(size_t)(b * 4 + e) * T_ + t] = z < -30.f ? z : -0.6931471805599453f * __builtin_amdgcn_logf(1.f + __builtin_amdgcn_exp2f(-z * LOG2E)); } } }
            }
            return;
        }
        if (pn == 6 || pn == 9) {
            const int lane_ = (fq << 4) | fr;
#pragma unroll
            for (int bj = 0; bj < 2; ++bj)
#pragma unroll
                for (int ai = 0; ai < 2; ++ai) { float mx = 0.f;
#pragma unroll
                    for (int m = 0; m < 4; ++m) { const pg8::f32x4 v0 = acc[ai][bj][m][0], v1 = acc[ai][bj][m][1];
                        float ss = (v0[0] * v0[0] + v0[1] * v0[1]) + (v0[2] * v0[2] + v0[3] * v0[3]) + (v1[0] * v1[0] + v1[1] * v1[1]) + (v1[2] * v1[2] + v1[3] * v1[3]);
                        { const float rsr = rt[ai * 128 + m * 16]; ss *= rsr * rsr; }
                        { auto r16 = __builtin_amdgcn_permlane16_swap(__float_as_uint(ss), __float_as_uint(ss), false, false); ss = __uint_as_float(r16[0]) + __uint_as_float(r16[1]); }
                        { auto r32 = __builtin_amdgcn_permlane32_swap(__float_as_uint(ss), __float_as_uint(ss), false, false); ss = __uint_as_float(r32[0]) + __uint_as_float(r32[1]); }
                        mx = fmaxf(mx, ss); }
                    mx = fmaxf(mx, __uint_as_float(__builtin_amdgcn_update_dpp(__float_as_uint(mx), __float_as_uint(mx), 0x111, 0xf, 0xf, false)));
                    mx = fmaxf(mx, __uint_as_float(__builtin_amdgcn_update_dpp(__float_as_uint(mx), __float_as_uint(mx), 0x112, 0xf, 0xf, false)));
                    mx = fmaxf(mx, __uint_as_float(__builtin_amdgcn_update_dpp(__float_as_uint(mx), __float_as_uint(mx), 0x114, 0xf, 0xf, false)));
                    mx = fmaxf(mx, __uint_as_float(__builtin_amdgcn_update_dpp(__float_as_uint(mx), __float_as_uint(mx), 0x118, 0xf, 0xf, false)));
                    if (lane_ == 15) { const int cg = bj * 4 + wc, tile = (u.pm * 256 - b * T_ + ai * 128 + wr * 64) >> 6;
                        unsigned* dst = pn == 6 ? kn + ((b * 4 + (cg >> 1)) * 64 + tile) * 2 + (cg & 1) : kn + 4096 + (b * 8 + cg) * 64 + tile;
                        atomicMax(dst, __float_as_uint(mx)); } }
        }
#pragma unroll
        for (int bj = 0; bj < 2; ++bj) {
            const int c = bj * 128 + wc * 32 + 8 * fq;
            bf16* base; int W = 64; float sc = 1.f;
            if (pn < 2) { base = (bf16*)(ws + WS_QN) + (size_t)(b * 8 + pn * 4 + (c >> 6)) * T_ * 64 + (c & 63); sc = 0.125f * LOG2E; }
            else if (pn < 5) { base = (bf16*)(ws + WS_KV6 + (size_t)((pn - 2) * 2 + (c >> 7)) * KV6_STRIDE) + (size_t)(b * 2 + ((c >> 6) & 1)) * T_ * 64 + (c & 63); }
            else if (pn < 8) { base = (bf16*)(ws + WS_FQKV) + (size_t)(pn - 5) * (8 * MiB) + (size_t)(b * 4 + (c >> 6)) * T_ * 64 + (c & 63); if (pn == 5) sc = 0.125f * LOG2E; }
            else if (pn < 10) { base = (bf16*)(ws + WS_DQK) + (size_t)(pn - 8) * (8 * MiB) + (size_t)(b * 8 + (c >> 5)) * T_ * 32 + (c & 31); W = 32; if (pn == 8) sc = 0.17677669529663687f * LOG2E; }
            else { base = (bf16*)(ws + WS_DV) + (size_t)(b * 4 + (c >> 6)) * T_ * 64 + (c & 63); }
            const bool blk = W == 64 && pn != 2;
            if (blk) base += -(c & 63) + ((c >> 5) & 1) * 512 + (c & 31);
#pragma unroll
            for (int ai = 0; ai < 2; ++ai)
#pragma unroll
                for (int m = 0; m < 4; ++m) { const int t = t0 + ai * 128 + m * 16; const float rsc = sc * rt[ai * 128 + m * 16];
                    const pg8::f32x4 v0 = acc[ai][bj][m][0] * rsc, v1 = acc[ai][bj][m][1] * rsc;
                    pg8::u32x4 w; w.x = pg8::cvt_pk_bf16(v0[0], v0[1]); w.y = pg8::cvt_pk_bf16(v0[2], v0[3]); w.z = pg8::cvt_pk_bf16(v1[0], v1[1]); w.w = pg8::cvt_pk_bf16(v1[2], v1[3]);
                    *(pg8::u32x4*)(base + (blk ? (size_t)((t >> 4) * 1024 + (t & 15) * 32) : (size_t)t * W)) = w; }
        }
    }
};
__device__ __forceinline__ u32x4 res_add8(u32x4 w, const pg8::f32x4& a0, const pg8::f32x4& a1) {
    u32x4 o;
    o.x = pg8::cvt_pk_bf16(__uint_as_float(w.x << 16) + a0[0], __uint_as_float(w.x & 0xffff0000u) + a0[1]); o.y = pg8::cvt_pk_bf16(__uint_as_float(w.y << 16) + a0[2], __uint_as_float(w.y & 0xffff0000u) + a0[3]);
    o.z = pg8::cvt_pk_bf16(__uint_as_float(w.z << 16) + a1[0], __uint_as_float(w.z & 0xffff0000u) + a1[1]); o.w = pg8::cvt_pk_bf16(__uint_as_float(w.w << 16) + a1[2], __uint_as_float(w.w & 0xffff0000u) + a1[3]);
    return o;
}
struct EpiResBf16 {
    static constexpr bool PERM = true, AFTER_DRAIN = false;
    bf16* xr;
    __device__ __forceinline__ void operator()(const pg8::f32x4 (&acc)[2][2][4][2], const pg8::Unit& u, int wr, int wc, int fr, int fq) const {
        { int t_ = threadIdx.x; asm volatile("" : "+v"(t_)); fr = t_ & 15; fq = (t_ >> 4) & 3; }
#pragma unroll
        for (int ai = 0; ai < 2; ++ai) { u32x4 w[4][2];
#pragma unroll
            for (int m = 0; m < 4; ++m)
#pragma unroll
                for (int bj = 0; bj < 2; ++bj) w[m][bj] = *(const u32x4*)(xr + (size_t)(u.pm * 256 + ai * 128 + wr * 64 + m * 16 + fr) * D_ + u.pn * 256 + wc * 32 + 8 * fq + bj * 128);
#pragma unroll
            for (int m = 0; m < 4; ++m)
#pragma unroll
                for (int bj = 0; bj < 2; ++bj) asm volatile("" : "+v"(w[m][bj]));
#pragma unroll
            for (int m = 0; m < 4; ++m)
#pragma unroll
                for (int bj = 0; bj < 2; ++bj) *(u32x4*)(xr + (size_t)(u.pm * 256 + ai * 128 + wr * 64 + m * 16 + fr) * D_ + u.pn * 256 + wc * 32 + 8 * fq + bj * 128) = res_add8(w[m][bj], acc[ai][bj][m][0], acc[ai][bj][m][1]); }
    }
};


struct EpiDummy {
    static constexpr bool PERM = true, AFTER_DRAIN = false;
    float* dst;
    __device__ __forceinline__ void operator()(const pg8::f32x4 (&acc)[2][2][4][2], const pg8::Unit& u, int wr, int wc, int fr, int fq) const {
        pg8::f32x4 a = {0.f, 0.f, 0.f, 0.f};
#pragma unroll
        for (int ai = 0; ai < 2; ++ai)
#pragma unroll
            for (int bj = 0; bj < 2; ++bj)
#pragma unroll
                for (int m = 0; m < 4; ++m) { a = a + acc[ai][bj][m][0]; a = a + acc[ai][bj][m][1]; }
        *(pg8::f32x4*)(dst + ((size_t)(u.pm * 12 + u.pn) * 512 + threadIdx.x) * 4) = a;
    }
};
struct OneUnitOrder { pg8::Unit u; bool has;
    __device__ __forceinline__ bool next(int i, pg8::Unit& o) const { if (i != 0 || !has) return false; o = u; return true; }
    __device__ __forceinline__ void a_ready(const pg8::Unit&) const {}
    __device__ __forceinline__ void done(const pg8::Unit&) const {} };
__device__ __forceinline__ float gelu_tanh_fast(float x) { const float u2 = 1.5957691216057308f * (x + 0.044715f * x * x * x); return x * __builtin_amdgcn_rcpf(1.f + __builtin_amdgcn_exp2f(-u2 * LOG2E)); }
struct EpiCmpH {
    static constexpr bool PERM = true, AFTER_DRAIN = false;
    bf16* hc; const float* bias1;
    __device__ __forceinline__ void operator()(const pg8::f32x4 (&acc)[2][2][4][2], const pg8::Unit& u, int wr, int wc, int fr, int fq) const {
        { int t_ = threadIdx.x; asm volatile("" : "+v"(t_)); fr = t_ & 15; fq = (t_ >> 4) & 3; }
        const int kv = u.pn;
#pragma unroll
        for (int bj = 0; bj < 2; ++bj) { const int col = bj * 128 + wc * 32 + 8 * fq;
            const pg8::f32x4 b0 = *(const pg8::f32x4*)(bias1 + kv * 256 + col), b1 = *(const pg8::f32x4*)(bias1 + kv * 256 + col + 4);
#pragma unroll
            for (int ai = 0; ai < 2; ++ai)
#pragma unroll
                for (int m = 0; m < 4; ++m) { const int row = u.pm * 256 + ai * 128 + wr * 64 + m * 16 + fr;
                    const pg8::f32x4 v0 = acc[ai][bj][m][0] + b0, v1 = acc[ai][bj][m][1] + b1;
                    pg8::u32x4 w; w.x = pg8::cvt_pk_bf16(gelu_tanh_fast(v0[0]), gelu_tanh_fast(v0[1])); w.y = pg8::cvt_pk_bf16(gelu_tanh_fast(v0[2]), gelu_tanh_fast(v0[3]));
                    w.z = pg8::cvt_pk_bf16(gelu_tanh_fast(v1[0]), gelu_tanh_fast(v1[1])); w.w = pg8::cvt_pk_bf16(gelu_tanh_fast(v1[2]), gelu_tanh_fast(v1[3]));
                    *(pg8::u32x4*)(hc + ((size_t)kv * 4096 + row) * 256 + col) = w; } }
    }
};
struct EpiCmpOut {
    static constexpr bool PERM = true, AFTER_DRAIN = false;
    bf16* kvcmp;
    __device__ __forceinline__ void operator()(const pg8::f32x4 (&acc)[2][2][4][2], const pg8::Unit& u, int wr, int wc, int fr, int fq) const {
        { int t_ = threadIdx.x; asm volatile("" : "+v"(t_)); fr = t_ & 15; fq = (t_ >> 4) & 3; }
        if (wc >= 2) return;
        const int kv = u.pn, col = wc * 32 + 8 * fq;
#pragma unroll
        for (int ai = 0; ai < 2; ++ai)
#pragma unroll
            for (int m = 0; m < 4; ++m) { const int row = u.pm * 256 + ai * 128 + wr * 64 + m * 16 + fr; const float z = ((row & 255) == 255) ? 0.f : 1.f;
                const pg8::f32x4 v0 = acc[ai][0][m][0], v1 = acc[ai][0][m][1];
                pg8::u32x4 w; w.x = pg8::cvt_pk_bf16(z != 0.f ? v0[0] : 0.f, z != 0.f ? v0[1] : 0.f); w.y = pg8::cvt_pk_bf16(z != 0.f ? v0[2] : 0.f, z != 0.f ? v0[3] : 0.f);
                w.z = pg8::cvt_pk_bf16(z != 0.f ? v1[0] : 0.f, z != 0.f ? v1[1] : 0.f); w.w = pg8::cvt_pk_bf16(z != 0.f ? v1[2] : 0.f, z != 0.f ? v1[3] : 0.f);
                *(pg8::u32x4*)(kvcmp + ((size_t)kv * 4096 + row) * 64 + col) = w; }
    }
};

__device__ __forceinline__ void moe_build_tables(const unsigned* cnt, int tid) {
    LAS int* T = (LAS int*)((LAS unsigned char*)lds_raw + TBL_OFF);
    __syncthreads();
    if (tid < 112) T[384 + tid] = (int)cnt[tid * MOE_CS];
    else if (tid >= 128 && tid < 128 + NEXP) T[560 + tid - 128] = (int)cnt[(112 + tid - 128) * MOE_CS];
    __syncthreads();
    if (tid < 112) { int o = 0;
        _Pragma("unroll 8") for (int c = 0; c < tid; ++c) o += (T[384 + c] + 255) >> 8;
        const int n = (T[384 + tid] + 255) >> 8; T[tid] = o;
        _Pragma("clang loop vectorize(disable) unroll(disable)") for (int k = 0; k < n; ++k) T[128 + o + k] = tid;
        if (tid == 111) T[112] = o + n; }
    else if (tid >= 128 && tid < 128 + NEXP) { const int e = tid - 128; int o = 0;
        _Pragma("unroll 8") for (int c = 0; c < e; ++c) o += (T[560 + c] + 255) >> 8;
        const int n = (T[560 + e] + 255) >> 8; T[512 + e] = o;
        _Pragma("clang loop vectorize(disable) unroll(disable)") for (int k = 0; k < n; ++k) T[608 + o + k] = e;
        if (e == NEXP - 1) T[544] = o + n; }
    __syncthreads();
}
__device__ __forceinline__ void moe_pair(int cls, int& ea, int& eb) { const int grp = cls / 28; int idx = cls % 28, lo = 0; while (idx >= 7 - lo) { idx -= 7 - lo; ++lo; } ea = grp * 8 + lo; eb = grp * 8 + lo + 1 + idx; }
struct MoeOrder1 {
    const char* wsb; const unsigned* rec; const char* wgu; unsigned* edone; int G, c;
    __device__ __forceinline__ bool next(int i, pg8::Unit& u) const {
        const LAS int* T = (const LAS int*)((LAS unsigned char*)lds_raw + TBL_OFF);
        const int idx = i * G + c; if (idx >= 2 * T[544]) return false;
        const int tile = idx >> 1, pn = idx & 1, e = T[608 + tile];
        u.pm = tile; u.pn = pn; u.a = wsb; u.b = wgu + ((size_t)e * 512 + pn * 256) * 2048; u.b2 = u.b; return true; }
    __device__ __forceinline__ const char* abase() const { return wsb; }
    __device__ __forceinline__ void arows4(const pg8::Unit& u, int r0, unsigned cb, unsigned (&g)[2][2]) const {
        const LAS int* T = (const LAS int*)((LAS unsigned char*)lds_raw + TBL_OFF);
        const int e = T[608 + u.pm], base = (u.pm - T[512 + e]) * 256 + r0, n = T[560 + e];
        const unsigned ob = (unsigned)(e * 32768 + base) * 16u;
#pragma unroll
        for (int k = 0; k < 4; ++k) { unsigned off = ZROW_OFF; if (base + 64 * k < n) off = (unsigned)WS_HN + *(const unsigned*)((const char*)rec + (ob + 1024u * k)) * 2048u; g[k >> 1][k & 1] = off + cb; } }
    __device__ __forceinline__ void a_ready(const pg8::Unit&) const {}
    __device__ __forceinline__ void done(const pg8::Unit& u) const {
        asm volatile("s_waitcnt vmcnt(0)" ::: "memory");
        const LAS int* T = (const LAS int*)((LAS unsigned char*)lds_raw + TBL_OFF);
        int t_ = threadIdx.x; asm volatile("" : "+v"(t_));
        if ((t_ & 63) == 0) (void)__hip_atomic_fetch_add(edone + T[608 + u.pm] * MOE_CS, 1u, __ATOMIC_RELAXED, __HIP_MEMORY_SCOPE_AGENT); } };
struct MoeOrder2 {
    const char* hb; const char* wd; const unsigned* edone; unsigned* tmo; int G, c;
    __device__ __forceinline__ bool next(int i, pg8::Unit& u) const {
        const LAS int* T = (const LAS int*)((LAS unsigned char*)lds_raw + TBL_OFF);
        const int n1 = (2 * T[544]) % G, idx = i * G + (c >= n1 ? c - n1 : c - n1 + G); if (idx >= 4 * T[112]) return false;
        const int tile = idx >> 2, pn = idx & 3; int ea, eb; moe_pair(T[128 + tile], ea, eb);
        { const int cl = T[128 + tile]; u.hf = (T[384 + cl] - (tile - T[cl]) * 256) <= 128; }
        u.pm = tile; u.pn = pn; u.a = hb + (size_t)tile * 256 * 1024; u.b = wd + ((size_t)ea * 1024 + pn * 256) * 512; u.b2 = wd + ((size_t)eb * 1024 + pn * 256) * 512; return true; }
    __device__ __forceinline__ void a_ready(const pg8::Unit& u) const {
        int t_ = threadIdx.x; asm volatile("" : "+v"(t_));
        if (t_ < 64) {
            const LAS int* T = (const LAS int*)((LAS unsigned char*)lds_raw + TBL_OFF);
            int ea, eb; moe_pair(T[128 + u.pm], ea, eb);
            const unsigned na = 16u * (unsigned)((T[560 + ea] + 255) >> 8), nb = 16u * (unsigned)((T[560 + eb] + 255) >> 8);
            unsigned polls = 0u;
            while ((unsigned)__builtin_amdgcn_readfirstlane(__hip_atomic_load(edone + ea * MOE_CS, __ATOMIC_RELAXED, __HIP_MEMORY_SCOPE_AGENT)) < na ||
                   (unsigned)__builtin_amdgcn_readfirstlane(__hip_atomic_load(edone + eb * MOE_CS, __ATOMIC_RELAXED, __HIP_MEMORY_SCOPE_AGENT)) < nb) {
                if ((++polls & 255u) == 0u) { if (__builtin_amdgcn_readfirstlane(__hip_atomic_load(tmo, __ATOMIC_RELAXED, __HIP_MEMORY_SCOPE_AGENT)) != 0u) break;
                    if (polls > (1u << 22)) { if (t_ == 0) __hip_atomic_store(tmo, 1u, __ATOMIC_RELAXED, __HIP_MEMORY_SCOPE_AGENT); break; } }
                __builtin_amdgcn_s_sleep(2); }
            __builtin_amdgcn_fence(__ATOMIC_ACQUIRE, "agent");
            asm volatile("s_waitcnt vmcnt(0)" ::: "memory");
        }
        asm volatile("" ::: "memory"); __builtin_amdgcn_s_barrier(); asm volatile("" ::: "memory");
    }
    __device__ __forceinline__ void done(const pg8::Unit&) const {} };
struct EpiMoeH {
    static constexpr bool PERM = true, AFTER_DRAIN = false;
    bf16* hb; const u32x4* rec;
    __device__ __forceinline__ void operator()(const pg8::f32x4 (&acc)[2][2][4][2], const pg8::Unit& u, int wr, int wc, int fr, int fq) const {
        { int t_ = threadIdx.x; asm volatile("" : "+v"(t_)); fr = t_ & 15; fq = (t_ >> 4) & 3; }
        const LAS int* T = (const LAS int*)((LAS unsigned char*)lds_raw + TBL_OFF);
        const int ex = T[608 + u.pm], vr0 = (u.pm - T[512 + ex]) * 256, nex = T[560 + ex];
#pragma unroll
        for (int ai = 0; ai < 2; ++ai) {
            u32x4 q4[4];
#pragma unroll
            for (int m = 0; m < 4; ++m) q4[m] = *(const u32x4*)((const char*)rec + (unsigned)(ex * 32768 + vr0 + ai * 128 + wr * 64 + m * 16 + fr) * 16u);
#pragma unroll
            for (int m = 0; m < 4; ++m) { asm volatile("" : "+v"(q4[m]));
            }
#pragma unroll
            for (int m = 0; m < 4; ++m) { const int rr = ai * 128 + wr * 64 + m * 16 + fr; const bool valid = vr0 + rr < nex;
                const u32x4 q = q4[m]; const float w = __uint_as_float(q.y), rs = __uint_as_float(q.z);
                const int slot = (int)((q.w >> 15) & 1u); const unsigned row = (unsigned)T[valid ? (q.w >> 16) : 0u] * 256u + (q.w & 0x7fffu);
#pragma unroll
                for (int bj = 0; bj < 2; ++bj) { const int j0 = (u.pn & 1) * 128 + (bj * 128 + wc * 32 + 8 * fq) / 2;
                    pg8::f32x4 v0 = acc[ai][bj][m][0], v1 = acc[ai][bj][m][1];
#pragma unroll
                    for (int e = 0; e < 4; ++e) { v0[e] *= rs; v1[e] *= rs; }
                    const float h0 = v0[0] * __builtin_amdgcn_rcpf(1.f + __builtin_amdgcn_exp2f(-v0[0] * LOG2E)) * v0[1] * w, h1 = v0[2] * __builtin_amdgcn_rcpf(1.f + __builtin_amdgcn_exp2f(-v0[2] * LOG2E)) * v0[3] * w;
                    const float h2 = v1[0] * __builtin_amdgcn_rcpf(1.f + __builtin_amdgcn_exp2f(-v1[0] * LOG2E)) * v1[1] * w, h3 = v1[2] * __builtin_amdgcn_rcpf(1.f + __builtin_amdgcn_exp2f(-v1[2] * LOG2E)) * v1[3] * w;
                    const int jg = slot * 256 + j0;
                    if (valid) __hip_atomic_store((u64*)((char*)hb + (((row >> 4) * 32u + (unsigned)(jg >> 4)) * 256u + (row & 15u) * 16u + (unsigned)(jg & 15)) * 2u), (u64)pg8::cvt_pk_bf16(h0, h1) | ((u64)pg8::cvt_pk_bf16(h2, h3) << 32),
                                                  __ATOMIC_RELAXED, __HIP_MEMORY_SCOPE_AGENT); }
            }
            asm volatile("" ::: "memory"); }
    }
};
struct EpiMoeOut {
    static constexpr bool PERM = true, AFTER_DRAIN = false;
    bf16* x; const unsigned* rec; float* ssq;
    __device__ __forceinline__ void operator()(const pg8::f32x4 (&acc)[2][2][4][2], const pg8::Unit& u, int wr, int wc, int fr, int fq) const {
        { int t_ = threadIdx.x; asm volatile("" : "+v"(t_)); fr = t_ & 15; fq = (t_ >> 4) & 3; }
        bf16* xx = x; const unsigned* rt = rec; float* sq = ssq; asm volatile("" : "+s"(xx), "+s"(rt), "+s"(sq));
        const LAS int* T = (const LAS int*)((LAS unsigned char*)lds_raw + TBL_OFF);
        const int cls = T[128 + u.pm], vr0 = (u.pm - T[cls]) * 256, ncls = T[384 + cls];
        int tok[2][4];
#pragma unroll
        for (int ai = 0; ai < 2; ++ai)
#pragma unroll
            for (int m = 0; m < 4; ++m) { const int rr = ai * 128 + wr * 64 + m * 16 + fr; tok[ai][m] = -1; if (vr0 + rr < ncls) tok[ai][m] = (int)rt[(size_t)cls * 32768 + vr0 + rr]; }
#pragma unroll
        for (int ai = 0; ai < 2; ++ai)
#pragma unroll
            for (int m = 0; m < 4; ++m) asm volatile("" : "+v"(tok[ai][m]));
#pragma unroll
        for (int ai = 0; ai < 2; ++ai) { u32x4 w[4][2];
#pragma unroll
            for (int m = 0; m < 4; ++m)
#pragma unroll
                for (int bj = 0; bj < 2; ++bj) w[m][bj] = *(const u32x4*)(xx + (size_t)(tok[ai][m] >= 0 ? tok[ai][m] : 0) * D_ + u.pn * 256 + wc * 32 + 8 * fq + bj * 128);
#pragma unroll
            for (int m = 0; m < 4; ++m)
#pragma unroll
                for (int bj = 0; bj < 2; ++bj) asm volatile("" : "+v"(w[m][bj]));
#pragma unroll
            for (int m = 0; m < 4; ++m) { float ss = 0.f;
                if (tok[ai][m] >= 0) {
#pragma unroll
                    for (int bj = 0; bj < 2; ++bj) { const u32x4 o = res_add8(w[m][bj], acc[ai][bj][m][0], acc[ai][bj][m][1]);
                        *(u32x4*)(xx + (size_t)tok[ai][m] * D_ + u.pn * 256 + wc * 32 + 8 * fq + bj * 128) = o;
                        if (sq) { const unsigned ow[4] = {o.x, o.y, o.z, o.w};
#pragma unroll
                            for (int e = 0; e < 4; ++e) { const float a = __uint_as_float(ow[e] << 16), b2 = __uint_as_float(ow[e] & 0xffff0000u); ss = fmaf(a, a, ss); ss = fmaf(b2, b2, ss); } } } }
                if (sq) {
                    { auto r16 = __builtin_amdgcn_permlane16_swap(__float_as_uint(ss), __float_as_uint(ss), false, false); ss = __uint_as_float(r16[0]) + __uint_as_float(r16[1]); }
                    { auto r32 = __builtin_amdgcn_permlane32_swap(__float_as_uint(ss), __float_as_uint(ss), false, false); ss = __uint_as_float(r32[0]) + __uint_as_float(r32[1]); }
                    if (fq == 0 && tok[ai][m] >= 0) sq[(size_t)tok[ai][m] * 16 + u.pn * 4 + wc] = ss; } } }
    }
};

__device__ __forceinline__ void transpose_item(const float* W, int ldw, bf16* WT, int ldt, int r0, int rmul, int k0, LAS float* scr, int lane, const float* gk = nullptr) {
    f32x4 v[8];
#pragma unroll
    for (int i = 0; i < 8; ++i) v[i] = *(const f32x4*)(W + (size_t)(k0 + i * 8 + (lane >> 3)) * ldw + (lane & 7) * 4);
    if (gk) { float gsc[8];
#pragma unroll
        for (int i = 0; i < 8; ++i) gsc[i] = gk[k0 + i * 8 + (lane >> 3)];
#pragma unroll
        for (int i = 0; i < 8; ++i) asm volatile("" : "+v"(gsc[i]));
#pragma unroll
        for (int i = 0; i < 8; ++i) { v[i].x *= gsc[i]; v[i].y *= gsc[i]; v[i].z *= gsc[i]; v[i].w *= gsc[i]; } }
#pragma unroll
    for (int i = 0; i < 8; ++i) { LAS float* d = scr + (i * 8 + (lane >> 3)) * 33 + (lane & 7) * 4; d[0] = v[i].x; d[1] = v[i].y; d[2] = v[i].z; d[3] = v[i].w; }
    asm volatile("s_waitcnt lgkmcnt(0)" ::: "memory");
    const int c = lane & 7;
#pragma unroll
    for (int j = 0; j < 4; ++j) { const int n = (lane >> 3) + 8 * j; const LAS float* sp = scr + (8 * c) * 33 + n;
        u32x4 o; o.x = pk2(sp[0 * 33], sp[1 * 33]); o.y = pk2(sp[2 * 33], sp[3 * 33]); o.z = pk2(sp[4 * 33], sp[5 * 33]); o.w = pk2(sp[6 * 33], sp[7 * 33]);
        *(u32x4*)(WT + (size_t)(r0 + rmul * n) * ldt + k0 + 8 * c) = o; }
    asm volatile("s_waitcnt lgkmcnt(0)" ::: "memory");
}
__device__ __forceinline__ void transpose_seg(const float* W, int ldw, int K, int sc0, int ncol, bf16* WT, int r0, int rmul, int item, LAS float* scr, int lane, const float* gk = nullptr) {
    const int nb = ncol / 32, kb = item / nb, cb = item % nb;
    transpose_item(W + sc0 + cb * 32, ldw, WT, K, r0 + rmul * cb * 32, rmul, kb * 64, scr, lane, gk);
}

typedef float f32x16 __attribute__((ext_vector_type(16)));
typedef short bf16x8v __attribute__((ext_vector_type(8)));
typedef short s16x4 __attribute__((ext_vector_type(4)));
typedef float f32x2_t __attribute__((ext_vector_type(2)));
typedef __bf16 bf16x2_t __attribute__((ext_vector_type(2)));
constexpr int A_KBUF = 10240, A_VBUF = 12288;
constexpr int A_KOFF = 0, A_VOFF = 2 * A_KBUF, A_BOFF = A_VOFF + 2 * A_VBUF, A_BTILE = 8 * 256, A_LDS_END = A_BOFF + 2 * A_BTILE;
__device__ __forceinline__ constexpr int crow0(int reg) { return (reg & 3) + 8 * (reg >> 2); }
__device__ __forceinline__ float swap_max(float m) { auto rr = __builtin_amdgcn_permlane32_swap(__float_as_uint(m), __float_as_uint(m), false, false); return fmaxf(__uint_as_float(rr[0]), __uint_as_float(rr[1])); }
__device__ __forceinline__ float swap_sum(float m) { auto rr = __builtin_amdgcn_permlane32_swap(__float_as_uint(m), __float_as_uint(m), false, false); return __uint_as_float(rr[0]) + __uint_as_float(rr[1]); }
__device__ __forceinline__ unsigned cvtpk(float lo, float hi) { f32x2_t v = {lo, hi}; bf16x2_t b = __builtin_convertvector(v, bf16x2_t); return __builtin_bit_cast(unsigned, b); }
__device__ __forceinline__ bf16x8v pack8(const f32x16& p, int b0) { u32x4 w; w.x = cvtpk(p[b0 + 0], p[b0 + 1]); w.y = cvtpk(p[b0 + 2], p[b0 + 3]); w.z = cvtpk(p[b0 + 4], p[b0 + 5]); w.w = cvtpk(p[b0 + 6], p[b0 + 7]); return __builtin_bit_cast(bf16x8v, w); }
__device__ __forceinline__ s16x4 tr_read(const LAS unsigned char* p) { typedef short v4i16_t __attribute__((ext_vector_type(4))); return __builtin_bit_cast(s16x4, __builtin_amdgcn_ds_read_tr16_b64_v4i16((LAS v4i16_t*)p)); }

template <int DQK>
__device__ __forceinline__ void attn_preload(const bf16* Kb0, const bf16* Kb1, const bf16* Vb, int j, int tid, u32x4& kreg, u32x4& vreg) {
    const bf16* ksrc;
    if (DQK == 64) ksrc = Kb0 + b64_off(tid >> 3, (tid & 7) * 8); else { const int mp = tid >> 8, tt = tid & 255; ksrc = (mp ? Kb1 : Kb0) + (tt >> 2) * 32 + (tt & 3) * 8; }
    const bf16* vsrc = Vb + b64_off(tid >> 3, (tid & 7) * 8);
    kreg = *(const u32x4*)(ksrc + (size_t)(j * 64) * DQK); vreg = *(const u32x4*)(vsrc + (size_t)(j * 64) * 64);
}
template <int DQK, int NMAP, bool FOX, bool SLC, bool PRE = false, bool NOMAX = false>
__device__ __forceinline__ void attn_core(LAS unsigned char* L, const bf16* Kb0, const bf16* Kb1, const bf16* Vb, const LAS float* cum, float cum_ref,
                                          const bf16x8v (&Qf)[NMAP][DQK / 16], u64 tilemask, int t_lane, int tw0, int win, float slope2, unsigned selw0, unsigned selw1,
                                          f32x16 (&O)[NMAP][2], float (&M)[NMAP], float (&Ls)[NMAP], int tid, bool started0 = false, int jpre = 0, u32x4 kpre = (u32x4){0u, 0u, 0u, 0u}, u32x4 vpre = (u32x4){0u, 0u, 0u, 0u}) {
    constexpr int KP = DQK * 2 + 16, VP = 192;
    const int lane = tid & 63, r = lane & 31, h = lane >> 5;
    int kdst; const bf16* ksrc;
    if (DQK == 64) { kdst = (tid >> 3) * KP + (tid & 7) * 16; ksrc = Kb0 + b64_off(tid >> 3, (tid & 7) * 8); }
    else { const int mp = tid >> 8, tt = tid & 255; kdst = mp * 5120 + (tt >> 2) * KP + (tt & 3) * 16; ksrc = (mp ? Kb1 : Kb0) + (tt >> 2) * 32 + (tt & 3) * 8; }
    const int vdst = (tid >> 3) * VP + (tid & 7) * 16; const bf16* vsrc = Vb + b64_off(tid >> 3, (tid & 7) * 8);
    const LAS unsigned char* kfrag = L + A_KOFF + r * KP + h * 16;
    const LAS unsigned char* vfrag = L + A_VOFF + (4 * h + ((lane & 15) >> 2)) * VP + (16 * ((lane >> 4) & 1) + 4 * (lane & 3)) * 2;
    u32x4 kreg, vreg; float breg = 0.f;
    u64 mk = tilemask;
    int j = PRE ? jpre : 63 - __builtin_clzll(mk); mk &= ~(1ull << j);
    { const int kv0 = j * 64; if (PRE) { kreg = kpre; vreg = vpre; } else { kreg = *(const u32x4*)(ksrc + (size_t)kv0 * DQK); vreg = *(const u32x4*)(vsrc + (size_t)kv0 * 64); } if (FOX) breg = (cum_ref - cum[kv0 + lane]) * LOG2E; }
    *(LAS u32x4*)(L + A_KOFF + kdst) = kreg; *(LAS u32x4*)(L + A_VOFF + vdst) = vreg; if (FOX) *(LAS float*)(L + A_BOFF + tid * 4) = breg;
    __syncthreads();
    int buf = 0; bool started = started0;
    float pdummy = 0.f; int idummy = 0; f32x16 dm0; for (int i = 0; i < 16; ++i) dm0[i] = 0.f;
    for (;;) {
        const bool more = mk != 0ull; int jn = 0;
        if (more) { jn = 63 - __builtin_clzll(mk); mk &= ~(1ull << jn); const int kv0 = jn * 64;
            kreg = *(const u32x4*)(ksrc + (size_t)kv0 * DQK); vreg = *(const u32x4*)(vsrc + (size_t)kv0 * 64); if (FOX) breg = (cum_ref - cum[kv0 + lane]) * LOG2E; }
        { const int kv0 = j * 64;
          bool wave_has = true; float selb = 0.f;
          if (SLC) { const bool mine = ((j < 32 ? (selw0 >> j) : (selw1 >> (j - 32))) & 1u) != 0u; selb = mine ? 0.f : -INFINITY; wave_has = __any(mine); }
          if (wave_has && !(kv0 > tw0 + 31) && !(tw0 - (kv0 + 63) >= win)) {
            const bool need_mask = (kv0 + 63 > tw0) || (tw0 + 31 - kv0 >= win);
            const int dl = t_lane - kv0 - 4 * h;
            bf16x8v pa[NMAP][4];
#pragma unroll
            for (int mp = 0; mp < NMAP; ++mp) {
                f32x16 p0, p1;
                if (FOX) { const LAS f32x4* bl = (const LAS f32x4*)(L + A_BOFF + buf * A_BTILE + (tid >> 6) * 256) + h; const float mm = NOMAX ? 0.f : M[mp];
#pragma unroll
                    for (int g4 = 0; g4 < 4; ++g4) { const f32x4 b0 = bl[2 * g4], b1 = bl[8 + 2 * g4];
                        p0[4 * g4 + 0] = b0.x - mm; p0[4 * g4 + 1] = b0.y - mm; p0[4 * g4 + 2] = b0.z - mm; p0[4 * g4 + 3] = b0.w - mm; p1[4 * g4 + 0] = b1.x - mm; p1[4 * g4 + 1] = b1.y - mm; p1[4 * g4 + 2] = b1.z - mm; p1[4 * g4 + 3] = b1.w - mm; } }
                else { const float base_l = (slope2 * (float)(kv0 + 4 * h - tw0) - (NOMAX ? 0.f : M[mp])) + selb, s8 = slope2 * 8.f, s32 = slope2 * 32.f;
                    p0[0] = base_l; p0[1] = p0[0] + slope2; p0[2] = p0[1] + slope2; p0[3] = p0[2] + slope2;
#pragma unroll
                    for (int reg = 4; reg < 16; ++reg) p0[reg] = p0[reg - 4] + s8;
#pragma unroll
                    for (int reg = 0; reg < 16; ++reg) p1[reg] = p0[reg] + s32; }
                const LAS unsigned char* kb = kfrag + buf * A_KBUF + (DQK == 32 ? mp * 5120 : 0);
#pragma unroll
                for (int s = 0; s < DQK / 16; ++s) { const bf16x8v kf0 = *(const LAS bf16x8v*)(kb + s * 32), kf1 = *(const LAS bf16x8v*)(kb + 32 * KP + s * 32);
#ifdef PROBE_X_LDSK
                    { const bf16x8v z0 = *(const volatile LAS bf16x8v*)(kb + s * 32), z1 = *(const volatile LAS bf16x8v*)(kb + 32 * KP + s * 32); idummy ^= z0[0] ^ z1[1]; }
#endif
#ifdef PROBE_X_MFMA
                    dm0 = __builtin_amdgcn_mfma_f32_32x32x16_bf16(kf0, Qf[mp][s], dm0, 0, 0, 0); dm0 = __builtin_amdgcn_mfma_f32_32x32x16_bf16(kf1, Qf[mp][s], dm0, 0, 0, 0);
#endif
                    p0 = __builtin_amdgcn_mfma_f32_32x32x16_bf16(kf0, Qf[mp][s], p0, 0, 0, 0); p1 = __builtin_amdgcn_mfma_f32_32x32x16_bf16(kf1, Qf[mp][s], p1, 0, 0, 0); }
                if (need_mask) {
#pragma unroll
                    for (int reg = 0; reg < 16; ++reg) { const int d0 = dl - crow0(reg), d1 = d0 - 32;
                        p0[reg] = (d0 >= 0 && d0 < win) ? p0[reg] : -INFINITY; p1[reg] = (d1 >= 0 && d1 < win) ? p1[reg] : -INFINITY; } }
                if (!NOMAX) {
                float mt = fmaxf(fmaxf(p0[0], p1[0]), fmaxf(p0[1], p1[1]));
#pragma unroll
                for (int reg = 2; reg < 16; reg += 2) mt = fmaxf(fmaxf(mt, fmaxf(fmaxf(p0[reg], p1[reg]), p0[reg + 1])), p1[reg + 1]);
                mt = swap_max(mt);
                if (!started || __any(mt > 8.f)) {
                    const float d = (mt > -1e30f) ? (started ? fmaxf(mt, 0.f) : mt) : 0.f, alpha = __builtin_amdgcn_exp2f(-d);
                    O[mp][0] *= alpha; O[mp][1] *= alpha; Ls[mp] *= alpha; M[mp] += d;
#pragma unroll
                    for (int reg = 0; reg < 16; ++reg) { p0[reg] -= d; p1[reg] -= d; } } }
                float rs = 0.f;
#ifdef PROBE_X_EXP
#pragma unroll
                for (int reg = 0; reg < 16; ++reg) { pdummy += __builtin_amdgcn_exp2f(p0[reg] - 1.f) + __builtin_amdgcn_exp2f(p1[reg] - 1.f); }
#endif
                float rs2 = 0.f, one = 1.f; asm volatile("" : "+v"(one));
#pragma unroll
                for (int reg = 0; reg < 16; ++reg) { p0[reg] = __builtin_amdgcn_exp2f(p0[reg]); p1[reg] = __builtin_amdgcn_exp2f(p1[reg]); rs += p0[reg]; rs2 = __builtin_fmaf(p1[reg], one, rs2); }
                Ls[mp] += rs + rs2;
                pa[mp][0] = pack8(p0, 0); pa[mp][1] = pack8(p0, 8); pa[mp][2] = pack8(p1, 0); pa[mp][3] = pack8(p1, 8);
            }
            started = true;
            const LAS unsigned char* vb = vfrag + buf * A_VBUF;
#pragma unroll
            for (int db = 0; db < 2; ++db)
#pragma unroll
                for (int ks = 0; ks < 4; ++ks) { const s16x4 lo = tr_read(vb + ks * (16 * VP) + db * 64), hi = tr_read(vb + ks * (16 * VP) + db * 64 + 8 * VP);
                    const bf16x8v vf = {lo[0], lo[1], lo[2], lo[3], hi[0], hi[1], hi[2], hi[3]};
#pragma unroll
                    for (int mp = 0; mp < NMAP; ++mp) O[mp][db] = __builtin_amdgcn_mfma_f32_32x32x16_bf16(vf, pa[mp][ks], O[mp][db], 0, 0, 0); }
          } }
        if (more) { *(LAS u32x4*)(L + A_KOFF + (buf ^ 1) * A_KBUF + kdst) = kreg; *(LAS u32x4*)(L + A_VOFF + (buf ^ 1) * A_VBUF + vdst) = vreg; if (FOX) *(LAS float*)(L + A_BOFF + (buf ^ 1) * A_BTILE + tid * 4) = breg; }
#ifdef PROBE_X_BAR
        __syncthreads();
#endif
        __syncthreads();
        if (!more) break;
        j = jn; buf ^= 1;
    }
    if (pdummy == 123.456f || idummy == 0x7fffabcd || dm0[3] == 98765.4321f) Ls[0] += 1e-30f;
}
#ifndef AC2_MODE
#define AC2_MODE 0
#endif
#ifndef AC2_INIT_VALU
#define AC2_INIT_VALU 24
#endif
template <bool FOX, bool SLC>
__device__ __forceinline__ void attn_core2(LAS unsigned char* L, const bf16* Kb0, const bf16* Vb, const LAS float* cum, float cum_ref,
                                           const bf16x8v (&Qf)[4], u64 tilemask, int t_lane, int tw0, int win, float slope2, unsigned selw0, unsigned selw1,
                                           f32x16 (&O)[2], float& M, float& Ls, int tid) {
    constexpr int KP = 144, VP = 192;
    const int lane = tid & 63, r = lane & 31, h = lane >> 5;
    const int kdst = (tid >> 3) * KP + (tid & 7) * 16; const bf16* ksrc = Kb0 + b64_off(tid >> 3, (tid & 7) * 8);
    const int vdst = (tid >> 3) * VP + (tid & 7) * 16; const bf16* vsrc = Vb + b64_off(tid >> 3, (tid & 7) * 8);
    const LAS unsigned char* kfrag = L + A_KOFF + r * KP + h * 16;
    const LAS unsigned char* vfrag = L + A_VOFF + (4 * h + ((lane & 15) >> 2)) * VP + (16 * ((lane >> 4) & 1) + 4 * (lane & 3)) * 2;
#define AC2_ACTIVE(jj) (!((jj) * 64 > tw0 + 31) && !(tw0 - ((jj) * 64 + 63) >= win))
#define AC2_INIT(jj, kslot, q0, q1) do { const int kv0_ = (jj) * 64; \
        if (FOX) { const LAS f32x4* bl = (const LAS f32x4*)(L + A_BOFF + (kslot) * 256) + h; const float mm = M; \
            _Pragma("unroll") for (int g4 = 0; g4 < 4; ++g4) { const f32x4 b0 = bl[2 * g4], b1 = bl[8 + 2 * g4]; \
                q0[4 * g4 + 0] = b0.x - mm; q0[4 * g4 + 1] = b0.y - mm; q0[4 * g4 + 2] = b0.z - mm; q0[4 * g4 + 3] = b0.w - mm; q1[4 * g4 + 0] = b1.x - mm; q1[4 * g4 + 1] = b1.y - mm; q1[4 * g4 + 2] = b1.z - mm; q1[4 * g4 + 3] = b1.w - mm; } } \
        else { float selb = 0.f; if (SLC) selb = ((((jj) < 32) ? (selw0 >> (jj)) : (selw1 >> ((jj) - 32))) & 1u) ? 0.f : -INFINITY; \
            const float base_l = (slope2 * (float)(kv0_ + 4 * h - tw0) - M) + selb, s8 = slope2 * 8.f, s32 = slope2 * 32.f; \
            q0[0] = base_l; q0[1] = q0[0] + slope2; q0[2] = q0[1] + slope2; q0[3] = q0[2] + slope2; \
            _Pragma("unroll") for (int reg = 4; reg < 16; ++reg) q0[reg] = q0[reg - 4] + s8; \
            _Pragma("unroll") for (int reg = 0; reg < 16; ++reg) q1[reg] = q0[reg] + s32; } } while (0)
#define AC2_QK(jj, kslot) do { AC2_INIT(jj, kslot, p0, p1); \
        const LAS unsigned char* kb_ = kfrag + (kslot) * A_KBUF; \
        _Pragma("unroll") for (int s_ = 0; s_ < 4; ++s_) { const bf16x8v kf0 = *(const LAS bf16x8v*)(kb_ + s_ * 32), kf1 = *(const LAS bf16x8v*)(kb_ + 32 * KP + s_ * 32); \
            p0 = __builtin_amdgcn_mfma_f32_32x32x16_bf16(kf0, Qf[s_], p0, 0, 0, 0); p1 = __builtin_amdgcn_mfma_f32_32x32x16_bf16(kf1, Qf[s_], p1, 0, 0, 0); } } while (0)
    u32x4 kreg, vreg; float breg = 0.f;
    u64 mk = tilemask;
    int j = 63 - __builtin_clzll(mk); mk &= ~(1ull << j);
    int jn = -1; if (mk) { jn = 63 - __builtin_clzll(mk); mk &= ~(1ull << jn); }
    { kreg = *(const u32x4*)(ksrc + (size_t)j * 64 * 64); vreg = *(const u32x4*)(vsrc + (size_t)j * 64 * 64); if (FOX && tid < 64) breg = (cum_ref - cum[j * 64 + tid]) * LOG2E;
      *(LAS u32x4*)(L + A_KOFF + kdst) = kreg; *(LAS u32x4*)(L + A_VOFF + vdst) = vreg; if (FOX && tid < 64) *(LAS float*)(L + A_BOFF + tid * 4) = breg;
      if (jn >= 0) { kreg = *(const u32x4*)(ksrc + (size_t)jn * 64 * 64); if (FOX && tid < 64) breg = (cum_ref - cum[jn * 64 + tid]) * LOG2E;
          *(LAS u32x4*)(L + A_KOFF + A_KBUF + kdst) = kreg; if (FOX && tid < 64) *(LAS float*)(L + A_BOFF + 256 + tid * 4) = breg; } }
    __syncthreads();
    f32x16 p0, p1;
    bool started = false;
    int ks = 0, vs = 0;
    if (AC2_ACTIVE(j)) AC2_QK(j, 0);
    for (;;) {
        int jnn = -1; if (mk) { jnn = 63 - __builtin_clzll(mk); mk &= ~(1ull << jnn); }
        if (jnn >= 0) { kreg = *(const u32x4*)(ksrc + (size_t)jnn * 64 * 64); if (FOX && tid < 64) breg = (cum_ref - cum[jnn * 64 + tid]) * LOG2E; }
        if (jn >= 0) vreg = *(const u32x4*)(vsrc + (size_t)jn * 64 * 64);
        const bool act = AC2_ACTIVE(j), actn = jn >= 0 && AC2_ACTIVE(jn);
        if (act) {
            const int kv0 = j * 64;
            if ((kv0 + 63 > tw0) || (tw0 + 31 - kv0 >= win)) { const int dl = t_lane - kv0 - 4 * h;
#pragma unroll
                for (int reg = 0; reg < 16; ++reg) { const int d0 = dl - crow0(reg), d1 = d0 - 32;
                    p0[reg] = (d0 >= 0 && d0 < win) ? p0[reg] : -INFINITY; p1[reg] = (d1 >= 0 && d1 < win) ? p1[reg] : -INFINITY; } }
            float mt = fmaxf(fmaxf(p0[0], p1[0]), fmaxf(p0[1], p1[1]));
#pragma unroll
            for (int reg = 2; reg < 16; reg += 2) mt = fmaxf(fmaxf(mt, fmaxf(fmaxf(p0[reg], p1[reg]), p0[reg + 1])), p1[reg + 1]);
            mt = swap_max(mt);
            if (!started || __any(mt > 8.f)) {
                const float d = (mt > -1e30f) ? (started ? fmaxf(mt, 0.f) : mt) : 0.f, alpha = __builtin_amdgcn_exp2f(-d);
                O[0] *= alpha; O[1] *= alpha; Ls *= alpha; M += d;
#pragma unroll
                for (int reg = 0; reg < 16; ++reg) { p0[reg] -= d; p1[reg] -= d; } }
            started = true;
#if AC2_MODE == 1
            {
                const int jq = jn >= 0 ? jn : 0;
                float rs = 0.f;
#pragma unroll
                for (int reg = 0; reg < 16; ++reg) { p0[reg] = __builtin_amdgcn_exp2f(p0[reg]); p1[reg] = __builtin_amdgcn_exp2f(p1[reg]); rs += p0[reg] + p1[reg]; }
                Ls += rs;
                const bf16x8v pa0 = pack8(p0, 0), pa1 = pack8(p0, 8), pa2 = pack8(p1, 0), pa3 = pack8(p1, 8);
                AC2_QK(jq, ks ^ 1);
                const LAS unsigned char* vb = vfrag + vs * A_VBUF;
#pragma unroll
                for (int db = 0; db < 2; ++db)
#pragma unroll
                    for (int kq = 0; kq < 4; ++kq) { const s16x4 lo = tr_read(vb + kq * (16 * VP) + db * 64), hi = tr_read(vb + kq * (16 * VP) + db * 64 + 8 * VP);
                        const bf16x8v vf = {lo[0], lo[1], lo[2], lo[3], hi[0], hi[1], hi[2], hi[3]};
                        O[db] = __builtin_amdgcn_mfma_f32_32x32x16_bf16(vf, kq == 0 ? pa0 : kq == 1 ? pa1 : kq == 2 ? pa2 : pa3, O[db], 0, 0, 0); }
            }
#else
            {
                const int jq = jn >= 0 ? jn : 0;
                f32x16 n0, n1;
                AC2_INIT(jq, ks ^ 1, n0, n1);
                const LAS unsigned char* kb_ = kfrag + (ks ^ 1) * A_KBUF;
                bf16x8v kf[8];
#pragma unroll
                for (int s_ = 0; s_ < 4; ++s_) { kf[2 * s_] = *(const LAS bf16x8v*)(kb_ + s_ * 32); kf[2 * s_ + 1] = *(const LAS bf16x8v*)(kb_ + 32 * KP + s_ * 32); }
                const LAS unsigned char* vb = vfrag + vs * A_VBUF;
                __builtin_amdgcn_sched_barrier(0);
                float ra = 0.f, rb = 0.f; unsigned w[16];
#define AC2_PINF(x) asm volatile("" : "+v"(x))
#define AC2_QGAP(i) do { if ((i) & 1) n1 = __builtin_amdgcn_mfma_f32_32x32x16_bf16(kf[i], Qf[(i) >> 1], n1, 0, 0, 0); else n0 = __builtin_amdgcn_mfma_f32_32x32x16_bf16(kf[i], Qf[(i) >> 1], n0, 0, 0, 0); \
                    float e0 = __builtin_amdgcn_exp2f(p0[2 * (i)]), e1 = __builtin_amdgcn_exp2f(p0[2 * (i) + 1]), e2 = __builtin_amdgcn_exp2f(p1[2 * (i)]), e3 = __builtin_amdgcn_exp2f(p1[2 * (i) + 1]); \
                    ra += e0 + e1; rb += e2 + e3; \
                    AC2_PINF(e0); AC2_PINF(e1); AC2_PINF(e2); AC2_PINF(e3); AC2_PINF(ra); AC2_PINF(rb); \
                    p0[2 * (i)] = e0; p0[2 * (i) + 1] = e1; p1[2 * (i)] = e2; p1[2 * (i) + 1] = e3; \
                    if ((i) >= 4) { w[2 * ((i) - 4)] = cvtpk(p0[4 * ((i) - 4)], p0[4 * ((i) - 4) + 1]); w[2 * ((i) - 4) + 1] = cvtpk(p0[4 * ((i) - 4) + 2], p0[4 * ((i) - 4) + 3]); AC2_PINF(w[2 * ((i) - 4)]); AC2_PINF(w[2 * ((i) - 4) + 1]); } \
                    if ((i) == 6) { vl[0] = tr_read(vb); vh[0] = tr_read(vb + 8 * VP); } \
                    if ((i) == 7) { vl[1] = tr_read(vb + 64); vh[1] = tr_read(vb + 64 + 8 * VP); } \
                    __builtin_amdgcn_sched_barrier(0); } while (0)
                s16x4 vl[2], vh[2];
                AC2_QGAP(0); AC2_QGAP(1); AC2_QGAP(2); AC2_QGAP(3); AC2_QGAP(4); AC2_QGAP(5); AC2_QGAP(6); AC2_QGAP(7);
                Ls += ra + rb;
#define AC2_PA(kq) __builtin_bit_cast(bf16x8v, (u32x4){w[4 * (kq)], w[4 * (kq) + 1], w[4 * (kq) + 2], w[4 * (kq) + 3]})
#define AC2_PGAP(g) do { const int kq_ = (g) >> 1, db_ = (g) & 1; const bf16x8v vf = {vl[(g) & 1][0], vl[(g) & 1][1], vl[(g) & 1][2], vl[(g) & 1][3], vh[(g) & 1][0], vh[(g) & 1][1], vh[(g) & 1][2], vh[(g) & 1][3]}; \
                    if ((g) < 6) { const int kq2 = ((g) + 2) >> 1, db2 = (g) & 1; vl[(g) & 1] = tr_read(vb + kq2 * (16 * VP) + db2 * 64); vh[(g) & 1] = tr_read(vb + kq2 * (16 * VP) + db2 * 64 + 8 * VP); } \
                    O[db_] = __builtin_amdgcn_mfma_f32_32x32x16_bf16(vf, AC2_PA(kq_), O[db_], 0, 0, 0); \
                    if ((g) < 4) { w[8 + 2 * (g)] = cvtpk(p1[4 * (g)], p1[4 * (g) + 1]); w[8 + 2 * (g) + 1] = cvtpk(p1[4 * (g) + 2], p1[4 * (g) + 3]); AC2_PINF(w[8 + 2 * (g)]); AC2_PINF(w[8 + 2 * (g) + 1]); } \
                    __builtin_amdgcn_sched_barrier(0); } while (0)
                AC2_PGAP(0); AC2_PGAP(1); AC2_PGAP(2); AC2_PGAP(3); AC2_PGAP(4); AC2_PGAP(5); AC2_PGAP(6); AC2_PGAP(7);
#undef AC2_PGAP
#undef AC2_PA
#undef AC2_QGAP
#undef AC2_PINF
                p0 = n0; p1 = n1;
            }
#endif
        } else if (actn) AC2_QK(jn, ks ^ 1);
        if (jnn >= 0) { *(LAS u32x4*)(L + A_KOFF + ks * A_KBUF + kdst) = kreg; if (FOX && tid < 64) *(LAS float*)(L + A_BOFF + ks * 256 + tid * 4) = breg; }
        if (jn >= 0) *(LAS u32x4*)(L + A_VOFF + (vs ^ 1) * A_VBUF + vdst) = vreg;
        __syncthreads();
        if (jn < 0) break;
        j = jn; jn = jnn; ks ^= 1; vs ^= 1;
    }
#undef AC2_QK
#undef AC2_INIT
#undef AC2_ACTIVE
}
__device__ __forceinline__ size_t mix_off(size_t n, int c, int W) { return ((n >> 5) * (size_t)(W / 8) + (size_t)(c >> 3)) * 256 + (n & 31) * 8 + (c & 7); }
#define ATTN_FOR_CHUNKS(db, g4) _Pragma("unroll") for (int db = 0; db < 2; ++db) _Pragma("unroll") for (int g4 = 0; g4 < 4; ++g4)

__device__ __forceinline__ void unpack8(const u32x4 w, float (&f)[8]) { f[0] = __uint_as_float(w.x << 16); f[1] = __uint_as_float(w.x & 0xffff0000u); f[2] = __uint_as_float(w.y << 16); f[3] = __uint_as_float(w.y & 0xffff0000u);
    f[4] = __uint_as_float(w.z << 16); f[5] = __uint_as_float(w.z & 0xffff0000u); f[6] = __uint_as_float(w.w << 16); f[7] = __uint_as_float(w.w & 0xffff0000u); }
__device__ __forceinline__ void ph_norm_bf16_from_bf16(const Ctx& c, const bf16* x, const float* g, bf16* out) {
    constexpr int RB = 4; float gg[2][8];
#pragma unroll
    for (int j = 0; j < 2; ++j) { const f32x4 a = ((const f32x4*)g)[2 * c.lane + 128 * j], b2 = ((const f32x4*)g)[2 * c.lane + 128 * j + 1]; gg[j][0] = a.x; gg[j][1] = a.y; gg[j][2] = a.z; gg[j][3] = a.w; gg[j][4] = b2.x; gg[j][5] = b2.y; gg[j][6] = b2.z; gg[j][7] = b2.w; }
    for (int row0 = c.gw * RB; row0 < NT; row0 += c.ngw * RB) {
        u32x4 v[RB][2];
#pragma unroll
        for (int q = 0; q < RB; ++q)
#pragma unroll
            for (int j = 0; j < 2; ++j) v[q][j] = ((const u32x4*)(x + (size_t)(row0 + q) * D_))[c.lane + 64 * j];
#pragma unroll
        for (int q = 0; q < RB; ++q) { float f[2][8]; float ss = 0.f;
#pragma unroll
            for (int j = 0; j < 2; ++j) { unpack8(v[q][j], f[j]);
#pragma unroll
                for (int e = 0; e < 8; ++e) ss = fmaf(f[j][e], f[j][e], ss); }
            const float r = rsqrtf(wave_sum_l(ss, c.lane) * (1.f / D_) + EPS);
#pragma unroll
            for (int j = 0; j < 2; ++j) { u32x4 o; o.x = pk2(f[j][0] * r * gg[j][0], f[j][1] * r * gg[j][1]); o.y = pk2(f[j][2] * r * gg[j][2], f[j][3] * r * gg[j][3]); o.z = pk2(f[j][4] * r * gg[j][4], f[j][5] * r * gg[j][5]); o.w = pk2(f[j][6] * r * gg[j][6], f[j][7] * r * gg[j][7]);
                ((u32x4*)(out + (size_t)(row0 + q) * D_))[c.lane + 64 * j] = o; } }
    }
}
__device__ __forceinline__ void ph_norm_final_from_bf16(const Ctx& c, const bf16* x, const float* g, float* out) {
    constexpr int RB = 4; float gg[2][8];
#pragma unroll
    for (int j = 0; j < 2; ++j) { const f32x4 a = ((const f32x4*)g)[2 * c.lane + 128 * j], b2 = ((const f32x4*)g)[2 * c.lane + 128 * j + 1]; gg[j][0] = a.x; gg[j][1] = a.y; gg[j][2] = a.z; gg[j][3] = a.w; gg[j][4] = b2.x; gg[j][5] = b2.y; gg[j][6] = b2.z; gg[j][7] = b2.w; }
    for (int row0 = c.gw * RB; row0 < NT; row0 += c.ngw * RB) {
        u32x4 v[RB][2];
#pragma unroll
        for (int q = 0; q < RB; ++q)
#pragma unroll
            for (int j = 0; j < 2; ++j) v[q][j] = ((const u32x4*)(x + (size_t)(row0 + q) * D_))[c.lane + 64 * j];
#pragma unroll
        for (int q = 0; q < RB; ++q) { float f[2][8]; float ss = 0.f;
#pragma unroll
            for (int j = 0; j < 2; ++j) { unpack8(v[q][j], f[j]);
#pragma unroll
                for (int e = 0; e < 8; ++e) ss = fmaf(f[j][e], f[j][e], ss); }
            const float r = rsqrtf(wave_sum_l(ss, c.lane) * (1.f / D_) + EPS);
#pragma unroll
            for (int j = 0; j < 2; ++j) { f32x4* o = (f32x4*)(out + (size_t)(row0 + q) * D_) + 2 * c.lane + 128 * j;
                o[0] = (f32x4){f[j][0] * r * gg[j][0], f[j][1] * r * gg[j][1], f[j][2] * r * gg[j][2], f[j][3] * r * gg[j][3]}; o[1] = (f32x4){f[j][4] * r * gg[j][4], f[j][5] * r * gg[j][5], f[j][6] * r * gg[j][6], f[j][7] * r * gg[j][7]}; } }
    }
}
__device__ __forceinline__ void ph_norm_bf16(const Ctx& c, const float* x, const float* g, bf16* out, bf16* raw) {
    constexpr int RB = 4;
    f32x4 gg[4];
#pragma unroll
    for (int j = 0; j < 4; ++j) gg[j] = ((const f32x4*)g)[c.lane + 64 * j];
    for (int row0 = c.gw * RB; row0 < NT; row0 += c.ngw * RB) {
        f32x4 v[RB][4];
#pragma unroll
        for (int q = 0; q < RB; ++q)
#pragma unroll
            for (int j = 0; j < 4; ++j) v[q][j] = ((const f32x4*)(x + (size_t)(row0 + q) * D_))[c.lane + 64 * j];
#pragma unroll
        for (int q = 0; q < RB; ++q) { float ss = 0.f;
#pragma unroll
            for (int j = 0; j < 4; ++j) ss += v[q][j].x * v[q][j].x + v[q][j].y * v[q][j].y + v[q][j].z * v[q][j].z + v[q][j].w * v[q][j].w;
            const float r = rsqrtf(wave_sum_l(ss, c.lane) * (1.f / D_) + EPS);
            u64* o8 = (u64*)(out + (size_t)(row0 + q) * D_) + c.lane; u64* r8 = (u64*)(raw + (size_t)(row0 + q) * D_) + c.lane;
#pragma unroll
            for (int j = 0; j < 4; ++j) { o8[64 * j] = (u64)pk2(v[q][j].x * r * gg[j].x, v[q][j].y * r * gg[j].y) | ((u64)pk2(v[q][j].z * r * gg[j].z, v[q][j].w * r * gg[j].w) << 32);
                r8[64 * j] = (u64)pk2(v[q][j].x, v[q][j].y) | ((u64)pk2(v[q][j].z, v[q][j].w) << 32); } }
    }
}
__device__ __forceinline__ void ph_raw_bf16_ssq(const Ctx& c, const float* x, bf16* raw, float* ssq) {
    constexpr int RB = 4;
    for (int row0 = c.gw * RB; row0 < NT; row0 += c.ngw * RB) {
        f32x4 v[RB][4];
#pragma unroll
        for (int q = 0; q < RB; ++q)
#pragma unroll
            for (int j = 0; j < 4; ++j) v[q][j] = ((const f32x4*)(x + (size_t)(row0 + q) * D_))[c.lane + 64 * j];
#pragma unroll
        for (int q = 0; q < RB; ++q) { float ss = 0.f;
#pragma unroll
            for (int j = 0; j < 4; ++j) ss += v[q][j].x * v[q][j].x + v[q][j].y * v[q][j].y + v[q][j].z * v[q][j].z + v[q][j].w * v[q][j].w;
            const float tot = wave_sum_l(ss, c.lane);
            u64* r8 = (u64*)(raw + (size_t)(row0 + q) * D_) + c.lane;
#pragma unroll
            for (int j = 0; j < 4; ++j) r8[64 * j] = (u64)pk2(v[q][j].x, v[q][j].y) | ((u64)pk2(v[q][j].z, v[q][j].w) << 32);
            if (c.lane < 16) ssq[(size_t)(row0 + q) * 16 + c.lane] = c.lane == 0 ? tot : 0.f; }
    }
}
__device__ __forceinline__ void ph_norm_final(const Ctx& c, float* x, const float* g) {
    constexpr int RB = 4;
    f32x4 gg[4];
#pragma unroll
    for (int j = 0; j < 4; ++j) gg[j] = ((const f32x4*)g)[c.lane + 64 * j];
    for (int row0 = c.gw * RB; row0 < NT; row0 += c.ngw * RB) {
        f32x4 v[RB][4];
#pragma unroll
        for (int q = 0; q < RB; ++q)
#pragma unroll
            for (int j = 0; j < 4; ++j) v[q][j] = ((const f32x4*)(x + (size_t)(row0 + q) * D_))[c.lane + 64 * j];
#pragma unroll
        for (int q = 0; q < RB; ++q) { float ss = 0.f;
#pragma unroll
            for (int j = 0; j < 4; ++j) ss += v[q][j].x * v[q][j].x + v[q][j].y * v[q][j].y + v[q][j].z * v[q][j].z + v[q][j].w * v[q][j].w;
            const float r = rsqrtf(wave_sum_l(ss, c.lane) * (1.f / D_) + EPS);
            f32x4* xr = (f32x4*)(x + (size_t)(row0 + q) * D_) + c.lane;
#pragma unroll
            for (int j = 0; j < 4; ++j) xr[64 * j] = v[q][j] * r * gg[j]; }
    }
}

template <class AF, class EF>
__device__ __forceinline__ void naive_gemm(const Ctx& c, int M, int N, int K, AF af, const float* W, int ldb, EF ef) {
    LAS float* As = (LAS float*)c.lds;
    LAS float* Bs = As + 16 * 132;
    const int tm = (M + 127) / 128, tn = (N + 127) / 128, ntile = tm * tn;
    const int ty = c.tid >> 4, tx = c.tid & 15;
    for (int tile = c.bid; tile < ntile; tile += c.G) {
        const int m0 = (tile / tn) * 128, n0 = (tile % tn) * 128;
        float acc[4][8];
#pragma unroll
        for (int i = 0; i < 4; ++i)
#pragma unroll
            for (int j = 0; j < 8; ++j) acc[i][j] = 0.f;
        for (int k0 = 0; k0 < K; k0 += 16) {
            __syncthreads();
#pragma unroll
            for (int i = 0; i < 4; ++i) { const int e = c.tid + i * 512, r = e >> 4, kk = e & 15; const int row = m0 + r;
                As[kk * 132 + r] = (row < M) ? af(row, k0 + kk) : 0.f; }
#pragma unroll
            for (int i = 0; i < 4; ++i) { const int e = c.tid + i * 512, kk = e >> 7, cc = e & 127; const int col = n0 + cc;
                Bs[kk * 132 + cc] = (col < N) ? W[(size_t)(k0 + kk) * ldb + col] : 0.f; }
            __syncthreads();
#pragma unroll 2
            for (int kk = 0; kk < 16; ++kk) {
                float a[4], b[8];
#pragma unroll
                for (int i = 0; i < 4; ++i) a[i] = As[kk * 132 + ty * 4 + i];
#pragma unroll
                for (int j = 0; j < 8; ++j) b[j] = Bs[kk * 132 + tx * 8 + j];
#pragma unroll
                for (int i = 0; i < 4; ++i)
#pragma unroll
                    for (int j = 0; j < 8; ++j) acc[i][j] = fmaf(a[i], b[j], acc[i][j]);
            }
        }
        LAS float* Cs = Bs + 16 * 132;
        __syncthreads();
#pragma unroll
        for (int i = 0; i < 4; ++i)
#pragma unroll
            for (int j = 0; j < 8; ++j) Cs[(ty * 4 + i) * 129 + tx * 8 + j] = acc[i][j];
        __syncthreads();
#pragma unroll 1
        for (int e = c.tid; e < 128 * 128; e += NTHREADS) { const int r = e >> 7, cc = e & 127, row = m0 + r, col = n0 + cc; if (row < M && col < N) ef(row, col, Cs[r * 129 + cc]); }
    }
    __syncthreads();
}

struct InProjOut { bf16* qn; bf16* kv6; bf16* fqkv; bf16* dqk; bf16* dv; float* gate; float* fl; const float* b_gate; const float* b_fgt; };
__device__ __forceinline__ void inproj_store(const InProjOut& o, int n, int col, float v) {
    const int b = n / T_, t = n % T_;
    if (col < C_KV6) { const int h = col >> 6, d = col & 63; o.qn[((size_t)(b * 8 + h) * T_ + t) * 64 + d] = (bf16)f2bf(v * (0.125f * LOG2E)); }
    else if (col < C_GATE) { const int cc = col - C_KV6, idx = cc >> 7, g = (cc >> 6) & 1, d = cc & 63;
        ((bf16*)((unsigned char*)o.kv6 + idx * KV6_STRIDE))[((size_t)(b * 2 + g) * T_ + t) * 64 + d] = (bf16)f2bf(v); }
    else if (col < C_FQ) { const int j = col - C_GATE; o.gate[(size_t)n * 24 + j] = sigmoidf_(v + o.b_gate[j]); }
    else if (col < C_FF) { const int cc = col - C_FQ, idx = cc >> 8, h = (cc >> 6) & 3, d = cc & 63;
        o.fqkv[(size_t)idx * (8 * MiB) + ((size_t)(b * 4 + h) * T_ + t) * 64 + d] = (bf16)f2bf(idx == 0 ? v * (0.125f * LOG2E) : v); }
    else if (col < C_DQ) { const int h = col - C_FF; o.fl[(size_t)(b * 4 + h) * T_ + t] = log_sigmoidf_(v + o.b_fgt[h]); }
    else if (col < C_DV) { const int cc = col - C_DQ, idx = cc >> 8, h = (cc >> 6) & 3, i = (cc >> 5) & 1, d = cc & 31;
        o.dqk[(size_t)idx * (8 * MiB) + ((size_t)((b * 4 + h) * 2 + i) * T_ + t) * 32 + d] = (bf16)f2bf(idx == 0 ? v * (0.17677669529663687f * LOG2E) : v); }
    else { const int cc = col - C_DV, h = cc >> 6, d = cc & 63; o.dv[((size_t)(b * 4 + h) * T_ + t) * 64 + d] = (bf16)f2bf(v); }
}

__device__ __forceinline__ void ph_cumsum(const Ctx& c, float* fl) {
    for (int s = c.gw; s < B_ * 4; s += c.ngw) {
        float* p = fl + (size_t)s * T_; float carry = 0.f;
        for (int t0 = 0; t0 < T_; t0 += 64) {
            float v = p[t0 + c.lane];
#pragma unroll
            for (int o = 1; o < 64; o <<= 1) { const float u = __shfl_up(v, o); if (c.lane >= o) v += u; }
            v += carry; p[t0 + c.lane] = v; carry = __shfl(v, 63);
        }
    }
}

template <int DQK>
__device__ __forceinline__ float naive_attn_row(const bf16* q, const bf16* K, const bf16* V, int t, u64 mask, float slope2, const float* cum, int win, int lane) {
    float qv[DQK];
    { const u32x4* q4 = (const u32x4*)q;
#pragma unroll
      for (int i = 0; i < DQK / 8; ++i) { const u32x4 w = q4[i];
          qv[8 * i + 0] = __uint_as_float(w.x << 16); qv[8 * i + 1] = __uint_as_float(w.x & 0xffff0000u);
          qv[8 * i + 2] = __uint_as_float(w.y << 16); qv[8 * i + 3] = __uint_as_float(w.y & 0xffff0000u);
          qv[8 * i + 4] = __uint_as_float(w.z << 16); qv[8 * i + 5] = __uint_as_float(w.z & 0xffff0000u);
          qv[8 * i + 6] = __uint_as_float(w.w << 16); qv[8 * i + 7] = __uint_as_float(w.w & 0xffff0000u); } }
    const float cumt = cum ? cum[t] : 0.f;
    float m = -INFINITY, l = 0.f, o = 0.f;
    while (mask) {
        const int j = __builtin_ctzll(mask); mask &= mask - 1;
        const int kpos = 64 * j + lane; const int dist = t - kpos;
        const bool valid = dist >= 0 && dist < win;
        float s = 0.f;
        { const u32x4* k4 = (const u32x4*)(K + (size_t)kpos * DQK);
#pragma unroll
          for (int i = 0; i < DQK / 8; ++i) { const u32x4 w = k4[i];
              s = fmaf(qv[8 * i + 0], __uint_as_float(w.x << 16), s); s = fmaf(qv[8 * i + 1], __uint_as_float(w.x & 0xffff0000u), s);
              s = fmaf(qv[8 * i + 2], __uint_as_float(w.y << 16), s); s = fmaf(qv[8 * i + 3], __uint_as_float(w.y & 0xffff0000u), s);
              s = fmaf(qv[8 * i + 4], __uint_as_float(w.z << 16), s); s = fmaf(qv[8 * i + 5], __uint_as_float(w.z & 0xffff0000u), s);
              s = fmaf(qv[8 * i + 6], __uint_as_float(w.w << 16), s); s = fmaf(qv[8 * i + 7], __uint_as_float(w.w & 0xffff0000u), s); } }
        s -= slope2 * (float)dist;
        if (cum) s += (cumt - cum[kpos]) * LOG2E;
        s = valid ? s : -INFINITY;
        const float mb = wave_max(s);
        if (mb == -INFINITY) continue;
        const float mn = fmaxf(m, mb), alpha = exp2f(m - mn);
        const float p = valid ? exp2f(s - mn) : 0.f;
        l = l * alpha + wave_sum(p); o *= alpha; m = mn;
        const bf16* vb = V + (size_t)(64 * j) * 64 + lane;
#pragma unroll 8
        for (int k = 0; k < 64; ++k) o = fmaf(__shfl(p, k), bf2f(vb[(size_t)k * 64]), o);
    }
    return l > 0.f ? o / l : 0.f;
}

__device__ __forceinline__ void ph_cmp_attn(const Ctx& c, const bf16* qn, const bf16* kcmp, const bf16* vcmp, const float* gate, u64* sel, bf16* ocmp) {
    LAS float* pl = (LAS float*)(c.lds) + c.wave * 256;
    const int lane = c.lane;
    for (int it = c.gw; it < B_ * 2 * T_; it += c.ngw) {
        const int t = it % T_, bg = it / T_, b = bg >> 1, g = bg & 1;
        const int nvis = (t >= 31) ? ((t - 31) >> 4) + 1 : 0;
        const bf16* kc = kcmp + (size_t)bg * 256 * 64; const bf16* vc = vcmp + (size_t)bg * 256 * 64;
        float imp = 0.f;
        for (int hg = 0; hg < 4; ++hg) {
            const int h = g * 4 + hg; const float slope2 = alibi_slope(h + 1, 8) * LOG2E;
            const bf16* q = qn + ((size_t)(b * 8 + h) * T_ + t) * 64;
            float qv[64];
            { const u32x4* q4 = (const u32x4*)q;
#pragma unroll
              for (int i = 0; i < 8; ++i) { const u32x4 w = q4[i];
                  qv[8 * i + 0] = __uint_as_float(w.x << 16); qv[8 * i + 1] = __uint_as_float(w.x & 0xffff0000u);
                  qv[8 * i + 2] = __uint_as_float(w.y << 16); qv[8 * i + 3] = __uint_as_float(w.y & 0xffff0000u);
                  qv[8 * i + 4] = __uint_as_float(w.z << 16); qv[8 * i + 5] = __uint_as_float(w.z & 0xffff0000u);
                  qv[8 * i + 6] = __uint_as_float(w.w << 16); qv[8 * i + 7] = __uint_as_float(w.w & 0xffff0000u); } }
            float s[4]; float m = -INFINITY;
#pragma unroll
            for (int i = 0; i < 4; ++i) { const int cc = lane + 64 * i; float a = 0.f;
                if (cc < nvis) { const u32x4* k4 = (const u32x4*)(kc + (size_t)cc * 64);
#pragma unroll
                    for (int e = 0; e < 8; ++e) { const u32x4 w = k4[e];
                        a = fmaf(qv[8 * e + 0], __uint_as_float(w.x << 16), a); a = fmaf(qv[8 * e + 1], __uint_as_float(w.x & 0xffff0000u), a);
                        a = fmaf(qv[8 * e + 2], __uint_as_float(w.y << 16), a); a = fmaf(qv[8 * e + 3], __uint_as_float(w.y & 0xffff0000u), a);
                        a = fmaf(qv[8 * e + 4], __uint_as_float(w.z << 16), a); a = fmaf(qv[8 * e + 5], __uint_as_float(w.z & 0xffff0000u), a);
                        a = fmaf(qv[8 * e + 6], __uint_as_float(w.w << 16), a); a = fmaf(qv[8 * e + 7], __uint_as_float(w.w & 0xffff0000u), a); }
                    a -= slope2 * (float)(t - (16 * cc + 31)); } else a = -INFINITY;
                s[i] = a; m = fmaxf(m, a); }
            m = wave_max(m);
            float p[4], lsum = 0.f;
#pragma unroll
            for (int i = 0; i < 4; ++i) { p[i] = (lane + 64 * i < nvis) ? exp2f(s[i] - m) : 0.f; lsum += p[i]; }
            lsum = wave_sum(lsum);
            const float inv = lsum > 0.f ? 1.f / lsum : 0.f;
#pragma unroll
            for (int i = 0; i < 4; ++i) { p[i] *= inv; pl[lane + 64 * i] = p[i]; }
            asm volatile("s_waitcnt lgkmcnt(0)" ::: "memory");
            float o = 0.f;
            for (int cc = 0; cc < nvis; ++cc) o = fmaf(pl[cc], bf2f(vc[(size_t)cc * 64 + lane]), o);
            const float gt = gate[((size_t)(b * T_ + t)) * 24 + h * 3 + 0];
            ocmp[(size_t)(b * T_ + t) * 512 + h * 64 + lane] = (bf16)f2bf(gt * o);
            { const int j = lane; float a = pl[4 * j] + pl[4 * j + 1] + pl[4 * j + 2] + 0.5f * pl[4 * j + 3]; if (j > 0) a += 0.5f * pl[4 * j - 1]; imp += a; }
            asm volatile("s_waitcnt lgkmcnt(0)" ::: "memory");
        }
        const int cur = t >> 6; const int j = lane;
        u64 m64;
        if (cur <= 15) m64 = (cur == 63) ? ~0ull : ((1ull << (cur + 1)) - 1ull);
        else {
            float val = (j > cur) ? -INFINITY : ((j == 0 || j == cur || j == cur - 1) ? 1e4f : imp);
            m64 = 0ull;
            for (int r = 0; r < 16; ++r) {
                const float mx = wave_max(val);
                const u64 bal = __ballot(val == mx);
                const int w = __builtin_ctzll(bal);
                m64 |= 1ull << w; if (j == w) val = -INFINITY;
            }
        }
        if (lane == 0) sel[(size_t)bg * T_ + t] = m64;
    }
}

__device__ __forceinline__ void ph_win_attn(const Ctx& c, const bf16* qn, const bf16* kw, const bf16* vw, const float* gate, bf16* owin) {
    for (int it = c.gw; it < B_ * 8 * T_; it += c.ngw) {
        const int t = it % T_, bh = it / T_, b = bh >> 3, h = bh & 7, g = h >> 2;
        const int cur = t >> 6, jlo = (t - 511) > 0 ? (t - 511) >> 6 : 0;
        const u64 hi = (cur == 63) ? ~0ull : ((1ull << (cur + 1)) - 1ull); const u64 mask = hi & ~((1ull << jlo) - 1ull);
        const float o = naive_attn_row<64>(qn + ((size_t)bh * T_ + t) * 64, kw + (size_t)(b * 2 + g) * T_ * 64, vw + (size_t)(b * 2 + g) * T_ * 64, t, mask,
                                           alibi_slope(h + 1, 8) * LOG2E, nullptr, 512, c.lane);
        owin[(size_t)(b * T_ + t) * 512 + h * 64 + c.lane] = (bf16)f2bf(gate[(size_t)(b * T_ + t) * 24 + h * 3 + 2] * o);
    }
}
__device__ __forceinline__ void ph_slc_attn(const Ctx& c, const bf16* qn, const bf16* ks, const bf16* vs, const float* gate, const u64* sel, const bf16* ocmp, const bf16* owin, bf16* att) {
    for (int it = c.gw; it < B_ * 8 * T_; it += c.ngw) {
        const int t = it % T_, bh = it / T_, b = bh >> 3, h = bh & 7, g = h >> 2;
        const u64 mask = sel[(size_t)(b * 2 + g) * T_ + t];
        const float o = naive_attn_row<64>(qn + ((size_t)bh * T_ + t) * 64, ks + (size_t)(b * 2 + g) * T_ * 64, vs + (size_t)(b * 2 + g) * T_ * 64, t, mask,
                                           alibi_slope(h + 1, 8) * LOG2E, nullptr, 1 << 30, c.lane);
        const size_t n = (size_t)(b * T_ + t);
        const float r = gate[n * 24 + h * 3 + 1] * o + bf2f(ocmp[n * 512 + h * 64 + c.lane]) + bf2f(owin[n * 512 + h * 64 + c.lane]);
        att[n * 1024 + h * 64 + c.lane] = (bf16)f2bf(r);
    }
}
__device__ __forceinline__ void ph_fox_attn(const Ctx& c, const bf16* fq, const bf16* fk, const bf16* fv, const float* cum, bf16* att) {
    for (int it = c.gw; it < B_ * 4 * T_; it += c.ngw) {
        const int t = it % T_, bh = it / T_, b = bh >> 2, h = bh & 3;
        const int cur = t >> 6; const u64 mask = (cur == 63) ? ~0ull : ((1ull << (cur + 1)) - 1ull);
        const float o = naive_attn_row<64>(fq + ((size_t)bh * T_ + t) * 64, fk + (size_t)bh * T_ * 64, fv + (size_t)bh * T_ * 64, t, mask, 0.f, cum + (size_t)bh * T_, 1 << 30, c.lane);
        att[(size_t)(b * T_ + t) * 1024 + 512 + h * 64 + c.lane] = (bf16)f2bf(o);
    }
}
__device__ __forceinline__ void ph_diff_attn(const Ctx& c, const bf16* dq, const bf16* dk, const bf16* dv, const float* lam, const float* subln, float lambda_init, bf16* att) {
    float l1 = 0.f, l2 = 0.f;
    if (c.lane < 32) { l1 = lam[c.lane] * lam[32 + c.lane]; l2 = lam[64 + c.lane] * lam[96 + c.lane]; }
    const float lam_full = __expf(wave_sum(l1)) - __expf(wave_sum(l2)) + lambda_init;
    const float sg = subln[c.lane] * (1.f - lambda_init);
    for (int it = c.gw; it < B_ * 4 * T_; it += c.ngw) {
        const int t = it % T_, bh = it / T_, b = bh >> 2, h = bh & 3;
        const int cur = t >> 6; const u64 mask = (cur == 63) ? ~0ull : ((1ull << (cur + 1)) - 1ull);
        const float slope2 = alibi_slope(h + 1, 4) * LOG2E;
        const bf16* vb = dv + (size_t)bh * T_ * 64;
        const float o1 = naive_attn_row<32>(dq + ((size_t)(bh * 2 + 0) * T_ + t) * 32, dk + (size_t)(bh * 2 + 0) * T_ * 32, vb, t, mask, slope2, nullptr, 1 << 30, c.lane);
        const float o2 = naive_attn_row<32>(dq + ((size_t)(bh * 2 + 1) * T_ + t) * 32, dk + (size_t)(bh * 2 + 1) * T_ * 32, vb, t, mask, slope2, nullptr, 1 << 30, c.lane);
        const float o = o1 - lam_full * o2;
        const float r = rsqrtf(wave_sum(o * o) * (1.f / 64.f) + EPS);
        att[(size_t)(b * T_ + t) * 1024 + 768 + h * 64 + c.lane] = (bf16)f2bf(o * r * sg);
    }
}

__device__ __forceinline__ void ph_moe_route(const Ctx& c, const float* x, const float* g, const float* wgrp, const float* bgrp, const float* wexp, const float* bexp, bf16* hn, int* route_e, float* route_w, unsigned* cnt) {
    for (int row = c.gw; row < NT; row += c.ngw) {
        const f32x4* xr = (const f32x4*)(x + (size_t)row * D_) + c.lane;
        f32x4 v[4]; float ss = 0.f;
#pragma unroll
        for (int j = 0; j < 4; ++j) { v[j] = xr[64 * j]; ss += v[j].x * v[j].x + v[j].y * v[j].y + v[j].z * v[j].z + v[j].w * v[j].w; }
        const float r = rsqrtf(wave_sum(ss) * (1.f / D_) + EPS);
        u64* o8 = (u64*)(hn + (size_t)row * D_) + c.lane;
#pragma unroll
        for (int j = 0; j < 4; ++j) { const f32x4 gg = ((const f32x4*)g)[c.lane + 64 * j]; v[j] = v[j] * r * gg;
            o8[64 * j] = (u64)pk2(v[j].x, v[j].y) | ((u64)pk2(v[j].z, v[j].w) << 32); }
        float gl[4];
#pragma unroll
        for (int q = 0; q < 4; ++q) { float a = 0.f;
#pragma unroll
            for (int j = 0; j < 4; ++j) { const int k = 4 * (c.lane + 64 * j);
                a = fmaf(v[j].x, wgrp[(size_t)(k + 0) * 4 + q], a); a = fmaf(v[j].y, wgrp[(size_t)(k + 1) * 4 + q], a);
                a = fmaf(v[j].z, wgrp[(size_t)(k + 2) * 4 + q], a); a = fmaf(v[j].w, wgrp[(size_t)(k + 3) * 4 + q], a); }
            gl[q] = wave_sum(a) + bgrp[q]; }
        int grp = 0; float gm = gl[0];
#pragma unroll
        for (int q = 1; q < 4; ++q) if (gl[q] > gm) { gm = gl[q]; grp = q; }
        float gs = 0.f;
#pragma unroll
        for (int q = 0; q < 4; ++q) gs += __expf(gl[q] - gm);
        const float grp_gate = 1.f / gs;
        float el[8];
#pragma unroll
        for (int q = 0; q < 8; ++q) { float a = 0.f; const int col = grp * 8 + q;
#pragma unroll
            for (int j = 0; j < 4; ++j) { const int k = 4 * (c.lane + 64 * j);
                a = fmaf(v[j].x, wexp[(size_t)(k + 0) * 32 + col], a); a = fmaf(v[j].y, wexp[(size_t)(k + 1) * 32 + col], a);
                a = fmaf(v[j].z, wexp[(size_t)(k + 2) * 32 + col], a); a = fmaf(v[j].w, wexp[(size_t)(k + 3) * 32 + col], a); }
            el[q] = wave_sum(a) + bexp[col]; }
        int i0 = 0; float v0 = el[0];
#pragma unroll
        for (int q = 1; q < 8; ++q) if (el[q] > v0) { v0 = el[q]; i0 = q; }
        int i1 = -1; float v1 = -INFINITY;
#pragma unroll
        for (int q = 0; q < 8; ++q) if (q != i0 && el[q] > v1) { v1 = el[q]; i1 = q; }
        const float e1 = __expf(v1 - v0), den = 1.f + e1;
        if (c.lane == 0) { const float w0 = grp_gate / den, w1 = grp_gate * e1 / den;
            const int lo = i0 < i1 ? i0 : i1, hi = i0 < i1 ? i1 : i0, cls = grp * 28 + lo * 8 - (lo * (lo + 1)) / 2 + (hi - lo - 1);
            const unsigned rank = __hip_atomic_fetch_add(cnt + cls, 1u, __ATOMIC_RELAXED, __HIP_MEMORY_SCOPE_AGENT);
            route_e[row] = (int)(((unsigned)cls << 24) | rank); route_w[2 * row] = i0 < i1 ? w0 : w1; route_w[2 * row + 1] = i0 < i1 ? w1 : w0; }
    }
}
__device__ __forceinline__ void ph_moe_naive(const Ctx& c, const bf16* hn, const int* route_e, const float* route_w, const float* wg, const float* wu, const float* wd, float* x) {
    LAS float* hs = (LAS float*)c.lds;
    LAS float* au = hs + 1024;
    LAS float* h2 = au + 512;
    for (int row = c.bid; row < NT; row += c.G) {
        __syncthreads();
        hs[c.tid] = bf2f(hn[(size_t)row * D_ + c.tid]); hs[c.tid + 512] = bf2f(hn[(size_t)row * D_ + c.tid + 512]);
        float o0 = 0.f, o1 = 0.f;
        for (int s = 0; s < 2; ++s) {
            const int e = route_e[2 * row + s]; const float w = route_w[2 * row + s];
            __syncthreads();
            const float* W = (c.tid < 256 ? wg : wu) + (size_t)e * D_ * DEXP + (c.tid & 255);
            float a = 0.f;
            for (int k = 0; k < D_; ++k) a = fmaf(hs[k], W[(size_t)k * DEXP], a);
            au[c.tid] = a;
            __syncthreads();
            if (c.tid < 256) { const float ga = au[c.tid], up = au[c.tid + 256]; h2[c.tid] = ga / (1.f + __expf(-ga)) * up * w; }
            __syncthreads();
            const float* Wd = wd + (size_t)e * DEXP * D_;
            for (int k = 0; k < DEXP; ++k) { const float hv = h2[k]; o0 = fmaf(hv, Wd[(size_t)k * D_ + c.tid], o0); o1 = fmaf(hv, Wd[(size_t)k * D_ + c.tid + 512], o1); }
        }
        x[(size_t)row * D_ + c.tid] += o0; x[(size_t)row * D_ + c.tid + 512] += o1;
    }
    __syncthreads();
}

typedef __attribute__((address_space(4))) const Params* KP;
__device__ __forceinline__ KP uni_kp(KP p) { const unsigned long long v = (unsigned long long)p; const unsigned lo = __builtin_amdgcn_readfirstlane((unsigned)v), hi = __builtin_amdgcn_readfirstlane((unsigned)(v >> 32)); return (KP)(((unsigned long long)hi << 32) | lo); }
constexpr int PH_PER_LAYER = 11, N_PHASES = L_ * PH_PER_LAYER + 2;
__device__ __forceinline__ Ctx make_ctx(KP p) {
    Ctx c; c.lds = (LAS unsigned char*)lds_raw; { int t_ = threadIdx.x; asm volatile("" : "+v"(t_)); c.tid = t_; } c.lane = c.tid & 63; c.wave = __builtin_amdgcn_readfirstlane(c.tid >> 6);
    c.bid = blockIdx.x; c.G = gridDim.x; c.gw = c.bid * NWAVES + c.wave; c.ngw = c.G * NWAVES; c.in = nullptr; c.xcur = p->out; c.ws = p->ws;
    return c;
}
struct Bufs {
    bf16 *QN, *KV6, *KC, *VC, *KS, *VS, *KW, *VW, *FQ, *FK, *FV, *DQ, *DK, *DV, *HC, *KCMP, *VCMP, *OCMP, *OWIN, *HN, *ATT;
    float *GATE, *FL, *ROUTE_W; u64* SEL; int* ROUTE_E;
};
__device__ __forceinline__ Bufs make_bufs(unsigned char* ws) {
    Bufs b;
    b.QN = (bf16*)(ws + WS_QN); b.KV6 = (bf16*)(ws + WS_KV6);
    b.KC = (bf16*)(ws + WS_KV6 + 0 * KV6_STRIDE); b.VC = (bf16*)(ws + WS_KV6 + 1 * KV6_STRIDE);
    b.KS = (bf16*)(ws + WS_KV6 + 2 * KV6_STRIDE); b.VS = (bf16*)(ws + WS_KV6 + 3 * KV6_STRIDE);
    b.KW = (bf16*)(ws + WS_KV6 + 4 * KV6_STRIDE); b.VW = (bf16*)(ws + WS_KV6 + 5 * KV6_STRIDE);
    b.FQ = (bf16*)(ws + WS_FQKV); b.FK = b.FQ + 8 * MiB; b.FV = b.FQ + 16 * MiB;
    b.DQ = (bf16*)(ws + WS_DQK); b.DK = b.DQ + 8 * MiB; b.DV = (bf16*)(ws + WS_DV);
    b.GATE = (float*)(ws + WS_GATE); b.FL = (float*)(ws + WS_FL);
    b.HC = (bf16*)(ws + WS_HC); b.KCMP = (bf16*)(ws + WS_KVCMP); b.VCMP = b.KCMP + 16 * 256 * 64;
    b.SEL = (u64*)(ws + WS_SEL); b.OCMP = (bf16*)(ws + WS_OCMP); b.OWIN = (bf16*)(ws + WS_OWIN);
    b.HN = (bf16*)(ws + WS_HN); b.ATT = (bf16*)(ws + WS_ATT);
    b.ROUTE_E = (int*)(ws + WS_ROUTE); b.ROUTE_W = (float*)(ws + WS_ROUTE + 512 * 1024);
    return b;
}
__device__ __forceinline__ float lambda_init_of(int l) { return l == 0 ? 0.2f : 0.35550906759096926f; }

__device__ __noinline__ void P_prologue(KP p_) { const KP p = uni_kp(p_);
    const Ctx c = make_ctx(p); unsigned char* ws = p->ws;
    LAS float* scr = (LAS float*)(c.lds) + c.wave * (64 * 33);
    constexpr int I_A = 16 * 40, I_B = 16 * 24, I_C = 16 * 24, I_O = 16 * 32, I_G = 16 * 8, I_D = 4 * 32, I_E = 2 * I_G + I_D, I_W1 = 32 * 8, I_W2 = 4 * 2;
    constexpr int PER_L = I_A + I_B + I_C + I_O + 2 * (I_W1 + I_W2);
    for (int it = c.gw; it < L_ * PER_L; it += c.ngw) {
        const int l = it / PER_L; int r = it % PER_L;
        const float* W; bf16* WT; int ldw, K, sc0, ncol, r0 = 0, rmul = 1; const bool isin = r < I_A + I_B + I_C;
        if (r < I_A + I_B + I_C) { W = p->in[2] + (size_t)l * D_ * D_IN; WT = (bf16*)(ws + WS_WIN_T) + (size_t)l * NIN * D_; ldw = D_IN; K = D_;
            if (r < I_A) { sc0 = 0; ncol = 1280; r0 = 0; } else if (r < I_A + I_B) { r -= I_A; sc0 = C_FQ; ncol = 768; r0 = 1280; } else { r -= I_A + I_B; sc0 = C_DQ; ncol = 768; r0 = 2048; } }
        else if ((r -= I_A + I_B + I_C) < I_O) { W = p->in[13] + (size_t)l * D_ * D_; WT = (bf16*)(ws + WS_WOUT_T) + (size_t)l * D_ * D_; ldw = D_; K = D_; sc0 = 0; ncol = 1024; }
        else { r -= I_O; const int kv = r / (I_W1 + I_W2); r = r % (I_W1 + I_W2); const size_t lk = (size_t)l * 2 + kv;
            if (r < I_W1) { W = p->in[kv == 0 ? 6 : 9] + (size_t)l * 2048 * 256; WT = (bf16*)(ws + WS_W1_T) + lk * 256 * 2048; ldw = 256; K = 2048; sc0 = 0; ncol = 256; }
            else { r -= I_W1; W = p->in[kv == 0 ? 7 : 10] + (size_t)l * 256 * 64; WT = (bf16*)(ws + WS_W2_T) + lk * 64 * 256; ldw = 64; K = 256; sc0 = 0; ncol = 64; } }
        transpose_seg(W, ldw, K, sc0, ncol, WT, r0, rmul, r, scr, c.lane, isin ? p->in[1] + (size_t)l * D_ : nullptr);
    }
    for (int i = c.bid * NTHREADS + c.tid; i < L_ * 256 * D_; i += c.G * NTHREADS) {
        const int l = i / (256 * D_), rr = (i / D_) % 256, k = i % D_;
        const float* win = p->in[2] + (size_t)l * D_ * D_IN;
        float v = 0.f; if (rr < 24) v = win[(size_t)k * D_IN + C_GATE + rr]; else if (rr < 28) v = win[(size_t)k * D_IN + C_FF + (rr - 24)];
        if (rr < 28) v *= p->in[1][(size_t)l * D_ + k];
        ((bf16*)(ws + WS_WIN_T))[((size_t)l * NIN + 2816 + rr) * D_ + k] = (bf16)f2bf(v);
    }
    for (int w = c.gw; w < L_ * 2 * 4 * 128; w += c.ngw) {
        const int lk = w >> 9, cg = (w >> 7) & 3, kc = w & 127, l = lk >> 1, kv = lk & 1, j = cg * 64 + c.lane;
        const float* pe = p->in[kv == 0 ? 5 : 8] + (size_t)l * 2048 + kc * 16; const float* w1 = p->in[kv == 0 ? 6 : 9] + (size_t)l * 2048 * 256 + (size_t)kc * 16 * 256;
        float a = 0.f;
#pragma unroll
        for (int k = 0; k < 16; ++k) a = fmaf(pe[k], w1[(size_t)k * 256 + j], a);
        ((float*)(ws + WS_B1PART))[((size_t)lk * 128 + kc) * 256 + j] = a;
    }
    for (int i = c.bid * NTHREADS + c.tid; i < L_ * 64 * 2 * 64; i += c.G * NTHREADS) {
        const int l = i / (64 * 2 * 64), ks = (i / 128) % 64, cb = (i / 64) & 1, lane = i & 63, col = 32 * cb + (lane & 31);
        unsigned hi[4], lo[4];
#pragma unroll
        for (int jp = 0; jp < 4; ++jp) { float v[2];
#pragma unroll
            for (int e = 0; e < 2; ++e) { const int k = 16 * ks + 8 * (lane >> 5) + 2 * jp + e; const float g = p->in[14][(size_t)l * D_ + k];
                v[e] = col < 4 ? g * p->in[15][((size_t)l * D_ + k) * 4 + col] : (col < 36 ? g * p->in[17][((size_t)l * D_ + k) * 32 + (col - 4)] : 0.f); }
            const unsigned h0 = f2bf(v[0]), h1 = f2bf(v[1]); hi[jp] = h0 | (h1 << 16);
            lo[jp] = f2bf(v[0] - __uint_as_float(h0 << 16)) | (f2bf(v[1] - __uint_as_float(h1 << 16)) << 16); }
        u32x4* dst = (u32x4*)(ws + WS_WR) + ((size_t)((l * 64 + ks) * 2 + cb) * 2) * 64 + lane;
        dst[0] = (u32x4){hi[0], hi[1], hi[2], hi[3]}; dst[64] = (u32x4){lo[0], lo[1], lo[2], lo[3]};
    }
}
__device__ __forceinline__ void P_inproj_mfma(int l_) { const KP p = (KP)__builtin_amdgcn_kernarg_segment_ptr(); int l = l_; asm volatile("" : "+s"(l));
    unsigned char* ws = p->ws; asm volatile("" : "+s"(ws));
    PlainOrder S; S.init((const bf16*)(ws + WS_HN), (const bf16*)(ws + WS_WIN_T) + (size_t)l * NIN * D_, D_, D_, NT, NIN, (int)gridDim.x, launder_s((int)blockIdx.x));
    {
        static_assert(NT / 256 == 128 && NIN / 256 == 12, "a workgroup's six in-projection units cover exactly two row tiles, pm and pm + 8 (units 0..2 and 3..5)");
        int t_ = threadIdx.x; asm volatile("" : "+v"(t_));
        pg8::Unit u; S.next(0, u);
        __syncthreads();
        float v;
        { const f32x4* sp = (const f32x4*)((const float*)(ws + WS_SSQ) + ((size_t)(u.pm + ((t_ >> 8) << 3)) * 256 + (t_ & 255)) * 16); const f32x4 a = sp[0], b2 = sp[1], c2 = sp[2], d2 = sp[3];
            const float s16 = (((a.x + a.y) + (a.z + a.w)) + ((b2.x + b2.y) + (b2.z + b2.w))) + (((c2.x + c2.y) + (c2.z + c2.w)) + ((d2.x + d2.y) + (d2.z + d2.w)));
            v = __builtin_amdgcn_rsqf(s16 * (1.f / D_) + EPS); }
        ((LAS float*)((LAS unsigned char*)lds_raw + RSTD_OFF))[(((u.pm >> 3) & 1) ^ (t_ >> 8)) * 256 + (t_ & 255)] = v;
        __syncthreads();
    }
#ifdef STAGGER_TICKS
    { const unsigned long long t0 = __builtin_amdgcn_s_memrealtime(); const unsigned long long d = (unsigned long long)((launder_s((int)blockIdx.x) >> 3) & 3) * STAGGER_TICKS;
      while (__builtin_amdgcn_s_memrealtime() - t0 < d) __builtin_amdgcn_s_sleep(4); }
#endif
    const pg8::Gemm g{D_, D_, D_, D_ / 64, 0, 0};
    const EpiInProj E{ws, p->in[3] + l * 24, p->in[4] + l * 4, (unsigned*)(ws + WS_CTL) + CW_KN + l * 8192};
    pg8::gemm_phase<EpiInProj, PlainOrder, INPROJ_ALIGN, INPROJ_SP2>((LAS unsigned char*)lds_raw, g, S, E);
}
__device__ __forceinline__ void P_inproj_dummy(int l_) { const KP p = (KP)__builtin_amdgcn_kernarg_segment_ptr(); int l = l_; asm volatile("" : "+s"(l));
    unsigned char* ws = p->ws; asm volatile("" : "+s"(ws));
    PlainOrder S; S.init(p->out, (const bf16*)(ws + WS_WIN_T) + (size_t)l * NIN * D_, D_, D_, NT, NIN, (int)gridDim.x, launder_s((int)blockIdx.x));
    const pg8::Gemm g{D_, D_, D_, D_ / 64, 0, 0};
    const EpiDummy E{(float*)(ws + WS_HB)};
    pg8::gemm_phase<EpiDummy, PlainOrder, true, true>((LAS unsigned char*)lds_raw, g, S, E);
}
__device__ __forceinline__ void P_outproj_mfma(int l_) { const KP p = (KP)__builtin_amdgcn_kernarg_segment_ptr(); int l = l_; asm volatile("" : "+s"(l));
    unsigned char* ws = p->ws; asm volatile("" : "+s"(ws));
    PlainOrder S; S.init(ws + WS_ATT, (const bf16*)(ws + WS_WOUT_T) + (size_t)l * D_ * D_, D_, D_, NT, D_, (int)gridDim.x, launder_s((int)blockIdx.x));
    const pg8::Gemm g{D_, D_, D_, D_ / 64, 32, 8};
    const EpiResBf16 E{(bf16*)(ws + WS_HN)};
    pg8::gemm_phase<EpiResBf16, PlainOrder, true, true>((LAS unsigned char*)lds_raw, g, S, E);
}
#define DPP_SHR(x, n) __builtin_amdgcn_update_dpp((x), (x), 0x110 + (n), 0xf, 0xf, false)
__device__ __forceinline__ unsigned wave_or_u(unsigned v) {
    v |= DPP_SHR(v, 1); v |= DPP_SHR(v, 2); v |= DPP_SHR(v, 4); v |= DPP_SHR(v, 8);
    { auto r = __builtin_amdgcn_permlane16_swap(v, v, false, false); v = r[0] | r[1]; }
    { auto r = __builtin_amdgcn_permlane32_swap(v, v, false, false); v = r[0] | r[1]; }
    return (unsigned)__builtin_amdgcn_readlane((int)v, 15);
}
__device__ __forceinline__ float wave_max_l(float v, int lane) {
#pragma unroll
    for (int o = 1; o < 64; o <<= 1) v = fmaxf(v, shflx_f(v, o, lane));
    return v;
}
__device__ __forceinline__ float wave_min_l(float v, int lane) {
#pragma unroll
    for (int o = 1; o < 64; o <<= 1) v = fminf(v, shflx_f(v, o, lane));
    return v;
}
template <int NS> __device__ __forceinline__ float q_norm2_max(const bf16x8v (&Q)[NS], int lane) {
    float ss = 0.f;
#pragma unroll
    for (int s = 0; s < NS; ++s)
#pragma unroll
        for (int e = 0; e < 8; ++e) { const float v = __uint_as_float(((unsigned)(unsigned short)Q[s][e]) << 16); ss = fmaf(v, v, ss); }
    return wave_max_l(swap_sum(ss), lane);
}
__device__ __forceinline__ u64 prune_consensus(bool skip, LAS u64* slots, int wave, int lane) {
    const u64 mine = __ballot(skip);
    __syncthreads();
    if (lane == 0) slots[wave] = mine;
    __syncthreads();
    u64 all = slots[0];
#pragma unroll
    for (int w = 1; w < NWAVES; ++w) all &= slots[w];
    return all;
}
__device__ __forceinline__ bool block_any(bool v, LAS u64* slots, int wave, int lane) {
#ifdef FORCE_FALLBACK
    v = true;
#endif
    const u64 mine = __ballot(v);
    __syncthreads();
    if (lane == 0) slots[wave] = mine;
    __syncthreads();
    u64 all = slots[0];
#pragma unroll
    for (int w = 1; w < NWAVES; ++w) all |= slots[w];
    return all != 0ull;
}
__device__ __forceinline__ bool sum_bad(float l) { return !(l < 1e30f); }
__device__ __forceinline__ void U_fox(KP p_, int bh_, int qb_, int l_) {
    const KP p = uni_kp(p_); const int bh = __builtin_amdgcn_readfirstlane(bh_), qb = __builtin_amdgcn_readfirstlane(qb_), l = __builtin_amdgcn_readfirstlane(l_);
    int tid_ = threadIdx.x; asm volatile("" : "+v"(tid_));
    const int tid = tid_, lane = tid & 63, wave = __builtin_amdgcn_readfirstlane(tid >> 6), r = lane & 31, h = lane >> 5;
    unsigned char* ws = p->ws; asm volatile("" : "+s"(ws)); LAS unsigned char* L = (LAS unsigned char*)lds_raw;
    const int tw0 = 256 * qb + 32 * wave, t_lane = tw0 + r, b = bh >> 2, hd = bh & 3;
    const bf16* q = (const bf16*)(ws + WS_FQKV) + (size_t)bh * T_ * 64 + (t_lane >> 4) * 1024 + (t_lane & 15) * 32 + 8 * h;
    bf16x8v Qf[1][4];
#pragma unroll
    for (int s = 0; s < 4; ++s) Qf[0][s] = *(const bf16x8v*)(q + (s >> 1) * 512 + (s & 1) * 16);
    const bf16* Kp = (const bf16*)(ws + WS_FQKV) + 8 * MiB + (size_t)bh * T_ * 64; const bf16* Vp = (const bf16*)(ws + WS_FQKV) + 16 * MiB + (size_t)bh * T_ * 64;
    u32x4 kpre, vpre; attn_preload<64>(Kp, nullptr, Vp, 4 * qb + 3, tid, kpre, vpre);
    LAS float* cum = (LAS float*)(L + A_LDS_END);
    { const float* fl = (const float*)(ws + WS_FL) + (size_t)bh * T_; LAS float* tot = cum + 4096;
      const int nval = 256 * (qb + 1); float v[8];
      if (8 * tid < nval) { const f32x4 a = *(const f32x4*)(fl + 8 * tid), c2 = *(const f32x4*)(fl + 8 * tid + 4); v[0] = a.x; v[1] = a.y; v[2] = a.z; v[3] = a.w; v[4] = c2.x; v[5] = c2.y; v[6] = c2.z; v[7] = c2.w; }
      else {
#pragma unroll
          for (int i = 0; i < 8; ++i) v[i] = 0.f; }
#pragma unroll
      for (int i = 1; i < 8; ++i) v[i] += v[i - 1];
      float sc = v[7];
#pragma unroll
      for (int o = 1; o < 64; o <<= 1) { const float up = __uint_as_float((unsigned)__builtin_amdgcn_ds_bpermute((lane - o) << 2, (int)__float_as_uint(sc))); if (lane >= o) sc += up; }
      if (lane == 63) tot[wave] = sc;
      __syncthreads();
      float base = sc - v[7];
      for (int w = 0; w < wave; ++w) base += tot[w];
      if (8 * tid < nval) {
#pragma unroll
          for (int i = 0; i < 8; ++i) cum[8 * tid + i] = v[i] + base; }
      __syncthreads(); }
    f32x16 O[1][2]; float M[1] = {0.f}, Ls[1] = {0.f};
#pragma unroll
    for (int i = 0; i < 16; ++i) { O[0][0][i] = 0.f; O[0][1][i] = 0.f; }
    const u64 tm = (qb == 15) ? ~0ull : ((1ull << (4 * qb + 4)) - 1ull);
#if AC2_MODE == 0
    {
        const u64 low = (1ull << (4 * qb)) - 1ull; const float cref = cum[tw0];
#define FOX_CORES(NM, FIRSTCALL) do { FIRSTCALL; \
        if (qb > 0) { \
            const float qn2 = q_norm2_max<4>(Qf[0], lane), mmin = wave_min_l(M[0], lane); \
            const float* kn = (const float*)((const unsigned*)(ws + WS_CTL) + CW_KN + l * 8192) + ((size_t)bh * 64 + lane) * 2; \
            bool skip = false; \
            if (lane < 4 * qb) { const float kn2 = kn[0] + kn[1]; const float bound = sqrtf(qn2 * kn2) * local_const(1.02f) + (cref - cum[64 * lane + 63]) * local_const(LOG2E) - mmin; skip = bound < -152.f; } \
            const u64 drop = prune_consensus(skip, (LAS u64*)(cum + 4096 + 16), wave, lane); \
            const u64 tm2 = low & ~drop; \
            if (tm2) attn_core<64, 1, true, false, false, NM>(L, Kp, nullptr, Vp, cum, cref, Qf, tm2, t_lane, tw0, 1 << 30, 0.f, 0u, 0u, O, M, Ls, tid, true); \
        } } while (0)
        FOX_CORES(NOMAX_ON, (attn_core<64, 1, true, false, true, NOMAX_ON>(L, Kp, nullptr, Vp, cum, cref, Qf, tm & ~low, t_lane, tw0, 1 << 30, 0.f, 0u, 0u, O, M, Ls, tid, false, 4 * qb + 3, kpre, vpre)));
        if (NOMAX_ON && block_any(sum_bad(Ls[0]), (LAS u64*)(cum + 4096 + 32), wave, lane)) {
#pragma unroll
            for (int i = 0; i < 16; ++i) { O[0][0][i] = 0.f; O[0][1][i] = 0.f; }
            M[0] = 0.f; Ls[0] = 0.f;
            FOX_CORES(false, (attn_core<64, 1, true, false, false, false>(L, Kp, nullptr, Vp, cum, cref, Qf, tm & ~low, t_lane, tw0, 1 << 30, 0.f, 0u, 0u, O, M, Ls, tid)));
        }
#undef FOX_CORES
    }
#else
    attn_core2<true, false>(L, (const bf16*)(ws + WS_FQKV) + 8 * MiB + (size_t)bh * T_ * 64, (const bf16*)(ws + WS_FQKV) + 16 * MiB + (size_t)bh * T_ * 64, cum, cum[256 * qb],
                            Qf[0], tm, t_lane, tw0, 1 << 30, 0.f, 0u, 0u, O[0], M[0], Ls[0], tid);
#endif
    const float lt = swap_sum(Ls[0]), inv = lt > 0.f ? 1.f / lt : 0.f;
    bf16* dst = (bf16*)(ws + WS_ATT) + mix_off((size_t)b * T_ + t_lane, 512 + hd * 64 + 4 * h, 1024);
    ATTN_FOR_CHUNKS(db, g4) { const unsigned w0 = cvtpk(O[0][db][4 * g4 + 0] * inv, O[0][db][4 * g4 + 1] * inv), w1 = cvtpk(O[0][db][4 * g4 + 2] * inv, O[0][db][4 * g4 + 3] * inv);
        *(u64*)(dst + (4 * db + g4) * 256) = (u64)w0 | ((u64)w1 << 32); }
}
__device__ __forceinline__ void U_diff(KP p_, int bh_, int qb_, int l_) {
    const KP p = uni_kp(p_); const int bh = __builtin_amdgcn_readfirstlane(bh_), qb = __builtin_amdgcn_readfirstlane(qb_), l = __builtin_amdgcn_readfirstlane(l_);
    int tid_ = threadIdx.x; asm volatile("" : "+v"(tid_));
    const int tid = tid_, lane = tid & 63, wave = __builtin_amdgcn_readfirstlane(tid >> 6), r = lane & 31, h = lane >> 5;
    unsigned char* ws = p->ws; asm volatile("" : "+s"(ws)); LAS unsigned char* L = (LAS unsigned char*)lds_raw;
    const int tw0 = 256 * qb + 32 * wave, t_lane = tw0 + r, b = bh >> 2, hd = bh & 3;
    const bf16* DQ = (const bf16*)(ws + WS_DQK); const bf16* DK = DQ + 8 * MiB;
    bf16x8v Qf[2][2];
#pragma unroll
    for (int mp = 0; mp < 2; ++mp)
#pragma unroll
        for (int s = 0; s < 2; ++s) Qf[mp][s] = *(const bf16x8v*)(DQ + ((size_t)(bh * 2 + mp) * T_ + t_lane) * 32 + 16 * s + 8 * h);
    f32x16 O[2][2]; float M[2] = {0.f, 0.f}, Ls[2] = {0.f, 0.f};
#pragma unroll
    for (int i = 0; i < 16; ++i) { O[0][0][i] = 0.f; O[0][1][i] = 0.f; O[1][0][i] = 0.f; O[1][1][i] = 0.f; }
    const u64 tm = (qb == 15) ? ~0ull : ((1ull << (4 * qb + 4)) - 1ull);
    {
        const u64 low = (1ull << (4 * qb)) - 1ull; const float slope2 = alibi_slope(hd + 1, 4) * LOG2E;
        const bf16* K0 = DK + (size_t)(bh * 2 + 0) * T_ * 32; const bf16* K1 = DK + (size_t)(bh * 2 + 1) * T_ * 32; const bf16* Vp = (const bf16*)(ws + WS_DV) + (size_t)bh * T_ * 64;
#define DIFF_CORES(NM) do { \
        attn_core<32, 2, false, false, false, NM>(L, K0, K1, Vp, nullptr, 0.f, Qf, tm & ~low, t_lane, tw0, 1 << 30, slope2, 0u, 0u, O, M, Ls, tid); \
        if (qb > 0) { \
            const float qa = q_norm2_max<2>(Qf[0], lane), qb2 = q_norm2_max<2>(Qf[1], lane), ma = wave_min_l(M[0], lane), mb = wave_min_l(M[1], lane); \
            const float* kn = (const float*)((const unsigned*)(ws + WS_CTL) + CW_KN + l * 8192 + 4096) + (size_t)(bh * 2) * 64 + lane; \
            bool skip = false; \
            if (lane < 4 * qb) { const float bmax = slope2 * (float)(64 * lane + 63 - tw0);            \
                skip = (sqrtf(qa * kn[0]) * local_const(1.02f) + bmax - ma < -152.f) && (sqrtf(qb2 * kn[64]) * local_const(1.02f) + bmax - mb < -152.f); } \
            const u64 drop = prune_consensus(skip, (LAS u64*)(L + A_LDS_END), wave, lane); \
            const u64 tm2 = low & ~drop; \
            if (tm2) attn_core<32, 2, false, false, false, NM>(L, K0, K1, Vp, nullptr, 0.f, Qf, tm2, t_lane, tw0, 1 << 30, slope2, 0u, 0u, O, M, Ls, tid, true); \
        } } while (0)
        DIFF_CORES(NOMAX_ON);
        if (NOMAX_ON && block_any(sum_bad(Ls[0]) || sum_bad(Ls[1]), (LAS u64*)(L + A_LDS_END + 64), wave, lane)) {
#pragma unroll
            for (int i = 0; i < 16; ++i) { O[0][0][i] = 0.f; O[0][1][i] = 0.f; O[1][0][i] = 0.f; O[1][1][i] = 0.f; }
            M[0] = 0.f; M[1] = 0.f; Ls[0] = 0.f; Ls[1] = 0.f;
            DIFF_CORES(false);
        }
#undef DIFF_CORES
    }
    const float* lam = p->in[11] + (size_t)l * 128; const float* subln = p->in[12] + (size_t)l * 64;
    float l1 = 0.f, l2 = 0.f; if (lane < 32) { l1 = lam[lane] * lam[32 + lane]; l2 = lam[64 + lane] * lam[96 + lane]; }
    const float li = lambda_init_of(l), lam_full = __expf(wave_sum_l(l1, lane)) - __expf(wave_sum_l(l2, lane)) + li;
    const float lt0 = swap_sum(Ls[0]), lt1 = swap_sum(Ls[1]), i0 = lt0 > 0.f ? 1.f / lt0 : 0.f, i1 = (lt1 > 0.f ? 1.f / lt1 : 0.f) * lam_full;
    float ss = 0.f;
#pragma unroll
    for (int db = 0; db < 2; ++db)
#pragma unroll
        for (int i = 0; i < 16; ++i) { const float o = O[0][db][i] * i0 - O[1][db][i] * i1; O[0][db][i] = o; ss += o * o; }
    ss = swap_sum(ss);
    const float rn = rsqrtf(ss * (1.f / 64.f) + EPS) * (1.f - li);
    bf16* dst = (bf16*)(ws + WS_ATT) + mix_off((size_t)b * T_ + t_lane, 768 + hd * 64 + 4 * h, 1024);
    f32x4 sgv[8];
    ATTN_FOR_CHUNKS(db, g4) sgv[4 * db + g4] = *(const f32x4*)(subln + 32 * db + 8 * g4 + 4 * h);
#pragma unroll
    for (int i = 0; i < 8; ++i) asm volatile("" : "+v"(sgv[i]));
    ATTN_FOR_CHUNKS(db, g4) { const f32x4 sg = sgv[4 * db + g4];
        const unsigned w0 = cvtpk(O[0][db][4 * g4 + 0] * rn * sg.x, O[0][db][4 * g4 + 1] * rn * sg.y), w1 = cvtpk(O[0][db][4 * g4 + 2] * rn * sg.z, O[0][db][4 * g4 + 3] * rn * sg.w);
        *(u64*)(dst + (4 * db + g4) * 256) = (u64)w0 | ((u64)w1 << 32); }
}
__device__ __forceinline__ void U_win(KP p_, int bg_, int c_) {
    const KP p = uni_kp(p_); const int bg = __builtin_amdgcn_readfirstlane(bg_), cc = __builtin_amdgcn_readfirstlane(c_);
    int tid_ = threadIdx.x; asm volatile("" : "+v"(tid_));
    const int tid = tid_, lane = tid & 63, wave = __builtin_amdgcn_readfirstlane(tid >> 6), r = lane & 31, h = lane >> 5;
    unsigned char* ws = p->ws; asm volatile("" : "+s"(ws)); LAS unsigned char* L = (LAS unsigned char*)lds_raw;
    const int b = bg >> 1, g = bg & 1, hd = g * 4 + (wave >> 1), tw0 = 64 * cc + 32 * (wave & 1), t_lane = tw0 + r;
    const bf16* q = (const bf16*)(ws + WS_QN) + (size_t)(b * 8 + hd) * T_ * 64 + (t_lane >> 4) * 1024 + (t_lane & 15) * 32 + 8 * h;
    bf16x8v Qf[1][4];
#pragma unroll
    for (int s = 0; s < 4; ++s) Qf[0][s] = *(const bf16x8v*)(q + (s >> 1) * 512 + (s & 1) * 16);
    f32x16 O[1][2]; float M[1] = {0.f}, Ls[1] = {0.f};
#pragma unroll
    for (int i = 0; i < 16; ++i) { O[0][0][i] = 0.f; O[0][1][i] = 0.f; }
    const size_t n = (size_t)b * T_ + t_lane;
    const float gate_w = ((const float*)(ws + WS_GATE))[n * 24 + hd * 3 + 2];
    const int jlo = cc > 8 ? cc - 8 : 0;
    const u64 hi = (cc == 63) ? ~0ull : ((1ull << (cc + 1)) - 1ull), tm = hi & ~((1ull << jlo) - 1ull);
#if AC2_MODE == 0
    attn_core<64, 1, false, false, false, NOMAX_ON>(L, (const bf16*)(ws + WS_KV6 + 4 * KV6_STRIDE) + (size_t)bg * T_ * 64, nullptr, (const bf16*)(ws + WS_KV6 + 5 * KV6_STRIDE) + (size_t)bg * T_ * 64, nullptr, 0.f,
                                   Qf, tm, t_lane, tw0, 512, alibi_slope(hd + 1, 8) * LOG2E, 0u, 0u, O, M, Ls, tid);
    if (NOMAX_ON && block_any(sum_bad(Ls[0]), (LAS u64*)(L + A_LDS_END + 64), wave, lane)) {
#pragma unroll
        for (int i = 0; i < 16; ++i) { O[0][0][i] = 0.f; O[0][1][i] = 0.f; }
        M[0] = 0.f; Ls[0] = 0.f;
        attn_core<64, 1, false, false, false, false>(L, (const bf16*)(ws + WS_KV6 + 4 * KV6_STRIDE) + (size_t)bg * T_ * 64, nullptr, (const bf16*)(ws + WS_KV6 + 5 * KV6_STRIDE) + (size_t)bg * T_ * 64, nullptr, 0.f,
                                       Qf, tm, t_lane, tw0, 512, alibi_slope(hd + 1, 8) * LOG2E, 0u, 0u, O, M, Ls, tid);
    }
#ifdef PROBE_WINCORE2
    attn_core<64, 1, false, false>(L, (const bf16*)(ws + WS_KV6 + 4 * KV6_STRIDE) + (size_t)bg * T_ * 64, nullptr, (const bf16*)(ws + WS_KV6 + 5 * KV6_STRIDE) + (size_t)bg * T_ * 64, nullptr, 0.f,
                                   Qf, tm, t_lane, tw0, 512, alibi_slope(hd + 1, 8) * LOG2E, 0u, 0u, O, M, Ls, tid, true);
#endif
#else
    attn_core2<false, false>(L, (const bf16*)(ws + WS_KV6 + 4 * KV6_STRIDE) + (size_t)bg * T_ * 64, (const bf16*)(ws + WS_KV6 + 5 * KV6_STRIDE) + (size_t)bg * T_ * 64, nullptr, 0.f,
                             Qf[0], tm, t_lane, tw0, 512, alibi_slope(hd + 1, 8) * LOG2E, 0u, 0u, O[0], M[0], Ls[0], tid);
#endif
    const float lt = swap_sum(Ls[0]), inv = (lt > 0.f ? 1.f / lt : 0.f) * gate_w;
    bf16* dst = (bf16*)(ws + WS_OWIN) + mix_off(n, hd * 64 + 4 * h, 512);
    ATTN_FOR_CHUNKS(db, g4) { const unsigned w0 = cvtpk(O[0][db][4 * g4 + 0] * inv, O[0][db][4 * g4 + 1] * inv), w1 = cvtpk(O[0][db][4 * g4 + 2] * inv, O[0][db][4 * g4 + 3] * inv);
        *(u64*)(dst + (4 * db + g4) * 256) = (u64)w0 | ((u64)w1 << 32); }
}
__device__ __forceinline__ void U_slc(KP p_, int bg_, int c_) {
    const KP p = uni_kp(p_); const int bg = __builtin_amdgcn_readfirstlane(bg_), cc = __builtin_amdgcn_readfirstlane(c_);
    int tid_ = threadIdx.x; asm volatile("" : "+v"(tid_));
    const int tid = tid_, lane = tid & 63, wave = __builtin_amdgcn_readfirstlane(tid >> 6), r = lane & 31, h = lane >> 5;
    unsigned char* ws = p->ws; asm volatile("" : "+s"(ws)); LAS unsigned char* L = (LAS unsigned char*)lds_raw;
    const int b = bg >> 1, g = bg & 1, hd = g * 4 + (wave >> 1), tw0 = 64 * cc + 32 * (wave & 1), t_lane = tw0 + r;
    const bf16* q = (const bf16*)(ws + WS_QN) + (size_t)(b * 8 + hd) * T_ * 64 + (t_lane >> 4) * 1024 + (t_lane & 15) * 32 + 8 * h;
    bf16x8v Qf[1][4];
#pragma unroll
    for (int s = 0; s < 4; ++s) Qf[0][s] = *(const bf16x8v*)(q + (s >> 1) * 512 + (s & 1) * 16);
    f32x16 O[1][2]; float M[1] = {0.f}, Ls[1] = {0.f};
#pragma unroll
    for (int i = 0; i < 16; ++i) { O[0][0][i] = 0.f; O[0][1][i] = 0.f; }
    const bf16* Ksl = (const bf16*)(ws + WS_KV6 + 2 * KV6_STRIDE) + (size_t)bg * T_ * 64; const bf16* Vsl = (const bf16*)(ws + WS_KV6 + 3 * KV6_STRIDE) + (size_t)bg * T_ * 64;
    u32x4 kpre, vpre; attn_preload<64>(Ksl, nullptr, Vsl, cc, tid, kpre, vpre);
    const size_t n = (size_t)b * T_ + t_lane;
    const float gate_s = ((const float*)(ws + WS_GATE))[n * 24 + hd * 3 + 1];
    const bf16* oc = (const bf16*)(ws + WS_OCMP) + mix_off(n, hd * 64 + 4 * h, 512); const bf16* ow = (const bf16*)(ws + WS_OWIN) + mix_off(n, hd * 64 + 4 * h, 512);
    u64 ocv[8], owv[8];
    ATTN_FOR_CHUNKS(db, g4) { ocv[4 * db + g4] = *(const u64*)(oc + (4 * db + g4) * 256); owv[4 * db + g4] = *(const u64*)(ow + (4 * db + g4) * 256); }
    const u64* sel = (const u64*)(ws + WS_SEL) + (size_t)bg * T_;
    const u64 mine = sel[t_lane]; u64 un = sel[64 * cc + lane];
    { unsigned ul = (unsigned)un, uh = (unsigned)(un >> 32);
      un = ((u64)wave_or_u(uh) << 32) | wave_or_u(ul); }
#if AC2_MODE == 0
    attn_core<64, 1, false, true, true, NOMAX_ON>(L, Ksl, nullptr, Vsl, nullptr, 0.f,
                                  Qf, un, t_lane, tw0, 1 << 30, alibi_slope(hd + 1, 8) * LOG2E, (unsigned)mine, (unsigned)(mine >> 32), O, M, Ls, tid, false, cc, kpre, vpre);
    if (NOMAX_ON && block_any(sum_bad(Ls[0]), (LAS u64*)(L + A_LDS_END + 64), wave, lane)) {
#pragma unroll
        for (int i = 0; i < 16; ++i) { O[0][0][i] = 0.f; O[0][1][i] = 0.f; }
        M[0] = 0.f; Ls[0] = 0.f;
        attn_core<64, 1, false, true, false, false>(L, Ksl, nullptr, Vsl, nullptr, 0.f, Qf, un, t_lane, tw0, 1 << 30, alibi_slope(hd + 1, 8) * LOG2E, (unsigned)mine, (unsigned)(mine >> 32), O, M, Ls, tid);
    }
#else
    attn_core2<false, true>(L, (const bf16*)(ws + WS_KV6 + 2 * KV6_STRIDE) + (size_t)bg * T_ * 64, (const bf16*)(ws + WS_KV6 + 3 * KV6_STRIDE) + (size_t)bg * T_ * 64, nullptr, 0.f,
                            Qf[0], un, t_lane, tw0, 1 << 30, alibi_slope(hd + 1, 8) * LOG2E, (unsigned)mine, (unsigned)(mine >> 32), O[0], M[0], Ls[0], tid);
#endif
    const float lt = swap_sum(Ls[0]), inv = (lt > 0.f ? 1.f / lt : 0.f) * gate_s;
    bf16* dst = (bf16*)(ws + WS_ATT) + mix_off(n, hd * 64 + 4 * h, 1024);
    ATTN_FOR_CHUNKS(db, g4) { const u64 a = ocv[4 * db + g4], w = owv[4 * db + g4];
        const float x0 = O[0][db][4 * g4 + 0] * inv + __uint_as_float((unsigned)a << 16) + __uint_as_float((unsigned)w << 16);
        const float x1 = O[0][db][4 * g4 + 1] * inv + __uint_as_float((unsigned)a & 0xffff0000u) + __uint_as_float((unsigned)w & 0xffff0000u);
        const float x2 = O[0][db][4 * g4 + 2] * inv + __uint_as_float((unsigned)(a >> 32) << 16) + __uint_as_float((unsigned)(w >> 32) << 16);
        const float x3 = O[0][db][4 * g4 + 3] * inv + __uint_as_float((unsigned)(a >> 32) & 0xffff0000u) + __uint_as_float((unsigned)(w >> 32) & 0xffff0000u);
        *(u64*)(dst + (4 * db + g4) * 256) = (u64)cvtpk(x0, x1) | ((u64)cvtpk(x2, x3) << 32); }
}
__device__ __forceinline__ float other_half(float x, int h) { auto rr = __builtin_amdgcn_permlane32_swap(__float_as_uint(x), __float_as_uint(x), false, false); return __uint_as_float(h ? rr[0] : rr[1]); }
__device__ __forceinline__ int other_half_i(int x, int h) { auto rr = __builtin_amdgcn_permlane32_swap((unsigned)x, (unsigned)x, false, false); return (int)(h ? rr[0] : rr[1]); }
template <bool MASK>
__device__ __forceinline__ void cmp_scores(f32x16& p0, f32x16& p1, const LAS unsigned char* kt, const bf16x8v (&Qf)[4], float b0, float s1, int cl, int nvis_l) {
    const float s8 = s1 * 8.f, s32 = s1 * 32.f;
    p0[0] = b0; p0[1] = p0[0] + s1; p0[2] = p0[1] + s1; p0[3] = p0[2] + s1;
#pragma unroll
    for (int reg = 4; reg < 16; ++reg) p0[reg] = p0[reg - 4] + s8;
#pragma unroll
    for (int reg = 0; reg < 16; ++reg) p1[reg] = p0[reg] + s32;
#pragma unroll
    for (int s = 0; s < 4; ++s) { const bf16x8v kf0 = *(const LAS bf16x8v*)(kt + s * 32), kf1 = *(const LAS bf16x8v*)(kt + 32 * 144 + s * 32);
        p0 = __builtin_amdgcn_mfma_f32_32x32x16_bf16(kf0, Qf[s], p0, 0, 0, 0); p1 = __builtin_amdgcn_mfma_f32_32x32x16_bf16(kf1, Qf[s], p1, 0, 0, 0); }
    if (MASK) {
#pragma unroll
        for (int reg = 0; reg < 16; ++reg) { const int c = cl + crow0(reg); p0[reg] = (c < nvis_l) ? p0[reg] : -INFINITY; p1[reg] = (c + 32 < nvis_l) ? p1[reg] : -INFINITY; } }
}
__device__ __forceinline__ void U_cmp(KP p_, int bg_, int u_) {
    const KP p = uni_kp(p_); const int bg = __builtin_amdgcn_readfirstlane(bg_), uu = __builtin_amdgcn_readfirstlane(u_);
    int tid_ = threadIdx.x; asm volatile("" : "+v"(tid_));
    const int tid = tid_, lane = tid & 63, wave = __builtin_amdgcn_readfirstlane(tid >> 6), r = lane & 31, h = lane >> 5;
    unsigned char* ws = p->ws; asm volatile("" : "+s"(ws)); LAS unsigned char* L = (LAS unsigned char*)lds_raw;
    const int b = bg >> 1, g = bg & 1, tw0 = 32 * (uu + 16 * (wave < 4 ? wave : 11 - wave)), t_lane = tw0 + r;
    { const bf16* kc = (const bf16*)(ws + WS_KVCMP) + (size_t)bg * 256 * 64; const bf16* vc = kc + 16 * 256 * 64;
      u32x4 kq[4], vq[4];
#pragma unroll
      for (int i = 0; i < 4; ++i) { const int ch = tid + 512 * i, row = ch >> 3, c8 = ch & 7; kq[i] = *(const u32x4*)(kc + row * 64 + c8 * 8); vq[i] = *(const u32x4*)(vc + row * 64 + c8 * 8); }
#pragma unroll
      for (int i = 0; i < 4; ++i) { asm volatile("" : "+v"(kq[i])); asm volatile("" : "+v"(vq[i])); }
#pragma unroll
      for (int i = 0; i < 4; ++i) { const int ch = tid + 512 * i, row = ch >> 3, c8 = ch & 7;
          *(LAS u32x4*)(L + row * 144 + c8 * 16) = kq[i]; *(LAS u32x4*)(L + 36864 + row * 144 + c8 * 16) = vq[i]; } }
    __syncthreads();
    const int nvis_l = t_lane >= 31 ? ((t_lane - 31) >> 4) + 1 : 0, nvis_max = (tw0 >> 4) + 1, nvis_min = tw0 >= 31 ? ((tw0 - 31) >> 4) + 1 : 0, ntile = (nvis_max + 63) >> 6;
    const LAS unsigned char* kfrag = L + r * 144 + h * 16;
    const LAS unsigned char* vfrag = L + 36864 + (4 * h + ((lane & 15) >> 2)) * 144 + (16 * ((lane >> 4) & 1) + 4 * (lane & 3)) * 2;
    float imp[32];
#pragma unroll
    for (int e = 0; e < 32; ++e) imp[e] = 0.f;
    const float* gate = (const float*)(ws + WS_GATE) + ((size_t)b * T_ + t_lane) * 24;
#pragma unroll 1
    for (int hg = 0; hg < 4; ++hg) {
        const int hd = g * 4 + hg; const float s1 = alibi_slope(hd + 1, 8) * LOG2E * 16.f;
        const bf16* q = (const bf16*)(ws + WS_QN) + (size_t)(b * 8 + hd) * T_ * 64 + (t_lane >> 4) * 1024 + (t_lane & 15) * 32 + 8 * h;
        bf16x8v Qf[4];
#pragma unroll
        for (int s = 0; s < 4; ++s) Qf[s] = *(const bf16x8v*)(q + (s >> 1) * 512 + (s & 1) * 16);
        f32x16 O0, O1;
#pragma unroll
        for (int i = 0; i < 16; ++i) { O0[i] = 0.f; O1[i] = 0.f; }
        float oscale = 0.f; bool bad;
        {
        float lsum = 0.f, carry = 0.f; float ih[32];
#pragma unroll
        for (int e = 0; e < 32; ++e) ih[e] = 0.f;
#pragma unroll
        for (int jt = 0; jt < 4; ++jt) if (jt < ntile) {
            f32x16 p0, p1; const float b0 = s1 * (float)(64 * jt + 4 * h - nvis_max);
            if (64 * jt + 63 >= nvis_min) cmp_scores<true>(p0, p1, kfrag + jt * (64 * 144), Qf, b0, s1, 64 * jt + 4 * h, nvis_l);
            else cmp_scores<false>(p0, p1, kfrag + jt * (64 * 144), Qf, b0, s1, 64 * jt + 4 * h, nvis_l);
            float rs = 0.f;
#pragma unroll
            for (int reg = 0; reg < 16; ++reg) { p0[reg] = __builtin_amdgcn_exp2f(p0[reg]); p1[reg] = __builtin_amdgcn_exp2f(p1[reg]); rs += p0[reg] + p1[reg]; }
            lsum += rs;
            float cv[8];
#pragma unroll
            for (int g4 = 0; g4 < 4; ++g4) { const float h0 = 0.5f * p0[4 * g4 + 3], h1 = 0.5f * p1[4 * g4 + 3];
                ih[jt * 8 + g4] += ((p0[4 * g4] + p0[4 * g4 + 1]) + p0[4 * g4 + 2]) + h0; ih[jt * 8 + 4 + g4] += ((p1[4 * g4] + p1[4 * g4 + 1]) + p1[4 * g4 + 2]) + h1;
                cv[g4] = h0; cv[4 + g4] = h1; }
            float prev = carry;
#pragma unroll
            for (int k = 0; k < 8; ++k) { const float sv = other_half(cv[k], h); ih[jt * 8 + k] += h ? sv : prev; prev = sv; }
            carry = prev;
            const bf16x8v pa0 = pack8(p0, 0), pa1 = pack8(p0, 8), pa2 = pack8(p1, 0), pa3 = pack8(p1, 8);
            const LAS unsigned char* vb = vfrag + jt * (64 * 144);
#pragma unroll
            for (int ks = 0; ks < 4; ++ks) { const bf16x8v pa = ks == 0 ? pa0 : ks == 1 ? pa1 : ks == 2 ? pa2 : pa3;
                { const s16x4 lo = tr_read(vb + ks * (16 * 144)), hi = tr_read(vb + ks * (16 * 144) + 8 * 144); const bf16x8v vf = {lo[0], lo[1], lo[2], lo[3], hi[0], hi[1], hi[2], hi[3]};
                  O0 = __builtin_amdgcn_mfma_f32_32x32x16_bf16(vf, pa, O0, 0, 0, 0); }
                { const s16x4 lo = tr_read(vb + ks * (16 * 144) + 64), hi = tr_read(vb + ks * (16 * 144) + 64 + 8 * 144); const bf16x8v vf = {lo[0], lo[1], lo[2], lo[3], hi[0], hi[1], hi[2], hi[3]};
                  O1 = __builtin_amdgcn_mfma_f32_32x32x16_bf16(vf, pa, O1, 0, 0, 0); } }
        }
#ifdef FORCE_FALLBACK
        bad = true;
#else
        bad = __any(sum_bad(lsum));
#endif
        if (!bad) { const float lt = swap_sum(lsum), inv = lt > 0.f ? 1.f / lt : 0.f; oscale = inv;
#pragma unroll
            for (int e = 0; e < 32; ++e) imp[e] = fmaf(ih[e], inv, imp[e]); }
        }
        if (bad) {
        float m, lsum;
#pragma unroll
        for (int i = 0; i < 16; ++i) { O0[i] = 0.f; O1[i] = 0.f; }
        m = -1e30f; lsum = 0.f;
#pragma unroll 1
        for (int jt = 0; jt < ntile; ++jt) {
            f32x16 p0, p1; const float b0 = s1 * (float)(64 * jt + 4 * h - nvis_max);
            if (64 * jt + 63 >= nvis_min) cmp_scores<true>(p0, p1, kfrag + jt * (64 * 144), Qf, b0, s1, 64 * jt + 4 * h, nvis_l);
            else cmp_scores<false>(p0, p1, kfrag + jt * (64 * 144), Qf, b0, s1, 64 * jt + 4 * h, nvis_l);
            float mt = fmaxf(p0[0], p1[0]);
#pragma unroll
            for (int reg = 1; reg < 16; ++reg) mt = fmaxf(mt, fmaxf(p0[reg], p1[reg]));
            mt = swap_max(mt);
            const float mn = fmaxf(m, mt); float rs = 0.f;
#pragma unroll
            for (int reg = 0; reg < 16; ++reg) rs += __builtin_amdgcn_exp2f(p0[reg] - mn) + __builtin_amdgcn_exp2f(p1[reg] - mn);
            lsum = lsum * __builtin_amdgcn_exp2f(m - mn) + rs; m = mn;
        }
        const float lt = swap_sum(lsum), cnorm = lt > 0.f ? m + __builtin_amdgcn_logf(lt) : 1e30f;
        float carry = 0.f;
#pragma unroll
        for (int jt = 0; jt < 4; ++jt) if (jt < ntile) {
            f32x16 p0, p1; const float b0 = s1 * (float)(64 * jt + 4 * h - nvis_max) - cnorm;
            if (64 * jt + 63 >= nvis_min) cmp_scores<true>(p0, p1, kfrag + jt * (64 * 144), Qf, b0, s1, 64 * jt + 4 * h, nvis_l);
            else cmp_scores<false>(p0, p1, kfrag + jt * (64 * 144), Qf, b0, s1, 64 * jt + 4 * h, nvis_l);
#pragma unroll
            for (int reg = 0; reg < 16; ++reg) { p0[reg] = __builtin_amdgcn_exp2f(p0[reg]); p1[reg] = __builtin_amdgcn_exp2f(p1[reg]); }
            float cv[8];
#pragma unroll
            for (int g4 = 0; g4 < 4; ++g4) { const float h0 = 0.5f * p0[4 * g4 + 3], h1 = 0.5f * p1[4 * g4 + 3];
                imp[jt * 8 + g4] += ((p0[4 * g4] + p0[4 * g4 + 1]) + p0[4 * g4 + 2]) + h0; imp[jt * 8 + 4 + g4] += ((p1[4 * g4] + p1[4 * g4 + 1]) + p1[4 * g4 + 2]) + h1;
                cv[g4] = h0; cv[4 + g4] = h1; }
            float prev = carry;
#pragma unroll
            for (int k = 0; k < 8; ++k) { const float sv = other_half(cv[k], h); imp[jt * 8 + k] += h ? sv : prev; prev = sv; }
            carry = prev;
            const bf16x8v pa0 = pack8(p0, 0), pa1 = pack8(p0, 8), pa2 = pack8(p1, 0), pa3 = pack8(p1, 8);
            const LAS unsigned char* vb = vfrag + jt * (64 * 144);
#pragma unroll
            for (int ks = 0; ks < 4; ++ks) { const bf16x8v pa = ks == 0 ? pa0 : ks == 1 ? pa1 : ks == 2 ? pa2 : pa3;
                { const s16x4 lo = tr_read(vb + ks * (16 * 144)), hi = tr_read(vb + ks * (16 * 144) + 8 * 144); const bf16x8v vf = {lo[0], lo[1], lo[2], lo[3], hi[0], hi[1], hi[2], hi[3]};
                  O0 = __builtin_amdgcn_mfma_f32_32x32x16_bf16(vf, pa, O0, 0, 0, 0); }
                { const s16x4 lo = tr_read(vb + ks * (16 * 144) + 64), hi = tr_read(vb + ks * (16 * 144) + 64 + 8 * 144); const bf16x8v vf = {lo[0], lo[1], lo[2], lo[3], hi[0], hi[1], hi[2], hi[3]};
                  O1 = __builtin_amdgcn_mfma_f32_32x32x16_bf16(vf, pa, O1, 0, 0, 0); } }
        }
        oscale = 1.f;
        }
        const float gt = gate[hd * 3 + 0] * oscale;
        bf16* dst = (bf16*)(ws + WS_OCMP) + mix_off((size_t)b * T_ + t_lane, hd * 64 + 4 * h, 512);
#pragma unroll
        for (int g4 = 0; g4 < 4; ++g4) {
            *(u64*)(dst + g4 * 256) = (u64)cvtpk(O0[4 * g4 + 0] * gt, O0[4 * g4 + 1] * gt) | ((u64)cvtpk(O0[4 * g4 + 2] * gt, O0[4 * g4 + 3] * gt) << 32);
            *(u64*)(dst + (4 + g4) * 256) = (u64)cvtpk(O1[4 * g4 + 0] * gt, O1[4 * g4 + 1] * gt) | ((u64)cvtpk(O1[4 * g4 + 2] * gt, O1[4 * g4 + 3] * gt) << 32); }
    }
    const int cur = tw0 >> 6; u64 mask;
    if (cur <= 15) mask = (1ull << (cur + 1)) - 1ull;
    else {
        mask = 1ull | (1ull << cur) | (1ull << (cur - 1));
#pragma unroll
        for (int e = 0; e < 32; ++e) { const int j = 2 * e + h; if (j > cur || j == 0 || j >= cur - 1) imp[e] = -INFINITY; }
#pragma unroll 1
        for (int round = 0; round < 13; ++round) {
            float bv = imp[0]; int be = 0;
#pragma unroll
            for (int e = 1; e < 32; ++e) if (imp[e] > bv) { bv = imp[e]; be = e; }
            const int bj = 2 * be + h; const float ov = other_half(bv, h); const int oj = other_half_i(bj, h);
            const bool mine = bv > ov || (bv == ov && bj < oj);
            mask |= 1ull << (mine ? bj : oj);
#pragma unroll
            for (int e = 0; e < 32; ++e) imp[e] = (mine && e == be) ? -INFINITY : imp[e];
        }
    }
    if (h == 0) ((u64*)(ws + WS_SEL))[(size_t)bg * T_ + t_lane] = mask;
    __syncthreads();
}
constexpr int CONV_UNITS = L_ * NEXP * (2 * 16 * 8 + 4 * 32) / 32;
__device__ __forceinline__ void U_conv(KP p_, int k_) {
    const KP p = uni_kp(p_); const int k = __builtin_amdgcn_readfirstlane(k_);
    int tid_ = threadIdx.x; asm volatile("" : "+v"(tid_));
    const int tid = tid_, lane = tid & 63, wave = __builtin_amdgcn_readfirstlane(tid >> 6);
    unsigned char* ws = p->ws; asm volatile("" : "+s"(ws));
    LAS float* scr = (LAS float*)lds_raw + wave * (64 * 33);
    constexpr int I_G = 16 * 8, I_D = 4 * 32, I_E = 2 * I_G + I_D;
#pragma unroll 1
    for (int i = 0; i < 4; ++i) {
        const int m = k * 32 + i * 8 + wave, l = m / (NEXP * I_E); int r = m % (NEXP * I_E); const int e = r / I_E; r = r % I_E; const size_t le = (size_t)l * NEXP + e;
        const float* W; bf16* WT; int ldw, K, ncol, r0 = 0, rmul = 1; const float* gk = nullptr;
        if (r < 2 * I_G) { const int up = r >= I_G; r -= up * I_G; W = p->in[19 + up] + le * D_ * DEXP; WT = (bf16*)(ws + WS_WGU_T) + le * 512 * D_; ldw = DEXP; K = D_; ncol = 256; r0 = up; rmul = 2; gk = p->in[14] + (size_t)l * D_; }
        else { r -= 2 * I_G; W = p->in[21] + le * DEXP * D_; WT = (bf16*)(ws + WS_WD_T) + le * D_ * DEXP; ldw = D_; K = DEXP; ncol = 1024; }
        transpose_seg(W, ldw, K, 0, ncol, WT, r0, rmul, r, scr, lane, gk);
    }
}
__device__ __forceinline__ int fetch_unit(KP p, int qidx) {
    volatile LAS unsigned* slot = (volatile LAS unsigned*)((LAS unsigned char*)lds_raw + MISC_OFF) + 16;
    __syncthreads();
    int t0_ = threadIdx.x; asm volatile("" : "+v"(t0_));
    if (t0_ == 0) *slot = __hip_atomic_fetch_add((unsigned*)(p->ws + WS_CTL) + CW_QUEUE + 64 * qidx, 1u, __ATOMIC_RELAXED, __HIP_MEMORY_SCOPE_AGENT);
    __syncthreads();
    return (int)__builtin_amdgcn_readfirstlane(*slot);
}
__device__ __forceinline__ void P_cmp1_mfma(int l_) { const KP p = (KP)__builtin_amdgcn_kernarg_segment_ptr(); int l = l_; asm volatile("" : "+s"(l));
    unsigned char* ws = p->ws; asm volatile("" : "+s"(ws)); const int c = launder_s((int)blockIdx.x), kv = c >> 4, pm = c & 15;
    OneUnitOrder S; S.has = c < 32; S.u.pm = pm; S.u.pn = kv;
    S.u.a = (const char*)(ws + WS_KV6 + (size_t)kv * KV6_STRIDE) + (size_t)pm * 256 * 1024 * 2; S.u.b = (const char*)((const bf16*)(ws + WS_W1_T) + ((size_t)l * 2 + kv) * 256 * 2048); S.u.b2 = S.u.b;
    const pg8::Gemm g{1024, 2048, 2048, 32, 0, 0};
    const EpiCmpH E{(bf16*)(ws + WS_HC), (const float*)(ws + WS_BIAS1) + l * 512};
    pg8::gemm_phase<EpiCmpH, OneUnitOrder, false, true>((LAS unsigned char*)lds_raw, g, S, E);
}
__device__ __forceinline__ void P_cmp2_mfma(int l_) { const KP p = (KP)__builtin_amdgcn_kernarg_segment_ptr(); int l = l_; asm volatile("" : "+s"(l));
    unsigned char* ws = p->ws; asm volatile("" : "+s"(ws)); const int c = launder_s((int)blockIdx.x), kv = c >> 4, pm = c & 15;
    OneUnitOrder S; S.has = c < 32; S.u.pm = pm; S.u.pn = kv;
    S.u.a = (const char*)((const bf16*)(ws + WS_HC) + ((size_t)kv * 4096 + pm * 256) * 256); S.u.b = (const char*)((const bf16*)(ws + WS_W2_T) + ((size_t)l * 2 + kv) * 64 * 256); S.u.b2 = S.u.b;
    const pg8::Gemm g{256, 256, 256, 4, 0, 0};
    const EpiCmpOut E{(bf16*)(ws + WS_KVCMP)};
    pg8::gemm_phase<EpiCmpOut, OneUnitOrder, false, true>((LAS unsigned char*)lds_raw, g, S, E);
}
__device__ __forceinline__ void P_moe_scatter(KP p_, int l_) { const KP p = uni_kp(p_); const int l = __builtin_amdgcn_readfirstlane(l_); const Ctx c = make_ctx(p); unsigned char* ws = p->ws;
    const unsigned* cnt = (const unsigned*)(ws + WS_CTL) + CW_MOECNT + l * MOE_LS;
    moe_build_tables(cnt, c.tid);
    const LAS int* T = (const LAS int*)((LAS unsigned char*)lds_raw + TBL_OFF);
    const unsigned* info = (const unsigned*)(ws + WS_ROUTE + RT_INFO); const float* tw = (const float*)(ws + WS_ROUTE + RT_W);
    int* rowtok = (int*)(ws + WS_ROUTE + RT_ROWTOK); float* roww = (float*)(ws + WS_ROUTE + RT_ROWW);
    bf16* xs = (bf16*)(ws + WS_XS); const bf16* x = (const bf16*)(ws + WS_HN); const float* gain = p->in[14] + (size_t)l * D_; const float* rstdv = (const float*)(ws + WS_ROUTE + RT_RSTD);
    { constexpr int RB = 4; float gg[2][8];
#pragma unroll
      for (int j = 0; j < 2; ++j) { const f32x4 a = ((const f32x4*)gain)[2 * c.lane + 128 * j], b2 = ((const f32x4*)gain)[2 * c.lane + 128 * j + 1]; gg[j][0] = a.x; gg[j][1] = a.y; gg[j][2] = a.z; gg[j][3] = a.w; gg[j][4] = b2.x; gg[j][5] = b2.y; gg[j][6] = b2.z; gg[j][7] = b2.w; }
      for (int row0 = c.gw * RB; row0 < NT; row0 += c.ngw * RB) {
        u32x4 vv[RB][2];
#pragma unroll
        for (int q = 0; q < RB; ++q)
#pragma unroll
            for (int j = 0; j < 2; ++j) vv[q][j] = ((const u32x4*)(x + (size_t)(row0 + q) * D_))[c.lane + 64 * j];
#pragma unroll
        for (int q = 0; q < RB; ++q) { const int row = row0 + q;
            const unsigned v = info[row]; const int cls = (int)(v >> 24), rank = (int)(v & 0xffffffu); const size_t dest = (size_t)T[cls] * 256 + rank; const float r = rstdv[row];
#pragma unroll
            for (int j = 0; j < 2; ++j) { float f[8]; unpack8(vv[q][j], f); u32x4 o; o.x = pk2(f[0] * r * gg[j][0], f[1] * r * gg[j][1]); o.y = pk2(f[2] * r * gg[j][2], f[3] * r * gg[j][3]); o.z = pk2(f[4] * r * gg[j][4], f[5] * r * gg[j][5]); o.w = pk2(f[6] * r * gg[j][6], f[7] * r * gg[j][7]);
                ((u32x4*)(xs + dest * D_))[c.lane + 64 * j] = o; }
            if (c.lane == 0) { rowtok[dest] = row; roww[2 * dest] = tw[2 * row]; roww[2 * dest + 1] = tw[2 * row + 1]; } }
      } }
    for (int cls = c.bid; cls < 112; cls += c.G) { const int n = (int)cnt[cls * MOE_CS], end = (int)((cnt[cls * MOE_CS] + 255u) >> 8) * 256; const size_t base = (size_t)T[cls] * 256;
        for (int r = n + c.tid; r < end; r += NTHREADS) rowtok[base + r] = -1; }
}
__device__ __forceinline__ int xcd_major(int bid, int G) { bid = launder_s(bid); return (G & 7) ? bid : (bid & 7) * (G >> 3) + (bid >> 3); }
__device__ __forceinline__ void P_moe_g1(int l_) { const KP p = (KP)__builtin_amdgcn_kernarg_segment_ptr(); int l = l_; asm volatile("" : "+s"(l));
    unsigned char* ws = p->ws; asm volatile("" : "+s"(ws));
    { int t0_ = threadIdx.x; asm volatile("" : "+v"(t0_)); moe_build_tables((const unsigned*)(ws + WS_CTL) + CW_MOECNT + l * MOE_LS, t0_); }
    const MoeOrder1 S{(const char*)ws, (const unsigned*)(ws + WS_REC), (const char*)((const bf16*)(ws + WS_WGU_T) + (size_t)l * NEXP * 512 * D_), (unsigned*)(ws + WS_CTL) + CW_MOECNT + l * MOE_LS + (112 + NEXP) * MOE_CS, (int)gridDim.x, xcd_major((int)blockIdx.x, (int)gridDim.x)};
    const pg8::Gemm g{D_, D_, D_, D_ / 64, 0, 0};
    const EpiMoeH E{(bf16*)(ws + WS_HB), (const u32x4*)(ws + WS_REC)};
    pg8::gemm_phase<EpiMoeH, MoeOrder1, true, true, true>((LAS unsigned char*)lds_raw, g, S, E);
}
__device__ __forceinline__ void P_moe_g2(int l_) { const KP p = (KP)__builtin_amdgcn_kernarg_segment_ptr(); int l = l_; asm volatile("" : "+s"(l));
    unsigned char* ws = p->ws; asm volatile("" : "+s"(ws));
    { int t0_ = threadIdx.x; asm volatile("" : "+v"(t0_)); moe_build_tables((const unsigned*)(ws + WS_CTL) + CW_MOECNT + l * MOE_LS, t0_); }
    const MoeOrder2 S{(const char*)(ws + WS_HB), (const char*)((const bf16*)(ws + WS_WD_T) + (size_t)l * NEXP * D_ * DEXP), (const unsigned*)(ws + WS_CTL) + CW_MOECNT + l * MOE_LS + (112 + NEXP) * MOE_CS, (unsigned*)(ws + WS_CTL) + XB_TMO + 4096, (int)gridDim.x, xcd_major((int)blockIdx.x, (int)gridDim.x)};
    const pg8::Gemm g{512, DEXP, 512, 4, 16, 16};
    const EpiMoeOut E{(bf16*)(ws + WS_HN), (const unsigned*)(ws + WS_RECC), l + 1 < L_ ? (float*)(ws + WS_SSQ) : nullptr};
    pg8::gemm_phase<EpiMoeOut, MoeOrder2, true, true, false, true>((LAS unsigned char*)lds_raw, g, S, E);
}
__device__ __forceinline__ void P_bias1(KP p_) { const KP p = uni_kp(p_); int t_ = threadIdx.x; asm volatile("" : "+v"(t_));
    const int i = launder_s((int)blockIdx.x) * NTHREADS + t_; if (i < L_ * 2 * 256) { const float* part = (const float*)(p->ws + WS_B1PART) + (size_t)(i >> 8) * 128 * 256 + (i & 255); float a = 0.f;
        for (int k = 0; k < 128; ++k) a += part[(size_t)k * 256]; ((float*)(p->ws + WS_BIAS1))[i] = a; } }
__device__ __forceinline__ void P_norm1(KP p_, int l_) { const KP p = uni_kp(p_); const int l = __builtin_amdgcn_readfirstlane(l_); const Ctx c = make_ctx(p); const Bufs b = make_bufs(p->ws);
    ph_raw_bf16_ssq(c, p->in[0], (bf16*)(p->ws + WS_HN), (float*)(p->ws + WS_SSQ)); }
__device__ __noinline__ void P_inproj(KP p_, int l_) { const KP p = uni_kp(p_); const int l = __builtin_amdgcn_readfirstlane(l_); const Ctx c = make_ctx(p); const Bufs b = make_bufs(p->ws);
    InProjOut o{b.QN, b.KV6, b.FQ, b.DQ, b.DV, b.GATE, b.FL, p->in[3] + l * 24, p->in[4] + l * 4};
    const bf16* A = b.HN;
    naive_gemm(c, NT, D_IN, D_, [=](int r, int k) { return bf2f(A[(size_t)r * D_ + k]); }, p->in[2] + (size_t)l * D_ * D_IN, D_IN,
               [=](int r, int col, float v) { inproj_store(o, r, col, v); }); }
__device__ __noinline__ void P_cmp1(KP p_, int l_, int kv_) { const KP p = uni_kp(p_); const int l = __builtin_amdgcn_readfirstlane(l_), kv = __builtin_amdgcn_readfirstlane(kv_); const Ctx c = make_ctx(p); const Bufs b = make_bufs(p->ws);
    const bf16* src = kv == 0 ? b.KC : b.VC; const float* pe = p->in[kv == 0 ? 5 : 8] + (size_t)l * 2048; bf16* hc = b.HC + (size_t)kv * 4096 * 256;
    naive_gemm(c, 4096, 256, 2048, [=](int r, int k) { return bf2f(src[(size_t)r * 1024 + k]) + pe[k]; }, p->in[kv == 0 ? 6 : 9] + (size_t)l * 2048 * 256, 256,
               [=](int r, int col, float v) { hc[(size_t)r * 256 + col] = (bf16)f2bf(gelu_tanh(v)); }); }
__device__ __noinline__ void P_cumsum(KP p_, int l_) { const KP p = uni_kp(p_); const int l = __builtin_amdgcn_readfirstlane(l_); const Ctx c = make_ctx(p); const Bufs b = make_bufs(p->ws); ph_cumsum(c, b.FL); }
__device__ __noinline__ void P_cmp2(KP p_, int l_, int kv_) { const KP p = uni_kp(p_); const int l = __builtin_amdgcn_readfirstlane(l_), kv = __builtin_amdgcn_readfirstlane(kv_); const Ctx c = make_ctx(p); const Bufs b = make_bufs(p->ws);
    const bf16* hc = b.HC + (size_t)kv * 4096 * 256; bf16* dst = kv == 0 ? b.KCMP : b.VCMP;
    naive_gemm(c, 4096, 64, 256, [=](int r, int k) { return bf2f(hc[(size_t)r * 256 + k]); }, p->in[kv == 0 ? 7 : 10] + (size_t)l * 256 * 64, 64,
               [=](int r, int col, float v) { dst[(size_t)r * 64 + col] = (bf16)f2bf((r & 255) == 255 ? 0.f : v); }); }
__device__ __noinline__ void P_win(KP p_, int l_) { const KP p = uni_kp(p_); const int l = __builtin_amdgcn_readfirstlane(l_); const Ctx c = make_ctx(p); const Bufs b = make_bufs(p->ws); ph_win_attn(c, b.QN, b.KW, b.VW, b.GATE, b.OWIN); }
__device__ __noinline__ void P_fox(KP p_, int l_) { const KP p = uni_kp(p_); const int l = __builtin_amdgcn_readfirstlane(l_); const Ctx c = make_ctx(p); const Bufs b = make_bufs(p->ws); ph_fox_attn(c, b.FQ, b.FK, b.FV, b.FL, b.ATT); }
__device__ __noinline__ void P_diff(KP p_, int l_) { const KP p = uni_kp(p_); const int l = __builtin_amdgcn_readfirstlane(l_); const Ctx c = make_ctx(p); const Bufs b = make_bufs(p->ws);
    ph_diff_attn(c, b.DQ, b.DK, b.DV, p->in[11] + (size_t)l * 128, p->in[12] + (size_t)l * 64, lambda_init_of(l), b.ATT); }
__device__ __noinline__ void P_cmpattn(KP p_, int l_) { const KP p = uni_kp(p_); const int l = __builtin_amdgcn_readfirstlane(l_); const Ctx c = make_ctx(p); const Bufs b = make_bufs(p->ws); ph_cmp_attn(c, b.QN, b.KCMP, b.VCMP, b.GATE, b.SEL, b.OCMP); }
__device__ __noinline__ void P_slc(KP p_, int l_) { const KP p = uni_kp(p_); const int l = __builtin_amdgcn_readfirstlane(l_); const Ctx c = make_ctx(p); const Bufs b = make_bufs(p->ws); ph_slc_attn(c, b.QN, b.KS, b.VS, b.GATE, b.SEL, b.OCMP, b.OWIN, b.ATT); }
__device__ __noinline__ void P_outproj(KP p_, int l_) { const KP p = uni_kp(p_); const int l = __builtin_amdgcn_readfirstlane(l_); const Ctx c = make_ctx(p); const Bufs b = make_bufs(p->ws);
    const bf16* A = b.ATT; float* xo = p->out; const float* xin = (l == 0) ? p->in[0] : p->out;
    naive_gemm(c, NT, D_, D_, [=](int r, int k) { return bf2f(A[(size_t)r * D_ + k]); }, p->in[13] + (size_t)l * D_ * D_, D_,
               [=](int r, int col, float v) { xo[(size_t)r * D_ + col] = xin[(size_t)r * D_ + col] + v; }); }
__device__ __forceinline__ void P_route3(int l_, int cbank) { const KP p = (KP)__builtin_amdgcn_kernarg_segment_ptr(); int l = l_; asm volatile("" : "+s"(l));
    int tid_ = threadIdx.x; asm volatile("" : "+v"(tid_));
    const int tid = tid_, lane = tid & 63, wave = __builtin_amdgcn_readfirstlane(tid >> 6), r = lane & 31, h = lane >> 5, kh = wave >> 2, wr = wave & 3;
    unsigned char* ws = p->ws; asm volatile("" : "+s"(ws)); const bf16* x = (const bf16*)(ws + WS_HN);
    const float* WR = (const float*)(ws + WS_WR) + (size_t)l * D_ * 64;
    LAS float* XT = (LAS float*)lds_raw + wave * (32 * 36);
    LAS float* WT = (LAS float*)lds_raw + 8 * 32 * 36 + kh * (2 * 32 * 64);
    LAS float* PL = (LAS float*)lds_raw + 8 * 32 * 36 + 2 * 2 * 32 * 64;
    LAS float* SS = PL + 2 * 128 * 41;
    const float* bgrp = p->in[16] + l * 4; const float* bexp = p->in[18] + l * 32;
    unsigned* cnt = (unsigned*)(ws + WS_CTL) + CW_MOECNT + l * MOE_LS + cbank;
    LAS unsigned* HIST = (LAS unsigned*)(SS + 2 * 128 * 2);
    for (int grp = launder_s((int)blockIdx.x); grp < NT / 128; grp += (int)gridDim.x) {
        const int row0 = grp * 128 + wr * 32;
        if (tid < 144) HIST[tid] = 0u;
        f32x16 acc0, acc1; float ss = 0.f;
#pragma unroll
        for (int i = 0; i < 16; ++i) { acc0[i] = 0.f; acc1[i] = 0.f; }
        { const u32x4* xsrc = (const u32x4*)(x + (size_t)(row0 + r) * D_ + kh * 512 + 8 * h);
          const u32x4* wsrc = (const u32x4*)(ws + WS_WR) + ((size_t)l * 64 + kh * 32) * 256 + lane;
#pragma unroll 4
          for (int ks = 0; ks < 32; ++ks) {
              const u32x4 av = xsrc[2 * ks], b0h = wsrc[ks * 256], b0l = wsrc[ks * 256 + 64], b1h = wsrc[ks * 256 + 128], b1l = wsrc[ks * 256 + 192];
              { float f_[8]; unpack8(av, f_);
#pragma unroll
                for (int e = 0; e < 8; ++e) ss = fmaf(f_[e], f_[e], ss); }
              const bf16x8v A = __builtin_bit_cast(bf16x8v, av);
              acc0 = __builtin_amdgcn_mfma_f32_32x32x16_bf16(A, __builtin_bit_cast(bf16x8v, b0h), acc0, 0, 0, 0); acc1 = __builtin_amdgcn_mfma_f32_32x32x16_bf16(A, __builtin_bit_cast(bf16x8v, b1h), acc1, 0, 0, 0);
              acc0 = __builtin_amdgcn_mfma_f32_32x32x16_bf16(A, __builtin_bit_cast(bf16x8v, b0l), acc0, 0, 0, 0); acc1 = __builtin_amdgcn_mfma_f32_32x32x16_bf16(A, __builtin_bit_cast(bf16x8v, b1l), acc1, 0, 0, 0);
          } }
#pragma unroll
        for (int reg = 0; reg < 16; ++reg) { const int row = wr * 32 + crow0(reg) + 4 * h; PL[(kh * 128 + row) * 41 + r] = acc0[reg]; if (r < 4) PL[(kh * 128 + row) * 41 + 32 + r] = acc1[reg]; }
        SS[(kh * 128 + wr * 32 + r) * 2 + h] = ss;
        __syncthreads();
        int cls = 0, ea = 0, eb = 0; unsigned lrank = 0u, lra = 0u, lrb = 0u; float wlo = 0.f, whi = 0.f, rstd = 0.f;
        if (tid < 128) {
            float lg[36];
#pragma unroll
            for (int cidx = 0; cidx < 36; ++cidx) lg[cidx] = PL[tid * 41 + cidx] + PL[(128 + tid) * 41 + cidx];
            const float sq = (SS[tid * 2] + SS[tid * 2 + 1]) + (SS[(128 + tid) * 2] + SS[(128 + tid) * 2 + 1]);
            rstd = rsqrtf(sq * (1.f / D_) + EPS);
            float gl[4]; int grp_i = 0;
#pragma unroll
            for (int q = 0; q < 4; ++q) gl[q] = lg[q] * rstd + bgrp[q];
            float gm = gl[0];
#pragma unroll
            for (int q = 1; q < 4; ++q) if (gl[q] > gm) { gm = gl[q]; grp_i = q; }
            float gs = 0.f;
#pragma unroll
            for (int q = 0; q < 4; ++q) gs += __expf(gl[q] - gm);
            const float grp_gate = 1.f / gs;
            float el[8];
#pragma unroll
            for (int q = 0; q < 8; ++q) { float v = lg[4 + q]; float bb = bexp[q];
                if (grp_i == 1) { v = lg[12 + q]; bb = bexp[8 + q]; } else if (grp_i == 2) { v = lg[20 + q]; bb = bexp[16 + q]; } else if (grp_i == 3) { v = lg[28 + q]; bb = bexp[24 + q]; }
                el[q] = v * rstd + bb; }
            int i0 = 0; float v0 = el[0];
#pragma unroll
            for (int q = 1; q < 8; ++q) if (el[q] > v0) { v0 = el[q]; i0 = q; }
            int i1 = -1; float v1 = -INFINITY;
#pragma unroll
            for (int q = 0; q < 8; ++q) if (q != i0 && el[q] > v1) { v1 = el[q]; i1 = q; }
            const float e1 = __expf(v1 - v0), den = 1.f + e1, w0 = grp_gate / den, w1 = grp_gate * e1 / den;
            const int lo = i0 < i1 ? i0 : i1, hi = i0 < i1 ? i1 : i0; cls = grp_i * 28 + lo * 8 - (lo * (lo + 1)) / 2 + (hi - lo - 1);
            wlo = i0 < i1 ? w0 : w1; whi = i0 < i1 ? w1 : w0;
            ea = grp_i * 8 + lo; eb = grp_i * 8 + hi;
            lrank = __hip_atomic_fetch_add(HIST + cls, 1u, __ATOMIC_RELAXED, __HIP_MEMORY_SCOPE_WORKGROUP);
            lra = __hip_atomic_fetch_add(HIST + 112 + ea, 1u, __ATOMIC_RELAXED, __HIP_MEMORY_SCOPE_WORKGROUP); lrb = __hip_atomic_fetch_add(HIST + 112 + eb, 1u, __ATOMIC_RELAXED, __HIP_MEMORY_SCOPE_WORKGROUP);
        }
        __syncthreads();
        if (tid < 144) { const unsigned n = HIST[tid]; if (n) HIST[144 + tid] = __hip_atomic_fetch_add(cnt + tid * MOE_CS, n, __ATOMIC_RELAXED, __HIP_MEMORY_SCOPE_AGENT); }
        __syncthreads();
        if (tid < 128) {
            const unsigned rank = HIST[144 + cls] + lrank, ra = HIST[144 + 112 + ea] + lra, rb = HIST[144 + 112 + eb] + lrb;
            const int row = grp * 128 + tid;
            ((unsigned*)(ws + WS_RECC))[(size_t)cls * 32768 + rank] = (unsigned)row;
            const unsigned info = ((unsigned)cls << 16) | rank;
            ((u32x4*)(ws + WS_REC))[(size_t)ea * 32768 + ra] = (u32x4){(unsigned)row, __float_as_uint(wlo), __float_as_uint(rstd), info};
            ((u32x4*)(ws + WS_REC))[(size_t)eb * 32768 + rb] = (u32x4){(unsigned)row, __float_as_uint(whi), __float_as_uint(rstd), info | 0x8000u};
        }
        __syncthreads();
    }
}
typedef float f32x8 __attribute__((ext_vector_type(8)));
__device__ __forceinline__ void P_route2(int l_, int cbank) { const KP p = (KP)__builtin_amdgcn_kernarg_segment_ptr(); int l = l_; asm volatile("" : "+s"(l));
    int tid_ = threadIdx.x; asm volatile("" : "+v"(tid_));
    const int tid = tid_, lane = tid & 63, wave = __builtin_amdgcn_readfirstlane(tid >> 6);
    unsigned char* ws = p->ws; asm volatile("" : "+s"(ws)); const float* x = p->out;
    const float* WR = (const float*)(ws + WS_WR) + (size_t)l * D_ * 40;
    LAS float* xt = (LAS float*)lds_raw + wave * (64 * 36);
    LAS float* part = (LAS float*)lds_raw;
    const float* bgrp = p->in[16] + l * 4; const float* bexp = p->in[18] + l * 32;
    unsigned* cnt = (unsigned*)(ws + WS_CTL) + CW_MOECNT + l * 128 + cbank;
    for (int grp = launder_s((int)blockIdx.x); grp < NT / 128; grp += (int)gridDim.x) {
        const int row0 = grp * 128 + (wave >> 2) * 64, kq = wave & 3;
        float acc[40]; float ss = 0.f;
#pragma unroll
        for (int cidx = 0; cidx < 40; ++cidx) acc[cidx] = 0.f;
#pragma unroll 1
        for (int kc = 0; kc < 8; ++kc) {
            const int k0 = kq * 256 + kc * 32;
#pragma unroll
            for (int i = 0; i < 8; ++i) { const int row = i * 8 + (lane >> 3), c4 = (lane & 7) * 4; *(LAS f32x4*)(xt + row * 36 + c4) = *(const f32x4*)(x + (size_t)(row0 + row) * D_ + k0 + c4); }
            float xr[32];
#pragma unroll
            for (int j = 0; j < 8; ++j) { const f32x4 t = *(const LAS f32x4*)(xt + lane * 36 + 4 * j); xr[4 * j] = t.x; xr[4 * j + 1] = t.y; xr[4 * j + 2] = t.z; xr[4 * j + 3] = t.w; }
            const float* wk = WR + (size_t)k0 * 40;
#pragma unroll
            for (int kk = 0; kk < 32; ++kk) {
                f32x8 w0, w1, w2, w3, w4;
                asm volatile("s_load_dwordx8 %0, %5, %6\n\ts_load_dwordx8 %1, %5, %7\n\ts_load_dwordx8 %2, %5, %8\n\ts_load_dwordx8 %3, %5, %9\n\ts_load_dwordx8 %4, %5, %10\n\ts_waitcnt lgkmcnt(0)"
                             : "=&s"(w0), "=&s"(w1), "=&s"(w2), "=&s"(w3), "=&s"(w4) : "s"(wk), "i"(kk * 160), "i"(kk * 160 + 32), "i"(kk * 160 + 64), "i"(kk * 160 + 96), "i"(kk * 160 + 128) : "memory");
                const float xv = xr[kk]; ss = fmaf(xv, xv, ss);
#pragma unroll
                for (int e = 0; e < 8; ++e) { acc[e] = fmaf(xv, w0[e], acc[e]); acc[8 + e] = fmaf(xv, w1[e], acc[8 + e]); acc[16 + e] = fmaf(xv, w2[e], acc[16 + e]); acc[24 + e] = fmaf(xv, w3[e], acc[24 + e]); }
#pragma unroll
                for (int e = 0; e < 4; ++e) acc[32 + e] = fmaf(xv, w4[e], acc[32 + e]);
            }
        }
        __syncthreads();
#pragma unroll
        for (int cidx = 0; cidx < 36; ++cidx) part[(wave * 64 + lane) * 37 + cidx] = acc[cidx];
        part[(wave * 64 + lane) * 37 + 36] = ss;
        __syncthreads();
        if (tid < 128) {
            const int rg = tid >> 6, rr = tid & 63; float lg[37];
#pragma unroll
            for (int cidx = 0; cidx < 37; ++cidx) lg[cidx] = ((part[((rg * 4 + 0) * 64 + rr) * 37 + cidx] + part[((rg * 4 + 1) * 64 + rr) * 37 + cidx]) + part[((rg * 4 + 2) * 64 + rr) * 37 + cidx]) + part[((rg * 4 + 3) * 64 + rr) * 37 + cidx];
            const float rstd = rsqrtf(lg[36] * (1.f / D_) + EPS);
            float gl[4]; int grp_i = 0;
#pragma unroll
            for (int q = 0; q < 4; ++q) gl[q] = lg[q] * rstd + bgrp[q];
            float gm = gl[0];
#pragma unroll
            for (int q = 1; q < 4; ++q) if (gl[q] > gm) { gm = gl[q]; grp_i = q; }
            float gs = 0.f;
#pragma unroll
            for (int q = 0; q < 4; ++q) gs += __expf(gl[q] - gm);
            const float grp_gate = 1.f / gs;
            float el[8];
#pragma unroll
            for (int q = 0; q < 8; ++q) { float v = lg[4 + q]; float bb = bexp[q];
                if (grp_i == 1) { v = lg[12 + q]; bb = bexp[8 + q]; } else if (grp_i == 2) { v = lg[20 + q]; bb = bexp[16 + q]; } else if (grp_i == 3) { v = lg[28 + q]; bb = bexp[24 + q]; }
                el[q] = v * rstd + bb; }
            int i0 = 0; float v0 = el[0];
#pragma unroll
            for (int q = 1; q < 8; ++q) if (el[q] > v0) { v0 = el[q]; i0 = q; }
            int i1 = -1; float v1 = -INFINITY;
#pragma unroll
            for (int q = 0; q < 8; ++q) if (q != i0 && el[q] > v1) { v1 = el[q]; i1 = q; }
            const float e1 = __expf(v1 - v0), den = 1.f + e1, w0 = grp_gate / den, w1 = grp_gate * e1 / den;
            const int lo = i0 < i1 ? i0 : i1, hi = i0 < i1 ? i1 : i0, cls = grp_i * 28 + lo * 8 - (lo * (lo + 1)) / 2 + (hi - lo - 1);
            const unsigned rank = __hip_atomic_fetch_add(cnt + cls, 1u, __ATOMIC_RELAXED, __HIP_MEMORY_SCOPE_AGENT);
            const int row = grp * 128 + tid;
            ((unsigned*)(ws + WS_ROUTE + RT_INFO))[row] = ((unsigned)cls << 24) | rank;
            ((float*)(ws + WS_ROUTE + RT_W))[2 * row] = i0 < i1 ? w0 : w1; ((float*)(ws + WS_ROUTE + RT_W))[2 * row + 1] = i0 < i1 ? w1 : w0;
            ((float*)(ws + WS_ROUTE + RT_RSTD))[row] = rstd;
        }
        __syncthreads();
    }
}
__device__ __noinline__ void P_route(KP p_, int l_) { const KP p = uni_kp(p_); const int l = __builtin_amdgcn_readfirstlane(l_); const Ctx c = make_ctx(p); const Bufs b = make_bufs(p->ws);
    ph_moe_route(c, p->out, p->in[14] + (size_t)l * D_, p->in[15] + (size_t)l * D_ * 4, p->in[16] + l * 4, p->in[17] + (size_t)l * D_ * 32, p->in[18] + l * 32, b.HN, (int*)(p->ws + WS_ROUTE + RT_INFO), (float*)(p->ws + WS_ROUTE + RT_W), (unsigned*)(p->ws + WS_CTL) + CW_MOECNT + l * 128); }
__device__ __noinline__ void P_moe(KP p_, int l_) { const KP p = uni_kp(p_); const int l = __builtin_amdgcn_readfirstlane(l_); const Ctx c = make_ctx(p); const Bufs b = make_bufs(p->ws);
    ph_moe_naive(c, b.HN, b.ROUTE_E, b.ROUTE_W, p->in[19] + (size_t)l * NEXP * D_ * DEXP, p->in[20] + (size_t)l * NEXP * D_ * DEXP, p->in[21] + (size_t)l * NEXP * DEXP * D_, p->out); }
__device__ __noinline__ void P_final(KP p_) { const KP p = uni_kp(p_); const Ctx c = make_ctx(p); ph_norm_final_from_bf16(c, (const bf16*)(p->ws + WS_HN), p->in[22], p->out); }
__device__ __forceinline__ void P_gridbar(KP p_) { const KP p = uni_kp(p_);
    XcdBarrier bar; bar.bar = (unsigned*)(p->ws + WS_CTL) + 4096; bar.x = xb_xcc_id(); bar.st = (volatile LAS unsigned*)((LAS unsigned char*)lds_raw + MISC_OFF) + 8;
    xcd_barrier(bar);
}

__global__ void __launch_bounds__(NTHREADS, 2) fwd_kernel(Params pp) {
    const KP p = (KP)__builtin_amdgcn_kernarg_segment_ptr();
    { volatile LAS unsigned* MISC = (volatile LAS unsigned*)((LAS unsigned char*)lds_raw + MISC_OFF); if (threadIdx.x < 32) MISC[threadIdx.x] = 0u; }
    __syncthreads();
    const int lo = p->ph_lo, hi = p->ph_hi;
    if (hi - lo > 1) (void)xcd_barrier_post((unsigned*)(p->ws + WS_CTL) + 4096, (volatile LAS unsigned*)((LAS unsigned char*)lds_raw + MISC_OFF) + 8);
#define IN(k) (lo <= (k) && (k) < hi)
#define SEAM(k) do { if (IN(k) && IN((k) + 1)) P_gridbar(p); } while (0)
    if (IN(0)) { for (int rep = 0; rep < REP_PRO; ++rep) { if (rep) P_gridbar(p); P_prologue(p); } }
    for (int l = 0; l < L_; ++l) {
        const int P0 = 1 + l * PH_PER_LAYER;
        if (l == 0) {
        if (IN(P0 + 0)) { for (int rep = 0; rep < REP_NORM; ++rep) { if (rep) P_gridbar(p); P_norm1(p, l); } }
        SEAM(P0 + 0);
        }
        if (IN(P0 + 1)) { if (l == 0) P_bias1(p);
            for (int rep = 0; rep < REP_INPROJ; ++rep) { if (rep) P_gridbar(p); P_inproj_mfma(l); }
#ifdef REP_INDUMMY
            for (int rep = 0; rep < REP_INDUMMY; ++rep) { P_gridbar(p); P_inproj_dummy(l); }
#endif
        }
        SEAM(P0 + 1);
        if (IN(P0 + 3)) {
            P_cmp1_mfma(l);
            if (launder_s((int)blockIdx.x) < 32) { asm volatile("s_waitcnt vmcnt(0)" ::: "memory"); __builtin_amdgcn_fence(__ATOMIC_SEQ_CST, "agent"); asm volatile("s_waitcnt vmcnt(0)" ::: "memory"); }
            __syncthreads();
            P_cmp2_mfma(l);
            for (int rep = 0; rep < REP_ATT3; ++rep) { if (rep) P_gridbar(p);
            for (;;) { int u = fetch_unit(p, l * 8 + 0 + 16 * rep);
                if (l == 0) {
                    if (u >= 2048 + CONV_UNITS) break;
                    const int k11 = u / 11, r11 = u - 11 * k11;
                    if (r11 == 3 || r11 == 7 || r11 == 10) { U_conv(p, 3 * k11 + (r11 > 3) + (r11 > 7)); continue; }
                    u = 8 * k11 + r11 - (r11 > 3) - (r11 > 7); }
                else if (u >= 2048) break;
                if (u < 1024) { const int qb = 15 - (u >> 6), k = u & 63; if (k < 32) U_diff(p, k, qb, l); else U_fox(p, k - 32, qb, l); }
                else { const int w = u - 1024; U_win(p, w & 15, 63 - (w >> 4));
#ifdef PROBE_WINUNIT2
                    U_win(p, w & 15, 63 - (w >> 4));
#endif
                } } } }
        SEAM(P0 + 3);
        if (IN(P0 + 4)) { for (int rep = 0; rep < REP_CMP; ++rep) { if (rep) P_gridbar(p); for (int u = launder_s((int)blockIdx.x); u < 256; u += (int)gridDim.x) U_cmp(p, u & 15, u >> 4); } }
        SEAM(P0 + 4);
        if (IN(P0 + 5)) { for (int rep = 0; rep < REP_SLC; ++rep) { if (rep) P_gridbar(p); for (;;) { const int u = fetch_unit(p, l * 8 + 1 + 16 * rep); if (u >= 1024) break; U_slc(p, u & 15, 63 - (u >> 4)); } } }
        SEAM(P0 + 5);
        if (IN(P0 + 6)) P_outproj_mfma(l);
        SEAM(P0 + 6);
        if (IN(P0 + 7)) { for (int rep = 0; rep < REP_ROUTE; ++rep) { if (rep) P_gridbar(p); P_route3(l, REP_ROUTE - 1 - rep); } }
        SEAM(P0 + 7);
        if (IN(P0 + 9)) { for (int rep = 0; rep < REP_G1; ++rep) { if (rep) P_gridbar(p); P_moe_g1(l); } }
        if (IN(P0 + 10)) P_moe_g2(l);
        SEAM(P0 + 10);
    }
    if (IN(1 + L_ * PH_PER_LAYER)) P_final(p);
#undef IN
#undef SEAM
}

extern "C" void kernel_launch(void* const* d_in, const int* in_sizes, int n_in, void* d_out, int out_size, void* d_ws, size_t ws_size, hipStream_t stream) {
    static int grid = 0;
    if (grid == 0) {
        if (n_in != 23 || out_size != NT * D_ || ws_size < WS_END) { fprintf(stderr, "kernel_launch: unexpected sizes n_in %d out %d ws %zu (need %zu)\n", n_in, out_size, ws_size, (size_t)WS_END); grid = -1; return; }
        int dev = 0, cus = 0, per_cu = 0;
        if (hipGetDevice(&dev) != hipSuccess || hipDeviceGetAttribute(&cus, hipDeviceAttributeMultiprocessorCount, dev) != hipSuccess) { grid = -1; return; }
        if (hipFuncSetAttribute((const void*)fwd_kernel, hipFuncAttributeMaxDynamicSharedMemorySize, LDS_BYTES) != hipSuccess) { fprintf(stderr, "kernel_launch: hipFuncSetAttribute failed\n"); grid = -1; return; }
        if (hipOccupancyMaxActiveBlocksPerMultiprocessor(&per_cu, (const void*)fwd_kernel, NTHREADS, LDS_BYTES) != hipSuccess || per_cu < 1) { fprintf(stderr, "kernel_launch: occupancy query says %d\n", per_cu); }
        (void)hipGetLastError();
        if (cus < 256) { fprintf(stderr, "kernel_launch: %d CUs: this kernel is laid out for the 256-CU MI355X (the in-projection's per-workgroup 1/rms tables assume a 256-workgroup deal)\n", cus); grid = -1; return; }
        grid = 256;
    }
    if (grid < 0) return;
    (void)hipMemsetAsync((char*)d_ws + WS_CTL, 0, CTL_BYTES, stream);
    Params p{};
    for (int i = 0; i < 23; ++i) p.in[i] = (const float*)d_in[i];
    p.out = (float*)d_out; p.ws = (unsigned char*)d_ws;
#if N_LAUNCH_MODE == 0
    p.ph_lo = 0; p.ph_hi = N_PHASES;
    hipLaunchKernelGGL(fwd_kernel, dim3(grid), dim3(NTHREADS), LDS_BYTES, stream, p);
#else
    for (int k = 0; k < N_PHASES; ++k) { p.ph_lo = k; p.ph_hi = k + 1; hipLaunchKernelGGL(fwd_kernel, dim3(grid), dim3(NTHREADS), LDS_BYTES, stream, p); }
#endif
}
```
